# Optimizing an MI355X kernel written in HIP

```python
import math
import jax
import jax.numpy as jnp
from jax import lax
import numpy as np

D_MODEL = 1024
BATCH = 4
SEQ = 4096
DEPTH = 2

D_MIX = D_MODEL
W_GROUP = D_MIX // 4
M_HEADDIM = 64
M_HEADS = W_GROUP // M_HEADDIM
M_STATE = 64
M_BC_GROUPS = 2
M_CONV = 4
M_CHUNK = 128
M_CONV_CH = W_GROUP + 2 * M_BC_GROUPS * M_STATE
M_IN = W_GROUP + M_CONV_CH + M_HEADS
R_HEADDIM = 64
R_HEADS = W_GROUP // R_HEADDIM
R_LORA_W = 32
R_LORA_A = 32
R_LORA_G = 64
R_GN_EPS = 64e-5
R_IN = 3 * W_GROUP + R_LORA_W + R_LORA_A + R_LORA_G
C_HEADDIM = 64
C_HEADS = W_GROUP // C_HEADDIM
C_Q = C_HEADS * C_HEADDIM
C_KV_RANK = 128
I_HEADS = 8
I_DIM = 32
TOPK_MAX = 256
Q_BLOCK = 128
C_IN = C_Q + C_KV_RANK + I_HEADS * I_DIM + I_DIM + I_HEADS
REL_BUCKETS = 32
REL_MAX_DIST = 128
S_GROUP_CH = 16
S_GROUPS = W_GROUP // S_GROUP_CH
S_STATE = 64
S_IN = W_GROUP
N_IN = M_IN + R_IN + C_IN + S_IN
E_GROUPS = 4
E_PER_GROUP = 8
D_EXPERT = 256
TOPK_INNER = 2
NORM_EPS = 1e-6

kernel_name = 'hybrid_hymba_ssd_rwkv7_dsa_s5_hmoe'


def rmsnorm(x, w):
    xf = x.astype(jnp.float32)
    y = xf * lax.rsqrt(jnp.mean(xf * xf, axis=-1, keepdims=True) + NORM_EPS)
    return (y * w.astype(jnp.float32)).astype(x.dtype)


def causal_dwconv(x, w, b):
    k, ch = w.shape
    y = lax.conv_general_dilated(x, w.astype(x.dtype)[:, None, :], window_strides=(1,),
                                 padding=[(k - 1, 0)], dimension_numbers=('NWC', 'WIO', 'NWC'),
                                 feature_group_count=ch)
    return y + b.astype(x.dtype)


def ssd_chunked(xdt, a, bm, cm):
    b, L, h, p = xdt.shape
    n = bm.shape[-1]
    c = L // M_CHUNK
    xdt = xdt.reshape(b, c, M_CHUNK, h, p)
    bm = bm.reshape(b, c, M_CHUNK, h, n)
    cm = cm.reshape(b, c, M_CHUNK, h, n)
    a_cum = jnp.cumsum(jnp.moveaxis(a.reshape(b, c, M_CHUNK, h), 2, 3), axis=-1)
    pos = jnp.arange(M_CHUNK)
    causal = pos[:, None] >= pos[None, :]
    decay_ls = jnp.exp(jnp.where(causal, a_cum[..., :, None] - a_cum[..., None, :], -jnp.inf))
    scores = jnp.einsum('bclhn,bcshn->bchls', cm, bm) * decay_ls
    y_diag = jnp.einsum('bchls,bcshp->bclhp', scores, xdt)
    decay_to_end = jnp.moveaxis(jnp.exp(a_cum[..., -1:] - a_cum), 2, 3)
    chunk_states = jnp.einsum('bclhn,bclhp->bchpn', bm * decay_to_end[..., None], xdt)
    chunk_decay = jnp.exp(a_cum[..., -1])

    def step(state, inp):
        st, dec = inp
        return state * dec[:, :, None, None] + st, state

    s0 = jnp.zeros((b, h, p, n), jnp.float32)
    _, start_states = lax.scan(step, s0, (jnp.moveaxis(chunk_states, 1, 0), jnp.moveaxis(chunk_decay, 1, 0)))
    start_states = jnp.moveaxis(start_states, 0, 1)
    decay_in = jnp.moveaxis(jnp.exp(a_cum), 2, 3)[..., None]
    y_off = jnp.einsum('bclhn,bchpn->bclhp', cm, start_states) * decay_in
    return (y_diag + y_off).reshape(b, L, h, p)


def mamba2_group(u, conv_w, conv_b, dt_bias, a_log, d_skip, norm_w):
    f32 = jnp.float32
    bsz, L, _ = u.shape
    z, xbc, dt = jnp.split(u, [W_GROUP, W_GROUP + M_CONV_CH], axis=-1)
    xbc = jax.nn.silu(causal_dwconv(xbc, conv_w, conv_b)).astype(f32)
    xs, bm, cm = jnp.split(xbc, [W_GROUP, W_GROUP + M_BC_GROUPS * M_STATE], axis=-1)
    rep = M_HEADS // M_BC_GROUPS
    xs = xs.reshape(bsz, L, M_HEADS, M_HEADDIM)
    bm = jnp.repeat(bm.reshape(bsz, L, M_BC_GROUPS, M_STATE), rep, axis=2)
    cm = jnp.repeat(cm.reshape(bsz, L, M_BC_GROUPS, M_STATE), rep, axis=2)
    dt = jax.nn.softplus(dt.astype(f32) + dt_bias.astype(f32))
    a_head = -jnp.exp(a_log.astype(f32))
    y = ssd_chunked(xs * dt[..., None], dt * a_head, bm, cm)
    y = (y + xs * d_skip.astype(f32)[:, None]).reshape(bsz, L, W_GROUP)
    return rmsnorm(y * jax.nn.silu(z.astype(f32)), norm_w)


def rwkv7_group(u, mu, w0, w2, a0, a2, g2, k_k, k_a, r_k, ln_w, ln_b):
    f32 = jnp.float32
    bsz, L, _ = u.shape
    u = u.astype(f32)
    u_prev = jnp.pad(u, ((0, 0), (1, 0), (0, 0)))[:, :-1]
    u = u + mu.astype(f32) * (u_prev - u)
    s1 = W_GROUP
    r, k, v, dw, da, dg = jnp.split(u, [s1, 2 * s1, 3 * s1, 3 * s1 + R_LORA_W, 3 * s1 + R_LORA_W + R_LORA_A], axis=-1)
    w_log = -jax.nn.softplus(-(w0.astype(f32) + jnp.tanh(dw) @ w2.astype(f32))) - 0.5
    decay = jnp.exp(-jnp.exp(w_log))
    a = jax.nn.sigmoid(a0.astype(f32) + da @ a2.astype(f32))
    g = jax.nn.sigmoid(dg) @ g2.astype(f32)

    def heads(t):
        return t.reshape(bsz, L, R_HEADS, R_HEADDIM)

    kk = heads(k * k_k.astype(f32))
    kk = kk * lax.rsqrt(jnp.maximum(jnp.sum(kk * kk, axis=-1, keepdims=True), 1e-24))
    k = k * (1.0 + (a - 1.0) * k_a.astype(f32))
    r, decay, k, v, a = heads(r), heads(decay), heads(k), heads(v), heads(a)

    def step(state, inp):
        r_t, w_t, k_t, v_t, a_t, b_t = inp
        sa = jnp.einsum('bhvk,bhk->bhv', state, a_t)
        state = state * w_t[:, :, None, :] + sa[..., None] * b_t[:, :, None, :] + v_t[..., None] * k_t[:, :, None, :]
        return state, jnp.einsum('bhvk,bhk->bhv', state, r_t)

    def tm(t):
        return jnp.swapaxes(t, 0, 1)

    s0 = jnp.zeros((bsz, R_HEADS, R_HEADDIM, R_HEADDIM), f32)
    _, o = lax.scan(step, s0, (tm(r), tm(decay), tm(k), tm(v), tm(-kk), tm(kk * a)))
    o = tm(o)
    mean = jnp.mean(o, axis=-1, keepdims=True)
    var = jnp.mean(jnp.square(o - mean), axis=-1, keepdims=True)
    o = ((o - mean) * lax.rsqrt(var + R_GN_EPS)).reshape(bsz, L, W_GROUP) * ln_w.astype(f32) + ln_b.astype(f32)
    o = o + (jnp.sum(r * k * r_k.astype(f32), axis=-1, keepdims=True) * v).reshape(bsz, L, W_GROUP)
    return o * g


def t5_bucket(dist):
    n = jnp.maximum(dist, 0)
    max_exact = REL_BUCKETS // 2
    log_ratio = jnp.log(jnp.maximum(n, 1).astype(jnp.float32) / max_exact) / math.log(REL_MAX_DIST / max_exact)
    large = jnp.minimum(max_exact + (log_ratio * (REL_BUCKETS - max_exact)).astype(jnp.int32), REL_BUCKETS - 1)
    return jnp.where(n < max_exact, n, large)


def dsa_group(u, kv_norm_w, w_uk, w_uv, rel_bias):
    f32 = jnp.float32
    bsz, L, _ = u.shape
    q, c_kv, q_idx, k_idx, w_idx = jnp.split(
        u, [C_Q, C_Q + C_KV_RANK, C_Q + C_KV_RANK + I_HEADS * I_DIM, C_Q + C_KV_RANK + I_HEADS * I_DIM + I_DIM], axis=-1)
    c_kv = rmsnorm(c_kv, kv_norm_w)
    k = (c_kv @ w_uk).astype(f32)
    v = (c_kv @ w_uv).astype(f32)
    k_idx = k_idx.astype(f32)
    n_blk = L // Q_BLOCK
    top_k = min(TOPK_MAX, L // 4)

    def to_blocks(t):
        return jnp.moveaxis(t.reshape((bsz, n_blk, Q_BLOCK) + t.shape[2:]), 1, 0)

    qb_all = to_blocks(q.astype(f32).reshape(bsz, L, C_HEADS, C_HEADDIM))
    qi_all = to_blocks(q_idx.astype(f32).reshape(bsz, L, I_HEADS, I_DIM))
    wi_all = to_blocks(w_idx.astype(f32) * I_HEADS ** -0.5)
    starts = jnp.arange(n_blk, dtype=jnp.int32) * Q_BLOCK
    key_pos = jnp.arange(L, dtype=jnp.int32)
    bias_table = rel_bias.astype(f32)
    gather = jax.vmap(lambda table, idx: table[idx])

    def block(args):
        qb, qib, wib, start = args
        qpos = start + jnp.arange(Q_BLOCK, dtype=jnp.int32)
        idx_logits = jnp.einsum('bqhd,bsd->bqhs', qib, k_idx) * I_DIM ** -0.5
        score = jnp.einsum('bqhs,bqh->bqs', jax.nn.relu(idx_logits), wib)
        score = jnp.where(key_pos[None, None, :] <= qpos[None, :, None], score, -jnp.inf)
        _, sel = lax.top_k(score, top_k)
        k_sel = gather(k, sel)
        v_sel = gather(v, sel)
        dist = qpos[None, :, None] - sel
        bias = jnp.moveaxis(bias_table[t5_bucket(dist)], -1, 2)
        logits = jnp.einsum('bqhd,bqkd->bqhk', qb, k_sel) * C_HEADDIM ** -0.5 + bias
        logits = jnp.where((dist >= 0)[:, :, None, :], logits, -jnp.inf)
        p = jax.nn.softmax(logits, axis=-1)
        return jnp.einsum('bqhk,bqkd->bqhd', p, v_sel)

    out = lax.map(block, (qb_all, qi_all, wi_all, starts))
    return jnp.moveaxis(out, 0, 1).reshape(bsz, L, W_GROUP)


def _cplx_affine_combine(e1, e2):
    a1r, a1i, b1r, b1i = e1
    a2r, a2i, b2r, b2i = e2
    return (a1r * a2r - a1i * a2i, a1r * a2i + a1i * a2r,
            a2r * b1r - a2i * b1i + b2r, a2r * b1i + a2i * b1r + b2i)


def s5_group(u, a_re, a_im, b_re, b_im, c_re, c_im, d_skip, log_dt, glu_w, glu_b):
    f32 = jnp.float32
    bsz, L, _ = u.shape
    uf = u.astype(f32).reshape(bsz, L, S_GROUPS, S_GROUP_CH)
    lam_re = jnp.minimum(a_re.astype(f32), -1e-4)
    lam_im = a_im.astype(f32)
    dt = jnp.exp(log_dt.astype(f32))[:, None]
    mag = jnp.exp(dt * lam_re)
    ab_re = mag * jnp.cos(dt * lam_im)
    ab_im = mag * jnp.sin(dt * lam_im)
    den = lam_re * lam_re + lam_im * lam_im
    f_re = ((ab_re - 1.0) * lam_re + ab_im * lam_im) / den
    f_im = (ab_im * lam_re - (ab_re - 1.0) * lam_im) / den
    b_re = b_re.astype(f32)
    b_im = b_im.astype(f32)
    bb_re = f_re[..., None] * b_re - f_im[..., None] * b_im
    bb_im = f_re[..., None] * b_im + f_im[..., None] * b_re
    bu_re = jnp.einsum('gnp,blgp->blgn', bb_re, uf)
    bu_im = jnp.einsum('gnp,blgp->blgn', bb_im, uf)
    a_re_t = jnp.broadcast_to(ab_re, bu_re.shape)
    a_im_t = jnp.broadcast_to(ab_im, bu_im.shape)
    _, _, h_re, h_im = lax.associative_scan(_cplx_affine_combine, (a_re_t, a_im_t, bu_re, bu_im), axis=1)
    y = jnp.einsum('gpn,blgn->blgp', c_re.astype(f32), h_re) - jnp.einsum('gpn,blgn->blgp', c_im.astype(f32), h_im)
    y = (y + d_skip.astype(f32).reshape(S_GROUPS, S_GROUP_CH) * uf).reshape(bsz, L, W_GROUP)
    y = jax.nn.gelu(y)
    gl = y @ glu_w.astype(f32) + glu_b.astype(f32)
    val, gate = jnp.split(gl, 2, axis=-1)
    return val * jax.nn.sigmoid(gate)


def hier_moe(h, wr_g, br_g, wr_e, br_e, w_gate, w_up, w_down):
    f32 = jnp.float32
    bsz, L, d = h.shape
    t = h.reshape(bsz * L, d)
    n_tok = bsz * L
    g_logits = (t @ wr_g).astype(f32) + br_g.astype(f32)
    g_prob = jax.nn.softmax(g_logits, axis=-1)
    g_sel = jnp.argmax(g_logits, axis=-1)
    g_gate = jnp.take_along_axis(g_prob, g_sel[:, None], axis=-1)
    e_logits = ((t @ wr_e).astype(f32) + br_e.astype(f32)).reshape(n_tok, E_GROUPS, E_PER_GROUP)
    e_logits = e_logits[jnp.arange(n_tok), g_sel]
    top_v, top_i = lax.top_k(e_logits, TOPK_INNER)
    top_w = jax.nn.softmax(top_v, axis=-1) * g_gate
    comb = jnp.einsum('tke,tk->te', jax.nn.one_hot(top_i, E_PER_GROUP, dtype=f32), top_w)
    out = jnp.zeros((n_tok, d), f32)
    for g in range(E_GROUPS):
        cw = comb * (g_sel == g).astype(f32)[:, None]
        hid = jax.nn.silu(jnp.einsum('td,edf->tef', t, w_gate[g])) * jnp.einsum('td,edf->tef', t, w_up[g])
        out = out + jnp.einsum('tef,efd->td', hid * cw[:, :, None], w_down[g])
    return out.reshape(bsz, L, d).astype(h.dtype)


def setup_inputs(seed: int = 0) -> dict:
    key = jax.random.key(seed)
    keys = iter(jax.random.split(key, 64))
    f32 = jnp.float32

    def nrm(shape, scale):
        return jax.random.normal(next(keys), shape, f32) * scale

    def uni(shape, lo, hi):
        return jax.random.uniform(next(keys), shape, f32, lo, hi)

    nl = DEPTH
    x = nrm((BATCH, SEQ, D_MODEL), 1.0)
    norm1_w = 1.0 + nrm((nl, D_MODEL), 0.02)
    w_in = nrm((nl, D_MODEL, N_IN), D_MODEL ** -0.5)
    m_conv_w = nrm((nl, M_CONV, M_CONV_CH), M_CONV ** -0.5)
    m_conv_b = nrm((nl, M_CONV_CH), 0.02)
    dt0 = jnp.exp(uni((nl, M_HEADS), math.log(1e-3), math.log(1e-1)))
    m_dt_bias = dt0 + jnp.log(-jnp.expm1(-dt0))
    m_a_log = jnp.log(uni((nl, M_HEADS), 1.0, 16.0))
    m_d = 1.0 + nrm((nl, M_HEADS), 0.02)
    m_norm_w = 1.0 + nrm((nl, W_GROUP), 0.02)
    r_mu = uni((nl, R_IN), 0.0, 1.0)
    ratio = (jnp.arange(W_GROUP, dtype=f32) / (W_GROUP - 1)) ** 0.9
    r_w0 = -6.0 + 5.0 * ratio + 0.5 + nrm((nl, W_GROUP), 0.05)
    r_w2 = nrm((nl, R_LORA_W, W_GROUP), 0.1)
    r_a0 = nrm((nl, W_GROUP), 0.1)
    r_a2 = nrm((nl, R_LORA_A, W_GROUP), R_LORA_A ** -0.5)
    r_g2 = nrm((nl, R_LORA_G, W_GROUP), R_LORA_G ** -0.5)
    r_k_k = 0.85 + nrm((nl, W_GROUP), 0.02)
    r_k_a = 1.0 + nrm((nl, W_GROUP), 0.02)
    r_r_k = nrm((nl, R_HEADS, R_HEADDIM), 0.1)
    r_ln_w = 1.0 + nrm((nl, W_GROUP), 0.02)
    r_ln_b = nrm((nl, W_GROUP), 0.02)
    c_kv_norm_w = 1.0 + nrm((nl, C_KV_RANK), 0.02)
    c_w_uk = nrm((nl, C_KV_RANK, C_HEADDIM), C_KV_RANK ** -0.5)
    c_w_uv = nrm((nl, C_KV_RANK, C_HEADDIM), C_KV_RANK ** -0.5)
    rel_bias = nrm((REL_BUCKETS, C_HEADS), 0.5)
    s_a_re = -0.5 + nrm((nl, S_GROUPS, S_STATE), 0.01)
    s_a_im = jnp.pi * jnp.arange(S_STATE, dtype=f32) + nrm((nl, S_GROUPS, S_STATE), 0.01)
    s_b_re = nrm((nl, S_GROUPS, S_STATE, S_GROUP_CH), (2 * S_GROUP_CH) ** -0.5)
    s_b_im = nrm((nl, S_GROUPS, S_STATE, S_GROUP_CH), (2 * S_GROUP_CH) ** -0.5)
    s_c_re = nrm((nl, S_GROUPS, S_GROUP_CH, S_STATE), S_STATE ** -0.5)
    s_c_im = nrm((nl, S_GROUPS, S_GROUP_CH, S_STATE), S_STATE ** -0.5)
    s_d = nrm((nl, W_GROUP), 1.0)
    s_log_dt = uni((nl, S_GROUPS), math.log(1e-3), math.log(1e-1))
    s_glu_w = nrm((nl, W_GROUP, 2 * W_GROUP), W_GROUP ** -0.5)
    s_glu_b = nrm((nl, 2 * W_GROUP), 0.02)
    w_out = nrm((nl, D_MIX, D_MODEL), D_MIX ** -0.5)
    norm2_w = 1.0 + nrm((nl, D_MODEL), 0.02)
    moe_wr_group = nrm((nl, D_MODEL, E_GROUPS), D_MODEL ** -0.5)
    moe_br_group = nrm((nl, E_GROUPS), 0.01)
    moe_wr_exp = nrm((nl, D_MODEL, E_GROUPS * E_PER_GROUP), D_MODEL ** -0.5)
    moe_br_exp = nrm((nl, E_GROUPS * E_PER_GROUP), 0.01)
    moe_w_gate = nrm((nl, E_GROUPS, E_PER_GROUP, D_MODEL, D_EXPERT), D_MODEL ** -0.5)
    moe_w_up = nrm((nl, E_GROUPS, E_PER_GROUP, D_MODEL, D_EXPERT), D_MODEL ** -0.5)
    moe_w_down = nrm((nl, E_GROUPS, E_PER_GROUP, D_EXPERT, D_MODEL), D_EXPERT ** -0.5)
    final_norm_w = 1.0 + nrm((D_MODEL,), 0.02)
    return {'x': x, 'norm1_w': norm1_w, 'w_in': w_in,
            'm_conv_w': m_conv_w, 'm_conv_b': m_conv_b, 'm_dt_bias': m_dt_bias, 'm_a_log': m_a_log,
            'm_d': m_d, 'm_norm_w': m_norm_w,
            'r_mu': r_mu, 'r_w0': r_w0, 'r_w2': r_w2, 'r_a0': r_a0, 'r_a2': r_a2, 'r_g2': r_g2,
            'r_k_k': r_k_k, 'r_k_a': r_k_a, 'r_r_k': r_r_k, 'r_ln_w': r_ln_w, 'r_ln_b': r_ln_b,
            'c_kv_norm_w': c_kv_norm_w, 'c_w_uk': c_w_uk, 'c_w_uv': c_w_uv, 'rel_bias': rel_bias,
            's_a_re': s_a_re, 's_a_im': s_a_im, 's_b_re': s_b_re, 's_b_im': s_b_im,
            's_c_re': s_c_re, 's_c_im': s_c_im, 's_d': s_d, 's_log_dt': s_log_dt,
            's_glu_w': s_glu_w, 's_glu_b': s_glu_b,
            'w_out': w_out, 'norm2_w': norm2_w,
            'moe_wr_group': moe_wr_group, 'moe_br_group': moe_br_group,
            'moe_wr_exp': moe_wr_exp, 'moe_br_exp': moe_br_exp,
            'moe_w_gate': moe_w_gate, 'moe_w_up': moe_w_up, 'moe_w_down': moe_w_down,
            'final_norm_w': final_norm_w}


def reference(x, norm1_w, w_in,
              m_conv_w, m_conv_b, m_dt_bias, m_a_log, m_d, m_norm_w,
              r_mu, r_w0, r_w2, r_a0, r_a2, r_g2, r_k_k, r_k_a, r_r_k, r_ln_w, r_ln_b,
              c_kv_norm_w, c_w_uk, c_w_uv, rel_bias,
              s_a_re, s_a_im, s_b_re, s_b_im, s_c_re, s_c_im, s_d, s_log_dt, s_glu_w, s_glu_b,
              w_out, norm2_w,
              moe_wr_group, moe_br_group, moe_wr_exp, moe_br_exp, moe_w_gate, moe_w_up, moe_w_down,
              final_norm_w):
    split_pts = [M_IN, M_IN + R_IN, M_IN + R_IN + C_IN]
    for i in range(DEPTH):
        h = rmsnorm(x, norm1_w[i])
        u = h @ w_in[i]
        u_m, u_r, u_c, u_s = jnp.split(u, split_pts, axis=-1)
        y_m = mamba2_group(u_m, m_conv_w[i], m_conv_b[i], m_dt_bias[i], m_a_log[i], m_d[i], m_norm_w[i])
        y_r = rwkv7_group(u_r, r_mu[i], r_w0[i], r_w2[i], r_a0[i], r_a2[i], r_g2[i],
                          r_k_k[i], r_k_a[i], r_r_k[i], r_ln_w[i], r_ln_b[i])
        y_c = dsa_group(u_c, c_kv_norm_w[i], c_w_uk[i], c_w_uv[i], rel_bias)
        y_s = s5_group(u_s, s_a_re[i], s_a_im[i], s_b_re[i], s_b_im[i], s_c_re[i], s_c_im[i],
                       s_d[i], s_log_dt[i], s_glu_w[i], s_glu_b[i])
        y = jnp.concatenate([y_m.astype(x.dtype), y_r.astype(x.dtype), y_c.astype(x.dtype), y_s.astype(x.dtype)], axis=-1)
        x = x + (y @ w_out[i]).astype(x.dtype)
        x = x + hier_moe(rmsnorm(x, norm2_w[i]), moe_wr_group[i], moe_br_group[i], moe_wr_exp[i], moe_br_exp[i],
                         moe_w_gate[i], moe_w_up[i], moe_w_down[i])
    return rmsnorm(x, final_norm_w)
```

```cpp
#include <hip/hip_runtime.h>
#include <stdint.h>
#include <stdio.h>

#define LAS __attribute__((address_space(3)))
typedef unsigned short bf16_t;
typedef short bf16x8 __attribute__((ext_vector_type(8)));
typedef float f32x4 __attribute__((ext_vector_type(4)));
typedef float f32x2 __attribute__((ext_vector_type(2)));
typedef float f32x16 __attribute__((ext_vector_type(16)));
typedef unsigned u32x4 __attribute__((ext_vector_type(4)));
typedef unsigned u32x2 __attribute__((ext_vector_type(2)));

constexpr int NTOK = 16384, DM = 1024, SEQ = 4096, NBATCH = 4, DEPTH = 2;
constexpr int NIN = 2604, NINP = 2816;
constexpr int UM = 0;
constexpr int UR = 784;
constexpr int UC = 1680;
constexpr int US = 2368;
constexpr int NTHR = 512;
constexpr int LDS_BYTES = 147456;
constexpr int MISC_OFF = LDS_BYTES - 256;

constexpr size_t WS_CTL   = 0;
constexpr size_t CTL_BYTES = 65536;
constexpr size_t WS_X     = WS_CTL + CTL_BYTES;
constexpr size_t WS_H     = WS_X + (size_t)NTOK * DM * 4;
constexpr size_t WS_U     = WS_H + (size_t)NTOK * DM * 2;
constexpr size_t WS_WIN   = WS_U + (size_t)NTOK * NINP * 2;
constexpr size_t WS_WOUT  = WS_WIN + (size_t)2 * NINP * DM * 2;
constexpr size_t WS_GLU   = WS_WOUT + (size_t)2 * DM * DM * 2;
constexpr size_t WS_MOE   = WS_GLU + (size_t)2 * 512 * 256 * 2;
constexpr size_t MOE_WGU  = 0;
constexpr size_t MOE_WD   = (size_t)32 * 512 * 1024 * 2;
constexpr size_t MOE_BYTES = MOE_WD + (size_t)32 * 1024 * 256 * 2;
constexpr size_t RW_PT    = 0;
constexpr size_t RW_U     = (size_t)1024 * 4096 * 2;
constexpr size_t RW_S     = RW_U + (size_t)1024 * 4096 * 4;
constexpr size_t YSG_OFF  = RW_S + (size_t)1024 * 4096 * 4;
static_assert(YSG_OFF + (size_t)NTOK * 256 * 2 <= MOE_BYTES, "alias");
constexpr size_t WS_MST   = WS_MOE + MOE_BYTES;
constexpr size_t WS_MDEC  = WS_MST + (size_t)4 * 64 * 4 * 4096 * 4;
constexpr size_t WS_S5ST  = WS_MDEC + 4096;
constexpr size_t WS_K     = WS_S5ST + (size_t)4 * 64 * 2048 * 4;
constexpr size_t WS_V     = WS_K + (size_t)NTOK * 64 * 2;
constexpr size_t WS_KIDX  = WS_V + (size_t)NTOK * 64 * 2;
constexpr size_t WS_ROUTE = WS_KIDX + (size_t)NTOK * 32 * 2;
constexpr size_t WS_ROWS  = WS_ROUTE + (size_t)NTOK * 32;
constexpr int    MAXROWS  = 49152;
constexpr size_t WS_TILES = WS_ROWS + (size_t)MAXROWS * 8;
constexpr size_t WS_S5TAB = WS_TILES + 4096;
constexpr size_t S5TAB_F  = (size_t)(2048 + 2048 + 32768) * 4;
constexpr size_t S5TAB_L  = S5TAB_F + (size_t)16 * 16 * 128 * 2;
constexpr size_t WS_END   = WS_S5TAB + 2 * S5TAB_L;

constexpr int CW_BAR = 0;
constexpr int CW_Q   = 4096;
constexpr int CW_CNT = 8192;

__device__ __forceinline__ float bf2f(bf16_t b) { return __uint_as_float(((unsigned)b) << 16); }
__device__ __forceinline__ bf16_t f2bf(float f) { unsigned u = __float_as_uint(f); u += 0x7FFFu + ((u >> 16) & 1u); return (bf16_t)(u >> 16); }
__device__ __forceinline__ unsigned pk2(float lo, float hi) { return (unsigned)f2bf(lo) | ((unsigned)f2bf(hi) << 16); }
__device__ __forceinline__ unsigned cvt_pk_bf16(float lo, float hi) { unsigned r; asm volatile("v_cvt_pk_bf16_f32 %0, %1, %2" : "=v"(r) : "v"(lo), "v"(hi)); return r; }
__device__ __forceinline__ float sigmoidf_(float x) { return 1.0f / (1.0f + __expf(-x)); }
__device__ __forceinline__ float siluf_(float x) { return x / (1.0f + __expf(-x)); }
__device__ __forceinline__ float tanhf_(float x) { const float e = __expf(2.0f * x); return 1.0f - 2.0f / (e + 1.0f); }
__device__ __forceinline__ float softplusf_(float x) { return fmaxf(x, 0.0f) + log1pf(__expf(-fabsf(x))); }
__device__ __forceinline__ float gelu_tanh(float x) { return 0.5f * x * (1.0f + tanhf_(0.7978845608028654f * (x + 0.044715f * x * x * x))); }
template <int CTRL> __device__ __forceinline__ float dppf(float x) { return __int_as_float(__builtin_amdgcn_update_dpp(0, __float_as_int(x), CTRL, 0xF, 0xF, true)); }
__device__ __forceinline__ float sum4(float x) { x += dppf<0xB1>(x); x += dppf<0x4E>(x); return x; }
__device__ __forceinline__ float sum8(float x) { x = sum4(x); x += dppf<0x141>(x); return x; }
__device__ __forceinline__ float sum16(float x) { x = sum8(x); x += dppf<0x140>(x); return x; }
__device__ __forceinline__ int lane_id_() { int l = (int)__builtin_amdgcn_mbcnt_hi(~0u, __builtin_amdgcn_mbcnt_lo(~0u, 0u)); asm volatile("" : "+v"(l)); return l; }
__device__ __forceinline__ float shx(float x, int o) { return __int_as_float(__builtin_amdgcn_ds_bpermute((lane_id_() ^ o) << 2, __float_as_int(x))); }
__device__ __forceinline__ unsigned shdown_u(unsigned x, int o) { return (unsigned)__builtin_amdgcn_ds_bpermute(((lane_id_() + o) & 63) << 2, (int)x); }
__device__ __forceinline__ int shidx_i(int x, int src) { return __builtin_amdgcn_ds_bpermute(src << 2, x); }
__device__ __forceinline__ float wave_sum(float x) { x = sum16(x); x += shx(x, 16); x += shx(x, 32); return x; }
__device__ __forceinline__ void unpack8(const u32x4 v, float (&f)[8]) {
    f[0] = __uint_as_float(v.x << 16); f[1] = __uint_as_float(v.x & 0xffff0000u); f[2] = __uint_as_float(v.y << 16); f[3] = __uint_as_float(v.y & 0xffff0000u);
    f[4] = __uint_as_float(v.z << 16); f[5] = __uint_as_float(v.z & 0xffff0000u); f[6] = __uint_as_float(v.w << 16); f[7] = __uint_as_float(v.w & 0xffff0000u);
}

#define XB_TMO      128
#define XB_XCNT(j)  (256  + 64 * (j))
#define XB_XSUB(j)  (1280 + 64 * (j))
#define XB_XGEN(j)  (2304 + 64 * (j))
#define XB_TOP      3328
#define XB_TOPGEN   3392
#define XCD_BAR_WORDS 3456
#define XB_SPIN_CAP (1u << 22)
__device__ __forceinline__ unsigned xb_ld(unsigned* p)              { return __hip_atomic_load(p, __ATOMIC_RELAXED, __HIP_MEMORY_SCOPE_AGENT); }
__device__ __forceinline__ unsigned xb_add(unsigned* p, unsigned v) { return __hip_atomic_fetch_add(p, v, __ATOMIC_RELAXED, __HIP_MEMORY_SCOPE_AGENT); }
__device__ __forceinline__ unsigned xb_xcc_id() { return (unsigned)__builtin_amdgcn_s_getreg((3 << 11) | 20) & 0xFu; }
#define XB_SPIN(cond, bar) do { unsigned _sp = 0; while (cond) { __builtin_amdgcn_s_sleep(1); \
    if ((++_sp & 255u) == 0u) { if (xb_ld(&(bar)[XB_TMO])) break; if (_sp > XB_SPIN_CAP) { atomicAdd(&(bar)[XB_TMO], 1u); break; } } } } while (0)
struct XcdBarrier { unsigned* bar; unsigned x; volatile LAS unsigned* st; };
__device__ __forceinline__ XcdBarrier xcd_barrier_post(unsigned* bar, volatile LAS unsigned* st) {
    XcdBarrier b; b.bar = bar; b.x = xb_xcc_id(); b.st = st;
    if (threadIdx.x == 0) (void)xb_add(&bar[XB_XCNT(b.x)], 1u);
    return b;
}
__device__ __forceinline__ void xcd_barrier_complete(unsigned* bar, unsigned x, unsigned& nloc, unsigned& nx) {
    const unsigned G = gridDim.x * gridDim.y * gridDim.z;
    unsigned sum, cnt, mine, sp = 0u;
    for (;;) {
        sum = 0u; cnt = 0u; mine = 0u;
#pragma unroll
        for (unsigned j = 0; j < 16; ++j) { const unsigned c = xb_ld(&bar[XB_XCNT(j)]); sum += c; cnt += (c > 0u) ? 1u : 0u; mine = (j == x) ? c : mine; }
        if (sum == G) break;
        __builtin_amdgcn_s_sleep(1);
        if ((++sp & 255u) == 0u) { if (xb_ld(&bar[XB_TMO])) break; if (sp > XB_SPIN_CAP) { atomicAdd(&bar[XB_TMO], 1u); break; } }
    }
    nloc = mine > 0u ? mine : 1u; nx = cnt > 0u ? cnt : 1u;
}
__device__ __forceinline__ void xcd_barrier(const XcdBarrier& b) {
    asm volatile("s_waitcnt vmcnt(0)" ::: "memory");
    __syncthreads();
    if (threadIdx.x == 0) {
        unsigned* bar = b.bar;
        __builtin_amdgcn_s_waitcnt(0);
        unsigned nloc = b.st[0], nx = b.st[1];
        if (nloc == 0u) { xcd_barrier_complete(bar, b.x, nloc, nx); b.st[0] = nloc; b.st[1] = nx; }
        const unsigned old = xb_add(&bar[XB_XSUB(b.x)], 1u);
        const unsigned gen = old / nloc;
        if (old + 1u == (gen + 1u) * nloc) {
            __builtin_amdgcn_fence(__ATOMIC_RELEASE, "agent");
            asm volatile("s_waitcnt vmcnt(0)" ::: "memory");
            const unsigned og = xb_add(&bar[XB_TOP], 1u);
            const unsigned tg = og / nx;
            if (og + 1u == (tg + 1u) * nx) xb_add(&bar[XB_TOPGEN], 1u);
            else XB_SPIN(xb_ld(&bar[XB_TOPGEN]) == tg, bar);
            __builtin_amdgcn_fence(__ATOMIC_ACQUIRE, "agent");
            xb_add(&bar[XB_XGEN(b.x)], 1u);
            asm volatile("s_waitcnt vmcnt(0)" ::: "memory");
        } else {
            XB_SPIN(xb_ld(&bar[XB_XGEN(b.x)]) == gen, bar);
            __builtin_amdgcn_fence(__ATOMIC_ACQUIRE, "agent");
            asm volatile("s_waitcnt vmcnt(0)" ::: "memory");
        }
    }
    __syncthreads();
}

namespace pg8 {
constexpr int BM = 256, BK = 64, HALF = 128, HTB = HALF * BK * 2, STAGE_BYTES = 8 * HTB, NXCD = 8, WGM = 8;
__host__ __device__ __forceinline__ int lds_byte(int r, int c) { const int st = (r >> 4) * 2 + (c >> 5), rr = r & 15, cc = c & 31, ob = rr * 64 + cc * 2; return st * 1024 + (ob ^ (((ob >> 9) & 1) << 5)); }
__host__ __device__ __forceinline__ void stage_rc(int b, int& R, int& C) { const int st = b / 1024, sb = b % 1024, swz = sb ^ (((sb >> 9) & 1) << 5); R = (st >> 1) * 16 + swz / 64; C = (st & 1) * 32 + (swz % 64) / 2; }
__host__ __device__ __forceinline__ int perm32(int rho) { const int n = rho >> 4, i = rho & 15; return 8 * (i >> 2) + 4 * n + (i & 3); }
struct Unit { int pm, pn; const char* a; const char* b; };

struct StaticOrder {
    int nM, nN, nwg, G, c, K; const char* A; const char* B;
    __device__ void init(const bf16_t* A_, const bf16_t* B_, int M, int N, int K_, int G_, int c_) { A = (const char*)A_; B = (const char*)B_; K = K_; nM = M / BM; nN = N / BM; nwg = nM * nN; G = G_; c = c_; }
    __device__ bool next(int i, Unit& u) const {
        const long L = (long)i * G + c; if (L >= nwg) return false;
        int wgid = (int)L; { const int q = nwg / NXCD, r = nwg % NXCD, xcd = wgid % NXCD, off = wgid / NXCD; wgid = (xcd < r ? xcd * (q + 1) : r * (q + 1) + (xcd - r) * q) + off; }
        const int nig = WGM * nN, gid = wgid / nig, fm = gid * WGM, gsz = (nM - fm) < WGM ? (nM - fm) : WGM;
        u.pm = fm + ((wgid % nig) % gsz); u.pn = (wgid % nig) / gsz;
        u.a = A + (size_t)u.pm * 256 * K * 2; u.b = B + (size_t)u.pn * 256 * K * 2; return true;
    }
};

template <class Epi, class Sched>
__device__ __forceinline__ void gemm_phase(LAS unsigned char* lds, const int K_, const Sched& S, const Epi& E) {
    int K = K_; asm volatile("" : "+s"(K));
    int tid_ = threadIdx.x; asm volatile("" : "+v"(tid_));
    const int tid = tid_, wid = __builtin_amdgcn_readfirstlane(tid >> 6), lane = tid & 63, wr = wid >> 2, wc = wid & 3, fr = lane & 15, fq = lane >> 4;
    const int nt = K / BK;
    unsigned voffA[2], voffB[2];
#pragma unroll
    for (int i = 0; i < 2; ++i) { int R, C; stage_rc(tid * 16 + i * 8192, R, C); const int Rb = Epi::PERM ? ((R & ~31) + perm32(R & 31)) : R;
        voffA[i] = (unsigned)(R * K + C) * 2u; voffB[i] = (unsigned)(Rb * K + C) * 2u; }
    const size_t kstep = (size_t)(BK * 2);
    const size_t hstep = (size_t)HALF * K * 2;
    const unsigned ldsw = (unsigned)wid * 1024u;
    const int aoff = lds_byte(wr * 64 + fr, fq * 8), boff = lds_byte(wc * 32 + fr, fq * 8);
#define PG8_SA(b, h) (((b) * 2 + (h)) * HTB)
#define PG8_SB(b, h) ((4 + (b) * 2 + (h)) * HTB)
#define PG8_STAGE(bufoff, gbase, voff) do { _Pragma("unroll") for (int _i = 0; _i < 2; ++_i) \
        __builtin_amdgcn_global_load_lds((const unsigned*)((const char*)(gbase) + (voff)[_i]), (LAS unsigned*)(lds + (bufoff) + ldsw + _i * 8192), 16, 0, 0); } while (0)
#define PG8_LDA(dst, b, h) do { _Pragma("unroll") for (int m = 0; m < 4; ++m) _Pragma("unroll") for (int k = 0; k < 2; ++k) dst[m][k] = *(const LAS bf16x8*)(lds + PG8_SA(b, h) + aoff + m * 2048 + k * 1024); } while (0)
#define PG8_LDB(dst, b, h) do { _Pragma("unroll") for (int n = 0; n < 2; ++n) _Pragma("unroll") for (int k = 0; k < 2; ++k) dst[n][k] = *(const LAS bf16x8*)(lds + PG8_SB(b, h) + boff + n * 2048 + k * 1024); } while (0)
#define PG8_MMA(ai, bj, At, Bt) do { __builtin_amdgcn_s_setprio(1); _Pragma("unroll") for (int m = 0; m < 4; ++m) _Pragma("unroll") for (int n = 0; n < 2; ++n) _Pragma("unroll") for (int k = 0; k < 2; ++k) \
        acc[ai][bj][m][n] = __builtin_amdgcn_mfma_f32_16x16x32_bf16(Bt[n][k], At[m][k], acc[ai][bj][m][n], 0, 0, 0); __builtin_amdgcn_s_setprio(0); } while (0)
#define PG8_WAIT_V(n) asm volatile("s_waitcnt vmcnt(" #n ")" ::: "memory")
#define PG8_WAIT_L(n) asm volatile("s_waitcnt lgkmcnt(" #n ")" ::: "memory")
#define PG8_BAR __builtin_amdgcn_s_barrier()
#define PG8_SCHED __builtin_amdgcn_sched_barrier(0)
    Unit cur, nxt; int ui = 0;
    if (!S.next(0, cur)) return;
    f32x4 acc[2][2][4][2];
#pragma unroll
    for (int a = 0; a < 2; ++a)
#pragma unroll
        for (int b = 0; b < 2; ++b)
#pragma unroll
            for (int m = 0; m < 4; ++m)
#pragma unroll
                for (int n = 0; n < 2; ++n) acc[a][b][m][n] = (f32x4){0.f, 0.f, 0.f, 0.f};
    bf16x8 At[4][2], B0[2][2], B1[2][2];
    const char* cA = cur.a; const char* cB = cur.b;
    PG8_STAGE(PG8_SB(0, 0), cB, voffB); PG8_STAGE(PG8_SA(0, 0), cA, voffA); PG8_STAGE(PG8_SB(0, 1), cB + hstep, voffB); PG8_STAGE(PG8_SA(0, 1), cA + hstep, voffA);
    if (wr == 1) PG8_BAR;
    PG8_WAIT_V(4); PG8_BAR;
    PG8_STAGE(PG8_SB(1, 0), cB + kstep, voffB); PG8_STAGE(PG8_SA(1, 0), cA + kstep, voffA); PG8_STAGE(PG8_SB(1, 1), cB + hstep + kstep, voffB);
    PG8_WAIT_V(6); PG8_BAR;
    for (;;) {
        const bool has_next = S.next(ui + 1, nxt);
        const char* nA = has_next ? nxt.a : cA; const char* nB = has_next ? nxt.b : cB;
        for (int t = 0; t < nt; t += 2) {
            const bool last = (t == nt - 2);
            const char* a1 = cA + (size_t)(t + 1) * kstep;
            const char* a2 = last ? nA : cA + (size_t)(t + 2) * kstep; const char* b2 = last ? nB : cB + (size_t)(t + 2) * kstep;
            const char* a3 = a2 + kstep; const char* b3 = b2 + kstep;
            PG8_LDB(B0, 0, 0); PG8_SCHED; PG8_LDA(At, 0, 0); PG8_STAGE(PG8_SA(1, 1), a1 + hstep, voffA);
            PG8_WAIT_L(8); PG8_BAR; PG8_WAIT_L(0); PG8_MMA(0, 0, At, B0); PG8_BAR; PG8_SCHED;
            PG8_LDB(B1, 0, 1); PG8_STAGE(PG8_SB(0, 0), b2, voffB);
            PG8_BAR; PG8_WAIT_L(0); PG8_MMA(0, 1, At, B1); PG8_BAR;
            PG8_LDA(At, 0, 1); PG8_STAGE(PG8_SA(0, 0), a2, voffA);
            PG8_BAR; PG8_WAIT_L(0); PG8_MMA(1, 0, At, B0); PG8_BAR; PG8_SCHED;
            PG8_STAGE(PG8_SB(0, 1), b2 + hstep, voffB);
            PG8_WAIT_V(6); PG8_BAR; PG8_MMA(1, 1, At, B1); PG8_BAR;
            PG8_LDB(B0, 1, 0); PG8_SCHED; PG8_LDA(At, 1, 0); PG8_STAGE(PG8_SA(0, 1), a2 + hstep, voffA);
            PG8_WAIT_L(8); PG8_BAR; PG8_WAIT_L(0); PG8_MMA(0, 0, At, B0); PG8_BAR; PG8_SCHED;
            PG8_LDB(B1, 1, 1); PG8_STAGE(PG8_SB(1, 0), b3, voffB);
            PG8_BAR; PG8_WAIT_L(0); PG8_MMA(0, 1, At, B1); PG8_BAR;
            PG8_LDA(At, 1, 1); PG8_STAGE(PG8_SA(1, 0), a3, voffA);
            PG8_BAR; PG8_WAIT_L(0); PG8_MMA(1, 0, At, B0); PG8_BAR; PG8_SCHED;
            PG8_STAGE(PG8_SB(1, 1), b3 + hstep, voffB);
            PG8_WAIT_V(6); PG8_BAR; PG8_MMA(1, 1, At, B1); PG8_BAR;
        }
        E(acc, cur, wr, wc, fr, fq);
        if (!has_next) break;
#pragma unroll
        for (int a = 0; a < 2; ++a)
#pragma unroll
            for (int b = 0; b < 2; ++b)
#pragma unroll
                for (int m = 0; m < 4; ++m)
#pragma unroll
                    for (int n = 0; n < 2; ++n) acc[a][b][m][n] = (f32x4){0.f, 0.f, 0.f, 0.f};
        cur = nxt; cA = nA; cB = nB; ++ui;
    }
    PG8_WAIT_V(0);
    if (wr == 0) PG8_BAR;
    PG8_BAR;
#undef PG8_SA
#undef PG8_SB
#undef PG8_STAGE
#undef PG8_LDA
#undef PG8_LDB
#undef PG8_MMA
#undef PG8_WAIT_V
#undef PG8_WAIT_L
#undef PG8_BAR
#undef PG8_SCHED
}

struct EpiBf16 {
    static constexpr bool PERM = true;
    bf16_t* O; int ldc;
    __device__ __forceinline__ void operator()(const f32x4 (&acc)[2][2][4][2], const Unit& u, int wr, int wc, int fr, int fq) const {
        const int row0 = u.pm * BM + wr * 64 + fr, col0 = u.pn * BM + wc * 32 + 8 * fq;
#pragma unroll
        for (int ai = 0; ai < 2; ++ai)
#pragma unroll
            for (int m = 0; m < 4; ++m) { bf16_t* rowp = O + (size_t)(row0 + ai * HALF + m * 16) * ldc + col0;
#pragma unroll
                for (int bj = 0; bj < 2; ++bj) { const f32x4 v0 = acc[ai][bj][m][0], v1 = acc[ai][bj][m][1];
                    u32x4 w; w.x = cvt_pk_bf16(v0[0], v0[1]); w.y = cvt_pk_bf16(v0[2], v0[3]); w.z = cvt_pk_bf16(v1[0], v1[1]); w.w = cvt_pk_bf16(v1[2], v1[3]);
                    *(u32x4*)(rowp + bj * HALF) = w; } }
    }
};
struct EpiResid {
    static constexpr bool PERM = false;
    float* C; int ldc;
    __device__ __forceinline__ void operator()(const f32x4 (&acc)[2][2][4][2], const Unit& u, int wr, int wc, int fr, int fq) const {
        const int row0 = u.pm * BM + wr * 64 + fr, col0 = u.pn * BM + wc * 32 + 4 * fq;
#pragma unroll
        for (int ai = 0; ai < 2; ++ai)
#pragma unroll
            for (int m = 0; m < 4; ++m) { float* rowp = C + (size_t)(row0 + ai * HALF + m * 16) * ldc + col0;
#pragma unroll
                for (int bj = 0; bj < 2; ++bj)
#pragma unroll
                    for (int n = 0; n < 2; ++n) { f32x4* p = (f32x4*)(rowp + bj * HALF + n * 16); *p = *p + acc[ai][bj][m][n]; } }
    }
};
template <int ACT  > struct EpiGated {
    static constexpr bool PERM = true;
    bf16_t* O; int ldo; int coloff; const float* ba; const float* bb;
    __device__ __forceinline__ void operator()(const f32x4 (&acc)[2][2][4][2], const Unit& u, int wr, int wc, int fr, int fq) const {
        const int row0 = u.pm * BM + wr * 64 + fr, cl = u.pn * HALF + wc * 32 + 8 * fq;
        float va[8], vb[8];
#pragma unroll
        for (int j = 0; j < 8; ++j) { va[j] = (ACT == 0) ? ba[cl + j] : 0.f; vb[j] = (ACT == 0) ? bb[cl + j] : 0.f; }
#pragma unroll
        for (int ai = 0; ai < 2; ++ai)
#pragma unroll
            for (int m = 0; m < 4; ++m) { bf16_t* rowp = O + (size_t)(row0 + ai * HALF + m * 16) * ldo + coloff + cl;
                float o[8];
#pragma unroll
                for (int n = 0; n < 2; ++n)
#pragma unroll
                    for (int j = 0; j < 4; ++j) { const float a = acc[ai][0][m][n][j] + va[4 * n + j], b = acc[ai][1][m][n][j] + vb[4 * n + j];
                        o[4 * n + j] = (ACT == 0) ? a * sigmoidf_(b) : siluf_(a) * b; }
                u32x4 w; w.x = cvt_pk_bf16(o[0], o[1]); w.y = cvt_pk_bf16(o[2], o[3]); w.z = cvt_pk_bf16(o[4], o[5]); w.w = cvt_pk_bf16(o[6], o[7]);
                *(u32x4*)rowp = w; asm volatile("" ::: "memory"); }
    }
};
struct EpiMoeOut {
    static constexpr bool PERM = true;
    bf16_t* O; const int* row_tok; const float* row_w;
    __device__ __forceinline__ void operator()(const f32x4 (&acc)[2][2][4][2], const Unit& u, int wr, int wc, int fr, int fq) const {
        const int row0 = u.pm * BM + wr * 64 + fr, col0 = u.pn * BM + wc * 32 + 8 * fq;
#pragma unroll
        for (int ai = 0; ai < 2; ++ai)
#pragma unroll
            for (int m = 0; m < 4; ++m) { const int row = row0 + ai * HALF + m * 16; const int ts = row_tok[row]; const float w = row_w[row];
                if (ts >= 0) { bf16_t* rowp = O + ((size_t)(ts & 1) * NTOK + (size_t)(ts >> 1)) * DM + col0;
#pragma unroll
                    for (int bj = 0; bj < 2; ++bj) { const f32x4 v0 = acc[ai][bj][m][0] * w, v1 = acc[ai][bj][m][1] * w;
                        u32x4 q; q.x = cvt_pk_bf16(v0[0], v0[1]); q.y = cvt_pk_bf16(v0[2], v0[3]); q.z = cvt_pk_bf16(v1[0], v1[1]); q.w = cvt_pk_bf16(v1[2], v1[3]);
                        *(u32x4*)(rowp + bj * HALF) = q; } } asm volatile("" ::: "memory"); }
    }
};
struct MoeOrder {
    int nN, G, c, K; const char* A; const char* B; size_t bstride; const int* tiles;
    __device__ bool next(int i, Unit& u) const {
        const int nrt = tiles[0]; const long L = (long)i * G + c; if (L >= (long)nrt * nN) return false;
        u.pm = (int)(L / nN); u.pn = (int)(L % nN); const int e = tiles[64 + u.pm];
        u.a = A + (size_t)u.pm * 256 * K * 2; u.b = B + (size_t)e * bstride + (size_t)u.pn * 256 * K * 2; return true;
    }
};
}

struct Params { const float* in[44]; float* out; unsigned char* ws; int ph_lo, ph_hi; };
enum { I_X = 0, I_NORM1, I_WIN, I_MCONVW, I_MCONVB, I_MDTB, I_MALOG, I_MD, I_MNORM, I_RMU, I_RW0, I_RW2, I_RA0, I_RA2, I_RG2, I_RKK, I_RKA, I_RRK, I_RLNW, I_RLNB,
       I_CKVN, I_CWUK, I_CWUV, I_RELB, I_SARE, I_SAIM, I_SBRE, I_SBIM, I_SCRE, I_SCIM, I_SD, I_SLOGDT, I_SGLUW, I_SGLUB, I_WOUT, I_NORM2, I_WRG, I_BRG, I_WRE, I_BRE,
       I_WGATE, I_WUP, I_WDOWN, I_FNORM };

struct Frame {
    LAS unsigned char* lds; int tid, lane, wave, bid, G;
    const float* const* in; float* out; unsigned char* ws; unsigned* ctl;
    volatile LAS int* misc;
};

__device__ __forceinline__ int q_pop(Frame& F, int qi) {
    __syncthreads();
    if (F.tid == 0) F.misc[0] = (int)__hip_atomic_fetch_add(F.ctl + CW_Q + 64 * qi, 1u, __ATOMIC_RELAXED, __HIP_MEMORY_SCOPE_AGENT);
    __syncthreads();
    return F.misc[0];
}

__device__ __forceinline__ const void* opaque_ptr(const void* p) { const unsigned long long v = (unsigned long long)p; unsigned lo = __builtin_amdgcn_readfirstlane((unsigned)v), hi = __builtin_amdgcn_readfirstlane((unsigned)(v >> 32));
    asm volatile("" : "+s"(lo), "+s"(hi)); return (const void*)(((unsigned long long)hi << 32) | lo); }
__device__ __forceinline__ Frame relocal(const Frame& G) { Frame F = G; asm volatile("" : "+v"(F.tid)); F.ws = (unsigned char*)opaque_ptr(F.ws); F.ctl = (unsigned*)(F.ws + WS_CTL); F.lane = F.tid & 63; F.wave = __builtin_amdgcn_readfirstlane(F.tid >> 6); return F; }
template <int K> __device__ __forceinline__ f32x4 mma_nt(const LAS bf16_t* A, int lda, const LAS bf16_t* Bt, int ldb, f32x4 acc, int lane) {
    const int r = lane & 15, g = lane >> 4;
#pragma unroll
    for (int k0 = 0; k0 < K; k0 += 32) {
        const bf16x8 a = *(const LAS bf16x8*)(A + r * lda + k0 + 8 * g);
        const bf16x8 b = *(const LAS bf16x8*)(Bt + r * ldb + k0 + 8 * g);
        acc = __builtin_amdgcn_mfma_f32_16x16x32_bf16(a, b, acc, 0, 0, 0);
    }
    return acc;
}

template <class ColMap> __device__ __forceinline__ void tr_tile(Frame& F, const float* src, int ldsrc, bf16_t* dst, int K, int k0, int n0, ColMap cm) {
    LAS float* tile = (LAS float*)F.lds;
    __syncthreads();
    { const int kk = F.tid >> 4, n4 = (F.tid & 15) * 4;
#pragma unroll
      for (int ps = 0; ps < 2; ++ps) { const int k = kk + 32 * ps; const int sc = cm(n0 + n4);
          f32x4 v = (f32x4){0.f, 0.f, 0.f, 0.f}; if (sc >= 0) v = *(const f32x4*)(src + (size_t)(k0 + k) * ldsrc + sc);
          tile[k * 65 + n4 + 0] = v[0]; tile[k * 65 + n4 + 1] = v[1]; tile[k * 65 + n4 + 2] = v[2]; tile[k * 65 + n4 + 3] = v[3]; } }
    __syncthreads();
    { const int n = F.tid >> 3, kc = F.tid & 7; float f[8];
#pragma unroll
      for (int j = 0; j < 8; ++j) f[j] = tile[(8 * kc + j) * 65 + n];
      u32x4 w; w.x = pk2(f[0], f[1]); w.y = pk2(f[2], f[3]); w.z = pk2(f[4], f[5]); w.w = pk2(f[6], f[7]);
      *(u32x4*)(dst + (size_t)(n0 + n) * K + k0 + 8 * kc) = w; }
}

struct CmIn { __device__ __forceinline__ int operator()(int n) const {
    if (n < 772) return n; if (n < UR) return -1; if (n < UR + 896) return 772 + (n - UR); if (n < UC) return -1;
    if (n < UC + 680) return 1668 + (n - UC); if (n < US) return -1; if (n < US + 256) return 2348 + (n - US); return -1; } };
struct CmId { __device__ __forceinline__ int operator()(int n) const { return n; } };
struct CmGlu { __device__ __forceinline__ int operator()(int n) const { const int pn = n >> 8, rr = n & 255; return rr < 128 ? 128 * pn + rr : 256 + 128 * pn + (rr - 128); } };
struct CmGateUp { int half; __device__ __forceinline__ int operator()(int n) const { return n; } };

__device__ __forceinline__ void phase_prologue(const Frame& F_) { Frame F = relocal(F_);
    for (int t = F.bid; t < 1984; t += F.G) {
        if (t < 1408) { const int l = t / 704, r = t % 704, kt = r / 44, nt = r % 44;
            tr_tile(F, F.in[I_WIN] + (size_t)l * DM * NIN, NIN, (bf16_t*)(F.ws + WS_WIN) + (size_t)l * NINP * DM, DM, kt * 64, nt * 64, CmIn()); }
        else if (t < 1920) { const int q = t - 1408, l = q / 256, r = q % 256, kt = r / 16, nt = r % 16;
            tr_tile(F, F.in[I_WOUT] + (size_t)l * DM * DM, DM, (bf16_t*)(F.ws + WS_WOUT) + (size_t)l * DM * DM, DM, kt * 64, nt * 64, CmId()); }
        else { const int q = t - 1920, l = q / 32, r = q % 32, kt = r / 8, nt = r % 8;
            tr_tile(F, F.in[I_SGLUW] + (size_t)l * 256 * 512, 512, (bf16_t*)(F.ws + WS_GLU) + (size_t)l * 512 * 256, 256, kt * 64, nt * 64, CmGlu()); }
    }
    for (int i = F.bid * NTHR + F.tid; i < 2048 + 65536; i += F.G * NTHR) {
        if (i < 2048) {
            const int l = i >> 10, gn = i & 1023, g = gn >> 6;
            float* tab = (float*)(F.ws + WS_S5TAB + (size_t)l * S5TAB_L);
            const float lre = fminf(F.in[I_SARE][l * 1024 + gn], -1e-4f), lim = F.in[I_SAIM][l * 1024 + gn];
            const float dt = expf(F.in[I_SLOGDT][l * 16 + g]);
            const float mag = expf(dt * lre); float sn, cs; sincosf(dt * lim, &sn, &cs);
            const float are = mag * cs, aim = mag * sn;
            const float den = lre * lre + lim * lim;
            const float fre = ((are - 1.0f) * lre + aim * lim) / den, fim = (aim * lre - (are - 1.0f) * lim) / den;
            tab[gn * 2] = are; tab[gn * 2 + 1] = aim;
            float pr = are, pi = aim;
#pragma unroll
            for (int s = 0; s < 6; ++s) { const float nr = pr * pr - pi * pi, ni = 2.0f * pr * pi; pr = nr; pi = ni; }
            tab[2048 + gn * 2] = pr; tab[2048 + gn * 2 + 1] = pi;
            const float* bre = F.in[I_SBRE] + ((size_t)l * 1024 + gn) * 16; const float* bim = F.in[I_SBIM] + ((size_t)l * 1024 + gn) * 16;
            for (int p = 0; p < 16; ++p) { tab[4096 + (gn * 16 + p) * 2] = fre * bre[p] - fim * bim[p]; tab[4096 + (gn * 16 + p) * 2 + 1] = fre * bim[p] + fim * bre[p]; }
        } else {
            const int j = i - 2048, l = j >> 15, r = j & 32767, gp = r >> 7, k = r & 127;
            bf16_t* cm = (bf16_t*)(F.ws + WS_S5TAB + (size_t)l * S5TAB_L + S5TAB_F);
            const float v = k < 64 ? F.in[I_SCRE][((size_t)l * 256 + gp) * 64 + k] : -F.in[I_SCIM][((size_t)l * 256 + gp) * 64 + (k - 64)];
            cm[r] = f2bf(v);
        }
    }
}

__device__ __forceinline__ void phase_norm(const Frame& F_, const float* xin, bool add_o, const float* w, int mode) { Frame F = relocal(F_);
    float* X = (float*)(F.ws + WS_X); bf16_t* H = (bf16_t*)(F.ws + WS_H); const bf16_t* O = (const bf16_t*)(F.ws + WS_U);
    for (int row = F.bid * 8 + F.wave; row < NTOK; row += F.G * 8) {
        f32x4 v[4]; float ss = 0.f;
#pragma unroll
        for (int j = 0; j < 4; ++j) { const int c = 4 * F.lane + 256 * j; v[j] = *(const f32x4*)(xin + (size_t)row * DM + c);
            if (add_o) { const u32x2 a = *(const u32x2*)(O + (size_t)row * DM + c), b = *(const u32x2*)(O + ((size_t)NTOK + row) * DM + c);
                v[j][0] += __uint_as_float(a.x << 16) + __uint_as_float(b.x << 16); v[j][1] += __uint_as_float(a.x & 0xffff0000u) + __uint_as_float(b.x & 0xffff0000u);
                v[j][2] += __uint_as_float(a.y << 16) + __uint_as_float(b.y << 16); v[j][3] += __uint_as_float(a.y & 0xffff0000u) + __uint_as_float(b.y & 0xffff0000u); }
            ss += v[j][0] * v[j][0] + v[j][1] * v[j][1] + v[j][2] * v[j][2] + v[j][3] * v[j][3]; }
        ss = wave_sum(ss);
        const float rstd = rsqrtf(ss * (1.0f / DM) + 1e-6f);
#pragma unroll
        for (int j = 0; j < 4; ++j) { const int c = 4 * F.lane + 256 * j; const f32x4 wv = *(const f32x4*)(w + c);
            if (mode == 2) { *(f32x4*)(F.out + (size_t)row * DM + c) = v[j] * rstd * wv; }
            else { *(f32x4*)(X + (size_t)row * DM + c) = v[j];
                u32x2 o; o.x = pk2(v[j][0] * rstd * wv[0], v[j][1] * rstd * wv[1]); o.y = pk2(v[j][2] * rstd * wv[2], v[j][3] * rstd * wv[3]);
                *(u32x2*)(H + (size_t)row * DM + c) = o; } }
    }
}

__device__ __forceinline__ void item_kv(const Frame& F_, int layer, int item) { Frame F = relocal(F_);
    const bf16_t* U = (const bf16_t*)(F.ws + WS_U);
    LAS bf16_t* Ab = (LAS bf16_t*)F.lds;
    LAS bf16_t* Bt = (LAS bf16_t*)(F.lds + 17408);
    const int t0 = item * 64;
    { const int tok = F.tid >> 3, part = F.tid & 7; const bf16_t* src = U + (size_t)(t0 + tok) * NINP + UC + 256 + 16 * part;
      float f[16]; { float a[8], b[8]; unpack8(*(const u32x4*)src, a); unpack8(*(const u32x4*)(src + 8), b);
#pragma unroll
        for (int j = 0; j < 8; ++j) { f[j] = a[j]; f[8 + j] = b[j]; } }
      float ss = 0.f;
#pragma unroll
      for (int j = 0; j < 16; ++j) ss += f[j] * f[j];
      ss = sum8(ss);
      const float rstd = rsqrtf(ss * (1.0f / 128.0f) + 1e-6f); const float* nw = F.in[I_CKVN] + layer * 128 + 16 * part;
#pragma unroll
      for (int j = 0; j < 16; j += 2) *(LAS unsigned*)(Ab + tok * 136 + 16 * part + j) = pk2(f[j] * rstd * nw[j], f[j + 1] * rstd * nw[j + 1]); }
    { const int n = F.tid >> 2, kq = F.tid & 3; const float* w = (n < 64 ? F.in[I_CWUK] : F.in[I_CWUV]) + (size_t)layer * 128 * 64 + (n & 63);
#pragma unroll 4
      for (int k = 32 * kq; k < 32 * kq + 32; ++k) Bt[n * 136 + k] = f2bf(w[(size_t)k * 64]); }
    if (F.tid < 256) { const int tok = F.tid >> 2, q = F.tid & 3;
        *(u32x4*)((bf16_t*)(F.ws + WS_KIDX) + (size_t)(t0 + tok) * 32 + 8 * q) = *(const u32x4*)(U + (size_t)(t0 + tok) * NINP + UC + 640 + 8 * q); }
    __syncthreads();
    const int mt = F.wave & 3, g = F.lane >> 4, r = F.lane & 15;
#pragma unroll
    for (int q = 0; q < 4; ++q) { const int nt = (F.wave >> 2) * 4 + q;
        f32x4 acc = (f32x4){0.f, 0.f, 0.f, 0.f};
        acc = mma_nt<128>(Ab + mt * 16 * 136, 136, Bt + nt * 16 * 136, 136, acc, F.lane);
        const int n = nt * 16 + r; bf16_t* dst = (bf16_t*)(F.ws + (n < 64 ? WS_K : WS_V));
#pragma unroll
        for (int i = 0; i < 4; ++i) dst[(size_t)(t0 + mt * 16 + 4 * g + i) * 64 + (n & 63)] = f2bf(acc[i]); }
}

constexpr int MB_CG = 0, MB_BG = 18432, MB_BT = 36864, MB_XT = 55296, MB_M = 92160, MB_S0 = 101376, MB_DT = 110592, MB_AC = 111616, MB_RS = 112640;
template <int STAGE> __device__ __forceinline__ void item_mamba(const Frame& F_, int layer, int item) { Frame F = relocal(F_);
    const bf16_t* U = (const bf16_t*)(F.ws + WS_U);
    const int b = item >> 6, c = item & 63, l0 = c * 64; const size_t T0 = (size_t)b * SEQ + l0;
    LAS bf16_t* Cg = (LAS bf16_t*)(F.lds + MB_CG); LAS bf16_t* Bg = (LAS bf16_t*)(F.lds + MB_BG); LAS bf16_t* BT = (LAS bf16_t*)(F.lds + MB_BT);
    LAS bf16_t* XT = (LAS bf16_t*)(F.lds + MB_XT); LAS bf16_t* Mb = (LAS bf16_t*)(F.lds + MB_M); LAS bf16_t* S0 = (LAS bf16_t*)(F.lds + MB_S0);
    LAS float* dts = (LAS float*)(F.lds + MB_DT); LAS float* acs = (LAS float*)(F.lds + MB_AC); LAS float* rs = (LAS float*)(F.lds + MB_RS);
    if (F.tid < 256) { const int l = F.tid >> 2, h = F.tid & 3;
        const float raw = bf2f(U[(T0 + l) * NINP + UM + 768 + h]) + F.in[I_MDTB][layer * 4 + h];
        const float dt = softplusf_(raw); dts[l * 4 + h] = dt; acs[l * 4 + h] = -__expf(F.in[I_MALOG][layer * 4 + h]) * dt; }
    if (F.tid < 64) rs[F.tid] = 0.f;
    __syncthreads();
    float mycum = 0.f;
    if (F.tid < 256) { const int l = F.tid >> 2, h = F.tid & 3; for (int s = 0; s <= l; ++s) mycum += acs[s * 4 + h]; }
    __syncthreads();
    if (F.tid < 256) acs[F.tid] = mycum;
    __syncthreads();
    { const int ch8 = F.tid & 63, tg = F.tid >> 6, c0 = ch8 * 8;
      float wv[4][8], bv[8];
#pragma unroll
      for (int j = 0; j < 8; ++j) { bv[j] = F.in[I_MCONVB][layer * 512 + c0 + j];
#pragma unroll
          for (int k = 0; k < 4; ++k) wv[k][j] = F.in[I_MCONVW][(layer * 4 + k) * 512 + c0 + j]; }
      float win[3][8];
#pragma unroll
      for (int k = 0; k < 3; ++k) { const int l = l0 + tg * 8 - 3 + k;
          if (l >= 0) unpack8(*(const u32x4*)(U + ((size_t)b * SEQ + l) * NINP + UM + 256 + c0), win[k]);
          else {
#pragma unroll
              for (int j = 0; j < 8; ++j) win[k][j] = 0.f; } }
#pragma unroll 1
      for (int i = 0; i < 8; ++i) { const int l = tg * 8 + i; float cur[8]; unpack8(*(const u32x4*)(U + (T0 + l) * NINP + UM + 256 + c0), cur);
          float o[8];
#pragma unroll
          for (int j = 0; j < 8; ++j) { o[j] = siluf_(bv[j] + wv[0][j] * win[0][j] + wv[1][j] * win[1][j] + wv[2][j] * win[2][j] + wv[3][j] * cur[j]);
              win[0][j] = win[1][j]; win[1][j] = win[2][j]; win[2][j] = cur[j]; }
          if (c0 < 256) { const int h = c0 >> 6, p0 = c0 & 63; float sc = dts[l * 4 + h]; if (STAGE == 1) sc *= __expf(acs[63 * 4 + h] - acs[l * 4 + h]);
#pragma unroll
              for (int j = 0; j < 8; ++j) XT[(h * 64 + p0 + j) * 72 + l] = f2bf(o[j] * sc); }
          else if (c0 < 384) { const int g = (c0 - 256) >> 6, n0 = (c0 - 256) & 63;
              if (STAGE == 1) {
#pragma unroll
                  for (int j = 0; j < 8; ++j) BT[(g * 64 + n0 + j) * 72 + l] = f2bf(o[j]); }
              else { u32x4 w; w.x = pk2(o[0], o[1]); w.y = pk2(o[2], o[3]); w.z = pk2(o[4], o[5]); w.w = pk2(o[6], o[7]); *(LAS u32x4*)(Bg + (g * 64 + l) * 72 + n0) = w; } }
          else if (STAGE == 2) { const int g = (c0 - 384) >> 6, n0 = (c0 - 384) & 63;
              u32x4 w; w.x = pk2(o[0], o[1]); w.y = pk2(o[2], o[3]); w.z = pk2(o[4], o[5]); w.w = pk2(o[6], o[7]); *(LAS u32x4*)(Cg + (g * 64 + l) * 72 + n0) = w; } } }
    __syncthreads();
    const int g4 = F.lane >> 4, r16 = F.lane & 15;
    if (STAGE == 1) {
        float* MST = (float*)(F.ws + WS_MST) + ((size_t)(b * 64 + c) * 4) * 4096;
#pragma unroll
        for (int q = 0; q < 8; ++q) { const int tix = F.wave * 8 + q, h = tix >> 4, mt = (tix >> 2) & 3, nt = tix & 3;
            f32x4 acc = (f32x4){0.f, 0.f, 0.f, 0.f};
            acc = mma_nt<64>(XT + (h * 64 + mt * 16) * 72, 72, BT + ((h >> 1) * 64 + nt * 16) * 72, 72, acc, F.lane);
#pragma unroll
            for (int i = 0; i < 4; ++i) MST[(size_t)h * 4096 + (mt * 16 + 4 * g4 + i) * 64 + nt * 16 + r16] = acc[i]; }
        if (F.tid < 4) ((float*)(F.ws + WS_MDEC))[(b * 64 + c) * 4 + F.tid] = __expf(acs[63 * 4 + F.tid]);
    } else {
        const int mt = F.wave & 3, nh = F.wave >> 2;
        const float* MST = (const float*)(F.ws + WS_MST) + ((size_t)(b * 64 + c) * 4) * 4096;
        f32x4 G[2], yv[4][2];
#pragma unroll
        for (int h = 0; h < 4; ++h) {
            const int g = h >> 1;
            { const float* src = MST + (size_t)h * 4096 + F.tid * 8; const f32x4 a = *(const f32x4*)src, bq = *(const f32x4*)(src + 4);
              u32x4 w; w.x = pk2(a[0], a[1]); w.y = pk2(a[2], a[3]); w.z = pk2(bq[0], bq[1]); w.w = pk2(bq[2], bq[3]);
              *(LAS u32x4*)(S0 + (F.tid >> 3) * 72 + (F.tid & 7) * 8) = w; }
            if ((h & 1) == 0) {
#pragma unroll
                for (int q = 0; q < 2; ++q) { G[q] = (f32x4){0.f, 0.f, 0.f, 0.f};
                    G[q] = mma_nt<64>(Cg + (g * 64 + mt * 16) * 72, 72, Bg + (g * 64 + (2 * nh + q) * 16) * 72, 72, G[q], F.lane); } }
#pragma unroll
            for (int q = 0; q < 2; ++q) { const int s = (2 * nh + q) * 16 + r16; const float as = acs[s * 4 + h];
#pragma unroll
                for (int i = 0; i < 4; ++i) { const int l = mt * 16 + 4 * g4 + i; const float v = (s <= l) ? G[q][i] * __expf(acs[l * 4 + h] - as) : 0.f;
                    Mb[l * 72 + s] = f2bf(v); } }
            __syncthreads();
#pragma unroll
            for (int q = 0; q < 2; ++q) { const int nt = 2 * nh + q;
                f32x4 yd = (f32x4){0.f, 0.f, 0.f, 0.f}, yo = (f32x4){0.f, 0.f, 0.f, 0.f};
                yd = mma_nt<64>(Mb + mt * 16 * 72, 72, XT + (h * 64 + nt * 16) * 72, 72, yd, F.lane);
                yo = mma_nt<64>(Cg + (g * 64 + mt * 16) * 72, 72, S0 + nt * 16 * 72, 72, yo, F.lane);
                const int p = nt * 16 + r16; const float dsk = F.in[I_MD][layer * 4 + h];
#pragma unroll
                for (int i = 0; i < 4; ++i) { const int l = mt * 16 + 4 * g4 + i;
                    const float xs = bf2f(XT[(h * 64 + p) * 72 + l]) / dts[l * 4 + h];
                    yv[h][q][i] = yd[i] + yo[i] * __expf(acs[l * 4 + h]) + dsk * xs; } }
            __syncthreads();
        }
        float part[4] = {0.f, 0.f, 0.f, 0.f};
#pragma unroll
        for (int h = 0; h < 4; ++h)
#pragma unroll
            for (int q = 0; q < 2; ++q) { const int ch = h * 64 + (2 * nh + q) * 16 + r16;
#pragma unroll
                for (int i = 0; i < 4; ++i) { const int l = mt * 16 + 4 * g4 + i; const float z = bf2f(U[(T0 + l) * NINP + UM + ch]);
                    const float v = yv[h][q][i] * siluf_(z); yv[h][q][i] = v; part[i] += v * v; } }
#pragma unroll
        for (int i = 0; i < 4; ++i) { const float s = sum16(part[i]); if (r16 == 0) atomicAdd((float*)(rs + mt * 16 + 4 * g4 + i), s); }
        __syncthreads();
        bf16_t* Y = (bf16_t*)(F.ws + WS_H);
#pragma unroll
        for (int i = 0; i < 4; ++i) { const int l = mt * 16 + 4 * g4 + i; const float rstd = rsqrtf(rs[l] * (1.0f / 256.0f) + 1e-6f);
#pragma unroll
            for (int h = 0; h < 4; ++h)
#pragma unroll
                for (int q = 0; q < 2; ++q) { const int ch = h * 64 + (2 * nh + q) * 16 + r16;
                    Y[(T0 + l) * DM + ch] = f2bf(yv[h][q][i] * rstd * F.in[I_MNORM][layer * 256 + ch]); } }
    }
}
__device__ __forceinline__ void item_mamba_carry(const Frame& F_, int item) { Frame F = relocal(F_);
    const int b = item >> 2, h = item & 3;
    float* MST = (float*)(F.ws + WS_MST); const float* MD = (const float*)(F.ws + WS_MDEC);
    float s[8];
#pragma unroll
    for (int j = 0; j < 8; ++j) s[j] = 0.f;
    for (int c = 0; c < 64; ++c) { float* p = MST + ((size_t)(b * 64 + c) * 4 + h) * 4096 + F.tid * 8; const float d = MD[(b * 64 + c) * 4 + h];
        const f32x4 a = *(f32x4*)p, q = *(f32x4*)(p + 4);
        *(f32x4*)p = (f32x4){s[0], s[1], s[2], s[3]}; *(f32x4*)(p + 4) = (f32x4){s[4], s[5], s[6], s[7]};
        s[0] = s[0] * d + a[0]; s[1] = s[1] * d + a[1]; s[2] = s[2] * d + a[2]; s[3] = s[3] * d + a[3];
        s[4] = s[4] * d + q[0]; s[5] = s[5] * d + q[1]; s[6] = s[6] * d + q[2]; s[7] = s[7] * d + q[3]; }
}

template <int STAGE> __device__ __forceinline__ void item_s5(const Frame& F_, int layer, int item) { Frame F = relocal(F_);
    const bf16_t* U = (const bf16_t*)(F.ws + WS_U);
    const int b = item >> 6, c = item & 63; const size_t T0 = (size_t)b * SEQ + c * 64;
    LAS float* us = (LAS float*)F.lds; LAS bf16_t* Hs = (LAS bf16_t*)(F.lds + 65536);
    const float* tab = (const float*)(F.ws + WS_S5TAB + (size_t)layer * S5TAB_L);
    { const int tok = F.tid >> 3, part = F.tid & 7;
#pragma unroll
      for (int q = 0; q < 4; ++q) { float f[8]; unpack8(*(const u32x4*)(U + (T0 + tok) * NINP + US + 32 * part + 8 * q), f);
          *(LAS f32x4*)(us + tok * 256 + 32 * part + 8 * q) = (f32x4){f[0], f[1], f[2], f[3]}; *(LAS f32x4*)(us + tok * 256 + 32 * part + 8 * q + 4) = (f32x4){f[4], f[5], f[6], f[7]}; } }
    const int g = F.tid >> 5, n0 = F.tid & 31, gn0 = g * 64 + n0, gn1 = gn0 + 32;
    float bb0[32], bb1[32];
#pragma unroll
    for (int j = 0; j < 32; j += 4) { const f32x4 a = *(const f32x4*)(tab + 4096 + gn0 * 32 + j), bq = *(const f32x4*)(tab + 4096 + gn1 * 32 + j);
        bb0[j] = a[0]; bb0[j + 1] = a[1]; bb0[j + 2] = a[2]; bb0[j + 3] = a[3]; bb1[j] = bq[0]; bb1[j + 1] = bq[1]; bb1[j + 2] = bq[2]; bb1[j + 3] = bq[3]; }
    const float a0r = tab[gn0 * 2], a0i = tab[gn0 * 2 + 1], a1r = tab[gn1 * 2], a1i = tab[gn1 * 2 + 1];
    float* ST = (float*)(F.ws + WS_S5ST) + (size_t)(b * 64 + c) * 2048;
    float h0r = 0.f, h0i = 0.f, h1r = 0.f, h1i = 0.f;
    if (STAGE == 2) { h0r = ST[gn0 * 2]; h0i = ST[gn0 * 2 + 1]; h1r = ST[gn1 * 2]; h1i = ST[gn1 * 2 + 1]; }
    bf16x8 cf[2][4];
    if (STAGE == 2) { const bf16_t* cm = (const bf16_t*)(F.ws + WS_S5TAB + (size_t)layer * S5TAB_L + S5TAB_F);
#pragma unroll
        for (int gg = 0; gg < 2; ++gg)
#pragma unroll
            for (int ks = 0; ks < 4; ++ks) cf[gg][ks] = *(const bf16x8*)(cm + ((size_t)((2 * F.wave + gg) * 16 + (F.lane & 15))) * 128 + 32 * ks + 8 * (F.lane >> 4)); }
    __syncthreads();
    for (int lb = 0; lb < 4; ++lb) {
        for (int li = 0; li < 16; ++li) { const int l = lb * 16 + li;
            float uu[16];
#pragma unroll
            for (int q = 0; q < 4; ++q) { const f32x4 v = *(const LAS f32x4*)(us + l * 256 + g * 16 + 4 * q); uu[4 * q] = v[0]; uu[4 * q + 1] = v[1]; uu[4 * q + 2] = v[2]; uu[4 * q + 3] = v[3]; }
            float b0r = 0.f, b0i = 0.f, b1r = 0.f, b1i = 0.f;
#pragma unroll
            for (int p = 0; p < 16; ++p) { b0r += bb0[2 * p] * uu[p]; b0i += bb0[2 * p + 1] * uu[p]; b1r += bb1[2 * p] * uu[p]; b1i += bb1[2 * p + 1] * uu[p]; }
            { const float nr = a0r * h0r - a0i * h0i + b0r, ni = a0r * h0i + a0i * h0r + b0i; h0r = nr; h0i = ni; }
            { const float nr = a1r * h1r - a1i * h1i + b1r, ni = a1r * h1i + a1i * h1r + b1i; h1r = nr; h1i = ni; }
            if (STAGE == 2) { LAS bf16_t* hp = Hs + li * 2056 + g * 128; hp[n0] = f2bf(h0r); hp[64 + n0] = f2bf(h0i); hp[n0 + 32] = f2bf(h1r); hp[96 + n0] = f2bf(h1i); }
        }
        if (STAGE == 2) {
            __syncthreads();
            bf16_t* YS = (bf16_t*)(F.ws + WS_MOE + YSG_OFF);
#pragma unroll
            for (int gg = 0; gg < 2; ++gg) { const int gq = 2 * F.wave + gg; f32x4 acc = (f32x4){0.f, 0.f, 0.f, 0.f};
#pragma unroll
                for (int ks = 0; ks < 4; ++ks) { const bf16x8 a = *(const LAS bf16x8*)(Hs + (F.lane & 15) * 2056 + gq * 128 + 32 * ks + 8 * (F.lane >> 4));
                    acc = __builtin_amdgcn_mfma_f32_16x16x32_bf16(a, cf[gg][ks], acc, 0, 0, 0); }
                const int ch = gq * 16 + (F.lane & 15); const float dsk = F.in[I_SD][layer * 256 + ch];
#pragma unroll
                for (int i = 0; i < 4; ++i) { const int l = lb * 16 + 4 * (F.lane >> 4) + i; const float y = acc[i] + dsk * us[l * 256 + ch];
                    YS[(T0 + l) * 256 + ch] = f2bf(gelu_tanh(y)); } }
            __syncthreads();
        }
    }
    if (STAGE == 1) { ST[gn0 * 2] = h0r; ST[gn0 * 2 + 1] = h0i; ST[gn1 * 2] = h1r; ST[gn1 * 2 + 1] = h1i; }
}
__device__ __forceinline__ void item_s5_carry(const Frame& F_, int layer, int b) { Frame F = relocal(F_);
    const float* tab = (const float*)(F.ws + WS_S5TAB + (size_t)layer * S5TAB_L) + 2048;
    float* ST = (float*)(F.ws + WS_S5ST) + (size_t)b * 64 * 2048;
#pragma unroll
    for (int q = 0; q < 2; ++q) { const int gn = F.tid + 512 * q; const float pr = tab[gn * 2], pi = tab[gn * 2 + 1]; float hr = 0.f, hi = 0.f;
        for (int c = 0; c < 64; ++c) { float* p = ST + (size_t)c * 2048 + gn * 2; const float tr = p[0], ti = p[1]; p[0] = hr; p[1] = hi;
            const float nr = pr * hr - pi * hi + tr, ni = pr * hi + pi * hr + ti; hr = nr; hi = ni; } }
}

constexpr int RW_R = 0, RW_K = 16384, RW_V = 32768, RW_W = 49152, RW_A = 65536, RW_B = 81920, RW_TW = 98304, RW_DA = 106496, RW_O = 98304, RW_SG = 114688, RW_BON = 131072;
template <int STAGE> __device__ __forceinline__ void rwkv_prep(const Frame& F_, int layer, int b, int h, int c) { Frame F = relocal(F_);
    const bf16_t* U = (const bf16_t*)(F.ws + WS_U);
    const int l0 = c * 64; const size_t T0 = (size_t)b * SEQ + l0;
    LAS float* Rr = (LAS float*)(F.lds + RW_R); LAS float* Kk = (LAS float*)(F.lds + RW_K); LAS float* Vv = (LAS float*)(F.lds + RW_V); LAS float* Ww = (LAS float*)(F.lds + RW_W);
    LAS float* Aa = (LAS float*)(F.lds + RW_A); LAS float* Bb = (LAS float*)(F.lds + RW_B); LAS float* TW = (LAS float*)(F.lds + RW_TW); LAS float* DA = (LAS float*)(F.lds + RW_DA);
    LAS float* SG = (LAS float*)(F.lds + RW_SG); LAS float* BON = (LAS float*)(F.lds + RW_BON);
    const float* mu = F.in[I_RMU] + layer * 896;
    { const int tok = F.tid >> 3, p8 = F.tid & 7; const bool first = (l0 + tok == 0);
      const bf16_t* cur = U + (T0 + tok) * NINP + UR; const bf16_t* prv = cur - NINP;
#pragma unroll
      for (int sec = 0; sec < 3; ++sec) { const int co = sec * 256 + h * 64 + 8 * p8; float a[8], pq[8]; unpack8(*(const u32x4*)(cur + co), a);
          if (first) {
#pragma unroll
              for (int j = 0; j < 8; ++j) pq[j] = 0.f; } else unpack8(*(const u32x4*)(prv + co), pq);
          LAS float* dst = (sec == 0 ? Rr : sec == 1 ? Kk : Vv) + tok * 64 + 8 * p8;
#pragma unroll
          for (int j = 0; j < 8; ++j) dst[j] = a[j] + mu[co + j] * (pq[j] - a[j]); }
#pragma unroll
      for (int q = 0; q < 2; ++q) { const int co = 768 + 16 * p8 + 8 * q; float a[8], pq[8]; unpack8(*(const u32x4*)(cur + co), a);
          if (first) {
#pragma unroll
              for (int j = 0; j < 8; ++j) pq[j] = 0.f; } else unpack8(*(const u32x4*)(prv + co), pq);
#pragma unroll
          for (int j = 0; j < 8; ++j) { const float s = a[j] + mu[co + j] * (pq[j] - a[j]); const int cc = co - 768 + j;
              if (cc < 32) TW[tok * 32 + cc] = tanhf_(s); else if (cc < 64) DA[tok * 32 + cc - 32] = s; else SG[tok * 64 + cc - 64] = sigmoidf_(s); } } }
    __syncthreads();
    { const int j = F.lane, tq = F.wave, ch = h * 64 + j;
      float w2c[32], a2c[32];
#pragma unroll
      for (int i = 0; i < 32; ++i) { w2c[i] = F.in[I_RW2][((size_t)layer * 32 + i) * 256 + ch]; a2c[i] = F.in[I_RA2][((size_t)layer * 32 + i) * 256 + ch]; }
      const float w0 = F.in[I_RW0][layer * 256 + ch], a0 = F.in[I_RA0][layer * 256 + ch], kkw = F.in[I_RKK][layer * 256 + ch], kaw = F.in[I_RKA][layer * 256 + ch], rk = F.in[I_RRK][layer * 256 + ch];
      for (int i8 = 0; i8 < 8; ++i8) { const int t = tq + 8 * i8;
          float wl = w0, al = a0;
#pragma unroll
          for (int i = 0; i < 32; i += 4) { const f32x4 tv = *(const LAS f32x4*)(TW + t * 32 + i), dv = *(const LAS f32x4*)(DA + t * 32 + i);
              wl += tv[0] * w2c[i] + tv[1] * w2c[i + 1] + tv[2] * w2c[i + 2] + tv[3] * w2c[i + 3]; al += dv[0] * a2c[i] + dv[1] * a2c[i + 1] + dv[2] * a2c[i + 2] + dv[3] * a2c[i + 3]; }
          const float wlog = -softplusf_(-wl) - 0.5f; const float dec = __expf(-__expf(wlog)); const float a = sigmoidf_(al);
          const float kraw = Kk[t * 64 + j]; const float kkv = kraw * kkw; const float ss = wave_sum(kkv * kkv);
          const float kkn = kkv * rsqrtf(fmaxf(ss, 1e-24f)); const float kp = kraw * (1.0f + (a - 1.0f) * kaw);
          Ww[t * 64 + j] = dec; Kk[t * 64 + j] = kp; Aa[t * 64 + j] = -kkn; Bb[t * 64 + j] = kkn * a;
          if (STAGE == 3) { const float bo = wave_sum(Rr[t * 64 + j] * kp * rk); if (j == 0) BON[t] = bo; } } }
    __syncthreads();
}
__device__ __forceinline__ void item_rwkv1(const Frame& F_, int layer, int item) { Frame F = relocal(F_);
    const int b = item >> 8, h = (item >> 6) & 3, c = item & 63;
    rwkv_prep<1>(F, layer, b, h, c);
    LAS float* Kk = (LAS float*)(F.lds + RW_K); LAS float* Vv = (LAS float*)(F.lds + RW_V); LAS float* Ww = (LAS float*)(F.lds + RW_W);
    LAS float* Aa = (LAS float*)(F.lds + RW_A); LAS float* Bb = (LAS float*)(F.lds + RW_B);
    const int row = F.tid >> 2, part = F.tid & 3; const bool isU = row < 64;
    float S[16];
#pragma unroll
    for (int e = 0; e < 16; ++e) S[e] = (!isU && (16 * part + e == row - 64)) ? 1.0f : 0.0f;
    for (int t = 0; t < 64; ++t) {
        float a[16], bq[16], w[16], k[16];
#pragma unroll
        for (int q = 0; q < 4; ++q) { const f32x4 va = *(const LAS f32x4*)(Aa + t * 64 + 16 * part + 4 * q), vb = *(const LAS f32x4*)(Bb + t * 64 + 16 * part + 4 * q),
                                                  vw = *(const LAS f32x4*)(Ww + t * 64 + 16 * part + 4 * q), vk = *(const LAS f32x4*)(Kk + t * 64 + 16 * part + 4 * q);
#pragma unroll
            for (int j = 0; j < 4; ++j) { a[4 * q + j] = va[j]; bq[4 * q + j] = vb[j]; w[4 * q + j] = vw[j]; k[4 * q + j] = vk[j]; } }
        const float vr = isU ? Vv[t * 64 + row] : 0.0f;
        float sa = 0.f;
#pragma unroll
        for (int e = 0; e < 16; ++e) sa += S[e] * a[e];
        sa = sum4(sa);
#pragma unroll
        for (int e = 0; e < 16; ++e) S[e] = S[e] * w[e] + sa * bq[e] + vr * k[e];
    }
    const size_t ci = (size_t)(b * 4 + h) * 64 + c;
    if (isU) { float* dst = (float*)(F.ws + WS_MOE + RW_U) + ci * 4096 + row * 64 + 16 * part;
#pragma unroll
        for (int q = 0; q < 4; ++q) *(f32x4*)(dst + 4 * q) = (f32x4){S[4 * q], S[4 * q + 1], S[4 * q + 2], S[4 * q + 3]}; }
    else { const int i = row - 64; const int pos = 32 * (i >> 5) + 8 * ((i >> 2) & 3) + 4 * ((i >> 4) & 1) + (i & 3);
        bf16_t* dst = (bf16_t*)(F.ws + WS_MOE + RW_PT) + ci * 4096 + pos;
#pragma unroll
        for (int e = 0; e < 16; ++e) dst[(16 * part + e) * 64] = f2bf(S[e]); }
}
__device__ __forceinline__ void item_rwkv_carry(const Frame& F_, int item) { Frame F = relocal(F_);
    const int bh = item * 2 + (F.wave >> 2), nt = F.wave & 3, r = F.lane & 15, g = F.lane >> 4;
    const bf16_t* PT = (const bf16_t*)(F.ws + WS_MOE + RW_PT); const float* Uc = (const float*)(F.ws + WS_MOE + RW_U); float* Ss = (float*)(F.ws + WS_MOE + RW_S);
    f32x4 acc[4];
#pragma unroll
    for (int m = 0; m < 4; ++m) acc[m] = (f32x4){0.f, 0.f, 0.f, 0.f};
    for (int c = 0; c < 64; ++c) { const size_t ci = (size_t)bh * 64 + c;
        bf16x8 af[4][2]; f32x4 cin[4];
#pragma unroll
        for (int m = 0; m < 4; ++m) { cin[m] = *(const f32x4*)(Uc + ci * 4096 + (16 * nt + r) * 64 + 16 * m + 4 * g);
#pragma unroll
            for (int s = 0; s < 2; ++s) af[m][s] = *(const bf16x8*)(PT + ci * 4096 + (16 * m + r) * 64 + 32 * s + 8 * g); }
#pragma unroll
        for (int m = 0; m < 4; ++m) *(f32x4*)(Ss + ci * 4096 + (16 * nt + r) * 64 + 16 * m + 4 * g) = acc[m];
        bf16x8 bfr[2];
#pragma unroll
        for (int s = 0; s < 2; ++s) { u32x4 w; w.x = pk2(acc[2 * s][0], acc[2 * s][1]); w.y = pk2(acc[2 * s][2], acc[2 * s][3]); w.z = pk2(acc[2 * s + 1][0], acc[2 * s + 1][1]); w.w = pk2(acc[2 * s + 1][2], acc[2 * s + 1][3]);
            bfr[s] = __builtin_bit_cast(bf16x8, w); }
#pragma unroll
        for (int m = 0; m < 4; ++m) { acc[m] = __builtin_amdgcn_mfma_f32_16x16x32_bf16(af[m][0], bfr[0], cin[m], 0, 0, 0);
            acc[m] = __builtin_amdgcn_mfma_f32_16x16x32_bf16(af[m][1], bfr[1], acc[m], 0, 0, 0); }
    }
}
__device__ __forceinline__ void item_rwkv3(const Frame& F_, int layer, int item) { Frame F = relocal(F_);
    const int b = item >> 8, h = (item >> 6) & 3, c = item & 63; const size_t T0 = (size_t)b * SEQ + c * 64;
    rwkv_prep<3>(F, layer, b, h, c);
    LAS float* Rr = (LAS float*)(F.lds + RW_R); LAS float* Kk = (LAS float*)(F.lds + RW_K); LAS float* Vv = (LAS float*)(F.lds + RW_V); LAS float* Ww = (LAS float*)(F.lds + RW_W);
    LAS float* Aa = (LAS float*)(F.lds + RW_A); LAS float* Bb = (LAS float*)(F.lds + RW_B); LAS float* Oo = (LAS float*)(F.lds + RW_O);
    LAS float* SG = (LAS float*)(F.lds + RW_SG); LAS float* BON = (LAS float*)(F.lds + RW_BON);
    { const int row = F.tid >> 3, part = F.tid & 7; const size_t ci = (size_t)(b * 4 + h) * 64 + c;
      const float* sp = (const float*)(F.ws + WS_MOE + RW_S) + ci * 4096 + row * 64 + 8 * part;
      float S[8]; { const f32x4 x = *(const f32x4*)sp, y = *(const f32x4*)(sp + 4); S[0] = x[0]; S[1] = x[1]; S[2] = x[2]; S[3] = x[3]; S[4] = y[0]; S[5] = y[1]; S[6] = y[2]; S[7] = y[3]; }
      for (int t = 0; t < 64; ++t) {
          float a[8], bq[8], w[8], k[8], rr[8];
#pragma unroll
          for (int q = 0; q < 2; ++q) { const int o = t * 64 + 8 * part + 4 * q; const f32x4 va = *(const LAS f32x4*)(Aa + o), vb = *(const LAS f32x4*)(Bb + o), vw = *(const LAS f32x4*)(Ww + o), vk = *(const LAS f32x4*)(Kk + o), vr4 = *(const LAS f32x4*)(Rr + o);
#pragma unroll
              for (int j = 0; j < 4; ++j) { a[4 * q + j] = va[j]; bq[4 * q + j] = vb[j]; w[4 * q + j] = vw[j]; k[4 * q + j] = vk[j]; rr[4 * q + j] = vr4[j]; } }
          const float vr = Vv[t * 64 + row];
          float sa = 0.f;
#pragma unroll
          for (int e = 0; e < 8; ++e) sa += S[e] * a[e];
          sa = sum8(sa);
          float o = 0.f;
#pragma unroll
          for (int e = 0; e < 8; ++e) { S[e] = S[e] * w[e] + sa * bq[e] + vr * k[e]; o += S[e] * rr[e]; }
          o = sum8(o);
          if (part == 0) Oo[t * 64 + row] = o;
      } }
    __syncthreads();
    { const int j = F.lane, tq = F.wave, ch = h * 64 + j;
      float g2c[64];
#pragma unroll
      for (int i = 0; i < 64; ++i) g2c[i] = F.in[I_RG2][((size_t)layer * 64 + i) * 256 + ch];
      const float lw = F.in[I_RLNW][layer * 256 + ch], lb = F.in[I_RLNB][layer * 256 + ch];
      bf16_t* Y = (bf16_t*)(F.ws + WS_H);
      for (int i8 = 0; i8 < 8; ++i8) { const int t = tq + 8 * i8;
          const float o = Oo[t * 64 + j]; const float mean = wave_sum(o) * (1.0f / 64.0f); const float d = o - mean; const float var = wave_sum(d * d) * (1.0f / 64.0f);
          float on = d * rsqrtf(var + 64e-5f) * lw + lb; on += BON[t] * Vv[t * 64 + j];
          float gg = 0.f;
#pragma unroll
          for (int i = 0; i < 64; i += 4) { const f32x4 sv = *(const LAS f32x4*)(SG + t * 64 + i); gg += sv[0] * g2c[i] + sv[1] * g2c[i + 1] + sv[2] * g2c[i + 2] + sv[3] * g2c[i + 3]; }
          Y[(T0 + t) * DM + 256 + ch] = f2bf(on * gg); } }
}

constexpr int DS_SEL = 131072, DS_HIST = 135168, DS_BKT = 143360, DS_BIAS = 143872;
__device__ __forceinline__ unsigned fkey(float f) { const unsigned u = __float_as_uint(f); return (u & 0x80000000u) ? ~u : (u | 0x80000000u); }
__device__ __forceinline__ void item_dsa(const Frame& F_, int layer, int item) { Frame F = relocal(F_);
    const bf16_t* U = (const bf16_t*)(F.ws + WS_U); const bf16_t* KI = (const bf16_t*)(F.ws + WS_KIDX);
    const bf16_t* Kb = (const bf16_t*)(F.ws + WS_K); const bf16_t* Vb = (const bf16_t*)(F.ws + WS_V);
    const int b = item & 3, qg = 511 - (item >> 2); const size_t TB = (size_t)b * SEQ, T0 = TB + qg * 8;
    LAS float* sc = (LAS float*)F.lds; LAS unsigned short* selall = (LAS unsigned short*)(F.lds + DS_SEL); LAS unsigned* histall = (LAS unsigned*)(F.lds + DS_HIST);
    LAS int* bkt = (LAS int*)(F.lds + DS_BKT); LAS float* biasT = (LAS float*)(F.lds + DS_BIAS);
    if (F.tid < 128) { const int n = F.tid; int bk = n; if (n >= 16) { const float lr = logf((float)n / 16.0f) / 2.0794415416798357f; bk = 16 + (int)(lr * 16.0f); bk = bk < 31 ? bk : 31; } bkt[n] = bk; biasT[n] = F.in[I_RELB][n]; }
    const int lane = F.lane, hh = lane >> 5;
    {
        bf16x8 af[2][2]; float wq[2][2][8];
        { const int r = lane & 31, q4 = 2 * ((r >> 2) & 1) + (r >> 4), head = 4 * ((r >> 3) & 1) + (r & 3);
#pragma unroll
          for (int mt = 0; mt < 2; ++mt)
#pragma unroll
              for (int ks = 0; ks < 2; ++ks) af[mt][ks] = *(const bf16x8*)(U + (T0 + 4 * mt + q4) * NINP + UC + 384 + head * 32 + 16 * ks + 8 * hh); }
#pragma unroll
        for (int mt = 0; mt < 2; ++mt)
#pragma unroll
            for (int q2 = 0; q2 < 2; ++q2) { float f[8]; unpack8(*(const u32x4*)(U + (T0 + 4 * mt + 2 * hh + q2) * NINP + UC + 672), f);
#pragma unroll
                for (int hd = 0; hd < 8; ++hd) wq[mt][q2][hd] = f[hd]; }
        const int ntile = (qg * 8 + 8 + 31) >> 5;
        for (int kt = F.wave; kt < ntile; kt += 8) {
            const int key = kt * 32 + (lane & 31);
            const bf16x8 b0 = *(const bf16x8*)(KI + (TB + key) * 32 + 8 * hh), b1 = *(const bf16x8*)(KI + (TB + key) * 32 + 16 + 8 * hh);
#pragma unroll
            for (int mt = 0; mt < 2; ++mt) { f32x16 acc;
#pragma unroll
                for (int i = 0; i < 16; ++i) acc[i] = 0.f;
                acc = __builtin_amdgcn_mfma_f32_32x32x16_bf16(af[mt][0], b0, acc, 0, 0, 0);
                acc = __builtin_amdgcn_mfma_f32_32x32x16_bf16(af[mt][1], b1, acc, 0, 0, 0);
#pragma unroll
                for (int q2 = 0; q2 < 2; ++q2) { float s = 0.f;
#pragma unroll
                    for (int hd = 0; hd < 8; ++hd) s += fmaxf(acc[8 * q2 + hd], 0.f) * wq[mt][q2][hd];
                    const int qi = 4 * mt + 2 * hh + q2;
                    sc[qi * 4096 + key] = (key <= qg * 8 + qi) ? s : -INFINITY; } }
        }
    }
    __syncthreads();
    const int qi = F.wave, tq = qg * 8 + qi, n = tq + 1;
    LAS float* scq = sc + qi * 4096; LAS unsigned short* sel = selall + qi * 256; LAS unsigned* hist = histall + qi * 256;
    int nsel;
    if (n <= 256) { nsel = n; for (int j = lane; j < 256; j += 64) sel[j] = (unsigned short)(j < n ? j : 0); }
    else {
        nsel = 256;
        const int R = (n + 63) >> 6;
        unsigned prefix = 0u; int need = 256; unsigned neq = 0u;
        for (int p = 0; p < 4; ++p) { const int shift = 24 - 8 * p;
            *(LAS u32x4*)(hist + 4 * lane) = (u32x4){0u, 0u, 0u, 0u};
            for (int i = 0; i < R; ++i) { const int j = lane + 64 * i; if (j < n) { const unsigned u = fkey(scq[j]);
                if (p == 0 || (u >> (shift + 8)) == prefix) atomicAdd((unsigned*)(hist + ((u >> shift) & 255u)), 1u); } }
            const u32x4 hv = *(const LAS u32x4*)(hist + 4 * lane);
            const unsigned tot = hv.x + hv.y + hv.z + hv.w;
            unsigned incl = tot;
#pragma unroll
            for (int o = 1; o < 64; o <<= 1) { const unsigned t = shdown_u(incl, o); if (lane + o < 64) incl += t; }
            const unsigned above = incl - tot;
            int fb = -1; unsigned fabove = 0u, feq = 0u; unsigned cum = above;
            { const unsigned hq[4] = {hv.x, hv.y, hv.z, hv.w};
#pragma unroll
              for (int q = 3; q >= 0; --q) { if (fb < 0 && cum < (unsigned)need && (unsigned)need <= cum + hq[q]) { fb = 4 * lane + q; fabove = cum; feq = hq[q]; } cum += hq[q]; } }
            const unsigned long long m = __ballot(fb >= 0);
            const int src = (int)__ffsll((long long)m) - 1;
            const int bin = shidx_i(fb, src); const unsigned ab = (unsigned)shidx_i((int)fabove, src); neq = (unsigned)shidx_i((int)feq, src);
            need -= (int)ab; prefix = (prefix << 8) | (unsigned)bin;
        }
        const int ngt = 256 - need;
        int base_gt = 0, base_eq = 0;
        for (int i = 0; i < R; ++i) { const int j = lane + 64 * i; const unsigned u = (j < n) ? fkey(scq[j]) : 0u;
            const bool gt = (j < n) && (u > prefix), eq = (j < n) && (u == prefix);
            const unsigned long long mg = __ballot(gt), me = __ballot(eq); const unsigned long long lt = (1ull << lane) - 1ull;
            if (gt) sel[base_gt + __popcll(mg & lt)] = (unsigned short)j;
            if (eq) { const int rk = base_eq + __popcll(me & lt); if (rk < need) sel[ngt + rk] = (unsigned short)j; }
            base_gt += __popcll(mg); base_eq += __popcll(me); }
        (void)neq;
    }
    const int nt16 = (nsel + 15) >> 4, r16 = lane & 15, g4 = lane >> 4;
    bf16x8 qf[2];
#pragma unroll
    for (int s = 0; s < 2; ++s) { u32x4 z = (u32x4){0u, 0u, 0u, 0u}; if (r16 < 4) z = *(const u32x4*)(U + (T0 + qi) * NINP + UC + r16 * 64 + 32 * s + 8 * g4); qf[s] = __builtin_bit_cast(bf16x8, z); }
    float lg[16][4]; float mx = -INFINITY;
#pragma unroll
    for (int m = 0; m < 16; ++m) {
        if (m < nt16) {
            const int key = sel[16 * m + r16];
            const bf16x8 a0 = *(const bf16x8*)(Kb + (TB + key) * 64 + 8 * g4), a1 = *(const bf16x8*)(Kb + (TB + key) * 64 + 32 + 8 * g4);
            f32x4 acc = (f32x4){0.f, 0.f, 0.f, 0.f};
            acc = __builtin_amdgcn_mfma_f32_16x16x32_bf16(a0, qf[0], acc, 0, 0, 0);
            acc = __builtin_amdgcn_mfma_f32_16x16x32_bf16(a1, qf[1], acc, 0, 0, 0);
#pragma unroll
            for (int i = 0; i < 4; ++i) { const int j = 16 * m + 4 * g4 + i; const int kj = sel[j]; const int dist = tq - kj;
                const int bk = dist < 128 ? bkt[dist < 0 ? 0 : dist] : 31;
                const float v = (j < nsel) ? acc[i] * 0.125f + biasT[bk * 4 + (r16 & 3)] : -INFINITY;
                lg[m][i] = v; mx = fmaxf(mx, v); }
        } else {
#pragma unroll
            for (int i = 0; i < 4; ++i) lg[m][i] = -INFINITY;
        }
    }
    mx = fmaxf(mx, shx(mx, 16)); mx = fmaxf(mx, shx(mx, 32));
    float sm = 0.f;
    LAS float* Pw = scq;
#pragma unroll
    for (int m = 0; m < 16; ++m) { if (m < nt16) {
#pragma unroll
        for (int i = 0; i < 4; ++i) { const float p = __expf(lg[m][i] - mx); sm += p; if (r16 < 4) Pw[(16 * m + 4 * g4 + i) * 4 + r16] = p; } } }
    sm += shx(sm, 16); sm += shx(sm, 32);
    if (lane < 4) Pw[1024 + lane] = 1.0f / sm;
    const int kg = lane >> 3, dc = lane & 7;
    float o[4][8];
#pragma unroll
    for (int h = 0; h < 4; ++h)
#pragma unroll
        for (int d = 0; d < 8; ++d) o[h][d] = 0.f;
    for (int i = 0; i < 2 * nt16; ++i) { const int j = 8 * i + kg; const int key = sel[j];
        float vv[8]; unpack8(*(const u32x4*)(Vb + (TB + key) * 64 + 8 * dc), vv);
        const f32x4 p4 = *(const LAS f32x4*)(Pw + 4 * j);
#pragma unroll
        for (int h = 0; h < 4; ++h)
#pragma unroll
            for (int d = 0; d < 8; ++d) o[h][d] += p4[h] * vv[d]; }
#pragma unroll
    for (int h = 0; h < 4; ++h)
#pragma unroll
        for (int d = 0; d < 8; ++d) { float v = o[h][d]; v += shx(v, 8); v += shx(v, 16); v += shx(v, 32); o[h][d] = v; }
    if (kg == 0) { bf16_t* Y = (bf16_t*)(F.ws + WS_H) + (T0 + qi) * DM + 512 + 8 * dc;
#pragma unroll
        for (int h = 0; h < 4; ++h) { const float inv = Pw[1024 + h];
            u32x4 w; w.x = pk2(o[h][0] * inv, o[h][1] * inv); w.y = pk2(o[h][2] * inv, o[h][3] * inv); w.z = pk2(o[h][4] * inv, o[h][5] * inv); w.w = pk2(o[h][6] * inv, o[h][7] * inv);
            *(u32x4*)(Y + h * 64) = w; } }
}

__device__ __forceinline__ void phase_router(const Frame& F_, int layer) { Frame F = relocal(F_);
    const float* X = (const float*)(F.ws + WS_X); bf16_t* H2 = (bf16_t*)(F.ws + WS_H);
    const float* nw = F.in[I_NORM2] + (size_t)layer * DM; const float* WE = F.in[I_WRE] + (size_t)layer * DM * 32; const float* WG = F.in[I_WRG] + (size_t)layer * DM * 4;
    LAS float* lgs = (LAS float*)F.lds;
    LAS int* es = (LAS int*)(F.lds + 10240);
    LAS int* lr = (LAS int*)(F.lds + 10752);
    LAS float* wsl = (LAS float*)(F.lds + 11264);
    for (int blk = F.bid; blk < NTOK / 64; blk += F.G) {
        __syncthreads();
        const int tl = F.tid >> 3, og = F.tid & 7; const size_t t = (size_t)blk * 64 + tl; const float* xr = X + t * DM;
        float ss = 0.f;
#pragma unroll 8
        for (int c = 128 * og; c < 128 * og + 128; c += 4) { const f32x4 v = *(const f32x4*)(xr + c); ss += v[0] * v[0] + v[1] * v[1] + v[2] * v[2] + v[3] * v[3]; }
        ss = sum8(ss);
        const float rstd = rsqrtf(ss * (1.0f / DM) + 1e-6f);
        f32x4 ae = (f32x4){0.f, 0.f, 0.f, 0.f}; float ag = 0.f;
        for (int c = 0; c < DM; c += 4) { const f32x4 v = *(const f32x4*)(xr + c), wv = *(const f32x4*)(nw + c); const f32x4 hv = v * rstd * wv;
            if (((c >> 2) & 7) == og) { u32x2 o; o.x = pk2(hv[0], hv[1]); o.y = pk2(hv[2], hv[3]); *(u32x2*)(H2 + t * DM + c) = o; }
#pragma unroll
            for (int i = 0; i < 4; ++i) { const f32x4 w4 = *(const f32x4*)(WE + (size_t)(c + i) * 32 + 4 * og); ae += hv[i] * w4; ag += hv[i] * WG[(size_t)(c + i) * 4 + (og & 3)]; } }
#pragma unroll
        for (int i = 0; i < 4; ++i) lgs[tl * 40 + 4 * og + i] = ae[i] + F.in[I_BRE][layer * 32 + 4 * og + i];
        if (og < 4) lgs[tl * 40 + 32 + og] = ag + F.in[I_BRG][layer * 4 + og];
        __syncthreads();
        if (F.tid < 64) { LAS float* l = lgs + F.tid * 40;
            int gs = 0; float gm = l[32];
#pragma unroll
            for (int j = 1; j < 4; ++j) if (l[32 + j] > gm) { gm = l[32 + j]; gs = j; }
            float den = 0.f;
#pragma unroll
            for (int j = 0; j < 4; ++j) den += __expf(l[32 + j] - gm);
            const float gate = 1.0f / den;
            int i1 = 0; float v1 = l[gs * 8];
#pragma unroll
            for (int j = 1; j < 8; ++j) if (l[gs * 8 + j] > v1) { v1 = l[gs * 8 + j]; i1 = j; }
            int i2 = -1; float v2 = -INFINITY;
#pragma unroll
            for (int j = 0; j < 8; ++j) if (j != i1 && l[gs * 8 + j] > v2) { v2 = l[gs * 8 + j]; i2 = j; }
            const float e2 = __expf(v2 - v1); const float p1 = 1.0f / (1.0f + e2);
            es[F.tid * 2] = gs * 8 + i1; es[F.tid * 2 + 1] = gs * 8 + i2; wsl[F.tid * 2] = p1 * gate; wsl[F.tid * 2 + 1] = (1.0f - p1) * gate; }
        __syncthreads();
        if (F.tid < 32) { int cnt = 0; for (int i = 0; i < 128; ++i) if (es[i] == F.tid) lr[i] = cnt++;
            if (cnt) { const int base = (int)__hip_atomic_fetch_add(F.ctl + CW_CNT + layer * 32 + F.tid, (unsigned)cnt, __ATOMIC_RELAXED, __HIP_MEMORY_SCOPE_AGENT);
                for (int i = 0; i < 128; ++i) if (es[i] == F.tid) lr[i] += base; } }
        __syncthreads();
        if (F.tid < 64) { int* rt = (int*)(F.ws + WS_ROUTE) + ((size_t)blk * 64 + F.tid) * 8;
            rt[0] = es[F.tid * 2]; rt[1] = es[F.tid * 2 + 1]; ((float*)rt)[2] = wsl[F.tid * 2]; ((float*)rt)[3] = wsl[F.tid * 2 + 1]; rt[4] = lr[F.tid * 2]; rt[5] = lr[F.tid * 2 + 1]; }
    }
}
struct CmGU { __device__ __forceinline__ int operator()(int n) const { return 128 * (n >> 8) + (n & 127); } };
__device__ __forceinline__ void phase_moe_convert(const Frame& F_, int layer) { Frame F = relocal(F_);
    bf16_t* WGU = (bf16_t*)(F.ws + WS_MOE + MOE_WGU); bf16_t* WD = (bf16_t*)(F.ws + WS_MOE + MOE_WD);
    for (int t = F.bid; t < 6144; t += F.G) {
        if (t < 4096) { const int e = t >> 7, r = t & 127, kt = r >> 3, nt = r & 7; const bool up = ((nt * 64) & 255) >= 128;
            const float* src = (up ? F.in[I_WUP] : F.in[I_WGATE]) + ((size_t)layer * 32 + e) * 1024 * 256;
            tr_tile(F, src, 256, WGU + (size_t)e * 512 * 1024, 1024, kt * 64, nt * 64, CmGU()); }
        else { const int q = t - 4096, e = q >> 6, r = q & 63, kt = r >> 4, nt = r & 15;
            tr_tile(F, F.in[I_WDOWN] + ((size_t)layer * 32 + e) * 256 * 1024, 1024, WD + (size_t)e * 1024 * 256, 256, kt * 64, nt * 64, CmId()); }
    }
}
__device__ __forceinline__ void phase_gather(const Frame& F_, int layer) { Frame F = relocal(F_);
    LAS int* off = (LAS int*)F.lds;
    __syncthreads();
    if (F.tid == 0) { int acc = 0; for (int e = 0; e < 32; ++e) { off[e] = acc; const int c = (int)__hip_atomic_load(F.ctl + CW_CNT + layer * 32 + e, __ATOMIC_RELAXED, __HIP_MEMORY_SCOPE_AGENT); acc += (c + 255) & ~255; } off[32] = acc; }
    __syncthreads();
    int* tiles = (int*)(F.ws + WS_TILES); int* row_tok = (int*)(F.ws + WS_ROWS); float* row_w = (float*)(F.ws + WS_ROWS) + MAXROWS;
    if (F.bid == 0) { if (F.tid == 0) tiles[0] = off[32] >> 8; if (F.tid < 33) tiles[1 + F.tid] = off[F.tid];
        if (F.tid < 32) for (int rt = off[F.tid] >> 8; rt < (off[F.tid + 1] >> 8); ++rt) tiles[64 + rt] = F.tid; }
    for (int e = F.bid; e < 32; e += F.G) { const int c = (int)__hip_atomic_load(F.ctl + CW_CNT + layer * 32 + e, __ATOMIC_RELAXED, __HIP_MEMORY_SCOPE_AGENT);
        for (int r = off[e] + c + F.tid; r < off[e + 1]; r += NTHR) { row_tok[r] = -1; row_w[r] = 0.f; } }
    const bf16_t* H2 = (const bf16_t*)(F.ws + WS_H); bf16_t* HP = (bf16_t*)(F.ws + WS_U);
    for (int blk = F.bid; blk < NTOK / 64; blk += F.G) {
        for (int q = F.wave; q < 128; q += 8) { const size_t t = (size_t)blk * 64 + (q >> 1); const int slot = q & 1;
            const int* rt = (const int*)(F.ws + WS_ROUTE) + t * 8; const int e = rt[slot], rank = rt[4 + slot]; const float w = ((const float*)rt)[2 + slot];
            const int pos = off[e] + rank;
            const u32x4 a = *(const u32x4*)(H2 + t * DM + 8 * F.lane), bq = *(const u32x4*)(H2 + t * DM + 512 + 8 * F.lane);
            *(u32x4*)(HP + (size_t)pos * DM + 8 * F.lane) = a; *(u32x4*)(HP + (size_t)pos * DM + 512 + 8 * F.lane) = bq;
            if (F.lane == 0) { row_tok[pos] = (int)t * 2 + slot; row_w[pos] = w; } }
    }
}

constexpr int NPH_LAYER = 11, NPHASE = 1 + 2 * NPH_LAYER + 1;
__global__ void __launch_bounds__(NTHR, 2) mk_forward(Params P) {
    extern __shared__ __attribute__((aligned(16))) unsigned char lds_raw[];
    Frame F; F.lds = (LAS unsigned char*)lds_raw; F.tid = threadIdx.x; F.lane = F.tid & 63; F.wave = __builtin_amdgcn_readfirstlane(F.tid >> 6); F.bid = blockIdx.x; F.G = gridDim.x;
    F.in = P.in; F.out = P.out; F.ws = P.ws; F.ctl = (unsigned*)(P.ws + WS_CTL); F.misc = (volatile LAS int*)(F.lds + MISC_OFF);
    if (F.tid < 64) ((LAS unsigned*)(F.lds + MISC_OFF))[F.tid] = 0u;
    __syncthreads();
    const int lo = P.ph_lo, hi = P.ph_hi;
    XcdBarrier bar; bar.bar = F.ctl + CW_BAR; bar.x = 0; bar.st = (volatile LAS unsigned*)(F.lds + MISC_OFF + 16);
    if (hi - lo > 1) bar = xcd_barrier_post(F.ctl + CW_BAR, (volatile LAS unsigned*)(F.lds + MISC_OFF + 16));
#ifndef MK_ONLY
#define MK_ONLY -1
#endif
#define EN(o) (MK_ONLY < 0 || MK_ONLY == (o))
#ifndef MK_ITEM
#define MK_ITEM -1
#endif
#define IT(o) (MK_ITEM < 0 || MK_ITEM == (o))
#define IN(k) (lo <= (k) && (k) < hi)
#define SEAM(k) do { if (IN(k) && IN((k) + 1)) xcd_barrier(bar); } while (0)
    if (EN(100) && IN(0)) { phase_prologue(F); } SEAM(0);
    for (int layer = 0; layer < DEPTH; ++layer) {
        const int pb = 1 + layer * NPH_LAYER;
        if (EN(0) && IN(pb + 0)) { phase_norm(F, layer == 0 ? F.in[I_X] : (const float*)(F.ws + WS_X), layer > 0, F.in[I_NORM1] + (size_t)layer * DM, 0); } SEAM(pb + 0);
        if (EN(1) && IN(pb + 1)) { const Frame F_ = F; Frame F = relocal(F_); pg8::StaticOrder S; S.init((const bf16_t*)(F.ws + WS_H), (const bf16_t*)(F.ws + WS_WIN) + (size_t)layer * NINP * DM, NTOK, NINP, DM, F.G, F.bid);
            pg8::EpiBf16 E{(bf16_t*)(F.ws + WS_U), NINP}; pg8::gemm_phase(F.lds, DM, S, E); } SEAM(pb + 1);
#define QLOOP(qi, n, body) for (;;) { const int it = q_pop(F, layer * 12 + (qi)); if (it >= (n)) break; body; }
        if (EN(2) && IN(pb + 2)) {
            if (IT(0)) QLOOP(0, 256, item_s5<1>(F, layer, it));
            if (IT(1)) QLOOP(1, 1024, item_rwkv1(F, layer, it));
            if (IT(2)) QLOOP(2, 256, item_mamba<1>(F, layer, it));
            if (IT(3)) QLOOP(3, 256, item_kv(F, layer, it));
        } SEAM(pb + 2);
        if (EN(3) && IN(pb + 3)) {
            if (IT(0)) QLOOP(4, 8, item_rwkv_carry(F, it));
            if (IT(1)) QLOOP(5, 16, item_mamba_carry(F, it));
            if (IT(2)) QLOOP(6, 4, item_s5_carry(F, layer, it));
            if (IT(3)) QLOOP(7, 2048, item_dsa(F, layer, it));
        } SEAM(pb + 3);
        if (EN(4) && IN(pb + 4)) {
            if (IT(0)) QLOOP(8, 256, item_s5<2>(F, layer, it));
            if (IT(1)) QLOOP(9, 1024, item_rwkv3(F, layer, it));
            if (IT(2)) QLOOP(10, 256, item_mamba<2>(F, layer, it));
        } SEAM(pb + 4);
        if (EN(5) && IN(pb + 5)) { const Frame F_ = F; Frame F = relocal(F_); pg8::StaticOrder S; S.init((const bf16_t*)(F.ws + WS_MOE + YSG_OFF), (const bf16_t*)(F.ws + WS_GLU) + (size_t)layer * 512 * 256, NTOK, 512, 256, F.G, F.bid);
            pg8::EpiGated<0> E{(bf16_t*)(F.ws + WS_H), DM, 768, F.in[I_SGLUB] + layer * 512, F.in[I_SGLUB] + layer * 512 + 256}; pg8::gemm_phase(F.lds, 256, S, E); } SEAM(pb + 5);
        if (EN(6) && IN(pb + 6)) { const Frame F_ = F; Frame F = relocal(F_); pg8::StaticOrder S; S.init((const bf16_t*)(F.ws + WS_H), (const bf16_t*)(F.ws + WS_WOUT) + (size_t)layer * DM * DM, NTOK, DM, DM, F.G, F.bid);
            pg8::EpiResid E{(float*)(F.ws + WS_X), DM}; pg8::gemm_phase(F.lds, DM, S, E); } SEAM(pb + 6);
        if (EN(7) && IN(pb + 7)) { phase_router(F, layer); phase_moe_convert(F, layer); } SEAM(pb + 7);
        if (EN(8) && IN(pb + 8)) { phase_gather(F, layer); } SEAM(pb + 8);
        if (EN(9) && IN(pb + 9)) { const Frame F_ = F; Frame F = relocal(F_); pg8::MoeOrder S{2, F.G, F.bid, DM, (const char*)(F.ws + WS_U), (const char*)(F.ws + WS_MOE + MOE_WGU), (size_t)512 * 1024 * 2, (const int*)(F.ws + WS_TILES)};
            pg8::EpiGated<1> E{(bf16_t*)(F.ws + WS_H), 256, 0, nullptr, nullptr}; pg8::gemm_phase(F.lds, DM, S, E); } SEAM(pb + 9);
        if (EN(10) && IN(pb + 10)) { const Frame F_ = F; Frame F = relocal(F_); pg8::MoeOrder S{4, F.G, F.bid, 256, (const char*)(F.ws + WS_H), (const char*)(F.ws + WS_MOE + MOE_WD), (size_t)1024 * 256 * 2, (const int*)(F.ws + WS_TILES)};
            pg8::EpiMoeOut E{(bf16_t*)(F.ws + WS_U), (const int*)(F.ws + WS_ROWS), (const float*)(F.ws + WS_ROWS) + MAXROWS}; pg8::gemm_phase(F.lds, 256, S, E); } SEAM(pb + 10);
    }
    if (EN(101) && IN(NPHASE - 1)) { phase_norm(F, (const float*)(F.ws + WS_X), true, F.in[I_FNORM], 2); }
#undef IN
#undef SEAM
}

#ifndef MK_SPLIT
#define MK_SPLIT 1
#endif
extern "C" void kernel_launch(void* const* d_in, const int* in_sizes, int n_in, void* d_out, int out_size, void* d_ws, size_t ws_size, hipStream_t stream) {
    static int grid = 0;
    if (grid == 0) {
        if (n_in != 44 || out_size != NTOK * DM || ws_size < WS_END) { fprintf(stderr, "kernel_launch: unexpected shapes (n_in %d out %d ws %zu need %zu)\n", n_in, out_size, ws_size, (size_t)WS_END); grid = -1; return; }
        int dev = 0, cus = 0;
        if (hipGetDevice(&dev) != hipSuccess || hipDeviceGetAttribute(&cus, hipDeviceAttributeMultiprocessorCount, dev) != hipSuccess) { grid = -1; return; }
        if (hipFuncSetAttribute((const void*)mk_forward, hipFuncAttributeMaxDynamicSharedMemorySize, LDS_BYTES) != hipSuccess) { fprintf(stderr, "kernel_launch: hipFuncSetAttribute failed\n"); grid = -1; return; }
        int per_cu = 0;
        if (hipOccupancyMaxActiveBlocksPerMultiprocessor(&per_cu, (const void*)mk_forward, NTHR, LDS_BYTES) != hipSuccess || per_cu < 1) { fprintf(stderr, "kernel_launch: occupancy query says %d\n", per_cu); }
        (void)hipGetLastError();
        grid = cus;
    }
    if (grid < 0) return;
    hipMemsetAsync((char*)d_ws + WS_CTL, 0, CTL_BYTES, stream);
    Params p{};
    for (int i = 0; i < 44; ++i) p.in[i] = (const float*)d_in[i];
    p.out = (float*)d_out; p.ws = (unsigned char*)d_ws;
#if MK_SPLIT
    for (int ph = 0; ph < NPHASE; ++ph) { p.ph_lo = ph; p.ph_hi = ph + 1; hipLaunchKernelGGL(mk_forward, dim3(grid), dim3(NTHR), LDS_BYTES, stream, p); }
#else
    p.ph_lo = 0; p.ph_hi = NPHASE; hipLaunchKernelGGL(mk_forward, dim3(grid), dim3(NTHR), LDS_BYTES, stream, p);
#endif
}
```

```cpp
#include <hip/hip_runtime.h>
#include <stdint.h>
#include <stdio.h>

#define LAS __attribute__((address_space(3)))
typedef unsigned short bf16_t;
typedef short bf16x8 __attribute__((ext_vector_type(8)));
typedef float f32x4 __attribute__((ext_vector_type(4)));
typedef float f32x2 __attribute__((ext_vector_type(2)));
typedef float f32x16 __attribute__((ext_vector_type(16)));
typedef unsigned u32x4 __attribute__((ext_vector_type(4)));
typedef unsigned u32x2 __attribute__((ext_vector_type(2)));

constexpr int NTOK = 16384, DM = 1024, SEQ = 4096, NBATCH = 4, DEPTH = 2;
constexpr int NIN = 2604, NINP = 2816;
constexpr int UM = 0;
constexpr int UR = 784;
constexpr int UC = 1680;
constexpr int US = 2368;
constexpr int NTHR = 512;
constexpr int LDS_BYTES = 147456;
constexpr int MISC_OFF = LDS_BYTES - 256;

constexpr size_t WS_CTL   = 0;
constexpr size_t CTL_BYTES = 65536;
constexpr size_t WS_X     = WS_CTL + CTL_BYTES;
constexpr size_t WS_H     = WS_X + (size_t)NTOK * DM * 4;
constexpr size_t WS_U     = WS_H + (size_t)NTOK * DM * 2;
constexpr size_t WS_WIN   = WS_U + (size_t)NTOK * NINP * 2;
constexpr size_t WS_WOUT  = WS_WIN + (size_t)2 * NINP * DM * 2;
constexpr size_t WS_GLU   = WS_WOUT + (size_t)2 * DM * DM * 2;
constexpr size_t WS_MOE   = WS_GLU + (size_t)2 * 512 * 256 * 2;
constexpr size_t MOE_WGU  = 0;
constexpr size_t MOE_WD   = (size_t)32 * 512 * 1024 * 2;
constexpr size_t MOE_BYTES = MOE_WD + (size_t)32 * 1024 * 256 * 2;
constexpr size_t RW_PT    = 0;
constexpr size_t RW_U     = (size_t)1024 * 4096 * 2;
constexpr size_t RW_S     = RW_U + (size_t)1024 * 4096 * 4;
constexpr size_t YSG_OFF  = RW_S + (size_t)1024 * 4096 * 4;
static_assert(YSG_OFF + (size_t)NTOK * 256 * 2 <= MOE_BYTES, "alias");
constexpr size_t WS_MST   = WS_MOE + MOE_BYTES;
constexpr size_t WS_MDEC  = WS_MST + (size_t)4 * 64 * 4 * 4096 * 4;
constexpr size_t WS_S5ST  = WS_MDEC + 4096;
constexpr size_t WS_K     = WS_S5ST + (size_t)4 * 64 * 2048 * 4;
constexpr size_t WS_V     = WS_K + (size_t)NTOK * 64 * 2;
constexpr size_t WS_KIDX  = WS_V + (size_t)NTOK * 64 * 2;
constexpr size_t WS_ROUTE = WS_KIDX + (size_t)NTOK * 32 * 2;
constexpr size_t WS_ROWS  = WS_ROUTE + (size_t)NTOK * 32;
constexpr int    MAXROWS  = 49152;
constexpr size_t WS_TILES = WS_ROWS + (size_t)MAXROWS * 8;
constexpr size_t WS_S5TAB = WS_TILES + 4096;
constexpr size_t S5TAB_F  = (size_t)(2048 + 2048 + 32768) * 4;
constexpr size_t S5TAB_L  = S5TAB_F + (size_t)16 * 16 * 128 * 2;
constexpr size_t WS_END   = WS_S5TAB + 2 * S5TAB_L;

constexpr int CW_BAR = 0;
constexpr int CW_Q   = 4096;
constexpr int CW_CNT = 8192;

__device__ __forceinline__ float bf2f(bf16_t b) { return __uint_as_float(((unsigned)b) << 16); }
__device__ __forceinline__ bf16_t f2bf(float f) { unsigned u = __float_as_uint(f); u += 0x7FFFu + ((u >> 16) & 1u); return (bf16_t)(u >> 16); }
__device__ __forceinline__ unsigned pk2(float lo, float hi) { return (unsigned)f2bf(lo) | ((unsigned)f2bf(hi) << 16); }
__device__ __forceinline__ unsigned cvt_pk_bf16(float lo, float hi) { unsigned r; asm volatile("v_cvt_pk_bf16_f32 %0, %1, %2" : "=v"(r) : "v"(lo), "v"(hi)); return r; }
__device__ __forceinline__ float sigmoidf_(float x) { return 1.0f / (1.0f + __expf(-x)); }
__device__ __forceinline__ float siluf_(float x) { return x / (1.0f + __expf(-x)); }
__device__ __forceinline__ float tanhf_(float x) { const float e = __expf(2.0f * x); return 1.0f - 2.0f / (e + 1.0f); }
__device__ __forceinline__ float softplusf_(float x) { return fmaxf(x, 0.0f) + log1pf(__expf(-fabsf(x))); }
__device__ __forceinline__ float gelu_tanh(float x) { return 0.5f * x * (1.0f + tanhf_(0.7978845608028654f * (x + 0.044715f * x * x * x))); }
template <int CTRL> __device__ __forceinline__ float dppf(float x) { return __int_as_float(__builtin_amdgcn_update_dpp(0, __float_as_int(x), CTRL, 0xF, 0xF, true)); }
__device__ __forceinline__ float sum4(float x) { x += dppf<0xB1>(x); x += dppf<0x4E>(x); return x; }
__device__ __forceinline__ float sum8(float x) { x = sum4(x); x += dppf<0x141>(x); return x; }
__device__ __forceinline__ float sum16(float x) { x = sum8(x); x += dppf<0x140>(x); return x; }
__device__ __forceinline__ int lane_id_() { int l = (int)__builtin_amdgcn_mbcnt_hi(~0u, __builtin_amdgcn_mbcnt_lo(~0u, 0u)); asm volatile("" : "+v"(l)); return l; }
__device__ __forceinline__ float shx(float x, int o) { return __int_as_float(__builtin_amdgcn_ds_bpermute((lane_id_() ^ o) << 2, __float_as_int(x))); }
__device__ __forceinline__ unsigned shdown_u(unsigned x, int o) { return (unsigned)__builtin_amdgcn_ds_bpermute(((lane_id_() + o) & 63) << 2, (int)x); }
__device__ __forceinline__ int shidx_i(int x, int src) { return __builtin_amdgcn_ds_bpermute(src << 2, x); }
__device__ __forceinline__ float wave_sum(float x) { x = sum16(x); x += shx(x, 16); x += shx(x, 32); return x; }
__device__ __forceinline__ void unpack8(const u32x4 v, float (&f)[8]) {
    f[0] = __uint_as_float(v.x << 16); f[1] = __uint_as_float(v.x & 0xffff0000u); f[2] = __uint_as_float(v.y << 16); f[3] = __uint_as_float(v.y & 0xffff0000u);
    f[4] = __uint_as_float(v.z << 16); f[5] = __uint_as_float(v.z & 0xffff0000u); f[6] = __uint_as_float(v.w << 16); f[7] = __uint_as_float(v.w & 0xffff0000u);
}

#define XB_TMO      128
#define XB_XCNT(j)  (256  + 64 * (j))
#define XB_XSUB(j)  (1280 + 64 * (j))
#define XB_XGEN(j)  (2304 + 64 * (j))
#define XB_TOP      3328
#define XB_TOPGEN   3392
#define XCD_BAR_WORDS 3456
#define XB_SPIN_CAP (1u << 22)
__device__ __forceinline__ unsigned xb_ld(unsigned* p)              { return __hip_atomic_load(p, __ATOMIC_RELAXED, __HIP_MEMORY_SCOPE_AGENT); }
__device__ __forceinline__ unsigned xb_add(unsigned* p, unsigned v) { return __hip_atomic_fetch_add(p, v, __ATOMIC_RELAXED, __HIP_MEMORY_SCOPE_AGENT); }
__device__ __forceinline__ unsigned xb_xcc_id() { return (unsigned)__builtin_amdgcn_s_getreg((3 << 11) | 20) & 0xFu; }
#define XB_SPIN(cond, bar) do { unsigned _sp = 0; while (cond) { __builtin_amdgcn_s_sleep(1); \
    if ((++_sp & 255u) == 0u) { if (xb_ld(&(bar)[XB_TMO])) break; if (_sp > XB_SPIN_CAP) { atomicAdd(&(bar)[XB_TMO], 1u); break; } } } } while (0)
struct XcdBarrier { unsigned* bar; unsigned x; volatile LAS unsigned* st; };
__device__ __forceinline__ XcdBarrier xcd_barrier_post(unsigned* bar, volatile LAS unsigned* st) {
    XcdBarrier b; b.bar = bar; b.x = xb_xcc_id(); b.st = st;
    if (threadIdx.x == 0) (void)xb_add(&bar[XB_XCNT(b.x)], 1u);
    return b;
}
__device__ __forceinline__ void xcd_barrier_complete(unsigned* bar, unsigned x, unsigned& nloc, unsigned& nx) {
    const unsigned G = gridDim.x * gridDim.y * gridDim.z;
    unsigned sum, cnt, mine, sp = 0u;
    for (;;) {
        sum = 0u; cnt = 0u; mine = 0u;
#pragma unroll
        for (unsigned j = 0; j < 16; ++j) { const unsigned c = xb_ld(&bar[XB_XCNT(j)]); sum += c; cnt += (c > 0u) ? 1u : 0u; mine = (j == x) ? c : mine; }
        if (sum == G) break;
        __builtin_amdgcn_s_sleep(1);
        if ((++sp & 255u) == 0u) { if (xb_ld(&bar[XB_TMO])) break; if (sp > XB_SPIN_CAP) { atomicAdd(&bar[XB_TMO], 1u); break; } }
    }
    nloc = mine > 0u ? mine : 1u; nx = cnt > 0u ? cnt : 1u;
}
__device__ __forceinline__ void xcd_barrier(const XcdBarrier& b) {
    asm volatile("s_waitcnt vmcnt(0)" ::: "memory");
    __syncthreads();
    if (threadIdx.x == 0) {
        unsigned* bar = b.bar;
        __builtin_amdgcn_s_waitcnt(0);
        unsigned nloc = b.st[0], nx = b.st[1];
        if (nloc == 0u) { xcd_barrier_complete(bar, b.x, nloc, nx); b.st[0] = nloc; b.st[1] = nx; }
        const unsigned old = xb_add(&bar[XB_XSUB(b.x)], 1u);
        const unsigned gen = old / nloc;
        if (old + 1u == (gen + 1u) * nloc) {
            __builtin_amdgcn_fence(__ATOMIC_RELEASE, "agent");
            asm volatile("s_waitcnt vmcnt(0)" ::: "memory");
            const unsigned og = xb_add(&bar[XB_TOP], 1u);
            const unsigned tg = og / nx;
            if (og + 1u == (tg + 1u) * nx) xb_add(&bar[XB_TOPGEN], 1u);
            else XB_SPIN(xb_ld(&bar[XB_TOPGEN]) == tg, bar);
            __builtin_amdgcn_fence(__ATOMIC_ACQUIRE, "agent");
            xb_add(&bar[XB_XGEN(b.x)], 1u);
            asm volatile("s_waitcnt vmcnt(0)" ::: "memory");
        } else {
            XB_SPIN(xb_ld(&bar[XB_XGEN(b.x)]) == gen, bar);
            __builtin_amdgcn_fence(__ATOMIC_ACQUIRE, "agent");
            asm volatile("s_waitcnt vmcnt(0)" ::: "memory");
        }
    }
    __syncthreads();
}

namespace pg8 {
constexpr int BM = 256, BK = 64, HALF = 128, HTB = HALF * BK * 2, STAGE_BYTES = 8 * HTB, NXCD = 8, WGM = 8;
__host__ __device__ __forceinline__ int lds_byte(int r, int c) { const int st = (r >> 4) * 2 + (c >> 5), rr = r & 15, cc = c & 31, ob = rr * 64 + cc * 2; return st * 1024 + (ob ^ (((ob >> 9) & 1) << 5)); }
__host__ __device__ __forceinline__ void stage_rc(int b, int& R, int& C) { const int st = b / 1024, sb = b % 1024, swz = sb ^ (((sb >> 9) & 1) << 5); R = (st >> 1) * 16 + swz / 64; C = (st & 1) * 32 + (swz % 64) / 2; }
__host__ __device__ __forceinline__ int perm32(int rho) { const int n = rho >> 4, i = rho & 15; return 8 * (i >> 2) + 4 * n + (i & 3); }
struct Unit { int pm, pn; const char* a; const char* b; };

struct StaticOrder {
    int nM, nN, nwg, G, c, K; const char* A; const char* B;
    __device__ void init(const bf16_t* A_, const bf16_t* B_, int M, int N, int K_, int G_, int c_) { A = (const char*)A_; B = (const char*)B_; K = K_; nM = M / BM; nN = N / BM; nwg = nM * nN; G = G_; c = c_; }
    __device__ bool next(int i, Unit& u) const {
        const long L = (long)i * G + c; if (L >= nwg) return false;
        int wgid = (int)L; { const int q = nwg / NXCD, r = nwg % NXCD, xcd = wgid % NXCD, off = wgid / NXCD; wgid = (xcd < r ? xcd * (q + 1) : r * (q + 1) + (xcd - r) * q) + off; }
        const int nig = WGM * nN, gid = wgid / nig, fm = gid * WGM, gsz = (nM - fm) < WGM ? (nM - fm) : WGM;
        u.pm = fm + ((wgid % nig) % gsz); u.pn = (wgid % nig) / gsz;
        u.a = A + (size_t)u.pm * 256 * K * 2; u.b = B + (size_t)u.pn * 256 * K * 2; return true;
    }
};

template <class Epi, class Sched>
__device__ __forceinline__ void gemm_phase(LAS unsigned char* lds, const int K_, const Sched& S, const Epi& E) {
    int K = K_; asm volatile("" : "+s"(K));
    int tid_ = threadIdx.x; asm volatile("" : "+v"(tid_));
    const int tid = tid_, wid = __builtin_amdgcn_readfirstlane(tid >> 6), lane = tid & 63, wr = wid >> 2, wc = wid & 3, fr = lane & 15, fq = lane >> 4;
    const int nt = K / BK;
    unsigned voffA[2], voffB[2];
#pragma unroll
    for (int i = 0; i < 2; ++i) { int R, C; stage_rc(tid * 16 + i * 8192, R, C); const int Rb = Epi::PERM ? ((R & ~31) + perm32(R & 31)) : R;
        voffA[i] = (unsigned)(R * K + C) * 2u; voffB[i] = (unsigned)(Rb * K + C) * 2u; }
    const size_t kstep = (size_t)(BK * 2);
    const size_t hstep = (size_t)HALF * K * 2;
    const unsigned ldsw = (unsigned)wid * 1024u;
    const int aoff = lds_byte(wr * 64 + fr, fq * 8), boff = lds_byte(wc * 32 + fr, fq * 8);
#define PG8_SA(b, h) (((b) * 2 + (h)) * HTB)
#define PG8_SB(b, h) ((4 + (b) * 2 + (h)) * HTB)
#define PG8_STAGE(bufoff, gbase, voff) do { _Pragma("unroll") for (int _i = 0; _i < 2; ++_i) \
        __builtin_amdgcn_global_load_lds((const unsigned*)((const char*)(gbase) + (voff)[_i]), (LAS unsigned*)(lds + (bufoff) + ldsw + _i * 8192), 16, 0, 0); } while (0)
#define PG8_LDA(dst, b, h) do { _Pragma("unroll") for (int m = 0; m < 4; ++m) _Pragma("unroll") for (int k = 0; k < 2; ++k) dst[m][k] = *(const LAS bf16x8*)(lds + PG8_SA(b, h) + aoff + m * 2048 + k * 1024); } while (0)
#define PG8_LDB(dst, b, h) do { _Pragma("unroll") for (int n = 0; n < 2; ++n) _Pragma("unroll") for (int k = 0; k < 2; ++k) dst[n][k] = *(const LAS bf16x8*)(lds + PG8_SB(b, h) + boff + n * 2048 + k * 1024); } while (0)
#define PG8_MMA(ai, bj, At, Bt) do { __builtin_amdgcn_s_setprio(1); _Pragma("unroll") for (int m = 0; m < 4; ++m) _Pragma("unroll") for (int n = 0; n < 2; ++n) _Pragma("unroll") for (int k = 0; k < 2; ++k) \
        acc[ai][bj][m][n] = __builtin_amdgcn_mfma_f32_16x16x32_bf16(Bt[n][k], At[m][k], acc[ai][bj][m][n], 0, 0, 0); __builtin_amdgcn_s_setprio(0); } while (0)
#define PG8_WAIT_V(n) asm volatile("s_waitcnt vmcnt(" #n ")" ::: "memory")
#define PG8_WAIT_L(n) asm volatile("s_waitcnt lgkmcnt(" #n ")" ::: "memory")
#define PG8_BAR __builtin_amdgcn_s_barrier()
#define PG8_SCHED __builtin_amdgcn_sched_barrier(0)
    Unit cur, nxt; int ui = 0;
    if (!S.next(0, cur)) return;
    f32x4 acc[2][2][4][2];
#pragma unroll
    for (int a = 0; a < 2; ++a)
#pragma unroll
        for (int b = 0; b < 2; ++b)
#pragma unroll
            for (int m = 0; m < 4; ++m)
#pragma unroll
                for (int n = 0; n < 2; ++n) acc[a][b][m][n] = (f32x4){0.f, 0.f, 0.f, 0.f};
    bf16x8 At[4][2], B0[2][2], B1[2][2];
    const char* cA = cur.a; const char* cB = cur.b;
    PG8_STAGE(PG8_SB(0, 0), cB, voffB); PG8_STAGE(PG8_SA(0, 0), cA, voffA); PG8_STAGE(PG8_SB(0, 1), cB + hstep, voffB); PG8_STAGE(PG8_SA(0, 1), cA + hstep, voffA);
    if (wr == 1) PG8_BAR;
    PG8_WAIT_V(4); PG8_BAR;
    PG8_STAGE(PG8_SB(1, 0), cB + kstep, voffB); PG8_STAGE(PG8_SA(1, 0), cA + kstep, voffA); PG8_STAGE(PG8_SB(1, 1), cB + hstep + kstep, voffB);
    PG8_WAIT_V(6); PG8_BAR;
    for (;;) {
        const bool has_next = S.next(ui + 1, nxt);
        const char* nA = has_next ? nxt.a : cA; const char* nB = has_next ? nxt.b : cB;
        for (int t = 0; t < nt; t += 2) {
            const bool last = (t == nt - 2);
            const char* a1 = cA + (size_t)(t + 1) * kstep;
            const char* a2 = last ? nA : cA + (size_t)(t + 2) * kstep; const char* b2 = last ? nB : cB + (size_t)(t + 2) * kstep;
            const char* a3 = a2 + kstep; const char* b3 = b2 + kstep;
            PG8_LDB(B0, 0, 0); PG8_SCHED; PG8_LDA(At, 0, 0); PG8_STAGE(PG8_SA(1, 1), a1 + hstep, voffA);
            PG8_WAIT_L(8); PG8_BAR; PG8_WAIT_L(0); PG8_MMA(0, 0, At, B0); PG8_BAR; PG8_SCHED;
            PG8_LDB(B1, 0, 1); PG8_STAGE(PG8_SB(0, 0), b2, voffB);
            PG8_BAR; PG8_WAIT_L(0); PG8_MMA(0, 1, At, B1); PG8_BAR;
            PG8_LDA(At, 0, 1); PG8_STAGE(PG8_SA(0, 0), a2, voffA);
            PG8_BAR; PG8_WAIT_L(0); PG8_MMA(1, 0, At, B0); PG8_BAR; PG8_SCHED;
            PG8_STAGE(PG8_SB(0, 1), b2 + hstep, voffB);
            PG8_WAIT_V(6); PG8_BAR; PG8_MMA(1, 1, At, B1); PG8_BAR;
            PG8_LDB(B0, 1, 0); PG8_SCHED; PG8_LDA(At, 1, 0); PG8_STAGE(PG8_SA(0, 1), a2 + hstep, voffA);
            PG8_WAIT_L(8); PG8_BAR; PG8_WAIT_L(0); PG8_MMA(0, 0, At, B0); PG8_BAR; PG8_SCHED;
            PG8_LDB(B1, 1, 1); PG8_STAGE(PG8_SB(1, 0), b3, voffB);
            PG8_BAR; PG8_WAIT_L(0); PG8_MMA(0, 1, At, B1); PG8_BAR;
            PG8_LDA(At, 1, 1); PG8_STAGE(PG8_SA(1, 0), a3, voffA);
            PG8_BAR; PG8_WAIT_L(0); PG8_MMA(1, 0, At, B0); PG8_BAR; PG8_SCHED;
            PG8_STAGE(PG8_SB(1, 1), b3 + hstep, voffB);
            PG8_WAIT_V(6); PG8_BAR; PG8_MMA(1, 1, At, B1); PG8_BAR;
        }
        E(acc, cur, wr, wc, fr, fq);
        if (!has_next) break;
#pragma unroll
        for (int a = 0; a < 2; ++a)
#pragma unroll
            for (int b = 0; b < 2; ++b)
#pragma unroll
                for (int m = 0; m < 4; ++m)
#pragma unroll
                    for (int n = 0; n < 2; ++n) acc[a][b][m][n] = (f32x4){0.f, 0.f, 0.f, 0.f};
        cur = nxt; cA = nA; cB = nB; ++ui;
    }
    PG8_WAIT_V(0);
    if (wr == 0) PG8_BAR;
    PG8_BAR;
#undef PG8_SA
#undef PG8_SB
#undef PG8_STAGE
#undef PG8_LDA
#undef PG8_LDB
#undef PG8_MMA
#undef PG8_WAIT_V
#undef PG8_WAIT_L
#undef PG8_BAR
#undef PG8_SCHED
}

struct EpiBf16 {
    static constexpr bool PERM = true;
    bf16_t* O; int ldc;
    __device__ __forceinline__ void operator()(const f32x4 (&acc)[2][2][4][2], const Unit& u, int wr, int wc, int fr, int fq) const {
        const int row0 = u.pm * BM + wr * 64 + fr, col0 = u.pn * BM + wc * 32 + 8 * fq;
#pragma unroll
        for (int ai = 0; ai < 2; ++ai)
#pragma unroll
            for (int m = 0; m < 4; ++m) { bf16_t* rowp = O + (size_t)(row0 + ai * HALF + m * 16) * ldc + col0;
#pragma unroll
                for (int bj = 0; bj < 2; ++bj) { const f32x4 v0 = acc[ai][bj][m][0], v1 = acc[ai][bj][m][1];
                    u32x4 w; w.x = cvt_pk_bf16(v0[0], v0[1]); w.y = cvt_pk_bf16(v0[2], v0[3]); w.z = cvt_pk_bf16(v1[0], v1[1]); w.w = cvt_pk_bf16(v1[2], v1[3]);
                    *(u32x4*)(rowp + bj * HALF) = w; } }
    }
};
struct EpiResid {
    static constexpr bool PERM = false;
    float* C; int ldc;
    __device__ __forceinline__ void operator()(const f32x4 (&acc)[2][2][4][2], const Unit& u, int wr, int wc, int fr, int fq) const {
        const int row0 = u.pm * BM + wr * 64 + fr, col0 = u.pn * BM + wc * 32 + 4 * fq;
#pragma unroll
        for (int ai = 0; ai < 2; ++ai)
#pragma unroll
            for (int m = 0; m < 4; ++m) { float* rowp = C + (size_t)(row0 + ai * HALF + m * 16) * ldc + col0;
#pragma unroll
                for (int bj = 0; bj < 2; ++bj)
#pragma unroll
                    for (int n = 0; n < 2; ++n) { f32x4* p = (f32x4*)(rowp + bj * HALF + n * 16); *p = *p + acc[ai][bj][m][n]; } }
    }
};
template <int ACT  > struct EpiGated {
    static constexpr bool PERM = true;
    bf16_t* O; int ldo; int coloff; const float* ba; const float* bb;
    __device__ __forceinline__ void operator()(const f32x4 (&acc)[2][2][4][2], const Unit& u, int wr, int wc, int fr, int fq) const {
        const int row0 = u.pm * BM + wr * 64 + fr, cl = u.pn * HALF + wc * 32 + 8 * fq;
        float va[8], vb[8];
#pragma unroll
        for (int j = 0; j < 8; ++j) { va[j] = (ACT == 0) ? ba[cl + j] : 0.f; vb[j] = (ACT == 0) ? bb[cl + j] : 0.f; }
#pragma unroll
        for (int ai = 0; ai < 2; ++ai)
#pragma unroll
            for (int m = 0; m < 4; ++m) { bf16_t* rowp = O + (size_t)(row0 + ai * HALF + m * 16) * ldo + coloff + cl;
                float o[8];
#pragma unroll
                for (int n = 0; n < 2; ++n)
#pragma unroll
                    for (int j = 0; j < 4; ++j) { const float a = acc[ai][0][m][n][j] + va[4 * n + j], b = acc[ai][1][m][n][j] + vb[4 * n + j];
                        o[4 * n + j] = (ACT == 0) ? a * sigmoidf_(b) : siluf_(a) * b; }
                u32x4 w; w.x = cvt_pk_bf16(o[0], o[1]); w.y = cvt_pk_bf16(o[2], o[3]); w.z = cvt_pk_bf16(o[4], o[5]); w.w = cvt_pk_bf16(o[6], o[7]);
                *(u32x4*)rowp = w; asm volatile("" ::: "memory"); }
    }
};
struct EpiMoeOut {
    static constexpr bool PERM = true;
    bf16_t* O; const int* row_tok; const float* row_w;
    __device__ __forceinline__ void operator()(const f32x4 (&acc)[2][2][4][2], const Unit& u, int wr, int wc, int fr, int fq) const {
        const int row0 = u.pm * BM + wr * 64 + fr, col0 = u.pn * BM + wc * 32 + 8 * fq;
#pragma unroll
        for (int ai = 0; ai < 2; ++ai)
#pragma unroll
            for (int m = 0; m < 4; ++m) { const int row = row0 + ai * HALF + m * 16; const int ts = row_tok[row]; const float w = row_w[row];
                if (ts >= 0) { bf16_t* rowp = O + ((size_t)(ts & 1) * NTOK + (size_t)(ts >> 1)) * DM + col0;
#pragma unroll
                    for (int bj = 0; bj < 2; ++bj) { const f32x4 v0 = acc[ai][bj][m][0] * w, v1 = acc[ai][bj][m][1] * w;
                        u32x4 q; q.x = cvt_pk_bf16(v0[0], v0[1]); q.y = cvt_pk_bf16(v0[2], v0[3]); q.z = cvt_pk_bf16(v1[0], v1[1]); q.w = cvt_pk_bf16(v1[2], v1[3]);
                        *(u32x4*)(rowp + bj * HALF) = q; } } asm volatile("" ::: "memory"); }
    }
};
struct MoeOrder {
    int nN, G, c, K; const char* A; const char* B; size_t bstride; const int* tiles;
    __device__ bool next(int i, Unit& u) const {
        const int nrt = tiles[0]; const long L = (long)i * G + c; if (L >= (long)nrt * nN) return false;
        u.pm = (int)(L / nN); u.pn = (int)(L % nN); const int e = tiles[64 + u.pm];
        u.a = A + (size_t)u.pm * 256 * K * 2; u.b = B + (size_t)e * bstride + (size_t)u.pn * 256 * K * 2; return true;
    }
};
}

struct Params { const float* in[44]; float* out; unsigned char* ws; int ph_lo, ph_hi; };
enum { I_X = 0, I_NORM1, I_WIN, I_MCONVW, I_MCONVB, I_MDTB, I_MALOG, I_MD, I_MNORM, I_RMU, I_RW0, I_RW2, I_RA0, I_RA2, I_RG2, I_RKK, I_RKA, I_RRK, I_RLNW, I_RLNB,
       I_CKVN, I_CWUK, I_CWUV, I_RELB, I_SARE, I_SAIM, I_SBRE, I_SBIM, I_SCRE, I_SCIM, I_SD, I_SLOGDT, I_SGLUW, I_SGLUB, I_WOUT, I_NORM2, I_WRG, I_BRG, I_WRE, I_BRE,
       I_WGATE, I_WUP, I_WDOWN, I_FNORM };

struct Frame {
    LAS unsigned char* lds; int tid, lane, wave, bid, G;
    const float* const* in; float* out; unsigned char* ws; unsigned* ctl;
    volatile LAS int* misc;
};

__device__ __forceinline__ int q_pop(Frame& F, int qi) {
    __syncthreads();
    if (F.tid == 0) F.misc[0] = (int)__hip_atomic_fetch_add(F.ctl + CW_Q + 64 * qi, 1u, __ATOMIC_RELAXED, __HIP_MEMORY_SCOPE_AGENT);
    __syncthreads();
    return F.misc[0];
}

__device__ __forceinline__ const void* opaque_ptr(const void* p) { const unsigned long long v = (unsigned long long)p; unsigned lo = __builtin_amdgcn_readfirstlane((unsigned)v), hi = __builtin_amdgcn_readfirstlane((unsigned)(v >> 32));
    asm volatile("" : "+s"(lo), "+s"(hi)); return (const void*)(((unsigned long long)hi << 32) | lo); }
__device__ __forceinline__ Frame relocal(const Frame& G) { Frame F = G; asm volatile("" : "+v"(F.tid)); F.ws = (unsigned char*)opaque_ptr(F.ws); F.ctl = (unsigned*)(F.ws + WS_CTL); F.lane = F.tid & 63; F.wave = __builtin_amdgcn_readfirstlane(F.tid >> 6); return F; }
template <int K> __device__ __forceinline__ f32x4 mma_nt(const LAS bf16_t* A, int lda, const LAS bf16_t* Bt, int ldb, f32x4 acc, int lane) {
    const int r = lane & 15, g = lane >> 4;
#pragma unroll
    for (int k0 = 0; k0 < K; k0 += 32) {
        const bf16x8 a = *(const LAS bf16x8*)(A + r * lda + k0 + 8 * g);
        const bf16x8 b = *(const LAS bf16x8*)(Bt + r * ldb + k0 + 8 * g);
        acc = __builtin_amdgcn_mfma_f32_16x16x32_bf16(a, b, acc, 0, 0, 0);
    }
    return acc;
}

template <class ColMap> __device__ __forceinline__ void tr_tile(Frame& F, const float* src, int ldsrc, bf16_t* dst, int K, int k0, int n0, ColMap cm) {
    LAS float* tile = (LAS float*)F.lds;
    __syncthreads();
    { const int kk = F.tid >> 4, n4 = (F.tid & 15) * 4;
#pragma unroll
      for (int ps = 0; ps < 2; ++ps) { const int k = kk + 32 * ps; const int sc = cm(n0 + n4);
          f32x4 v = (f32x4){0.f, 0.f, 0.f, 0.f}; if (sc >= 0) v = *(const f32x4*)(src + (size_t)(k0 + k) * ldsrc + sc);
          tile[k * 65 + n4 + 0] = v[0]; tile[k * 65 + n4 + 1] = v[1]; tile[k * 65 + n4 + 2] = v[2]; tile[k * 65 + n4 + 3] = v[3]; } }
    __syncthreads();
    { const int n = F.tid >> 3, kc = F.tid & 7; float f[8];
#pragma unroll
      for (int j = 0; j < 8; ++j) f[j] = tile[(8 * kc + j) * 65 + n];
      u32x4 w; w.x = pk2(f[0], f[1]); w.y = pk2(f[2], f[3]); w.z = pk2(f[4], f[5]); w.w = pk2(f[6], f[7]);
      *(u32x4*)(dst + (size_t)(n0 + n) * K + k0 + 8 * kc) = w; }
}

struct CmIn { __device__ __forceinline__ int operator()(int n) const {
    if (n < 772) return n; if (n < UR) return -1; if (n < UR + 896) return 772 + (n - UR); if (n < UC) return -1;
    if (n < UC + 680) return 1668 + (n - UC); if (n < US) return -1; if (n < US + 256) return 2348 + (n - US); return -1; } };
struct CmId { __device__ __forceinline__ int operator()(int n) const { return n; } };
struct CmGlu { __device__ __forceinline__ int operator()(int n) const { const int pn = n >> 8, rr = n & 255; return rr < 128 ? 128 * pn + rr : 256 + 128 * pn + (rr - 128); } };
struct CmGateUp { int half; __device__ __forceinline__ int operator()(int n) const { return n; } };

__device__ __forceinline__ void phase_prologue(const Frame& F_) { Frame F = relocal(F_);
    for (int t = F.bid; t < 1984; t += F.G) {
        if (t < 1408) { const int l = t / 704, r = t % 704, kt = r / 44, nt = r % 44;
            tr_tile(F, F.in[I_WIN] + (size_t)l * DM * NIN, NIN, (bf16_t*)(F.ws + WS_WIN) + (size_t)l * NINP * DM, DM, kt * 64, nt * 64, CmIn()); }
        else if (t < 1920) { const int q = t - 1408, l = q / 256, r = q % 256, kt = r / 16, nt = r % 16;
            tr_tile(F, F.in[I_WOUT] + (size_t)l * DM * DM, DM, (bf16_t*)(F.ws + WS_WOUT) + (size_t)l * DM * DM, DM, kt * 64, nt * 64, CmId()); }
        else { const int q = t - 1920, l = q / 32, r = q % 32, kt = r / 8, nt = r % 8;
            tr_tile(F, F.in[I_SGLUW] + (size_t)l * 256 * 512, 512, (bf16_t*)(F.ws + WS_GLU) + (size_t)l * 512 * 256, 256, kt * 64, nt * 64, CmGlu()); }
    }
    for (int i = F.bid * NTHR + F.tid; i < 2048 + 65536; i += F.G * NTHR) {
        if (i < 2048) {
            const int l = i >> 10, gn = i & 1023, g = gn >> 6;
            float* tab = (float*)(F.ws + WS_S5TAB + (size_t)l * S5TAB_L);
            const float lre = fminf(F.in[I_SARE][l * 1024 + gn], -1e-4f), lim = F.in[I_SAIM][l * 1024 + gn];
            const float dt = expf(F.in[I_SLOGDT][l * 16 + g]);
            const float mag = expf(dt * lre); float sn, cs; sincosf(dt * lim, &sn, &cs);
            const float are = mag * cs, aim = mag * sn;
            const float den = lre * lre + lim * lim;
            const float fre = ((are - 1.0f) * lre + aim * lim) / den, fim = (aim * lre - (are - 1.0f) * lim) / den;
            tab[gn * 2] = are; tab[gn * 2 + 1] = aim;
            float pr = are, pi = aim;
#pragma unroll
            for (int s = 0; s < 6; ++s) { const float nr = pr * pr - pi * pi, ni = 2.0f * pr * pi; pr = nr; pi = ni; }
            tab[2048 + gn * 2] = pr; tab[2048 + gn * 2 + 1] = pi;
            const float* bre = F.in[I_SBRE] + ((size_t)l * 1024 + gn) * 16; const float* bim = F.in[I_SBIM] + ((size_t)l * 1024 + gn) * 16;
            for (int p = 0; p < 16; ++p) { tab[4096 + (gn * 16 + p) * 2] = fre * bre[p] - fim * bim[p]; tab[4096 + (gn * 16 + p) * 2 + 1] = fre * bim[p] + fim * bre[p]; }
        } else {
            const int j = i - 2048, l = j >> 15, r = j & 32767, gp = r >> 7, k = r & 127;
            bf16_t* cm = (bf16_t*)(F.ws + WS_S5TAB + (size_t)l * S5TAB_L + S5TAB_F);
            const float v = k < 64 ? F.in[I_SCRE][((size_t)l * 256 + gp) * 64 + k] : -F.in[I_SCIM][((size_t)l * 256 + gp) * 64 + (k - 64)];
            cm[r] = f2bf(v);
        }
    }
}

__device__ __forceinline__ void phase_norm(const Frame& F_, const float* xin, bool add_o, const float* w, int mode) { Frame F = relocal(F_);
    float* X = (float*)(F.ws + WS_X); bf16_t* H = (bf16_t*)(F.ws + WS_H); const bf16_t* O = (const bf16_t*)(F.ws + WS_U);
    for (int row = F.bid * 8 + F.wave; row < NTOK; row += F.G * 8) {
        f32x4 v[4]; float ss = 0.f;
#pragma unroll
        for (int j = 0; j < 4; ++j) { const int c = 4 * F.lane + 256 * j; v[j] = *(const f32x4*)(xin + (size_t)row * DM + c);
            if (add_o) { const u32x2 a = *(const u32x2*)(O + (size_t)row * DM + c), b = *(const u32x2*)(O + ((size_t)NTOK + row) * DM + c);
                v[j][0] += __uint_as_float(a.x << 16) + __uint_as_float(b.x << 16); v[j][1] += __uint_as_float(a.x & 0xffff0000u) + __uint_as_float(b.x & 0xffff0000u);
                v[j][2] += __uint_as_float(a.y << 16) + __uint_as_float(b.y << 16); v[j][3] += __uint_as_float(a.y & 0xffff0000u) + __uint_as_float(b.y & 0xffff0000u); }
            ss += v[j][0] * v[j][0] + v[j][1] * v[j][1] + v[j][2] * v[j][2] + v[j][3] * v[j][3]; }
        ss = wave_sum(ss);
        const float rstd = rsqrtf(ss * (1.0f / DM) + 1e-6f);
#pragma unroll
        for (int j = 0; j < 4; ++j) { const int c = 4 * F.lane + 256 * j; const f32x4 wv = *(const f32x4*)(w + c);
            if (mode == 2) { *(f32x4*)(F.out + (size_t)row * DM + c) = v[j] * rstd * wv; }
            else { *(f32x4*)(X + (size_t)row * DM + c) = v[j];
                u32x2 o; o.x = pk2(v[j][0] * rstd * wv[0], v[j][1] * rstd * wv[1]); o.y = pk2(v[j][2] * rstd * wv[2], v[j][3] * rstd * wv[3]);
                *(u32x2*)(H + (size_t)row * DM + c) = o; } }
    }
}

__device__ __forceinline__ void item_kv(const Frame& F_, int layer, int item) { Frame F = relocal(F_);
    const bf16_t* U = (const bf16_t*)(F.ws + WS_U);
    LAS bf16_t* Ab = (LAS bf16_t*)F.lds;
    LAS bf16_t* Bt = (LAS bf16_t*)(F.lds + 17408);
    const int t0 = item * 64;
    { const int tok = F.tid >> 3, part = F.tid & 7; const bf16_t* src = U + (size_t)(t0 + tok) * NINP + UC + 256 + 16 * part;
      float f[16]; { float a[8], b[8]; unpack8(*(const u32x4*)src, a); unpack8(*(const u32x4*)(src + 8), b);
#pragma unroll
        for (int j = 0; j < 8; ++j) { f[j] = a[j]; f[8 + j] = b[j]; } }
      float ss = 0.f;
#pragma unroll
      for (int j = 0; j < 16; ++j) ss += f[j] * f[j];
      ss = sum8(ss);
      const float rstd = rsqrtf(ss * (1.0f / 128.0f) + 1e-6f); const float* nw = F.in[I_CKVN] + layer * 128 + 16 * part;
#pragma unroll
      for (int j = 0; j < 16; j += 2) *(LAS unsigned*)(Ab + tok * 136 + 16 * part + j) = pk2(f[j] * rstd * nw[j], f[j + 1] * rstd * nw[j + 1]); }
    { const int n = F.tid >> 2, kq = F.tid & 3; const float* w = (n < 64 ? F.in[I_CWUK] : F.in[I_CWUV]) + (size_t)layer * 128 * 64 + (n & 63);
#pragma unroll 4
      for (int k = 32 * kq; k < 32 * kq + 32; ++k) Bt[n * 136 + k] = f2bf(w[(size_t)k * 64]); }
    if (F.tid < 256) { const int tok = F.tid >> 2, q = F.tid & 3;
        *(u32x4*)((bf16_t*)(F.ws + WS_KIDX) + (size_t)(t0 + tok) * 32 + 8 * q) = *(const u32x4*)(U + (size_t)(t0 + tok) * NINP + UC + 640 + 8 * q); }
    __syncthreads();
    const int mt = F.wave & 3, g = F.lane >> 4, r = F.lane & 15;
#pragma unroll
    for (int q = 0; q < 4; ++q) { const int nt = (F.wave >> 2) * 4 + q;
        f32x4 acc = (f32x4){0.f, 0.f, 0.f, 0.f};
        acc = mma_nt<128>(Ab + mt * 16 * 136, 136, Bt + nt * 16 * 136, 136, acc, F.lane);
        const int n = nt * 16 + r; bf16_t* dst = (bf16_t*)(F.ws + (n < 64 ? WS_K : WS_V));
#pragma unroll
        for (int i = 0; i < 4; ++i) dst[(size_t)(t0 + mt * 16 + 4 * g + i) * 64 + (n & 63)] = f2bf(acc[i]); }
}

constexpr int MB_CG = 0, MB_BG = 18432, MB_BT = 36864, MB_XT = 55296, MB_M = 92160, MB_S0 = 101376, MB_DT = 110592, MB_AC = 111616, MB_RS = 112640;
template <int STAGE> __device__ __forceinline__ void item_mamba(const Frame& F_, int layer, int item) { Frame F = relocal(F_);
    const bf16_t* U = (const bf16_t*)(F.ws + WS_U);
    const int b = item >> 6, c = item & 63, l0 = c * 64; const size_t T0 = (size_t)b * SEQ + l0;
    LAS bf16_t* Cg = (LAS bf16_t*)(F.lds + MB_CG); LAS bf16_t* Bg = (LAS bf16_t*)(F.lds + MB_BG); LAS bf16_t* BT = (LAS bf16_t*)(F.lds + MB_BT);
    LAS bf16_t* XT = (LAS bf16_t*)(F.lds + MB_XT); LAS bf16_t* Mb = (LAS bf16_t*)(F.lds + MB_M); LAS bf16_t* S0 = (LAS bf16_t*)(F.lds + MB_S0);
    LAS float* dts = (LAS float*)(F.lds + MB_DT); LAS float* acs = (LAS float*)(F.lds + MB_AC); LAS float* rs = (LAS float*)(F.lds + MB_RS);
    if (F.tid < 256) { const int l = F.tid >> 2, h = F.tid & 3;
        const float raw = bf2f(U[(T0 + l) * NINP + UM + 768 + h]) + F.in[I_MDTB][layer * 4 + h];
        const float dt = softplusf_(raw); dts[l * 4 + h] = dt; acs[l * 4 + h] = -__expf(F.in[I_MALOG][layer * 4 + h]) * dt; }
    if (F.tid < 64) rs[F.tid] = 0.f;
    __syncthreads();
    float mycum = 0.f;
    if (F.tid < 256) { const int l = F.tid >> 2, h = F.tid & 3; for (int s = 0; s <= l; ++s) mycum += acs[s * 4 + h]; }
    __syncthreads();
    if (F.tid < 256) acs[F.tid] = mycum;
    __syncthreads();
    { const int ch8 = F.tid & 63, tg = F.tid >> 6, c0 = ch8 * 8;
      float wv[4][8], bv[8];
#pragma unroll
      for (int j = 0; j < 8; ++j) { bv[j] = F.in[I_MCONVB][layer * 512 + c0 + j];
#pragma unroll
          for (int k = 0; k < 4; ++k) wv[k][j] = F.in[I_MCONVW][(layer * 4 + k) * 512 + c0 + j]; }
      float win[3][8];
#pragma unroll
      for (int k = 0; k < 3; ++k) { const int l = l0 + tg * 8 - 3 + k;
          if (l >= 0) unpack8(*(const u32x4*)(U + ((size_t)b * SEQ + l) * NINP + UM + 256 + c0), win[k]);
          else {
#pragma unroll
              for (int j = 0; j < 8; ++j) win[k][j] = 0.f; } }
#pragma unroll 1
      for (int i = 0; i < 8; ++i) { const int l = tg * 8 + i; float cur[8]; unpack8(*(const u32x4*)(U + (T0 + l) * NINP + UM + 256 + c0), cur);
          float o[8];
#pragma unroll
          for (int j = 0; j < 8; ++j) { o[j] = siluf_(bv[j] + wv[0][j] * win[0][j] + wv[1][j] * win[1][j] + wv[2][j] * win[2][j] + wv[3][j] * cur[j]);
              win[0][j] = win[1][j]; win[1][j] = win[2][j]; win[2][j] = cur[j]; }
          if (c0 < 256) { const int h = c0 >> 6, p0 = c0 & 63; float sc = dts[l * 4 + h]; if (STAGE == 1) sc *= __expf(acs[63 * 4 + h] - acs[l * 4 + h]);
#pragma unroll
              for (int j = 0; j < 8; ++j) XT[(h * 64 + p0 + j) * 72 + l] = f2bf(o[j] * sc); }
          else if (c0 < 384) { const int g = (c0 - 256) >> 6, n0 = (c0 - 256) & 63;
              if (STAGE == 1) {
#pragma unroll
                  for (int j = 0; j < 8; ++j) BT[(g * 64 + n0 + j) * 72 + l] = f2bf(o[j]); }
              else { u32x4 w; w.x = pk2(o[0], o[1]); w.y = pk2(o[2], o[3]); w.z = pk2(o[4], o[5]); w.w = pk2(o[6], o[7]); *(LAS u32x4*)(Bg + (g * 64 + l) * 72 + n0) = w; } }
          else if (STAGE == 2) { const int g = (c0 - 384) >> 6, n0 = (c0 - 384) & 63;
              u32x4 w; w.x = pk2(o[0], o[1]); w.y = pk2(o[2], o[3]); w.z = pk2(o[4], o[5]); w.w = pk2(o[6], o[7]); *(LAS u32x4*)(Cg + (g * 64 + l) * 72 + n0) = w; } } }
    __syncthreads();
    const int g4 = F.lane >> 4, r16 = F.lane & 15;
    if (STAGE == 1) {
        float* MST = (float*)(F.ws + WS_MST) + ((size_t)(b * 64 + c) * 4) * 4096;
#pragma unroll
        for (int q = 0; q < 8; ++q) { const int tix = F.wave * 8 + q, h = tix >> 4, mt = (tix >> 2) & 3, nt = tix & 3;
            f32x4 acc = (f32x4){0.f, 0.f, 0.f, 0.f};
            acc = mma_nt<64>(XT + (h * 64 + mt * 16) * 72, 72, BT + ((h >> 1) * 64 + nt * 16) * 72, 72, acc, F.lane);
#pragma unroll
            for (int i = 0; i < 4; ++i) MST[(size_t)h * 4096 + (mt * 16 + 4 * g4 + i) * 64 + nt * 16 + r16] = acc[i]; }
        if (F.tid < 4) ((float*)(F.ws + WS_MDEC))[(b * 64 + c) * 4 + F.tid] = __expf(acs[63 * 4 + F.tid]);
    } else {
        const int mt = F.wave & 3, nh = F.wave >> 2;
        const float* MST = (const float*)(F.ws + WS_MST) + ((size_t)(b * 64 + c) * 4) * 4096;
        f32x4 G[2], yv[4][2];
#pragma unroll
        for (int h = 0; h < 4; ++h) {
            const int g = h >> 1;
            { const float* src = MST + (size_t)h * 4096 + F.tid * 8; const f32x4 a = *(const f32x4*)src, bq = *(const f32x4*)(src + 4);
              u32x4 w; w.x = pk2(a[0], a[1]); w.y = pk2(a[2], a[3]); w.z = pk2(bq[0], bq[1]); w.w = pk2(bq[2], bq[3]);
              *(LAS u32x4*)(S0 + (F.tid >> 3) * 72 + (F.tid & 7) * 8) = w; }
            if ((h & 1) == 0) {
#pragma unroll
                for (int q = 0; q < 2; ++q) { G[q] = (f32x4){0.f, 0.f, 0.f, 0.f};
                    G[q] = mma_nt<64>(Cg + (g * 64 + mt * 16) * 72, 72, Bg + (g * 64 + (2 * nh + q) * 16) * 72, 72, G[q], F.lane); } }
#pragma unroll
            for (int q = 0; q < 2; ++q) { const int s = (2 * nh + q) * 16 + r16; const float as = acs[s * 4 + h];
#pragma unroll
                for (int i = 0; i < 4; ++i) { const int l = mt * 16 + 4 * g4 + i; const float v = (s <= l) ? G[q][i] * __expf(acs[l * 4 + h] - as) : 0.f;
                    Mb[l * 72 + s] = f2bf(v); } }
            __syncthreads();
#pragma unroll
            for (int q = 0; q < 2; ++q) { const int nt = 2 * nh + q;
                f32x4 yd = (f32x4){0.f, 0.f, 0.f, 0.f}, yo = (f32x4){0.f, 0.f, 0.f, 0.f};
                yd = mma_nt<64>(Mb + mt * 16 * 72, 72, XT + (h * 64 + nt * 16) * 72, 72, yd, F.lane);
                yo = mma_nt<64>(Cg + (g * 64 + mt * 16) * 72, 72, S0 + nt * 16 * 72, 72, yo, F.lane);
                const int p = nt * 16 + r16; const float dsk = F.in[I_MD][layer * 4 + h];
#pragma unroll
                for (int i = 0; i < 4; ++i) { const int l = mt * 16 + 4 * g4 + i;
                    const float xs = bf2f(XT[(h * 64 + p) * 72 + l]) / dts[l * 4 + h];
                    yv[h][q][i] = yd[i] + yo[i] * __expf(acs[l * 4 + h]) + dsk * xs; } }
            __syncthreads();
        }
        float part[4] = {0.f, 0.f, 0.f, 0.f};
#pragma unroll
        for (int h = 0; h < 4; ++h)
#pragma unroll
            for (int q = 0; q < 2; ++q) { const int ch = h * 64 + (2 * nh + q) * 16 + r16;
#pragma unroll
                for (int i = 0; i < 4; ++i) { const int l = mt * 16 + 4 * g4 + i; const float z = bf2f(U[(T0 + l) * NINP + UM + ch]);
                    const float v = yv[h][q][i] * siluf_(z); yv[h][q][i] = v; part[i] += v * v; } }
#pragma unroll
        for (int i = 0; i < 4; ++i) { const float s = sum16(part[i]); if (r16 == 0) atomicAdd((float*)(rs + mt * 16 + 4 * g4 + i), s); }
        __syncthreads();
        bf16_t* Y = (bf16_t*)(F.ws + WS_H);
#pragma unroll
        for (int i = 0; i < 4; ++i) { const int l = mt * 16 + 4 * g4 + i; const float rstd = rsqrtf(rs[l] * (1.0f / 256.0f) + 1e-6f);
#pragma unroll
            for (int h = 0; h < 4; ++h)
#pragma unroll
                for (int q = 0; q < 2; ++q) { const int ch = h * 64 + (2 * nh + q) * 16 + r16;
                    Y[(T0 + l) * DM + ch] = f2bf(yv[h][q][i] * rstd * F.in[I_MNORM][layer * 256 + ch]); } }
    }
}
__device__ __forceinline__ void item_mamba_carry(const Frame& F_, int item) { Frame F = relocal(F_);
    const int b = item >> 2, h = item & 3;
    float* MST = (float*)(F.ws + WS_MST); const float* MD = (const float*)(F.ws + WS_MDEC);
    float s[8];
#pragma unroll
    for (int j = 0; j < 8; ++j) s[j] = 0.f;
    for (int c = 0; c < 64; ++c) { float* p = MST + ((size_t)(b * 64 + c) * 4 + h) * 4096 + F.tid * 8; const float d = MD[(b * 64 + c) * 4 + h];
        const f32x4 a = *(f32x4*)p, q = *(f32x4*)(p + 4);
        *(f32x4*)p = (f32x4){s[0], s[1], s[2], s[3]}; *(f32x4*)(p + 4) = (f32x4){s[4], s[5], s[6], s[7]};
        s[0] = s[0] * d + a[0]; s[1] = s[1] * d + a[1]; s[2] = s[2] * d + a[2]; s[3] = s[3] * d + a[3];
        s[4] = s[4] * d + q[0]; s[5] = s[5] * d + q[1]; s[6] = s[6] * d + q[2]; s[7] = s[7] * d + q[3]; }
}

template <int STAGE> __device__ __forceinline__ void item_s5(const Frame& F_, int layer, int item) { Frame F = relocal(F_);
    const bf16_t* U = (const bf16_t*)(F.ws + WS_U);
    const int b = item >> 6, c = item & 63; const size_t T0 = (size_t)b * SEQ + c * 64;
    LAS float* us = (LAS float*)F.lds; LAS bf16_t* Hs = (LAS bf16_t*)(F.lds + 65536);
    const float* tab = (const float*)(F.ws + WS_S5TAB + (size_t)layer * S5TAB_L);
    { const int tok = F.tid >> 3, part = F.tid & 7;
#pragma unroll
      for (int q = 0; q < 4; ++q) { float f[8]; unpack8(*(const u32x4*)(U + (T0 + tok) * NINP + US + 32 * part + 8 * q), f);
          *(LAS f32x4*)(us + tok * 256 + 32 * part + 8 * q) = (f32x4){f[0], f[1], f[2], f[3]}; *(LAS f32x4*)(us + tok * 256 + 32 * part + 8 * q + 4) = (f32x4){f[4], f[5], f[6], f[7]}; } }
    const int g = F.tid >> 5, n0 = F.tid & 31, gn0 = g * 64 + n0, gn1 = gn0 + 32;
    float bb0[32], bb1[32];
#pragma unroll
    for (int j = 0; j < 32; j += 4) { const f32x4 a = *(const f32x4*)(tab + 4096 + gn0 * 32 + j), bq = *(const f32x4*)(tab + 4096 + gn1 * 32 + j);
        bb0[j] = a[0]; bb0[j + 1] = a[1]; bb0[j + 2] = a[2]; bb0[j + 3] = a[3]; bb1[j] = bq[0]; bb1[j + 1] = bq[1]; bb1[j + 2] = bq[2]; bb1[j + 3] = bq[3]; }
    const float a0r = tab[gn0 * 2], a0i = tab[gn0 * 2 + 1], a1r = tab[gn1 * 2], a1i = tab[gn1 * 2 + 1];
    float* ST = (float*)(F.ws + WS_S5ST) + (size_t)(b * 64 + c) * 2048;
    float h0r = 0.f, h0i = 0.f, h1r = 0.f, h1i = 0.f;
    if (STAGE == 2) { h0r = ST[gn0 * 2]; h0i = ST[gn0 * 2 + 1]; h1r = ST[gn1 * 2]; h1i = ST[gn1 * 2 + 1]; }
    bf16x8 cf[2][4];
    if (STAGE == 2) { const bf16_t* cm = (const bf16_t*)(F.ws + WS_S5TAB + (size_t)layer * S5TAB_L + S5TAB_F);
#pragma unroll
        for (int gg = 0; gg < 2; ++gg)
#pragma unroll
            for (int ks = 0; ks < 4; ++ks) cf[gg][ks] = *(const bf16x8*)(cm + ((size_t)((2 * F.wave + gg) * 16 + (F.lane & 15))) * 128 + 32 * ks + 8 * (F.lane >> 4)); }
    __syncthreads();
    for (int lb = 0; lb < 4; ++lb) {
        for (int li = 0; li < 16; ++li) { const int l = lb * 16 + li;
            float uu[16];
#pragma unroll
            for (int q = 0; q < 4; ++q) { const f32x4 v = *(const LAS f32x4*)(us + l * 256 + g * 16 + 4 * q); uu[4 * q] = v[0]; uu[4 * q + 1] = v[1]; uu[4 * q + 2] = v[2]; uu[4 * q + 3] = v[3]; }
            float b0r = 0.f, b0i = 0.f, b1r = 0.f, b1i = 0.f;
#pragma unroll
            for (int p = 0; p < 16; ++p) { b0r += bb0[2 * p] * uu[p]; b0i += bb0[2 * p + 1] * uu[p]; b1r += bb1[2 * p] * uu[p]; b1i += bb1[2 * p + 1] * uu[p]; }
            { const float nr = a0r * h0r - a0i * h0i + b0r, ni = a0r * h0i + a0i * h0r + b0i; h0r = nr; h0i = ni; }
            { const float nr = a1r * h1r - a1i * h1i + b1r, ni = a1r * h1i + a1i * h1r + b1i; h1r = nr; h1i = ni; }
            if (STAGE == 2) { LAS bf16_t* hp = Hs + li * 2056 + g * 128; hp[n0] = f2bf(h0r); hp[64 + n0] = f2bf(h0i); hp[n0 + 32] = f2bf(h1r); hp[96 + n0] = f2bf(h1i); }
        }
        if (STAGE == 2) {
            __syncthreads();
            bf16_t* YS = (bf16_t*)(F.ws + WS_MOE + YSG_OFF);
#pragma unroll
            for (int gg = 0; gg < 2; ++gg) { const int gq = 2 * F.wave + gg; f32x4 acc = (f32x4){0.f, 0.f, 0.f, 0.f};
#pragma unroll
                for (int ks = 0; ks < 4; ++ks) { const bf16x8 a = *(const LAS bf16x8*)(Hs + (F.lane & 15) * 2056 + gq * 128 + 32 * ks + 8 * (F.lane >> 4));
                    acc = __builtin_amdgcn_mfma_f32_16x16x32_bf16(a, cf[gg][ks], acc, 0, 0, 0); }
                const int ch = gq * 16 + (F.lane & 15); const float dsk = F.in[I_SD][layer * 256 + ch];
#pragma unroll
                for (int i = 0; i < 4; ++i) { const int l = lb * 16 + 4 * (F.lane >> 4) + i; const float y = acc[i] + dsk * us[l * 256 + ch];
                    YS[(T0 + l) * 256 + ch] = f2bf(gelu_tanh(y)); } }
            __syncthreads();
        }
    }
    if (STAGE == 1) { ST[gn0 * 2] = h0r; ST[gn0 * 2 + 1] = h0i; ST[gn1 * 2] = h1r; ST[gn1 * 2 + 1] = h1i; }
}
__device__ __forceinline__ void item_s5_carry(const Frame& F_, int layer, int b) { Frame F = relocal(F_);
    const float* tab = (const float*)(F.ws + WS_S5TAB + (size_t)layer * S5TAB_L) + 2048;
    float* ST = (float*)(F.ws + WS_S5ST) + (size_t)b * 64 * 2048;
#pragma unroll
    for (int q = 0; q < 2; ++q) { const int gn = F.tid + 512 * q; const float pr = tab[gn * 2], pi = tab[gn * 2 + 1]; float hr = 0.f, hi = 0.f;
        for (int c = 0; c < 64; ++c) { float* p = ST + (size_t)c * 2048 + gn * 2; const float tr = p[0], ti = p[1]; p[0] = hr; p[1] = hi;
            const float nr = pr * hr - pi * hi + tr, ni = pr * hi + pi * hr + ti; hr = nr; hi = ni; } }
}

constexpr int RW_R = 0, RW_K = 16384, RW_V = 32768, RW_W = 49152, RW_A = 65536, RW_B = 81920, RW_TW = 98304, RW_DA = 106496, RW_O = 98304, RW_SG = 114688, RW_BON = 131072;
template <int STAGE> __device__ __forceinline__ void rwkv_prep(const Frame& F_, int layer, int b, int h, int c) { Frame F = relocal(F_);
    const bf16_t* U = (const bf16_t*)(F.ws + WS_U);
    const int l0 = c * 64; const size_t T0 = (size_t)b * SEQ + l0;
    LAS float* Rr = (LAS float*)(F.lds + RW_R); LAS float* Kk = (LAS float*)(F.lds + RW_K); LAS float* Vv = (LAS float*)(F.lds + RW_V); LAS float* Ww = (LAS float*)(F.lds + RW_W);
    LAS float* Aa = (LAS float*)(F.lds + RW_A); LAS float* Bb = (LAS float*)(F.lds + RW_B); LAS float* TW = (LAS float*)(F.lds + RW_TW); LAS float* DA = (LAS float*)(F.lds + RW_DA);
    LAS float* SG = (LAS float*)(F.lds + RW_SG); LAS float* BON = (LAS float*)(F.lds + RW_BON);
    const float* mu = F.in[I_RMU] + layer * 896;
    { const int tok = F.tid >> 3, p8 = F.tid & 7; const bool first = (l0 + tok == 0);
      const bf16_t* cur = U + (T0 + tok) * NINP + UR; const bf16_t* prv = cur - NINP;
#pragma unroll
      for (int sec = 0; sec < 3; ++sec) { const int co = sec * 256 + h * 64 + 8 * p8; float a[8], pq[8]; unpack8(*(const u32x4*)(cur + co), a);
          if (first) {
#pragma unroll
              for (int j = 0; j < 8; ++j) pq[j] = 0.f; } else unpack8(*(const u32x4*)(prv + co), pq);
          LAS float* dst = (sec == 0 ? Rr : sec == 1 ? Kk : Vv) + tok * 64 + 8 * p8;
#pragma unroll
          for (int j = 0; j < 8; ++j) dst[j] = a[j] + mu[co + j] * (pq[j] - a[j]); }
#pragma unroll
      for (int q = 0; q < 2; ++q) { const int co = 768 + 16 * p8 + 8 * q; float a[8], pq[8]; unpack8(*(const u32x4*)(cur + co), a);
          if (first) {
#pragma unroll
              for (int j = 0; j < 8; ++j) pq[j] = 0.f; } else unpack8(*(const u32x4*)(prv + co), pq);
#pragma unroll
          for (int j = 0; j < 8; ++j) { const float s = a[j] + mu[co + j] * (pq[j] - a[j]); const int cc = co - 768 + j;
              if (cc < 32) TW[tok * 32 + cc] = tanhf_(s); else if (cc < 64) DA[tok * 32 + cc - 32] = s; else SG[tok * 64 + cc - 64] = sigmoidf_(s); } } }
    __syncthreads();
    { const int j = F.lane, tq = F.wave, ch = h * 64 + j;
      float w2c[32], a2c[32];
#pragma unroll
      for (int i = 0; i < 32; ++i) { w2c[i] = F.in[I_RW2][((size_t)layer * 32 + i) * 256 + ch]; a2c[i] = F.in[I_RA2][((size_t)layer * 32 + i) * 256 + ch]; }
      const float w0 = F.in[I_RW0][layer * 256 + ch], a0 = F.in[I_RA0][layer * 256 + ch], kkw = F.in[I_RKK][layer * 256 + ch], kaw = F.in[I_RKA][layer * 256 + ch], rk = F.in[I_RRK][layer * 256 + ch];
      for (int i8 = 0; i8 < 8; ++i8) { const int t = tq + 8 * i8;
          float wl = w0, al = a0;
#pragma unroll
          for (int i = 0; i < 32; i += 4) { const f32x4 tv = *(const LAS f32x4*)(TW + t * 32 + i), dv = *(const LAS f32x4*)(DA + t * 32 + i);
              wl += tv[0] * w2c[i] + tv[1] * w2c[i + 1] + tv[2] * w2c[i + 2] + tv[3] * w2c[i + 3]; al += dv[0] * a2c[i] + dv[1] * a2c[i + 1] + dv[2] * a2c[i + 2] + dv[3] * a2c[i + 3]; }
          const float wlog = -softplusf_(-wl) - 0.5f; const float dec = __expf(-__expf(wlog)); const float a = sigmoidf_(al);
          const float kraw = Kk[t * 64 + j]; const float kkv = kraw * kkw; const float ss = wave_sum(kkv * kkv);
          const float kkn = kkv * rsqrtf(fmaxf(ss, 1e-24f)); const float kp = kraw * (1.0f + (a - 1.0f) * kaw);
          Ww[t * 64 + j] = dec; Kk[t * 64 + j] = kp; Aa[t * 64 + j] = -kkn; Bb[t * 64 + j] = kkn * a;
          if (STAGE == 3) { const float bo = wave_sum(Rr[t * 64 + j] * kp * rk); if (j == 0) BON[t] = bo; } } }
    __syncthreads();
}
__device__ __forceinline__ void item_rwkv1(const Frame& F_, int layer, int item) { Frame F = relocal(F_);
    const int b = item >> 8, h = (item >> 6) & 3, c = item & 63;
    rwkv_prep<1>(F, layer, b, h, c);
    LAS float* Kk = (LAS float*)(F.lds + RW_K); LAS float* Vv = (LAS float*)(F.lds + RW_V); LAS float* Ww = (LAS float*)(F.lds + RW_W);
    LAS float* Aa = (LAS float*)(F.lds + RW_A); LAS float* Bb = (LAS float*)(F.lds + RW_B);
    const int row = F.tid >> 2, part = F.tid & 3; const bool isU = row < 64;
    float S[16];
#pragma unroll
    for (int e = 0; e < 16; ++e) S[e] = (!isU && (16 * part + e == row - 64)) ? 1.0f : 0.0f;
    for (int t = 0; t < 64; ++t) {
        float a[16], bq[16], w[16], k[16];
#pragma unroll
        for (int q = 0; q < 4; ++q) { const f32x4 va = *(const LAS f32x4*)(Aa + t * 64 + 16 * part + 4 * q), vb = *(const LAS f32x4*)(Bb + t * 64 + 16 * part + 4 * q),
                                                  vw = *(const LAS f32x4*)(Ww + t * 64 + 16 * part + 4 * q), vk = *(const LAS f32x4*)(Kk + t * 64 + 16 * part + 4 * q);
#pragma unroll
            for (int j = 0; j < 4; ++j) { a[4 * q + j] = va[j]; bq[4 * q + j] = vb[j]; w[4 * q + j] = vw[j]; k[4 * q + j] = vk[j]; } }
        const float vr = isU ? Vv[t * 64 + row] : 0.0f;
        float sa = 0.f;
#pragma unroll
        for (int e = 0; e < 16; ++e) sa += S[e] * a[e];
        sa = sum4(sa);
#pragma unroll
        for (int e = 0; e < 16; ++e) S[e] = S[e] * w[e] + sa * bq[e] + vr * k[e];
    }
    const size_t ci = (size_t)(b * 4 + h) * 64 + c;
    if (isU) { float* dst = (float*)(F.ws + WS_MOE + RW_U) + ci * 4096 + row * 64 + 16 * part;
#pragma unroll
        for (int q = 0; q < 4; ++q) *(f32x4*)(dst + 4 * q) = (f32x4){S[4 * q], S[4 * q + 1], S[4 * q + 2], S[4 * q + 3]}; }
    else { const int i = row - 64; const int pos = 32 * (i >> 5) + 8 * ((i >> 2) & 3) + 4 * ((i >> 4) & 1) + (i & 3);
        bf16_t* dst = (bf16_t*)(F.ws + WS_MOE + RW_PT) + ci * 4096 + pos;
#pragma unroll
        for (int e = 0; e < 16; ++e) dst[(16 * part + e) * 64] = f2bf(S[e]); }
}
__device__ __forceinline__ void item_rwkv_carry(const Frame& F_, int item) { Frame F = relocal(F_);
    const int bh = item * 2 + (F.wave >> 2), nt = F.wave & 3, r = F.lane & 15, g = F.lane >> 4;
    const bf16_t* PT = (const bf16_t*)(F.ws + WS_MOE + RW_PT); const float* Uc = (const float*)(F.ws + WS_MOE + RW_U); float* Ss = (float*)(F.ws + WS_MOE + RW_S);
    f32x4 acc[4];
#pragma unroll
    for (int m = 0; m < 4; ++m) acc[m] = (f32x4){0.f, 0.f, 0.f, 0.f};
    for (int c = 0; c < 64; ++c) { const size_t ci = (size_t)bh * 64 + c;
        bf16x8 af[4][2]; f32x4 cin[4];
#pragma unroll
        for (int m = 0; m < 4; ++m) { cin[m] = *(const f32x4*)(Uc + ci * 4096 + (16 * nt + r) * 64 + 16 * m + 4 * g);
#pragma unroll
            for (int s = 0; s < 2; ++s) af[m][s] = *(const bf16x8*)(PT + ci * 4096 + (16 * m + r) * 64 + 32 * s + 8 * g); }
#pragma unroll
        for (int m = 0; m < 4; ++m) *(f32x4*)(Ss + ci * 4096 + (16 * nt + r) * 64 + 16 * m + 4 * g) = acc[m];
        bf16x8 bfr[2];
#pragma unroll
        for (int s = 0; s < 2; ++s) { u32x4 w; w.x = pk2(acc[2 * s][0], acc[2 * s][1]); w.y = pk2(acc[2 * s][2], acc[2 * s][3]); w.z = pk2(acc[2 * s + 1][0], acc[2 * s + 1][1]); w.w = pk2(acc[2 * s + 1][2], acc[2 * s + 1][3]);
            bfr[s] = __builtin_bit_cast(bf16x8, w); }
#pragma unroll
        for (int m = 0; m < 4; ++m) { acc[m] = __builtin_amdgcn_mfma_f32_16x16x32_bf16(af[m][0], bfr[0], cin[m], 0, 0, 0);
            acc[m] = __builtin_amdgcn_mfma_f32_16x16x32_bf16(af[m][1], bfr[1], acc[m], 0, 0, 0); }
    }
}
__device__ __forceinline__ void item_rwkv3(const Frame& F_, int layer, int item) { Frame F = relocal(F_);
    const int b = item >> 8, h = (item >> 6) & 3, c = item & 63; const size_t T0 = (size_t)b * SEQ + c * 64;
    rwkv_prep<3>(F, layer, b, h, c);
    LAS float* Rr = (LAS float*)(F.lds + RW_R); LAS float* Kk = (LAS float*)(F.lds + RW_K); LAS float* Vv = (LAS float*)(F.lds + RW_V); LAS float* Ww = (LAS float*)(F.lds + RW_W);
    LAS float* Aa = (LAS float*)(F.lds + RW_A); LAS float* Bb = (LAS float*)(F.lds + RW_B); LAS float* Oo = (LAS float*)(F.lds + RW_O);
    LAS float* SG = (LAS float*)(F.lds + RW_SG); LAS float* BON = (LAS float*)(F.lds + RW_BON);
    { const int row = F.tid >> 3, part = F.tid & 7; const size_t ci = (size_t)(b * 4 + h) * 64 + c;
      const float* sp = (const float*)(F.ws + WS_MOE + RW_S) + ci * 4096 + row * 64 + 8 * part;
      float S[8]; { const f32x4 x = *(const f32x4*)sp, y = *(const f32x4*)(sp + 4); S[0] = x[0]; S[1] = x[1]; S[2] = x[2]; S[3] = x[3]; S[4] = y[0]; S[5] = y[1]; S[6] = y[2]; S[7] = y[3]; }
      for (int t = 0; t < 64; ++t) {
          float a[8], bq[8], w[8], k[8], rr[8];
#pragma unroll
          for (int q = 0; q < 2; ++q) { const int o = t * 64 + 8 * part + 4 * q; const f32x4 va = *(const LAS f32x4*)(Aa + o), vb = *(const LAS f32x4*)(Bb + o), vw = *(const LAS f32x4*)(Ww + o), vk = *(const LAS f32x4*)(Kk + o), vr4 = *(const LAS f32x4*)(Rr + o);
#pragma unroll
              for (int j = 0; j < 4; ++j) { a[4 * q + j] = va[j]; bq[4 * q + j] = vb[j]; w[4 * q + j] = vw[j]; k[4 * q + j] = vk[j]; rr[4 * q + j] = vr4[j]; } }
          const float vr = Vv[t * 64 + row];
          float sa = 0.f;
#pragma unroll
          for (int e = 0; e < 8; ++e) sa += S[e] * a[e];
          sa = sum8(sa);
          float o = 0.f;
#pragma unroll
          for (int e = 0; e < 8; ++e) { S[e] = S[e] * w[e] + sa * bq[e] + vr * k[e]; o += S[e] * rr[e]; }
          o = sum8(o);
          if (part == 0) Oo[t * 64 + row] = o;
      } }
    __syncthreads();
    { const int j = F.lane, tq = F.wave, ch = h * 64 + j;
      float g2c[64];
#pragma unroll
      for (int i = 0; i < 64; ++i) g2c[i] = F.in[I_RG2][((size_t)layer * 64 + i) * 256 + ch];
      const float lw = F.in[I_RLNW][layer * 256 + ch], lb = F.in[I_RLNB][layer * 256 + ch];
      bf16_t* Y = (bf16_t*)(F.ws + WS_H);
      for (int i8 = 0; i8 < 8; ++i8) { const int t = tq + 8 * i8;
          const float o = Oo[t * 64 + j]; const float mean = wave_sum(o) * (1.0f / 64.0f); const float d = o - mean; const float var = wave_sum(d * d) * (1.0f / 64.0f);
          float on = d * rsqrtf(var + 64e-5f) * lw + lb; on += BON[t] * Vv[t * 64 + j];
          float gg = 0.f;
#pragma unroll
          for (int i = 0; i < 64; i += 4) { const f32x4 sv = *(const LAS f32x4*)(SG + t * 64 + i); gg += sv[0] * g2c[i] + sv[1] * g2c[i + 1] + sv[2] * g2c[i + 2] + sv[3] * g2c[i + 3]; }
          Y[(T0 + t) * DM + 256 + ch] = f2bf(on * gg); } }
}

constexpr int DS_SEL = 131072, DS_HIST = 135168, DS_BKT = 143360, DS_BIAS = 143872;
__device__ __forceinline__ unsigned fkey(float f) { const unsigned u = __float_as_uint(f); return (u & 0x80000000u) ? ~u : (u | 0x80000000u); }
__device__ __forceinline__ void item_dsa(const Frame& F_, int layer, int item) { Frame F = relocal(F_);
    const bf16_t* U = (const bf16_t*)(F.ws + WS_U); const bf16_t* KI = (const bf16_t*)(F.ws + WS_KIDX);
    const bf16_t* Kb = (const bf16_t*)(F.ws + WS_K); const bf16_t* Vb = (const bf16_t*)(F.ws + WS_V);
    const int b = item & 3, qg = 511 - (item >> 2); const size_t TB = (size_t)b * SEQ, T0 = TB + qg * 8;
    LAS float* sc = (LAS float*)F.lds; LAS unsigned short* selall = (LAS unsigned short*)(F.lds + DS_SEL); LAS unsigned* histall = (LAS unsigned*)(F.lds + DS_HIST);
    LAS int* bkt = (LAS int*)(F.lds + DS_BKT); LAS float* biasT = (LAS float*)(F.lds + DS_BIAS);
    if (F.tid < 128) { const int n = F.tid; int bk = n; if (n >= 16) { const float lr = logf((float)n / 16.0f) / 2.0794415416798357f; bk = 16 + (int)(lr * 16.0f); bk = bk < 31 ? bk : 31; } bkt[n] = bk; biasT[n] = F.in[I_RELB][n]; }
    const int lane = F.lane, hh = lane >> 5;
    {
        bf16x8 af[2][2]; float wq[2][2][8];
        { const int r = lane & 31, q4 = 2 * ((r >> 2) & 1) + (r >> 4), head = 4 * ((r >> 3) & 1) + (r & 3);
#pragma unroll
          for (int mt = 0; mt < 2; ++mt)
#pragma unroll
              for (int ks = 0; ks < 2; ++ks) af[mt][ks] = *(const bf16x8*)(U + (T0 + 4 * mt + q4) * NINP + UC + 384 + head * 32 + 16 * ks + 8 * hh); }
#pragma unroll
        for (int mt = 0; mt < 2; ++mt)
#pragma unroll
            for (int q2 = 0; q2 < 2; ++q2) { float f[8]; unpack8(*(const u32x4*)(U + (T0 + 4 * mt + 2 * hh + q2) * NINP + UC + 672), f);
#pragma unroll
                for (int hd = 0; hd < 8; ++hd) wq[mt][q2][hd] = f[hd]; }
        const int ntile = (qg * 8 + 8 + 31) >> 5;
        for (int kt = F.wave; kt < ntile; kt += 8) {
            const int key = kt * 32 + (lane & 31);
            const bf16x8 b0 = *(const bf16x8*)(KI + (TB + key) * 32 + 8 * hh), b1 = *(const bf16x8*)(KI + (TB + key) * 32 + 16 + 8 * hh);
#pragma unroll
            for (int mt = 0; mt < 2; ++mt) { f32x16 acc;
#pragma unroll
                for (int i = 0; i < 16; ++i) acc[i] = 0.f;
                acc = __builtin_amdgcn_mfma_f32_32x32x16_bf16(af[mt][0], b0, acc, 0, 0, 0);
                acc = __builtin_amdgcn_mfma_f32_32x32x16_bf16(af[mt][1], b1, acc, 0, 0, 0);
#pragma unroll
                for (int q2 = 0; q2 < 2; ++q2) { float s = 0.f;
#pragma unroll
                    for (int hd = 0; hd < 8; ++hd) s += fmaxf(acc[8 * q2 + hd], 0.f) * wq[mt][q2][hd];
                    const int qi = 4 * mt + 2 * hh + q2;
                    sc[qi * 4096 + key] = (key <= qg * 8 + qi) ? s : -INFINITY; } }
        }
    }
    __syncthreads();
    const int qi = F.wave, tq = qg * 8 + qi, n = tq + 1;
    LAS float* scq = sc + qi * 4096; LAS unsigned short* sel = selall + qi * 256; LAS unsigned* hist = histall + qi * 256;
    int nsel;
    if (n <= 256) { nsel = n; for (int j = lane; j < 256; j += 64) sel[j] = (unsigned short)(j < n ? j : 0); }
    else {
        nsel = 256;
        const int R = (n + 63) >> 6;
        unsigned prefix = 0u; int need = 256; unsigned neq = 0u;
        for (int p = 0; p < 4; ++p) { const int shift = 24 - 8 * p;
            *(LAS u32x4*)(hist + 4 * lane) = (u32x4){0u, 0u, 0u, 0u};
            for (int i = 0; i < R; ++i) { const int j = lane + 64 * i; if (j < n) { const unsigned u = fkey(scq[j]);
                if (p == 0 || (u >> (shift + 8)) == prefix) atomicAdd((unsigned*)(hist + ((u >> shift) & 255u)), 1u); } }
            const u32x4 hv = *(const LAS u32x4*)(hist + 4 * lane);
            const unsigned tot = hv.x + hv.y + hv.z + hv.w;
            unsigned incl = tot;
#pragma unroll
            for (int o = 1; o < 64; o <<= 1) { const unsigned t = shdown_u(incl, o); if (lane + o < 64) incl += t; }
            const unsigned above = incl - tot;
            int fb = -1; unsigned fabove = 0u, feq = 0u; unsigned cum = above;
            { const unsigned hq[4] = {hv.x, hv.y, hv.z, hv.w};
#pragma unroll
              for (int q = 3; q >= 0; --q) { if (fb < 0 && cum < (unsigned)need && (unsigned)need <= cum + hq[q]) { fb = 4 * lane + q; fabove = cum; feq = hq[q]; } cum += hq[q]; } }
            const unsigned long long m = __ballot(fb >= 0);
            const int src = (int)__ffsll((long long)m) - 1;
            const int bin = shidx_i(fb, src); const unsigned ab = (unsigned)shidx_i((int)fabove, src); neq = (unsigned)shidx_i((int)feq, src);
            need -= (int)ab; prefix = (prefix << 8) | (unsigned)bin;
        }
        const int ngt = 256 - need;
        int base_gt = 0, base_eq = 0;
        for (int i = 0; i < R; ++i) { const int j = lane + 64 * i; const unsigned u = (j < n) ? fkey(scq[j]) : 0u;
            const bool gt = (j < n) && (u > prefix), eq = (j < n) && (u == prefix);
            const unsigned long long mg = __ballot(gt), me = __ballot(eq); const unsigned long long lt = (1ull << lane) - 1ull;
            if (gt) sel[base_gt + __popcll(mg & lt)] = (unsigned short)j;
            if (eq) { const int rk = base_eq + __popcll(me & lt); if (rk < need) sel[ngt + rk] = (unsigned short)j; }
            base_gt += __popcll(mg); base_eq += __popcll(me); }
        (void)neq;
    }
    const int nt16 = (nsel + 15) >> 4, r16 = lane & 15, g4 = lane >> 4;
    bf16x8 qf[2];
#pragma unroll
    for (int s = 0; s < 2; ++s) { u32x4 z = (u32x4){0u, 0u, 0u, 0u}; if (r16 < 4) z = *(const u32x4*)(U + (T0 + qi) * NINP + UC + r16 * 64 + 32 * s + 8 * g4); qf[s] = __builtin_bit_cast(bf16x8, z); }
    float lg[16][4]; float mx = -INFINITY;
#pragma unroll
    for (int m = 0; m < 16; ++m) {
        if (m < nt16) {
            const int key = sel[16 * m + r16];
            const bf16x8 a0 = *(const bf16x8*)(Kb + (TB + key) * 64 + 8 * g4), a1 = *(const bf16x8*)(Kb + (TB + key) * 64 + 32 + 8 * g4);
            f32x4 acc = (f32x4){0.f, 0.f, 0.f, 0.f};
            acc = __builtin_amdgcn_mfma_f32_16x16x32_bf16(a0, qf[0], acc, 0, 0, 0);
            acc = __builtin_amdgcn_mfma_f32_16x16x32_bf16(a1, qf[1], acc, 0, 0, 0);
#pragma unroll
            for (int i = 0; i < 4; ++i) { const int j = 16 * m + 4 * g4 + i; const int kj = sel[j]; const int dist = tq - kj;
                const int bk = dist < 128 ? bkt[dist < 0 ? 0 : dist] : 31;
                const float v = (j < nsel) ? acc[i] * 0.125f + biasT[bk * 4 + (r16 & 3)] : -INFINITY;
                lg[m][i] = v; mx = fmaxf(mx, v); }
        } else {
#pragma unroll
            for (int i = 0; i < 4; ++i) lg[m][i] = -INFINITY;
        }
    }
    mx = fmaxf(mx, shx(mx, 16)); mx = fmaxf(mx, shx(mx, 32));
    float sm = 0.f;
    LAS float* Pw = scq;
#pragma unroll
    for (int m = 0; m < 16; ++m) { if (m < nt16) {
#pragma unroll
        for (int i = 0; i < 4; ++i) { const float p = __expf(lg[m][i] - mx); sm += p; if (r16 < 4) Pw[(16 * m + 4 * g4 + i) * 4 + r16] = p; } } }
    sm += shx(sm, 16); sm += shx(sm, 32);
    if (lane < 4) Pw[1024 + lane] = 1.0f / sm;
    const int kg = lane >> 3, dc = lane & 7;
    float o[4][8];
#pragma unroll
    for (int h = 0; h < 4; ++h)
#pragma unroll
        for (int d = 0; d < 8; ++d) o[h][d] = 0.f;
    for (int i = 0; i < 2 * nt16; ++i) { const int j = 8 * i + kg; const int key = sel[j];
        float vv[8]; unpack8(*(const u32x4*)(Vb + (TB + key) * 64 + 8 * dc), vv);
        const f32x4 p4 = *(const LAS f32x4*)(Pw + 4 * j);
#pragma unroll
        for (int h = 0; h < 4; ++h)
#pragma unroll
            for (int d = 0; d < 8; ++d) o[h][d] += p4[h] * vv[d]; }
#pragma unroll
    for (int h = 0; h < 4; ++h)
#pragma unroll
        for (int d = 0; d < 8; ++d) { float v = o[h][d]; v += shx(v, 8); v += shx(v, 16); v += shx(v, 32); o[h][d] = v; }
    if (kg == 0) { bf16_t* Y = (bf16_t*)(F.ws + WS_H) + (T0 + qi) * DM + 512 + 8 * dc;
#pragma unroll
        for (int h = 0; h < 4; ++h) { const float inv = Pw[1024 + h];
            u32x4 w; w.x = pk2(o[h][0] * inv, o[h][1] * inv); w.y = pk2(o[h][2] * inv, o[h][3] * inv); w.z = pk2(o[h][4] * inv, o[h][5] * inv); w.w = pk2(o[h][6] * inv, o[h][7] * inv);
            *(u32x4*)(Y + h * 64) = w; } }
}

__device__ __forceinline__ void phase_router(const Frame& F_, int layer) { Frame F = relocal(F_);
    const float* X = (const float*)(F.ws + WS_X); bf16_t* H2 = (bf16_t*)(F.ws + WS_H);
    const float* nw = F.in[I_NORM2] + (size_t)layer * DM; const float* WE = F.in[I_WRE] + (size_t)layer * DM * 32; const float* WG = F.in[I_WRG] + (size_t)layer * DM * 4;
    LAS float* lgs = (LAS float*)F.lds;
    LAS int* es = (LAS int*)(F.lds + 10240);
    LAS int* lr = (LAS int*)(F.lds + 10752);
    LAS float* wsl = (LAS float*)(F.lds + 11264);
    for (int blk = F.bid; blk < NTOK / 64; blk += F.G) {
        __syncthreads();
        const int tl = F.tid >> 3, og = F.tid & 7; const size_t t = (size_t)blk * 64 + tl; const float* xr = X + t * DM;
        float ss = 0.f;
#pragma unroll 8
        for (int c = 128 * og; c < 128 * og + 128; c += 4) { const f32x4 v = *(const f32x4*)(xr + c); ss += v[0] * v[0] + v[1] * v[1] + v[2] * v[2] + v[3] * v[3]; }
        ss = sum8(ss);
        const float rstd = rsqrtf(ss * (1.0f / DM) + 1e-6f);
        f32x4 ae = (f32x4){0.f, 0.f, 0.f, 0.f}; float ag = 0.f;
        for (int c = 0; c < DM; c += 4) { const f32x4 v = *(const f32x4*)(xr + c), wv = *(const f32x4*)(nw + c); const f32x4 hv = v * rstd * wv;
            if (((c >> 2) & 7) == og) { u32x2 o; o.x = pk2(hv[0], hv[1]); o.y = pk2(hv[2], hv[3]); *(u32x2*)(H2 + t * DM + c) = o; }
#pragma unroll
            for (int i = 0; i < 4; ++i) { const f32x4 w4 = *(const f32x4*)(WE + (size_t)(c + i) * 32 + 4 * og); ae += hv[i] * w4; ag += hv[i] * WG[(size_t)(c + i) * 4 + (og & 3)]; } }
#pragma unroll
        for (int i = 0; i < 4; ++i) lgs[tl * 40 + 4 * og + i] = ae[i] + F.in[I_BRE][layer * 32 + 4 * og + i];
        if (og < 4) lgs[tl * 40 + 32 + og] = ag + F.in[I_BRG][layer * 4 + og];
        __syncthreads();
        if (F.tid < 64) { LAS float* l = lgs + F.tid * 40;
            int gs = 0; float gm = l[32];
#pragma unroll
            for (int j = 1; j < 4; ++j) if (l[32 + j] > gm) { gm = l[32 + j]; gs = j; }
            float den = 0.f;
#pragma unroll
            for (int j = 0; j < 4; ++j) den += __expf(l[32 + j] - gm);
            const float gate = 1.0f / den;
            int i1 = 0; float v1 = l[gs * 8];
#pragma unroll
            for (int j = 1; j < 8; ++j) if (l[gs * 8 + j] > v1) { v1 = l[gs * 8 + j]; i1 = j; }
            int i2 = -1; float v2 = -INFINITY;
#pragma unroll
            for (int j = 0; j < 8; ++j) if (j != i1 && l[gs * 8 + j] > v2) { v2 = l[gs * 8 + j]; i2 = j; }
            const float e2 = __expf(v2 - v1); const float p1 = 1.0f / (1.0f + e2);
            es[F.tid * 2] = gs * 8 + i1; es[F.tid * 2 + 1] = gs * 8 + i2; wsl[F.tid * 2] = p1 * gate; wsl[F.tid * 2 + 1] = (1.0f - p1) * gate; }
        __syncthreads();
        if (F.tid < 32) { int cnt = 0; for (int i = 0; i < 128; ++i) if (es[i] == F.tid) lr[i] = cnt++;
            if (cnt) { const int base = (int)__hip_atomic_fetch_add(F.ctl + CW_CNT + layer * 32 + F.tid, (unsigned)cnt, __ATOMIC_RELAXED, __HIP_MEMORY_SCOPE_AGENT);
                for (int i = 0; i < 128; ++i) if (es[i] == F.tid) lr[i] += base; } }
        __syncthreads();
        if (F.tid < 64) { int* rt = (int*)(F.ws + WS_ROUTE) + ((size_t)blk * 64 + F.tid) * 8;
            rt[0] = es[F.tid * 2]; rt[1] = es[F.tid * 2 + 1]; ((float*)rt)[2] = wsl[F.tid * 2]; ((float*)rt)[3] = wsl[F.tid * 2 + 1]; rt[4] = lr[F.tid * 2]; rt[5] = lr[F.tid * 2 + 1]; }
    }
}
struct CmGU { __device__ __forceinline__ int operator()(int n) const { return 128 * (n >> 8) + (n & 127); } };
__device__ __forceinline__ void phase_moe_convert(const Frame& F_, int layer) { Frame F = relocal(F_);
    bf16_t* WGU = (bf16_t*)(F.ws + WS_MOE + MOE_WGU); bf16_t* WD = (bf16_t*)(F.ws + WS_MOE + MOE_WD);
    for (int t = F.bid; t < 6144; t += F.G) {
        if (t < 4096) { const int e = t >> 7, r = t & 127, kt = r >> 3, nt = r & 7; const bool up = ((nt * 64) & 255) >= 128;
            const float* src = (up ? F.in[I_WUP] : F.in[I_WGATE]) + ((size_t)layer * 32 + e) * 1024 * 256;
            tr_tile(F, src, 256, WGU + (size_t)e * 512 * 1024, 1024, kt * 64, nt * 64, CmGU()); }
        else { const int q = t - 4096, e = q >> 6, r = q & 63, kt = r >> 4, nt = r & 15;
            tr_tile(F, F.in[I_WDOWN] + ((size_t)layer * 32 + e) * 256 * 1024, 1024, WD + (size_t)e * 1024 * 256, 256, kt * 64, nt * 64, CmId()); }
    }
}
__device__ __forceinline__ void phase_gather(const Frame& F_, int layer) { Frame F = relocal(F_);
    LAS int* off = (LAS int*)F.lds;
    __syncthreads();
    if (F.tid == 0) { int acc = 0; for (int e = 0; e < 32; ++e) { off[e] = acc; const int c = (int)__hip_atomic_load(F.ctl + CW_CNT + layer * 32 + e, __ATOMIC_RELAXED, __HIP_MEMORY_SCOPE_AGENT); acc += (c + 255) & ~255; } off[32] = acc; }
    __syncthreads();
    int* tiles = (int*)(F.ws + WS_TILES); int* row_tok = (int*)(F.ws + WS_ROWS); float* row_w = (float*)(F.ws + WS_ROWS) + MAXROWS;
    if (F.bid == 0) { if (F.tid == 0) tiles[0] = off[32] >> 8; if (F.tid < 33) tiles[1 + F.tid] = off[F.tid];
        if (F.tid < 32) for (int rt = off[F.tid] >> 8; rt < (off[F.tid + 1] >> 8); ++rt) tiles[64 + rt] = F.tid; }
    for (int e = F.bid; e < 32; e += F.G) { const int c = (int)__hip_atomic_load(F.ctl + CW_CNT + layer * 32 + e, __ATOMIC_RELAXED, __HIP_MEMORY_SCOPE_AGENT);
        for (int r = off[e] + c + F.tid; r < off[e + 1]; r += NTHR) { row_tok[r] = -1; row_w[r] = 0.f; } }
    const bf16_t* H2 = (const bf16_t*)(F.ws + WS_H); bf16_t* HP = (bf16_t*)(F.ws + WS_U);
    for (int blk = F.bid; blk < NTOK / 64; blk += F.G) {
        for (int q = F.wave; q < 128; q += 8) { const size_t t = (size_t)blk * 64 + (q >> 1); const int slot = q & 1;
            const int* rt = (const int*)(F.ws + WS_ROUTE) + t * 8; const int e = rt[slot], rank = rt[4 + slot]; const float w = ((const float*)rt)[2 + slot];
            const int pos = off[e] + rank;
            const u32x4 a = *(const u32x4*)(H2 + t * DM + 8 * F.lane), bq = *(const u32x4*)(H2 + t * DM + 512 + 8 * F.lane);
            *(u32x4*)(HP + (size_t)pos * DM + 8 * F.lane) = a; *(u32x4*)(HP + (size_t)pos * DM + 512 + 8 * F.lane) = bq;
            if (F.lane == 0) { row_tok[pos] = (int)t * 2 + slot; row_w[pos] = w; } }
    }
}

constexpr int NPH_LAYER = 11, NPHASE = 1 + 2 * NPH_LAYER + 1;
__global__ void __launch_bounds__(NTHR, 2) mk_forward(Params P) {
    extern __shared__ __attribute__((aligned(16))) unsigned char lds_raw[];
    Frame F; F.lds = (LAS unsigned char*)lds_raw; F.tid = threadIdx.x; F.lane = F.tid & 63; F.wave = __builtin_amdgcn_readfirstlane(F.tid >> 6); F.bid = blockIdx.x; F.G = gridDim.x;
    F.in = P.in; F.out = P.out; F.ws = P.ws; F.ctl = (unsigned*)(P.ws + WS_CTL); F.misc = (volatile LAS int*)(F.lds + MISC_OFF);
    if (F.tid < 64) ((LAS unsigned*)(F.lds + MISC_OFF))[F.tid] = 0u;
    __syncthreads();
    const int lo = P.ph_lo, hi = P.ph_hi;
    XcdBarrier bar; bar.bar = F.ctl + CW_BAR; bar.x = 0; bar.st = (volatile LAS unsigned*)(F.lds + MISC_OFF + 16);
    if (hi - lo > 1) bar = xcd_barrier_post(F.ctl + CW_BAR, (volatile LAS unsigned*)(F.lds + MISC_OFF + 16));
#ifndef MK_ONLY
#define MK_ONLY -1
#endif
#define EN(o) (MK_ONLY < 0 || MK_ONLY == (o))
#ifndef MK_ITEM
#define MK_ITEM -1
#endif
#define IT(o) (MK_ITEM < 0 || MK_ITEM == (o))
#define IN(k) (lo <= (k) && (k) < hi)
#define SEAM(k) do { if (IN(k) && IN((k) + 1)) xcd_barrier(bar); } while (0)
    if (EN(100) && IN(0)) { phase_prologue(F); } SEAM(0);
    for (int layer = 0; layer < DEPTH; ++layer) {
        const int pb = 1 + layer * NPH_LAYER;
        if (EN(0) && IN(pb + 0)) { phase_norm(F, layer == 0 ? F.in[I_X] : (const float*)(F.ws + WS_X), layer > 0, F.in[I_NORM1] + (size_t)layer * DM, 0); } SEAM(pb + 0);
        if (EN(1) && IN(pb + 1)) { const Frame F_ = F; Frame F = relocal(F_); pg8::StaticOrder S; S.init((const bf16_t*)(F.ws + WS_H), (const bf16_t*)(F.ws + WS_WIN) + (size_t)layer * NINP * DM, NTOK, NINP, DM, F.G, F.bid);
            pg8::EpiBf16 E{(bf16_t*)(F.ws + WS_U), NINP}; pg8::gemm_phase(F.lds, DM, S, E); } SEAM(pb + 1);
#define QLOOP(qi, n, body) for (;;) { const int it = q_pop(F, layer * 12 + (qi)); if (it >= (n)) break; body; }
        if (EN(2) && IN(pb + 2)) {
            if (IT(0)) QLOOP(0, 256, item_s5<1>(F, layer, it));
            if (IT(1)) QLOOP(1, 1024, item_rwkv1(F, layer, it));
            if (IT(2)) QLOOP(2, 256, item_mamba<1>(F, layer, it));
            if (IT(3)) QLOOP(3, 256, item_kv(F, layer, it));
        } SEAM(pb + 2);
        if (EN(3) && IN(pb + 3)) {
            if (IT(0)) QLOOP(4, 8, item_rwkv_carry(F, it));
            if (IT(1)) QLOOP(5, 16, item_mamba_carry(F, it));
            if (IT(2)) QLOOP(6, 4, item_s5_carry(F, layer, it));
            if (IT(3)) QLOOP(7, 2048, item_dsa(F, layer, it));
        } SEAM(pb + 3);
        if (EN(4) && IN(pb + 4)) {
            if (IT(0)) QLOOP(8, 256, item_s5<2>(F, layer, it));
            if (IT(1)) QLOOP(9, 1024, item_rwkv3(F, layer, it));
            if (IT(2)) QLOOP(10, 256, item_mamba<2>(F, layer, it));
        } SEAM(pb + 4);
        if (EN(5) && IN(pb + 5)) { const Frame F_ = F; Frame F = relocal(F_); pg8::StaticOrder S; S.init((const bf16_t*)(F.ws + WS_MOE + YSG_OFF), (const bf16_t*)(F.ws + WS_GLU) + (size_t)layer * 512 * 256, NTOK, 512, 256, F.G, F.bid);
            pg8::EpiGated<0> E{(bf16_t*)(F.ws + WS_H), DM, 768, F.in[I_SGLUB] + layer * 512, F.in[I_SGLUB] + layer * 512 + 256}; pg8::gemm_phase(F.lds, 256, S, E); } SEAM(pb + 5);
        if (EN(6) && IN(pb + 6)) { const Frame F_ = F; Frame F = relocal(F_); pg8::StaticOrder S; S.init((const bf16_t*)(F.ws + WS_H), (const bf16_t*)(F.ws + WS_WOUT) + (size_t)layer * DM * DM, NTOK, DM, DM, F.G, F.bid);
            pg8::EpiResid E{(float*)(F.ws + WS_X), DM}; pg8::gemm_phase(F.lds, DM, S, E); } SEAM(pb + 6);
        if (EN(7) && IN(pb + 7)) { phase_router(F, layer); phase_moe_convert(F, layer); } SEAM(pb + 7);
        if (EN(8) && IN(pb + 8)) { phase_gather(F, layer); } SEAM(pb + 8);
        if (EN(9) && IN(pb + 9)) { const Frame F_ = F; Frame F = relocal(F_); pg8::MoeOrder S{2, F.G, F.bid, DM, (const char*)(F.ws + WS_U), (const char*)(F.ws + WS_MOE + MOE_WGU), (size_t)512 * 1024 * 2, (const int*)(F.ws + WS_TILES)};
            pg8::EpiGated<1> E{(bf16_t*)(F.ws + WS_H), 256, 0, nullptr, nullptr}; pg8::gemm_phase(F.lds, DM, S, E); } SEAM(pb + 9);
        if (EN(10) && IN(pb + 10)) { const Frame F_ = F; Frame F = relocal(F_); pg8::MoeOrder S{4, F.G, F.bid, 256, (const char*)(F.ws + WS_H), (const char*)(F.ws + WS_MOE + MOE_WD), (size_t)1024 * 256 * 2, (const int*)(F.ws + WS_TILES)};
            pg8::EpiMoeOut E{(bf16_t*)(F.ws + WS_U), (const int*)(F.ws + WS_ROWS), (const float*)(F.ws + WS_ROWS) + MAXROWS}; pg8::gemm_phase(F.lds, 256, S, E); } SEAM(pb + 10);
    }
    if (EN(101) && IN(NPHASE - 1)) { phase_norm(F, (const float*)(F.ws + WS_X), true, F.in[I_FNORM], 2); }
#undef IN
#undef SEAM
}

#ifndef MK_SPLIT
#define MK_SPLIT 0
#endif
extern "C" void kernel_launch(void* const* d_in, const int* in_sizes, int n_in, void* d_out, int out_size, void* d_ws, size_t ws_size, hipStream_t stream) {
    static int grid = 0;
    if (grid == 0) {
        if (n_in != 44 || out_size != NTOK * DM || ws_size < WS_END) { fprintf(stderr, "kernel_launch: unexpected shapes (n_in %d out %d ws %zu need %zu)\n", n_in, out_size, ws_size, (size_t)WS_END); grid = -1; return; }
        int dev = 0, cus = 0;
        if (hipGetDevice(&dev) != hipSuccess || hipDeviceGetAttribute(&cus, hipDeviceAttributeMultiprocessorCount, dev) != hipSuccess) { grid = -1; return; }
        if (hipFuncSetAttribute((const void*)mk_forward, hipFuncAttributeMaxDynamicSharedMemorySize, LDS_BYTES) != hipSuccess) { fprintf(stderr, "kernel_launch: hipFuncSetAttribute failed\n"); grid = -1; return; }
        int per_cu = 0;
        if (hipOccupancyMaxActiveBlocksPerMultiprocessor(&per_cu, (const void*)mk_forward, NTHR, LDS_BYTES) != hipSuccess || per_cu < 1) { fprintf(stderr, "kernel_launch: occupancy query says %d\n", per_cu); }
        (void)hipGetLastError();
        grid = cus;
    }
    if (grid < 0) return;
    hipMemsetAsync((char*)d_ws + WS_CTL, 0, CTL_BYTES, stream);
    Params p{};
    for (int i = 0; i < 44; ++i) p.in[i] = (const float*)d_in[i];
    p.out = (float*)d_out; p.ws = (unsigned char*)d_ws;
#if MK_SPLIT
    for (int ph = 0; ph < NPHASE; ++ph) { p.ph_lo = ph; p.ph_hi = ph + 1; hipLaunchKernelGGL(mk_forward, dim3(grid), dim3(NTHR), LDS_BYTES, stream, p); }
#else
    p.ph_lo = 0; p.ph_hi = NPHASE; hipLaunchKernelGGL(mk_forward, dim3(grid), dim3(NTHR), LDS_BYTES, stream, p);
#endif
}
```

```cpp
#include <hip/hip_runtime.h>
#include <stdint.h>
#include <stdio.h>

#define LAS __attribute__((address_space(3)))
typedef unsigned short bf16_t;
typedef short bf16x8 __attribute__((ext_vector_type(8)));
typedef float f32x4 __attribute__((ext_vector_type(4)));
typedef float f32x2 __attribute__((ext_vector_type(2)));
typedef float f32x16 __attribute__((ext_vector_type(16)));
typedef unsigned u32x4 __attribute__((ext_vector_type(4)));
typedef unsigned u32x2 __attribute__((ext_vector_type(2)));

constexpr int NTOK = 16384, DM = 1024, SEQ = 4096, NBATCH = 4, DEPTH = 2;
constexpr int NIN = 2604, NINP = 2816;
constexpr int UM = 0;
constexpr int UR = 784;
constexpr int UC = 1680;
constexpr int US = 2368;
constexpr int NTHR = 512;
constexpr int LDS_BYTES = 147456;
constexpr int MISC_OFF = LDS_BYTES - 256;

constexpr size_t WS_CTL   = 0;
constexpr size_t CTL_BYTES = 65536;
constexpr size_t WS_X     = WS_CTL + CTL_BYTES;
constexpr size_t WS_H     = WS_X + (size_t)NTOK * DM * 4;
constexpr size_t WS_U     = WS_H + (size_t)NTOK * DM * 2;
constexpr size_t WS_WIN   = WS_U + (size_t)NTOK * NINP * 2;
constexpr size_t WS_WOUT  = WS_WIN + (size_t)2 * NINP * DM * 2;
constexpr size_t WS_GLU   = WS_WOUT + (size_t)2 * DM * DM * 2;
constexpr size_t WS_MOE   = WS_GLU + (size_t)2 * 512 * 256 * 2;
constexpr size_t MOE_WGU  = 0;
constexpr size_t MOE_WD   = (size_t)32 * 512 * 1024 * 2;
constexpr size_t MOE_BYTES = MOE_WD + (size_t)32 * 1024 * 256 * 2;
constexpr size_t RW_PT    = 0;
constexpr size_t RW_U     = (size_t)1024 * 4096 * 2;
constexpr size_t RW_S     = RW_U + (size_t)1024 * 4096 * 4;
constexpr size_t YSG_OFF  = RW_S + (size_t)1024 * 4096 * 4;
static_assert(YSG_OFF + (size_t)NTOK * 256 * 2 <= MOE_BYTES, "alias");
constexpr size_t WS_MST   = WS_MOE + MOE_BYTES;
constexpr size_t WS_MDEC  = WS_MST + (size_t)4 * 64 * 4 * 4096 * 4;
constexpr size_t WS_S5ST  = WS_MDEC + 4096;
constexpr size_t WS_K     = WS_S5ST + (size_t)4 * 64 * 2048 * 4;
constexpr size_t WS_V     = WS_K + (size_t)NTOK * 64 * 2;
constexpr size_t WS_KIDX  = WS_V + (size_t)NTOK * 64 * 2;
constexpr size_t WS_ROUTE = WS_KIDX + (size_t)NTOK * 32 * 2;
constexpr size_t WS_ROWS  = WS_ROUTE + (size_t)NTOK * 32;
constexpr int    MAXROWS  = 49152;
constexpr size_t WS_TILES = WS_ROWS + (size_t)MAXROWS * 8;
constexpr size_t WS_S5TAB = WS_TILES + 4096;
constexpr size_t S5TAB_F  = (size_t)(2048 + 2048 + 32768) * 4;
constexpr size_t S5TAB_L  = S5TAB_F + (size_t)16 * 16 * 128 * 2;
constexpr size_t WS_WRT   = WS_S5TAB + 2 * S5TAB_L;
constexpr size_t WS_END   = WS_WRT + (size_t)2 * 2 * 48 * 1024 * 2;

constexpr int CW_BAR = 0;
constexpr int CW_Q   = 4096;
constexpr int CW_CNT = 8192;

__device__ __forceinline__ float bf2f(bf16_t b) { return __uint_as_float(((unsigned)b) << 16); }
__device__ __forceinline__ bf16_t f2bf(float f) { unsigned u = __float_as_uint(f); u += 0x7FFFu + ((u >> 16) & 1u); return (bf16_t)(u >> 16); }
__device__ __forceinline__ unsigned pk2(float lo, float hi) { return (unsigned)f2bf(lo) | ((unsigned)f2bf(hi) << 16); }
__device__ __forceinline__ unsigned cvt_pk_bf16(float lo, float hi) { unsigned r; asm volatile("v_cvt_pk_bf16_f32 %0, %1, %2" : "=v"(r) : "v"(lo), "v"(hi)); return r; }
__device__ __forceinline__ float sigmoidf_(float x) { return 1.0f / (1.0f + __expf(-x)); }
__device__ __forceinline__ float siluf_(float x) { return x / (1.0f + __expf(-x)); }
__device__ __forceinline__ float tanhf_(float x) { const float e = __expf(2.0f * x); return 1.0f - 2.0f / (e + 1.0f); }
__device__ __forceinline__ float softplusf_(float x) { return fmaxf(x, 0.0f) + log1pf(__expf(-fabsf(x))); }
__device__ __forceinline__ float gelu_tanh(float x) { return 0.5f * x * (1.0f + tanhf_(0.7978845608028654f * (x + 0.044715f * x * x * x))); }
template <int CTRL> __device__ __forceinline__ float dppf(float x) { return __int_as_float(__builtin_amdgcn_update_dpp(0, __float_as_int(x), CTRL, 0xF, 0xF, true)); }
__device__ __forceinline__ float sum4(float x) { x += dppf<0xB1>(x); x += dppf<0x4E>(x); return x; }
__device__ __forceinline__ float sum8(float x) { x = sum4(x); x += dppf<0x141>(x); return x; }
__device__ __forceinline__ float sum16(float x) { x = sum8(x); x += dppf<0x140>(x); return x; }
__device__ __forceinline__ int lane_id_() { int l = (int)__builtin_amdgcn_mbcnt_hi(~0u, __builtin_amdgcn_mbcnt_lo(~0u, 0u)); asm volatile("" : "+v"(l)); return l; }
__device__ __forceinline__ float shx(float x, int o) { return __int_as_float(__builtin_amdgcn_ds_bpermute((lane_id_() ^ o) << 2, __float_as_int(x))); }
__device__ __forceinline__ unsigned shdown_u(unsigned x, int o) { return (unsigned)__builtin_amdgcn_ds_bpermute(((lane_id_() + o) & 63) << 2, (int)x); }
__device__ __forceinline__ int shidx_i(int x, int src) { return __builtin_amdgcn_ds_bpermute(src << 2, x); }
__device__ __forceinline__ float wave_sum(float x) { x = sum16(x); x += shx(x, 16); x += shx(x, 32); return x; }
__device__ __forceinline__ void unpack8(const u32x4 v, float (&f)[8]) {
    f[0] = __uint_as_float(v.x << 16); f[1] = __uint_as_float(v.x & 0xffff0000u); f[2] = __uint_as_float(v.y << 16); f[3] = __uint_as_float(v.y & 0xffff0000u);
    f[4] = __uint_as_float(v.z << 16); f[5] = __uint_as_float(v.z & 0xffff0000u); f[6] = __uint_as_float(v.w << 16); f[7] = __uint_as_float(v.w & 0xffff0000u);
}

#define XB_TMO      128
#define XB_XCNT(j)  (256  + 64 * (j))
#define XB_XSUB(j)  (1280 + 64 * (j))
#define XB_XGEN(j)  (2304 + 64 * (j))
#define XB_TOP      3328
#define XB_TOPGEN   3392
#define XCD_BAR_WORDS 3456
#define XB_SPIN_CAP (1u << 22)
__device__ __forceinline__ unsigned xb_ld(unsigned* p)              { return __hip_atomic_load(p, __ATOMIC_RELAXED, __HIP_MEMORY_SCOPE_AGENT); }
__device__ __forceinline__ unsigned xb_add(unsigned* p, unsigned v) { return __hip_atomic_fetch_add(p, v, __ATOMIC_RELAXED, __HIP_MEMORY_SCOPE_AGENT); }
__device__ __forceinline__ unsigned xb_xcc_id() { return (unsigned)__builtin_amdgcn_s_getreg((3 << 11) | 20) & 0xFu; }
#define XB_SPIN(cond, bar) do { unsigned _sp = 0; while (cond) { __builtin_amdgcn_s_sleep(1); \
    if ((++_sp & 255u) == 0u) { if (xb_ld(&(bar)[XB_TMO])) break; if (_sp > XB_SPIN_CAP) { atomicAdd(&(bar)[XB_TMO], 1u); break; } } } } while (0)
struct XcdBarrier { unsigned* bar; unsigned x; volatile LAS unsigned* st; };
__device__ __forceinline__ XcdBarrier xcd_barrier_post(unsigned* bar, volatile LAS unsigned* st) {
    XcdBarrier b; b.bar = bar; b.x = xb_xcc_id(); b.st = st;
    if (threadIdx.x == 0) (void)xb_add(&bar[XB_XCNT(b.x)], 1u);
    return b;
}
__device__ __forceinline__ void xcd_barrier_complete(unsigned* bar, unsigned x, unsigned& nloc, unsigned& nx) {
    const unsigned G = gridDim.x * gridDim.y * gridDim.z;
    unsigned sum, cnt, mine, sp = 0u;
    for (;;) {
        sum = 0u; cnt = 0u; mine = 0u;
#pragma unroll
        for (unsigned j = 0; j < 16; ++j) { const unsigned c = xb_ld(&bar[XB_XCNT(j)]); sum += c; cnt += (c > 0u) ? 1u : 0u; mine = (j == x) ? c : mine; }
        if (sum == G) break;
        __builtin_amdgcn_s_sleep(1);
        if ((++sp & 255u) == 0u) { if (xb_ld(&bar[XB_TMO])) break; if (sp > XB_SPIN_CAP) { atomicAdd(&bar[XB_TMO], 1u); break; } }
    }
    nloc = mine > 0u ? mine : 1u; nx = cnt > 0u ? cnt : 1u;
}
__device__ __forceinline__ void xcd_barrier(const XcdBarrier& b_) {
    XcdBarrier b = b_; { const unsigned long long v = (unsigned long long)b.bar; unsigned lo = __builtin_amdgcn_readfirstlane((unsigned)v), hi = __builtin_amdgcn_readfirstlane((unsigned)(v >> 32)); asm volatile("" : "+s"(lo), "+s"(hi)); b.bar = (unsigned*)(((unsigned long long)hi << 32) | lo); unsigned xx = __builtin_amdgcn_readfirstlane(b.x); asm volatile("" : "+s"(xx)); b.x = xx; }
    asm volatile("s_waitcnt vmcnt(0)" ::: "memory");
    __syncthreads();
    if (threadIdx.x == 0) {
        unsigned* bar = b.bar;
        __builtin_amdgcn_s_waitcnt(0);
        unsigned nloc = b.st[0], nx = b.st[1];
        if (nloc == 0u) { xcd_barrier_complete(bar, b.x, nloc, nx); b.st[0] = nloc; b.st[1] = nx; }
        const unsigned old = xb_add(&bar[XB_XSUB(b.x)], 1u);
        const unsigned gen = old / nloc;
        if (old + 1u == (gen + 1u) * nloc) {
            __builtin_amdgcn_fence(__ATOMIC_RELEASE, "agent");
            asm volatile("s_waitcnt vmcnt(0)" ::: "memory");
            const unsigned og = xb_add(&bar[XB_TOP], 1u);
            const unsigned tg = og / nx;
            if (og + 1u == (tg + 1u) * nx) xb_add(&bar[XB_TOPGEN], 1u);
            else XB_SPIN(xb_ld(&bar[XB_TOPGEN]) == tg, bar);
            __builtin_amdgcn_fence(__ATOMIC_ACQUIRE, "agent");
            xb_add(&bar[XB_XGEN(b.x)], 1u);
            asm volatile("s_waitcnt vmcnt(0)" ::: "memory");
        } else {
            XB_SPIN(xb_ld(&bar[XB_XGEN(b.x)]) == gen, bar);
            __builtin_amdgcn_fence(__ATOMIC_ACQUIRE, "agent");
            asm volatile("s_waitcnt vmcnt(0)" ::: "memory");
        }
    }
    __syncthreads();
}

namespace pg8 {
constexpr int BM = 256, BK = 64, HALF = 128, HTB = HALF * BK * 2, STAGE_BYTES = 8 * HTB, NXCD = 8, WGM = 8;
__host__ __device__ __forceinline__ int lds_byte(int r, int c) { const int st = (r >> 4) * 2 + (c >> 5), rr = r & 15, cc = c & 31, ob = rr * 64 + cc * 2; return st * 1024 + (ob ^ (((ob >> 9) & 1) << 5)); }
__host__ __device__ __forceinline__ void stage_rc(int b, int& R, int& C) { const int st = b / 1024, sb = b % 1024, swz = sb ^ (((sb >> 9) & 1) << 5); R = (st >> 1) * 16 + swz / 64; C = (st & 1) * 32 + (swz % 64) / 2; }
__host__ __device__ __forceinline__ int perm32(int rho) { const int n = rho >> 4, i = rho & 15; return 8 * (i >> 2) + 4 * n + (i & 3); }
struct Unit { int pm, pn; const char* a; const char* b; };

struct StaticOrder {
    int nM, nN, nwg, G, c, K; const char* A; const char* B;
    __device__ void init(const bf16_t* A_, const bf16_t* B_, int M, int N, int K_, int G_, int c_) { A = (const char*)A_; B = (const char*)B_; K = K_; nM = M / BM; nN = N / BM; nwg = nM * nN; G = G_; c = c_; }
    __device__ bool next(int i, Unit& u) const {
        const long L = (long)i * G + c; if (L >= nwg) return false;
        int wgid = (int)L; { const int q = nwg / NXCD, r = nwg % NXCD, xcd = wgid % NXCD, off = wgid / NXCD; wgid = (xcd < r ? xcd * (q + 1) : r * (q + 1) + (xcd - r) * q) + off; }
        const int nig = WGM * nN, gid = wgid / nig, fm = gid * WGM, gsz = (nM - fm) < WGM ? (nM - fm) : WGM;
        u.pm = fm + ((wgid % nig) % gsz); u.pn = (wgid % nig) / gsz;
        u.a = A + (size_t)u.pm * 256 * K * 2; u.b = B + (size_t)u.pn * 256 * K * 2; return true;
    }
};

template <class Epi, class Sched>
__device__ __forceinline__ void gemm_phase(LAS unsigned char* lds, const int K_, const Sched& S, const Epi& E) {
    int K = K_; asm volatile("" : "+s"(K));
    int tid_ = threadIdx.x; asm volatile("" : "+v"(tid_));
    const int tid = tid_, wid = __builtin_amdgcn_readfirstlane(tid >> 6), lane = tid & 63, wr = wid >> 2, wc = wid & 3, fr = lane & 15, fq = lane >> 4;
    const int nt = K / BK;
    unsigned voffA[2], voffB[2];
#pragma unroll
    for (int i = 0; i < 2; ++i) { int R, C; stage_rc(tid * 16 + i * 8192, R, C); const int Rb = Epi::PERM ? ((R & ~31) + perm32(R & 31)) : R;
        voffA[i] = (unsigned)(R * K + C) * 2u; voffB[i] = (unsigned)(Rb * K + C) * 2u; }
    const size_t kstep = (size_t)(BK * 2);
    const size_t hstep = (size_t)HALF * K * 2;
    const unsigned ldsw = (unsigned)wid * 1024u;
    const int aoff = lds_byte(wr * 64 + fr, fq * 8), boff = lds_byte(wc * 32 + fr, fq * 8);
#define PG8_SA(b, h) (((b) * 2 + (h)) * HTB)
#define PG8_SB(b, h) ((4 + (b) * 2 + (h)) * HTB)
#define PG8_STAGE(bufoff, gbase, voff) do { _Pragma("unroll") for (int _i = 0; _i < 2; ++_i) \
        __builtin_amdgcn_global_load_lds((const unsigned*)((const char*)(gbase) + (voff)[_i]), (LAS unsigned*)(lds + (bufoff) + ldsw + _i * 8192), 16, 0, 0); } while (0)
#define PG8_LDA(dst, b, h) do { _Pragma("unroll") for (int m = 0; m < 4; ++m) _Pragma("unroll") for (int k = 0; k < 2; ++k) dst[m][k] = *(const LAS bf16x8*)(lds + PG8_SA(b, h) + aoff + m * 2048 + k * 1024); } while (0)
#define PG8_LDB(dst, b, h) do { _Pragma("unroll") for (int n = 0; n < 2; ++n) _Pragma("unroll") for (int k = 0; k < 2; ++k) dst[n][k] = *(const LAS bf16x8*)(lds + PG8_SB(b, h) + boff + n * 2048 + k * 1024); } while (0)
#define PG8_MMA(ai, bj, At, Bt) do { __builtin_amdgcn_s_setprio(1); _Pragma("unroll") for (int m = 0; m < 4; ++m) _Pragma("unroll") for (int n = 0; n < 2; ++n) _Pragma("unroll") for (int k = 0; k < 2; ++k) \
        acc[ai][bj][m][n] = __builtin_amdgcn_mfma_f32_16x16x32_bf16(Bt[n][k], At[m][k], acc[ai][bj][m][n], 0, 0, 0); __builtin_amdgcn_s_setprio(0); } while (0)
#define PG8_WAIT_V(n) asm volatile("s_waitcnt vmcnt(" #n ")" ::: "memory")
#define PG8_WAIT_L(n) asm volatile("s_waitcnt lgkmcnt(" #n ")" ::: "memory")
#define PG8_BAR __builtin_amdgcn_s_barrier()
#define PG8_SCHED __builtin_amdgcn_sched_barrier(0)
    Unit cur, nxt; int ui = 0;
    if (!S.next(0, cur)) return;
    f32x4 acc[2][2][4][2];
#pragma unroll
    for (int a = 0; a < 2; ++a)
#pragma unroll
        for (int b = 0; b < 2; ++b)
#pragma unroll
            for (int m = 0; m < 4; ++m)
#pragma unroll
                for (int n = 0; n < 2; ++n) acc[a][b][m][n] = (f32x4){0.f, 0.f, 0.f, 0.f};
    bf16x8 At[4][2], B0[2][2], B1[2][2];
    const char* cA = cur.a; const char* cB = cur.b;
    PG8_STAGE(PG8_SB(0, 0), cB, voffB); PG8_STAGE(PG8_SA(0, 0), cA, voffA); PG8_STAGE(PG8_SB(0, 1), cB + hstep, voffB); PG8_STAGE(PG8_SA(0, 1), cA + hstep, voffA);
    if (wr == 1) PG8_BAR;
    PG8_WAIT_V(4); PG8_BAR;
    PG8_STAGE(PG8_SB(1, 0), cB + kstep, voffB); PG8_STAGE(PG8_SA(1, 0), cA + kstep, voffA); PG8_STAGE(PG8_SB(1, 1), cB + hstep + kstep, voffB);
    PG8_WAIT_V(6); PG8_BAR;
    for (;;) {
        const bool has_next = S.next(ui + 1, nxt);
        const char* nA = has_next ? nxt.a : cA; const char* nB = has_next ? nxt.b : cB;
        for (int t = 0; t < nt; t += 2) {
            const bool last = (t == nt - 2);
            const char* a1 = cA + (size_t)(t + 1) * kstep;
            const char* a2 = last ? nA : cA + (size_t)(t + 2) * kstep; const char* b2 = last ? nB : cB + (size_t)(t + 2) * kstep;
            const char* a3 = a2 + kstep; const char* b3 = b2 + kstep;
            PG8_LDB(B0, 0, 0); PG8_SCHED; PG8_LDA(At, 0, 0); PG8_STAGE(PG8_SA(1, 1), a1 + hstep, voffA);
            PG8_WAIT_L(8); PG8_BAR; PG8_WAIT_L(0); PG8_MMA(0, 0, At, B0); PG8_BAR; PG8_SCHED;
            PG8_LDB(B1, 0, 1); PG8_STAGE(PG8_SB(0, 0), b2, voffB);
            PG8_BAR; PG8_WAIT_L(0); PG8_MMA(0, 1, At, B1); PG8_BAR;
            PG8_LDA(At, 0, 1); PG8_STAGE(PG8_SA(0, 0), a2, voffA);
            PG8_BAR; PG8_WAIT_L(0); PG8_MMA(1, 0, At, B0); PG8_BAR; PG8_SCHED;
            PG8_STAGE(PG8_SB(0, 1), b2 + hstep, voffB);
            PG8_WAIT_V(6); PG8_BAR; PG8_MMA(1, 1, At, B1); PG8_BAR;
            PG8_LDB(B0, 1, 0); PG8_SCHED; PG8_LDA(At, 1, 0); PG8_STAGE(PG8_SA(0, 1), a2 + hstep, voffA);
            PG8_WAIT_L(8); PG8_BAR; PG8_WAIT_L(0); PG8_MMA(0, 0, At, B0); PG8_BAR; PG8_SCHED;
            PG8_LDB(B1, 1, 1); PG8_STAGE(PG8_SB(1, 0), b3, voffB);
            PG8_BAR; PG8_WAIT_L(0); PG8_MMA(0, 1, At, B1); PG8_BAR;
            PG8_LDA(At, 1, 1); PG8_STAGE(PG8_SA(1, 0), a3, voffA);
            PG8_BAR; PG8_WAIT_L(0); PG8_MMA(1, 0, At, B0); PG8_BAR; PG8_SCHED;
            PG8_STAGE(PG8_SB(1, 1), b3 + hstep, voffB);
            PG8_WAIT_V(6); PG8_BAR; PG8_MMA(1, 1, At, B1); PG8_BAR;
        }
        E(acc, cur, wr, wc, fr, fq);
        if (!has_next) break;
#pragma unroll
        for (int a = 0; a < 2; ++a)
#pragma unroll
            for (int b = 0; b < 2; ++b)
#pragma unroll
                for (int m = 0; m < 4; ++m)
#pragma unroll
                    for (int n = 0; n < 2; ++n) acc[a][b][m][n] = (f32x4){0.f, 0.f, 0.f, 0.f};
        cur = nxt; cA = nA; cB = nB; ++ui;
    }
    PG8_WAIT_V(0);
    if (wr == 0) PG8_BAR;
    PG8_BAR;
#undef PG8_SA
#undef PG8_SB
#undef PG8_STAGE
#undef PG8_LDA
#undef PG8_LDB
#undef PG8_MMA
#undef PG8_WAIT_V
#undef PG8_WAIT_L
#undef PG8_BAR
#undef PG8_SCHED
}

struct EpiBf16 {
    static constexpr bool PERM = true;
    bf16_t* O; int ldc;
    __device__ __forceinline__ void operator()(const f32x4 (&acc)[2][2][4][2], const Unit& u, int wr, int wc, int fr, int fq) const {
        const int row0 = u.pm * BM + wr * 64 + fr, col0 = u.pn * BM + wc * 32 + 8 * fq;
#pragma unroll
        for (int ai = 0; ai < 2; ++ai)
#pragma unroll
            for (int m = 0; m < 4; ++m) { bf16_t* rowp = O + (size_t)(row0 + ai * HALF + m * 16) * ldc + col0;
#pragma unroll
                for (int bj = 0; bj < 2; ++bj) { const f32x4 v0 = acc[ai][bj][m][0], v1 = acc[ai][bj][m][1];
                    u32x4 w; w.x = cvt_pk_bf16(v0[0], v0[1]); w.y = cvt_pk_bf16(v0[2], v0[3]); w.z = cvt_pk_bf16(v1[0], v1[1]); w.w = cvt_pk_bf16(v1[2], v1[3]);
                    *(u32x4*)(rowp + bj * HALF) = w; } }
    }
};
struct EpiResid {
    static constexpr bool PERM = false;
    float* C; int ldc;
    __device__ __forceinline__ void operator()(const f32x4 (&acc)[2][2][4][2], const Unit& u, int wr, int wc, int fr, int fq) const {
        const int row0 = u.pm * BM + wr * 64 + fr, col0 = u.pn * BM + wc * 32 + 4 * fq;
#pragma unroll
        for (int ai = 0; ai < 2; ++ai)
#pragma unroll
            for (int m = 0; m < 4; ++m) { float* rowp = C + (size_t)(row0 + ai * HALF + m * 16) * ldc + col0;
#pragma unroll
                for (int bj = 0; bj < 2; ++bj)
#pragma unroll
                    for (int n = 0; n < 2; ++n) { f32x4* p = (f32x4*)(rowp + bj * HALF + n * 16); *p = *p + acc[ai][bj][m][n]; } }
    }
};
template <int ACT  > struct EpiGated {
    static constexpr bool PERM = true;
    bf16_t* O; int ldo; int coloff; const float* ba; const float* bb;
    __device__ __forceinline__ void operator()(const f32x4 (&acc)[2][2][4][2], const Unit& u, int wr, int wc, int fr, int fq) const {
        const int row0 = u.pm * BM + wr * 64 + fr, cl = u.pn * HALF + wc * 32 + 8 * fq;
        float va[8], vb[8];
#pragma unroll
        for (int j = 0; j < 8; ++j) { va[j] = (ACT == 0) ? ba[cl + j] : 0.f; vb[j] = (ACT == 0) ? bb[cl + j] : 0.f; }
#pragma unroll
        for (int ai = 0; ai < 2; ++ai)
#pragma unroll
            for (int m = 0; m < 4; ++m) { bf16_t* rowp = O + (size_t)(row0 + ai * HALF + m * 16) * ldo + coloff + cl;
                float o[8];
#pragma unroll
                for (int n = 0; n < 2; ++n)
#pragma unroll
                    for (int j = 0; j < 4; ++j) { const float a = acc[ai][0][m][n][j] + va[4 * n + j], b = acc[ai][1][m][n][j] + vb[4 * n + j];
                        o[4 * n + j] = (ACT == 0) ? a * sigmoidf_(b) : siluf_(a) * b; }
                u32x4 w; w.x = cvt_pk_bf16(o[0], o[1]); w.y = cvt_pk_bf16(o[2], o[3]); w.z = cvt_pk_bf16(o[4], o[5]); w.w = cvt_pk_bf16(o[6], o[7]);
                *(u32x4*)rowp = w; asm volatile("" ::: "memory"); }
    }
};
struct EpiMoeOut {
    static constexpr bool PERM = true;
    bf16_t* O; const int* row_tok; const float* row_w;
    __device__ __forceinline__ void operator()(const f32x4 (&acc)[2][2][4][2], const Unit& u, int wr, int wc, int fr, int fq) const {
        const int row0 = u.pm * BM + wr * 64 + fr, col0 = u.pn * BM + wc * 32 + 8 * fq;
#pragma unroll
        for (int ai = 0; ai < 2; ++ai)
#pragma unroll
            for (int m = 0; m < 4; ++m) { const int row = row0 + ai * HALF + m * 16; const int ts = row_tok[row]; const float w = row_w[row];
                if (ts >= 0) { bf16_t* rowp = O + ((size_t)(ts & 1) * NTOK + (size_t)(ts >> 1)) * DM + col0;
#pragma unroll
                    for (int bj = 0; bj < 2; ++bj) { const f32x4 v0 = acc[ai][bj][m][0] * w, v1 = acc[ai][bj][m][1] * w;
                        u32x4 q; q.x = cvt_pk_bf16(v0[0], v0[1]); q.y = cvt_pk_bf16(v0[2], v0[3]); q.z = cvt_pk_bf16(v1[0], v1[1]); q.w = cvt_pk_bf16(v1[2], v1[3]);
                        *(u32x4*)(rowp + bj * HALF) = q; } } asm volatile("" ::: "memory"); }
    }
};
struct MoeOrder {
    int nN, G, c, K; const char* A; const char* B; size_t bstride; const int* tiles;
    __device__ bool next(int i, Unit& u) const {
        const int nrt = tiles[0]; const long L = (long)i * G + c; if (L >= (long)nrt * nN) return false;
        u.pm = (int)(L / nN); u.pn = (int)(L % nN); const int e = tiles[64 + u.pm];
        u.a = A + (size_t)u.pm * 256 * K * 2; u.b = B + (size_t)e * bstride + (size_t)u.pn * 256 * K * 2; return true;
    }
};
}

struct Params { const float* in[44]; float* out; unsigned char* ws; int ph_lo, ph_hi; };
enum { I_X = 0, I_NORM1, I_WIN, I_MCONVW, I_MCONVB, I_MDTB, I_MALOG, I_MD, I_MNORM, I_RMU, I_RW0, I_RW2, I_RA0, I_RA2, I_RG2, I_RKK, I_RKA, I_RRK, I_RLNW, I_RLNB,
       I_CKVN, I_CWUK, I_CWUV, I_RELB, I_SARE, I_SAIM, I_SBRE, I_SBIM, I_SCRE, I_SCIM, I_SD, I_SLOGDT, I_SGLUW, I_SGLUB, I_WOUT, I_NORM2, I_WRG, I_BRG, I_WRE, I_BRE,
       I_WGATE, I_WUP, I_WDOWN, I_FNORM };

typedef const float* const __attribute__((address_space(4)))* in_tab_t;
struct Frame {
    LAS unsigned char* lds; int tid, lane, wave, bid, G;
    in_tab_t in; float* out; unsigned char* ws; unsigned* ctl;
    volatile LAS int* misc;
};

__device__ __forceinline__ int q_pop(Frame& F, int qi) {
    __syncthreads();
    if (F.tid == 0) F.misc[0] = (int)__hip_atomic_fetch_add(F.ctl + CW_Q + 64 * qi, 1u, __ATOMIC_RELAXED, __HIP_MEMORY_SCOPE_AGENT);
    __syncthreads();
    return F.misc[0];
}

__device__ __forceinline__ const void* opaque_ptr(const void* p) { const unsigned long long v = (unsigned long long)p; unsigned lo = __builtin_amdgcn_readfirstlane((unsigned)v), hi = __builtin_amdgcn_readfirstlane((unsigned)(v >> 32));
    asm volatile("" : "+s"(lo), "+s"(hi)); return (const void*)(((unsigned long long)hi << 32) | lo); }
__device__ __forceinline__ Frame relocal(const Frame& G) { Frame F = G; asm volatile("" : "+v"(F.tid)); F.ws = (unsigned char*)opaque_ptr(F.ws); F.ctl = (unsigned*)(F.ws + WS_CTL); F.in = (in_tab_t)(unsigned long long)opaque_ptr((const void*)(unsigned long long)F.in); F.lane = F.tid & 63; F.wave = __builtin_amdgcn_readfirstlane(F.tid >> 6); return F; }
template <int K> __device__ __forceinline__ f32x4 mma_nt(const LAS bf16_t* A, int lda, const LAS bf16_t* Bt, int ldb, f32x4 acc, int lane) {
    const int r = lane & 15, g = lane >> 4;
#pragma unroll
    for (int k0 = 0; k0 < K; k0 += 32) {
        const bf16x8 a = *(const LAS bf16x8*)(A + r * lda + k0 + 8 * g);
        const bf16x8 b = *(const LAS bf16x8*)(Bt + r * ldb + k0 + 8 * g);
        acc = __builtin_amdgcn_mfma_f32_16x16x32_bf16(a, b, acc, 0, 0, 0);
    }
    return acc;
}

template <class ColMap> __device__ __forceinline__ void tr_tile(Frame& F, const float* src, int ldsrc, bf16_t* dst, int K, int k0, int n0, ColMap cm) {
    LAS float* tile = (LAS float*)F.lds;
    __syncthreads();
    { const int kk = F.tid >> 4, n4 = (F.tid & 15) * 4;
#pragma unroll
      for (int ps = 0; ps < 2; ++ps) { const int k = kk + 32 * ps; const int sc = cm(n0 + n4);
          f32x4 v = (f32x4){0.f, 0.f, 0.f, 0.f}; if (sc >= 0) v = *(const f32x4*)(src + (size_t)(k0 + k) * ldsrc + sc);
          tile[k * 65 + n4 + 0] = v[0]; tile[k * 65 + n4 + 1] = v[1]; tile[k * 65 + n4 + 2] = v[2]; tile[k * 65 + n4 + 3] = v[3]; } }
    __syncthreads();
    { const int n = F.tid >> 3, kc = F.tid & 7; float f[8];
#pragma unroll
      for (int j = 0; j < 8; ++j) f[j] = tile[(8 * kc + j) * 65 + n];
      u32x4 w; w.x = pk2(f[0], f[1]); w.y = pk2(f[2], f[3]); w.z = pk2(f[4], f[5]); w.w = pk2(f[6], f[7]);
      *(u32x4*)(dst + (size_t)(n0 + n) * K + k0 + 8 * kc) = w; }
}

struct CmIn { __device__ __forceinline__ int operator()(int n) const {
    if (n < 772) return n; if (n < UR) return -1; if (n < UR + 896) return 772 + (n - UR); if (n < UC) return -1;
    if (n < UC + 680) return 1668 + (n - UC); if (n < US) return -1; if (n < US + 256) return 2348 + (n - US); return -1; } };
struct CmId { __device__ __forceinline__ int operator()(int n) const { return n; } };
struct CmGlu { __device__ __forceinline__ int operator()(int n) const { const int pn = n >> 8, rr = n & 255; return rr < 128 ? 128 * pn + rr : 256 + 128 * pn + (rr - 128); } };
struct CmGateUp { int half; __device__ __forceinline__ int operator()(int n) const { return n; } };

__device__ __forceinline__ void phase_prologue(const Frame& F_) { Frame F = relocal(F_);
    for (int t = F.bid; t < 1984; t += F.G) {
        if (t < 1408) { const int l = t / 704, r = t % 704, kt = r / 44, nt = r % 44;
            tr_tile(F, F.in[I_WIN] + (size_t)l * DM * NIN, NIN, (bf16_t*)(F.ws + WS_WIN) + (size_t)l * NINP * DM, DM, kt * 64, nt * 64, CmIn()); }
        else if (t < 1920) { const int q = t - 1408, l = q / 256, r = q % 256, kt = r / 16, nt = r % 16;
            tr_tile(F, F.in[I_WOUT] + (size_t)l * DM * DM, DM, (bf16_t*)(F.ws + WS_WOUT) + (size_t)l * DM * DM, DM, kt * 64, nt * 64, CmId()); }
        else { const int q = t - 1920, l = q / 32, r = q % 32, kt = r / 8, nt = r % 8;
            tr_tile(F, F.in[I_SGLUW] + (size_t)l * 256 * 512, 512, (bf16_t*)(F.ws + WS_GLU) + (size_t)l * 512 * 256, 256, kt * 64, nt * 64, CmGlu()); }
    }
    for (int i = F.bid * NTHR + F.tid; i < 2 * 48 * 1024; i += F.G * NTHR) { const int l = i / 49152, r = i % 49152, o = r >> 10, k = r & 1023;
        float v = 0.f; if (o < 32) v = F.in[I_WRE][((size_t)l * DM + k) * 32 + o]; else if (o < 36) v = F.in[I_WRG][((size_t)l * DM + k) * 4 + (o - 32)];
        v *= F.in[I_NORM2][l * DM + k];
        const bf16_t hi = f2bf(v); const bf16_t lo = f2bf(v - bf2f(hi));
        bf16_t* w = (bf16_t*)(F.ws + WS_WRT) + (size_t)l * 2 * 49152; w[r] = hi; w[49152 + r] = lo; }
    for (int i = F.bid * NTHR + F.tid; i < 2048 + 65536; i += F.G * NTHR) {
        if (i < 2048) {
            const int l = i >> 10, gn = i & 1023, g = gn >> 6;
            float* tab = (float*)(F.ws + WS_S5TAB + (size_t)l * S5TAB_L);
            const float lre = fminf(F.in[I_SARE][l * 1024 + gn], -1e-4f), lim = F.in[I_SAIM][l * 1024 + gn];
            const float dt = expf(F.in[I_SLOGDT][l * 16 + g]);
            const float mag = expf(dt * lre); float sn, cs; sincosf(dt * lim, &sn, &cs);
            const float are = mag * cs, aim = mag * sn;
            const float den = lre * lre + lim * lim;
            const float fre = ((are - 1.0f) * lre + aim * lim) / den, fim = (aim * lre - (are - 1.0f) * lim) / den;
            tab[gn * 2] = are; tab[gn * 2 + 1] = aim;
            float pr = are, pi = aim;
#pragma unroll
            for (int s = 0; s < 6; ++s) { const float nr = pr * pr - pi * pi, ni = 2.0f * pr * pi; pr = nr; pi = ni; }
            tab[2048 + gn * 2] = pr; tab[2048 + gn * 2 + 1] = pi;
            const float* bre = F.in[I_SBRE] + ((size_t)l * 1024 + gn) * 16; const float* bim = F.in[I_SBIM] + ((size_t)l * 1024 + gn) * 16;
            for (int p = 0; p < 16; ++p) { tab[4096 + (gn * 16 + p) * 2] = fre * bre[p] - fim * bim[p]; tab[4096 + (gn * 16 + p) * 2 + 1] = fre * bim[p] + fim * bre[p]; }
        } else {
            const int j = i - 2048, l = j >> 15, r = j & 32767, gp = r >> 7, k = r & 127;
            bf16_t* cm = (bf16_t*)(F.ws + WS_S5TAB + (size_t)l * S5TAB_L + S5TAB_F);
            const float v = k < 64 ? F.in[I_SCRE][((size_t)l * 256 + gp) * 64 + k] : -F.in[I_SCIM][((size_t)l * 256 + gp) * 64 + (k - 64)];
            cm[r] = f2bf(v);
        }
    }
}

__device__ __forceinline__ void phase_norm(const Frame& F_, const float* xin, bool add_o, const float* w, int mode) { Frame F = relocal(F_);
    float* X = (float*)(F.ws + WS_X); bf16_t* H = (bf16_t*)(F.ws + WS_H); const bf16_t* O = (const bf16_t*)(F.ws + WS_U);
    for (int row = F.bid * 8 + F.wave; row < NTOK; row += F.G * 8) {
        f32x4 v[4]; float ss = 0.f;
#pragma unroll
        for (int j = 0; j < 4; ++j) { const int c = 4 * F.lane + 256 * j; v[j] = *(const f32x4*)(xin + (size_t)row * DM + c);
            if (add_o) { const u32x2 a = *(const u32x2*)(O + (size_t)row * DM + c), b = *(const u32x2*)(O + ((size_t)NTOK + row) * DM + c);
                v[j][0] += __uint_as_float(a.x << 16) + __uint_as_float(b.x << 16); v[j][1] += __uint_as_float(a.x & 0xffff0000u) + __uint_as_float(b.x & 0xffff0000u);
                v[j][2] += __uint_as_float(a.y << 16) + __uint_as_float(b.y << 16); v[j][3] += __uint_as_float(a.y & 0xffff0000u) + __uint_as_float(b.y & 0xffff0000u); }
            ss += v[j][0] * v[j][0] + v[j][1] * v[j][1] + v[j][2] * v[j][2] + v[j][3] * v[j][3]; }
        ss = wave_sum(ss);
        const float rstd = rsqrtf(ss * (1.0f / DM) + 1e-6f);
#pragma unroll
        for (int j = 0; j < 4; ++j) { const int c = 4 * F.lane + 256 * j; const f32x4 wv = *(const f32x4*)(w + c);
            if (mode == 2) { *(f32x4*)(F.out + (size_t)row * DM + c) = v[j] * rstd * wv; }
            else { *(f32x4*)(X + (size_t)row * DM + c) = v[j];
                u32x2 o; o.x = pk2(v[j][0] * rstd * wv[0], v[j][1] * rstd * wv[1]); o.y = pk2(v[j][2] * rstd * wv[2], v[j][3] * rstd * wv[3]);
                *(u32x2*)(H + (size_t)row * DM + c) = o; } }
    }
}

__device__ __forceinline__ void item_kv(const Frame& F_, int layer, int item) { Frame F = relocal(F_);
    const bf16_t* U = (const bf16_t*)(F.ws + WS_U);
    LAS bf16_t* Ab = (LAS bf16_t*)F.lds;
    LAS bf16_t* Bt = (LAS bf16_t*)(F.lds + 17408);
    const int t0 = item * 64;
    { const int tok = F.tid >> 3, part = F.tid & 7; const bf16_t* src = U + (size_t)(t0 + tok) * NINP + UC + 256 + 16 * part;
      float f[16]; { float a[8], b[8]; unpack8(*(const u32x4*)src, a); unpack8(*(const u32x4*)(src + 8), b);
#pragma unroll
        for (int j = 0; j < 8; ++j) { f[j] = a[j]; f[8 + j] = b[j]; } }
      float ss = 0.f;
#pragma unroll
      for (int j = 0; j < 16; ++j) ss += f[j] * f[j];
      ss = sum8(ss);
      const float rstd = rsqrtf(ss * (1.0f / 128.0f) + 1e-6f); const float* nw = F.in[I_CKVN] + layer * 128 + 16 * part;
#pragma unroll
      for (int j = 0; j < 16; j += 2) *(LAS unsigned*)(Ab + tok * 136 + 16 * part + j) = pk2(f[j] * rstd * nw[j], f[j + 1] * rstd * nw[j + 1]); }
    { const int n = F.tid >> 2, kq = F.tid & 3; const float* w = (n < 64 ? F.in[I_CWUK] : F.in[I_CWUV]) + (size_t)layer * 128 * 64 + (n & 63);
#pragma unroll 4
      for (int k = 32 * kq; k < 32 * kq + 32; ++k) Bt[n * 136 + k] = f2bf(w[(size_t)k * 64]); }
    if (F.tid < 256) { const int tok = F.tid >> 2, q = F.tid & 3;
        *(u32x4*)((bf16_t*)(F.ws + WS_KIDX) + (size_t)(t0 + tok) * 32 + 8 * q) = *(const u32x4*)(U + (size_t)(t0 + tok) * NINP + UC + 640 + 8 * q); }
    __syncthreads();
    const int mt = F.wave & 3, g = F.lane >> 4, r = F.lane & 15;
#pragma unroll
    for (int q = 0; q < 4; ++q) { const int nt = (F.wave >> 2) * 4 + q;
        f32x4 acc = (f32x4){0.f, 0.f, 0.f, 0.f};
        acc = mma_nt<128>(Ab + mt * 16 * 136, 136, Bt + nt * 16 * 136, 136, acc, F.lane);
        const int n = nt * 16 + r; bf16_t* dst = (bf16_t*)(F.ws + (n < 64 ? WS_K : WS_V));
#pragma unroll
        for (int i = 0; i < 4; ++i) dst[(size_t)(t0 + mt * 16 + 4 * g + i) * 64 + (n & 63)] = f2bf(acc[i]); }
}

constexpr int MB_CG = 0, MB_BG = 18432, MB_BT = 36864, MB_XT = 55296, MB_M = 92160, MB_S0 = 101376, MB_DT = 110592, MB_AC = 111616, MB_RS = 112640;
template <int STAGE> __device__ __forceinline__ void item_mamba(const Frame& F_, int layer, int item) { Frame F = relocal(F_);
    const bf16_t* U = (const bf16_t*)(F.ws + WS_U);
    const int b = item >> 6, c = item & 63, l0 = c * 64; const size_t T0 = (size_t)b * SEQ + l0;
    LAS bf16_t* Cg = (LAS bf16_t*)(F.lds + MB_CG); LAS bf16_t* Bg = (LAS bf16_t*)(F.lds + MB_BG); LAS bf16_t* BT = (LAS bf16_t*)(F.lds + MB_BT);
    LAS bf16_t* XT = (LAS bf16_t*)(F.lds + MB_XT); LAS bf16_t* Mb = (LAS bf16_t*)(F.lds + MB_M); LAS bf16_t* S0 = (LAS bf16_t*)(F.lds + MB_S0);
    LAS float* dts = (LAS float*)(F.lds + MB_DT); LAS float* acs = (LAS float*)(F.lds + MB_AC); LAS float* rs = (LAS float*)(F.lds + MB_RS);
    if (F.tid < 256) { const int l = F.tid >> 2, h = F.tid & 3;
        const float raw = bf2f(U[(T0 + l) * NINP + UM + 768 + h]) + F.in[I_MDTB][layer * 4 + h];
        const float dt = softplusf_(raw); dts[l * 4 + h] = dt; acs[l * 4 + h] = -__expf(F.in[I_MALOG][layer * 4 + h]) * dt; }
    if (F.tid < 64) rs[F.tid] = 0.f;
    __syncthreads();
    float mycum = 0.f;
    if (F.tid < 256) { const int l = F.tid >> 2, h = F.tid & 3; for (int s = 0; s <= l; ++s) mycum += acs[s * 4 + h]; }
    __syncthreads();
    if (F.tid < 256) acs[F.tid] = mycum;
    __syncthreads();
    { const int ch8 = F.tid & 63, tg = F.tid >> 6, c0 = ch8 * 8;
      float wv[4][8], bv[8];
#pragma unroll
      for (int j = 0; j < 8; ++j) { bv[j] = F.in[I_MCONVB][layer * 512 + c0 + j];
#pragma unroll
          for (int k = 0; k < 4; ++k) wv[k][j] = F.in[I_MCONVW][(layer * 4 + k) * 512 + c0 + j]; }
      float win[3][8];
#pragma unroll
      for (int k = 0; k < 3; ++k) { const int l = l0 + tg * 8 - 3 + k;
          if (l >= 0) unpack8(*(const u32x4*)(U + ((size_t)b * SEQ + l) * NINP + UM + 256 + c0), win[k]);
          else {
#pragma unroll
              for (int j = 0; j < 8; ++j) win[k][j] = 0.f; } }
#pragma unroll 1
      for (int i = 0; i < 8; ++i) { const int l = tg * 8 + i; float cur[8]; unpack8(*(const u32x4*)(U + (T0 + l) * NINP + UM + 256 + c0), cur);
          float o[8];
#pragma unroll
          for (int j = 0; j < 8; ++j) { o[j] = siluf_(bv[j] + wv[0][j] * win[0][j] + wv[1][j] * win[1][j] + wv[2][j] * win[2][j] + wv[3][j] * cur[j]);
              win[0][j] = win[1][j]; win[1][j] = win[2][j]; win[2][j] = cur[j]; }
          if (c0 < 256) { const int h = c0 >> 6, p0 = c0 & 63; float sc = dts[l * 4 + h]; if (STAGE == 1) sc *= __expf(acs[63 * 4 + h] - acs[l * 4 + h]);
#pragma unroll
              for (int j = 0; j < 8; ++j) XT[(h * 64 + p0 + j) * 72 + l] = f2bf(o[j] * sc); }
          else if (c0 < 384) { const int g = (c0 - 256) >> 6, n0 = (c0 - 256) & 63;
              if (STAGE == 1) {
#pragma unroll
                  for (int j = 0; j < 8; ++j) BT[(g * 64 + n0 + j) * 72 + l] = f2bf(o[j]); }
              else { u32x4 w; w.x = pk2(o[0], o[1]); w.y = pk2(o[2], o[3]); w.z = pk2(o[4], o[5]); w.w = pk2(o[6], o[7]); *(LAS u32x4*)(Bg + (g * 64 + l) * 72 + n0) = w; } }
          else if (STAGE == 2) { const int g = (c0 - 384) >> 6, n0 = (c0 - 384) & 63;
              u32x4 w; w.x = pk2(o[0], o[1]); w.y = pk2(o[2], o[3]); w.z = pk2(o[4], o[5]); w.w = pk2(o[6], o[7]); *(LAS u32x4*)(Cg + (g * 64 + l) * 72 + n0) = w; } } }
    __syncthreads();
    const int g4 = F.lane >> 4, r16 = F.lane & 15;
    if (STAGE == 1) {
        float* MST = (float*)(F.ws + WS_MST) + ((size_t)(b * 64 + c) * 4) * 4096;
#pragma unroll
        for (int q = 0; q < 8; ++q) { const int tix = F.wave * 8 + q, h = tix >> 4, mt = (tix >> 2) & 3, nt = tix & 3;
            f32x4 acc = (f32x4){0.f, 0.f, 0.f, 0.f};
            acc = mma_nt<64>(XT + (h * 64 + mt * 16) * 72, 72, BT + ((h >> 1) * 64 + nt * 16) * 72, 72, acc, F.lane);
#pragma unroll
            for (int i = 0; i < 4; ++i) MST[(size_t)h * 4096 + (mt * 16 + 4 * g4 + i) * 64 + nt * 16 + r16] = acc[i]; }
        if (F.tid < 4) ((float*)(F.ws + WS_MDEC))[(b * 64 + c) * 4 + F.tid] = __expf(acs[63 * 4 + F.tid]);
    } else {
        const int mt = F.wave & 3, nh = F.wave >> 2;
        const float* MST = (const float*)(F.ws + WS_MST) + ((size_t)(b * 64 + c) * 4) * 4096;
        f32x4 G[2], yv[4][2];
#pragma unroll
        for (int h = 0; h < 4; ++h) {
            const int g = h >> 1;
            { const float* src = MST + (size_t)h * 4096 + F.tid * 8; const f32x4 a = *(const f32x4*)src, bq = *(const f32x4*)(src + 4);
              u32x4 w; w.x = pk2(a[0], a[1]); w.y = pk2(a[2], a[3]); w.z = pk2(bq[0], bq[1]); w.w = pk2(bq[2], bq[3]);
              *(LAS u32x4*)(S0 + (F.tid >> 3) * 72 + (F.tid & 7) * 8) = w; }
            if ((h & 1) == 0) {
#pragma unroll
                for (int q = 0; q < 2; ++q) { G[q] = (f32x4){0.f, 0.f, 0.f, 0.f};
                    G[q] = mma_nt<64>(Cg + (g * 64 + mt * 16) * 72, 72, Bg + (g * 64 + (2 * nh + q) * 16) * 72, 72, G[q], F.lane); } }
#pragma unroll
            for (int q = 0; q < 2; ++q) { const int s = (2 * nh + q) * 16 + r16; const float as = acs[s * 4 + h];
#pragma unroll
                for (int i = 0; i < 4; ++i) { const int l = mt * 16 + 4 * g4 + i; const float v = (s <= l) ? G[q][i] * __expf(acs[l * 4 + h] - as) : 0.f;
                    Mb[l * 72 + s] = f2bf(v); } }
            __syncthreads();
#pragma unroll
            for (int q = 0; q < 2; ++q) { const int nt = 2 * nh + q;
                f32x4 yd = (f32x4){0.f, 0.f, 0.f, 0.f}, yo = (f32x4){0.f, 0.f, 0.f, 0.f};
                yd = mma_nt<64>(Mb + mt * 16 * 72, 72, XT + (h * 64 + nt * 16) * 72, 72, yd, F.lane);
                yo = mma_nt<64>(Cg + (g * 64 + mt * 16) * 72, 72, S0 + nt * 16 * 72, 72, yo, F.lane);
                const int p = nt * 16 + r16; const float dsk = F.in[I_MD][layer * 4 + h];
#pragma unroll
                for (int i = 0; i < 4; ++i) { const int l = mt * 16 + 4 * g4 + i;
                    const float xs = bf2f(XT[(h * 64 + p) * 72 + l]) / dts[l * 4 + h];
                    yv[h][q][i] = yd[i] + yo[i] * __expf(acs[l * 4 + h]) + dsk * xs; } }
            __syncthreads();
        }
        float part[4] = {0.f, 0.f, 0.f, 0.f};
#pragma unroll
        for (int h = 0; h < 4; ++h)
#pragma unroll
            for (int q = 0; q < 2; ++q) { const int ch = h * 64 + (2 * nh + q) * 16 + r16;
#pragma unroll
                for (int i = 0; i < 4; ++i) { const int l = mt * 16 + 4 * g4 + i; const float z = bf2f(U[(T0 + l) * NINP + UM + ch]);
                    const float v = yv[h][q][i] * siluf_(z); yv[h][q][i] = v; part[i] += v * v; } }
#pragma unroll
        for (int i = 0; i < 4; ++i) { const float s = sum16(part[i]); if (r16 == 0) atomicAdd((float*)(rs + mt * 16 + 4 * g4 + i), s); }
        __syncthreads();
        bf16_t* Y = (bf16_t*)(F.ws + WS_H);
#pragma unroll
        for (int i = 0; i < 4; ++i) { const int l = mt * 16 + 4 * g4 + i; const float rstd = rsqrtf(rs[l] * (1.0f / 256.0f) + 1e-6f);
#pragma unroll
            for (int h = 0; h < 4; ++h)
#pragma unroll
                for (int q = 0; q < 2; ++q) { const int ch = h * 64 + (2 * nh + q) * 16 + r16;
                    Y[(T0 + l) * DM + ch] = f2bf(yv[h][q][i] * rstd * F.in[I_MNORM][layer * 256 + ch]); } }
    }
}
__device__ __forceinline__ void item_mamba_carry(const Frame& F_, int item) { Frame F = relocal(F_);
    const int b = item >> 2, h = item & 3;
    float* MST = (float*)(F.ws + WS_MST); const float* MD = (const float*)(F.ws + WS_MDEC);
    float s[8];
#pragma unroll
    for (int j = 0; j < 8; ++j) s[j] = 0.f;
    for (int c = 0; c < 64; ++c) { float* p = MST + ((size_t)(b * 64 + c) * 4 + h) * 4096 + F.tid * 8; const float d = MD[(b * 64 + c) * 4 + h];
        const f32x4 a = *(f32x4*)p, q = *(f32x4*)(p + 4);
        *(f32x4*)p = (f32x4){s[0], s[1], s[2], s[3]}; *(f32x4*)(p + 4) = (f32x4){s[4], s[5], s[6], s[7]};
        s[0] = s[0] * d + a[0]; s[1] = s[1] * d + a[1]; s[2] = s[2] * d + a[2]; s[3] = s[3] * d + a[3];
        s[4] = s[4] * d + q[0]; s[5] = s[5] * d + q[1]; s[6] = s[6] * d + q[2]; s[7] = s[7] * d + q[3]; }
}

template <int STAGE> __device__ __forceinline__ void item_s5(const Frame& F_, int layer, int item) { Frame F = relocal(F_);
    const bf16_t* U = (const bf16_t*)(F.ws + WS_U);
    const int b = item >> 6, c = item & 63; const size_t T0 = (size_t)b * SEQ + c * 64;
    LAS float* us = (LAS float*)F.lds; LAS bf16_t* Hs = (LAS bf16_t*)(F.lds + 65536);
    const float* tab = (const float*)(F.ws + WS_S5TAB + (size_t)layer * S5TAB_L);
    { const int tok = F.tid >> 3, part = F.tid & 7;
#pragma unroll
      for (int q = 0; q < 4; ++q) { float f[8]; unpack8(*(const u32x4*)(U + (T0 + tok) * NINP + US + 32 * part + 8 * q), f);
          *(LAS f32x4*)(us + tok * 256 + 32 * part + 8 * q) = (f32x4){f[0], f[1], f[2], f[3]}; *(LAS f32x4*)(us + tok * 256 + 32 * part + 8 * q + 4) = (f32x4){f[4], f[5], f[6], f[7]}; } }
    const int g = F.tid >> 5, n0 = F.tid & 31, gn0 = g * 64 + n0, gn1 = gn0 + 32;
    float bb0[32], bb1[32];
#pragma unroll
    for (int j = 0; j < 32; j += 4) { const f32x4 a = *(const f32x4*)(tab + 4096 + gn0 * 32 + j), bq = *(const f32x4*)(tab + 4096 + gn1 * 32 + j);
        bb0[j] = a[0]; bb0[j + 1] = a[1]; bb0[j + 2] = a[2]; bb0[j + 3] = a[3]; bb1[j] = bq[0]; bb1[j + 1] = bq[1]; bb1[j + 2] = bq[2]; bb1[j + 3] = bq[3]; }
    const float a0r = tab[gn0 * 2], a0i = tab[gn0 * 2 + 1], a1r = tab[gn1 * 2], a1i = tab[gn1 * 2 + 1];
    float* ST = (float*)(F.ws + WS_S5ST) + (size_t)(b * 64 + c) * 2048;
    float h0r = 0.f, h0i = 0.f, h1r = 0.f, h1i = 0.f;
    if (STAGE == 2) { h0r = ST[gn0 * 2]; h0i = ST[gn0 * 2 + 1]; h1r = ST[gn1 * 2]; h1i = ST[gn1 * 2 + 1]; }
    bf16x8 cf[2][4];
    if (STAGE == 2) { const bf16_t* cm = (const bf16_t*)(F.ws + WS_S5TAB + (size_t)layer * S5TAB_L + S5TAB_F);
#pragma unroll
        for (int gg = 0; gg < 2; ++gg)
#pragma unroll
            for (int ks = 0; ks < 4; ++ks) cf[gg][ks] = *(const bf16x8*)(cm + ((size_t)((2 * F.wave + gg) * 16 + (F.lane & 15))) * 128 + 32 * ks + 8 * (F.lane >> 4)); }
    __syncthreads();
    for (int lb = 0; lb < 4; ++lb) {
        for (int li = 0; li < 16; ++li) { const int l = lb * 16 + li;
            float uu[16];
#pragma unroll
            for (int q = 0; q < 4; ++q) { const f32x4 v = *(const LAS f32x4*)(us + l * 256 + g * 16 + 4 * q); uu[4 * q] = v[0]; uu[4 * q + 1] = v[1]; uu[4 * q + 2] = v[2]; uu[4 * q + 3] = v[3]; }
            float b0r = 0.f, b0i = 0.f, b1r = 0.f, b1i = 0.f;
#pragma unroll
            for (int p = 0; p < 16; ++p) { b0r += bb0[2 * p] * uu[p]; b0i += bb0[2 * p + 1] * uu[p]; b1r += bb1[2 * p] * uu[p]; b1i += bb1[2 * p + 1] * uu[p]; }
            { const float nr = a0r * h0r - a0i * h0i + b0r, ni = a0r * h0i + a0i * h0r + b0i; h0r = nr; h0i = ni; }
            { const float nr = a1r * h1r - a1i * h1i + b1r, ni = a1r * h1i + a1i * h1r + b1i; h1r = nr; h1i = ni; }
            if (STAGE == 2) { LAS bf16_t* hp = Hs + li * 2056 + g * 128; hp[n0] = f2bf(h0r); hp[64 + n0] = f2bf(h0i); hp[n0 + 32] = f2bf(h1r); hp[96 + n0] = f2bf(h1i); }
        }
        if (STAGE == 2) {
            __syncthreads();
            bf16_t* YS = (bf16_t*)(F.ws + WS_MOE + YSG_OFF);
#pragma unroll
            for (int gg = 0; gg < 2; ++gg) { const int gq = 2 * F.wave + gg; f32x4 acc = (f32x4){0.f, 0.f, 0.f, 0.f};
#pragma unroll
                for (int ks = 0; ks < 4; ++ks) { const bf16x8 a = *(const LAS bf16x8*)(Hs + (F.lane & 15) * 2056 + gq * 128 + 32 * ks + 8 * (F.lane >> 4));
                    acc = __builtin_amdgcn_mfma_f32_16x16x32_bf16(a, cf[gg][ks], acc, 0, 0, 0); }
                const int ch = gq * 16 + (F.lane & 15); const float dsk = F.in[I_SD][layer * 256 + ch];
#pragma unroll
                for (int i = 0; i < 4; ++i) { const int l = lb * 16 + 4 * (F.lane >> 4) + i; const float y = acc[i] + dsk * us[l * 256 + ch];
                    YS[(T0 + l) * 256 + ch] = f2bf(gelu_tanh(y)); } }
            __syncthreads();
        }
    }
    if (STAGE == 1) { ST[gn0 * 2] = h0r; ST[gn0 * 2 + 1] = h0i; ST[gn1 * 2] = h1r; ST[gn1 * 2 + 1] = h1i; }
}
__device__ __forceinline__ void item_s5_carry(const Frame& F_, int layer, int b) { Frame F = relocal(F_);
    const float* tab = (const float*)(F.ws + WS_S5TAB + (size_t)layer * S5TAB_L) + 2048;
    float* ST = (float*)(F.ws + WS_S5ST) + (size_t)b * 64 * 2048;
#pragma unroll
    for (int q = 0; q < 2; ++q) { const int gn = F.tid + 512 * q; const float pr = tab[gn * 2], pi = tab[gn * 2 + 1]; float hr = 0.f, hi = 0.f;
        for (int c = 0; c < 64; ++c) { float* p = ST + (size_t)c * 2048 + gn * 2; const float tr = p[0], ti = p[1]; p[0] = hr; p[1] = hi;
            const float nr = pr * hr - pi * hi + tr, ni = pr * hi + pi * hr + ti; hr = nr; hi = ni; } }
}

constexpr int RW_R = 0, RW_K = 16384, RW_V = 32768, RW_W = 49152, RW_A = 65536, RW_B = 81920, RW_TW = 98304, RW_DA = 106496, RW_O = 98304, RW_SG = 114688, RW_BON = 131072;
template <int STAGE> __device__ __forceinline__ void rwkv_prep(const Frame& F_, int layer, int b, int h, int c) { Frame F = relocal(F_);
    const bf16_t* U = (const bf16_t*)(F.ws + WS_U);
    const int l0 = c * 64; const size_t T0 = (size_t)b * SEQ + l0;
    LAS float* Rr = (LAS float*)(F.lds + RW_R); LAS float* Kk = (LAS float*)(F.lds + RW_K); LAS float* Vv = (LAS float*)(F.lds + RW_V); LAS float* Ww = (LAS float*)(F.lds + RW_W);
    LAS float* Aa = (LAS float*)(F.lds + RW_A); LAS float* Bb = (LAS float*)(F.lds + RW_B); LAS float* TW = (LAS float*)(F.lds + RW_TW); LAS float* DA = (LAS float*)(F.lds + RW_DA);
    LAS float* SG = (LAS float*)(F.lds + RW_SG); LAS float* BON = (LAS float*)(F.lds + RW_BON);
    const float* mu = F.in[I_RMU] + layer * 896;
    { const int tok = F.tid >> 3, p8 = F.tid & 7; const bool first = (l0 + tok == 0);
      const bf16_t* cur = U + (T0 + tok) * NINP + UR; const bf16_t* prv = cur - NINP;
#pragma unroll
      for (int sec = 0; sec < 3; ++sec) { const int co = sec * 256 + h * 64 + 8 * p8; float a[8], pq[8]; unpack8(*(const u32x4*)(cur + co), a);
          if (first) {
#pragma unroll
              for (int j = 0; j < 8; ++j) pq[j] = 0.f; } else unpack8(*(const u32x4*)(prv + co), pq);
          LAS float* dst = (sec == 0 ? Rr : sec == 1 ? Kk : Vv) + tok * 64 + 8 * p8;
#pragma unroll
          for (int j = 0; j < 8; ++j) dst[j] = a[j] + mu[co + j] * (pq[j] - a[j]); }
#pragma unroll
      for (int q = 0; q < 2; ++q) { const int co = 768 + 16 * p8 + 8 * q; float a[8], pq[8]; unpack8(*(const u32x4*)(cur + co), a);
          if (first) {
#pragma unroll
              for (int j = 0; j < 8; ++j) pq[j] = 0.f; } else unpack8(*(const u32x4*)(prv + co), pq);
#pragma unroll
          for (int j = 0; j < 8; ++j) { const float s = a[j] + mu[co + j] * (pq[j] - a[j]); const int cc = co - 768 + j;
              if (cc < 32) TW[tok * 32 + cc] = tanhf_(s); else if (cc < 64) DA[tok * 32 + cc - 32] = s; else SG[tok * 64 + cc - 64] = sigmoidf_(s); } } }
    __syncthreads();
    { const int j = F.lane, tq = F.wave, ch = h * 64 + j;
      float w2c[32], a2c[32];
#pragma unroll
      for (int i = 0; i < 32; ++i) { w2c[i] = F.in[I_RW2][((size_t)layer * 32 + i) * 256 + ch]; a2c[i] = F.in[I_RA2][((size_t)layer * 32 + i) * 256 + ch]; }
      const float w0 = F.in[I_RW0][layer * 256 + ch], a0 = F.in[I_RA0][layer * 256 + ch], kkw = F.in[I_RKK][layer * 256 + ch], kaw = F.in[I_RKA][layer * 256 + ch], rk = F.in[I_RRK][layer * 256 + ch];
      for (int i8 = 0; i8 < 8; ++i8) { const int t = tq + 8 * i8;
          float wl = w0, al = a0;
#pragma unroll
          for (int i = 0; i < 32; i += 4) { const f32x4 tv = *(const LAS f32x4*)(TW + t * 32 + i), dv = *(const LAS f32x4*)(DA + t * 32 + i);
              wl += tv[0] * w2c[i] + tv[1] * w2c[i + 1] + tv[2] * w2c[i + 2] + tv[3] * w2c[i + 3]; al += dv[0] * a2c[i] + dv[1] * a2c[i + 1] + dv[2] * a2c[i + 2] + dv[3] * a2c[i + 3]; }
          const float wlog = -softplusf_(-wl) - 0.5f; const float dec = __expf(-__expf(wlog)); const float a = sigmoidf_(al);
          const float kraw = Kk[t * 64 + j]; const float kkv = kraw * kkw; const float ss = wave_sum(kkv * kkv);
          const float kkn = kkv * rsqrtf(fmaxf(ss, 1e-24f)); const float kp = kraw * (1.0f + (a - 1.0f) * kaw);
          Ww[t * 64 + j] = dec; Kk[t * 64 + j] = kp; Aa[t * 64 + j] = -kkn; Bb[t * 64 + j] = kkn * a;
          if (STAGE == 3) { const float bo = wave_sum(Rr[t * 64 + j] * kp * rk); if (j == 0) BON[t] = bo; } } }
    __syncthreads();
}
__device__ __forceinline__ void item_rwkv1(const Frame& F_, int layer, int item) { Frame F = relocal(F_);
    const int b = item >> 8, h = (item >> 6) & 3, c = item & 63;
    rwkv_prep<1>(F, layer, b, h, c);
    LAS float* Kk = (LAS float*)(F.lds + RW_K); LAS float* Vv = (LAS float*)(F.lds + RW_V); LAS float* Ww = (LAS float*)(F.lds + RW_W);
    LAS float* Aa = (LAS float*)(F.lds + RW_A); LAS float* Bb = (LAS float*)(F.lds + RW_B);
    const int row = F.tid >> 2, part = F.tid & 3; const bool isU = row < 64;
    float S[16];
#pragma unroll
    for (int e = 0; e < 16; ++e) S[e] = (!isU && (16 * part + e == row - 64)) ? 1.0f : 0.0f;
    for (int t = 0; t < 64; ++t) {
        float a[16], bq[16], w[16], k[16];
#pragma unroll
        for (int q = 0; q < 4; ++q) { const f32x4 va = *(const LAS f32x4*)(Aa + t * 64 + 16 * part + 4 * q), vb = *(const LAS f32x4*)(Bb + t * 64 + 16 * part + 4 * q),
                                                  vw = *(const LAS f32x4*)(Ww + t * 64 + 16 * part + 4 * q), vk = *(const LAS f32x4*)(Kk + t * 64 + 16 * part + 4 * q);
#pragma unroll
            for (int j = 0; j < 4; ++j) { a[4 * q + j] = va[j]; bq[4 * q + j] = vb[j]; w[4 * q + j] = vw[j]; k[4 * q + j] = vk[j]; } }
        const float vr = isU ? Vv[t * 64 + row] : 0.0f;
        float sa = 0.f;
#pragma unroll
        for (int e = 0; e < 16; ++e) sa += S[e] * a[e];
        sa = sum4(sa);
#pragma unroll
        for (int e = 0; e < 16; ++e) S[e] = S[e] * w[e] + sa * bq[e] + vr * k[e];
    }
    const size_t ci = (size_t)(b * 4 + h) * 64 + c;
    if (isU) { float* dst = (float*)(F.ws + WS_MOE + RW_U) + ci * 4096 + row * 64 + 16 * part;
#pragma unroll
        for (int q = 0; q < 4; ++q) *(f32x4*)(dst + 4 * q) = (f32x4){S[4 * q], S[4 * q + 1], S[4 * q + 2], S[4 * q + 3]}; }
    else { const int i = row - 64; const int pos = 32 * (i >> 5) + 8 * ((i >> 2) & 3) + 4 * ((i >> 4) & 1) + (i & 3);
        bf16_t* dst = (bf16_t*)(F.ws + WS_MOE + RW_PT) + ci * 4096 + pos;
#pragma unroll
        for (int e = 0; e < 16; ++e) dst[(16 * part + e) * 64] = f2bf(S[e]); }
}
__device__ __forceinline__ void item_rwkv_carry(const Frame& F_, int item) { Frame F = relocal(F_);
    const int bh = item * 2 + (F.wave >> 2), nt = F.wave & 3, r = F.lane & 15, g = F.lane >> 4;
    const bf16_t* PT = (const bf16_t*)(F.ws + WS_MOE + RW_PT); const float* Uc = (const float*)(F.ws + WS_MOE + RW_U); float* Ss = (float*)(F.ws + WS_MOE + RW_S);
    f32x4 acc[4];
#pragma unroll
    for (int m = 0; m < 4; ++m) acc[m] = (f32x4){0.f, 0.f, 0.f, 0.f};
    for (int c = 0; c < 64; ++c) { const size_t ci = (size_t)bh * 64 + c;
        bf16x8 af[4][2]; f32x4 cin[4];
#pragma unroll
        for (int m = 0; m < 4; ++m) { cin[m] = *(const f32x4*)(Uc + ci * 4096 + (16 * nt + r) * 64 + 16 * m + 4 * g);
#pragma unroll
            for (int s = 0; s < 2; ++s) af[m][s] = *(const bf16x8*)(PT + ci * 4096 + (16 * m + r) * 64 + 32 * s + 8 * g); }
#pragma unroll
        for (int m = 0; m < 4; ++m) *(f32x4*)(Ss + ci * 4096 + (16 * nt + r) * 64 + 16 * m + 4 * g) = acc[m];
        bf16x8 bfr[2];
#pragma unroll
        for (int s = 0; s < 2; ++s) { u32x4 w; w.x = pk2(acc[2 * s][0], acc[2 * s][1]); w.y = pk2(acc[2 * s][2], acc[2 * s][3]); w.z = pk2(acc[2 * s + 1][0], acc[2 * s + 1][1]); w.w = pk2(acc[2 * s + 1][2], acc[2 * s + 1][3]);
            bfr[s] = __builtin_bit_cast(bf16x8, w); }
#pragma unroll
        for (int m = 0; m < 4; ++m) { acc[m] = __builtin_amdgcn_mfma_f32_16x16x32_bf16(af[m][0], bfr[0], cin[m], 0, 0, 0);
            acc[m] = __builtin_amdgcn_mfma_f32_16x16x32_bf16(af[m][1], bfr[1], acc[m], 0, 0, 0); }
    }
}
__device__ __forceinline__ void item_rwkv3(const Frame& F_, int layer, int item) { Frame F = relocal(F_);
    const int b = item >> 8, h = (item >> 6) & 3, c = item & 63; const size_t T0 = (size_t)b * SEQ + c * 64;
    rwkv_prep<3>(F, layer, b, h, c);
    LAS float* Rr = (LAS float*)(F.lds + RW_R); LAS float* Kk = (LAS float*)(F.lds + RW_K); LAS float* Vv = (LAS float*)(F.lds + RW_V); LAS float* Ww = (LAS float*)(F.lds + RW_W);
    LAS float* Aa = (LAS float*)(F.lds + RW_A); LAS float* Bb = (LAS float*)(F.lds + RW_B); LAS float* Oo = (LAS float*)(F.lds + RW_O);
    LAS float* SG = (LAS float*)(F.lds + RW_SG); LAS float* BON = (LAS float*)(F.lds + RW_BON);
    { const int row = F.tid >> 3, part = F.tid & 7; const size_t ci = (size_t)(b * 4 + h) * 64 + c;
      const float* sp = (const float*)(F.ws + WS_MOE + RW_S) + ci * 4096 + row * 64 + 8 * part;
      float S[8]; { const f32x4 x = *(const f32x4*)sp, y = *(const f32x4*)(sp + 4); S[0] = x[0]; S[1] = x[1]; S[2] = x[2]; S[3] = x[3]; S[4] = y[0]; S[5] = y[1]; S[6] = y[2]; S[7] = y[3]; }
      for (int t = 0; t < 64; ++t) {
          float a[8], bq[8], w[8], k[8], rr[8];
#pragma unroll
          for (int q = 0; q < 2; ++q) { const int o = t * 64 + 8 * part + 4 * q; const f32x4 va = *(const LAS f32x4*)(Aa + o), vb = *(const LAS f32x4*)(Bb + o), vw = *(const LAS f32x4*)(Ww + o), vk = *(const LAS f32x4*)(Kk + o), vr4 = *(const LAS f32x4*)(Rr + o);
#pragma unroll
              for (int j = 0; j < 4; ++j) { a[4 * q + j] = va[j]; bq[4 * q + j] = vb[j]; w[4 * q + j] = vw[j]; k[4 * q + j] = vk[j]; rr[4 * q + j] = vr4[j]; } }
          const float vr = Vv[t * 64 + row];
          float sa = 0.f;
#pragma unroll
          for (int e = 0; e < 8; ++e) sa += S[e] * a[e];
          sa = sum8(sa);
          float o = 0.f;
#pragma unroll
          for (int e = 0; e < 8; ++e) { S[e] = S[e] * w[e] + sa * bq[e] + vr * k[e]; o += S[e] * rr[e]; }
          o = sum8(o);
          if (part == 0) Oo[t * 64 + row] = o;
      } }
    __syncthreads();
    { const int j = F.lane, tq = F.wave, ch = h * 64 + j;
      float g2c[64];
#pragma unroll
      for (int i = 0; i < 64; ++i) g2c[i] = F.in[I_RG2][((size_t)layer * 64 + i) * 256 + ch];
      const float lw = F.in[I_RLNW][layer * 256 + ch], lb = F.in[I_RLNB][layer * 256 + ch];
      bf16_t* Y = (bf16_t*)(F.ws + WS_H);
      for (int i8 = 0; i8 < 8; ++i8) { const int t = tq + 8 * i8;
          const float o = Oo[t * 64 + j]; const float mean = wave_sum(o) * (1.0f / 64.0f); const float d = o - mean; const float var = wave_sum(d * d) * (1.0f / 64.0f);
          float on = d * rsqrtf(var + 64e-5f) * lw + lb; on += BON[t] * Vv[t * 64 + j];
          float gg = 0.f;
#pragma unroll
          for (int i = 0; i < 64; i += 4) { const f32x4 sv = *(const LAS f32x4*)(SG + t * 64 + i); gg += sv[0] * g2c[i] + sv[1] * g2c[i + 1] + sv[2] * g2c[i + 2] + sv[3] * g2c[i + 3]; }
          Y[(T0 + t) * DM + 256 + ch] = f2bf(on * gg); } }
}

constexpr int DS_SEL = 131072, DS_HIST = 135168, DS_BKT = 143360, DS_BIAS = 143872;
__device__ __forceinline__ unsigned fkey(float f) { const unsigned u = __float_as_uint(f); return (u & 0x80000000u) ? ~u : (u | 0x80000000u); }
__device__ __forceinline__ void item_dsa(const Frame& F_, int layer, int item) { Frame F = relocal(F_);
    const bf16_t* U = (const bf16_t*)(F.ws + WS_U); const bf16_t* KI = (const bf16_t*)(F.ws + WS_KIDX);
    const bf16_t* Kb = (const bf16_t*)(F.ws + WS_K); const bf16_t* Vb = (const bf16_t*)(F.ws + WS_V);
    const int b = item & 3, qg = 511 - (item >> 2); const size_t TB = (size_t)b * SEQ, T0 = TB + qg * 8;
    LAS float* sc = (LAS float*)F.lds; LAS unsigned short* selall = (LAS unsigned short*)(F.lds + DS_SEL); LAS unsigned* histall = (LAS unsigned*)(F.lds + DS_HIST);
    LAS int* bkt = (LAS int*)(F.lds + DS_BKT); LAS float* biasT = (LAS float*)(F.lds + DS_BIAS);
    if (F.tid < 128) { const int n = F.tid; int bk = n; if (n >= 16) { const float lr = logf((float)n / 16.0f) / 2.0794415416798357f; bk = 16 + (int)(lr * 16.0f); bk = bk < 31 ? bk : 31; } bkt[n] = bk; biasT[n] = F.in[I_RELB][n]; }
    const int lane = F.lane, hh = lane >> 5;
    {
        bf16x8 af[2][2]; float wq[2][2][8];
        { const int r = lane & 31, q4 = 2 * ((r >> 2) & 1) + (r >> 4), head = 4 * ((r >> 3) & 1) + (r & 3);
#pragma unroll
          for (int mt = 0; mt < 2; ++mt)
#pragma unroll
              for (int ks = 0; ks < 2; ++ks) af[mt][ks] = *(const bf16x8*)(U + (T0 + 4 * mt + q4) * NINP + UC + 384 + head * 32 + 16 * ks + 8 * hh); }
#pragma unroll
        for (int mt = 0; mt < 2; ++mt)
#pragma unroll
            for (int q2 = 0; q2 < 2; ++q2) { float f[8]; unpack8(*(const u32x4*)(U + (T0 + 4 * mt + 2 * hh + q2) * NINP + UC + 672), f);
#pragma unroll
                for (int hd = 0; hd < 8; ++hd) wq[mt][q2][hd] = f[hd]; }
        const int ntile = (qg * 8 + 8 + 31) >> 5;
        for (int kt = F.wave; kt < ntile; kt += 8) {
            const int key = kt * 32 + (lane & 31);
            const bf16x8 b0 = *(const bf16x8*)(KI + (TB + key) * 32 + 8 * hh), b1 = *(const bf16x8*)(KI + (TB + key) * 32 + 16 + 8 * hh);
#pragma unroll
            for (int mt = 0; mt < 2; ++mt) { f32x16 acc;
#pragma unroll
                for (int i = 0; i < 16; ++i) acc[i] = 0.f;
                acc = __builtin_amdgcn_mfma_f32_32x32x16_bf16(af[mt][0], b0, acc, 0, 0, 0);
                acc = __builtin_amdgcn_mfma_f32_32x32x16_bf16(af[mt][1], b1, acc, 0, 0, 0);
#pragma unroll
                for (int q2 = 0; q2 < 2; ++q2) { float s = 0.f;
#pragma unroll
                    for (int hd = 0; hd < 8; ++hd) s += fmaxf(acc[8 * q2 + hd], 0.f) * wq[mt][q2][hd];
                    const int qi = 4 * mt + 2 * hh + q2;
                    sc[qi * 4096 + key] = (key <= qg * 8 + qi) ? s : -INFINITY; } }
        }
    }
    __syncthreads();
    const int qi = F.wave, tq = qg * 8 + qi, n = tq + 1;
    LAS float* scq = sc + qi * 4096; LAS unsigned short* sel = selall + qi * 256; LAS unsigned* hist = histall + qi * 256;
    int nsel;
    if (n <= 256) { nsel = n; for (int j = lane; j < 256; j += 64) sel[j] = (unsigned short)(j < n ? j : 0); }
    else {
        nsel = 256;
        const int R = (n + 63) >> 6;
        unsigned prefix = 0u; int need = 256; unsigned neq = 0u;
        for (int p = 0; p < 4; ++p) { const int shift = 24 - 8 * p;
            *(LAS u32x4*)(hist + 4 * lane) = (u32x4){0u, 0u, 0u, 0u};
            for (int i = 0; i < R; ++i) { const int j = lane + 64 * i; if (j < n) { const unsigned u = fkey(scq[j]);
                if (p == 0 || (u >> (shift + 8)) == prefix) atomicAdd((unsigned*)(hist + ((u >> shift) & 255u)), 1u); } }
            const u32x4 hv = *(const LAS u32x4*)(hist + 4 * lane);
            const unsigned tot = hv.x + hv.y + hv.z + hv.w;
            unsigned incl = tot;
#pragma unroll
            for (int o = 1; o < 64; o <<= 1) { const unsigned t = shdown_u(incl, o); if (lane + o < 64) incl += t; }
            const unsigned above = incl - tot;
            int fb = -1; unsigned fabove = 0u, feq = 0u; unsigned cum = above;
            { const unsigned hq[4] = {hv.x, hv.y, hv.z, hv.w};
#pragma unroll
              for (int q = 3; q >= 0; --q) { if (fb < 0 && cum < (unsigned)need && (unsigned)need <= cum + hq[q]) { fb = 4 * lane + q; fabove = cum; feq = hq[q]; } cum += hq[q]; } }
            const unsigned long long m = __ballot(fb >= 0);
            const int src = (int)__ffsll((long long)m) - 1;
            const int bin = shidx_i(fb, src); const unsigned ab = (unsigned)shidx_i((int)fabove, src); neq = (unsigned)shidx_i((int)feq, src);
            need -= (int)ab; prefix = (prefix << 8) | (unsigned)bin;
        }
        const int ngt = 256 - need;
        int base_gt = 0, base_eq = 0;
        for (int i = 0; i < R; ++i) { const int j = lane + 64 * i; const unsigned u = (j < n) ? fkey(scq[j]) : 0u;
            const bool gt = (j < n) && (u > prefix), eq = (j < n) && (u == prefix);
            const unsigned long long mg = __ballot(gt), me = __ballot(eq); const unsigned long long lt = (1ull << lane) - 1ull;
            if (gt) sel[base_gt + __popcll(mg & lt)] = (unsigned short)j;
            if (eq) { const int rk = base_eq + __popcll(me & lt); if (rk < need) sel[ngt + rk] = (unsigned short)j; }
            base_gt += __popcll(mg); base_eq += __popcll(me); }
        (void)neq;
    }
    const int nt16 = (nsel + 15) >> 4, r16 = lane & 15, g4 = lane >> 4;
    bf16x8 qf[2];
#pragma unroll
    for (int s = 0; s < 2; ++s) { u32x4 z = (u32x4){0u, 0u, 0u, 0u}; if (r16 < 4) z = *(const u32x4*)(U + (T0 + qi) * NINP + UC + r16 * 64 + 32 * s + 8 * g4); qf[s] = __builtin_bit_cast(bf16x8, z); }
    float lg[16][4]; float mx = -INFINITY;
#pragma unroll
    for (int m = 0; m < 16; ++m) {
        if (m < nt16) {
            const int key = sel[16 * m + r16];
            const bf16x8 a0 = *(const bf16x8*)(Kb + (TB + key) * 64 + 8 * g4), a1 = *(const bf16x8*)(Kb + (TB + key) * 64 + 32 + 8 * g4);
            f32x4 acc = (f32x4){0.f, 0.f, 0.f, 0.f};
            acc = __builtin_amdgcn_mfma_f32_16x16x32_bf16(a0, qf[0], acc, 0, 0, 0);
            acc = __builtin_amdgcn_mfma_f32_16x16x32_bf16(a1, qf[1], acc, 0, 0, 0);
#pragma unroll
            for (int i = 0; i < 4; ++i) { const int j = 16 * m + 4 * g4 + i; const int kj = sel[j]; const int dist = tq - kj;
                const int bk = dist < 128 ? bkt[dist < 0 ? 0 : dist] : 31;
                const float v = (j < nsel) ? acc[i] * 0.125f + biasT[bk * 4 + (r16 & 3)] : -INFINITY;
                lg[m][i] = v; mx = fmaxf(mx, v); }
        } else {
#pragma unroll
            for (int i = 0; i < 4; ++i) lg[m][i] = -INFINITY;
        }
    }
    mx = fmaxf(mx, shx(mx, 16)); mx = fmaxf(mx, shx(mx, 32));
    float sm = 0.f;
    LAS float* Pw = scq;
#pragma unroll
    for (int m = 0; m < 16; ++m) { if (m < nt16) {
#pragma unroll
        for (int i = 0; i < 4; ++i) { const float p = __expf(lg[m][i] - mx); sm += p; if (r16 < 4) Pw[(16 * m + 4 * g4 + i) * 4 + r16] = p; } } }
    sm += shx(sm, 16); sm += shx(sm, 32);
    if (lane < 4) Pw[1024 + lane] = 1.0f / sm;
    const int kg = lane >> 3, dc = lane & 7;
    float o[4][8];
#pragma unroll
    for (int h = 0; h < 4; ++h)
#pragma unroll
        for (int d = 0; d < 8; ++d) o[h][d] = 0.f;
    for (int i = 0; i < 2 * nt16; ++i) { const int j = 8 * i + kg; const int key = sel[j];
        float vv[8]; unpack8(*(const u32x4*)(Vb + (TB + key) * 64 + 8 * dc), vv);
        const f32x4 p4 = *(const LAS f32x4*)(Pw + 4 * j);
#pragma unroll
        for (int h = 0; h < 4; ++h)
#pragma unroll
            for (int d = 0; d < 8; ++d) o[h][d] += p4[h] * vv[d]; }
#pragma unroll
    for (int h = 0; h < 4; ++h)
#pragma unroll
        for (int d = 0; d < 8; ++d) { float v = o[h][d]; v += shx(v, 8); v += shx(v, 16); v += shx(v, 32); o[h][d] = v; }
    if (kg == 0) { bf16_t* Y = (bf16_t*)(F.ws + WS_H) + (T0 + qi) * DM + 512 + 8 * dc;
#pragma unroll
        for (int h = 0; h < 4; ++h) { const float inv = Pw[1024 + h];
            u32x4 w; w.x = pk2(o[h][0] * inv, o[h][1] * inv); w.y = pk2(o[h][2] * inv, o[h][3] * inv); w.z = pk2(o[h][4] * inv, o[h][5] * inv); w.w = pk2(o[h][6] * inv, o[h][7] * inv);
            *(u32x4*)(Y + h * 64) = w; } }
}

__device__ __forceinline__ void phase_router(const Frame& F_, int layer, int cset) { Frame F = relocal(F_);
    const float* X = (const float*)(F.ws + WS_X);
    const bf16_t* WH = (const bf16_t*)(F.ws + WS_WRT) + (size_t)layer * 2 * 49152; const bf16_t* WL = WH + 49152;
    LAS float* part = (LAS float*)F.lds;
    LAS float* ssq = (LAS float*)(F.lds + 24576);
    LAS int* es = (LAS int*)(F.lds + 25088);
    LAS int* lr = (LAS int*)(F.lds + 25600);
    LAS float* wsl = (LAS float*)(F.lds + 26112);
    LAS float* rsd = (LAS float*)(F.lds + 26624);
    for (int blk = F.bid; blk < NTOK / 64; blk += F.G) {
        __syncthreads();
        const int mt = F.wave & 3, kh = F.wave >> 2, r16 = F.lane & 15, g4 = F.lane >> 4;
        const float* xr = X + ((size_t)blk * 64 + mt * 16 + r16) * DM + kh * 512 + 8 * g4;
        f32x4 acc[3]; acc[0] = acc[1] = acc[2] = (f32x4){0.f, 0.f, 0.f, 0.f}; float ss = 0.f;
#pragma unroll 4
        for (int ks = 0; ks < 16; ++ks) {
            const f32x4 xa = *(const f32x4*)(xr + ks * 32), xb = *(const f32x4*)(xr + ks * 32 + 4);
            ss += xa[0] * xa[0] + xa[1] * xa[1] + xa[2] * xa[2] + xa[3] * xa[3] + xb[0] * xb[0] + xb[1] * xb[1] + xb[2] * xb[2] + xb[3] * xb[3];
            float xv[8] = {xa[0], xa[1], xa[2], xa[3], xb[0], xb[1], xb[2], xb[3]}; unsigned hw[4], lw[4];
#pragma unroll
            for (int j = 0; j < 4; ++j) { const bf16_t h0 = f2bf(xv[2 * j]), h1 = f2bf(xv[2 * j + 1]); hw[j] = (unsigned)h0 | ((unsigned)h1 << 16);
                lw[j] = pk2(xv[2 * j] - bf2f(h0), xv[2 * j + 1] - bf2f(h1)); }
            const bf16x8 ahi = __builtin_bit_cast(bf16x8, (u32x4){hw[0], hw[1], hw[2], hw[3]}), alo = __builtin_bit_cast(bf16x8, (u32x4){lw[0], lw[1], lw[2], lw[3]});
#pragma unroll
            for (int nt = 0; nt < 3; ++nt) { const size_t wo = (size_t)(nt * 16 + r16) * 1024 + kh * 512 + ks * 32 + 8 * g4;
                const bf16x8 bh = *(const bf16x8*)(WH + wo), bl = *(const bf16x8*)(WL + wo);
                acc[nt] = __builtin_amdgcn_mfma_f32_16x16x32_bf16(ahi, bh, acc[nt], 0, 0, 0);
                acc[nt] = __builtin_amdgcn_mfma_f32_16x16x32_bf16(ahi, bl, acc[nt], 0, 0, 0);
                acc[nt] = __builtin_amdgcn_mfma_f32_16x16x32_bf16(alo, bh, acc[nt], 0, 0, 0); }
        }
        ss += shx(ss, 16); ss += shx(ss, 32);
        if (g4 == 0) ssq[kh * 64 + mt * 16 + r16] = ss;
#pragma unroll
        for (int nt = 0; nt < 3; ++nt)
#pragma unroll
            for (int i = 0; i < 4; ++i) part[(kh * 64 + mt * 16 + 4 * g4 + i) * 48 + nt * 16 + r16] = acc[nt][i];
        __syncthreads();
        if (F.tid < 64) { const float rstd = rsqrtf((ssq[F.tid] + ssq[64 + F.tid]) * (1.0f / DM) + 1e-6f); rsd[F.tid] = rstd;
            float l[36];
#pragma unroll
            for (int o = 0; o < 36; ++o) l[o] = (part[F.tid * 48 + o] + part[(64 + F.tid) * 48 + o]) * rstd + (o < 32 ? F.in[I_BRE][layer * 32 + o] : F.in[I_BRG][layer * 4 + o - 32]);
            int gs = 0; float gm = l[32];
#pragma unroll
            for (int j = 1; j < 4; ++j) if (l[32 + j] > gm) { gm = l[32 + j]; gs = j; }
            float den = 0.f;
#pragma unroll
            for (int j = 0; j < 4; ++j) den += __expf(l[32 + j] - gm);
            const float gate = 1.0f / den;
            float e8[8];
#pragma unroll
            for (int j = 0; j < 8; ++j) e8[j] = gs == 0 ? l[j] : gs == 1 ? l[8 + j] : gs == 2 ? l[16 + j] : l[24 + j];
            int i1 = 0; float v1 = e8[0];
#pragma unroll
            for (int j = 1; j < 8; ++j) if (e8[j] > v1) { v1 = e8[j]; i1 = j; }
            int i2 = -1; float v2 = -INFINITY;
#pragma unroll
            for (int j = 0; j < 8; ++j) if (j != i1 && e8[j] > v2) { v2 = e8[j]; i2 = j; }
            const float e2 = __expf(v2 - v1); const float p1 = 1.0f / (1.0f + e2);
            es[F.tid * 2] = gs * 8 + i1; es[F.tid * 2 + 1] = gs * 8 + i2; wsl[F.tid * 2] = p1 * gate; wsl[F.tid * 2 + 1] = (1.0f - p1) * gate; }
        __syncthreads();
        if (F.tid < 32) { int cnt = 0; for (int i = 0; i < 128; ++i) if (es[i] == F.tid) lr[i] = cnt++;
            if (cnt) { const int base = (int)__hip_atomic_fetch_add(F.ctl + CW_CNT + cset * 32 + F.tid, (unsigned)cnt, __ATOMIC_RELAXED, __HIP_MEMORY_SCOPE_AGENT);
                for (int i = 0; i < 128; ++i) if (es[i] == F.tid) lr[i] += base; } }
        __syncthreads();
        if (F.tid < 64) { int* rt = (int*)(F.ws + WS_ROUTE) + ((size_t)blk * 64 + F.tid) * 8;
            rt[0] = es[F.tid * 2]; rt[1] = es[F.tid * 2 + 1]; ((float*)rt)[2] = wsl[F.tid * 2]; ((float*)rt)[3] = wsl[F.tid * 2 + 1]; rt[4] = lr[F.tid * 2]; rt[5] = lr[F.tid * 2 + 1]; ((float*)rt)[6] = rsd[F.tid]; }
    }
}
struct CmGU { __device__ __forceinline__ int operator()(int n) const { return 128 * (n >> 8) + (n & 127); } };
__device__ __forceinline__ void phase_moe_convert(const Frame& F_, int layer) { Frame F = relocal(F_);
    bf16_t* WGU = (bf16_t*)(F.ws + WS_MOE + MOE_WGU); bf16_t* WD = (bf16_t*)(F.ws + WS_MOE + MOE_WD);
    for (int t = F.bid; t < 6144; t += F.G) {
        if (t < 4096) { const int e = t >> 7, r = t & 127, kt = r >> 3, nt = r & 7; const bool up = ((nt * 64) & 255) >= 128;
            const float* src = (up ? F.in[I_WUP] : F.in[I_WGATE]) + ((size_t)layer * 32 + e) * 1024 * 256;
            tr_tile(F, src, 256, WGU + (size_t)e * 512 * 1024, 1024, kt * 64, nt * 64, CmGU()); }
        else { const int q = t - 4096, e = q >> 6, r = q & 63, kt = r >> 4, nt = r & 15;
            tr_tile(F, F.in[I_WDOWN] + ((size_t)layer * 32 + e) * 256 * 1024, 1024, WD + (size_t)e * 1024 * 256, 256, kt * 64, nt * 64, CmId()); }
    }
}
__device__ __forceinline__ void phase_gather(const Frame& F_, int layer) { Frame F = relocal(F_);
    LAS int* off = (LAS int*)F.lds;
    __syncthreads();
    if (F.tid == 0) { int acc = 0; for (int e = 0; e < 32; ++e) { off[e] = acc; const int c = (int)__hip_atomic_load(F.ctl + CW_CNT + layer * 32 + e, __ATOMIC_RELAXED, __HIP_MEMORY_SCOPE_AGENT); acc += (c + 255) & ~255; } off[32] = acc; }
    __syncthreads();
    int* tiles = (int*)(F.ws + WS_TILES); int* row_tok = (int*)(F.ws + WS_ROWS); float* row_w = (float*)(F.ws + WS_ROWS) + MAXROWS;
    if (F.bid == 0) { if (F.tid == 0) tiles[0] = off[32] >> 8; if (F.tid < 33) tiles[1 + F.tid] = off[F.tid];
        if (F.tid < 32) for (int rt = off[F.tid] >> 8; rt < (off[F.tid + 1] >> 8); ++rt) tiles[64 + rt] = F.tid; }
    for (int e = F.bid; e < 32; e += F.G) { const int c = (int)__hip_atomic_load(F.ctl + CW_CNT + layer * 32 + e, __ATOMIC_RELAXED, __HIP_MEMORY_SCOPE_AGENT);
        for (int r = off[e] + c + F.tid; r < off[e + 1]; r += NTHR) { row_tok[r] = -1; row_w[r] = 0.f; } }
    const float* X = (const float*)(F.ws + WS_X); bf16_t* HP = (bf16_t*)(F.ws + WS_U); const float* nw = F.in[I_NORM2] + (size_t)layer * DM;
    f32x4 nwv[4];
#pragma unroll
    for (int j = 0; j < 4; ++j) nwv[j] = *(const f32x4*)(nw + 4 * F.lane + 256 * j);
    for (int t = F.bid * 8 + F.wave; t < NTOK; t += F.G * 8) {
        const int* rt = (const int*)(F.ws + WS_ROUTE) + (size_t)t * 8; const float rstd = ((const float*)rt)[6];
        const int p0 = off[rt[0]] + rt[4], p1 = off[rt[1]] + rt[5];
#pragma unroll
        for (int j = 0; j < 4; ++j) { const int c = 4 * F.lane + 256 * j; const f32x4 v = *(const f32x4*)(X + (size_t)t * DM + c) * rstd * nwv[j];
            u32x2 o; o.x = pk2(v[0], v[1]); o.y = pk2(v[2], v[3]);
            *(u32x2*)(HP + (size_t)p0 * DM + c) = o; *(u32x2*)(HP + (size_t)p1 * DM + c) = o; }
        if (F.lane == 0) { row_tok[p0] = t * 2; row_w[p0] = ((const float*)rt)[2]; row_tok[p1] = t * 2 + 1; row_w[p1] = ((const float*)rt)[3]; }
    }
}

constexpr int NPH_LAYER = 11, NPHASE = 1 + 2 * NPH_LAYER + 1;
__global__ void __launch_bounds__(NTHR, 2) mk_forward(Params P) {
    extern __shared__ __attribute__((aligned(16))) unsigned char lds_raw[];
    Frame F; F.lds = (LAS unsigned char*)lds_raw; F.tid = threadIdx.x; F.lane = F.tid & 63; F.wave = __builtin_amdgcn_readfirstlane(F.tid >> 6); F.bid = blockIdx.x; F.G = gridDim.x;
    F.in = (in_tab_t)__builtin_amdgcn_kernarg_segment_ptr(); F.out = P.out; F.ws = P.ws; F.ctl = (unsigned*)(P.ws + WS_CTL); F.misc = (volatile LAS int*)(F.lds + MISC_OFF);
    if (F.tid < 64) ((LAS unsigned*)(F.lds + MISC_OFF))[F.tid] = 0u;
    __syncthreads();
    const int lo = P.ph_lo, hi = P.ph_hi;
    XcdBarrier bar; bar.bar = F.ctl + CW_BAR; bar.x = 0; bar.st = (volatile LAS unsigned*)(F.lds + MISC_OFF + 16);
    if (hi - lo > 1) bar = xcd_barrier_post(F.ctl + CW_BAR, (volatile LAS unsigned*)(F.lds + MISC_OFF + 16));
#ifndef MK_ONLY
#define MK_ONLY -1
#endif
#define EN(o) (MK_ONLY < 0 || MK_ONLY == (o))
#ifndef MK_ITEM
#define MK_ITEM -1
#endif
#define IT(o) (MK_ITEM < 0 || MK_ITEM == (o))
#define IN(k) (lo <= (k) && (k) < hi)
#ifndef RPH
#define RPH -1
#endif
#define SEAM(k) do { if (IN(k) && IN((k) + 1)) xcd_barrier(bar); } while (0)
    if (EN(100) && IN(0)) { phase_prologue(F); } SEAM(0);
#if RPH == 101
    if (IN(1)) { phase_norm(F, F.in[I_X], false, F.in[I_NORM1], 0); phase_norm(F, F.in[I_X], false, F.in[I_NORM1], 0); phase_norm(F, F.in[I_X], false, F.in[I_NORM1], 0); phase_norm(F, F.in[I_X], false, F.in[I_NORM1], 0); } SEAM(0);
#endif
#if RPH == 100
    if (IN(0)) { phase_prologue(F); } SEAM(0);
#endif
#pragma unroll
    for (int layer = 0; layer < DEPTH; ++layer) {
        const int pb = 1 + layer * NPH_LAYER;
        if (EN(0) && IN(pb + 0)) { phase_norm(F, layer == 0 ? F.in[I_X] : (const float*)(F.ws + WS_X), layer > 0, F.in[I_NORM1] + (size_t)layer * DM, 0); } SEAM(pb + 0);
        if (EN(1) && IN(pb + 1)) { const Frame F_ = F; Frame F = relocal(F_); pg8::StaticOrder S; S.init((const bf16_t*)(F.ws + WS_H), (const bf16_t*)(F.ws + WS_WIN) + (size_t)layer * NINP * DM, NTOK, NINP, DM, F.G, F.bid);
            pg8::EpiBf16 E{(bf16_t*)(F.ws + WS_U), NINP}; pg8::gemm_phase(F.lds, DM, S, E); } SEAM(pb + 1);
#if RPH == 1
        if (IN(pb + 1)) { const Frame F_ = F; Frame F = relocal(F_); pg8::StaticOrder S; S.init((const bf16_t*)(F.ws + WS_H), (const bf16_t*)(F.ws + WS_WIN) + (size_t)layer * NINP * DM, NTOK, NINP, DM, F.G, F.bid);
            pg8::EpiBf16 E{(bf16_t*)(F.ws + WS_U), NINP}; pg8::gemm_phase(F.lds, DM, S, E); } SEAM(pb + 1);
#endif
#ifndef REP_C
#define REP_C 1
#endif
#ifndef REP_D
#define REP_D 1
#endif
#ifndef REP_E
#define REP_E 1
#endif
#define QLOOP(qi, n, body) for (;;) { const int it = q_pop(F, layer * 12 + (qi)); if (it >= (n)) break; body; }
        if (EN(2) && IN(pb + 2)) {
            if (IT(0)) QLOOP(0, 256, item_s5<1>(F, layer, it));
            if (IT(1)) QLOOP(1, 1024, item_rwkv1(F, layer, it));
            if (IT(2)) QLOOP(2, 256, item_mamba<1>(F, layer, it));
            if (IT(3)) QLOOP(3, 256, item_kv(F, layer, it));
#if REP_C == 2
            QLOOP(24, 256, item_s5<1>(F, layer, it));
#elif REP_C == 3
            QLOOP(25, 1024, item_rwkv1(F, layer, it));
#elif REP_C == 4
            QLOOP(26, 256, item_mamba<1>(F, layer, it));
#elif REP_C == 5
            QLOOP(27, 256, item_kv(F, layer, it));
#endif
        } SEAM(pb + 2);
        if (EN(3) && IN(pb + 3)) {
            if (IT(0)) QLOOP(4, 8, item_rwkv_carry(F, it));
            if (IT(1)) QLOOP(5, 16, item_mamba_carry(F, it));
            if (IT(2)) QLOOP(6, 4, item_s5_carry(F, layer, it));
            if (IT(3)) QLOOP(7, 2048, item_dsa(F, layer, it));
#if REP_D == 2
            QLOOP(31, 2048, item_dsa(F, layer, it));
#endif
        } SEAM(pb + 3);
        if (EN(4) && IN(pb + 4)) {
            if (IT(0)) QLOOP(8, 256, item_s5<2>(F, layer, it));
            if (IT(1)) QLOOP(9, 1024, item_rwkv3(F, layer, it));
            if (IT(2)) QLOOP(10, 256, item_mamba<2>(F, layer, it));
#if REP_E == 2
            QLOOP(32, 256, item_s5<2>(F, layer, it));
#elif REP_E == 3
            QLOOP(33, 1024, item_rwkv3(F, layer, it));
#elif REP_E == 4
            QLOOP(34, 256, item_mamba<2>(F, layer, it));
#endif
        } SEAM(pb + 4);
        if (EN(5) && IN(pb + 5)) { const Frame F_ = F; Frame F = relocal(F_); pg8::StaticOrder S; S.init((const bf16_t*)(F.ws + WS_MOE + YSG_OFF), (const bf16_t*)(F.ws + WS_GLU) + (size_t)layer * 512 * 256, NTOK, 512, 256, F.G, F.bid);
            pg8::EpiGated<0> E{(bf16_t*)(F.ws + WS_H), DM, 768, F.in[I_SGLUB] + layer * 512, F.in[I_SGLUB] + layer * 512 + 256}; pg8::gemm_phase(F.lds, 256, S, E); } SEAM(pb + 5);
#if RPH == 5
        if (IN(pb + 5)) { const Frame F_ = F; Frame F = relocal(F_); pg8::StaticOrder S; S.init((const bf16_t*)(F.ws + WS_MOE + YSG_OFF), (const bf16_t*)(F.ws + WS_GLU) + (size_t)layer * 512 * 256, NTOK, 512, 256, F.G, F.bid);
            pg8::EpiGated<0> E{(bf16_t*)(F.ws + WS_H), DM, 768, F.in[I_SGLUB] + layer * 512, F.in[I_SGLUB] + layer * 512 + 256}; pg8::gemm_phase(F.lds, 256, S, E); } SEAM(pb + 5);
#endif
        if (EN(6) && IN(pb + 6)) { const Frame F_ = F; Frame F = relocal(F_); pg8::StaticOrder S; S.init((const bf16_t*)(F.ws + WS_H), (const bf16_t*)(F.ws + WS_WOUT) + (size_t)layer * DM * DM, NTOK, DM, DM, F.G, F.bid);
            pg8::EpiResid E{(float*)(F.ws + WS_X), DM}; pg8::gemm_phase(F.lds, DM, S, E); } SEAM(pb + 6);
        if (EN(7) && IN(pb + 7)) { phase_router(F, layer, layer); phase_moe_convert(F, layer); } SEAM(pb + 7);
#if RPH == 70
        if (IN(pb + 7)) { phase_router(F, layer, layer + 2); } SEAM(pb + 7);
#endif
#if RPH == 7
        if (IN(pb + 7)) { phase_moe_convert(F, layer); } SEAM(pb + 7);
#endif
        if (EN(8) && IN(pb + 8)) { phase_gather(F, layer); } SEAM(pb + 8);
#if RPH == 8
        if (IN(pb + 8)) { phase_gather(F, layer); } SEAM(pb + 8);
#endif
        if (EN(9) && IN(pb + 9)) { const Frame F_ = F; Frame F = relocal(F_); pg8::MoeOrder S{2, F.G, F.bid, DM, (const char*)(F.ws + WS_U), (const char*)(F.ws + WS_MOE + MOE_WGU), (size_t)512 * 1024 * 2, (const int*)(F.ws + WS_TILES)};
            pg8::EpiGated<1> E{(bf16_t*)(F.ws + WS_H), 256, 0, nullptr, nullptr}; pg8::gemm_phase(F.lds, DM, S, E); } SEAM(pb + 9);
#if RPH == 9
        if (IN(pb + 9)) { const Frame F_ = F; Frame F = relocal(F_); pg8::MoeOrder S{2, F.G, F.bid, DM, (const char*)(F.ws + WS_U), (const char*)(F.ws + WS_MOE + MOE_WGU), (size_t)512 * 1024 * 2, (const int*)(F.ws + WS_TILES)};
            pg8::EpiGated<1> E{(bf16_t*)(F.ws + WS_H), 256, 0, nullptr, nullptr}; pg8::gemm_phase(F.lds, DM, S, E); } SEAM(pb + 9);
#endif
        if (EN(10) && IN(pb + 10)) { const Frame F_ = F; Frame F = relocal(F_); pg8::MoeOrder S{4, F.G, F.bid, 256, (const char*)(F.ws + WS_H), (const char*)(F.ws + WS_MOE + MOE_WD), (size_t)1024 * 256 * 2, (const int*)(F.ws + WS_TILES)};
            pg8::EpiMoeOut E{(bf16_t*)(F.ws + WS_U), (const int*)(F.ws + WS_ROWS), (const float*)(F.ws + WS_ROWS) + MAXROWS}; pg8::gemm_phase(F.lds, 256, S, E); } SEAM(pb + 10);
#if RPH == 10
        if (IN(pb + 10)) { const Frame F_ = F; Frame F = relocal(F_); pg8::MoeOrder S{4, F.G, F.bid, 256, (const char*)(F.ws + WS_H), (const char*)(F.ws + WS_MOE + MOE_WD), (size_t)1024 * 256 * 2, (const int*)(F.ws + WS_TILES)};
            pg8::EpiMoeOut E{(bf16_t*)(F.ws + WS_U), (const int*)(F.ws + WS_ROWS), (const float*)(F.ws + WS_ROWS) + MAXROWS}; pg8::gemm_phase(F.lds, 256, S, E); } SEAM(pb + 10);
#endif
    }
    if (EN(101) && IN(NPHASE - 1)) { phase_norm(F, (const float*)(F.ws + WS_X), true, F.in[I_FNORM], 2); }
#undef IN
#undef SEAM
}

#ifndef MK_SPLIT
#define MK_SPLIT 0
#endif
extern "C" void kernel_launch(void* const* d_in, const int* in_sizes, int n_in, void* d_out, int out_size, void* d_ws, size_t ws_size, hipStream_t stream) {
    static int grid = 0;
    if (grid == 0) {
        if (n_in != 44 || out_size != NTOK * DM || ws_size < WS_END) { fprintf(stderr, "kernel_launch: unexpected shapes (n_in %d out %d ws %zu need %zu)\n", n_in, out_size, ws_size, (size_t)WS_END); grid = -1; return; }
        int dev = 0, cus = 0;
        if (hipGetDevice(&dev) != hipSuccess || hipDeviceGetAttribute(&cus, hipDeviceAttributeMultiprocessorCount, dev) != hipSuccess) { grid = -1; return; }
        if (hipFuncSetAttribute((const void*)mk_forward, hipFuncAttributeMaxDynamicSharedMemorySize, LDS_BYTES) != hipSuccess) { fprintf(stderr, "kernel_launch: hipFuncSetAttribute failed\n"); grid = -1; return; }
        int per_cu = 0;
        if (hipOccupancyMaxActiveBlocksPerMultiprocessor(&per_cu, (const void*)mk_forward, NTHR, LDS_BYTES) != hipSuccess || per_cu < 1) { fprintf(stderr, "kernel_launch: occupancy query says %d\n", per_cu); }
        (void)hipGetLastError();
        grid = cus;
    }
    if (grid < 0) return;
    hipMemsetAsync((char*)d_ws + WS_CTL, 0, CTL_BYTES, stream);
    Params p{};
    for (int i = 0; i < 44; ++i) p.in[i] = (const float*)d_in[i];
    p.out = (float*)d_out; p.ws = (unsigned char*)d_ws;
#if MK_SPLIT
    for (int ph = 0; ph < NPHASE; ++ph) { p.ph_lo = ph; p.ph_hi = ph + 1; hipLaunchKernelGGL(mk_forward, dim3(grid), dim3(NTHR), LDS_BYTES, stream, p); }
#else
    p.ph_lo = 0; p.ph_hi = NPHASE; hipLaunchKernelGGL(mk_forward, dim3(grid), dim3(NTHR), LDS_BYTES, stream, p);
#endif
}
```

```cpp
#include <hip/hip_runtime.h>
#include <stdint.h>
#include <stdio.h>

#define LAS __attribute__((address_space(3)))
typedef unsigned short bf16_t;
typedef short bf16x8 __attribute__((ext_vector_type(8)));
typedef float f32x4 __attribute__((ext_vector_type(4)));
typedef float f32x2 __attribute__((ext_vector_type(2)));
typedef float f32x16 __attribute__((ext_vector_type(16)));
typedef unsigned u32x4 __attribute__((ext_vector_type(4)));
typedef unsigned u32x2 __attribute__((ext_vector_type(2)));

constexpr int NTOK = 16384, DM = 1024, SEQ = 4096, NBATCH = 4, DEPTH = 2;
constexpr int NIN = 2604, NINP = 2816;
constexpr int UM = 0;
constexpr int UR = 784;
constexpr int UC = 1680;
constexpr int US = 2368;
constexpr int NTHR = 512;
constexpr int LDS_BYTES = 163840;
constexpr int MISC_OFF = LDS_BYTES - 256;

constexpr size_t WS_CTL   = 0;
constexpr size_t CTL_BYTES = 65536;
constexpr size_t WS_X     = WS_CTL + CTL_BYTES;
constexpr size_t WS_H     = WS_X + (size_t)NTOK * DM * 4;
constexpr size_t WS_U     = WS_H + (size_t)NTOK * DM * 2;
constexpr size_t WS_WIN   = WS_U + (size_t)NTOK * NINP * 2;
constexpr size_t WS_WOUT  = WS_WIN + (size_t)2 * NINP * DM * 2;
constexpr size_t WS_GLU   = WS_WOUT + (size_t)2 * DM * DM * 2;
constexpr size_t WS_MOE   = WS_GLU + (size_t)2 * 512 * 256 * 2;
constexpr size_t MOE_WGU  = 0;
constexpr size_t MOE_WD   = (size_t)32 * 512 * 1024 * 2;
constexpr size_t MOE_BYTES = MOE_WD + (size_t)32 * 1024 * 256 * 2;
constexpr size_t RW_PT    = 0;
constexpr size_t RW_U     = (size_t)1024 * 4096 * 2;
constexpr size_t RW_S     = RW_U + (size_t)1024 * 4096 * 4;
constexpr size_t YSG_OFF  = RW_S + (size_t)1024 * 4096 * 4;
static_assert(YSG_OFF + (size_t)NTOK * 256 * 2 <= MOE_BYTES, "alias");
constexpr size_t WS_MST   = WS_MOE + MOE_BYTES;
constexpr size_t WS_MDEC  = WS_MST + (size_t)4 * 64 * 4 * 4096 * 4;
constexpr size_t WS_S5ST  = WS_MDEC + 4096;
constexpr size_t WS_K     = WS_S5ST + (size_t)4 * 64 * 2048 * 4;
constexpr size_t WS_V     = WS_K + (size_t)NTOK * 64 * 2;
constexpr size_t WS_KIDX  = WS_V + (size_t)NTOK * 64 * 2;
constexpr size_t WS_ROUTE = WS_KIDX + (size_t)NTOK * 32 * 2;
constexpr size_t WS_ROWS  = WS_ROUTE + (size_t)NTOK * 32;
constexpr int    MAXROWS  = 49152;
constexpr size_t WS_TILES = WS_ROWS + (size_t)MAXROWS * 8;
constexpr size_t WS_S5TAB = WS_TILES + 4096;
constexpr size_t S5TAB_F  = (size_t)(2048 + 2048 + 32768) * 4;
constexpr size_t S5TAB_L  = S5TAB_F + (size_t)16 * 16 * 128 * 2;
constexpr size_t WS_WRT   = WS_S5TAB + 2 * S5TAB_L;
constexpr size_t WS_END   = WS_WRT + (size_t)2 * 2 * 48 * 1024 * 2;

constexpr int CW_BAR = 0;
constexpr int CW_Q   = 4096;
constexpr int CW_CNT = 8192;

__device__ __forceinline__ float bf2f(bf16_t b) { return __uint_as_float(((unsigned)b) << 16); }
__device__ __forceinline__ bf16_t f2bf(float f) { unsigned u = __float_as_uint(f); u += 0x7FFFu + ((u >> 16) & 1u); return (bf16_t)(u >> 16); }
__device__ __forceinline__ unsigned pk2(float lo, float hi) { return (unsigned)f2bf(lo) | ((unsigned)f2bf(hi) << 16); }
__device__ __forceinline__ unsigned cvt_pk_bf16(float lo, float hi) { unsigned r; asm volatile("v_cvt_pk_bf16_f32 %0, %1, %2" : "=v"(r) : "v"(lo), "v"(hi)); return r; }
__device__ __forceinline__ float sigmoidf_(float x) { return 1.0f / (1.0f + __expf(-x)); }
__device__ __forceinline__ float siluf_(float x) { return x / (1.0f + __expf(-x)); }
__device__ __forceinline__ float tanhf_(float x) { const float e = __expf(2.0f * x); return 1.0f - 2.0f / (e + 1.0f); }
__device__ __forceinline__ float softplusf_(float x) { return fmaxf(x, 0.0f) + log1pf(__expf(-fabsf(x))); }
__device__ __forceinline__ float gelu_tanh(float x) { return 0.5f * x * (1.0f + tanhf_(0.7978845608028654f * (x + 0.044715f * x * x * x))); }
template <int CTRL> __device__ __forceinline__ float dppf(float x) { return __int_as_float(__builtin_amdgcn_update_dpp(0, __float_as_int(x), CTRL, 0xF, 0xF, true)); }
__device__ __forceinline__ float sum4(float x) { x += dppf<0xB1>(x); x += dppf<0x4E>(x); return x; }
__device__ __forceinline__ float sum8(float x) { x = sum4(x); x += dppf<0x141>(x); return x; }
__device__ __forceinline__ float sum16(float x) { x = sum8(x); x += dppf<0x140>(x); return x; }
__device__ __forceinline__ int lane_id_() { int l = (int)__builtin_amdgcn_mbcnt_hi(~0u, __builtin_amdgcn_mbcnt_lo(~0u, 0u)); asm volatile("" : "+v"(l)); return l; }
__device__ __forceinline__ float shx(float x, int o) { return __int_as_float(__builtin_amdgcn_ds_bpermute((lane_id_() ^ o) << 2, __float_as_int(x))); }
__device__ __forceinline__ unsigned shdown_u(unsigned x, int o) { return (unsigned)__builtin_amdgcn_ds_bpermute(((lane_id_() + o) & 63) << 2, (int)x); }
__device__ __forceinline__ int shidx_i(int x, int src) { return __builtin_amdgcn_ds_bpermute(src << 2, x); }
__device__ __forceinline__ float wave_sum(float x) { x = sum16(x); x += shx(x, 16); x += shx(x, 32); return x; }
__device__ __forceinline__ void unpack8(const u32x4 v, float (&f)[8]) {
    f[0] = __uint_as_float(v.x << 16); f[1] = __uint_as_float(v.x & 0xffff0000u); f[2] = __uint_as_float(v.y << 16); f[3] = __uint_as_float(v.y & 0xffff0000u);
    f[4] = __uint_as_float(v.z << 16); f[5] = __uint_as_float(v.z & 0xffff0000u); f[6] = __uint_as_float(v.w << 16); f[7] = __uint_as_float(v.w & 0xffff0000u);
}

#define XB_TMO      128
#define XB_XCNT(j)  (256  + 64 * (j))
#define XB_XSUB(j)  (1280 + 64 * (j))
#define XB_XGEN(j)  (2304 + 64 * (j))
#define XB_TOP      3328
#define XB_TOPGEN   3392
#define XCD_BAR_WORDS 3456
#define XB_SPIN_CAP (1u << 22)
__device__ __forceinline__ unsigned xb_ld(unsigned* p)              { return __hip_atomic_load(p, __ATOMIC_RELAXED, __HIP_MEMORY_SCOPE_AGENT); }
__device__ __forceinline__ unsigned xb_add(unsigned* p, unsigned v) { return __hip_atomic_fetch_add(p, v, __ATOMIC_RELAXED, __HIP_MEMORY_SCOPE_AGENT); }
__device__ __forceinline__ unsigned xb_xcc_id() { return (unsigned)__builtin_amdgcn_s_getreg((3 << 11) | 20) & 0xFu; }
#define XB_SPIN(cond, bar) do { unsigned _sp = 0; while (cond) { __builtin_amdgcn_s_sleep(1); \
    if ((++_sp & 255u) == 0u) { if (xb_ld(&(bar)[XB_TMO])) break; if (_sp > XB_SPIN_CAP) { atomicAdd(&(bar)[XB_TMO], 1u); break; } } } } while (0)
struct XcdBarrier { unsigned* bar; unsigned x; volatile LAS unsigned* st; };
__device__ __forceinline__ XcdBarrier xcd_barrier_post(unsigned* bar, volatile LAS unsigned* st) {
    XcdBarrier b; b.bar = bar; b.x = xb_xcc_id(); b.st = st;
    if (threadIdx.x == 0) (void)xb_add(&bar[XB_XCNT(b.x)], 1u);
    return b;
}
__device__ __forceinline__ void xcd_barrier_complete(unsigned* bar, unsigned x, unsigned& nloc, unsigned& nx) {
    const unsigned G = gridDim.x * gridDim.y * gridDim.z;
    unsigned sum, cnt, mine, sp = 0u;
    for (;;) {
        sum = 0u; cnt = 0u; mine = 0u;
#pragma unroll
        for (unsigned j = 0; j < 16; ++j) { const unsigned c = xb_ld(&bar[XB_XCNT(j)]); sum += c; cnt += (c > 0u) ? 1u : 0u; mine = (j == x) ? c : mine; }
        if (sum == G) break;
        __builtin_amdgcn_s_sleep(1);
        if ((++sp & 255u) == 0u) { if (xb_ld(&bar[XB_TMO])) break; if (sp > XB_SPIN_CAP) { atomicAdd(&bar[XB_TMO], 1u); break; } }
    }
    nloc = mine > 0u ? mine : 1u; nx = cnt > 0u ? cnt : 1u;
}
__device__ __forceinline__ void xcd_barrier(const XcdBarrier& b_) {
    XcdBarrier b = b_; { const unsigned long long v = (unsigned long long)b.bar; unsigned lo = __builtin_amdgcn_readfirstlane((unsigned)v), hi = __builtin_amdgcn_readfirstlane((unsigned)(v >> 32)); asm volatile("" : "+s"(lo), "+s"(hi)); b.bar = (unsigned*)(((unsigned long long)hi << 32) | lo); unsigned xx = __builtin_amdgcn_readfirstlane(b.x); asm volatile("" : "+s"(xx)); b.x = xx; }
    asm volatile("s_waitcnt vmcnt(0)" ::: "memory");
    __syncthreads();
    if (threadIdx.x == 0) {
        unsigned* bar = b.bar;
        __builtin_amdgcn_s_waitcnt(0);
        unsigned nloc = b.st[0], nx = b.st[1];
        if (nloc == 0u) { xcd_barrier_complete(bar, b.x, nloc, nx); b.st[0] = nloc; b.st[1] = nx; }
        const unsigned old = xb_add(&bar[XB_XSUB(b.x)], 1u);
        const unsigned gen = old / nloc;
        if (old + 1u == (gen + 1u) * nloc) {
            __builtin_amdgcn_fence(__ATOMIC_RELEASE, "agent");
            asm volatile("s_waitcnt vmcnt(0)" ::: "memory");
            const unsigned og = xb_add(&bar[XB_TOP], 1u);
            const unsigned tg = og / nx;
            if (og + 1u == (tg + 1u) * nx) xb_add(&bar[XB_TOPGEN], 1u);
            else XB_SPIN(xb_ld(&bar[XB_TOPGEN]) == tg, bar);
            __builtin_amdgcn_fence(__ATOMIC_ACQUIRE, "agent");
            xb_add(&bar[XB_XGEN(b.x)], 1u);
            asm volatile("s_waitcnt vmcnt(0)" ::: "memory");
        } else {
            XB_SPIN(xb_ld(&bar[XB_XGEN(b.x)]) == gen, bar);
            __builtin_amdgcn_fence(__ATOMIC_ACQUIRE, "agent");
            asm volatile("s_waitcnt vmcnt(0)" ::: "memory");
        }
    }
    __syncthreads();
}

namespace pg8 {
constexpr int BM = 256, BK = 64, HALF = 128, HTB = HALF * BK * 2, STAGE_BYTES = 8 * HTB, NXCD = 8, WGM = 8;
__host__ __device__ __forceinline__ int lds_byte(int r, int c) { const int st = (r >> 4) * 2 + (c >> 5), rr = r & 15, cc = c & 31, ob = rr * 64 + cc * 2; return st * 1024 + (ob ^ (((ob >> 9) & 1) << 5)); }
__host__ __device__ __forceinline__ void stage_rc(int b, int& R, int& C) { const int st = b / 1024, sb = b % 1024, swz = sb ^ (((sb >> 9) & 1) << 5); R = (st >> 1) * 16 + swz / 64; C = (st & 1) * 32 + (swz % 64) / 2; }
__host__ __device__ __forceinline__ int perm32(int rho) { const int n = rho >> 4, i = rho & 15; return 8 * (i >> 2) + 4 * n + (i & 3); }
struct Unit { int pm, pn; const char* a; const char* b; };

struct StaticOrder {
    int nM, nN, nwg, G, c, K; const char* A; const char* B;
    __device__ void init(const bf16_t* A_, const bf16_t* B_, int M, int N, int K_, int G_, int c_) { A = (const char*)A_; B = (const char*)B_; K = K_; nM = M / BM; nN = N / BM; nwg = nM * nN; G = G_; c = c_; }
    __device__ bool next(int i, Unit& u) const {
        const long L = (long)i * G + c; if (L >= nwg) return false;
        int wgid = (int)L; { const int q = nwg / NXCD, r = nwg % NXCD, xcd = wgid % NXCD, off = wgid / NXCD; wgid = (xcd < r ? xcd * (q + 1) : r * (q + 1) + (xcd - r) * q) + off; }
        const int nig = WGM * nN, gid = wgid / nig, fm = gid * WGM, gsz = (nM - fm) < WGM ? (nM - fm) : WGM;
        u.pm = fm + ((wgid % nig) % gsz); u.pn = (wgid % nig) / gsz;
        u.a = A + (size_t)u.pm * 256 * K * 2; u.b = B + (size_t)u.pn * 256 * K * 2; return true;
    }
};

template <class Epi, class Sched>
__device__ __forceinline__ void gemm_phase(LAS unsigned char* lds, const int K_, const Sched& S, const Epi& E) {
    int K = K_; asm volatile("" : "+s"(K));
    int tid_ = threadIdx.x; asm volatile("" : "+v"(tid_));
    const int tid = tid_, wid = __builtin_amdgcn_readfirstlane(tid >> 6), lane = tid & 63, wr = wid >> 2, wc = wid & 3, fr = lane & 15, fq = lane >> 4;
    const int nt = K / BK;
    unsigned voffA[2], voffB[2];
#pragma unroll
    for (int i = 0; i < 2; ++i) { int R, C; stage_rc(tid * 16 + i * 8192, R, C); const int Rb = Epi::PERM ? ((R & ~31) + perm32(R & 31)) : R;
        voffA[i] = (unsigned)(R * K + C) * 2u; voffB[i] = (unsigned)(Rb * K + C) * 2u; }
    const size_t kstep = (size_t)(BK * 2);
    const size_t hstep = (size_t)HALF * K * 2;
    const unsigned ldsw = (unsigned)wid * 1024u;
    const int aoff = lds_byte(wr * 64 + fr, fq * 8), boff = lds_byte(wc * 32 + fr, fq * 8);
#define PG8_SA(b, h) (((b) * 2 + (h)) * HTB)
#define PG8_SB(b, h) ((4 + (b) * 2 + (h)) * HTB)
#define PG8_STAGE(bufoff, gbase, voff) do { _Pragma("unroll") for (int _i = 0; _i < 2; ++_i) \
        __builtin_amdgcn_global_load_lds((const unsigned*)((const char*)(gbase) + (voff)[_i]), (LAS unsigned*)(lds + (bufoff) + ldsw + _i * 8192), 16, 0, 0); } while (0)
#define PG8_LDA(dst, b, h) do { _Pragma("unroll") for (int m = 0; m < 4; ++m) _Pragma("unroll") for (int k = 0; k < 2; ++k) dst[m][k] = *(const LAS bf16x8*)(lds + PG8_SA(b, h) + aoff + m * 2048 + k * 1024); } while (0)
#define PG8_LDB(dst, b, h) do { _Pragma("unroll") for (int n = 0; n < 2; ++n) _Pragma("unroll") for (int k = 0; k < 2; ++k) dst[n][k] = *(const LAS bf16x8*)(lds + PG8_SB(b, h) + boff + n * 2048 + k * 1024); } while (0)
#define PG8_MMA(ai, bj, At, Bt) do { __builtin_amdgcn_s_setprio(1); _Pragma("unroll") for (int m = 0; m < 4; ++m) _Pragma("unroll") for (int n = 0; n < 2; ++n) _Pragma("unroll") for (int k = 0; k < 2; ++k) \
        acc[ai][bj][m][n] = __builtin_amdgcn_mfma_f32_16x16x32_bf16(Bt[n][k], At[m][k], acc[ai][bj][m][n], 0, 0, 0); __builtin_amdgcn_s_setprio(0); } while (0)
#define PG8_WAIT_V(n) asm volatile("s_waitcnt vmcnt(" #n ")" ::: "memory")
#define PG8_WAIT_L(n) asm volatile("s_waitcnt lgkmcnt(" #n ")" ::: "memory")
#define PG8_BAR __builtin_amdgcn_s_barrier()
#define PG8_SCHED __builtin_amdgcn_sched_barrier(0)
    Unit cur, nxt; int ui = 0;
    if (!S.next(0, cur)) return;
    f32x4 acc[2][2][4][2];
#pragma unroll
    for (int a = 0; a < 2; ++a)
#pragma unroll
        for (int b = 0; b < 2; ++b)
#pragma unroll
            for (int m = 0; m < 4; ++m)
#pragma unroll
                for (int n = 0; n < 2; ++n) acc[a][b][m][n] = (f32x4){0.f, 0.f, 0.f, 0.f};
    bf16x8 At[4][2], B0[2][2], B1[2][2];
    const char* cA = cur.a; const char* cB = cur.b;
    PG8_STAGE(PG8_SB(0, 0), cB, voffB); PG8_STAGE(PG8_SA(0, 0), cA, voffA); PG8_STAGE(PG8_SB(0, 1), cB + hstep, voffB); PG8_STAGE(PG8_SA(0, 1), cA + hstep, voffA);
    if (wr == 1) PG8_BAR;
    PG8_WAIT_V(4); PG8_BAR;
    PG8_STAGE(PG8_SB(1, 0), cB + kstep, voffB); PG8_STAGE(PG8_SA(1, 0), cA + kstep, voffA); PG8_STAGE(PG8_SB(1, 1), cB + hstep + kstep, voffB);
    PG8_WAIT_V(6); PG8_BAR;
    for (;;) {
        const bool has_next = S.next(ui + 1, nxt);
        const char* nA = has_next ? nxt.a : cA; const char* nB = has_next ? nxt.b : cB;
        for (int t = 0; t < nt; t += 2) {
            const bool last = (t == nt - 2);
            const char* a1 = cA + (size_t)(t + 1) * kstep;
            const char* a2 = last ? nA : cA + (size_t)(t + 2) * kstep; const char* b2 = last ? nB : cB + (size_t)(t + 2) * kstep;
            const char* a3 = a2 + kstep; const char* b3 = b2 + kstep;
            PG8_LDB(B0, 0, 0); PG8_SCHED; PG8_LDA(At, 0, 0); PG8_STAGE(PG8_SA(1, 1), a1 + hstep, voffA);
            PG8_WAIT_L(8); PG8_BAR; PG8_WAIT_L(0); PG8_MMA(0, 0, At, B0); PG8_BAR; PG8_SCHED;
            PG8_LDB(B1, 0, 1); PG8_STAGE(PG8_SB(0, 0), b2, voffB);
            PG8_BAR; PG8_WAIT_L(0); PG8_MMA(0, 1, At, B1); PG8_BAR;
            PG8_LDA(At, 0, 1); PG8_STAGE(PG8_SA(0, 0), a2, voffA);
            PG8_BAR; PG8_WAIT_L(0); PG8_MMA(1, 0, At, B0); PG8_BAR; PG8_SCHED;
            PG8_STAGE(PG8_SB(0, 1), b2 + hstep, voffB);
            PG8_WAIT_V(6); PG8_BAR; PG8_MMA(1, 1, At, B1); PG8_BAR;
            PG8_LDB(B0, 1, 0); PG8_SCHED; PG8_LDA(At, 1, 0); PG8_STAGE(PG8_SA(0, 1), a2 + hstep, voffA);
            PG8_WAIT_L(8); PG8_BAR; PG8_WAIT_L(0); PG8_MMA(0, 0, At, B0); PG8_BAR; PG8_SCHED;
            PG8_LDB(B1, 1, 1); PG8_STAGE(PG8_SB(1, 0), b3, voffB);
            PG8_BAR; PG8_WAIT_L(0); PG8_MMA(0, 1, At, B1); PG8_BAR;
            PG8_LDA(At, 1, 1); PG8_STAGE(PG8_SA(1, 0), a3, voffA);
            PG8_BAR; PG8_WAIT_L(0); PG8_MMA(1, 0, At, B0); PG8_BAR; PG8_SCHED;
            PG8_STAGE(PG8_SB(1, 1), b3 + hstep, voffB);
            PG8_WAIT_V(6); PG8_BAR; PG8_MMA(1, 1, At, B1); PG8_BAR;
        }
        E(acc, cur, wr, wc, fr, fq);
        if (!has_next) break;
#pragma unroll
        for (int a = 0; a < 2; ++a)
#pragma unroll
            for (int b = 0; b < 2; ++b)
#pragma unroll
                for (int m = 0; m < 4; ++m)
#pragma unroll
                    for (int n = 0; n < 2; ++n) acc[a][b][m][n] = (f32x4){0.f, 0.f, 0.f, 0.f};
        cur = nxt; cA = nA; cB = nB; ++ui;
    }
    PG8_WAIT_V(0);
    if (wr == 0) PG8_BAR;
    PG8_BAR;
#undef PG8_SA
#undef PG8_SB
#undef PG8_STAGE
#undef PG8_LDA
#undef PG8_LDB
#undef PG8_MMA
#undef PG8_WAIT_V
#undef PG8_WAIT_L
#undef PG8_BAR
#undef PG8_SCHED
}

struct EpiBf16 {
    static constexpr bool PERM = true;
    bf16_t* O; int ldc;
    __device__ __forceinline__ void operator()(const f32x4 (&acc)[2][2][4][2], const Unit& u, int wr, int wc, int fr, int fq) const {
        const int row0 = u.pm * BM + wr * 64 + fr, col0 = u.pn * BM + wc * 32 + 8 * fq;
#pragma unroll
        for (int ai = 0; ai < 2; ++ai)
#pragma unroll
            for (int m = 0; m < 4; ++m) { bf16_t* rowp = O + (size_t)(row0 + ai * HALF + m * 16) * ldc + col0;
#pragma unroll
                for (int bj = 0; bj < 2; ++bj) { const f32x4 v0 = acc[ai][bj][m][0], v1 = acc[ai][bj][m][1];
                    u32x4 w; w.x = cvt_pk_bf16(v0[0], v0[1]); w.y = cvt_pk_bf16(v0[2], v0[3]); w.z = cvt_pk_bf16(v1[0], v1[1]); w.w = cvt_pk_bf16(v1[2], v1[3]);
                    *(u32x4*)(rowp + bj * HALF) = w; } }
    }
};
struct EpiResid {
    static constexpr bool PERM = false;
    float* C; int ldc;
    __device__ __forceinline__ void operator()(const f32x4 (&acc)[2][2][4][2], const Unit& u, int wr, int wc, int fr, int fq) const {
        const int row0 = u.pm * BM + wr * 64 + fr, col0 = u.pn * BM + wc * 32 + 4 * fq;
#pragma unroll
        for (int ai = 0; ai < 2; ++ai)
#pragma unroll
            for (int m = 0; m < 4; ++m) { float* rowp = C + (size_t)(row0 + ai * HALF + m * 16) * ldc + col0;
#pragma unroll
                for (int bj = 0; bj < 2; ++bj)
#pragma unroll
                    for (int n = 0; n < 2; ++n) { f32x4* p = (f32x4*)(rowp + bj * HALF + n * 16); *p = *p + acc[ai][bj][m][n]; } }
    }
};
template <int ACT  > struct EpiGated {
    static constexpr bool PERM = true;
    bf16_t* O; int ldo; int coloff; const float* ba; const float* bb;
    __device__ __forceinline__ void operator()(const f32x4 (&acc)[2][2][4][2], const Unit& u, int wr, int wc, int fr, int fq) const {
        const int row0 = u.pm * BM + wr * 64 + fr, cl = u.pn * HALF + wc * 32 + 8 * fq;
        float va[8], vb[8];
#pragma unroll
        for (int j = 0; j < 8; ++j) { va[j] = (ACT == 0) ? ba[cl + j] : 0.f; vb[j] = (ACT == 0) ? bb[cl + j] : 0.f; }
#pragma unroll
        for (int ai = 0; ai < 2; ++ai)
#pragma unroll
            for (int m = 0; m < 4; ++m) { bf16_t* rowp = O + (size_t)(row0 + ai * HALF + m * 16) * ldo + coloff + cl;
                float o[8];
#pragma unroll
                for (int n = 0; n < 2; ++n)
#pragma unroll
                    for (int j = 0; j < 4; ++j) { const float a = acc[ai][0][m][n][j] + va[4 * n + j], b = acc[ai][1][m][n][j] + vb[4 * n + j];
                        o[4 * n + j] = (ACT == 0) ? a * sigmoidf_(b) : siluf_(a) * b; }
                u32x4 w; w.x = cvt_pk_bf16(o[0], o[1]); w.y = cvt_pk_bf16(o[2], o[3]); w.z = cvt_pk_bf16(o[4], o[5]); w.w = cvt_pk_bf16(o[6], o[7]);
                *(u32x4*)rowp = w; asm volatile("" ::: "memory"); }
    }
};
struct EpiMoeOut {
    static constexpr bool PERM = true;
    bf16_t* O; const int* row_tok; const float* row_w;
    __device__ __forceinline__ void operator()(const f32x4 (&acc)[2][2][4][2], const Unit& u, int wr, int wc, int fr, int fq) const {
        const int row0 = u.pm * BM + wr * 64 + fr, col0 = u.pn * BM + wc * 32 + 8 * fq;
#pragma unroll
        for (int ai = 0; ai < 2; ++ai)
#pragma unroll
            for (int m = 0; m < 4; ++m) { const int row = row0 + ai * HALF + m * 16; const int ts = row_tok[row]; const float w = row_w[row];
                if (ts >= 0) { bf16_t* rowp = O + ((size_t)(ts & 1) * NTOK + (size_t)(ts >> 1)) * DM + col0;
#pragma unroll
                    for (int bj = 0; bj < 2; ++bj) { const f32x4 v0 = acc[ai][bj][m][0] * w, v1 = acc[ai][bj][m][1] * w;
                        u32x4 q; q.x = cvt_pk_bf16(v0[0], v0[1]); q.y = cvt_pk_bf16(v0[2], v0[3]); q.z = cvt_pk_bf16(v1[0], v1[1]); q.w = cvt_pk_bf16(v1[2], v1[3]);
                        *(u32x4*)(rowp + bj * HALF) = q; } } asm volatile("" ::: "memory"); }
    }
};
struct MoeOrder {
    int nN, G, c, K; const char* A; const char* B; size_t bstride; const int* tiles;
    __device__ bool next(int i, Unit& u) const {
        const int nrt = tiles[0]; const long L = (long)i * G + c; if (L >= (long)nrt * nN) return false;
        u.pm = (int)(L / nN); u.pn = (int)(L % nN); const int e = tiles[64 + u.pm];
        u.a = A + (size_t)u.pm * 256 * K * 2; u.b = B + (size_t)e * bstride + (size_t)u.pn * 256 * K * 2; return true;
    }
};
}

struct Params { const float* in[44]; float* out; unsigned char* ws; int ph_lo, ph_hi; };
enum { I_X = 0, I_NORM1, I_WIN, I_MCONVW, I_MCONVB, I_MDTB, I_MALOG, I_MD, I_MNORM, I_RMU, I_RW0, I_RW2, I_RA0, I_RA2, I_RG2, I_RKK, I_RKA, I_RRK, I_RLNW, I_RLNB,
       I_CKVN, I_CWUK, I_CWUV, I_RELB, I_SARE, I_SAIM, I_SBRE, I_SBIM, I_SCRE, I_SCIM, I_SD, I_SLOGDT, I_SGLUW, I_SGLUB, I_WOUT, I_NORM2, I_WRG, I_BRG, I_WRE, I_BRE,
       I_WGATE, I_WUP, I_WDOWN, I_FNORM };

typedef const float* const __attribute__((address_space(4)))* in_tab_t;
struct Frame {
    LAS unsigned char* lds; int tid, lane, wave, bid, G;
    in_tab_t in; float* out; unsigned char* ws; unsigned* ctl;
    volatile LAS int* misc;
};

__device__ __forceinline__ int q_pop(Frame& F, int qi) {
    __syncthreads();
    if (F.tid == 0) F.misc[0] = (int)__hip_atomic_fetch_add(F.ctl + CW_Q + 64 * qi, 1u, __ATOMIC_RELAXED, __HIP_MEMORY_SCOPE_AGENT);
    __syncthreads();
    return F.misc[0];
}

__device__ __forceinline__ const void* opaque_ptr(const void* p) { const unsigned long long v = (unsigned long long)p; unsigned lo = __builtin_amdgcn_readfirstlane((unsigned)v), hi = __builtin_amdgcn_readfirstlane((unsigned)(v >> 32));
    asm volatile("" : "+s"(lo), "+s"(hi)); return (const void*)(((unsigned long long)hi << 32) | lo); }
__device__ __forceinline__ Frame relocal(const Frame& G) { Frame F = G; asm volatile("" : "+v"(F.tid)); F.ws = (unsigned char*)opaque_ptr(F.ws); F.ctl = (unsigned*)(F.ws + WS_CTL); F.in = (in_tab_t)(unsigned long long)opaque_ptr((const void*)(unsigned long long)F.in); F.lane = F.tid & 63; F.wave = __builtin_amdgcn_readfirstlane(F.tid >> 6); return F; }
template <int K> __device__ __forceinline__ f32x4 mma_nt(const LAS bf16_t* A, int lda, const LAS bf16_t* Bt, int ldb, f32x4 acc, int lane) {
    const int r = lane & 15, g = lane >> 4;
#pragma unroll
    for (int k0 = 0; k0 < K; k0 += 32) {
        const bf16x8 a = *(const LAS bf16x8*)(A + r * lda + k0 + 8 * g);
        const bf16x8 b = *(const LAS bf16x8*)(Bt + r * ldb + k0 + 8 * g);
        acc = __builtin_amdgcn_mfma_f32_16x16x32_bf16(a, b, acc, 0, 0, 0);
    }
    return acc;
}

template <class ColMap> __device__ __forceinline__ void tr_tile(Frame& F, const float* src, int ldsrc, bf16_t* dst, int K, int k0, int n0, ColMap cm) {
    LAS float* tile = (LAS float*)F.lds;
    __syncthreads();
    { const int kk = F.tid >> 4, n4 = (F.tid & 15) * 4;
#pragma unroll
      for (int ps = 0; ps < 2; ++ps) { const int k = kk + 32 * ps; const int sc = cm(n0 + n4);
          f32x4 v = (f32x4){0.f, 0.f, 0.f, 0.f}; if (sc >= 0) v = *(const f32x4*)(src + (size_t)(k0 + k) * ldsrc + sc);
          tile[k * 65 + n4 + 0] = v[0]; tile[k * 65 + n4 + 1] = v[1]; tile[k * 65 + n4 + 2] = v[2]; tile[k * 65 + n4 + 3] = v[3]; } }
    __syncthreads();
    { const int n = F.tid >> 3, kc = F.tid & 7; float f[8];
#pragma unroll
      for (int j = 0; j < 8; ++j) f[j] = tile[(8 * kc + j) * 65 + n];
      u32x4 w; w.x = pk2(f[0], f[1]); w.y = pk2(f[2], f[3]); w.z = pk2(f[4], f[5]); w.w = pk2(f[6], f[7]);
      *(u32x4*)(dst + (size_t)(n0 + n) * K + k0 + 8 * kc) = w; }
}

struct CmIn { __device__ __forceinline__ int operator()(int n) const {
    if (n < 772) return n; if (n < UR) return -1; if (n < UR + 896) return 772 + (n - UR); if (n < UC) return -1;
    if (n < UC + 680) return 1668 + (n - UC); if (n < US) return -1; if (n < US + 256) return 2348 + (n - US); return -1; } };
struct CmId { __device__ __forceinline__ int operator()(int n) const { return n; } };
struct CmGlu { __device__ __forceinline__ int operator()(int n) const { const int pn = n >> 8, rr = n & 255; return rr < 128 ? 128 * pn + rr : 256 + 128 * pn + (rr - 128); } };
struct CmGateUp { int half; __device__ __forceinline__ int operator()(int n) const { return n; } };

__device__ __forceinline__ void phase_prologue(const Frame& F_) { Frame F = relocal(F_);
    for (int t = F.bid; t < 1984; t += F.G) {
        if (t < 1408) { const int l = t / 704, r = t % 704, kt = r / 44, nt = r % 44;
            tr_tile(F, F.in[I_WIN] + (size_t)l * DM * NIN, NIN, (bf16_t*)(F.ws + WS_WIN) + (size_t)l * NINP * DM, DM, kt * 64, nt * 64, CmIn()); }
        else if (t < 1920) { const int q = t - 1408, l = q / 256, r = q % 256, kt = r / 16, nt = r % 16;
            tr_tile(F, F.in[I_WOUT] + (size_t)l * DM * DM, DM, (bf16_t*)(F.ws + WS_WOUT) + (size_t)l * DM * DM, DM, kt * 64, nt * 64, CmId()); }
        else { const int q = t - 1920, l = q / 32, r = q % 32, kt = r / 8, nt = r % 8;
            tr_tile(F, F.in[I_SGLUW] + (size_t)l * 256 * 512, 512, (bf16_t*)(F.ws + WS_GLU) + (size_t)l * 512 * 256, 256, kt * 64, nt * 64, CmGlu()); }
    }
    for (int i = F.bid * NTHR + F.tid; i < 2 * 48 * 1024; i += F.G * NTHR) { const int l = i / 49152, r = i % 49152, o = r >> 10, k = r & 1023;
        float v = 0.f; if (o < 32) v = F.in[I_WRE][((size_t)l * DM + k) * 32 + o]; else if (o < 36) v = F.in[I_WRG][((size_t)l * DM + k) * 4 + (o - 32)];
        v *= F.in[I_NORM2][l * DM + k];
        const bf16_t hi = f2bf(v); const bf16_t lo = f2bf(v - bf2f(hi));
        bf16_t* w = (bf16_t*)(F.ws + WS_WRT) + (size_t)l * 2 * 49152; w[r] = hi; w[49152 + r] = lo; }
    for (int i = F.bid * NTHR + F.tid; i < 2048 + 65536; i += F.G * NTHR) {
        if (i < 2048) {
            const int l = i >> 10, gn = i & 1023, g = gn >> 6;
            float* tab = (float*)(F.ws + WS_S5TAB + (size_t)l * S5TAB_L);
            const float lre = fminf(F.in[I_SARE][l * 1024 + gn], -1e-4f), lim = F.in[I_SAIM][l * 1024 + gn];
            const float dt = expf(F.in[I_SLOGDT][l * 16 + g]);
            const float mag = expf(dt * lre); float sn, cs; sincosf(dt * lim, &sn, &cs);
            const float are = mag * cs, aim = mag * sn;
            const float den = lre * lre + lim * lim;
            const float fre = ((are - 1.0f) * lre + aim * lim) / den, fim = (aim * lre - (are - 1.0f) * lim) / den;
            tab[gn * 2] = are; tab[gn * 2 + 1] = aim;
            float pr = are, pi = aim;
#pragma unroll
            for (int s = 0; s < 6; ++s) { const float nr = pr * pr - pi * pi, ni = 2.0f * pr * pi; pr = nr; pi = ni; }
            tab[2048 + gn * 2] = pr; tab[2048 + gn * 2 + 1] = pi;
            const float* bre = F.in[I_SBRE] + ((size_t)l * 1024 + gn) * 16; const float* bim = F.in[I_SBIM] + ((size_t)l * 1024 + gn) * 16;
            for (int p = 0; p < 16; ++p) { tab[4096 + (gn * 16 + p) * 2] = fre * bre[p] - fim * bim[p]; tab[4096 + (gn * 16 + p) * 2 + 1] = fre * bim[p] + fim * bre[p]; }
        } else {
            const int j = i - 2048, l = j >> 15, r = j & 32767, gp = r >> 7, k = r & 127;
            bf16_t* cm = (bf16_t*)(F.ws + WS_S5TAB + (size_t)l * S5TAB_L + S5TAB_F);
            const float v = k < 64 ? F.in[I_SCRE][((size_t)l * 256 + gp) * 64 + k] : -F.in[I_SCIM][((size_t)l * 256 + gp) * 64 + (k - 64)];
            cm[r] = f2bf(v);
        }
    }
}

__device__ __forceinline__ void phase_norm(const Frame& F_, const float* xin, bool add_o, const float* w, int mode) { Frame F = relocal(F_);
    float* X = (float*)(F.ws + WS_X); bf16_t* H = (bf16_t*)(F.ws + WS_H); const bf16_t* O = (const bf16_t*)(F.ws + WS_U);
    for (int row = F.bid * 8 + F.wave; row < NTOK; row += F.G * 8) {
        f32x4 v[4]; float ss = 0.f;
#pragma unroll
        for (int j = 0; j < 4; ++j) { const int c = 4 * F.lane + 256 * j; v[j] = *(const f32x4*)(xin + (size_t)row * DM + c);
            if (add_o) { const u32x2 a = *(const u32x2*)(O + (size_t)row * DM + c), b = *(const u32x2*)(O + ((size_t)NTOK + row) * DM + c);
                v[j][0] += __uint_as_float(a.x << 16) + __uint_as_float(b.x << 16); v[j][1] += __uint_as_float(a.x & 0xffff0000u) + __uint_as_float(b.x & 0xffff0000u);
                v[j][2] += __uint_as_float(a.y << 16) + __uint_as_float(b.y << 16); v[j][3] += __uint_as_float(a.y & 0xffff0000u) + __uint_as_float(b.y & 0xffff0000u); }
            ss += v[j][0] * v[j][0] + v[j][1] * v[j][1] + v[j][2] * v[j][2] + v[j][3] * v[j][3]; }
        ss = wave_sum(ss);
        const float rstd = rsqrtf(ss * (1.0f / DM) + 1e-6f);
#pragma unroll
        for (int j = 0; j < 4; ++j) { const int c = 4 * F.lane + 256 * j; const f32x4 wv = *(const f32x4*)(w + c);
            if (mode == 2) { *(f32x4*)(F.out + (size_t)row * DM + c) = v[j] * rstd * wv; }
            else { *(f32x4*)(X + (size_t)row * DM + c) = v[j];
                u32x2 o; o.x = pk2(v[j][0] * rstd * wv[0], v[j][1] * rstd * wv[1]); o.y = pk2(v[j][2] * rstd * wv[2], v[j][3] * rstd * wv[3]);
                *(u32x2*)(H + (size_t)row * DM + c) = o; } }
    }
}

__device__ __forceinline__ void item_kv(const Frame& F_, int layer, int item) { Frame F = relocal(F_);
    const bf16_t* U = (const bf16_t*)(F.ws + WS_U);
    LAS bf16_t* Ab = (LAS bf16_t*)F.lds;
    LAS bf16_t* Bt = (LAS bf16_t*)(F.lds + 17408);
    const int t0 = item * 64;
    { const int tok = F.tid >> 3, part = F.tid & 7; const bf16_t* src = U + (size_t)(t0 + tok) * NINP + UC + 256 + 16 * part;
      float f[16]; { float a[8], b[8]; unpack8(*(const u32x4*)src, a); unpack8(*(const u32x4*)(src + 8), b);
#pragma unroll
        for (int j = 0; j < 8; ++j) { f[j] = a[j]; f[8 + j] = b[j]; } }
      float ss = 0.f;
#pragma unroll
      for (int j = 0; j < 16; ++j) ss += f[j] * f[j];
      ss = sum8(ss);
      const float rstd = rsqrtf(ss * (1.0f / 128.0f) + 1e-6f); const float* nw = F.in[I_CKVN] + layer * 128 + 16 * part;
#pragma unroll
      for (int j = 0; j < 16; j += 2) *(LAS unsigned*)(Ab + tok * 136 + 16 * part + j) = pk2(f[j] * rstd * nw[j], f[j + 1] * rstd * nw[j + 1]); }
    { const int n = F.tid >> 2, kq = F.tid & 3; const float* w = (n < 64 ? F.in[I_CWUK] : F.in[I_CWUV]) + (size_t)layer * 128 * 64 + (n & 63);
#pragma unroll 4
      for (int k = 32 * kq; k < 32 * kq + 32; ++k) Bt[n * 136 + k] = f2bf(w[(size_t)k * 64]); }
    if (F.tid < 256) { const int tok = F.tid >> 2, q = F.tid & 3;
        *(u32x4*)((bf16_t*)(F.ws + WS_KIDX) + (size_t)(t0 + tok) * 32 + 8 * q) = *(const u32x4*)(U + (size_t)(t0 + tok) * NINP + UC + 640 + 8 * q); }
    __syncthreads();
    const int mt = F.wave & 3, g = F.lane >> 4, r = F.lane & 15;
#pragma unroll
    for (int q = 0; q < 4; ++q) { const int nt = (F.wave >> 2) * 4 + q;
        f32x4 acc = (f32x4){0.f, 0.f, 0.f, 0.f};
        acc = mma_nt<128>(Ab + mt * 16 * 136, 136, Bt + nt * 16 * 136, 136, acc, F.lane);
        const int n = nt * 16 + r; bf16_t* dst = (bf16_t*)(F.ws + (n < 64 ? WS_K : WS_V));
#pragma unroll
        for (int i = 0; i < 4; ++i) dst[(size_t)(t0 + mt * 16 + 4 * g + i) * 64 + (n & 63)] = f2bf(acc[i]); }
}

constexpr int MB_CG = 0, MB_BG = 18432, MB_BT = 36864, MB_XT = 55296, MB_M = 92160, MB_S0 = 101376, MB_DT = 110592, MB_AC = 111616, MB_RS = 112640;
template <int STAGE> __device__ __forceinline__ void item_mamba(const Frame& F_, int layer, int item) { Frame F = relocal(F_);
    const bf16_t* U = (const bf16_t*)(F.ws + WS_U);
    const int b = item >> 6, c = item & 63, l0 = c * 64; const size_t T0 = (size_t)b * SEQ + l0;
    LAS bf16_t* Cg = (LAS bf16_t*)(F.lds + MB_CG); LAS bf16_t* Bg = (LAS bf16_t*)(F.lds + MB_BG); LAS bf16_t* BT = (LAS bf16_t*)(F.lds + MB_BT);
    LAS bf16_t* XT = (LAS bf16_t*)(F.lds + MB_XT); LAS bf16_t* Mb = (LAS bf16_t*)(F.lds + MB_M); LAS bf16_t* S0 = (LAS bf16_t*)(F.lds + MB_S0);
    LAS float* dts = (LAS float*)(F.lds + MB_DT); LAS float* acs = (LAS float*)(F.lds + MB_AC); LAS float* rs = (LAS float*)(F.lds + MB_RS);
    if (F.tid < 256) { const int l = F.tid >> 2, h = F.tid & 3;
        const float raw = bf2f(U[(T0 + l) * NINP + UM + 768 + h]) + F.in[I_MDTB][layer * 4 + h];
        const float dt = softplusf_(raw); dts[l * 4 + h] = dt; acs[l * 4 + h] = -__expf(F.in[I_MALOG][layer * 4 + h]) * dt; }
    if (F.tid < 64) rs[F.tid] = 0.f;
    __syncthreads();
    float mycum = 0.f;
    if (F.tid < 256) { const int l = F.tid >> 2, h = F.tid & 3; for (int s = 0; s <= l; ++s) mycum += acs[s * 4 + h]; }
    __syncthreads();
    if (F.tid < 256) acs[F.tid] = mycum;
    __syncthreads();
    { const int ch8 = F.tid & 63, tg = F.tid >> 6, c0 = ch8 * 8;
      float wv[4][8], bv[8];
#pragma unroll
      for (int j = 0; j < 8; ++j) { bv[j] = F.in[I_MCONVB][layer * 512 + c0 + j];
#pragma unroll
          for (int k = 0; k < 4; ++k) wv[k][j] = F.in[I_MCONVW][(layer * 4 + k) * 512 + c0 + j]; }
      float win[3][8];
#pragma unroll
      for (int k = 0; k < 3; ++k) { const int l = l0 + tg * 8 - 3 + k;
          if (l >= 0) unpack8(*(const u32x4*)(U + ((size_t)b * SEQ + l) * NINP + UM + 256 + c0), win[k]);
          else {
#pragma unroll
              for (int j = 0; j < 8; ++j) win[k][j] = 0.f; } }
#pragma unroll 1
      for (int i = 0; i < 8; ++i) { const int l = tg * 8 + i; float cur[8]; unpack8(*(const u32x4*)(U + (T0 + l) * NINP + UM + 256 + c0), cur);
          float o[8];
#pragma unroll
          for (int j = 0; j < 8; ++j) { o[j] = siluf_(bv[j] + wv[0][j] * win[0][j] + wv[1][j] * win[1][j] + wv[2][j] * win[2][j] + wv[3][j] * cur[j]);
              win[0][j] = win[1][j]; win[1][j] = win[2][j]; win[2][j] = cur[j]; }
          if (c0 < 256) { const int h = c0 >> 6, p0 = c0 & 63; float sc = dts[l * 4 + h]; if (STAGE == 1) sc *= __expf(acs[63 * 4 + h] - acs[l * 4 + h]);
#pragma unroll
              for (int j = 0; j < 8; ++j) XT[(h * 64 + p0 + j) * 72 + l] = f2bf(o[j] * sc); }
          else if (c0 < 384) { const int g = (c0 - 256) >> 6, n0 = (c0 - 256) & 63;
              if (STAGE == 1) {
#pragma unroll
                  for (int j = 0; j < 8; ++j) BT[(g * 64 + n0 + j) * 72 + l] = f2bf(o[j]); }
              else { u32x4 w; w.x = pk2(o[0], o[1]); w.y = pk2(o[2], o[3]); w.z = pk2(o[4], o[5]); w.w = pk2(o[6], o[7]); *(LAS u32x4*)(Bg + (g * 64 + l) * 72 + n0) = w; } }
          else if (STAGE == 2) { const int g = (c0 - 384) >> 6, n0 = (c0 - 384) & 63;
              u32x4 w; w.x = pk2(o[0], o[1]); w.y = pk2(o[2], o[3]); w.z = pk2(o[4], o[5]); w.w = pk2(o[6], o[7]); *(LAS u32x4*)(Cg + (g * 64 + l) * 72 + n0) = w; } } }
    __syncthreads();
    const int g4 = F.lane >> 4, r16 = F.lane & 15;
    if (STAGE == 1) {
        float* MST = (float*)(F.ws + WS_MST) + ((size_t)(b * 64 + c) * 4) * 4096;
#pragma unroll
        for (int q = 0; q < 8; ++q) { const int tix = F.wave * 8 + q, h = tix >> 4, mt = (tix >> 2) & 3, nt = tix & 3;
            f32x4 acc = (f32x4){0.f, 0.f, 0.f, 0.f};
            acc = mma_nt<64>(XT + (h * 64 + mt * 16) * 72, 72, BT + ((h >> 1) * 64 + nt * 16) * 72, 72, acc, F.lane);
#pragma unroll
            for (int i = 0; i < 4; ++i) MST[(size_t)h * 4096 + (mt * 16 + 4 * g4 + i) * 64 + nt * 16 + r16] = acc[i]; }
        if (F.tid < 4) ((float*)(F.ws + WS_MDEC))[(b * 64 + c) * 4 + F.tid] = __expf(acs[63 * 4 + F.tid]);
    } else {
        const int mt = F.wave & 3, nh = F.wave >> 2;
        const float* MST = (const float*)(F.ws + WS_MST) + ((size_t)(b * 64 + c) * 4) * 4096;
        f32x4 G[2], yv[4][2];
#pragma unroll
        for (int h = 0; h < 4; ++h) {
            const int g = h >> 1;
            { const float* src = MST + (size_t)h * 4096 + F.tid * 8; const f32x4 a = *(const f32x4*)src, bq = *(const f32x4*)(src + 4);
              u32x4 w; w.x = pk2(a[0], a[1]); w.y = pk2(a[2], a[3]); w.z = pk2(bq[0], bq[1]); w.w = pk2(bq[2], bq[3]);
              *(LAS u32x4*)(S0 + (F.tid >> 3) * 72 + (F.tid & 7) * 8) = w; }
            if ((h & 1) == 0) {
#pragma unroll
                for (int q = 0; q < 2; ++q) { G[q] = (f32x4){0.f, 0.f, 0.f, 0.f};
                    G[q] = mma_nt<64>(Cg + (g * 64 + mt * 16) * 72, 72, Bg + (g * 64 + (2 * nh + q) * 16) * 72, 72, G[q], F.lane); } }
#pragma unroll
            for (int q = 0; q < 2; ++q) { const int s = (2 * nh + q) * 16 + r16; const float as = acs[s * 4 + h];
#pragma unroll
                for (int i = 0; i < 4; ++i) { const int l = mt * 16 + 4 * g4 + i; const float v = (s <= l) ? G[q][i] * __expf(acs[l * 4 + h] - as) : 0.f;
                    Mb[l * 72 + s] = f2bf(v); } }
            __syncthreads();
#pragma unroll
            for (int q = 0; q < 2; ++q) { const int nt = 2 * nh + q;
                f32x4 yd = (f32x4){0.f, 0.f, 0.f, 0.f}, yo = (f32x4){0.f, 0.f, 0.f, 0.f};
                yd = mma_nt<64>(Mb + mt * 16 * 72, 72, XT + (h * 64 + nt * 16) * 72, 72, yd, F.lane);
                yo = mma_nt<64>(Cg + (g * 64 + mt * 16) * 72, 72, S0 + nt * 16 * 72, 72, yo, F.lane);
                const int p = nt * 16 + r16; const float dsk = F.in[I_MD][layer * 4 + h];
#pragma unroll
                for (int i = 0; i < 4; ++i) { const int l = mt * 16 + 4 * g4 + i;
                    const float xs = bf2f(XT[(h * 64 + p) * 72 + l]) / dts[l * 4 + h];
                    yv[h][q][i] = yd[i] + yo[i] * __expf(acs[l * 4 + h]) + dsk * xs; } }
            __syncthreads();
        }
        float part[4] = {0.f, 0.f, 0.f, 0.f};
#pragma unroll
        for (int h = 0; h < 4; ++h)
#pragma unroll
            for (int q = 0; q < 2; ++q) { const int ch = h * 64 + (2 * nh + q) * 16 + r16;
#pragma unroll
                for (int i = 0; i < 4; ++i) { const int l = mt * 16 + 4 * g4 + i; const float z = bf2f(U[(T0 + l) * NINP + UM + ch]);
                    const float v = yv[h][q][i] * siluf_(z); yv[h][q][i] = v; part[i] += v * v; } }
#pragma unroll
        for (int i = 0; i < 4; ++i) { const float s = sum16(part[i]); if (r16 == 0) atomicAdd((float*)(rs + mt * 16 + 4 * g4 + i), s); }
        __syncthreads();
        bf16_t* Y = (bf16_t*)(F.ws + WS_H);
#pragma unroll
        for (int i = 0; i < 4; ++i) { const int l = mt * 16 + 4 * g4 + i; const float rstd = rsqrtf(rs[l] * (1.0f / 256.0f) + 1e-6f);
#pragma unroll
            for (int h = 0; h < 4; ++h)
#pragma unroll
                for (int q = 0; q < 2; ++q) { const int ch = h * 64 + (2 * nh + q) * 16 + r16;
                    Y[(T0 + l) * DM + ch] = f2bf(yv[h][q][i] * rstd * F.in[I_MNORM][layer * 256 + ch]); } }
    }
}
__device__ __forceinline__ void item_mamba_carry(const Frame& F_, int item) { Frame F = relocal(F_);
    const int b = item >> 2, h = item & 3;
    float* MST = (float*)(F.ws + WS_MST); const float* MD = (const float*)(F.ws + WS_MDEC);
    float s[8];
#pragma unroll
    for (int j = 0; j < 8; ++j) s[j] = 0.f;
    for (int c = 0; c < 64; ++c) { float* p = MST + ((size_t)(b * 64 + c) * 4 + h) * 4096 + F.tid * 8; const float d = MD[(b * 64 + c) * 4 + h];
        const f32x4 a = *(f32x4*)p, q = *(f32x4*)(p + 4);
        *(f32x4*)p = (f32x4){s[0], s[1], s[2], s[3]}; *(f32x4*)(p + 4) = (f32x4){s[4], s[5], s[6], s[7]};
        s[0] = s[0] * d + a[0]; s[1] = s[1] * d + a[1]; s[2] = s[2] * d + a[2]; s[3] = s[3] * d + a[3];
        s[4] = s[4] * d + q[0]; s[5] = s[5] * d + q[1]; s[6] = s[6] * d + q[2]; s[7] = s[7] * d + q[3]; }
}

template <int STAGE> __device__ __forceinline__ void item_s5(const Frame& F_, int layer, int item) { Frame F = relocal(F_);
    const bf16_t* U = (const bf16_t*)(F.ws + WS_U);
    const int b = item >> 6, c = item & 63; const size_t T0 = (size_t)b * SEQ + c * 64;
    LAS float* us = (LAS float*)F.lds; LAS bf16_t* Hs = (LAS bf16_t*)(F.lds + 65536);
    const float* tab = (const float*)(F.ws + WS_S5TAB + (size_t)layer * S5TAB_L);
    { const int tok = F.tid >> 3, part = F.tid & 7;
#pragma unroll
      for (int q = 0; q < 4; ++q) { float f[8]; unpack8(*(const u32x4*)(U + (T0 + tok) * NINP + US + 32 * part + 8 * q), f);
          *(LAS f32x4*)(us + tok * 256 + 32 * part + 8 * q) = (f32x4){f[0], f[1], f[2], f[3]}; *(LAS f32x4*)(us + tok * 256 + 32 * part + 8 * q + 4) = (f32x4){f[4], f[5], f[6], f[7]}; } }
    const int g = F.tid >> 5, n0 = F.tid & 31, gn0 = g * 64 + n0, gn1 = gn0 + 32;
    float bb0[32], bb1[32];
#pragma unroll
    for (int j = 0; j < 32; j += 4) { const f32x4 a = *(const f32x4*)(tab + 4096 + gn0 * 32 + j), bq = *(const f32x4*)(tab + 4096 + gn1 * 32 + j);
        bb0[j] = a[0]; bb0[j + 1] = a[1]; bb0[j + 2] = a[2]; bb0[j + 3] = a[3]; bb1[j] = bq[0]; bb1[j + 1] = bq[1]; bb1[j + 2] = bq[2]; bb1[j + 3] = bq[3]; }
    const float a0r = tab[gn0 * 2], a0i = tab[gn0 * 2 + 1], a1r = tab[gn1 * 2], a1i = tab[gn1 * 2 + 1];
    float* ST = (float*)(F.ws + WS_S5ST) + (size_t)(b * 64 + c) * 2048;
    float h0r = 0.f, h0i = 0.f, h1r = 0.f, h1i = 0.f;
    if (STAGE == 2) { h0r = ST[gn0 * 2]; h0i = ST[gn0 * 2 + 1]; h1r = ST[gn1 * 2]; h1i = ST[gn1 * 2 + 1]; }
    bf16x8 cf[2][4];
    if (STAGE == 2) { const bf16_t* cm = (const bf16_t*)(F.ws + WS_S5TAB + (size_t)layer * S5TAB_L + S5TAB_F);
#pragma unroll
        for (int gg = 0; gg < 2; ++gg)
#pragma unroll
            for (int ks = 0; ks < 4; ++ks) cf[gg][ks] = *(const bf16x8*)(cm + ((size_t)((2 * F.wave + gg) * 16 + (F.lane & 15))) * 128 + 32 * ks + 8 * (F.lane >> 4)); }
    __syncthreads();
    for (int lb = 0; lb < 4; ++lb) {
        for (int li = 0; li < 16; ++li) { const int l = lb * 16 + li;
            float uu[16];
#pragma unroll
            for (int q = 0; q < 4; ++q) { const f32x4 v = *(const LAS f32x4*)(us + l * 256 + g * 16 + 4 * q); uu[4 * q] = v[0]; uu[4 * q + 1] = v[1]; uu[4 * q + 2] = v[2]; uu[4 * q + 3] = v[3]; }
            float b0r = 0.f, b0i = 0.f, b1r = 0.f, b1i = 0.f;
#pragma unroll
            for (int p = 0; p < 16; ++p) { b0r += bb0[2 * p] * uu[p]; b0i += bb0[2 * p + 1] * uu[p]; b1r += bb1[2 * p] * uu[p]; b1i += bb1[2 * p + 1] * uu[p]; }
            { const float nr = a0r * h0r - a0i * h0i + b0r, ni = a0r * h0i + a0i * h0r + b0i; h0r = nr; h0i = ni; }
            { const float nr = a1r * h1r - a1i * h1i + b1r, ni = a1r * h1i + a1i * h1r + b1i; h1r = nr; h1i = ni; }
            if (STAGE == 2) { LAS bf16_t* hp = Hs + li * 2056 + g * 128; hp[n0] = f2bf(h0r); hp[64 + n0] = f2bf(h0i); hp[n0 + 32] = f2bf(h1r); hp[96 + n0] = f2bf(h1i); }
        }
        if (STAGE == 2) {
            __syncthreads();
            bf16_t* YS = (bf16_t*)(F.ws + WS_MOE + YSG_OFF);
#pragma unroll
            for (int gg = 0; gg < 2; ++gg) { const int gq = 2 * F.wave + gg; f32x4 acc = (f32x4){0.f, 0.f, 0.f, 0.f};
#pragma unroll
                for (int ks = 0; ks < 4; ++ks) { const bf16x8 a = *(const LAS bf16x8*)(Hs + (F.lane & 15) * 2056 + gq * 128 + 32 * ks + 8 * (F.lane >> 4));
                    acc = __builtin_amdgcn_mfma_f32_16x16x32_bf16(a, cf[gg][ks], acc, 0, 0, 0); }
                const int ch = gq * 16 + (F.lane & 15); const float dsk = F.in[I_SD][layer * 256 + ch];
#pragma unroll
                for (int i = 0; i < 4; ++i) { const int l = lb * 16 + 4 * (F.lane >> 4) + i; const float y = acc[i] + dsk * us[l * 256 + ch];
                    YS[(T0 + l) * 256 + ch] = f2bf(gelu_tanh(y)); } }
            __syncthreads();
        }
    }
    if (STAGE == 1) { ST[gn0 * 2] = h0r; ST[gn0 * 2 + 1] = h0i; ST[gn1 * 2] = h1r; ST[gn1 * 2 + 1] = h1i; }
}
__device__ __forceinline__ void item_s5_carry(const Frame& F_, int layer, int b) { Frame F = relocal(F_);
    const float* tab = (const float*)(F.ws + WS_S5TAB + (size_t)layer * S5TAB_L) + 2048;
    float* ST = (float*)(F.ws + WS_S5ST) + (size_t)b * 64 * 2048;
#pragma unroll
    for (int q = 0; q < 2; ++q) { const int gn = F.tid + 512 * q; const float pr = tab[gn * 2], pi = tab[gn * 2 + 1]; float hr = 0.f, hi = 0.f;
        for (int c = 0; c < 64; ++c) { float* p = ST + (size_t)c * 2048 + gn * 2; const float tr = p[0], ti = p[1]; p[0] = hr; p[1] = hi;
            const float nr = pr * hr - pi * hi + tr, ni = pr * hi + pi * hr + ti; hr = nr; hi = ni; } }
}

constexpr int RW_R = 0, RW_K = 16384, RW_V = 32768, RW_W = 49152, RW_A = 65536, RW_B = 81920, RW_TW = 98304, RW_DA = 106496, RW_O = 98304, RW_SG = 114688, RW_BON = 131072;
template <int STAGE> __device__ __forceinline__ void rwkv_prep(const Frame& F_, int layer, int b, int h, int c) { Frame F = relocal(F_);
    const bf16_t* U = (const bf16_t*)(F.ws + WS_U);
    const int l0 = c * 64; const size_t T0 = (size_t)b * SEQ + l0;
    LAS float* Rr = (LAS float*)(F.lds + RW_R); LAS float* Kk = (LAS float*)(F.lds + RW_K); LAS float* Vv = (LAS float*)(F.lds + RW_V); LAS float* Ww = (LAS float*)(F.lds + RW_W);
    LAS float* Aa = (LAS float*)(F.lds + RW_A); LAS float* Bb = (LAS float*)(F.lds + RW_B); LAS float* TW = (LAS float*)(F.lds + RW_TW); LAS float* DA = (LAS float*)(F.lds + RW_DA);
    LAS float* SG = (LAS float*)(F.lds + RW_SG); LAS float* BON = (LAS float*)(F.lds + RW_BON);
    const float* mu = F.in[I_RMU] + layer * 896;
    { const int tok = F.tid >> 3, p8 = F.tid & 7; const bool first = (l0 + tok == 0);
      const bf16_t* cur = U + (T0 + tok) * NINP + UR; const bf16_t* prv = cur - NINP;
#pragma unroll
      for (int sec = 0; sec < 3; ++sec) { const int co = sec * 256 + h * 64 + 8 * p8; float a[8], pq[8]; unpack8(*(const u32x4*)(cur + co), a);
          if (first) {
#pragma unroll
              for (int j = 0; j < 8; ++j) pq[j] = 0.f; } else unpack8(*(const u32x4*)(prv + co), pq);
          LAS float* dst = (sec == 0 ? Rr : sec == 1 ? Kk : Vv) + tok * 64 + 8 * p8;
#pragma unroll
          for (int j = 0; j < 8; ++j) dst[j] = a[j] + mu[co + j] * (pq[j] - a[j]); }
#pragma unroll
      for (int q = 0; q < 2; ++q) { const int co = 768 + 16 * p8 + 8 * q; float a[8], pq[8]; unpack8(*(const u32x4*)(cur + co), a);
          if (first) {
#pragma unroll
              for (int j = 0; j < 8; ++j) pq[j] = 0.f; } else unpack8(*(const u32x4*)(prv + co), pq);
#pragma unroll
          for (int j = 0; j < 8; ++j) { const float s = a[j] + mu[co + j] * (pq[j] - a[j]); const int cc = co - 768 + j;
              if (cc < 32) TW[tok * 32 + cc] = tanhf_(s); else if (cc < 64) DA[tok * 32 + cc - 32] = s; else SG[tok * 64 + cc - 64] = sigmoidf_(s); } } }
    __syncthreads();
    { const int j = F.lane, tq = F.wave, ch = h * 64 + j;
      float w2c[32], a2c[32];
#pragma unroll
      for (int i = 0; i < 32; ++i) { w2c[i] = F.in[I_RW2][((size_t)layer * 32 + i) * 256 + ch]; a2c[i] = F.in[I_RA2][((size_t)layer * 32 + i) * 256 + ch]; }
      const float w0 = F.in[I_RW0][layer * 256 + ch], a0 = F.in[I_RA0][layer * 256 + ch], kkw = F.in[I_RKK][layer * 256 + ch], kaw = F.in[I_RKA][layer * 256 + ch], rk = F.in[I_RRK][layer * 256 + ch];
      for (int i8 = 0; i8 < 8; ++i8) { const int t = tq + 8 * i8;
          float wl = w0, al = a0;
#pragma unroll
          for (int i = 0; i < 32; i += 4) { const f32x4 tv = *(const LAS f32x4*)(TW + t * 32 + i), dv = *(const LAS f32x4*)(DA + t * 32 + i);
              wl += tv[0] * w2c[i] + tv[1] * w2c[i + 1] + tv[2] * w2c[i + 2] + tv[3] * w2c[i + 3]; al += dv[0] * a2c[i] + dv[1] * a2c[i + 1] + dv[2] * a2c[i + 2] + dv[3] * a2c[i + 3]; }
          const float wlog = -softplusf_(-wl) - 0.5f; const float dec = __expf(-__expf(wlog)); const float a = sigmoidf_(al);
          const float kraw = Kk[t * 64 + j]; const float kkv = kraw * kkw; const float ss = wave_sum(kkv * kkv);
          const float kkn = kkv * rsqrtf(fmaxf(ss, 1e-24f)); const float kp = kraw * (1.0f + (a - 1.0f) * kaw);
          Ww[t * 64 + j] = dec; Kk[t * 64 + j] = kp; Aa[t * 64 + j] = -kkn; Bb[t * 64 + j] = kkn * a;
          if (STAGE == 3) { const float bo = wave_sum(Rr[t * 64 + j] * kp * rk); if (j == 0) BON[t] = bo; } } }
    __syncthreads();
}
__device__ __forceinline__ void item_rwkv1(const Frame& F_, int layer, int item) { Frame F = relocal(F_);
    const int b = item >> 8, h = (item >> 6) & 3, c = item & 63;
    rwkv_prep<1>(F, layer, b, h, c);
    LAS float* Kk = (LAS float*)(F.lds + RW_K); LAS float* Vv = (LAS float*)(F.lds + RW_V); LAS float* Ww = (LAS float*)(F.lds + RW_W);
    LAS float* Aa = (LAS float*)(F.lds + RW_A); LAS float* Bb = (LAS float*)(F.lds + RW_B);
    const int row = F.tid >> 2, part = F.tid & 3; const bool isU = row < 64;
    float S[16];
#pragma unroll
    for (int e = 0; e < 16; ++e) S[e] = (!isU && (16 * part + e == row - 64)) ? 1.0f : 0.0f;
    for (int t = 0; t < 64; ++t) {
        float a[16], bq[16], w[16], k[16];
#pragma unroll
        for (int q = 0; q < 4; ++q) { const f32x4 va = *(const LAS f32x4*)(Aa + t * 64 + 16 * part + 4 * q), vb = *(const LAS f32x4*)(Bb + t * 64 + 16 * part + 4 * q),
                                                  vw = *(const LAS f32x4*)(Ww + t * 64 + 16 * part + 4 * q), vk = *(const LAS f32x4*)(Kk + t * 64 + 16 * part + 4 * q);
#pragma unroll
            for (int j = 0; j < 4; ++j) { a[4 * q + j] = va[j]; bq[4 * q + j] = vb[j]; w[4 * q + j] = vw[j]; k[4 * q + j] = vk[j]; } }
        const float vr = isU ? Vv[t * 64 + row] : 0.0f;
        float sa = 0.f;
#pragma unroll
        for (int e = 0; e < 16; ++e) sa += S[e] * a[e];
        sa = sum4(sa);
#pragma unroll
        for (int e = 0; e < 16; ++e) S[e] = S[e] * w[e] + sa * bq[e] + vr * k[e];
    }
    const size_t ci = (size_t)(b * 4 + h) * 64 + c;
    if (isU) { float* dst = (float*)(F.ws + WS_MOE + RW_U) + ci * 4096 + row * 64 + 16 * part;
#pragma unroll
        for (int q = 0; q < 4; ++q) *(f32x4*)(dst + 4 * q) = (f32x4){S[4 * q], S[4 * q + 1], S[4 * q + 2], S[4 * q + 3]}; }
    else { const int i = row - 64; const int pos = 32 * (i >> 5) + 8 * ((i >> 2) & 3) + 4 * ((i >> 4) & 1) + (i & 3);
        bf16_t* dst = (bf16_t*)(F.ws + WS_MOE + RW_PT) + ci * 4096 + pos;
#pragma unroll
        for (int e = 0; e < 16; ++e) dst[(16 * part + e) * 64] = f2bf(S[e]); }
}
__device__ __forceinline__ void item_rwkv_carry(const Frame& F_, int item) { Frame F = relocal(F_);
    const int bh = item * 2 + (F.wave >> 2), nt = F.wave & 3, r = F.lane & 15, g = F.lane >> 4;
    const bf16_t* PT = (const bf16_t*)(F.ws + WS_MOE + RW_PT); const float* Uc = (const float*)(F.ws + WS_MOE + RW_U); float* Ss = (float*)(F.ws + WS_MOE + RW_S);
    f32x4 acc[4];
#pragma unroll
    for (int m = 0; m < 4; ++m) acc[m] = (f32x4){0.f, 0.f, 0.f, 0.f};
    for (int c = 0; c < 64; ++c) { const size_t ci = (size_t)bh * 64 + c;
        bf16x8 af[4][2]; f32x4 cin[4];
#pragma unroll
        for (int m = 0; m < 4; ++m) { cin[m] = *(const f32x4*)(Uc + ci * 4096 + (16 * nt + r) * 64 + 16 * m + 4 * g);
#pragma unroll
            for (int s = 0; s < 2; ++s) af[m][s] = *(const bf16x8*)(PT + ci * 4096 + (16 * m + r) * 64 + 32 * s + 8 * g); }
#pragma unroll
        for (int m = 0; m < 4; ++m) *(f32x4*)(Ss + ci * 4096 + (16 * nt + r) * 64 + 16 * m + 4 * g) = acc[m];
        bf16x8 bfr[2];
#pragma unroll
        for (int s = 0; s < 2; ++s) { u32x4 w; w.x = pk2(acc[2 * s][0], acc[2 * s][1]); w.y = pk2(acc[2 * s][2], acc[2 * s][3]); w.z = pk2(acc[2 * s + 1][0], acc[2 * s + 1][1]); w.w = pk2(acc[2 * s + 1][2], acc[2 * s + 1][3]);
            bfr[s] = __builtin_bit_cast(bf16x8, w); }
#pragma unroll
        for (int m = 0; m < 4; ++m) { acc[m] = __builtin_amdgcn_mfma_f32_16x16x32_bf16(af[m][0], bfr[0], cin[m], 0, 0, 0);
            acc[m] = __builtin_amdgcn_mfma_f32_16x16x32_bf16(af[m][1], bfr[1], acc[m], 0, 0, 0); }
    }
}
__device__ __forceinline__ void item_rwkv3(const Frame& F_, int layer, int item) { Frame F = relocal(F_);
    const int b = item >> 8, h = (item >> 6) & 3, c = item & 63; const size_t T0 = (size_t)b * SEQ + c * 64;
    rwkv_prep<3>(F, layer, b, h, c);
    LAS float* Rr = (LAS float*)(F.lds + RW_R); LAS float* Kk = (LAS float*)(F.lds + RW_K); LAS float* Vv = (LAS float*)(F.lds + RW_V); LAS float* Ww = (LAS float*)(F.lds + RW_W);
    LAS float* Aa = (LAS float*)(F.lds + RW_A); LAS float* Bb = (LAS float*)(F.lds + RW_B); LAS float* Oo = (LAS float*)(F.lds + RW_O);
    LAS float* SG = (LAS float*)(F.lds + RW_SG); LAS float* BON = (LAS float*)(F.lds + RW_BON);
    { const int row = F.tid >> 3, part = F.tid & 7; const size_t ci = (size_t)(b * 4 + h) * 64 + c;
      const float* sp = (const float*)(F.ws + WS_MOE + RW_S) + ci * 4096 + row * 64 + 8 * part;
      float S[8]; { const f32x4 x = *(const f32x4*)sp, y = *(const f32x4*)(sp + 4); S[0] = x[0]; S[1] = x[1]; S[2] = x[2]; S[3] = x[3]; S[4] = y[0]; S[5] = y[1]; S[6] = y[2]; S[7] = y[3]; }
      for (int t = 0; t < 64; ++t) {
          float a[8], bq[8], w[8], k[8], rr[8];
#pragma unroll
          for (int q = 0; q < 2; ++q) { const int o = t * 64 + 8 * part + 4 * q; const f32x4 va = *(const LAS f32x4*)(Aa + o), vb = *(const LAS f32x4*)(Bb + o), vw = *(const LAS f32x4*)(Ww + o), vk = *(const LAS f32x4*)(Kk + o), vr4 = *(const LAS f32x4*)(Rr + o);
#pragma unroll
              for (int j = 0; j < 4; ++j) { a[4 * q + j] = va[j]; bq[4 * q + j] = vb[j]; w[4 * q + j] = vw[j]; k[4 * q + j] = vk[j]; rr[4 * q + j] = vr4[j]; } }
          const float vr = Vv[t * 64 + row];
          float sa = 0.f;
#pragma unroll
          for (int e = 0; e < 8; ++e) sa += S[e] * a[e];
          sa = sum8(sa);
          float o = 0.f;
#pragma unroll
          for (int e = 0; e < 8; ++e) { S[e] = S[e] * w[e] + sa * bq[e] + vr * k[e]; o += S[e] * rr[e]; }
          o = sum8(o);
          if (part == 0) Oo[t * 64 + row] = o;
      } }
    __syncthreads();
    { const int j = F.lane, tq = F.wave, ch = h * 64 + j;
      float g2c[64];
#pragma unroll
      for (int i = 0; i < 64; ++i) g2c[i] = F.in[I_RG2][((size_t)layer * 64 + i) * 256 + ch];
      const float lw = F.in[I_RLNW][layer * 256 + ch], lb = F.in[I_RLNB][layer * 256 + ch];
      bf16_t* Y = (bf16_t*)(F.ws + WS_H);
      for (int i8 = 0; i8 < 8; ++i8) { const int t = tq + 8 * i8;
          const float o = Oo[t * 64 + j]; const float mean = wave_sum(o) * (1.0f / 64.0f); const float d = o - mean; const float var = wave_sum(d * d) * (1.0f / 64.0f);
          float on = d * rsqrtf(var + 64e-5f) * lw + lb; on += BON[t] * Vv[t * 64 + j];
          float gg = 0.f;
#pragma unroll
          for (int i = 0; i < 64; i += 4) { const f32x4 sv = *(const LAS f32x4*)(SG + t * 64 + i); gg += sv[0] * g2c[i] + sv[1] * g2c[i + 1] + sv[2] * g2c[i + 2] + sv[3] * g2c[i + 3]; }
          Y[(T0 + t) * DM + 256 + ch] = f2bf(on * gg); } }
}

constexpr int DS_SEL = 131072, DS_HIST = 135168, DS_BKT = 151552, DS_BIAS = 152064;
__device__ __forceinline__ unsigned fkey(float f) { const unsigned u = __float_as_uint(f); return (u & 0x80000000u) ? ~u : (u | 0x80000000u); }
__device__ __forceinline__ void item_dsa(const Frame& F_, int layer, int item) { Frame F = relocal(F_);
    const bf16_t* U = (const bf16_t*)(F.ws + WS_U); const bf16_t* KI = (const bf16_t*)(F.ws + WS_KIDX);
    const bf16_t* Kb = (const bf16_t*)(F.ws + WS_K); const bf16_t* Vb = (const bf16_t*)(F.ws + WS_V);
    const int b = item & 3, qg = 511 - (item >> 2); const size_t TB = (size_t)b * SEQ, T0 = TB + qg * 8;
    LAS float* sc = (LAS float*)F.lds; LAS unsigned short* selall = (LAS unsigned short*)(F.lds + DS_SEL); LAS unsigned* histall = (LAS unsigned*)(F.lds + DS_HIST);
    LAS int* bkt = (LAS int*)(F.lds + DS_BKT); LAS float* biasT = (LAS float*)(F.lds + DS_BIAS);
    if (F.tid < 128) { const int n = F.tid; int bk = n; if (n >= 16) { const float lr = logf((float)n / 16.0f) / 2.0794415416798357f; bk = 16 + (int)(lr * 16.0f); bk = bk < 31 ? bk : 31; } bkt[n] = bk; biasT[n] = F.in[I_RELB][n]; }
    const int lane = F.lane, hh = lane >> 5;
    {
        bf16x8 af[2][2]; float wq[2][2][8];
        { const int r = lane & 31, q4 = 2 * ((r >> 2) & 1) + (r >> 4), head = 4 * ((r >> 3) & 1) + (r & 3);
#pragma unroll
          for (int mt = 0; mt < 2; ++mt)
#pragma unroll
              for (int ks = 0; ks < 2; ++ks) af[mt][ks] = *(const bf16x8*)(U + (T0 + 4 * mt + q4) * NINP + UC + 384 + head * 32 + 16 * ks + 8 * hh); }
#pragma unroll
        for (int mt = 0; mt < 2; ++mt)
#pragma unroll
            for (int q2 = 0; q2 < 2; ++q2) { float f[8]; unpack8(*(const u32x4*)(U + (T0 + 4 * mt + 2 * hh + q2) * NINP + UC + 672), f);
#pragma unroll
                for (int hd = 0; hd < 8; ++hd) wq[mt][q2][hd] = f[hd]; }
        const int ntile = (qg * 8 + 8 + 31) >> 5;
        for (int kt = F.wave; kt < ntile; kt += 8) {
            const int key = kt * 32 + (lane & 31);
            const bf16x8 b0 = *(const bf16x8*)(KI + (TB + key) * 32 + 8 * hh), b1 = *(const bf16x8*)(KI + (TB + key) * 32 + 16 + 8 * hh);
#pragma unroll
            for (int mt = 0; mt < 2; ++mt) { f32x16 acc;
#pragma unroll
                for (int i = 0; i < 16; ++i) acc[i] = 0.f;
                acc = __builtin_amdgcn_mfma_f32_32x32x16_bf16(af[mt][0], b0, acc, 0, 0, 0);
                acc = __builtin_amdgcn_mfma_f32_32x32x16_bf16(af[mt][1], b1, acc, 0, 0, 0);
#pragma unroll
                for (int q2 = 0; q2 < 2; ++q2) { float s = 0.f;
#pragma unroll
                    for (int hd = 0; hd < 8; ++hd) s += fmaxf(acc[8 * q2 + hd], 0.f) * wq[mt][q2][hd];
                    const int qi = 4 * mt + 2 * hh + q2;
                    sc[qi * 4096 + key] = (key <= qg * 8 + qi) ? s : -INFINITY; } }
        }
    }
    __syncthreads();
    const int qi = F.wave, tq = qg * 8 + qi, n = tq + 1;
    LAS float* scq = sc + qi * 4096; LAS unsigned short* sel = selall + qi * 256; LAS unsigned* hist = histall + qi * 512;
    int nsel;
    if (n <= 256) { nsel = n; for (int j = lane; j < 256; j += 64) sel[j] = (unsigned short)(j < n ? j : 0); }
    else {
        nsel = 256;
        const int R = (n + 63) >> 6; const unsigned long long ltm = (1ull << lane) - 1ull;
        float lo = INFINITY, hi = -INFINITY;
#pragma unroll 8
        for (int i = 0; i < R; ++i) { const int j = lane + 64 * i; if (j < n) { const float v = scq[j]; lo = fminf(lo, v); hi = fmaxf(hi, v); } }
#pragma unroll
        for (int o = 1; o < 64; o <<= 1) { lo = fminf(lo, shx(lo, o)); hi = fmaxf(hi, shx(hi, o)); }
        bool slow = false;
        if (!(hi > lo)) { for (int j = lane; j < 256; j += 64) sel[j] = (unsigned short)j; }
        else {
            const float scale = 1023.0f / (hi - lo);
            *(LAS u32x4*)(hist + 8 * lane) = (u32x4){0u, 0u, 0u, 0u}; *(LAS u32x4*)(hist + 8 * lane + 4) = (u32x4){0u, 0u, 0u, 0u};
#pragma unroll 8
            for (int i = 0; i < R; ++i) { const int j = lane + 64 * i; if (j < n) { int bk = (int)((scq[j] - lo) * scale); bk = bk < 1023 ? bk : 1023;
                atomicAdd((unsigned*)(hist + (bk >> 1)), (bk & 1) ? 65536u : 1u); } }
            const u32x4 h0 = *(const LAS u32x4*)(hist + 8 * lane), h1 = *(const LAS u32x4*)(hist + 8 * lane + 4);
            unsigned cb[16];
            cb[0] = h0.x & 0xffffu; cb[1] = h0.x >> 16; cb[2] = h0.y & 0xffffu; cb[3] = h0.y >> 16; cb[4] = h0.z & 0xffffu; cb[5] = h0.z >> 16; cb[6] = h0.w & 0xffffu; cb[7] = h0.w >> 16;
            cb[8] = h1.x & 0xffffu; cb[9] = h1.x >> 16; cb[10] = h1.y & 0xffffu; cb[11] = h1.y >> 16; cb[12] = h1.z & 0xffffu; cb[13] = h1.z >> 16; cb[14] = h1.w & 0xffffu; cb[15] = h1.w >> 16;
            unsigned tot = 0u;
#pragma unroll
            for (int q = 0; q < 16; ++q) tot += cb[q];
            unsigned incl = tot;
#pragma unroll
            for (int o = 1; o < 64; o <<= 1) { const unsigned t = shdown_u(incl, o); if (lane + o < 64) incl += t; }
            int fb = -1; unsigned fabove = 0u, fcnt = 0u; unsigned cum = incl - tot;
#pragma unroll
            for (int q = 15; q >= 0; --q) { if (fb < 0 && cum < 256u && 256u <= cum + cb[q]) { fb = 16 * lane + q; fabove = cum; fcnt = cb[q]; } cum += cb[q]; }
            const unsigned long long mf = __ballot(fb >= 0); const int src = (int)__ffsll((long long)mf) - 1;
            const int B = shidx_i(fb, src); const int above = shidx_i((int)fabove, src), cntB = shidx_i((int)fcnt, src); const int need = 256 - above;
            if (cntB > 256) slow = true;
            else {
                LAS unsigned* cand = hist;
                int base_gt = 0, base_c = 0;
#pragma unroll 4
                for (int i = 0; i < R; ++i) { const int j = lane + 64 * i; const bool valid = j < n; const float v = valid ? scq[j] : lo;
                    int bk = (int)((v - lo) * scale); bk = bk < 1023 ? bk : 1023;
                    const bool gt = valid && bk > B, eq = valid && bk == B;
                    const unsigned long long mg = __ballot(gt), me = __ballot(eq);
                    if (gt) sel[base_gt + __popcll(mg & ltm)] = (unsigned short)j;
                    if (eq) { const int p = base_c + __popcll(me & ltm); cand[2 * p] = fkey(v); cand[2 * p + 1] = (unsigned)j; }
                    base_gt += __popcll(mg); base_c += __popcll(me); }
                if (need == cntB) { for (int c = lane; c < cntB; c += 64) sel[above + c] = (unsigned short)cand[2 * c + 1]; }
                else {
                    unsigned ck[4]; int rk[4];
#pragma unroll
                    for (int q = 0; q < 4; ++q) { const int c = lane + 64 * q; ck[q] = c < cntB ? cand[2 * c] : 0u; rk[q] = 0; }
                    for (int c2 = 0; c2 < cntB; ++c2) { const unsigned k2 = cand[2 * c2];
#pragma unroll
                        for (int q = 0; q < 4; ++q) rk[q] += (k2 > ck[q] || (k2 == ck[q] && c2 < lane + 64 * q)) ? 1 : 0; }
#pragma unroll
                    for (int q = 0; q < 4; ++q) { const int c = lane + 64 * q; if (c < cntB && rk[q] < need) sel[above + rk[q]] = (unsigned short)cand[2 * c + 1]; }
                }
            }
        }
        if (slow) {
        unsigned prefix = 0u; int need = 256; unsigned neq = 0u;
        for (int p = 0; p < 4; ++p) { const int shift = 24 - 8 * p;
            *(LAS u32x4*)(hist + 4 * lane) = (u32x4){0u, 0u, 0u, 0u};
            for (int i = 0; i < R; ++i) { const int j = lane + 64 * i; if (j < n) { const unsigned u = fkey(scq[j]);
                if (p == 0 || (u >> (shift + 8)) == prefix) atomicAdd((unsigned*)(hist + ((u >> shift) & 255u)), 1u); } }
            const u32x4 hv = *(const LAS u32x4*)(hist + 4 * lane);
            const unsigned tot = hv.x + hv.y + hv.z + hv.w;
            unsigned incl = tot;
#pragma unroll
            for (int o = 1; o < 64; o <<= 1) { const unsigned t = shdown_u(incl, o); if (lane + o < 64) incl += t; }
            const unsigned above = incl - tot;
            int fb = -1; unsigned fabove = 0u, feq = 0u; unsigned cum = above;
            { const unsigned hq[4] = {hv.x, hv.y, hv.z, hv.w};
#pragma unroll
              for (int q = 3; q >= 0; --q) { if (fb < 0 && cum < (unsigned)need && (unsigned)need <= cum + hq[q]) { fb = 4 * lane + q; fabove = cum; feq = hq[q]; } cum += hq[q]; } }
            const unsigned long long m = __ballot(fb >= 0);
            const int src = (int)__ffsll((long long)m) - 1;
            const int bin = shidx_i(fb, src); const unsigned ab = (unsigned)shidx_i((int)fabove, src); neq = (unsigned)shidx_i((int)feq, src);
            need -= (int)ab; prefix = (prefix << 8) | (unsigned)bin;
        }
        const int ngt = 256 - need;
        int base_gt = 0, base_eq = 0;
        for (int i = 0; i < R; ++i) { const int j = lane + 64 * i; const unsigned u = (j < n) ? fkey(scq[j]) : 0u;
            const bool gt = (j < n) && (u > prefix), eq = (j < n) && (u == prefix);
            const unsigned long long mg = __ballot(gt), me = __ballot(eq); const unsigned long long lt = (1ull << lane) - 1ull;
            if (gt) sel[base_gt + __popcll(mg & lt)] = (unsigned short)j;
            if (eq) { const int rk = base_eq + __popcll(me & lt); if (rk < need) sel[ngt + rk] = (unsigned short)j; }
            base_gt += __popcll(mg); base_eq += __popcll(me); }
        (void)neq;
            }
    }
    const int nt16 = (nsel + 15) >> 4, r16 = lane & 15, g4 = lane >> 4;
    LAS float* biasj = scq + 2048;
#pragma unroll
    for (int q = 0; q < 4; ++q) { const int j = lane + 64 * q; f32x4 bv = (f32x4){-INFINITY, -INFINITY, -INFINITY, -INFINITY};
        if (j < nsel) { const int dist = tq - (int)sel[j]; const int bk = dist < 128 ? bkt[dist < 0 ? 0 : dist] : 31; bv = *(const LAS f32x4*)(biasT + 4 * bk); }
        *(LAS f32x4*)(biasj + 4 * j) = bv; }
    bf16x8 qf[2];
#pragma unroll
    for (int s = 0; s < 2; ++s) { u32x4 z = (u32x4){0u, 0u, 0u, 0u}; if (r16 < 4) z = *(const u32x4*)(U + (T0 + qi) * NINP + UC + r16 * 64 + 32 * s + 8 * g4); qf[s] = __builtin_bit_cast(bf16x8, z); }
    float lg[16][4]; float mx = -INFINITY;
#pragma unroll
    for (int hb = 0; hb < 2; ++hb) {
        if (hb * 8 < nt16) {
            int keyr[8]; bf16x8 a0[8], a1[8];
#pragma unroll
            for (int m8 = 0; m8 < 8; ++m8) keyr[m8] = sel[16 * (8 * hb + m8) + r16];
#pragma unroll
            for (int m8 = 0; m8 < 8; ++m8) { a0[m8] = *(const bf16x8*)(Kb + (TB + keyr[m8]) * 64 + 8 * g4); a1[m8] = *(const bf16x8*)(Kb + (TB + keyr[m8]) * 64 + 32 + 8 * g4); }
#pragma unroll
            for (int m8 = 0; m8 < 8; ++m8) { const int m = 8 * hb + m8;
                f32x4 acc = (f32x4){0.f, 0.f, 0.f, 0.f};
                acc = __builtin_amdgcn_mfma_f32_16x16x32_bf16(a0[m8], qf[0], acc, 0, 0, 0);
                acc = __builtin_amdgcn_mfma_f32_16x16x32_bf16(a1[m8], qf[1], acc, 0, 0, 0);
#pragma unroll
                for (int i = 0; i < 4; ++i) { const float v = acc[i] * 0.125f + biasj[(16 * m + 4 * g4 + i) * 4 + (r16 & 3)]; lg[m][i] = v; mx = fmaxf(mx, v); } }
        } else {
#pragma unroll
            for (int m8 = 0; m8 < 8; ++m8)
#pragma unroll
                for (int i = 0; i < 4; ++i) lg[8 * hb + m8][i] = -INFINITY;
        }
    }
    mx = fmaxf(mx, shx(mx, 16)); mx = fmaxf(mx, shx(mx, 32));
    float sm = 0.f;
#pragma unroll
    for (int m = 0; m < 16; ++m)
#pragma unroll
        for (int i = 0; i < 4; ++i) { const float p = __expf(lg[m][i] - mx); lg[m][i] = p; sm += p; }
    sm += shx(sm, 16); sm += shx(sm, 32);
    f32x4 ov[4];
#pragma unroll
    for (int nt = 0; nt < 4; ++nt) ov[nt] = (f32x4){0.f, 0.f, 0.f, 0.f};
    const unsigned vs_base = (unsigned)(unsigned long)scq;
#pragma unroll
    for (int half = 0; half < 2; ++half) {
        if (half * 8 < nt16) {
            asm volatile("s_waitcnt lgkmcnt(0)" ::: "memory");
#pragma unroll
            for (int q = 0; q < 16; ++q) { const int rho = 8 * q + (lane >> 3);
                const int j = half * 128 + (rho & ~31) + 16 * ((rho >> 2) & 1) + 4 * ((rho >> 3) & 3) + (rho & 3);
                const int key = sel[j];
                __builtin_amdgcn_global_load_lds((const unsigned*)(Vb + (TB + key) * 64 + 8 * (lane & 7)), (LAS unsigned*)((LAS unsigned char*)scq + q * 1024), 16, 0, 0); }
            asm volatile("s_waitcnt vmcnt(0)" ::: "memory");
#pragma unroll
            for (int s4 = 0; s4 < 4; ++s4) { const int s = half * 4 + s4;
                u32x4 pw; pw.x = pk2(lg[2 * s][0], lg[2 * s][1]); pw.y = pk2(lg[2 * s][2], lg[2 * s][3]); pw.z = pk2(lg[2 * s + 1][0], lg[2 * s + 1][1]); pw.w = pk2(lg[2 * s + 1][2], lg[2 * s + 1][3]);
                const bf16x8 pa = __builtin_bit_cast(bf16x8, pw);
                const unsigned ad = vs_base + (unsigned)((32 * s4 + 8 * g4 + (r16 >> 2)) * 128 + (r16 & 3) * 8);
                u32x2 t0[4], t1[4];
                asm volatile("ds_read_b64_tr_b16 %0, %8\n\tds_read_b64_tr_b16 %1, %8 offset:512\n\tds_read_b64_tr_b16 %2, %8 offset:32\n\tds_read_b64_tr_b16 %3, %8 offset:544\n\t"
                             "ds_read_b64_tr_b16 %4, %8 offset:64\n\tds_read_b64_tr_b16 %5, %8 offset:576\n\tds_read_b64_tr_b16 %6, %8 offset:96\n\tds_read_b64_tr_b16 %7, %8 offset:608\n\ts_waitcnt lgkmcnt(0)"
                             : "=&v"(t0[0]), "=&v"(t1[0]), "=&v"(t0[1]), "=&v"(t1[1]), "=&v"(t0[2]), "=&v"(t1[2]), "=&v"(t0[3]), "=&v"(t1[3]) : "v"(ad) : "memory");
#pragma unroll
                for (int nt = 0; nt < 4; ++nt) { const bf16x8 vb = __builtin_bit_cast(bf16x8, (u32x4){t0[nt].x, t0[nt].y, t1[nt].x, t1[nt].y});
                    ov[nt] = __builtin_amdgcn_mfma_f32_16x16x32_bf16(pa, vb, ov[nt], 0, 0, 0); } }
        }
    }
    { float inv[4];
#pragma unroll
      for (int h = 0; h < 4; ++h) inv[h] = 1.0f / __int_as_float(__builtin_amdgcn_readlane(__float_as_int(sm), h));
      if (lane < 16) { bf16_t* Y = (bf16_t*)(F.ws + WS_H) + (T0 + qi) * DM + 512 + r16;
#pragma unroll
          for (int h = 0; h < 4; ++h)
#pragma unroll
              for (int nt = 0; nt < 4; ++nt) Y[h * 64 + 16 * nt] = f2bf(ov[nt][h] * inv[h]); } }
}

__device__ __forceinline__ void phase_router(const Frame& F_, int layer, int cset) { Frame F = relocal(F_);
    const float* X = (const float*)(F.ws + WS_X);
    const bf16_t* WH = (const bf16_t*)(F.ws + WS_WRT) + (size_t)layer * 2 * 49152; const bf16_t* WL = WH + 49152;
    LAS float* part = (LAS float*)F.lds;
    LAS float* ssq = (LAS float*)(F.lds + 24576);
    LAS int* es = (LAS int*)(F.lds + 25088);
    LAS int* lr = (LAS int*)(F.lds + 25600);
    LAS float* wsl = (LAS float*)(F.lds + 26112);
    LAS float* rsd = (LAS float*)(F.lds + 26624);
    for (int blk = F.bid; blk < NTOK / 64; blk += F.G) {
        __syncthreads();
        const int mt = F.wave & 3, kh = F.wave >> 2, r16 = F.lane & 15, g4 = F.lane >> 4;
        const float* xr = X + ((size_t)blk * 64 + mt * 16 + r16) * DM + kh * 512 + 8 * g4;
        f32x4 acc[3]; acc[0] = acc[1] = acc[2] = (f32x4){0.f, 0.f, 0.f, 0.f}; float ss = 0.f;
#pragma unroll 4
        for (int ks = 0; ks < 16; ++ks) {
            const f32x4 xa = *(const f32x4*)(xr + ks * 32), xb = *(const f32x4*)(xr + ks * 32 + 4);
            ss += xa[0] * xa[0] + xa[1] * xa[1] + xa[2] * xa[2] + xa[3] * xa[3] + xb[0] * xb[0] + xb[1] * xb[1] + xb[2] * xb[2] + xb[3] * xb[3];
            float xv[8] = {xa[0], xa[1], xa[2], xa[3], xb[0], xb[1], xb[2], xb[3]}; unsigned hw[4], lw[4];
#pragma unroll
            for (int j = 0; j < 4; ++j) { const bf16_t h0 = f2bf(xv[2 * j]), h1 = f2bf(xv[2 * j + 1]); hw[j] = (unsigned)h0 | ((unsigned)h1 << 16);
                lw[j] = pk2(xv[2 * j] - bf2f(h0), xv[2 * j + 1] - bf2f(h1)); }
            const bf16x8 ahi = __builtin_bit_cast(bf16x8, (u32x4){hw[0], hw[1], hw[2], hw[3]}), alo = __builtin_bit_cast(bf16x8, (u32x4){lw[0], lw[1], lw[2], lw[3]});
#pragma unroll
            for (int nt = 0; nt < 3; ++nt) { const size_t wo = (size_t)(nt * 16 + r16) * 1024 + kh * 512 + ks * 32 + 8 * g4;
                const bf16x8 bh = *(const bf16x8*)(WH + wo), bl = *(const bf16x8*)(WL + wo);
                acc[nt] = __builtin_amdgcn_mfma_f32_16x16x32_bf16(ahi, bh, acc[nt], 0, 0, 0);
                acc[nt] = __builtin_amdgcn_mfma_f32_16x16x32_bf16(ahi, bl, acc[nt], 0, 0, 0);
                acc[nt] = __builtin_amdgcn_mfma_f32_16x16x32_bf16(alo, bh, acc[nt], 0, 0, 0); }
        }
        ss += shx(ss, 16); ss += shx(ss, 32);
        if (g4 == 0) ssq[kh * 64 + mt * 16 + r16] = ss;
#pragma unroll
        for (int nt = 0; nt < 3; ++nt)
#pragma unroll
            for (int i = 0; i < 4; ++i) part[(kh * 64 + mt * 16 + 4 * g4 + i) * 48 + nt * 16 + r16] = acc[nt][i];
        __syncthreads();
        if (F.tid < 64) { const float rstd = rsqrtf((ssq[F.tid] + ssq[64 + F.tid]) * (1.0f / DM) + 1e-6f); rsd[F.tid] = rstd;
            float l[36];
#pragma unroll
            for (int o = 0; o < 36; ++o) l[o] = (part[F.tid * 48 + o] + part[(64 + F.tid) * 48 + o]) * rstd + (o < 32 ? F.in[I_BRE][layer * 32 + o] : F.in[I_BRG][layer * 4 + o - 32]);
            int gs = 0; float gm = l[32];
#pragma unroll
            for (int j = 1; j < 4; ++j) if (l[32 + j] > gm) { gm = l[32 + j]; gs = j; }
            float den = 0.f;
#pragma unroll
            for (int j = 0; j < 4; ++j) den += __expf(l[32 + j] - gm);
            const float gate = 1.0f / den;
            float e8[8];
#pragma unroll
            for (int j = 0; j < 8; ++j) e8[j] = gs == 0 ? l[j] : gs == 1 ? l[8 + j] : gs == 2 ? l[16 + j] : l[24 + j];
            int i1 = 0; float v1 = e8[0];
#pragma unroll
            for (int j = 1; j < 8; ++j) if (e8[j] > v1) { v1 = e8[j]; i1 = j; }
            int i2 = -1; float v2 = -INFINITY;
#pragma unroll
            for (int j = 0; j < 8; ++j) if (j != i1 && e8[j] > v2) { v2 = e8[j]; i2 = j; }
            const float e2 = __expf(v2 - v1); const float p1 = 1.0f / (1.0f + e2);
            es[F.tid * 2] = gs * 8 + i1; es[F.tid * 2 + 1] = gs * 8 + i2; wsl[F.tid * 2] = p1 * gate; wsl[F.tid * 2 + 1] = (1.0f - p1) * gate; }
        __syncthreads();
        if (F.tid < 32) { int cnt = 0; for (int i = 0; i < 128; ++i) if (es[i] == F.tid) lr[i] = cnt++;
            if (cnt) { const int base = (int)__hip_atomic_fetch_add(F.ctl + CW_CNT + cset * 32 + F.tid, (unsigned)cnt, __ATOMIC_RELAXED, __HIP_MEMORY_SCOPE_AGENT);
                for (int i = 0; i < 128; ++i) if (es[i] == F.tid) lr[i] += base; } }
        __syncthreads();
        if (F.tid < 64) { int* rt = (int*)(F.ws + WS_ROUTE) + ((size_t)blk * 64 + F.tid) * 8;
            rt[0] = es[F.tid * 2]; rt[1] = es[F.tid * 2 + 1]; ((float*)rt)[2] = wsl[F.tid * 2]; ((float*)rt)[3] = wsl[F.tid * 2 + 1]; rt[4] = lr[F.tid * 2]; rt[5] = lr[F.tid * 2 + 1]; ((float*)rt)[6] = rsd[F.tid]; }
    }
}
struct CmGU { __device__ __forceinline__ int operator()(int n) const { return 128 * (n >> 8) + (n & 127); } };
__device__ __forceinline__ void phase_moe_convert(const Frame& F_, int layer) { Frame F = relocal(F_);
    bf16_t* WGU = (bf16_t*)(F.ws + WS_MOE + MOE_WGU); bf16_t* WD = (bf16_t*)(F.ws + WS_MOE + MOE_WD);
    for (int t = F.bid; t < 6144; t += F.G) {
        if (t < 4096) { const int e = t >> 7, r = t & 127, kt = r >> 3, nt = r & 7; const bool up = ((nt * 64) & 255) >= 128;
            const float* src = (up ? F.in[I_WUP] : F.in[I_WGATE]) + ((size_t)layer * 32 + e) * 1024 * 256;
            tr_tile(F, src, 256, WGU + (size_t)e * 512 * 1024, 1024, kt * 64, nt * 64, CmGU()); }
        else { const int q = t - 4096, e = q >> 6, r = q & 63, kt = r >> 4, nt = r & 15;
            tr_tile(F, F.in[I_WDOWN] + ((size_t)layer * 32 + e) * 256 * 1024, 1024, WD + (size_t)e * 1024 * 256, 256, kt * 64, nt * 64, CmId()); }
    }
}
__device__ __forceinline__ void phase_gather(const Frame& F_, int layer) { Frame F = relocal(F_);
    LAS int* off = (LAS int*)F.lds;
    __syncthreads();
    if (F.tid == 0) { int acc = 0; for (int e = 0; e < 32; ++e) { off[e] = acc; const int c = (int)__hip_atomic_load(F.ctl + CW_CNT + layer * 32 + e, __ATOMIC_RELAXED, __HIP_MEMORY_SCOPE_AGENT); acc += (c + 255) & ~255; } off[32] = acc; }
    __syncthreads();
    int* tiles = (int*)(F.ws + WS_TILES); int* row_tok = (int*)(F.ws + WS_ROWS); float* row_w = (float*)(F.ws + WS_ROWS) + MAXROWS;
    if (F.bid == 0) { if (F.tid == 0) tiles[0] = off[32] >> 8; if (F.tid < 33) tiles[1 + F.tid] = off[F.tid];
        if (F.tid < 32) for (int rt = off[F.tid] >> 8; rt < (off[F.tid + 1] >> 8); ++rt) tiles[64 + rt] = F.tid; }
    for (int e = F.bid; e < 32; e += F.G) { const int c = (int)__hip_atomic_load(F.ctl + CW_CNT + layer * 32 + e, __ATOMIC_RELAXED, __HIP_MEMORY_SCOPE_AGENT);
        for (int r = off[e] + c + F.tid; r < off[e + 1]; r += NTHR) { row_tok[r] = -1; row_w[r] = 0.f; } }
    const float* X = (const float*)(F.ws + WS_X); bf16_t* HP = (bf16_t*)(F.ws + WS_U); const float* nw = F.in[I_NORM2] + (size_t)layer * DM;
    f32x4 nwv[4];
#pragma unroll
    for (int j = 0; j < 4; ++j) nwv[j] = *(const f32x4*)(nw + 4 * F.lane + 256 * j);
    for (int t = F.bid * 8 + F.wave; t < NTOK; t += F.G * 8) {
        const int* rt = (const int*)(F.ws + WS_ROUTE) + (size_t)t * 8; const float rstd = ((const float*)rt)[6];
        const int p0 = off[rt[0]] + rt[4], p1 = off[rt[1]] + rt[5];
#pragma unroll
        for (int j = 0; j < 4; ++j) { const int c = 4 * F.lane + 256 * j; const f32x4 v = *(const f32x4*)(X + (size_t)t * DM + c) * rstd * nwv[j];
            u32x2 o; o.x = pk2(v[0], v[1]); o.y = pk2(v[2], v[3]);
            *(u32x2*)(HP + (size_t)p0 * DM + c) = o; *(u32x2*)(HP + (size_t)p1 * DM + c) = o; }
        if (F.lane == 0) { row_tok[p0] = t * 2; row_w[p0] = ((const float*)rt)[2]; row_tok[p1] = t * 2 + 1; row_w[p1] = ((const float*)rt)[3]; }
    }
}

constexpr int NPH_LAYER = 11, NPHASE = 1 + 2 * NPH_LAYER + 1;
__global__ void __launch_bounds__(NTHR, 2) mk_forward(Params P) {
    extern __shared__ __attribute__((aligned(16))) unsigned char lds_raw[];
    Frame F; F.lds = (LAS unsigned char*)lds_raw; F.tid = threadIdx.x; F.lane = F.tid & 63; F.wave = __builtin_amdgcn_readfirstlane(F.tid >> 6); F.bid = blockIdx.x; F.G = gridDim.x;
    F.in = (in_tab_t)__builtin_amdgcn_kernarg_segment_ptr(); F.out = P.out; F.ws = P.ws; F.ctl = (unsigned*)(P.ws + WS_CTL); F.misc = (volatile LAS int*)(F.lds + MISC_OFF);
    if (F.tid < 64) ((LAS unsigned*)(F.lds + MISC_OFF))[F.tid] = 0u;
    __syncthreads();
    const int lo = P.ph_lo, hi = P.ph_hi;
    XcdBarrier bar; bar.bar = F.ctl + CW_BAR; bar.x = 0; bar.st = (volatile LAS unsigned*)(F.lds + MISC_OFF + 16);
    if (hi - lo > 1) bar = xcd_barrier_post(F.ctl + CW_BAR, (volatile LAS unsigned*)(F.lds + MISC_OFF + 16));
#ifndef MK_ONLY
#define MK_ONLY -1
#endif
#define EN(o) (MK_ONLY < 0 || MK_ONLY == (o))
#ifndef MK_ITEM
#define MK_ITEM -1
#endif
#define IT(o) (MK_ITEM < 0 || MK_ITEM == (o))
#define IN(k) (lo <= (k) && (k) < hi)
#ifndef RPH
#define RPH -1
#endif
#define SEAM(k) do { if (IN(k) && IN((k) + 1)) xcd_barrier(bar); } while (0)
    if (EN(100) && IN(0)) { phase_prologue(F); } SEAM(0);
#if RPH == 101
    if (IN(1)) { phase_norm(F, F.in[I_X], false, F.in[I_NORM1], 0); phase_norm(F, F.in[I_X], false, F.in[I_NORM1], 0); phase_norm(F, F.in[I_X], false, F.in[I_NORM1], 0); phase_norm(F, F.in[I_X], false, F.in[I_NORM1], 0); } SEAM(0);
#endif
#if RPH == 100
    if (IN(0)) { phase_prologue(F); } SEAM(0);
#endif
#pragma unroll
    for (int layer = 0; layer < DEPTH; ++layer) {
        const int pb = 1 + layer * NPH_LAYER;
        if (EN(0) && IN(pb + 0)) { phase_norm(F, layer == 0 ? F.in[I_X] : (const float*)(F.ws + WS_X), layer > 0, F.in[I_NORM1] + (size_t)layer * DM, 0); } SEAM(pb + 0);
        if (EN(1) && IN(pb + 1)) { const Frame F_ = F; Frame F = relocal(F_); pg8::StaticOrder S; S.init((const bf16_t*)(F.ws + WS_H), (const bf16_t*)(F.ws + WS_WIN) + (size_t)layer * NINP * DM, NTOK, NINP, DM, F.G, F.bid);
            pg8::EpiBf16 E{(bf16_t*)(F.ws + WS_U), NINP}; pg8::gemm_phase(F.lds, DM, S, E); } SEAM(pb + 1);
#if RPH == 1
        if (IN(pb + 1)) { const Frame F_ = F; Frame F = relocal(F_); pg8::StaticOrder S; S.init((const bf16_t*)(F.ws + WS_H), (const bf16_t*)(F.ws + WS_WIN) + (size_t)layer * NINP * DM, NTOK, NINP, DM, F.G, F.bid);
            pg8::EpiBf16 E{(bf16_t*)(F.ws + WS_U), NINP}; pg8::gemm_phase(F.lds, DM, S, E); } SEAM(pb + 1);
#endif
#ifndef REP_C
#define REP_C 1
#endif
#ifndef REP_D
#define REP_D 1
#endif
#ifndef REP_E
#define REP_E 1
#endif
#define QLOOP(qi, n, body) for (;;) { const int it = q_pop(F, layer * 12 + (qi)); if (it >= (n)) break; body; }
        if (EN(2) && IN(pb + 2)) {
            if (IT(0)) QLOOP(0, 256, item_s5<1>(F, layer, it));
            if (IT(1)) QLOOP(1, 1024, item_rwkv1(F, layer, it));
            if (IT(2)) QLOOP(2, 256, item_mamba<1>(F, layer, it));
            if (IT(3)) QLOOP(3, 256, item_kv(F, layer, it));
#if REP_C == 2
            QLOOP(24, 256, item_s5<1>(F, layer, it));
#elif REP_C == 3
            QLOOP(25, 1024, item_rwkv1(F, layer, it));
#elif REP_C == 4
            QLOOP(26, 256, item_mamba<1>(F, layer, it));
#elif REP_C == 5
            QLOOP(27, 256, item_kv(F, layer, it));
#endif
        } SEAM(pb + 2);
        if (EN(3) && IN(pb + 3)) {
            if (IT(0)) QLOOP(4, 8, item_rwkv_carry(F, it));
            if (IT(1)) QLOOP(5, 16, item_mamba_carry(F, it));
            if (IT(2)) QLOOP(6, 4, item_s5_carry(F, layer, it));
            if (IT(3)) QLOOP(7, 2048, item_dsa(F, layer, it));
#if REP_D == 2
            QLOOP(31, 2048, item_dsa(F, layer, it));
#endif
        } SEAM(pb + 3);
        if (EN(4) && IN(pb + 4)) {
            if (IT(0)) QLOOP(8, 256, item_s5<2>(F, layer, it));
            if (IT(1)) QLOOP(9, 1024, item_rwkv3(F, layer, it));
            if (IT(2)) QLOOP(10, 256, item_mamba<2>(F, layer, it));
#if REP_E == 2
            QLOOP(32, 256, item_s5<2>(F, layer, it));
#elif REP_E == 3
            QLOOP(33, 1024, item_rwkv3(F, layer, it));
#elif REP_E == 4
            QLOOP(34, 256, item_mamba<2>(F, layer, it));
#endif
        } SEAM(pb + 4);
        if (EN(5) && IN(pb + 5)) { const Frame F_ = F; Frame F = relocal(F_); pg8::StaticOrder S; S.init((const bf16_t*)(F.ws + WS_MOE + YSG_OFF), (const bf16_t*)(F.ws + WS_GLU) + (size_t)layer * 512 * 256, NTOK, 512, 256, F.G, F.bid);
            pg8::EpiGated<0> E{(bf16_t*)(F.ws + WS_H), DM, 768, F.in[I_SGLUB] + layer * 512, F.in[I_SGLUB] + layer * 512 + 256}; pg8::gemm_phase(F.lds, 256, S, E); } SEAM(pb + 5);
#if RPH == 5
        if (IN(pb + 5)) { const Frame F_ = F; Frame F = relocal(F_); pg8::StaticOrder S; S.init((const bf16_t*)(F.ws + WS_MOE + YSG_OFF), (const bf16_t*)(F.ws + WS_GLU) + (size_t)layer * 512 * 256, NTOK, 512, 256, F.G, F.bid);
            pg8::EpiGated<0> E{(bf16_t*)(F.ws + WS_H), DM, 768, F.in[I_SGLUB] + layer * 512, F.in[I_SGLUB] + layer * 512 + 256}; pg8::gemm_phase(F.lds, 256, S, E); } SEAM(pb + 5);
#endif
        if (EN(6) && IN(pb + 6)) { const Frame F_ = F; Frame F = relocal(F_); pg8::StaticOrder S; S.init((const bf16_t*)(F.ws + WS_H), (const bf16_t*)(F.ws + WS_WOUT) + (size_t)layer * DM * DM, NTOK, DM, DM, F.G, F.bid);
            pg8::EpiResid E{(float*)(F.ws + WS_X), DM}; pg8::gemm_phase(F.lds, DM, S, E); } SEAM(pb + 6);
        if (EN(7) && IN(pb + 7)) { phase_router(F, layer, layer); phase_moe_convert(F, layer); } SEAM(pb + 7);
#if RPH == 70
        if (IN(pb + 7)) { phase_router(F, layer, layer + 2); } SEAM(pb + 7);
#endif
#if RPH == 7
        if (IN(pb + 7)) { phase_moe_convert(F, layer); } SEAM(pb + 7);
#endif
        if (EN(8) && IN(pb + 8)) { phase_gather(F, layer); } SEAM(pb + 8);
#if RPH == 8
        if (IN(pb + 8)) { phase_gather(F, layer); } SEAM(pb + 8);
#endif
        if (EN(9) && IN(pb + 9)) { const Frame F_ = F; Frame F = relocal(F_); pg8::MoeOrder S{2, F.G, F.bid, DM, (const char*)(F.ws + WS_U), (const char*)(F.ws + WS_MOE + MOE_WGU), (size_t)512 * 1024 * 2, (const int*)(F.ws + WS_TILES)};
            pg8::EpiGated<1> E{(bf16_t*)(F.ws + WS_H), 256, 0, nullptr, nullptr}; pg8::gemm_phase(F.lds, DM, S, E); } SEAM(pb + 9);
#if RPH == 9
        if (IN(pb + 9)) { const Frame F_ = F; Frame F = relocal(F_); pg8::MoeOrder S{2, F.G, F.bid, DM, (const char*)(F.ws + WS_U), (const char*)(F.ws + WS_MOE + MOE_WGU), (size_t)512 * 1024 * 2, (const int*)(F.ws + WS_TILES)};
            pg8::EpiGated<1> E{(bf16_t*)(F.ws + WS_H), 256, 0, nullptr, nullptr}; pg8::gemm_phase(F.lds, DM, S, E); } SEAM(pb + 9);
#endif
        if (EN(10) && IN(pb + 10)) { const Frame F_ = F; Frame F = relocal(F_); pg8::MoeOrder S{4, F.G, F.bid, 256, (const char*)(F.ws + WS_H), (const char*)(F.ws + WS_MOE + MOE_WD), (size_t)1024 * 256 * 2, (const int*)(F.ws + WS_TILES)};
            pg8::EpiMoeOut E{(bf16_t*)(F.ws + WS_U), (const int*)(F.ws + WS_ROWS), (const float*)(F.ws + WS_ROWS) + MAXROWS}; pg8::gemm_phase(F.lds, 256, S, E); } SEAM(pb + 10);
#if RPH == 10
        if (IN(pb + 10)) { const Frame F_ = F; Frame F = relocal(F_); pg8::MoeOrder S{4, F.G, F.bid, 256, (const char*)(F.ws + WS_H), (const char*)(F.ws + WS_MOE + MOE_WD), (size_t)1024 * 256 * 2, (const int*)(F.ws + WS_TILES)};
            pg8::EpiMoeOut E{(bf16_t*)(F.ws + WS_U), (const int*)(F.ws + WS_ROWS), (const float*)(F.ws + WS_ROWS) + MAXROWS}; pg8::gemm_phase(F.lds, 256, S, E); } SEAM(pb + 10);
#endif
    }
    if (EN(101) && IN(NPHASE - 1)) { phase_norm(F, (const float*)(F.ws + WS_X), true, F.in[I_FNORM], 2); }
#undef IN
#undef SEAM
}

#ifndef MK_SPLIT
#define MK_SPLIT 0
#endif
extern "C" void kernel_launch(void* const* d_in, const int* in_sizes, int n_in, void* d_out, int out_size, void* d_ws, size_t ws_size, hipStream_t stream) {
    static int grid = 0;
    if (grid == 0) {
        if (n_in != 44 || out_size != NTOK * DM || ws_size < WS_END) { fprintf(stderr, "kernel_launch: unexpected shapes (n_in %d out %d ws %zu need %zu)\n", n_in, out_size, ws_size, (size_t)WS_END); grid = -1; return; }
        int dev = 0, cus = 0;
        if (hipGetDevice(&dev) != hipSuccess || hipDeviceGetAttribute(&cus, hipDeviceAttributeMultiprocessorCount, dev) != hipSuccess) { grid = -1; return; }
        if (hipFuncSetAttribute((const void*)mk_forward, hipFuncAttributeMaxDynamicSharedMemorySize, LDS_BYTES) != hipSuccess) { fprintf(stderr, "kernel_launch: hipFuncSetAttribute failed\n"); grid = -1; return; }
        int per_cu = 0;
        if (hipOccupancyMaxActiveBlocksPerMultiprocessor(&per_cu, (const void*)mk_forward, NTHR, LDS_BYTES) != hipSuccess || per_cu < 1) { fprintf(stderr, "kernel_launch: occupancy query says %d\n", per_cu); }
        (void)hipGetLastError();
        grid = cus;
    }
    if (grid < 0) return;
    hipMemsetAsync((char*)d_ws + WS_CTL, 0, CTL_BYTES, stream);
    Params p{};
    for (int i = 0; i < 44; ++i) p.in[i] = (const float*)d_in[i];
    p.out = (float*)d_out; p.ws = (unsigned char*)d_ws;
#if MK_SPLIT
    for (int ph = 0; ph < NPHASE; ++ph) { p.ph_lo = ph; p.ph_hi = ph + 1; hipLaunchKernelGGL(mk_forward, dim3(grid), dim3(NTHR), LDS_BYTES, stream, p); }
#else
    p.ph_lo = 0; p.ph_hi = NPHASE; hipLaunchKernelGGL(mk_forward, dim3(grid), dim3(NTHR), LDS_BYTES, stream, p);
#endif
}
```

```cpp
#include <hip/hip_runtime.h>
#include <stdint.h>
#include <stdio.h>

#define LAS __attribute__((address_space(3)))
typedef unsigned short bf16_t;
typedef short bf16x8 __attribute__((ext_vector_type(8)));
typedef float f32x4 __attribute__((ext_vector_type(4)));
typedef float f32x2 __attribute__((ext_vector_type(2)));
typedef float f32x16 __attribute__((ext_vector_type(16)));
typedef unsigned u32x4 __attribute__((ext_vector_type(4)));
typedef unsigned u32x2 __attribute__((ext_vector_type(2)));

constexpr int NTOK = 16384, DM = 1024, SEQ = 4096, NBATCH = 4, DEPTH = 2;
constexpr int NIN = 2604, NINP = 2816;
constexpr int UM = 0;
constexpr int UR = 784;
constexpr int UC = 1680;
constexpr int US = 2368;
constexpr int NTHR = 512;
constexpr int LDS_BYTES = 163840;
constexpr int MISC_OFF = LDS_BYTES - 256;

constexpr size_t WS_CTL   = 0;
constexpr size_t CTL_BYTES = 65536;
constexpr size_t WS_X     = WS_CTL + CTL_BYTES;
constexpr size_t WS_H     = WS_X + (size_t)NTOK * DM * 4;
constexpr size_t WS_U     = WS_H + (size_t)NTOK * DM * 2;
constexpr size_t WS_WIN   = WS_U + (size_t)NTOK * NINP * 2;
constexpr size_t WS_WOUT  = WS_WIN + (size_t)2 * NINP * DM * 2;
constexpr size_t WS_GLU   = WS_WOUT + (size_t)2 * DM * DM * 2;
constexpr size_t WS_MOE   = WS_GLU + (size_t)2 * 512 * 256 * 2;
constexpr size_t MOE_WGU  = 0;
constexpr size_t MOE_WD   = (size_t)32 * 512 * 1024 * 2;
constexpr size_t MOE_BYTES = MOE_WD + (size_t)32 * 1024 * 256 * 2;
constexpr size_t RW_PT    = 0;
constexpr size_t RW_U     = (size_t)1024 * 4096 * 2;
constexpr size_t RW_S     = RW_U + (size_t)1024 * 4096 * 2;
constexpr size_t RW_W1    = RW_S + (size_t)1024 * 4096 * 2;
constexpr size_t RW_Z     = RW_W1 + (size_t)1024 * 4096 * 2;
constexpr size_t YSG_OFF  = RW_Z + (size_t)1024 * 4096 * 2;
static_assert(YSG_OFF + (size_t)NTOK * 256 * 2 <= MOE_BYTES, "alias");
constexpr size_t WS_MST   = WS_MOE + MOE_BYTES;
constexpr size_t WS_MDEC  = WS_MST + (size_t)4 * 64 * 4 * 4096 * 4;
constexpr size_t WS_S5ST  = WS_MDEC + 4096;
constexpr size_t WS_K     = WS_S5ST + (size_t)4 * 64 * 2048 * 4;
constexpr size_t WS_V     = WS_K + (size_t)NTOK * 64 * 2;
constexpr size_t WS_KIDX  = WS_V + (size_t)NTOK * 64 * 2;
constexpr size_t WS_ROUTE = WS_KIDX + (size_t)NTOK * 32 * 2;
constexpr size_t WS_ROWS  = WS_ROUTE + (size_t)NTOK * 32;
constexpr int    MAXROWS  = 49152;
constexpr size_t WS_TILES = WS_ROWS + (size_t)MAXROWS * 8;
constexpr size_t WS_S5TAB = WS_TILES + 4096;
constexpr size_t S5TAB_F  = (size_t)(2048 + 2048 + 32768) * 4;
constexpr size_t S5TAB_L  = S5TAB_F + (size_t)16 * 16 * 128 * 2;
constexpr size_t WS_WRT   = WS_S5TAB + 2 * S5TAB_L;
constexpr size_t WS_END   = WS_WRT + (size_t)2 * 2 * 48 * 1024 * 2;

constexpr int CW_BAR = 0;
constexpr int CW_Q   = 4096;
constexpr int CW_CNT = 8192;

__device__ __forceinline__ float bf2f(bf16_t b) { return __uint_as_float(((unsigned)b) << 16); }
__device__ __forceinline__ bf16_t f2bf(float f) { unsigned u = __float_as_uint(f); u += 0x7FFFu + ((u >> 16) & 1u); return (bf16_t)(u >> 16); }
__device__ __forceinline__ unsigned pk2(float lo, float hi) { return (unsigned)f2bf(lo) | ((unsigned)f2bf(hi) << 16); }
__device__ __forceinline__ unsigned cvt_pk_bf16(float lo, float hi) { unsigned r; asm volatile("v_cvt_pk_bf16_f32 %0, %1, %2" : "=v"(r) : "v"(lo), "v"(hi)); return r; }
__device__ __forceinline__ float sigmoidf_(float x) { return 1.0f / (1.0f + __expf(-x)); }
__device__ __forceinline__ float siluf_(float x) { return x / (1.0f + __expf(-x)); }
__device__ __forceinline__ float tanhf_(float x) { const float e = __expf(2.0f * x); return 1.0f - 2.0f / (e + 1.0f); }
__device__ __forceinline__ float softplusf_(float x) { return fmaxf(x, 0.0f) + log1pf(__expf(-fabsf(x))); }
__device__ __forceinline__ float gelu_tanh(float x) { return 0.5f * x * (1.0f + tanhf_(0.7978845608028654f * (x + 0.044715f * x * x * x))); }
template <int CTRL> __device__ __forceinline__ float dppf(float x) { return __int_as_float(__builtin_amdgcn_update_dpp(0, __float_as_int(x), CTRL, 0xF, 0xF, true)); }
__device__ __forceinline__ float sum4(float x) { x += dppf<0xB1>(x); x += dppf<0x4E>(x); return x; }
__device__ __forceinline__ float sum8(float x) { x = sum4(x); x += dppf<0x141>(x); return x; }
__device__ __forceinline__ float sum16(float x) { x = sum8(x); x += dppf<0x140>(x); return x; }
__device__ __forceinline__ int lane_id_() { int l = (int)__builtin_amdgcn_mbcnt_hi(~0u, __builtin_amdgcn_mbcnt_lo(~0u, 0u)); asm volatile("" : "+v"(l)); return l; }
__device__ __forceinline__ float shx(float x, int o) { return __int_as_float(__builtin_amdgcn_ds_bpermute((lane_id_() ^ o) << 2, __float_as_int(x))); }
__device__ __forceinline__ unsigned shdown_u(unsigned x, int o) { return (unsigned)__builtin_amdgcn_ds_bpermute(((lane_id_() + o) & 63) << 2, (int)x); }
__device__ __forceinline__ int shidx_i(int x, int src) { return __builtin_amdgcn_ds_bpermute(src << 2, x); }
__device__ __forceinline__ float wave_sum(float x) { x = sum16(x); x += shx(x, 16); x += shx(x, 32); return x; }
__device__ __forceinline__ void unpack8(const u32x4 v, float (&f)[8]) {
    f[0] = __uint_as_float(v.x << 16); f[1] = __uint_as_float(v.x & 0xffff0000u); f[2] = __uint_as_float(v.y << 16); f[3] = __uint_as_float(v.y & 0xffff0000u);
    f[4] = __uint_as_float(v.z << 16); f[5] = __uint_as_float(v.z & 0xffff0000u); f[6] = __uint_as_float(v.w << 16); f[7] = __uint_as_float(v.w & 0xffff0000u);
}

#define XB_TMO      128
#define XB_XCNT(j)  (256  + 64 * (j))
#define XB_XSUB(j)  (1280 + 64 * (j))
#define XB_XGEN(j)  (2304 + 64 * (j))
#define XB_TOP      3328
#define XB_TOPGEN   3392
#define XCD_BAR_WORDS 3456
#define XB_SPIN_CAP (1u << 22)
__device__ __forceinline__ unsigned xb_ld(unsigned* p)              { return __hip_atomic_load(p, __ATOMIC_RELAXED, __HIP_MEMORY_SCOPE_AGENT); }
__device__ __forceinline__ unsigned xb_add(unsigned* p, unsigned v) { return __hip_atomic_fetch_add(p, v, __ATOMIC_RELAXED, __HIP_MEMORY_SCOPE_AGENT); }
__device__ __forceinline__ unsigned xb_xcc_id() { return (unsigned)__builtin_amdgcn_s_getreg((3 << 11) | 20) & 0xFu; }
#define XB_SPIN(cond, bar) do { unsigned _sp = 0; while (cond) { __builtin_amdgcn_s_sleep(1); \
    if ((++_sp & 255u) == 0u) { if (xb_ld(&(bar)[XB_TMO])) break; if (_sp > XB_SPIN_CAP) { atomicAdd(&(bar)[XB_TMO], 1u); break; } } } } while (0)
struct XcdBarrier { unsigned* bar; unsigned x; volatile LAS unsigned* st; };
__device__ __forceinline__ XcdBarrier xcd_barrier_post(unsigned* bar, volatile LAS unsigned* st) {
    XcdBarrier b; b.bar = bar; b.x = xb_xcc_id(); b.st = st;
    if (threadIdx.x == 0) (void)xb_add(&bar[XB_XCNT(b.x)], 1u);
    return b;
}
__device__ __forceinline__ void xcd_barrier_complete(unsigned* bar, unsigned x, unsigned& nloc, unsigned& nx) {
    const unsigned G = gridDim.x * gridDim.y * gridDim.z;
    unsigned sum, cnt, mine, sp = 0u;
    for (;;) {
        sum = 0u; cnt = 0u; mine = 0u;
#pragma unroll
        for (unsigned j = 0; j < 16; ++j) { const unsigned c = xb_ld(&bar[XB_XCNT(j)]); sum += c; cnt += (c > 0u) ? 1u : 0u; mine = (j == x) ? c : mine; }
        if (sum == G) break;
        __builtin_amdgcn_s_sleep(1);
        if ((++sp & 255u) == 0u) { if (xb_ld(&bar[XB_TMO])) break; if (sp > XB_SPIN_CAP) { atomicAdd(&bar[XB_TMO], 1u); break; } }
    }
    nloc = mine > 0u ? mine : 1u; nx = cnt > 0u ? cnt : 1u;
}
__device__ __forceinline__ void xcd_barrier(const XcdBarrier& b_) {
    XcdBarrier b = b_; { const unsigned long long v = (unsigned long long)b.bar; unsigned lo = __builtin_amdgcn_readfirstlane((unsigned)v), hi = __builtin_amdgcn_readfirstlane((unsigned)(v >> 32)); asm volatile("" : "+s"(lo), "+s"(hi)); b.bar = (unsigned*)(((unsigned long long)hi << 32) | lo); unsigned xx = __builtin_amdgcn_readfirstlane(b.x); asm volatile("" : "+s"(xx)); b.x = xx; }
    asm volatile("s_waitcnt vmcnt(0)" ::: "memory");
    __syncthreads();
    if (threadIdx.x == 0) {
        unsigned* bar = b.bar;
        __builtin_amdgcn_s_waitcnt(0);
        unsigned nloc = b.st[0], nx = b.st[1];
        if (nloc == 0u) { xcd_barrier_complete(bar, b.x, nloc, nx); b.st[0] = nloc; b.st[1] = nx; }
        const unsigned old = xb_add(&bar[XB_XSUB(b.x)], 1u);
        const unsigned gen = old / nloc;
        if (old + 1u == (gen + 1u) * nloc) {
            __builtin_amdgcn_fence(__ATOMIC_RELEASE, "agent");
            asm volatile("s_waitcnt vmcnt(0)" ::: "memory");
            const unsigned og = xb_add(&bar[XB_TOP], 1u);
            const unsigned tg = og / nx;
            if (og + 1u == (tg + 1u) * nx) xb_add(&bar[XB_TOPGEN], 1u);
            else XB_SPIN(xb_ld(&bar[XB_TOPGEN]) == tg, bar);
            __builtin_amdgcn_fence(__ATOMIC_ACQUIRE, "agent");
            xb_add(&bar[XB_XGEN(b.x)], 1u);
            asm volatile("s_waitcnt vmcnt(0)" ::: "memory");
        } else {
            XB_SPIN(xb_ld(&bar[XB_XGEN(b.x)]) == gen, bar);
            __builtin_amdgcn_fence(__ATOMIC_ACQUIRE, "agent");
            asm volatile("s_waitcnt vmcnt(0)" ::: "memory");
        }
    }
    __syncthreads();
}

namespace pg8 {
constexpr int BM = 256, BK = 64, HALF = 128, HTB = HALF * BK * 2, STAGE_BYTES = 8 * HTB, NXCD = 8, WGM = 8;
__host__ __device__ __forceinline__ int lds_byte(int r, int c) { const int st = (r >> 4) * 2 + (c >> 5), rr = r & 15, cc = c & 31, ob = rr * 64 + cc * 2; return st * 1024 + (ob ^ (((ob >> 9) & 1) << 5)); }
__host__ __device__ __forceinline__ void stage_rc(int b, int& R, int& C) { const int st = b / 1024, sb = b % 1024, swz = sb ^ (((sb >> 9) & 1) << 5); R = (st >> 1) * 16 + swz / 64; C = (st & 1) * 32 + (swz % 64) / 2; }
__host__ __device__ __forceinline__ int perm32(int rho) { const int n = rho >> 4, i = rho & 15; return 8 * (i >> 2) + 4 * n + (i & 3); }
struct Unit { int pm, pn; const char* a; const char* b; };

struct StaticOrder {
    int nM, nN, nwg, G, c, K; const char* A; const char* B;
    __device__ void init(const bf16_t* A_, const bf16_t* B_, int M, int N, int K_, int G_, int c_) { A = (const char*)A_; B = (const char*)B_; K = K_; nM = M / BM; nN = N / BM; nwg = nM * nN; G = G_; c = c_; }
    __device__ bool next(int i, Unit& u) const {
        const long L = (long)i * G + c; if (L >= nwg) return false;
        int wgid = (int)L; { const int q = nwg / NXCD, r = nwg % NXCD, xcd = wgid % NXCD, off = wgid / NXCD; wgid = (xcd < r ? xcd * (q + 1) : r * (q + 1) + (xcd - r) * q) + off; }
        const int nig = WGM * nN, gid = wgid / nig, fm = gid * WGM, gsz = (nM - fm) < WGM ? (nM - fm) : WGM;
        u.pm = fm + ((wgid % nig) % gsz); u.pn = (wgid % nig) / gsz;
        u.a = A + (size_t)u.pm * 256 * K * 2; u.b = B + (size_t)u.pn * 256 * K * 2; return true;
    }
};

template <class Epi, class Sched>
__device__ __forceinline__ void gemm_phase(LAS unsigned char* lds, const int K_, const Sched& S, const Epi& E) {
    int K = K_; asm volatile("" : "+s"(K));
    int tid_ = threadIdx.x; asm volatile("" : "+v"(tid_));
    const int tid = tid_, wid = __builtin_amdgcn_readfirstlane(tid >> 6), lane = tid & 63, wr = wid >> 2, wc = wid & 3, fr = lane & 15, fq = lane >> 4;
    const int nt = K / BK;
    unsigned voffA[2], voffB[2];
#pragma unroll
    for (int i = 0; i < 2; ++i) { int R, C; stage_rc(tid * 16 + i * 8192, R, C); const int Rb = Epi::PERM ? ((R & ~31) + perm32(R & 31)) : R;
        voffA[i] = (unsigned)(R * K + C) * 2u; voffB[i] = (unsigned)(Rb * K + C) * 2u; }
    const size_t kstep = (size_t)(BK * 2);
    const size_t hstep = (size_t)HALF * K * 2;
    const unsigned ldsw = (unsigned)wid * 1024u;
    const int aoff = lds_byte(wr * 64 + fr, fq * 8), boff = lds_byte(wc * 32 + fr, fq * 8);
#define PG8_SA(b, h) (((b) * 2 + (h)) * HTB)
#define PG8_SB(b, h) ((4 + (b) * 2 + (h)) * HTB)
#define PG8_STAGE(bufoff, gbase, voff) do { _Pragma("unroll") for (int _i = 0; _i < 2; ++_i) \
        __builtin_amdgcn_global_load_lds((const unsigned*)((const char*)(gbase) + (voff)[_i]), (LAS unsigned*)(lds + (bufoff) + ldsw + _i * 8192), 16, 0, 0); } while (0)
#define PG8_LDA(dst, b, h) do { _Pragma("unroll") for (int m = 0; m < 4; ++m) _Pragma("unroll") for (int k = 0; k < 2; ++k) dst[m][k] = *(const LAS bf16x8*)(lds + PG8_SA(b, h) + aoff + m * 2048 + k * 1024); } while (0)
#define PG8_LDB(dst, b, h) do { _Pragma("unroll") for (int n = 0; n < 2; ++n) _Pragma("unroll") for (int k = 0; k < 2; ++k) dst[n][k] = *(const LAS bf16x8*)(lds + PG8_SB(b, h) + boff + n * 2048 + k * 1024); } while (0)
#define PG8_MMA(ai, bj, At, Bt) do { __builtin_amdgcn_s_setprio(1); _Pragma("unroll") for (int m = 0; m < 4; ++m) _Pragma("unroll") for (int n = 0; n < 2; ++n) _Pragma("unroll") for (int k = 0; k < 2; ++k) \
        acc[ai][bj][m][n] = __builtin_amdgcn_mfma_f32_16x16x32_bf16(Bt[n][k], At[m][k], acc[ai][bj][m][n], 0, 0, 0); __builtin_amdgcn_s_setprio(0); } while (0)
#define PG8_WAIT_V(n) asm volatile("s_waitcnt vmcnt(" #n ")" ::: "memory")
#define PG8_WAIT_L(n) asm volatile("s_waitcnt lgkmcnt(" #n ")" ::: "memory")
#define PG8_BAR __builtin_amdgcn_s_barrier()
#define PG8_SCHED __builtin_amdgcn_sched_barrier(0)
    Unit cur, nxt; int ui = 0;
    if (!S.next(0, cur)) return;
    f32x4 acc[2][2][4][2];
#pragma unroll
    for (int a = 0; a < 2; ++a)
#pragma unroll
        for (int b = 0; b < 2; ++b)
#pragma unroll
            for (int m = 0; m < 4; ++m)
#pragma unroll
                for (int n = 0; n < 2; ++n) acc[a][b][m][n] = (f32x4){0.f, 0.f, 0.f, 0.f};
    bf16x8 At[4][2], B0[2][2], B1[2][2];
    const char* cA = cur.a; const char* cB = cur.b;
    PG8_STAGE(PG8_SB(0, 0), cB, voffB); PG8_STAGE(PG8_SA(0, 0), cA, voffA); PG8_STAGE(PG8_SB(0, 1), cB + hstep, voffB); PG8_STAGE(PG8_SA(0, 1), cA + hstep, voffA);
    if (wr == 1) PG8_BAR;
    PG8_WAIT_V(4); PG8_BAR;
    PG8_STAGE(PG8_SB(1, 0), cB + kstep, voffB); PG8_STAGE(PG8_SA(1, 0), cA + kstep, voffA); PG8_STAGE(PG8_SB(1, 1), cB + hstep + kstep, voffB);
    PG8_WAIT_V(6); PG8_BAR;
    for (;;) {
        const bool has_next = S.next(ui + 1, nxt);
        const char* nA = has_next ? nxt.a : cA; const char* nB = has_next ? nxt.b : cB;
        for (int t = 0; t < nt; t += 2) {
            const bool last = (t == nt - 2);
            const char* a1 = cA + (size_t)(t + 1) * kstep;
            const char* a2 = last ? nA : cA + (size_t)(t + 2) * kstep; const char* b2 = last ? nB : cB + (size_t)(t + 2) * kstep;
            const char* a3 = a2 + kstep; const char* b3 = b2 + kstep;
            PG8_LDB(B0, 0, 0); PG8_SCHED; PG8_LDA(At, 0, 0); PG8_STAGE(PG8_SA(1, 1), a1 + hstep, voffA);
            PG8_WAIT_L(8); PG8_BAR; PG8_WAIT_L(0); PG8_MMA(0, 0, At, B0); PG8_BAR; PG8_SCHED;
            PG8_LDB(B1, 0, 1); PG8_STAGE(PG8_SB(0, 0), b2, voffB);
            PG8_BAR; PG8_WAIT_L(0); PG8_MMA(0, 1, At, B1); PG8_BAR;
            PG8_LDA(At, 0, 1); PG8_STAGE(PG8_SA(0, 0), a2, voffA);
            PG8_BAR; PG8_WAIT_L(0); PG8_MMA(1, 0, At, B0); PG8_BAR; PG8_SCHED;
            PG8_STAGE(PG8_SB(0, 1), b2 + hstep, voffB);
            PG8_WAIT_V(6); PG8_BAR; PG8_MMA(1, 1, At, B1); PG8_BAR;
            PG8_LDB(B0, 1, 0); PG8_SCHED; PG8_LDA(At, 1, 0); PG8_STAGE(PG8_SA(0, 1), a2 + hstep, voffA);
            PG8_WAIT_L(8); PG8_BAR; PG8_WAIT_L(0); PG8_MMA(0, 0, At, B0); PG8_BAR; PG8_SCHED;
            PG8_LDB(B1, 1, 1); PG8_STAGE(PG8_SB(1, 0), b3, voffB);
            PG8_BAR; PG8_WAIT_L(0); PG8_MMA(0, 1, At, B1); PG8_BAR;
            PG8_LDA(At, 1, 1); PG8_STAGE(PG8_SA(1, 0), a3, voffA);
            PG8_BAR; PG8_WAIT_L(0); PG8_MMA(1, 0, At, B0); PG8_BAR; PG8_SCHED;
            PG8_STAGE(PG8_SB(1, 1), b3 + hstep, voffB);
            PG8_WAIT_V(6); PG8_BAR; PG8_MMA(1, 1, At, B1); PG8_BAR;
        }
        E(acc, cur, wr, wc, fr, fq);
        if (!has_next) break;
#pragma unroll
        for (int a = 0; a < 2; ++a)
#pragma unroll
            for (int b = 0; b < 2; ++b)
#pragma unroll
                for (int m = 0; m < 4; ++m)
#pragma unroll
                    for (int n = 0; n < 2; ++n) acc[a][b][m][n] = (f32x4){0.f, 0.f, 0.f, 0.f};
        cur = nxt; cA = nA; cB = nB; ++ui;
    }
    PG8_WAIT_V(0);
    if (wr == 0) PG8_BAR;
    PG8_BAR;
#undef PG8_SA
#undef PG8_SB
#undef PG8_STAGE
#undef PG8_LDA
#undef PG8_LDB
#undef PG8_MMA
#undef PG8_WAIT_V
#undef PG8_WAIT_L
#undef PG8_BAR
#undef PG8_SCHED
}

struct EpiBf16 {
    static constexpr bool PERM = true;
    bf16_t* O; int ldc;
    __device__ __forceinline__ void operator()(const f32x4 (&acc)[2][2][4][2], const Unit& u, int wr, int wc, int fr, int fq) const {
        const int row0 = u.pm * BM + wr * 64 + fr, col0 = u.pn * BM + wc * 32 + 8 * fq;
#pragma unroll
        for (int ai = 0; ai < 2; ++ai)
#pragma unroll
            for (int m = 0; m < 4; ++m) { bf16_t* rowp = O + (size_t)(row0 + ai * HALF + m * 16) * ldc + col0;
#pragma unroll
                for (int bj = 0; bj < 2; ++bj) { const f32x4 v0 = acc[ai][bj][m][0], v1 = acc[ai][bj][m][1];
                    u32x4 w; w.x = cvt_pk_bf16(v0[0], v0[1]); w.y = cvt_pk_bf16(v0[2], v0[3]); w.z = cvt_pk_bf16(v1[0], v1[1]); w.w = cvt_pk_bf16(v1[2], v1[3]);
                    *(u32x4*)(rowp + bj * HALF) = w; } }
    }
};
struct EpiResid {
    static constexpr bool PERM = false;
    float* C; int ldc;
    __device__ __forceinline__ void operator()(const f32x4 (&acc)[2][2][4][2], const Unit& u, int wr, int wc, int fr, int fq) const {
        const int row0 = u.pm * BM + wr * 64 + fr, col0 = u.pn * BM + wc * 32 + 4 * fq;
#pragma unroll
        for (int ai = 0; ai < 2; ++ai)
#pragma unroll
            for (int m = 0; m < 4; ++m) { float* rowp = C + (size_t)(row0 + ai * HALF + m * 16) * ldc + col0;
#pragma unroll
                for (int bj = 0; bj < 2; ++bj)
#pragma unroll
                    for (int n = 0; n < 2; ++n) { f32x4* p = (f32x4*)(rowp + bj * HALF + n * 16); *p = *p + acc[ai][bj][m][n]; } }
    }
};
template <int ACT  > struct EpiGated {
    static constexpr bool PERM = true;
    bf16_t* O; int ldo; int coloff; const float* ba; const float* bb;
    __device__ __forceinline__ void operator()(const f32x4 (&acc)[2][2][4][2], const Unit& u, int wr, int wc, int fr, int fq) const {
        const int row0 = u.pm * BM + wr * 64 + fr, cl = u.pn * HALF + wc * 32 + 8 * fq;
        float va[8], vb[8];
#pragma unroll
        for (int j = 0; j < 8; ++j) { va[j] = (ACT == 0) ? ba[cl + j] : 0.f; vb[j] = (ACT == 0) ? bb[cl + j] : 0.f; }
#pragma unroll
        for (int ai = 0; ai < 2; ++ai)
#pragma unroll
            for (int m = 0; m < 4; ++m) { bf16_t* rowp = O + (size_t)(row0 + ai * HALF + m * 16) * ldo + coloff + cl;
                float o[8];
#pragma unroll
                for (int n = 0; n < 2; ++n)
#pragma unroll
                    for (int j = 0; j < 4; ++j) { const float a = acc[ai][0][m][n][j] + va[4 * n + j], b = acc[ai][1][m][n][j] + vb[4 * n + j];
                        o[4 * n + j] = (ACT == 0) ? a * sigmoidf_(b) : siluf_(a) * b; }
                u32x4 w; w.x = cvt_pk_bf16(o[0], o[1]); w.y = cvt_pk_bf16(o[2], o[3]); w.z = cvt_pk_bf16(o[4], o[5]); w.w = cvt_pk_bf16(o[6], o[7]);
                *(u32x4*)rowp = w; asm volatile("" ::: "memory"); }
    }
};
struct EpiMoeOut {
    static constexpr bool PERM = true;
    bf16_t* O; const int* row_tok; const float* row_w;
    __device__ __forceinline__ void operator()(const f32x4 (&acc)[2][2][4][2], const Unit& u, int wr, int wc, int fr, int fq) const {
        const int row0 = u.pm * BM + wr * 64 + fr, col0 = u.pn * BM + wc * 32 + 8 * fq;
#pragma unroll
        for (int ai = 0; ai < 2; ++ai)
#pragma unroll
            for (int m = 0; m < 4; ++m) { const int row = row0 + ai * HALF + m * 16; const int ts = row_tok[row]; const float w = row_w[row];
                if (ts >= 0) { bf16_t* rowp = O + ((size_t)(ts & 1) * NTOK + (size_t)(ts >> 1)) * DM + col0;
#pragma unroll
                    for (int bj = 0; bj < 2; ++bj) { const f32x4 v0 = acc[ai][bj][m][0] * w, v1 = acc[ai][bj][m][1] * w;
                        u32x4 q; q.x = cvt_pk_bf16(v0[0], v0[1]); q.y = cvt_pk_bf16(v0[2], v0[3]); q.z = cvt_pk_bf16(v1[0], v1[1]); q.w = cvt_pk_bf16(v1[2], v1[3]);
                        *(u32x4*)(rowp + bj * HALF) = q; } } asm volatile("" ::: "memory"); }
    }
};
struct MoeOrder {
    int nN, G, c, K; const char* A; const char* B; size_t bstride; const int* tiles;
    __device__ bool next(int i, Unit& u) const {
        const int nrt = tiles[0]; const long L = (long)i * G + c; if (L >= (long)nrt * nN) return false;
        u.pm = (int)(L / nN); u.pn = (int)(L % nN); const int e = tiles[64 + u.pm];
        u.a = A + (size_t)u.pm * 256 * K * 2; u.b = B + (size_t)e * bstride + (size_t)u.pn * 256 * K * 2; return true;
    }
};
}

struct Params { const float* in[44]; float* out; unsigned char* ws; int ph_lo, ph_hi; };
enum { I_X = 0, I_NORM1, I_WIN, I_MCONVW, I_MCONVB, I_MDTB, I_MALOG, I_MD, I_MNORM, I_RMU, I_RW0, I_RW2, I_RA0, I_RA2, I_RG2, I_RKK, I_RKA, I_RRK, I_RLNW, I_RLNB,
       I_CKVN, I_CWUK, I_CWUV, I_RELB, I_SARE, I_SAIM, I_SBRE, I_SBIM, I_SCRE, I_SCIM, I_SD, I_SLOGDT, I_SGLUW, I_SGLUB, I_WOUT, I_NORM2, I_WRG, I_BRG, I_WRE, I_BRE,
       I_WGATE, I_WUP, I_WDOWN, I_FNORM };

typedef const float* const __attribute__((address_space(4)))* in_tab_t;
struct Frame {
    LAS unsigned char* lds; int tid, lane, wave, bid, G;
    in_tab_t in; float* out; unsigned char* ws; unsigned* ctl;
    volatile LAS int* misc;
};

__device__ __forceinline__ int q_pop(Frame& F, int qi) {
    __syncthreads();
    if (F.tid == 0) F.misc[0] = (int)__hip_atomic_fetch_add(F.ctl + CW_Q + 64 * qi, 1u, __ATOMIC_RELAXED, __HIP_MEMORY_SCOPE_AGENT);
    __syncthreads();
    return F.misc[0];
}

__device__ __forceinline__ const void* opaque_ptr(const void* p) { const unsigned long long v = (unsigned long long)p; unsigned lo = __builtin_amdgcn_readfirstlane((unsigned)v), hi = __builtin_amdgcn_readfirstlane((unsigned)(v >> 32));
    asm volatile("" : "+s"(lo), "+s"(hi)); return (const void*)(((unsigned long long)hi << 32) | lo); }
__device__ __forceinline__ Frame relocal(const Frame& G) { Frame F = G; asm volatile("" : "+v"(F.tid)); F.ws = (unsigned char*)opaque_ptr(F.ws); F.ctl = (unsigned*)(F.ws + WS_CTL); F.in = (in_tab_t)(unsigned long long)opaque_ptr((const void*)(unsigned long long)F.in); F.lane = F.tid & 63; F.wave = __builtin_amdgcn_readfirstlane(F.tid >> 6); return F; }
template <int K> __device__ __forceinline__ f32x4 mma_nt(const LAS bf16_t* A, int lda, const LAS bf16_t* Bt, int ldb, f32x4 acc, int lane) {
    const int r = lane & 15, g = lane >> 4;
#pragma unroll
    for (int k0 = 0; k0 < K; k0 += 32) {
        const bf16x8 a = *(const LAS bf16x8*)(A + r * lda + k0 + 8 * g);
        const bf16x8 b = *(const LAS bf16x8*)(Bt + r * ldb + k0 + 8 * g);
        acc = __builtin_amdgcn_mfma_f32_16x16x32_bf16(a, b, acc, 0, 0, 0);
    }
    return acc;
}

template <class ColMap> __device__ __forceinline__ void tr_tile(Frame& F, const float* src, int ldsrc, bf16_t* dst, int K, int k0, int n0, ColMap cm) {
    LAS float* tile = (LAS float*)F.lds;
    __syncthreads();
    { const int kk = F.tid >> 4, n4 = (F.tid & 15) * 4;
#pragma unroll
      for (int ps = 0; ps < 2; ++ps) { const int k = kk + 32 * ps; const int sc = cm(n0 + n4);
          f32x4 v = (f32x4){0.f, 0.f, 0.f, 0.f}; if (sc >= 0) v = *(const f32x4*)(src + (size_t)(k0 + k) * ldsrc + sc);
          tile[k * 65 + n4 + 0] = v[0]; tile[k * 65 + n4 + 1] = v[1]; tile[k * 65 + n4 + 2] = v[2]; tile[k * 65 + n4 + 3] = v[3]; } }
    __syncthreads();
    { const int n = F.tid >> 3, kc = F.tid & 7; float f[8];
#pragma unroll
      for (int j = 0; j < 8; ++j) f[j] = tile[(8 * kc + j) * 65 + n];
      u32x4 w; w.x = pk2(f[0], f[1]); w.y = pk2(f[2], f[3]); w.z = pk2(f[4], f[5]); w.w = pk2(f[6], f[7]);
      *(u32x4*)(dst + (size_t)(n0 + n) * K + k0 + 8 * kc) = w; }
}

struct CmIn { __device__ __forceinline__ int operator()(int n) const {
    if (n < 772) return n; if (n < UR) return -1; if (n < UR + 896) return 772 + (n - UR); if (n < UC) return -1;
    if (n < UC + 680) return 1668 + (n - UC); if (n < US) return -1; if (n < US + 256) return 2348 + (n - US); return -1; } };
struct CmId { __device__ __forceinline__ int operator()(int n) const { return n; } };
struct CmGlu { __device__ __forceinline__ int operator()(int n) const { const int pn = n >> 8, rr = n & 255; return rr < 128 ? 128 * pn + rr : 256 + 128 * pn + (rr - 128); } };
struct CmGateUp { int half; __device__ __forceinline__ int operator()(int n) const { return n; } };

__device__ __forceinline__ void phase_prologue(const Frame& F_) { Frame F = relocal(F_);
    for (int t = F.bid; t < 1984; t += F.G) {
        if (t < 1408) { const int l = t / 704, r = t % 704, kt = r / 44, nt = r % 44;
            tr_tile(F, F.in[I_WIN] + (size_t)l * DM * NIN, NIN, (bf16_t*)(F.ws + WS_WIN) + (size_t)l * NINP * DM, DM, kt * 64, nt * 64, CmIn()); }
        else if (t < 1920) { const int q = t - 1408, l = q / 256, r = q % 256, kt = r / 16, nt = r % 16;
            tr_tile(F, F.in[I_WOUT] + (size_t)l * DM * DM, DM, (bf16_t*)(F.ws + WS_WOUT) + (size_t)l * DM * DM, DM, kt * 64, nt * 64, CmId()); }
        else { const int q = t - 1920, l = q / 32, r = q % 32, kt = r / 8, nt = r % 8;
            tr_tile(F, F.in[I_SGLUW] + (size_t)l * 256 * 512, 512, (bf16_t*)(F.ws + WS_GLU) + (size_t)l * 512 * 256, 256, kt * 64, nt * 64, CmGlu()); }
    }
    for (int i = F.bid * NTHR + F.tid; i < 2 * 48 * 1024; i += F.G * NTHR) { const int l = i / 49152, r = i % 49152, o = r >> 10, k = r & 1023;
        float v = 0.f; if (o < 32) v = F.in[I_WRE][((size_t)l * DM + k) * 32 + o]; else if (o < 36) v = F.in[I_WRG][((size_t)l * DM + k) * 4 + (o - 32)];
        v *= F.in[I_NORM2][l * DM + k];
        const bf16_t hi = f2bf(v); const bf16_t lo = f2bf(v - bf2f(hi));
        bf16_t* w = (bf16_t*)(F.ws + WS_WRT) + (size_t)l * 2 * 49152; w[r] = hi; w[49152 + r] = lo; }
    for (int i = F.bid * NTHR + F.tid; i < 2048 + 65536; i += F.G * NTHR) {
        if (i < 2048) {
            const int l = i >> 10, gn = i & 1023, g = gn >> 6;
            float* tab = (float*)(F.ws + WS_S5TAB + (size_t)l * S5TAB_L);
            const float lre = fminf(F.in[I_SARE][l * 1024 + gn], -1e-4f), lim = F.in[I_SAIM][l * 1024 + gn];
            const float dt = expf(F.in[I_SLOGDT][l * 16 + g]);
            const float mag = expf(dt * lre); float sn, cs; sincosf(dt * lim, &sn, &cs);
            const float are = mag * cs, aim = mag * sn;
            const float den = lre * lre + lim * lim;
            const float fre = ((are - 1.0f) * lre + aim * lim) / den, fim = (aim * lre - (are - 1.0f) * lim) / den;
            tab[gn * 2] = are; tab[gn * 2 + 1] = aim;
            float pr = are, pi = aim;
#pragma unroll
            for (int s = 0; s < 6; ++s) { const float nr = pr * pr - pi * pi, ni = 2.0f * pr * pi; pr = nr; pi = ni; }
            tab[2048 + gn * 2] = pr; tab[2048 + gn * 2 + 1] = pi;
            const float* bre = F.in[I_SBRE] + ((size_t)l * 1024 + gn) * 16; const float* bim = F.in[I_SBIM] + ((size_t)l * 1024 + gn) * 16;
            for (int p = 0; p < 16; ++p) { tab[4096 + (gn * 16 + p) * 2] = fre * bre[p] - fim * bim[p]; tab[4096 + (gn * 16 + p) * 2 + 1] = fre * bim[p] + fim * bre[p]; }
        } else {
            const int j = i - 2048, l = j >> 15, r = j & 32767, gp = r >> 7, k = r & 127;
            bf16_t* cm = (bf16_t*)(F.ws + WS_S5TAB + (size_t)l * S5TAB_L + S5TAB_F);
            const float v = k < 64 ? F.in[I_SCRE][((size_t)l * 256 + gp) * 64 + k] : -F.in[I_SCIM][((size_t)l * 256 + gp) * 64 + (k - 64)];
            cm[r] = f2bf(v);
        }
    }
}

__device__ __forceinline__ void phase_norm(const Frame& F_, const float* xin, bool add_o, const float* w, int mode) { Frame F = relocal(F_);
    float* X = (float*)(F.ws + WS_X); bf16_t* H = (bf16_t*)(F.ws + WS_H); const bf16_t* O = (const bf16_t*)(F.ws + WS_U);
    for (int row = F.bid * 8 + F.wave; row < NTOK; row += F.G * 8) {
        f32x4 v[4]; float ss = 0.f;
#pragma unroll
        for (int j = 0; j < 4; ++j) { const int c = 4 * F.lane + 256 * j; v[j] = *(const f32x4*)(xin + (size_t)row * DM + c);
            if (add_o) { const u32x2 a = *(const u32x2*)(O + (size_t)row * DM + c), b = *(const u32x2*)(O + ((size_t)NTOK + row) * DM + c);
                v[j][0] += __uint_as_float(a.x << 16) + __uint_as_float(b.x << 16); v[j][1] += __uint_as_float(a.x & 0xffff0000u) + __uint_as_float(b.x & 0xffff0000u);
                v[j][2] += __uint_as_float(a.y << 16) + __uint_as_float(b.y << 16); v[j][3] += __uint_as_float(a.y & 0xffff0000u) + __uint_as_float(b.y & 0xffff0000u); }
            ss += v[j][0] * v[j][0] + v[j][1] * v[j][1] + v[j][2] * v[j][2] + v[j][3] * v[j][3]; }
        ss = wave_sum(ss);
        const float rstd = rsqrtf(ss * (1.0f / DM) + 1e-6f);
#pragma unroll
        for (int j = 0; j < 4; ++j) { const int c = 4 * F.lane + 256 * j; const f32x4 wv = *(const f32x4*)(w + c);
            if (mode == 2) { *(f32x4*)(F.out + (size_t)row * DM + c) = v[j] * rstd * wv; }
            else { *(f32x4*)(X + (size_t)row * DM + c) = v[j];
                u32x2 o; o.x = pk2(v[j][0] * rstd * wv[0], v[j][1] * rstd * wv[1]); o.y = pk2(v[j][2] * rstd * wv[2], v[j][3] * rstd * wv[3]);
                *(u32x2*)(H + (size_t)row * DM + c) = o; } }
    }
}

__device__ __forceinline__ void item_kv(const Frame& F_, int layer, int item) { Frame F = relocal(F_);
    const bf16_t* U = (const bf16_t*)(F.ws + WS_U);
    LAS bf16_t* Ab = (LAS bf16_t*)F.lds;
    LAS bf16_t* Bt = (LAS bf16_t*)(F.lds + 17408);
    const int t0 = item * 64;
    { const int tok = F.tid >> 3, part = F.tid & 7; const bf16_t* src = U + (size_t)(t0 + tok) * NINP + UC + 256 + 16 * part;
      float f[16]; { float a[8], b[8]; unpack8(*(const u32x4*)src, a); unpack8(*(const u32x4*)(src + 8), b);
#pragma unroll
        for (int j = 0; j < 8; ++j) { f[j] = a[j]; f[8 + j] = b[j]; } }
      float ss = 0.f;
#pragma unroll
      for (int j = 0; j < 16; ++j) ss += f[j] * f[j];
      ss = sum8(ss);
      const float rstd = rsqrtf(ss * (1.0f / 128.0f) + 1e-6f); const float* nw = F.in[I_CKVN] + layer * 128 + 16 * part;
#pragma unroll
      for (int j = 0; j < 16; j += 2) *(LAS unsigned*)(Ab + tok * 136 + 16 * part + j) = pk2(f[j] * rstd * nw[j], f[j + 1] * rstd * nw[j + 1]); }
    { const int n = F.tid >> 2, kq = F.tid & 3; const float* w = (n < 64 ? F.in[I_CWUK] : F.in[I_CWUV]) + (size_t)layer * 128 * 64 + (n & 63);
#pragma unroll 4
      for (int k = 32 * kq; k < 32 * kq + 32; ++k) Bt[n * 136 + k] = f2bf(w[(size_t)k * 64]); }
    if (F.tid < 256) { const int tok = F.tid >> 2, q = F.tid & 3;
        *(u32x4*)((bf16_t*)(F.ws + WS_KIDX) + (size_t)(t0 + tok) * 32 + 8 * q) = *(const u32x4*)(U + (size_t)(t0 + tok) * NINP + UC + 640 + 8 * q); }
    __syncthreads();
    const int mt = F.wave & 3, g = F.lane >> 4, r = F.lane & 15;
#pragma unroll
    for (int q = 0; q < 4; ++q) { const int nt = (F.wave >> 2) * 4 + q;
        f32x4 acc = (f32x4){0.f, 0.f, 0.f, 0.f};
        acc = mma_nt<128>(Ab + mt * 16 * 136, 136, Bt + nt * 16 * 136, 136, acc, F.lane);
        const int n = nt * 16 + r; bf16_t* dst = (bf16_t*)(F.ws + (n < 64 ? WS_K : WS_V));
#pragma unroll
        for (int i = 0; i < 4; ++i) dst[(size_t)(t0 + mt * 16 + 4 * g + i) * 64 + (n & 63)] = f2bf(acc[i]); }
}

constexpr int MB_CG = 0, MB_BG = 18432, MB_BT = 36864, MB_XT = 55296, MB_M = 92160, MB_S0 = 101376, MB_DT = 110592, MB_AC = 111616, MB_RS = 112640;
template <int STAGE> __device__ __forceinline__ void item_mamba(const Frame& F_, int layer, int item) { Frame F = relocal(F_);
    const bf16_t* U = (const bf16_t*)(F.ws + WS_U);
    const int b = item >> 6, c = item & 63, l0 = c * 64; const size_t T0 = (size_t)b * SEQ + l0;
    LAS bf16_t* Cg = (LAS bf16_t*)(F.lds + MB_CG); LAS bf16_t* Bg = (LAS bf16_t*)(F.lds + MB_BG); LAS bf16_t* BT = (LAS bf16_t*)(F.lds + MB_BT);
    LAS bf16_t* XT = (LAS bf16_t*)(F.lds + MB_XT); LAS bf16_t* Mb = (LAS bf16_t*)(F.lds + MB_M); LAS bf16_t* S0 = (LAS bf16_t*)(F.lds + MB_S0);
    LAS float* dts = (LAS float*)(F.lds + MB_DT); LAS float* acs = (LAS float*)(F.lds + MB_AC); LAS float* rs = (LAS float*)(F.lds + MB_RS);
    if (F.tid < 256) { const int l = F.tid >> 2, h = F.tid & 3;
        const float raw = bf2f(U[(T0 + l) * NINP + UM + 768 + h]) + F.in[I_MDTB][layer * 4 + h];
        const float dt = softplusf_(raw); dts[l * 4 + h] = dt; acs[l * 4 + h] = -__expf(F.in[I_MALOG][layer * 4 + h]) * dt; }
    if (F.tid < 64) rs[F.tid] = 0.f;
    __syncthreads();
    float mycum = 0.f;
    if (F.tid < 256) { const int l = F.tid >> 2, h = F.tid & 3; for (int s = 0; s <= l; ++s) mycum += acs[s * 4 + h]; }
    __syncthreads();
    if (F.tid < 256) acs[F.tid] = mycum;
    __syncthreads();
    { const int ch8 = F.tid & 63, tg = F.tid >> 6, c0 = ch8 * 8;
      float wv[4][8], bv[8];
#pragma unroll
      for (int j = 0; j < 8; ++j) { bv[j] = F.in[I_MCONVB][layer * 512 + c0 + j];
#pragma unroll
          for (int k = 0; k < 4; ++k) wv[k][j] = F.in[I_MCONVW][(layer * 4 + k) * 512 + c0 + j]; }
      float win[3][8];
#pragma unroll
      for (int k = 0; k < 3; ++k) { const int l = l0 + tg * 8 - 3 + k;
          if (l >= 0) unpack8(*(const u32x4*)(U + ((size_t)b * SEQ + l) * NINP + UM + 256 + c0), win[k]);
          else {
#pragma unroll
              for (int j = 0; j < 8; ++j) win[k][j] = 0.f; } }
#pragma unroll 1
      for (int i = 0; i < 8; ++i) { const int l = tg * 8 + i; float cur[8]; unpack8(*(const u32x4*)(U + (T0 + l) * NINP + UM + 256 + c0), cur);
          float o[8];
#pragma unroll
          for (int j = 0; j < 8; ++j) { o[j] = siluf_(bv[j] + wv[0][j] * win[0][j] + wv[1][j] * win[1][j] + wv[2][j] * win[2][j] + wv[3][j] * cur[j]);
              win[0][j] = win[1][j]; win[1][j] = win[2][j]; win[2][j] = cur[j]; }
          if (c0 < 256) { const int h = c0 >> 6, p0 = c0 & 63; float sc = dts[l * 4 + h]; if (STAGE == 1) sc *= __expf(acs[63 * 4 + h] - acs[l * 4 + h]);
#pragma unroll
              for (int j = 0; j < 8; ++j) XT[(h * 64 + p0 + j) * 72 + l] = f2bf(o[j] * sc); }
          else if (c0 < 384) { const int g = (c0 - 256) >> 6, n0 = (c0 - 256) & 63;
              if (STAGE == 1) {
#pragma unroll
                  for (int j = 0; j < 8; ++j) BT[(g * 64 + n0 + j) * 72 + l] = f2bf(o[j]); }
              else { u32x4 w; w.x = pk2(o[0], o[1]); w.y = pk2(o[2], o[3]); w.z = pk2(o[4], o[5]); w.w = pk2(o[6], o[7]); *(LAS u32x4*)(Bg + (g * 64 + l) * 72 + n0) = w; } }
          else if (STAGE == 2) { const int g = (c0 - 384) >> 6, n0 = (c0 - 384) & 63;
              u32x4 w; w.x = pk2(o[0], o[1]); w.y = pk2(o[2], o[3]); w.z = pk2(o[4], o[5]); w.w = pk2(o[6], o[7]); *(LAS u32x4*)(Cg + (g * 64 + l) * 72 + n0) = w; } } }
    __syncthreads();
    const int g4 = F.lane >> 4, r16 = F.lane & 15;
    if (STAGE == 1) {
        float* MST = (float*)(F.ws + WS_MST) + ((size_t)(b * 64 + c) * 4) * 4096;
#pragma unroll
        for (int q = 0; q < 8; ++q) { const int tix = F.wave * 8 + q, h = tix >> 4, mt = (tix >> 2) & 3, nt = tix & 3;
            f32x4 acc = (f32x4){0.f, 0.f, 0.f, 0.f};
            acc = mma_nt<64>(XT + (h * 64 + mt * 16) * 72, 72, BT + ((h >> 1) * 64 + nt * 16) * 72, 72, acc, F.lane);
#pragma unroll
            for (int i = 0; i < 4; ++i) MST[(size_t)h * 4096 + (mt * 16 + 4 * g4 + i) * 64 + nt * 16 + r16] = acc[i]; }
        if (F.tid < 4) ((float*)(F.ws + WS_MDEC))[(b * 64 + c) * 4 + F.tid] = __expf(acs[63 * 4 + F.tid]);
    } else {
        const int mt = F.wave & 3, nh = F.wave >> 2;
        const float* MST = (const float*)(F.ws + WS_MST) + ((size_t)(b * 64 + c) * 4) * 4096;
        f32x4 G[2], yv[4][2];
#pragma unroll
        for (int h = 0; h < 4; ++h) {
            const int g = h >> 1;
            { const float* src = MST + (size_t)h * 4096 + F.tid * 8; const f32x4 a = *(const f32x4*)src, bq = *(const f32x4*)(src + 4);
              u32x4 w; w.x = pk2(a[0], a[1]); w.y = pk2(a[2], a[3]); w.z = pk2(bq[0], bq[1]); w.w = pk2(bq[2], bq[3]);
              *(LAS u32x4*)(S0 + (F.tid >> 3) * 72 + (F.tid & 7) * 8) = w; }
            if ((h & 1) == 0) {
#pragma unroll
                for (int q = 0; q < 2; ++q) { G[q] = (f32x4){0.f, 0.f, 0.f, 0.f};
                    G[q] = mma_nt<64>(Cg + (g * 64 + mt * 16) * 72, 72, Bg + (g * 64 + (2 * nh + q) * 16) * 72, 72, G[q], F.lane); } }
#pragma unroll
            for (int q = 0; q < 2; ++q) { const int s = (2 * nh + q) * 16 + r16; const float as = acs[s * 4 + h];
#pragma unroll
                for (int i = 0; i < 4; ++i) { const int l = mt * 16 + 4 * g4 + i; const float v = (s <= l) ? G[q][i] * __expf(acs[l * 4 + h] - as) : 0.f;
                    Mb[l * 72 + s] = f2bf(v); } }
            __syncthreads();
#pragma unroll
            for (int q = 0; q < 2; ++q) { const int nt = 2 * nh + q;
                f32x4 yd = (f32x4){0.f, 0.f, 0.f, 0.f}, yo = (f32x4){0.f, 0.f, 0.f, 0.f};
                yd = mma_nt<64>(Mb + mt * 16 * 72, 72, XT + (h * 64 + nt * 16) * 72, 72, yd, F.lane);
                yo = mma_nt<64>(Cg + (g * 64 + mt * 16) * 72, 72, S0 + nt * 16 * 72, 72, yo, F.lane);
                const int p = nt * 16 + r16; const float dsk = F.in[I_MD][layer * 4 + h];
#pragma unroll
                for (int i = 0; i < 4; ++i) { const int l = mt * 16 + 4 * g4 + i;
                    const float xs = bf2f(XT[(h * 64 + p) * 72 + l]) / dts[l * 4 + h];
                    yv[h][q][i] = yd[i] + yo[i] * __expf(acs[l * 4 + h]) + dsk * xs; } }
            __syncthreads();
        }
        float part[4] = {0.f, 0.f, 0.f, 0.f};
#pragma unroll
        for (int h = 0; h < 4; ++h)
#pragma unroll
            for (int q = 0; q < 2; ++q) { const int ch = h * 64 + (2 * nh + q) * 16 + r16;
#pragma unroll
                for (int i = 0; i < 4; ++i) { const int l = mt * 16 + 4 * g4 + i; const float z = bf2f(U[(T0 + l) * NINP + UM + ch]);
                    const float v = yv[h][q][i] * siluf_(z); yv[h][q][i] = v; part[i] += v * v; } }
#pragma unroll
        for (int i = 0; i < 4; ++i) { const float s = sum16(part[i]); if (r16 == 0) atomicAdd((float*)(rs + mt * 16 + 4 * g4 + i), s); }
        __syncthreads();
        bf16_t* Y = (bf16_t*)(F.ws + WS_H);
#pragma unroll
        for (int i = 0; i < 4; ++i) { const int l = mt * 16 + 4 * g4 + i; const float rstd = rsqrtf(rs[l] * (1.0f / 256.0f) + 1e-6f);
#pragma unroll
            for (int h = 0; h < 4; ++h)
#pragma unroll
                for (int q = 0; q < 2; ++q) { const int ch = h * 64 + (2 * nh + q) * 16 + r16;
                    Y[(T0 + l) * DM + ch] = f2bf(yv[h][q][i] * rstd * F.in[I_MNORM][layer * 256 + ch]); } }
    }
}
__device__ __forceinline__ void item_mamba_carry(const Frame& F_, int item) { Frame F = relocal(F_);
    const int b = item >> 2, h = item & 3;
    float* MST = (float*)(F.ws + WS_MST); const float* MD = (const float*)(F.ws + WS_MDEC);
    float s[8];
#pragma unroll
    for (int j = 0; j < 8; ++j) s[j] = 0.f;
    for (int c = 0; c < 64; ++c) { float* p = MST + ((size_t)(b * 64 + c) * 4 + h) * 4096 + F.tid * 8; const float d = MD[(b * 64 + c) * 4 + h];
        const f32x4 a = *(f32x4*)p, q = *(f32x4*)(p + 4);
        *(f32x4*)p = (f32x4){s[0], s[1], s[2], s[3]}; *(f32x4*)(p + 4) = (f32x4){s[4], s[5], s[6], s[7]};
        s[0] = s[0] * d + a[0]; s[1] = s[1] * d + a[1]; s[2] = s[2] * d + a[2]; s[3] = s[3] * d + a[3];
        s[4] = s[4] * d + q[0]; s[5] = s[5] * d + q[1]; s[6] = s[6] * d + q[2]; s[7] = s[7] * d + q[3]; }
}

template <int STAGE> __device__ __forceinline__ void item_s5(const Frame& F_, int layer, int item) { Frame F = relocal(F_);
    const bf16_t* U = (const bf16_t*)(F.ws + WS_U);
    const int b = item >> 6, c = item & 63; const size_t T0 = (size_t)b * SEQ + c * 64;
    LAS float* us = (LAS float*)F.lds; LAS bf16_t* Hs = (LAS bf16_t*)(F.lds + 65536);
    const float* tab = (const float*)(F.ws + WS_S5TAB + (size_t)layer * S5TAB_L);
    { const int tok = F.tid >> 3, part = F.tid & 7;
#pragma unroll
      for (int q = 0; q < 4; ++q) { float f[8]; unpack8(*(const u32x4*)(U + (T0 + tok) * NINP + US + 32 * part + 8 * q), f);
          *(LAS f32x4*)(us + tok * 256 + 32 * part + 8 * q) = (f32x4){f[0], f[1], f[2], f[3]}; *(LAS f32x4*)(us + tok * 256 + 32 * part + 8 * q + 4) = (f32x4){f[4], f[5], f[6], f[7]}; } }
    const int g = F.tid >> 5, n0 = F.tid & 31, gn0 = g * 64 + n0, gn1 = gn0 + 32;
    float bb0[32], bb1[32];
#pragma unroll
    for (int j = 0; j < 32; j += 4) { const f32x4 a = *(const f32x4*)(tab + 4096 + gn0 * 32 + j), bq = *(const f32x4*)(tab + 4096 + gn1 * 32 + j);
        bb0[j] = a[0]; bb0[j + 1] = a[1]; bb0[j + 2] = a[2]; bb0[j + 3] = a[3]; bb1[j] = bq[0]; bb1[j + 1] = bq[1]; bb1[j + 2] = bq[2]; bb1[j + 3] = bq[3]; }
    const float a0r = tab[gn0 * 2], a0i = tab[gn0 * 2 + 1], a1r = tab[gn1 * 2], a1i = tab[gn1 * 2 + 1];
    float* ST = (float*)(F.ws + WS_S5ST) + (size_t)(b * 64 + c) * 2048;
    float h0r = 0.f, h0i = 0.f, h1r = 0.f, h1i = 0.f;
    if (STAGE == 2) { h0r = ST[gn0 * 2]; h0i = ST[gn0 * 2 + 1]; h1r = ST[gn1 * 2]; h1i = ST[gn1 * 2 + 1]; }
    bf16x8 cf[2][4];
    if (STAGE == 2) { const bf16_t* cm = (const bf16_t*)(F.ws + WS_S5TAB + (size_t)layer * S5TAB_L + S5TAB_F);
#pragma unroll
        for (int gg = 0; gg < 2; ++gg)
#pragma unroll
            for (int ks = 0; ks < 4; ++ks) cf[gg][ks] = *(const bf16x8*)(cm + ((size_t)((2 * F.wave + gg) * 16 + (F.lane & 15))) * 128 + 32 * ks + 8 * (F.lane >> 4)); }
    __syncthreads();
    for (int lb = 0; lb < 4; ++lb) {
        for (int li = 0; li < 16; ++li) { const int l = lb * 16 + li;
            float uu[16];
#pragma unroll
            for (int q = 0; q < 4; ++q) { const f32x4 v = *(const LAS f32x4*)(us + l * 256 + g * 16 + 4 * q); uu[4 * q] = v[0]; uu[4 * q + 1] = v[1]; uu[4 * q + 2] = v[2]; uu[4 * q + 3] = v[3]; }
            float b0r = 0.f, b0i = 0.f, b1r = 0.f, b1i = 0.f;
#pragma unroll
            for (int p = 0; p < 16; ++p) { b0r += bb0[2 * p] * uu[p]; b0i += bb0[2 * p + 1] * uu[p]; b1r += bb1[2 * p] * uu[p]; b1i += bb1[2 * p + 1] * uu[p]; }
            { const float nr = a0r * h0r - a0i * h0i + b0r, ni = a0r * h0i + a0i * h0r + b0i; h0r = nr; h0i = ni; }
            { const float nr = a1r * h1r - a1i * h1i + b1r, ni = a1r * h1i + a1i * h1r + b1i; h1r = nr; h1i = ni; }
            if (STAGE == 2) { LAS bf16_t* hp = Hs + li * 2056 + g * 128; hp[n0] = f2bf(h0r); hp[64 + n0] = f2bf(h0i); hp[n0 + 32] = f2bf(h1r); hp[96 + n0] = f2bf(h1i); }
        }
        if (STAGE == 2) {
            __syncthreads();
            bf16_t* YS = (bf16_t*)(F.ws + WS_MOE + YSG_OFF);
#pragma unroll
            for (int gg = 0; gg < 2; ++gg) { const int gq = 2 * F.wave + gg; f32x4 acc = (f32x4){0.f, 0.f, 0.f, 0.f};
#pragma unroll
                for (int ks = 0; ks < 4; ++ks) { const bf16x8 a = *(const LAS bf16x8*)(Hs + (F.lane & 15) * 2056 + gq * 128 + 32 * ks + 8 * (F.lane >> 4));
                    acc = __builtin_amdgcn_mfma_f32_16x16x32_bf16(a, cf[gg][ks], acc, 0, 0, 0); }
                const int ch = gq * 16 + (F.lane & 15); const float dsk = F.in[I_SD][layer * 256 + ch];
#pragma unroll
                for (int i = 0; i < 4; ++i) { const int l = lb * 16 + 4 * (F.lane >> 4) + i; const float y = acc[i] + dsk * us[l * 256 + ch];
                    YS[(T0 + l) * 256 + ch] = f2bf(gelu_tanh(y)); } }
            __syncthreads();
        }
    }
    if (STAGE == 1) { ST[gn0 * 2] = h0r; ST[gn0 * 2 + 1] = h0i; ST[gn1 * 2] = h1r; ST[gn1 * 2 + 1] = h1i; }
}
__device__ __forceinline__ void item_s5_carry(const Frame& F_, int layer, int b) { Frame F = relocal(F_);
    const float* tab = (const float*)(F.ws + WS_S5TAB + (size_t)layer * S5TAB_L) + 2048;
    float* ST = (float*)(F.ws + WS_S5ST) + (size_t)b * 64 * 2048;
#pragma unroll
    for (int q = 0; q < 2; ++q) { const int gn = F.tid + 512 * q; const float pr = tab[gn * 2], pi = tab[gn * 2 + 1]; float hr = 0.f, hi = 0.f;
        for (int c = 0; c < 64; ++c) { float* p = ST + (size_t)c * 2048 + gn * 2; const float tr = p[0], ti = p[1]; p[0] = hr; p[1] = hi;
            const float nr = pr * hr - pi * hi + tr, ni = pr * hi + pi * hr + ti; hr = nr; hi = ni; } }
}

constexpr int RB_LD = 72;
constexpr int RW_R = 0, RW_K = 16384, RW_V = 32768, RW_W = 49152, RW_A = 65536, RW_B = 81920;
constexpr int R3_G = 49152, R3_O = 65536, R3_TILES = 81920, R3_BON = 147456;
template <int STAGE> __device__ __forceinline__ void rwkv_prep(const Frame& F_, int layer, int b, int h, int c) { Frame F = relocal(F_);
    const bf16_t* U = (const bf16_t*)(F.ws + WS_U);
    const int l0 = c * 64; const size_t T0 = (size_t)b * SEQ + l0;
    LAS float* Rr = (LAS float*)(F.lds + RW_R); LAS float* Kk = (LAS float*)(F.lds + RW_K); LAS float* Vv = (LAS float*)(F.lds + RW_V); LAS float* Ww = (LAS float*)(F.lds + RW_W);
    LAS float* Aa = (LAS float*)(F.lds + (STAGE == 1 ? RW_A : R3_O)); LAS float* Bb = (LAS float*)(F.lds + RW_B); LAS float* Gg = (LAS float*)(F.lds + R3_G); LAS float* BON = (LAS float*)(F.lds + R3_BON);
    LAS bf16_t* TWb = (LAS bf16_t*)(F.lds + 98304); LAS bf16_t* DAb = (LAS bf16_t*)(F.lds + (STAGE == 1 ? 103424 : 118784)); LAS bf16_t* SGb = (LAS bf16_t*)(F.lds + 123904);
    LAS bf16_t* w2T = (LAS bf16_t*)(F.lds + 108544); LAS bf16_t* a2T = (LAS bf16_t*)(F.lds + (STAGE == 1 ? 113664 : 133120)); LAS bf16_t* g2T = (LAS bf16_t*)(F.lds + 138240);
    const float* mu = F.in[I_RMU] + layer * 896;
    { const int tok = F.tid >> 3, p8 = F.tid & 7; const bool first = (l0 + tok == 0);
      const bf16_t* cur = U + (T0 + tok) * NINP + UR; const bf16_t* prv = cur - NINP;
#pragma unroll
      for (int sec = 0; sec < 3; ++sec) { const int co = sec * 256 + h * 64 + 8 * p8; float av[8], pq[8]; unpack8(*(const u32x4*)(cur + co), av);
          if (first) {
#pragma unroll
              for (int j = 0; j < 8; ++j) pq[j] = 0.f; } else unpack8(*(const u32x4*)(prv + co), pq);
          const f32x4 m0 = *(const f32x4*)(mu + co), m1 = *(const f32x4*)(mu + co + 4);
          LAS float* dst = (sec == 0 ? Rr : sec == 1 ? Kk : Vv) + tok * 64 + 8 * p8;
          *(LAS f32x4*)dst = (f32x4){av[0] + m0[0] * (pq[0] - av[0]), av[1] + m0[1] * (pq[1] - av[1]), av[2] + m0[2] * (pq[2] - av[2]), av[3] + m0[3] * (pq[3] - av[3])};
          *(LAS f32x4*)(dst + 4) = (f32x4){av[4] + m1[0] * (pq[4] - av[4]), av[5] + m1[1] * (pq[5] - av[5]), av[6] + m1[2] * (pq[6] - av[6]), av[7] + m1[3] * (pq[7] - av[7])}; }
      { const int co = 768 + (STAGE == 1 ? 0 : 32) + 4 * p8;
        const u32x2 cv = *(const u32x2*)(cur + co); u32x2 pv = (u32x2){0u, 0u}; if (!first) pv = *(const u32x2*)(prv + co);
        const f32x4 m0 = *(const f32x4*)(mu + co);
        float x[4] = {__uint_as_float(cv.x << 16), __uint_as_float(cv.x & 0xffff0000u), __uint_as_float(cv.y << 16), __uint_as_float(cv.y & 0xffff0000u)};
        const float y[4] = {__uint_as_float(pv.x << 16), __uint_as_float(pv.x & 0xffff0000u), __uint_as_float(pv.y << 16), __uint_as_float(pv.y & 0xffff0000u)};
#pragma unroll
        for (int j = 0; j < 4; ++j) { x[j] = x[j] + m0[j] * (y[j] - x[j]); if (STAGE == 1) x[j] = tanhf_(x[j]); }
        *(LAS u32x2*)((STAGE == 1 ? TWb : DAb) + tok * 40 + 4 * p8) = (u32x2){pk2(x[0], x[1]), pk2(x[2], x[3])}; }
      if (STAGE == 1) { const int co = 800 + 4 * p8;
        const u32x2 cv = *(const u32x2*)(cur + co); u32x2 pv = (u32x2){0u, 0u}; if (!first) pv = *(const u32x2*)(prv + co);
        const f32x4 m0 = *(const f32x4*)(mu + co);
        float x[4] = {__uint_as_float(cv.x << 16), __uint_as_float(cv.x & 0xffff0000u), __uint_as_float(cv.y << 16), __uint_as_float(cv.y & 0xffff0000u)};
        const float y[4] = {__uint_as_float(pv.x << 16), __uint_as_float(pv.x & 0xffff0000u), __uint_as_float(pv.y << 16), __uint_as_float(pv.y & 0xffff0000u)};
#pragma unroll
        for (int j = 0; j < 4; ++j) x[j] = x[j] + m0[j] * (y[j] - x[j]);
        *(LAS u32x2*)(DAb + tok * 40 + 4 * p8) = (u32x2){pk2(x[0], x[1]), pk2(x[2], x[3])}; }
      if (STAGE == 3) { const int co = 832 + 8 * p8; float av[8], pq[8]; unpack8(*(const u32x4*)(cur + co), av);
          if (first) {
#pragma unroll
              for (int j = 0; j < 8; ++j) pq[j] = 0.f; } else unpack8(*(const u32x4*)(prv + co), pq);
          const f32x4 m0 = *(const f32x4*)(mu + co), m1 = *(const f32x4*)(mu + co + 4); float x[8];
#pragma unroll
          for (int j = 0; j < 8; ++j) x[j] = sigmoidf_(av[j] + (j < 4 ? m0[j] : m1[j - 4]) * (pq[j] - av[j]));
          *(LAS u32x4*)(SGb + tok * RB_LD + 8 * p8) = (u32x4){pk2(x[0], x[1]), pk2(x[2], x[3]), pk2(x[4], x[5]), pk2(x[6], x[7])}; } }
    { const int ch = F.tid & 63, part = F.tid >> 6;
      if (STAGE == 1) { const float* w2 = F.in[I_RW2] + ((size_t)layer * 32 + 4 * part) * 256 + h * 64 + ch;
          *(LAS u32x2*)(w2T + ch * 40 + 4 * part) = (u32x2){pk2(w2[0], w2[256]), pk2(w2[512], w2[768])}; }
      { const float* a2 = F.in[I_RA2] + ((size_t)layer * 32 + 4 * part) * 256 + h * 64 + ch;
          *(LAS u32x2*)(a2T + ch * 40 + 4 * part) = (u32x2){pk2(a2[0], a2[256]), pk2(a2[512], a2[768])}; }
      if (STAGE == 3) { const float* g2 = F.in[I_RG2] + ((size_t)layer * 64 + 8 * part) * 256 + h * 64 + ch;
          *(LAS u32x4*)(g2T + ch * RB_LD + 8 * part) = (u32x4){pk2(g2[0], g2[256]), pk2(g2[512], g2[768]), pk2(g2[1024], g2[1280]), pk2(g2[1536], g2[1792])}; } }
    __syncthreads();
    { const int lane = F.lane, mt = F.wave >> 1, nt0 = 2 * (F.wave & 1), r = lane & 15, g4 = lane >> 4; const f32x4 zero4 = (f32x4){0.f, 0.f, 0.f, 0.f};
#pragma unroll
      for (int q = 0; q < 2; ++q) { const int nt = nt0 + q, ch = 16 * nt + r, cg = layer * 256 + h * 64 + ch;
          if (STAGE == 1) { const f32x4 wl = mma_nt<32>(TWb + 16 * mt * 40, 40, w2T + 16 * nt * 40, 40, zero4, lane); const float w0 = F.in[I_RW0][cg];
#pragma unroll
              for (int i = 0; i < 4; ++i) { const float x = w0 + wl[i]; const float wlog = -__logf(1.0f + __expf(-x)) - 0.5f; Ww[(16 * mt + 4 * g4 + i) * 64 + ch] = __expf(-__expf(wlog)); } }
          { const f32x4 al = mma_nt<32>(DAb + 16 * mt * 40, 40, a2T + 16 * nt * 40, 40, zero4, lane); const float a0 = F.in[I_RA0][cg];
#pragma unroll
              for (int i = 0; i < 4; ++i) Aa[(16 * mt + 4 * g4 + i) * 64 + ch] = sigmoidf_(a0 + al[i]); }
          if (STAGE == 3) { const f32x4 gv = mma_nt<64>(SGb + 16 * mt * RB_LD, RB_LD, g2T + 16 * nt * RB_LD, RB_LD, zero4, lane);
#pragma unroll
              for (int i = 0; i < 4; ++i) Gg[(16 * mt + 4 * g4 + i) * 64 + ch] = gv[i]; } } }
    __syncthreads();
    { const int j = F.lane, tq = F.wave, cg = layer * 256 + h * 64 + j;
      const float kkw = F.in[I_RKK][cg], kaw = F.in[I_RKA][cg], rk = F.in[I_RRK][cg];
#pragma unroll 2
      for (int i8 = 0; i8 < 8; ++i8) { const int t = tq + 8 * i8;
          const float a = Aa[t * 64 + j]; const float kraw = Kk[t * 64 + j]; const float kp = kraw * (1.0f + (a - 1.0f) * kaw);
          Kk[t * 64 + j] = kp;
          if (STAGE == 1) { const float kkv = kraw * kkw; const float ss = wave_sum(kkv * kkv); const float kkn = kkv * rsqrtf(fmaxf(ss, 1e-24f)); Aa[t * 64 + j] = -kkn; Bb[t * 64 + j] = kkn * a; }
          if (STAGE == 3) { const float bo = wave_sum(Rr[t * 64 + j] * kp * rk); if (j == 0) BON[t] = bo; } } }
    __syncthreads();
}
constexpr int RB_AT = 98304, RB_ATT = RB_AT + 9216, RB_BT = RB_ATT + 9216, RB_BTT = RB_BT + 9216, RB_KT = RB_BTT + 9216, RB_RT = RB_KT + 9216, RB_VT = RB_RT + 9216, RB_GC = RB_VT + 9216;
constexpr int RX_X = 0, RX_XT = 9216, RX_TB = 18432, RX_M = 27648, RX_NRT = 36864, RX_G1T = 46080, RX_G2T = 55296, RX_QT = 64512;
__device__ __forceinline__ void st_tile(LAS bf16_t* dst, int mt, int nt, const f32x4 v, int lane) {
    const int r = lane & 15, g = lane >> 4;
#pragma unroll
    for (int i = 0; i < 4; ++i) dst[(16 * mt + 4 * g + i) * RB_LD + 16 * nt + r] = f2bf(v[i]);
}
__device__ __forceinline__ void st_tile_t(LAS bf16_t* dst, int mt, int nt, const f32x4 v, int lane) {
    const int r = lane & 15, g = lane >> 4; u32x2 w; w.x = pk2(v[0], v[1]); w.y = pk2(v[2], v[3]);
    *(LAS u32x2*)(dst + (16 * nt + r) * RB_LD + 16 * mt + 4 * g) = w;
}
__device__ __forceinline__ void item_rwkv1(const Frame& F_, int layer, int item) { Frame F = relocal(F_);
    const int b = item >> 8, h = (item >> 6) & 3, c = item & 63;
    rwkv_prep<1>(F, layer, b, h, c);
    LAS float* Rr = (LAS float*)(F.lds + RW_R); LAS float* Kk = (LAS float*)(F.lds + RW_K); LAS float* Vv = (LAS float*)(F.lds + RW_V); LAS float* Ww = (LAS float*)(F.lds + RW_W);
    LAS float* Aa = (LAS float*)(F.lds + RW_A); LAS float* Bb = (LAS float*)(F.lds + RW_B);
    LAS bf16_t* At = (LAS bf16_t*)(F.lds + RB_AT); LAS bf16_t* AtT = (LAS bf16_t*)(F.lds + RB_ATT); LAS bf16_t* Bt = (LAS bf16_t*)(F.lds + RB_BT); LAS bf16_t* BtT = (LAS bf16_t*)(F.lds + RB_BTT);
    LAS bf16_t* Kt = (LAS bf16_t*)(F.lds + RB_KT); LAS bf16_t* Rt = (LAS bf16_t*)(F.lds + RB_RT); LAS bf16_t* VT = (LAS bf16_t*)(F.lds + RB_VT); LAS float* gC = (LAS float*)(F.lds + RB_GC);
    LAS bf16_t* X = (LAS bf16_t*)(F.lds + RX_X); LAS bf16_t* XT = (LAS bf16_t*)(F.lds + RX_XT); LAS bf16_t* Tb = (LAS bf16_t*)(F.lds + RX_TB); LAS bf16_t* Mm = (LAS bf16_t*)(F.lds + RX_M);
    LAS bf16_t* NrT = (LAS bf16_t*)(F.lds + RX_NRT); LAS bf16_t* G1T = (LAS bf16_t*)(F.lds + RX_G1T); LAS bf16_t* G2T = (LAS bf16_t*)(F.lds + RX_G2T); LAS bf16_t* QT = (LAS bf16_t*)(F.lds + RX_QT);
    { const int k = F.tid & 63, part = F.tid >> 6; float g = 1.0f;
      for (int t = 0; t < 8 * part; ++t) g *= Ww[t * 64 + k];
#pragma unroll
      for (int i = 0; i < 8; ++i) { const int t = 8 * part + i; const float gp = g; g *= Ww[t * 64 + k]; const float ig = 1.0f / g;
          const bf16_t av = f2bf(Aa[t * 64 + k] * gp), bv = f2bf(Bb[t * 64 + k] * ig);
          At[t * RB_LD + k] = av; AtT[k * RB_LD + t] = av; Bt[t * RB_LD + k] = bv; BtT[k * RB_LD + t] = bv;
          Kt[t * RB_LD + k] = f2bf(Kk[t * 64 + k] * ig); Rt[t * RB_LD + k] = f2bf(Rr[t * 64 + k] * g); VT[k * RB_LD + t] = f2bf(Vv[t * 64 + k]); }
      if (part == 7) gC[k] = g; }
    __syncthreads();
    const int lane = F.lane, mt = F.wave >> 1, nt0 = 2 * (F.wave & 1), r = lane & 15, g4 = lane >> 4;
    const f32x4 zero4 = (f32x4){0.f, 0.f, 0.f, 0.f};
    f32x4 Tacc[2];
#pragma unroll
    for (int q = 0; q < 2; ++q) { const int nt = nt0 + q;
        f32x4 n = mma_nt<64>(Bt + 16 * mt * RB_LD, RB_LD, At + 16 * nt * RB_LD, RB_LD, zero4, lane);
        f32x4 m = mma_nt<64>(Kt + 16 * mt * RB_LD, RB_LD, At + 16 * nt * RB_LD, RB_LD, zero4, lane);
        f32x4 nr = mma_nt<64>(Rt + 16 * mt * RB_LD, RB_LD, Bt + 16 * nt * RB_LD, RB_LD, zero4, lane);
#pragma unroll
        for (int i = 0; i < 4; ++i) { const int row = 16 * mt + 4 * g4 + i, col = 16 * nt + r;
            n[i] = (row < col) ? n[i] : 0.f; m[i] = (row < col) ? m[i] : 0.f; nr[i] = (col <= row) ? nr[i] : 0.f;
            Tacc[q][i] = n[i] + (row == col ? 1.0f : 0.f); }
        st_tile(X, mt, nt, n, lane); st_tile_t(XT, mt, nt, n, lane); st_tile(Tb, mt, nt, Tacc[q], lane); st_tile(Mm, mt, nt, m, lane); st_tile(NrT, mt, nt, nr, lane); }
    __syncthreads();
#pragma unroll 1
    for (int it = 0; it < 6; ++it) {
        f32x4 x2[2];
#pragma unroll
        for (int q = 0; q < 2; ++q) { const int nt = nt0 + q;
            if (it > 0) Tacc[q] = mma_nt<64>(Tb + 16 * mt * RB_LD, RB_LD, XT + 16 * nt * RB_LD, RB_LD, Tacc[q], lane);
            x2[q] = zero4; if (it < 5) x2[q] = mma_nt<64>(X + 16 * mt * RB_LD, RB_LD, XT + 16 * nt * RB_LD, RB_LD, zero4, lane); }
        __syncthreads();
#pragma unroll
        for (int q = 0; q < 2; ++q) { const int nt = nt0 + q;
            if (it > 0) st_tile(Tb, mt, nt, Tacc[q], lane);
            if (it < 5) { st_tile(X, mt, nt, x2[q], lane); st_tile_t(XT, mt, nt, x2[q], lane); } }
        __syncthreads();
    }
#pragma unroll
    for (int q = 0; q < 2; ++q) { const int nt = nt0 + q;
        st_tile(G1T, mt, nt, mma_nt<64>(NrT + 16 * mt * RB_LD, RB_LD, Tb + 16 * nt * RB_LD, RB_LD, zero4, lane), lane);
        st_tile(G2T, mt, nt, mma_nt<64>(BtT + 16 * mt * RB_LD, RB_LD, Tb + 16 * nt * RB_LD, RB_LD, zero4, lane), lane); }
    __syncthreads();
    const size_t ci = (size_t)(b * 4 + h) * 64 + c;
    bf16_t* gPT = (bf16_t*)(F.ws + WS_MOE + RW_PT) + ci * 4096; bf16_t* gW1 = (bf16_t*)(F.ws + WS_MOE + RW_W1) + ci * 4096; bf16_t* gZ = (bf16_t*)(F.ws + WS_MOE + RW_Z) + ci * 4096;
#pragma unroll
    for (int q = 0; q < 2; ++q) { const int nt = nt0 + q; const int col = 16 * nt + r;
        f32x4 w1 = mma_nt<64>(G1T + 16 * mt * RB_LD, RB_LD, AtT + 16 * nt * RB_LD, RB_LD, zero4, lane);
        f32x4 z = mma_nt<64>(G1T + 16 * mt * RB_LD, RB_LD, Mm + 16 * nt * RB_LD, RB_LD, zero4, lane);
        f32x4 mr = mma_nt<64>(Rt + 16 * mt * RB_LD, RB_LD, Kt + 16 * nt * RB_LD, RB_LD, zero4, lane);
        f32x4 p = mma_nt<64>(G2T + 16 * mt * RB_LD, RB_LD, AtT + 16 * nt * RB_LD, RB_LD, zero4, lane);
        f32x4 qq = mma_nt<64>(G2T + 16 * mt * RB_LD, RB_LD, Mm + 16 * nt * RB_LD, RB_LD, zero4, lane);
        const int pos = 32 * (col >> 5) + 8 * ((col >> 2) & 3) + 4 * ((col >> 4) & 1) + (col & 3);
#pragma unroll
        for (int i = 0; i < 4; ++i) { const int row = 16 * mt + 4 * g4 + i;
            gW1[row * 64 + col] = f2bf(w1[i] + bf2f(Rt[row * RB_LD + col]));
            gZ[row * 64 + col] = f2bf(z[i] + (col <= row ? mr[i] : 0.f));
            const float gc = gC[row];
            gPT[row * 64 + pos] = f2bf((p[i] + (row == col ? 1.0f : 0.f)) * gc);
            qq[i] = (qq[i] + bf2f(Kt[col * RB_LD + row])) * gc; }
        st_tile(QT, mt, nt, qq, lane); }
    __syncthreads();
    bf16_t* gU = (bf16_t*)(F.ws + WS_MOE + RW_U) + ci * 4096;
#pragma unroll
    for (int q = 0; q < 2; ++q) { const int nt = nt0 + q;
        const f32x4 u = mma_nt<64>(VT + 16 * mt * RB_LD, RB_LD, QT + 16 * nt * RB_LD, RB_LD, zero4, lane);
#pragma unroll
        for (int i = 0; i < 4; ++i) gU[(16 * mt + 4 * g4 + i) * 64 + 16 * nt + r] = f2bf(u[i]); }
}
__device__ __forceinline__ void item_rwkv_carry(const Frame& F_, int item) { Frame F = relocal(F_);
    const int bh = item * 2 + (F.wave >> 2), nt = F.wave & 3, r = F.lane & 15, g = F.lane >> 4;
    const bf16_t* PT = (const bf16_t*)(F.ws + WS_MOE + RW_PT); const bf16_t* Uc = (const bf16_t*)(F.ws + WS_MOE + RW_U); bf16_t* Ss = (bf16_t*)(F.ws + WS_MOE + RW_S);
    f32x4 acc[4];
#pragma unroll
    for (int m = 0; m < 4; ++m) acc[m] = (f32x4){0.f, 0.f, 0.f, 0.f};
    for (int c = 0; c < 64; ++c) { const size_t ci = (size_t)bh * 64 + c;
        bf16x8 af[4][2]; f32x4 cin[4];
#pragma unroll
        for (int m = 0; m < 4; ++m) { const u32x2 uv = *(const u32x2*)(Uc + ci * 4096 + (16 * nt + r) * 64 + 16 * m + 4 * g);
            cin[m] = (f32x4){__uint_as_float(uv.x << 16), __uint_as_float(uv.x & 0xffff0000u), __uint_as_float(uv.y << 16), __uint_as_float(uv.y & 0xffff0000u)};
#pragma unroll
            for (int s = 0; s < 2; ++s) af[m][s] = *(const bf16x8*)(PT + ci * 4096 + (16 * m + r) * 64 + 32 * s + 8 * g); }
        unsigned pw[4][2];
#pragma unroll
        for (int m = 0; m < 4; ++m) { pw[m][0] = pk2(acc[m][0], acc[m][1]); pw[m][1] = pk2(acc[m][2], acc[m][3]);
            *(u32x2*)(Ss + ci * 4096 + (16 * nt + r) * 64 + 16 * m + 4 * g) = (u32x2){pw[m][0], pw[m][1]}; }
        bf16x8 bfr[2];
#pragma unroll
        for (int s = 0; s < 2; ++s) bfr[s] = __builtin_bit_cast(bf16x8, (u32x4){pw[2 * s][0], pw[2 * s][1], pw[2 * s + 1][0], pw[2 * s + 1][1]});
#pragma unroll
        for (int m = 0; m < 4; ++m) { acc[m] = __builtin_amdgcn_mfma_f32_16x16x32_bf16(af[m][0], bfr[0], cin[m], 0, 0, 0);
            acc[m] = __builtin_amdgcn_mfma_f32_16x16x32_bf16(af[m][1], bfr[1], acc[m], 0, 0, 0); }
    }
}
__device__ __forceinline__ void item_rwkv3(const Frame& F_, int layer, int item) { Frame F = relocal(F_);
    const int b = item >> 8, h = (item >> 6) & 3, c = item & 63; const size_t T0 = (size_t)b * SEQ + c * 64;
    rwkv_prep<3>(F, layer, b, h, c);
#ifdef PROBE_PREP
    rwkv_prep<3>(F, layer, b, h, c);
#endif
    LAS float* Vv = (LAS float*)(F.lds + RW_V); LAS float* Oo = (LAS float*)(F.lds + R3_O);
    LAS float* Gg = (LAS float*)(F.lds + R3_G); LAS float* BON = (LAS float*)(F.lds + R3_BON);
    LAS bf16_t* S0b = (LAS bf16_t*)(F.lds + R3_TILES); LAS bf16_t* W1b = S0b + 4608; LAS bf16_t* Zb = W1b + 4608; LAS bf16_t* VTb = Zb + 4608;
    { const size_t ci = (size_t)(b * 4 + h) * 64 + c; const int row = F.tid >> 3, col = (F.tid & 7) * 8;
      *(LAS u32x4*)(S0b + row * RB_LD + col) = *(const u32x4*)((const bf16_t*)(F.ws + WS_MOE + RW_S) + ci * 4096 + F.tid * 8);
      *(LAS u32x4*)(W1b + row * RB_LD + col) = *(const u32x4*)((const bf16_t*)(F.ws + WS_MOE + RW_W1) + ci * 4096 + F.tid * 8);
      *(LAS u32x4*)(Zb + row * RB_LD + col) = *(const u32x4*)((const bf16_t*)(F.ws + WS_MOE + RW_Z) + ci * 4096 + F.tid * 8);
      const int vv = F.tid & 63, part = F.tid >> 6;
#pragma unroll
      for (int i = 0; i < 8; ++i) { const int t = 8 * part + i; VTb[vv * RB_LD + t] = f2bf(Vv[t * 64 + vv]); } }
    __syncthreads();
    { const int lane = F.lane, mt = F.wave >> 1, nt0 = 2 * (F.wave & 1), r = lane & 15, g4 = lane >> 4;
#pragma unroll
      for (int q = 0; q < 2; ++q) { const int nt = nt0 + q;
          f32x4 o = mma_nt<64>(W1b + 16 * mt * RB_LD, RB_LD, S0b + 16 * nt * RB_LD, RB_LD, (f32x4){0.f, 0.f, 0.f, 0.f}, lane);
          o = mma_nt<64>(Zb + 16 * mt * RB_LD, RB_LD, VTb + 16 * nt * RB_LD, RB_LD, o, lane);
#pragma unroll
          for (int i = 0; i < 4; ++i) Oo[(16 * mt + 4 * g4 + i) * 64 + 16 * nt + r] = o[i]; } }
    __syncthreads();
    { const int j = F.lane, tq = F.wave, ch = h * 64 + j;
      const float lw = F.in[I_RLNW][layer * 256 + ch], lb = F.in[I_RLNB][layer * 256 + ch];
      bf16_t* Y = (bf16_t*)(F.ws + WS_H);
#pragma unroll 2
      for (int i8 = 0; i8 < 8; ++i8) { const int t = tq + 8 * i8;
          const float o = Oo[t * 64 + j]; const float mean = wave_sum(o) * (1.0f / 64.0f); const float d = o - mean; const float var = wave_sum(d * d) * (1.0f / 64.0f);
          float on = d * rsqrtf(var + 64e-5f) * lw + lb; on += BON[t] * Vv[t * 64 + j];
          Y[(T0 + t) * DM + 256 + ch] = f2bf(on * Gg[t * 64 + j]); } }
}

constexpr int DS_SEL = 131072, DS_HIST = 135168, DS_BKT = 151552, DS_BIAS = 152064;
__device__ __forceinline__ unsigned fkey(float f) { const unsigned u = __float_as_uint(f); return (u & 0x80000000u) ? ~u : (u | 0x80000000u); }
__device__ __forceinline__ void item_dsa(const Frame& F_, int layer, int item) { Frame F = relocal(F_);
    const bf16_t* U = (const bf16_t*)(F.ws + WS_U); const bf16_t* KI = (const bf16_t*)(F.ws + WS_KIDX);
    const bf16_t* Kb = (const bf16_t*)(F.ws + WS_K); const bf16_t* Vb = (const bf16_t*)(F.ws + WS_V);
    const int b = item & 3, qg = 511 - (item >> 2); const size_t TB = (size_t)b * SEQ, T0 = TB + qg * 8;
    LAS float* sc = (LAS float*)F.lds; LAS unsigned short* selall = (LAS unsigned short*)(F.lds + DS_SEL); LAS unsigned* histall = (LAS unsigned*)(F.lds + DS_HIST);
    LAS int* bkt = (LAS int*)(F.lds + DS_BKT); LAS float* biasT = (LAS float*)(F.lds + DS_BIAS);
    if (F.tid < 128) { const int n = F.tid; int bk = n; if (n >= 16) { const float lr = logf((float)n / 16.0f) / 2.0794415416798357f; bk = 16 + (int)(lr * 16.0f); bk = bk < 31 ? bk : 31; } bkt[n] = bk; biasT[n] = F.in[I_RELB][n]; }
    const int lane = F.lane, hh = lane >> 5;
    {
        bf16x8 af[2][2]; float wq[2][2][8];
        { const int r = lane & 31, q4 = 2 * ((r >> 2) & 1) + (r >> 4), head = 4 * ((r >> 3) & 1) + (r & 3);
#pragma unroll
          for (int mt = 0; mt < 2; ++mt)
#pragma unroll
              for (int ks = 0; ks < 2; ++ks) af[mt][ks] = *(const bf16x8*)(U + (T0 + 4 * mt + q4) * NINP + UC + 384 + head * 32 + 16 * ks + 8 * hh); }
#pragma unroll
        for (int mt = 0; mt < 2; ++mt)
#pragma unroll
            for (int q2 = 0; q2 < 2; ++q2) { float f[8]; unpack8(*(const u32x4*)(U + (T0 + 4 * mt + 2 * hh + q2) * NINP + UC + 672), f);
#pragma unroll
                for (int hd = 0; hd < 8; ++hd) wq[mt][q2][hd] = f[hd]; }
        const int ntile = (qg * 8 + 8 + 31) >> 5;
        for (int kt = F.wave; kt < ntile; kt += 8) {
            const int key = kt * 32 + (lane & 31);
            const bf16x8 b0 = *(const bf16x8*)(KI + (TB + key) * 32 + 8 * hh), b1 = *(const bf16x8*)(KI + (TB + key) * 32 + 16 + 8 * hh);
#pragma unroll
            for (int mt = 0; mt < 2; ++mt) { f32x16 acc;
#pragma unroll
                for (int i = 0; i < 16; ++i) acc[i] = 0.f;
                acc = __builtin_amdgcn_mfma_f32_32x32x16_bf16(af[mt][0], b0, acc, 0, 0, 0);
                acc = __builtin_amdgcn_mfma_f32_32x32x16_bf16(af[mt][1], b1, acc, 0, 0, 0);
#pragma unroll
                for (int q2 = 0; q2 < 2; ++q2) { float s = 0.f;
#pragma unroll
                    for (int hd = 0; hd < 8; ++hd) s += fmaxf(acc[8 * q2 + hd], 0.f) * wq[mt][q2][hd];
                    const int qi = 4 * mt + 2 * hh + q2;
                    sc[qi * 4096 + key] = (key <= qg * 8 + qi) ? s : -INFINITY; } }
        }
    }
    __syncthreads();
    const int qi = F.wave, tq = qg * 8 + qi, n = tq + 1;
    LAS float* scq = sc + qi * 4096; LAS unsigned short* sel = selall + qi * 256; LAS unsigned* hist = histall + qi * 512;
    int nsel;
    if (n <= 256) { nsel = n; for (int j = lane; j < 256; j += 64) sel[j] = (unsigned short)(j < n ? j : 0); }
    else {
        nsel = 256;
        const int R = (n + 63) >> 6; const unsigned long long ltm = (1ull << lane) - 1ull;
        float lo = INFINITY, hi = -INFINITY;
#pragma unroll 8
        for (int i = 0; i < R; ++i) { const int j = lane + 64 * i; if (j < n) { const float v = scq[j]; lo = fminf(lo, v); hi = fmaxf(hi, v); } }
#pragma unroll
        for (int o = 1; o < 64; o <<= 1) { lo = fminf(lo, shx(lo, o)); hi = fmaxf(hi, shx(hi, o)); }
        bool slow = false;
        if (!(hi > lo)) { for (int j = lane; j < 256; j += 64) sel[j] = (unsigned short)j; }
        else {
            const float scale = 1023.0f / (hi - lo);
            *(LAS u32x4*)(hist + 8 * lane) = (u32x4){0u, 0u, 0u, 0u}; *(LAS u32x4*)(hist + 8 * lane + 4) = (u32x4){0u, 0u, 0u, 0u};
#pragma unroll 8
            for (int i = 0; i < R; ++i) { const int j = lane + 64 * i; if (j < n) { int bk = (int)((scq[j] - lo) * scale); bk = bk < 1023 ? bk : 1023;
                atomicAdd((unsigned*)(hist + (bk >> 1)), (bk & 1) ? 65536u : 1u); } }
            const u32x4 h0 = *(const LAS u32x4*)(hist + 8 * lane), h1 = *(const LAS u32x4*)(hist + 8 * lane + 4);
            unsigned cb[16];
            cb[0] = h0.x & 0xffffu; cb[1] = h0.x >> 16; cb[2] = h0.y & 0xffffu; cb[3] = h0.y >> 16; cb[4] = h0.z & 0xffffu; cb[5] = h0.z >> 16; cb[6] = h0.w & 0xffffu; cb[7] = h0.w >> 16;
            cb[8] = h1.x & 0xffffu; cb[9] = h1.x >> 16; cb[10] = h1.y & 0xffffu; cb[11] = h1.y >> 16; cb[12] = h1.z & 0xffffu; cb[13] = h1.z >> 16; cb[14] = h1.w & 0xffffu; cb[15] = h1.w >> 16;
            unsigned tot = 0u;
#pragma unroll
            for (int q = 0; q < 16; ++q) tot += cb[q];
            unsigned incl = tot;
#pragma unroll
            for (int o = 1; o < 64; o <<= 1) { const unsigned t = shdown_u(incl, o); if (lane + o < 64) incl += t; }
            int fb = -1; unsigned fabove = 0u, fcnt = 0u; unsigned cum = incl - tot;
#pragma unroll
            for (int q = 15; q >= 0; --q) { if (fb < 0 && cum < 256u && 256u <= cum + cb[q]) { fb = 16 * lane + q; fabove = cum; fcnt = cb[q]; } cum += cb[q]; }
            const unsigned long long mf = __ballot(fb >= 0); const int src = (int)__ffsll((long long)mf) - 1;
            const int B = shidx_i(fb, src); const int above = shidx_i((int)fabove, src), cntB = shidx_i((int)fcnt, src); const int need = 256 - above;
            if (cntB > 256) slow = true;
            else {
                LAS unsigned* cand = hist;
                int base_gt = 0, base_c = 0;
#pragma unroll 4
                for (int i = 0; i < R; ++i) { const int j = lane + 64 * i; const bool valid = j < n; const float v = valid ? scq[j] : lo;
                    int bk = (int)((v - lo) * scale); bk = bk < 1023 ? bk : 1023;
                    const bool gt = valid && bk > B, eq = valid && bk == B;
                    const unsigned long long mg = __ballot(gt), me = __ballot(eq);
                    if (gt) sel[base_gt + __popcll(mg & ltm)] = (unsigned short)j;
                    if (eq) { const int p = base_c + __popcll(me & ltm); cand[2 * p] = fkey(v); cand[2 * p + 1] = (unsigned)j; }
                    base_gt += __popcll(mg); base_c += __popcll(me); }
                if (need == cntB) { for (int c = lane; c < cntB; c += 64) sel[above + c] = (unsigned short)cand[2 * c + 1]; }
                else {
                    unsigned ck[4]; int rk[4];
#pragma unroll
                    for (int q = 0; q < 4; ++q) { const int c = lane + 64 * q; ck[q] = c < cntB ? cand[2 * c] : 0u; rk[q] = 0; }
                    for (int c2 = 0; c2 < cntB; ++c2) { const unsigned k2 = cand[2 * c2];
#pragma unroll
                        for (int q = 0; q < 4; ++q) rk[q] += (k2 > ck[q] || (k2 == ck[q] && c2 < lane + 64 * q)) ? 1 : 0; }
#pragma unroll
                    for (int q = 0; q < 4; ++q) { const int c = lane + 64 * q; if (c < cntB && rk[q] < need) sel[above + rk[q]] = (unsigned short)cand[2 * c + 1]; }
                }
            }
        }
        if (slow) {
        unsigned prefix = 0u; int need = 256; unsigned neq = 0u;
        for (int p = 0; p < 4; ++p) { const int shift = 24 - 8 * p;
            *(LAS u32x4*)(hist + 4 * lane) = (u32x4){0u, 0u, 0u, 0u};
            for (int i = 0; i < R; ++i) { const int j = lane + 64 * i; if (j < n) { const unsigned u = fkey(scq[j]);
                if (p == 0 || (u >> (shift + 8)) == prefix) atomicAdd((unsigned*)(hist + ((u >> shift) & 255u)), 1u); } }
            const u32x4 hv = *(const LAS u32x4*)(hist + 4 * lane);
            const unsigned tot = hv.x + hv.y + hv.z + hv.w;
            unsigned incl = tot;
#pragma unroll
            for (int o = 1; o < 64; o <<= 1) { const unsigned t = shdown_u(incl, o); if (lane + o < 64) incl += t; }
            const unsigned above = incl - tot;
            int fb = -1; unsigned fabove = 0u, feq = 0u; unsigned cum = above;
            { const unsigned hq[4] = {hv.x, hv.y, hv.z, hv.w};
#pragma unroll
              for (int q = 3; q >= 0; --q) { if (fb < 0 && cum < (unsigned)need && (unsigned)need <= cum + hq[q]) { fb = 4 * lane + q; fabove = cum; feq = hq[q]; } cum += hq[q]; } }
            const unsigned long long m = __ballot(fb >= 0);
            const int src = (int)__ffsll((long long)m) - 1;
            const int bin = shidx_i(fb, src); const unsigned ab = (unsigned)shidx_i((int)fabove, src); neq = (unsigned)shidx_i((int)feq, src);
            need -= (int)ab; prefix = (prefix << 8) | (unsigned)bin;
        }
        const int ngt = 256 - need;
        int base_gt = 0, base_eq = 0;
        for (int i = 0; i < R; ++i) { const int j = lane + 64 * i; const unsigned u = (j < n) ? fkey(scq[j]) : 0u;
            const bool gt = (j < n) && (u > prefix), eq = (j < n) && (u == prefix);
            const unsigned long long mg = __ballot(gt), me = __ballot(eq); const unsigned long long lt = (1ull << lane) - 1ull;
            if (gt) sel[base_gt + __popcll(mg & lt)] = (unsigned short)j;
            if (eq) { const int rk = base_eq + __popcll(me & lt); if (rk < need) sel[ngt + rk] = (unsigned short)j; }
            base_gt += __popcll(mg); base_eq += __popcll(me); }
        (void)neq;
            }
    }
    const int nt16 = (nsel + 15) >> 4, r16 = lane & 15, g4 = lane >> 4;
    LAS float* biasj = scq + 2048;
#pragma unroll
    for (int q = 0; q < 4; ++q) { const int j = lane + 64 * q; f32x4 bv = (f32x4){-INFINITY, -INFINITY, -INFINITY, -INFINITY};
        if (j < nsel) { const int dist = tq - (int)sel[j]; const int bk = dist < 128 ? bkt[dist < 0 ? 0 : dist] : 31; bv = *(const LAS f32x4*)(biasT + 4 * bk); }
        *(LAS f32x4*)(biasj + 4 * j) = bv; }
    bf16x8 qf[2];
#pragma unroll
    for (int s = 0; s < 2; ++s) { u32x4 z = (u32x4){0u, 0u, 0u, 0u}; if (r16 < 4) z = *(const u32x4*)(U + (T0 + qi) * NINP + UC + r16 * 64 + 32 * s + 8 * g4); qf[s] = __builtin_bit_cast(bf16x8, z); }
    float lg[16][4]; float mx = -INFINITY;
#pragma unroll
    for (int hb = 0; hb < 2; ++hb) {
        if (hb * 8 < nt16) {
            int keyr[8]; bf16x8 a0[8], a1[8];
#pragma unroll
            for (int m8 = 0; m8 < 8; ++m8) keyr[m8] = sel[16 * (8 * hb + m8) + r16];
#pragma unroll
            for (int m8 = 0; m8 < 8; ++m8) { a0[m8] = *(const bf16x8*)(Kb + (TB + keyr[m8]) * 64 + 8 * g4); a1[m8] = *(const bf16x8*)(Kb + (TB + keyr[m8]) * 64 + 32 + 8 * g4); }
#pragma unroll
            for (int m8 = 0; m8 < 8; ++m8) { const int m = 8 * hb + m8;
                f32x4 acc = (f32x4){0.f, 0.f, 0.f, 0.f};
                acc = __builtin_amdgcn_mfma_f32_16x16x32_bf16(a0[m8], qf[0], acc, 0, 0, 0);
                acc = __builtin_amdgcn_mfma_f32_16x16x32_bf16(a1[m8], qf[1], acc, 0, 0, 0);
#pragma unroll
                for (int i = 0; i < 4; ++i) { const float v = acc[i] * 0.125f + biasj[(16 * m + 4 * g4 + i) * 4 + (r16 & 3)]; lg[m][i] = v; mx = fmaxf(mx, v); } }
        } else {
#pragma unroll
            for (int m8 = 0; m8 < 8; ++m8)
#pragma unroll
                for (int i = 0; i < 4; ++i) lg[8 * hb + m8][i] = -INFINITY;
        }
    }
    mx = fmaxf(mx, shx(mx, 16)); mx = fmaxf(mx, shx(mx, 32));
    float sm = 0.f;
#pragma unroll
    for (int m = 0; m < 16; ++m)
#pragma unroll
        for (int i = 0; i < 4; ++i) { const float p = __expf(lg[m][i] - mx); lg[m][i] = p; sm += p; }
    sm += shx(sm, 16); sm += shx(sm, 32);
    f32x4 ov[4];
#pragma unroll
    for (int nt = 0; nt < 4; ++nt) ov[nt] = (f32x4){0.f, 0.f, 0.f, 0.f};
    const unsigned vs_base = (unsigned)(unsigned long)scq;
#pragma unroll
    for (int half = 0; half < 2; ++half) {
        if (half * 8 < nt16) {
            asm volatile("s_waitcnt lgkmcnt(0)" ::: "memory");
#pragma unroll
            for (int q = 0; q < 16; ++q) { const int rho = 8 * q + (lane >> 3);
                const int j = half * 128 + (rho & ~31) + 16 * ((rho >> 2) & 1) + 4 * ((rho >> 3) & 3) + (rho & 3);
                const int key = sel[j];
                __builtin_amdgcn_global_load_lds((const unsigned*)(Vb + (TB + key) * 64 + 8 * (lane & 7)), (LAS unsigned*)((LAS unsigned char*)scq + q * 1024), 16, 0, 0); }
            asm volatile("s_waitcnt vmcnt(0)" ::: "memory");
#pragma unroll
            for (int s4 = 0; s4 < 4; ++s4) { const int s = half * 4 + s4;
                u32x4 pw; pw.x = pk2(lg[2 * s][0], lg[2 * s][1]); pw.y = pk2(lg[2 * s][2], lg[2 * s][3]); pw.z = pk2(lg[2 * s + 1][0], lg[2 * s + 1][1]); pw.w = pk2(lg[2 * s + 1][2], lg[2 * s + 1][3]);
                const bf16x8 pa = __builtin_bit_cast(bf16x8, pw);
                const unsigned ad = vs_base + (unsigned)((32 * s4 + 8 * g4 + (r16 >> 2)) * 128 + (r16 & 3) * 8);
                u32x2 t0[4], t1[4];
                asm volatile("ds_read_b64_tr_b16 %0, %8\n\tds_read_b64_tr_b16 %1, %8 offset:512\n\tds_read_b64_tr_b16 %2, %8 offset:32\n\tds_read_b64_tr_b16 %3, %8 offset:544\n\t"
                             "ds_read_b64_tr_b16 %4, %8 offset:64\n\tds_read_b64_tr_b16 %5, %8 offset:576\n\tds_read_b64_tr_b16 %6, %8 offset:96\n\tds_read_b64_tr_b16 %7, %8 offset:608\n\ts_waitcnt lgkmcnt(0)"
                             : "=&v"(t0[0]), "=&v"(t1[0]), "=&v"(t0[1]), "=&v"(t1[1]), "=&v"(t0[2]), "=&v"(t1[2]), "=&v"(t0[3]), "=&v"(t1[3]) : "v"(ad) : "memory");
#pragma unroll
                for (int nt = 0; nt < 4; ++nt) { const bf16x8 vb = __builtin_bit_cast(bf16x8, (u32x4){t0[nt].x, t0[nt].y, t1[nt].x, t1[nt].y});
                    ov[nt] = __builtin_amdgcn_mfma_f32_16x16x32_bf16(pa, vb, ov[nt], 0, 0, 0); } }
        }
    }
    { float inv[4];
#pragma unroll
      for (int h = 0; h < 4; ++h) inv[h] = 1.0f / __int_as_float(__builtin_amdgcn_readlane(__float_as_int(sm), h));
      if (lane < 16) { bf16_t* Y = (bf16_t*)(F.ws + WS_H) + (T0 + qi) * DM + 512 + r16;
#pragma unroll
          for (int h = 0; h < 4; ++h)
#pragma unroll
              for (int nt = 0; nt < 4; ++nt) Y[h * 64 + 16 * nt] = f2bf(ov[nt][h] * inv[h]); } }
}

__device__ __forceinline__ void phase_router(const Frame& F_, int layer, int cset) { Frame F = relocal(F_);
    const float* X = (const float*)(F.ws + WS_X);
    const bf16_t* WH = (const bf16_t*)(F.ws + WS_WRT) + (size_t)layer * 2 * 49152; const bf16_t* WL = WH + 49152;
    LAS float* part = (LAS float*)F.lds;
    LAS float* ssq = (LAS float*)(F.lds + 24576);
    LAS int* es = (LAS int*)(F.lds + 25088);
    LAS int* lr = (LAS int*)(F.lds + 25600);
    LAS float* wsl = (LAS float*)(F.lds + 26112);
    LAS float* rsd = (LAS float*)(F.lds + 26624);
    for (int blk = F.bid; blk < NTOK / 64; blk += F.G) {
        __syncthreads();
        const int mt = F.wave & 3, kh = F.wave >> 2, r16 = F.lane & 15, g4 = F.lane >> 4;
        const float* xr = X + ((size_t)blk * 64 + mt * 16 + r16) * DM + kh * 512 + 8 * g4;
        f32x4 acc[3]; acc[0] = acc[1] = acc[2] = (f32x4){0.f, 0.f, 0.f, 0.f}; float ss = 0.f;
#pragma unroll 4
        for (int ks = 0; ks < 16; ++ks) {
            const f32x4 xa = *(const f32x4*)(xr + ks * 32), xb = *(const f32x4*)(xr + ks * 32 + 4);
            ss += xa[0] * xa[0] + xa[1] * xa[1] + xa[2] * xa[2] + xa[3] * xa[3] + xb[0] * xb[0] + xb[1] * xb[1] + xb[2] * xb[2] + xb[3] * xb[3];
            float xv[8] = {xa[0], xa[1], xa[2], xa[3], xb[0], xb[1], xb[2], xb[3]}; unsigned hw[4], lw[4];
#pragma unroll
            for (int j = 0; j < 4; ++j) { const bf16_t h0 = f2bf(xv[2 * j]), h1 = f2bf(xv[2 * j + 1]); hw[j] = (unsigned)h0 | ((unsigned)h1 << 16);
                lw[j] = pk2(xv[2 * j] - bf2f(h0), xv[2 * j + 1] - bf2f(h1)); }
            const bf16x8 ahi = __builtin_bit_cast(bf16x8, (u32x4){hw[0], hw[1], hw[2], hw[3]}), alo = __builtin_bit_cast(bf16x8, (u32x4){lw[0], lw[1], lw[2], lw[3]});
#pragma unroll
            for (int nt = 0; nt < 3; ++nt) { const size_t wo = (size_t)(nt * 16 + r16) * 1024 + kh * 512 + ks * 32 + 8 * g4;
                const bf16x8 bh = *(const bf16x8*)(WH + wo), bl = *(const bf16x8*)(WL + wo);
                acc[nt] = __builtin_amdgcn_mfma_f32_16x16x32_bf16(ahi, bh, acc[nt], 0, 0, 0);
                acc[nt] = __builtin_amdgcn_mfma_f32_16x16x32_bf16(ahi, bl, acc[nt], 0, 0, 0);
                acc[nt] = __builtin_amdgcn_mfma_f32_16x16x32_bf16(alo, bh, acc[nt], 0, 0, 0); }
        }
        ss += shx(ss, 16); ss += shx(ss, 32);
        if (g4 == 0) ssq[kh * 64 + mt * 16 + r16] = ss;
#pragma unroll
        for (int nt = 0; nt < 3; ++nt)
#pragma unroll
            for (int i = 0; i < 4; ++i) part[(kh * 64 + mt * 16 + 4 * g4 + i) * 48 + nt * 16 + r16] = acc[nt][i];
        __syncthreads();
        if (F.tid < 64) { const float rstd = rsqrtf((ssq[F.tid] + ssq[64 + F.tid]) * (1.0f / DM) + 1e-6f); rsd[F.tid] = rstd;
            float l[36];
#pragma unroll
            for (int o = 0; o < 36; ++o) l[o] = (part[F.tid * 48 + o] + part[(64 + F.tid) * 48 + o]) * rstd + (o < 32 ? F.in[I_BRE][layer * 32 + o] : F.in[I_BRG][layer * 4 + o - 32]);
            int gs = 0; float gm = l[32];
#pragma unroll
            for (int j = 1; j < 4; ++j) if (l[32 + j] > gm) { gm = l[32 + j]; gs = j; }
            float den = 0.f;
#pragma unroll
            for (int j = 0; j < 4; ++j) den += __expf(l[32 + j] - gm);
            const float gate = 1.0f / den;
            float e8[8];
#pragma unroll
            for (int j = 0; j < 8; ++j) e8[j] = gs == 0 ? l[j] : gs == 1 ? l[8 + j] : gs == 2 ? l[16 + j] : l[24 + j];
            int i1 = 0; float v1 = e8[0];
#pragma unroll
            for (int j = 1; j < 8; ++j) if (e8[j] > v1) { v1 = e8[j]; i1 = j; }
            int i2 = -1; float v2 = -INFINITY;
#pragma unroll
            for (int j = 0; j < 8; ++j) if (j != i1 && e8[j] > v2) { v2 = e8[j]; i2 = j; }
            const float e2 = __expf(v2 - v1); const float p1 = 1.0f / (1.0f + e2);
            es[F.tid * 2] = gs * 8 + i1; es[F.tid * 2 + 1] = gs * 8 + i2; wsl[F.tid * 2] = p1 * gate; wsl[F.tid * 2 + 1] = (1.0f - p1) * gate; }
        __syncthreads();
        if (F.tid < 32) { int cnt = 0; for (int i = 0; i < 128; ++i) if (es[i] == F.tid) lr[i] = cnt++;
            if (cnt) { const int base = (int)__hip_atomic_fetch_add(F.ctl + CW_CNT + cset * 32 + F.tid, (unsigned)cnt, __ATOMIC_RELAXED, __HIP_MEMORY_SCOPE_AGENT);
                for (int i = 0; i < 128; ++i) if (es[i] == F.tid) lr[i] += base; } }
        __syncthreads();
        if (F.tid < 64) { int* rt = (int*)(F.ws + WS_ROUTE) + ((size_t)blk * 64 + F.tid) * 8;
            rt[0] = es[F.tid * 2]; rt[1] = es[F.tid * 2 + 1]; ((float*)rt)[2] = wsl[F.tid * 2]; ((float*)rt)[3] = wsl[F.tid * 2 + 1]; rt[4] = lr[F.tid * 2]; rt[5] = lr[F.tid * 2 + 1]; ((float*)rt)[6] = rsd[F.tid]; }
    }
}
struct CmGU { __device__ __forceinline__ int operator()(int n) const { return 128 * (n >> 8) + (n & 127); } };
__device__ __forceinline__ void phase_moe_convert(const Frame& F_, int layer) { Frame F = relocal(F_);
    bf16_t* WGU = (bf16_t*)(F.ws + WS_MOE + MOE_WGU); bf16_t* WD = (bf16_t*)(F.ws + WS_MOE + MOE_WD);
    for (int t = F.bid; t < 6144; t += F.G) {
        if (t < 4096) { const int e = t >> 7, r = t & 127, kt = r >> 3, nt = r & 7; const bool up = ((nt * 64) & 255) >= 128;
            const float* src = (up ? F.in[I_WUP] : F.in[I_WGATE]) + ((size_t)layer * 32 + e) * 1024 * 256;
            tr_tile(F, src, 256, WGU + (size_t)e * 512 * 1024, 1024, kt * 64, nt * 64, CmGU()); }
        else { const int q = t - 4096, e = q >> 6, r = q & 63, kt = r >> 4, nt = r & 15;
            tr_tile(F, F.in[I_WDOWN] + ((size_t)layer * 32 + e) * 256 * 1024, 1024, WD + (size_t)e * 1024 * 256, 256, kt * 64, nt * 64, CmId()); }
    }
}
__device__ __forceinline__ void phase_gather(const Frame& F_, int layer) { Frame F = relocal(F_);
    LAS int* off = (LAS int*)F.lds;
    __syncthreads();
    if (F.tid == 0) { int acc = 0; for (int e = 0; e < 32; ++e) { off[e] = acc; const int c = (int)__hip_atomic_load(F.ctl + CW_CNT + layer * 32 + e, __ATOMIC_RELAXED, __HIP_MEMORY_SCOPE_AGENT); acc += (c + 255) & ~255; } off[32] = acc; }
    __syncthreads();
    int* tiles = (int*)(F.ws + WS_TILES); int* row_tok = (int*)(F.ws + WS_ROWS); float* row_w = (float*)(F.ws + WS_ROWS) + MAXROWS;
    if (F.bid == 0) { if (F.tid == 0) tiles[0] = off[32] >> 8; if (F.tid < 33) tiles[1 + F.tid] = off[F.tid];
        if (F.tid < 32) for (int rt = off[F.tid] >> 8; rt < (off[F.tid + 1] >> 8); ++rt) tiles[64 + rt] = F.tid; }
    for (int e = F.bid; e < 32; e += F.G) { const int c = (int)__hip_atomic_load(F.ctl + CW_CNT + layer * 32 + e, __ATOMIC_RELAXED, __HIP_MEMORY_SCOPE_AGENT);
        for (int r = off[e] + c + F.tid; r < off[e + 1]; r += NTHR) { row_tok[r] = -1; row_w[r] = 0.f; } }
    const float* X = (const float*)(F.ws + WS_X); bf16_t* HP = (bf16_t*)(F.ws + WS_U); const float* nw = F.in[I_NORM2] + (size_t)layer * DM;
    f32x4 nwv[4];
#pragma unroll
    for (int j = 0; j < 4; ++j) nwv[j] = *(const f32x4*)(nw + 4 * F.lane + 256 * j);
    for (int t = F.bid * 8 + F.wave; t < NTOK; t += F.G * 8) {
        const int* rt = (const int*)(F.ws + WS_ROUTE) + (size_t)t * 8; const float rstd = ((const float*)rt)[6];
        const int p0 = off[rt[0]] + rt[4], p1 = off[rt[1]] + rt[5];
#pragma unroll
        for (int j = 0; j < 4; ++j) { const int c = 4 * F.lane + 256 * j; const f32x4 v = *(const f32x4*)(X + (size_t)t * DM + c) * rstd * nwv[j];
            u32x2 o; o.x = pk2(v[0], v[1]); o.y = pk2(v[2], v[3]);
            *(u32x2*)(HP + (size_t)p0 * DM + c) = o; *(u32x2*)(HP + (size_t)p1 * DM + c) = o; }
        if (F.lane == 0) { row_tok[p0] = t * 2; row_w[p0] = ((const float*)rt)[2]; row_tok[p1] = t * 2 + 1; row_w[p1] = ((const float*)rt)[3]; }
    }
}

constexpr int NPH_LAYER = 11, NPHASE = 1 + 2 * NPH_LAYER + 1;
__global__ void __launch_bounds__(NTHR, 2) mk_forward(Params P) {
    extern __shared__ __attribute__((aligned(16))) unsigned char lds_raw[];
    Frame F; F.lds = (LAS unsigned char*)lds_raw; F.tid = threadIdx.x; F.lane = F.tid & 63; F.wave = __builtin_amdgcn_readfirstlane(F.tid >> 6); F.bid = blockIdx.x; F.G = gridDim.x;
    F.in = (in_tab_t)__builtin_amdgcn_kernarg_segment_ptr(); F.out = P.out; F.ws = P.ws; F.ctl = (unsigned*)(P.ws + WS_CTL); F.misc = (volatile LAS int*)(F.lds + MISC_OFF);
    if (F.tid < 64) ((LAS unsigned*)(F.lds + MISC_OFF))[F.tid] = 0u;
    __syncthreads();
    const int lo = P.ph_lo, hi = P.ph_hi;
    XcdBarrier bar; bar.bar = F.ctl + CW_BAR; bar.x = 0; bar.st = (volatile LAS unsigned*)(F.lds + MISC_OFF + 16);
    if (hi - lo > 1) bar = xcd_barrier_post(F.ctl + CW_BAR, (volatile LAS unsigned*)(F.lds + MISC_OFF + 16));
#ifndef MK_ONLY
#define MK_ONLY -1
#endif
#define EN(o) (MK_ONLY < 0 || MK_ONLY == (o))
#ifndef MK_ITEM
#define MK_ITEM -1
#endif
#define IT(o) (MK_ITEM < 0 || MK_ITEM == (o))
#define IN(k) (lo <= (k) && (k) < hi)
#ifndef RPH
#define RPH -1
#endif
#define SEAM(k) do { if (IN(k) && IN((k) + 1)) xcd_barrier(bar); } while (0)
    if (EN(100) && IN(0)) { phase_prologue(F); } SEAM(0);
#if RPH == 101
    if (IN(1)) { phase_norm(F, F.in[I_X], false, F.in[I_NORM1], 0); phase_norm(F, F.in[I_X], false, F.in[I_NORM1], 0); phase_norm(F, F.in[I_X], false, F.in[I_NORM1], 0); phase_norm(F, F.in[I_X], false, F.in[I_NORM1], 0); } SEAM(0);
#endif
#if RPH == 100
    if (IN(0)) { phase_prologue(F); } SEAM(0);
#endif
#pragma unroll
    for (int layer = 0; layer < DEPTH; ++layer) {
        const int pb = 1 + layer * NPH_LAYER;
        if (EN(0) && IN(pb + 0)) { phase_norm(F, layer == 0 ? F.in[I_X] : (const float*)(F.ws + WS_X), layer > 0, F.in[I_NORM1] + (size_t)layer * DM, 0); } SEAM(pb + 0);
        if (EN(1) && IN(pb + 1)) { const Frame F_ = F; Frame F = relocal(F_); pg8::StaticOrder S; S.init((const bf16_t*)(F.ws + WS_H), (const bf16_t*)(F.ws + WS_WIN) + (size_t)layer * NINP * DM, NTOK, NINP, DM, F.G, F.bid);
            pg8::EpiBf16 E{(bf16_t*)(F.ws + WS_U), NINP}; pg8::gemm_phase(F.lds, DM, S, E); } SEAM(pb + 1);
#if RPH == 1
        if (IN(pb + 1)) { const Frame F_ = F; Frame F = relocal(F_); pg8::StaticOrder S; S.init((const bf16_t*)(F.ws + WS_H), (const bf16_t*)(F.ws + WS_WIN) + (size_t)layer * NINP * DM, NTOK, NINP, DM, F.G, F.bid);
            pg8::EpiBf16 E{(bf16_t*)(F.ws + WS_U), NINP}; pg8::gemm_phase(F.lds, DM, S, E); } SEAM(pb + 1);
#endif
#ifndef REP_C
#define REP_C 1
#endif
#ifndef REP_D
#define REP_D 1
#endif
#ifndef REP_E
#define REP_E 1
#endif
#define QLOOP(qi, n, body) for (;;) { const int it = q_pop(F, layer * 12 + (qi)); if (it >= (n)) break; body; }
        if (EN(2) && IN(pb + 2)) {
            if (IT(0)) QLOOP(0, 256, item_s5<1>(F, layer, it));
            if (IT(1)) QLOOP(1, 1024, item_rwkv1(F, layer, it));
            if (IT(2)) QLOOP(2, 256, item_mamba<1>(F, layer, it));
            if (IT(3)) QLOOP(3, 256, item_kv(F, layer, it));
#if REP_C == 2
            QLOOP(24, 256, item_s5<1>(F, layer, it));
#elif REP_C == 3
            QLOOP(25, 1024, item_rwkv1(F, layer, it));
#elif REP_C == 4
            QLOOP(26, 256, item_mamba<1>(F, layer, it));
#elif REP_C == 5
            QLOOP(27, 256, item_kv(F, layer, it));
#endif
        } SEAM(pb + 2);
        if (EN(3) && IN(pb + 3)) {
            if (IT(0)) QLOOP(4, 8, item_rwkv_carry(F, it));
            if (IT(1)) QLOOP(5, 16, item_mamba_carry(F, it));
            if (IT(2)) QLOOP(6, 4, item_s5_carry(F, layer, it));
            if (IT(3)) QLOOP(7, 2048, item_dsa(F, layer, it));
#if REP_D == 2
            QLOOP(31, 2048, item_dsa(F, layer, it));
#endif
        } SEAM(pb + 3);
        if (EN(4) && IN(pb + 4)) {
            if (IT(0)) QLOOP(8, 256, item_s5<2>(F, layer, it));
            if (IT(1)) QLOOP(9, 1024, item_rwkv3(F, layer, it));
            if (IT(2)) QLOOP(10, 256, item_mamba<2>(F, layer, it));
#if REP_E == 2
            QLOOP(32, 256, item_s5<2>(F, layer, it));
#elif REP_E == 3
            QLOOP(33, 1024, item_rwkv3(F, layer, it));
#elif REP_E == 4
            QLOOP(34, 256, item_mamba<2>(F, layer, it));
#endif
        } SEAM(pb + 4);
        if (EN(5) && IN(pb + 5)) { const Frame F_ = F; Frame F = relocal(F_); pg8::StaticOrder S; S.init((const bf16_t*)(F.ws + WS_MOE + YSG_OFF), (const bf16_t*)(F.ws + WS_GLU) + (size_t)layer * 512 * 256, NTOK, 512, 256, F.G, F.bid);
            pg8::EpiGated<0> E{(bf16_t*)(F.ws + WS_H), DM, 768, F.in[I_SGLUB] + layer * 512, F.in[I_SGLUB] + layer * 512 + 256}; pg8::gemm_phase(F.lds, 256, S, E); } SEAM(pb + 5);
#if RPH == 5
        if (IN(pb + 5)) { const Frame F_ = F; Frame F = relocal(F_); pg8::StaticOrder S; S.init((const bf16_t*)(F.ws + WS_MOE + YSG_OFF), (const bf16_t*)(F.ws + WS_GLU) + (size_t)layer * 512 * 256, NTOK, 512, 256, F.G, F.bid);
            pg8::EpiGated<0> E{(bf16_t*)(F.ws + WS_H), DM, 768, F.in[I_SGLUB] + layer * 512, F.in[I_SGLUB] + layer * 512 + 256}; pg8::gemm_phase(F.lds, 256, S, E); } SEAM(pb + 5);
#endif
        if (EN(6) && IN(pb + 6)) { const Frame F_ = F; Frame F = relocal(F_); pg8::StaticOrder S; S.init((const bf16_t*)(F.ws + WS_H), (const bf16_t*)(F.ws + WS_WOUT) + (size_t)layer * DM * DM, NTOK, DM, DM, F.G, F.bid);
            pg8::EpiResid E{(float*)(F.ws + WS_X), DM}; pg8::gemm_phase(F.lds, DM, S, E); } SEAM(pb + 6);
        if (EN(7) && IN(pb + 7)) { phase_router(F, layer, layer); phase_moe_convert(F, layer); } SEAM(pb + 7);
#if RPH == 70
        if (IN(pb + 7)) { phase_router(F, layer, layer + 2); } SEAM(pb + 7);
#endif
#if RPH == 7
        if (IN(pb + 7)) { phase_moe_convert(F, layer); } SEAM(pb + 7);
#endif
        if (EN(8) && IN(pb + 8)) { phase_gather(F, layer); } SEAM(pb + 8);
#if RPH == 8
        if (IN(pb + 8)) { phase_gather(F, layer); } SEAM(pb + 8);
#endif
        if (EN(9) && IN(pb + 9)) { const Frame F_ = F; Frame F = relocal(F_); pg8::MoeOrder S{2, F.G, F.bid, DM, (const char*)(F.ws + WS_U), (const char*)(F.ws + WS_MOE + MOE_WGU), (size_t)512 * 1024 * 2, (const int*)(F.ws + WS_TILES)};
            pg8::EpiGated<1> E{(bf16_t*)(F.ws + WS_H), 256, 0, nullptr, nullptr}; pg8::gemm_phase(F.lds, DM, S, E); } SEAM(pb + 9);
#if RPH == 9
        if (IN(pb + 9)) { const Frame F_ = F; Frame F = relocal(F_); pg8::MoeOrder S{2, F.G, F.bid, DM, (const char*)(F.ws + WS_U), (const char*)(F.ws + WS_MOE + MOE_WGU), (size_t)512 * 1024 * 2, (const int*)(F.ws + WS_TILES)};
            pg8::EpiGated<1> E{(bf16_t*)(F.ws + WS_H), 256, 0, nullptr, nullptr}; pg8::gemm_phase(F.lds, DM, S, E); } SEAM(pb + 9);
#endif
        if (EN(10) && IN(pb + 10)) { const Frame F_ = F; Frame F = relocal(F_); pg8::MoeOrder S{4, F.G, F.bid, 256, (const char*)(F.ws + WS_H), (const char*)(F.ws + WS_MOE + MOE_WD), (size_t)1024 * 256 * 2, (const int*)(F.ws + WS_TILES)};
            pg8::EpiMoeOut E{(bf16_t*)(F.ws + WS_U), (const int*)(F.ws + WS_ROWS), (const float*)(F.ws + WS_ROWS) + MAXROWS}; pg8::gemm_phase(F.lds, 256, S, E); } SEAM(pb + 10);
#if RPH == 10
        if (IN(pb + 10)) { const Frame F_ = F; Frame F = relocal(F_); pg8::MoeOrder S{4, F.G, F.bid, 256, (const char*)(F.ws + WS_H), (const char*)(F.ws + WS_MOE + MOE_WD), (size_t)1024 * 256 * 2, (const int*)(F.ws + WS_TILES)};
            pg8::EpiMoeOut E{(bf16_t*)(F.ws + WS_U), (const int*)(F.ws + WS_ROWS), (const float*)(F.ws + WS_ROWS) + MAXROWS}; pg8::gemm_phase(F.lds, 256, S, E); } SEAM(pb + 10);
#endif
    }
    if (EN(101) && IN(NPHASE - 1)) { phase_norm(F, (const float*)(F.ws + WS_X), true, F.in[I_FNORM], 2); }
#undef IN
#undef SEAM
}

#ifndef MK_SPLIT
#define MK_SPLIT 0
#endif
extern "C" void kernel_launch(void* const* d_in, const int* in_sizes, int n_in, void* d_out, int out_size, void* d_ws, size_t ws_size, hipStream_t stream) {
    static int grid = 0;
    if (grid == 0) {
        if (n_in != 44 || out_size != NTOK * DM || ws_size < WS_END) { fprintf(stderr, "kernel_launch: unexpected shapes (n_in %d out %d ws %zu need %zu)\n", n_in, out_size, ws_size, (size_t)WS_END); grid = -1; return; }
        int dev = 0, cus = 0;
        if (hipGetDevice(&dev) != hipSuccess || hipDeviceGetAttribute(&cus, hipDeviceAttributeMultiprocessorCount, dev) != hipSuccess) { grid = -1; return; }
        if (hipFuncSetAttribute((const void*)mk_forward, hipFuncAttributeMaxDynamicSharedMemorySize, LDS_BYTES) != hipSuccess) { fprintf(stderr, "kernel_launch: hipFuncSetAttribute failed\n"); grid = -1; return; }
        int per_cu = 0;
        if (hipOccupancyMaxActiveBlocksPerMultiprocessor(&per_cu, (const void*)mk_forward, NTHR, LDS_BYTES) != hipSuccess || per_cu < 1) { fprintf(stderr, "kernel_launch: occupancy query says %d\n", per_cu); }
        (void)hipGetLastError();
        grid = cus;
    }
    if (grid < 0) return;
    hipMemsetAsync((char*)d_ws + WS_CTL, 0, CTL_BYTES, stream);
    Params p{};
    for (int i = 0; i < 44; ++i) p.in[i] = (const float*)d_in[i];
    p.out = (float*)d_out; p.ws = (unsigned char*)d_ws;
#if MK_SPLIT
    for (int ph = 0; ph < NPHASE; ++ph) { p.ph_lo = ph; p.ph_hi = ph + 1; hipLaunchKernelGGL(mk_forward, dim3(grid), dim3(NTHR), LDS_BYTES, stream, p); }
#else
    p.ph_lo = 0; p.ph_hi = NPHASE; hipLaunchKernelGGL(mk_forward, dim3(grid), dim3(NTHR), LDS_BYTES, stream, p);
#endif
}
```

```cpp
#include <hip/hip_runtime.h>
#include <stdint.h>
#include <stdio.h>

#define LAS __attribute__((address_space(3)))
typedef unsigned short bf16_t;
typedef short bf16x8 __attribute__((ext_vector_type(8)));
typedef float f32x4 __attribute__((ext_vector_type(4)));
typedef float f32x2 __attribute__((ext_vector_type(2)));
typedef float f32x16 __attribute__((ext_vector_type(16)));
typedef unsigned u32x4 __attribute__((ext_vector_type(4)));
typedef unsigned u32x2 __attribute__((ext_vector_type(2)));

constexpr int NTOK = 16384, DM = 1024, SEQ = 4096, NBATCH = 4, DEPTH = 2;
constexpr int NIN = 2604, NINP = 2816;
constexpr int UM = 0;
constexpr int UR = 784;
constexpr int UC = 1680;
constexpr int US = 2368;
constexpr int NTHR = 512;
constexpr int LDS_BYTES = 163840;
constexpr int MISC_OFF = LDS_BYTES - 256;

constexpr size_t WS_CTL   = 0;
constexpr size_t CTL_BYTES = 65536;
constexpr size_t WS_X     = WS_CTL + CTL_BYTES;
constexpr size_t WS_H     = WS_X + (size_t)NTOK * DM * 4;
constexpr size_t WS_U     = WS_H + (size_t)NTOK * DM * 2;
constexpr size_t WS_WIN   = WS_U + (size_t)NTOK * NINP * 2;
constexpr size_t WS_WOUT  = WS_WIN + (size_t)2 * NINP * DM * 2;
constexpr size_t WS_GLU   = WS_WOUT + (size_t)2 * DM * DM * 2;
constexpr size_t WS_MOE   = WS_GLU + (size_t)2 * 512 * 256 * 2;
constexpr size_t MOE_WGU  = 0;
constexpr size_t MOE_WD   = (size_t)32 * 512 * 1024 * 2;
constexpr size_t MOE_BYTES = MOE_WD + (size_t)32 * 1024 * 256 * 2;
constexpr size_t RW_PT    = 0;
constexpr size_t RW_U     = (size_t)1024 * 4096 * 2;
constexpr size_t RW_S     = RW_U + (size_t)1024 * 4096 * 2;
constexpr size_t RW_W1    = RW_S + (size_t)1024 * 4096 * 2;
constexpr size_t RW_Z     = RW_W1 + (size_t)1024 * 4096 * 2;
constexpr size_t YSG_OFF  = RW_Z + (size_t)1024 * 4096 * 2;
static_assert(YSG_OFF + (size_t)NTOK * 256 * 2 <= MOE_BYTES, "alias");
constexpr size_t WS_MST   = WS_MOE + MOE_BYTES;
constexpr size_t WS_MDEC  = WS_MST + (size_t)4 * 64 * 4 * 4096 * 4;
constexpr size_t WS_S5ST  = WS_MDEC + 4096;
constexpr size_t WS_K     = WS_S5ST + (size_t)4 * 64 * 2048 * 4;
constexpr size_t WS_V     = WS_K + (size_t)NTOK * 64 * 2;
constexpr size_t WS_KIDX  = WS_V + (size_t)NTOK * 64 * 2;
constexpr size_t WS_ROUTE = WS_KIDX + (size_t)NTOK * 32 * 2;
constexpr size_t WS_ROWS  = WS_ROUTE + (size_t)NTOK * 32;
constexpr int    MAXROWS  = 49152;
constexpr size_t WS_TILES = WS_ROWS + (size_t)MAXROWS * 8;
constexpr size_t WS_S5TAB = WS_TILES + 4096;
constexpr size_t S5TAB_F  = (size_t)(2048 + 2048 + 32768) * 4;
constexpr size_t S5TAB_L  = S5TAB_F + (size_t)16 * 16 * 128 * 2;
constexpr size_t WS_WRT   = WS_S5TAB + 2 * S5TAB_L;
constexpr size_t WS_END   = WS_WRT + (size_t)2 * 2 * 48 * 1024 * 2;

constexpr int CW_BAR = 0;
constexpr int CW_Q   = 4096;
constexpr int CW_CNT = 8192;
constexpr int CW_RB  = 8448;

__device__ __forceinline__ float bf2f(bf16_t b) { return __uint_as_float(((unsigned)b) << 16); }
__device__ __forceinline__ bf16_t f2bf(float f) { const __bf16 h = (__bf16)f; return __builtin_bit_cast(bf16_t, h); }
__device__ __forceinline__ unsigned pk2(float lo, float hi) { typedef __bf16 bf2_t __attribute__((ext_vector_type(2))); const bf2_t h = __builtin_convertvector((f32x2){lo, hi}, bf2_t); return __builtin_bit_cast(unsigned, h); }
__device__ __forceinline__ unsigned cvt_pk_bf16(float lo, float hi) { unsigned r; asm volatile("v_cvt_pk_bf16_f32 %0, %1, %2" : "=v"(r) : "v"(lo), "v"(hi)); return r; }
__device__ __forceinline__ float sigmoidf_(float x) { return 1.0f / (1.0f + __expf(-x)); }
__device__ __forceinline__ float siluf_(float x) { return x / (1.0f + __expf(-x)); }
__device__ __forceinline__ float tanhf_(float x) { const float e = __expf(2.0f * x); return 1.0f - 2.0f / (e + 1.0f); }
__device__ __forceinline__ float softplusf_(float x) { return fmaxf(x, 0.0f) + log1pf(__expf(-fabsf(x))); }
__device__ __forceinline__ float gelu_tanh(float x) { return 0.5f * x * (1.0f + tanhf_(0.7978845608028654f * (x + 0.044715f * x * x * x))); }
template <int CTRL> __device__ __forceinline__ float dppf(float x) { return __int_as_float(__builtin_amdgcn_update_dpp(0, __float_as_int(x), CTRL, 0xF, 0xF, true)); }
__device__ __forceinline__ float sum4(float x) { x += dppf<0xB1>(x); x += dppf<0x4E>(x); return x; }
__device__ __forceinline__ float sum8(float x) { x = sum4(x); x += dppf<0x141>(x); return x; }
__device__ __forceinline__ float sum16(float x) { x = sum8(x); x += dppf<0x140>(x); return x; }
__device__ __forceinline__ int lane_id_() { int l = (int)__builtin_amdgcn_mbcnt_hi(~0u, __builtin_amdgcn_mbcnt_lo(~0u, 0u)); asm volatile("" : "+v"(l)); return l; }
__device__ __forceinline__ float shx(float x, int o) { return __int_as_float(__builtin_amdgcn_ds_bpermute((lane_id_() ^ o) << 2, __float_as_int(x))); }
__device__ __forceinline__ unsigned shdown_u(unsigned x, int o) { return (unsigned)__builtin_amdgcn_ds_bpermute(((lane_id_() + o) & 63) << 2, (int)x); }
__device__ __forceinline__ int shidx_i(int x, int src) { return __builtin_amdgcn_ds_bpermute(src << 2, x); }
__device__ __forceinline__ float wave_sum(float x) { x = sum16(x); x += shx(x, 16); x += shx(x, 32); return x; }
__device__ __forceinline__ void unpack8(const u32x4 v, float (&f)[8]) {
    f[0] = __uint_as_float(v.x << 16); f[1] = __uint_as_float(v.x & 0xffff0000u); f[2] = __uint_as_float(v.y << 16); f[3] = __uint_as_float(v.y & 0xffff0000u);
    f[4] = __uint_as_float(v.z << 16); f[5] = __uint_as_float(v.z & 0xffff0000u); f[6] = __uint_as_float(v.w << 16); f[7] = __uint_as_float(v.w & 0xffff0000u);
}

#define XB_TMO      128
#define XB_XCNT(j)  (256  + 64 * (j))
#define XB_XSUB(j)  (1280 + 64 * (j))
#define XB_XGEN(j)  (2304 + 64 * (j))
#define XB_TOP      3328
#define XB_TOPGEN   3392
#define XCD_BAR_WORDS 3456
#define XB_SPIN_CAP (1u << 22)
__device__ __forceinline__ unsigned xb_ld(unsigned* p)              { return __hip_atomic_load(p, __ATOMIC_RELAXED, __HIP_MEMORY_SCOPE_AGENT); }
__device__ __forceinline__ unsigned xb_add(unsigned* p, unsigned v) { return __hip_atomic_fetch_add(p, v, __ATOMIC_RELAXED, __HIP_MEMORY_SCOPE_AGENT); }
__device__ __forceinline__ unsigned xb_xcc_id() { return (unsigned)__builtin_amdgcn_s_getreg((3 << 11) | 20) & 0xFu; }
#define XB_SPIN(cond, bar) do { unsigned _sp = 0; while (cond) { __builtin_amdgcn_s_sleep(1); \
    if ((++_sp & 255u) == 0u) { if (xb_ld(&(bar)[XB_TMO])) break; if (_sp > XB_SPIN_CAP) { atomicAdd(&(bar)[XB_TMO], 1u); break; } } } } while (0)
struct XcdBarrier { unsigned* bar; unsigned x; volatile LAS unsigned* st; };
__device__ __forceinline__ XcdBarrier xcd_barrier_post(unsigned* bar, volatile LAS unsigned* st) {
    XcdBarrier b; b.bar = bar; b.x = xb_xcc_id(); b.st = st;
    if (threadIdx.x == 0) (void)xb_add(&bar[XB_XCNT(b.x)], 1u);
    return b;
}
__device__ __forceinline__ void xcd_barrier_complete(unsigned* bar, unsigned x, unsigned& nloc, unsigned& nx) {
    const unsigned G = gridDim.x * gridDim.y * gridDim.z;
    unsigned sum, cnt, mine, sp = 0u;
    for (;;) {
        sum = 0u; cnt = 0u; mine = 0u;
#pragma unroll
        for (unsigned j = 0; j < 16; ++j) { const unsigned c = xb_ld(&bar[XB_XCNT(j)]); sum += c; cnt += (c > 0u) ? 1u : 0u; mine = (j == x) ? c : mine; }
        if (sum == G) break;
        __builtin_amdgcn_s_sleep(1);
        if ((++sp & 255u) == 0u) { if (xb_ld(&bar[XB_TMO])) break; if (sp > XB_SPIN_CAP) { atomicAdd(&bar[XB_TMO], 1u); break; } }
    }
    nloc = mine > 0u ? mine : 1u; nx = cnt > 0u ? cnt : 1u;
}
__device__ __forceinline__ void xcd_barrier(const XcdBarrier& b_) {
    XcdBarrier b = b_; { const unsigned long long v = (unsigned long long)b.bar; unsigned lo = __builtin_amdgcn_readfirstlane((unsigned)v), hi = __builtin_amdgcn_readfirstlane((unsigned)(v >> 32)); asm volatile("" : "+s"(lo), "+s"(hi)); b.bar = (unsigned*)(((unsigned long long)hi << 32) | lo); unsigned xx = __builtin_amdgcn_readfirstlane(b.x); asm volatile("" : "+s"(xx)); b.x = xx; }
    asm volatile("s_waitcnt vmcnt(0)" ::: "memory");
    __syncthreads();
    if (threadIdx.x == 0) {
        unsigned* bar = b.bar;
        __builtin_amdgcn_s_waitcnt(0);
        unsigned nloc = b.st[0], nx = b.st[1];
        if (nloc == 0u) { xcd_barrier_complete(bar, b.x, nloc, nx); b.st[0] = nloc; b.st[1] = nx; }
        const unsigned old = xb_add(&bar[XB_XSUB(b.x)], 1u);
        const unsigned gen = old / nloc;
        if (old + 1u == (gen + 1u) * nloc) {
            __builtin_amdgcn_fence(__ATOMIC_RELEASE, "agent");
            asm volatile("s_waitcnt vmcnt(0)" ::: "memory");
            const unsigned og = xb_add(&bar[XB_TOP], 1u);
            const unsigned tg = og / nx;
            if (og + 1u == (tg + 1u) * nx) xb_add(&bar[XB_TOPGEN], 1u);
            else XB_SPIN(xb_ld(&bar[XB_TOPGEN]) == tg, bar);
            __builtin_amdgcn_fence(__ATOMIC_ACQUIRE, "agent");
            xb_add(&bar[XB_XGEN(b.x)], 1u);
            asm volatile("s_waitcnt vmcnt(0)" ::: "memory");
        } else {
            XB_SPIN(xb_ld(&bar[XB_XGEN(b.x)]) == gen, bar);
            __builtin_amdgcn_fence(__ATOMIC_ACQUIRE, "agent");
            asm volatile("s_waitcnt vmcnt(0)" ::: "memory");
        }
    }
    __syncthreads();
}

namespace pg8 {
constexpr int BM = 256, BK = 64, HALF = 128, HTB = HALF * BK * 2, STAGE_BYTES = 8 * HTB, NXCD = 8, WGM = 8;
__host__ __device__ __forceinline__ int lds_byte(int r, int c) { const int st = (r >> 4) * 2 + (c >> 5), rr = r & 15, cc = c & 31, ob = rr * 64 + cc * 2; return st * 1024 + (ob ^ (((ob >> 9) & 1) << 5)); }
__host__ __device__ __forceinline__ void stage_rc(int b, int& R, int& C) { const int st = b / 1024, sb = b % 1024, swz = sb ^ (((sb >> 9) & 1) << 5); R = (st >> 1) * 16 + swz / 64; C = (st & 1) * 32 + (swz % 64) / 2; }
__host__ __device__ __forceinline__ int perm32(int rho) { const int n = rho >> 4, i = rho & 15; return 8 * (i >> 2) + 4 * n + (i & 3); }
struct Unit { int pm, pn; const char* a; const char* b; };

struct StaticOrder {
    int nM, nN, nwg, G, c, K; const char* A; const char* B;
    __device__ void init(const bf16_t* A_, const bf16_t* B_, int M, int N, int K_, int G_, int c_) { A = (const char*)A_; B = (const char*)B_; K = K_; nM = M / BM; nN = N / BM; nwg = nM * nN; G = G_; c = c_; }
    __device__ bool next(int i, Unit& u) const {
        const long L = (long)i * G + c; if (L >= nwg) return false;
        int wgid = (int)L; { const int q = nwg / NXCD, r = nwg % NXCD, xcd = wgid % NXCD, off = wgid / NXCD; wgid = (xcd < r ? xcd * (q + 1) : r * (q + 1) + (xcd - r) * q) + off; }
        const int nig = WGM * nN, gid = wgid / nig, fm = gid * WGM, gsz = (nM - fm) < WGM ? (nM - fm) : WGM;
        u.pm = fm + ((wgid % nig) % gsz); u.pn = (wgid % nig) / gsz;
        u.a = A + (size_t)u.pm * 256 * K * 2; u.b = B + (size_t)u.pn * 256 * K * 2; return true;
    }
};

template <class Epi, class Sched>
__device__ __forceinline__ void gemm_phase(LAS unsigned char* lds, const int K_, const Sched& S, const Epi& E) {
    int K = K_; asm volatile("" : "+s"(K));
    int tid_ = threadIdx.x; asm volatile("" : "+v"(tid_));
    const int tid = tid_, wid = __builtin_amdgcn_readfirstlane(tid >> 6), lane = tid & 63, wr = wid >> 2, wc = wid & 3, fr = lane & 15, fq = lane >> 4;
    const int nt = K / BK;
    unsigned voffA[2], voffB[2];
#pragma unroll
    for (int i = 0; i < 2; ++i) { int R, C; stage_rc(tid * 16 + i * 8192, R, C); const int Rb = Epi::PERM ? ((R & ~31) + perm32(R & 31)) : R;
        voffA[i] = (unsigned)(R * K + C) * 2u; voffB[i] = (unsigned)(Rb * K + C) * 2u; }
    const size_t kstep = (size_t)(BK * 2);
    const size_t hstep = (size_t)HALF * K * 2;
    const unsigned ldsw = (unsigned)wid * 1024u;
    const int aoff = lds_byte(wr * 64 + fr, fq * 8), boff = lds_byte(wc * 32 + fr, fq * 8);
#define PG8_SA(b, h) (((b) * 2 + (h)) * HTB)
#define PG8_SB(b, h) ((4 + (b) * 2 + (h)) * HTB)
#define PG8_STAGE(bufoff, gbase, voff) do { _Pragma("unroll") for (int _i = 0; _i < 2; ++_i) \
        __builtin_amdgcn_global_load_lds((const unsigned*)((const char*)(gbase) + (voff)[_i]), (LAS unsigned*)(lds + (bufoff) + ldsw + _i * 8192), 16, 0, 0); } while (0)
#define PG8_LDA(dst, b, h) do { _Pragma("unroll") for (int m = 0; m < 4; ++m) _Pragma("unroll") for (int k = 0; k < 2; ++k) dst[m][k] = *(const LAS bf16x8*)(lds + PG8_SA(b, h) + aoff + m * 2048 + k * 1024); } while (0)
#define PG8_LDB(dst, b, h) do { _Pragma("unroll") for (int n = 0; n < 2; ++n) _Pragma("unroll") for (int k = 0; k < 2; ++k) dst[n][k] = *(const LAS bf16x8*)(lds + PG8_SB(b, h) + boff + n * 2048 + k * 1024); } while (0)
#define PG8_MMA(ai, bj, At, Bt) do { __builtin_amdgcn_s_setprio(1); _Pragma("unroll") for (int m = 0; m < 4; ++m) _Pragma("unroll") for (int n = 0; n < 2; ++n) _Pragma("unroll") for (int k = 0; k < 2; ++k) \
        acc[ai][bj][m][n] = __builtin_amdgcn_mfma_f32_16x16x32_bf16(Bt[n][k], At[m][k], acc[ai][bj][m][n], 0, 0, 0); __builtin_amdgcn_s_setprio(0); } while (0)
#define PG8_WAIT_V(n) asm volatile("s_waitcnt vmcnt(" #n ")" ::: "memory")
#define PG8_WAIT_L(n) asm volatile("s_waitcnt lgkmcnt(" #n ")" ::: "memory")
#define PG8_BAR __builtin_amdgcn_s_barrier()
#define PG8_SCHED __builtin_amdgcn_sched_barrier(0)
    Unit cur, nxt; int ui = 0;
    if (!S.next(0, cur)) return;
    f32x4 acc[2][2][4][2];
#pragma unroll
    for (int a = 0; a < 2; ++a)
#pragma unroll
        for (int b = 0; b < 2; ++b)
#pragma unroll
            for (int m = 0; m < 4; ++m)
#pragma unroll
                for (int n = 0; n < 2; ++n) acc[a][b][m][n] = (f32x4){0.f, 0.f, 0.f, 0.f};
    bf16x8 At[4][2], B0[2][2], B1[2][2];
    const char* cA = cur.a; const char* cB = cur.b;
    PG8_STAGE(PG8_SB(0, 0), cB, voffB); PG8_STAGE(PG8_SA(0, 0), cA, voffA); PG8_STAGE(PG8_SB(0, 1), cB + hstep, voffB); PG8_STAGE(PG8_SA(0, 1), cA + hstep, voffA);
    if (wr == 1) PG8_BAR;
    PG8_WAIT_V(4); PG8_BAR;
    PG8_STAGE(PG8_SB(1, 0), cB + kstep, voffB); PG8_STAGE(PG8_SA(1, 0), cA + kstep, voffA); PG8_STAGE(PG8_SB(1, 1), cB + hstep + kstep, voffB);
    PG8_WAIT_V(6); PG8_BAR;
    for (;;) {
        const bool has_next = S.next(ui + 1, nxt);
        const char* nA = has_next ? nxt.a : cA; const char* nB = has_next ? nxt.b : cB;
        for (int t = 0; t < nt; t += 2) {
            const bool last = (t == nt - 2);
            const char* a1 = cA + (size_t)(t + 1) * kstep;
            const char* a2 = last ? nA : cA + (size_t)(t + 2) * kstep; const char* b2 = last ? nB : cB + (size_t)(t + 2) * kstep;
            const char* a3 = a2 + kstep; const char* b3 = b2 + kstep;
            PG8_LDB(B0, 0, 0); PG8_SCHED; PG8_LDA(At, 0, 0); PG8_STAGE(PG8_SA(1, 1), a1 + hstep, voffA);
            PG8_WAIT_L(8); PG8_BAR; PG8_WAIT_L(0); PG8_MMA(0, 0, At, B0); PG8_BAR; PG8_SCHED;
            PG8_LDB(B1, 0, 1); PG8_STAGE(PG8_SB(0, 0), b2, voffB);
            PG8_BAR; PG8_WAIT_L(0); PG8_MMA(0, 1, At, B1); PG8_BAR;
            PG8_LDA(At, 0, 1); PG8_STAGE(PG8_SA(0, 0), a2, voffA);
            PG8_BAR; PG8_WAIT_L(0); PG8_MMA(1, 0, At, B0); PG8_BAR; PG8_SCHED;
            PG8_STAGE(PG8_SB(0, 1), b2 + hstep, voffB);
            PG8_WAIT_V(6); PG8_BAR; PG8_MMA(1, 1, At, B1); PG8_BAR;
            PG8_LDB(B0, 1, 0); PG8_SCHED; PG8_LDA(At, 1, 0); PG8_STAGE(PG8_SA(0, 1), a2 + hstep, voffA);
            PG8_WAIT_L(8); PG8_BAR; PG8_WAIT_L(0); PG8_MMA(0, 0, At, B0); PG8_BAR; PG8_SCHED;
            PG8_LDB(B1, 1, 1); PG8_STAGE(PG8_SB(1, 0), b3, voffB);
            PG8_BAR; PG8_WAIT_L(0); PG8_MMA(0, 1, At, B1); PG8_BAR;
            PG8_LDA(At, 1, 1); PG8_STAGE(PG8_SA(1, 0), a3, voffA);
            PG8_BAR; PG8_WAIT_L(0); PG8_MMA(1, 0, At, B0); PG8_BAR; PG8_SCHED;
            PG8_STAGE(PG8_SB(1, 1), b3 + hstep, voffB);
            PG8_WAIT_V(6); PG8_BAR; PG8_MMA(1, 1, At, B1); PG8_BAR;
        }
        E(acc, cur, wr, wc, fr, fq);
        if (!has_next) break;
#pragma unroll
        for (int a = 0; a < 2; ++a)
#pragma unroll
            for (int b = 0; b < 2; ++b)
#pragma unroll
                for (int m = 0; m < 4; ++m)
#pragma unroll
                    for (int n = 0; n < 2; ++n) acc[a][b][m][n] = (f32x4){0.f, 0.f, 0.f, 0.f};
        cur = nxt; cA = nA; cB = nB; ++ui;
    }
    PG8_WAIT_V(0);
    if (wr == 0) PG8_BAR;
    PG8_BAR;
#undef PG8_SA
#undef PG8_SB
#undef PG8_STAGE
#undef PG8_LDA
#undef PG8_LDB
#undef PG8_MMA
#undef PG8_WAIT_V
#undef PG8_WAIT_L
#undef PG8_BAR
#undef PG8_SCHED
}

struct EpiBf16 {
    static constexpr bool PERM = true;
    bf16_t* O; int ldc;
    __device__ __forceinline__ void operator()(const f32x4 (&acc)[2][2][4][2], const Unit& u, int wr, int wc, int fr, int fq) const {
        const int row0 = u.pm * BM + wr * 64 + fr, col0 = u.pn * BM + wc * 32 + 8 * fq;
#pragma unroll
        for (int ai = 0; ai < 2; ++ai)
#pragma unroll
            for (int m = 0; m < 4; ++m) { bf16_t* rowp = O + (size_t)(row0 + ai * HALF + m * 16) * ldc + col0;
#pragma unroll
                for (int bj = 0; bj < 2; ++bj) { const f32x4 v0 = acc[ai][bj][m][0], v1 = acc[ai][bj][m][1];
                    u32x4 w; w.x = cvt_pk_bf16(v0[0], v0[1]); w.y = cvt_pk_bf16(v0[2], v0[3]); w.z = cvt_pk_bf16(v1[0], v1[1]); w.w = cvt_pk_bf16(v1[2], v1[3]);
                    *(u32x4*)(rowp + bj * HALF) = w; } }
    }
};
struct EpiResid {
    static constexpr bool PERM = false;
    float* C; int ldc;
    __device__ __forceinline__ void operator()(const f32x4 (&acc)[2][2][4][2], const Unit& u, int wr, int wc, int fr, int fq) const {
        const int row0 = u.pm * BM + wr * 64 + fr, col0 = u.pn * BM + wc * 32 + 4 * fq;
#pragma unroll
        for (int ai = 0; ai < 2; ++ai)
#pragma unroll
            for (int m = 0; m < 4; ++m) { float* rowp = C + (size_t)(row0 + ai * HALF + m * 16) * ldc + col0;
#pragma unroll
                for (int bj = 0; bj < 2; ++bj)
#pragma unroll
                    for (int n = 0; n < 2; ++n) { f32x4* p = (f32x4*)(rowp + bj * HALF + n * 16); *p = *p + acc[ai][bj][m][n]; } }
    }
};
template <int ACT  > struct EpiGated {
    static constexpr bool PERM = true;
    bf16_t* O; int ldo; int coloff; const float* ba; const float* bb;
    __device__ __forceinline__ void operator()(const f32x4 (&acc)[2][2][4][2], const Unit& u, int wr, int wc, int fr, int fq) const {
        const int row0 = u.pm * BM + wr * 64 + fr, cl = u.pn * HALF + wc * 32 + 8 * fq;
        float va[8], vb[8];
#pragma unroll
        for (int j = 0; j < 8; ++j) { va[j] = (ACT == 0) ? ba[cl + j] : 0.f; vb[j] = (ACT == 0) ? bb[cl + j] : 0.f; }
#pragma unroll
        for (int ai = 0; ai < 2; ++ai)
#pragma unroll
            for (int m = 0; m < 4; ++m) { bf16_t* rowp = O + (size_t)(row0 + ai * HALF + m * 16) * ldo + coloff + cl;
                float o[8];
#pragma unroll
                for (int n = 0; n < 2; ++n)
#pragma unroll
                    for (int j = 0; j < 4; ++j) { const float a = acc[ai][0][m][n][j] + va[4 * n + j], b = acc[ai][1][m][n][j] + vb[4 * n + j];
                        o[4 * n + j] = (ACT == 0) ? a * sigmoidf_(b) : siluf_(a) * b; }
                u32x4 w; w.x = cvt_pk_bf16(o[0], o[1]); w.y = cvt_pk_bf16(o[2], o[3]); w.z = cvt_pk_bf16(o[4], o[5]); w.w = cvt_pk_bf16(o[6], o[7]);
                *(u32x4*)rowp = w; asm volatile("" ::: "memory"); }
    }
};
struct EpiMoeOut {
    static constexpr bool PERM = true;
    bf16_t* O; const int* row_tok; const float* row_w;
    __device__ __forceinline__ void operator()(const f32x4 (&acc)[2][2][4][2], const Unit& u, int wr, int wc, int fr, int fq) const {
        const int row0 = u.pm * BM + wr * 64 + fr, col0 = u.pn * BM + wc * 32 + 8 * fq;
#pragma unroll
        for (int ai = 0; ai < 2; ++ai)
#pragma unroll
            for (int m = 0; m < 4; ++m) { const int row = row0 + ai * HALF + m * 16; const int ts = row_tok[row]; const float w = row_w[row];
                if (ts >= 0) { bf16_t* rowp = O + ((size_t)(ts & 1) * NTOK + (size_t)(ts >> 1)) * DM + col0;
#pragma unroll
                    for (int bj = 0; bj < 2; ++bj) { const f32x4 v0 = acc[ai][bj][m][0] * w, v1 = acc[ai][bj][m][1] * w;
                        u32x4 q; q.x = cvt_pk_bf16(v0[0], v0[1]); q.y = cvt_pk_bf16(v0[2], v0[3]); q.z = cvt_pk_bf16(v1[0], v1[1]); q.w = cvt_pk_bf16(v1[2], v1[3]);
                        *(u32x4*)(rowp + bj * HALF) = q; } } asm volatile("" ::: "memory"); }
    }
};
struct MoeOrder {
    int nN, G, c, K; const char* A; const char* B; size_t bstride; const int* tiles;
    __device__ bool next(int i, Unit& u) const {
        const int nrt = tiles[0]; const long L = (long)i * G + c; if (L >= (long)nrt * nN) return false;
        u.pm = (int)(L / nN); u.pn = (int)(L % nN); const int e = tiles[64 + u.pm];
        u.a = A + (size_t)u.pm * 256 * K * 2; u.b = B + (size_t)e * bstride + (size_t)u.pn * 256 * K * 2; return true;
    }
};
}

struct Params { const float* in[44]; float* out; unsigned char* ws; int ph_lo, ph_hi; };
enum { I_X = 0, I_NORM1, I_WIN, I_MCONVW, I_MCONVB, I_MDTB, I_MALOG, I_MD, I_MNORM, I_RMU, I_RW0, I_RW2, I_RA0, I_RA2, I_RG2, I_RKK, I_RKA, I_RRK, I_RLNW, I_RLNB,
       I_CKVN, I_CWUK, I_CWUV, I_RELB, I_SARE, I_SAIM, I_SBRE, I_SBIM, I_SCRE, I_SCIM, I_SD, I_SLOGDT, I_SGLUW, I_SGLUB, I_WOUT, I_NORM2, I_WRG, I_BRG, I_WRE, I_BRE,
       I_WGATE, I_WUP, I_WDOWN, I_FNORM };

typedef const float* const __attribute__((address_space(4)))* in_tab_t;
struct Frame {
    LAS unsigned char* lds; int tid, lane, wave, bid, G;
    in_tab_t in; float* out; unsigned char* ws; unsigned* ctl;
    volatile LAS int* misc;
};

__device__ __forceinline__ int q_pop(Frame& F, int qi) {
    __syncthreads();
    if (F.tid == 0) F.misc[0] = (int)__hip_atomic_fetch_add(F.ctl + CW_Q + 64 * qi, 1u, __ATOMIC_RELAXED, __HIP_MEMORY_SCOPE_AGENT);
    __syncthreads();
    return F.misc[0];
}

__device__ __forceinline__ const void* opaque_ptr(const void* p) { const unsigned long long v = (unsigned long long)p; unsigned lo = __builtin_amdgcn_readfirstlane((unsigned)v), hi = __builtin_amdgcn_readfirstlane((unsigned)(v >> 32));
    asm volatile("" : "+s"(lo), "+s"(hi)); return (const void*)(((unsigned long long)hi << 32) | lo); }
__device__ __forceinline__ Frame relocal(const Frame& G) { Frame F = G; asm volatile("" : "+v"(F.tid)); F.ws = (unsigned char*)opaque_ptr(F.ws); F.ctl = (unsigned*)(F.ws + WS_CTL); F.in = (in_tab_t)(unsigned long long)opaque_ptr((const void*)(unsigned long long)F.in); F.lane = F.tid & 63; F.wave = __builtin_amdgcn_readfirstlane(F.tid >> 6); return F; }
template <int K> __device__ __forceinline__ f32x4 mma_nt(const LAS bf16_t* A, int lda, const LAS bf16_t* Bt, int ldb, f32x4 acc, int lane) {
    const int r = lane & 15, g = lane >> 4;
#pragma unroll
    for (int k0 = 0; k0 < K; k0 += 32) {
        const bf16x8 a = *(const LAS bf16x8*)(A + r * lda + k0 + 8 * g);
        const bf16x8 b = *(const LAS bf16x8*)(Bt + r * ldb + k0 + 8 * g);
        acc = __builtin_amdgcn_mfma_f32_16x16x32_bf16(a, b, acc, 0, 0, 0);
    }
    return acc;
}

template <class ColMap> __device__ __forceinline__ void tr_tile(Frame& F, const float* src, int ldsrc, bf16_t* dst, int K, int k0, int n0, ColMap cm) {
    LAS float* tile = (LAS float*)F.lds;
    __syncthreads();
    { const int kk = F.tid >> 4, n4 = (F.tid & 15) * 4;
#pragma unroll
      for (int ps = 0; ps < 2; ++ps) { const int k = kk + 32 * ps; const int sc = cm(n0 + n4);
          f32x4 v = (f32x4){0.f, 0.f, 0.f, 0.f}; if (sc >= 0) v = *(const f32x4*)(src + (size_t)(k0 + k) * ldsrc + sc);
          tile[k * 65 + n4 + 0] = v[0]; tile[k * 65 + n4 + 1] = v[1]; tile[k * 65 + n4 + 2] = v[2]; tile[k * 65 + n4 + 3] = v[3]; } }
    __syncthreads();
    { const int n = F.tid >> 3, kc = F.tid & 7; float f[8];
#pragma unroll
      for (int j = 0; j < 8; ++j) f[j] = tile[(8 * kc + j) * 65 + n];
      u32x4 w; w.x = pk2(f[0], f[1]); w.y = pk2(f[2], f[3]); w.z = pk2(f[4], f[5]); w.w = pk2(f[6], f[7]);
      *(u32x4*)(dst + (size_t)(n0 + n) * K + k0 + 8 * kc) = w; }
}

struct CmIn { __device__ __forceinline__ int operator()(int n) const {
    if (n < 772) return n; if (n < UR) return -1; if (n < UR + 896) return 772 + (n - UR); if (n < UC) return -1;
    if (n < UC + 680) return 1668 + (n - UC); if (n < US) return -1; if (n < US + 256) return 2348 + (n - US); return -1; } };
struct CmId { __device__ __forceinline__ int operator()(int n) const { return n; } };
struct CmGlu { __device__ __forceinline__ int operator()(int n) const { const int pn = n >> 8, rr = n & 255; return rr < 128 ? 128 * pn + rr : 256 + 128 * pn + (rr - 128); } };
struct CmGateUp { int half; __device__ __forceinline__ int operator()(int n) const { return n; } };

__device__ __forceinline__ void phase_prologue(const Frame& F_) { Frame F = relocal(F_);
    for (int t = F.bid; t < 1984; t += F.G) {
        if (t < 1408) { const int l = t / 704, r = t % 704, kt = r / 44, nt = r % 44;
            tr_tile(F, F.in[I_WIN] + (size_t)l * DM * NIN, NIN, (bf16_t*)(F.ws + WS_WIN) + (size_t)l * NINP * DM, DM, kt * 64, nt * 64, CmIn()); }
        else if (t < 1920) { const int q = t - 1408, l = q / 256, r = q % 256, kt = r / 16, nt = r % 16;
            tr_tile(F, F.in[I_WOUT] + (size_t)l * DM * DM, DM, (bf16_t*)(F.ws + WS_WOUT) + (size_t)l * DM * DM, DM, kt * 64, nt * 64, CmId()); }
        else { const int q = t - 1920, l = q / 32, r = q % 32, kt = r / 8, nt = r % 8;
            tr_tile(F, F.in[I_SGLUW] + (size_t)l * 256 * 512, 512, (bf16_t*)(F.ws + WS_GLU) + (size_t)l * 512 * 256, 256, kt * 64, nt * 64, CmGlu()); }
    }
    for (int i = F.bid * NTHR + F.tid; i < 2 * 48 * 1024; i += F.G * NTHR) { const int l = i / 49152, r = i % 49152, o = r >> 10, k = r & 1023;
        float v = 0.f; if (o < 32) v = F.in[I_WRE][((size_t)l * DM + k) * 32 + o]; else if (o < 36) v = F.in[I_WRG][((size_t)l * DM + k) * 4 + (o - 32)];
        v *= F.in[I_NORM2][l * DM + k];
        const bf16_t hi = f2bf(v); const bf16_t lo = f2bf(v - bf2f(hi));
        bf16_t* w = (bf16_t*)(F.ws + WS_WRT) + (size_t)l * 2 * 49152; w[r] = hi; w[49152 + r] = lo; }
    for (int i = F.bid * NTHR + F.tid; i < 2048 + 65536; i += F.G * NTHR) {
        if (i < 2048) {
            const int l = i >> 10, gn = i & 1023, g = gn >> 6;
            float* tab = (float*)(F.ws + WS_S5TAB + (size_t)l * S5TAB_L);
            const float lre = fminf(F.in[I_SARE][l * 1024 + gn], -1e-4f), lim = F.in[I_SAIM][l * 1024 + gn];
            const float dt = expf(F.in[I_SLOGDT][l * 16 + g]);
            const float mag = expf(dt * lre); float sn, cs; sincosf(dt * lim, &sn, &cs);
            const float are = mag * cs, aim = mag * sn;
            const float den = lre * lre + lim * lim;
            const float fre = ((are - 1.0f) * lre + aim * lim) / den, fim = (aim * lre - (are - 1.0f) * lim) / den;
            tab[gn * 2] = are; tab[gn * 2 + 1] = aim;
            float pr = are, pi = aim;
#pragma unroll
            for (int s = 0; s < 6; ++s) { const float nr = pr * pr - pi * pi, ni = 2.0f * pr * pi; pr = nr; pi = ni; }
            tab[2048 + gn * 2] = pr; tab[2048 + gn * 2 + 1] = pi;
            const float* bre = F.in[I_SBRE] + ((size_t)l * 1024 + gn) * 16; const float* bim = F.in[I_SBIM] + ((size_t)l * 1024 + gn) * 16;
            for (int p = 0; p < 16; ++p) { tab[4096 + (gn * 16 + p) * 2] = fre * bre[p] - fim * bim[p]; tab[4096 + (gn * 16 + p) * 2 + 1] = fre * bim[p] + fim * bre[p]; }
        } else {
            const int j = i - 2048, l = j >> 15, r = j & 32767, gp = r >> 7, k = r & 127;
            bf16_t* cm = (bf16_t*)(F.ws + WS_S5TAB + (size_t)l * S5TAB_L + S5TAB_F);
            const float v = k < 64 ? F.in[I_SCRE][((size_t)l * 256 + gp) * 64 + k] : -F.in[I_SCIM][((size_t)l * 256 + gp) * 64 + (k - 64)];
            cm[r] = f2bf(v);
        }
    }
}

__device__ __forceinline__ void phase_norm(const Frame& F_, const float* xin, bool add_o, const float* w, int mode) { Frame F = relocal(F_);
    float* X = (float*)(F.ws + WS_X); bf16_t* H = (bf16_t*)(F.ws + WS_H); const bf16_t* O = (const bf16_t*)(F.ws + WS_U);
    for (int row = F.bid * 8 + F.wave; row < NTOK; row += F.G * 8) {
        f32x4 v[4]; float ss = 0.f;
#pragma unroll
        for (int j = 0; j < 4; ++j) { const int c = 4 * F.lane + 256 * j; v[j] = *(const f32x4*)(xin + (size_t)row * DM + c);
            if (add_o) { const u32x2 a = *(const u32x2*)(O + (size_t)row * DM + c), b = *(const u32x2*)(O + ((size_t)NTOK + row) * DM + c);
                v[j][0] += __uint_as_float(a.x << 16) + __uint_as_float(b.x << 16); v[j][1] += __uint_as_float(a.x & 0xffff0000u) + __uint_as_float(b.x & 0xffff0000u);
                v[j][2] += __uint_as_float(a.y << 16) + __uint_as_float(b.y << 16); v[j][3] += __uint_as_float(a.y & 0xffff0000u) + __uint_as_float(b.y & 0xffff0000u); }
            ss += v[j][0] * v[j][0] + v[j][1] * v[j][1] + v[j][2] * v[j][2] + v[j][3] * v[j][3]; }
        ss = wave_sum(ss);
        const float rstd = rsqrtf(ss * (1.0f / DM) + 1e-6f);
#pragma unroll
        for (int j = 0; j < 4; ++j) { const int c = 4 * F.lane + 256 * j; const f32x4 wv = *(const f32x4*)(w + c);
            if (mode == 2) { *(f32x4*)(F.out + (size_t)row * DM + c) = v[j] * rstd * wv; }
            else { *(f32x4*)(X + (size_t)row * DM + c) = v[j];
                u32x2 o; o.x = pk2(v[j][0] * rstd * wv[0], v[j][1] * rstd * wv[1]); o.y = pk2(v[j][2] * rstd * wv[2], v[j][3] * rstd * wv[3]);
                *(u32x2*)(H + (size_t)row * DM + c) = o; } }
    }
}

__device__ __forceinline__ void item_kv(const Frame& F_, int layer, int item) { Frame F = relocal(F_);
    const bf16_t* U = (const bf16_t*)(F.ws + WS_U);
    LAS bf16_t* Ab = (LAS bf16_t*)F.lds;
    LAS bf16_t* Bt = (LAS bf16_t*)(F.lds + 17408);
    const int t0 = item * 64;
    { const int tok = F.tid >> 3, part = F.tid & 7; const bf16_t* src = U + (size_t)(t0 + tok) * NINP + UC + 256 + 16 * part;
      float f[16]; { float a[8], b[8]; unpack8(*(const u32x4*)src, a); unpack8(*(const u32x4*)(src + 8), b);
#pragma unroll
        for (int j = 0; j < 8; ++j) { f[j] = a[j]; f[8 + j] = b[j]; } }
      float ss = 0.f;
#pragma unroll
      for (int j = 0; j < 16; ++j) ss += f[j] * f[j];
      ss = sum8(ss);
      const float rstd = rsqrtf(ss * (1.0f / 128.0f) + 1e-6f); const float* nw = F.in[I_CKVN] + layer * 128 + 16 * part;
#pragma unroll
      for (int j = 0; j < 16; j += 2) *(LAS unsigned*)(Ab + tok * 136 + 16 * part + j) = pk2(f[j] * rstd * nw[j], f[j + 1] * rstd * nw[j + 1]); }
    { const int n = F.tid >> 2, kq = F.tid & 3; const float* w = (n < 64 ? F.in[I_CWUK] : F.in[I_CWUV]) + (size_t)layer * 128 * 64 + (n & 63);
#pragma unroll 4
      for (int k = 32 * kq; k < 32 * kq + 32; ++k) Bt[n * 136 + k] = f2bf(w[(size_t)k * 64]); }
    if (F.tid < 256) { const int tok = F.tid >> 2, q = F.tid & 3;
        *(u32x4*)((bf16_t*)(F.ws + WS_KIDX) + (size_t)(t0 + tok) * 32 + 8 * q) = *(const u32x4*)(U + (size_t)(t0 + tok) * NINP + UC + 640 + 8 * q); }
    __syncthreads();
    const int mt = F.wave & 3, g = F.lane >> 4, r = F.lane & 15;
#pragma unroll
    for (int q = 0; q < 4; ++q) { const int nt = (F.wave >> 2) * 4 + q;
        f32x4 acc = (f32x4){0.f, 0.f, 0.f, 0.f};
        acc = mma_nt<128>(Ab + mt * 16 * 136, 136, Bt + nt * 16 * 136, 136, acc, F.lane);
        const int n = nt * 16 + r; bf16_t* dst = (bf16_t*)(F.ws + (n < 64 ? WS_K : WS_V));
#pragma unroll
        for (int i = 0; i < 4; ++i) dst[(size_t)(t0 + mt * 16 + 4 * g + i) * 64 + (n & 63)] = f2bf(acc[i]); }
}

constexpr int MB_CG = 0, MB_BG = 18432, MB_BT = 36864, MB_XT = 55296, MB_M = 92160, MB_S0 = 101376, MB_DT = 110592, MB_AC = 111616, MB_RS = 112640;
template <int STAGE> __device__ __forceinline__ void item_mamba(const Frame& F_, int layer, int item) { Frame F = relocal(F_);
    const bf16_t* U = (const bf16_t*)(F.ws + WS_U);
    const int b = item >> 6, c = item & 63, l0 = c * 64; const size_t T0 = (size_t)b * SEQ + l0;
    LAS bf16_t* Cg = (LAS bf16_t*)(F.lds + MB_CG); LAS bf16_t* Bg = (LAS bf16_t*)(F.lds + MB_BG); LAS bf16_t* BT = (LAS bf16_t*)(F.lds + MB_BT);
    LAS bf16_t* XT = (LAS bf16_t*)(F.lds + MB_XT); LAS bf16_t* Mb = (LAS bf16_t*)(F.lds + MB_M); LAS bf16_t* S0 = (LAS bf16_t*)(F.lds + MB_S0);
    LAS float* dts = (LAS float*)(F.lds + MB_DT); LAS float* acs = (LAS float*)(F.lds + MB_AC); LAS float* rs = (LAS float*)(F.lds + MB_RS);
    if (F.tid < 256) { const int l = F.tid >> 2, h = F.tid & 3;
        const float raw = bf2f(U[(T0 + l) * NINP + UM + 768 + h]) + F.in[I_MDTB][layer * 4 + h];
        const float dt = softplusf_(raw); dts[l * 4 + h] = dt; acs[l * 4 + h] = -__expf(F.in[I_MALOG][layer * 4 + h]) * dt; }
    if (F.tid < 64) rs[F.tid] = 0.f;
    __syncthreads();
    float mycum = 0.f;
    if (F.tid < 256) { const int l = F.tid >> 2, h = F.tid & 3; for (int s = 0; s <= l; ++s) mycum += acs[s * 4 + h]; }
    __syncthreads();
    if (F.tid < 256) acs[F.tid] = mycum;
    __syncthreads();
    { const int ch8 = F.tid & 63, tg = F.tid >> 6, c0 = ch8 * 8;
      float wv[4][8], bv[8];
#pragma unroll
      for (int j = 0; j < 8; ++j) { bv[j] = F.in[I_MCONVB][layer * 512 + c0 + j];
#pragma unroll
          for (int k = 0; k < 4; ++k) wv[k][j] = F.in[I_MCONVW][(layer * 4 + k) * 512 + c0 + j]; }
      float win[3][8];
#pragma unroll
      for (int k = 0; k < 3; ++k) { const int l = l0 + tg * 8 - 3 + k;
          if (l >= 0) unpack8(*(const u32x4*)(U + ((size_t)b * SEQ + l) * NINP + UM + 256 + c0), win[k]);
          else {
#pragma unroll
              for (int j = 0; j < 8; ++j) win[k][j] = 0.f; } }
#pragma unroll 1
      for (int i = 0; i < 8; ++i) { const int l = tg * 8 + i; float cur[8]; unpack8(*(const u32x4*)(U + (T0 + l) * NINP + UM + 256 + c0), cur);
          float o[8];
#pragma unroll
          for (int j = 0; j < 8; ++j) { o[j] = siluf_(bv[j] + wv[0][j] * win[0][j] + wv[1][j] * win[1][j] + wv[2][j] * win[2][j] + wv[3][j] * cur[j]);
              win[0][j] = win[1][j]; win[1][j] = win[2][j]; win[2][j] = cur[j]; }
          if (c0 < 256) { const int h = c0 >> 6, p0 = c0 & 63; float sc = dts[l * 4 + h]; if (STAGE == 1) sc *= __expf(acs[63 * 4 + h] - acs[l * 4 + h]);
#pragma unroll
              for (int j = 0; j < 8; ++j) XT[(h * 64 + p0 + j) * 72 + l] = f2bf(o[j] * sc); }
          else if (c0 < 384) { const int g = (c0 - 256) >> 6, n0 = (c0 - 256) & 63;
              if (STAGE == 1) {
#pragma unroll
                  for (int j = 0; j < 8; ++j) BT[(g * 64 + n0 + j) * 72 + l] = f2bf(o[j]); }
              else { u32x4 w; w.x = pk2(o[0], o[1]); w.y = pk2(o[2], o[3]); w.z = pk2(o[4], o[5]); w.w = pk2(o[6], o[7]); *(LAS u32x4*)(Bg + (g * 64 + l) * 72 + n0) = w; } }
          else if (STAGE == 2) { const int g = (c0 - 384) >> 6, n0 = (c0 - 384) & 63;
              u32x4 w; w.x = pk2(o[0], o[1]); w.y = pk2(o[2], o[3]); w.z = pk2(o[4], o[5]); w.w = pk2(o[6], o[7]); *(LAS u32x4*)(Cg + (g * 64 + l) * 72 + n0) = w; } } }
    __syncthreads();
    const int g4 = F.lane >> 4, r16 = F.lane & 15;
    if (STAGE == 1) {
        float* MST = (float*)(F.ws + WS_MST) + ((size_t)(b * 64 + c) * 4) * 4096;
#pragma unroll
        for (int q = 0; q < 8; ++q) { const int tix = F.wave * 8 + q, h = tix >> 4, mt = (tix >> 2) & 3, nt = tix & 3;
            f32x4 acc = (f32x4){0.f, 0.f, 0.f, 0.f};
            acc = mma_nt<64>(XT + (h * 64 + mt * 16) * 72, 72, BT + ((h >> 1) * 64 + nt * 16) * 72, 72, acc, F.lane);
#pragma unroll
            for (int i = 0; i < 4; ++i) MST[(size_t)h * 4096 + (mt * 16 + 4 * g4 + i) * 64 + nt * 16 + r16] = acc[i]; }
        if (F.tid < 4) ((float*)(F.ws + WS_MDEC))[(b * 64 + c) * 4 + F.tid] = __expf(acs[63 * 4 + F.tid]);
    } else {
        const int mt = F.wave & 3, nh = F.wave >> 2;
        const float* MST = (const float*)(F.ws + WS_MST) + ((size_t)(b * 64 + c) * 4) * 4096;
        f32x4 G[2], yv[4][2];
#pragma unroll
        for (int h = 0; h < 4; ++h) {
            const int g = h >> 1;
            { const float* src = MST + (size_t)h * 4096 + F.tid * 8; const f32x4 a = *(const f32x4*)src, bq = *(const f32x4*)(src + 4);
              u32x4 w; w.x = pk2(a[0], a[1]); w.y = pk2(a[2], a[3]); w.z = pk2(bq[0], bq[1]); w.w = pk2(bq[2], bq[3]);
              *(LAS u32x4*)(S0 + (F.tid >> 3) * 72 + (F.tid & 7) * 8) = w; }
            if ((h & 1) == 0) {
#pragma unroll
                for (int q = 0; q < 2; ++q) { G[q] = (f32x4){0.f, 0.f, 0.f, 0.f};
                    G[q] = mma_nt<64>(Cg + (g * 64 + mt * 16) * 72, 72, Bg + (g * 64 + (2 * nh + q) * 16) * 72, 72, G[q], F.lane); } }
#pragma unroll
            for (int q = 0; q < 2; ++q) { const int s = (2 * nh + q) * 16 + r16; const float as = acs[s * 4 + h];
#pragma unroll
                for (int i = 0; i < 4; ++i) { const int l = mt * 16 + 4 * g4 + i; const float v = (s <= l) ? G[q][i] * __expf(acs[l * 4 + h] - as) : 0.f;
                    Mb[l * 72 + s] = f2bf(v); } }
            __syncthreads();
#pragma unroll
            for (int q = 0; q < 2; ++q) { const int nt = 2 * nh + q;
                f32x4 yd = (f32x4){0.f, 0.f, 0.f, 0.f}, yo = (f32x4){0.f, 0.f, 0.f, 0.f};
                yd = mma_nt<64>(Mb + mt * 16 * 72, 72, XT + (h * 64 + nt * 16) * 72, 72, yd, F.lane);
                yo = mma_nt<64>(Cg + (g * 64 + mt * 16) * 72, 72, S0 + nt * 16 * 72, 72, yo, F.lane);
                const int p = nt * 16 + r16; const float dsk = F.in[I_MD][layer * 4 + h];
#pragma unroll
                for (int i = 0; i < 4; ++i) { const int l = mt * 16 + 4 * g4 + i;
                    const float xs = bf2f(XT[(h * 64 + p) * 72 + l]) / dts[l * 4 + h];
                    yv[h][q][i] = yd[i] + yo[i] * __expf(acs[l * 4 + h]) + dsk * xs; } }
            __syncthreads();
        }
        float part[4] = {0.f, 0.f, 0.f, 0.f};
#pragma unroll
        for (int h = 0; h < 4; ++h)
#pragma unroll
            for (int q = 0; q < 2; ++q) { const int ch = h * 64 + (2 * nh + q) * 16 + r16;
#pragma unroll
                for (int i = 0; i < 4; ++i) { const int l = mt * 16 + 4 * g4 + i; const float z = bf2f(U[(T0 + l) * NINP + UM + ch]);
                    const float v = yv[h][q][i] * siluf_(z); yv[h][q][i] = v; part[i] += v * v; } }
#pragma unroll
        for (int i = 0; i < 4; ++i) { const float s = sum16(part[i]); if (r16 == 0) atomicAdd((float*)(rs + mt * 16 + 4 * g4 + i), s); }
        __syncthreads();
        bf16_t* Y = (bf16_t*)(F.ws + WS_H);
#pragma unroll
        for (int i = 0; i < 4; ++i) { const int l = mt * 16 + 4 * g4 + i; const float rstd = rsqrtf(rs[l] * (1.0f / 256.0f) + 1e-6f);
#pragma unroll
            for (int h = 0; h < 4; ++h)
#pragma unroll
                for (int q = 0; q < 2; ++q) { const int ch = h * 64 + (2 * nh + q) * 16 + r16;
                    Y[(T0 + l) * DM + ch] = f2bf(yv[h][q][i] * rstd * F.in[I_MNORM][layer * 256 + ch]); } }
    }
}
__device__ __forceinline__ void item_mamba_carry(const Frame& F_, int item) { Frame F = relocal(F_);
    const int b = item >> 2, h = item & 3;
    float* MST = (float*)(F.ws + WS_MST); const float* MD = (const float*)(F.ws + WS_MDEC);
    float s[8];
#pragma unroll
    for (int j = 0; j < 8; ++j) s[j] = 0.f;
    for (int c = 0; c < 64; ++c) { float* p = MST + ((size_t)(b * 64 + c) * 4 + h) * 4096 + F.tid * 8; const float d = MD[(b * 64 + c) * 4 + h];
        const f32x4 a = *(f32x4*)p, q = *(f32x4*)(p + 4);
        *(f32x4*)p = (f32x4){s[0], s[1], s[2], s[3]}; *(f32x4*)(p + 4) = (f32x4){s[4], s[5], s[6], s[7]};
        s[0] = s[0] * d + a[0]; s[1] = s[1] * d + a[1]; s[2] = s[2] * d + a[2]; s[3] = s[3] * d + a[3];
        s[4] = s[4] * d + q[0]; s[5] = s[5] * d + q[1]; s[6] = s[6] * d + q[2]; s[7] = s[7] * d + q[3]; }
}

template <int STAGE> __device__ __forceinline__ void item_s5(const Frame& F_, int layer, int item) { Frame F = relocal(F_);
    const bf16_t* U = (const bf16_t*)(F.ws + WS_U);
    const int b = item >> 6, c = item & 63; const size_t T0 = (size_t)b * SEQ + c * 64;
    LAS float* us = (LAS float*)F.lds; LAS bf16_t* Hs = (LAS bf16_t*)(F.lds + 65536);
    const float* tab = (const float*)(F.ws + WS_S5TAB + (size_t)layer * S5TAB_L);
    { const int tok = F.tid >> 3, part = F.tid & 7;
#pragma unroll
      for (int q = 0; q < 4; ++q) { float f[8]; unpack8(*(const u32x4*)(U + (T0 + tok) * NINP + US + 32 * part + 8 * q), f);
          *(LAS f32x4*)(us + tok * 256 + 32 * part + 8 * q) = (f32x4){f[0], f[1], f[2], f[3]}; *(LAS f32x4*)(us + tok * 256 + 32 * part + 8 * q + 4) = (f32x4){f[4], f[5], f[6], f[7]}; } }
    const int g = F.tid >> 5, n0 = F.tid & 31, gn0 = g * 64 + n0, gn1 = gn0 + 32;
    float bb0[32], bb1[32];
#pragma unroll
    for (int j = 0; j < 32; j += 4) { const f32x4 a = *(const f32x4*)(tab + 4096 + gn0 * 32 + j), bq = *(const f32x4*)(tab + 4096 + gn1 * 32 + j);
        bb0[j] = a[0]; bb0[j + 1] = a[1]; bb0[j + 2] = a[2]; bb0[j + 3] = a[3]; bb1[j] = bq[0]; bb1[j + 1] = bq[1]; bb1[j + 2] = bq[2]; bb1[j + 3] = bq[3]; }
    const float a0r = tab[gn0 * 2], a0i = tab[gn0 * 2 + 1], a1r = tab[gn1 * 2], a1i = tab[gn1 * 2 + 1];
    float* ST = (float*)(F.ws + WS_S5ST) + (size_t)(b * 64 + c) * 2048;
    float h0r = 0.f, h0i = 0.f, h1r = 0.f, h1i = 0.f;
    if (STAGE == 2) { h0r = ST[gn0 * 2]; h0i = ST[gn0 * 2 + 1]; h1r = ST[gn1 * 2]; h1i = ST[gn1 * 2 + 1]; }
    bf16x8 cf[2][4];
    if (STAGE == 2) { const bf16_t* cm = (const bf16_t*)(F.ws + WS_S5TAB + (size_t)layer * S5TAB_L + S5TAB_F);
#pragma unroll
        for (int gg = 0; gg < 2; ++gg)
#pragma unroll
            for (int ks = 0; ks < 4; ++ks) cf[gg][ks] = *(const bf16x8*)(cm + ((size_t)((2 * F.wave + gg) * 16 + (F.lane & 15))) * 128 + 32 * ks + 8 * (F.lane >> 4)); }
    __syncthreads();
#pragma unroll 1
    for (int lb = 0; lb < 4; ++lb) {
#pragma unroll 2
        for (int li = 0; li < 16; ++li) { const int l = lb * 16 + li;
            float uu[16];
#pragma unroll
            for (int q = 0; q < 4; ++q) { const f32x4 v = *(const LAS f32x4*)(us + l * 256 + g * 16 + 4 * q); uu[4 * q] = v[0]; uu[4 * q + 1] = v[1]; uu[4 * q + 2] = v[2]; uu[4 * q + 3] = v[3]; }
            float b0r = 0.f, b0i = 0.f, b1r = 0.f, b1i = 0.f;
#pragma unroll
            for (int p = 0; p < 16; ++p) { b0r += bb0[2 * p] * uu[p]; b0i += bb0[2 * p + 1] * uu[p]; b1r += bb1[2 * p] * uu[p]; b1i += bb1[2 * p + 1] * uu[p]; }
            { const float nr = a0r * h0r - a0i * h0i + b0r, ni = a0r * h0i + a0i * h0r + b0i; h0r = nr; h0i = ni; }
            { const float nr = a1r * h1r - a1i * h1i + b1r, ni = a1r * h1i + a1i * h1r + b1i; h1r = nr; h1i = ni; }
            if (STAGE == 2) { LAS bf16_t* hp = Hs + li * 2056 + g * 128; hp[n0] = f2bf(h0r); hp[64 + n0] = f2bf(h0i); hp[n0 + 32] = f2bf(h1r); hp[96 + n0] = f2bf(h1i); }
        }
        if (STAGE == 2) {
            __syncthreads();
            bf16_t* YS = (bf16_t*)(F.ws + WS_MOE + YSG_OFF);
#pragma unroll
            for (int gg = 0; gg < 2; ++gg) { const int gq = 2 * F.wave + gg; f32x4 acc = (f32x4){0.f, 0.f, 0.f, 0.f};
#pragma unroll
                for (int ks = 0; ks < 4; ++ks) { const bf16x8 a = *(const LAS bf16x8*)(Hs + (F.lane & 15) * 2056 + gq * 128 + 32 * ks + 8 * (F.lane >> 4));
                    acc = __builtin_amdgcn_mfma_f32_16x16x32_bf16(a, cf[gg][ks], acc, 0, 0, 0); }
                const int ch = gq * 16 + (F.lane & 15); const float dsk = F.in[I_SD][layer * 256 + ch];
#pragma unroll
                for (int i = 0; i < 4; ++i) { const int l = lb * 16 + 4 * (F.lane >> 4) + i; const float y = acc[i] + dsk * us[l * 256 + ch];
                    YS[(T0 + l) * 256 + ch] = f2bf(gelu_tanh(y)); } }
            __syncthreads();
        }
    }
    if (STAGE == 1) { ST[gn0 * 2] = h0r; ST[gn0 * 2 + 1] = h0i; ST[gn1 * 2] = h1r; ST[gn1 * 2 + 1] = h1i; }
}
__device__ __forceinline__ void item_s5_carry(const Frame& F_, int layer, int b) { Frame F = relocal(F_);
    const float* tab = (const float*)(F.ws + WS_S5TAB + (size_t)layer * S5TAB_L) + 2048;
    float* ST = (float*)(F.ws + WS_S5ST) + (size_t)b * 64 * 2048;
#pragma unroll
    for (int q = 0; q < 2; ++q) { const int gn = F.tid + 512 * q; const float pr = tab[gn * 2], pi = tab[gn * 2 + 1]; float hr = 0.f, hi = 0.f;
        for (int c = 0; c < 64; ++c) { float* p = ST + (size_t)c * 2048 + gn * 2; const float tr = p[0], ti = p[1]; p[0] = hr; p[1] = hi;
            const float nr = pr * hr - pi * hi + tr, ni = pr * hi + pi * hr + ti; hr = nr; hi = ni; } }
}

constexpr int RB_LD = 72;
constexpr int RW_R = 0, RW_K = 16384, RW_V = 32768, RW_W = 49152, RW_A = 65536, RW_B = 81920;
constexpr int R3_G = 49152, R3_O = 65536, R3_TILES = 81920, R3_BON = 147456;
template <int STAGE> __device__ __forceinline__ void rwkv_prep(const Frame& F_, int layer, int b, int h, int c) { Frame F = relocal(F_);
    const bf16_t* U = (const bf16_t*)(F.ws + WS_U);
    const int l0 = c * 64; const size_t T0 = (size_t)b * SEQ + l0;
    LAS float* Rr = (LAS float*)(F.lds + RW_R); LAS float* Kk = (LAS float*)(F.lds + RW_K); LAS float* Vv = (LAS float*)(F.lds + RW_V); LAS float* Ww = (LAS float*)(F.lds + RW_W);
    LAS float* Aa = (LAS float*)(F.lds + (STAGE == 1 ? RW_A : R3_O)); LAS float* Bb = (LAS float*)(F.lds + RW_B); LAS float* Gg = (LAS float*)(F.lds + R3_G); LAS float* BON = (LAS float*)(F.lds + R3_BON);
    LAS bf16_t* TWb = (LAS bf16_t*)(F.lds + 98304); LAS bf16_t* DAb = (LAS bf16_t*)(F.lds + (STAGE == 1 ? 103424 : 118784)); LAS bf16_t* SGb = (LAS bf16_t*)(F.lds + 123904);
    LAS bf16_t* w2T = (LAS bf16_t*)(F.lds + 108544); LAS bf16_t* a2T = (LAS bf16_t*)(F.lds + (STAGE == 1 ? 113664 : 133120)); LAS bf16_t* g2T = (LAS bf16_t*)(F.lds + 138240);
    const float* mu = F.in[I_RMU] + layer * 896;
    { const int tok = F.tid >> 3, p8 = F.tid & 7; const bool first = (l0 + tok == 0);
      const bf16_t* cur = U + (T0 + tok) * NINP + UR; const bf16_t* prv = cur - NINP;
#pragma unroll
      for (int sec = 0; sec < 3; ++sec) { const int co = sec * 256 + h * 64 + 8 * p8; float av[8], pq[8]; unpack8(*(const u32x4*)(cur + co), av);
          if (first) {
#pragma unroll
              for (int j = 0; j < 8; ++j) pq[j] = 0.f; } else unpack8(*(const u32x4*)(prv + co), pq);
          const f32x4 m0 = *(const f32x4*)(mu + co), m1 = *(const f32x4*)(mu + co + 4);
          LAS float* dst = (sec == 0 ? Rr : sec == 1 ? Kk : Vv) + tok * 64 + 8 * p8;
          *(LAS f32x4*)dst = (f32x4){av[0] + m0[0] * (pq[0] - av[0]), av[1] + m0[1] * (pq[1] - av[1]), av[2] + m0[2] * (pq[2] - av[2]), av[3] + m0[3] * (pq[3] - av[3])};
          *(LAS f32x4*)(dst + 4) = (f32x4){av[4] + m1[0] * (pq[4] - av[4]), av[5] + m1[1] * (pq[5] - av[5]), av[6] + m1[2] * (pq[6] - av[6]), av[7] + m1[3] * (pq[7] - av[7])}; }
      { const int co = 768 + (STAGE == 1 ? 0 : 32) + 4 * p8;
        const u32x2 cv = *(const u32x2*)(cur + co); u32x2 pv = (u32x2){0u, 0u}; if (!first) pv = *(const u32x2*)(prv + co);
        const f32x4 m0 = *(const f32x4*)(mu + co);
        float x[4] = {__uint_as_float(cv.x << 16), __uint_as_float(cv.x & 0xffff0000u), __uint_as_float(cv.y << 16), __uint_as_float(cv.y & 0xffff0000u)};
        const float y[4] = {__uint_as_float(pv.x << 16), __uint_as_float(pv.x & 0xffff0000u), __uint_as_float(pv.y << 16), __uint_as_float(pv.y & 0xffff0000u)};
#pragma unroll
        for (int j = 0; j < 4; ++j) { x[j] = x[j] + m0[j] * (y[j] - x[j]); if (STAGE == 1) x[j] = tanhf_(x[j]); }
        *(LAS u32x2*)((STAGE == 1 ? TWb : DAb) + tok * 40 + 4 * p8) = (u32x2){pk2(x[0], x[1]), pk2(x[2], x[3])}; }
      if (STAGE == 1) { const int co = 800 + 4 * p8;
        const u32x2 cv = *(const u32x2*)(cur + co); u32x2 pv = (u32x2){0u, 0u}; if (!first) pv = *(const u32x2*)(prv + co);
        const f32x4 m0 = *(const f32x4*)(mu + co);
        float x[4] = {__uint_as_float(cv.x << 16), __uint_as_float(cv.x & 0xffff0000u), __uint_as_float(cv.y << 16), __uint_as_float(cv.y & 0xffff0000u)};
        const float y[4] = {__uint_as_float(pv.x << 16), __uint_as_float(pv.x & 0xffff0000u), __uint_as_float(pv.y << 16), __uint_as_float(pv.y & 0xffff0000u)};
#pragma unroll
        for (int j = 0; j < 4; ++j) x[j] = x[j] + m0[j] * (y[j] - x[j]);
        *(LAS u32x2*)(DAb + tok * 40 + 4 * p8) = (u32x2){pk2(x[0], x[1]), pk2(x[2], x[3])}; }
      if (STAGE == 3) { const int co = 832 + 8 * p8; float av[8], pq[8]; unpack8(*(const u32x4*)(cur + co), av);
          if (first) {
#pragma unroll
              for (int j = 0; j < 8; ++j) pq[j] = 0.f; } else unpack8(*(const u32x4*)(prv + co), pq);
          const f32x4 m0 = *(const f32x4*)(mu + co), m1 = *(const f32x4*)(mu + co + 4); float x[8];
#pragma unroll
          for (int j = 0; j < 8; ++j) x[j] = sigmoidf_(av[j] + (j < 4 ? m0[j] : m1[j - 4]) * (pq[j] - av[j]));
          *(LAS u32x4*)(SGb + tok * RB_LD + 8 * p8) = (u32x4){pk2(x[0], x[1]), pk2(x[2], x[3]), pk2(x[4], x[5]), pk2(x[6], x[7])}; } }
    { const int ch = F.tid & 63, part = F.tid >> 6;
      if (STAGE == 1) { const float* w2 = F.in[I_RW2] + ((size_t)layer * 32 + 4 * part) * 256 + h * 64 + ch;
          *(LAS u32x2*)(w2T + ch * 40 + 4 * part) = (u32x2){pk2(w2[0], w2[256]), pk2(w2[512], w2[768])}; }
      { const float* a2 = F.in[I_RA2] + ((size_t)layer * 32 + 4 * part) * 256 + h * 64 + ch;
          *(LAS u32x2*)(a2T + ch * 40 + 4 * part) = (u32x2){pk2(a2[0], a2[256]), pk2(a2[512], a2[768])}; }
      if (STAGE == 3) { const float* g2 = F.in[I_RG2] + ((size_t)layer * 64 + 8 * part) * 256 + h * 64 + ch;
          *(LAS u32x4*)(g2T + ch * RB_LD + 8 * part) = (u32x4){pk2(g2[0], g2[256]), pk2(g2[512], g2[768]), pk2(g2[1024], g2[1280]), pk2(g2[1536], g2[1792])}; } }
    __syncthreads();
    { const int lane = F.lane, mt = F.wave >> 1, nt0 = 2 * (F.wave & 1), r = lane & 15, g4 = lane >> 4; const f32x4 zero4 = (f32x4){0.f, 0.f, 0.f, 0.f};
#pragma unroll
      for (int q = 0; q < 2; ++q) { const int nt = nt0 + q, ch = 16 * nt + r, cg = layer * 256 + h * 64 + ch;
          if (STAGE == 1) { const f32x4 wl = mma_nt<32>(TWb + 16 * mt * 40, 40, w2T + 16 * nt * 40, 40, zero4, lane); const float w0 = F.in[I_RW0][cg];
#pragma unroll
              for (int i = 0; i < 4; ++i) { const float x = w0 + wl[i]; const float wlog = -__logf(1.0f + __expf(-x)) - 0.5f; Ww[(16 * mt + 4 * g4 + i) * 64 + ch] = __expf(-__expf(wlog)); } }
          { const f32x4 al = mma_nt<32>(DAb + 16 * mt * 40, 40, a2T + 16 * nt * 40, 40, zero4, lane); const float a0 = F.in[I_RA0][cg];
#pragma unroll
              for (int i = 0; i < 4; ++i) Aa[(16 * mt + 4 * g4 + i) * 64 + ch] = sigmoidf_(a0 + al[i]); }
          if (STAGE == 3) { const f32x4 gv = mma_nt<64>(SGb + 16 * mt * RB_LD, RB_LD, g2T + 16 * nt * RB_LD, RB_LD, zero4, lane);
#pragma unroll
              for (int i = 0; i < 4; ++i) Gg[(16 * mt + 4 * g4 + i) * 64 + ch] = gv[i]; } } }
    __syncthreads();
    { const int j = F.lane, tq = F.wave, cg = layer * 256 + h * 64 + j;
      const float kkw = F.in[I_RKK][cg], kaw = F.in[I_RKA][cg], rk = F.in[I_RRK][cg];
#pragma unroll 2
      for (int i8 = 0; i8 < 8; ++i8) { const int t = tq + 8 * i8;
          const float a = Aa[t * 64 + j]; const float kraw = Kk[t * 64 + j]; const float kp = kraw * (1.0f + (a - 1.0f) * kaw);
          Kk[t * 64 + j] = kp;
          if (STAGE == 1) { const float kkv = kraw * kkw; const float ss = wave_sum(kkv * kkv); const float kkn = kkv * rsqrtf(fmaxf(ss, 1e-24f)); Aa[t * 64 + j] = -kkn; Bb[t * 64 + j] = kkn * a; }
          if (STAGE == 3) { const float bo = wave_sum(Rr[t * 64 + j] * kp * rk); if (j == 0) BON[t] = bo; } } }
    __syncthreads();
}
constexpr int RB_AT = 98304, RB_ATT = RB_AT + 9216, RB_BT = RB_ATT + 9216, RB_BTT = RB_BT + 9216, RB_KT = RB_BTT + 9216, RB_RT = RB_KT + 9216, RB_VT = RB_RT + 9216, RB_GC = RB_VT + 9216;
constexpr int RX_X = 0, RX_XT = 9216, RX_TB = 18432, RX_M = 27648, RX_NRT = 36864, RX_G1T = 46080, RX_G2T = 55296, RX_QT = 64512;
__device__ __forceinline__ void st_tile(LAS bf16_t* dst, int mt, int nt, const f32x4 v, int lane) {
    const int r = lane & 15, g = lane >> 4;
#pragma unroll
    for (int i = 0; i < 4; ++i) dst[(16 * mt + 4 * g + i) * RB_LD + 16 * nt + r] = f2bf(v[i]);
}
__device__ __forceinline__ void st_tile_t(LAS bf16_t* dst, int mt, int nt, const f32x4 v, int lane) {
    const int r = lane & 15, g = lane >> 4; u32x2 w; w.x = pk2(v[0], v[1]); w.y = pk2(v[2], v[3]);
    *(LAS u32x2*)(dst + (16 * nt + r) * RB_LD + 16 * mt + 4 * g) = w;
}
__device__ __forceinline__ void item_rwkv1(const Frame& F_, int layer, int item) { Frame F = relocal(F_);
    const int b = item >> 8, h = (item >> 6) & 3, c = item & 63;
    rwkv_prep<1>(F, layer, b, h, c);
    LAS float* Rr = (LAS float*)(F.lds + RW_R); LAS float* Kk = (LAS float*)(F.lds + RW_K); LAS float* Vv = (LAS float*)(F.lds + RW_V); LAS float* Ww = (LAS float*)(F.lds + RW_W);
    LAS float* Aa = (LAS float*)(F.lds + RW_A); LAS float* Bb = (LAS float*)(F.lds + RW_B);
    LAS bf16_t* At = (LAS bf16_t*)(F.lds + RB_AT); LAS bf16_t* AtT = (LAS bf16_t*)(F.lds + RB_ATT); LAS bf16_t* Bt = (LAS bf16_t*)(F.lds + RB_BT); LAS bf16_t* BtT = (LAS bf16_t*)(F.lds + RB_BTT);
    LAS bf16_t* Kt = (LAS bf16_t*)(F.lds + RB_KT); LAS bf16_t* Rt = (LAS bf16_t*)(F.lds + RB_RT); LAS bf16_t* VT = (LAS bf16_t*)(F.lds + RB_VT); LAS float* gC = (LAS float*)(F.lds + RB_GC);
    LAS bf16_t* X = (LAS bf16_t*)(F.lds + RX_X); LAS bf16_t* XT = (LAS bf16_t*)(F.lds + RX_XT); LAS bf16_t* Tb = (LAS bf16_t*)(F.lds + RX_TB); LAS bf16_t* Mm = (LAS bf16_t*)(F.lds + RX_M);
    LAS bf16_t* NrT = (LAS bf16_t*)(F.lds + RX_NRT); LAS bf16_t* G1T = (LAS bf16_t*)(F.lds + RX_G1T); LAS bf16_t* G2T = (LAS bf16_t*)(F.lds + RX_G2T); LAS bf16_t* QT = (LAS bf16_t*)(F.lds + RX_QT);
    { const int k = F.tid & 63, part = F.tid >> 6; float g = 1.0f;
      for (int t = 0; t < 8 * part; ++t) g *= Ww[t * 64 + k];
#pragma unroll
      for (int i = 0; i < 8; ++i) { const int t = 8 * part + i; const float gp = g; g *= Ww[t * 64 + k]; const float ig = 1.0f / g;
          const bf16_t av = f2bf(Aa[t * 64 + k] * gp), bv = f2bf(Bb[t * 64 + k] * ig);
          At[t * RB_LD + k] = av; AtT[k * RB_LD + t] = av; Bt[t * RB_LD + k] = bv; BtT[k * RB_LD + t] = bv;
          Kt[t * RB_LD + k] = f2bf(Kk[t * 64 + k] * ig); Rt[t * RB_LD + k] = f2bf(Rr[t * 64 + k] * g); VT[k * RB_LD + t] = f2bf(Vv[t * 64 + k]); }
      if (part == 7) gC[k] = g; }
    __syncthreads();
    const int lane = F.lane, mt = F.wave >> 1, nt0 = 2 * (F.wave & 1), r = lane & 15, g4 = lane >> 4;
    const f32x4 zero4 = (f32x4){0.f, 0.f, 0.f, 0.f};
    f32x4 Tacc[2];
#pragma unroll
    for (int q = 0; q < 2; ++q) { const int nt = nt0 + q;
        f32x4 n = mma_nt<64>(Bt + 16 * mt * RB_LD, RB_LD, At + 16 * nt * RB_LD, RB_LD, zero4, lane);
        f32x4 m = mma_nt<64>(Kt + 16 * mt * RB_LD, RB_LD, At + 16 * nt * RB_LD, RB_LD, zero4, lane);
        f32x4 nr = mma_nt<64>(Rt + 16 * mt * RB_LD, RB_LD, Bt + 16 * nt * RB_LD, RB_LD, zero4, lane);
#pragma unroll
        for (int i = 0; i < 4; ++i) { const int row = 16 * mt + 4 * g4 + i, col = 16 * nt + r;
            n[i] = (row < col) ? n[i] : 0.f; m[i] = (row < col) ? m[i] : 0.f; nr[i] = (col <= row) ? nr[i] : 0.f;
            Tacc[q][i] = n[i] + (row == col ? 1.0f : 0.f); }
        st_tile(X, mt, nt, n, lane); st_tile_t(XT, mt, nt, n, lane); st_tile(Tb, mt, nt, Tacc[q], lane); st_tile(Mm, mt, nt, m, lane); st_tile(NrT, mt, nt, nr, lane); }
    __syncthreads();
#pragma unroll 1
    for (int it = 0; it < 6; ++it) {
        f32x4 x2[2];
#pragma unroll
        for (int q = 0; q < 2; ++q) { const int nt = nt0 + q;
            if (it > 0) Tacc[q] = mma_nt<64>(Tb + 16 * mt * RB_LD, RB_LD, XT + 16 * nt * RB_LD, RB_LD, Tacc[q], lane);
            x2[q] = zero4; if (it < 5) x2[q] = mma_nt<64>(X + 16 * mt * RB_LD, RB_LD, XT + 16 * nt * RB_LD, RB_LD, zero4, lane); }
        __syncthreads();
#pragma unroll
        for (int q = 0; q < 2; ++q) { const int nt = nt0 + q;
            if (it > 0) st_tile(Tb, mt, nt, Tacc[q], lane);
            if (it < 5) { st_tile(X, mt, nt, x2[q], lane); st_tile_t(XT, mt, nt, x2[q], lane); } }
        __syncthreads();
    }
#pragma unroll
    for (int q = 0; q < 2; ++q) { const int nt = nt0 + q;
        st_tile(G1T, mt, nt, mma_nt<64>(NrT + 16 * mt * RB_LD, RB_LD, Tb + 16 * nt * RB_LD, RB_LD, zero4, lane), lane);
        st_tile(G2T, mt, nt, mma_nt<64>(BtT + 16 * mt * RB_LD, RB_LD, Tb + 16 * nt * RB_LD, RB_LD, zero4, lane), lane); }
    __syncthreads();
    const size_t ci = (size_t)(b * 4 + h) * 64 + c;
    bf16_t* gPT = (bf16_t*)(F.ws + WS_MOE + RW_PT) + ci * 4096; bf16_t* gW1 = (bf16_t*)(F.ws + WS_MOE + RW_W1) + ci * 4096; bf16_t* gZ = (bf16_t*)(F.ws + WS_MOE + RW_Z) + ci * 4096;
#pragma unroll
    for (int q = 0; q < 2; ++q) { const int nt = nt0 + q; const int col = 16 * nt + r;
        f32x4 w1 = mma_nt<64>(G1T + 16 * mt * RB_LD, RB_LD, AtT + 16 * nt * RB_LD, RB_LD, zero4, lane);
        f32x4 z = mma_nt<64>(G1T + 16 * mt * RB_LD, RB_LD, Mm + 16 * nt * RB_LD, RB_LD, zero4, lane);
        f32x4 mr = mma_nt<64>(Rt + 16 * mt * RB_LD, RB_LD, Kt + 16 * nt * RB_LD, RB_LD, zero4, lane);
        f32x4 p = mma_nt<64>(G2T + 16 * mt * RB_LD, RB_LD, AtT + 16 * nt * RB_LD, RB_LD, zero4, lane);
        f32x4 qq = mma_nt<64>(G2T + 16 * mt * RB_LD, RB_LD, Mm + 16 * nt * RB_LD, RB_LD, zero4, lane);
        const int pos = 32 * (col >> 5) + 8 * ((col >> 2) & 3) + 4 * ((col >> 4) & 1) + (col & 3);
#pragma unroll
        for (int i = 0; i < 4; ++i) { const int row = 16 * mt + 4 * g4 + i;
            gW1[row * 64 + col] = f2bf(w1[i] + bf2f(Rt[row * RB_LD + col]));
            gZ[row * 64 + col] = f2bf(z[i] + (col <= row ? mr[i] : 0.f));
            const float gc = gC[row];
            gPT[row * 64 + pos] = f2bf((p[i] + (row == col ? 1.0f : 0.f)) * gc);
            qq[i] = (qq[i] + bf2f(Kt[col * RB_LD + row])) * gc; }
        st_tile(QT, mt, nt, qq, lane); }
    __syncthreads();
    bf16_t* gU = (bf16_t*)(F.ws + WS_MOE + RW_U) + ci * 4096;
#pragma unroll
    for (int q = 0; q < 2; ++q) { const int nt = nt0 + q;
        const f32x4 u = mma_nt<64>(VT + 16 * mt * RB_LD, RB_LD, QT + 16 * nt * RB_LD, RB_LD, zero4, lane);
#pragma unroll
        for (int i = 0; i < 4; ++i) gU[(16 * mt + 4 * g4 + i) * 64 + 16 * nt + r] = f2bf(u[i]); }
}
__device__ __forceinline__ void item_rwkv_carry(const Frame& F_, int item) { Frame F = relocal(F_);
    const int bh = item * 2 + (F.wave >> 2), nt = F.wave & 3, r = F.lane & 15, g = F.lane >> 4;
    const bf16_t* PT = (const bf16_t*)(F.ws + WS_MOE + RW_PT); const bf16_t* Uc = (const bf16_t*)(F.ws + WS_MOE + RW_U); bf16_t* Ss = (bf16_t*)(F.ws + WS_MOE + RW_S);
    f32x4 acc[4];
#pragma unroll
    for (int m = 0; m < 4; ++m) acc[m] = (f32x4){0.f, 0.f, 0.f, 0.f};
    for (int c = 0; c < 64; ++c) { const size_t ci = (size_t)bh * 64 + c;
        bf16x8 af[4][2]; f32x4 cin[4];
#pragma unroll
        for (int m = 0; m < 4; ++m) { const u32x2 uv = *(const u32x2*)(Uc + ci * 4096 + (16 * nt + r) * 64 + 16 * m + 4 * g);
            cin[m] = (f32x4){__uint_as_float(uv.x << 16), __uint_as_float(uv.x & 0xffff0000u), __uint_as_float(uv.y << 16), __uint_as_float(uv.y & 0xffff0000u)};
#pragma unroll
            for (int s = 0; s < 2; ++s) af[m][s] = *(const bf16x8*)(PT + ci * 4096 + (16 * m + r) * 64 + 32 * s + 8 * g); }
        unsigned pw[4][2];
#pragma unroll
        for (int m = 0; m < 4; ++m) { pw[m][0] = pk2(acc[m][0], acc[m][1]); pw[m][1] = pk2(acc[m][2], acc[m][3]);
            *(u32x2*)(Ss + ci * 4096 + (16 * nt + r) * 64 + 16 * m + 4 * g) = (u32x2){pw[m][0], pw[m][1]}; }
        bf16x8 bfr[2];
#pragma unroll
        for (int s = 0; s < 2; ++s) bfr[s] = __builtin_bit_cast(bf16x8, (u32x4){pw[2 * s][0], pw[2 * s][1], pw[2 * s + 1][0], pw[2 * s + 1][1]});
#pragma unroll
        for (int m = 0; m < 4; ++m) { acc[m] = __builtin_amdgcn_mfma_f32_16x16x32_bf16(af[m][0], bfr[0], cin[m], 0, 0, 0);
            acc[m] = __builtin_amdgcn_mfma_f32_16x16x32_bf16(af[m][1], bfr[1], acc[m], 0, 0, 0); }
    }
}
__device__ __forceinline__ void item_rwkv3(const Frame& F_, int layer, int item) { Frame F = relocal(F_);
    const int b = item >> 8, h = (item >> 6) & 3, c = item & 63; const size_t T0 = (size_t)b * SEQ + c * 64;
    rwkv_prep<3>(F, layer, b, h, c);
#ifdef PROBE_PREP
    rwkv_prep<3>(F, layer, b, h, c);
#endif
    LAS float* Vv = (LAS float*)(F.lds + RW_V); LAS float* Oo = (LAS float*)(F.lds + R3_O);
    LAS float* Gg = (LAS float*)(F.lds + R3_G); LAS float* BON = (LAS float*)(F.lds + R3_BON);
    LAS bf16_t* S0b = (LAS bf16_t*)(F.lds + R3_TILES); LAS bf16_t* W1b = S0b + 4608; LAS bf16_t* Zb = W1b + 4608; LAS bf16_t* VTb = Zb + 4608;
    { const size_t ci = (size_t)(b * 4 + h) * 64 + c; const int row = F.tid >> 3, col = (F.tid & 7) * 8;
      *(LAS u32x4*)(S0b + row * RB_LD + col) = *(const u32x4*)((const bf16_t*)(F.ws + WS_MOE + RW_S) + ci * 4096 + F.tid * 8);
      *(LAS u32x4*)(W1b + row * RB_LD + col) = *(const u32x4*)((const bf16_t*)(F.ws + WS_MOE + RW_W1) + ci * 4096 + F.tid * 8);
      *(LAS u32x4*)(Zb + row * RB_LD + col) = *(const u32x4*)((const bf16_t*)(F.ws + WS_MOE + RW_Z) + ci * 4096 + F.tid * 8);
      const int vv = F.tid & 63, part = F.tid >> 6;
#pragma unroll
      for (int i = 0; i < 8; ++i) { const int t = 8 * part + i; VTb[vv * RB_LD + t] = f2bf(Vv[t * 64 + vv]); } }
    __syncthreads();
    { const int lane = F.lane, mt = F.wave >> 1, nt0 = 2 * (F.wave & 1), r = lane & 15, g4 = lane >> 4;
#pragma unroll
      for (int q = 0; q < 2; ++q) { const int nt = nt0 + q;
          f32x4 o = mma_nt<64>(W1b + 16 * mt * RB_LD, RB_LD, S0b + 16 * nt * RB_LD, RB_LD, (f32x4){0.f, 0.f, 0.f, 0.f}, lane);
          o = mma_nt<64>(Zb + 16 * mt * RB_LD, RB_LD, VTb + 16 * nt * RB_LD, RB_LD, o, lane);
#pragma unroll
          for (int i = 0; i < 4; ++i) Oo[(16 * mt + 4 * g4 + i) * 64 + 16 * nt + r] = o[i]; } }
    __syncthreads();
    { const int j = F.lane, tq = F.wave, ch = h * 64 + j;
      const float lw = F.in[I_RLNW][layer * 256 + ch], lb = F.in[I_RLNB][layer * 256 + ch];
      bf16_t* Y = (bf16_t*)(F.ws + WS_H);
#pragma unroll 2
      for (int i8 = 0; i8 < 8; ++i8) { const int t = tq + 8 * i8;
          const float o = Oo[t * 64 + j]; const float mean = wave_sum(o) * (1.0f / 64.0f); const float d = o - mean; const float var = wave_sum(d * d) * (1.0f / 64.0f);
          float on = d * rsqrtf(var + 64e-5f) * lw + lb; on += BON[t] * Vv[t * 64 + j];
          Y[(T0 + t) * DM + 256 + ch] = f2bf(on * Gg[t * 64 + j]); } }
}

constexpr int DS_SEL = 131072, DS_HIST = 135168, DS_BKT = 151552, DS_BIAS = 152064;
__device__ __forceinline__ unsigned fkey(float f) { const unsigned u = __float_as_uint(f); return (u & 0x80000000u) ? ~u : (u | 0x80000000u); }
__device__ __forceinline__ void item_dsa(const Frame& F_, int layer, int item) { Frame F = relocal(F_);
    const bf16_t* U = (const bf16_t*)(F.ws + WS_U); const bf16_t* KI = (const bf16_t*)(F.ws + WS_KIDX);
    const bf16_t* Kb = (const bf16_t*)(F.ws + WS_K); const bf16_t* Vb = (const bf16_t*)(F.ws + WS_V);
    const int b = item & 3, qg = 511 - (item >> 2); const size_t TB = (size_t)b * SEQ, T0 = TB + qg * 8;
    LAS float* sc = (LAS float*)F.lds; LAS unsigned short* selall = (LAS unsigned short*)(F.lds + DS_SEL); LAS unsigned* histall = (LAS unsigned*)(F.lds + DS_HIST);
    LAS int* bkt = (LAS int*)(F.lds + DS_BKT); LAS float* biasT = (LAS float*)(F.lds + DS_BIAS);
    if (F.tid < 128) { const int n = F.tid; int bk = n; if (n >= 16) { const float lr = logf((float)n / 16.0f) / 2.0794415416798357f; bk = 16 + (int)(lr * 16.0f); bk = bk < 31 ? bk : 31; } bkt[n] = bk; biasT[n] = F.in[I_RELB][n]; }
    const int lane = F.lane, hh = lane >> 5;
    {
        bf16x8 af[2][2]; float wq[2][2][8];
        { const int r = lane & 31, q4 = 2 * ((r >> 2) & 1) + (r >> 4), head = 4 * ((r >> 3) & 1) + (r & 3);
#pragma unroll
          for (int mt = 0; mt < 2; ++mt)
#pragma unroll
              for (int ks = 0; ks < 2; ++ks) af[mt][ks] = *(const bf16x8*)(U + (T0 + 4 * mt + q4) * NINP + UC + 384 + head * 32 + 16 * ks + 8 * hh); }
#pragma unroll
        for (int mt = 0; mt < 2; ++mt)
#pragma unroll
            for (int q2 = 0; q2 < 2; ++q2) { float f[8]; unpack8(*(const u32x4*)(U + (T0 + 4 * mt + 2 * hh + q2) * NINP + UC + 672), f);
#pragma unroll
                for (int hd = 0; hd < 8; ++hd) wq[mt][q2][hd] = f[hd]; }
        const int ntile = (qg * 8 + 8 + 31) >> 5;
        for (int kt = F.wave; kt < ntile; kt += 8) {
            const int key = kt * 32 + (lane & 31);
            const bf16x8 b0 = *(const bf16x8*)(KI + (TB + key) * 32 + 8 * hh), b1 = *(const bf16x8*)(KI + (TB + key) * 32 + 16 + 8 * hh);
#pragma unroll
            for (int mt = 0; mt < 2; ++mt) { f32x16 acc;
#pragma unroll
                for (int i = 0; i < 16; ++i) acc[i] = 0.f;
                acc = __builtin_amdgcn_mfma_f32_32x32x16_bf16(af[mt][0], b0, acc, 0, 0, 0);
                acc = __builtin_amdgcn_mfma_f32_32x32x16_bf16(af[mt][1], b1, acc, 0, 0, 0);
#pragma unroll
                for (int q2 = 0; q2 < 2; ++q2) { float s = 0.f;
#pragma unroll
                    for (int hd = 0; hd < 8; ++hd) s += fmaxf(acc[8 * q2 + hd], 0.f) * wq[mt][q2][hd];
                    const int qi = 4 * mt + 2 * hh + q2;
                    sc[qi * 4096 + key] = (key <= qg * 8 + qi) ? s : -INFINITY; } }
        }
    }
    __syncthreads();
    const int qi = F.wave, tq = qg * 8 + qi, n = tq + 1;
    LAS float* scq = sc + qi * 4096; LAS unsigned short* sel = selall + qi * 256; LAS unsigned* hist = histall + qi * 512;
    int nsel;
    if (n <= 256) { nsel = n; for (int j = lane; j < 256; j += 64) sel[j] = (unsigned short)(j < n ? j : 0); }
    else {
        nsel = 256;
        const int R = (n + 63) >> 6; const unsigned long long ltm = (1ull << lane) - 1ull;
        float lo = INFINITY, hi = -INFINITY;
#pragma unroll 8
        for (int i = 0; i < R; ++i) { const int j = lane + 64 * i; if (j < n) { const float v = scq[j]; lo = fminf(lo, v); hi = fmaxf(hi, v); } }
#pragma unroll
        for (int o = 1; o < 64; o <<= 1) { lo = fminf(lo, shx(lo, o)); hi = fmaxf(hi, shx(hi, o)); }
        bool slow = false;
        if (!(hi > lo)) { for (int j = lane; j < 256; j += 64) sel[j] = (unsigned short)j; }
        else {
            const float scale = 1023.0f / (hi - lo);
            *(LAS u32x4*)(hist + 8 * lane) = (u32x4){0u, 0u, 0u, 0u}; *(LAS u32x4*)(hist + 8 * lane + 4) = (u32x4){0u, 0u, 0u, 0u};
#pragma unroll 8
            for (int i = 0; i < R; ++i) { const int j = lane + 64 * i; if (j < n) { int bk = (int)((scq[j] - lo) * scale); bk = bk < 1023 ? bk : 1023;
                atomicAdd((unsigned*)(hist + (bk >> 1)), (bk & 1) ? 65536u : 1u); } }
            const u32x4 h0 = *(const LAS u32x4*)(hist + 8 * lane), h1 = *(const LAS u32x4*)(hist + 8 * lane + 4);
            unsigned cb[16];
            cb[0] = h0.x & 0xffffu; cb[1] = h0.x >> 16; cb[2] = h0.y & 0xffffu; cb[3] = h0.y >> 16; cb[4] = h0.z & 0xffffu; cb[5] = h0.z >> 16; cb[6] = h0.w & 0xffffu; cb[7] = h0.w >> 16;
            cb[8] = h1.x & 0xffffu; cb[9] = h1.x >> 16; cb[10] = h1.y & 0xffffu; cb[11] = h1.y >> 16; cb[12] = h1.z & 0xffffu; cb[13] = h1.z >> 16; cb[14] = h1.w & 0xffffu; cb[15] = h1.w >> 16;
            unsigned tot = 0u;
#pragma unroll
            for (int q = 0; q < 16; ++q) tot += cb[q];
            unsigned incl = tot;
#pragma unroll
            for (int o = 1; o < 64; o <<= 1) { const unsigned t = shdown_u(incl, o); if (lane + o < 64) incl += t; }
            int fb = -1; unsigned fabove = 0u, fcnt = 0u; unsigned cum = incl - tot;
#pragma unroll
            for (int q = 15; q >= 0; --q) { if (fb < 0 && cum < 256u && 256u <= cum + cb[q]) { fb = 16 * lane + q; fabove = cum; fcnt = cb[q]; } cum += cb[q]; }
            const unsigned long long mf = __ballot(fb >= 0); const int src = (int)__ffsll((long long)mf) - 1;
            const int B = shidx_i(fb, src); const int above = shidx_i((int)fabove, src), cntB = shidx_i((int)fcnt, src); const int need = 256 - above;
            if (cntB > 256) slow = true;
            else {
                LAS unsigned* cand = hist;
                int base_gt = 0, base_c = 0;
#pragma unroll 4
                for (int i = 0; i < R; ++i) { const int j = lane + 64 * i; const bool valid = j < n; const float v = valid ? scq[j] : lo;
                    int bk = (int)((v - lo) * scale); bk = bk < 1023 ? bk : 1023;
                    const bool gt = valid && bk > B, eq = valid && bk == B;
                    const unsigned long long mg = __ballot(gt), me = __ballot(eq);
                    if (gt) sel[base_gt + __popcll(mg & ltm)] = (unsigned short)j;
                    if (eq) { const int p = base_c + __popcll(me & ltm); cand[2 * p] = fkey(v); cand[2 * p + 1] = (unsigned)j; }
                    base_gt += __popcll(mg); base_c += __popcll(me); }
                if (need == cntB) { for (int c = lane; c < cntB; c += 64) sel[above + c] = (unsigned short)cand[2 * c + 1]; }
                else {
                    unsigned ck[4]; int rk[4];
#pragma unroll
                    for (int q = 0; q < 4; ++q) { const int c = lane + 64 * q; ck[q] = c < cntB ? cand[2 * c] : 0u; rk[q] = 0; }
                    for (int c2 = 0; c2 < cntB; ++c2) { const unsigned k2 = cand[2 * c2];
#pragma unroll
                        for (int q = 0; q < 4; ++q) rk[q] += (k2 > ck[q] || (k2 == ck[q] && c2 < lane + 64 * q)) ? 1 : 0; }
#pragma unroll
                    for (int q = 0; q < 4; ++q) { const int c = lane + 64 * q; if (c < cntB && rk[q] < need) sel[above + rk[q]] = (unsigned short)cand[2 * c + 1]; }
                }
            }
        }
        if (slow) {
        unsigned prefix = 0u; int need = 256; unsigned neq = 0u;
        for (int p = 0; p < 4; ++p) { const int shift = 24 - 8 * p;
            *(LAS u32x4*)(hist + 4 * lane) = (u32x4){0u, 0u, 0u, 0u};
            for (int i = 0; i < R; ++i) { const int j = lane + 64 * i; if (j < n) { const unsigned u = fkey(scq[j]);
                if (p == 0 || (u >> (shift + 8)) == prefix) atomicAdd((unsigned*)(hist + ((u >> shift) & 255u)), 1u); } }
            const u32x4 hv = *(const LAS u32x4*)(hist + 4 * lane);
            const unsigned tot = hv.x + hv.y + hv.z + hv.w;
            unsigned incl = tot;
#pragma unroll
            for (int o = 1; o < 64; o <<= 1) { const unsigned t = shdown_u(incl, o); if (lane + o < 64) incl += t; }
            const unsigned above = incl - tot;
            int fb = -1; unsigned fabove = 0u, feq = 0u; unsigned cum = above;
            { const unsigned hq[4] = {hv.x, hv.y, hv.z, hv.w};
#pragma unroll
              for (int q = 3; q >= 0; --q) { if (fb < 0 && cum < (unsigned)need && (unsigned)need <= cum + hq[q]) { fb = 4 * lane + q; fabove = cum; feq = hq[q]; } cum += hq[q]; } }
            const unsigned long long m = __ballot(fb >= 0);
            const int src = (int)__ffsll((long long)m) - 1;
            const int bin = shidx_i(fb, src); const unsigned ab = (unsigned)shidx_i((int)fabove, src); neq = (unsigned)shidx_i((int)feq, src);
            need -= (int)ab; prefix = (prefix << 8) | (unsigned)bin;
        }
        const int ngt = 256 - need;
        int base_gt = 0, base_eq = 0;
        for (int i = 0; i < R; ++i) { const int j = lane + 64 * i; const unsigned u = (j < n) ? fkey(scq[j]) : 0u;
            const bool gt = (j < n) && (u > prefix), eq = (j < n) && (u == prefix);
            const unsigned long long mg = __ballot(gt), me = __ballot(eq); const unsigned long long lt = (1ull << lane) - 1ull;
            if (gt) sel[base_gt + __popcll(mg & lt)] = (unsigned short)j;
            if (eq) { const int rk = base_eq + __popcll(me & lt); if (rk < need) sel[ngt + rk] = (unsigned short)j; }
            base_gt += __popcll(mg); base_eq += __popcll(me); }
        (void)neq;
            }
    }
    const int nt16 = (nsel + 15) >> 4, r16 = lane & 15, g4 = lane >> 4;
    LAS float* biasj = scq + 2048;
#pragma unroll
    for (int q = 0; q < 4; ++q) { const int j = lane + 64 * q; f32x4 bv = (f32x4){-INFINITY, -INFINITY, -INFINITY, -INFINITY};
        if (j < nsel) { const int dist = tq - (int)sel[j]; const int bk = dist < 128 ? bkt[dist < 0 ? 0 : dist] : 31; bv = *(const LAS f32x4*)(biasT + 4 * bk); }
        *(LAS f32x4*)(biasj + 4 * j) = bv; }
    bf16x8 qf[2];
#pragma unroll
    for (int s = 0; s < 2; ++s) { u32x4 z = (u32x4){0u, 0u, 0u, 0u}; if (r16 < 4) z = *(const u32x4*)(U + (T0 + qi) * NINP + UC + r16 * 64 + 32 * s + 8 * g4); qf[s] = __builtin_bit_cast(bf16x8, z); }
    float lg[16][4]; float mx = -INFINITY;
#pragma unroll
    for (int hb = 0; hb < 2; ++hb) {
        if (hb * 8 < nt16) {
            int keyr[8]; bf16x8 a0[8], a1[8];
#pragma unroll
            for (int m8 = 0; m8 < 8; ++m8) keyr[m8] = sel[16 * (8 * hb + m8) + r16];
#pragma unroll
            for (int m8 = 0; m8 < 8; ++m8) { a0[m8] = *(const bf16x8*)(Kb + (TB + keyr[m8]) * 64 + 8 * g4); a1[m8] = *(const bf16x8*)(Kb + (TB + keyr[m8]) * 64 + 32 + 8 * g4); }
#pragma unroll
            for (int m8 = 0; m8 < 8; ++m8) { const int m = 8 * hb + m8;
                f32x4 acc = (f32x4){0.f, 0.f, 0.f, 0.f};
                acc = __builtin_amdgcn_mfma_f32_16x16x32_bf16(a0[m8], qf[0], acc, 0, 0, 0);
                acc = __builtin_amdgcn_mfma_f32_16x16x32_bf16(a1[m8], qf[1], acc, 0, 0, 0);
#pragma unroll
                for (int i = 0; i < 4; ++i) { const float v = acc[i] * 0.125f + biasj[(16 * m + 4 * g4 + i) * 4 + (r16 & 3)]; lg[m][i] = v; mx = fmaxf(mx, v); } }
        } else {
#pragma unroll
            for (int m8 = 0; m8 < 8; ++m8)
#pragma unroll
                for (int i = 0; i < 4; ++i) lg[8 * hb + m8][i] = -INFINITY;
        }
    }
    mx = fmaxf(mx, shx(mx, 16)); mx = fmaxf(mx, shx(mx, 32));
    float sm = 0.f;
#pragma unroll
    for (int m = 0; m < 16; ++m)
#pragma unroll
        for (int i = 0; i < 4; ++i) { const float p = __expf(lg[m][i] - mx); lg[m][i] = p; sm += p; }
    sm += shx(sm, 16); sm += shx(sm, 32);
    f32x4 ov[4];
#pragma unroll
    for (int nt = 0; nt < 4; ++nt) ov[nt] = (f32x4){0.f, 0.f, 0.f, 0.f};
    const unsigned vs_base = (unsigned)(unsigned long)scq;
#pragma unroll
    for (int half = 0; half < 2; ++half) {
        if (half * 8 < nt16) {
            asm volatile("s_waitcnt lgkmcnt(0)" ::: "memory");
#pragma unroll
            for (int q = 0; q < 16; ++q) { const int rho = 8 * q + (lane >> 3);
                const int j = half * 128 + (rho & ~31) + 16 * ((rho >> 2) & 1) + 4 * ((rho >> 3) & 3) + (rho & 3);
                const int key = sel[j];
                __builtin_amdgcn_global_load_lds((const unsigned*)(Vb + (TB + key) * 64 + 8 * (lane & 7)), (LAS unsigned*)((LAS unsigned char*)scq + q * 1024), 16, 0, 0); }
            asm volatile("s_waitcnt vmcnt(0)" ::: "memory");
#pragma unroll
            for (int s4 = 0; s4 < 4; ++s4) { const int s = half * 4 + s4;
                u32x4 pw; pw.x = pk2(lg[2 * s][0], lg[2 * s][1]); pw.y = pk2(lg[2 * s][2], lg[2 * s][3]); pw.z = pk2(lg[2 * s + 1][0], lg[2 * s + 1][1]); pw.w = pk2(lg[2 * s + 1][2], lg[2 * s + 1][3]);
                const bf16x8 pa = __builtin_bit_cast(bf16x8, pw);
                const unsigned ad = vs_base + (unsigned)((32 * s4 + 8 * g4 + (r16 >> 2)) * 128 + (r16 & 3) * 8);
                u32x2 t0[4], t1[4];
                asm volatile("ds_read_b64_tr_b16 %0, %8\n\tds_read_b64_tr_b16 %1, %8 offset:512\n\tds_read_b64_tr_b16 %2, %8 offset:32\n\tds_read_b64_tr_b16 %3, %8 offset:544\n\t"
                             "ds_read_b64_tr_b16 %4, %8 offset:64\n\tds_read_b64_tr_b16 %5, %8 offset:576\n\tds_read_b64_tr_b16 %6, %8 offset:96\n\tds_read_b64_tr_b16 %7, %8 offset:608\n\ts_waitcnt lgkmcnt(0)"
                             : "=&v"(t0[0]), "=&v"(t1[0]), "=&v"(t0[1]), "=&v"(t1[1]), "=&v"(t0[2]), "=&v"(t1[2]), "=&v"(t0[3]), "=&v"(t1[3]) : "v"(ad) : "memory");
#pragma unroll
                for (int nt = 0; nt < 4; ++nt) { const bf16x8 vb = __builtin_bit_cast(bf16x8, (u32x4){t0[nt].x, t0[nt].y, t1[nt].x, t1[nt].y});
                    ov[nt] = __builtin_amdgcn_mfma_f32_16x16x32_bf16(pa, vb, ov[nt], 0, 0, 0); } }
        }
    }
    { float inv[4];
#pragma unroll
      for (int h = 0; h < 4; ++h) inv[h] = 1.0f / __int_as_float(__builtin_amdgcn_readlane(__float_as_int(sm), h));
      if (lane < 16) { bf16_t* Y = (bf16_t*)(F.ws + WS_H) + (T0 + qi) * DM + 512 + r16;
#pragma unroll
          for (int h = 0; h < 4; ++h)
#pragma unroll
              for (int nt = 0; nt < 4; ++nt) Y[h * 64 + 16 * nt] = f2bf(ov[nt][h] * inv[h]); } }
}

__device__ __forceinline__ void phase_router(const Frame& F_, int layer) { Frame F = relocal(F_); const int cset = layer;
    const float* X = (const float*)(F.ws + WS_X);
    const bf16_t* WH = (const bf16_t*)(F.ws + WS_WRT) + (size_t)layer * 2 * 49152; const bf16_t* WL = WH + 49152;
    LAS float* part = (LAS float*)F.lds;
    LAS float* ssq = (LAS float*)(F.lds + 24576);
    LAS int* es = (LAS int*)(F.lds + 25088);
    LAS int* lr = (LAS int*)(F.lds + 25600);
    LAS float* wsl = (LAS float*)(F.lds + 26112);
    LAS float* rsd = (LAS float*)(F.lds + 26624);
    for (int blk = F.bid; blk < NTOK / 64; blk += F.G) {
        __syncthreads();
        const int mt = F.wave & 3, kh = F.wave >> 2, r16 = F.lane & 15, g4 = F.lane >> 4;
        const float* xr = X + ((size_t)blk * 64 + mt * 16 + r16) * DM + kh * 512 + 8 * g4;
        f32x4 acc[3]; acc[0] = acc[1] = acc[2] = (f32x4){0.f, 0.f, 0.f, 0.f}; float ss = 0.f;
#pragma unroll 4
        for (int ks = 0; ks < 16; ++ks) {
            const f32x4 xa = *(const f32x4*)(xr + ks * 32), xb = *(const f32x4*)(xr + ks * 32 + 4);
            ss += xa[0] * xa[0] + xa[1] * xa[1] + xa[2] * xa[2] + xa[3] * xa[3] + xb[0] * xb[0] + xb[1] * xb[1] + xb[2] * xb[2] + xb[3] * xb[3];
            float xv[8] = {xa[0], xa[1], xa[2], xa[3], xb[0], xb[1], xb[2], xb[3]}; unsigned hw[4], lw[4];
#pragma unroll
            for (int j = 0; j < 4; ++j) { const bf16_t h0 = f2bf(xv[2 * j]), h1 = f2bf(xv[2 * j + 1]); hw[j] = (unsigned)h0 | ((unsigned)h1 << 16);
                lw[j] = pk2(xv[2 * j] - bf2f(h0), xv[2 * j + 1] - bf2f(h1)); }
            const bf16x8 ahi = __builtin_bit_cast(bf16x8, (u32x4){hw[0], hw[1], hw[2], hw[3]}), alo = __builtin_bit_cast(bf16x8, (u32x4){lw[0], lw[1], lw[2], lw[3]});
#pragma unroll
            for (int nt = 0; nt < 3; ++nt) { const size_t wo = (size_t)(nt * 16 + r16) * 1024 + kh * 512 + ks * 32 + 8 * g4;
                const bf16x8 bh = *(const bf16x8*)(WH + wo), bl = *(const bf16x8*)(WL + wo);
                acc[nt] = __builtin_amdgcn_mfma_f32_16x16x32_bf16(ahi, bh, acc[nt], 0, 0, 0);
                acc[nt] = __builtin_amdgcn_mfma_f32_16x16x32_bf16(ahi, bl, acc[nt], 0, 0, 0);
                acc[nt] = __builtin_amdgcn_mfma_f32_16x16x32_bf16(alo, bh, acc[nt], 0, 0, 0); }
        }
        ss += shx(ss, 16); ss += shx(ss, 32);
        if (g4 == 0) ssq[kh * 64 + mt * 16 + r16] = ss;
#pragma unroll
        for (int nt = 0; nt < 3; ++nt)
#pragma unroll
            for (int i = 0; i < 4; ++i) part[(kh * 64 + mt * 16 + 4 * g4 + i) * 48 + nt * 16 + r16] = acc[nt][i];
        __syncthreads();
        if (F.tid < 64) { const float rstd = rsqrtf((ssq[F.tid] + ssq[64 + F.tid]) * (1.0f / DM) + 1e-6f); rsd[F.tid] = rstd;
            float l[36];
#pragma unroll
            for (int o = 0; o < 36; ++o) l[o] = (part[F.tid * 48 + o] + part[(64 + F.tid) * 48 + o]) * rstd + (o < 32 ? F.in[I_BRE][layer * 32 + o] : F.in[I_BRG][layer * 4 + o - 32]);
            int gs = 0; float gm = l[32];
#pragma unroll
            for (int j = 1; j < 4; ++j) if (l[32 + j] > gm) { gm = l[32 + j]; gs = j; }
            float den = 0.f;
#pragma unroll
            for (int j = 0; j < 4; ++j) den += __expf(l[32 + j] - gm);
            const float gate = 1.0f / den;
            float e8[8];
#pragma unroll
            for (int j = 0; j < 8; ++j) e8[j] = gs == 0 ? l[j] : gs == 1 ? l[8 + j] : gs == 2 ? l[16 + j] : l[24 + j];
            int i1 = 0; float v1 = e8[0];
#pragma unroll
            for (int j = 1; j < 8; ++j) if (e8[j] > v1) { v1 = e8[j]; i1 = j; }
            int i2 = -1; float v2 = -INFINITY;
#pragma unroll
            for (int j = 0; j < 8; ++j) if (j != i1 && e8[j] > v2) { v2 = e8[j]; i2 = j; }
            const float e2 = __expf(v2 - v1); const float p1 = 1.0f / (1.0f + e2);
            es[F.tid * 2] = gs * 8 + i1; es[F.tid * 2 + 1] = gs * 8 + i2; wsl[F.tid * 2] = p1 * gate; wsl[F.tid * 2 + 1] = (1.0f - p1) * gate; }
        __syncthreads();
        if (F.tid < 32) { int cnt = 0; for (int i = 0; i < 128; ++i) if (es[i] == F.tid) lr[i] = cnt++;
            if (cnt) { const int base = (int)__hip_atomic_fetch_add(F.ctl + CW_CNT + cset * 32 + F.tid, (unsigned)cnt, __ATOMIC_RELAXED, __HIP_MEMORY_SCOPE_AGENT);
                for (int i = 0; i < 128; ++i) if (es[i] == F.tid) lr[i] += base; } }
        __syncthreads();
        if (F.tid < 64) { int* rt = (int*)(F.ws + WS_ROUTE) + ((size_t)blk * 64 + F.tid) * 8;
            rt[0] = es[F.tid * 2]; rt[1] = es[F.tid * 2 + 1]; ((float*)rt)[2] = wsl[F.tid * 2]; ((float*)rt)[3] = wsl[F.tid * 2 + 1]; rt[4] = lr[F.tid * 2]; rt[5] = lr[F.tid * 2 + 1]; ((float*)rt)[6] = rsd[F.tid]; }
    }
    __syncthreads();
    if (F.tid == 0) __hip_atomic_fetch_add(F.ctl + CW_RB + 64 * layer, 1u, __ATOMIC_RELAXED, __HIP_MEMORY_SCOPE_AGENT);
}
struct CmGU { __device__ __forceinline__ int operator()(int n) const { return 128 * (n >> 8) + (n & 127); } };
__device__ __forceinline__ void phase_moe_convert(const Frame& F_, int layer) { Frame F = relocal(F_);
    bf16_t* WGU = (bf16_t*)(F.ws + WS_MOE + MOE_WGU); bf16_t* WD = (bf16_t*)(F.ws + WS_MOE + MOE_WD);
    for (int t = F.bid; t < 6144; t += F.G) {
        if (t < 4096) { const int e = t >> 7, r = t & 127, kt = r >> 3, nt = r & 7; const bool up = ((nt * 64) & 255) >= 128;
            const float* src = (up ? F.in[I_WUP] : F.in[I_WGATE]) + ((size_t)layer * 32 + e) * 1024 * 256;
            tr_tile(F, src, 256, WGU + (size_t)e * 512 * 1024, 1024, kt * 64, nt * 64, CmGU()); }
        else { const int q = t - 4096, e = q >> 6, r = q & 63, kt = r >> 4, nt = r & 15;
            tr_tile(F, F.in[I_WDOWN] + ((size_t)layer * 32 + e) * 256 * 1024, 1024, WD + (size_t)e * 1024 * 256, 256, kt * 64, nt * 64, CmId()); }
    }
}
__device__ __forceinline__ void phase_gather(const Frame& F_, int layer) { Frame F = relocal(F_);
    LAS int* off = (LAS int*)F.lds;
    __syncthreads();
    if (F.tid == 0) { unsigned sp = 0;
        while (__hip_atomic_load(F.ctl + CW_RB + 64 * layer, __ATOMIC_RELAXED, __HIP_MEMORY_SCOPE_AGENT) < (unsigned)F.G) { __builtin_amdgcn_s_sleep(2); if (++sp > (1u << 22)) break; } }
    __syncthreads();
    if (F.tid == 0) { int acc = 0; for (int e = 0; e < 32; ++e) { off[e] = acc; const int c = (int)__hip_atomic_load(F.ctl + CW_CNT + layer * 32 + e, __ATOMIC_RELAXED, __HIP_MEMORY_SCOPE_AGENT); acc += (c + 255) & ~255; } off[32] = acc; }
    __syncthreads();
    int* tiles = (int*)(F.ws + WS_TILES); int* row_tok = (int*)(F.ws + WS_ROWS); float* row_w = (float*)(F.ws + WS_ROWS) + MAXROWS;
    if (F.bid == 0) { if (F.tid == 0) tiles[0] = off[32] >> 8; if (F.tid < 33) tiles[1 + F.tid] = off[F.tid];
        if (F.tid < 32) for (int rt = off[F.tid] >> 8; rt < (off[F.tid + 1] >> 8); ++rt) tiles[64 + rt] = F.tid; }
    for (int e = F.bid; e < 32; e += F.G) { const int c = (int)__hip_atomic_load(F.ctl + CW_CNT + layer * 32 + e, __ATOMIC_RELAXED, __HIP_MEMORY_SCOPE_AGENT);
        for (int r = off[e] + c + F.tid; r < off[e + 1]; r += NTHR) { row_tok[r] = -1; row_w[r] = 0.f; } }
    const float* X = (const float*)(F.ws + WS_X); bf16_t* HP = (bf16_t*)(F.ws + WS_U); const float* nw = F.in[I_NORM2] + (size_t)layer * DM;
    f32x4 nwv[4];
#pragma unroll
    for (int j = 0; j < 4; ++j) nwv[j] = *(const f32x4*)(nw + 4 * F.lane + 256 * j);
    for (int blk = F.bid; blk < NTOK / 64; blk += F.G)
    for (int i8 = 0; i8 < 8; ++i8) { const int t = blk * 64 + F.wave * 8 + i8;
        const int* rt = (const int*)(F.ws + WS_ROUTE) + (size_t)t * 8; const float rstd = ((const float*)rt)[6];
        const int p0 = off[rt[0]] + rt[4], p1 = off[rt[1]] + rt[5];
#pragma unroll
        for (int j = 0; j < 4; ++j) { const int c = 4 * F.lane + 256 * j; const f32x4 v = *(const f32x4*)(X + (size_t)t * DM + c) * rstd * nwv[j];
            u32x2 o; o.x = pk2(v[0], v[1]); o.y = pk2(v[2], v[3]);
            *(u32x2*)(HP + (size_t)p0 * DM + c) = o; *(u32x2*)(HP + (size_t)p1 * DM + c) = o; }
        if (F.lane == 0) { row_tok[p0] = t * 2; row_w[p0] = ((const float*)rt)[2]; row_tok[p1] = t * 2 + 1; row_w[p1] = ((const float*)rt)[3]; }
    }
}

constexpr int NPH_LAYER = 10, NPHASE = 1 + 2 * NPH_LAYER + 1;
#ifndef MK_ONLY
#define MK_ONLY -1
#endif
#ifndef MK_ITEM
#define MK_ITEM -1
#endif
#define EN(o) (MK_ONLY < 0 || MK_ONLY == (o))
#define IT(o) (MK_ITEM < 0 || MK_ITEM == (o))
__global__ void __launch_bounds__(NTHR, 2) mk_forward(Params P) {
    extern __shared__ __attribute__((aligned(16))) unsigned char lds_raw[];
    Frame F; F.lds = (LAS unsigned char*)lds_raw; F.tid = threadIdx.x; F.lane = F.tid & 63; F.wave = __builtin_amdgcn_readfirstlane(F.tid >> 6); F.bid = blockIdx.x; F.G = gridDim.x;
    F.in = (in_tab_t)__builtin_amdgcn_kernarg_segment_ptr(); F.out = P.out; F.ws = P.ws; F.ctl = (unsigned*)(P.ws + WS_CTL); F.misc = (volatile LAS int*)(F.lds + MISC_OFF);
    if (F.tid < 64) ((LAS unsigned*)(F.lds + MISC_OFF))[F.tid] = 0u;
    __syncthreads();
    const int lo = P.ph_lo, hi = P.ph_hi;
    XcdBarrier bar; bar.bar = F.ctl + CW_BAR; bar.x = 0; bar.st = (volatile LAS unsigned*)(F.lds + MISC_OFF + 16);
    if (hi - lo > 1) bar = xcd_barrier_post(F.ctl + CW_BAR, (volatile LAS unsigned*)(F.lds + MISC_OFF + 16));
#define IN(k) (lo <= (k) && (k) < hi)
#define SEAM(k) do { if (IN(k) && IN((k) + 1)) xcd_barrier(bar); } while (0)
#define QLOOP(qi, n, body) for (;;) { const int it = q_pop(F, layer * 12 + (qi)); if (it >= (n)) break; body; }
    if (EN(100) && IN(0)) { phase_prologue(F); phase_norm(F, F.in[I_X], false, F.in[I_NORM1], 0); } SEAM(0);
#pragma unroll
    for (int layer = 0; layer < DEPTH; ++layer) {
        const int pb = 1 + layer * NPH_LAYER;
        if (layer > 0) { if (EN(0) && IN(pb + 0)) { phase_norm(F, (const float*)(F.ws + WS_X), true, F.in[I_NORM1] + (size_t)layer * DM, 0); } SEAM(pb + 0); }
        if (EN(1) && IN(pb + 1)) { const Frame F_ = F; Frame F = relocal(F_); pg8::StaticOrder S; S.init((const bf16_t*)(F.ws + WS_H), (const bf16_t*)(F.ws + WS_WIN) + (size_t)layer * NINP * DM, NTOK, NINP, DM, F.G, F.bid);
            pg8::EpiBf16 E{(bf16_t*)(F.ws + WS_U), NINP}; pg8::gemm_phase(F.lds, DM, S, E); } SEAM(pb + 1);
        if (EN(2) && IN(pb + 2)) {
            if (IT(0)) QLOOP(0, 256, item_s5<1>(F, layer, it));
            if (IT(1)) QLOOP(1, 1024, item_rwkv1(F, layer, it));
            if (IT(2)) QLOOP(2, 256, item_mamba<1>(F, layer, it));
            if (IT(3)) QLOOP(3, 256, item_kv(F, layer, it));
        } SEAM(pb + 2);
        if (EN(3) && IN(pb + 3)) {
            if (IT(0)) QLOOP(4, 8, item_rwkv_carry(F, it));
            if (IT(1)) QLOOP(5, 16, item_mamba_carry(F, it));
            if (IT(2)) QLOOP(6, 4, item_s5_carry(F, layer, it));
            if (IT(3)) QLOOP(7, 2048, item_dsa(F, layer, it));
        } SEAM(pb + 3);
        if (EN(4) && IN(pb + 4)) {
            if (IT(0)) QLOOP(8, 256, item_s5<2>(F, layer, it));
            if (IT(1)) QLOOP(9, 1024, item_rwkv3(F, layer, it));
            if (IT(2)) QLOOP(10, 256, item_mamba<2>(F, layer, it));
        } SEAM(pb + 4);
        if (EN(5) && IN(pb + 5)) { const Frame F_ = F; Frame F = relocal(F_); pg8::StaticOrder S; S.init((const bf16_t*)(F.ws + WS_MOE + YSG_OFF), (const bf16_t*)(F.ws + WS_GLU) + (size_t)layer * 512 * 256, NTOK, 512, 256, F.G, F.bid);
            pg8::EpiGated<0> E{(bf16_t*)(F.ws + WS_H), DM, 768, F.in[I_SGLUB] + layer * 512, F.in[I_SGLUB] + layer * 512 + 256}; pg8::gemm_phase(F.lds, 256, S, E); } SEAM(pb + 5);
        if (EN(6) && IN(pb + 6)) { const Frame F_ = F; Frame F = relocal(F_); pg8::StaticOrder S; S.init((const bf16_t*)(F.ws + WS_H), (const bf16_t*)(F.ws + WS_WOUT) + (size_t)layer * DM * DM, NTOK, DM, DM, F.G, F.bid);
            pg8::EpiResid E{(float*)(F.ws + WS_X), DM}; pg8::gemm_phase(F.lds, DM, S, E); } SEAM(pb + 6);
        if (EN(7) && IN(pb + 7)) { phase_router(F, layer); phase_moe_convert(F, layer); phase_gather(F, layer); } SEAM(pb + 7);
        if (EN(8) && IN(pb + 8)) { const Frame F_ = F; Frame F = relocal(F_); pg8::MoeOrder S{2, F.G, F.bid, DM, (const char*)(F.ws + WS_U), (const char*)(F.ws + WS_MOE + MOE_WGU), (size_t)512 * 1024 * 2, (const int*)(F.ws + WS_TILES)};
            pg8::EpiGated<1> E{(bf16_t*)(F.ws + WS_H), 256, 0, nullptr, nullptr}; pg8::gemm_phase(F.lds, DM, S, E); } SEAM(pb + 8);
        if (EN(9) && IN(pb + 9)) { const Frame F_ = F; Frame F = relocal(F_); pg8::MoeOrder S{4, F.G, F.bid, 256, (const char*)(F.ws + WS_H), (const char*)(F.ws + WS_MOE + MOE_WD), (size_t)1024 * 256 * 2, (const int*)(F.ws + WS_TILES)};
            pg8::EpiMoeOut E{(bf16_t*)(F.ws + WS_U), (const int*)(F.ws + WS_ROWS), (const float*)(F.ws + WS_ROWS) + MAXROWS}; pg8::gemm_phase(F.lds, 256, S, E); } SEAM(pb + 9);
    }
    if (EN(101) && IN(NPHASE - 1)) { phase_norm(F, (const float*)(F.ws + WS_X), true, F.in[I_FNORM], 2); }
#undef IN
#undef SEAM
}

#ifndef MK_SPLIT
#define MK_SPLIT 0
#endif
extern "C" void kernel_launch(void* const* d_in, const int* in_sizes, int n_in, void* d_out, int out_size, void* d_ws, size_t ws_size, hipStream_t stream) {
    static int grid = 0;
    if (grid == 0) {
        if (n_in != 44 || out_size != NTOK * DM || ws_size < WS_END) { fprintf(stderr, "kernel_launch: unexpected shapes (n_in %d out %d ws %zu need %zu)\n", n_in, out_size, ws_size, (size_t)WS_END); grid = -1; return; }
        int dev = 0, cus = 0;
        if (hipGetDevice(&dev) != hipSuccess || hipDeviceGetAttribute(&cus, hipDeviceAttributeMultiprocessorCount, dev) != hipSuccess) { grid = -1; return; }
        if (hipFuncSetAttribute((const void*)mk_forward, hipFuncAttributeMaxDynamicSharedMemorySize, LDS_BYTES) != hipSuccess) { fprintf(stderr, "kernel_launch: hipFuncSetAttribute failed\n"); grid = -1; return; }
        int per_cu = 0;
        if (hipOccupancyMaxActiveBlocksPerMultiprocessor(&per_cu, (const void*)mk_forward, NTHR, LDS_BYTES) != hipSuccess || per_cu < 1) { fprintf(stderr, "kernel_launch: occupancy query says %d\n", per_cu); }
        (void)hipGetLastError();
        grid = cus;
    }
    if (grid < 0) return;
    hipMemsetAsync((char*)d_ws + WS_CTL, 0, CTL_BYTES, stream);
    Params p{};
    for (int i = 0; i < 44; ++i) p.in[i] = (const float*)d_in[i];
    p.out = (float*)d_out; p.ws = (unsigned char*)d_ws;
#if MK_SPLIT
    for (int ph = 0; ph < NPHASE; ++ph) { p.ph_lo = ph; p.ph_hi = ph + 1; hipLaunchKernelGGL(mk_forward, dim3(grid), dim3(NTHR), LDS_BYTES, stream, p); }
#else
    p.ph_lo = 0; p.ph_hi = NPHASE; hipLaunchKernelGGL(mk_forward, dim3(grid), dim3(NTHR), LDS_BYTES, stream, p);
#endif
}
```

```cpp
#include <hip/hip_runtime.h>
#include <stdint.h>
#include <stdio.h>

#define LAS __attribute__((address_space(3)))
typedef unsigned short bf16_t;
typedef short bf16x8 __attribute__((ext_vector_type(8)));
typedef float f32x4 __attribute__((ext_vector_type(4)));
typedef float f32x2 __attribute__((ext_vector_type(2)));
typedef float f32x16 __attribute__((ext_vector_type(16)));
typedef unsigned u32x4 __attribute__((ext_vector_type(4)));
typedef unsigned u32x2 __attribute__((ext_vector_type(2)));

constexpr int NTOK = 16384, DM = 1024, SEQ = 4096, NBATCH = 4, DEPTH = 2;
constexpr int NIN = 2604, NINP = 2816;
constexpr int UM = 0;
constexpr int UR = 784;
constexpr int UC = 1680;
constexpr int US = 2368;
constexpr int NTHR = 512;
constexpr int LDS_BYTES = 163840;
constexpr int MISC_OFF = LDS_BYTES - 256;

constexpr size_t WS_CTL   = 0;
constexpr size_t CTL_BYTES = 65536;
constexpr size_t WS_X     = WS_CTL + CTL_BYTES;
constexpr size_t WS_H     = WS_X + (size_t)NTOK * DM * 4;
constexpr size_t WS_U     = WS_H + (size_t)NTOK * DM * 2;
constexpr size_t WS_WIN   = WS_U + (size_t)NTOK * NINP * 2;
constexpr size_t WS_WOUT  = WS_WIN + (size_t)2 * NINP * DM * 2;
constexpr size_t WS_GLU   = WS_WOUT + (size_t)2 * DM * DM * 2;
constexpr size_t WS_MOE   = WS_GLU + (size_t)2 * 512 * 256 * 2;
constexpr size_t MOE_WGU  = 0;
constexpr size_t MOE_WD   = (size_t)32 * 512 * 1024 * 2;
constexpr size_t MOE_BYTES = MOE_WD + (size_t)32 * 1024 * 256 * 2;
constexpr size_t RW_PT    = 0;
constexpr size_t RW_U     = (size_t)1024 * 4096 * 2;
constexpr size_t RW_S     = RW_U + (size_t)1024 * 4096 * 2;
constexpr size_t RW_W1    = RW_S + (size_t)1024 * 4096 * 2;
constexpr size_t RW_Z     = RW_W1 + (size_t)1024 * 4096 * 2;
constexpr size_t YSG_OFF  = RW_Z + (size_t)1024 * 4096 * 2;
static_assert(YSG_OFF + (size_t)NTOK * 256 * 2 <= MOE_BYTES, "alias");
constexpr size_t WS_MST   = WS_MOE + MOE_BYTES;
constexpr size_t WS_MDEC  = WS_MST + (size_t)4 * 64 * 4 * 4096 * 4;
constexpr size_t WS_S5ST  = WS_MDEC + 4096;
constexpr size_t WS_K     = WS_S5ST + (size_t)4 * 64 * 2048 * 4;
constexpr size_t WS_V     = WS_K + (size_t)NTOK * 64 * 2;
constexpr size_t WS_KIDX  = WS_V + (size_t)NTOK * 64 * 2;
constexpr size_t WS_ROUTE = WS_KIDX + (size_t)NTOK * 32 * 2;
constexpr size_t WS_ROWS  = WS_ROUTE + (size_t)NTOK * 32;
constexpr int    MAXROWS  = 49152;
constexpr size_t WS_TILES = WS_ROWS + (size_t)MAXROWS * 8;
constexpr size_t WS_S5TAB = WS_TILES + 4096;
constexpr size_t S5TAB_F  = (size_t)(2048 + 2048 + 32768) * 4;
constexpr size_t S5TAB_L  = S5TAB_F + (size_t)16 * 16 * 128 * 2;
constexpr size_t WS_WRT   = WS_S5TAB + 2 * S5TAB_L;
constexpr size_t WS_END   = WS_WRT + (size_t)2 * 2 * 48 * 1024 * 2;

constexpr int CW_BAR = 0;
constexpr int CW_Q   = 4096;
constexpr int CW_CNT = 8192;
constexpr int CW_RB  = 8448;

__device__ __forceinline__ float bf2f(bf16_t b) { return __uint_as_float(((unsigned)b) << 16); }
__device__ __forceinline__ bf16_t f2bf(float f) { const __bf16 h = (__bf16)f; return __builtin_bit_cast(bf16_t, h); }
__device__ __forceinline__ unsigned pk2(float lo, float hi) { typedef __bf16 bf2_t __attribute__((ext_vector_type(2))); const bf2_t h = __builtin_convertvector((f32x2){lo, hi}, bf2_t); return __builtin_bit_cast(unsigned, h); }
__device__ __forceinline__ unsigned cvt_pk_bf16(float lo, float hi) { unsigned r; asm volatile("v_cvt_pk_bf16_f32 %0, %1, %2" : "=v"(r) : "v"(lo), "v"(hi)); return r; }
__device__ __forceinline__ float sigmoidf_(float x) { return 1.0f / (1.0f + __expf(-x)); }
__device__ __forceinline__ float siluf_(float x) { return x / (1.0f + __expf(-x)); }
__device__ __forceinline__ float tanhf_(float x) { const float e = __expf(2.0f * x); return 1.0f - 2.0f / (e + 1.0f); }
__device__ __forceinline__ float softplusf_(float x) { return fmaxf(x, 0.0f) + log1pf(__expf(-fabsf(x))); }
__device__ __forceinline__ float gelu_tanh(float x) { return 0.5f * x * (1.0f + tanhf_(0.7978845608028654f * (x + 0.044715f * x * x * x))); }
template <int CTRL> __device__ __forceinline__ float dppf(float x) { return __int_as_float(__builtin_amdgcn_update_dpp(0, __float_as_int(x), CTRL, 0xF, 0xF, true)); }
__device__ __forceinline__ float sum4(float x) { x += dppf<0xB1>(x); x += dppf<0x4E>(x); return x; }
__device__ __forceinline__ float sum8(float x) { x = sum4(x); x += dppf<0x141>(x); return x; }
__device__ __forceinline__ float sum16(float x) { x = sum8(x); x += dppf<0x140>(x); return x; }
__device__ __forceinline__ int lane_id_() { int l = (int)__builtin_amdgcn_mbcnt_hi(~0u, __builtin_amdgcn_mbcnt_lo(~0u, 0u)); asm volatile("" : "+v"(l)); return l; }
__device__ __forceinline__ float shx(float x, int o) { return __int_as_float(__builtin_amdgcn_ds_bpermute((lane_id_() ^ o) << 2, __float_as_int(x))); }
__device__ __forceinline__ unsigned shdown_u(unsigned x, int o) { return (unsigned)__builtin_amdgcn_ds_bpermute(((lane_id_() + o) & 63) << 2, (int)x); }
__device__ __forceinline__ int shidx_i(int x, int src) { return __builtin_amdgcn_ds_bpermute(src << 2, x); }
__device__ __forceinline__ float wave_sum(float x) { x = sum16(x); x += shx(x, 16); x += shx(x, 32); return x; }
__device__ __forceinline__ void unpack8(const u32x4 v, float (&f)[8]) {
    f[0] = __uint_as_float(v.x << 16); f[1] = __uint_as_float(v.x & 0xffff0000u); f[2] = __uint_as_float(v.y << 16); f[3] = __uint_as_float(v.y & 0xffff0000u);
    f[4] = __uint_as_float(v.z << 16); f[5] = __uint_as_float(v.z & 0xffff0000u); f[6] = __uint_as_float(v.w << 16); f[7] = __uint_as_float(v.w & 0xffff0000u);
}

#define XB_TMO      128
#define XB_XCNT(j)  (256  + 64 * (j))
#define XB_XSUB(j)  (1280 + 64 * (j))
#define XB_XGEN(j)  (2304 + 64 * (j))
#define XB_TOP      3328
#define XB_TOPGEN   3392
#define XCD_BAR_WORDS 3456
#define XB_SPIN_CAP (1u << 22)
__device__ __forceinline__ unsigned xb_ld(unsigned* p)              { return __hip_atomic_load(p, __ATOMIC_RELAXED, __HIP_MEMORY_SCOPE_AGENT); }
__device__ __forceinline__ unsigned xb_add(unsigned* p, unsigned v) { return __hip_atomic_fetch_add(p, v, __ATOMIC_RELAXED, __HIP_MEMORY_SCOPE_AGENT); }
__device__ __forceinline__ unsigned xb_xcc_id() { return (unsigned)__builtin_amdgcn_s_getreg((3 << 11) | 20) & 0xFu; }
#define XB_SPIN(cond, bar) do { unsigned _sp = 0; while (cond) { __builtin_amdgcn_s_sleep(1); \
    if ((++_sp & 255u) == 0u) { if (xb_ld(&(bar)[XB_TMO])) break; if (_sp > XB_SPIN_CAP) { atomicAdd(&(bar)[XB_TMO], 1u); break; } } } } while (0)
struct XcdBarrier { unsigned* bar; unsigned x; volatile LAS unsigned* st; };
__device__ __forceinline__ XcdBarrier xcd_barrier_post(unsigned* bar, volatile LAS unsigned* st) {
    XcdBarrier b; b.bar = bar; b.x = xb_xcc_id(); b.st = st;
    if (threadIdx.x == 0) (void)xb_add(&bar[XB_XCNT(b.x)], 1u);
    return b;
}
__device__ __forceinline__ void xcd_barrier_complete(unsigned* bar, unsigned x, unsigned& nloc, unsigned& nx) {
    const unsigned G = gridDim.x * gridDim.y * gridDim.z;
    unsigned sum, cnt, mine, sp = 0u;
    for (;;) {
        sum = 0u; cnt = 0u; mine = 0u;
#pragma unroll
        for (unsigned j = 0; j < 16; ++j) { const unsigned c = xb_ld(&bar[XB_XCNT(j)]); sum += c; cnt += (c > 0u) ? 1u : 0u; mine = (j == x) ? c : mine; }
        if (sum == G) break;
        __builtin_amdgcn_s_sleep(1);
        if ((++sp & 255u) == 0u) { if (xb_ld(&bar[XB_TMO])) break; if (sp > XB_SPIN_CAP) { atomicAdd(&bar[XB_TMO], 1u); break; } }
    }
    nloc = mine > 0u ? mine : 1u; nx = cnt > 0u ? cnt : 1u;
}
__device__ __forceinline__ void xcd_barrier(const XcdBarrier& b_) {
    XcdBarrier b = b_; { const unsigned long long v = (unsigned long long)b.bar; unsigned lo = __builtin_amdgcn_readfirstlane((unsigned)v), hi = __builtin_amdgcn_readfirstlane((unsigned)(v >> 32)); asm volatile("" : "+s"(lo), "+s"(hi)); b.bar = (unsigned*)(((unsigned long long)hi << 32) | lo); unsigned xx = __builtin_amdgcn_readfirstlane(b.x); asm volatile("" : "+s"(xx)); b.x = xx; }
    asm volatile("s_waitcnt vmcnt(0)" ::: "memory");
    __syncthreads();
    if (threadIdx.x == 0) {
        unsigned* bar = b.bar;
        __builtin_amdgcn_s_waitcnt(0);
        unsigned nloc = b.st[0], nx = b.st[1];
        if (nloc == 0u) { xcd_barrier_complete(bar, b.x, nloc, nx); b.st[0] = nloc; b.st[1] = nx; }
        const unsigned old = xb_add(&bar[XB_XSUB(b.x)], 1u);
        const unsigned gen = old / nloc;
        if (old + 1u == (gen + 1u) * nloc) {
            __builtin_amdgcn_fence(__ATOMIC_RELEASE, "agent");
            asm volatile("s_waitcnt vmcnt(0)" ::: "memory");
            const unsigned og = xb_add(&bar[XB_TOP], 1u);
            const unsigned tg = og / nx;
            if (og + 1u == (tg + 1u) * nx) xb_add(&bar[XB_TOPGEN], 1u);
            else XB_SPIN(xb_ld(&bar[XB_TOPGEN]) == tg, bar);
            __builtin_amdgcn_fence(__ATOMIC_ACQUIRE, "agent");
            xb_add(&bar[XB_XGEN(b.x)], 1u);
            asm volatile("s_waitcnt vmcnt(0)" ::: "memory");
        } else {
            XB_SPIN(xb_ld(&bar[XB_XGEN(b.x)]) == gen, bar);
            __builtin_amdgcn_fence(__ATOMIC_ACQUIRE, "agent");
            asm volatile("s_waitcnt vmcnt(0)" ::: "memory");
        }
    }
    __syncthreads();
}

namespace pg8 {
constexpr int BM = 256, BK = 64, HALF = 128, HTB = HALF * BK * 2, STAGE_BYTES = 8 * HTB, NXCD = 8, WGM = 8;
__host__ __device__ __forceinline__ int lds_byte(int r, int c) { const int st = (r >> 4) * 2 + (c >> 5), rr = r & 15, cc = c & 31, ob = rr * 64 + cc * 2; return st * 1024 + (ob ^ (((ob >> 9) & 1) << 5)); }
__host__ __device__ __forceinline__ void stage_rc(int b, int& R, int& C) { const int st = b / 1024, sb = b % 1024, swz = sb ^ (((sb >> 9) & 1) << 5); R = (st >> 1) * 16 + swz / 64; C = (st & 1) * 32 + (swz % 64) / 2; }
__host__ __device__ __forceinline__ int perm32(int rho) { const int n = rho >> 4, i = rho & 15; return 8 * (i >> 2) + 4 * n + (i & 3); }
struct Unit { int pm, pn; const char* a; const char* b; };

struct StaticOrder {
    int nM, nN, nwg, G, c, K; const char* A; const char* B;
    __device__ void init(const bf16_t* A_, const bf16_t* B_, int M, int N, int K_, int G_, int c_) { A = (const char*)A_; B = (const char*)B_; K = K_; nM = M / BM; nN = N / BM; nwg = nM * nN; G = G_; c = c_; }
    __device__ bool next(int i, Unit& u) const {
        const long L = (long)i * G + c; if (L >= nwg) return false;
        int wgid = (int)L; { const int q = nwg / NXCD, r = nwg % NXCD, xcd = wgid % NXCD, off = wgid / NXCD; wgid = (xcd < r ? xcd * (q + 1) : r * (q + 1) + (xcd - r) * q) + off; }
        const int nig = WGM * nN, gid = wgid / nig, fm = gid * WGM, gsz = (nM - fm) < WGM ? (nM - fm) : WGM;
        u.pm = fm + ((wgid % nig) % gsz); u.pn = (wgid % nig) / gsz;
        u.a = A + (size_t)u.pm * 256 * K * 2; u.b = B + (size_t)u.pn * 256 * K * 2; return true;
    }
};

template <class Epi, class Sched>
__device__ __forceinline__ void gemm_phase(LAS unsigned char* lds, const int K_, const Sched& S, const Epi& E) {
    int K = K_; asm volatile("" : "+s"(K));
    int tid_ = threadIdx.x; asm volatile("" : "+v"(tid_));
    const int tid = tid_, wid = __builtin_amdgcn_readfirstlane(tid >> 6), lane = tid & 63, wr = wid >> 2, wc = wid & 3, fr = lane & 15, fq = lane >> 4;
    const int nt = K / BK;
    unsigned voffA[2], voffB[2];
#pragma unroll
    for (int i = 0; i < 2; ++i) { int R, C; stage_rc(tid * 16 + i * 8192, R, C); const int Rb = Epi::PERM ? ((R & ~31) + perm32(R & 31)) : R;
        voffA[i] = (unsigned)(R * K + C) * 2u; voffB[i] = (unsigned)(Rb * K + C) * 2u; }
    const size_t kstep = (size_t)(BK * 2);
    const size_t hstep = (size_t)HALF * K * 2;
    const unsigned ldsw = (unsigned)wid * 1024u;
    const int aoff = lds_byte(wr * 64 + fr, fq * 8), boff = lds_byte(wc * 32 + fr, fq * 8);
#define PG8_SA(b, h) (((b) * 2 + (h)) * HTB)
#define PG8_SB(b, h) ((4 + (b) * 2 + (h)) * HTB)
#define PG8_STAGE(bufoff, gbase, voff) do { _Pragma("unroll") for (int _i = 0; _i < 2; ++_i) \
        __builtin_amdgcn_global_load_lds((const unsigned*)((const char*)(gbase) + (voff)[_i]), (LAS unsigned*)(lds + (bufoff) + ldsw + _i * 8192), 16, 0, 0); } while (0)
#define PG8_LDA(dst, b, h) do { _Pragma("unroll") for (int m = 0; m < 4; ++m) _Pragma("unroll") for (int k = 0; k < 2; ++k) dst[m][k] = *(const LAS bf16x8*)(lds + PG8_SA(b, h) + aoff + m * 2048 + k * 1024); } while (0)
#define PG8_LDB(dst, b, h) do { _Pragma("unroll") for (int n = 0; n < 2; ++n) _Pragma("unroll") for (int k = 0; k < 2; ++k) dst[n][k] = *(const LAS bf16x8*)(lds + PG8_SB(b, h) + boff + n * 2048 + k * 1024); } while (0)
#define PG8_MMA(ai, bj, At, Bt) do { __builtin_amdgcn_s_setprio(1); _Pragma("unroll") for (int m = 0; m < 4; ++m) _Pragma("unroll") for (int n = 0; n < 2; ++n) _Pragma("unroll") for (int k = 0; k < 2; ++k) \
        acc[ai][bj][m][n] = __builtin_amdgcn_mfma_f32_16x16x32_bf16(Bt[n][k], At[m][k], acc[ai][bj][m][n], 0, 0, 0); __builtin_amdgcn_s_setprio(0); } while (0)
#define PG8_WAIT_V(n) asm volatile("s_waitcnt vmcnt(" #n ")" ::: "memory")
#define PG8_WAIT_L(n) asm volatile("s_waitcnt lgkmcnt(" #n ")" ::: "memory")
#define PG8_BAR __builtin_amdgcn_s_barrier()
#define PG8_SCHED __builtin_amdgcn_sched_barrier(0)
    Unit cur, nxt; int ui = 0;
    if (!S.next(0, cur)) return;
    f32x4 acc[2][2][4][2];
#pragma unroll
    for (int a = 0; a < 2; ++a)
#pragma unroll
        for (int b = 0; b < 2; ++b)
#pragma unroll
            for (int m = 0; m < 4; ++m)
#pragma unroll
                for (int n = 0; n < 2; ++n) acc[a][b][m][n] = (f32x4){0.f, 0.f, 0.f, 0.f};
    bf16x8 At[4][2], B0[2][2], B1[2][2];
    const char* cA = cur.a; const char* cB = cur.b;
    PG8_STAGE(PG8_SB(0, 0), cB, voffB); PG8_STAGE(PG8_SA(0, 0), cA, voffA); PG8_STAGE(PG8_SB(0, 1), cB + hstep, voffB); PG8_STAGE(PG8_SA(0, 1), cA + hstep, voffA);
    if (wr == 1) PG8_BAR;
    PG8_WAIT_V(4); PG8_BAR;
    PG8_STAGE(PG8_SB(1, 0), cB + kstep, voffB); PG8_STAGE(PG8_SA(1, 0), cA + kstep, voffA); PG8_STAGE(PG8_SB(1, 1), cB + hstep + kstep, voffB);
    PG8_WAIT_V(6); PG8_BAR;
    for (;;) {
        const bool has_next = S.next(ui + 1, nxt);
        const char* nA = has_next ? nxt.a : cA; const char* nB = has_next ? nxt.b : cB;
        for (int t = 0; t < nt; t += 2) {
            const bool last = (t == nt - 2);
            const char* a1 = cA + (size_t)(t + 1) * kstep;
            const char* a2 = last ? nA : cA + (size_t)(t + 2) * kstep; const char* b2 = last ? nB : cB + (size_t)(t + 2) * kstep;
            const char* a3 = a2 + kstep; const char* b3 = b2 + kstep;
            PG8_LDB(B0, 0, 0); PG8_SCHED; PG8_LDA(At, 0, 0); PG8_STAGE(PG8_SA(1, 1), a1 + hstep, voffA);
            PG8_WAIT_L(8); PG8_BAR; PG8_WAIT_L(0); PG8_MMA(0, 0, At, B0); PG8_BAR; PG8_SCHED;
            PG8_LDB(B1, 0, 1); PG8_STAGE(PG8_SB(0, 0), b2, voffB);
            PG8_BAR; PG8_WAIT_L(0); PG8_MMA(0, 1, At, B1); PG8_BAR;
            PG8_LDA(At, 0, 1); PG8_STAGE(PG8_SA(0, 0), a2, voffA);
            PG8_BAR; PG8_WAIT_L(0); PG8_MMA(1, 0, At, B0); PG8_BAR; PG8_SCHED;
            PG8_STAGE(PG8_SB(0, 1), b2 + hstep, voffB);
            PG8_WAIT_V(6); PG8_BAR; PG8_MMA(1, 1, At, B1); PG8_BAR;
            PG8_LDB(B0, 1, 0); PG8_SCHED; PG8_LDA(At, 1, 0); PG8_STAGE(PG8_SA(0, 1), a2 + hstep, voffA);
            PG8_WAIT_L(8); PG8_BAR; PG8_WAIT_L(0); PG8_MMA(0, 0, At, B0); PG8_BAR; PG8_SCHED;
            PG8_LDB(B1, 1, 1); PG8_STAGE(PG8_SB(1, 0), b3, voffB);
            PG8_BAR; PG8_WAIT_L(0); PG8_MMA(0, 1, At, B1); PG8_BAR;
            PG8_LDA(At, 1, 1); PG8_STAGE(PG8_SA(1, 0), a3, voffA);
            PG8_BAR; PG8_WAIT_L(0); PG8_MMA(1, 0, At, B0); PG8_BAR; PG8_SCHED;
            PG8_STAGE(PG8_SB(1, 1), b3 + hstep, voffB);
            PG8_WAIT_V(6); PG8_BAR; PG8_MMA(1, 1, At, B1); PG8_BAR;
        }
        E(acc, cur, wr, wc, fr, fq);
        if (!has_next) break;
#pragma unroll
        for (int a = 0; a < 2; ++a)
#pragma unroll
            for (int b = 0; b < 2; ++b)
#pragma unroll
                for (int m = 0; m < 4; ++m)
#pragma unroll
                    for (int n = 0; n < 2; ++n) acc[a][b][m][n] = (f32x4){0.f, 0.f, 0.f, 0.f};
        cur = nxt; cA = nA; cB = nB; ++ui;
    }
    PG8_WAIT_V(0);
    if (wr == 0) PG8_BAR;
    PG8_BAR;
#undef PG8_SA
#undef PG8_SB
#undef PG8_STAGE
#undef PG8_LDA
#undef PG8_LDB
#undef PG8_MMA
#undef PG8_WAIT_V
#undef PG8_WAIT_L
#undef PG8_BAR
#undef PG8_SCHED
}

struct EpiBf16 {
    static constexpr bool PERM = true;
    bf16_t* O; int ldc;
    __device__ __forceinline__ void operator()(const f32x4 (&acc)[2][2][4][2], const Unit& u, int wr, int wc, int fr, int fq) const {
        const int row0 = u.pm * BM + wr * 64 + fr, col0 = u.pn * BM + wc * 32 + 8 * fq;
#pragma unroll
        for (int ai = 0; ai < 2; ++ai)
#pragma unroll
            for (int m = 0; m < 4; ++m) { bf16_t* rowp = O + (size_t)(row0 + ai * HALF + m * 16) * ldc + col0;
#pragma unroll
                for (int bj = 0; bj < 2; ++bj) { const f32x4 v0 = acc[ai][bj][m][0], v1 = acc[ai][bj][m][1];
                    u32x4 w; w.x = cvt_pk_bf16(v0[0], v0[1]); w.y = cvt_pk_bf16(v0[2], v0[3]); w.z = cvt_pk_bf16(v1[0], v1[1]); w.w = cvt_pk_bf16(v1[2], v1[3]);
                    *(u32x4*)(rowp + bj * HALF) = w; } }
    }
};
struct EpiResid {
    static constexpr bool PERM = false;
    float* C; int ldc;
    __device__ __forceinline__ void operator()(const f32x4 (&acc)[2][2][4][2], const Unit& u, int wr, int wc, int fr, int fq) const {
        const int row0 = u.pm * BM + wr * 64 + fr, col0 = u.pn * BM + wc * 32 + 4 * fq;
#pragma unroll
        for (int ai = 0; ai < 2; ++ai)
#pragma unroll
            for (int m = 0; m < 4; ++m) { float* rowp = C + (size_t)(row0 + ai * HALF + m * 16) * ldc + col0;
#pragma unroll
                for (int bj = 0; bj < 2; ++bj)
#pragma unroll
                    for (int n = 0; n < 2; ++n) { f32x4* p = (f32x4*)(rowp + bj * HALF + n * 16); *p = *p + acc[ai][bj][m][n]; } }
    }
};
template <int ACT  > struct EpiGated {
    static constexpr bool PERM = true;
    bf16_t* O; int ldo; int coloff; const float* ba; const float* bb;
    __device__ __forceinline__ void operator()(const f32x4 (&acc)[2][2][4][2], const Unit& u, int wr, int wc, int fr, int fq) const {
        const int row0 = u.pm * BM + wr * 64 + fr, cl = u.pn * HALF + wc * 32 + 8 * fq;
        float va[8], vb[8];
#pragma unroll
        for (int j = 0; j < 8; ++j) { va[j] = (ACT == 0) ? ba[cl + j] : 0.f; vb[j] = (ACT == 0) ? bb[cl + j] : 0.f; }
#pragma unroll
        for (int ai = 0; ai < 2; ++ai)
#pragma unroll
            for (int m = 0; m < 4; ++m) { bf16_t* rowp = O + (size_t)(row0 + ai * HALF + m * 16) * ldo + coloff + cl;
                float o[8];
#pragma unroll
                for (int n = 0; n < 2; ++n)
#pragma unroll
                    for (int j = 0; j < 4; ++j) { const float a = acc[ai][0][m][n][j] + va[4 * n + j], b = acc[ai][1][m][n][j] + vb[4 * n + j];
                        o[4 * n + j] = (ACT == 0) ? a * sigmoidf_(b) : siluf_(a) * b; }
                u32x4 w; w.x = cvt_pk_bf16(o[0], o[1]); w.y = cvt_pk_bf16(o[2], o[3]); w.z = cvt_pk_bf16(o[4], o[5]); w.w = cvt_pk_bf16(o[6], o[7]);
                *(u32x4*)rowp = w; asm volatile("" ::: "memory"); }
    }
};
struct EpiMoeOut {
    static constexpr bool PERM = true;
    bf16_t* O; const int* row_tok; const float* row_w;
    __device__ __forceinline__ void operator()(const f32x4 (&acc)[2][2][4][2], const Unit& u, int wr, int wc, int fr, int fq) const {
        const int row0 = u.pm * BM + wr * 64 + fr, col0 = u.pn * BM + wc * 32 + 8 * fq;
#pragma unroll
        for (int ai = 0; ai < 2; ++ai)
#pragma unroll
            for (int m = 0; m < 4; ++m) { const int row = row0 + ai * HALF + m * 16; const int ts = row_tok[row]; const float w = row_w[row];
                if (ts >= 0) { bf16_t* rowp = O + ((size_t)(ts & 1) * NTOK + (size_t)(ts >> 1)) * DM + col0;
#pragma unroll
                    for (int bj = 0; bj < 2; ++bj) { const f32x4 v0 = acc[ai][bj][m][0] * w, v1 = acc[ai][bj][m][1] * w;
                        u32x4 q; q.x = cvt_pk_bf16(v0[0], v0[1]); q.y = cvt_pk_bf16(v0[2], v0[3]); q.z = cvt_pk_bf16(v1[0], v1[1]); q.w = cvt_pk_bf16(v1[2], v1[3]);
                        *(u32x4*)(rowp + bj * HALF) = q; } } asm volatile("" ::: "memory"); }
    }
};
struct MoeOrder {
    int nN, G, c, K; const char* A; const char* B; size_t bstride; const int* tiles;
    __device__ bool next(int i, Unit& u) const {
        const int nrt = tiles[0]; const long L = (long)i * G + c; if (L >= (long)nrt * nN) return false;
        u.pm = (int)(L / nN); u.pn = (int)(L % nN); const int e = tiles[64 + u.pm];
        u.a = A + (size_t)u.pm * 256 * K * 2; u.b = B + (size_t)e * bstride + (size_t)u.pn * 256 * K * 2; return true;
    }
};
}

struct Params { const float* in[44]; float* out; unsigned char* ws; int ph_lo, ph_hi; };
enum { I_X = 0, I_NORM1, I_WIN, I_MCONVW, I_MCONVB, I_MDTB, I_MALOG, I_MD, I_MNORM, I_RMU, I_RW0, I_RW2, I_RA0, I_RA2, I_RG2, I_RKK, I_RKA, I_RRK, I_RLNW, I_RLNB,
       I_CKVN, I_CWUK, I_CWUV, I_RELB, I_SARE, I_SAIM, I_SBRE, I_SBIM, I_SCRE, I_SCIM, I_SD, I_SLOGDT, I_SGLUW, I_SGLUB, I_WOUT, I_NORM2, I_WRG, I_BRG, I_WRE, I_BRE,
       I_WGATE, I_WUP, I_WDOWN, I_FNORM };

typedef const float* const __attribute__((address_space(4)))* in_tab_t;
struct Frame {
    LAS unsigned char* lds; int tid, lane, wave, bid, G;
    in_tab_t in; float* out; unsigned char* ws; unsigned* ctl;
    volatile LAS int* misc;
};

__device__ __forceinline__ int q_pop(Frame& F, int qi) {
    __syncthreads();
    if (F.tid == 0) F.misc[0] = (int)__hip_atomic_fetch_add(F.ctl + CW_Q + 64 * qi, 1u, __ATOMIC_RELAXED, __HIP_MEMORY_SCOPE_AGENT);
    __syncthreads();
    return F.misc[0];
}

__device__ __forceinline__ const void* opaque_ptr(const void* p) { const unsigned long long v = (unsigned long long)p; unsigned lo = __builtin_amdgcn_readfirstlane((unsigned)v), hi = __builtin_amdgcn_readfirstlane((unsigned)(v >> 32));
    asm volatile("" : "+s"(lo), "+s"(hi)); return (const void*)(((unsigned long long)hi << 32) | lo); }
__device__ __forceinline__ Frame relocal(const Frame& G) { Frame F = G; asm volatile("" : "+v"(F.tid)); F.ws = (unsigned char*)opaque_ptr(F.ws); F.ctl = (unsigned*)(F.ws + WS_CTL); F.in = (in_tab_t)(unsigned long long)opaque_ptr((const void*)(unsigned long long)F.in); F.lane = F.tid & 63; F.wave = __builtin_amdgcn_readfirstlane(F.tid >> 6); return F; }
template <int K> __device__ __forceinline__ f32x4 mma_nt(const LAS bf16_t* A, int lda, const LAS bf16_t* Bt, int ldb, f32x4 acc, int lane) {
    const int r = lane & 15, g = lane >> 4;
#pragma unroll
    for (int k0 = 0; k0 < K; k0 += 32) {
        const bf16x8 a = *(const LAS bf16x8*)(A + r * lda + k0 + 8 * g);
        const bf16x8 b = *(const LAS bf16x8*)(Bt + r * ldb + k0 + 8 * g);
        acc = __builtin_amdgcn_mfma_f32_16x16x32_bf16(a, b, acc, 0, 0, 0);
    }
    return acc;
}

template <class SrcMap> __device__ __forceinline__ void tr_tile(Frame& F, int ldsrc, bf16_t* dst, int K, int k0, int n0, SrcMap sm) {
    LAS float* tile = (LAS float*)F.lds;
    __syncthreads();
    { const int n4 = (F.tid & 63) * 4, kk = F.tid >> 6; const float* sp = sm(n0 + n4);
      f32x4 v[8];
#pragma unroll
      for (int ps = 0; ps < 8; ++ps) { v[ps] = (f32x4){0.f, 0.f, 0.f, 0.f}; if (sp) v[ps] = *(const f32x4*)(sp + (size_t)(k0 + kk + 8 * ps) * ldsrc); }
#pragma unroll
      for (int ps = 0; ps < 8; ++ps) { LAS float* t = tile + (kk + 8 * ps) * 257 + n4; t[0] = v[ps][0]; t[1] = v[ps][1]; t[2] = v[ps][2]; t[3] = v[ps][3]; } }
    __syncthreads();
    { const int kc = F.tid & 7;
#pragma unroll
      for (int j = 0; j < 4; ++j) { const int n = (F.tid >> 3) + 64 * j; float f[8];
#pragma unroll
          for (int i = 0; i < 8; ++i) f[i] = tile[(8 * kc + i) * 257 + n];
          u32x4 w; w.x = pk2(f[0], f[1]); w.y = pk2(f[2], f[3]); w.z = pk2(f[4], f[5]); w.w = pk2(f[6], f[7]);
          *(u32x4*)(dst + (size_t)(n0 + n) * K + k0 + 8 * kc) = w; } }
}

struct SmIn { const float* base; __device__ __forceinline__ const float* operator()(int n) const {
    int c; if (n < 772) c = n; else if (n < UR) return nullptr; else if (n < UR + 896) c = 772 + (n - UR); else if (n < UC) return nullptr;
    else if (n < UC + 680) c = 1668 + (n - UC); else if (n < US) return nullptr; else if (n < US + 256) c = 2348 + (n - US); else return nullptr; return base + c; } };
struct SmId { const float* base; __device__ __forceinline__ const float* operator()(int n) const { return base + n; } };
struct SmGlu { const float* base; __device__ __forceinline__ const float* operator()(int n) const { const int pn = n >> 8, rr = n & 255; return base + (rr < 128 ? 128 * pn + rr : 256 + 128 * pn + (rr - 128)); } };
struct SmGU { const float* gate; const float* up; __device__ __forceinline__ const float* operator()(int n) const {
    const unsigned long long d = (unsigned long long)up - (unsigned long long)gate; const unsigned long long a = (unsigned long long)gate + (((n & 255) < 128) ? 0ull : d); return (const float*)a + 128 * (n >> 8) + (n & 127); } };
__device__ __forceinline__ void phase_prologue(const Frame& F_) { Frame F = relocal(F_);
    for (int t = F.bid; t < 496; t += F.G) {
        if (t < 352) { const int l = t / 176, r = t % 176, kt = r / 11, nt = r % 11;
            tr_tile(F, NIN, (bf16_t*)(F.ws + WS_WIN) + (size_t)l * NINP * DM, DM, kt * 64, nt * 256, SmIn{F.in[I_WIN] + (size_t)l * DM * NIN}); }
        else if (t < 480) { const int q = t - 352, l = q / 64, r = q % 64, kt = r / 4, nt = r % 4;
            tr_tile(F, DM, (bf16_t*)(F.ws + WS_WOUT) + (size_t)l * DM * DM, DM, kt * 64, nt * 256, SmId{F.in[I_WOUT] + (size_t)l * DM * DM}); }
        else { const int q = t - 480, l = q / 8, r = q % 8, kt = r / 2, nt = r % 2;
            tr_tile(F, 512, (bf16_t*)(F.ws + WS_GLU) + (size_t)l * 512 * 256, 256, kt * 64, nt * 256, SmGlu{F.in[I_SGLUW] + (size_t)l * 256 * 512}); }
    }
    for (int i = F.bid * NTHR + F.tid; i < 2 * 48 * 1024; i += F.G * NTHR) { const int l = i / 49152, r = i % 49152, o = r >> 10, k = r & 1023;
        float v = 0.f; if (o < 32) v = F.in[I_WRE][((size_t)l * DM + k) * 32 + o]; else if (o < 36) v = F.in[I_WRG][((size_t)l * DM + k) * 4 + (o - 32)];
        v *= F.in[I_NORM2][l * DM + k];
        const bf16_t hi = f2bf(v); const bf16_t lo = f2bf(v - bf2f(hi));
        bf16_t* w = (bf16_t*)(F.ws + WS_WRT) + (size_t)l * 2 * 49152; w[r] = hi; w[49152 + r] = lo; }
    for (int i = F.bid * NTHR + F.tid; i < 2048 + 65536; i += F.G * NTHR) {
        if (i < 2048) {
            const int l = i >> 10, gn = i & 1023, g = gn >> 6;
            float* tab = (float*)(F.ws + WS_S5TAB + (size_t)l * S5TAB_L);
            const float lre = fminf(F.in[I_SARE][l * 1024 + gn], -1e-4f), lim = F.in[I_SAIM][l * 1024 + gn];
            const float dt = expf(F.in[I_SLOGDT][l * 16 + g]);
            const float mag = expf(dt * lre); float sn, cs; sincosf(dt * lim, &sn, &cs);
            const float are = mag * cs, aim = mag * sn;
            const float den = lre * lre + lim * lim;
            const float fre = ((are - 1.0f) * lre + aim * lim) / den, fim = (aim * lre - (are - 1.0f) * lim) / den;
            tab[gn * 2] = are; tab[gn * 2 + 1] = aim;
            float pr = are, pi = aim;
#pragma unroll
            for (int s = 0; s < 6; ++s) { const float nr = pr * pr - pi * pi, ni = 2.0f * pr * pi; pr = nr; pi = ni; }
            tab[2048 + gn * 2] = pr; tab[2048 + gn * 2 + 1] = pi;
            const float* bre = F.in[I_SBRE] + ((size_t)l * 1024 + gn) * 16; const float* bim = F.in[I_SBIM] + ((size_t)l * 1024 + gn) * 16;
            for (int p = 0; p < 16; ++p) { tab[4096 + (gn * 16 + p) * 2] = fre * bre[p] - fim * bim[p]; tab[4096 + (gn * 16 + p) * 2 + 1] = fre * bim[p] + fim * bre[p]; }
        } else {
            const int j = i - 2048, l = j >> 15, r = j & 32767, gp = r >> 7, k = r & 127;
            bf16_t* cm = (bf16_t*)(F.ws + WS_S5TAB + (size_t)l * S5TAB_L + S5TAB_F);
            const float v = k < 64 ? F.in[I_SCRE][((size_t)l * 256 + gp) * 64 + k] : -F.in[I_SCIM][((size_t)l * 256 + gp) * 64 + (k - 64)];
            cm[r] = f2bf(v);
        }
    }
}

__device__ __forceinline__ void phase_norm(const Frame& F_, const float* xin, bool add_o, const float* w, int mode) { Frame F = relocal(F_);
    float* X = (float*)(F.ws + WS_X); bf16_t* H = (bf16_t*)(F.ws + WS_H); const bf16_t* O = (const bf16_t*)(F.ws + WS_U);
    for (int row = F.bid * 8 + F.wave; row < NTOK; row += F.G * 8) {
        f32x4 v[4]; float ss = 0.f;
#pragma unroll
        for (int j = 0; j < 4; ++j) { const int c = 4 * F.lane + 256 * j; v[j] = *(const f32x4*)(xin + (size_t)row * DM + c);
            if (add_o) { const u32x2 a = *(const u32x2*)(O + (size_t)row * DM + c), b = *(const u32x2*)(O + ((size_t)NTOK + row) * DM + c);
                v[j][0] += __uint_as_float(a.x << 16) + __uint_as_float(b.x << 16); v[j][1] += __uint_as_float(a.x & 0xffff0000u) + __uint_as_float(b.x & 0xffff0000u);
                v[j][2] += __uint_as_float(a.y << 16) + __uint_as_float(b.y << 16); v[j][3] += __uint_as_float(a.y & 0xffff0000u) + __uint_as_float(b.y & 0xffff0000u); }
            ss += v[j][0] * v[j][0] + v[j][1] * v[j][1] + v[j][2] * v[j][2] + v[j][3] * v[j][3]; }
        ss = wave_sum(ss);
        const float rstd = rsqrtf(ss * (1.0f / DM) + 1e-6f);
#pragma unroll
        for (int j = 0; j < 4; ++j) { const int c = 4 * F.lane + 256 * j; const f32x4 wv = *(const f32x4*)(w + c);
            if (mode == 2) { *(f32x4*)(F.out + (size_t)row * DM + c) = v[j] * rstd * wv; }
            else { *(f32x4*)(X + (size_t)row * DM + c) = v[j];
                u32x2 o; o.x = pk2(v[j][0] * rstd * wv[0], v[j][1] * rstd * wv[1]); o.y = pk2(v[j][2] * rstd * wv[2], v[j][3] * rstd * wv[3]);
                *(u32x2*)(H + (size_t)row * DM + c) = o; } }
    }
}

__device__ __forceinline__ void item_kv(const Frame& F_, int layer, int item) { Frame F = relocal(F_);
    const bf16_t* U = (const bf16_t*)(F.ws + WS_U);
    LAS bf16_t* Ab = (LAS bf16_t*)F.lds;
    LAS bf16_t* Bt = (LAS bf16_t*)(F.lds + 17408);
    const int t0 = item * 64;
    { const int tok = F.tid >> 3, part = F.tid & 7; const bf16_t* src = U + (size_t)(t0 + tok) * NINP + UC + 256 + 16 * part;
      float f[16]; { float a[8], b[8]; unpack8(*(const u32x4*)src, a); unpack8(*(const u32x4*)(src + 8), b);
#pragma unroll
        for (int j = 0; j < 8; ++j) { f[j] = a[j]; f[8 + j] = b[j]; } }
      float ss = 0.f;
#pragma unroll
      for (int j = 0; j < 16; ++j) ss += f[j] * f[j];
      ss = sum8(ss);
      const float rstd = rsqrtf(ss * (1.0f / 128.0f) + 1e-6f); const float* nw = F.in[I_CKVN] + layer * 128 + 16 * part;
#pragma unroll
      for (int j = 0; j < 16; j += 2) *(LAS unsigned*)(Ab + tok * 136 + 16 * part + j) = pk2(f[j] * rstd * nw[j], f[j + 1] * rstd * nw[j + 1]); }
    { const int n = F.tid >> 2, kq = F.tid & 3; const float* w = (n < 64 ? F.in[I_CWUK] : F.in[I_CWUV]) + (size_t)layer * 128 * 64 + (n & 63);
#pragma unroll 4
      for (int k = 32 * kq; k < 32 * kq + 32; ++k) Bt[n * 136 + k] = f2bf(w[(size_t)k * 64]); }
    if (F.tid < 256) { const int tok = F.tid >> 2, q = F.tid & 3;
        *(u32x4*)((bf16_t*)(F.ws + WS_KIDX) + (size_t)(t0 + tok) * 32 + 8 * q) = *(const u32x4*)(U + (size_t)(t0 + tok) * NINP + UC + 640 + 8 * q); }
    __syncthreads();
    const int mt = F.wave & 3, g = F.lane >> 4, r = F.lane & 15;
#pragma unroll
    for (int q = 0; q < 4; ++q) { const int nt = (F.wave >> 2) * 4 + q;
        f32x4 acc = (f32x4){0.f, 0.f, 0.f, 0.f};
        acc = mma_nt<128>(Ab + mt * 16 * 136, 136, Bt + nt * 16 * 136, 136, acc, F.lane);
        const int n = nt * 16 + r; bf16_t* dst = (bf16_t*)(F.ws + (n < 64 ? WS_K : WS_V));
#pragma unroll
        for (int i = 0; i < 4; ++i) dst[(size_t)(t0 + mt * 16 + 4 * g + i) * 64 + (n & 63)] = f2bf(acc[i]); }
}

constexpr int MB_CG = 0, MB_BG = 18432, MB_BT = 36864, MB_XT = 55296, MB_M = 92160, MB_S0 = 101376, MB_DT = 110592, MB_AC = 111616, MB_RS = 112640;
template <int STAGE> __device__ __forceinline__ void item_mamba(const Frame& F_, int layer, int item) { Frame F = relocal(F_);
    const bf16_t* U = (const bf16_t*)(F.ws + WS_U);
    const int b = item >> 6, c = item & 63, l0 = c * 64; const size_t T0 = (size_t)b * SEQ + l0;
    LAS bf16_t* Cg = (LAS bf16_t*)(F.lds + MB_CG); LAS bf16_t* Bg = (LAS bf16_t*)(F.lds + MB_BG); LAS bf16_t* BT = (LAS bf16_t*)(F.lds + MB_BT);
    LAS bf16_t* XT = (LAS bf16_t*)(F.lds + MB_XT); LAS bf16_t* Mb = (LAS bf16_t*)(F.lds + MB_M); LAS bf16_t* S0 = (LAS bf16_t*)(F.lds + MB_S0);
    LAS float* dts = (LAS float*)(F.lds + MB_DT); LAS float* acs = (LAS float*)(F.lds + MB_AC); LAS float* rs = (LAS float*)(F.lds + MB_RS);
    if (F.tid < 256) { const int l = F.tid >> 2, h = F.tid & 3;
        const float raw = bf2f(U[(T0 + l) * NINP + UM + 768 + h]) + F.in[I_MDTB][layer * 4 + h];
        const float dt = softplusf_(raw); dts[l * 4 + h] = dt; acs[l * 4 + h] = -__expf(F.in[I_MALOG][layer * 4 + h]) * dt; }
    if (F.tid < 64) rs[F.tid] = 0.f;
    __syncthreads();
    float mycum = 0.f;
    if (F.tid < 256) { const int l = F.tid >> 2, h = F.tid & 3; for (int s = 0; s <= l; ++s) mycum += acs[s * 4 + h]; }
    __syncthreads();
    if (F.tid < 256) acs[F.tid] = mycum;
    __syncthreads();
    { const int ch8 = F.tid & 63, tg = F.tid >> 6, c0 = ch8 * 8;
      float wv[4][8], bv[8];
#pragma unroll
      for (int j = 0; j < 8; ++j) { bv[j] = F.in[I_MCONVB][layer * 512 + c0 + j];
#pragma unroll
          for (int k = 0; k < 4; ++k) wv[k][j] = F.in[I_MCONVW][(layer * 4 + k) * 512 + c0 + j]; }
      float win[3][8];
#pragma unroll
      for (int k = 0; k < 3; ++k) { const int l = l0 + tg * 8 - 3 + k;
          if (l >= 0) unpack8(*(const u32x4*)(U + ((size_t)b * SEQ + l) * NINP + UM + 256 + c0), win[k]);
          else {
#pragma unroll
              for (int j = 0; j < 8; ++j) win[k][j] = 0.f; } }
#pragma unroll 1
      for (int i = 0; i < 8; ++i) { const int l = tg * 8 + i; float cur[8]; unpack8(*(const u32x4*)(U + (T0 + l) * NINP + UM + 256 + c0), cur);
          float o[8];
#pragma unroll
          for (int j = 0; j < 8; ++j) { o[j] = siluf_(bv[j] + wv[0][j] * win[0][j] + wv[1][j] * win[1][j] + wv[2][j] * win[2][j] + wv[3][j] * cur[j]);
              win[0][j] = win[1][j]; win[1][j] = win[2][j]; win[2][j] = cur[j]; }
          if (c0 < 256) { const int h = c0 >> 6, p0 = c0 & 63; float sc = dts[l * 4 + h]; if (STAGE == 1) sc *= __expf(acs[63 * 4 + h] - acs[l * 4 + h]);
#pragma unroll
              for (int j = 0; j < 8; ++j) XT[(h * 64 + p0 + j) * 72 + l] = f2bf(o[j] * sc); }
          else if (c0 < 384) { const int g = (c0 - 256) >> 6, n0 = (c0 - 256) & 63;
              if (STAGE == 1) {
#pragma unroll
                  for (int j = 0; j < 8; ++j) BT[(g * 64 + n0 + j) * 72 + l] = f2bf(o[j]); }
              else { u32x4 w; w.x = pk2(o[0], o[1]); w.y = pk2(o[2], o[3]); w.z = pk2(o[4], o[5]); w.w = pk2(o[6], o[7]); *(LAS u32x4*)(Bg + (g * 64 + l) * 72 + n0) = w; } }
          else if (STAGE == 2) { const int g = (c0 - 384) >> 6, n0 = (c0 - 384) & 63;
              u32x4 w; w.x = pk2(o[0], o[1]); w.y = pk2(o[2], o[3]); w.z = pk2(o[4], o[5]); w.w = pk2(o[6], o[7]); *(LAS u32x4*)(Cg + (g * 64 + l) * 72 + n0) = w; } } }
    __syncthreads();
    const int g4 = F.lane >> 4, r16 = F.lane & 15;
    if (STAGE == 1) {
        float* MST = (float*)(F.ws + WS_MST) + ((size_t)(b * 64 + c) * 4) * 4096;
#pragma unroll
        for (int q = 0; q < 8; ++q) { const int tix = F.wave * 8 + q, h = tix >> 4, mt = (tix >> 2) & 3, nt = tix & 3;
            f32x4 acc = (f32x4){0.f, 0.f, 0.f, 0.f};
            acc = mma_nt<64>(XT + (h * 64 + mt * 16) * 72, 72, BT + ((h >> 1) * 64 + nt * 16) * 72, 72, acc, F.lane);
#pragma unroll
            for (int i = 0; i < 4; ++i) MST[(size_t)h * 4096 + (mt * 16 + 4 * g4 + i) * 64 + nt * 16 + r16] = acc[i]; }
        if (F.tid < 4) ((float*)(F.ws + WS_MDEC))[(b * 64 + c) * 4 + F.tid] = __expf(acs[63 * 4 + F.tid]);
    } else {
        const int mt = F.wave & 3, nh = F.wave >> 2;
        const float* MST = (const float*)(F.ws + WS_MST) + ((size_t)(b * 64 + c) * 4) * 4096;
        f32x4 G[2], yv[4][2];
#pragma unroll
        for (int h = 0; h < 4; ++h) {
            const int g = h >> 1;
            { const float* src = MST + (size_t)h * 4096 + F.tid * 8; const f32x4 a = *(const f32x4*)src, bq = *(const f32x4*)(src + 4);
              u32x4 w; w.x = pk2(a[0], a[1]); w.y = pk2(a[2], a[3]); w.z = pk2(bq[0], bq[1]); w.w = pk2(bq[2], bq[3]);
              *(LAS u32x4*)(S0 + (F.tid >> 3) * 72 + (F.tid & 7) * 8) = w; }
            if ((h & 1) == 0) {
#pragma unroll
                for (int q = 0; q < 2; ++q) { G[q] = (f32x4){0.f, 0.f, 0.f, 0.f};
                    G[q] = mma_nt<64>(Cg + (g * 64 + mt * 16) * 72, 72, Bg + (g * 64 + (2 * nh + q) * 16) * 72, 72, G[q], F.lane); } }
#pragma unroll
            for (int q = 0; q < 2; ++q) { const int s = (2 * nh + q) * 16 + r16; const float as = acs[s * 4 + h];
#pragma unroll
                for (int i = 0; i < 4; ++i) { const int l = mt * 16 + 4 * g4 + i; const float v = (s <= l) ? G[q][i] * __expf(acs[l * 4 + h] - as) : 0.f;
                    Mb[l * 72 + s] = f2bf(v); } }
            __syncthreads();
#pragma unroll
            for (int q = 0; q < 2; ++q) { const int nt = 2 * nh + q;
                f32x4 yd = (f32x4){0.f, 0.f, 0.f, 0.f}, yo = (f32x4){0.f, 0.f, 0.f, 0.f};
                yd = mma_nt<64>(Mb + mt * 16 * 72, 72, XT + (h * 64 + nt * 16) * 72, 72, yd, F.lane);
                yo = mma_nt<64>(Cg + (g * 64 + mt * 16) * 72, 72, S0 + nt * 16 * 72, 72, yo, F.lane);
                const int p = nt * 16 + r16; const float dsk = F.in[I_MD][layer * 4 + h];
#pragma unroll
                for (int i = 0; i < 4; ++i) { const int l = mt * 16 + 4 * g4 + i;
                    const float xs = bf2f(XT[(h * 64 + p) * 72 + l]) / dts[l * 4 + h];
                    yv[h][q][i] = yd[i] + yo[i] * __expf(acs[l * 4 + h]) + dsk * xs; } }
            __syncthreads();
        }
        float part[4] = {0.f, 0.f, 0.f, 0.f};
#pragma unroll
        for (int h = 0; h < 4; ++h)
#pragma unroll
            for (int q = 0; q < 2; ++q) { const int ch = h * 64 + (2 * nh + q) * 16 + r16;
#pragma unroll
                for (int i = 0; i < 4; ++i) { const int l = mt * 16 + 4 * g4 + i; const float z = bf2f(U[(T0 + l) * NINP + UM + ch]);
                    const float v = yv[h][q][i] * siluf_(z); yv[h][q][i] = v; part[i] += v * v; } }
#pragma unroll
        for (int i = 0; i < 4; ++i) { const float s = sum16(part[i]); if (r16 == 0) atomicAdd((float*)(rs + mt * 16 + 4 * g4 + i), s); }
        __syncthreads();
        bf16_t* Y = (bf16_t*)(F.ws + WS_H);
#pragma unroll
        for (int i = 0; i < 4; ++i) { const int l = mt * 16 + 4 * g4 + i; const float rstd = rsqrtf(rs[l] * (1.0f / 256.0f) + 1e-6f);
#pragma unroll
            for (int h = 0; h < 4; ++h)
#pragma unroll
                for (int q = 0; q < 2; ++q) { const int ch = h * 64 + (2 * nh + q) * 16 + r16;
                    Y[(T0 + l) * DM + ch] = f2bf(yv[h][q][i] * rstd * F.in[I_MNORM][layer * 256 + ch]); } }
    }
}
__device__ __forceinline__ void item_mamba_carry(const Frame& F_, int item) { Frame F = relocal(F_);
    const int b = item >> 2, h = item & 3;
    float* MST = (float*)(F.ws + WS_MST); const float* MD = (const float*)(F.ws + WS_MDEC);
    float s[8];
#pragma unroll
    for (int j = 0; j < 8; ++j) s[j] = 0.f;
    for (int c = 0; c < 64; ++c) { float* p = MST + ((size_t)(b * 64 + c) * 4 + h) * 4096 + F.tid * 8; const float d = MD[(b * 64 + c) * 4 + h];
        const f32x4 a = *(f32x4*)p, q = *(f32x4*)(p + 4);
        *(f32x4*)p = (f32x4){s[0], s[1], s[2], s[3]}; *(f32x4*)(p + 4) = (f32x4){s[4], s[5], s[6], s[7]};
        s[0] = s[0] * d + a[0]; s[1] = s[1] * d + a[1]; s[2] = s[2] * d + a[2]; s[3] = s[3] * d + a[3];
        s[4] = s[4] * d + q[0]; s[5] = s[5] * d + q[1]; s[6] = s[6] * d + q[2]; s[7] = s[7] * d + q[3]; }
}

template <int STAGE> __device__ __forceinline__ void item_s5(const Frame& F_, int layer, int item) { Frame F = relocal(F_);
    const bf16_t* U = (const bf16_t*)(F.ws + WS_U);
    const int b = item >> 6, c = item & 63; const size_t T0 = (size_t)b * SEQ + c * 64;
    LAS float* us = (LAS float*)F.lds; LAS bf16_t* Hs = (LAS bf16_t*)(F.lds + 65536);
    const float* tab = (const float*)(F.ws + WS_S5TAB + (size_t)layer * S5TAB_L);
    { const int tok = F.tid >> 3, part = F.tid & 7;
#pragma unroll
      for (int q = 0; q < 4; ++q) { float f[8]; unpack8(*(const u32x4*)(U + (T0 + tok) * NINP + US + 32 * part + 8 * q), f);
          *(LAS f32x4*)(us + tok * 256 + 32 * part + 8 * q) = (f32x4){f[0], f[1], f[2], f[3]}; *(LAS f32x4*)(us + tok * 256 + 32 * part + 8 * q + 4) = (f32x4){f[4], f[5], f[6], f[7]}; } }
    const int g = F.tid >> 5, n0 = F.tid & 31, gn0 = g * 64 + n0, gn1 = gn0 + 32;
    float bb0[32], bb1[32];
#pragma unroll
    for (int j = 0; j < 32; j += 4) { const f32x4 a = *(const f32x4*)(tab + 4096 + gn0 * 32 + j), bq = *(const f32x4*)(tab + 4096 + gn1 * 32 + j);
        bb0[j] = a[0]; bb0[j + 1] = a[1]; bb0[j + 2] = a[2]; bb0[j + 3] = a[3]; bb1[j] = bq[0]; bb1[j + 1] = bq[1]; bb1[j + 2] = bq[2]; bb1[j + 3] = bq[3]; }
    const float a0r = tab[gn0 * 2], a0i = tab[gn0 * 2 + 1], a1r = tab[gn1 * 2], a1i = tab[gn1 * 2 + 1];
    float* ST = (float*)(F.ws + WS_S5ST) + (size_t)(b * 64 + c) * 2048;
    float h0r = 0.f, h0i = 0.f, h1r = 0.f, h1i = 0.f;
    if (STAGE == 2) { h0r = ST[gn0 * 2]; h0i = ST[gn0 * 2 + 1]; h1r = ST[gn1 * 2]; h1i = ST[gn1 * 2 + 1]; }
    bf16x8 cf[2][4];
    if (STAGE == 2) { const bf16_t* cm = (const bf16_t*)(F.ws + WS_S5TAB + (size_t)layer * S5TAB_L + S5TAB_F);
#pragma unroll
        for (int gg = 0; gg < 2; ++gg)
#pragma unroll
            for (int ks = 0; ks < 4; ++ks) cf[gg][ks] = *(const bf16x8*)(cm + ((size_t)((2 * F.wave + gg) * 16 + (F.lane & 15))) * 128 + 32 * ks + 8 * (F.lane >> 4)); }
    __syncthreads();
#pragma unroll 1
    for (int lb = 0; lb < 4; ++lb) {
#pragma unroll 2
        for (int li = 0; li < 16; ++li) { const int l = lb * 16 + li;
            float uu[16];
#pragma unroll
            for (int q = 0; q < 4; ++q) { const f32x4 v = *(const LAS f32x4*)(us + l * 256 + g * 16 + 4 * q); uu[4 * q] = v[0]; uu[4 * q + 1] = v[1]; uu[4 * q + 2] = v[2]; uu[4 * q + 3] = v[3]; }
            float b0r = 0.f, b0i = 0.f, b1r = 0.f, b1i = 0.f;
#pragma unroll
            for (int p = 0; p < 16; ++p) { b0r += bb0[2 * p] * uu[p]; b0i += bb0[2 * p + 1] * uu[p]; b1r += bb1[2 * p] * uu[p]; b1i += bb1[2 * p + 1] * uu[p]; }
            { const float nr = a0r * h0r - a0i * h0i + b0r, ni = a0r * h0i + a0i * h0r + b0i; h0r = nr; h0i = ni; }
            { const float nr = a1r * h1r - a1i * h1i + b1r, ni = a1r * h1i + a1i * h1r + b1i; h1r = nr; h1i = ni; }
            if (STAGE == 2) { LAS bf16_t* hp = Hs + li * 2056 + g * 128; hp[n0] = f2bf(h0r); hp[64 + n0] = f2bf(h0i); hp[n0 + 32] = f2bf(h1r); hp[96 + n0] = f2bf(h1i); }
        }
        if (STAGE == 2) {
            __syncthreads();
            bf16_t* YS = (bf16_t*)(F.ws + WS_MOE + YSG_OFF);
#pragma unroll
            for (int gg = 0; gg < 2; ++gg) { const int gq = 2 * F.wave + gg; f32x4 acc = (f32x4){0.f, 0.f, 0.f, 0.f};
#pragma unroll
                for (int ks = 0; ks < 4; ++ks) { const bf16x8 a = *(const LAS bf16x8*)(Hs + (F.lane & 15) * 2056 + gq * 128 + 32 * ks + 8 * (F.lane >> 4));
                    acc = __builtin_amdgcn_mfma_f32_16x16x32_bf16(a, cf[gg][ks], acc, 0, 0, 0); }
                const int ch = gq * 16 + (F.lane & 15); const float dsk = F.in[I_SD][layer * 256 + ch];
#pragma unroll
                for (int i = 0; i < 4; ++i) { const int l = lb * 16 + 4 * (F.lane >> 4) + i; const float y = acc[i] + dsk * us[l * 256 + ch];
                    YS[(T0 + l) * 256 + ch] = f2bf(gelu_tanh(y)); } }
            __syncthreads();
        }
    }
    if (STAGE == 1) { ST[gn0 * 2] = h0r; ST[gn0 * 2 + 1] = h0i; ST[gn1 * 2] = h1r; ST[gn1 * 2 + 1] = h1i; }
    if (STAGE == 2) {
        asm volatile("s_waitcnt vmcnt(0)" ::: "memory"); __syncthreads();
        const bf16_t* YS = (const bf16_t*)(F.ws + WS_MOE + YSG_OFF) + T0 * 256; const bf16_t* GW = (const bf16_t*)(F.ws + WS_GLU) + (size_t)layer * 512 * 256;
        const int r16 = F.lane & 15, g4 = F.lane >> 4;
        f32x4 av[4][2], ag[4][2];
#pragma unroll
        for (int m = 0; m < 4; ++m)
#pragma unroll
            for (int q = 0; q < 2; ++q) { av[m][q] = (f32x4){0.f, 0.f, 0.f, 0.f}; ag[m][q] = (f32x4){0.f, 0.f, 0.f, 0.f}; }
#pragma unroll 2
        for (int ks = 0; ks < 8; ++ks) {
            bf16x8 af[4], bv[2], bg[2];
#pragma unroll
            for (int m = 0; m < 4; ++m) af[m] = *(const bf16x8*)(YS + (size_t)(16 * m + r16) * 256 + 32 * ks + 8 * g4);
#pragma unroll
            for (int q = 0; q < 2; ++q) { const int c = 32 * F.wave + 16 * q + r16; const int rowv = 256 * (c >> 7) + (c & 127);
                bv[q] = *(const bf16x8*)(GW + (size_t)rowv * 256 + 32 * ks + 8 * g4); bg[q] = *(const bf16x8*)(GW + (size_t)(rowv + 128) * 256 + 32 * ks + 8 * g4); }
#pragma unroll
            for (int m = 0; m < 4; ++m)
#pragma unroll
                for (int q = 0; q < 2; ++q) { av[m][q] = __builtin_amdgcn_mfma_f32_16x16x32_bf16(af[m], bv[q], av[m][q], 0, 0, 0); ag[m][q] = __builtin_amdgcn_mfma_f32_16x16x32_bf16(af[m], bg[q], ag[m][q], 0, 0, 0); }
        }
        bf16_t* Y = (bf16_t*)(F.ws + WS_H);
#pragma unroll
        for (int q = 0; q < 2; ++q) { const int c = 32 * F.wave + 16 * q + r16; const float bvl = F.in[I_SGLUB][layer * 512 + c], bgt = F.in[I_SGLUB][layer * 512 + 256 + c];
#pragma unroll
            for (int m = 0; m < 4; ++m)
#pragma unroll
                for (int i = 0; i < 4; ++i) Y[(T0 + 16 * m + 4 * g4 + i) * DM + 768 + c] = f2bf((av[m][q][i] + bvl) * sigmoidf_(ag[m][q][i] + bgt)); }
    }
}
__device__ __forceinline__ void item_s5_carry(const Frame& F_, int layer, int b) { Frame F = relocal(F_);
    const float* tab = (const float*)(F.ws + WS_S5TAB + (size_t)layer * S5TAB_L) + 2048;
    float* ST = (float*)(F.ws + WS_S5ST) + (size_t)b * 64 * 2048;
#pragma unroll
    for (int q = 0; q < 2; ++q) { const int gn = F.tid + 512 * q; const float pr = tab[gn * 2], pi = tab[gn * 2 + 1]; float hr = 0.f, hi = 0.f;
        for (int c = 0; c < 64; ++c) { float* p = ST + (size_t)c * 2048 + gn * 2; const float tr = p[0], ti = p[1]; p[0] = hr; p[1] = hi;
            const float nr = pr * hr - pi * hi + tr, ni = pr * hi + pi * hr + ti; hr = nr; hi = ni; } }
}

constexpr int RB_LD = 72;
constexpr int RW_R = 0, RW_K = 16384, RW_V = 32768, RW_W = 49152, RW_A = 65536, RW_B = 81920;
constexpr int R3_G = 49152, R3_O = 65536, R3_TILES = 81920, R3_BON = 147456;
template <int STAGE> __device__ __forceinline__ void rwkv_prep(const Frame& F_, int layer, int b, int h, int c) { Frame F = relocal(F_);
    const bf16_t* U = (const bf16_t*)(F.ws + WS_U);
    const int l0 = c * 64; const size_t T0 = (size_t)b * SEQ + l0;
    LAS float* Rr = (LAS float*)(F.lds + RW_R); LAS float* Kk = (LAS float*)(F.lds + RW_K); LAS float* Vv = (LAS float*)(F.lds + RW_V); LAS float* Ww = (LAS float*)(F.lds + RW_W);
    LAS float* Aa = (LAS float*)(F.lds + (STAGE == 1 ? RW_A : R3_O)); LAS float* Bb = (LAS float*)(F.lds + RW_B); LAS float* Gg = (LAS float*)(F.lds + R3_G); LAS float* BON = (LAS float*)(F.lds + R3_BON);
    LAS bf16_t* TWb = (LAS bf16_t*)(F.lds + 98304); LAS bf16_t* DAb = (LAS bf16_t*)(F.lds + (STAGE == 1 ? 103424 : 118784)); LAS bf16_t* SGb = (LAS bf16_t*)(F.lds + 123904);
    LAS bf16_t* w2T = (LAS bf16_t*)(F.lds + 108544); LAS bf16_t* a2T = (LAS bf16_t*)(F.lds + (STAGE == 1 ? 113664 : 133120)); LAS bf16_t* g2T = (LAS bf16_t*)(F.lds + 138240);
    const float* mu = F.in[I_RMU] + layer * 896;
    { const int tok = F.tid >> 3, p8 = F.tid & 7; const bool first = (l0 + tok == 0);
      const bf16_t* cur = U + (T0 + tok) * NINP + UR; const bf16_t* prv = cur - NINP;
#pragma unroll
      for (int sec = 0; sec < 3; ++sec) { const int co = sec * 256 + h * 64 + 8 * p8; float av[8], pq[8]; unpack8(*(const u32x4*)(cur + co), av);
          if (first) {
#pragma unroll
              for (int j = 0; j < 8; ++j) pq[j] = 0.f; } else unpack8(*(const u32x4*)(prv + co), pq);
          const f32x4 m0 = *(const f32x4*)(mu + co), m1 = *(const f32x4*)(mu + co + 4);
          LAS float* dst = (sec == 0 ? Rr : sec == 1 ? Kk : Vv) + tok * 64 + 8 * p8;
          *(LAS f32x4*)dst = (f32x4){av[0] + m0[0] * (pq[0] - av[0]), av[1] + m0[1] * (pq[1] - av[1]), av[2] + m0[2] * (pq[2] - av[2]), av[3] + m0[3] * (pq[3] - av[3])};
          *(LAS f32x4*)(dst + 4) = (f32x4){av[4] + m1[0] * (pq[4] - av[4]), av[5] + m1[1] * (pq[5] - av[5]), av[6] + m1[2] * (pq[6] - av[6]), av[7] + m1[3] * (pq[7] - av[7])}; }
      { const int co = 768 + (STAGE == 1 ? 0 : 32) + 4 * p8;
        const u32x2 cv = *(const u32x2*)(cur + co); u32x2 pv = (u32x2){0u, 0u}; if (!first) pv = *(const u32x2*)(prv + co);
        const f32x4 m0 = *(const f32x4*)(mu + co);
        float x[4] = {__uint_as_float(cv.x << 16), __uint_as_float(cv.x & 0xffff0000u), __uint_as_float(cv.y << 16), __uint_as_float(cv.y & 0xffff0000u)};
        const float y[4] = {__uint_as_float(pv.x << 16), __uint_as_float(pv.x & 0xffff0000u), __uint_as_float(pv.y << 16), __uint_as_float(pv.y & 0xffff0000u)};
#pragma unroll
        for (int j = 0; j < 4; ++j) { x[j] = x[j] + m0[j] * (y[j] - x[j]); if (STAGE == 1) x[j] = tanhf_(x[j]); }
        *(LAS u32x2*)((STAGE == 1 ? TWb : DAb) + tok * 40 + 4 * p8) = (u32x2){pk2(x[0], x[1]), pk2(x[2], x[3])}; }
      if (STAGE == 1) { const int co = 800 + 4 * p8;
        const u32x2 cv = *(const u32x2*)(cur + co); u32x2 pv = (u32x2){0u, 0u}; if (!first) pv = *(const u32x2*)(prv + co);
        const f32x4 m0 = *(const f32x4*)(mu + co);
        float x[4] = {__uint_as_float(cv.x << 16), __uint_as_float(cv.x & 0xffff0000u), __uint_as_float(cv.y << 16), __uint_as_float(cv.y & 0xffff0000u)};
        const float y[4] = {__uint_as_float(pv.x << 16), __uint_as_float(pv.x & 0xffff0000u), __uint_as_float(pv.y << 16), __uint_as_float(pv.y & 0xffff0000u)};
#pragma unroll
        for (int j = 0; j < 4; ++j) x[j] = x[j] + m0[j] * (y[j] - x[j]);
        *(LAS u32x2*)(DAb + tok * 40 + 4 * p8) = (u32x2){pk2(x[0], x[1]), pk2(x[2], x[3])}; }
      if (STAGE == 3) { const int co = 832 + 8 * p8; float av[8], pq[8]; unpack8(*(const u32x4*)(cur + co), av);
          if (first) {
#pragma unroll
              for (int j = 0; j < 8; ++j) pq[j] = 0.f; } else unpack8(*(const u32x4*)(prv + co), pq);
          const f32x4 m0 = *(const f32x4*)(mu + co), m1 = *(const f32x4*)(mu + co + 4); float x[8];
#pragma unroll
          for (int j = 0; j < 8; ++j) x[j] = sigmoidf_(av[j] + (j < 4 ? m0[j] : m1[j - 4]) * (pq[j] - av[j]));
          *(LAS u32x4*)(SGb + tok * RB_LD + 8 * p8) = (u32x4){pk2(x[0], x[1]), pk2(x[2], x[3]), pk2(x[4], x[5]), pk2(x[6], x[7])}; } }
    { const int ch = F.tid & 63, part = F.tid >> 6;
      if (STAGE == 1) { const float* w2 = F.in[I_RW2] + ((size_t)layer * 32 + 4 * part) * 256 + h * 64 + ch;
          *(LAS u32x2*)(w2T + ch * 40 + 4 * part) = (u32x2){pk2(w2[0], w2[256]), pk2(w2[512], w2[768])}; }
      { const float* a2 = F.in[I_RA2] + ((size_t)layer * 32 + 4 * part) * 256 + h * 64 + ch;
          *(LAS u32x2*)(a2T + ch * 40 + 4 * part) = (u32x2){pk2(a2[0], a2[256]), pk2(a2[512], a2[768])}; }
      if (STAGE == 3) { const float* g2 = F.in[I_RG2] + ((size_t)layer * 64 + 8 * part) * 256 + h * 64 + ch;
          *(LAS u32x4*)(g2T + ch * RB_LD + 8 * part) = (u32x4){pk2(g2[0], g2[256]), pk2(g2[512], g2[768]), pk2(g2[1024], g2[1280]), pk2(g2[1536], g2[1792])}; } }
    __syncthreads();
    { const int lane = F.lane, mt = F.wave >> 1, nt0 = 2 * (F.wave & 1), r = lane & 15, g4 = lane >> 4; const f32x4 zero4 = (f32x4){0.f, 0.f, 0.f, 0.f};
#pragma unroll
      for (int q = 0; q < 2; ++q) { const int nt = nt0 + q, ch = 16 * nt + r, cg = layer * 256 + h * 64 + ch;
          if (STAGE == 1) { const f32x4 wl = mma_nt<32>(TWb + 16 * mt * 40, 40, w2T + 16 * nt * 40, 40, zero4, lane); const float w0 = F.in[I_RW0][cg];
#pragma unroll
              for (int i = 0; i < 4; ++i) { const float x = w0 + wl[i]; const float wlog = -__logf(1.0f + __expf(-x)) - 0.5f; Ww[(16 * mt + 4 * g4 + i) * 64 + ch] = __expf(-__expf(wlog)); } }
          { const f32x4 al = mma_nt<32>(DAb + 16 * mt * 40, 40, a2T + 16 * nt * 40, 40, zero4, lane); const float a0 = F.in[I_RA0][cg];
#pragma unroll
              for (int i = 0; i < 4; ++i) Aa[(16 * mt + 4 * g4 + i) * 64 + ch] = sigmoidf_(a0 + al[i]); }
          if (STAGE == 3) { const f32x4 gv = mma_nt<64>(SGb + 16 * mt * RB_LD, RB_LD, g2T + 16 * nt * RB_LD, RB_LD, zero4, lane);
#pragma unroll
              for (int i = 0; i < 4; ++i) Gg[(16 * mt + 4 * g4 + i) * 64 + ch] = gv[i]; } } }
    __syncthreads();
    { const int j = F.lane, tq = F.wave, cg = layer * 256 + h * 64 + j;
      const float kkw = F.in[I_RKK][cg], kaw = F.in[I_RKA][cg], rk = F.in[I_RRK][cg];
#pragma unroll 2
      for (int i8 = 0; i8 < 8; ++i8) { const int t = tq + 8 * i8;
          const float a = Aa[t * 64 + j]; const float kraw = Kk[t * 64 + j]; const float kp = kraw * (1.0f + (a - 1.0f) * kaw);
          Kk[t * 64 + j] = kp;
          if (STAGE == 1) { const float kkv = kraw * kkw; const float ss = wave_sum(kkv * kkv); const float kkn = kkv * rsqrtf(fmaxf(ss, 1e-24f)); Aa[t * 64 + j] = -kkn; Bb[t * 64 + j] = kkn * a; }
          if (STAGE == 3) { const float bo = wave_sum(Rr[t * 64 + j] * kp * rk); if (j == 0) BON[t] = bo; } } }
    __syncthreads();
}
constexpr int RB_AT = 98304, RB_ATT = RB_AT + 9216, RB_BT = RB_ATT + 9216, RB_BTT = RB_BT + 9216, RB_KT = RB_BTT + 9216, RB_RT = RB_KT + 9216, RB_VT = RB_RT + 9216, RB_GC = RB_VT + 9216;
constexpr int RX_X = 0, RX_XT = 9216, RX_TB = 18432, RX_M = 27648, RX_NRT = 36864, RX_G1T = 46080, RX_G2T = 55296, RX_QT = 64512;
__device__ __forceinline__ void st_tile(LAS bf16_t* dst, int mt, int nt, const f32x4 v, int lane) {
    const int r = lane & 15, g = lane >> 4;
#pragma unroll
    for (int i = 0; i < 4; ++i) dst[(16 * mt + 4 * g + i) * RB_LD + 16 * nt + r] = f2bf(v[i]);
}
__device__ __forceinline__ void st_tile_t(LAS bf16_t* dst, int mt, int nt, const f32x4 v, int lane) {
    const int r = lane & 15, g = lane >> 4; u32x2 w; w.x = pk2(v[0], v[1]); w.y = pk2(v[2], v[3]);
    *(LAS u32x2*)(dst + (16 * nt + r) * RB_LD + 16 * mt + 4 * g) = w;
}
__device__ __forceinline__ void item_rwkv1(const Frame& F_, int layer, int item) { Frame F = relocal(F_);
    const int b = item >> 8, h = (item >> 6) & 3, c = item & 63;
    rwkv_prep<1>(F, layer, b, h, c);
    LAS float* Rr = (LAS float*)(F.lds + RW_R); LAS float* Kk = (LAS float*)(F.lds + RW_K); LAS float* Vv = (LAS float*)(F.lds + RW_V); LAS float* Ww = (LAS float*)(F.lds + RW_W);
    LAS float* Aa = (LAS float*)(F.lds + RW_A); LAS float* Bb = (LAS float*)(F.lds + RW_B);
    LAS bf16_t* At = (LAS bf16_t*)(F.lds + RB_AT); LAS bf16_t* AtT = (LAS bf16_t*)(F.lds + RB_ATT); LAS bf16_t* Bt = (LAS bf16_t*)(F.lds + RB_BT); LAS bf16_t* BtT = (LAS bf16_t*)(F.lds + RB_BTT);
    LAS bf16_t* Kt = (LAS bf16_t*)(F.lds + RB_KT); LAS bf16_t* Rt = (LAS bf16_t*)(F.lds + RB_RT); LAS bf16_t* VT = (LAS bf16_t*)(F.lds + RB_VT); LAS float* gC = (LAS float*)(F.lds + RB_GC);
    LAS bf16_t* X = (LAS bf16_t*)(F.lds + RX_X); LAS bf16_t* XT = (LAS bf16_t*)(F.lds + RX_XT); LAS bf16_t* Tb = (LAS bf16_t*)(F.lds + RX_TB); LAS bf16_t* Mm = (LAS bf16_t*)(F.lds + RX_M);
    LAS bf16_t* NrT = (LAS bf16_t*)(F.lds + RX_NRT); LAS bf16_t* G1T = (LAS bf16_t*)(F.lds + RX_G1T); LAS bf16_t* G2T = (LAS bf16_t*)(F.lds + RX_G2T); LAS bf16_t* QT = (LAS bf16_t*)(F.lds + RX_QT);
    { const int k = F.tid & 63, part = F.tid >> 6; float g = 1.0f;
      for (int t = 0; t < 8 * part; ++t) g *= Ww[t * 64 + k];
#pragma unroll
      for (int i = 0; i < 8; ++i) { const int t = 8 * part + i; const float gp = g; g *= Ww[t * 64 + k]; const float ig = 1.0f / g;
          const bf16_t av = f2bf(Aa[t * 64 + k] * gp), bv = f2bf(Bb[t * 64 + k] * ig);
          At[t * RB_LD + k] = av; AtT[k * RB_LD + t] = av; Bt[t * RB_LD + k] = bv; BtT[k * RB_LD + t] = bv;
          Kt[t * RB_LD + k] = f2bf(Kk[t * 64 + k] * ig); Rt[t * RB_LD + k] = f2bf(Rr[t * 64 + k] * g); VT[k * RB_LD + t] = f2bf(Vv[t * 64 + k]); }
      if (part == 7) gC[k] = g; }
    __syncthreads();
    const int lane = F.lane, mt = F.wave >> 1, nt0 = 2 * (F.wave & 1), r = lane & 15, g4 = lane >> 4;
    const f32x4 zero4 = (f32x4){0.f, 0.f, 0.f, 0.f};
    f32x4 Tacc[2];
#pragma unroll
    for (int q = 0; q < 2; ++q) { const int nt = nt0 + q;
        f32x4 n = mma_nt<64>(Bt + 16 * mt * RB_LD, RB_LD, At + 16 * nt * RB_LD, RB_LD, zero4, lane);
        f32x4 m = mma_nt<64>(Kt + 16 * mt * RB_LD, RB_LD, At + 16 * nt * RB_LD, RB_LD, zero4, lane);
        f32x4 nr = mma_nt<64>(Rt + 16 * mt * RB_LD, RB_LD, Bt + 16 * nt * RB_LD, RB_LD, zero4, lane);
#pragma unroll
        for (int i = 0; i < 4; ++i) { const int row = 16 * mt + 4 * g4 + i, col = 16 * nt + r;
            n[i] = (row < col) ? n[i] : 0.f; m[i] = (row < col) ? m[i] : 0.f; nr[i] = (col <= row) ? nr[i] : 0.f;
            Tacc[q][i] = n[i] + (row == col ? 1.0f : 0.f); }
        st_tile(X, mt, nt, n, lane); st_tile_t(XT, mt, nt, n, lane); st_tile(Tb, mt, nt, Tacc[q], lane); st_tile(Mm, mt, nt, m, lane); st_tile(NrT, mt, nt, nr, lane); }
    __syncthreads();
#pragma unroll 1
    for (int it = 0; it < 6; ++it) {
        f32x4 x2[2];
#pragma unroll
        for (int q = 0; q < 2; ++q) { const int nt = nt0 + q;
            if (it > 0) Tacc[q] = mma_nt<64>(Tb + 16 * mt * RB_LD, RB_LD, XT + 16 * nt * RB_LD, RB_LD, Tacc[q], lane);
            x2[q] = zero4; if (it < 5) x2[q] = mma_nt<64>(X + 16 * mt * RB_LD, RB_LD, XT + 16 * nt * RB_LD, RB_LD, zero4, lane); }
        __syncthreads();
#pragma unroll
        for (int q = 0; q < 2; ++q) { const int nt = nt0 + q;
            if (it > 0) st_tile(Tb, mt, nt, Tacc[q], lane);
            if (it < 5) { st_tile(X, mt, nt, x2[q], lane); st_tile_t(XT, mt, nt, x2[q], lane); } }
        __syncthreads();
    }
#pragma unroll
    for (int q = 0; q < 2; ++q) { const int nt = nt0 + q;
        st_tile(G1T, mt, nt, mma_nt<64>(NrT + 16 * mt * RB_LD, RB_LD, Tb + 16 * nt * RB_LD, RB_LD, zero4, lane), lane);
        st_tile(G2T, mt, nt, mma_nt<64>(BtT + 16 * mt * RB_LD, RB_LD, Tb + 16 * nt * RB_LD, RB_LD, zero4, lane), lane); }
    __syncthreads();
    const size_t ci = (size_t)(b * 4 + h) * 64 + c;
    bf16_t* gPT = (bf16_t*)(F.ws + WS_MOE + RW_PT) + ci * 4096; bf16_t* gW1 = (bf16_t*)(F.ws + WS_MOE + RW_W1) + ci * 4096; bf16_t* gZ = (bf16_t*)(F.ws + WS_MOE + RW_Z) + ci * 4096;
#pragma unroll
    for (int q = 0; q < 2; ++q) { const int nt = nt0 + q; const int col = 16 * nt + r;
        f32x4 w1 = mma_nt<64>(G1T + 16 * mt * RB_LD, RB_LD, AtT + 16 * nt * RB_LD, RB_LD, zero4, lane);
        f32x4 z = mma_nt<64>(G1T + 16 * mt * RB_LD, RB_LD, Mm + 16 * nt * RB_LD, RB_LD, zero4, lane);
        f32x4 mr = mma_nt<64>(Rt + 16 * mt * RB_LD, RB_LD, Kt + 16 * nt * RB_LD, RB_LD, zero4, lane);
        f32x4 p = mma_nt<64>(G2T + 16 * mt * RB_LD, RB_LD, AtT + 16 * nt * RB_LD, RB_LD, zero4, lane);
        f32x4 qq = mma_nt<64>(G2T + 16 * mt * RB_LD, RB_LD, Mm + 16 * nt * RB_LD, RB_LD, zero4, lane);
        const int pos = 32 * (col >> 5) + 8 * ((col >> 2) & 3) + 4 * ((col >> 4) & 1) + (col & 3);
#pragma unroll
        for (int i = 0; i < 4; ++i) { const int row = 16 * mt + 4 * g4 + i;
            gW1[row * 64 + col] = f2bf(w1[i] + bf2f(Rt[row * RB_LD + col]));
            gZ[row * 64 + col] = f2bf(z[i] + (col <= row ? mr[i] : 0.f));
            const float gc = gC[row];
            gPT[row * 64 + pos] = f2bf((p[i] + (row == col ? 1.0f : 0.f)) * gc);
            qq[i] = (qq[i] + bf2f(Kt[col * RB_LD + row])) * gc; }
        st_tile(QT, mt, nt, qq, lane); }
    __syncthreads();
    bf16_t* gU = (bf16_t*)(F.ws + WS_MOE + RW_U) + ci * 4096;
#pragma unroll
    for (int q = 0; q < 2; ++q) { const int nt = nt0 + q;
        const f32x4 u = mma_nt<64>(VT + 16 * mt * RB_LD, RB_LD, QT + 16 * nt * RB_LD, RB_LD, zero4, lane);
#pragma unroll
        for (int i = 0; i < 4; ++i) gU[(16 * mt + 4 * g4 + i) * 64 + 16 * nt + r] = f2bf(u[i]); }
}
__device__ __forceinline__ void item_rwkv_carry(const Frame& F_, int item) { Frame F = relocal(F_);
    const int bh = item * 2 + (F.wave >> 2), nt = F.wave & 3, r = F.lane & 15, g = F.lane >> 4;
    const bf16_t* PT = (const bf16_t*)(F.ws + WS_MOE + RW_PT); const bf16_t* Uc = (const bf16_t*)(F.ws + WS_MOE + RW_U); bf16_t* Ss = (bf16_t*)(F.ws + WS_MOE + RW_S);
    f32x4 acc[4];
#pragma unroll
    for (int m = 0; m < 4; ++m) acc[m] = (f32x4){0.f, 0.f, 0.f, 0.f};
    for (int c = 0; c < 64; ++c) { const size_t ci = (size_t)bh * 64 + c;
        bf16x8 af[4][2]; f32x4 cin[4];
#pragma unroll
        for (int m = 0; m < 4; ++m) { const u32x2 uv = *(const u32x2*)(Uc + ci * 4096 + (16 * nt + r) * 64 + 16 * m + 4 * g);
            cin[m] = (f32x4){__uint_as_float(uv.x << 16), __uint_as_float(uv.x & 0xffff0000u), __uint_as_float(uv.y << 16), __uint_as_float(uv.y & 0xffff0000u)};
#pragma unroll
            for (int s = 0; s < 2; ++s) af[m][s] = *(const bf16x8*)(PT + ci * 4096 + (16 * m + r) * 64 + 32 * s + 8 * g); }
        unsigned pw[4][2];
#pragma unroll
        for (int m = 0; m < 4; ++m) { pw[m][0] = pk2(acc[m][0], acc[m][1]); pw[m][1] = pk2(acc[m][2], acc[m][3]);
            *(u32x2*)(Ss + ci * 4096 + (16 * nt + r) * 64 + 16 * m + 4 * g) = (u32x2){pw[m][0], pw[m][1]}; }
        bf16x8 bfr[2];
#pragma unroll
        for (int s = 0; s < 2; ++s) bfr[s] = __builtin_bit_cast(bf16x8, (u32x4){pw[2 * s][0], pw[2 * s][1], pw[2 * s + 1][0], pw[2 * s + 1][1]});
#pragma unroll
        for (int m = 0; m < 4; ++m) { acc[m] = __builtin_amdgcn_mfma_f32_16x16x32_bf16(af[m][0], bfr[0], cin[m], 0, 0, 0);
            acc[m] = __builtin_amdgcn_mfma_f32_16x16x32_bf16(af[m][1], bfr[1], acc[m], 0, 0, 0); }
    }
}
__device__ __forceinline__ void item_rwkv3(const Frame& F_, int layer, int item) { Frame F = relocal(F_);
    const int b = item >> 8, h = (item >> 6) & 3, c = item & 63; const size_t T0 = (size_t)b * SEQ + c * 64;
    rwkv_prep<3>(F, layer, b, h, c);
#ifdef PROBE_PREP
    rwkv_prep<3>(F, layer, b, h, c);
#endif
    LAS float* Vv = (LAS float*)(F.lds + RW_V); LAS float* Oo = (LAS float*)(F.lds + R3_O);
    LAS float* Gg = (LAS float*)(F.lds + R3_G); LAS float* BON = (LAS float*)(F.lds + R3_BON);
    LAS bf16_t* S0b = (LAS bf16_t*)(F.lds + R3_TILES); LAS bf16_t* W1b = S0b + 4608; LAS bf16_t* Zb = W1b + 4608; LAS bf16_t* VTb = Zb + 4608;
    { const size_t ci = (size_t)(b * 4 + h) * 64 + c; const int row = F.tid >> 3, col = (F.tid & 7) * 8;
      *(LAS u32x4*)(S0b + row * RB_LD + col) = *(const u32x4*)((const bf16_t*)(F.ws + WS_MOE + RW_S) + ci * 4096 + F.tid * 8);
      *(LAS u32x4*)(W1b + row * RB_LD + col) = *(const u32x4*)((const bf16_t*)(F.ws + WS_MOE + RW_W1) + ci * 4096 + F.tid * 8);
      *(LAS u32x4*)(Zb + row * RB_LD + col) = *(const u32x4*)((const bf16_t*)(F.ws + WS_MOE + RW_Z) + ci * 4096 + F.tid * 8);
      const int vv = F.tid & 63, part = F.tid >> 6;
#pragma unroll
      for (int i = 0; i < 8; ++i) { const int t = 8 * part + i; VTb[vv * RB_LD + t] = f2bf(Vv[t * 64 + vv]); } }
    __syncthreads();
    { const int lane = F.lane, mt = F.wave >> 1, nt0 = 2 * (F.wave & 1), r = lane & 15, g4 = lane >> 4;
#pragma unroll
      for (int q = 0; q < 2; ++q) { const int nt = nt0 + q;
          f32x4 o = mma_nt<64>(W1b + 16 * mt * RB_LD, RB_LD, S0b + 16 * nt * RB_LD, RB_LD, (f32x4){0.f, 0.f, 0.f, 0.f}, lane);
          o = mma_nt<64>(Zb + 16 * mt * RB_LD, RB_LD, VTb + 16 * nt * RB_LD, RB_LD, o, lane);
#pragma unroll
          for (int i = 0; i < 4; ++i) Oo[(16 * mt + 4 * g4 + i) * 64 + 16 * nt + r] = o[i]; } }
    __syncthreads();
    { const int j = F.lane, tq = F.wave, ch = h * 64 + j;
      const float lw = F.in[I_RLNW][layer * 256 + ch], lb = F.in[I_RLNB][layer * 256 + ch];
      bf16_t* Y = (bf16_t*)(F.ws + WS_H);
#pragma unroll 2
      for (int i8 = 0; i8 < 8; ++i8) { const int t = tq + 8 * i8;
          const float o = Oo[t * 64 + j]; const float mean = wave_sum(o) * (1.0f / 64.0f); const float d = o - mean; const float var = wave_sum(d * d) * (1.0f / 64.0f);
          float on = d * rsqrtf(var + 64e-5f) * lw + lb; on += BON[t] * Vv[t * 64 + j];
          Y[(T0 + t) * DM + 256 + ch] = f2bf(on * Gg[t * 64 + j]); } }
}

constexpr int DS_SEL = 131072, DS_HIST = 135168, DS_BKT = 151552, DS_BIAS = 152064;
__device__ __forceinline__ unsigned fkey(float f) { const unsigned u = __float_as_uint(f); return (u & 0x80000000u) ? ~u : (u | 0x80000000u); }
__device__ __forceinline__ void item_dsa(const Frame& F_, int layer, int item) { Frame F = relocal(F_);
    const bf16_t* U = (const bf16_t*)(F.ws + WS_U); const bf16_t* KI = (const bf16_t*)(F.ws + WS_KIDX);
    const bf16_t* Kb = (const bf16_t*)(F.ws + WS_K); const bf16_t* Vb = (const bf16_t*)(F.ws + WS_V);
    const int b = item & 3, qg = 511 - (item >> 2); const size_t TB = (size_t)b * SEQ, T0 = TB + qg * 8;
    LAS float* sc = (LAS float*)F.lds; LAS unsigned short* selall = (LAS unsigned short*)(F.lds + DS_SEL); LAS unsigned* histall = (LAS unsigned*)(F.lds + DS_HIST);
    LAS int* bkt = (LAS int*)(F.lds + DS_BKT); LAS float* biasT = (LAS float*)(F.lds + DS_BIAS);
    if (F.tid < 128) { const int n = F.tid; int bk = n; if (n >= 16) { const float lr = logf((float)n / 16.0f) / 2.0794415416798357f; bk = 16 + (int)(lr * 16.0f); bk = bk < 31 ? bk : 31; } bkt[n] = bk; biasT[n] = F.in[I_RELB][n]; }
    const int lane = F.lane, hh = lane >> 5;
    {
        bf16x8 af[2][2]; float wq[2][2][8];
        { const int r = lane & 31, q4 = 2 * ((r >> 2) & 1) + (r >> 4), head = 4 * ((r >> 3) & 1) + (r & 3);
#pragma unroll
          for (int mt = 0; mt < 2; ++mt)
#pragma unroll
              for (int ks = 0; ks < 2; ++ks) af[mt][ks] = *(const bf16x8*)(U + (T0 + 4 * mt + q4) * NINP + UC + 384 + head * 32 + 16 * ks + 8 * hh); }
#pragma unroll
        for (int mt = 0; mt < 2; ++mt)
#pragma unroll
            for (int q2 = 0; q2 < 2; ++q2) { float f[8]; unpack8(*(const u32x4*)(U + (T0 + 4 * mt + 2 * hh + q2) * NINP + UC + 672), f);
#pragma unroll
                for (int hd = 0; hd < 8; ++hd) wq[mt][q2][hd] = f[hd]; }
        const int ntile = (qg * 8 + 8 + 31) >> 5;
        for (int kt = F.wave; kt < ntile; kt += 8) {
            const int key = kt * 32 + (lane & 31);
            const bf16x8 b0 = *(const bf16x8*)(KI + (TB + key) * 32 + 8 * hh), b1 = *(const bf16x8*)(KI + (TB + key) * 32 + 16 + 8 * hh);
#pragma unroll
            for (int mt = 0; mt < 2; ++mt) { f32x16 acc;
#pragma unroll
                for (int i = 0; i < 16; ++i) acc[i] = 0.f;
                acc = __builtin_amdgcn_mfma_f32_32x32x16_bf16(af[mt][0], b0, acc, 0, 0, 0);
                acc = __builtin_amdgcn_mfma_f32_32x32x16_bf16(af[mt][1], b1, acc, 0, 0, 0);
#pragma unroll
                for (int q2 = 0; q2 < 2; ++q2) { float s = 0.f;
#pragma unroll
                    for (int hd = 0; hd < 8; ++hd) s += fmaxf(acc[8 * q2 + hd], 0.f) * wq[mt][q2][hd];
                    const int qi = 4 * mt + 2 * hh + q2;
                    sc[qi * 4096 + key] = (key <= qg * 8 + qi) ? s : -INFINITY; } }
        }
    }
    __syncthreads();
    const int qi = F.wave, tq = qg * 8 + qi, n = tq + 1;
    LAS float* scq = sc + qi * 4096; LAS unsigned short* sel = selall + qi * 256; LAS unsigned* hist = histall + qi * 512;
    int nsel;
    if (n <= 256) { nsel = n; for (int j = lane; j < 256; j += 64) sel[j] = (unsigned short)(j < n ? j : 0); }
    else {
        nsel = 256;
        const int R = (n + 63) >> 6; const unsigned long long ltm = (1ull << lane) - 1ull;
        float lo = INFINITY, hi = -INFINITY;
#pragma unroll 8
        for (int i = 0; i < R; ++i) { const int j = lane + 64 * i; if (j < n) { const float v = scq[j]; lo = fminf(lo, v); hi = fmaxf(hi, v); } }
#pragma unroll
        for (int o = 1; o < 64; o <<= 1) { lo = fminf(lo, shx(lo, o)); hi = fmaxf(hi, shx(hi, o)); }
        bool slow = false;
        if (!(hi > lo)) { for (int j = lane; j < 256; j += 64) sel[j] = (unsigned short)j; }
        else {
            const float scale = 1023.0f / (hi - lo);
            *(LAS u32x4*)(hist + 8 * lane) = (u32x4){0u, 0u, 0u, 0u}; *(LAS u32x4*)(hist + 8 * lane + 4) = (u32x4){0u, 0u, 0u, 0u};
#pragma unroll 8
            for (int i = 0; i < R; ++i) { const int j = lane + 64 * i; if (j < n) { int bk = (int)((scq[j] - lo) * scale); bk = bk < 1023 ? bk : 1023;
                atomicAdd((unsigned*)(hist + (bk >> 1)), (bk & 1) ? 65536u : 1u); } }
            const u32x4 h0 = *(const LAS u32x4*)(hist + 8 * lane), h1 = *(const LAS u32x4*)(hist + 8 * lane + 4);
            unsigned cb[16];
            cb[0] = h0.x & 0xffffu; cb[1] = h0.x >> 16; cb[2] = h0.y & 0xffffu; cb[3] = h0.y >> 16; cb[4] = h0.z & 0xffffu; cb[5] = h0.z >> 16; cb[6] = h0.w & 0xffffu; cb[7] = h0.w >> 16;
            cb[8] = h1.x & 0xffffu; cb[9] = h1.x >> 16; cb[10] = h1.y & 0xffffu; cb[11] = h1.y >> 16; cb[12] = h1.z & 0xffffu; cb[13] = h1.z >> 16; cb[14] = h1.w & 0xffffu; cb[15] = h1.w >> 16;
            unsigned tot = 0u;
#pragma unroll
            for (int q = 0; q < 16; ++q) tot += cb[q];
            unsigned incl = tot;
#pragma unroll
            for (int o = 1; o < 64; o <<= 1) { const unsigned t = shdown_u(incl, o); if (lane + o < 64) incl += t; }
            int fb = -1; unsigned fabove = 0u, fcnt = 0u; unsigned cum = incl - tot;
#pragma unroll
            for (int q = 15; q >= 0; --q) { if (fb < 0 && cum < 256u && 256u <= cum + cb[q]) { fb = 16 * lane + q; fabove = cum; fcnt = cb[q]; } cum += cb[q]; }
            const unsigned long long mf = __ballot(fb >= 0); const int src = (int)__ffsll((long long)mf) - 1;
            const int B = shidx_i(fb, src); const int above = shidx_i((int)fabove, src), cntB = shidx_i((int)fcnt, src); const int need = 256 - above;
            if (cntB > 256) slow = true;
            else {
                LAS unsigned* cand = hist;
                int base_gt = 0, base_c = 0;
#pragma unroll 4
                for (int i = 0; i < R; ++i) { const int j = lane + 64 * i; const bool valid = j < n; const float v = valid ? scq[j] : lo;
                    int bk = (int)((v - lo) * scale); bk = bk < 1023 ? bk : 1023;
                    const bool gt = valid && bk > B, eq = valid && bk == B;
                    const unsigned long long mg = __ballot(gt), me = __ballot(eq);
                    if (gt) sel[base_gt + __popcll(mg & ltm)] = (unsigned short)j;
                    if (eq) { const int p = base_c + __popcll(me & ltm); cand[2 * p] = fkey(v); cand[2 * p + 1] = (unsigned)j; }
                    base_gt += __popcll(mg); base_c += __popcll(me); }
                if (need == cntB) { for (int c = lane; c < cntB; c += 64) sel[above + c] = (unsigned short)cand[2 * c + 1]; }
                else {
                    unsigned ck[4]; int rk[4];
#pragma unroll
                    for (int q = 0; q < 4; ++q) { const int c = lane + 64 * q; ck[q] = c < cntB ? cand[2 * c] : 0u; rk[q] = 0; }
                    for (int c2 = 0; c2 < cntB; ++c2) { const unsigned k2 = cand[2 * c2];
#pragma unroll
                        for (int q = 0; q < 4; ++q) rk[q] += (k2 > ck[q] || (k2 == ck[q] && c2 < lane + 64 * q)) ? 1 : 0; }
#pragma unroll
                    for (int q = 0; q < 4; ++q) { const int c = lane + 64 * q; if (c < cntB && rk[q] < need) sel[above + rk[q]] = (unsigned short)cand[2 * c + 1]; }
                }
            }
        }
        if (slow) {
        unsigned prefix = 0u; int need = 256; unsigned neq = 0u;
        for (int p = 0; p < 4; ++p) { const int shift = 24 - 8 * p;
            *(LAS u32x4*)(hist + 4 * lane) = (u32x4){0u, 0u, 0u, 0u};
            for (int i = 0; i < R; ++i) { const int j = lane + 64 * i; if (j < n) { const unsigned u = fkey(scq[j]);
                if (p == 0 || (u >> (shift + 8)) == prefix) atomicAdd((unsigned*)(hist + ((u >> shift) & 255u)), 1u); } }
            const u32x4 hv = *(const LAS u32x4*)(hist + 4 * lane);
            const unsigned tot = hv.x + hv.y + hv.z + hv.w;
            unsigned incl = tot;
#pragma unroll
            for (int o = 1; o < 64; o <<= 1) { const unsigned t = shdown_u(incl, o); if (lane + o < 64) incl += t; }
            const unsigned above = incl - tot;
            int fb = -1; unsigned fabove = 0u, feq = 0u; unsigned cum = above;
            { const unsigned hq[4] = {hv.x, hv.y, hv.z, hv.w};
#pragma unroll
              for (int q = 3; q >= 0; --q) { if (fb < 0 && cum < (unsigned)need && (unsigned)need <= cum + hq[q]) { fb = 4 * lane + q; fabove = cum; feq = hq[q]; } cum += hq[q]; } }
            const unsigned long long m = __ballot(fb >= 0);
            const int src = (int)__ffsll((long long)m) - 1;
            const int bin = shidx_i(fb, src); const unsigned ab = (unsigned)shidx_i((int)fabove, src); neq = (unsigned)shidx_i((int)feq, src);
            need -= (int)ab; prefix = (prefix << 8) | (unsigned)bin;
        }
        const int ngt = 256 - need;
        int base_gt = 0, base_eq = 0;
        for (int i = 0; i < R; ++i) { const int j = lane + 64 * i; const unsigned u = (j < n) ? fkey(scq[j]) : 0u;
            const bool gt = (j < n) && (u > prefix), eq = (j < n) && (u == prefix);
            const unsigned long long mg = __ballot(gt), me = __ballot(eq); const unsigned long long lt = (1ull << lane) - 1ull;
            if (gt) sel[base_gt + __popcll(mg & lt)] = (unsigned short)j;
            if (eq) { const int rk = base_eq + __popcll(me & lt); if (rk < need) sel[ngt + rk] = (unsigned short)j; }
            base_gt += __popcll(mg); base_eq += __popcll(me); }
        (void)neq;
            }
    }
    const int nt16 = (nsel + 15) >> 4, r16 = lane & 15, g4 = lane >> 4;
    LAS float* biasj = scq + 2048;
#pragma unroll
    for (int q = 0; q < 4; ++q) { const int j = lane + 64 * q; f32x4 bv = (f32x4){-INFINITY, -INFINITY, -INFINITY, -INFINITY};
        if (j < nsel) { const int dist = tq - (int)sel[j]; const int bk = dist < 128 ? bkt[dist < 0 ? 0 : dist] : 31; bv = *(const LAS f32x4*)(biasT + 4 * bk); }
        *(LAS f32x4*)(biasj + 4 * j) = bv; }
    bf16x8 qf[2];
#pragma unroll
    for (int s = 0; s < 2; ++s) { u32x4 z = (u32x4){0u, 0u, 0u, 0u}; if (r16 < 4) z = *(const u32x4*)(U + (T0 + qi) * NINP + UC + r16 * 64 + 32 * s + 8 * g4); qf[s] = __builtin_bit_cast(bf16x8, z); }
    float lg[16][4]; float mx = -INFINITY;
#pragma unroll
    for (int hb = 0; hb < 2; ++hb) {
        if (hb * 8 < nt16) {
            int keyr[8]; bf16x8 a0[8], a1[8];
#pragma unroll
            for (int m8 = 0; m8 < 8; ++m8) keyr[m8] = sel[16 * (8 * hb + m8) + r16];
#pragma unroll
            for (int m8 = 0; m8 < 8; ++m8) { a0[m8] = *(const bf16x8*)(Kb + (TB + keyr[m8]) * 64 + 8 * g4); a1[m8] = *(const bf16x8*)(Kb + (TB + keyr[m8]) * 64 + 32 + 8 * g4); }
#pragma unroll
            for (int m8 = 0; m8 < 8; ++m8) { const int m = 8 * hb + m8;
                f32x4 acc = (f32x4){0.f, 0.f, 0.f, 0.f};
                acc = __builtin_amdgcn_mfma_f32_16x16x32_bf16(a0[m8], qf[0], acc, 0, 0, 0);
                acc = __builtin_amdgcn_mfma_f32_16x16x32_bf16(a1[m8], qf[1], acc, 0, 0, 0);
#pragma unroll
                for (int i = 0; i < 4; ++i) { const float v = acc[i] * 0.125f + biasj[(16 * m + 4 * g4 + i) * 4 + (r16 & 3)]; lg[m][i] = v; mx = fmaxf(mx, v); } }
        } else {
#pragma unroll
            for (int m8 = 0; m8 < 8; ++m8)
#pragma unroll
                for (int i = 0; i < 4; ++i) lg[8 * hb + m8][i] = -INFINITY;
        }
    }
    mx = fmaxf(mx, shx(mx, 16)); mx = fmaxf(mx, shx(mx, 32));
    float sm = 0.f;
#pragma unroll
    for (int m = 0; m < 16; ++m)
#pragma unroll
        for (int i = 0; i < 4; ++i) { const float p = __expf(lg[m][i] - mx); lg[m][i] = p; sm += p; }
    sm += shx(sm, 16); sm += shx(sm, 32);
    f32x4 ov[4];
#pragma unroll
    for (int nt = 0; nt < 4; ++nt) ov[nt] = (f32x4){0.f, 0.f, 0.f, 0.f};
    const unsigned vs_base = (unsigned)(unsigned long)scq;
#pragma unroll
    for (int half = 0; half < 2; ++half) {
        if (half * 8 < nt16) {
            asm volatile("s_waitcnt lgkmcnt(0)" ::: "memory");
#pragma unroll
            for (int q = 0; q < 16; ++q) { const int rho = 8 * q + (lane >> 3);
                const int j = half * 128 + (rho & ~31) + 16 * ((rho >> 2) & 1) + 4 * ((rho >> 3) & 3) + (rho & 3);
                const int key = sel[j];
                __builtin_amdgcn_global_load_lds((const unsigned*)(Vb + (TB + key) * 64 + 8 * (lane & 7)), (LAS unsigned*)((LAS unsigned char*)scq + q * 1024), 16, 0, 0); }
            asm volatile("s_waitcnt vmcnt(0)" ::: "memory");
#pragma unroll
            for (int s4 = 0; s4 < 4; ++s4) { const int s = half * 4 + s4;
                u32x4 pw; pw.x = pk2(lg[2 * s][0], lg[2 * s][1]); pw.y = pk2(lg[2 * s][2], lg[2 * s][3]); pw.z = pk2(lg[2 * s + 1][0], lg[2 * s + 1][1]); pw.w = pk2(lg[2 * s + 1][2], lg[2 * s + 1][3]);
                const bf16x8 pa = __builtin_bit_cast(bf16x8, pw);
                const unsigned ad = vs_base + (unsigned)((32 * s4 + 8 * g4 + (r16 >> 2)) * 128 + (r16 & 3) * 8);
                u32x2 t0[4], t1[4];
                asm volatile("ds_read_b64_tr_b16 %0, %8\n\tds_read_b64_tr_b16 %1, %8 offset:512\n\tds_read_b64_tr_b16 %2, %8 offset:32\n\tds_read_b64_tr_b16 %3, %8 offset:544\n\t"
                             "ds_read_b64_tr_b16 %4, %8 offset:64\n\tds_read_b64_tr_b16 %5, %8 offset:576\n\tds_read_b64_tr_b16 %6, %8 offset:96\n\tds_read_b64_tr_b16 %7, %8 offset:608\n\ts_waitcnt lgkmcnt(0)"
                             : "=&v"(t0[0]), "=&v"(t1[0]), "=&v"(t0[1]), "=&v"(t1[1]), "=&v"(t0[2]), "=&v"(t1[2]), "=&v"(t0[3]), "=&v"(t1[3]) : "v"(ad) : "memory");
#pragma unroll
                for (int nt = 0; nt < 4; ++nt) { const bf16x8 vb = __builtin_bit_cast(bf16x8, (u32x4){t0[nt].x, t0[nt].y, t1[nt].x, t1[nt].y});
                    ov[nt] = __builtin_amdgcn_mfma_f32_16x16x32_bf16(pa, vb, ov[nt], 0, 0, 0); } }
        }
    }
    { float inv[4];
#pragma unroll
      for (int h = 0; h < 4; ++h) inv[h] = 1.0f / __int_as_float(__builtin_amdgcn_readlane(__float_as_int(sm), h));
      if (lane < 16) { bf16_t* Y = (bf16_t*)(F.ws + WS_H) + (T0 + qi) * DM + 512 + r16;
#pragma unroll
          for (int h = 0; h < 4; ++h)
#pragma unroll
              for (int nt = 0; nt < 4; ++nt) Y[h * 64 + 16 * nt] = f2bf(ov[nt][h] * inv[h]); } }
}

__device__ __forceinline__ void phase_router(const Frame& F_, int layer) { Frame F = relocal(F_); const int cset = layer;
    const float* X = (const float*)(F.ws + WS_X);
    const bf16_t* WH = (const bf16_t*)(F.ws + WS_WRT) + (size_t)layer * 2 * 49152; const bf16_t* WL = WH + 49152;
    LAS float* part = (LAS float*)F.lds;
    LAS float* ssq = (LAS float*)(F.lds + 24576);
    LAS int* es = (LAS int*)(F.lds + 25088);
    LAS int* lr = (LAS int*)(F.lds + 25600);
    LAS float* wsl = (LAS float*)(F.lds + 26112);
    LAS float* rsd = (LAS float*)(F.lds + 26624);
    for (int blk = F.bid; blk < NTOK / 64; blk += F.G) {
        __syncthreads();
        const int mt = F.wave & 3, kh = F.wave >> 2, r16 = F.lane & 15, g4 = F.lane >> 4;
        const float* xr = X + ((size_t)blk * 64 + mt * 16 + r16) * DM + kh * 512 + 8 * g4;
        f32x4 acc[3]; acc[0] = acc[1] = acc[2] = (f32x4){0.f, 0.f, 0.f, 0.f}; float ss = 0.f;
#pragma unroll 4
        for (int ks = 0; ks < 16; ++ks) {
            const f32x4 xa = *(const f32x4*)(xr + ks * 32), xb = *(const f32x4*)(xr + ks * 32 + 4);
            ss += xa[0] * xa[0] + xa[1] * xa[1] + xa[2] * xa[2] + xa[3] * xa[3] + xb[0] * xb[0] + xb[1] * xb[1] + xb[2] * xb[2] + xb[3] * xb[3];
            float xv[8] = {xa[0], xa[1], xa[2], xa[3], xb[0], xb[1], xb[2], xb[3]}; unsigned hw[4], lw[4];
#pragma unroll
            for (int j = 0; j < 4; ++j) { const bf16_t h0 = f2bf(xv[2 * j]), h1 = f2bf(xv[2 * j + 1]); hw[j] = (unsigned)h0 | ((unsigned)h1 << 16);
                lw[j] = pk2(xv[2 * j] - bf2f(h0), xv[2 * j + 1] - bf2f(h1)); }
            const bf16x8 ahi = __builtin_bit_cast(bf16x8, (u32x4){hw[0], hw[1], hw[2], hw[3]}), alo = __builtin_bit_cast(bf16x8, (u32x4){lw[0], lw[1], lw[2], lw[3]});
#pragma unroll
            for (int nt = 0; nt < 3; ++nt) { const size_t wo = (size_t)(nt * 16 + r16) * 1024 + kh * 512 + ks * 32 + 8 * g4;
                const bf16x8 bh = *(const bf16x8*)(WH + wo), bl = *(const bf16x8*)(WL + wo);
                acc[nt] = __builtin_amdgcn_mfma_f32_16x16x32_bf16(ahi, bh, acc[nt], 0, 0, 0);
                acc[nt] = __builtin_amdgcn_mfma_f32_16x16x32_bf16(ahi, bl, acc[nt], 0, 0, 0);
                acc[nt] = __builtin_amdgcn_mfma_f32_16x16x32_bf16(alo, bh, acc[nt], 0, 0, 0); }
        }
        ss += shx(ss, 16); ss += shx(ss, 32);
        if (g4 == 0) ssq[kh * 64 + mt * 16 + r16] = ss;
#pragma unroll
        for (int nt = 0; nt < 3; ++nt)
#pragma unroll
            for (int i = 0; i < 4; ++i) part[(kh * 64 + mt * 16 + 4 * g4 + i) * 48 + nt * 16 + r16] = acc[nt][i];
        __syncthreads();
        if (F.tid < 64) { const float rstd = rsqrtf((ssq[F.tid] + ssq[64 + F.tid]) * (1.0f / DM) + 1e-6f); rsd[F.tid] = rstd;
            float l[36];
#pragma unroll
            for (int o = 0; o < 36; ++o) l[o] = (part[F.tid * 48 + o] + part[(64 + F.tid) * 48 + o]) * rstd + (o < 32 ? F.in[I_BRE][layer * 32 + o] : F.in[I_BRG][layer * 4 + o - 32]);
            int gs = 0; float gm = l[32];
#pragma unroll
            for (int j = 1; j < 4; ++j) if (l[32 + j] > gm) { gm = l[32 + j]; gs = j; }
            float den = 0.f;
#pragma unroll
            for (int j = 0; j < 4; ++j) den += __expf(l[32 + j] - gm);
            const float gate = 1.0f / den;
            float e8[8];
#pragma unroll
            for (int j = 0; j < 8; ++j) e8[j] = gs == 0 ? l[j] : gs == 1 ? l[8 + j] : gs == 2 ? l[16 + j] : l[24 + j];
            int i1 = 0; float v1 = e8[0];
#pragma unroll
            for (int j = 1; j < 8; ++j) if (e8[j] > v1) { v1 = e8[j]; i1 = j; }
            int i2 = -1; float v2 = -INFINITY;
#pragma unroll
            for (int j = 0; j < 8; ++j) if (j != i1 && e8[j] > v2) { v2 = e8[j]; i2 = j; }
            const float e2 = __expf(v2 - v1); const float p1 = 1.0f / (1.0f + e2);
            es[F.tid * 2] = gs * 8 + i1; es[F.tid * 2 + 1] = gs * 8 + i2; wsl[F.tid * 2] = p1 * gate; wsl[F.tid * 2 + 1] = (1.0f - p1) * gate; }
        __syncthreads();
        if (F.tid < 32) { int cnt = 0; for (int i = 0; i < 128; ++i) if (es[i] == F.tid) lr[i] = cnt++;
            if (cnt) { const int base = (int)__hip_atomic_fetch_add(F.ctl + CW_CNT + cset * 32 + F.tid, (unsigned)cnt, __ATOMIC_RELAXED, __HIP_MEMORY_SCOPE_AGENT);
                for (int i = 0; i < 128; ++i) if (es[i] == F.tid) lr[i] += base; } }
        __syncthreads();
        if (F.tid < 64) { int* rt = (int*)(F.ws + WS_ROUTE) + ((size_t)blk * 64 + F.tid) * 8;
            rt[0] = es[F.tid * 2]; rt[1] = es[F.tid * 2 + 1]; ((float*)rt)[2] = wsl[F.tid * 2]; ((float*)rt)[3] = wsl[F.tid * 2 + 1]; rt[4] = lr[F.tid * 2]; rt[5] = lr[F.tid * 2 + 1]; ((float*)rt)[6] = rsd[F.tid]; }
    }
    __syncthreads();
    if (F.tid == 0) __hip_atomic_fetch_add(F.ctl + CW_RB + 64 * layer, 1u, __ATOMIC_RELAXED, __HIP_MEMORY_SCOPE_AGENT);
}
__device__ __forceinline__ void phase_moe_convert(const Frame& F_, int layer) { Frame F = relocal(F_);
    bf16_t* WGU = (bf16_t*)(F.ws + WS_MOE + MOE_WGU); bf16_t* WD = (bf16_t*)(F.ws + WS_MOE + MOE_WD);
    for (int t = F.bid; t < 1536; t += F.G) {
        if (t < 1024) { const int e = t >> 5, r = t & 31, kt = r >> 1, nt = r & 1; const size_t eo = ((size_t)layer * 32 + e) * 1024 * 256;
            tr_tile(F, 256, WGU + (size_t)e * 512 * 1024, 1024, kt * 64, nt * 256, SmGU{F.in[I_WGATE] + eo, F.in[I_WUP] + eo}); }
        else { const int q = t - 1024, e = q >> 4, r = q & 15, kt = r >> 2, nt = r & 3;
            tr_tile(F, 1024, WD + (size_t)e * 1024 * 256, 256, kt * 64, nt * 256, SmId{F.in[I_WDOWN] + ((size_t)layer * 32 + e) * 256 * 1024}); }
    }
}
__device__ __forceinline__ void phase_gather(const Frame& F_, int layer) { Frame F = relocal(F_);
    LAS int* off = (LAS int*)F.lds;
    __syncthreads();
    if (F.tid == 0) { unsigned sp = 0;
        while (__hip_atomic_load(F.ctl + CW_RB + 64 * layer, __ATOMIC_RELAXED, __HIP_MEMORY_SCOPE_AGENT) < (unsigned)F.G) { __builtin_amdgcn_s_sleep(2); if (++sp > (1u << 22)) break; } }
    __syncthreads();
    if (F.tid == 0) { int acc = 0; for (int e = 0; e < 32; ++e) { off[e] = acc; const int c = (int)__hip_atomic_load(F.ctl + CW_CNT + layer * 32 + e, __ATOMIC_RELAXED, __HIP_MEMORY_SCOPE_AGENT); acc += (c + 255) & ~255; } off[32] = acc; }
    __syncthreads();
    int* tiles = (int*)(F.ws + WS_TILES); int* row_tok = (int*)(F.ws + WS_ROWS); float* row_w = (float*)(F.ws + WS_ROWS) + MAXROWS;
    if (F.bid == 0) { if (F.tid == 0) tiles[0] = off[32] >> 8; if (F.tid < 33) tiles[1 + F.tid] = off[F.tid];
        if (F.tid < 32) for (int rt = off[F.tid] >> 8; rt < (off[F.tid + 1] >> 8); ++rt) tiles[64 + rt] = F.tid; }
    for (int e = F.bid; e < 32; e += F.G) { const int c = (int)__hip_atomic_load(F.ctl + CW_CNT + layer * 32 + e, __ATOMIC_RELAXED, __HIP_MEMORY_SCOPE_AGENT);
        for (int r = off[e] + c + F.tid; r < off[e + 1]; r += NTHR) { row_tok[r] = -1; row_w[r] = 0.f; } }
    const float* X = (const float*)(F.ws + WS_X); bf16_t* HP = (bf16_t*)(F.ws + WS_U); const float* nw = F.in[I_NORM2] + (size_t)layer * DM;
    f32x4 nwv[4];
#pragma unroll
    for (int j = 0; j < 4; ++j) nwv[j] = *(const f32x4*)(nw + 4 * F.lane + 256 * j);
    for (int blk = F.bid; blk < NTOK / 64; blk += F.G)
    for (int i8 = 0; i8 < 8; ++i8) { const int t = blk * 64 + F.wave * 8 + i8;
        const int* rt = (const int*)(F.ws + WS_ROUTE) + (size_t)t * 8; const float rstd = ((const float*)rt)[6];
        const int p0 = off[rt[0]] + rt[4], p1 = off[rt[1]] + rt[5];
#pragma unroll
        for (int j = 0; j < 4; ++j) { const int c = 4 * F.lane + 256 * j; const f32x4 v = *(const f32x4*)(X + (size_t)t * DM + c) * rstd * nwv[j];
            u32x2 o; o.x = pk2(v[0], v[1]); o.y = pk2(v[2], v[3]);
            *(u32x2*)(HP + (size_t)p0 * DM + c) = o; *(u32x2*)(HP + (size_t)p1 * DM + c) = o; }
        if (F.lane == 0) { row_tok[p0] = t * 2; row_w[p0] = ((const float*)rt)[2]; row_tok[p1] = t * 2 + 1; row_w[p1] = ((const float*)rt)[3]; }
    }
}

constexpr int NPH_LAYER = 9, NPHASE = 1 + 2 * NPH_LAYER + 1;
#ifndef MK_ONLY
#define MK_ONLY -1
#endif
#ifndef MK_ITEM
#define MK_ITEM -1
#endif
#define EN(o) (MK_ONLY < 0 || MK_ONLY == (o))
#define IT(o) (MK_ITEM < 0 || MK_ITEM == (o))
__global__ void __launch_bounds__(NTHR, 2) mk_forward(Params P) {
    extern __shared__ __attribute__((aligned(16))) unsigned char lds_raw[];
    Frame F; F.lds = (LAS unsigned char*)lds_raw; F.tid = threadIdx.x; F.lane = F.tid & 63; F.wave = __builtin_amdgcn_readfirstlane(F.tid >> 6); F.bid = blockIdx.x; F.G = gridDim.x;
    F.in = (in_tab_t)__builtin_amdgcn_kernarg_segment_ptr(); F.out = P.out; F.ws = P.ws; F.ctl = (unsigned*)(P.ws + WS_CTL); F.misc = (volatile LAS int*)(F.lds + MISC_OFF);
    if (F.tid < 64) ((LAS unsigned*)(F.lds + MISC_OFF))[F.tid] = 0u;
    __syncthreads();
    const int lo = P.ph_lo, hi = P.ph_hi;
    XcdBarrier bar; bar.bar = F.ctl + CW_BAR; bar.x = 0; bar.st = (volatile LAS unsigned*)(F.lds + MISC_OFF + 16);
    if (hi - lo > 1) bar = xcd_barrier_post(F.ctl + CW_BAR, (volatile LAS unsigned*)(F.lds + MISC_OFF + 16));
#define IN(k) (lo <= (k) && (k) < hi)
#define SEAM(k) do { if (IN(k) && IN((k) + 1)) xcd_barrier(bar); } while (0)
#define QLOOP(qi, n, body) for (;;) { const int it = q_pop(F, layer * 12 + (qi)); if (it >= (n)) break; body; }
    if (EN(100) && IN(0)) { phase_prologue(F); phase_norm(F, F.in[I_X], false, F.in[I_NORM1], 0); } SEAM(0);
#pragma unroll
    for (int layer = 0; layer < DEPTH; ++layer) {
        const int pb = 1 + layer * NPH_LAYER;
        if (layer > 0) { if (EN(0) && IN(pb + 0)) { phase_norm(F, (const float*)(F.ws + WS_X), true, F.in[I_NORM1] + (size_t)layer * DM, 0); } SEAM(pb + 0); }
        if (EN(1) && IN(pb + 1)) { const Frame F_ = F; Frame F = relocal(F_); pg8::StaticOrder S; S.init((const bf16_t*)(F.ws + WS_H), (const bf16_t*)(F.ws + WS_WIN) + (size_t)layer * NINP * DM, NTOK, NINP, DM, F.G, F.bid);
            pg8::EpiBf16 E{(bf16_t*)(F.ws + WS_U), NINP}; pg8::gemm_phase(F.lds, DM, S, E); } SEAM(pb + 1);
        if (EN(2) && IN(pb + 2)) {
            if (IT(0)) QLOOP(0, 256, item_s5<1>(F, layer, it));
            if (IT(1)) QLOOP(1, 1024, item_rwkv1(F, layer, it));
            if (IT(2)) QLOOP(2, 256, item_mamba<1>(F, layer, it));
            if (IT(3)) QLOOP(3, 256, item_kv(F, layer, it));
        } SEAM(pb + 2);
        if (EN(3) && IN(pb + 3)) {
            if (IT(0)) QLOOP(4, 8, item_rwkv_carry(F, it));
            if (IT(1)) QLOOP(5, 16, item_mamba_carry(F, it));
            if (IT(2)) QLOOP(6, 4, item_s5_carry(F, layer, it));
            if (IT(3)) QLOOP(7, 2048, item_dsa(F, layer, it));
        } SEAM(pb + 3);
        if (EN(4) && IN(pb + 4)) {
            if (IT(0)) QLOOP(8, 256, item_s5<2>(F, layer, it));
            if (IT(1)) QLOOP(9, 1024, item_rwkv3(F, layer, it));
            if (IT(2)) QLOOP(10, 256, item_mamba<2>(F, layer, it));
        } SEAM(pb + 4);
        if (EN(6) && IN(pb + 5)) { const Frame F_ = F; Frame F = relocal(F_); pg8::StaticOrder S; S.init((const bf16_t*)(F.ws + WS_H), (const bf16_t*)(F.ws + WS_WOUT) + (size_t)layer * DM * DM, NTOK, DM, DM, F.G, F.bid);
            pg8::EpiResid E{(float*)(F.ws + WS_X), DM}; pg8::gemm_phase(F.lds, DM, S, E); } SEAM(pb + 5);
        if (EN(7) && IN(pb + 6)) { phase_router(F, layer); phase_moe_convert(F, layer); phase_gather(F, layer); } SEAM(pb + 6);
        if (EN(8) && IN(pb + 7)) { const Frame F_ = F; Frame F = relocal(F_); pg8::MoeOrder S{2, F.G, F.bid, DM, (const char*)(F.ws + WS_U), (const char*)(F.ws + WS_MOE + MOE_WGU), (size_t)512 * 1024 * 2, (const int*)(F.ws + WS_TILES)};
            pg8::EpiGated<1> E{(bf16_t*)(F.ws + WS_H), 256, 0, nullptr, nullptr}; pg8::gemm_phase(F.lds, DM, S, E); } SEAM(pb + 7);
        if (EN(9) && IN(pb + 8)) { const Frame F_ = F; Frame F = relocal(F_); pg8::MoeOrder S{4, F.G, F.bid, 256, (const char*)(F.ws + WS_H), (const char*)(F.ws + WS_MOE + MOE_WD), (size_t)1024 * 256 * 2, (const int*)(F.ws + WS_TILES)};
            pg8::EpiMoeOut E{(bf16_t*)(F.ws + WS_U), (const int*)(F.ws + WS_ROWS), (const float*)(F.ws + WS_ROWS) + MAXROWS}; pg8::gemm_phase(F.lds, 256, S, E); } SEAM(pb + 8);
    }
    if (EN(101) && IN(NPHASE - 1)) { phase_norm(F, (const float*)(F.ws + WS_X), true, F.in[I_FNORM], 2); }
#undef IN
#undef SEAM
}

#ifndef MK_SPLIT
#define MK_SPLIT 0
#endif
extern "C" void kernel_launch(void* const* d_in, const int* in_sizes, int n_in, void* d_out, int out_size, void* d_ws, size_t ws_size, hipStream_t stream) {
    static int grid = 0;
    if (grid == 0) {
        if (n_in != 44 || out_size != NTOK * DM || ws_size < WS_END) { fprintf(stderr, "kernel_launch: unexpected shapes (n_in %d out %d ws %zu need %zu)\n", n_in, out_size, ws_size, (size_t)WS_END); grid = -1; return; }
        int dev = 0, cus = 0;
        if (hipGetDevice(&dev) != hipSuccess || hipDeviceGetAttribute(&cus, hipDeviceAttributeMultiprocessorCount, dev) != hipSuccess) { grid = -1; return; }
        if (hipFuncSetAttribute((const void*)mk_forward, hipFuncAttributeMaxDynamicSharedMemorySize, LDS_BYTES) != hipSuccess) { fprintf(stderr, "kernel_launch: hipFuncSetAttribute failed\n"); grid = -1; return; }
        int per_cu = 0;
        if (hipOccupancyMaxActiveBlocksPerMultiprocessor(&per_cu, (const void*)mk_forward, NTHR, LDS_BYTES) != hipSuccess || per_cu < 1) { fprintf(stderr, "kernel_launch: occupancy query says %d\n", per_cu); }
        (void)hipGetLastError();
        grid = cus;
    }
    if (grid < 0) return;
    hipMemsetAsync((char*)d_ws + WS_CTL, 0, CTL_BYTES, stream);
    Params p{};
    for (int i = 0; i < 44; ++i) p.in[i] = (const float*)d_in[i];
    p.out = (float*)d_out; p.ws = (unsigned char*)d_ws;
#if MK_SPLIT
    for (int ph = 0; ph < NPHASE; ++ph) { p.ph_lo = ph; p.ph_hi = ph + 1; hipLaunchKernelGGL(mk_forward, dim3(grid), dim3(NTHR), LDS_BYTES, stream, p); }
#else
    p.ph_lo = 0; p.ph_hi = NPHASE; hipLaunchKernelGGL(mk_forward, dim3(grid), dim3(NTHR), LDS_BYTES, stream, p);
#endif
}
```

```cpp
#include <hip/hip_runtime.h>
#include <stdint.h>
#include <stdio.h>

#define LAS __attribute__((address_space(3)))
typedef unsigned short bf16_t;
typedef short bf16x8 __attribute__((ext_vector_type(8)));
typedef float f32x4 __attribute__((ext_vector_type(4)));
typedef float f32x2 __attribute__((ext_vector_type(2)));
typedef float f32x16 __attribute__((ext_vector_type(16)));
typedef unsigned u32x4 __attribute__((ext_vector_type(4)));
typedef unsigned u32x2 __attribute__((ext_vector_type(2)));

constexpr int NTOK = 16384, DM = 1024, SEQ = 4096, NBATCH = 4, DEPTH = 2;
constexpr int NIN = 2604, NINP = 2816;
constexpr int UM = 0;
constexpr int UR = 784;
constexpr int UC = 1680;
constexpr int US = 2368;
constexpr int NTHR = 512;
constexpr int LDS_BYTES = 163840;
constexpr int MISC_OFF = LDS_BYTES - 256;

constexpr size_t WS_CTL   = 0;
constexpr size_t CTL_BYTES = 65536;
constexpr size_t WS_X     = WS_CTL + CTL_BYTES;
constexpr size_t WS_H     = WS_X + (size_t)NTOK * DM * 4;
constexpr size_t WS_U     = WS_H + (size_t)NTOK * DM * 2;
constexpr size_t WS_WIN   = WS_U + (size_t)NTOK * NINP * 2;
constexpr size_t WS_WOUT  = WS_WIN + (size_t)2 * NINP * DM * 2;
constexpr size_t WS_GLU   = WS_WOUT + (size_t)2 * DM * DM * 2;
constexpr size_t WS_MOE   = WS_GLU + (size_t)2 * 512 * 256 * 2;
constexpr size_t MOE_WGU  = 0;
constexpr size_t MOE_WD   = (size_t)32 * 512 * 1024 * 2;
constexpr size_t MOE_BYTES = MOE_WD + (size_t)32 * 1024 * 256 * 2;
constexpr size_t RW_PT    = 0;
constexpr size_t RW_U     = (size_t)1024 * 4096 * 2;
constexpr size_t RW_S     = RW_U + (size_t)1024 * 4096 * 2;
constexpr size_t RW_W1    = RW_S + (size_t)1024 * 4096 * 2;
constexpr size_t RW_Z     = RW_W1 + (size_t)1024 * 4096 * 2;
constexpr size_t YSG_OFF  = RW_Z + (size_t)1024 * 4096 * 2;
static_assert(YSG_OFF + (size_t)NTOK * 256 * 2 <= MOE_BYTES, "alias");
constexpr size_t WS_MST   = WS_MOE + MOE_BYTES;
constexpr size_t WS_MDEC  = WS_MST + (size_t)4 * 64 * 4 * 4096 * 4;
constexpr size_t WS_S5ST  = WS_MDEC + 4096;
constexpr size_t WS_K     = WS_S5ST + (size_t)4 * 64 * 2048 * 4;
constexpr size_t WS_V     = WS_K + (size_t)NTOK * 64 * 2;
constexpr size_t WS_KIDX  = WS_V + (size_t)NTOK * 64 * 2;
constexpr size_t WS_ROUTE = WS_KIDX + (size_t)NTOK * 32 * 2;
constexpr size_t WS_ROWS  = WS_ROUTE + (size_t)NTOK * 32;
constexpr int    MAXROWS  = 49152;
constexpr size_t WS_TILES = WS_ROWS + (size_t)MAXROWS * 8;
constexpr size_t WS_S5TAB = WS_TILES + 4096;
constexpr size_t S5TAB_F  = (size_t)(2048 + 2048 + 32768) * 4;
constexpr size_t S5TAB_L  = S5TAB_F + (size_t)16 * 16 * 128 * 2;
constexpr size_t WS_WRT   = WS_S5TAB + 2 * S5TAB_L;
constexpr size_t WS_BON   = WS_WRT + (size_t)2 * 2 * 48 * 1024 * 2;
constexpr size_t WS_END   = WS_BON + (size_t)1024 * 64 * 4;

constexpr int CW_BAR = 0;
constexpr int CW_Q   = 4096;
constexpr int CW_CNT = 8192;
constexpr int CW_RB  = 8448;

__device__ __forceinline__ float bf2f(bf16_t b) { return __uint_as_float(((unsigned)b) << 16); }
__device__ __forceinline__ bf16_t f2bf(float f) { const __bf16 h = (__bf16)f; return __builtin_bit_cast(bf16_t, h); }
__device__ __forceinline__ unsigned pk2(float lo, float hi) { typedef __bf16 bf2_t __attribute__((ext_vector_type(2))); const bf2_t h = __builtin_convertvector((f32x2){lo, hi}, bf2_t); return __builtin_bit_cast(unsigned, h); }
__device__ __forceinline__ unsigned cvt_pk_bf16(float lo, float hi) { unsigned r; asm volatile("v_cvt_pk_bf16_f32 %0, %1, %2" : "=v"(r) : "v"(lo), "v"(hi)); return r; }
__device__ __forceinline__ float sigmoidf_(float x) { return 1.0f / (1.0f + __expf(-x)); }
__device__ __forceinline__ float siluf_(float x) { return x / (1.0f + __expf(-x)); }
__device__ __forceinline__ float tanhf_(float x) { const float e = __expf(2.0f * x); return 1.0f - 2.0f / (e + 1.0f); }
__device__ __forceinline__ float softplusf_(float x) { return fmaxf(x, 0.0f) + log1pf(__expf(-fabsf(x))); }
__device__ __forceinline__ float gelu_tanh(float x) { return 0.5f * x * (1.0f + tanhf_(0.7978845608028654f * (x + 0.044715f * x * x * x))); }
template <int CTRL> __device__ __forceinline__ float dppf(float x) { return __int_as_float(__builtin_amdgcn_update_dpp(0, __float_as_int(x), CTRL, 0xF, 0xF, true)); }
__device__ __forceinline__ float sum4(float x) { x += dppf<0xB1>(x); x += dppf<0x4E>(x); return x; }
__device__ __forceinline__ float sum8(float x) { x = sum4(x); x += dppf<0x141>(x); return x; }
__device__ __forceinline__ float sum16(float x) { x = sum8(x); x += dppf<0x140>(x); return x; }
__device__ __forceinline__ int lane_id_() { int l = (int)__builtin_amdgcn_mbcnt_hi(~0u, __builtin_amdgcn_mbcnt_lo(~0u, 0u)); asm volatile("" : "+v"(l)); return l; }
__device__ __forceinline__ float shx(float x, int o) { return __int_as_float(__builtin_amdgcn_ds_bpermute((lane_id_() ^ o) << 2, __float_as_int(x))); }
__device__ __forceinline__ unsigned shdown_u(unsigned x, int o) { return (unsigned)__builtin_amdgcn_ds_bpermute(((lane_id_() + o) & 63) << 2, (int)x); }
__device__ __forceinline__ int shidx_i(int x, int src) { return __builtin_amdgcn_ds_bpermute(src << 2, x); }
__device__ __forceinline__ float wave_sum(float x) { x = sum16(x); x += shx(x, 16); x += shx(x, 32); return x; }
__device__ __forceinline__ void unpack8(const u32x4 v, float (&f)[8]) {
    f[0] = __uint_as_float(v.x << 16); f[1] = __uint_as_float(v.x & 0xffff0000u); f[2] = __uint_as_float(v.y << 16); f[3] = __uint_as_float(v.y & 0xffff0000u);
    f[4] = __uint_as_float(v.z << 16); f[5] = __uint_as_float(v.z & 0xffff0000u); f[6] = __uint_as_float(v.w << 16); f[7] = __uint_as_float(v.w & 0xffff0000u);
}

#define XB_TMO      128
#define XB_XCNT(j)  (256  + 64 * (j))
#define XB_XSUB(j)  (1280 + 64 * (j))
#define XB_XGEN(j)  (2304 + 64 * (j))
#define XB_TOP      3328
#define XB_TOPGEN   3392
#define XCD_BAR_WORDS 3456
#define XB_SPIN_CAP (1u << 22)
__device__ __forceinline__ unsigned xb_ld(unsigned* p)              { return __hip_atomic_load(p, __ATOMIC_RELAXED, __HIP_MEMORY_SCOPE_AGENT); }
__device__ __forceinline__ unsigned xb_add(unsigned* p, unsigned v) { return __hip_atomic_fetch_add(p, v, __ATOMIC_RELAXED, __HIP_MEMORY_SCOPE_AGENT); }
__device__ __forceinline__ unsigned xb_xcc_id() { return (unsigned)__builtin_amdgcn_s_getreg((3 << 11) | 20) & 0xFu; }
#define XB_SPIN(cond, bar) do { unsigned _sp = 0; while (cond) { __builtin_amdgcn_s_sleep(1); \
    if ((++_sp & 255u) == 0u) { if (xb_ld(&(bar)[XB_TMO])) break; if (_sp > XB_SPIN_CAP) { atomicAdd(&(bar)[XB_TMO], 1u); break; } } } } while (0)
struct XcdBarrier { unsigned* bar; unsigned x; volatile LAS unsigned* st; };
__device__ __forceinline__ XcdBarrier xcd_barrier_post(unsigned* bar, volatile LAS unsigned* st) {
    XcdBarrier b; b.bar = bar; b.x = xb_xcc_id(); b.st = st;
    if (threadIdx.x == 0) (void)xb_add(&bar[XB_XCNT(b.x)], 1u);
    return b;
}
__device__ __forceinline__ void xcd_barrier_complete(unsigned* bar, unsigned x, unsigned& nloc, unsigned& nx) {
    const unsigned G = gridDim.x * gridDim.y * gridDim.z;
    unsigned sum, cnt, mine, sp = 0u;
    for (;;) {
        sum = 0u; cnt = 0u; mine = 0u;
#pragma unroll
        for (unsigned j = 0; j < 16; ++j) { const unsigned c = xb_ld(&bar[XB_XCNT(j)]); sum += c; cnt += (c > 0u) ? 1u : 0u; mine = (j == x) ? c : mine; }
        if (sum == G) break;
        __builtin_amdgcn_s_sleep(1);
        if ((++sp & 255u) == 0u) { if (xb_ld(&bar[XB_TMO])) break; if (sp > XB_SPIN_CAP) { atomicAdd(&bar[XB_TMO], 1u); break; } }
    }
    nloc = mine > 0u ? mine : 1u; nx = cnt > 0u ? cnt : 1u;
}
__device__ __forceinline__ void xcd_barrier(const XcdBarrier& b_) {
    XcdBarrier b = b_; { const unsigned long long v = (unsigned long long)b.bar; unsigned lo = __builtin_amdgcn_readfirstlane((unsigned)v), hi = __builtin_amdgcn_readfirstlane((unsigned)(v >> 32)); asm volatile("" : "+s"(lo), "+s"(hi)); b.bar = (unsigned*)(((unsigned long long)hi << 32) | lo); unsigned xx = __builtin_amdgcn_readfirstlane(b.x); asm volatile("" : "+s"(xx)); b.x = xx; }
    asm volatile("s_waitcnt vmcnt(0)" ::: "memory");
    __syncthreads();
    if (threadIdx.x == 0) {
        unsigned* bar = b.bar;
        __builtin_amdgcn_s_waitcnt(0);
        unsigned nloc = b.st[0], nx = b.st[1];
        if (nloc == 0u) { xcd_barrier_complete(bar, b.x, nloc, nx); b.st[0] = nloc; b.st[1] = nx; }
        const unsigned old = xb_add(&bar[XB_XSUB(b.x)], 1u);
        const unsigned gen = old / nloc;
        if (old + 1u == (gen + 1u) * nloc) {
            __builtin_amdgcn_fence(__ATOMIC_RELEASE, "agent");
            asm volatile("s_waitcnt vmcnt(0)" ::: "memory");
            const unsigned og = xb_add(&bar[XB_TOP], 1u);
            const unsigned tg = og / nx;
            if (og + 1u == (tg + 1u) * nx) xb_add(&bar[XB_TOPGEN], 1u);
            else XB_SPIN(xb_ld(&bar[XB_TOPGEN]) == tg, bar);
            __builtin_amdgcn_fence(__ATOMIC_ACQUIRE, "agent");
            xb_add(&bar[XB_XGEN(b.x)], 1u);
            asm volatile("s_waitcnt vmcnt(0)" ::: "memory");
        } else {
            XB_SPIN(xb_ld(&bar[XB_XGEN(b.x)]) == gen, bar);
            __builtin_amdgcn_fence(__ATOMIC_ACQUIRE, "agent");
            asm volatile("s_waitcnt vmcnt(0)" ::: "memory");
        }
    }
    __syncthreads();
}

namespace pg8 {
constexpr int BM = 256, BK = 64, HALF = 128, HTB = HALF * BK * 2, STAGE_BYTES = 8 * HTB, NXCD = 8, WGM = 8;
__host__ __device__ __forceinline__ int lds_byte(int r, int c) { const int st = (r >> 4) * 2 + (c >> 5), rr = r & 15, cc = c & 31, ob = rr * 64 + cc * 2; return st * 1024 + (ob ^ (((ob >> 9) & 1) << 5)); }
__host__ __device__ __forceinline__ void stage_rc(int b, int& R, int& C) { const int st = b / 1024, sb = b % 1024, swz = sb ^ (((sb >> 9) & 1) << 5); R = (st >> 1) * 16 + swz / 64; C = (st & 1) * 32 + (swz % 64) / 2; }
__host__ __device__ __forceinline__ int perm32(int rho) { const int n = rho >> 4, i = rho & 15; return 8 * (i >> 2) + 4 * n + (i & 3); }
struct Unit { int pm, pn; const char* a; const char* b; };

struct StaticOrder {
    int nM, nN, nwg, G, c, K; const char* A; const char* B;
    __device__ void init(const bf16_t* A_, const bf16_t* B_, int M, int N, int K_, int G_, int c_) { A = (const char*)A_; B = (const char*)B_; K = K_; nM = M / BM; nN = N / BM; nwg = nM * nN; G = G_; c = c_; }
    __device__ bool next(int i, Unit& u) const {
        const long L = (long)i * G + c; if (L >= nwg) return false;
        int wgid = (int)L; { const int q = nwg / NXCD, r = nwg % NXCD, xcd = wgid % NXCD, off = wgid / NXCD; wgid = (xcd < r ? xcd * (q + 1) : r * (q + 1) + (xcd - r) * q) + off; }
        const int nig = WGM * nN, gid = wgid / nig, fm = gid * WGM, gsz = (nM - fm) < WGM ? (nM - fm) : WGM;
        u.pm = fm + ((wgid % nig) % gsz); u.pn = (wgid % nig) / gsz;
        u.a = A + (size_t)u.pm * 256 * K * 2; u.b = B + (size_t)u.pn * 256 * K * 2; return true;
    }
};

template <class Epi, class Sched>
__device__ __forceinline__ void gemm_phase(LAS unsigned char* lds, const int K_, const Sched& S, const Epi& E) {
    int K = K_; asm volatile("" : "+s"(K));
    int tid_ = threadIdx.x; asm volatile("" : "+v"(tid_));
    const int tid = tid_, wid = __builtin_amdgcn_readfirstlane(tid >> 6), lane = tid & 63, wr = wid >> 2, wc = wid & 3, fr = lane & 15, fq = lane >> 4;
    const int nt = K / BK;
    unsigned voffA[2], voffB[2];
#pragma unroll
    for (int i = 0; i < 2; ++i) { int R, C; stage_rc(tid * 16 + i * 8192, R, C); const int Rb = Epi::PERM ? ((R & ~31) + perm32(R & 31)) : R;
        voffA[i] = (unsigned)(R * K + C) * 2u; voffB[i] = (unsigned)(Rb * K + C) * 2u; }
    const size_t kstep = (size_t)(BK * 2);
    const size_t hstep = (size_t)HALF * K * 2;
    const unsigned ldsw = (unsigned)wid * 1024u;
    const int aoff = lds_byte(wr * 64 + fr, fq * 8), boff = lds_byte(wc * 32 + fr, fq * 8);
#define PG8_SA(b, h) (((b) * 2 + (h)) * HTB)
#define PG8_SB(b, h) ((4 + (b) * 2 + (h)) * HTB)
#define PG8_STAGE(bufoff, gbase, voff) do { _Pragma("unroll") for (int _i = 0; _i < 2; ++_i) \
        __builtin_amdgcn_global_load_lds((const unsigned*)((const char*)(gbase) + (voff)[_i]), (LAS unsigned*)(lds + (bufoff) + ldsw + _i * 8192), 16, 0, 0); } while (0)
#define PG8_LDA(dst, b, h) do { _Pragma("unroll") for (int m = 0; m < 4; ++m) _Pragma("unroll") for (int k = 0; k < 2; ++k) dst[m][k] = *(const LAS bf16x8*)(lds + PG8_SA(b, h) + aoff + m * 2048 + k * 1024); } while (0)
#define PG8_LDB(dst, b, h) do { _Pragma("unroll") for (int n = 0; n < 2; ++n) _Pragma("unroll") for (int k = 0; k < 2; ++k) dst[n][k] = *(const LAS bf16x8*)(lds + PG8_SB(b, h) + boff + n * 2048 + k * 1024); } while (0)
#define PG8_MMA(ai, bj, At, Bt) do { __builtin_amdgcn_s_setprio(1); _Pragma("unroll") for (int m = 0; m < 4; ++m) _Pragma("unroll") for (int n = 0; n < 2; ++n) _Pragma("unroll") for (int k = 0; k < 2; ++k) \
        acc[ai][bj][m][n] = __builtin_amdgcn_mfma_f32_16x16x32_bf16(Bt[n][k], At[m][k], acc[ai][bj][m][n], 0, 0, 0); __builtin_amdgcn_s_setprio(0); } while (0)
#define PG8_WAIT_V(n) asm volatile("s_waitcnt vmcnt(" #n ")" ::: "memory")
#define PG8_WAIT_L(n) asm volatile("s_waitcnt lgkmcnt(" #n ")" ::: "memory")
#define PG8_BAR __builtin_amdgcn_s_barrier()
#define PG8_SCHED __builtin_amdgcn_sched_barrier(0)
    Unit cur, nxt; int ui = 0;
    if (!S.next(0, cur)) return;
    f32x4 acc[2][2][4][2];
#pragma unroll
    for (int a = 0; a < 2; ++a)
#pragma unroll
        for (int b = 0; b < 2; ++b)
#pragma unroll
            for (int m = 0; m < 4; ++m)
#pragma unroll
                for (int n = 0; n < 2; ++n) acc[a][b][m][n] = (f32x4){0.f, 0.f, 0.f, 0.f};
    bf16x8 At[4][2], B0[2][2], B1[2][2];
    const char* cA = cur.a; const char* cB = cur.b;
    PG8_STAGE(PG8_SB(0, 0), cB, voffB); PG8_STAGE(PG8_SA(0, 0), cA, voffA); PG8_STAGE(PG8_SB(0, 1), cB + hstep, voffB); PG8_STAGE(PG8_SA(0, 1), cA + hstep, voffA);
    if (wr == 1) PG8_BAR;
    PG8_WAIT_V(4); PG8_BAR;
    PG8_STAGE(PG8_SB(1, 0), cB + kstep, voffB); PG8_STAGE(PG8_SA(1, 0), cA + kstep, voffA); PG8_STAGE(PG8_SB(1, 1), cB + hstep + kstep, voffB);
    PG8_WAIT_V(6); PG8_BAR;
    for (;;) {
        const bool has_next = S.next(ui + 1, nxt);
        const char* nA = has_next ? nxt.a : cA; const char* nB = has_next ? nxt.b : cB;
        for (int t = 0; t < nt; t += 2) {
            const bool last = (t == nt - 2);
            const char* a1 = cA + (size_t)(t + 1) * kstep;
            const char* a2 = last ? nA : cA + (size_t)(t + 2) * kstep; const char* b2 = last ? nB : cB + (size_t)(t + 2) * kstep;
            const char* a3 = a2 + kstep; const char* b3 = b2 + kstep;
            PG8_LDB(B0, 0, 0); PG8_SCHED; PG8_LDA(At, 0, 0); PG8_STAGE(PG8_SA(1, 1), a1 + hstep, voffA);
            PG8_WAIT_L(8); PG8_BAR; PG8_WAIT_L(0); PG8_MMA(0, 0, At, B0); PG8_BAR; PG8_SCHED;
            PG8_LDB(B1, 0, 1); PG8_STAGE(PG8_SB(0, 0), b2, voffB);
            PG8_BAR; PG8_WAIT_L(0); PG8_MMA(0, 1, At, B1); PG8_BAR;
            PG8_LDA(At, 0, 1); PG8_STAGE(PG8_SA(0, 0), a2, voffA);
            PG8_BAR; PG8_WAIT_L(0); PG8_MMA(1, 0, At, B0); PG8_BAR; PG8_SCHED;
            PG8_STAGE(PG8_SB(0, 1), b2 + hstep, voffB);
            PG8_WAIT_V(6); PG8_BAR; PG8_MMA(1, 1, At, B1); PG8_BAR;
            PG8_LDB(B0, 1, 0); PG8_SCHED; PG8_LDA(At, 1, 0); PG8_STAGE(PG8_SA(0, 1), a2 + hstep, voffA);
            PG8_WAIT_L(8); PG8_BAR; PG8_WAIT_L(0); PG8_MMA(0, 0, At, B0); PG8_BAR; PG8_SCHED;
            PG8_LDB(B1, 1, 1); PG8_STAGE(PG8_SB(1, 0), b3, voffB);
            PG8_BAR; PG8_WAIT_L(0); PG8_MMA(0, 1, At, B1); PG8_BAR;
            PG8_LDA(At, 1, 1); PG8_STAGE(PG8_SA(1, 0), a3, voffA);
            PG8_BAR; PG8_WAIT_L(0); PG8_MMA(1, 0, At, B0); PG8_BAR; PG8_SCHED;
            PG8_STAGE(PG8_SB(1, 1), b3 + hstep, voffB);
            PG8_WAIT_V(6); PG8_BAR; PG8_MMA(1, 1, At, B1); PG8_BAR;
        }
        E(acc, cur, wr, wc, fr, fq);
        if (!has_next) break;
#pragma unroll
        for (int a = 0; a < 2; ++a)
#pragma unroll
            for (int b = 0; b < 2; ++b)
#pragma unroll
                for (int m = 0; m < 4; ++m)
#pragma unroll
                    for (int n = 0; n < 2; ++n) acc[a][b][m][n] = (f32x4){0.f, 0.f, 0.f, 0.f};
        cur = nxt; cA = nA; cB = nB; ++ui;
    }
    PG8_WAIT_V(0);
    if (wr == 0) PG8_BAR;
    PG8_BAR;
#undef PG8_SA
#undef PG8_SB
#undef PG8_STAGE
#undef PG8_LDA
#undef PG8_LDB
#undef PG8_MMA
#undef PG8_WAIT_V
#undef PG8_WAIT_L
#undef PG8_BAR
#undef PG8_SCHED
}

struct EpiBf16 {
    static constexpr bool PERM = true;
    bf16_t* O; int ldc;
    __device__ __forceinline__ void operator()(const f32x4 (&acc)[2][2][4][2], const Unit& u, int wr, int wc, int fr, int fq) const {
        const int row0 = u.pm * BM + wr * 64 + fr, col0 = u.pn * BM + wc * 32 + 8 * fq;
#pragma unroll
        for (int ai = 0; ai < 2; ++ai)
#pragma unroll
            for (int m = 0; m < 4; ++m) { bf16_t* rowp = O + (size_t)(row0 + ai * HALF + m * 16) * ldc + col0;
#pragma unroll
                for (int bj = 0; bj < 2; ++bj) { const f32x4 v0 = acc[ai][bj][m][0], v1 = acc[ai][bj][m][1];
                    u32x4 w; w.x = cvt_pk_bf16(v0[0], v0[1]); w.y = cvt_pk_bf16(v0[2], v0[3]); w.z = cvt_pk_bf16(v1[0], v1[1]); w.w = cvt_pk_bf16(v1[2], v1[3]);
                    *(u32x4*)(rowp + bj * HALF) = w; } }
    }
};
struct EpiResid {
    static constexpr bool PERM = false;
    float* C; int ldc;
    __device__ __forceinline__ void operator()(const f32x4 (&acc)[2][2][4][2], const Unit& u, int wr, int wc, int fr, int fq) const {
        const int row0 = u.pm * BM + wr * 64 + fr, col0 = u.pn * BM + wc * 32 + 4 * fq;
#pragma unroll
        for (int ai = 0; ai < 2; ++ai)
#pragma unroll
            for (int m = 0; m < 4; ++m) { float* rowp = C + (size_t)(row0 + ai * HALF + m * 16) * ldc + col0;
#pragma unroll
                for (int bj = 0; bj < 2; ++bj)
#pragma unroll
                    for (int n = 0; n < 2; ++n) { f32x4* p = (f32x4*)(rowp + bj * HALF + n * 16); *p = *p + acc[ai][bj][m][n]; } }
    }
};
template <int ACT  > struct EpiGated {
    static constexpr bool PERM = true;
    bf16_t* O; int ldo; int coloff; const float* ba; const float* bb;
    __device__ __forceinline__ void operator()(const f32x4 (&acc)[2][2][4][2], const Unit& u, int wr, int wc, int fr, int fq) const {
        const int row0 = u.pm * BM + wr * 64 + fr, cl = u.pn * HALF + wc * 32 + 8 * fq;
        float va[8], vb[8];
#pragma unroll
        for (int j = 0; j < 8; ++j) { va[j] = (ACT == 0) ? ba[cl + j] : 0.f; vb[j] = (ACT == 0) ? bb[cl + j] : 0.f; }
#pragma unroll
        for (int ai = 0; ai < 2; ++ai)
#pragma unroll
            for (int m = 0; m < 4; ++m) { bf16_t* rowp = O + (size_t)(row0 + ai * HALF + m * 16) * ldo + coloff + cl;
                float o[8];
#pragma unroll
                for (int n = 0; n < 2; ++n)
#pragma unroll
                    for (int j = 0; j < 4; ++j) { const float a = acc[ai][0][m][n][j] + va[4 * n + j], b = acc[ai][1][m][n][j] + vb[4 * n + j];
                        o[4 * n + j] = (ACT == 0) ? a * sigmoidf_(b) : siluf_(a) * b; }
                u32x4 w; w.x = cvt_pk_bf16(o[0], o[1]); w.y = cvt_pk_bf16(o[2], o[3]); w.z = cvt_pk_bf16(o[4], o[5]); w.w = cvt_pk_bf16(o[6], o[7]);
                *(u32x4*)rowp = w; asm volatile("" ::: "memory"); }
    }
};
struct EpiMoeOut {
    static constexpr bool PERM = true;
    bf16_t* O; const int* row_tok; const float* row_w;
    __device__ __forceinline__ void operator()(const f32x4 (&acc)[2][2][4][2], const Unit& u, int wr, int wc, int fr, int fq) const {
        const int row0 = u.pm * BM + wr * 64 + fr, col0 = u.pn * BM + wc * 32 + 8 * fq;
#pragma unroll
        for (int ai = 0; ai < 2; ++ai)
#pragma unroll
            for (int m = 0; m < 4; ++m) { const int row = row0 + ai * HALF + m * 16; const int ts = row_tok[row]; const float w = row_w[row];
                if (ts >= 0) { bf16_t* rowp = O + ((size_t)(ts & 1) * NTOK + (size_t)(ts >> 1)) * DM + col0;
#pragma unroll
                    for (int bj = 0; bj < 2; ++bj) { const f32x4 v0 = acc[ai][bj][m][0] * w, v1 = acc[ai][bj][m][1] * w;
                        u32x4 q; q.x = cvt_pk_bf16(v0[0], v0[1]); q.y = cvt_pk_bf16(v0[2], v0[3]); q.z = cvt_pk_bf16(v1[0], v1[1]); q.w = cvt_pk_bf16(v1[2], v1[3]);
                        *(u32x4*)(rowp + bj * HALF) = q; } } asm volatile("" ::: "memory"); }
    }
};
struct MoeOrder {
    int nN, G, c, K; const char* A; const char* B; size_t bstride; const int* tiles;
    __device__ bool next(int i, Unit& u) const {
        const int nrt = tiles[0]; const long L = (long)i * G + c; if (L >= (long)nrt * nN) return false;
        u.pm = (int)(L / nN); u.pn = (int)(L % nN); const int e = tiles[64 + u.pm];
        u.a = A + (size_t)u.pm * 256 * K * 2; u.b = B + (size_t)e * bstride + (size_t)u.pn * 256 * K * 2; return true;
    }
};
}

struct Params { const float* in[44]; float* out; unsigned char* ws; int ph_lo, ph_hi; };
enum { I_X = 0, I_NORM1, I_WIN, I_MCONVW, I_MCONVB, I_MDTB, I_MALOG, I_MD, I_MNORM, I_RMU, I_RW0, I_RW2, I_RA0, I_RA2, I_RG2, I_RKK, I_RKA, I_RRK, I_RLNW, I_RLNB,
       I_CKVN, I_CWUK, I_CWUV, I_RELB, I_SARE, I_SAIM, I_SBRE, I_SBIM, I_SCRE, I_SCIM, I_SD, I_SLOGDT, I_SGLUW, I_SGLUB, I_WOUT, I_NORM2, I_WRG, I_BRG, I_WRE, I_BRE,
       I_WGATE, I_WUP, I_WDOWN, I_FNORM };

typedef const float* const __attribute__((address_space(4)))* in_tab_t;
struct Frame {
    LAS unsigned char* lds; int tid, lane, wave, bid, G;
    in_tab_t in; float* out; unsigned char* ws; unsigned* ctl;
    volatile LAS int* misc;
};

__device__ __forceinline__ int q_pop(Frame& F, int qi) {
    __syncthreads();
    if (F.tid == 0) F.misc[0] = (int)__hip_atomic_fetch_add(F.ctl + CW_Q + 64 * qi, 1u, __ATOMIC_RELAXED, __HIP_MEMORY_SCOPE_AGENT);
    __syncthreads();
    return F.misc[0];
}

__device__ __forceinline__ const void* opaque_ptr(const void* p) { const unsigned long long v = (unsigned long long)p; unsigned lo = __builtin_amdgcn_readfirstlane((unsigned)v), hi = __builtin_amdgcn_readfirstlane((unsigned)(v >> 32));
    asm volatile("" : "+s"(lo), "+s"(hi)); return (const void*)(((unsigned long long)hi << 32) | lo); }
__device__ __forceinline__ Frame relocal(const Frame& G) { Frame F = G; asm volatile("" : "+v"(F.tid)); F.ws = (unsigned char*)opaque_ptr(F.ws); F.ctl = (unsigned*)(F.ws + WS_CTL); F.in = (in_tab_t)(unsigned long long)opaque_ptr((const void*)(unsigned long long)F.in); F.lane = F.tid & 63; F.wave = __builtin_amdgcn_readfirstlane(F.tid >> 6); return F; }
template <int K> __device__ __forceinline__ f32x4 mma_nt(const LAS bf16_t* A, int lda, const LAS bf16_t* Bt, int ldb, f32x4 acc, int lane) {
    const int r = lane & 15, g = lane >> 4;
#pragma unroll
    for (int k0 = 0; k0 < K; k0 += 32) {
        const bf16x8 a = *(const LAS bf16x8*)(A + r * lda + k0 + 8 * g);
        const bf16x8 b = *(const LAS bf16x8*)(Bt + r * ldb + k0 + 8 * g);
        acc = __builtin_amdgcn_mfma_f32_16x16x32_bf16(a, b, acc, 0, 0, 0);
    }
    return acc;
}

template <class SrcMap> __device__ __forceinline__ void tr_tile(Frame& F, int ldsrc, bf16_t* dst, int K, int k0, int n0, SrcMap sm) {
    LAS float* tile = (LAS float*)F.lds;
    __syncthreads();
    { const int n4 = (F.tid & 63) * 4, kk = F.tid >> 6; const float* sp = sm(n0 + n4);
      f32x4 v[8];
#pragma unroll
      for (int ps = 0; ps < 8; ++ps) { v[ps] = (f32x4){0.f, 0.f, 0.f, 0.f}; if (sp) v[ps] = *(const f32x4*)(sp + (size_t)(k0 + kk + 8 * ps) * ldsrc); }
#pragma unroll
      for (int ps = 0; ps < 8; ++ps) { LAS float* t = tile + (kk + 8 * ps) * 257 + n4; t[0] = v[ps][0]; t[1] = v[ps][1]; t[2] = v[ps][2]; t[3] = v[ps][3]; } }
    __syncthreads();
    { const int kc = F.tid & 7;
#pragma unroll
      for (int j = 0; j < 4; ++j) { const int n = (F.tid >> 3) + 64 * j; float f[8];
#pragma unroll
          for (int i = 0; i < 8; ++i) f[i] = tile[(8 * kc + i) * 257 + n];
          u32x4 w; w.x = pk2(f[0], f[1]); w.y = pk2(f[2], f[3]); w.z = pk2(f[4], f[5]); w.w = pk2(f[6], f[7]);
          *(u32x4*)(dst + (size_t)(n0 + n) * K + k0 + 8 * kc) = w; } }
}

struct SmIn { const float* base; __device__ __forceinline__ const float* operator()(int n) const {
    int c; if (n < 772) c = n; else if (n < UR) return nullptr; else if (n < UR + 896) c = 772 + (n - UR); else if (n < UC) return nullptr;
    else if (n < UC + 680) c = 1668 + (n - UC); else if (n < US) return nullptr; else if (n < US + 256) c = 2348 + (n - US); else return nullptr; return base + c; } };
struct SmId { const float* base; __device__ __forceinline__ const float* operator()(int n) const { return base + n; } };
struct SmGlu { const float* base; __device__ __forceinline__ const float* operator()(int n) const { const int pn = n >> 8, rr = n & 255; return base + (rr < 128 ? 128 * pn + rr : 256 + 128 * pn + (rr - 128)); } };
struct SmGU { const float* gate; const float* up; __device__ __forceinline__ const float* operator()(int n) const {
    const unsigned long long d = (unsigned long long)up - (unsigned long long)gate; const unsigned long long a = (unsigned long long)gate + (((n & 255) < 128) ? 0ull : d); return (const float*)a + 128 * (n >> 8) + (n & 127); } };
__device__ __forceinline__ void phase_prologue(const Frame& F_) { Frame F = relocal(F_);
    for (int t = F.bid; t < 496; t += F.G) {
        if (t < 352) { const int l = t / 176, r = t % 176, kt = r / 11, nt = r % 11;
            tr_tile(F, NIN, (bf16_t*)(F.ws + WS_WIN) + (size_t)l * NINP * DM, DM, kt * 64, nt * 256, SmIn{F.in[I_WIN] + (size_t)l * DM * NIN}); }
        else if (t < 480) { const int q = t - 352, l = q / 64, r = q % 64, kt = r / 4, nt = r % 4;
            tr_tile(F, DM, (bf16_t*)(F.ws + WS_WOUT) + (size_t)l * DM * DM, DM, kt * 64, nt * 256, SmId{F.in[I_WOUT] + (size_t)l * DM * DM}); }
        else { const int q = t - 480, l = q / 8, r = q % 8, kt = r / 2, nt = r % 2;
            tr_tile(F, 512, (bf16_t*)(F.ws + WS_GLU) + (size_t)l * 512 * 256, 256, kt * 64, nt * 256, SmGlu{F.in[I_SGLUW] + (size_t)l * 256 * 512}); }
    }
    for (int i = F.bid * NTHR + F.tid; i < 2 * 48 * 1024; i += F.G * NTHR) { const int l = i / 49152, r = i % 49152, o = r >> 10, k = r & 1023;
        float v = 0.f; if (o < 32) v = F.in[I_WRE][((size_t)l * DM + k) * 32 + o]; else if (o < 36) v = F.in[I_WRG][((size_t)l * DM + k) * 4 + (o - 32)];
        v *= F.in[I_NORM2][l * DM + k];
        const bf16_t hi = f2bf(v); const bf16_t lo = f2bf(v - bf2f(hi));
        bf16_t* w = (bf16_t*)(F.ws + WS_WRT) + (size_t)l * 2 * 49152; w[r] = hi; w[49152 + r] = lo; }
    for (int i = F.bid * NTHR + F.tid; i < 2048 + 65536; i += F.G * NTHR) {
        if (i < 2048) {
            const int l = i >> 10, gn = i & 1023, g = gn >> 6;
            float* tab = (float*)(F.ws + WS_S5TAB + (size_t)l * S5TAB_L);
            const float lre = fminf(F.in[I_SARE][l * 1024 + gn], -1e-4f), lim = F.in[I_SAIM][l * 1024 + gn];
            const float dt = expf(F.in[I_SLOGDT][l * 16 + g]);
            const float mag = expf(dt * lre); float sn, cs; sincosf(dt * lim, &sn, &cs);
            const float are = mag * cs, aim = mag * sn;
            const float den = lre * lre + lim * lim;
            const float fre = ((are - 1.0f) * lre + aim * lim) / den, fim = (aim * lre - (are - 1.0f) * lim) / den;
            tab[gn * 2] = are; tab[gn * 2 + 1] = aim;
            float pr = are, pi = aim;
#pragma unroll
            for (int s = 0; s < 6; ++s) { const float nr = pr * pr - pi * pi, ni = 2.0f * pr * pi; pr = nr; pi = ni; }
            tab[2048 + gn * 2] = pr; tab[2048 + gn * 2 + 1] = pi;
            const float* bre = F.in[I_SBRE] + ((size_t)l * 1024 + gn) * 16; const float* bim = F.in[I_SBIM] + ((size_t)l * 1024 + gn) * 16;
            for (int p = 0; p < 16; ++p) { tab[4096 + (gn * 16 + p) * 2] = fre * bre[p] - fim * bim[p]; tab[4096 + (gn * 16 + p) * 2 + 1] = fre * bim[p] + fim * bre[p]; }
        } else {
            const int j = i - 2048, l = j >> 15, r = j & 32767, gp = r >> 7, k = r & 127;
            bf16_t* cm = (bf16_t*)(F.ws + WS_S5TAB + (size_t)l * S5TAB_L + S5TAB_F);
            const float v = k < 64 ? F.in[I_SCRE][((size_t)l * 256 + gp) * 64 + k] : -F.in[I_SCIM][((size_t)l * 256 + gp) * 64 + (k - 64)];
            cm[r] = f2bf(v);
        }
    }
}

__device__ __forceinline__ void phase_norm(const Frame& F_, const float* xin, bool add_o, const float* w, int mode) { Frame F = relocal(F_);
    float* X = (float*)(F.ws + WS_X); bf16_t* H = (bf16_t*)(F.ws + WS_H); const bf16_t* O = (const bf16_t*)(F.ws + WS_U);
    for (int row = F.bid * 8 + F.wave; row < NTOK; row += F.G * 8) {
        f32x4 v[4]; float ss = 0.f;
#pragma unroll
        for (int j = 0; j < 4; ++j) { const int c = 4 * F.lane + 256 * j; v[j] = *(const f32x4*)(xin + (size_t)row * DM + c);
            if (add_o) { const u32x2 a = *(const u32x2*)(O + (size_t)row * DM + c), b = *(const u32x2*)(O + ((size_t)NTOK + row) * DM + c);
                v[j][0] += __uint_as_float(a.x << 16) + __uint_as_float(b.x << 16); v[j][1] += __uint_as_float(a.x & 0xffff0000u) + __uint_as_float(b.x & 0xffff0000u);
                v[j][2] += __uint_as_float(a.y << 16) + __uint_as_float(b.y << 16); v[j][3] += __uint_as_float(a.y & 0xffff0000u) + __uint_as_float(b.y & 0xffff0000u); }
            ss += v[j][0] * v[j][0] + v[j][1] * v[j][1] + v[j][2] * v[j][2] + v[j][3] * v[j][3]; }
        ss = wave_sum(ss);
        const float rstd = rsqrtf(ss * (1.0f / DM) + 1e-6f);
#pragma unroll
        for (int j = 0; j < 4; ++j) { const int c = 4 * F.lane + 256 * j; const f32x4 wv = *(const f32x4*)(w + c);
            if (mode == 2) { *(f32x4*)(F.out + (size_t)row * DM + c) = v[j] * rstd * wv; }
            else { *(f32x4*)(X + (size_t)row * DM + c) = v[j];
                u32x2 o; o.x = pk2(v[j][0] * rstd * wv[0], v[j][1] * rstd * wv[1]); o.y = pk2(v[j][2] * rstd * wv[2], v[j][3] * rstd * wv[3]);
                *(u32x2*)(H + (size_t)row * DM + c) = o; } }
    }
}

__device__ __forceinline__ void item_kv(const Frame& F_, int layer, int item) { Frame F = relocal(F_);
    const bf16_t* U = (const bf16_t*)(F.ws + WS_U);
    LAS bf16_t* Ab = (LAS bf16_t*)F.lds;
    LAS bf16_t* Bt = (LAS bf16_t*)(F.lds + 17408);
    const int t0 = item * 64;
    { const int tok = F.tid >> 3, part = F.tid & 7; const bf16_t* src = U + (size_t)(t0 + tok) * NINP + UC + 256 + 16 * part;
      float f[16]; { float a[8], b[8]; unpack8(*(const u32x4*)src, a); unpack8(*(const u32x4*)(src + 8), b);
#pragma unroll
        for (int j = 0; j < 8; ++j) { f[j] = a[j]; f[8 + j] = b[j]; } }
      float ss = 0.f;
#pragma unroll
      for (int j = 0; j < 16; ++j) ss += f[j] * f[j];
      ss = sum8(ss);
      const float rstd = rsqrtf(ss * (1.0f / 128.0f) + 1e-6f); const float* nw = F.in[I_CKVN] + layer * 128 + 16 * part;
#pragma unroll
      for (int j = 0; j < 16; j += 2) *(LAS unsigned*)(Ab + tok * 136 + 16 * part + j) = pk2(f[j] * rstd * nw[j], f[j + 1] * rstd * nw[j + 1]); }
    { const int n = F.tid >> 2, kq = F.tid & 3; const float* w = (n < 64 ? F.in[I_CWUK] : F.in[I_CWUV]) + (size_t)layer * 128 * 64 + (n & 63);
#pragma unroll 4
      for (int k = 32 * kq; k < 32 * kq + 32; ++k) Bt[n * 136 + k] = f2bf(w[(size_t)k * 64]); }
    if (F.tid < 256) { const int tok = F.tid >> 2, q = F.tid & 3;
        *(u32x4*)((bf16_t*)(F.ws + WS_KIDX) + (size_t)(t0 + tok) * 32 + 8 * q) = *(const u32x4*)(U + (size_t)(t0 + tok) * NINP + UC + 640 + 8 * q); }
    __syncthreads();
    const int mt = F.wave & 3, g = F.lane >> 4, r = F.lane & 15;
#pragma unroll
    for (int q = 0; q < 4; ++q) { const int nt = (F.wave >> 2) * 4 + q;
        f32x4 acc = (f32x4){0.f, 0.f, 0.f, 0.f};
        acc = mma_nt<128>(Ab + mt * 16 * 136, 136, Bt + nt * 16 * 136, 136, acc, F.lane);
        const int n = nt * 16 + r; bf16_t* dst = (bf16_t*)(F.ws + (n < 64 ? WS_K : WS_V));
#pragma unroll
        for (int i = 0; i < 4; ++i) dst[(size_t)(t0 + mt * 16 + 4 * g + i) * 64 + (n & 63)] = f2bf(acc[i]); }
}

constexpr int MB_CG = 0, MB_BG = 18432, MB_BT = 36864, MB_XT = 55296, MB_M = 92160, MB_S0 = 101376, MB_DT = 110592, MB_AC = 111616, MB_RS = 112640;
template <int STAGE> __device__ __forceinline__ void item_mamba(const Frame& F_, int layer, int item) { Frame F = relocal(F_);
    const bf16_t* U = (const bf16_t*)(F.ws + WS_U);
    const int b = item >> 6, c = item & 63, l0 = c * 64; const size_t T0 = (size_t)b * SEQ + l0;
    LAS bf16_t* Cg = (LAS bf16_t*)(F.lds + MB_CG); LAS bf16_t* Bg = (LAS bf16_t*)(F.lds + MB_BG); LAS bf16_t* BT = (LAS bf16_t*)(F.lds + MB_BT);
    LAS bf16_t* XT = (LAS bf16_t*)(F.lds + MB_XT); LAS bf16_t* Mb = (LAS bf16_t*)(F.lds + MB_M); LAS bf16_t* S0 = (LAS bf16_t*)(F.lds + MB_S0);
    LAS float* dts = (LAS float*)(F.lds + MB_DT); LAS float* acs = (LAS float*)(F.lds + MB_AC); LAS float* rs = (LAS float*)(F.lds + MB_RS);
    if (F.tid < 256) { const int l = F.tid >> 2, h = F.tid & 3;
        const float raw = bf2f(U[(T0 + l) * NINP + UM + 768 + h]) + F.in[I_MDTB][layer * 4 + h];
        const float dt = softplusf_(raw); dts[l * 4 + h] = dt; acs[l * 4 + h] = -__expf(F.in[I_MALOG][layer * 4 + h]) * dt; }
    if (F.tid < 64) rs[F.tid] = 0.f;
    __syncthreads();
    float mycum = 0.f;
    if (F.tid < 256) { const int l = F.tid >> 2, h = F.tid & 3; for (int s = 0; s <= l; ++s) mycum += acs[s * 4 + h]; }
    __syncthreads();
    if (F.tid < 256) acs[F.tid] = mycum;
    __syncthreads();
    { const int ch8 = F.tid & 63, tg = F.tid >> 6, c0 = ch8 * 8;
      float wv[4][8], bv[8];
#pragma unroll
      for (int j = 0; j < 8; ++j) { bv[j] = F.in[I_MCONVB][layer * 512 + c0 + j];
#pragma unroll
          for (int k = 0; k < 4; ++k) wv[k][j] = F.in[I_MCONVW][(layer * 4 + k) * 512 + c0 + j]; }
      float win[3][8];
#pragma unroll
      for (int k = 0; k < 3; ++k) { const int l = l0 + tg * 8 - 3 + k;
          if (l >= 0) unpack8(*(const u32x4*)(U + ((size_t)b * SEQ + l) * NINP + UM + 256 + c0), win[k]);
          else {
#pragma unroll
              for (int j = 0; j < 8; ++j) win[k][j] = 0.f; } }
#pragma unroll 1
      for (int i = 0; i < 8; ++i) { const int l = tg * 8 + i; float cur[8]; unpack8(*(const u32x4*)(U + (T0 + l) * NINP + UM + 256 + c0), cur);
          float o[8];
#pragma unroll
          for (int j = 0; j < 8; ++j) { o[j] = siluf_(bv[j] + wv[0][j] * win[0][j] + wv[1][j] * win[1][j] + wv[2][j] * win[2][j] + wv[3][j] * cur[j]);
              win[0][j] = win[1][j]; win[1][j] = win[2][j]; win[2][j] = cur[j]; }
          if (c0 < 256) { const int h = c0 >> 6, p0 = c0 & 63; float sc = dts[l * 4 + h]; if (STAGE == 1) sc *= __expf(acs[63 * 4 + h] - acs[l * 4 + h]);
#pragma unroll
              for (int j = 0; j < 8; ++j) XT[(h * 64 + p0 + j) * 72 + l] = f2bf(o[j] * sc); }
          else if (c0 < 384) { const int g = (c0 - 256) >> 6, n0 = (c0 - 256) & 63;
              if (STAGE == 1) {
#pragma unroll
                  for (int j = 0; j < 8; ++j) BT[(g * 64 + n0 + j) * 72 + l] = f2bf(o[j]); }
              else { u32x4 w; w.x = pk2(o[0], o[1]); w.y = pk2(o[2], o[3]); w.z = pk2(o[4], o[5]); w.w = pk2(o[6], o[7]); *(LAS u32x4*)(Bg + (g * 64 + l) * 72 + n0) = w; } }
          else if (STAGE == 2) { const int g = (c0 - 384) >> 6, n0 = (c0 - 384) & 63;
              u32x4 w; w.x = pk2(o[0], o[1]); w.y = pk2(o[2], o[3]); w.z = pk2(o[4], o[5]); w.w = pk2(o[6], o[7]); *(LAS u32x4*)(Cg + (g * 64 + l) * 72 + n0) = w; } } }
    __syncthreads();
    const int g4 = F.lane >> 4, r16 = F.lane & 15;
    if (STAGE == 1) {
        float* MST = (float*)(F.ws + WS_MST) + ((size_t)(b * 64 + c) * 4) * 4096;
#pragma unroll
        for (int q = 0; q < 8; ++q) { const int tix = F.wave * 8 + q, h = tix >> 4, mt = (tix >> 2) & 3, nt = tix & 3;
            f32x4 acc = (f32x4){0.f, 0.f, 0.f, 0.f};
            acc = mma_nt<64>(XT + (h * 64 + mt * 16) * 72, 72, BT + ((h >> 1) * 64 + nt * 16) * 72, 72, acc, F.lane);
#pragma unroll
            for (int i = 0; i < 4; ++i) MST[(size_t)h * 4096 + (mt * 16 + 4 * g4 + i) * 64 + nt * 16 + r16] = acc[i]; }
        if (F.tid < 4) ((float*)(F.ws + WS_MDEC))[(b * 64 + c) * 4 + F.tid] = __expf(acs[63 * 4 + F.tid]);
    } else {
        const int mt = F.wave & 3, nh = F.wave >> 2;
        const float* MST = (const float*)(F.ws + WS_MST) + ((size_t)(b * 64 + c) * 4) * 4096;
        f32x4 G[2], yv[4][2];
#pragma unroll
        for (int h = 0; h < 4; ++h) {
            const int g = h >> 1;
            { const float* src = MST + (size_t)h * 4096 + F.tid * 8; const f32x4 a = *(const f32x4*)src, bq = *(const f32x4*)(src + 4);
              u32x4 w; w.x = pk2(a[0], a[1]); w.y = pk2(a[2], a[3]); w.z = pk2(bq[0], bq[1]); w.w = pk2(bq[2], bq[3]);
              *(LAS u32x4*)(S0 + (F.tid >> 3) * 72 + (F.tid & 7) * 8) = w; }
            if ((h & 1) == 0) {
#pragma unroll
                for (int q = 0; q < 2; ++q) { G[q] = (f32x4){0.f, 0.f, 0.f, 0.f};
                    G[q] = mma_nt<64>(Cg + (g * 64 + mt * 16) * 72, 72, Bg + (g * 64 + (2 * nh + q) * 16) * 72, 72, G[q], F.lane); } }
#pragma unroll
            for (int q = 0; q < 2; ++q) { const int s = (2 * nh + q) * 16 + r16; const float as = acs[s * 4 + h];
#pragma unroll
                for (int i = 0; i < 4; ++i) { const int l = mt * 16 + 4 * g4 + i; const float v = (s <= l) ? G[q][i] * __expf(acs[l * 4 + h] - as) : 0.f;
                    Mb[l * 72 + s] = f2bf(v); } }
            __syncthreads();
#pragma unroll
            for (int q = 0; q < 2; ++q) { const int nt = 2 * nh + q;
                f32x4 yd = (f32x4){0.f, 0.f, 0.f, 0.f}, yo = (f32x4){0.f, 0.f, 0.f, 0.f};
                yd = mma_nt<64>(Mb + mt * 16 * 72, 72, XT + (h * 64 + nt * 16) * 72, 72, yd, F.lane);
                yo = mma_nt<64>(Cg + (g * 64 + mt * 16) * 72, 72, S0 + nt * 16 * 72, 72, yo, F.lane);
                const int p = nt * 16 + r16; const float dsk = F.in[I_MD][layer * 4 + h];
#pragma unroll
                for (int i = 0; i < 4; ++i) { const int l = mt * 16 + 4 * g4 + i;
                    const float xs = bf2f(XT[(h * 64 + p) * 72 + l]) / dts[l * 4 + h];
                    yv[h][q][i] = yd[i] + yo[i] * __expf(acs[l * 4 + h]) + dsk * xs; } }
            __syncthreads();
        }
        float part[4] = {0.f, 0.f, 0.f, 0.f};
#pragma unroll
        for (int h = 0; h < 4; ++h)
#pragma unroll
            for (int q = 0; q < 2; ++q) { const int ch = h * 64 + (2 * nh + q) * 16 + r16;
#pragma unroll
                for (int i = 0; i < 4; ++i) { const int l = mt * 16 + 4 * g4 + i; const float z = bf2f(U[(T0 + l) * NINP + UM + ch]);
                    const float v = yv[h][q][i] * siluf_(z); yv[h][q][i] = v; part[i] += v * v; } }
#pragma unroll
        for (int i = 0; i < 4; ++i) { const float s = sum16(part[i]); if (r16 == 0) atomicAdd((float*)(rs + mt * 16 + 4 * g4 + i), s); }
        __syncthreads();
        bf16_t* Y = (bf16_t*)(F.ws + WS_H);
#pragma unroll
        for (int i = 0; i < 4; ++i) { const int l = mt * 16 + 4 * g4 + i; const float rstd = rsqrtf(rs[l] * (1.0f / 256.0f) + 1e-6f);
#pragma unroll
            for (int h = 0; h < 4; ++h)
#pragma unroll
                for (int q = 0; q < 2; ++q) { const int ch = h * 64 + (2 * nh + q) * 16 + r16;
                    Y[(T0 + l) * DM + ch] = f2bf(yv[h][q][i] * rstd * F.in[I_MNORM][layer * 256 + ch]); } }
    }
}
__device__ __forceinline__ void item_mamba_carry(const Frame& F_, int item) { Frame F = relocal(F_);
    const int b = item >> 2, h = item & 3;
    float* MST = (float*)(F.ws + WS_MST); const float* MD = (const float*)(F.ws + WS_MDEC);
    float s[8];
#pragma unroll
    for (int j = 0; j < 8; ++j) s[j] = 0.f;
    for (int c = 0; c < 64; ++c) { float* p = MST + ((size_t)(b * 64 + c) * 4 + h) * 4096 + F.tid * 8; const float d = MD[(b * 64 + c) * 4 + h];
        const f32x4 a = *(f32x4*)p, q = *(f32x4*)(p + 4);
        *(f32x4*)p = (f32x4){s[0], s[1], s[2], s[3]}; *(f32x4*)(p + 4) = (f32x4){s[4], s[5], s[6], s[7]};
        s[0] = s[0] * d + a[0]; s[1] = s[1] * d + a[1]; s[2] = s[2] * d + a[2]; s[3] = s[3] * d + a[3];
        s[4] = s[4] * d + q[0]; s[5] = s[5] * d + q[1]; s[6] = s[6] * d + q[2]; s[7] = s[7] * d + q[3]; }
}

template <int STAGE> __device__ __forceinline__ void item_s5(const Frame& F_, int layer, int item) { Frame F = relocal(F_);
    const bf16_t* U = (const bf16_t*)(F.ws + WS_U);
    const int b = item >> 6, c = item & 63; const size_t T0 = (size_t)b * SEQ + c * 64;
    LAS float* us = (LAS float*)F.lds; LAS bf16_t* Hs = (LAS bf16_t*)(F.lds + 65536);
    const float* tab = (const float*)(F.ws + WS_S5TAB + (size_t)layer * S5TAB_L);
    { const int tok = F.tid >> 3, part = F.tid & 7;
#pragma unroll
      for (int q = 0; q < 4; ++q) { float f[8]; unpack8(*(const u32x4*)(U + (T0 + tok) * NINP + US + 32 * part + 8 * q), f);
          *(LAS f32x4*)(us + tok * 256 + 32 * part + 8 * q) = (f32x4){f[0], f[1], f[2], f[3]}; *(LAS f32x4*)(us + tok * 256 + 32 * part + 8 * q + 4) = (f32x4){f[4], f[5], f[6], f[7]}; } }
    const int g = F.tid >> 5, n0 = F.tid & 31, gn0 = g * 64 + n0, gn1 = gn0 + 32;
    float bb0[32], bb1[32];
#pragma unroll
    for (int j = 0; j < 32; j += 4) { const f32x4 a = *(const f32x4*)(tab + 4096 + gn0 * 32 + j), bq = *(const f32x4*)(tab + 4096 + gn1 * 32 + j);
        bb0[j] = a[0]; bb0[j + 1] = a[1]; bb0[j + 2] = a[2]; bb0[j + 3] = a[3]; bb1[j] = bq[0]; bb1[j + 1] = bq[1]; bb1[j + 2] = bq[2]; bb1[j + 3] = bq[3]; }
    const float a0r = tab[gn0 * 2], a0i = tab[gn0 * 2 + 1], a1r = tab[gn1 * 2], a1i = tab[gn1 * 2 + 1];
    float* ST = (float*)(F.ws + WS_S5ST) + (size_t)(b * 64 + c) * 2048;
    float h0r = 0.f, h0i = 0.f, h1r = 0.f, h1i = 0.f;
    if (STAGE == 2) { h0r = ST[gn0 * 2]; h0i = ST[gn0 * 2 + 1]; h1r = ST[gn1 * 2]; h1i = ST[gn1 * 2 + 1]; }
    bf16x8 cf[2][4];
    if (STAGE == 2) { const bf16_t* cm = (const bf16_t*)(F.ws + WS_S5TAB + (size_t)layer * S5TAB_L + S5TAB_F);
#pragma unroll
        for (int gg = 0; gg < 2; ++gg)
#pragma unroll
            for (int ks = 0; ks < 4; ++ks) cf[gg][ks] = *(const bf16x8*)(cm + ((size_t)((2 * F.wave + gg) * 16 + (F.lane & 15))) * 128 + 32 * ks + 8 * (F.lane >> 4)); }
    __syncthreads();
#pragma unroll 1
    for (int lb = 0; lb < 4; ++lb) {
#pragma unroll 2
        for (int li = 0; li < 16; ++li) { const int l = lb * 16 + li;
            float uu[16];
#pragma unroll
            for (int q = 0; q < 4; ++q) { const f32x4 v = *(const LAS f32x4*)(us + l * 256 + g * 16 + 4 * q); uu[4 * q] = v[0]; uu[4 * q + 1] = v[1]; uu[4 * q + 2] = v[2]; uu[4 * q + 3] = v[3]; }
            float b0r = 0.f, b0i = 0.f, b1r = 0.f, b1i = 0.f;
#pragma unroll
            for (int p = 0; p < 16; ++p) { b0r += bb0[2 * p] * uu[p]; b0i += bb0[2 * p + 1] * uu[p]; b1r += bb1[2 * p] * uu[p]; b1i += bb1[2 * p + 1] * uu[p]; }
            { const float nr = a0r * h0r - a0i * h0i + b0r, ni = a0r * h0i + a0i * h0r + b0i; h0r = nr; h0i = ni; }
            { const float nr = a1r * h1r - a1i * h1i + b1r, ni = a1r * h1i + a1i * h1r + b1i; h1r = nr; h1i = ni; }
            if (STAGE == 2) { LAS bf16_t* hp = Hs + li * 2056 + g * 128; hp[n0] = f2bf(h0r); hp[64 + n0] = f2bf(h0i); hp[n0 + 32] = f2bf(h1r); hp[96 + n0] = f2bf(h1i); }
        }
        if (STAGE == 2) {
            __syncthreads();
            bf16_t* YS = (bf16_t*)(F.ws + WS_MOE + YSG_OFF);
#pragma unroll
            for (int gg = 0; gg < 2; ++gg) { const int gq = 2 * F.wave + gg; f32x4 acc = (f32x4){0.f, 0.f, 0.f, 0.f};
#pragma unroll
                for (int ks = 0; ks < 4; ++ks) { const bf16x8 a = *(const LAS bf16x8*)(Hs + (F.lane & 15) * 2056 + gq * 128 + 32 * ks + 8 * (F.lane >> 4));
                    acc = __builtin_amdgcn_mfma_f32_16x16x32_bf16(a, cf[gg][ks], acc, 0, 0, 0); }
                const int ch = gq * 16 + (F.lane & 15); const float dsk = F.in[I_SD][layer * 256 + ch];
#pragma unroll
                for (int i = 0; i < 4; ++i) { const int l = lb * 16 + 4 * (F.lane >> 4) + i; const float y = acc[i] + dsk * us[l * 256 + ch];
                    YS[(T0 + l) * 256 + ch] = f2bf(gelu_tanh(y)); } }
            __syncthreads();
        }
    }
    if (STAGE == 1) { ST[gn0 * 2] = h0r; ST[gn0 * 2 + 1] = h0i; ST[gn1 * 2] = h1r; ST[gn1 * 2 + 1] = h1i; }
    if (STAGE == 2) {
        asm volatile("s_waitcnt vmcnt(0)" ::: "memory"); __syncthreads();
        const bf16_t* YS = (const bf16_t*)(F.ws + WS_MOE + YSG_OFF) + T0 * 256; const bf16_t* GW = (const bf16_t*)(F.ws + WS_GLU) + (size_t)layer * 512 * 256;
        const int r16 = F.lane & 15, g4 = F.lane >> 4;
        f32x4 av[4][2], ag[4][2];
#pragma unroll
        for (int m = 0; m < 4; ++m)
#pragma unroll
            for (int q = 0; q < 2; ++q) { av[m][q] = (f32x4){0.f, 0.f, 0.f, 0.f}; ag[m][q] = (f32x4){0.f, 0.f, 0.f, 0.f}; }
#pragma unroll 2
        for (int ks = 0; ks < 8; ++ks) {
            bf16x8 af[4], bv[2], bg[2];
#pragma unroll
            for (int m = 0; m < 4; ++m) af[m] = *(const bf16x8*)(YS + (size_t)(16 * m + r16) * 256 + 32 * ks + 8 * g4);
#pragma unroll
            for (int q = 0; q < 2; ++q) { const int c = 32 * F.wave + 16 * q + r16; const int rowv = 256 * (c >> 7) + (c & 127);
                bv[q] = *(const bf16x8*)(GW + (size_t)rowv * 256 + 32 * ks + 8 * g4); bg[q] = *(const bf16x8*)(GW + (size_t)(rowv + 128) * 256 + 32 * ks + 8 * g4); }
#pragma unroll
            for (int m = 0; m < 4; ++m)
#pragma unroll
                for (int q = 0; q < 2; ++q) { av[m][q] = __builtin_amdgcn_mfma_f32_16x16x32_bf16(af[m], bv[q], av[m][q], 0, 0, 0); ag[m][q] = __builtin_amdgcn_mfma_f32_16x16x32_bf16(af[m], bg[q], ag[m][q], 0, 0, 0); }
        }
        bf16_t* Y = (bf16_t*)(F.ws + WS_H);
#pragma unroll
        for (int q = 0; q < 2; ++q) { const int c = 32 * F.wave + 16 * q + r16; const float bvl = F.in[I_SGLUB][layer * 512 + c], bgt = F.in[I_SGLUB][layer * 512 + 256 + c];
#pragma unroll
            for (int m = 0; m < 4; ++m)
#pragma unroll
                for (int i = 0; i < 4; ++i) Y[(T0 + 16 * m + 4 * g4 + i) * DM + 768 + c] = f2bf((av[m][q][i] + bvl) * sigmoidf_(ag[m][q][i] + bgt)); }
    }
}
__device__ __forceinline__ void item_s5_carry(const Frame& F_, int layer, int b) { Frame F = relocal(F_);
    const float* tab = (const float*)(F.ws + WS_S5TAB + (size_t)layer * S5TAB_L) + 2048;
    float* ST = (float*)(F.ws + WS_S5ST) + (size_t)b * 64 * 2048;
#pragma unroll
    for (int q = 0; q < 2; ++q) { const int gn = F.tid + 512 * q; const float pr = tab[gn * 2], pi = tab[gn * 2 + 1]; float hr = 0.f, hi = 0.f;
        for (int c = 0; c < 64; ++c) { float* p = ST + (size_t)c * 2048 + gn * 2; const float tr = p[0], ti = p[1]; p[0] = hr; p[1] = hi;
            const float nr = pr * hr - pi * hi + tr, ni = pr * hi + pi * hr + ti; hr = nr; hi = ni; } }
}

constexpr int RB_LD = 72;
constexpr int RW_R = 0, RW_K = 16384, RW_V = 32768, RW_W = 49152, RW_A = 65536, RW_B = 81920;
constexpr int R3_G = 49152, R3_O = 65536, R3_TILES = 81920, R3_BON = 147456;
template <int STAGE> __device__ __forceinline__ void rwkv_prep(const Frame& F_, int layer, int b, int h, int c) { Frame F = relocal(F_);
    const bf16_t* U = (const bf16_t*)(F.ws + WS_U);
    const int l0 = c * 64; const size_t T0 = (size_t)b * SEQ + l0;
    LAS float* Rr = (LAS float*)(F.lds + RW_R); LAS float* Kk = (LAS float*)(F.lds + RW_K); LAS float* Vv = (LAS float*)(F.lds + RW_V); LAS float* Ww = (LAS float*)(F.lds + RW_W);
    LAS float* Aa = (LAS float*)(F.lds + (STAGE == 1 ? RW_A : R3_O)); LAS float* Bb = (LAS float*)(F.lds + RW_B); LAS float* Gg = (LAS float*)(F.lds + R3_G); LAS float* BON = (LAS float*)(F.lds + R3_BON);
    LAS bf16_t* TWb = (LAS bf16_t*)(F.lds + 98304); LAS bf16_t* DAb = (LAS bf16_t*)(F.lds + (STAGE == 1 ? 103424 : 118784)); LAS bf16_t* SGb = (LAS bf16_t*)(F.lds + 123904);
    LAS bf16_t* w2T = (LAS bf16_t*)(F.lds + 108544); LAS bf16_t* a2T = (LAS bf16_t*)(F.lds + (STAGE == 1 ? 113664 : 133120)); LAS bf16_t* g2T = (LAS bf16_t*)(F.lds + 138240);
    const float* mu = F.in[I_RMU] + layer * 896;
    { const int tok = F.tid >> 3, p8 = F.tid & 7; const bool first = (l0 + tok == 0);
      const bf16_t* cur = U + (T0 + tok) * NINP + UR; const bf16_t* prv = cur - NINP;
#pragma unroll
      for (int sec = (STAGE == 1 ? 0 : 2); sec < 3; ++sec) { const int co = sec * 256 + h * 64 + 8 * p8; float av[8], pq[8]; unpack8(*(const u32x4*)(cur + co), av);
          if (first) {
#pragma unroll
              for (int j = 0; j < 8; ++j) pq[j] = 0.f; } else unpack8(*(const u32x4*)(prv + co), pq);
          const f32x4 m0 = *(const f32x4*)(mu + co), m1 = *(const f32x4*)(mu + co + 4);
          LAS float* dst = (sec == 0 ? Rr : sec == 1 ? Kk : Vv) + tok * 64 + 8 * p8;
          *(LAS f32x4*)dst = (f32x4){av[0] + m0[0] * (pq[0] - av[0]), av[1] + m0[1] * (pq[1] - av[1]), av[2] + m0[2] * (pq[2] - av[2]), av[3] + m0[3] * (pq[3] - av[3])};
          *(LAS f32x4*)(dst + 4) = (f32x4){av[4] + m1[0] * (pq[4] - av[4]), av[5] + m1[1] * (pq[5] - av[5]), av[6] + m1[2] * (pq[6] - av[6]), av[7] + m1[3] * (pq[7] - av[7])}; }
      if (STAGE == 1) { const int co = 768 + 4 * p8;
        const u32x2 cv = *(const u32x2*)(cur + co); u32x2 pv = (u32x2){0u, 0u}; if (!first) pv = *(const u32x2*)(prv + co);
        const f32x4 m0 = *(const f32x4*)(mu + co);
        float x[4] = {__uint_as_float(cv.x << 16), __uint_as_float(cv.x & 0xffff0000u), __uint_as_float(cv.y << 16), __uint_as_float(cv.y & 0xffff0000u)};
        const float y[4] = {__uint_as_float(pv.x << 16), __uint_as_float(pv.x & 0xffff0000u), __uint_as_float(pv.y << 16), __uint_as_float(pv.y & 0xffff0000u)};
#pragma unroll
        for (int j = 0; j < 4; ++j) x[j] = tanhf_(x[j] + m0[j] * (y[j] - x[j]));
        *(LAS u32x2*)(TWb + tok * 40 + 4 * p8) = (u32x2){pk2(x[0], x[1]), pk2(x[2], x[3])}; }
      if (STAGE == 1) { const int co = 800 + 4 * p8;
        const u32x2 cv = *(const u32x2*)(cur + co); u32x2 pv = (u32x2){0u, 0u}; if (!first) pv = *(const u32x2*)(prv + co);
        const f32x4 m0 = *(const f32x4*)(mu + co);
        float x[4] = {__uint_as_float(cv.x << 16), __uint_as_float(cv.x & 0xffff0000u), __uint_as_float(cv.y << 16), __uint_as_float(cv.y & 0xffff0000u)};
        const float y[4] = {__uint_as_float(pv.x << 16), __uint_as_float(pv.x & 0xffff0000u), __uint_as_float(pv.y << 16), __uint_as_float(pv.y & 0xffff0000u)};
#pragma unroll
        for (int j = 0; j < 4; ++j) x[j] = x[j] + m0[j] * (y[j] - x[j]);
        *(LAS u32x2*)(DAb + tok * 40 + 4 * p8) = (u32x2){pk2(x[0], x[1]), pk2(x[2], x[3])}; }
      if (STAGE == 3) { const int co = 832 + 8 * p8; float av[8], pq[8]; unpack8(*(const u32x4*)(cur + co), av);
          if (first) {
#pragma unroll
              for (int j = 0; j < 8; ++j) pq[j] = 0.f; } else unpack8(*(const u32x4*)(prv + co), pq);
          const f32x4 m0 = *(const f32x4*)(mu + co), m1 = *(const f32x4*)(mu + co + 4); float x[8];
#pragma unroll
          for (int j = 0; j < 8; ++j) x[j] = sigmoidf_(av[j] + (j < 4 ? m0[j] : m1[j - 4]) * (pq[j] - av[j]));
          *(LAS u32x4*)(SGb + tok * RB_LD + 8 * p8) = (u32x4){pk2(x[0], x[1]), pk2(x[2], x[3]), pk2(x[4], x[5]), pk2(x[6], x[7])}; } }
    { const int ch = F.tid & 63, part = F.tid >> 6;
      if (STAGE == 1) { const float* w2 = F.in[I_RW2] + ((size_t)layer * 32 + 4 * part) * 256 + h * 64 + ch;
          *(LAS u32x2*)(w2T + ch * 40 + 4 * part) = (u32x2){pk2(w2[0], w2[256]), pk2(w2[512], w2[768])}; }
      if (STAGE == 1) { const float* a2 = F.in[I_RA2] + ((size_t)layer * 32 + 4 * part) * 256 + h * 64 + ch;
          *(LAS u32x2*)(a2T + ch * 40 + 4 * part) = (u32x2){pk2(a2[0], a2[256]), pk2(a2[512], a2[768])}; }
      if (STAGE == 3) { const float* g2 = F.in[I_RG2] + ((size_t)layer * 64 + 8 * part) * 256 + h * 64 + ch;
          *(LAS u32x4*)(g2T + ch * RB_LD + 8 * part) = (u32x4){pk2(g2[0], g2[256]), pk2(g2[512], g2[768]), pk2(g2[1024], g2[1280]), pk2(g2[1536], g2[1792])}; } }
    __syncthreads();
    { const int lane = F.lane, mt = F.wave >> 1, nt0 = 2 * (F.wave & 1), r = lane & 15, g4 = lane >> 4; const f32x4 zero4 = (f32x4){0.f, 0.f, 0.f, 0.f};
#pragma unroll
      for (int q = 0; q < 2; ++q) { const int nt = nt0 + q, ch = 16 * nt + r, cg = layer * 256 + h * 64 + ch;
          if (STAGE == 1) { const f32x4 wl = mma_nt<32>(TWb + 16 * mt * 40, 40, w2T + 16 * nt * 40, 40, zero4, lane); const float w0 = F.in[I_RW0][cg];
#pragma unroll
              for (int i = 0; i < 4; ++i) { const float x = w0 + wl[i]; const float wlog = -__logf(1.0f + __expf(-x)) - 0.5f; Ww[(16 * mt + 4 * g4 + i) * 64 + ch] = __expf(-__expf(wlog)); } }
          if (STAGE == 1) { const f32x4 al = mma_nt<32>(DAb + 16 * mt * 40, 40, a2T + 16 * nt * 40, 40, zero4, lane); const float a0 = F.in[I_RA0][cg];
#pragma unroll
              for (int i = 0; i < 4; ++i) Aa[(16 * mt + 4 * g4 + i) * 64 + ch] = sigmoidf_(a0 + al[i]); }
          if (STAGE == 3) { const f32x4 gv = mma_nt<64>(SGb + 16 * mt * RB_LD, RB_LD, g2T + 16 * nt * RB_LD, RB_LD, zero4, lane);
#pragma unroll
              for (int i = 0; i < 4; ++i) Gg[(16 * mt + 4 * g4 + i) * 64 + ch] = gv[i]; } } }
    __syncthreads();
    float* gBON = (float*)(F.ws + WS_BON) + ((size_t)(b * 4 + h) * 64 + c) * 64;
    if (STAGE == 1) { const int j = F.lane, tq = F.wave, cg = layer * 256 + h * 64 + j;
      const float kkw = F.in[I_RKK][cg], kaw = F.in[I_RKA][cg], rk = F.in[I_RRK][cg];
#pragma unroll 2
      for (int i8 = 0; i8 < 8; ++i8) { const int t = tq + 8 * i8;
          const float a = Aa[t * 64 + j]; const float kraw = Kk[t * 64 + j]; const float kp = kraw * (1.0f + (a - 1.0f) * kaw);
          Kk[t * 64 + j] = kp;
          const float kkv = kraw * kkw; const float ss = wave_sum(kkv * kkv); const float kkn = kkv * rsqrtf(fmaxf(ss, 1e-24f)); Aa[t * 64 + j] = -kkn; Bb[t * 64 + j] = kkn * a;
          const float bo = wave_sum(Rr[t * 64 + j] * kp * rk); if (j == 0) gBON[t] = bo; } }
    else if (F.tid < 64) BON[F.tid] = gBON[F.tid];
    __syncthreads();
}
constexpr int RB_AT = 98304, RB_ATT = RB_AT + 9216, RB_BT = RB_ATT + 9216, RB_BTT = RB_BT + 9216, RB_KT = RB_BTT + 9216, RB_RT = RB_KT + 9216, RB_VT = RB_RT + 9216, RB_GC = RB_VT + 9216;
constexpr int RX_X = 0, RX_XT = 9216, RX_TB = 18432, RX_M = 27648, RX_NRT = 36864, RX_G1T = 46080, RX_G2T = 55296, RX_QT = 64512;
__device__ __forceinline__ void st_tile(LAS bf16_t* dst, int mt, int nt, const f32x4 v, int lane) {
    const int r = lane & 15, g = lane >> 4;
#pragma unroll
    for (int i = 0; i < 4; ++i) dst[(16 * mt + 4 * g + i) * RB_LD + 16 * nt + r] = f2bf(v[i]);
}
__device__ __forceinline__ void st_tile_t(LAS bf16_t* dst, int mt, int nt, const f32x4 v, int lane) {
    const int r = lane & 15, g = lane >> 4; u32x2 w; w.x = pk2(v[0], v[1]); w.y = pk2(v[2], v[3]);
    *(LAS u32x2*)(dst + (16 * nt + r) * RB_LD + 16 * mt + 4 * g) = w;
}
__device__ __forceinline__ void item_rwkv1(const Frame& F_, int layer, int item) { Frame F = relocal(F_);
    const int b = item >> 8, h = (item >> 6) & 3, c = item & 63;
    rwkv_prep<1>(F, layer, b, h, c);
    LAS float* Rr = (LAS float*)(F.lds + RW_R); LAS float* Kk = (LAS float*)(F.lds + RW_K); LAS float* Vv = (LAS float*)(F.lds + RW_V); LAS float* Ww = (LAS float*)(F.lds + RW_W);
    LAS float* Aa = (LAS float*)(F.lds + RW_A); LAS float* Bb = (LAS float*)(F.lds + RW_B);
    LAS bf16_t* At = (LAS bf16_t*)(F.lds + RB_AT); LAS bf16_t* AtT = (LAS bf16_t*)(F.lds + RB_ATT); LAS bf16_t* Bt = (LAS bf16_t*)(F.lds + RB_BT); LAS bf16_t* BtT = (LAS bf16_t*)(F.lds + RB_BTT);
    LAS bf16_t* Kt = (LAS bf16_t*)(F.lds + RB_KT); LAS bf16_t* Rt = (LAS bf16_t*)(F.lds + RB_RT); LAS bf16_t* VT = (LAS bf16_t*)(F.lds + RB_VT); LAS float* gC = (LAS float*)(F.lds + RB_GC);
    LAS bf16_t* X = (LAS bf16_t*)(F.lds + RX_X); LAS bf16_t* XT = (LAS bf16_t*)(F.lds + RX_XT); LAS bf16_t* Tb = (LAS bf16_t*)(F.lds + RX_TB); LAS bf16_t* Mm = (LAS bf16_t*)(F.lds + RX_M);
    LAS bf16_t* NrT = (LAS bf16_t*)(F.lds + RX_NRT); LAS bf16_t* G1T = (LAS bf16_t*)(F.lds + RX_G1T); LAS bf16_t* G2T = (LAS bf16_t*)(F.lds + RX_G2T); LAS bf16_t* QT = (LAS bf16_t*)(F.lds + RX_QT);
    { const int k = F.tid & 63, part = F.tid >> 6; float g = 1.0f;
      for (int t = 0; t < 8 * part; ++t) g *= Ww[t * 64 + k];
#pragma unroll
      for (int i = 0; i < 8; ++i) { const int t = 8 * part + i; const float gp = g; g *= Ww[t * 64 + k]; const float ig = 1.0f / g;
          const bf16_t av = f2bf(Aa[t * 64 + k] * gp), bv = f2bf(Bb[t * 64 + k] * ig);
          At[t * RB_LD + k] = av; AtT[k * RB_LD + t] = av; Bt[t * RB_LD + k] = bv; BtT[k * RB_LD + t] = bv;
          Kt[t * RB_LD + k] = f2bf(Kk[t * 64 + k] * ig); Rt[t * RB_LD + k] = f2bf(Rr[t * 64 + k] * g); VT[k * RB_LD + t] = f2bf(Vv[t * 64 + k]); }
      if (part == 7) gC[k] = g; }
    __syncthreads();
    const int lane = F.lane, mt = F.wave >> 1, nt0 = 2 * (F.wave & 1), r = lane & 15, g4 = lane >> 4;
    const f32x4 zero4 = (f32x4){0.f, 0.f, 0.f, 0.f};
    f32x4 Tacc[2];
#pragma unroll
    for (int q = 0; q < 2; ++q) { const int nt = nt0 + q;
        f32x4 n = mma_nt<64>(Bt + 16 * mt * RB_LD, RB_LD, At + 16 * nt * RB_LD, RB_LD, zero4, lane);
        f32x4 m = mma_nt<64>(Kt + 16 * mt * RB_LD, RB_LD, At + 16 * nt * RB_LD, RB_LD, zero4, lane);
        f32x4 nr = mma_nt<64>(Rt + 16 * mt * RB_LD, RB_LD, Bt + 16 * nt * RB_LD, RB_LD, zero4, lane);
#pragma unroll
        for (int i = 0; i < 4; ++i) { const int row = 16 * mt + 4 * g4 + i, col = 16 * nt + r;
            n[i] = (row < col) ? n[i] : 0.f; m[i] = (row < col) ? m[i] : 0.f; nr[i] = (col <= row) ? nr[i] : 0.f;
            Tacc[q][i] = n[i] + (row == col ? 1.0f : 0.f); }
        st_tile(X, mt, nt, n, lane); st_tile_t(XT, mt, nt, n, lane); st_tile(Tb, mt, nt, Tacc[q], lane); st_tile(Mm, mt, nt, m, lane); st_tile(NrT, mt, nt, nr, lane); }
    __syncthreads();
#pragma unroll 1
    for (int it = 0; it < 6; ++it) {
        f32x4 x2[2];
#pragma unroll
        for (int q = 0; q < 2; ++q) { const int nt = nt0 + q;
            if (it > 0) Tacc[q] = mma_nt<64>(Tb + 16 * mt * RB_LD, RB_LD, XT + 16 * nt * RB_LD, RB_LD, Tacc[q], lane);
            x2[q] = zero4; if (it < 5) x2[q] = mma_nt<64>(X + 16 * mt * RB_LD, RB_LD, XT + 16 * nt * RB_LD, RB_LD, zero4, lane); }
        __syncthreads();
#pragma unroll
        for (int q = 0; q < 2; ++q) { const int nt = nt0 + q;
            if (it > 0) st_tile(Tb, mt, nt, Tacc[q], lane);
            if (it < 5) { st_tile(X, mt, nt, x2[q], lane); st_tile_t(XT, mt, nt, x2[q], lane); } }
        __syncthreads();
    }
#pragma unroll
    for (int q = 0; q < 2; ++q) { const int nt = nt0 + q;
        st_tile(G1T, mt, nt, mma_nt<64>(NrT + 16 * mt * RB_LD, RB_LD, Tb + 16 * nt * RB_LD, RB_LD, zero4, lane), lane);
        st_tile(G2T, mt, nt, mma_nt<64>(BtT + 16 * mt * RB_LD, RB_LD, Tb + 16 * nt * RB_LD, RB_LD, zero4, lane), lane); }
    __syncthreads();
    const size_t ci = (size_t)(b * 4 + h) * 64 + c;
    bf16_t* gPT = (bf16_t*)(F.ws + WS_MOE + RW_PT) + ci * 4096; bf16_t* gW1 = (bf16_t*)(F.ws + WS_MOE + RW_W1) + ci * 4096; bf16_t* gZ = (bf16_t*)(F.ws + WS_MOE + RW_Z) + ci * 4096;
#pragma unroll
    for (int q = 0; q < 2; ++q) { const int nt = nt0 + q; const int col = 16 * nt + r;
        f32x4 w1 = mma_nt<64>(G1T + 16 * mt * RB_LD, RB_LD, AtT + 16 * nt * RB_LD, RB_LD, zero4, lane);
        f32x4 z = mma_nt<64>(G1T + 16 * mt * RB_LD, RB_LD, Mm + 16 * nt * RB_LD, RB_LD, zero4, lane);
        f32x4 mr = mma_nt<64>(Rt + 16 * mt * RB_LD, RB_LD, Kt + 16 * nt * RB_LD, RB_LD, zero4, lane);
        f32x4 p = mma_nt<64>(G2T + 16 * mt * RB_LD, RB_LD, AtT + 16 * nt * RB_LD, RB_LD, zero4, lane);
        f32x4 qq = mma_nt<64>(G2T + 16 * mt * RB_LD, RB_LD, Mm + 16 * nt * RB_LD, RB_LD, zero4, lane);
        const int pos = 32 * (col >> 5) + 8 * ((col >> 2) & 3) + 4 * ((col >> 4) & 1) + (col & 3);
#pragma unroll
        for (int i = 0; i < 4; ++i) { const int row = 16 * mt + 4 * g4 + i;
            gW1[row * 64 + col] = f2bf(w1[i] + bf2f(Rt[row * RB_LD + col]));
            gZ[row * 64 + col] = f2bf(z[i] + (col <= row ? mr[i] : 0.f));
            const float gc = gC[row];
            gPT[row * 64 + pos] = f2bf((p[i] + (row == col ? 1.0f : 0.f)) * gc);
            qq[i] = (qq[i] + bf2f(Kt[col * RB_LD + row])) * gc; }
        st_tile(QT, mt, nt, qq, lane); }
    __syncthreads();
    bf16_t* gU = (bf16_t*)(F.ws + WS_MOE + RW_U) + ci * 4096;
#pragma unroll
    for (int q = 0; q < 2; ++q) { const int nt = nt0 + q;
        const f32x4 u = mma_nt<64>(VT + 16 * mt * RB_LD, RB_LD, QT + 16 * nt * RB_LD, RB_LD, zero4, lane);
#pragma unroll
        for (int i = 0; i < 4; ++i) gU[(16 * mt + 4 * g4 + i) * 64 + 16 * nt + r] = f2bf(u[i]); }
}
__device__ __forceinline__ void item_rwkv_carry(const Frame& F_, int item) { Frame F = relocal(F_);
    const int bh = item * 2 + (F.wave >> 2), nt = F.wave & 3, r = F.lane & 15, g = F.lane >> 4;
    const bf16_t* PT = (const bf16_t*)(F.ws + WS_MOE + RW_PT); const bf16_t* Uc = (const bf16_t*)(F.ws + WS_MOE + RW_U); bf16_t* Ss = (bf16_t*)(F.ws + WS_MOE + RW_S);
    f32x4 acc[4];
#pragma unroll
    for (int m = 0; m < 4; ++m) acc[m] = (f32x4){0.f, 0.f, 0.f, 0.f};
    for (int c = 0; c < 64; ++c) { const size_t ci = (size_t)bh * 64 + c;
        bf16x8 af[4][2]; f32x4 cin[4];
#pragma unroll
        for (int m = 0; m < 4; ++m) { const u32x2 uv = *(const u32x2*)(Uc + ci * 4096 + (16 * nt + r) * 64 + 16 * m + 4 * g);
            cin[m] = (f32x4){__uint_as_float(uv.x << 16), __uint_as_float(uv.x & 0xffff0000u), __uint_as_float(uv.y << 16), __uint_as_float(uv.y & 0xffff0000u)};
#pragma unroll
            for (int s = 0; s < 2; ++s) af[m][s] = *(const bf16x8*)(PT + ci * 4096 + (16 * m + r) * 64 + 32 * s + 8 * g); }
        unsigned pw[4][2];
#pragma unroll
        for (int m = 0; m < 4; ++m) { pw[m][0] = pk2(acc[m][0], acc[m][1]); pw[m][1] = pk2(acc[m][2], acc[m][3]);
            *(u32x2*)(Ss + ci * 4096 + (16 * nt + r) * 64 + 16 * m + 4 * g) = (u32x2){pw[m][0], pw[m][1]}; }
        bf16x8 bfr[2];
#pragma unroll
        for (int s = 0; s < 2; ++s) bfr[s] = __builtin_bit_cast(bf16x8, (u32x4){pw[2 * s][0], pw[2 * s][1], pw[2 * s + 1][0], pw[2 * s + 1][1]});
#pragma unroll
        for (int m = 0; m < 4; ++m) { acc[m] = __builtin_amdgcn_mfma_f32_16x16x32_bf16(af[m][0], bfr[0], cin[m], 0, 0, 0);
            acc[m] = __builtin_amdgcn_mfma_f32_16x16x32_bf16(af[m][1], bfr[1], acc[m], 0, 0, 0); }
    }
}
__device__ __forceinline__ void item_rwkv3(const Frame& F_, int layer, int item) { Frame F = relocal(F_);
    const int b = item >> 8, h = (item >> 6) & 3, c = item & 63; const size_t T0 = (size_t)b * SEQ + c * 64;
    rwkv_prep<3>(F, layer, b, h, c);
#ifdef PROBE_PREP
    rwkv_prep<3>(F, layer, b, h, c);
#endif
    LAS float* Vv = (LAS float*)(F.lds + RW_V); LAS float* Oo = (LAS float*)(F.lds + R3_O);
    LAS float* Gg = (LAS float*)(F.lds + R3_G); LAS float* BON = (LAS float*)(F.lds + R3_BON);
    LAS bf16_t* S0b = (LAS bf16_t*)(F.lds + R3_TILES); LAS bf16_t* W1b = S0b + 4608; LAS bf16_t* Zb = W1b + 4608; LAS bf16_t* VTb = Zb + 4608;
    { const size_t ci = (size_t)(b * 4 + h) * 64 + c; const int row = F.tid >> 3, col = (F.tid & 7) * 8;
      *(LAS u32x4*)(S0b + row * RB_LD + col) = *(const u32x4*)((const bf16_t*)(F.ws + WS_MOE + RW_S) + ci * 4096 + F.tid * 8);
      *(LAS u32x4*)(W1b + row * RB_LD + col) = *(const u32x4*)((const bf16_t*)(F.ws + WS_MOE + RW_W1) + ci * 4096 + F.tid * 8);
      *(LAS u32x4*)(Zb + row * RB_LD + col) = *(const u32x4*)((const bf16_t*)(F.ws + WS_MOE + RW_Z) + ci * 4096 + F.tid * 8);
      const int vv = F.tid & 63, part = F.tid >> 6;
#pragma unroll
      for (int i = 0; i < 8; ++i) { const int t = 8 * part + i; VTb[vv * RB_LD + t] = f2bf(Vv[t * 64 + vv]); } }
    __syncthreads();
    { const int lane = F.lane, mt = F.wave >> 1, nt0 = 2 * (F.wave & 1), r = lane & 15, g4 = lane >> 4;
#pragma unroll
      for (int q = 0; q < 2; ++q) { const int nt = nt0 + q;
          f32x4 o = mma_nt<64>(W1b + 16 * mt * RB_LD, RB_LD, S0b + 16 * nt * RB_LD, RB_LD, (f32x4){0.f, 0.f, 0.f, 0.f}, lane);
          o = mma_nt<64>(Zb + 16 * mt * RB_LD, RB_LD, VTb + 16 * nt * RB_LD, RB_LD, o, lane);
#pragma unroll
          for (int i = 0; i < 4; ++i) Oo[(16 * mt + 4 * g4 + i) * 64 + 16 * nt + r] = o[i]; } }
    __syncthreads();
    { const int j = F.lane, tq = F.wave, ch = h * 64 + j;
      const float lw = F.in[I_RLNW][layer * 256 + ch], lb = F.in[I_RLNB][layer * 256 + ch];
      bf16_t* Y = (bf16_t*)(F.ws + WS_H);
#pragma unroll 2
      for (int i8 = 0; i8 < 8; ++i8) { const int t = tq + 8 * i8;
          const float o = Oo[t * 64 + j]; const float mean = wave_sum(o) * (1.0f / 64.0f); const float d = o - mean; const float var = wave_sum(d * d) * (1.0f / 64.0f);
          float on = d * rsqrtf(var + 64e-5f) * lw + lb; on += BON[t] * Vv[t * 64 + j];
          Y[(T0 + t) * DM + 256 + ch] = f2bf(on * Gg[t * 64 + j]); } }
}

constexpr int DS_SEL = 131072, DS_HIST = 135168, DS_BKT = 151552, DS_BIAS = 152064;
__device__ __forceinline__ unsigned fkey(float f) { const unsigned u = __float_as_uint(f); return (u & 0x80000000u) ? ~u : (u | 0x80000000u); }
__device__ __forceinline__ void item_dsa(const Frame& F_, int layer, int item) { Frame F = relocal(F_);
    const bf16_t* U = (const bf16_t*)(F.ws + WS_U); const bf16_t* KI = (const bf16_t*)(F.ws + WS_KIDX);
    const bf16_t* Kb = (const bf16_t*)(F.ws + WS_K); const bf16_t* Vb = (const bf16_t*)(F.ws + WS_V);
    const int b = item & 3, qg = 511 - (item >> 2); const size_t TB = (size_t)b * SEQ, T0 = TB + qg * 8;
    LAS float* sc = (LAS float*)F.lds; LAS unsigned short* selall = (LAS unsigned short*)(F.lds + DS_SEL); LAS unsigned* histall = (LAS unsigned*)(F.lds + DS_HIST);
    LAS int* bkt = (LAS int*)(F.lds + DS_BKT); LAS float* biasT = (LAS float*)(F.lds + DS_BIAS);
    if (F.tid < 128) { const int n = F.tid; int bk = n; if (n >= 16) { const float lr = logf((float)n / 16.0f) / 2.0794415416798357f; bk = 16 + (int)(lr * 16.0f); bk = bk < 31 ? bk : 31; } bkt[n] = bk; biasT[n] = F.in[I_RELB][n]; }
    const int lane = F.lane, hh = lane >> 5;
    {
        bf16x8 af[2][2]; float wq[2][2][8];
        { const int r = lane & 31, q4 = 2 * ((r >> 2) & 1) + (r >> 4), head = 4 * ((r >> 3) & 1) + (r & 3);
#pragma unroll
          for (int mt = 0; mt < 2; ++mt)
#pragma unroll
              for (int ks = 0; ks < 2; ++ks) af[mt][ks] = *(const bf16x8*)(U + (T0 + 4 * mt + q4) * NINP + UC + 384 + head * 32 + 16 * ks + 8 * hh); }
#pragma unroll
        for (int mt = 0; mt < 2; ++mt)
#pragma unroll
            for (int q2 = 0; q2 < 2; ++q2) { float f[8]; unpack8(*(const u32x4*)(U + (T0 + 4 * mt + 2 * hh + q2) * NINP + UC + 672), f);
#pragma unroll
                for (int hd = 0; hd < 8; ++hd) wq[mt][q2][hd] = f[hd]; }
        const int ntile = (qg * 8 + 8 + 31) >> 5;
        bf16x8 nb0 = af[0][0], nb1 = af[0][0];
        if (F.wave < ntile) { const int key = F.wave * 32 + (lane & 31); nb0 = *(const bf16x8*)(KI + (TB + key) * 32 + 8 * hh); nb1 = *(const bf16x8*)(KI + (TB + key) * 32 + 16 + 8 * hh); }
        for (int kt = F.wave; kt < ntile; kt += 8) {
            const int key = kt * 32 + (lane & 31);
            const bf16x8 b0 = nb0, b1 = nb1;
            if (kt + 8 < ntile) { const int k2 = key + 256; nb0 = *(const bf16x8*)(KI + (TB + k2) * 32 + 8 * hh); nb1 = *(const bf16x8*)(KI + (TB + k2) * 32 + 16 + 8 * hh); }
#pragma unroll
            for (int mt = 0; mt < 2; ++mt) { f32x16 acc;
#pragma unroll
                for (int i = 0; i < 16; ++i) acc[i] = 0.f;
                acc = __builtin_amdgcn_mfma_f32_32x32x16_bf16(af[mt][0], b0, acc, 0, 0, 0);
                acc = __builtin_amdgcn_mfma_f32_32x32x16_bf16(af[mt][1], b1, acc, 0, 0, 0);
#pragma unroll
                for (int q2 = 0; q2 < 2; ++q2) { float s = 0.f;
#pragma unroll
                    for (int hd = 0; hd < 8; ++hd) s += fmaxf(acc[8 * q2 + hd], 0.f) * wq[mt][q2][hd];
                    const int qi = 4 * mt + 2 * hh + q2;
                    sc[qi * 4096 + key] = (key <= qg * 8 + qi) ? s : -INFINITY; } }
        }
    }
    __syncthreads();
    const int qi = F.wave, tq = qg * 8 + qi, n = tq + 1;
    LAS float* scq = sc + qi * 4096; LAS unsigned short* sel = selall + qi * 256; LAS unsigned* hist = histall + qi * 512;
    int nsel;
    if (n <= 256) { nsel = n; for (int j = lane; j < 256; j += 64) sel[j] = (unsigned short)(j < n ? j : 0); }
    else {
        nsel = 256;
        const int R = (n + 63) >> 6; const unsigned long long ltm = (1ull << lane) - 1ull;
        float lo = INFINITY, hi = -INFINITY;
        const int R4 = (n + 255) >> 8;
#pragma unroll 4
        for (int i = 0; i < R4; ++i) { const int j0 = 256 * i + 4 * lane; const f32x4 v4 = *(const LAS f32x4*)(scq + j0);
#pragma unroll
            for (int q = 0; q < 4; ++q) { const bool valid = j0 + q < n; lo = fminf(lo, valid ? v4[q] : INFINITY); hi = fmaxf(hi, valid ? v4[q] : -INFINITY); } }
#pragma unroll
        for (int o = 1; o < 64; o <<= 1) { lo = fminf(lo, shx(lo, o)); hi = fmaxf(hi, shx(hi, o)); }
        bool slow = false;
        if (!(hi > lo)) { for (int j = lane; j < 256; j += 64) sel[j] = (unsigned short)j; }
        else {
            const float scale = 1023.0f / (hi - lo);
            *(LAS u32x4*)(hist + 8 * lane) = (u32x4){0u, 0u, 0u, 0u}; *(LAS u32x4*)(hist + 8 * lane + 4) = (u32x4){0u, 0u, 0u, 0u};
#pragma unroll 2
            for (int i = 0; i < R4; ++i) { const int j0 = 256 * i + 4 * lane; const f32x4 v4 = *(const LAS f32x4*)(scq + j0);
#pragma unroll
                for (int q = 0; q < 4; ++q) { if (j0 + q < n) { int bk = (int)((v4[q] - lo) * scale); bk = bk < 1023 ? bk : 1023;
                    atomicAdd((unsigned*)(hist + (bk >> 1)), (bk & 1) ? 65536u : 1u); } } }
            const u32x4 h0 = *(const LAS u32x4*)(hist + 8 * lane), h1 = *(const LAS u32x4*)(hist + 8 * lane + 4);
            unsigned cb[16];
            cb[0] = h0.x & 0xffffu; cb[1] = h0.x >> 16; cb[2] = h0.y & 0xffffu; cb[3] = h0.y >> 16; cb[4] = h0.z & 0xffffu; cb[5] = h0.z >> 16; cb[6] = h0.w & 0xffffu; cb[7] = h0.w >> 16;
            cb[8] = h1.x & 0xffffu; cb[9] = h1.x >> 16; cb[10] = h1.y & 0xffffu; cb[11] = h1.y >> 16; cb[12] = h1.z & 0xffffu; cb[13] = h1.z >> 16; cb[14] = h1.w & 0xffffu; cb[15] = h1.w >> 16;
            unsigned tot = 0u;
#pragma unroll
            for (int q = 0; q < 16; ++q) tot += cb[q];
            unsigned incl = tot;
#pragma unroll
            for (int o = 1; o < 64; o <<= 1) { const unsigned t = shdown_u(incl, o); if (lane + o < 64) incl += t; }
            int fb = -1; unsigned fabove = 0u, fcnt = 0u; unsigned cum = incl - tot;
#pragma unroll
            for (int q = 15; q >= 0; --q) { if (fb < 0 && cum < 256u && 256u <= cum + cb[q]) { fb = 16 * lane + q; fabove = cum; fcnt = cb[q]; } cum += cb[q]; }
            const unsigned long long mf = __ballot(fb >= 0); const int src = (int)__ffsll((long long)mf) - 1;
            const int B = shidx_i(fb, src); const int above = shidx_i((int)fabove, src), cntB = shidx_i((int)fcnt, src); const int need = 256 - above;
            if (cntB > 256) slow = true;
            else {
                LAS unsigned* cand = hist;
                int base_gt = 0, base_c = 0;
#pragma unroll 2
                for (int i = 0; i < R4; ++i) { const int j0 = 256 * i + 4 * lane; const f32x4 v4 = *(const LAS f32x4*)(scq + j0);
#pragma unroll
                    for (int q = 0; q < 4; ++q) { const int j = j0 + q; const bool valid = j < n; const float v = valid ? v4[q] : lo;
                        int bk = (int)((v - lo) * scale); bk = bk < 1023 ? bk : 1023;
                        const bool gt = valid && bk > B, eq = valid && bk == B;
                        const unsigned long long mg = __ballot(gt), me = __ballot(eq);
                        if (gt) sel[base_gt + __popcll(mg & ltm)] = (unsigned short)j;
                        if (eq) { const int p = base_c + __popcll(me & ltm); cand[2 * p] = fkey(v); cand[2 * p + 1] = (unsigned)j; }
                        base_gt += __popcll(mg); base_c += __popcll(me); } }
                if (need == cntB) { for (int c = lane; c < cntB; c += 64) sel[above + c] = (unsigned short)cand[2 * c + 1]; }
                else {
                    unsigned ck[4], cx[4]; int rk[4];
#pragma unroll
                    for (int q = 0; q < 4; ++q) { const int c = lane + 64 * q; ck[q] = c < cntB ? cand[2 * c] : 0u; cx[q] = c < cntB ? cand[2 * c + 1] : 0u; rk[q] = 0; }
                    for (int c2 = 0; c2 < cntB; ++c2) { const unsigned k2 = cand[2 * c2], x2 = cand[2 * c2 + 1];
#pragma unroll
                        for (int q = 0; q < 4; ++q) rk[q] += (k2 > ck[q] || (k2 == ck[q] && x2 < cx[q])) ? 1 : 0; }
#pragma unroll
                    for (int q = 0; q < 4; ++q) { const int c = lane + 64 * q; if (c < cntB && rk[q] < need) sel[above + rk[q]] = (unsigned short)cand[2 * c + 1]; }
                }
            }
        }
        if (slow) {
        unsigned prefix = 0u; int need = 256; unsigned neq = 0u;
        for (int p = 0; p < 4; ++p) { const int shift = 24 - 8 * p;
            *(LAS u32x4*)(hist + 4 * lane) = (u32x4){0u, 0u, 0u, 0u};
            for (int i = 0; i < R; ++i) { const int j = lane + 64 * i; if (j < n) { const unsigned u = fkey(scq[j]);
                if (p == 0 || (u >> (shift + 8)) == prefix) atomicAdd((unsigned*)(hist + ((u >> shift) & 255u)), 1u); } }
            const u32x4 hv = *(const LAS u32x4*)(hist + 4 * lane);
            const unsigned tot = hv.x + hv.y + hv.z + hv.w;
            unsigned incl = tot;
#pragma unroll
            for (int o = 1; o < 64; o <<= 1) { const unsigned t = shdown_u(incl, o); if (lane + o < 64) incl += t; }
            const unsigned above = incl - tot;
            int fb = -1; unsigned fabove = 0u, feq = 0u; unsigned cum = above;
            { const unsigned hq[4] = {hv.x, hv.y, hv.z, hv.w};
#pragma unroll
              for (int q = 3; q >= 0; --q) { if (fb < 0 && cum < (unsigned)need && (unsigned)need <= cum + hq[q]) { fb = 4 * lane + q; fabove = cum; feq = hq[q]; } cum += hq[q]; } }
            const unsigned long long m = __ballot(fb >= 0);
            const int src = (int)__ffsll((long long)m) - 1;
            const int bin = shidx_i(fb, src); const unsigned ab = (unsigned)shidx_i((int)fabove, src); neq = (unsigned)shidx_i((int)feq, src);
            need -= (int)ab; prefix = (prefix << 8) | (unsigned)bin;
        }
        const int ngt = 256 - need;
        int base_gt = 0, base_eq = 0;
        for (int i = 0; i < R; ++i) { const int j = lane + 64 * i; const unsigned u = (j < n) ? fkey(scq[j]) : 0u;
            const bool gt = (j < n) && (u > prefix), eq = (j < n) && (u == prefix);
            const unsigned long long mg = __ballot(gt), me = __ballot(eq); const unsigned long long lt = (1ull << lane) - 1ull;
            if (gt) sel[base_gt + __popcll(mg & lt)] = (unsigned short)j;
            if (eq) { const int rk = base_eq + __popcll(me & lt); if (rk < need) sel[ngt + rk] = (unsigned short)j; }
            base_gt += __popcll(mg); base_eq += __popcll(me); }
        (void)neq;
            }
    }
    const int nt16 = (nsel + 15) >> 4, r16 = lane & 15, g4 = lane >> 4;
    LAS float* biasj = scq + 2048;
#pragma unroll
    for (int q = 0; q < 4; ++q) { const int j = lane + 64 * q; f32x4 bv = (f32x4){-INFINITY, -INFINITY, -INFINITY, -INFINITY};
        if (j < nsel) { const int dist = tq - (int)sel[j]; const int bk = dist < 128 ? bkt[dist < 0 ? 0 : dist] : 31; bv = *(const LAS f32x4*)(biasT + 4 * bk); }
        *(LAS f32x4*)(biasj + 4 * j) = bv; }
    bf16x8 qf[2];
#pragma unroll
    for (int s = 0; s < 2; ++s) { u32x4 z = (u32x4){0u, 0u, 0u, 0u}; if (r16 < 4) z = *(const u32x4*)(U + (T0 + qi) * NINP + UC + r16 * 64 + 32 * s + 8 * g4); qf[s] = __builtin_bit_cast(bf16x8, z); }
    float lg[16][4]; float mx = -INFINITY;
#define DSA_QK(M0, NM) do { int keyr[NM]; bf16x8 a0[NM], a1[NM]; \
        _Pragma("unroll") for (int m8 = 0; m8 < NM; ++m8) keyr[m8] = sel[16 * ((M0) + m8) + r16]; \
        _Pragma("unroll") for (int m8 = 0; m8 < NM; ++m8) { a0[m8] = *(const bf16x8*)(Kb + (TB + keyr[m8]) * 64 + 8 * g4); a1[m8] = *(const bf16x8*)(Kb + (TB + keyr[m8]) * 64 + 32 + 8 * g4); } \
        _Pragma("unroll") for (int m8 = 0; m8 < NM; ++m8) { const int m = (M0) + m8; \
            f32x4 acc = (f32x4){0.f, 0.f, 0.f, 0.f}; \
            acc = __builtin_amdgcn_mfma_f32_16x16x32_bf16(a0[m8], qf[0], acc, 0, 0, 0); \
            acc = __builtin_amdgcn_mfma_f32_16x16x32_bf16(a1[m8], qf[1], acc, 0, 0, 0); \
            _Pragma("unroll") for (int i = 0; i < 4; ++i) { const float v = acc[i] * 0.125f + biasj[(16 * m + 4 * g4 + i) * 4 + (r16 & 3)]; lg[m][i] = v; mx = fmaxf(mx, v); } } } while (0)
    if (nt16 > 8) { DSA_QK(0, 16); }
    else { DSA_QK(0, 8);
#pragma unroll
        for (int m8 = 8; m8 < 16; ++m8)
#pragma unroll
            for (int i = 0; i < 4; ++i) lg[m8][i] = -INFINITY; }
#undef DSA_QK
    mx = fmaxf(mx, shx(mx, 16)); mx = fmaxf(mx, shx(mx, 32));
    float sm = 0.f;
#pragma unroll
    for (int m = 0; m < 16; ++m)
#pragma unroll
        for (int i = 0; i < 4; ++i) { const float p = __expf(lg[m][i] - mx); lg[m][i] = p; sm += p; }
    sm += shx(sm, 16); sm += shx(sm, 32);
    f32x4 ov[4];
#pragma unroll
    for (int nt = 0; nt < 4; ++nt) ov[nt] = (f32x4){0.f, 0.f, 0.f, 0.f};
    const unsigned vs_base = (unsigned)(unsigned long)scq;
#pragma unroll
    for (int half = 0; half < 2; ++half) {
        if (half * 8 < nt16) {
            asm volatile("s_waitcnt lgkmcnt(0)" ::: "memory");
            int vkey[16];
#pragma unroll
            for (int q = 0; q < 16; ++q) { const int rho = 8 * q + (lane >> 3);
                vkey[q] = sel[half * 128 + (rho & ~31) + 16 * ((rho >> 2) & 1) + 4 * ((rho >> 3) & 3) + (rho & 3)]; }
            asm volatile("s_waitcnt lgkmcnt(0)" : "+v"(vkey[0]), "+v"(vkey[1]), "+v"(vkey[2]), "+v"(vkey[3]), "+v"(vkey[4]), "+v"(vkey[5]), "+v"(vkey[6]), "+v"(vkey[7]),
                         "+v"(vkey[8]), "+v"(vkey[9]), "+v"(vkey[10]), "+v"(vkey[11]), "+v"(vkey[12]), "+v"(vkey[13]), "+v"(vkey[14]), "+v"(vkey[15]) :: "memory");
#pragma unroll
            for (int q = 0; q < 16; ++q)
                __builtin_amdgcn_global_load_lds((const unsigned*)(Vb + (TB + vkey[q]) * 64 + 8 * (lane & 7)), (LAS unsigned*)((LAS unsigned char*)scq + q * 1024), 16, 0, 0);
            asm volatile("s_waitcnt vmcnt(0)" ::: "memory");
#pragma unroll
            for (int s4 = 0; s4 < 4; ++s4) { const int s = half * 4 + s4;
                u32x4 pw; pw.x = pk2(lg[2 * s][0], lg[2 * s][1]); pw.y = pk2(lg[2 * s][2], lg[2 * s][3]); pw.z = pk2(lg[2 * s + 1][0], lg[2 * s + 1][1]); pw.w = pk2(lg[2 * s + 1][2], lg[2 * s + 1][3]);
                const bf16x8 pa = __builtin_bit_cast(bf16x8, pw);
                const unsigned ad = vs_base + (unsigned)((32 * s4 + 8 * g4 + (r16 >> 2)) * 128 + (r16 & 3) * 8);
                u32x2 t0[4], t1[4];
                asm volatile("ds_read_b64_tr_b16 %0, %8\n\tds_read_b64_tr_b16 %1, %8 offset:512\n\tds_read_b64_tr_b16 %2, %8 offset:32\n\tds_read_b64_tr_b16 %3, %8 offset:544\n\t"
                             "ds_read_b64_tr_b16 %4, %8 offset:64\n\tds_read_b64_tr_b16 %5, %8 offset:576\n\tds_read_b64_tr_b16 %6, %8 offset:96\n\tds_read_b64_tr_b16 %7, %8 offset:608\n\ts_waitcnt lgkmcnt(0)"
                             : "=&v"(t0[0]), "=&v"(t1[0]), "=&v"(t0[1]), "=&v"(t1[1]), "=&v"(t0[2]), "=&v"(t1[2]), "=&v"(t0[3]), "=&v"(t1[3]) : "v"(ad) : "memory");
#pragma unroll
                for (int nt = 0; nt < 4; ++nt) { const bf16x8 vb = __builtin_bit_cast(bf16x8, (u32x4){t0[nt].x, t0[nt].y, t1[nt].x, t1[nt].y});
                    ov[nt] = __builtin_amdgcn_mfma_f32_16x16x32_bf16(pa, vb, ov[nt], 0, 0, 0); } }
        }
    }
    { float inv[4];
#pragma unroll
      for (int h = 0; h < 4; ++h) inv[h] = 1.0f / __int_as_float(__builtin_amdgcn_readlane(__float_as_int(sm), h));
      if (lane < 16) { bf16_t* Y = (bf16_t*)(F.ws + WS_H) + (T0 + qi) * DM + 512 + r16;
#pragma unroll
          for (int h = 0; h < 4; ++h)
#pragma unroll
              for (int nt = 0; nt < 4; ++nt) Y[h * 64 + 16 * nt] = f2bf(ov[nt][h] * inv[h]); } }
}

__device__ __forceinline__ void phase_router(const Frame& F_, int layer) { Frame F = relocal(F_); const int cset = layer;
    const float* X = (const float*)(F.ws + WS_X);
    const bf16_t* WH = (const bf16_t*)(F.ws + WS_WRT) + (size_t)layer * 2 * 49152; const bf16_t* WL = WH + 49152;
    LAS float* part = (LAS float*)F.lds;
    LAS float* ssq = (LAS float*)(F.lds + 24576);
    LAS int* es = (LAS int*)(F.lds + 25088);
    LAS int* lr = (LAS int*)(F.lds + 25600);
    LAS float* wsl = (LAS float*)(F.lds + 26112);
    LAS float* rsd = (LAS float*)(F.lds + 26624);
    for (int blk = F.bid; blk < NTOK / 64; blk += F.G) {
        __syncthreads();
        const int mt = F.wave & 3, kh = F.wave >> 2, r16 = F.lane & 15, g4 = F.lane >> 4;
        const float* xr = X + ((size_t)blk * 64 + mt * 16 + r16) * DM + kh * 512 + 8 * g4;
        f32x4 acc[3]; acc[0] = acc[1] = acc[2] = (f32x4){0.f, 0.f, 0.f, 0.f}; float ss = 0.f;
#pragma unroll 4
        for (int ks = 0; ks < 16; ++ks) {
            const f32x4 xa = *(const f32x4*)(xr + ks * 32), xb = *(const f32x4*)(xr + ks * 32 + 4);
            ss += xa[0] * xa[0] + xa[1] * xa[1] + xa[2] * xa[2] + xa[3] * xa[3] + xb[0] * xb[0] + xb[1] * xb[1] + xb[2] * xb[2] + xb[3] * xb[3];
            float xv[8] = {xa[0], xa[1], xa[2], xa[3], xb[0], xb[1], xb[2], xb[3]}; unsigned hw[4], lw[4];
#pragma unroll
            for (int j = 0; j < 4; ++j) { const bf16_t h0 = f2bf(xv[2 * j]), h1 = f2bf(xv[2 * j + 1]); hw[j] = (unsigned)h0 | ((unsigned)h1 << 16);
                lw[j] = pk2(xv[2 * j] - bf2f(h0), xv[2 * j + 1] - bf2f(h1)); }
            const bf16x8 ahi = __builtin_bit_cast(bf16x8, (u32x4){hw[0], hw[1], hw[2], hw[3]}), alo = __builtin_bit_cast(bf16x8, (u32x4){lw[0], lw[1], lw[2], lw[3]});
#pragma unroll
            for (int nt = 0; nt < 3; ++nt) { const size_t wo = (size_t)(nt * 16 + r16) * 1024 + kh * 512 + ks * 32 + 8 * g4;
                const bf16x8 bh = *(const bf16x8*)(WH + wo), bl = *(const bf16x8*)(WL + wo);
                acc[nt] = __builtin_amdgcn_mfma_f32_16x16x32_bf16(ahi, bh, acc[nt], 0, 0, 0);
                acc[nt] = __builtin_amdgcn_mfma_f32_16x16x32_bf16(ahi, bl, acc[nt], 0, 0, 0);
                acc[nt] = __builtin_amdgcn_mfma_f32_16x16x32_bf16(alo, bh, acc[nt], 0, 0, 0); }
        }
        ss += shx(ss, 16); ss += shx(ss, 32);
        if (g4 == 0) ssq[kh * 64 + mt * 16 + r16] = ss;
#pragma unroll
        for (int nt = 0; nt < 3; ++nt)
#pragma unroll
            for (int i = 0; i < 4; ++i) part[(kh * 64 + mt * 16 + 4 * g4 + i) * 48 + nt * 16 + r16] = acc[nt][i];
        __syncthreads();
        if (F.tid < 64) { const float rstd = rsqrtf((ssq[F.tid] + ssq[64 + F.tid]) * (1.0f / DM) + 1e-6f); rsd[F.tid] = rstd;
            float l[36];
#pragma unroll
            for (int o = 0; o < 36; ++o) l[o] = (part[F.tid * 48 + o] + part[(64 + F.tid) * 48 + o]) * rstd + (o < 32 ? F.in[I_BRE][layer * 32 + o] : F.in[I_BRG][layer * 4 + o - 32]);
            int gs = 0; float gm = l[32];
#pragma unroll
            for (int j = 1; j < 4; ++j) if (l[32 + j] > gm) { gm = l[32 + j]; gs = j; }
            float den = 0.f;
#pragma unroll
            for (int j = 0; j < 4; ++j) den += __expf(l[32 + j] - gm);
            const float gate = 1.0f / den;
            float e8[8];
#pragma unroll
            for (int j = 0; j < 8; ++j) e8[j] = gs == 0 ? l[j] : gs == 1 ? l[8 + j] : gs == 2 ? l[16 + j] : l[24 + j];
            int i1 = 0; float v1 = e8[0];
#pragma unroll
            for (int j = 1; j < 8; ++j) if (e8[j] > v1) { v1 = e8[j]; i1 = j; }
            int i2 = -1; float v2 = -INFINITY;
#pragma unroll
            for (int j = 0; j < 8; ++j) if (j != i1 && e8[j] > v2) { v2 = e8[j]; i2 = j; }
            const float e2 = __expf(v2 - v1); const float p1 = 1.0f / (1.0f + e2);
            es[F.tid * 2] = gs * 8 + i1; es[F.tid * 2 + 1] = gs * 8 + i2; wsl[F.tid * 2] = p1 * gate; wsl[F.tid * 2 + 1] = (1.0f - p1) * gate; }
        __syncthreads();
        if (F.tid < 32) { int cnt = 0; for (int i = 0; i < 128; ++i) if (es[i] == F.tid) lr[i] = cnt++;
            if (cnt) { const int base = (int)__hip_atomic_fetch_add(F.ctl + CW_CNT + cset * 32 + F.tid, (unsigned)cnt, __ATOMIC_RELAXED, __HIP_MEMORY_SCOPE_AGENT);
                for (int i = 0; i < 128; ++i) if (es[i] == F.tid) lr[i] += base; } }
        __syncthreads();
        if (F.tid < 64) { int* rt = (int*)(F.ws + WS_ROUTE) + ((size_t)blk * 64 + F.tid) * 8;
            rt[0] = es[F.tid * 2]; rt[1] = es[F.tid * 2 + 1]; ((float*)rt)[2] = wsl[F.tid * 2]; ((float*)rt)[3] = wsl[F.tid * 2 + 1]; rt[4] = lr[F.tid * 2]; rt[5] = lr[F.tid * 2 + 1]; ((float*)rt)[6] = rsd[F.tid]; }
    }
    __syncthreads();
    if (F.tid == 0) __hip_atomic_fetch_add(F.ctl + CW_RB + 64 * layer, 1u, __ATOMIC_RELAXED, __HIP_MEMORY_SCOPE_AGENT);
}
__device__ __forceinline__ void phase_moe_convert(const Frame& F_, int layer) { Frame F = relocal(F_);
    bf16_t* WGU = (bf16_t*)(F.ws + WS_MOE + MOE_WGU); bf16_t* WD = (bf16_t*)(F.ws + WS_MOE + MOE_WD);
    for (int t = F.bid; t < 1536; t += F.G) {
        if (t < 1024) { const int e = t >> 5, r = t & 31, kt = r >> 1, nt = r & 1; const size_t eo = ((size_t)layer * 32 + e) * 1024 * 256;
            tr_tile(F, 256, WGU + (size_t)e * 512 * 1024, 1024, kt * 64, nt * 256, SmGU{F.in[I_WGATE] + eo, F.in[I_WUP] + eo}); }
        else { const int q = t - 1024, e = q >> 4, r = q & 15, kt = r >> 2, nt = r & 3;
            tr_tile(F, 1024, WD + (size_t)e * 1024 * 256, 256, kt * 64, nt * 256, SmId{F.in[I_WDOWN] + ((size_t)layer * 32 + e) * 256 * 1024}); }
    }
}
__device__ __forceinline__ void phase_gather(const Frame& F_, int layer) { Frame F = relocal(F_);
    LAS int* off = (LAS int*)F.lds;
    __syncthreads();
    if (F.tid == 0) { unsigned sp = 0;
        while (__hip_atomic_load(F.ctl + CW_RB + 64 * layer, __ATOMIC_RELAXED, __HIP_MEMORY_SCOPE_AGENT) < (unsigned)F.G) { __builtin_amdgcn_s_sleep(2); if (++sp > (1u << 22)) break; } }
    __syncthreads();
    if (F.tid == 0) { int acc = 0; for (int e = 0; e < 32; ++e) { off[e] = acc; const int c = (int)__hip_atomic_load(F.ctl + CW_CNT + layer * 32 + e, __ATOMIC_RELAXED, __HIP_MEMORY_SCOPE_AGENT); acc += (c + 255) & ~255; } off[32] = acc; }
    __syncthreads();
    int* tiles = (int*)(F.ws + WS_TILES); int* row_tok = (int*)(F.ws + WS_ROWS); float* row_w = (float*)(F.ws + WS_ROWS) + MAXROWS;
    if (F.bid == 0) { if (F.tid == 0) tiles[0] = off[32] >> 8; if (F.tid < 33) tiles[1 + F.tid] = off[F.tid];
        if (F.tid < 32) for (int rt = off[F.tid] >> 8; rt < (off[F.tid + 1] >> 8); ++rt) tiles[64 + rt] = F.tid; }
    for (int e = F.bid; e < 32; e += F.G) { const int c = (int)__hip_atomic_load(F.ctl + CW_CNT + layer * 32 + e, __ATOMIC_RELAXED, __HIP_MEMORY_SCOPE_AGENT);
        for (int r = off[e] + c + F.tid; r < off[e + 1]; r += NTHR) { row_tok[r] = -1; row_w[r] = 0.f; } }
    const float* X = (const float*)(F.ws + WS_X); bf16_t* HP = (bf16_t*)(F.ws + WS_U); const float* nw = F.in[I_NORM2] + (size_t)layer * DM;
    f32x4 nwv[4];
#pragma unroll
    for (int j = 0; j < 4; ++j) nwv[j] = *(const f32x4*)(nw + 4 * F.lane + 256 * j);
    for (int blk = F.bid; blk < NTOK / 64; blk += F.G)
    for (int i8 = 0; i8 < 8; ++i8) { const int t = blk * 64 + F.wave * 8 + i8;
        const int* rt = (const int*)(F.ws + WS_ROUTE) + (size_t)t * 8; const float rstd = ((const float*)rt)[6];
        const int p0 = off[rt[0]] + rt[4], p1 = off[rt[1]] + rt[5];
#pragma unroll
        for (int j = 0; j < 4; ++j) { const int c = 4 * F.lane + 256 * j; const f32x4 v = *(const f32x4*)(X + (size_t)t * DM + c) * rstd * nwv[j];
            u32x2 o; o.x = pk2(v[0], v[1]); o.y = pk2(v[2], v[3]);
            *(u32x2*)(HP + (size_t)p0 * DM + c) = o; *(u32x2*)(HP + (size_t)p1 * DM + c) = o; }
        if (F.lane == 0) { row_tok[p0] = t * 2; row_w[p0] = ((const float*)rt)[2]; row_tok[p1] = t * 2 + 1; row_w[p1] = ((const float*)rt)[3]; }
    }
}

constexpr int NPH_LAYER = 9, NPHASE = 1 + 2 * NPH_LAYER + 1;
#ifndef MK_ONLY
#define MK_ONLY -1
#endif
#ifndef MK_ITEM
#define MK_ITEM -1
#endif
#define EN(o) (MK_ONLY < 0 || MK_ONLY == (o))
#define IT(o) (MK_ITEM < 0 || MK_ITEM == (o))
__global__ void __launch_bounds__(NTHR, 2) mk_forward(Params P) {
    extern __shared__ __attribute__((aligned(16))) unsigned char lds_raw[];
    Frame F; F.lds = (LAS unsigned char*)lds_raw; F.tid = threadIdx.x; F.lane = F.tid & 63; F.wave = __builtin_amdgcn_readfirstlane(F.tid >> 6); F.bid = blockIdx.x; F.G = gridDim.x;
    F.in = (in_tab_t)__builtin_amdgcn_kernarg_segment_ptr(); F.out = P.out; F.ws = P.ws; F.ctl = (unsigned*)(P.ws + WS_CTL); F.misc = (volatile LAS int*)(F.lds + MISC_OFF);
    if (F.tid < 64) ((LAS unsigned*)(F.lds + MISC_OFF))[F.tid] = 0u;
    __syncthreads();
    const int lo = P.ph_lo, hi = P.ph_hi;
    XcdBarrier bar; bar.bar = F.ctl + CW_BAR; bar.x = 0; bar.st = (volatile LAS unsigned*)(F.lds + MISC_OFF + 16);
    if (hi - lo > 1) bar = xcd_barrier_post(F.ctl + CW_BAR, (volatile LAS unsigned*)(F.lds + MISC_OFF + 16));
#define IN(k) (lo <= (k) && (k) < hi)
#define SEAM(k) do { if (IN(k) && IN((k) + 1)) xcd_barrier(bar); } while (0)
#define QLOOP(qi, n, body) for (;;) { const int it = q_pop(F, layer * 12 + (qi)); if (it >= (n)) break; body; }
    if (EN(100) && IN(0)) { phase_prologue(F); phase_norm(F, F.in[I_X], false, F.in[I_NORM1], 0); } SEAM(0);
#pragma unroll
    for (int layer = 0; layer < DEPTH; ++layer) {
        const int pb = 1 + layer * NPH_LAYER;
        if (layer > 0) { if (EN(0) && IN(pb + 0)) { phase_norm(F, (const float*)(F.ws + WS_X), true, F.in[I_NORM1] + (size_t)layer * DM, 0); } SEAM(pb + 0); }
        if (EN(1) && IN(pb + 1)) { const Frame F_ = F; Frame F = relocal(F_); pg8::StaticOrder S; S.init((const bf16_t*)(F.ws + WS_H), (const bf16_t*)(F.ws + WS_WIN) + (size_t)layer * NINP * DM, NTOK, NINP, DM, F.G, F.bid);
            pg8::EpiBf16 E{(bf16_t*)(F.ws + WS_U), NINP}; pg8::gemm_phase(F.lds, DM, S, E); } SEAM(pb + 1);
        if (EN(2) && IN(pb + 2)) {
            if (IT(0)) QLOOP(0, 256, item_s5<1>(F, layer, it));
            if (IT(1)) QLOOP(1, 1024, item_rwkv1(F, layer, it));
            if (IT(2)) QLOOP(2, 256, item_mamba<1>(F, layer, it));
            if (IT(3)) QLOOP(3, 256, item_kv(F, layer, it));
        } SEAM(pb + 2);
        if (EN(3) && IN(pb + 3)) {
            if (IT(0)) QLOOP(4, 8, item_rwkv_carry(F, it));
            if (IT(1)) QLOOP(5, 16, item_mamba_carry(F, it));
            if (IT(2)) QLOOP(6, 4, item_s5_carry(F, layer, it));
            if (IT(3)) QLOOP(7, 2048, item_dsa(F, layer, it));
        } SEAM(pb + 3);
        if (EN(4) && IN(pb + 4)) {
            if (IT(0)) QLOOP(8, 256, item_s5<2>(F, layer, it));
            if (IT(1)) QLOOP(9, 1024, item_rwkv3(F, layer, it));
            if (IT(2)) QLOOP(10, 256, item_mamba<2>(F, layer, it));
        } SEAM(pb + 4);
        if (EN(6) && IN(pb + 5)) { const Frame F_ = F; Frame F = relocal(F_); pg8::StaticOrder S; S.init((const bf16_t*)(F.ws + WS_H), (const bf16_t*)(F.ws + WS_WOUT) + (size_t)layer * DM * DM, NTOK, DM, DM, F.G, F.bid);
            pg8::EpiResid E{(float*)(F.ws + WS_X), DM}; pg8::gemm_phase(F.lds, DM, S, E); } SEAM(pb + 5);
        if (EN(7) && IN(pb + 6)) { phase_router(F, layer); phase_moe_convert(F, layer); phase_gather(F, layer); } SEAM(pb + 6);
        if (EN(8) && IN(pb + 7)) { const Frame F_ = F; Frame F = relocal(F_); pg8::MoeOrder S{2, F.G, F.bid, DM, (const char*)(F.ws + WS_U), (const char*)(F.ws + WS_MOE + MOE_WGU), (size_t)512 * 1024 * 2, (const int*)(F.ws + WS_TILES)};
            pg8::EpiGated<1> E{(bf16_t*)(F.ws + WS_H), 256, 0, nullptr, nullptr}; pg8::gemm_phase(F.lds, DM, S, E); } SEAM(pb + 7);
        if (EN(9) && IN(pb + 8)) { const Frame F_ = F; Frame F = relocal(F_); pg8::MoeOrder S{4, F.G, F.bid, 256, (const char*)(F.ws + WS_H), (const char*)(F.ws + WS_MOE + MOE_WD), (size_t)1024 * 256 * 2, (const int*)(F.ws + WS_TILES)};
            pg8::EpiMoeOut E{(bf16_t*)(F.ws + WS_U), (const int*)(F.ws + WS_ROWS), (const float*)(F.ws + WS_ROWS) + MAXROWS}; pg8::gemm_phase(F.lds, 256, S, E); } SEAM(pb + 8);
    }
    if (EN(101) && IN(NPHASE - 1)) { phase_norm(F, (const float*)(F.ws + WS_X), true, F.in[I_FNORM], 2); }
#undef IN
#undef SEAM
}

#ifndef MK_SPLIT
#define MK_SPLIT 0
#endif
extern "C" void kernel_launch(void* const* d_in, const int* in_sizes, int n_in, void* d_out, int out_size, void* d_ws, size_t ws_size, hipStream_t stream) {
    static int grid = 0;
    if (grid == 0) {
        if (n_in != 44 || out_size != NTOK * DM || ws_size < WS_END) { fprintf(stderr, "kernel_launch: unexpected shapes (n_in %d out %d ws %zu need %zu)\n", n_in, out_size, ws_size, (size_t)WS_END); grid = -1; return; }
        int dev = 0, cus = 0;
        if (hipGetDevice(&dev) != hipSuccess || hipDeviceGetAttribute(&cus, hipDeviceAttributeMultiprocessorCount, dev) != hipSuccess) { grid = -1; return; }
        if (hipFuncSetAttribute((const void*)mk_forward, hipFuncAttributeMaxDynamicSharedMemorySize, LDS_BYTES) != hipSuccess) { fprintf(stderr, "kernel_launch: hipFuncSetAttribute failed\n"); grid = -1; return; }
        int per_cu = 0;
        if (hipOccupancyMaxActiveBlocksPerMultiprocessor(&per_cu, (const void*)mk_forward, NTHR, LDS_BYTES) != hipSuccess || per_cu < 1) { fprintf(stderr, "kernel_launch: occupancy query says %d\n", per_cu); }
        (void)hipGetLastError();
        grid = cus;
    }
    if (grid < 0) return;
    hipMemsetAsync((char*)d_ws + WS_CTL, 0, CTL_BYTES, stream);
    Params p{};
    for (int i = 0; i < 44; ++i) p.in[i] = (const float*)d_in[i];
    p.out = (float*)d_out; p.ws = (unsigned char*)d_ws;
#if MK_SPLIT
    for (int ph = 0; ph < NPHASE; ++ph) { p.ph_lo = ph; p.ph_hi = ph + 1; hipLaunchKernelGGL(mk_forward, dim3(grid), dim3(NTHR), LDS_BYTES, stream, p); }
#else
    p.ph_lo = 0; p.ph_hi = NPHASE; hipLaunchKernelGGL(mk_forward, dim3(grid), dim3(NTHR), LDS_BYTES, stream, p);
#endif
}
```

```cpp
#include <hip/hip_runtime.h>
#include <stdint.h>
#include <stdio.h>

#define LAS __attribute__((address_space(3)))
typedef unsigned short bf16_t;
typedef short bf16x8 __attribute__((ext_vector_type(8)));
typedef float f32x4 __attribute__((ext_vector_type(4)));
typedef float f32x2 __attribute__((ext_vector_type(2)));
typedef float f32x16 __attribute__((ext_vector_type(16)));
typedef unsigned u32x4 __attribute__((ext_vector_type(4)));
typedef unsigned u32x2 __attribute__((ext_vector_type(2)));

constexpr int NTOK = 16384, DM = 1024, SEQ = 4096, NBATCH = 4, DEPTH = 2;
constexpr int NIN = 2604, NINP = 2816;
constexpr int UM = 0;
constexpr int UR = 784;
constexpr int UC = 1680;
constexpr int US = 2368;
constexpr int NTHR = 512;
constexpr int LDS_BYTES = 163840;
constexpr int MISC_OFF = LDS_BYTES - 256;

constexpr size_t WS_CTL   = 0;
constexpr size_t CTL_BYTES = 65536;
constexpr size_t WS_X     = WS_CTL + CTL_BYTES;
constexpr size_t WS_H     = WS_X + (size_t)NTOK * DM * 4;
constexpr size_t WS_U     = WS_H + (size_t)NTOK * DM * 2;
constexpr size_t WS_WIN   = WS_U + (size_t)NTOK * NINP * 2;
constexpr size_t WS_WOUT  = WS_WIN + (size_t)2 * NINP * DM * 2;
constexpr size_t WS_GLU   = WS_WOUT + (size_t)2 * DM * DM * 2;
constexpr size_t WS_MOE   = WS_GLU + (size_t)2 * 512 * 256 * 2;
constexpr size_t MOE_WGU  = 0;
constexpr size_t MOE_WD   = (size_t)32 * 512 * 1024 * 2;
constexpr size_t MOE_BYTES = MOE_WD + (size_t)32 * 1024 * 256 * 2;
constexpr size_t RW_PT    = 0;
constexpr size_t RW_U     = (size_t)1024 * 4096 * 2;
constexpr size_t RW_S     = RW_U + (size_t)1024 * 4096 * 2;
constexpr size_t RW_W1    = RW_S + (size_t)1024 * 4096 * 2;
constexpr size_t RW_Z     = RW_W1 + (size_t)1024 * 4096 * 2;
constexpr size_t YSG_OFF  = RW_Z + (size_t)1024 * 4096 * 2;
static_assert(YSG_OFF + (size_t)NTOK * 256 * 2 <= MOE_BYTES, "alias");
constexpr size_t WS_MST   = WS_MOE + MOE_BYTES;
constexpr size_t WS_MDEC  = WS_MST + (size_t)4 * 64 * 4 * 4096 * 4;
constexpr size_t WS_S5ST  = WS_MDEC + 4096;
constexpr size_t WS_K     = WS_S5ST + (size_t)4 * 64 * 2048 * 4;
constexpr size_t WS_V     = WS_K + (size_t)NTOK * 64 * 2;
constexpr size_t WS_KIDX  = WS_V + (size_t)NTOK * 64 * 2;
constexpr size_t WS_ROUTE = WS_KIDX + (size_t)NTOK * 32 * 2;
constexpr size_t WS_ROWS  = WS_ROUTE + (size_t)NTOK * 32;
constexpr int    MAXROWS  = 49152;
constexpr size_t WS_TILES = WS_ROWS + (size_t)MAXROWS * 8;
constexpr size_t WS_S5TAB = WS_TILES + 4096;
constexpr size_t S5TAB_F  = (size_t)(2048 + 2048 + 32768) * 4;
constexpr size_t S5TAB_L  = S5TAB_F + (size_t)16 * 16 * 128 * 2;
constexpr size_t WS_WRT   = WS_S5TAB + 2 * S5TAB_L;
constexpr size_t WS_BON   = WS_WRT + (size_t)2 * 2 * 48 * 1024 * 2;
constexpr size_t WS_END   = WS_BON + (size_t)1024 * 64 * 4;

constexpr int CW_BAR = 0;
constexpr int CW_Q   = 4096;
constexpr int CW_CNT = 8192;
constexpr int CW_RB  = 8448;

__device__ __forceinline__ float bf2f(bf16_t b) { return __uint_as_float(((unsigned)b) << 16); }
__device__ __forceinline__ bf16_t f2bf(float f) { const __bf16 h = (__bf16)f; return __builtin_bit_cast(bf16_t, h); }
__device__ __forceinline__ unsigned pk2(float lo, float hi) { typedef __bf16 bf2_t __attribute__((ext_vector_type(2))); const bf2_t h = __builtin_convertvector((f32x2){lo, hi}, bf2_t); return __builtin_bit_cast(unsigned, h); }
__device__ __forceinline__ unsigned cvt_pk_bf16(float lo, float hi) { unsigned r; asm volatile("v_cvt_pk_bf16_f32 %0, %1, %2" : "=v"(r) : "v"(lo), "v"(hi)); return r; }
__device__ __forceinline__ float sigmoidf_(float x) { return 1.0f / (1.0f + __expf(-x)); }
__device__ __forceinline__ float siluf_(float x) { return x / (1.0f + __expf(-x)); }
__device__ __forceinline__ float tanhf_(float x) { const float e = __expf(2.0f * x); return 1.0f - 2.0f / (e + 1.0f); }
__device__ __forceinline__ float softplusf_(float x) { return fmaxf(x, 0.0f) + log1pf(__expf(-fabsf(x))); }
__device__ __forceinline__ float gelu_tanh(float x) { return 0.5f * x * (1.0f + tanhf_(0.7978845608028654f * (x + 0.044715f * x * x * x))); }
template <int CTRL> __device__ __forceinline__ float dppf(float x) { return __int_as_float(__builtin_amdgcn_update_dpp(0, __float_as_int(x), CTRL, 0xF, 0xF, true)); }
__device__ __forceinline__ float sum4(float x) { x += dppf<0xB1>(x); x += dppf<0x4E>(x); return x; }
__device__ __forceinline__ float sum8(float x) { x = sum4(x); x += dppf<0x141>(x); return x; }
__device__ __forceinline__ float sum16(float x) { x = sum8(x); x += dppf<0x140>(x); return x; }
__device__ __forceinline__ int lane_id_() { int l = (int)__builtin_amdgcn_mbcnt_hi(~0u, __builtin_amdgcn_mbcnt_lo(~0u, 0u)); asm volatile("" : "+v"(l)); return l; }
__device__ __forceinline__ float shx(float x, int o) { return __int_as_float(__builtin_amdgcn_ds_bpermute((lane_id_() ^ o) << 2, __float_as_int(x))); }
__device__ __forceinline__ unsigned shdown_u(unsigned x, int o) { return (unsigned)__builtin_amdgcn_ds_bpermute(((lane_id_() + o) & 63) << 2, (int)x); }
__device__ __forceinline__ int shidx_i(int x, int src) { return __builtin_amdgcn_ds_bpermute(src << 2, x); }
__device__ __forceinline__ float wave_sum(float x) { x = sum16(x); x += shx(x, 16); x += shx(x, 32); return x; }
__device__ __forceinline__ void unpack8(const u32x4 v, float (&f)[8]) {
    f[0] = __uint_as_float(v.x << 16); f[1] = __uint_as_float(v.x & 0xffff0000u); f[2] = __uint_as_float(v.y << 16); f[3] = __uint_as_float(v.y & 0xffff0000u);
    f[4] = __uint_as_float(v.z << 16); f[5] = __uint_as_float(v.z & 0xffff0000u); f[6] = __uint_as_float(v.w << 16); f[7] = __uint_as_float(v.w & 0xffff0000u);
}

#define XB_TMO      128
#define XB_XCNT(j)  (256  + 64 * (j))
#define XB_XSUB(j)  (1280 + 64 * (j))
#define XB_XGEN(j)  (2304 + 64 * (j))
#define XB_TOP      3328
#define XB_TOPGEN   3392
#define XCD_BAR_WORDS 3456
#define XB_SPIN_CAP (1u << 22)
__device__ __forceinline__ unsigned xb_ld(unsigned* p)              { return __hip_atomic_load(p, __ATOMIC_RELAXED, __HIP_MEMORY_SCOPE_AGENT); }
__device__ __forceinline__ unsigned xb_add(unsigned* p, unsigned v) { return __hip_atomic_fetch_add(p, v, __ATOMIC_RELAXED, __HIP_MEMORY_SCOPE_AGENT); }
__device__ __forceinline__ unsigned xb_xcc_id() { return (unsigned)__builtin_amdgcn_s_getreg((3 << 11) | 20) & 0xFu; }
#define XB_SPIN(cond, bar) do { unsigned _sp = 0; while (cond) { __builtin_amdgcn_s_sleep(1); \
    if ((++_sp & 255u) == 0u) { if (xb_ld(&(bar)[XB_TMO])) break; if (_sp > XB_SPIN_CAP) { atomicAdd(&(bar)[XB_TMO], 1u); break; } } } } while (0)
struct XcdBarrier { unsigned* bar; unsigned x; volatile LAS unsigned* st; };
__device__ __forceinline__ XcdBarrier xcd_barrier_post(unsigned* bar, volatile LAS unsigned* st) {
    XcdBarrier b; b.bar = bar; b.x = xb_xcc_id(); b.st = st;
    if (threadIdx.x == 0) (void)xb_add(&bar[XB_XCNT(b.x)], 1u);
    return b;
}
__device__ __forceinline__ void xcd_barrier_complete(unsigned* bar, unsigned x, unsigned& nloc, unsigned& nx) {
    const unsigned G = gridDim.x * gridDim.y * gridDim.z;
    unsigned sum, cnt, mine, sp = 0u;
    for (;;) {
        sum = 0u; cnt = 0u; mine = 0u;
#pragma unroll
        for (unsigned j = 0; j < 16; ++j) { const unsigned c = xb_ld(&bar[XB_XCNT(j)]); sum += c; cnt += (c > 0u) ? 1u : 0u; mine = (j == x) ? c : mine; }
        if (sum == G) break;
        __builtin_amdgcn_s_sleep(1);
        if ((++sp & 255u) == 0u) { if (xb_ld(&bar[XB_TMO])) break; if (sp > XB_SPIN_CAP) { atomicAdd(&bar[XB_TMO], 1u); break; } }
    }
    nloc = mine > 0u ? mine : 1u; nx = cnt > 0u ? cnt : 1u;
}
__device__ __forceinline__ void xcd_barrier(const XcdBarrier& b_) {
    XcdBarrier b = b_; { const unsigned long long v = (unsigned long long)b.bar; unsigned lo = __builtin_amdgcn_readfirstlane((unsigned)v), hi = __builtin_amdgcn_readfirstlane((unsigned)(v >> 32)); asm volatile("" : "+s"(lo), "+s"(hi)); b.bar = (unsigned*)(((unsigned long long)hi << 32) | lo); unsigned xx = __builtin_amdgcn_readfirstlane(b.x); asm volatile("" : "+s"(xx)); b.x = xx; }
    asm volatile("s_waitcnt vmcnt(0)" ::: "memory");
    __syncthreads();
    if (threadIdx.x == 0) {
        unsigned* bar = b.bar;
        __builtin_amdgcn_s_waitcnt(0);
        unsigned nloc = b.st[0], nx = b.st[1];
        if (nloc == 0u) { xcd_barrier_complete(bar, b.x, nloc, nx); b.st[0] = nloc; b.st[1] = nx; }
        const unsigned old = xb_add(&bar[XB_XSUB(b.x)], 1u);
        const unsigned gen = old / nloc;
        if (old + 1u == (gen + 1u) * nloc) {
            __builtin_amdgcn_fence(__ATOMIC_RELEASE, "agent");
            asm volatile("s_waitcnt vmcnt(0)" ::: "memory");
            const unsigned og = xb_add(&bar[XB_TOP], 1u);
            const unsigned tg = og / nx;
            if (og + 1u == (tg + 1u) * nx) xb_add(&bar[XB_TOPGEN], 1u);
            else XB_SPIN(xb_ld(&bar[XB_TOPGEN]) == tg, bar);
            __builtin_amdgcn_fence(__ATOMIC_ACQUIRE, "agent");
            xb_add(&bar[XB_XGEN(b.x)], 1u);
            asm volatile("s_waitcnt vmcnt(0)" ::: "memory");
        } else {
            XB_SPIN(xb_ld(&bar[XB_XGEN(b.x)]) == gen, bar);
            __builtin_amdgcn_fence(__ATOMIC_ACQUIRE, "agent");
            asm volatile("s_waitcnt vmcnt(0)" ::: "memory");
        }
    }
    __syncthreads();
}

namespace pg8 {
constexpr int BM = 256, BK = 64, HALF = 128, HTB = HALF * BK * 2, STAGE_BYTES = 8 * HTB, NXCD = 8, WGM = 8;
__host__ __device__ __forceinline__ int lds_byte(int r, int c) { const int st = (r >> 4) * 2 + (c >> 5), rr = r & 15, cc = c & 31, ob = rr * 64 + cc * 2; return st * 1024 + (ob ^ (((ob >> 9) & 1) << 5)); }
__host__ __device__ __forceinline__ void stage_rc(int b, int& R, int& C) { const int st = b / 1024, sb = b % 1024, swz = sb ^ (((sb >> 9) & 1) << 5); R = (st >> 1) * 16 + swz / 64; C = (st & 1) * 32 + (swz % 64) / 2; }
__host__ __device__ __forceinline__ int perm32(int rho) { const int n = rho >> 4, i = rho & 15; return 8 * (i >> 2) + 4 * n + (i & 3); }
struct Unit { int pm, pn; const char* a; const char* b; };

struct StaticOrder {
    int nM, nN, nwg, G, c, K; const char* A; const char* B;
    __device__ void init(const bf16_t* A_, const bf16_t* B_, int M, int N, int K_, int G_, int c_) { A = (const char*)A_; B = (const char*)B_; K = K_; nM = M / BM; nN = N / BM; nwg = nM * nN; G = G_; c = c_; }
    __device__ bool next(int i, Unit& u) const {
        const long L = (long)i * G + c; if (L >= nwg) return false;
        int wgid = (int)L; { const int q = nwg / NXCD, r = nwg % NXCD, xcd = wgid % NXCD, off = wgid / NXCD; wgid = (xcd < r ? xcd * (q + 1) : r * (q + 1) + (xcd - r) * q) + off; }
        const int nig = WGM * nN, gid = wgid / nig, fm = gid * WGM, gsz = (nM - fm) < WGM ? (nM - fm) : WGM;
        u.pm = fm + ((wgid % nig) % gsz); u.pn = (wgid % nig) / gsz;
        u.a = A + (size_t)u.pm * 256 * K * 2; u.b = B + (size_t)u.pn * 256 * K * 2; return true;
    }
};

template <class Epi, class Sched>
__device__ __forceinline__ void gemm_phase(LAS unsigned char* lds, const int K_, const Sched& S, const Epi& E) {
    int K = K_; asm volatile("" : "+s"(K));
    int tid_ = threadIdx.x; asm volatile("" : "+v"(tid_));
    const int tid = tid_, wid = __builtin_amdgcn_readfirstlane(tid >> 6), lane = tid & 63, wr = wid >> 2, wc = wid & 3, fr = lane & 15, fq = lane >> 4;
    const int nt = K / BK;
    unsigned voffA[2], voffB[2];
#pragma unroll
    for (int i = 0; i < 2; ++i) { int R, C; stage_rc(tid * 16 + i * 8192, R, C); const int Rb = Epi::PERM ? ((R & ~31) + perm32(R & 31)) : R;
        voffA[i] = (unsigned)(R * K + C) * 2u; voffB[i] = (unsigned)(Rb * K + C) * 2u; }
    const size_t kstep = (size_t)(BK * 2);
    const size_t hstep = (size_t)HALF * K * 2;
    const unsigned ldsw = (unsigned)wid * 1024u;
    const int aoff = lds_byte(wr * 64 + fr, fq * 8), boff = lds_byte(wc * 32 + fr, fq * 8);
#define PG8_SA(b, h) (((b) * 2 + (h)) * HTB)
#define PG8_SB(b, h) ((4 + (b) * 2 + (h)) * HTB)
#define PG8_STAGE(bufoff, gbase, voff) do { _Pragma("unroll") for (int _i = 0; _i < 2; ++_i) \
        __builtin_amdgcn_global_load_lds((const unsigned*)((const char*)(gbase) + (voff)[_i]), (LAS unsigned*)(lds + (bufoff) + ldsw + _i * 8192), 16, 0, 0); } while (0)
#define PG8_LDA(dst, b, h) do { _Pragma("unroll") for (int m = 0; m < 4; ++m) _Pragma("unroll") for (int k = 0; k < 2; ++k) dst[m][k] = *(const LAS bf16x8*)(lds + PG8_SA(b, h) + aoff + m * 2048 + k * 1024); } while (0)
#define PG8_LDB(dst, b, h) do { _Pragma("unroll") for (int n = 0; n < 2; ++n) _Pragma("unroll") for (int k = 0; k < 2; ++k) dst[n][k] = *(const LAS bf16x8*)(lds + PG8_SB(b, h) + boff + n * 2048 + k * 1024); } while (0)
#define PG8_MMA(ai, bj, At, Bt) do { __builtin_amdgcn_s_setprio(1); _Pragma("unroll") for (int m = 0; m < 4; ++m) _Pragma("unroll") for (int n = 0; n < 2; ++n) _Pragma("unroll") for (int k = 0; k < 2; ++k) \
        acc[ai][bj][m][n] = __builtin_amdgcn_mfma_f32_16x16x32_bf16(Bt[n][k], At[m][k], acc[ai][bj][m][n], 0, 0, 0); __builtin_amdgcn_s_setprio(0); } while (0)
#define PG8_WAIT_V(n) asm volatile("s_waitcnt vmcnt(" #n ")" ::: "memory")
#define PG8_WAIT_L(n) asm volatile("s_waitcnt lgkmcnt(" #n ")" ::: "memory")
#define PG8_BAR __builtin_amdgcn_s_barrier()
#define PG8_SCHED __builtin_amdgcn_sched_barrier(0)
    Unit cur, nxt; int ui = 0;
    if (!S.next(0, cur)) return;
    f32x4 acc[2][2][4][2];
#pragma unroll
    for (int a = 0; a < 2; ++a)
#pragma unroll
        for (int b = 0; b < 2; ++b)
#pragma unroll
            for (int m = 0; m < 4; ++m)
#pragma unroll
                for (int n = 0; n < 2; ++n) acc[a][b][m][n] = (f32x4){0.f, 0.f, 0.f, 0.f};
    bf16x8 At[4][2], B0[2][2], B1[2][2];
    const char* cA = cur.a; const char* cB = cur.b;
    PG8_STAGE(PG8_SB(0, 0), cB, voffB); PG8_STAGE(PG8_SA(0, 0), cA, voffA); PG8_STAGE(PG8_SB(0, 1), cB + hstep, voffB); PG8_STAGE(PG8_SA(0, 1), cA + hstep, voffA);
    if (wr == 1) PG8_BAR;
    PG8_WAIT_V(4); PG8_BAR;
    PG8_STAGE(PG8_SB(1, 0), cB + kstep, voffB); PG8_STAGE(PG8_SA(1, 0), cA + kstep, voffA); PG8_STAGE(PG8_SB(1, 1), cB + hstep + kstep, voffB);
    PG8_WAIT_V(6); PG8_BAR;
    for (;;) {
        const bool has_next = S.next(ui + 1, nxt);
        const char* nA = has_next ? nxt.a : cA; const char* nB = has_next ? nxt.b : cB;
        for (int t = 0; t < nt; t += 2) {
            const bool last = (t == nt - 2);
            const char* a1 = cA + (size_t)(t + 1) * kstep;
            const char* a2 = last ? nA : cA + (size_t)(t + 2) * kstep; const char* b2 = last ? nB : cB + (size_t)(t + 2) * kstep;
            const char* a3 = a2 + kstep; const char* b3 = b2 + kstep;
            PG8_LDB(B0, 0, 0); PG8_SCHED; PG8_LDA(At, 0, 0); PG8_STAGE(PG8_SA(1, 1), a1 + hstep, voffA);
            PG8_WAIT_L(8); PG8_BAR; PG8_WAIT_L(0); PG8_MMA(0, 0, At, B0); PG8_BAR; PG8_SCHED;
            PG8_LDB(B1, 0, 1); PG8_STAGE(PG8_SB(0, 0), b2, voffB);
            PG8_BAR; PG8_WAIT_L(0); PG8_MMA(0, 1, At, B1); PG8_BAR;
            PG8_LDA(At, 0, 1); PG8_STAGE(PG8_SA(0, 0), a2, voffA);
            PG8_BAR; PG8_WAIT_L(0); PG8_MMA(1, 0, At, B0); PG8_BAR; PG8_SCHED;
            PG8_STAGE(PG8_SB(0, 1), b2 + hstep, voffB);
            PG8_WAIT_V(6); PG8_BAR; PG8_MMA(1, 1, At, B1); PG8_BAR;
            PG8_LDB(B0, 1, 0); PG8_SCHED; PG8_LDA(At, 1, 0); PG8_STAGE(PG8_SA(0, 1), a2 + hstep, voffA);
            PG8_WAIT_L(8); PG8_BAR; PG8_WAIT_L(0); PG8_MMA(0, 0, At, B0); PG8_BAR; PG8_SCHED;
            PG8_LDB(B1, 1, 1); PG8_STAGE(PG8_SB(1, 0), b3, voffB);
            PG8_BAR; PG8_WAIT_L(0); PG8_MMA(0, 1, At, B1); PG8_BAR;
            PG8_LDA(At, 1, 1); PG8_STAGE(PG8_SA(1, 0), a3, voffA);
            PG8_BAR; PG8_WAIT_L(0); PG8_MMA(1, 0, At, B0); PG8_BAR; PG8_SCHED;
            PG8_STAGE(PG8_SB(1, 1), b3 + hstep, voffB);
            PG8_WAIT_V(6); PG8_BAR; PG8_MMA(1, 1, At, B1); PG8_BAR;
        }
        E(acc, cur, wr, wc, fr, fq);
        if (!has_next) break;
#pragma unroll
        for (int a = 0; a < 2; ++a)
#pragma unroll
            for (int b = 0; b < 2; ++b)
#pragma unroll
                for (int m = 0; m < 4; ++m)
#pragma unroll
                    for (int n = 0; n < 2; ++n) acc[a][b][m][n] = (f32x4){0.f, 0.f, 0.f, 0.f};
        cur = nxt; cA = nA; cB = nB; ++ui;
    }
    PG8_WAIT_V(0);
    if (wr == 0) PG8_BAR;
    PG8_BAR;
#undef PG8_SA
#undef PG8_SB
#undef PG8_STAGE
#undef PG8_LDA
#undef PG8_LDB
#undef PG8_MMA
#undef PG8_WAIT_V
#undef PG8_WAIT_L
#undef PG8_BAR
#undef PG8_SCHED
}

struct EpiBf16 {
    static constexpr bool PERM = true;
    bf16_t* O; int ldc;
    __device__ __forceinline__ void operator()(const f32x4 (&acc)[2][2][4][2], const Unit& u, int wr, int wc, int fr, int fq) const {
        const int row0 = u.pm * BM + wr * 64 + fr, col0 = u.pn * BM + wc * 32 + 8 * fq;
#pragma unroll
        for (int ai = 0; ai < 2; ++ai)
#pragma unroll
            for (int m = 0; m < 4; ++m) { bf16_t* rowp = O + (size_t)(row0 + ai * HALF + m * 16) * ldc + col0;
#pragma unroll
                for (int bj = 0; bj < 2; ++bj) { const f32x4 v0 = acc[ai][bj][m][0], v1 = acc[ai][bj][m][1];
                    u32x4 w; w.x = cvt_pk_bf16(v0[0], v0[1]); w.y = cvt_pk_bf16(v0[2], v0[3]); w.z = cvt_pk_bf16(v1[0], v1[1]); w.w = cvt_pk_bf16(v1[2], v1[3]);
                    *(u32x4*)(rowp + bj * HALF) = w; } }
    }
};
struct EpiResid {
    static constexpr bool PERM = false;
    float* C; int ldc;
    __device__ __forceinline__ void operator()(const f32x4 (&acc)[2][2][4][2], const Unit& u, int wr, int wc, int fr, int fq) const {
        const int row0 = u.pm * BM + wr * 64 + fr, col0 = u.pn * BM + wc * 32 + 4 * fq;
#pragma unroll
        for (int ai = 0; ai < 2; ++ai)
#pragma unroll
            for (int m = 0; m < 4; ++m) { float* rowp = C + (size_t)(row0 + ai * HALF + m * 16) * ldc + col0;
#pragma unroll
                for (int bj = 0; bj < 2; ++bj)
#pragma unroll
                    for (int n = 0; n < 2; ++n) { f32x4* p = (f32x4*)(rowp + bj * HALF + n * 16); *p = *p + acc[ai][bj][m][n]; } }
    }
};
template <int ACT  > struct EpiGated {
    static constexpr bool PERM = true;
    bf16_t* O; int ldo; int coloff; const float* ba; const float* bb;
    __device__ __forceinline__ void operator()(const f32x4 (&acc)[2][2][4][2], const Unit& u, int wr, int wc, int fr, int fq) const {
        const int row0 = u.pm * BM + wr * 64 + fr, cl = u.pn * HALF + wc * 32 + 8 * fq;
        float va[8], vb[8];
#pragma unroll
        for (int j = 0; j < 8; ++j) { va[j] = (ACT == 0) ? ba[cl + j] : 0.f; vb[j] = (ACT == 0) ? bb[cl + j] : 0.f; }
#pragma unroll
        for (int ai = 0; ai < 2; ++ai)
#pragma unroll
            for (int m = 0; m < 4; ++m) { bf16_t* rowp = O + (size_t)(row0 + ai * HALF + m * 16) * ldo + coloff + cl;
                float o[8];
#pragma unroll
                for (int n = 0; n < 2; ++n)
#pragma unroll
                    for (int j = 0; j < 4; ++j) { const float a = acc[ai][0][m][n][j] + va[4 * n + j], b = acc[ai][1][m][n][j] + vb[4 * n + j];
                        o[4 * n + j] = (ACT == 0) ? a * sigmoidf_(b) : siluf_(a) * b; }
                u32x4 w; w.x = cvt_pk_bf16(o[0], o[1]); w.y = cvt_pk_bf16(o[2], o[3]); w.z = cvt_pk_bf16(o[4], o[5]); w.w = cvt_pk_bf16(o[6], o[7]);
                *(u32x4*)rowp = w; asm volatile("" ::: "memory"); }
    }
};
struct EpiMoeOut {
    static constexpr bool PERM = true;
    bf16_t* O; const int* row_tok; const float* row_w; LAS unsigned char* lds;
    __device__ __forceinline__ void operator()(const f32x4 (&acc)[2][2][4][2], const Unit& u, int wr, int wc, int fr_, int fq_) const {
        int fr = fr_, fq = fq_; asm volatile("" : "+v"(fr), "+v"(fq));
        const int col0 = u.pn * BM + wc * 32 + 8 * fq, lane = fq * 16 + fr;
        LAS u32x2* rinfo = (LAS u32x2*)(lds + STAGE_BYTES) + (wr * 4 + wc) * 128;
        { const int ra = u.pm * BM + wr * 64 + lane, rb = ra + HALF;
          const u32x2 ia = (u32x2){(unsigned)row_tok[ra], __float_as_uint(row_w[ra])}, ib = (u32x2){(unsigned)row_tok[rb], __float_as_uint(row_w[rb])};
          rinfo[lane] = ia; rinfo[64 + lane] = ib; }
#pragma unroll
        for (int ai = 0; ai < 2; ++ai)
#pragma unroll
            for (int m = 0; m < 4; ++m) { const u32x2 inf = rinfo[ai * 64 + m * 16 + fr]; const int ts = (int)inf.x; const float w = __uint_as_float(inf.y);
                if (ts >= 0) { bf16_t* rowp = O + ((size_t)(ts & 1) * NTOK + (size_t)(ts >> 1)) * DM + col0;
#pragma unroll
                    for (int bj = 0; bj < 2; ++bj) { const f32x4 v0 = acc[ai][bj][m][0] * w, v1 = acc[ai][bj][m][1] * w;
                        u32x4 q; q.x = cvt_pk_bf16(v0[0], v0[1]); q.y = cvt_pk_bf16(v0[2], v0[3]); q.z = cvt_pk_bf16(v1[0], v1[1]); q.w = cvt_pk_bf16(v1[2], v1[3]);
                        *(u32x4*)(rowp + bj * HALF) = q; } } }
    }
};
struct MoeOrder {
    int nN, G, c, K; const char* A; const char* B; size_t bstride; const int* tiles;
    __device__ bool next(int i, Unit& u) const {
        const int nrt = tiles[0]; const long L = (long)i * G + c; if (L >= (long)nrt * nN) return false;
        u.pm = (int)(L / nN); u.pn = (int)(L % nN); const int e = tiles[64 + u.pm];
        u.a = A + (size_t)u.pm * 256 * K * 2; u.b = B + (size_t)e * bstride + (size_t)u.pn * 256 * K * 2; return true;
    }
};
}

struct Params { const float* in[44]; float* out; unsigned char* ws; int ph_lo, ph_hi; };
enum { I_X = 0, I_NORM1, I_WIN, I_MCONVW, I_MCONVB, I_MDTB, I_MALOG, I_MD, I_MNORM, I_RMU, I_RW0, I_RW2, I_RA0, I_RA2, I_RG2, I_RKK, I_RKA, I_RRK, I_RLNW, I_RLNB,
       I_CKVN, I_CWUK, I_CWUV, I_RELB, I_SARE, I_SAIM, I_SBRE, I_SBIM, I_SCRE, I_SCIM, I_SD, I_SLOGDT, I_SGLUW, I_SGLUB, I_WOUT, I_NORM2, I_WRG, I_BRG, I_WRE, I_BRE,
       I_WGATE, I_WUP, I_WDOWN, I_FNORM };

typedef const float* const __attribute__((address_space(4)))* in_tab_t;
struct Frame {
    LAS unsigned char* lds; int tid, lane, wave, bid, G;
    in_tab_t in; float* out; unsigned char* ws; unsigned* ctl;
    volatile LAS int* misc;
};

__device__ __forceinline__ int q_pop(Frame& F, int qi) {
    __syncthreads();
    if (F.tid == 0) F.misc[0] = (int)__hip_atomic_fetch_add(F.ctl + CW_Q + 64 * qi, 1u, __ATOMIC_RELAXED, __HIP_MEMORY_SCOPE_AGENT);
    __syncthreads();
    return F.misc[0];
}

__device__ __forceinline__ const void* opaque_ptr(const void* p) { const unsigned long long v = (unsigned long long)p; unsigned lo = __builtin_amdgcn_readfirstlane((unsigned)v), hi = __builtin_amdgcn_readfirstlane((unsigned)(v >> 32));
    asm volatile("" : "+s"(lo), "+s"(hi)); return (const void*)(((unsigned long long)hi << 32) | lo); }
__device__ __forceinline__ Frame relocal(const Frame& G) { Frame F = G; asm volatile("" : "+v"(F.tid)); F.ws = (unsigned char*)opaque_ptr(F.ws); F.ctl = (unsigned*)(F.ws + WS_CTL); F.in = (in_tab_t)(unsigned long long)opaque_ptr((const void*)(unsigned long long)F.in); F.lane = F.tid & 63; F.wave = __builtin_amdgcn_readfirstlane(F.tid >> 6); return F; }
template <int K> __device__ __forceinline__ f32x4 mma_nt(const LAS bf16_t* A, int lda, const LAS bf16_t* Bt, int ldb, f32x4 acc, int lane) {
    const int r = lane & 15, g = lane >> 4;
#pragma unroll
    for (int k0 = 0; k0 < K; k0 += 32) {
        const bf16x8 a = *(const LAS bf16x8*)(A + r * lda + k0 + 8 * g);
        const bf16x8 b = *(const LAS bf16x8*)(Bt + r * ldb + k0 + 8 * g);
        acc = __builtin_amdgcn_mfma_f32_16x16x32_bf16(a, b, acc, 0, 0, 0);
    }
    return acc;
}

template <class SrcMap> __device__ __forceinline__ void tr_tile(Frame& F, int ldsrc, bf16_t* dst, int K, int k0, int n0, SrcMap sm) {
    LAS float* tile = (LAS float*)F.lds;
    __syncthreads();
    { const int n4 = (F.tid & 63) * 4, kk = F.tid >> 6; const float* sp = sm(n0 + n4);
      f32x4 v[8];
#pragma unroll
      for (int ps = 0; ps < 8; ++ps) { v[ps] = (f32x4){0.f, 0.f, 0.f, 0.f}; if (sp) v[ps] = *(const f32x4*)(sp + (size_t)(k0 + kk + 8 * ps) * ldsrc); }
#pragma unroll
      for (int ps = 0; ps < 8; ++ps) { LAS float* t = tile + (kk + 8 * ps) * 257 + n4; t[0] = v[ps][0]; t[1] = v[ps][1]; t[2] = v[ps][2]; t[3] = v[ps][3]; } }
    __syncthreads();
    { const int kc = F.tid & 7;
#pragma unroll
      for (int j = 0; j < 4; ++j) { const int n = (F.tid >> 3) + 64 * j; float f[8];
#pragma unroll
          for (int i = 0; i < 8; ++i) f[i] = tile[(8 * kc + i) * 257 + n];
          u32x4 w; w.x = pk2(f[0], f[1]); w.y = pk2(f[2], f[3]); w.z = pk2(f[4], f[5]); w.w = pk2(f[6], f[7]);
          *(u32x4*)(dst + (size_t)(n0 + n) * K + k0 + 8 * kc) = w; } }
}

struct SmIn { const float* base; __device__ __forceinline__ const float* operator()(int n) const {
    int c; if (n < 772) c = n; else if (n < UR) return nullptr; else if (n < UR + 896) c = 772 + (n - UR); else if (n < UC) return nullptr;
    else if (n < UC + 680) c = 1668 + (n - UC); else if (n < US) return nullptr; else if (n < US + 256) c = 2348 + (n - US); else return nullptr; return base + c; } };
struct SmId { const float* base; __device__ __forceinline__ const float* operator()(int n) const { return base + n; } };
struct SmGlu { const float* base; __device__ __forceinline__ const float* operator()(int n) const { const int pn = n >> 8, rr = n & 255; return base + (rr < 128 ? 128 * pn + rr : 256 + 128 * pn + (rr - 128)); } };
struct SmGU { const float* gate; const float* up; __device__ __forceinline__ const float* operator()(int n) const {
    const unsigned long long d = (unsigned long long)up - (unsigned long long)gate; const unsigned long long a = (unsigned long long)gate + (((n & 255) < 128) ? 0ull : d); return (const float*)a + 128 * (n >> 8) + (n & 127); } };
__device__ __forceinline__ void phase_prologue(const Frame& F_) { Frame F = relocal(F_);
    for (int t = F.bid; t < 496; t += F.G) {
        if (t < 352) { const int l = t / 176, r = t % 176, kt = r / 11, nt = r % 11;
            tr_tile(F, NIN, (bf16_t*)(F.ws + WS_WIN) + (size_t)l * NINP * DM, DM, kt * 64, nt * 256, SmIn{F.in[I_WIN] + (size_t)l * DM * NIN}); }
        else if (t < 480) { const int q = t - 352, l = q / 64, r = q % 64, kt = r / 4, nt = r % 4;
            tr_tile(F, DM, (bf16_t*)(F.ws + WS_WOUT) + (size_t)l * DM * DM, DM, kt * 64, nt * 256, SmId{F.in[I_WOUT] + (size_t)l * DM * DM}); }
        else { const int q = t - 480, l = q / 8, r = q % 8, kt = r / 2, nt = r % 2;
            tr_tile(F, 512, (bf16_t*)(F.ws + WS_GLU) + (size_t)l * 512 * 256, 256, kt * 64, nt * 256, SmGlu{F.in[I_SGLUW] + (size_t)l * 256 * 512}); }
    }
    for (int i = F.bid * NTHR + F.tid; i < 2 * 48 * 1024; i += F.G * NTHR) { const int l = i / 49152, r = i % 49152, o = r >> 10, k = r & 1023;
        float v = 0.f; if (o < 32) v = F.in[I_WRE][((size_t)l * DM + k) * 32 + o]; else if (o < 36) v = F.in[I_WRG][((size_t)l * DM + k) * 4 + (o - 32)];
        v *= F.in[I_NORM2][l * DM + k];
        const bf16_t hi = f2bf(v); const bf16_t lo = f2bf(v - bf2f(hi));
        bf16_t* w = (bf16_t*)(F.ws + WS_WRT) + (size_t)l * 2 * 49152; w[r] = hi; w[49152 + r] = lo; }
    for (int i = F.bid * NTHR + F.tid; i < 2048 + 65536; i += F.G * NTHR) {
        if (i < 2048) {
            const int l = i >> 10, gn = i & 1023, g = gn >> 6;
            float* tab = (float*)(F.ws + WS_S5TAB + (size_t)l * S5TAB_L);
            const float lre = fminf(F.in[I_SARE][l * 1024 + gn], -1e-4f), lim = F.in[I_SAIM][l * 1024 + gn];
            const float dt = expf(F.in[I_SLOGDT][l * 16 + g]);
            const float mag = expf(dt * lre); float sn, cs; sincosf(dt * lim, &sn, &cs);
            const float are = mag * cs, aim = mag * sn;
            const float den = lre * lre + lim * lim;
            const float fre = ((are - 1.0f) * lre + aim * lim) / den, fim = (aim * lre - (are - 1.0f) * lim) / den;
            tab[gn * 2] = are; tab[gn * 2 + 1] = aim;
            float pr = are, pi = aim;
#pragma unroll
            for (int s = 0; s < 6; ++s) { const float nr = pr * pr - pi * pi, ni = 2.0f * pr * pi; pr = nr; pi = ni; }
            tab[2048 + gn * 2] = pr; tab[2048 + gn * 2 + 1] = pi;
            const float* bre = F.in[I_SBRE] + ((size_t)l * 1024 + gn) * 16; const float* bim = F.in[I_SBIM] + ((size_t)l * 1024 + gn) * 16;
            for (int p = 0; p < 16; ++p) { tab[4096 + (gn * 16 + p) * 2] = fre * bre[p] - fim * bim[p]; tab[4096 + (gn * 16 + p) * 2 + 1] = fre * bim[p] + fim * bre[p]; }
        } else {
            const int j = i - 2048, l = j >> 15, r = j & 32767, gp = r >> 7, k = r & 127;
            bf16_t* cm = (bf16_t*)(F.ws + WS_S5TAB + (size_t)l * S5TAB_L + S5TAB_F);
            const float v = k < 64 ? F.in[I_SCRE][((size_t)l * 256 + gp) * 64 + k] : -F.in[I_SCIM][((size_t)l * 256 + gp) * 64 + (k - 64)];
            cm[r] = f2bf(v);
        }
    }
}

__device__ __forceinline__ void phase_norm(const Frame& F_, const float* xin, bool add_o, const float* w, int mode) { Frame F = relocal(F_);
    float* X = (float*)(F.ws + WS_X); bf16_t* H = (bf16_t*)(F.ws + WS_H); const bf16_t* O = (const bf16_t*)(F.ws + WS_U);
    for (int row = F.bid * 8 + F.wave; row < NTOK; row += F.G * 8) {
        f32x4 v[4]; float ss = 0.f;
#pragma unroll
        for (int j = 0; j < 4; ++j) { const int c = 4 * F.lane + 256 * j; v[j] = *(const f32x4*)(xin + (size_t)row * DM + c);
            if (add_o) { const u32x2 a = *(const u32x2*)(O + (size_t)row * DM + c), b = *(const u32x2*)(O + ((size_t)NTOK + row) * DM + c);
                v[j][0] += __uint_as_float(a.x << 16) + __uint_as_float(b.x << 16); v[j][1] += __uint_as_float(a.x & 0xffff0000u) + __uint_as_float(b.x & 0xffff0000u);
                v[j][2] += __uint_as_float(a.y << 16) + __uint_as_float(b.y << 16); v[j][3] += __uint_as_float(a.y & 0xffff0000u) + __uint_as_float(b.y & 0xffff0000u); }
            ss += v[j][0] * v[j][0] + v[j][1] * v[j][1] + v[j][2] * v[j][2] + v[j][3] * v[j][3]; }
        ss = wave_sum(ss);
        const float rstd = rsqrtf(ss * (1.0f / DM) + 1e-6f);
#pragma unroll
        for (int j = 0; j < 4; ++j) { const int c = 4 * F.lane + 256 * j; const f32x4 wv = *(const f32x4*)(w + c);
            if (mode == 2) { *(f32x4*)(F.out + (size_t)row * DM + c) = v[j] * rstd * wv; }
            else { *(f32x4*)(X + (size_t)row * DM + c) = v[j];
                u32x2 o; o.x = pk2(v[j][0] * rstd * wv[0], v[j][1] * rstd * wv[1]); o.y = pk2(v[j][2] * rstd * wv[2], v[j][3] * rstd * wv[3]);
                *(u32x2*)(H + (size_t)row * DM + c) = o; } }
    }
}

__device__ __forceinline__ void item_kv(const Frame& F_, int layer, int item) { Frame F = relocal(F_);
    const bf16_t* U = (const bf16_t*)(F.ws + WS_U);
    LAS bf16_t* Ab = (LAS bf16_t*)F.lds;
    LAS bf16_t* Bt = (LAS bf16_t*)(F.lds + 17408);
    const int t0 = item * 64;
    { const int tok = F.tid >> 3, part = F.tid & 7; const bf16_t* src = U + (size_t)(t0 + tok) * NINP + UC + 256 + 16 * part;
      float f[16]; { float a[8], b[8]; unpack8(*(const u32x4*)src, a); unpack8(*(const u32x4*)(src + 8), b);
#pragma unroll
        for (int j = 0; j < 8; ++j) { f[j] = a[j]; f[8 + j] = b[j]; } }
      float ss = 0.f;
#pragma unroll
      for (int j = 0; j < 16; ++j) ss += f[j] * f[j];
      ss = sum8(ss);
      const float rstd = rsqrtf(ss * (1.0f / 128.0f) + 1e-6f); const float* nw = F.in[I_CKVN] + layer * 128 + 16 * part;
#pragma unroll
      for (int j = 0; j < 16; j += 2) *(LAS unsigned*)(Ab + tok * 136 + 16 * part + j) = pk2(f[j] * rstd * nw[j], f[j + 1] * rstd * nw[j + 1]); }
    { const int n = F.tid >> 2, kq = F.tid & 3; const float* w = (n < 64 ? F.in[I_CWUK] : F.in[I_CWUV]) + (size_t)layer * 128 * 64 + (n & 63);
#pragma unroll 4
      for (int k = 32 * kq; k < 32 * kq + 32; ++k) Bt[n * 136 + k] = f2bf(w[(size_t)k * 64]); }
    if (F.tid < 256) { const int tok = F.tid >> 2, q = F.tid & 3;
        *(u32x4*)((bf16_t*)(F.ws + WS_KIDX) + (size_t)(t0 + tok) * 32 + 8 * q) = *(const u32x4*)(U + (size_t)(t0 + tok) * NINP + UC + 640 + 8 * q); }
    __syncthreads();
    const int mt = F.wave & 3, g = F.lane >> 4, r = F.lane & 15;
#pragma unroll
    for (int q = 0; q < 4; ++q) { const int nt = (F.wave >> 2) * 4 + q;
        f32x4 acc = (f32x4){0.f, 0.f, 0.f, 0.f};
        acc = mma_nt<128>(Ab + mt * 16 * 136, 136, Bt + nt * 16 * 136, 136, acc, F.lane);
        const int n = nt * 16 + r; bf16_t* dst = (bf16_t*)(F.ws + (n < 64 ? WS_K : WS_V));
#pragma unroll
        for (int i = 0; i < 4; ++i) dst[(size_t)(t0 + mt * 16 + 4 * g + i) * 64 + (n & 63)] = f2bf(acc[i]); }
}

constexpr int MB_CG = 0, MB_BG = 18432, MB_BT = 36864, MB_XT = 55296, MB_M = 92160, MB_S0 = 101376, MB_DT = 110592, MB_AC = 111616, MB_RS = 112640;
template <int STAGE> __device__ __forceinline__ void item_mamba(const Frame& F_, int layer, int item) { Frame F = relocal(F_);
    const bf16_t* U = (const bf16_t*)(F.ws + WS_U);
    const int b = item >> 6, c = item & 63, l0 = c * 64; const size_t T0 = (size_t)b * SEQ + l0;
    LAS bf16_t* Cg = (LAS bf16_t*)(F.lds + MB_CG); LAS bf16_t* Bg = (LAS bf16_t*)(F.lds + MB_BG); LAS bf16_t* BT = (LAS bf16_t*)(F.lds + MB_BT);
    LAS bf16_t* XT = (LAS bf16_t*)(F.lds + MB_XT); LAS bf16_t* Mb = (LAS bf16_t*)(F.lds + MB_M); LAS bf16_t* S0 = (LAS bf16_t*)(F.lds + MB_S0);
    LAS float* dts = (LAS float*)(F.lds + MB_DT); LAS float* acs = (LAS float*)(F.lds + MB_AC); LAS float* rs = (LAS float*)(F.lds + MB_RS);
    if (F.tid < 256) { const int l = F.tid >> 2, h = F.tid & 3;
        const float raw = bf2f(U[(T0 + l) * NINP + UM + 768 + h]) + F.in[I_MDTB][layer * 4 + h];
        const float dt = softplusf_(raw); dts[l * 4 + h] = dt; acs[l * 4 + h] = -__expf(F.in[I_MALOG][layer * 4 + h]) * dt; }
    if (F.tid < 64) rs[F.tid] = 0.f;
    __syncthreads();
    float mycum = 0.f;
    if (F.tid < 256) { const int l = F.tid >> 2, h = F.tid & 3; for (int s = 0; s <= l; ++s) mycum += acs[s * 4 + h]; }
    __syncthreads();
    if (F.tid < 256) acs[F.tid] = mycum;
    __syncthreads();
    { const int ch8 = F.tid & 63, tg = F.tid >> 6, c0 = ch8 * 8;
      float wv[4][8], bv[8];
#pragma unroll
      for (int j = 0; j < 8; ++j) { bv[j] = F.in[I_MCONVB][layer * 512 + c0 + j];
#pragma unroll
          for (int k = 0; k < 4; ++k) wv[k][j] = F.in[I_MCONVW][(layer * 4 + k) * 512 + c0 + j]; }
      float win[3][8];
#pragma unroll
      for (int k = 0; k < 3; ++k) { const int l = l0 + tg * 8 - 3 + k;
          if (l >= 0) unpack8(*(const u32x4*)(U + ((size_t)b * SEQ + l) * NINP + UM + 256 + c0), win[k]);
          else {
#pragma unroll
              for (int j = 0; j < 8; ++j) win[k][j] = 0.f; } }
#pragma unroll 1
      for (int i = 0; i < 8; ++i) { const int l = tg * 8 + i; float cur[8]; unpack8(*(const u32x4*)(U + (T0 + l) * NINP + UM + 256 + c0), cur);
          float o[8];
#pragma unroll
          for (int j = 0; j < 8; ++j) { o[j] = siluf_(bv[j] + wv[0][j] * win[0][j] + wv[1][j] * win[1][j] + wv[2][j] * win[2][j] + wv[3][j] * cur[j]);
              win[0][j] = win[1][j]; win[1][j] = win[2][j]; win[2][j] = cur[j]; }
          if (c0 < 256) { const int h = c0 >> 6, p0 = c0 & 63; float sc = dts[l * 4 + h]; if (STAGE == 1) sc *= __expf(acs[63 * 4 + h] - acs[l * 4 + h]);
#pragma unroll
              for (int j = 0; j < 8; ++j) XT[(h * 64 + p0 + j) * 72 + l] = f2bf(o[j] * sc); }
          else if (c0 < 384) { const int g = (c0 - 256) >> 6, n0 = (c0 - 256) & 63;
              if (STAGE == 1) {
#pragma unroll
                  for (int j = 0; j < 8; ++j) BT[(g * 64 + n0 + j) * 72 + l] = f2bf(o[j]); }
              else { u32x4 w; w.x = pk2(o[0], o[1]); w.y = pk2(o[2], o[3]); w.z = pk2(o[4], o[5]); w.w = pk2(o[6], o[7]); *(LAS u32x4*)(Bg + (g * 64 + l) * 72 + n0) = w; } }
          else if (STAGE == 2) { const int g = (c0 - 384) >> 6, n0 = (c0 - 384) & 63;
              u32x4 w; w.x = pk2(o[0], o[1]); w.y = pk2(o[2], o[3]); w.z = pk2(o[4], o[5]); w.w = pk2(o[6], o[7]); *(LAS u32x4*)(Cg + (g * 64 + l) * 72 + n0) = w; } } }
    __syncthreads();
    const int g4 = F.lane >> 4, r16 = F.lane & 15;
    if (STAGE == 1) {
        float* MST = (float*)(F.ws + WS_MST) + ((size_t)(b * 64 + c) * 4) * 4096;
#pragma unroll
        for (int q = 0; q < 8; ++q) { const int tix = F.wave * 8 + q, h = tix >> 4, mt = (tix >> 2) & 3, nt = tix & 3;
            f32x4 acc = (f32x4){0.f, 0.f, 0.f, 0.f};
            acc = mma_nt<64>(XT + (h * 64 + mt * 16) * 72, 72, BT + ((h >> 1) * 64 + nt * 16) * 72, 72, acc, F.lane);
#pragma unroll
            for (int i = 0; i < 4; ++i) MST[(size_t)h * 4096 + (mt * 16 + 4 * g4 + i) * 64 + nt * 16 + r16] = acc[i]; }
        if (F.tid < 4) ((float*)(F.ws + WS_MDEC))[(b * 64 + c) * 4 + F.tid] = __expf(acs[63 * 4 + F.tid]);
    } else {
        const int mt = F.wave & 3, nh = F.wave >> 2;
        const float* MST = (const float*)(F.ws + WS_MST) + ((size_t)(b * 64 + c) * 4) * 4096;
        f32x4 G[2], yv[4][2];
#pragma unroll
        for (int h = 0; h < 4; ++h) {
            const int g = h >> 1;
            { const float* src = MST + (size_t)h * 4096 + F.tid * 8; const f32x4 a = *(const f32x4*)src, bq = *(const f32x4*)(src + 4);
              u32x4 w; w.x = pk2(a[0], a[1]); w.y = pk2(a[2], a[3]); w.z = pk2(bq[0], bq[1]); w.w = pk2(bq[2], bq[3]);
              *(LAS u32x4*)(S0 + (F.tid >> 3) * 72 + (F.tid & 7) * 8) = w; }
            if ((h & 1) == 0) {
#pragma unroll
                for (int q = 0; q < 2; ++q) { G[q] = (f32x4){0.f, 0.f, 0.f, 0.f};
                    G[q] = mma_nt<64>(Cg + (g * 64 + mt * 16) * 72, 72, Bg + (g * 64 + (2 * nh + q) * 16) * 72, 72, G[q], F.lane); } }
#pragma unroll
            for (int q = 0; q < 2; ++q) { const int s = (2 * nh + q) * 16 + r16; const float as = acs[s * 4 + h];
#pragma unroll
                for (int i = 0; i < 4; ++i) { const int l = mt * 16 + 4 * g4 + i; const float v = (s <= l) ? G[q][i] * __expf(acs[l * 4 + h] - as) : 0.f;
                    Mb[l * 72 + s] = f2bf(v); } }
            __syncthreads();
#pragma unroll
            for (int q = 0; q < 2; ++q) { const int nt = 2 * nh + q;
                f32x4 yd = (f32x4){0.f, 0.f, 0.f, 0.f}, yo = (f32x4){0.f, 0.f, 0.f, 0.f};
                yd = mma_nt<64>(Mb + mt * 16 * 72, 72, XT + (h * 64 + nt * 16) * 72, 72, yd, F.lane);
                yo = mma_nt<64>(Cg + (g * 64 + mt * 16) * 72, 72, S0 + nt * 16 * 72, 72, yo, F.lane);
                const int p = nt * 16 + r16; const float dsk = F.in[I_MD][layer * 4 + h];
#pragma unroll
                for (int i = 0; i < 4; ++i) { const int l = mt * 16 + 4 * g4 + i;
                    const float xs = bf2f(XT[(h * 64 + p) * 72 + l]) / dts[l * 4 + h];
                    yv[h][q][i] = yd[i] + yo[i] * __expf(acs[l * 4 + h]) + dsk * xs; } }
            __syncthreads();
        }
        float part[4] = {0.f, 0.f, 0.f, 0.f};
#pragma unroll
        for (int h = 0; h < 4; ++h)
#pragma unroll
            for (int q = 0; q < 2; ++q) { const int ch = h * 64 + (2 * nh + q) * 16 + r16;
#pragma unroll
                for (int i = 0; i < 4; ++i) { const int l = mt * 16 + 4 * g4 + i; const float z = bf2f(U[(T0 + l) * NINP + UM + ch]);
                    const float v = yv[h][q][i] * siluf_(z); yv[h][q][i] = v; part[i] += v * v; } }
#pragma unroll
        for (int i = 0; i < 4; ++i) { const float s = sum16(part[i]); if (r16 == 0) atomicAdd((float*)(rs + mt * 16 + 4 * g4 + i), s); }
        __syncthreads();
        bf16_t* Y = (bf16_t*)(F.ws + WS_H);
#pragma unroll
        for (int i = 0; i < 4; ++i) { const int l = mt * 16 + 4 * g4 + i; const float rstd = rsqrtf(rs[l] * (1.0f / 256.0f) + 1e-6f);
#pragma unroll
            for (int h = 0; h < 4; ++h)
#pragma unroll
                for (int q = 0; q < 2; ++q) { const int ch = h * 64 + (2 * nh + q) * 16 + r16;
                    Y[(T0 + l) * DM + ch] = f2bf(yv[h][q][i] * rstd * F.in[I_MNORM][layer * 256 + ch]); } }
    }
}
__device__ __forceinline__ void item_mamba_carry(const Frame& F_, int item) { Frame F = relocal(F_);
    const int b = item >> 2, h = item & 3;
    float* MST = (float*)(F.ws + WS_MST); const float* MD = (const float*)(F.ws + WS_MDEC);
    float s[8];
#pragma unroll
    for (int j = 0; j < 8; ++j) s[j] = 0.f;
    for (int c = 0; c < 64; ++c) { float* p = MST + ((size_t)(b * 64 + c) * 4 + h) * 4096 + F.tid * 8; const float d = MD[(b * 64 + c) * 4 + h];
        const f32x4 a = *(f32x4*)p, q = *(f32x4*)(p + 4);
        *(f32x4*)p = (f32x4){s[0], s[1], s[2], s[3]}; *(f32x4*)(p + 4) = (f32x4){s[4], s[5], s[6], s[7]};
        s[0] = s[0] * d + a[0]; s[1] = s[1] * d + a[1]; s[2] = s[2] * d + a[2]; s[3] = s[3] * d + a[3];
        s[4] = s[4] * d + q[0]; s[5] = s[5] * d + q[1]; s[6] = s[6] * d + q[2]; s[7] = s[7] * d + q[3]; }
}

template <int STAGE> __device__ __forceinline__ void item_s5(const Frame& F_, int layer, int item) { Frame F = relocal(F_);
    const bf16_t* U = (const bf16_t*)(F.ws + WS_U);
    const int b = item >> 6, c = item & 63; const size_t T0 = (size_t)b * SEQ + c * 64;
    LAS float* us = (LAS float*)F.lds; LAS bf16_t* Hs = (LAS bf16_t*)(F.lds + 65536);
    const float* tab = (const float*)(F.ws + WS_S5TAB + (size_t)layer * S5TAB_L);
    { const int tok = F.tid >> 3, part = F.tid & 7;
#pragma unroll
      for (int q = 0; q < 4; ++q) { float f[8]; unpack8(*(const u32x4*)(U + (T0 + tok) * NINP + US + 32 * part + 8 * q), f);
          *(LAS f32x4*)(us + tok * 256 + 32 * part + 8 * q) = (f32x4){f[0], f[1], f[2], f[3]}; *(LAS f32x4*)(us + tok * 256 + 32 * part + 8 * q + 4) = (f32x4){f[4], f[5], f[6], f[7]}; } }
    const int g = F.tid >> 5, n0 = F.tid & 31, gn0 = g * 64 + n0, gn1 = gn0 + 32;
    float bb0[32], bb1[32];
#pragma unroll
    for (int j = 0; j < 32; j += 4) { const f32x4 a = *(const f32x4*)(tab + 4096 + gn0 * 32 + j), bq = *(const f32x4*)(tab + 4096 + gn1 * 32 + j);
        bb0[j] = a[0]; bb0[j + 1] = a[1]; bb0[j + 2] = a[2]; bb0[j + 3] = a[3]; bb1[j] = bq[0]; bb1[j + 1] = bq[1]; bb1[j + 2] = bq[2]; bb1[j + 3] = bq[3]; }
    const float a0r = tab[gn0 * 2], a0i = tab[gn0 * 2 + 1], a1r = tab[gn1 * 2], a1i = tab[gn1 * 2 + 1];
    float* ST = (float*)(F.ws + WS_S5ST) + (size_t)(b * 64 + c) * 2048;
    float h0r = 0.f, h0i = 0.f, h1r = 0.f, h1i = 0.f;
    if (STAGE == 2) { h0r = ST[gn0 * 2]; h0i = ST[gn0 * 2 + 1]; h1r = ST[gn1 * 2]; h1i = ST[gn1 * 2 + 1]; }
    bf16x8 cf[2][4];
    if (STAGE == 2) { const bf16_t* cm = (const bf16_t*)(F.ws + WS_S5TAB + (size_t)layer * S5TAB_L + S5TAB_F);
#pragma unroll
        for (int gg = 0; gg < 2; ++gg)
#pragma unroll
            for (int ks = 0; ks < 4; ++ks) cf[gg][ks] = *(const bf16x8*)(cm + ((size_t)((2 * F.wave + gg) * 16 + (F.lane & 15))) * 128 + 32 * ks + 8 * (F.lane >> 4)); }
    __syncthreads();
#pragma unroll 1
    for (int lb = 0; lb < 4; ++lb) {
#pragma unroll 2
        for (int li = 0; li < 16; ++li) { const int l = lb * 16 + li;
            float uu[16];
#pragma unroll
            for (int q = 0; q < 4; ++q) { const f32x4 v = *(const LAS f32x4*)(us + l * 256 + g * 16 + 4 * q); uu[4 * q] = v[0]; uu[4 * q + 1] = v[1]; uu[4 * q + 2] = v[2]; uu[4 * q + 3] = v[3]; }
            float b0r = 0.f, b0i = 0.f, b1r = 0.f, b1i = 0.f;
#pragma unroll
            for (int p = 0; p < 16; ++p) { b0r += bb0[2 * p] * uu[p]; b0i += bb0[2 * p + 1] * uu[p]; b1r += bb1[2 * p] * uu[p]; b1i += bb1[2 * p + 1] * uu[p]; }
            { const float nr = a0r * h0r - a0i * h0i + b0r, ni = a0r * h0i + a0i * h0r + b0i; h0r = nr; h0i = ni; }
            { const float nr = a1r * h1r - a1i * h1i + b1r, ni = a1r * h1i + a1i * h1r + b1i; h1r = nr; h1i = ni; }
            if (STAGE == 2) { LAS bf16_t* hp = Hs + li * 2056 + g * 128; hp[n0] = f2bf(h0r); hp[64 + n0] = f2bf(h0i); hp[n0 + 32] = f2bf(h1r); hp[96 + n0] = f2bf(h1i); }
        }
        if (STAGE == 2) {
            __syncthreads();
            bf16_t* YS = (bf16_t*)(F.ws + WS_MOE + YSG_OFF);
#pragma unroll
            for (int gg = 0; gg < 2; ++gg) { const int gq = 2 * F.wave + gg; f32x4 acc = (f32x4){0.f, 0.f, 0.f, 0.f};
#pragma unroll
                for (int ks = 0; ks < 4; ++ks) { const bf16x8 a = *(const LAS bf16x8*)(Hs + (F.lane & 15) * 2056 + gq * 128 + 32 * ks + 8 * (F.lane >> 4));
                    acc = __builtin_amdgcn_mfma_f32_16x16x32_bf16(a, cf[gg][ks], acc, 0, 0, 0); }
                const int ch = gq * 16 + (F.lane & 15); const float dsk = F.in[I_SD][layer * 256 + ch];
#pragma unroll
                for (int i = 0; i < 4; ++i) { const int l = lb * 16 + 4 * (F.lane >> 4) + i; const float y = acc[i] + dsk * us[l * 256 + ch];
                    YS[(T0 + l) * 256 + ch] = f2bf(gelu_tanh(y)); } }
            __syncthreads();
        }
    }
    if (STAGE == 1) { ST[gn0 * 2] = h0r; ST[gn0 * 2 + 1] = h0i; ST[gn1 * 2] = h1r; ST[gn1 * 2 + 1] = h1i; }
    if (STAGE == 2) {
        asm volatile("s_waitcnt vmcnt(0)" ::: "memory"); __syncthreads();
        const bf16_t* YS = (const bf16_t*)(F.ws + WS_MOE + YSG_OFF) + T0 * 256; const bf16_t* GW = (const bf16_t*)(F.ws + WS_GLU) + (size_t)layer * 512 * 256;
        const int r16 = F.lane & 15, g4 = F.lane >> 4;
        f32x4 av[4][2], ag[4][2];
#pragma unroll
        for (int m = 0; m < 4; ++m)
#pragma unroll
            for (int q = 0; q < 2; ++q) { av[m][q] = (f32x4){0.f, 0.f, 0.f, 0.f}; ag[m][q] = (f32x4){0.f, 0.f, 0.f, 0.f}; }
#pragma unroll 2
        for (int ks = 0; ks < 8; ++ks) {
            bf16x8 af[4], bv[2], bg[2];
#pragma unroll
            for (int m = 0; m < 4; ++m) af[m] = *(const bf16x8*)(YS + (size_t)(16 * m + r16) * 256 + 32 * ks + 8 * g4);
#pragma unroll
            for (int q = 0; q < 2; ++q) { const int c = 32 * F.wave + 16 * q + r16; const int rowv = 256 * (c >> 7) + (c & 127);
                bv[q] = *(const bf16x8*)(GW + (size_t)rowv * 256 + 32 * ks + 8 * g4); bg[q] = *(const bf16x8*)(GW + (size_t)(rowv + 128) * 256 + 32 * ks + 8 * g4); }
#pragma unroll
            for (int m = 0; m < 4; ++m)
#pragma unroll
                for (int q = 0; q < 2; ++q) { av[m][q] = __builtin_amdgcn_mfma_f32_16x16x32_bf16(af[m], bv[q], av[m][q], 0, 0, 0); ag[m][q] = __builtin_amdgcn_mfma_f32_16x16x32_bf16(af[m], bg[q], ag[m][q], 0, 0, 0); }
        }
        bf16_t* Y = (bf16_t*)(F.ws + WS_H);
#pragma unroll
        for (int q = 0; q < 2; ++q) { const int c = 32 * F.wave + 16 * q + r16; const float bvl = F.in[I_SGLUB][layer * 512 + c], bgt = F.in[I_SGLUB][layer * 512 + 256 + c];
#pragma unroll
            for (int m = 0; m < 4; ++m)
#pragma unroll
                for (int i = 0; i < 4; ++i) Y[(T0 + 16 * m + 4 * g4 + i) * DM + 768 + c] = f2bf((av[m][q][i] + bvl) * sigmoidf_(ag[m][q][i] + bgt)); }
    }
}
__device__ __forceinline__ void item_s5_carry(const Frame& F_, int layer, int b) { Frame F = relocal(F_);
    const float* tab = (const float*)(F.ws + WS_S5TAB + (size_t)layer * S5TAB_L) + 2048;
    float* ST = (float*)(F.ws + WS_S5ST) + (size_t)b * 64 * 2048;
#pragma unroll
    for (int q = 0; q < 2; ++q) { const int gn = F.tid + 512 * q; const float pr = tab[gn * 2], pi = tab[gn * 2 + 1]; float hr = 0.f, hi = 0.f;
        for (int c = 0; c < 64; ++c) { float* p = ST + (size_t)c * 2048 + gn * 2; const float tr = p[0], ti = p[1]; p[0] = hr; p[1] = hi;
            const float nr = pr * hr - pi * hi + tr, ni = pr * hi + pi * hr + ti; hr = nr; hi = ni; } }
}

constexpr int RB_LD = 72;
constexpr int RW_R = 0, RW_K = 16384, RW_V = 32768, RW_W = 49152, RW_A = 65536, RW_B = 81920;
constexpr int R3_G = 49152, R3_O = 65536, R3_TILES = 81920, R3_BON = 147456;
template <int STAGE> __device__ __forceinline__ void rwkv_prep(const Frame& F_, int layer, int b, int h, int c) { Frame F = relocal(F_);
    const bf16_t* U = (const bf16_t*)(F.ws + WS_U);
    const int l0 = c * 64; const size_t T0 = (size_t)b * SEQ + l0;
    LAS float* Rr = (LAS float*)(F.lds + RW_R); LAS float* Kk = (LAS float*)(F.lds + RW_K); LAS float* Vv = (LAS float*)(F.lds + RW_V); LAS float* Ww = (LAS float*)(F.lds + RW_W);
    LAS float* Aa = (LAS float*)(F.lds + (STAGE == 1 ? RW_A : R3_O)); LAS float* Bb = (LAS float*)(F.lds + RW_B); LAS float* Gg = (LAS float*)(F.lds + R3_G); LAS float* BON = (LAS float*)(F.lds + R3_BON);
    LAS bf16_t* TWb = (LAS bf16_t*)(F.lds + 98304); LAS bf16_t* DAb = (LAS bf16_t*)(F.lds + (STAGE == 1 ? 103424 : 118784)); LAS bf16_t* SGb = (LAS bf16_t*)(F.lds + 123904);
    LAS bf16_t* w2T = (LAS bf16_t*)(F.lds + 108544); LAS bf16_t* a2T = (LAS bf16_t*)(F.lds + (STAGE == 1 ? 113664 : 133120)); LAS bf16_t* g2T = (LAS bf16_t*)(F.lds + 138240);
    const float* mu = F.in[I_RMU] + layer * 896;
    { const int tok = F.tid >> 3, p8 = F.tid & 7; const bool first = (l0 + tok == 0);
      const bf16_t* cur = U + (T0 + tok) * NINP + UR; const bf16_t* prv = cur - NINP;
#pragma unroll
      for (int sec = (STAGE == 1 ? 0 : 2); sec < 3; ++sec) { const int co = sec * 256 + h * 64 + 8 * p8; float av[8], pq[8]; unpack8(*(const u32x4*)(cur + co), av);
          if (first) {
#pragma unroll
              for (int j = 0; j < 8; ++j) pq[j] = 0.f; } else unpack8(*(const u32x4*)(prv + co), pq);
          const f32x4 m0 = *(const f32x4*)(mu + co), m1 = *(const f32x4*)(mu + co + 4);
          LAS float* dst = (sec == 0 ? Rr : sec == 1 ? Kk : Vv) + tok * 64 + 8 * p8;
          *(LAS f32x4*)dst = (f32x4){av[0] + m0[0] * (pq[0] - av[0]), av[1] + m0[1] * (pq[1] - av[1]), av[2] + m0[2] * (pq[2] - av[2]), av[3] + m0[3] * (pq[3] - av[3])};
          *(LAS f32x4*)(dst + 4) = (f32x4){av[4] + m1[0] * (pq[4] - av[4]), av[5] + m1[1] * (pq[5] - av[5]), av[6] + m1[2] * (pq[6] - av[6]), av[7] + m1[3] * (pq[7] - av[7])}; }
      if (STAGE == 1) { const int co = 768 + 4 * p8;
        const u32x2 cv = *(const u32x2*)(cur + co); u32x2 pv = (u32x2){0u, 0u}; if (!first) pv = *(const u32x2*)(prv + co);
        const f32x4 m0 = *(const f32x4*)(mu + co);
        float x[4] = {__uint_as_float(cv.x << 16), __uint_as_float(cv.x & 0xffff0000u), __uint_as_float(cv.y << 16), __uint_as_float(cv.y & 0xffff0000u)};
        const float y[4] = {__uint_as_float(pv.x << 16), __uint_as_float(pv.x & 0xffff0000u), __uint_as_float(pv.y << 16), __uint_as_float(pv.y & 0xffff0000u)};
#pragma unroll
        for (int j = 0; j < 4; ++j) x[j] = tanhf_(x[j] + m0[j] * (y[j] - x[j]));
        *(LAS u32x2*)(TWb + tok * 40 + 4 * p8) = (u32x2){pk2(x[0], x[1]), pk2(x[2], x[3])}; }
      if (STAGE == 1) { const int co = 800 + 4 * p8;
        const u32x2 cv = *(const u32x2*)(cur + co); u32x2 pv = (u32x2){0u, 0u}; if (!first) pv = *(const u32x2*)(prv + co);
        const f32x4 m0 = *(const f32x4*)(mu + co);
        float x[4] = {__uint_as_float(cv.x << 16), __uint_as_float(cv.x & 0xffff0000u), __uint_as_float(cv.y << 16), __uint_as_float(cv.y & 0xffff0000u)};
        const float y[4] = {__uint_as_float(pv.x << 16), __uint_as_float(pv.x & 0xffff0000u), __uint_as_float(pv.y << 16), __uint_as_float(pv.y & 0xffff0000u)};
#pragma unroll
        for (int j = 0; j < 4; ++j) x[j] = x[j] + m0[j] * (y[j] - x[j]);
        *(LAS u32x2*)(DAb + tok * 40 + 4 * p8) = (u32x2){pk2(x[0], x[1]), pk2(x[2], x[3])}; }
      if (STAGE == 3) { const int co = 832 + 8 * p8; float av[8], pq[8]; unpack8(*(const u32x4*)(cur + co), av);
          if (first) {
#pragma unroll
              for (int j = 0; j < 8; ++j) pq[j] = 0.f; } else unpack8(*(const u32x4*)(prv + co), pq);
          const f32x4 m0 = *(const f32x4*)(mu + co), m1 = *(const f32x4*)(mu + co + 4); float x[8];
#pragma unroll
          for (int j = 0; j < 8; ++j) x[j] = sigmoidf_(av[j] + (j < 4 ? m0[j] : m1[j - 4]) * (pq[j] - av[j]));
          *(LAS u32x4*)(SGb + tok * RB_LD + 8 * p8) = (u32x4){pk2(x[0], x[1]), pk2(x[2], x[3]), pk2(x[4], x[5]), pk2(x[6], x[7])}; } }
    { const int ch = F.tid & 63, part = F.tid >> 6;
      if (STAGE == 1) { const float* w2 = F.in[I_RW2] + ((size_t)layer * 32 + 4 * part) * 256 + h * 64 + ch;
          *(LAS u32x2*)(w2T + ch * 40 + 4 * part) = (u32x2){pk2(w2[0], w2[256]), pk2(w2[512], w2[768])}; }
      if (STAGE == 1) { const float* a2 = F.in[I_RA2] + ((size_t)layer * 32 + 4 * part) * 256 + h * 64 + ch;
          *(LAS u32x2*)(a2T + ch * 40 + 4 * part) = (u32x2){pk2(a2[0], a2[256]), pk2(a2[512], a2[768])}; }
      if (STAGE == 3) { const float* g2 = F.in[I_RG2] + ((size_t)layer * 64 + 8 * part) * 256 + h * 64 + ch;
          *(LAS u32x4*)(g2T + ch * RB_LD + 8 * part) = (u32x4){pk2(g2[0], g2[256]), pk2(g2[512], g2[768]), pk2(g2[1024], g2[1280]), pk2(g2[1536], g2[1792])}; } }
    __syncthreads();
    { const int lane = F.lane, mt = F.wave >> 1, nt0 = 2 * (F.wave & 1), r = lane & 15, g4 = lane >> 4; const f32x4 zero4 = (f32x4){0.f, 0.f, 0.f, 0.f};
#pragma unroll
      for (int q = 0; q < 2; ++q) { const int nt = nt0 + q, ch = 16 * nt + r, cg = layer * 256 + h * 64 + ch;
          if (STAGE == 1) { const f32x4 wl = mma_nt<32>(TWb + 16 * mt * 40, 40, w2T + 16 * nt * 40, 40, zero4, lane); const float w0 = F.in[I_RW0][cg];
#pragma unroll
              for (int i = 0; i < 4; ++i) { const float x = w0 + wl[i]; const float wlog = -__logf(1.0f + __expf(-x)) - 0.5f; Ww[(16 * mt + 4 * g4 + i) * 64 + ch] = __expf(-__expf(wlog)); } }
          if (STAGE == 1) { const f32x4 al = mma_nt<32>(DAb + 16 * mt * 40, 40, a2T + 16 * nt * 40, 40, zero4, lane); const float a0 = F.in[I_RA0][cg];
#pragma unroll
              for (int i = 0; i < 4; ++i) Aa[(16 * mt + 4 * g4 + i) * 64 + ch] = sigmoidf_(a0 + al[i]); }
          if (STAGE == 3) { const f32x4 gv = mma_nt<64>(SGb + 16 * mt * RB_LD, RB_LD, g2T + 16 * nt * RB_LD, RB_LD, zero4, lane);
#pragma unroll
              for (int i = 0; i < 4; ++i) Gg[(16 * mt + 4 * g4 + i) * 64 + ch] = gv[i]; } } }
    __syncthreads();
    float* gBON = (float*)(F.ws + WS_BON) + ((size_t)(b * 4 + h) * 64 + c) * 64;
    if (STAGE == 1) { const int j = F.lane, tq = F.wave, cg = layer * 256 + h * 64 + j;
      const float kkw = F.in[I_RKK][cg], kaw = F.in[I_RKA][cg], rk = F.in[I_RRK][cg];
#pragma unroll 2
      for (int i8 = 0; i8 < 8; ++i8) { const int t = tq + 8 * i8;
          const float a = Aa[t * 64 + j]; const float kraw = Kk[t * 64 + j]; const float kp = kraw * (1.0f + (a - 1.0f) * kaw);
          Kk[t * 64 + j] = kp;
          const float kkv = kraw * kkw; const float ss = wave_sum(kkv * kkv); const float kkn = kkv * rsqrtf(fmaxf(ss, 1e-24f)); Aa[t * 64 + j] = -kkn; Bb[t * 64 + j] = kkn * a;
          const float bo = wave_sum(Rr[t * 64 + j] * kp * rk); if (j == 0) gBON[t] = bo; } }
    else if (F.tid < 64) BON[F.tid] = gBON[F.tid];
    __syncthreads();
}
constexpr int RB_AT = 98304, RB_ATT = RB_AT + 9216, RB_BT = RB_ATT + 9216, RB_BTT = RB_BT + 9216, RB_KT = RB_BTT + 9216, RB_RT = RB_KT + 9216, RB_VT = RB_RT + 9216, RB_GC = RB_VT + 9216;
constexpr int RX_X = 0, RX_XT = 9216, RX_TB = 18432, RX_M = 27648, RX_NRT = 36864, RX_G1T = 46080, RX_G2T = 55296, RX_QT = 64512;
__device__ __forceinline__ void st_tile(LAS bf16_t* dst, int mt, int nt, const f32x4 v, int lane) {
    const int r = lane & 15, g = lane >> 4;
#pragma unroll
    for (int i = 0; i < 4; ++i) dst[(16 * mt + 4 * g + i) * RB_LD + 16 * nt + r] = f2bf(v[i]);
}
__device__ __forceinline__ void st_tile_t(LAS bf16_t* dst, int mt, int nt, const f32x4 v, int lane) {
    const int r = lane & 15, g = lane >> 4; u32x2 w; w.x = pk2(v[0], v[1]); w.y = pk2(v[2], v[3]);
    *(LAS u32x2*)(dst + (16 * nt + r) * RB_LD + 16 * mt + 4 * g) = w;
}
__device__ __forceinline__ void item_rwkv1(const Frame& F_, int layer, int item) { Frame F = relocal(F_);
    const int b = item >> 8, h = (item >> 6) & 3, c = item & 63;
    rwkv_prep<1>(F, layer, b, h, c);
    LAS float* Rr = (LAS float*)(F.lds + RW_R); LAS float* Kk = (LAS float*)(F.lds + RW_K); LAS float* Vv = (LAS float*)(F.lds + RW_V); LAS float* Ww = (LAS float*)(F.lds + RW_W);
    LAS float* Aa = (LAS float*)(F.lds + RW_A); LAS float* Bb = (LAS float*)(F.lds + RW_B);
    LAS bf16_t* At = (LAS bf16_t*)(F.lds + RB_AT); LAS bf16_t* AtT = (LAS bf16_t*)(F.lds + RB_ATT); LAS bf16_t* Bt = (LAS bf16_t*)(F.lds + RB_BT); LAS bf16_t* BtT = (LAS bf16_t*)(F.lds + RB_BTT);
    LAS bf16_t* Kt = (LAS bf16_t*)(F.lds + RB_KT); LAS bf16_t* Rt = (LAS bf16_t*)(F.lds + RB_RT); LAS bf16_t* VT = (LAS bf16_t*)(F.lds + RB_VT); LAS float* gC = (LAS float*)(F.lds + RB_GC);
    LAS bf16_t* X = (LAS bf16_t*)(F.lds + RX_X); LAS bf16_t* XT = (LAS bf16_t*)(F.lds + RX_XT); LAS bf16_t* Tb = (LAS bf16_t*)(F.lds + RX_TB); LAS bf16_t* Mm = (LAS bf16_t*)(F.lds + RX_M);
    LAS bf16_t* NrT = (LAS bf16_t*)(F.lds + RX_NRT); LAS bf16_t* G1T = (LAS bf16_t*)(F.lds + RX_G1T); LAS bf16_t* G2T = (LAS bf16_t*)(F.lds + RX_G2T); LAS bf16_t* QT = (LAS bf16_t*)(F.lds + RX_QT);
    { const int k = F.tid & 63, part = F.tid >> 6; float g = 1.0f;
      for (int pp = 0; pp < part; ++pp) { float w8[8];
#pragma unroll
          for (int i = 0; i < 8; ++i) w8[i] = Ww[(8 * pp + i) * 64 + k];
          g *= ((w8[0] * w8[1]) * (w8[2] * w8[3])) * ((w8[4] * w8[5]) * (w8[6] * w8[7])); }
#pragma unroll
      for (int i = 0; i < 8; ++i) { const int t = 8 * part + i; const float gp = g; g *= Ww[t * 64 + k]; const float ig = 1.0f / g;
          const bf16_t av = f2bf(Aa[t * 64 + k] * gp), bv = f2bf(Bb[t * 64 + k] * ig);
          At[t * RB_LD + k] = av; AtT[k * RB_LD + t] = av; Bt[t * RB_LD + k] = bv; BtT[k * RB_LD + t] = bv;
          Kt[t * RB_LD + k] = f2bf(Kk[t * 64 + k] * ig); Rt[t * RB_LD + k] = f2bf(Rr[t * 64 + k] * g); VT[k * RB_LD + t] = f2bf(Vv[t * 64 + k]); }
      if (part == 7) gC[k] = g; }
    __syncthreads();
    const int lane = F.lane, mt = F.wave >> 1, nt0 = 2 * (F.wave & 1), r = lane & 15, g4 = lane >> 4;
    const f32x4 zero4 = (f32x4){0.f, 0.f, 0.f, 0.f};
    f32x4 Tacc[2];
#pragma unroll
    for (int q = 0; q < 2; ++q) { const int nt = nt0 + q;
        f32x4 n = mma_nt<64>(Bt + 16 * mt * RB_LD, RB_LD, At + 16 * nt * RB_LD, RB_LD, zero4, lane);
        f32x4 m = mma_nt<64>(Kt + 16 * mt * RB_LD, RB_LD, At + 16 * nt * RB_LD, RB_LD, zero4, lane);
        f32x4 nr = mma_nt<64>(Rt + 16 * mt * RB_LD, RB_LD, Bt + 16 * nt * RB_LD, RB_LD, zero4, lane);
#pragma unroll
        for (int i = 0; i < 4; ++i) { const int row = 16 * mt + 4 * g4 + i, col = 16 * nt + r;
            n[i] = (row < col) ? n[i] : 0.f; m[i] = (row < col) ? m[i] : 0.f; nr[i] = (col <= row) ? nr[i] : 0.f;
            Tacc[q][i] = n[i] + (row == col ? 1.0f : 0.f); }
        st_tile(X, mt, nt, n, lane); st_tile_t(XT, mt, nt, n, lane); st_tile(Tb, mt, nt, Tacc[q], lane); st_tile(Mm, mt, nt, m, lane); st_tile(NrT, mt, nt, nr, lane); }
    __syncthreads();
#pragma unroll 1
    for (int it = 0; it < 6; ++it) {
        LAS bf16_t* Xr = (it & 1) ? G1T : X; LAS bf16_t* XTr = (it & 1) ? G2T : XT; LAS bf16_t* Tr = (it & 1) ? QT : Tb;
        LAS bf16_t* Xw = (it & 1) ? X : G1T; LAS bf16_t* XTw = (it & 1) ? XT : G2T; LAS bf16_t* Tw = (it & 1) ? Tb : QT;
#pragma unroll
        for (int q = 0; q < 2; ++q) { const int nt = nt0 + q;
            if (it > 0) Tacc[q] = mma_nt<64>(Tr + 16 * mt * RB_LD, RB_LD, XTr + 16 * nt * RB_LD, RB_LD, Tacc[q], lane);
            if (it < 5) { const f32x4 x2 = mma_nt<64>(Xr + 16 * mt * RB_LD, RB_LD, XTr + 16 * nt * RB_LD, RB_LD, zero4, lane); st_tile(Xw, mt, nt, x2, lane); st_tile_t(XTw, mt, nt, x2, lane); }
            st_tile(Tw, mt, nt, Tacc[q], lane); }
        __syncthreads();
    }
#pragma unroll
    for (int q = 0; q < 2; ++q) { const int nt = nt0 + q;
        st_tile(G1T, mt, nt, mma_nt<64>(NrT + 16 * mt * RB_LD, RB_LD, Tb + 16 * nt * RB_LD, RB_LD, zero4, lane), lane);
        st_tile(G2T, mt, nt, mma_nt<64>(BtT + 16 * mt * RB_LD, RB_LD, Tb + 16 * nt * RB_LD, RB_LD, zero4, lane), lane); }
    __syncthreads();
    const size_t ci = (size_t)(b * 4 + h) * 64 + c;
    bf16_t* gPT = (bf16_t*)(F.ws + WS_MOE + RW_PT) + ci * 4096; bf16_t* gW1 = (bf16_t*)(F.ws + WS_MOE + RW_W1) + ci * 4096; bf16_t* gZ = (bf16_t*)(F.ws + WS_MOE + RW_Z) + ci * 4096;
#pragma unroll
    for (int q = 0; q < 2; ++q) { const int nt = nt0 + q; const int col = 16 * nt + r;
        f32x4 w1 = mma_nt<64>(G1T + 16 * mt * RB_LD, RB_LD, AtT + 16 * nt * RB_LD, RB_LD, zero4, lane);
        f32x4 z = mma_nt<64>(G1T + 16 * mt * RB_LD, RB_LD, Mm + 16 * nt * RB_LD, RB_LD, zero4, lane);
        f32x4 mr = mma_nt<64>(Rt + 16 * mt * RB_LD, RB_LD, Kt + 16 * nt * RB_LD, RB_LD, zero4, lane);
        f32x4 p = mma_nt<64>(G2T + 16 * mt * RB_LD, RB_LD, AtT + 16 * nt * RB_LD, RB_LD, zero4, lane);
        f32x4 qq = mma_nt<64>(G2T + 16 * mt * RB_LD, RB_LD, Mm + 16 * nt * RB_LD, RB_LD, zero4, lane);
        const int pos = 32 * (col >> 5) + 8 * ((col >> 2) & 3) + 4 * ((col >> 4) & 1) + (col & 3);
#pragma unroll
        for (int i = 0; i < 4; ++i) { const int row = 16 * mt + 4 * g4 + i;
            gW1[row * 64 + col] = f2bf(w1[i] + bf2f(Rt[row * RB_LD + col]));
            gZ[row * 64 + col] = f2bf(z[i] + (col <= row ? mr[i] : 0.f));
            const float gc = gC[row];
            gPT[row * 64 + pos] = f2bf((p[i] + (row == col ? 1.0f : 0.f)) * gc);
            qq[i] = (qq[i] + bf2f(Kt[col * RB_LD + row])) * gc; }
        st_tile(QT, mt, nt, qq, lane); }
    __syncthreads();
    bf16_t* gU = (bf16_t*)(F.ws + WS_MOE + RW_U) + ci * 4096;
#pragma unroll
    for (int q = 0; q < 2; ++q) { const int nt = nt0 + q;
        const f32x4 u = mma_nt<64>(VT + 16 * mt * RB_LD, RB_LD, QT + 16 * nt * RB_LD, RB_LD, zero4, lane);
#pragma unroll
        for (int i = 0; i < 4; ++i) gU[(16 * mt + 4 * g4 + i) * 64 + 16 * nt + r] = f2bf(u[i]); }
}
__device__ __forceinline__ void item_rwkv_carry(const Frame& F_, int item) { Frame F = relocal(F_);
    const int bh = item * 2 + (F.wave >> 2), nt = F.wave & 3, r = F.lane & 15, g = F.lane >> 4;
    const bf16_t* PT = (const bf16_t*)(F.ws + WS_MOE + RW_PT); const bf16_t* Uc = (const bf16_t*)(F.ws + WS_MOE + RW_U); bf16_t* Ss = (bf16_t*)(F.ws + WS_MOE + RW_S);
    f32x4 acc[4];
#pragma unroll
    for (int m = 0; m < 4; ++m) acc[m] = (f32x4){0.f, 0.f, 0.f, 0.f};
    for (int c = 0; c < 64; ++c) { const size_t ci = (size_t)bh * 64 + c;
        bf16x8 af[4][2]; f32x4 cin[4];
#pragma unroll
        for (int m = 0; m < 4; ++m) { const u32x2 uv = *(const u32x2*)(Uc + ci * 4096 + (16 * nt + r) * 64 + 16 * m + 4 * g);
            cin[m] = (f32x4){__uint_as_float(uv.x << 16), __uint_as_float(uv.x & 0xffff0000u), __uint_as_float(uv.y << 16), __uint_as_float(uv.y & 0xffff0000u)};
#pragma unroll
            for (int s = 0; s < 2; ++s) af[m][s] = *(const bf16x8*)(PT + ci * 4096 + (16 * m + r) * 64 + 32 * s + 8 * g); }
        unsigned pw[4][2];
#pragma unroll
        for (int m = 0; m < 4; ++m) { pw[m][0] = pk2(acc[m][0], acc[m][1]); pw[m][1] = pk2(acc[m][2], acc[m][3]);
            *(u32x2*)(Ss + ci * 4096 + (16 * nt + r) * 64 + 16 * m + 4 * g) = (u32x2){pw[m][0], pw[m][1]}; }
        bf16x8 bfr[2];
#pragma unroll
        for (int s = 0; s < 2; ++s) bfr[s] = __builtin_bit_cast(bf16x8, (u32x4){pw[2 * s][0], pw[2 * s][1], pw[2 * s + 1][0], pw[2 * s + 1][1]});
#pragma unroll
        for (int m = 0; m < 4; ++m) { acc[m] = __builtin_amdgcn_mfma_f32_16x16x32_bf16(af[m][0], bfr[0], cin[m], 0, 0, 0);
            acc[m] = __builtin_amdgcn_mfma_f32_16x16x32_bf16(af[m][1], bfr[1], acc[m], 0, 0, 0); }
    }
}
__device__ __forceinline__ void item_rwkv3(const Frame& F_, int layer, int item) { Frame F = relocal(F_);
    const int b = item >> 8, h = (item >> 6) & 3, c = item & 63; const size_t T0 = (size_t)b * SEQ + c * 64;
    rwkv_prep<3>(F, layer, b, h, c);
#ifdef PROBE_PREP
    rwkv_prep<3>(F, layer, b, h, c);
#endif
    LAS float* Vv = (LAS float*)(F.lds + RW_V); LAS float* Oo = (LAS float*)(F.lds + R3_O);
    LAS float* Gg = (LAS float*)(F.lds + R3_G); LAS float* BON = (LAS float*)(F.lds + R3_BON);
    LAS bf16_t* S0b = (LAS bf16_t*)(F.lds + R3_TILES); LAS bf16_t* W1b = S0b + 4608; LAS bf16_t* Zb = W1b + 4608; LAS bf16_t* VTb = Zb + 4608;
    { const size_t ci = (size_t)(b * 4 + h) * 64 + c; const int row = F.tid >> 3, col = (F.tid & 7) * 8;
      *(LAS u32x4*)(S0b + row * RB_LD + col) = *(const u32x4*)((const bf16_t*)(F.ws + WS_MOE + RW_S) + ci * 4096 + F.tid * 8);
      *(LAS u32x4*)(W1b + row * RB_LD + col) = *(const u32x4*)((const bf16_t*)(F.ws + WS_MOE + RW_W1) + ci * 4096 + F.tid * 8);
      *(LAS u32x4*)(Zb + row * RB_LD + col) = *(const u32x4*)((const bf16_t*)(F.ws + WS_MOE + RW_Z) + ci * 4096 + F.tid * 8);
      const int vv = F.tid & 63, part = F.tid >> 6;
#pragma unroll
      for (int i = 0; i < 8; ++i) { const int t = 8 * part + i; VTb[vv * RB_LD + t] = f2bf(Vv[t * 64 + vv]); } }
    __syncthreads();
    { const int lane = F.lane, mt = F.wave >> 1, nt0 = 2 * (F.wave & 1), r = lane & 15, g4 = lane >> 4;
#pragma unroll
      for (int q = 0; q < 2; ++q) { const int nt = nt0 + q;
          f32x4 o = mma_nt<64>(W1b + 16 * mt * RB_LD, RB_LD, S0b + 16 * nt * RB_LD, RB_LD, (f32x4){0.f, 0.f, 0.f, 0.f}, lane);
          o = mma_nt<64>(Zb + 16 * mt * RB_LD, RB_LD, VTb + 16 * nt * RB_LD, RB_LD, o, lane);
#pragma unroll
          for (int i = 0; i < 4; ++i) Oo[(16 * mt + 4 * g4 + i) * 64 + 16 * nt + r] = o[i]; } }
    __syncthreads();
    { const int j = F.lane, tq = F.wave, ch = h * 64 + j;
      const float lw = F.in[I_RLNW][layer * 256 + ch], lb = F.in[I_RLNB][layer * 256 + ch];
      bf16_t* Y = (bf16_t*)(F.ws + WS_H);
#pragma unroll 2
      for (int i8 = 0; i8 < 8; ++i8) { const int t = tq + 8 * i8;
          const float o = Oo[t * 64 + j]; const float mean = wave_sum(o) * (1.0f / 64.0f); const float d = o - mean; const float var = wave_sum(d * d) * (1.0f / 64.0f);
          float on = d * rsqrtf(var + 64e-5f) * lw + lb; on += BON[t] * Vv[t * 64 + j];
          Y[(T0 + t) * DM + 256 + ch] = f2bf(on * Gg[t * 64 + j]); } }
}

constexpr int DS_SEL = 131072, DS_HIST = 135168, DS_BKT = 151552, DS_BIAS = 152064;
__device__ __forceinline__ unsigned fkey(float f) { const unsigned u = __float_as_uint(f); return (u & 0x80000000u) ? ~u : (u | 0x80000000u); }
__device__ __forceinline__ void item_dsa(const Frame& F_, int layer, int item) { Frame F = relocal(F_);
    const bf16_t* U = (const bf16_t*)(F.ws + WS_U); const bf16_t* KI = (const bf16_t*)(F.ws + WS_KIDX);
    const bf16_t* Kb = (const bf16_t*)(F.ws + WS_K); const bf16_t* Vb = (const bf16_t*)(F.ws + WS_V);
    const int b = item & 3, qg = 511 - (item >> 2); const size_t TB = (size_t)b * SEQ, T0 = TB + qg * 8;
    LAS float* sc = (LAS float*)F.lds; LAS unsigned short* selall = (LAS unsigned short*)(F.lds + DS_SEL); LAS unsigned* histall = (LAS unsigned*)(F.lds + DS_HIST);
    LAS int* bkt = (LAS int*)(F.lds + DS_BKT); LAS float* biasT = (LAS float*)(F.lds + DS_BIAS);
    if (F.tid < 128) { const int n = F.tid; int bk = n; if (n >= 16) { const float lr = logf((float)n / 16.0f) / 2.0794415416798357f; bk = 16 + (int)(lr * 16.0f); bk = bk < 31 ? bk : 31; } bkt[n] = bk; biasT[n] = F.in[I_RELB][n]; }
    const int lane = F.lane, hh = lane >> 5;
    {
        bf16x8 af[2][2]; float wq[2][2][8];
        { const int r = lane & 31, q4 = 2 * ((r >> 2) & 1) + (r >> 4), head = 4 * ((r >> 3) & 1) + (r & 3);
#pragma unroll
          for (int mt = 0; mt < 2; ++mt)
#pragma unroll
              for (int ks = 0; ks < 2; ++ks) af[mt][ks] = *(const bf16x8*)(U + (T0 + 4 * mt + q4) * NINP + UC + 384 + head * 32 + 16 * ks + 8 * hh); }
#pragma unroll
        for (int mt = 0; mt < 2; ++mt)
#pragma unroll
            for (int q2 = 0; q2 < 2; ++q2) { float f[8]; unpack8(*(const u32x4*)(U + (T0 + 4 * mt + 2 * hh + q2) * NINP + UC + 672), f);
#pragma unroll
                for (int hd = 0; hd < 8; ++hd) wq[mt][q2][hd] = f[hd]; }
        const int ntile = (qg * 8 + 8 + 31) >> 5;
        bf16x8 nb0 = af[0][0], nb1 = af[0][0];
        if (F.wave < ntile) { const int key = F.wave * 32 + (lane & 31); nb0 = *(const bf16x8*)(KI + (TB + key) * 32 + 8 * hh); nb1 = *(const bf16x8*)(KI + (TB + key) * 32 + 16 + 8 * hh); }
        for (int kt = F.wave; kt < ntile; kt += 8) {
            const int key = kt * 32 + (lane & 31);
            const bf16x8 b0 = nb0, b1 = nb1;
            if (kt + 8 < ntile) { const int k2 = key + 256; nb0 = *(const bf16x8*)(KI + (TB + k2) * 32 + 8 * hh); nb1 = *(const bf16x8*)(KI + (TB + k2) * 32 + 16 + 8 * hh); }
#pragma unroll
            for (int mt = 0; mt < 2; ++mt) { f32x16 acc;
#pragma unroll
                for (int i = 0; i < 16; ++i) acc[i] = 0.f;
                acc = __builtin_amdgcn_mfma_f32_32x32x16_bf16(af[mt][0], b0, acc, 0, 0, 0);
                acc = __builtin_amdgcn_mfma_f32_32x32x16_bf16(af[mt][1], b1, acc, 0, 0, 0);
#pragma unroll
                for (int q2 = 0; q2 < 2; ++q2) { float s = 0.f;
#pragma unroll
                    for (int hd = 0; hd < 8; ++hd) s += fmaxf(acc[8 * q2 + hd], 0.f) * wq[mt][q2][hd];
                    const int qi = 4 * mt + 2 * hh + q2;
                    sc[qi * 4096 + key] = (key <= qg * 8 + qi) ? s : -INFINITY; } }
        }
    }
    __syncthreads();
    const int qi = F.wave, tq = qg * 8 + qi, n = tq + 1;
    LAS float* scq = sc + qi * 4096; LAS unsigned short* sel = selall + qi * 256; LAS unsigned* hist = histall + qi * 512;
    int nsel;
    if (n <= 256) { nsel = n; for (int j = lane; j < 256; j += 64) sel[j] = (unsigned short)(j < n ? j : 0); }
    else {
        nsel = 256;
        const int R = (n + 63) >> 6; const unsigned long long ltm = (1ull << lane) - 1ull;
        float lo = INFINITY, hi = -INFINITY;
        const int R4 = (n + 255) >> 8;
#pragma unroll 4
        for (int i = 0; i < R4; ++i) { const int j0 = 256 * i + 4 * lane; const f32x4 v4 = *(const LAS f32x4*)(scq + j0);
#pragma unroll
            for (int q = 0; q < 4; ++q) { const bool valid = j0 + q < n; lo = fminf(lo, valid ? v4[q] : INFINITY); hi = fmaxf(hi, valid ? v4[q] : -INFINITY); } }
#pragma unroll
        for (int o = 1; o < 64; o <<= 1) { lo = fminf(lo, shx(lo, o)); hi = fmaxf(hi, shx(hi, o)); }
        bool slow = false;
        if (!(hi > lo)) { for (int j = lane; j < 256; j += 64) sel[j] = (unsigned short)j; }
        else {
            const float scale = 1023.0f / (hi - lo);
            *(LAS u32x4*)(hist + 8 * lane) = (u32x4){0u, 0u, 0u, 0u}; *(LAS u32x4*)(hist + 8 * lane + 4) = (u32x4){0u, 0u, 0u, 0u};
#pragma unroll 2
            for (int i = 0; i < R4; ++i) { const int j0 = 256 * i + 4 * lane; const f32x4 v4 = *(const LAS f32x4*)(scq + j0);
#pragma unroll
                for (int q = 0; q < 4; ++q) { if (j0 + q < n) { int bk = (int)((v4[q] - lo) * scale); bk = bk < 1023 ? bk : 1023;
                    atomicAdd((unsigned*)(hist + (bk >> 1)), (bk & 1) ? 65536u : 1u); } } }
            const u32x4 h0 = *(const LAS u32x4*)(hist + 8 * lane), h1 = *(const LAS u32x4*)(hist + 8 * lane + 4);
            unsigned cb[16];
            cb[0] = h0.x & 0xffffu; cb[1] = h0.x >> 16; cb[2] = h0.y & 0xffffu; cb[3] = h0.y >> 16; cb[4] = h0.z & 0xffffu; cb[5] = h0.z >> 16; cb[6] = h0.w & 0xffffu; cb[7] = h0.w >> 16;
            cb[8] = h1.x & 0xffffu; cb[9] = h1.x >> 16; cb[10] = h1.y & 0xffffu; cb[11] = h1.y >> 16; cb[12] = h1.z & 0xffffu; cb[13] = h1.z >> 16; cb[14] = h1.w & 0xffffu; cb[15] = h1.w >> 16;
            unsigned tot = 0u;
#pragma unroll
            for (int q = 0; q < 16; ++q) tot += cb[q];
            unsigned incl = tot;
#pragma unroll
            for (int o = 1; o < 64; o <<= 1) { const unsigned t = shdown_u(incl, o); if (lane + o < 64) incl += t; }
            int fb = -1; unsigned fabove = 0u, fcnt = 0u; unsigned cum = incl - tot;
#pragma unroll
            for (int q = 15; q >= 0; --q) { if (fb < 0 && cum < 256u && 256u <= cum + cb[q]) { fb = 16 * lane + q; fabove = cum; fcnt = cb[q]; } cum += cb[q]; }
            const unsigned long long mf = __ballot(fb >= 0); const int src = (int)__ffsll((long long)mf) - 1;
            const int B = shidx_i(fb, src); const int above = shidx_i((int)fabove, src), cntB = shidx_i((int)fcnt, src); const int need = 256 - above;
            if (cntB > 256) slow = true;
            else {
                LAS unsigned* cand = hist;
                int base_gt = 0, base_c = 0;
#pragma unroll 2
                for (int i = 0; i < R4; ++i) { const int j0 = 256 * i + 4 * lane; const f32x4 v4 = *(const LAS f32x4*)(scq + j0);
#pragma unroll
                    for (int q = 0; q < 4; ++q) { const int j = j0 + q; const bool valid = j < n; const float v = valid ? v4[q] : lo;
                        int bk = (int)((v - lo) * scale); bk = bk < 1023 ? bk : 1023;
                        const bool gt = valid && bk > B, eq = valid && bk == B;
                        const unsigned long long mg = __ballot(gt), me = __ballot(eq);
                        if (gt) sel[base_gt + __popcll(mg & ltm)] = (unsigned short)j;
                        if (eq) { const int p = base_c + __popcll(me & ltm); cand[2 * p] = fkey(v); cand[2 * p + 1] = (unsigned)j; }
                        base_gt += __popcll(mg); base_c += __popcll(me); } }
                if (need == cntB) { for (int c = lane; c < cntB; c += 64) sel[above + c] = (unsigned short)cand[2 * c + 1]; }
                else {
                    unsigned ck[4], cx[4]; int rk[4];
#pragma unroll
                    for (int q = 0; q < 4; ++q) { const int c = lane + 64 * q; ck[q] = c < cntB ? cand[2 * c] : 0u; cx[q] = c < cntB ? cand[2 * c + 1] : 0u; rk[q] = 0; }
                    for (int c2 = 0; c2 < cntB; ++c2) { const unsigned k2 = cand[2 * c2], x2 = cand[2 * c2 + 1];
#pragma unroll
                        for (int q = 0; q < 4; ++q) rk[q] += (k2 > ck[q] || (k2 == ck[q] && x2 < cx[q])) ? 1 : 0; }
#pragma unroll
                    for (int q = 0; q < 4; ++q) { const int c = lane + 64 * q; if (c < cntB && rk[q] < need) sel[above + rk[q]] = (unsigned short)cand[2 * c + 1]; }
                }
            }
        }
        if (slow) {
        unsigned prefix = 0u; int need = 256; unsigned neq = 0u;
        for (int p = 0; p < 4; ++p) { const int shift = 24 - 8 * p;
            *(LAS u32x4*)(hist + 4 * lane) = (u32x4){0u, 0u, 0u, 0u};
            for (int i = 0; i < R; ++i) { const int j = lane + 64 * i; if (j < n) { const unsigned u = fkey(scq[j]);
                if (p == 0 || (u >> (shift + 8)) == prefix) atomicAdd((unsigned*)(hist + ((u >> shift) & 255u)), 1u); } }
            const u32x4 hv = *(const LAS u32x4*)(hist + 4 * lane);
            const unsigned tot = hv.x + hv.y + hv.z + hv.w;
            unsigned incl = tot;
#pragma unroll
            for (int o = 1; o < 64; o <<= 1) { const unsigned t = shdown_u(incl, o); if (lane + o < 64) incl += t; }
            const unsigned above = incl - tot;
            int fb = -1; unsigned fabove = 0u, feq = 0u; unsigned cum = above;
            { const unsigned hq[4] = {hv.x, hv.y, hv.z, hv.w};
#pragma unroll
              for (int q = 3; q >= 0; --q) { if (fb < 0 && cum < (unsigned)need && (unsigned)need <= cum + hq[q]) { fb = 4 * lane + q; fabove = cum; feq = hq[q]; } cum += hq[q]; } }
            const unsigned long long m = __ballot(fb >= 0);
            const int src = (int)__ffsll((long long)m) - 1;
            const int bin = shidx_i(fb, src); const unsigned ab = (unsigned)shidx_i((int)fabove, src); neq = (unsigned)shidx_i((int)feq, src);
            need -= (int)ab; prefix = (prefix << 8) | (unsigned)bin;
        }
        const int ngt = 256 - need;
        int base_gt = 0, base_eq = 0;
        for (int i = 0; i < R; ++i) { const int j = lane + 64 * i; const unsigned u = (j < n) ? fkey(scq[j]) : 0u;
            const bool gt = (j < n) && (u > prefix), eq = (j < n) && (u == prefix);
            const unsigned long long mg = __ballot(gt), me = __ballot(eq); const unsigned long long lt = (1ull << lane) - 1ull;
            if (gt) sel[base_gt + __popcll(mg & lt)] = (unsigned short)j;
            if (eq) { const int rk = base_eq + __popcll(me & lt); if (rk < need) sel[ngt + rk] = (unsigned short)j; }
            base_gt += __popcll(mg); base_eq += __popcll(me); }
        (void)neq;
            }
    }
    const int nt16 = (nsel + 15) >> 4, r16 = lane & 15, g4 = lane >> 4;
    LAS float* biasj = scq + 2048;
#pragma unroll
    for (int q = 0; q < 4; ++q) { const int j = lane + 64 * q; f32x4 bv = (f32x4){-INFINITY, -INFINITY, -INFINITY, -INFINITY};
        if (j < nsel) { const int dist = tq - (int)sel[j]; const int bk = dist < 128 ? bkt[dist < 0 ? 0 : dist] : 31; bv = *(const LAS f32x4*)(biasT + 4 * bk); }
        *(LAS f32x4*)(biasj + 4 * j) = bv; }
    bf16x8 qf[2];
#pragma unroll
    for (int s = 0; s < 2; ++s) { u32x4 z = (u32x4){0u, 0u, 0u, 0u}; if (r16 < 4) z = *(const u32x4*)(U + (T0 + qi) * NINP + UC + r16 * 64 + 32 * s + 8 * g4); qf[s] = __builtin_bit_cast(bf16x8, z); }
    float lg[16][4]; float mx = -INFINITY;
#define DSA_QK(M0, NM) do { int keyr[NM]; bf16x8 a0[NM], a1[NM]; \
        _Pragma("unroll") for (int m8 = 0; m8 < NM; ++m8) keyr[m8] = sel[16 * ((M0) + m8) + r16]; \
        _Pragma("unroll") for (int m8 = 0; m8 < NM; ++m8) { a0[m8] = *(const bf16x8*)(Kb + (TB + keyr[m8]) * 64 + 8 * g4); a1[m8] = *(const bf16x8*)(Kb + (TB + keyr[m8]) * 64 + 32 + 8 * g4); } \
        _Pragma("unroll") for (int m8 = 0; m8 < NM; ++m8) { const int m = (M0) + m8; \
            f32x4 acc = (f32x4){0.f, 0.f, 0.f, 0.f}; \
            acc = __builtin_amdgcn_mfma_f32_16x16x32_bf16(a0[m8], qf[0], acc, 0, 0, 0); \
            acc = __builtin_amdgcn_mfma_f32_16x16x32_bf16(a1[m8], qf[1], acc, 0, 0, 0); \
            _Pragma("unroll") for (int i = 0; i < 4; ++i) { const float v = acc[i] * 0.125f + biasj[(16 * m + 4 * g4 + i) * 4 + (r16 & 3)]; lg[m][i] = v; mx = fmaxf(mx, v); } } } while (0)
    if (nt16 > 8) { DSA_QK(0, 16); }
    else { DSA_QK(0, 8);
#pragma unroll
        for (int m8 = 8; m8 < 16; ++m8)
#pragma unroll
            for (int i = 0; i < 4; ++i) lg[m8][i] = -INFINITY; }
#undef DSA_QK
    mx = fmaxf(mx, shx(mx, 16)); mx = fmaxf(mx, shx(mx, 32));
    float sm = 0.f;
#pragma unroll
    for (int m = 0; m < 16; ++m)
#pragma unroll
        for (int i = 0; i < 4; ++i) { const float p = __expf(lg[m][i] - mx); lg[m][i] = p; sm += p; }
    sm += shx(sm, 16); sm += shx(sm, 32);
    f32x4 ov[4];
#pragma unroll
    for (int nt = 0; nt < 4; ++nt) ov[nt] = (f32x4){0.f, 0.f, 0.f, 0.f};
    const unsigned vs_base = (unsigned)(unsigned long)scq;
#pragma unroll
    for (int half = 0; half < 2; ++half) {
        if (half * 8 < nt16) {
            asm volatile("s_waitcnt lgkmcnt(0)" ::: "memory");
            int vkey[16];
#pragma unroll
            for (int q = 0; q < 16; ++q) { const int rho = 8 * q + (lane >> 3);
                vkey[q] = sel[half * 128 + (rho & ~31) + 16 * ((rho >> 2) & 1) + 4 * ((rho >> 3) & 3) + (rho & 3)]; }
            asm volatile("s_waitcnt lgkmcnt(0)" : "+v"(vkey[0]), "+v"(vkey[1]), "+v"(vkey[2]), "+v"(vkey[3]), "+v"(vkey[4]), "+v"(vkey[5]), "+v"(vkey[6]), "+v"(vkey[7]),
                         "+v"(vkey[8]), "+v"(vkey[9]), "+v"(vkey[10]), "+v"(vkey[11]), "+v"(vkey[12]), "+v"(vkey[13]), "+v"(vkey[14]), "+v"(vkey[15]) :: "memory");
#pragma unroll
            for (int q = 0; q < 16; ++q)
                __builtin_amdgcn_global_load_lds((const unsigned*)(Vb + (TB + vkey[q]) * 64 + 8 * (lane & 7)), (LAS unsigned*)((LAS unsigned char*)scq + q * 1024), 16, 0, 0);
            asm volatile("s_waitcnt vmcnt(0)" ::: "memory");
#pragma unroll
            for (int s4 = 0; s4 < 4; ++s4) { const int s = half * 4 + s4;
                u32x4 pw; pw.x = pk2(lg[2 * s][0], lg[2 * s][1]); pw.y = pk2(lg[2 * s][2], lg[2 * s][3]); pw.z = pk2(lg[2 * s + 1][0], lg[2 * s + 1][1]); pw.w = pk2(lg[2 * s + 1][2], lg[2 * s + 1][3]);
                const bf16x8 pa = __builtin_bit_cast(bf16x8, pw);
                const unsigned ad = vs_base + (unsigned)((32 * s4 + 8 * g4 + (r16 >> 2)) * 128 + (r16 & 3) * 8);
                u32x2 t0[4], t1[4];
                asm volatile("ds_read_b64_tr_b16 %0, %8\n\tds_read_b64_tr_b16 %1, %8 offset:512\n\tds_read_b64_tr_b16 %2, %8 offset:32\n\tds_read_b64_tr_b16 %3, %8 offset:544\n\t"
                             "ds_read_b64_tr_b16 %4, %8 offset:64\n\tds_read_b64_tr_b16 %5, %8 offset:576\n\tds_read_b64_tr_b16 %6, %8 offset:96\n\tds_read_b64_tr_b16 %7, %8 offset:608\n\ts_waitcnt lgkmcnt(0)"
                             : "=&v"(t0[0]), "=&v"(t1[0]), "=&v"(t0[1]), "=&v"(t1[1]), "=&v"(t0[2]), "=&v"(t1[2]), "=&v"(t0[3]), "=&v"(t1[3]) : "v"(ad) : "memory");
#pragma unroll
                for (int nt = 0; nt < 4; ++nt) { const bf16x8 vb = __builtin_bit_cast(bf16x8, (u32x4){t0[nt].x, t0[nt].y, t1[nt].x, t1[nt].y});
                    ov[nt] = __builtin_amdgcn_mfma_f32_16x16x32_bf16(pa, vb, ov[nt], 0, 0, 0); } }
        }
    }
    { float inv[4];
#pragma unroll
      for (int h = 0; h < 4; ++h) inv[h] = 1.0f / __int_as_float(__builtin_amdgcn_readlane(__float_as_int(sm), h));
      if (lane < 16) { bf16_t* Y = (bf16_t*)(F.ws + WS_H) + (T0 + qi) * DM + 512 + r16;
#pragma unroll
          for (int h = 0; h < 4; ++h)
#pragma unroll
              for (int nt = 0; nt < 4; ++nt) Y[h * 64 + 16 * nt] = f2bf(ov[nt][h] * inv[h]); } }
}

__device__ __forceinline__ void phase_router(const Frame& F_, int layer) { Frame F = relocal(F_); const int cset = layer;
    const float* X = (const float*)(F.ws + WS_X);
    const bf16_t* WH = (const bf16_t*)(F.ws + WS_WRT) + (size_t)layer * 2 * 49152; const bf16_t* WL = WH + 49152;
    LAS float* part = (LAS float*)F.lds;
    LAS float* ssq = (LAS float*)(F.lds + 24576);
    LAS int* es = (LAS int*)(F.lds + 25088);
    LAS int* lr = (LAS int*)(F.lds + 25600);
    LAS float* wsl = (LAS float*)(F.lds + 26112);
    LAS float* rsd = (LAS float*)(F.lds + 26624);
    for (int blk = F.bid; blk < NTOK / 64; blk += F.G) {
        __syncthreads();
        const int mt = F.wave & 3, kh = F.wave >> 2, r16 = F.lane & 15, g4 = F.lane >> 4;
        const float* xr = X + ((size_t)blk * 64 + mt * 16 + r16) * DM + kh * 512 + 8 * g4;
        f32x4 acc[3]; acc[0] = acc[1] = acc[2] = (f32x4){0.f, 0.f, 0.f, 0.f}; float ss = 0.f;
#pragma unroll 4
        for (int ks = 0; ks < 16; ++ks) {
            const f32x4 xa = *(const f32x4*)(xr + ks * 32), xb = *(const f32x4*)(xr + ks * 32 + 4);
            ss += xa[0] * xa[0] + xa[1] * xa[1] + xa[2] * xa[2] + xa[3] * xa[3] + xb[0] * xb[0] + xb[1] * xb[1] + xb[2] * xb[2] + xb[3] * xb[3];
            float xv[8] = {xa[0], xa[1], xa[2], xa[3], xb[0], xb[1], xb[2], xb[3]}; unsigned hw[4], lw[4];
#pragma unroll
            for (int j = 0; j < 4; ++j) { const bf16_t h0 = f2bf(xv[2 * j]), h1 = f2bf(xv[2 * j + 1]); hw[j] = (unsigned)h0 | ((unsigned)h1 << 16);
                lw[j] = pk2(xv[2 * j] - bf2f(h0), xv[2 * j + 1] - bf2f(h1)); }
            const bf16x8 ahi = __builtin_bit_cast(bf16x8, (u32x4){hw[0], hw[1], hw[2], hw[3]}), alo = __builtin_bit_cast(bf16x8, (u32x4){lw[0], lw[1], lw[2], lw[3]});
#pragma unroll
            for (int nt = 0; nt < 3; ++nt) { const size_t wo = (size_t)(nt * 16 + r16) * 1024 + kh * 512 + ks * 32 + 8 * g4;
                const bf16x8 bh = *(const bf16x8*)(WH + wo), bl = *(const bf16x8*)(WL + wo);
                acc[nt] = __builtin_amdgcn_mfma_f32_16x16x32_bf16(ahi, bh, acc[nt], 0, 0, 0);
                acc[nt] = __builtin_amdgcn_mfma_f32_16x16x32_bf16(ahi, bl, acc[nt], 0, 0, 0);
                acc[nt] = __builtin_amdgcn_mfma_f32_16x16x32_bf16(alo, bh, acc[nt], 0, 0, 0); }
        }
        ss += shx(ss, 16); ss += shx(ss, 32);
        if (g4 == 0) ssq[kh * 64 + mt * 16 + r16] = ss;
#pragma unroll
        for (int nt = 0; nt < 3; ++nt)
#pragma unroll
            for (int i = 0; i < 4; ++i) part[(kh * 64 + mt * 16 + 4 * g4 + i) * 48 + nt * 16 + r16] = acc[nt][i];
        __syncthreads();
        if (F.tid < 64) { const float rstd = rsqrtf((ssq[F.tid] + ssq[64 + F.tid]) * (1.0f / DM) + 1e-6f); rsd[F.tid] = rstd;
            float l[36];
#pragma unroll
            for (int o = 0; o < 36; ++o) l[o] = (part[F.tid * 48 + o] + part[(64 + F.tid) * 48 + o]) * rstd + (o < 32 ? F.in[I_BRE][layer * 32 + o] : F.in[I_BRG][layer * 4 + o - 32]);
            int gs = 0; float gm = l[32];
#pragma unroll
            for (int j = 1; j < 4; ++j) if (l[32 + j] > gm) { gm = l[32 + j]; gs = j; }
            float den = 0.f;
#pragma unroll
            for (int j = 0; j < 4; ++j) den += __expf(l[32 + j] - gm);
            const float gate = 1.0f / den;
            float e8[8];
#pragma unroll
            for (int j = 0; j < 8; ++j) e8[j] = gs == 0 ? l[j] : gs == 1 ? l[8 + j] : gs == 2 ? l[16 + j] : l[24 + j];
            int i1 = 0; float v1 = e8[0];
#pragma unroll
            for (int j = 1; j < 8; ++j) if (e8[j] > v1) { v1 = e8[j]; i1 = j; }
            int i2 = -1; float v2 = -INFINITY;
#pragma unroll
            for (int j = 0; j < 8; ++j) if (j != i1 && e8[j] > v2) { v2 = e8[j]; i2 = j; }
            const float e2 = __expf(v2 - v1); const float p1 = 1.0f / (1.0f + e2);
            es[F.tid * 2] = gs * 8 + i1; es[F.tid * 2 + 1] = gs * 8 + i2; wsl[F.tid * 2] = p1 * gate; wsl[F.tid * 2 + 1] = (1.0f - p1) * gate; }
        __syncthreads();
        if (F.tid < 32) { int cnt = 0; for (int i = 0; i < 128; ++i) if (es[i] == F.tid) lr[i] = cnt++;
            if (cnt) { const int base = (int)__hip_atomic_fetch_add(F.ctl + CW_CNT + cset * 32 + F.tid, (unsigned)cnt, __ATOMIC_RELAXED, __HIP_MEMORY_SCOPE_AGENT);
                for (int i = 0; i < 128; ++i) if (es[i] == F.tid) lr[i] += base; } }
        __syncthreads();
        if (F.tid < 64) { int* rt = (int*)(F.ws + WS_ROUTE) + ((size_t)blk * 64 + F.tid) * 8;
            rt[0] = es[F.tid * 2]; rt[1] = es[F.tid * 2 + 1]; ((float*)rt)[2] = wsl[F.tid * 2]; ((float*)rt)[3] = wsl[F.tid * 2 + 1]; rt[4] = lr[F.tid * 2]; rt[5] = lr[F.tid * 2 + 1]; ((float*)rt)[6] = rsd[F.tid]; }
    }
    __syncthreads();
    if (F.tid == 0) __hip_atomic_fetch_add(F.ctl + CW_RB + 64 * layer, 1u, __ATOMIC_RELAXED, __HIP_MEMORY_SCOPE_AGENT);
}
__device__ __forceinline__ void phase_moe_convert(const Frame& F_, int layer) { Frame F = relocal(F_);
    bf16_t* WGU = (bf16_t*)(F.ws + WS_MOE + MOE_WGU); bf16_t* WD = (bf16_t*)(F.ws + WS_MOE + MOE_WD);
    for (int t = F.bid; t < 1536; t += F.G) {
        if (t < 1024) { const int e = t >> 5, r = t & 31, kt = r >> 1, nt = r & 1; const size_t eo = ((size_t)layer * 32 + e) * 1024 * 256;
            tr_tile(F, 256, WGU + (size_t)e * 512 * 1024, 1024, kt * 64, nt * 256, SmGU{F.in[I_WGATE] + eo, F.in[I_WUP] + eo}); }
        else { const int q = t - 1024, e = q >> 4, r = q & 15, kt = r >> 2, nt = r & 3;
            tr_tile(F, 1024, WD + (size_t)e * 1024 * 256, 256, kt * 64, nt * 256, SmId{F.in[I_WDOWN] + ((size_t)layer * 32 + e) * 256 * 1024}); }
    }
}
__device__ __forceinline__ void phase_gather(const Frame& F_, int layer) { Frame F = relocal(F_);
    LAS int* off = (LAS int*)F.lds;
    __syncthreads();
    if (F.tid == 0) { unsigned sp = 0;
        while (__hip_atomic_load(F.ctl + CW_RB + 64 * layer, __ATOMIC_RELAXED, __HIP_MEMORY_SCOPE_AGENT) < (unsigned)F.G) { __builtin_amdgcn_s_sleep(2); if (++sp > (1u << 22)) break; } }
    __syncthreads();
    if (F.tid == 0) { int acc = 0; for (int e = 0; e < 32; ++e) { off[e] = acc; const int c = (int)__hip_atomic_load(F.ctl + CW_CNT + layer * 32 + e, __ATOMIC_RELAXED, __HIP_MEMORY_SCOPE_AGENT); acc += (c + 255) & ~255; } off[32] = acc; }
    __syncthreads();
    int* tiles = (int*)(F.ws + WS_TILES); int* row_tok = (int*)(F.ws + WS_ROWS); float* row_w = (float*)(F.ws + WS_ROWS) + MAXROWS;
    if (F.bid == 0) { if (F.tid == 0) tiles[0] = off[32] >> 8; if (F.tid < 33) tiles[1 + F.tid] = off[F.tid];
        if (F.tid < 32) for (int rt = off[F.tid] >> 8; rt < (off[F.tid + 1] >> 8); ++rt) tiles[64 + rt] = F.tid; }
    for (int e = F.bid; e < 32; e += F.G) { const int c = (int)__hip_atomic_load(F.ctl + CW_CNT + layer * 32 + e, __ATOMIC_RELAXED, __HIP_MEMORY_SCOPE_AGENT);
        for (int r = off[e] + c + F.tid; r < off[e + 1]; r += NTHR) { row_tok[r] = -1; row_w[r] = 0.f; } }
    const float* X = (const float*)(F.ws + WS_X); bf16_t* HP = (bf16_t*)(F.ws + WS_U); const float* nw = F.in[I_NORM2] + (size_t)layer * DM;
    f32x4 nwv[4];
#pragma unroll
    for (int j = 0; j < 4; ++j) nwv[j] = *(const f32x4*)(nw + 4 * F.lane + 256 * j);
    for (int blk = F.bid; blk < NTOK / 64; blk += F.G)
    for (int i8 = 0; i8 < 8; ++i8) { const int t = blk * 64 + F.wave * 8 + i8;
        const int* rt = (const int*)(F.ws + WS_ROUTE) + (size_t)t * 8; const float rstd = ((const float*)rt)[6];
        const int p0 = off[rt[0]] + rt[4], p1 = off[rt[1]] + rt[5];
#pragma unroll
        for (int j = 0; j < 4; ++j) { const int c = 4 * F.lane + 256 * j; const f32x4 v = *(const f32x4*)(X + (size_t)t * DM + c) * rstd * nwv[j];
            u32x2 o; o.x = pk2(v[0], v[1]); o.y = pk2(v[2], v[3]);
            *(u32x2*)(HP + (size_t)p0 * DM + c) = o; *(u32x2*)(HP + (size_t)p1 * DM + c) = o; }
        if (F.lane == 0) { row_tok[p0] = t * 2; row_w[p0] = ((const float*)rt)[2]; row_tok[p1] = t * 2 + 1; row_w[p1] = ((const float*)rt)[3]; }
    }
}

constexpr int NPH_LAYER = 9, NPHASE = 1 + 2 * NPH_LAYER + 1;
#ifndef MK_ONLY
#define MK_ONLY -1
#endif
#ifndef MK_ITEM
#define MK_ITEM -1
#endif
#define EN(o) (MK_ONLY < 0 || MK_ONLY == (o))
#define IT(o) (MK_ITEM < 0 || MK_ITEM == (o))
__global__ void __launch_bounds__(NTHR, 2) mk_forward(Params P) {
    extern __shared__ __attribute__((aligned(16))) unsigned char lds_raw[];
    Frame F; F.lds = (LAS unsigned char*)lds_raw; F.tid = threadIdx.x; F.lane = F.tid & 63; F.wave = __builtin_amdgcn_readfirstlane(F.tid >> 6); F.bid = blockIdx.x; F.G = gridDim.x;
    F.in = (in_tab_t)__builtin_amdgcn_kernarg_segment_ptr(); F.out = P.out; F.ws = P.ws; F.ctl = (unsigned*)(P.ws + WS_CTL); F.misc = (volatile LAS int*)(F.lds + MISC_OFF);
    if (F.tid < 64) ((LAS unsigned*)(F.lds + MISC_OFF))[F.tid] = 0u;
    __syncthreads();
    const int lo = P.ph_lo, hi = P.ph_hi;
    XcdBarrier bar; bar.bar = F.ctl + CW_BAR; bar.x = 0; bar.st = (volatile LAS unsigned*)(F.lds + MISC_OFF + 16);
    if (hi - lo > 1) bar = xcd_barrier_post(F.ctl + CW_BAR, (volatile LAS unsigned*)(F.lds + MISC_OFF + 16));
#define IN(k) (lo <= (k) && (k) < hi)
#define SEAM(k) do { if (IN(k) && IN((k) + 1)) xcd_barrier(bar); } while (0)
#define QLOOP(qi, n, body) for (;;) { const int it = q_pop(F, layer * 12 + (qi)); if (it >= (n)) break; body; }
    if (EN(100) && IN(0)) { phase_prologue(F); phase_norm(F, F.in[I_X], false, F.in[I_NORM1], 0); } SEAM(0);
#pragma unroll
    for (int layer = 0; layer < DEPTH; ++layer) {
        const int pb = 1 + layer * NPH_LAYER;
        if (layer > 0) { if (EN(0) && IN(pb + 0)) { phase_norm(F, (const float*)(F.ws + WS_X), true, F.in[I_NORM1] + (size_t)layer * DM, 0); } SEAM(pb + 0); }
        if (EN(1) && IN(pb + 1)) { const Frame F_ = F; Frame F = relocal(F_); pg8::StaticOrder S; S.init((const bf16_t*)(F.ws + WS_H), (const bf16_t*)(F.ws + WS_WIN) + (size_t)layer * NINP * DM, NTOK, NINP, DM, F.G, F.bid);
            pg8::EpiBf16 E{(bf16_t*)(F.ws + WS_U), NINP}; pg8::gemm_phase(F.lds, DM, S, E); } SEAM(pb + 1);
        if (EN(2) && IN(pb + 2)) {
            if (IT(0)) QLOOP(0, 256, item_s5<1>(F, layer, it));
            if (IT(1)) QLOOP(1, 1024, item_rwkv1(F, layer, it));
            if (IT(2)) QLOOP(2, 256, item_mamba<1>(F, layer, it));
            if (IT(3)) QLOOP(3, 256, item_kv(F, layer, it));
        } SEAM(pb + 2);
        if (EN(3) && IN(pb + 3)) {
            if (IT(0)) QLOOP(4, 8, item_rwkv_carry(F, it));
            if (IT(1)) QLOOP(5, 16, item_mamba_carry(F, it));
            if (IT(2)) QLOOP(6, 4, item_s5_carry(F, layer, it));
            if (IT(3)) QLOOP(7, 2048, item_dsa(F, layer, it));
        } SEAM(pb + 3);
        if (EN(4) && IN(pb + 4)) {
            if (IT(0)) QLOOP(8, 256, item_s5<2>(F, layer, it));
            if (IT(1)) QLOOP(9, 1024, item_rwkv3(F, layer, it));
            if (IT(2)) QLOOP(10, 256, item_mamba<2>(F, layer, it));
        } SEAM(pb + 4);
        if (EN(6) && IN(pb + 5)) { const Frame F_ = F; Frame F = relocal(F_); pg8::StaticOrder S; S.init((const bf16_t*)(F.ws + WS_H), (const bf16_t*)(F.ws + WS_WOUT) + (size_t)layer * DM * DM, NTOK, DM, DM, F.G, F.bid);
            pg8::EpiResid E{(float*)(F.ws + WS_X), DM}; pg8::gemm_phase(F.lds, DM, S, E); } SEAM(pb + 5);
        if (EN(7) && IN(pb + 6)) { phase_router(F, layer); phase_moe_convert(F, layer); phase_gather(F, layer); } SEAM(pb + 6);
        if (EN(8) && IN(pb + 7)) { const Frame F_ = F; Frame F = relocal(F_); pg8::MoeOrder S{2, F.G, F.bid, DM, (const char*)(F.ws + WS_U), (const char*)(F.ws + WS_MOE + MOE_WGU), (size_t)512 * 1024 * 2, (const int*)(F.ws + WS_TILES)};
            pg8::EpiGated<1> E{(bf16_t*)(F.ws + WS_H), 256, 0, nullptr, nullptr}; pg8::gemm_phase(F.lds, DM, S, E); } SEAM(pb + 7);
        if (EN(9) && IN(pb + 8)) { const Frame F_ = F; Frame F = relocal(F_); pg8::MoeOrder S{4, F.G, F.bid, 256, (const char*)(F.ws + WS_H), (const char*)(F.ws + WS_MOE + MOE_WD), (size_t)1024 * 256 * 2, (const int*)(F.ws + WS_TILES)};
            pg8::EpiMoeOut E{(bf16_t*)(F.ws + WS_U), (const int*)(F.ws + WS_ROWS), (const float*)(F.ws + WS_ROWS) + MAXROWS, F.lds}; pg8::gemm_phase(F.lds, 256, S, E); } SEAM(pb + 8);
    }
    if (EN(101) && IN(NPHASE - 1)) { phase_norm(F, (const float*)(F.ws + WS_X), true, F.in[I_FNORM], 2); }
#undef IN
#undef SEAM
}

#ifndef MK_SPLIT
#define MK_SPLIT 0
#endif
extern "C" void kernel_launch(void* const* d_in, const int* in_sizes, int n_in, void* d_out, int out_size, void* d_ws, size_t ws_size, hipStream_t stream) {
    static int grid = 0;
    if (grid == 0) {
        if (n_in != 44 || out_size != NTOK * DM || ws_size < WS_END) { fprintf(stderr, "kernel_launch: unexpected shapes (n_in %d out %d ws %zu need %zu)\n", n_in, out_size, ws_size, (size_t)WS_END); grid = -1; return; }
        int dev = 0, cus = 0;
        if (hipGetDevice(&dev) != hipSuccess || hipDeviceGetAttribute(&cus, hipDeviceAttributeMultiprocessorCount, dev) != hipSuccess) { grid = -1; return; }
        if (hipFuncSetAttribute((const void*)mk_forward, hipFuncAttributeMaxDynamicSharedMemorySize, LDS_BYTES) != hipSuccess) { fprintf(stderr, "kernel_launch: hipFuncSetAttribute failed\n"); grid = -1; return; }
        int per_cu = 0;
        if (hipOccupancyMaxActiveBlocksPerMultiprocessor(&per_cu, (const void*)mk_forward, NTHR, LDS_BYTES) != hipSuccess || per_cu < 1) { fprintf(stderr, "kernel_launch: occupancy query says %d\n", per_cu); }
        (void)hipGetLastError();
        grid = cus;
    }
    if (grid < 0) return;
    hipMemsetAsync((char*)d_ws + WS_CTL, 0, CTL_BYTES, stream);
    Params p{};
    for (int i = 0; i < 44; ++i) p.in[i] = (const float*)d_in[i];
    p.out = (float*)d_out; p.ws = (unsigned char*)d_ws;
#if MK_SPLIT
    for (int ph = 0; ph < NPHASE; ++ph) { p.ph_lo = ph; p.ph_hi = ph + 1; hipLaunchKernelGGL(mk_forward, dim3(grid), dim3(NTHR), LDS_BYTES, stream, p); }
#else
    p.ph_lo = 0; p.ph_hi = NPHASE; hipLaunchKernelGGL(mk_forward, dim3(grid), dim3(NTHR), LDS_BYTES, stream, p);
#endif
}
```

```cpp
#include <hip/hip_runtime.h>
#include <stdint.h>
#include <stdio.h>

#define LAS __attribute__((address_space(3)))
typedef unsigned short bf16_t;
typedef short bf16x8 __attribute__((ext_vector_type(8)));
typedef float f32x4 __attribute__((ext_vector_type(4)));
typedef float f32x2 __attribute__((ext_vector_type(2)));
typedef float f32x16 __attribute__((ext_vector_type(16)));
typedef unsigned u32x4 __attribute__((ext_vector_type(4)));
typedef unsigned u32x2 __attribute__((ext_vector_type(2)));

constexpr int NTOK = 16384, DM = 1024, SEQ = 4096, NBATCH = 4, DEPTH = 2;
constexpr int NIN = 2604, NINP = 2816;
constexpr int UM = 0;
constexpr int UR = 784;
constexpr int UC = 1680;
constexpr int US = 2368;
constexpr int NTHR = 512;
constexpr int LDS_BYTES = 163840;
constexpr int MISC_OFF = LDS_BYTES - 256;

constexpr size_t WS_CTL   = 0;
constexpr size_t CTL_BYTES = 65536;
constexpr size_t WS_X     = WS_CTL + CTL_BYTES;
constexpr size_t WS_H     = WS_X + (size_t)NTOK * DM * 4;
constexpr size_t WS_U     = WS_H + (size_t)NTOK * DM * 2;
constexpr size_t WS_WIN   = WS_U + (size_t)NTOK * NINP * 2;
constexpr size_t WS_WOUT  = WS_WIN + (size_t)2 * NINP * DM * 2;
constexpr size_t WS_GLU   = WS_WOUT + (size_t)2 * DM * DM * 2;
constexpr size_t WS_MOE   = WS_GLU + (size_t)2 * 512 * 256 * 2;
constexpr size_t MOE_WGU  = 0;
constexpr size_t MOE_WD   = (size_t)32 * 512 * 1024 * 2;
constexpr size_t MOE_BYTES = MOE_WD + (size_t)32 * 1024 * 256 * 2;
constexpr size_t RW_PT    = 0;
constexpr size_t RW_U     = (size_t)1024 * 4096 * 2;
constexpr size_t RW_S     = RW_U + (size_t)1024 * 4096 * 2;
constexpr size_t RW_W1    = RW_S + (size_t)1024 * 4096 * 2;
constexpr size_t RW_Z     = RW_W1 + (size_t)1024 * 4096 * 2;
constexpr size_t YSG_OFF  = RW_Z + (size_t)1024 * 4096 * 2;
static_assert(YSG_OFF + (size_t)NTOK * 256 * 2 <= MOE_BYTES, "alias");
constexpr size_t WS_MST   = WS_MOE + MOE_BYTES;
constexpr size_t WS_MDEC  = WS_MST + (size_t)4 * 64 * 4 * 4096 * 4;
constexpr size_t WS_S5ST  = WS_MDEC + 4096;
constexpr size_t WS_K     = WS_S5ST + (size_t)4 * 64 * 2048 * 4;
constexpr size_t WS_V     = WS_K + (size_t)NTOK * 64 * 2;
constexpr size_t WS_KIDX  = WS_V + (size_t)NTOK * 64 * 2;
constexpr size_t WS_ROUTE = WS_KIDX + (size_t)NTOK * 32 * 2;
constexpr size_t WS_ROWS  = WS_ROUTE + (size_t)NTOK * 32;
constexpr int    MAXROWS  = 49152;
constexpr size_t WS_TILES = WS_ROWS + (size_t)MAXROWS * 8;
constexpr size_t WS_S5TAB = WS_TILES + 4096;
constexpr size_t S5TAB_F  = (size_t)(2048 + 2048 + 32768) * 4;
constexpr size_t S5TAB_BBT = S5TAB_F + (size_t)16 * 16 * 128 * 2;
constexpr size_t S5TAB_L  = S5TAB_BBT + (size_t)16 * 128 * 16 * 2;
constexpr size_t WS_WRT   = WS_S5TAB + 2 * S5TAB_L;
constexpr size_t WS_BON   = WS_WRT + (size_t)2 * 2 * 48 * 1024 * 2;
constexpr size_t WS_END   = WS_BON + (size_t)1024 * 64 * 4;

constexpr int CW_BAR = 0;
constexpr int CW_Q   = 4096;
constexpr int CW_CNT = 8192;
constexpr int CW_RB  = 8448;

__device__ __forceinline__ float bf2f(bf16_t b) { return __uint_as_float(((unsigned)b) << 16); }
__device__ __forceinline__ bf16_t f2bf(float f) { const __bf16 h = (__bf16)f; return __builtin_bit_cast(bf16_t, h); }
__device__ __forceinline__ unsigned pk2(float lo, float hi) { typedef __bf16 bf2_t __attribute__((ext_vector_type(2))); const bf2_t h = __builtin_convertvector((f32x2){lo, hi}, bf2_t); return __builtin_bit_cast(unsigned, h); }
__device__ __forceinline__ unsigned cvt_pk_bf16(float lo, float hi) { unsigned r; asm volatile("v_cvt_pk_bf16_f32 %0, %1, %2" : "=v"(r) : "v"(lo), "v"(hi)); return r; }
__device__ __forceinline__ float sigmoidf_(float x) { return 1.0f / (1.0f + __expf(-x)); }
__device__ __forceinline__ float siluf_(float x) { return x / (1.0f + __expf(-x)); }
__device__ __forceinline__ float tanhf_(float x) { const float e = __expf(2.0f * x); return 1.0f - 2.0f / (e + 1.0f); }
__device__ __forceinline__ float softplusf_(float x) { return fmaxf(x, 0.0f) + log1pf(__expf(-fabsf(x))); }
__device__ __forceinline__ float gelu_tanh(float x) { return 0.5f * x * (1.0f + tanhf_(0.7978845608028654f * (x + 0.044715f * x * x * x))); }
template <int CTRL> __device__ __forceinline__ float dppf(float x) { return __int_as_float(__builtin_amdgcn_update_dpp(0, __float_as_int(x), CTRL, 0xF, 0xF, true)); }
__device__ __forceinline__ float sum4(float x) { x += dppf<0xB1>(x); x += dppf<0x4E>(x); return x; }
__device__ __forceinline__ float sum8(float x) { x = sum4(x); x += dppf<0x141>(x); return x; }
__device__ __forceinline__ float sum16(float x) { x = sum8(x); x += dppf<0x140>(x); return x; }
__device__ __forceinline__ int lane_id_() { int l = (int)__builtin_amdgcn_mbcnt_hi(~0u, __builtin_amdgcn_mbcnt_lo(~0u, 0u)); asm volatile("" : "+v"(l)); return l; }
__device__ __forceinline__ float shx(float x, int o) { return __int_as_float(__builtin_amdgcn_ds_bpermute((lane_id_() ^ o) << 2, __float_as_int(x))); }
__device__ __forceinline__ unsigned shdown_u(unsigned x, int o) { return (unsigned)__builtin_amdgcn_ds_bpermute(((lane_id_() + o) & 63) << 2, (int)x); }
__device__ __forceinline__ int shidx_i(int x, int src) { return __builtin_amdgcn_ds_bpermute(src << 2, x); }
__device__ __forceinline__ float wave_sum(float x) { x = sum16(x); x += shx(x, 16); x += shx(x, 32); return x; }
__device__ __forceinline__ void unpack8(const u32x4 v, float (&f)[8]) {
    f[0] = __uint_as_float(v.x << 16); f[1] = __uint_as_float(v.x & 0xffff0000u); f[2] = __uint_as_float(v.y << 16); f[3] = __uint_as_float(v.y & 0xffff0000u);
    f[4] = __uint_as_float(v.z << 16); f[5] = __uint_as_float(v.z & 0xffff0000u); f[6] = __uint_as_float(v.w << 16); f[7] = __uint_as_float(v.w & 0xffff0000u);
}

#define XB_TMO      128
#define XB_XCNT(j)  (256  + 64 * (j))
#define XB_XSUB(j)  (1280 + 64 * (j))
#define XB_XGEN(j)  (2304 + 64 * (j))
#define XB_TOP      3328
#define XB_TOPGEN   3392
#define XCD_BAR_WORDS 3456
#define XB_SPIN_CAP (1u << 22)
__device__ __forceinline__ unsigned xb_ld(unsigned* p)              { return __hip_atomic_load(p, __ATOMIC_RELAXED, __HIP_MEMORY_SCOPE_AGENT); }
__device__ __forceinline__ unsigned xb_add(unsigned* p, unsigned v) { return __hip_atomic_fetch_add(p, v, __ATOMIC_RELAXED, __HIP_MEMORY_SCOPE_AGENT); }
__device__ __forceinline__ unsigned xb_xcc_id() { return (unsigned)__builtin_amdgcn_s_getreg((3 << 11) | 20) & 0xFu; }
#define XB_SPIN(cond, bar) do { unsigned _sp = 0; while (cond) { __builtin_amdgcn_s_sleep(1); \
    if ((++_sp & 255u) == 0u) { if (xb_ld(&(bar)[XB_TMO])) break; if (_sp > XB_SPIN_CAP) { atomicAdd(&(bar)[XB_TMO], 1u); break; } } } } while (0)
struct XcdBarrier { unsigned* bar; unsigned x; volatile LAS unsigned* st; };
__device__ __forceinline__ XcdBarrier xcd_barrier_post(unsigned* bar, volatile LAS unsigned* st) {
    XcdBarrier b; b.bar = bar; b.x = xb_xcc_id(); b.st = st;
    if (threadIdx.x == 0) (void)xb_add(&bar[XB_XCNT(b.x)], 1u);
    return b;
}
__device__ __forceinline__ void xcd_barrier_complete(unsigned* bar, unsigned x, unsigned& nloc, unsigned& nx) {
    const unsigned G = gridDim.x * gridDim.y * gridDim.z;
    unsigned sum, cnt, mine, sp = 0u;
    for (;;) {
        sum = 0u; cnt = 0u; mine = 0u;
#pragma unroll
        for (unsigned j = 0; j < 16; ++j) { const unsigned c = xb_ld(&bar[XB_XCNT(j)]); sum += c; cnt += (c > 0u) ? 1u : 0u; mine = (j == x) ? c : mine; }
        if (sum == G) break;
        __builtin_amdgcn_s_sleep(1);
        if ((++sp & 255u) == 0u) { if (xb_ld(&bar[XB_TMO])) break; if (sp > XB_SPIN_CAP) { atomicAdd(&bar[XB_TMO], 1u); break; } }
    }
    nloc = mine > 0u ? mine : 1u; nx = cnt > 0u ? cnt : 1u;
}
__device__ __forceinline__ void xcd_barrier(const XcdBarrier& b_) {
    XcdBarrier b = b_; { const unsigned long long v = (unsigned long long)b.bar; unsigned lo = __builtin_amdgcn_readfirstlane((unsigned)v), hi = __builtin_amdgcn_readfirstlane((unsigned)(v >> 32)); asm volatile("" : "+s"(lo), "+s"(hi)); b.bar = (unsigned*)(((unsigned long long)hi << 32) | lo); unsigned xx = __builtin_amdgcn_readfirstlane(b.x); asm volatile("" : "+s"(xx)); b.x = xx; }
    asm volatile("s_waitcnt vmcnt(0)" ::: "memory");
    __syncthreads();
    if (threadIdx.x == 0) {
        unsigned* bar = b.bar;
        __builtin_amdgcn_s_waitcnt(0);
        unsigned nloc = b.st[0], nx = b.st[1];
        if (nloc == 0u) { xcd_barrier_complete(bar, b.x, nloc, nx); b.st[0] = nloc; b.st[1] = nx; }
        const unsigned old = xb_add(&bar[XB_XSUB(b.x)], 1u);
        const unsigned gen = old / nloc;
        if (old + 1u == (gen + 1u) * nloc) {
            __builtin_amdgcn_fence(__ATOMIC_RELEASE, "agent");
            asm volatile("s_waitcnt vmcnt(0)" ::: "memory");
            const unsigned og = xb_add(&bar[XB_TOP], 1u);
            const unsigned tg = og / nx;
            if (og + 1u == (tg + 1u) * nx) xb_add(&bar[XB_TOPGEN], 1u);
            else XB_SPIN(xb_ld(&bar[XB_TOPGEN]) == tg, bar);
            __builtin_amdgcn_fence(__ATOMIC_ACQUIRE, "agent");
            xb_add(&bar[XB_XGEN(b.x)], 1u);
            asm volatile("s_waitcnt vmcnt(0)" ::: "memory");
        } else {
            XB_SPIN(xb_ld(&bar[XB_XGEN(b.x)]) == gen, bar);
            __builtin_amdgcn_fence(__ATOMIC_ACQUIRE, "agent");
            asm volatile("s_waitcnt vmcnt(0)" ::: "memory");
        }
    }
    __syncthreads();
}

namespace pg8 {
constexpr int BM = 256, BK = 64, HALF = 128, HTB = HALF * BK * 2, STAGE_BYTES = 8 * HTB, NXCD = 8, WGM = 8;
__host__ __device__ __forceinline__ int lds_byte(int r, int c) { const int st = (r >> 4) * 2 + (c >> 5), rr = r & 15, cc = c & 31, ob = rr * 64 + cc * 2; return st * 1024 + (ob ^ (((ob >> 9) & 1) << 5)); }
__host__ __device__ __forceinline__ void stage_rc(int b, int& R, int& C) { const int st = b / 1024, sb = b % 1024, swz = sb ^ (((sb >> 9) & 1) << 5); R = (st >> 1) * 16 + swz / 64; C = (st & 1) * 32 + (swz % 64) / 2; }
__host__ __device__ __forceinline__ int perm32(int rho) { const int n = rho >> 4, i = rho & 15; return 8 * (i >> 2) + 4 * n + (i & 3); }
struct Unit { int pm, pn; const char* a; const char* b; };

struct StaticOrder {
    int nM, nN, nwg, G, c, K; const char* A; const char* B;
    __device__ void init(const bf16_t* A_, const bf16_t* B_, int M, int N, int K_, int G_, int c_) { A = (const char*)A_; B = (const char*)B_; K = K_; nM = M / BM; nN = N / BM; nwg = nM * nN; G = G_; c = c_; }
    __device__ bool next(int i, Unit& u) const {
        const long L = (long)i * G + c; if (L >= nwg) return false;
        int wgid = (int)L; { const int q = nwg / NXCD, r = nwg % NXCD, xcd = wgid % NXCD, off = wgid / NXCD; wgid = (xcd < r ? xcd * (q + 1) : r * (q + 1) + (xcd - r) * q) + off; }
        const int nig = WGM * nN, gid = wgid / nig, fm = gid * WGM, gsz = (nM - fm) < WGM ? (nM - fm) : WGM;
        u.pm = fm + ((wgid % nig) % gsz); u.pn = (wgid % nig) / gsz;
        u.a = A + (size_t)u.pm * 256 * K * 2; u.b = B + (size_t)u.pn * 256 * K * 2; return true;
    }
};

template <class Epi, class Sched>
__device__ __forceinline__ void gemm_phase(LAS unsigned char* lds, const int K_, const Sched& S, const Epi& E) {
    int K = K_; asm volatile("" : "+s"(K));
    int tid_ = threadIdx.x; asm volatile("" : "+v"(tid_));
    const int tid = tid_, wid = __builtin_amdgcn_readfirstlane(tid >> 6), lane = tid & 63, wr = wid >> 2, wc = wid & 3, fr = lane & 15, fq = lane >> 4;
    const int nt = K / BK;
    unsigned voffA[2], voffB[2];
#pragma unroll
    for (int i = 0; i < 2; ++i) { int R, C; stage_rc(tid * 16 + i * 8192, R, C); const int Rb = Epi::PERM ? ((R & ~31) + perm32(R & 31)) : R;
        voffA[i] = (unsigned)(R * K + C) * 2u; voffB[i] = (unsigned)(Rb * K + C) * 2u; }
    const size_t kstep = (size_t)(BK * 2);
    const size_t hstep = (size_t)HALF * K * 2;
    const unsigned ldsw = (unsigned)wid * 1024u;
    const int aoff = lds_byte(wr * 64 + fr, fq * 8), boff = lds_byte(wc * 32 + fr, fq * 8);
#define PG8_SA(b, h) (((b) * 2 + (h)) * HTB)
#define PG8_SB(b, h) ((4 + (b) * 2 + (h)) * HTB)
#define PG8_STAGE(bufoff, gbase, voff) do { _Pragma("unroll") for (int _i = 0; _i < 2; ++_i) \
        __builtin_amdgcn_global_load_lds((const unsigned*)((const char*)(gbase) + (voff)[_i]), (LAS unsigned*)(lds + (bufoff) + ldsw + _i * 8192), 16, 0, 0); } while (0)
#define PG8_LDA(dst, b, h) do { _Pragma("unroll") for (int m = 0; m < 4; ++m) _Pragma("unroll") for (int k = 0; k < 2; ++k) dst[m][k] = *(const LAS bf16x8*)(lds + PG8_SA(b, h) + aoff + m * 2048 + k * 1024); } while (0)
#define PG8_LDB(dst, b, h) do { _Pragma("unroll") for (int n = 0; n < 2; ++n) _Pragma("unroll") for (int k = 0; k < 2; ++k) dst[n][k] = *(const LAS bf16x8*)(lds + PG8_SB(b, h) + boff + n * 2048 + k * 1024); } while (0)
#define PG8_MMA(ai, bj, At, Bt) do { __builtin_amdgcn_s_setprio(1); _Pragma("unroll") for (int m = 0; m < 4; ++m) _Pragma("unroll") for (int n = 0; n < 2; ++n) _Pragma("unroll") for (int k = 0; k < 2; ++k) \
        acc[ai][bj][m][n] = __builtin_amdgcn_mfma_f32_16x16x32_bf16(Bt[n][k], At[m][k], acc[ai][bj][m][n], 0, 0, 0); __builtin_amdgcn_s_setprio(0); } while (0)
#define PG8_WAIT_V(n) asm volatile("s_waitcnt vmcnt(" #n ")" ::: "memory")
#define PG8_WAIT_L(n) asm volatile("s_waitcnt lgkmcnt(" #n ")" ::: "memory")
#define PG8_BAR __builtin_amdgcn_s_barrier()
#define PG8_SCHED __builtin_amdgcn_sched_barrier(0)
    Unit cur, nxt; int ui = 0;
    if (!S.next(0, cur)) return;
    f32x4 acc[2][2][4][2];
#pragma unroll
    for (int a = 0; a < 2; ++a)
#pragma unroll
        for (int b = 0; b < 2; ++b)
#pragma unroll
            for (int m = 0; m < 4; ++m)
#pragma unroll
                for (int n = 0; n < 2; ++n) acc[a][b][m][n] = (f32x4){0.f, 0.f, 0.f, 0.f};
    bf16x8 At[4][2], B0[2][2], B1[2][2];
    const char* cA = cur.a; const char* cB = cur.b;
    PG8_STAGE(PG8_SB(0, 0), cB, voffB); PG8_STAGE(PG8_SA(0, 0), cA, voffA); PG8_STAGE(PG8_SB(0, 1), cB + hstep, voffB); PG8_STAGE(PG8_SA(0, 1), cA + hstep, voffA);
    if (wr == 1) PG8_BAR;
    PG8_WAIT_V(4); PG8_BAR;
    PG8_STAGE(PG8_SB(1, 0), cB + kstep, voffB); PG8_STAGE(PG8_SA(1, 0), cA + kstep, voffA); PG8_STAGE(PG8_SB(1, 1), cB + hstep + kstep, voffB);
    PG8_WAIT_V(6); PG8_BAR;
    for (;;) {
        const bool has_next = S.next(ui + 1, nxt);
        const char* nA = has_next ? nxt.a : cA; const char* nB = has_next ? nxt.b : cB;
        for (int t = 0; t < nt; t += 2) {
            const bool last = (t == nt - 2);
            const char* a1 = cA + (size_t)(t + 1) * kstep;
            const char* a2 = last ? nA : cA + (size_t)(t + 2) * kstep; const char* b2 = last ? nB : cB + (size_t)(t + 2) * kstep;
            const char* a3 = a2 + kstep; const char* b3 = b2 + kstep;
            PG8_LDB(B0, 0, 0); PG8_SCHED; PG8_LDA(At, 0, 0); PG8_STAGE(PG8_SA(1, 1), a1 + hstep, voffA);
            PG8_WAIT_L(8); PG8_BAR; PG8_WAIT_L(0); PG8_MMA(0, 0, At, B0); PG8_BAR; PG8_SCHED;
            PG8_LDB(B1, 0, 1); PG8_STAGE(PG8_SB(0, 0), b2, voffB);
            PG8_BAR; PG8_WAIT_L(0); PG8_MMA(0, 1, At, B1); PG8_BAR;
            PG8_LDA(At, 0, 1); PG8_STAGE(PG8_SA(0, 0), a2, voffA);
            PG8_BAR; PG8_WAIT_L(0); PG8_MMA(1, 0, At, B0); PG8_BAR; PG8_SCHED;
            PG8_STAGE(PG8_SB(0, 1), b2 + hstep, voffB);
            PG8_WAIT_V(6); PG8_BAR; PG8_MMA(1, 1, At, B1); PG8_BAR;
            PG8_LDB(B0, 1, 0); PG8_SCHED; PG8_LDA(At, 1, 0); PG8_STAGE(PG8_SA(0, 1), a2 + hstep, voffA);
            PG8_WAIT_L(8); PG8_BAR; PG8_WAIT_L(0); PG8_MMA(0, 0, At, B0); PG8_BAR; PG8_SCHED;
            PG8_LDB(B1, 1, 1); PG8_STAGE(PG8_SB(1, 0), b3, voffB);
            PG8_BAR; PG8_WAIT_L(0); PG8_MMA(0, 1, At, B1); PG8_BAR;
            PG8_LDA(At, 1, 1); PG8_STAGE(PG8_SA(1, 0), a3, voffA);
            PG8_BAR; PG8_WAIT_L(0); PG8_MMA(1, 0, At, B0); PG8_BAR; PG8_SCHED;
            PG8_STAGE(PG8_SB(1, 1), b3 + hstep, voffB);
            PG8_WAIT_V(6); PG8_BAR; PG8_MMA(1, 1, At, B1); PG8_BAR;
        }
        E(acc, cur, wr, wc, fr, fq);
        if (!has_next) break;
#pragma unroll
        for (int a = 0; a < 2; ++a)
#pragma unroll
            for (int b = 0; b < 2; ++b)
#pragma unroll
                for (int m = 0; m < 4; ++m)
#pragma unroll
                    for (int n = 0; n < 2; ++n) acc[a][b][m][n] = (f32x4){0.f, 0.f, 0.f, 0.f};
        cur = nxt; cA = nA; cB = nB; ++ui;
    }
    PG8_WAIT_V(0);
    if (wr == 0) PG8_BAR;
    PG8_BAR;
#undef PG8_SA
#undef PG8_SB
#undef PG8_STAGE
#undef PG8_LDA
#undef PG8_LDB
#undef PG8_MMA
#undef PG8_WAIT_V
#undef PG8_WAIT_L
#undef PG8_BAR
#undef PG8_SCHED
}

struct EpiBf16 {
    static constexpr bool PERM = true;
    bf16_t* O; int ldc;
    __device__ __forceinline__ void operator()(const f32x4 (&acc)[2][2][4][2], const Unit& u, int wr, int wc, int fr, int fq) const {
        const int row0 = u.pm * BM + wr * 64 + fr, col0 = u.pn * BM + wc * 32 + 8 * fq;
#pragma unroll
        for (int ai = 0; ai < 2; ++ai)
#pragma unroll
            for (int m = 0; m < 4; ++m) { bf16_t* rowp = O + (size_t)(row0 + ai * HALF + m * 16) * ldc + col0;
#pragma unroll
                for (int bj = 0; bj < 2; ++bj) { const f32x4 v0 = acc[ai][bj][m][0], v1 = acc[ai][bj][m][1];
                    u32x4 w; w.x = cvt_pk_bf16(v0[0], v0[1]); w.y = cvt_pk_bf16(v0[2], v0[3]); w.z = cvt_pk_bf16(v1[0], v1[1]); w.w = cvt_pk_bf16(v1[2], v1[3]);
                    *(u32x4*)(rowp + bj * HALF) = w; } }
    }
};
struct EpiResid {
    static constexpr bool PERM = false;
    float* C; int ldc;
    __device__ __forceinline__ void operator()(const f32x4 (&acc)[2][2][4][2], const Unit& u, int wr, int wc, int fr, int fq) const {
        const int row0 = u.pm * BM + wr * 64 + fr, col0 = u.pn * BM + wc * 32 + 4 * fq;
#pragma unroll
        for (int ai = 0; ai < 2; ++ai)
#pragma unroll
            for (int m = 0; m < 4; ++m) { float* rowp = C + (size_t)(row0 + ai * HALF + m * 16) * ldc + col0;
#pragma unroll
                for (int bj = 0; bj < 2; ++bj)
#pragma unroll
                    for (int n = 0; n < 2; ++n) { f32x4* p = (f32x4*)(rowp + bj * HALF + n * 16); *p = *p + acc[ai][bj][m][n]; } }
    }
};
template <int ACT  > struct EpiGated {
    static constexpr bool PERM = true;
    bf16_t* O; int ldo; int coloff; const float* ba; const float* bb;
    __device__ __forceinline__ void operator()(const f32x4 (&acc)[2][2][4][2], const Unit& u, int wr, int wc, int fr, int fq) const {
        const int row0 = u.pm * BM + wr * 64 + fr, cl = u.pn * HALF + wc * 32 + 8 * fq;
        float va[8], vb[8];
#pragma unroll
        for (int j = 0; j < 8; ++j) { va[j] = (ACT == 0) ? ba[cl + j] : 0.f; vb[j] = (ACT == 0) ? bb[cl + j] : 0.f; }
#pragma unroll
        for (int ai = 0; ai < 2; ++ai)
#pragma unroll
            for (int m = 0; m < 4; ++m) { bf16_t* rowp = O + (size_t)(row0 + ai * HALF + m * 16) * ldo + coloff + cl;
                float o[8];
#pragma unroll
                for (int n = 0; n < 2; ++n)
#pragma unroll
                    for (int j = 0; j < 4; ++j) { const float a = acc[ai][0][m][n][j] + va[4 * n + j], b = acc[ai][1][m][n][j] + vb[4 * n + j];
                        o[4 * n + j] = (ACT == 0) ? a * sigmoidf_(b) : siluf_(a) * b; }
                u32x4 w; w.x = cvt_pk_bf16(o[0], o[1]); w.y = cvt_pk_bf16(o[2], o[3]); w.z = cvt_pk_bf16(o[4], o[5]); w.w = cvt_pk_bf16(o[6], o[7]);
                *(u32x4*)rowp = w; asm volatile("" ::: "memory"); }
    }
};
struct EpiMoeOut {
    static constexpr bool PERM = true;
    bf16_t* O; const int* row_tok; const float* row_w; LAS unsigned char* lds;
    __device__ __forceinline__ void operator()(const f32x4 (&acc)[2][2][4][2], const Unit& u, int wr, int wc, int fr_, int fq_) const {
        int fr = fr_, fq = fq_; asm volatile("" : "+v"(fr), "+v"(fq));
        const int col0 = u.pn * BM + wc * 32 + 8 * fq, lane = fq * 16 + fr;
        LAS u32x2* rinfo = (LAS u32x2*)(lds + STAGE_BYTES) + (wr * 4 + wc) * 128;
        { const int ra = u.pm * BM + wr * 64 + lane, rb = ra + HALF;
          const u32x2 ia = (u32x2){(unsigned)row_tok[ra], __float_as_uint(row_w[ra])}, ib = (u32x2){(unsigned)row_tok[rb], __float_as_uint(row_w[rb])};
          rinfo[lane] = ia; rinfo[64 + lane] = ib; }
#pragma unroll
        for (int ai = 0; ai < 2; ++ai)
#pragma unroll
            for (int m = 0; m < 4; ++m) { const u32x2 inf = rinfo[ai * 64 + m * 16 + fr]; const int ts = (int)inf.x; const float w = __uint_as_float(inf.y);
                if (ts >= 0) { bf16_t* rowp = O + ((size_t)(ts & 1) * NTOK + (size_t)(ts >> 1)) * DM + col0;
#pragma unroll
                    for (int bj = 0; bj < 2; ++bj) { const f32x4 v0 = acc[ai][bj][m][0] * w, v1 = acc[ai][bj][m][1] * w;
                        u32x4 q; q.x = cvt_pk_bf16(v0[0], v0[1]); q.y = cvt_pk_bf16(v0[2], v0[3]); q.z = cvt_pk_bf16(v1[0], v1[1]); q.w = cvt_pk_bf16(v1[2], v1[3]);
                        *(u32x4*)(rowp + bj * HALF) = q; } } }
    }
};
struct MoeOrder {
    int nN, G, c, K; const char* A; const char* B; size_t bstride; const int* tiles;
    __device__ bool next(int i, Unit& u) const {
        const int nrt = tiles[0]; const long L = (long)i * G + c; if (L >= (long)nrt * nN) return false;
        u.pm = (int)(L / nN); u.pn = (int)(L % nN); const int e = tiles[64 + u.pm];
        u.a = A + (size_t)u.pm * 256 * K * 2; u.b = B + (size_t)e * bstride + (size_t)u.pn * 256 * K * 2; return true;
    }
};
}

struct Params { const float* in[44]; float* out; unsigned char* ws; int ph_lo, ph_hi; };
enum { I_X = 0, I_NORM1, I_WIN, I_MCONVW, I_MCONVB, I_MDTB, I_MALOG, I_MD, I_MNORM, I_RMU, I_RW0, I_RW2, I_RA0, I_RA2, I_RG2, I_RKK, I_RKA, I_RRK, I_RLNW, I_RLNB,
       I_CKVN, I_CWUK, I_CWUV, I_RELB, I_SARE, I_SAIM, I_SBRE, I_SBIM, I_SCRE, I_SCIM, I_SD, I_SLOGDT, I_SGLUW, I_SGLUB, I_WOUT, I_NORM2, I_WRG, I_BRG, I_WRE, I_BRE,
       I_WGATE, I_WUP, I_WDOWN, I_FNORM };

typedef const float* const __attribute__((address_space(4)))* in_tab_t;
struct Frame {
    LAS unsigned char* lds; int tid, lane, wave, bid, G;
    in_tab_t in; float* out; unsigned char* ws; unsigned* ctl;
    volatile LAS int* misc;
};

__device__ __forceinline__ int q_pop(Frame& F, int qi) {
    __syncthreads();
    if (F.tid == 0) F.misc[0] = (int)__hip_atomic_fetch_add(F.ctl + CW_Q + 64 * qi, 1u, __ATOMIC_RELAXED, __HIP_MEMORY_SCOPE_AGENT);
    __syncthreads();
    return F.misc[0];
}

__device__ __forceinline__ const void* opaque_ptr(const void* p) { const unsigned long long v = (unsigned long long)p; unsigned lo = __builtin_amdgcn_readfirstlane((unsigned)v), hi = __builtin_amdgcn_readfirstlane((unsigned)(v >> 32));
    asm volatile("" : "+s"(lo), "+s"(hi)); return (const void*)(((unsigned long long)hi << 32) | lo); }
__device__ __forceinline__ Frame relocal(const Frame& G) { Frame F = G; asm volatile("" : "+v"(F.tid)); F.ws = (unsigned char*)opaque_ptr(F.ws); F.ctl = (unsigned*)(F.ws + WS_CTL); F.in = (in_tab_t)(unsigned long long)opaque_ptr((const void*)(unsigned long long)F.in); F.lane = F.tid & 63; F.wave = __builtin_amdgcn_readfirstlane(F.tid >> 6); return F; }
template <int K> __device__ __forceinline__ f32x4 mma_nt(const LAS bf16_t* A, int lda, const LAS bf16_t* Bt, int ldb, f32x4 acc, int lane) {
    const int r = lane & 15, g = lane >> 4;
#pragma unroll
    for (int k0 = 0; k0 < K; k0 += 32) {
        const bf16x8 a = *(const LAS bf16x8*)(A + r * lda + k0 + 8 * g);
        const bf16x8 b = *(const LAS bf16x8*)(Bt + r * ldb + k0 + 8 * g);
        acc = __builtin_amdgcn_mfma_f32_16x16x32_bf16(a, b, acc, 0, 0, 0);
    }
    return acc;
}

template <class SrcMap> __device__ __forceinline__ void tr_tile(Frame& F, int ldsrc, bf16_t* dst, int K, int k0, int n0, SrcMap sm) {
    LAS float* tile = (LAS float*)F.lds;
    __syncthreads();
    { const int n4 = (F.tid & 63) * 4, kk = F.tid >> 6; const float* sp = sm(n0 + n4);
      f32x4 v[8];
#pragma unroll
      for (int ps = 0; ps < 8; ++ps) { v[ps] = (f32x4){0.f, 0.f, 0.f, 0.f}; if (sp) v[ps] = *(const f32x4*)(sp + (size_t)(k0 + kk + 8 * ps) * ldsrc); }
#pragma unroll
      for (int ps = 0; ps < 8; ++ps) { LAS float* t = tile + (kk + 8 * ps) * 257 + n4; t[0] = v[ps][0]; t[1] = v[ps][1]; t[2] = v[ps][2]; t[3] = v[ps][3]; } }
    __syncthreads();
    { const int kc = F.tid & 7;
#pragma unroll
      for (int j = 0; j < 4; ++j) { const int n = (F.tid >> 3) + 64 * j; float f[8];
#pragma unroll
          for (int i = 0; i < 8; ++i) f[i] = tile[(8 * kc + i) * 257 + n];
          u32x4 w; w.x = pk2(f[0], f[1]); w.y = pk2(f[2], f[3]); w.z = pk2(f[4], f[5]); w.w = pk2(f[6], f[7]);
          *(u32x4*)(dst + (size_t)(n0 + n) * K + k0 + 8 * kc) = w; } }
}

struct SmIn { const float* base; __device__ __forceinline__ const float* operator()(int n) const {
    int c; if (n < 772) c = n; else if (n < UR) return nullptr; else if (n < UR + 896) c = 772 + (n - UR); else if (n < UC) return nullptr;
    else if (n < UC + 680) c = 1668 + (n - UC); else if (n < US) return nullptr; else if (n < US + 256) c = 2348 + (n - US); else return nullptr; return base + c; } };
struct SmId { const float* base; __device__ __forceinline__ const float* operator()(int n) const { return base + n; } };
struct SmGlu { const float* base; __device__ __forceinline__ const float* operator()(int n) const { const int pn = n >> 8, rr = n & 255; return base + (rr < 128 ? 128 * pn + rr : 256 + 128 * pn + (rr - 128)); } };
struct SmGU { const float* gate; const float* up; __device__ __forceinline__ const float* operator()(int n) const {
    const unsigned long long d = (unsigned long long)up - (unsigned long long)gate; const unsigned long long a = (unsigned long long)gate + (((n & 255) < 128) ? 0ull : d); return (const float*)a + 128 * (n >> 8) + (n & 127); } };
__device__ __forceinline__ void phase_prologue(const Frame& F_) { Frame F = relocal(F_);
    for (int t = F.bid; t < 496; t += F.G) {
        if (t < 352) { const int l = t / 176, r = t % 176, kt = r / 11, nt = r % 11;
            tr_tile(F, NIN, (bf16_t*)(F.ws + WS_WIN) + (size_t)l * NINP * DM, DM, kt * 64, nt * 256, SmIn{F.in[I_WIN] + (size_t)l * DM * NIN}); }
        else if (t < 480) { const int q = t - 352, l = q / 64, r = q % 64, kt = r / 4, nt = r % 4;
            tr_tile(F, DM, (bf16_t*)(F.ws + WS_WOUT) + (size_t)l * DM * DM, DM, kt * 64, nt * 256, SmId{F.in[I_WOUT] + (size_t)l * DM * DM}); }
        else { const int q = t - 480, l = q / 8, r = q % 8, kt = r / 2, nt = r % 2;
            tr_tile(F, 512, (bf16_t*)(F.ws + WS_GLU) + (size_t)l * 512 * 256, 256, kt * 64, nt * 256, SmGlu{F.in[I_SGLUW] + (size_t)l * 256 * 512}); }
    }
    for (int i = F.bid * NTHR + F.tid; i < 2 * 48 * 1024; i += F.G * NTHR) { const int l = i / 49152, r = i % 49152, o = r >> 10, k = r & 1023;
        float v = 0.f; if (o < 32) v = F.in[I_WRE][((size_t)l * DM + k) * 32 + o]; else if (o < 36) v = F.in[I_WRG][((size_t)l * DM + k) * 4 + (o - 32)];
        v *= F.in[I_NORM2][l * DM + k];
        const bf16_t hi = f2bf(v); const bf16_t lo = f2bf(v - bf2f(hi));
        bf16_t* w = (bf16_t*)(F.ws + WS_WRT) + (size_t)l * 2 * 49152; w[r] = hi; w[49152 + r] = lo; }
    for (int i = F.bid * NTHR + F.tid; i < 2048 + 65536; i += F.G * NTHR) {
        if (i < 2048) {
            const int l = i >> 10, gn = i & 1023, g = gn >> 6;
            float* tab = (float*)(F.ws + WS_S5TAB + (size_t)l * S5TAB_L);
            const float lre = fminf(F.in[I_SARE][l * 1024 + gn], -1e-4f), lim = F.in[I_SAIM][l * 1024 + gn];
            const float dt = expf(F.in[I_SLOGDT][l * 16 + g]);
            const float mag = expf(dt * lre); float sn, cs; sincosf(dt * lim, &sn, &cs);
            const float are = mag * cs, aim = mag * sn;
            const float den = lre * lre + lim * lim;
            const float fre = ((are - 1.0f) * lre + aim * lim) / den, fim = (aim * lre - (are - 1.0f) * lim) / den;
            tab[gn * 2] = are; tab[gn * 2 + 1] = aim;
            float pr = are, pi = aim;
#pragma unroll
            for (int s = 0; s < 6; ++s) { const float nr = pr * pr - pi * pi, ni = 2.0f * pr * pi; pr = nr; pi = ni; }
            tab[2048 + gn * 2] = pr; tab[2048 + gn * 2 + 1] = pi;
            const float* bre = F.in[I_SBRE] + ((size_t)l * 1024 + gn) * 16; const float* bim = F.in[I_SBIM] + ((size_t)l * 1024 + gn) * 16;
            bf16_t* bbt = (bf16_t*)(F.ws + WS_S5TAB + (size_t)l * S5TAB_L + S5TAB_BBT); const int n = gn & 63, col = 4 * (n & 31) + 2 * (n >> 5);
            for (int p = 0; p < 16; ++p) { const float vr = fre * bre[p] - fim * bim[p], vi = fre * bim[p] + fim * bre[p];
                bbt[((size_t)g * 128 + col) * 16 + p] = f2bf(vr); bbt[((size_t)g * 128 + col + 1) * 16 + p] = f2bf(vi); }
        } else {
            const int j = i - 2048, l = j >> 15, r = j & 32767, gp = r >> 7, k = r & 127;
            bf16_t* cm = (bf16_t*)(F.ws + WS_S5TAB + (size_t)l * S5TAB_L + S5TAB_F);
            const int n = (k >> 2) + 32 * ((k >> 1) & 1);
            const float v = (k & 1) == 0 ? F.in[I_SCRE][((size_t)l * 256 + gp) * 64 + n] : -F.in[I_SCIM][((size_t)l * 256 + gp) * 64 + n];
            cm[r] = f2bf(v);
        }
    }
}

__device__ __forceinline__ void phase_norm(const Frame& F_, const float* xin, bool add_o, const float* w, int mode) { Frame F = relocal(F_);
    float* X = (float*)(F.ws + WS_X); bf16_t* H = (bf16_t*)(F.ws + WS_H); const bf16_t* O = (const bf16_t*)(F.ws + WS_U);
    for (int row = F.bid * 8 + F.wave; row < NTOK; row += F.G * 8) {
        f32x4 v[4]; float ss = 0.f;
#pragma unroll
        for (int j = 0; j < 4; ++j) { const int c = 4 * F.lane + 256 * j; v[j] = *(const f32x4*)(xin + (size_t)row * DM + c);
            if (add_o) { const u32x2 a = *(const u32x2*)(O + (size_t)row * DM + c), b = *(const u32x2*)(O + ((size_t)NTOK + row) * DM + c);
                v[j][0] += __uint_as_float(a.x << 16) + __uint_as_float(b.x << 16); v[j][1] += __uint_as_float(a.x & 0xffff0000u) + __uint_as_float(b.x & 0xffff0000u);
                v[j][2] += __uint_as_float(a.y << 16) + __uint_as_float(b.y << 16); v[j][3] += __uint_as_float(a.y & 0xffff0000u) + __uint_as_float(b.y & 0xffff0000u); }
            ss += v[j][0] * v[j][0] + v[j][1] * v[j][1] + v[j][2] * v[j][2] + v[j][3] * v[j][3]; }
        ss = wave_sum(ss);
        const float rstd = rsqrtf(ss * (1.0f / DM) + 1e-6f);
#pragma unroll
        for (int j = 0; j < 4; ++j) { const int c = 4 * F.lane + 256 * j; const f32x4 wv = *(const f32x4*)(w + c);
            if (mode == 2) { *(f32x4*)(F.out + (size_t)row * DM + c) = v[j] * rstd * wv; }
            else { *(f32x4*)(X + (size_t)row * DM + c) = v[j];
                u32x2 o; o.x = pk2(v[j][0] * rstd * wv[0], v[j][1] * rstd * wv[1]); o.y = pk2(v[j][2] * rstd * wv[2], v[j][3] * rstd * wv[3]);
                *(u32x2*)(H + (size_t)row * DM + c) = o; } }
    }
}

__device__ __forceinline__ void item_kv(const Frame& F_, int layer, int item) { Frame F = relocal(F_);
    const bf16_t* U = (const bf16_t*)(F.ws + WS_U);
    LAS bf16_t* Ab = (LAS bf16_t*)F.lds;
    LAS bf16_t* Bt = (LAS bf16_t*)(F.lds + 17408);
    const int t0 = item * 64;
    { const int tok = F.tid >> 3, part = F.tid & 7; const bf16_t* src = U + (size_t)(t0 + tok) * NINP + UC + 256 + 16 * part;
      float f[16]; { float a[8], b[8]; unpack8(*(const u32x4*)src, a); unpack8(*(const u32x4*)(src + 8), b);
#pragma unroll
        for (int j = 0; j < 8; ++j) { f[j] = a[j]; f[8 + j] = b[j]; } }
      float ss = 0.f;
#pragma unroll
      for (int j = 0; j < 16; ++j) ss += f[j] * f[j];
      ss = sum8(ss);
      const float rstd = rsqrtf(ss * (1.0f / 128.0f) + 1e-6f); const float* nw = F.in[I_CKVN] + layer * 128 + 16 * part;
#pragma unroll
      for (int j = 0; j < 16; j += 2) *(LAS unsigned*)(Ab + tok * 136 + 16 * part + j) = pk2(f[j] * rstd * nw[j], f[j + 1] * rstd * nw[j + 1]); }
    { const int n = F.tid >> 2, kq = F.tid & 3; const float* w = (n < 64 ? F.in[I_CWUK] : F.in[I_CWUV]) + (size_t)layer * 128 * 64 + (n & 63);
      float wv[32];
#pragma unroll
      for (int k = 0; k < 32; ++k) wv[k] = w[(size_t)(32 * kq + k) * 64];
#pragma unroll
      for (int k = 0; k < 32; k += 2) *(LAS unsigned*)(Bt + n * 136 + 32 * kq + k) = pk2(wv[k], wv[k + 1]); }
    if (F.tid < 256) { const int tok = F.tid >> 2, q = F.tid & 3;
        *(u32x4*)((bf16_t*)(F.ws + WS_KIDX) + (size_t)(t0 + tok) * 32 + 8 * q) = *(const u32x4*)(U + (size_t)(t0 + tok) * NINP + UC + 640 + 8 * q); }
    __syncthreads();
    const int mt = F.wave & 3, g = F.lane >> 4, r = F.lane & 15;
#pragma unroll
    for (int q = 0; q < 4; ++q) { const int nt = (F.wave >> 2) * 4 + q;
        f32x4 acc = (f32x4){0.f, 0.f, 0.f, 0.f};
        acc = mma_nt<128>(Ab + mt * 16 * 136, 136, Bt + nt * 16 * 136, 136, acc, F.lane);
        const int n = nt * 16 + r; bf16_t* dst = (bf16_t*)(F.ws + (n < 64 ? WS_K : WS_V));
#pragma unroll
        for (int i = 0; i < 4; ++i) dst[(size_t)(t0 + mt * 16 + 4 * g + i) * 64 + (n & 63)] = f2bf(acc[i]); }
}

constexpr int MB_CG = 0, MB_BG = 18432, MB_BT = 36864, MB_XT = 55296, MB_M = 92160, MB_S0 = 101376, MB_DT = 110592, MB_AC = 111616, MB_RS = 112640;
template <int STAGE> __device__ __forceinline__ void item_mamba(const Frame& F_, int layer, int item) { Frame F = relocal(F_);
    const bf16_t* U = (const bf16_t*)(F.ws + WS_U);
    const int b = item >> 6, c = item & 63, l0 = c * 64; const size_t T0 = (size_t)b * SEQ + l0;
    LAS bf16_t* Cg = (LAS bf16_t*)(F.lds + MB_CG); LAS bf16_t* Bg = (LAS bf16_t*)(F.lds + MB_BG); LAS bf16_t* BT = (LAS bf16_t*)(F.lds + MB_BT);
    LAS bf16_t* XT = (LAS bf16_t*)(F.lds + MB_XT); LAS bf16_t* Mb = (LAS bf16_t*)(F.lds + MB_M); LAS bf16_t* S0 = (LAS bf16_t*)(F.lds + MB_S0);
    LAS float* dts = (LAS float*)(F.lds + MB_DT); LAS float* acs = (LAS float*)(F.lds + MB_AC); LAS float* rs = (LAS float*)(F.lds + MB_RS);
    if (F.tid < 256) { const int l = F.tid >> 2, h = F.tid & 3;
        const float raw = bf2f(U[(T0 + l) * NINP + UM + 768 + h]) + F.in[I_MDTB][layer * 4 + h];
        const float dt = softplusf_(raw); dts[l * 4 + h] = dt; acs[l * 4 + h] = -__expf(F.in[I_MALOG][layer * 4 + h]) * dt; }
    if (F.tid < 64) rs[F.tid] = 0.f;
    __syncthreads();
    float mycum = 0.f;
    if (F.tid < 256) { const int l = F.tid >> 2, h = F.tid & 3; for (int s = 0; s <= l; ++s) mycum += acs[s * 4 + h]; }
    __syncthreads();
    if (F.tid < 256) acs[F.tid] = mycum;
    __syncthreads();
    { const int ch8 = F.tid & 63, tg = F.tid >> 6, c0 = ch8 * 8;
      float wv[4][8], bv[8];
#pragma unroll
      for (int j = 0; j < 8; ++j) { bv[j] = F.in[I_MCONVB][layer * 512 + c0 + j];
#pragma unroll
          for (int k = 0; k < 4; ++k) wv[k][j] = F.in[I_MCONVW][(layer * 4 + k) * 512 + c0 + j]; }
      float win[3][8];
#pragma unroll
      for (int k = 0; k < 3; ++k) { const int l = l0 + tg * 8 - 3 + k;
          if (l >= 0) unpack8(*(const u32x4*)(U + ((size_t)b * SEQ + l) * NINP + UM + 256 + c0), win[k]);
          else {
#pragma unroll
              for (int j = 0; j < 8; ++j) win[k][j] = 0.f; } }
#pragma unroll 1
      for (int ib = 0; ib < 2; ++ib) { u32x4 rows[4];
#pragma unroll
          for (int i4 = 0; i4 < 4; ++i4) rows[i4] = *(const u32x4*)(U + (T0 + tg * 8 + ib * 4 + i4) * NINP + UM + 256 + c0);
#pragma unroll
      for (int i4 = 0; i4 < 4; ++i4) { const int l = tg * 8 + ib * 4 + i4; float cur[8]; unpack8(rows[i4], cur);
          float o[8];
#pragma unroll
          for (int j = 0; j < 8; ++j) { o[j] = siluf_(bv[j] + wv[0][j] * win[0][j] + wv[1][j] * win[1][j] + wv[2][j] * win[2][j] + wv[3][j] * cur[j]);
              win[0][j] = win[1][j]; win[1][j] = win[2][j]; win[2][j] = cur[j]; }
          if (c0 < 256) { const int h = c0 >> 6, p0 = c0 & 63; float sc = dts[l * 4 + h]; if (STAGE == 1) sc *= __expf(acs[63 * 4 + h] - acs[l * 4 + h]);
#pragma unroll
              for (int j = 0; j < 8; ++j) XT[(h * 64 + p0 + j) * 72 + l] = f2bf(o[j] * sc); }
          else if (c0 < 384) { const int g = (c0 - 256) >> 6, n0 = (c0 - 256) & 63;
              if (STAGE == 1) {
#pragma unroll
                  for (int j = 0; j < 8; ++j) BT[(g * 64 + n0 + j) * 72 + l] = f2bf(o[j]); }
              else { u32x4 w; w.x = pk2(o[0], o[1]); w.y = pk2(o[2], o[3]); w.z = pk2(o[4], o[5]); w.w = pk2(o[6], o[7]); *(LAS u32x4*)(Bg + (g * 64 + l) * 72 + n0) = w; } }
          else if (STAGE == 2) { const int g = (c0 - 384) >> 6, n0 = (c0 - 384) & 63;
              u32x4 w; w.x = pk2(o[0], o[1]); w.y = pk2(o[2], o[3]); w.z = pk2(o[4], o[5]); w.w = pk2(o[6], o[7]); *(LAS u32x4*)(Cg + (g * 64 + l) * 72 + n0) = w; } } } }
    __syncthreads();
    const int g4 = F.lane >> 4, r16 = F.lane & 15;
    if (STAGE == 1) {
        float* MST = (float*)(F.ws + WS_MST) + ((size_t)(b * 64 + c) * 4) * 4096;
#pragma unroll
        for (int q = 0; q < 8; ++q) { const int tix = F.wave * 8 + q, h = tix >> 4, mt = (tix >> 2) & 3, nt = tix & 3;
            f32x4 acc = (f32x4){0.f, 0.f, 0.f, 0.f};
            acc = mma_nt<64>(XT + (h * 64 + mt * 16) * 72, 72, BT + ((h >> 1) * 64 + nt * 16) * 72, 72, acc, F.lane);
#pragma unroll
            for (int i = 0; i < 4; ++i) MST[(size_t)h * 4096 + (mt * 16 + 4 * g4 + i) * 64 + nt * 16 + r16] = acc[i]; }
        if (F.tid < 4) ((float*)(F.ws + WS_MDEC))[(b * 64 + c) * 4 + F.tid] = __expf(acs[63 * 4 + F.tid]);
    } else {
        const int mt = F.wave & 3, nh = F.wave >> 2;
        const float* MST = (const float*)(F.ws + WS_MST) + ((size_t)(b * 64 + c) * 4) * 4096;
        f32x4 G[2], yv[4][2];
#pragma unroll
        for (int h = 0; h < 4; ++h) {
            const int g = h >> 1;
            { const float* src = MST + (size_t)h * 4096 + F.tid * 8; const f32x4 a = *(const f32x4*)src, bq = *(const f32x4*)(src + 4);
              u32x4 w; w.x = pk2(a[0], a[1]); w.y = pk2(a[2], a[3]); w.z = pk2(bq[0], bq[1]); w.w = pk2(bq[2], bq[3]);
              *(LAS u32x4*)(S0 + (F.tid >> 3) * 72 + (F.tid & 7) * 8) = w; }
            if ((h & 1) == 0) {
#pragma unroll
                for (int q = 0; q < 2; ++q) { G[q] = (f32x4){0.f, 0.f, 0.f, 0.f};
                    G[q] = mma_nt<64>(Cg + (g * 64 + mt * 16) * 72, 72, Bg + (g * 64 + (2 * nh + q) * 16) * 72, 72, G[q], F.lane); } }
#pragma unroll
            for (int q = 0; q < 2; ++q) { const int s = (2 * nh + q) * 16 + r16; const float as = acs[s * 4 + h];
#pragma unroll
                for (int i = 0; i < 4; ++i) { const int l = mt * 16 + 4 * g4 + i; const float v = (s <= l) ? G[q][i] * __expf(acs[l * 4 + h] - as) : 0.f;
                    Mb[l * 72 + s] = f2bf(v); } }
            __syncthreads();
#pragma unroll
            for (int q = 0; q < 2; ++q) { const int nt = 2 * nh + q;
                f32x4 yd = (f32x4){0.f, 0.f, 0.f, 0.f}, yo = (f32x4){0.f, 0.f, 0.f, 0.f};
                yd = mma_nt<64>(Mb + mt * 16 * 72, 72, XT + (h * 64 + nt * 16) * 72, 72, yd, F.lane);
                yo = mma_nt<64>(Cg + (g * 64 + mt * 16) * 72, 72, S0 + nt * 16 * 72, 72, yo, F.lane);
                const int p = nt * 16 + r16; const float dsk = F.in[I_MD][layer * 4 + h];
#pragma unroll
                for (int i = 0; i < 4; ++i) { const int l = mt * 16 + 4 * g4 + i;
                    const float xs = bf2f(XT[(h * 64 + p) * 72 + l]) / dts[l * 4 + h];
                    yv[h][q][i] = yd[i] + yo[i] * __expf(acs[l * 4 + h]) + dsk * xs; } }
            __syncthreads();
        }
        float part[4] = {0.f, 0.f, 0.f, 0.f};
#pragma unroll
        for (int h = 0; h < 4; ++h)
#pragma unroll
            for (int q = 0; q < 2; ++q) { const int ch = h * 64 + (2 * nh + q) * 16 + r16;
#pragma unroll
                for (int i = 0; i < 4; ++i) { const int l = mt * 16 + 4 * g4 + i; const float z = bf2f(U[(T0 + l) * NINP + UM + ch]);
                    const float v = yv[h][q][i] * siluf_(z); yv[h][q][i] = v; part[i] += v * v; } }
#pragma unroll
        for (int i = 0; i < 4; ++i) { const float s = sum16(part[i]); if (r16 == 0) atomicAdd((float*)(rs + mt * 16 + 4 * g4 + i), s); }
        __syncthreads();
        bf16_t* Y = (bf16_t*)(F.ws + WS_H);
#pragma unroll
        for (int i = 0; i < 4; ++i) { const int l = mt * 16 + 4 * g4 + i; const float rstd = rsqrtf(rs[l] * (1.0f / 256.0f) + 1e-6f);
#pragma unroll
            for (int h = 0; h < 4; ++h)
#pragma unroll
                for (int q = 0; q < 2; ++q) { const int ch = h * 64 + (2 * nh + q) * 16 + r16;
                    Y[(T0 + l) * DM + ch] = f2bf(yv[h][q][i] * rstd * F.in[I_MNORM][layer * 256 + ch]); } }
    }
}
__device__ __forceinline__ void item_mamba_carry(const Frame& F_, int item) { Frame F = relocal(F_);
    const int b = item >> 2, h = item & 3;
    float* MST = (float*)(F.ws + WS_MST); const float* MD = (const float*)(F.ws + WS_MDEC);
    float s[8];
#pragma unroll
    for (int j = 0; j < 8; ++j) s[j] = 0.f;
    for (int c = 0; c < 64; ++c) { float* p = MST + ((size_t)(b * 64 + c) * 4 + h) * 4096 + F.tid * 8; const float d = MD[(b * 64 + c) * 4 + h];
        const f32x4 a = *(f32x4*)p, q = *(f32x4*)(p + 4);
        *(f32x4*)p = (f32x4){s[0], s[1], s[2], s[3]}; *(f32x4*)(p + 4) = (f32x4){s[4], s[5], s[6], s[7]};
        s[0] = s[0] * d + a[0]; s[1] = s[1] * d + a[1]; s[2] = s[2] * d + a[2]; s[3] = s[3] * d + a[3];
        s[4] = s[4] * d + q[0]; s[5] = s[5] * d + q[1]; s[6] = s[6] * d + q[2]; s[7] = s[7] * d + q[3]; }
}

template <int STAGE> __device__ __forceinline__ void item_s5(const Frame& F_, int layer, int item) { Frame F = relocal(F_);
    const bf16_t* U = (const bf16_t*)(F.ws + WS_U);
    const int b = item >> 6, c = item & 63; const size_t T0 = (size_t)b * SEQ + c * 64;
    LAS bf16_t* us = (LAS bf16_t*)F.lds;
    LAS bf16_t* BuW = (LAS bf16_t*)(F.lds + 33792) + F.wave * 4224;
    const float* tab = (const float*)(F.ws + WS_S5TAB + (size_t)layer * S5TAB_L);
    { const int tok = F.tid >> 3, part = F.tid & 7;
#pragma unroll
      for (int q = 0; q < 4; ++q) *(LAS u32x4*)(us + tok * 264 + 32 * part + 8 * q) = *(const u32x4*)(U + (T0 + tok) * NINP + US + 32 * part + 8 * q); }
    const int lane = F.lane, r16 = lane & 15, g4 = lane >> 4, gq = lane >> 5, n0 = lane & 31, g = 2 * F.wave + gq, gn0 = g * 64 + n0, gn1 = gn0 + 32;
    bf16x8 bfr[2][8];
    { const bf16_t* bbt = (const bf16_t*)(F.ws + WS_S5TAB + (size_t)layer * S5TAB_L + S5TAB_BBT);
#pragma unroll
      for (int gg = 0; gg < 2; ++gg)
#pragma unroll
          for (int nt = 0; nt < 8; ++nt) { u32x4 z = (u32x4){0u, 0u, 0u, 0u}; if (g4 < 2) z = *(const u32x4*)(bbt + ((size_t)(2 * F.wave + gg) * 128 + 16 * nt + r16) * 16 + 8 * g4); bfr[gg][nt] = __builtin_bit_cast(bf16x8, z); } }
    const float a0r = tab[gn0 * 2], a0i = tab[gn0 * 2 + 1], a1r = tab[gn1 * 2], a1i = tab[gn1 * 2 + 1];
    float* ST = (float*)(F.ws + WS_S5ST) + (size_t)(b * 64 + c) * 2048;
    float h0r = 0.f, h0i = 0.f, h1r = 0.f, h1i = 0.f;
    if (STAGE == 2) { h0r = ST[gn0 * 2]; h0i = ST[gn0 * 2 + 1]; h1r = ST[gn1 * 2]; h1i = ST[gn1 * 2 + 1]; }
    bf16x8 cf[2][4];
    if (STAGE == 2) { const bf16_t* cm = (const bf16_t*)(F.ws + WS_S5TAB + (size_t)layer * S5TAB_L + S5TAB_F);
#pragma unroll
        for (int gg = 0; gg < 2; ++gg)
#pragma unroll
            for (int ks = 0; ks < 4; ++ks) cf[gg][ks] = *(const bf16x8*)(cm + ((size_t)((2 * F.wave + gg) * 16 + r16)) * 128 + 32 * ks + 8 * g4); }
    __syncthreads();
#pragma unroll 1
    for (int lb = 0; lb < 4; ++lb) {
#pragma unroll
        for (int gg = 0; gg < 2; ++gg) { u32x4 z = (u32x4){0u, 0u, 0u, 0u}; if (g4 < 2) z = *(const LAS u32x4*)(us + (16 * lb + r16) * 264 + (2 * F.wave + gg) * 16 + 8 * g4);
            const bf16x8 afr = __builtin_bit_cast(bf16x8, z);
#pragma unroll
            for (int nt = 0; nt < 8; ++nt) { const f32x4 acc = __builtin_amdgcn_mfma_f32_16x16x32_bf16(afr, bfr[gg][nt], (f32x4){0.f, 0.f, 0.f, 0.f}, 0, 0, 0);
#pragma unroll
                for (int i = 0; i < 4; ++i) BuW[(4 * g4 + i) * 264 + gg * 128 + 16 * nt + r16] = f2bf(acc[i]); } }
        __syncthreads();
#pragma unroll 4
        for (int li = 0; li < 16; ++li) { LAS u32x2* bp = (LAS u32x2*)(BuW + li * 264 + gq * 128 + 4 * n0); const u32x2 v = *bp;
            { const float br = __uint_as_float(v.x << 16), bi = __uint_as_float(v.x & 0xffff0000u); const float nr = a0r * h0r - a0i * h0i + br, ni = a0r * h0i + a0i * h0r + bi; h0r = nr; h0i = ni; }
            { const float br = __uint_as_float(v.y << 16), bi = __uint_as_float(v.y & 0xffff0000u); const float nr = a1r * h1r - a1i * h1i + br, ni = a1r * h1i + a1i * h1r + bi; h1r = nr; h1i = ni; }
            if (STAGE == 2) *bp = (u32x2){pk2(h0r, h0i), pk2(h1r, h1i)}; }
        __syncthreads();
        if (STAGE == 2) {
            bf16_t* YS = (bf16_t*)(F.ws + WS_MOE + YSG_OFF);
#pragma unroll
            for (int gg = 0; gg < 2; ++gg) { f32x4 acc = (f32x4){0.f, 0.f, 0.f, 0.f};
#pragma unroll
                for (int ks = 0; ks < 4; ++ks) { const bf16x8 a = *(const LAS bf16x8*)(BuW + r16 * 264 + gg * 128 + 32 * ks + 8 * g4);
                    acc = __builtin_amdgcn_mfma_f32_16x16x32_bf16(a, cf[gg][ks], acc, 0, 0, 0); }
                const int ch = (2 * F.wave + gg) * 16 + r16; const float dsk = F.in[I_SD][layer * 256 + ch];
#pragma unroll
                for (int i = 0; i < 4; ++i) { const int l = lb * 16 + 4 * g4 + i; const float y = acc[i] + dsk * bf2f(us[l * 264 + ch]);
                    YS[(T0 + l) * 256 + ch] = f2bf(gelu_tanh(y)); } }
            __syncthreads();
        }
    }
    if (STAGE == 1) { ST[gn0 * 2] = h0r; ST[gn0 * 2 + 1] = h0i; ST[gn1 * 2] = h1r; ST[gn1 * 2 + 1] = h1i; }
    if (STAGE == 2) {
        asm volatile("s_waitcnt vmcnt(0)" ::: "memory"); __syncthreads();
        const bf16_t* YS = (const bf16_t*)(F.ws + WS_MOE + YSG_OFF) + T0 * 256; const bf16_t* GW = (const bf16_t*)(F.ws + WS_GLU) + (size_t)layer * 512 * 256;
        const int r16 = F.lane & 15, g4 = F.lane >> 4;
        f32x4 av[4][2], ag[4][2];
#pragma unroll
        for (int m = 0; m < 4; ++m)
#pragma unroll
            for (int q = 0; q < 2; ++q) { av[m][q] = (f32x4){0.f, 0.f, 0.f, 0.f}; ag[m][q] = (f32x4){0.f, 0.f, 0.f, 0.f}; }
#pragma unroll 2
        for (int ks = 0; ks < 8; ++ks) {
            bf16x8 af[4], bv[2], bg[2];
#pragma unroll
            for (int m = 0; m < 4; ++m) af[m] = *(const bf16x8*)(YS + (size_t)(16 * m + r16) * 256 + 32 * ks + 8 * g4);
#pragma unroll
            for (int q = 0; q < 2; ++q) { const int c = 32 * F.wave + 16 * q + r16; const int rowv = 256 * (c >> 7) + (c & 127);
                bv[q] = *(const bf16x8*)(GW + (size_t)rowv * 256 + 32 * ks + 8 * g4); bg[q] = *(const bf16x8*)(GW + (size_t)(rowv + 128) * 256 + 32 * ks + 8 * g4); }
#pragma unroll
            for (int m = 0; m < 4; ++m)
#pragma unroll
                for (int q = 0; q < 2; ++q) { av[m][q] = __builtin_amdgcn_mfma_f32_16x16x32_bf16(af[m], bv[q], av[m][q], 0, 0, 0); ag[m][q] = __builtin_amdgcn_mfma_f32_16x16x32_bf16(af[m], bg[q], ag[m][q], 0, 0, 0); }
        }
        bf16_t* Y = (bf16_t*)(F.ws + WS_H);
#pragma unroll
        for (int q = 0; q < 2; ++q) { const int c = 32 * F.wave + 16 * q + r16; const float bvl = F.in[I_SGLUB][layer * 512 + c], bgt = F.in[I_SGLUB][layer * 512 + 256 + c];
#pragma unroll
            for (int m = 0; m < 4; ++m)
#pragma unroll
                for (int i = 0; i < 4; ++i) Y[(T0 + 16 * m + 4 * g4 + i) * DM + 768 + c] = f2bf((av[m][q][i] + bvl) * sigmoidf_(ag[m][q][i] + bgt)); }
    }
}
__device__ __forceinline__ void item_s5_carry(const Frame& F_, int layer, int b) { Frame F = relocal(F_);
    const float* tab = (const float*)(F.ws + WS_S5TAB + (size_t)layer * S5TAB_L) + 2048;
    float* ST = (float*)(F.ws + WS_S5ST) + (size_t)b * 64 * 2048;
#pragma unroll
    for (int q = 0; q < 2; ++q) { const int gn = F.tid + 512 * q; const float pr = tab[gn * 2], pi = tab[gn * 2 + 1]; float hr = 0.f, hi = 0.f;
        for (int c = 0; c < 64; ++c) { float* p = ST + (size_t)c * 2048 + gn * 2; const float tr = p[0], ti = p[1]; p[0] = hr; p[1] = hi;
            const float nr = pr * hr - pi * hi + tr, ni = pr * hi + pi * hr + ti; hr = nr; hi = ni; } }
}

constexpr int RB_LD = 72;
constexpr int RW_R = 0, RW_K = 16384, RW_V = 32768, RW_W = 49152, RW_A = 65536, RW_B = 81920;
constexpr int R3_G = 49152, R3_O = 65536, R3_TILES = 81920, R3_BON = 147456;
template <int STAGE> __device__ __forceinline__ void rwkv_prep(const Frame& F_, int layer, int b, int h, int c) { Frame F = relocal(F_);
    const bf16_t* U = (const bf16_t*)(F.ws + WS_U);
    const int l0 = c * 64; const size_t T0 = (size_t)b * SEQ + l0;
    LAS float* Rr = (LAS float*)(F.lds + RW_R); LAS float* Kk = (LAS float*)(F.lds + RW_K); LAS float* Vv = (LAS float*)(F.lds + RW_V); LAS float* Ww = (LAS float*)(F.lds + RW_W);
    LAS float* Aa = (LAS float*)(F.lds + (STAGE == 1 ? RW_A : R3_O)); LAS float* Bb = (LAS float*)(F.lds + RW_B); LAS float* Gg = (LAS float*)(F.lds + R3_G); LAS float* BON = (LAS float*)(F.lds + R3_BON);
    LAS bf16_t* TWb = (LAS bf16_t*)(F.lds + 98304); LAS bf16_t* DAb = (LAS bf16_t*)(F.lds + (STAGE == 1 ? 103424 : 118784)); LAS bf16_t* SGb = (LAS bf16_t*)(F.lds + 123904);
    LAS bf16_t* w2T = (LAS bf16_t*)(F.lds + 108544); LAS bf16_t* a2T = (LAS bf16_t*)(F.lds + (STAGE == 1 ? 113664 : 133120)); LAS bf16_t* g2T = (LAS bf16_t*)(F.lds + 138240);
    const float* mu = F.in[I_RMU] + layer * 896;
    { const int tok = F.tid >> 3, p8 = F.tid & 7; const bool first = (l0 + tok == 0);
      const bf16_t* cur = U + (T0 + tok) * NINP + UR; const bf16_t* prv = cur - NINP;
#pragma unroll
      for (int sec = (STAGE == 1 ? 0 : 2); sec < 3; ++sec) { const int co = sec * 256 + h * 64 + 8 * p8; float av[8], pq[8]; unpack8(*(const u32x4*)(cur + co), av);
          if (first) {
#pragma unroll
              for (int j = 0; j < 8; ++j) pq[j] = 0.f; } else unpack8(*(const u32x4*)(prv + co), pq);
          const f32x4 m0 = *(const f32x4*)(mu + co), m1 = *(const f32x4*)(mu + co + 4);
          LAS float* dst = (sec == 0 ? Rr : sec == 1 ? Kk : Vv) + tok * 64 + 8 * p8;
          *(LAS f32x4*)dst = (f32x4){av[0] + m0[0] * (pq[0] - av[0]), av[1] + m0[1] * (pq[1] - av[1]), av[2] + m0[2] * (pq[2] - av[2]), av[3] + m0[3] * (pq[3] - av[3])};
          *(LAS f32x4*)(dst + 4) = (f32x4){av[4] + m1[0] * (pq[4] - av[4]), av[5] + m1[1] * (pq[5] - av[5]), av[6] + m1[2] * (pq[6] - av[6]), av[7] + m1[3] * (pq[7] - av[7])}; }
      if (STAGE == 1) { const int co = 768 + 4 * p8;
        const u32x2 cv = *(const u32x2*)(cur + co); u32x2 pv = (u32x2){0u, 0u}; if (!first) pv = *(const u32x2*)(prv + co);
        const f32x4 m0 = *(const f32x4*)(mu + co);
        float x[4] = {__uint_as_float(cv.x << 16), __uint_as_float(cv.x & 0xffff0000u), __uint_as_float(cv.y << 16), __uint_as_float(cv.y & 0xffff0000u)};
        const float y[4] = {__uint_as_float(pv.x << 16), __uint_as_float(pv.x & 0xffff0000u), __uint_as_float(pv.y << 16), __uint_as_float(pv.y & 0xffff0000u)};
#pragma unroll
        for (int j = 0; j < 4; ++j) x[j] = tanhf_(x[j] + m0[j] * (y[j] - x[j]));
        *(LAS u32x2*)(TWb + tok * 40 + 4 * p8) = (u32x2){pk2(x[0], x[1]), pk2(x[2], x[3])}; }
      if (STAGE == 1) { const int co = 800 + 4 * p8;
        const u32x2 cv = *(const u32x2*)(cur + co); u32x2 pv = (u32x2){0u, 0u}; if (!first) pv = *(const u32x2*)(prv + co);
        const f32x4 m0 = *(const f32x4*)(mu + co);
        float x[4] = {__uint_as_float(cv.x << 16), __uint_as_float(cv.x & 0xffff0000u), __uint_as_float(cv.y << 16), __uint_as_float(cv.y & 0xffff0000u)};
        const float y[4] = {__uint_as_float(pv.x << 16), __uint_as_float(pv.x & 0xffff0000u), __uint_as_float(pv.y << 16), __uint_as_float(pv.y & 0xffff0000u)};
#pragma unroll
        for (int j = 0; j < 4; ++j) x[j] = x[j] + m0[j] * (y[j] - x[j]);
        *(LAS u32x2*)(DAb + tok * 40 + 4 * p8) = (u32x2){pk2(x[0], x[1]), pk2(x[2], x[3])}; }
      if (STAGE == 3) { const int co = 832 + 8 * p8; float av[8], pq[8]; unpack8(*(const u32x4*)(cur + co), av);
          if (first) {
#pragma unroll
              for (int j = 0; j < 8; ++j) pq[j] = 0.f; } else unpack8(*(const u32x4*)(prv + co), pq);
          const f32x4 m0 = *(const f32x4*)(mu + co), m1 = *(const f32x4*)(mu + co + 4); float x[8];
#pragma unroll
          for (int j = 0; j < 8; ++j) x[j] = sigmoidf_(av[j] + (j < 4 ? m0[j] : m1[j - 4]) * (pq[j] - av[j]));
          *(LAS u32x4*)(SGb + tok * RB_LD + 8 * p8) = (u32x4){pk2(x[0], x[1]), pk2(x[2], x[3]), pk2(x[4], x[5]), pk2(x[6], x[7])}; } }
    { const int ch = F.tid & 63, part = F.tid >> 6;
      if (STAGE == 1) { const float* w2 = F.in[I_RW2] + ((size_t)layer * 32 + 4 * part) * 256 + h * 64 + ch;
          *(LAS u32x2*)(w2T + ch * 40 + 4 * part) = (u32x2){pk2(w2[0], w2[256]), pk2(w2[512], w2[768])}; }
      if (STAGE == 1) { const float* a2 = F.in[I_RA2] + ((size_t)layer * 32 + 4 * part) * 256 + h * 64 + ch;
          *(LAS u32x2*)(a2T + ch * 40 + 4 * part) = (u32x2){pk2(a2[0], a2[256]), pk2(a2[512], a2[768])}; }
      if (STAGE == 3) { const float* g2 = F.in[I_RG2] + ((size_t)layer * 64 + 8 * part) * 256 + h * 64 + ch;
          *(LAS u32x4*)(g2T + ch * RB_LD + 8 * part) = (u32x4){pk2(g2[0], g2[256]), pk2(g2[512], g2[768]), pk2(g2[1024], g2[1280]), pk2(g2[1536], g2[1792])}; } }
    __syncthreads();
    { const int lane = F.lane, mt = F.wave >> 1, nt0 = 2 * (F.wave & 1), r = lane & 15, g4 = lane >> 4; const f32x4 zero4 = (f32x4){0.f, 0.f, 0.f, 0.f};
#pragma unroll
      for (int q = 0; q < 2; ++q) { const int nt = nt0 + q, ch = 16 * nt + r, cg = layer * 256 + h * 64 + ch;
          if (STAGE == 1) { const f32x4 wl = mma_nt<32>(TWb + 16 * mt * 40, 40, w2T + 16 * nt * 40, 40, zero4, lane); const float w0 = F.in[I_RW0][cg];
#pragma unroll
              for (int i = 0; i < 4; ++i) { const float x = w0 + wl[i]; const float wlog = -__logf(1.0f + __expf(-x)) - 0.5f; Ww[(16 * mt + 4 * g4 + i) * 64 + ch] = __expf(-__expf(wlog)); } }
          if (STAGE == 1) { const f32x4 al = mma_nt<32>(DAb + 16 * mt * 40, 40, a2T + 16 * nt * 40, 40, zero4, lane); const float a0 = F.in[I_RA0][cg];
#pragma unroll
              for (int i = 0; i < 4; ++i) Aa[(16 * mt + 4 * g4 + i) * 64 + ch] = sigmoidf_(a0 + al[i]); }
          if (STAGE == 3) { const f32x4 gv = mma_nt<64>(SGb + 16 * mt * RB_LD, RB_LD, g2T + 16 * nt * RB_LD, RB_LD, zero4, lane);
#pragma unroll
              for (int i = 0; i < 4; ++i) Gg[(16 * mt + 4 * g4 + i) * 64 + ch] = gv[i]; } } }
    __syncthreads();
    float* gBON = (float*)(F.ws + WS_BON) + ((size_t)(b * 4 + h) * 64 + c) * 64;
    if (STAGE == 1) { const int j = F.lane, tq = F.wave, cg = layer * 256 + h * 64 + j;
      const float kkw = F.in[I_RKK][cg], kaw = F.in[I_RKA][cg], rk = F.in[I_RRK][cg];
#pragma unroll 2
      for (int i8 = 0; i8 < 8; ++i8) { const int t = tq + 8 * i8;
          const float a = Aa[t * 64 + j]; const float kraw = Kk[t * 64 + j]; const float kp = kraw * (1.0f + (a - 1.0f) * kaw);
          Kk[t * 64 + j] = kp;
          const float kkv = kraw * kkw; const float ss = wave_sum(kkv * kkv); const float kkn = kkv * rsqrtf(fmaxf(ss, 1e-24f)); Aa[t * 64 + j] = -kkn; Bb[t * 64 + j] = kkn * a;
          const float bo = wave_sum(Rr[t * 64 + j] * kp * rk); if (j == 0) gBON[t] = bo; } }
    else if (F.tid < 64) BON[F.tid] = gBON[F.tid];
    __syncthreads();
}
constexpr int RB_AT = 98304, RB_ATT = RB_AT + 9216, RB_BT = RB_ATT + 9216, RB_BTT = RB_BT + 9216, RB_KT = RB_BTT + 9216, RB_RT = RB_KT + 9216, RB_VT = RB_RT + 9216, RB_GC = RB_VT + 9216;
constexpr int RX_X = 0, RX_XT = 9216, RX_TB = 18432, RX_M = 27648, RX_NRT = 36864, RX_G1T = 46080, RX_G2T = 55296, RX_QT = 64512;
__device__ __forceinline__ void st_tile(LAS bf16_t* dst, int mt, int nt, const f32x4 v, int lane) {
    const int r = lane & 15, g = lane >> 4;
#pragma unroll
    for (int i = 0; i < 4; ++i) dst[(16 * mt + 4 * g + i) * RB_LD + 16 * nt + r] = f2bf(v[i]);
}
__device__ __forceinline__ void st_tile_t(LAS bf16_t* dst, int mt, int nt, const f32x4 v, int lane) {
    const int r = lane & 15, g = lane >> 4; u32x2 w; w.x = pk2(v[0], v[1]); w.y = pk2(v[2], v[3]);
    *(LAS u32x2*)(dst + (16 * nt + r) * RB_LD + 16 * mt + 4 * g) = w;
}
__device__ __forceinline__ void item_rwkv1(const Frame& F_, int layer, int item) { Frame F = relocal(F_);
    const int b = item >> 8, h = (item >> 6) & 3, c = item & 63;
    rwkv_prep<1>(F, layer, b, h, c);
    LAS float* Rr = (LAS float*)(F.lds + RW_R); LAS float* Kk = (LAS float*)(F.lds + RW_K); LAS float* Vv = (LAS float*)(F.lds + RW_V); LAS float* Ww = (LAS float*)(F.lds + RW_W);
    LAS float* Aa = (LAS float*)(F.lds + RW_A); LAS float* Bb = (LAS float*)(F.lds + RW_B);
    LAS bf16_t* At = (LAS bf16_t*)(F.lds + RB_AT); LAS bf16_t* AtT = (LAS bf16_t*)(F.lds + RB_ATT); LAS bf16_t* Bt = (LAS bf16_t*)(F.lds + RB_BT); LAS bf16_t* BtT = (LAS bf16_t*)(F.lds + RB_BTT);
    LAS bf16_t* Kt = (LAS bf16_t*)(F.lds + RB_KT); LAS bf16_t* Rt = (LAS bf16_t*)(F.lds + RB_RT); LAS bf16_t* VT = (LAS bf16_t*)(F.lds + RB_VT); LAS float* gC = (LAS float*)(F.lds + RB_GC);
    LAS bf16_t* X = (LAS bf16_t*)(F.lds + RX_X); LAS bf16_t* XT = (LAS bf16_t*)(F.lds + RX_XT); LAS bf16_t* Tb = (LAS bf16_t*)(F.lds + RX_TB); LAS bf16_t* Mm = (LAS bf16_t*)(F.lds + RX_M);
    LAS bf16_t* NrT = (LAS bf16_t*)(F.lds + RX_NRT); LAS bf16_t* G1T = (LAS bf16_t*)(F.lds + RX_G1T); LAS bf16_t* G2T = (LAS bf16_t*)(F.lds + RX_G2T); LAS bf16_t* QT = (LAS bf16_t*)(F.lds + RX_QT);
    { const int k = F.tid & 63, part = F.tid >> 6; float g = 1.0f;
      for (int pp = 0; pp < part; ++pp) { float w8[8];
#pragma unroll
          for (int i = 0; i < 8; ++i) w8[i] = Ww[(8 * pp + i) * 64 + k];
          g *= ((w8[0] * w8[1]) * (w8[2] * w8[3])) * ((w8[4] * w8[5]) * (w8[6] * w8[7])); }
#pragma unroll
      for (int i = 0; i < 8; ++i) { const int t = 8 * part + i; const float gp = g; g *= Ww[t * 64 + k]; const float ig = 1.0f / g;
          const bf16_t av = f2bf(Aa[t * 64 + k] * gp), bv = f2bf(Bb[t * 64 + k] * ig);
          At[t * RB_LD + k] = av; AtT[k * RB_LD + t] = av; Bt[t * RB_LD + k] = bv; BtT[k * RB_LD + t] = bv;
          Kt[t * RB_LD + k] = f2bf(Kk[t * 64 + k] * ig); Rt[t * RB_LD + k] = f2bf(Rr[t * 64 + k] * g); VT[k * RB_LD + t] = f2bf(Vv[t * 64 + k]); }
      if (part == 7) gC[k] = g; }
    __syncthreads();
    const int lane = F.lane, mt = F.wave >> 1, nt0 = 2 * (F.wave & 1), r = lane & 15, g4 = lane >> 4;
    const f32x4 zero4 = (f32x4){0.f, 0.f, 0.f, 0.f};
    f32x4 Tacc[2];
#pragma unroll
    for (int q = 0; q < 2; ++q) { const int nt = nt0 + q;
        f32x4 n = mma_nt<64>(Bt + 16 * mt * RB_LD, RB_LD, At + 16 * nt * RB_LD, RB_LD, zero4, lane);
        f32x4 m = mma_nt<64>(Kt + 16 * mt * RB_LD, RB_LD, At + 16 * nt * RB_LD, RB_LD, zero4, lane);
        f32x4 nr = mma_nt<64>(Rt + 16 * mt * RB_LD, RB_LD, Bt + 16 * nt * RB_LD, RB_LD, zero4, lane);
#pragma unroll
        for (int i = 0; i < 4; ++i) { const int row = 16 * mt + 4 * g4 + i, col = 16 * nt + r;
            n[i] = (row < col) ? n[i] : 0.f; m[i] = (row < col) ? m[i] : 0.f; nr[i] = (col <= row) ? nr[i] : 0.f;
            Tacc[q][i] = n[i] + (row == col ? 1.0f : 0.f); }
        st_tile(X, mt, nt, n, lane); st_tile_t(XT, mt, nt, n, lane); st_tile(Tb, mt, nt, Tacc[q], lane); st_tile(Mm, mt, nt, m, lane); st_tile(NrT, mt, nt, nr, lane); }
    __syncthreads();
#pragma unroll 1
    for (int it = 0; it < 6; ++it) {
        LAS bf16_t* Xr = (it & 1) ? G1T : X; LAS bf16_t* XTr = (it & 1) ? G2T : XT; LAS bf16_t* Tr = (it & 1) ? QT : Tb;
        LAS bf16_t* Xw = (it & 1) ? X : G1T; LAS bf16_t* XTw = (it & 1) ? XT : G2T; LAS bf16_t* Tw = (it & 1) ? Tb : QT;
#pragma unroll
        for (int q = 0; q < 2; ++q) { const int nt = nt0 + q;
            if (it > 0) Tacc[q] = mma_nt<64>(Tr + 16 * mt * RB_LD, RB_LD, XTr + 16 * nt * RB_LD, RB_LD, Tacc[q], lane);
            if (it < 5) { const f32x4 x2 = mma_nt<64>(Xr + 16 * mt * RB_LD, RB_LD, XTr + 16 * nt * RB_LD, RB_LD, zero4, lane); st_tile(Xw, mt, nt, x2, lane); st_tile_t(XTw, mt, nt, x2, lane); }
            st_tile(Tw, mt, nt, Tacc[q], lane); }
        __syncthreads();
    }
#pragma unroll
    for (int q = 0; q < 2; ++q) { const int nt = nt0 + q;
        st_tile(G1T, mt, nt, mma_nt<64>(NrT + 16 * mt * RB_LD, RB_LD, Tb + 16 * nt * RB_LD, RB_LD, zero4, lane), lane);
        st_tile(G2T, mt, nt, mma_nt<64>(BtT + 16 * mt * RB_LD, RB_LD, Tb + 16 * nt * RB_LD, RB_LD, zero4, lane), lane); }
    __syncthreads();
    const size_t ci = (size_t)(b * 4 + h) * 64 + c;
    bf16_t* gPT = (bf16_t*)(F.ws + WS_MOE + RW_PT) + ci * 4096; bf16_t* gW1 = (bf16_t*)(F.ws + WS_MOE + RW_W1) + ci * 4096; bf16_t* gZ = (bf16_t*)(F.ws + WS_MOE + RW_Z) + ci * 4096;
#pragma unroll
    for (int q = 0; q < 2; ++q) { const int nt = nt0 + q; const int col = 16 * nt + r;
        f32x4 w1 = mma_nt<64>(G1T + 16 * mt * RB_LD, RB_LD, AtT + 16 * nt * RB_LD, RB_LD, zero4, lane);
        f32x4 z = mma_nt<64>(G1T + 16 * mt * RB_LD, RB_LD, Mm + 16 * nt * RB_LD, RB_LD, zero4, lane);
        f32x4 mr = mma_nt<64>(Rt + 16 * mt * RB_LD, RB_LD, Kt + 16 * nt * RB_LD, RB_LD, zero4, lane);
        f32x4 p = mma_nt<64>(G2T + 16 * mt * RB_LD, RB_LD, AtT + 16 * nt * RB_LD, RB_LD, zero4, lane);
        f32x4 qq = mma_nt<64>(G2T + 16 * mt * RB_LD, RB_LD, Mm + 16 * nt * RB_LD, RB_LD, zero4, lane);
        const int pos = 32 * (col >> 5) + 8 * ((col >> 2) & 3) + 4 * ((col >> 4) & 1) + (col & 3);
#pragma unroll
        for (int i = 0; i < 4; ++i) { const int row = 16 * mt + 4 * g4 + i;
            gW1[row * 64 + col] = f2bf(w1[i] + bf2f(Rt[row * RB_LD + col]));
            gZ[row * 64 + col] = f2bf(z[i] + (col <= row ? mr[i] : 0.f));
            const float gc = gC[row];
            gPT[row * 64 + pos] = f2bf((p[i] + (row == col ? 1.0f : 0.f)) * gc);
            qq[i] = (qq[i] + bf2f(Kt[col * RB_LD + row])) * gc; }
        st_tile(QT, mt, nt, qq, lane); }
    __syncthreads();
    bf16_t* gU = (bf16_t*)(F.ws + WS_MOE + RW_U) + ci * 4096;
#pragma unroll
    for (int q = 0; q < 2; ++q) { const int nt = nt0 + q;
        const f32x4 u = mma_nt<64>(VT + 16 * mt * RB_LD, RB_LD, QT + 16 * nt * RB_LD, RB_LD, zero4, lane);
#pragma unroll
        for (int i = 0; i < 4; ++i) gU[(16 * mt + 4 * g4 + i) * 64 + 16 * nt + r] = f2bf(u[i]); }
}
__device__ __forceinline__ void item_rwkv_carry(const Frame& F_, int item) { Frame F = relocal(F_);
    const int bh = item * 2 + (F.wave >> 2), nt = F.wave & 3, r = F.lane & 15, g = F.lane >> 4;
    const bf16_t* PT = (const bf16_t*)(F.ws + WS_MOE + RW_PT); const bf16_t* Uc = (const bf16_t*)(F.ws + WS_MOE + RW_U); bf16_t* Ss = (bf16_t*)(F.ws + WS_MOE + RW_S);
    f32x4 acc[4];
#pragma unroll
    for (int m = 0; m < 4; ++m) acc[m] = (f32x4){0.f, 0.f, 0.f, 0.f};
    for (int c = 0; c < 64; ++c) { const size_t ci = (size_t)bh * 64 + c;
        bf16x8 af[4][2]; f32x4 cin[4];
#pragma unroll
        for (int m = 0; m < 4; ++m) { const u32x2 uv = *(const u32x2*)(Uc + ci * 4096 + (16 * nt + r) * 64 + 16 * m + 4 * g);
            cin[m] = (f32x4){__uint_as_float(uv.x << 16), __uint_as_float(uv.x & 0xffff0000u), __uint_as_float(uv.y << 16), __uint_as_float(uv.y & 0xffff0000u)};
#pragma unroll
            for (int s = 0; s < 2; ++s) af[m][s] = *(const bf16x8*)(PT + ci * 4096 + (16 * m + r) * 64 + 32 * s + 8 * g); }
        unsigned pw[4][2];
#pragma unroll
        for (int m = 0; m < 4; ++m) { pw[m][0] = pk2(acc[m][0], acc[m][1]); pw[m][1] = pk2(acc[m][2], acc[m][3]);
            *(u32x2*)(Ss + ci * 4096 + (16 * nt + r) * 64 + 16 * m + 4 * g) = (u32x2){pw[m][0], pw[m][1]}; }
        bf16x8 bfr[2];
#pragma unroll
        for (int s = 0; s < 2; ++s) bfr[s] = __builtin_bit_cast(bf16x8, (u32x4){pw[2 * s][0], pw[2 * s][1], pw[2 * s + 1][0], pw[2 * s + 1][1]});
#pragma unroll
        for (int m = 0; m < 4; ++m) { acc[m] = __builtin_amdgcn_mfma_f32_16x16x32_bf16(af[m][0], bfr[0], cin[m], 0, 0, 0);
            acc[m] = __builtin_amdgcn_mfma_f32_16x16x32_bf16(af[m][1], bfr[1], acc[m], 0, 0, 0); }
    }
}
__device__ __forceinline__ void item_rwkv3(const Frame& F_, int layer, int item) { Frame F = relocal(F_);
    const int b = item >> 8, h = (item >> 6) & 3, c = item & 63; const size_t T0 = (size_t)b * SEQ + c * 64;
    rwkv_prep<3>(F, layer, b, h, c);
#ifdef PROBE_PREP
    rwkv_prep<3>(F, layer, b, h, c);
#endif
    LAS float* Vv = (LAS float*)(F.lds + RW_V); LAS float* Oo = (LAS float*)(F.lds + R3_O);
    LAS float* Gg = (LAS float*)(F.lds + R3_G); LAS float* BON = (LAS float*)(F.lds + R3_BON);
    LAS bf16_t* S0b = (LAS bf16_t*)(F.lds + R3_TILES); LAS bf16_t* W1b = S0b + 4608; LAS bf16_t* Zb = W1b + 4608; LAS bf16_t* VTb = Zb + 4608;
    { const size_t ci = (size_t)(b * 4 + h) * 64 + c; const int row = F.tid >> 3, col = (F.tid & 7) * 8;
      *(LAS u32x4*)(S0b + row * RB_LD + col) = *(const u32x4*)((const bf16_t*)(F.ws + WS_MOE + RW_S) + ci * 4096 + F.tid * 8);
      *(LAS u32x4*)(W1b + row * RB_LD + col) = *(const u32x4*)((const bf16_t*)(F.ws + WS_MOE + RW_W1) + ci * 4096 + F.tid * 8);
      *(LAS u32x4*)(Zb + row * RB_LD + col) = *(const u32x4*)((const bf16_t*)(F.ws + WS_MOE + RW_Z) + ci * 4096 + F.tid * 8);
      const int vv = F.tid & 63, part = F.tid >> 6;
#pragma unroll
      for (int i = 0; i < 8; ++i) { const int t = 8 * part + i; VTb[vv * RB_LD + t] = f2bf(Vv[t * 64 + vv]); } }
    __syncthreads();
    { const int lane = F.lane, mt = F.wave >> 1, nt0 = 2 * (F.wave & 1), r = lane & 15, g4 = lane >> 4;
#pragma unroll
      for (int q = 0; q < 2; ++q) { const int nt = nt0 + q;
          f32x4 o = mma_nt<64>(W1b + 16 * mt * RB_LD, RB_LD, S0b + 16 * nt * RB_LD, RB_LD, (f32x4){0.f, 0.f, 0.f, 0.f}, lane);
          o = mma_nt<64>(Zb + 16 * mt * RB_LD, RB_LD, VTb + 16 * nt * RB_LD, RB_LD, o, lane);
#pragma unroll
          for (int i = 0; i < 4; ++i) Oo[(16 * mt + 4 * g4 + i) * 64 + 16 * nt + r] = o[i]; } }
    __syncthreads();
    { const int j = F.lane, tq = F.wave, ch = h * 64 + j;
      const float lw = F.in[I_RLNW][layer * 256 + ch], lb = F.in[I_RLNB][layer * 256 + ch];
      bf16_t* Y = (bf16_t*)(F.ws + WS_H);
#pragma unroll 2
      for (int i8 = 0; i8 < 8; ++i8) { const int t = tq + 8 * i8;
          const float o = Oo[t * 64 + j]; const float mean = wave_sum(o) * (1.0f / 64.0f); const float d = o - mean; const float var = wave_sum(d * d) * (1.0f / 64.0f);
          float on = d * rsqrtf(var + 64e-5f) * lw + lb; on += BON[t] * Vv[t * 64 + j];
          Y[(T0 + t) * DM + 256 + ch] = f2bf(on * Gg[t * 64 + j]); } }
}

constexpr int DS_SEL = 131072, DS_HIST = 135168, DS_BKT = 151552, DS_BIAS = 152064;
__device__ __forceinline__ unsigned fkey(float f) { const unsigned u = __float_as_uint(f); return (u & 0x80000000u) ? ~u : (u | 0x80000000u); }
__device__ __forceinline__ void item_dsa(const Frame& F_, int layer, int item) { Frame F = relocal(F_);
    const bf16_t* U = (const bf16_t*)(F.ws + WS_U); const bf16_t* KI = (const bf16_t*)(F.ws + WS_KIDX);
    const bf16_t* Kb = (const bf16_t*)(F.ws + WS_K); const bf16_t* Vb = (const bf16_t*)(F.ws + WS_V);
    const int b = item & 3, qg = 511 - (item >> 2); const size_t TB = (size_t)b * SEQ, T0 = TB + qg * 8;
    LAS float* sc = (LAS float*)F.lds; LAS unsigned short* selall = (LAS unsigned short*)(F.lds + DS_SEL); LAS unsigned* histall = (LAS unsigned*)(F.lds + DS_HIST);
    LAS int* bkt = (LAS int*)(F.lds + DS_BKT); LAS float* biasT = (LAS float*)(F.lds + DS_BIAS);
    if (F.tid < 128) { const int n = F.tid; int bk = n; if (n >= 16) { const float lr = logf((float)n / 16.0f) / 2.0794415416798357f; bk = 16 + (int)(lr * 16.0f); bk = bk < 31 ? bk : 31; } bkt[n] = bk; biasT[n] = F.in[I_RELB][n]; }
    const int lane = F.lane, hh = lane >> 5;
    {
        bf16x8 af[2][2]; float wq[2][2][8];
        { const int r = lane & 31, q4 = 2 * ((r >> 2) & 1) + (r >> 4), head = 4 * ((r >> 3) & 1) + (r & 3);
#pragma unroll
          for (int mt = 0; mt < 2; ++mt)
#pragma unroll
              for (int ks = 0; ks < 2; ++ks) af[mt][ks] = *(const bf16x8*)(U + (T0 + 4 * mt + q4) * NINP + UC + 384 + head * 32 + 16 * ks + 8 * hh); }
#pragma unroll
        for (int mt = 0; mt < 2; ++mt)
#pragma unroll
            for (int q2 = 0; q2 < 2; ++q2) { float f[8]; unpack8(*(const u32x4*)(U + (T0 + 4 * mt + 2 * hh + q2) * NINP + UC + 672), f);
#pragma unroll
                for (int hd = 0; hd < 8; ++hd) wq[mt][q2][hd] = f[hd]; }
        const int ntile = (qg * 8 + 8 + 31) >> 5;
        bf16x8 nb0 = af[0][0], nb1 = af[0][0];
        if (F.wave < ntile) { const int key = F.wave * 32 + (lane & 31); nb0 = *(const bf16x8*)(KI + (TB + key) * 32 + 8 * hh); nb1 = *(const bf16x8*)(KI + (TB + key) * 32 + 16 + 8 * hh); }
        for (int kt = F.wave; kt < ntile; kt += 8) {
            const int key = kt * 32 + (lane & 31);
            const bf16x8 b0 = nb0, b1 = nb1;
            if (kt + 8 < ntile) { const int k2 = key + 256; nb0 = *(const bf16x8*)(KI + (TB + k2) * 32 + 8 * hh); nb1 = *(const bf16x8*)(KI + (TB + k2) * 32 + 16 + 8 * hh); }
#pragma unroll
            for (int mt = 0; mt < 2; ++mt) { f32x16 acc;
#pragma unroll
                for (int i = 0; i < 16; ++i) acc[i] = 0.f;
                acc = __builtin_amdgcn_mfma_f32_32x32x16_bf16(af[mt][0], b0, acc, 0, 0, 0);
                acc = __builtin_amdgcn_mfma_f32_32x32x16_bf16(af[mt][1], b1, acc, 0, 0, 0);
#pragma unroll
                for (int q2 = 0; q2 < 2; ++q2) { float s = 0.f;
#pragma unroll
                    for (int hd = 0; hd < 8; ++hd) s += fmaxf(acc[8 * q2 + hd], 0.f) * wq[mt][q2][hd];
                    const int qi = 4 * mt + 2 * hh + q2;
                    sc[qi * 4096 + key] = (key <= qg * 8 + qi) ? s : -INFINITY; } }
        }
    }
    __syncthreads();
    const int qi = F.wave, tq = qg * 8 + qi, n = tq + 1;
    LAS float* scq = sc + qi * 4096; LAS unsigned short* sel = selall + qi * 256; LAS unsigned* hist = histall + qi * 512;
    int nsel;
    if (n <= 256) { nsel = n; for (int j = lane; j < 256; j += 64) sel[j] = (unsigned short)(j < n ? j : 0); }
    else {
        nsel = 256;
        const int R = (n + 63) >> 6; const unsigned long long ltm = (1ull << lane) - 1ull;
        float lo = INFINITY, hi = -INFINITY;
        const int R4 = (n + 255) >> 8;
#pragma unroll 4
        for (int i = 0; i < R4; ++i) { const int j0 = 256 * i + 4 * lane; const f32x4 v4 = *(const LAS f32x4*)(scq + j0);
#pragma unroll
            for (int q = 0; q < 4; ++q) { const bool valid = j0 + q < n; lo = fminf(lo, valid ? v4[q] : INFINITY); hi = fmaxf(hi, valid ? v4[q] : -INFINITY); } }
#pragma unroll
        for (int o = 1; o < 64; o <<= 1) { lo = fminf(lo, shx(lo, o)); hi = fmaxf(hi, shx(hi, o)); }
        bool slow = false;
        if (!(hi > lo)) { for (int j = lane; j < 256; j += 64) sel[j] = (unsigned short)j; }
        else {
            const float scale = 1023.0f / (hi - lo);
            *(LAS u32x4*)(hist + 8 * lane) = (u32x4){0u, 0u, 0u, 0u}; *(LAS u32x4*)(hist + 8 * lane + 4) = (u32x4){0u, 0u, 0u, 0u};
#pragma unroll 2
            for (int i = 0; i < R4; ++i) { const int j0 = 256 * i + 4 * lane; const f32x4 v4 = *(const LAS f32x4*)(scq + j0);
#pragma unroll
                for (int q = 0; q < 4; ++q) { if (j0 + q < n) { int bk = (int)((v4[q] - lo) * scale); bk = bk < 1023 ? bk : 1023;
                    atomicAdd((unsigned*)(hist + (bk >> 1)), (bk & 1) ? 65536u : 1u); } } }
            const u32x4 h0 = *(const LAS u32x4*)(hist + 8 * lane), h1 = *(const LAS u32x4*)(hist + 8 * lane + 4);
            unsigned cb[16];
            cb[0] = h0.x & 0xffffu; cb[1] = h0.x >> 16; cb[2] = h0.y & 0xffffu; cb[3] = h0.y >> 16; cb[4] = h0.z & 0xffffu; cb[5] = h0.z >> 16; cb[6] = h0.w & 0xffffu; cb[7] = h0.w >> 16;
            cb[8] = h1.x & 0xffffu; cb[9] = h1.x >> 16; cb[10] = h1.y & 0xffffu; cb[11] = h1.y >> 16; cb[12] = h1.z & 0xffffu; cb[13] = h1.z >> 16; cb[14] = h1.w & 0xffffu; cb[15] = h1.w >> 16;
            unsigned tot = 0u;
#pragma unroll
            for (int q = 0; q < 16; ++q) tot += cb[q];
            unsigned incl = tot;
#pragma unroll
            for (int o = 1; o < 64; o <<= 1) { const unsigned t = shdown_u(incl, o); if (lane + o < 64) incl += t; }
            int fb = -1; unsigned fabove = 0u, fcnt = 0u; unsigned cum = incl - tot;
#pragma unroll
            for (int q = 15; q >= 0; --q) { if (fb < 0 && cum < 256u && 256u <= cum + cb[q]) { fb = 16 * lane + q; fabove = cum; fcnt = cb[q]; } cum += cb[q]; }
            const unsigned long long mf = __ballot(fb >= 0); const int src = (int)__ffsll((long long)mf) - 1;
            const int B = shidx_i(fb, src); const int above = shidx_i((int)fabove, src), cntB = shidx_i((int)fcnt, src); const int need = 256 - above;
            if (cntB > 256) slow = true;
            else {
                LAS unsigned* cand = hist;
                int base_gt = 0, base_c = 0;
#pragma unroll 2
                for (int i = 0; i < R4; ++i) { const int j0 = 256 * i + 4 * lane; const f32x4 v4 = *(const LAS f32x4*)(scq + j0);
#pragma unroll
                    for (int q = 0; q < 4; ++q) { const int j = j0 + q; const bool valid = j < n; const float v = valid ? v4[q] : lo;
                        int bk = (int)((v - lo) * scale); bk = bk < 1023 ? bk : 1023;
                        const bool gt = valid && bk > B, eq = valid && bk == B;
                        const unsigned long long mg = __ballot(gt), me = __ballot(eq);
                        if (gt) sel[base_gt + __popcll(mg & ltm)] = (unsigned short)j;
                        if (eq) { const int p = base_c + __popcll(me & ltm); cand[2 * p] = fkey(v); cand[2 * p + 1] = (unsigned)j; }
                        base_gt += __popcll(mg); base_c += __popcll(me); } }
                if (need == cntB) { for (int c = lane; c < cntB; c += 64) sel[above + c] = (unsigned short)cand[2 * c + 1]; }
                else {
                    unsigned ck[4], cx[4]; int rk[4];
#pragma unroll
                    for (int q = 0; q < 4; ++q) { const int c = lane + 64 * q; ck[q] = c < cntB ? cand[2 * c] : 0u; cx[q] = c < cntB ? cand[2 * c + 1] : 0u; rk[q] = 0; }
                    for (int c2 = 0; c2 < cntB; ++c2) { const unsigned k2 = cand[2 * c2], x2 = cand[2 * c2 + 1];
#pragma unroll
                        for (int q = 0; q < 4; ++q) rk[q] += (k2 > ck[q] || (k2 == ck[q] && x2 < cx[q])) ? 1 : 0; }
#pragma unroll
                    for (int q = 0; q < 4; ++q) { const int c = lane + 64 * q; if (c < cntB && rk[q] < need) sel[above + rk[q]] = (unsigned short)cand[2 * c + 1]; }
                }
            }
        }
        if (slow) {
        unsigned prefix = 0u; int need = 256; unsigned neq = 0u;
        for (int p = 0; p < 4; ++p) { const int shift = 24 - 8 * p;
            *(LAS u32x4*)(hist + 4 * lane) = (u32x4){0u, 0u, 0u, 0u};
            for (int i = 0; i < R; ++i) { const int j = lane + 64 * i; if (j < n) { const unsigned u = fkey(scq[j]);
                if (p == 0 || (u >> (shift + 8)) == prefix) atomicAdd((unsigned*)(hist + ((u >> shift) & 255u)), 1u); } }
            const u32x4 hv = *(const LAS u32x4*)(hist + 4 * lane);
            const unsigned tot = hv.x + hv.y + hv.z + hv.w;
            unsigned incl = tot;
#pragma unroll
            for (int o = 1; o < 64; o <<= 1) { const unsigned t = shdown_u(incl, o); if (lane + o < 64) incl += t; }
            const unsigned above = incl - tot;
            int fb = -1; unsigned fabove = 0u, feq = 0u; unsigned cum = above;
            { const unsigned hq[4] = {hv.x, hv.y, hv.z, hv.w};
#pragma unroll
              for (int q = 3; q >= 0; --q) { if (fb < 0 && cum < (unsigned)need && (unsigned)need <= cum + hq[q]) { fb = 4 * lane + q; fabove = cum; feq = hq[q]; } cum += hq[q]; } }
            const unsigned long long m = __ballot(fb >= 0);
            const int src = (int)__ffsll((long long)m) - 1;
            const int bin = shidx_i(fb, src); const unsigned ab = (unsigned)shidx_i((int)fabove, src); neq = (unsigned)shidx_i((int)feq, src);
            need -= (int)ab; prefix = (prefix << 8) | (unsigned)bin;
        }
        const int ngt = 256 - need;
        int base_gt = 0, base_eq = 0;
        for (int i = 0; i < R; ++i) { const int j = lane + 64 * i; const unsigned u = (j < n) ? fkey(scq[j]) : 0u;
            const bool gt = (j < n) && (u > prefix), eq = (j < n) && (u == prefix);
            const unsigned long long mg = __ballot(gt), me = __ballot(eq); const unsigned long long lt = (1ull << lane) - 1ull;
            if (gt) sel[base_gt + __popcll(mg & lt)] = (unsigned short)j;
            if (eq) { const int rk = base_eq + __popcll(me & lt); if (rk < need) sel[ngt + rk] = (unsigned short)j; }
            base_gt += __popcll(mg); base_eq += __popcll(me); }
        (void)neq;
            }
    }
    const int nt16 = (nsel + 15) >> 4, r16 = lane & 15, g4 = lane >> 4;
    LAS float* biasj = scq + 2048;
#pragma unroll
    for (int q = 0; q < 4; ++q) { const int j = lane + 64 * q; f32x4 bv = (f32x4){-INFINITY, -INFINITY, -INFINITY, -INFINITY};
        if (j < nsel) { const int dist = tq - (int)sel[j]; const int bk = dist < 128 ? bkt[dist < 0 ? 0 : dist] : 31; bv = *(const LAS f32x4*)(biasT + 4 * bk); }
        *(LAS f32x4*)(biasj + 4 * j) = bv; }
    bf16x8 qf[2];
#pragma unroll
    for (int s = 0; s < 2; ++s) { u32x4 z = (u32x4){0u, 0u, 0u, 0u}; if (r16 < 4) z = *(const u32x4*)(U + (T0 + qi) * NINP + UC + r16 * 64 + 32 * s + 8 * g4); qf[s] = __builtin_bit_cast(bf16x8, z); }
    float lg[16][4]; float mx = -INFINITY;
#define DSA_QK(M0, NM) do { int keyr[NM]; bf16x8 a0[NM], a1[NM]; \
        _Pragma("unroll") for (int m8 = 0; m8 < NM; ++m8) keyr[m8] = sel[16 * ((M0) + m8) + r16]; \
        _Pragma("unroll") for (int m8 = 0; m8 < NM; ++m8) { a0[m8] = *(const bf16x8*)(Kb + (TB + keyr[m8]) * 64 + 8 * g4); a1[m8] = *(const bf16x8*)(Kb + (TB + keyr[m8]) * 64 + 32 + 8 * g4); } \
        _Pragma("unroll") for (int m8 = 0; m8 < NM; ++m8) { const int m = (M0) + m8; \
            f32x4 acc = (f32x4){0.f, 0.f, 0.f, 0.f}; \
            acc = __builtin_amdgcn_mfma_f32_16x16x32_bf16(a0[m8], qf[0], acc, 0, 0, 0); \
            acc = __builtin_amdgcn_mfma_f32_16x16x32_bf16(a1[m8], qf[1], acc, 0, 0, 0); \
            _Pragma("unroll") for (int i = 0; i < 4; ++i) { const float v = acc[i] * 0.125f + biasj[(16 * m + 4 * g4 + i) * 4 + (r16 & 3)]; lg[m][i] = v; mx = fmaxf(mx, v); } } } while (0)
    if (nt16 > 8) { DSA_QK(0, 16); }
    else { DSA_QK(0, 8);
#pragma unroll
        for (int m8 = 8; m8 < 16; ++m8)
#pragma unroll
            for (int i = 0; i < 4; ++i) lg[m8][i] = -INFINITY; }
#undef DSA_QK
    mx = fmaxf(mx, shx(mx, 16)); mx = fmaxf(mx, shx(mx, 32));
    float sm = 0.f;
#pragma unroll
    for (int m = 0; m < 16; ++m)
#pragma unroll
        for (int i = 0; i < 4; ++i) { const float p = __expf(lg[m][i] - mx); lg[m][i] = p; sm += p; }
    sm += shx(sm, 16); sm += shx(sm, 32);
    f32x4 ov[4];
#pragma unroll
    for (int nt = 0; nt < 4; ++nt) ov[nt] = (f32x4){0.f, 0.f, 0.f, 0.f};
    const unsigned vs_base = (unsigned)(unsigned long)scq;
#pragma unroll
    for (int half = 0; half < 2; ++half) {
        if (half * 8 < nt16) {
            asm volatile("s_waitcnt lgkmcnt(0)" ::: "memory");
            int vkey[16];
#pragma unroll
            for (int q = 0; q < 16; ++q) { const int rho = 8 * q + (lane >> 3);
                vkey[q] = sel[half * 128 + (rho & ~31) + 16 * ((rho >> 2) & 1) + 4 * ((rho >> 3) & 3) + (rho & 3)]; }
            asm volatile("s_waitcnt lgkmcnt(0)" : "+v"(vkey[0]), "+v"(vkey[1]), "+v"(vkey[2]), "+v"(vkey[3]), "+v"(vkey[4]), "+v"(vkey[5]), "+v"(vkey[6]), "+v"(vkey[7]),
                         "+v"(vkey[8]), "+v"(vkey[9]), "+v"(vkey[10]), "+v"(vkey[11]), "+v"(vkey[12]), "+v"(vkey[13]), "+v"(vkey[14]), "+v"(vkey[15]) :: "memory");
#pragma unroll
            for (int q = 0; q < 16; ++q)
                __builtin_amdgcn_global_load_lds((const unsigned*)(Vb + (TB + vkey[q]) * 64 + 8 * (lane & 7)), (LAS unsigned*)((LAS unsigned char*)scq + q * 1024), 16, 0, 0);
            asm volatile("s_waitcnt vmcnt(0)" ::: "memory");
#pragma unroll
            for (int s4 = 0; s4 < 4; ++s4) { const int s = half * 4 + s4;
                u32x4 pw; pw.x = pk2(lg[2 * s][0], lg[2 * s][1]); pw.y = pk2(lg[2 * s][2], lg[2 * s][3]); pw.z = pk2(lg[2 * s + 1][0], lg[2 * s + 1][1]); pw.w = pk2(lg[2 * s + 1][2], lg[2 * s + 1][3]);
                const bf16x8 pa = __builtin_bit_cast(bf16x8, pw);
                const unsigned ad = vs_base + (unsigned)((32 * s4 + 8 * g4 + (r16 >> 2)) * 128 + (r16 & 3) * 8);
                u32x2 t0[4], t1[4];
                asm volatile("ds_read_b64_tr_b16 %0, %8\n\tds_read_b64_tr_b16 %1, %8 offset:512\n\tds_read_b64_tr_b16 %2, %8 offset:32\n\tds_read_b64_tr_b16 %3, %8 offset:544\n\t"
                             "ds_read_b64_tr_b16 %4, %8 offset:64\n\tds_read_b64_tr_b16 %5, %8 offset:576\n\tds_read_b64_tr_b16 %6, %8 offset:96\n\tds_read_b64_tr_b16 %7, %8 offset:608\n\ts_waitcnt lgkmcnt(0)"
                             : "=&v"(t0[0]), "=&v"(t1[0]), "=&v"(t0[1]), "=&v"(t1[1]), "=&v"(t0[2]), "=&v"(t1[2]), "=&v"(t0[3]), "=&v"(t1[3]) : "v"(ad) : "memory");
#pragma unroll
                for (int nt = 0; nt < 4; ++nt) { const bf16x8 vb = __builtin_bit_cast(bf16x8, (u32x4){t0[nt].x, t0[nt].y, t1[nt].x, t1[nt].y});
                    ov[nt] = __builtin_amdgcn_mfma_f32_16x16x32_bf16(pa, vb, ov[nt], 0, 0, 0); } }
        }
    }
    { float inv[4];
#pragma unroll
      for (int h = 0; h < 4; ++h) inv[h] = 1.0f / __int_as_float(__builtin_amdgcn_readlane(__float_as_int(sm), h));
      if (lane < 16) { bf16_t* Y = (bf16_t*)(F.ws + WS_H) + (T0 + qi) * DM + 512 + r16;
#pragma unroll
          for (int h = 0; h < 4; ++h)
#pragma unroll
              for (int nt = 0; nt < 4; ++nt) Y[h * 64 + 16 * nt] = f2bf(ov[nt][h] * inv[h]); } }
}

__device__ __forceinline__ void phase_router(const Frame& F_, int layer) { Frame F = relocal(F_); const int cset = layer;
    const float* X = (const float*)(F.ws + WS_X);
    const bf16_t* WH = (const bf16_t*)(F.ws + WS_WRT) + (size_t)layer * 2 * 49152; const bf16_t* WL = WH + 49152;
    LAS float* part = (LAS float*)F.lds;
    LAS float* ssq = (LAS float*)(F.lds + 24576);
    LAS int* es = (LAS int*)(F.lds + 25088);
    LAS int* lr = (LAS int*)(F.lds + 25600);
    LAS float* wsl = (LAS float*)(F.lds + 26112);
    LAS float* rsd = (LAS float*)(F.lds + 26624);
    for (int blk = F.bid; blk < NTOK / 64; blk += F.G) {
        __syncthreads();
        const int mt = F.wave & 3, kh = F.wave >> 2, r16 = F.lane & 15, g4 = F.lane >> 4;
        const float* xr = X + ((size_t)blk * 64 + mt * 16 + r16) * DM + kh * 512 + 8 * g4;
        f32x4 acc[3]; acc[0] = acc[1] = acc[2] = (f32x4){0.f, 0.f, 0.f, 0.f}; float ss = 0.f;
#pragma unroll 4
        for (int ks = 0; ks < 16; ++ks) {
            const f32x4 xa = *(const f32x4*)(xr + ks * 32), xb = *(const f32x4*)(xr + ks * 32 + 4);
            ss += xa[0] * xa[0] + xa[1] * xa[1] + xa[2] * xa[2] + xa[3] * xa[3] + xb[0] * xb[0] + xb[1] * xb[1] + xb[2] * xb[2] + xb[3] * xb[3];
            float xv[8] = {xa[0], xa[1], xa[2], xa[3], xb[0], xb[1], xb[2], xb[3]}; unsigned hw[4], lw[4];
#pragma unroll
            for (int j = 0; j < 4; ++j) { const bf16_t h0 = f2bf(xv[2 * j]), h1 = f2bf(xv[2 * j + 1]); hw[j] = (unsigned)h0 | ((unsigned)h1 << 16);
                lw[j] = pk2(xv[2 * j] - bf2f(h0), xv[2 * j + 1] - bf2f(h1)); }
            const bf16x8 ahi = __builtin_bit_cast(bf16x8, (u32x4){hw[0], hw[1], hw[2], hw[3]}), alo = __builtin_bit_cast(bf16x8, (u32x4){lw[0], lw[1], lw[2], lw[3]});
#pragma unroll
            for (int nt = 0; nt < 3; ++nt) { const size_t wo = (size_t)(nt * 16 + r16) * 1024 + kh * 512 + ks * 32 + 8 * g4;
                const bf16x8 bh = *(const bf16x8*)(WH + wo), bl = *(const bf16x8*)(WL + wo);
                acc[nt] = __builtin_amdgcn_mfma_f32_16x16x32_bf16(ahi, bh, acc[nt], 0, 0, 0);
                acc[nt] = __builtin_amdgcn_mfma_f32_16x16x32_bf16(ahi, bl, acc[nt], 0, 0, 0);
                acc[nt] = __builtin_amdgcn_mfma_f32_16x16x32_bf16(alo, bh, acc[nt], 0, 0, 0); }
        }
        ss += shx(ss, 16); ss += shx(ss, 32);
        if (g4 == 0) ssq[kh * 64 + mt * 16 + r16] = ss;
#pragma unroll
        for (int nt = 0; nt < 3; ++nt)
#pragma unroll
            for (int i = 0; i < 4; ++i) part[(kh * 64 + mt * 16 + 4 * g4 + i) * 48 + nt * 16 + r16] = acc[nt][i];
        __syncthreads();
        if (F.tid < 64) { const float rstd = rsqrtf((ssq[F.tid] + ssq[64 + F.tid]) * (1.0f / DM) + 1e-6f); rsd[F.tid] = rstd;
            float l[36];
#pragma unroll
            for (int o = 0; o < 36; ++o) l[o] = (part[F.tid * 48 + o] + part[(64 + F.tid) * 48 + o]) * rstd + (o < 32 ? F.in[I_BRE][layer * 32 + o] : F.in[I_BRG][layer * 4 + o - 32]);
            int gs = 0; float gm = l[32];
#pragma unroll
            for (int j = 1; j < 4; ++j) if (l[32 + j] > gm) { gm = l[32 + j]; gs = j; }
            float den = 0.f;
#pragma unroll
            for (int j = 0; j < 4; ++j) den += __expf(l[32 + j] - gm);
            const float gate = 1.0f / den;
            float e8[8];
#pragma unroll
            for (int j = 0; j < 8; ++j) e8[j] = gs == 0 ? l[j] : gs == 1 ? l[8 + j] : gs == 2 ? l[16 + j] : l[24 + j];
            int i1 = 0; float v1 = e8[0];
#pragma unroll
            for (int j = 1; j < 8; ++j) if (e8[j] > v1) { v1 = e8[j]; i1 = j; }
            int i2 = -1; float v2 = -INFINITY;
#pragma unroll
            for (int j = 0; j < 8; ++j) if (j != i1 && e8[j] > v2) { v2 = e8[j]; i2 = j; }
            const float e2 = __expf(v2 - v1); const float p1 = 1.0f / (1.0f + e2);
            es[F.tid * 2] = gs * 8 + i1; es[F.tid * 2 + 1] = gs * 8 + i2; wsl[F.tid * 2] = p1 * gate; wsl[F.tid * 2 + 1] = (1.0f - p1) * gate; }
        __syncthreads();
        if (F.tid < 32) { int cnt = 0; for (int i = 0; i < 128; ++i) if (es[i] == F.tid) lr[i] = cnt++;
            if (cnt) { const int base = (int)__hip_atomic_fetch_add(F.ctl + CW_CNT + cset * 32 + F.tid, (unsigned)cnt, __ATOMIC_RELAXED, __HIP_MEMORY_SCOPE_AGENT);
                for (int i = 0; i < 128; ++i) if (es[i] == F.tid) lr[i] += base; } }
        __syncthreads();
        if (F.tid < 64) { int* rt = (int*)(F.ws + WS_ROUTE) + ((size_t)blk * 64 + F.tid) * 8;
            rt[0] = es[F.tid * 2]; rt[1] = es[F.tid * 2 + 1]; ((float*)rt)[2] = wsl[F.tid * 2]; ((float*)rt)[3] = wsl[F.tid * 2 + 1]; rt[4] = lr[F.tid * 2]; rt[5] = lr[F.tid * 2 + 1]; ((float*)rt)[6] = rsd[F.tid]; }
    }
    __syncthreads();
    if (F.tid == 0) __hip_atomic_fetch_add(F.ctl + CW_RB + 64 * layer, 1u, __ATOMIC_RELAXED, __HIP_MEMORY_SCOPE_AGENT);
}
__device__ __forceinline__ void phase_moe_convert(const Frame& F_, int layer) { Frame F = relocal(F_);
    bf16_t* WGU = (bf16_t*)(F.ws + WS_MOE + MOE_WGU); bf16_t* WD = (bf16_t*)(F.ws + WS_MOE + MOE_WD);
    for (int t = F.bid; t < 1536; t += F.G) {
        if (t < 1024) { const int e = t >> 5, r = t & 31, kt = r >> 1, nt = r & 1; const size_t eo = ((size_t)layer * 32 + e) * 1024 * 256;
            tr_tile(F, 256, WGU + (size_t)e * 512 * 1024, 1024, kt * 64, nt * 256, SmGU{F.in[I_WGATE] + eo, F.in[I_WUP] + eo}); }
        else { const int q = t - 1024, e = q >> 4, r = q & 15, kt = r >> 2, nt = r & 3;
            tr_tile(F, 1024, WD + (size_t)e * 1024 * 256, 256, kt * 64, nt * 256, SmId{F.in[I_WDOWN] + ((size_t)layer * 32 + e) * 256 * 1024}); }
    }
}
__device__ __forceinline__ void phase_gather(const Frame& F_, int layer) { Frame F = relocal(F_);
    LAS int* off = (LAS int*)F.lds;
    __syncthreads();
    if (F.tid == 0) { unsigned sp = 0;
        while (__hip_atomic_load(F.ctl + CW_RB + 64 * layer, __ATOMIC_RELAXED, __HIP_MEMORY_SCOPE_AGENT) < (unsigned)F.G) { __builtin_amdgcn_s_sleep(2); if (++sp > (1u << 22)) break; } }
    __syncthreads();
    if (F.tid == 0) { int acc = 0; for (int e = 0; e < 32; ++e) { off[e] = acc; const int c = (int)__hip_atomic_load(F.ctl + CW_CNT + layer * 32 + e, __ATOMIC_RELAXED, __HIP_MEMORY_SCOPE_AGENT); acc += (c + 255) & ~255; } off[32] = acc; }
    __syncthreads();
    int* tiles = (int*)(F.ws + WS_TILES); int* row_tok = (int*)(F.ws + WS_ROWS); float* row_w = (float*)(F.ws + WS_ROWS) + MAXROWS;
    if (F.bid == 0) { if (F.tid == 0) tiles[0] = off[32] >> 8; if (F.tid < 33) tiles[1 + F.tid] = off[F.tid];
        if (F.tid < 32) for (int rt = off[F.tid] >> 8; rt < (off[F.tid + 1] >> 8); ++rt) tiles[64 + rt] = F.tid; }
    for (int e = F.bid; e < 32; e += F.G) { const int c = (int)__hip_atomic_load(F.ctl + CW_CNT + layer * 32 + e, __ATOMIC_RELAXED, __HIP_MEMORY_SCOPE_AGENT);
        for (int r = off[e] + c + F.tid; r < off[e + 1]; r += NTHR) { row_tok[r] = -1; row_w[r] = 0.f; } }
    const float* X = (const float*)(F.ws + WS_X); bf16_t* HP = (bf16_t*)(F.ws + WS_U); const float* nw = F.in[I_NORM2] + (size_t)layer * DM;
    f32x4 nwv[4];
#pragma unroll
    for (int j = 0; j < 4; ++j) nwv[j] = *(const f32x4*)(nw + 4 * F.lane + 256 * j);
    for (int blk = F.bid; blk < NTOK / 64; blk += F.G)
    for (int i8 = 0; i8 < 8; ++i8) { const int t = blk * 64 + F.wave * 8 + i8;
        const int* rt = (const int*)(F.ws + WS_ROUTE) + (size_t)t * 8; const float rstd = ((const float*)rt)[6];
        const int p0 = off[rt[0]] + rt[4], p1 = off[rt[1]] + rt[5];
#pragma unroll
        for (int j = 0; j < 4; ++j) { const int c = 4 * F.lane + 256 * j; const f32x4 v = *(const f32x4*)(X + (size_t)t * DM + c) * rstd * nwv[j];
            u32x2 o; o.x = pk2(v[0], v[1]); o.y = pk2(v[2], v[3]);
            *(u32x2*)(HP + (size_t)p0 * DM + c) = o; *(u32x2*)(HP + (size_t)p1 * DM + c) = o; }
        if (F.lane == 0) { row_tok[p0] = t * 2; row_w[p0] = ((const float*)rt)[2]; row_tok[p1] = t * 2 + 1; row_w[p1] = ((const float*)rt)[3]; }
    }
}

constexpr int NPH_LAYER = 9, NPHASE = 1 + 2 * NPH_LAYER + 1;
#ifndef MK_ONLY
#define MK_ONLY -1
#endif
#ifndef MK_ITEM
#define MK_ITEM -1
#endif
#define EN(o) (MK_ONLY < 0 || MK_ONLY == (o))
#define IT(o) (MK_ITEM < 0 || MK_ITEM == (o))
__global__ void __launch_bounds__(NTHR, 2) mk_forward(Params P) {
    extern __shared__ __attribute__((aligned(16))) unsigned char lds_raw[];
    Frame F; F.lds = (LAS unsigned char*)lds_raw; F.tid = threadIdx.x; F.lane = F.tid & 63; F.wave = __builtin_amdgcn_readfirstlane(F.tid >> 6); F.bid = blockIdx.x; F.G = gridDim.x;
    F.in = (in_tab_t)__builtin_amdgcn_kernarg_segment_ptr(); F.out = P.out; F.ws = P.ws; F.ctl = (unsigned*)(P.ws + WS_CTL); F.misc = (volatile LAS int*)(F.lds + MISC_OFF);
    if (F.tid < 64) ((LAS unsigned*)(F.lds + MISC_OFF))[F.tid] = 0u;
    __syncthreads();
    const int lo = P.ph_lo, hi = P.ph_hi;
    XcdBarrier bar; bar.bar = F.ctl + CW_BAR; bar.x = 0; bar.st = (volatile LAS unsigned*)(F.lds + MISC_OFF + 16);
    if (hi - lo > 1) bar = xcd_barrier_post(F.ctl + CW_BAR, (volatile LAS unsigned*)(F.lds + MISC_OFF + 16));
#define IN(k) (lo <= (k) && (k) < hi)
#define SEAM(k) do { if (IN(k) && IN((k) + 1)) xcd_barrier(bar); } while (0)
#define QLOOP(qi, n, body) for (;;) { const int it = q_pop(F, layer * 12 + (qi)); if (it >= (n)) break; body; }
    if (EN(100) && IN(0)) { phase_prologue(F); phase_norm(F, F.in[I_X], false, F.in[I_NORM1], 0); } SEAM(0);
#pragma unroll
    for (int layer = 0; layer < DEPTH; ++layer) {
        const int pb = 1 + layer * NPH_LAYER;
        if (layer > 0) { if (EN(0) && IN(pb + 0)) { phase_norm(F, (const float*)(F.ws + WS_X), true, F.in[I_NORM1] + (size_t)layer * DM, 0); } SEAM(pb + 0); }
        if (EN(1) && IN(pb + 1)) { const Frame F_ = F; Frame F = relocal(F_); pg8::StaticOrder S; S.init((const bf16_t*)(F.ws + WS_H), (const bf16_t*)(F.ws + WS_WIN) + (size_t)layer * NINP * DM, NTOK, NINP, DM, F.G, F.bid);
            pg8::EpiBf16 E{(bf16_t*)(F.ws + WS_U), NINP}; pg8::gemm_phase(F.lds, DM, S, E); } SEAM(pb + 1);
        if (EN(2) && IN(pb + 2)) {
            if (IT(0)) QLOOP(0, 256, item_s5<1>(F, layer, it));
            if (IT(1)) QLOOP(1, 1024, item_rwkv1(F, layer, it));
            if (IT(2)) QLOOP(2, 256, item_mamba<1>(F, layer, it));
            if (IT(3)) QLOOP(3, 256, item_kv(F, layer, it));
        } SEAM(pb + 2);
        if (EN(3) && IN(pb + 3)) {
            if (IT(0)) QLOOP(4, 8, item_rwkv_carry(F, it));
            if (IT(1)) QLOOP(5, 16, item_mamba_carry(F, it));
            if (IT(2)) QLOOP(6, 4, item_s5_carry(F, layer, it));
            if (IT(3)) {
                const int pref = (int)(xb_xcc_id() & 3u);
#pragma unroll 1
                for (int k4 = 0; k4 < 4; ++k4) { const int bq = (pref + k4) & 3;
                    for (;;) { const int it = q_pop(F, 24 + layer * 4 + bq); if (it >= 512) break; item_dsa(F, layer, it * 4 + bq); } } }
        } SEAM(pb + 3);
        if (EN(4) && IN(pb + 4)) {
            if (IT(0)) QLOOP(8, 256, item_s5<2>(F, layer, it));
            if (IT(1)) QLOOP(9, 1024, item_rwkv3(F, layer, it));
            if (IT(2)) QLOOP(10, 256, item_mamba<2>(F, layer, it));
        } SEAM(pb + 4);
        if (EN(6) && IN(pb + 5)) { const Frame F_ = F; Frame F = relocal(F_); pg8::StaticOrder S; S.init((const bf16_t*)(F.ws + WS_H), (const bf16_t*)(F.ws + WS_WOUT) + (size_t)layer * DM * DM, NTOK, DM, DM, F.G, F.bid);
            pg8::EpiResid E{(float*)(F.ws + WS_X), DM}; pg8::gemm_phase(F.lds, DM, S, E); } SEAM(pb + 5);
        if (EN(7) && IN(pb + 6)) { phase_router(F, layer); phase_moe_convert(F, layer); phase_gather(F, layer); } SEAM(pb + 6);
        if (EN(8) && IN(pb + 7)) { const Frame F_ = F; Frame F = relocal(F_); pg8::MoeOrder S{2, F.G, F.bid, DM, (const char*)(F.ws + WS_U), (const char*)(F.ws + WS_MOE + MOE_WGU), (size_t)512 * 1024 * 2, (const int*)(F.ws + WS_TILES)};
            pg8::EpiGated<1> E{(bf16_t*)(F.ws + WS_H), 256, 0, nullptr, nullptr}; pg8::gemm_phase(F.lds, DM, S, E); } SEAM(pb + 7);
        if (EN(9) && IN(pb + 8)) { const Frame F_ = F; Frame F = relocal(F_); pg8::MoeOrder S{4, F.G, F.bid, 256, (const char*)(F.ws + WS_H), (const char*)(F.ws + WS_MOE + MOE_WD), (size_t)1024 * 256 * 2, (const int*)(F.ws + WS_TILES)};
            pg8::EpiMoeOut E{(bf16_t*)(F.ws + WS_U), (const int*)(F.ws + WS_ROWS), (const float*)(F.ws + WS_ROWS) + MAXROWS, F.lds}; pg8::gemm_phase(F.lds, 256, S, E); } SEAM(pb + 8);
    }
    if (EN(101) && IN(NPHASE - 1)) { phase_norm(F, (const float*)(F.ws + WS_X), true, F.in[I_FNORM], 2); }
#undef IN
#undef SEAM
}

#ifndef MK_SPLIT
#define MK_SPLIT 0
#endif
extern "C" void kernel_launch(void* const* d_in, const int* in_sizes, int n_in, void* d_out, int out_size, void* d_ws, size_t ws_size, hipStream_t stream) {
    static int grid = 0;
    if (grid == 0) {
        if (n_in != 44 || out_size != NTOK * DM || ws_size < WS_END) { fprintf(stderr, "kernel_launch: unexpected shapes (n_in %d out %d ws %zu need %zu)\n", n_in, out_size, ws_size, (size_t)WS_END); grid = -1; return; }
        int dev = 0, cus = 0;
        if (hipGetDevice(&dev) != hipSuccess || hipDeviceGetAttribute(&cus, hipDeviceAttributeMultiprocessorCount, dev) != hipSuccess) { grid = -1; return; }
        if (hipFuncSetAttribute((const void*)mk_forward, hipFuncAttributeMaxDynamicSharedMemorySize, LDS_BYTES) != hipSuccess) { fprintf(stderr, "kernel_launch: hipFuncSetAttribute failed\n"); grid = -1; return; }
        int per_cu = 0;
        if (hipOccupancyMaxActiveBlocksPerMultiprocessor(&per_cu, (const void*)mk_forward, NTHR, LDS_BYTES) != hipSuccess || per_cu < 1) { fprintf(stderr, "kernel_launch: occupancy query says %d\n", per_cu); }
        (void)hipGetLastError();
        grid = cus;
    }
    if (grid < 0) return;
    hipMemsetAsync((char*)d_ws + WS_CTL, 0, CTL_BYTES, stream);
    Params p{};
    for (int i = 0; i < 44; ++i) p.in[i] = (const float*)d_in[i];
    p.out = (float*)d_out; p.ws = (unsigned char*)d_ws;
#if MK_SPLIT
    for (int ph = 0; ph < NPHASE; ++ph) { p.ph_lo = ph; p.ph_hi = ph + 1; hipLaunchKernelGGL(mk_forward, dim3(grid), dim3(NTHR), LDS_BYTES, stream, p); }
#else
    p.ph_lo = 0; p.ph_hi = NPHASE; hipLaunchKernelGGL(mk_forward, dim3(grid), dim3(NTHR), LDS_BYTES, stream, p);
#endif
}
```

```cpp
#include <hip/hip_runtime.h>
#include <stdint.h>
#include <stdio.h>

#define LAS __attribute__((address_space(3)))
typedef unsigned short bf16_t;
typedef short bf16x8 __attribute__((ext_vector_type(8)));
typedef float f32x4 __attribute__((ext_vector_type(4)));
typedef float f32x2 __attribute__((ext_vector_type(2)));
typedef float f32x16 __attribute__((ext_vector_type(16)));
typedef unsigned u32x4 __attribute__((ext_vector_type(4)));
typedef unsigned u32x2 __attribute__((ext_vector_type(2)));

constexpr int NTOK = 16384, DM = 1024, SEQ = 4096, NBATCH = 4, DEPTH = 2;
constexpr int NIN = 2604, NINP = 2816;
constexpr int UM = 0;
constexpr int UR = 784;
constexpr int UC = 1680;
constexpr int US = 2368;
constexpr int NTHR = 512;
constexpr int LDS_BYTES = 163840;
constexpr int MISC_OFF = LDS_BYTES - 256;

constexpr size_t WS_CTL   = 0;
constexpr size_t CTL_BYTES = 65536;
constexpr size_t WS_X     = WS_CTL + CTL_BYTES;
constexpr size_t WS_H     = WS_X + (size_t)NTOK * DM * 4;
constexpr size_t WS_U     = WS_H + (size_t)NTOK * DM * 2;
constexpr size_t WS_WIN   = WS_U + (size_t)NTOK * NINP * 2;
constexpr size_t WS_WOUT  = WS_WIN + (size_t)2 * NINP * DM * 2;
constexpr size_t WS_GLU   = WS_WOUT + (size_t)2 * DM * DM * 2;
constexpr size_t WS_MOE   = WS_GLU + (size_t)2 * 512 * 256 * 2;
constexpr size_t MOE_WGU  = 0;
constexpr size_t MOE_WD   = (size_t)32 * 512 * 1024 * 2;
constexpr size_t MOE_BYTES = MOE_WD + (size_t)32 * 1024 * 256 * 2;
constexpr size_t RW_PT    = 0;
constexpr size_t RW_U     = (size_t)1024 * 4096 * 2;
constexpr size_t RW_S     = RW_U + (size_t)1024 * 4096 * 2;
constexpr size_t RW_W1    = RW_S + (size_t)1024 * 4096 * 2;
constexpr size_t RW_Z     = RW_W1 + (size_t)1024 * 4096 * 2;
constexpr size_t YSG_OFF  = RW_Z + (size_t)1024 * 4096 * 2;
static_assert(YSG_OFF + (size_t)NTOK * 256 * 2 <= MOE_BYTES, "alias");
constexpr size_t WS_MST   = WS_MOE + MOE_BYTES;
constexpr size_t WS_MDEC  = WS_MST + (size_t)4 * 64 * 4 * 4096 * 4;
constexpr size_t WS_S5ST  = WS_MDEC + 4096;
constexpr size_t WS_K     = WS_S5ST + (size_t)4 * 64 * 2048 * 4;
constexpr size_t WS_V     = WS_K + (size_t)NTOK * 64 * 2;
constexpr size_t WS_KIDX  = WS_V + (size_t)NTOK * 64 * 2;
constexpr size_t WS_ROUTE = WS_KIDX + (size_t)NTOK * 32 * 2;
constexpr size_t WS_ROWS  = WS_ROUTE + (size_t)NTOK * 32;
constexpr int    MAXROWS  = 49152;
constexpr size_t WS_TILES = WS_ROWS + (size_t)MAXROWS * 8;
constexpr size_t WS_S5TAB = WS_TILES + 4096;
constexpr size_t S5TAB_F  = (size_t)(2048 + 2048 + 32768) * 4;
constexpr size_t S5TAB_BBT = S5TAB_F + (size_t)16 * 16 * 128 * 2;
constexpr size_t S5TAB_L  = S5TAB_BBT + (size_t)16 * 128 * 16 * 2;
constexpr size_t WS_WRT   = WS_S5TAB + 2 * S5TAB_L;
constexpr size_t WS_BON   = WS_WRT + (size_t)2 * 2 * 48 * 1024 * 2;
constexpr size_t WS_END   = WS_BON + (size_t)1024 * 64 * 4;

constexpr int CW_BAR = 0;
constexpr int CW_Q   = 4096;
constexpr int CW_CNT = 8192;
constexpr int CW_RB  = 8448;

__device__ __forceinline__ float bf2f(bf16_t b) { return __uint_as_float(((unsigned)b) << 16); }
__device__ __forceinline__ bf16_t f2bf(float f) { const __bf16 h = (__bf16)f; return __builtin_bit_cast(bf16_t, h); }
__device__ __forceinline__ unsigned pk2(float lo, float hi) { typedef __bf16 bf2_t __attribute__((ext_vector_type(2))); const bf2_t h = __builtin_convertvector((f32x2){lo, hi}, bf2_t); return __builtin_bit_cast(unsigned, h); }
__device__ __forceinline__ unsigned cvt_pk_bf16(float lo, float hi) { unsigned r; asm volatile("v_cvt_pk_bf16_f32 %0, %1, %2" : "=v"(r) : "v"(lo), "v"(hi)); return r; }
__device__ __forceinline__ float sigmoidf_(float x) { return 1.0f / (1.0f + __expf(-x)); }
__device__ __forceinline__ float siluf_(float x) { return x / (1.0f + __expf(-x)); }
__device__ __forceinline__ float tanhf_(float x) { const float e = __expf(2.0f * x); return 1.0f - 2.0f / (e + 1.0f); }
__device__ __forceinline__ float softplusf_(float x) { return fmaxf(x, 0.0f) + log1pf(__expf(-fabsf(x))); }
__device__ __forceinline__ float gelu_tanh(float x) { return 0.5f * x * (1.0f + tanhf_(0.7978845608028654f * (x + 0.044715f * x * x * x))); }
template <int CTRL> __device__ __forceinline__ float dppf(float x) { return __int_as_float(__builtin_amdgcn_update_dpp(0, __float_as_int(x), CTRL, 0xF, 0xF, true)); }
__device__ __forceinline__ float sum4(float x) { x += dppf<0xB1>(x); x += dppf<0x4E>(x); return x; }
__device__ __forceinline__ float sum8(float x) { x = sum4(x); x += dppf<0x141>(x); return x; }
__device__ __forceinline__ float sum16(float x) { x = sum8(x); x += dppf<0x140>(x); return x; }
__device__ __forceinline__ int lane_id_() { int l = (int)__builtin_amdgcn_mbcnt_hi(~0u, __builtin_amdgcn_mbcnt_lo(~0u, 0u)); asm volatile("" : "+v"(l)); return l; }
__device__ __forceinline__ float shx(float x, int o) { return __int_as_float(__builtin_amdgcn_ds_bpermute((lane_id_() ^ o) << 2, __float_as_int(x))); }
__device__ __forceinline__ unsigned shdown_u(unsigned x, int o) { return (unsigned)__builtin_amdgcn_ds_bpermute(((lane_id_() + o) & 63) << 2, (int)x); }
__device__ __forceinline__ int shidx_i(int x, int src) { return __builtin_amdgcn_ds_bpermute(src << 2, x); }
__device__ __forceinline__ float wave_sum(float x) { x = sum16(x); x += shx(x, 16); x += shx(x, 32); return x; }
__device__ __forceinline__ void unpack8(const u32x4 v, float (&f)[8]) {
    f[0] = __uint_as_float(v.x << 16); f[1] = __uint_as_float(v.x & 0xffff0000u); f[2] = __uint_as_float(v.y << 16); f[3] = __uint_as_float(v.y & 0xffff0000u);
    f[4] = __uint_as_float(v.z << 16); f[5] = __uint_as_float(v.z & 0xffff0000u); f[6] = __uint_as_float(v.w << 16); f[7] = __uint_as_float(v.w & 0xffff0000u);
}

#define XB_TMO      128
#define XB_XCNT(j)  (256  + 64 * (j))
#define XB_XSUB(j)  (1280 + 64 * (j))
#define XB_XGEN(j)  (2304 + 64 * (j))
#define XB_TOP      3328
#define XB_TOPGEN   3392
#define XCD_BAR_WORDS 3456
#define XB_SPIN_CAP (1u << 22)
__device__ __forceinline__ unsigned xb_ld(unsigned* p)              { return __hip_atomic_load(p, __ATOMIC_RELAXED, __HIP_MEMORY_SCOPE_AGENT); }
__device__ __forceinline__ unsigned xb_add(unsigned* p, unsigned v) { return __hip_atomic_fetch_add(p, v, __ATOMIC_RELAXED, __HIP_MEMORY_SCOPE_AGENT); }
__device__ __forceinline__ unsigned xb_xcc_id() { return (unsigned)__builtin_amdgcn_s_getreg((3 << 11) | 20) & 0xFu; }
#define XB_SPIN(cond, bar) do { unsigned _sp = 0; while (cond) { __builtin_amdgcn_s_sleep(1); \
    if ((++_sp & 255u) == 0u) { if (xb_ld(&(bar)[XB_TMO])) break; if (_sp > XB_SPIN_CAP) { atomicAdd(&(bar)[XB_TMO], 1u); break; } } } } while (0)
struct XcdBarrier { unsigned* bar; unsigned x; volatile LAS unsigned* st; };
__device__ __forceinline__ XcdBarrier xcd_barrier_post(unsigned* bar, volatile LAS unsigned* st) {
    XcdBarrier b; b.bar = bar; b.x = xb_xcc_id(); b.st = st;
    if (threadIdx.x == 0) (void)xb_add(&bar[XB_XCNT(b.x)], 1u);
    return b;
}
__device__ __forceinline__ void xcd_barrier_complete(unsigned* bar, unsigned x, unsigned& nloc, unsigned& nx) {
    const unsigned G = gridDim.x * gridDim.y * gridDim.z;
    unsigned sum, cnt, mine, sp = 0u;
    for (;;) {
        sum = 0u; cnt = 0u; mine = 0u;
#pragma unroll
        for (unsigned j = 0; j < 16; ++j) { const unsigned c = xb_ld(&bar[XB_XCNT(j)]); sum += c; cnt += (c > 0u) ? 1u : 0u; mine = (j == x) ? c : mine; }
        if (sum == G) break;
        __builtin_amdgcn_s_sleep(1);
        if ((++sp & 255u) == 0u) { if (xb_ld(&bar[XB_TMO])) break; if (sp > XB_SPIN_CAP) { atomicAdd(&bar[XB_TMO], 1u); break; } }
    }
    nloc = mine > 0u ? mine : 1u; nx = cnt > 0u ? cnt : 1u;
}
__device__ __forceinline__ void xcd_barrier(const XcdBarrier& b_) {
    XcdBarrier b = b_; { const unsigned long long v = (unsigned long long)b.bar; unsigned lo = __builtin_amdgcn_readfirstlane((unsigned)v), hi = __builtin_amdgcn_readfirstlane((unsigned)(v >> 32)); asm volatile("" : "+s"(lo), "+s"(hi)); b.bar = (unsigned*)(((unsigned long long)hi << 32) | lo); unsigned xx = __builtin_amdgcn_readfirstlane(b.x); asm volatile("" : "+s"(xx)); b.x = xx; }
    asm volatile("s_waitcnt vmcnt(0)" ::: "memory");
    __syncthreads();
    if (threadIdx.x == 0) {
        unsigned* bar = b.bar;
        __builtin_amdgcn_s_waitcnt(0);
        unsigned nloc = b.st[0], nx = b.st[1];
        if (nloc == 0u) { xcd_barrier_complete(bar, b.x, nloc, nx); b.st[0] = nloc; b.st[1] = nx; }
        const unsigned old = xb_add(&bar[XB_XSUB(b.x)], 1u);
        const unsigned gen = old / nloc;
        if (old + 1u == (gen + 1u) * nloc) {
            __builtin_amdgcn_fence(__ATOMIC_RELEASE, "agent");
            asm volatile("s_waitcnt vmcnt(0)" ::: "memory");
            const unsigned og = xb_add(&bar[XB_TOP], 1u);
            const unsigned tg = og / nx;
            if (og + 1u == (tg + 1u) * nx) xb_add(&bar[XB_TOPGEN], 1u);
            else XB_SPIN(xb_ld(&bar[XB_TOPGEN]) == tg, bar);
            __builtin_amdgcn_fence(__ATOMIC_ACQUIRE, "agent");
            xb_add(&bar[XB_XGEN(b.x)], 1u);
            asm volatile("s_waitcnt vmcnt(0)" ::: "memory");
        } else {
            XB_SPIN(xb_ld(&bar[XB_XGEN(b.x)]) == gen, bar);
            __builtin_amdgcn_fence(__ATOMIC_ACQUIRE, "agent");
            asm volatile("s_waitcnt vmcnt(0)" ::: "memory");
        }
    }
    __syncthreads();
}

namespace pg8 {
constexpr int BM = 256, BK = 64, HALF = 128, HTB = HALF * BK * 2, STAGE_BYTES = 8 * HTB, NXCD = 8, WGM = 8;
__host__ __device__ __forceinline__ int lds_byte(int r, int c) { const int st = (r >> 4) * 2 + (c >> 5), rr = r & 15, cc = c & 31, ob = rr * 64 + cc * 2; return st * 1024 + (ob ^ (((ob >> 9) & 1) << 5)); }
__host__ __device__ __forceinline__ void stage_rc(int b, int& R, int& C) { const int st = b / 1024, sb = b % 1024, swz = sb ^ (((sb >> 9) & 1) << 5); R = (st >> 1) * 16 + swz / 64; C = (st & 1) * 32 + (swz % 64) / 2; }
__host__ __device__ __forceinline__ int perm32(int rho) { const int n = rho >> 4, i = rho & 15; return 8 * (i >> 2) + 4 * n + (i & 3); }
struct Unit { int pm, pn; const char* a; const char* b; };

struct StaticOrder {
    int nM, nN, nwg, G, c, K; const char* A; const char* B;
    __device__ void init(const bf16_t* A_, const bf16_t* B_, int M, int N, int K_, int G_, int c_) { A = (const char*)A_; B = (const char*)B_; K = K_; nM = M / BM; nN = N / BM; nwg = nM * nN; G = G_; c = c_; }
    __device__ bool next(int i, Unit& u) const {
        const long L = (long)i * G + c; if (L >= nwg) return false;
        int wgid = (int)L; { const int q = nwg / NXCD, r = nwg % NXCD, xcd = wgid % NXCD, off = wgid / NXCD; wgid = (xcd < r ? xcd * (q + 1) : r * (q + 1) + (xcd - r) * q) + off; }
        const int nig = WGM * nN, gid = wgid / nig, fm = gid * WGM, gsz = (nM - fm) < WGM ? (nM - fm) : WGM;
        u.pm = fm + ((wgid % nig) % gsz); u.pn = (wgid % nig) / gsz;
        u.a = A + (size_t)u.pm * 256 * K * 2; u.b = B + (size_t)u.pn * 256 * K * 2; return true;
    }
};

template <class Epi, class Sched>
__device__ __forceinline__ void gemm_phase(LAS unsigned char* lds, const int K_, const Sched& S, const Epi& E) {
    int K = K_; asm volatile("" : "+s"(K));
    int tid_ = threadIdx.x; asm volatile("" : "+v"(tid_));
    const int tid = tid_, wid = __builtin_amdgcn_readfirstlane(tid >> 6), lane = tid & 63, wr = wid >> 2, wc = wid & 3, fr = lane & 15, fq = lane >> 4;
    const int nt = K / BK;
    unsigned voffA[2], voffB[2];
#pragma unroll
    for (int i = 0; i < 2; ++i) { int R, C; stage_rc(tid * 16 + i * 8192, R, C); const int Rb = Epi::PERM ? ((R & ~31) + perm32(R & 31)) : R;
        voffA[i] = (unsigned)(R * K + C) * 2u; voffB[i] = (unsigned)(Rb * K + C) * 2u; }
    const size_t kstep = (size_t)(BK * 2);
    const size_t hstep = (size_t)HALF * K * 2;
    const unsigned ldsw = (unsigned)wid * 1024u;
    const int aoff = lds_byte(wr * 64 + fr, fq * 8), boff = lds_byte(wc * 32 + fr, fq * 8);
#define PG8_SA(b, h) (((b) * 2 + (h)) * HTB)
#define PG8_SB(b, h) ((4 + (b) * 2 + (h)) * HTB)
#define PG8_STAGE(bufoff, gbase, voff) do { _Pragma("unroll") for (int _i = 0; _i < 2; ++_i) \
        __builtin_amdgcn_global_load_lds((const unsigned*)((const char*)(gbase) + (voff)[_i]), (LAS unsigned*)(lds + (bufoff) + ldsw + _i * 8192), 16, 0, 0); } while (0)
#define PG8_LDA(dst, b, h) do { _Pragma("unroll") for (int m = 0; m < 4; ++m) _Pragma("unroll") for (int k = 0; k < 2; ++k) dst[m][k] = *(const LAS bf16x8*)(lds + PG8_SA(b, h) + aoff + m * 2048 + k * 1024); } while (0)
#define PG8_LDB(dst, b, h) do { _Pragma("unroll") for (int n = 0; n < 2; ++n) _Pragma("unroll") for (int k = 0; k < 2; ++k) dst[n][k] = *(const LAS bf16x8*)(lds + PG8_SB(b, h) + boff + n * 2048 + k * 1024); } while (0)
#define PG8_MMA(ai, bj, At, Bt) do { __builtin_amdgcn_s_setprio(1); _Pragma("unroll") for (int m = 0; m < 4; ++m) _Pragma("unroll") for (int n = 0; n < 2; ++n) _Pragma("unroll") for (int k = 0; k < 2; ++k) \
        acc[ai][bj][m][n] = __builtin_amdgcn_mfma_f32_16x16x32_bf16(Bt[n][k], At[m][k], acc[ai][bj][m][n], 0, 0, 0); __builtin_amdgcn_s_setprio(0); } while (0)
#define PG8_WAIT_V(n) asm volatile("s_waitcnt vmcnt(" #n ")" ::: "memory")
#define PG8_WAIT_L(n) asm volatile("s_waitcnt lgkmcnt(" #n ")" ::: "memory")
#define PG8_BAR __builtin_amdgcn_s_barrier()
#define PG8_SCHED __builtin_amdgcn_sched_barrier(0)
    Unit cur, nxt; int ui = 0;
    if (!S.next(0, cur)) return;
    f32x4 acc[2][2][4][2];
#pragma unroll
    for (int a = 0; a < 2; ++a)
#pragma unroll
        for (int b = 0; b < 2; ++b)
#pragma unroll
            for (int m = 0; m < 4; ++m)
#pragma unroll
                for (int n = 0; n < 2; ++n) acc[a][b][m][n] = (f32x4){0.f, 0.f, 0.f, 0.f};
    bf16x8 At[4][2], B0[2][2], B1[2][2];
    const char* cA = cur.a; const char* cB = cur.b;
    PG8_STAGE(PG8_SB(0, 0), cB, voffB); PG8_STAGE(PG8_SA(0, 0), cA, voffA); PG8_STAGE(PG8_SB(0, 1), cB + hstep, voffB); PG8_STAGE(PG8_SA(0, 1), cA + hstep, voffA);
    if (wr == 1) PG8_BAR;
    PG8_WAIT_V(4); PG8_BAR;
    PG8_STAGE(PG8_SB(1, 0), cB + kstep, voffB); PG8_STAGE(PG8_SA(1, 0), cA + kstep, voffA); PG8_STAGE(PG8_SB(1, 1), cB + hstep + kstep, voffB);
    PG8_WAIT_V(6); PG8_BAR;
    for (;;) {
        const bool has_next = S.next(ui + 1, nxt);
        const char* nA = has_next ? nxt.a : cA; const char* nB = has_next ? nxt.b : cB;
        for (int t = 0; t < nt; t += 2) {
            const bool last = (t == nt - 2);
            const char* a1 = cA + (size_t)(t + 1) * kstep;
            const char* a2 = last ? nA : cA + (size_t)(t + 2) * kstep; const char* b2 = last ? nB : cB + (size_t)(t + 2) * kstep;
            const char* a3 = a2 + kstep; const char* b3 = b2 + kstep;
            PG8_LDB(B0, 0, 0); PG8_SCHED; PG8_LDA(At, 0, 0); PG8_STAGE(PG8_SA(1, 1), a1 + hstep, voffA);
            PG8_WAIT_L(8); PG8_BAR; PG8_WAIT_L(0); PG8_MMA(0, 0, At, B0); PG8_BAR; PG8_SCHED;
            PG8_LDB(B1, 0, 1); PG8_STAGE(PG8_SB(0, 0), b2, voffB);
            PG8_BAR; PG8_WAIT_L(0); PG8_MMA(0, 1, At, B1); PG8_BAR;
            PG8_LDA(At, 0, 1); PG8_STAGE(PG8_SA(0, 0), a2, voffA);
            PG8_BAR; PG8_WAIT_L(0); PG8_MMA(1, 0, At, B0); PG8_BAR; PG8_SCHED;
            PG8_STAGE(PG8_SB(0, 1), b2 + hstep, voffB);
            PG8_WAIT_V(6); PG8_BAR; PG8_MMA(1, 1, At, B1); PG8_BAR;
            PG8_LDB(B0, 1, 0); PG8_SCHED; PG8_LDA(At, 1, 0); PG8_STAGE(PG8_SA(0, 1), a2 + hstep, voffA);
            PG8_WAIT_L(8); PG8_BAR; PG8_WAIT_L(0); PG8_MMA(0, 0, At, B0); PG8_BAR; PG8_SCHED;
            PG8_LDB(B1, 1, 1); PG8_STAGE(PG8_SB(1, 0), b3, voffB);
            PG8_BAR; PG8_WAIT_L(0); PG8_MMA(0, 1, At, B1); PG8_BAR;
            PG8_LDA(At, 1, 1); PG8_STAGE(PG8_SA(1, 0), a3, voffA);
            PG8_BAR; PG8_WAIT_L(0); PG8_MMA(1, 0, At, B0); PG8_BAR; PG8_SCHED;
            PG8_STAGE(PG8_SB(1, 1), b3 + hstep, voffB);
            PG8_WAIT_V(6); PG8_BAR; PG8_MMA(1, 1, At, B1); PG8_BAR;
        }
        E(acc, cur, wr, wc, fr, fq);
        if (!has_next) break;
#pragma unroll
        for (int a = 0; a < 2; ++a)
#pragma unroll
            for (int b = 0; b < 2; ++b)
#pragma unroll
                for (int m = 0; m < 4; ++m)
#pragma unroll
                    for (int n = 0; n < 2; ++n) acc[a][b][m][n] = (f32x4){0.f, 0.f, 0.f, 0.f};
        cur = nxt; cA = nA; cB = nB; ++ui;
    }
    PG8_WAIT_V(0);
    if (wr == 0) PG8_BAR;
    PG8_BAR;
#undef PG8_SA
#undef PG8_SB
#undef PG8_STAGE
#undef PG8_LDA
#undef PG8_LDB
#undef PG8_MMA
#undef PG8_WAIT_V
#undef PG8_WAIT_L
#undef PG8_BAR
#undef PG8_SCHED
}

struct EpiBf16 {
    static constexpr bool PERM = true;
    bf16_t* O; int ldc;
    __device__ __forceinline__ void operator()(const f32x4 (&acc)[2][2][4][2], const Unit& u, int wr, int wc, int fr, int fq) const {
        const int row0 = u.pm * BM + wr * 64 + fr, col0 = u.pn * BM + wc * 32 + 8 * fq;
#pragma unroll
        for (int ai = 0; ai < 2; ++ai)
#pragma unroll
            for (int m = 0; m < 4; ++m) { bf16_t* rowp = O + (size_t)(row0 + ai * HALF + m * 16) * ldc + col0;
#pragma unroll
                for (int bj = 0; bj < 2; ++bj) { const f32x4 v0 = acc[ai][bj][m][0], v1 = acc[ai][bj][m][1];
                    u32x4 w; w.x = cvt_pk_bf16(v0[0], v0[1]); w.y = cvt_pk_bf16(v0[2], v0[3]); w.z = cvt_pk_bf16(v1[0], v1[1]); w.w = cvt_pk_bf16(v1[2], v1[3]);
                    *(u32x4*)(rowp + bj * HALF) = w; } }
    }
};
struct EpiResid {
    static constexpr bool PERM = false;
    float* C; int ldc;
    __device__ __forceinline__ void operator()(const f32x4 (&acc)[2][2][4][2], const Unit& u, int wr, int wc, int fr_, int fq_) const {
        int fr = fr_, fq = fq_; asm volatile("" : "+v"(fr), "+v"(fq));
        const int row0 = u.pm * BM + wr * 64 + fr, col0 = u.pn * BM + wc * 32 + 4 * fq;
#pragma unroll
        for (int ai = 0; ai < 2; ++ai)
#pragma unroll
            for (int mp = 0; mp < 2; ++mp) { f32x4 cv[2][2][2];
#pragma unroll
                for (int mm = 0; mm < 2; ++mm) { const float* rowp = C + (size_t)(row0 + ai * HALF + (2 * mp + mm) * 16) * ldc + col0;
#pragma unroll
                    for (int bj = 0; bj < 2; ++bj)
#pragma unroll
                        for (int n = 0; n < 2; ++n) cv[mm][bj][n] = *(const f32x4*)(rowp + bj * HALF + n * 16); }
#pragma unroll
                for (int mm = 0; mm < 2; ++mm) { float* rowp = C + (size_t)(row0 + ai * HALF + (2 * mp + mm) * 16) * ldc + col0;
#pragma unroll
                    for (int bj = 0; bj < 2; ++bj)
#pragma unroll
                        for (int n = 0; n < 2; ++n) *(f32x4*)(rowp + bj * HALF + n * 16) = cv[mm][bj][n] + acc[ai][bj][2 * mp + mm][n]; }
                asm volatile("" ::: "memory"); }
    }
};
template <int ACT  > struct EpiGated {
    static constexpr bool PERM = true;
    bf16_t* O; int ldo; int coloff; const float* ba; const float* bb;
    __device__ __forceinline__ void operator()(const f32x4 (&acc)[2][2][4][2], const Unit& u, int wr, int wc, int fr, int fq) const {
        const int row0 = u.pm * BM + wr * 64 + fr, cl = u.pn * HALF + wc * 32 + 8 * fq;
        float va[8], vb[8];
#pragma unroll
        for (int j = 0; j < 8; ++j) { va[j] = (ACT == 0) ? ba[cl + j] : 0.f; vb[j] = (ACT == 0) ? bb[cl + j] : 0.f; }
#pragma unroll
        for (int ai = 0; ai < 2; ++ai)
#pragma unroll
            for (int m = 0; m < 4; ++m) { bf16_t* rowp = O + (size_t)(row0 + ai * HALF + m * 16) * ldo + coloff + cl;
                float o[8];
#pragma unroll
                for (int n = 0; n < 2; ++n)
#pragma unroll
                    for (int j = 0; j < 4; ++j) { const float a = acc[ai][0][m][n][j] + va[4 * n + j], b = acc[ai][1][m][n][j] + vb[4 * n + j];
                        o[4 * n + j] = (ACT == 0) ? a * sigmoidf_(b) : siluf_(a) * b; }
                u32x4 w; w.x = cvt_pk_bf16(o[0], o[1]); w.y = cvt_pk_bf16(o[2], o[3]); w.z = cvt_pk_bf16(o[4], o[5]); w.w = cvt_pk_bf16(o[6], o[7]);
                *(u32x4*)rowp = w; asm volatile("" ::: "memory"); }
    }
};
struct EpiMoeOut {
    static constexpr bool PERM = true;
    bf16_t* O; const int* row_tok; const float* row_w; LAS unsigned char* lds;
    __device__ __forceinline__ void operator()(const f32x4 (&acc)[2][2][4][2], const Unit& u, int wr, int wc, int fr_, int fq_) const {
        int fr = fr_, fq = fq_; asm volatile("" : "+v"(fr), "+v"(fq));
        const int col0 = u.pn * BM + wc * 32 + 8 * fq, lane = fq * 16 + fr;
        LAS u32x2* rinfo = (LAS u32x2*)(lds + STAGE_BYTES) + (wr * 4 + wc) * 128;
        { const int ra = u.pm * BM + wr * 64 + lane, rb = ra + HALF;
          const u32x2 ia = (u32x2){(unsigned)row_tok[ra], __float_as_uint(row_w[ra])}, ib = (u32x2){(unsigned)row_tok[rb], __float_as_uint(row_w[rb])};
          rinfo[lane] = ia; rinfo[64 + lane] = ib; }
#pragma unroll
        for (int ai = 0; ai < 2; ++ai)
#pragma unroll
            for (int m = 0; m < 4; ++m) { const u32x2 inf = rinfo[ai * 64 + m * 16 + fr]; const int ts = (int)inf.x; const float w = __uint_as_float(inf.y);
                if (ts >= 0) { bf16_t* rowp = O + ((size_t)(ts & 1) * NTOK + (size_t)(ts >> 1)) * DM + col0;
#pragma unroll
                    for (int bj = 0; bj < 2; ++bj) { const f32x4 v0 = acc[ai][bj][m][0] * w, v1 = acc[ai][bj][m][1] * w;
                        u32x4 q; q.x = cvt_pk_bf16(v0[0], v0[1]); q.y = cvt_pk_bf16(v0[2], v0[3]); q.z = cvt_pk_bf16(v1[0], v1[1]); q.w = cvt_pk_bf16(v1[2], v1[3]);
                        *(u32x4*)(rowp + bj * HALF) = q; } } }
    }
};
struct MoeOrder {
    int nN, G, c, K; const char* A; const char* B; size_t bstride; const int* tiles;
    __device__ bool next(int i, Unit& u) const {
        const int nrt = tiles[0]; const long L = (long)i * G + c; if (L >= (long)nrt * nN) return false;
        u.pm = (int)(L / nN); u.pn = (int)(L % nN); const int e = tiles[64 + u.pm];
        u.a = A + (size_t)u.pm * 256 * K * 2; u.b = B + (size_t)e * bstride + (size_t)u.pn * 256 * K * 2; return true;
    }
};
}

struct Params { const float* in[44]; float* out; unsigned char* ws; int ph_lo, ph_hi; };
enum { I_X = 0, I_NORM1, I_WIN, I_MCONVW, I_MCONVB, I_MDTB, I_MALOG, I_MD, I_MNORM, I_RMU, I_RW0, I_RW2, I_RA0, I_RA2, I_RG2, I_RKK, I_RKA, I_RRK, I_RLNW, I_RLNB,
       I_CKVN, I_CWUK, I_CWUV, I_RELB, I_SARE, I_SAIM, I_SBRE, I_SBIM, I_SCRE, I_SCIM, I_SD, I_SLOGDT, I_SGLUW, I_SGLUB, I_WOUT, I_NORM2, I_WRG, I_BRG, I_WRE, I_BRE,
       I_WGATE, I_WUP, I_WDOWN, I_FNORM };

typedef const float* const __attribute__((address_space(4)))* in_tab_t;
struct Frame {
    LAS unsigned char* lds; int tid, lane, wave, bid, G;
    in_tab_t in; float* out; unsigned char* ws; unsigned* ctl;
    volatile LAS int* misc;
};

__device__ __forceinline__ int q_pop(Frame& F, int qi) {
    __syncthreads();
    if (F.tid == 0) F.misc[0] = (int)__hip_atomic_fetch_add(F.ctl + CW_Q + 64 * qi, 1u, __ATOMIC_RELAXED, __HIP_MEMORY_SCOPE_AGENT);
    __syncthreads();
    return F.misc[0];
}

__device__ __forceinline__ const void* opaque_ptr(const void* p) { const unsigned long long v = (unsigned long long)p; unsigned lo = __builtin_amdgcn_readfirstlane((unsigned)v), hi = __builtin_amdgcn_readfirstlane((unsigned)(v >> 32));
    asm volatile("" : "+s"(lo), "+s"(hi)); return (const void*)(((unsigned long long)hi << 32) | lo); }
__device__ __forceinline__ Frame relocal(const Frame& G) { Frame F = G; asm volatile("" : "+v"(F.tid)); F.ws = (unsigned char*)opaque_ptr(F.ws); F.ctl = (unsigned*)(F.ws + WS_CTL); F.in = (in_tab_t)(unsigned long long)opaque_ptr((const void*)(unsigned long long)F.in); F.lane = F.tid & 63; F.wave = __builtin_amdgcn_readfirstlane(F.tid >> 6); return F; }
template <int K> __device__ __forceinline__ f32x4 mma_nt(const LAS bf16_t* A, int lda, const LAS bf16_t* Bt, int ldb, f32x4 acc, int lane) {
    const int r = lane & 15, g = lane >> 4;
#pragma unroll
    for (int k0 = 0; k0 < K; k0 += 32) {
        const bf16x8 a = *(const LAS bf16x8*)(A + r * lda + k0 + 8 * g);
        const bf16x8 b = *(const LAS bf16x8*)(Bt + r * ldb + k0 + 8 * g);
        acc = __builtin_amdgcn_mfma_f32_16x16x32_bf16(a, b, acc, 0, 0, 0);
    }
    return acc;
}

template <class SrcMap> __device__ __forceinline__ void tr_tile(Frame& F, int ldsrc, bf16_t* dst, int K, int k0, int n0, SrcMap sm) {
    LAS float* tile = (LAS float*)F.lds;
    __syncthreads();
    { const int n4 = (F.tid & 63) * 4, kk = F.tid >> 6; const float* sp = sm(n0 + n4);
      f32x4 v[8];
#pragma unroll
      for (int ps = 0; ps < 8; ++ps) { v[ps] = (f32x4){0.f, 0.f, 0.f, 0.f}; if (sp) v[ps] = *(const f32x4*)(sp + (size_t)(k0 + kk + 8 * ps) * ldsrc); }
#pragma unroll
      for (int ps = 0; ps < 8; ++ps) { LAS float* t = tile + (kk + 8 * ps) * 257 + n4; t[0] = v[ps][0]; t[1] = v[ps][1]; t[2] = v[ps][2]; t[3] = v[ps][3]; } }
    __syncthreads();
    { const int kc = F.tid & 7;
#pragma unroll
      for (int j = 0; j < 4; ++j) { const int n = (F.tid >> 3) + 64 * j; float f[8];
#pragma unroll
          for (int i = 0; i < 8; ++i) f[i] = tile[(8 * kc + i) * 257 + n];
          u32x4 w; w.x = pk2(f[0], f[1]); w.y = pk2(f[2], f[3]); w.z = pk2(f[4], f[5]); w.w = pk2(f[6], f[7]);
          *(u32x4*)(dst + (size_t)(n0 + n) * K + k0 + 8 * kc) = w; } }
}

struct SmIn { const float* base; __device__ __forceinline__ const float* operator()(int n) const {
    int c; if (n < 772) c = n; else if (n < UR) return nullptr; else if (n < UR + 896) c = 772 + (n - UR); else if (n < UC) return nullptr;
    else if (n < UC + 680) c = 1668 + (n - UC); else if (n < US) return nullptr; else if (n < US + 256) c = 2348 + (n - US); else return nullptr; return base + c; } };
struct SmId { const float* base; __device__ __forceinline__ const float* operator()(int n) const { return base + n; } };
struct SmGlu { const float* base; __device__ __forceinline__ const float* operator()(int n) const { const int pn = n >> 8, rr = n & 255; return base + (rr < 128 ? 128 * pn + rr : 256 + 128 * pn + (rr - 128)); } };
struct SmGU { const float* gate; const float* up; __device__ __forceinline__ const float* operator()(int n) const {
    const unsigned long long d = (unsigned long long)up - (unsigned long long)gate; const unsigned long long a = (unsigned long long)gate + (((n & 255) < 128) ? 0ull : d); return (const float*)a + 128 * (n >> 8) + (n & 127); } };
__device__ __forceinline__ void phase_prologue(const Frame& F_) { Frame F = relocal(F_);
    for (int t = F.bid; t < 496; t += F.G) {
        if (t < 352) { const int l = t / 176, r = t % 176, kt = r / 11, nt = r % 11;
            tr_tile(F, NIN, (bf16_t*)(F.ws + WS_WIN) + (size_t)l * NINP * DM, DM, kt * 64, nt * 256, SmIn{F.in[I_WIN] + (size_t)l * DM * NIN}); }
        else if (t < 480) { const int q = t - 352, l = q / 64, r = q % 64, kt = r / 4, nt = r % 4;
            tr_tile(F, DM, (bf16_t*)(F.ws + WS_WOUT) + (size_t)l * DM * DM, DM, kt * 64, nt * 256, SmId{F.in[I_WOUT] + (size_t)l * DM * DM}); }
        else { const int q = t - 480, l = q / 8, r = q % 8, kt = r / 2, nt = r % 2;
            tr_tile(F, 512, (bf16_t*)(F.ws + WS_GLU) + (size_t)l * 512 * 256, 256, kt * 64, nt * 256, SmGlu{F.in[I_SGLUW] + (size_t)l * 256 * 512}); }
    }
    for (int i = F.bid * NTHR + F.tid; i < 2 * 48 * 1024; i += F.G * NTHR) { const int l = i / 49152, r = i % 49152, o = r >> 10, k = r & 1023;
        float v = 0.f; if (o < 32) v = F.in[I_WRE][((size_t)l * DM + k) * 32 + o]; else if (o < 36) v = F.in[I_WRG][((size_t)l * DM + k) * 4 + (o - 32)];
        v *= F.in[I_NORM2][l * DM + k];
        const bf16_t hi = f2bf(v); const bf16_t lo = f2bf(v - bf2f(hi));
        bf16_t* w = (bf16_t*)(F.ws + WS_WRT) + (size_t)l * 2 * 49152; w[r] = hi; w[49152 + r] = lo; }
    for (int i = F.bid * NTHR + F.tid; i < 2048 + 65536; i += F.G * NTHR) {
        if (i < 2048) {
            const int l = i >> 10, gn = i & 1023, g = gn >> 6;
            float* tab = (float*)(F.ws + WS_S5TAB + (size_t)l * S5TAB_L);
            const float lre = fminf(F.in[I_SARE][l * 1024 + gn], -1e-4f), lim = F.in[I_SAIM][l * 1024 + gn];
            const float dt = expf(F.in[I_SLOGDT][l * 16 + g]);
            const float mag = expf(dt * lre); float sn, cs; sincosf(dt * lim, &sn, &cs);
            const float are = mag * cs, aim = mag * sn;
            const float den = lre * lre + lim * lim;
            const float fre = ((are - 1.0f) * lre + aim * lim) / den, fim = (aim * lre - (are - 1.0f) * lim) / den;
            tab[gn * 2] = are; tab[gn * 2 + 1] = aim;
            float pr = are, pi = aim;
#pragma unroll
            for (int s = 0; s < 6; ++s) { const float nr = pr * pr - pi * pi, ni = 2.0f * pr * pi; pr = nr; pi = ni; }
            tab[2048 + gn * 2] = pr; tab[2048 + gn * 2 + 1] = pi;
            const float* bre = F.in[I_SBRE] + ((size_t)l * 1024 + gn) * 16; const float* bim = F.in[I_SBIM] + ((size_t)l * 1024 + gn) * 16;
            bf16_t* bbt = (bf16_t*)(F.ws + WS_S5TAB + (size_t)l * S5TAB_L + S5TAB_BBT); const int n = gn & 63, col = 4 * (n & 31) + 2 * (n >> 5);
            for (int p = 0; p < 16; ++p) { const float vr = fre * bre[p] - fim * bim[p], vi = fre * bim[p] + fim * bre[p];
                bbt[((size_t)g * 128 + col) * 16 + p] = f2bf(vr); bbt[((size_t)g * 128 + col + 1) * 16 + p] = f2bf(vi); }
        } else {
            const int j = i - 2048, l = j >> 15, r = j & 32767, gp = r >> 7, k = r & 127;
            bf16_t* cm = (bf16_t*)(F.ws + WS_S5TAB + (size_t)l * S5TAB_L + S5TAB_F);
            const int n = (k >> 2) + 32 * ((k >> 1) & 1);
            const float v = (k & 1) == 0 ? F.in[I_SCRE][((size_t)l * 256 + gp) * 64 + n] : -F.in[I_SCIM][((size_t)l * 256 + gp) * 64 + n];
            cm[r] = f2bf(v);
        }
    }
}

__device__ __forceinline__ void phase_norm(const Frame& F_, const float* xin, bool add_o, const float* w, int mode) { Frame F = relocal(F_);
    float* X = (float*)(F.ws + WS_X); bf16_t* H = (bf16_t*)(F.ws + WS_H); const bf16_t* O = (const bf16_t*)(F.ws + WS_U);
    for (int row0 = F.bid * 32 + F.wave * 4; row0 < NTOK; row0 += F.G * 32) {
        f32x4 v[4][4]; u32x2 oa[4][4], ob[4][4];
#pragma unroll
        for (int r = 0; r < 4; ++r)
#pragma unroll
            for (int j = 0; j < 4; ++j) { const int c = 4 * F.lane + 256 * j; const size_t o = (size_t)(row0 + r) * DM + c; v[r][j] = *(const f32x4*)(xin + o);
                if (add_o) { oa[r][j] = *(const u32x2*)(O + o); ob[r][j] = *(const u32x2*)(O + (size_t)NTOK * DM + o); } }
#pragma unroll
        for (int r = 0; r < 4; ++r) { const int row = row0 + r; float ss = 0.f;
#pragma unroll
            for (int j = 0; j < 4; ++j) {
                if (add_o) { const u32x2 a = oa[r][j], b = ob[r][j];
                    v[r][j][0] += __uint_as_float(a.x << 16) + __uint_as_float(b.x << 16); v[r][j][1] += __uint_as_float(a.x & 0xffff0000u) + __uint_as_float(b.x & 0xffff0000u);
                    v[r][j][2] += __uint_as_float(a.y << 16) + __uint_as_float(b.y << 16); v[r][j][3] += __uint_as_float(a.y & 0xffff0000u) + __uint_as_float(b.y & 0xffff0000u); }
                ss += v[r][j][0] * v[r][j][0] + v[r][j][1] * v[r][j][1] + v[r][j][2] * v[r][j][2] + v[r][j][3] * v[r][j][3]; }
            ss = wave_sum(ss);
            const float rstd = rsqrtf(ss * (1.0f / DM) + 1e-6f);
#pragma unroll
            for (int j = 0; j < 4; ++j) { const int c = 4 * F.lane + 256 * j; const f32x4 wv = *(const f32x4*)(w + c);
                if (mode == 2) { *(f32x4*)(F.out + (size_t)row * DM + c) = v[r][j] * rstd * wv; }
                else { *(f32x4*)(X + (size_t)row * DM + c) = v[r][j];
                    u32x2 o; o.x = pk2(v[r][j][0] * rstd * wv[0], v[r][j][1] * rstd * wv[1]); o.y = pk2(v[r][j][2] * rstd * wv[2], v[r][j][3] * rstd * wv[3]);
                    *(u32x2*)(H + (size_t)row * DM + c) = o; } } }
    }
}

__device__ __forceinline__ void item_kv(const Frame& F_, int layer, int item) { Frame F = relocal(F_);
    const bf16_t* U = (const bf16_t*)(F.ws + WS_U);
    LAS bf16_t* Ab = (LAS bf16_t*)F.lds;
    LAS bf16_t* Bt = (LAS bf16_t*)(F.lds + 17408);
    const int t0 = item * 64;
    { const int tok = F.tid >> 3, part = F.tid & 7; const bf16_t* src = U + (size_t)(t0 + tok) * NINP + UC + 256 + 16 * part;
      float f[16]; { float a[8], b[8]; unpack8(*(const u32x4*)src, a); unpack8(*(const u32x4*)(src + 8), b);
#pragma unroll
        for (int j = 0; j < 8; ++j) { f[j] = a[j]; f[8 + j] = b[j]; } }
      float ss = 0.f;
#pragma unroll
      for (int j = 0; j < 16; ++j) ss += f[j] * f[j];
      ss = sum8(ss);
      const float rstd = rsqrtf(ss * (1.0f / 128.0f) + 1e-6f); const float* nw = F.in[I_CKVN] + layer * 128 + 16 * part;
#pragma unroll
      for (int j = 0; j < 16; j += 2) *(LAS unsigned*)(Ab + tok * 136 + 16 * part + j) = pk2(f[j] * rstd * nw[j], f[j + 1] * rstd * nw[j + 1]); }
    { const int n = F.tid >> 2, kq = F.tid & 3; const float* w = (n < 64 ? F.in[I_CWUK] : F.in[I_CWUV]) + (size_t)layer * 128 * 64 + (n & 63);
      float wv[32];
#pragma unroll
      for (int k = 0; k < 32; ++k) wv[k] = w[(size_t)(32 * kq + k) * 64];
#pragma unroll
      for (int k = 0; k < 32; k += 2) *(LAS unsigned*)(Bt + n * 136 + 32 * kq + k) = pk2(wv[k], wv[k + 1]); }
    if (F.tid < 256) { const int tok = F.tid >> 2, q = F.tid & 3;
        *(u32x4*)((bf16_t*)(F.ws + WS_KIDX) + (size_t)(t0 + tok) * 32 + 8 * q) = *(const u32x4*)(U + (size_t)(t0 + tok) * NINP + UC + 640 + 8 * q); }
    __syncthreads();
    const int mt = F.wave & 3, g = F.lane >> 4, r = F.lane & 15;
#pragma unroll
    for (int q = 0; q < 4; ++q) { const int nt = (F.wave >> 2) * 4 + q;
        f32x4 acc = (f32x4){0.f, 0.f, 0.f, 0.f};
        acc = mma_nt<128>(Ab + mt * 16 * 136, 136, Bt + nt * 16 * 136, 136, acc, F.lane);
        const int n = nt * 16 + r; bf16_t* dst = (bf16_t*)(F.ws + (n < 64 ? WS_K : WS_V));
#pragma unroll
        for (int i = 0; i < 4; ++i) dst[(size_t)(t0 + mt * 16 + 4 * g + i) * 64 + (n & 63)] = f2bf(acc[i]); }
}

constexpr int MB_CG = 0, MB_BG = 18432, MB_BT = 36864, MB_XT = 55296, MB_M = 92160, MB_S0 = 101376, MB_DT = 110592, MB_AC = 111616, MB_RS = 112640;
template <int STAGE> __device__ __forceinline__ void item_mamba(const Frame& F_, int layer, int item) { Frame F = relocal(F_);
    const bf16_t* U = (const bf16_t*)(F.ws + WS_U);
    const int b = item >> 6, c = item & 63, l0 = c * 64; const size_t T0 = (size_t)b * SEQ + l0;
    LAS bf16_t* Cg = (LAS bf16_t*)(F.lds + MB_CG); LAS bf16_t* Bg = (LAS bf16_t*)(F.lds + MB_BG); LAS bf16_t* BT = (LAS bf16_t*)(F.lds + MB_BT);
    LAS bf16_t* XT = (LAS bf16_t*)(F.lds + MB_XT); LAS bf16_t* Mb = (LAS bf16_t*)(F.lds + MB_M); LAS bf16_t* S0 = (LAS bf16_t*)(F.lds + MB_S0);
    LAS float* dts = (LAS float*)(F.lds + MB_DT); LAS float* acs = (LAS float*)(F.lds + MB_AC); LAS float* rs = (LAS float*)(F.lds + MB_RS);
    if (F.tid < 256) { const int l = F.tid >> 2, h = F.tid & 3;
        const float raw = bf2f(U[(T0 + l) * NINP + UM + 768 + h]) + F.in[I_MDTB][layer * 4 + h];
        const float dt = softplusf_(raw); dts[l * 4 + h] = dt; acs[l * 4 + h] = -__expf(F.in[I_MALOG][layer * 4 + h]) * dt; }
    if (F.tid < 64) rs[F.tid] = 0.f;
    __syncthreads();
    float mycum = 0.f;
    if (F.tid < 256) { const int l = F.tid >> 2, h = F.tid & 3; for (int s = 0; s <= l; ++s) mycum += acs[s * 4 + h]; }
    __syncthreads();
    if (F.tid < 256) acs[F.tid] = mycum;
    __syncthreads();
    { const int ch8 = F.tid & 63, tg = F.tid >> 6, c0 = ch8 * 8;
      float wv[4][8], bv[8];
#pragma unroll
      for (int j = 0; j < 8; ++j) { bv[j] = F.in[I_MCONVB][layer * 512 + c0 + j];
#pragma unroll
          for (int k = 0; k < 4; ++k) wv[k][j] = F.in[I_MCONVW][(layer * 4 + k) * 512 + c0 + j]; }
      float win[3][8];
#pragma unroll
      for (int k = 0; k < 3; ++k) { const int l = l0 + tg * 8 - 3 + k;
          if (l >= 0) unpack8(*(const u32x4*)(U + ((size_t)b * SEQ + l) * NINP + UM + 256 + c0), win[k]);
          else {
#pragma unroll
              for (int j = 0; j < 8; ++j) win[k][j] = 0.f; } }
#pragma unroll 1
      for (int ib = 0; ib < 2; ++ib) { u32x4 rows[4];
#pragma unroll
          for (int i4 = 0; i4 < 4; ++i4) rows[i4] = *(const u32x4*)(U + (T0 + tg * 8 + ib * 4 + i4) * NINP + UM + 256 + c0);
#pragma unroll
      for (int i4 = 0; i4 < 4; ++i4) { const int l = tg * 8 + ib * 4 + i4; float cur[8]; unpack8(rows[i4], cur);
          float o[8];
#pragma unroll
          for (int j = 0; j < 8; ++j) { o[j] = siluf_(bv[j] + wv[0][j] * win[0][j] + wv[1][j] * win[1][j] + wv[2][j] * win[2][j] + wv[3][j] * cur[j]);
              win[0][j] = win[1][j]; win[1][j] = win[2][j]; win[2][j] = cur[j]; }
          if (c0 < 256) { const int h = c0 >> 6, p0 = c0 & 63; float sc = dts[l * 4 + h]; if (STAGE == 1) sc *= __expf(acs[63 * 4 + h] - acs[l * 4 + h]);
#pragma unroll
              for (int j = 0; j < 8; ++j) XT[(h * 64 + p0 + j) * 72 + l] = f2bf(o[j] * sc); }
          else if (c0 < 384) { const int g = (c0 - 256) >> 6, n0 = (c0 - 256) & 63;
              if (STAGE == 1) {
#pragma unroll
                  for (int j = 0; j < 8; ++j) BT[(g * 64 + n0 + j) * 72 + l] = f2bf(o[j]); }
              else { u32x4 w; w.x = pk2(o[0], o[1]); w.y = pk2(o[2], o[3]); w.z = pk2(o[4], o[5]); w.w = pk2(o[6], o[7]); *(LAS u32x4*)(Bg + (g * 64 + l) * 72 + n0) = w; } }
          else if (STAGE == 2) { const int g = (c0 - 384) >> 6, n0 = (c0 - 384) & 63;
              u32x4 w; w.x = pk2(o[0], o[1]); w.y = pk2(o[2], o[3]); w.z = pk2(o[4], o[5]); w.w = pk2(o[6], o[7]); *(LAS u32x4*)(Cg + (g * 64 + l) * 72 + n0) = w; } } } }
    __syncthreads();
    const int g4 = F.lane >> 4, r16 = F.lane & 15;
    if (STAGE == 1) {
        float* MST = (float*)(F.ws + WS_MST) + ((size_t)(b * 64 + c) * 4) * 4096;
#pragma unroll
        for (int q = 0; q < 8; ++q) { const int tix = F.wave * 8 + q, h = tix >> 4, mt = (tix >> 2) & 3, nt = tix & 3;
            f32x4 acc = (f32x4){0.f, 0.f, 0.f, 0.f};
            acc = mma_nt<64>(XT + (h * 64 + mt * 16) * 72, 72, BT + ((h >> 1) * 64 + nt * 16) * 72, 72, acc, F.lane);
#pragma unroll
            for (int i = 0; i < 4; ++i) MST[(size_t)h * 4096 + (mt * 16 + 4 * g4 + i) * 64 + nt * 16 + r16] = acc[i]; }
        if (F.tid < 4) ((float*)(F.ws + WS_MDEC))[(b * 64 + c) * 4 + F.tid] = __expf(acs[63 * 4 + F.tid]);
    } else {
        const int mt = F.wave & 3, nh = F.wave >> 2;
        const float* MST = (const float*)(F.ws + WS_MST) + ((size_t)(b * 64 + c) * 4) * 4096;
        f32x4 G[2], yv[4][2];
#pragma unroll
        for (int h = 0; h < 4; ++h) {
            const int g = h >> 1;
            { const float* src = MST + (size_t)h * 4096 + F.tid * 8; const f32x4 a = *(const f32x4*)src, bq = *(const f32x4*)(src + 4);
              u32x4 w; w.x = pk2(a[0], a[1]); w.y = pk2(a[2], a[3]); w.z = pk2(bq[0], bq[1]); w.w = pk2(bq[2], bq[3]);
              *(LAS u32x4*)(S0 + (F.tid >> 3) * 72 + (F.tid & 7) * 8) = w; }
            if ((h & 1) == 0) {
#pragma unroll
                for (int q = 0; q < 2; ++q) { G[q] = (f32x4){0.f, 0.f, 0.f, 0.f};
                    G[q] = mma_nt<64>(Cg + (g * 64 + mt * 16) * 72, 72, Bg + (g * 64 + (2 * nh + q) * 16) * 72, 72, G[q], F.lane); } }
#pragma unroll
            for (int q = 0; q < 2; ++q) { const int s = (2 * nh + q) * 16 + r16; const float as = acs[s * 4 + h];
#pragma unroll
                for (int i = 0; i < 4; ++i) { const int l = mt * 16 + 4 * g4 + i; const float v = (s <= l) ? G[q][i] * __expf(acs[l * 4 + h] - as) : 0.f;
                    Mb[l * 72 + s] = f2bf(v); } }
            __syncthreads();
#pragma unroll
            for (int q = 0; q < 2; ++q) { const int nt = 2 * nh + q;
                f32x4 yd = (f32x4){0.f, 0.f, 0.f, 0.f}, yo = (f32x4){0.f, 0.f, 0.f, 0.f};
                yd = mma_nt<64>(Mb + mt * 16 * 72, 72, XT + (h * 64 + nt * 16) * 72, 72, yd, F.lane);
                yo = mma_nt<64>(Cg + (g * 64 + mt * 16) * 72, 72, S0 + nt * 16 * 72, 72, yo, F.lane);
                const int p = nt * 16 + r16; const float dsk = F.in[I_MD][layer * 4 + h];
#pragma unroll
                for (int i = 0; i < 4; ++i) { const int l = mt * 16 + 4 * g4 + i;
                    const float xs = bf2f(XT[(h * 64 + p) * 72 + l]) / dts[l * 4 + h];
                    yv[h][q][i] = yd[i] + yo[i] * __expf(acs[l * 4 + h]) + dsk * xs; } }
            __syncthreads();
        }
        float part[4] = {0.f, 0.f, 0.f, 0.f};
#pragma unroll
        for (int h = 0; h < 4; ++h)
#pragma unroll
            for (int q = 0; q < 2; ++q) { const int ch = h * 64 + (2 * nh + q) * 16 + r16;
#pragma unroll
                for (int i = 0; i < 4; ++i) { const int l = mt * 16 + 4 * g4 + i; const float z = bf2f(U[(T0 + l) * NINP + UM + ch]);
                    const float v = yv[h][q][i] * siluf_(z); yv[h][q][i] = v; part[i] += v * v; } }
#pragma unroll
        for (int i = 0; i < 4; ++i) { const float s = sum16(part[i]); if (r16 == 0) atomicAdd((float*)(rs + mt * 16 + 4 * g4 + i), s); }
        __syncthreads();
        bf16_t* Y = (bf16_t*)(F.ws + WS_H);
#pragma unroll
        for (int i = 0; i < 4; ++i) { const int l = mt * 16 + 4 * g4 + i; const float rstd = rsqrtf(rs[l] * (1.0f / 256.0f) + 1e-6f);
#pragma unroll
            for (int h = 0; h < 4; ++h)
#pragma unroll
                for (int q = 0; q < 2; ++q) { const int ch = h * 64 + (2 * nh + q) * 16 + r16;
                    Y[(T0 + l) * DM + ch] = f2bf(yv[h][q][i] * rstd * F.in[I_MNORM][layer * 256 + ch]); } }
    }
}
__device__ __forceinline__ void item_mamba_carry(const Frame& F_, int item) { Frame F = relocal(F_);
    const int b = item >> 2, h = item & 3;
    float* MST = (float*)(F.ws + WS_MST); const float* MD = (const float*)(F.ws + WS_MDEC);
    float s[8];
#pragma unroll
    for (int j = 0; j < 8; ++j) s[j] = 0.f;
    for (int c = 0; c < 64; ++c) { float* p = MST + ((size_t)(b * 64 + c) * 4 + h) * 4096 + F.tid * 8; const float d = MD[(b * 64 + c) * 4 + h];
        const f32x4 a = *(f32x4*)p, q = *(f32x4*)(p + 4);
        *(f32x4*)p = (f32x4){s[0], s[1], s[2], s[3]}; *(f32x4*)(p + 4) = (f32x4){s[4], s[5], s[6], s[7]};
        s[0] = s[0] * d + a[0]; s[1] = s[1] * d + a[1]; s[2] = s[2] * d + a[2]; s[3] = s[3] * d + a[3];
        s[4] = s[4] * d + q[0]; s[5] = s[5] * d + q[1]; s[6] = s[6] * d + q[2]; s[7] = s[7] * d + q[3]; }
}

template <int STAGE> __device__ __forceinline__ void item_s5(const Frame& F_, int layer, int item) { Frame F = relocal(F_);
    const bf16_t* U = (const bf16_t*)(F.ws + WS_U);
    const int b = item >> 6, c = item & 63; const size_t T0 = (size_t)b * SEQ + c * 64;
    LAS bf16_t* us = (LAS bf16_t*)F.lds;
    LAS bf16_t* BuW = (LAS bf16_t*)(F.lds + 33792) + F.wave * 4224;
    const float* tab = (const float*)(F.ws + WS_S5TAB + (size_t)layer * S5TAB_L);
    { const int tok = F.tid >> 3, part = F.tid & 7;
#pragma unroll
      for (int q = 0; q < 4; ++q) *(LAS u32x4*)(us + tok * 264 + 32 * part + 8 * q) = *(const u32x4*)(U + (T0 + tok) * NINP + US + 32 * part + 8 * q); }
    const int lane = F.lane, r16 = lane & 15, g4 = lane >> 4, gq = lane >> 5, n0 = lane & 31, g = 2 * F.wave + gq, gn0 = g * 64 + n0, gn1 = gn0 + 32;
    bf16x8 bfr[2][8];
    { const bf16_t* bbt = (const bf16_t*)(F.ws + WS_S5TAB + (size_t)layer * S5TAB_L + S5TAB_BBT);
#pragma unroll
      for (int gg = 0; gg < 2; ++gg)
#pragma unroll
          for (int nt = 0; nt < 8; ++nt) { u32x4 z = (u32x4){0u, 0u, 0u, 0u}; if (g4 < 2) z = *(const u32x4*)(bbt + ((size_t)(2 * F.wave + gg) * 128 + 16 * nt + r16) * 16 + 8 * g4); bfr[gg][nt] = __builtin_bit_cast(bf16x8, z); } }
    const float a0r = tab[gn0 * 2], a0i = tab[gn0 * 2 + 1], a1r = tab[gn1 * 2], a1i = tab[gn1 * 2 + 1];
    float* ST = (float*)(F.ws + WS_S5ST) + (size_t)(b * 64 + c) * 2048;
    float h0r = 0.f, h0i = 0.f, h1r = 0.f, h1i = 0.f;
    if (STAGE == 2) { h0r = ST[gn0 * 2]; h0i = ST[gn0 * 2 + 1]; h1r = ST[gn1 * 2]; h1i = ST[gn1 * 2 + 1]; }
    bf16x8 cf[2][4];
    if (STAGE == 2) { const bf16_t* cm = (const bf16_t*)(F.ws + WS_S5TAB + (size_t)layer * S5TAB_L + S5TAB_F);
#pragma unroll
        for (int gg = 0; gg < 2; ++gg)
#pragma unroll
            for (int ks = 0; ks < 4; ++ks) cf[gg][ks] = *(const bf16x8*)(cm + ((size_t)((2 * F.wave + gg) * 16 + r16)) * 128 + 32 * ks + 8 * g4); }
    __syncthreads();
#pragma unroll 1
    for (int lb = 0; lb < 4; ++lb) {
#pragma unroll
        for (int gg = 0; gg < 2; ++gg) { u32x4 z = (u32x4){0u, 0u, 0u, 0u}; if (g4 < 2) z = *(const LAS u32x4*)(us + (16 * lb + r16) * 264 + (2 * F.wave + gg) * 16 + 8 * g4);
            const bf16x8 afr = __builtin_bit_cast(bf16x8, z);
#pragma unroll
            for (int nt = 0; nt < 8; ++nt) { const f32x4 acc = __builtin_amdgcn_mfma_f32_16x16x32_bf16(afr, bfr[gg][nt], (f32x4){0.f, 0.f, 0.f, 0.f}, 0, 0, 0);
#pragma unroll
                for (int i = 0; i < 4; ++i) BuW[(4 * g4 + i) * 264 + gg * 128 + 16 * nt + r16] = f2bf(acc[i]); } }
        __syncthreads();
#pragma unroll 4
        for (int li = 0; li < 16; ++li) { LAS u32x2* bp = (LAS u32x2*)(BuW + li * 264 + gq * 128 + 4 * n0); const u32x2 v = *bp;
            { const float br = __uint_as_float(v.x << 16), bi = __uint_as_float(v.x & 0xffff0000u); const float nr = a0r * h0r - a0i * h0i + br, ni = a0r * h0i + a0i * h0r + bi; h0r = nr; h0i = ni; }
            { const float br = __uint_as_float(v.y << 16), bi = __uint_as_float(v.y & 0xffff0000u); const float nr = a1r * h1r - a1i * h1i + br, ni = a1r * h1i + a1i * h1r + bi; h1r = nr; h1i = ni; }
            if (STAGE == 2) *bp = (u32x2){pk2(h0r, h0i), pk2(h1r, h1i)}; }
        __syncthreads();
        if (STAGE == 2) {
            bf16_t* YS = (bf16_t*)(F.ws + WS_MOE + YSG_OFF);
#pragma unroll
            for (int gg = 0; gg < 2; ++gg) { f32x4 acc = (f32x4){0.f, 0.f, 0.f, 0.f};
#pragma unroll
                for (int ks = 0; ks < 4; ++ks) { const bf16x8 a = *(const LAS bf16x8*)(BuW + r16 * 264 + gg * 128 + 32 * ks + 8 * g4);
                    acc = __builtin_amdgcn_mfma_f32_16x16x32_bf16(a, cf[gg][ks], acc, 0, 0, 0); }
                const int ch = (2 * F.wave + gg) * 16 + r16; const float dsk = F.in[I_SD][layer * 256 + ch];
#pragma unroll
                for (int i = 0; i < 4; ++i) { const int l = lb * 16 + 4 * g4 + i; const float y = acc[i] + dsk * bf2f(us[l * 264 + ch]);
                    YS[(T0 + l) * 256 + ch] = f2bf(gelu_tanh(y)); } }
            __syncthreads();
        }
    }
    if (STAGE == 1) { ST[gn0 * 2] = h0r; ST[gn0 * 2 + 1] = h0i; ST[gn1 * 2] = h1r; ST[gn1 * 2 + 1] = h1i; }
    if (STAGE == 2) {
        asm volatile("s_waitcnt vmcnt(0)" ::: "memory"); __syncthreads();
        const bf16_t* YS = (const bf16_t*)(F.ws + WS_MOE + YSG_OFF) + T0 * 256; const bf16_t* GW = (const bf16_t*)(F.ws + WS_GLU) + (size_t)layer * 512 * 256;
        const int r16 = F.lane & 15, g4 = F.lane >> 4;
        f32x4 av[4][2], ag[4][2];
#pragma unroll
        for (int m = 0; m < 4; ++m)
#pragma unroll
            for (int q = 0; q < 2; ++q) { av[m][q] = (f32x4){0.f, 0.f, 0.f, 0.f}; ag[m][q] = (f32x4){0.f, 0.f, 0.f, 0.f}; }
#pragma unroll 2
        for (int ks = 0; ks < 8; ++ks) {
            bf16x8 af[4], bv[2], bg[2];
#pragma unroll
            for (int m = 0; m < 4; ++m) af[m] = *(const bf16x8*)(YS + (size_t)(16 * m + r16) * 256 + 32 * ks + 8 * g4);
#pragma unroll
            for (int q = 0; q < 2; ++q) { const int c = 32 * F.wave + 16 * q + r16; const int rowv = 256 * (c >> 7) + (c & 127);
                bv[q] = *(const bf16x8*)(GW + (size_t)rowv * 256 + 32 * ks + 8 * g4); bg[q] = *(const bf16x8*)(GW + (size_t)(rowv + 128) * 256 + 32 * ks + 8 * g4); }
#pragma unroll
            for (int m = 0; m < 4; ++m)
#pragma unroll
                for (int q = 0; q < 2; ++q) { av[m][q] = __builtin_amdgcn_mfma_f32_16x16x32_bf16(af[m], bv[q], av[m][q], 0, 0, 0); ag[m][q] = __builtin_amdgcn_mfma_f32_16x16x32_bf16(af[m], bg[q], ag[m][q], 0, 0, 0); }
        }
        bf16_t* Y = (bf16_t*)(F.ws + WS_H);
#pragma unroll
        for (int q = 0; q < 2; ++q) { const int c = 32 * F.wave + 16 * q + r16; const float bvl = F.in[I_SGLUB][layer * 512 + c], bgt = F.in[I_SGLUB][layer * 512 + 256 + c];
#pragma unroll
            for (int m = 0; m < 4; ++m)
#pragma unroll
                for (int i = 0; i < 4; ++i) Y[(T0 + 16 * m + 4 * g4 + i) * DM + 768 + c] = f2bf((av[m][q][i] + bvl) * sigmoidf_(ag[m][q][i] + bgt)); }
    }
}
__device__ __forceinline__ void item_s5_carry(const Frame& F_, int layer, int b) { Frame F = relocal(F_);
    const float* tab = (const float*)(F.ws + WS_S5TAB + (size_t)layer * S5TAB_L) + 2048;
    float* ST = (float*)(F.ws + WS_S5ST) + (size_t)b * 64 * 2048;
#pragma unroll
    for (int q = 0; q < 2; ++q) { const int gn = F.tid + 512 * q; const float pr = tab[gn * 2], pi = tab[gn * 2 + 1]; float hr = 0.f, hi = 0.f;
        for (int c = 0; c < 64; ++c) { float* p = ST + (size_t)c * 2048 + gn * 2; const float tr = p[0], ti = p[1]; p[0] = hr; p[1] = hi;
            const float nr = pr * hr - pi * hi + tr, ni = pr * hi + pi * hr + ti; hr = nr; hi = ni; } }
}

constexpr int RB_LD = 72;
constexpr int RW_R = 0, RW_K = 16384, RW_V = 32768, RW_W = 49152, RW_A = 65536, RW_B = 81920;
constexpr int R3_G = 49152, R3_O = 65536, R3_TILES = 81920, R3_BON = 147456;
template <int STAGE> __device__ __forceinline__ void rwkv_prep(const Frame& F_, int layer, int b, int h, int c) { Frame F = relocal(F_);
    const bf16_t* U = (const bf16_t*)(F.ws + WS_U);
    const int l0 = c * 64; const size_t T0 = (size_t)b * SEQ + l0;
    LAS float* Rr = (LAS float*)(F.lds + RW_R); LAS float* Kk = (LAS float*)(F.lds + RW_K); LAS float* Vv = (LAS float*)(F.lds + RW_V); LAS float* Ww = (LAS float*)(F.lds + RW_W);
    LAS float* Aa = (LAS float*)(F.lds + (STAGE == 1 ? RW_A : R3_O)); LAS float* Bb = (LAS float*)(F.lds + RW_B); LAS float* Gg = (LAS float*)(F.lds + R3_G); LAS float* BON = (LAS float*)(F.lds + R3_BON);
    LAS bf16_t* TWb = (LAS bf16_t*)(F.lds + 98304); LAS bf16_t* DAb = (LAS bf16_t*)(F.lds + (STAGE == 1 ? 103424 : 118784)); LAS bf16_t* SGb = (LAS bf16_t*)(F.lds + 123904);
    LAS bf16_t* w2T = (LAS bf16_t*)(F.lds + 108544); LAS bf16_t* a2T = (LAS bf16_t*)(F.lds + (STAGE == 1 ? 113664 : 133120)); LAS bf16_t* g2T = (LAS bf16_t*)(F.lds + 138240);
    const float* mu = F.in[I_RMU] + layer * 896;
    { const int tok = F.tid >> 3, p8 = F.tid & 7; const bool first = (l0 + tok == 0);
      const bf16_t* cur = U + (T0 + tok) * NINP + UR; const bf16_t* prv = first ? cur : cur - NINP;
      const float pz = first ? 0.f : 1.f;
      u32x4 cw[3], pw[3]; u32x2 c1 = (u32x2){0u, 0u}, p1 = (u32x2){0u, 0u}, c2 = (u32x2){0u, 0u}, p2 = (u32x2){0u, 0u}; u32x4 c3 = (u32x4){0u, 0u, 0u, 0u}, p3 = (u32x4){0u, 0u, 0u, 0u};
#pragma unroll
      for (int sec = (STAGE == 1 ? 0 : 2); sec < 3; ++sec) { const int co = sec * 256 + h * 64 + 8 * p8; cw[sec] = *(const u32x4*)(cur + co); pw[sec] = *(const u32x4*)(prv + co); }
      if (STAGE == 1) { c1 = *(const u32x2*)(cur + 768 + 4 * p8); p1 = *(const u32x2*)(prv + 768 + 4 * p8); c2 = *(const u32x2*)(cur + 800 + 4 * p8); p2 = *(const u32x2*)(prv + 800 + 4 * p8); }
      if (STAGE == 3) { c3 = *(const u32x4*)(cur + 832 + 8 * p8); p3 = *(const u32x4*)(prv + 832 + 8 * p8); }
#pragma unroll
      for (int sec = (STAGE == 1 ? 0 : 2); sec < 3; ++sec) { const int co = sec * 256 + h * 64 + 8 * p8; float av[8], pq[8]; unpack8(cw[sec], av); unpack8(pw[sec], pq);
          const f32x4 m0 = *(const f32x4*)(mu + co), m1 = *(const f32x4*)(mu + co + 4);
          LAS float* dst = (sec == 0 ? Rr : sec == 1 ? Kk : Vv) + tok * 64 + 8 * p8;
#pragma unroll
          for (int j = 0; j < 8; ++j) pq[j] *= pz;
          *(LAS f32x4*)dst = (f32x4){av[0] + m0[0] * (pq[0] - av[0]), av[1] + m0[1] * (pq[1] - av[1]), av[2] + m0[2] * (pq[2] - av[2]), av[3] + m0[3] * (pq[3] - av[3])};
          *(LAS f32x4*)(dst + 4) = (f32x4){av[4] + m1[0] * (pq[4] - av[4]), av[5] + m1[1] * (pq[5] - av[5]), av[6] + m1[2] * (pq[6] - av[6]), av[7] + m1[3] * (pq[7] - av[7])}; }
      if (STAGE == 1) {
#pragma unroll
        for (int which = 0; which < 2; ++which) { const int co = 768 + 32 * which + 4 * p8; const u32x2 cv = which ? c2 : c1, pv = which ? p2 : p1;
          const f32x4 m0 = *(const f32x4*)(mu + co);
          float x[4] = {__uint_as_float(cv.x << 16), __uint_as_float(cv.x & 0xffff0000u), __uint_as_float(cv.y << 16), __uint_as_float(cv.y & 0xffff0000u)};
          const float y[4] = {pz * __uint_as_float(pv.x << 16), pz * __uint_as_float(pv.x & 0xffff0000u), pz * __uint_as_float(pv.y << 16), pz * __uint_as_float(pv.y & 0xffff0000u)};
#pragma unroll
          for (int j = 0; j < 4; ++j) { x[j] = x[j] + m0[j] * (y[j] - x[j]); if (which == 0) x[j] = tanhf_(x[j]); }
          *(LAS u32x2*)((which ? DAb : TWb) + tok * 40 + 4 * p8) = (u32x2){pk2(x[0], x[1]), pk2(x[2], x[3])}; } }
      if (STAGE == 3) { const int co = 832 + 8 * p8; float av[8], pq[8]; unpack8(c3, av); unpack8(p3, pq);
          const f32x4 m0 = *(const f32x4*)(mu + co), m1 = *(const f32x4*)(mu + co + 4); float x[8];
#pragma unroll
          for (int j = 0; j < 8; ++j) x[j] = sigmoidf_(av[j] + (j < 4 ? m0[j] : m1[j - 4]) * (pz * pq[j] - av[j]));
          *(LAS u32x4*)(SGb + tok * RB_LD + 8 * p8) = (u32x4){pk2(x[0], x[1]), pk2(x[2], x[3]), pk2(x[4], x[5]), pk2(x[6], x[7])}; } }
    { const int ch = F.tid & 63, part = F.tid >> 6;
      if (STAGE == 1) { const float* w2 = F.in[I_RW2] + ((size_t)layer * 32 + 4 * part) * 256 + h * 64 + ch;
          *(LAS u32x2*)(w2T + ch * 40 + 4 * part) = (u32x2){pk2(w2[0], w2[256]), pk2(w2[512], w2[768])}; }
      if (STAGE == 1) { const float* a2 = F.in[I_RA2] + ((size_t)layer * 32 + 4 * part) * 256 + h * 64 + ch;
          *(LAS u32x2*)(a2T + ch * 40 + 4 * part) = (u32x2){pk2(a2[0], a2[256]), pk2(a2[512], a2[768])}; }
      if (STAGE == 3) { const float* g2 = F.in[I_RG2] + ((size_t)layer * 64 + 8 * part) * 256 + h * 64 + ch;
          *(LAS u32x4*)(g2T + ch * RB_LD + 8 * part) = (u32x4){pk2(g2[0], g2[256]), pk2(g2[512], g2[768]), pk2(g2[1024], g2[1280]), pk2(g2[1536], g2[1792])}; } }
    __syncthreads();
    { const int lane = F.lane, mt = F.wave >> 1, nt0 = 2 * (F.wave & 1), r = lane & 15, g4 = lane >> 4; const f32x4 zero4 = (f32x4){0.f, 0.f, 0.f, 0.f};
#pragma unroll
      for (int q = 0; q < 2; ++q) { const int nt = nt0 + q, ch = 16 * nt + r, cg = layer * 256 + h * 64 + ch;
          if (STAGE == 1) { const f32x4 wl = mma_nt<32>(TWb + 16 * mt * 40, 40, w2T + 16 * nt * 40, 40, zero4, lane); const float w0 = F.in[I_RW0][cg];
#pragma unroll
              for (int i = 0; i < 4; ++i) { const float x = w0 + wl[i]; const float wlog = -__logf(1.0f + __expf(-x)) - 0.5f; Ww[(16 * mt + 4 * g4 + i) * 64 + ch] = __expf(-__expf(wlog)); } }
          if (STAGE == 1) { const f32x4 al = mma_nt<32>(DAb + 16 * mt * 40, 40, a2T + 16 * nt * 40, 40, zero4, lane); const float a0 = F.in[I_RA0][cg];
#pragma unroll
              for (int i = 0; i < 4; ++i) Aa[(16 * mt + 4 * g4 + i) * 64 + ch] = sigmoidf_(a0 + al[i]); }
          if (STAGE == 3) { const f32x4 gv = mma_nt<64>(SGb + 16 * mt * RB_LD, RB_LD, g2T + 16 * nt * RB_LD, RB_LD, zero4, lane);
#pragma unroll
              for (int i = 0; i < 4; ++i) Gg[(16 * mt + 4 * g4 + i) * 64 + ch] = gv[i]; } } }
    __syncthreads();
    float* gBON = (float*)(F.ws + WS_BON) + ((size_t)(b * 4 + h) * 64 + c) * 64;
    if (STAGE == 1) { const int j = F.lane, tq = F.wave, cg = layer * 256 + h * 64 + j;
      const float kkw = F.in[I_RKK][cg], kaw = F.in[I_RKA][cg], rk = F.in[I_RRK][cg];
#pragma unroll 2
      for (int i8 = 0; i8 < 8; ++i8) { const int t = tq + 8 * i8;
          const float a = Aa[t * 64 + j]; const float kraw = Kk[t * 64 + j]; const float kp = kraw * (1.0f + (a - 1.0f) * kaw);
          Kk[t * 64 + j] = kp;
          const float kkv = kraw * kkw; const float ss = wave_sum(kkv * kkv); const float kkn = kkv * rsqrtf(fmaxf(ss, 1e-24f)); Aa[t * 64 + j] = -kkn; Bb[t * 64 + j] = kkn * a;
          const float bo = wave_sum(Rr[t * 64 + j] * kp * rk); if (j == 0) gBON[t] = bo; } }
    else if (F.tid < 64) BON[F.tid] = gBON[F.tid];
    __syncthreads();
}
constexpr int RB_AT = 98304, RB_ATT = RB_AT + 9216, RB_BT = RB_ATT + 9216, RB_BTT = RB_BT + 9216, RB_KT = RB_BTT + 9216, RB_RT = RB_KT + 9216, RB_VT = RB_RT + 9216, RB_GC = RB_VT + 9216;
constexpr int RX_X = 0, RX_XT = 9216, RX_TB = 18432, RX_M = 27648, RX_NRT = 36864, RX_G1T = 46080, RX_G2T = 55296, RX_QT = 64512;
__device__ __forceinline__ void st_tile(LAS bf16_t* dst, int mt, int nt, const f32x4 v, int lane) {
    const int r = lane & 15, g = lane >> 4;
#pragma unroll
    for (int i = 0; i < 4; ++i) dst[(16 * mt + 4 * g + i) * RB_LD + 16 * nt + r] = f2bf(v[i]);
}
__device__ __forceinline__ void st_tile_t(LAS bf16_t* dst, int mt, int nt, const f32x4 v, int lane) {
    const int r = lane & 15, g = lane >> 4; u32x2 w; w.x = pk2(v[0], v[1]); w.y = pk2(v[2], v[3]);
    *(LAS u32x2*)(dst + (16 * nt + r) * RB_LD + 16 * mt + 4 * g) = w;
}
__device__ __forceinline__ void item_rwkv1(const Frame& F_, int layer, int item) { Frame F = relocal(F_);
    const int b = item >> 8, h = (item >> 6) & 3, c = item & 63;
    rwkv_prep<1>(F, layer, b, h, c);
    LAS float* Rr = (LAS float*)(F.lds + RW_R); LAS float* Kk = (LAS float*)(F.lds + RW_K); LAS float* Vv = (LAS float*)(F.lds + RW_V); LAS float* Ww = (LAS float*)(F.lds + RW_W);
    LAS float* Aa = (LAS float*)(F.lds + RW_A); LAS float* Bb = (LAS float*)(F.lds + RW_B);
    LAS bf16_t* At = (LAS bf16_t*)(F.lds + RB_AT); LAS bf16_t* AtT = (LAS bf16_t*)(F.lds + RB_ATT); LAS bf16_t* Bt = (LAS bf16_t*)(F.lds + RB_BT); LAS bf16_t* BtT = (LAS bf16_t*)(F.lds + RB_BTT);
    LAS bf16_t* Kt = (LAS bf16_t*)(F.lds + RB_KT); LAS bf16_t* Rt = (LAS bf16_t*)(F.lds + RB_RT); LAS bf16_t* VT = (LAS bf16_t*)(F.lds + RB_VT); LAS float* gC = (LAS float*)(F.lds + RB_GC);
    LAS bf16_t* X = (LAS bf16_t*)(F.lds + RX_X); LAS bf16_t* XT = (LAS bf16_t*)(F.lds + RX_XT); LAS bf16_t* Tb = (LAS bf16_t*)(F.lds + RX_TB); LAS bf16_t* Mm = (LAS bf16_t*)(F.lds + RX_M);
    LAS bf16_t* NrT = (LAS bf16_t*)(F.lds + RX_NRT); LAS bf16_t* G1T = (LAS bf16_t*)(F.lds + RX_G1T); LAS bf16_t* G2T = (LAS bf16_t*)(F.lds + RX_G2T); LAS bf16_t* QT = (LAS bf16_t*)(F.lds + RX_QT);
    { const int k = F.tid & 63, part = F.tid >> 6; float g = 1.0f;
      for (int pp = 0; pp < part; ++pp) { float w8[8];
#pragma unroll
          for (int i = 0; i < 8; ++i) w8[i] = Ww[(8 * pp + i) * 64 + k];
          g *= ((w8[0] * w8[1]) * (w8[2] * w8[3])) * ((w8[4] * w8[5]) * (w8[6] * w8[7])); }
#pragma unroll
      for (int i = 0; i < 8; ++i) { const int t = 8 * part + i; const float gp = g; g *= Ww[t * 64 + k]; const float ig = 1.0f / g;
          const bf16_t av = f2bf(Aa[t * 64 + k] * gp), bv = f2bf(Bb[t * 64 + k] * ig);
          At[t * RB_LD + k] = av; AtT[k * RB_LD + t] = av; Bt[t * RB_LD + k] = bv; BtT[k * RB_LD + t] = bv;
          Kt[t * RB_LD + k] = f2bf(Kk[t * 64 + k] * ig); Rt[t * RB_LD + k] = f2bf(Rr[t * 64 + k] * g); VT[k * RB_LD + t] = f2bf(Vv[t * 64 + k]); }
      if (part == 7) gC[k] = g; }
    __syncthreads();
    const int lane = F.lane, mt = F.wave >> 1, nt0 = 2 * (F.wave & 1), r = lane & 15, g4 = lane >> 4;
    const f32x4 zero4 = (f32x4){0.f, 0.f, 0.f, 0.f};
    f32x4 Tacc[2];
#pragma unroll
    for (int q = 0; q < 2; ++q) { const int nt = nt0 + q;
        f32x4 n = mma_nt<64>(Bt + 16 * mt * RB_LD, RB_LD, At + 16 * nt * RB_LD, RB_LD, zero4, lane);
        f32x4 m = mma_nt<64>(Kt + 16 * mt * RB_LD, RB_LD, At + 16 * nt * RB_LD, RB_LD, zero4, lane);
        f32x4 nr = mma_nt<64>(Rt + 16 * mt * RB_LD, RB_LD, Bt + 16 * nt * RB_LD, RB_LD, zero4, lane);
#pragma unroll
        for (int i = 0; i < 4; ++i) { const int row = 16 * mt + 4 * g4 + i, col = 16 * nt + r;
            n[i] = (row < col) ? n[i] : 0.f; m[i] = (row < col) ? m[i] : 0.f; nr[i] = (col <= row) ? nr[i] : 0.f;
            Tacc[q][i] = n[i] + (row == col ? 1.0f : 0.f); }
        st_tile(X, mt, nt, n, lane); st_tile_t(XT, mt, nt, n, lane); st_tile(Tb, mt, nt, Tacc[q], lane); st_tile(Mm, mt, nt, m, lane); st_tile(NrT, mt, nt, nr, lane); }
    __syncthreads();
#pragma unroll 1
    for (int it = 0; it < 6; ++it) {
        LAS bf16_t* Xr = (it & 1) ? G1T : X; LAS bf16_t* XTr = (it & 1) ? G2T : XT; LAS bf16_t* Tr = (it & 1) ? QT : Tb;
        LAS bf16_t* Xw = (it & 1) ? X : G1T; LAS bf16_t* XTw = (it & 1) ? XT : G2T; LAS bf16_t* Tw = (it & 1) ? Tb : QT;
#pragma unroll
        for (int q = 0; q < 2; ++q) { const int nt = nt0 + q;
            if (it > 0) Tacc[q] = mma_nt<64>(Tr + 16 * mt * RB_LD, RB_LD, XTr + 16 * nt * RB_LD, RB_LD, Tacc[q], lane);
            if (it < 5) { const f32x4 x2 = mma_nt<64>(Xr + 16 * mt * RB_LD, RB_LD, XTr + 16 * nt * RB_LD, RB_LD, zero4, lane); st_tile(Xw, mt, nt, x2, lane); st_tile_t(XTw, mt, nt, x2, lane); }
            st_tile(Tw, mt, nt, Tacc[q], lane); }
        __syncthreads();
    }
#pragma unroll
    for (int q = 0; q < 2; ++q) { const int nt = nt0 + q;
        st_tile(G1T, mt, nt, mma_nt<64>(NrT + 16 * mt * RB_LD, RB_LD, Tb + 16 * nt * RB_LD, RB_LD, zero4, lane), lane);
        st_tile(G2T, mt, nt, mma_nt<64>(BtT + 16 * mt * RB_LD, RB_LD, Tb + 16 * nt * RB_LD, RB_LD, zero4, lane), lane); }
    __syncthreads();
    const size_t ci = (size_t)(b * 4 + h) * 64 + c;
    bf16_t* gPT = (bf16_t*)(F.ws + WS_MOE + RW_PT) + ci * 4096; bf16_t* gW1 = (bf16_t*)(F.ws + WS_MOE + RW_W1) + ci * 4096; bf16_t* gZ = (bf16_t*)(F.ws + WS_MOE + RW_Z) + ci * 4096;
#pragma unroll
    for (int q = 0; q < 2; ++q) { const int nt = nt0 + q; const int col = 16 * nt + r;
        f32x4 w1 = mma_nt<64>(G1T + 16 * mt * RB_LD, RB_LD, AtT + 16 * nt * RB_LD, RB_LD, zero4, lane);
        f32x4 z = mma_nt<64>(G1T + 16 * mt * RB_LD, RB_LD, Mm + 16 * nt * RB_LD, RB_LD, zero4, lane);
        f32x4 mr = mma_nt<64>(Rt + 16 * mt * RB_LD, RB_LD, Kt + 16 * nt * RB_LD, RB_LD, zero4, lane);
        f32x4 p = mma_nt<64>(G2T + 16 * mt * RB_LD, RB_LD, AtT + 16 * nt * RB_LD, RB_LD, zero4, lane);
        f32x4 qq = mma_nt<64>(G2T + 16 * mt * RB_LD, RB_LD, Mm + 16 * nt * RB_LD, RB_LD, zero4, lane);
        const int pos = 32 * (col >> 5) + 8 * ((col >> 2) & 3) + 4 * ((col >> 4) & 1) + (col & 3);
#pragma unroll
        for (int i = 0; i < 4; ++i) { const int row = 16 * mt + 4 * g4 + i;
            gW1[row * 64 + col] = f2bf(w1[i] + bf2f(Rt[row * RB_LD + col]));
            gZ[row * 64 + col] = f2bf(z[i] + (col <= row ? mr[i] : 0.f));
            const float gc = gC[row];
            gPT[row * 64 + pos] = f2bf((p[i] + (row == col ? 1.0f : 0.f)) * gc);
            qq[i] = (qq[i] + bf2f(Kt[col * RB_LD + row])) * gc; }
        st_tile(QT, mt, nt, qq, lane); }
    __syncthreads();
    bf16_t* gU = (bf16_t*)(F.ws + WS_MOE + RW_U) + ci * 4096;
#pragma unroll
    for (int q = 0; q < 2; ++q) { const int nt = nt0 + q;
        const f32x4 u = mma_nt<64>(VT + 16 * mt * RB_LD, RB_LD, QT + 16 * nt * RB_LD, RB_LD, zero4, lane);
#pragma unroll
        for (int i = 0; i < 4; ++i) gU[(16 * mt + 4 * g4 + i) * 64 + 16 * nt + r] = f2bf(u[i]); }
}
__device__ __forceinline__ void item_rwkv_carry(const Frame& F_, int item) { Frame F = relocal(F_);
    const int bh = item * 2 + (F.wave >> 2), nt = F.wave & 3, r = F.lane & 15, g = F.lane >> 4;
    const bf16_t* PT = (const bf16_t*)(F.ws + WS_MOE + RW_PT); const bf16_t* Uc = (const bf16_t*)(F.ws + WS_MOE + RW_U); bf16_t* Ss = (bf16_t*)(F.ws + WS_MOE + RW_S);
    f32x4 acc[4];
#pragma unroll
    for (int m = 0; m < 4; ++m) acc[m] = (f32x4){0.f, 0.f, 0.f, 0.f};
    for (int c = 0; c < 64; ++c) { const size_t ci = (size_t)bh * 64 + c;
        bf16x8 af[4][2]; f32x4 cin[4];
#pragma unroll
        for (int m = 0; m < 4; ++m) { const u32x2 uv = *(const u32x2*)(Uc + ci * 4096 + (16 * nt + r) * 64 + 16 * m + 4 * g);
            cin[m] = (f32x4){__uint_as_float(uv.x << 16), __uint_as_float(uv.x & 0xffff0000u), __uint_as_float(uv.y << 16), __uint_as_float(uv.y & 0xffff0000u)};
#pragma unroll
            for (int s = 0; s < 2; ++s) af[m][s] = *(const bf16x8*)(PT + ci * 4096 + (16 * m + r) * 64 + 32 * s + 8 * g); }
        unsigned pw[4][2];
#pragma unroll
        for (int m = 0; m < 4; ++m) { pw[m][0] = pk2(acc[m][0], acc[m][1]); pw[m][1] = pk2(acc[m][2], acc[m][3]);
            *(u32x2*)(Ss + ci * 4096 + (16 * nt + r) * 64 + 16 * m + 4 * g) = (u32x2){pw[m][0], pw[m][1]}; }
        bf16x8 bfr[2];
#pragma unroll
        for (int s = 0; s < 2; ++s) bfr[s] = __builtin_bit_cast(bf16x8, (u32x4){pw[2 * s][0], pw[2 * s][1], pw[2 * s + 1][0], pw[2 * s + 1][1]});
#pragma unroll
        for (int m = 0; m < 4; ++m) { acc[m] = __builtin_amdgcn_mfma_f32_16x16x32_bf16(af[m][0], bfr[0], cin[m], 0, 0, 0);
            acc[m] = __builtin_amdgcn_mfma_f32_16x16x32_bf16(af[m][1], bfr[1], acc[m], 0, 0, 0); }
    }
}
__device__ __forceinline__ void item_rwkv3(const Frame& F_, int layer, int item) { Frame F = relocal(F_);
    const int b = item >> 8, h = (item >> 6) & 3, c = item & 63; const size_t T0 = (size_t)b * SEQ + c * 64;
    rwkv_prep<3>(F, layer, b, h, c);
#ifdef PROBE_PREP
    rwkv_prep<3>(F, layer, b, h, c);
#endif
    LAS float* Vv = (LAS float*)(F.lds + RW_V); LAS float* Oo = (LAS float*)(F.lds + R3_O);
    LAS float* Gg = (LAS float*)(F.lds + R3_G); LAS float* BON = (LAS float*)(F.lds + R3_BON);
    LAS bf16_t* S0b = (LAS bf16_t*)(F.lds + R3_TILES); LAS bf16_t* W1b = S0b + 4608; LAS bf16_t* Zb = W1b + 4608; LAS bf16_t* VTb = Zb + 4608;
    { const size_t ci = (size_t)(b * 4 + h) * 64 + c; const int row = F.tid >> 3, col = (F.tid & 7) * 8;
      *(LAS u32x4*)(S0b + row * RB_LD + col) = *(const u32x4*)((const bf16_t*)(F.ws + WS_MOE + RW_S) + ci * 4096 + F.tid * 8);
      *(LAS u32x4*)(W1b + row * RB_LD + col) = *(const u32x4*)((const bf16_t*)(F.ws + WS_MOE + RW_W1) + ci * 4096 + F.tid * 8);
      *(LAS u32x4*)(Zb + row * RB_LD + col) = *(const u32x4*)((const bf16_t*)(F.ws + WS_MOE + RW_Z) + ci * 4096 + F.tid * 8);
      const int vv = F.tid & 63, part = F.tid >> 6;
#pragma unroll
      for (int i = 0; i < 8; ++i) { const int t = 8 * part + i; VTb[vv * RB_LD + t] = f2bf(Vv[t * 64 + vv]); } }
    __syncthreads();
    { const int lane = F.lane, mt = F.wave >> 1, nt0 = 2 * (F.wave & 1), r = lane & 15, g4 = lane >> 4;
#pragma unroll
      for (int q = 0; q < 2; ++q) { const int nt = nt0 + q;
          f32x4 o = mma_nt<64>(W1b + 16 * mt * RB_LD, RB_LD, S0b + 16 * nt * RB_LD, RB_LD, (f32x4){0.f, 0.f, 0.f, 0.f}, lane);
          o = mma_nt<64>(Zb + 16 * mt * RB_LD, RB_LD, VTb + 16 * nt * RB_LD, RB_LD, o, lane);
#pragma unroll
          for (int i = 0; i < 4; ++i) Oo[(16 * mt + 4 * g4 + i) * 64 + 16 * nt + r] = o[i]; } }
    __syncthreads();
    { const int j = F.lane, tq = F.wave, ch = h * 64 + j;
      const float lw = F.in[I_RLNW][layer * 256 + ch], lb = F.in[I_RLNB][layer * 256 + ch];
      bf16_t* Y = (bf16_t*)(F.ws + WS_H);
#pragma unroll 2
      for (int i8 = 0; i8 < 8; ++i8) { const int t = tq + 8 * i8;
          const float o = Oo[t * 64 + j]; const float mean = wave_sum(o) * (1.0f / 64.0f); const float d = o - mean; const float var = wave_sum(d * d) * (1.0f / 64.0f);
          float on = d * rsqrtf(var + 64e-5f) * lw + lb; on += BON[t] * Vv[t * 64 + j];
          Y[(T0 + t) * DM + 256 + ch] = f2bf(on * Gg[t * 64 + j]); } }
}

constexpr int DS_SEL = 131072, DS_HIST = 135168, DS_BKT = 151552, DS_BIAS = 152064;
__device__ __forceinline__ void dsa_tables(const Frame& F_) { Frame F = relocal(F_);
    LAS int* bkt = (LAS int*)(F.lds + DS_BKT); LAS float* biasT = (LAS float*)(F.lds + DS_BIAS);
    if (F.tid < 128) { const int n = F.tid; int bk = n; if (n >= 16) { const float lr = logf((float)n / 16.0f) / 2.0794415416798357f; bk = 16 + (int)(lr * 16.0f); bk = bk < 31 ? bk : 31; } bkt[n] = bk; biasT[n] = F.in[I_RELB][n]; }
    __syncthreads();
}
__device__ __forceinline__ unsigned fkey(float f) { const unsigned u = __float_as_uint(f); return (u & 0x80000000u) ? ~u : (u | 0x80000000u); }
__device__ __forceinline__ void item_dsa(const Frame& F_, int layer, int item) { Frame F = relocal(F_);
    const bf16_t* U = (const bf16_t*)(F.ws + WS_U); const bf16_t* KI = (const bf16_t*)(F.ws + WS_KIDX);
    const bf16_t* Kb = (const bf16_t*)(F.ws + WS_K); const bf16_t* Vb = (const bf16_t*)(F.ws + WS_V);
    const int b = item & 3, qg = 511 - (item >> 2); const size_t TB = (size_t)b * SEQ, T0 = TB + qg * 8;
    LAS float* sc = (LAS float*)F.lds; LAS unsigned short* selall = (LAS unsigned short*)(F.lds + DS_SEL); LAS unsigned* histall = (LAS unsigned*)(F.lds + DS_HIST);
    LAS int* bkt = (LAS int*)(F.lds + DS_BKT); LAS float* biasT = (LAS float*)(F.lds + DS_BIAS);
    const int lane = F.lane, hh = lane >> 5;
    {
        bf16x8 af[2][2]; float wq[2][2][8];
        { const int r = lane & 31, q4 = 2 * ((r >> 2) & 1) + (r >> 4), head = 4 * ((r >> 3) & 1) + (r & 3);
#pragma unroll
          for (int mt = 0; mt < 2; ++mt)
#pragma unroll
              for (int ks = 0; ks < 2; ++ks) af[mt][ks] = *(const bf16x8*)(U + (T0 + 4 * mt + q4) * NINP + UC + 384 + head * 32 + 16 * ks + 8 * hh); }
#pragma unroll
        for (int mt = 0; mt < 2; ++mt)
#pragma unroll
            for (int q2 = 0; q2 < 2; ++q2) { float f[8]; unpack8(*(const u32x4*)(U + (T0 + 4 * mt + 2 * hh + q2) * NINP + UC + 672), f);
#pragma unroll
                for (int hd = 0; hd < 8; ++hd) wq[mt][q2][hd] = f[hd]; }
        const int ntile = (qg * 8 + 8 + 31) >> 5;
        bf16x8 nb0 = af[0][0], nb1 = af[0][0];
        if (F.wave < ntile) { const int key = F.wave * 32 + (lane & 31); nb0 = *(const bf16x8*)(KI + (TB + key) * 32 + 8 * hh); nb1 = *(const bf16x8*)(KI + (TB + key) * 32 + 16 + 8 * hh); }
        for (int kt = F.wave; kt < ntile; kt += 8) {
            const int key = kt * 32 + (lane & 31);
            const bf16x8 b0 = nb0, b1 = nb1;
            if (kt + 8 < ntile) { const int k2 = key + 256; nb0 = *(const bf16x8*)(KI + (TB + k2) * 32 + 8 * hh); nb1 = *(const bf16x8*)(KI + (TB + k2) * 32 + 16 + 8 * hh); }
#pragma unroll
            for (int mt = 0; mt < 2; ++mt) { f32x16 acc;
#pragma unroll
                for (int i = 0; i < 16; ++i) acc[i] = 0.f;
                acc = __builtin_amdgcn_mfma_f32_32x32x16_bf16(af[mt][0], b0, acc, 0, 0, 0);
                acc = __builtin_amdgcn_mfma_f32_32x32x16_bf16(af[mt][1], b1, acc, 0, 0, 0);
#pragma unroll
                for (int q2 = 0; q2 < 2; ++q2) { float s = 0.f;
#pragma unroll
                    for (int hd = 0; hd < 8; ++hd) s += fmaxf(acc[8 * q2 + hd], 0.f) * wq[mt][q2][hd];
                    const int qi = 4 * mt + 2 * hh + q2;
                    sc[qi * 4096 + key] = (key <= qg * 8 + qi) ? s : -INFINITY; } }
        }
    }
    __syncthreads();
    const int qi = F.wave, tq = qg * 8 + qi, n = tq + 1;
    LAS float* scq = sc + qi * 4096; LAS unsigned short* sel = selall + qi * 256; LAS unsigned* hist = histall + qi * 512;
    int nsel;
    if (n <= 256) { nsel = n; for (int j = lane; j < 256; j += 64) sel[j] = (unsigned short)(j < n ? j : 0); }
    else {
        nsel = 256;
        const int R = (n + 63) >> 6; const unsigned long long ltm = (1ull << lane) - 1ull;
        float lo = INFINITY, hi = -INFINITY;
        const int R4 = (n + 255) >> 8;
#pragma unroll 4
        for (int i = 0; i < R4; ++i) { const int j0 = 256 * i + 4 * lane; const f32x4 v4 = *(const LAS f32x4*)(scq + j0);
#pragma unroll
            for (int q = 0; q < 4; ++q) { const bool valid = j0 + q < n; lo = fminf(lo, valid ? v4[q] : INFINITY); hi = fmaxf(hi, valid ? v4[q] : -INFINITY); } }
#pragma unroll
        for (int o = 1; o < 64; o <<= 1) { lo = fminf(lo, shx(lo, o)); hi = fmaxf(hi, shx(hi, o)); }
        bool slow = false;
        if (!(hi > lo)) { for (int j = lane; j < 256; j += 64) sel[j] = (unsigned short)j; }
        else {
            const float scale = 1023.0f / (hi - lo);
            *(LAS u32x4*)(hist + 8 * lane) = (u32x4){0u, 0u, 0u, 0u}; *(LAS u32x4*)(hist + 8 * lane + 4) = (u32x4){0u, 0u, 0u, 0u};
#pragma unroll 2
            for (int i = 0; i < R4; ++i) { const int j0 = 256 * i + 4 * lane; const f32x4 v4 = *(const LAS f32x4*)(scq + j0);
#pragma unroll
                for (int q = 0; q < 4; ++q) { if (j0 + q < n) { int bk = (int)((v4[q] - lo) * scale); bk = bk < 1023 ? bk : 1023;
                    atomicAdd((unsigned*)(hist + (bk >> 1)), (bk & 1) ? 65536u : 1u); } } }
            const u32x4 h0 = *(const LAS u32x4*)(hist + 8 * lane), h1 = *(const LAS u32x4*)(hist + 8 * lane + 4);
            unsigned cb[16];
            cb[0] = h0.x & 0xffffu; cb[1] = h0.x >> 16; cb[2] = h0.y & 0xffffu; cb[3] = h0.y >> 16; cb[4] = h0.z & 0xffffu; cb[5] = h0.z >> 16; cb[6] = h0.w & 0xffffu; cb[7] = h0.w >> 16;
            cb[8] = h1.x & 0xffffu; cb[9] = h1.x >> 16; cb[10] = h1.y & 0xffffu; cb[11] = h1.y >> 16; cb[12] = h1.z & 0xffffu; cb[13] = h1.z >> 16; cb[14] = h1.w & 0xffffu; cb[15] = h1.w >> 16;
            unsigned tot = 0u;
#pragma unroll
            for (int q = 0; q < 16; ++q) tot += cb[q];
            unsigned incl = tot;
#pragma unroll
            for (int o = 1; o < 64; o <<= 1) { const unsigned t = shdown_u(incl, o); if (lane + o < 64) incl += t; }
            int fb = -1; unsigned fabove = 0u, fcnt = 0u; unsigned cum = incl - tot;
#pragma unroll
            for (int q = 15; q >= 0; --q) { if (fb < 0 && cum < 256u && 256u <= cum + cb[q]) { fb = 16 * lane + q; fabove = cum; fcnt = cb[q]; } cum += cb[q]; }
            const unsigned long long mf = __ballot(fb >= 0); const int src = (int)__ffsll((long long)mf) - 1;
            const int B = shidx_i(fb, src); const int above = shidx_i((int)fabove, src), cntB = shidx_i((int)fcnt, src); const int need = 256 - above;
            if (cntB > 256) slow = true;
            else {
                LAS unsigned* cand = hist;
                int base_gt = 0, base_c = 0;
#pragma unroll 2
                for (int i = 0; i < R4; ++i) { const int j0 = 256 * i + 4 * lane; const f32x4 v4 = *(const LAS f32x4*)(scq + j0);
#pragma unroll
                    for (int q = 0; q < 4; ++q) { const int j = j0 + q; const bool valid = j < n; const float v = valid ? v4[q] : lo;
                        int bk = (int)((v - lo) * scale); bk = bk < 1023 ? bk : 1023;
                        const bool gt = valid && bk > B, eq = valid && bk == B;
                        const unsigned long long mg = __ballot(gt), me = __ballot(eq);
                        if (gt) sel[base_gt + __popcll(mg & ltm)] = (unsigned short)j;
                        if (eq) { const int p = base_c + __popcll(me & ltm); cand[2 * p] = fkey(v); cand[2 * p + 1] = (unsigned)j; }
                        base_gt += __popcll(mg); base_c += __popcll(me); } }
                if (need == cntB) { for (int c = lane; c < cntB; c += 64) sel[above + c] = (unsigned short)cand[2 * c + 1]; }
                else {
                    unsigned ck[4], cx[4]; int rk[4];
#pragma unroll
                    for (int q = 0; q < 4; ++q) { const int c = lane + 64 * q; ck[q] = c < cntB ? cand[2 * c] : 0u; cx[q] = c < cntB ? cand[2 * c + 1] : 0u; rk[q] = 0; }
                    for (int c2 = 0; c2 < cntB; ++c2) { const unsigned k2 = cand[2 * c2], x2 = cand[2 * c2 + 1];
#pragma unroll
                        for (int q = 0; q < 4; ++q) rk[q] += (k2 > ck[q] || (k2 == ck[q] && x2 < cx[q])) ? 1 : 0; }
#pragma unroll
                    for (int q = 0; q < 4; ++q) { const int c = lane + 64 * q; if (c < cntB && rk[q] < need) sel[above + rk[q]] = (unsigned short)cand[2 * c + 1]; }
                }
            }
        }
        if (slow) {
        unsigned prefix = 0u; int need = 256; unsigned neq = 0u;
        for (int p = 0; p < 4; ++p) { const int shift = 24 - 8 * p;
            *(LAS u32x4*)(hist + 4 * lane) = (u32x4){0u, 0u, 0u, 0u};
            for (int i = 0; i < R; ++i) { const int j = lane + 64 * i; if (j < n) { const unsigned u = fkey(scq[j]);
                if (p == 0 || (u >> (shift + 8)) == prefix) atomicAdd((unsigned*)(hist + ((u >> shift) & 255u)), 1u); } }
            const u32x4 hv = *(const LAS u32x4*)(hist + 4 * lane);
            const unsigned tot = hv.x + hv.y + hv.z + hv.w;
            unsigned incl = tot;
#pragma unroll
            for (int o = 1; o < 64; o <<= 1) { const unsigned t = shdown_u(incl, o); if (lane + o < 64) incl += t; }
            const unsigned above = incl - tot;
            int fb = -1; unsigned fabove = 0u, feq = 0u; unsigned cum = above;
            { const unsigned hq[4] = {hv.x, hv.y, hv.z, hv.w};
#pragma unroll
              for (int q = 3; q >= 0; --q) { if (fb < 0 && cum < (unsigned)need && (unsigned)need <= cum + hq[q]) { fb = 4 * lane + q; fabove = cum; feq = hq[q]; } cum += hq[q]; } }
            const unsigned long long m = __ballot(fb >= 0);
            const int src = (int)__ffsll((long long)m) - 1;
            const int bin = shidx_i(fb, src); const unsigned ab = (unsigned)shidx_i((int)fabove, src); neq = (unsigned)shidx_i((int)feq, src);
            need -= (int)ab; prefix = (prefix << 8) | (unsigned)bin;
        }
        const int ngt = 256 - need;
        int base_gt = 0, base_eq = 0;
        for (int i = 0; i < R; ++i) { const int j = lane + 64 * i; const unsigned u = (j < n) ? fkey(scq[j]) : 0u;
            const bool gt = (j < n) && (u > prefix), eq = (j < n) && (u == prefix);
            const unsigned long long mg = __ballot(gt), me = __ballot(eq); const unsigned long long lt = (1ull << lane) - 1ull;
            if (gt) sel[base_gt + __popcll(mg & lt)] = (unsigned short)j;
            if (eq) { const int rk = base_eq + __popcll(me & lt); if (rk < need) sel[ngt + rk] = (unsigned short)j; }
            base_gt += __popcll(mg); base_eq += __popcll(me); }
        (void)neq;
            }
    }
    const int nt16 = (nsel + 15) >> 4, r16 = lane & 15, g4 = lane >> 4;
    LAS float* biasj = scq + 2048;
#pragma unroll
    for (int q = 0; q < 4; ++q) { const int j = lane + 64 * q; f32x4 bv = (f32x4){-INFINITY, -INFINITY, -INFINITY, -INFINITY};
        if (j < nsel) { const int dist = tq - (int)sel[j]; const int bk = dist < 128 ? bkt[dist < 0 ? 0 : dist] : 31; bv = *(const LAS f32x4*)(biasT + 4 * bk); }
        *(LAS f32x4*)(biasj + 4 * j) = bv; }
    bf16x8 qf[2];
#pragma unroll
    for (int s = 0; s < 2; ++s) { u32x4 z = (u32x4){0u, 0u, 0u, 0u}; if (r16 < 4) z = *(const u32x4*)(U + (T0 + qi) * NINP + UC + r16 * 64 + 32 * s + 8 * g4); qf[s] = __builtin_bit_cast(bf16x8, z); }
    float lg[16][4]; float mx = -INFINITY;
#define DSA_QK(M0, NM) do { int keyr[NM]; bf16x8 a0[NM], a1[NM]; \
        _Pragma("unroll") for (int m8 = 0; m8 < NM; ++m8) keyr[m8] = sel[16 * ((M0) + m8) + r16]; \
        _Pragma("unroll") for (int m8 = 0; m8 < NM; ++m8) { a0[m8] = *(const bf16x8*)(Kb + (TB + keyr[m8]) * 64 + 8 * g4); a1[m8] = *(const bf16x8*)(Kb + (TB + keyr[m8]) * 64 + 32 + 8 * g4); } \
        _Pragma("unroll") for (int m8 = 0; m8 < NM; ++m8) { const int m = (M0) + m8; \
            f32x4 acc = (f32x4){0.f, 0.f, 0.f, 0.f}; \
            acc = __builtin_amdgcn_mfma_f32_16x16x32_bf16(a0[m8], qf[0], acc, 0, 0, 0); \
            acc = __builtin_amdgcn_mfma_f32_16x16x32_bf16(a1[m8], qf[1], acc, 0, 0, 0); \
            _Pragma("unroll") for (int i = 0; i < 4; ++i) { const float v = acc[i] * 0.125f + biasj[(16 * m + 4 * g4 + i) * 4 + (r16 & 3)]; lg[m][i] = v; mx = fmaxf(mx, v); } } } while (0)
    if (nt16 > 8) { DSA_QK(0, 16); }
    else { DSA_QK(0, 8);
#pragma unroll
        for (int m8 = 8; m8 < 16; ++m8)
#pragma unroll
            for (int i = 0; i < 4; ++i) lg[m8][i] = -INFINITY; }
#undef DSA_QK
    mx = fmaxf(mx, shx(mx, 16)); mx = fmaxf(mx, shx(mx, 32));
    float sm = 0.f;
#pragma unroll
    for (int m = 0; m < 16; ++m)
#pragma unroll
        for (int i = 0; i < 4; ++i) { const float p = __expf(lg[m][i] - mx); lg[m][i] = p; sm += p; }
    sm += shx(sm, 16); sm += shx(sm, 32);
    f32x4 ov[4];
#pragma unroll
    for (int nt = 0; nt < 4; ++nt) ov[nt] = (f32x4){0.f, 0.f, 0.f, 0.f};
    const unsigned vs_base = (unsigned)(unsigned long)scq;
#pragma unroll
    for (int half = 0; half < 2; ++half) {
        if (half * 8 < nt16) {
            asm volatile("s_waitcnt lgkmcnt(0)" ::: "memory");
            int vkey[16];
#pragma unroll
            for (int q = 0; q < 16; ++q) { const int rho = 8 * q + (lane >> 3);
                vkey[q] = sel[half * 128 + (rho & ~31) + 16 * ((rho >> 2) & 1) + 4 * ((rho >> 3) & 3) + (rho & 3)]; }
            asm volatile("s_waitcnt lgkmcnt(0)" : "+v"(vkey[0]), "+v"(vkey[1]), "+v"(vkey[2]), "+v"(vkey[3]), "+v"(vkey[4]), "+v"(vkey[5]), "+v"(vkey[6]), "+v"(vkey[7]),
                         "+v"(vkey[8]), "+v"(vkey[9]), "+v"(vkey[10]), "+v"(vkey[11]), "+v"(vkey[12]), "+v"(vkey[13]), "+v"(vkey[14]), "+v"(vkey[15]) :: "memory");
#pragma unroll
            for (int q = 0; q < 16; ++q)
                __builtin_amdgcn_global_load_lds((const unsigned*)(Vb + (TB + vkey[q]) * 64 + 8 * (lane & 7)), (LAS unsigned*)((LAS unsigned char*)scq + q * 1024), 16, 0, 0);
            asm volatile("s_waitcnt vmcnt(0)" ::: "memory");
#pragma unroll
            for (int s4 = 0; s4 < 4; ++s4) { const int s = half * 4 + s4;
                u32x4 pw; pw.x = pk2(lg[2 * s][0], lg[2 * s][1]); pw.y = pk2(lg[2 * s][2], lg[2 * s][3]); pw.z = pk2(lg[2 * s + 1][0], lg[2 * s + 1][1]); pw.w = pk2(lg[2 * s + 1][2], lg[2 * s + 1][3]);
                const bf16x8 pa = __builtin_bit_cast(bf16x8, pw);
                const unsigned ad = vs_base + (unsigned)((32 * s4 + 8 * g4 + (r16 >> 2)) * 128 + (r16 & 3) * 8);
                u32x2 t0[4], t1[4];
                asm volatile("ds_read_b64_tr_b16 %0, %8\n\tds_read_b64_tr_b16 %1, %8 offset:512\n\tds_read_b64_tr_b16 %2, %8 offset:32\n\tds_read_b64_tr_b16 %3, %8 offset:544\n\t"
                             "ds_read_b64_tr_b16 %4, %8 offset:64\n\tds_read_b64_tr_b16 %5, %8 offset:576\n\tds_read_b64_tr_b16 %6, %8 offset:96\n\tds_read_b64_tr_b16 %7, %8 offset:608\n\ts_waitcnt lgkmcnt(0)"
                             : "=&v"(t0[0]), "=&v"(t1[0]), "=&v"(t0[1]), "=&v"(t1[1]), "=&v"(t0[2]), "=&v"(t1[2]), "=&v"(t0[3]), "=&v"(t1[3]) : "v"(ad) : "memory");
#pragma unroll
                for (int nt = 0; nt < 4; ++nt) { const bf16x8 vb = __builtin_bit_cast(bf16x8, (u32x4){t0[nt].x, t0[nt].y, t1[nt].x, t1[nt].y});
                    ov[nt] = __builtin_amdgcn_mfma_f32_16x16x32_bf16(pa, vb, ov[nt], 0, 0, 0); } }
        }
    }
    { float inv[4];
#pragma unroll
      for (int h = 0; h < 4; ++h) inv[h] = 1.0f / __int_as_float(__builtin_amdgcn_readlane(__float_as_int(sm), h));
      if (lane < 16) { bf16_t* Y = (bf16_t*)(F.ws + WS_H) + (T0 + qi) * DM + 512 + r16;
#pragma unroll
          for (int h = 0; h < 4; ++h)
#pragma unroll
              for (int nt = 0; nt < 4; ++nt) Y[h * 64 + 16 * nt] = f2bf(ov[nt][h] * inv[h]); } }
}

__device__ __forceinline__ void phase_router(const Frame& F_, int layer) { Frame F = relocal(F_); const int cset = layer;
    const float* X = (const float*)(F.ws + WS_X);
    const bf16_t* WH = (const bf16_t*)(F.ws + WS_WRT) + (size_t)layer * 2 * 49152; const bf16_t* WL = WH + 49152;
    LAS float* part = (LAS float*)F.lds;
    LAS float* ssq = (LAS float*)(F.lds + 24576);
    LAS int* es = (LAS int*)(F.lds + 25088);
    LAS int* lr = (LAS int*)(F.lds + 25600);
    LAS float* wsl = (LAS float*)(F.lds + 26112);
    LAS float* rsd = (LAS float*)(F.lds + 26624);
    for (int blk = F.bid; blk < NTOK / 64; blk += F.G) {
        __syncthreads();
        const int mt = F.wave & 3, kh = F.wave >> 2, r16 = F.lane & 15, g4 = F.lane >> 4;
        const float* xr = X + ((size_t)blk * 64 + mt * 16 + r16) * DM + kh * 512 + 8 * g4;
        f32x4 acc[3]; acc[0] = acc[1] = acc[2] = (f32x4){0.f, 0.f, 0.f, 0.f}; float ss = 0.f;
#pragma unroll 4
        for (int ks = 0; ks < 16; ++ks) {
            const f32x4 xa = *(const f32x4*)(xr + ks * 32), xb = *(const f32x4*)(xr + ks * 32 + 4);
            ss += xa[0] * xa[0] + xa[1] * xa[1] + xa[2] * xa[2] + xa[3] * xa[3] + xb[0] * xb[0] + xb[1] * xb[1] + xb[2] * xb[2] + xb[3] * xb[3];
            float xv[8] = {xa[0], xa[1], xa[2], xa[3], xb[0], xb[1], xb[2], xb[3]}; unsigned hw[4], lw[4];
#pragma unroll
            for (int j = 0; j < 4; ++j) { const bf16_t h0 = f2bf(xv[2 * j]), h1 = f2bf(xv[2 * j + 1]); hw[j] = (unsigned)h0 | ((unsigned)h1 << 16);
                lw[j] = pk2(xv[2 * j] - bf2f(h0), xv[2 * j + 1] - bf2f(h1)); }
            const bf16x8 ahi = __builtin_bit_cast(bf16x8, (u32x4){hw[0], hw[1], hw[2], hw[3]}), alo = __builtin_bit_cast(bf16x8, (u32x4){lw[0], lw[1], lw[2], lw[3]});
#pragma unroll
            for (int nt = 0; nt < 3; ++nt) { const size_t wo = (size_t)(nt * 16 + r16) * 1024 + kh * 512 + ks * 32 + 8 * g4;
                const bf16x8 bh = *(const bf16x8*)(WH + wo), bl = *(const bf16x8*)(WL + wo);
                acc[nt] = __builtin_amdgcn_mfma_f32_16x16x32_bf16(ahi, bh, acc[nt], 0, 0, 0);
                acc[nt] = __builtin_amdgcn_mfma_f32_16x16x32_bf16(ahi, bl, acc[nt], 0, 0, 0);
                acc[nt] = __builtin_amdgcn_mfma_f32_16x16x32_bf16(alo, bh, acc[nt], 0, 0, 0); }
        }
        ss += shx(ss, 16); ss += shx(ss, 32);
        if (g4 == 0) ssq[kh * 64 + mt * 16 + r16] = ss;
#pragma unroll
        for (int nt = 0; nt < 3; ++nt)
#pragma unroll
            for (int i = 0; i < 4; ++i) part[(kh * 64 + mt * 16 + 4 * g4 + i) * 48 + nt * 16 + r16] = acc[nt][i];
        __syncthreads();
        if (F.tid < 64) { const float rstd = rsqrtf((ssq[F.tid] + ssq[64 + F.tid]) * (1.0f / DM) + 1e-6f); rsd[F.tid] = rstd;
            float l[36];
#pragma unroll
            for (int o = 0; o < 36; ++o) l[o] = (part[F.tid * 48 + o] + part[(64 + F.tid) * 48 + o]) * rstd + (o < 32 ? F.in[I_BRE][layer * 32 + o] : F.in[I_BRG][layer * 4 + o - 32]);
            int gs = 0; float gm = l[32];
#pragma unroll
            for (int j = 1; j < 4; ++j) if (l[32 + j] > gm) { gm = l[32 + j]; gs = j; }
            float den = 0.f;
#pragma unroll
            for (int j = 0; j < 4; ++j) den += __expf(l[32 + j] - gm);
            const float gate = 1.0f / den;
            float e8[8];
#pragma unroll
            for (int j = 0; j < 8; ++j) e8[j] = gs == 0 ? l[j] : gs == 1 ? l[8 + j] : gs == 2 ? l[16 + j] : l[24 + j];
            int i1 = 0; float v1 = e8[0];
#pragma unroll
            for (int j = 1; j < 8; ++j) if (e8[j] > v1) { v1 = e8[j]; i1 = j; }
            int i2 = -1; float v2 = -INFINITY;
#pragma unroll
            for (int j = 0; j < 8; ++j) if (j != i1 && e8[j] > v2) { v2 = e8[j]; i2 = j; }
            const float e2 = __expf(v2 - v1); const float p1 = 1.0f / (1.0f + e2);
            es[F.tid * 2] = gs * 8 + i1; es[F.tid * 2 + 1] = gs * 8 + i2; wsl[F.tid * 2] = p1 * gate; wsl[F.tid * 2 + 1] = (1.0f - p1) * gate; }
        __syncthreads();
        if (F.tid < 32) { int cnt = 0; for (int i = 0; i < 128; ++i) if (es[i] == F.tid) lr[i] = cnt++;
            if (cnt) { const int base = (int)__hip_atomic_fetch_add(F.ctl + CW_CNT + cset * 32 + F.tid, (unsigned)cnt, __ATOMIC_RELAXED, __HIP_MEMORY_SCOPE_AGENT);
                for (int i = 0; i < 128; ++i) if (es[i] == F.tid) lr[i] += base; } }
        __syncthreads();
        if (F.tid < 64) { int* rt = (int*)(F.ws + WS_ROUTE) + ((size_t)blk * 64 + F.tid) * 8;
            rt[0] = es[F.tid * 2]; rt[1] = es[F.tid * 2 + 1]; ((float*)rt)[2] = wsl[F.tid * 2]; ((float*)rt)[3] = wsl[F.tid * 2 + 1]; rt[4] = lr[F.tid * 2]; rt[5] = lr[F.tid * 2 + 1]; ((float*)rt)[6] = rsd[F.tid]; }
    }
    __syncthreads();
    if (F.tid == 0) __hip_atomic_fetch_add(F.ctl + CW_RB + 64 * layer, 1u, __ATOMIC_RELAXED, __HIP_MEMORY_SCOPE_AGENT);
}
__device__ __forceinline__ void phase_moe_convert(const Frame& F_, int layer) { Frame F = relocal(F_);
    bf16_t* WGU = (bf16_t*)(F.ws + WS_MOE + MOE_WGU); bf16_t* WD = (bf16_t*)(F.ws + WS_MOE + MOE_WD);
    for (int t = F.bid; t < 1536; t += F.G) {
        if (t < 1024) { const int e = t >> 5, r = t & 31, kt = r >> 1, nt = r & 1; const size_t eo = ((size_t)layer * 32 + e) * 1024 * 256;
            tr_tile(F, 256, WGU + (size_t)e * 512 * 1024, 1024, kt * 64, nt * 256, SmGU{F.in[I_WGATE] + eo, F.in[I_WUP] + eo}); }
        else { const int q = t - 1024, e = q >> 4, r = q & 15, kt = r >> 2, nt = r & 3;
            tr_tile(F, 1024, WD + (size_t)e * 1024 * 256, 256, kt * 64, nt * 256, SmId{F.in[I_WDOWN] + ((size_t)layer * 32 + e) * 256 * 1024}); }
    }
}
__device__ __forceinline__ void phase_gather(const Frame& F_, int layer) { Frame F = relocal(F_);
    LAS int* off = (LAS int*)F.lds;
    __syncthreads();
    if (F.tid == 0) { unsigned sp = 0;
        while (__hip_atomic_load(F.ctl + CW_RB + 64 * layer, __ATOMIC_RELAXED, __HIP_MEMORY_SCOPE_AGENT) < (unsigned)F.G) { __builtin_amdgcn_s_sleep(2); if (++sp > (1u << 22)) break; } }
    __syncthreads();
    if (F.tid == 0) { int acc = 0; for (int e = 0; e < 32; ++e) { off[e] = acc; const int c = (int)__hip_atomic_load(F.ctl + CW_CNT + layer * 32 + e, __ATOMIC_RELAXED, __HIP_MEMORY_SCOPE_AGENT); acc += (c + 255) & ~255; } off[32] = acc; }
    __syncthreads();
    int* tiles = (int*)(F.ws + WS_TILES); int* row_tok = (int*)(F.ws + WS_ROWS); float* row_w = (float*)(F.ws + WS_ROWS) + MAXROWS;
    if (F.bid == 0) { if (F.tid == 0) tiles[0] = off[32] >> 8; if (F.tid < 33) tiles[1 + F.tid] = off[F.tid];
        if (F.tid < 32) for (int rt = off[F.tid] >> 8; rt < (off[F.tid + 1] >> 8); ++rt) tiles[64 + rt] = F.tid; }
    for (int e = F.bid; e < 32; e += F.G) { const int c = (int)__hip_atomic_load(F.ctl + CW_CNT + layer * 32 + e, __ATOMIC_RELAXED, __HIP_MEMORY_SCOPE_AGENT);
        for (int r = off[e] + c + F.tid; r < off[e + 1]; r += NTHR) { row_tok[r] = -1; row_w[r] = 0.f; } }
    const float* X = (const float*)(F.ws + WS_X); bf16_t* HP = (bf16_t*)(F.ws + WS_U); const float* nw = F.in[I_NORM2] + (size_t)layer * DM;
    f32x4 nwv[4];
#pragma unroll
    for (int j = 0; j < 4; ++j) nwv[j] = *(const f32x4*)(nw + 4 * F.lane + 256 * j);
    for (int blk = F.bid; blk < NTOK / 64; blk += F.G)
    for (int i4 = 0; i4 < 2; ++i4) {
        int p0[4], p1[4], tt[4]; float rstd[4], w0[4], w1[4]; f32x4 xv[4][4];
#pragma unroll
        for (int r = 0; r < 4; ++r) { const int t = blk * 64 + F.wave * 8 + 4 * i4 + r; tt[r] = t;
            const int* rt = (const int*)(F.ws + WS_ROUTE) + (size_t)t * 8; rstd[r] = ((const float*)rt)[6]; w0[r] = ((const float*)rt)[2]; w1[r] = ((const float*)rt)[3];
            p0[r] = off[rt[0]] + rt[4]; p1[r] = off[rt[1]] + rt[5];
#pragma unroll
            for (int j = 0; j < 4; ++j) xv[r][j] = *(const f32x4*)(X + (size_t)t * DM + 4 * F.lane + 256 * j); }
#pragma unroll
        for (int r = 0; r < 4; ++r) {
#pragma unroll
            for (int j = 0; j < 4; ++j) { const int c = 4 * F.lane + 256 * j; const f32x4 v = xv[r][j] * rstd[r] * nwv[j];
                u32x2 o; o.x = pk2(v[0], v[1]); o.y = pk2(v[2], v[3]);
                *(u32x2*)(HP + (size_t)p0[r] * DM + c) = o; *(u32x2*)(HP + (size_t)p1[r] * DM + c) = o; }
            if (F.lane == 0) { row_tok[p0[r]] = tt[r] * 2; row_w[p0[r]] = w0[r]; row_tok[p1[r]] = tt[r] * 2 + 1; row_w[p1[r]] = w1[r]; } }
    }
}

constexpr int NPH_LAYER = 9, NPHASE = 1 + 2 * NPH_LAYER + 1;
#ifndef MK_ONLY
#define MK_ONLY -1
#endif
#ifndef MK_ITEM
#define MK_ITEM -1
#endif
#define EN(o) (MK_ONLY < 0 || MK_ONLY == (o))
#define IT(o) (MK_ITEM < 0 || MK_ITEM == (o))
__global__ void __launch_bounds__(NTHR, 2) mk_forward(Params P) {
    extern __shared__ __attribute__((aligned(16))) unsigned char lds_raw[];
    Frame F; F.lds = (LAS unsigned char*)lds_raw; F.tid = threadIdx.x; F.lane = F.tid & 63; F.wave = __builtin_amdgcn_readfirstlane(F.tid >> 6); F.bid = blockIdx.x; F.G = gridDim.x;
    F.in = (in_tab_t)__builtin_amdgcn_kernarg_segment_ptr(); F.out = P.out; F.ws = P.ws; F.ctl = (unsigned*)(P.ws + WS_CTL); F.misc = (volatile LAS int*)(F.lds + MISC_OFF);
    if (F.tid < 64) ((LAS unsigned*)(F.lds + MISC_OFF))[F.tid] = 0u;
    __syncthreads();
    const int lo = P.ph_lo, hi = P.ph_hi;
    XcdBarrier bar; bar.bar = F.ctl + CW_BAR; bar.x = 0; bar.st = (volatile LAS unsigned*)(F.lds + MISC_OFF + 16);
    if (hi - lo > 1) bar = xcd_barrier_post(F.ctl + CW_BAR, (volatile LAS unsigned*)(F.lds + MISC_OFF + 16));
#define IN(k) (lo <= (k) && (k) < hi)
#define SEAM(k) do { if (IN(k) && IN((k) + 1)) xcd_barrier(bar); } while (0)
#define QLOOP(qi, n, body) for (;;) { const int it = q_pop(F, layer * 12 + (qi)); if (it >= (n)) break; body; }
    if (EN(100) && IN(0)) { phase_prologue(F); phase_norm(F, F.in[I_X], false, F.in[I_NORM1], 0); } SEAM(0);
#pragma unroll
    for (int layer = 0; layer < DEPTH; ++layer) {
        const int pb = 1 + layer * NPH_LAYER;
        if (layer > 0) { if (EN(0) && IN(pb + 0)) { phase_norm(F, (const float*)(F.ws + WS_X), true, F.in[I_NORM1] + (size_t)layer * DM, 0); } SEAM(pb + 0); }
        if (EN(1) && IN(pb + 1)) { const Frame F_ = F; Frame F = relocal(F_); pg8::StaticOrder S; S.init((const bf16_t*)(F.ws + WS_H), (const bf16_t*)(F.ws + WS_WIN) + (size_t)layer * NINP * DM, NTOK, NINP, DM, F.G, F.bid);
            pg8::EpiBf16 E{(bf16_t*)(F.ws + WS_U), NINP}; pg8::gemm_phase(F.lds, DM, S, E); } SEAM(pb + 1);
        if (EN(2) && IN(pb + 2)) {
            if (IT(0)) QLOOP(0, 256, item_s5<1>(F, layer, it));
            if (IT(1)) QLOOP(1, 1024, item_rwkv1(F, layer, it));
            if (IT(2)) QLOOP(2, 256, item_mamba<1>(F, layer, it));
            if (IT(3)) QLOOP(3, 256, item_kv(F, layer, it));
        } SEAM(pb + 2);
        if (EN(3) && IN(pb + 3)) {
            if (IT(0)) QLOOP(4, 8, item_rwkv_carry(F, it));
            if (IT(1)) QLOOP(5, 16, item_mamba_carry(F, it));
            if (IT(2)) QLOOP(6, 4, item_s5_carry(F, layer, it));
            if (IT(3)) {
                dsa_tables(F);
                const int pref = (int)(xb_xcc_id() & 3u);
#pragma unroll 1
                for (int k4 = 0; k4 < 4; ++k4) { const int bq = (pref + k4) & 3;
                    for (;;) { const int it = q_pop(F, 24 + layer * 4 + bq); if (it >= 512) break; item_dsa(F, layer, it * 4 + bq); } } }
        } SEAM(pb + 3);
        if (EN(4) && IN(pb + 4)) {
            if (IT(0)) QLOOP(8, 256, item_s5<2>(F, layer, it));
            if (IT(1)) QLOOP(9, 1024, item_rwkv3(F, layer, it));
            if (IT(2)) QLOOP(10, 256, item_mamba<2>(F, layer, it));
        } SEAM(pb + 4);
        if (EN(6) && IN(pb + 5)) { const Frame F_ = F; Frame F = relocal(F_); pg8::StaticOrder S; S.init((const bf16_t*)(F.ws + WS_H), (const bf16_t*)(F.ws + WS_WOUT) + (size_t)layer * DM * DM, NTOK, DM, DM, F.G, F.bid);
            pg8::EpiResid E{(float*)(F.ws + WS_X), DM}; pg8::gemm_phase(F.lds, DM, S, E); } SEAM(pb + 5);
        if (EN(7) && IN(pb + 6)) { phase_router(F, layer); phase_moe_convert(F, layer); phase_gather(F, layer); } SEAM(pb + 6);
        if (EN(8) && IN(pb + 7)) { const Frame F_ = F; Frame F = relocal(F_); pg8::MoeOrder S{2, F.G, F.bid, DM, (const char*)(F.ws + WS_U), (const char*)(F.ws + WS_MOE + MOE_WGU), (size_t)512 * 1024 * 2, (const int*)(F.ws + WS_TILES)};
            pg8::EpiGated<1> E{(bf16_t*)(F.ws + WS_H), 256, 0, nullptr, nullptr}; pg8::gemm_phase(F.lds, DM, S, E); } SEAM(pb + 7);
        if (EN(9) && IN(pb + 8)) { const Frame F_ = F; Frame F = relocal(F_); pg8::MoeOrder S{4, F.G, F.bid, 256, (const char*)(F.ws + WS_H), (const char*)(F.ws + WS_MOE + MOE_WD), (size_t)1024 * 256 * 2, (const int*)(F.ws + WS_TILES)};
            pg8::EpiMoeOut E{(bf16_t*)(F.ws + WS_U), (const int*)(F.ws + WS_ROWS), (const float*)(F.ws + WS_ROWS) + MAXROWS, F.lds}; pg8::gemm_phase(F.lds, 256, S, E); } SEAM(pb + 8);
    }
    if (EN(101) && IN(NPHASE - 1)) { phase_norm(F, (const float*)(F.ws + WS_X), true, F.in[I_FNORM], 2); }
#undef IN
#undef SEAM
}

#ifndef MK_SPLIT
#define MK_SPLIT 0
#endif
extern "C" void kernel_launch(void* const* d_in, const int* in_sizes, int n_in, void* d_out, int out_size, void* d_ws, size_t ws_size, hipStream_t stream) {
    static int grid = 0;
    if (grid == 0) {
        if (n_in != 44 || out_size != NTOK * DM || ws_size < WS_END) { fprintf(stderr, "kernel_launch: unexpected shapes (n_in %d out %d ws %zu need %zu)\n", n_in, out_size, ws_size, (size_t)WS_END); grid = -1; return; }
        int dev = 0, cus = 0;
        if (hipGetDevice(&dev) != hipSuccess || hipDeviceGetAttribute(&cus, hipDeviceAttributeMultiprocessorCount, dev) != hipSuccess) { grid = -1; return; }
        if (hipFuncSetAttribute((const void*)mk_forward, hipFuncAttributeMaxDynamicSharedMemorySize, LDS_BYTES) != hipSuccess) { fprintf(stderr, "kernel_launch: hipFuncSetAttribute failed\n"); grid = -1; return; }
        int per_cu = 0;
        if (hipOccupancyMaxActiveBlocksPerMultiprocessor(&per_cu, (const void*)mk_forward, NTHR, LDS_BYTES) != hipSuccess || per_cu < 1) { fprintf(stderr, "kernel_launch: occupancy query says %d\n", per_cu); }
        (void)hipGetLastError();
        grid = cus;
    }
    if (grid < 0) return;
    hipMemsetAsync((char*)d_ws + WS_CTL, 0, CTL_BYTES, stream);
    Params p{};
    for (int i = 0; i < 44; ++i) p.in[i] = (const float*)d_in[i];
    p.out = (float*)d_out; p.ws = (unsigned char*)d_ws;
#if MK_SPLIT
    for (int ph = 0; ph < NPHASE; ++ph) { p.ph_lo = ph; p.ph_hi = ph + 1; hipLaunchKernelGGL(mk_forward, dim3(grid), dim3(NTHR), LDS_BYTES, stream, p); }
#else
    p.ph_lo = 0; p.ph_hi = NPHASE; hipLaunchKernelGGL(mk_forward, dim3(grid), dim3(NTHR), LDS_BYTES, stream, p);
#endif
}
```

```cpp
#include <hip/hip_runtime.h>
#include <stdint.h>
#include <stdio.h>

#define LAS __attribute__((address_space(3)))
typedef unsigned short bf16_t;
typedef short bf16x8 __attribute__((ext_vector_type(8)));
typedef float f32x4 __attribute__((ext_vector_type(4)));
typedef float f32x2 __attribute__((ext_vector_type(2)));
typedef float f32x16 __attribute__((ext_vector_type(16)));
typedef unsigned u32x4 __attribute__((ext_vector_type(4)));
typedef unsigned u32x2 __attribute__((ext_vector_type(2)));

constexpr int NTOK = 16384, DM = 1024, SEQ = 4096, NBATCH = 4, DEPTH = 2;
constexpr int NIN = 2604, NINP = 2816;
constexpr int UM = 0;
constexpr int UR = 784;
constexpr int UC = 1680;
constexpr int US = 2368;
constexpr int NTHR = 512;
constexpr int LDS_BYTES = 163840;
constexpr int MISC_OFF = LDS_BYTES - 256;

constexpr size_t WS_CTL   = 0;
constexpr size_t CTL_BYTES = 65536;
constexpr size_t WS_X     = WS_CTL + CTL_BYTES;
constexpr size_t WS_H     = WS_X + (size_t)NTOK * DM * 4;
constexpr size_t WS_U     = WS_H + (size_t)NTOK * DM * 2;
constexpr size_t WS_WIN   = WS_U + (size_t)NTOK * NINP * 2;
constexpr size_t WS_WOUT  = WS_WIN + (size_t)2 * NINP * DM * 2;
constexpr size_t WS_GLU   = WS_WOUT + (size_t)2 * DM * DM * 2;
constexpr size_t WS_MOE   = WS_GLU + (size_t)2 * 512 * 256 * 2;
constexpr size_t MOE_WGU  = 0;
constexpr size_t MOE_WD   = (size_t)32 * 512 * 1024 * 2;
constexpr size_t MOE_BYTES = MOE_WD + (size_t)32 * 1024 * 256 * 2;
constexpr size_t RW_PT    = 0;
constexpr size_t RW_U     = (size_t)1024 * 4096 * 2;
constexpr size_t RW_S     = RW_U + (size_t)1024 * 4096 * 2;
constexpr size_t RW_W1    = RW_S + (size_t)1024 * 4096 * 2;
constexpr size_t RW_Z     = RW_W1 + (size_t)1024 * 4096 * 2;
constexpr size_t YSG_OFF  = RW_Z + (size_t)1024 * 4096 * 2;
static_assert(YSG_OFF + (size_t)NTOK * 256 * 2 <= MOE_BYTES, "alias");
constexpr size_t WS_MST   = WS_MOE + MOE_BYTES;
constexpr size_t WS_MDEC  = WS_MST + (size_t)4 * 64 * 4 * 4096 * 4;
constexpr size_t WS_S5ST  = WS_MDEC + 4096;
constexpr size_t WS_K     = WS_S5ST + (size_t)4 * 64 * 2048 * 4;
constexpr size_t WS_V     = WS_K + (size_t)NTOK * 64 * 2;
constexpr size_t WS_KIDX  = WS_V + (size_t)NTOK * 64 * 2;
constexpr size_t WS_ROUTE = WS_KIDX + (size_t)NTOK * 32 * 2;
constexpr size_t WS_ROWS  = WS_ROUTE + (size_t)NTOK * 32;
constexpr int    MAXROWS  = 49152;
constexpr size_t WS_TILES = WS_ROWS + (size_t)MAXROWS * 8;
constexpr size_t WS_S5TAB = WS_TILES + 4096;
constexpr size_t S5TAB_F  = (size_t)(2048 + 2048 + 32768) * 4;
constexpr size_t S5TAB_BBT = S5TAB_F + (size_t)16 * 16 * 128 * 2;
constexpr size_t S5TAB_L  = S5TAB_BBT + (size_t)16 * 128 * 16 * 2;
constexpr size_t WS_WRT   = WS_S5TAB + 2 * S5TAB_L;
constexpr size_t WS_BON   = WS_WRT + (size_t)2 * 2 * 48 * 1024 * 2;
constexpr size_t WS_END   = WS_BON + (size_t)1024 * 64 * 4;

constexpr int CW_BAR = 0;
constexpr int CW_Q   = 4096;
constexpr int CW_CNT = 8192;
constexpr int CW_RB  = 8448;

__device__ __forceinline__ float bf2f(bf16_t b) { return __uint_as_float(((unsigned)b) << 16); }
__device__ __forceinline__ bf16_t f2bf(float f) { const __bf16 h = (__bf16)f; return __builtin_bit_cast(bf16_t, h); }
__device__ __forceinline__ unsigned pk2(float lo, float hi) { typedef __bf16 bf2_t __attribute__((ext_vector_type(2))); const bf2_t h = __builtin_convertvector((f32x2){lo, hi}, bf2_t); return __builtin_bit_cast(unsigned, h); }
__device__ __forceinline__ unsigned cvt_pk_bf16(float lo, float hi) { unsigned r; asm volatile("v_cvt_pk_bf16_f32 %0, %1, %2" : "=v"(r) : "v"(lo), "v"(hi)); return r; }
__device__ __forceinline__ float sigmoidf_(float x) { return 1.0f / (1.0f + __expf(-x)); }
__device__ __forceinline__ float siluf_(float x) { return x / (1.0f + __expf(-x)); }
__device__ __forceinline__ float tanhf_(float x) { const float e = __expf(2.0f * x); return 1.0f - 2.0f / (e + 1.0f); }
__device__ __forceinline__ float softplusf_(float x) { return fmaxf(x, 0.0f) + log1pf(__expf(-fabsf(x))); }
__device__ __forceinline__ float gelu_tanh(float x) { return 0.5f * x * (1.0f + tanhf_(0.7978845608028654f * (x + 0.044715f * x * x * x))); }
template <int CTRL> __device__ __forceinline__ float dppf(float x) { return __int_as_float(__builtin_amdgcn_update_dpp(0, __float_as_int(x), CTRL, 0xF, 0xF, true)); }
__device__ __forceinline__ float sum4(float x) { x += dppf<0xB1>(x); x += dppf<0x4E>(x); return x; }
__device__ __forceinline__ float sum8(float x) { x = sum4(x); x += dppf<0x141>(x); return x; }
__device__ __forceinline__ float sum16(float x) { x = sum8(x); x += dppf<0x140>(x); return x; }
__device__ __forceinline__ int lane_id_() { int l = (int)__builtin_amdgcn_mbcnt_hi(~0u, __builtin_amdgcn_mbcnt_lo(~0u, 0u)); asm volatile("" : "+v"(l)); return l; }
__device__ __forceinline__ float shx(float x, int o) { return __int_as_float(__builtin_amdgcn_ds_bpermute((lane_id_() ^ o) << 2, __float_as_int(x))); }
__device__ __forceinline__ unsigned shdown_u(unsigned x, int o) { return (unsigned)__builtin_amdgcn_ds_bpermute(((lane_id_() + o) & 63) << 2, (int)x); }
__device__ __forceinline__ int shidx_i(int x, int src) { return __builtin_amdgcn_ds_bpermute(src << 2, x); }
__device__ __forceinline__ float wave_sum(float x) { x = sum16(x); x += shx(x, 16); x += shx(x, 32); return x; }
__device__ __forceinline__ void unpack8(const u32x4 v, float (&f)[8]) {
    f[0] = __uint_as_float(v.x << 16); f[1] = __uint_as_float(v.x & 0xffff0000u); f[2] = __uint_as_float(v.y << 16); f[3] = __uint_as_float(v.y & 0xffff0000u);
    f[4] = __uint_as_float(v.z << 16); f[5] = __uint_as_float(v.z & 0xffff0000u); f[6] = __uint_as_float(v.w << 16); f[7] = __uint_as_float(v.w & 0xffff0000u);
}

#define XB_TMO      128
#define XB_XCNT(j)  (256  + 64 * (j))
#define XB_XSUB(j)  (1280 + 64 * (j))
#define XB_XGEN(j)  (2304 + 64 * (j))
#define XB_TOP      3328
#define XB_TOPGEN   3392
#define XCD_BAR_WORDS 3456
#define XB_SPIN_CAP (1u << 22)
__device__ __forceinline__ unsigned xb_ld(unsigned* p)              { return __hip_atomic_load(p, __ATOMIC_RELAXED, __HIP_MEMORY_SCOPE_AGENT); }
__device__ __forceinline__ unsigned xb_add(unsigned* p, unsigned v) { return __hip_atomic_fetch_add(p, v, __ATOMIC_RELAXED, __HIP_MEMORY_SCOPE_AGENT); }
__device__ __forceinline__ unsigned xb_xcc_id() { return (unsigned)__builtin_amdgcn_s_getreg((3 << 11) | 20) & 0xFu; }
#define XB_SPIN(cond, bar) do { unsigned _sp = 0; while (cond) { __builtin_amdgcn_s_sleep(1); \
    if ((++_sp & 255u) == 0u) { if (xb_ld(&(bar)[XB_TMO])) break; if (_sp > XB_SPIN_CAP) { atomicAdd(&(bar)[XB_TMO], 1u); break; } } } } while (0)
struct XcdBarrier { unsigned* bar; unsigned x; volatile LAS unsigned* st; };
__device__ __forceinline__ XcdBarrier xcd_barrier_post(unsigned* bar, volatile LAS unsigned* st) {
    XcdBarrier b; b.bar = bar; b.x = xb_xcc_id(); b.st = st;
    if (threadIdx.x == 0) (void)xb_add(&bar[XB_XCNT(b.x)], 1u);
    return b;
}
__device__ __forceinline__ void xcd_barrier_complete(unsigned* bar, unsigned x, unsigned& nloc, unsigned& nx) {
    const unsigned G = gridDim.x * gridDim.y * gridDim.z;
    unsigned sum, cnt, mine, sp = 0u;
    for (;;) {
        sum = 0u; cnt = 0u; mine = 0u;
#pragma unroll
        for (unsigned j = 0; j < 16; ++j) { const unsigned c = xb_ld(&bar[XB_XCNT(j)]); sum += c; cnt += (c > 0u) ? 1u : 0u; mine = (j == x) ? c : mine; }
        if (sum == G) break;
        __builtin_amdgcn_s_sleep(1);
        if ((++sp & 255u) == 0u) { if (xb_ld(&bar[XB_TMO])) break; if (sp > XB_SPIN_CAP) { atomicAdd(&bar[XB_TMO], 1u); break; } }
    }
    nloc = mine > 0u ? mine : 1u; nx = cnt > 0u ? cnt : 1u;
}
__device__ __forceinline__ void xcd_barrier(const XcdBarrier& b_) {
    XcdBarrier b = b_; { const unsigned long long v = (unsigned long long)b.bar; unsigned lo = __builtin_amdgcn_readfirstlane((unsigned)v), hi = __builtin_amdgcn_readfirstlane((unsigned)(v >> 32)); asm volatile("" : "+s"(lo), "+s"(hi)); b.bar = (unsigned*)(((unsigned long long)hi << 32) | lo); unsigned xx = __builtin_amdgcn_readfirstlane(b.x); asm volatile("" : "+s"(xx)); b.x = xx; }
    asm volatile("s_waitcnt vmcnt(0)" ::: "memory");
    __syncthreads();
    if (threadIdx.x == 0) {
        unsigned* bar = b.bar;
        __builtin_amdgcn_s_waitcnt(0);
        unsigned nloc = b.st[0], nx = b.st[1];
        if (nloc == 0u) { xcd_barrier_complete(bar, b.x, nloc, nx); b.st[0] = nloc; b.st[1] = nx; }
        const unsigned old = xb_add(&bar[XB_XSUB(b.x)], 1u);
        const unsigned gen = old / nloc;
        if (old + 1u == (gen + 1u) * nloc) {
            __builtin_amdgcn_fence(__ATOMIC_RELEASE, "agent");
            asm volatile("s_waitcnt vmcnt(0)" ::: "memory");
            const unsigned og = xb_add(&bar[XB_TOP], 1u);
            const unsigned tg = og / nx;
            if (og + 1u == (tg + 1u) * nx) xb_add(&bar[XB_TOPGEN], 1u);
            else XB_SPIN(xb_ld(&bar[XB_TOPGEN]) == tg, bar);
            __builtin_amdgcn_fence(__ATOMIC_ACQUIRE, "agent");
            xb_add(&bar[XB_XGEN(b.x)], 1u);
            asm volatile("s_waitcnt vmcnt(0)" ::: "memory");
        } else {
            XB_SPIN(xb_ld(&bar[XB_XGEN(b.x)]) == gen, bar);
            __builtin_amdgcn_fence(__ATOMIC_ACQUIRE, "agent");
            asm volatile("s_waitcnt vmcnt(0)" ::: "memory");
        }
    }
    __syncthreads();
}

namespace pg8 {
constexpr int BM = 256, BK = 64, HALF = 128, HTB = HALF * BK * 2, STAGE_BYTES = 8 * HTB, NXCD = 8, WGM = 8;
__host__ __device__ __forceinline__ int lds_byte(int r, int c) { const int st = (r >> 4) * 2 + (c >> 5), rr = r & 15, cc = c & 31, ob = rr * 64 + cc * 2; return st * 1024 + (ob ^ (((ob >> 9) & 1) << 5)); }
__host__ __device__ __forceinline__ void stage_rc(int b, int& R, int& C) { const int st = b / 1024, sb = b % 1024, swz = sb ^ (((sb >> 9) & 1) << 5); R = (st >> 1) * 16 + swz / 64; C = (st & 1) * 32 + (swz % 64) / 2; }
__host__ __device__ __forceinline__ int perm32(int rho) { const int n = rho >> 4, i = rho & 15; return 8 * (i >> 2) + 4 * n + (i & 3); }
struct Unit { int pm, pn; const char* a; const char* b; };

struct StaticOrder {
    int nM, nN, nwg, G, c, K; const char* A; const char* B;
    __device__ void init(const bf16_t* A_, const bf16_t* B_, int M, int N, int K_, int G_, int c_) { A = (const char*)A_; B = (const char*)B_; K = K_; nM = M / BM; nN = N / BM; nwg = nM * nN; G = G_; c = c_; }
    __device__ bool next(int i, Unit& u) const {
        const long L = (long)i * G + c; if (L >= nwg) return false;
        int wgid = (int)L; { const int q = nwg / NXCD, r = nwg % NXCD, xcd = wgid % NXCD, off = wgid / NXCD; wgid = (xcd < r ? xcd * (q + 1) : r * (q + 1) + (xcd - r) * q) + off; }
        const int nig = WGM * nN, gid = wgid / nig, fm = gid * WGM, gsz = (nM - fm) < WGM ? (nM - fm) : WGM;
        u.pm = fm + ((wgid % nig) % gsz); u.pn = (wgid % nig) / gsz;
        u.a = A + (size_t)u.pm * 256 * K * 2; u.b = B + (size_t)u.pn * 256 * K * 2; return true;
    }
};

template <class Epi, class Sched>
__device__ __forceinline__ void gemm_phase(LAS unsigned char* lds, const int K_, const Sched& S, const Epi& E) {
    int K = K_; asm volatile("" : "+s"(K));
    int tid_ = threadIdx.x; asm volatile("" : "+v"(tid_));
    const int tid = tid_, wid = __builtin_amdgcn_readfirstlane(tid >> 6), lane = tid & 63, wr = wid >> 2, wc = wid & 3, fr = lane & 15, fq = lane >> 4;
    const int nt = K / BK;
    unsigned voffA[2], voffB[2];
#pragma unroll
    for (int i = 0; i < 2; ++i) { int R, C; stage_rc(tid * 16 + i * 8192, R, C); const int Rb = Epi::PERM ? ((R & ~31) + perm32(R & 31)) : R;
        voffA[i] = (unsigned)(R * K + C) * 2u; voffB[i] = (unsigned)(Rb * K + C) * 2u; }
    const size_t kstep = (size_t)(BK * 2);
    const size_t hstep = (size_t)HALF * K * 2;
    const unsigned ldsw = (unsigned)wid * 1024u;
    const int aoff = lds_byte(wr * 64 + fr, fq * 8), boff = lds_byte(wc * 32 + fr, fq * 8);
#define PG8_SA(b, h) (((b) * 2 + (h)) * HTB)
#define PG8_SB(b, h) ((4 + (b) * 2 + (h)) * HTB)
#define PG8_STAGE(bufoff, gbase, voff) do { _Pragma("unroll") for (int _i = 0; _i < 2; ++_i) \
        __builtin_amdgcn_global_load_lds((const unsigned*)((const char*)(gbase) + (voff)[_i]), (LAS unsigned*)(lds + (bufoff) + ldsw + _i * 8192), 16, 0, 0); } while (0)
#define PG8_LDA(dst, b, h) do { _Pragma("unroll") for (int m = 0; m < 4; ++m) _Pragma("unroll") for (int k = 0; k < 2; ++k) dst[m][k] = *(const LAS bf16x8*)(lds + PG8_SA(b, h) + aoff + m * 2048 + k * 1024); } while (0)
#define PG8_LDB(dst, b, h) do { _Pragma("unroll") for (int n = 0; n < 2; ++n) _Pragma("unroll") for (int k = 0; k < 2; ++k) dst[n][k] = *(const LAS bf16x8*)(lds + PG8_SB(b, h) + boff + n * 2048 + k * 1024); } while (0)
#define PG8_MMA(ai, bj, At, Bt) do { __builtin_amdgcn_s_setprio(1); _Pragma("unroll") for (int m = 0; m < 4; ++m) _Pragma("unroll") for (int n = 0; n < 2; ++n) _Pragma("unroll") for (int k = 0; k < 2; ++k) \
        acc[ai][bj][m][n] = __builtin_amdgcn_mfma_f32_16x16x32_bf16(Bt[n][k], At[m][k], acc[ai][bj][m][n], 0, 0, 0); __builtin_amdgcn_s_setprio(0); } while (0)
#define PG8_WAIT_V(n) asm volatile("s_waitcnt vmcnt(" #n ")" ::: "memory")
#define PG8_WAIT_L(n) asm volatile("s_waitcnt lgkmcnt(" #n ")" ::: "memory")
#define PG8_BAR __builtin_amdgcn_s_barrier()
#define PG8_SCHED __builtin_amdgcn_sched_barrier(0)
    Unit cur, nxt; int ui = 0;
    if (!S.next(0, cur)) return;
    f32x4 acc[2][2][4][2];
#pragma unroll
    for (int a = 0; a < 2; ++a)
#pragma unroll
        for (int b = 0; b < 2; ++b)
#pragma unroll
            for (int m = 0; m < 4; ++m)
#pragma unroll
                for (int n = 0; n < 2; ++n) acc[a][b][m][n] = (f32x4){0.f, 0.f, 0.f, 0.f};
    bf16x8 At[4][2], B0[2][2], B1[2][2];
    const char* cA = cur.a; const char* cB = cur.b;
    PG8_STAGE(PG8_SB(0, 0), cB, voffB); PG8_STAGE(PG8_SA(0, 0), cA, voffA); PG8_STAGE(PG8_SB(0, 1), cB + hstep, voffB); PG8_STAGE(PG8_SA(0, 1), cA + hstep, voffA);
    if (wr == 1) PG8_BAR;
    PG8_WAIT_V(4); PG8_BAR;
    PG8_STAGE(PG8_SB(1, 0), cB + kstep, voffB); PG8_STAGE(PG8_SA(1, 0), cA + kstep, voffA); PG8_STAGE(PG8_SB(1, 1), cB + hstep + kstep, voffB);
    PG8_WAIT_V(6); PG8_BAR;
    for (;;) {
        const bool has_next = S.next(ui + 1, nxt);
        const char* nA = has_next ? nxt.a : cA; const char* nB = has_next ? nxt.b : cB;
        for (int t = 0; t < nt; t += 2) {
            const bool last = (t == nt - 2);
            const char* a1 = cA + (size_t)(t + 1) * kstep;
            const char* a2 = last ? nA : cA + (size_t)(t + 2) * kstep; const char* b2 = last ? nB : cB + (size_t)(t + 2) * kstep;
            const char* a3 = a2 + kstep; const char* b3 = b2 + kstep;
            PG8_LDB(B0, 0, 0); PG8_SCHED; PG8_LDA(At, 0, 0); PG8_STAGE(PG8_SA(1, 1), a1 + hstep, voffA);
            PG8_WAIT_L(8); PG8_BAR; PG8_WAIT_L(0); PG8_MMA(0, 0, At, B0); PG8_BAR; PG8_SCHED;
            PG8_LDB(B1, 0, 1); PG8_STAGE(PG8_SB(0, 0), b2, voffB);
            PG8_BAR; PG8_WAIT_L(0); PG8_MMA(0, 1, At, B1); PG8_BAR;
            PG8_LDA(At, 0, 1); PG8_STAGE(PG8_SA(0, 0), a2, voffA);
            PG8_BAR; PG8_WAIT_L(0); PG8_MMA(1, 0, At, B0); PG8_BAR; PG8_SCHED;
            PG8_STAGE(PG8_SB(0, 1), b2 + hstep, voffB);
            PG8_WAIT_V(6); PG8_BAR; PG8_MMA(1, 1, At, B1); PG8_BAR;
            PG8_LDB(B0, 1, 0); PG8_SCHED; PG8_LDA(At, 1, 0); PG8_STAGE(PG8_SA(0, 1), a2 + hstep, voffA);
            PG8_WAIT_L(8); PG8_BAR; PG8_WAIT_L(0); PG8_MMA(0, 0, At, B0); PG8_BAR; PG8_SCHED;
            PG8_LDB(B1, 1, 1); PG8_STAGE(PG8_SB(1, 0), b3, voffB);
            PG8_BAR; PG8_WAIT_L(0); PG8_MMA(0, 1, At, B1); PG8_BAR;
            PG8_LDA(At, 1, 1); PG8_STAGE(PG8_SA(1, 0), a3, voffA);
            PG8_BAR; PG8_WAIT_L(0); PG8_MMA(1, 0, At, B0); PG8_BAR; PG8_SCHED;
            PG8_STAGE(PG8_SB(1, 1), b3 + hstep, voffB);
            PG8_WAIT_V(6); PG8_BAR; PG8_MMA(1, 1, At, B1); PG8_BAR;
        }
        E(acc, cur, wr, wc, fr, fq);
        if (!has_next) break;
#pragma unroll
        for (int a = 0; a < 2; ++a)
#pragma unroll
            for (int b = 0; b < 2; ++b)
#pragma unroll
                for (int m = 0; m < 4; ++m)
#pragma unroll
                    for (int n = 0; n < 2; ++n) acc[a][b][m][n] = (f32x4){0.f, 0.f, 0.f, 0.f};
        cur = nxt; cA = nA; cB = nB; ++ui;
    }
    PG8_WAIT_V(0);
    if (wr == 0) PG8_BAR;
    PG8_BAR;
#undef PG8_SA
#undef PG8_SB
#undef PG8_STAGE
#undef PG8_LDA
#undef PG8_LDB
#undef PG8_MMA
#undef PG8_WAIT_V
#undef PG8_WAIT_L
#undef PG8_BAR
#undef PG8_SCHED
}

struct EpiBf16 {
    static constexpr bool PERM = true;
    bf16_t* O; int ldc;
    __device__ __forceinline__ void operator()(const f32x4 (&acc)[2][2][4][2], const Unit& u, int wr, int wc, int fr, int fq) const {
        const int row0 = u.pm * BM + wr * 64 + fr, col0 = u.pn * BM + wc * 32 + 8 * fq;
#pragma unroll
        for (int ai = 0; ai < 2; ++ai)
#pragma unroll
            for (int m = 0; m < 4; ++m) { bf16_t* rowp = O + (size_t)(row0 + ai * HALF + m * 16) * ldc + col0;
#pragma unroll
                for (int bj = 0; bj < 2; ++bj) { const f32x4 v0 = acc[ai][bj][m][0], v1 = acc[ai][bj][m][1];
                    u32x4 w; w.x = cvt_pk_bf16(v0[0], v0[1]); w.y = cvt_pk_bf16(v0[2], v0[3]); w.z = cvt_pk_bf16(v1[0], v1[1]); w.w = cvt_pk_bf16(v1[2], v1[3]);
                    *(u32x4*)(rowp + bj * HALF) = w; } }
    }
};
struct EpiResid {
    static constexpr bool PERM = false;
    float* C; int ldc;
    __device__ __forceinline__ void operator()(const f32x4 (&acc)[2][2][4][2], const Unit& u, int wr, int wc, int fr_, int fq_) const {
        int fr = fr_, fq = fq_; asm volatile("" : "+v"(fr), "+v"(fq));
        const int row0 = u.pm * BM + wr * 64 + fr, col0 = u.pn * BM + wc * 32 + 4 * fq;
#pragma unroll
        for (int ai = 0; ai < 2; ++ai)
#pragma unroll
            for (int mp = 0; mp < 2; ++mp) { f32x4 cv[2][2][2];
#pragma unroll
                for (int mm = 0; mm < 2; ++mm) { const float* rowp = C + (size_t)(row0 + ai * HALF + (2 * mp + mm) * 16) * ldc + col0;
#pragma unroll
                    for (int bj = 0; bj < 2; ++bj)
#pragma unroll
                        for (int n = 0; n < 2; ++n) cv[mm][bj][n] = *(const f32x4*)(rowp + bj * HALF + n * 16); }
#pragma unroll
                for (int mm = 0; mm < 2; ++mm) { float* rowp = C + (size_t)(row0 + ai * HALF + (2 * mp + mm) * 16) * ldc + col0;
#pragma unroll
                    for (int bj = 0; bj < 2; ++bj)
#pragma unroll
                        for (int n = 0; n < 2; ++n) *(f32x4*)(rowp + bj * HALF + n * 16) = cv[mm][bj][n] + acc[ai][bj][2 * mp + mm][n]; }
                asm volatile("" ::: "memory"); }
    }
};
template <int ACT  > struct EpiGated {
    static constexpr bool PERM = true;
    bf16_t* O; int ldo; int coloff; const float* ba; const float* bb;
    __device__ __forceinline__ void operator()(const f32x4 (&acc)[2][2][4][2], const Unit& u, int wr, int wc, int fr, int fq) const {
        const int row0 = u.pm * BM + wr * 64 + fr, cl = u.pn * HALF + wc * 32 + 8 * fq;
        float va[8], vb[8];
#pragma unroll
        for (int j = 0; j < 8; ++j) { va[j] = (ACT == 0) ? ba[cl + j] : 0.f; vb[j] = (ACT == 0) ? bb[cl + j] : 0.f; }
#pragma unroll
        for (int ai = 0; ai < 2; ++ai)
#pragma unroll
            for (int m = 0; m < 4; ++m) { bf16_t* rowp = O + (size_t)(row0 + ai * HALF + m * 16) * ldo + coloff + cl;
                float o[8];
#pragma unroll
                for (int n = 0; n < 2; ++n)
#pragma unroll
                    for (int j = 0; j < 4; ++j) { const float a = acc[ai][0][m][n][j] + va[4 * n + j], b = acc[ai][1][m][n][j] + vb[4 * n + j];
                        o[4 * n + j] = (ACT == 0) ? a * sigmoidf_(b) : siluf_(a) * b; }
                u32x4 w; w.x = cvt_pk_bf16(o[0], o[1]); w.y = cvt_pk_bf16(o[2], o[3]); w.z = cvt_pk_bf16(o[4], o[5]); w.w = cvt_pk_bf16(o[6], o[7]);
                *(u32x4*)rowp = w; asm volatile("" ::: "memory"); }
    }
};
struct EpiMoeOut {
    static constexpr bool PERM = true;
    bf16_t* O; const int* row_tok; const float* row_w; LAS unsigned char* lds;
    __device__ __forceinline__ void operator()(const f32x4 (&acc)[2][2][4][2], const Unit& u, int wr, int wc, int fr_, int fq_) const {
        int fr = fr_, fq = fq_; asm volatile("" : "+v"(fr), "+v"(fq));
        const int col0 = u.pn * BM + wc * 32 + 8 * fq, lane = fq * 16 + fr;
        LAS u32x2* rinfo = (LAS u32x2*)(lds + STAGE_BYTES) + (wr * 4 + wc) * 128;
        { const int ra = u.pm * BM + wr * 64 + lane, rb = ra + HALF;
          const u32x2 ia = (u32x2){(unsigned)row_tok[ra], __float_as_uint(row_w[ra])}, ib = (u32x2){(unsigned)row_tok[rb], __float_as_uint(row_w[rb])};
          rinfo[lane] = ia; rinfo[64 + lane] = ib; }
#pragma unroll
        for (int ai = 0; ai < 2; ++ai)
#pragma unroll
            for (int m = 0; m < 4; ++m) { const u32x2 inf = rinfo[ai * 64 + m * 16 + fr]; const int ts = (int)inf.x; const float w = __uint_as_float(inf.y);
                if (ts >= 0) { bf16_t* rowp = O + ((size_t)(ts & 1) * NTOK + (size_t)(ts >> 1)) * DM + col0;
#pragma unroll
                    for (int bj = 0; bj < 2; ++bj) { const f32x4 v0 = acc[ai][bj][m][0] * w, v1 = acc[ai][bj][m][1] * w;
                        u32x4 q; q.x = cvt_pk_bf16(v0[0], v0[1]); q.y = cvt_pk_bf16(v0[2], v0[3]); q.z = cvt_pk_bf16(v1[0], v1[1]); q.w = cvt_pk_bf16(v1[2], v1[3]);
                        *(u32x4*)(rowp + bj * HALF) = q; } } }
    }
};
struct MoeOrder {
    int nN, G, c, K; const char* A; const char* B; size_t bstride; const int* tiles;
    __device__ bool next(int i, Unit& u) const {
        const int nrt = tiles[0]; const long L = (long)i * G + c; if (L >= (long)nrt * nN) return false;
        u.pm = (int)(L / nN); u.pn = (int)(L % nN); const int e = tiles[64 + u.pm];
        u.a = A + (size_t)u.pm * 256 * K * 2; u.b = B + (size_t)e * bstride + (size_t)u.pn * 256 * K * 2; return true;
    }
};
}

struct Params { const float* in[44]; float* out; unsigned char* ws; int ph_lo, ph_hi; };
enum { I_X = 0, I_NORM1, I_WIN, I_MCONVW, I_MCONVB, I_MDTB, I_MALOG, I_MD, I_MNORM, I_RMU, I_RW0, I_RW2, I_RA0, I_RA2, I_RG2, I_RKK, I_RKA, I_RRK, I_RLNW, I_RLNB,
       I_CKVN, I_CWUK, I_CWUV, I_RELB, I_SARE, I_SAIM, I_SBRE, I_SBIM, I_SCRE, I_SCIM, I_SD, I_SLOGDT, I_SGLUW, I_SGLUB, I_WOUT, I_NORM2, I_WRG, I_BRG, I_WRE, I_BRE,
       I_WGATE, I_WUP, I_WDOWN, I_FNORM };

typedef const float* const __attribute__((address_space(4)))* in_tab_t;
struct Frame {
    LAS unsigned char* lds; int tid, lane, wave, bid, G;
    in_tab_t in; float* out; unsigned char* ws; unsigned* ctl;
    volatile LAS int* misc;
};

__device__ __forceinline__ int q_pop(Frame& F, int qi) {
    __syncthreads();
    if (F.tid == 0) F.misc[0] = (int)__hip_atomic_fetch_add(F.ctl + CW_Q + 64 * qi, 1u, __ATOMIC_RELAXED, __HIP_MEMORY_SCOPE_AGENT);
    __syncthreads();
    return F.misc[0];
}

__device__ __forceinline__ const void* opaque_ptr(const void* p) { const unsigned long long v = (unsigned long long)p; unsigned lo = __builtin_amdgcn_readfirstlane((unsigned)v), hi = __builtin_amdgcn_readfirstlane((unsigned)(v >> 32));
    asm volatile("" : "+s"(lo), "+s"(hi)); return (const void*)(((unsigned long long)hi << 32) | lo); }
__device__ __forceinline__ Frame relocal(const Frame& G) { Frame F = G; asm volatile("" : "+v"(F.tid)); F.ws = (unsigned char*)opaque_ptr(F.ws); F.ctl = (unsigned*)(F.ws + WS_CTL); F.in = (in_tab_t)(unsigned long long)opaque_ptr((const void*)(unsigned long long)F.in); F.lane = F.tid & 63; F.wave = __builtin_amdgcn_readfirstlane(F.tid >> 6); return F; }
template <int K> __device__ __forceinline__ f32x4 mma_nt(const LAS bf16_t* A, int lda, const LAS bf16_t* Bt, int ldb, f32x4 acc, int lane) {
    const int r = lane & 15, g = lane >> 4;
#pragma unroll
    for (int k0 = 0; k0 < K; k0 += 32) {
        const bf16x8 a = *(const LAS bf16x8*)(A + r * lda + k0 + 8 * g);
        const bf16x8 b = *(const LAS bf16x8*)(Bt + r * ldb + k0 + 8 * g);
        acc = __builtin_amdgcn_mfma_f32_16x16x32_bf16(a, b, acc, 0, 0, 0);
    }
    return acc;
}

template <class SrcMap> __device__ __forceinline__ void tr_tile(Frame& F, int ldsrc, bf16_t* dst, int K, int k0, int n0, SrcMap sm) {
    LAS float* tile = (LAS float*)F.lds;
    __syncthreads();
    { const int n4 = (F.tid & 63) * 4, kk = F.tid >> 6; const float* sp = sm(n0 + n4);
      f32x4 v[8];
#pragma unroll
      for (int ps = 0; ps < 8; ++ps) { v[ps] = (f32x4){0.f, 0.f, 0.f, 0.f}; if (sp) v[ps] = *(const f32x4*)(sp + (size_t)(k0 + kk + 8 * ps) * ldsrc); }
#pragma unroll
      for (int ps = 0; ps < 8; ++ps) { LAS float* t = tile + (kk + 8 * ps) * 257 + n4; t[0] = v[ps][0]; t[1] = v[ps][1]; t[2] = v[ps][2]; t[3] = v[ps][3]; } }
    __syncthreads();
    { const int kc = F.tid & 7;
#pragma unroll
      for (int j = 0; j < 4; ++j) { const int n = (F.tid >> 3) + 64 * j; float f[8];
#pragma unroll
          for (int i = 0; i < 8; ++i) f[i] = tile[(8 * kc + i) * 257 + n];
          u32x4 w; w.x = pk2(f[0], f[1]); w.y = pk2(f[2], f[3]); w.z = pk2(f[4], f[5]); w.w = pk2(f[6], f[7]);
          *(u32x4*)(dst + (size_t)(n0 + n) * K + k0 + 8 * kc) = w; } }
}

struct SmIn { const float* base; __device__ __forceinline__ const float* operator()(int n) const {
    int c; if (n < 772) c = n; else if (n < UR) return nullptr; else if (n < UR + 896) c = 772 + (n - UR); else if (n < UC) return nullptr;
    else if (n < UC + 680) c = 1668 + (n - UC); else if (n < US) return nullptr; else if (n < US + 256) c = 2348 + (n - US); else return nullptr; return base + c; } };
struct SmId { const float* base; __device__ __forceinline__ const float* operator()(int n) const { return base + n; } };
struct SmGlu { const float* base; __device__ __forceinline__ const float* operator()(int n) const { const int pn = n >> 8, rr = n & 255; return base + (rr < 128 ? 128 * pn + rr : 256 + 128 * pn + (rr - 128)); } };
struct SmGU { const float* gate; const float* up; __device__ __forceinline__ const float* operator()(int n) const {
    const unsigned long long d = (unsigned long long)up - (unsigned long long)gate; const unsigned long long a = (unsigned long long)gate + (((n & 255) < 128) ? 0ull : d); return (const float*)a + 128 * (n >> 8) + (n & 127); } };
__device__ __forceinline__ void phase_prologue(const Frame& F_) { Frame F = relocal(F_);
    for (int t = F.bid; t < 496; t += F.G) {
        if (t < 352) { const int l = t / 176, r = t % 176, kt = r / 11, nt = r % 11;
            tr_tile(F, NIN, (bf16_t*)(F.ws + WS_WIN) + (size_t)l * NINP * DM, DM, kt * 64, nt * 256, SmIn{F.in[I_WIN] + (size_t)l * DM * NIN}); }
        else if (t < 480) { const int q = t - 352, l = q / 64, r = q % 64, kt = r / 4, nt = r % 4;
            tr_tile(F, DM, (bf16_t*)(F.ws + WS_WOUT) + (size_t)l * DM * DM, DM, kt * 64, nt * 256, SmId{F.in[I_WOUT] + (size_t)l * DM * DM}); }
        else { const int q = t - 480, l = q / 8, r = q % 8, kt = r / 2, nt = r % 2;
            tr_tile(F, 512, (bf16_t*)(F.ws + WS_GLU) + (size_t)l * 512 * 256, 256, kt * 64, nt * 256, SmGlu{F.in[I_SGLUW] + (size_t)l * 256 * 512}); }
    }
    for (int i = F.bid * NTHR + F.tid; i < 2 * 48 * 1024; i += F.G * NTHR) { const int l = i / 49152, r = i % 49152, o = r >> 10, k = r & 1023;
        float v = 0.f; if (o < 32) v = F.in[I_WRE][((size_t)l * DM + k) * 32 + o]; else if (o < 36) v = F.in[I_WRG][((size_t)l * DM + k) * 4 + (o - 32)];
        v *= F.in[I_NORM2][l * DM + k];
        const bf16_t hi = f2bf(v); const bf16_t lo = f2bf(v - bf2f(hi));
        bf16_t* w = (bf16_t*)(F.ws + WS_WRT) + (size_t)l * 2 * 49152; w[r] = hi; w[49152 + r] = lo; }
    for (int i = F.bid * NTHR + F.tid; i < 2048 + 65536; i += F.G * NTHR) {
        if (i < 2048) {
            const int l = i >> 10, gn = i & 1023, g = gn >> 6;
            float* tab = (float*)(F.ws + WS_S5TAB + (size_t)l * S5TAB_L);
            const float lre = fminf(F.in[I_SARE][l * 1024 + gn], -1e-4f), lim = F.in[I_SAIM][l * 1024 + gn];
            const float dt = expf(F.in[I_SLOGDT][l * 16 + g]);
            const float mag = expf(dt * lre); float sn, cs; sincosf(dt * lim, &sn, &cs);
            const float are = mag * cs, aim = mag * sn;
            const float den = lre * lre + lim * lim;
            const float fre = ((are - 1.0f) * lre + aim * lim) / den, fim = (aim * lre - (are - 1.0f) * lim) / den;
            tab[gn * 2] = are; tab[gn * 2 + 1] = aim;
            float pr = are, pi = aim;
#pragma unroll
            for (int s = 0; s < 6; ++s) { const float nr = pr * pr - pi * pi, ni = 2.0f * pr * pi; pr = nr; pi = ni; }
            tab[2048 + gn * 2] = pr; tab[2048 + gn * 2 + 1] = pi;
            const float* bre = F.in[I_SBRE] + ((size_t)l * 1024 + gn) * 16; const float* bim = F.in[I_SBIM] + ((size_t)l * 1024 + gn) * 16;
            bf16_t* bbt = (bf16_t*)(F.ws + WS_S5TAB + (size_t)l * S5TAB_L + S5TAB_BBT); const int n = gn & 63, col = 4 * (n & 31) + 2 * (n >> 5);
            for (int p = 0; p < 16; ++p) { const float vr = fre * bre[p] - fim * bim[p], vi = fre * bim[p] + fim * bre[p];
                bbt[((size_t)g * 128 + col) * 16 + p] = f2bf(vr); bbt[((size_t)g * 128 + col + 1) * 16 + p] = f2bf(vi); }
        } else {
            const int j = i - 2048, l = j >> 15, r = j & 32767, gp = r >> 7, k = r & 127;
            bf16_t* cm = (bf16_t*)(F.ws + WS_S5TAB + (size_t)l * S5TAB_L + S5TAB_F);
            const int n = (k >> 2) + 32 * ((k >> 1) & 1);
            const float v = (k & 1) == 0 ? F.in[I_SCRE][((size_t)l * 256 + gp) * 64 + n] : -F.in[I_SCIM][((size_t)l * 256 + gp) * 64 + n];
            cm[r] = f2bf(v);
        }
    }
}

__device__ __forceinline__ void phase_norm(const Frame& F_, const float* xin, bool add_o, const float* w, int mode) { Frame F = relocal(F_);
    float* X = (float*)(F.ws + WS_X); bf16_t* H = (bf16_t*)(F.ws + WS_H); const bf16_t* O = (const bf16_t*)(F.ws + WS_U);
    for (int row0 = F.bid * 32 + F.wave * 4; row0 < NTOK; row0 += F.G * 32) {
        f32x4 v[4][4]; u32x2 oa[4][4], ob[4][4];
#pragma unroll
        for (int r = 0; r < 4; ++r)
#pragma unroll
            for (int j = 0; j < 4; ++j) { const int c = 4 * F.lane + 256 * j; const size_t o = (size_t)(row0 + r) * DM + c; v[r][j] = *(const f32x4*)(xin + o);
                if (add_o) { oa[r][j] = *(const u32x2*)(O + o); ob[r][j] = *(const u32x2*)(O + (size_t)NTOK * DM + o); } }
#pragma unroll
        for (int r = 0; r < 4; ++r) { const int row = row0 + r; float ss = 0.f;
#pragma unroll
            for (int j = 0; j < 4; ++j) {
                if (add_o) { const u32x2 a = oa[r][j], b = ob[r][j];
                    v[r][j][0] += __uint_as_float(a.x << 16) + __uint_as_float(b.x << 16); v[r][j][1] += __uint_as_float(a.x & 0xffff0000u) + __uint_as_float(b.x & 0xffff0000u);
                    v[r][j][2] += __uint_as_float(a.y << 16) + __uint_as_float(b.y << 16); v[r][j][3] += __uint_as_float(a.y & 0xffff0000u) + __uint_as_float(b.y & 0xffff0000u); }
                ss += v[r][j][0] * v[r][j][0] + v[r][j][1] * v[r][j][1] + v[r][j][2] * v[r][j][2] + v[r][j][3] * v[r][j][3]; }
            ss = wave_sum(ss);
            const float rstd = rsqrtf(ss * (1.0f / DM) + 1e-6f);
#pragma unroll
            for (int j = 0; j < 4; ++j) { const int c = 4 * F.lane + 256 * j; const f32x4 wv = *(const f32x4*)(w + c);
                if (mode == 2) { *(f32x4*)(F.out + (size_t)row * DM + c) = v[r][j] * rstd * wv; }
                else { *(f32x4*)(X + (size_t)row * DM + c) = v[r][j];
                    u32x2 o; o.x = pk2(v[r][j][0] * rstd * wv[0], v[r][j][1] * rstd * wv[1]); o.y = pk2(v[r][j][2] * rstd * wv[2], v[r][j][3] * rstd * wv[3]);
                    *(u32x2*)(H + (size_t)row * DM + c) = o; } } }
    }
}

__device__ __forceinline__ void item_kv(const Frame& F_, int layer, int item) { Frame F = relocal(F_);
    const bf16_t* U = (const bf16_t*)(F.ws + WS_U);
    LAS bf16_t* Ab = (LAS bf16_t*)F.lds;
    LAS bf16_t* Bt = (LAS bf16_t*)(F.lds + 17408);
    const int t0 = item * 64;
    { const int tok = F.tid >> 3, part = F.tid & 7; const bf16_t* src = U + (size_t)(t0 + tok) * NINP + UC + 256 + 16 * part;
      float f[16]; { float a[8], b[8]; unpack8(*(const u32x4*)src, a); unpack8(*(const u32x4*)(src + 8), b);
#pragma unroll
        for (int j = 0; j < 8; ++j) { f[j] = a[j]; f[8 + j] = b[j]; } }
      float ss = 0.f;
#pragma unroll
      for (int j = 0; j < 16; ++j) ss += f[j] * f[j];
      ss = sum8(ss);
      const float rstd = rsqrtf(ss * (1.0f / 128.0f) + 1e-6f); const float* nw = F.in[I_CKVN] + layer * 128 + 16 * part;
#pragma unroll
      for (int j = 0; j < 16; j += 2) *(LAS unsigned*)(Ab + tok * 136 + 16 * part + j) = pk2(f[j] * rstd * nw[j], f[j + 1] * rstd * nw[j + 1]); }
    { const int n = F.tid >> 2, kq = F.tid & 3; const float* w = (n < 64 ? F.in[I_CWUK] : F.in[I_CWUV]) + (size_t)layer * 128 * 64 + (n & 63);
      float wv[32];
#pragma unroll
      for (int k = 0; k < 32; ++k) wv[k] = w[(size_t)(32 * kq + k) * 64];
#pragma unroll
      for (int k = 0; k < 32; k += 2) *(LAS unsigned*)(Bt + n * 136 + 32 * kq + k) = pk2(wv[k], wv[k + 1]); }
    if (F.tid < 256) { const int tok = F.tid >> 2, q = F.tid & 3;
        *(u32x4*)((bf16_t*)(F.ws + WS_KIDX) + (size_t)(t0 + tok) * 32 + 8 * q) = *(const u32x4*)(U + (size_t)(t0 + tok) * NINP + UC + 640 + 8 * q); }
    __syncthreads();
    const int mt = F.wave & 3, g = F.lane >> 4, r = F.lane & 15;
#pragma unroll
    for (int q = 0; q < 4; ++q) { const int nt = (F.wave >> 2) * 4 + q;
        f32x4 acc = (f32x4){0.f, 0.f, 0.f, 0.f};
        acc = mma_nt<128>(Ab + mt * 16 * 136, 136, Bt + nt * 16 * 136, 136, acc, F.lane);
        const int n = nt * 16 + r; bf16_t* dst = (bf16_t*)(F.ws + (n < 64 ? WS_K : WS_V));
#pragma unroll
        for (int i = 0; i < 4; ++i) dst[(size_t)(t0 + mt * 16 + 4 * g + i) * 64 + (n & 63)] = f2bf(acc[i]); }
}

constexpr int MB_CG = 0, MB_BG = 18432, MB_BT = 36864, MB_XT = 55296, MB_M = 92160, MB_S0 = 101376, MB_DT = 110592, MB_AC = 111616, MB_RS = 112640;
template <int STAGE> __device__ __forceinline__ void item_mamba(const Frame& F_, int layer, int item) { Frame F = relocal(F_);
    const bf16_t* U = (const bf16_t*)(F.ws + WS_U);
    const int b = item >> 6, c = item & 63, l0 = c * 64; const size_t T0 = (size_t)b * SEQ + l0;
    LAS bf16_t* Cg = (LAS bf16_t*)(F.lds + MB_CG); LAS bf16_t* Bg = (LAS bf16_t*)(F.lds + MB_BG); LAS bf16_t* BT = (LAS bf16_t*)(F.lds + MB_BT);
    LAS bf16_t* XT = (LAS bf16_t*)(F.lds + MB_XT); LAS bf16_t* Mb = (LAS bf16_t*)(F.lds + MB_M); LAS bf16_t* S0 = (LAS bf16_t*)(F.lds + MB_S0);
    LAS float* dts = (LAS float*)(F.lds + MB_DT); LAS float* acs = (LAS float*)(F.lds + MB_AC); LAS float* rs = (LAS float*)(F.lds + MB_RS);
    if (F.tid < 256) { const int l = F.tid >> 2, h = F.tid & 3;
        const float raw = bf2f(U[(T0 + l) * NINP + UM + 768 + h]) + F.in[I_MDTB][layer * 4 + h];
        const float dt = softplusf_(raw); dts[l * 4 + h] = dt; acs[l * 4 + h] = -__expf(F.in[I_MALOG][layer * 4 + h]) * dt; }
    if (F.tid < 64) rs[F.tid] = 0.f;
    __syncthreads();
    float mycum = 0.f;
    if (F.tid < 256) { const int l = F.tid >> 2, h = F.tid & 3; for (int s = 0; s <= l; ++s) mycum += acs[s * 4 + h]; }
    __syncthreads();
    if (F.tid < 256) acs[F.tid] = mycum;
    __syncthreads();
    { const int ch8 = F.tid & 63, tg = F.tid >> 6, c0 = ch8 * 8;
      float wv[4][8], bv[8];
#pragma unroll
      for (int j = 0; j < 8; ++j) { bv[j] = F.in[I_MCONVB][layer * 512 + c0 + j];
#pragma unroll
          for (int k = 0; k < 4; ++k) wv[k][j] = F.in[I_MCONVW][(layer * 4 + k) * 512 + c0 + j]; }
      float win[3][8];
#pragma unroll
      for (int k = 0; k < 3; ++k) { const int l = l0 + tg * 8 - 3 + k;
          if (l >= 0) unpack8(*(const u32x4*)(U + ((size_t)b * SEQ + l) * NINP + UM + 256 + c0), win[k]);
          else {
#pragma unroll
              for (int j = 0; j < 8; ++j) win[k][j] = 0.f; } }
#pragma unroll 1
      for (int ib = 0; ib < 2; ++ib) { u32x4 rows[4];
#pragma unroll
          for (int i4 = 0; i4 < 4; ++i4) rows[i4] = *(const u32x4*)(U + (T0 + tg * 8 + ib * 4 + i4) * NINP + UM + 256 + c0);
#pragma unroll
      for (int i4 = 0; i4 < 4; ++i4) { const int l = tg * 8 + ib * 4 + i4; float cur[8]; unpack8(rows[i4], cur);
          float o[8];
#pragma unroll
          for (int j = 0; j < 8; ++j) { o[j] = siluf_(bv[j] + wv[0][j] * win[0][j] + wv[1][j] * win[1][j] + wv[2][j] * win[2][j] + wv[3][j] * cur[j]);
              win[0][j] = win[1][j]; win[1][j] = win[2][j]; win[2][j] = cur[j]; }
          if (c0 < 256) { const int h = c0 >> 6, p0 = c0 & 63; float sc = dts[l * 4 + h]; if (STAGE == 1) sc *= __expf(acs[63 * 4 + h] - acs[l * 4 + h]);
#pragma unroll
              for (int j = 0; j < 8; ++j) XT[(h * 64 + p0 + j) * 72 + l] = f2bf(o[j] * sc); }
          else if (c0 < 384) { const int g = (c0 - 256) >> 6, n0 = (c0 - 256) & 63;
              if (STAGE == 1) {
#pragma unroll
                  for (int j = 0; j < 8; ++j) BT[(g * 64 + n0 + j) * 72 + l] = f2bf(o[j]); }
              else { u32x4 w; w.x = pk2(o[0], o[1]); w.y = pk2(o[2], o[3]); w.z = pk2(o[4], o[5]); w.w = pk2(o[6], o[7]); *(LAS u32x4*)(Bg + (g * 64 + l) * 72 + n0) = w; } }
          else if (STAGE == 2) { const int g = (c0 - 384) >> 6, n0 = (c0 - 384) & 63;
              u32x4 w; w.x = pk2(o[0], o[1]); w.y = pk2(o[2], o[3]); w.z = pk2(o[4], o[5]); w.w = pk2(o[6], o[7]); *(LAS u32x4*)(Cg + (g * 64 + l) * 72 + n0) = w; } } } }
    __syncthreads();
    const int g4 = F.lane >> 4, r16 = F.lane & 15;
    if (STAGE == 1) {
        float* MST = (float*)(F.ws + WS_MST) + ((size_t)(b * 64 + c) * 4) * 4096;
#pragma unroll
        for (int q = 0; q < 8; ++q) { const int tix = F.wave * 8 + q, h = tix >> 4, mt = (tix >> 2) & 3, nt = tix & 3;
            f32x4 acc = (f32x4){0.f, 0.f, 0.f, 0.f};
            acc = mma_nt<64>(XT + (h * 64 + mt * 16) * 72, 72, BT + ((h >> 1) * 64 + nt * 16) * 72, 72, acc, F.lane);
#pragma unroll
            for (int i = 0; i < 4; ++i) MST[(size_t)h * 4096 + (mt * 16 + 4 * g4 + i) * 64 + nt * 16 + r16] = acc[i]; }
        if (F.tid < 4) ((float*)(F.ws + WS_MDEC))[(b * 64 + c) * 4 + F.tid] = __expf(acs[63 * 4 + F.tid]);
    } else {
        const int mt = F.wave & 3, nh = F.wave >> 2;
        const float* MST = (const float*)(F.ws + WS_MST) + ((size_t)(b * 64 + c) * 4) * 4096;
        f32x4 G[2], yv[4][2];
#pragma unroll
        for (int h = 0; h < 4; ++h) {
            const int g = h >> 1;
            { const float* src = MST + (size_t)h * 4096 + F.tid * 8; const f32x4 a = *(const f32x4*)src, bq = *(const f32x4*)(src + 4);
              u32x4 w; w.x = pk2(a[0], a[1]); w.y = pk2(a[2], a[3]); w.z = pk2(bq[0], bq[1]); w.w = pk2(bq[2], bq[3]);
              *(LAS u32x4*)(S0 + (F.tid >> 3) * 72 + (F.tid & 7) * 8) = w; }
            if ((h & 1) == 0) {
#pragma unroll
                for (int q = 0; q < 2; ++q) { G[q] = (f32x4){0.f, 0.f, 0.f, 0.f};
                    G[q] = mma_nt<64>(Cg + (g * 64 + mt * 16) * 72, 72, Bg + (g * 64 + (2 * nh + q) * 16) * 72, 72, G[q], F.lane); } }
#pragma unroll
            for (int q = 0; q < 2; ++q) { const int s = (2 * nh + q) * 16 + r16; const float as = acs[s * 4 + h];
#pragma unroll
                for (int i = 0; i < 4; ++i) { const int l = mt * 16 + 4 * g4 + i; const float v = (s <= l) ? G[q][i] * __expf(acs[l * 4 + h] - as) : 0.f;
                    Mb[l * 72 + s] = f2bf(v); } }
            __syncthreads();
#pragma unroll
            for (int q = 0; q < 2; ++q) { const int nt = 2 * nh + q;
                f32x4 yd = (f32x4){0.f, 0.f, 0.f, 0.f}, yo = (f32x4){0.f, 0.f, 0.f, 0.f};
                yd = mma_nt<64>(Mb + mt * 16 * 72, 72, XT + (h * 64 + nt * 16) * 72, 72, yd, F.lane);
                yo = mma_nt<64>(Cg + (g * 64 + mt * 16) * 72, 72, S0 + nt * 16 * 72, 72, yo, F.lane);
                const int p = nt * 16 + r16; const float dsk = F.in[I_MD][layer * 4 + h];
#pragma unroll
                for (int i = 0; i < 4; ++i) { const int l = mt * 16 + 4 * g4 + i;
                    const float xs = bf2f(XT[(h * 64 + p) * 72 + l]) / dts[l * 4 + h];
                    yv[h][q][i] = yd[i] + yo[i] * __expf(acs[l * 4 + h]) + dsk * xs; } }
            __syncthreads();
        }
        float part[4] = {0.f, 0.f, 0.f, 0.f};
#pragma unroll
        for (int h = 0; h < 4; ++h)
#pragma unroll
            for (int q = 0; q < 2; ++q) { const int ch = h * 64 + (2 * nh + q) * 16 + r16;
#pragma unroll
                for (int i = 0; i < 4; ++i) { const int l = mt * 16 + 4 * g4 + i; const float z = bf2f(U[(T0 + l) * NINP + UM + ch]);
                    const float v = yv[h][q][i] * siluf_(z); yv[h][q][i] = v; part[i] += v * v; } }
#pragma unroll
        for (int i = 0; i < 4; ++i) { const float s = sum16(part[i]); if (r16 == 0) atomicAdd((float*)(rs + mt * 16 + 4 * g4 + i), s); }
        __syncthreads();
        bf16_t* Y = (bf16_t*)(F.ws + WS_H);
#pragma unroll
        for (int i = 0; i < 4; ++i) { const int l = mt * 16 + 4 * g4 + i; const float rstd = rsqrtf(rs[l] * (1.0f / 256.0f) + 1e-6f);
#pragma unroll
            for (int h = 0; h < 4; ++h)
#pragma unroll
                for (int q = 0; q < 2; ++q) { const int ch = h * 64 + (2 * nh + q) * 16 + r16;
                    Y[(T0 + l) * DM + ch] = f2bf(yv[h][q][i] * rstd * F.in[I_MNORM][layer * 256 + ch]); } }
    }
}
__device__ __forceinline__ void item_mamba_carry(const Frame& F_, int item) { Frame F = relocal(F_);
    const int b = item >> 2, h = item & 3;
    float* MST = (float*)(F.ws + WS_MST); const float* MD = (const float*)(F.ws + WS_MDEC);
    float s[8];
#pragma unroll
    for (int j = 0; j < 8; ++j) s[j] = 0.f;
    for (int c = 0; c < 64; ++c) { float* p = MST + ((size_t)(b * 64 + c) * 4 + h) * 4096 + F.tid * 8; const float d = MD[(b * 64 + c) * 4 + h];
        const f32x4 a = *(f32x4*)p, q = *(f32x4*)(p + 4);
        *(f32x4*)p = (f32x4){s[0], s[1], s[2], s[3]}; *(f32x4*)(p + 4) = (f32x4){s[4], s[5], s[6], s[7]};
        s[0] = s[0] * d + a[0]; s[1] = s[1] * d + a[1]; s[2] = s[2] * d + a[2]; s[3] = s[3] * d + a[3];
        s[4] = s[4] * d + q[0]; s[5] = s[5] * d + q[1]; s[6] = s[6] * d + q[2]; s[7] = s[7] * d + q[3]; }
}

template <int STAGE> __device__ __forceinline__ void item_s5(const Frame& F_, int layer, int item) { Frame F = relocal(F_);
    const bf16_t* U = (const bf16_t*)(F.ws + WS_U);
    const int b = item >> 6, c = item & 63; const size_t T0 = (size_t)b * SEQ + c * 64;
    LAS bf16_t* us = (LAS bf16_t*)F.lds;
    LAS bf16_t* BuW = (LAS bf16_t*)(F.lds + 33792) + F.wave * 4224;
    const float* tab = (const float*)(F.ws + WS_S5TAB + (size_t)layer * S5TAB_L);
    { const int tok = F.tid >> 3, part = F.tid & 7;
#pragma unroll
      for (int q = 0; q < 4; ++q) *(LAS u32x4*)(us + tok * 264 + 32 * part + 8 * q) = *(const u32x4*)(U + (T0 + tok) * NINP + US + 32 * part + 8 * q); }
    const int lane = F.lane, r16 = lane & 15, g4 = lane >> 4, gq = lane >> 5, n0 = lane & 31, g = 2 * F.wave + gq, gn0 = g * 64 + n0, gn1 = gn0 + 32;
    bf16x8 bfr[2][8];
    { const bf16_t* bbt = (const bf16_t*)(F.ws + WS_S5TAB + (size_t)layer * S5TAB_L + S5TAB_BBT);
#pragma unroll
      for (int gg = 0; gg < 2; ++gg)
#pragma unroll
          for (int nt = 0; nt < 8; ++nt) { u32x4 z = (u32x4){0u, 0u, 0u, 0u}; if (g4 < 2) z = *(const u32x4*)(bbt + ((size_t)(2 * F.wave + gg) * 128 + 16 * nt + r16) * 16 + 8 * g4); bfr[gg][nt] = __builtin_bit_cast(bf16x8, z); } }
    const float a0r = tab[gn0 * 2], a0i = tab[gn0 * 2 + 1], a1r = tab[gn1 * 2], a1i = tab[gn1 * 2 + 1];
    float* ST = (float*)(F.ws + WS_S5ST) + (size_t)(b * 64 + c) * 2048;
    float h0r = 0.f, h0i = 0.f, h1r = 0.f, h1i = 0.f;
    if (STAGE == 2) { h0r = ST[gn0 * 2]; h0i = ST[gn0 * 2 + 1]; h1r = ST[gn1 * 2]; h1i = ST[gn1 * 2 + 1]; }
    bf16x8 cf[2][4];
    if (STAGE == 2) { const bf16_t* cm = (const bf16_t*)(F.ws + WS_S5TAB + (size_t)layer * S5TAB_L + S5TAB_F);
#pragma unroll
        for (int gg = 0; gg < 2; ++gg)
#pragma unroll
            for (int ks = 0; ks < 4; ++ks) cf[gg][ks] = *(const bf16x8*)(cm + ((size_t)((2 * F.wave + gg) * 16 + r16)) * 128 + 32 * ks + 8 * g4); }
    __syncthreads();
#pragma unroll 1
    for (int lb = 0; lb < 4; ++lb) {
#pragma unroll
        for (int gg = 0; gg < 2; ++gg) { u32x4 z = (u32x4){0u, 0u, 0u, 0u}; if (g4 < 2) z = *(const LAS u32x4*)(us + (16 * lb + r16) * 264 + (2 * F.wave + gg) * 16 + 8 * g4);
            const bf16x8 afr = __builtin_bit_cast(bf16x8, z);
#pragma unroll
            for (int nt = 0; nt < 8; ++nt) { const f32x4 acc = __builtin_amdgcn_mfma_f32_16x16x32_bf16(afr, bfr[gg][nt], (f32x4){0.f, 0.f, 0.f, 0.f}, 0, 0, 0);
#pragma unroll
                for (int i = 0; i < 4; ++i) BuW[(4 * g4 + i) * 264 + gg * 128 + 16 * nt + r16] = f2bf(acc[i]); } }
        __syncthreads();
#pragma unroll 4
        for (int li = 0; li < 16; ++li) { LAS u32x2* bp = (LAS u32x2*)(BuW + li * 264 + gq * 128 + 4 * n0); const u32x2 v = *bp;
            { const float br = __uint_as_float(v.x << 16), bi = __uint_as_float(v.x & 0xffff0000u); const float nr = a0r * h0r - a0i * h0i + br, ni = a0r * h0i + a0i * h0r + bi; h0r = nr; h0i = ni; }
            { const float br = __uint_as_float(v.y << 16), bi = __uint_as_float(v.y & 0xffff0000u); const float nr = a1r * h1r - a1i * h1i + br, ni = a1r * h1i + a1i * h1r + bi; h1r = nr; h1i = ni; }
            if (STAGE == 2) *bp = (u32x2){pk2(h0r, h0i), pk2(h1r, h1i)}; }
        __syncthreads();
        if (STAGE == 2) {
            bf16_t* YS = (bf16_t*)(F.ws + WS_MOE + YSG_OFF);
#pragma unroll
            for (int gg = 0; gg < 2; ++gg) { f32x4 acc = (f32x4){0.f, 0.f, 0.f, 0.f};
#pragma unroll
                for (int ks = 0; ks < 4; ++ks) { const bf16x8 a = *(const LAS bf16x8*)(BuW + r16 * 264 + gg * 128 + 32 * ks + 8 * g4);
                    acc = __builtin_amdgcn_mfma_f32_16x16x32_bf16(a, cf[gg][ks], acc, 0, 0, 0); }
                const int ch = (2 * F.wave + gg) * 16 + r16; const float dsk = F.in[I_SD][layer * 256 + ch];
#pragma unroll
                for (int i = 0; i < 4; ++i) { const int l = lb * 16 + 4 * g4 + i; const float y = acc[i] + dsk * bf2f(us[l * 264 + ch]);
                    YS[(T0 + l) * 256 + ch] = f2bf(gelu_tanh(y)); } }
            __syncthreads();
        }
    }
    if (STAGE == 1) { ST[gn0 * 2] = h0r; ST[gn0 * 2 + 1] = h0i; ST[gn1 * 2] = h1r; ST[gn1 * 2 + 1] = h1i; }
    if (STAGE == 2) {
        asm volatile("s_waitcnt vmcnt(0)" ::: "memory"); __syncthreads();
        const bf16_t* YS = (const bf16_t*)(F.ws + WS_MOE + YSG_OFF) + T0 * 256; const bf16_t* GW = (const bf16_t*)(F.ws + WS_GLU) + (size_t)layer * 512 * 256;
        const int r16 = F.lane & 15, g4 = F.lane >> 4;
        f32x4 av[4][2], ag[4][2];
#pragma unroll
        for (int m = 0; m < 4; ++m)
#pragma unroll
            for (int q = 0; q < 2; ++q) { av[m][q] = (f32x4){0.f, 0.f, 0.f, 0.f}; ag[m][q] = (f32x4){0.f, 0.f, 0.f, 0.f}; }
#pragma unroll 2
        for (int ks = 0; ks < 8; ++ks) {
            bf16x8 af[4], bv[2], bg[2];
#pragma unroll
            for (int m = 0; m < 4; ++m) af[m] = *(const bf16x8*)(YS + (size_t)(16 * m + r16) * 256 + 32 * ks + 8 * g4);
#pragma unroll
            for (int q = 0; q < 2; ++q) { const int c = 32 * F.wave + 16 * q + r16; const int rowv = 256 * (c >> 7) + (c & 127);
                bv[q] = *(const bf16x8*)(GW + (size_t)rowv * 256 + 32 * ks + 8 * g4); bg[q] = *(const bf16x8*)(GW + (size_t)(rowv + 128) * 256 + 32 * ks + 8 * g4); }
#pragma unroll
            for (int m = 0; m < 4; ++m)
#pragma unroll
                for (int q = 0; q < 2; ++q) { av[m][q] = __builtin_amdgcn_mfma_f32_16x16x32_bf16(af[m], bv[q], av[m][q], 0, 0, 0); ag[m][q] = __builtin_amdgcn_mfma_f32_16x16x32_bf16(af[m], bg[q], ag[m][q], 0, 0, 0); }
        }
        bf16_t* Y = (bf16_t*)(F.ws + WS_H);
#pragma unroll
        for (int q = 0; q < 2; ++q) { const int c = 32 * F.wave + 16 * q + r16; const float bvl = F.in[I_SGLUB][layer * 512 + c], bgt = F.in[I_SGLUB][layer * 512 + 256 + c];
#pragma unroll
            for (int m = 0; m < 4; ++m)
#pragma unroll
                for (int i = 0; i < 4; ++i) Y[(T0 + 16 * m + 4 * g4 + i) * DM + 768 + c] = f2bf((av[m][q][i] + bvl) * sigmoidf_(ag[m][q][i] + bgt)); }
    }
}
__device__ __forceinline__ void item_s5_carry(const Frame& F_, int layer, int b) { Frame F = relocal(F_);
    const float* tab = (const float*)(F.ws + WS_S5TAB + (size_t)layer * S5TAB_L) + 2048;
    float* ST = (float*)(F.ws + WS_S5ST) + (size_t)b * 64 * 2048;
#pragma unroll
    for (int q = 0; q < 2; ++q) { const int gn = F.tid + 512 * q; const float pr = tab[gn * 2], pi = tab[gn * 2 + 1]; float hr = 0.f, hi = 0.f;
        for (int c = 0; c < 64; ++c) { float* p = ST + (size_t)c * 2048 + gn * 2; const float tr = p[0], ti = p[1]; p[0] = hr; p[1] = hi;
            const float nr = pr * hr - pi * hi + tr, ni = pr * hi + pi * hr + ti; hr = nr; hi = ni; } }
}

constexpr int RB_LD = 72;
constexpr int RW_R = 0, RW_K = 16384, RW_V = 32768, RW_W = 49152, RW_A = 65536, RW_B = 81920;
constexpr int R3_G = 49152, R3_O = 65536, R3_TILES = 81920, R3_BON = 147456;
template <int STAGE> __device__ __forceinline__ void rwkv_prep(const Frame& F_, int layer, int b, int h, int c) { Frame F = relocal(F_);
    const bf16_t* U = (const bf16_t*)(F.ws + WS_U);
    const int l0 = c * 64; const size_t T0 = (size_t)b * SEQ + l0;
    LAS float* Rr = (LAS float*)(F.lds + RW_R); LAS float* Kk = (LAS float*)(F.lds + RW_K); LAS float* Vv = (LAS float*)(F.lds + RW_V); LAS float* Ww = (LAS float*)(F.lds + RW_W);
    LAS float* Aa = (LAS float*)(F.lds + (STAGE == 1 ? RW_A : R3_O)); LAS float* Bb = (LAS float*)(F.lds + RW_B); LAS float* Gg = (LAS float*)(F.lds + R3_G); LAS float* BON = (LAS float*)(F.lds + R3_BON);
    LAS bf16_t* TWb = (LAS bf16_t*)(F.lds + 98304); LAS bf16_t* DAb = (LAS bf16_t*)(F.lds + (STAGE == 1 ? 103424 : 118784)); LAS bf16_t* SGb = (LAS bf16_t*)(F.lds + 123904);
    LAS bf16_t* w2T = (LAS bf16_t*)(F.lds + 108544); LAS bf16_t* a2T = (LAS bf16_t*)(F.lds + (STAGE == 1 ? 113664 : 133120)); LAS bf16_t* g2T = (LAS bf16_t*)(F.lds + 138240);
    const float* mu = F.in[I_RMU] + layer * 896;
    { const int tok = F.tid >> 3, p8 = F.tid & 7; const bool first = (l0 + tok == 0);
      const bf16_t* cur = U + (T0 + tok) * NINP + UR; const bf16_t* prv = first ? cur : cur - NINP;
      const float pz = first ? 0.f : 1.f;
      u32x4 cw[3], pw[3]; u32x2 c1 = (u32x2){0u, 0u}, p1 = (u32x2){0u, 0u}, c2 = (u32x2){0u, 0u}, p2 = (u32x2){0u, 0u}; u32x4 c3 = (u32x4){0u, 0u, 0u, 0u}, p3 = (u32x4){0u, 0u, 0u, 0u};
#pragma unroll
      for (int sec = (STAGE == 1 ? 0 : 2); sec < 3; ++sec) { const int co = sec * 256 + h * 64 + 8 * p8; cw[sec] = *(const u32x4*)(cur + co); pw[sec] = *(const u32x4*)(prv + co); }
      if (STAGE == 1) { c1 = *(const u32x2*)(cur + 768 + 4 * p8); p1 = *(const u32x2*)(prv + 768 + 4 * p8); c2 = *(const u32x2*)(cur + 800 + 4 * p8); p2 = *(const u32x2*)(prv + 800 + 4 * p8); }
      if (STAGE == 3) { c3 = *(const u32x4*)(cur + 832 + 8 * p8); p3 = *(const u32x4*)(prv + 832 + 8 * p8); }
#pragma unroll
      for (int sec = (STAGE == 1 ? 0 : 2); sec < 3; ++sec) { const int co = sec * 256 + h * 64 + 8 * p8; float av[8], pq[8]; unpack8(cw[sec], av); unpack8(pw[sec], pq);
          const f32x4 m0 = *(const f32x4*)(mu + co), m1 = *(const f32x4*)(mu + co + 4);
          LAS float* dst = (sec == 0 ? Rr : sec == 1 ? Kk : Vv) + tok * 64 + 8 * p8;
#pragma unroll
          for (int j = 0; j < 8; ++j) pq[j] *= pz;
          *(LAS f32x4*)dst = (f32x4){av[0] + m0[0] * (pq[0] - av[0]), av[1] + m0[1] * (pq[1] - av[1]), av[2] + m0[2] * (pq[2] - av[2]), av[3] + m0[3] * (pq[3] - av[3])};
          *(LAS f32x4*)(dst + 4) = (f32x4){av[4] + m1[0] * (pq[4] - av[4]), av[5] + m1[1] * (pq[5] - av[5]), av[6] + m1[2] * (pq[6] - av[6]), av[7] + m1[3] * (pq[7] - av[7])}; }
      if (STAGE == 1) {
#pragma unroll
        for (int which = 0; which < 2; ++which) { const int co = 768 + 32 * which + 4 * p8; const u32x2 cv = which ? c2 : c1, pv = which ? p2 : p1;
          const f32x4 m0 = *(const f32x4*)(mu + co);
          float x[4] = {__uint_as_float(cv.x << 16), __uint_as_float(cv.x & 0xffff0000u), __uint_as_float(cv.y << 16), __uint_as_float(cv.y & 0xffff0000u)};
          const float y[4] = {pz * __uint_as_float(pv.x << 16), pz * __uint_as_float(pv.x & 0xffff0000u), pz * __uint_as_float(pv.y << 16), pz * __uint_as_float(pv.y & 0xffff0000u)};
#pragma unroll
          for (int j = 0; j < 4; ++j) { x[j] = x[j] + m0[j] * (y[j] - x[j]); if (which == 0) x[j] = tanhf_(x[j]); }
          *(LAS u32x2*)((which ? DAb : TWb) + tok * 40 + 4 * p8) = (u32x2){pk2(x[0], x[1]), pk2(x[2], x[3])}; } }
      if (STAGE == 3) { const int co = 832 + 8 * p8; float av[8], pq[8]; unpack8(c3, av); unpack8(p3, pq);
          const f32x4 m0 = *(const f32x4*)(mu + co), m1 = *(const f32x4*)(mu + co + 4); float x[8];
#pragma unroll
          for (int j = 0; j < 8; ++j) x[j] = sigmoidf_(av[j] + (j < 4 ? m0[j] : m1[j - 4]) * (pz * pq[j] - av[j]));
          *(LAS u32x4*)(SGb + tok * RB_LD + 8 * p8) = (u32x4){pk2(x[0], x[1]), pk2(x[2], x[3]), pk2(x[4], x[5]), pk2(x[6], x[7])}; } }
    { const int ch = F.tid & 63, part = F.tid >> 6;
      if (STAGE == 1) { const float* w2 = F.in[I_RW2] + ((size_t)layer * 32 + 4 * part) * 256 + h * 64 + ch;
          *(LAS u32x2*)(w2T + ch * 40 + 4 * part) = (u32x2){pk2(w2[0], w2[256]), pk2(w2[512], w2[768])}; }
      if (STAGE == 1) { const float* a2 = F.in[I_RA2] + ((size_t)layer * 32 + 4 * part) * 256 + h * 64 + ch;
          *(LAS u32x2*)(a2T + ch * 40 + 4 * part) = (u32x2){pk2(a2[0], a2[256]), pk2(a2[512], a2[768])}; }
      if (STAGE == 3) { const float* g2 = F.in[I_RG2] + ((size_t)layer * 64 + 8 * part) * 256 + h * 64 + ch;
          *(LAS u32x4*)(g2T + ch * RB_LD + 8 * part) = (u32x4){pk2(g2[0], g2[256]), pk2(g2[512], g2[768]), pk2(g2[1024], g2[1280]), pk2(g2[1536], g2[1792])}; } }
    __syncthreads();
    { const int lane = F.lane, mt = F.wave >> 1, nt0 = 2 * (F.wave & 1), r = lane & 15, g4 = lane >> 4; const f32x4 zero4 = (f32x4){0.f, 0.f, 0.f, 0.f};
#pragma unroll
      for (int q = 0; q < 2; ++q) { const int nt = nt0 + q, ch = 16 * nt + r, cg = layer * 256 + h * 64 + ch;
          if (STAGE == 1) { const f32x4 wl = mma_nt<32>(TWb + 16 * mt * 40, 40, w2T + 16 * nt * 40, 40, zero4, lane); const float w0 = F.in[I_RW0][cg];
#pragma unroll
              for (int i = 0; i < 4; ++i) { const float x = w0 + wl[i]; const float wlog = -__logf(1.0f + __expf(-x)) - 0.5f; Ww[(16 * mt + 4 * g4 + i) * 64 + ch] = __expf(-__expf(wlog)); } }
          if (STAGE == 1) { const f32x4 al = mma_nt<32>(DAb + 16 * mt * 40, 40, a2T + 16 * nt * 40, 40, zero4, lane); const float a0 = F.in[I_RA0][cg];
#pragma unroll
              for (int i = 0; i < 4; ++i) Aa[(16 * mt + 4 * g4 + i) * 64 + ch] = sigmoidf_(a0 + al[i]); }
          if (STAGE == 3) { const f32x4 gv = mma_nt<64>(SGb + 16 * mt * RB_LD, RB_LD, g2T + 16 * nt * RB_LD, RB_LD, zero4, lane);
#pragma unroll
              for (int i = 0; i < 4; ++i) Gg[(16 * mt + 4 * g4 + i) * 64 + ch] = gv[i]; } } }
    __syncthreads();
    float* gBON = (float*)(F.ws + WS_BON) + ((size_t)(b * 4 + h) * 64 + c) * 64;
    if (STAGE == 1) { const int j = F.lane, tq = F.wave, cg = layer * 256 + h * 64 + j;
      const float kkw = F.in[I_RKK][cg], kaw = F.in[I_RKA][cg], rk = F.in[I_RRK][cg];
#pragma unroll 2
      for (int i8 = 0; i8 < 8; ++i8) { const int t = tq + 8 * i8;
          const float a = Aa[t * 64 + j]; const float kraw = Kk[t * 64 + j]; const float kp = kraw * (1.0f + (a - 1.0f) * kaw);
          Kk[t * 64 + j] = kp;
          const float kkv = kraw * kkw; const float ss = wave_sum(kkv * kkv); const float kkn = kkv * rsqrtf(fmaxf(ss, 1e-24f)); Aa[t * 64 + j] = -kkn; Bb[t * 64 + j] = kkn * a;
          const float bo = wave_sum(Rr[t * 64 + j] * kp * rk); if (j == 0) gBON[t] = bo; } }
    else if (F.tid < 64) BON[F.tid] = gBON[F.tid];
    __syncthreads();
}
constexpr int RB_AT = 98304, RB_ATT = RB_AT + 9216, RB_BT = RB_ATT + 9216, RB_BTT = RB_BT + 9216, RB_KT = RB_BTT + 9216, RB_RT = RB_KT + 9216, RB_VT = RB_RT + 9216, RB_GC = RB_VT + 9216;
constexpr int RX_X = 0, RX_XT = 9216, RX_TB = 18432, RX_M = 27648, RX_NRT = 36864, RX_G1T = 46080, RX_G2T = 55296, RX_QT = 64512;
__device__ __forceinline__ void st_tile(LAS bf16_t* dst, int mt, int nt, const f32x4 v, int lane) {
    const int r = lane & 15, g = lane >> 4;
#pragma unroll
    for (int i = 0; i < 4; ++i) dst[(16 * mt + 4 * g + i) * RB_LD + 16 * nt + r] = f2bf(v[i]);
}
__device__ __forceinline__ void st_tile_t(LAS bf16_t* dst, int mt, int nt, const f32x4 v, int lane) {
    const int r = lane & 15, g = lane >> 4; u32x2 w; w.x = pk2(v[0], v[1]); w.y = pk2(v[2], v[3]);
    *(LAS u32x2*)(dst + (16 * nt + r) * RB_LD + 16 * mt + 4 * g) = w;
}
__device__ __forceinline__ void item_rwkv1(const Frame& F_, int layer, int item) { Frame F = relocal(F_);
    const int b = item >> 8, h = (item >> 6) & 3, c = item & 63;
    rwkv_prep<1>(F, layer, b, h, c);
    LAS float* Rr = (LAS float*)(F.lds + RW_R); LAS float* Kk = (LAS float*)(F.lds + RW_K); LAS float* Vv = (LAS float*)(F.lds + RW_V); LAS float* Ww = (LAS float*)(F.lds + RW_W);
    LAS float* Aa = (LAS float*)(F.lds + RW_A); LAS float* Bb = (LAS float*)(F.lds + RW_B);
    LAS bf16_t* At = (LAS bf16_t*)(F.lds + RB_AT); LAS bf16_t* AtT = (LAS bf16_t*)(F.lds + RB_ATT); LAS bf16_t* Bt = (LAS bf16_t*)(F.lds + RB_BT); LAS bf16_t* BtT = (LAS bf16_t*)(F.lds + RB_BTT);
    LAS bf16_t* Kt = (LAS bf16_t*)(F.lds + RB_KT); LAS bf16_t* Rt = (LAS bf16_t*)(F.lds + RB_RT); LAS bf16_t* VT = (LAS bf16_t*)(F.lds + RB_VT); LAS float* gC = (LAS float*)(F.lds + RB_GC);
    LAS bf16_t* X = (LAS bf16_t*)(F.lds + RX_X); LAS bf16_t* XT = (LAS bf16_t*)(F.lds + RX_XT); LAS bf16_t* Tb = (LAS bf16_t*)(F.lds + RX_TB); LAS bf16_t* Mm = (LAS bf16_t*)(F.lds + RX_M);
    LAS bf16_t* NrT = (LAS bf16_t*)(F.lds + RX_NRT); LAS bf16_t* G1T = (LAS bf16_t*)(F.lds + RX_G1T); LAS bf16_t* G2T = (LAS bf16_t*)(F.lds + RX_G2T); LAS bf16_t* QT = (LAS bf16_t*)(F.lds + RX_QT);
    { const int k = F.tid & 63, part = F.tid >> 6; float g = 1.0f;
      for (int pp = 0; pp < part; ++pp) { float w8[8];
#pragma unroll
          for (int i = 0; i < 8; ++i) w8[i] = Ww[(8 * pp + i) * 64 + k];
          g *= ((w8[0] * w8[1]) * (w8[2] * w8[3])) * ((w8[4] * w8[5]) * (w8[6] * w8[7])); }
#pragma unroll
      for (int i = 0; i < 8; ++i) { const int t = 8 * part + i; const float gp = g; g *= Ww[t * 64 + k]; const float ig = 1.0f / g;
          const bf16_t av = f2bf(Aa[t * 64 + k] * gp), bv = f2bf(Bb[t * 64 + k] * ig);
          At[t * RB_LD + k] = av; AtT[k * RB_LD + t] = av; Bt[t * RB_LD + k] = bv; BtT[k * RB_LD + t] = bv;
          Kt[t * RB_LD + k] = f2bf(Kk[t * 64 + k] * ig); Rt[t * RB_LD + k] = f2bf(Rr[t * 64 + k] * g); VT[k * RB_LD + t] = f2bf(Vv[t * 64 + k]); }
      if (part == 7) gC[k] = g; }
    __syncthreads();
    const int lane = F.lane, mt = F.wave >> 1, nt0 = 2 * (F.wave & 1), r = lane & 15, g4 = lane >> 4;
    const f32x4 zero4 = (f32x4){0.f, 0.f, 0.f, 0.f};
    f32x4 Tacc[2];
#pragma unroll
    for (int q = 0; q < 2; ++q) { const int nt = nt0 + q;
        f32x4 n = mma_nt<64>(Bt + 16 * mt * RB_LD, RB_LD, At + 16 * nt * RB_LD, RB_LD, zero4, lane);
        f32x4 m = mma_nt<64>(Kt + 16 * mt * RB_LD, RB_LD, At + 16 * nt * RB_LD, RB_LD, zero4, lane);
        f32x4 nr = mma_nt<64>(Rt + 16 * mt * RB_LD, RB_LD, Bt + 16 * nt * RB_LD, RB_LD, zero4, lane);
#pragma unroll
        for (int i = 0; i < 4; ++i) { const int row = 16 * mt + 4 * g4 + i, col = 16 * nt + r;
            n[i] = (row < col) ? n[i] : 0.f; m[i] = (row < col) ? m[i] : 0.f; nr[i] = (col <= row) ? nr[i] : 0.f;
            Tacc[q][i] = n[i] + (row == col ? 1.0f : 0.f); }
        st_tile(X, mt, nt, n, lane); st_tile_t(XT, mt, nt, n, lane); st_tile(Tb, mt, nt, Tacc[q], lane); st_tile(Mm, mt, nt, m, lane); st_tile(NrT, mt, nt, nr, lane); }
    __syncthreads();
#pragma unroll 1
    for (int it = 0; it < 6; ++it) {
        LAS bf16_t* Xr = (it & 1) ? G1T : X; LAS bf16_t* XTr = (it & 1) ? G2T : XT; LAS bf16_t* Tr = (it & 1) ? QT : Tb;
        LAS bf16_t* Xw = (it & 1) ? X : G1T; LAS bf16_t* XTw = (it & 1) ? XT : G2T; LAS bf16_t* Tw = (it & 1) ? Tb : QT;
#pragma unroll
        for (int q = 0; q < 2; ++q) { const int nt = nt0 + q;
            if (it > 0) Tacc[q] = mma_nt<64>(Tr + 16 * mt * RB_LD, RB_LD, XTr + 16 * nt * RB_LD, RB_LD, Tacc[q], lane);
            if (it < 5) { const f32x4 x2 = mma_nt<64>(Xr + 16 * mt * RB_LD, RB_LD, XTr + 16 * nt * RB_LD, RB_LD, zero4, lane); st_tile(Xw, mt, nt, x2, lane); st_tile_t(XTw, mt, nt, x2, lane); }
            st_tile(Tw, mt, nt, Tacc[q], lane); }
        __syncthreads();
    }
#pragma unroll
    for (int q = 0; q < 2; ++q) { const int nt = nt0 + q;
        st_tile(G1T, mt, nt, mma_nt<64>(NrT + 16 * mt * RB_LD, RB_LD, Tb + 16 * nt * RB_LD, RB_LD, zero4, lane), lane);
        st_tile(G2T, mt, nt, mma_nt<64>(BtT + 16 * mt * RB_LD, RB_LD, Tb + 16 * nt * RB_LD, RB_LD, zero4, lane), lane); }
    __syncthreads();
    const size_t ci = (size_t)(b * 4 + h) * 64 + c;
    bf16_t* gPT = (bf16_t*)(F.ws + WS_MOE + RW_PT) + ci * 4096; bf16_t* gW1 = (bf16_t*)(F.ws + WS_MOE + RW_W1) + ci * 4096; bf16_t* gZ = (bf16_t*)(F.ws + WS_MOE + RW_Z) + ci * 4096;
#pragma unroll
    for (int q = 0; q < 2; ++q) { const int nt = nt0 + q; const int col = 16 * nt + r;
        f32x4 w1 = mma_nt<64>(G1T + 16 * mt * RB_LD, RB_LD, AtT + 16 * nt * RB_LD, RB_LD, zero4, lane);
        f32x4 z = mma_nt<64>(G1T + 16 * mt * RB_LD, RB_LD, Mm + 16 * nt * RB_LD, RB_LD, zero4, lane);
        f32x4 mr = mma_nt<64>(Rt + 16 * mt * RB_LD, RB_LD, Kt + 16 * nt * RB_LD, RB_LD, zero4, lane);
        f32x4 p = mma_nt<64>(G2T + 16 * mt * RB_LD, RB_LD, AtT + 16 * nt * RB_LD, RB_LD, zero4, lane);
        f32x4 qq = mma_nt<64>(G2T + 16 * mt * RB_LD, RB_LD, Mm + 16 * nt * RB_LD, RB_LD, zero4, lane);
        const int pos = 32 * (col >> 5) + 8 * ((col >> 2) & 3) + 4 * ((col >> 4) & 1) + (col & 3);
#pragma unroll
        for (int i = 0; i < 4; ++i) { const int row = 16 * mt + 4 * g4 + i;
            gW1[row * 64 + col] = f2bf(w1[i] + bf2f(Rt[row * RB_LD + col]));
            gZ[row * 64 + col] = f2bf(z[i] + (col <= row ? mr[i] : 0.f));
            const float gc = gC[row];
            gPT[row * 64 + pos] = f2bf((p[i] + (row == col ? 1.0f : 0.f)) * gc);
            qq[i] = (qq[i] + bf2f(Kt[col * RB_LD + row])) * gc; }
        st_tile(QT, mt, nt, qq, lane); }
    __syncthreads();
    bf16_t* gU = (bf16_t*)(F.ws + WS_MOE + RW_U) + ci * 4096;
#pragma unroll
    for (int q = 0; q < 2; ++q) { const int nt = nt0 + q;
        const f32x4 u = mma_nt<64>(VT + 16 * mt * RB_LD, RB_LD, QT + 16 * nt * RB_LD, RB_LD, zero4, lane);
#pragma unroll
        for (int i = 0; i < 4; ++i) gU[(16 * mt + 4 * g4 + i) * 64 + 16 * nt + r] = f2bf(u[i]); }
}
__device__ __forceinline__ void item_rwkv_carry(const Frame& F_, int item) { Frame F = relocal(F_);
    const int bh = item * 2 + (F.wave >> 2), nt = F.wave & 3, r = F.lane & 15, g = F.lane >> 4;
    const bf16_t* PT = (const bf16_t*)(F.ws + WS_MOE + RW_PT); const bf16_t* Uc = (const bf16_t*)(F.ws + WS_MOE + RW_U); bf16_t* Ss = (bf16_t*)(F.ws + WS_MOE + RW_S);
    f32x4 acc[4];
#pragma unroll
    for (int m = 0; m < 4; ++m) acc[m] = (f32x4){0.f, 0.f, 0.f, 0.f};
    for (int c = 0; c < 64; ++c) { const size_t ci = (size_t)bh * 64 + c;
        bf16x8 af[4][2]; f32x4 cin[4];
#pragma unroll
        for (int m = 0; m < 4; ++m) { const u32x2 uv = *(const u32x2*)(Uc + ci * 4096 + (16 * nt + r) * 64 + 16 * m + 4 * g);
            cin[m] = (f32x4){__uint_as_float(uv.x << 16), __uint_as_float(uv.x & 0xffff0000u), __uint_as_float(uv.y << 16), __uint_as_float(uv.y & 0xffff0000u)};
#pragma unroll
            for (int s = 0; s < 2; ++s) af[m][s] = *(const bf16x8*)(PT + ci * 4096 + (16 * m + r) * 64 + 32 * s + 8 * g); }
        unsigned pw[4][2];
#pragma unroll
        for (int m = 0; m < 4; ++m) { pw[m][0] = pk2(acc[m][0], acc[m][1]); pw[m][1] = pk2(acc[m][2], acc[m][3]);
            *(u32x2*)(Ss + ci * 4096 + (16 * nt + r) * 64 + 16 * m + 4 * g) = (u32x2){pw[m][0], pw[m][1]}; }
        bf16x8 bfr[2];
#pragma unroll
        for (int s = 0; s < 2; ++s) bfr[s] = __builtin_bit_cast(bf16x8, (u32x4){pw[2 * s][0], pw[2 * s][1], pw[2 * s + 1][0], pw[2 * s + 1][1]});
#pragma unroll
        for (int m = 0; m < 4; ++m) { acc[m] = __builtin_amdgcn_mfma_f32_16x16x32_bf16(af[m][0], bfr[0], cin[m], 0, 0, 0);
            acc[m] = __builtin_amdgcn_mfma_f32_16x16x32_bf16(af[m][1], bfr[1], acc[m], 0, 0, 0); }
    }
}
__device__ __forceinline__ void item_rwkv3(const Frame& F_, int layer, int item) { Frame F = relocal(F_);
    const int b = item >> 8, h = (item >> 6) & 3, c = item & 63; const size_t T0 = (size_t)b * SEQ + c * 64;
    rwkv_prep<3>(F, layer, b, h, c);
    LAS float* Vv = (LAS float*)(F.lds + RW_V); LAS float* Oo = (LAS float*)(F.lds + R3_O);
    LAS float* Gg = (LAS float*)(F.lds + R3_G); LAS float* BON = (LAS float*)(F.lds + R3_BON);
    LAS bf16_t* S0b = (LAS bf16_t*)(F.lds + R3_TILES); LAS bf16_t* W1b = S0b + 4608; LAS bf16_t* Zb = W1b + 4608; LAS bf16_t* VTb = Zb + 4608;
    { const size_t ci = (size_t)(b * 4 + h) * 64 + c; const int row = F.tid >> 3, col = (F.tid & 7) * 8;
      *(LAS u32x4*)(S0b + row * RB_LD + col) = *(const u32x4*)((const bf16_t*)(F.ws + WS_MOE + RW_S) + ci * 4096 + F.tid * 8);
      *(LAS u32x4*)(W1b + row * RB_LD + col) = *(const u32x4*)((const bf16_t*)(F.ws + WS_MOE + RW_W1) + ci * 4096 + F.tid * 8);
      *(LAS u32x4*)(Zb + row * RB_LD + col) = *(const u32x4*)((const bf16_t*)(F.ws + WS_MOE + RW_Z) + ci * 4096 + F.tid * 8);
      const int vv = F.tid & 63, part = F.tid >> 6;
#pragma unroll
      for (int i = 0; i < 8; ++i) { const int t = 8 * part + i; VTb[vv * RB_LD + t] = f2bf(Vv[t * 64 + vv]); } }
    __syncthreads();
    { const int lane = F.lane, mt = F.wave >> 1, nt0 = 2 * (F.wave & 1), r = lane & 15, g4 = lane >> 4;
#pragma unroll
      for (int q = 0; q < 2; ++q) { const int nt = nt0 + q;
          f32x4 o = mma_nt<64>(W1b + 16 * mt * RB_LD, RB_LD, S0b + 16 * nt * RB_LD, RB_LD, (f32x4){0.f, 0.f, 0.f, 0.f}, lane);
          o = mma_nt<64>(Zb + 16 * mt * RB_LD, RB_LD, VTb + 16 * nt * RB_LD, RB_LD, o, lane);
#pragma unroll
          for (int i = 0; i < 4; ++i) Oo[(16 * mt + 4 * g4 + i) * 64 + 16 * nt + r] = o[i]; } }
    __syncthreads();
    { const int j = F.lane, tq = F.wave, ch = h * 64 + j;
      const float lw = F.in[I_RLNW][layer * 256 + ch], lb = F.in[I_RLNB][layer * 256 + ch];
      bf16_t* Y = (bf16_t*)(F.ws + WS_H);
#pragma unroll 2
      for (int i8 = 0; i8 < 8; ++i8) { const int t = tq + 8 * i8;
          const float o = Oo[t * 64 + j]; const float mean = wave_sum(o) * (1.0f / 64.0f); const float d = o - mean; const float var = wave_sum(d * d) * (1.0f / 64.0f);
          float on = d * rsqrtf(var + 64e-5f) * lw + lb; on += BON[t] * Vv[t * 64 + j];
          Y[(T0 + t) * DM + 256 + ch] = f2bf(on * Gg[t * 64 + j]); } }
}

constexpr int DS_SEL = 131072, DS_HIST = 135168, DS_BKT = 151552, DS_BIAS = 152064;
__device__ __forceinline__ void dsa_tables(const Frame& F_) { Frame F = relocal(F_);
    LAS int* bkt = (LAS int*)(F.lds + DS_BKT); LAS float* biasT = (LAS float*)(F.lds + DS_BIAS);
    if (F.tid < 128) { const int n = F.tid; int bk = n; if (n >= 16) { const float lr = logf((float)n / 16.0f) / 2.0794415416798357f; bk = 16 + (int)(lr * 16.0f); bk = bk < 31 ? bk : 31; } bkt[n] = bk; biasT[n] = F.in[I_RELB][n]; }
    __syncthreads();
}
__device__ __forceinline__ unsigned fkey(float f) { const unsigned u = __float_as_uint(f); return (u & 0x80000000u) ? ~u : (u | 0x80000000u); }
__device__ __forceinline__ void item_dsa(const Frame& F_, int layer, int item) { Frame F = relocal(F_);
    const bf16_t* U = (const bf16_t*)(F.ws + WS_U); const bf16_t* KI = (const bf16_t*)(F.ws + WS_KIDX);
    const bf16_t* Kb = (const bf16_t*)(F.ws + WS_K); const bf16_t* Vb = (const bf16_t*)(F.ws + WS_V);
    const int b = item & 3, qg = 511 - (item >> 2); const size_t TB = (size_t)b * SEQ, T0 = TB + qg * 8;
    LAS float* sc = (LAS float*)F.lds; LAS unsigned short* selall = (LAS unsigned short*)(F.lds + DS_SEL); LAS unsigned* histall = (LAS unsigned*)(F.lds + DS_HIST);
    LAS int* bkt = (LAS int*)(F.lds + DS_BKT); LAS float* biasT = (LAS float*)(F.lds + DS_BIAS);
    const int lane = F.lane, hh = lane >> 5;
    {
        bf16x8 af[2][2]; float wq[2][2][8];
        { const int r = lane & 31, q4 = 2 * ((r >> 2) & 1) + (r >> 4), head = 4 * ((r >> 3) & 1) + (r & 3);
#pragma unroll
          for (int mt = 0; mt < 2; ++mt)
#pragma unroll
              for (int ks = 0; ks < 2; ++ks) af[mt][ks] = *(const bf16x8*)(U + (T0 + 4 * mt + q4) * NINP + UC + 384 + head * 32 + 16 * ks + 8 * hh); }
#pragma unroll
        for (int mt = 0; mt < 2; ++mt)
#pragma unroll
            for (int q2 = 0; q2 < 2; ++q2) { float f[8]; unpack8(*(const u32x4*)(U + (T0 + 4 * mt + 2 * hh + q2) * NINP + UC + 672), f);
#pragma unroll
                for (int hd = 0; hd < 8; ++hd) wq[mt][q2][hd] = f[hd]; }
        const int ntile = (qg * 8 + 8 + 31) >> 5;
        bf16x8 nb0 = af[0][0], nb1 = af[0][0];
        if (F.wave < ntile) { const int key = F.wave * 32 + (lane & 31); nb0 = *(const bf16x8*)(KI + (TB + key) * 32 + 8 * hh); nb1 = *(const bf16x8*)(KI + (TB + key) * 32 + 16 + 8 * hh); }
        for (int kt = F.wave; kt < ntile; kt += 8) {
            const int key = kt * 32 + (lane & 31);
            const bf16x8 b0 = nb0, b1 = nb1;
            if (kt + 8 < ntile) { const int k2 = key + 256; nb0 = *(const bf16x8*)(KI + (TB + k2) * 32 + 8 * hh); nb1 = *(const bf16x8*)(KI + (TB + k2) * 32 + 16 + 8 * hh); }
#pragma unroll
            for (int mt = 0; mt < 2; ++mt) { f32x16 acc;
#pragma unroll
                for (int i = 0; i < 16; ++i) acc[i] = 0.f;
                acc = __builtin_amdgcn_mfma_f32_32x32x16_bf16(af[mt][0], b0, acc, 0, 0, 0);
                acc = __builtin_amdgcn_mfma_f32_32x32x16_bf16(af[mt][1], b1, acc, 0, 0, 0);
#pragma unroll
                for (int q2 = 0; q2 < 2; ++q2) { float s = 0.f;
#pragma unroll
                    for (int hd = 0; hd < 8; ++hd) s += fmaxf(acc[8 * q2 + hd], 0.f) * wq[mt][q2][hd];
                    const int qi = 4 * mt + 2 * hh + q2;
                    sc[qi * 4096 + key] = (key <= qg * 8 + qi) ? s : -INFINITY; } }
        }
    }
    __syncthreads();
    const int qi = F.wave, tq = qg * 8 + qi, n = tq + 1;
    LAS float* scq = sc + qi * 4096; LAS unsigned short* sel = selall + qi * 256; LAS unsigned* hist = histall + qi * 512;
    int nsel;
    if (n <= 256) { nsel = n; for (int j = lane; j < 256; j += 64) sel[j] = (unsigned short)(j < n ? j : 0); }
    else {
        nsel = 256;
        const int R = (n + 63) >> 6; const unsigned long long ltm = (1ull << lane) - 1ull;
        float lo = INFINITY, hi = -INFINITY;
        const int R4 = (n + 255) >> 8;
#pragma unroll 4
        for (int i = 0; i < R4; ++i) { const int j0 = 256 * i + 4 * lane; const f32x4 v4 = *(const LAS f32x4*)(scq + j0);
#pragma unroll
            for (int q = 0; q < 4; ++q) { const bool valid = j0 + q < n; lo = fminf(lo, valid ? v4[q] : INFINITY); hi = fmaxf(hi, valid ? v4[q] : -INFINITY); } }
#pragma unroll
        for (int o = 1; o < 64; o <<= 1) { lo = fminf(lo, shx(lo, o)); hi = fmaxf(hi, shx(hi, o)); }
        bool slow = false;
        if (!(hi > lo)) { for (int j = lane; j < 256; j += 64) sel[j] = (unsigned short)j; }
        else {
            const float scale = 1023.0f / (hi - lo);
            *(LAS u32x4*)(hist + 8 * lane) = (u32x4){0u, 0u, 0u, 0u}; *(LAS u32x4*)(hist + 8 * lane + 4) = (u32x4){0u, 0u, 0u, 0u};
#pragma unroll 2
            for (int i = 0; i < R4; ++i) { const int j0 = 256 * i + 4 * lane; const f32x4 v4 = *(const LAS f32x4*)(scq + j0);
#pragma unroll
                for (int q = 0; q < 4; ++q) { if (j0 + q < n) { int bk = (int)((v4[q] - lo) * scale); bk = bk < 1023 ? bk : 1023;
                    atomicAdd((unsigned*)(hist + (bk >> 1)), (bk & 1) ? 65536u : 1u); } } }
            const u32x4 h0 = *(const LAS u32x4*)(hist + 8 * lane), h1 = *(const LAS u32x4*)(hist + 8 * lane + 4);
            unsigned cb[16];
            cb[0] = h0.x & 0xffffu; cb[1] = h0.x >> 16; cb[2] = h0.y & 0xffffu; cb[3] = h0.y >> 16; cb[4] = h0.z & 0xffffu; cb[5] = h0.z >> 16; cb[6] = h0.w & 0xffffu; cb[7] = h0.w >> 16;
            cb[8] = h1.x & 0xffffu; cb[9] = h1.x >> 16; cb[10] = h1.y & 0xffffu; cb[11] = h1.y >> 16; cb[12] = h1.z & 0xffffu; cb[13] = h1.z >> 16; cb[14] = h1.w & 0xffffu; cb[15] = h1.w >> 16;
            unsigned tot = 0u;
#pragma unroll
            for (int q = 0; q < 16; ++q) tot += cb[q];
            unsigned incl = tot;
#pragma unroll
            for (int o = 1; o < 64; o <<= 1) { const unsigned t = shdown_u(incl, o); if (lane + o < 64) incl += t; }
            int fb = -1; unsigned fabove = 0u, fcnt = 0u; unsigned cum = incl - tot;
#pragma unroll
            for (int q = 15; q >= 0; --q) { if (fb < 0 && cum < 256u && 256u <= cum + cb[q]) { fb = 16 * lane + q; fabove = cum; fcnt = cb[q]; } cum += cb[q]; }
            const unsigned long long mf = __ballot(fb >= 0); const int src = (int)__ffsll((long long)mf) - 1;
            const int B = shidx_i(fb, src); const int above = shidx_i((int)fabove, src), cntB = shidx_i((int)fcnt, src); const int need = 256 - above;
            if (cntB > 256) slow = true;
            else {
                LAS unsigned* cand = hist;
                int base_gt = 0, base_c = 0;
#pragma unroll 2
                for (int i = 0; i < R4; ++i) { const int j0 = 256 * i + 4 * lane; const f32x4 v4 = *(const LAS f32x4*)(scq + j0);
#pragma unroll
                    for (int q = 0; q < 4; ++q) { const int j = j0 + q; const bool valid = j < n; const float v = valid ? v4[q] : lo;
                        int bk = (int)((v - lo) * scale); bk = bk < 1023 ? bk : 1023;
                        const bool gt = valid && bk > B, eq = valid && bk == B;
                        const unsigned long long mg = __ballot(gt), me = __ballot(eq);
                        if (gt) sel[base_gt + __popcll(mg & ltm)] = (unsigned short)j;
                        if (eq) { const int p = base_c + __popcll(me & ltm); cand[2 * p] = fkey(v); cand[2 * p + 1] = (unsigned)j; }
                        base_gt += __popcll(mg); base_c += __popcll(me); } }
                if (need == cntB) { for (int c = lane; c < cntB; c += 64) sel[above + c] = (unsigned short)cand[2 * c + 1]; }
                else {
                    unsigned ck[4], cx[4]; int rk[4];
#pragma unroll
                    for (int q = 0; q < 4; ++q) { const int c = lane + 64 * q; ck[q] = c < cntB ? cand[2 * c] : 0u; cx[q] = c < cntB ? cand[2 * c + 1] : 0u; rk[q] = 0; }
                    for (int c2 = 0; c2 < cntB; ++c2) { const unsigned k2 = cand[2 * c2], x2 = cand[2 * c2 + 1];
#pragma unroll
                        for (int q = 0; q < 4; ++q) rk[q] += (k2 > ck[q] || (k2 == ck[q] && x2 < cx[q])) ? 1 : 0; }
#pragma unroll
                    for (int q = 0; q < 4; ++q) { const int c = lane + 64 * q; if (c < cntB && rk[q] < need) sel[above + rk[q]] = (unsigned short)cand[2 * c + 1]; }
                }
            }
        }
        if (slow) {
        unsigned prefix = 0u; int need = 256; unsigned neq = 0u;
        for (int p = 0; p < 4; ++p) { const int shift = 24 - 8 * p;
            *(LAS u32x4*)(hist + 4 * lane) = (u32x4){0u, 0u, 0u, 0u};
            for (int i = 0; i < R; ++i) { const int j = lane + 64 * i; if (j < n) { const unsigned u = fkey(scq[j]);
                if (p == 0 || (u >> (shift + 8)) == prefix) atomicAdd((unsigned*)(hist + ((u >> shift) & 255u)), 1u); } }
            const u32x4 hv = *(const LAS u32x4*)(hist + 4 * lane);
            const unsigned tot = hv.x + hv.y + hv.z + hv.w;
            unsigned incl = tot;
#pragma unroll
            for (int o = 1; o < 64; o <<= 1) { const unsigned t = shdown_u(incl, o); if (lane + o < 64) incl += t; }
            const unsigned above = incl - tot;
            int fb = -1; unsigned fabove = 0u, feq = 0u; unsigned cum = above;
            { const unsigned hq[4] = {hv.x, hv.y, hv.z, hv.w};
#pragma unroll
              for (int q = 3; q >= 0; --q) { if (fb < 0 && cum < (unsigned)need && (unsigned)need <= cum + hq[q]) { fb = 4 * lane + q; fabove = cum; feq = hq[q]; } cum += hq[q]; } }
            const unsigned long long m = __ballot(fb >= 0);
            const int src = (int)__ffsll((long long)m) - 1;
            const int bin = shidx_i(fb, src); const unsigned ab = (unsigned)shidx_i((int)fabove, src); neq = (unsigned)shidx_i((int)feq, src);
            need -= (int)ab; prefix = (prefix << 8) | (unsigned)bin;
        }
        const int ngt = 256 - need;
        int base_gt = 0, base_eq = 0;
        for (int i = 0; i < R; ++i) { const int j = lane + 64 * i; const unsigned u = (j < n) ? fkey(scq[j]) : 0u;
            const bool gt = (j < n) && (u > prefix), eq = (j < n) && (u == prefix);
            const unsigned long long mg = __ballot(gt), me = __ballot(eq); const unsigned long long lt = (1ull << lane) - 1ull;
            if (gt) sel[base_gt + __popcll(mg & lt)] = (unsigned short)j;
            if (eq) { const int rk = base_eq + __popcll(me & lt); if (rk < need) sel[ngt + rk] = (unsigned short)j; }
            base_gt += __popcll(mg); base_eq += __popcll(me); }
        (void)neq;
            }
    }
    const int nt16 = (nsel + 15) >> 4, r16 = lane & 15, g4 = lane >> 4;
    LAS float* biasj = scq + 2048;
#pragma unroll
    for (int q = 0; q < 4; ++q) { const int j = lane + 64 * q; f32x4 bv = (f32x4){-INFINITY, -INFINITY, -INFINITY, -INFINITY};
        if (j < nsel) { const int dist = tq - (int)sel[j]; const int bk = dist < 128 ? bkt[dist < 0 ? 0 : dist] : 31; bv = *(const LAS f32x4*)(biasT + 4 * bk); }
        *(LAS f32x4*)(biasj + 4 * j) = bv; }
    bf16x8 qf[2];
#pragma unroll
    for (int s = 0; s < 2; ++s) { u32x4 z = (u32x4){0u, 0u, 0u, 0u}; if (r16 < 4) z = *(const u32x4*)(U + (T0 + qi) * NINP + UC + r16 * 64 + 32 * s + 8 * g4); qf[s] = __builtin_bit_cast(bf16x8, z); }
    float lg[16][4]; float mx = -INFINITY;
#define DSA_QK(M0, NM) do { int keyr[NM]; bf16x8 a0[NM], a1[NM]; \
        _Pragma("unroll") for (int m8 = 0; m8 < NM; ++m8) keyr[m8] = sel[16 * ((M0) + m8) + r16]; \
        _Pragma("unroll") for (int m8 = 0; m8 < NM; ++m8) { a0[m8] = *(const bf16x8*)(Kb + (TB + keyr[m8]) * 64 + 8 * g4); a1[m8] = *(const bf16x8*)(Kb + (TB + keyr[m8]) * 64 + 32 + 8 * g4); } \
        _Pragma("unroll") for (int m8 = 0; m8 < NM; ++m8) { const int m = (M0) + m8; \
            f32x4 acc = (f32x4){0.f, 0.f, 0.f, 0.f}; \
            acc = __builtin_amdgcn_mfma_f32_16x16x32_bf16(a0[m8], qf[0], acc, 0, 0, 0); \
            acc = __builtin_amdgcn_mfma_f32_16x16x32_bf16(a1[m8], qf[1], acc, 0, 0, 0); \
            _Pragma("unroll") for (int i = 0; i < 4; ++i) { const float v = acc[i] * 0.125f + biasj[(16 * m + 4 * g4 + i) * 4 + (r16 & 3)]; lg[m][i] = v; mx = fmaxf(mx, v); } } } while (0)
    if (nt16 > 8) { DSA_QK(0, 16); }
    else { DSA_QK(0, 8);
#pragma unroll
        for (int m8 = 8; m8 < 16; ++m8)
#pragma unroll
            for (int i = 0; i < 4; ++i) lg[m8][i] = -INFINITY; }
#undef DSA_QK
    mx = fmaxf(mx, shx(mx, 16)); mx = fmaxf(mx, shx(mx, 32));
    float sm = 0.f;
#pragma unroll
    for (int m = 0; m < 16; ++m)
#pragma unroll
        for (int i = 0; i < 4; ++i) { const float p = __expf(lg[m][i] - mx); lg[m][i] = p; sm += p; }
    sm += shx(sm, 16); sm += shx(sm, 32);
    f32x4 ov[4];
#pragma unroll
    for (int nt = 0; nt < 4; ++nt) ov[nt] = (f32x4){0.f, 0.f, 0.f, 0.f};
    const unsigned vs_base = (unsigned)(unsigned long)scq;
#pragma unroll
    for (int half = 0; half < 2; ++half) {
        if (half * 8 < nt16) {
            asm volatile("s_waitcnt lgkmcnt(0)" ::: "memory");
            int vkey[16];
#pragma unroll
            for (int q = 0; q < 16; ++q) { const int rho = 8 * q + (lane >> 3);
                vkey[q] = sel[half * 128 + (rho & ~31) + 16 * ((rho >> 2) & 1) + 4 * ((rho >> 3) & 3) + (rho & 3)]; }
            asm volatile("s_waitcnt lgkmcnt(0)" : "+v"(vkey[0]), "+v"(vkey[1]), "+v"(vkey[2]), "+v"(vkey[3]), "+v"(vkey[4]), "+v"(vkey[5]), "+v"(vkey[6]), "+v"(vkey[7]),
                         "+v"(vkey[8]), "+v"(vkey[9]), "+v"(vkey[10]), "+v"(vkey[11]), "+v"(vkey[12]), "+v"(vkey[13]), "+v"(vkey[14]), "+v"(vkey[15]) :: "memory");
#pragma unroll
            for (int q = 0; q < 16; ++q)
                __builtin_amdgcn_global_load_lds((const unsigned*)(Vb + (TB + vkey[q]) * 64 + 8 * (lane & 7)), (LAS unsigned*)((LAS unsigned char*)scq + q * 1024), 16, 0, 0);
            asm volatile("s_waitcnt vmcnt(0)" ::: "memory");
#pragma unroll
            for (int s4 = 0; s4 < 4; ++s4) { const int s = half * 4 + s4;
                u32x4 pw; pw.x = pk2(lg[2 * s][0], lg[2 * s][1]); pw.y = pk2(lg[2 * s][2], lg[2 * s][3]); pw.z = pk2(lg[2 * s + 1][0], lg[2 * s + 1][1]); pw.w = pk2(lg[2 * s + 1][2], lg[2 * s + 1][3]);
                const bf16x8 pa = __builtin_bit_cast(bf16x8, pw);
                const unsigned ad = vs_base + (unsigned)((32 * s4 + 8 * g4 + (r16 >> 2)) * 128 + (r16 & 3) * 8);
                u32x2 t0[4], t1[4];
                asm volatile("ds_read_b64_tr_b16 %0, %8\n\tds_read_b64_tr_b16 %1, %8 offset:512\n\tds_read_b64_tr_b16 %2, %8 offset:32\n\tds_read_b64_tr_b16 %3, %8 offset:544\n\t"
                             "ds_read_b64_tr_b16 %4, %8 offset:64\n\tds_read_b64_tr_b16 %5, %8 offset:576\n\tds_read_b64_tr_b16 %6, %8 offset:96\n\tds_read_b64_tr_b16 %7, %8 offset:608\n\ts_waitcnt lgkmcnt(0)"
                             : "=&v"(t0[0]), "=&v"(t1[0]), "=&v"(t0[1]), "=&v"(t1[1]), "=&v"(t0[2]), "=&v"(t1[2]), "=&v"(t0[3]), "=&v"(t1[3]) : "v"(ad) : "memory");
#pragma unroll
                for (int nt = 0; nt < 4; ++nt) { const bf16x8 vb = __builtin_bit_cast(bf16x8, (u32x4){t0[nt].x, t0[nt].y, t1[nt].x, t1[nt].y});
                    ov[nt] = __builtin_amdgcn_mfma_f32_16x16x32_bf16(pa, vb, ov[nt], 0, 0, 0); } }
        }
    }
    { float inv[4];
#pragma unroll
      for (int h = 0; h < 4; ++h) inv[h] = 1.0f / __int_as_float(__builtin_amdgcn_readlane(__float_as_int(sm), h));
      if (lane < 16) { bf16_t* Y = (bf16_t*)(F.ws + WS_H) + (T0 + qi) * DM + 512 + r16;
#pragma unroll
          for (int h = 0; h < 4; ++h)
#pragma unroll
              for (int nt = 0; nt < 4; ++nt) Y[h * 64 + 16 * nt] = f2bf(ov[nt][h] * inv[h]); } }
}

__device__ __forceinline__ void phase_router(const Frame& F_, int layer) { Frame F = relocal(F_); const int cset = layer;
    const float* X = (const float*)(F.ws + WS_X);
    const bf16_t* WH = (const bf16_t*)(F.ws + WS_WRT) + (size_t)layer * 2 * 49152; const bf16_t* WL = WH + 49152;
    LAS float* part = (LAS float*)F.lds;
    LAS float* ssq = (LAS float*)(F.lds + 24576);
    LAS int* es = (LAS int*)(F.lds + 25088);
    LAS int* lr = (LAS int*)(F.lds + 25600);
    LAS float* wsl = (LAS float*)(F.lds + 26112);
    LAS float* rsd = (LAS float*)(F.lds + 26624);
    for (int blk = F.bid; blk < NTOK / 64; blk += F.G) {
        __syncthreads();
        const int mt = F.wave & 3, kh = F.wave >> 2, r16 = F.lane & 15, g4 = F.lane >> 4;
        const float* xr = X + ((size_t)blk * 64 + mt * 16 + r16) * DM + kh * 512 + 8 * g4;
        f32x4 acc[3]; acc[0] = acc[1] = acc[2] = (f32x4){0.f, 0.f, 0.f, 0.f}; float ss = 0.f;
#pragma unroll 4
        for (int ks = 0; ks < 16; ++ks) {
            const f32x4 xa = *(const f32x4*)(xr + ks * 32), xb = *(const f32x4*)(xr + ks * 32 + 4);
            ss += xa[0] * xa[0] + xa[1] * xa[1] + xa[2] * xa[2] + xa[3] * xa[3] + xb[0] * xb[0] + xb[1] * xb[1] + xb[2] * xb[2] + xb[3] * xb[3];
            float xv[8] = {xa[0], xa[1], xa[2], xa[3], xb[0], xb[1], xb[2], xb[3]}; unsigned hw[4], lw[4];
#pragma unroll
            for (int j = 0; j < 4; ++j) { const bf16_t h0 = f2bf(xv[2 * j]), h1 = f2bf(xv[2 * j + 1]); hw[j] = (unsigned)h0 | ((unsigned)h1 << 16);
                lw[j] = pk2(xv[2 * j] - bf2f(h0), xv[2 * j + 1] - bf2f(h1)); }
            const bf16x8 ahi = __builtin_bit_cast(bf16x8, (u32x4){hw[0], hw[1], hw[2], hw[3]}), alo = __builtin_bit_cast(bf16x8, (u32x4){lw[0], lw[1], lw[2], lw[3]});
#pragma unroll
            for (int nt = 0; nt < 3; ++nt) { const size_t wo = (size_t)(nt * 16 + r16) * 1024 + kh * 512 + ks * 32 + 8 * g4;
                const bf16x8 bh = *(const bf16x8*)(WH + wo), bl = *(const bf16x8*)(WL + wo);
                acc[nt] = __builtin_amdgcn_mfma_f32_16x16x32_bf16(ahi, bh, acc[nt], 0, 0, 0);
                acc[nt] = __builtin_amdgcn_mfma_f32_16x16x32_bf16(ahi, bl, acc[nt], 0, 0, 0);
                acc[nt] = __builtin_amdgcn_mfma_f32_16x16x32_bf16(alo, bh, acc[nt], 0, 0, 0); }
        }
        ss += shx(ss, 16); ss += shx(ss, 32);
        if (g4 == 0) ssq[kh * 64 + mt * 16 + r16] = ss;
#pragma unroll
        for (int nt = 0; nt < 3; ++nt)
#pragma unroll
            for (int i = 0; i < 4; ++i) part[(kh * 64 + mt * 16 + 4 * g4 + i) * 48 + nt * 16 + r16] = acc[nt][i];
        __syncthreads();
        if (F.tid < 64) { const float rstd = rsqrtf((ssq[F.tid] + ssq[64 + F.tid]) * (1.0f / DM) + 1e-6f); rsd[F.tid] = rstd;
            float l[36];
#pragma unroll
            for (int o = 0; o < 36; ++o) l[o] = (part[F.tid * 48 + o] + part[(64 + F.tid) * 48 + o]) * rstd + (o < 32 ? F.in[I_BRE][layer * 32 + o] : F.in[I_BRG][layer * 4 + o - 32]);
            int gs = 0; float gm = l[32];
#pragma unroll
            for (int j = 1; j < 4; ++j) if (l[32 + j] > gm) { gm = l[32 + j]; gs = j; }
            float den = 0.f;
#pragma unroll
            for (int j = 0; j < 4; ++j) den += __expf(l[32 + j] - gm);
            const float gate = 1.0f / den;
            float e8[8];
#pragma unroll
            for (int j = 0; j < 8; ++j) e8[j] = gs == 0 ? l[j] : gs == 1 ? l[8 + j] : gs == 2 ? l[16 + j] : l[24 + j];
            int i1 = 0; float v1 = e8[0];
#pragma unroll
            for (int j = 1; j < 8; ++j) if (e8[j] > v1) { v1 = e8[j]; i1 = j; }
            int i2 = -1; float v2 = -INFINITY;
#pragma unroll
            for (int j = 0; j < 8; ++j) if (j != i1 && e8[j] > v2) { v2 = e8[j]; i2 = j; }
            const float e2 = __expf(v2 - v1); const float p1 = 1.0f / (1.0f + e2);
            es[F.tid * 2] = gs * 8 + i1; es[F.tid * 2 + 1] = gs * 8 + i2; wsl[F.tid * 2] = p1 * gate; wsl[F.tid * 2 + 1] = (1.0f - p1) * gate; }
        __syncthreads();
        if (F.tid < 32) { int cnt = 0; for (int i = 0; i < 128; ++i) if (es[i] == F.tid) lr[i] = cnt++;
            if (cnt) { const int base = (int)__hip_atomic_fetch_add(F.ctl + CW_CNT + cset * 32 + F.tid, (unsigned)cnt, __ATOMIC_RELAXED, __HIP_MEMORY_SCOPE_AGENT);
                for (int i = 0; i < 128; ++i) if (es[i] == F.tid) lr[i] += base; } }
        __syncthreads();
        if (F.tid < 64) { int* rt = (int*)(F.ws + WS_ROUTE) + ((size_t)blk * 64 + F.tid) * 8;
            rt[0] = es[F.tid * 2]; rt[1] = es[F.tid * 2 + 1]; ((float*)rt)[2] = wsl[F.tid * 2]; ((float*)rt)[3] = wsl[F.tid * 2 + 1]; rt[4] = lr[F.tid * 2]; rt[5] = lr[F.tid * 2 + 1]; ((float*)rt)[6] = rsd[F.tid]; }
    }
    __syncthreads();
    if (F.tid == 0) __hip_atomic_fetch_add(F.ctl + CW_RB + 64 * layer, 1u, __ATOMIC_RELAXED, __HIP_MEMORY_SCOPE_AGENT);
}
__device__ __forceinline__ void phase_moe_convert(const Frame& F_, int layer) { Frame F = relocal(F_);
    bf16_t* WGU = (bf16_t*)(F.ws + WS_MOE + MOE_WGU); bf16_t* WD = (bf16_t*)(F.ws + WS_MOE + MOE_WD);
    for (int t = F.bid; t < 1536; t += F.G) {
        if (t < 1024) { const int e = t >> 5, r = t & 31, kt = r >> 1, nt = r & 1; const size_t eo = ((size_t)layer * 32 + e) * 1024 * 256;
            tr_tile(F, 256, WGU + (size_t)e * 512 * 1024, 1024, kt * 64, nt * 256, SmGU{F.in[I_WGATE] + eo, F.in[I_WUP] + eo}); }
        else { const int q = t - 1024, e = q >> 4, r = q & 15, kt = r >> 2, nt = r & 3;
            tr_tile(F, 1024, WD + (size_t)e * 1024 * 256, 256, kt * 64, nt * 256, SmId{F.in[I_WDOWN] + ((size_t)layer * 32 + e) * 256 * 1024}); }
    }
}
__device__ __forceinline__ void phase_gather(const Frame& F_, int layer) { Frame F = relocal(F_);
    LAS int* off = (LAS int*)F.lds;
    __syncthreads();
    if (F.tid == 0) { unsigned sp = 0;
        while (__hip_atomic_load(F.ctl + CW_RB + 64 * layer, __ATOMIC_RELAXED, __HIP_MEMORY_SCOPE_AGENT) < (unsigned)F.G) { __builtin_amdgcn_s_sleep(2); if (++sp > (1u << 22)) break; } }
    __syncthreads();
    if (F.tid == 0) { int acc = 0; for (int e = 0; e < 32; ++e) { off[e] = acc; const int c = (int)__hip_atomic_load(F.ctl + CW_CNT + layer * 32 + e, __ATOMIC_RELAXED, __HIP_MEMORY_SCOPE_AGENT); acc += (c + 255) & ~255; } off[32] = acc; }
    __syncthreads();
    int* tiles = (int*)(F.ws + WS_TILES); int* row_tok = (int*)(F.ws + WS_ROWS); float* row_w = (float*)(F.ws + WS_ROWS) + MAXROWS;
    if (F.bid == 0) { if (F.tid == 0) tiles[0] = off[32] >> 8; if (F.tid < 33) tiles[1 + F.tid] = off[F.tid];
        if (F.tid < 32) for (int rt = off[F.tid] >> 8; rt < (off[F.tid + 1] >> 8); ++rt) tiles[64 + rt] = F.tid; }
    for (int e = F.bid; e < 32; e += F.G) { const int c = (int)__hip_atomic_load(F.ctl + CW_CNT + layer * 32 + e, __ATOMIC_RELAXED, __HIP_MEMORY_SCOPE_AGENT);
        for (int r = off[e] + c + F.tid; r < off[e + 1]; r += NTHR) { row_tok[r] = -1; row_w[r] = 0.f; } }
    const float* X = (const float*)(F.ws + WS_X); bf16_t* HP = (bf16_t*)(F.ws + WS_U); const float* nw = F.in[I_NORM2] + (size_t)layer * DM;
    f32x4 nwv[4];
#pragma unroll
    for (int j = 0; j < 4; ++j) nwv[j] = *(const f32x4*)(nw + 4 * F.lane + 256 * j);
    for (int blk = F.bid; blk < NTOK / 64; blk += F.G)
    for (int i4 = 0; i4 < 2; ++i4) {
        int p0[4], p1[4], tt[4]; float rstd[4], w0[4], w1[4]; f32x4 xv[4][4];
#pragma unroll
        for (int r = 0; r < 4; ++r) { const int t = blk * 64 + F.wave * 8 + 4 * i4 + r; tt[r] = t;
            const int* rt = (const int*)(F.ws + WS_ROUTE) + (size_t)t * 8; rstd[r] = ((const float*)rt)[6]; w0[r] = ((const float*)rt)[2]; w1[r] = ((const float*)rt)[3];
            p0[r] = off[rt[0]] + rt[4]; p1[r] = off[rt[1]] + rt[5];
#pragma unroll
            for (int j = 0; j < 4; ++j) xv[r][j] = *(const f32x4*)(X + (size_t)t * DM + 4 * F.lane + 256 * j); }
#pragma unroll
        for (int r = 0; r < 4; ++r) {
#pragma unroll
            for (int j = 0; j < 4; ++j) { const int c = 4 * F.lane + 256 * j; const f32x4 v = xv[r][j] * rstd[r] * nwv[j];
                u32x2 o; o.x = pk2(v[0], v[1]); o.y = pk2(v[2], v[3]);
                *(u32x2*)(HP + (size_t)p0[r] * DM + c) = o; *(u32x2*)(HP + (size_t)p1[r] * DM + c) = o; }
            if (F.lane == 0) { row_tok[p0[r]] = tt[r] * 2; row_w[p0[r]] = w0[r]; row_tok[p1[r]] = tt[r] * 2 + 1; row_w[p1[r]] = w1[r]; } }
    }
}

constexpr int NPH_LAYER = 9, NPHASE = 1 + 2 * NPH_LAYER + 1;
#ifndef MK_ONLY
#define MK_ONLY -1
#endif
#ifndef MK_ITEM
#define MK_ITEM -1
#endif
#define EN(o) (MK_ONLY < 0 || MK_ONLY == (o))
#define IT(o) (MK_ITEM < 0 || MK_ITEM == (o))
__global__ void __launch_bounds__(NTHR, 2) mk_forward(Params P) {
    extern __shared__ __attribute__((aligned(16))) unsigned char lds_raw[];
    Frame F; F.lds = (LAS unsigned char*)lds_raw; F.tid = threadIdx.x; F.lane = F.tid & 63; F.wave = __builtin_amdgcn_readfirstlane(F.tid >> 6); F.bid = blockIdx.x; F.G = gridDim.x;
    F.in = (in_tab_t)__builtin_amdgcn_kernarg_segment_ptr(); F.out = P.out; F.ws = P.ws; F.ctl = (unsigned*)(P.ws + WS_CTL); F.misc = (volatile LAS int*)(F.lds + MISC_OFF);
    if (F.tid < 64) ((LAS unsigned*)(F.lds + MISC_OFF))[F.tid] = 0u;
    __syncthreads();
    const int lo = P.ph_lo, hi = P.ph_hi;
    XcdBarrier bar; bar.bar = F.ctl + CW_BAR; bar.x = 0; bar.st = (volatile LAS unsigned*)(F.lds + MISC_OFF + 16);
    if (hi - lo > 1) bar = xcd_barrier_post(F.ctl + CW_BAR, (volatile LAS unsigned*)(F.lds + MISC_OFF + 16));
#define IN(k) (lo <= (k) && (k) < hi)
#define SEAM(k) do { if (IN(k) && IN((k) + 1)) xcd_barrier(bar); } while (0)
#define QLOOP(qi, n, body) for (;;) { const int it = q_pop(F, layer * 12 + (qi)); if (it >= (n)) break; body; }
    if (EN(100) && IN(0)) { phase_prologue(F); phase_norm(F, F.in[I_X], false, F.in[I_NORM1], 0); } SEAM(0);
#pragma unroll
    for (int layer = 0; layer < DEPTH; ++layer) {
        const int pb = 1 + layer * NPH_LAYER;
        if (layer > 0) { if (EN(0) && IN(pb + 0)) { phase_norm(F, (const float*)(F.ws + WS_X), true, F.in[I_NORM1] + (size_t)layer * DM, 0); } SEAM(pb + 0); }
        if (EN(1) && IN(pb + 1)) { const Frame F_ = F; Frame F = relocal(F_); pg8::StaticOrder S; S.init((const bf16_t*)(F.ws + WS_H), (const bf16_t*)(F.ws + WS_WIN) + (size_t)layer * NINP * DM, NTOK, NINP, DM, F.G, F.bid);
            pg8::EpiBf16 E{(bf16_t*)(F.ws + WS_U), NINP}; pg8::gemm_phase(F.lds, DM, S, E); } SEAM(pb + 1);
#define SLOOP(n, body) for (int it = F.bid; it < (n); it += F.G) { __syncthreads(); body; }
        if (EN(2) && IN(pb + 2)) {
            if (IT(1)) SLOOP(1024, item_rwkv1(F, layer, it));
            if (IT(0)) SLOOP(256, item_s5<1>(F, layer, it));
            if (IT(2)) SLOOP(256, item_mamba<1>(F, layer, it));
            if (IT(3)) SLOOP(256, item_kv(F, layer, it));
        } SEAM(pb + 2);
        if (EN(3) && IN(pb + 3)) {
            if (IT(0)) QLOOP(4, 8, item_rwkv_carry(F, it));
            if (IT(1)) QLOOP(5, 16, item_mamba_carry(F, it));
            if (IT(2)) QLOOP(6, 4, item_s5_carry(F, layer, it));
            if (IT(3)) {
                dsa_tables(F);
                const int pref = (int)(xb_xcc_id() & 3u);
#pragma unroll 1
                for (int k4 = 0; k4 < 4; ++k4) { const int bq = (pref + k4) & 3;
                    for (;;) { const int it = q_pop(F, 24 + layer * 4 + bq); if (it >= 512) break; item_dsa(F, layer, it * 4 + bq); } } }
        } SEAM(pb + 3);
        if (EN(4) && IN(pb + 4)) {
            if (IT(0)) SLOOP(256, item_s5<2>(F, layer, it));
            if (IT(2)) SLOOP(256, item_mamba<2>(F, layer, it));
            if (IT(1)) SLOOP(1024, item_rwkv3(F, layer, it));
        } SEAM(pb + 4);
        if (EN(6) && IN(pb + 5)) { const Frame F_ = F; Frame F = relocal(F_); pg8::StaticOrder S; S.init((const bf16_t*)(F.ws + WS_H), (const bf16_t*)(F.ws + WS_WOUT) + (size_t)layer * DM * DM, NTOK, DM, DM, F.G, F.bid);
            pg8::EpiResid E{(float*)(F.ws + WS_X), DM}; pg8::gemm_phase(F.lds, DM, S, E); } SEAM(pb + 5);
        if (EN(7) && IN(pb + 6)) { phase_router(F, layer); phase_moe_convert(F, layer); phase_gather(F, layer); } SEAM(pb + 6);
        if (EN(8) && IN(pb + 7)) { const Frame F_ = F; Frame F = relocal(F_); pg8::MoeOrder S{2, F.G, F.bid, DM, (const char*)(F.ws + WS_U), (const char*)(F.ws + WS_MOE + MOE_WGU), (size_t)512 * 1024 * 2, (const int*)(F.ws + WS_TILES)};
            pg8::EpiGated<1> E{(bf16_t*)(F.ws + WS_H), 256, 0, nullptr, nullptr}; pg8::gemm_phase(F.lds, DM, S, E); } SEAM(pb + 7);
        if (EN(9) && IN(pb + 8)) { const Frame F_ = F; Frame F = relocal(F_); pg8::MoeOrder S{4, F.G, F.bid, 256, (const char*)(F.ws + WS_H), (const char*)(F.ws + WS_MOE + MOE_WD), (size_t)1024 * 256 * 2, (const int*)(F.ws + WS_TILES)};
            pg8::EpiMoeOut E{(bf16_t*)(F.ws + WS_U), (const int*)(F.ws + WS_ROWS), (const float*)(F.ws + WS_ROWS) + MAXROWS, F.lds}; pg8::gemm_phase(F.lds, 256, S, E); } SEAM(pb + 8);
    }
    if (EN(101) && IN(NPHASE - 1)) { phase_norm(F, (const float*)(F.ws + WS_X), true, F.in[I_FNORM], 2); }
#undef IN
#undef SEAM
}

#ifndef MK_SPLIT
#define MK_SPLIT 0
#endif
extern "C" void kernel_launch(void* const* d_in, const int* in_sizes, int n_in, void* d_out, int out_size, void* d_ws, size_t ws_size, hipStream_t stream) {
    static int grid = 0;
    if (grid == 0) {
        if (n_in != 44 || out_size != NTOK * DM || ws_size < WS_END) { fprintf(stderr, "kernel_launch: unexpected shapes (n_in %d out %d ws %zu need %zu)\n", n_in, out_size, ws_size, (size_t)WS_END); grid = -1; return; }
        int dev = 0, cus = 0;
        if (hipGetDevice(&dev) != hipSuccess || hipDeviceGetAttribute(&cus, hipDeviceAttributeMultiprocessorCount, dev) != hipSuccess) { grid = -1; return; }
        if (hipFuncSetAttribute((const void*)mk_forward, hipFuncAttributeMaxDynamicSharedMemorySize, LDS_BYTES) != hipSuccess) { fprintf(stderr, "kernel_launch: hipFuncSetAttribute failed\n"); grid = -1; return; }
        int per_cu = 0;
        if (hipOccupancyMaxActiveBlocksPerMultiprocessor(&per_cu, (const void*)mk_forward, NTHR, LDS_BYTES) != hipSuccess || per_cu < 1) { fprintf(stderr, "kernel_launch: occupancy query says %d\n", per_cu); }
        (void)hipGetLastError();
        grid = cus;
    }
    if (grid < 0) return;
    hipMemsetAsync((char*)d_ws + WS_CTL, 0, CTL_BYTES, stream);
    Params p{};
    for (int i = 0; i < 44; ++i) p.in[i] = (const float*)d_in[i];
    p.out = (float*)d_out; p.ws = (unsigned char*)d_ws;
#if MK_SPLIT
    for (int ph = 0; ph < NPHASE; ++ph) { p.ph_lo = ph; p.ph_hi = ph + 1; hipLaunchKernelGGL(mk_forward, dim3(grid), dim3(NTHR), LDS_BYTES, stream, p); }
#else
    p.ph_lo = 0; p.ph_hi = NPHASE; hipLaunchKernelGGL(mk_forward, dim3(grid), dim3(NTHR), LDS_BYTES, stream, p);
#endif
}
```

```cpp
#include <hip/hip_runtime.h>
#include <stdint.h>
#include <stdio.h>

#define LAS __attribute__((address_space(3)))
typedef unsigned short bf16_t;
typedef short bf16x8 __attribute__((ext_vector_type(8)));
typedef float f32x4 __attribute__((ext_vector_type(4)));
typedef float f32x2 __attribute__((ext_vector_type(2)));
typedef float f32x16 __attribute__((ext_vector_type(16)));
typedef unsigned u32x4 __attribute__((ext_vector_type(4)));
typedef unsigned u32x2 __attribute__((ext_vector_type(2)));

constexpr int NTOK = 16384, DM = 1024, SEQ = 4096, NBATCH = 4, DEPTH = 2;
constexpr int NIN = 2604, NINP = 2816;
constexpr int UM = 0;
constexpr int UR = 784;
constexpr int UC = 1680;
constexpr int US = 2368;
constexpr int NTHR = 512;
constexpr int LDS_BYTES = 163840;
constexpr int MISC_OFF = LDS_BYTES - 256;

constexpr size_t WS_CTL   = 0;
constexpr size_t CTL_BYTES = 65536;
constexpr size_t WS_X     = WS_CTL + CTL_BYTES;
constexpr size_t WS_H     = WS_X + (size_t)NTOK * DM * 4;
constexpr size_t WS_U     = WS_H + (size_t)NTOK * DM * 2;
constexpr size_t WS_WIN   = WS_U + (size_t)NTOK * NINP * 2;
constexpr size_t WS_WOUT  = WS_WIN + (size_t)2 * NINP * DM * 2;
constexpr size_t WS_GLU   = WS_WOUT + (size_t)2 * DM * DM * 2;
constexpr size_t WS_MOE   = WS_GLU + (size_t)2 * 512 * 256 * 2;
constexpr size_t MOE_WGU  = 0;
constexpr size_t MOE_WD   = (size_t)32 * 512 * 1024 * 2;
constexpr size_t MOE_BYTES = MOE_WD + (size_t)32 * 1024 * 256 * 2;
constexpr size_t RW_PT    = 0;
constexpr size_t RW_U     = (size_t)1024 * 4096 * 2;
constexpr size_t RW_S     = RW_U + (size_t)1024 * 4096 * 2;
constexpr size_t RW_W1    = RW_S + (size_t)1024 * 4096 * 2;
constexpr size_t RW_Z     = RW_W1 + (size_t)1024 * 4096 * 2;
constexpr size_t YSG_OFF  = RW_Z + (size_t)1024 * 4096 * 2;
static_assert(YSG_OFF + (size_t)NTOK * 256 * 2 <= MOE_BYTES, "alias");
constexpr size_t WS_MST   = WS_MOE + MOE_BYTES;
constexpr size_t WS_MDEC  = WS_MST + (size_t)4 * 64 * 4 * 4096 * 4;
constexpr size_t WS_S5ST  = WS_MDEC + 4096;
constexpr size_t WS_K     = WS_S5ST + (size_t)4 * 64 * 2048 * 4;
constexpr size_t WS_V     = WS_K + (size_t)NTOK * 64 * 2;
constexpr size_t WS_KIDX  = WS_V + (size_t)NTOK * 64 * 2;
constexpr size_t WS_ROUTE = WS_KIDX + (size_t)NTOK * 32 * 2;
constexpr size_t WS_ROWS  = WS_ROUTE + (size_t)NTOK * 32;
constexpr int    MAXROWS  = 49152;
constexpr size_t WS_TILES = WS_ROWS + (size_t)MAXROWS * 8;
constexpr size_t WS_S5TAB = WS_TILES + 4096;
constexpr size_t S5TAB_F  = (size_t)(2048 + 2048 + 32768) * 4;
constexpr size_t S5TAB_BBT = S5TAB_F + (size_t)16 * 16 * 128 * 2;
constexpr size_t S5TAB_L  = S5TAB_BBT + (size_t)16 * 128 * 16 * 2;
constexpr size_t WS_WRT   = WS_S5TAB + 2 * S5TAB_L;
constexpr size_t WS_BON   = WS_WRT + (size_t)2 * 2 * 48 * 1024 * 2;
constexpr size_t WS_END   = WS_BON + (size_t)1024 * 64 * 4;

constexpr int CW_BAR = 0;
constexpr int CW_Q   = 4096;
constexpr int CW_CNT = 8192;
constexpr int CW_RB  = 8448;

__device__ __forceinline__ float bf2f(bf16_t b) { return __uint_as_float(((unsigned)b) << 16); }
__device__ __forceinline__ bf16_t f2bf(float f) { const __bf16 h = (__bf16)f; return __builtin_bit_cast(bf16_t, h); }
__device__ __forceinline__ unsigned pk2(float lo, float hi) { typedef __bf16 bf2_t __attribute__((ext_vector_type(2))); const bf2_t h = __builtin_convertvector((f32x2){lo, hi}, bf2_t); return __builtin_bit_cast(unsigned, h); }
__device__ __forceinline__ unsigned cvt_pk_bf16(float lo, float hi) { unsigned r; asm volatile("v_cvt_pk_bf16_f32 %0, %1, %2" : "=v"(r) : "v"(lo), "v"(hi)); return r; }
__device__ __forceinline__ float sigmoidf_(float x) { return 1.0f / (1.0f + __expf(-x)); }
__device__ __forceinline__ float siluf_(float x) { return x / (1.0f + __expf(-x)); }
__device__ __forceinline__ float tanhf_(float x) { const float e = __expf(2.0f * x); return 1.0f - 2.0f / (e + 1.0f); }
__device__ __forceinline__ float softplusf_(float x) { return fmaxf(x, 0.0f) + log1pf(__expf(-fabsf(x))); }
__device__ __forceinline__ float gelu_tanh(float x) { return 0.5f * x * (1.0f + tanhf_(0.7978845608028654f * (x + 0.044715f * x * x * x))); }
template <int CTRL> __device__ __forceinline__ float dppf(float x) { return __int_as_float(__builtin_amdgcn_update_dpp(0, __float_as_int(x), CTRL, 0xF, 0xF, true)); }
__device__ __forceinline__ float sum4(float x) { x += dppf<0xB1>(x); x += dppf<0x4E>(x); return x; }
__device__ __forceinline__ float sum8(float x) { x = sum4(x); x += dppf<0x141>(x); return x; }
__device__ __forceinline__ float sum16(float x) { x = sum8(x); x += dppf<0x140>(x); return x; }
__device__ __forceinline__ int lane_id_() { int l = (int)__builtin_amdgcn_mbcnt_hi(~0u, __builtin_amdgcn_mbcnt_lo(~0u, 0u)); asm volatile("" : "+v"(l)); return l; }
__device__ __forceinline__ float shx(float x, int o) { return __int_as_float(__builtin_amdgcn_ds_bpermute((lane_id_() ^ o) << 2, __float_as_int(x))); }
__device__ __forceinline__ unsigned shdown_u(unsigned x, int o) { return (unsigned)__builtin_amdgcn_ds_bpermute(((lane_id_() + o) & 63) << 2, (int)x); }
__device__ __forceinline__ int shidx_i(int x, int src) { return __builtin_amdgcn_ds_bpermute(src << 2, x); }
__device__ __forceinline__ float wave_sum(float x) { x = sum16(x); x += shx(x, 16); x += shx(x, 32); return x; }
__device__ __forceinline__ void unpack8(const u32x4 v, float (&f)[8]) {
    f[0] = __uint_as_float(v.x << 16); f[1] = __uint_as_float(v.x & 0xffff0000u); f[2] = __uint_as_float(v.y << 16); f[3] = __uint_as_float(v.y & 0xffff0000u);
    f[4] = __uint_as_float(v.z << 16); f[5] = __uint_as_float(v.z & 0xffff0000u); f[6] = __uint_as_float(v.w << 16); f[7] = __uint_as_float(v.w & 0xffff0000u);
}

#define XB_TMO      128
#define XB_XCNT(j)  (256  + 64 * (j))
#define XB_XSUB(j)  (1280 + 64 * (j))
#define XB_XGEN(j)  (2304 + 64 * (j))
#define XB_TOP      3328
#define XB_TOPGEN   3392
#define XCD_BAR_WORDS 3456
#define XB_SPIN_CAP (1u << 22)
__device__ __forceinline__ unsigned xb_ld(unsigned* p)              { return __hip_atomic_load(p, __ATOMIC_RELAXED, __HIP_MEMORY_SCOPE_AGENT); }
__device__ __forceinline__ unsigned xb_add(unsigned* p, unsigned v) { return __hip_atomic_fetch_add(p, v, __ATOMIC_RELAXED, __HIP_MEMORY_SCOPE_AGENT); }
__device__ __forceinline__ unsigned xb_xcc_id() { return (unsigned)__builtin_amdgcn_s_getreg((3 << 11) | 20) & 0xFu; }
#define XB_SPIN(cond, bar) do { unsigned _sp = 0; while (cond) { __builtin_amdgcn_s_sleep(1); \
    if ((++_sp & 255u) == 0u) { if (xb_ld(&(bar)[XB_TMO])) break; if (_sp > XB_SPIN_CAP) { atomicAdd(&(bar)[XB_TMO], 1u); break; } } } } while (0)
struct XcdBarrier { unsigned* bar; unsigned x; volatile LAS unsigned* st; };
__device__ __forceinline__ XcdBarrier xcd_barrier_post(unsigned* bar, volatile LAS unsigned* st) {
    XcdBarrier b; b.bar = bar; b.x = xb_xcc_id(); b.st = st;
    if (threadIdx.x == 0) (void)xb_add(&bar[XB_XCNT(b.x)], 1u);
    return b;
}
__device__ __forceinline__ void xcd_barrier_complete(unsigned* bar, unsigned x, unsigned& nloc, unsigned& nx) {
    const unsigned G = gridDim.x * gridDim.y * gridDim.z;
    unsigned sum, cnt, mine, sp = 0u;
    for (;;) {
        sum = 0u; cnt = 0u; mine = 0u;
#pragma unroll
        for (unsigned j = 0; j < 16; ++j) { const unsigned c = xb_ld(&bar[XB_XCNT(j)]); sum += c; cnt += (c > 0u) ? 1u : 0u; mine = (j == x) ? c : mine; }
        if (sum == G) break;
        __builtin_amdgcn_s_sleep(1);
        if ((++sp & 255u) == 0u) { if (xb_ld(&bar[XB_TMO])) break; if (sp > XB_SPIN_CAP) { atomicAdd(&bar[XB_TMO], 1u); break; } }
    }
    nloc = mine > 0u ? mine : 1u; nx = cnt > 0u ? cnt : 1u;
}
__device__ __forceinline__ void xcd_barrier(const XcdBarrier& b_) {
    XcdBarrier b = b_; { const unsigned long long v = (unsigned long long)b.bar; unsigned lo = __builtin_amdgcn_readfirstlane((unsigned)v), hi = __builtin_amdgcn_readfirstlane((unsigned)(v >> 32)); asm volatile("" : "+s"(lo), "+s"(hi)); b.bar = (unsigned*)(((unsigned long long)hi << 32) | lo); unsigned xx = __builtin_amdgcn_readfirstlane(b.x); asm volatile("" : "+s"(xx)); b.x = xx; }
    asm volatile("s_waitcnt vmcnt(0)" ::: "memory");
    __syncthreads();
    if (threadIdx.x == 0) {
        unsigned* bar = b.bar;
        __builtin_amdgcn_s_waitcnt(0);
        unsigned nloc = b.st[0], nx = b.st[1];
        if (nloc == 0u) { xcd_barrier_complete(bar, b.x, nloc, nx); b.st[0] = nloc; b.st[1] = nx; }
        const unsigned old = xb_add(&bar[XB_XSUB(b.x)], 1u);
        const unsigned gen = old / nloc;
        if (old + 1u == (gen + 1u) * nloc) {
            __builtin_amdgcn_fence(__ATOMIC_RELEASE, "agent");
            asm volatile("s_waitcnt vmcnt(0)" ::: "memory");
            const unsigned og = xb_add(&bar[XB_TOP], 1u);
            const unsigned tg = og / nx;
            if (og + 1u == (tg + 1u) * nx) xb_add(&bar[XB_TOPGEN], 1u);
            else XB_SPIN(xb_ld(&bar[XB_TOPGEN]) == tg, bar);
            __builtin_amdgcn_fence(__ATOMIC_ACQUIRE, "agent");
            xb_add(&bar[XB_XGEN(b.x)], 1u);
            asm volatile("s_waitcnt vmcnt(0)" ::: "memory");
        } else {
            XB_SPIN(xb_ld(&bar[XB_XGEN(b.x)]) == gen, bar);
            __builtin_amdgcn_fence(__ATOMIC_ACQUIRE, "agent");
            asm volatile("s_waitcnt vmcnt(0)" ::: "memory");
        }
    }
    __syncthreads();
}

namespace pg8 {
constexpr int BM = 256, BK = 64, HALF = 128, HTB = HALF * BK * 2, STAGE_BYTES = 8 * HTB, NXCD = 8, WGM = 8;
__host__ __device__ __forceinline__ int lds_byte(int r, int c) { const int st = (r >> 4) * 2 + (c >> 5), rr = r & 15, cc = c & 31, ob = rr * 64 + cc * 2; return st * 1024 + (ob ^ (((ob >> 9) & 1) << 5)); }
__host__ __device__ __forceinline__ void stage_rc(int b, int& R, int& C) { const int st = b / 1024, sb = b % 1024, swz = sb ^ (((sb >> 9) & 1) << 5); R = (st >> 1) * 16 + swz / 64; C = (st & 1) * 32 + (swz % 64) / 2; }
__host__ __device__ __forceinline__ int perm32(int rho) { const int n = rho >> 4, i = rho & 15; return 8 * (i >> 2) + 4 * n + (i & 3); }
struct Unit { int pm, pn; const char* a; const char* b; };

struct StaticOrder {
    int nM, nN, nwg, G, c, K; const char* A; const char* B;
    __device__ void init(const bf16_t* A_, const bf16_t* B_, int M, int N, int K_, int G_, int c_) { A = (const char*)A_; B = (const char*)B_; K = K_; nM = M / BM; nN = N / BM; nwg = nM * nN; G = G_; c = c_; }
    __device__ bool next(int i, Unit& u) const {
        const long L = (long)i * G + c; if (L >= nwg) return false;
        int wgid = (int)L; { const int q = nwg / NXCD, r = nwg % NXCD, xcd = wgid % NXCD, off = wgid / NXCD; wgid = (xcd < r ? xcd * (q + 1) : r * (q + 1) + (xcd - r) * q) + off; }
        const int nig = WGM * nN, gid = wgid / nig, fm = gid * WGM, gsz = (nM - fm) < WGM ? (nM - fm) : WGM;
        u.pm = fm + ((wgid % nig) % gsz); u.pn = (wgid % nig) / gsz;
        u.a = A + (size_t)u.pm * 256 * K * 2; u.b = B + (size_t)u.pn * 256 * K * 2; return true;
    }
};

template <class Epi, class Sched>
__device__ __forceinline__ void gemm_phase(LAS unsigned char* lds, const int K_, const Sched& S, const Epi& E) {
    int K = K_; asm volatile("" : "+s"(K));
    int tid_ = threadIdx.x; asm volatile("" : "+v"(tid_));
    const int tid = tid_, wid = __builtin_amdgcn_readfirstlane(tid >> 6), lane = tid & 63, wr = wid >> 2, wc = wid & 3, fr = lane & 15, fq = lane >> 4;
    const int nt = K / BK;
    unsigned voffA[2], voffB[2];
#pragma unroll
    for (int i = 0; i < 2; ++i) { int R, C; stage_rc(tid * 16 + i * 8192, R, C); const int Rb = Epi::PERM ? ((R & ~31) + perm32(R & 31)) : R;
        voffA[i] = (unsigned)(R * K + C) * 2u; voffB[i] = (unsigned)(Rb * K + C) * 2u; }
    const size_t kstep = (size_t)(BK * 2);
    const size_t hstep = (size_t)HALF * K * 2;
    const unsigned ldsw = (unsigned)wid * 1024u;
    const int aoff = lds_byte(wr * 64 + fr, fq * 8), boff = lds_byte(wc * 32 + fr, fq * 8);
#define PG8_SA(b, h) (((b) * 2 + (h)) * HTB)
#define PG8_SB(b, h) ((4 + (b) * 2 + (h)) * HTB)
#define PG8_STAGE(bufoff, gbase, voff) do { _Pragma("unroll") for (int _i = 0; _i < 2; ++_i) \
        __builtin_amdgcn_global_load_lds((const unsigned*)((const char*)(gbase) + (voff)[_i]), (LAS unsigned*)(lds + (bufoff) + ldsw + _i * 8192), 16, 0, 0); } while (0)
#define PG8_LDA(dst, b, h) do { _Pragma("unroll") for (int m = 0; m < 4; ++m) _Pragma("unroll") for (int k = 0; k < 2; ++k) dst[m][k] = *(const LAS bf16x8*)(lds + PG8_SA(b, h) + aoff + m * 2048 + k * 1024); } while (0)
#define PG8_LDB(dst, b, h) do { _Pragma("unroll") for (int n = 0; n < 2; ++n) _Pragma("unroll") for (int k = 0; k < 2; ++k) dst[n][k] = *(const LAS bf16x8*)(lds + PG8_SB(b, h) + boff + n * 2048 + k * 1024); } while (0)
#define PG8_MMA(ai, bj, At, Bt) do { __builtin_amdgcn_s_setprio(1); _Pragma("unroll") for (int m = 0; m < 4; ++m) _Pragma("unroll") for (int n = 0; n < 2; ++n) _Pragma("unroll") for (int k = 0; k < 2; ++k) \
        acc[ai][bj][m][n] = __builtin_amdgcn_mfma_f32_16x16x32_bf16(Bt[n][k], At[m][k], acc[ai][bj][m][n], 0, 0, 0); __builtin_amdgcn_s_setprio(0); } while (0)
#define PG8_WAIT_V(n) asm volatile("s_waitcnt vmcnt(" #n ")" ::: "memory")
#define PG8_WAIT_L(n) asm volatile("s_waitcnt lgkmcnt(" #n ")" ::: "memory")
#define PG8_BAR __builtin_amdgcn_s_barrier()
#define PG8_SCHED __builtin_amdgcn_sched_barrier(0)
    Unit cur, nxt; int ui = 0;
    if (!S.next(0, cur)) return;
    f32x4 acc[2][2][4][2];
#pragma unroll
    for (int a = 0; a < 2; ++a)
#pragma unroll
        for (int b = 0; b < 2; ++b)
#pragma unroll
            for (int m = 0; m < 4; ++m)
#pragma unroll
                for (int n = 0; n < 2; ++n) acc[a][b][m][n] = (f32x4){0.f, 0.f, 0.f, 0.f};
    bf16x8 At[4][2], B0[2][2], B1[2][2];
    const char* cA = cur.a; const char* cB = cur.b;
    PG8_STAGE(PG8_SB(0, 0), cB, voffB); PG8_STAGE(PG8_SA(0, 0), cA, voffA); PG8_STAGE(PG8_SB(0, 1), cB + hstep, voffB); PG8_STAGE(PG8_SA(0, 1), cA + hstep, voffA);
    if (wr == 1) PG8_BAR;
    PG8_WAIT_V(4); PG8_BAR;
    PG8_STAGE(PG8_SB(1, 0), cB + kstep, voffB); PG8_STAGE(PG8_SA(1, 0), cA + kstep, voffA); PG8_STAGE(PG8_SB(1, 1), cB + hstep + kstep, voffB);
    PG8_WAIT_V(6); PG8_BAR;
    for (;;) {
        const bool has_next = S.next(ui + 1, nxt);
        const char* nA = has_next ? nxt.a : cA; const char* nB = has_next ? nxt.b : cB;
        for (int t = 0; t < nt; t += 2) {
            const bool last = (t == nt - 2);
            const char* a1 = cA + (size_t)(t + 1) * kstep;
            const char* a2 = last ? nA : cA + (size_t)(t + 2) * kstep; const char* b2 = last ? nB : cB + (size_t)(t + 2) * kstep;
            const char* a3 = a2 + kstep; const char* b3 = b2 + kstep;
            PG8_LDB(B0, 0, 0); PG8_SCHED; PG8_LDA(At, 0, 0); PG8_STAGE(PG8_SA(1, 1), a1 + hstep, voffA);
            PG8_WAIT_L(8); PG8_BAR; PG8_WAIT_L(0); PG8_MMA(0, 0, At, B0); PG8_BAR; PG8_SCHED;
            PG8_LDB(B1, 0, 1); PG8_STAGE(PG8_SB(0, 0), b2, voffB);
            PG8_BAR; PG8_WAIT_L(0); PG8_MMA(0, 1, At, B1); PG8_BAR;
            PG8_LDA(At, 0, 1); PG8_STAGE(PG8_SA(0, 0), a2, voffA);
            PG8_BAR; PG8_WAIT_L(0); PG8_MMA(1, 0, At, B0); PG8_BAR; PG8_SCHED;
            PG8_STAGE(PG8_SB(0, 1), b2 + hstep, voffB);
            PG8_WAIT_V(6); PG8_BAR; PG8_MMA(1, 1, At, B1); PG8_BAR;
            PG8_LDB(B0, 1, 0); PG8_SCHED; PG8_LDA(At, 1, 0); PG8_STAGE(PG8_SA(0, 1), a2 + hstep, voffA);
            PG8_WAIT_L(8); PG8_BAR; PG8_WAIT_L(0); PG8_MMA(0, 0, At, B0); PG8_BAR; PG8_SCHED;
            PG8_LDB(B1, 1, 1); PG8_STAGE(PG8_SB(1, 0), b3, voffB);
            PG8_BAR; PG8_WAIT_L(0); PG8_MMA(0, 1, At, B1); PG8_BAR;
            PG8_LDA(At, 1, 1); PG8_STAGE(PG8_SA(1, 0), a3, voffA);
            PG8_BAR; PG8_WAIT_L(0); PG8_MMA(1, 0, At, B0); PG8_BAR; PG8_SCHED;
            PG8_STAGE(PG8_SB(1, 1), b3 + hstep, voffB);
            PG8_WAIT_V(6); PG8_BAR; PG8_MMA(1, 1, At, B1); PG8_BAR;
        }
        E(acc, cur, wr, wc, fr, fq);
        if (!has_next) break;
#pragma unroll
        for (int a = 0; a < 2; ++a)
#pragma unroll
            for (int b = 0; b < 2; ++b)
#pragma unroll
                for (int m = 0; m < 4; ++m)
#pragma unroll
                    for (int n = 0; n < 2; ++n) acc[a][b][m][n] = (f32x4){0.f, 0.f, 0.f, 0.f};
        cur = nxt; cA = nA; cB = nB; ++ui;
    }
    PG8_WAIT_V(0);
    if (wr == 0) PG8_BAR;
    PG8_BAR;
#undef PG8_SA
#undef PG8_SB
#undef PG8_STAGE
#undef PG8_LDA
#undef PG8_LDB
#undef PG8_MMA
#undef PG8_WAIT_V
#undef PG8_WAIT_L
#undef PG8_BAR
#undef PG8_SCHED
}

struct EpiBf16 {
    static constexpr bool PERM = true;
    bf16_t* O; int ldc;
    __device__ __forceinline__ void operator()(const f32x4 (&acc)[2][2][4][2], const Unit& u, int wr, int wc, int fr, int fq) const {
        const int row0 = u.pm * BM + wr * 64 + fr, col0 = u.pn * BM + wc * 32 + 8 * fq;
#pragma unroll
        for (int ai = 0; ai < 2; ++ai)
#pragma unroll
            for (int m = 0; m < 4; ++m) { bf16_t* rowp = O + (size_t)(row0 + ai * HALF + m * 16) * ldc + col0;
#pragma unroll
                for (int bj = 0; bj < 2; ++bj) { const f32x4 v0 = acc[ai][bj][m][0], v1 = acc[ai][bj][m][1];
                    u32x4 w; w.x = cvt_pk_bf16(v0[0], v0[1]); w.y = cvt_pk_bf16(v0[2], v0[3]); w.z = cvt_pk_bf16(v1[0], v1[1]); w.w = cvt_pk_bf16(v1[2], v1[3]);
                    *(u32x4*)(rowp + bj * HALF) = w; } }
    }
};
struct EpiResid {
    static constexpr bool PERM = false;
    float* C; int ldc;
    __device__ __forceinline__ void operator()(const f32x4 (&acc)[2][2][4][2], const Unit& u, int wr, int wc, int fr_, int fq_) const {
        int fr = fr_, fq = fq_; asm volatile("" : "+v"(fr), "+v"(fq));
        const int row0 = u.pm * BM + wr * 64 + fr, col0 = u.pn * BM + wc * 32 + 4 * fq;
#pragma unroll
        for (int ai = 0; ai < 2; ++ai)
#pragma unroll
            for (int mp = 0; mp < 2; ++mp) { f32x4 cv[2][2][2];
#pragma unroll
                for (int mm = 0; mm < 2; ++mm) { const float* rowp = C + (size_t)(row0 + ai * HALF + (2 * mp + mm) * 16) * ldc + col0;
#pragma unroll
                    for (int bj = 0; bj < 2; ++bj)
#pragma unroll
                        for (int n = 0; n < 2; ++n) cv[mm][bj][n] = *(const f32x4*)(rowp + bj * HALF + n * 16); }
#pragma unroll
                for (int mm = 0; mm < 2; ++mm) { float* rowp = C + (size_t)(row0 + ai * HALF + (2 * mp + mm) * 16) * ldc + col0;
#pragma unroll
                    for (int bj = 0; bj < 2; ++bj)
#pragma unroll
                        for (int n = 0; n < 2; ++n) *(f32x4*)(rowp + bj * HALF + n * 16) = cv[mm][bj][n] + acc[ai][bj][2 * mp + mm][n]; }
                asm volatile("" ::: "memory"); }
    }
};
template <int ACT  > struct EpiGated {
    static constexpr bool PERM = true;
    bf16_t* O; int ldo; int coloff; const float* ba; const float* bb;
    __device__ __forceinline__ void operator()(const f32x4 (&acc)[2][2][4][2], const Unit& u, int wr, int wc, int fr, int fq) const {
        const int row0 = u.pm * BM + wr * 64 + fr, cl = u.pn * HALF + wc * 32 + 8 * fq;
        float va[8], vb[8];
#pragma unroll
        for (int j = 0; j < 8; ++j) { va[j] = (ACT == 0) ? ba[cl + j] : 0.f; vb[j] = (ACT == 0) ? bb[cl + j] : 0.f; }
#pragma unroll
        for (int ai = 0; ai < 2; ++ai)
#pragma unroll
            for (int m = 0; m < 4; ++m) { bf16_t* rowp = O + (size_t)(row0 + ai * HALF + m * 16) * ldo + coloff + cl;
                float o[8];
#pragma unroll
                for (int n = 0; n < 2; ++n)
#pragma unroll
                    for (int j = 0; j < 4; ++j) { const float a = acc[ai][0][m][n][j] + va[4 * n + j], b = acc[ai][1][m][n][j] + vb[4 * n + j];
                        o[4 * n + j] = (ACT == 0) ? a * sigmoidf_(b) : siluf_(a) * b; }
                u32x4 w; w.x = cvt_pk_bf16(o[0], o[1]); w.y = cvt_pk_bf16(o[2], o[3]); w.z = cvt_pk_bf16(o[4], o[5]); w.w = cvt_pk_bf16(o[6], o[7]);
                *(u32x4*)rowp = w; asm volatile("" ::: "memory"); }
    }
};
struct EpiMoeOut {
    static constexpr bool PERM = true;
    bf16_t* O; const int* row_tok; const float* row_w; LAS unsigned char* lds;
    __device__ __forceinline__ void operator()(const f32x4 (&acc)[2][2][4][2], const Unit& u, int wr, int wc, int fr_, int fq_) const {
        int fr = fr_, fq = fq_; asm volatile("" : "+v"(fr), "+v"(fq));
        const int col0 = u.pn * BM + wc * 32 + 8 * fq, lane = fq * 16 + fr;
        LAS u32x2* rinfo = (LAS u32x2*)(lds + STAGE_BYTES) + (wr * 4 + wc) * 128;
        { const int ra = u.pm * BM + wr * 64 + lane, rb = ra + HALF;
          const u32x2 ia = (u32x2){(unsigned)row_tok[ra], __float_as_uint(row_w[ra])}, ib = (u32x2){(unsigned)row_tok[rb], __float_as_uint(row_w[rb])};
          rinfo[lane] = ia; rinfo[64 + lane] = ib; }
#pragma unroll
        for (int ai = 0; ai < 2; ++ai)
#pragma unroll
            for (int m = 0; m < 4; ++m) { const u32x2 inf = rinfo[ai * 64 + m * 16 + fr]; const int ts = (int)inf.x; const float w = __uint_as_float(inf.y);
                if (ts >= 0) { bf16_t* rowp = O + ((size_t)(ts & 1) * NTOK + (size_t)(ts >> 1)) * DM + col0;
#pragma unroll
                    for (int bj = 0; bj < 2; ++bj) { const f32x4 v0 = acc[ai][bj][m][0] * w, v1 = acc[ai][bj][m][1] * w;
                        u32x4 q; q.x = cvt_pk_bf16(v0[0], v0[1]); q.y = cvt_pk_bf16(v0[2], v0[3]); q.z = cvt_pk_bf16(v1[0], v1[1]); q.w = cvt_pk_bf16(v1[2], v1[3]);
                        *(u32x4*)(rowp + bj * HALF) = q; } } }
    }
};
struct MoeOrder {
    int nN, G, c, K; const char* A; const char* B; size_t bstride; const int* tiles;
    __device__ bool next(int i, Unit& u) const {
        const int nrt = tiles[0]; const long L = (long)i * G + c; if (L >= (long)nrt * nN) return false;
        u.pm = (int)(L / nN); u.pn = (int)(L % nN); const int e = tiles[64 + u.pm];
        u.a = A + (size_t)u.pm * 256 * K * 2; u.b = B + (size_t)e * bstride + (size_t)u.pn * 256 * K * 2; return true;
    }
};
}

struct Params { const float* in[44]; float* out; unsigned char* ws; int ph_lo, ph_hi; };
enum { I_X = 0, I_NORM1, I_WIN, I_MCONVW, I_MCONVB, I_MDTB, I_MALOG, I_MD, I_MNORM, I_RMU, I_RW0, I_RW2, I_RA0, I_RA2, I_RG2, I_RKK, I_RKA, I_RRK, I_RLNW, I_RLNB,
       I_CKVN, I_CWUK, I_CWUV, I_RELB, I_SARE, I_SAIM, I_SBRE, I_SBIM, I_SCRE, I_SCIM, I_SD, I_SLOGDT, I_SGLUW, I_SGLUB, I_WOUT, I_NORM2, I_WRG, I_BRG, I_WRE, I_BRE,
       I_WGATE, I_WUP, I_WDOWN, I_FNORM };

typedef const float* const __attribute__((address_space(4)))* in_tab_t;
struct Frame {
    LAS unsigned char* lds; int tid, lane, wave, bid, G;
    in_tab_t in; float* out; unsigned char* ws; unsigned* ctl;
    volatile LAS int* misc;
};

__device__ __forceinline__ int q_pop(Frame& F, int qi) {
    __syncthreads();
    if (F.tid == 0) F.misc[0] = (int)__hip_atomic_fetch_add(F.ctl + CW_Q + 64 * qi, 1u, __ATOMIC_RELAXED, __HIP_MEMORY_SCOPE_AGENT);
    __syncthreads();
    return F.misc[0];
}

__device__ __forceinline__ const void* opaque_ptr(const void* p) { const unsigned long long v = (unsigned long long)p; unsigned lo = __builtin_amdgcn_readfirstlane((unsigned)v), hi = __builtin_amdgcn_readfirstlane((unsigned)(v >> 32));
    asm volatile("" : "+s"(lo), "+s"(hi)); return (const void*)(((unsigned long long)hi << 32) | lo); }
__device__ __forceinline__ Frame relocal(const Frame& G) { Frame F = G; asm volatile("" : "+v"(F.tid)); F.ws = (unsigned char*)opaque_ptr(F.ws); F.ctl = (unsigned*)(F.ws + WS_CTL); F.in = (in_tab_t)(unsigned long long)opaque_ptr((const void*)(unsigned long long)F.in); F.lane = F.tid & 63; F.wave = __builtin_amdgcn_readfirstlane(F.tid >> 6); return F; }
template <int K> __device__ __forceinline__ f32x4 mma_nt(const LAS bf16_t* A, int lda, const LAS bf16_t* Bt, int ldb, f32x4 acc, int lane) {
    const int r = lane & 15, g = lane >> 4;
#pragma unroll
    for (int k0 = 0; k0 < K; k0 += 32) {
        const bf16x8 a = *(const LAS bf16x8*)(A + r * lda + k0 + 8 * g);
        const bf16x8 b = *(const LAS bf16x8*)(Bt + r * ldb + k0 + 8 * g);
        acc = __builtin_amdgcn_mfma_f32_16x16x32_bf16(a, b, acc, 0, 0, 0);
    }
    return acc;
}

template <class SrcMap> __device__ __forceinline__ void tr_tile(Frame& F, int ldsrc, bf16_t* dst, int K, int k0, int n0, SrcMap sm) {
    LAS float* tile = (LAS float*)F.lds;
    __syncthreads();
    { const int n4 = (F.tid & 63) * 4, kk = F.tid >> 6; const float* sp = sm(n0 + n4);
      f32x4 v[8];
#pragma unroll
      for (int ps = 0; ps < 8; ++ps) { v[ps] = (f32x4){0.f, 0.f, 0.f, 0.f}; if (sp) v[ps] = *(const f32x4*)(sp + (size_t)(k0 + kk + 8 * ps) * ldsrc); }
#pragma unroll
      for (int ps = 0; ps < 8; ++ps) { LAS float* t = tile + (kk + 8 * ps) * 257 + n4; t[0] = v[ps][0]; t[1] = v[ps][1]; t[2] = v[ps][2]; t[3] = v[ps][3]; } }
    __syncthreads();
    { const int kc = F.tid & 7;
#pragma unroll
      for (int j = 0; j < 4; ++j) { const int n = (F.tid >> 3) + 64 * j; float f[8];
#pragma unroll
          for (int i = 0; i < 8; ++i) f[i] = tile[(8 * kc + i) * 257 + n];
          u32x4 w; w.x = pk2(f[0], f[1]); w.y = pk2(f[2], f[3]); w.z = pk2(f[4], f[5]); w.w = pk2(f[6], f[7]);
          *(u32x4*)(dst + (size_t)(n0 + n) * K + k0 + 8 * kc) = w; } }
}

struct SmIn { const float* base; __device__ __forceinline__ const float* operator()(int n) const {
    int c; if (n < 772) c = n; else if (n < UR) return nullptr; else if (n < UR + 896) c = 772 + (n - UR); else if (n < UC) return nullptr;
    else if (n < UC + 680) c = 1668 + (n - UC); else if (n < US) return nullptr; else if (n < US + 256) c = 2348 + (n - US); else return nullptr; return base + c; } };
struct SmId { const float* base; __device__ __forceinline__ const float* operator()(int n) const { return base + n; } };
struct SmGlu { const float* base; __device__ __forceinline__ const float* operator()(int n) const { const int pn = n >> 8, rr = n & 255; return base + (rr < 128 ? 128 * pn + rr : 256 + 128 * pn + (rr - 128)); } };
struct SmGU { const float* gate; const float* up; __device__ __forceinline__ const float* operator()(int n) const {
    const unsigned long long d = (unsigned long long)up - (unsigned long long)gate; const unsigned long long a = (unsigned long long)gate + (((n & 255) < 128) ? 0ull : d); return (const float*)a + 128 * (n >> 8) + (n & 127); } };
__device__ __forceinline__ void phase_prologue(const Frame& F_) { Frame F = relocal(F_);
    for (int t = F.bid; t < 496; t += F.G) {
        if (t < 352) { const int l = t / 176, r = t % 176, kt = r / 11, nt = r % 11;
            tr_tile(F, NIN, (bf16_t*)(F.ws + WS_WIN) + (size_t)l * NINP * DM, DM, kt * 64, nt * 256, SmIn{F.in[I_WIN] + (size_t)l * DM * NIN}); }
        else if (t < 480) { const int q = t - 352, l = q / 64, r = q % 64, kt = r / 4, nt = r % 4;
            tr_tile(F, DM, (bf16_t*)(F.ws + WS_WOUT) + (size_t)l * DM * DM, DM, kt * 64, nt * 256, SmId{F.in[I_WOUT] + (size_t)l * DM * DM}); }
        else { const int q = t - 480, l = q / 8, r = q % 8, kt = r / 2, nt = r % 2;
            tr_tile(F, 512, (bf16_t*)(F.ws + WS_GLU) + (size_t)l * 512 * 256, 256, kt * 64, nt * 256, SmGlu{F.in[I_SGLUW] + (size_t)l * 256 * 512}); }
    }
    for (int i = F.bid * NTHR + F.tid; i < 2 * 48 * 1024; i += F.G * NTHR) { const int l = i / 49152, r = i % 49152, o = r >> 10, k = r & 1023;
        float v = 0.f; if (o < 32) v = F.in[I_WRE][((size_t)l * DM + k) * 32 + o]; else if (o < 36) v = F.in[I_WRG][((size_t)l * DM + k) * 4 + (o - 32)];
        v *= F.in[I_NORM2][l * DM + k];
        const bf16_t hi = f2bf(v); const bf16_t lo = f2bf(v - bf2f(hi));
        bf16_t* w = (bf16_t*)(F.ws + WS_WRT) + (size_t)l * 2 * 49152; w[r] = hi; w[49152 + r] = lo; }
    for (int i = F.bid * NTHR + F.tid; i < 2048 + 65536; i += F.G * NTHR) {
        if (i < 2048) {
            const int l = i >> 10, gn = i & 1023, g = gn >> 6;
            float* tab = (float*)(F.ws + WS_S5TAB + (size_t)l * S5TAB_L);
            const float lre = fminf(F.in[I_SARE][l * 1024 + gn], -1e-4f), lim = F.in[I_SAIM][l * 1024 + gn];
            const float dt = expf(F.in[I_SLOGDT][l * 16 + g]);
            const float mag = expf(dt * lre); float sn, cs; sincosf(dt * lim, &sn, &cs);
            const float are = mag * cs, aim = mag * sn;
            const float den = lre * lre + lim * lim;
            const float fre = ((are - 1.0f) * lre + aim * lim) / den, fim = (aim * lre - (are - 1.0f) * lim) / den;
            tab[gn * 2] = are; tab[gn * 2 + 1] = aim;
            float pr = are, pi = aim;
#pragma unroll
            for (int s = 0; s < 6; ++s) { const float nr = pr * pr - pi * pi, ni = 2.0f * pr * pi; pr = nr; pi = ni; }
            tab[2048 + gn * 2] = pr; tab[2048 + gn * 2 + 1] = pi;
            const float* bre = F.in[I_SBRE] + ((size_t)l * 1024 + gn) * 16; const float* bim = F.in[I_SBIM] + ((size_t)l * 1024 + gn) * 16;
            bf16_t* bbt = (bf16_t*)(F.ws + WS_S5TAB + (size_t)l * S5TAB_L + S5TAB_BBT); const int n = gn & 63, col = 4 * (n & 31) + 2 * (n >> 5);
            for (int p = 0; p < 16; ++p) { const float vr = fre * bre[p] - fim * bim[p], vi = fre * bim[p] + fim * bre[p];
                bbt[((size_t)g * 128 + col) * 16 + p] = f2bf(vr); bbt[((size_t)g * 128 + col + 1) * 16 + p] = f2bf(vi); }
        } else {
            const int j = i - 2048, l = j >> 15, r = j & 32767, gp = r >> 7, k = r & 127;
            bf16_t* cm = (bf16_t*)(F.ws + WS_S5TAB + (size_t)l * S5TAB_L + S5TAB_F);
            const int n = (k >> 2) + 32 * ((k >> 1) & 1);
            const float v = (k & 1) == 0 ? F.in[I_SCRE][((size_t)l * 256 + gp) * 64 + n] : -F.in[I_SCIM][((size_t)l * 256 + gp) * 64 + n];
            cm[r] = f2bf(v);
        }
    }
}

__device__ __forceinline__ void phase_norm(const Frame& F_, const float* xin, bool add_o, const float* w, int mode) { Frame F = relocal(F_);
    float* X = (float*)(F.ws + WS_X); bf16_t* H = (bf16_t*)(F.ws + WS_H); const bf16_t* O = (const bf16_t*)(F.ws + WS_U);
    for (int row0 = F.bid * 32 + F.wave * 4; row0 < NTOK; row0 += F.G * 32) {
        f32x4 v[4][4]; u32x2 oa[4][4], ob[4][4];
#pragma unroll
        for (int r = 0; r < 4; ++r)
#pragma unroll
            for (int j = 0; j < 4; ++j) { const int c = 4 * F.lane + 256 * j; const size_t o = (size_t)(row0 + r) * DM + c; v[r][j] = *(const f32x4*)(xin + o);
                if (add_o) { oa[r][j] = *(const u32x2*)(O + o); ob[r][j] = *(const u32x2*)(O + (size_t)NTOK * DM + o); } }
#pragma unroll
        for (int r = 0; r < 4; ++r) { const int row = row0 + r; float ss = 0.f;
#pragma unroll
            for (int j = 0; j < 4; ++j) {
                if (add_o) { const u32x2 a = oa[r][j], b = ob[r][j];
                    v[r][j][0] += __uint_as_float(a.x << 16) + __uint_as_float(b.x << 16); v[r][j][1] += __uint_as_float(a.x & 0xffff0000u) + __uint_as_float(b.x & 0xffff0000u);
                    v[r][j][2] += __uint_as_float(a.y << 16) + __uint_as_float(b.y << 16); v[r][j][3] += __uint_as_float(a.y & 0xffff0000u) + __uint_as_float(b.y & 0xffff0000u); }
                ss += v[r][j][0] * v[r][j][0] + v[r][j][1] * v[r][j][1] + v[r][j][2] * v[r][j][2] + v[r][j][3] * v[r][j][3]; }
            ss = wave_sum(ss);
            const float rstd = rsqrtf(ss * (1.0f / DM) + 1e-6f);
#pragma unroll
            for (int j = 0; j < 4; ++j) { const int c = 4 * F.lane + 256 * j; const f32x4 wv = *(const f32x4*)(w + c);
                if (mode == 2) { *(f32x4*)(F.out + (size_t)row * DM + c) = v[r][j] * rstd * wv; }
                else { *(f32x4*)(X + (size_t)row * DM + c) = v[r][j];
                    u32x2 o; o.x = pk2(v[r][j][0] * rstd * wv[0], v[r][j][1] * rstd * wv[1]); o.y = pk2(v[r][j][2] * rstd * wv[2], v[r][j][3] * rstd * wv[3]);
                    *(u32x2*)(H + (size_t)row * DM + c) = o; } } }
    }
}

__device__ __forceinline__ void item_kv(const Frame& F_, int layer, int item) { Frame F = relocal(F_);
    const bf16_t* U = (const bf16_t*)(F.ws + WS_U);
    LAS bf16_t* Ab = (LAS bf16_t*)F.lds;
    LAS bf16_t* Bt = (LAS bf16_t*)(F.lds + 17408);
    const int t0 = item * 64;
    { const int tok = F.tid >> 3, part = F.tid & 7; const bf16_t* src = U + (size_t)(t0 + tok) * NINP + UC + 256 + 16 * part;
      float f[16]; { float a[8], b[8]; unpack8(*(const u32x4*)src, a); unpack8(*(const u32x4*)(src + 8), b);
#pragma unroll
        for (int j = 0; j < 8; ++j) { f[j] = a[j]; f[8 + j] = b[j]; } }
      float ss = 0.f;
#pragma unroll
      for (int j = 0; j < 16; ++j) ss += f[j] * f[j];
      ss = sum8(ss);
      const float rstd = rsqrtf(ss * (1.0f / 128.0f) + 1e-6f); const float* nw = F.in[I_CKVN] + layer * 128 + 16 * part;
#pragma unroll
      for (int j = 0; j < 16; j += 2) *(LAS unsigned*)(Ab + tok * 136 + 16 * part + j) = pk2(f[j] * rstd * nw[j], f[j + 1] * rstd * nw[j + 1]); }
    { const int n = F.tid >> 2, kq = F.tid & 3; const float* w = (n < 64 ? F.in[I_CWUK] : F.in[I_CWUV]) + (size_t)layer * 128 * 64 + (n & 63);
      float wv[32];
#pragma unroll
      for (int k = 0; k < 32; ++k) wv[k] = w[(size_t)(32 * kq + k) * 64];
#pragma unroll
      for (int k = 0; k < 32; k += 2) *(LAS unsigned*)(Bt + n * 136 + 32 * kq + k) = pk2(wv[k], wv[k + 1]); }
    if (F.tid < 256) { const int tok = F.tid >> 2, q = F.tid & 3;
        *(u32x4*)((bf16_t*)(F.ws + WS_KIDX) + (size_t)(t0 + tok) * 32 + 8 * q) = *(const u32x4*)(U + (size_t)(t0 + tok) * NINP + UC + 640 + 8 * q); }
    __syncthreads();
    const int mt = F.wave & 3, g = F.lane >> 4, r = F.lane & 15;
#pragma unroll
    for (int q = 0; q < 4; ++q) { const int nt = (F.wave >> 2) * 4 + q;
        f32x4 acc = (f32x4){0.f, 0.f, 0.f, 0.f};
        acc = mma_nt<128>(Ab + mt * 16 * 136, 136, Bt + nt * 16 * 136, 136, acc, F.lane);
        const int n = nt * 16 + r; bf16_t* dst = (bf16_t*)(F.ws + (n < 64 ? WS_K : WS_V));
#pragma unroll
        for (int i = 0; i < 4; ++i) dst[(size_t)(t0 + mt * 16 + 4 * g + i) * 64 + (n & 63)] = f2bf(acc[i]); }
}

constexpr int MB_CG = 0, MB_BG = 18432, MB_BT = 36864, MB_XT = 55296, MB_M = 92160, MB_S0 = 101376, MB_DT = 110592, MB_AC = 111616, MB_RS = 112640;
template <int STAGE> __device__ __forceinline__ void item_mamba(const Frame& F_, int layer, int item) { Frame F = relocal(F_);
    const bf16_t* U = (const bf16_t*)(F.ws + WS_U);
    const int b = item >> 6, c = item & 63, l0 = c * 64; const size_t T0 = (size_t)b * SEQ + l0;
    LAS bf16_t* Cg = (LAS bf16_t*)(F.lds + MB_CG); LAS bf16_t* Bg = (LAS bf16_t*)(F.lds + MB_BG); LAS bf16_t* BT = (LAS bf16_t*)(F.lds + MB_BT);
    LAS bf16_t* XT = (LAS bf16_t*)(F.lds + MB_XT); LAS bf16_t* Mb = (LAS bf16_t*)(F.lds + MB_M); LAS bf16_t* S0 = (LAS bf16_t*)(F.lds + MB_S0);
    LAS float* dts = (LAS float*)(F.lds + MB_DT); LAS float* acs = (LAS float*)(F.lds + MB_AC); LAS float* rs = (LAS float*)(F.lds + MB_RS);
    if (F.tid < 256) { const int l = F.tid >> 2, h = F.tid & 3;
        const float raw = bf2f(U[(T0 + l) * NINP + UM + 768 + h]) + F.in[I_MDTB][layer * 4 + h];
        const float dt = softplusf_(raw); dts[l * 4 + h] = dt; acs[l * 4 + h] = -__expf(F.in[I_MALOG][layer * 4 + h]) * dt; }
    if (F.tid < 64) rs[F.tid] = 0.f;
    __syncthreads();
    float mycum = 0.f;
    if (F.tid < 256) { const int l = F.tid >> 2, h = F.tid & 3; for (int s = 0; s <= l; ++s) mycum += acs[s * 4 + h]; }
    __syncthreads();
    if (F.tid < 256) acs[F.tid] = mycum;
    __syncthreads();
    { const int ch8 = F.tid & 63, tg = F.tid >> 6, c0 = ch8 * 8;
      float wv[4][8], bv[8];
#pragma unroll
      for (int j = 0; j < 8; ++j) { bv[j] = F.in[I_MCONVB][layer * 512 + c0 + j];
#pragma unroll
          for (int k = 0; k < 4; ++k) wv[k][j] = F.in[I_MCONVW][(layer * 4 + k) * 512 + c0 + j]; }
      float win[3][8];
#pragma unroll
      for (int k = 0; k < 3; ++k) { const int l = l0 + tg * 8 - 3 + k;
          if (l >= 0) unpack8(*(const u32x4*)(U + ((size_t)b * SEQ + l) * NINP + UM + 256 + c0), win[k]);
          else {
#pragma unroll
              for (int j = 0; j < 8; ++j) win[k][j] = 0.f; } }
#pragma unroll 1
      for (int ib = 0; ib < 2; ++ib) { u32x4 rows[4];
#pragma unroll
          for (int i4 = 0; i4 < 4; ++i4) rows[i4] = *(const u32x4*)(U + (T0 + tg * 8 + ib * 4 + i4) * NINP + UM + 256 + c0);
#pragma unroll
      for (int i4 = 0; i4 < 4; ++i4) { const int l = tg * 8 + ib * 4 + i4; float cur[8]; unpack8(rows[i4], cur);
          float o[8];
#pragma unroll
          for (int j = 0; j < 8; ++j) { o[j] = siluf_(bv[j] + wv[0][j] * win[0][j] + wv[1][j] * win[1][j] + wv[2][j] * win[2][j] + wv[3][j] * cur[j]);
              win[0][j] = win[1][j]; win[1][j] = win[2][j]; win[2][j] = cur[j]; }
          if (c0 < 256) { const int h = c0 >> 6, p0 = c0 & 63; float sc = dts[l * 4 + h]; if (STAGE == 1) sc *= __expf(acs[63 * 4 + h] - acs[l * 4 + h]);
#pragma unroll
              for (int j = 0; j < 8; ++j) XT[(h * 64 + p0 + j) * 72 + l] = f2bf(o[j] * sc); }
          else if (c0 < 384) { const int g = (c0 - 256) >> 6, n0 = (c0 - 256) & 63;
              if (STAGE == 1) {
#pragma unroll
                  for (int j = 0; j < 8; ++j) BT[(g * 64 + n0 + j) * 72 + l] = f2bf(o[j]); }
              else { u32x4 w; w.x = pk2(o[0], o[1]); w.y = pk2(o[2], o[3]); w.z = pk2(o[4], o[5]); w.w = pk2(o[6], o[7]); *(LAS u32x4*)(Bg + (g * 64 + l) * 72 + n0) = w; } }
          else if (STAGE == 2) { const int g = (c0 - 384) >> 6, n0 = (c0 - 384) & 63;
              u32x4 w; w.x = pk2(o[0], o[1]); w.y = pk2(o[2], o[3]); w.z = pk2(o[4], o[5]); w.w = pk2(o[6], o[7]); *(LAS u32x4*)(Cg + (g * 64 + l) * 72 + n0) = w; } } } }
    __syncthreads();
    const int g4 = F.lane >> 4, r16 = F.lane & 15;
    if (STAGE == 1) {
        float* MST = (float*)(F.ws + WS_MST) + ((size_t)(b * 64 + c) * 4) * 4096;
#pragma unroll
        for (int q = 0; q < 8; ++q) { const int tix = F.wave * 8 + q, h = tix >> 4, mt = (tix >> 2) & 3, nt = tix & 3;
            f32x4 acc = (f32x4){0.f, 0.f, 0.f, 0.f};
            acc = mma_nt<64>(XT + (h * 64 + mt * 16) * 72, 72, BT + ((h >> 1) * 64 + nt * 16) * 72, 72, acc, F.lane);
#pragma unroll
            for (int i = 0; i < 4; ++i) MST[(size_t)h * 4096 + (mt * 16 + 4 * g4 + i) * 64 + nt * 16 + r16] = acc[i]; }
        if (F.tid < 4) ((float*)(F.ws + WS_MDEC))[(b * 64 + c) * 4 + F.tid] = __expf(acs[63 * 4 + F.tid]);
    } else {
        const int mt = F.wave & 3, nh = F.wave >> 2;
        const float* MST = (const float*)(F.ws + WS_MST) + ((size_t)(b * 64 + c) * 4) * 4096;
        f32x4 G[2], yv[4][2];
#pragma unroll
        for (int h = 0; h < 4; ++h) {
            const int g = h >> 1;
            { const float* src = MST + (size_t)h * 4096 + F.tid * 8; const f32x4 a = *(const f32x4*)src, bq = *(const f32x4*)(src + 4);
              u32x4 w; w.x = pk2(a[0], a[1]); w.y = pk2(a[2], a[3]); w.z = pk2(bq[0], bq[1]); w.w = pk2(bq[2], bq[3]);
              *(LAS u32x4*)(S0 + (F.tid >> 3) * 72 + (F.tid & 7) * 8) = w; }
            if ((h & 1) == 0) {
#pragma unroll
                for (int q = 0; q < 2; ++q) { G[q] = (f32x4){0.f, 0.f, 0.f, 0.f};
                    G[q] = mma_nt<64>(Cg + (g * 64 + mt * 16) * 72, 72, Bg + (g * 64 + (2 * nh + q) * 16) * 72, 72, G[q], F.lane); } }
#pragma unroll
            for (int q = 0; q < 2; ++q) { const int s = (2 * nh + q) * 16 + r16; const float as = acs[s * 4 + h];
#pragma unroll
                for (int i = 0; i < 4; ++i) { const int l = mt * 16 + 4 * g4 + i; const float v = (s <= l) ? G[q][i] * __expf(acs[l * 4 + h] - as) : 0.f;
                    Mb[l * 72 + s] = f2bf(v); } }
            __syncthreads();
#pragma unroll
            for (int q = 0; q < 2; ++q) { const int nt = 2 * nh + q;
                f32x4 yd = (f32x4){0.f, 0.f, 0.f, 0.f}, yo = (f32x4){0.f, 0.f, 0.f, 0.f};
                yd = mma_nt<64>(Mb + mt * 16 * 72, 72, XT + (h * 64 + nt * 16) * 72, 72, yd, F.lane);
                yo = mma_nt<64>(Cg + (g * 64 + mt * 16) * 72, 72, S0 + nt * 16 * 72, 72, yo, F.lane);
                const int p = nt * 16 + r16; const float dsk = F.in[I_MD][layer * 4 + h];
#pragma unroll
                for (int i = 0; i < 4; ++i) { const int l = mt * 16 + 4 * g4 + i;
                    const float xs = bf2f(XT[(h * 64 + p) * 72 + l]) / dts[l * 4 + h];
                    yv[h][q][i] = yd[i] + yo[i] * __expf(acs[l * 4 + h]) + dsk * xs; } }
            __syncthreads();
        }
        float part[4] = {0.f, 0.f, 0.f, 0.f};
#pragma unroll
        for (int h = 0; h < 4; ++h)
#pragma unroll
            for (int q = 0; q < 2; ++q) { const int ch = h * 64 + (2 * nh + q) * 16 + r16;
#pragma unroll
                for (int i = 0; i < 4; ++i) { const int l = mt * 16 + 4 * g4 + i; const float z = bf2f(U[(T0 + l) * NINP + UM + ch]);
                    const float v = yv[h][q][i] * siluf_(z); yv[h][q][i] = v; part[i] += v * v; } }
#pragma unroll
        for (int i = 0; i < 4; ++i) { const float s = sum16(part[i]); if (r16 == 0) atomicAdd((float*)(rs + mt * 16 + 4 * g4 + i), s); }
        __syncthreads();
        bf16_t* Y = (bf16_t*)(F.ws + WS_H);
#pragma unroll
        for (int i = 0; i < 4; ++i) { const int l = mt * 16 + 4 * g4 + i; const float rstd = rsqrtf(rs[l] * (1.0f / 256.0f) + 1e-6f);
#pragma unroll
            for (int h = 0; h < 4; ++h)
#pragma unroll
                for (int q = 0; q < 2; ++q) { const int ch = h * 64 + (2 * nh + q) * 16 + r16;
                    Y[(T0 + l) * DM + ch] = f2bf(yv[h][q][i] * rstd * F.in[I_MNORM][layer * 256 + ch]); } }
    }
}
__device__ __forceinline__ void item_mamba_carry(const Frame& F_, int item) { Frame F = relocal(F_);
    const int b = item >> 2, h = item & 3;
    float* MST = (float*)(F.ws + WS_MST); const float* MD = (const float*)(F.ws + WS_MDEC);
    float s[8];
#pragma unroll
    for (int j = 0; j < 8; ++j) s[j] = 0.f;
    for (int c = 0; c < 64; ++c) { float* p = MST + ((size_t)(b * 64 + c) * 4 + h) * 4096 + F.tid * 8; const float d = MD[(b * 64 + c) * 4 + h];
        const f32x4 a = *(f32x4*)p, q = *(f32x4*)(p + 4);
        *(f32x4*)p = (f32x4){s[0], s[1], s[2], s[3]}; *(f32x4*)(p + 4) = (f32x4){s[4], s[5], s[6], s[7]};
        s[0] = s[0] * d + a[0]; s[1] = s[1] * d + a[1]; s[2] = s[2] * d + a[2]; s[3] = s[3] * d + a[3];
        s[4] = s[4] * d + q[0]; s[5] = s[5] * d + q[1]; s[6] = s[6] * d + q[2]; s[7] = s[7] * d + q[3]; }
}

template <int STAGE> __device__ __forceinline__ void item_s5(const Frame& F_, int layer, int item) { Frame F = relocal(F_);
    const bf16_t* U = (const bf16_t*)(F.ws + WS_U);
    const int b = item >> 6, c = item & 63; const size_t T0 = (size_t)b * SEQ + c * 64;
    LAS bf16_t* us = (LAS bf16_t*)F.lds;
    LAS bf16_t* BuW = (LAS bf16_t*)(F.lds + 33792) + F.wave * 4224;
    const float* tab = (const float*)(F.ws + WS_S5TAB + (size_t)layer * S5TAB_L);
    { const int tok = F.tid >> 3, part = F.tid & 7;
#pragma unroll
      for (int q = 0; q < 4; ++q) *(LAS u32x4*)(us + tok * 264 + 32 * part + 8 * q) = *(const u32x4*)(U + (T0 + tok) * NINP + US + 32 * part + 8 * q); }
    const int lane = F.lane, r16 = lane & 15, g4 = lane >> 4, gq = lane >> 5, n0 = lane & 31, g = 2 * F.wave + gq, gn0 = g * 64 + n0, gn1 = gn0 + 32;
    bf16x8 bfr[2][8];
    { const bf16_t* bbt = (const bf16_t*)(F.ws + WS_S5TAB + (size_t)layer * S5TAB_L + S5TAB_BBT);
#pragma unroll
      for (int gg = 0; gg < 2; ++gg)
#pragma unroll
          for (int nt = 0; nt < 8; ++nt) { u32x4 z = (u32x4){0u, 0u, 0u, 0u}; if (g4 < 2) z = *(const u32x4*)(bbt + ((size_t)(2 * F.wave + gg) * 128 + 16 * nt + r16) * 16 + 8 * g4); bfr[gg][nt] = __builtin_bit_cast(bf16x8, z); } }
    const float a0r = tab[gn0 * 2], a0i = tab[gn0 * 2 + 1], a1r = tab[gn1 * 2], a1i = tab[gn1 * 2 + 1];
    float* ST = (float*)(F.ws + WS_S5ST) + (size_t)(b * 64 + c) * 2048;
    float h0r = 0.f, h0i = 0.f, h1r = 0.f, h1i = 0.f;
    if (STAGE == 2) { h0r = ST[gn0 * 2]; h0i = ST[gn0 * 2 + 1]; h1r = ST[gn1 * 2]; h1i = ST[gn1 * 2 + 1]; }
    bf16x8 cf[2][4];
    if (STAGE == 2) { const bf16_t* cm = (const bf16_t*)(F.ws + WS_S5TAB + (size_t)layer * S5TAB_L + S5TAB_F);
#pragma unroll
        for (int gg = 0; gg < 2; ++gg)
#pragma unroll
            for (int ks = 0; ks < 4; ++ks) cf[gg][ks] = *(const bf16x8*)(cm + ((size_t)((2 * F.wave + gg) * 16 + r16)) * 128 + 32 * ks + 8 * g4); }
    __syncthreads();
#pragma unroll 1
    for (int lb = 0; lb < 4; ++lb) {
#pragma unroll
        for (int gg = 0; gg < 2; ++gg) { u32x4 z = (u32x4){0u, 0u, 0u, 0u}; if (g4 < 2) z = *(const LAS u32x4*)(us + (16 * lb + r16) * 264 + (2 * F.wave + gg) * 16 + 8 * g4);
            const bf16x8 afr = __builtin_bit_cast(bf16x8, z);
#pragma unroll
            for (int nt = 0; nt < 8; ++nt) { const f32x4 acc = __builtin_amdgcn_mfma_f32_16x16x32_bf16(afr, bfr[gg][nt], (f32x4){0.f, 0.f, 0.f, 0.f}, 0, 0, 0);
#pragma unroll
                for (int i = 0; i < 4; ++i) BuW[(4 * g4 + i) * 264 + gg * 128 + 16 * nt + r16] = f2bf(acc[i]); } }
        __syncthreads();
#pragma unroll 4
        for (int li = 0; li < 16; ++li) { LAS u32x2* bp = (LAS u32x2*)(BuW + li * 264 + gq * 128 + 4 * n0); const u32x2 v = *bp;
            { const float br = __uint_as_float(v.x << 16), bi = __uint_as_float(v.x & 0xffff0000u); const float nr = a0r * h0r - a0i * h0i + br, ni = a0r * h0i + a0i * h0r + bi; h0r = nr; h0i = ni; }
            { const float br = __uint_as_float(v.y << 16), bi = __uint_as_float(v.y & 0xffff0000u); const float nr = a1r * h1r - a1i * h1i + br, ni = a1r * h1i + a1i * h1r + bi; h1r = nr; h1i = ni; }
            if (STAGE == 2) *bp = (u32x2){pk2(h0r, h0i), pk2(h1r, h1i)}; }
        __syncthreads();
        if (STAGE == 2) {
            bf16_t* YS = (bf16_t*)(F.ws + WS_MOE + YSG_OFF);
#pragma unroll
            for (int gg = 0; gg < 2; ++gg) { f32x4 acc = (f32x4){0.f, 0.f, 0.f, 0.f};
#pragma unroll
                for (int ks = 0; ks < 4; ++ks) { const bf16x8 a = *(const LAS bf16x8*)(BuW + r16 * 264 + gg * 128 + 32 * ks + 8 * g4);
                    acc = __builtin_amdgcn_mfma_f32_16x16x32_bf16(a, cf[gg][ks], acc, 0, 0, 0); }
                const int ch = (2 * F.wave + gg) * 16 + r16; const float dsk = F.in[I_SD][layer * 256 + ch];
#pragma unroll
                for (int i = 0; i < 4; ++i) { const int l = lb * 16 + 4 * g4 + i; const float y = acc[i] + dsk * bf2f(us[l * 264 + ch]);
                    YS[(T0 + l) * 256 + ch] = f2bf(gelu_tanh(y)); } }
            __syncthreads();
        }
    }
    if (STAGE == 1) { ST[gn0 * 2] = h0r; ST[gn0 * 2 + 1] = h0i; ST[gn1 * 2] = h1r; ST[gn1 * 2 + 1] = h1i; }
    if (STAGE == 2) {
        asm volatile("s_waitcnt vmcnt(0)" ::: "memory"); __syncthreads();
        const bf16_t* YS = (const bf16_t*)(F.ws + WS_MOE + YSG_OFF) + T0 * 256; const bf16_t* GW = (const bf16_t*)(F.ws + WS_GLU) + (size_t)layer * 512 * 256;
        const int r16 = F.lane & 15, g4 = F.lane >> 4;
        f32x4 av[4][2], ag[4][2];
#pragma unroll
        for (int m = 0; m < 4; ++m)
#pragma unroll
            for (int q = 0; q < 2; ++q) { av[m][q] = (f32x4){0.f, 0.f, 0.f, 0.f}; ag[m][q] = (f32x4){0.f, 0.f, 0.f, 0.f}; }
#pragma unroll 2
        for (int ks = 0; ks < 8; ++ks) {
            bf16x8 af[4], bv[2], bg[2];
#pragma unroll
            for (int m = 0; m < 4; ++m) af[m] = *(const bf16x8*)(YS + (size_t)(16 * m + r16) * 256 + 32 * ks + 8 * g4);
#pragma unroll
            for (int q = 0; q < 2; ++q) { const int c = 32 * F.wave + 16 * q + r16; const int rowv = 256 * (c >> 7) + (c & 127);
                bv[q] = *(const bf16x8*)(GW + (size_t)rowv * 256 + 32 * ks + 8 * g4); bg[q] = *(const bf16x8*)(GW + (size_t)(rowv + 128) * 256 + 32 * ks + 8 * g4); }
#pragma unroll
            for (int m = 0; m < 4; ++m)
#pragma unroll
                for (int q = 0; q < 2; ++q) { av[m][q] = __builtin_amdgcn_mfma_f32_16x16x32_bf16(af[m], bv[q], av[m][q], 0, 0, 0); ag[m][q] = __builtin_amdgcn_mfma_f32_16x16x32_bf16(af[m], bg[q], ag[m][q], 0, 0, 0); }
        }
        bf16_t* Y = (bf16_t*)(F.ws + WS_H);
#pragma unroll
        for (int q = 0; q < 2; ++q) { const int c = 32 * F.wave + 16 * q + r16; const float bvl = F.in[I_SGLUB][layer * 512 + c], bgt = F.in[I_SGLUB][layer * 512 + 256 + c];
#pragma unroll
            for (int m = 0; m < 4; ++m)
#pragma unroll
                for (int i = 0; i < 4; ++i) Y[(T0 + 16 * m + 4 * g4 + i) * DM + 768 + c] = f2bf((av[m][q][i] + bvl) * sigmoidf_(ag[m][q][i] + bgt)); }
    }
}
__device__ __forceinline__ void item_s5_carry(const Frame& F_, int layer, int b) { Frame F = relocal(F_);
    const float* tab = (const float*)(F.ws + WS_S5TAB + (size_t)layer * S5TAB_L) + 2048;
    float* ST = (float*)(F.ws + WS_S5ST) + (size_t)b * 64 * 2048;
#pragma unroll
    for (int q = 0; q < 2; ++q) { const int gn = F.tid + 512 * q; const float pr = tab[gn * 2], pi = tab[gn * 2 + 1]; float hr = 0.f, hi = 0.f;
        for (int c = 0; c < 64; ++c) { float* p = ST + (size_t)c * 2048 + gn * 2; const float tr = p[0], ti = p[1]; p[0] = hr; p[1] = hi;
            const float nr = pr * hr - pi * hi + tr, ni = pr * hi + pi * hr + ti; hr = nr; hi = ni; } }
}

constexpr int RB_LD = 72;
constexpr int RW_R = 0, RW_K = 16384, RW_V = 32768, RW_W = 49152, RW_A = 65536, RW_B = 81920;
constexpr int R3_G = 49152, R3_O = 65536, R3_TILES = 81920, R3_BON = 147456;
template <int STAGE> __device__ __forceinline__ void rwkv_prep(const Frame& F_, int layer, int b, int h, int c) { Frame F = relocal(F_);
    const bf16_t* U = (const bf16_t*)(F.ws + WS_U);
    const int l0 = c * 64; const size_t T0 = (size_t)b * SEQ + l0;
    LAS float* Rr = (LAS float*)(F.lds + RW_R); LAS float* Kk = (LAS float*)(F.lds + RW_K); LAS float* Vv = (LAS float*)(F.lds + RW_V); LAS float* Ww = (LAS float*)(F.lds + RW_W);
    LAS float* Aa = (LAS float*)(F.lds + (STAGE == 1 ? RW_A : R3_O)); LAS float* Bb = (LAS float*)(F.lds + RW_B); LAS float* Gg = (LAS float*)(F.lds + R3_G); LAS float* BON = (LAS float*)(F.lds + R3_BON);
    LAS bf16_t* TWb = (LAS bf16_t*)(F.lds + 98304); LAS bf16_t* DAb = (LAS bf16_t*)(F.lds + (STAGE == 1 ? 103424 : 118784)); LAS bf16_t* SGb = (LAS bf16_t*)(F.lds + 123904);
    LAS bf16_t* w2T = (LAS bf16_t*)(F.lds + 108544); LAS bf16_t* a2T = (LAS bf16_t*)(F.lds + (STAGE == 1 ? 113664 : 133120)); LAS bf16_t* g2T = (LAS bf16_t*)(F.lds + 138240);
    const float* mu = F.in[I_RMU] + layer * 896;
    { const int tok = F.tid >> 3, p8 = F.tid & 7; const bool first = (l0 + tok == 0);
      const bf16_t* cur = U + (T0 + tok) * NINP + UR; const bf16_t* prv = first ? cur : cur - NINP;
      const float pz = first ? 0.f : 1.f;
      u32x4 cw[3], pw[3]; u32x2 c1 = (u32x2){0u, 0u}, p1 = (u32x2){0u, 0u}, c2 = (u32x2){0u, 0u}, p2 = (u32x2){0u, 0u}; u32x4 c3 = (u32x4){0u, 0u, 0u, 0u}, p3 = (u32x4){0u, 0u, 0u, 0u};
#pragma unroll
      for (int sec = (STAGE == 1 ? 0 : 2); sec < 3; ++sec) { const int co = sec * 256 + h * 64 + 8 * p8; cw[sec] = *(const u32x4*)(cur + co); pw[sec] = *(const u32x4*)(prv + co); }
      if (STAGE == 1) { c1 = *(const u32x2*)(cur + 768 + 4 * p8); p1 = *(const u32x2*)(prv + 768 + 4 * p8); c2 = *(const u32x2*)(cur + 800 + 4 * p8); p2 = *(const u32x2*)(prv + 800 + 4 * p8); }
      if (STAGE == 3) { c3 = *(const u32x4*)(cur + 832 + 8 * p8); p3 = *(const u32x4*)(prv + 832 + 8 * p8); }
#pragma unroll
      for (int sec = (STAGE == 1 ? 0 : 2); sec < 3; ++sec) { const int co = sec * 256 + h * 64 + 8 * p8; float av[8], pq[8]; unpack8(cw[sec], av); unpack8(pw[sec], pq);
          const f32x4 m0 = *(const f32x4*)(mu + co), m1 = *(const f32x4*)(mu + co + 4);
          LAS float* dst = (sec == 0 ? Rr : sec == 1 ? Kk : Vv) + tok * 64 + 8 * p8;
#pragma unroll
          for (int j = 0; j < 8; ++j) pq[j] *= pz;
          *(LAS f32x4*)dst = (f32x4){av[0] + m0[0] * (pq[0] - av[0]), av[1] + m0[1] * (pq[1] - av[1]), av[2] + m0[2] * (pq[2] - av[2]), av[3] + m0[3] * (pq[3] - av[3])};
          *(LAS f32x4*)(dst + 4) = (f32x4){av[4] + m1[0] * (pq[4] - av[4]), av[5] + m1[1] * (pq[5] - av[5]), av[6] + m1[2] * (pq[6] - av[6]), av[7] + m1[3] * (pq[7] - av[7])}; }
      if (STAGE == 1) {
#pragma unroll
        for (int which = 0; which < 2; ++which) { const int co = 768 + 32 * which + 4 * p8; const u32x2 cv = which ? c2 : c1, pv = which ? p2 : p1;
          const f32x4 m0 = *(const f32x4*)(mu + co);
          float x[4] = {__uint_as_float(cv.x << 16), __uint_as_float(cv.x & 0xffff0000u), __uint_as_float(cv.y << 16), __uint_as_float(cv.y & 0xffff0000u)};
          const float y[4] = {pz * __uint_as_float(pv.x << 16), pz * __uint_as_float(pv.x & 0xffff0000u), pz * __uint_as_float(pv.y << 16), pz * __uint_as_float(pv.y & 0xffff0000u)};
#pragma unroll
          for (int j = 0; j < 4; ++j) { x[j] = x[j] + m0[j] * (y[j] - x[j]); if (which == 0) x[j] = tanhf_(x[j]); }
          *(LAS u32x2*)((which ? DAb : TWb) + tok * 40 + 4 * p8) = (u32x2){pk2(x[0], x[1]), pk2(x[2], x[3])}; } }
      if (STAGE == 3) { const int co = 832 + 8 * p8; float av[8], pq[8]; unpack8(c3, av); unpack8(p3, pq);
          const f32x4 m0 = *(const f32x4*)(mu + co), m1 = *(const f32x4*)(mu + co + 4); float x[8];
#pragma unroll
          for (int j = 0; j < 8; ++j) x[j] = sigmoidf_(av[j] + (j < 4 ? m0[j] : m1[j - 4]) * (pz * pq[j] - av[j]));
          *(LAS u32x4*)(SGb + tok * RB_LD + 8 * p8) = (u32x4){pk2(x[0], x[1]), pk2(x[2], x[3]), pk2(x[4], x[5]), pk2(x[6], x[7])}; } }
    { const int ch = F.tid & 63, part = F.tid >> 6;
      if (STAGE == 1) { const float* w2 = F.in[I_RW2] + ((size_t)layer * 32 + 4 * part) * 256 + h * 64 + ch;
          *(LAS u32x2*)(w2T + ch * 40 + 4 * part) = (u32x2){pk2(w2[0], w2[256]), pk2(w2[512], w2[768])}; }
      if (STAGE == 1) { const float* a2 = F.in[I_RA2] + ((size_t)layer * 32 + 4 * part) * 256 + h * 64 + ch;
          *(LAS u32x2*)(a2T + ch * 40 + 4 * part) = (u32x2){pk2(a2[0], a2[256]), pk2(a2[512], a2[768])}; }
      if (STAGE == 3) { const float* g2 = F.in[I_RG2] + ((size_t)layer * 64 + 8 * part) * 256 + h * 64 + ch;
          *(LAS u32x4*)(g2T + ch * RB_LD + 8 * part) = (u32x4){pk2(g2[0], g2[256]), pk2(g2[512], g2[768]), pk2(g2[1024], g2[1280]), pk2(g2[1536], g2[1792])}; } }
    __syncthreads();
    { const int lane = F.lane, mt = F.wave >> 1, nt0 = 2 * (F.wave & 1), r = lane & 15, g4 = lane >> 4; const f32x4 zero4 = (f32x4){0.f, 0.f, 0.f, 0.f};
#pragma unroll
      for (int q = 0; q < 2; ++q) { const int nt = nt0 + q, ch = 16 * nt + r, cg = layer * 256 + h * 64 + ch;
          if (STAGE == 1) { const f32x4 wl = mma_nt<32>(TWb + 16 * mt * 40, 40, w2T + 16 * nt * 40, 40, zero4, lane); const float w0 = F.in[I_RW0][cg];
#pragma unroll
              for (int i = 0; i < 4; ++i) { const float x = w0 + wl[i]; const float wlog = -__logf(1.0f + __expf(-x)) - 0.5f; Ww[(16 * mt + 4 * g4 + i) * 64 + ch] = __expf(-__expf(wlog)); } }
          if (STAGE == 1) { const f32x4 al = mma_nt<32>(DAb + 16 * mt * 40, 40, a2T + 16 * nt * 40, 40, zero4, lane); const float a0 = F.in[I_RA0][cg];
#pragma unroll
              for (int i = 0; i < 4; ++i) Aa[(16 * mt + 4 * g4 + i) * 64 + ch] = sigmoidf_(a0 + al[i]); }
          if (STAGE == 3) { const f32x4 gv = mma_nt<64>(SGb + 16 * mt * RB_LD, RB_LD, g2T + 16 * nt * RB_LD, RB_LD, zero4, lane);
#pragma unroll
              for (int i = 0; i < 4; ++i) Gg[(16 * mt + 4 * g4 + i) * 64 + ch] = gv[i]; } } }
    __syncthreads();
    float* gBON = (float*)(F.ws + WS_BON) + ((size_t)(b * 4 + h) * 64 + c) * 64;
    if (STAGE == 1) { const int j = F.lane, tq = F.wave, cg = layer * 256 + h * 64 + j;
      const float kkw = F.in[I_RKK][cg], kaw = F.in[I_RKA][cg], rk = F.in[I_RRK][cg];
#pragma unroll 2
      for (int i8 = 0; i8 < 8; ++i8) { const int t = tq + 8 * i8;
          const float a = Aa[t * 64 + j]; const float kraw = Kk[t * 64 + j]; const float kp = kraw * (1.0f + (a - 1.0f) * kaw);
          Kk[t * 64 + j] = kp;
          const float kkv = kraw * kkw; const float ss = wave_sum(kkv * kkv); const float kkn = kkv * rsqrtf(fmaxf(ss, 1e-24f)); Aa[t * 64 + j] = -kkn; Bb[t * 64 + j] = kkn * a;
          const float bo = wave_sum(Rr[t * 64 + j] * kp * rk); if (j == 0) gBON[t] = bo; } }
    else if (F.tid < 64) BON[F.tid] = gBON[F.tid];
    __syncthreads();
}
constexpr int RB_AT = 98304, RB_ATT = RB_AT + 9216, RB_BT = RB_ATT + 9216, RB_BTT = RB_BT + 9216, RB_KT = RB_BTT + 9216, RB_RT = RB_KT + 9216, RB_VT = RB_RT + 9216, RB_GC = RB_VT + 9216;
constexpr int RX_X = 0, RX_XT = 9216, RX_TB = 18432, RX_M = 27648, RX_NRT = 36864, RX_G1T = 46080, RX_G2T = 55296, RX_QT = 64512;
__device__ __forceinline__ void st_tile(LAS bf16_t* dst, int mt, int nt, const f32x4 v, int lane) {
    const int r = lane & 15, g = lane >> 4;
#pragma unroll
    for (int i = 0; i < 4; ++i) dst[(16 * mt + 4 * g + i) * RB_LD + 16 * nt + r] = f2bf(v[i]);
}
__device__ __forceinline__ void st_tile_t(LAS bf16_t* dst, int mt, int nt, const f32x4 v, int lane) {
    const int r = lane & 15, g = lane >> 4; u32x2 w; w.x = pk2(v[0], v[1]); w.y = pk2(v[2], v[3]);
    *(LAS u32x2*)(dst + (16 * nt + r) * RB_LD + 16 * mt + 4 * g) = w;
}
__device__ __forceinline__ void item_rwkv1(const Frame& F_, int layer, int item) { Frame F = relocal(F_);
    const int b = item >> 8, h = (item >> 6) & 3, c = item & 63;
    rwkv_prep<1>(F, layer, b, h, c);
    LAS float* Rr = (LAS float*)(F.lds + RW_R); LAS float* Kk = (LAS float*)(F.lds + RW_K); LAS float* Vv = (LAS float*)(F.lds + RW_V); LAS float* Ww = (LAS float*)(F.lds + RW_W);
    LAS float* Aa = (LAS float*)(F.lds + RW_A); LAS float* Bb = (LAS float*)(F.lds + RW_B);
    LAS bf16_t* At = (LAS bf16_t*)(F.lds + RB_AT); LAS bf16_t* AtT = (LAS bf16_t*)(F.lds + RB_ATT); LAS bf16_t* Bt = (LAS bf16_t*)(F.lds + RB_BT); LAS bf16_t* BtT = (LAS bf16_t*)(F.lds + RB_BTT);
    LAS bf16_t* Kt = (LAS bf16_t*)(F.lds + RB_KT); LAS bf16_t* Rt = (LAS bf16_t*)(F.lds + RB_RT); LAS bf16_t* VT = (LAS bf16_t*)(F.lds + RB_VT); LAS float* gC = (LAS float*)(F.lds + RB_GC);
    LAS bf16_t* X = (LAS bf16_t*)(F.lds + RX_X); LAS bf16_t* XT = (LAS bf16_t*)(F.lds + RX_XT); LAS bf16_t* Tb = (LAS bf16_t*)(F.lds + RX_TB); LAS bf16_t* Mm = (LAS bf16_t*)(F.lds + RX_M);
    LAS bf16_t* NrT = (LAS bf16_t*)(F.lds + RX_NRT); LAS bf16_t* G1T = (LAS bf16_t*)(F.lds + RX_G1T); LAS bf16_t* G2T = (LAS bf16_t*)(F.lds + RX_G2T); LAS bf16_t* QT = (LAS bf16_t*)(F.lds + RX_QT);
    { const int k = F.tid & 63, part = F.tid >> 6; float g = 1.0f;
      for (int pp = 0; pp < part; ++pp) { float w8[8];
#pragma unroll
          for (int i = 0; i < 8; ++i) w8[i] = Ww[(8 * pp + i) * 64 + k];
          g *= ((w8[0] * w8[1]) * (w8[2] * w8[3])) * ((w8[4] * w8[5]) * (w8[6] * w8[7])); }
#pragma unroll
      for (int i = 0; i < 8; ++i) { const int t = 8 * part + i; const float gp = g; g *= Ww[t * 64 + k]; const float ig = 1.0f / g;
          const bf16_t av = f2bf(Aa[t * 64 + k] * gp), bv = f2bf(Bb[t * 64 + k] * ig);
          At[t * RB_LD + k] = av; AtT[k * RB_LD + t] = av; Bt[t * RB_LD + k] = bv; BtT[k * RB_LD + t] = bv;
          Kt[t * RB_LD + k] = f2bf(Kk[t * 64 + k] * ig); Rt[t * RB_LD + k] = f2bf(Rr[t * 64 + k] * g); VT[k * RB_LD + t] = f2bf(Vv[t * 64 + k]); }
      if (part == 7) gC[k] = g; }
    __syncthreads();
    const int lane = F.lane, mt = F.wave >> 1, nt0 = 2 * (F.wave & 1), r = lane & 15, g4 = lane >> 4;
    const f32x4 zero4 = (f32x4){0.f, 0.f, 0.f, 0.f};
    f32x4 Tacc[2];
#pragma unroll
    for (int q = 0; q < 2; ++q) { const int nt = nt0 + q;
        f32x4 n = mma_nt<64>(Bt + 16 * mt * RB_LD, RB_LD, At + 16 * nt * RB_LD, RB_LD, zero4, lane);
        f32x4 m = mma_nt<64>(Kt + 16 * mt * RB_LD, RB_LD, At + 16 * nt * RB_LD, RB_LD, zero4, lane);
        f32x4 nr = mma_nt<64>(Rt + 16 * mt * RB_LD, RB_LD, Bt + 16 * nt * RB_LD, RB_LD, zero4, lane);
#pragma unroll
        for (int i = 0; i < 4; ++i) { const int row = 16 * mt + 4 * g4 + i, col = 16 * nt + r;
            n[i] = (row < col) ? n[i] : 0.f; m[i] = (row < col) ? m[i] : 0.f; nr[i] = (col <= row) ? nr[i] : 0.f;
            Tacc[q][i] = n[i] + (row == col ? 1.0f : 0.f); }
        st_tile(X, mt, nt, n, lane); st_tile_t(XT, mt, nt, n, lane); st_tile(Tb, mt, nt, Tacc[q], lane); st_tile(Mm, mt, nt, m, lane); st_tile(NrT, mt, nt, nr, lane); }
    __syncthreads();
#pragma unroll 1
    for (int it = 0; it < 6; ++it) {
        LAS bf16_t* Xr = (it & 1) ? G1T : X; LAS bf16_t* XTr = (it & 1) ? G2T : XT; LAS bf16_t* Tr = (it & 1) ? QT : Tb;
        LAS bf16_t* Xw = (it & 1) ? X : G1T; LAS bf16_t* XTw = (it & 1) ? XT : G2T; LAS bf16_t* Tw = (it & 1) ? Tb : QT;
#pragma unroll
        for (int q = 0; q < 2; ++q) { const int nt = nt0 + q;
            if (it > 0) Tacc[q] = mma_nt<64>(Tr + 16 * mt * RB_LD, RB_LD, XTr + 16 * nt * RB_LD, RB_LD, Tacc[q], lane);
            if (it < 5) { const f32x4 x2 = mma_nt<64>(Xr + 16 * mt * RB_LD, RB_LD, XTr + 16 * nt * RB_LD, RB_LD, zero4, lane); st_tile(Xw, mt, nt, x2, lane); st_tile_t(XTw, mt, nt, x2, lane); }
            st_tile(Tw, mt, nt, Tacc[q], lane); }
        __syncthreads();
    }
#pragma unroll
    for (int q = 0; q < 2; ++q) { const int nt = nt0 + q;
        st_tile(G1T, mt, nt, mma_nt<64>(NrT + 16 * mt * RB_LD, RB_LD, Tb + 16 * nt * RB_LD, RB_LD, zero4, lane), lane);
        st_tile(G2T, mt, nt, mma_nt<64>(BtT + 16 * mt * RB_LD, RB_LD, Tb + 16 * nt * RB_LD, RB_LD, zero4, lane), lane); }
    __syncthreads();
    const size_t ci = (size_t)(b * 4 + h) * 64 + c;
    bf16_t* gPT = (bf16_t*)(F.ws + WS_MOE + RW_PT) + ci * 4096; bf16_t* gW1 = (bf16_t*)(F.ws + WS_MOE + RW_W1) + ci * 4096; bf16_t* gZ = (bf16_t*)(F.ws + WS_MOE + RW_Z) + ci * 4096;
#pragma unroll
    for (int q = 0; q < 2; ++q) { const int nt = nt0 + q; const int col = 16 * nt + r;
        f32x4 w1 = mma_nt<64>(G1T + 16 * mt * RB_LD, RB_LD, AtT + 16 * nt * RB_LD, RB_LD, zero4, lane);
        f32x4 z = mma_nt<64>(G1T + 16 * mt * RB_LD, RB_LD, Mm + 16 * nt * RB_LD, RB_LD, zero4, lane);
        f32x4 mr = mma_nt<64>(Rt + 16 * mt * RB_LD, RB_LD, Kt + 16 * nt * RB_LD, RB_LD, zero4, lane);
        f32x4 p = mma_nt<64>(G2T + 16 * mt * RB_LD, RB_LD, AtT + 16 * nt * RB_LD, RB_LD, zero4, lane);
        f32x4 qq = mma_nt<64>(G2T + 16 * mt * RB_LD, RB_LD, Mm + 16 * nt * RB_LD, RB_LD, zero4, lane);
        const int pos = 32 * (col >> 5) + 8 * ((col >> 2) & 3) + 4 * ((col >> 4) & 1) + (col & 3);
#pragma unroll
        for (int i = 0; i < 4; ++i) { const int row = 16 * mt + 4 * g4 + i;
            gW1[row * 64 + col] = f2bf(w1[i] + bf2f(Rt[row * RB_LD + col]));
            gZ[row * 64 + col] = f2bf(z[i] + (col <= row ? mr[i] : 0.f));
            const float gc = gC[row];
            gPT[row * 64 + pos] = f2bf((p[i] + (row == col ? 1.0f : 0.f)) * gc);
            qq[i] = (qq[i] + bf2f(Kt[col * RB_LD + row])) * gc; }
        st_tile(QT, mt, nt, qq, lane); }
    __syncthreads();
    bf16_t* gU = (bf16_t*)(F.ws + WS_MOE + RW_U) + ci * 4096;
#pragma unroll
    for (int q = 0; q < 2; ++q) { const int nt = nt0 + q;
        const f32x4 u = mma_nt<64>(VT + 16 * mt * RB_LD, RB_LD, QT + 16 * nt * RB_LD, RB_LD, zero4, lane);
#pragma unroll
        for (int i = 0; i < 4; ++i) gU[(16 * mt + 4 * g4 + i) * 64 + 16 * nt + r] = f2bf(u[i]); }
}
__device__ __forceinline__ void item_rwkv_carry(const Frame& F_, int item) { Frame F = relocal(F_);
    const int bh = item * 2 + (F.wave >> 2), nt = F.wave & 3, r = F.lane & 15, g = F.lane >> 4;
    const bf16_t* PT = (const bf16_t*)(F.ws + WS_MOE + RW_PT); const bf16_t* Uc = (const bf16_t*)(F.ws + WS_MOE + RW_U); bf16_t* Ss = (bf16_t*)(F.ws + WS_MOE + RW_S);
    f32x4 acc[4];
#pragma unroll
    for (int m = 0; m < 4; ++m) acc[m] = (f32x4){0.f, 0.f, 0.f, 0.f};
    for (int c = 0; c < 64; ++c) { const size_t ci = (size_t)bh * 64 + c;
        bf16x8 af[4][2]; f32x4 cin[4];
#pragma unroll
        for (int m = 0; m < 4; ++m) { const u32x2 uv = *(const u32x2*)(Uc + ci * 4096 + (16 * nt + r) * 64 + 16 * m + 4 * g);
            cin[m] = (f32x4){__uint_as_float(uv.x << 16), __uint_as_float(uv.x & 0xffff0000u), __uint_as_float(uv.y << 16), __uint_as_float(uv.y & 0xffff0000u)};
#pragma unroll
            for (int s = 0; s < 2; ++s) af[m][s] = *(const bf16x8*)(PT + ci * 4096 + (16 * m + r) * 64 + 32 * s + 8 * g); }
        unsigned pw[4][2];
#pragma unroll
        for (int m = 0; m < 4; ++m) { pw[m][0] = pk2(acc[m][0], acc[m][1]); pw[m][1] = pk2(acc[m][2], acc[m][3]);
            *(u32x2*)(Ss + ci * 4096 + (16 * nt + r) * 64 + 16 * m + 4 * g) = (u32x2){pw[m][0], pw[m][1]}; }
        bf16x8 bfr[2];
#pragma unroll
        for (int s = 0; s < 2; ++s) bfr[s] = __builtin_bit_cast(bf16x8, (u32x4){pw[2 * s][0], pw[2 * s][1], pw[2 * s + 1][0], pw[2 * s + 1][1]});
#pragma unroll
        for (int m = 0; m < 4; ++m) { acc[m] = __builtin_amdgcn_mfma_f32_16x16x32_bf16(af[m][0], bfr[0], cin[m], 0, 0, 0);
            acc[m] = __builtin_amdgcn_mfma_f32_16x16x32_bf16(af[m][1], bfr[1], acc[m], 0, 0, 0); }
    }
}
__device__ __forceinline__ void item_rwkv3(const Frame& F_, int layer, int item) { Frame F = relocal(F_);
    const int b = item >> 8, h = (item >> 6) & 3, c = item & 63; const size_t T0 = (size_t)b * SEQ + c * 64;
    rwkv_prep<3>(F, layer, b, h, c);
    LAS float* Vv = (LAS float*)(F.lds + RW_V); LAS float* Oo = (LAS float*)(F.lds + R3_O);
    LAS float* Gg = (LAS float*)(F.lds + R3_G); LAS float* BON = (LAS float*)(F.lds + R3_BON);
    LAS bf16_t* S0b = (LAS bf16_t*)(F.lds + R3_TILES); LAS bf16_t* W1b = S0b + 4608; LAS bf16_t* Zb = W1b + 4608; LAS bf16_t* VTb = Zb + 4608;
    { const size_t ci = (size_t)(b * 4 + h) * 64 + c; const int row = F.tid >> 3, col = (F.tid & 7) * 8;
      *(LAS u32x4*)(S0b + row * RB_LD + col) = *(const u32x4*)((const bf16_t*)(F.ws + WS_MOE + RW_S) + ci * 4096 + F.tid * 8);
      *(LAS u32x4*)(W1b + row * RB_LD + col) = *(const u32x4*)((const bf16_t*)(F.ws + WS_MOE + RW_W1) + ci * 4096 + F.tid * 8);
      *(LAS u32x4*)(Zb + row * RB_LD + col) = *(const u32x4*)((const bf16_t*)(F.ws + WS_MOE + RW_Z) + ci * 4096 + F.tid * 8);
      const int vv = F.tid & 63, part = F.tid >> 6;
#pragma unroll
      for (int i = 0; i < 8; ++i) { const int t = 8 * part + i; VTb[vv * RB_LD + t] = f2bf(Vv[t * 64 + vv]); } }
    __syncthreads();
    { const int lane = F.lane, mt = F.wave >> 1, nt0 = 2 * (F.wave & 1), r = lane & 15, g4 = lane >> 4;
#pragma unroll
      for (int q = 0; q < 2; ++q) { const int nt = nt0 + q;
          f32x4 o = mma_nt<64>(W1b + 16 * mt * RB_LD, RB_LD, S0b + 16 * nt * RB_LD, RB_LD, (f32x4){0.f, 0.f, 0.f, 0.f}, lane);
          o = mma_nt<64>(Zb + 16 * mt * RB_LD, RB_LD, VTb + 16 * nt * RB_LD, RB_LD, o, lane);
#pragma unroll
          for (int i = 0; i < 4; ++i) Oo[(16 * mt + 4 * g4 + i) * 64 + 16 * nt + r] = o[i]; } }
    __syncthreads();
    { const int j = F.lane, tq = F.wave, ch = h * 64 + j;
      const float lw = F.in[I_RLNW][layer * 256 + ch], lb = F.in[I_RLNB][layer * 256 + ch];
      bf16_t* Y = (bf16_t*)(F.ws + WS_H);
#pragma unroll 2
      for (int i8 = 0; i8 < 8; ++i8) { const int t = tq + 8 * i8;
          const float o = Oo[t * 64 + j]; const float mean = wave_sum(o) * (1.0f / 64.0f); const float d = o - mean; const float var = wave_sum(d * d) * (1.0f / 64.0f);
          float on = d * rsqrtf(var + 64e-5f) * lw + lb; on += BON[t] * Vv[t * 64 + j];
          Y[(T0 + t) * DM + 256 + ch] = f2bf(on * Gg[t * 64 + j]); } }
}

constexpr int DS_SEL = 131072, DS_HIST = 135168, DS_BKT = 151552, DS_BIAS = 152064;
__device__ __forceinline__ void dsa_tables(const Frame& F_) { Frame F = relocal(F_);
    LAS int* bkt = (LAS int*)(F.lds + DS_BKT); LAS float* biasT = (LAS float*)(F.lds + DS_BIAS);
    if (F.tid < 128) { const int n = F.tid; int bk = n; if (n >= 16) { const float lr = logf((float)n / 16.0f) / 2.0794415416798357f; bk = 16 + (int)(lr * 16.0f); bk = bk < 31 ? bk : 31; } bkt[n] = bk; biasT[n] = F.in[I_RELB][n]; }
    __syncthreads();
}
__device__ __forceinline__ unsigned fkey(float f) { const unsigned u = __float_as_uint(f); return (u & 0x80000000u) ? ~u : (u | 0x80000000u); }
__device__ __forceinline__ void item_dsa(const Frame& F_, int layer, int item) { Frame F = relocal(F_);
    const bf16_t* U = (const bf16_t*)(F.ws + WS_U); const bf16_t* KI = (const bf16_t*)(F.ws + WS_KIDX);
    const bf16_t* Kb = (const bf16_t*)(F.ws + WS_K); const bf16_t* Vb = (const bf16_t*)(F.ws + WS_V);
    const int b = item & 3, qg = 511 - (item >> 2); const size_t TB = (size_t)b * SEQ, T0 = TB + qg * 8;
    LAS float* sc = (LAS float*)F.lds; LAS unsigned short* selall = (LAS unsigned short*)(F.lds + DS_SEL); LAS unsigned* histall = (LAS unsigned*)(F.lds + DS_HIST);
    LAS int* bkt = (LAS int*)(F.lds + DS_BKT); LAS float* biasT = (LAS float*)(F.lds + DS_BIAS);
    const int lane = F.lane, hh = lane >> 5;
    {
        bf16x8 af[2][2]; float wq[2][2][8];
        { const int r = lane & 31, q4 = 2 * ((r >> 2) & 1) + (r >> 4), head = 4 * ((r >> 3) & 1) + (r & 3);
#pragma unroll
          for (int mt = 0; mt < 2; ++mt)
#pragma unroll
              for (int ks = 0; ks < 2; ++ks) af[mt][ks] = *(const bf16x8*)(U + (T0 + 4 * mt + q4) * NINP + UC + 384 + head * 32 + 16 * ks + 8 * hh); }
#pragma unroll
        for (int mt = 0; mt < 2; ++mt)
#pragma unroll
            for (int q2 = 0; q2 < 2; ++q2) { float f[8]; unpack8(*(const u32x4*)(U + (T0 + 4 * mt + 2 * hh + q2) * NINP + UC + 672), f);
#pragma unroll
                for (int hd = 0; hd < 8; ++hd) wq[mt][q2][hd] = f[hd]; }
        const int ntile = (qg * 8 + 8 + 31) >> 5;
        bf16x8 nb0 = af[0][0], nb1 = af[0][0];
        if (F.wave < ntile) { const int key = F.wave * 32 + (lane & 31); nb0 = *(const bf16x8*)(KI + (TB + key) * 32 + 8 * hh); nb1 = *(const bf16x8*)(KI + (TB + key) * 32 + 16 + 8 * hh); }
        for (int kt = F.wave; kt < ntile; kt += 8) {
            const int key = kt * 32 + (lane & 31);
            const bf16x8 b0 = nb0, b1 = nb1;
            if (kt + 8 < ntile) { const int k2 = key + 256; nb0 = *(const bf16x8*)(KI + (TB + k2) * 32 + 8 * hh); nb1 = *(const bf16x8*)(KI + (TB + k2) * 32 + 16 + 8 * hh); }
#pragma unroll
            for (int mt = 0; mt < 2; ++mt) { f32x16 acc;
#pragma unroll
                for (int i = 0; i < 16; ++i) acc[i] = 0.f;
                acc = __builtin_amdgcn_mfma_f32_32x32x16_bf16(af[mt][0], b0, acc, 0, 0, 0);
                acc = __builtin_amdgcn_mfma_f32_32x32x16_bf16(af[mt][1], b1, acc, 0, 0, 0);
#pragma unroll
                for (int q2 = 0; q2 < 2; ++q2) { float s = 0.f;
#pragma unroll
                    for (int hd = 0; hd < 8; ++hd) s += fmaxf(acc[8 * q2 + hd], 0.f) * wq[mt][q2][hd];
                    const int qi = 4 * mt + 2 * hh + q2;
                    sc[qi * 4096 + key] = (key <= qg * 8 + qi) ? s : -INFINITY; } }
        }
    }
    __syncthreads();
    const int qi = F.wave, tq = qg * 8 + qi, n = tq + 1;
    LAS float* scq = sc + qi * 4096; LAS unsigned short* sel = selall + qi * 256; LAS unsigned* hist = histall + qi * 512;
    int nsel;
    if (n <= 256) { nsel = n; for (int j = lane; j < 256; j += 64) sel[j] = (unsigned short)(j < n ? j : 0); }
    else {
        nsel = 256;
        const int R = (n + 63) >> 6; const unsigned long long ltm = (1ull << lane) - 1ull;
        float lo = INFINITY, hi = -INFINITY;
        const int R4 = (n + 255) >> 8;
#pragma unroll 4
        for (int i = 0; i < R4; ++i) { const int j0 = 256 * i + 4 * lane; const f32x4 v4 = *(const LAS f32x4*)(scq + j0);
#pragma unroll
            for (int q = 0; q < 4; ++q) { const bool valid = j0 + q < n; lo = fminf(lo, valid ? v4[q] : INFINITY); hi = fmaxf(hi, valid ? v4[q] : -INFINITY); } }
#pragma unroll
        for (int o = 1; o < 64; o <<= 1) { lo = fminf(lo, shx(lo, o)); hi = fmaxf(hi, shx(hi, o)); }
        bool slow = false;
        if (!(hi > lo)) { for (int j = lane; j < 256; j += 64) sel[j] = (unsigned short)j; }
        else {
            const float scale = 1023.0f / (hi - lo);
            *(LAS u32x4*)(hist + 8 * lane) = (u32x4){0u, 0u, 0u, 0u}; *(LAS u32x4*)(hist + 8 * lane + 4) = (u32x4){0u, 0u, 0u, 0u};
#pragma unroll 2
            for (int i = 0; i < R4; ++i) { const int j0 = 256 * i + 4 * lane; const f32x4 v4 = *(const LAS f32x4*)(scq + j0);
#pragma unroll
                for (int q = 0; q < 4; ++q) { if (j0 + q < n) { int bk = (int)((v4[q] - lo) * scale); bk = bk < 1023 ? bk : 1023;
                    atomicAdd((unsigned*)(hist + (bk >> 1)), (bk & 1) ? 65536u : 1u); } } }
            const u32x4 h0 = *(const LAS u32x4*)(hist + 8 * lane), h1 = *(const LAS u32x4*)(hist + 8 * lane + 4);
            unsigned cb[16];
            cb[0] = h0.x & 0xffffu; cb[1] = h0.x >> 16; cb[2] = h0.y & 0xffffu; cb[3] = h0.y >> 16; cb[4] = h0.z & 0xffffu; cb[5] = h0.z >> 16; cb[6] = h0.w & 0xffffu; cb[7] = h0.w >> 16;
            cb[8] = h1.x & 0xffffu; cb[9] = h1.x >> 16; cb[10] = h1.y & 0xffffu; cb[11] = h1.y >> 16; cb[12] = h1.z & 0xffffu; cb[13] = h1.z >> 16; cb[14] = h1.w & 0xffffu; cb[15] = h1.w >> 16;
            unsigned tot = 0u;
#pragma unroll
            for (int q = 0; q < 16; ++q) tot += cb[q];
            unsigned incl = tot;
#pragma unroll
            for (int o = 1; o < 64; o <<= 1) { const unsigned t = shdown_u(incl, o); if (lane + o < 64) incl += t; }
            int fb = -1; unsigned fabove = 0u, fcnt = 0u; unsigned cum = incl - tot;
#pragma unroll
            for (int q = 15; q >= 0; --q) { if (fb < 0 && cum < 256u && 256u <= cum + cb[q]) { fb = 16 * lane + q; fabove = cum; fcnt = cb[q]; } cum += cb[q]; }
            const unsigned long long mf = __ballot(fb >= 0); const int src = (int)__ffsll((long long)mf) - 1;
            const int B = shidx_i(fb, src); const int above = shidx_i((int)fabove, src), cntB = shidx_i((int)fcnt, src); const int need = 256 - above;
            if (cntB > 256) slow = true;
            else {
                LAS unsigned* cand = hist;
                int base_gt = 0, base_c = 0;
#pragma unroll 2
                for (int i = 0; i < R4; ++i) { const int j0 = 256 * i + 4 * lane; const f32x4 v4 = *(const LAS f32x4*)(scq + j0);
#pragma unroll
                    for (int q = 0; q < 4; ++q) { const int j = j0 + q; const bool valid = j < n; const float v = valid ? v4[q] : lo;
                        int bk = (int)((v - lo) * scale); bk = bk < 1023 ? bk : 1023;
                        const bool gt = valid && bk > B, eq = valid && bk == B;
                        const unsigned long long mg = __ballot(gt), me = __ballot(eq);
                        if (gt) sel[base_gt + __popcll(mg & ltm)] = (unsigned short)j;
                        if (eq) { const int p = base_c + __popcll(me & ltm); cand[2 * p] = fkey(v); cand[2 * p + 1] = (unsigned)j; }
                        base_gt += __popcll(mg); base_c += __popcll(me); } }
                if (need == cntB) { for (int c = lane; c < cntB; c += 64) sel[above + c] = (unsigned short)cand[2 * c + 1]; }
                else {
                    unsigned ck[4], cx[4]; int rk[4];
#pragma unroll
                    for (int q = 0; q < 4; ++q) { const int c = lane + 64 * q; ck[q] = c < cntB ? cand[2 * c] : 0u; cx[q] = c < cntB ? cand[2 * c + 1] : 0u; rk[q] = 0; }
                    for (int c2 = 0; c2 < cntB; ++c2) { const unsigned k2 = cand[2 * c2], x2 = cand[2 * c2 + 1];
#pragma unroll
                        for (int q = 0; q < 4; ++q) rk[q] += (k2 > ck[q] || (k2 == ck[q] && x2 < cx[q])) ? 1 : 0; }
#pragma unroll
                    for (int q = 0; q < 4; ++q) { const int c = lane + 64 * q; if (c < cntB && rk[q] < need) sel[above + rk[q]] = (unsigned short)cand[2 * c + 1]; }
                }
            }
        }
        if (slow) {
        unsigned prefix = 0u; int need = 256; unsigned neq = 0u;
        for (int p = 0; p < 4; ++p) { const int shift = 24 - 8 * p;
            *(LAS u32x4*)(hist + 4 * lane) = (u32x4){0u, 0u, 0u, 0u};
            for (int i = 0; i < R; ++i) { const int j = lane + 64 * i; if (j < n) { const unsigned u = fkey(scq[j]);
                if (p == 0 || (u >> (shift + 8)) == prefix) atomicAdd((unsigned*)(hist + ((u >> shift) & 255u)), 1u); } }
            const u32x4 hv = *(const LAS u32x4*)(hist + 4 * lane);
            const unsigned tot = hv.x + hv.y + hv.z + hv.w;
            unsigned incl = tot;
#pragma unroll
            for (int o = 1; o < 64; o <<= 1) { const unsigned t = shdown_u(incl, o); if (lane + o < 64) incl += t; }
            const unsigned above = incl - tot;
            int fb = -1; unsigned fabove = 0u, feq = 0u; unsigned cum = above;
            { const unsigned hq[4] = {hv.x, hv.y, hv.z, hv.w};
#pragma unroll
              for (int q = 3; q >= 0; --q) { if (fb < 0 && cum < (unsigned)need && (unsigned)need <= cum + hq[q]) { fb = 4 * lane + q; fabove = cum; feq = hq[q]; } cum += hq[q]; } }
            const unsigned long long m = __ballot(fb >= 0);
            const int src = (int)__ffsll((long long)m) - 1;
            const int bin = shidx_i(fb, src); const unsigned ab = (unsigned)shidx_i((int)fabove, src); neq = (unsigned)shidx_i((int)feq, src);
            need -= (int)ab; prefix = (prefix << 8) | (unsigned)bin;
        }
        const int ngt = 256 - need;
        int base_gt = 0, base_eq = 0;
        for (int i = 0; i < R; ++i) { const int j = lane + 64 * i; const unsigned u = (j < n) ? fkey(scq[j]) : 0u;
            const bool gt = (j < n) && (u > prefix), eq = (j < n) && (u == prefix);
            const unsigned long long mg = __ballot(gt), me = __ballot(eq); const unsigned long long lt = (1ull << lane) - 1ull;
            if (gt) sel[base_gt + __popcll(mg & lt)] = (unsigned short)j;
            if (eq) { const int rk = base_eq + __popcll(me & lt); if (rk < need) sel[ngt + rk] = (unsigned short)j; }
            base_gt += __popcll(mg); base_eq += __popcll(me); }
        (void)neq;
            }
    }
    const int nt16 = (nsel + 15) >> 4, r16 = lane & 15, g4 = lane >> 4;
    LAS float* biasj = scq + 2048;
#pragma unroll
    for (int q = 0; q < 4; ++q) { const int j = lane + 64 * q; f32x4 bv = (f32x4){-INFINITY, -INFINITY, -INFINITY, -INFINITY};
        if (j < nsel) { const int dist = tq - (int)sel[j]; const int bk = dist < 128 ? bkt[dist < 0 ? 0 : dist] : 31; bv = *(const LAS f32x4*)(biasT + 4 * bk); }
        *(LAS f32x4*)(biasj + 4 * j) = bv; }
    bf16x8 qf[2];
#pragma unroll
    for (int s = 0; s < 2; ++s) { u32x4 z = (u32x4){0u, 0u, 0u, 0u}; if (r16 < 4) z = *(const u32x4*)(U + (T0 + qi) * NINP + UC + r16 * 64 + 32 * s + 8 * g4); qf[s] = __builtin_bit_cast(bf16x8, z); }
    float lg[16][4]; float mx = -INFINITY;
#define DSA_QK(M0, NM) do { int keyr[NM]; bf16x8 a0[NM], a1[NM]; \
        _Pragma("unroll") for (int m8 = 0; m8 < NM; ++m8) keyr[m8] = sel[16 * ((M0) + m8) + r16]; \
        _Pragma("unroll") for (int m8 = 0; m8 < NM; ++m8) { a0[m8] = *(const bf16x8*)(Kb + (TB + keyr[m8]) * 64 + 8 * g4); a1[m8] = *(const bf16x8*)(Kb + (TB + keyr[m8]) * 64 + 32 + 8 * g4); } \
        _Pragma("unroll") for (int m8 = 0; m8 < NM; ++m8) { const int m = (M0) + m8; \
            f32x4 acc = (f32x4){0.f, 0.f, 0.f, 0.f}; \
            acc = __builtin_amdgcn_mfma_f32_16x16x32_bf16(a0[m8], qf[0], acc, 0, 0, 0); \
            acc = __builtin_amdgcn_mfma_f32_16x16x32_bf16(a1[m8], qf[1], acc, 0, 0, 0); \
            _Pragma("unroll") for (int i = 0; i < 4; ++i) { const float v = acc[i] * 0.125f + biasj[(16 * m + 4 * g4 + i) * 4 + (r16 & 3)]; lg[m][i] = v; mx = fmaxf(mx, v); } } } while (0)
    if (nt16 > 8) { DSA_QK(0, 16); }
    else { DSA_QK(0, 8);
#pragma unroll
        for (int m8 = 8; m8 < 16; ++m8)
#pragma unroll
            for (int i = 0; i < 4; ++i) lg[m8][i] = -INFINITY; }
#undef DSA_QK
    mx = fmaxf(mx, shx(mx, 16)); mx = fmaxf(mx, shx(mx, 32));
    float sm = 0.f;
#pragma unroll
    for (int m = 0; m < 16; ++m)
#pragma unroll
        for (int i = 0; i < 4; ++i) { const float p = __expf(lg[m][i] - mx); lg[m][i] = p; sm += p; }
    sm += shx(sm, 16); sm += shx(sm, 32);
    f32x4 ov[4];
#pragma unroll
    for (int nt = 0; nt < 4; ++nt) ov[nt] = (f32x4){0.f, 0.f, 0.f, 0.f};
    const unsigned vs_base = (unsigned)(unsigned long)scq;
#pragma unroll
    for (int half = 0; half < 2; ++half) {
        if (half * 8 < nt16) {
            asm volatile("s_waitcnt lgkmcnt(0)" ::: "memory");
            int vkey[16];
#pragma unroll
            for (int q = 0; q < 16; ++q) { const int rho = 8 * q + (lane >> 3);
                vkey[q] = sel[half * 128 + (rho & ~31) + 16 * ((rho >> 2) & 1) + 4 * ((rho >> 3) & 3) + (rho & 3)]; }
            asm volatile("s_waitcnt lgkmcnt(0)" : "+v"(vkey[0]), "+v"(vkey[1]), "+v"(vkey[2]), "+v"(vkey[3]), "+v"(vkey[4]), "+v"(vkey[5]), "+v"(vkey[6]), "+v"(vkey[7]),
                         "+v"(vkey[8]), "+v"(vkey[9]), "+v"(vkey[10]), "+v"(vkey[11]), "+v"(vkey[12]), "+v"(vkey[13]), "+v"(vkey[14]), "+v"(vkey[15]) :: "memory");
#pragma unroll
            for (int q = 0; q < 16; ++q)
                __builtin_amdgcn_global_load_lds((const unsigned*)(Vb + (TB + vkey[q]) * 64 + 8 * (lane & 7)), (LAS unsigned*)((LAS unsigned char*)scq + q * 1024), 16, 0, 0);
            asm volatile("s_waitcnt vmcnt(0)" ::: "memory");
#pragma unroll
            for (int s4 = 0; s4 < 4; ++s4) { const int s = half * 4 + s4;
                u32x4 pw; pw.x = pk2(lg[2 * s][0], lg[2 * s][1]); pw.y = pk2(lg[2 * s][2], lg[2 * s][3]); pw.z = pk2(lg[2 * s + 1][0], lg[2 * s + 1][1]); pw.w = pk2(lg[2 * s + 1][2], lg[2 * s + 1][3]);
                const bf16x8 pa = __builtin_bit_cast(bf16x8, pw);
                const unsigned ad = vs_base + (unsigned)((32 * s4 + 8 * g4 + (r16 >> 2)) * 128 + (r16 & 3) * 8);
                u32x2 t0[4], t1[4];
                asm volatile("ds_read_b64_tr_b16 %0, %8\n\tds_read_b64_tr_b16 %1, %8 offset:512\n\tds_read_b64_tr_b16 %2, %8 offset:32\n\tds_read_b64_tr_b16 %3, %8 offset:544\n\t"
                             "ds_read_b64_tr_b16 %4, %8 offset:64\n\tds_read_b64_tr_b16 %5, %8 offset:576\n\tds_read_b64_tr_b16 %6, %8 offset:96\n\tds_read_b64_tr_b16 %7, %8 offset:608\n\ts_waitcnt lgkmcnt(0)"
                             : "=&v"(t0[0]), "=&v"(t1[0]), "=&v"(t0[1]), "=&v"(t1[1]), "=&v"(t0[2]), "=&v"(t1[2]), "=&v"(t0[3]), "=&v"(t1[3]) : "v"(ad) : "memory");
#pragma unroll
                for (int nt = 0; nt < 4; ++nt) { const bf16x8 vb = __builtin_bit_cast(bf16x8, (u32x4){t0[nt].x, t0[nt].y, t1[nt].x, t1[nt].y});
                    ov[nt] = __builtin_amdgcn_mfma_f32_16x16x32_bf16(pa, vb, ov[nt], 0, 0, 0); } }
        }
    }
    { float inv[4];
#pragma unroll
      for (int h = 0; h < 4; ++h) inv[h] = 1.0f / __int_as_float(__builtin_amdgcn_readlane(__float_as_int(sm), h));
      if (lane < 16) { bf16_t* Y = (bf16_t*)(F.ws + WS_H) + (T0 + qi) * DM + 512 + r16;
#pragma unroll
          for (int h = 0; h < 4; ++h)
#pragma unroll
              for (int nt = 0; nt < 4; ++nt) Y[h * 64 + 16 * nt] = f2bf(ov[nt][h] * inv[h]); } }
}

__device__ __forceinline__ void phase_router(const Frame& F_, int layer) { Frame F = relocal(F_); const int cset = layer;
    const float* X = (const float*)(F.ws + WS_X);
    const bf16_t* WH = (const bf16_t*)(F.ws + WS_WRT) + (size_t)layer * 2 * 49152; const bf16_t* WL = WH + 49152;
    LAS float* part = (LAS float*)F.lds;
    LAS float* ssq = (LAS float*)(F.lds + 24576);
    LAS int* es = (LAS int*)(F.lds + 25088);
    LAS int* lr = (LAS int*)(F.lds + 25600);
    LAS float* wsl = (LAS float*)(F.lds + 26112);
    LAS float* rsd = (LAS float*)(F.lds + 26624);
    for (int blk = F.bid; blk < NTOK / 64; blk += F.G) {
        __syncthreads();
        const int mt = F.wave & 3, kh = F.wave >> 2, r16 = F.lane & 15, g4 = F.lane >> 4;
        const float* xr = X + ((size_t)blk * 64 + mt * 16 + r16) * DM + kh * 512 + 8 * g4;
        f32x4 acc[3]; acc[0] = acc[1] = acc[2] = (f32x4){0.f, 0.f, 0.f, 0.f}; float ss = 0.f;
#pragma unroll 4
        for (int ks = 0; ks < 16; ++ks) {
            const f32x4 xa = *(const f32x4*)(xr + ks * 32), xb = *(const f32x4*)(xr + ks * 32 + 4);
            ss += xa[0] * xa[0] + xa[1] * xa[1] + xa[2] * xa[2] + xa[3] * xa[3] + xb[0] * xb[0] + xb[1] * xb[1] + xb[2] * xb[2] + xb[3] * xb[3];
            float xv[8] = {xa[0], xa[1], xa[2], xa[3], xb[0], xb[1], xb[2], xb[3]}; unsigned hw[4], lw[4];
#pragma unroll
            for (int j = 0; j < 4; ++j) { const bf16_t h0 = f2bf(xv[2 * j]), h1 = f2bf(xv[2 * j + 1]); hw[j] = (unsigned)h0 | ((unsigned)h1 << 16);
                lw[j] = pk2(xv[2 * j] - bf2f(h0), xv[2 * j + 1] - bf2f(h1)); }
            const bf16x8 ahi = __builtin_bit_cast(bf16x8, (u32x4){hw[0], hw[1], hw[2], hw[3]}), alo = __builtin_bit_cast(bf16x8, (u32x4){lw[0], lw[1], lw[2], lw[3]});
#pragma unroll
            for (int nt = 0; nt < 3; ++nt) { const size_t wo = (size_t)(nt * 16 + r16) * 1024 + kh * 512 + ks * 32 + 8 * g4;
                const bf16x8 bh = *(const bf16x8*)(WH + wo), bl = *(const bf16x8*)(WL + wo);
                acc[nt] = __builtin_amdgcn_mfma_f32_16x16x32_bf16(ahi, bh, acc[nt], 0, 0, 0);
                acc[nt] = __builtin_amdgcn_mfma_f32_16x16x32_bf16(ahi, bl, acc[nt], 0, 0, 0);
                acc[nt] = __builtin_amdgcn_mfma_f32_16x16x32_bf16(alo, bh, acc[nt], 0, 0, 0); }
        }
        ss += shx(ss, 16); ss += shx(ss, 32);
        if (g4 == 0) ssq[kh * 64 + mt * 16 + r16] = ss;
#pragma unroll
        for (int nt = 0; nt < 3; ++nt)
#pragma unroll
            for (int i = 0; i < 4; ++i) part[(kh * 64 + mt * 16 + 4 * g4 + i) * 48 + nt * 16 + r16] = acc[nt][i];
        __syncthreads();
        if (F.tid < 64) { const float rstd = rsqrtf((ssq[F.tid] + ssq[64 + F.tid]) * (1.0f / DM) + 1e-6f); rsd[F.tid] = rstd;
            float l[36];
#pragma unroll
            for (int o = 0; o < 36; ++o) l[o] = (part[F.tid * 48 + o] + part[(64 + F.tid) * 48 + o]) * rstd + (o < 32 ? F.in[I_BRE][layer * 32 + o] : F.in[I_BRG][layer * 4 + o - 32]);
            int gs = 0; float gm = l[32];
#pragma unroll
            for (int j = 1; j < 4; ++j) if (l[32 + j] > gm) { gm = l[32 + j]; gs = j; }
            float den = 0.f;
#pragma unroll
            for (int j = 0; j < 4; ++j) den += __expf(l[32 + j] - gm);
            const float gate = 1.0f / den;
            float e8[8];
#pragma unroll
            for (int j = 0; j < 8; ++j) e8[j] = gs == 0 ? l[j] : gs == 1 ? l[8 + j] : gs == 2 ? l[16 + j] : l[24 + j];
            int i1 = 0; float v1 = e8[0];
#pragma unroll
            for (int j = 1; j < 8; ++j) if (e8[j] > v1) { v1 = e8[j]; i1 = j; }
            int i2 = -1; float v2 = -INFINITY;
#pragma unroll
            for (int j = 0; j < 8; ++j) if (j != i1 && e8[j] > v2) { v2 = e8[j]; i2 = j; }
            const float e2 = __expf(v2 - v1); const float p1 = 1.0f / (1.0f + e2);
            es[F.tid * 2] = gs * 8 + i1; es[F.tid * 2 + 1] = gs * 8 + i2; wsl[F.tid * 2] = p1 * gate; wsl[F.tid * 2 + 1] = (1.0f - p1) * gate; }
        __syncthreads();
        if (F.tid < 32) { int cnt = 0; for (int i = 0; i < 128; ++i) if (es[i] == F.tid) lr[i] = cnt++;
            if (cnt) { const int base = (int)__hip_atomic_fetch_add(F.ctl + CW_CNT + cset * 32 + F.tid, (unsigned)cnt, __ATOMIC_RELAXED, __HIP_MEMORY_SCOPE_AGENT);
                for (int i = 0; i < 128; ++i) if (es[i] == F.tid) lr[i] += base; } }
        __syncthreads();
        if (F.tid < 64) { int* rt = (int*)(F.ws + WS_ROUTE) + ((size_t)blk * 64 + F.tid) * 8;
            rt[0] = es[F.tid * 2]; rt[1] = es[F.tid * 2 + 1]; ((float*)rt)[2] = wsl[F.tid * 2]; ((float*)rt)[3] = wsl[F.tid * 2 + 1]; rt[4] = lr[F.tid * 2]; rt[5] = lr[F.tid * 2 + 1]; ((float*)rt)[6] = rsd[F.tid]; }
    }
    __syncthreads();
    if (F.tid == 0) __hip_atomic_fetch_add(F.ctl + CW_RB + 64 * layer, 1u, __ATOMIC_RELAXED, __HIP_MEMORY_SCOPE_AGENT);
}
__device__ __forceinline__ void phase_moe_convert(const Frame& F_, int layer) { Frame F = relocal(F_);
    bf16_t* WGU = (bf16_t*)(F.ws + WS_MOE + MOE_WGU);
    for (int t = F.bid; t < 1024; t += F.G) {
        const int e = t >> 5, r = t & 31, kt = r >> 1, nt = r & 1; const size_t eo = ((size_t)layer * 32 + e) * 1024 * 256;
        tr_tile(F, 256, WGU + (size_t)e * 512 * 1024, 1024, kt * 64, nt * 256, SmGU{F.in[I_WGATE] + eo, F.in[I_WUP] + eo}); }
}
__device__ __forceinline__ void phase_moe_convert_down(const Frame& F_, int layer) { Frame F = relocal(F_);
    bf16_t* WD = (bf16_t*)(F.ws + WS_MOE + MOE_WD);
    for (;;) { const int q = q_pop(F, 32 + layer); if (q >= 512) break;
        const int e = q >> 4, r = q & 15, kt = r >> 2, nt = r & 3;
        tr_tile(F, 1024, WD + (size_t)e * 1024 * 256, 256, kt * 64, nt * 256, SmId{F.in[I_WDOWN] + ((size_t)layer * 32 + e) * 256 * 1024}); }
}
__device__ __forceinline__ void phase_gather(const Frame& F_, int layer) { Frame F = relocal(F_);
    LAS int* off = (LAS int*)F.lds;
    __syncthreads();
    if (F.tid == 0) { unsigned sp = 0;
        while (__hip_atomic_load(F.ctl + CW_RB + 64 * layer, __ATOMIC_RELAXED, __HIP_MEMORY_SCOPE_AGENT) < (unsigned)F.G) { __builtin_amdgcn_s_sleep(2); if (++sp > (1u << 22)) break; } }
    __syncthreads();
    if (F.tid == 0) { int acc = 0; for (int e = 0; e < 32; ++e) { off[e] = acc; const int c = (int)__hip_atomic_load(F.ctl + CW_CNT + layer * 32 + e, __ATOMIC_RELAXED, __HIP_MEMORY_SCOPE_AGENT); acc += (c + 255) & ~255; } off[32] = acc; }
    __syncthreads();
    int* tiles = (int*)(F.ws + WS_TILES); int* row_tok = (int*)(F.ws + WS_ROWS); float* row_w = (float*)(F.ws + WS_ROWS) + MAXROWS;
    if (F.bid == 0) { if (F.tid == 0) tiles[0] = off[32] >> 8; if (F.tid < 33) tiles[1 + F.tid] = off[F.tid];
        if (F.tid < 32) for (int rt = off[F.tid] >> 8; rt < (off[F.tid + 1] >> 8); ++rt) tiles[64 + rt] = F.tid; }
    for (int e = F.bid; e < 32; e += F.G) { const int c = (int)__hip_atomic_load(F.ctl + CW_CNT + layer * 32 + e, __ATOMIC_RELAXED, __HIP_MEMORY_SCOPE_AGENT);
        for (int r = off[e] + c + F.tid; r < off[e + 1]; r += NTHR) { row_tok[r] = -1; row_w[r] = 0.f; } }
    const float* X = (const float*)(F.ws + WS_X); bf16_t* HP = (bf16_t*)(F.ws + WS_U); const float* nw = F.in[I_NORM2] + (size_t)layer * DM;
    f32x4 nwv[4];
#pragma unroll
    for (int j = 0; j < 4; ++j) nwv[j] = *(const f32x4*)(nw + 4 * F.lane + 256 * j);
    for (int blk = F.bid; blk < NTOK / 64; blk += F.G)
    for (int i4 = 0; i4 < 2; ++i4) {
        int p0[4], p1[4], tt[4]; float rstd[4], w0[4], w1[4]; f32x4 xv[4][4];
#pragma unroll
        for (int r = 0; r < 4; ++r) { const int t = blk * 64 + F.wave * 8 + 4 * i4 + r; tt[r] = t;
            const int* rt = (const int*)(F.ws + WS_ROUTE) + (size_t)t * 8; rstd[r] = ((const float*)rt)[6]; w0[r] = ((const float*)rt)[2]; w1[r] = ((const float*)rt)[3];
            p0[r] = off[rt[0]] + rt[4]; p1[r] = off[rt[1]] + rt[5];
#pragma unroll
            for (int j = 0; j < 4; ++j) xv[r][j] = *(const f32x4*)(X + (size_t)t * DM + 4 * F.lane + 256 * j); }
#pragma unroll
        for (int r = 0; r < 4; ++r) {
#pragma unroll
            for (int j = 0; j < 4; ++j) { const int c = 4 * F.lane + 256 * j; const f32x4 v = xv[r][j] * rstd[r] * nwv[j];
                u32x2 o; o.x = pk2(v[0], v[1]); o.y = pk2(v[2], v[3]);
                *(u32x2*)(HP + (size_t)p0[r] * DM + c) = o; *(u32x2*)(HP + (size_t)p1[r] * DM + c) = o; }
            if (F.lane == 0) { row_tok[p0[r]] = tt[r] * 2; row_w[p0[r]] = w0[r]; row_tok[p1[r]] = tt[r] * 2 + 1; row_w[p1[r]] = w1[r]; } }
    }
}

constexpr int NPH_LAYER = 9, NPHASE = 1 + 2 * NPH_LAYER + 1;
#ifndef MK_ONLY
#define MK_ONLY -1
#endif
#ifndef MK_ITEM
#define MK_ITEM -1
#endif
#define EN(o) (MK_ONLY < 0 || MK_ONLY == (o))
#define IT(o) (MK_ITEM < 0 || MK_ITEM == (o))
__global__ void __launch_bounds__(NTHR, 2) mk_forward(Params P) {
    extern __shared__ __attribute__((aligned(16))) unsigned char lds_raw[];
    Frame F; F.lds = (LAS unsigned char*)lds_raw; F.tid = threadIdx.x; F.lane = F.tid & 63; F.wave = __builtin_amdgcn_readfirstlane(F.tid >> 6); F.bid = blockIdx.x; F.G = gridDim.x;
    F.in = (in_tab_t)__builtin_amdgcn_kernarg_segment_ptr(); F.out = P.out; F.ws = P.ws; F.ctl = (unsigned*)(P.ws + WS_CTL); F.misc = (volatile LAS int*)(F.lds + MISC_OFF);
    if (F.tid < 64) ((LAS unsigned*)(F.lds + MISC_OFF))[F.tid] = 0u;
    __syncthreads();
    const int lo = P.ph_lo, hi = P.ph_hi;
    XcdBarrier bar; bar.bar = F.ctl + CW_BAR; bar.x = 0; bar.st = (volatile LAS unsigned*)(F.lds + MISC_OFF + 16);
    if (hi - lo > 1) bar = xcd_barrier_post(F.ctl + CW_BAR, (volatile LAS unsigned*)(F.lds + MISC_OFF + 16));
#define IN(k) (lo <= (k) && (k) < hi)
#define SEAM(k) do { if (IN(k) && IN((k) + 1)) xcd_barrier(bar); } while (0)
#define QLOOP(qi, n, body) for (;;) { const int it = q_pop(F, layer * 12 + (qi)); if (it >= (n)) break; body; }
    if (EN(100) && IN(0)) { phase_prologue(F); phase_norm(F, F.in[I_X], false, F.in[I_NORM1], 0); } SEAM(0);
#pragma unroll
    for (int layer = 0; layer < DEPTH; ++layer) {
        const int pb = 1 + layer * NPH_LAYER;
        if (layer > 0) { if (EN(0) && IN(pb + 0)) { phase_norm(F, (const float*)(F.ws + WS_X), true, F.in[I_NORM1] + (size_t)layer * DM, 0); } SEAM(pb + 0); }
        if (EN(1) && IN(pb + 1)) { const Frame F_ = F; Frame F = relocal(F_); pg8::StaticOrder S; S.init((const bf16_t*)(F.ws + WS_H), (const bf16_t*)(F.ws + WS_WIN) + (size_t)layer * NINP * DM, NTOK, NINP, DM, F.G, F.bid);
            pg8::EpiBf16 E{(bf16_t*)(F.ws + WS_U), NINP}; pg8::gemm_phase(F.lds, DM, S, E); } SEAM(pb + 1);
#define SLOOP(n, body) for (int it = F.bid; it < (n); it += F.G) { __syncthreads(); body; }
        if (EN(2) && IN(pb + 2)) {
            if (IT(1)) SLOOP(1024, item_rwkv1(F, layer, it));
            if (IT(0)) SLOOP(256, item_s5<1>(F, layer, it));
            if (IT(2)) SLOOP(256, item_mamba<1>(F, layer, it));
            if (IT(3)) SLOOP(256, item_kv(F, layer, it));
        } SEAM(pb + 2);
        if (EN(3) && IN(pb + 3)) {
            if (IT(0)) QLOOP(4, 8, item_rwkv_carry(F, it));
            if (IT(1)) QLOOP(5, 16, item_mamba_carry(F, it));
            if (IT(2)) QLOOP(6, 4, item_s5_carry(F, layer, it));
            if (IT(3)) {
                dsa_tables(F);
                const int pref = (int)(xb_xcc_id() & 3u);
#pragma unroll 1
                for (int k4 = 0; k4 < 4; ++k4) { const int bq = (pref + k4) & 3;
                    for (;;) { const int it = q_pop(F, 24 + layer * 4 + bq); if (it >= 512) break; item_dsa(F, layer, it * 4 + bq); } } }
        } SEAM(pb + 3);
        if (EN(4) && IN(pb + 4)) {
            if (IT(0)) SLOOP(256, item_s5<2>(F, layer, it));
            if (IT(2)) SLOOP(256, item_mamba<2>(F, layer, it));
            if (IT(1)) SLOOP(1024, item_rwkv3(F, layer, it));
        } SEAM(pb + 4);
        if (EN(6) && IN(pb + 5)) { const Frame F_ = F; Frame F = relocal(F_); pg8::StaticOrder S; S.init((const bf16_t*)(F.ws + WS_H), (const bf16_t*)(F.ws + WS_WOUT) + (size_t)layer * DM * DM, NTOK, DM, DM, F.G, F.bid);
            pg8::EpiResid E{(float*)(F.ws + WS_X), DM}; pg8::gemm_phase(F.lds, DM, S, E); } SEAM(pb + 5);
        if (EN(7) && IN(pb + 6)) { phase_router(F, layer); phase_moe_convert(F, layer); phase_gather(F, layer); } SEAM(pb + 6);
        if (EN(8) && IN(pb + 7)) { const Frame F_ = F; Frame F = relocal(F_); pg8::MoeOrder S{2, F.G, F.bid, DM, (const char*)(F.ws + WS_U), (const char*)(F.ws + WS_MOE + MOE_WGU), (size_t)512 * 1024 * 2, (const int*)(F.ws + WS_TILES)};
            pg8::EpiGated<1> E{(bf16_t*)(F.ws + WS_H), 256, 0, nullptr, nullptr}; pg8::gemm_phase(F.lds, DM, S, E); phase_moe_convert_down(F, layer); } SEAM(pb + 7);
        if (EN(9) && IN(pb + 8)) { const Frame F_ = F; Frame F = relocal(F_); pg8::MoeOrder S{4, F.G, F.bid, 256, (const char*)(F.ws + WS_H), (const char*)(F.ws + WS_MOE + MOE_WD), (size_t)1024 * 256 * 2, (const int*)(F.ws + WS_TILES)};
            pg8::EpiMoeOut E{(bf16_t*)(F.ws + WS_U), (const int*)(F.ws + WS_ROWS), (const float*)(F.ws + WS_ROWS) + MAXROWS, F.lds}; pg8::gemm_phase(F.lds, 256, S, E); } SEAM(pb + 8);
    }
    if (EN(101) && IN(NPHASE - 1)) { phase_norm(F, (const float*)(F.ws + WS_X), true, F.in[I_FNORM], 2); }
#undef IN
#undef SEAM
}

#ifndef MK_SPLIT
#define MK_SPLIT 0
#endif
extern "C" void kernel_launch(void* const* d_in, const int* in_sizes, int n_in, void* d_out, int out_size, void* d_ws, size_t ws_size, hipStream_t stream) {
    static int grid = 0;
    if (grid == 0) {
        if (n_in != 44 || out_size != NTOK * DM || ws_size < WS_END) { fprintf(stderr, "kernel_launch: unexpected shapes (n_in %d out %d ws %zu need %zu)\n", n_in, out_size, ws_size, (size_t)WS_END); grid = -1; return; }
        int dev = 0, cus = 0;
        if (hipGetDevice(&dev) != hipSuccess || hipDeviceGetAttribute(&cus, hipDeviceAttributeMultiprocessorCount, dev) != hipSuccess) { grid = -1; return; }
        if (hipFuncSetAttribute((const void*)mk_forward, hipFuncAttributeMaxDynamicSharedMemorySize, LDS_BYTES) != hipSuccess) { fprintf(stderr, "kernel_launch: hipFuncSetAttribute failed\n"); grid = -1; return; }
        int per_cu = 0;
        if (hipOccupancyMaxActiveBlocksPerMultiprocessor(&per_cu, (const void*)mk_forward, NTHR, LDS_BYTES) != hipSuccess || per_cu < 1) { fprintf(stderr, "kernel_launch: occupancy query says %d\n", per_cu); }
        (void)hipGetLastError();
        grid = cus;
    }
    if (grid < 0) return;
    hipMemsetAsync((char*)d_ws + WS_CTL, 0, CTL_BYTES, stream);
    Params p{};
    for (int i = 0; i < 44; ++i) p.in[i] = (const float*)d_in[i];
    p.out = (float*)d_out; p.ws = (unsigned char*)d_ws;
#if MK_SPLIT
    for (int ph = 0; ph < NPHASE; ++ph) { p.ph_lo = ph; p.ph_hi = ph + 1; hipLaunchKernelGGL(mk_forward, dim3(grid), dim3(NTHR), LDS_BYTES, stream, p); }
#else
    p.ph_lo = 0; p.ph_hi = NPHASE; hipLaunchKernelGGL(mk_forward, dim3(grid), dim3(NTHR), LDS_BYTES, stream, p);
#endif
}
```

```cpp
#include <hip/hip_runtime.h>
#include <stdint.h>
#include <stdio.h>

#define LAS __attribute__((address_space(3)))
typedef unsigned short bf16_t;
typedef short bf16x8 __attribute__((ext_vector_type(8)));
typedef float f32x4 __attribute__((ext_vector_type(4)));
typedef float f32x2 __attribute__((ext_vector_type(2)));
typedef float f32x16 __attribute__((ext_vector_type(16)));
typedef unsigned u32x4 __attribute__((ext_vector_type(4)));
typedef unsigned u32x2 __attribute__((ext_vector_type(2)));

constexpr int NTOK = 16384, DM = 1024, SEQ = 4096, NBATCH = 4, DEPTH = 2;
constexpr int NIN = 2604, NINP = 2816;
constexpr int UM = 0;
constexpr int UR = 784;
constexpr int UC = 1680;
constexpr int US = 2368;
constexpr int NTHR = 512;
constexpr int LDS_BYTES = 163840;
constexpr int MISC_OFF = LDS_BYTES - 256;

constexpr size_t WS_CTL   = 0;
constexpr size_t CTL_BYTES = 65536;
constexpr size_t WS_X     = WS_CTL + CTL_BYTES;
constexpr size_t WS_H     = WS_X + (size_t)NTOK * DM * 4;
constexpr size_t WS_U     = WS_H + (size_t)NTOK * DM * 2;
constexpr size_t WS_WIN   = WS_U + (size_t)NTOK * NINP * 2;
constexpr size_t WS_WOUT  = WS_WIN + (size_t)2 * NINP * DM * 2;
constexpr size_t WS_GLU   = WS_WOUT + (size_t)2 * DM * DM * 2;
constexpr size_t WS_MOE   = WS_GLU + (size_t)2 * 512 * 256 * 2;
constexpr size_t MOE_WGU  = 0;
constexpr size_t MOE_WD   = (size_t)32 * 512 * 1024 * 2;
constexpr size_t MOE_BYTES = MOE_WD + (size_t)32 * 1024 * 256 * 2;
constexpr size_t RW_PT    = 0;
constexpr size_t RW_U     = (size_t)1024 * 4096 * 2;
constexpr size_t RW_S     = RW_U + (size_t)1024 * 4096 * 2;
constexpr size_t RW_W1    = RW_S + (size_t)1024 * 4096 * 2;
constexpr size_t RW_Z     = RW_W1 + (size_t)1024 * 4096 * 2;
constexpr size_t YSG_OFF  = RW_Z + (size_t)1024 * 4096 * 2;
static_assert(YSG_OFF + (size_t)NTOK * 256 * 2 <= MOE_BYTES, "alias");
constexpr size_t WS_MST   = WS_MOE + MOE_BYTES;
constexpr size_t WS_MDEC  = WS_MST + (size_t)4 * 64 * 4 * 4096 * 4;
constexpr size_t WS_S5ST  = WS_MDEC + 4096;
constexpr size_t WS_K     = WS_S5ST + (size_t)4 * 64 * 2048 * 4;
constexpr size_t WS_V     = WS_K + (size_t)NTOK * 64 * 2;
constexpr size_t WS_KIDX  = WS_V + (size_t)NTOK * 64 * 2;
constexpr size_t WS_ROUTE = WS_KIDX + (size_t)NTOK * 32 * 2;
constexpr size_t WS_ROWS  = WS_ROUTE + (size_t)NTOK * 32;
constexpr int    MAXROWS  = 49152;
constexpr size_t WS_TILES = WS_ROWS + (size_t)MAXROWS * 8;
constexpr size_t WS_S5TAB = WS_TILES + 4096;
constexpr size_t S5TAB_F  = (size_t)(2048 + 2048 + 32768) * 4;
constexpr size_t S5TAB_BBT = S5TAB_F + (size_t)16 * 16 * 128 * 2;
constexpr size_t S5TAB_L  = S5TAB_BBT + (size_t)16 * 128 * 16 * 2;
constexpr size_t WS_WRT   = WS_S5TAB + 2 * S5TAB_L;
constexpr size_t WS_BON   = WS_WRT + (size_t)2 * 2 * 48 * 1024 * 2;
constexpr size_t WS_END   = WS_BON + (size_t)1024 * 64 * 4;

constexpr int CW_BAR = 0;
constexpr int CW_Q   = 4096;
constexpr int CW_CNT = 8192;
constexpr int CW_RB  = 8448;

__device__ __forceinline__ float bf2f(bf16_t b) { return __uint_as_float(((unsigned)b) << 16); }
__device__ __forceinline__ bf16_t f2bf(float f) { const __bf16 h = (__bf16)f; return __builtin_bit_cast(bf16_t, h); }
__device__ __forceinline__ unsigned pk2(float lo, float hi) { typedef __bf16 bf2_t __attribute__((ext_vector_type(2))); const bf2_t h = __builtin_convertvector((f32x2){lo, hi}, bf2_t); return __builtin_bit_cast(unsigned, h); }
__device__ __forceinline__ unsigned cvt_pk_bf16(float lo, float hi) { unsigned r; asm volatile("v_cvt_pk_bf16_f32 %0, %1, %2" : "=v"(r) : "v"(lo), "v"(hi)); return r; }
__device__ __forceinline__ float sigmoidf_(float x) { return 1.0f / (1.0f + __expf(-x)); }
__device__ __forceinline__ float siluf_(float x) { return x / (1.0f + __expf(-x)); }
__device__ __forceinline__ float tanhf_(float x) { const float e = __expf(2.0f * x); return 1.0f - 2.0f / (e + 1.0f); }
__device__ __forceinline__ float softplusf_(float x) { return fmaxf(x, 0.0f) + log1pf(__expf(-fabsf(x))); }
__device__ __forceinline__ float gelu_tanh(float x) { return 0.5f * x * (1.0f + tanhf_(0.7978845608028654f * (x + 0.044715f * x * x * x))); }
template <int CTRL> __device__ __forceinline__ float dppf(float x) { return __int_as_float(__builtin_amdgcn_update_dpp(0, __float_as_int(x), CTRL, 0xF, 0xF, true)); }
__device__ __forceinline__ float sum4(float x) { x += dppf<0xB1>(x); x += dppf<0x4E>(x); return x; }
__device__ __forceinline__ float sum8(float x) { x = sum4(x); x += dppf<0x141>(x); return x; }
__device__ __forceinline__ float sum16(float x) { x = sum8(x); x += dppf<0x140>(x); return x; }
__device__ __forceinline__ int lane_id_() { int l = (int)__builtin_amdgcn_mbcnt_hi(~0u, __builtin_amdgcn_mbcnt_lo(~0u, 0u)); asm volatile("" : "+v"(l)); return l; }
__device__ __forceinline__ float shx(float x, int o) { return __int_as_float(__builtin_amdgcn_ds_bpermute((lane_id_() ^ o) << 2, __float_as_int(x))); }
__device__ __forceinline__ unsigned shdown_u(unsigned x, int o) { return (unsigned)__builtin_amdgcn_ds_bpermute(((lane_id_() + o) & 63) << 2, (int)x); }
__device__ __forceinline__ int shidx_i(int x, int src) { return __builtin_amdgcn_ds_bpermute(src << 2, x); }
__device__ __forceinline__ float wave_sum(float x) { x = sum16(x); x += shx(x, 16); x += shx(x, 32); return x; }
__device__ __forceinline__ void unpack8(const u32x4 v, float (&f)[8]) {
    f[0] = __uint_as_float(v.x << 16); f[1] = __uint_as_float(v.x & 0xffff0000u); f[2] = __uint_as_float(v.y << 16); f[3] = __uint_as_float(v.y & 0xffff0000u);
    f[4] = __uint_as_float(v.z << 16); f[5] = __uint_as_float(v.z & 0xffff0000u); f[6] = __uint_as_float(v.w << 16); f[7] = __uint_as_float(v.w & 0xffff0000u);
}

#define XB_TMO      128
#define XB_XCNT(j)  (256  + 64 * (j))
#define XB_XSUB(j)  (1280 + 64 * (j))
#define XB_XGEN(j)  (2304 + 64 * (j))
#define XB_TOP      3328
#define XB_TOPGEN   3392
#define XCD_BAR_WORDS 3456
#define XB_SPIN_CAP (1u << 22)
__device__ __forceinline__ unsigned xb_ld(unsigned* p)              { return __hip_atomic_load(p, __ATOMIC_RELAXED, __HIP_MEMORY_SCOPE_AGENT); }
__device__ __forceinline__ unsigned xb_add(unsigned* p, unsigned v) { return __hip_atomic_fetch_add(p, v, __ATOMIC_RELAXED, __HIP_MEMORY_SCOPE_AGENT); }
__device__ __forceinline__ unsigned xb_xcc_id() { return (unsigned)__builtin_amdgcn_s_getreg((3 << 11) | 20) & 0xFu; }
#define XB_SPIN(cond, bar) do { unsigned _sp = 0; while (cond) { __builtin_amdgcn_s_sleep(1); \
    if ((++_sp & 255u) == 0u) { if (xb_ld(&(bar)[XB_TMO])) break; if (_sp > XB_SPIN_CAP) { atomicAdd(&(bar)[XB_TMO], 1u); break; } } } } while (0)
struct XcdBarrier { unsigned* bar; unsigned x; volatile LAS unsigned* st; };
__device__ __forceinline__ XcdBarrier xcd_barrier_post(unsigned* bar, volatile LAS unsigned* st) {
    XcdBarrier b; b.bar = bar; b.x = xb_xcc_id(); b.st = st;
    if (threadIdx.x == 0) (void)xb_add(&bar[XB_XCNT(b.x)], 1u);
    return b;
}
__device__ __forceinline__ void xcd_barrier_complete(unsigned* bar, unsigned x, unsigned& nloc, unsigned& nx) {
    const unsigned G = gridDim.x * gridDim.y * gridDim.z;
    unsigned sum, cnt, mine, sp = 0u;
    for (;;) {
        sum = 0u; cnt = 0u; mine = 0u;
#pragma unroll
        for (unsigned j = 0; j < 16; ++j) { const unsigned c = xb_ld(&bar[XB_XCNT(j)]); sum += c; cnt += (c > 0u) ? 1u : 0u; mine = (j == x) ? c : mine; }
        if (sum == G) break;
        __builtin_amdgcn_s_sleep(1);
        if ((++sp & 255u) == 0u) { if (xb_ld(&bar[XB_TMO])) break; if (sp > XB_SPIN_CAP) { atomicAdd(&bar[XB_TMO], 1u); break; } }
    }
    nloc = mine > 0u ? mine : 1u; nx = cnt > 0u ? cnt : 1u;
}
__device__ __forceinline__ void xcd_barrier(const XcdBarrier& b_) {
    XcdBarrier b = b_; { const unsigned long long v = (unsigned long long)b.bar; unsigned lo = __builtin_amdgcn_readfirstlane((unsigned)v), hi = __builtin_amdgcn_readfirstlane((unsigned)(v >> 32)); asm volatile("" : "+s"(lo), "+s"(hi)); b.bar = (unsigned*)(((unsigned long long)hi << 32) | lo); unsigned xx = __builtin_amdgcn_readfirstlane(b.x); asm volatile("" : "+s"(xx)); b.x = xx; }
    asm volatile("s_waitcnt vmcnt(0)" ::: "memory");
    __syncthreads();
    if (threadIdx.x == 0) {
        unsigned* bar = b.bar;
        __builtin_amdgcn_s_waitcnt(0);
        unsigned nloc = b.st[0], nx = b.st[1];
        if (nloc == 0u) { xcd_barrier_complete(bar, b.x, nloc, nx); b.st[0] = nloc; b.st[1] = nx; }
        const unsigned old = xb_add(&bar[XB_XSUB(b.x)], 1u);
        const unsigned gen = old / nloc;
        if (old + 1u == (gen + 1u) * nloc) {
            __builtin_amdgcn_fence(__ATOMIC_RELEASE, "agent");
            asm volatile("s_waitcnt vmcnt(0)" ::: "memory");
            const unsigned og = xb_add(&bar[XB_TOP], 1u);
            const unsigned tg = og / nx;
            if (og + 1u == (tg + 1u) * nx) xb_add(&bar[XB_TOPGEN], 1u);
            else XB_SPIN(xb_ld(&bar[XB_TOPGEN]) == tg, bar);
            __builtin_amdgcn_fence(__ATOMIC_ACQUIRE, "agent");
            xb_add(&bar[XB_XGEN(b.x)], 1u);
            asm volatile("s_waitcnt vmcnt(0)" ::: "memory");
        } else {
            XB_SPIN(xb_ld(&bar[XB_XGEN(b.x)]) == gen, bar);
            __builtin_amdgcn_fence(__ATOMIC_ACQUIRE, "agent");
            asm volatile("s_waitcnt vmcnt(0)" ::: "memory");
        }
    }
    __syncthreads();
}

namespace pg8 {
constexpr int BM = 256, BK = 64, HALF = 128, HTB = HALF * BK * 2, STAGE_BYTES = 8 * HTB, NXCD = 8, WGM = 8;
__host__ __device__ __forceinline__ int lds_byte(int r, int c) { const int st = (r >> 4) * 2 + (c >> 5), rr = r & 15, cc = c & 31, ob = rr * 64 + cc * 2; return st * 1024 + (ob ^ (((ob >> 9) & 1) << 5)); }
__host__ __device__ __forceinline__ void stage_rc(int b, int& R, int& C) { const int st = b / 1024, sb = b % 1024, swz = sb ^ (((sb >> 9) & 1) << 5); R = (st >> 1) * 16 + swz / 64; C = (st & 1) * 32 + (swz % 64) / 2; }
__host__ __device__ __forceinline__ int perm32(int rho) { const int n = rho >> 4, i = rho & 15; return 8 * (i >> 2) + 4 * n + (i & 3); }
struct Unit { int pm, pn; const char* a; const char* b; };

struct StaticOrder {
    int nM, nN, nwg, G, c, K; const char* A; const char* B;
    __device__ void init(const bf16_t* A_, const bf16_t* B_, int M, int N, int K_, int G_, int c_) { A = (const char*)A_; B = (const char*)B_; K = K_; nM = M / BM; nN = N / BM; nwg = nM * nN; G = G_; c = c_; }
    __device__ bool next(int i, Unit& u) const {
        const long L = (long)i * G + c; if (L >= nwg) return false;
        int wgid = (int)L; { const int q = nwg / NXCD, r = nwg % NXCD, xcd = wgid % NXCD, off = wgid / NXCD; wgid = (xcd < r ? xcd * (q + 1) : r * (q + 1) + (xcd - r) * q) + off; }
        const int nig = WGM * nN, gid = wgid / nig, fm = gid * WGM, gsz = (nM - fm) < WGM ? (nM - fm) : WGM;
        u.pm = fm + ((wgid % nig) % gsz); u.pn = (wgid % nig) / gsz;
        u.a = A + (size_t)u.pm * 256 * K * 2; u.b = B + (size_t)u.pn * 256 * K * 2; return true;
    }
};

template <class Epi, class Sched>
__device__ __forceinline__ void gemm_phase(LAS unsigned char* lds, const int K_, const Sched& S, const Epi& E) {
    int K = K_; asm volatile("" : "+s"(K));
    int tid_ = threadIdx.x; asm volatile("" : "+v"(tid_));
    const int tid = tid_, wid = __builtin_amdgcn_readfirstlane(tid >> 6), lane = tid & 63, wr = wid >> 2, wc = wid & 3, fr = lane & 15, fq = lane >> 4;
    const int nt = K / BK;
    unsigned voffA[2], voffB[2];
#pragma unroll
    for (int i = 0; i < 2; ++i) { int R, C; stage_rc(tid * 16 + i * 8192, R, C); const int Rb = Epi::PERM ? ((R & ~31) + perm32(R & 31)) : R;
        voffA[i] = (unsigned)(R * K + C) * 2u; voffB[i] = (unsigned)(Rb * K + C) * 2u; }
    const size_t kstep = (size_t)(BK * 2);
    const size_t hstep = (size_t)HALF * K * 2;
    const unsigned ldsw = (unsigned)wid * 1024u;
    const int aoff = lds_byte(wr * 64 + fr, fq * 8), boff = lds_byte(wc * 32 + fr, fq * 8);
#define PG8_SA(b, h) (((b) * 2 + (h)) * HTB)
#define PG8_SB(b, h) ((4 + (b) * 2 + (h)) * HTB)
#define PG8_STAGE(bufoff, gbase, voff) do { _Pragma("unroll") for (int _i = 0; _i < 2; ++_i) \
        __builtin_amdgcn_global_load_lds((const unsigned*)((const char*)(gbase) + (voff)[_i]), (LAS unsigned*)(lds + (bufoff) + ldsw + _i * 8192), 16, 0, 0); } while (0)
#define PG8_LDA(dst, b, h) do { _Pragma("unroll") for (int m = 0; m < 4; ++m) _Pragma("unroll") for (int k = 0; k < 2; ++k) dst[m][k] = *(const LAS bf16x8*)(lds + PG8_SA(b, h) + aoff + m * 2048 + k * 1024); } while (0)
#define PG8_LDB(dst, b, h) do { _Pragma("unroll") for (int n = 0; n < 2; ++n) _Pragma("unroll") for (int k = 0; k < 2; ++k) dst[n][k] = *(const LAS bf16x8*)(lds + PG8_SB(b, h) + boff + n * 2048 + k * 1024); } while (0)
#define PG8_MMA(ai, bj, At, Bt) do { __builtin_amdgcn_s_setprio(1); _Pragma("unroll") for (int m = 0; m < 4; ++m) _Pragma("unroll") for (int n = 0; n < 2; ++n) _Pragma("unroll") for (int k = 0; k < 2; ++k) \
        acc[ai][bj][m][n] = __builtin_amdgcn_mfma_f32_16x16x32_bf16(Bt[n][k], At[m][k], acc[ai][bj][m][n], 0, 0, 0); __builtin_amdgcn_s_setprio(0); } while (0)
#define PG8_WAIT_V(n) asm volatile("s_waitcnt vmcnt(" #n ")" ::: "memory")
#define PG8_WAIT_L(n) asm volatile("s_waitcnt lgkmcnt(" #n ")" ::: "memory")
#define PG8_BAR __builtin_amdgcn_s_barrier()
#define PG8_SCHED __builtin_amdgcn_sched_barrier(0)
    Unit cur, nxt; int ui = 0;
    if (!S.next(0, cur)) return;
    f32x4 acc[2][2][4][2];
#pragma unroll
    for (int a = 0; a < 2; ++a)
#pragma unroll
        for (int b = 0; b < 2; ++b)
#pragma unroll
            for (int m = 0; m < 4; ++m)
#pragma unroll
                for (int n = 0; n < 2; ++n) acc[a][b][m][n] = (f32x4){0.f, 0.f, 0.f, 0.f};
    bf16x8 At[4][2], B0[2][2], B1[2][2];
    const char* cA = cur.a; const char* cB = cur.b;
    PG8_STAGE(PG8_SB(0, 0), cB, voffB); PG8_STAGE(PG8_SA(0, 0), cA, voffA); PG8_STAGE(PG8_SB(0, 1), cB + hstep, voffB); PG8_STAGE(PG8_SA(0, 1), cA + hstep, voffA);
    if (wr == 1) PG8_BAR;
    PG8_WAIT_V(4); PG8_BAR;
    PG8_STAGE(PG8_SB(1, 0), cB + kstep, voffB); PG8_STAGE(PG8_SA(1, 0), cA + kstep, voffA); PG8_STAGE(PG8_SB(1, 1), cB + hstep + kstep, voffB);
    PG8_WAIT_V(6); PG8_BAR;
    for (;;) {
        const bool has_next = S.next(ui + 1, nxt);
        const char* nA = has_next ? nxt.a : cA; const char* nB = has_next ? nxt.b : cB;
        for (int t = 0; t < nt; t += 2) {
            const bool last = (t == nt - 2);
            const char* a1 = cA + (size_t)(t + 1) * kstep;
            const char* a2 = last ? nA : cA + (size_t)(t + 2) * kstep; const char* b2 = last ? nB : cB + (size_t)(t + 2) * kstep;
            const char* a3 = a2 + kstep; const char* b3 = b2 + kstep;
            PG8_LDB(B0, 0, 0); PG8_SCHED; PG8_LDA(At, 0, 0); PG8_STAGE(PG8_SA(1, 1), a1 + hstep, voffA);
            PG8_WAIT_L(8); PG8_BAR; PG8_WAIT_L(0); PG8_MMA(0, 0, At, B0); PG8_BAR; PG8_SCHED;
            PG8_LDB(B1, 0, 1); PG8_STAGE(PG8_SB(0, 0), b2, voffB);
            PG8_BAR; PG8_WAIT_L(0); PG8_MMA(0, 1, At, B1); PG8_BAR;
            PG8_LDA(At, 0, 1); PG8_STAGE(PG8_SA(0, 0), a2, voffA);
            PG8_BAR; PG8_WAIT_L(0); PG8_MMA(1, 0, At, B0); PG8_BAR; PG8_SCHED;
            PG8_STAGE(PG8_SB(0, 1), b2 + hstep, voffB);
            PG8_WAIT_V(6); PG8_BAR; PG8_MMA(1, 1, At, B1); PG8_BAR;
            PG8_LDB(B0, 1, 0); PG8_SCHED; PG8_LDA(At, 1, 0); PG8_STAGE(PG8_SA(0, 1), a2 + hstep, voffA);
            PG8_WAIT_L(8); PG8_BAR; PG8_WAIT_L(0); PG8_MMA(0, 0, At, B0); PG8_BAR; PG8_SCHED;
            PG8_LDB(B1, 1, 1); PG8_STAGE(PG8_SB(1, 0), b3, voffB);
            PG8_BAR; PG8_WAIT_L(0); PG8_MMA(0, 1, At, B1); PG8_BAR;
            PG8_LDA(At, 1, 1); PG8_STAGE(PG8_SA(1, 0), a3, voffA);
            PG8_BAR; PG8_WAIT_L(0); PG8_MMA(1, 0, At, B0); PG8_BAR; PG8_SCHED;
            PG8_STAGE(PG8_SB(1, 1), b3 + hstep, voffB);
            PG8_WAIT_V(6); PG8_BAR; PG8_MMA(1, 1, At, B1); PG8_BAR;
        }
        E(acc, cur, wr, wc, fr, fq);
        if (!has_next) break;
#pragma unroll
        for (int a = 0; a < 2; ++a)
#pragma unroll
            for (int b = 0; b < 2; ++b)
#pragma unroll
                for (int m = 0; m < 4; ++m)
#pragma unroll
                    for (int n = 0; n < 2; ++n) acc[a][b][m][n] = (f32x4){0.f, 0.f, 0.f, 0.f};
        cur = nxt; cA = nA; cB = nB; ++ui;
    }
    PG8_WAIT_V(0);
    if (wr == 0) PG8_BAR;
    PG8_BAR;
#undef PG8_SA
#undef PG8_SB
#undef PG8_STAGE
#undef PG8_LDA
#undef PG8_LDB
#undef PG8_MMA
#undef PG8_WAIT_V
#undef PG8_WAIT_L
#undef PG8_BAR
#undef PG8_SCHED
}

struct EpiBf16 {
    static constexpr bool PERM = true;
    bf16_t* O; int ldc;
    __device__ __forceinline__ void operator()(const f32x4 (&acc)[2][2][4][2], const Unit& u, int wr, int wc, int fr, int fq) const {
        const int row0 = u.pm * BM + wr * 64 + fr, col0 = u.pn * BM + wc * 32 + 8 * fq;
#pragma unroll
        for (int ai = 0; ai < 2; ++ai)
#pragma unroll
            for (int m = 0; m < 4; ++m) { bf16_t* rowp = O + (size_t)(row0 + ai * HALF + m * 16) * ldc + col0;
#pragma unroll
                for (int bj = 0; bj < 2; ++bj) { const f32x4 v0 = acc[ai][bj][m][0], v1 = acc[ai][bj][m][1];
                    u32x4 w; w.x = cvt_pk_bf16(v0[0], v0[1]); w.y = cvt_pk_bf16(v0[2], v0[3]); w.z = cvt_pk_bf16(v1[0], v1[1]); w.w = cvt_pk_bf16(v1[2], v1[3]);
                    *(u32x4*)(rowp + bj * HALF) = w; } }
    }
};
struct EpiResid {
    static constexpr bool PERM = false;
    float* C; int ldc;
    __device__ __forceinline__ void operator()(const f32x4 (&acc)[2][2][4][2], const Unit& u, int wr, int wc, int fr_, int fq_) const {
        int fr = fr_, fq = fq_; asm volatile("" : "+v"(fr), "+v"(fq));
        const int row0 = u.pm * BM + wr * 64 + fr, col0 = u.pn * BM + wc * 32 + 4 * fq;
#pragma unroll
        for (int ai = 0; ai < 2; ++ai)
#pragma unroll
            for (int mp = 0; mp < 2; ++mp) { f32x4 cv[2][2][2];
#pragma unroll
                for (int mm = 0; mm < 2; ++mm) { const float* rowp = C + (size_t)(row0 + ai * HALF + (2 * mp + mm) * 16) * ldc + col0;
#pragma unroll
                    for (int bj = 0; bj < 2; ++bj)
#pragma unroll
                        for (int n = 0; n < 2; ++n) cv[mm][bj][n] = *(const f32x4*)(rowp + bj * HALF + n * 16); }
#pragma unroll
                for (int mm = 0; mm < 2; ++mm) { float* rowp = C + (size_t)(row0 + ai * HALF + (2 * mp + mm) * 16) * ldc + col0;
#pragma unroll
                    for (int bj = 0; bj < 2; ++bj)
#pragma unroll
                        for (int n = 0; n < 2; ++n) *(f32x4*)(rowp + bj * HALF + n * 16) = cv[mm][bj][n] + acc[ai][bj][2 * mp + mm][n]; }
                asm volatile("" ::: "memory"); }
    }
};
template <int ACT  > struct EpiGated {
    static constexpr bool PERM = true;
    bf16_t* O; int ldo; int coloff; const float* ba; const float* bb;
    __device__ __forceinline__ void operator()(const f32x4 (&acc)[2][2][4][2], const Unit& u, int wr, int wc, int fr, int fq) const {
        const int row0 = u.pm * BM + wr * 64 + fr, cl = u.pn * HALF + wc * 32 + 8 * fq;
        float va[8], vb[8];
#pragma unroll
        for (int j = 0; j < 8; ++j) { va[j] = (ACT == 0) ? ba[cl + j] : 0.f; vb[j] = (ACT == 0) ? bb[cl + j] : 0.f; }
#pragma unroll
        for (int ai = 0; ai < 2; ++ai)
#pragma unroll
            for (int m = 0; m < 4; ++m) { bf16_t* rowp = O + (size_t)(row0 + ai * HALF + m * 16) * ldo + coloff + cl;
                float o[8];
#pragma unroll
                for (int n = 0; n < 2; ++n)
#pragma unroll
                    for (int j = 0; j < 4; ++j) { const float a = acc[ai][0][m][n][j] + va[4 * n + j], b = acc[ai][1][m][n][j] + vb[4 * n + j];
                        o[4 * n + j] = (ACT == 0) ? a * sigmoidf_(b) : siluf_(a) * b; }
                u32x4 w; w.x = cvt_pk_bf16(o[0], o[1]); w.y = cvt_pk_bf16(o[2], o[3]); w.z = cvt_pk_bf16(o[4], o[5]); w.w = cvt_pk_bf16(o[6], o[7]);
                *(u32x4*)rowp = w; asm volatile("" ::: "memory"); }
    }
};
struct EpiMoeOut {
    static constexpr bool PERM = true;
    bf16_t* O; const int* row_tok; const float* row_w; LAS unsigned char* lds;
    __device__ __forceinline__ void operator()(const f32x4 (&acc)[2][2][4][2], const Unit& u, int wr, int wc, int fr_, int fq_) const {
        int fr = fr_, fq = fq_; asm volatile("" : "+v"(fr), "+v"(fq));
        const int col0 = u.pn * BM + wc * 32 + 8 * fq, lane = fq * 16 + fr;
        LAS u32x2* rinfo = (LAS u32x2*)(lds + STAGE_BYTES) + (wr * 4 + wc) * 128;
        { const int ra = u.pm * BM + wr * 64 + lane, rb = ra + HALF;
          const u32x2 ia = (u32x2){(unsigned)row_tok[ra], __float_as_uint(row_w[ra])}, ib = (u32x2){(unsigned)row_tok[rb], __float_as_uint(row_w[rb])};
          rinfo[lane] = ia; rinfo[64 + lane] = ib; }
#pragma unroll
        for (int ai = 0; ai < 2; ++ai)
#pragma unroll
            for (int m = 0; m < 4; ++m) { const u32x2 inf = rinfo[ai * 64 + m * 16 + fr]; const int ts = (int)inf.x; const float w = __uint_as_float(inf.y);
                if (ts >= 0) { bf16_t* rowp = O + ((size_t)(ts & 1) * NTOK + (size_t)(ts >> 1)) * DM + col0;
#pragma unroll
                    for (int bj = 0; bj < 2; ++bj) { const f32x4 v0 = acc[ai][bj][m][0] * w, v1 = acc[ai][bj][m][1] * w;
                        u32x4 q; q.x = cvt_pk_bf16(v0[0], v0[1]); q.y = cvt_pk_bf16(v0[2], v0[3]); q.z = cvt_pk_bf16(v1[0], v1[1]); q.w = cvt_pk_bf16(v1[2], v1[3]);
                        *(u32x4*)(rowp + bj * HALF) = q; } } }
    }
};
struct MoeOrder {
    int K; const char* A; const char* B; size_t bstride; const LAS int* list;
    static __device__ __forceinline__ void build(LAS int* list, const int* tiles, int nN, int G, int c) {
        const int nrt = tiles[0], nwg = nrt * nN; int n = 0;
        for (int i = 0; ; ++i) { const long L = (long)i * G + c; if (L >= (long)nwg || n >= 20) break;
            int wgid = (int)L; { const int q = nwg / NXCD, r = nwg % NXCD, xcd = wgid % NXCD, off = wgid / NXCD; wgid = (xcd < r ? xcd * (q + 1) : r * (q + 1) + (xcd - r) * q) + off; }
            const int pm = wgid / nN; list[1 + 3 * n] = pm; list[2 + 3 * n] = wgid % nN; list[3 + 3 * n] = tiles[64 + pm]; ++n; }
        list[0] = n;
    }
    __device__ bool next(int i, Unit& u) const {
        const int n = __builtin_amdgcn_readfirstlane(list[0]); if (i >= n) return false;
        u.pm = __builtin_amdgcn_readfirstlane(list[1 + 3 * i]); u.pn = __builtin_amdgcn_readfirstlane(list[2 + 3 * i]); const int e = __builtin_amdgcn_readfirstlane(list[3 + 3 * i]);
        u.a = A + (size_t)u.pm * 256 * K * 2; u.b = B + (size_t)e * bstride + (size_t)u.pn * 256 * K * 2; return true;
    }
};
}

struct Params { const float* in[44]; float* out; unsigned char* ws; int ph_lo, ph_hi; };
enum { I_X = 0, I_NORM1, I_WIN, I_MCONVW, I_MCONVB, I_MDTB, I_MALOG, I_MD, I_MNORM, I_RMU, I_RW0, I_RW2, I_RA0, I_RA2, I_RG2, I_RKK, I_RKA, I_RRK, I_RLNW, I_RLNB,
       I_CKVN, I_CWUK, I_CWUV, I_RELB, I_SARE, I_SAIM, I_SBRE, I_SBIM, I_SCRE, I_SCIM, I_SD, I_SLOGDT, I_SGLUW, I_SGLUB, I_WOUT, I_NORM2, I_WRG, I_BRG, I_WRE, I_BRE,
       I_WGATE, I_WUP, I_WDOWN, I_FNORM };

typedef const float* const __attribute__((address_space(4)))* in_tab_t;
struct Frame {
    LAS unsigned char* lds; int tid, lane, wave, bid, G;
    in_tab_t in; float* out; unsigned char* ws; unsigned* ctl;
    volatile LAS int* misc;
};

__device__ __forceinline__ int q_pop(Frame& F, int qi) {
    __syncthreads();
    if (F.tid == 0) F.misc[0] = (int)__hip_atomic_fetch_add(F.ctl + CW_Q + 64 * qi, 1u, __ATOMIC_RELAXED, __HIP_MEMORY_SCOPE_AGENT);
    __syncthreads();
    return F.misc[0];
}

__device__ __forceinline__ const void* opaque_ptr(const void* p) { const unsigned long long v = (unsigned long long)p; unsigned lo = __builtin_amdgcn_readfirstlane((unsigned)v), hi = __builtin_amdgcn_readfirstlane((unsigned)(v >> 32));
    asm volatile("" : "+s"(lo), "+s"(hi)); return (const void*)(((unsigned long long)hi << 32) | lo); }
__device__ __forceinline__ Frame relocal(const Frame& G) { Frame F = G; asm volatile("" : "+v"(F.tid)); F.ws = (unsigned char*)opaque_ptr(F.ws); F.ctl = (unsigned*)(F.ws + WS_CTL); F.in = (in_tab_t)(unsigned long long)opaque_ptr((const void*)(unsigned long long)F.in); F.lane = F.tid & 63; F.wave = __builtin_amdgcn_readfirstlane(F.tid >> 6); return F; }
template <int K> __device__ __forceinline__ f32x4 mma_nt(const LAS bf16_t* A, int lda, const LAS bf16_t* Bt, int ldb, f32x4 acc, int lane) {
    const int r = lane & 15, g = lane >> 4;
#pragma unroll
    for (int k0 = 0; k0 < K; k0 += 32) {
        const bf16x8 a = *(const LAS bf16x8*)(A + r * lda + k0 + 8 * g);
        const bf16x8 b = *(const LAS bf16x8*)(Bt + r * ldb + k0 + 8 * g);
        acc = __builtin_amdgcn_mfma_f32_16x16x32_bf16(a, b, acc, 0, 0, 0);
    }
    return acc;
}

template <class SrcMap> __device__ __forceinline__ void tr_tile(Frame& F, int ldsrc, bf16_t* dst, int K, int k0, int n0, SrcMap sm) {
    LAS float* tile = (LAS float*)F.lds;
    __syncthreads();
    { const int n4 = (F.tid & 63) * 4, kk = F.tid >> 6; const float* sp = sm(n0 + n4);
      f32x4 v[8];
#pragma unroll
      for (int ps = 0; ps < 8; ++ps) { v[ps] = (f32x4){0.f, 0.f, 0.f, 0.f}; if (sp) v[ps] = *(const f32x4*)(sp + (size_t)(k0 + kk + 8 * ps) * ldsrc); }
#pragma unroll
      for (int ps = 0; ps < 8; ++ps) { LAS float* t = tile + (kk + 8 * ps) * 257 + n4; t[0] = v[ps][0]; t[1] = v[ps][1]; t[2] = v[ps][2]; t[3] = v[ps][3]; } }
    __syncthreads();
    { const int kc = F.tid & 7;
#pragma unroll
      for (int j = 0; j < 4; ++j) { const int n = (F.tid >> 3) + 64 * j; float f[8];
#pragma unroll
          for (int i = 0; i < 8; ++i) f[i] = tile[(8 * kc + i) * 257 + n];
          u32x4 w; w.x = pk2(f[0], f[1]); w.y = pk2(f[2], f[3]); w.z = pk2(f[4], f[5]); w.w = pk2(f[6], f[7]);
          *(u32x4*)(dst + (size_t)(n0 + n) * K + k0 + 8 * kc) = w; } }
}

struct SmIn { const float* base; __device__ __forceinline__ const float* operator()(int n) const {
    int c; if (n < 772) c = n; else if (n < UR) return nullptr; else if (n < UR + 896) c = 772 + (n - UR); else if (n < UC) return nullptr;
    else if (n < UC + 680) c = 1668 + (n - UC); else if (n < US) return nullptr; else if (n < US + 256) c = 2348 + (n - US); else return nullptr; return base + c; } };
struct SmId { const float* base; __device__ __forceinline__ const float* operator()(int n) const { return base + n; } };
struct SmGlu { const float* base; __device__ __forceinline__ const float* operator()(int n) const { const int pn = n >> 8, rr = n & 255; return base + (rr < 128 ? 128 * pn + rr : 256 + 128 * pn + (rr - 128)); } };
struct SmGU { const float* gate; const float* up; __device__ __forceinline__ const float* operator()(int n) const {
    const unsigned long long d = (unsigned long long)up - (unsigned long long)gate; const unsigned long long a = (unsigned long long)gate + (((n & 255) < 128) ? 0ull : d); return (const float*)a + 128 * (n >> 8) + (n & 127); } };
__device__ __forceinline__ void phase_prologue(const Frame& F_) { Frame F = relocal(F_);
    for (int t = F.bid; t < 496; t += F.G) {
        if (t < 352) { const int l = t / 176, r = t % 176, kt = r / 11, nt = r % 11;
            tr_tile(F, NIN, (bf16_t*)(F.ws + WS_WIN) + (size_t)l * NINP * DM, DM, kt * 64, nt * 256, SmIn{F.in[I_WIN] + (size_t)l * DM * NIN}); }
        else if (t < 480) { const int q = t - 352, l = q / 64, r = q % 64, kt = r / 4, nt = r % 4;
            tr_tile(F, DM, (bf16_t*)(F.ws + WS_WOUT) + (size_t)l * DM * DM, DM, kt * 64, nt * 256, SmId{F.in[I_WOUT] + (size_t)l * DM * DM}); }
        else { const int q = t - 480, l = q / 8, r = q % 8, kt = r / 2, nt = r % 2;
            tr_tile(F, 512, (bf16_t*)(F.ws + WS_GLU) + (size_t)l * 512 * 256, 256, kt * 64, nt * 256, SmGlu{F.in[I_SGLUW] + (size_t)l * 256 * 512}); }
    }
    for (int i = F.bid * NTHR + F.tid; i < 2 * 48 * 1024; i += F.G * NTHR) { const int l = i / 49152, r = i % 49152, o = r >> 10, k = r & 1023;
        float v = 0.f; if (o < 32) v = F.in[I_WRE][((size_t)l * DM + k) * 32 + o]; else if (o < 36) v = F.in[I_WRG][((size_t)l * DM + k) * 4 + (o - 32)];
        v *= F.in[I_NORM2][l * DM + k];
        const bf16_t hi = f2bf(v); const bf16_t lo = f2bf(v - bf2f(hi));
        bf16_t* w = (bf16_t*)(F.ws + WS_WRT) + (size_t)l * 2 * 49152; w[r] = hi; w[49152 + r] = lo; }
    for (int i = F.bid * NTHR + F.tid; i < 2048 + 65536; i += F.G * NTHR) {
        if (i < 2048) {
            const int l = i >> 10, gn = i & 1023, g = gn >> 6;
            float* tab = (float*)(F.ws + WS_S5TAB + (size_t)l * S5TAB_L);
            const float lre = fminf(F.in[I_SARE][l * 1024 + gn], -1e-4f), lim = F.in[I_SAIM][l * 1024 + gn];
            const float dt = expf(F.in[I_SLOGDT][l * 16 + g]);
            const float mag = expf(dt * lre); float sn, cs; sincosf(dt * lim, &sn, &cs);
            const float are = mag * cs, aim = mag * sn;
            const float den = lre * lre + lim * lim;
            const float fre = ((are - 1.0f) * lre + aim * lim) / den, fim = (aim * lre - (are - 1.0f) * lim) / den;
            tab[gn * 2] = are; tab[gn * 2 + 1] = aim;
            float pr = are, pi = aim;
#pragma unroll
            for (int s = 0; s < 6; ++s) { const float nr = pr * pr - pi * pi, ni = 2.0f * pr * pi; pr = nr; pi = ni; }
            tab[2048 + gn * 2] = pr; tab[2048 + gn * 2 + 1] = pi;
            const float* bre = F.in[I_SBRE] + ((size_t)l * 1024 + gn) * 16; const float* bim = F.in[I_SBIM] + ((size_t)l * 1024 + gn) * 16;
            bf16_t* bbt = (bf16_t*)(F.ws + WS_S5TAB + (size_t)l * S5TAB_L + S5TAB_BBT); const int n = gn & 63, col = 4 * (n & 31) + 2 * (n >> 5);
            for (int p = 0; p < 16; ++p) { const float vr = fre * bre[p] - fim * bim[p], vi = fre * bim[p] + fim * bre[p];
                bbt[((size_t)g * 128 + col) * 16 + p] = f2bf(vr); bbt[((size_t)g * 128 + col + 1) * 16 + p] = f2bf(vi); }
        } else {
            const int j = i - 2048, l = j >> 15, r = j & 32767, gp = r >> 7, k = r & 127;
            bf16_t* cm = (bf16_t*)(F.ws + WS_S5TAB + (size_t)l * S5TAB_L + S5TAB_F);
            const int n = (k >> 2) + 32 * ((k >> 1) & 1);
            const float v = (k & 1) == 0 ? F.in[I_SCRE][((size_t)l * 256 + gp) * 64 + n] : -F.in[I_SCIM][((size_t)l * 256 + gp) * 64 + n];
            cm[r] = f2bf(v);
        }
    }
}

__device__ __forceinline__ void phase_norm(const Frame& F_, const float* xin, bool add_o, const float* w, int mode) { Frame F = relocal(F_);
    float* X = (float*)(F.ws + WS_X); bf16_t* H = (bf16_t*)(F.ws + WS_H); const bf16_t* O = (const bf16_t*)(F.ws + WS_U);
    for (int row0 = F.bid * 32 + F.wave * 4; row0 < NTOK; row0 += F.G * 32) {
        f32x4 v[4][4]; u32x2 oa[4][4], ob[4][4];
#pragma unroll
        for (int r = 0; r < 4; ++r)
#pragma unroll
            for (int j = 0; j < 4; ++j) { const int c = 4 * F.lane + 256 * j; const size_t o = (size_t)(row0 + r) * DM + c; v[r][j] = *(const f32x4*)(xin + o);
                if (add_o) { oa[r][j] = *(const u32x2*)(O + o); ob[r][j] = *(const u32x2*)(O + (size_t)NTOK * DM + o); } }
#pragma unroll
        for (int r = 0; r < 4; ++r) { const int row = row0 + r; float ss = 0.f;
#pragma unroll
            for (int j = 0; j < 4; ++j) {
                if (add_o) { const u32x2 a = oa[r][j], b = ob[r][j];
                    v[r][j][0] += __uint_as_float(a.x << 16) + __uint_as_float(b.x << 16); v[r][j][1] += __uint_as_float(a.x & 0xffff0000u) + __uint_as_float(b.x & 0xffff0000u);
                    v[r][j][2] += __uint_as_float(a.y << 16) + __uint_as_float(b.y << 16); v[r][j][3] += __uint_as_float(a.y & 0xffff0000u) + __uint_as_float(b.y & 0xffff0000u); }
                ss += v[r][j][0] * v[r][j][0] + v[r][j][1] * v[r][j][1] + v[r][j][2] * v[r][j][2] + v[r][j][3] * v[r][j][3]; }
            ss = wave_sum(ss);
            const float rstd = rsqrtf(ss * (1.0f / DM) + 1e-6f);
#pragma unroll
            for (int j = 0; j < 4; ++j) { const int c = 4 * F.lane + 256 * j; const f32x4 wv = *(const f32x4*)(w + c);
                if (mode == 2) { *(f32x4*)(F.out + (size_t)row * DM + c) = v[r][j] * rstd * wv; }
                else { *(f32x4*)(X + (size_t)row * DM + c) = v[r][j];
                    u32x2 o; o.x = pk2(v[r][j][0] * rstd * wv[0], v[r][j][1] * rstd * wv[1]); o.y = pk2(v[r][j][2] * rstd * wv[2], v[r][j][3] * rstd * wv[3]);
                    *(u32x2*)(H + (size_t)row * DM + c) = o; } } }
    }
}

__device__ __forceinline__ void item_kv(const Frame& F_, int layer, int item) { Frame F = relocal(F_);
    const bf16_t* U = (const bf16_t*)(F.ws + WS_U);
    LAS bf16_t* Ab = (LAS bf16_t*)F.lds;
    LAS bf16_t* Bt = (LAS bf16_t*)(F.lds + 17408);
    const int t0 = item * 64;
    { const int tok = F.tid >> 3, part = F.tid & 7; const bf16_t* src = U + (size_t)(t0 + tok) * NINP + UC + 256 + 16 * part;
      float f[16]; { float a[8], b[8]; unpack8(*(const u32x4*)src, a); unpack8(*(const u32x4*)(src + 8), b);
#pragma unroll
        for (int j = 0; j < 8; ++j) { f[j] = a[j]; f[8 + j] = b[j]; } }
      float ss = 0.f;
#pragma unroll
      for (int j = 0; j < 16; ++j) ss += f[j] * f[j];
      ss = sum8(ss);
      const float rstd = rsqrtf(ss * (1.0f / 128.0f) + 1e-6f); const float* nw = F.in[I_CKVN] + layer * 128 + 16 * part;
#pragma unroll
      for (int j = 0; j < 16; j += 2) *(LAS unsigned*)(Ab + tok * 136 + 16 * part + j) = pk2(f[j] * rstd * nw[j], f[j + 1] * rstd * nw[j + 1]); }
    { const int n = F.tid >> 2, kq = F.tid & 3; const float* w = (n < 64 ? F.in[I_CWUK] : F.in[I_CWUV]) + (size_t)layer * 128 * 64 + (n & 63);
      float wv[32];
#pragma unroll
      for (int k = 0; k < 32; ++k) wv[k] = w[(size_t)(32 * kq + k) * 64];
#pragma unroll
      for (int k = 0; k < 32; k += 2) *(LAS unsigned*)(Bt + n * 136 + 32 * kq + k) = pk2(wv[k], wv[k + 1]); }
    if (F.tid < 256) { const int tok = F.tid >> 2, q = F.tid & 3;
        *(u32x4*)((bf16_t*)(F.ws + WS_KIDX) + (size_t)(t0 + tok) * 32 + 8 * q) = *(const u32x4*)(U + (size_t)(t0 + tok) * NINP + UC + 640 + 8 * q); }
    __syncthreads();
    const int mt = F.wave & 3, g = F.lane >> 4, r = F.lane & 15;
#pragma unroll
    for (int q = 0; q < 4; ++q) { const int nt = (F.wave >> 2) * 4 + q;
        f32x4 acc = (f32x4){0.f, 0.f, 0.f, 0.f};
        acc = mma_nt<128>(Ab + mt * 16 * 136, 136, Bt + nt * 16 * 136, 136, acc, F.lane);
        const int n = nt * 16 + r; bf16_t* dst = (bf16_t*)(F.ws + (n < 64 ? WS_K : WS_V));
#pragma unroll
        for (int i = 0; i < 4; ++i) dst[(size_t)(t0 + mt * 16 + 4 * g + i) * 64 + (n & 63)] = f2bf(acc[i]); }
}

constexpr int MB_CG = 0, MB_BG = 18432, MB_BT = 36864, MB_XT = 55296, MB_M = 92160, MB_S0 = 101376, MB_DT = 110592, MB_AC = 111616, MB_RS = 112640;
template <int STAGE> __device__ __forceinline__ void item_mamba(const Frame& F_, int layer, int item) { Frame F = relocal(F_);
    const bf16_t* U = (const bf16_t*)(F.ws + WS_U);
    const int b = item >> 6, c = item & 63, l0 = c * 64; const size_t T0 = (size_t)b * SEQ + l0;
    LAS bf16_t* Cg = (LAS bf16_t*)(F.lds + MB_CG); LAS bf16_t* Bg = (LAS bf16_t*)(F.lds + MB_BG); LAS bf16_t* BT = (LAS bf16_t*)(F.lds + MB_BT);
    LAS bf16_t* XT = (LAS bf16_t*)(F.lds + MB_XT); LAS bf16_t* Mb = (LAS bf16_t*)(F.lds + MB_M); LAS bf16_t* S0 = (LAS bf16_t*)(F.lds + MB_S0);
    LAS float* dts = (LAS float*)(F.lds + MB_DT); LAS float* acs = (LAS float*)(F.lds + MB_AC); LAS float* rs = (LAS float*)(F.lds + MB_RS);
    if (F.tid < 256) { const int l = F.tid >> 2, h = F.tid & 3;
        const float raw = bf2f(U[(T0 + l) * NINP + UM + 768 + h]) + F.in[I_MDTB][layer * 4 + h];
        const float dt = softplusf_(raw); dts[l * 4 + h] = dt; acs[l * 4 + h] = -__expf(F.in[I_MALOG][layer * 4 + h]) * dt; }
    if (F.tid < 64) rs[F.tid] = 0.f;
    __syncthreads();
    float mycum = 0.f;
    if (F.tid < 256) { const int l = F.tid >> 2, h = F.tid & 3; for (int s = 0; s <= l; ++s) mycum += acs[s * 4 + h]; }
    __syncthreads();
    if (F.tid < 256) acs[F.tid] = mycum;
    __syncthreads();
    { const int ch8 = F.tid & 63, tg = F.tid >> 6, c0 = ch8 * 8;
      float wv[4][8], bv[8];
#pragma unroll
      for (int j = 0; j < 8; ++j) { bv[j] = F.in[I_MCONVB][layer * 512 + c0 + j];
#pragma unroll
          for (int k = 0; k < 4; ++k) wv[k][j] = F.in[I_MCONVW][(layer * 4 + k) * 512 + c0 + j]; }
      float win[3][8];
#pragma unroll
      for (int k = 0; k < 3; ++k) { const int l = l0 + tg * 8 - 3 + k;
          if (l >= 0) unpack8(*(const u32x4*)(U + ((size_t)b * SEQ + l) * NINP + UM + 256 + c0), win[k]);
          else {
#pragma unroll
              for (int j = 0; j < 8; ++j) win[k][j] = 0.f; } }
#pragma unroll 1
      for (int ib = 0; ib < 2; ++ib) { u32x4 rows[4];
#pragma unroll
          for (int i4 = 0; i4 < 4; ++i4) rows[i4] = *(const u32x4*)(U + (T0 + tg * 8 + ib * 4 + i4) * NINP + UM + 256 + c0);
#pragma unroll
      for (int i4 = 0; i4 < 4; ++i4) { const int l = tg * 8 + ib * 4 + i4; float cur[8]; unpack8(rows[i4], cur);
          float o[8];
#pragma unroll
          for (int j = 0; j < 8; ++j) { o[j] = siluf_(bv[j] + wv[0][j] * win[0][j] + wv[1][j] * win[1][j] + wv[2][j] * win[2][j] + wv[3][j] * cur[j]);
              win[0][j] = win[1][j]; win[1][j] = win[2][j]; win[2][j] = cur[j]; }
          if (c0 < 256) { const int h = c0 >> 6, p0 = c0 & 63; float sc = dts[l * 4 + h]; if (STAGE == 1) sc *= __expf(acs[63 * 4 + h] - acs[l * 4 + h]);
#pragma unroll
              for (int j = 0; j < 8; ++j) XT[(h * 64 + p0 + j) * 72 + l] = f2bf(o[j] * sc); }
          else if (c0 < 384) { const int g = (c0 - 256) >> 6, n0 = (c0 - 256) & 63;
              if (STAGE == 1) {
#pragma unroll
                  for (int j = 0; j < 8; ++j) BT[(g * 64 + n0 + j) * 72 + l] = f2bf(o[j]); }
              else { u32x4 w; w.x = pk2(o[0], o[1]); w.y = pk2(o[2], o[3]); w.z = pk2(o[4], o[5]); w.w = pk2(o[6], o[7]); *(LAS u32x4*)(Bg + (g * 64 + l) * 72 + n0) = w; } }
          else if (STAGE == 2) { const int g = (c0 - 384) >> 6, n0 = (c0 - 384) & 63;
              u32x4 w; w.x = pk2(o[0], o[1]); w.y = pk2(o[2], o[3]); w.z = pk2(o[4], o[5]); w.w = pk2(o[6], o[7]); *(LAS u32x4*)(Cg + (g * 64 + l) * 72 + n0) = w; } } } }
    __syncthreads();
    const int g4 = F.lane >> 4, r16 = F.lane & 15;
    if (STAGE == 1) {
        float* MST = (float*)(F.ws + WS_MST) + ((size_t)(b * 64 + c) * 4) * 4096;
#pragma unroll
        for (int q = 0; q < 8; ++q) { const int tix = F.wave * 8 + q, h = tix >> 4, mt = (tix >> 2) & 3, nt = tix & 3;
            f32x4 acc = (f32x4){0.f, 0.f, 0.f, 0.f};
            acc = mma_nt<64>(XT + (h * 64 + mt * 16) * 72, 72, BT + ((h >> 1) * 64 + nt * 16) * 72, 72, acc, F.lane);
#pragma unroll
            for (int i = 0; i < 4; ++i) MST[(size_t)h * 4096 + (mt * 16 + 4 * g4 + i) * 64 + nt * 16 + r16] = acc[i]; }
        if (F.tid < 4) ((float*)(F.ws + WS_MDEC))[(b * 64 + c) * 4 + F.tid] = __expf(acs[63 * 4 + F.tid]);
    } else {
        const int mt = F.wave & 3, nh = F.wave >> 2;
        const float* MST = (const float*)(F.ws + WS_MST) + ((size_t)(b * 64 + c) * 4) * 4096;
        f32x4 G[2], yv[4][2];
#pragma unroll
        for (int h = 0; h < 4; ++h) {
            const int g = h >> 1;
            { const float* src = MST + (size_t)h * 4096 + F.tid * 8; const f32x4 a = *(const f32x4*)src, bq = *(const f32x4*)(src + 4);
              u32x4 w; w.x = pk2(a[0], a[1]); w.y = pk2(a[2], a[3]); w.z = pk2(bq[0], bq[1]); w.w = pk2(bq[2], bq[3]);
              *(LAS u32x4*)(S0 + (F.tid >> 3) * 72 + (F.tid & 7) * 8) = w; }
            if ((h & 1) == 0) {
#pragma unroll
                for (int q = 0; q < 2; ++q) { G[q] = (f32x4){0.f, 0.f, 0.f, 0.f};
                    G[q] = mma_nt<64>(Cg + (g * 64 + mt * 16) * 72, 72, Bg + (g * 64 + (2 * nh + q) * 16) * 72, 72, G[q], F.lane); } }
#pragma unroll
            for (int q = 0; q < 2; ++q) { const int s = (2 * nh + q) * 16 + r16; const float as = acs[s * 4 + h];
#pragma unroll
                for (int i = 0; i < 4; ++i) { const int l = mt * 16 + 4 * g4 + i; const float v = (s <= l) ? G[q][i] * __expf(acs[l * 4 + h] - as) : 0.f;
                    Mb[l * 72 + s] = f2bf(v); } }
            __syncthreads();
#pragma unroll
            for (int q = 0; q < 2; ++q) { const int nt = 2 * nh + q;
                f32x4 yd = (f32x4){0.f, 0.f, 0.f, 0.f}, yo = (f32x4){0.f, 0.f, 0.f, 0.f};
                yd = mma_nt<64>(Mb + mt * 16 * 72, 72, XT + (h * 64 + nt * 16) * 72, 72, yd, F.lane);
                yo = mma_nt<64>(Cg + (g * 64 + mt * 16) * 72, 72, S0 + nt * 16 * 72, 72, yo, F.lane);
                const int p = nt * 16 + r16; const float dsk = F.in[I_MD][layer * 4 + h];
#pragma unroll
                for (int i = 0; i < 4; ++i) { const int l = mt * 16 + 4 * g4 + i;
                    const float xs = bf2f(XT[(h * 64 + p) * 72 + l]) / dts[l * 4 + h];
                    yv[h][q][i] = yd[i] + yo[i] * __expf(acs[l * 4 + h]) + dsk * xs; } }
            __syncthreads();
        }
        float part[4] = {0.f, 0.f, 0.f, 0.f};
#pragma unroll
        for (int h = 0; h < 4; ++h)
#pragma unroll
            for (int q = 0; q < 2; ++q) { const int ch = h * 64 + (2 * nh + q) * 16 + r16;
#pragma unroll
                for (int i = 0; i < 4; ++i) { const int l = mt * 16 + 4 * g4 + i; const float z = bf2f(U[(T0 + l) * NINP + UM + ch]);
                    const float v = yv[h][q][i] * siluf_(z); yv[h][q][i] = v; part[i] += v * v; } }
#pragma unroll
        for (int i = 0; i < 4; ++i) { const float s = sum16(part[i]); if (r16 == 0) atomicAdd((float*)(rs + mt * 16 + 4 * g4 + i), s); }
        __syncthreads();
        bf16_t* Y = (bf16_t*)(F.ws + WS_H);
#pragma unroll
        for (int i = 0; i < 4; ++i) { const int l = mt * 16 + 4 * g4 + i; const float rstd = rsqrtf(rs[l] * (1.0f / 256.0f) + 1e-6f);
#pragma unroll
            for (int h = 0; h < 4; ++h)
#pragma unroll
                for (int q = 0; q < 2; ++q) { const int ch = h * 64 + (2 * nh + q) * 16 + r16;
                    Y[(T0 + l) * DM + ch] = f2bf(yv[h][q][i] * rstd * F.in[I_MNORM][layer * 256 + ch]); } }
    }
}
__device__ __forceinline__ void item_mamba_carry(const Frame& F_, int item) { Frame F = relocal(F_);
    const int b = item >> 2, h = item & 3;
    float* MST = (float*)(F.ws + WS_MST); const float* MD = (const float*)(F.ws + WS_MDEC);
    float s[8];
#pragma unroll
    for (int j = 0; j < 8; ++j) s[j] = 0.f;
    for (int c = 0; c < 64; ++c) { float* p = MST + ((size_t)(b * 64 + c) * 4 + h) * 4096 + F.tid * 8; const float d = MD[(b * 64 + c) * 4 + h];
        const f32x4 a = *(f32x4*)p, q = *(f32x4*)(p + 4);
        *(f32x4*)p = (f32x4){s[0], s[1], s[2], s[3]}; *(f32x4*)(p + 4) = (f32x4){s[4], s[5], s[6], s[7]};
        s[0] = s[0] * d + a[0]; s[1] = s[1] * d + a[1]; s[2] = s[2] * d + a[2]; s[3] = s[3] * d + a[3];
        s[4] = s[4] * d + q[0]; s[5] = s[5] * d + q[1]; s[6] = s[6] * d + q[2]; s[7] = s[7] * d + q[3]; }
}

template <int STAGE> __device__ __forceinline__ void item_s5(const Frame& F_, int layer, int item) { Frame F = relocal(F_);
    const bf16_t* U = (const bf16_t*)(F.ws + WS_U);
    const int b = item >> 6, c = item & 63; const size_t T0 = (size_t)b * SEQ + c * 64;
    LAS bf16_t* us = (LAS bf16_t*)F.lds;
    LAS bf16_t* BuW = (LAS bf16_t*)(F.lds + 33792) + F.wave * 4224;
    const float* tab = (const float*)(F.ws + WS_S5TAB + (size_t)layer * S5TAB_L);
    { const int tok = F.tid >> 3, part = F.tid & 7;
#pragma unroll
      for (int q = 0; q < 4; ++q) *(LAS u32x4*)(us + tok * 264 + 32 * part + 8 * q) = *(const u32x4*)(U + (T0 + tok) * NINP + US + 32 * part + 8 * q); }
    const int lane = F.lane, r16 = lane & 15, g4 = lane >> 4, gq = lane >> 5, n0 = lane & 31, g = 2 * F.wave + gq, gn0 = g * 64 + n0, gn1 = gn0 + 32;
    bf16x8 bfr[2][8];
    { const bf16_t* bbt = (const bf16_t*)(F.ws + WS_S5TAB + (size_t)layer * S5TAB_L + S5TAB_BBT);
#pragma unroll
      for (int gg = 0; gg < 2; ++gg)
#pragma unroll
          for (int nt = 0; nt < 8; ++nt) { u32x4 z = (u32x4){0u, 0u, 0u, 0u}; if (g4 < 2) z = *(const u32x4*)(bbt + ((size_t)(2 * F.wave + gg) * 128 + 16 * nt + r16) * 16 + 8 * g4); bfr[gg][nt] = __builtin_bit_cast(bf16x8, z); } }
    const float a0r = tab[gn0 * 2], a0i = tab[gn0 * 2 + 1], a1r = tab[gn1 * 2], a1i = tab[gn1 * 2 + 1];
    float* ST = (float*)(F.ws + WS_S5ST) + (size_t)(b * 64 + c) * 2048;
    float h0r = 0.f, h0i = 0.f, h1r = 0.f, h1i = 0.f;
    if (STAGE == 2) { h0r = ST[gn0 * 2]; h0i = ST[gn0 * 2 + 1]; h1r = ST[gn1 * 2]; h1i = ST[gn1 * 2 + 1]; }
    bf16x8 cf[2][4];
    if (STAGE == 2) { const bf16_t* cm = (const bf16_t*)(F.ws + WS_S5TAB + (size_t)layer * S5TAB_L + S5TAB_F);
#pragma unroll
        for (int gg = 0; gg < 2; ++gg)
#pragma unroll
            for (int ks = 0; ks < 4; ++ks) cf[gg][ks] = *(const bf16x8*)(cm + ((size_t)((2 * F.wave + gg) * 16 + r16)) * 128 + 32 * ks + 8 * g4); }
    __syncthreads();
#pragma unroll 1
    for (int lb = 0; lb < 4; ++lb) {
#pragma unroll
        for (int gg = 0; gg < 2; ++gg) { u32x4 z = (u32x4){0u, 0u, 0u, 0u}; if (g4 < 2) z = *(const LAS u32x4*)(us + (16 * lb + r16) * 264 + (2 * F.wave + gg) * 16 + 8 * g4);
            const bf16x8 afr = __builtin_bit_cast(bf16x8, z);
#pragma unroll
            for (int nt = 0; nt < 8; ++nt) { const f32x4 acc = __builtin_amdgcn_mfma_f32_16x16x32_bf16(afr, bfr[gg][nt], (f32x4){0.f, 0.f, 0.f, 0.f}, 0, 0, 0);
#pragma unroll
                for (int i = 0; i < 4; ++i) BuW[(4 * g4 + i) * 264 + gg * 128 + 16 * nt + r16] = f2bf(acc[i]); } }
        __syncthreads();
#pragma unroll 4
        for (int li = 0; li < 16; ++li) { LAS u32x2* bp = (LAS u32x2*)(BuW + li * 264 + gq * 128 + 4 * n0); const u32x2 v = *bp;
            { const float br = __uint_as_float(v.x << 16), bi = __uint_as_float(v.x & 0xffff0000u); const float nr = a0r * h0r - a0i * h0i + br, ni = a0r * h0i + a0i * h0r + bi; h0r = nr; h0i = ni; }
            { const float br = __uint_as_float(v.y << 16), bi = __uint_as_float(v.y & 0xffff0000u); const float nr = a1r * h1r - a1i * h1i + br, ni = a1r * h1i + a1i * h1r + bi; h1r = nr; h1i = ni; }
            if (STAGE == 2) *bp = (u32x2){pk2(h0r, h0i), pk2(h1r, h1i)}; }
        __syncthreads();
        if (STAGE == 2) {
            bf16_t* YS = (bf16_t*)(F.ws + WS_MOE + YSG_OFF);
#pragma unroll
            for (int gg = 0; gg < 2; ++gg) { f32x4 acc = (f32x4){0.f, 0.f, 0.f, 0.f};
#pragma unroll
                for (int ks = 0; ks < 4; ++ks) { const bf16x8 a = *(const LAS bf16x8*)(BuW + r16 * 264 + gg * 128 + 32 * ks + 8 * g4);
                    acc = __builtin_amdgcn_mfma_f32_16x16x32_bf16(a, cf[gg][ks], acc, 0, 0, 0); }
                const int ch = (2 * F.wave + gg) * 16 + r16; const float dsk = F.in[I_SD][layer * 256 + ch];
#pragma unroll
                for (int i = 0; i < 4; ++i) { const int l = lb * 16 + 4 * g4 + i; const float y = acc[i] + dsk * bf2f(us[l * 264 + ch]);
                    YS[(T0 + l) * 256 + ch] = f2bf(gelu_tanh(y)); } }
            __syncthreads();
        }
    }
    if (STAGE == 1) { ST[gn0 * 2] = h0r; ST[gn0 * 2 + 1] = h0i; ST[gn1 * 2] = h1r; ST[gn1 * 2 + 1] = h1i; }
    if (STAGE == 2) {
        asm volatile("s_waitcnt vmcnt(0)" ::: "memory"); __syncthreads();
        const bf16_t* YS = (const bf16_t*)(F.ws + WS_MOE + YSG_OFF) + T0 * 256; const bf16_t* GW = (const bf16_t*)(F.ws + WS_GLU) + (size_t)layer * 512 * 256;
        const int r16 = F.lane & 15, g4 = F.lane >> 4;
        f32x4 av[4][2], ag[4][2];
#pragma unroll
        for (int m = 0; m < 4; ++m)
#pragma unroll
            for (int q = 0; q < 2; ++q) { av[m][q] = (f32x4){0.f, 0.f, 0.f, 0.f}; ag[m][q] = (f32x4){0.f, 0.f, 0.f, 0.f}; }
#pragma unroll 2
        for (int ks = 0; ks < 8; ++ks) {
            bf16x8 af[4], bv[2], bg[2];
#pragma unroll
            for (int m = 0; m < 4; ++m) af[m] = *(const bf16x8*)(YS + (size_t)(16 * m + r16) * 256 + 32 * ks + 8 * g4);
#pragma unroll
            for (int q = 0; q < 2; ++q) { const int c = 32 * F.wave + 16 * q + r16; const int rowv = 256 * (c >> 7) + (c & 127);
                bv[q] = *(const bf16x8*)(GW + (size_t)rowv * 256 + 32 * ks + 8 * g4); bg[q] = *(const bf16x8*)(GW + (size_t)(rowv + 128) * 256 + 32 * ks + 8 * g4); }
#pragma unroll
            for (int m = 0; m < 4; ++m)
#pragma unroll
                for (int q = 0; q < 2; ++q) { av[m][q] = __builtin_amdgcn_mfma_f32_16x16x32_bf16(af[m], bv[q], av[m][q], 0, 0, 0); ag[m][q] = __builtin_amdgcn_mfma_f32_16x16x32_bf16(af[m], bg[q], ag[m][q], 0, 0, 0); }
        }
        bf16_t* Y = (bf16_t*)(F.ws + WS_H);
#pragma unroll
        for (int q = 0; q < 2; ++q) { const int c = 32 * F.wave + 16 * q + r16; const float bvl = F.in[I_SGLUB][layer * 512 + c], bgt = F.in[I_SGLUB][layer * 512 + 256 + c];
#pragma unroll
            for (int m = 0; m < 4; ++m)
#pragma unroll
                for (int i = 0; i < 4; ++i) Y[(T0 + 16 * m + 4 * g4 + i) * DM + 768 + c] = f2bf((av[m][q][i] + bvl) * sigmoidf_(ag[m][q][i] + bgt)); }
    }
}
__device__ __forceinline__ void item_s5_carry(const Frame& F_, int layer, int b) { Frame F = relocal(F_);
    const float* tab = (const float*)(F.ws + WS_S5TAB + (size_t)layer * S5TAB_L) + 2048;
    float* ST = (float*)(F.ws + WS_S5ST) + (size_t)b * 64 * 2048;
#pragma unroll
    for (int q = 0; q < 2; ++q) { const int gn = F.tid + 512 * q; const float pr = tab[gn * 2], pi = tab[gn * 2 + 1]; float hr = 0.f, hi = 0.f;
        for (int c = 0; c < 64; ++c) { float* p = ST + (size_t)c * 2048 + gn * 2; const float tr = p[0], ti = p[1]; p[0] = hr; p[1] = hi;
            const float nr = pr * hr - pi * hi + tr, ni = pr * hi + pi * hr + ti; hr = nr; hi = ni; } }
}

constexpr int RB_LD = 72;
constexpr int RW_R = 0, RW_K = 16384, RW_V = 32768, RW_W = 49152, RW_A = 65536, RW_B = 81920;
constexpr int R3_G = 49152, R3_O = 65536, R3_TILES = 81920, R3_BON = 147456;
template <int STAGE> __device__ __forceinline__ void rwkv_prep(const Frame& F_, int layer, int b, int h, int c) { Frame F = relocal(F_);
    const bf16_t* U = (const bf16_t*)(F.ws + WS_U);
    const int l0 = c * 64; const size_t T0 = (size_t)b * SEQ + l0;
    LAS float* Rr = (LAS float*)(F.lds + RW_R); LAS float* Kk = (LAS float*)(F.lds + RW_K); LAS float* Vv = (LAS float*)(F.lds + RW_V); LAS float* Ww = (LAS float*)(F.lds + RW_W);
    LAS float* Aa = (LAS float*)(F.lds + (STAGE == 1 ? RW_A : R3_O)); LAS float* Bb = (LAS float*)(F.lds + RW_B); LAS float* Gg = (LAS float*)(F.lds + R3_G); LAS float* BON = (LAS float*)(F.lds + R3_BON);
    LAS bf16_t* TWb = (LAS bf16_t*)(F.lds + 98304); LAS bf16_t* DAb = (LAS bf16_t*)(F.lds + (STAGE == 1 ? 103424 : 118784)); LAS bf16_t* SGb = (LAS bf16_t*)(F.lds + 123904);
    LAS bf16_t* w2T = (LAS bf16_t*)(F.lds + 108544); LAS bf16_t* a2T = (LAS bf16_t*)(F.lds + (STAGE == 1 ? 113664 : 133120)); LAS bf16_t* g2T = (LAS bf16_t*)(F.lds + 138240);
    const float* mu = F.in[I_RMU] + layer * 896;
    { const int tok = F.tid >> 3, p8 = F.tid & 7; const bool first = (l0 + tok == 0);
      const bf16_t* cur = U + (T0 + tok) * NINP + UR; const bf16_t* prv = first ? cur : cur - NINP;
      const float pz = first ? 0.f : 1.f;
      u32x4 cw[3], pw[3]; u32x2 c1 = (u32x2){0u, 0u}, p1 = (u32x2){0u, 0u}, c2 = (u32x2){0u, 0u}, p2 = (u32x2){0u, 0u}; u32x4 c3 = (u32x4){0u, 0u, 0u, 0u}, p3 = (u32x4){0u, 0u, 0u, 0u};
#pragma unroll
      for (int sec = (STAGE == 1 ? 0 : 2); sec < 3; ++sec) { const int co = sec * 256 + h * 64 + 8 * p8; cw[sec] = *(const u32x4*)(cur + co); pw[sec] = *(const u32x4*)(prv + co); }
      if (STAGE == 1) { c1 = *(const u32x2*)(cur + 768 + 4 * p8); p1 = *(const u32x2*)(prv + 768 + 4 * p8); c2 = *(const u32x2*)(cur + 800 + 4 * p8); p2 = *(const u32x2*)(prv + 800 + 4 * p8); }
      if (STAGE == 3) { c3 = *(const u32x4*)(cur + 832 + 8 * p8); p3 = *(const u32x4*)(prv + 832 + 8 * p8); }
#pragma unroll
      for (int sec = (STAGE == 1 ? 0 : 2); sec < 3; ++sec) { const int co = sec * 256 + h * 64 + 8 * p8; float av[8], pq[8]; unpack8(cw[sec], av); unpack8(pw[sec], pq);
          const f32x4 m0 = *(const f32x4*)(mu + co), m1 = *(const f32x4*)(mu + co + 4);
          LAS float* dst = (sec == 0 ? Rr : sec == 1 ? Kk : Vv) + tok * 64 + 8 * p8;
#pragma unroll
          for (int j = 0; j < 8; ++j) pq[j] *= pz;
          *(LAS f32x4*)dst = (f32x4){av[0] + m0[0] * (pq[0] - av[0]), av[1] + m0[1] * (pq[1] - av[1]), av[2] + m0[2] * (pq[2] - av[2]), av[3] + m0[3] * (pq[3] - av[3])};
          *(LAS f32x4*)(dst + 4) = (f32x4){av[4] + m1[0] * (pq[4] - av[4]), av[5] + m1[1] * (pq[5] - av[5]), av[6] + m1[2] * (pq[6] - av[6]), av[7] + m1[3] * (pq[7] - av[7])}; }
      if (STAGE == 1) {
#pragma unroll
        for (int which = 0; which < 2; ++which) { const int co = 768 + 32 * which + 4 * p8; const u32x2 cv = which ? c2 : c1, pv = which ? p2 : p1;
          const f32x4 m0 = *(const f32x4*)(mu + co);
          float x[4] = {__uint_as_float(cv.x << 16), __uint_as_float(cv.x & 0xffff0000u), __uint_as_float(cv.y << 16), __uint_as_float(cv.y & 0xffff0000u)};
          const float y[4] = {pz * __uint_as_float(pv.x << 16), pz * __uint_as_float(pv.x & 0xffff0000u), pz * __uint_as_float(pv.y << 16), pz * __uint_as_float(pv.y & 0xffff0000u)};
#pragma unroll
          for (int j = 0; j < 4; ++j) { x[j] = x[j] + m0[j] * (y[j] - x[j]); if (which == 0) x[j] = tanhf_(x[j]); }
          *(LAS u32x2*)((which ? DAb : TWb) + tok * 40 + 4 * p8) = (u32x2){pk2(x[0], x[1]), pk2(x[2], x[3])}; } }
      if (STAGE == 3) { const int co = 832 + 8 * p8; float av[8], pq[8]; unpack8(c3, av); unpack8(p3, pq);
          const f32x4 m0 = *(const f32x4*)(mu + co), m1 = *(const f32x4*)(mu + co + 4); float x[8];
#pragma unroll
          for (int j = 0; j < 8; ++j) x[j] = sigmoidf_(av[j] + (j < 4 ? m0[j] : m1[j - 4]) * (pz * pq[j] - av[j]));
          *(LAS u32x4*)(SGb + tok * RB_LD + 8 * p8) = (u32x4){pk2(x[0], x[1]), pk2(x[2], x[3]), pk2(x[4], x[5]), pk2(x[6], x[7])}; } }
    { const int ch = F.tid & 63, part = F.tid >> 6;
      if (STAGE == 1) { const float* w2 = F.in[I_RW2] + ((size_t)layer * 32 + 4 * part) * 256 + h * 64 + ch;
          *(LAS u32x2*)(w2T + ch * 40 + 4 * part) = (u32x2){pk2(w2[0], w2[256]), pk2(w2[512], w2[768])}; }
      if (STAGE == 1) { const float* a2 = F.in[I_RA2] + ((size_t)layer * 32 + 4 * part) * 256 + h * 64 + ch;
          *(LAS u32x2*)(a2T + ch * 40 + 4 * part) = (u32x2){pk2(a2[0], a2[256]), pk2(a2[512], a2[768])}; }
      if (STAGE == 3) { const float* g2 = F.in[I_RG2] + ((size_t)layer * 64 + 8 * part) * 256 + h * 64 + ch;
          *(LAS u32x4*)(g2T + ch * RB_LD + 8 * part) = (u32x4){pk2(g2[0], g2[256]), pk2(g2[512], g2[768]), pk2(g2[1024], g2[1280]), pk2(g2[1536], g2[1792])}; } }
    __syncthreads();
    { const int lane = F.lane, mt = F.wave >> 1, nt0 = 2 * (F.wave & 1), r = lane & 15, g4 = lane >> 4; const f32x4 zero4 = (f32x4){0.f, 0.f, 0.f, 0.f};
#pragma unroll
      for (int q = 0; q < 2; ++q) { const int nt = nt0 + q, ch = 16 * nt + r, cg = layer * 256 + h * 64 + ch;
          if (STAGE == 1) { const f32x4 wl = mma_nt<32>(TWb + 16 * mt * 40, 40, w2T + 16 * nt * 40, 40, zero4, lane); const float w0 = F.in[I_RW0][cg];
#pragma unroll
              for (int i = 0; i < 4; ++i) { const float x = w0 + wl[i]; const float wlog = -__logf(1.0f + __expf(-x)) - 0.5f; Ww[(16 * mt + 4 * g4 + i) * 64 + ch] = __expf(-__expf(wlog)); } }
          if (STAGE == 1) { const f32x4 al = mma_nt<32>(DAb + 16 * mt * 40, 40, a2T + 16 * nt * 40, 40, zero4, lane); const float a0 = F.in[I_RA0][cg];
#pragma unroll
              for (int i = 0; i < 4; ++i) Aa[(16 * mt + 4 * g4 + i) * 64 + ch] = sigmoidf_(a0 + al[i]); }
          if (STAGE == 3) { const f32x4 gv = mma_nt<64>(SGb + 16 * mt * RB_LD, RB_LD, g2T + 16 * nt * RB_LD, RB_LD, zero4, lane);
#pragma unroll
              for (int i = 0; i < 4; ++i) Gg[(16 * mt + 4 * g4 + i) * 64 + ch] = gv[i]; } } }
    __syncthreads();
    float* gBON = (float*)(F.ws + WS_BON) + ((size_t)(b * 4 + h) * 64 + c) * 64;
    if (STAGE == 1) { const int j = F.lane, tq = F.wave, cg = layer * 256 + h * 64 + j;
      const float kkw = F.in[I_RKK][cg], kaw = F.in[I_RKA][cg], rk = F.in[I_RRK][cg];
#pragma unroll 2
      for (int i8 = 0; i8 < 8; ++i8) { const int t = tq + 8 * i8;
          const float a = Aa[t * 64 + j]; const float kraw = Kk[t * 64 + j]; const float kp = kraw * (1.0f + (a - 1.0f) * kaw);
          Kk[t * 64 + j] = kp;
          const float kkv = kraw * kkw; const float ss = wave_sum(kkv * kkv); const float kkn = kkv * rsqrtf(fmaxf(ss, 1e-24f)); Aa[t * 64 + j] = -kkn; Bb[t * 64 + j] = kkn * a;
          const float bo = wave_sum(Rr[t * 64 + j] * kp * rk); if (j == 0) gBON[t] = bo; } }
    else if (F.tid < 64) BON[F.tid] = gBON[F.tid];
    __syncthreads();
}
constexpr int RB_AT = 98304, RB_ATT = RB_AT + 9216, RB_BT = RB_ATT + 9216, RB_BTT = RB_BT + 9216, RB_KT = RB_BTT + 9216, RB_RT = RB_KT + 9216, RB_VT = RB_RT + 9216, RB_GC = RB_VT + 9216;
constexpr int RX_X = 0, RX_XT = 9216, RX_TB = 18432, RX_M = 27648, RX_NRT = 36864, RX_G1T = 46080, RX_G2T = 55296, RX_QT = 64512;
__device__ __forceinline__ void st_tile(LAS bf16_t* dst, int mt, int nt, const f32x4 v, int lane) {
    const int r = lane & 15, g = lane >> 4;
#pragma unroll
    for (int i = 0; i < 4; ++i) dst[(16 * mt + 4 * g + i) * RB_LD + 16 * nt + r] = f2bf(v[i]);
}
__device__ __forceinline__ void st_tile_t(LAS bf16_t* dst, int mt, int nt, const f32x4 v, int lane) {
    const int r = lane & 15, g = lane >> 4; u32x2 w; w.x = pk2(v[0], v[1]); w.y = pk2(v[2], v[3]);
    *(LAS u32x2*)(dst + (16 * nt + r) * RB_LD + 16 * mt + 4 * g) = w;
}
__device__ __forceinline__ void item_rwkv1(const Frame& F_, int layer, int item) { Frame F = relocal(F_);
    const int b = item >> 8, h = (item >> 6) & 3, c = item & 63;
    rwkv_prep<1>(F, layer, b, h, c);
    LAS float* Rr = (LAS float*)(F.lds + RW_R); LAS float* Kk = (LAS float*)(F.lds + RW_K); LAS float* Vv = (LAS float*)(F.lds + RW_V); LAS float* Ww = (LAS float*)(F.lds + RW_W);
    LAS float* Aa = (LAS float*)(F.lds + RW_A); LAS float* Bb = (LAS float*)(F.lds + RW_B);
    LAS bf16_t* At = (LAS bf16_t*)(F.lds + RB_AT); LAS bf16_t* AtT = (LAS bf16_t*)(F.lds + RB_ATT); LAS bf16_t* Bt = (LAS bf16_t*)(F.lds + RB_BT); LAS bf16_t* BtT = (LAS bf16_t*)(F.lds + RB_BTT);
    LAS bf16_t* Kt = (LAS bf16_t*)(F.lds + RB_KT); LAS bf16_t* Rt = (LAS bf16_t*)(F.lds + RB_RT); LAS bf16_t* VT = (LAS bf16_t*)(F.lds + RB_VT); LAS float* gC = (LAS float*)(F.lds + RB_GC);
    LAS bf16_t* X = (LAS bf16_t*)(F.lds + RX_X); LAS bf16_t* XT = (LAS bf16_t*)(F.lds + RX_XT); LAS bf16_t* Tb = (LAS bf16_t*)(F.lds + RX_TB); LAS bf16_t* Mm = (LAS bf16_t*)(F.lds + RX_M);
    LAS bf16_t* NrT = (LAS bf16_t*)(F.lds + RX_NRT); LAS bf16_t* G1T = (LAS bf16_t*)(F.lds + RX_G1T); LAS bf16_t* G2T = (LAS bf16_t*)(F.lds + RX_G2T); LAS bf16_t* QT = (LAS bf16_t*)(F.lds + RX_QT);
    { const int k = F.tid & 63, part = F.tid >> 6; float g = 1.0f;
      for (int pp = 0; pp < part; ++pp) { float w8[8];
#pragma unroll
          for (int i = 0; i < 8; ++i) w8[i] = Ww[(8 * pp + i) * 64 + k];
          g *= ((w8[0] * w8[1]) * (w8[2] * w8[3])) * ((w8[4] * w8[5]) * (w8[6] * w8[7])); }
#pragma unroll
      for (int i = 0; i < 8; ++i) { const int t = 8 * part + i; const float gp = g; g *= Ww[t * 64 + k]; const float ig = 1.0f / g;
          const bf16_t av = f2bf(Aa[t * 64 + k] * gp), bv = f2bf(Bb[t * 64 + k] * ig);
          At[t * RB_LD + k] = av; AtT[k * RB_LD + t] = av; Bt[t * RB_LD + k] = bv; BtT[k * RB_LD + t] = bv;
          Kt[t * RB_LD + k] = f2bf(Kk[t * 64 + k] * ig); Rt[t * RB_LD + k] = f2bf(Rr[t * 64 + k] * g); VT[k * RB_LD + t] = f2bf(Vv[t * 64 + k]); }
      if (part == 7) gC[k] = g; }
    __syncthreads();
    const int lane = F.lane, mt = F.wave >> 1, nt0 = 2 * (F.wave & 1), r = lane & 15, g4 = lane >> 4;
    const f32x4 zero4 = (f32x4){0.f, 0.f, 0.f, 0.f};
    f32x4 Tacc[2];
#pragma unroll
    for (int q = 0; q < 2; ++q) { const int nt = nt0 + q;
        f32x4 n = mma_nt<64>(Bt + 16 * mt * RB_LD, RB_LD, At + 16 * nt * RB_LD, RB_LD, zero4, lane);
        f32x4 m = mma_nt<64>(Kt + 16 * mt * RB_LD, RB_LD, At + 16 * nt * RB_LD, RB_LD, zero4, lane);
        f32x4 nr = mma_nt<64>(Rt + 16 * mt * RB_LD, RB_LD, Bt + 16 * nt * RB_LD, RB_LD, zero4, lane);
#pragma unroll
        for (int i = 0; i < 4; ++i) { const int row = 16 * mt + 4 * g4 + i, col = 16 * nt + r;
            n[i] = (row < col) ? n[i] : 0.f; m[i] = (row < col) ? m[i] : 0.f; nr[i] = (col <= row) ? nr[i] : 0.f;
            Tacc[q][i] = n[i] + (row == col ? 1.0f : 0.f); }
        st_tile(X, mt, nt, n, lane); st_tile_t(XT, mt, nt, n, lane); st_tile(Tb, mt, nt, Tacc[q], lane); st_tile(Mm, mt, nt, m, lane); st_tile(NrT, mt, nt, nr, lane); }
    __syncthreads();
#pragma unroll 1
    for (int it = 0; it < 6; ++it) {
        LAS bf16_t* Xr = (it & 1) ? G1T : X; LAS bf16_t* XTr = (it & 1) ? G2T : XT; LAS bf16_t* Tr = (it & 1) ? QT : Tb;
        LAS bf16_t* Xw = (it & 1) ? X : G1T; LAS bf16_t* XTw = (it & 1) ? XT : G2T; LAS bf16_t* Tw = (it & 1) ? Tb : QT;
#pragma unroll
        for (int q = 0; q < 2; ++q) { const int nt = nt0 + q;
            if (it > 0) Tacc[q] = mma_nt<64>(Tr + 16 * mt * RB_LD, RB_LD, XTr + 16 * nt * RB_LD, RB_LD, Tacc[q], lane);
            if (it < 5) { const f32x4 x2 = mma_nt<64>(Xr + 16 * mt * RB_LD, RB_LD, XTr + 16 * nt * RB_LD, RB_LD, zero4, lane); st_tile(Xw, mt, nt, x2, lane); st_tile_t(XTw, mt, nt, x2, lane); }
            st_tile(Tw, mt, nt, Tacc[q], lane); }
        __syncthreads();
    }
#pragma unroll
    for (int q = 0; q < 2; ++q) { const int nt = nt0 + q;
        st_tile(G1T, mt, nt, mma_nt<64>(NrT + 16 * mt * RB_LD, RB_LD, Tb + 16 * nt * RB_LD, RB_LD, zero4, lane), lane);
        st_tile(G2T, mt, nt, mma_nt<64>(BtT + 16 * mt * RB_LD, RB_LD, Tb + 16 * nt * RB_LD, RB_LD, zero4, lane), lane); }
    __syncthreads();
    const size_t ci = (size_t)(b * 4 + h) * 64 + c;
    bf16_t* gPT = (bf16_t*)(F.ws + WS_MOE + RW_PT) + ci * 4096; bf16_t* gW1 = (bf16_t*)(F.ws + WS_MOE + RW_W1) + ci * 4096; bf16_t* gZ = (bf16_t*)(F.ws + WS_MOE + RW_Z) + ci * 4096;
#pragma unroll
    for (int q = 0; q < 2; ++q) { const int nt = nt0 + q; const int col = 16 * nt + r;
        f32x4 w1 = mma_nt<64>(G1T + 16 * mt * RB_LD, RB_LD, AtT + 16 * nt * RB_LD, RB_LD, zero4, lane);
        f32x4 z = mma_nt<64>(G1T + 16 * mt * RB_LD, RB_LD, Mm + 16 * nt * RB_LD, RB_LD, zero4, lane);
        f32x4 mr = mma_nt<64>(Rt + 16 * mt * RB_LD, RB_LD, Kt + 16 * nt * RB_LD, RB_LD, zero4, lane);
        f32x4 p = mma_nt<64>(G2T + 16 * mt * RB_LD, RB_LD, AtT + 16 * nt * RB_LD, RB_LD, zero4, lane);
        f32x4 qq = mma_nt<64>(G2T + 16 * mt * RB_LD, RB_LD, Mm + 16 * nt * RB_LD, RB_LD, zero4, lane);
        const int pos = 32 * (col >> 5) + 8 * ((col >> 2) & 3) + 4 * ((col >> 4) & 1) + (col & 3);
#pragma unroll
        for (int i = 0; i < 4; ++i) { const int row = 16 * mt + 4 * g4 + i;
            gW1[row * 64 + col] = f2bf(w1[i] + bf2f(Rt[row * RB_LD + col]));
            gZ[row * 64 + col] = f2bf(z[i] + (col <= row ? mr[i] : 0.f));
            const float gc = gC[row];
            gPT[row * 64 + pos] = f2bf((p[i] + (row == col ? 1.0f : 0.f)) * gc);
            qq[i] = (qq[i] + bf2f(Kt[col * RB_LD + row])) * gc; }
        st_tile(QT, mt, nt, qq, lane); }
    __syncthreads();
    bf16_t* gU = (bf16_t*)(F.ws + WS_MOE + RW_U) + ci * 4096;
#pragma unroll
    for (int q = 0; q < 2; ++q) { const int nt = nt0 + q;
        const f32x4 u = mma_nt<64>(VT + 16 * mt * RB_LD, RB_LD, QT + 16 * nt * RB_LD, RB_LD, zero4, lane);
#pragma unroll
        for (int i = 0; i < 4; ++i) gU[(16 * mt + 4 * g4 + i) * 64 + 16 * nt + r] = f2bf(u[i]); }
}
__device__ __forceinline__ void item_rwkv_carry(const Frame& F_, int item) { Frame F = relocal(F_);
    const int bh = item * 2 + (F.wave >> 2), nt = F.wave & 3, r = F.lane & 15, g = F.lane >> 4;
    const bf16_t* PT = (const bf16_t*)(F.ws + WS_MOE + RW_PT); const bf16_t* Uc = (const bf16_t*)(F.ws + WS_MOE + RW_U); bf16_t* Ss = (bf16_t*)(F.ws + WS_MOE + RW_S);
    f32x4 acc[4];
#pragma unroll
    for (int m = 0; m < 4; ++m) acc[m] = (f32x4){0.f, 0.f, 0.f, 0.f};
    for (int c = 0; c < 64; ++c) { const size_t ci = (size_t)bh * 64 + c;
        bf16x8 af[4][2]; f32x4 cin[4];
#pragma unroll
        for (int m = 0; m < 4; ++m) { const u32x2 uv = *(const u32x2*)(Uc + ci * 4096 + (16 * nt + r) * 64 + 16 * m + 4 * g);
            cin[m] = (f32x4){__uint_as_float(uv.x << 16), __uint_as_float(uv.x & 0xffff0000u), __uint_as_float(uv.y << 16), __uint_as_float(uv.y & 0xffff0000u)};
#pragma unroll
            for (int s = 0; s < 2; ++s) af[m][s] = *(const bf16x8*)(PT + ci * 4096 + (16 * m + r) * 64 + 32 * s + 8 * g); }
        unsigned pw[4][2];
#pragma unroll
        for (int m = 0; m < 4; ++m) { pw[m][0] = pk2(acc[m][0], acc[m][1]); pw[m][1] = pk2(acc[m][2], acc[m][3]);
            *(u32x2*)(Ss + ci * 4096 + (16 * nt + r) * 64 + 16 * m + 4 * g) = (u32x2){pw[m][0], pw[m][1]}; }
        bf16x8 bfr[2];
#pragma unroll
        for (int s = 0; s < 2; ++s) bfr[s] = __builtin_bit_cast(bf16x8, (u32x4){pw[2 * s][0], pw[2 * s][1], pw[2 * s + 1][0], pw[2 * s + 1][1]});
#pragma unroll
        for (int m = 0; m < 4; ++m) { acc[m] = __builtin_amdgcn_mfma_f32_16x16x32_bf16(af[m][0], bfr[0], cin[m], 0, 0, 0);
            acc[m] = __builtin_amdgcn_mfma_f32_16x16x32_bf16(af[m][1], bfr[1], acc[m], 0, 0, 0); }
    }
}
__device__ __forceinline__ void item_rwkv3(const Frame& F_, int layer, int item) { Frame F = relocal(F_);
    const int b = item >> 8, h = (item >> 6) & 3, c = item & 63; const size_t T0 = (size_t)b * SEQ + c * 64;
    rwkv_prep<3>(F, layer, b, h, c);
    LAS float* Vv = (LAS float*)(F.lds + RW_V); LAS float* Oo = (LAS float*)(F.lds + R3_O);
    LAS float* Gg = (LAS float*)(F.lds + R3_G); LAS float* BON = (LAS float*)(F.lds + R3_BON);
    LAS bf16_t* S0b = (LAS bf16_t*)(F.lds + R3_TILES); LAS bf16_t* W1b = S0b + 4608; LAS bf16_t* Zb = W1b + 4608; LAS bf16_t* VTb = Zb + 4608;
    { const size_t ci = (size_t)(b * 4 + h) * 64 + c; const int row = F.tid >> 3, col = (F.tid & 7) * 8;
      *(LAS u32x4*)(S0b + row * RB_LD + col) = *(const u32x4*)((const bf16_t*)(F.ws + WS_MOE + RW_S) + ci * 4096 + F.tid * 8);
      *(LAS u32x4*)(W1b + row * RB_LD + col) = *(const u32x4*)((const bf16_t*)(F.ws + WS_MOE + RW_W1) + ci * 4096 + F.tid * 8);
      *(LAS u32x4*)(Zb + row * RB_LD + col) = *(const u32x4*)((const bf16_t*)(F.ws + WS_MOE + RW_Z) + ci * 4096 + F.tid * 8);
      const int vv = F.tid & 63, part = F.tid >> 6;
#pragma unroll
      for (int i = 0; i < 8; ++i) { const int t = 8 * part + i; VTb[vv * RB_LD + t] = f2bf(Vv[t * 64 + vv]); } }
    __syncthreads();
    { const int lane = F.lane, mt = F.wave >> 1, nt0 = 2 * (F.wave & 1), r = lane & 15, g4 = lane >> 4;
#pragma unroll
      for (int q = 0; q < 2; ++q) { const int nt = nt0 + q;
          f32x4 o = mma_nt<64>(W1b + 16 * mt * RB_LD, RB_LD, S0b + 16 * nt * RB_LD, RB_LD, (f32x4){0.f, 0.f, 0.f, 0.f}, lane);
          o = mma_nt<64>(Zb + 16 * mt * RB_LD, RB_LD, VTb + 16 * nt * RB_LD, RB_LD, o, lane);
#pragma unroll
          for (int i = 0; i < 4; ++i) Oo[(16 * mt + 4 * g4 + i) * 64 + 16 * nt + r] = o[i]; } }
    __syncthreads();
    { const int j = F.lane, tq = F.wave, ch = h * 64 + j;
      const float lw = F.in[I_RLNW][layer * 256 + ch], lb = F.in[I_RLNB][layer * 256 + ch];
      bf16_t* Y = (bf16_t*)(F.ws + WS_H);
#pragma unroll 2
      for (int i8 = 0; i8 < 8; ++i8) { const int t = tq + 8 * i8;
          const float o = Oo[t * 64 + j]; const float mean = wave_sum(o) * (1.0f / 64.0f); const float d = o - mean; const float var = wave_sum(d * d) * (1.0f / 64.0f);
          float on = d * rsqrtf(var + 64e-5f) * lw + lb; on += BON[t] * Vv[t * 64 + j];
          Y[(T0 + t) * DM + 256 + ch] = f2bf(on * Gg[t * 64 + j]); } }
}

constexpr int DS_SEL = 131072, DS_HIST = 135168, DS_BKT = 151552, DS_BIAS = 152064;
__device__ __forceinline__ void dsa_tables(const Frame& F_) { Frame F = relocal(F_);
    LAS int* bkt = (LAS int*)(F.lds + DS_BKT); LAS float* biasT = (LAS float*)(F.lds + DS_BIAS);
    if (F.tid < 128) { const int n = F.tid; int bk = n; if (n >= 16) { const float lr = logf((float)n / 16.0f) / 2.0794415416798357f; bk = 16 + (int)(lr * 16.0f); bk = bk < 31 ? bk : 31; } bkt[n] = bk; biasT[n] = F.in[I_RELB][n]; }
    __syncthreads();
}
__device__ __forceinline__ unsigned fkey(float f) { const unsigned u = __float_as_uint(f); return (u & 0x80000000u) ? ~u : (u | 0x80000000u); }
__device__ __forceinline__ void item_dsa(const Frame& F_, int layer, int item) { Frame F = relocal(F_);
    const bf16_t* U = (const bf16_t*)(F.ws + WS_U); const bf16_t* KI = (const bf16_t*)(F.ws + WS_KIDX);
    const bf16_t* Kb = (const bf16_t*)(F.ws + WS_K); const bf16_t* Vb = (const bf16_t*)(F.ws + WS_V);
    const int b = item & 3, qg = 511 - (item >> 2); const size_t TB = (size_t)b * SEQ, T0 = TB + qg * 8;
    LAS float* sc = (LAS float*)F.lds; LAS unsigned short* selall = (LAS unsigned short*)(F.lds + DS_SEL); LAS unsigned* histall = (LAS unsigned*)(F.lds + DS_HIST);
    LAS int* bkt = (LAS int*)(F.lds + DS_BKT); LAS float* biasT = (LAS float*)(F.lds + DS_BIAS);
    const int lane = F.lane, hh = lane >> 5;
    {
        bf16x8 af[2][2]; float wq[2][2][8];
        { const int r = lane & 31, q4 = 2 * ((r >> 2) & 1) + (r >> 4), head = 4 * ((r >> 3) & 1) + (r & 3);
#pragma unroll
          for (int mt = 0; mt < 2; ++mt)
#pragma unroll
              for (int ks = 0; ks < 2; ++ks) af[mt][ks] = *(const bf16x8*)(U + (T0 + 4 * mt + q4) * NINP + UC + 384 + head * 32 + 16 * ks + 8 * hh); }
#pragma unroll
        for (int mt = 0; mt < 2; ++mt)
#pragma unroll
            for (int q2 = 0; q2 < 2; ++q2) { float f[8]; unpack8(*(const u32x4*)(U + (T0 + 4 * mt + 2 * hh + q2) * NINP + UC + 672), f);
#pragma unroll
                for (int hd = 0; hd < 8; ++hd) wq[mt][q2][hd] = f[hd]; }
        const int ntile = (qg * 8 + 8 + 31) >> 5;
        bf16x8 nb0 = af[0][0], nb1 = af[0][0];
        if (F.wave < ntile) { const int key = F.wave * 32 + (lane & 31); nb0 = *(const bf16x8*)(KI + (TB + key) * 32 + 8 * hh); nb1 = *(const bf16x8*)(KI + (TB + key) * 32 + 16 + 8 * hh); }
        for (int kt = F.wave; kt < ntile; kt += 8) {
            const int key = kt * 32 + (lane & 31);
            const bf16x8 b0 = nb0, b1 = nb1;
            if (kt + 8 < ntile) { const int k2 = key + 256; nb0 = *(const bf16x8*)(KI + (TB + k2) * 32 + 8 * hh); nb1 = *(const bf16x8*)(KI + (TB + k2) * 32 + 16 + 8 * hh); }
#pragma unroll
            for (int mt = 0; mt < 2; ++mt) { f32x16 acc;
#pragma unroll
                for (int i = 0; i < 16; ++i) acc[i] = 0.f;
                acc = __builtin_amdgcn_mfma_f32_32x32x16_bf16(af[mt][0], b0, acc, 0, 0, 0);
                acc = __builtin_amdgcn_mfma_f32_32x32x16_bf16(af[mt][1], b1, acc, 0, 0, 0);
#pragma unroll
                for (int q2 = 0; q2 < 2; ++q2) { float s = 0.f;
#pragma unroll
                    for (int hd = 0; hd < 8; ++hd) s += fmaxf(acc[8 * q2 + hd], 0.f) * wq[mt][q2][hd];
                    const int qi = 4 * mt + 2 * hh + q2;
                    sc[qi * 4096 + key] = (key <= qg * 8 + qi) ? s : -INFINITY; } }
        }
    }
    __syncthreads();
    const int qi = F.wave, tq = qg * 8 + qi, n = tq + 1;
    LAS float* scq = sc + qi * 4096; LAS unsigned short* sel = selall + qi * 256; LAS unsigned* hist = histall + qi * 512;
    int nsel;
    if (n <= 256) { nsel = n; for (int j = lane; j < 256; j += 64) sel[j] = (unsigned short)(j < n ? j : 0); }
    else {
        nsel = 256;
        const int R = (n + 63) >> 6; const unsigned long long ltm = (1ull << lane) - 1ull;
        float lo = INFINITY, hi = -INFINITY;
        const int R4 = (n + 255) >> 8;
#pragma unroll 4
        for (int i = 0; i < R4; ++i) { const int j0 = 256 * i + 4 * lane; const f32x4 v4 = *(const LAS f32x4*)(scq + j0);
#pragma unroll
            for (int q = 0; q < 4; ++q) { const bool valid = j0 + q < n; lo = fminf(lo, valid ? v4[q] : INFINITY); hi = fmaxf(hi, valid ? v4[q] : -INFINITY); } }
#pragma unroll
        for (int o = 1; o < 64; o <<= 1) { lo = fminf(lo, shx(lo, o)); hi = fmaxf(hi, shx(hi, o)); }
        bool slow = false;
        if (!(hi > lo)) { for (int j = lane; j < 256; j += 64) sel[j] = (unsigned short)j; }
        else {
            const float scale = 1023.0f / (hi - lo);
            *(LAS u32x4*)(hist + 8 * lane) = (u32x4){0u, 0u, 0u, 0u}; *(LAS u32x4*)(hist + 8 * lane + 4) = (u32x4){0u, 0u, 0u, 0u};
#pragma unroll 2
            for (int i = 0; i < R4; ++i) { const int j0 = 256 * i + 4 * lane; const f32x4 v4 = *(const LAS f32x4*)(scq + j0);
#pragma unroll
                for (int q = 0; q < 4; ++q) { if (j0 + q < n) { int bk = (int)((v4[q] - lo) * scale); bk = bk < 1023 ? bk : 1023;
                    atomicAdd((unsigned*)(hist + (bk >> 1)), (bk & 1) ? 65536u : 1u); } } }
            const u32x4 h0 = *(const LAS u32x4*)(hist + 8 * lane), h1 = *(const LAS u32x4*)(hist + 8 * lane + 4);
            unsigned cb[16];
            cb[0] = h0.x & 0xffffu; cb[1] = h0.x >> 16; cb[2] = h0.y & 0xffffu; cb[3] = h0.y >> 16; cb[4] = h0.z & 0xffffu; cb[5] = h0.z >> 16; cb[6] = h0.w & 0xffffu; cb[7] = h0.w >> 16;
            cb[8] = h1.x & 0xffffu; cb[9] = h1.x >> 16; cb[10] = h1.y & 0xffffu; cb[11] = h1.y >> 16; cb[12] = h1.z & 0xffffu; cb[13] = h1.z >> 16; cb[14] = h1.w & 0xffffu; cb[15] = h1.w >> 16;
            unsigned tot = 0u;
#pragma unroll
            for (int q = 0; q < 16; ++q) tot += cb[q];
            unsigned incl = tot;
#pragma unroll
            for (int o = 1; o < 64; o <<= 1) { const unsigned t = shdown_u(incl, o); if (lane + o < 64) incl += t; }
            int fb = -1; unsigned fabove = 0u, fcnt = 0u; unsigned cum = incl - tot;
#pragma unroll
            for (int q = 15; q >= 0; --q) { if (fb < 0 && cum < 256u && 256u <= cum + cb[q]) { fb = 16 * lane + q; fabove = cum; fcnt = cb[q]; } cum += cb[q]; }
            const unsigned long long mf = __ballot(fb >= 0); const int src = (int)__ffsll((long long)mf) - 1;
            const int B = shidx_i(fb, src); const int above = shidx_i((int)fabove, src), cntB = shidx_i((int)fcnt, src); const int need = 256 - above;
            if (cntB > 256) slow = true;
            else {
                LAS unsigned* cand = hist;
                int base_gt = 0, base_c = 0;
#pragma unroll 2
                for (int i = 0; i < R4; ++i) { const int j0 = 256 * i + 4 * lane; const f32x4 v4 = *(const LAS f32x4*)(scq + j0);
#pragma unroll
                    for (int q = 0; q < 4; ++q) { const int j = j0 + q; const bool valid = j < n; const float v = valid ? v4[q] : lo;
                        int bk = (int)((v - lo) * scale); bk = bk < 1023 ? bk : 1023;
                        const bool gt = valid && bk > B, eq = valid && bk == B;
                        const unsigned long long mg = __ballot(gt), me = __ballot(eq);
                        if (gt) sel[base_gt + __popcll(mg & ltm)] = (unsigned short)j;
                        if (eq) { const int p = base_c + __popcll(me & ltm); cand[2 * p] = fkey(v); cand[2 * p + 1] = (unsigned)j; }
                        base_gt += __popcll(mg); base_c += __popcll(me); } }
                if (need == cntB) { for (int c = lane; c < cntB; c += 64) sel[above + c] = (unsigned short)cand[2 * c + 1]; }
                else {
                    unsigned ck[4], cx[4]; int rk[4];
#pragma unroll
                    for (int q = 0; q < 4; ++q) { const int c = lane + 64 * q; ck[q] = c < cntB ? cand[2 * c] : 0u; cx[q] = c < cntB ? cand[2 * c + 1] : 0u; rk[q] = 0; }
                    for (int c2 = 0; c2 < cntB; ++c2) { const unsigned k2 = cand[2 * c2], x2 = cand[2 * c2 + 1];
#pragma unroll
                        for (int q = 0; q < 4; ++q) rk[q] += (k2 > ck[q] || (k2 == ck[q] && x2 < cx[q])) ? 1 : 0; }
#pragma unroll
                    for (int q = 0; q < 4; ++q) { const int c = lane + 64 * q; if (c < cntB && rk[q] < need) sel[above + rk[q]] = (unsigned short)cand[2 * c + 1]; }
                }
            }
        }
        if (slow) {
        unsigned prefix = 0u; int need = 256; unsigned neq = 0u;
        for (int p = 0; p < 4; ++p) { const int shift = 24 - 8 * p;
            *(LAS u32x4*)(hist + 4 * lane) = (u32x4){0u, 0u, 0u, 0u};
            for (int i = 0; i < R; ++i) { const int j = lane + 64 * i; if (j < n) { const unsigned u = fkey(scq[j]);
                if (p == 0 || (u >> (shift + 8)) == prefix) atomicAdd((unsigned*)(hist + ((u >> shift) & 255u)), 1u); } }
            const u32x4 hv = *(const LAS u32x4*)(hist + 4 * lane);
            const unsigned tot = hv.x + hv.y + hv.z + hv.w;
            unsigned incl = tot;
#pragma unroll
            for (int o = 1; o < 64; o <<= 1) { const unsigned t = shdown_u(incl, o); if (lane + o < 64) incl += t; }
            const unsigned above = incl - tot;
            int fb = -1; unsigned fabove = 0u, feq = 0u; unsigned cum = above;
            { const unsigned hq[4] = {hv.x, hv.y, hv.z, hv.w};
#pragma unroll
              for (int q = 3; q >= 0; --q) { if (fb < 0 && cum < (unsigned)need && (unsigned)need <= cum + hq[q]) { fb = 4 * lane + q; fabove = cum; feq = hq[q]; } cum += hq[q]; } }
            const unsigned long long m = __ballot(fb >= 0);
            const int src = (int)__ffsll((long long)m) - 1;
            const int bin = shidx_i(fb, src); const unsigned ab = (unsigned)shidx_i((int)fabove, src); neq = (unsigned)shidx_i((int)feq, src);
            need -= (int)ab; prefix = (prefix << 8) | (unsigned)bin;
        }
        const int ngt = 256 - need;
        int base_gt = 0, base_eq = 0;
        for (int i = 0; i < R; ++i) { const int j = lane + 64 * i; const unsigned u = (j < n) ? fkey(scq[j]) : 0u;
            const bool gt = (j < n) && (u > prefix), eq = (j < n) && (u == prefix);
            const unsigned long long mg = __ballot(gt), me = __ballot(eq); const unsigned long long lt = (1ull << lane) - 1ull;
            if (gt) sel[base_gt + __popcll(mg & lt)] = (unsigned short)j;
            if (eq) { const int rk = base_eq + __popcll(me & lt); if (rk < need) sel[ngt + rk] = (unsigned short)j; }
            base_gt += __popcll(mg); base_eq += __popcll(me); }
        (void)neq;
            }
    }
    const int nt16 = (nsel + 15) >> 4, r16 = lane & 15, g4 = lane >> 4;
    LAS float* biasj = scq + 2048;
#pragma unroll
    for (int q = 0; q < 4; ++q) { const int j = lane + 64 * q; f32x4 bv = (f32x4){-INFINITY, -INFINITY, -INFINITY, -INFINITY};
        if (j < nsel) { const int dist = tq - (int)sel[j]; const int bk = dist < 128 ? bkt[dist < 0 ? 0 : dist] : 31; bv = *(const LAS f32x4*)(biasT + 4 * bk); }
        *(LAS f32x4*)(biasj + 4 * j) = bv; }
    bf16x8 qf[2];
#pragma unroll
    for (int s = 0; s < 2; ++s) { u32x4 z = (u32x4){0u, 0u, 0u, 0u}; if (r16 < 4) z = *(const u32x4*)(U + (T0 + qi) * NINP + UC + r16 * 64 + 32 * s + 8 * g4); qf[s] = __builtin_bit_cast(bf16x8, z); }
    float lg[16][4]; float mx = -INFINITY;
#define DSA_QK(M0, NM) do { int keyr[NM]; bf16x8 a0[NM], a1[NM]; \
        _Pragma("unroll") for (int m8 = 0; m8 < NM; ++m8) keyr[m8] = sel[16 * ((M0) + m8) + r16]; \
        _Pragma("unroll") for (int m8 = 0; m8 < NM; ++m8) { a0[m8] = *(const bf16x8*)(Kb + (TB + keyr[m8]) * 64 + 8 * g4); a1[m8] = *(const bf16x8*)(Kb + (TB + keyr[m8]) * 64 + 32 + 8 * g4); } \
        _Pragma("unroll") for (int m8 = 0; m8 < NM; ++m8) { const int m = (M0) + m8; \
            f32x4 acc = (f32x4){0.f, 0.f, 0.f, 0.f}; \
            acc = __builtin_amdgcn_mfma_f32_16x16x32_bf16(a0[m8], qf[0], acc, 0, 0, 0); \
            acc = __builtin_amdgcn_mfma_f32_16x16x32_bf16(a1[m8], qf[1], acc, 0, 0, 0); \
            _Pragma("unroll") for (int i = 0; i < 4; ++i) { const float v = acc[i] * 0.125f + biasj[(16 * m + 4 * g4 + i) * 4 + (r16 & 3)]; lg[m][i] = v; mx = fmaxf(mx, v); } } } while (0)
    if (nt16 > 8) { DSA_QK(0, 16); }
    else { DSA_QK(0, 8);
#pragma unroll
        for (int m8 = 8; m8 < 16; ++m8)
#pragma unroll
            for (int i = 0; i < 4; ++i) lg[m8][i] = -INFINITY; }
#undef DSA_QK
    mx = fmaxf(mx, shx(mx, 16)); mx = fmaxf(mx, shx(mx, 32));
    float sm = 0.f;
#pragma unroll
    for (int m = 0; m < 16; ++m)
#pragma unroll
        for (int i = 0; i < 4; ++i) { const float p = __expf(lg[m][i] - mx); lg[m][i] = p; sm += p; }
    sm += shx(sm, 16); sm += shx(sm, 32);
    f32x4 ov[4];
#pragma unroll
    for (int nt = 0; nt < 4; ++nt) ov[nt] = (f32x4){0.f, 0.f, 0.f, 0.f};
    const unsigned vs_base = (unsigned)(unsigned long)scq;
#pragma unroll
    for (int half = 0; half < 2; ++half) {
        if (half * 8 < nt16) {
            asm volatile("s_waitcnt lgkmcnt(0)" ::: "memory");
            int vkey[16];
#pragma unroll
            for (int q = 0; q < 16; ++q) { const int rho = 8 * q + (lane >> 3);
                vkey[q] = sel[half * 128 + (rho & ~31) + 16 * ((rho >> 2) & 1) + 4 * ((rho >> 3) & 3) + (rho & 3)]; }
            asm volatile("s_waitcnt lgkmcnt(0)" : "+v"(vkey[0]), "+v"(vkey[1]), "+v"(vkey[2]), "+v"(vkey[3]), "+v"(vkey[4]), "+v"(vkey[5]), "+v"(vkey[6]), "+v"(vkey[7]),
                         "+v"(vkey[8]), "+v"(vkey[9]), "+v"(vkey[10]), "+v"(vkey[11]), "+v"(vkey[12]), "+v"(vkey[13]), "+v"(vkey[14]), "+v"(vkey[15]) :: "memory");
#pragma unroll
            for (int q = 0; q < 16; ++q)
                __builtin_amdgcn_global_load_lds((const unsigned*)(Vb + (TB + vkey[q]) * 64 + 8 * (lane & 7)), (LAS unsigned*)((LAS unsigned char*)scq + q * 1024), 16, 0, 0);
            asm volatile("s_waitcnt vmcnt(0)" ::: "memory");
#pragma unroll
            for (int s4 = 0; s4 < 4; ++s4) { const int s = half * 4 + s4;
                u32x4 pw; pw.x = pk2(lg[2 * s][0], lg[2 * s][1]); pw.y = pk2(lg[2 * s][2], lg[2 * s][3]); pw.z = pk2(lg[2 * s + 1][0], lg[2 * s + 1][1]); pw.w = pk2(lg[2 * s + 1][2], lg[2 * s + 1][3]);
                const bf16x8 pa = __builtin_bit_cast(bf16x8, pw);
                const unsigned ad = vs_base + (unsigned)((32 * s4 + 8 * g4 + (r16 >> 2)) * 128 + (r16 & 3) * 8);
                u32x2 t0[4], t1[4];
                asm volatile("ds_read_b64_tr_b16 %0, %8\n\tds_read_b64_tr_b16 %1, %8 offset:512\n\tds_read_b64_tr_b16 %2, %8 offset:32\n\tds_read_b64_tr_b16 %3, %8 offset:544\n\t"
                             "ds_read_b64_tr_b16 %4, %8 offset:64\n\tds_read_b64_tr_b16 %5, %8 offset:576\n\tds_read_b64_tr_b16 %6, %8 offset:96\n\tds_read_b64_tr_b16 %7, %8 offset:608\n\ts_waitcnt lgkmcnt(0)"
                             : "=&v"(t0[0]), "=&v"(t1[0]), "=&v"(t0[1]), "=&v"(t1[1]), "=&v"(t0[2]), "=&v"(t1[2]), "=&v"(t0[3]), "=&v"(t1[3]) : "v"(ad) : "memory");
#pragma unroll
                for (int nt = 0; nt < 4; ++nt) { const bf16x8 vb = __builtin_bit_cast(bf16x8, (u32x4){t0[nt].x, t0[nt].y, t1[nt].x, t1[nt].y});
                    ov[nt] = __builtin_amdgcn_mfma_f32_16x16x32_bf16(pa, vb, ov[nt], 0, 0, 0); } }
        }
    }
    { float inv[4];
#pragma unroll
      for (int h = 0; h < 4; ++h) inv[h] = 1.0f / __int_as_float(__builtin_amdgcn_readlane(__float_as_int(sm), h));
      if (lane < 16) { bf16_t* Y = (bf16_t*)(F.ws + WS_H) + (T0 + qi) * DM + 512 + r16;
#pragma unroll
          for (int h = 0; h < 4; ++h)
#pragma unroll
              for (int nt = 0; nt < 4; ++nt) Y[h * 64 + 16 * nt] = f2bf(ov[nt][h] * inv[h]); } }
}

__device__ __forceinline__ void phase_router(const Frame& F_, int layer) { Frame F = relocal(F_); const int cset = layer;
    const float* X = (const float*)(F.ws + WS_X);
    const bf16_t* WH = (const bf16_t*)(F.ws + WS_WRT) + (size_t)layer * 2 * 49152; const bf16_t* WL = WH + 49152;
    LAS float* part = (LAS float*)F.lds;
    LAS float* ssq = (LAS float*)(F.lds + 24576);
    LAS int* es = (LAS int*)(F.lds + 25088);
    LAS int* lr = (LAS int*)(F.lds + 25600);
    LAS float* wsl = (LAS float*)(F.lds + 26112);
    LAS float* rsd = (LAS float*)(F.lds + 26624);
    for (int blk = F.bid; blk < NTOK / 64; blk += F.G) {
        __syncthreads();
        const int mt = F.wave & 3, kh = F.wave >> 2, r16 = F.lane & 15, g4 = F.lane >> 4;
        const float* xr = X + ((size_t)blk * 64 + mt * 16 + r16) * DM + kh * 512 + 8 * g4;
        f32x4 acc[3]; acc[0] = acc[1] = acc[2] = (f32x4){0.f, 0.f, 0.f, 0.f}; float ss = 0.f;
#pragma unroll 4
        for (int ks = 0; ks < 16; ++ks) {
            const f32x4 xa = *(const f32x4*)(xr + ks * 32), xb = *(const f32x4*)(xr + ks * 32 + 4);
            ss += xa[0] * xa[0] + xa[1] * xa[1] + xa[2] * xa[2] + xa[3] * xa[3] + xb[0] * xb[0] + xb[1] * xb[1] + xb[2] * xb[2] + xb[3] * xb[3];
            float xv[8] = {xa[0], xa[1], xa[2], xa[3], xb[0], xb[1], xb[2], xb[3]}; unsigned hw[4], lw[4];
#pragma unroll
            for (int j = 0; j < 4; ++j) { const bf16_t h0 = f2bf(xv[2 * j]), h1 = f2bf(xv[2 * j + 1]); hw[j] = (unsigned)h0 | ((unsigned)h1 << 16);
                lw[j] = pk2(xv[2 * j] - bf2f(h0), xv[2 * j + 1] - bf2f(h1)); }
            const bf16x8 ahi = __builtin_bit_cast(bf16x8, (u32x4){hw[0], hw[1], hw[2], hw[3]}), alo = __builtin_bit_cast(bf16x8, (u32x4){lw[0], lw[1], lw[2], lw[3]});
#pragma unroll
            for (int nt = 0; nt < 3; ++nt) { const size_t wo = (size_t)(nt * 16 + r16) * 1024 + kh * 512 + ks * 32 + 8 * g4;
                const bf16x8 bh = *(const bf16x8*)(WH + wo), bl = *(const bf16x8*)(WL + wo);
                acc[nt] = __builtin_amdgcn_mfma_f32_16x16x32_bf16(ahi, bh, acc[nt], 0, 0, 0);
                acc[nt] = __builtin_amdgcn_mfma_f32_16x16x32_bf16(ahi, bl, acc[nt], 0, 0, 0);
                acc[nt] = __builtin_amdgcn_mfma_f32_16x16x32_bf16(alo, bh, acc[nt], 0, 0, 0); }
        }
        ss += shx(ss, 16); ss += shx(ss, 32);
        if (g4 == 0) ssq[kh * 64 + mt * 16 + r16] = ss;
#pragma unroll
        for (int nt = 0; nt < 3; ++nt)
#pragma unroll
            for (int i = 0; i < 4; ++i) part[(kh * 64 + mt * 16 + 4 * g4 + i) * 48 + nt * 16 + r16] = acc[nt][i];
        __syncthreads();
        if (F.tid < 64) { const float rstd = rsqrtf((ssq[F.tid] + ssq[64 + F.tid]) * (1.0f / DM) + 1e-6f); rsd[F.tid] = rstd;
            float l[36];
#pragma unroll
            for (int o = 0; o < 36; ++o) l[o] = (part[F.tid * 48 + o] + part[(64 + F.tid) * 48 + o]) * rstd + (o < 32 ? F.in[I_BRE][layer * 32 + o] : F.in[I_BRG][layer * 4 + o - 32]);
            int gs = 0; float gm = l[32];
#pragma unroll
            for (int j = 1; j < 4; ++j) if (l[32 + j] > gm) { gm = l[32 + j]; gs = j; }
            float den = 0.f;
#pragma unroll
            for (int j = 0; j < 4; ++j) den += __expf(l[32 + j] - gm);
            const float gate = 1.0f / den;
            float e8[8];
#pragma unroll
            for (int j = 0; j < 8; ++j) e8[j] = gs == 0 ? l[j] : gs == 1 ? l[8 + j] : gs == 2 ? l[16 + j] : l[24 + j];
            int i1 = 0; float v1 = e8[0];
#pragma unroll
            for (int j = 1; j < 8; ++j) if (e8[j] > v1) { v1 = e8[j]; i1 = j; }
            int i2 = -1; float v2 = -INFINITY;
#pragma unroll
            for (int j = 0; j < 8; ++j) if (j != i1 && e8[j] > v2) { v2 = e8[j]; i2 = j; }
            const float e2 = __expf(v2 - v1); const float p1 = 1.0f / (1.0f + e2);
            es[F.tid * 2] = gs * 8 + i1; es[F.tid * 2 + 1] = gs * 8 + i2; wsl[F.tid * 2] = p1 * gate; wsl[F.tid * 2 + 1] = (1.0f - p1) * gate; }
        __syncthreads();
        if (F.tid < 32) { int cnt = 0; for (int i = 0; i < 128; ++i) if (es[i] == F.tid) lr[i] = cnt++;
            if (cnt) { const int base = (int)__hip_atomic_fetch_add(F.ctl + CW_CNT + cset * 32 + F.tid, (unsigned)cnt, __ATOMIC_RELAXED, __HIP_MEMORY_SCOPE_AGENT);
                for (int i = 0; i < 128; ++i) if (es[i] == F.tid) lr[i] += base; } }
        __syncthreads();
        if (F.tid < 64) { int* rt = (int*)(F.ws + WS_ROUTE) + ((size_t)blk * 64 + F.tid) * 8;
            rt[0] = es[F.tid * 2]; rt[1] = es[F.tid * 2 + 1]; ((float*)rt)[2] = wsl[F.tid * 2]; ((float*)rt)[3] = wsl[F.tid * 2 + 1]; rt[4] = lr[F.tid * 2]; rt[5] = lr[F.tid * 2 + 1]; ((float*)rt)[6] = rsd[F.tid]; }
    }
    __syncthreads();
    if (F.tid == 0) __hip_atomic_fetch_add(F.ctl + CW_RB + 64 * layer, 1u, __ATOMIC_RELAXED, __HIP_MEMORY_SCOPE_AGENT);
}
__device__ __forceinline__ void phase_moe_convert(const Frame& F_, int layer) { Frame F = relocal(F_);
    bf16_t* WGU = (bf16_t*)(F.ws + WS_MOE + MOE_WGU);
    for (int t = F.bid; t < 1024; t += F.G) {
        const int e = t >> 5, r = t & 31, kt = r >> 1, nt = r & 1; const size_t eo = ((size_t)layer * 32 + e) * 1024 * 256;
        tr_tile(F, 256, WGU + (size_t)e * 512 * 1024, 1024, kt * 64, nt * 256, SmGU{F.in[I_WGATE] + eo, F.in[I_WUP] + eo}); }
}
__device__ __forceinline__ void phase_moe_convert_down(const Frame& F_, int layer) { Frame F = relocal(F_);
    bf16_t* WD = (bf16_t*)(F.ws + WS_MOE + MOE_WD);
    for (;;) { const int q = q_pop(F, 32 + layer); if (q >= 512) break;
        const int e = q >> 4, r = q & 15, kt = r >> 2, nt = r & 3;
        tr_tile(F, 1024, WD + (size_t)e * 1024 * 256, 256, kt * 64, nt * 256, SmId{F.in[I_WDOWN] + ((size_t)layer * 32 + e) * 256 * 1024}); }
}
__device__ __forceinline__ void phase_gather(const Frame& F_, int layer) { Frame F = relocal(F_);
    LAS int* off = (LAS int*)F.lds;
    __syncthreads();
    if (F.tid == 0) { unsigned sp = 0;
        while (__hip_atomic_load(F.ctl + CW_RB + 64 * layer, __ATOMIC_RELAXED, __HIP_MEMORY_SCOPE_AGENT) < (unsigned)F.G) { __builtin_amdgcn_s_sleep(2); if (++sp > (1u << 22)) break; } }
    __syncthreads();
    if (F.tid == 0) { int acc = 0; for (int e = 0; e < 32; ++e) { off[e] = acc; const int c = (int)__hip_atomic_load(F.ctl + CW_CNT + layer * 32 + e, __ATOMIC_RELAXED, __HIP_MEMORY_SCOPE_AGENT); acc += (c + 255) & ~255; } off[32] = acc; }
    __syncthreads();
    int* tiles = (int*)(F.ws + WS_TILES); int* row_tok = (int*)(F.ws + WS_ROWS); float* row_w = (float*)(F.ws + WS_ROWS) + MAXROWS;
    if (F.bid == 0) { if (F.tid == 0) tiles[0] = off[32] >> 8; if (F.tid < 33) tiles[1 + F.tid] = off[F.tid];
        if (F.tid < 32) for (int rt = off[F.tid] >> 8; rt < (off[F.tid + 1] >> 8); ++rt) tiles[64 + rt] = F.tid; }
    for (int e = F.bid; e < 32; e += F.G) { const int c = (int)__hip_atomic_load(F.ctl + CW_CNT + layer * 32 + e, __ATOMIC_RELAXED, __HIP_MEMORY_SCOPE_AGENT);
        for (int r = off[e] + c + F.tid; r < off[e + 1]; r += NTHR) { row_tok[r] = -1; row_w[r] = 0.f; } }
    const float* X = (const float*)(F.ws + WS_X); bf16_t* HP = (bf16_t*)(F.ws + WS_U); const float* nw = F.in[I_NORM2] + (size_t)layer * DM;
    f32x4 nwv[4];
#pragma unroll
    for (int j = 0; j < 4; ++j) nwv[j] = *(const f32x4*)(nw + 4 * F.lane + 256 * j);
    for (int blk = F.bid; blk < NTOK / 64; blk += F.G)
    for (int i4 = 0; i4 < 2; ++i4) {
        int p0[4], p1[4], tt[4]; float rstd[4], w0[4], w1[4]; f32x4 xv[4][4];
#pragma unroll
        for (int r = 0; r < 4; ++r) { const int t = blk * 64 + F.wave * 8 + 4 * i4 + r; tt[r] = t;
            const int* rt = (const int*)(F.ws + WS_ROUTE) + (size_t)t * 8; rstd[r] = ((const float*)rt)[6]; w0[r] = ((const float*)rt)[2]; w1[r] = ((const float*)rt)[3];
            p0[r] = off[rt[0]] + rt[4]; p1[r] = off[rt[1]] + rt[5];
#pragma unroll
            for (int j = 0; j < 4; ++j) xv[r][j] = *(const f32x4*)(X + (size_t)t * DM + 4 * F.lane + 256 * j); }
#pragma unroll
        for (int r = 0; r < 4; ++r) {
#pragma unroll
            for (int j = 0; j < 4; ++j) { const int c = 4 * F.lane + 256 * j; const f32x4 v = xv[r][j] * rstd[r] * nwv[j];
                u32x2 o; o.x = pk2(v[0], v[1]); o.y = pk2(v[2], v[3]);
                *(u32x2*)(HP + (size_t)p0[r] * DM + c) = o; *(u32x2*)(HP + (size_t)p1[r] * DM + c) = o; }
            if (F.lane == 0) { row_tok[p0[r]] = tt[r] * 2; row_w[p0[r]] = w0[r]; row_tok[p1[r]] = tt[r] * 2 + 1; row_w[p1[r]] = w1[r]; } }
    }
}

constexpr int NPH_LAYER = 9, NPHASE = 1 + 2 * NPH_LAYER + 1;
#ifndef MK_ONLY
#define MK_ONLY -1
#endif
#ifndef MK_ITEM
#define MK_ITEM -1
#endif
#define EN(o) (MK_ONLY < 0 || MK_ONLY == (o))
#define IT(o) (MK_ITEM < 0 || MK_ITEM == (o))
__global__ void __launch_bounds__(NTHR, 2) mk_forward(Params P) {
    extern __shared__ __attribute__((aligned(16))) unsigned char lds_raw[];
    Frame F; F.lds = (LAS unsigned char*)lds_raw; F.tid = threadIdx.x; F.lane = F.tid & 63; F.wave = __builtin_amdgcn_readfirstlane(F.tid >> 6); F.bid = blockIdx.x; F.G = gridDim.x;
    F.in = (in_tab_t)__builtin_amdgcn_kernarg_segment_ptr(); F.out = P.out; F.ws = P.ws; F.ctl = (unsigned*)(P.ws + WS_CTL); F.misc = (volatile LAS int*)(F.lds + MISC_OFF);
    if (F.tid < 64) ((LAS unsigned*)(F.lds + MISC_OFF))[F.tid] = 0u;
    __syncthreads();
    const int lo = P.ph_lo, hi = P.ph_hi;
    XcdBarrier bar; bar.bar = F.ctl + CW_BAR; bar.x = 0; bar.st = (volatile LAS unsigned*)(F.lds + MISC_OFF + 16);
    if (hi - lo > 1) bar = xcd_barrier_post(F.ctl + CW_BAR, (volatile LAS unsigned*)(F.lds + MISC_OFF + 16));
#define IN(k) (lo <= (k) && (k) < hi)
#define SEAM(k) do { if (IN(k) && IN((k) + 1)) xcd_barrier(bar); } while (0)
#define QLOOP(qi, n, body) for (;;) { const int it = q_pop(F, layer * 12 + (qi)); if (it >= (n)) break; body; }
    if (EN(100) && IN(0)) { phase_prologue(F); phase_norm(F, F.in[I_X], false, F.in[I_NORM1], 0); } SEAM(0);
#pragma unroll
    for (int layer = 0; layer < DEPTH; ++layer) {
        const int pb = 1 + layer * NPH_LAYER;
        if (layer > 0) { if (EN(0) && IN(pb + 0)) { phase_norm(F, (const float*)(F.ws + WS_X), true, F.in[I_NORM1] + (size_t)layer * DM, 0); } SEAM(pb + 0); }
        if (EN(1) && IN(pb + 1)) { const Frame F_ = F; Frame F = relocal(F_); pg8::StaticOrder S; S.init((const bf16_t*)(F.ws + WS_H), (const bf16_t*)(F.ws + WS_WIN) + (size_t)layer * NINP * DM, NTOK, NINP, DM, F.G, F.bid);
            pg8::EpiBf16 E{(bf16_t*)(F.ws + WS_U), NINP}; pg8::gemm_phase(F.lds, DM, S, E); } SEAM(pb + 1);
#define SLOOP(n, body) for (int it = F.bid; it < (n); it += F.G) { __syncthreads(); body; }
        if (EN(2) && IN(pb + 2)) {
            if (IT(1)) SLOOP(1024, item_rwkv1(F, layer, it));
            if (IT(0)) SLOOP(256, item_s5<1>(F, layer, it));
            if (IT(2)) SLOOP(256, item_mamba<1>(F, layer, it));
            if (IT(3)) SLOOP(256, item_kv(F, layer, it));
        } SEAM(pb + 2);
        if (EN(3) && IN(pb + 3)) {
            if (IT(0)) QLOOP(4, 8, item_rwkv_carry(F, it));
            if (IT(1)) QLOOP(5, 16, item_mamba_carry(F, it));
            if (IT(2)) QLOOP(6, 4, item_s5_carry(F, layer, it));
            if (IT(3)) {
                dsa_tables(F);
                const int pref = (int)(xb_xcc_id() & 3u);
#pragma unroll 1
                for (int k4 = 0; k4 < 4; ++k4) { const int bq = (pref + k4) & 3;
                    for (;;) { const int it = q_pop(F, 24 + layer * 4 + bq); if (it >= 512) break; item_dsa(F, layer, it * 4 + bq); } } }
        } SEAM(pb + 3);
        if (EN(4) && IN(pb + 4)) {
            if (IT(0)) SLOOP(256, item_s5<2>(F, layer, it));
            if (IT(2)) SLOOP(256, item_mamba<2>(F, layer, it));
            if (IT(1)) SLOOP(1024, item_rwkv3(F, layer, it));
        } SEAM(pb + 4);
        if (EN(6) && IN(pb + 5)) { const Frame F_ = F; Frame F = relocal(F_); pg8::StaticOrder S; S.init((const bf16_t*)(F.ws + WS_H), (const bf16_t*)(F.ws + WS_WOUT) + (size_t)layer * DM * DM, NTOK, DM, DM, F.G, F.bid);
            pg8::EpiResid E{(float*)(F.ws + WS_X), DM}; pg8::gemm_phase(F.lds, DM, S, E); } SEAM(pb + 5);
        if (EN(7) && IN(pb + 6)) { phase_router(F, layer); phase_moe_convert(F, layer); phase_gather(F, layer); } SEAM(pb + 6);
        if (EN(8) && IN(pb + 7)) { const Frame F_ = F; Frame F = relocal(F_); LAS int* ul = (LAS int*)(F.lds + pg8::STAGE_BYTES + 8192); if (F.tid == 0) pg8::MoeOrder::build(ul, (const int*)(F.ws + WS_TILES), 2, F.G, F.bid); __syncthreads();
            pg8::MoeOrder S{DM, (const char*)(F.ws + WS_U), (const char*)(F.ws + WS_MOE + MOE_WGU), (size_t)512 * 1024 * 2, ul};
            pg8::EpiGated<1> E{(bf16_t*)(F.ws + WS_H), 256, 0, nullptr, nullptr}; pg8::gemm_phase(F.lds, DM, S, E); phase_moe_convert_down(F, layer); } SEAM(pb + 7);
        if (EN(9) && IN(pb + 8)) { const Frame F_ = F; Frame F = relocal(F_); LAS int* ul = (LAS int*)(F.lds + pg8::STAGE_BYTES + 8192); if (F.tid == 0) pg8::MoeOrder::build(ul, (const int*)(F.ws + WS_TILES), 4, F.G, F.bid); __syncthreads();
            pg8::MoeOrder S{256, (const char*)(F.ws + WS_H), (const char*)(F.ws + WS_MOE + MOE_WD), (size_t)1024 * 256 * 2, ul};
            pg8::EpiMoeOut E{(bf16_t*)(F.ws + WS_U), (const int*)(F.ws + WS_ROWS), (const float*)(F.ws + WS_ROWS) + MAXROWS, F.lds}; pg8::gemm_phase(F.lds, 256, S, E); } SEAM(pb + 8);
    }
    if (EN(101) && IN(NPHASE - 1)) { phase_norm(F, (const float*)(F.ws + WS_X), true, F.in[I_FNORM], 2); }
#undef IN
#undef SEAM
}

#ifndef MK_SPLIT
#define MK_SPLIT 0
#endif
extern "C" void kernel_launch(void* const* d_in, const int* in_sizes, int n_in, void* d_out, int out_size, void* d_ws, size_t ws_size, hipStream_t stream) {
    static int grid = 0;
    if (grid == 0) {
        if (n_in != 44 || out_size != NTOK * DM || ws_size < WS_END) { fprintf(stderr, "kernel_launch: unexpected shapes (n_in %d out %d ws %zu need %zu)\n", n_in, out_size, ws_size, (size_t)WS_END); grid = -1; return; }
        int dev = 0, cus = 0;
        if (hipGetDevice(&dev) != hipSuccess || hipDeviceGetAttribute(&cus, hipDeviceAttributeMultiprocessorCount, dev) != hipSuccess) { grid = -1; return; }
        if (hipFuncSetAttribute((const void*)mk_forward, hipFuncAttributeMaxDynamicSharedMemorySize, LDS_BYTES) != hipSuccess) { fprintf(stderr, "kernel_launch: hipFuncSetAttribute failed\n"); grid = -1; return; }
        int per_cu = 0;
        if (hipOccupancyMaxActiveBlocksPerMultiprocessor(&per_cu, (const void*)mk_forward, NTHR, LDS_BYTES) != hipSuccess || per_cu < 1) { fprintf(stderr, "kernel_launch: occupancy query says %d\n", per_cu); }
        (void)hipGetLastError();
        grid = cus;
    }
    if (grid < 0) return;
    hipMemsetAsync((char*)d_ws + WS_CTL, 0, CTL_BYTES, stream);
    Params p{};
    for (int i = 0; i < 44; ++i) p.in[i] = (const float*)d_in[i];
    p.out = (float*)d_out; p.ws = (unsigned char*)d_ws;
#if MK_SPLIT
    for (int ph = 0; ph < NPHASE; ++ph) { p.ph_lo = ph; p.ph_hi = ph + 1; hipLaunchKernelGGL(mk_forward, dim3(grid), dim3(NTHR), LDS_BYTES, stream, p); }
#else
    p.ph_lo = 0; p.ph_hi = NPHASE; hipLaunchKernelGGL(mk_forward, dim3(grid), dim3(NTHR), LDS_BYTES, stream, p);
#endif
}
```

```cpp
#include <hip/hip_runtime.h>
#include <stdint.h>
#include <stdio.h>

#define LAS __attribute__((address_space(3)))
typedef unsigned short bf16_t;
typedef short bf16x8 __attribute__((ext_vector_type(8)));
typedef float f32x4 __attribute__((ext_vector_type(4)));
typedef float f32x2 __attribute__((ext_vector_type(2)));
typedef float f32x16 __attribute__((ext_vector_type(16)));
typedef unsigned u32x4 __attribute__((ext_vector_type(4)));
typedef unsigned u32x2 __attribute__((ext_vector_type(2)));

constexpr int NTOK = 16384, DM = 1024, SEQ = 4096, NBATCH = 4, DEPTH = 2;
constexpr int NIN = 2604, NINP = 2816;
constexpr int UM = 0;
constexpr int UR = 784;
constexpr int UC = 1680;
constexpr int US = 2368;
constexpr int NTHR = 512;
constexpr int LDS_BYTES = 163840;
constexpr int MISC_OFF = LDS_BYTES - 256;

constexpr size_t WS_CTL   = 0;
constexpr size_t CTL_BYTES = 65536;
constexpr size_t WS_X     = WS_CTL + CTL_BYTES;
constexpr size_t WS_H     = WS_X + (size_t)NTOK * DM * 4;
constexpr size_t WS_U     = WS_H + (size_t)NTOK * DM * 2;
constexpr size_t WS_WIN   = WS_U + (size_t)NTOK * NINP * 2;
constexpr size_t WS_WOUT  = WS_WIN + (size_t)2 * NINP * DM * 2;
constexpr size_t WS_GLU   = WS_WOUT + (size_t)2 * DM * DM * 2;
constexpr size_t WS_MOE   = WS_GLU + (size_t)2 * 512 * 256 * 2;
constexpr size_t MOE_WGU  = 0;
constexpr size_t MOE_WD   = (size_t)32 * 512 * 1024 * 2;
constexpr size_t MOE_BYTES = MOE_WD + (size_t)32 * 1024 * 256 * 2;
constexpr size_t RW_PT    = 0;
constexpr size_t RW_U     = (size_t)1024 * 4096 * 2;
constexpr size_t RW_S     = RW_U + (size_t)1024 * 4096 * 2;
constexpr size_t RW_W1    = RW_S + (size_t)1024 * 4096 * 2;
constexpr size_t RW_Z     = RW_W1 + (size_t)1024 * 4096 * 2;
constexpr size_t YSG_OFF  = RW_Z + (size_t)1024 * 4096 * 2;
static_assert(YSG_OFF + (size_t)NTOK * 256 * 2 <= MOE_BYTES, "alias");
constexpr size_t WS_MST   = WS_MOE + MOE_BYTES;
constexpr size_t WS_MDEC  = WS_MST + (size_t)4 * 64 * 4 * 4096 * 4;
constexpr size_t WS_S5ST  = WS_MDEC + 4096;
constexpr size_t WS_K     = WS_S5ST + (size_t)4 * 64 * 2048 * 4;
constexpr size_t WS_V     = WS_K + (size_t)NTOK * 64 * 2;
constexpr size_t WS_KIDX  = WS_V + (size_t)NTOK * 64 * 2;
constexpr size_t WS_ROUTE = WS_KIDX + (size_t)NTOK * 32 * 2;
constexpr size_t WS_ROWS  = WS_ROUTE + (size_t)NTOK * 32;
constexpr int    MAXROWS  = 49152;
constexpr size_t WS_TILES = WS_ROWS + (size_t)MAXROWS * 8;
constexpr size_t WS_S5TAB = WS_TILES + 4096;
constexpr size_t S5TAB_F  = (size_t)(2048 + 2048 + 32768) * 4;
constexpr size_t S5TAB_BBT = S5TAB_F + (size_t)16 * 16 * 128 * 2;
constexpr size_t S5TAB_L  = S5TAB_BBT + (size_t)16 * 128 * 16 * 2;
constexpr size_t WS_WRT   = WS_S5TAB + 2 * S5TAB_L;
constexpr size_t WS_BON   = WS_WRT + (size_t)2 * 2 * 48 * 1024 * 2;
constexpr size_t WS_END   = WS_BON + (size_t)1024 * 64 * 4;

constexpr int CW_BAR = 0;
constexpr int CW_Q   = 4096;
constexpr int CW_CNT = 8192;
constexpr int CW_RB  = 8448;

__device__ __forceinline__ float bf2f(bf16_t b) { return __uint_as_float(((unsigned)b) << 16); }
__device__ __forceinline__ bf16_t f2bf(float f) { const __bf16 h = (__bf16)f; return __builtin_bit_cast(bf16_t, h); }
__device__ __forceinline__ unsigned pk2(float lo, float hi) { typedef __bf16 bf2_t __attribute__((ext_vector_type(2))); const bf2_t h = __builtin_convertvector((f32x2){lo, hi}, bf2_t); return __builtin_bit_cast(unsigned, h); }
__device__ __forceinline__ unsigned cvt_pk_bf16(float lo, float hi) { unsigned r; asm volatile("v_cvt_pk_bf16_f32 %0, %1, %2" : "=v"(r) : "v"(lo), "v"(hi)); return r; }
__device__ __forceinline__ float sigmoidf_(float x) { return 1.0f / (1.0f + __expf(-x)); }
__device__ __forceinline__ float siluf_(float x) { return x / (1.0f + __expf(-x)); }
__device__ __forceinline__ float tanhf_(float x) { const float e = __expf(2.0f * x); return 1.0f - 2.0f / (e + 1.0f); }
__device__ __forceinline__ float softplusf_(float x) { return fmaxf(x, 0.0f) + log1pf(__expf(-fabsf(x))); }
__device__ __forceinline__ float gelu_tanh(float x) { return 0.5f * x * (1.0f + tanhf_(0.7978845608028654f * (x + 0.044715f * x * x * x))); }
template <int CTRL> __device__ __forceinline__ float dppf(float x) { return __int_as_float(__builtin_amdgcn_update_dpp(0, __float_as_int(x), CTRL, 0xF, 0xF, true)); }
__device__ __forceinline__ float sum4(float x) { x += dppf<0xB1>(x); x += dppf<0x4E>(x); return x; }
__device__ __forceinline__ float sum8(float x) { x = sum4(x); x += dppf<0x141>(x); return x; }
__device__ __forceinline__ float sum16(float x) { x = sum8(x); x += dppf<0x140>(x); return x; }
__device__ __forceinline__ int lane_id_() { int l = (int)__builtin_amdgcn_mbcnt_hi(~0u, __builtin_amdgcn_mbcnt_lo(~0u, 0u)); asm volatile("" : "+v"(l)); return l; }
__device__ __forceinline__ float shx(float x, int o) { return __int_as_float(__builtin_amdgcn_ds_bpermute((lane_id_() ^ o) << 2, __float_as_int(x))); }
__device__ __forceinline__ unsigned shdown_u(unsigned x, int o) { return (unsigned)__builtin_amdgcn_ds_bpermute(((lane_id_() + o) & 63) << 2, (int)x); }
__device__ __forceinline__ int shidx_i(int x, int src) { return __builtin_amdgcn_ds_bpermute(src << 2, x); }
__device__ __forceinline__ float wave_sum(float x) { x = sum16(x); x += shx(x, 16); x += shx(x, 32); return x; }
__device__ __forceinline__ void unpack8(const u32x4 v, float (&f)[8]) {
    f[0] = __uint_as_float(v.x << 16); f[1] = __uint_as_float(v.x & 0xffff0000u); f[2] = __uint_as_float(v.y << 16); f[3] = __uint_as_float(v.y & 0xffff0000u);
    f[4] = __uint_as_float(v.z << 16); f[5] = __uint_as_float(v.z & 0xffff0000u); f[6] = __uint_as_float(v.w << 16); f[7] = __uint_as_float(v.w & 0xffff0000u);
}

#define XB_TMO      128
#define XB_XCNT(j)  (256  + 64 * (j))
#define XB_XSUB(j)  (1280 + 64 * (j))
#define XB_XGEN(j)  (2304 + 64 * (j))
#define XB_TOP      3328
#define XB_TOPGEN   3392
#define XCD_BAR_WORDS 3456
#define XB_SPIN_CAP (1u << 22)
__device__ __forceinline__ unsigned xb_ld(unsigned* p)              { return __hip_atomic_load(p, __ATOMIC_RELAXED, __HIP_MEMORY_SCOPE_AGENT); }
__device__ __forceinline__ unsigned xb_add(unsigned* p, unsigned v) { return __hip_atomic_fetch_add(p, v, __ATOMIC_RELAXED, __HIP_MEMORY_SCOPE_AGENT); }
__device__ __forceinline__ unsigned xb_xcc_id() { return (unsigned)__builtin_amdgcn_s_getreg((3 << 11) | 20) & 0xFu; }
#define XB_SPIN(cond, bar) do { unsigned _sp = 0; while (cond) { __builtin_amdgcn_s_sleep(1); \
    if ((++_sp & 255u) == 0u) { if (xb_ld(&(bar)[XB_TMO])) break; if (_sp > XB_SPIN_CAP) { atomicAdd(&(bar)[XB_TMO], 1u); break; } } } } while (0)
struct XcdBarrier { unsigned* bar; unsigned x; volatile LAS unsigned* st; };
__device__ __forceinline__ XcdBarrier xcd_barrier_post(unsigned* bar, volatile LAS unsigned* st) {
    XcdBarrier b; b.bar = bar; b.x = xb_xcc_id(); b.st = st;
    if (threadIdx.x == 0) (void)xb_add(&bar[XB_XCNT(b.x)], 1u);
    return b;
}
__device__ __forceinline__ void xcd_barrier_complete(unsigned* bar, unsigned x, unsigned& nloc, unsigned& nx) {
    const unsigned G = gridDim.x * gridDim.y * gridDim.z;
    unsigned sum, cnt, mine, sp = 0u;
    for (;;) {
        sum = 0u; cnt = 0u; mine = 0u;
#pragma unroll
        for (unsigned j = 0; j < 16; ++j) { const unsigned c = xb_ld(&bar[XB_XCNT(j)]); sum += c; cnt += (c > 0u) ? 1u : 0u; mine = (j == x) ? c : mine; }
        if (sum == G) break;
        __builtin_amdgcn_s_sleep(1);
        if ((++sp & 255u) == 0u) { if (xb_ld(&bar[XB_TMO])) break; if (sp > XB_SPIN_CAP) { atomicAdd(&bar[XB_TMO], 1u); break; } }
    }
    nloc = mine > 0u ? mine : 1u; nx = cnt > 0u ? cnt : 1u;
}
__device__ __forceinline__ void xcd_barrier(const XcdBarrier& b_) {
    XcdBarrier b = b_; { const unsigned long long v = (unsigned long long)b.bar; unsigned lo = __builtin_amdgcn_readfirstlane((unsigned)v), hi = __builtin_amdgcn_readfirstlane((unsigned)(v >> 32)); asm volatile("" : "+s"(lo), "+s"(hi)); b.bar = (unsigned*)(((unsigned long long)hi << 32) | lo); unsigned xx = __builtin_amdgcn_readfirstlane(b.x); asm volatile("" : "+s"(xx)); b.x = xx; }
    asm volatile("s_waitcnt vmcnt(0)" ::: "memory");
    __syncthreads();
    if (threadIdx.x == 0) {
        unsigned* bar = b.bar;
        __builtin_amdgcn_s_waitcnt(0);
        unsigned nloc = b.st[0], nx = b.st[1];
        if (nloc == 0u) { xcd_barrier_complete(bar, b.x, nloc, nx); b.st[0] = nloc; b.st[1] = nx; }
        const unsigned old = xb_add(&bar[XB_XSUB(b.x)], 1u);
        const unsigned gen = old / nloc;
        if (old + 1u == (gen + 1u) * nloc) {
            __builtin_amdgcn_fence(__ATOMIC_RELEASE, "agent");
            asm volatile("s_waitcnt vmcnt(0)" ::: "memory");
            const unsigned og = xb_add(&bar[XB_TOP], 1u);
            const unsigned tg = og / nx;
            if (og + 1u == (tg + 1u) * nx) xb_add(&bar[XB_TOPGEN], 1u);
            else XB_SPIN(xb_ld(&bar[XB_TOPGEN]) == tg, bar);
            __builtin_amdgcn_fence(__ATOMIC_ACQUIRE, "agent");
            xb_add(&bar[XB_XGEN(b.x)], 1u);
            asm volatile("s_waitcnt vmcnt(0)" ::: "memory");
        } else {
            XB_SPIN(xb_ld(&bar[XB_XGEN(b.x)]) == gen, bar);
            __builtin_amdgcn_fence(__ATOMIC_ACQUIRE, "agent");
            asm volatile("s_waitcnt vmcnt(0)" ::: "memory");
        }
    }
    __syncthreads();
}

namespace pg8 {
constexpr int BM = 256, BK = 64, HALF = 128, HTB = HALF * BK * 2, STAGE_BYTES = 8 * HTB, NXCD = 8, WGM = 8;
__host__ __device__ __forceinline__ int lds_byte(int r, int c) { const int st = (r >> 4) * 2 + (c >> 5), rr = r & 15, cc = c & 31, ob = rr * 64 + cc * 2; return st * 1024 + (ob ^ (((ob >> 9) & 1) << 5)); }
__host__ __device__ __forceinline__ void stage_rc(int b, int& R, int& C) { const int st = b / 1024, sb = b % 1024, swz = sb ^ (((sb >> 9) & 1) << 5); R = (st >> 1) * 16 + swz / 64; C = (st & 1) * 32 + (swz % 64) / 2; }
__host__ __device__ __forceinline__ int perm32(int rho) { const int n = rho >> 4, i = rho & 15; return 8 * (i >> 2) + 4 * n + (i & 3); }
struct Unit { int pm, pn; const char* a; const char* b; };

struct StaticOrder {
    int nM, nN, nwg, G, c, K; const char* A; const char* B;
    __device__ void init(const bf16_t* A_, const bf16_t* B_, int M, int N, int K_, int G_, int c_) { A = (const char*)A_; B = (const char*)B_; K = K_; nM = M / BM; nN = N / BM; nwg = nM * nN; G = G_; c = c_; }
    __device__ bool next(int i, Unit& u) const {
        const long L = (long)i * G + c; if (L >= nwg) return false;
        int wgid = (int)L; { const int q = nwg / NXCD, r = nwg % NXCD, xcd = wgid % NXCD, off = wgid / NXCD; wgid = (xcd < r ? xcd * (q + 1) : r * (q + 1) + (xcd - r) * q) + off; }
        const int nig = WGM * nN, gid = wgid / nig, fm = gid * WGM, gsz = (nM - fm) < WGM ? (nM - fm) : WGM;
        u.pm = fm + ((wgid % nig) % gsz); u.pn = (wgid % nig) / gsz;
        u.a = A + (size_t)u.pm * 256 * K * 2; u.b = B + (size_t)u.pn * 256 * K * 2; return true;
    }
};

template <class Epi, class Sched>
__device__ __forceinline__ void gemm_phase(LAS unsigned char* lds, const int K_, const Sched& S, const Epi& E) {
    int K = K_; asm volatile("" : "+s"(K));
    int tid_ = threadIdx.x; asm volatile("" : "+v"(tid_));
    const int tid = tid_, wid = __builtin_amdgcn_readfirstlane(tid >> 6), lane = tid & 63, wr = wid >> 2, wc = wid & 3, fr = lane & 15, fq = lane >> 4;
    const int nt = K / BK;
    unsigned voffA[2], voffB[2];
#pragma unroll
    for (int i = 0; i < 2; ++i) { int R, C; stage_rc(tid * 16 + i * 8192, R, C); const int Rb = Epi::PERM ? ((R & ~31) + perm32(R & 31)) : R;
        voffA[i] = (unsigned)(R * K + C) * 2u; voffB[i] = (unsigned)(Rb * K + C) * 2u; }
    const size_t kstep = (size_t)(BK * 2);
    const size_t hstep = (size_t)HALF * K * 2;
    const unsigned ldsw = (unsigned)wid * 1024u;
    const int aoff = lds_byte(wr * 64 + fr, fq * 8), boff = lds_byte(wc * 32 + fr, fq * 8);
#define PG8_SA(b, h) (((b) * 2 + (h)) * HTB)
#define PG8_SB(b, h) ((4 + (b) * 2 + (h)) * HTB)
#define PG8_STAGE(bufoff, gbase, voff) do { _Pragma("unroll") for (int _i = 0; _i < 2; ++_i) \
        __builtin_amdgcn_global_load_lds((const unsigned*)((const char*)(gbase) + (voff)[_i]), (LAS unsigned*)(lds + (bufoff) + ldsw + _i * 8192), 16, 0, 0); } while (0)
#define PG8_LDA(dst, b, h) do { _Pragma("unroll") for (int m = 0; m < 4; ++m) _Pragma("unroll") for (int k = 0; k < 2; ++k) dst[m][k] = *(const LAS bf16x8*)(lds + PG8_SA(b, h) + aoff + m * 2048 + k * 1024); } while (0)
#define PG8_LDB(dst, b, h) do { _Pragma("unroll") for (int n = 0; n < 2; ++n) _Pragma("unroll") for (int k = 0; k < 2; ++k) dst[n][k] = *(const LAS bf16x8*)(lds + PG8_SB(b, h) + boff + n * 2048 + k * 1024); } while (0)
#define PG8_MMA(ai, bj, At, Bt) do { __builtin_amdgcn_s_setprio(1); _Pragma("unroll") for (int m = 0; m < 4; ++m) _Pragma("unroll") for (int n = 0; n < 2; ++n) _Pragma("unroll") for (int k = 0; k < 2; ++k) \
        acc[ai][bj][m][n] = __builtin_amdgcn_mfma_f32_16x16x32_bf16(Bt[n][k], At[m][k], acc[ai][bj][m][n], 0, 0, 0); __builtin_amdgcn_s_setprio(0); } while (0)
#define PG8_WAIT_V(n) asm volatile("s_waitcnt vmcnt(" #n ")" ::: "memory")
#define PG8_WAIT_L(n) asm volatile("s_waitcnt lgkmcnt(" #n ")" ::: "memory")
#define PG8_BAR __builtin_amdgcn_s_barrier()
#define PG8_SCHED __builtin_amdgcn_sched_barrier(0)
    Unit cur, nxt; int ui = 0;
    if (!S.next(0, cur)) return;
    f32x4 acc[2][2][4][2];
#pragma unroll
    for (int a = 0; a < 2; ++a)
#pragma unroll
        for (int b = 0; b < 2; ++b)
#pragma unroll
            for (int m = 0; m < 4; ++m)
#pragma unroll
                for (int n = 0; n < 2; ++n) acc[a][b][m][n] = (f32x4){0.f, 0.f, 0.f, 0.f};
    bf16x8 At[4][2], B0[2][2], B1[2][2];
    const char* cA = cur.a; const char* cB = cur.b;
    PG8_STAGE(PG8_SB(0, 0), cB, voffB); PG8_STAGE(PG8_SA(0, 0), cA, voffA); PG8_STAGE(PG8_SB(0, 1), cB + hstep, voffB); PG8_STAGE(PG8_SA(0, 1), cA + hstep, voffA);
    if (wr == 1) PG8_BAR;
    PG8_WAIT_V(4); PG8_BAR;
    PG8_STAGE(PG8_SB(1, 0), cB + kstep, voffB); PG8_STAGE(PG8_SA(1, 0), cA + kstep, voffA); PG8_STAGE(PG8_SB(1, 1), cB + hstep + kstep, voffB);
    PG8_WAIT_V(6); PG8_BAR;
    for (;;) {
        const bool has_next = S.next(ui + 1, nxt);
        const char* nA = has_next ? nxt.a : cA; const char* nB = has_next ? nxt.b : cB;
        for (int t = 0; t < nt; t += 2) {
            const bool last = (t == nt - 2);
            const char* a1 = cA + (size_t)(t + 1) * kstep;
            const char* a2 = last ? nA : cA + (size_t)(t + 2) * kstep; const char* b2 = last ? nB : cB + (size_t)(t + 2) * kstep;
            const char* a3 = a2 + kstep; const char* b3 = b2 + kstep;
            PG8_LDB(B0, 0, 0); PG8_SCHED; PG8_LDA(At, 0, 0); PG8_STAGE(PG8_SA(1, 1), a1 + hstep, voffA);
            PG8_WAIT_L(8); PG8_BAR; PG8_WAIT_L(0); PG8_MMA(0, 0, At, B0); PG8_BAR; PG8_SCHED;
            PG8_LDB(B1, 0, 1); PG8_STAGE(PG8_SB(0, 0), b2, voffB);
            PG8_BAR; PG8_WAIT_L(0); PG8_MMA(0, 1, At, B1); PG8_BAR;
            PG8_LDA(At, 0, 1); PG8_STAGE(PG8_SA(0, 0), a2, voffA);
            PG8_BAR; PG8_WAIT_L(0); PG8_MMA(1, 0, At, B0); PG8_BAR; PG8_SCHED;
            PG8_STAGE(PG8_SB(0, 1), b2 + hstep, voffB);
            PG8_WAIT_V(6); PG8_BAR; PG8_MMA(1, 1, At, B1); PG8_BAR;
            PG8_LDB(B0, 1, 0); PG8_SCHED; PG8_LDA(At, 1, 0); PG8_STAGE(PG8_SA(0, 1), a2 + hstep, voffA);
            PG8_WAIT_L(8); PG8_BAR; PG8_WAIT_L(0); PG8_MMA(0, 0, At, B0); PG8_BAR; PG8_SCHED;
            PG8_LDB(B1, 1, 1); PG8_STAGE(PG8_SB(1, 0), b3, voffB);
            PG8_BAR; PG8_WAIT_L(0); PG8_MMA(0, 1, At, B1); PG8_BAR;
            PG8_LDA(At, 1, 1); PG8_STAGE(PG8_SA(1, 0), a3, voffA);
            PG8_BAR; PG8_WAIT_L(0); PG8_MMA(1, 0, At, B0); PG8_BAR; PG8_SCHED;
            PG8_STAGE(PG8_SB(1, 1), b3 + hstep, voffB);
            PG8_WAIT_V(6); PG8_BAR; PG8_MMA(1, 1, At, B1); PG8_BAR;
        }
        E(acc, cur, wr, wc, fr, fq);
        if (!has_next) break;
#pragma unroll
        for (int a = 0; a < 2; ++a)
#pragma unroll
            for (int b = 0; b < 2; ++b)
#pragma unroll
                for (int m = 0; m < 4; ++m)
#pragma unroll
                    for (int n = 0; n < 2; ++n) acc[a][b][m][n] = (f32x4){0.f, 0.f, 0.f, 0.f};
        cur = nxt; cA = nA; cB = nB; ++ui;
    }
    PG8_WAIT_V(0);
    if (wr == 0) PG8_BAR;
    PG8_BAR;
#undef PG8_SA
#undef PG8_SB
#undef PG8_STAGE
#undef PG8_LDA
#undef PG8_LDB
#undef PG8_MMA
#undef PG8_WAIT_V
#undef PG8_WAIT_L
#undef PG8_BAR
#undef PG8_SCHED
}

struct EpiBf16 {
    static constexpr bool PERM = true;
    bf16_t* O; int ldc;
    __device__ __forceinline__ void operator()(const f32x4 (&acc)[2][2][4][2], const Unit& u, int wr, int wc, int fr, int fq) const {
        const int row0 = u.pm * BM + wr * 64 + fr, col0 = u.pn * BM + wc * 32 + 8 * fq;
#pragma unroll
        for (int ai = 0; ai < 2; ++ai)
#pragma unroll
            for (int m = 0; m < 4; ++m) { bf16_t* rowp = O + (size_t)(row0 + ai * HALF + m * 16) * ldc + col0;
#pragma unroll
                for (int bj = 0; bj < 2; ++bj) { const f32x4 v0 = acc[ai][bj][m][0], v1 = acc[ai][bj][m][1];
                    u32x4 w; w.x = cvt_pk_bf16(v0[0], v0[1]); w.y = cvt_pk_bf16(v0[2], v0[3]); w.z = cvt_pk_bf16(v1[0], v1[1]); w.w = cvt_pk_bf16(v1[2], v1[3]);
                    *(u32x4*)(rowp + bj * HALF) = w; } }
    }
};
struct EpiResid {
    static constexpr bool PERM = false;
    float* C; int ldc;
    __device__ __forceinline__ void operator()(const f32x4 (&acc)[2][2][4][2], const Unit& u, int wr, int wc, int fr_, int fq_) const {
        int fr = fr_, fq = fq_; asm volatile("" : "+v"(fr), "+v"(fq));
        const int row0 = u.pm * BM + wr * 64 + fr, col0 = u.pn * BM + wc * 32 + 4 * fq;
#pragma unroll
        for (int ai = 0; ai < 2; ++ai)
#pragma unroll
            for (int mp = 0; mp < 2; ++mp) { f32x4 cv[2][2][2];
#pragma unroll
                for (int mm = 0; mm < 2; ++mm) { const float* rowp = C + (size_t)(row0 + ai * HALF + (2 * mp + mm) * 16) * ldc + col0;
#pragma unroll
                    for (int bj = 0; bj < 2; ++bj)
#pragma unroll
                        for (int n = 0; n < 2; ++n) cv[mm][bj][n] = *(const f32x4*)(rowp + bj * HALF + n * 16); }
#pragma unroll
                for (int mm = 0; mm < 2; ++mm) { float* rowp = C + (size_t)(row0 + ai * HALF + (2 * mp + mm) * 16) * ldc + col0;
#pragma unroll
                    for (int bj = 0; bj < 2; ++bj)
#pragma unroll
                        for (int n = 0; n < 2; ++n) *(f32x4*)(rowp + bj * HALF + n * 16) = cv[mm][bj][n] + acc[ai][bj][2 * mp + mm][n]; }
                asm volatile("" ::: "memory"); }
    }
};
template <int ACT  > struct EpiGated {
    static constexpr bool PERM = true;
    bf16_t* O; int ldo; int coloff; const float* ba; const float* bb;
    __device__ __forceinline__ void operator()(const f32x4 (&acc)[2][2][4][2], const Unit& u, int wr, int wc, int fr, int fq) const {
        const int row0 = u.pm * BM + wr * 64 + fr, cl = u.pn * HALF + wc * 32 + 8 * fq;
        float va[8], vb[8];
#pragma unroll
        for (int j = 0; j < 8; ++j) { va[j] = (ACT == 0) ? ba[cl + j] : 0.f; vb[j] = (ACT == 0) ? bb[cl + j] : 0.f; }
#pragma unroll
        for (int ai = 0; ai < 2; ++ai)
#pragma unroll
            for (int m = 0; m < 4; ++m) { bf16_t* rowp = O + (size_t)(row0 + ai * HALF + m * 16) * ldo + coloff + cl;
                float o[8];
#pragma unroll
                for (int n = 0; n < 2; ++n)
#pragma unroll
                    for (int j = 0; j < 4; ++j) { const float a = acc[ai][0][m][n][j] + va[4 * n + j], b = acc[ai][1][m][n][j] + vb[4 * n + j];
                        o[4 * n + j] = (ACT == 0) ? a * sigmoidf_(b) : siluf_(a) * b; }
                u32x4 w; w.x = cvt_pk_bf16(o[0], o[1]); w.y = cvt_pk_bf16(o[2], o[3]); w.z = cvt_pk_bf16(o[4], o[5]); w.w = cvt_pk_bf16(o[6], o[7]);
                *(u32x4*)rowp = w; asm volatile("" ::: "memory"); }
    }
};
struct EpiMoeOut {
    static constexpr bool PERM = true;
    bf16_t* O; const int* row_tok; const float* row_w; LAS unsigned char* lds;
    __device__ __forceinline__ void operator()(const f32x4 (&acc)[2][2][4][2], const Unit& u, int wr, int wc, int fr_, int fq_) const {
        int fr = fr_, fq = fq_; asm volatile("" : "+v"(fr), "+v"(fq));
        const int col0 = u.pn * BM + wc * 32 + 8 * fq, lane = fq * 16 + fr;
        LAS u32x2* rinfo = (LAS u32x2*)(lds + STAGE_BYTES) + (wr * 4 + wc) * 128;
        { const int ra = u.pm * BM + wr * 64 + lane, rb = ra + HALF;
          const u32x2 ia = (u32x2){(unsigned)row_tok[ra], __float_as_uint(row_w[ra])}, ib = (u32x2){(unsigned)row_tok[rb], __float_as_uint(row_w[rb])};
          rinfo[lane] = ia; rinfo[64 + lane] = ib; }
#pragma unroll
        for (int ai = 0; ai < 2; ++ai)
#pragma unroll
            for (int m = 0; m < 4; ++m) { const u32x2 inf = rinfo[ai * 64 + m * 16 + fr]; const int ts = (int)inf.x; const float w = __uint_as_float(inf.y);
                if (ts >= 0) { bf16_t* rowp = O + ((size_t)(ts & 1) * NTOK + (size_t)(ts >> 1)) * DM + col0;
#pragma unroll
                    for (int bj = 0; bj < 2; ++bj) { const f32x4 v0 = acc[ai][bj][m][0] * w, v1 = acc[ai][bj][m][1] * w;
                        u32x4 q; q.x = cvt_pk_bf16(v0[0], v0[1]); q.y = cvt_pk_bf16(v0[2], v0[3]); q.z = cvt_pk_bf16(v1[0], v1[1]); q.w = cvt_pk_bf16(v1[2], v1[3]);
                        *(u32x4*)(rowp + bj * HALF) = q; } } }
    }
};
struct MoeOrder {
    int K; const char* A; const char* B; size_t bstride; const LAS int* list;
    static __device__ __forceinline__ void build(LAS int* list, const int* tiles, int nN, int G, int c) {
        const int nrt = tiles[0], nwg = nrt * nN; int n = 0;
        for (int i = 0; ; ++i) { const long L = (long)i * G + c; if (L >= (long)nwg || n >= 20) break;
            int wgid = (int)L; { const int q = nwg / NXCD, r = nwg % NXCD, xcd = wgid % NXCD, off = wgid / NXCD; wgid = (xcd < r ? xcd * (q + 1) : r * (q + 1) + (xcd - r) * q) + off; }
            const int pm = wgid / nN; list[1 + 3 * n] = pm; list[2 + 3 * n] = wgid % nN; list[3 + 3 * n] = tiles[64 + pm]; ++n; }
        list[0] = n;
    }
    __device__ bool next(int i, Unit& u) const {
        const int n = __builtin_amdgcn_readfirstlane(list[0]); if (i >= n) return false;
        u.pm = __builtin_amdgcn_readfirstlane(list[1 + 3 * i]); u.pn = __builtin_amdgcn_readfirstlane(list[2 + 3 * i]); const int e = __builtin_amdgcn_readfirstlane(list[3 + 3 * i]);
        u.a = A + (size_t)u.pm * 256 * K * 2; u.b = B + (size_t)e * bstride + (size_t)u.pn * 256 * K * 2; return true;
    }
};
}

struct Params { const float* in[44]; float* out; unsigned char* ws; int ph_lo, ph_hi; };
enum { I_X = 0, I_NORM1, I_WIN, I_MCONVW, I_MCONVB, I_MDTB, I_MALOG, I_MD, I_MNORM, I_RMU, I_RW0, I_RW2, I_RA0, I_RA2, I_RG2, I_RKK, I_RKA, I_RRK, I_RLNW, I_RLNB,
       I_CKVN, I_CWUK, I_CWUV, I_RELB, I_SARE, I_SAIM, I_SBRE, I_SBIM, I_SCRE, I_SCIM, I_SD, I_SLOGDT, I_SGLUW, I_SGLUB, I_WOUT, I_NORM2, I_WRG, I_BRG, I_WRE, I_BRE,
       I_WGATE, I_WUP, I_WDOWN, I_FNORM };

typedef const float* const __attribute__((address_space(4)))* in_tab_t;
struct Frame {
    LAS unsigned char* lds; int tid, lane, wave, bid, G;
    in_tab_t in; float* out; unsigned char* ws; unsigned* ctl;
    volatile LAS int* misc;
};

__device__ __forceinline__ int q_pop(Frame& F, int qi) {
    __syncthreads();
    if (F.tid == 0) F.misc[0] = (int)__hip_atomic_fetch_add(F.ctl + CW_Q + 64 * qi, 1u, __ATOMIC_RELAXED, __HIP_MEMORY_SCOPE_AGENT);
    __syncthreads();
    return F.misc[0];
}

__device__ __forceinline__ const void* opaque_ptr(const void* p) { const unsigned long long v = (unsigned long long)p; unsigned lo = __builtin_amdgcn_readfirstlane((unsigned)v), hi = __builtin_amdgcn_readfirstlane((unsigned)(v >> 32));
    asm volatile("" : "+s"(lo), "+s"(hi)); return (const void*)(((unsigned long long)hi << 32) | lo); }
__device__ __forceinline__ Frame relocal(const Frame& G) { Frame F = G; asm volatile("" : "+v"(F.tid)); F.ws = (unsigned char*)opaque_ptr(F.ws); F.ctl = (unsigned*)(F.ws + WS_CTL); F.in = (in_tab_t)(unsigned long long)opaque_ptr((const void*)(unsigned long long)F.in); F.lane = F.tid & 63; F.wave = __builtin_amdgcn_readfirstlane(F.tid >> 6); return F; }
template <int K> __device__ __forceinline__ f32x4 mma_nt(const LAS bf16_t* A, int lda, const LAS bf16_t* Bt, int ldb, f32x4 acc, int lane) {
    const int r = lane & 15, g = lane >> 4;
#pragma unroll
    for (int k0 = 0; k0 < K; k0 += 32) {
        const bf16x8 a = *(const LAS bf16x8*)(A + r * lda + k0 + 8 * g);
        const bf16x8 b = *(const LAS bf16x8*)(Bt + r * ldb + k0 + 8 * g);
        acc = __builtin_amdgcn_mfma_f32_16x16x32_bf16(a, b, acc, 0, 0, 0);
    }
    return acc;
}

template <class SrcMap> __device__ __forceinline__ void tr_tile(Frame& F, int ldsrc, bf16_t* dst, int K, int k0, int n0, SrcMap sm) {
    LAS float* tile = (LAS float*)F.lds;
    __syncthreads();
    { const int n4 = (F.tid & 63) * 4, kk = F.tid >> 6; const float* sp = sm(n0 + n4);
      f32x4 v[8];
#pragma unroll
      for (int ps = 0; ps < 8; ++ps) { v[ps] = (f32x4){0.f, 0.f, 0.f, 0.f}; if (sp) v[ps] = *(const f32x4*)(sp + (size_t)(k0 + kk + 8 * ps) * ldsrc); }
#pragma unroll
      for (int ps = 0; ps < 8; ++ps) { LAS float* t = tile + (kk + 8 * ps) * 257 + n4; t[0] = v[ps][0]; t[1] = v[ps][1]; t[2] = v[ps][2]; t[3] = v[ps][3]; } }
    __syncthreads();
    { const int kc = F.tid & 7;
#pragma unroll
      for (int j = 0; j < 4; ++j) { const int n = (F.tid >> 3) + 64 * j; float f[8];
#pragma unroll
          for (int i = 0; i < 8; ++i) f[i] = tile[(8 * kc + i) * 257 + n];
          u32x4 w; w.x = pk2(f[0], f[1]); w.y = pk2(f[2], f[3]); w.z = pk2(f[4], f[5]); w.w = pk2(f[6], f[7]);
          *(u32x4*)(dst + (size_t)(n0 + n) * K + k0 + 8 * kc) = w; } }
}

struct SmIn { const float* base; __device__ __forceinline__ const float* operator()(int n) const {
    int c; if (n < 772) c = n; else if (n < UR) return nullptr; else if (n < UR + 896) c = 772 + (n - UR); else if (n < UC) return nullptr;
    else if (n < UC + 680) c = 1668 + (n - UC); else if (n < US) return nullptr; else if (n < US + 256) c = 2348 + (n - US); else return nullptr; return base + c; } };
struct SmId { const float* base; __device__ __forceinline__ const float* operator()(int n) const { return base + n; } };
struct SmGlu { const float* base; __device__ __forceinline__ const float* operator()(int n) const { const int pn = n >> 8, rr = n & 255; return base + (rr < 128 ? 128 * pn + rr : 256 + 128 * pn + (rr - 128)); } };
struct SmGU { const float* gate; const float* up; __device__ __forceinline__ const float* operator()(int n) const {
    const unsigned long long d = (unsigned long long)up - (unsigned long long)gate; const unsigned long long a = (unsigned long long)gate + (((n & 255) < 128) ? 0ull : d); return (const float*)a + 128 * (n >> 8) + (n & 127); } };
__device__ __forceinline__ void phase_prologue(const Frame& F_) { Frame F = relocal(F_);
    for (int t = F.bid; t < 496; t += F.G) {
        if (t < 352) { const int l = t / 176, r = t % 176, kt = r / 11, nt = r % 11;
            tr_tile(F, NIN, (bf16_t*)(F.ws + WS_WIN) + (size_t)l * NINP * DM, DM, kt * 64, nt * 256, SmIn{F.in[I_WIN] + (size_t)l * DM * NIN}); }
        else if (t < 480) { const int q = t - 352, l = q / 64, r = q % 64, kt = r / 4, nt = r % 4;
            tr_tile(F, DM, (bf16_t*)(F.ws + WS_WOUT) + (size_t)l * DM * DM, DM, kt * 64, nt * 256, SmId{F.in[I_WOUT] + (size_t)l * DM * DM}); }
        else { const int q = t - 480, l = q / 8, r = q % 8, kt = r / 2, nt = r % 2;
            tr_tile(F, 512, (bf16_t*)(F.ws + WS_GLU) + (size_t)l * 512 * 256, 256, kt * 64, nt * 256, SmGlu{F.in[I_SGLUW] + (size_t)l * 256 * 512}); }
    }
    for (int i = F.bid * NTHR + F.tid; i < 2 * 48 * 1024; i += F.G * NTHR) { const int l = i / 49152, r = i % 49152, o = r >> 10, k = r & 1023;
        float v = 0.f; if (o < 32) v = F.in[I_WRE][((size_t)l * DM + k) * 32 + o]; else if (o < 36) v = F.in[I_WRG][((size_t)l * DM + k) * 4 + (o - 32)];
        v *= F.in[I_NORM2][l * DM + k];
        const bf16_t hi = f2bf(v); const bf16_t lo = f2bf(v - bf2f(hi));
        bf16_t* w = (bf16_t*)(F.ws + WS_WRT) + (size_t)l * 2 * 49152; w[r] = hi; w[49152 + r] = lo; }
    for (int i = F.bid * NTHR + F.tid; i < 2048 + 65536; i += F.G * NTHR) {
        if (i < 2048) {
            const int l = i >> 10, gn = i & 1023, g = gn >> 6;
            float* tab = (float*)(F.ws + WS_S5TAB + (size_t)l * S5TAB_L);
            const float lre = fminf(F.in[I_SARE][l * 1024 + gn], -1e-4f), lim = F.in[I_SAIM][l * 1024 + gn];
            const float dt = expf(F.in[I_SLOGDT][l * 16 + g]);
            const float mag = expf(dt * lre); float sn, cs; sincosf(dt * lim, &sn, &cs);
            const float are = mag * cs, aim = mag * sn;
            const float den = lre * lre + lim * lim;
            const float fre = ((are - 1.0f) * lre + aim * lim) / den, fim = (aim * lre - (are - 1.0f) * lim) / den;
            tab[gn * 2] = are; tab[gn * 2 + 1] = aim;
            float pr = are, pi = aim;
#pragma unroll
            for (int s = 0; s < 6; ++s) { const float nr = pr * pr - pi * pi, ni = 2.0f * pr * pi; pr = nr; pi = ni; }
            tab[2048 + gn * 2] = pr; tab[2048 + gn * 2 + 1] = pi;
            const float* bre = F.in[I_SBRE] + ((size_t)l * 1024 + gn) * 16; const float* bim = F.in[I_SBIM] + ((size_t)l * 1024 + gn) * 16;
            bf16_t* bbt = (bf16_t*)(F.ws + WS_S5TAB + (size_t)l * S5TAB_L + S5TAB_BBT); const int n = gn & 63, col = 4 * (n & 31) + 2 * (n >> 5);
            for (int p = 0; p < 16; ++p) { const float vr = fre * bre[p] - fim * bim[p], vi = fre * bim[p] + fim * bre[p];
                bbt[((size_t)g * 128 + col) * 16 + p] = f2bf(vr); bbt[((size_t)g * 128 + col + 1) * 16 + p] = f2bf(vi); }
        } else {
            const int j = i - 2048, l = j >> 15, r = j & 32767, gp = r >> 7, k = r & 127;
            bf16_t* cm = (bf16_t*)(F.ws + WS_S5TAB + (size_t)l * S5TAB_L + S5TAB_F);
            const int n = (k >> 2) + 32 * ((k >> 1) & 1);
            const float v = (k & 1) == 0 ? F.in[I_SCRE][((size_t)l * 256 + gp) * 64 + n] : -F.in[I_SCIM][((size_t)l * 256 + gp) * 64 + n];
            cm[r] = f2bf(v);
        }
    }
}

__device__ __forceinline__ void phase_norm(const Frame& F_, const float* xin, bool add_o, const float* w, int mode) { Frame F = relocal(F_);
    float* X = (float*)(F.ws + WS_X); bf16_t* H = (bf16_t*)(F.ws + WS_H); const bf16_t* O = (const bf16_t*)(F.ws + WS_U);
    for (int row0 = F.bid * 32 + F.wave * 4; row0 < NTOK; row0 += F.G * 32) {
        f32x4 v[4][4]; u32x2 oa[4][4], ob[4][4];
#pragma unroll
        for (int r = 0; r < 4; ++r)
#pragma unroll
            for (int j = 0; j < 4; ++j) { const int c = 4 * F.lane + 256 * j; const size_t o = (size_t)(row0 + r) * DM + c; v[r][j] = *(const f32x4*)(xin + o);
                if (add_o) { oa[r][j] = *(const u32x2*)(O + o); ob[r][j] = *(const u32x2*)(O + (size_t)NTOK * DM + o); } }
#pragma unroll
        for (int r = 0; r < 4; ++r) { const int row = row0 + r; float ss = 0.f;
#pragma unroll
            for (int j = 0; j < 4; ++j) {
                if (add_o) { const u32x2 a = oa[r][j], b = ob[r][j];
                    v[r][j][0] += __uint_as_float(a.x << 16) + __uint_as_float(b.x << 16); v[r][j][1] += __uint_as_float(a.x & 0xffff0000u) + __uint_as_float(b.x & 0xffff0000u);
                    v[r][j][2] += __uint_as_float(a.y << 16) + __uint_as_float(b.y << 16); v[r][j][3] += __uint_as_float(a.y & 0xffff0000u) + __uint_as_float(b.y & 0xffff0000u); }
                ss += v[r][j][0] * v[r][j][0] + v[r][j][1] * v[r][j][1] + v[r][j][2] * v[r][j][2] + v[r][j][3] * v[r][j][3]; }
            ss = wave_sum(ss);
            const float rstd = rsqrtf(ss * (1.0f / DM) + 1e-6f);
#pragma unroll
            for (int j = 0; j < 4; ++j) { const int c = 4 * F.lane + 256 * j; const f32x4 wv = *(const f32x4*)(w + c);
                if (mode == 2) { *(f32x4*)(F.out + (size_t)row * DM + c) = v[r][j] * rstd * wv; }
                else { *(f32x4*)(X + (size_t)row * DM + c) = v[r][j];
                    u32x2 o; o.x = pk2(v[r][j][0] * rstd * wv[0], v[r][j][1] * rstd * wv[1]); o.y = pk2(v[r][j][2] * rstd * wv[2], v[r][j][3] * rstd * wv[3]);
                    *(u32x2*)(H + (size_t)row * DM + c) = o; } } }
    }
}

__device__ __forceinline__ void item_kv(const Frame& F_, int layer, int item) { Frame F = relocal(F_);
    const bf16_t* U = (const bf16_t*)(F.ws + WS_U);
    LAS bf16_t* Ab = (LAS bf16_t*)F.lds;
    LAS bf16_t* Bt = (LAS bf16_t*)(F.lds + 17408);
    const int t0 = item * 64;
    { const int tok = F.tid >> 3, part = F.tid & 7; const bf16_t* src = U + (size_t)(t0 + tok) * NINP + UC + 256 + 16 * part;
      float f[16]; { float a[8], b[8]; unpack8(*(const u32x4*)src, a); unpack8(*(const u32x4*)(src + 8), b);
#pragma unroll
        for (int j = 0; j < 8; ++j) { f[j] = a[j]; f[8 + j] = b[j]; } }
      float ss = 0.f;
#pragma unroll
      for (int j = 0; j < 16; ++j) ss += f[j] * f[j];
      ss = sum8(ss);
      const float rstd = rsqrtf(ss * (1.0f / 128.0f) + 1e-6f); const float* nw = F.in[I_CKVN] + layer * 128 + 16 * part;
#pragma unroll
      for (int j = 0; j < 16; j += 2) *(LAS unsigned*)(Ab + tok * 136 + 16 * part + j) = pk2(f[j] * rstd * nw[j], f[j + 1] * rstd * nw[j + 1]); }
    { const int n = F.tid >> 2, kq = F.tid & 3; const float* w = (n < 64 ? F.in[I_CWUK] : F.in[I_CWUV]) + (size_t)layer * 128 * 64 + (n & 63);
      float wv[32];
#pragma unroll
      for (int k = 0; k < 32; ++k) wv[k] = w[(size_t)(32 * kq + k) * 64];
#pragma unroll
      for (int k = 0; k < 32; k += 2) *(LAS unsigned*)(Bt + n * 136 + 32 * kq + k) = pk2(wv[k], wv[k + 1]); }
    if (F.tid < 256) { const int tok = F.tid >> 2, q = F.tid & 3;
        *(u32x4*)((bf16_t*)(F.ws + WS_KIDX) + (size_t)(t0 + tok) * 32 + 8 * q) = *(const u32x4*)(U + (size_t)(t0 + tok) * NINP + UC + 640 + 8 * q); }
    __syncthreads();
    const int mt = F.wave & 3, g = F.lane >> 4, r = F.lane & 15;
#pragma unroll
    for (int q = 0; q < 4; ++q) { const int nt = (F.wave >> 2) * 4 + q;
        f32x4 acc = (f32x4){0.f, 0.f, 0.f, 0.f};
        acc = mma_nt<128>(Ab + mt * 16 * 136, 136, Bt + nt * 16 * 136, 136, acc, F.lane);
        const int n = nt * 16 + r; bf16_t* dst = (bf16_t*)(F.ws + (n < 64 ? WS_K : WS_V));
#pragma unroll
        for (int i = 0; i < 4; ++i) dst[(size_t)(t0 + mt * 16 + 4 * g + i) * 64 + (n & 63)] = f2bf(acc[i]); }
}

constexpr int MB_CG = 0, MB_BG = 18432, MB_BT = 36864, MB_XT = 55296, MB_M = 92160, MB_S0 = 101376, MB_DT = 110592, MB_AC = 111616, MB_RS = 112640;
template <int STAGE> __device__ __forceinline__ void item_mamba(const Frame& F_, int layer, int item) { Frame F = relocal(F_);
    const bf16_t* U = (const bf16_t*)(F.ws + WS_U);
    const int b = item >> 6, c = item & 63, l0 = c * 64; const size_t T0 = (size_t)b * SEQ + l0;
    LAS bf16_t* Cg = (LAS bf16_t*)(F.lds + MB_CG); LAS bf16_t* Bg = (LAS bf16_t*)(F.lds + MB_BG); LAS bf16_t* BT = (LAS bf16_t*)(F.lds + MB_BT);
    LAS bf16_t* XT = (LAS bf16_t*)(F.lds + MB_XT); LAS bf16_t* Mb = (LAS bf16_t*)(F.lds + MB_M); LAS bf16_t* S0 = (LAS bf16_t*)(F.lds + MB_S0);
    LAS float* dts = (LAS float*)(F.lds + MB_DT); LAS float* acs = (LAS float*)(F.lds + MB_AC); LAS float* rs = (LAS float*)(F.lds + MB_RS);
    if (F.tid < 256) { const int l = F.tid >> 2, h = F.tid & 3;
        const float raw = bf2f(U[(T0 + l) * NINP + UM + 768 + h]) + F.in[I_MDTB][layer * 4 + h];
        const float dt = softplusf_(raw); dts[l * 4 + h] = dt; acs[l * 4 + h] = -__expf(F.in[I_MALOG][layer * 4 + h]) * dt; }
    if (F.tid < 64) rs[F.tid] = 0.f;
    __syncthreads();
    float mycum = 0.f;
    if (F.tid < 256) { const int l = F.tid >> 2, h = F.tid & 3; for (int s = 0; s <= l; ++s) mycum += acs[s * 4 + h]; }
    __syncthreads();
    if (F.tid < 256) acs[F.tid] = mycum;
    __syncthreads();
    { const int ch8 = F.tid & 63, tg = F.tid >> 6, c0 = ch8 * 8;
      float wv[4][8], bv[8];
#pragma unroll
      for (int j = 0; j < 8; ++j) { bv[j] = F.in[I_MCONVB][layer * 512 + c0 + j];
#pragma unroll
          for (int k = 0; k < 4; ++k) wv[k][j] = F.in[I_MCONVW][(layer * 4 + k) * 512 + c0 + j]; }
      float win[3][8];
#pragma unroll
      for (int k = 0; k < 3; ++k) { const int l = l0 + tg * 8 - 3 + k;
          if (l >= 0) unpack8(*(const u32x4*)(U + ((size_t)b * SEQ + l) * NINP + UM + 256 + c0), win[k]);
          else {
#pragma unroll
              for (int j = 0; j < 8; ++j) win[k][j] = 0.f; } }
#pragma unroll 1
      for (int ib = 0; ib < 2; ++ib) { u32x4 rows[4];
#pragma unroll
          for (int i4 = 0; i4 < 4; ++i4) rows[i4] = *(const u32x4*)(U + (T0 + tg * 8 + ib * 4 + i4) * NINP + UM + 256 + c0);
#pragma unroll
      for (int i4 = 0; i4 < 4; ++i4) { const int l = tg * 8 + ib * 4 + i4; float cur[8]; unpack8(rows[i4], cur);
          float o[8];
#pragma unroll
          for (int j = 0; j < 8; ++j) { o[j] = siluf_(bv[j] + wv[0][j] * win[0][j] + wv[1][j] * win[1][j] + wv[2][j] * win[2][j] + wv[3][j] * cur[j]);
              win[0][j] = win[1][j]; win[1][j] = win[2][j]; win[2][j] = cur[j]; }
          if (c0 < 256) { const int h = c0 >> 6, p0 = c0 & 63; float sc = dts[l * 4 + h]; if (STAGE == 1) sc *= __expf(acs[63 * 4 + h] - acs[l * 4 + h]);
#pragma unroll
              for (int j = 0; j < 8; ++j) XT[(h * 64 + p0 + j) * 72 + l] = f2bf(o[j] * sc); }
          else if (c0 < 384) { const int g = (c0 - 256) >> 6, n0 = (c0 - 256) & 63;
              if (STAGE == 1) {
#pragma unroll
                  for (int j = 0; j < 8; ++j) BT[(g * 64 + n0 + j) * 72 + l] = f2bf(o[j]); }
              else { u32x4 w; w.x = pk2(o[0], o[1]); w.y = pk2(o[2], o[3]); w.z = pk2(o[4], o[5]); w.w = pk2(o[6], o[7]); *(LAS u32x4*)(Bg + (g * 64 + l) * 72 + n0) = w; } }
          else if (STAGE == 2) { const int g = (c0 - 384) >> 6, n0 = (c0 - 384) & 63;
              u32x4 w; w.x = pk2(o[0], o[1]); w.y = pk2(o[2], o[3]); w.z = pk2(o[4], o[5]); w.w = pk2(o[6], o[7]); *(LAS u32x4*)(Cg + (g * 64 + l) * 72 + n0) = w; } } } }
    __syncthreads();
    const int g4 = F.lane >> 4, r16 = F.lane & 15;
    if (STAGE == 1) {
        float* MST = (float*)(F.ws + WS_MST) + ((size_t)(b * 64 + c) * 4) * 4096;
#pragma unroll
        for (int q = 0; q < 8; ++q) { const int tix = F.wave * 8 + q, h = tix >> 4, mt = (tix >> 2) & 3, nt = tix & 3;
            f32x4 acc = (f32x4){0.f, 0.f, 0.f, 0.f};
            acc = mma_nt<64>(XT + (h * 64 + mt * 16) * 72, 72, BT + ((h >> 1) * 64 + nt * 16) * 72, 72, acc, F.lane);
#pragma unroll
            for (int i = 0; i < 4; ++i) MST[(size_t)h * 4096 + (mt * 16 + 4 * g4 + i) * 64 + nt * 16 + r16] = acc[i]; }
        if (F.tid < 4) ((float*)(F.ws + WS_MDEC))[(b * 64 + c) * 4 + F.tid] = __expf(acs[63 * 4 + F.tid]);
    } else {
        const int mt = F.wave & 3, nh = F.wave >> 2;
        const float* MST = (const float*)(F.ws + WS_MST) + ((size_t)(b * 64 + c) * 4) * 4096;
        f32x4 G[2], yv[4][2];
#pragma unroll
        for (int h = 0; h < 4; ++h) {
            const int g = h >> 1;
            { const float* src = MST + (size_t)h * 4096 + F.tid * 8; const f32x4 a = *(const f32x4*)src, bq = *(const f32x4*)(src + 4);
              u32x4 w; w.x = pk2(a[0], a[1]); w.y = pk2(a[2], a[3]); w.z = pk2(bq[0], bq[1]); w.w = pk2(bq[2], bq[3]);
              *(LAS u32x4*)(S0 + (F.tid >> 3) * 72 + (F.tid & 7) * 8) = w; }
            if ((h & 1) == 0) {
#pragma unroll
                for (int q = 0; q < 2; ++q) { G[q] = (f32x4){0.f, 0.f, 0.f, 0.f};
                    G[q] = mma_nt<64>(Cg + (g * 64 + mt * 16) * 72, 72, Bg + (g * 64 + (2 * nh + q) * 16) * 72, 72, G[q], F.lane); } }
#pragma unroll
            for (int q = 0; q < 2; ++q) { const int s = (2 * nh + q) * 16 + r16; const float as = acs[s * 4 + h];
#pragma unroll
                for (int i = 0; i < 4; ++i) { const int l = mt * 16 + 4 * g4 + i; const float v = (s <= l) ? G[q][i] * __expf(acs[l * 4 + h] - as) : 0.f;
                    Mb[l * 72 + s] = f2bf(v); } }
            __syncthreads();
#pragma unroll
            for (int q = 0; q < 2; ++q) { const int nt = 2 * nh + q;
                f32x4 yd = (f32x4){0.f, 0.f, 0.f, 0.f}, yo = (f32x4){0.f, 0.f, 0.f, 0.f};
                yd = mma_nt<64>(Mb + mt * 16 * 72, 72, XT + (h * 64 + nt * 16) * 72, 72, yd, F.lane);
                yo = mma_nt<64>(Cg + (g * 64 + mt * 16) * 72, 72, S0 + nt * 16 * 72, 72, yo, F.lane);
                const int p = nt * 16 + r16; const float dsk = F.in[I_MD][layer * 4 + h];
#pragma unroll
                for (int i = 0; i < 4; ++i) { const int l = mt * 16 + 4 * g4 + i;
                    const float xs = bf2f(XT[(h * 64 + p) * 72 + l]) / dts[l * 4 + h];
                    yv[h][q][i] = yd[i] + yo[i] * __expf(acs[l * 4 + h]) + dsk * xs; } }
            __syncthreads();
        }
        float part[4] = {0.f, 0.f, 0.f, 0.f};
#pragma unroll
        for (int h = 0; h < 4; ++h)
#pragma unroll
            for (int q = 0; q < 2; ++q) { const int ch = h * 64 + (2 * nh + q) * 16 + r16;
#pragma unroll
                for (int i = 0; i < 4; ++i) { const int l = mt * 16 + 4 * g4 + i; const float z = bf2f(U[(T0 + l) * NINP + UM + ch]);
                    const float v = yv[h][q][i] * siluf_(z); yv[h][q][i] = v; part[i] += v * v; } }
#pragma unroll
        for (int i = 0; i < 4; ++i) { const float s = sum16(part[i]); if (r16 == 0) atomicAdd((float*)(rs + mt * 16 + 4 * g4 + i), s); }
        __syncthreads();
        bf16_t* Y = (bf16_t*)(F.ws + WS_H);
#pragma unroll
        for (int i = 0; i < 4; ++i) { const int l = mt * 16 + 4 * g4 + i; const float rstd = rsqrtf(rs[l] * (1.0f / 256.0f) + 1e-6f);
#pragma unroll
            for (int h = 0; h < 4; ++h)
#pragma unroll
                for (int q = 0; q < 2; ++q) { const int ch = h * 64 + (2 * nh + q) * 16 + r16;
                    Y[(T0 + l) * DM + ch] = f2bf(yv[h][q][i] * rstd * F.in[I_MNORM][layer * 256 + ch]); } }
    }
}
__device__ __forceinline__ void item_mamba_carry(const Frame& F_, int item) { Frame F = relocal(F_);
    const int b = item >> 2, h = item & 3;
    float* MST = (float*)(F.ws + WS_MST); const float* MD = (const float*)(F.ws + WS_MDEC);
    float s[8];
#pragma unroll
    for (int j = 0; j < 8; ++j) s[j] = 0.f;
    for (int c = 0; c < 64; ++c) { float* p = MST + ((size_t)(b * 64 + c) * 4 + h) * 4096 + F.tid * 8; const float d = MD[(b * 64 + c) * 4 + h];
        const f32x4 a = *(f32x4*)p, q = *(f32x4*)(p + 4);
        *(f32x4*)p = (f32x4){s[0], s[1], s[2], s[3]}; *(f32x4*)(p + 4) = (f32x4){s[4], s[5], s[6], s[7]};
        s[0] = s[0] * d + a[0]; s[1] = s[1] * d + a[1]; s[2] = s[2] * d + a[2]; s[3] = s[3] * d + a[3];
        s[4] = s[4] * d + q[0]; s[5] = s[5] * d + q[1]; s[6] = s[6] * d + q[2]; s[7] = s[7] * d + q[3]; }
}

template <int STAGE> __device__ __forceinline__ void item_s5(const Frame& F_, int layer, int item) { Frame F = relocal(F_);
    const bf16_t* U = (const bf16_t*)(F.ws + WS_U);
    const int b = item >> 6, c = item & 63; const size_t T0 = (size_t)b * SEQ + c * 64;
    LAS bf16_t* us = (LAS bf16_t*)F.lds;
    LAS bf16_t* BuW = (LAS bf16_t*)(F.lds + 33792) + F.wave * 4224;
    const float* tab = (const float*)(F.ws + WS_S5TAB + (size_t)layer * S5TAB_L);
    { const int tok = F.tid >> 3, part = F.tid & 7;
#pragma unroll
      for (int q = 0; q < 4; ++q) *(LAS u32x4*)(us + tok * 264 + 32 * part + 8 * q) = *(const u32x4*)(U + (T0 + tok) * NINP + US + 32 * part + 8 * q); }
    const int lane = F.lane, r16 = lane & 15, g4 = lane >> 4, gq = lane >> 5, n0 = lane & 31, g = 2 * F.wave + gq, gn0 = g * 64 + n0, gn1 = gn0 + 32;
    bf16x8 bfr[2][8];
    { const bf16_t* bbt = (const bf16_t*)(F.ws + WS_S5TAB + (size_t)layer * S5TAB_L + S5TAB_BBT);
#pragma unroll
      for (int gg = 0; gg < 2; ++gg)
#pragma unroll
          for (int nt = 0; nt < 8; ++nt) { u32x4 z = (u32x4){0u, 0u, 0u, 0u}; if (g4 < 2) z = *(const u32x4*)(bbt + ((size_t)(2 * F.wave + gg) * 128 + 16 * nt + r16) * 16 + 8 * g4); bfr[gg][nt] = __builtin_bit_cast(bf16x8, z); } }
    const float a0r = tab[gn0 * 2], a0i = tab[gn0 * 2 + 1], a1r = tab[gn1 * 2], a1i = tab[gn1 * 2 + 1];
    float* ST = (float*)(F.ws + WS_S5ST) + (size_t)(b * 64 + c) * 2048;
    float h0r = 0.f, h0i = 0.f, h1r = 0.f, h1i = 0.f;
    if (STAGE == 2) { h0r = ST[gn0 * 2]; h0i = ST[gn0 * 2 + 1]; h1r = ST[gn1 * 2]; h1i = ST[gn1 * 2 + 1]; }
    bf16x8 cf[2][4];
    if (STAGE == 2) { const bf16_t* cm = (const bf16_t*)(F.ws + WS_S5TAB + (size_t)layer * S5TAB_L + S5TAB_F);
#pragma unroll
        for (int gg = 0; gg < 2; ++gg)
#pragma unroll
            for (int ks = 0; ks < 4; ++ks) cf[gg][ks] = *(const bf16x8*)(cm + ((size_t)((2 * F.wave + gg) * 16 + r16)) * 128 + 32 * ks + 8 * g4); }
    __syncthreads();
#pragma unroll 1
    for (int lb = 0; lb < 4; ++lb) {
#pragma unroll
        for (int gg = 0; gg < 2; ++gg) { u32x4 z = (u32x4){0u, 0u, 0u, 0u}; if (g4 < 2) z = *(const LAS u32x4*)(us + (16 * lb + r16) * 264 + (2 * F.wave + gg) * 16 + 8 * g4);
            const bf16x8 afr = __builtin_bit_cast(bf16x8, z);
#pragma unroll
            for (int nt = 0; nt < 8; ++nt) { const f32x4 acc = __builtin_amdgcn_mfma_f32_16x16x32_bf16(afr, bfr[gg][nt], (f32x4){0.f, 0.f, 0.f, 0.f}, 0, 0, 0);
#pragma unroll
                for (int i = 0; i < 4; ++i) BuW[(4 * g4 + i) * 264 + gg * 128 + 16 * nt + r16] = f2bf(acc[i]); } }
        __syncthreads();
#pragma unroll 4
        for (int li = 0; li < 16; ++li) { LAS u32x2* bp = (LAS u32x2*)(BuW + li * 264 + gq * 128 + 4 * n0); const u32x2 v = *bp;
            { const float br = __uint_as_float(v.x << 16), bi = __uint_as_float(v.x & 0xffff0000u); const float nr = a0r * h0r - a0i * h0i + br, ni = a0r * h0i + a0i * h0r + bi; h0r = nr; h0i = ni; }
            { const float br = __uint_as_float(v.y << 16), bi = __uint_as_float(v.y & 0xffff0000u); const float nr = a1r * h1r - a1i * h1i + br, ni = a1r * h1i + a1i * h1r + bi; h1r = nr; h1i = ni; }
            if (STAGE == 2) *bp = (u32x2){pk2(h0r, h0i), pk2(h1r, h1i)}; }
        __syncthreads();
        if (STAGE == 2) {
            bf16_t* YS = (bf16_t*)(F.ws + WS_MOE + YSG_OFF);
#pragma unroll
            for (int gg = 0; gg < 2; ++gg) { f32x4 acc = (f32x4){0.f, 0.f, 0.f, 0.f};
#pragma unroll
                for (int ks = 0; ks < 4; ++ks) { const bf16x8 a = *(const LAS bf16x8*)(BuW + r16 * 264 + gg * 128 + 32 * ks + 8 * g4);
                    acc = __builtin_amdgcn_mfma_f32_16x16x32_bf16(a, cf[gg][ks], acc, 0, 0, 0); }
                const int ch = (2 * F.wave + gg) * 16 + r16; const float dsk = F.in[I_SD][layer * 256 + ch];
#pragma unroll
                for (int i = 0; i < 4; ++i) { const int l = lb * 16 + 4 * g4 + i; const float y = acc[i] + dsk * bf2f(us[l * 264 + ch]);
                    YS[(T0 + l) * 256 + ch] = f2bf(gelu_tanh(y)); } }
            __syncthreads();
        }
    }
    if (STAGE == 1) { ST[gn0 * 2] = h0r; ST[gn0 * 2 + 1] = h0i; ST[gn1 * 2] = h1r; ST[gn1 * 2 + 1] = h1i; }
    if (STAGE == 2) {
        asm volatile("s_waitcnt vmcnt(0)" ::: "memory"); __syncthreads();
        const bf16_t* YS = (const bf16_t*)(F.ws + WS_MOE + YSG_OFF) + T0 * 256; const bf16_t* GW = (const bf16_t*)(F.ws + WS_GLU) + (size_t)layer * 512 * 256;
        const int r16 = F.lane & 15, g4 = F.lane >> 4;
        f32x4 av[4][2], ag[4][2];
#pragma unroll
        for (int m = 0; m < 4; ++m)
#pragma unroll
            for (int q = 0; q < 2; ++q) { av[m][q] = (f32x4){0.f, 0.f, 0.f, 0.f}; ag[m][q] = (f32x4){0.f, 0.f, 0.f, 0.f}; }
#pragma unroll 2
        for (int ks = 0; ks < 8; ++ks) {
            bf16x8 af[4], bv[2], bg[2];
#pragma unroll
            for (int m = 0; m < 4; ++m) af[m] = *(const bf16x8*)(YS + (size_t)(16 * m + r16) * 256 + 32 * ks + 8 * g4);
#pragma unroll
            for (int q = 0; q < 2; ++q) { const int c = 32 * F.wave + 16 * q + r16; const int rowv = 256 * (c >> 7) + (c & 127);
                bv[q] = *(const bf16x8*)(GW + (size_t)rowv * 256 + 32 * ks + 8 * g4); bg[q] = *(const bf16x8*)(GW + (size_t)(rowv + 128) * 256 + 32 * ks + 8 * g4); }
#pragma unroll
            for (int m = 0; m < 4; ++m)
#pragma unroll
                for (int q = 0; q < 2; ++q) { av[m][q] = __builtin_amdgcn_mfma_f32_16x16x32_bf16(af[m], bv[q], av[m][q], 0, 0, 0); ag[m][q] = __builtin_amdgcn_mfma_f32_16x16x32_bf16(af[m], bg[q], ag[m][q], 0, 0, 0); }
        }
        bf16_t* Y = (bf16_t*)(F.ws + WS_H);
#pragma unroll
        for (int q = 0; q < 2; ++q) { const int c = 32 * F.wave + 16 * q + r16; const float bvl = F.in[I_SGLUB][layer * 512 + c], bgt = F.in[I_SGLUB][layer * 512 + 256 + c];
#pragma unroll
            for (int m = 0; m < 4; ++m)
#pragma unroll
                for (int i = 0; i < 4; ++i) Y[(T0 + 16 * m + 4 * g4 + i) * DM + 768 + c] = f2bf((av[m][q][i] + bvl) * sigmoidf_(ag[m][q][i] + bgt)); }
    }
}
__device__ __forceinline__ void item_s5_carry(const Frame& F_, int layer, int b) { Frame F = relocal(F_);
    const float* tab = (const float*)(F.ws + WS_S5TAB + (size_t)layer * S5TAB_L) + 2048;
    float* ST = (float*)(F.ws + WS_S5ST) + (size_t)b * 64 * 2048;
#pragma unroll
    for (int q = 0; q < 2; ++q) { const int gn = F.tid + 512 * q; const float pr = tab[gn * 2], pi = tab[gn * 2 + 1]; float hr = 0.f, hi = 0.f;
        for (int c = 0; c < 64; ++c) { float* p = ST + (size_t)c * 2048 + gn * 2; const float tr = p[0], ti = p[1]; p[0] = hr; p[1] = hi;
            const float nr = pr * hr - pi * hi + tr, ni = pr * hi + pi * hr + ti; hr = nr; hi = ni; } }
}

constexpr int RB_LD = 72;
constexpr int RW_R = 0, RW_K = 16384, RW_V = 32768, RW_W = 49152, RW_A = 65536, RW_B = 81920;
constexpr int R3_G = 49152, R3_O = 65536, R3_TILES = 81920, R3_BON = 147456;
template <int STAGE> __device__ __forceinline__ void rwkv_prep(const Frame& F_, int layer, int b, int h, int c) { Frame F = relocal(F_);
    const bf16_t* U = (const bf16_t*)(F.ws + WS_U);
    const int l0 = c * 64; const size_t T0 = (size_t)b * SEQ + l0;
    LAS float* Rr = (LAS float*)(F.lds + RW_R); LAS float* Kk = (LAS float*)(F.lds + RW_K); LAS float* Vv = (LAS float*)(F.lds + RW_V); LAS float* Ww = (LAS float*)(F.lds + RW_W);
    LAS float* Aa = (LAS float*)(F.lds + (STAGE == 1 ? RW_A : R3_O)); LAS float* Bb = (LAS float*)(F.lds + RW_B); LAS float* Gg = (LAS float*)(F.lds + R3_G); LAS float* BON = (LAS float*)(F.lds + R3_BON);
    LAS bf16_t* TWb = (LAS bf16_t*)(F.lds + 98304); LAS bf16_t* DAb = (LAS bf16_t*)(F.lds + (STAGE == 1 ? 103424 : 118784)); LAS bf16_t* SGb = (LAS bf16_t*)(F.lds + 123904);
    LAS bf16_t* w2T = (LAS bf16_t*)(F.lds + 108544); LAS bf16_t* a2T = (LAS bf16_t*)(F.lds + (STAGE == 1 ? 113664 : 133120)); LAS bf16_t* g2T = (LAS bf16_t*)(F.lds + 138240);
    const float* mu = F.in[I_RMU] + layer * 896;
    { const int tok = F.tid >> 3, p8 = F.tid & 7; const bool first = (l0 + tok == 0);
      const bf16_t* cur = U + (T0 + tok) * NINP + UR; const bf16_t* prv = first ? cur : cur - NINP;
      const float pz = first ? 0.f : 1.f;
      u32x4 cw[3], pw[3]; u32x2 c1 = (u32x2){0u, 0u}, p1 = (u32x2){0u, 0u}, c2 = (u32x2){0u, 0u}, p2 = (u32x2){0u, 0u}; u32x4 c3 = (u32x4){0u, 0u, 0u, 0u}, p3 = (u32x4){0u, 0u, 0u, 0u};
#pragma unroll
      for (int sec = (STAGE == 1 ? 0 : 2); sec < 3; ++sec) { const int co = sec * 256 + h * 64 + 8 * p8; cw[sec] = *(const u32x4*)(cur + co); pw[sec] = *(const u32x4*)(prv + co); }
      if (STAGE == 1) { c1 = *(const u32x2*)(cur + 768 + 4 * p8); p1 = *(const u32x2*)(prv + 768 + 4 * p8); c2 = *(const u32x2*)(cur + 800 + 4 * p8); p2 = *(const u32x2*)(prv + 800 + 4 * p8); }
      if (STAGE == 3) { c3 = *(const u32x4*)(cur + 832 + 8 * p8); p3 = *(const u32x4*)(prv + 832 + 8 * p8); }
#pragma unroll
      for (int sec = (STAGE == 1 ? 0 : 2); sec < 3; ++sec) { const int co = sec * 256 + h * 64 + 8 * p8; float av[8], pq[8]; unpack8(cw[sec], av); unpack8(pw[sec], pq);
          const f32x4 m0 = *(const f32x4*)(mu + co), m1 = *(const f32x4*)(mu + co + 4);
          LAS float* dst = (sec == 0 ? Rr : sec == 1 ? Kk : Vv) + tok * 64 + 8 * p8;
#pragma unroll
          for (int j = 0; j < 8; ++j) pq[j] *= pz;
          *(LAS f32x4*)dst = (f32x4){av[0] + m0[0] * (pq[0] - av[0]), av[1] + m0[1] * (pq[1] - av[1]), av[2] + m0[2] * (pq[2] - av[2]), av[3] + m0[3] * (pq[3] - av[3])};
          *(LAS f32x4*)(dst + 4) = (f32x4){av[4] + m1[0] * (pq[4] - av[4]), av[5] + m1[1] * (pq[5] - av[5]), av[6] + m1[2] * (pq[6] - av[6]), av[7] + m1[3] * (pq[7] - av[7])}; }
      if (STAGE == 1) {
#pragma unroll
        for (int which = 0; which < 2; ++which) { const int co = 768 + 32 * which + 4 * p8; const u32x2 cv = which ? c2 : c1, pv = which ? p2 : p1;
          const f32x4 m0 = *(const f32x4*)(mu + co);
          float x[4] = {__uint_as_float(cv.x << 16), __uint_as_float(cv.x & 0xffff0000u), __uint_as_float(cv.y << 16), __uint_as_float(cv.y & 0xffff0000u)};
          const float y[4] = {pz * __uint_as_float(pv.x << 16), pz * __uint_as_float(pv.x & 0xffff0000u), pz * __uint_as_float(pv.y << 16), pz * __uint_as_float(pv.y & 0xffff0000u)};
#pragma unroll
          for (int j = 0; j < 4; ++j) { x[j] = x[j] + m0[j] * (y[j] - x[j]); if (which == 0) x[j] = tanhf_(x[j]); }
          *(LAS u32x2*)((which ? DAb : TWb) + tok * 40 + 4 * p8) = (u32x2){pk2(x[0], x[1]), pk2(x[2], x[3])}; } }
      if (STAGE == 3) { const int co = 832 + 8 * p8; float av[8], pq[8]; unpack8(c3, av); unpack8(p3, pq);
          const f32x4 m0 = *(const f32x4*)(mu + co), m1 = *(const f32x4*)(mu + co + 4); float x[8];
#pragma unroll
          for (int j = 0; j < 8; ++j) x[j] = sigmoidf_(av[j] + (j < 4 ? m0[j] : m1[j - 4]) * (pz * pq[j] - av[j]));
          *(LAS u32x4*)(SGb + tok * RB_LD + 8 * p8) = (u32x4){pk2(x[0], x[1]), pk2(x[2], x[3]), pk2(x[4], x[5]), pk2(x[6], x[7])}; } }
    { const int ch = F.tid & 63, part = F.tid >> 6;
      if (STAGE == 1) { const float* w2 = F.in[I_RW2] + ((size_t)layer * 32 + 4 * part) * 256 + h * 64 + ch;
          *(LAS u32x2*)(w2T + ch * 40 + 4 * part) = (u32x2){pk2(w2[0], w2[256]), pk2(w2[512], w2[768])}; }
      if (STAGE == 1) { const float* a2 = F.in[I_RA2] + ((size_t)layer * 32 + 4 * part) * 256 + h * 64 + ch;
          *(LAS u32x2*)(a2T + ch * 40 + 4 * part) = (u32x2){pk2(a2[0], a2[256]), pk2(a2[512], a2[768])}; }
      if (STAGE == 3) { const float* g2 = F.in[I_RG2] + ((size_t)layer * 64 + 8 * part) * 256 + h * 64 + ch;
          *(LAS u32x4*)(g2T + ch * RB_LD + 8 * part) = (u32x4){pk2(g2[0], g2[256]), pk2(g2[512], g2[768]), pk2(g2[1024], g2[1280]), pk2(g2[1536], g2[1792])}; } }
    __syncthreads();
    { const int lane = F.lane, mt = F.wave >> 1, nt0 = 2 * (F.wave & 1), r = lane & 15, g4 = lane >> 4; const f32x4 zero4 = (f32x4){0.f, 0.f, 0.f, 0.f};
#pragma unroll
      for (int q = 0; q < 2; ++q) { const int nt = nt0 + q, ch = 16 * nt + r, cg = layer * 256 + h * 64 + ch;
          if (STAGE == 1) { const f32x4 wl = mma_nt<32>(TWb + 16 * mt * 40, 40, w2T + 16 * nt * 40, 40, zero4, lane); const float w0 = F.in[I_RW0][cg];
#pragma unroll
              for (int i = 0; i < 4; ++i) { const float x = w0 + wl[i]; const float wlog = -__logf(1.0f + __expf(-x)) - 0.5f; Ww[(16 * mt + 4 * g4 + i) * 64 + ch] = __expf(-__expf(wlog)); } }
          if (STAGE == 1) { const f32x4 al = mma_nt<32>(DAb + 16 * mt * 40, 40, a2T + 16 * nt * 40, 40, zero4, lane); const float a0 = F.in[I_RA0][cg];
#pragma unroll
              for (int i = 0; i < 4; ++i) Aa[(16 * mt + 4 * g4 + i) * 64 + ch] = sigmoidf_(a0 + al[i]); }
          if (STAGE == 3) { const f32x4 gv = mma_nt<64>(SGb + 16 * mt * RB_LD, RB_LD, g2T + 16 * nt * RB_LD, RB_LD, zero4, lane);
#pragma unroll
              for (int i = 0; i < 4; ++i) Gg[(16 * mt + 4 * g4 + i) * 64 + ch] = gv[i]; } } }
    __syncthreads();
    float* gBON = (float*)(F.ws + WS_BON) + ((size_t)(b * 4 + h) * 64 + c) * 64;
    if (STAGE == 1) { const int j = F.lane, tq = F.wave, cg = layer * 256 + h * 64 + j;
      const float kkw = F.in[I_RKK][cg], kaw = F.in[I_RKA][cg], rk = F.in[I_RRK][cg];
#pragma unroll 2
      for (int i8 = 0; i8 < 8; ++i8) { const int t = tq + 8 * i8;
          const float a = Aa[t * 64 + j]; const float kraw = Kk[t * 64 + j]; const float kp = kraw * (1.0f + (a - 1.0f) * kaw);
          Kk[t * 64 + j] = kp;
          const float kkv = kraw * kkw; const float ss = wave_sum(kkv * kkv); const float kkn = kkv * rsqrtf(fmaxf(ss, 1e-24f)); Aa[t * 64 + j] = -kkn; Bb[t * 64 + j] = kkn * a;
          const float bo = wave_sum(Rr[t * 64 + j] * kp * rk); if (j == 0) gBON[t] = bo; } }
    else if (F.tid < 64) BON[F.tid] = gBON[F.tid];
    __syncthreads();
}
constexpr int RB_AT = 98304, RB_ATT = RB_AT + 9216, RB_BT = RB_ATT + 9216, RB_BTT = RB_BT + 9216, RB_KT = RB_BTT + 9216, RB_RT = RB_KT + 9216, RB_VT = RB_RT + 9216, RB_GC = RB_VT + 9216;
constexpr int RX_X = 0, RX_XT = 9216, RX_TB = 18432, RX_M = 27648, RX_NRT = 36864, RX_G1T = 46080, RX_G2T = 55296, RX_QT = 64512;
__device__ __forceinline__ void st_tile(LAS bf16_t* dst, int mt, int nt, const f32x4 v, int lane) {
    const int r = lane & 15, g = lane >> 4;
#pragma unroll
    for (int i = 0; i < 4; ++i) dst[(16 * mt + 4 * g + i) * RB_LD + 16 * nt + r] = f2bf(v[i]);
}
__device__ __forceinline__ void st_tile_t(LAS bf16_t* dst, int mt, int nt, const f32x4 v, int lane) {
    const int r = lane & 15, g = lane >> 4; u32x2 w; w.x = pk2(v[0], v[1]); w.y = pk2(v[2], v[3]);
    *(LAS u32x2*)(dst + (16 * nt + r) * RB_LD + 16 * mt + 4 * g) = w;
}
__device__ __forceinline__ void item_rwkv1(const Frame& F_, int layer, int item) { Frame F = relocal(F_);
    const int b = item >> 8, h = (item >> 6) & 3, c = item & 63;
    rwkv_prep<1>(F, layer, b, h, c);
    LAS float* Rr = (LAS float*)(F.lds + RW_R); LAS float* Kk = (LAS float*)(F.lds + RW_K); LAS float* Vv = (LAS float*)(F.lds + RW_V); LAS float* Ww = (LAS float*)(F.lds + RW_W);
    LAS float* Aa = (LAS float*)(F.lds + RW_A); LAS float* Bb = (LAS float*)(F.lds + RW_B);
    LAS bf16_t* At = (LAS bf16_t*)(F.lds + RB_AT); LAS bf16_t* AtT = (LAS bf16_t*)(F.lds + RB_ATT); LAS bf16_t* Bt = (LAS bf16_t*)(F.lds + RB_BT); LAS bf16_t* BtT = (LAS bf16_t*)(F.lds + RB_BTT);
    LAS bf16_t* Kt = (LAS bf16_t*)(F.lds + RB_KT); LAS bf16_t* Rt = (LAS bf16_t*)(F.lds + RB_RT); LAS bf16_t* VT = (LAS bf16_t*)(F.lds + RB_VT); LAS float* gC = (LAS float*)(F.lds + RB_GC);
    LAS bf16_t* X = (LAS bf16_t*)(F.lds + RX_X); LAS bf16_t* XT = (LAS bf16_t*)(F.lds + RX_XT); LAS bf16_t* Tb = (LAS bf16_t*)(F.lds + RX_TB); LAS bf16_t* Mm = (LAS bf16_t*)(F.lds + RX_M);
    LAS bf16_t* NrT = (LAS bf16_t*)(F.lds + RX_NRT); LAS bf16_t* G1T = (LAS bf16_t*)(F.lds + RX_G1T); LAS bf16_t* G2T = (LAS bf16_t*)(F.lds + RX_G2T); LAS bf16_t* QT = (LAS bf16_t*)(F.lds + RX_QT);
    { const int k = F.tid & 63, part = F.tid >> 6; float g = 1.0f;
      for (int pp = 0; pp < part; ++pp) { float w8[8];
#pragma unroll
          for (int i = 0; i < 8; ++i) w8[i] = Ww[(8 * pp + i) * 64 + k];
          g *= ((w8[0] * w8[1]) * (w8[2] * w8[3])) * ((w8[4] * w8[5]) * (w8[6] * w8[7])); }
#pragma unroll
      for (int i = 0; i < 8; ++i) { const int t = 8 * part + i; const float gp = g; g *= Ww[t * 64 + k]; const float ig = 1.0f / g;
          const bf16_t av = f2bf(Aa[t * 64 + k] * gp), bv = f2bf(Bb[t * 64 + k] * ig);
          At[t * RB_LD + k] = av; AtT[k * RB_LD + t] = av; Bt[t * RB_LD + k] = bv; BtT[k * RB_LD + t] = bv;
          Kt[t * RB_LD + k] = f2bf(Kk[t * 64 + k] * ig); Rt[t * RB_LD + k] = f2bf(Rr[t * 64 + k] * g); VT[k * RB_LD + t] = f2bf(Vv[t * 64 + k]); }
      if (part == 7) gC[k] = g; }
    __syncthreads();
    const int lane = F.lane, mt = F.wave >> 1, nt0 = 2 * (F.wave & 1), r = lane & 15, g4 = lane >> 4;
    const f32x4 zero4 = (f32x4){0.f, 0.f, 0.f, 0.f};
    f32x4 Tacc[2];
#pragma unroll
    for (int q = 0; q < 2; ++q) { const int nt = nt0 + q;
        f32x4 n = mma_nt<64>(Bt + 16 * mt * RB_LD, RB_LD, At + 16 * nt * RB_LD, RB_LD, zero4, lane);
        f32x4 m = mma_nt<64>(Kt + 16 * mt * RB_LD, RB_LD, At + 16 * nt * RB_LD, RB_LD, zero4, lane);
        f32x4 nr = mma_nt<64>(Rt + 16 * mt * RB_LD, RB_LD, Bt + 16 * nt * RB_LD, RB_LD, zero4, lane);
#pragma unroll
        for (int i = 0; i < 4; ++i) { const int row = 16 * mt + 4 * g4 + i, col = 16 * nt + r;
            n[i] = (row < col) ? n[i] : 0.f; m[i] = (row < col) ? m[i] : 0.f; nr[i] = (col <= row) ? nr[i] : 0.f;
            Tacc[q][i] = n[i] + (row == col ? 1.0f : 0.f); }
        st_tile(X, mt, nt, n, lane); st_tile_t(XT, mt, nt, n, lane); st_tile(Tb, mt, nt, Tacc[q], lane); st_tile(Mm, mt, nt, m, lane); st_tile(NrT, mt, nt, nr, lane); }
    __syncthreads();
#pragma unroll 1
    for (int it = 0; it < 6; ++it) {
        LAS bf16_t* Xr = (it & 1) ? G1T : X; LAS bf16_t* XTr = (it & 1) ? G2T : XT; LAS bf16_t* Tr = (it & 1) ? QT : Tb;
        LAS bf16_t* Xw = (it & 1) ? X : G1T; LAS bf16_t* XTw = (it & 1) ? XT : G2T; LAS bf16_t* Tw = (it & 1) ? Tb : QT;
#pragma unroll
        for (int q = 0; q < 2; ++q) { const int nt = nt0 + q;
            if (it > 0) Tacc[q] = mma_nt<64>(Tr + 16 * mt * RB_LD, RB_LD, XTr + 16 * nt * RB_LD, RB_LD, Tacc[q], lane);
            if (it < 5) { const f32x4 x2 = mma_nt<64>(Xr + 16 * mt * RB_LD, RB_LD, XTr + 16 * nt * RB_LD, RB_LD, zero4, lane); st_tile(Xw, mt, nt, x2, lane); st_tile_t(XTw, mt, nt, x2, lane); }
            st_tile(Tw, mt, nt, Tacc[q], lane); }
        __syncthreads();
    }
#pragma unroll
    for (int q = 0; q < 2; ++q) { const int nt = nt0 + q;
        st_tile(G1T, mt, nt, mma_nt<64>(NrT + 16 * mt * RB_LD, RB_LD, Tb + 16 * nt * RB_LD, RB_LD, zero4, lane), lane);
        st_tile(G2T, mt, nt, mma_nt<64>(BtT + 16 * mt * RB_LD, RB_LD, Tb + 16 * nt * RB_LD, RB_LD, zero4, lane), lane); }
    __syncthreads();
    const size_t ci = (size_t)(b * 4 + h) * 64 + c;
    bf16_t* gPT = (bf16_t*)(F.ws + WS_MOE + RW_PT) + ci * 4096; bf16_t* gW1 = (bf16_t*)(F.ws + WS_MOE + RW_W1) + ci * 4096; bf16_t* gZ = (bf16_t*)(F.ws + WS_MOE + RW_Z) + ci * 4096;
#pragma unroll
    for (int q = 0; q < 2; ++q) { const int nt = nt0 + q; const int col = 16 * nt + r;
        f32x4 w1 = mma_nt<64>(G1T + 16 * mt * RB_LD, RB_LD, AtT + 16 * nt * RB_LD, RB_LD, zero4, lane);
        f32x4 z = mma_nt<64>(G1T + 16 * mt * RB_LD, RB_LD, Mm + 16 * nt * RB_LD, RB_LD, zero4, lane);
        f32x4 mr = mma_nt<64>(Rt + 16 * mt * RB_LD, RB_LD, Kt + 16 * nt * RB_LD, RB_LD, zero4, lane);
        f32x4 p = mma_nt<64>(G2T + 16 * mt * RB_LD, RB_LD, AtT + 16 * nt * RB_LD, RB_LD, zero4, lane);
        f32x4 qq = mma_nt<64>(G2T + 16 * mt * RB_LD, RB_LD, Mm + 16 * nt * RB_LD, RB_LD, zero4, lane);
        const int pos = 32 * (col >> 5) + 8 * ((col >> 2) & 3) + 4 * ((col >> 4) & 1) + (col & 3);
#pragma unroll
        for (int i = 0; i < 4; ++i) { const int row = 16 * mt + 4 * g4 + i;
            gW1[row * 64 + col] = f2bf(w1[i] + bf2f(Rt[row * RB_LD + col]));
            gZ[row * 64 + col] = f2bf(z[i] + (col <= row ? mr[i] : 0.f));
            const float gc = gC[row];
            gPT[row * 64 + pos] = f2bf((p[i] + (row == col ? 1.0f : 0.f)) * gc);
            qq[i] = (qq[i] + bf2f(Kt[col * RB_LD + row])) * gc; }
        st_tile(QT, mt, nt, qq, lane); }
    __syncthreads();
    bf16_t* gU = (bf16_t*)(F.ws + WS_MOE + RW_U) + ci * 4096;
#pragma unroll
    for (int q = 0; q < 2; ++q) { const int nt = nt0 + q;
        const f32x4 u = mma_nt<64>(VT + 16 * mt * RB_LD, RB_LD, QT + 16 * nt * RB_LD, RB_LD, zero4, lane);
#pragma unroll
        for (int i = 0; i < 4; ++i) gU[(16 * mt + 4 * g4 + i) * 64 + 16 * nt + r] = f2bf(u[i]); }
}
__device__ __forceinline__ void item_rwkv_carry(const Frame& F_, int item) { Frame F = relocal(F_);
    const int bh = item * 2 + (F.wave >> 2), nt = F.wave & 3, r = F.lane & 15, g = F.lane >> 4;
    const bf16_t* PT = (const bf16_t*)(F.ws + WS_MOE + RW_PT); const bf16_t* Uc = (const bf16_t*)(F.ws + WS_MOE + RW_U); bf16_t* Ss = (bf16_t*)(F.ws + WS_MOE + RW_S);
    f32x4 acc[4];
#pragma unroll
    for (int m = 0; m < 4; ++m) acc[m] = (f32x4){0.f, 0.f, 0.f, 0.f};
    for (int c = 0; c < 64; ++c) { const size_t ci = (size_t)bh * 64 + c;
        bf16x8 af[4][2]; f32x4 cin[4];
#pragma unroll
        for (int m = 0; m < 4; ++m) { const u32x2 uv = *(const u32x2*)(Uc + ci * 4096 + (16 * nt + r) * 64 + 16 * m + 4 * g);
            cin[m] = (f32x4){__uint_as_float(uv.x << 16), __uint_as_float(uv.x & 0xffff0000u), __uint_as_float(uv.y << 16), __uint_as_float(uv.y & 0xffff0000u)};
#pragma unroll
            for (int s = 0; s < 2; ++s) af[m][s] = *(const bf16x8*)(PT + ci * 4096 + (16 * m + r) * 64 + 32 * s + 8 * g); }
        unsigned pw[4][2];
#pragma unroll
        for (int m = 0; m < 4; ++m) { pw[m][0] = pk2(acc[m][0], acc[m][1]); pw[m][1] = pk2(acc[m][2], acc[m][3]);
            *(u32x2*)(Ss + ci * 4096 + (16 * nt + r) * 64 + 16 * m + 4 * g) = (u32x2){pw[m][0], pw[m][1]}; }
        bf16x8 bfr[2];
#pragma unroll
        for (int s = 0; s < 2; ++s) bfr[s] = __builtin_bit_cast(bf16x8, (u32x4){pw[2 * s][0], pw[2 * s][1], pw[2 * s + 1][0], pw[2 * s + 1][1]});
#pragma unroll
        for (int m = 0; m < 4; ++m) { acc[m] = __builtin_amdgcn_mfma_f32_16x16x32_bf16(af[m][0], bfr[0], cin[m], 0, 0, 0);
            acc[m] = __builtin_amdgcn_mfma_f32_16x16x32_bf16(af[m][1], bfr[1], acc[m], 0, 0, 0); }
    }
}
__device__ __forceinline__ void item_rwkv3(const Frame& F_, int layer, int item) { Frame F = relocal(F_);
    const int b = item >> 8, h = (item >> 6) & 3, c = item & 63; const size_t T0 = (size_t)b * SEQ + c * 64;
    rwkv_prep<3>(F, layer, b, h, c);
    LAS float* Vv = (LAS float*)(F.lds + RW_V); LAS float* Oo = (LAS float*)(F.lds + R3_O);
    LAS float* Gg = (LAS float*)(F.lds + R3_G); LAS float* BON = (LAS float*)(F.lds + R3_BON);
    LAS bf16_t* S0b = (LAS bf16_t*)(F.lds + R3_TILES); LAS bf16_t* W1b = S0b + 4608; LAS bf16_t* Zb = W1b + 4608; LAS bf16_t* VTb = Zb + 4608;
    { const size_t ci = (size_t)(b * 4 + h) * 64 + c; const int row = F.tid >> 3, col = (F.tid & 7) * 8;
      *(LAS u32x4*)(S0b + row * RB_LD + col) = *(const u32x4*)((const bf16_t*)(F.ws + WS_MOE + RW_S) + ci * 4096 + F.tid * 8);
      *(LAS u32x4*)(W1b + row * RB_LD + col) = *(const u32x4*)((const bf16_t*)(F.ws + WS_MOE + RW_W1) + ci * 4096 + F.tid * 8);
      *(LAS u32x4*)(Zb + row * RB_LD + col) = *(const u32x4*)((const bf16_t*)(F.ws + WS_MOE + RW_Z) + ci * 4096 + F.tid * 8);
      const int vv = F.tid & 63, part = F.tid >> 6;
#pragma unroll
      for (int i = 0; i < 8; ++i) { const int t = 8 * part + i; VTb[vv * RB_LD + t] = f2bf(Vv[t * 64 + vv]); } }
    __syncthreads();
    { const int lane = F.lane, mt = F.wave >> 1, nt0 = 2 * (F.wave & 1), r = lane & 15, g4 = lane >> 4;
#pragma unroll
      for (int q = 0; q < 2; ++q) { const int nt = nt0 + q;
          f32x4 o = mma_nt<64>(W1b + 16 * mt * RB_LD, RB_LD, S0b + 16 * nt * RB_LD, RB_LD, (f32x4){0.f, 0.f, 0.f, 0.f}, lane);
          o = mma_nt<64>(Zb + 16 * mt * RB_LD, RB_LD, VTb + 16 * nt * RB_LD, RB_LD, o, lane);
#pragma unroll
          for (int i = 0; i < 4; ++i) Oo[(16 * mt + 4 * g4 + i) * 64 + 16 * nt + r] = o[i]; } }
    __syncthreads();
    { const int j = F.lane, tq = F.wave, ch = h * 64 + j;
      const float lw = F.in[I_RLNW][layer * 256 + ch], lb = F.in[I_RLNB][layer * 256 + ch];
      bf16_t* Y = (bf16_t*)(F.ws + WS_H);
#pragma unroll 2
      for (int i8 = 0; i8 < 8; ++i8) { const int t = tq + 8 * i8;
          const float o = Oo[t * 64 + j]; const float mean = wave_sum(o) * (1.0f / 64.0f); const float d = o - mean; const float var = wave_sum(d * d) * (1.0f / 64.0f);
          float on = d * rsqrtf(var + 64e-5f) * lw + lb; on += BON[t] * Vv[t * 64 + j];
          Y[(T0 + t) * DM + 256 + ch] = f2bf(on * Gg[t * 64 + j]); } }
}

constexpr int DS_SEL = 131072, DS_HIST = 135168, DS_BKT = 151552, DS_BIAS = 152064;
__device__ __forceinline__ void dsa_tables(const Frame& F_) { Frame F = relocal(F_);
    LAS int* bkt = (LAS int*)(F.lds + DS_BKT); LAS float* biasT = (LAS float*)(F.lds + DS_BIAS);
    if (F.tid < 128) { const int n = F.tid; int bk = n; if (n >= 16) { const float lr = logf((float)n / 16.0f) / 2.0794415416798357f; bk = 16 + (int)(lr * 16.0f); bk = bk < 31 ? bk : 31; } bkt[n] = bk; biasT[n] = F.in[I_RELB][n]; }
    __syncthreads();
}
__device__ __forceinline__ unsigned fkey(float f) { const unsigned u = __float_as_uint(f); return (u & 0x80000000u) ? ~u : (u | 0x80000000u); }
__device__ __forceinline__ void item_dsa(const Frame& F_, int layer, int item) { Frame F = relocal(F_);
    const bf16_t* U = (const bf16_t*)(F.ws + WS_U); const bf16_t* KI = (const bf16_t*)(F.ws + WS_KIDX);
    const bf16_t* Kb = (const bf16_t*)(F.ws + WS_K); const bf16_t* Vb = (const bf16_t*)(F.ws + WS_V);
    const int b = item & 3, qg = 511 - (item >> 2); const size_t TB = (size_t)b * SEQ, T0 = TB + qg * 8;
    LAS float* sc = (LAS float*)F.lds; LAS unsigned short* selall = (LAS unsigned short*)(F.lds + DS_SEL); LAS unsigned* histall = (LAS unsigned*)(F.lds + DS_HIST);
    LAS int* bkt = (LAS int*)(F.lds + DS_BKT); LAS float* biasT = (LAS float*)(F.lds + DS_BIAS);
    const int lane = F.lane, hh = lane >> 5;
    {
        bf16x8 af[2][2]; float wq[2][2][8];
        { const int r = lane & 31, q4 = 2 * ((r >> 2) & 1) + (r >> 4), head = 4 * ((r >> 3) & 1) + (r & 3);
#pragma unroll
          for (int mt = 0; mt < 2; ++mt)
#pragma unroll
              for (int ks = 0; ks < 2; ++ks) af[mt][ks] = *(const bf16x8*)(U + (T0 + 4 * mt + q4) * NINP + UC + 384 + head * 32 + 16 * ks + 8 * hh); }
#pragma unroll
        for (int mt = 0; mt < 2; ++mt)
#pragma unroll
            for (int q2 = 0; q2 < 2; ++q2) { float f[8]; unpack8(*(const u32x4*)(U + (T0 + 4 * mt + 2 * hh + q2) * NINP + UC + 672), f);
#pragma unroll
                for (int hd = 0; hd < 8; ++hd) wq[mt][q2][hd] = f[hd]; }
        const int ntile = (qg * 8 + 8 + 31) >> 5;
        bf16x8 nb0 = af[0][0], nb1 = af[0][0];
        if (F.wave < ntile) { const int key = F.wave * 32 + (lane & 31); nb0 = *(const bf16x8*)(KI + (TB + key) * 32 + 8 * hh); nb1 = *(const bf16x8*)(KI + (TB + key) * 32 + 16 + 8 * hh); }
        for (int kt = F.wave; kt < ntile; kt += 8) {
            const int key = kt * 32 + (lane & 31);
            const bf16x8 b0 = nb0, b1 = nb1;
            if (kt + 8 < ntile) { const int k2 = key + 256; nb0 = *(const bf16x8*)(KI + (TB + k2) * 32 + 8 * hh); nb1 = *(const bf16x8*)(KI + (TB + k2) * 32 + 16 + 8 * hh); }
#pragma unroll
            for (int mt = 0; mt < 2; ++mt) { f32x16 acc;
#pragma unroll
                for (int i = 0; i < 16; ++i) acc[i] = 0.f;
                acc = __builtin_amdgcn_mfma_f32_32x32x16_bf16(af[mt][0], b0, acc, 0, 0, 0);
                acc = __builtin_amdgcn_mfma_f32_32x32x16_bf16(af[mt][1], b1, acc, 0, 0, 0);
#pragma unroll
                for (int q2 = 0; q2 < 2; ++q2) { float s = 0.f;
#pragma unroll
                    for (int hd = 0; hd < 8; ++hd) s += fmaxf(acc[8 * q2 + hd], 0.f) * wq[mt][q2][hd];
                    const int qi = 4 * mt + 2 * hh + q2;
                    sc[qi * 4096 + key] = (key <= qg * 8 + qi) ? s : -INFINITY; } }
        }
    }
    __syncthreads();
    const int qi = F.wave, tq = qg * 8 + qi, n = tq + 1;
    LAS float* scq = sc + qi * 4096; LAS unsigned short* sel = selall + qi * 256; LAS unsigned* hist = histall + qi * 512;
    int nsel;
    if (n <= 256) { nsel = n; for (int j = lane; j < 256; j += 64) sel[j] = (unsigned short)(j < n ? j : 0); }
    else {
        nsel = 256;
        const int R = (n + 63) >> 6; const unsigned long long ltm = (1ull << lane) - 1ull;
        float lo = INFINITY, hi = -INFINITY;
        const int R4 = (n + 255) >> 8;
#pragma unroll 4
        for (int i = 0; i < R4; ++i) { const int j0 = 256 * i + 4 * lane; const f32x4 v4 = *(const LAS f32x4*)(scq + j0);
#pragma unroll
            for (int q = 0; q < 4; ++q) { const bool valid = j0 + q < n; lo = fminf(lo, valid ? v4[q] : INFINITY); hi = fmaxf(hi, valid ? v4[q] : -INFINITY); } }
#pragma unroll
        for (int o = 1; o < 64; o <<= 1) { lo = fminf(lo, shx(lo, o)); hi = fmaxf(hi, shx(hi, o)); }
        bool slow = false;
        if (!(hi > lo)) { for (int j = lane; j < 256; j += 64) sel[j] = (unsigned short)j; }
        else {
            const float scale = 1023.0f / (hi - lo);
            *(LAS u32x4*)(hist + 8 * lane) = (u32x4){0u, 0u, 0u, 0u}; *(LAS u32x4*)(hist + 8 * lane + 4) = (u32x4){0u, 0u, 0u, 0u};
#pragma unroll 2
            for (int i = 0; i < R4; ++i) { const int j0 = 256 * i + 4 * lane; const f32x4 v4 = *(const LAS f32x4*)(scq + j0);
#pragma unroll
                for (int q = 0; q < 4; ++q) { if (j0 + q < n) { int bk = (int)((v4[q] - lo) * scale); bk = bk < 1023 ? bk : 1023;
                    atomicAdd((unsigned*)(hist + (bk >> 1)), (bk & 1) ? 65536u : 1u); } } }
            const u32x4 h0 = *(const LAS u32x4*)(hist + 8 * lane), h1 = *(const LAS u32x4*)(hist + 8 * lane + 4);
            unsigned cb[16];
            cb[0] = h0.x & 0xffffu; cb[1] = h0.x >> 16; cb[2] = h0.y & 0xffffu; cb[3] = h0.y >> 16; cb[4] = h0.z & 0xffffu; cb[5] = h0.z >> 16; cb[6] = h0.w & 0xffffu; cb[7] = h0.w >> 16;
            cb[8] = h1.x & 0xffffu; cb[9] = h1.x >> 16; cb[10] = h1.y & 0xffffu; cb[11] = h1.y >> 16; cb[12] = h1.z & 0xffffu; cb[13] = h1.z >> 16; cb[14] = h1.w & 0xffffu; cb[15] = h1.w >> 16;
            unsigned tot = 0u;
#pragma unroll
            for (int q = 0; q < 16; ++q) tot += cb[q];
            unsigned incl = tot;
#pragma unroll
            for (int o = 1; o < 64; o <<= 1) { const unsigned t = shdown_u(incl, o); if (lane + o < 64) incl += t; }
            int fb = -1; unsigned fabove = 0u, fcnt = 0u; unsigned cum = incl - tot;
#pragma unroll
            for (int q = 15; q >= 0; --q) { if (fb < 0 && cum < 256u && 256u <= cum + cb[q]) { fb = 16 * lane + q; fabove = cum; fcnt = cb[q]; } cum += cb[q]; }
            const unsigned long long mf = __ballot(fb >= 0); const int src = (int)__ffsll((long long)mf) - 1;
            const int B = shidx_i(fb, src); const int above = shidx_i((int)fabove, src), cntB = shidx_i((int)fcnt, src); const int need = 256 - above;
            if (cntB > 256) slow = true;
            else {
                LAS unsigned* cand = hist;
                int base_gt = 0, base_c = 0;
#pragma unroll 2
                for (int i = 0; i < R4; ++i) { const int j0 = 256 * i + 4 * lane; const f32x4 v4 = *(const LAS f32x4*)(scq + j0);
#pragma unroll
                    for (int q = 0; q < 4; ++q) { const int j = j0 + q; const bool valid = j < n; const float v = valid ? v4[q] : lo;
                        int bk = (int)((v - lo) * scale); bk = bk < 1023 ? bk : 1023;
                        const bool gt = valid && bk > B, eq = valid && bk == B;
                        const unsigned long long mg = __ballot(gt), me = __ballot(eq);
                        if (gt) sel[base_gt + __popcll(mg & ltm)] = (unsigned short)j;
                        if (eq) { const int p = base_c + __popcll(me & ltm); cand[2 * p] = fkey(v); cand[2 * p + 1] = (unsigned)j; }
                        base_gt += __popcll(mg); base_c += __popcll(me); } }
                if (need == cntB) { for (int c = lane; c < cntB; c += 64) sel[above + c] = (unsigned short)cand[2 * c + 1]; }
                else {
                    unsigned ck[4], cx[4]; int rk[4];
#pragma unroll
                    for (int q = 0; q < 4; ++q) { const int c = lane + 64 * q; ck[q] = c < cntB ? cand[2 * c] : 0u; cx[q] = c < cntB ? cand[2 * c + 1] : 0u; rk[q] = 0; }
                    for (int c2 = 0; c2 < cntB; ++c2) { const unsigned k2 = cand[2 * c2], x2 = cand[2 * c2 + 1];
#pragma unroll
                        for (int q = 0; q < 4; ++q) rk[q] += (k2 > ck[q] || (k2 == ck[q] && x2 < cx[q])) ? 1 : 0; }
#pragma unroll
                    for (int q = 0; q < 4; ++q) { const int c = lane + 64 * q; if (c < cntB && rk[q] < need) sel[above + rk[q]] = (unsigned short)cand[2 * c + 1]; }
                }
            }
        }
        if (slow) {
        unsigned prefix = 0u; int need = 256; unsigned neq = 0u;
        for (int p = 0; p < 4; ++p) { const int shift = 24 - 8 * p;
            *(LAS u32x4*)(hist + 4 * lane) = (u32x4){0u, 0u, 0u, 0u};
            for (int i = 0; i < R; ++i) { const int j = lane + 64 * i; if (j < n) { const unsigned u = fkey(scq[j]);
                if (p == 0 || (u >> (shift + 8)) == prefix) atomicAdd((unsigned*)(hist + ((u >> shift) & 255u)), 1u); } }
            const u32x4 hv = *(const LAS u32x4*)(hist + 4 * lane);
            const unsigned tot = hv.x + hv.y + hv.z + hv.w;
            unsigned incl = tot;
#pragma unroll
            for (int o = 1; o < 64; o <<= 1) { const unsigned t = shdown_u(incl, o); if (lane + o < 64) incl += t; }
            const unsigned above = incl - tot;
            int fb = -1; unsigned fabove = 0u, feq = 0u; unsigned cum = above;
            { const unsigned hq[4] = {hv.x, hv.y, hv.z, hv.w};
#pragma unroll
              for (int q = 3; q >= 0; --q) { if (fb < 0 && cum < (unsigned)need && (unsigned)need <= cum + hq[q]) { fb = 4 * lane + q; fabove = cum; feq = hq[q]; } cum += hq[q]; } }
            const unsigned long long m = __ballot(fb >= 0);
            const int src = (int)__ffsll((long long)m) - 1;
            const int bin = shidx_i(fb, src); const unsigned ab = (unsigned)shidx_i((int)fabove, src); neq = (unsigned)shidx_i((int)feq, src);
            need -= (int)ab; prefix = (prefix << 8) | (unsigned)bin;
        }
        const int ngt = 256 - need;
        int base_gt = 0, base_eq = 0;
        for (int i = 0; i < R; ++i) { const int j = lane + 64 * i; const unsigned u = (j < n) ? fkey(scq[j]) : 0u;
            const bool gt = (j < n) && (u > prefix), eq = (j < n) && (u == prefix);
            const unsigned long long mg = __ballot(gt), me = __ballot(eq); const unsigned long long lt = (1ull << lane) - 1ull;
            if (gt) sel[base_gt + __popcll(mg & lt)] = (unsigned short)j;
            if (eq) { const int rk = base_eq + __popcll(me & lt); if (rk < need) sel[ngt + rk] = (unsigned short)j; }
            base_gt += __popcll(mg); base_eq += __popcll(me); }
        (void)neq;
            }
    }
    const int nt16 = (nsel + 15) >> 4, r16 = lane & 15, g4 = lane >> 4;
    LAS float* biasj = scq + 2048;
#pragma unroll
    for (int q = 0; q < 4; ++q) { const int j = lane + 64 * q; f32x4 bv = (f32x4){-INFINITY, -INFINITY, -INFINITY, -INFINITY};
        if (j < nsel) { const int dist = tq - (int)sel[j]; const int bk = dist < 128 ? bkt[dist < 0 ? 0 : dist] : 31; bv = *(const LAS f32x4*)(biasT + 4 * bk); }
        *(LAS f32x4*)(biasj + 4 * j) = bv; }
    bf16x8 qf[2];
#pragma unroll
    for (int s = 0; s < 2; ++s) { u32x4 z = (u32x4){0u, 0u, 0u, 0u}; if (r16 < 4) z = *(const u32x4*)(U + (T0 + qi) * NINP + UC + r16 * 64 + 32 * s + 8 * g4); qf[s] = __builtin_bit_cast(bf16x8, z); }
    float lg[16][4]; float mx = -INFINITY;
#define DSA_QK(M0, NM) do { int keyr[NM]; bf16x8 a0[NM], a1[NM]; \
        _Pragma("unroll") for (int m8 = 0; m8 < NM; ++m8) keyr[m8] = sel[16 * ((M0) + m8) + r16]; \
        _Pragma("unroll") for (int m8 = 0; m8 < NM; ++m8) { a0[m8] = *(const bf16x8*)(Kb + (TB + keyr[m8]) * 64 + 8 * g4); a1[m8] = *(const bf16x8*)(Kb + (TB + keyr[m8]) * 64 + 32 + 8 * g4); } \
        _Pragma("unroll") for (int m8 = 0; m8 < NM; ++m8) { const int m = (M0) + m8; \
            f32x4 acc = (f32x4){0.f, 0.f, 0.f, 0.f}; \
            acc = __builtin_amdgcn_mfma_f32_16x16x32_bf16(a0[m8], qf[0], acc, 0, 0, 0); \
            acc = __builtin_amdgcn_mfma_f32_16x16x32_bf16(a1[m8], qf[1], acc, 0, 0, 0); \
            _Pragma("unroll") for (int i = 0; i < 4; ++i) { const float v = acc[i] * 0.125f + biasj[(16 * m + 4 * g4 + i) * 4 + (r16 & 3)]; lg[m][i] = v; mx = fmaxf(mx, v); } } } while (0)
    if (nt16 > 8) { DSA_QK(0, 16); }
    else { DSA_QK(0, 8);
#pragma unroll
        for (int m8 = 8; m8 < 16; ++m8)
#pragma unroll
            for (int i = 0; i < 4; ++i) lg[m8][i] = -INFINITY; }
#undef DSA_QK
    mx = fmaxf(mx, shx(mx, 16)); mx = fmaxf(mx, shx(mx, 32));
    float sm = 0.f;
#pragma unroll
    for (int m = 0; m < 16; ++m)
#pragma unroll
        for (int i = 0; i < 4; ++i) { const float p = __expf(lg[m][i] - mx); lg[m][i] = p; sm += p; }
    sm += shx(sm, 16); sm += shx(sm, 32);
    f32x4 ov[4];
#pragma unroll
    for (int nt = 0; nt < 4; ++nt) ov[nt] = (f32x4){0.f, 0.f, 0.f, 0.f};
    const unsigned vs_base = (unsigned)(unsigned long)scq;
#pragma unroll
    for (int half = 0; half < 2; ++half) {
        if (half * 8 < nt16) {
            asm volatile("s_waitcnt lgkmcnt(0)" ::: "memory");
            int vkey[16];
#pragma unroll
            for (int q = 0; q < 16; ++q) { const int rho = 8 * q + (lane >> 3);
                vkey[q] = sel[half * 128 + (rho & ~31) + 16 * ((rho >> 2) & 1) + 4 * ((rho >> 3) & 3) + (rho & 3)]; }
            asm volatile("s_waitcnt lgkmcnt(0)" : "+v"(vkey[0]), "+v"(vkey[1]), "+v"(vkey[2]), "+v"(vkey[3]), "+v"(vkey[4]), "+v"(vkey[5]), "+v"(vkey[6]), "+v"(vkey[7]),
                         "+v"(vkey[8]), "+v"(vkey[9]), "+v"(vkey[10]), "+v"(vkey[11]), "+v"(vkey[12]), "+v"(vkey[13]), "+v"(vkey[14]), "+v"(vkey[15]) :: "memory");
#pragma unroll
            for (int q = 0; q < 16; ++q)
                __builtin_amdgcn_global_load_lds((const unsigned*)(Vb + (TB + vkey[q]) * 64 + 8 * (lane & 7)), (LAS unsigned*)((LAS unsigned char*)scq + q * 1024), 16, 0, 0);
            asm volatile("s_waitcnt vmcnt(0)" ::: "memory");
#pragma unroll
            for (int s4 = 0; s4 < 4; ++s4) { const int s = half * 4 + s4;
                u32x4 pw; pw.x = pk2(lg[2 * s][0], lg[2 * s][1]); pw.y = pk2(lg[2 * s][2], lg[2 * s][3]); pw.z = pk2(lg[2 * s + 1][0], lg[2 * s + 1][1]); pw.w = pk2(lg[2 * s + 1][2], lg[2 * s + 1][3]);
                const bf16x8 pa = __builtin_bit_cast(bf16x8, pw);
                const unsigned ad = vs_base + (unsigned)((32 * s4 + 8 * g4 + (r16 >> 2)) * 128 + (r16 & 3) * 8);
                u32x2 t0[4], t1[4];
                asm volatile("ds_read_b64_tr_b16 %0, %8\n\tds_read_b64_tr_b16 %1, %8 offset:512\n\tds_read_b64_tr_b16 %2, %8 offset:32\n\tds_read_b64_tr_b16 %3, %8 offset:544\n\t"
                             "ds_read_b64_tr_b16 %4, %8 offset:64\n\tds_read_b64_tr_b16 %5, %8 offset:576\n\tds_read_b64_tr_b16 %6, %8 offset:96\n\tds_read_b64_tr_b16 %7, %8 offset:608\n\ts_waitcnt lgkmcnt(0)"
                             : "=&v"(t0[0]), "=&v"(t1[0]), "=&v"(t0[1]), "=&v"(t1[1]), "=&v"(t0[2]), "=&v"(t1[2]), "=&v"(t0[3]), "=&v"(t1[3]) : "v"(ad) : "memory");
#pragma unroll
                for (int nt = 0; nt < 4; ++nt) { const bf16x8 vb = __builtin_bit_cast(bf16x8, (u32x4){t0[nt].x, t0[nt].y, t1[nt].x, t1[nt].y});
                    ov[nt] = __builtin_amdgcn_mfma_f32_16x16x32_bf16(pa, vb, ov[nt], 0, 0, 0); } }
        }
    }
    { float inv[4];
#pragma unroll
      for (int h = 0; h < 4; ++h) inv[h] = 1.0f / __int_as_float(__builtin_amdgcn_readlane(__float_as_int(sm), h));
      if (lane < 16) { bf16_t* Y = (bf16_t*)(F.ws + WS_H) + (T0 + qi) * DM + 512 + r16;
#pragma unroll
          for (int h = 0; h < 4; ++h)
#pragma unroll
              for (int nt = 0; nt < 4; ++nt) Y[h * 64 + 16 * nt] = f2bf(ov[nt][h] * inv[h]); } }
}

__device__ __forceinline__ void phase_router(const Frame& F_, int layer) { Frame F = relocal(F_); const int cset = layer;
    const float* X = (const float*)(F.ws + WS_X);
    const bf16_t* WH = (const bf16_t*)(F.ws + WS_WRT) + (size_t)layer * 2 * 49152; const bf16_t* WL = WH + 49152;
    LAS float* part = (LAS float*)F.lds;
    LAS float* ssq = (LAS float*)(F.lds + 24576);
    LAS int* es = (LAS int*)(F.lds + 25088);
    LAS int* lr = (LAS int*)(F.lds + 25600);
    LAS float* wsl = (LAS float*)(F.lds + 26112);
    LAS float* rsd = (LAS float*)(F.lds + 26624);
    for (int blk = F.bid; blk < NTOK / 64; blk += F.G) {
        __syncthreads();
        const int mt = F.wave & 3, kh = F.wave >> 2, r16 = F.lane & 15, g4 = F.lane >> 4;
        const float* xr = X + ((size_t)blk * 64 + mt * 16 + r16) * DM + kh * 512 + 8 * g4;
        f32x4 acc[3]; acc[0] = acc[1] = acc[2] = (f32x4){0.f, 0.f, 0.f, 0.f}; float ss = 0.f;
#pragma unroll 4
        for (int ks = 0; ks < 16; ++ks) {
            const f32x4 xa = *(const f32x4*)(xr + ks * 32), xb = *(const f32x4*)(xr + ks * 32 + 4);
            ss += xa[0] * xa[0] + xa[1] * xa[1] + xa[2] * xa[2] + xa[3] * xa[3] + xb[0] * xb[0] + xb[1] * xb[1] + xb[2] * xb[2] + xb[3] * xb[3];
            float xv[8] = {xa[0], xa[1], xa[2], xa[3], xb[0], xb[1], xb[2], xb[3]}; unsigned hw[4], lw[4];
#pragma unroll
            for (int j = 0; j < 4; ++j) { const bf16_t h0 = f2bf(xv[2 * j]), h1 = f2bf(xv[2 * j + 1]); hw[j] = (unsigned)h0 | ((unsigned)h1 << 16);
                lw[j] = pk2(xv[2 * j] - bf2f(h0), xv[2 * j + 1] - bf2f(h1)); }
            const bf16x8 ahi = __builtin_bit_cast(bf16x8, (u32x4){hw[0], hw[1], hw[2], hw[3]}), alo = __builtin_bit_cast(bf16x8, (u32x4){lw[0], lw[1], lw[2], lw[3]});
#pragma unroll
            for (int nt = 0; nt < 3; ++nt) { const size_t wo = (size_t)(nt * 16 + r16) * 1024 + kh * 512 + ks * 32 + 8 * g4;
                const bf16x8 bh = *(const bf16x8*)(WH + wo), bl = *(const bf16x8*)(WL + wo);
                acc[nt] = __builtin_amdgcn_mfma_f32_16x16x32_bf16(ahi, bh, acc[nt], 0, 0, 0);
                acc[nt] = __builtin_amdgcn_mfma_f32_16x16x32_bf16(ahi, bl, acc[nt], 0, 0, 0);
                acc[nt] = __builtin_amdgcn_mfma_f32_16x16x32_bf16(alo, bh, acc[nt], 0, 0, 0); }
        }
        ss += shx(ss, 16); ss += shx(ss, 32);
        if (g4 == 0) ssq[kh * 64 + mt * 16 + r16] = ss;
#pragma unroll
        for (int nt = 0; nt < 3; ++nt)
#pragma unroll
            for (int i = 0; i < 4; ++i) part[(kh * 64 + mt * 16 + 4 * g4 + i) * 48 + nt * 16 + r16] = acc[nt][i];
        __syncthreads();
        if (F.tid < 64) { const float rstd = rsqrtf((ssq[F.tid] + ssq[64 + F.tid]) * (1.0f / DM) + 1e-6f); rsd[F.tid] = rstd;
            float l[36];
#pragma unroll
            for (int o = 0; o < 36; ++o) l[o] = (part[F.tid * 48 + o] + part[(64 + F.tid) * 48 + o]) * rstd + (o < 32 ? F.in[I_BRE][layer * 32 + o] : F.in[I_BRG][layer * 4 + o - 32]);
            int gs = 0; float gm = l[32];
#pragma unroll
            for (int j = 1; j < 4; ++j) if (l[32 + j] > gm) { gm = l[32 + j]; gs = j; }
            float den = 0.f;
#pragma unroll
            for (int j = 0; j < 4; ++j) den += __expf(l[32 + j] - gm);
            const float gate = 1.0f / den;
            float e8[8];
#pragma unroll
            for (int j = 0; j < 8; ++j) e8[j] = gs == 0 ? l[j] : gs == 1 ? l[8 + j] : gs == 2 ? l[16 + j] : l[24 + j];
            int i1 = 0; float v1 = e8[0];
#pragma unroll
            for (int j = 1; j < 8; ++j) if (e8[j] > v1) { v1 = e8[j]; i1 = j; }
            int i2 = -1; float v2 = -INFINITY;
#pragma unroll
            for (int j = 0; j < 8; ++j) if (j != i1 && e8[j] > v2) { v2 = e8[j]; i2 = j; }
            const float e2 = __expf(v2 - v1); const float p1 = 1.0f / (1.0f + e2);
            es[F.tid * 2] = gs * 8 + i1; es[F.tid * 2 + 1] = gs * 8 + i2; wsl[F.tid * 2] = p1 * gate; wsl[F.tid * 2 + 1] = (1.0f - p1) * gate; }
        __syncthreads();
        if (F.tid < 32) { int cnt = 0; for (int i = 0; i < 128; ++i) if (es[i] == F.tid) lr[i] = cnt++;
            if (cnt) { const int base = (int)__hip_atomic_fetch_add(F.ctl + CW_CNT + cset * 32 + F.tid, (unsigned)cnt, __ATOMIC_RELAXED, __HIP_MEMORY_SCOPE_AGENT);
                for (int i = 0; i < 128; ++i) if (es[i] == F.tid) lr[i] += base; } }
        __syncthreads();
        if (F.tid < 64) { int* rt = (int*)(F.ws + WS_ROUTE) + ((size_t)blk * 64 + F.tid) * 8;
            rt[0] = es[F.tid * 2]; rt[1] = es[F.tid * 2 + 1]; ((float*)rt)[2] = wsl[F.tid * 2]; ((float*)rt)[3] = wsl[F.tid * 2 + 1]; rt[4] = lr[F.tid * 2]; rt[5] = lr[F.tid * 2 + 1]; ((float*)rt)[6] = rsd[F.tid]; }
    }
    __syncthreads();
    if (F.tid == 0) __hip_atomic_fetch_add(F.ctl + CW_RB + 64 * layer, 1u, __ATOMIC_RELAXED, __HIP_MEMORY_SCOPE_AGENT);
}
__device__ __forceinline__ void phase_moe_convert(const Frame& F_, int layer) { Frame F = relocal(F_);
    bf16_t* WGU = (bf16_t*)(F.ws + WS_MOE + MOE_WGU);
    for (int t = F.bid; t < 1024; t += F.G) {
        const int e = t >> 5, r = t & 31, kt = r >> 1, nt = r & 1; const size_t eo = ((size_t)layer * 32 + e) * 1024 * 256;
        tr_tile(F, 256, WGU + (size_t)e * 512 * 1024, 1024, kt * 64, nt * 256, SmGU{F.in[I_WGATE] + eo, F.in[I_WUP] + eo}); }
}
__device__ __forceinline__ void phase_moe_convert_down(const Frame& F_, int layer) { Frame F = relocal(F_);
    bf16_t* WD = (bf16_t*)(F.ws + WS_MOE + MOE_WD);
    for (;;) { const int q = q_pop(F, 32 + layer); if (q >= 512) break;
        const int e = q >> 4, r = q & 15, kt = r >> 2, nt = r & 3;
        tr_tile(F, 1024, WD + (size_t)e * 1024 * 256, 256, kt * 64, nt * 256, SmId{F.in[I_WDOWN] + ((size_t)layer * 32 + e) * 256 * 1024}); }
}
__device__ __forceinline__ void phase_gather(const Frame& F_, int layer) { Frame F = relocal(F_);
    LAS int* off = (LAS int*)F.lds;
    __syncthreads();
    if (F.tid == 0) { unsigned sp = 0;
        while (__hip_atomic_load(F.ctl + CW_RB + 64 * layer, __ATOMIC_RELAXED, __HIP_MEMORY_SCOPE_AGENT) < (unsigned)F.G) { __builtin_amdgcn_s_sleep(2); if (++sp > (1u << 22)) break; } }
    __syncthreads();
    if (F.tid == 0) { int acc = 0; for (int e = 0; e < 32; ++e) { off[e] = acc; const int c = (int)__hip_atomic_load(F.ctl + CW_CNT + layer * 32 + e, __ATOMIC_RELAXED, __HIP_MEMORY_SCOPE_AGENT); acc += (c + 255) & ~255; } off[32] = acc; }
    __syncthreads();
    int* tiles = (int*)(F.ws + WS_TILES); int* row_tok = (int*)(F.ws + WS_ROWS); float* row_w = (float*)(F.ws + WS_ROWS) + MAXROWS;
    if (F.bid == 0) { if (F.tid == 0) tiles[0] = off[32] >> 8; if (F.tid < 33) tiles[1 + F.tid] = off[F.tid];
        if (F.tid < 32) for (int rt = off[F.tid] >> 8; rt < (off[F.tid + 1] >> 8); ++rt) tiles[64 + rt] = F.tid; }
    for (int e = F.bid; e < 32; e += F.G) { const int c = (int)__hip_atomic_load(F.ctl + CW_CNT + layer * 32 + e, __ATOMIC_RELAXED, __HIP_MEMORY_SCOPE_AGENT);
        for (int r = off[e] + c + F.tid; r < off[e + 1]; r += NTHR) { row_tok[r] = -1; row_w[r] = 0.f; } }
    const float* X = (const float*)(F.ws + WS_X); bf16_t* HP = (bf16_t*)(F.ws + WS_U); const float* nw = F.in[I_NORM2] + (size_t)layer * DM;
    f32x4 nwv[4];
#pragma unroll
    for (int j = 0; j < 4; ++j) nwv[j] = *(const f32x4*)(nw + 4 * F.lane + 256 * j);
    for (int blk = F.bid; blk < NTOK / 64; blk += F.G)
    for (int i4 = 0; i4 < 2; ++i4) {
        int p0[4], p1[4], tt[4]; float rstd[4], w0[4], w1[4]; f32x4 xv[4][4];
#pragma unroll
        for (int r = 0; r < 4; ++r) { const int t = blk * 64 + F.wave * 8 + 4 * i4 + r; tt[r] = t;
            const int* rt = (const int*)(F.ws + WS_ROUTE) + (size_t)t * 8; rstd[r] = ((const float*)rt)[6]; w0[r] = ((const float*)rt)[2]; w1[r] = ((const float*)rt)[3];
            p0[r] = off[rt[0]] + rt[4]; p1[r] = off[rt[1]] + rt[5];
#pragma unroll
            for (int j = 0; j < 4; ++j) xv[r][j] = *(const f32x4*)(X + (size_t)t * DM + 4 * F.lane + 256 * j); }
#pragma unroll
        for (int r = 0; r < 4; ++r) {
#pragma unroll
            for (int j = 0; j < 4; ++j) { const int c = 4 * F.lane + 256 * j; const f32x4 v = xv[r][j] * rstd[r] * nwv[j];
                u32x2 o; o.x = pk2(v[0], v[1]); o.y = pk2(v[2], v[3]);
                *(u32x2*)(HP + (size_t)p0[r] * DM + c) = o; *(u32x2*)(HP + (size_t)p1[r] * DM + c) = o; }
            if (F.lane == 0) { row_tok[p0[r]] = tt[r] * 2; row_w[p0[r]] = w0[r]; row_tok[p1[r]] = tt[r] * 2 + 1; row_w[p1[r]] = w1[r]; } }
    }
}

constexpr int NPH_LAYER = 9, NPHASE = 1 + 2 * NPH_LAYER + 1;
#ifndef MK_ONLY
#define MK_ONLY -1
#endif
#ifndef MK_ITEM
#define MK_ITEM -1
#endif
#define EN(o) (MK_ONLY < 0 || MK_ONLY == (o))
#define IT(o) (MK_ITEM < 0 || MK_ITEM == (o))
__global__ void __launch_bounds__(NTHR, 2) mk_forward(Params P) {
    extern __shared__ __attribute__((aligned(16))) unsigned char lds_raw[];
    Frame F; F.lds = (LAS unsigned char*)lds_raw; F.tid = threadIdx.x; F.lane = F.tid & 63; F.wave = __builtin_amdgcn_readfirstlane(F.tid >> 6); F.bid = blockIdx.x; F.G = gridDim.x;
    F.in = (in_tab_t)__builtin_amdgcn_kernarg_segment_ptr(); F.out = P.out; F.ws = P.ws; F.ctl = (unsigned*)(P.ws + WS_CTL); F.misc = (volatile LAS int*)(F.lds + MISC_OFF);
    if (F.tid < 64) ((LAS unsigned*)(F.lds + MISC_OFF))[F.tid] = 0u;
    __syncthreads();
    const int lo = P.ph_lo, hi = P.ph_hi;
    XcdBarrier bar; bar.bar = F.ctl + CW_BAR; bar.x = 0; bar.st = (volatile LAS unsigned*)(F.lds + MISC_OFF + 16);
    if (hi - lo > 1) bar = xcd_barrier_post(F.ctl + CW_BAR, (volatile LAS unsigned*)(F.lds + MISC_OFF + 16));
#define IN(k) (lo <= (k) && (k) < hi)
#define SEAM(k) do { if (IN(k) && IN((k) + 1)) xcd_barrier(bar); } while (0)
#define QLOOP(qi, n, body) for (;;) { const int it = q_pop(F, layer * 12 + (qi)); if (it >= (n)) break; body; }
    if (EN(100) && IN(0)) { phase_prologue(F); phase_norm(F, F.in[I_X], false, F.in[I_NORM1], 0); } SEAM(0);
#pragma unroll
    for (int layer = 0; layer < DEPTH; ++layer) {
        const int pb = 1 + layer * NPH_LAYER;
        if (layer > 0) { if (EN(0) && IN(pb + 0)) { phase_norm(F, (const float*)(F.ws + WS_X), true, F.in[I_NORM1] + (size_t)layer * DM, 0); } SEAM(pb + 0); }
        if (EN(1) && IN(pb + 1)) { const Frame F_ = F; Frame F = relocal(F_); pg8::StaticOrder S; S.init((const bf16_t*)(F.ws + WS_H), (const bf16_t*)(F.ws + WS_WIN) + (size_t)layer * NINP * DM, NTOK, NINP, DM, F.G, F.bid);
            pg8::EpiBf16 E{(bf16_t*)(F.ws + WS_U), NINP}; pg8::gemm_phase(F.lds, DM, S, E); } SEAM(pb + 1);
#define SLOOP(n, body) for (int it = F.bid; it < (n); it += F.G) { __syncthreads(); body; }
        if (EN(2) && IN(pb + 2)) {
            if (IT(1)) SLOOP(1024, item_rwkv1(F, layer, it));
            if (IT(0)) SLOOP(256, item_s5<1>(F, layer, it));
            if (IT(2)) SLOOP(256, item_mamba<1>(F, layer, it));
            if (IT(3)) SLOOP(256, item_kv(F, layer, it));
        } SEAM(pb + 2);
        if (EN(3) && IN(pb + 3)) {
            if (IT(0)) SLOOP(8, item_rwkv_carry(F, it));
            if (IT(1)) { for (int it = F.bid - 8; it >= 0 && it < 16; it += F.G) { __syncthreads(); item_mamba_carry(F, it); } }
            if (IT(2)) { for (int it = F.bid - 24; it >= 0 && it < 4; it += F.G) { __syncthreads(); item_s5_carry(F, layer, it); } }
            if (IT(3)) {
                dsa_tables(F);
                const int pref = (int)(xb_xcc_id() & 3u);
#pragma unroll 1
                for (int k4 = 0; k4 < 4; ++k4) { const int bq = (pref + k4) & 3;
                    for (;;) { const int it = q_pop(F, 24 + layer * 4 + bq); if (it >= 512) break; item_dsa(F, layer, it * 4 + bq); } } }
        } SEAM(pb + 3);
        if (EN(4) && IN(pb + 4)) {
            if (IT(0)) SLOOP(256, item_s5<2>(F, layer, it));
            if (IT(2)) SLOOP(256, item_mamba<2>(F, layer, it));
            if (IT(1)) SLOOP(1024, item_rwkv3(F, layer, it));
        } SEAM(pb + 4);
        if (EN(6) && IN(pb + 5)) { const Frame F_ = F; Frame F = relocal(F_); pg8::StaticOrder S; S.init((const bf16_t*)(F.ws + WS_H), (const bf16_t*)(F.ws + WS_WOUT) + (size_t)layer * DM * DM, NTOK, DM, DM, F.G, F.bid);
            pg8::EpiResid E{(float*)(F.ws + WS_X), DM}; pg8::gemm_phase(F.lds, DM, S, E); } SEAM(pb + 5);
        if (EN(7) && IN(pb + 6)) { phase_router(F, layer); phase_moe_convert(F, layer); phase_gather(F, layer); } SEAM(pb + 6);
        if (EN(8) && IN(pb + 7)) { const Frame F_ = F; Frame F = relocal(F_); LAS int* ul = (LAS int*)(F.lds + pg8::STAGE_BYTES + 8192); if (F.tid == 0) pg8::MoeOrder::build(ul, (const int*)(F.ws + WS_TILES), 2, F.G, F.bid); __syncthreads();
            pg8::MoeOrder S{DM, (const char*)(F.ws + WS_U), (const char*)(F.ws + WS_MOE + MOE_WGU), (size_t)512 * 1024 * 2, ul};
            pg8::EpiGated<1> E{(bf16_t*)(F.ws + WS_H), 256, 0, nullptr, nullptr}; pg8::gemm_phase(F.lds, DM, S, E); phase_moe_convert_down(F, layer); } SEAM(pb + 7);
        if (EN(9) && IN(pb + 8)) { const Frame F_ = F; Frame F = relocal(F_); LAS int* ul = (LAS int*)(F.lds + pg8::STAGE_BYTES + 8192); if (F.tid == 0) pg8::MoeOrder::build(ul, (const int*)(F.ws + WS_TILES), 4, F.G, F.bid); __syncthreads();
            pg8::MoeOrder S{256, (const char*)(F.ws + WS_H), (const char*)(F.ws + WS_MOE + MOE_WD), (size_t)1024 * 256 * 2, ul};
            pg8::EpiMoeOut E{(bf16_t*)(F.ws + WS_U), (const int*)(F.ws + WS_ROWS), (const float*)(F.ws + WS_ROWS) + MAXROWS, F.lds}; pg8::gemm_phase(F.lds, 256, S, E); } SEAM(pb + 8);
    }
    if (EN(101) && IN(NPHASE - 1)) { phase_norm(F, (const float*)(F.ws + WS_X), true, F.in[I_FNORM], 2); }
#undef IN
#undef SEAM
}

#ifndef MK_SPLIT
#define MK_SPLIT 0
#endif
extern "C" void kernel_launch(void* const* d_in, const int* in_sizes, int n_in, void* d_out, int out_size, void* d_ws, size_t ws_size, hipStream_t stream) {
    static int grid = 0;
    if (grid == 0) {
        if (n_in != 44 || out_size != NTOK * DM || ws_size < WS_END) { fprintf(stderr, "kernel_launch: unexpected shapes (n_in %d out %d ws %zu need %zu)\n", n_in, out_size, ws_size, (size_t)WS_END); grid = -1; return; }
        int dev = 0, cus = 0;
        if (hipGetDevice(&dev) != hipSuccess || hipDeviceGetAttribute(&cus, hipDeviceAttributeMultiprocessorCount, dev) != hipSuccess) { grid = -1; return; }
        if (hipFuncSetAttribute((const void*)mk_forward, hipFuncAttributeMaxDynamicSharedMemorySize, LDS_BYTES) != hipSuccess) { fprintf(stderr, "kernel_launch: hipFuncSetAttribute failed\n"); grid = -1; return; }
        int per_cu = 0;
        if (hipOccupancyMaxActiveBlocksPerMultiprocessor(&per_cu, (const void*)mk_forward, NTHR, LDS_BYTES) != hipSuccess || per_cu < 1) { fprintf(stderr, "kernel_launch: occupancy query says %d\n", per_cu); }
        (void)hipGetLastError();
        grid = cus;
    }
    if (grid < 0) return;
    hipMemsetAsync((char*)d_ws + WS_CTL, 0, CTL_BYTES, stream);
    Params p{};
    for (int i = 0; i < 44; ++i) p.in[i] = (const float*)d_in[i];
    p.out = (float*)d_out; p.ws = (unsigned char*)d_ws;
#if MK_SPLIT
    for (int ph = 0; ph < NPHASE; ++ph) { p.ph_lo = ph; p.ph_hi = ph + 1; hipLaunchKernelGGL(mk_forward, dim3(grid), dim3(NTHR), LDS_BYTES, stream, p); }
#else
    p.ph_lo = 0; p.ph_hi = NPHASE; hipLaunchKernelGGL(mk_forward, dim3(grid), dim3(NTHR), LDS_BYTES, stream, p);
#endif
}
```

```cpp
#include <hip/hip_runtime.h>
#include <stdint.h>
#include <stdio.h>

#define LAS __attribute__((address_space(3)))
typedef unsigned short bf16_t;
typedef short bf16x8 __attribute__((ext_vector_type(8)));
typedef float f32x4 __attribute__((ext_vector_type(4)));
typedef float f32x2 __attribute__((ext_vector_type(2)));
typedef float f32x16 __attribute__((ext_vector_type(16)));
typedef unsigned u32x4 __attribute__((ext_vector_type(4)));
typedef unsigned u32x2 __attribute__((ext_vector_type(2)));

constexpr int NTOK = 16384, DM = 1024, SEQ = 4096, NBATCH = 4, DEPTH = 2;
constexpr int NIN = 2604, NINP = 2816;
constexpr int UM = 0;
constexpr int UR = 784;
constexpr int UC = 1680;
constexpr int US = 2368;
constexpr int NTHR = 512;
constexpr int LDS_BYTES = 163840;
constexpr int MISC_OFF = LDS_BYTES - 256;

constexpr size_t WS_CTL   = 0;
constexpr size_t CTL_BYTES = 65536;
constexpr size_t WS_X     = WS_CTL + CTL_BYTES;
constexpr size_t WS_H     = WS_X + (size_t)NTOK * DM * 4;
constexpr size_t WS_U     = WS_H + (size_t)NTOK * DM * 2;
constexpr size_t WS_WIN   = WS_U + (size_t)NTOK * NINP * 2;
constexpr size_t WS_WOUT  = WS_WIN + (size_t)2 * NINP * DM * 2;
constexpr size_t WS_GLU   = WS_WOUT + (size_t)2 * DM * DM * 2;
constexpr size_t WS_MOE   = WS_GLU + (size_t)2 * 512 * 256 * 2;
constexpr size_t MOE_WGU  = 0;
constexpr size_t MOE_WD   = (size_t)32 * 512 * 1024 * 2;
constexpr size_t MOE_BYTES = MOE_WD + (size_t)32 * 1024 * 256 * 2;
constexpr size_t RW_PT    = 0;
constexpr size_t RW_U     = (size_t)1024 * 4096 * 2;
constexpr size_t RW_S     = RW_U + (size_t)1024 * 4096 * 2;
constexpr size_t RW_W1    = RW_S + (size_t)1024 * 4096 * 2;
constexpr size_t RW_Z     = RW_W1 + (size_t)1024 * 4096 * 2;
constexpr size_t YSG_OFF  = RW_Z + (size_t)1024 * 4096 * 2;
static_assert(YSG_OFF + (size_t)NTOK * 256 * 2 <= MOE_BYTES, "alias");
constexpr size_t WS_MST   = WS_MOE + MOE_BYTES;
constexpr size_t WS_MDEC  = WS_MST + (size_t)4 * 64 * 4 * 4096 * 4;
constexpr size_t WS_S5ST  = WS_MDEC + 4096;
constexpr size_t WS_K     = WS_S5ST + (size_t)4 * 64 * 2048 * 4;
constexpr size_t WS_V     = WS_K + (size_t)NTOK * 64 * 2;
constexpr size_t WS_KIDX  = WS_V + (size_t)NTOK * 64 * 2;
constexpr size_t WS_ROUTE = WS_KIDX + (size_t)NTOK * 32 * 2;
constexpr size_t WS_ROWS  = WS_ROUTE + (size_t)NTOK * 32;
constexpr int    MAXROWS  = 49152;
constexpr size_t WS_TILES = WS_ROWS + (size_t)MAXROWS * 8;
constexpr size_t WS_S5TAB = WS_TILES + 4096;
constexpr size_t S5TAB_F  = (size_t)(2048 + 2048 + 32768) * 4;
constexpr size_t S5TAB_BBT = S5TAB_F + (size_t)16 * 16 * 128 * 2;
constexpr size_t S5TAB_L  = S5TAB_BBT + (size_t)16 * 128 * 16 * 2;
constexpr size_t WS_WRT   = WS_S5TAB + 2 * S5TAB_L;
constexpr size_t WS_BON   = WS_WRT + (size_t)2 * 2 * 48 * 1024 * 2;
constexpr size_t WS_END   = WS_BON + (size_t)1024 * 64 * 4;

constexpr int CW_BAR = 0;
constexpr int CW_Q   = 4096;
constexpr int CW_CNT = 8192;
constexpr int CW_RB  = 8448;

__device__ __forceinline__ float bf2f(bf16_t b) { return __uint_as_float(((unsigned)b) << 16); }
__device__ __forceinline__ bf16_t f2bf(float f) { const __bf16 h = (__bf16)f; return __builtin_bit_cast(bf16_t, h); }
__device__ __forceinline__ unsigned pk2(float lo, float hi) { typedef __bf16 bf2_t __attribute__((ext_vector_type(2))); const bf2_t h = __builtin_convertvector((f32x2){lo, hi}, bf2_t); return __builtin_bit_cast(unsigned, h); }
__device__ __forceinline__ unsigned cvt_pk_bf16(float lo, float hi) { unsigned r; asm volatile("v_cvt_pk_bf16_f32 %0, %1, %2" : "=v"(r) : "v"(lo), "v"(hi)); return r; }
__device__ __forceinline__ float sigmoidf_(float x) { return 1.0f / (1.0f + __expf(-x)); }
__device__ __forceinline__ float siluf_(float x) { return x / (1.0f + __expf(-x)); }
__device__ __forceinline__ float tanhf_(float x) { const float e = __expf(2.0f * x); return 1.0f - 2.0f / (e + 1.0f); }
__device__ __forceinline__ float softplusf_(float x) { return fmaxf(x, 0.0f) + log1pf(__expf(-fabsf(x))); }
__device__ __forceinline__ float gelu_tanh(float x) { return 0.5f * x * (1.0f + tanhf_(0.7978845608028654f * (x + 0.044715f * x * x * x))); }
template <int CTRL> __device__ __forceinline__ float dppf(float x) { return __int_as_float(__builtin_amdgcn_update_dpp(0, __float_as_int(x), CTRL, 0xF, 0xF, true)); }
__device__ __forceinline__ float sum4(float x) { x += dppf<0xB1>(x); x += dppf<0x4E>(x); return x; }
__device__ __forceinline__ float sum8(float x) { x = sum4(x); x += dppf<0x141>(x); return x; }
__device__ __forceinline__ float sum16(float x) { x = sum8(x); x += dppf<0x140>(x); return x; }
__device__ __forceinline__ int lane_id_() { int l = (int)__builtin_amdgcn_mbcnt_hi(~0u, __builtin_amdgcn_mbcnt_lo(~0u, 0u)); asm volatile("" : "+v"(l)); return l; }
__device__ __forceinline__ float shx(float x, int o) { return __int_as_float(__builtin_amdgcn_ds_bpermute((lane_id_() ^ o) << 2, __float_as_int(x))); }
__device__ __forceinline__ unsigned shdown_u(unsigned x, int o) { return (unsigned)__builtin_amdgcn_ds_bpermute(((lane_id_() + o) & 63) << 2, (int)x); }
__device__ __forceinline__ int shidx_i(int x, int src) { return __builtin_amdgcn_ds_bpermute(src << 2, x); }
__device__ __forceinline__ float wave_sum(float x) { x = sum16(x); x += shx(x, 16); x += shx(x, 32); return x; }
__device__ __forceinline__ void unpack8(const u32x4 v, float (&f)[8]) {
    f[0] = __uint_as_float(v.x << 16); f[1] = __uint_as_float(v.x & 0xffff0000u); f[2] = __uint_as_float(v.y << 16); f[3] = __uint_as_float(v.y & 0xffff0000u);
    f[4] = __uint_as_float(v.z << 16); f[5] = __uint_as_float(v.z & 0xffff0000u); f[6] = __uint_as_float(v.w << 16); f[7] = __uint_as_float(v.w & 0xffff0000u);
}

#define XB_TMO      128
#define XB_XCNT(j)  (256  + 64 * (j))
#define XB_XSUB(j)  (1280 + 64 * (j))
#define XB_XGEN(j)  (2304 + 64 * (j))
#define XB_TOP      3328
#define XB_TOPGEN   3392
#define XCD_BAR_WORDS 3456
#define XB_SPIN_CAP (1u << 22)
__device__ __forceinline__ unsigned xb_ld(unsigned* p)              { return __hip_atomic_load(p, __ATOMIC_RELAXED, __HIP_MEMORY_SCOPE_AGENT); }
__device__ __forceinline__ unsigned xb_add(unsigned* p, unsigned v) { return __hip_atomic_fetch_add(p, v, __ATOMIC_RELAXED, __HIP_MEMORY_SCOPE_AGENT); }
__device__ __forceinline__ unsigned xb_xcc_id() { return (unsigned)__builtin_amdgcn_s_getreg((3 << 11) | 20) & 0xFu; }
#define XB_SPIN(cond, bar) do { unsigned _sp = 0; while (cond) { __builtin_amdgcn_s_sleep(1); \
    if ((++_sp & 255u) == 0u) { if (xb_ld(&(bar)[XB_TMO])) break; if (_sp > XB_SPIN_CAP) { atomicAdd(&(bar)[XB_TMO], 1u); break; } } } } while (0)
struct XcdBarrier { unsigned* bar; unsigned x; volatile LAS unsigned* st; };
__device__ __forceinline__ XcdBarrier xcd_barrier_post(unsigned* bar, volatile LAS unsigned* st) {
    XcdBarrier b; b.bar = bar; b.x = xb_xcc_id(); b.st = st;
    if (threadIdx.x == 0) (void)xb_add(&bar[XB_XCNT(b.x)], 1u);
    return b;
}
__device__ __forceinline__ void xcd_barrier_complete(unsigned* bar, unsigned x, unsigned& nloc, unsigned& nx) {
    const unsigned G = gridDim.x * gridDim.y * gridDim.z;
    unsigned sum, cnt, mine, sp = 0u;
    for (;;) {
        sum = 0u; cnt = 0u; mine = 0u;
#pragma unroll
        for (unsigned j = 0; j < 16; ++j) { const unsigned c = xb_ld(&bar[XB_XCNT(j)]); sum += c; cnt += (c > 0u) ? 1u : 0u; mine = (j == x) ? c : mine; }
        if (sum == G) break;
        __builtin_amdgcn_s_sleep(1);
        if ((++sp & 255u) == 0u) { if (xb_ld(&bar[XB_TMO])) break; if (sp > XB_SPIN_CAP) { atomicAdd(&bar[XB_TMO], 1u); break; } }
    }
    nloc = mine > 0u ? mine : 1u; nx = cnt > 0u ? cnt : 1u;
}
__device__ __forceinline__ void xcd_barrier(const XcdBarrier& b_) {
    XcdBarrier b = b_; { const unsigned long long v = (unsigned long long)b.bar; unsigned lo = __builtin_amdgcn_readfirstlane((unsigned)v), hi = __builtin_amdgcn_readfirstlane((unsigned)(v >> 32)); asm volatile("" : "+s"(lo), "+s"(hi)); b.bar = (unsigned*)(((unsigned long long)hi << 32) | lo); unsigned xx = __builtin_amdgcn_readfirstlane(b.x); asm volatile("" : "+s"(xx)); b.x = xx; }
    asm volatile("s_waitcnt vmcnt(0)" ::: "memory");
    __syncthreads();
    if (threadIdx.x == 0) {
        unsigned* bar = b.bar;
        __builtin_amdgcn_s_waitcnt(0);
        unsigned nloc = b.st[0], nx = b.st[1];
        if (nloc == 0u) { xcd_barrier_complete(bar, b.x, nloc, nx); b.st[0] = nloc; b.st[1] = nx; }
        const unsigned old = xb_add(&bar[XB_XSUB(b.x)], 1u);
        const unsigned gen = old / nloc;
        if (old + 1u == (gen + 1u) * nloc) {
            __builtin_amdgcn_fence(__ATOMIC_RELEASE, "agent");
            asm volatile("s_waitcnt vmcnt(0)" ::: "memory");
            const unsigned og = xb_add(&bar[XB_TOP], 1u);
            const unsigned tg = og / nx;
            if (og + 1u == (tg + 1u) * nx) xb_add(&bar[XB_TOPGEN], 1u);
            else XB_SPIN(xb_ld(&bar[XB_TOPGEN]) == tg, bar);
            __builtin_amdgcn_fence(__ATOMIC_ACQUIRE, "agent");
            xb_add(&bar[XB_XGEN(b.x)], 1u);
            asm volatile("s_waitcnt vmcnt(0)" ::: "memory");
        } else {
            XB_SPIN(xb_ld(&bar[XB_XGEN(b.x)]) == gen, bar);
            __builtin_amdgcn_fence(__ATOMIC_ACQUIRE, "agent");
            asm volatile("s_waitcnt vmcnt(0)" ::: "memory");
        }
    }
    __syncthreads();
}

namespace pg8 {
constexpr int BM = 256, BK = 64, HALF = 128, HTB = HALF * BK * 2, STAGE_BYTES = 8 * HTB, NXCD = 8, WGM = 8;
__host__ __device__ __forceinline__ int lds_byte(int r, int c) { const int st = (r >> 4) * 2 + (c >> 5), rr = r & 15, cc = c & 31, ob = rr * 64 + cc * 2; return st * 1024 + (ob ^ (((ob >> 9) & 1) << 5)); }
__host__ __device__ __forceinline__ void stage_rc(int b, int& R, int& C) { const int st = b / 1024, sb = b % 1024, swz = sb ^ (((sb >> 9) & 1) << 5); R = (st >> 1) * 16 + swz / 64; C = (st & 1) * 32 + (swz % 64) / 2; }
__host__ __device__ __forceinline__ int perm32(int rho) { const int n = rho >> 4, i = rho & 15; return 8 * (i >> 2) + 4 * n + (i & 3); }
struct Unit { int pm, pn; const char* a; const char* b; };

struct StaticOrder {
    int nM, nN, nwg, G, c, K; const char* A; const char* B;
    __device__ void init(const bf16_t* A_, const bf16_t* B_, int M, int N, int K_, int G_, int c_) { A = (const char*)A_; B = (const char*)B_; K = K_; nM = M / BM; nN = N / BM; nwg = nM * nN; G = G_; c = c_; }
    __device__ bool next(int i, Unit& u) const {
        const long L = (long)i * G + c; if (L >= nwg) return false;
        int wgid = (int)L; { const int q = nwg / NXCD, r = nwg % NXCD, xcd = wgid % NXCD, off = wgid / NXCD; wgid = (xcd < r ? xcd * (q + 1) : r * (q + 1) + (xcd - r) * q) + off; }
        const int nig = WGM * nN, gid = wgid / nig, fm = gid * WGM, gsz = (nM - fm) < WGM ? (nM - fm) : WGM;
        u.pm = fm + ((wgid % nig) % gsz); u.pn = (wgid % nig) / gsz;
        u.a = A + (size_t)u.pm * 256 * K * 2; u.b = B + (size_t)u.pn * 256 * K * 2; return true;
    }
};

template <class Epi, class Sched>
__device__ __forceinline__ void gemm_phase(LAS unsigned char* lds, const int K_, const Sched& S, const Epi& E) {
    int K = K_; asm volatile("" : "+s"(K));
    int tid_ = threadIdx.x; asm volatile("" : "+v"(tid_));
    const int tid = tid_, wid = __builtin_amdgcn_readfirstlane(tid >> 6), lane = tid & 63, wr = wid >> 2, wc = wid & 3, fr = lane & 15, fq = lane >> 4;
    const int nt = K / BK;
    unsigned voffA[2], voffB[2];
#pragma unroll
    for (int i = 0; i < 2; ++i) { int R, C; stage_rc(tid * 16 + i * 8192, R, C); const int Rb = Epi::PERM ? ((R & ~31) + perm32(R & 31)) : R;
        voffA[i] = (unsigned)(R * K + C) * 2u; voffB[i] = (unsigned)(Rb * K + C) * 2u; }
    const size_t kstep = (size_t)(BK * 2);
    const size_t hstep = (size_t)HALF * K * 2;
    const unsigned ldsw = (unsigned)wid * 1024u;
    const int aoff = lds_byte(wr * 64 + fr, fq * 8), boff = lds_byte(wc * 32 + fr, fq * 8);
#define PG8_SA(b, h) (((b) * 2 + (h)) * HTB)
#define PG8_SB(b, h) ((4 + (b) * 2 + (h)) * HTB)
#define PG8_STAGE(bufoff, gbase, voff) do { _Pragma("unroll") for (int _i = 0; _i < 2; ++_i) \
        __builtin_amdgcn_global_load_lds((const unsigned*)((const char*)(gbase) + (voff)[_i]), (LAS unsigned*)(lds + (bufoff) + ldsw + _i * 8192), 16, 0, 0); } while (0)
#define PG8_LDA(dst, b, h) do { _Pragma("unroll") for (int m = 0; m < 4; ++m) _Pragma("unroll") for (int k = 0; k < 2; ++k) dst[m][k] = *(const LAS bf16x8*)(lds + PG8_SA(b, h) + aoff + m * 2048 + k * 1024); } while (0)
#define PG8_LDB(dst, b, h) do { _Pragma("unroll") for (int n = 0; n < 2; ++n) _Pragma("unroll") for (int k = 0; k < 2; ++k) dst[n][k] = *(const LAS bf16x8*)(lds + PG8_SB(b, h) + boff + n * 2048 + k * 1024); } while (0)
#define PG8_MMA(ai, bj, At, Bt) do { __builtin_amdgcn_s_setprio(1); _Pragma("unroll") for (int m = 0; m < 4; ++m) _Pragma("unroll") for (int n = 0; n < 2; ++n) _Pragma("unroll") for (int k = 0; k < 2; ++k) \
        acc[ai][bj][m][n] = __builtin_amdgcn_mfma_f32_16x16x32_bf16(Bt[n][k], At[m][k], acc[ai][bj][m][n], 0, 0, 0); __builtin_amdgcn_s_setprio(0); } while (0)
#define PG8_WAIT_V(n) asm volatile("s_waitcnt vmcnt(" #n ")" ::: "memory")
#define PG8_WAIT_L(n) asm volatile("s_waitcnt lgkmcnt(" #n ")" ::: "memory")
#define PG8_BAR __builtin_amdgcn_s_barrier()
#define PG8_SCHED __builtin_amdgcn_sched_barrier(0)
    Unit cur, nxt; int ui = 0;
    if (!S.next(0, cur)) return;
    f32x4 acc[2][2][4][2];
#pragma unroll
    for (int a = 0; a < 2; ++a)
#pragma unroll
        for (int b = 0; b < 2; ++b)
#pragma unroll
            for (int m = 0; m < 4; ++m)
#pragma unroll
                for (int n = 0; n < 2; ++n) acc[a][b][m][n] = (f32x4){0.f, 0.f, 0.f, 0.f};
    bf16x8 At[4][2], B0[2][2], B1[2][2];
    const char* cA = cur.a; const char* cB = cur.b;
    PG8_STAGE(PG8_SB(0, 0), cB, voffB); PG8_STAGE(PG8_SA(0, 0), cA, voffA); PG8_STAGE(PG8_SB(0, 1), cB + hstep, voffB); PG8_STAGE(PG8_SA(0, 1), cA + hstep, voffA);
    if (wr == 1) PG8_BAR;
    PG8_WAIT_V(4); PG8_BAR;
    PG8_STAGE(PG8_SB(1, 0), cB + kstep, voffB); PG8_STAGE(PG8_SA(1, 0), cA + kstep, voffA); PG8_STAGE(PG8_SB(1, 1), cB + hstep + kstep, voffB);
    PG8_WAIT_V(6); PG8_BAR;
    for (;;) {
        const bool has_next = S.next(ui + 1, nxt);
        const char* nA = has_next ? nxt.a : cA; const char* nB = has_next ? nxt.b : cB;
        for (int t = 0; t < nt; t += 2) {
            const bool last = (t == nt - 2);
            const char* a1 = cA + (size_t)(t + 1) * kstep;
            const char* a2 = last ? nA : cA + (size_t)(t + 2) * kstep; const char* b2 = last ? nB : cB + (size_t)(t + 2) * kstep;
            const char* a3 = a2 + kstep; const char* b3 = b2 + kstep;
            PG8_LDB(B0, 0, 0); PG8_SCHED; PG8_LDA(At, 0, 0); PG8_STAGE(PG8_SA(1, 1), a1 + hstep, voffA);
            PG8_WAIT_L(8); PG8_BAR; PG8_WAIT_L(0); PG8_MMA(0, 0, At, B0); PG8_BAR; PG8_SCHED;
            PG8_LDB(B1, 0, 1); PG8_STAGE(PG8_SB(0, 0), b2, voffB);
            PG8_BAR; PG8_WAIT_L(0); PG8_MMA(0, 1, At, B1); PG8_BAR;
            PG8_LDA(At, 0, 1); PG8_STAGE(PG8_SA(0, 0), a2, voffA);
            PG8_BAR; PG8_WAIT_L(0); PG8_MMA(1, 0, At, B0); PG8_BAR; PG8_SCHED;
            PG8_STAGE(PG8_SB(0, 1), b2 + hstep, voffB);
            PG8_WAIT_V(6); PG8_BAR; PG8_MMA(1, 1, At, B1); PG8_BAR;
            PG8_LDB(B0, 1, 0); PG8_SCHED; PG8_LDA(At, 1, 0); PG8_STAGE(PG8_SA(0, 1), a2 + hstep, voffA);
            PG8_WAIT_L(8); PG8_BAR; PG8_WAIT_L(0); PG8_MMA(0, 0, At, B0); PG8_BAR; PG8_SCHED;
            PG8_LDB(B1, 1, 1); PG8_STAGE(PG8_SB(1, 0), b3, voffB);
            PG8_BAR; PG8_WAIT_L(0); PG8_MMA(0, 1, At, B1); PG8_BAR;
            PG8_LDA(At, 1, 1); PG8_STAGE(PG8_SA(1, 0), a3, voffA);
            PG8_BAR; PG8_WAIT_L(0); PG8_MMA(1, 0, At, B0); PG8_BAR; PG8_SCHED;
            PG8_STAGE(PG8_SB(1, 1), b3 + hstep, voffB);
            PG8_WAIT_V(6); PG8_BAR; PG8_MMA(1, 1, At, B1); PG8_BAR;
        }
        E(acc, cur, wr, wc, fr, fq);
        if (!has_next) break;
#pragma unroll
        for (int a = 0; a < 2; ++a)
#pragma unroll
            for (int b = 0; b < 2; ++b)
#pragma unroll
                for (int m = 0; m < 4; ++m)
#pragma unroll
                    for (int n = 0; n < 2; ++n) acc[a][b][m][n] = (f32x4){0.f, 0.f, 0.f, 0.f};
        cur = nxt; cA = nA; cB = nB; ++ui;
    }
    PG8_WAIT_V(0);
    if (wr == 0) PG8_BAR;
    PG8_BAR;
#undef PG8_SA
#undef PG8_SB
#undef PG8_STAGE
#undef PG8_LDA
#undef PG8_LDB
#undef PG8_MMA
#undef PG8_WAIT_V
#undef PG8_WAIT_L
#undef PG8_BAR
#undef PG8_SCHED
}

struct EpiBf16 {
    static constexpr bool PERM = true;
    bf16_t* O; int ldc;
    __device__ __forceinline__ void operator()(const f32x4 (&acc)[2][2][4][2], const Unit& u, int wr, int wc, int fr, int fq) const {
        const int row0 = u.pm * BM + wr * 64 + fr, col0 = u.pn * BM + wc * 32 + 8 * fq;
#pragma unroll
        for (int ai = 0; ai < 2; ++ai)
#pragma unroll
            for (int m = 0; m < 4; ++m) { bf16_t* rowp = O + (size_t)(row0 + ai * HALF + m * 16) * ldc + col0;
#pragma unroll
                for (int bj = 0; bj < 2; ++bj) { const f32x4 v0 = acc[ai][bj][m][0], v1 = acc[ai][bj][m][1];
                    u32x4 w; w.x = cvt_pk_bf16(v0[0], v0[1]); w.y = cvt_pk_bf16(v0[2], v0[3]); w.z = cvt_pk_bf16(v1[0], v1[1]); w.w = cvt_pk_bf16(v1[2], v1[3]);
                    *(u32x4*)(rowp + bj * HALF) = w; } }
    }
};
struct EpiResid {
    static constexpr bool PERM = false;
    const float* Cin; float* C; int ldc;
    __device__ __forceinline__ void operator()(const f32x4 (&acc)[2][2][4][2], const Unit& u, int wr, int wc, int fr_, int fq_) const {
        int fr = fr_, fq = fq_; asm volatile("" : "+v"(fr), "+v"(fq));
        const int row0 = u.pm * BM + wr * 64 + fr, col0 = u.pn * BM + wc * 32 + 4 * fq;
#pragma unroll
        for (int ai = 0; ai < 2; ++ai)
#pragma unroll
            for (int mp = 0; mp < 2; ++mp) { f32x4 cv[2][2][2];
#pragma unroll
                for (int mm = 0; mm < 2; ++mm) { const float* rowp = Cin + (size_t)(row0 + ai * HALF + (2 * mp + mm) * 16) * ldc + col0;
#pragma unroll
                    for (int bj = 0; bj < 2; ++bj)
#pragma unroll
                        for (int n = 0; n < 2; ++n) cv[mm][bj][n] = *(const f32x4*)(rowp + bj * HALF + n * 16); }
#pragma unroll
                for (int mm = 0; mm < 2; ++mm) { float* rowp = C + (size_t)(row0 + ai * HALF + (2 * mp + mm) * 16) * ldc + col0;
#pragma unroll
                    for (int bj = 0; bj < 2; ++bj)
#pragma unroll
                        for (int n = 0; n < 2; ++n) *(f32x4*)(rowp + bj * HALF + n * 16) = cv[mm][bj][n] + acc[ai][bj][2 * mp + mm][n]; }
                asm volatile("" ::: "memory"); }
    }
};
template <int ACT  > struct EpiGated {
    static constexpr bool PERM = true;
    bf16_t* O; int ldo; int coloff; const float* ba; const float* bb;
    __device__ __forceinline__ void operator()(const f32x4 (&acc)[2][2][4][2], const Unit& u, int wr, int wc, int fr, int fq) const {
        const int row0 = u.pm * BM + wr * 64 + fr, cl = u.pn * HALF + wc * 32 + 8 * fq;
        float va[8], vb[8];
#pragma unroll
        for (int j = 0; j < 8; ++j) { va[j] = (ACT == 0) ? ba[cl + j] : 0.f; vb[j] = (ACT == 0) ? bb[cl + j] : 0.f; }
#pragma unroll
        for (int ai = 0; ai < 2; ++ai)
#pragma unroll
            for (int m = 0; m < 4; ++m) { bf16_t* rowp = O + (size_t)(row0 + ai * HALF + m * 16) * ldo + coloff + cl;
                float o[8];
#pragma unroll
                for (int n = 0; n < 2; ++n)
#pragma unroll
                    for (int j = 0; j < 4; ++j) { const float a = acc[ai][0][m][n][j] + va[4 * n + j], b = acc[ai][1][m][n][j] + vb[4 * n + j];
                        o[4 * n + j] = (ACT == 0) ? a * sigmoidf_(b) : siluf_(a) * b; }
                u32x4 w; w.x = cvt_pk_bf16(o[0], o[1]); w.y = cvt_pk_bf16(o[2], o[3]); w.z = cvt_pk_bf16(o[4], o[5]); w.w = cvt_pk_bf16(o[6], o[7]);
                *(u32x4*)rowp = w; asm volatile("" ::: "memory"); }
    }
};
struct EpiMoeOut {
    static constexpr bool PERM = true;
    bf16_t* O; const int* row_tok; const float* row_w; LAS unsigned char* lds;
    __device__ __forceinline__ void operator()(const f32x4 (&acc)[2][2][4][2], const Unit& u, int wr, int wc, int fr_, int fq_) const {
        int fr = fr_, fq = fq_; asm volatile("" : "+v"(fr), "+v"(fq));
        const int col0 = u.pn * BM + wc * 32 + 8 * fq, lane = fq * 16 + fr;
        LAS u32x2* rinfo = (LAS u32x2*)(lds + STAGE_BYTES) + (wr * 4 + wc) * 128;
        { const int ra = u.pm * BM + wr * 64 + lane, rb = ra + HALF;
          const u32x2 ia = (u32x2){(unsigned)row_tok[ra], __float_as_uint(row_w[ra])}, ib = (u32x2){(unsigned)row_tok[rb], __float_as_uint(row_w[rb])};
          rinfo[lane] = ia; rinfo[64 + lane] = ib; }
#pragma unroll
        for (int ai = 0; ai < 2; ++ai)
#pragma unroll
            for (int m = 0; m < 4; ++m) { const u32x2 inf = rinfo[ai * 64 + m * 16 + fr]; const int ts = (int)inf.x; const float w = __uint_as_float(inf.y);
                if (ts >= 0) { bf16_t* rowp = O + ((size_t)(ts & 1) * NTOK + (size_t)(ts >> 1)) * DM + col0;
#pragma unroll
                    for (int bj = 0; bj < 2; ++bj) { const f32x4 v0 = acc[ai][bj][m][0] * w, v1 = acc[ai][bj][m][1] * w;
                        u32x4 q; q.x = cvt_pk_bf16(v0[0], v0[1]); q.y = cvt_pk_bf16(v0[2], v0[3]); q.z = cvt_pk_bf16(v1[0], v1[1]); q.w = cvt_pk_bf16(v1[2], v1[3]);
                        *(u32x4*)(rowp + bj * HALF) = q; } } }
    }
};
struct MoeOrder {
    int K; const char* A; const char* B; size_t bstride; const LAS int* list;
    static __device__ __forceinline__ void build(LAS int* list, const int* tiles, int nN, int G, int c) {
        const int nrt = tiles[0], nwg = nrt * nN; int n = 0;
        for (int i = 0; ; ++i) { const long L = (long)i * G + c; if (L >= (long)nwg || n >= 20) break;
            int wgid = (int)L; { const int q = nwg / NXCD, r = nwg % NXCD, xcd = wgid % NXCD, off = wgid / NXCD; wgid = (xcd < r ? xcd * (q + 1) : r * (q + 1) + (xcd - r) * q) + off; }
            const int pm = wgid / nN; list[1 + 3 * n] = pm; list[2 + 3 * n] = wgid % nN; list[3 + 3 * n] = tiles[64 + pm]; ++n; }
        list[0] = n;
    }
    __device__ bool next(int i, Unit& u) const {
        const int n = __builtin_amdgcn_readfirstlane(list[0]); if (i >= n) return false;
        u.pm = __builtin_amdgcn_readfirstlane(list[1 + 3 * i]); u.pn = __builtin_amdgcn_readfirstlane(list[2 + 3 * i]); const int e = __builtin_amdgcn_readfirstlane(list[3 + 3 * i]);
        u.a = A + (size_t)u.pm * 256 * K * 2; u.b = B + (size_t)e * bstride + (size_t)u.pn * 256 * K * 2; return true;
    }
};
}

struct Params { const float* in[44]; float* out; unsigned char* ws; int ph_lo, ph_hi; };
enum { I_X = 0, I_NORM1, I_WIN, I_MCONVW, I_MCONVB, I_MDTB, I_MALOG, I_MD, I_MNORM, I_RMU, I_RW0, I_RW2, I_RA0, I_RA2, I_RG2, I_RKK, I_RKA, I_RRK, I_RLNW, I_RLNB,
       I_CKVN, I_CWUK, I_CWUV, I_RELB, I_SARE, I_SAIM, I_SBRE, I_SBIM, I_SCRE, I_SCIM, I_SD, I_SLOGDT, I_SGLUW, I_SGLUB, I_WOUT, I_NORM2, I_WRG, I_BRG, I_WRE, I_BRE,
       I_WGATE, I_WUP, I_WDOWN, I_FNORM };

typedef const float* const __attribute__((address_space(4)))* in_tab_t;
struct Frame {
    LAS unsigned char* lds; int tid, lane, wave, bid, G;
    in_tab_t in; float* out; unsigned char* ws; unsigned* ctl;
    volatile LAS int* misc;
};

__device__ __forceinline__ int q_pop(Frame& F, int qi) {
    __syncthreads();
    if (F.tid == 0) F.misc[0] = (int)__hip_atomic_fetch_add(F.ctl + CW_Q + 64 * qi, 1u, __ATOMIC_RELAXED, __HIP_MEMORY_SCOPE_AGENT);
    __syncthreads();
    return F.misc[0];
}

__device__ __forceinline__ const void* opaque_ptr(const void* p) { const unsigned long long v = (unsigned long long)p; unsigned lo = __builtin_amdgcn_readfirstlane((unsigned)v), hi = __builtin_amdgcn_readfirstlane((unsigned)(v >> 32));
    asm volatile("" : "+s"(lo), "+s"(hi)); return (const void*)(((unsigned long long)hi << 32) | lo); }
__device__ __forceinline__ Frame relocal(const Frame& G) { Frame F = G; asm volatile("" : "+v"(F.tid)); F.ws = (unsigned char*)opaque_ptr(F.ws); F.ctl = (unsigned*)(F.ws + WS_CTL); F.in = (in_tab_t)(unsigned long long)opaque_ptr((const void*)(unsigned long long)F.in); F.lane = F.tid & 63; F.wave = __builtin_amdgcn_readfirstlane(F.tid >> 6); return F; }
template <int K> __device__ __forceinline__ f32x4 mma_nt(const LAS bf16_t* A, int lda, const LAS bf16_t* Bt, int ldb, f32x4 acc, int lane) {
    const int r = lane & 15, g = lane >> 4;
#pragma unroll
    for (int k0 = 0; k0 < K; k0 += 32) {
        const bf16x8 a = *(const LAS bf16x8*)(A + r * lda + k0 + 8 * g);
        const bf16x8 b = *(const LAS bf16x8*)(Bt + r * ldb + k0 + 8 * g);
        acc = __builtin_amdgcn_mfma_f32_16x16x32_bf16(a, b, acc, 0, 0, 0);
    }
    return acc;
}

template <class SrcMap> __device__ __forceinline__ void tr_tile(Frame& F, int ldsrc, bf16_t* dst, int K, int k0, int n0, SrcMap sm) {
    LAS float* tile = (LAS float*)F.lds;
    __syncthreads();
    { const int n4 = (F.tid & 63) * 4, kk = F.tid >> 6; const float* sp = sm(n0 + n4);
      f32x4 v[8];
#pragma unroll
      for (int ps = 0; ps < 8; ++ps) { v[ps] = (f32x4){0.f, 0.f, 0.f, 0.f}; if (sp) v[ps] = *(const f32x4*)(sp + (size_t)(k0 + kk + 8 * ps) * ldsrc); }
#pragma unroll
      for (int ps = 0; ps < 8; ++ps) { LAS float* t = tile + (kk + 8 * ps) * 257 + n4; t[0] = v[ps][0]; t[1] = v[ps][1]; t[2] = v[ps][2]; t[3] = v[ps][3]; } }
    __syncthreads();
    { const int kc = F.tid & 7;
#pragma unroll
      for (int j = 0; j < 4; ++j) { const int n = (F.tid >> 3) + 64 * j; float f[8];
#pragma unroll
          for (int i = 0; i < 8; ++i) f[i] = tile[(8 * kc + i) * 257 + n];
          u32x4 w; w.x = pk2(f[0], f[1]); w.y = pk2(f[2], f[3]); w.z = pk2(f[4], f[5]); w.w = pk2(f[6], f[7]);
          *(u32x4*)(dst + (size_t)(n0 + n) * K + k0 + 8 * kc) = w; } }
}

struct SmIn { const float* base; __device__ __forceinline__ const float* operator()(int n) const {
    int c; if (n < 772) c = n; else if (n < UR) return nullptr; else if (n < UR + 896) c = 772 + (n - UR); else if (n < UC) return nullptr;
    else if (n < UC + 680) c = 1668 + (n - UC); else if (n < US) return nullptr; else if (n < US + 256) c = 2348 + (n - US); else return nullptr; return base + c; } };
struct SmId { const float* base; __device__ __forceinline__ const float* operator()(int n) const { return base + n; } };
struct SmGlu { const float* base; __device__ __forceinline__ const float* operator()(int n) const { const int pn = n >> 8, rr = n & 255; return base + (rr < 128 ? 128 * pn + rr : 256 + 128 * pn + (rr - 128)); } };
struct SmGU { const float* gate; const float* up; __device__ __forceinline__ const float* operator()(int n) const {
    const unsigned long long d = (unsigned long long)up - (unsigned long long)gate; const unsigned long long a = (unsigned long long)gate + (((n & 255) < 128) ? 0ull : d); return (const float*)a + 128 * (n >> 8) + (n & 127); } };
__device__ __forceinline__ void phase_prologue(const Frame& F_) { Frame F = relocal(F_);
    for (int t = F.bid; t < 496; t += F.G) {
        if (t < 352) { const int l = t / 176, r = t % 176, kt = r / 11, nt = r % 11;
            tr_tile(F, NIN, (bf16_t*)(F.ws + WS_WIN) + (size_t)l * NINP * DM, DM, kt * 64, nt * 256, SmIn{F.in[I_WIN] + (size_t)l * DM * NIN}); }
        else if (t < 480) { const int q = t - 352, l = q / 64, r = q % 64, kt = r / 4, nt = r % 4;
            tr_tile(F, DM, (bf16_t*)(F.ws + WS_WOUT) + (size_t)l * DM * DM, DM, kt * 64, nt * 256, SmId{F.in[I_WOUT] + (size_t)l * DM * DM}); }
        else { const int q = t - 480, l = q / 8, r = q % 8, kt = r / 2, nt = r % 2;
            tr_tile(F, 512, (bf16_t*)(F.ws + WS_GLU) + (size_t)l * 512 * 256, 256, kt * 64, nt * 256, SmGlu{F.in[I_SGLUW] + (size_t)l * 256 * 512}); }
    }
    for (int i = F.bid * NTHR + F.tid; i < 2 * 48 * 1024; i += F.G * NTHR) { const int l = i / 49152, r = i % 49152, o = r >> 10, k = r & 1023;
        float v = 0.f; if (o < 32) v = F.in[I_WRE][((size_t)l * DM + k) * 32 + o]; else if (o < 36) v = F.in[I_WRG][((size_t)l * DM + k) * 4 + (o - 32)];
        v *= F.in[I_NORM2][l * DM + k];
        const bf16_t hi = f2bf(v); const bf16_t lo = f2bf(v - bf2f(hi));
        bf16_t* w = (bf16_t*)(F.ws + WS_WRT) + (size_t)l * 2 * 49152; w[r] = hi; w[49152 + r] = lo; }
    for (int i = F.bid * NTHR + F.tid; i < 2048 + 65536; i += F.G * NTHR) {
        if (i < 2048) {
            const int l = i >> 10, gn = i & 1023, g = gn >> 6;
            float* tab = (float*)(F.ws + WS_S5TAB + (size_t)l * S5TAB_L);
            const float lre = fminf(F.in[I_SARE][l * 1024 + gn], -1e-4f), lim = F.in[I_SAIM][l * 1024 + gn];
            const float dt = expf(F.in[I_SLOGDT][l * 16 + g]);
            const float mag = expf(dt * lre); float sn, cs; sincosf(dt * lim, &sn, &cs);
            const float are = mag * cs, aim = mag * sn;
            const float den = lre * lre + lim * lim;
            const float fre = ((are - 1.0f) * lre + aim * lim) / den, fim = (aim * lre - (are - 1.0f) * lim) / den;
            tab[gn * 2] = are; tab[gn * 2 + 1] = aim;
            float pr = are, pi = aim;
#pragma unroll
            for (int s = 0; s < 6; ++s) { const float nr = pr * pr - pi * pi, ni = 2.0f * pr * pi; pr = nr; pi = ni; }
            tab[2048 + gn * 2] = pr; tab[2048 + gn * 2 + 1] = pi;
            const float* bre = F.in[I_SBRE] + ((size_t)l * 1024 + gn) * 16; const float* bim = F.in[I_SBIM] + ((size_t)l * 1024 + gn) * 16;
            bf16_t* bbt = (bf16_t*)(F.ws + WS_S5TAB + (size_t)l * S5TAB_L + S5TAB_BBT); const int n = gn & 63, col = 4 * (n & 31) + 2 * (n >> 5);
            for (int p = 0; p < 16; ++p) { const float vr = fre * bre[p] - fim * bim[p], vi = fre * bim[p] + fim * bre[p];
                bbt[((size_t)g * 128 + col) * 16 + p] = f2bf(vr); bbt[((size_t)g * 128 + col + 1) * 16 + p] = f2bf(vi); }
        } else {
            const int j = i - 2048, l = j >> 15, r = j & 32767, gp = r >> 7, k = r & 127;
            bf16_t* cm = (bf16_t*)(F.ws + WS_S5TAB + (size_t)l * S5TAB_L + S5TAB_F);
            const int n = (k >> 2) + 32 * ((k >> 1) & 1);
            const float v = (k & 1) == 0 ? F.in[I_SCRE][((size_t)l * 256 + gp) * 64 + n] : -F.in[I_SCIM][((size_t)l * 256 + gp) * 64 + n];
            cm[r] = f2bf(v);
        }
    }
}

__device__ __forceinline__ void phase_norm(const Frame& F_, const float* xin, bool add_o, const float* w, int mode) { Frame F = relocal(F_);
    float* X = (float*)(F.ws + WS_X); bf16_t* H = (bf16_t*)(F.ws + WS_H); const bf16_t* O = (const bf16_t*)(F.ws + WS_U);
    for (int row0 = F.bid * 32 + F.wave * 4; row0 < NTOK; row0 += F.G * 32) {
        f32x4 v[4][4]; u32x2 oa[4][4], ob[4][4];
#pragma unroll
        for (int r = 0; r < 4; ++r)
#pragma unroll
            for (int j = 0; j < 4; ++j) { const int c = 4 * F.lane + 256 * j; const size_t o = (size_t)(row0 + r) * DM + c; v[r][j] = *(const f32x4*)(xin + o);
                if (add_o) { oa[r][j] = *(const u32x2*)(O + o); ob[r][j] = *(const u32x2*)(O + (size_t)NTOK * DM + o); } }
#pragma unroll
        for (int r = 0; r < 4; ++r) { const int row = row0 + r; float ss = 0.f;
#pragma unroll
            for (int j = 0; j < 4; ++j) {
                if (add_o) { const u32x2 a = oa[r][j], b = ob[r][j];
                    v[r][j][0] += __uint_as_float(a.x << 16) + __uint_as_float(b.x << 16); v[r][j][1] += __uint_as_float(a.x & 0xffff0000u) + __uint_as_float(b.x & 0xffff0000u);
                    v[r][j][2] += __uint_as_float(a.y << 16) + __uint_as_float(b.y << 16); v[r][j][3] += __uint_as_float(a.y & 0xffff0000u) + __uint_as_float(b.y & 0xffff0000u); }
                ss += v[r][j][0] * v[r][j][0] + v[r][j][1] * v[r][j][1] + v[r][j][2] * v[r][j][2] + v[r][j][3] * v[r][j][3]; }
            ss = wave_sum(ss);
            const float rstd = rsqrtf(ss * (1.0f / DM) + 1e-6f);
#pragma unroll
            for (int j = 0; j < 4; ++j) { const int c = 4 * F.lane + 256 * j; const f32x4 wv = *(const f32x4*)(w + c);
                if (mode == 2) { *(f32x4*)(F.out + (size_t)row * DM + c) = v[r][j] * rstd * wv; }
                else { if (mode == 0) *(f32x4*)(X + (size_t)row * DM + c) = v[r][j];
                    u32x2 o; o.x = pk2(v[r][j][0] * rstd * wv[0], v[r][j][1] * rstd * wv[1]); o.y = pk2(v[r][j][2] * rstd * wv[2], v[r][j][3] * rstd * wv[3]);
                    *(u32x2*)(H + (size_t)row * DM + c) = o; } } }
    }
}

__device__ __forceinline__ void item_kv(const Frame& F_, int layer, int item) { Frame F = relocal(F_);
    const bf16_t* U = (const bf16_t*)(F.ws + WS_U);
    LAS bf16_t* Ab = (LAS bf16_t*)F.lds;
    LAS bf16_t* Bt = (LAS bf16_t*)(F.lds + 17408);
    const int t0 = item * 64;
    { const int tok = F.tid >> 3, part = F.tid & 7; const bf16_t* src = U + (size_t)(t0 + tok) * NINP + UC + 256 + 16 * part;
      float f[16]; { float a[8], b[8]; unpack8(*(const u32x4*)src, a); unpack8(*(const u32x4*)(src + 8), b);
#pragma unroll
        for (int j = 0; j < 8; ++j) { f[j] = a[j]; f[8 + j] = b[j]; } }
      float ss = 0.f;
#pragma unroll
      for (int j = 0; j < 16; ++j) ss += f[j] * f[j];
      ss = sum8(ss);
      const float rstd = rsqrtf(ss * (1.0f / 128.0f) + 1e-6f); const float* nw = F.in[I_CKVN] + layer * 128 + 16 * part;
#pragma unroll
      for (int j = 0; j < 16; j += 2) *(LAS unsigned*)(Ab + tok * 136 + 16 * part + j) = pk2(f[j] * rstd * nw[j], f[j + 1] * rstd * nw[j + 1]); }
    { const int n = F.tid >> 2, kq = F.tid & 3; const float* w = (n < 64 ? F.in[I_CWUK] : F.in[I_CWUV]) + (size_t)layer * 128 * 64 + (n & 63);
      float wv[32];
#pragma unroll
      for (int k = 0; k < 32; ++k) wv[k] = w[(size_t)(32 * kq + k) * 64];
#pragma unroll
      for (int k = 0; k < 32; k += 2) *(LAS unsigned*)(Bt + n * 136 + 32 * kq + k) = pk2(wv[k], wv[k + 1]); }
    if (F.tid < 256) { const int tok = F.tid >> 2, q = F.tid & 3;
        *(u32x4*)((bf16_t*)(F.ws + WS_KIDX) + (size_t)(t0 + tok) * 32 + 8 * q) = *(const u32x4*)(U + (size_t)(t0 + tok) * NINP + UC + 640 + 8 * q); }
    __syncthreads();
    const int mt = F.wave & 3, g = F.lane >> 4, r = F.lane & 15;
#pragma unroll
    for (int q = 0; q < 4; ++q) { const int nt = (F.wave >> 2) * 4 + q;
        f32x4 acc = (f32x4){0.f, 0.f, 0.f, 0.f};
        acc = mma_nt<128>(Ab + mt * 16 * 136, 136, Bt + nt * 16 * 136, 136, acc, F.lane);
        const int n = nt * 16 + r; bf16_t* dst = (bf16_t*)(F.ws + (n < 64 ? WS_K : WS_V));
#pragma unroll
        for (int i = 0; i < 4; ++i) dst[(size_t)(t0 + mt * 16 + 4 * g + i) * 64 + (n & 63)] = f2bf(acc[i]); }
}

constexpr int MB_CG = 0, MB_BG = 18432, MB_BT = 36864, MB_XT = 55296, MB_M = 92160, MB_S0 = 101376, MB_DT = 110592, MB_AC = 111616, MB_RS = 112640;
template <int STAGE> __device__ __forceinline__ void item_mamba(const Frame& F_, int layer, int item) { Frame F = relocal(F_);
    const bf16_t* U = (const bf16_t*)(F.ws + WS_U);
    const int b = item >> 6, c = item & 63, l0 = c * 64; const size_t T0 = (size_t)b * SEQ + l0;
    LAS bf16_t* Cg = (LAS bf16_t*)(F.lds + MB_CG); LAS bf16_t* Bg = (LAS bf16_t*)(F.lds + MB_BG); LAS bf16_t* BT = (LAS bf16_t*)(F.lds + MB_BT);
    LAS bf16_t* XT = (LAS bf16_t*)(F.lds + MB_XT); LAS bf16_t* Mb = (LAS bf16_t*)(F.lds + MB_M); LAS bf16_t* S0 = (LAS bf16_t*)(F.lds + MB_S0);
    LAS float* dts = (LAS float*)(F.lds + MB_DT); LAS float* acs = (LAS float*)(F.lds + MB_AC); LAS float* rs = (LAS float*)(F.lds + MB_RS);
    if (F.tid < 256) { const int l = F.tid >> 2, h = F.tid & 3;
        const float raw = bf2f(U[(T0 + l) * NINP + UM + 768 + h]) + F.in[I_MDTB][layer * 4 + h];
        const float dt = softplusf_(raw); dts[l * 4 + h] = dt; acs[l * 4 + h] = -__expf(F.in[I_MALOG][layer * 4 + h]) * dt; }
    if (F.tid < 64) rs[F.tid] = 0.f;
    __syncthreads();
    float mycum = 0.f;
    if (F.tid < 256) { const int l = F.tid >> 2, h = F.tid & 3; for (int s = 0; s <= l; ++s) mycum += acs[s * 4 + h]; }
    __syncthreads();
    if (F.tid < 256) acs[F.tid] = mycum;
    __syncthreads();
    { const int ch8 = F.tid & 63, tg = F.tid >> 6, c0 = ch8 * 8;
      float wv[4][8], bv[8];
#pragma unroll
      for (int j = 0; j < 8; ++j) { bv[j] = F.in[I_MCONVB][layer * 512 + c0 + j];
#pragma unroll
          for (int k = 0; k < 4; ++k) wv[k][j] = F.in[I_MCONVW][(layer * 4 + k) * 512 + c0 + j]; }
      float win[3][8];
#pragma unroll
      for (int k = 0; k < 3; ++k) { const int l = l0 + tg * 8 - 3 + k;
          if (l >= 0) unpack8(*(const u32x4*)(U + ((size_t)b * SEQ + l) * NINP + UM + 256 + c0), win[k]);
          else {
#pragma unroll
              for (int j = 0; j < 8; ++j) win[k][j] = 0.f; } }
#pragma unroll 1
      for (int ib = 0; ib < 2; ++ib) { u32x4 rows[4];
#pragma unroll
          for (int i4 = 0; i4 < 4; ++i4) rows[i4] = *(const u32x4*)(U + (T0 + tg * 8 + ib * 4 + i4) * NINP + UM + 256 + c0);
#pragma unroll
      for (int i4 = 0; i4 < 4; ++i4) { const int l = tg * 8 + ib * 4 + i4; float cur[8]; unpack8(rows[i4], cur);
          float o[8];
#pragma unroll
          for (int j = 0; j < 8; ++j) { o[j] = siluf_(bv[j] + wv[0][j] * win[0][j] + wv[1][j] * win[1][j] + wv[2][j] * win[2][j] + wv[3][j] * cur[j]);
              win[0][j] = win[1][j]; win[1][j] = win[2][j]; win[2][j] = cur[j]; }
          if (c0 < 256) { const int h = c0 >> 6, p0 = c0 & 63; float sc = dts[l * 4 + h]; if (STAGE == 1) sc *= __expf(acs[63 * 4 + h] - acs[l * 4 + h]);
#pragma unroll
              for (int j = 0; j < 8; ++j) XT[(h * 64 + p0 + j) * 72 + l] = f2bf(o[j] * sc); }
          else if (c0 < 384) { const int g = (c0 - 256) >> 6, n0 = (c0 - 256) & 63;
              if (STAGE == 1) {
#pragma unroll
                  for (int j = 0; j < 8; ++j) BT[(g * 64 + n0 + j) * 72 + l] = f2bf(o[j]); }
              else { u32x4 w; w.x = pk2(o[0], o[1]); w.y = pk2(o[2], o[3]); w.z = pk2(o[4], o[5]); w.w = pk2(o[6], o[7]); *(LAS u32x4*)(Bg + (g * 64 + l) * 72 + n0) = w; } }
          else if (STAGE == 2) { const int g = (c0 - 384) >> 6, n0 = (c0 - 384) & 63;
              u32x4 w; w.x = pk2(o[0], o[1]); w.y = pk2(o[2], o[3]); w.z = pk2(o[4], o[5]); w.w = pk2(o[6], o[7]); *(LAS u32x4*)(Cg + (g * 64 + l) * 72 + n0) = w; } } } }
    __syncthreads();
    const int g4 = F.lane >> 4, r16 = F.lane & 15;
    if (STAGE == 1) {
        float* MST = (float*)(F.ws + WS_MST) + ((size_t)(b * 64 + c) * 4) * 4096;
#pragma unroll
        for (int q = 0; q < 8; ++q) { const int tix = F.wave * 8 + q, h = tix >> 4, mt = (tix >> 2) & 3, nt = tix & 3;
            f32x4 acc = (f32x4){0.f, 0.f, 0.f, 0.f};
            acc = mma_nt<64>(XT + (h * 64 + mt * 16) * 72, 72, BT + ((h >> 1) * 64 + nt * 16) * 72, 72, acc, F.lane);
#pragma unroll
            for (int i = 0; i < 4; ++i) MST[(size_t)h * 4096 + (mt * 16 + 4 * g4 + i) * 64 + nt * 16 + r16] = acc[i]; }
        if (F.tid < 4) ((float*)(F.ws + WS_MDEC))[(b * 64 + c) * 4 + F.tid] = __expf(acs[63 * 4 + F.tid]);
    } else {
        const int mt = F.wave & 3, nh = F.wave >> 2;
        const float* MST = (const float*)(F.ws + WS_MST) + ((size_t)(b * 64 + c) * 4) * 4096;
        f32x4 G[2], yv[4][2];
#pragma unroll
        for (int h = 0; h < 4; ++h) {
            const int g = h >> 1;
            { const float* src = MST + (size_t)h * 4096 + F.tid * 8; const f32x4 a = *(const f32x4*)src, bq = *(const f32x4*)(src + 4);
              u32x4 w; w.x = pk2(a[0], a[1]); w.y = pk2(a[2], a[3]); w.z = pk2(bq[0], bq[1]); w.w = pk2(bq[2], bq[3]);
              *(LAS u32x4*)(S0 + (F.tid >> 3) * 72 + (F.tid & 7) * 8) = w; }
            if ((h & 1) == 0) {
#pragma unroll
                for (int q = 0; q < 2; ++q) { G[q] = (f32x4){0.f, 0.f, 0.f, 0.f};
                    G[q] = mma_nt<64>(Cg + (g * 64 + mt * 16) * 72, 72, Bg + (g * 64 + (2 * nh + q) * 16) * 72, 72, G[q], F.lane); } }
#pragma unroll
            for (int q = 0; q < 2; ++q) { const int s = (2 * nh + q) * 16 + r16; const float as = acs[s * 4 + h];
#pragma unroll
                for (int i = 0; i < 4; ++i) { const int l = mt * 16 + 4 * g4 + i; const float v = (s <= l) ? G[q][i] * __expf(acs[l * 4 + h] - as) : 0.f;
                    Mb[l * 72 + s] = f2bf(v); } }
            __syncthreads();
#pragma unroll
            for (int q = 0; q < 2; ++q) { const int nt = 2 * nh + q;
                f32x4 yd = (f32x4){0.f, 0.f, 0.f, 0.f}, yo = (f32x4){0.f, 0.f, 0.f, 0.f};
                yd = mma_nt<64>(Mb + mt * 16 * 72, 72, XT + (h * 64 + nt * 16) * 72, 72, yd, F.lane);
                yo = mma_nt<64>(Cg + (g * 64 + mt * 16) * 72, 72, S0 + nt * 16 * 72, 72, yo, F.lane);
                const int p = nt * 16 + r16; const float dsk = F.in[I_MD][layer * 4 + h];
#pragma unroll
                for (int i = 0; i < 4; ++i) { const int l = mt * 16 + 4 * g4 + i;
                    const float xs = bf2f(XT[(h * 64 + p) * 72 + l]) / dts[l * 4 + h];
                    yv[h][q][i] = yd[i] + yo[i] * __expf(acs[l * 4 + h]) + dsk * xs; } }
            __syncthreads();
        }
        float part[4] = {0.f, 0.f, 0.f, 0.f};
#pragma unroll
        for (int h = 0; h < 4; ++h)
#pragma unroll
            for (int q = 0; q < 2; ++q) { const int ch = h * 64 + (2 * nh + q) * 16 + r16;
#pragma unroll
                for (int i = 0; i < 4; ++i) { const int l = mt * 16 + 4 * g4 + i; const float z = bf2f(U[(T0 + l) * NINP + UM + ch]);
                    const float v = yv[h][q][i] * siluf_(z); yv[h][q][i] = v; part[i] += v * v; } }
#pragma unroll
        for (int i = 0; i < 4; ++i) { const float s = sum16(part[i]); if (r16 == 0) atomicAdd((float*)(rs + mt * 16 + 4 * g4 + i), s); }
        __syncthreads();
        bf16_t* Y = (bf16_t*)(F.ws + WS_H);
#pragma unroll
        for (int i = 0; i < 4; ++i) { const int l = mt * 16 + 4 * g4 + i; const float rstd = rsqrtf(rs[l] * (1.0f / 256.0f) + 1e-6f);
#pragma unroll
            for (int h = 0; h < 4; ++h)
#pragma unroll
                for (int q = 0; q < 2; ++q) { const int ch = h * 64 + (2 * nh + q) * 16 + r16;
                    Y[(T0 + l) * DM + ch] = f2bf(yv[h][q][i] * rstd * F.in[I_MNORM][layer * 256 + ch]); } }
    }
}
__device__ __forceinline__ void item_mamba_carry(const Frame& F_, int item) { Frame F = relocal(F_);
    const int b = item >> 2, h = item & 3;
    float* MST = (float*)(F.ws + WS_MST); const float* MD = (const float*)(F.ws + WS_MDEC);
    float s[8];
#pragma unroll
    for (int j = 0; j < 8; ++j) s[j] = 0.f;
    for (int c = 0; c < 64; ++c) { float* p = MST + ((size_t)(b * 64 + c) * 4 + h) * 4096 + F.tid * 8; const float d = MD[(b * 64 + c) * 4 + h];
        const f32x4 a = *(f32x4*)p, q = *(f32x4*)(p + 4);
        *(f32x4*)p = (f32x4){s[0], s[1], s[2], s[3]}; *(f32x4*)(p + 4) = (f32x4){s[4], s[5], s[6], s[7]};
        s[0] = s[0] * d + a[0]; s[1] = s[1] * d + a[1]; s[2] = s[2] * d + a[2]; s[3] = s[3] * d + a[3];
        s[4] = s[4] * d + q[0]; s[5] = s[5] * d + q[1]; s[6] = s[6] * d + q[2]; s[7] = s[7] * d + q[3]; }
}

template <int STAGE> __device__ __forceinline__ void item_s5(const Frame& F_, int layer, int item) { Frame F = relocal(F_);
    const bf16_t* U = (const bf16_t*)(F.ws + WS_U);
    const int b = item >> 6, c = item & 63; const size_t T0 = (size_t)b * SEQ + c * 64;
    LAS bf16_t* us = (LAS bf16_t*)F.lds;
    LAS bf16_t* BuW = (LAS bf16_t*)(F.lds + 33792) + F.wave * 4224;
    const float* tab = (const float*)(F.ws + WS_S5TAB + (size_t)layer * S5TAB_L);
    { const int tok = F.tid >> 3, part = F.tid & 7;
#pragma unroll
      for (int q = 0; q < 4; ++q) *(LAS u32x4*)(us + tok * 264 + 32 * part + 8 * q) = *(const u32x4*)(U + (T0 + tok) * NINP + US + 32 * part + 8 * q); }
    const int lane = F.lane, r16 = lane & 15, g4 = lane >> 4, gq = lane >> 5, n0 = lane & 31, g = 2 * F.wave + gq, gn0 = g * 64 + n0, gn1 = gn0 + 32;
    bf16x8 bfr[2][8];
    { const bf16_t* bbt = (const bf16_t*)(F.ws + WS_S5TAB + (size_t)layer * S5TAB_L + S5TAB_BBT);
#pragma unroll
      for (int gg = 0; gg < 2; ++gg)
#pragma unroll
          for (int nt = 0; nt < 8; ++nt) { u32x4 z = (u32x4){0u, 0u, 0u, 0u}; if (g4 < 2) z = *(const u32x4*)(bbt + ((size_t)(2 * F.wave + gg) * 128 + 16 * nt + r16) * 16 + 8 * g4); bfr[gg][nt] = __builtin_bit_cast(bf16x8, z); } }
    const float a0r = tab[gn0 * 2], a0i = tab[gn0 * 2 + 1], a1r = tab[gn1 * 2], a1i = tab[gn1 * 2 + 1];
    float* ST = (float*)(F.ws + WS_S5ST) + (size_t)(b * 64 + c) * 2048;
    float h0r = 0.f, h0i = 0.f, h1r = 0.f, h1i = 0.f;
    if (STAGE == 2) { h0r = ST[gn0 * 2]; h0i = ST[gn0 * 2 + 1]; h1r = ST[gn1 * 2]; h1i = ST[gn1 * 2 + 1]; }
    bf16x8 cf[2][4];
    if (STAGE == 2) { const bf16_t* cm = (const bf16_t*)(F.ws + WS_S5TAB + (size_t)layer * S5TAB_L + S5TAB_F);
#pragma unroll
        for (int gg = 0; gg < 2; ++gg)
#pragma unroll
            for (int ks = 0; ks < 4; ++ks) cf[gg][ks] = *(const bf16x8*)(cm + ((size_t)((2 * F.wave + gg) * 16 + r16)) * 128 + 32 * ks + 8 * g4); }
    __syncthreads();
#pragma unroll 1
    for (int lb = 0; lb < 4; ++lb) {
#pragma unroll
        for (int gg = 0; gg < 2; ++gg) { u32x4 z = (u32x4){0u, 0u, 0u, 0u}; if (g4 < 2) z = *(const LAS u32x4*)(us + (16 * lb + r16) * 264 + (2 * F.wave + gg) * 16 + 8 * g4);
            const bf16x8 afr = __builtin_bit_cast(bf16x8, z);
#pragma unroll
            for (int nt = 0; nt < 8; ++nt) { const f32x4 acc = __builtin_amdgcn_mfma_f32_16x16x32_bf16(afr, bfr[gg][nt], (f32x4){0.f, 0.f, 0.f, 0.f}, 0, 0, 0);
#pragma unroll
                for (int i = 0; i < 4; ++i) BuW[(4 * g4 + i) * 264 + gg * 128 + 16 * nt + r16] = f2bf(acc[i]); } }
        __syncthreads();
#pragma unroll 4
        for (int li = 0; li < 16; ++li) { LAS u32x2* bp = (LAS u32x2*)(BuW + li * 264 + gq * 128 + 4 * n0); const u32x2 v = *bp;
            { const float br = __uint_as_float(v.x << 16), bi = __uint_as_float(v.x & 0xffff0000u); const float nr = a0r * h0r - a0i * h0i + br, ni = a0r * h0i + a0i * h0r + bi; h0r = nr; h0i = ni; }
            { const float br = __uint_as_float(v.y << 16), bi = __uint_as_float(v.y & 0xffff0000u); const float nr = a1r * h1r - a1i * h1i + br, ni = a1r * h1i + a1i * h1r + bi; h1r = nr; h1i = ni; }
            if (STAGE == 2) *bp = (u32x2){pk2(h0r, h0i), pk2(h1r, h1i)}; }
        __syncthreads();
        if (STAGE == 2) {
            bf16_t* YS = (bf16_t*)(F.ws + WS_MOE + YSG_OFF);
#pragma unroll
            for (int gg = 0; gg < 2; ++gg) { f32x4 acc = (f32x4){0.f, 0.f, 0.f, 0.f};
#pragma unroll
                for (int ks = 0; ks < 4; ++ks) { const bf16x8 a = *(const LAS bf16x8*)(BuW + r16 * 264 + gg * 128 + 32 * ks + 8 * g4);
                    acc = __builtin_amdgcn_mfma_f32_16x16x32_bf16(a, cf[gg][ks], acc, 0, 0, 0); }
                const int ch = (2 * F.wave + gg) * 16 + r16; const float dsk = F.in[I_SD][layer * 256 + ch];
#pragma unroll
                for (int i = 0; i < 4; ++i) { const int l = lb * 16 + 4 * g4 + i; const float y = acc[i] + dsk * bf2f(us[l * 264 + ch]);
                    YS[(T0 + l) * 256 + ch] = f2bf(gelu_tanh(y)); } }
            __syncthreads();
        }
    }
    if (STAGE == 1) { ST[gn0 * 2] = h0r; ST[gn0 * 2 + 1] = h0i; ST[gn1 * 2] = h1r; ST[gn1 * 2 + 1] = h1i; }
    if (STAGE == 2) {
        asm volatile("s_waitcnt vmcnt(0)" ::: "memory"); __syncthreads();
        const bf16_t* YS = (const bf16_t*)(F.ws + WS_MOE + YSG_OFF) + T0 * 256; const bf16_t* GW = (const bf16_t*)(F.ws + WS_GLU) + (size_t)layer * 512 * 256;
        const int r16 = F.lane & 15, g4 = F.lane >> 4;
        f32x4 av[4][2], ag[4][2];
#pragma unroll
        for (int m = 0; m < 4; ++m)
#pragma unroll
            for (int q = 0; q < 2; ++q) { av[m][q] = (f32x4){0.f, 0.f, 0.f, 0.f}; ag[m][q] = (f32x4){0.f, 0.f, 0.f, 0.f}; }
#pragma unroll 2
        for (int ks = 0; ks < 8; ++ks) {
            bf16x8 af[4], bv[2], bg[2];
#pragma unroll
            for (int m = 0; m < 4; ++m) af[m] = *(const bf16x8*)(YS + (size_t)(16 * m + r16) * 256 + 32 * ks + 8 * g4);
#pragma unroll
            for (int q = 0; q < 2; ++q) { const int c = 32 * F.wave + 16 * q + r16; const int rowv = 256 * (c >> 7) + (c & 127);
                bv[q] = *(const bf16x8*)(GW + (size_t)rowv * 256 + 32 * ks + 8 * g4); bg[q] = *(const bf16x8*)(GW + (size_t)(rowv + 128) * 256 + 32 * ks + 8 * g4); }
#pragma unroll
            for (int m = 0; m < 4; ++m)
#pragma unroll
                for (int q = 0; q < 2; ++q) { av[m][q] = __builtin_amdgcn_mfma_f32_16x16x32_bf16(af[m], bv[q], av[m][q], 0, 0, 0); ag[m][q] = __builtin_amdgcn_mfma_f32_16x16x32_bf16(af[m], bg[q], ag[m][q], 0, 0, 0); }
        }
        bf16_t* Y = (bf16_t*)(F.ws + WS_H);
#pragma unroll
        for (int q = 0; q < 2; ++q) { const int c = 32 * F.wave + 16 * q + r16; const float bvl = F.in[I_SGLUB][layer * 512 + c], bgt = F.in[I_SGLUB][layer * 512 + 256 + c];
#pragma unroll
            for (int m = 0; m < 4; ++m)
#pragma unroll
                for (int i = 0; i < 4; ++i) Y[(T0 + 16 * m + 4 * g4 + i) * DM + 768 + c] = f2bf((av[m][q][i] + bvl) * sigmoidf_(ag[m][q][i] + bgt)); }
    }
}
__device__ __forceinline__ void item_s5_carry(const Frame& F_, int layer, int b) { Frame F = relocal(F_);
    const float* tab = (const float*)(F.ws + WS_S5TAB + (size_t)layer * S5TAB_L) + 2048;
    float* ST = (float*)(F.ws + WS_S5ST) + (size_t)b * 64 * 2048;
#pragma unroll
    for (int q = 0; q < 2; ++q) { const int gn = F.tid + 512 * q; const float pr = tab[gn * 2], pi = tab[gn * 2 + 1]; float hr = 0.f, hi = 0.f;
        for (int c = 0; c < 64; ++c) { float* p = ST + (size_t)c * 2048 + gn * 2; const float tr = p[0], ti = p[1]; p[0] = hr; p[1] = hi;
            const float nr = pr * hr - pi * hi + tr, ni = pr * hi + pi * hr + ti; hr = nr; hi = ni; } }
}

constexpr int RB_LD = 72;
constexpr int RW_R = 0, RW_K = 16384, RW_V = 32768, RW_W = 49152, RW_A = 65536, RW_B = 81920;
constexpr int R3_G = 49152, R3_O = 65536, R3_TILES = 81920, R3_BON = 147456;
template <int STAGE> __device__ __forceinline__ void rwkv_prep(const Frame& F_, int layer, int b, int h, int c) { Frame F = relocal(F_);
    const bf16_t* U = (const bf16_t*)(F.ws + WS_U);
    const int l0 = c * 64; const size_t T0 = (size_t)b * SEQ + l0;
    LAS float* Rr = (LAS float*)(F.lds + RW_R); LAS float* Kk = (LAS float*)(F.lds + RW_K); LAS float* Vv = (LAS float*)(F.lds + RW_V); LAS float* Ww = (LAS float*)(F.lds + RW_W);
    LAS float* Aa = (LAS float*)(F.lds + (STAGE == 1 ? RW_A : R3_O)); LAS float* Bb = (LAS float*)(F.lds + RW_B); LAS float* Gg = (LAS float*)(F.lds + R3_G); LAS float* BON = (LAS float*)(F.lds + R3_BON);
    LAS bf16_t* TWb = (LAS bf16_t*)(F.lds + 98304); LAS bf16_t* DAb = (LAS bf16_t*)(F.lds + (STAGE == 1 ? 103424 : 118784)); LAS bf16_t* SGb = (LAS bf16_t*)(F.lds + 123904);
    LAS bf16_t* w2T = (LAS bf16_t*)(F.lds + 108544); LAS bf16_t* a2T = (LAS bf16_t*)(F.lds + (STAGE == 1 ? 113664 : 133120)); LAS bf16_t* g2T = (LAS bf16_t*)(F.lds + 138240);
    const float* mu = F.in[I_RMU] + layer * 896;
    { const int tok = F.tid >> 3, p8 = F.tid & 7; const bool first = (l0 + tok == 0);
      const bf16_t* cur = U + (T0 + tok) * NINP + UR; const bf16_t* prv = first ? cur : cur - NINP;
      const float pz = first ? 0.f : 1.f;
      u32x4 cw[3], pw[3]; u32x2 c1 = (u32x2){0u, 0u}, p1 = (u32x2){0u, 0u}, c2 = (u32x2){0u, 0u}, p2 = (u32x2){0u, 0u}; u32x4 c3 = (u32x4){0u, 0u, 0u, 0u}, p3 = (u32x4){0u, 0u, 0u, 0u};
#pragma unroll
      for (int sec = (STAGE == 1 ? 0 : 2); sec < 3; ++sec) { const int co = sec * 256 + h * 64 + 8 * p8; cw[sec] = *(const u32x4*)(cur + co); pw[sec] = *(const u32x4*)(prv + co); }
      if (STAGE == 1) { c1 = *(const u32x2*)(cur + 768 + 4 * p8); p1 = *(const u32x2*)(prv + 768 + 4 * p8); c2 = *(const u32x2*)(cur + 800 + 4 * p8); p2 = *(const u32x2*)(prv + 800 + 4 * p8); }
      if (STAGE == 3) { c3 = *(const u32x4*)(cur + 832 + 8 * p8); p3 = *(const u32x4*)(prv + 832 + 8 * p8); }
#pragma unroll
      for (int sec = (STAGE == 1 ? 0 : 2); sec < 3; ++sec) { const int co = sec * 256 + h * 64 + 8 * p8; float av[8], pq[8]; unpack8(cw[sec], av); unpack8(pw[sec], pq);
          const f32x4 m0 = *(const f32x4*)(mu + co), m1 = *(const f32x4*)(mu + co + 4);
          LAS float* dst = (sec == 0 ? Rr : sec == 1 ? Kk : Vv) + tok * 64 + 8 * p8;
#pragma unroll
          for (int j = 0; j < 8; ++j) pq[j] *= pz;
          *(LAS f32x4*)dst = (f32x4){av[0] + m0[0] * (pq[0] - av[0]), av[1] + m0[1] * (pq[1] - av[1]), av[2] + m0[2] * (pq[2] - av[2]), av[3] + m0[3] * (pq[3] - av[3])};
          *(LAS f32x4*)(dst + 4) = (f32x4){av[4] + m1[0] * (pq[4] - av[4]), av[5] + m1[1] * (pq[5] - av[5]), av[6] + m1[2] * (pq[6] - av[6]), av[7] + m1[3] * (pq[7] - av[7])}; }
      if (STAGE == 1) {
#pragma unroll
        for (int which = 0; which < 2; ++which) { const int co = 768 + 32 * which + 4 * p8; const u32x2 cv = which ? c2 : c1, pv = which ? p2 : p1;
          const f32x4 m0 = *(const f32x4*)(mu + co);
          float x[4] = {__uint_as_float(cv.x << 16), __uint_as_float(cv.x & 0xffff0000u), __uint_as_float(cv.y << 16), __uint_as_float(cv.y & 0xffff0000u)};
          const float y[4] = {pz * __uint_as_float(pv.x << 16), pz * __uint_as_float(pv.x & 0xffff0000u), pz * __uint_as_float(pv.y << 16), pz * __uint_as_float(pv.y & 0xffff0000u)};
#pragma unroll
          for (int j = 0; j < 4; ++j) { x[j] = x[j] + m0[j] * (y[j] - x[j]); if (which == 0) x[j] = tanhf_(x[j]); }
          *(LAS u32x2*)((which ? DAb : TWb) + tok * 40 + 4 * p8) = (u32x2){pk2(x[0], x[1]), pk2(x[2], x[3])}; } }
      if (STAGE == 3) { const int co = 832 + 8 * p8; float av[8], pq[8]; unpack8(c3, av); unpack8(p3, pq);
          const f32x4 m0 = *(const f32x4*)(mu + co), m1 = *(const f32x4*)(mu + co + 4); float x[8];
#pragma unroll
          for (int j = 0; j < 8; ++j) x[j] = sigmoidf_(av[j] + (j < 4 ? m0[j] : m1[j - 4]) * (pz * pq[j] - av[j]));
          *(LAS u32x4*)(SGb + tok * RB_LD + 8 * p8) = (u32x4){pk2(x[0], x[1]), pk2(x[2], x[3]), pk2(x[4], x[5]), pk2(x[6], x[7])}; } }
    { const int ch = F.tid & 63, part = F.tid >> 6;
      if (STAGE == 1) { const float* w2 = F.in[I_RW2] + ((size_t)layer * 32 + 4 * part) * 256 + h * 64 + ch;
          *(LAS u32x2*)(w2T + ch * 40 + 4 * part) = (u32x2){pk2(w2[0], w2[256]), pk2(w2[512], w2[768])}; }
      if (STAGE == 1) { const float* a2 = F.in[I_RA2] + ((size_t)layer * 32 + 4 * part) * 256 + h * 64 + ch;
          *(LAS u32x2*)(a2T + ch * 40 + 4 * part) = (u32x2){pk2(a2[0], a2[256]), pk2(a2[512], a2[768])}; }
      if (STAGE == 3) { const float* g2 = F.in[I_RG2] + ((size_t)layer * 64 + 8 * part) * 256 + h * 64 + ch;
          *(LAS u32x4*)(g2T + ch * RB_LD + 8 * part) = (u32x4){pk2(g2[0], g2[256]), pk2(g2[512], g2[768]), pk2(g2[1024], g2[1280]), pk2(g2[1536], g2[1792])}; } }
    __syncthreads();
    { const int lane = F.lane, mt = F.wave >> 1, nt0 = 2 * (F.wave & 1), r = lane & 15, g4 = lane >> 4; const f32x4 zero4 = (f32x4){0.f, 0.f, 0.f, 0.f};
#pragma unroll
      for (int q = 0; q < 2; ++q) { const int nt = nt0 + q, ch = 16 * nt + r, cg = layer * 256 + h * 64 + ch;
          if (STAGE == 1) { const f32x4 wl = mma_nt<32>(TWb + 16 * mt * 40, 40, w2T + 16 * nt * 40, 40, zero4, lane); const float w0 = F.in[I_RW0][cg];
#pragma unroll
              for (int i = 0; i < 4; ++i) { const float x = w0 + wl[i]; const float wlog = -__logf(1.0f + __expf(-x)) - 0.5f; Ww[(16 * mt + 4 * g4 + i) * 64 + ch] = __expf(-__expf(wlog)); } }
          if (STAGE == 1) { const f32x4 al = mma_nt<32>(DAb + 16 * mt * 40, 40, a2T + 16 * nt * 40, 40, zero4, lane); const float a0 = F.in[I_RA0][cg];
#pragma unroll
              for (int i = 0; i < 4; ++i) Aa[(16 * mt + 4 * g4 + i) * 64 + ch] = sigmoidf_(a0 + al[i]); }
          if (STAGE == 3) { const f32x4 gv = mma_nt<64>(SGb + 16 * mt * RB_LD, RB_LD, g2T + 16 * nt * RB_LD, RB_LD, zero4, lane);
#pragma unroll
              for (int i = 0; i < 4; ++i) Gg[(16 * mt + 4 * g4 + i) * 64 + ch] = gv[i]; } } }
    __syncthreads();
    float* gBON = (float*)(F.ws + WS_BON) + ((size_t)(b * 4 + h) * 64 + c) * 64;
    if (STAGE == 1) { const int j = F.lane, tq = F.wave, cg = layer * 256 + h * 64 + j;
      const float kkw = F.in[I_RKK][cg], kaw = F.in[I_RKA][cg], rk = F.in[I_RRK][cg];
#pragma unroll 2
      for (int i8 = 0; i8 < 8; ++i8) { const int t = tq + 8 * i8;
          const float a = Aa[t * 64 + j]; const float kraw = Kk[t * 64 + j]; const float kp = kraw * (1.0f + (a - 1.0f) * kaw);
          Kk[t * 64 + j] = kp;
          const float kkv = kraw * kkw; const float ss = wave_sum(kkv * kkv); const float kkn = kkv * rsqrtf(fmaxf(ss, 1e-24f)); Aa[t * 64 + j] = -kkn; Bb[t * 64 + j] = kkn * a;
          const float bo = wave_sum(Rr[t * 64 + j] * kp * rk); if (j == 0) gBON[t] = bo; } }
    else if (F.tid < 64) BON[F.tid] = gBON[F.tid];
    __syncthreads();
}
constexpr int RB_AT = 98304, RB_ATT = RB_AT + 9216, RB_BT = RB_ATT + 9216, RB_BTT = RB_BT + 9216, RB_KT = RB_BTT + 9216, RB_RT = RB_KT + 9216, RB_VT = RB_RT + 9216, RB_GC = RB_VT + 9216;
constexpr int RX_X = 0, RX_XT = 9216, RX_TB = 18432, RX_M = 27648, RX_NRT = 36864, RX_G1T = 46080, RX_G2T = 55296, RX_QT = 64512;
__device__ __forceinline__ void st_tile(LAS bf16_t* dst, int mt, int nt, const f32x4 v, int lane) {
    const int r = lane & 15, g = lane >> 4;
#pragma unroll
    for (int i = 0; i < 4; ++i) dst[(16 * mt + 4 * g + i) * RB_LD + 16 * nt + r] = f2bf(v[i]);
}
__device__ __forceinline__ void st_tile_t(LAS bf16_t* dst, int mt, int nt, const f32x4 v, int lane) {
    const int r = lane & 15, g = lane >> 4; u32x2 w; w.x = pk2(v[0], v[1]); w.y = pk2(v[2], v[3]);
    *(LAS u32x2*)(dst + (16 * nt + r) * RB_LD + 16 * mt + 4 * g) = w;
}
__device__ __forceinline__ void item_rwkv1(const Frame& F_, int layer, int item) { Frame F = relocal(F_);
    const int b = item >> 8, h = (item >> 6) & 3, c = item & 63;
    rwkv_prep<1>(F, layer, b, h, c);
    LAS float* Rr = (LAS float*)(F.lds + RW_R); LAS float* Kk = (LAS float*)(F.lds + RW_K); LAS float* Vv = (LAS float*)(F.lds + RW_V); LAS float* Ww = (LAS float*)(F.lds + RW_W);
    LAS float* Aa = (LAS float*)(F.lds + RW_A); LAS float* Bb = (LAS float*)(F.lds + RW_B);
    LAS bf16_t* At = (LAS bf16_t*)(F.lds + RB_AT); LAS bf16_t* AtT = (LAS bf16_t*)(F.lds + RB_ATT); LAS bf16_t* Bt = (LAS bf16_t*)(F.lds + RB_BT); LAS bf16_t* BtT = (LAS bf16_t*)(F.lds + RB_BTT);
    LAS bf16_t* Kt = (LAS bf16_t*)(F.lds + RB_KT); LAS bf16_t* Rt = (LAS bf16_t*)(F.lds + RB_RT); LAS bf16_t* VT = (LAS bf16_t*)(F.lds + RB_VT); LAS float* gC = (LAS float*)(F.lds + RB_GC);
    LAS bf16_t* X = (LAS bf16_t*)(F.lds + RX_X); LAS bf16_t* XT = (LAS bf16_t*)(F.lds + RX_XT); LAS bf16_t* Tb = (LAS bf16_t*)(F.lds + RX_TB); LAS bf16_t* Mm = (LAS bf16_t*)(F.lds + RX_M);
    LAS bf16_t* NrT = (LAS bf16_t*)(F.lds + RX_NRT); LAS bf16_t* G1T = (LAS bf16_t*)(F.lds + RX_G1T); LAS bf16_t* G2T = (LAS bf16_t*)(F.lds + RX_G2T); LAS bf16_t* QT = (LAS bf16_t*)(F.lds + RX_QT);
    { const int k = F.tid & 63, part = F.tid >> 6; float g = 1.0f;
      for (int pp = 0; pp < part; ++pp) { float w8[8];
#pragma unroll
          for (int i = 0; i < 8; ++i) w8[i] = Ww[(8 * pp + i) * 64 + k];
          g *= ((w8[0] * w8[1]) * (w8[2] * w8[3])) * ((w8[4] * w8[5]) * (w8[6] * w8[7])); }
#pragma unroll
      for (int i = 0; i < 8; ++i) { const int t = 8 * part + i; const float gp = g; g *= Ww[t * 64 + k]; const float ig = 1.0f / g;
          const bf16_t av = f2bf(Aa[t * 64 + k] * gp), bv = f2bf(Bb[t * 64 + k] * ig);
          At[t * RB_LD + k] = av; AtT[k * RB_LD + t] = av; Bt[t * RB_LD + k] = bv; BtT[k * RB_LD + t] = bv;
          Kt[t * RB_LD + k] = f2bf(Kk[t * 64 + k] * ig); Rt[t * RB_LD + k] = f2bf(Rr[t * 64 + k] * g); VT[k * RB_LD + t] = f2bf(Vv[t * 64 + k]); }
      if (part == 7) gC[k] = g; }
    __syncthreads();
    const int lane = F.lane, mt = F.wave >> 1, nt0 = 2 * (F.wave & 1), r = lane & 15, g4 = lane >> 4;
    const f32x4 zero4 = (f32x4){0.f, 0.f, 0.f, 0.f};
    f32x4 Tacc[2];
#pragma unroll
    for (int q = 0; q < 2; ++q) { const int nt = nt0 + q;
        f32x4 n = mma_nt<64>(Bt + 16 * mt * RB_LD, RB_LD, At + 16 * nt * RB_LD, RB_LD, zero4, lane);
        f32x4 m = mma_nt<64>(Kt + 16 * mt * RB_LD, RB_LD, At + 16 * nt * RB_LD, RB_LD, zero4, lane);
        f32x4 nr = mma_nt<64>(Rt + 16 * mt * RB_LD, RB_LD, Bt + 16 * nt * RB_LD, RB_LD, zero4, lane);
#pragma unroll
        for (int i = 0; i < 4; ++i) { const int row = 16 * mt + 4 * g4 + i, col = 16 * nt + r;
            n[i] = (row < col) ? n[i] : 0.f; m[i] = (row < col) ? m[i] : 0.f; nr[i] = (col <= row) ? nr[i] : 0.f;
            Tacc[q][i] = n[i] + (row == col ? 1.0f : 0.f); }
        st_tile(X, mt, nt, n, lane); st_tile_t(XT, mt, nt, n, lane); st_tile(Tb, mt, nt, Tacc[q], lane); st_tile(Mm, mt, nt, m, lane); st_tile(NrT, mt, nt, nr, lane); }
    __syncthreads();
#pragma unroll 1
    for (int it = 0; it < 6; ++it) {
        LAS bf16_t* Xr = (it & 1) ? G1T : X; LAS bf16_t* XTr = (it & 1) ? G2T : XT; LAS bf16_t* Tr = (it & 1) ? QT : Tb;
        LAS bf16_t* Xw = (it & 1) ? X : G1T; LAS bf16_t* XTw = (it & 1) ? XT : G2T; LAS bf16_t* Tw = (it & 1) ? Tb : QT;
#pragma unroll
        for (int q = 0; q < 2; ++q) { const int nt = nt0 + q;
            if (it > 0) Tacc[q] = mma_nt<64>(Tr + 16 * mt * RB_LD, RB_LD, XTr + 16 * nt * RB_LD, RB_LD, Tacc[q], lane);
            if (it < 5) { const f32x4 x2 = mma_nt<64>(Xr + 16 * mt * RB_LD, RB_LD, XTr + 16 * nt * RB_LD, RB_LD, zero4, lane); st_tile(Xw, mt, nt, x2, lane); st_tile_t(XTw, mt, nt, x2, lane); }
            st_tile(Tw, mt, nt, Tacc[q], lane); }
        __syncthreads();
    }
#pragma unroll
    for (int q = 0; q < 2; ++q) { const int nt = nt0 + q;
        st_tile(G1T, mt, nt, mma_nt<64>(NrT + 16 * mt * RB_LD, RB_LD, Tb + 16 * nt * RB_LD, RB_LD, zero4, lane), lane);
        st_tile(G2T, mt, nt, mma_nt<64>(BtT + 16 * mt * RB_LD, RB_LD, Tb + 16 * nt * RB_LD, RB_LD, zero4, lane), lane); }
    __syncthreads();
    const size_t ci = (size_t)(b * 4 + h) * 64 + c;
    bf16_t* gPT = (bf16_t*)(F.ws + WS_MOE + RW_PT) + ci * 4096; bf16_t* gW1 = (bf16_t*)(F.ws + WS_MOE + RW_W1) + ci * 4096; bf16_t* gZ = (bf16_t*)(F.ws + WS_MOE + RW_Z) + ci * 4096;
#pragma unroll
    for (int q = 0; q < 2; ++q) { const int nt = nt0 + q; const int col = 16 * nt + r;
        f32x4 w1 = mma_nt<64>(G1T + 16 * mt * RB_LD, RB_LD, AtT + 16 * nt * RB_LD, RB_LD, zero4, lane);
        f32x4 z = mma_nt<64>(G1T + 16 * mt * RB_LD, RB_LD, Mm + 16 * nt * RB_LD, RB_LD, zero4, lane);
        f32x4 mr = mma_nt<64>(Rt + 16 * mt * RB_LD, RB_LD, Kt + 16 * nt * RB_LD, RB_LD, zero4, lane);
        f32x4 p = mma_nt<64>(G2T + 16 * mt * RB_LD, RB_LD, AtT + 16 * nt * RB_LD, RB_LD, zero4, lane);
        f32x4 qq = mma_nt<64>(G2T + 16 * mt * RB_LD, RB_LD, Mm + 16 * nt * RB_LD, RB_LD, zero4, lane);
        const int pos = 32 * (col >> 5) + 8 * ((col >> 2) & 3) + 4 * ((col >> 4) & 1) + (col & 3);
#pragma unroll
        for (int i = 0; i < 4; ++i) { const int row = 16 * mt + 4 * g4 + i;
            gW1[row * 64 + col] = f2bf(w1[i] + bf2f(Rt[row * RB_LD + col]));
            gZ[row * 64 + col] = f2bf(z[i] + (col <= row ? mr[i] : 0.f));
            const float gc = gC[row];
            gPT[row * 64 + pos] = f2bf((p[i] + (row == col ? 1.0f : 0.f)) * gc);
            qq[i] = (qq[i] + bf2f(Kt[col * RB_LD + row])) * gc; }
        st_tile(QT, mt, nt, qq, lane); }
    __syncthreads();
    bf16_t* gU = (bf16_t*)(F.ws + WS_MOE + RW_U) + ci * 4096;
#pragma unroll
    for (int q = 0; q < 2; ++q) { const int nt = nt0 + q;
        const f32x4 u = mma_nt<64>(VT + 16 * mt * RB_LD, RB_LD, QT + 16 * nt * RB_LD, RB_LD, zero4, lane);
#pragma unroll
        for (int i = 0; i < 4; ++i) gU[(16 * mt + 4 * g4 + i) * 64 + 16 * nt + r] = f2bf(u[i]); }
}
__device__ __forceinline__ void item_rwkv_carry(const Frame& F_, int item) { Frame F = relocal(F_);
    const int bh = item * 2 + (F.wave >> 2), nt = F.wave & 3, r = F.lane & 15, g = F.lane >> 4;
    const bf16_t* PT = (const bf16_t*)(F.ws + WS_MOE + RW_PT); const bf16_t* Uc = (const bf16_t*)(F.ws + WS_MOE + RW_U); bf16_t* Ss = (bf16_t*)(F.ws + WS_MOE + RW_S);
    f32x4 acc[4];
#pragma unroll
    for (int m = 0; m < 4; ++m) acc[m] = (f32x4){0.f, 0.f, 0.f, 0.f};
    for (int c = 0; c < 64; ++c) { const size_t ci = (size_t)bh * 64 + c;
        bf16x8 af[4][2]; f32x4 cin[4];
#pragma unroll
        for (int m = 0; m < 4; ++m) { const u32x2 uv = *(const u32x2*)(Uc + ci * 4096 + (16 * nt + r) * 64 + 16 * m + 4 * g);
            cin[m] = (f32x4){__uint_as_float(uv.x << 16), __uint_as_float(uv.x & 0xffff0000u), __uint_as_float(uv.y << 16), __uint_as_float(uv.y & 0xffff0000u)};
#pragma unroll
            for (int s = 0; s < 2; ++s) af[m][s] = *(const bf16x8*)(PT + ci * 4096 + (16 * m + r) * 64 + 32 * s + 8 * g); }
        unsigned pw[4][2];
#pragma unroll
        for (int m = 0; m < 4; ++m) { pw[m][0] = pk2(acc[m][0], acc[m][1]); pw[m][1] = pk2(acc[m][2], acc[m][3]);
            *(u32x2*)(Ss + ci * 4096 + (16 * nt + r) * 64 + 16 * m + 4 * g) = (u32x2){pw[m][0], pw[m][1]}; }
        bf16x8 bfr[2];
#pragma unroll
        for (int s = 0; s < 2; ++s) bfr[s] = __builtin_bit_cast(bf16x8, (u32x4){pw[2 * s][0], pw[2 * s][1], pw[2 * s + 1][0], pw[2 * s + 1][1]});
#pragma unroll
        for (int m = 0; m < 4; ++m) { acc[m] = __builtin_amdgcn_mfma_f32_16x16x32_bf16(af[m][0], bfr[0], cin[m], 0, 0, 0);
            acc[m] = __builtin_amdgcn_mfma_f32_16x16x32_bf16(af[m][1], bfr[1], acc[m], 0, 0, 0); }
    }
}
__device__ __forceinline__ void item_rwkv3(const Frame& F_, int layer, int item) { Frame F = relocal(F_);
    const int b = item >> 8, h = (item >> 6) & 3, c = item & 63; const size_t T0 = (size_t)b * SEQ + c * 64;
    rwkv_prep<3>(F, layer, b, h, c);
    LAS float* Vv = (LAS float*)(F.lds + RW_V); LAS float* Oo = (LAS float*)(F.lds + R3_O);
    LAS float* Gg = (LAS float*)(F.lds + R3_G); LAS float* BON = (LAS float*)(F.lds + R3_BON);
    LAS bf16_t* S0b = (LAS bf16_t*)(F.lds + R3_TILES); LAS bf16_t* W1b = S0b + 4608; LAS bf16_t* Zb = W1b + 4608; LAS bf16_t* VTb = Zb + 4608;
    { const size_t ci = (size_t)(b * 4 + h) * 64 + c; const int row = F.tid >> 3, col = (F.tid & 7) * 8;
      *(LAS u32x4*)(S0b + row * RB_LD + col) = *(const u32x4*)((const bf16_t*)(F.ws + WS_MOE + RW_S) + ci * 4096 + F.tid * 8);
      *(LAS u32x4*)(W1b + row * RB_LD + col) = *(const u32x4*)((const bf16_t*)(F.ws + WS_MOE + RW_W1) + ci * 4096 + F.tid * 8);
      *(LAS u32x4*)(Zb + row * RB_LD + col) = *(const u32x4*)((const bf16_t*)(F.ws + WS_MOE + RW_Z) + ci * 4096 + F.tid * 8);
      const int vv = F.tid & 63, part = F.tid >> 6;
#pragma unroll
      for (int i = 0; i < 8; ++i) { const int t = 8 * part + i; VTb[vv * RB_LD + t] = f2bf(Vv[t * 64 + vv]); } }
    __syncthreads();
    { const int lane = F.lane, mt = F.wave >> 1, nt0 = 2 * (F.wave & 1), r = lane & 15, g4 = lane >> 4;
#pragma unroll
      for (int q = 0; q < 2; ++q) { const int nt = nt0 + q;
          f32x4 o = mma_nt<64>(W1b + 16 * mt * RB_LD, RB_LD, S0b + 16 * nt * RB_LD, RB_LD, (f32x4){0.f, 0.f, 0.f, 0.f}, lane);
          o = mma_nt<64>(Zb + 16 * mt * RB_LD, RB_LD, VTb + 16 * nt * RB_LD, RB_LD, o, lane);
#pragma unroll
          for (int i = 0; i < 4; ++i) Oo[(16 * mt + 4 * g4 + i) * 64 + 16 * nt + r] = o[i]; } }
    __syncthreads();
    { const int j = F.lane, tq = F.wave, ch = h * 64 + j;
      const float lw = F.in[I_RLNW][layer * 256 + ch], lb = F.in[I_RLNB][layer * 256 + ch];
      bf16_t* Y = (bf16_t*)(F.ws + WS_H);
#pragma unroll 2
      for (int i8 = 0; i8 < 8; ++i8) { const int t = tq + 8 * i8;
          const float o = Oo[t * 64 + j]; const float mean = wave_sum(o) * (1.0f / 64.0f); const float d = o - mean; const float var = wave_sum(d * d) * (1.0f / 64.0f);
          float on = d * rsqrtf(var + 64e-5f) * lw + lb; on += BON[t] * Vv[t * 64 + j];
          Y[(T0 + t) * DM + 256 + ch] = f2bf(on * Gg[t * 64 + j]); } }
}

constexpr int DS_SEL = 131072, DS_HIST = 135168, DS_BKT = 151552, DS_BIAS = 152064;
__device__ __forceinline__ void dsa_tables(const Frame& F_) { Frame F = relocal(F_);
    LAS int* bkt = (LAS int*)(F.lds + DS_BKT); LAS float* biasT = (LAS float*)(F.lds + DS_BIAS);
    if (F.tid < 128) { const int n = F.tid; int bk = n; if (n >= 16) { const float lr = logf((float)n / 16.0f) / 2.0794415416798357f; bk = 16 + (int)(lr * 16.0f); bk = bk < 31 ? bk : 31; } bkt[n] = bk; biasT[n] = F.in[I_RELB][n]; }
    __syncthreads();
}
__device__ __forceinline__ unsigned fkey(float f) { const unsigned u = __float_as_uint(f); return (u & 0x80000000u) ? ~u : (u | 0x80000000u); }
__device__ __forceinline__ void item_dsa(const Frame& F_, int layer, int item) { Frame F = relocal(F_);
    const bf16_t* U = (const bf16_t*)(F.ws + WS_U); const bf16_t* KI = (const bf16_t*)(F.ws + WS_KIDX);
    const bf16_t* Kb = (const bf16_t*)(F.ws + WS_K); const bf16_t* Vb = (const bf16_t*)(F.ws + WS_V);
    const int b = item & 3, qg = 511 - (item >> 2); const size_t TB = (size_t)b * SEQ, T0 = TB + qg * 8;
    LAS float* sc = (LAS float*)F.lds; LAS unsigned short* selall = (LAS unsigned short*)(F.lds + DS_SEL); LAS unsigned* histall = (LAS unsigned*)(F.lds + DS_HIST);
    LAS int* bkt = (LAS int*)(F.lds + DS_BKT); LAS float* biasT = (LAS float*)(F.lds + DS_BIAS);
    const int lane = F.lane, hh = lane >> 5;
    {
        bf16x8 af[2][2]; float wq[2][2][8];
        { const int r = lane & 31, q4 = 2 * ((r >> 2) & 1) + (r >> 4), head = 4 * ((r >> 3) & 1) + (r & 3);
#pragma unroll
          for (int mt = 0; mt < 2; ++mt)
#pragma unroll
              for (int ks = 0; ks < 2; ++ks) af[mt][ks] = *(const bf16x8*)(U + (T0 + 4 * mt + q4) * NINP + UC + 384 + head * 32 + 16 * ks + 8 * hh); }
#pragma unroll
        for (int mt = 0; mt < 2; ++mt)
#pragma unroll
            for (int q2 = 0; q2 < 2; ++q2) { float f[8]; unpack8(*(const u32x4*)(U + (T0 + 4 * mt + 2 * hh + q2) * NINP + UC + 672), f);
#pragma unroll
                for (int hd = 0; hd < 8; ++hd) wq[mt][q2][hd] = f[hd]; }
        const int ntile = (qg * 8 + 8 + 31) >> 5;
        bf16x8 nb0 = af[0][0], nb1 = af[0][0];
        if (F.wave < ntile) { const int key = F.wave * 32 + (lane & 31); nb0 = *(const bf16x8*)(KI + (TB + key) * 32 + 8 * hh); nb1 = *(const bf16x8*)(KI + (TB + key) * 32 + 16 + 8 * hh); }
        for (int kt = F.wave; kt < ntile; kt += 8) {
            const int key = kt * 32 + (lane & 31);
            const bf16x8 b0 = nb0, b1 = nb1;
            if (kt + 8 < ntile) { const int k2 = key + 256; nb0 = *(const bf16x8*)(KI + (TB + k2) * 32 + 8 * hh); nb1 = *(const bf16x8*)(KI + (TB + k2) * 32 + 16 + 8 * hh); }
#pragma unroll
            for (int mt = 0; mt < 2; ++mt) { f32x16 acc;
#pragma unroll
                for (int i = 0; i < 16; ++i) acc[i] = 0.f;
                acc = __builtin_amdgcn_mfma_f32_32x32x16_bf16(af[mt][0], b0, acc, 0, 0, 0);
                acc = __builtin_amdgcn_mfma_f32_32x32x16_bf16(af[mt][1], b1, acc, 0, 0, 0);
#pragma unroll
                for (int q2 = 0; q2 < 2; ++q2) { float s = 0.f;
#pragma unroll
                    for (int hd = 0; hd < 8; ++hd) s += fmaxf(acc[8 * q2 + hd], 0.f) * wq[mt][q2][hd];
                    const int qi = 4 * mt + 2 * hh + q2;
                    sc[qi * 4096 + key] = (key <= qg * 8 + qi) ? s : -INFINITY; } }
        }
    }
    __syncthreads();
    const int qi = F.wave, tq = qg * 8 + qi, n = tq + 1;
    LAS float* scq = sc + qi * 4096; LAS unsigned short* sel = selall + qi * 256; LAS unsigned* hist = histall + qi * 512;
    int nsel;
    if (n <= 256) { nsel = n; for (int j = lane; j < 256; j += 64) sel[j] = (unsigned short)(j < n ? j : 0); }
    else {
        nsel = 256;
        const int R = (n + 63) >> 6; const unsigned long long ltm = (1ull << lane) - 1ull;
        float lo = INFINITY, hi = -INFINITY;
        const int R4 = (n + 255) >> 8;
#pragma unroll 4
        for (int i = 0; i < R4; ++i) { const int j0 = 256 * i + 4 * lane; const f32x4 v4 = *(const LAS f32x4*)(scq + j0);
#pragma unroll
            for (int q = 0; q < 4; ++q) { const bool valid = j0 + q < n; lo = fminf(lo, valid ? v4[q] : INFINITY); hi = fmaxf(hi, valid ? v4[q] : -INFINITY); } }
#pragma unroll
        for (int o = 1; o < 64; o <<= 1) { lo = fminf(lo, shx(lo, o)); hi = fmaxf(hi, shx(hi, o)); }
        bool slow = false;
        if (!(hi > lo)) { for (int j = lane; j < 256; j += 64) sel[j] = (unsigned short)j; }
        else {
            const float scale = 1023.0f / (hi - lo);
            *(LAS u32x4*)(hist + 8 * lane) = (u32x4){0u, 0u, 0u, 0u}; *(LAS u32x4*)(hist + 8 * lane + 4) = (u32x4){0u, 0u, 0u, 0u};
#pragma unroll 2
            for (int i = 0; i < R4; ++i) { const int j0 = 256 * i + 4 * lane; const f32x4 v4 = *(const LAS f32x4*)(scq + j0);
#pragma unroll
                for (int q = 0; q < 4; ++q) { if (j0 + q < n) { int bk = (int)((v4[q] - lo) * scale); bk = bk < 1023 ? bk : 1023;
                    atomicAdd((unsigned*)(hist + (bk >> 1)), (bk & 1) ? 65536u : 1u); } } }
            const u32x4 h0 = *(const LAS u32x4*)(hist + 8 * lane), h1 = *(const LAS u32x4*)(hist + 8 * lane + 4);
            unsigned cb[16];
            cb[0] = h0.x & 0xffffu; cb[1] = h0.x >> 16; cb[2] = h0.y & 0xffffu; cb[3] = h0.y >> 16; cb[4] = h0.z & 0xffffu; cb[5] = h0.z >> 16; cb[6] = h0.w & 0xffffu; cb[7] = h0.w >> 16;
            cb[8] = h1.x & 0xffffu; cb[9] = h1.x >> 16; cb[10] = h1.y & 0xffffu; cb[11] = h1.y >> 16; cb[12] = h1.z & 0xffffu; cb[13] = h1.z >> 16; cb[14] = h1.w & 0xffffu; cb[15] = h1.w >> 16;
            unsigned tot = 0u;
#pragma unroll
            for (int q = 0; q < 16; ++q) tot += cb[q];
            unsigned incl = tot;
#pragma unroll
            for (int o = 1; o < 64; o <<= 1) { const unsigned t = shdown_u(incl, o); if (lane + o < 64) incl += t; }
            int fb = -1; unsigned fabove = 0u, fcnt = 0u; unsigned cum = incl - tot;
#pragma unroll
            for (int q = 15; q >= 0; --q) { if (fb < 0 && cum < 256u && 256u <= cum + cb[q]) { fb = 16 * lane + q; fabove = cum; fcnt = cb[q]; } cum += cb[q]; }
            const unsigned long long mf = __ballot(fb >= 0); const int src = (int)__ffsll((long long)mf) - 1;
            const int B = shidx_i(fb, src); const int above = shidx_i((int)fabove, src), cntB = shidx_i((int)fcnt, src); const int need = 256 - above;
            if (cntB > 256) slow = true;
            else {
                LAS unsigned* cand = hist;
                int base_gt = 0, base_c = 0;
#pragma unroll 2
                for (int i = 0; i < R4; ++i) { const int j0 = 256 * i + 4 * lane; const f32x4 v4 = *(const LAS f32x4*)(scq + j0);
#pragma unroll
                    for (int q = 0; q < 4; ++q) { const int j = j0 + q; const bool valid = j < n; const float v = valid ? v4[q] : lo;
                        int bk = (int)((v - lo) * scale); bk = bk < 1023 ? bk : 1023;
                        const bool gt = valid && bk > B, eq = valid && bk == B;
                        const unsigned long long mg = __ballot(gt), me = __ballot(eq);
                        if (gt) sel[base_gt + __popcll(mg & ltm)] = (unsigned short)j;
                        if (eq) { const int p = base_c + __popcll(me & ltm); cand[2 * p] = fkey(v); cand[2 * p + 1] = (unsigned)j; }
                        base_gt += __popcll(mg); base_c += __popcll(me); } }
                if (need == cntB) { for (int c = lane; c < cntB; c += 64) sel[above + c] = (unsigned short)cand[2 * c + 1]; }
                else {
                    unsigned ck[4], cx[4]; int rk[4];
#pragma unroll
                    for (int q = 0; q < 4; ++q) { const int c = lane + 64 * q; ck[q] = c < cntB ? cand[2 * c] : 0u; cx[q] = c < cntB ? cand[2 * c + 1] : 0u; rk[q] = 0; }
                    for (int c2 = 0; c2 < cntB; ++c2) { const unsigned k2 = cand[2 * c2], x2 = cand[2 * c2 + 1];
#pragma unroll
                        for (int q = 0; q < 4; ++q) rk[q] += (k2 > ck[q] || (k2 == ck[q] && x2 < cx[q])) ? 1 : 0; }
#pragma unroll
                    for (int q = 0; q < 4; ++q) { const int c = lane + 64 * q; if (c < cntB && rk[q] < need) sel[above + rk[q]] = (unsigned short)cand[2 * c + 1]; }
                }
            }
        }
        if (slow) {
        unsigned prefix = 0u; int need = 256; unsigned neq = 0u;
        for (int p = 0; p < 4; ++p) { const int shift = 24 - 8 * p;
            *(LAS u32x4*)(hist + 4 * lane) = (u32x4){0u, 0u, 0u, 0u};
            for (int i = 0; i < R; ++i) { const int j = lane + 64 * i; if (j < n) { const unsigned u = fkey(scq[j]);
                if (p == 0 || (u >> (shift + 8)) == prefix) atomicAdd((unsigned*)(hist + ((u >> shift) & 255u)), 1u); } }
            const u32x4 hv = *(const LAS u32x4*)(hist + 4 * lane);
            const unsigned tot = hv.x + hv.y + hv.z + hv.w;
            unsigned incl = tot;
#pragma unroll
            for (int o = 1; o < 64; o <<= 1) { const unsigned t = shdown_u(incl, o); if (lane + o < 64) incl += t; }
            const unsigned above = incl - tot;
            int fb = -1; unsigned fabove = 0u, feq = 0u; unsigned cum = above;
            { const unsigned hq[4] = {hv.x, hv.y, hv.z, hv.w};
#pragma unroll
              for (int q = 3; q >= 0; --q) { if (fb < 0 && cum < (unsigned)need && (unsigned)need <= cum + hq[q]) { fb = 4 * lane + q; fabove = cum; feq = hq[q]; } cum += hq[q]; } }
            const unsigned long long m = __ballot(fb >= 0);
            const int src = (int)__ffsll((long long)m) - 1;
            const int bin = shidx_i(fb, src); const unsigned ab = (unsigned)shidx_i((int)fabove, src); neq = (unsigned)shidx_i((int)feq, src);
            need -= (int)ab; prefix = (prefix << 8) | (unsigned)bin;
        }
        const int ngt = 256 - need;
        int base_gt = 0, base_eq = 0;
        for (int i = 0; i < R; ++i) { const int j = lane + 64 * i; const unsigned u = (j < n) ? fkey(scq[j]) : 0u;
            const bool gt = (j < n) && (u > prefix), eq = (j < n) && (u == prefix);
            const unsigned long long mg = __ballot(gt), me = __ballot(eq); const unsigned long long lt = (1ull << lane) - 1ull;
            if (gt) sel[base_gt + __popcll(mg & lt)] = (unsigned short)j;
            if (eq) { const int rk = base_eq + __popcll(me & lt); if (rk < need) sel[ngt + rk] = (unsigned short)j; }
            base_gt += __popcll(mg); base_eq += __popcll(me); }
        (void)neq;
            }
    }
    const int nt16 = (nsel + 15) >> 4, r16 = lane & 15, g4 = lane >> 4;
    LAS float* biasj = scq + 2048;
#pragma unroll
    for (int q = 0; q < 4; ++q) { const int j = lane + 64 * q; f32x4 bv = (f32x4){-INFINITY, -INFINITY, -INFINITY, -INFINITY};
        if (j < nsel) { const int dist = tq - (int)sel[j]; const int bk = dist < 128 ? bkt[dist < 0 ? 0 : dist] : 31; bv = *(const LAS f32x4*)(biasT + 4 * bk); }
        *(LAS f32x4*)(biasj + 4 * j) = bv; }
    bf16x8 qf[2];
#pragma unroll
    for (int s = 0; s < 2; ++s) { u32x4 z = (u32x4){0u, 0u, 0u, 0u}; if (r16 < 4) z = *(const u32x4*)(U + (T0 + qi) * NINP + UC + r16 * 64 + 32 * s + 8 * g4); qf[s] = __builtin_bit_cast(bf16x8, z); }
    float lg[16][4]; float mx = -INFINITY;
#define DSA_QK(M0, NM) do { int keyr[NM]; bf16x8 a0[NM], a1[NM]; \
        _Pragma("unroll") for (int m8 = 0; m8 < NM; ++m8) keyr[m8] = sel[16 * ((M0) + m8) + r16]; \
        _Pragma("unroll") for (int m8 = 0; m8 < NM; ++m8) { a0[m8] = *(const bf16x8*)(Kb + (TB + keyr[m8]) * 64 + 8 * g4); a1[m8] = *(const bf16x8*)(Kb + (TB + keyr[m8]) * 64 + 32 + 8 * g4); } \
        _Pragma("unroll") for (int m8 = 0; m8 < NM; ++m8) { const int m = (M0) + m8; \
            f32x4 acc = (f32x4){0.f, 0.f, 0.f, 0.f}; \
            acc = __builtin_amdgcn_mfma_f32_16x16x32_bf16(a0[m8], qf[0], acc, 0, 0, 0); \
            acc = __builtin_amdgcn_mfma_f32_16x16x32_bf16(a1[m8], qf[1], acc, 0, 0, 0); \
            _Pragma("unroll") for (int i = 0; i < 4; ++i) { const float v = acc[i] * 0.125f + biasj[(16 * m + 4 * g4 + i) * 4 + (r16 & 3)]; lg[m][i] = v; mx = fmaxf(mx, v); } } } while (0)
    if (nt16 > 8) { DSA_QK(0, 16); }
    else { DSA_QK(0, 8);
#pragma unroll
        for (int m8 = 8; m8 < 16; ++m8)
#pragma unroll
            for (int i = 0; i < 4; ++i) lg[m8][i] = -INFINITY; }
#undef DSA_QK
    mx = fmaxf(mx, shx(mx, 16)); mx = fmaxf(mx, shx(mx, 32));
    float sm = 0.f;
#pragma unroll
    for (int m = 0; m < 16; ++m)
#pragma unroll
        for (int i = 0; i < 4; ++i) { const float p = __expf(lg[m][i] - mx); lg[m][i] = p; sm += p; }
    sm += shx(sm, 16); sm += shx(sm, 32);
    f32x4 ov[4];
#pragma unroll
    for (int nt = 0; nt < 4; ++nt) ov[nt] = (f32x4){0.f, 0.f, 0.f, 0.f};
    const unsigned vs_base = (unsigned)(unsigned long)scq;
#pragma unroll
    for (int half = 0; half < 2; ++half) {
        if (half * 8 < nt16) {
            asm volatile("s_waitcnt lgkmcnt(0)" ::: "memory");
            int vkey[16];
#pragma unroll
            for (int q = 0; q < 16; ++q) { const int rho = 8 * q + (lane >> 3);
                vkey[q] = sel[half * 128 + (rho & ~31) + 16 * ((rho >> 2) & 1) + 4 * ((rho >> 3) & 3) + (rho & 3)]; }
            asm volatile("s_waitcnt lgkmcnt(0)" : "+v"(vkey[0]), "+v"(vkey[1]), "+v"(vkey[2]), "+v"(vkey[3]), "+v"(vkey[4]), "+v"(vkey[5]), "+v"(vkey[6]), "+v"(vkey[7]),
                         "+v"(vkey[8]), "+v"(vkey[9]), "+v"(vkey[10]), "+v"(vkey[11]), "+v"(vkey[12]), "+v"(vkey[13]), "+v"(vkey[14]), "+v"(vkey[15]) :: "memory");
#pragma unroll
            for (int q = 0; q < 16; ++q)
                __builtin_amdgcn_global_load_lds((const unsigned*)(Vb + (TB + vkey[q]) * 64 + 8 * (lane & 7)), (LAS unsigned*)((LAS unsigned char*)scq + q * 1024), 16, 0, 0);
            asm volatile("s_waitcnt vmcnt(0)" ::: "memory");
#pragma unroll
            for (int s4 = 0; s4 < 4; ++s4) { const int s = half * 4 + s4;
                u32x4 pw; pw.x = pk2(lg[2 * s][0], lg[2 * s][1]); pw.y = pk2(lg[2 * s][2], lg[2 * s][3]); pw.z = pk2(lg[2 * s + 1][0], lg[2 * s + 1][1]); pw.w = pk2(lg[2 * s + 1][2], lg[2 * s + 1][3]);
                const bf16x8 pa = __builtin_bit_cast(bf16x8, pw);
                const unsigned ad = vs_base + (unsigned)((32 * s4 + 8 * g4 + (r16 >> 2)) * 128 + (r16 & 3) * 8);
                u32x2 t0[4], t1[4];
                asm volatile("ds_read_b64_tr_b16 %0, %8\n\tds_read_b64_tr_b16 %1, %8 offset:512\n\tds_read_b64_tr_b16 %2, %8 offset:32\n\tds_read_b64_tr_b16 %3, %8 offset:544\n\t"
                             "ds_read_b64_tr_b16 %4, %8 offset:64\n\tds_read_b64_tr_b16 %5, %8 offset:576\n\tds_read_b64_tr_b16 %6, %8 offset:96\n\tds_read_b64_tr_b16 %7, %8 offset:608\n\ts_waitcnt lgkmcnt(0)"
                             : "=&v"(t0[0]), "=&v"(t1[0]), "=&v"(t0[1]), "=&v"(t1[1]), "=&v"(t0[2]), "=&v"(t1[2]), "=&v"(t0[3]), "=&v"(t1[3]) : "v"(ad) : "memory");
#pragma unroll
                for (int nt = 0; nt < 4; ++nt) { const bf16x8 vb = __builtin_bit_cast(bf16x8, (u32x4){t0[nt].x, t0[nt].y, t1[nt].x, t1[nt].y});
                    ov[nt] = __builtin_amdgcn_mfma_f32_16x16x32_bf16(pa, vb, ov[nt], 0, 0, 0); } }
        }
    }
    { float inv[4];
#pragma unroll
      for (int h = 0; h < 4; ++h) inv[h] = 1.0f / __int_as_float(__builtin_amdgcn_readlane(__float_as_int(sm), h));
      if (lane < 16) { bf16_t* Y = (bf16_t*)(F.ws + WS_H) + (T0 + qi) * DM + 512 + r16;
#pragma unroll
          for (int h = 0; h < 4; ++h)
#pragma unroll
              for (int nt = 0; nt < 4; ++nt) Y[h * 64 + 16 * nt] = f2bf(ov[nt][h] * inv[h]); } }
}

__device__ __forceinline__ void phase_router(const Frame& F_, int layer) { Frame F = relocal(F_); const int cset = layer;
    const float* X = (const float*)(F.ws + WS_X);
    const bf16_t* WH = (const bf16_t*)(F.ws + WS_WRT) + (size_t)layer * 2 * 49152; const bf16_t* WL = WH + 49152;
    LAS float* part = (LAS float*)F.lds;
    LAS float* ssq = (LAS float*)(F.lds + 24576);
    LAS int* es = (LAS int*)(F.lds + 25088);
    LAS int* lr = (LAS int*)(F.lds + 25600);
    LAS float* wsl = (LAS float*)(F.lds + 26112);
    LAS float* rsd = (LAS float*)(F.lds + 26624);
    for (int blk = F.bid; blk < NTOK / 64; blk += F.G) {
        __syncthreads();
        const int mt = F.wave & 3, kh = F.wave >> 2, r16 = F.lane & 15, g4 = F.lane >> 4;
        const float* xr = X + ((size_t)blk * 64 + mt * 16 + r16) * DM + kh * 512 + 8 * g4;
        f32x4 acc[3]; acc[0] = acc[1] = acc[2] = (f32x4){0.f, 0.f, 0.f, 0.f}; float ss = 0.f;
#pragma unroll 4
        for (int ks = 0; ks < 16; ++ks) {
            const f32x4 xa = *(const f32x4*)(xr + ks * 32), xb = *(const f32x4*)(xr + ks * 32 + 4);
            ss += xa[0] * xa[0] + xa[1] * xa[1] + xa[2] * xa[2] + xa[3] * xa[3] + xb[0] * xb[0] + xb[1] * xb[1] + xb[2] * xb[2] + xb[3] * xb[3];
            float xv[8] = {xa[0], xa[1], xa[2], xa[3], xb[0], xb[1], xb[2], xb[3]}; unsigned hw[4], lw[4];
#pragma unroll
            for (int j = 0; j < 4; ++j) { const bf16_t h0 = f2bf(xv[2 * j]), h1 = f2bf(xv[2 * j + 1]); hw[j] = (unsigned)h0 | ((unsigned)h1 << 16);
                lw[j] = pk2(xv[2 * j] - bf2f(h0), xv[2 * j + 1] - bf2f(h1)); }
            const bf16x8 ahi = __builtin_bit_cast(bf16x8, (u32x4){hw[0], hw[1], hw[2], hw[3]}), alo = __builtin_bit_cast(bf16x8, (u32x4){lw[0], lw[1], lw[2], lw[3]});
#pragma unroll
            for (int nt = 0; nt < 3; ++nt) { const size_t wo = (size_t)(nt * 16 + r16) * 1024 + kh * 512 + ks * 32 + 8 * g4;
                const bf16x8 bh = *(const bf16x8*)(WH + wo), bl = *(const bf16x8*)(WL + wo);
                acc[nt] = __builtin_amdgcn_mfma_f32_16x16x32_bf16(ahi, bh, acc[nt], 0, 0, 0);
                acc[nt] = __builtin_amdgcn_mfma_f32_16x16x32_bf16(ahi, bl, acc[nt], 0, 0, 0);
                acc[nt] = __builtin_amdgcn_mfma_f32_16x16x32_bf16(alo, bh, acc[nt], 0, 0, 0); }
        }
        ss += shx(ss, 16); ss += shx(ss, 32);
        if (g4 == 0) ssq[kh * 64 + mt * 16 + r16] = ss;
#pragma unroll
        for (int nt = 0; nt < 3; ++nt)
#pragma unroll
            for (int i = 0; i < 4; ++i) part[(kh * 64 + mt * 16 + 4 * g4 + i) * 48 + nt * 16 + r16] = acc[nt][i];
        __syncthreads();
        if (F.tid < 64) { const float rstd = rsqrtf((ssq[F.tid] + ssq[64 + F.tid]) * (1.0f / DM) + 1e-6f); rsd[F.tid] = rstd;
            float l[36];
#pragma unroll
            for (int o = 0; o < 36; ++o) l[o] = (part[F.tid * 48 + o] + part[(64 + F.tid) * 48 + o]) * rstd + (o < 32 ? F.in[I_BRE][layer * 32 + o] : F.in[I_BRG][layer * 4 + o - 32]);
            int gs = 0; float gm = l[32];
#pragma unroll
            for (int j = 1; j < 4; ++j) if (l[32 + j] > gm) { gm = l[32 + j]; gs = j; }
            float den = 0.f;
#pragma unroll
            for (int j = 0; j < 4; ++j) den += __expf(l[32 + j] - gm);
            const float gate = 1.0f / den;
            float e8[8];
#pragma unroll
            for (int j = 0; j < 8; ++j) e8[j] = gs == 0 ? l[j] : gs == 1 ? l[8 + j] : gs == 2 ? l[16 + j] : l[24 + j];
            int i1 = 0; float v1 = e8[0];
#pragma unroll
            for (int j = 1; j < 8; ++j) if (e8[j] > v1) { v1 = e8[j]; i1 = j; }
            int i2 = -1; float v2 = -INFINITY;
#pragma unroll
            for (int j = 0; j < 8; ++j) if (j != i1 && e8[j] > v2) { v2 = e8[j]; i2 = j; }
            const float e2 = __expf(v2 - v1); const float p1 = 1.0f / (1.0f + e2);
            es[F.tid * 2] = gs * 8 + i1; es[F.tid * 2 + 1] = gs * 8 + i2; wsl[F.tid * 2] = p1 * gate; wsl[F.tid * 2 + 1] = (1.0f - p1) * gate; }
        __syncthreads();
        if (F.tid < 32) { int cnt = 0; for (int i = 0; i < 128; ++i) if (es[i] == F.tid) lr[i] = cnt++;
            if (cnt) { const int base = (int)__hip_atomic_fetch_add(F.ctl + CW_CNT + cset * 32 + F.tid, (unsigned)cnt, __ATOMIC_RELAXED, __HIP_MEMORY_SCOPE_AGENT);
                for (int i = 0; i < 128; ++i) if (es[i] == F.tid) lr[i] += base; } }
        __syncthreads();
        if (F.tid < 64) { int* rt = (int*)(F.ws + WS_ROUTE) + ((size_t)blk * 64 + F.tid) * 8;
            rt[0] = es[F.tid * 2]; rt[1] = es[F.tid * 2 + 1]; ((float*)rt)[2] = wsl[F.tid * 2]; ((float*)rt)[3] = wsl[F.tid * 2 + 1]; rt[4] = lr[F.tid * 2]; rt[5] = lr[F.tid * 2 + 1]; ((float*)rt)[6] = rsd[F.tid]; }
    }
    __syncthreads();
    if (F.tid == 0) __hip_atomic_fetch_add(F.ctl + CW_RB + 64 * layer, 1u, __ATOMIC_RELAXED, __HIP_MEMORY_SCOPE_AGENT);
}
__device__ __forceinline__ void phase_moe_convert(const Frame& F_, int layer) { Frame F = relocal(F_);
    bf16_t* WGU = (bf16_t*)(F.ws + WS_MOE + MOE_WGU);
    for (int t = F.bid; t < 1024; t += F.G) {
        const int e = t >> 5, r = t & 31, kt = r >> 1, nt = r & 1; const size_t eo = ((size_t)layer * 32 + e) * 1024 * 256;
        tr_tile(F, 256, WGU + (size_t)e * 512 * 1024, 1024, kt * 64, nt * 256, SmGU{F.in[I_WGATE] + eo, F.in[I_WUP] + eo}); }
}
__device__ __forceinline__ void phase_moe_convert_down(const Frame& F_, int layer) { Frame F = relocal(F_);
    bf16_t* WD = (bf16_t*)(F.ws + WS_MOE + MOE_WD);
    for (;;) { const int q = q_pop(F, 32 + layer); if (q >= 512) break;
        const int e = q >> 4, r = q & 15, kt = r >> 2, nt = r & 3;
        tr_tile(F, 1024, WD + (size_t)e * 1024 * 256, 256, kt * 64, nt * 256, SmId{F.in[I_WDOWN] + ((size_t)layer * 32 + e) * 256 * 1024}); }
}
__device__ __forceinline__ void phase_gather(const Frame& F_, int layer) { Frame F = relocal(F_);
    LAS int* off = (LAS int*)F.lds;
    __syncthreads();
    if (F.tid == 0) { unsigned sp = 0;
        while (__hip_atomic_load(F.ctl + CW_RB + 64 * layer, __ATOMIC_RELAXED, __HIP_MEMORY_SCOPE_AGENT) < (unsigned)F.G) { __builtin_amdgcn_s_sleep(2); if (++sp > (1u << 22)) break; } }
    __syncthreads();
    if (F.tid == 0) { int acc = 0; for (int e = 0; e < 32; ++e) { off[e] = acc; const int c = (int)__hip_atomic_load(F.ctl + CW_CNT + layer * 32 + e, __ATOMIC_RELAXED, __HIP_MEMORY_SCOPE_AGENT); acc += (c + 255) & ~255; } off[32] = acc; }
    __syncthreads();
    int* tiles = (int*)(F.ws + WS_TILES); int* row_tok = (int*)(F.ws + WS_ROWS); float* row_w = (float*)(F.ws + WS_ROWS) + MAXROWS;
    if (F.bid == 0) { if (F.tid == 0) tiles[0] = off[32] >> 8; if (F.tid < 33) tiles[1 + F.tid] = off[F.tid];
        if (F.tid < 32) for (int rt = off[F.tid] >> 8; rt < (off[F.tid + 1] >> 8); ++rt) tiles[64 + rt] = F.tid; }
    for (int e = F.bid; e < 32; e += F.G) { const int c = (int)__hip_atomic_load(F.ctl + CW_CNT + layer * 32 + e, __ATOMIC_RELAXED, __HIP_MEMORY_SCOPE_AGENT);
        for (int r = off[e] + c + F.tid; r < off[e + 1]; r += NTHR) { row_tok[r] = -1; row_w[r] = 0.f; } }
    const float* X = (const float*)(F.ws + WS_X); bf16_t* HP = (bf16_t*)(F.ws + WS_U); const float* nw = F.in[I_NORM2] + (size_t)layer * DM;
    f32x4 nwv[4];
#pragma unroll
    for (int j = 0; j < 4; ++j) nwv[j] = *(const f32x4*)(nw + 4 * F.lane + 256 * j);
    for (int blk = F.bid; blk < NTOK / 64; blk += F.G)
    for (int i4 = 0; i4 < 2; ++i4) {
        int p0[4], p1[4], tt[4]; float rstd[4], w0[4], w1[4]; f32x4 xv[4][4];
#pragma unroll
        for (int r = 0; r < 4; ++r) { const int t = blk * 64 + F.wave * 8 + 4 * i4 + r; tt[r] = t;
            const int* rt = (const int*)(F.ws + WS_ROUTE) + (size_t)t * 8; rstd[r] = ((const float*)rt)[6]; w0[r] = ((const float*)rt)[2]; w1[r] = ((const float*)rt)[3];
            p0[r] = off[rt[0]] + rt[4]; p1[r] = off[rt[1]] + rt[5];
#pragma unroll
            for (int j = 0; j < 4; ++j) xv[r][j] = *(const f32x4*)(X + (size_t)t * DM + 4 * F.lane + 256 * j); }
#pragma unroll
        for (int r = 0; r < 4; ++r) {
#pragma unroll
            for (int j = 0; j < 4; ++j) { const int c = 4 * F.lane + 256 * j; const f32x4 v = xv[r][j] * rstd[r] * nwv[j];
                u32x2 o; o.x = pk2(v[0], v[1]); o.y = pk2(v[2], v[3]);
                *(u32x2*)(HP + (size_t)p0[r] * DM + c) = o; *(u32x2*)(HP + (size_t)p1[r] * DM + c) = o; }
            if (F.lane == 0) { row_tok[p0[r]] = tt[r] * 2; row_w[p0[r]] = w0[r]; row_tok[p1[r]] = tt[r] * 2 + 1; row_w[p1[r]] = w1[r]; } }
    }
}

constexpr int NPH_LAYER = 9, NPHASE = 1 + 2 * NPH_LAYER + 1;
#ifndef MK_ONLY
#define MK_ONLY -1
#endif
#ifndef MK_ITEM
#define MK_ITEM -1
#endif
#define EN(o) (MK_ONLY < 0 || MK_ONLY == (o))
#define IT(o) (MK_ITEM < 0 || MK_ITEM == (o))
__global__ void __launch_bounds__(NTHR, 2) mk_forward(Params P) {
    extern __shared__ __attribute__((aligned(16))) unsigned char lds_raw[];
    Frame F; F.lds = (LAS unsigned char*)lds_raw; F.tid = threadIdx.x; F.lane = F.tid & 63; F.wave = __builtin_amdgcn_readfirstlane(F.tid >> 6); F.bid = blockIdx.x; F.G = gridDim.x;
    F.in = (in_tab_t)__builtin_amdgcn_kernarg_segment_ptr(); F.out = P.out; F.ws = P.ws; F.ctl = (unsigned*)(P.ws + WS_CTL); F.misc = (volatile LAS int*)(F.lds + MISC_OFF);
    if (F.tid < 64) ((LAS unsigned*)(F.lds + MISC_OFF))[F.tid] = 0u;
    __syncthreads();
    const int lo = P.ph_lo, hi = P.ph_hi;
    XcdBarrier bar; bar.bar = F.ctl + CW_BAR; bar.x = 0; bar.st = (volatile LAS unsigned*)(F.lds + MISC_OFF + 16);
    if (hi - lo > 1) bar = xcd_barrier_post(F.ctl + CW_BAR, (volatile LAS unsigned*)(F.lds + MISC_OFF + 16));
#define IN(k) (lo <= (k) && (k) < hi)
#define SEAM(k) do { if (IN(k) && IN((k) + 1)) xcd_barrier(bar); } while (0)
#define QLOOP(qi, n, body) for (;;) { const int it = q_pop(F, layer * 12 + (qi)); if (it >= (n)) break; body; }
    if (EN(100) && IN(0)) { phase_prologue(F); phase_norm(F, F.in[I_X], false, F.in[I_NORM1], 3); } SEAM(0);
#pragma unroll
    for (int layer = 0; layer < DEPTH; ++layer) {
        const int pb = 1 + layer * NPH_LAYER;
        if (layer > 0) { if (EN(0) && IN(pb + 0)) { phase_norm(F, (const float*)(F.ws + WS_X), true, F.in[I_NORM1] + (size_t)layer * DM, 0); } SEAM(pb + 0); }
        if (EN(1) && IN(pb + 1)) { const Frame F_ = F; Frame F = relocal(F_); pg8::StaticOrder S; S.init((const bf16_t*)(F.ws + WS_H), (const bf16_t*)(F.ws + WS_WIN) + (size_t)layer * NINP * DM, NTOK, NINP, DM, F.G, F.bid);
            pg8::EpiBf16 E{(bf16_t*)(F.ws + WS_U), NINP}; pg8::gemm_phase(F.lds, DM, S, E); } SEAM(pb + 1);
#define SLOOP(n, body) for (int it = F.bid; it < (n); it += F.G) { __syncthreads(); body; }
        if (EN(2) && IN(pb + 2)) {
            if (IT(1)) SLOOP(1024, item_rwkv1(F, layer, it));
            if (IT(0)) SLOOP(256, item_s5<1>(F, layer, it));
            if (IT(2)) SLOOP(256, item_mamba<1>(F, layer, it));
            if (IT(3)) SLOOP(256, item_kv(F, layer, it));
        } SEAM(pb + 2);
        if (EN(3) && IN(pb + 3)) {
            if (IT(0)) SLOOP(8, item_rwkv_carry(F, it));
            if (IT(1)) { for (int it = F.bid - 8; it >= 0 && it < 16; it += F.G) { __syncthreads(); item_mamba_carry(F, it); } }
            if (IT(2)) { for (int it = F.bid - 24; it >= 0 && it < 4; it += F.G) { __syncthreads(); item_s5_carry(F, layer, it); } }
            if (IT(3)) {
                dsa_tables(F);
                const int pref = (int)(xb_xcc_id() & 3u);
#pragma unroll 1
                for (int k4 = 0; k4 < 4; ++k4) { const int bq = (pref + k4) & 3;
                    for (;;) { const int it = q_pop(F, 24 + layer * 4 + bq); if (it >= 512) break; item_dsa(F, layer, it * 4 + bq); } } }
        } SEAM(pb + 3);
        if (EN(4) && IN(pb + 4)) {
            if (IT(0)) SLOOP(256, item_s5<2>(F, layer, it));
            if (IT(2)) SLOOP(256, item_mamba<2>(F, layer, it));
            if (IT(1)) SLOOP(1024, item_rwkv3(F, layer, it));
        } SEAM(pb + 4);
        if (EN(6) && IN(pb + 5)) { const Frame F_ = F; Frame F = relocal(F_); pg8::StaticOrder S; S.init((const bf16_t*)(F.ws + WS_H), (const bf16_t*)(F.ws + WS_WOUT) + (size_t)layer * DM * DM, NTOK, DM, DM, F.G, F.bid);
            pg8::EpiResid E{layer == 0 ? F.in[I_X] : (const float*)(F.ws + WS_X), (float*)(F.ws + WS_X), DM}; pg8::gemm_phase(F.lds, DM, S, E); } SEAM(pb + 5);
        if (EN(7) && IN(pb + 6)) { phase_router(F, layer); phase_moe_convert(F, layer); phase_gather(F, layer); } SEAM(pb + 6);
        if (EN(8) && IN(pb + 7)) { const Frame F_ = F; Frame F = relocal(F_); LAS int* ul = (LAS int*)(F.lds + pg8::STAGE_BYTES + 8192); if (F.tid == 0) pg8::MoeOrder::build(ul, (const int*)(F.ws + WS_TILES), 2, F.G, F.bid); __syncthreads();
            pg8::MoeOrder S{DM, (const char*)(F.ws + WS_U), (const char*)(F.ws + WS_MOE + MOE_WGU), (size_t)512 * 1024 * 2, ul};
            pg8::EpiGated<1> E{(bf16_t*)(F.ws + WS_H), 256, 0, nullptr, nullptr}; pg8::gemm_phase(F.lds, DM, S, E); phase_moe_convert_down(F, layer); } SEAM(pb + 7);
        if (EN(9) && IN(pb + 8)) { const Frame F_ = F; Frame F = relocal(F_); LAS int* ul = (LAS int*)(F.lds + pg8::STAGE_BYTES + 8192); if (F.tid == 0) pg8::MoeOrder::build(ul, (const int*)(F.ws + WS_TILES), 4, F.G, F.bid); __syncthreads();
            pg8::MoeOrder S{256, (const char*)(F.ws + WS_H), (const char*)(F.ws + WS_MOE + MOE_WD), (size_t)1024 * 256 * 2, ul};
            pg8::EpiMoeOut E{(bf16_t*)(F.ws + WS_U), (const int*)(F.ws + WS_ROWS), (const float*)(F.ws + WS_ROWS) + MAXROWS, F.lds}; pg8::gemm_phase(F.lds, 256, S, E); } SEAM(pb + 8);
    }
    if (EN(101) && IN(NPHASE - 1)) { phase_norm(F, (const float*)(F.ws + WS_X), true, F.in[I_FNORM], 2); }
#undef IN
#undef SEAM
}

#ifndef MK_SPLIT
#define MK_SPLIT 0
#endif
extern "C" void kernel_launch(void* const* d_in, const int* in_sizes, int n_in, void* d_out, int out_size, void* d_ws, size_t ws_size, hipStream_t stream) {
    static int grid = 0;
    if (grid == 0) {
        if (n_in != 44 || out_size != NTOK * DM || ws_size < WS_END) { fprintf(stderr, "kernel_launch: unexpected shapes (n_in %d out %d ws %zu need %zu)\n", n_in, out_size, ws_size, (size_t)WS_END); grid = -1; return; }
        int dev = 0, cus = 0;
        if (hipGetDevice(&dev) != hipSuccess || hipDeviceGetAttribute(&cus, hipDeviceAttributeMultiprocessorCount, dev) != hipSuccess) { grid = -1; return; }
        if (hipFuncSetAttribute((const void*)mk_forward, hipFuncAttributeMaxDynamicSharedMemorySize, LDS_BYTES) != hipSuccess) { fprintf(stderr, "kernel_launch: hipFuncSetAttribute failed\n"); grid = -1; return; }
        int per_cu = 0;
        if (hipOccupancyMaxActiveBlocksPerMultiprocessor(&per_cu, (const void*)mk_forward, NTHR, LDS_BYTES) != hipSuccess || per_cu < 1) { fprintf(stderr, "kernel_launch: occupancy query says %d\n", per_cu); }
        (void)hipGetLastError();
        grid = cus;
    }
    if (grid < 0) return;
    hipMemsetAsync((char*)d_ws + WS_CTL, 0, CTL_BYTES, stream);
    Params p{};
    for (int i = 0; i < 44; ++i) p.in[i] = (const float*)d_in[i];
    p.out = (float*)d_out; p.ws = (unsigned char*)d_ws;
#if MK_SPLIT
    for (int ph = 0; ph < NPHASE; ++ph) { p.ph_lo = ph; p.ph_hi = ph + 1; hipLaunchKernelGGL(mk_forward, dim3(grid), dim3(NTHR), LDS_BYTES, stream, p); }
#else
    p.ph_lo = 0; p.ph_hi = NPHASE; hipLaunchKernelGGL(mk_forward, dim3(grid), dim3(NTHR), LDS_BYTES, stream, p);
#endif
}
```

```cpp
#include <hip/hip_runtime.h>
#include <stdint.h>
#include <stdio.h>

#define LAS __attribute__((address_space(3)))
typedef unsigned short bf16_t;
typedef short bf16x8 __attribute__((ext_vector_type(8)));
typedef float f32x4 __attribute__((ext_vector_type(4)));
typedef float f32x2 __attribute__((ext_vector_type(2)));
typedef float f32x16 __attribute__((ext_vector_type(16)));
typedef unsigned u32x4 __attribute__((ext_vector_type(4)));
typedef unsigned u32x2 __attribute__((ext_vector_type(2)));

constexpr int NTOK = 16384, DM = 1024, SEQ = 4096, NBATCH = 4, DEPTH = 2;
constexpr int NIN = 2604, NINP = 2816;
constexpr int UM = 0;
constexpr int UR = 784;
constexpr int UC = 1680;
constexpr int US = 2368;
constexpr int NTHR = 512;
constexpr int LDS_BYTES = 163840;
constexpr int MISC_OFF = LDS_BYTES - 256;

constexpr size_t WS_CTL   = 0;
constexpr size_t CTL_BYTES = 65536;
constexpr size_t WS_X     = WS_CTL + CTL_BYTES;
constexpr size_t WS_H     = WS_X + (size_t)NTOK * DM * 4;
constexpr size_t WS_U     = WS_H + (size_t)NTOK * DM * 2;
constexpr size_t WS_WIN   = WS_U + (size_t)NTOK * NINP * 2;
constexpr size_t WS_WOUT  = WS_WIN + (size_t)2 * NINP * DM * 2;
constexpr size_t WS_GLU   = WS_WOUT + (size_t)2 * DM * DM * 2;
constexpr size_t WS_MOE   = WS_GLU + (size_t)2 * 512 * 256 * 2;
constexpr size_t MOE_WGU  = 0;
constexpr size_t MOE_WD   = (size_t)32 * 512 * 1024 * 2;
constexpr size_t MOE_BYTES = MOE_WD + (size_t)32 * 1024 * 256 * 2;
constexpr size_t RW_PT    = 0;
constexpr size_t RW_U     = (size_t)1024 * 4096 * 2;
constexpr size_t RW_S     = RW_U + (size_t)1024 * 4096 * 2;
constexpr size_t RW_W1    = RW_S + (size_t)1024 * 4096 * 2;
constexpr size_t RW_Z     = RW_W1 + (size_t)1024 * 4096 * 2;
constexpr size_t YSG_OFF  = RW_Z + (size_t)1024 * 4096 * 2;
static_assert(YSG_OFF + (size_t)NTOK * 256 * 2 <= MOE_BYTES, "alias");
constexpr size_t WS_MST   = WS_MOE + MOE_BYTES;
constexpr size_t WS_MDEC  = WS_MST + (size_t)4 * 64 * 4 * 4096 * 4;
constexpr size_t WS_S5ST  = WS_MDEC + 4096;
constexpr size_t WS_K     = WS_S5ST + (size_t)4 * 64 * 2048 * 4;
constexpr size_t WS_V     = WS_K + (size_t)NTOK * 64 * 2;
constexpr size_t WS_KIDX  = WS_V + (size_t)NTOK * 64 * 2;
constexpr size_t WS_ROUTE = WS_KIDX + (size_t)NTOK * 32 * 2;
constexpr size_t WS_ROWS  = WS_ROUTE + (size_t)NTOK * 32;
constexpr int    MAXROWS  = 49152;
constexpr size_t WS_TILES = WS_ROWS + (size_t)MAXROWS * 8;
constexpr size_t WS_S5TAB = WS_TILES + 4096;
constexpr size_t S5TAB_F  = (size_t)(2048 + 2048 + 32768) * 4;
constexpr size_t S5TAB_BBT = S5TAB_F + (size_t)16 * 16 * 128 * 2;
constexpr size_t S5TAB_L  = S5TAB_BBT + (size_t)16 * 128 * 16 * 2;
constexpr size_t WS_WRT   = WS_S5TAB + 2 * S5TAB_L;
constexpr size_t WS_BON   = WS_WRT + (size_t)2 * 2 * 48 * 1024 * 2;
constexpr size_t WS_END   = WS_BON + (size_t)1024 * 64 * 4;

constexpr int CW_BAR = 0;
constexpr int CW_Q   = 4096;
constexpr int CW_CNT = 8192;
constexpr int CW_RB  = 8448;

__device__ __forceinline__ float bf2f(bf16_t b) { return __uint_as_float(((unsigned)b) << 16); }
__device__ __forceinline__ bf16_t f2bf(float f) { const __bf16 h = (__bf16)f; return __builtin_bit_cast(bf16_t, h); }
__device__ __forceinline__ unsigned pk2(float lo, float hi) { typedef __bf16 bf2_t __attribute__((ext_vector_type(2))); const bf2_t h = __builtin_convertvector((f32x2){lo, hi}, bf2_t); return __builtin_bit_cast(unsigned, h); }
__device__ __forceinline__ unsigned cvt_pk_bf16(float lo, float hi) { unsigned r; asm volatile("v_cvt_pk_bf16_f32 %0, %1, %2" : "=v"(r) : "v"(lo), "v"(hi)); return r; }
__device__ __forceinline__ float sigmoidf_(float x) { return 1.0f / (1.0f + __expf(-x)); }
__device__ __forceinline__ float siluf_(float x) { return x / (1.0f + __expf(-x)); }
__device__ __forceinline__ float tanhf_(float x) { const float e = __expf(2.0f * x); return 1.0f - 2.0f / (e + 1.0f); }
__device__ __forceinline__ float softplusf_(float x) { return fmaxf(x, 0.0f) + log1pf(__expf(-fabsf(x))); }
__device__ __forceinline__ float gelu_tanh(float x) { return 0.5f * x * (1.0f + tanhf_(0.7978845608028654f * (x + 0.044715f * x * x * x))); }
template <int CTRL> __device__ __forceinline__ float dppf(float x) { return __int_as_float(__builtin_amdgcn_update_dpp(0, __float_as_int(x), CTRL, 0xF, 0xF, true)); }
__device__ __forceinline__ float sum4(float x) { x += dppf<0xB1>(x); x += dppf<0x4E>(x); return x; }
__device__ __forceinline__ float sum8(float x) { x = sum4(x); x += dppf<0x141>(x); return x; }
__device__ __forceinline__ float sum16(float x) { x = sum8(x); x += dppf<0x140>(x); return x; }
__device__ __forceinline__ int lane_id_() { int l = (int)__builtin_amdgcn_mbcnt_hi(~0u, __builtin_amdgcn_mbcnt_lo(~0u, 0u)); asm volatile("" : "+v"(l)); return l; }
__device__ __forceinline__ float shx(float x, int o) { return __int_as_float(__builtin_amdgcn_ds_bpermute((lane_id_() ^ o) << 2, __float_as_int(x))); }
__device__ __forceinline__ unsigned shdown_u(unsigned x, int o) { return (unsigned)__builtin_amdgcn_ds_bpermute(((lane_id_() + o) & 63) << 2, (int)x); }
__device__ __forceinline__ int shidx_i(int x, int src) { return __builtin_amdgcn_ds_bpermute(src << 2, x); }
__device__ __forceinline__ float wave_sum(float x) { x = sum16(x); x += shx(x, 16); x += shx(x, 32); return x; }
__device__ __forceinline__ void unpack8(const u32x4 v, float (&f)[8]) {
    f[0] = __uint_as_float(v.x << 16); f[1] = __uint_as_float(v.x & 0xffff0000u); f[2] = __uint_as_float(v.y << 16); f[3] = __uint_as_float(v.y & 0xffff0000u);
    f[4] = __uint_as_float(v.z << 16); f[5] = __uint_as_float(v.z & 0xffff0000u); f[6] = __uint_as_float(v.w << 16); f[7] = __uint_as_float(v.w & 0xffff0000u);
}

#define XB_TMO      128
#define XB_XCNT(j)  (256  + 64 * (j))
#define XB_XSUB(j)  (1280 + 64 * (j))
#define XB_XGEN(j)  (2304 + 64 * (j))
#define XB_TOP      3328
#define XB_TOPGEN   3392
#define XCD_BAR_WORDS 3456
#define XB_SPIN_CAP (1u << 22)
__device__ __forceinline__ unsigned xb_ld(unsigned* p)              { return __hip_atomic_load(p, __ATOMIC_RELAXED, __HIP_MEMORY_SCOPE_AGENT); }
__device__ __forceinline__ unsigned xb_add(unsigned* p, unsigned v) { return __hip_atomic_fetch_add(p, v, __ATOMIC_RELAXED, __HIP_MEMORY_SCOPE_AGENT); }
__device__ __forceinline__ unsigned xb_xcc_id() { return (unsigned)__builtin_amdgcn_s_getreg((3 << 11) | 20) & 0xFu; }
#define XB_SPIN(cond, bar) do { unsigned _sp = 0; while (cond) { __builtin_amdgcn_s_sleep(1); \
    if ((++_sp & 255u) == 0u) { if (xb_ld(&(bar)[XB_TMO])) break; if (_sp > XB_SPIN_CAP) { atomicAdd(&(bar)[XB_TMO], 1u); break; } } } } while (0)
struct XcdBarrier { unsigned* bar; unsigned x; volatile LAS unsigned* st; };
__device__ __forceinline__ XcdBarrier xcd_barrier_post(unsigned* bar, volatile LAS unsigned* st) {
    XcdBarrier b; b.bar = bar; b.x = xb_xcc_id(); b.st = st;
    if (threadIdx.x == 0) (void)xb_add(&bar[XB_XCNT(b.x)], 1u);
    return b;
}
__device__ __forceinline__ void xcd_barrier_complete(unsigned* bar, unsigned x, unsigned& nloc, unsigned& nx) {
    const unsigned G = gridDim.x * gridDim.y * gridDim.z;
    unsigned sum, cnt, mine, sp = 0u;
    for (;;) {
        sum = 0u; cnt = 0u; mine = 0u;
#pragma unroll
        for (unsigned j = 0; j < 16; ++j) { const unsigned c = xb_ld(&bar[XB_XCNT(j)]); sum += c; cnt += (c > 0u) ? 1u : 0u; mine = (j == x) ? c : mine; }
        if (sum == G) break;
        __builtin_amdgcn_s_sleep(1);
        if ((++sp & 255u) == 0u) { if (xb_ld(&bar[XB_TMO])) break; if (sp > XB_SPIN_CAP) { atomicAdd(&bar[XB_TMO], 1u); break; } }
    }
    nloc = mine > 0u ? mine : 1u; nx = cnt > 0u ? cnt : 1u;
}
__device__ __forceinline__ void xcd_barrier(const XcdBarrier& b_) {
    XcdBarrier b = b_; { const unsigned long long v = (unsigned long long)b.bar; unsigned lo = __builtin_amdgcn_readfirstlane((unsigned)v), hi = __builtin_amdgcn_readfirstlane((unsigned)(v >> 32)); asm volatile("" : "+s"(lo), "+s"(hi)); b.bar = (unsigned*)(((unsigned long long)hi << 32) | lo); unsigned xx = __builtin_amdgcn_readfirstlane(b.x); asm volatile("" : "+s"(xx)); b.x = xx; }
    asm volatile("s_waitcnt vmcnt(0)" ::: "memory");
    __syncthreads();
    if (threadIdx.x == 0) {
        unsigned* bar = b.bar;
        __builtin_amdgcn_s_waitcnt(0);
        unsigned nloc = b.st[0], nx = b.st[1];
        if (nloc == 0u) { xcd_barrier_complete(bar, b.x, nloc, nx); b.st[0] = nloc; b.st[1] = nx; }
        const unsigned old = xb_add(&bar[XB_XSUB(b.x)], 1u);
        const unsigned gen = old / nloc;
        if (old + 1u == (gen + 1u) * nloc) {
            __builtin_amdgcn_fence(__ATOMIC_RELEASE, "agent");
            asm volatile("s_waitcnt vmcnt(0)" ::: "memory");
            const unsigned og = xb_add(&bar[XB_TOP], 1u);
            const unsigned tg = og / nx;
            if (og + 1u == (tg + 1u) * nx) xb_add(&bar[XB_TOPGEN], 1u);
            else XB_SPIN(xb_ld(&bar[XB_TOPGEN]) == tg, bar);
            __builtin_amdgcn_fence(__ATOMIC_ACQUIRE, "agent");
            xb_add(&bar[XB_XGEN(b.x)], 1u);
            asm volatile("s_waitcnt vmcnt(0)" ::: "memory");
        } else {
            XB_SPIN(xb_ld(&bar[XB_XGEN(b.x)]) == gen, bar);
            __builtin_amdgcn_fence(__ATOMIC_ACQUIRE, "agent");
            asm volatile("s_waitcnt vmcnt(0)" ::: "memory");
        }
    }
    __syncthreads();
}

namespace pg8 {
constexpr int BM = 256, BK = 64, HALF = 128, HTB = HALF * BK * 2, STAGE_BYTES = 8 * HTB, NXCD = 8, WGM = 8;
__host__ __device__ __forceinline__ int lds_byte(int r, int c) { const int st = (r >> 4) * 2 + (c >> 5), rr = r & 15, cc = c & 31, ob = rr * 64 + cc * 2; return st * 1024 + (ob ^ (((ob >> 9) & 1) << 5)); }
__host__ __device__ __forceinline__ void stage_rc(int b, int& R, int& C) { const int st = b / 1024, sb = b % 1024, swz = sb ^ (((sb >> 9) & 1) << 5); R = (st >> 1) * 16 + swz / 64; C = (st & 1) * 32 + (swz % 64) / 2; }
__host__ __device__ __forceinline__ int perm32(int rho) { const int n = rho >> 4, i = rho & 15; return 8 * (i >> 2) + 4 * n + (i & 3); }
struct Unit { int pm, pn; const char* a; const char* b; };

struct StaticOrder {
    int nM, nN, nwg, G, c, K; const char* A; const char* B;
    __device__ void init(const bf16_t* A_, const bf16_t* B_, int M, int N, int K_, int G_, int c_) { A = (const char*)A_; B = (const char*)B_; K = K_; nM = M / BM; nN = N / BM; nwg = nM * nN; G = G_; c = c_; }
    __device__ bool next(int i, Unit& u) const {
        const long L = (long)i * G + c; if (L >= nwg) return false;
        int wgid = (int)L; { const int q = nwg / NXCD, r = nwg % NXCD, xcd = wgid % NXCD, off = wgid / NXCD; wgid = (xcd < r ? xcd * (q + 1) : r * (q + 1) + (xcd - r) * q) + off; }
        const int nig = WGM * nN, gid = wgid / nig, fm = gid * WGM, gsz = (nM - fm) < WGM ? (nM - fm) : WGM;
        u.pm = fm + ((wgid % nig) % gsz); u.pn = (wgid % nig) / gsz;
        u.a = A + (size_t)u.pm * 256 * K * 2; u.b = B + (size_t)u.pn * 256 * K * 2; return true;
    }
};

template <class Epi, class Sched, bool GATHER = false>
__device__ __forceinline__ void gemm_phase(LAS unsigned char* lds, const int K_, const Sched& S, const Epi& E, const char* Aall = nullptr, const int* arow = nullptr) {
    int K = K_; asm volatile("" : "+s"(K));
    int tid_ = threadIdx.x; asm volatile("" : "+v"(tid_));
    const int tid = tid_, wid = __builtin_amdgcn_readfirstlane(tid >> 6), lane = tid & 63, wr = wid >> 2, wc = wid & 3, fr = lane & 15, fq = lane >> 4;
    const int nt = K / BK;
    unsigned voffA[2], voffB[2]; int Rst[2], Cst[2];
#pragma unroll
    for (int i = 0; i < 2; ++i) { int R, C; stage_rc(tid * 16 + i * 8192, R, C); const int Rb = Epi::PERM ? ((R & ~31) + perm32(R & 31)) : R; Rst[i] = R; Cst[i] = C;
        voffA[i] = (unsigned)(R * K + C) * 2u; voffB[i] = (unsigned)(Rb * K + C) * 2u; }
    unsigned gv[2][2], gn[2][2];
#define PG8_GOFF(dst, unit) do { _Pragma("unroll") for (int h_ = 0; h_ < 2; ++h_) _Pragma("unroll") for (int i_ = 0; i_ < 2; ++i_) { const int rr_ = arow[(unit).pm * BM + h_ * HALF + Rst[i_]]; \
        dst[h_][i_] = ((unsigned)(rr_ < 0 ? 0 : rr_ >> 1) * (unsigned)K + (unsigned)Cst[i_]) * 2u; } } while (0)
    const size_t kstep = (size_t)(BK * 2);
    const size_t hstep = (size_t)HALF * K * 2;
    const unsigned ldsw = (unsigned)wid * 1024u;
    const int aoff = lds_byte(wr * 64 + fr, fq * 8), boff = lds_byte(wc * 32 + fr, fq * 8);
#define PG8_SA(b, h) (((b) * 2 + (h)) * HTB)
#define PG8_SB(b, h) ((4 + (b) * 2 + (h)) * HTB)
#define PG8_STAGE(bufoff, gbase, voff) do { _Pragma("unroll") for (int _i = 0; _i < 2; ++_i) \
        __builtin_amdgcn_global_load_lds((const unsigned*)((const char*)(gbase) + (voff)[_i]), (LAS unsigned*)(lds + (bufoff) + ldsw + _i * 8192), 16, 0, 0); } while (0)
#define PG8_LDA(dst, b, h) do { _Pragma("unroll") for (int m = 0; m < 4; ++m) _Pragma("unroll") for (int k = 0; k < 2; ++k) dst[m][k] = *(const LAS bf16x8*)(lds + PG8_SA(b, h) + aoff + m * 2048 + k * 1024); } while (0)
#define PG8_LDB(dst, b, h) do { _Pragma("unroll") for (int n = 0; n < 2; ++n) _Pragma("unroll") for (int k = 0; k < 2; ++k) dst[n][k] = *(const LAS bf16x8*)(lds + PG8_SB(b, h) + boff + n * 2048 + k * 1024); } while (0)
#define PG8_MMA(ai, bj, At, Bt) do { __builtin_amdgcn_s_setprio(1); _Pragma("unroll") for (int m = 0; m < 4; ++m) _Pragma("unroll") for (int n = 0; n < 2; ++n) _Pragma("unroll") for (int k = 0; k < 2; ++k) \
        acc[ai][bj][m][n] = __builtin_amdgcn_mfma_f32_16x16x32_bf16(Bt[n][k], At[m][k], acc[ai][bj][m][n], 0, 0, 0); __builtin_amdgcn_s_setprio(0); } while (0)
#define PG8_WAIT_V(n) asm volatile("s_waitcnt vmcnt(" #n ")" ::: "memory")
#define PG8_WAIT_L(n) asm volatile("s_waitcnt lgkmcnt(" #n ")" ::: "memory")
#define PG8_BAR __builtin_amdgcn_s_barrier()
#define PG8_SCHED __builtin_amdgcn_sched_barrier(0)
    Unit cur, nxt; int ui = 0;
    if (!S.next(0, cur)) return;
    f32x4 acc[2][2][4][2];
#pragma unroll
    for (int a = 0; a < 2; ++a)
#pragma unroll
        for (int b = 0; b < 2; ++b)
#pragma unroll
            for (int m = 0; m < 4; ++m)
#pragma unroll
                for (int n = 0; n < 2; ++n) acc[a][b][m][n] = (f32x4){0.f, 0.f, 0.f, 0.f};
    bf16x8 At[4][2], B0[2][2], B1[2][2];
    const char* cA = GATHER ? Aall : cur.a; const char* cB = cur.b;
    if (GATHER) PG8_GOFF(gv, cur);
#define PG8_STAGE_A(bufoff, gbase, h, vo) do { if (GATHER) PG8_STAGE(bufoff, gbase, (vo)[h]); else PG8_STAGE(bufoff, (gbase) + ((h) ? hstep : 0), voffA); } while (0)
    PG8_STAGE(PG8_SB(0, 0), cB, voffB); PG8_STAGE_A(PG8_SA(0, 0), cA, 0, gv); PG8_STAGE(PG8_SB(0, 1), cB + hstep, voffB); PG8_STAGE_A(PG8_SA(0, 1), cA, 1, gv);
    if (wr == 1) PG8_BAR;
    PG8_WAIT_V(4); PG8_BAR;
    PG8_STAGE(PG8_SB(1, 0), cB + kstep, voffB); PG8_STAGE_A(PG8_SA(1, 0), cA + kstep, 0, gv); PG8_STAGE(PG8_SB(1, 1), cB + hstep + kstep, voffB);
    PG8_WAIT_V(6); PG8_BAR;
    for (;;) {
        const bool has_next = S.next(ui + 1, nxt);
        const char* nA = GATHER ? cA : (has_next ? nxt.a : cA); const char* nB = has_next ? nxt.b : cB;
        if (GATHER) { if (has_next) PG8_GOFF(gn, nxt); else {
#pragma unroll
            for (int h_ = 0; h_ < 2; ++h_)
#pragma unroll
                for (int i_ = 0; i_ < 2; ++i_) gn[h_][i_] = gv[h_][i_]; } }
        for (int t = 0; t < nt; t += 2) {
            const bool last = (t == nt - 2);
            const char* a1 = cA + (size_t)(t + 1) * kstep;
            const char* a2 = last ? nA : cA + (size_t)(t + 2) * kstep; const char* b2 = last ? nB : cB + (size_t)(t + 2) * kstep;
            const char* a3 = a2 + kstep; const char* b3 = b2 + kstep;
            unsigned vo2[2][2];
#pragma unroll
            for (int h_ = 0; h_ < 2; ++h_)
#pragma unroll
                for (int i_ = 0; i_ < 2; ++i_) vo2[h_][i_] = GATHER ? (last ? gn[h_][i_] : gv[h_][i_]) : 0u;
            PG8_LDB(B0, 0, 0); PG8_SCHED; PG8_LDA(At, 0, 0); PG8_STAGE_A(PG8_SA(1, 1), a1, 1, gv);
            PG8_WAIT_L(8); PG8_BAR; PG8_WAIT_L(0); PG8_MMA(0, 0, At, B0); PG8_BAR; PG8_SCHED;
            PG8_LDB(B1, 0, 1); PG8_STAGE(PG8_SB(0, 0), b2, voffB);
            PG8_BAR; PG8_WAIT_L(0); PG8_MMA(0, 1, At, B1); PG8_BAR;
            PG8_LDA(At, 0, 1); PG8_STAGE_A(PG8_SA(0, 0), a2, 0, vo2);
            PG8_BAR; PG8_WAIT_L(0); PG8_MMA(1, 0, At, B0); PG8_BAR; PG8_SCHED;
            PG8_STAGE(PG8_SB(0, 1), b2 + hstep, voffB);
            PG8_WAIT_V(6); PG8_BAR; PG8_MMA(1, 1, At, B1); PG8_BAR;
            PG8_LDB(B0, 1, 0); PG8_SCHED; PG8_LDA(At, 1, 0); PG8_STAGE_A(PG8_SA(0, 1), a2, 1, vo2);
            PG8_WAIT_L(8); PG8_BAR; PG8_WAIT_L(0); PG8_MMA(0, 0, At, B0); PG8_BAR; PG8_SCHED;
            PG8_LDB(B1, 1, 1); PG8_STAGE(PG8_SB(1, 0), b3, voffB);
            PG8_BAR; PG8_WAIT_L(0); PG8_MMA(0, 1, At, B1); PG8_BAR;
            PG8_LDA(At, 1, 1); PG8_STAGE_A(PG8_SA(1, 0), a3, 0, vo2);
            PG8_BAR; PG8_WAIT_L(0); PG8_MMA(1, 0, At, B0); PG8_BAR; PG8_SCHED;
            PG8_STAGE(PG8_SB(1, 1), b3 + hstep, voffB);
            PG8_WAIT_V(6); PG8_BAR; PG8_MMA(1, 1, At, B1); PG8_BAR;
        }
        E(acc, cur, wr, wc, fr, fq);
        if (!has_next) break;
#pragma unroll
        for (int a = 0; a < 2; ++a)
#pragma unroll
            for (int b = 0; b < 2; ++b)
#pragma unroll
                for (int m = 0; m < 4; ++m)
#pragma unroll
                    for (int n = 0; n < 2; ++n) acc[a][b][m][n] = (f32x4){0.f, 0.f, 0.f, 0.f};
        cur = nxt; cA = nA; cB = nB; ++ui;
        if (GATHER) {
#pragma unroll
            for (int h_ = 0; h_ < 2; ++h_)
#pragma unroll
                for (int i_ = 0; i_ < 2; ++i_) gv[h_][i_] = gn[h_][i_]; }
    }
    PG8_WAIT_V(0);
    if (wr == 0) PG8_BAR;
    PG8_BAR;
#undef PG8_SA
#undef PG8_SB
#undef PG8_STAGE
#undef PG8_STAGE_A
#undef PG8_GOFF
#undef PG8_LDA
#undef PG8_LDB
#undef PG8_MMA
#undef PG8_WAIT_V
#undef PG8_WAIT_L
#undef PG8_BAR
#undef PG8_SCHED
}

struct EpiBf16 {
    static constexpr bool PERM = true;
    bf16_t* O; int ldc;
    __device__ __forceinline__ void operator()(const f32x4 (&acc)[2][2][4][2], const Unit& u, int wr, int wc, int fr, int fq) const {
        const int row0 = u.pm * BM + wr * 64 + fr, col0 = u.pn * BM + wc * 32 + 8 * fq;
#pragma unroll
        for (int ai = 0; ai < 2; ++ai)
#pragma unroll
            for (int m = 0; m < 4; ++m) { bf16_t* rowp = O + (size_t)(row0 + ai * HALF + m * 16) * ldc + col0;
#pragma unroll
                for (int bj = 0; bj < 2; ++bj) { const f32x4 v0 = acc[ai][bj][m][0], v1 = acc[ai][bj][m][1];
                    u32x4 w; w.x = cvt_pk_bf16(v0[0], v0[1]); w.y = cvt_pk_bf16(v0[2], v0[3]); w.z = cvt_pk_bf16(v1[0], v1[1]); w.w = cvt_pk_bf16(v1[2], v1[3]);
                    *(u32x4*)(rowp + bj * HALF) = w; } }
    }
};
struct EpiResid {
    static constexpr bool PERM = false;
    const float* Cin; float* C; int ldc;
    __device__ __forceinline__ void operator()(const f32x4 (&acc)[2][2][4][2], const Unit& u, int wr, int wc, int fr_, int fq_) const {
        int fr = fr_, fq = fq_; asm volatile("" : "+v"(fr), "+v"(fq));
        const int row0 = u.pm * BM + wr * 64 + fr, col0 = u.pn * BM + wc * 32 + 4 * fq;
#pragma unroll
        for (int ai = 0; ai < 2; ++ai)
#pragma unroll
            for (int mp = 0; mp < 2; ++mp) { f32x4 cv[2][2][2];
#pragma unroll
                for (int mm = 0; mm < 2; ++mm) { const float* rowp = Cin + (size_t)(row0 + ai * HALF + (2 * mp + mm) * 16) * ldc + col0;
#pragma unroll
                    for (int bj = 0; bj < 2; ++bj)
#pragma unroll
                        for (int n = 0; n < 2; ++n) cv[mm][bj][n] = *(const f32x4*)(rowp + bj * HALF + n * 16); }
#pragma unroll
                for (int mm = 0; mm < 2; ++mm) { float* rowp = C + (size_t)(row0 + ai * HALF + (2 * mp + mm) * 16) * ldc + col0;
#pragma unroll
                    for (int bj = 0; bj < 2; ++bj)
#pragma unroll
                        for (int n = 0; n < 2; ++n) *(f32x4*)(rowp + bj * HALF + n * 16) = cv[mm][bj][n] + acc[ai][bj][2 * mp + mm][n]; }
                asm volatile("" ::: "memory"); }
    }
};
template <int ACT  > struct EpiGated {
    static constexpr bool PERM = true;
    bf16_t* O; int ldo; int coloff; const float* ba; const float* bb;
    __device__ __forceinline__ void operator()(const f32x4 (&acc)[2][2][4][2], const Unit& u, int wr, int wc, int fr, int fq) const {
        const int row0 = u.pm * BM + wr * 64 + fr, cl = u.pn * HALF + wc * 32 + 8 * fq;
        float va[8], vb[8];
#pragma unroll
        for (int j = 0; j < 8; ++j) { va[j] = (ACT == 0) ? ba[cl + j] : 0.f; vb[j] = (ACT == 0) ? bb[cl + j] : 0.f; }
#pragma unroll
        for (int ai = 0; ai < 2; ++ai)
#pragma unroll
            for (int m = 0; m < 4; ++m) { bf16_t* rowp = O + (size_t)(row0 + ai * HALF + m * 16) * ldo + coloff + cl;
                float o[8];
#pragma unroll
                for (int n = 0; n < 2; ++n)
#pragma unroll
                    for (int j = 0; j < 4; ++j) { const float a = acc[ai][0][m][n][j] + va[4 * n + j], b = acc[ai][1][m][n][j] + vb[4 * n + j];
                        o[4 * n + j] = (ACT == 0) ? a * sigmoidf_(b) : siluf_(a) * b; }
                u32x4 w; w.x = cvt_pk_bf16(o[0], o[1]); w.y = cvt_pk_bf16(o[2], o[3]); w.z = cvt_pk_bf16(o[4], o[5]); w.w = cvt_pk_bf16(o[6], o[7]);
                *(u32x4*)rowp = w; asm volatile("" ::: "memory"); }
    }
};
struct EpiMoeOut {
    static constexpr bool PERM = true;
    bf16_t* O; const int* row_tok; const float* row_w; LAS unsigned char* lds;
    __device__ __forceinline__ void operator()(const f32x4 (&acc)[2][2][4][2], const Unit& u, int wr, int wc, int fr_, int fq_) const {
        int fr = fr_, fq = fq_; asm volatile("" : "+v"(fr), "+v"(fq));
        const int col0 = u.pn * BM + wc * 32 + 8 * fq, lane = fq * 16 + fr;
        LAS u32x2* rinfo = (LAS u32x2*)(lds + STAGE_BYTES) + (wr * 4 + wc) * 128;
        { const int ra = u.pm * BM + wr * 64 + lane, rb = ra + HALF;
          const u32x2 ia = (u32x2){(unsigned)row_tok[ra], __float_as_uint(row_w[ra])}, ib = (u32x2){(unsigned)row_tok[rb], __float_as_uint(row_w[rb])};
          rinfo[lane] = ia; rinfo[64 + lane] = ib; }
#pragma unroll
        for (int ai = 0; ai < 2; ++ai)
#pragma unroll
            for (int m = 0; m < 4; ++m) { const u32x2 inf = rinfo[ai * 64 + m * 16 + fr]; const int ts = (int)inf.x; const float w = __uint_as_float(inf.y);
                if (ts >= 0) { bf16_t* rowp = O + ((size_t)(ts & 1) * NTOK + (size_t)(ts >> 1)) * DM + col0;
#pragma unroll
                    for (int bj = 0; bj < 2; ++bj) { const f32x4 v0 = acc[ai][bj][m][0] * w, v1 = acc[ai][bj][m][1] * w;
                        u32x4 q; q.x = cvt_pk_bf16(v0[0], v0[1]); q.y = cvt_pk_bf16(v0[2], v0[3]); q.z = cvt_pk_bf16(v1[0], v1[1]); q.w = cvt_pk_bf16(v1[2], v1[3]);
                        *(u32x4*)(rowp + bj * HALF) = q; } } }
    }
};
struct MoeOrder {
    int K; const char* A; const char* B; size_t bstride; const LAS int* list;
    static __device__ __forceinline__ void build(LAS int* list, const int* tiles, int nN, int G, int c) {
        const int nrt = tiles[0], nwg = nrt * nN; int n = 0;
        for (int i = 0; ; ++i) { const long L = (long)i * G + c; if (L >= (long)nwg || n >= 20) break;
            int wgid = (int)L; { const int q = nwg / NXCD, r = nwg % NXCD, xcd = wgid % NXCD, off = wgid / NXCD; wgid = (xcd < r ? xcd * (q + 1) : r * (q + 1) + (xcd - r) * q) + off; }
            const int pm = wgid / nN; list[1 + 3 * n] = pm; list[2 + 3 * n] = wgid % nN; list[3 + 3 * n] = tiles[64 + pm]; ++n; }
        list[0] = n;
    }
    __device__ bool next(int i, Unit& u) const {
        const int n = __builtin_amdgcn_readfirstlane(list[0]); if (i >= n) return false;
        u.pm = __builtin_amdgcn_readfirstlane(list[1 + 3 * i]); u.pn = __builtin_amdgcn_readfirstlane(list[2 + 3 * i]); const int e = __builtin_amdgcn_readfirstlane(list[3 + 3 * i]);
        u.a = A + (size_t)u.pm * 256 * K * 2; u.b = B + (size_t)e * bstride + (size_t)u.pn * 256 * K * 2; return true;
    }
};
}

struct Params { const float* in[44]; float* out; unsigned char* ws; int ph_lo, ph_hi; };
enum { I_X = 0, I_NORM1, I_WIN, I_MCONVW, I_MCONVB, I_MDTB, I_MALOG, I_MD, I_MNORM, I_RMU, I_RW0, I_RW2, I_RA0, I_RA2, I_RG2, I_RKK, I_RKA, I_RRK, I_RLNW, I_RLNB,
       I_CKVN, I_CWUK, I_CWUV, I_RELB, I_SARE, I_SAIM, I_SBRE, I_SBIM, I_SCRE, I_SCIM, I_SD, I_SLOGDT, I_SGLUW, I_SGLUB, I_WOUT, I_NORM2, I_WRG, I_BRG, I_WRE, I_BRE,
       I_WGATE, I_WUP, I_WDOWN, I_FNORM };

typedef const float* const __attribute__((address_space(4)))* in_tab_t;
struct Frame {
    LAS unsigned char* lds; int tid, lane, wave, bid, G;
    in_tab_t in; float* out; unsigned char* ws; unsigned* ctl;
    volatile LAS int* misc;
};

__device__ __forceinline__ int q_pop(Frame& F, int qi) {
    __syncthreads();
    if (F.tid == 0) F.misc[0] = (int)__hip_atomic_fetch_add(F.ctl + CW_Q + 64 * qi, 1u, __ATOMIC_RELAXED, __HIP_MEMORY_SCOPE_AGENT);
    __syncthreads();
    return F.misc[0];
}

__device__ __forceinline__ const void* opaque_ptr(const void* p) { const unsigned long long v = (unsigned long long)p; unsigned lo = __builtin_amdgcn_readfirstlane((unsigned)v), hi = __builtin_amdgcn_readfirstlane((unsigned)(v >> 32));
    asm volatile("" : "+s"(lo), "+s"(hi)); return (const void*)(((unsigned long long)hi << 32) | lo); }
__device__ __forceinline__ Frame relocal(const Frame& G) { Frame F = G; asm volatile("" : "+v"(F.tid)); F.ws = (unsigned char*)opaque_ptr(F.ws); F.ctl = (unsigned*)(F.ws + WS_CTL); F.in = (in_tab_t)(unsigned long long)opaque_ptr((const void*)(unsigned long long)F.in); F.lane = F.tid & 63; F.wave = __builtin_amdgcn_readfirstlane(F.tid >> 6); return F; }
template <int K> __device__ __forceinline__ f32x4 mma_nt(const LAS bf16_t* A, int lda, const LAS bf16_t* Bt, int ldb, f32x4 acc, int lane) {
    const int r = lane & 15, g = lane >> 4;
#pragma unroll
    for (int k0 = 0; k0 < K; k0 += 32) {
        const bf16x8 a = *(const LAS bf16x8*)(A + r * lda + k0 + 8 * g);
        const bf16x8 b = *(const LAS bf16x8*)(Bt + r * ldb + k0 + 8 * g);
        acc = __builtin_amdgcn_mfma_f32_16x16x32_bf16(a, b, acc, 0, 0, 0);
    }
    return acc;
}

template <class SrcMap> __device__ __forceinline__ void tr_tile(Frame& F, int ldsrc, bf16_t* dst, int K, int k0, int n0, SrcMap sm) {
    LAS float* tile = (LAS float*)F.lds;
    __syncthreads();
    { const int n4 = (F.tid & 63) * 4, kk = F.tid >> 6; const float* sp = sm(n0 + n4);
      f32x4 v[8];
#pragma unroll
      for (int ps = 0; ps < 8; ++ps) { v[ps] = (f32x4){0.f, 0.f, 0.f, 0.f}; if (sp) v[ps] = *(const f32x4*)(sp + (size_t)(k0 + kk + 8 * ps) * ldsrc); }
#pragma unroll
      for (int ps = 0; ps < 8; ++ps) { LAS float* t = tile + (kk + 8 * ps) * 257 + n4; t[0] = v[ps][0]; t[1] = v[ps][1]; t[2] = v[ps][2]; t[3] = v[ps][3]; } }
    __syncthreads();
    { const int kc = F.tid & 7;
#pragma unroll
      for (int j = 0; j < 4; ++j) { const int n = (F.tid >> 3) + 64 * j; float f[8];
#pragma unroll
          for (int i = 0; i < 8; ++i) f[i] = tile[(8 * kc + i) * 257 + n];
          u32x4 w; w.x = pk2(f[0], f[1]); w.y = pk2(f[2], f[3]); w.z = pk2(f[4], f[5]); w.w = pk2(f[6], f[7]);
          *(u32x4*)(dst + (size_t)(n0 + n) * K + k0 + 8 * kc) = w; } }
}

struct SmIn { const float* base; __device__ __forceinline__ const float* operator()(int n) const {
    int c; if (n < 772) c = n; else if (n < UR) return nullptr; else if (n < UR + 896) c = 772 + (n - UR); else if (n < UC) return nullptr;
    else if (n < UC + 680) c = 1668 + (n - UC); else if (n < US) return nullptr; else if (n < US + 256) c = 2348 + (n - US); else return nullptr; return base + c; } };
struct SmId { const float* base; __device__ __forceinline__ const float* operator()(int n) const { return base + n; } };
struct SmGlu { const float* base; __device__ __forceinline__ const float* operator()(int n) const { const int pn = n >> 8, rr = n & 255; return base + (rr < 128 ? 128 * pn + rr : 256 + 128 * pn + (rr - 128)); } };
struct SmGU { const float* gate; const float* up; __device__ __forceinline__ const float* operator()(int n) const {
    const unsigned long long d = (unsigned long long)up - (unsigned long long)gate; const unsigned long long a = (unsigned long long)gate + (((n & 255) < 128) ? 0ull : d); return (const float*)a + 128 * (n >> 8) + (n & 127); } };
__device__ __forceinline__ void phase_prologue(const Frame& F_) { Frame F = relocal(F_);
    for (int t = F.bid; t < 496; t += F.G) {
        if (t < 352) { const int l = t / 176, r = t % 176, kt = r / 11, nt = r % 11;
            tr_tile(F, NIN, (bf16_t*)(F.ws + WS_WIN) + (size_t)l * NINP * DM, DM, kt * 64, nt * 256, SmIn{F.in[I_WIN] + (size_t)l * DM * NIN}); }
        else if (t < 480) { const int q = t - 352, l = q / 64, r = q % 64, kt = r / 4, nt = r % 4;
            tr_tile(F, DM, (bf16_t*)(F.ws + WS_WOUT) + (size_t)l * DM * DM, DM, kt * 64, nt * 256, SmId{F.in[I_WOUT] + (size_t)l * DM * DM}); }
        else { const int q = t - 480, l = q / 8, r = q % 8, kt = r / 2, nt = r % 2;
            tr_tile(F, 512, (bf16_t*)(F.ws + WS_GLU) + (size_t)l * 512 * 256, 256, kt * 64, nt * 256, SmGlu{F.in[I_SGLUW] + (size_t)l * 256 * 512}); }
    }
    for (int i = F.bid * NTHR + F.tid; i < 2 * 48 * 1024; i += F.G * NTHR) { const int l = i / 49152, r = i % 49152, o = r >> 10, k = r & 1023;
        float v = 0.f; if (o < 32) v = F.in[I_WRE][((size_t)l * DM + k) * 32 + o]; else if (o < 36) v = F.in[I_WRG][((size_t)l * DM + k) * 4 + (o - 32)];
        v *= F.in[I_NORM2][l * DM + k];
        const bf16_t hi = f2bf(v); const bf16_t lo = f2bf(v - bf2f(hi));
        bf16_t* w = (bf16_t*)(F.ws + WS_WRT) + (size_t)l * 2 * 49152; w[r] = hi; w[49152 + r] = lo; }
    for (int i = F.bid * NTHR + F.tid; i < 2048 + 65536; i += F.G * NTHR) {
        if (i < 2048) {
            const int l = i >> 10, gn = i & 1023, g = gn >> 6;
            float* tab = (float*)(F.ws + WS_S5TAB + (size_t)l * S5TAB_L);
            const float lre = fminf(F.in[I_SARE][l * 1024 + gn], -1e-4f), lim = F.in[I_SAIM][l * 1024 + gn];
            const float dt = expf(F.in[I_SLOGDT][l * 16 + g]);
            const float mag = expf(dt * lre); float sn, cs; sincosf(dt * lim, &sn, &cs);
            const float are = mag * cs, aim = mag * sn;
            const float den = lre * lre + lim * lim;
            const float fre = ((are - 1.0f) * lre + aim * lim) / den, fim = (aim * lre - (are - 1.0f) * lim) / den;
            tab[gn * 2] = are; tab[gn * 2 + 1] = aim;
            float pr = are, pi = aim;
#pragma unroll
            for (int s = 0; s < 6; ++s) { const float nr = pr * pr - pi * pi, ni = 2.0f * pr * pi; pr = nr; pi = ni; }
            tab[2048 + gn * 2] = pr; tab[2048 + gn * 2 + 1] = pi;
            const float* bre = F.in[I_SBRE] + ((size_t)l * 1024 + gn) * 16; const float* bim = F.in[I_SBIM] + ((size_t)l * 1024 + gn) * 16;
            bf16_t* bbt = (bf16_t*)(F.ws + WS_S5TAB + (size_t)l * S5TAB_L + S5TAB_BBT); const int n = gn & 63, col = 4 * (n & 31) + 2 * (n >> 5);
            for (int p = 0; p < 16; ++p) { const float vr = fre * bre[p] - fim * bim[p], vi = fre * bim[p] + fim * bre[p];
                bbt[((size_t)g * 128 + col) * 16 + p] = f2bf(vr); bbt[((size_t)g * 128 + col + 1) * 16 + p] = f2bf(vi); }
        } else {
            const int j = i - 2048, l = j >> 15, r = j & 32767, gp = r >> 7, k = r & 127;
            bf16_t* cm = (bf16_t*)(F.ws + WS_S5TAB + (size_t)l * S5TAB_L + S5TAB_F);
            const int n = (k >> 2) + 32 * ((k >> 1) & 1);
            const float v = (k & 1) == 0 ? F.in[I_SCRE][((size_t)l * 256 + gp) * 64 + n] : -F.in[I_SCIM][((size_t)l * 256 + gp) * 64 + n];
            cm[r] = f2bf(v);
        }
    }
}

__device__ __forceinline__ void phase_norm(const Frame& F_, const float* xin, bool add_o, const float* w, int mode) { Frame F = relocal(F_);
    float* X = (float*)(F.ws + WS_X); bf16_t* H = (bf16_t*)(F.ws + WS_H); const bf16_t* O = (const bf16_t*)(F.ws + WS_U);
    for (int row0 = F.bid * 32 + F.wave * 4; row0 < NTOK; row0 += F.G * 32) {
        f32x4 v[4][4]; u32x2 oa[4][4], ob[4][4];
#pragma unroll
        for (int r = 0; r < 4; ++r)
#pragma unroll
            for (int j = 0; j < 4; ++j) { const int c = 4 * F.lane + 256 * j; const size_t o = (size_t)(row0 + r) * DM + c; v[r][j] = *(const f32x4*)(xin + o);
                if (add_o) { oa[r][j] = *(const u32x2*)(O + o); ob[r][j] = *(const u32x2*)(O + (size_t)NTOK * DM + o); } }
#pragma unroll
        for (int r = 0; r < 4; ++r) { const int row = row0 + r; float ss = 0.f;
#pragma unroll
            for (int j = 0; j < 4; ++j) {
                if (add_o) { const u32x2 a = oa[r][j], b = ob[r][j];
                    v[r][j][0] += __uint_as_float(a.x << 16) + __uint_as_float(b.x << 16); v[r][j][1] += __uint_as_float(a.x & 0xffff0000u) + __uint_as_float(b.x & 0xffff0000u);
                    v[r][j][2] += __uint_as_float(a.y << 16) + __uint_as_float(b.y << 16); v[r][j][3] += __uint_as_float(a.y & 0xffff0000u) + __uint_as_float(b.y & 0xffff0000u); }
                ss += v[r][j][0] * v[r][j][0] + v[r][j][1] * v[r][j][1] + v[r][j][2] * v[r][j][2] + v[r][j][3] * v[r][j][3]; }
            ss = wave_sum(ss);
            const float rstd = rsqrtf(ss * (1.0f / DM) + 1e-6f);
#pragma unroll
            for (int j = 0; j < 4; ++j) { const int c = 4 * F.lane + 256 * j; const f32x4 wv = *(const f32x4*)(w + c);
                if (mode == 2) { *(f32x4*)(F.out + (size_t)row * DM + c) = v[r][j] * rstd * wv; }
                else { if (mode == 0) *(f32x4*)(X + (size_t)row * DM + c) = v[r][j];
                    u32x2 o; o.x = pk2(v[r][j][0] * rstd * wv[0], v[r][j][1] * rstd * wv[1]); o.y = pk2(v[r][j][2] * rstd * wv[2], v[r][j][3] * rstd * wv[3]);
                    *(u32x2*)(H + (size_t)row * DM + c) = o; } } }
    }
}

__device__ __forceinline__ void item_kv(const Frame& F_, int layer, int item) { Frame F = relocal(F_);
    const bf16_t* U = (const bf16_t*)(F.ws + WS_U);
    LAS bf16_t* Ab = (LAS bf16_t*)F.lds;
    LAS bf16_t* Bt = (LAS bf16_t*)(F.lds + 17408);
    const int t0 = item * 64;
    { const int tok = F.tid >> 3, part = F.tid & 7; const bf16_t* src = U + (size_t)(t0 + tok) * NINP + UC + 256 + 16 * part;
      float f[16]; { float a[8], b[8]; unpack8(*(const u32x4*)src, a); unpack8(*(const u32x4*)(src + 8), b);
#pragma unroll
        for (int j = 0; j < 8; ++j) { f[j] = a[j]; f[8 + j] = b[j]; } }
      float ss = 0.f;
#pragma unroll
      for (int j = 0; j < 16; ++j) ss += f[j] * f[j];
      ss = sum8(ss);
      const float rstd = rsqrtf(ss * (1.0f / 128.0f) + 1e-6f); const float* nw = F.in[I_CKVN] + layer * 128 + 16 * part;
#pragma unroll
      for (int j = 0; j < 16; j += 2) *(LAS unsigned*)(Ab + tok * 136 + 16 * part + j) = pk2(f[j] * rstd * nw[j], f[j + 1] * rstd * nw[j + 1]); }
    { const int n = F.tid >> 2, kq = F.tid & 3; const float* w = (n < 64 ? F.in[I_CWUK] : F.in[I_CWUV]) + (size_t)layer * 128 * 64 + (n & 63);
      float wv[32];
#pragma unroll
      for (int k = 0; k < 32; ++k) wv[k] = w[(size_t)(32 * kq + k) * 64];
#pragma unroll
      for (int k = 0; k < 32; k += 2) *(LAS unsigned*)(Bt + n * 136 + 32 * kq + k) = pk2(wv[k], wv[k + 1]); }
    if (F.tid < 256) { const int tok = F.tid >> 2, q = F.tid & 3;
        *(u32x4*)((bf16_t*)(F.ws + WS_KIDX) + (size_t)(t0 + tok) * 32 + 8 * q) = *(const u32x4*)(U + (size_t)(t0 + tok) * NINP + UC + 640 + 8 * q); }
    __syncthreads();
    const int mt = F.wave & 3, g = F.lane >> 4, r = F.lane & 15;
#pragma unroll
    for (int q = 0; q < 4; ++q) { const int nt = (F.wave >> 2) * 4 + q;
        f32x4 acc = (f32x4){0.f, 0.f, 0.f, 0.f};
        acc = mma_nt<128>(Ab + mt * 16 * 136, 136, Bt + nt * 16 * 136, 136, acc, F.lane);
        const int n = nt * 16 + r; bf16_t* dst = (bf16_t*)(F.ws + (n < 64 ? WS_K : WS_V));
#pragma unroll
        for (int i = 0; i < 4; ++i) dst[(size_t)(t0 + mt * 16 + 4 * g + i) * 64 + (n & 63)] = f2bf(acc[i]); }
}

constexpr int MB_CG = 0, MB_BG = 18432, MB_BT = 36864, MB_XT = 55296, MB_M = 92160, MB_S0 = 101376, MB_DT = 110592, MB_AC = 111616, MB_RS = 112640;
template <int STAGE> __device__ __forceinline__ void item_mamba(const Frame& F_, int layer, int item) { Frame F = relocal(F_);
    const bf16_t* U = (const bf16_t*)(F.ws + WS_U);
    const int b = item >> 6, c = item & 63, l0 = c * 64; const size_t T0 = (size_t)b * SEQ + l0;
    LAS bf16_t* Cg = (LAS bf16_t*)(F.lds + MB_CG); LAS bf16_t* Bg = (LAS bf16_t*)(F.lds + MB_BG); LAS bf16_t* BT = (LAS bf16_t*)(F.lds + MB_BT);
    LAS bf16_t* XT = (LAS bf16_t*)(F.lds + MB_XT); LAS bf16_t* Mb = (LAS bf16_t*)(F.lds + MB_M); LAS bf16_t* S0 = (LAS bf16_t*)(F.lds + MB_S0);
    LAS float* dts = (LAS float*)(F.lds + MB_DT); LAS float* acs = (LAS float*)(F.lds + MB_AC); LAS float* rs = (LAS float*)(F.lds + MB_RS);
    if (F.tid < 256) { const int l = F.tid >> 2, h = F.tid & 3;
        const float raw = bf2f(U[(T0 + l) * NINP + UM + 768 + h]) + F.in[I_MDTB][layer * 4 + h];
        const float dt = softplusf_(raw); dts[l * 4 + h] = dt; acs[l * 4 + h] = -__expf(F.in[I_MALOG][layer * 4 + h]) * dt; }
    if (F.tid < 64) rs[F.tid] = 0.f;
    __syncthreads();
    float mycum = 0.f;
    if (F.tid < 256) { const int l = F.tid >> 2, h = F.tid & 3; for (int s = 0; s <= l; ++s) mycum += acs[s * 4 + h]; }
    __syncthreads();
    if (F.tid < 256) acs[F.tid] = mycum;
    __syncthreads();
    { const int ch8 = F.tid & 63, tg = F.tid >> 6, c0 = ch8 * 8;
      float wv[4][8], bv[8];
#pragma unroll
      for (int j = 0; j < 8; ++j) { bv[j] = F.in[I_MCONVB][layer * 512 + c0 + j];
#pragma unroll
          for (int k = 0; k < 4; ++k) wv[k][j] = F.in[I_MCONVW][(layer * 4 + k) * 512 + c0 + j]; }
      float win[3][8];
#pragma unroll
      for (int k = 0; k < 3; ++k) { const int l = l0 + tg * 8 - 3 + k;
          if (l >= 0) unpack8(*(const u32x4*)(U + ((size_t)b * SEQ + l) * NINP + UM + 256 + c0), win[k]);
          else {
#pragma unroll
              for (int j = 0; j < 8; ++j) win[k][j] = 0.f; } }
#pragma unroll 1
      for (int ib = 0; ib < 2; ++ib) { u32x4 rows[4];
#pragma unroll
          for (int i4 = 0; i4 < 4; ++i4) rows[i4] = *(const u32x4*)(U + (T0 + tg * 8 + ib * 4 + i4) * NINP + UM + 256 + c0);
#pragma unroll
      for (int i4 = 0; i4 < 4; ++i4) { const int l = tg * 8 + ib * 4 + i4; float cur[8]; unpack8(rows[i4], cur);
          float o[8];
#pragma unroll
          for (int j = 0; j < 8; ++j) { o[j] = siluf_(bv[j] + wv[0][j] * win[0][j] + wv[1][j] * win[1][j] + wv[2][j] * win[2][j] + wv[3][j] * cur[j]);
              win[0][j] = win[1][j]; win[1][j] = win[2][j]; win[2][j] = cur[j]; }
          if (c0 < 256) { const int h = c0 >> 6, p0 = c0 & 63; float sc = dts[l * 4 + h]; if (STAGE == 1) sc *= __expf(acs[63 * 4 + h] - acs[l * 4 + h]);
#pragma unroll
              for (int j = 0; j < 8; ++j) XT[(h * 64 + p0 + j) * 72 + l] = f2bf(o[j] * sc); }
          else if (c0 < 384) { const int g = (c0 - 256) >> 6, n0 = (c0 - 256) & 63;
              if (STAGE == 1) {
#pragma unroll
                  for (int j = 0; j < 8; ++j) BT[(g * 64 + n0 + j) * 72 + l] = f2bf(o[j]); }
              else { u32x4 w; w.x = pk2(o[0], o[1]); w.y = pk2(o[2], o[3]); w.z = pk2(o[4], o[5]); w.w = pk2(o[6], o[7]); *(LAS u32x4*)(Bg + (g * 64 + l) * 72 + n0) = w; } }
          else if (STAGE == 2) { const int g = (c0 - 384) >> 6, n0 = (c0 - 384) & 63;
              u32x4 w; w.x = pk2(o[0], o[1]); w.y = pk2(o[2], o[3]); w.z = pk2(o[4], o[5]); w.w = pk2(o[6], o[7]); *(LAS u32x4*)(Cg + (g * 64 + l) * 72 + n0) = w; } } } }
    __syncthreads();
    const int g4 = F.lane >> 4, r16 = F.lane & 15;
    if (STAGE == 1) {
        float* MST = (float*)(F.ws + WS_MST) + ((size_t)(b * 64 + c) * 4) * 4096;
#pragma unroll
        for (int q = 0; q < 8; ++q) { const int tix = F.wave * 8 + q, h = tix >> 4, mt = (tix >> 2) & 3, nt = tix & 3;
            f32x4 acc = (f32x4){0.f, 0.f, 0.f, 0.f};
            acc = mma_nt<64>(XT + (h * 64 + mt * 16) * 72, 72, BT + ((h >> 1) * 64 + nt * 16) * 72, 72, acc, F.lane);
#pragma unroll
            for (int i = 0; i < 4; ++i) MST[(size_t)h * 4096 + (mt * 16 + 4 * g4 + i) * 64 + nt * 16 + r16] = acc[i]; }
        if (F.tid < 4) ((float*)(F.ws + WS_MDEC))[(b * 64 + c) * 4 + F.tid] = __expf(acs[63 * 4 + F.tid]);
    } else {
        const int mt = F.wave & 3, nh = F.wave >> 2;
        const float* MST = (const float*)(F.ws + WS_MST) + ((size_t)(b * 64 + c) * 4) * 4096;
        f32x4 G[2], yv[4][2];
#pragma unroll
        for (int h = 0; h < 4; ++h) {
            const int g = h >> 1;
            { const float* src = MST + (size_t)h * 4096 + F.tid * 8; const f32x4 a = *(const f32x4*)src, bq = *(const f32x4*)(src + 4);
              u32x4 w; w.x = pk2(a[0], a[1]); w.y = pk2(a[2], a[3]); w.z = pk2(bq[0], bq[1]); w.w = pk2(bq[2], bq[3]);
              *(LAS u32x4*)(S0 + (F.tid >> 3) * 72 + (F.tid & 7) * 8) = w; }
            if ((h & 1) == 0) {
#pragma unroll
                for (int q = 0; q < 2; ++q) { G[q] = (f32x4){0.f, 0.f, 0.f, 0.f};
                    G[q] = mma_nt<64>(Cg + (g * 64 + mt * 16) * 72, 72, Bg + (g * 64 + (2 * nh + q) * 16) * 72, 72, G[q], F.lane); } }
#pragma unroll
            for (int q = 0; q < 2; ++q) { const int s = (2 * nh + q) * 16 + r16; const float as = acs[s * 4 + h];
#pragma unroll
                for (int i = 0; i < 4; ++i) { const int l = mt * 16 + 4 * g4 + i; const float v = (s <= l) ? G[q][i] * __expf(acs[l * 4 + h] - as) : 0.f;
                    Mb[l * 72 + s] = f2bf(v); } }
            __syncthreads();
#pragma unroll
            for (int q = 0; q < 2; ++q) { const int nt = 2 * nh + q;
                f32x4 yd = (f32x4){0.f, 0.f, 0.f, 0.f}, yo = (f32x4){0.f, 0.f, 0.f, 0.f};
                yd = mma_nt<64>(Mb + mt * 16 * 72, 72, XT + (h * 64 + nt * 16) * 72, 72, yd, F.lane);
                yo = mma_nt<64>(Cg + (g * 64 + mt * 16) * 72, 72, S0 + nt * 16 * 72, 72, yo, F.lane);
                const int p = nt * 16 + r16; const float dsk = F.in[I_MD][layer * 4 + h];
#pragma unroll
                for (int i = 0; i < 4; ++i) { const int l = mt * 16 + 4 * g4 + i;
                    const float xs = bf2f(XT[(h * 64 + p) * 72 + l]) / dts[l * 4 + h];
                    yv[h][q][i] = yd[i] + yo[i] * __expf(acs[l * 4 + h]) + dsk * xs; } }
            __syncthreads();
        }
        float part[4] = {0.f, 0.f, 0.f, 0.f};
#pragma unroll
        for (int h = 0; h < 4; ++h)
#pragma unroll
            for (int q = 0; q < 2; ++q) { const int ch = h * 64 + (2 * nh + q) * 16 + r16;
#pragma unroll
                for (int i = 0; i < 4; ++i) { const int l = mt * 16 + 4 * g4 + i; const float z = bf2f(U[(T0 + l) * NINP + UM + ch]);
                    const float v = yv[h][q][i] * siluf_(z); yv[h][q][i] = v; part[i] += v * v; } }
#pragma unroll
        for (int i = 0; i < 4; ++i) { const float s = sum16(part[i]); if (r16 == 0) atomicAdd((float*)(rs + mt * 16 + 4 * g4 + i), s); }
        __syncthreads();
        bf16_t* Y = (bf16_t*)(F.ws + WS_H);
#pragma unroll
        for (int i = 0; i < 4; ++i) { const int l = mt * 16 + 4 * g4 + i; const float rstd = rsqrtf(rs[l] * (1.0f / 256.0f) + 1e-6f);
#pragma unroll
            for (int h = 0; h < 4; ++h)
#pragma unroll
                for (int q = 0; q < 2; ++q) { const int ch = h * 64 + (2 * nh + q) * 16 + r16;
                    Y[(T0 + l) * DM + ch] = f2bf(yv[h][q][i] * rstd * F.in[I_MNORM][layer * 256 + ch]); } }
    }
}
__device__ __forceinline__ void item_mamba_carry(const Frame& F_, int item) { Frame F = relocal(F_);
    const int b = item >> 2, h = item & 3;
    float* MST = (float*)(F.ws + WS_MST); const float* MD = (const float*)(F.ws + WS_MDEC);
    float s[8];
#pragma unroll
    for (int j = 0; j < 8; ++j) s[j] = 0.f;
    for (int c = 0; c < 64; ++c) { float* p = MST + ((size_t)(b * 64 + c) * 4 + h) * 4096 + F.tid * 8; const float d = MD[(b * 64 + c) * 4 + h];
        const f32x4 a = *(f32x4*)p, q = *(f32x4*)(p + 4);
        *(f32x4*)p = (f32x4){s[0], s[1], s[2], s[3]}; *(f32x4*)(p + 4) = (f32x4){s[4], s[5], s[6], s[7]};
        s[0] = s[0] * d + a[0]; s[1] = s[1] * d + a[1]; s[2] = s[2] * d + a[2]; s[3] = s[3] * d + a[3];
        s[4] = s[4] * d + q[0]; s[5] = s[5] * d + q[1]; s[6] = s[6] * d + q[2]; s[7] = s[7] * d + q[3]; }
}

template <int STAGE> __device__ __forceinline__ void item_s5(const Frame& F_, int layer, int item) { Frame F = relocal(F_);
    const bf16_t* U = (const bf16_t*)(F.ws + WS_U);
    const int b = item >> 6, c = item & 63; const size_t T0 = (size_t)b * SEQ + c * 64;
    LAS bf16_t* us = (LAS bf16_t*)F.lds;
    LAS bf16_t* BuW = (LAS bf16_t*)(F.lds + 33792) + F.wave * 4224;
    const float* tab = (const float*)(F.ws + WS_S5TAB + (size_t)layer * S5TAB_L);
    { const int tok = F.tid >> 3, part = F.tid & 7;
#pragma unroll
      for (int q = 0; q < 4; ++q) *(LAS u32x4*)(us + tok * 264 + 32 * part + 8 * q) = *(const u32x4*)(U + (T0 + tok) * NINP + US + 32 * part + 8 * q); }
    const int lane = F.lane, r16 = lane & 15, g4 = lane >> 4, gq = lane >> 5, n0 = lane & 31, g = 2 * F.wave + gq, gn0 = g * 64 + n0, gn1 = gn0 + 32;
    bf16x8 bfr[2][8];
    { const bf16_t* bbt = (const bf16_t*)(F.ws + WS_S5TAB + (size_t)layer * S5TAB_L + S5TAB_BBT);
#pragma unroll
      for (int gg = 0; gg < 2; ++gg)
#pragma unroll
          for (int nt = 0; nt < 8; ++nt) { u32x4 z = (u32x4){0u, 0u, 0u, 0u}; if (g4 < 2) z = *(const u32x4*)(bbt + ((size_t)(2 * F.wave + gg) * 128 + 16 * nt + r16) * 16 + 8 * g4); bfr[gg][nt] = __builtin_bit_cast(bf16x8, z); } }
    const float a0r = tab[gn0 * 2], a0i = tab[gn0 * 2 + 1], a1r = tab[gn1 * 2], a1i = tab[gn1 * 2 + 1];
    float* ST = (float*)(F.ws + WS_S5ST) + (size_t)(b * 64 + c) * 2048;
    float h0r = 0.f, h0i = 0.f, h1r = 0.f, h1i = 0.f;
    if (STAGE == 2) { h0r = ST[gn0 * 2]; h0i = ST[gn0 * 2 + 1]; h1r = ST[gn1 * 2]; h1i = ST[gn1 * 2 + 1]; }
    bf16x8 cf[2][4];
    if (STAGE == 2) { const bf16_t* cm = (const bf16_t*)(F.ws + WS_S5TAB + (size_t)layer * S5TAB_L + S5TAB_F);
#pragma unroll
        for (int gg = 0; gg < 2; ++gg)
#pragma unroll
            for (int ks = 0; ks < 4; ++ks) cf[gg][ks] = *(const bf16x8*)(cm + ((size_t)((2 * F.wave + gg) * 16 + r16)) * 128 + 32 * ks + 8 * g4); }
    __syncthreads();
#pragma unroll 1
    for (int lb = 0; lb < 4; ++lb) {
#pragma unroll
        for (int gg = 0; gg < 2; ++gg) { u32x4 z = (u32x4){0u, 0u, 0u, 0u}; if (g4 < 2) z = *(const LAS u32x4*)(us + (16 * lb + r16) * 264 + (2 * F.wave + gg) * 16 + 8 * g4);
            const bf16x8 afr = __builtin_bit_cast(bf16x8, z);
#pragma unroll
            for (int nt = 0; nt < 8; ++nt) { const f32x4 acc = __builtin_amdgcn_mfma_f32_16x16x32_bf16(afr, bfr[gg][nt], (f32x4){0.f, 0.f, 0.f, 0.f}, 0, 0, 0);
#pragma unroll
                for (int i = 0; i < 4; ++i) BuW[(4 * g4 + i) * 264 + gg * 128 + 16 * nt + r16] = f2bf(acc[i]); } }
        __syncthreads();
#pragma unroll 4
        for (int li = 0; li < 16; ++li) { LAS u32x2* bp = (LAS u32x2*)(BuW + li * 264 + gq * 128 + 4 * n0); const u32x2 v = *bp;
            { const float br = __uint_as_float(v.x << 16), bi = __uint_as_float(v.x & 0xffff0000u); const float nr = a0r * h0r - a0i * h0i + br, ni = a0r * h0i + a0i * h0r + bi; h0r = nr; h0i = ni; }
            { const float br = __uint_as_float(v.y << 16), bi = __uint_as_float(v.y & 0xffff0000u); const float nr = a1r * h1r - a1i * h1i + br, ni = a1r * h1i + a1i * h1r + bi; h1r = nr; h1i = ni; }
            if (STAGE == 2) *bp = (u32x2){pk2(h0r, h0i), pk2(h1r, h1i)}; }
        __syncthreads();
        if (STAGE == 2) {
            bf16_t* YS = (bf16_t*)(F.ws + WS_MOE + YSG_OFF);
#pragma unroll
            for (int gg = 0; gg < 2; ++gg) { f32x4 acc = (f32x4){0.f, 0.f, 0.f, 0.f};
#pragma unroll
                for (int ks = 0; ks < 4; ++ks) { const bf16x8 a = *(const LAS bf16x8*)(BuW + r16 * 264 + gg * 128 + 32 * ks + 8 * g4);
                    acc = __builtin_amdgcn_mfma_f32_16x16x32_bf16(a, cf[gg][ks], acc, 0, 0, 0); }
                const int ch = (2 * F.wave + gg) * 16 + r16; const float dsk = F.in[I_SD][layer * 256 + ch];
#pragma unroll
                for (int i = 0; i < 4; ++i) { const int l = lb * 16 + 4 * g4 + i; const float y = acc[i] + dsk * bf2f(us[l * 264 + ch]);
                    YS[(T0 + l) * 256 + ch] = f2bf(gelu_tanh(y)); } }
            __syncthreads();
        }
    }
    if (STAGE == 1) { ST[gn0 * 2] = h0r; ST[gn0 * 2 + 1] = h0i; ST[gn1 * 2] = h1r; ST[gn1 * 2 + 1] = h1i; }
    if (STAGE == 2) {
        asm volatile("s_waitcnt vmcnt(0)" ::: "memory"); __syncthreads();
        const bf16_t* YS = (const bf16_t*)(F.ws + WS_MOE + YSG_OFF) + T0 * 256; const bf16_t* GW = (const bf16_t*)(F.ws + WS_GLU) + (size_t)layer * 512 * 256;
        const int r16 = F.lane & 15, g4 = F.lane >> 4;
        f32x4 av[4][2], ag[4][2];
#pragma unroll
        for (int m = 0; m < 4; ++m)
#pragma unroll
            for (int q = 0; q < 2; ++q) { av[m][q] = (f32x4){0.f, 0.f, 0.f, 0.f}; ag[m][q] = (f32x4){0.f, 0.f, 0.f, 0.f}; }
#pragma unroll 2
        for (int ks = 0; ks < 8; ++ks) {
            bf16x8 af[4], bv[2], bg[2];
#pragma unroll
            for (int m = 0; m < 4; ++m) af[m] = *(const bf16x8*)(YS + (size_t)(16 * m + r16) * 256 + 32 * ks + 8 * g4);
#pragma unroll
            for (int q = 0; q < 2; ++q) { const int c = 32 * F.wave + 16 * q + r16; const int rowv = 256 * (c >> 7) + (c & 127);
                bv[q] = *(const bf16x8*)(GW + (size_t)rowv * 256 + 32 * ks + 8 * g4); bg[q] = *(const bf16x8*)(GW + (size_t)(rowv + 128) * 256 + 32 * ks + 8 * g4); }
#pragma unroll
            for (int m = 0; m < 4; ++m)
#pragma unroll
                for (int q = 0; q < 2; ++q) { av[m][q] = __builtin_amdgcn_mfma_f32_16x16x32_bf16(af[m], bv[q], av[m][q], 0, 0, 0); ag[m][q] = __builtin_amdgcn_mfma_f32_16x16x32_bf16(af[m], bg[q], ag[m][q], 0, 0, 0); }
        }
        bf16_t* Y = (bf16_t*)(F.ws + WS_H);
#pragma unroll
        for (int q = 0; q < 2; ++q) { const int c = 32 * F.wave + 16 * q + r16; const float bvl = F.in[I_SGLUB][layer * 512 + c], bgt = F.in[I_SGLUB][layer * 512 + 256 + c];
#pragma unroll
            for (int m = 0; m < 4; ++m)
#pragma unroll
                for (int i = 0; i < 4; ++i) Y[(T0 + 16 * m + 4 * g4 + i) * DM + 768 + c] = f2bf((av[m][q][i] + bvl) * sigmoidf_(ag[m][q][i] + bgt)); }
    }
}
__device__ __forceinline__ void item_s5_carry(const Frame& F_, int layer, int b) { Frame F = relocal(F_);
    const float* tab = (const float*)(F.ws + WS_S5TAB + (size_t)layer * S5TAB_L) + 2048;
    float* ST = (float*)(F.ws + WS_S5ST) + (size_t)b * 64 * 2048;
#pragma unroll
    for (int q = 0; q < 2; ++q) { const int gn = F.tid + 512 * q; const float pr = tab[gn * 2], pi = tab[gn * 2 + 1]; float hr = 0.f, hi = 0.f;
        for (int c = 0; c < 64; ++c) { float* p = ST + (size_t)c * 2048 + gn * 2; const float tr = p[0], ti = p[1]; p[0] = hr; p[1] = hi;
            const float nr = pr * hr - pi * hi + tr, ni = pr * hi + pi * hr + ti; hr = nr; hi = ni; } }
}

constexpr int RB_LD = 72;
constexpr int RW_R = 0, RW_K = 16384, RW_V = 32768, RW_W = 49152, RW_A = 65536, RW_B = 81920;
constexpr int R3_G = 49152, R3_O = 65536, R3_TILES = 81920, R3_BON = 147456;
template <int STAGE> __device__ __forceinline__ void rwkv_prep(const Frame& F_, int layer, int b, int h, int c) { Frame F = relocal(F_);
    const bf16_t* U = (const bf16_t*)(F.ws + WS_U);
    const int l0 = c * 64; const size_t T0 = (size_t)b * SEQ + l0;
    LAS float* Rr = (LAS float*)(F.lds + RW_R); LAS float* Kk = (LAS float*)(F.lds + RW_K); LAS float* Vv = (LAS float*)(F.lds + RW_V); LAS float* Ww = (LAS float*)(F.lds + RW_W);
    LAS float* Aa = (LAS float*)(F.lds + (STAGE == 1 ? RW_A : R3_O)); LAS float* Bb = (LAS float*)(F.lds + RW_B); LAS float* Gg = (LAS float*)(F.lds + R3_G); LAS float* BON = (LAS float*)(F.lds + R3_BON);
    LAS bf16_t* TWb = (LAS bf16_t*)(F.lds + 98304); LAS bf16_t* DAb = (LAS bf16_t*)(F.lds + (STAGE == 1 ? 103424 : 118784)); LAS bf16_t* SGb = (LAS bf16_t*)(F.lds + 123904);
    LAS bf16_t* w2T = (LAS bf16_t*)(F.lds + 108544); LAS bf16_t* a2T = (LAS bf16_t*)(F.lds + (STAGE == 1 ? 113664 : 133120)); LAS bf16_t* g2T = (LAS bf16_t*)(F.lds + 138240);
    const float* mu = F.in[I_RMU] + layer * 896;
    { const int tok = F.tid >> 3, p8 = F.tid & 7; const bool first = (l0 + tok == 0);
      const bf16_t* cur = U + (T0 + tok) * NINP + UR; const bf16_t* prv = first ? cur : cur - NINP;
      const float pz = first ? 0.f : 1.f;
      u32x4 cw[3], pw[3]; u32x2 c1 = (u32x2){0u, 0u}, p1 = (u32x2){0u, 0u}, c2 = (u32x2){0u, 0u}, p2 = (u32x2){0u, 0u}; u32x4 c3 = (u32x4){0u, 0u, 0u, 0u}, p3 = (u32x4){0u, 0u, 0u, 0u};
#pragma unroll
      for (int sec = (STAGE == 1 ? 0 : 2); sec < 3; ++sec) { const int co = sec * 256 + h * 64 + 8 * p8; cw[sec] = *(const u32x4*)(cur + co); pw[sec] = *(const u32x4*)(prv + co); }
      if (STAGE == 1) { c1 = *(const u32x2*)(cur + 768 + 4 * p8); p1 = *(const u32x2*)(prv + 768 + 4 * p8); c2 = *(const u32x2*)(cur + 800 + 4 * p8); p2 = *(const u32x2*)(prv + 800 + 4 * p8); }
      if (STAGE == 3) { c3 = *(const u32x4*)(cur + 832 + 8 * p8); p3 = *(const u32x4*)(prv + 832 + 8 * p8); }
#pragma unroll
      for (int sec = (STAGE == 1 ? 0 : 2); sec < 3; ++sec) { const int co = sec * 256 + h * 64 + 8 * p8; float av[8], pq[8]; unpack8(cw[sec], av); unpack8(pw[sec], pq);
          const f32x4 m0 = *(const f32x4*)(mu + co), m1 = *(const f32x4*)(mu + co + 4);
          LAS float* dst = (sec == 0 ? Rr : sec == 1 ? Kk : Vv) + tok * 64 + 8 * p8;
#pragma unroll
          for (int j = 0; j < 8; ++j) pq[j] *= pz;
          *(LAS f32x4*)dst = (f32x4){av[0] + m0[0] * (pq[0] - av[0]), av[1] + m0[1] * (pq[1] - av[1]), av[2] + m0[2] * (pq[2] - av[2]), av[3] + m0[3] * (pq[3] - av[3])};
          *(LAS f32x4*)(dst + 4) = (f32x4){av[4] + m1[0] * (pq[4] - av[4]), av[5] + m1[1] * (pq[5] - av[5]), av[6] + m1[2] * (pq[6] - av[6]), av[7] + m1[3] * (pq[7] - av[7])}; }
      if (STAGE == 1) {
#pragma unroll
        for (int which = 0; which < 2; ++which) { const int co = 768 + 32 * which + 4 * p8; const u32x2 cv = which ? c2 : c1, pv = which ? p2 : p1;
          const f32x4 m0 = *(const f32x4*)(mu + co);
          float x[4] = {__uint_as_float(cv.x << 16), __uint_as_float(cv.x & 0xffff0000u), __uint_as_float(cv.y << 16), __uint_as_float(cv.y & 0xffff0000u)};
          const float y[4] = {pz * __uint_as_float(pv.x << 16), pz * __uint_as_float(pv.x & 0xffff0000u), pz * __uint_as_float(pv.y << 16), pz * __uint_as_float(pv.y & 0xffff0000u)};
#pragma unroll
          for (int j = 0; j < 4; ++j) { x[j] = x[j] + m0[j] * (y[j] - x[j]); if (which == 0) x[j] = tanhf_(x[j]); }
          *(LAS u32x2*)((which ? DAb : TWb) + tok * 40 + 4 * p8) = (u32x2){pk2(x[0], x[1]), pk2(x[2], x[3])}; } }
      if (STAGE == 3) { const int co = 832 + 8 * p8; float av[8], pq[8]; unpack8(c3, av); unpack8(p3, pq);
          const f32x4 m0 = *(const f32x4*)(mu + co), m1 = *(const f32x4*)(mu + co + 4); float x[8];
#pragma unroll
          for (int j = 0; j < 8; ++j) x[j] = sigmoidf_(av[j] + (j < 4 ? m0[j] : m1[j - 4]) * (pz * pq[j] - av[j]));
          *(LAS u32x4*)(SGb + tok * RB_LD + 8 * p8) = (u32x4){pk2(x[0], x[1]), pk2(x[2], x[3]), pk2(x[4], x[5]), pk2(x[6], x[7])}; } }
    { const int ch = F.tid & 63, part = F.tid >> 6;
      if (STAGE == 1) { const float* w2 = F.in[I_RW2] + ((size_t)layer * 32 + 4 * part) * 256 + h * 64 + ch;
          *(LAS u32x2*)(w2T + ch * 40 + 4 * part) = (u32x2){pk2(w2[0], w2[256]), pk2(w2[512], w2[768])}; }
      if (STAGE == 1) { const float* a2 = F.in[I_RA2] + ((size_t)layer * 32 + 4 * part) * 256 + h * 64 + ch;
          *(LAS u32x2*)(a2T + ch * 40 + 4 * part) = (u32x2){pk2(a2[0], a2[256]), pk2(a2[512], a2[768])}; }
      if (STAGE == 3) { const float* g2 = F.in[I_RG2] + ((size_t)layer * 64 + 8 * part) * 256 + h * 64 + ch;
          *(LAS u32x4*)(g2T + ch * RB_LD + 8 * part) = (u32x4){pk2(g2[0], g2[256]), pk2(g2[512], g2[768]), pk2(g2[1024], g2[1280]), pk2(g2[1536], g2[1792])}; } }
    __syncthreads();
    { const int lane = F.lane, mt = F.wave >> 1, nt0 = 2 * (F.wave & 1), r = lane & 15, g4 = lane >> 4; const f32x4 zero4 = (f32x4){0.f, 0.f, 0.f, 0.f};
#pragma unroll
      for (int q = 0; q < 2; ++q) { const int nt = nt0 + q, ch = 16 * nt + r, cg = layer * 256 + h * 64 + ch;
          if (STAGE == 1) { const f32x4 wl = mma_nt<32>(TWb + 16 * mt * 40, 40, w2T + 16 * nt * 40, 40, zero4, lane); const float w0 = F.in[I_RW0][cg];
#pragma unroll
              for (int i = 0; i < 4; ++i) { const float x = w0 + wl[i]; const float wlog = -__logf(1.0f + __expf(-x)) - 0.5f; Ww[(16 * mt + 4 * g4 + i) * 64 + ch] = __expf(-__expf(wlog)); } }
          if (STAGE == 1) { const f32x4 al = mma_nt<32>(DAb + 16 * mt * 40, 40, a2T + 16 * nt * 40, 40, zero4, lane); const float a0 = F.in[I_RA0][cg];
#pragma unroll
              for (int i = 0; i < 4; ++i) Aa[(16 * mt + 4 * g4 + i) * 64 + ch] = sigmoidf_(a0 + al[i]); }
          if (STAGE == 3) { const f32x4 gv = mma_nt<64>(SGb + 16 * mt * RB_LD, RB_LD, g2T + 16 * nt * RB_LD, RB_LD, zero4, lane);
#pragma unroll
              for (int i = 0; i < 4; ++i) Gg[(16 * mt + 4 * g4 + i) * 64 + ch] = gv[i]; } } }
    __syncthreads();
    float* gBON = (float*)(F.ws + WS_BON) + ((size_t)(b * 4 + h) * 64 + c) * 64;
    if (STAGE == 1) { const int j = F.lane, tq = F.wave, cg = layer * 256 + h * 64 + j;
      const float kkw = F.in[I_RKK][cg], kaw = F.in[I_RKA][cg], rk = F.in[I_RRK][cg];
#pragma unroll 2
      for (int i8 = 0; i8 < 8; ++i8) { const int t = tq + 8 * i8;
          const float a = Aa[t * 64 + j]; const float kraw = Kk[t * 64 + j]; const float kp = kraw * (1.0f + (a - 1.0f) * kaw);
          Kk[t * 64 + j] = kp;
          const float kkv = kraw * kkw; const float ss = wave_sum(kkv * kkv); const float kkn = kkv * rsqrtf(fmaxf(ss, 1e-24f)); Aa[t * 64 + j] = -kkn; Bb[t * 64 + j] = kkn * a;
          const float bo = wave_sum(Rr[t * 64 + j] * kp * rk); if (j == 0) gBON[t] = bo; } }
    else if (F.tid < 64) BON[F.tid] = gBON[F.tid];
    __syncthreads();
}
constexpr int RB_AT = 98304, RB_ATT = RB_AT + 9216, RB_BT = RB_ATT + 9216, RB_BTT = RB_BT + 9216, RB_KT = RB_BTT + 9216, RB_RT = RB_KT + 9216, RB_VT = RB_RT + 9216, RB_GC = RB_VT + 9216;
constexpr int RX_X = 0, RX_XT = 9216, RX_TB = 18432, RX_M = 27648, RX_NRT = 36864, RX_G1T = 46080, RX_G2T = 55296, RX_QT = 64512;
__device__ __forceinline__ void st_tile(LAS bf16_t* dst, int mt, int nt, const f32x4 v, int lane) {
    const int r = lane & 15, g = lane >> 4;
#pragma unroll
    for (int i = 0; i < 4; ++i) dst[(16 * mt + 4 * g + i) * RB_LD + 16 * nt + r] = f2bf(v[i]);
}
__device__ __forceinline__ void st_tile_t(LAS bf16_t* dst, int mt, int nt, const f32x4 v, int lane) {
    const int r = lane & 15, g = lane >> 4; u32x2 w; w.x = pk2(v[0], v[1]); w.y = pk2(v[2], v[3]);
    *(LAS u32x2*)(dst + (16 * nt + r) * RB_LD + 16 * mt + 4 * g) = w;
}
__device__ __forceinline__ void item_rwkv1(const Frame& F_, int layer, int item) { Frame F = relocal(F_);
    const int b = item >> 8, h = (item >> 6) & 3, c = item & 63;
    rwkv_prep<1>(F, layer, b, h, c);
    LAS float* Rr = (LAS float*)(F.lds + RW_R); LAS float* Kk = (LAS float*)(F.lds + RW_K); LAS float* Vv = (LAS float*)(F.lds + RW_V); LAS float* Ww = (LAS float*)(F.lds + RW_W);
    LAS float* Aa = (LAS float*)(F.lds + RW_A); LAS float* Bb = (LAS float*)(F.lds + RW_B);
    LAS bf16_t* At = (LAS bf16_t*)(F.lds + RB_AT); LAS bf16_t* AtT = (LAS bf16_t*)(F.lds + RB_ATT); LAS bf16_t* Bt = (LAS bf16_t*)(F.lds + RB_BT); LAS bf16_t* BtT = (LAS bf16_t*)(F.lds + RB_BTT);
    LAS bf16_t* Kt = (LAS bf16_t*)(F.lds + RB_KT); LAS bf16_t* Rt = (LAS bf16_t*)(F.lds + RB_RT); LAS bf16_t* VT = (LAS bf16_t*)(F.lds + RB_VT); LAS float* gC = (LAS float*)(F.lds + RB_GC);
    LAS bf16_t* X = (LAS bf16_t*)(F.lds + RX_X); LAS bf16_t* XT = (LAS bf16_t*)(F.lds + RX_XT); LAS bf16_t* Tb = (LAS bf16_t*)(F.lds + RX_TB); LAS bf16_t* Mm = (LAS bf16_t*)(F.lds + RX_M);
    LAS bf16_t* NrT = (LAS bf16_t*)(F.lds + RX_NRT); LAS bf16_t* G1T = (LAS bf16_t*)(F.lds + RX_G1T); LAS bf16_t* G2T = (LAS bf16_t*)(F.lds + RX_G2T); LAS bf16_t* QT = (LAS bf16_t*)(F.lds + RX_QT);
    { const int k = F.tid & 63, part = F.tid >> 6; float g = 1.0f;
      for (int pp = 0; pp < part; ++pp) { float w8[8];
#pragma unroll
          for (int i = 0; i < 8; ++i) w8[i] = Ww[(8 * pp + i) * 64 + k];
          g *= ((w8[0] * w8[1]) * (w8[2] * w8[3])) * ((w8[4] * w8[5]) * (w8[6] * w8[7])); }
#pragma unroll
      for (int i = 0; i < 8; ++i) { const int t = 8 * part + i; const float gp = g; g *= Ww[t * 64 + k]; const float ig = 1.0f / g;
          const bf16_t av = f2bf(Aa[t * 64 + k] * gp), bv = f2bf(Bb[t * 64 + k] * ig);
          At[t * RB_LD + k] = av; AtT[k * RB_LD + t] = av; Bt[t * RB_LD + k] = bv; BtT[k * RB_LD + t] = bv;
          Kt[t * RB_LD + k] = f2bf(Kk[t * 64 + k] * ig); Rt[t * RB_LD + k] = f2bf(Rr[t * 64 + k] * g); VT[k * RB_LD + t] = f2bf(Vv[t * 64 + k]); }
      if (part == 7) gC[k] = g; }
    __syncthreads();
    const int lane = F.lane, mt = F.wave >> 1, nt0 = 2 * (F.wave & 1), r = lane & 15, g4 = lane >> 4;
    const f32x4 zero4 = (f32x4){0.f, 0.f, 0.f, 0.f};
    f32x4 Tacc[2];
#pragma unroll
    for (int q = 0; q < 2; ++q) { const int nt = nt0 + q;
        f32x4 n = mma_nt<64>(Bt + 16 * mt * RB_LD, RB_LD, At + 16 * nt * RB_LD, RB_LD, zero4, lane);
        f32x4 m = mma_nt<64>(Kt + 16 * mt * RB_LD, RB_LD, At + 16 * nt * RB_LD, RB_LD, zero4, lane);
        f32x4 nr = mma_nt<64>(Rt + 16 * mt * RB_LD, RB_LD, Bt + 16 * nt * RB_LD, RB_LD, zero4, lane);
#pragma unroll
        for (int i = 0; i < 4; ++i) { const int row = 16 * mt + 4 * g4 + i, col = 16 * nt + r;
            n[i] = (row < col) ? n[i] : 0.f; m[i] = (row < col) ? m[i] : 0.f; nr[i] = (col <= row) ? nr[i] : 0.f;
            Tacc[q][i] = n[i] + (row == col ? 1.0f : 0.f); }
        st_tile(X, mt, nt, n, lane); st_tile_t(XT, mt, nt, n, lane); st_tile(Tb, mt, nt, Tacc[q], lane); st_tile(Mm, mt, nt, m, lane); st_tile(NrT, mt, nt, nr, lane); }
    __syncthreads();
#pragma unroll 1
    for (int it = 0; it < 6; ++it) {
        LAS bf16_t* Xr = (it & 1) ? G1T : X; LAS bf16_t* XTr = (it & 1) ? G2T : XT; LAS bf16_t* Tr = (it & 1) ? QT : Tb;
        LAS bf16_t* Xw = (it & 1) ? X : G1T; LAS bf16_t* XTw = (it & 1) ? XT : G2T; LAS bf16_t* Tw = (it & 1) ? Tb : QT;
#pragma unroll
        for (int q = 0; q < 2; ++q) { const int nt = nt0 + q;
            if (it > 0) Tacc[q] = mma_nt<64>(Tr + 16 * mt * RB_LD, RB_LD, XTr + 16 * nt * RB_LD, RB_LD, Tacc[q], lane);
            if (it < 5) { const f32x4 x2 = mma_nt<64>(Xr + 16 * mt * RB_LD, RB_LD, XTr + 16 * nt * RB_LD, RB_LD, zero4, lane); st_tile(Xw, mt, nt, x2, lane); st_tile_t(XTw, mt, nt, x2, lane); }
            st_tile(Tw, mt, nt, Tacc[q], lane); }
        __syncthreads();
    }
#pragma unroll
    for (int q = 0; q < 2; ++q) { const int nt = nt0 + q;
        st_tile(G1T, mt, nt, mma_nt<64>(NrT + 16 * mt * RB_LD, RB_LD, Tb + 16 * nt * RB_LD, RB_LD, zero4, lane), lane);
        st_tile(G2T, mt, nt, mma_nt<64>(BtT + 16 * mt * RB_LD, RB_LD, Tb + 16 * nt * RB_LD, RB_LD, zero4, lane), lane); }
    __syncthreads();
    const size_t ci = (size_t)(b * 4 + h) * 64 + c;
    bf16_t* gPT = (bf16_t*)(F.ws + WS_MOE + RW_PT) + ci * 4096; bf16_t* gW1 = (bf16_t*)(F.ws + WS_MOE + RW_W1) + ci * 4096; bf16_t* gZ = (bf16_t*)(F.ws + WS_MOE + RW_Z) + ci * 4096;
#pragma unroll
    for (int q = 0; q < 2; ++q) { const int nt = nt0 + q; const int col = 16 * nt + r;
        f32x4 w1 = mma_nt<64>(G1T + 16 * mt * RB_LD, RB_LD, AtT + 16 * nt * RB_LD, RB_LD, zero4, lane);
        f32x4 z = mma_nt<64>(G1T + 16 * mt * RB_LD, RB_LD, Mm + 16 * nt * RB_LD, RB_LD, zero4, lane);
        f32x4 mr = mma_nt<64>(Rt + 16 * mt * RB_LD, RB_LD, Kt + 16 * nt * RB_LD, RB_LD, zero4, lane);
        f32x4 p = mma_nt<64>(G2T + 16 * mt * RB_LD, RB_LD, AtT + 16 * nt * RB_LD, RB_LD, zero4, lane);
        f32x4 qq = mma_nt<64>(G2T + 16 * mt * RB_LD, RB_LD, Mm + 16 * nt * RB_LD, RB_LD, zero4, lane);
        const int pos = 32 * (col >> 5) + 8 * ((col >> 2) & 3) + 4 * ((col >> 4) & 1) + (col & 3);
#pragma unroll
        for (int i = 0; i < 4; ++i) { const int row = 16 * mt + 4 * g4 + i;
            gW1[row * 64 + col] = f2bf(w1[i] + bf2f(Rt[row * RB_LD + col]));
            gZ[row * 64 + col] = f2bf(z[i] + (col <= row ? mr[i] : 0.f));
            const float gc = gC[row];
            gPT[row * 64 + pos] = f2bf((p[i] + (row == col ? 1.0f : 0.f)) * gc);
            qq[i] = (qq[i] + bf2f(Kt[col * RB_LD + row])) * gc; }
        st_tile(QT, mt, nt, qq, lane); }
    __syncthreads();
    bf16_t* gU = (bf16_t*)(F.ws + WS_MOE + RW_U) + ci * 4096;
#pragma unroll
    for (int q = 0; q < 2; ++q) { const int nt = nt0 + q;
        const f32x4 u = mma_nt<64>(VT + 16 * mt * RB_LD, RB_LD, QT + 16 * nt * RB_LD, RB_LD, zero4, lane);
#pragma unroll
        for (int i = 0; i < 4; ++i) gU[(16 * mt + 4 * g4 + i) * 64 + 16 * nt + r] = f2bf(u[i]); }
}
__device__ __forceinline__ void item_rwkv_carry(const Frame& F_, int item) { Frame F = relocal(F_);
    const int bh = item * 2 + (F.wave >> 2), nt = F.wave & 3, r = F.lane & 15, g = F.lane >> 4;
    const bf16_t* PT = (const bf16_t*)(F.ws + WS_MOE + RW_PT); const bf16_t* Uc = (const bf16_t*)(F.ws + WS_MOE + RW_U); bf16_t* Ss = (bf16_t*)(F.ws + WS_MOE + RW_S);
    f32x4 acc[4];
#pragma unroll
    for (int m = 0; m < 4; ++m) acc[m] = (f32x4){0.f, 0.f, 0.f, 0.f};
    for (int c = 0; c < 64; ++c) { const size_t ci = (size_t)bh * 64 + c;
        bf16x8 af[4][2]; f32x4 cin[4];
#pragma unroll
        for (int m = 0; m < 4; ++m) { const u32x2 uv = *(const u32x2*)(Uc + ci * 4096 + (16 * nt + r) * 64 + 16 * m + 4 * g);
            cin[m] = (f32x4){__uint_as_float(uv.x << 16), __uint_as_float(uv.x & 0xffff0000u), __uint_as_float(uv.y << 16), __uint_as_float(uv.y & 0xffff0000u)};
#pragma unroll
            for (int s = 0; s < 2; ++s) af[m][s] = *(const bf16x8*)(PT + ci * 4096 + (16 * m + r) * 64 + 32 * s + 8 * g); }
        unsigned pw[4][2];
#pragma unroll
        for (int m = 0; m < 4; ++m) { pw[m][0] = pk2(acc[m][0], acc[m][1]); pw[m][1] = pk2(acc[m][2], acc[m][3]);
            *(u32x2*)(Ss + ci * 4096 + (16 * nt + r) * 64 + 16 * m + 4 * g) = (u32x2){pw[m][0], pw[m][1]}; }
        bf16x8 bfr[2];
#pragma unroll
        for (int s = 0; s < 2; ++s) bfr[s] = __builtin_bit_cast(bf16x8, (u32x4){pw[2 * s][0], pw[2 * s][1], pw[2 * s + 1][0], pw[2 * s + 1][1]});
#pragma unroll
        for (int m = 0; m < 4; ++m) { acc[m] = __builtin_amdgcn_mfma_f32_16x16x32_bf16(af[m][0], bfr[0], cin[m], 0, 0, 0);
            acc[m] = __builtin_amdgcn_mfma_f32_16x16x32_bf16(af[m][1], bfr[1], acc[m], 0, 0, 0); }
    }
}
__device__ __forceinline__ void item_rwkv3(const Frame& F_, int layer, int item) { Frame F = relocal(F_);
    const int b = item >> 8, h = (item >> 6) & 3, c = item & 63; const size_t T0 = (size_t)b * SEQ + c * 64;
    rwkv_prep<3>(F, layer, b, h, c);
    LAS float* Vv = (LAS float*)(F.lds + RW_V); LAS float* Oo = (LAS float*)(F.lds + R3_O);
    LAS float* Gg = (LAS float*)(F.lds + R3_G); LAS float* BON = (LAS float*)(F.lds + R3_BON);
    LAS bf16_t* S0b = (LAS bf16_t*)(F.lds + R3_TILES); LAS bf16_t* W1b = S0b + 4608; LAS bf16_t* Zb = W1b + 4608; LAS bf16_t* VTb = Zb + 4608;
    { const size_t ci = (size_t)(b * 4 + h) * 64 + c; const int row = F.tid >> 3, col = (F.tid & 7) * 8;
      *(LAS u32x4*)(S0b + row * RB_LD + col) = *(const u32x4*)((const bf16_t*)(F.ws + WS_MOE + RW_S) + ci * 4096 + F.tid * 8);
      *(LAS u32x4*)(W1b + row * RB_LD + col) = *(const u32x4*)((const bf16_t*)(F.ws + WS_MOE + RW_W1) + ci * 4096 + F.tid * 8);
      *(LAS u32x4*)(Zb + row * RB_LD + col) = *(const u32x4*)((const bf16_t*)(F.ws + WS_MOE + RW_Z) + ci * 4096 + F.tid * 8);
      const int vv = F.tid & 63, part = F.tid >> 6;
#pragma unroll
      for (int i = 0; i < 8; ++i) { const int t = 8 * part + i; VTb[vv * RB_LD + t] = f2bf(Vv[t * 64 + vv]); } }
    __syncthreads();
    { const int lane = F.lane, mt = F.wave >> 1, nt0 = 2 * (F.wave & 1), r = lane & 15, g4 = lane >> 4;
#pragma unroll
      for (int q = 0; q < 2; ++q) { const int nt = nt0 + q;
          f32x4 o = mma_nt<64>(W1b + 16 * mt * RB_LD, RB_LD, S0b + 16 * nt * RB_LD, RB_LD, (f32x4){0.f, 0.f, 0.f, 0.f}, lane);
          o = mma_nt<64>(Zb + 16 * mt * RB_LD, RB_LD, VTb + 16 * nt * RB_LD, RB_LD, o, lane);
#pragma unroll
          for (int i = 0; i < 4; ++i) Oo[(16 * mt + 4 * g4 + i) * 64 + 16 * nt + r] = o[i]; } }
    __syncthreads();
    { const int j = F.lane, tq = F.wave, ch = h * 64 + j;
      const float lw = F.in[I_RLNW][layer * 256 + ch], lb = F.in[I_RLNB][layer * 256 + ch];
      bf16_t* Y = (bf16_t*)(F.ws + WS_H);
#pragma unroll 2
      for (int i8 = 0; i8 < 8; ++i8) { const int t = tq + 8 * i8;
          const float o = Oo[t * 64 + j]; const float mean = wave_sum(o) * (1.0f / 64.0f); const float d = o - mean; const float var = wave_sum(d * d) * (1.0f / 64.0f);
          float on = d * rsqrtf(var + 64e-5f) * lw + lb; on += BON[t] * Vv[t * 64 + j];
          Y[(T0 + t) * DM + 256 + ch] = f2bf(on * Gg[t * 64 + j]); } }
}

constexpr int DS_SEL = 131072, DS_HIST = 135168, DS_BKT = 151552, DS_BIAS = 152064;
__device__ __forceinline__ void dsa_tables(const Frame& F_) { Frame F = relocal(F_);
    LAS int* bkt = (LAS int*)(F.lds + DS_BKT); LAS float* biasT = (LAS float*)(F.lds + DS_BIAS);
    if (F.tid < 128) { const int n = F.tid; int bk = n; if (n >= 16) { const float lr = logf((float)n / 16.0f) / 2.0794415416798357f; bk = 16 + (int)(lr * 16.0f); bk = bk < 31 ? bk : 31; } bkt[n] = bk; biasT[n] = F.in[I_RELB][n]; }
    __syncthreads();
}
__device__ __forceinline__ unsigned fkey(float f) { const unsigned u = __float_as_uint(f); return (u & 0x80000000u) ? ~u : (u | 0x80000000u); }
__device__ __forceinline__ void item_dsa(const Frame& F_, int layer, int item) { Frame F = relocal(F_);
    const bf16_t* U = (const bf16_t*)(F.ws + WS_U); const bf16_t* KI = (const bf16_t*)(F.ws + WS_KIDX);
    const bf16_t* Kb = (const bf16_t*)(F.ws + WS_K); const bf16_t* Vb = (const bf16_t*)(F.ws + WS_V);
    const int b = item & 3, qg = 511 - (item >> 2); const size_t TB = (size_t)b * SEQ, T0 = TB + qg * 8;
    LAS float* sc = (LAS float*)F.lds; LAS unsigned short* selall = (LAS unsigned short*)(F.lds + DS_SEL); LAS unsigned* histall = (LAS unsigned*)(F.lds + DS_HIST);
    LAS int* bkt = (LAS int*)(F.lds + DS_BKT); LAS float* biasT = (LAS float*)(F.lds + DS_BIAS);
    const int lane = F.lane, hh = lane >> 5;
    {
        bf16x8 af[2][2]; float wq[2][2][8];
        { const int r = lane & 31, q4 = 2 * ((r >> 2) & 1) + (r >> 4), head = 4 * ((r >> 3) & 1) + (r & 3);
#pragma unroll
          for (int mt = 0; mt < 2; ++mt)
#pragma unroll
              for (int ks = 0; ks < 2; ++ks) af[mt][ks] = *(const bf16x8*)(U + (T0 + 4 * mt + q4) * NINP + UC + 384 + head * 32 + 16 * ks + 8 * hh); }
#pragma unroll
        for (int mt = 0; mt < 2; ++mt)
#pragma unroll
            for (int q2 = 0; q2 < 2; ++q2) { float f[8]; unpack8(*(const u32x4*)(U + (T0 + 4 * mt + 2 * hh + q2) * NINP + UC + 672), f);
#pragma unroll
                for (int hd = 0; hd < 8; ++hd) wq[mt][q2][hd] = f[hd]; }
        const int ntile = (qg * 8 + 8 + 31) >> 5;
        bf16x8 nb0 = af[0][0], nb1 = af[0][0];
        if (F.wave < ntile) { const int key = F.wave * 32 + (lane & 31); nb0 = *(const bf16x8*)(KI + (TB + key) * 32 + 8 * hh); nb1 = *(const bf16x8*)(KI + (TB + key) * 32 + 16 + 8 * hh); }
        for (int kt = F.wave; kt < ntile; kt += 8) {
            const int key = kt * 32 + (lane & 31);
            const bf16x8 b0 = nb0, b1 = nb1;
            if (kt + 8 < ntile) { const int k2 = key + 256; nb0 = *(const bf16x8*)(KI + (TB + k2) * 32 + 8 * hh); nb1 = *(const bf16x8*)(KI + (TB + k2) * 32 + 16 + 8 * hh); }
#pragma unroll
            for (int mt = 0; mt < 2; ++mt) { f32x16 acc;
#pragma unroll
                for (int i = 0; i < 16; ++i) acc[i] = 0.f;
                acc = __builtin_amdgcn_mfma_f32_32x32x16_bf16(af[mt][0], b0, acc, 0, 0, 0);
                acc = __builtin_amdgcn_mfma_f32_32x32x16_bf16(af[mt][1], b1, acc, 0, 0, 0);
#pragma unroll
                for (int q2 = 0; q2 < 2; ++q2) { float s = 0.f;
#pragma unroll
                    for (int hd = 0; hd < 8; ++hd) s += fmaxf(acc[8 * q2 + hd], 0.f) * wq[mt][q2][hd];
                    const int qi = 4 * mt + 2 * hh + q2;
                    sc[qi * 4096 + key] = (key <= qg * 8 + qi) ? s : -INFINITY; } }
        }
    }
    __syncthreads();
    const int qi = F.wave, tq = qg * 8 + qi, n = tq + 1;
    LAS float* scq = sc + qi * 4096; LAS unsigned short* sel = selall + qi * 256; LAS unsigned* hist = histall + qi * 512;
    int nsel;
    if (n <= 256) { nsel = n; for (int j = lane; j < 256; j += 64) sel[j] = (unsigned short)(j < n ? j : 0); }
    else {
        nsel = 256;
        const int R = (n + 63) >> 6; const unsigned long long ltm = (1ull << lane) - 1ull;
        float lo = INFINITY, hi = -INFINITY;
        const int R4 = (n + 255) >> 8;
#pragma unroll 4
        for (int i = 0; i < R4; ++i) { const int j0 = 256 * i + 4 * lane; const f32x4 v4 = *(const LAS f32x4*)(scq + j0);
#pragma unroll
            for (int q = 0; q < 4; ++q) { const bool valid = j0 + q < n; lo = fminf(lo, valid ? v4[q] : INFINITY); hi = fmaxf(hi, valid ? v4[q] : -INFINITY); } }
#pragma unroll
        for (int o = 1; o < 64; o <<= 1) { lo = fminf(lo, shx(lo, o)); hi = fmaxf(hi, shx(hi, o)); }
        bool slow = false;
        if (!(hi > lo)) { for (int j = lane; j < 256; j += 64) sel[j] = (unsigned short)j; }
        else {
            const float scale = 1023.0f / (hi - lo);
            *(LAS u32x4*)(hist + 8 * lane) = (u32x4){0u, 0u, 0u, 0u}; *(LAS u32x4*)(hist + 8 * lane + 4) = (u32x4){0u, 0u, 0u, 0u};
#pragma unroll 2
            for (int i = 0; i < R4; ++i) { const int j0 = 256 * i + 4 * lane; const f32x4 v4 = *(const LAS f32x4*)(scq + j0);
#pragma unroll
                for (int q = 0; q < 4; ++q) { if (j0 + q < n) { int bk = (int)((v4[q] - lo) * scale); bk = bk < 1023 ? bk : 1023;
                    atomicAdd((unsigned*)(hist + (bk >> 1)), (bk & 1) ? 65536u : 1u); } } }
            const u32x4 h0 = *(const LAS u32x4*)(hist + 8 * lane), h1 = *(const LAS u32x4*)(hist + 8 * lane + 4);
            unsigned cb[16];
            cb[0] = h0.x & 0xffffu; cb[1] = h0.x >> 16; cb[2] = h0.y & 0xffffu; cb[3] = h0.y >> 16; cb[4] = h0.z & 0xffffu; cb[5] = h0.z >> 16; cb[6] = h0.w & 0xffffu; cb[7] = h0.w >> 16;
            cb[8] = h1.x & 0xffffu; cb[9] = h1.x >> 16; cb[10] = h1.y & 0xffffu; cb[11] = h1.y >> 16; cb[12] = h1.z & 0xffffu; cb[13] = h1.z >> 16; cb[14] = h1.w & 0xffffu; cb[15] = h1.w >> 16;
            unsigned tot = 0u;
#pragma unroll
            for (int q = 0; q < 16; ++q) tot += cb[q];
            unsigned incl = tot;
#pragma unroll
            for (int o = 1; o < 64; o <<= 1) { const unsigned t = shdown_u(incl, o); if (lane + o < 64) incl += t; }
            int fb = -1; unsigned fabove = 0u, fcnt = 0u; unsigned cum = incl - tot;
#pragma unroll
            for (int q = 15; q >= 0; --q) { if (fb < 0 && cum < 256u && 256u <= cum + cb[q]) { fb = 16 * lane + q; fabove = cum; fcnt = cb[q]; } cum += cb[q]; }
            const unsigned long long mf = __ballot(fb >= 0); const int src = (int)__ffsll((long long)mf) - 1;
            const int B = shidx_i(fb, src); const int above = shidx_i((int)fabove, src), cntB = shidx_i((int)fcnt, src); const int need = 256 - above;
            if (cntB > 256) slow = true;
            else {
                LAS unsigned* cand = hist;
                int base_gt = 0, base_c = 0;
#pragma unroll 2
                for (int i = 0; i < R4; ++i) { const int j0 = 256 * i + 4 * lane; const f32x4 v4 = *(const LAS f32x4*)(scq + j0);
#pragma unroll
                    for (int q = 0; q < 4; ++q) { const int j = j0 + q; const bool valid = j < n; const float v = valid ? v4[q] : lo;
                        int bk = (int)((v - lo) * scale); bk = bk < 1023 ? bk : 1023;
                        const bool gt = valid && bk > B, eq = valid && bk == B;
                        const unsigned long long mg = __ballot(gt), me = __ballot(eq);
                        if (gt) sel[base_gt + __popcll(mg & ltm)] = (unsigned short)j;
                        if (eq) { const int p = base_c + __popcll(me & ltm); cand[2 * p] = fkey(v); cand[2 * p + 1] = (unsigned)j; }
                        base_gt += __popcll(mg); base_c += __popcll(me); } }
                if (need == cntB) { for (int c = lane; c < cntB; c += 64) sel[above + c] = (unsigned short)cand[2 * c + 1]; }
                else {
                    unsigned ck[4], cx[4]; int rk[4];
#pragma unroll
                    for (int q = 0; q < 4; ++q) { const int c = lane + 64 * q; ck[q] = c < cntB ? cand[2 * c] : 0u; cx[q] = c < cntB ? cand[2 * c + 1] : 0u; rk[q] = 0; }
                    for (int c2 = 0; c2 < cntB; ++c2) { const unsigned k2 = cand[2 * c2], x2 = cand[2 * c2 + 1];
#pragma unroll
                        for (int q = 0; q < 4; ++q) rk[q] += (k2 > ck[q] || (k2 == ck[q] && x2 < cx[q])) ? 1 : 0; }
#pragma unroll
                    for (int q = 0; q < 4; ++q) { const int c = lane + 64 * q; if (c < cntB && rk[q] < need) sel[above + rk[q]] = (unsigned short)cand[2 * c + 1]; }
                }
            }
        }
        if (slow) {
        unsigned prefix = 0u; int need = 256; unsigned neq = 0u;
        for (int p = 0; p < 4; ++p) { const int shift = 24 - 8 * p;
            *(LAS u32x4*)(hist + 4 * lane) = (u32x4){0u, 0u, 0u, 0u};
            for (int i = 0; i < R; ++i) { const int j = lane + 64 * i; if (j < n) { const unsigned u = fkey(scq[j]);
                if (p == 0 || (u >> (shift + 8)) == prefix) atomicAdd((unsigned*)(hist + ((u >> shift) & 255u)), 1u); } }
            const u32x4 hv = *(const LAS u32x4*)(hist + 4 * lane);
            const unsigned tot = hv.x + hv.y + hv.z + hv.w;
            unsigned incl = tot;
#pragma unroll
            for (int o = 1; o < 64; o <<= 1) { const unsigned t = shdown_u(incl, o); if (lane + o < 64) incl += t; }
            const unsigned above = incl - tot;
            int fb = -1; unsigned fabove = 0u, feq = 0u; unsigned cum = above;
            { const unsigned hq[4] = {hv.x, hv.y, hv.z, hv.w};
#pragma unroll
              for (int q = 3; q >= 0; --q) { if (fb < 0 && cum < (unsigned)need && (unsigned)need <= cum + hq[q]) { fb = 4 * lane + q; fabove = cum; feq = hq[q]; } cum += hq[q]; } }
            const unsigned long long m = __ballot(fb >= 0);
            const int src = (int)__ffsll((long long)m) - 1;
            const int bin = shidx_i(fb, src); const unsigned ab = (unsigned)shidx_i((int)fabove, src); neq = (unsigned)shidx_i((int)feq, src);
            need -= (int)ab; prefix = (prefix << 8) | (unsigned)bin;
        }
        const int ngt = 256 - need;
        int base_gt = 0, base_eq = 0;
        for (int i = 0; i < R; ++i) { const int j = lane + 64 * i; const unsigned u = (j < n) ? fkey(scq[j]) : 0u;
            const bool gt = (j < n) && (u > prefix), eq = (j < n) && (u == prefix);
            const unsigned long long mg = __ballot(gt), me = __ballot(eq); const unsigned long long lt = (1ull << lane) - 1ull;
            if (gt) sel[base_gt + __popcll(mg & lt)] = (unsigned short)j;
            if (eq) { const int rk = base_eq + __popcll(me & lt); if (rk < need) sel[ngt + rk] = (unsigned short)j; }
            base_gt += __popcll(mg); base_eq += __popcll(me); }
        (void)neq;
            }
    }
    const int nt16 = (nsel + 15) >> 4, r16 = lane & 15, g4 = lane >> 4;
    LAS float* biasj = scq + 2048;
#pragma unroll
    for (int q = 0; q < 4; ++q) { const int j = lane + 64 * q; f32x4 bv = (f32x4){-INFINITY, -INFINITY, -INFINITY, -INFINITY};
        if (j < nsel) { const int dist = tq - (int)sel[j]; const int bk = dist < 128 ? bkt[dist < 0 ? 0 : dist] : 31; bv = *(const LAS f32x4*)(biasT + 4 * bk); }
        *(LAS f32x4*)(biasj + 4 * j) = bv; }
    bf16x8 qf[2];
#pragma unroll
    for (int s = 0; s < 2; ++s) { u32x4 z = (u32x4){0u, 0u, 0u, 0u}; if (r16 < 4) z = *(const u32x4*)(U + (T0 + qi) * NINP + UC + r16 * 64 + 32 * s + 8 * g4); qf[s] = __builtin_bit_cast(bf16x8, z); }
    float lg[16][4]; float mx = -INFINITY;
#define DSA_QK(M0, NM) do { int keyr[NM]; bf16x8 a0[NM], a1[NM]; \
        _Pragma("unroll") for (int m8 = 0; m8 < NM; ++m8) keyr[m8] = sel[16 * ((M0) + m8) + r16]; \
        _Pragma("unroll") for (int m8 = 0; m8 < NM; ++m8) { a0[m8] = *(const bf16x8*)(Kb + (TB + keyr[m8]) * 64 + 8 * g4); a1[m8] = *(const bf16x8*)(Kb + (TB + keyr[m8]) * 64 + 32 + 8 * g4); } \
        _Pragma("unroll") for (int m8 = 0; m8 < NM; ++m8) { const int m = (M0) + m8; \
            f32x4 acc = (f32x4){0.f, 0.f, 0.f, 0.f}; \
            acc = __builtin_amdgcn_mfma_f32_16x16x32_bf16(a0[m8], qf[0], acc, 0, 0, 0); \
            acc = __builtin_amdgcn_mfma_f32_16x16x32_bf16(a1[m8], qf[1], acc, 0, 0, 0); \
            _Pragma("unroll") for (int i = 0; i < 4; ++i) { const float v = acc[i] * 0.125f + biasj[(16 * m + 4 * g4 + i) * 4 + (r16 & 3)]; lg[m][i] = v; mx = fmaxf(mx, v); } } } while (0)
    if (nt16 > 8) { DSA_QK(0, 16); }
    else { DSA_QK(0, 8);
#pragma unroll
        for (int m8 = 8; m8 < 16; ++m8)
#pragma unroll
            for (int i = 0; i < 4; ++i) lg[m8][i] = -INFINITY; }
#undef DSA_QK
    mx = fmaxf(mx, shx(mx, 16)); mx = fmaxf(mx, shx(mx, 32));
    float sm = 0.f;
#pragma unroll
    for (int m = 0; m < 16; ++m)
#pragma unroll
        for (int i = 0; i < 4; ++i) { const float p = __expf(lg[m][i] - mx); lg[m][i] = p; sm += p; }
    sm += shx(sm, 16); sm += shx(sm, 32);
    f32x4 ov[4];
#pragma unroll
    for (int nt = 0; nt < 4; ++nt) ov[nt] = (f32x4){0.f, 0.f, 0.f, 0.f};
    const unsigned vs_base = (unsigned)(unsigned long)scq;
#pragma unroll
    for (int half = 0; half < 2; ++half) {
        if (half * 8 < nt16) {
            asm volatile("s_waitcnt lgkmcnt(0)" ::: "memory");
            int vkey[16];
#pragma unroll
            for (int q = 0; q < 16; ++q) { const int rho = 8 * q + (lane >> 3);
                vkey[q] = sel[half * 128 + (rho & ~31) + 16 * ((rho >> 2) & 1) + 4 * ((rho >> 3) & 3) + (rho & 3)]; }
            asm volatile("s_waitcnt lgkmcnt(0)" : "+v"(vkey[0]), "+v"(vkey[1]), "+v"(vkey[2]), "+v"(vkey[3]), "+v"(vkey[4]), "+v"(vkey[5]), "+v"(vkey[6]), "+v"(vkey[7]),
                         "+v"(vkey[8]), "+v"(vkey[9]), "+v"(vkey[10]), "+v"(vkey[11]), "+v"(vkey[12]), "+v"(vkey[13]), "+v"(vkey[14]), "+v"(vkey[15]) :: "memory");
#pragma unroll
            for (int q = 0; q < 16; ++q)
                __builtin_amdgcn_global_load_lds((const unsigned*)(Vb + (TB + vkey[q]) * 64 + 8 * (lane & 7)), (LAS unsigned*)((LAS unsigned char*)scq + q * 1024), 16, 0, 0);
            asm volatile("s_waitcnt vmcnt(0)" ::: "memory");
#pragma unroll
            for (int s4 = 0; s4 < 4; ++s4) { const int s = half * 4 + s4;
                u32x4 pw; pw.x = pk2(lg[2 * s][0], lg[2 * s][1]); pw.y = pk2(lg[2 * s][2], lg[2 * s][3]); pw.z = pk2(lg[2 * s + 1][0], lg[2 * s + 1][1]); pw.w = pk2(lg[2 * s + 1][2], lg[2 * s + 1][3]);
                const bf16x8 pa = __builtin_bit_cast(bf16x8, pw);
                const unsigned ad = vs_base + (unsigned)((32 * s4 + 8 * g4 + (r16 >> 2)) * 128 + (r16 & 3) * 8);
                u32x2 t0[4], t1[4];
                asm volatile("ds_read_b64_tr_b16 %0, %8\n\tds_read_b64_tr_b16 %1, %8 offset:512\n\tds_read_b64_tr_b16 %2, %8 offset:32\n\tds_read_b64_tr_b16 %3, %8 offset:544\n\t"
                             "ds_read_b64_tr_b16 %4, %8 offset:64\n\tds_read_b64_tr_b16 %5, %8 offset:576\n\tds_read_b64_tr_b16 %6, %8 offset:96\n\tds_read_b64_tr_b16 %7, %8 offset:608\n\ts_waitcnt lgkmcnt(0)"
                             : "=&v"(t0[0]), "=&v"(t1[0]), "=&v"(t0[1]), "=&v"(t1[1]), "=&v"(t0[2]), "=&v"(t1[2]), "=&v"(t0[3]), "=&v"(t1[3]) : "v"(ad) : "memory");
#pragma unroll
                for (int nt = 0; nt < 4; ++nt) { const bf16x8 vb = __builtin_bit_cast(bf16x8, (u32x4){t0[nt].x, t0[nt].y, t1[nt].x, t1[nt].y});
                    ov[nt] = __builtin_amdgcn_mfma_f32_16x16x32_bf16(pa, vb, ov[nt], 0, 0, 0); } }
        }
    }
    { float inv[4];
#pragma unroll
      for (int h = 0; h < 4; ++h) inv[h] = 1.0f / __int_as_float(__builtin_amdgcn_readlane(__float_as_int(sm), h));
      if (lane < 16) { bf16_t* Y = (bf16_t*)(F.ws + WS_H) + (T0 + qi) * DM + 512 + r16;
#pragma unroll
          for (int h = 0; h < 4; ++h)
#pragma unroll
              for (int nt = 0; nt < 4; ++nt) Y[h * 64 + 16 * nt] = f2bf(ov[nt][h] * inv[h]); } }
}

__device__ __forceinline__ void phase_router(const Frame& F_, int layer) { Frame F = relocal(F_); const int cset = layer;
    const float* X = (const float*)(F.ws + WS_X);
    const bf16_t* WH = (const bf16_t*)(F.ws + WS_WRT) + (size_t)layer * 2 * 49152; const bf16_t* WL = WH + 49152;
    LAS float* part = (LAS float*)F.lds;
    LAS float* ssq = (LAS float*)(F.lds + 24576);
    LAS int* es = (LAS int*)(F.lds + 25088);
    LAS int* lr = (LAS int*)(F.lds + 25600);
    LAS float* wsl = (LAS float*)(F.lds + 26112);
    LAS float* rsd = (LAS float*)(F.lds + 26624);
    for (int blk = F.bid; blk < NTOK / 64; blk += F.G) {
        __syncthreads();
        const int mt = F.wave & 3, kh = F.wave >> 2, r16 = F.lane & 15, g4 = F.lane >> 4;
        const float* xr = X + ((size_t)blk * 64 + mt * 16 + r16) * DM + kh * 512 + 8 * g4;
        f32x4 acc[3]; acc[0] = acc[1] = acc[2] = (f32x4){0.f, 0.f, 0.f, 0.f}; float ss = 0.f;
#pragma unroll 4
        for (int ks = 0; ks < 16; ++ks) {
            const f32x4 xa = *(const f32x4*)(xr + ks * 32), xb = *(const f32x4*)(xr + ks * 32 + 4);
            ss += xa[0] * xa[0] + xa[1] * xa[1] + xa[2] * xa[2] + xa[3] * xa[3] + xb[0] * xb[0] + xb[1] * xb[1] + xb[2] * xb[2] + xb[3] * xb[3];
            float xv[8] = {xa[0], xa[1], xa[2], xa[3], xb[0], xb[1], xb[2], xb[3]}; unsigned hw[4], lw[4];
#pragma unroll
            for (int j = 0; j < 4; ++j) { const bf16_t h0 = f2bf(xv[2 * j]), h1 = f2bf(xv[2 * j + 1]); hw[j] = (unsigned)h0 | ((unsigned)h1 << 16);
                lw[j] = pk2(xv[2 * j] - bf2f(h0), xv[2 * j + 1] - bf2f(h1)); }
            const bf16x8 ahi = __builtin_bit_cast(bf16x8, (u32x4){hw[0], hw[1], hw[2], hw[3]}), alo = __builtin_bit_cast(bf16x8, (u32x4){lw[0], lw[1], lw[2], lw[3]});
#pragma unroll
            for (int nt = 0; nt < 3; ++nt) { const size_t wo = (size_t)(nt * 16 + r16) * 1024 + kh * 512 + ks * 32 + 8 * g4;
                const bf16x8 bh = *(const bf16x8*)(WH + wo), bl = *(const bf16x8*)(WL + wo);
                acc[nt] = __builtin_amdgcn_mfma_f32_16x16x32_bf16(ahi, bh, acc[nt], 0, 0, 0);
                acc[nt] = __builtin_amdgcn_mfma_f32_16x16x32_bf16(ahi, bl, acc[nt], 0, 0, 0);
                acc[nt] = __builtin_amdgcn_mfma_f32_16x16x32_bf16(alo, bh, acc[nt], 0, 0, 0); }
        }
        ss += shx(ss, 16); ss += shx(ss, 32);
        if (g4 == 0) ssq[kh * 64 + mt * 16 + r16] = ss;
#pragma unroll
        for (int nt = 0; nt < 3; ++nt)
#pragma unroll
            for (int i = 0; i < 4; ++i) part[(kh * 64 + mt * 16 + 4 * g4 + i) * 48 + nt * 16 + r16] = acc[nt][i];
        __syncthreads();
        if (F.tid < 64) { const float rstd = rsqrtf((ssq[F.tid] + ssq[64 + F.tid]) * (1.0f / DM) + 1e-6f); rsd[F.tid] = rstd;
            float l[36];
#pragma unroll
            for (int o = 0; o < 36; ++o) l[o] = (part[F.tid * 48 + o] + part[(64 + F.tid) * 48 + o]) * rstd + (o < 32 ? F.in[I_BRE][layer * 32 + o] : F.in[I_BRG][layer * 4 + o - 32]);
            int gs = 0; float gm = l[32];
#pragma unroll
            for (int j = 1; j < 4; ++j) if (l[32 + j] > gm) { gm = l[32 + j]; gs = j; }
            float den = 0.f;
#pragma unroll
            for (int j = 0; j < 4; ++j) den += __expf(l[32 + j] - gm);
            const float gate = 1.0f / den;
            float e8[8];
#pragma unroll
            for (int j = 0; j < 8; ++j) e8[j] = gs == 0 ? l[j] : gs == 1 ? l[8 + j] : gs == 2 ? l[16 + j] : l[24 + j];
            int i1 = 0; float v1 = e8[0];
#pragma unroll
            for (int j = 1; j < 8; ++j) if (e8[j] > v1) { v1 = e8[j]; i1 = j; }
            int i2 = -1; float v2 = -INFINITY;
#pragma unroll
            for (int j = 0; j < 8; ++j) if (j != i1 && e8[j] > v2) { v2 = e8[j]; i2 = j; }
            const float e2 = __expf(v2 - v1); const float p1 = 1.0f / (1.0f + e2);
            es[F.tid * 2] = gs * 8 + i1; es[F.tid * 2 + 1] = gs * 8 + i2; wsl[F.tid * 2] = p1 * gate; wsl[F.tid * 2 + 1] = (1.0f - p1) * gate; }
        __syncthreads();
        if (F.tid < 32) { int cnt = 0; for (int i = 0; i < 128; ++i) if (es[i] == F.tid) lr[i] = cnt++;
            if (cnt) { const int base = (int)__hip_atomic_fetch_add(F.ctl + CW_CNT + cset * 32 + F.tid, (unsigned)cnt, __ATOMIC_RELAXED, __HIP_MEMORY_SCOPE_AGENT);
                for (int i = 0; i < 128; ++i) if (es[i] == F.tid) lr[i] += base; } }
        __syncthreads();
        if (F.tid < 64) { int* rt = (int*)(F.ws + WS_ROUTE) + ((size_t)blk * 64 + F.tid) * 8;
            rt[0] = es[F.tid * 2]; rt[1] = es[F.tid * 2 + 1]; ((float*)rt)[2] = wsl[F.tid * 2]; ((float*)rt)[3] = wsl[F.tid * 2 + 1]; rt[4] = lr[F.tid * 2]; rt[5] = lr[F.tid * 2 + 1]; ((float*)rt)[6] = rsd[F.tid]; }
    }
    __syncthreads();
    if (F.tid == 0) __hip_atomic_fetch_add(F.ctl + CW_RB + 64 * layer, 1u, __ATOMIC_RELAXED, __HIP_MEMORY_SCOPE_AGENT);
}
__device__ __forceinline__ void phase_moe_convert(const Frame& F_, int layer) { Frame F = relocal(F_);
    bf16_t* WGU = (bf16_t*)(F.ws + WS_MOE + MOE_WGU);
    for (int t = F.bid; t < 1024; t += F.G) {
        const int e = t >> 5, r = t & 31, kt = r >> 1, nt = r & 1; const size_t eo = ((size_t)layer * 32 + e) * 1024 * 256;
        tr_tile(F, 256, WGU + (size_t)e * 512 * 1024, 1024, kt * 64, nt * 256, SmGU{F.in[I_WGATE] + eo, F.in[I_WUP] + eo}); }
}
__device__ __forceinline__ void phase_moe_convert_down(const Frame& F_, int layer) { Frame F = relocal(F_);
    bf16_t* WD = (bf16_t*)(F.ws + WS_MOE + MOE_WD);
    for (;;) { const int q = q_pop(F, 32 + layer); if (q >= 512) break;
        const int e = q >> 4, r = q & 15, kt = r >> 2, nt = r & 3;
        tr_tile(F, 1024, WD + (size_t)e * 1024 * 256, 256, kt * 64, nt * 256, SmId{F.in[I_WDOWN] + ((size_t)layer * 32 + e) * 256 * 1024}); }
}
__device__ __forceinline__ void phase_gather(const Frame& F_, int layer) { Frame F = relocal(F_);
    LAS int* off = (LAS int*)F.lds;
    __syncthreads();
    if (F.tid == 0) { unsigned sp = 0;
        while (__hip_atomic_load(F.ctl + CW_RB + 64 * layer, __ATOMIC_RELAXED, __HIP_MEMORY_SCOPE_AGENT) < (unsigned)F.G) { __builtin_amdgcn_s_sleep(2); if (++sp > (1u << 22)) break; } }
    __syncthreads();
    if (F.tid == 0) { int acc = 0; for (int e = 0; e < 32; ++e) { off[e] = acc; const int c = (int)__hip_atomic_load(F.ctl + CW_CNT + layer * 32 + e, __ATOMIC_RELAXED, __HIP_MEMORY_SCOPE_AGENT); acc += (c + 255) & ~255; } off[32] = acc; }
    __syncthreads();
    int* tiles = (int*)(F.ws + WS_TILES); int* row_tok = (int*)(F.ws + WS_ROWS); float* row_w = (float*)(F.ws + WS_ROWS) + MAXROWS;
    if (F.bid == 0) { if (F.tid == 0) tiles[0] = off[32] >> 8; if (F.tid < 33) tiles[1 + F.tid] = off[F.tid];
        if (F.tid < 32) for (int rt = off[F.tid] >> 8; rt < (off[F.tid + 1] >> 8); ++rt) tiles[64 + rt] = F.tid; }
    for (int e = F.bid; e < 32; e += F.G) { const int c = (int)__hip_atomic_load(F.ctl + CW_CNT + layer * 32 + e, __ATOMIC_RELAXED, __HIP_MEMORY_SCOPE_AGENT);
        for (int r = off[e] + c + F.tid; r < off[e + 1]; r += NTHR) { row_tok[r] = -1; row_w[r] = 0.f; } }
    const float* X = (const float*)(F.ws + WS_X); bf16_t* HP = (bf16_t*)(F.ws + WS_U); const float* nw = F.in[I_NORM2] + (size_t)layer * DM;
    f32x4 nwv[4];
#pragma unroll
    for (int j = 0; j < 4; ++j) nwv[j] = *(const f32x4*)(nw + 4 * F.lane + 256 * j);
    for (int blk = F.bid; blk < NTOK / 64; blk += F.G)
    for (int i4 = 0; i4 < 2; ++i4) {
        int p0[4], p1[4], tt[4]; float rstd[4], w0[4], w1[4]; f32x4 xv[4][4];
#pragma unroll
        for (int r = 0; r < 4; ++r) { const int t = blk * 64 + F.wave * 8 + 4 * i4 + r; tt[r] = t;
            const int* rt = (const int*)(F.ws + WS_ROUTE) + (size_t)t * 8; rstd[r] = ((const float*)rt)[6]; w0[r] = ((const float*)rt)[2]; w1[r] = ((const float*)rt)[3];
            p0[r] = off[rt[0]] + rt[4]; p1[r] = off[rt[1]] + rt[5];
#pragma unroll
            for (int j = 0; j < 4; ++j) xv[r][j] = *(const f32x4*)(X + (size_t)t * DM + 4 * F.lane + 256 * j); }
#pragma unroll
        for (int r = 0; r < 4; ++r) {
#pragma unroll
            for (int j = 0; j < 4; ++j) { const int c = 4 * F.lane + 256 * j; const f32x4 v = xv[r][j] * rstd[r] * nwv[j];
                u32x2 o; o.x = pk2(v[0], v[1]); o.y = pk2(v[2], v[3]);
                *(u32x2*)(HP + (size_t)tt[r] * DM + c) = o; }
            if (F.lane == 0) { row_tok[p0[r]] = tt[r] * 2; row_w[p0[r]] = w0[r]; row_tok[p1[r]] = tt[r] * 2 + 1; row_w[p1[r]] = w1[r]; } }
    }
}

constexpr int NPH_LAYER = 9, NPHASE = 1 + 2 * NPH_LAYER + 1;
#ifndef MK_ONLY
#define MK_ONLY -1
#endif
#ifndef MK_ITEM
#define MK_ITEM -1
#endif
#define EN(o) (MK_ONLY < 0 || MK_ONLY == (o))
#define IT(o) (MK_ITEM < 0 || MK_ITEM == (o))
__global__ void __launch_bounds__(NTHR, 2) mk_forward(Params P) {
    extern __shared__ __attribute__((aligned(16))) unsigned char lds_raw[];
    Frame F; F.lds = (LAS unsigned char*)lds_raw; F.tid = threadIdx.x; F.lane = F.tid & 63; F.wave = __builtin_amdgcn_readfirstlane(F.tid >> 6); F.bid = blockIdx.x; F.G = gridDim.x;
    F.in = (in_tab_t)__builtin_amdgcn_kernarg_segment_ptr(); F.out = P.out; F.ws = P.ws; F.ctl = (unsigned*)(P.ws + WS_CTL); F.misc = (volatile LAS int*)(F.lds + MISC_OFF);
    if (F.tid < 64) ((LAS unsigned*)(F.lds + MISC_OFF))[F.tid] = 0u;
    __syncthreads();
    const int lo = P.ph_lo, hi = P.ph_hi;
    XcdBarrier bar; bar.bar = F.ctl + CW_BAR; bar.x = 0; bar.st = (volatile LAS unsigned*)(F.lds + MISC_OFF + 16);
    if (hi - lo > 1) bar = xcd_barrier_post(F.ctl + CW_BAR, (volatile LAS unsigned*)(F.lds + MISC_OFF + 16));
#define IN(k) (lo <= (k) && (k) < hi)
#define SEAM(k) do { if (IN(k) && IN((k) + 1)) xcd_barrier(bar); } while (0)
#define QLOOP(qi, n, body) for (;;) { const int it = q_pop(F, layer * 12 + (qi)); if (it >= (n)) break; body; }
    if (EN(100) && IN(0)) { phase_prologue(F); phase_norm(F, F.in[I_X], false, F.in[I_NORM1], 3); } SEAM(0);
#pragma unroll
    for (int layer = 0; layer < DEPTH; ++layer) {
        const int pb = 1 + layer * NPH_LAYER;
        if (layer > 0) { if (EN(0) && IN(pb + 0)) { phase_norm(F, (const float*)(F.ws + WS_X), true, F.in[I_NORM1] + (size_t)layer * DM, 0); } SEAM(pb + 0); }
        if (EN(1) && IN(pb + 1)) { const Frame F_ = F; Frame F = relocal(F_); pg8::StaticOrder S; S.init((const bf16_t*)(F.ws + WS_H), (const bf16_t*)(F.ws + WS_WIN) + (size_t)layer * NINP * DM, NTOK, NINP, DM, F.G, F.bid);
            pg8::EpiBf16 E{(bf16_t*)(F.ws + WS_U), NINP}; pg8::gemm_phase(F.lds, DM, S, E); } SEAM(pb + 1);
#define SLOOP(n, body) for (int it = F.bid; it < (n); it += F.G) { __syncthreads(); body; }
        if (EN(2) && IN(pb + 2)) {
            if (IT(1)) SLOOP(1024, item_rwkv1(F, layer, it));
            if (IT(0)) SLOOP(256, item_s5<1>(F, layer, it));
            if (IT(2)) SLOOP(256, item_mamba<1>(F, layer, it));
            if (IT(3)) SLOOP(256, item_kv(F, layer, it));
        } SEAM(pb + 2);
        if (EN(3) && IN(pb + 3)) {
            if (IT(0)) SLOOP(8, item_rwkv_carry(F, it));
            if (IT(1)) { for (int it = F.bid - 8; it >= 0 && it < 16; it += F.G) { __syncthreads(); item_mamba_carry(F, it); } }
            if (IT(2)) { for (int it = F.bid - 24; it >= 0 && it < 4; it += F.G) { __syncthreads(); item_s5_carry(F, layer, it); } }
            if (IT(3)) {
                dsa_tables(F);
                const int pref = (int)(xb_xcc_id() & 3u);
#pragma unroll 1
                for (int k4 = 0; k4 < 4; ++k4) { const int bq = (pref + k4) & 3;
                    for (;;) { const int it = q_pop(F, 24 + layer * 4 + bq); if (it >= 512) break; item_dsa(F, layer, it * 4 + bq); } } }
        } SEAM(pb + 3);
        if (EN(4) && IN(pb + 4)) {
            if (IT(0)) SLOOP(256, item_s5<2>(F, layer, it));
            if (IT(2)) SLOOP(256, item_mamba<2>(F, layer, it));
            if (IT(1)) SLOOP(1024, item_rwkv3(F, layer, it));
        } SEAM(pb + 4);
        if (EN(6) && IN(pb + 5)) { const Frame F_ = F; Frame F = relocal(F_); pg8::StaticOrder S; S.init((const bf16_t*)(F.ws + WS_H), (const bf16_t*)(F.ws + WS_WOUT) + (size_t)layer * DM * DM, NTOK, DM, DM, F.G, F.bid);
            pg8::EpiResid E{layer == 0 ? F.in[I_X] : (const float*)(F.ws + WS_X), (float*)(F.ws + WS_X), DM}; pg8::gemm_phase(F.lds, DM, S, E); } SEAM(pb + 5);
        if (EN(7) && IN(pb + 6)) { phase_router(F, layer); phase_moe_convert(F, layer); phase_gather(F, layer); } SEAM(pb + 6);
        if (EN(8) && IN(pb + 7)) { const Frame F_ = F; Frame F = relocal(F_); LAS int* ul = (LAS int*)(F.lds + pg8::STAGE_BYTES + 8192); if (F.tid == 0) pg8::MoeOrder::build(ul, (const int*)(F.ws + WS_TILES), 2, F.G, F.bid); __syncthreads();
            pg8::MoeOrder S{DM, (const char*)(F.ws + WS_U), (const char*)(F.ws + WS_MOE + MOE_WGU), (size_t)512 * 1024 * 2, ul};
            pg8::EpiGated<1> E{(bf16_t*)(F.ws + WS_H), 256, 0, nullptr, nullptr}; pg8::gemm_phase<pg8::EpiGated<1>, pg8::MoeOrder, true>(F.lds, DM, S, E, (const char*)(F.ws + WS_U), (const int*)(F.ws + WS_ROWS)); phase_moe_convert_down(F, layer); } SEAM(pb + 7);
        if (EN(9) && IN(pb + 8)) { const Frame F_ = F; Frame F = relocal(F_); LAS int* ul = (LAS int*)(F.lds + pg8::STAGE_BYTES + 8192); if (F.tid == 0) pg8::MoeOrder::build(ul, (const int*)(F.ws + WS_TILES), 4, F.G, F.bid); __syncthreads();
            pg8::MoeOrder S{256, (const char*)(F.ws + WS_H), (const char*)(F.ws + WS_MOE + MOE_WD), (size_t)1024 * 256 * 2, ul};
            pg8::EpiMoeOut E{(bf16_t*)(F.ws + WS_U), (const int*)(F.ws + WS_ROWS), (const float*)(F.ws + WS_ROWS) + MAXROWS, F.lds}; pg8::gemm_phase(F.lds, 256, S, E); } SEAM(pb + 8);
    }
    if (EN(101) && IN(NPHASE - 1)) { phase_norm(F, (const float*)(F.ws + WS_X), true, F.in[I_FNORM], 2); }
#undef IN
#undef SEAM
}

#ifndef MK_SPLIT
#define MK_SPLIT 0
#endif
extern "C" void kernel_launch(void* const* d_in, const int* in_sizes, int n_in, void* d_out, int out_size, void* d_ws, size_t ws_size, hipStream_t stream) {
    static int grid = 0;
    if (grid == 0) {
        if (n_in != 44 || out_size != NTOK * DM || ws_size < WS_END) { fprintf(stderr, "kernel_launch: unexpected shapes (n_in %d out %d ws %zu need %zu)\n", n_in, out_size, ws_size, (size_t)WS_END); grid = -1; return; }
        int dev = 0, cus = 0;
        if (hipGetDevice(&dev) != hipSuccess || hipDeviceGetAttribute(&cus, hipDeviceAttributeMultiprocessorCount, dev) != hipSuccess) { grid = -1; return; }
        if (hipFuncSetAttribute((const void*)mk_forward, hipFuncAttributeMaxDynamicSharedMemorySize, LDS_BYTES) != hipSuccess) { fprintf(stderr, "kernel_launch: hipFuncSetAttribute failed\n"); grid = -1; return; }
        int per_cu = 0;
        if (hipOccupancyMaxActiveBlocksPerMultiprocessor(&per_cu, (const void*)mk_forward, NTHR, LDS_BYTES) != hipSuccess || per_cu < 1) { fprintf(stderr, "kernel_launch: occupancy query says %d\n", per_cu); }
        (void)hipGetLastError();
        grid = cus;
    }
    if (grid < 0) return;
    hipMemsetAsync((char*)d_ws + WS_CTL, 0, CTL_BYTES, stream);
    Params p{};
    for (int i = 0; i < 44; ++i) p.in[i] = (const float*)d_in[i];
    p.out = (float*)d_out; p.ws = (unsigned char*)d_ws;
#if MK_SPLIT
    for (int ph = 0; ph < NPHASE; ++ph) { p.ph_lo = ph; p.ph_hi = ph + 1; hipLaunchKernelGGL(mk_forward, dim3(grid), dim3(NTHR), LDS_BYTES, stream, p); }
#else
    p.ph_lo = 0; p.ph_hi = NPHASE; hipLaunchKernelGGL(mk_forward, dim3(grid), dim3(NTHR), LDS_BYTES, stream, p);
#endif
}
```

```cpp
#include <hip/hip_runtime.h>
#include <stdint.h>
#include <stdio.h>

#define LAS __attribute__((address_space(3)))
typedef unsigned short bf16_t;
typedef short bf16x8 __attribute__((ext_vector_type(8)));
typedef float f32x4 __attribute__((ext_vector_type(4)));
typedef float f32x2 __attribute__((ext_vector_type(2)));
typedef float f32x16 __attribute__((ext_vector_type(16)));
typedef unsigned u32x4 __attribute__((ext_vector_type(4)));
typedef unsigned u32x2 __attribute__((ext_vector_type(2)));

constexpr int NTOK = 16384, DM = 1024, SEQ = 4096, NBATCH = 4, DEPTH = 2;
constexpr int NIN = 2604, NINP = 2816;
constexpr int UM = 0;
constexpr int UR = 784;
constexpr int UC = 1680;
constexpr int US = 2368;
constexpr int NTHR = 512;
constexpr int LDS_BYTES = 163840;
constexpr int MISC_OFF = LDS_BYTES - 256;

constexpr size_t WS_CTL   = 0;
constexpr size_t CTL_BYTES = 65536;
constexpr size_t WS_X     = WS_CTL + CTL_BYTES;
constexpr size_t WS_H     = WS_X + (size_t)NTOK * DM * 4;
constexpr size_t WS_U     = WS_H + (size_t)NTOK * DM * 2;
constexpr size_t WS_WIN   = WS_U + (size_t)NTOK * NINP * 2;
constexpr size_t WS_WOUT  = WS_WIN + (size_t)2 * NINP * DM * 2;
constexpr size_t WS_GLU   = WS_WOUT + (size_t)2 * DM * DM * 2;
constexpr size_t WS_MOE   = WS_GLU + (size_t)2 * 512 * 256 * 2;
constexpr size_t MOE_WGU  = 0;
constexpr size_t MOE_WD   = (size_t)32 * 512 * 1024 * 2;
constexpr size_t MOE_BYTES = MOE_WD + (size_t)32 * 1024 * 256 * 2;
constexpr size_t RW_PT    = 0;
constexpr size_t RW_U     = (size_t)1024 * 4096 * 2;
constexpr size_t RW_S     = RW_U + (size_t)1024 * 4096 * 2;
constexpr size_t RW_W1    = RW_S + (size_t)1024 * 4096 * 2;
constexpr size_t RW_Z     = RW_W1 + (size_t)1024 * 4096 * 2;
constexpr size_t YSG_OFF  = RW_Z + (size_t)1024 * 4096 * 2;
static_assert(YSG_OFF + (size_t)NTOK * 256 * 2 <= MOE_BYTES, "alias");
constexpr size_t WS_MST   = WS_MOE + MOE_BYTES;
constexpr size_t WS_MDEC  = WS_MST + (size_t)4 * 64 * 4 * 4096 * 4;
constexpr size_t WS_S5ST  = WS_MDEC + 4096;
constexpr size_t WS_K     = WS_S5ST + (size_t)4 * 64 * 2048 * 4;
constexpr size_t WS_V     = WS_K + (size_t)NTOK * 64 * 2;
constexpr size_t WS_KIDX  = WS_V + (size_t)NTOK * 64 * 2;
constexpr size_t WS_ROUTE = WS_KIDX + (size_t)NTOK * 32 * 2;
constexpr size_t WS_ROWS  = WS_ROUTE + (size_t)NTOK * 32;
constexpr int    MAXROWS  = 49152;
constexpr size_t WS_TILES = WS_ROWS + (size_t)MAXROWS * 8;
constexpr size_t WS_S5TAB = WS_TILES + 4096;
constexpr size_t S5TAB_F  = (size_t)(2048 + 2048 + 32768) * 4;
constexpr size_t S5TAB_BBT = S5TAB_F + (size_t)16 * 16 * 128 * 2;
constexpr size_t S5TAB_L  = S5TAB_BBT + (size_t)16 * 128 * 16 * 2;
constexpr size_t WS_WRT   = WS_S5TAB + 2 * S5TAB_L;
constexpr size_t WS_BON   = WS_WRT + (size_t)2 * 2 * 48 * 1024 * 2;
constexpr size_t WS_END   = WS_BON + (size_t)1024 * 64 * 4;

constexpr int CW_BAR = 0;
constexpr int CW_Q   = 4096;
constexpr int CW_CNT = 8192;
constexpr int CW_RB  = 8448;

__device__ __forceinline__ float bf2f(bf16_t b) { return __uint_as_float(((unsigned)b) << 16); }
__device__ __forceinline__ bf16_t f2bf(float f) { const __bf16 h = (__bf16)f; return __builtin_bit_cast(bf16_t, h); }
__device__ __forceinline__ unsigned pk2(float lo, float hi) { typedef __bf16 bf2_t __attribute__((ext_vector_type(2))); const bf2_t h = __builtin_convertvector((f32x2){lo, hi}, bf2_t); return __builtin_bit_cast(unsigned, h); }
__device__ __forceinline__ unsigned cvt_pk_bf16(float lo, float hi) { unsigned r; asm volatile("v_cvt_pk_bf16_f32 %0, %1, %2" : "=v"(r) : "v"(lo), "v"(hi)); return r; }
__device__ __forceinline__ float sigmoidf_(float x) { return 1.0f / (1.0f + __expf(-x)); }
__device__ __forceinline__ float siluf_(float x) { return x / (1.0f + __expf(-x)); }
__device__ __forceinline__ float tanhf_(float x) { const float e = __expf(2.0f * x); return 1.0f - 2.0f / (e + 1.0f); }
__device__ __forceinline__ float softplusf_(float x) { return fmaxf(x, 0.0f) + log1pf(__expf(-fabsf(x))); }
__device__ __forceinline__ float gelu_tanh(float x) { return 0.5f * x * (1.0f + tanhf_(0.7978845608028654f * (x + 0.044715f * x * x * x))); }
template <int CTRL> __device__ __forceinline__ float dppf(float x) { return __int_as_float(__builtin_amdgcn_update_dpp(0, __float_as_int(x), CTRL, 0xF, 0xF, true)); }
__device__ __forceinline__ float sum4(float x) { x += dppf<0xB1>(x); x += dppf<0x4E>(x); return x; }
__device__ __forceinline__ float sum8(float x) { x = sum4(x); x += dppf<0x141>(x); return x; }
__device__ __forceinline__ float sum16(float x) { x = sum8(x); x += dppf<0x140>(x); return x; }
__device__ __forceinline__ int lane_id_() { int l = (int)__builtin_amdgcn_mbcnt_hi(~0u, __builtin_amdgcn_mbcnt_lo(~0u, 0u)); asm volatile("" : "+v"(l)); return l; }
__device__ __forceinline__ float shx(float x, int o) { return __int_as_float(__builtin_amdgcn_ds_bpermute((lane_id_() ^ o) << 2, __float_as_int(x))); }
__device__ __forceinline__ unsigned shdown_u(unsigned x, int o) { return (unsigned)__builtin_amdgcn_ds_bpermute(((lane_id_() + o) & 63) << 2, (int)x); }
__device__ __forceinline__ int shidx_i(int x, int src) { return __builtin_amdgcn_ds_bpermute(src << 2, x); }
__device__ __forceinline__ float wave_sum(float x) { x = sum16(x); x += shx(x, 16); x += shx(x, 32); return x; }
__device__ __forceinline__ void unpack8(const u32x4 v, float (&f)[8]) {
    f[0] = __uint_as_float(v.x << 16); f[1] = __uint_as_float(v.x & 0xffff0000u); f[2] = __uint_as_float(v.y << 16); f[3] = __uint_as_float(v.y & 0xffff0000u);
    f[4] = __uint_as_float(v.z << 16); f[5] = __uint_as_float(v.z & 0xffff0000u); f[6] = __uint_as_float(v.w << 16); f[7] = __uint_as_float(v.w & 0xffff0000u);
}

#define XB_TMO      128
#define XB_XCNT(j)  (256  + 64 * (j))
#define XB_XSUB(j)  (1280 + 64 * (j))
#define XB_XGEN(j)  (2304 + 64 * (j))
#define XB_TOP      3328
#define XB_TOPGEN   3392
#define XCD_BAR_WORDS 3456
#define XB_SPIN_CAP (1u << 22)
__device__ __forceinline__ unsigned xb_ld(unsigned* p)              { return __hip_atomic_load(p, __ATOMIC_RELAXED, __HIP_MEMORY_SCOPE_AGENT); }
__device__ __forceinline__ unsigned xb_add(unsigned* p, unsigned v) { return __hip_atomic_fetch_add(p, v, __ATOMIC_RELAXED, __HIP_MEMORY_SCOPE_AGENT); }
__device__ __forceinline__ unsigned xb_xcc_id() { return (unsigned)__builtin_amdgcn_s_getreg((3 << 11) | 20) & 0xFu; }
#define XB_SPIN(cond, bar) do { unsigned _sp = 0; while (cond) { __builtin_amdgcn_s_sleep(1); \
    if ((++_sp & 255u) == 0u) { if (xb_ld(&(bar)[XB_TMO])) break; if (_sp > XB_SPIN_CAP) { atomicAdd(&(bar)[XB_TMO], 1u); break; } } } } while (0)
struct XcdBarrier { unsigned* bar; unsigned x; volatile LAS unsigned* st; };
__device__ __forceinline__ XcdBarrier xcd_barrier_post(unsigned* bar, volatile LAS unsigned* st) {
    XcdBarrier b; b.bar = bar; b.x = xb_xcc_id(); b.st = st;
    if (threadIdx.x == 0) (void)xb_add(&bar[XB_XCNT(b.x)], 1u);
    return b;
}
__device__ __forceinline__ void xcd_barrier_complete(unsigned* bar, unsigned x, unsigned& nloc, unsigned& nx) {
    const unsigned G = gridDim.x * gridDim.y * gridDim.z;
    unsigned sum, cnt, mine, sp = 0u;
    for (;;) {
        sum = 0u; cnt = 0u; mine = 0u;
#pragma unroll
        for (unsigned j = 0; j < 16; ++j) { const unsigned c = xb_ld(&bar[XB_XCNT(j)]); sum += c; cnt += (c > 0u) ? 1u : 0u; mine = (j == x) ? c : mine; }
        if (sum == G) break;
        __builtin_amdgcn_s_sleep(1);
        if ((++sp & 255u) == 0u) { if (xb_ld(&bar[XB_TMO])) break; if (sp > XB_SPIN_CAP) { atomicAdd(&bar[XB_TMO], 1u); break; } }
    }
    nloc = mine > 0u ? mine : 1u; nx = cnt > 0u ? cnt : 1u;
}
__device__ __forceinline__ void xcd_barrier(const XcdBarrier& b_) {
    XcdBarrier b = b_; { const unsigned long long v = (unsigned long long)b.bar; unsigned lo = __builtin_amdgcn_readfirstlane((unsigned)v), hi = __builtin_amdgcn_readfirstlane((unsigned)(v >> 32)); asm volatile("" : "+s"(lo), "+s"(hi)); b.bar = (unsigned*)(((unsigned long long)hi << 32) | lo); unsigned xx = __builtin_amdgcn_readfirstlane(b.x); asm volatile("" : "+s"(xx)); b.x = xx; }
    asm volatile("s_waitcnt vmcnt(0)" ::: "memory");
    __syncthreads();
    if (threadIdx.x == 0) {
        unsigned* bar = b.bar;
        __builtin_amdgcn_s_waitcnt(0);
        unsigned nloc = b.st[0], nx = b.st[1];
        if (nloc == 0u) { xcd_barrier_complete(bar, b.x, nloc, nx); b.st[0] = nloc; b.st[1] = nx; }
        const unsigned old = xb_add(&bar[XB_XSUB(b.x)], 1u);
        const unsigned gen = old / nloc;
        if (old + 1u == (gen + 1u) * nloc) {
            __builtin_amdgcn_fence(__ATOMIC_RELEASE, "agent");
            asm volatile("s_waitcnt vmcnt(0)" ::: "memory");
            const unsigned og = xb_add(&bar[XB_TOP], 1u);
            const unsigned tg = og / nx;
            if (og + 1u == (tg + 1u) * nx) xb_add(&bar[XB_TOPGEN], 1u);
            else XB_SPIN(xb_ld(&bar[XB_TOPGEN]) == tg, bar);
            __builtin_amdgcn_fence(__ATOMIC_ACQUIRE, "agent");
            xb_add(&bar[XB_XGEN(b.x)], 1u);
            asm volatile("s_waitcnt vmcnt(0)" ::: "memory");
        } else {
            XB_SPIN(xb_ld(&bar[XB_XGEN(b.x)]) == gen, bar);
            __builtin_amdgcn_fence(__ATOMIC_ACQUIRE, "agent");
            asm volatile("s_waitcnt vmcnt(0)" ::: "memory");
        }
    }
    __syncthreads();
}

namespace pg8 {
constexpr int BM = 256, BK = 64, HALF = 128, HTB = HALF * BK * 2, STAGE_BYTES = 8 * HTB, NXCD = 8, WGM = 8;
__host__ __device__ __forceinline__ int lds_byte(int r, int c) { const int st = (r >> 4) * 2 + (c >> 5), rr = r & 15, cc = c & 31, ob = rr * 64 + cc * 2; return st * 1024 + (ob ^ (((ob >> 9) & 1) << 5)); }
__host__ __device__ __forceinline__ void stage_rc(int b, int& R, int& C) { const int st = b / 1024, sb = b % 1024, swz = sb ^ (((sb >> 9) & 1) << 5); R = (st >> 1) * 16 + swz / 64; C = (st & 1) * 32 + (swz % 64) / 2; }
__host__ __device__ __forceinline__ int perm32(int rho) { const int n = rho >> 4, i = rho & 15; return 8 * (i >> 2) + 4 * n + (i & 3); }
struct Unit { int pm, pn; const char* a; const char* b; };

struct StaticOrder {
    int nM, nN, nwg, G, c, K; const char* A; const char* B;
    __device__ void init(const bf16_t* A_, const bf16_t* B_, int M, int N, int K_, int G_, int c_) { A = (const char*)A_; B = (const char*)B_; K = K_; nM = M / BM; nN = N / BM; nwg = nM * nN; G = G_; c = c_; }
    __device__ bool next(int i, Unit& u) const {
        const long L = (long)i * G + c; if (L >= nwg) return false;
        int wgid = (int)L; { const int q = nwg / NXCD, r = nwg % NXCD, xcd = wgid % NXCD, off = wgid / NXCD; wgid = (xcd < r ? xcd * (q + 1) : r * (q + 1) + (xcd - r) * q) + off; }
        const int nig = WGM * nN, gid = wgid / nig, fm = gid * WGM, gsz = (nM - fm) < WGM ? (nM - fm) : WGM;
        u.pm = fm + ((wgid % nig) % gsz); u.pn = (wgid % nig) / gsz;
        u.a = A + (size_t)u.pm * 256 * K * 2; u.b = B + (size_t)u.pn * 256 * K * 2; return true;
    }
};

template <class Epi, class Sched, bool GATHER = false>
__device__ __forceinline__ void gemm_phase(LAS unsigned char* lds, const int K_, const Sched& S, const Epi& E, const char* Aall = nullptr, const int* arow = nullptr) {
    int K = K_; asm volatile("" : "+s"(K));
    int tid_ = threadIdx.x; asm volatile("" : "+v"(tid_));
    const int tid = tid_, wid = __builtin_amdgcn_readfirstlane(tid >> 6), lane = tid & 63, wr = wid >> 2, wc = wid & 3, fr = lane & 15, fq = lane >> 4;
    const int nt = K / BK;
    unsigned voffA[2], voffB[2]; int Rst[2], Cst[2];
#pragma unroll
    for (int i = 0; i < 2; ++i) { int R, C; stage_rc(tid * 16 + i * 8192, R, C); const int Rb = Epi::PERM ? ((R & ~31) + perm32(R & 31)) : R; Rst[i] = R; Cst[i] = C;
        voffA[i] = (unsigned)(R * K + C) * 2u; voffB[i] = (unsigned)(Rb * K + C) * 2u; }
    unsigned gv[2][2], gn[2][2];
#define PG8_GOFF(dst, unit) do { _Pragma("unroll") for (int h_ = 0; h_ < 2; ++h_) _Pragma("unroll") for (int i_ = 0; i_ < 2; ++i_) { const int rr_ = arow[(unit).pm * BM + h_ * HALF + Rst[i_]]; \
        dst[h_][i_] = ((unsigned)(rr_ < 0 ? 0 : rr_ >> 1) * (unsigned)K + (unsigned)Cst[i_]) * 2u; } } while (0)
    const size_t kstep = (size_t)(BK * 2);
    const size_t hstep = (size_t)HALF * K * 2;
    const unsigned ldsw = (unsigned)wid * 1024u;
    const int aoff = lds_byte(wr * 64 + fr, fq * 8), boff = lds_byte(wc * 32 + fr, fq * 8);
#define PG8_SA(b, h) (((b) * 2 + (h)) * HTB)
#define PG8_SB(b, h) ((4 + (b) * 2 + (h)) * HTB)
#define PG8_STAGE(bufoff, gbase, voff) do { _Pragma("unroll") for (int _i = 0; _i < 2; ++_i) \
        __builtin_amdgcn_global_load_lds((const unsigned*)((const char*)(gbase) + (voff)[_i]), (LAS unsigned*)(lds + (bufoff) + ldsw + _i * 8192), 16, 0, 0); } while (0)
#define PG8_LDA(dst, b, h) do { _Pragma("unroll") for (int m = 0; m < 4; ++m) _Pragma("unroll") for (int k = 0; k < 2; ++k) dst[m][k] = *(const LAS bf16x8*)(lds + PG8_SA(b, h) + aoff + m * 2048 + k * 1024); } while (0)
#define PG8_LDB(dst, b, h) do { _Pragma("unroll") for (int n = 0; n < 2; ++n) _Pragma("unroll") for (int k = 0; k < 2; ++k) dst[n][k] = *(const LAS bf16x8*)(lds + PG8_SB(b, h) + boff + n * 2048 + k * 1024); } while (0)
#define PG8_MMA(ai, bj, At, Bt) do { __builtin_amdgcn_s_setprio(1); _Pragma("unroll") for (int m = 0; m < 4; ++m) _Pragma("unroll") for (int n = 0; n < 2; ++n) _Pragma("unroll") for (int k = 0; k < 2; ++k) \
        acc[ai][bj][m][n] = __builtin_amdgcn_mfma_f32_16x16x32_bf16(Bt[n][k], At[m][k], acc[ai][bj][m][n], 0, 0, 0); __builtin_amdgcn_s_setprio(0); } while (0)
#define PG8_WAIT_V(n) asm volatile("s_waitcnt vmcnt(" #n ")" ::: "memory")
#define PG8_WAIT_L(n) asm volatile("s_waitcnt lgkmcnt(" #n ")" ::: "memory")
#define PG8_BAR __builtin_amdgcn_s_barrier()
#define PG8_SCHED __builtin_amdgcn_sched_barrier(0)
    Unit cur, nxt; int ui = 0;
    if (!S.next(0, cur)) return;
    f32x4 acc[2][2][4][2];
#pragma unroll
    for (int a = 0; a < 2; ++a)
#pragma unroll
        for (int b = 0; b < 2; ++b)
#pragma unroll
            for (int m = 0; m < 4; ++m)
#pragma unroll
                for (int n = 0; n < 2; ++n) acc[a][b][m][n] = (f32x4){0.f, 0.f, 0.f, 0.f};
    bf16x8 At[4][2], B0[2][2], B1[2][2];
    const char* cA = GATHER ? Aall : cur.a; const char* cB = cur.b;
    if (GATHER) PG8_GOFF(gv, cur);
#define PG8_STAGE_A(bufoff, gbase, h, vo) do { if (GATHER) PG8_STAGE(bufoff, gbase, (vo)[h]); else PG8_STAGE(bufoff, (gbase) + ((h) ? hstep : 0), voffA); } while (0)
    PG8_STAGE(PG8_SB(0, 0), cB, voffB); PG8_STAGE_A(PG8_SA(0, 0), cA, 0, gv); PG8_STAGE(PG8_SB(0, 1), cB + hstep, voffB); PG8_STAGE_A(PG8_SA(0, 1), cA, 1, gv);
    if (wr == 1) PG8_BAR;
    PG8_WAIT_V(4); PG8_BAR;
    PG8_STAGE(PG8_SB(1, 0), cB + kstep, voffB); PG8_STAGE_A(PG8_SA(1, 0), cA + kstep, 0, gv); PG8_STAGE(PG8_SB(1, 1), cB + hstep + kstep, voffB);
    PG8_WAIT_V(6); PG8_BAR;
    for (;;) {
        const bool has_next = S.next(ui + 1, nxt);
        const char* nA = GATHER ? cA : (has_next ? nxt.a : cA); const char* nB = has_next ? nxt.b : cB;
        if (GATHER) { if (has_next) PG8_GOFF(gn, nxt); else {
#pragma unroll
            for (int h_ = 0; h_ < 2; ++h_)
#pragma unroll
                for (int i_ = 0; i_ < 2; ++i_) gn[h_][i_] = gv[h_][i_]; } }
        for (int t = 0; t < nt; t += 2) {
            const bool last = (t == nt - 2);
            const char* a1 = cA + (size_t)(t + 1) * kstep;
            const char* a2 = last ? nA : cA + (size_t)(t + 2) * kstep; const char* b2 = last ? nB : cB + (size_t)(t + 2) * kstep;
            const char* a3 = a2 + kstep; const char* b3 = b2 + kstep;
            unsigned vo2[2][2];
#pragma unroll
            for (int h_ = 0; h_ < 2; ++h_)
#pragma unroll
                for (int i_ = 0; i_ < 2; ++i_) vo2[h_][i_] = GATHER ? (last ? gn[h_][i_] : gv[h_][i_]) : 0u;
            PG8_LDB(B0, 0, 0); PG8_SCHED; PG8_LDA(At, 0, 0); PG8_STAGE_A(PG8_SA(1, 1), a1, 1, gv);
            PG8_WAIT_L(8); PG8_BAR; PG8_WAIT_L(0); PG8_MMA(0, 0, At, B0); PG8_BAR; PG8_SCHED;
            PG8_LDB(B1, 0, 1); PG8_STAGE(PG8_SB(0, 0), b2, voffB);
            PG8_BAR; PG8_WAIT_L(0); PG8_MMA(0, 1, At, B1); PG8_BAR;
            PG8_LDA(At, 0, 1); PG8_STAGE_A(PG8_SA(0, 0), a2, 0, vo2);
            PG8_BAR; PG8_WAIT_L(0); PG8_MMA(1, 0, At, B0); PG8_BAR; PG8_SCHED;
            PG8_STAGE(PG8_SB(0, 1), b2 + hstep, voffB);
            PG8_WAIT_V(6); PG8_BAR; PG8_MMA(1, 1, At, B1); PG8_BAR;
            PG8_LDB(B0, 1, 0); PG8_SCHED; PG8_LDA(At, 1, 0); PG8_STAGE_A(PG8_SA(0, 1), a2, 1, vo2);
            PG8_WAIT_L(8); PG8_BAR; PG8_WAIT_L(0); PG8_MMA(0, 0, At, B0); PG8_BAR; PG8_SCHED;
            PG8_LDB(B1, 1, 1); PG8_STAGE(PG8_SB(1, 0), b3, voffB);
            PG8_BAR; PG8_WAIT_L(0); PG8_MMA(0, 1, At, B1); PG8_BAR;
            PG8_LDA(At, 1, 1); PG8_STAGE_A(PG8_SA(1, 0), a3, 0, vo2);
            PG8_BAR; PG8_WAIT_L(0); PG8_MMA(1, 0, At, B0); PG8_BAR; PG8_SCHED;
            PG8_STAGE(PG8_SB(1, 1), b3 + hstep, voffB);
            PG8_WAIT_V(6); PG8_BAR; PG8_MMA(1, 1, At, B1); PG8_BAR;
        }
        E(acc, cur, wr, wc, fr, fq);
        if (!has_next) break;
#pragma unroll
        for (int a = 0; a < 2; ++a)
#pragma unroll
            for (int b = 0; b < 2; ++b)
#pragma unroll
                for (int m = 0; m < 4; ++m)
#pragma unroll
                    for (int n = 0; n < 2; ++n) acc[a][b][m][n] = (f32x4){0.f, 0.f, 0.f, 0.f};
        cur = nxt; cA = nA; cB = nB; ++ui;
        if (GATHER) {
#pragma unroll
            for (int h_ = 0; h_ < 2; ++h_)
#pragma unroll
                for (int i_ = 0; i_ < 2; ++i_) gv[h_][i_] = gn[h_][i_]; }
    }
    PG8_WAIT_V(0);
    if (wr == 0) PG8_BAR;
    PG8_BAR;
#undef PG8_SA
#undef PG8_SB
#undef PG8_STAGE
#undef PG8_STAGE_A
#undef PG8_GOFF
#undef PG8_LDA
#undef PG8_LDB
#undef PG8_MMA
#undef PG8_WAIT_V
#undef PG8_WAIT_L
#undef PG8_BAR
#undef PG8_SCHED
}

struct EpiBf16 {
    static constexpr bool PERM = true;
    bf16_t* O; int ldc;
    __device__ __forceinline__ void operator()(const f32x4 (&acc)[2][2][4][2], const Unit& u, int wr, int wc, int fr, int fq) const {
        const int row0 = u.pm * BM + wr * 64 + fr, col0 = u.pn * BM + wc * 32 + 8 * fq;
#pragma unroll
        for (int ai = 0; ai < 2; ++ai)
#pragma unroll
            for (int m = 0; m < 4; ++m) { bf16_t* rowp = O + (size_t)(row0 + ai * HALF + m * 16) * ldc + col0;
#pragma unroll
                for (int bj = 0; bj < 2; ++bj) { const f32x4 v0 = acc[ai][bj][m][0], v1 = acc[ai][bj][m][1];
                    u32x4 w; w.x = cvt_pk_bf16(v0[0], v0[1]); w.y = cvt_pk_bf16(v0[2], v0[3]); w.z = cvt_pk_bf16(v1[0], v1[1]); w.w = cvt_pk_bf16(v1[2], v1[3]);
                    *(u32x4*)(rowp + bj * HALF) = w; } }
    }
};
struct EpiResid {
    static constexpr bool PERM = false;
    const float* Cin; float* C; int ldc;
    __device__ __forceinline__ void operator()(const f32x4 (&acc)[2][2][4][2], const Unit& u, int wr, int wc, int fr_, int fq_) const {
        int fr = fr_, fq = fq_; asm volatile("" : "+v"(fr), "+v"(fq));
        const int row0 = u.pm * BM + wr * 64 + fr, col0 = u.pn * BM + wc * 32 + 4 * fq;
#pragma unroll
        for (int ai = 0; ai < 2; ++ai)
#pragma unroll
            for (int mp = 0; mp < 2; ++mp) { f32x4 cv[2][2][2];
#pragma unroll
                for (int mm = 0; mm < 2; ++mm) { const float* rowp = Cin + (size_t)(row0 + ai * HALF + (2 * mp + mm) * 16) * ldc + col0;
#pragma unroll
                    for (int bj = 0; bj < 2; ++bj)
#pragma unroll
                        for (int n = 0; n < 2; ++n) cv[mm][bj][n] = *(const f32x4*)(rowp + bj * HALF + n * 16); }
#pragma unroll
                for (int mm = 0; mm < 2; ++mm) { float* rowp = C + (size_t)(row0 + ai * HALF + (2 * mp + mm) * 16) * ldc + col0;
#pragma unroll
                    for (int bj = 0; bj < 2; ++bj)
#pragma unroll
                        for (int n = 0; n < 2; ++n) *(f32x4*)(rowp + bj * HALF + n * 16) = cv[mm][bj][n] + acc[ai][bj][2 * mp + mm][n]; }
                asm volatile("" ::: "memory"); }
    }
};
template <int ACT  > struct EpiGated {
    static constexpr bool PERM = true;
    bf16_t* O; int ldo; int coloff; const float* ba; const float* bb;
    __device__ __forceinline__ void operator()(const f32x4 (&acc)[2][2][4][2], const Unit& u, int wr, int wc, int fr, int fq) const {
        const int row0 = u.pm * BM + wr * 64 + fr, cl = u.pn * HALF + wc * 32 + 8 * fq;
        float va[8], vb[8];
#pragma unroll
        for (int j = 0; j < 8; ++j) { va[j] = (ACT == 0) ? ba[cl + j] : 0.f; vb[j] = (ACT == 0) ? bb[cl + j] : 0.f; }
#pragma unroll
        for (int ai = 0; ai < 2; ++ai)
#pragma unroll
            for (int m = 0; m < 4; ++m) { bf16_t* rowp = O + (size_t)(row0 + ai * HALF + m * 16) * ldo + coloff + cl;
                float o[8];
#pragma unroll
                for (int n = 0; n < 2; ++n)
#pragma unroll
                    for (int j = 0; j < 4; ++j) { const float a = acc[ai][0][m][n][j] + va[4 * n + j], b = acc[ai][1][m][n][j] + vb[4 * n + j];
                        o[4 * n + j] = (ACT == 0) ? a * sigmoidf_(b) : siluf_(a) * b; }
                u32x4 w; w.x = cvt_pk_bf16(o[0], o[1]); w.y = cvt_pk_bf16(o[2], o[3]); w.z = cvt_pk_bf16(o[4], o[5]); w.w = cvt_pk_bf16(o[6], o[7]);
                *(u32x4*)rowp = w; asm volatile("" ::: "memory"); }
    }
};
struct EpiMoeOut {
    static constexpr bool PERM = true;
    bf16_t* O; const int* row_tok; const float* row_w; LAS unsigned char* lds;
    __device__ __forceinline__ void operator()(const f32x4 (&acc)[2][2][4][2], const Unit& u, int wr, int wc, int fr_, int fq_) const {
        int fr = fr_, fq = fq_; asm volatile("" : "+v"(fr), "+v"(fq));
        const int col0 = u.pn * BM + wc * 32 + 8 * fq, lane = fq * 16 + fr;
        LAS u32x2* rinfo = (LAS u32x2*)(lds + STAGE_BYTES) + (wr * 4 + wc) * 128;
        { const int ra = u.pm * BM + wr * 64 + lane, rb = ra + HALF;
          const u32x2 ia = (u32x2){(unsigned)row_tok[ra], __float_as_uint(row_w[ra])}, ib = (u32x2){(unsigned)row_tok[rb], __float_as_uint(row_w[rb])};
          rinfo[lane] = ia; rinfo[64 + lane] = ib; }
#pragma unroll
        for (int ai = 0; ai < 2; ++ai)
#pragma unroll
            for (int m = 0; m < 4; ++m) { const u32x2 inf = rinfo[ai * 64 + m * 16 + fr]; const int ts = (int)inf.x; const float w = __uint_as_float(inf.y);
                if (ts >= 0) { bf16_t* rowp = O + ((size_t)(ts & 1) * NTOK + (size_t)(ts >> 1)) * DM + col0;
#pragma unroll
                    for (int bj = 0; bj < 2; ++bj) { const f32x4 v0 = acc[ai][bj][m][0] * w, v1 = acc[ai][bj][m][1] * w;
                        u32x4 q; q.x = cvt_pk_bf16(v0[0], v0[1]); q.y = cvt_pk_bf16(v0[2], v0[3]); q.z = cvt_pk_bf16(v1[0], v1[1]); q.w = cvt_pk_bf16(v1[2], v1[3]);
                        *(u32x4*)(rowp + bj * HALF) = q; } } }
    }
};
struct MoeOrder {
    int K; const char* A; const char* B; size_t bstride; const LAS int* list;
    static __device__ __forceinline__ void build(LAS int* list, const int* tiles, int nN, int G, int c) {
        const int nrt = tiles[0], nwg = nrt * nN; int n = 0;
        for (int i = 0; ; ++i) { const long L = (long)i * G + c; if (L >= (long)nwg || n >= 20) break;
            int wgid = (int)L; { const int q = nwg / NXCD, r = nwg % NXCD, xcd = wgid % NXCD, off = wgid / NXCD; wgid = (xcd < r ? xcd * (q + 1) : r * (q + 1) + (xcd - r) * q) + off; }
            const int pm = wgid / nN; list[1 + 3 * n] = pm; list[2 + 3 * n] = wgid % nN; list[3 + 3 * n] = tiles[64 + pm]; ++n; }
        list[0] = n;
    }
    __device__ bool next(int i, Unit& u) const {
        const int n = __builtin_amdgcn_readfirstlane(list[0]); if (i >= n) return false;
        u.pm = __builtin_amdgcn_readfirstlane(list[1 + 3 * i]); u.pn = __builtin_amdgcn_readfirstlane(list[2 + 3 * i]); const int e = __builtin_amdgcn_readfirstlane(list[3 + 3 * i]);
        u.a = A + (size_t)u.pm * 256 * K * 2; u.b = B + (size_t)e * bstride + (size_t)u.pn * 256 * K * 2; return true;
    }
};
}

struct Params { const float* in[44]; float* out; unsigned char* ws; int ph_lo, ph_hi; };
enum { I_X = 0, I_NORM1, I_WIN, I_MCONVW, I_MCONVB, I_MDTB, I_MALOG, I_MD, I_MNORM, I_RMU, I_RW0, I_RW2, I_RA0, I_RA2, I_RG2, I_RKK, I_RKA, I_RRK, I_RLNW, I_RLNB,
       I_CKVN, I_CWUK, I_CWUV, I_RELB, I_SARE, I_SAIM, I_SBRE, I_SBIM, I_SCRE, I_SCIM, I_SD, I_SLOGDT, I_SGLUW, I_SGLUB, I_WOUT, I_NORM2, I_WRG, I_BRG, I_WRE, I_BRE,
       I_WGATE, I_WUP, I_WDOWN, I_FNORM };

typedef const float* const __attribute__((address_space(4)))* in_tab_t;
struct Frame {
    LAS unsigned char* lds; int tid, lane, wave, bid, G;
    in_tab_t in; float* out; unsigned char* ws; unsigned* ctl;
    volatile LAS int* misc;
};

__device__ __forceinline__ int q_pop(Frame& F, int qi) {
    __syncthreads();
    if (F.tid == 0) F.misc[0] = (int)__hip_atomic_fetch_add(F.ctl + CW_Q + 64 * qi, 1u, __ATOMIC_RELAXED, __HIP_MEMORY_SCOPE_AGENT);
    __syncthreads();
    return F.misc[0];
}

__device__ __forceinline__ const void* opaque_ptr(const void* p) { const unsigned long long v = (unsigned long long)p; unsigned lo = __builtin_amdgcn_readfirstlane((unsigned)v), hi = __builtin_amdgcn_readfirstlane((unsigned)(v >> 32));
    asm volatile("" : "+s"(lo), "+s"(hi)); return (const void*)(((unsigned long long)hi << 32) | lo); }
__device__ __forceinline__ Frame relocal(const Frame& G) { Frame F = G; asm volatile("" : "+v"(F.tid)); F.ws = (unsigned char*)opaque_ptr(F.ws); F.ctl = (unsigned*)(F.ws + WS_CTL); F.in = (in_tab_t)(unsigned long long)opaque_ptr((const void*)(unsigned long long)F.in); F.lane = F.tid & 63; F.wave = __builtin_amdgcn_readfirstlane(F.tid >> 6); return F; }
template <int K> __device__ __forceinline__ f32x4 mma_nt(const LAS bf16_t* A, int lda, const LAS bf16_t* Bt, int ldb, f32x4 acc, int lane) {
    const int r = lane & 15, g = lane >> 4;
#pragma unroll
    for (int k0 = 0; k0 < K; k0 += 32) {
        const bf16x8 a = *(const LAS bf16x8*)(A + r * lda + k0 + 8 * g);
        const bf16x8 b = *(const LAS bf16x8*)(Bt + r * ldb + k0 + 8 * g);
        acc = __builtin_amdgcn_mfma_f32_16x16x32_bf16(a, b, acc, 0, 0, 0);
    }
    return acc;
}

template <class SrcMap> __device__ __forceinline__ void tr_tile(Frame& F, int ldsrc, bf16_t* dst, int K, int k0, int n0, SrcMap sm) {
    LAS float* tile = (LAS float*)F.lds;
    __syncthreads();
    { const int n4 = (F.tid & 63) * 4, kk = F.tid >> 6; const float* sp = sm(n0 + n4);
      f32x4 v[8];
#pragma unroll
      for (int ps = 0; ps < 8; ++ps) { v[ps] = (f32x4){0.f, 0.f, 0.f, 0.f}; if (sp) v[ps] = __builtin_nontemporal_load((const f32x4*)(sp + (size_t)(k0 + kk + 8 * ps) * ldsrc)); }
#pragma unroll
      for (int ps = 0; ps < 8; ++ps) { LAS float* t = tile + (kk + 8 * ps) * 257 + n4; t[0] = v[ps][0]; t[1] = v[ps][1]; t[2] = v[ps][2]; t[3] = v[ps][3]; } }
    __syncthreads();
    { const int kc = F.tid & 7;
#pragma unroll
      for (int j = 0; j < 4; ++j) { const int n = (F.tid >> 3) + 64 * j; float f[8];
#pragma unroll
          for (int i = 0; i < 8; ++i) f[i] = tile[(8 * kc + i) * 257 + n];
          u32x4 w; w.x = pk2(f[0], f[1]); w.y = pk2(f[2], f[3]); w.z = pk2(f[4], f[5]); w.w = pk2(f[6], f[7]);
          *(u32x4*)(dst + (size_t)(n0 + n) * K + k0 + 8 * kc) = w; } }
}

struct SmIn { const float* base; __device__ __forceinline__ const float* operator()(int n) const {
    int c; if (n < 772) c = n; else if (n < UR) return nullptr; else if (n < UR + 896) c = 772 + (n - UR); else if (n < UC) return nullptr;
    else if (n < UC + 680) c = 1668 + (n - UC); else if (n < US) return nullptr; else if (n < US + 256) c = 2348 + (n - US); else return nullptr; return base + c; } };
struct SmId { const float* base; __device__ __forceinline__ const float* operator()(int n) const { return base + n; } };
struct SmGlu { const float* base; __device__ __forceinline__ const float* operator()(int n) const { const int pn = n >> 8, rr = n & 255; return base + (rr < 128 ? 128 * pn + rr : 256 + 128 * pn + (rr - 128)); } };
struct SmGU { const float* gate; const float* up; __device__ __forceinline__ const float* operator()(int n) const {
    const unsigned long long d = (unsigned long long)up - (unsigned long long)gate; const unsigned long long a = (unsigned long long)gate + (((n & 255) < 128) ? 0ull : d); return (const float*)a + 128 * (n >> 8) + (n & 127); } };
__device__ __forceinline__ void phase_prologue(const Frame& F_) { Frame F = relocal(F_);
    for (int t = F.bid; t < 496; t += F.G) {
        if (t < 352) { const int l = t / 176, r = t % 176, kt = r / 11, nt = r % 11;
            tr_tile(F, NIN, (bf16_t*)(F.ws + WS_WIN) + (size_t)l * NINP * DM, DM, kt * 64, nt * 256, SmIn{F.in[I_WIN] + (size_t)l * DM * NIN}); }
        else if (t < 480) { const int q = t - 352, l = q / 64, r = q % 64, kt = r / 4, nt = r % 4;
            tr_tile(F, DM, (bf16_t*)(F.ws + WS_WOUT) + (size_t)l * DM * DM, DM, kt * 64, nt * 256, SmId{F.in[I_WOUT] + (size_t)l * DM * DM}); }
        else { const int q = t - 480, l = q / 8, r = q % 8, kt = r / 2, nt = r % 2;
            tr_tile(F, 512, (bf16_t*)(F.ws + WS_GLU) + (size_t)l * 512 * 256, 256, kt * 64, nt * 256, SmGlu{F.in[I_SGLUW] + (size_t)l * 256 * 512}); }
    }
    for (int i = F.bid * NTHR + F.tid; i < 2 * 48 * 1024; i += F.G * NTHR) { const int l = i / 49152, r = i % 49152, o = r >> 10, k = r & 1023;
        float v = 0.f; if (o < 32) v = F.in[I_WRE][((size_t)l * DM + k) * 32 + o]; else if (o < 36) v = F.in[I_WRG][((size_t)l * DM + k) * 4 + (o - 32)];
        v *= F.in[I_NORM2][l * DM + k];
        const bf16_t hi = f2bf(v); const bf16_t lo = f2bf(v - bf2f(hi));
        bf16_t* w = (bf16_t*)(F.ws + WS_WRT) + (size_t)l * 2 * 49152; w[r] = hi; w[49152 + r] = lo; }
    for (int i = F.bid * NTHR + F.tid; i < 2048 + 65536; i += F.G * NTHR) {
        if (i < 2048) {
            const int l = i >> 10, gn = i & 1023, g = gn >> 6;
            float* tab = (float*)(F.ws + WS_S5TAB + (size_t)l * S5TAB_L);
            const float lre = fminf(F.in[I_SARE][l * 1024 + gn], -1e-4f), lim = F.in[I_SAIM][l * 1024 + gn];
            const float dt = expf(F.in[I_SLOGDT][l * 16 + g]);
            const float mag = expf(dt * lre); float sn, cs; sincosf(dt * lim, &sn, &cs);
            const float are = mag * cs, aim = mag * sn;
            const float den = lre * lre + lim * lim;
            const float fre = ((are - 1.0f) * lre + aim * lim) / den, fim = (aim * lre - (are - 1.0f) * lim) / den;
            tab[gn * 2] = are; tab[gn * 2 + 1] = aim;
            float pr = are, pi = aim;
#pragma unroll
            for (int s = 0; s < 6; ++s) { const float nr = pr * pr - pi * pi, ni = 2.0f * pr * pi; pr = nr; pi = ni; }
            tab[2048 + gn * 2] = pr; tab[2048 + gn * 2 + 1] = pi;
            const float* bre = F.in[I_SBRE] + ((size_t)l * 1024 + gn) * 16; const float* bim = F.in[I_SBIM] + ((size_t)l * 1024 + gn) * 16;
            bf16_t* bbt = (bf16_t*)(F.ws + WS_S5TAB + (size_t)l * S5TAB_L + S5TAB_BBT); const int n = gn & 63, col = 4 * (n & 31) + 2 * (n >> 5);
            for (int p = 0; p < 16; ++p) { const float vr = fre * bre[p] - fim * bim[p], vi = fre * bim[p] + fim * bre[p];
                bbt[((size_t)g * 128 + col) * 16 + p] = f2bf(vr); bbt[((size_t)g * 128 + col + 1) * 16 + p] = f2bf(vi); }
        } else {
            const int j = i - 2048, l = j >> 15, r = j & 32767, gp = r >> 7, k = r & 127;
            bf16_t* cm = (bf16_t*)(F.ws + WS_S5TAB + (size_t)l * S5TAB_L + S5TAB_F);
            const int n = (k >> 2) + 32 * ((k >> 1) & 1);
            const float v = (k & 1) == 0 ? F.in[I_SCRE][((size_t)l * 256 + gp) * 64 + n] : -F.in[I_SCIM][((size_t)l * 256 + gp) * 64 + n];
            cm[r] = f2bf(v);
        }
    }
}

__device__ __forceinline__ void phase_norm(const Frame& F_, const float* xin, bool add_o, const float* w, int mode) { Frame F = relocal(F_);
    float* X = (float*)(F.ws + WS_X); bf16_t* H = (bf16_t*)(F.ws + WS_H); const bf16_t* O = (const bf16_t*)(F.ws + WS_U);
    for (int row0 = F.bid * 32 + F.wave * 4; row0 < NTOK; row0 += F.G * 32) {
        f32x4 v[4][4]; u32x2 oa[4][4], ob[4][4];
#pragma unroll
        for (int r = 0; r < 4; ++r)
#pragma unroll
            for (int j = 0; j < 4; ++j) { const int c = 4 * F.lane + 256 * j; const size_t o = (size_t)(row0 + r) * DM + c; v[r][j] = *(const f32x4*)(xin + o);
                if (add_o) { oa[r][j] = *(const u32x2*)(O + o); ob[r][j] = *(const u32x2*)(O + (size_t)NTOK * DM + o); } }
#pragma unroll
        for (int r = 0; r < 4; ++r) { const int row = row0 + r; float ss = 0.f;
#pragma unroll
            for (int j = 0; j < 4; ++j) {
                if (add_o) { const u32x2 a = oa[r][j], b = ob[r][j];
                    v[r][j][0] += __uint_as_float(a.x << 16) + __uint_as_float(b.x << 16); v[r][j][1] += __uint_as_float(a.x & 0xffff0000u) + __uint_as_float(b.x & 0xffff0000u);
                    v[r][j][2] += __uint_as_float(a.y << 16) + __uint_as_float(b.y << 16); v[r][j][3] += __uint_as_float(a.y & 0xffff0000u) + __uint_as_float(b.y & 0xffff0000u); }
                ss += v[r][j][0] * v[r][j][0] + v[r][j][1] * v[r][j][1] + v[r][j][2] * v[r][j][2] + v[r][j][3] * v[r][j][3]; }
            ss = wave_sum(ss);
            const float rstd = rsqrtf(ss * (1.0f / DM) + 1e-6f);
#pragma unroll
            for (int j = 0; j < 4; ++j) { const int c = 4 * F.lane + 256 * j; const f32x4 wv = *(const f32x4*)(w + c);
                if (mode == 2) { *(f32x4*)(F.out + (size_t)row * DM + c) = v[r][j] * rstd * wv; }
                else { if (mode == 0) *(f32x4*)(X + (size_t)row * DM + c) = v[r][j];
                    u32x2 o; o.x = pk2(v[r][j][0] * rstd * wv[0], v[r][j][1] * rstd * wv[1]); o.y = pk2(v[r][j][2] * rstd * wv[2], v[r][j][3] * rstd * wv[3]);
                    *(u32x2*)(H + (size_t)row * DM + c) = o; } } }
    }
}

__device__ __forceinline__ void item_kv(const Frame& F_, int layer, int item) { Frame F = relocal(F_);
    const bf16_t* U = (const bf16_t*)(F.ws + WS_U);
    LAS bf16_t* Ab = (LAS bf16_t*)F.lds;
    LAS bf16_t* Bt = (LAS bf16_t*)(F.lds + 17408);
    const int t0 = item * 64;
    { const int tok = F.tid >> 3, part = F.tid & 7; const bf16_t* src = U + (size_t)(t0 + tok) * NINP + UC + 256 + 16 * part;
      float f[16]; { float a[8], b[8]; unpack8(*(const u32x4*)src, a); unpack8(*(const u32x4*)(src + 8), b);
#pragma unroll
        for (int j = 0; j < 8; ++j) { f[j] = a[j]; f[8 + j] = b[j]; } }
      float ss = 0.f;
#pragma unroll
      for (int j = 0; j < 16; ++j) ss += f[j] * f[j];
      ss = sum8(ss);
      const float rstd = rsqrtf(ss * (1.0f / 128.0f) + 1e-6f); const float* nw = F.in[I_CKVN] + layer * 128 + 16 * part;
#pragma unroll
      for (int j = 0; j < 16; j += 2) *(LAS unsigned*)(Ab + tok * 136 + 16 * part + j) = pk2(f[j] * rstd * nw[j], f[j + 1] * rstd * nw[j + 1]); }
    { const int n = F.tid >> 2, kq = F.tid & 3; const float* w = (n < 64 ? F.in[I_CWUK] : F.in[I_CWUV]) + (size_t)layer * 128 * 64 + (n & 63);
      float wv[32];
#pragma unroll
      for (int k = 0; k < 32; ++k) wv[k] = w[(size_t)(32 * kq + k) * 64];
#pragma unroll
      for (int k = 0; k < 32; k += 2) *(LAS unsigned*)(Bt + n * 136 + 32 * kq + k) = pk2(wv[k], wv[k + 1]); }
    if (F.tid < 256) { const int tok = F.tid >> 2, q = F.tid & 3;
        *(u32x4*)((bf16_t*)(F.ws + WS_KIDX) + (size_t)(t0 + tok) * 32 + 8 * q) = *(const u32x4*)(U + (size_t)(t0 + tok) * NINP + UC + 640 + 8 * q); }
    __syncthreads();
    const int mt = F.wave & 3, g = F.lane >> 4, r = F.lane & 15;
#pragma unroll
    for (int q = 0; q < 4; ++q) { const int nt = (F.wave >> 2) * 4 + q;
        f32x4 acc = (f32x4){0.f, 0.f, 0.f, 0.f};
        acc = mma_nt<128>(Ab + mt * 16 * 136, 136, Bt + nt * 16 * 136, 136, acc, F.lane);
        const int n = nt * 16 + r; bf16_t* dst = (bf16_t*)(F.ws + (n < 64 ? WS_K : WS_V));
#pragma unroll
        for (int i = 0; i < 4; ++i) dst[(size_t)(t0 + mt * 16 + 4 * g + i) * 64 + (n & 63)] = f2bf(acc[i]); }
}

constexpr int MB_CG = 0, MB_BG = 18432, MB_BT = 36864, MB_XT = 55296, MB_M = 92160, MB_S0 = 101376, MB_DT = 110592, MB_AC = 111616, MB_RS = 112640;
template <int STAGE> __device__ __forceinline__ void item_mamba(const Frame& F_, int layer, int item) { Frame F = relocal(F_);
    const bf16_t* U = (const bf16_t*)(F.ws + WS_U);
    const int b = item >> 6, c = item & 63, l0 = c * 64; const size_t T0 = (size_t)b * SEQ + l0;
    LAS bf16_t* Cg = (LAS bf16_t*)(F.lds + MB_CG); LAS bf16_t* Bg = (LAS bf16_t*)(F.lds + MB_BG); LAS bf16_t* BT = (LAS bf16_t*)(F.lds + MB_BT);
    LAS bf16_t* XT = (LAS bf16_t*)(F.lds + MB_XT); LAS bf16_t* Mb = (LAS bf16_t*)(F.lds + MB_M); LAS bf16_t* S0 = (LAS bf16_t*)(F.lds + MB_S0);
    LAS float* dts = (LAS float*)(F.lds + MB_DT); LAS float* acs = (LAS float*)(F.lds + MB_AC); LAS float* rs = (LAS float*)(F.lds + MB_RS);
    if (F.tid < 256) { const int l = F.tid >> 2, h = F.tid & 3;
        const float raw = bf2f(U[(T0 + l) * NINP + UM + 768 + h]) + F.in[I_MDTB][layer * 4 + h];
        const float dt = softplusf_(raw); dts[l * 4 + h] = dt; acs[l * 4 + h] = -__expf(F.in[I_MALOG][layer * 4 + h]) * dt; }
    if (F.tid < 64) rs[F.tid] = 0.f;
    __syncthreads();
    float mycum = 0.f;
    if (F.tid < 256) { const int l = F.tid >> 2, h = F.tid & 3; for (int s = 0; s <= l; ++s) mycum += acs[s * 4 + h]; }
    __syncthreads();
    if (F.tid < 256) acs[F.tid] = mycum;
    __syncthreads();
    { const int ch8 = F.tid & 63, tg = F.tid >> 6, c0 = ch8 * 8;
      float wv[4][8], bv[8];
#pragma unroll
      for (int j = 0; j < 8; ++j) { bv[j] = F.in[I_MCONVB][layer * 512 + c0 + j];
#pragma unroll
          for (int k = 0; k < 4; ++k) wv[k][j] = F.in[I_MCONVW][(layer * 4 + k) * 512 + c0 + j]; }
      float win[3][8];
#pragma unroll
      for (int k = 0; k < 3; ++k) { const int l = l0 + tg * 8 - 3 + k;
          if (l >= 0) unpack8(*(const u32x4*)(U + ((size_t)b * SEQ + l) * NINP + UM + 256 + c0), win[k]);
          else {
#pragma unroll
              for (int j = 0; j < 8; ++j) win[k][j] = 0.f; } }
#pragma unroll 1
      for (int ib = 0; ib < 2; ++ib) { u32x4 rows[4];
#pragma unroll
          for (int i4 = 0; i4 < 4; ++i4) rows[i4] = *(const u32x4*)(U + (T0 + tg * 8 + ib * 4 + i4) * NINP + UM + 256 + c0);
#pragma unroll
      for (int i4 = 0; i4 < 4; ++i4) { const int l = tg * 8 + ib * 4 + i4; float cur[8]; unpack8(rows[i4], cur);
          float o[8];
#pragma unroll
          for (int j = 0; j < 8; ++j) { o[j] = siluf_(bv[j] + wv[0][j] * win[0][j] + wv[1][j] * win[1][j] + wv[2][j] * win[2][j] + wv[3][j] * cur[j]);
              win[0][j] = win[1][j]; win[1][j] = win[2][j]; win[2][j] = cur[j]; }
          if (c0 < 256) { const int h = c0 >> 6, p0 = c0 & 63; float sc = dts[l * 4 + h]; if (STAGE == 1) sc *= __expf(acs[63 * 4 + h] - acs[l * 4 + h]);
#pragma unroll
              for (int j = 0; j < 8; ++j) XT[(h * 64 + p0 + j) * 72 + l] = f2bf(o[j] * sc); }
          else if (c0 < 384) { const int g = (c0 - 256) >> 6, n0 = (c0 - 256) & 63;
              if (STAGE == 1) {
#pragma unroll
                  for (int j = 0; j < 8; ++j) BT[(g * 64 + n0 + j) * 72 + l] = f2bf(o[j]); }
              else { u32x4 w; w.x = pk2(o[0], o[1]); w.y = pk2(o[2], o[3]); w.z = pk2(o[4], o[5]); w.w = pk2(o[6], o[7]); *(LAS u32x4*)(Bg + (g * 64 + l) * 72 + n0) = w; } }
          else if (STAGE == 2) { const int g = (c0 - 384) >> 6, n0 = (c0 - 384) & 63;
              u32x4 w; w.x = pk2(o[0], o[1]); w.y = pk2(o[2], o[3]); w.z = pk2(o[4], o[5]); w.w = pk2(o[6], o[7]); *(LAS u32x4*)(Cg + (g * 64 + l) * 72 + n0) = w; } } } }
    __syncthreads();
    const int g4 = F.lane >> 4, r16 = F.lane & 15;
    if (STAGE == 1) {
        float* MST = (float*)(F.ws + WS_MST) + ((size_t)(b * 64 + c) * 4) * 4096;
#pragma unroll
        for (int q = 0; q < 8; ++q) { const int tix = F.wave * 8 + q, h = tix >> 4, mt = (tix >> 2) & 3, nt = tix & 3;
            f32x4 acc = (f32x4){0.f, 0.f, 0.f, 0.f};
            acc = mma_nt<64>(XT + (h * 64 + mt * 16) * 72, 72, BT + ((h >> 1) * 64 + nt * 16) * 72, 72, acc, F.lane);
#pragma unroll
            for (int i = 0; i < 4; ++i) MST[(size_t)h * 4096 + (mt * 16 + 4 * g4 + i) * 64 + nt * 16 + r16] = acc[i]; }
        if (F.tid < 4) ((float*)(F.ws + WS_MDEC))[(b * 64 + c) * 4 + F.tid] = __expf(acs[63 * 4 + F.tid]);
    } else {
        const int mt = F.wave & 3, nh = F.wave >> 2;
        const float* MST = (const float*)(F.ws + WS_MST) + ((size_t)(b * 64 + c) * 4) * 4096;
        f32x4 G[2], yv[4][2];
#pragma unroll
        for (int h = 0; h < 4; ++h) {
            const int g = h >> 1;
            { const float* src = MST + (size_t)h * 4096 + F.tid * 8; const f32x4 a = *(const f32x4*)src, bq = *(const f32x4*)(src + 4);
              u32x4 w; w.x = pk2(a[0], a[1]); w.y = pk2(a[2], a[3]); w.z = pk2(bq[0], bq[1]); w.w = pk2(bq[2], bq[3]);
              *(LAS u32x4*)(S0 + (F.tid >> 3) * 72 + (F.tid & 7) * 8) = w; }
            if ((h & 1) == 0) {
#pragma unroll
                for (int q = 0; q < 2; ++q) { G[q] = (f32x4){0.f, 0.f, 0.f, 0.f};
                    G[q] = mma_nt<64>(Cg + (g * 64 + mt * 16) * 72, 72, Bg + (g * 64 + (2 * nh + q) * 16) * 72, 72, G[q], F.lane); } }
#pragma unroll
            for (int q = 0; q < 2; ++q) { const int s = (2 * nh + q) * 16 + r16; const float as = acs[s * 4 + h];
#pragma unroll
                for (int i = 0; i < 4; ++i) { const int l = mt * 16 + 4 * g4 + i; const float v = (s <= l) ? G[q][i] * __expf(acs[l * 4 + h] - as) : 0.f;
                    Mb[l * 72 + s] = f2bf(v); } }
            __syncthreads();
#pragma unroll
            for (int q = 0; q < 2; ++q) { const int nt = 2 * nh + q;
                f32x4 yd = (f32x4){0.f, 0.f, 0.f, 0.f}, yo = (f32x4){0.f, 0.f, 0.f, 0.f};
                yd = mma_nt<64>(Mb + mt * 16 * 72, 72, XT + (h * 64 + nt * 16) * 72, 72, yd, F.lane);
                yo = mma_nt<64>(Cg + (g * 64 + mt * 16) * 72, 72, S0 + nt * 16 * 72, 72, yo, F.lane);
                const int p = nt * 16 + r16; const float dsk = F.in[I_MD][layer * 4 + h];
#pragma unroll
                for (int i = 0; i < 4; ++i) { const int l = mt * 16 + 4 * g4 + i;
                    const float xs = bf2f(XT[(h * 64 + p) * 72 + l]) / dts[l * 4 + h];
                    yv[h][q][i] = yd[i] + yo[i] * __expf(acs[l * 4 + h]) + dsk * xs; } }
            __syncthreads();
        }
        float part[4] = {0.f, 0.f, 0.f, 0.f};
#pragma unroll
        for (int h = 0; h < 4; ++h)
#pragma unroll
            for (int q = 0; q < 2; ++q) { const int ch = h * 64 + (2 * nh + q) * 16 + r16;
#pragma unroll
                for (int i = 0; i < 4; ++i) { const int l = mt * 16 + 4 * g4 + i; const float z = bf2f(U[(T0 + l) * NINP + UM + ch]);
                    const float v = yv[h][q][i] * siluf_(z); yv[h][q][i] = v; part[i] += v * v; } }
#pragma unroll
        for (int i = 0; i < 4; ++i) { const float s = sum16(part[i]); if (r16 == 0) atomicAdd((float*)(rs + mt * 16 + 4 * g4 + i), s); }
        __syncthreads();
        bf16_t* Y = (bf16_t*)(F.ws + WS_H);
#pragma unroll
        for (int i = 0; i < 4; ++i) { const int l = mt * 16 + 4 * g4 + i; const float rstd = rsqrtf(rs[l] * (1.0f / 256.0f) + 1e-6f);
#pragma unroll
            for (int h = 0; h < 4; ++h)
#pragma unroll
                for (int q = 0; q < 2; ++q) { const int ch = h * 64 + (2 * nh + q) * 16 + r16;
                    Y[(T0 + l) * DM + ch] = f2bf(yv[h][q][i] * rstd * F.in[I_MNORM][layer * 256 + ch]); } }
    }
}
__device__ __forceinline__ void item_mamba_carry(const Frame& F_, int item) { Frame F = relocal(F_);
    const int b = item >> 2, h = item & 3;
    float* MST = (float*)(F.ws + WS_MST); const float* MD = (const float*)(F.ws + WS_MDEC);
    float s[8];
#pragma unroll
    for (int j = 0; j < 8; ++j) s[j] = 0.f;
    for (int c = 0; c < 64; ++c) { float* p = MST + ((size_t)(b * 64 + c) * 4 + h) * 4096 + F.tid * 8; const float d = MD[(b * 64 + c) * 4 + h];
        const f32x4 a = *(f32x4*)p, q = *(f32x4*)(p + 4);
        *(f32x4*)p = (f32x4){s[0], s[1], s[2], s[3]}; *(f32x4*)(p + 4) = (f32x4){s[4], s[5], s[6], s[7]};
        s[0] = s[0] * d + a[0]; s[1] = s[1] * d + a[1]; s[2] = s[2] * d + a[2]; s[3] = s[3] * d + a[3];
        s[4] = s[4] * d + q[0]; s[5] = s[5] * d + q[1]; s[6] = s[6] * d + q[2]; s[7] = s[7] * d + q[3]; }
}

template <int STAGE> __device__ __forceinline__ void item_s5(const Frame& F_, int layer, int item) { Frame F = relocal(F_);
    const bf16_t* U = (const bf16_t*)(F.ws + WS_U);
    const int b = item >> 6, c = item & 63; const size_t T0 = (size_t)b * SEQ + c * 64;
    LAS bf16_t* us = (LAS bf16_t*)F.lds;
    LAS bf16_t* BuW = (LAS bf16_t*)(F.lds + 33792) + F.wave * 4224;
    const float* tab = (const float*)(F.ws + WS_S5TAB + (size_t)layer * S5TAB_L);
    { const int tok = F.tid >> 3, part = F.tid & 7;
#pragma unroll
      for (int q = 0; q < 4; ++q) *(LAS u32x4*)(us + tok * 264 + 32 * part + 8 * q) = *(const u32x4*)(U + (T0 + tok) * NINP + US + 32 * part + 8 * q); }
    const int lane = F.lane, r16 = lane & 15, g4 = lane >> 4, gq = lane >> 5, n0 = lane & 31, g = 2 * F.wave + gq, gn0 = g * 64 + n0, gn1 = gn0 + 32;
    bf16x8 bfr[2][8];
    { const bf16_t* bbt = (const bf16_t*)(F.ws + WS_S5TAB + (size_t)layer * S5TAB_L + S5TAB_BBT);
#pragma unroll
      for (int gg = 0; gg < 2; ++gg)
#pragma unroll
          for (int nt = 0; nt < 8; ++nt) { u32x4 z = (u32x4){0u, 0u, 0u, 0u}; if (g4 < 2) z = *(const u32x4*)(bbt + ((size_t)(2 * F.wave + gg) * 128 + 16 * nt + r16) * 16 + 8 * g4); bfr[gg][nt] = __builtin_bit_cast(bf16x8, z); } }
    const float a0r = tab[gn0 * 2], a0i = tab[gn0 * 2 + 1], a1r = tab[gn1 * 2], a1i = tab[gn1 * 2 + 1];
    float* ST = (float*)(F.ws + WS_S5ST) + (size_t)(b * 64 + c) * 2048;
    float h0r = 0.f, h0i = 0.f, h1r = 0.f, h1i = 0.f;
    if (STAGE == 2) { h0r = ST[gn0 * 2]; h0i = ST[gn0 * 2 + 1]; h1r = ST[gn1 * 2]; h1i = ST[gn1 * 2 + 1]; }
    bf16x8 cf[2][4];
    if (STAGE == 2) { const bf16_t* cm = (const bf16_t*)(F.ws + WS_S5TAB + (size_t)layer * S5TAB_L + S5TAB_F);
#pragma unroll
        for (int gg = 0; gg < 2; ++gg)
#pragma unroll
            for (int ks = 0; ks < 4; ++ks) cf[gg][ks] = *(const bf16x8*)(cm + ((size_t)((2 * F.wave + gg) * 16 + r16)) * 128 + 32 * ks + 8 * g4); }
    __syncthreads();
#pragma unroll 1
    for (int lb = 0; lb < 4; ++lb) {
#pragma unroll
        for (int gg = 0; gg < 2; ++gg) { u32x4 z = (u32x4){0u, 0u, 0u, 0u}; if (g4 < 2) z = *(const LAS u32x4*)(us + (16 * lb + r16) * 264 + (2 * F.wave + gg) * 16 + 8 * g4);
            const bf16x8 afr = __builtin_bit_cast(bf16x8, z);
#pragma unroll
            for (int nt = 0; nt < 8; ++nt) { const f32x4 acc = __builtin_amdgcn_mfma_f32_16x16x32_bf16(afr, bfr[gg][nt], (f32x4){0.f, 0.f, 0.f, 0.f}, 0, 0, 0);
#pragma unroll
                for (int i = 0; i < 4; ++i) BuW[(4 * g4 + i) * 264 + gg * 128 + 16 * nt + r16] = f2bf(acc[i]); } }
        __syncthreads();
#pragma unroll 4
        for (int li = 0; li < 16; ++li) { LAS u32x2* bp = (LAS u32x2*)(BuW + li * 264 + gq * 128 + 4 * n0); const u32x2 v = *bp;
            { const float br = __uint_as_float(v.x << 16), bi = __uint_as_float(v.x & 0xffff0000u); const float nr = a0r * h0r - a0i * h0i + br, ni = a0r * h0i + a0i * h0r + bi; h0r = nr; h0i = ni; }
            { const float br = __uint_as_float(v.y << 16), bi = __uint_as_float(v.y & 0xffff0000u); const float nr = a1r * h1r - a1i * h1i + br, ni = a1r * h1i + a1i * h1r + bi; h1r = nr; h1i = ni; }
            if (STAGE == 2) *bp = (u32x2){pk2(h0r, h0i), pk2(h1r, h1i)}; }
        __syncthreads();
        if (STAGE == 2) {
            bf16_t* YS = (bf16_t*)(F.ws + WS_MOE + YSG_OFF);
#pragma unroll
            for (int gg = 0; gg < 2; ++gg) { f32x4 acc = (f32x4){0.f, 0.f, 0.f, 0.f};
#pragma unroll
                for (int ks = 0; ks < 4; ++ks) { const bf16x8 a = *(const LAS bf16x8*)(BuW + r16 * 264 + gg * 128 + 32 * ks + 8 * g4);
                    acc = __builtin_amdgcn_mfma_f32_16x16x32_bf16(a, cf[gg][ks], acc, 0, 0, 0); }
                const int ch = (2 * F.wave + gg) * 16 + r16; const float dsk = F.in[I_SD][layer * 256 + ch];
#pragma unroll
                for (int i = 0; i < 4; ++i) { const int l = lb * 16 + 4 * g4 + i; const float y = acc[i] + dsk * bf2f(us[l * 264 + ch]);
                    YS[(T0 + l) * 256 + ch] = f2bf(gelu_tanh(y)); } }
            __syncthreads();
        }
    }
    if (STAGE == 1) { ST[gn0 * 2] = h0r; ST[gn0 * 2 + 1] = h0i; ST[gn1 * 2] = h1r; ST[gn1 * 2 + 1] = h1i; }
    if (STAGE == 2) {
        asm volatile("s_waitcnt vmcnt(0)" ::: "memory"); __syncthreads();
        const bf16_t* YS = (const bf16_t*)(F.ws + WS_MOE + YSG_OFF) + T0 * 256; const bf16_t* GW = (const bf16_t*)(F.ws + WS_GLU) + (size_t)layer * 512 * 256;
        const int r16 = F.lane & 15, g4 = F.lane >> 4;
        f32x4 av[4][2], ag[4][2];
#pragma unroll
        for (int m = 0; m < 4; ++m)
#pragma unroll
            for (int q = 0; q < 2; ++q) { av[m][q] = (f32x4){0.f, 0.f, 0.f, 0.f}; ag[m][q] = (f32x4){0.f, 0.f, 0.f, 0.f}; }
#pragma unroll 2
        for (int ks = 0; ks < 8; ++ks) {
            bf16x8 af[4], bv[2], bg[2];
#pragma unroll
            for (int m = 0; m < 4; ++m) af[m] = *(const bf16x8*)(YS + (size_t)(16 * m + r16) * 256 + 32 * ks + 8 * g4);
#pragma unroll
            for (int q = 0; q < 2; ++q) { const int c = 32 * F.wave + 16 * q + r16; const int rowv = 256 * (c >> 7) + (c & 127);
                bv[q] = *(const bf16x8*)(GW + (size_t)rowv * 256 + 32 * ks + 8 * g4); bg[q] = *(const bf16x8*)(GW + (size_t)(rowv + 128) * 256 + 32 * ks + 8 * g4); }
#pragma unroll
            for (int m = 0; m < 4; ++m)
#pragma unroll
                for (int q = 0; q < 2; ++q) { av[m][q] = __builtin_amdgcn_mfma_f32_16x16x32_bf16(af[m], bv[q], av[m][q], 0, 0, 0); ag[m][q] = __builtin_amdgcn_mfma_f32_16x16x32_bf16(af[m], bg[q], ag[m][q], 0, 0, 0); }
        }
        bf16_t* Y = (bf16_t*)(F.ws + WS_H);
#pragma unroll
        for (int q = 0; q < 2; ++q) { const int c = 32 * F.wave + 16 * q + r16; const float bvl = F.in[I_SGLUB][layer * 512 + c], bgt = F.in[I_SGLUB][layer * 512 + 256 + c];
#pragma unroll
            for (int m = 0; m < 4; ++m)
#pragma unroll
                for (int i = 0; i < 4; ++i) Y[(T0 + 16 * m + 4 * g4 + i) * DM + 768 + c] = f2bf((av[m][q][i] + bvl) * sigmoidf_(ag[m][q][i] + bgt)); }
    }
}
__device__ __forceinline__ void item_s5_carry(const Frame& F_, int layer, int b) { Frame F = relocal(F_);
    const float* tab = (const float*)(F.ws + WS_S5TAB + (size_t)layer * S5TAB_L) + 2048;
    float* ST = (float*)(F.ws + WS_S5ST) + (size_t)b * 64 * 2048;
#pragma unroll
    for (int q = 0; q < 2; ++q) { const int gn = F.tid + 512 * q; const float pr = tab[gn * 2], pi = tab[gn * 2 + 1]; float hr = 0.f, hi = 0.f;
        for (int c = 0; c < 64; ++c) { float* p = ST + (size_t)c * 2048 + gn * 2; const float tr = p[0], ti = p[1]; p[0] = hr; p[1] = hi;
            const float nr = pr * hr - pi * hi + tr, ni = pr * hi + pi * hr + ti; hr = nr; hi = ni; } }
}

constexpr int RB_LD = 72;
constexpr int RW_R = 0, RW_K = 16384, RW_V = 32768, RW_W = 49152, RW_A = 65536, RW_B = 81920;
constexpr int R3_G = 49152, R3_O = 65536, R3_TILES = 81920, R3_BON = 147456;
template <int STAGE> __device__ __forceinline__ void rwkv_prep(const Frame& F_, int layer, int b, int h, int c) { Frame F = relocal(F_);
    const bf16_t* U = (const bf16_t*)(F.ws + WS_U);
    const int l0 = c * 64; const size_t T0 = (size_t)b * SEQ + l0;
    LAS float* Rr = (LAS float*)(F.lds + RW_R); LAS float* Kk = (LAS float*)(F.lds + RW_K); LAS float* Vv = (LAS float*)(F.lds + RW_V); LAS float* Ww = (LAS float*)(F.lds + RW_W);
    LAS float* Aa = (LAS float*)(F.lds + (STAGE == 1 ? RW_A : R3_O)); LAS float* Bb = (LAS float*)(F.lds + RW_B); LAS float* Gg = (LAS float*)(F.lds + R3_G); LAS float* BON = (LAS float*)(F.lds + R3_BON);
    LAS bf16_t* TWb = (LAS bf16_t*)(F.lds + 98304); LAS bf16_t* DAb = (LAS bf16_t*)(F.lds + (STAGE == 1 ? 103424 : 118784)); LAS bf16_t* SGb = (LAS bf16_t*)(F.lds + 123904);
    LAS bf16_t* w2T = (LAS bf16_t*)(F.lds + 108544); LAS bf16_t* a2T = (LAS bf16_t*)(F.lds + (STAGE == 1 ? 113664 : 133120)); LAS bf16_t* g2T = (LAS bf16_t*)(F.lds + 138240);
    const float* mu = F.in[I_RMU] + layer * 896;
    { const int tok = F.tid >> 3, p8 = F.tid & 7; const bool first = (l0 + tok == 0);
      const bf16_t* cur = U + (T0 + tok) * NINP + UR; const bf16_t* prv = first ? cur : cur - NINP;
      const float pz = first ? 0.f : 1.f;
      u32x4 cw[3], pw[3]; u32x2 c1 = (u32x2){0u, 0u}, p1 = (u32x2){0u, 0u}, c2 = (u32x2){0u, 0u}, p2 = (u32x2){0u, 0u}; u32x4 c3 = (u32x4){0u, 0u, 0u, 0u}, p3 = (u32x4){0u, 0u, 0u, 0u};
#pragma unroll
      for (int sec = (STAGE == 1 ? 0 : 2); sec < 3; ++sec) { const int co = sec * 256 + h * 64 + 8 * p8; cw[sec] = *(const u32x4*)(cur + co); pw[sec] = *(const u32x4*)(prv + co); }
      if (STAGE == 1) { c1 = *(const u32x2*)(cur + 768 + 4 * p8); p1 = *(const u32x2*)(prv + 768 + 4 * p8); c2 = *(const u32x2*)(cur + 800 + 4 * p8); p2 = *(const u32x2*)(prv + 800 + 4 * p8); }
      if (STAGE == 3) { c3 = *(const u32x4*)(cur + 832 + 8 * p8); p3 = *(const u32x4*)(prv + 832 + 8 * p8); }
#pragma unroll
      for (int sec = (STAGE == 1 ? 0 : 2); sec < 3; ++sec) { const int co = sec * 256 + h * 64 + 8 * p8; float av[8], pq[8]; unpack8(cw[sec], av); unpack8(pw[sec], pq);
          const f32x4 m0 = *(const f32x4*)(mu + co), m1 = *(const f32x4*)(mu + co + 4);
          LAS float* dst = (sec == 0 ? Rr : sec == 1 ? Kk : Vv) + tok * 64 + 8 * p8;
#pragma unroll
          for (int j = 0; j < 8; ++j) pq[j] *= pz;
          *(LAS f32x4*)dst = (f32x4){av[0] + m0[0] * (pq[0] - av[0]), av[1] + m0[1] * (pq[1] - av[1]), av[2] + m0[2] * (pq[2] - av[2]), av[3] + m0[3] * (pq[3] - av[3])};
          *(LAS f32x4*)(dst + 4) = (f32x4){av[4] + m1[0] * (pq[4] - av[4]), av[5] + m1[1] * (pq[5] - av[5]), av[6] + m1[2] * (pq[6] - av[6]), av[7] + m1[3] * (pq[7] - av[7])}; }
      if (STAGE == 1) {
#pragma unroll
        for (int which = 0; which < 2; ++which) { const int co = 768 + 32 * which + 4 * p8; const u32x2 cv = which ? c2 : c1, pv = which ? p2 : p1;
          const f32x4 m0 = *(const f32x4*)(mu + co);
          float x[4] = {__uint_as_float(cv.x << 16), __uint_as_float(cv.x & 0xffff0000u), __uint_as_float(cv.y << 16), __uint_as_float(cv.y & 0xffff0000u)};
          const float y[4] = {pz * __uint_as_float(pv.x << 16), pz * __uint_as_float(pv.x & 0xffff0000u), pz * __uint_as_float(pv.y << 16), pz * __uint_as_float(pv.y & 0xffff0000u)};
#pragma unroll
          for (int j = 0; j < 4; ++j) { x[j] = x[j] + m0[j] * (y[j] - x[j]); if (which == 0) x[j] = tanhf_(x[j]); }
          *(LAS u32x2*)((which ? DAb : TWb) + tok * 40 + 4 * p8) = (u32x2){pk2(x[0], x[1]), pk2(x[2], x[3])}; } }
      if (STAGE == 3) { const int co = 832 + 8 * p8; float av[8], pq[8]; unpack8(c3, av); unpack8(p3, pq);
          const f32x4 m0 = *(const f32x4*)(mu + co), m1 = *(const f32x4*)(mu + co + 4); float x[8];
#pragma unroll
          for (int j = 0; j < 8; ++j) x[j] = sigmoidf_(av[j] + (j < 4 ? m0[j] : m1[j - 4]) * (pz * pq[j] - av[j]));
          *(LAS u32x4*)(SGb + tok * RB_LD + 8 * p8) = (u32x4){pk2(x[0], x[1]), pk2(x[2], x[3]), pk2(x[4], x[5]), pk2(x[6], x[7])}; } }
    { const int ch = F.tid & 63, part = F.tid >> 6;
      if (STAGE == 1) { const float* w2 = F.in[I_RW2] + ((size_t)layer * 32 + 4 * part) * 256 + h * 64 + ch;
          *(LAS u32x2*)(w2T + ch * 40 + 4 * part) = (u32x2){pk2(w2[0], w2[256]), pk2(w2[512], w2[768])}; }
      if (STAGE == 1) { const float* a2 = F.in[I_RA2] + ((size_t)layer * 32 + 4 * part) * 256 + h * 64 + ch;
          *(LAS u32x2*)(a2T + ch * 40 + 4 * part) = (u32x2){pk2(a2[0], a2[256]), pk2(a2[512], a2[768])}; }
      if (STAGE == 3) { const float* g2 = F.in[I_RG2] + ((size_t)layer * 64 + 8 * part) * 256 + h * 64 + ch;
          *(LAS u32x4*)(g2T + ch * RB_LD + 8 * part) = (u32x4){pk2(g2[0], g2[256]), pk2(g2[512], g2[768]), pk2(g2[1024], g2[1280]), pk2(g2[1536], g2[1792])}; } }
    __syncthreads();
    { const int lane = F.lane, mt = F.wave >> 1, nt0 = 2 * (F.wave & 1), r = lane & 15, g4 = lane >> 4; const f32x4 zero4 = (f32x4){0.f, 0.f, 0.f, 0.f};
#pragma unroll
      for (int q = 0; q < 2; ++q) { const int nt = nt0 + q, ch = 16 * nt + r, cg = layer * 256 + h * 64 + ch;
          if (STAGE == 1) { const f32x4 wl = mma_nt<32>(TWb + 16 * mt * 40, 40, w2T + 16 * nt * 40, 40, zero4, lane); const float w0 = F.in[I_RW0][cg];
#pragma unroll
              for (int i = 0; i < 4; ++i) { const float x = w0 + wl[i]; const float wlog = -__logf(1.0f + __expf(-x)) - 0.5f; Ww[(16 * mt + 4 * g4 + i) * 64 + ch] = __expf(-__expf(wlog)); } }
          if (STAGE == 1) { const f32x4 al = mma_nt<32>(DAb + 16 * mt * 40, 40, a2T + 16 * nt * 40, 40, zero4, lane); const float a0 = F.in[I_RA0][cg];
#pragma unroll
              for (int i = 0; i < 4; ++i) Aa[(16 * mt + 4 * g4 + i) * 64 + ch] = sigmoidf_(a0 + al[i]); }
          if (STAGE == 3) { const f32x4 gv = mma_nt<64>(SGb + 16 * mt * RB_LD, RB_LD, g2T + 16 * nt * RB_LD, RB_LD, zero4, lane);
#pragma unroll
              for (int i = 0; i < 4; ++i) Gg[(16 * mt + 4 * g4 + i) * 64 + ch] = gv[i]; } } }
    __syncthreads();
    float* gBON = (float*)(F.ws + WS_BON) + ((size_t)(b * 4 + h) * 64 + c) * 64;
    if (STAGE == 1) { const int j = F.lane, tq = F.wave, cg = layer * 256 + h * 64 + j;
      const float kkw = F.in[I_RKK][cg], kaw = F.in[I_RKA][cg], rk = F.in[I_RRK][cg];
#pragma unroll 2
      for (int i8 = 0; i8 < 8; ++i8) { const int t = tq + 8 * i8;
          const float a = Aa[t * 64 + j]; const float kraw = Kk[t * 64 + j]; const float kp = kraw * (1.0f + (a - 1.0f) * kaw);
          Kk[t * 64 + j] = kp;
          const float kkv = kraw * kkw; const float ss = wave_sum(kkv * kkv); const float kkn = kkv * rsqrtf(fmaxf(ss, 1e-24f)); Aa[t * 64 + j] = -kkn; Bb[t * 64 + j] = kkn * a;
          const float bo = wave_sum(Rr[t * 64 + j] * kp * rk); if (j == 0) gBON[t] = bo; } }
    else if (F.tid < 64) BON[F.tid] = gBON[F.tid];
    __syncthreads();
}
constexpr int RB_AT = 98304, RB_ATT = RB_AT + 9216, RB_BT = RB_ATT + 9216, RB_BTT = RB_BT + 9216, RB_KT = RB_BTT + 9216, RB_RT = RB_KT + 9216, RB_VT = RB_RT + 9216, RB_GC = RB_VT + 9216;
constexpr int RX_X = 0, RX_XT = 9216, RX_TB = 18432, RX_M = 27648, RX_NRT = 36864, RX_G1T = 46080, RX_G2T = 55296, RX_QT = 64512;
__device__ __forceinline__ void st_tile(LAS bf16_t* dst, int mt, int nt, const f32x4 v, int lane) {
    const int r = lane & 15, g = lane >> 4;
#pragma unroll
    for (int i = 0; i < 4; ++i) dst[(16 * mt + 4 * g + i) * RB_LD + 16 * nt + r] = f2bf(v[i]);
}
__device__ __forceinline__ void st_tile_t(LAS bf16_t* dst, int mt, int nt, const f32x4 v, int lane) {
    const int r = lane & 15, g = lane >> 4; u32x2 w; w.x = pk2(v[0], v[1]); w.y = pk2(v[2], v[3]);
    *(LAS u32x2*)(dst + (16 * nt + r) * RB_LD + 16 * mt + 4 * g) = w;
}
__device__ __forceinline__ void item_rwkv1(const Frame& F_, int layer, int item) { Frame F = relocal(F_);
    const int b = item >> 8, h = (item >> 6) & 3, c = item & 63;
    rwkv_prep<1>(F, layer, b, h, c);
    LAS float* Rr = (LAS float*)(F.lds + RW_R); LAS float* Kk = (LAS float*)(F.lds + RW_K); LAS float* Vv = (LAS float*)(F.lds + RW_V); LAS float* Ww = (LAS float*)(F.lds + RW_W);
    LAS float* Aa = (LAS float*)(F.lds + RW_A); LAS float* Bb = (LAS float*)(F.lds + RW_B);
    LAS bf16_t* At = (LAS bf16_t*)(F.lds + RB_AT); LAS bf16_t* AtT = (LAS bf16_t*)(F.lds + RB_ATT); LAS bf16_t* Bt = (LAS bf16_t*)(F.lds + RB_BT); LAS bf16_t* BtT = (LAS bf16_t*)(F.lds + RB_BTT);
    LAS bf16_t* Kt = (LAS bf16_t*)(F.lds + RB_KT); LAS bf16_t* Rt = (LAS bf16_t*)(F.lds + RB_RT); LAS bf16_t* VT = (LAS bf16_t*)(F.lds + RB_VT); LAS float* gC = (LAS float*)(F.lds + RB_GC);
    LAS bf16_t* X = (LAS bf16_t*)(F.lds + RX_X); LAS bf16_t* XT = (LAS bf16_t*)(F.lds + RX_XT); LAS bf16_t* Tb = (LAS bf16_t*)(F.lds + RX_TB); LAS bf16_t* Mm = (LAS bf16_t*)(F.lds + RX_M);
    LAS bf16_t* NrT = (LAS bf16_t*)(F.lds + RX_NRT); LAS bf16_t* G1T = (LAS bf16_t*)(F.lds + RX_G1T); LAS bf16_t* G2T = (LAS bf16_t*)(F.lds + RX_G2T); LAS bf16_t* QT = (LAS bf16_t*)(F.lds + RX_QT);
    { const int k = F.tid & 63, part = F.tid >> 6; float g = 1.0f;
      for (int pp = 0; pp < part; ++pp) { float w8[8];
#pragma unroll
          for (int i = 0; i < 8; ++i) w8[i] = Ww[(8 * pp + i) * 64 + k];
          g *= ((w8[0] * w8[1]) * (w8[2] * w8[3])) * ((w8[4] * w8[5]) * (w8[6] * w8[7])); }
#pragma unroll
      for (int i = 0; i < 8; ++i) { const int t = 8 * part + i; const float gp = g; g *= Ww[t * 64 + k]; const float ig = 1.0f / g;
          const bf16_t av = f2bf(Aa[t * 64 + k] * gp), bv = f2bf(Bb[t * 64 + k] * ig);
          At[t * RB_LD + k] = av; AtT[k * RB_LD + t] = av; Bt[t * RB_LD + k] = bv; BtT[k * RB_LD + t] = bv;
          Kt[t * RB_LD + k] = f2bf(Kk[t * 64 + k] * ig); Rt[t * RB_LD + k] = f2bf(Rr[t * 64 + k] * g); VT[k * RB_LD + t] = f2bf(Vv[t * 64 + k]); }
      if (part == 7) gC[k] = g; }
    __syncthreads();
    const int lane = F.lane, mt = F.wave >> 1, nt0 = 2 * (F.wave & 1), r = lane & 15, g4 = lane >> 4;
    const f32x4 zero4 = (f32x4){0.f, 0.f, 0.f, 0.f};
    f32x4 Tacc[2];
#pragma unroll
    for (int q = 0; q < 2; ++q) { const int nt = nt0 + q;
        f32x4 n = mma_nt<64>(Bt + 16 * mt * RB_LD, RB_LD, At + 16 * nt * RB_LD, RB_LD, zero4, lane);
        f32x4 m = mma_nt<64>(Kt + 16 * mt * RB_LD, RB_LD, At + 16 * nt * RB_LD, RB_LD, zero4, lane);
        f32x4 nr = mma_nt<64>(Rt + 16 * mt * RB_LD, RB_LD, Bt + 16 * nt * RB_LD, RB_LD, zero4, lane);
#pragma unroll
        for (int i = 0; i < 4; ++i) { const int row = 16 * mt + 4 * g4 + i, col = 16 * nt + r;
            n[i] = (row < col) ? n[i] : 0.f; m[i] = (row < col) ? m[i] : 0.f; nr[i] = (col <= row) ? nr[i] : 0.f;
            Tacc[q][i] = n[i] + (row == col ? 1.0f : 0.f); }
        st_tile(X, mt, nt, n, lane); st_tile_t(XT, mt, nt, n, lane); st_tile(Tb, mt, nt, Tacc[q], lane); st_tile(Mm, mt, nt, m, lane); st_tile(NrT, mt, nt, nr, lane); }
    __syncthreads();
#pragma unroll 1
    for (int it = 0; it < 6; ++it) {
        LAS bf16_t* Xr = (it & 1) ? G1T : X; LAS bf16_t* XTr = (it & 1) ? G2T : XT; LAS bf16_t* Tr = (it & 1) ? QT : Tb;
        LAS bf16_t* Xw = (it & 1) ? X : G1T; LAS bf16_t* XTw = (it & 1) ? XT : G2T; LAS bf16_t* Tw = (it & 1) ? Tb : QT;
#pragma unroll
        for (int q = 0; q < 2; ++q) { const int nt = nt0 + q;
            if (it > 0) Tacc[q] = mma_nt<64>(Tr + 16 * mt * RB_LD, RB_LD, XTr + 16 * nt * RB_LD, RB_LD, Tacc[q], lane);
            if (it < 5) { const f32x4 x2 = mma_nt<64>(Xr + 16 * mt * RB_LD, RB_LD, XTr + 16 * nt * RB_LD, RB_LD, zero4, lane); st_tile(Xw, mt, nt, x2, lane); st_tile_t(XTw, mt, nt, x2, lane); }
            st_tile(Tw, mt, nt, Tacc[q], lane); }
        __syncthreads();
    }
#pragma unroll
    for (int q = 0; q < 2; ++q) { const int nt = nt0 + q;
        st_tile(G1T, mt, nt, mma_nt<64>(NrT + 16 * mt * RB_LD, RB_LD, Tb + 16 * nt * RB_LD, RB_LD, zero4, lane), lane);
        st_tile(G2T, mt, nt, mma_nt<64>(BtT + 16 * mt * RB_LD, RB_LD, Tb + 16 * nt * RB_LD, RB_LD, zero4, lane), lane); }
    __syncthreads();
    const size_t ci = (size_t)(b * 4 + h) * 64 + c;
    bf16_t* gPT = (bf16_t*)(F.ws + WS_MOE + RW_PT) + ci * 4096; bf16_t* gW1 = (bf16_t*)(F.ws + WS_MOE + RW_W1) + ci * 4096; bf16_t* gZ = (bf16_t*)(F.ws + WS_MOE + RW_Z) + ci * 4096;
#pragma unroll
    for (int q = 0; q < 2; ++q) { const int nt = nt0 + q; const int col = 16 * nt + r;
        f32x4 w1 = mma_nt<64>(G1T + 16 * mt * RB_LD, RB_LD, AtT + 16 * nt * RB_LD, RB_LD, zero4, lane);
        f32x4 z = mma_nt<64>(G1T + 16 * mt * RB_LD, RB_LD, Mm + 16 * nt * RB_LD, RB_LD, zero4, lane);
        f32x4 mr = mma_nt<64>(Rt + 16 * mt * RB_LD, RB_LD, Kt + 16 * nt * RB_LD, RB_LD, zero4, lane);
        f32x4 p = mma_nt<64>(G2T + 16 * mt * RB_LD, RB_LD, AtT + 16 * nt * RB_LD, RB_LD, zero4, lane);
        f32x4 qq = mma_nt<64>(G2T + 16 * mt * RB_LD, RB_LD, Mm + 16 * nt * RB_LD, RB_LD, zero4, lane);
        const int pos = 32 * (col >> 5) + 8 * ((col >> 2) & 3) + 4 * ((col >> 4) & 1) + (col & 3);
#pragma unroll
        for (int i = 0; i < 4; ++i) { const int row = 16 * mt + 4 * g4 + i;
            gW1[row * 64 + col] = f2bf(w1[i] + bf2f(Rt[row * RB_LD + col]));
            gZ[row * 64 + col] = f2bf(z[i] + (col <= row ? mr[i] : 0.f));
            const float gc = gC[row];
            gPT[row * 64 + pos] = f2bf((p[i] + (row == col ? 1.0f : 0.f)) * gc);
            qq[i] = (qq[i] + bf2f(Kt[col * RB_LD + row])) * gc; }
        st_tile(QT, mt, nt, qq, lane); }
    __syncthreads();
    bf16_t* gU = (bf16_t*)(F.ws + WS_MOE + RW_U) + ci * 4096;
#pragma unroll
    for (int q = 0; q < 2; ++q) { const int nt = nt0 + q;
        const f32x4 u = mma_nt<64>(VT + 16 * mt * RB_LD, RB_LD, QT + 16 * nt * RB_LD, RB_LD, zero4, lane);
#pragma unroll
        for (int i = 0; i < 4; ++i) gU[(16 * mt + 4 * g4 + i) * 64 + 16 * nt + r] = f2bf(u[i]); }
}
__device__ __forceinline__ void item_rwkv_carry(const Frame& F_, int item) { Frame F = relocal(F_);
    const int bh = item * 2 + (F.wave >> 2), nt = F.wave & 3, r = F.lane & 15, g = F.lane >> 4;
    const bf16_t* PT = (const bf16_t*)(F.ws + WS_MOE + RW_PT); const bf16_t* Uc = (const bf16_t*)(F.ws + WS_MOE + RW_U); bf16_t* Ss = (bf16_t*)(F.ws + WS_MOE + RW_S);
    f32x4 acc[4];
#pragma unroll
    for (int m = 0; m < 4; ++m) acc[m] = (f32x4){0.f, 0.f, 0.f, 0.f};
    for (int c = 0; c < 64; ++c) { const size_t ci = (size_t)bh * 64 + c;
        bf16x8 af[4][2]; f32x4 cin[4];
#pragma unroll
        for (int m = 0; m < 4; ++m) { const u32x2 uv = *(const u32x2*)(Uc + ci * 4096 + (16 * nt + r) * 64 + 16 * m + 4 * g);
            cin[m] = (f32x4){__uint_as_float(uv.x << 16), __uint_as_float(uv.x & 0xffff0000u), __uint_as_float(uv.y << 16), __uint_as_float(uv.y & 0xffff0000u)};
#pragma unroll
            for (int s = 0; s < 2; ++s) af[m][s] = *(const bf16x8*)(PT + ci * 4096 + (16 * m + r) * 64 + 32 * s + 8 * g); }
        unsigned pw[4][2];
#pragma unroll
        for (int m = 0; m < 4; ++m) { pw[m][0] = pk2(acc[m][0], acc[m][1]); pw[m][1] = pk2(acc[m][2], acc[m][3]);
            *(u32x2*)(Ss + ci * 4096 + (16 * nt + r) * 64 + 16 * m + 4 * g) = (u32x2){pw[m][0], pw[m][1]}; }
        bf16x8 bfr[2];
#pragma unroll
        for (int s = 0; s < 2; ++s) bfr[s] = __builtin_bit_cast(bf16x8, (u32x4){pw[2 * s][0], pw[2 * s][1], pw[2 * s + 1][0], pw[2 * s + 1][1]});
#pragma unroll
        for (int m = 0; m < 4; ++m) { acc[m] = __builtin_amdgcn_mfma_f32_16x16x32_bf16(af[m][0], bfr[0], cin[m], 0, 0, 0);
            acc[m] = __builtin_amdgcn_mfma_f32_16x16x32_bf16(af[m][1], bfr[1], acc[m], 0, 0, 0); }
    }
}
__device__ __forceinline__ void item_rwkv3(const Frame& F_, int layer, int item) { Frame F = relocal(F_);
    const int b = item >> 8, h = (item >> 6) & 3, c = item & 63; const size_t T0 = (size_t)b * SEQ + c * 64;
    rwkv_prep<3>(F, layer, b, h, c);
    LAS float* Vv = (LAS float*)(F.lds + RW_V); LAS float* Oo = (LAS float*)(F.lds + R3_O);
    LAS float* Gg = (LAS float*)(F.lds + R3_G); LAS float* BON = (LAS float*)(F.lds + R3_BON);
    LAS bf16_t* S0b = (LAS bf16_t*)(F.lds + R3_TILES); LAS bf16_t* W1b = S0b + 4608; LAS bf16_t* Zb = W1b + 4608; LAS bf16_t* VTb = Zb + 4608;
    { const size_t ci = (size_t)(b * 4 + h) * 64 + c; const int row = F.tid >> 3, col = (F.tid & 7) * 8;
      *(LAS u32x4*)(S0b + row * RB_LD + col) = *(const u32x4*)((const bf16_t*)(F.ws + WS_MOE + RW_S) + ci * 4096 + F.tid * 8);
      *(LAS u32x4*)(W1b + row * RB_LD + col) = *(const u32x4*)((const bf16_t*)(F.ws + WS_MOE + RW_W1) + ci * 4096 + F.tid * 8);
      *(LAS u32x4*)(Zb + row * RB_LD + col) = *(const u32x4*)((const bf16_t*)(F.ws + WS_MOE + RW_Z) + ci * 4096 + F.tid * 8);
      const int vv = F.tid & 63, part = F.tid >> 6;
#pragma unroll
      for (int i = 0; i < 8; ++i) { const int t = 8 * part + i; VTb[vv * RB_LD + t] = f2bf(Vv[t * 64 + vv]); } }
    __syncthreads();
    { const int lane = F.lane, mt = F.wave >> 1, nt0 = 2 * (F.wave & 1), r = lane & 15, g4 = lane >> 4;
#pragma unroll
      for (int q = 0; q < 2; ++q) { const int nt = nt0 + q;
          f32x4 o = mma_nt<64>(W1b + 16 * mt * RB_LD, RB_LD, S0b + 16 * nt * RB_LD, RB_LD, (f32x4){0.f, 0.f, 0.f, 0.f}, lane);
          o = mma_nt<64>(Zb + 16 * mt * RB_LD, RB_LD, VTb + 16 * nt * RB_LD, RB_LD, o, lane);
#pragma unroll
          for (int i = 0; i < 4; ++i) Oo[(16 * mt + 4 * g4 + i) * 64 + 16 * nt + r] = o[i]; } }
    __syncthreads();
    { const int j = F.lane, tq = F.wave, ch = h * 64 + j;
      const float lw = F.in[I_RLNW][layer * 256 + ch], lb = F.in[I_RLNB][layer * 256 + ch];
      bf16_t* Y = (bf16_t*)(F.ws + WS_H);
#pragma unroll 2
      for (int i8 = 0; i8 < 8; ++i8) { const int t = tq + 8 * i8;
          const float o = Oo[t * 64 + j]; const float mean = wave_sum(o) * (1.0f / 64.0f); const float d = o - mean; const float var = wave_sum(d * d) * (1.0f / 64.0f);
          float on = d * rsqrtf(var + 64e-5f) * lw + lb; on += BON[t] * Vv[t * 64 + j];
          Y[(T0 + t) * DM + 256 + ch] = f2bf(on * Gg[t * 64 + j]); } }
}

constexpr int DS_SEL = 131072, DS_HIST = 135168, DS_BKT = 151552, DS_BIAS = 152064;
__device__ __forceinline__ void dsa_tables(const Frame& F_) { Frame F = relocal(F_);
    LAS int* bkt = (LAS int*)(F.lds + DS_BKT); LAS float* biasT = (LAS float*)(F.lds + DS_BIAS);
    if (F.tid < 128) { const int n = F.tid; int bk = n; if (n >= 16) { const float lr = logf((float)n / 16.0f) / 2.0794415416798357f; bk = 16 + (int)(lr * 16.0f); bk = bk < 31 ? bk : 31; } bkt[n] = bk; biasT[n] = F.in[I_RELB][n]; }
    __syncthreads();
}
__device__ __forceinline__ unsigned fkey(float f) { const unsigned u = __float_as_uint(f); return (u & 0x80000000u) ? ~u : (u | 0x80000000u); }
__device__ __forceinline__ void item_dsa(const Frame& F_, int layer, int item) { Frame F = relocal(F_);
    const bf16_t* U = (const bf16_t*)(F.ws + WS_U); const bf16_t* KI = (const bf16_t*)(F.ws + WS_KIDX);
    const bf16_t* Kb = (const bf16_t*)(F.ws + WS_K); const bf16_t* Vb = (const bf16_t*)(F.ws + WS_V);
    const int b = item & 3, qg = 511 - (item >> 2); const size_t TB = (size_t)b * SEQ, T0 = TB + qg * 8;
    LAS float* sc = (LAS float*)F.lds; LAS unsigned short* selall = (LAS unsigned short*)(F.lds + DS_SEL); LAS unsigned* histall = (LAS unsigned*)(F.lds + DS_HIST);
    LAS int* bkt = (LAS int*)(F.lds + DS_BKT); LAS float* biasT = (LAS float*)(F.lds + DS_BIAS);
    const int lane = F.lane, hh = lane >> 5;
    {
        bf16x8 af[2][2]; float wq[2][2][8];
        { const int r = lane & 31, q4 = 2 * ((r >> 2) & 1) + (r >> 4), head = 4 * ((r >> 3) & 1) + (r & 3);
#pragma unroll
          for (int mt = 0; mt < 2; ++mt)
#pragma unroll
              for (int ks = 0; ks < 2; ++ks) af[mt][ks] = *(const bf16x8*)(U + (T0 + 4 * mt + q4) * NINP + UC + 384 + head * 32 + 16 * ks + 8 * hh); }
#pragma unroll
        for (int mt = 0; mt < 2; ++mt)
#pragma unroll
            for (int q2 = 0; q2 < 2; ++q2) { float f[8]; unpack8(*(const u32x4*)(U + (T0 + 4 * mt + 2 * hh + q2) * NINP + UC + 672), f);
#pragma unroll
                for (int hd = 0; hd < 8; ++hd) wq[mt][q2][hd] = f[hd]; }
        const int ntile = (qg * 8 + 8 + 31) >> 5;
        bf16x8 nb0 = af[0][0], nb1 = af[0][0];
        if (F.wave < ntile) { const int key = F.wave * 32 + (lane & 31); nb0 = *(const bf16x8*)(KI + (TB + key) * 32 + 8 * hh); nb1 = *(const bf16x8*)(KI + (TB + key) * 32 + 16 + 8 * hh); }
        for (int kt = F.wave; kt < ntile; kt += 8) {
            const int key = kt * 32 + (lane & 31);
            const bf16x8 b0 = nb0, b1 = nb1;
            if (kt + 8 < ntile) { const int k2 = key + 256; nb0 = *(const bf16x8*)(KI + (TB + k2) * 32 + 8 * hh); nb1 = *(const bf16x8*)(KI + (TB + k2) * 32 + 16 + 8 * hh); }
#pragma unroll
            for (int mt = 0; mt < 2; ++mt) { f32x16 acc;
#pragma unroll
                for (int i = 0; i < 16; ++i) acc[i] = 0.f;
                acc = __builtin_amdgcn_mfma_f32_32x32x16_bf16(af[mt][0], b0, acc, 0, 0, 0);
                acc = __builtin_amdgcn_mfma_f32_32x32x16_bf16(af[mt][1], b1, acc, 0, 0, 0);
#pragma unroll
                for (int q2 = 0; q2 < 2; ++q2) { float s = 0.f;
#pragma unroll
                    for (int hd = 0; hd < 8; ++hd) s += fmaxf(acc[8 * q2 + hd], 0.f) * wq[mt][q2][hd];
                    const int qi = 4 * mt + 2 * hh + q2;
                    sc[qi * 4096 + key] = (key <= qg * 8 + qi) ? s : -INFINITY; } }
        }
    }
    __syncthreads();
    const int qi = F.wave, tq = qg * 8 + qi, n = tq + 1;
    LAS float* scq = sc + qi * 4096; LAS unsigned short* sel = selall + qi * 256; LAS unsigned* hist = histall + qi * 512;
    int nsel;
    if (n <= 256) { nsel = n; for (int j = lane; j < 256; j += 64) sel[j] = (unsigned short)(j < n ? j : 0); }
    else {
        nsel = 256;
        const int R = (n + 63) >> 6; const unsigned long long ltm = (1ull << lane) - 1ull;
        float lo = INFINITY, hi = -INFINITY;
        const int R4 = (n + 255) >> 8;
#pragma unroll 4
        for (int i = 0; i < R4; ++i) { const int j0 = 256 * i + 4 * lane; const f32x4 v4 = *(const LAS f32x4*)(scq + j0);
#pragma unroll
            for (int q = 0; q < 4; ++q) { const bool valid = j0 + q < n; lo = fminf(lo, valid ? v4[q] : INFINITY); hi = fmaxf(hi, valid ? v4[q] : -INFINITY); } }
#pragma unroll
        for (int o = 1; o < 64; o <<= 1) { lo = fminf(lo, shx(lo, o)); hi = fmaxf(hi, shx(hi, o)); }
        bool slow = false;
        if (!(hi > lo)) { for (int j = lane; j < 256; j += 64) sel[j] = (unsigned short)j; }
        else {
            const float scale = 1023.0f / (hi - lo);
            *(LAS u32x4*)(hist + 8 * lane) = (u32x4){0u, 0u, 0u, 0u}; *(LAS u32x4*)(hist + 8 * lane + 4) = (u32x4){0u, 0u, 0u, 0u};
#pragma unroll 2
            for (int i = 0; i < R4; ++i) { const int j0 = 256 * i + 4 * lane; const f32x4 v4 = *(const LAS f32x4*)(scq + j0);
#pragma unroll
                for (int q = 0; q < 4; ++q) { if (j0 + q < n) { int bk = (int)((v4[q] - lo) * scale); bk = bk < 1023 ? bk : 1023;
                    atomicAdd((unsigned*)(hist + (bk >> 1)), (bk & 1) ? 65536u : 1u); } } }
            const u32x4 h0 = *(const LAS u32x4*)(hist + 8 * lane), h1 = *(const LAS u32x4*)(hist + 8 * lane + 4);
            unsigned cb[16];
            cb[0] = h0.x & 0xffffu; cb[1] = h0.x >> 16; cb[2] = h0.y & 0xffffu; cb[3] = h0.y >> 16; cb[4] = h0.z & 0xffffu; cb[5] = h0.z >> 16; cb[6] = h0.w & 0xffffu; cb[7] = h0.w >> 16;
            cb[8] = h1.x & 0xffffu; cb[9] = h1.x >> 16; cb[10] = h1.y & 0xffffu; cb[11] = h1.y >> 16; cb[12] = h1.z & 0xffffu; cb[13] = h1.z >> 16; cb[14] = h1.w & 0xffffu; cb[15] = h1.w >> 16;
            unsigned tot = 0u;
#pragma unroll
            for (int q = 0; q < 16; ++q) tot += cb[q];
            unsigned incl = tot;
#pragma unroll
            for (int o = 1; o < 64; o <<= 1) { const unsigned t = shdown_u(incl, o); if (lane + o < 64) incl += t; }
            int fb = -1; unsigned fabove = 0u, fcnt = 0u; unsigned cum = incl - tot;
#pragma unroll
            for (int q = 15; q >= 0; --q) { if (fb < 0 && cum < 256u && 256u <= cum + cb[q]) { fb = 16 * lane + q; fabove = cum; fcnt = cb[q]; } cum += cb[q]; }
            const unsigned long long mf = __ballot(fb >= 0); const int src = (int)__ffsll((long long)mf) - 1;
            const int B = shidx_i(fb, src); const int above = shidx_i((int)fabove, src), cntB = shidx_i((int)fcnt, src); const int need = 256 - above;
            if (cntB > 256) slow = true;
            else {
                LAS unsigned* cand = hist;
                int base_gt = 0, base_c = 0;
#pragma unroll 2
                for (int i = 0; i < R4; ++i) { const int j0 = 256 * i + 4 * lane; const f32x4 v4 = *(const LAS f32x4*)(scq + j0);
#pragma unroll
                    for (int q = 0; q < 4; ++q) { const int j = j0 + q; const bool valid = j < n; const float v = valid ? v4[q] : lo;
                        int bk = (int)((v - lo) * scale); bk = bk < 1023 ? bk : 1023;
                        const bool gt = valid && bk > B, eq = valid && bk == B;
                        const unsigned long long mg = __ballot(gt), me = __ballot(eq);
                        if (gt) sel[base_gt + __popcll(mg & ltm)] = (unsigned short)j;
                        if (eq) { const int p = base_c + __popcll(me & ltm); cand[2 * p] = fkey(v); cand[2 * p + 1] = (unsigned)j; }
                        base_gt += __popcll(mg); base_c += __popcll(me); } }
                if (need == cntB) { for (int c = lane; c < cntB; c += 64) sel[above + c] = (unsigned short)cand[2 * c + 1]; }
                else {
                    unsigned ck[4], cx[4]; int rk[4];
#pragma unroll
                    for (int q = 0; q < 4; ++q) { const int c = lane + 64 * q; ck[q] = c < cntB ? cand[2 * c] : 0u; cx[q] = c < cntB ? cand[2 * c + 1] : 0u; rk[q] = 0; }
                    for (int c2 = 0; c2 < cntB; ++c2) { const unsigned k2 = cand[2 * c2], x2 = cand[2 * c2 + 1];
#pragma unroll
                        for (int q = 0; q < 4; ++q) rk[q] += (k2 > ck[q] || (k2 == ck[q] && x2 < cx[q])) ? 1 : 0; }
#pragma unroll
                    for (int q = 0; q < 4; ++q) { const int c = lane + 64 * q; if (c < cntB && rk[q] < need) sel[above + rk[q]] = (unsigned short)cand[2 * c + 1]; }
                }
            }
        }
        if (slow) {
        unsigned prefix = 0u; int need = 256; unsigned neq = 0u;
        for (int p = 0; p < 4; ++p) { const int shift = 24 - 8 * p;
            *(LAS u32x4*)(hist + 4 * lane) = (u32x4){0u, 0u, 0u, 0u};
            for (int i = 0; i < R; ++i) { const int j = lane + 64 * i; if (j < n) { const unsigned u = fkey(scq[j]);
                if (p == 0 || (u >> (shift + 8)) == prefix) atomicAdd((unsigned*)(hist + ((u >> shift) & 255u)), 1u); } }
            const u32x4 hv = *(const LAS u32x4*)(hist + 4 * lane);
            const unsigned tot = hv.x + hv.y + hv.z + hv.w;
            unsigned incl = tot;
#pragma unroll
            for (int o = 1; o < 64; o <<= 1) { const unsigned t = shdown_u(incl, o); if (lane + o < 64) incl += t; }
            const unsigned above = incl - tot;
            int fb = -1; unsigned fabove = 0u, feq = 0u; unsigned cum = above;
            { const unsigned hq[4] = {hv.x, hv.y, hv.z, hv.w};
#pragma unroll
              for (int q = 3; q >= 0; --q) { if (fb < 0 && cum < (unsigned)need && (unsigned)need <= cum + hq[q]) { fb = 4 * lane + q; fabove = cum; feq = hq[q]; } cum += hq[q]; } }
            const unsigned long long m = __ballot(fb >= 0);
            const int src = (int)__ffsll((long long)m) - 1;
            const int bin = shidx_i(fb, src); const unsigned ab = (unsigned)shidx_i((int)fabove, src); neq = (unsigned)shidx_i((int)feq, src);
            need -= (int)ab; prefix = (prefix << 8) | (unsigned)bin;
        }
        const int ngt = 256 - need;
        int base_gt = 0, base_eq = 0;
        for (int i = 0; i < R; ++i) { const int j = lane + 64 * i; const unsigned u = (j < n) ? fkey(scq[j]) : 0u;
            const bool gt = (j < n) && (u > prefix), eq = (j < n) && (u == prefix);
            const unsigned long long mg = __ballot(gt), me = __ballot(eq); const unsigned long long lt = (1ull << lane) - 1ull;
            if (gt) sel[base_gt + __popcll(mg & lt)] = (unsigned short)j;
            if (eq) { const int rk = base_eq + __popcll(me & lt); if (rk < need) sel[ngt + rk] = (unsigned short)j; }
            base_gt += __popcll(mg); base_eq += __popcll(me); }
        (void)neq;
            }
    }
    const int nt16 = (nsel + 15) >> 4, r16 = lane & 15, g4 = lane >> 4;
    LAS float* biasj = scq + 2048;
#pragma unroll
    for (int q = 0; q < 4; ++q) { const int j = lane + 64 * q; f32x4 bv = (f32x4){-INFINITY, -INFINITY, -INFINITY, -INFINITY};
        if (j < nsel) { const int dist = tq - (int)sel[j]; const int bk = dist < 128 ? bkt[dist < 0 ? 0 : dist] : 31; bv = *(const LAS f32x4*)(biasT + 4 * bk); }
        *(LAS f32x4*)(biasj + 4 * j) = bv; }
    bf16x8 qf[2];
#pragma unroll
    for (int s = 0; s < 2; ++s) { u32x4 z = (u32x4){0u, 0u, 0u, 0u}; if (r16 < 4) z = *(const u32x4*)(U + (T0 + qi) * NINP + UC + r16 * 64 + 32 * s + 8 * g4); qf[s] = __builtin_bit_cast(bf16x8, z); }
    float lg[16][4]; float mx = -INFINITY;
#define DSA_QK(M0, NM) do { int keyr[NM]; bf16x8 a0[NM], a1[NM]; \
        _Pragma("unroll") for (int m8 = 0; m8 < NM; ++m8) keyr[m8] = sel[16 * ((M0) + m8) + r16]; \
        _Pragma("unroll") for (int m8 = 0; m8 < NM; ++m8) { a0[m8] = *(const bf16x8*)(Kb + (TB + keyr[m8]) * 64 + 8 * g4); a1[m8] = *(const bf16x8*)(Kb + (TB + keyr[m8]) * 64 + 32 + 8 * g4); } \
        _Pragma("unroll") for (int m8 = 0; m8 < NM; ++m8) { const int m = (M0) + m8; \
            f32x4 acc = (f32x4){0.f, 0.f, 0.f, 0.f}; \
            acc = __builtin_amdgcn_mfma_f32_16x16x32_bf16(a0[m8], qf[0], acc, 0, 0, 0); \
            acc = __builtin_amdgcn_mfma_f32_16x16x32_bf16(a1[m8], qf[1], acc, 0, 0, 0); \
            _Pragma("unroll") for (int i = 0; i < 4; ++i) { const float v = acc[i] * 0.125f + biasj[(16 * m + 4 * g4 + i) * 4 + (r16 & 3)]; lg[m][i] = v; mx = fmaxf(mx, v); } } } while (0)
    if (nt16 > 8) { DSA_QK(0, 16); }
    else { DSA_QK(0, 8);
#pragma unroll
        for (int m8 = 8; m8 < 16; ++m8)
#pragma unroll
            for (int i = 0; i < 4; ++i) lg[m8][i] = -INFINITY; }
#undef DSA_QK
    mx = fmaxf(mx, shx(mx, 16)); mx = fmaxf(mx, shx(mx, 32));
    float sm = 0.f;
#pragma unroll
    for (int m = 0; m < 16; ++m)
#pragma unroll
        for (int i = 0; i < 4; ++i) { const float p = __expf(lg[m][i] - mx); lg[m][i] = p; sm += p; }
    sm += shx(sm, 16); sm += shx(sm, 32);
    f32x4 ov[4];
#pragma unroll
    for (int nt = 0; nt < 4; ++nt) ov[nt] = (f32x4){0.f, 0.f, 0.f, 0.f};
    const unsigned vs_base = (unsigned)(unsigned long)scq;
#pragma unroll
    for (int half = 0; half < 2; ++half) {
        if (half * 8 < nt16) {
            asm volatile("s_waitcnt lgkmcnt(0)" ::: "memory");
            int vkey[16];
#pragma unroll
            for (int q = 0; q < 16; ++q) { const int rho = 8 * q + (lane >> 3);
                vkey[q] = sel[half * 128 + (rho & ~31) + 16 * ((rho >> 2) & 1) + 4 * ((rho >> 3) & 3) + (rho & 3)]; }
            asm volatile("s_waitcnt lgkmcnt(0)" : "+v"(vkey[0]), "+v"(vkey[1]), "+v"(vkey[2]), "+v"(vkey[3]), "+v"(vkey[4]), "+v"(vkey[5]), "+v"(vkey[6]), "+v"(vkey[7]),
                         "+v"(vkey[8]), "+v"(vkey[9]), "+v"(vkey[10]), "+v"(vkey[11]), "+v"(vkey[12]), "+v"(vkey[13]), "+v"(vkey[14]), "+v"(vkey[15]) :: "memory");
#pragma unroll
            for (int q = 0; q < 16; ++q)
                __builtin_amdgcn_global_load_lds((const unsigned*)(Vb + (TB + vkey[q]) * 64 + 8 * (lane & 7)), (LAS unsigned*)((LAS unsigned char*)scq + q * 1024), 16, 0, 0);
            asm volatile("s_waitcnt vmcnt(0)" ::: "memory");
#pragma unroll
            for (int s4 = 0; s4 < 4; ++s4) { const int s = half * 4 + s4;
                u32x4 pw; pw.x = pk2(lg[2 * s][0], lg[2 * s][1]); pw.y = pk2(lg[2 * s][2], lg[2 * s][3]); pw.z = pk2(lg[2 * s + 1][0], lg[2 * s + 1][1]); pw.w = pk2(lg[2 * s + 1][2], lg[2 * s + 1][3]);
                const bf16x8 pa = __builtin_bit_cast(bf16x8, pw);
                const unsigned ad = vs_base + (unsigned)((32 * s4 + 8 * g4 + (r16 >> 2)) * 128 + (r16 & 3) * 8);
                u32x2 t0[4], t1[4];
                asm volatile("ds_read_b64_tr_b16 %0, %8\n\tds_read_b64_tr_b16 %1, %8 offset:512\n\tds_read_b64_tr_b16 %2, %8 offset:32\n\tds_read_b64_tr_b16 %3, %8 offset:544\n\t"
                             "ds_read_b64_tr_b16 %4, %8 offset:64\n\tds_read_b64_tr_b16 %5, %8 offset:576\n\tds_read_b64_tr_b16 %6, %8 offset:96\n\tds_read_b64_tr_b16 %7, %8 offset:608\n\ts_waitcnt lgkmcnt(0)"
                             : "=&v"(t0[0]), "=&v"(t1[0]), "=&v"(t0[1]), "=&v"(t1[1]), "=&v"(t0[2]), "=&v"(t1[2]), "=&v"(t0[3]), "=&v"(t1[3]) : "v"(ad) : "memory");
#pragma unroll
                for (int nt = 0; nt < 4; ++nt) { const bf16x8 vb = __builtin_bit_cast(bf16x8, (u32x4){t0[nt].x, t0[nt].y, t1[nt].x, t1[nt].y});
                    ov[nt] = __builtin_amdgcn_mfma_f32_16x16x32_bf16(pa, vb, ov[nt], 0, 0, 0); } }
        }
    }
    { float inv[4];
#pragma unroll
      for (int h = 0; h < 4; ++h) inv[h] = 1.0f / __int_as_float(__builtin_amdgcn_readlane(__float_as_int(sm), h));
      if (lane < 16) { bf16_t* Y = (bf16_t*)(F.ws + WS_H) + (T0 + qi) * DM + 512 + r16;
#pragma unroll
          for (int h = 0; h < 4; ++h)
#pragma unroll
              for (int nt = 0; nt < 4; ++nt) Y[h * 64 + 16 * nt] = f2bf(ov[nt][h] * inv[h]); } }
}

__device__ __forceinline__ void phase_router(const Frame& F_, int layer) { Frame F = relocal(F_); const int cset = layer;
    const float* X = (const float*)(F.ws + WS_X);
    const bf16_t* WH = (const bf16_t*)(F.ws + WS_WRT) + (size_t)layer * 2 * 49152; const bf16_t* WL = WH + 49152;
    LAS float* part = (LAS float*)F.lds;
    LAS float* ssq = (LAS float*)(F.lds + 24576);
    LAS int* es = (LAS int*)(F.lds + 25088);
    LAS int* lr = (LAS int*)(F.lds + 25600);
    LAS float* wsl = (LAS float*)(F.lds + 26112);
    LAS float* rsd = (LAS float*)(F.lds + 26624);
    for (int blk = F.bid; blk < NTOK / 64; blk += F.G) {
        __syncthreads();
        const int mt = F.wave & 3, kh = F.wave >> 2, r16 = F.lane & 15, g4 = F.lane >> 4;
        const float* xr = X + ((size_t)blk * 64 + mt * 16 + r16) * DM + kh * 512 + 8 * g4;
        f32x4 acc[3]; acc[0] = acc[1] = acc[2] = (f32x4){0.f, 0.f, 0.f, 0.f}; float ss = 0.f;
#pragma unroll 4
        for (int ks = 0; ks < 16; ++ks) {
            const f32x4 xa = *(const f32x4*)(xr + ks * 32), xb = *(const f32x4*)(xr + ks * 32 + 4);
            ss += xa[0] * xa[0] + xa[1] * xa[1] + xa[2] * xa[2] + xa[3] * xa[3] + xb[0] * xb[0] + xb[1] * xb[1] + xb[2] * xb[2] + xb[3] * xb[3];
            float xv[8] = {xa[0], xa[1], xa[2], xa[3], xb[0], xb[1], xb[2], xb[3]}; unsigned hw[4], lw[4];
#pragma unroll
            for (int j = 0; j < 4; ++j) { const bf16_t h0 = f2bf(xv[2 * j]), h1 = f2bf(xv[2 * j + 1]); hw[j] = (unsigned)h0 | ((unsigned)h1 << 16);
                lw[j] = pk2(xv[2 * j] - bf2f(h0), xv[2 * j + 1] - bf2f(h1)); }
            const bf16x8 ahi = __builtin_bit_cast(bf16x8, (u32x4){hw[0], hw[1], hw[2], hw[3]}), alo = __builtin_bit_cast(bf16x8, (u32x4){lw[0], lw[1], lw[2], lw[3]});
#pragma unroll
            for (int nt = 0; nt < 3; ++nt) { const size_t wo = (size_t)(nt * 16 + r16) * 1024 + kh * 512 + ks * 32 + 8 * g4;
                const bf16x8 bh = *(const bf16x8*)(WH + wo), bl = *(const bf16x8*)(WL + wo);
                acc[nt] = __builtin_amdgcn_mfma_f32_16x16x32_bf16(ahi, bh, acc[nt], 0, 0, 0);
                acc[nt] = __builtin_amdgcn_mfma_f32_16x16x32_bf16(ahi, bl, acc[nt], 0, 0, 0);
                acc[nt] = __builtin_amdgcn_mfma_f32_16x16x32_bf16(alo, bh, acc[nt], 0, 0, 0); }
        }
        ss += shx(ss, 16); ss += shx(ss, 32);
        if (g4 == 0) ssq[kh * 64 + mt * 16 + r16] = ss;
#pragma unroll
        for (int nt = 0; nt < 3; ++nt)
#pragma unroll
            for (int i = 0; i < 4; ++i) part[(kh * 64 + mt * 16 + 4 * g4 + i) * 48 + nt * 16 + r16] = acc[nt][i];
        __syncthreads();
        if (F.tid < 64) { const float rstd = rsqrtf((ssq[F.tid] + ssq[64 + F.tid]) * (1.0f / DM) + 1e-6f); rsd[F.tid] = rstd;
            float l[36];
#pragma unroll
            for (int o = 0; o < 36; ++o) l[o] = (part[F.tid * 48 + o] + part[(64 + F.tid) * 48 + o]) * rstd + (o < 32 ? F.in[I_BRE][layer * 32 + o] : F.in[I_BRG][layer * 4 + o - 32]);
            int gs = 0; float gm = l[32];
#pragma unroll
            for (int j = 1; j < 4; ++j) if (l[32 + j] > gm) { gm = l[32 + j]; gs = j; }
            float den = 0.f;
#pragma unroll
            for (int j = 0; j < 4; ++j) den += __expf(l[32 + j] - gm);
            const float gate = 1.0f / den;
            float e8[8];
#pragma unroll
            for (int j = 0; j < 8; ++j) e8[j] = gs == 0 ? l[j] : gs == 1 ? l[8 + j] : gs == 2 ? l[16 + j] : l[24 + j];
            int i1 = 0; float v1 = e8[0];
#pragma unroll
            for (int j = 1; j < 8; ++j) if (e8[j] > v1) { v1 = e8[j]; i1 = j; }
            int i2 = -1; float v2 = -INFINITY;
#pragma unroll
            for (int j = 0; j < 8; ++j) if (j != i1 && e8[j] > v2) { v2 = e8[j]; i2 = j; }
            const float e2 = __expf(v2 - v1); const float p1 = 1.0f / (1.0f + e2);
            es[F.tid * 2] = gs * 8 + i1; es[F.tid * 2 + 1] = gs * 8 + i2; wsl[F.tid * 2] = p1 * gate; wsl[F.tid * 2 + 1] = (1.0f - p1) * gate; }
        __syncthreads();
        if (F.tid < 32) { int cnt = 0; for (int i = 0; i < 128; ++i) if (es[i] == F.tid) lr[i] = cnt++;
            if (cnt) { const int base = (int)__hip_atomic_fetch_add(F.ctl + CW_CNT + cset * 32 + F.tid, (unsigned)cnt, __ATOMIC_RELAXED, __HIP_MEMORY_SCOPE_AGENT);
                for (int i = 0; i < 128; ++i) if (es[i] == F.tid) lr[i] += base; } }
        __syncthreads();
        if (F.tid < 64) { int* rt = (int*)(F.ws + WS_ROUTE) + ((size_t)blk * 64 + F.tid) * 8;
            rt[0] = es[F.tid * 2]; rt[1] = es[F.tid * 2 + 1]; ((float*)rt)[2] = wsl[F.tid * 2]; ((float*)rt)[3] = wsl[F.tid * 2 + 1]; rt[4] = lr[F.tid * 2]; rt[5] = lr[F.tid * 2 + 1]; ((float*)rt)[6] = rsd[F.tid]; }
    }
    __syncthreads();
    if (F.tid == 0) __hip_atomic_fetch_add(F.ctl + CW_RB + 64 * layer, 1u, __ATOMIC_RELAXED, __HIP_MEMORY_SCOPE_AGENT);
}
__device__ __forceinline__ void phase_moe_convert(const Frame& F_, int layer) { Frame F = relocal(F_);
    bf16_t* WGU = (bf16_t*)(F.ws + WS_MOE + MOE_WGU);
    for (int t = F.bid; t < 1024; t += F.G) {
        const int e = t >> 5, r = t & 31, kt = r >> 1, nt = r & 1; const size_t eo = ((size_t)layer * 32 + e) * 1024 * 256;
        tr_tile(F, 256, WGU + (size_t)e * 512 * 1024, 1024, kt * 64, nt * 256, SmGU{F.in[I_WGATE] + eo, F.in[I_WUP] + eo}); }
}
__device__ __forceinline__ void phase_moe_convert_down(const Frame& F_, int layer) { Frame F = relocal(F_);
    bf16_t* WD = (bf16_t*)(F.ws + WS_MOE + MOE_WD);
    for (;;) { const int q = q_pop(F, 32 + layer); if (q >= 512) break;
        const int e = q >> 4, r = q & 15, kt = r >> 2, nt = r & 3;
        tr_tile(F, 1024, WD + (size_t)e * 1024 * 256, 256, kt * 64, nt * 256, SmId{F.in[I_WDOWN] + ((size_t)layer * 32 + e) * 256 * 1024}); }
}
__device__ __forceinline__ void phase_gather(const Frame& F_, int layer) { Frame F = relocal(F_);
    LAS int* off = (LAS int*)F.lds;
    __syncthreads();
    if (F.tid == 0) { unsigned sp = 0;
        while (__hip_atomic_load(F.ctl + CW_RB + 64 * layer, __ATOMIC_RELAXED, __HIP_MEMORY_SCOPE_AGENT) < (unsigned)F.G) { __builtin_amdgcn_s_sleep(2); if (++sp > (1u << 22)) break; } }
    __syncthreads();
    if (F.tid == 0) { int acc = 0; for (int e = 0; e < 32; ++e) { off[e] = acc; const int c = (int)__hip_atomic_load(F.ctl + CW_CNT + layer * 32 + e, __ATOMIC_RELAXED, __HIP_MEMORY_SCOPE_AGENT); acc += (c + 255) & ~255; } off[32] = acc; }
    __syncthreads();
    int* tiles = (int*)(F.ws + WS_TILES); int* row_tok = (int*)(F.ws + WS_ROWS); float* row_w = (float*)(F.ws + WS_ROWS) + MAXROWS;
    if (F.bid == 0) { if (F.tid == 0) tiles[0] = off[32] >> 8; if (F.tid < 33) tiles[1 + F.tid] = off[F.tid];
        if (F.tid < 32) for (int rt = off[F.tid] >> 8; rt < (off[F.tid + 1] >> 8); ++rt) tiles[64 + rt] = F.tid; }
    for (int e = F.bid; e < 32; e += F.G) { const int c = (int)__hip_atomic_load(F.ctl + CW_CNT + layer * 32 + e, __ATOMIC_RELAXED, __HIP_MEMORY_SCOPE_AGENT);
        for (int r = off[e] + c + F.tid; r < off[e + 1]; r += NTHR) { row_tok[r] = -1; row_w[r] = 0.f; } }
    const float* X = (const float*)(F.ws + WS_X); bf16_t* HP = (bf16_t*)(F.ws + WS_U); const float* nw = F.in[I_NORM2] + (size_t)layer * DM;
    f32x4 nwv[4];
#pragma unroll
    for (int j = 0; j < 4; ++j) nwv[j] = *(const f32x4*)(nw + 4 * F.lane + 256 * j);
    for (int blk = F.bid; blk < NTOK / 64; blk += F.G)
    for (int i4 = 0; i4 < 2; ++i4) {
        int p0[4], p1[4], tt[4]; float rstd[4], w0[4], w1[4]; f32x4 xv[4][4];
#pragma unroll
        for (int r = 0; r < 4; ++r) { const int t = blk * 64 + F.wave * 8 + 4 * i4 + r; tt[r] = t;
            const int* rt = (const int*)(F.ws + WS_ROUTE) + (size_t)t * 8; rstd[r] = ((const float*)rt)[6]; w0[r] = ((const float*)rt)[2]; w1[r] = ((const float*)rt)[3];
            p0[r] = off[rt[0]] + rt[4]; p1[r] = off[rt[1]] + rt[5];
#pragma unroll
            for (int j = 0; j < 4; ++j) xv[r][j] = *(const f32x4*)(X + (size_t)t * DM + 4 * F.lane + 256 * j); }
#pragma unroll
        for (int r = 0; r < 4; ++r) {
#pragma unroll
            for (int j = 0; j < 4; ++j) { const int c = 4 * F.lane + 256 * j; const f32x4 v = xv[r][j] * rstd[r] * nwv[j];
                u32x2 o; o.x = pk2(v[0], v[1]); o.y = pk2(v[2], v[3]);
                *(u32x2*)(HP + (size_t)tt[r] * DM + c) = o; }
            if (F.lane == 0) { row_tok[p0[r]] = tt[r] * 2; row_w[p0[r]] = w0[r]; row_tok[p1[r]] = tt[r] * 2 + 1; row_w[p1[r]] = w1[r]; } }
    }
}

constexpr int NPH_LAYER = 9, NPHASE = 1 + 2 * NPH_LAYER + 1;
#ifndef MK_ONLY
#define MK_ONLY -1
#endif
#ifndef MK_ITEM
#define MK_ITEM -1
#endif
#define EN(o) (MK_ONLY < 0 || MK_ONLY == (o))
#define IT(o) (MK_ITEM < 0 || MK_ITEM == (o))
__global__ void __launch_bounds__(NTHR, 2) mk_forward(Params P) {
    extern __shared__ __attribute__((aligned(16))) unsigned char lds_raw[];
    Frame F; F.lds = (LAS unsigned char*)lds_raw; F.tid = threadIdx.x; F.lane = F.tid & 63; F.wave = __builtin_amdgcn_readfirstlane(F.tid >> 6); F.bid = blockIdx.x; F.G = gridDim.x;
    F.in = (in_tab_t)__builtin_amdgcn_kernarg_segment_ptr(); F.out = P.out; F.ws = P.ws; F.ctl = (unsigned*)(P.ws + WS_CTL); F.misc = (volatile LAS int*)(F.lds + MISC_OFF);
    if (F.tid < 64) ((LAS unsigned*)(F.lds + MISC_OFF))[F.tid] = 0u;
    __syncthreads();
    const int lo = P.ph_lo, hi = P.ph_hi;
    XcdBarrier bar; bar.bar = F.ctl + CW_BAR; bar.x = 0; bar.st = (volatile LAS unsigned*)(F.lds + MISC_OFF + 16);
    if (hi - lo > 1) bar = xcd_barrier_post(F.ctl + CW_BAR, (volatile LAS unsigned*)(F.lds + MISC_OFF + 16));
#define IN(k) (lo <= (k) && (k) < hi)
#define SEAM(k) do { if (IN(k) && IN((k) + 1)) xcd_barrier(bar); } while (0)
#define QLOOP(qi, n, body) for (;;) { const int it = q_pop(F, layer * 12 + (qi)); if (it >= (n)) break; body; }
    if (EN(100) && IN(0)) { phase_prologue(F); phase_norm(F, F.in[I_X], false, F.in[I_NORM1], 3); } SEAM(0);
#pragma unroll
    for (int layer = 0; layer < DEPTH; ++layer) {
        const int pb = 1 + layer * NPH_LAYER;
        if (layer > 0) { if (EN(0) && IN(pb + 0)) { phase_norm(F, (const float*)(F.ws + WS_X), true, F.in[I_NORM1] + (size_t)layer * DM, 0); } SEAM(pb + 0); }
        if (EN(1) && IN(pb + 1)) { const Frame F_ = F; Frame F = relocal(F_); pg8::StaticOrder S; S.init((const bf16_t*)(F.ws + WS_H), (const bf16_t*)(F.ws + WS_WIN) + (size_t)layer * NINP * DM, NTOK, NINP, DM, F.G, F.bid);
            pg8::EpiBf16 E{(bf16_t*)(F.ws + WS_U), NINP}; pg8::gemm_phase(F.lds, DM, S, E); } SEAM(pb + 1);
#define SLOOP(n, body) for (int it = F.bid; it < (n); it += F.G) { __syncthreads(); body; }
        if (EN(2) && IN(pb + 2)) {
            if (IT(1)) SLOOP(1024, item_rwkv1(F, layer, it));
            if (IT(0)) SLOOP(256, item_s5<1>(F, layer, it));
            if (IT(2)) SLOOP(256, item_mamba<1>(F, layer, it));
            if (IT(3)) SLOOP(256, item_kv(F, layer, it));
        } SEAM(pb + 2);
        if (EN(3) && IN(pb + 3)) {
            if (IT(0)) SLOOP(8, item_rwkv_carry(F, it));
            if (IT(1)) { for (int it = F.bid - 8; it >= 0 && it < 16; it += F.G) { __syncthreads(); item_mamba_carry(F, it); } }
            if (IT(2)) { for (int it = F.bid - 24; it >= 0 && it < 4; it += F.G) { __syncthreads(); item_s5_carry(F, layer, it); } }
            if (IT(3)) {
                dsa_tables(F);
                const int pref = (int)(xb_xcc_id() & 3u);
#pragma unroll 1
                for (int k4 = 0; k4 < 4; ++k4) { const int bq = (pref + k4) & 3;
                    for (;;) { const int it = q_pop(F, 24 + layer * 4 + bq); if (it >= 512) break; item_dsa(F, layer, it * 4 + bq); } } }
        } SEAM(pb + 3);
        if (EN(4) && IN(pb + 4)) {
            if (IT(0)) SLOOP(256, item_s5<2>(F, layer, it));
            if (IT(2)) SLOOP(256, item_mamba<2>(F, layer, it));
            if (IT(1)) SLOOP(1024, item_rwkv3(F, layer, it));
        } SEAM(pb + 4);
        if (EN(6) && IN(pb + 5)) { const Frame F_ = F; Frame F = relocal(F_); pg8::StaticOrder S; S.init((const bf16_t*)(F.ws + WS_H), (const bf16_t*)(F.ws + WS_WOUT) + (size_t)layer * DM * DM, NTOK, DM, DM, F.G, F.bid);
            pg8::EpiResid E{layer == 0 ? F.in[I_X] : (const float*)(F.ws + WS_X), (float*)(F.ws + WS_X), DM}; pg8::gemm_phase(F.lds, DM, S, E); } SEAM(pb + 5);
        if (EN(7) && IN(pb + 6)) { phase_router(F, layer); phase_moe_convert(F, layer); phase_gather(F, layer); } SEAM(pb + 6);
        if (EN(8) && IN(pb + 7)) { const Frame F_ = F; Frame F = relocal(F_); LAS int* ul = (LAS int*)(F.lds + pg8::STAGE_BYTES + 8192); if (F.tid == 0) pg8::MoeOrder::build(ul, (const int*)(F.ws + WS_TILES), 2, F.G, F.bid); __syncthreads();
            pg8::MoeOrder S{DM, (const char*)(F.ws + WS_U), (const char*)(F.ws + WS_MOE + MOE_WGU), (size_t)512 * 1024 * 2, ul};
            pg8::EpiGated<1> E{(bf16_t*)(F.ws + WS_H), 256, 0, nullptr, nullptr}; pg8::gemm_phase<pg8::EpiGated<1>, pg8::MoeOrder, true>(F.lds, DM, S, E, (const char*)(F.ws + WS_U), (const int*)(F.ws + WS_ROWS)); phase_moe_convert_down(F, layer); } SEAM(pb + 7);
        if (EN(9) && IN(pb + 8)) { const Frame F_ = F; Frame F = relocal(F_); LAS int* ul = (LAS int*)(F.lds + pg8::STAGE_BYTES + 8192); if (F.tid == 0) pg8::MoeOrder::build(ul, (const int*)(F.ws + WS_TILES), 4, F.G, F.bid); __syncthreads();
            pg8::MoeOrder S{256, (const char*)(F.ws + WS_H), (const char*)(F.ws + WS_MOE + MOE_WD), (size_t)1024 * 256 * 2, ul};
            pg8::EpiMoeOut E{(bf16_t*)(F.ws + WS_U), (const int*)(F.ws + WS_ROWS), (const float*)(F.ws + WS_ROWS) + MAXROWS, F.lds}; pg8::gemm_phase(F.lds, 256, S, E); } SEAM(pb + 8);
    }
    if (EN(101) && IN(NPHASE - 1)) { phase_norm(F, (const float*)(F.ws + WS_X), true, F.in[I_FNORM], 2); }
#undef IN
#undef SEAM
}

#ifndef MK_SPLIT
#define MK_SPLIT 0
#endif
extern "C" void kernel_launch(void* const* d_in, const int* in_sizes, int n_in, void* d_out, int out_size, void* d_ws, size_t ws_size, hipStream_t stream) {
    static int grid = 0;
    if (grid == 0) {
        if (n_in != 44 || out_size != NTOK * DM || ws_size < WS_END) { fprintf(stderr, "kernel_launch: unexpected shapes (n_in %d out %d ws %zu need %zu)\n", n_in, out_size, ws_size, (size_t)WS_END); grid = -1; return; }
        int dev = 0, cus = 0;
        if (hipGetDevice(&dev) != hipSuccess || hipDeviceGetAttribute(&cus, hipDeviceAttributeMultiprocessorCount, dev) != hipSuccess) { grid = -1; return; }
        if (hipFuncSetAttribute((const void*)mk_forward, hipFuncAttributeMaxDynamicSharedMemorySize, LDS_BYTES) != hipSuccess) { fprintf(stderr, "kernel_launch: hipFuncSetAttribute failed\n"); grid = -1; return; }
        int per_cu = 0;
        if (hipOccupancyMaxActiveBlocksPerMultiprocessor(&per_cu, (const void*)mk_forward, NTHR, LDS_BYTES) != hipSuccess || per_cu < 1) { fprintf(stderr, "kernel_launch: occupancy query says %d\n", per_cu); }
        (void)hipGetLastError();
        grid = cus;
    }
    if (grid < 0) return;
    hipMemsetAsync((char*)d_ws + WS_CTL, 0, CTL_BYTES, stream);
    Params p{};
    for (int i = 0; i < 44; ++i) p.in[i] = (const float*)d_in[i];
    p.out = (float*)d_out; p.ws = (unsigned char*)d_ws;
#if MK_SPLIT
    for (int ph = 0; ph < NPHASE; ++ph) { p.ph_lo = ph; p.ph_hi = ph + 1; hipLaunchKernelGGL(mk_forward, dim3(grid), dim3(NTHR), LDS_BYTES, stream, p); }
#else
    p.ph_lo = 0; p.ph_hi = NPHASE; hipLaunchKernelGGL(mk_forward, dim3(grid), dim3(NTHR), LDS_BYTES, stream, p);
#endif
}
```

```cpp
#include <hip/hip_runtime.h>
#include <stdint.h>
#include <stdio.h>

#define LAS __attribute__((address_space(3)))
typedef unsigned short bf16_t;
typedef short bf16x8 __attribute__((ext_vector_type(8)));
typedef float f32x4 __attribute__((ext_vector_type(4)));
typedef float f32x2 __attribute__((ext_vector_type(2)));
typedef float f32x16 __attribute__((ext_vector_type(16)));
typedef unsigned u32x4 __attribute__((ext_vector_type(4)));
typedef unsigned u32x2 __attribute__((ext_vector_type(2)));

constexpr int NTOK = 16384, DM = 1024, SEQ = 4096, NBATCH = 4, DEPTH = 2;
constexpr int NIN = 2604, NINP = 2816;
constexpr int UM = 0;
constexpr int UR = 784;
constexpr int UC = 1680;
constexpr int US = 2368;
constexpr int NTHR = 512;
constexpr int LDS_BYTES = 163840;
constexpr int MISC_OFF = LDS_BYTES - 256;

constexpr size_t WS_CTL   = 0;
constexpr size_t CTL_BYTES = 65536;
constexpr size_t WS_X     = WS_CTL + CTL_BYTES;
constexpr size_t WS_H     = WS_X + (size_t)NTOK * DM * 4;
constexpr size_t WS_U     = WS_H + (size_t)NTOK * DM * 2;
constexpr size_t WS_WIN   = WS_U + (size_t)NTOK * NINP * 2;
constexpr size_t WS_WOUT  = WS_WIN + (size_t)2 * NINP * DM * 2;
constexpr size_t WS_GLU   = WS_WOUT + (size_t)2 * DM * DM * 2;
constexpr size_t WS_MOE   = WS_GLU + (size_t)2 * 512 * 256 * 2;
constexpr size_t MOE_WGU  = 0;
constexpr size_t MOE_WD   = (size_t)32 * 512 * 1024 * 2;
constexpr size_t MOE_BYTES = MOE_WD + (size_t)32 * 1024 * 256 * 2;
constexpr size_t RW_PT    = 0;
constexpr size_t RW_U     = (size_t)1024 * 4096 * 2;
constexpr size_t RW_S     = RW_U + (size_t)1024 * 4096 * 2;
constexpr size_t RW_W1    = RW_S + (size_t)1024 * 4096 * 2;
constexpr size_t RW_Z     = RW_W1 + (size_t)1024 * 4096 * 2;
constexpr size_t YSG_OFF  = RW_Z + (size_t)1024 * 4096 * 2;
static_assert(YSG_OFF + (size_t)NTOK * 256 * 2 <= MOE_BYTES, "alias");
constexpr size_t WS_MST   = WS_MOE + MOE_BYTES;
constexpr size_t WS_MDEC  = WS_MST + (size_t)4 * 64 * 4 * 4096 * 4;
constexpr size_t WS_S5ST  = WS_MDEC + 4096;
constexpr size_t WS_K     = WS_S5ST + (size_t)4 * 64 * 2048 * 4;
constexpr size_t WS_V     = WS_K + (size_t)NTOK * 64 * 2;
constexpr size_t WS_KIDX  = WS_V + (size_t)NTOK * 64 * 2;
constexpr size_t WS_ROUTE = WS_KIDX + (size_t)NTOK * 32 * 2;
constexpr size_t WS_ROWS  = WS_ROUTE + (size_t)NTOK * 32;
constexpr int    MAXROWS  = 49152;
constexpr size_t WS_TILES = WS_ROWS + (size_t)MAXROWS * 8;
constexpr size_t WS_S5TAB = WS_TILES + 4096;
constexpr size_t S5TAB_F  = (size_t)(2048 + 2048 + 32768) * 4;
constexpr size_t S5TAB_BBT = S5TAB_F + (size_t)16 * 16 * 128 * 2;
constexpr size_t S5TAB_L  = S5TAB_BBT + (size_t)16 * 128 * 16 * 2;
constexpr size_t WS_WRT   = WS_S5TAB + 2 * S5TAB_L;
constexpr size_t WS_BON   = WS_WRT + (size_t)2 * 2 * 48 * 1024 * 2;
constexpr size_t WS_END   = WS_BON + (size_t)1024 * 64 * 4;

constexpr int CW_BAR = 0;
constexpr int CW_Q   = 4096;
constexpr int CW_CNT = 8192;
constexpr int CW_RB  = 8448;

__device__ __forceinline__ float bf2f(bf16_t b) { return __uint_as_float(((unsigned)b) << 16); }
__device__ __forceinline__ bf16_t f2bf(float f) { const __bf16 h = (__bf16)f; return __builtin_bit_cast(bf16_t, h); }
__device__ __forceinline__ unsigned pk2(float lo, float hi) { typedef __bf16 bf2_t __attribute__((ext_vector_type(2))); const bf2_t h = __builtin_convertvector((f32x2){lo, hi}, bf2_t); return __builtin_bit_cast(unsigned, h); }
__device__ __forceinline__ unsigned cvt_pk_bf16(float lo, float hi) { unsigned r; asm volatile("v_cvt_pk_bf16_f32 %0, %1, %2" : "=v"(r) : "v"(lo), "v"(hi)); return r; }
__device__ __forceinline__ float sigmoidf_(float x) { return 1.0f / (1.0f + __expf(-x)); }
__device__ __forceinline__ float siluf_(float x) { return x / (1.0f + __expf(-x)); }
__device__ __forceinline__ float tanhf_(float x) { const float e = __expf(2.0f * x); return 1.0f - 2.0f / (e + 1.0f); }
__device__ __forceinline__ float softplusf_(float x) { return fmaxf(x, 0.0f) + log1pf(__expf(-fabsf(x))); }
__device__ __forceinline__ float gelu_tanh(float x) { return 0.5f * x * (1.0f + tanhf_(0.7978845608028654f * (x + 0.044715f * x * x * x))); }
template <int CTRL> __device__ __forceinline__ float dppf(float x) { return __int_as_float(__builtin_amdgcn_update_dpp(0, __float_as_int(x), CTRL, 0xF, 0xF, true)); }
__device__ __forceinline__ float sum4(float x) { x += dppf<0xB1>(x); x += dppf<0x4E>(x); return x; }
__device__ __forceinline__ float sum8(float x) { x = sum4(x); x += dppf<0x141>(x); return x; }
__device__ __forceinline__ float sum16(float x) { x = sum8(x); x += dppf<0x140>(x); return x; }
__device__ __forceinline__ int lane_id_() { int l = (int)__builtin_amdgcn_mbcnt_hi(~0u, __builtin_amdgcn_mbcnt_lo(~0u, 0u)); asm volatile("" : "+v"(l)); return l; }
__device__ __forceinline__ float shx(float x, int o) { return __int_as_float(__builtin_amdgcn_ds_bpermute((lane_id_() ^ o) << 2, __float_as_int(x))); }
__device__ __forceinline__ unsigned shdown_u(unsigned x, int o) { return (unsigned)__builtin_amdgcn_ds_bpermute(((lane_id_() + o) & 63) << 2, (int)x); }
__device__ __forceinline__ int shidx_i(int x, int src) { return __builtin_amdgcn_ds_bpermute(src << 2, x); }
__device__ __forceinline__ float wave_sum(float x) { x = sum16(x); x += shx(x, 16); x += shx(x, 32); return x; }
__device__ __forceinline__ void unpack8(const u32x4 v, float (&f)[8]) {
    f[0] = __uint_as_float(v.x << 16); f[1] = __uint_as_float(v.x & 0xffff0000u); f[2] = __uint_as_float(v.y << 16); f[3] = __uint_as_float(v.y & 0xffff0000u);
    f[4] = __uint_as_float(v.z << 16); f[5] = __uint_as_float(v.z & 0xffff0000u); f[6] = __uint_as_float(v.w << 16); f[7] = __uint_as_float(v.w & 0xffff0000u);
}

__device__ __forceinline__ void st16_wt(void* p, u32x4 v) { asm volatile("global_store_dwordx4 %0, %1, off sc1\n\ts_nop 1" :: "v"(p), "v"(v) : "memory"); }
#define XB_TMO      128
#define XB_XCNT(j)  (256  + 64 * (j))
#define XB_XSUB(j)  (1280 + 64 * (j))
#define XB_XGEN(j)  (2304 + 64 * (j))
#define XB_TOP      3328
#define XB_TOPGEN   3392
#define XCD_BAR_WORDS 3456
#define XB_SPIN_CAP (1u << 22)
__device__ __forceinline__ unsigned xb_ld(unsigned* p)              { return __hip_atomic_load(p, __ATOMIC_RELAXED, __HIP_MEMORY_SCOPE_AGENT); }
__device__ __forceinline__ unsigned xb_add(unsigned* p, unsigned v) { return __hip_atomic_fetch_add(p, v, __ATOMIC_RELAXED, __HIP_MEMORY_SCOPE_AGENT); }
__device__ __forceinline__ unsigned xb_xcc_id() { return (unsigned)__builtin_amdgcn_s_getreg((3 << 11) | 20) & 0xFu; }
#define XB_SPIN(cond, bar) do { unsigned _sp = 0; while (cond) { __builtin_amdgcn_s_sleep(1); \
    if ((++_sp & 255u) == 0u) { if (xb_ld(&(bar)[XB_TMO])) break; if (_sp > XB_SPIN_CAP) { atomicAdd(&(bar)[XB_TMO], 1u); break; } } } } while (0)
struct XcdBarrier { unsigned* bar; unsigned x; volatile LAS unsigned* st; };
__device__ __forceinline__ XcdBarrier xcd_barrier_post(unsigned* bar, volatile LAS unsigned* st) {
    XcdBarrier b; b.bar = bar; b.x = xb_xcc_id(); b.st = st;
    if (threadIdx.x == 0) (void)xb_add(&bar[XB_XCNT(b.x)], 1u);
    return b;
}
__device__ __forceinline__ void xcd_barrier_complete(unsigned* bar, unsigned x, unsigned& nloc, unsigned& nx) {
    const unsigned G = gridDim.x * gridDim.y * gridDim.z;
    unsigned sum, cnt, mine, sp = 0u;
    for (;;) {
        sum = 0u; cnt = 0u; mine = 0u;
#pragma unroll
        for (unsigned j = 0; j < 16; ++j) { const unsigned c = xb_ld(&bar[XB_XCNT(j)]); sum += c; cnt += (c > 0u) ? 1u : 0u; mine = (j == x) ? c : mine; }
        if (sum == G) break;
        __builtin_amdgcn_s_sleep(1);
        if ((++sp & 255u) == 0u) { if (xb_ld(&bar[XB_TMO])) break; if (sp > XB_SPIN_CAP) { atomicAdd(&bar[XB_TMO], 1u); break; } }
    }
    nloc = mine > 0u ? mine : 1u; nx = cnt > 0u ? cnt : 1u;
}
__device__ __forceinline__ void xcd_barrier(const XcdBarrier& b_) {
    XcdBarrier b = b_; { const unsigned long long v = (unsigned long long)b.bar; unsigned lo = __builtin_amdgcn_readfirstlane((unsigned)v), hi = __builtin_amdgcn_readfirstlane((unsigned)(v >> 32)); asm volatile("" : "+s"(lo), "+s"(hi)); b.bar = (unsigned*)(((unsigned long long)hi << 32) | lo); unsigned xx = __builtin_amdgcn_readfirstlane(b.x); asm volatile("" : "+s"(xx)); b.x = xx; }
    asm volatile("s_waitcnt vmcnt(0)" ::: "memory");
    __syncthreads();
    if (threadIdx.x == 0) {
        unsigned* bar = b.bar;
        __builtin_amdgcn_s_waitcnt(0);
        unsigned nloc = b.st[0], nx = b.st[1];
        if (nloc == 0u) { xcd_barrier_complete(bar, b.x, nloc, nx); b.st[0] = nloc; b.st[1] = nx; }
        const unsigned old = xb_add(&bar[XB_XSUB(b.x)], 1u);
        const unsigned gen = old / nloc;
        if (old + 1u == (gen + 1u) * nloc) {
            __builtin_amdgcn_fence(__ATOMIC_RELEASE, "agent");
            asm volatile("s_waitcnt vmcnt(0)" ::: "memory");
            const unsigned og = xb_add(&bar[XB_TOP], 1u);
            const unsigned tg = og / nx;
            if (og + 1u == (tg + 1u) * nx) xb_add(&bar[XB_TOPGEN], 1u);
            else XB_SPIN(xb_ld(&bar[XB_TOPGEN]) == tg, bar);
            __builtin_amdgcn_fence(__ATOMIC_ACQUIRE, "agent");
            xb_add(&bar[XB_XGEN(b.x)], 1u);
            asm volatile("s_waitcnt vmcnt(0)" ::: "memory");
        } else {
            XB_SPIN(xb_ld(&bar[XB_XGEN(b.x)]) == gen, bar);
            __builtin_amdgcn_fence(__ATOMIC_ACQUIRE, "agent");
            asm volatile("s_waitcnt vmcnt(0)" ::: "memory");
        }
    }
    __syncthreads();
}

namespace pg8 {
constexpr int BM = 256, BK = 64, HALF = 128, HTB = HALF * BK * 2, STAGE_BYTES = 8 * HTB, NXCD = 8, WGM = 8;
__host__ __device__ __forceinline__ int lds_byte(int r, int c) { const int st = (r >> 4) * 2 + (c >> 5), rr = r & 15, cc = c & 31, ob = rr * 64 + cc * 2; return st * 1024 + (ob ^ (((ob >> 9) & 1) << 5)); }
__host__ __device__ __forceinline__ void stage_rc(int b, int& R, int& C) { const int st = b / 1024, sb = b % 1024, swz = sb ^ (((sb >> 9) & 1) << 5); R = (st >> 1) * 16 + swz / 64; C = (st & 1) * 32 + (swz % 64) / 2; }
__host__ __device__ __forceinline__ int perm32(int rho) { const int n = rho >> 4, i = rho & 15; return 8 * (i >> 2) + 4 * n + (i & 3); }
struct Unit { int pm, pn; const char* a; const char* b; };

struct StaticOrder {
    int nM, nN, nwg, G, c, K; const char* A; const char* B;
    __device__ void init(const bf16_t* A_, const bf16_t* B_, int M, int N, int K_, int G_, int c_) { A = (const char*)A_; B = (const char*)B_; K = K_; nM = M / BM; nN = N / BM; nwg = nM * nN; G = G_; c = c_; }
    __device__ bool next(int i, Unit& u) const {
        const long L = (long)i * G + c; if (L >= nwg) return false;
        int wgid = (int)L; { const int q = nwg / NXCD, r = nwg % NXCD, xcd = wgid % NXCD, off = wgid / NXCD; wgid = (xcd < r ? xcd * (q + 1) : r * (q + 1) + (xcd - r) * q) + off; }
        const int nig = WGM * nN, gid = wgid / nig, fm = gid * WGM, gsz = (nM - fm) < WGM ? (nM - fm) : WGM;
        u.pm = fm + ((wgid % nig) % gsz); u.pn = (wgid % nig) / gsz;
        u.a = A + (size_t)u.pm * 256 * K * 2; u.b = B + (size_t)u.pn * 256 * K * 2; return true;
    }
};

template <class Epi, class Sched, bool GATHER = false>
__device__ __forceinline__ void gemm_phase(LAS unsigned char* lds, const int K_, const Sched& S, const Epi& E, const char* Aall = nullptr, const int* arow = nullptr) {
    int K = K_; asm volatile("" : "+s"(K));
    int tid_ = threadIdx.x; asm volatile("" : "+v"(tid_));
    const int tid = tid_, wid = __builtin_amdgcn_readfirstlane(tid >> 6), lane = tid & 63, wr = wid >> 2, wc = wid & 3, fr = lane & 15, fq = lane >> 4;
    const int nt = K / BK;
    unsigned voffA[2], voffB[2]; int Rst[2], Cst[2];
#pragma unroll
    for (int i = 0; i < 2; ++i) { int R, C; stage_rc(tid * 16 + i * 8192, R, C); const int Rb = Epi::PERM ? ((R & ~31) + perm32(R & 31)) : R; Rst[i] = R; Cst[i] = C;
        voffA[i] = (unsigned)(R * K + C) * 2u; voffB[i] = (unsigned)(Rb * K + C) * 2u; }
    unsigned gv[2][2], gn[2][2];
#define PG8_GOFF(dst, unit) do { _Pragma("unroll") for (int h_ = 0; h_ < 2; ++h_) _Pragma("unroll") for (int i_ = 0; i_ < 2; ++i_) { const int rr_ = arow[(unit).pm * BM + h_ * HALF + Rst[i_]]; \
        dst[h_][i_] = ((unsigned)(rr_ < 0 ? 0 : rr_ >> 1) * (unsigned)K + (unsigned)Cst[i_]) * 2u; } } while (0)
    const size_t kstep = (size_t)(BK * 2);
    const size_t hstep = (size_t)HALF * K * 2;
    const unsigned ldsw = (unsigned)wid * 1024u;
    const int aoff = lds_byte(wr * 64 + fr, fq * 8), boff = lds_byte(wc * 32 + fr, fq * 8);
#define PG8_SA(b, h) (((b) * 2 + (h)) * HTB)
#define PG8_SB(b, h) ((4 + (b) * 2 + (h)) * HTB)
#define PG8_STAGE(bufoff, gbase, voff) do { _Pragma("unroll") for (int _i = 0; _i < 2; ++_i) \
        __builtin_amdgcn_global_load_lds((const unsigned*)((const char*)(gbase) + (voff)[_i]), (LAS unsigned*)(lds + (bufoff) + ldsw + _i * 8192), 16, 0, 0); } while (0)
#define PG8_LDA(dst, b, h) do { _Pragma("unroll") for (int m = 0; m < 4; ++m) _Pragma("unroll") for (int k = 0; k < 2; ++k) dst[m][k] = *(const LAS bf16x8*)(lds + PG8_SA(b, h) + aoff + m * 2048 + k * 1024); } while (0)
#define PG8_LDB(dst, b, h) do { _Pragma("unroll") for (int n = 0; n < 2; ++n) _Pragma("unroll") for (int k = 0; k < 2; ++k) dst[n][k] = *(const LAS bf16x8*)(lds + PG8_SB(b, h) + boff + n * 2048 + k * 1024); } while (0)
#define PG8_MMA(ai, bj, At, Bt) do { __builtin_amdgcn_s_setprio(1); _Pragma("unroll") for (int m = 0; m < 4; ++m) _Pragma("unroll") for (int n = 0; n < 2; ++n) _Pragma("unroll") for (int k = 0; k < 2; ++k) \
        acc[ai][bj][m][n] = __builtin_amdgcn_mfma_f32_16x16x32_bf16(Bt[n][k], At[m][k], acc[ai][bj][m][n], 0, 0, 0); __builtin_amdgcn_s_setprio(0); } while (0)
#define PG8_WAIT_V(n) asm volatile("s_waitcnt vmcnt(" #n ")" ::: "memory")
#define PG8_WAIT_L(n) asm volatile("s_waitcnt lgkmcnt(" #n ")" ::: "memory")
#define PG8_BAR __builtin_amdgcn_s_barrier()
#define PG8_SCHED __builtin_amdgcn_sched_barrier(0)
    Unit cur, nxt; int ui = 0;
    if (!S.next(0, cur)) return;
    f32x4 acc[2][2][4][2];
#pragma unroll
    for (int a = 0; a < 2; ++a)
#pragma unroll
        for (int b = 0; b < 2; ++b)
#pragma unroll
            for (int m = 0; m < 4; ++m)
#pragma unroll
                for (int n = 0; n < 2; ++n) acc[a][b][m][n] = (f32x4){0.f, 0.f, 0.f, 0.f};
    bf16x8 At[4][2], B0[2][2], B1[2][2];
    const char* cA = GATHER ? Aall : cur.a; const char* cB = cur.b;
    if (GATHER) PG8_GOFF(gv, cur);
#define PG8_STAGE_A(bufoff, gbase, h, vo) do { if (GATHER) PG8_STAGE(bufoff, gbase, (vo)[h]); else PG8_STAGE(bufoff, (gbase) + ((h) ? hstep : 0), voffA); } while (0)
    PG8_STAGE(PG8_SB(0, 0), cB, voffB); PG8_STAGE_A(PG8_SA(0, 0), cA, 0, gv); PG8_STAGE(PG8_SB(0, 1), cB + hstep, voffB); PG8_STAGE_A(PG8_SA(0, 1), cA, 1, gv);
    if (wr == 1) PG8_BAR;
    PG8_WAIT_V(4); PG8_BAR;
    PG8_STAGE(PG8_SB(1, 0), cB + kstep, voffB); PG8_STAGE_A(PG8_SA(1, 0), cA + kstep, 0, gv); PG8_STAGE(PG8_SB(1, 1), cB + hstep + kstep, voffB);
    PG8_WAIT_V(6); PG8_BAR;
    for (;;) {
        const bool has_next = S.next(ui + 1, nxt);
        const char* nA = GATHER ? cA : (has_next ? nxt.a : cA); const char* nB = has_next ? nxt.b : cB;
        if (GATHER) { if (has_next) PG8_GOFF(gn, nxt); else {
#pragma unroll
            for (int h_ = 0; h_ < 2; ++h_)
#pragma unroll
                for (int i_ = 0; i_ < 2; ++i_) gn[h_][i_] = gv[h_][i_]; } }
        for (int t = 0; t < nt; t += 2) {
            const bool last = (t == nt - 2);
            const char* a1 = cA + (size_t)(t + 1) * kstep;
            const char* a2 = last ? nA : cA + (size_t)(t + 2) * kstep; const char* b2 = last ? nB : cB + (size_t)(t + 2) * kstep;
            const char* a3 = a2 + kstep; const char* b3 = b2 + kstep;
            unsigned vo2[2][2];
#pragma unroll
            for (int h_ = 0; h_ < 2; ++h_)
#pragma unroll
                for (int i_ = 0; i_ < 2; ++i_) vo2[h_][i_] = GATHER ? (last ? gn[h_][i_] : gv[h_][i_]) : 0u;
            PG8_LDB(B0, 0, 0); PG8_SCHED; PG8_LDA(At, 0, 0); PG8_STAGE_A(PG8_SA(1, 1), a1, 1, gv);
            PG8_WAIT_L(8); PG8_BAR; PG8_WAIT_L(0); PG8_MMA(0, 0, At, B0); PG8_BAR; PG8_SCHED;
            PG8_LDB(B1, 0, 1); PG8_STAGE(PG8_SB(0, 0), b2, voffB);
            PG8_BAR; PG8_WAIT_L(0); PG8_MMA(0, 1, At, B1); PG8_BAR;
            PG8_LDA(At, 0, 1); PG8_STAGE_A(PG8_SA(0, 0), a2, 0, vo2);
            PG8_BAR; PG8_WAIT_L(0); PG8_MMA(1, 0, At, B0); PG8_BAR; PG8_SCHED;
            PG8_STAGE(PG8_SB(0, 1), b2 + hstep, voffB);
            PG8_WAIT_V(6); PG8_BAR; PG8_MMA(1, 1, At, B1); PG8_BAR;
            PG8_LDB(B0, 1, 0); PG8_SCHED; PG8_LDA(At, 1, 0); PG8_STAGE_A(PG8_SA(0, 1), a2, 1, vo2);
            PG8_WAIT_L(8); PG8_BAR; PG8_WAIT_L(0); PG8_MMA(0, 0, At, B0); PG8_BAR; PG8_SCHED;
            PG8_LDB(B1, 1, 1); PG8_STAGE(PG8_SB(1, 0), b3, voffB);
            PG8_BAR; PG8_WAIT_L(0); PG8_MMA(0, 1, At, B1); PG8_BAR;
            PG8_LDA(At, 1, 1); PG8_STAGE_A(PG8_SA(1, 0), a3, 0, vo2);
            PG8_BAR; PG8_WAIT_L(0); PG8_MMA(1, 0, At, B0); PG8_BAR; PG8_SCHED;
            PG8_STAGE(PG8_SB(1, 1), b3 + hstep, voffB);
            PG8_WAIT_V(6); PG8_BAR; PG8_MMA(1, 1, At, B1); PG8_BAR;
        }
        E(acc, cur, wr, wc, fr, fq);
        if (!has_next) break;
#pragma unroll
        for (int a = 0; a < 2; ++a)
#pragma unroll
            for (int b = 0; b < 2; ++b)
#pragma unroll
                for (int m = 0; m < 4; ++m)
#pragma unroll
                    for (int n = 0; n < 2; ++n) acc[a][b][m][n] = (f32x4){0.f, 0.f, 0.f, 0.f};
        cur = nxt; cA = nA; cB = nB; ++ui;
        if (GATHER) {
#pragma unroll
            for (int h_ = 0; h_ < 2; ++h_)
#pragma unroll
                for (int i_ = 0; i_ < 2; ++i_) gv[h_][i_] = gn[h_][i_]; }
    }
    PG8_WAIT_V(0);
    if (wr == 0) PG8_BAR;
    PG8_BAR;
#undef PG8_SA
#undef PG8_SB
#undef PG8_STAGE
#undef PG8_STAGE_A
#undef PG8_GOFF
#undef PG8_LDA
#undef PG8_LDB
#undef PG8_MMA
#undef PG8_WAIT_V
#undef PG8_WAIT_L
#undef PG8_BAR
#undef PG8_SCHED
}

struct EpiBf16 {
    static constexpr bool PERM = true;
    bf16_t* O; int ldc;
    __device__ __forceinline__ void operator()(const f32x4 (&acc)[2][2][4][2], const Unit& u, int wr, int wc, int fr, int fq) const {
        const int row0 = u.pm * BM + wr * 64 + fr, col0 = u.pn * BM + wc * 32 + 8 * fq;
#pragma unroll
        for (int ai = 0; ai < 2; ++ai)
#pragma unroll
            for (int m = 0; m < 4; ++m) { bf16_t* rowp = O + (size_t)(row0 + ai * HALF + m * 16) * ldc + col0;
#pragma unroll
                for (int bj = 0; bj < 2; ++bj) { const f32x4 v0 = acc[ai][bj][m][0], v1 = acc[ai][bj][m][1];
                    u32x4 w; w.x = cvt_pk_bf16(v0[0], v0[1]); w.y = cvt_pk_bf16(v0[2], v0[3]); w.z = cvt_pk_bf16(v1[0], v1[1]); w.w = cvt_pk_bf16(v1[2], v1[3]);
                    st16_wt(rowp + bj * HALF, w); } }
    }
};
struct EpiResid {
    static constexpr bool PERM = false;
    const float* Cin; float* C; int ldc;
    __device__ __forceinline__ void operator()(const f32x4 (&acc)[2][2][4][2], const Unit& u, int wr, int wc, int fr_, int fq_) const {
        int fr = fr_, fq = fq_; asm volatile("" : "+v"(fr), "+v"(fq));
        const int row0 = u.pm * BM + wr * 64 + fr, col0 = u.pn * BM + wc * 32 + 4 * fq;
#pragma unroll
        for (int ai = 0; ai < 2; ++ai)
#pragma unroll
            for (int mp = 0; mp < 2; ++mp) { f32x4 cv[2][2][2];
#pragma unroll
                for (int mm = 0; mm < 2; ++mm) { const float* rowp = Cin + (size_t)(row0 + ai * HALF + (2 * mp + mm) * 16) * ldc + col0;
#pragma unroll
                    for (int bj = 0; bj < 2; ++bj)
#pragma unroll
                        for (int n = 0; n < 2; ++n) cv[mm][bj][n] = *(const f32x4*)(rowp + bj * HALF + n * 16); }
#pragma unroll
                for (int mm = 0; mm < 2; ++mm) { float* rowp = C + (size_t)(row0 + ai * HALF + (2 * mp + mm) * 16) * ldc + col0;
#pragma unroll
                    for (int bj = 0; bj < 2; ++bj)
#pragma unroll
                        for (int n = 0; n < 2; ++n) { const f32x4 o_ = cv[mm][bj][n] + acc[ai][bj][2 * mp + mm][n]; st16_wt(rowp + bj * HALF + n * 16, __builtin_bit_cast(u32x4, o_)); } }
                asm volatile("" ::: "memory"); }
    }
};
template <int ACT  > struct EpiGated {
    static constexpr bool PERM = true;
    bf16_t* O; int ldo; int coloff; const float* ba; const float* bb;
    __device__ __forceinline__ void operator()(const f32x4 (&acc)[2][2][4][2], const Unit& u, int wr, int wc, int fr, int fq) const {
        const int row0 = u.pm * BM + wr * 64 + fr, cl = u.pn * HALF + wc * 32 + 8 * fq;
        float va[8], vb[8];
#pragma unroll
        for (int j = 0; j < 8; ++j) { va[j] = (ACT == 0) ? ba[cl + j] : 0.f; vb[j] = (ACT == 0) ? bb[cl + j] : 0.f; }
#pragma unroll
        for (int ai = 0; ai < 2; ++ai)
#pragma unroll
            for (int m = 0; m < 4; ++m) { bf16_t* rowp = O + (size_t)(row0 + ai * HALF + m * 16) * ldo + coloff + cl;
                float o[8];
#pragma unroll
                for (int n = 0; n < 2; ++n)
#pragma unroll
                    for (int j = 0; j < 4; ++j) { const float a = acc[ai][0][m][n][j] + va[4 * n + j], b = acc[ai][1][m][n][j] + vb[4 * n + j];
                        o[4 * n + j] = (ACT == 0) ? a * sigmoidf_(b) : siluf_(a) * b; }
                u32x4 w; w.x = cvt_pk_bf16(o[0], o[1]); w.y = cvt_pk_bf16(o[2], o[3]); w.z = cvt_pk_bf16(o[4], o[5]); w.w = cvt_pk_bf16(o[6], o[7]);
                st16_wt(rowp, w); asm volatile("" ::: "memory"); }
    }
};
struct EpiMoeOut {
    static constexpr bool PERM = true;
    bf16_t* O; const int* row_tok; const float* row_w; LAS unsigned char* lds;
    __device__ __forceinline__ void operator()(const f32x4 (&acc)[2][2][4][2], const Unit& u, int wr, int wc, int fr_, int fq_) const {
        int fr = fr_, fq = fq_; asm volatile("" : "+v"(fr), "+v"(fq));
        const int col0 = u.pn * BM + wc * 32 + 8 * fq, lane = fq * 16 + fr;
        LAS u32x2* rinfo = (LAS u32x2*)(lds + STAGE_BYTES) + (wr * 4 + wc) * 128;
        { const int ra = u.pm * BM + wr * 64 + lane, rb = ra + HALF;
          const u32x2 ia = (u32x2){(unsigned)row_tok[ra], __float_as_uint(row_w[ra])}, ib = (u32x2){(unsigned)row_tok[rb], __float_as_uint(row_w[rb])};
          rinfo[lane] = ia; rinfo[64 + lane] = ib; }
#pragma unroll
        for (int ai = 0; ai < 2; ++ai)
#pragma unroll
            for (int m = 0; m < 4; ++m) { const u32x2 inf = rinfo[ai * 64 + m * 16 + fr]; const int ts = (int)inf.x; const float w = __uint_as_float(inf.y);
                if (ts >= 0) { bf16_t* rowp = O + ((size_t)(ts & 1) * NTOK + (size_t)(ts >> 1)) * DM + col0;
#pragma unroll
                    for (int bj = 0; bj < 2; ++bj) { const f32x4 v0 = acc[ai][bj][m][0] * w, v1 = acc[ai][bj][m][1] * w;
                        u32x4 q; q.x = cvt_pk_bf16(v0[0], v0[1]); q.y = cvt_pk_bf16(v0[2], v0[3]); q.z = cvt_pk_bf16(v1[0], v1[1]); q.w = cvt_pk_bf16(v1[2], v1[3]);
                        st16_wt(rowp + bj * HALF, q); } } }
    }
};
struct MoeOrder {
    int K; const char* A; const char* B; size_t bstride; const LAS int* list;
    static __device__ __forceinline__ void build(LAS int* list, const int* tiles, int nN, int G, int c) {
        const int nrt = tiles[0], nwg = nrt * nN; int n = 0;
        for (int i = 0; ; ++i) { const long L = (long)i * G + c; if (L >= (long)nwg || n >= 20) break;
            int wgid = (int)L; { const int q = nwg / NXCD, r = nwg % NXCD, xcd = wgid % NXCD, off = wgid / NXCD; wgid = (xcd < r ? xcd * (q + 1) : r * (q + 1) + (xcd - r) * q) + off; }
            const int pm = wgid / nN; list[1 + 3 * n] = pm; list[2 + 3 * n] = wgid % nN; list[3 + 3 * n] = tiles[64 + pm]; ++n; }
        list[0] = n;
    }
    __device__ bool next(int i, Unit& u) const {
        const int n = __builtin_amdgcn_readfirstlane(list[0]); if (i >= n) return false;
        u.pm = __builtin_amdgcn_readfirstlane(list[1 + 3 * i]); u.pn = __builtin_amdgcn_readfirstlane(list[2 + 3 * i]); const int e = __builtin_amdgcn_readfirstlane(list[3 + 3 * i]);
        u.a = A + (size_t)u.pm * 256 * K * 2; u.b = B + (size_t)e * bstride + (size_t)u.pn * 256 * K * 2; return true;
    }
};
}

struct Params { const float* in[44]; float* out; unsigned char* ws; int ph_lo, ph_hi; };
enum { I_X = 0, I_NORM1, I_WIN, I_MCONVW, I_MCONVB, I_MDTB, I_MALOG, I_MD, I_MNORM, I_RMU, I_RW0, I_RW2, I_RA0, I_RA2, I_RG2, I_RKK, I_RKA, I_RRK, I_RLNW, I_RLNB,
       I_CKVN, I_CWUK, I_CWUV, I_RELB, I_SARE, I_SAIM, I_SBRE, I_SBIM, I_SCRE, I_SCIM, I_SD, I_SLOGDT, I_SGLUW, I_SGLUB, I_WOUT, I_NORM2, I_WRG, I_BRG, I_WRE, I_BRE,
       I_WGATE, I_WUP, I_WDOWN, I_FNORM };

typedef const float* const __attribute__((address_space(4)))* in_tab_t;
struct Frame {
    LAS unsigned char* lds; int tid, lane, wave, bid, G;
    in_tab_t in; float* out; unsigned char* ws; unsigned* ctl;
    volatile LAS int* misc;
};

__device__ __forceinline__ int q_pop(Frame& F, int qi) {
    __syncthreads();
    if (F.tid == 0) F.misc[0] = (int)__hip_atomic_fetch_add(F.ctl + CW_Q + 64 * qi, 1u, __ATOMIC_RELAXED, __HIP_MEMORY_SCOPE_AGENT);
    __syncthreads();
    return F.misc[0];
}

__device__ __forceinline__ const void* opaque_ptr(const void* p) { const unsigned long long v = (unsigned long long)p; unsigned lo = __builtin_amdgcn_readfirstlane((unsigned)v), hi = __builtin_amdgcn_readfirstlane((unsigned)(v >> 32));
    asm volatile("" : "+s"(lo), "+s"(hi)); return (const void*)(((unsigned long long)hi << 32) | lo); }
__device__ __forceinline__ Frame relocal(const Frame& G) { Frame F = G; asm volatile("" : "+v"(F.tid)); F.ws = (unsigned char*)opaque_ptr(F.ws); F.ctl = (unsigned*)(F.ws + WS_CTL); F.in = (in_tab_t)(unsigned long long)opaque_ptr((const void*)(unsigned long long)F.in); F.lane = F.tid & 63; F.wave = __builtin_amdgcn_readfirstlane(F.tid >> 6); return F; }
template <int K> __device__ __forceinline__ f32x4 mma_nt(const LAS bf16_t* A, int lda, const LAS bf16_t* Bt, int ldb, f32x4 acc, int lane) {
    const int r = lane & 15, g = lane >> 4;
#pragma unroll
    for (int k0 = 0; k0 < K; k0 += 32) {
        const bf16x8 a = *(const LAS bf16x8*)(A + r * lda + k0 + 8 * g);
        const bf16x8 b = *(const LAS bf16x8*)(Bt + r * ldb + k0 + 8 * g);
        acc = __builtin_amdgcn_mfma_f32_16x16x32_bf16(a, b, acc, 0, 0, 0);
    }
    return acc;
}

template <class SrcMap> __device__ __forceinline__ void tr_tile(Frame& F, int ldsrc, bf16_t* dst, int K, int k0, int n0, SrcMap sm) {
    LAS float* tile = (LAS float*)F.lds;
    __syncthreads();
    { const int n4 = (F.tid & 63) * 4, kk = F.tid >> 6; const float* sp = sm(n0 + n4);
      f32x4 v[8];
#pragma unroll
      for (int ps = 0; ps < 8; ++ps) { v[ps] = (f32x4){0.f, 0.f, 0.f, 0.f}; if (sp) v[ps] = __builtin_nontemporal_load((const f32x4*)(sp + (size_t)(k0 + kk + 8 * ps) * ldsrc)); }
#pragma unroll
      for (int ps = 0; ps < 8; ++ps) { LAS float* t = tile + (kk + 8 * ps) * 257 + n4; t[0] = v[ps][0]; t[1] = v[ps][1]; t[2] = v[ps][2]; t[3] = v[ps][3]; } }
    __syncthreads();
    { const int kc = F.tid & 7;
#pragma unroll
      for (int j = 0; j < 4; ++j) { const int n = (F.tid >> 3) + 64 * j; float f[8];
#pragma unroll
          for (int i = 0; i < 8; ++i) f[i] = tile[(8 * kc + i) * 257 + n];
          u32x4 w; w.x = pk2(f[0], f[1]); w.y = pk2(f[2], f[3]); w.z = pk2(f[4], f[5]); w.w = pk2(f[6], f[7]);
          *(u32x4*)(dst + (size_t)(n0 + n) * K + k0 + 8 * kc) = w; } }
}

struct SmIn { const float* base; __device__ __forceinline__ const float* operator()(int n) const {
    int c; if (n < 772) c = n; else if (n < UR) return nullptr; else if (n < UR + 896) c = 772 + (n - UR); else if (n < UC) return nullptr;
    else if (n < UC + 680) c = 1668 + (n - UC); else if (n < US) return nullptr; else if (n < US + 256) c = 2348 + (n - US); else return nullptr; return base + c; } };
struct SmId { const float* base; __device__ __forceinline__ const float* operator()(int n) const { return base + n; } };
struct SmGlu { const float* base; __device__ __forceinline__ const float* operator()(int n) const { const int pn = n >> 8, rr = n & 255; return base + (rr < 128 ? 128 * pn + rr : 256 + 128 * pn + (rr - 128)); } };
struct SmGU { const float* gate; const float* up; __device__ __forceinline__ const float* operator()(int n) const {
    const unsigned long long d = (unsigned long long)up - (unsigned long long)gate; const unsigned long long a = (unsigned long long)gate + (((n & 255) < 128) ? 0ull : d); return (const float*)a + 128 * (n >> 8) + (n & 127); } };
__device__ __forceinline__ void phase_prologue(const Frame& F_) { Frame F = relocal(F_);
    for (int t = F.bid; t < 496; t += F.G) {
        if (t < 352) { const int l = t / 176, r = t % 176, kt = r / 11, nt = r % 11;
            tr_tile(F, NIN, (bf16_t*)(F.ws + WS_WIN) + (size_t)l * NINP * DM, DM, kt * 64, nt * 256, SmIn{F.in[I_WIN] + (size_t)l * DM * NIN}); }
        else if (t < 480) { const int q = t - 352, l = q / 64, r = q % 64, kt = r / 4, nt = r % 4;
            tr_tile(F, DM, (bf16_t*)(F.ws + WS_WOUT) + (size_t)l * DM * DM, DM, kt * 64, nt * 256, SmId{F.in[I_WOUT] + (size_t)l * DM * DM}); }
        else { const int q = t - 480, l = q / 8, r = q % 8, kt = r / 2, nt = r % 2;
            tr_tile(F, 512, (bf16_t*)(F.ws + WS_GLU) + (size_t)l * 512 * 256, 256, kt * 64, nt * 256, SmGlu{F.in[I_SGLUW] + (size_t)l * 256 * 512}); }
    }
    for (int i = F.bid * NTHR + F.tid; i < 2 * 48 * 1024; i += F.G * NTHR) { const int l = i / 49152, r = i % 49152, o = r >> 10, k = r & 1023;
        float v = 0.f; if (o < 32) v = F.in[I_WRE][((size_t)l * DM + k) * 32 + o]; else if (o < 36) v = F.in[I_WRG][((size_t)l * DM + k) * 4 + (o - 32)];
        v *= F.in[I_NORM2][l * DM + k];
        const bf16_t hi = f2bf(v); const bf16_t lo = f2bf(v - bf2f(hi));
        bf16_t* w = (bf16_t*)(F.ws + WS_WRT) + (size_t)l * 2 * 49152; w[r] = hi; w[49152 + r] = lo; }
    for (int i = F.bid * NTHR + F.tid; i < 2048 + 65536; i += F.G * NTHR) {
        if (i < 2048) {
            const int l = i >> 10, gn = i & 1023, g = gn >> 6;
            float* tab = (float*)(F.ws + WS_S5TAB + (size_t)l * S5TAB_L);
            const float lre = fminf(F.in[I_SARE][l * 1024 + gn], -1e-4f), lim = F.in[I_SAIM][l * 1024 + gn];
            const float dt = expf(F.in[I_SLOGDT][l * 16 + g]);
            const float mag = expf(dt * lre); float sn, cs; sincosf(dt * lim, &sn, &cs);
            const float are = mag * cs, aim = mag * sn;
            const float den = lre * lre + lim * lim;
            const float fre = ((are - 1.0f) * lre + aim * lim) / den, fim = (aim * lre - (are - 1.0f) * lim) / den;
            tab[gn * 2] = are; tab[gn * 2 + 1] = aim;
            float pr = are, pi = aim;
#pragma unroll
            for (int s = 0; s < 6; ++s) { const float nr = pr * pr - pi * pi, ni = 2.0f * pr * pi; pr = nr; pi = ni; }
            tab[2048 + gn * 2] = pr; tab[2048 + gn * 2 + 1] = pi;
            const float* bre = F.in[I_SBRE] + ((size_t)l * 1024 + gn) * 16; const float* bim = F.in[I_SBIM] + ((size_t)l * 1024 + gn) * 16;
            bf16_t* bbt = (bf16_t*)(F.ws + WS_S5TAB + (size_t)l * S5TAB_L + S5TAB_BBT); const int n = gn & 63, col = 4 * (n & 31) + 2 * (n >> 5);
            for (int p = 0; p < 16; ++p) { const float vr = fre * bre[p] - fim * bim[p], vi = fre * bim[p] + fim * bre[p];
                bbt[((size_t)g * 128 + col) * 16 + p] = f2bf(vr); bbt[((size_t)g * 128 + col + 1) * 16 + p] = f2bf(vi); }
        } else {
            const int j = i - 2048, l = j >> 15, r = j & 32767, gp = r >> 7, k = r & 127;
            bf16_t* cm = (bf16_t*)(F.ws + WS_S5TAB + (size_t)l * S5TAB_L + S5TAB_F);
            const int n = (k >> 2) + 32 * ((k >> 1) & 1);
            const float v = (k & 1) == 0 ? F.in[I_SCRE][((size_t)l * 256 + gp) * 64 + n] : -F.in[I_SCIM][((size_t)l * 256 + gp) * 64 + n];
            cm[r] = f2bf(v);
        }
    }
}

__device__ __forceinline__ void phase_norm(const Frame& F_, const float* xin, bool add_o, const float* w, int mode) { Frame F = relocal(F_);
    float* X = (float*)(F.ws + WS_X); bf16_t* H = (bf16_t*)(F.ws + WS_H); const bf16_t* O = (const bf16_t*)(F.ws + WS_U);
    for (int row0 = F.bid * 32 + F.wave * 4; row0 < NTOK; row0 += F.G * 32) {
        f32x4 v[4][4]; u32x2 oa[4][4], ob[4][4];
#pragma unroll
        for (int r = 0; r < 4; ++r)
#pragma unroll
            for (int j = 0; j < 4; ++j) { const int c = 4 * F.lane + 256 * j; const size_t o = (size_t)(row0 + r) * DM + c; v[r][j] = (mode == 2) ? __builtin_nontemporal_load((const f32x4*)(xin + o)) : *(const f32x4*)(xin + o);
                if (add_o) { oa[r][j] = __builtin_nontemporal_load((const u32x2*)(O + o)); ob[r][j] = __builtin_nontemporal_load((const u32x2*)(O + (size_t)NTOK * DM + o)); } }
#pragma unroll
        for (int r = 0; r < 4; ++r) { const int row = row0 + r; float ss = 0.f;
#pragma unroll
            for (int j = 0; j < 4; ++j) {
                if (add_o) { const u32x2 a = oa[r][j], b = ob[r][j];
                    v[r][j][0] += __uint_as_float(a.x << 16) + __uint_as_float(b.x << 16); v[r][j][1] += __uint_as_float(a.x & 0xffff0000u) + __uint_as_float(b.x & 0xffff0000u);
                    v[r][j][2] += __uint_as_float(a.y << 16) + __uint_as_float(b.y << 16); v[r][j][3] += __uint_as_float(a.y & 0xffff0000u) + __uint_as_float(b.y & 0xffff0000u); }
                ss += v[r][j][0] * v[r][j][0] + v[r][j][1] * v[r][j][1] + v[r][j][2] * v[r][j][2] + v[r][j][3] * v[r][j][3]; }
            ss = wave_sum(ss);
            const float rstd = rsqrtf(ss * (1.0f / DM) + 1e-6f);
#pragma unroll
            for (int j = 0; j < 4; ++j) { const int c = 4 * F.lane + 256 * j; const f32x4 wv = *(const f32x4*)(w + c);
                if (mode == 2) { __builtin_nontemporal_store(v[r][j] * rstd * wv, (f32x4*)(F.out + (size_t)row * DM + c)); }
                else { if (mode == 0) *(f32x4*)(X + (size_t)row * DM + c) = v[r][j];
                    u32x2 o; o.x = pk2(v[r][j][0] * rstd * wv[0], v[r][j][1] * rstd * wv[1]); o.y = pk2(v[r][j][2] * rstd * wv[2], v[r][j][3] * rstd * wv[3]);
                    *(u32x2*)(H + (size_t)row * DM + c) = o; } } }
    }
}

__device__ __forceinline__ void item_kv(const Frame& F_, int layer, int item) { Frame F = relocal(F_);
    const bf16_t* U = (const bf16_t*)(F.ws + WS_U);
    LAS bf16_t* Ab = (LAS bf16_t*)F.lds;
    LAS bf16_t* Bt = (LAS bf16_t*)(F.lds + 17408);
    const int t0 = item * 64;
    { const int tok = F.tid >> 3, part = F.tid & 7; const bf16_t* src = U + (size_t)(t0 + tok) * NINP + UC + 256 + 16 * part;
      float f[16]; { float a[8], b[8]; unpack8(*(const u32x4*)src, a); unpack8(*(const u32x4*)(src + 8), b);
#pragma unroll
        for (int j = 0; j < 8; ++j) { f[j] = a[j]; f[8 + j] = b[j]; } }
      float ss = 0.f;
#pragma unroll
      for (int j = 0; j < 16; ++j) ss += f[j] * f[j];
      ss = sum8(ss);
      const float rstd = rsqrtf(ss * (1.0f / 128.0f) + 1e-6f); const float* nw = F.in[I_CKVN] + layer * 128 + 16 * part;
#pragma unroll
      for (int j = 0; j < 16; j += 2) *(LAS unsigned*)(Ab + tok * 136 + 16 * part + j) = pk2(f[j] * rstd * nw[j], f[j + 1] * rstd * nw[j + 1]); }
    { const int n = F.tid >> 2, kq = F.tid & 3; const float* w = (n < 64 ? F.in[I_CWUK] : F.in[I_CWUV]) + (size_t)layer * 128 * 64 + (n & 63);
      float wv[32];
#pragma unroll
      for (int k = 0; k < 32; ++k) wv[k] = w[(size_t)(32 * kq + k) * 64];
#pragma unroll
      for (int k = 0; k < 32; k += 2) *(LAS unsigned*)(Bt + n * 136 + 32 * kq + k) = pk2(wv[k], wv[k + 1]); }
    if (F.tid < 256) { const int tok = F.tid >> 2, q = F.tid & 3;
        *(u32x4*)((bf16_t*)(F.ws + WS_KIDX) + (size_t)(t0 + tok) * 32 + 8 * q) = *(const u32x4*)(U + (size_t)(t0 + tok) * NINP + UC + 640 + 8 * q); }
    __syncthreads();
    const int mt = F.wave & 3, g = F.lane >> 4, r = F.lane & 15;
#pragma unroll
    for (int q = 0; q < 4; ++q) { const int nt = (F.wave >> 2) * 4 + q;
        f32x4 acc = (f32x4){0.f, 0.f, 0.f, 0.f};
        acc = mma_nt<128>(Ab + mt * 16 * 136, 136, Bt + nt * 16 * 136, 136, acc, F.lane);
        const int n = nt * 16 + r; bf16_t* dst = (bf16_t*)(F.ws + (n < 64 ? WS_K : WS_V));
#pragma unroll
        for (int i = 0; i < 4; ++i) dst[(size_t)(t0 + mt * 16 + 4 * g + i) * 64 + (n & 63)] = f2bf(acc[i]); }
}

constexpr int MB_CG = 0, MB_BG = 18432, MB_BT = 36864, MB_XT = 55296, MB_M = 92160, MB_S0 = 101376, MB_DT = 110592, MB_AC = 111616, MB_RS = 112640;
template <int STAGE> __device__ __forceinline__ void item_mamba(const Frame& F_, int layer, int item) { Frame F = relocal(F_);
    const bf16_t* U = (const bf16_t*)(F.ws + WS_U);
    const int b = item >> 6, c = item & 63, l0 = c * 64; const size_t T0 = (size_t)b * SEQ + l0;
    LAS bf16_t* Cg = (LAS bf16_t*)(F.lds + MB_CG); LAS bf16_t* Bg = (LAS bf16_t*)(F.lds + MB_BG); LAS bf16_t* BT = (LAS bf16_t*)(F.lds + MB_BT);
    LAS bf16_t* XT = (LAS bf16_t*)(F.lds + MB_XT); LAS bf16_t* Mb = (LAS bf16_t*)(F.lds + MB_M); LAS bf16_t* S0 = (LAS bf16_t*)(F.lds + MB_S0);
    LAS float* dts = (LAS float*)(F.lds + MB_DT); LAS float* acs = (LAS float*)(F.lds + MB_AC); LAS float* rs = (LAS float*)(F.lds + MB_RS);
    if (F.tid < 256) { const int l = F.tid >> 2, h = F.tid & 3;
        const float raw = bf2f(U[(T0 + l) * NINP + UM + 768 + h]) + F.in[I_MDTB][layer * 4 + h];
        const float dt = softplusf_(raw); dts[l * 4 + h] = dt; acs[l * 4 + h] = -__expf(F.in[I_MALOG][layer * 4 + h]) * dt; }
    if (F.tid < 64) rs[F.tid] = 0.f;
    __syncthreads();
    float mycum = 0.f;
    if (F.tid < 256) { const int l = F.tid >> 2, h = F.tid & 3; for (int s = 0; s <= l; ++s) mycum += acs[s * 4 + h]; }
    __syncthreads();
    if (F.tid < 256) acs[F.tid] = mycum;
    __syncthreads();
    { const int ch8 = F.tid & 63, tg = F.tid >> 6, c0 = ch8 * 8;
      float wv[4][8], bv[8];
#pragma unroll
      for (int j = 0; j < 8; ++j) { bv[j] = F.in[I_MCONVB][layer * 512 + c0 + j];
#pragma unroll
          for (int k = 0; k < 4; ++k) wv[k][j] = F.in[I_MCONVW][(layer * 4 + k) * 512 + c0 + j]; }
      float win[3][8];
#pragma unroll
      for (int k = 0; k < 3; ++k) { const int l = l0 + tg * 8 - 3 + k;
          if (l >= 0) unpack8(*(const u32x4*)(U + ((size_t)b * SEQ + l) * NINP + UM + 256 + c0), win[k]);
          else {
#pragma unroll
              for (int j = 0; j < 8; ++j) win[k][j] = 0.f; } }
#pragma unroll 1
      for (int ib = 0; ib < 2; ++ib) { u32x4 rows[4];
#pragma unroll
          for (int i4 = 0; i4 < 4; ++i4) rows[i4] = *(const u32x4*)(U + (T0 + tg * 8 + ib * 4 + i4) * NINP + UM + 256 + c0);
#pragma unroll
      for (int i4 = 0; i4 < 4; ++i4) { const int l = tg * 8 + ib * 4 + i4; float cur[8]; unpack8(rows[i4], cur);
          float o[8];
#pragma unroll
          for (int j = 0; j < 8; ++j) { o[j] = siluf_(bv[j] + wv[0][j] * win[0][j] + wv[1][j] * win[1][j] + wv[2][j] * win[2][j] + wv[3][j] * cur[j]);
              win[0][j] = win[1][j]; win[1][j] = win[2][j]; win[2][j] = cur[j]; }
          if (c0 < 256) { const int h = c0 >> 6, p0 = c0 & 63; float sc = dts[l * 4 + h]; if (STAGE == 1) sc *= __expf(acs[63 * 4 + h] - acs[l * 4 + h]);
#pragma unroll
              for (int j = 0; j < 8; ++j) XT[(h * 64 + p0 + j) * 72 + l] = f2bf(o[j] * sc); }
          else if (c0 < 384) { const int g = (c0 - 256) >> 6, n0 = (c0 - 256) & 63;
              if (STAGE == 1) {
#pragma unroll
                  for (int j = 0; j < 8; ++j) BT[(g * 64 + n0 + j) * 72 + l] = f2bf(o[j]); }
              else { u32x4 w; w.x = pk2(o[0], o[1]); w.y = pk2(o[2], o[3]); w.z = pk2(o[4], o[5]); w.w = pk2(o[6], o[7]); *(LAS u32x4*)(Bg + (g * 64 + l) * 72 + n0) = w; } }
          else if (STAGE == 2) { const int g = (c0 - 384) >> 6, n0 = (c0 - 384) & 63;
              u32x4 w; w.x = pk2(o[0], o[1]); w.y = pk2(o[2], o[3]); w.z = pk2(o[4], o[5]); w.w = pk2(o[6], o[7]); *(LAS u32x4*)(Cg + (g * 64 + l) * 72 + n0) = w; } } } }
    __syncthreads();
    const int g4 = F.lane >> 4, r16 = F.lane & 15;
    if (STAGE == 1) {
        float* MST = (float*)(F.ws + WS_MST) + ((size_t)(b * 64 + c) * 4) * 4096;
#pragma unroll
        for (int q = 0; q < 8; ++q) { const int tix = F.wave * 8 + q, h = tix >> 4, mt = (tix >> 2) & 3, nt = tix & 3;
            f32x4 acc = (f32x4){0.f, 0.f, 0.f, 0.f};
            acc = mma_nt<64>(XT + (h * 64 + mt * 16) * 72, 72, BT + ((h >> 1) * 64 + nt * 16) * 72, 72, acc, F.lane);
#pragma unroll
            for (int i = 0; i < 4; ++i) MST[(size_t)h * 4096 + (mt * 16 + 4 * g4 + i) * 64 + nt * 16 + r16] = acc[i]; }
        if (F.tid < 4) ((float*)(F.ws + WS_MDEC))[(b * 64 + c) * 4 + F.tid] = __expf(acs[63 * 4 + F.tid]);
    } else {
        const int mt = F.wave & 3, nh = F.wave >> 2;
        const float* MST = (const float*)(F.ws + WS_MST) + ((size_t)(b * 64 + c) * 4) * 4096;
        f32x4 G[2], yv[4][2];
#pragma unroll
        for (int h = 0; h < 4; ++h) {
            const int g = h >> 1;
            { const float* src = MST + (size_t)h * 4096 + F.tid * 8; const f32x4 a = *(const f32x4*)src, bq = *(const f32x4*)(src + 4);
              u32x4 w; w.x = pk2(a[0], a[1]); w.y = pk2(a[2], a[3]); w.z = pk2(bq[0], bq[1]); w.w = pk2(bq[2], bq[3]);
              *(LAS u32x4*)(S0 + (F.tid >> 3) * 72 + (F.tid & 7) * 8) = w; }
            if ((h & 1) == 0) {
#pragma unroll
                for (int q = 0; q < 2; ++q) { G[q] = (f32x4){0.f, 0.f, 0.f, 0.f};
                    G[q] = mma_nt<64>(Cg + (g * 64 + mt * 16) * 72, 72, Bg + (g * 64 + (2 * nh + q) * 16) * 72, 72, G[q], F.lane); } }
#pragma unroll
            for (int q = 0; q < 2; ++q) { const int s = (2 * nh + q) * 16 + r16; const float as = acs[s * 4 + h];
#pragma unroll
                for (int i = 0; i < 4; ++i) { const int l = mt * 16 + 4 * g4 + i; const float v = (s <= l) ? G[q][i] * __expf(acs[l * 4 + h] - as) : 0.f;
                    Mb[l * 72 + s] = f2bf(v); } }
            __syncthreads();
#pragma unroll
            for (int q = 0; q < 2; ++q) { const int nt = 2 * nh + q;
                f32x4 yd = (f32x4){0.f, 0.f, 0.f, 0.f}, yo = (f32x4){0.f, 0.f, 0.f, 0.f};
                yd = mma_nt<64>(Mb + mt * 16 * 72, 72, XT + (h * 64 + nt * 16) * 72, 72, yd, F.lane);
                yo = mma_nt<64>(Cg + (g * 64 + mt * 16) * 72, 72, S0 + nt * 16 * 72, 72, yo, F.lane);
                const int p = nt * 16 + r16; const float dsk = F.in[I_MD][layer * 4 + h];
#pragma unroll
                for (int i = 0; i < 4; ++i) { const int l = mt * 16 + 4 * g4 + i;
                    const float xs = bf2f(XT[(h * 64 + p) * 72 + l]) / dts[l * 4 + h];
                    yv[h][q][i] = yd[i] + yo[i] * __expf(acs[l * 4 + h]) + dsk * xs; } }
            __syncthreads();
        }
        float part[4] = {0.f, 0.f, 0.f, 0.f};
#pragma unroll
        for (int h = 0; h < 4; ++h)
#pragma unroll
            for (int q = 0; q < 2; ++q) { const int ch = h * 64 + (2 * nh + q) * 16 + r16;
#pragma unroll
                for (int i = 0; i < 4; ++i) { const int l = mt * 16 + 4 * g4 + i; const float z = bf2f(U[(T0 + l) * NINP + UM + ch]);
                    const float v = yv[h][q][i] * siluf_(z); yv[h][q][i] = v; part[i] += v * v; } }
#pragma unroll
        for (int i = 0; i < 4; ++i) { const float s = sum16(part[i]); if (r16 == 0) atomicAdd((float*)(rs + mt * 16 + 4 * g4 + i), s); }
        __syncthreads();
        bf16_t* Y = (bf16_t*)(F.ws + WS_H);
#pragma unroll
        for (int i = 0; i < 4; ++i) { const int l = mt * 16 + 4 * g4 + i; const float rstd = rsqrtf(rs[l] * (1.0f / 256.0f) + 1e-6f);
#pragma unroll
            for (int h = 0; h < 4; ++h)
#pragma unroll
                for (int q = 0; q < 2; ++q) { const int ch = h * 64 + (2 * nh + q) * 16 + r16;
                    Y[(T0 + l) * DM + ch] = f2bf(yv[h][q][i] * rstd * F.in[I_MNORM][layer * 256 + ch]); } }
    }
}
__device__ __forceinline__ void item_mamba_carry(const Frame& F_, int item) { Frame F = relocal(F_);
    const int b = item >> 2, h = item & 3;
    float* MST = (float*)(F.ws + WS_MST); const float* MD = (const float*)(F.ws + WS_MDEC);
    float s[8];
#pragma unroll
    for (int j = 0; j < 8; ++j) s[j] = 0.f;
    for (int c = 0; c < 64; ++c) { float* p = MST + ((size_t)(b * 64 + c) * 4 + h) * 4096 + F.tid * 8; const float d = MD[(b * 64 + c) * 4 + h];
        const f32x4 a = *(f32x4*)p, q = *(f32x4*)(p + 4);
        *(f32x4*)p = (f32x4){s[0], s[1], s[2], s[3]}; *(f32x4*)(p + 4) = (f32x4){s[4], s[5], s[6], s[7]};
        s[0] = s[0] * d + a[0]; s[1] = s[1] * d + a[1]; s[2] = s[2] * d + a[2]; s[3] = s[3] * d + a[3];
        s[4] = s[4] * d + q[0]; s[5] = s[5] * d + q[1]; s[6] = s[6] * d + q[2]; s[7] = s[7] * d + q[3]; }
}

template <int STAGE> __device__ __forceinline__ void item_s5(const Frame& F_, int layer, int item) { Frame F = relocal(F_);
    const bf16_t* U = (const bf16_t*)(F.ws + WS_U);
    const int b = item >> 6, c = item & 63; const size_t T0 = (size_t)b * SEQ + c * 64;
    LAS bf16_t* us = (LAS bf16_t*)F.lds;
    LAS bf16_t* BuW = (LAS bf16_t*)(F.lds + 33792) + F.wave * 4224;
    const float* tab = (const float*)(F.ws + WS_S5TAB + (size_t)layer * S5TAB_L);
    { const int tok = F.tid >> 3, part = F.tid & 7;
#pragma unroll
      for (int q = 0; q < 4; ++q) *(LAS u32x4*)(us + tok * 264 + 32 * part + 8 * q) = *(const u32x4*)(U + (T0 + tok) * NINP + US + 32 * part + 8 * q); }
    const int lane = F.lane, r16 = lane & 15, g4 = lane >> 4, gq = lane >> 5, n0 = lane & 31, g = 2 * F.wave + gq, gn0 = g * 64 + n0, gn1 = gn0 + 32;
    bf16x8 bfr[2][8];
    { const bf16_t* bbt = (const bf16_t*)(F.ws + WS_S5TAB + (size_t)layer * S5TAB_L + S5TAB_BBT);
#pragma unroll
      for (int gg = 0; gg < 2; ++gg)
#pragma unroll
          for (int nt = 0; nt < 8; ++nt) { u32x4 z = (u32x4){0u, 0u, 0u, 0u}; if (g4 < 2) z = *(const u32x4*)(bbt + ((size_t)(2 * F.wave + gg) * 128 + 16 * nt + r16) * 16 + 8 * g4); bfr[gg][nt] = __builtin_bit_cast(bf16x8, z); } }
    const float a0r = tab[gn0 * 2], a0i = tab[gn0 * 2 + 1], a1r = tab[gn1 * 2], a1i = tab[gn1 * 2 + 1];
    float* ST = (float*)(F.ws + WS_S5ST) + (size_t)(b * 64 + c) * 2048;
    float h0r = 0.f, h0i = 0.f, h1r = 0.f, h1i = 0.f;
    if (STAGE == 2) { h0r = ST[gn0 * 2]; h0i = ST[gn0 * 2 + 1]; h1r = ST[gn1 * 2]; h1i = ST[gn1 * 2 + 1]; }
    bf16x8 cf[2][4];
    if (STAGE == 2) { const bf16_t* cm = (const bf16_t*)(F.ws + WS_S5TAB + (size_t)layer * S5TAB_L + S5TAB_F);
#pragma unroll
        for (int gg = 0; gg < 2; ++gg)
#pragma unroll
            for (int ks = 0; ks < 4; ++ks) cf[gg][ks] = *(const bf16x8*)(cm + ((size_t)((2 * F.wave + gg) * 16 + r16)) * 128 + 32 * ks + 8 * g4); }
    __syncthreads();
#pragma unroll 1
    for (int lb = 0; lb < 4; ++lb) {
#pragma unroll
        for (int gg = 0; gg < 2; ++gg) { u32x4 z = (u32x4){0u, 0u, 0u, 0u}; if (g4 < 2) z = *(const LAS u32x4*)(us + (16 * lb + r16) * 264 + (2 * F.wave + gg) * 16 + 8 * g4);
            const bf16x8 afr = __builtin_bit_cast(bf16x8, z);
#pragma unroll
            for (int nt = 0; nt < 8; ++nt) { const f32x4 acc = __builtin_amdgcn_mfma_f32_16x16x32_bf16(afr, bfr[gg][nt], (f32x4){0.f, 0.f, 0.f, 0.f}, 0, 0, 0);
#pragma unroll
                for (int i = 0; i < 4; ++i) BuW[(4 * g4 + i) * 264 + gg * 128 + 16 * nt + r16] = f2bf(acc[i]); } }
        __syncthreads();
#pragma unroll 4
        for (int li = 0; li < 16; ++li) { LAS u32x2* bp = (LAS u32x2*)(BuW + li * 264 + gq * 128 + 4 * n0); const u32x2 v = *bp;
            { const float br = __uint_as_float(v.x << 16), bi = __uint_as_float(v.x & 0xffff0000u); const float nr = a0r * h0r - a0i * h0i + br, ni = a0r * h0i + a0i * h0r + bi; h0r = nr; h0i = ni; }
            { const float br = __uint_as_float(v.y << 16), bi = __uint_as_float(v.y & 0xffff0000u); const float nr = a1r * h1r - a1i * h1i + br, ni = a1r * h1i + a1i * h1r + bi; h1r = nr; h1i = ni; }
            if (STAGE == 2) *bp = (u32x2){pk2(h0r, h0i), pk2(h1r, h1i)}; }
        __syncthreads();
        if (STAGE == 2) {
            bf16_t* YS = (bf16_t*)(F.ws + WS_MOE + YSG_OFF);
#pragma unroll
            for (int gg = 0; gg < 2; ++gg) { f32x4 acc = (f32x4){0.f, 0.f, 0.f, 0.f};
#pragma unroll
                for (int ks = 0; ks < 4; ++ks) { const bf16x8 a = *(const LAS bf16x8*)(BuW + r16 * 264 + gg * 128 + 32 * ks + 8 * g4);
                    acc = __builtin_amdgcn_mfma_f32_16x16x32_bf16(a, cf[gg][ks], acc, 0, 0, 0); }
                const int ch = (2 * F.wave + gg) * 16 + r16; const float dsk = F.in[I_SD][layer * 256 + ch];
#pragma unroll
                for (int i = 0; i < 4; ++i) { const int l = lb * 16 + 4 * g4 + i; const float y = acc[i] + dsk * bf2f(us[l * 264 + ch]);
                    YS[(T0 + l) * 256 + ch] = f2bf(gelu_tanh(y)); } }
            __syncthreads();
        }
    }
    if (STAGE == 1) { ST[gn0 * 2] = h0r; ST[gn0 * 2 + 1] = h0i; ST[gn1 * 2] = h1r; ST[gn1 * 2 + 1] = h1i; }
    if (STAGE == 2) {
        asm volatile("s_waitcnt vmcnt(0)" ::: "memory"); __syncthreads();
        const bf16_t* YS = (const bf16_t*)(F.ws + WS_MOE + YSG_OFF) + T0 * 256; const bf16_t* GW = (const bf16_t*)(F.ws + WS_GLU) + (size_t)layer * 512 * 256;
        const int r16 = F.lane & 15, g4 = F.lane >> 4;
        f32x4 av[4][2], ag[4][2];
#pragma unroll
        for (int m = 0; m < 4; ++m)
#pragma unroll
            for (int q = 0; q < 2; ++q) { av[m][q] = (f32x4){0.f, 0.f, 0.f, 0.f}; ag[m][q] = (f32x4){0.f, 0.f, 0.f, 0.f}; }
#pragma unroll 2
        for (int ks = 0; ks < 8; ++ks) {
            bf16x8 af[4], bv[2], bg[2];
#pragma unroll
            for (int m = 0; m < 4; ++m) af[m] = *(const bf16x8*)(YS + (size_t)(16 * m + r16) * 256 + 32 * ks + 8 * g4);
#pragma unroll
            for (int q = 0; q < 2; ++q) { const int c = 32 * F.wave + 16 * q + r16; const int rowv = 256 * (c >> 7) + (c & 127);
                bv[q] = *(const bf16x8*)(GW + (size_t)rowv * 256 + 32 * ks + 8 * g4); bg[q] = *(const bf16x8*)(GW + (size_t)(rowv + 128) * 256 + 32 * ks + 8 * g4); }
#pragma unroll
            for (int m = 0; m < 4; ++m)
#pragma unroll
                for (int q = 0; q < 2; ++q) { av[m][q] = __builtin_amdgcn_mfma_f32_16x16x32_bf16(af[m], bv[q], av[m][q], 0, 0, 0); ag[m][q] = __builtin_amdgcn_mfma_f32_16x16x32_bf16(af[m], bg[q], ag[m][q], 0, 0, 0); }
        }
        bf16_t* Y = (bf16_t*)(F.ws + WS_H);
#pragma unroll
        for (int q = 0; q < 2; ++q) { const int c = 32 * F.wave + 16 * q + r16; const float bvl = F.in[I_SGLUB][layer * 512 + c], bgt = F.in[I_SGLUB][layer * 512 + 256 + c];
#pragma unroll
            for (int m = 0; m < 4; ++m)
#pragma unroll
                for (int i = 0; i < 4; ++i) Y[(T0 + 16 * m + 4 * g4 + i) * DM + 768 + c] = f2bf((av[m][q][i] + bvl) * sigmoidf_(ag[m][q][i] + bgt)); }
    }
}
__device__ __forceinline__ void item_s5_carry(const Frame& F_, int layer, int b) { Frame F = relocal(F_);
    const float* tab = (const float*)(F.ws + WS_S5TAB + (size_t)layer * S5TAB_L) + 2048;
    float* ST = (float*)(F.ws + WS_S5ST) + (size_t)b * 64 * 2048;
#pragma unroll
    for (int q = 0; q < 2; ++q) { const int gn = F.tid + 512 * q; const float pr = tab[gn * 2], pi = tab[gn * 2 + 1]; float hr = 0.f, hi = 0.f;
        for (int c = 0; c < 64; ++c) { float* p = ST + (size_t)c * 2048 + gn * 2; const float tr = p[0], ti = p[1]; p[0] = hr; p[1] = hi;
            const float nr = pr * hr - pi * hi + tr, ni = pr * hi + pi * hr + ti; hr = nr; hi = ni; } }
}

constexpr int RB_LD = 72;
constexpr int RW_R = 0, RW_K = 16384, RW_V = 32768, RW_W = 49152, RW_A = 65536, RW_B = 81920;
constexpr int R3_G = 49152, R3_O = 65536, R3_TILES = 81920, R3_BON = 147456;
template <int STAGE> __device__ __forceinline__ void rwkv_prep(const Frame& F_, int layer, int b, int h, int c) { Frame F = relocal(F_);
    const bf16_t* U = (const bf16_t*)(F.ws + WS_U);
    const int l0 = c * 64; const size_t T0 = (size_t)b * SEQ + l0;
    LAS float* Rr = (LAS float*)(F.lds + RW_R); LAS float* Kk = (LAS float*)(F.lds + RW_K); LAS float* Vv = (LAS float*)(F.lds + RW_V); LAS float* Ww = (LAS float*)(F.lds + RW_W);
    LAS float* Aa = (LAS float*)(F.lds + (STAGE == 1 ? RW_A : R3_O)); LAS float* Bb = (LAS float*)(F.lds + RW_B); LAS float* Gg = (LAS float*)(F.lds + R3_G); LAS float* BON = (LAS float*)(F.lds + R3_BON);
    LAS bf16_t* TWb = (LAS bf16_t*)(F.lds + 98304); LAS bf16_t* DAb = (LAS bf16_t*)(F.lds + (STAGE == 1 ? 103424 : 118784)); LAS bf16_t* SGb = (LAS bf16_t*)(F.lds + 123904);
    LAS bf16_t* w2T = (LAS bf16_t*)(F.lds + 108544); LAS bf16_t* a2T = (LAS bf16_t*)(F.lds + (STAGE == 1 ? 113664 : 133120)); LAS bf16_t* g2T = (LAS bf16_t*)(F.lds + 138240);
    const float* mu = F.in[I_RMU] + layer * 896;
    { const int tok = F.tid >> 3, p8 = F.tid & 7; const bool first = (l0 + tok == 0);
      const bf16_t* cur = U + (T0 + tok) * NINP + UR; const bf16_t* prv = first ? cur : cur - NINP;
      const float pz = first ? 0.f : 1.f;
      u32x4 cw[3], pw[3]; u32x2 c1 = (u32x2){0u, 0u}, p1 = (u32x2){0u, 0u}, c2 = (u32x2){0u, 0u}, p2 = (u32x2){0u, 0u}; u32x4 c3 = (u32x4){0u, 0u, 0u, 0u}, p3 = (u32x4){0u, 0u, 0u, 0u};
#pragma unroll
      for (int sec = (STAGE == 1 ? 0 : 2); sec < 3; ++sec) { const int co = sec * 256 + h * 64 + 8 * p8; cw[sec] = *(const u32x4*)(cur + co); pw[sec] = *(const u32x4*)(prv + co); }
      if (STAGE == 1) { c1 = *(const u32x2*)(cur + 768 + 4 * p8); p1 = *(const u32x2*)(prv + 768 + 4 * p8); c2 = *(const u32x2*)(cur + 800 + 4 * p8); p2 = *(const u32x2*)(prv + 800 + 4 * p8); }
      if (STAGE == 3) { c3 = *(const u32x4*)(cur + 832 + 8 * p8); p3 = *(const u32x4*)(prv + 832 + 8 * p8); }
#pragma unroll
      for (int sec = (STAGE == 1 ? 0 : 2); sec < 3; ++sec) { const int co = sec * 256 + h * 64 + 8 * p8; float av[8], pq[8]; unpack8(cw[sec], av); unpack8(pw[sec], pq);
          const f32x4 m0 = *(const f32x4*)(mu + co), m1 = *(const f32x4*)(mu + co + 4);
          LAS float* dst = (sec == 0 ? Rr : sec == 1 ? Kk : Vv) + tok * 64 + 8 * p8;
#pragma unroll
          for (int j = 0; j < 8; ++j) pq[j] *= pz;
          *(LAS f32x4*)dst = (f32x4){av[0] + m0[0] * (pq[0] - av[0]), av[1] + m0[1] * (pq[1] - av[1]), av[2] + m0[2] * (pq[2] - av[2]), av[3] + m0[3] * (pq[3] - av[3])};
          *(LAS f32x4*)(dst + 4) = (f32x4){av[4] + m1[0] * (pq[4] - av[4]), av[5] + m1[1] * (pq[5] - av[5]), av[6] + m1[2] * (pq[6] - av[6]), av[7] + m1[3] * (pq[7] - av[7])}; }
      if (STAGE == 1) {
#pragma unroll
        for (int which = 0; which < 2; ++which) { const int co = 768 + 32 * which + 4 * p8; const u32x2 cv = which ? c2 : c1, pv = which ? p2 : p1;
          const f32x4 m0 = *(const f32x4*)(mu + co);
          float x[4] = {__uint_as_float(cv.x << 16), __uint_as_float(cv.x & 0xffff0000u), __uint_as_float(cv.y << 16), __uint_as_float(cv.y & 0xffff0000u)};
          const float y[4] = {pz * __uint_as_float(pv.x << 16), pz * __uint_as_float(pv.x & 0xffff0000u), pz * __uint_as_float(pv.y << 16), pz * __uint_as_float(pv.y & 0xffff0000u)};
#pragma unroll
          for (int j = 0; j < 4; ++j) { x[j] = x[j] + m0[j] * (y[j] - x[j]); if (which == 0) x[j] = tanhf_(x[j]); }
          *(LAS u32x2*)((which ? DAb : TWb) + tok * 40 + 4 * p8) = (u32x2){pk2(x[0], x[1]), pk2(x[2], x[3])}; } }
      if (STAGE == 3) { const int co = 832 + 8 * p8; float av[8], pq[8]; unpack8(c3, av); unpack8(p3, pq);
          const f32x4 m0 = *(const f32x4*)(mu + co), m1 = *(const f32x4*)(mu + co + 4); float x[8];
#pragma unroll
          for (int j = 0; j < 8; ++j) x[j] = sigmoidf_(av[j] + (j < 4 ? m0[j] : m1[j - 4]) * (pz * pq[j] - av[j]));
          *(LAS u32x4*)(SGb + tok * RB_LD + 8 * p8) = (u32x4){pk2(x[0], x[1]), pk2(x[2], x[3]), pk2(x[4], x[5]), pk2(x[6], x[7])}; } }
    { const int ch = F.tid & 63, part = F.tid >> 6;
      if (STAGE == 1) { const float* w2 = F.in[I_RW2] + ((size_t)layer * 32 + 4 * part) * 256 + h * 64 + ch;
          *(LAS u32x2*)(w2T + ch * 40 + 4 * part) = (u32x2){pk2(w2[0], w2[256]), pk2(w2[512], w2[768])}; }
      if (STAGE == 1) { const float* a2 = F.in[I_RA2] + ((size_t)layer * 32 + 4 * part) * 256 + h * 64 + ch;
          *(LAS u32x2*)(a2T + ch * 40 + 4 * part) = (u32x2){pk2(a2[0], a2[256]), pk2(a2[512], a2[768])}; }
      if (STAGE == 3) { const float* g2 = F.in[I_RG2] + ((size_t)layer * 64 + 8 * part) * 256 + h * 64 + ch;
          *(LAS u32x4*)(g2T + ch * RB_LD + 8 * part) = (u32x4){pk2(g2[0], g2[256]), pk2(g2[512], g2[768]), pk2(g2[1024], g2[1280]), pk2(g2[1536], g2[1792])}; } }
    __syncthreads();
    { const int lane = F.lane, mt = F.wave >> 1, nt0 = 2 * (F.wave & 1), r = lane & 15, g4 = lane >> 4; const f32x4 zero4 = (f32x4){0.f, 0.f, 0.f, 0.f};
#pragma unroll
      for (int q = 0; q < 2; ++q) { const int nt = nt0 + q, ch = 16 * nt + r, cg = layer * 256 + h * 64 + ch;
          if (STAGE == 1) { const f32x4 wl = mma_nt<32>(TWb + 16 * mt * 40, 40, w2T + 16 * nt * 40, 40, zero4, lane); const float w0 = F.in[I_RW0][cg];
#pragma unroll
              for (int i = 0; i < 4; ++i) { const float x = w0 + wl[i]; const float wlog = -__logf(1.0f + __expf(-x)) - 0.5f; Ww[(16 * mt + 4 * g4 + i) * 64 + ch] = __expf(-__expf(wlog)); } }
          if (STAGE == 1) { const f32x4 al = mma_nt<32>(DAb + 16 * mt * 40, 40, a2T + 16 * nt * 40, 40, zero4, lane); const float a0 = F.in[I_RA0][cg];
#pragma unroll
              for (int i = 0; i < 4; ++i) Aa[(16 * mt + 4 * g4 + i) * 64 + ch] = sigmoidf_(a0 + al[i]); }
          if (STAGE == 3) { const f32x4 gv = mma_nt<64>(SGb + 16 * mt * RB_LD, RB_LD, g2T + 16 * nt * RB_LD, RB_LD, zero4, lane);
#pragma unroll
              for (int i = 0; i < 4; ++i) Gg[(16 * mt + 4 * g4 + i) * 64 + ch] = gv[i]; } } }
    __syncthreads();
    float* gBON = (float*)(F.ws + WS_BON) + ((size_t)(b * 4 + h) * 64 + c) * 64;
    if (STAGE == 1) { const int j = F.lane, tq = F.wave, cg = layer * 256 + h * 64 + j;
      const float kkw = F.in[I_RKK][cg], kaw = F.in[I_RKA][cg], rk = F.in[I_RRK][cg];
#pragma unroll 2
      for (int i8 = 0; i8 < 8; ++i8) { const int t = tq + 8 * i8;
          const float a = Aa[t * 64 + j]; const float kraw = Kk[t * 64 + j]; const float kp = kraw * (1.0f + (a - 1.0f) * kaw);
          Kk[t * 64 + j] = kp;
          const float kkv = kraw * kkw; const float ss = wave_sum(kkv * kkv); const float kkn = kkv * rsqrtf(fmaxf(ss, 1e-24f)); Aa[t * 64 + j] = -kkn; Bb[t * 64 + j] = kkn * a;
          const float bo = wave_sum(Rr[t * 64 + j] * kp * rk); if (j == 0) gBON[t] = bo; } }
    else if (F.tid < 64) BON[F.tid] = gBON[F.tid];
    __syncthreads();
}
constexpr int RB_AT = 98304, RB_ATT = RB_AT + 9216, RB_BT = RB_ATT + 9216, RB_BTT = RB_BT + 9216, RB_KT = RB_BTT + 9216, RB_RT = RB_KT + 9216, RB_VT = RB_RT + 9216, RB_GC = RB_VT + 9216;
constexpr int RX_X = 0, RX_XT = 9216, RX_TB = 18432, RX_M = 27648, RX_NRT = 36864, RX_G1T = 46080, RX_G2T = 55296, RX_QT = 64512;
__device__ __forceinline__ void st_tile(LAS bf16_t* dst, int mt, int nt, const f32x4 v, int lane) {
    const int r = lane & 15, g = lane >> 4;
#pragma unroll
    for (int i = 0; i < 4; ++i) dst[(16 * mt + 4 * g + i) * RB_LD + 16 * nt + r] = f2bf(v[i]);
}
__device__ __forceinline__ void st_tile_t(LAS bf16_t* dst, int mt, int nt, const f32x4 v, int lane) {
    const int r = lane & 15, g = lane >> 4; u32x2 w; w.x = pk2(v[0], v[1]); w.y = pk2(v[2], v[3]);
    *(LAS u32x2*)(dst + (16 * nt + r) * RB_LD + 16 * mt + 4 * g) = w;
}
__device__ __forceinline__ void item_rwkv1(const Frame& F_, int layer, int item) { Frame F = relocal(F_);
    const int b = item >> 8, h = (item >> 6) & 3, c = item & 63;
    rwkv_prep<1>(F, layer, b, h, c);
    LAS float* Rr = (LAS float*)(F.lds + RW_R); LAS float* Kk = (LAS float*)(F.lds + RW_K); LAS float* Vv = (LAS float*)(F.lds + RW_V); LAS float* Ww = (LAS float*)(F.lds + RW_W);
    LAS float* Aa = (LAS float*)(F.lds + RW_A); LAS float* Bb = (LAS float*)(F.lds + RW_B);
    LAS bf16_t* At = (LAS bf16_t*)(F.lds + RB_AT); LAS bf16_t* AtT = (LAS bf16_t*)(F.lds + RB_ATT); LAS bf16_t* Bt = (LAS bf16_t*)(F.lds + RB_BT); LAS bf16_t* BtT = (LAS bf16_t*)(F.lds + RB_BTT);
    LAS bf16_t* Kt = (LAS bf16_t*)(F.lds + RB_KT); LAS bf16_t* Rt = (LAS bf16_t*)(F.lds + RB_RT); LAS bf16_t* VT = (LAS bf16_t*)(F.lds + RB_VT); LAS float* gC = (LAS float*)(F.lds + RB_GC);
    LAS bf16_t* X = (LAS bf16_t*)(F.lds + RX_X); LAS bf16_t* XT = (LAS bf16_t*)(F.lds + RX_XT); LAS bf16_t* Tb = (LAS bf16_t*)(F.lds + RX_TB); LAS bf16_t* Mm = (LAS bf16_t*)(F.lds + RX_M);
    LAS bf16_t* NrT = (LAS bf16_t*)(F.lds + RX_NRT); LAS bf16_t* G1T = (LAS bf16_t*)(F.lds + RX_G1T); LAS bf16_t* G2T = (LAS bf16_t*)(F.lds + RX_G2T); LAS bf16_t* QT = (LAS bf16_t*)(F.lds + RX_QT);
    { const int k = F.tid & 63, part = F.tid >> 6; float g = 1.0f;
      for (int pp = 0; pp < part; ++pp) { float w8[8];
#pragma unroll
          for (int i = 0; i < 8; ++i) w8[i] = Ww[(8 * pp + i) * 64 + k];
          g *= ((w8[0] * w8[1]) * (w8[2] * w8[3])) * ((w8[4] * w8[5]) * (w8[6] * w8[7])); }
#pragma unroll
      for (int i = 0; i < 8; ++i) { const int t = 8 * part + i; const float gp = g; g *= Ww[t * 64 + k]; const float ig = 1.0f / g;
          const bf16_t av = f2bf(Aa[t * 64 + k] * gp), bv = f2bf(Bb[t * 64 + k] * ig);
          At[t * RB_LD + k] = av; AtT[k * RB_LD + t] = av; Bt[t * RB_LD + k] = bv; BtT[k * RB_LD + t] = bv;
          Kt[t * RB_LD + k] = f2bf(Kk[t * 64 + k] * ig); Rt[t * RB_LD + k] = f2bf(Rr[t * 64 + k] * g); VT[k * RB_LD + t] = f2bf(Vv[t * 64 + k]); }
      if (part == 7) gC[k] = g; }
    __syncthreads();
    const int lane = F.lane, mt = F.wave >> 1, nt0 = 2 * (F.wave & 1), r = lane & 15, g4 = lane >> 4;
    const f32x4 zero4 = (f32x4){0.f, 0.f, 0.f, 0.f};
    f32x4 Tacc[2];
#pragma unroll
    for (int q = 0; q < 2; ++q) { const int nt = nt0 + q;
        f32x4 n = mma_nt<64>(Bt + 16 * mt * RB_LD, RB_LD, At + 16 * nt * RB_LD, RB_LD, zero4, lane);
        f32x4 m = mma_nt<64>(Kt + 16 * mt * RB_LD, RB_LD, At + 16 * nt * RB_LD, RB_LD, zero4, lane);
        f32x4 nr = mma_nt<64>(Rt + 16 * mt * RB_LD, RB_LD, Bt + 16 * nt * RB_LD, RB_LD, zero4, lane);
#pragma unroll
        for (int i = 0; i < 4; ++i) { const int row = 16 * mt + 4 * g4 + i, col = 16 * nt + r;
            n[i] = (row < col) ? n[i] : 0.f; m[i] = (row < col) ? m[i] : 0.f; nr[i] = (col <= row) ? nr[i] : 0.f;
            Tacc[q][i] = n[i] + (row == col ? 1.0f : 0.f); }
        st_tile(X, mt, nt, n, lane); st_tile_t(XT, mt, nt, n, lane); st_tile(Tb, mt, nt, Tacc[q], lane); st_tile(Mm, mt, nt, m, lane); st_tile(NrT, mt, nt, nr, lane); }
    __syncthreads();
#pragma unroll 1
    for (int it = 0; it < 6; ++it) {
        LAS bf16_t* Xr = (it & 1) ? G1T : X; LAS bf16_t* XTr = (it & 1) ? G2T : XT; LAS bf16_t* Tr = (it & 1) ? QT : Tb;
        LAS bf16_t* Xw = (it & 1) ? X : G1T; LAS bf16_t* XTw = (it & 1) ? XT : G2T; LAS bf16_t* Tw = (it & 1) ? Tb : QT;
#pragma unroll
        for (int q = 0; q < 2; ++q) { const int nt = nt0 + q;
            if (it > 0) Tacc[q] = mma_nt<64>(Tr + 16 * mt * RB_LD, RB_LD, XTr + 16 * nt * RB_LD, RB_LD, Tacc[q], lane);
            if (it < 5) { const f32x4 x2 = mma_nt<64>(Xr + 16 * mt * RB_LD, RB_LD, XTr + 16 * nt * RB_LD, RB_LD, zero4, lane); st_tile(Xw, mt, nt, x2, lane); st_tile_t(XTw, mt, nt, x2, lane); }
            st_tile(Tw, mt, nt, Tacc[q], lane); }
        __syncthreads();
    }
#pragma unroll
    for (int q = 0; q < 2; ++q) { const int nt = nt0 + q;
        st_tile(G1T, mt, nt, mma_nt<64>(NrT + 16 * mt * RB_LD, RB_LD, Tb + 16 * nt * RB_LD, RB_LD, zero4, lane), lane);
        st_tile(G2T, mt, nt, mma_nt<64>(BtT + 16 * mt * RB_LD, RB_LD, Tb + 16 * nt * RB_LD, RB_LD, zero4, lane), lane); }
    __syncthreads();
    const size_t ci = (size_t)(b * 4 + h) * 64 + c;
    bf16_t* gPT = (bf16_t*)(F.ws + WS_MOE + RW_PT) + ci * 4096; bf16_t* gW1 = (bf16_t*)(F.ws + WS_MOE + RW_W1) + ci * 4096; bf16_t* gZ = (bf16_t*)(F.ws + WS_MOE + RW_Z) + ci * 4096;
#pragma unroll
    for (int q = 0; q < 2; ++q) { const int nt = nt0 + q; const int col = 16 * nt + r;
        f32x4 w1 = mma_nt<64>(G1T + 16 * mt * RB_LD, RB_LD, AtT + 16 * nt * RB_LD, RB_LD, zero4, lane);
        f32x4 z = mma_nt<64>(G1T + 16 * mt * RB_LD, RB_LD, Mm + 16 * nt * RB_LD, RB_LD, zero4, lane);
        f32x4 mr = mma_nt<64>(Rt + 16 * mt * RB_LD, RB_LD, Kt + 16 * nt * RB_LD, RB_LD, zero4, lane);
        f32x4 p = mma_nt<64>(G2T + 16 * mt * RB_LD, RB_LD, AtT + 16 * nt * RB_LD, RB_LD, zero4, lane);
        f32x4 qq = mma_nt<64>(G2T + 16 * mt * RB_LD, RB_LD, Mm + 16 * nt * RB_LD, RB_LD, zero4, lane);
        const int pos = 32 * (col >> 5) + 8 * ((col >> 2) & 3) + 4 * ((col >> 4) & 1) + (col & 3);
#pragma unroll
        for (int i = 0; i < 4; ++i) { const int row = 16 * mt + 4 * g4 + i;
            gW1[row * 64 + col] = f2bf(w1[i] + bf2f(Rt[row * RB_LD + col]));
            gZ[row * 64 + col] = f2bf(z[i] + (col <= row ? mr[i] : 0.f));
            const float gc = gC[row];
            gPT[row * 64 + pos] = f2bf((p[i] + (row == col ? 1.0f : 0.f)) * gc);
            qq[i] = (qq[i] + bf2f(Kt[col * RB_LD + row])) * gc; }
        st_tile(QT, mt, nt, qq, lane); }
    __syncthreads();
    bf16_t* gU = (bf16_t*)(F.ws + WS_MOE + RW_U) + ci * 4096;
#pragma unroll
    for (int q = 0; q < 2; ++q) { const int nt = nt0 + q;
        const f32x4 u = mma_nt<64>(VT + 16 * mt * RB_LD, RB_LD, QT + 16 * nt * RB_LD, RB_LD, zero4, lane);
#pragma unroll
        for (int i = 0; i < 4; ++i) gU[(16 * mt + 4 * g4 + i) * 64 + 16 * nt + r] = f2bf(u[i]); }
}
__device__ __forceinline__ void item_rwkv_carry(const Frame& F_, int item) { Frame F = relocal(F_);
    const int bh = item * 2 + (F.wave >> 2), nt = F.wave & 3, r = F.lane & 15, g = F.lane >> 4;
    const bf16_t* PT = (const bf16_t*)(F.ws + WS_MOE + RW_PT); const bf16_t* Uc = (const bf16_t*)(F.ws + WS_MOE + RW_U); bf16_t* Ss = (bf16_t*)(F.ws + WS_MOE + RW_S);
    f32x4 acc[4];
#pragma unroll
    for (int m = 0; m < 4; ++m) acc[m] = (f32x4){0.f, 0.f, 0.f, 0.f};
    for (int c = 0; c < 64; ++c) { const size_t ci = (size_t)bh * 64 + c;
        bf16x8 af[4][2]; f32x4 cin[4];
#pragma unroll
        for (int m = 0; m < 4; ++m) { const u32x2 uv = *(const u32x2*)(Uc + ci * 4096 + (16 * nt + r) * 64 + 16 * m + 4 * g);
            cin[m] = (f32x4){__uint_as_float(uv.x << 16), __uint_as_float(uv.x & 0xffff0000u), __uint_as_float(uv.y << 16), __uint_as_float(uv.y & 0xffff0000u)};
#pragma unroll
            for (int s = 0; s < 2; ++s) af[m][s] = *(const bf16x8*)(PT + ci * 4096 + (16 * m + r) * 64 + 32 * s + 8 * g); }
        unsigned pw[4][2];
#pragma unroll
        for (int m = 0; m < 4; ++m) { pw[m][0] = pk2(acc[m][0], acc[m][1]); pw[m][1] = pk2(acc[m][2], acc[m][3]);
            *(u32x2*)(Ss + ci * 4096 + (16 * nt + r) * 64 + 16 * m + 4 * g) = (u32x2){pw[m][0], pw[m][1]}; }
        bf16x8 bfr[2];
#pragma unroll
        for (int s = 0; s < 2; ++s) bfr[s] = __builtin_bit_cast(bf16x8, (u32x4){pw[2 * s][0], pw[2 * s][1], pw[2 * s + 1][0], pw[2 * s + 1][1]});
#pragma unroll
        for (int m = 0; m < 4; ++m) { acc[m] = __builtin_amdgcn_mfma_f32_16x16x32_bf16(af[m][0], bfr[0], cin[m], 0, 0, 0);
            acc[m] = __builtin_amdgcn_mfma_f32_16x16x32_bf16(af[m][1], bfr[1], acc[m], 0, 0, 0); }
    }
}
__device__ __forceinline__ void item_rwkv3(const Frame& F_, int layer, int item) { Frame F = relocal(F_);
    const int b = item >> 8, h = (item >> 6) & 3, c = item & 63; const size_t T0 = (size_t)b * SEQ + c * 64;
    rwkv_prep<3>(F, layer, b, h, c);
    LAS float* Vv = (LAS float*)(F.lds + RW_V); LAS float* Oo = (LAS float*)(F.lds + R3_O);
    LAS float* Gg = (LAS float*)(F.lds + R3_G); LAS float* BON = (LAS float*)(F.lds + R3_BON);
    LAS bf16_t* S0b = (LAS bf16_t*)(F.lds + R3_TILES); LAS bf16_t* W1b = S0b + 4608; LAS bf16_t* Zb = W1b + 4608; LAS bf16_t* VTb = Zb + 4608;
    { const size_t ci = (size_t)(b * 4 + h) * 64 + c; const int row = F.tid >> 3, col = (F.tid & 7) * 8;
      *(LAS u32x4*)(S0b + row * RB_LD + col) = *(const u32x4*)((const bf16_t*)(F.ws + WS_MOE + RW_S) + ci * 4096 + F.tid * 8);
      *(LAS u32x4*)(W1b + row * RB_LD + col) = *(const u32x4*)((const bf16_t*)(F.ws + WS_MOE + RW_W1) + ci * 4096 + F.tid * 8);
      *(LAS u32x4*)(Zb + row * RB_LD + col) = *(const u32x4*)((const bf16_t*)(F.ws + WS_MOE + RW_Z) + ci * 4096 + F.tid * 8);
      const int vv = F.tid & 63, part = F.tid >> 6;
#pragma unroll
      for (int i = 0; i < 8; ++i) { const int t = 8 * part + i; VTb[vv * RB_LD + t] = f2bf(Vv[t * 64 + vv]); } }
    __syncthreads();
    { const int lane = F.lane, mt = F.wave >> 1, nt0 = 2 * (F.wave & 1), r = lane & 15, g4 = lane >> 4;
#pragma unroll
      for (int q = 0; q < 2; ++q) { const int nt = nt0 + q;
          f32x4 o = mma_nt<64>(W1b + 16 * mt * RB_LD, RB_LD, S0b + 16 * nt * RB_LD, RB_LD, (f32x4){0.f, 0.f, 0.f, 0.f}, lane);
          o = mma_nt<64>(Zb + 16 * mt * RB_LD, RB_LD, VTb + 16 * nt * RB_LD, RB_LD, o, lane);
#pragma unroll
          for (int i = 0; i < 4; ++i) Oo[(16 * mt + 4 * g4 + i) * 64 + 16 * nt + r] = o[i]; } }
    __syncthreads();
    { const int j = F.lane, tq = F.wave, ch = h * 64 + j;
      const float lw = F.in[I_RLNW][layer * 256 + ch], lb = F.in[I_RLNB][layer * 256 + ch];
      bf16_t* Y = (bf16_t*)(F.ws + WS_H);
#pragma unroll 2
      for (int i8 = 0; i8 < 8; ++i8) { const int t = tq + 8 * i8;
          const float o = Oo[t * 64 + j]; const float mean = wave_sum(o) * (1.0f / 64.0f); const float d = o - mean; const float var = wave_sum(d * d) * (1.0f / 64.0f);
          float on = d * rsqrtf(var + 64e-5f) * lw + lb; on += BON[t] * Vv[t * 64 + j];
          Y[(T0 + t) * DM + 256 + ch] = f2bf(on * Gg[t * 64 + j]); } }
}

constexpr int DS_SEL = 131072, DS_HIST = 135168, DS_BKT = 151552, DS_BIAS = 152064;
__device__ __forceinline__ void dsa_tables(const Frame& F_) { Frame F = relocal(F_);
    LAS int* bkt = (LAS int*)(F.lds + DS_BKT); LAS float* biasT = (LAS float*)(F.lds + DS_BIAS);
    if (F.tid < 128) { const int n = F.tid; int bk = n; if (n >= 16) { const float lr = logf((float)n / 16.0f) / 2.0794415416798357f; bk = 16 + (int)(lr * 16.0f); bk = bk < 31 ? bk : 31; } bkt[n] = bk; biasT[n] = F.in[I_RELB][n]; }
    __syncthreads();
}
__device__ __forceinline__ unsigned fkey(float f) { const unsigned u = __float_as_uint(f); return (u & 0x80000000u) ? ~u : (u | 0x80000000u); }
__device__ __forceinline__ void item_dsa(const Frame& F_, int layer, int item) { Frame F = relocal(F_);
    const bf16_t* U = (const bf16_t*)(F.ws + WS_U); const bf16_t* KI = (const bf16_t*)(F.ws + WS_KIDX);
    const bf16_t* Kb = (const bf16_t*)(F.ws + WS_K); const bf16_t* Vb = (const bf16_t*)(F.ws + WS_V);
    const int b = item & 3, qg = 511 - (item >> 2); const size_t TB = (size_t)b * SEQ, T0 = TB + qg * 8;
    LAS float* sc = (LAS float*)F.lds; LAS unsigned short* selall = (LAS unsigned short*)(F.lds + DS_SEL); LAS unsigned* histall = (LAS unsigned*)(F.lds + DS_HIST);
    LAS int* bkt = (LAS int*)(F.lds + DS_BKT); LAS float* biasT = (LAS float*)(F.lds + DS_BIAS);
    const int lane = F.lane, hh = lane >> 5;
    {
        bf16x8 af[2][2]; float wq[2][2][8];
        { const int r = lane & 31, q4 = 2 * ((r >> 2) & 1) + (r >> 4), head = 4 * ((r >> 3) & 1) + (r & 3);
#pragma unroll
          for (int mt = 0; mt < 2; ++mt)
#pragma unroll
              for (int ks = 0; ks < 2; ++ks) af[mt][ks] = *(const bf16x8*)(U + (T0 + 4 * mt + q4) * NINP + UC + 384 + head * 32 + 16 * ks + 8 * hh); }
#pragma unroll
        for (int mt = 0; mt < 2; ++mt)
#pragma unroll
            for (int q2 = 0; q2 < 2; ++q2) { float f[8]; unpack8(*(const u32x4*)(U + (T0 + 4 * mt + 2 * hh + q2) * NINP + UC + 672), f);
#pragma unroll
                for (int hd = 0; hd < 8; ++hd) wq[mt][q2][hd] = f[hd]; }
        const int ntile = (qg * 8 + 8 + 31) >> 5;
        bf16x8 nb0 = af[0][0], nb1 = af[0][0];
        if (F.wave < ntile) { const int key = F.wave * 32 + (lane & 31); nb0 = *(const bf16x8*)(KI + (TB + key) * 32 + 8 * hh); nb1 = *(const bf16x8*)(KI + (TB + key) * 32 + 16 + 8 * hh); }
        for (int kt = F.wave; kt < ntile; kt += 8) {
            const int key = kt * 32 + (lane & 31);
            const bf16x8 b0 = nb0, b1 = nb1;
            if (kt + 8 < ntile) { const int k2 = key + 256; nb0 = *(const bf16x8*)(KI + (TB + k2) * 32 + 8 * hh); nb1 = *(const bf16x8*)(KI + (TB + k2) * 32 + 16 + 8 * hh); }
#pragma unroll
            for (int mt = 0; mt < 2; ++mt) { f32x16 acc;
#pragma unroll
                for (int i = 0; i < 16; ++i) acc[i] = 0.f;
                acc = __builtin_amdgcn_mfma_f32_32x32x16_bf16(af[mt][0], b0, acc, 0, 0, 0);
                acc = __builtin_amdgcn_mfma_f32_32x32x16_bf16(af[mt][1], b1, acc, 0, 0, 0);
#pragma unroll
                for (int q2 = 0; q2 < 2; ++q2) { float s = 0.f;
#pragma unroll
                    for (int hd = 0; hd < 8; ++hd) s += fmaxf(acc[8 * q2 + hd], 0.f) * wq[mt][q2][hd];
                    const int qi = 4 * mt + 2 * hh + q2;
                    sc[qi * 4096 + key] = (key <= qg * 8 + qi) ? s : -INFINITY; } }
        }
    }
    __syncthreads();
    const int qi = F.wave, tq = qg * 8 + qi, n = tq + 1;
    LAS float* scq = sc + qi * 4096; LAS unsigned short* sel = selall + qi * 256; LAS unsigned* hist = histall + qi * 512;
    int nsel;
    if (n <= 256) { nsel = n; for (int j = lane; j < 256; j += 64) sel[j] = (unsigned short)(j < n ? j : 0); }
    else {
        nsel = 256;
        const int R = (n + 63) >> 6; const unsigned long long ltm = (1ull << lane) - 1ull;
        float lo = INFINITY, hi = -INFINITY;
        const int R4 = (n + 255) >> 8;
#pragma unroll 4
        for (int i = 0; i < R4; ++i) { const int j0 = 256 * i + 4 * lane; const f32x4 v4 = *(const LAS f32x4*)(scq + j0);
#pragma unroll
            for (int q = 0; q < 4; ++q) { const bool valid = j0 + q < n; lo = fminf(lo, valid ? v4[q] : INFINITY); hi = fmaxf(hi, valid ? v4[q] : -INFINITY); } }
#pragma unroll
        for (int o = 1; o < 64; o <<= 1) { lo = fminf(lo, shx(lo, o)); hi = fmaxf(hi, shx(hi, o)); }
        bool slow = false;
        if (!(hi > lo)) { for (int j = lane; j < 256; j += 64) sel[j] = (unsigned short)j; }
        else {
            const float scale = 1023.0f / (hi - lo);
            *(LAS u32x4*)(hist + 8 * lane) = (u32x4){0u, 0u, 0u, 0u}; *(LAS u32x4*)(hist + 8 * lane + 4) = (u32x4){0u, 0u, 0u, 0u};
#pragma unroll 2
            for (int i = 0; i < R4; ++i) { const int j0 = 256 * i + 4 * lane; const f32x4 v4 = *(const LAS f32x4*)(scq + j0);
#pragma unroll
                for (int q = 0; q < 4; ++q) { if (j0 + q < n) { int bk = (int)((v4[q] - lo) * scale); bk = bk < 1023 ? bk : 1023;
                    atomicAdd((unsigned*)(hist + (bk >> 1)), (bk & 1) ? 65536u : 1u); } } }
            const u32x4 h0 = *(const LAS u32x4*)(hist + 8 * lane), h1 = *(const LAS u32x4*)(hist + 8 * lane + 4);
            unsigned cb[16];
            cb[0] = h0.x & 0xffffu; cb[1] = h0.x >> 16; cb[2] = h0.y & 0xffffu; cb[3] = h0.y >> 16; cb[4] = h0.z & 0xffffu; cb[5] = h0.z >> 16; cb[6] = h0.w & 0xffffu; cb[7] = h0.w >> 16;
            cb[8] = h1.x & 0xffffu; cb[9] = h1.x >> 16; cb[10] = h1.y & 0xffffu; cb[11] = h1.y >> 16; cb[12] = h1.z & 0xffffu; cb[13] = h1.z >> 16; cb[14] = h1.w & 0xffffu; cb[15] = h1.w >> 16;
            unsigned tot = 0u;
#pragma unroll
            for (int q = 0; q < 16; ++q) tot += cb[q];
            unsigned incl = tot;
#pragma unroll
            for (int o = 1; o < 64; o <<= 1) { const unsigned t = shdown_u(incl, o); if (lane + o < 64) incl += t; }
            int fb = -1; unsigned fabove = 0u, fcnt = 0u; unsigned cum = incl - tot;
#pragma unroll
            for (int q = 15; q >= 0; --q) { if (fb < 0 && cum < 256u && 256u <= cum + cb[q]) { fb = 16 * lane + q; fabove = cum; fcnt = cb[q]; } cum += cb[q]; }
            const unsigned long long mf = __ballot(fb >= 0); const int src = (int)__ffsll((long long)mf) - 1;
            const int B = shidx_i(fb, src); const int above = shidx_i((int)fabove, src), cntB = shidx_i((int)fcnt, src); const int need = 256 - above;
            if (cntB > 256) slow = true;
            else {
                LAS unsigned* cand = hist;
                int base_gt = 0, base_c = 0;
#pragma unroll 2
                for (int i = 0; i < R4; ++i) { const int j0 = 256 * i + 4 * lane; const f32x4 v4 = *(const LAS f32x4*)(scq + j0);
#pragma unroll
                    for (int q = 0; q < 4; ++q) { const int j = j0 + q; const bool valid = j < n; const float v = valid ? v4[q] : lo;
                        int bk = (int)((v - lo) * scale); bk = bk < 1023 ? bk : 1023;
                        const bool gt = valid && bk > B, eq = valid && bk == B;
                        const unsigned long long mg = __ballot(gt), me = __ballot(eq);
                        if (gt) sel[base_gt + __popcll(mg & ltm)] = (unsigned short)j;
                        if (eq) { const int p = base_c + __popcll(me & ltm); cand[2 * p] = fkey(v); cand[2 * p + 1] = (unsigned)j; }
                        base_gt += __popcll(mg); base_c += __popcll(me); } }
                if (need == cntB) { for (int c = lane; c < cntB; c += 64) sel[above + c] = (unsigned short)cand[2 * c + 1]; }
                else {
                    unsigned ck[4], cx[4]; int rk[4];
#pragma unroll
                    for (int q = 0; q < 4; ++q) { const int c = lane + 64 * q; ck[q] = c < cntB ? cand[2 * c] : 0u; cx[q] = c < cntB ? cand[2 * c + 1] : 0u; rk[q] = 0; }
                    for (int c2 = 0; c2 < cntB; ++c2) { const unsigned k2 = cand[2 * c2], x2 = cand[2 * c2 + 1];
#pragma unroll
                        for (int q = 0; q < 4; ++q) rk[q] += (k2 > ck[q] || (k2 == ck[q] && x2 < cx[q])) ? 1 : 0; }
#pragma unroll
                    for (int q = 0; q < 4; ++q) { const int c = lane + 64 * q; if (c < cntB && rk[q] < need) sel[above + rk[q]] = (unsigned short)cand[2 * c + 1]; }
                }
            }
        }
        if (slow) {
        unsigned prefix = 0u; int need = 256; unsigned neq = 0u;
        for (int p = 0; p < 4; ++p) { const int shift = 24 - 8 * p;
            *(LAS u32x4*)(hist + 4 * lane) = (u32x4){0u, 0u, 0u, 0u};
            for (int i = 0; i < R; ++i) { const int j = lane + 64 * i; if (j < n) { const unsigned u = fkey(scq[j]);
                if (p == 0 || (u >> (shift + 8)) == prefix) atomicAdd((unsigned*)(hist + ((u >> shift) & 255u)), 1u); } }
            const u32x4 hv = *(const LAS u32x4*)(hist + 4 * lane);
            const unsigned tot = hv.x + hv.y + hv.z + hv.w;
            unsigned incl = tot;
#pragma unroll
            for (int o = 1; o < 64; o <<= 1) { const unsigned t = shdown_u(incl, o); if (lane + o < 64) incl += t; }
            const unsigned above = incl - tot;
            int fb = -1; unsigned fabove = 0u, feq = 0u; unsigned cum = above;
            { const unsigned hq[4] = {hv.x, hv.y, hv.z, hv.w};
#pragma unroll
              for (int q = 3; q >= 0; --q) { if (fb < 0 && cum < (unsigned)need && (unsigned)need <= cum + hq[q]) { fb = 4 * lane + q; fabove = cum; feq = hq[q]; } cum += hq[q]; } }
            const unsigned long long m = __ballot(fb >= 0);
            const int src = (int)__ffsll((long long)m) - 1;
            const int bin = shidx_i(fb, src); const unsigned ab = (unsigned)shidx_i((int)fabove, src); neq = (unsigned)shidx_i((int)feq, src);
            need -= (int)ab; prefix = (prefix << 8) | (unsigned)bin;
        }
        const int ngt = 256 - need;
        int base_gt = 0, base_eq = 0;
        for (int i = 0; i < R; ++i) { const int j = lane + 64 * i; const unsigned u = (j < n) ? fkey(scq[j]) : 0u;
            const bool gt = (j < n) && (u > prefix), eq = (j < n) && (u == prefix);
            const unsigned long long mg = __ballot(gt), me = __ballot(eq); const unsigned long long lt = (1ull << lane) - 1ull;
            if (gt) sel[base_gt + __popcll(mg & lt)] = (unsigned short)j;
            if (eq) { const int rk = base_eq + __popcll(me & lt); if (rk < need) sel[ngt + rk] = (unsigned short)j; }
            base_gt += __popcll(mg); base_eq += __popcll(me); }
        (void)neq;
            }
    }
    const int nt16 = (nsel + 15) >> 4, r16 = lane & 15, g4 = lane >> 4;
    LAS float* biasj = scq + 2048;
#pragma unroll
    for (int q = 0; q < 4; ++q) { const int j = lane + 64 * q; f32x4 bv = (f32x4){-INFINITY, -INFINITY, -INFINITY, -INFINITY};
        if (j < nsel) { const int dist = tq - (int)sel[j]; const int bk = dist < 128 ? bkt[dist < 0 ? 0 : dist] : 31; bv = *(const LAS f32x4*)(biasT + 4 * bk); }
        *(LAS f32x4*)(biasj + 4 * j) = bv; }
    bf16x8 qf[2];
#pragma unroll
    for (int s = 0; s < 2; ++s) { u32x4 z = (u32x4){0u, 0u, 0u, 0u}; if (r16 < 4) z = *(const u32x4*)(U + (T0 + qi) * NINP + UC + r16 * 64 + 32 * s + 8 * g4); qf[s] = __builtin_bit_cast(bf16x8, z); }
    float lg[16][4]; float mx = -INFINITY;
#define DSA_QK(M0, NM) do { int keyr[NM]; bf16x8 a0[NM], a1[NM]; \
        _Pragma("unroll") for (int m8 = 0; m8 < NM; ++m8) keyr[m8] = sel[16 * ((M0) + m8) + r16]; \
        _Pragma("unroll") for (int m8 = 0; m8 < NM; ++m8) { a0[m8] = *(const bf16x8*)(Kb + (TB + keyr[m8]) * 64 + 8 * g4); a1[m8] = *(const bf16x8*)(Kb + (TB + keyr[m8]) * 64 + 32 + 8 * g4); } \
        _Pragma("unroll") for (int m8 = 0; m8 < NM; ++m8) { const int m = (M0) + m8; \
            f32x4 acc = (f32x4){0.f, 0.f, 0.f, 0.f}; \
            acc = __builtin_amdgcn_mfma_f32_16x16x32_bf16(a0[m8], qf[0], acc, 0, 0, 0); \
            acc = __builtin_amdgcn_mfma_f32_16x16x32_bf16(a1[m8], qf[1], acc, 0, 0, 0); \
            _Pragma("unroll") for (int i = 0; i < 4; ++i) { const float v = acc[i] * 0.125f + biasj[(16 * m + 4 * g4 + i) * 4 + (r16 & 3)]; lg[m][i] = v; mx = fmaxf(mx, v); } } } while (0)
    if (nt16 > 8) { DSA_QK(0, 16); }
    else { DSA_QK(0, 8);
#pragma unroll
        for (int m8 = 8; m8 < 16; ++m8)
#pragma unroll
            for (int i = 0; i < 4; ++i) lg[m8][i] = -INFINITY; }
#undef DSA_QK
    mx = fmaxf(mx, shx(mx, 16)); mx = fmaxf(mx, shx(mx, 32));
    float sm = 0.f;
#pragma unroll
    for (int m = 0; m < 16; ++m)
#pragma unroll
        for (int i = 0; i < 4; ++i) { const float p = __expf(lg[m][i] - mx); lg[m][i] = p; sm += p; }
    sm += shx(sm, 16); sm += shx(sm, 32);
    f32x4 ov[4];
#pragma unroll
    for (int nt = 0; nt < 4; ++nt) ov[nt] = (f32x4){0.f, 0.f, 0.f, 0.f};
    const unsigned vs_base = (unsigned)(unsigned long)scq;
#pragma unroll
    for (int half = 0; half < 2; ++half) {
        if (half * 8 < nt16) {
            asm volatile("s_waitcnt lgkmcnt(0)" ::: "memory");
            int vkey[16];
#pragma unroll
            for (int q = 0; q < 16; ++q) { const int rho = 8 * q + (lane >> 3);
                vkey[q] = sel[half * 128 + (rho & ~31) + 16 * ((rho >> 2) & 1) + 4 * ((rho >> 3) & 3) + (rho & 3)]; }
            asm volatile("s_waitcnt lgkmcnt(0)" : "+v"(vkey[0]), "+v"(vkey[1]), "+v"(vkey[2]), "+v"(vkey[3]), "+v"(vkey[4]), "+v"(vkey[5]), "+v"(vkey[6]), "+v"(vkey[7]),
                         "+v"(vkey[8]), "+v"(vkey[9]), "+v"(vkey[10]), "+v"(vkey[11]), "+v"(vkey[12]), "+v"(vkey[13]), "+v"(vkey[14]), "+v"(vkey[15]) :: "memory");
#pragma unroll
            for (int q = 0; q < 16; ++q)
                __builtin_amdgcn_global_load_lds((const unsigned*)(Vb + (TB + vkey[q]) * 64 + 8 * (lane & 7)), (LAS unsigned*)((LAS unsigned char*)scq + q * 1024), 16, 0, 0);
            asm volatile("s_waitcnt vmcnt(0)" ::: "memory");
#pragma unroll
            for (int s4 = 0; s4 < 4; ++s4) { const int s = half * 4 + s4;
                u32x4 pw; pw.x = pk2(lg[2 * s][0], lg[2 * s][1]); pw.y = pk2(lg[2 * s][2], lg[2 * s][3]); pw.z = pk2(lg[2 * s + 1][0], lg[2 * s + 1][1]); pw.w = pk2(lg[2 * s + 1][2], lg[2 * s + 1][3]);
                const bf16x8 pa = __builtin_bit_cast(bf16x8, pw);
                const unsigned ad = vs_base + (unsigned)((32 * s4 + 8 * g4 + (r16 >> 2)) * 128 + (r16 & 3) * 8);
                u32x2 t0[4], t1[4];
                asm volatile("ds_read_b64_tr_b16 %0, %8\n\tds_read_b64_tr_b16 %1, %8 offset:512\n\tds_read_b64_tr_b16 %2, %8 offset:32\n\tds_read_b64_tr_b16 %3, %8 offset:544\n\t"
                             "ds_read_b64_tr_b16 %4, %8 offset:64\n\tds_read_b64_tr_b16 %5, %8 offset:576\n\tds_read_b64_tr_b16 %6, %8 offset:96\n\tds_read_b64_tr_b16 %7, %8 offset:608\n\ts_waitcnt lgkmcnt(0)"
                             : "=&v"(t0[0]), "=&v"(t1[0]), "=&v"(t0[1]), "=&v"(t1[1]), "=&v"(t0[2]), "=&v"(t1[2]), "=&v"(t0[3]), "=&v"(t1[3]) : "v"(ad) : "memory");
#pragma unroll
                for (int nt = 0; nt < 4; ++nt) { const bf16x8 vb = __builtin_bit_cast(bf16x8, (u32x4){t0[nt].x, t0[nt].y, t1[nt].x, t1[nt].y});
                    ov[nt] = __builtin_amdgcn_mfma_f32_16x16x32_bf16(pa, vb, ov[nt], 0, 0, 0); } }
        }
    }
    { float inv[4];
#pragma unroll
      for (int h = 0; h < 4; ++h) inv[h] = 1.0f / __int_as_float(__builtin_amdgcn_readlane(__float_as_int(sm), h));
      if (lane < 16) { bf16_t* Y = (bf16_t*)(F.ws + WS_H) + (T0 + qi) * DM + 512 + r16;
#pragma unroll
          for (int h = 0; h < 4; ++h)
#pragma unroll
              for (int nt = 0; nt < 4; ++nt) Y[h * 64 + 16 * nt] = f2bf(ov[nt][h] * inv[h]); } }
}

__device__ __forceinline__ void phase_router(const Frame& F_, int layer) { Frame F = relocal(F_); const int cset = layer;
    const float* X = (const float*)(F.ws + WS_X);
    const bf16_t* WH = (const bf16_t*)(F.ws + WS_WRT) + (size_t)layer * 2 * 49152; const bf16_t* WL = WH + 49152;
    LAS float* part = (LAS float*)F.lds;
    LAS float* ssq = (LAS float*)(F.lds + 24576);
    LAS int* es = (LAS int*)(F.lds + 25088);
    LAS int* lr = (LAS int*)(F.lds + 25600);
    LAS float* wsl = (LAS float*)(F.lds + 26112);
    LAS float* rsd = (LAS float*)(F.lds + 26624);
    for (int blk = F.bid; blk < NTOK / 64; blk += F.G) {
        __syncthreads();
        const int mt = F.wave & 3, kh = F.wave >> 2, r16 = F.lane & 15, g4 = F.lane >> 4;
        const float* xr = X + ((size_t)blk * 64 + mt * 16 + r16) * DM + kh * 512 + 8 * g4;
        f32x4 acc[3]; acc[0] = acc[1] = acc[2] = (f32x4){0.f, 0.f, 0.f, 0.f}; float ss = 0.f;
#pragma unroll 4
        for (int ks = 0; ks < 16; ++ks) {
            const f32x4 xa = *(const f32x4*)(xr + ks * 32), xb = *(const f32x4*)(xr + ks * 32 + 4);
            ss += xa[0] * xa[0] + xa[1] * xa[1] + xa[2] * xa[2] + xa[3] * xa[3] + xb[0] * xb[0] + xb[1] * xb[1] + xb[2] * xb[2] + xb[3] * xb[3];
            float xv[8] = {xa[0], xa[1], xa[2], xa[3], xb[0], xb[1], xb[2], xb[3]}; unsigned hw[4], lw[4];
#pragma unroll
            for (int j = 0; j < 4; ++j) { const bf16_t h0 = f2bf(xv[2 * j]), h1 = f2bf(xv[2 * j + 1]); hw[j] = (unsigned)h0 | ((unsigned)h1 << 16);
                lw[j] = pk2(xv[2 * j] - bf2f(h0), xv[2 * j + 1] - bf2f(h1)); }
            const bf16x8 ahi = __builtin_bit_cast(bf16x8, (u32x4){hw[0], hw[1], hw[2], hw[3]}), alo = __builtin_bit_cast(bf16x8, (u32x4){lw[0], lw[1], lw[2], lw[3]});
#pragma unroll
            for (int nt = 0; nt < 3; ++nt) { const size_t wo = (size_t)(nt * 16 + r16) * 1024 + kh * 512 + ks * 32 + 8 * g4;
                const bf16x8 bh = *(const bf16x8*)(WH + wo), bl = *(const bf16x8*)(WL + wo);
                acc[nt] = __builtin_amdgcn_mfma_f32_16x16x32_bf16(ahi, bh, acc[nt], 0, 0, 0);
                acc[nt] = __builtin_amdgcn_mfma_f32_16x16x32_bf16(ahi, bl, acc[nt], 0, 0, 0);
                acc[nt] = __builtin_amdgcn_mfma_f32_16x16x32_bf16(alo, bh, acc[nt], 0, 0, 0); }
        }
        ss += shx(ss, 16); ss += shx(ss, 32);
        if (g4 == 0) ssq[kh * 64 + mt * 16 + r16] = ss;
#pragma unroll
        for (int nt = 0; nt < 3; ++nt)
#pragma unroll
            for (int i = 0; i < 4; ++i) part[(kh * 64 + mt * 16 + 4 * g4 + i) * 48 + nt * 16 + r16] = acc[nt][i];
        __syncthreads();
        if (F.tid < 64) { const float rstd = rsqrtf((ssq[F.tid] + ssq[64 + F.tid]) * (1.0f / DM) + 1e-6f); rsd[F.tid] = rstd;
            float l[36];
#pragma unroll
            for (int o = 0; o < 36; ++o) l[o] = (part[F.tid * 48 + o] + part[(64 + F.tid) * 48 + o]) * rstd + (o < 32 ? F.in[I_BRE][layer * 32 + o] : F.in[I_BRG][layer * 4 + o - 32]);
            int gs = 0; float gm = l[32];
#pragma unroll
            for (int j = 1; j < 4; ++j) if (l[32 + j] > gm) { gm = l[32 + j]; gs = j; }
            float den = 0.f;
#pragma unroll
            for (int j = 0; j < 4; ++j) den += __expf(l[32 + j] - gm);
            const float gate = 1.0f / den;
            float e8[8];
#pragma unroll
            for (int j = 0; j < 8; ++j) e8[j] = gs == 0 ? l[j] : gs == 1 ? l[8 + j] : gs == 2 ? l[16 + j] : l[24 + j];
            int i1 = 0; float v1 = e8[0];
#pragma unroll
            for (int j = 1; j < 8; ++j) if (e8[j] > v1) { v1 = e8[j]; i1 = j; }
            int i2 = -1; float v2 = -INFINITY;
#pragma unroll
            for (int j = 0; j < 8; ++j) if (j != i1 && e8[j] > v2) { v2 = e8[j]; i2 = j; }
            const float e2 = __expf(v2 - v1); const float p1 = 1.0f / (1.0f + e2);
            es[F.tid * 2] = gs * 8 + i1; es[F.tid * 2 + 1] = gs * 8 + i2; wsl[F.tid * 2] = p1 * gate; wsl[F.tid * 2 + 1] = (1.0f - p1) * gate; }
        __syncthreads();
        if (F.tid < 32) { int cnt = 0; for (int i = 0; i < 128; ++i) if (es[i] == F.tid) lr[i] = cnt++;
            if (cnt) { const int base = (int)__hip_atomic_fetch_add(F.ctl + CW_CNT + cset * 32 + F.tid, (unsigned)cnt, __ATOMIC_RELAXED, __HIP_MEMORY_SCOPE_AGENT);
                for (int i = 0; i < 128; ++i) if (es[i] == F.tid) lr[i] += base; } }
        __syncthreads();
        if (F.tid < 64) { int* rt = (int*)(F.ws + WS_ROUTE) + ((size_t)blk * 64 + F.tid) * 8;
            rt[0] = es[F.tid * 2]; rt[1] = es[F.tid * 2 + 1]; ((float*)rt)[2] = wsl[F.tid * 2]; ((float*)rt)[3] = wsl[F.tid * 2 + 1]; rt[4] = lr[F.tid * 2]; rt[5] = lr[F.tid * 2 + 1]; ((float*)rt)[6] = rsd[F.tid]; }
    }
    __syncthreads();
    if (F.tid == 0) __hip_atomic_fetch_add(F.ctl + CW_RB + 64 * layer, 1u, __ATOMIC_RELAXED, __HIP_MEMORY_SCOPE_AGENT);
}
__device__ __forceinline__ void phase_moe_convert(const Frame& F_, int layer) { Frame F = relocal(F_);
    bf16_t* WGU = (bf16_t*)(F.ws + WS_MOE + MOE_WGU);
    for (int t = F.bid; t < 1024; t += F.G) {
        const int e = t >> 5, r = t & 31, kt = r >> 1, nt = r & 1; const size_t eo = ((size_t)layer * 32 + e) * 1024 * 256;
        tr_tile(F, 256, WGU + (size_t)e * 512 * 1024, 1024, kt * 64, nt * 256, SmGU{F.in[I_WGATE] + eo, F.in[I_WUP] + eo}); }
}
__device__ __forceinline__ void phase_moe_convert_down(const Frame& F_, int layer) { Frame F = relocal(F_);
    bf16_t* WD = (bf16_t*)(F.ws + WS_MOE + MOE_WD);
    for (;;) { const int q = q_pop(F, 32 + layer); if (q >= 512) break;
        const int e = q >> 4, r = q & 15, kt = r >> 2, nt = r & 3;
        tr_tile(F, 1024, WD + (size_t)e * 1024 * 256, 256, kt * 64, nt * 256, SmId{F.in[I_WDOWN] + ((size_t)layer * 32 + e) * 256 * 1024}); }
}
__device__ __forceinline__ void phase_gather(const Frame& F_, int layer) { Frame F = relocal(F_);
    LAS int* off = (LAS int*)F.lds;
    __syncthreads();
    if (F.tid == 0) { unsigned sp = 0;
        while (__hip_atomic_load(F.ctl + CW_RB + 64 * layer, __ATOMIC_RELAXED, __HIP_MEMORY_SCOPE_AGENT) < (unsigned)F.G) { __builtin_amdgcn_s_sleep(2); if (++sp > (1u << 22)) break; } }
    __syncthreads();
    if (F.tid == 0) { int acc = 0; for (int e = 0; e < 32; ++e) { off[e] = acc; const int c = (int)__hip_atomic_load(F.ctl + CW_CNT + layer * 32 + e, __ATOMIC_RELAXED, __HIP_MEMORY_SCOPE_AGENT); acc += (c + 255) & ~255; } off[32] = acc; }
    __syncthreads();
    int* tiles = (int*)(F.ws + WS_TILES); int* row_tok = (int*)(F.ws + WS_ROWS); float* row_w = (float*)(F.ws + WS_ROWS) + MAXROWS;
    if (F.bid == 0) { if (F.tid == 0) tiles[0] = off[32] >> 8; if (F.tid < 33) tiles[1 + F.tid] = off[F.tid];
        if (F.tid < 32) for (int rt = off[F.tid] >> 8; rt < (off[F.tid + 1] >> 8); ++rt) tiles[64 + rt] = F.tid; }
    for (int e = F.bid; e < 32; e += F.G) { const int c = (int)__hip_atomic_load(F.ctl + CW_CNT + layer * 32 + e, __ATOMIC_RELAXED, __HIP_MEMORY_SCOPE_AGENT);
        for (int r = off[e] + c + F.tid; r < off[e + 1]; r += NTHR) { row_tok[r] = -1; row_w[r] = 0.f; } }
    const float* X = (const float*)(F.ws + WS_X); bf16_t* HP = (bf16_t*)(F.ws + WS_U); const float* nw = F.in[I_NORM2] + (size_t)layer * DM;
    f32x4 nwv[4];
#pragma unroll
    for (int j = 0; j < 4; ++j) nwv[j] = *(const f32x4*)(nw + 4 * F.lane + 256 * j);
    for (int blk = F.bid; blk < NTOK / 64; blk += F.G)
    for (int i4 = 0; i4 < 2; ++i4) {
        int p0[4], p1[4], tt[4]; float rstd[4], w0[4], w1[4]; f32x4 xv[4][4];
#pragma unroll
        for (int r = 0; r < 4; ++r) { const int t = blk * 64 + F.wave * 8 + 4 * i4 + r; tt[r] = t;
            const int* rt = (const int*)(F.ws + WS_ROUTE) + (size_t)t * 8; rstd[r] = ((const float*)rt)[6]; w0[r] = ((const float*)rt)[2]; w1[r] = ((const float*)rt)[3];
            p0[r] = off[rt[0]] + rt[4]; p1[r] = off[rt[1]] + rt[5];
#pragma unroll
            for (int j = 0; j < 4; ++j) xv[r][j] = *(const f32x4*)(X + (size_t)t * DM + 4 * F.lane + 256 * j); }
#pragma unroll
        for (int r = 0; r < 4; ++r) {
#pragma unroll
            for (int j = 0; j < 4; ++j) { const int c = 4 * F.lane + 256 * j; const f32x4 v = xv[r][j] * rstd[r] * nwv[j];
                u32x2 o; o.x = pk2(v[0], v[1]); o.y = pk2(v[2], v[3]);
                *(u32x2*)(HP + (size_t)tt[r] * DM + c) = o; }
            if (F.lane == 0) { row_tok[p0[r]] = tt[r] * 2; row_w[p0[r]] = w0[r]; row_tok[p1[r]] = tt[r] * 2 + 1; row_w[p1[r]] = w1[r]; } }
    }
}

constexpr int NPH_LAYER = 9, NPHASE = 1 + 2 * NPH_LAYER + 1;
#ifndef MK_ONLY
#define MK_ONLY -1
#endif
#ifndef MK_ITEM
#define MK_ITEM -1
#endif
#define EN(o) (MK_ONLY < 0 || MK_ONLY == (o))
#define IT(o) (MK_ITEM < 0 || MK_ITEM == (o))
__global__ void __launch_bounds__(NTHR, 2) mk_forward(Params P) {
    extern __shared__ __attribute__((aligned(16))) unsigned char lds_raw[];
    Frame F; F.lds = (LAS unsigned char*)lds_raw; F.tid = threadIdx.x; F.lane = F.tid & 63; F.wave = __builtin_amdgcn_readfirstlane(F.tid >> 6); F.bid = blockIdx.x; F.G = gridDim.x;
    F.in = (in_tab_t)__builtin_amdgcn_kernarg_segment_ptr(); F.out = P.out; F.ws = P.ws; F.ctl = (unsigned*)(P.ws + WS_CTL); F.misc = (volatile LAS int*)(F.lds + MISC_OFF);
    if (F.tid < 64) ((LAS unsigned*)(F.lds + MISC_OFF))[F.tid] = 0u;
    __syncthreads();
    const int lo = P.ph_lo, hi = P.ph_hi;
    XcdBarrier bar; bar.bar = F.ctl + CW_BAR; bar.x = 0; bar.st = (volatile LAS unsigned*)(F.lds + MISC_OFF + 16);
    if (hi - lo > 1) bar = xcd_barrier_post(F.ctl + CW_BAR, (volatile LAS unsigned*)(F.lds + MISC_OFF + 16));
#define IN(k) (lo <= (k) && (k) < hi)
#define SEAM(k) do { if (IN(k) && IN((k) + 1)) xcd_barrier(bar); } while (0)
#define QLOOP(qi, n, body) for (;;) { const int it = q_pop(F, layer * 12 + (qi)); if (it >= (n)) break; body; }
    if (EN(100) && IN(0)) { phase_prologue(F); phase_norm(F, F.in[I_X], false, F.in[I_NORM1], 3); } SEAM(0);
#pragma unroll
    for (int layer = 0; layer < DEPTH; ++layer) {
        const int pb = 1 + layer * NPH_LAYER;
        if (layer > 0) { if (EN(0) && IN(pb + 0)) { phase_norm(F, (const float*)(F.ws + WS_X), true, F.in[I_NORM1] + (size_t)layer * DM, 0); } SEAM(pb + 0); }
        if (EN(1) && IN(pb + 1)) { const Frame F_ = F; Frame F = relocal(F_); pg8::StaticOrder S; S.init((const bf16_t*)(F.ws + WS_H), (const bf16_t*)(F.ws + WS_WIN) + (size_t)layer * NINP * DM, NTOK, NINP, DM, F.G, F.bid);
            pg8::EpiBf16 E{(bf16_t*)(F.ws + WS_U), NINP}; pg8::gemm_phase(F.lds, DM, S, E); } SEAM(pb + 1);
#define SLOOP(n, body) for (int it = F.bid; it < (n); it += F.G) { __syncthreads(); body; }
        if (EN(2) && IN(pb + 2)) {
            if (IT(1)) SLOOP(1024, item_rwkv1(F, layer, it));
            if (IT(0)) SLOOP(256, item_s5<1>(F, layer, it));
            if (IT(2)) SLOOP(256, item_mamba<1>(F, layer, it));
            if (IT(3)) SLOOP(256, item_kv(F, layer, it));
        } SEAM(pb + 2);
        if (EN(3) && IN(pb + 3)) {
            if (IT(0)) SLOOP(8, item_rwkv_carry(F, it));
            if (IT(1)) { for (int it = F.bid - 8; it >= 0 && it < 16; it += F.G) { __syncthreads(); item_mamba_carry(F, it); } }
            if (IT(2)) { for (int it = F.bid - 24; it >= 0 && it < 4; it += F.G) { __syncthreads(); item_s5_carry(F, layer, it); } }
            if (IT(3)) {
                dsa_tables(F);
                const int pref = (int)(xb_xcc_id() & 3u);
#pragma unroll 1
                for (int k4 = 0; k4 < 4; ++k4) { const int bq = (pref + k4) & 3;
                    for (;;) { const int it = q_pop(F, 24 + layer * 4 + bq); if (it >= 512) break; item_dsa(F, layer, it * 4 + bq); } } }
        } SEAM(pb + 3);
        if (EN(4) && IN(pb + 4)) {
            if (IT(0)) SLOOP(256, item_s5<2>(F, layer, it));
            if (IT(2)) SLOOP(256, item_mamba<2>(F, layer, it));
            if (IT(1)) SLOOP(1024, item_rwkv3(F, layer, it));
        } SEAM(pb + 4);
        if (EN(6) && IN(pb + 5)) { const Frame F_ = F; Frame F = relocal(F_); pg8::StaticOrder S; S.init((const bf16_t*)(F.ws + WS_H), (const bf16_t*)(F.ws + WS_WOUT) + (size_t)layer * DM * DM, NTOK, DM, DM, F.G, F.bid);
            pg8::EpiResid E{layer == 0 ? F.in[I_X] : (const float*)(F.ws + WS_X), (float*)(F.ws + WS_X), DM}; pg8::gemm_phase(F.lds, DM, S, E); } SEAM(pb + 5);
        if (EN(7) && IN(pb + 6)) { phase_router(F, layer); phase_moe_convert(F, layer); phase_gather(F, layer); } SEAM(pb + 6);
        if (EN(8) && IN(pb + 7)) { const Frame F_ = F; Frame F = relocal(F_); LAS int* ul = (LAS int*)(F.lds + pg8::STAGE_BYTES + 8192); if (F.tid == 0) pg8::MoeOrder::build(ul, (const int*)(F.ws + WS_TILES), 2, F.G, F.bid); __syncthreads();
            pg8::MoeOrder S{DM, (const char*)(F.ws + WS_U), (const char*)(F.ws + WS_MOE + MOE_WGU), (size_t)512 * 1024 * 2, ul};
            pg8::EpiGated<1> E{(bf16_t*)(F.ws + WS_H), 256, 0, nullptr, nullptr}; pg8::gemm_phase<pg8::EpiGated<1>, pg8::MoeOrder, true>(F.lds, DM, S, E, (const char*)(F.ws + WS_U), (const int*)(F.ws + WS_ROWS)); phase_moe_convert_down(F, layer); } SEAM(pb + 7);
        if (EN(9) && IN(pb + 8)) { const Frame F_ = F; Frame F = relocal(F_); LAS int* ul = (LAS int*)(F.lds + pg8::STAGE_BYTES + 8192); if (F.tid == 0) pg8::MoeOrder::build(ul, (const int*)(F.ws + WS_TILES), 4, F.G, F.bid); __syncthreads();
            pg8::MoeOrder S{256, (const char*)(F.ws + WS_H), (const char*)(F.ws + WS_MOE + MOE_WD), (size_t)1024 * 256 * 2, ul};
            pg8::EpiMoeOut E{(bf16_t*)(F.ws + WS_U), (const int*)(F.ws + WS_ROWS), (const float*)(F.ws + WS_ROWS) + MAXROWS, F.lds}; pg8::gemm_phase(F.lds, 256, S, E); } SEAM(pb + 8);
    }
    if (EN(101) && IN(NPHASE - 1)) { phase_norm(F, (const float*)(F.ws + WS_X), true, F.in[I_FNORM], 2); }
#undef IN
#undef SEAM
}

#ifndef MK_SPLIT
#define MK_SPLIT 0
#endif
extern "C" void kernel_launch(void* const* d_in, const int* in_sizes, int n_in, void* d_out, int out_size, void* d_ws, size_t ws_size, hipStream_t stream) {
    static int grid = 0;
    if (grid == 0) {
        if (n_in != 44 || out_size != NTOK * DM || ws_size < WS_END) { fprintf(stderr, "kernel_launch: unexpected shapes (n_in %d out %d ws %zu need %zu)\n", n_in, out_size, ws_size, (size_t)WS_END); grid = -1; return; }
        int dev = 0, cus = 0;
        if (hipGetDevice(&dev) != hipSuccess || hipDeviceGetAttribute(&cus, hipDeviceAttributeMultiprocessorCount, dev) != hipSuccess) { grid = -1; return; }
        if (hipFuncSetAttribute((const void*)mk_forward, hipFuncAttributeMaxDynamicSharedMemorySize, LDS_BYTES) != hipSuccess) { fprintf(stderr, "kernel_launch: hipFuncSetAttribute failed\n"); grid = -1; return; }
        int per_cu = 0;
        if (hipOccupancyMaxActiveBlocksPerMultiprocessor(&per_cu, (const void*)mk_forward, NTHR, LDS_BYTES) != hipSuccess || per_cu < 1) { fprintf(stderr, "kernel_launch: occupancy query says %d\n", per_cu); }
        (void)hipGetLastError();
        grid = cus;
    }
    if (grid < 0) return;
    hipMemsetAsync((char*)d_ws + WS_CTL, 0, CTL_BYTES, stream);
    Params p{};
    for (int i = 0; i < 44; ++i) p.in[i] = (const float*)d_in[i];
    p.out = (float*)d_out; p.ws = (unsigned char*)d_ws;
#if MK_SPLIT
    for (int ph = 0; ph < NPHASE; ++ph) { p.ph_lo = ph; p.ph_hi = ph + 1; hipLaunchKernelGGL(mk_forward, dim3(grid), dim3(NTHR), LDS_BYTES, stream, p); }
#else
    p.ph_lo = 0; p.ph_hi = NPHASE; hipLaunchKernelGGL(mk_forward, dim3(grid), dim3(NTHR), LDS_BYTES, stream, p);
#endif
}
```

```cpp
#include <hip/hip_runtime.h>
#include <stdint.h>
#include <stdio.h>

#define LAS __attribute__((address_space(3)))
typedef unsigned short bf16_t;
typedef short bf16x8 __attribute__((ext_vector_type(8)));
typedef float f32x4 __attribute__((ext_vector_type(4)));
typedef float f32x2 __attribute__((ext_vector_type(2)));
typedef float f32x16 __attribute__((ext_vector_type(16)));
typedef unsigned u32x4 __attribute__((ext_vector_type(4)));
typedef unsigned u32x2 __attribute__((ext_vector_type(2)));

constexpr int NTOK = 16384, DM = 1024, SEQ = 4096, NBATCH = 4, DEPTH = 2;
constexpr int NIN = 2604, NINP = 2816;
constexpr int UM = 0;
constexpr int UR = 784;
constexpr int UC = 1680;
constexpr int US = 2368;
constexpr int NTHR = 512;
constexpr int LDS_BYTES = 163840;
constexpr int MISC_OFF = LDS_BYTES - 256;

constexpr size_t WS_CTL   = 0;
constexpr size_t CTL_BYTES = 65536;
constexpr size_t WS_X     = WS_CTL + CTL_BYTES;
constexpr size_t WS_H     = WS_X + (size_t)NTOK * DM * 4;
constexpr size_t WS_U     = WS_H + (size_t)NTOK * DM * 2;
constexpr size_t WS_WIN   = WS_U + (size_t)NTOK * NINP * 2;
constexpr size_t WS_WOUT  = WS_WIN + (size_t)2 * NINP * DM * 2;
constexpr size_t WS_GLU   = WS_WOUT + (size_t)2 * DM * DM * 2;
constexpr size_t WS_MOE   = WS_GLU + (size_t)2 * 512 * 256 * 2;
constexpr size_t MOE_WGU  = 0;
constexpr size_t MOE_WD   = (size_t)32 * 512 * 1024 * 2;
constexpr size_t MOE_BYTES = MOE_WD + (size_t)32 * 1024 * 256 * 2;
constexpr size_t RW_PT    = 0;
constexpr size_t RW_U     = (size_t)1024 * 4096 * 2;
constexpr size_t RW_S     = RW_U + (size_t)1024 * 4096 * 2;
constexpr size_t RW_W1    = RW_S + (size_t)1024 * 4096 * 2;
constexpr size_t RW_Z     = RW_W1 + (size_t)1024 * 4096 * 2;
constexpr size_t YSG_OFF  = RW_Z + (size_t)1024 * 4096 * 2;
static_assert(YSG_OFF + (size_t)NTOK * 256 * 2 <= MOE_BYTES, "alias");
constexpr size_t WS_MST   = WS_MOE + MOE_BYTES;
constexpr size_t WS_MDEC  = WS_MST + (size_t)4 * 64 * 4 * 4096 * 4;
constexpr size_t WS_S5ST  = WS_MDEC + 4096;
constexpr size_t WS_K     = WS_S5ST + (size_t)4 * 64 * 2048 * 4;
constexpr size_t WS_V     = WS_K + (size_t)NTOK * 64 * 2;
constexpr size_t WS_KIDX  = WS_V + (size_t)NTOK * 64 * 2;
constexpr size_t WS_ROUTE = WS_KIDX + (size_t)NTOK * 32 * 2;
constexpr size_t WS_ROWS  = WS_ROUTE + (size_t)NTOK * 32;
constexpr int    MAXROWS  = 49152;
constexpr size_t WS_TILES = WS_ROWS + (size_t)MAXROWS * 8;
constexpr size_t WS_S5TAB = WS_TILES + 4096;
constexpr size_t S5TAB_F  = (size_t)(2048 + 2048 + 32768) * 4;
constexpr size_t S5TAB_BBT = S5TAB_F + (size_t)16 * 16 * 128 * 2;
constexpr size_t S5TAB_L  = S5TAB_BBT + (size_t)16 * 128 * 16 * 2;
constexpr size_t WS_WRT   = WS_S5TAB + 2 * S5TAB_L;
constexpr size_t WS_BON   = WS_WRT + (size_t)2 * 2 * 48 * 1024 * 2;
constexpr size_t WS_END   = WS_BON + (size_t)1024 * 64 * 4;

constexpr int CW_BAR = 0;
constexpr int CW_Q   = 4096;
constexpr int CW_CNT = 8192;
constexpr int CW_RB  = 8448;

__device__ __forceinline__ float bf2f(bf16_t b) { return __uint_as_float(((unsigned)b) << 16); }
__device__ __forceinline__ bf16_t f2bf(float f) { const __bf16 h = (__bf16)f; return __builtin_bit_cast(bf16_t, h); }
__device__ __forceinline__ unsigned pk2(float lo, float hi) { typedef __bf16 bf2_t __attribute__((ext_vector_type(2))); const bf2_t h = __builtin_convertvector((f32x2){lo, hi}, bf2_t); return __builtin_bit_cast(unsigned, h); }
__device__ __forceinline__ unsigned cvt_pk_bf16(float lo, float hi) { unsigned r; asm volatile("v_cvt_pk_bf16_f32 %0, %1, %2" : "=v"(r) : "v"(lo), "v"(hi)); return r; }
__device__ __forceinline__ float sigmoidf_(float x) { return 1.0f / (1.0f + __expf(-x)); }
__device__ __forceinline__ float siluf_(float x) { return x / (1.0f + __expf(-x)); }
__device__ __forceinline__ float tanhf_(float x) { const float e = __expf(2.0f * x); return 1.0f - 2.0f / (e + 1.0f); }
__device__ __forceinline__ float softplusf_(float x) { return fmaxf(x, 0.0f) + log1pf(__expf(-fabsf(x))); }
__device__ __forceinline__ float gelu_tanh(float x) { return 0.5f * x * (1.0f + tanhf_(0.7978845608028654f * (x + 0.044715f * x * x * x))); }
template <int CTRL> __device__ __forceinline__ float dppf(float x) { return __int_as_float(__builtin_amdgcn_update_dpp(0, __float_as_int(x), CTRL, 0xF, 0xF, true)); }
__device__ __forceinline__ float sum4(float x) { x += dppf<0xB1>(x); x += dppf<0x4E>(x); return x; }
__device__ __forceinline__ float sum8(float x) { x = sum4(x); x += dppf<0x141>(x); return x; }
__device__ __forceinline__ float sum16(float x) { x = sum8(x); x += dppf<0x140>(x); return x; }
__device__ __forceinline__ int lane_id_() { int l = (int)__builtin_amdgcn_mbcnt_hi(~0u, __builtin_amdgcn_mbcnt_lo(~0u, 0u)); asm volatile("" : "+v"(l)); return l; }
__device__ __forceinline__ float shx(float x, int o) { return __int_as_float(__builtin_amdgcn_ds_bpermute((lane_id_() ^ o) << 2, __float_as_int(x))); }
__device__ __forceinline__ unsigned shdown_u(unsigned x, int o) { return (unsigned)__builtin_amdgcn_ds_bpermute(((lane_id_() + o) & 63) << 2, (int)x); }
__device__ __forceinline__ int shidx_i(int x, int src) { return __builtin_amdgcn_ds_bpermute(src << 2, x); }
__device__ __forceinline__ float wave_sum(float x) { x = sum16(x); x += shx(x, 16); x += shx(x, 32); return x; }
__device__ __forceinline__ void unpack8(const u32x4 v, float (&f)[8]) {
    f[0] = __uint_as_float(v.x << 16); f[1] = __uint_as_float(v.x & 0xffff0000u); f[2] = __uint_as_float(v.y << 16); f[3] = __uint_as_float(v.y & 0xffff0000u);
    f[4] = __uint_as_float(v.z << 16); f[5] = __uint_as_float(v.z & 0xffff0000u); f[6] = __uint_as_float(v.w << 16); f[7] = __uint_as_float(v.w & 0xffff0000u);
}

__device__ __forceinline__ void st16_wt(void* p, u32x4 v) { asm volatile("global_store_dwordx4 %0, %1, off sc1\n\ts_nop 1" :: "v"(p), "v"(v) : "memory"); }
#define XB_TMO      128
#define XB_XCNT(j)  (256  + 64 * (j))
#define XB_XSUB(j)  (1280 + 64 * (j))
#define XB_XGEN(j)  (2304 + 64 * (j))
#define XB_TOP      3328
#define XB_TOPGEN   3392
#define XCD_BAR_WORDS 3456
#define XB_SPIN_CAP (1u << 22)
__device__ __forceinline__ unsigned xb_ld(unsigned* p)              { return __hip_atomic_load(p, __ATOMIC_RELAXED, __HIP_MEMORY_SCOPE_AGENT); }
__device__ __forceinline__ unsigned xb_add(unsigned* p, unsigned v) { return __hip_atomic_fetch_add(p, v, __ATOMIC_RELAXED, __HIP_MEMORY_SCOPE_AGENT); }
__device__ __forceinline__ unsigned xb_xcc_id() { return (unsigned)__builtin_amdgcn_s_getreg((3 << 11) | 20) & 0xFu; }
#define XB_SPIN(cond, bar) do { unsigned _sp = 0; while (cond) { __builtin_amdgcn_s_sleep(1); \
    if ((++_sp & 255u) == 0u) { if (xb_ld(&(bar)[XB_TMO])) break; if (_sp > XB_SPIN_CAP) { atomicAdd(&(bar)[XB_TMO], 1u); break; } } } } while (0)
struct XcdBarrier { unsigned* bar; unsigned x; volatile LAS unsigned* st; };
__device__ __forceinline__ XcdBarrier xcd_barrier_post(unsigned* bar, volatile LAS unsigned* st) {
    XcdBarrier b; b.bar = bar; b.x = xb_xcc_id(); b.st = st;
    if (threadIdx.x == 0) (void)xb_add(&bar[XB_XCNT(b.x)], 1u);
    return b;
}
__device__ __forceinline__ void xcd_barrier_complete(unsigned* bar, unsigned x, unsigned& nloc, unsigned& nx) {
    const unsigned G = gridDim.x * gridDim.y * gridDim.z;
    unsigned sum, cnt, mine, sp = 0u;
    for (;;) {
        sum = 0u; cnt = 0u; mine = 0u;
#pragma unroll
        for (unsigned j = 0; j < 16; ++j) { const unsigned c = xb_ld(&bar[XB_XCNT(j)]); sum += c; cnt += (c > 0u) ? 1u : 0u; mine = (j == x) ? c : mine; }
        if (sum == G) break;
        __builtin_amdgcn_s_sleep(1);
        if ((++sp & 255u) == 0u) { if (xb_ld(&bar[XB_TMO])) break; if (sp > XB_SPIN_CAP) { atomicAdd(&bar[XB_TMO], 1u); break; } }
    }
    nloc = mine > 0u ? mine : 1u; nx = cnt > 0u ? cnt : 1u;
}
__device__ __forceinline__ void xcd_barrier(const XcdBarrier& b_) {
    XcdBarrier b = b_; { const unsigned long long v = (unsigned long long)b.bar; unsigned lo = __builtin_amdgcn_readfirstlane((unsigned)v), hi = __builtin_amdgcn_readfirstlane((unsigned)(v >> 32)); asm volatile("" : "+s"(lo), "+s"(hi)); b.bar = (unsigned*)(((unsigned long long)hi << 32) | lo); unsigned xx = __builtin_amdgcn_readfirstlane(b.x); asm volatile("" : "+s"(xx)); b.x = xx; }
    asm volatile("s_waitcnt vmcnt(0)" ::: "memory");
    __syncthreads();
    if (threadIdx.x == 0) {
        unsigned* bar = b.bar;
        __builtin_amdgcn_s_waitcnt(0);
        unsigned nloc = b.st[0], nx = b.st[1];
        if (nloc == 0u) { xcd_barrier_complete(bar, b.x, nloc, nx); b.st[0] = nloc; b.st[1] = nx; }
        const unsigned old = xb_add(&bar[XB_XSUB(b.x)], 1u);
        const unsigned gen = old / nloc;
        if (old + 1u == (gen + 1u) * nloc) {
            __builtin_amdgcn_fence(__ATOMIC_RELEASE, "agent");
            asm volatile("s_waitcnt vmcnt(0)" ::: "memory");
            const unsigned og = xb_add(&bar[XB_TOP], 1u);
            const unsigned tg = og / nx;
            if (og + 1u == (tg + 1u) * nx) xb_add(&bar[XB_TOPGEN], 1u);
            else XB_SPIN(xb_ld(&bar[XB_TOPGEN]) == tg, bar);
            __builtin_amdgcn_fence(__ATOMIC_ACQUIRE, "agent");
            xb_add(&bar[XB_XGEN(b.x)], 1u);
            asm volatile("s_waitcnt vmcnt(0)" ::: "memory");
        } else {
            XB_SPIN(xb_ld(&bar[XB_XGEN(b.x)]) == gen, bar);
            __builtin_amdgcn_fence(__ATOMIC_ACQUIRE, "agent");
            asm volatile("s_waitcnt vmcnt(0)" ::: "memory");
        }
    }
    __syncthreads();
}

namespace pg8 {
constexpr int BM = 256, BK = 64, HALF = 128, HTB = HALF * BK * 2, STAGE_BYTES = 8 * HTB, NXCD = 8, WGM = 8;
__host__ __device__ __forceinline__ int lds_byte(int r, int c) { const int st = (r >> 4) * 2 + (c >> 5), rr = r & 15, cc = c & 31, ob = rr * 64 + cc * 2; return st * 1024 + (ob ^ (((ob >> 9) & 1) << 5)); }
__host__ __device__ __forceinline__ void stage_rc(int b, int& R, int& C) { const int st = b / 1024, sb = b % 1024, swz = sb ^ (((sb >> 9) & 1) << 5); R = (st >> 1) * 16 + swz / 64; C = (st & 1) * 32 + (swz % 64) / 2; }
__host__ __device__ __forceinline__ int perm32(int rho) { const int n = rho >> 4, i = rho & 15; return 8 * (i >> 2) + 4 * n + (i & 3); }
struct Unit { int pm, pn; const char* a; const char* b; };

struct StaticOrder {
    int nM, nN, nwg, G, c, K; const char* A; const char* B;
    __device__ void init(const bf16_t* A_, const bf16_t* B_, int M, int N, int K_, int G_, int c_) { A = (const char*)A_; B = (const char*)B_; K = K_; nM = M / BM; nN = N / BM; nwg = nM * nN; G = G_; c = c_; }
    __device__ bool next(int i, Unit& u) const {
        const long L = (long)i * G + c; if (L >= nwg) return false;
        int wgid = (int)L; { const int q = nwg / NXCD, r = nwg % NXCD, xcd = wgid % NXCD, off = wgid / NXCD; wgid = (xcd < r ? xcd * (q + 1) : r * (q + 1) + (xcd - r) * q) + off; }
        const int nig = WGM * nN, gid = wgid / nig, fm = gid * WGM, gsz = (nM - fm) < WGM ? (nM - fm) : WGM;
        u.pm = fm + ((wgid % nig) % gsz); u.pn = (wgid % nig) / gsz;
        u.a = A + (size_t)u.pm * 256 * K * 2; u.b = B + (size_t)u.pn * 256 * K * 2; return true;
    }
};

template <class Epi, class Sched, bool GATHER = false>
__device__ __forceinline__ void gemm_phase(LAS unsigned char* lds, const int K_, const Sched& S, const Epi& E, const char* Aall = nullptr, const int* arow = nullptr) {
    int K = K_; asm volatile("" : "+s"(K));
    int tid_ = threadIdx.x; asm volatile("" : "+v"(tid_));
    const int tid = tid_, wid = __builtin_amdgcn_readfirstlane(tid >> 6), lane = tid & 63, wr = wid >> 2, wc = wid & 3, fr = lane & 15, fq = lane >> 4;
    const int nt = K / BK;
    unsigned voffA[2], voffB[2]; int Rst[2], Cst[2];
#pragma unroll
    for (int i = 0; i < 2; ++i) { int R, C; stage_rc(tid * 16 + i * 8192, R, C); const int Rb = Epi::PERM ? ((R & ~31) + perm32(R & 31)) : R; Rst[i] = R; Cst[i] = C;
        voffA[i] = (unsigned)(R * K + C) * 2u; voffB[i] = (unsigned)(Rb * K + C) * 2u; }
    unsigned gv[2][2], gn[2][2];
#define PG8_GOFF(dst, unit) do { _Pragma("unroll") for (int h_ = 0; h_ < 2; ++h_) _Pragma("unroll") for (int i_ = 0; i_ < 2; ++i_) { const int rr_ = arow[(unit).pm * BM + h_ * HALF + Rst[i_]]; \
        dst[h_][i_] = ((unsigned)(rr_ < 0 ? 0 : rr_ >> 1) * (unsigned)K + (unsigned)Cst[i_]) * 2u; } } while (0)
    const size_t kstep = (size_t)(BK * 2);
    const size_t hstep = (size_t)HALF * K * 2;
    const unsigned ldsw = (unsigned)wid * 1024u;
    const int aoff = lds_byte(wr * 64 + fr, fq * 8), boff = lds_byte(wc * 32 + fr, fq * 8);
#define PG8_SA(b, h) (((b) * 2 + (h)) * HTB)
#define PG8_SB(b, h) ((4 + (b) * 2 + (h)) * HTB)
#define PG8_STAGE(bufoff, gbase, voff) do { _Pragma("unroll") for (int _i = 0; _i < 2; ++_i) \
        __builtin_amdgcn_global_load_lds((const unsigned*)((const char*)(gbase) + (voff)[_i]), (LAS unsigned*)(lds + (bufoff) + ldsw + _i * 8192), 16, 0, 0); } while (0)
#define PG8_LDA(dst, b, h) do { _Pragma("unroll") for (int m = 0; m < 4; ++m) _Pragma("unroll") for (int k = 0; k < 2; ++k) dst[m][k] = *(const LAS bf16x8*)(lds + PG8_SA(b, h) + aoff + m * 2048 + k * 1024); } while (0)
#define PG8_LDB(dst, b, h) do { _Pragma("unroll") for (int n = 0; n < 2; ++n) _Pragma("unroll") for (int k = 0; k < 2; ++k) dst[n][k] = *(const LAS bf16x8*)(lds + PG8_SB(b, h) + boff + n * 2048 + k * 1024); } while (0)
#define PG8_MMA(ai, bj, At, Bt) do { __builtin_amdgcn_s_setprio(1); _Pragma("unroll") for (int m = 0; m < 4; ++m) _Pragma("unroll") for (int n = 0; n < 2; ++n) _Pragma("unroll") for (int k = 0; k < 2; ++k) \
        acc[ai][bj][m][n] = __builtin_amdgcn_mfma_f32_16x16x32_bf16(Bt[n][k], At[m][k], acc[ai][bj][m][n], 0, 0, 0); __builtin_amdgcn_s_setprio(0); } while (0)
#define PG8_WAIT_V(n) asm volatile("s_waitcnt vmcnt(" #n ")" ::: "memory")
#define PG8_WAIT_L(n) asm volatile("s_waitcnt lgkmcnt(" #n ")" ::: "memory")
#define PG8_BAR __builtin_amdgcn_s_barrier()
#define PG8_SCHED __builtin_amdgcn_sched_barrier(0)
    Unit cur, nxt; int ui = 0;
    if (!S.next(0, cur)) return;
    f32x4 acc[2][2][4][2];
#pragma unroll
    for (int a = 0; a < 2; ++a)
#pragma unroll
        for (int b = 0; b < 2; ++b)
#pragma unroll
            for (int m = 0; m < 4; ++m)
#pragma unroll
                for (int n = 0; n < 2; ++n) acc[a][b][m][n] = (f32x4){0.f, 0.f, 0.f, 0.f};
    bf16x8 At[4][2], B0[2][2], B1[2][2];
    const char* cA = GATHER ? Aall : cur.a; const char* cB = cur.b;
    if (GATHER) PG8_GOFF(gv, cur);
#define PG8_STAGE_A(bufoff, gbase, h, vo) do { if (GATHER) PG8_STAGE(bufoff, gbase, (vo)[h]); else PG8_STAGE(bufoff, (gbase) + ((h) ? hstep : 0), voffA); } while (0)
    PG8_STAGE(PG8_SB(0, 0), cB, voffB); PG8_STAGE_A(PG8_SA(0, 0), cA, 0, gv); PG8_STAGE(PG8_SB(0, 1), cB + hstep, voffB); PG8_STAGE_A(PG8_SA(0, 1), cA, 1, gv);
    if (wr == 1) PG8_BAR;
    PG8_WAIT_V(4); PG8_BAR;
    PG8_STAGE(PG8_SB(1, 0), cB + kstep, voffB); PG8_STAGE_A(PG8_SA(1, 0), cA + kstep, 0, gv); PG8_STAGE(PG8_SB(1, 1), cB + hstep + kstep, voffB);
    PG8_WAIT_V(6); PG8_BAR;
    for (;;) {
        const bool has_next = S.next(ui + 1, nxt);
        const char* nA = GATHER ? cA : (has_next ? nxt.a : cA); const char* nB = has_next ? nxt.b : cB;
        if (GATHER) { if (has_next) PG8_GOFF(gn, nxt); else {
#pragma unroll
            for (int h_ = 0; h_ < 2; ++h_)
#pragma unroll
                for (int i_ = 0; i_ < 2; ++i_) gn[h_][i_] = gv[h_][i_]; } }
        for (int t = 0; t < nt; t += 2) {
            const bool last = (t == nt - 2);
            const char* a1 = cA + (size_t)(t + 1) * kstep;
            const char* a2 = last ? nA : cA + (size_t)(t + 2) * kstep; const char* b2 = last ? nB : cB + (size_t)(t + 2) * kstep;
            const char* a3 = a2 + kstep; const char* b3 = b2 + kstep;
            unsigned vo2[2][2];
#pragma unroll
            for (int h_ = 0; h_ < 2; ++h_)
#pragma unroll
                for (int i_ = 0; i_ < 2; ++i_) vo2[h_][i_] = GATHER ? (last ? gn[h_][i_] : gv[h_][i_]) : 0u;
            PG8_LDB(B0, 0, 0); PG8_SCHED; PG8_LDA(At, 0, 0); PG8_STAGE_A(PG8_SA(1, 1), a1, 1, gv);
            PG8_WAIT_L(8); PG8_BAR; PG8_WAIT_L(0); PG8_MMA(0, 0, At, B0); PG8_BAR; PG8_SCHED;
            PG8_LDB(B1, 0, 1); PG8_STAGE(PG8_SB(0, 0), b2, voffB);
            PG8_BAR; PG8_WAIT_L(0); PG8_MMA(0, 1, At, B1); PG8_BAR;
            PG8_LDA(At, 0, 1); PG8_STAGE_A(PG8_SA(0, 0), a2, 0, vo2);
            PG8_BAR; PG8_WAIT_L(0); PG8_MMA(1, 0, At, B0); PG8_BAR; PG8_SCHED;
            PG8_STAGE(PG8_SB(0, 1), b2 + hstep, voffB);
            PG8_WAIT_V(6); PG8_BAR; PG8_MMA(1, 1, At, B1); PG8_BAR;
            PG8_LDB(B0, 1, 0); PG8_SCHED; PG8_LDA(At, 1, 0); PG8_STAGE_A(PG8_SA(0, 1), a2, 1, vo2);
            PG8_WAIT_L(8); PG8_BAR; PG8_WAIT_L(0); PG8_MMA(0, 0, At, B0); PG8_BAR; PG8_SCHED;
            PG8_LDB(B1, 1, 1); PG8_STAGE(PG8_SB(1, 0), b3, voffB);
            PG8_BAR; PG8_WAIT_L(0); PG8_MMA(0, 1, At, B1); PG8_BAR;
            PG8_LDA(At, 1, 1); PG8_STAGE_A(PG8_SA(1, 0), a3, 0, vo2);
            PG8_BAR; PG8_WAIT_L(0); PG8_MMA(1, 0, At, B0); PG8_BAR; PG8_SCHED;
            PG8_STAGE(PG8_SB(1, 1), b3 + hstep, voffB);
            PG8_WAIT_V(6); PG8_BAR; PG8_MMA(1, 1, At, B1); PG8_BAR;
        }
        E(acc, cur, wr, wc, fr, fq);
        if (!has_next) break;
#pragma unroll
        for (int a = 0; a < 2; ++a)
#pragma unroll
            for (int b = 0; b < 2; ++b)
#pragma unroll
                for (int m = 0; m < 4; ++m)
#pragma unroll
                    for (int n = 0; n < 2; ++n) acc[a][b][m][n] = (f32x4){0.f, 0.f, 0.f, 0.f};
        cur = nxt; cA = nA; cB = nB; ++ui;
        if (GATHER) {
#pragma unroll
            for (int h_ = 0; h_ < 2; ++h_)
#pragma unroll
                for (int i_ = 0; i_ < 2; ++i_) gv[h_][i_] = gn[h_][i_]; }
    }
    PG8_WAIT_V(0);
    if (wr == 0) PG8_BAR;
    PG8_BAR;
#undef PG8_SA
#undef PG8_SB
#undef PG8_STAGE
#undef PG8_STAGE_A
#undef PG8_GOFF
#undef PG8_LDA
#undef PG8_LDB
#undef PG8_MMA
#undef PG8_WAIT_V
#undef PG8_WAIT_L
#undef PG8_BAR
#undef PG8_SCHED
}

struct EpiBf16 {
    static constexpr bool PERM = true;
    bf16_t* O; int ldc;
    __device__ __forceinline__ void operator()(const f32x4 (&acc)[2][2][4][2], const Unit& u, int wr, int wc, int fr, int fq) const {
        const int row0 = u.pm * BM + wr * 64 + fr, col0 = u.pn * BM + wc * 32 + 8 * fq;
#pragma unroll
        for (int ai = 0; ai < 2; ++ai)
#pragma unroll
            for (int m = 0; m < 4; ++m) { bf16_t* rowp = O + (size_t)(row0 + ai * HALF + m * 16) * ldc + col0;
#pragma unroll
                for (int bj = 0; bj < 2; ++bj) { const f32x4 v0 = acc[ai][bj][m][0], v1 = acc[ai][bj][m][1];
                    u32x4 w; w.x = cvt_pk_bf16(v0[0], v0[1]); w.y = cvt_pk_bf16(v0[2], v0[3]); w.z = cvt_pk_bf16(v1[0], v1[1]); w.w = cvt_pk_bf16(v1[2], v1[3]);
                    st16_wt(rowp + bj * HALF, w); } }
    }
};
struct EpiResid {
    static constexpr bool PERM = false;
    const float* Cin; float* C; int ldc;
    __device__ __forceinline__ void operator()(const f32x4 (&acc)[2][2][4][2], const Unit& u, int wr, int wc, int fr_, int fq_) const {
        int fr = fr_, fq = fq_; asm volatile("" : "+v"(fr), "+v"(fq));
        const int row0 = u.pm * BM + wr * 64 + fr, col0 = u.pn * BM + wc * 32 + 4 * fq;
#pragma unroll
        for (int ai = 0; ai < 2; ++ai)
#pragma unroll
            for (int mp = 0; mp < 2; ++mp) { f32x4 cv[2][2][2];
#pragma unroll
                for (int mm = 0; mm < 2; ++mm) { const float* rowp = Cin + (size_t)(row0 + ai * HALF + (2 * mp + mm) * 16) * ldc + col0;
#pragma unroll
                    for (int bj = 0; bj < 2; ++bj)
#pragma unroll
                        for (int n = 0; n < 2; ++n) cv[mm][bj][n] = *(const f32x4*)(rowp + bj * HALF + n * 16); }
#pragma unroll
                for (int mm = 0; mm < 2; ++mm) { float* rowp = C + (size_t)(row0 + ai * HALF + (2 * mp + mm) * 16) * ldc + col0;
#pragma unroll
                    for (int bj = 0; bj < 2; ++bj)
#pragma unroll
                        for (int n = 0; n < 2; ++n) { const f32x4 o_ = cv[mm][bj][n] + acc[ai][bj][2 * mp + mm][n]; st16_wt(rowp + bj * HALF + n * 16, __builtin_bit_cast(u32x4, o_)); } }
                asm volatile("" ::: "memory"); }
    }
};
template <int ACT  > struct EpiGated {
    static constexpr bool PERM = true;
    bf16_t* O; int ldo; int coloff; const float* ba; const float* bb;
    __device__ __forceinline__ void operator()(const f32x4 (&acc)[2][2][4][2], const Unit& u, int wr, int wc, int fr, int fq) const {
        const int row0 = u.pm * BM + wr * 64 + fr, cl = u.pn * HALF + wc * 32 + 8 * fq;
        float va[8], vb[8];
#pragma unroll
        for (int j = 0; j < 8; ++j) { va[j] = (ACT == 0) ? ba[cl + j] : 0.f; vb[j] = (ACT == 0) ? bb[cl + j] : 0.f; }
#pragma unroll
        for (int ai = 0; ai < 2; ++ai)
#pragma unroll
            for (int m = 0; m < 4; ++m) { bf16_t* rowp = O + (size_t)(row0 + ai * HALF + m * 16) * ldo + coloff + cl;
                float o[8];
#pragma unroll
                for (int n = 0; n < 2; ++n)
#pragma unroll
                    for (int j = 0; j < 4; ++j) { const float a = acc[ai][0][m][n][j] + va[4 * n + j], b = acc[ai][1][m][n][j] + vb[4 * n + j];
                        o[4 * n + j] = (ACT == 0) ? a * sigmoidf_(b) : siluf_(a) * b; }
                u32x4 w; w.x = cvt_pk_bf16(o[0], o[1]); w.y = cvt_pk_bf16(o[2], o[3]); w.z = cvt_pk_bf16(o[4], o[5]); w.w = cvt_pk_bf16(o[6], o[7]);
                st16_wt(rowp, w); asm volatile("" ::: "memory"); }
    }
};
struct EpiMoeOut {
    static constexpr bool PERM = true;
    bf16_t* O; const int* row_tok; const float* row_w; LAS unsigned char* lds;
    __device__ __forceinline__ void operator()(const f32x4 (&acc)[2][2][4][2], const Unit& u, int wr, int wc, int fr_, int fq_) const {
        int fr = fr_, fq = fq_; asm volatile("" : "+v"(fr), "+v"(fq));
        const int col0 = u.pn * BM + wc * 32 + 8 * fq, lane = fq * 16 + fr;
        LAS u32x2* rinfo = (LAS u32x2*)(lds + STAGE_BYTES) + (wr * 4 + wc) * 128;
        { const int ra = u.pm * BM + wr * 64 + lane, rb = ra + HALF;
          const u32x2 ia = (u32x2){(unsigned)row_tok[ra], __float_as_uint(row_w[ra])}, ib = (u32x2){(unsigned)row_tok[rb], __float_as_uint(row_w[rb])};
          rinfo[lane] = ia; rinfo[64 + lane] = ib; }
#pragma unroll
        for (int ai = 0; ai < 2; ++ai)
#pragma unroll
            for (int m = 0; m < 4; ++m) { const u32x2 inf = rinfo[ai * 64 + m * 16 + fr]; const int ts = (int)inf.x; const float w = __uint_as_float(inf.y);
                if (ts >= 0) { bf16_t* rowp = O + ((size_t)(ts & 1) * NTOK + (size_t)(ts >> 1)) * DM + col0;
#pragma unroll
                    for (int bj = 0; bj < 2; ++bj) { const f32x4 v0 = acc[ai][bj][m][0] * w, v1 = acc[ai][bj][m][1] * w;
                        u32x4 q; q.x = cvt_pk_bf16(v0[0], v0[1]); q.y = cvt_pk_bf16(v0[2], v0[3]); q.z = cvt_pk_bf16(v1[0], v1[1]); q.w = cvt_pk_bf16(v1[2], v1[3]);
                        st16_wt(rowp + bj * HALF, q); } } }
    }
};
struct MoeOrder {
    int K; const char* A; const char* B; size_t bstride; const LAS int* list;
    static __device__ __forceinline__ void build(LAS int* list, const int* tiles, int nN, int G, int c) {
        const int nrt = tiles[0], nwg = nrt * nN; int n = 0;
        for (int i = 0; ; ++i) { const long L = (long)i * G + c; if (L >= (long)nwg || n >= 20) break;
            int wgid = (int)L; { const int q = nwg / NXCD, r = nwg % NXCD, xcd = wgid % NXCD, off = wgid / NXCD; wgid = (xcd < r ? xcd * (q + 1) : r * (q + 1) + (xcd - r) * q) + off; }
            const int pm = wgid / nN; list[1 + 3 * n] = pm; list[2 + 3 * n] = wgid % nN; list[3 + 3 * n] = tiles[64 + pm]; ++n; }
        list[0] = n;
    }
    __device__ bool next(int i, Unit& u) const {
        const int n = __builtin_amdgcn_readfirstlane(list[0]); if (i >= n) return false;
        u.pm = __builtin_amdgcn_readfirstlane(list[1 + 3 * i]); u.pn = __builtin_amdgcn_readfirstlane(list[2 + 3 * i]); const int e = __builtin_amdgcn_readfirstlane(list[3 + 3 * i]);
        u.a = A + (size_t)u.pm * 256 * K * 2; u.b = B + (size_t)e * bstride + (size_t)u.pn * 256 * K * 2; return true;
    }
};
}

struct Params { const float* in[44]; float* out; unsigned char* ws; int ph_lo, ph_hi; };
enum { I_X = 0, I_NORM1, I_WIN, I_MCONVW, I_MCONVB, I_MDTB, I_MALOG, I_MD, I_MNORM, I_RMU, I_RW0, I_RW2, I_RA0, I_RA2, I_RG2, I_RKK, I_RKA, I_RRK, I_RLNW, I_RLNB,
       I_CKVN, I_CWUK, I_CWUV, I_RELB, I_SARE, I_SAIM, I_SBRE, I_SBIM, I_SCRE, I_SCIM, I_SD, I_SLOGDT, I_SGLUW, I_SGLUB, I_WOUT, I_NORM2, I_WRG, I_BRG, I_WRE, I_BRE,
       I_WGATE, I_WUP, I_WDOWN, I_FNORM };

typedef const float* const __attribute__((address_space(4)))* in_tab_t;
struct Frame {
    LAS unsigned char* lds; int tid, lane, wave, bid, G;
    in_tab_t in; float* out; unsigned char* ws; unsigned* ctl;
    volatile LAS int* misc;
};

__device__ __forceinline__ int q_pop(Frame& F, int qi) {
    __syncthreads();
    if (F.tid == 0) F.misc[0] = (int)__hip_atomic_fetch_add(F.ctl + CW_Q + 64 * qi, 1u, __ATOMIC_RELAXED, __HIP_MEMORY_SCOPE_AGENT);
    __syncthreads();
    return F.misc[0];
}

__device__ __forceinline__ const void* opaque_ptr(const void* p) { const unsigned long long v = (unsigned long long)p; unsigned lo = __builtin_amdgcn_readfirstlane((unsigned)v), hi = __builtin_amdgcn_readfirstlane((unsigned)(v >> 32));
    asm volatile("" : "+s"(lo), "+s"(hi)); return (const void*)(((unsigned long long)hi << 32) | lo); }
__device__ __forceinline__ Frame relocal(const Frame& G) { Frame F = G; asm volatile("" : "+v"(F.tid)); F.ws = (unsigned char*)opaque_ptr(F.ws); F.ctl = (unsigned*)(F.ws + WS_CTL); F.in = (in_tab_t)(unsigned long long)opaque_ptr((const void*)(unsigned long long)F.in); F.lane = F.tid & 63; F.wave = __builtin_amdgcn_readfirstlane(F.tid >> 6); return F; }
template <int K> __device__ __forceinline__ f32x4 mma_nt(const LAS bf16_t* A, int lda, const LAS bf16_t* Bt, int ldb, f32x4 acc, int lane) {
    const int r = lane & 15, g = lane >> 4;
#pragma unroll
    for (int k0 = 0; k0 < K; k0 += 32) {
        const bf16x8 a = *(const LAS bf16x8*)(A + r * lda + k0 + 8 * g);
        const bf16x8 b = *(const LAS bf16x8*)(Bt + r * ldb + k0 + 8 * g);
        acc = __builtin_amdgcn_mfma_f32_16x16x32_bf16(a, b, acc, 0, 0, 0);
    }
    return acc;
}

template <class SrcMap> __device__ __forceinline__ void tr_tile(Frame& F, int ldsrc, bf16_t* dst, int K, int k0, int n0, SrcMap sm) {
    LAS float* tile = (LAS float*)F.lds;
    __syncthreads();
    { const int n4 = (F.tid & 63) * 4, kk = F.tid >> 6; const float* sp = sm(n0 + n4);
      f32x4 v[8];
#pragma unroll
      for (int ps = 0; ps < 8; ++ps) { v[ps] = (f32x4){0.f, 0.f, 0.f, 0.f}; if (sp) v[ps] = __builtin_nontemporal_load((const f32x4*)(sp + (size_t)(k0 + kk + 8 * ps) * ldsrc)); }
#pragma unroll
      for (int ps = 0; ps < 8; ++ps) { LAS float* t = tile + (kk + 8 * ps) * 257 + n4; t[0] = v[ps][0]; t[1] = v[ps][1]; t[2] = v[ps][2]; t[3] = v[ps][3]; } }
    __syncthreads();
    { const int kc = F.tid & 7;
#pragma unroll
      for (int j = 0; j < 4; ++j) { const int n = (F.tid >> 3) + 64 * j; float f[8];
#pragma unroll
          for (int i = 0; i < 8; ++i) f[i] = tile[(8 * kc + i) * 257 + n];
          u32x4 w; w.x = pk2(f[0], f[1]); w.y = pk2(f[2], f[3]); w.z = pk2(f[4], f[5]); w.w = pk2(f[6], f[7]);
          *(u32x4*)(dst + (size_t)(n0 + n) * K + k0 + 8 * kc) = w; } }
}

struct SmIn { const float* base; __device__ __forceinline__ const float* operator()(int n) const {
    int c; if (n < 772) c = n; else if (n < UR) return nullptr; else if (n < UR + 896) c = 772 + (n - UR); else if (n < UC) return nullptr;
    else if (n < UC + 680) c = 1668 + (n - UC); else if (n < US) return nullptr; else if (n < US + 256) c = 2348 + (n - US); else return nullptr; return base + c; } };
struct SmId { const float* base; __device__ __forceinline__ const float* operator()(int n) const { return base + n; } };
struct SmGlu { const float* base; __device__ __forceinline__ const float* operator()(int n) const { const int pn = n >> 8, rr = n & 255; return base + (rr < 128 ? 128 * pn + rr : 256 + 128 * pn + (rr - 128)); } };
struct SmGU { const float* gate; const float* up; __device__ __forceinline__ const float* operator()(int n) const {
    const unsigned long long d = (unsigned long long)up - (unsigned long long)gate; const unsigned long long a = (unsigned long long)gate + (((n & 255) < 128) ? 0ull : d); return (const float*)a + 128 * (n >> 8) + (n & 127); } };
__device__ __forceinline__ void phase_prologue(const Frame& F_) { Frame F = relocal(F_);
    for (int t = F.bid; t < 496; t += F.G) {
        if (t < 352) { const int l = t / 176, r = t % 176, kt = r / 11, nt = r % 11;
            tr_tile(F, NIN, (bf16_t*)(F.ws + WS_WIN) + (size_t)l * NINP * DM, DM, kt * 64, nt * 256, SmIn{F.in[I_WIN] + (size_t)l * DM * NIN}); }
        else if (t < 480) { const int q = t - 352, l = q / 64, r = q % 64, kt = r / 4, nt = r % 4;
            tr_tile(F, DM, (bf16_t*)(F.ws + WS_WOUT) + (size_t)l * DM * DM, DM, kt * 64, nt * 256, SmId{F.in[I_WOUT] + (size_t)l * DM * DM}); }
        else { const int q = t - 480, l = q / 8, r = q % 8, kt = r / 2, nt = r % 2;
            tr_tile(F, 512, (bf16_t*)(F.ws + WS_GLU) + (size_t)l * 512 * 256, 256, kt * 64, nt * 256, SmGlu{F.in[I_SGLUW] + (size_t)l * 256 * 512}); }
    }
    for (int i = F.bid * NTHR + F.tid; i < 2 * 48 * 1024; i += F.G * NTHR) { const int l = i / 49152, r = i % 49152, o = r >> 10, k = r & 1023;
        float v = 0.f; if (o < 32) v = F.in[I_WRE][((size_t)l * DM + k) * 32 + o]; else if (o < 36) v = F.in[I_WRG][((size_t)l * DM + k) * 4 + (o - 32)];
        v *= F.in[I_NORM2][l * DM + k];
        const bf16_t hi = f2bf(v); const bf16_t lo = f2bf(v - bf2f(hi));
        bf16_t* w = (bf16_t*)(F.ws + WS_WRT) + (size_t)l * 2 * 49152; w[r] = hi; w[49152 + r] = lo; }
    for (int i = F.bid * NTHR + F.tid; i < 2048 + 65536; i += F.G * NTHR) {
        if (i < 2048) {
            const int l = i >> 10, gn = i & 1023, g = gn >> 6;
            float* tab = (float*)(F.ws + WS_S5TAB + (size_t)l * S5TAB_L);
            const float lre = fminf(F.in[I_SARE][l * 1024 + gn], -1e-4f), lim = F.in[I_SAIM][l * 1024 + gn];
            const float dt = expf(F.in[I_SLOGDT][l * 16 + g]);
            const float mag = expf(dt * lre); float sn, cs; sincosf(dt * lim, &sn, &cs);
            const float are = mag * cs, aim = mag * sn;
            const float den = lre * lre + lim * lim;
            const float fre = ((are - 1.0f) * lre + aim * lim) / den, fim = (aim * lre - (are - 1.0f) * lim) / den;
            tab[gn * 2] = are; tab[gn * 2 + 1] = aim;
            float pr = are, pi = aim;
#pragma unroll
            for (int s = 0; s < 6; ++s) { const float nr = pr * pr - pi * pi, ni = 2.0f * pr * pi; pr = nr; pi = ni; }
            tab[2048 + gn * 2] = pr; tab[2048 + gn * 2 + 1] = pi;
            const float* bre = F.in[I_SBRE] + ((size_t)l * 1024 + gn) * 16; const float* bim = F.in[I_SBIM] + ((size_t)l * 1024 + gn) * 16;
            bf16_t* bbt = (bf16_t*)(F.ws + WS_S5TAB + (size_t)l * S5TAB_L + S5TAB_BBT); const int n = gn & 63, col = 4 * (n & 31) + 2 * (n >> 5);
            for (int p = 0; p < 16; ++p) { const float vr = fre * bre[p] - fim * bim[p], vi = fre * bim[p] + fim * bre[p];
                bbt[((size_t)g * 128 + col) * 16 + p] = f2bf(vr); bbt[((size_t)g * 128 + col + 1) * 16 + p] = f2bf(vi); }
        } else {
            const int j = i - 2048, l = j >> 15, r = j & 32767, gp = r >> 7, k = r & 127;
            bf16_t* cm = (bf16_t*)(F.ws + WS_S5TAB + (size_t)l * S5TAB_L + S5TAB_F);
            const int n = (k >> 2) + 32 * ((k >> 1) & 1);
            const float v = (k & 1) == 0 ? F.in[I_SCRE][((size_t)l * 256 + gp) * 64 + n] : -F.in[I_SCIM][((size_t)l * 256 + gp) * 64 + n];
            cm[r] = f2bf(v);
        }
    }
}

__device__ __forceinline__ void phase_norm(const Frame& F_, const float* xin, bool add_o, const float* w, int mode) { Frame F = relocal(F_);
    float* X = (float*)(F.ws + WS_X); bf16_t* H = (bf16_t*)(F.ws + WS_H); const bf16_t* O = (const bf16_t*)(F.ws + WS_U);
    for (int row0 = F.bid * 32 + F.wave * 4; row0 < NTOK; row0 += F.G * 32) {
        f32x4 v[4][4]; u32x2 oa[4][4], ob[4][4];
#pragma unroll
        for (int r = 0; r < 4; ++r)
#pragma unroll
            for (int j = 0; j < 4; ++j) { const int c = 4 * F.lane + 256 * j; const size_t o = (size_t)(row0 + r) * DM + c; v[r][j] = (mode == 2) ? __builtin_nontemporal_load((const f32x4*)(xin + o)) : *(const f32x4*)(xin + o);
                if (add_o) { oa[r][j] = __builtin_nontemporal_load((const u32x2*)(O + o)); ob[r][j] = __builtin_nontemporal_load((const u32x2*)(O + (size_t)NTOK * DM + o)); } }
#pragma unroll
        for (int r = 0; r < 4; ++r) { const int row = row0 + r; float ss = 0.f;
#pragma unroll
            for (int j = 0; j < 4; ++j) {
                if (add_o) { const u32x2 a = oa[r][j], b = ob[r][j];
                    v[r][j][0] += __uint_as_float(a.x << 16) + __uint_as_float(b.x << 16); v[r][j][1] += __uint_as_float(a.x & 0xffff0000u) + __uint_as_float(b.x & 0xffff0000u);
                    v[r][j][2] += __uint_as_float(a.y << 16) + __uint_as_float(b.y << 16); v[r][j][3] += __uint_as_float(a.y & 0xffff0000u) + __uint_as_float(b.y & 0xffff0000u); }
                ss += v[r][j][0] * v[r][j][0] + v[r][j][1] * v[r][j][1] + v[r][j][2] * v[r][j][2] + v[r][j][3] * v[r][j][3]; }
            ss = wave_sum(ss);
            const float rstd = rsqrtf(ss * (1.0f / DM) + 1e-6f);
#pragma unroll
            for (int j = 0; j < 4; ++j) { const int c = 4 * F.lane + 256 * j; const f32x4 wv = *(const f32x4*)(w + c);
                if (mode == 2) { __builtin_nontemporal_store(v[r][j] * rstd * wv, (f32x4*)(F.out + (size_t)row * DM + c)); }
                else { if (mode == 0) *(f32x4*)(X + (size_t)row * DM + c) = v[r][j];
                    u32x2 o; o.x = pk2(v[r][j][0] * rstd * wv[0], v[r][j][1] * rstd * wv[1]); o.y = pk2(v[r][j][2] * rstd * wv[2], v[r][j][3] * rstd * wv[3]);
                    *(u32x2*)(H + (size_t)row * DM + c) = o; } } }
    }
}

__device__ __forceinline__ void item_kv(const Frame& F_, int layer, int item) { Frame F = relocal(F_);
    const bf16_t* U = (const bf16_t*)(F.ws + WS_U);
    LAS bf16_t* Ab = (LAS bf16_t*)F.lds;
    LAS bf16_t* Bt = (LAS bf16_t*)(F.lds + 17408);
    const int t0 = item * 64;
    { const int tok = F.tid >> 3, part = F.tid & 7; const bf16_t* src = U + (size_t)(t0 + tok) * NINP + UC + 256 + 16 * part;
      float f[16]; { float a[8], b[8]; unpack8(*(const u32x4*)src, a); unpack8(*(const u32x4*)(src + 8), b);
#pragma unroll
        for (int j = 0; j < 8; ++j) { f[j] = a[j]; f[8 + j] = b[j]; } }
      float ss = 0.f;
#pragma unroll
      for (int j = 0; j < 16; ++j) ss += f[j] * f[j];
      ss = sum8(ss);
      const float rstd = rsqrtf(ss * (1.0f / 128.0f) + 1e-6f); const float* nw = F.in[I_CKVN] + layer * 128 + 16 * part;
#pragma unroll
      for (int j = 0; j < 16; j += 2) *(LAS unsigned*)(Ab + tok * 136 + 16 * part + j) = pk2(f[j] * rstd * nw[j], f[j + 1] * rstd * nw[j + 1]); }
    { const int n = F.tid >> 2, kq = F.tid & 3; const float* w = (n < 64 ? F.in[I_CWUK] : F.in[I_CWUV]) + (size_t)layer * 128 * 64 + (n & 63);
      float wv[32];
#pragma unroll
      for (int k = 0; k < 32; ++k) wv[k] = w[(size_t)(32 * kq + k) * 64];
#pragma unroll
      for (int k = 0; k < 32; k += 2) *(LAS unsigned*)(Bt + n * 136 + 32 * kq + k) = pk2(wv[k], wv[k + 1]); }
    if (F.tid < 256) { const int tok = F.tid >> 2, q = F.tid & 3;
        *(u32x4*)((bf16_t*)(F.ws + WS_KIDX) + (size_t)(t0 + tok) * 32 + 8 * q) = *(const u32x4*)(U + (size_t)(t0 + tok) * NINP + UC + 640 + 8 * q); }
    __syncthreads();
    const int mt = F.wave & 3, g = F.lane >> 4, r = F.lane & 15;
#pragma unroll
    for (int q = 0; q < 4; ++q) { const int nt = (F.wave >> 2) * 4 + q;
        f32x4 acc = (f32x4){0.f, 0.f, 0.f, 0.f};
        acc = mma_nt<128>(Ab + mt * 16 * 136, 136, Bt + nt * 16 * 136, 136, acc, F.lane);
        const int n = nt * 16 + r; bf16_t* dst = (bf16_t*)(F.ws + (n < 64 ? WS_K : WS_V));
#pragma unroll
        for (int i = 0; i < 4; ++i) dst[(size_t)(t0 + mt * 16 + 4 * g + i) * 64 + (n & 63)] = f2bf(acc[i]); }
}

constexpr int MB_CG = 0, MB_BG = 18432, MB_BT = 36864, MB_XT = 55296, MB_M = 92160, MB_S0 = 101376, MB_DT = 110592, MB_AC = 111616, MB_RS = 112640;
template <int STAGE> __device__ __forceinline__ void item_mamba(const Frame& F_, int layer, int item) { Frame F = relocal(F_);
    const bf16_t* U = (const bf16_t*)(F.ws + WS_U);
    const int b = item >> 6, c = item & 63, l0 = c * 64; const size_t T0 = (size_t)b * SEQ + l0;
    LAS bf16_t* Cg = (LAS bf16_t*)(F.lds + MB_CG); LAS bf16_t* Bg = (LAS bf16_t*)(F.lds + MB_BG); LAS bf16_t* BT = (LAS bf16_t*)(F.lds + MB_BT);
    LAS bf16_t* XT = (LAS bf16_t*)(F.lds + MB_XT); LAS bf16_t* Mb = (LAS bf16_t*)(F.lds + MB_M); LAS bf16_t* S0 = (LAS bf16_t*)(F.lds + MB_S0);
    LAS float* dts = (LAS float*)(F.lds + MB_DT); LAS float* acs = (LAS float*)(F.lds + MB_AC); LAS float* rs = (LAS float*)(F.lds + MB_RS);
    if (F.tid < 256) { const int l = F.tid >> 2, h = F.tid & 3;
        const float raw = bf2f(U[(T0 + l) * NINP + UM + 768 + h]) + F.in[I_MDTB][layer * 4 + h];
        const float dt = softplusf_(raw); dts[l * 4 + h] = dt; acs[l * 4 + h] = -__expf(F.in[I_MALOG][layer * 4 + h]) * dt; }
    if (F.tid < 64) rs[F.tid] = 0.f;
    __syncthreads();
    float mycum = 0.f;
    if (F.tid < 256) { const int l = F.lane, h = F.wave; mycum = acs[l * 4 + h];
#pragma unroll
        for (int o = 1; o < 64; o <<= 1) { const float t = __int_as_float(__builtin_amdgcn_ds_bpermute(((lane_id_() - o) & 63) << 2, __float_as_int(mycum))); if (l >= o) mycum += t; } }
    __syncthreads();
    if (F.tid < 256) acs[F.lane * 4 + F.wave] = mycum;
    __syncthreads();
    { const int ch8 = F.tid & 63, tg = F.tid >> 6, c0 = ch8 * 8;
      float wv[4][8], bv[8];
#pragma unroll
      for (int j = 0; j < 8; ++j) { bv[j] = F.in[I_MCONVB][layer * 512 + c0 + j];
#pragma unroll
          for (int k = 0; k < 4; ++k) wv[k][j] = F.in[I_MCONVW][(layer * 4 + k) * 512 + c0 + j]; }
      float win[3][8];
#pragma unroll
      for (int k = 0; k < 3; ++k) { const int l = l0 + tg * 8 - 3 + k;
          if (l >= 0) unpack8(*(const u32x4*)(U + ((size_t)b * SEQ + l) * NINP + UM + 256 + c0), win[k]);
          else {
#pragma unroll
              for (int j = 0; j < 8; ++j) win[k][j] = 0.f; } }
#pragma unroll 1
      for (int ib = 0; ib < 2; ++ib) { u32x4 rows[4];
#pragma unroll
          for (int i4 = 0; i4 < 4; ++i4) rows[i4] = *(const u32x4*)(U + (T0 + tg * 8 + ib * 4 + i4) * NINP + UM + 256 + c0);
#pragma unroll
      for (int i4 = 0; i4 < 4; ++i4) { const int l = tg * 8 + ib * 4 + i4; float cur[8]; unpack8(rows[i4], cur);
          float o[8];
#pragma unroll
          for (int j = 0; j < 8; ++j) { o[j] = siluf_(bv[j] + wv[0][j] * win[0][j] + wv[1][j] * win[1][j] + wv[2][j] * win[2][j] + wv[3][j] * cur[j]);
              win[0][j] = win[1][j]; win[1][j] = win[2][j]; win[2][j] = cur[j]; }
          if (c0 < 256) { const int h = c0 >> 6, p0 = c0 & 63; float sc = dts[l * 4 + h]; if (STAGE == 1) sc *= __expf(acs[63 * 4 + h] - acs[l * 4 + h]);
#pragma unroll
              for (int j = 0; j < 8; ++j) XT[(h * 64 + p0 + j) * 72 + l] = f2bf(o[j] * sc); }
          else if (c0 < 384) { const int g = (c0 - 256) >> 6, n0 = (c0 - 256) & 63;
              if (STAGE == 1) {
#pragma unroll
                  for (int j = 0; j < 8; ++j) BT[(g * 64 + n0 + j) * 72 + l] = f2bf(o[j]); }
              else { u32x4 w; w.x = pk2(o[0], o[1]); w.y = pk2(o[2], o[3]); w.z = pk2(o[4], o[5]); w.w = pk2(o[6], o[7]); *(LAS u32x4*)(Bg + (g * 64 + l) * 72 + n0) = w; } }
          else if (STAGE == 2) { const int g = (c0 - 384) >> 6, n0 = (c0 - 384) & 63;
              u32x4 w; w.x = pk2(o[0], o[1]); w.y = pk2(o[2], o[3]); w.z = pk2(o[4], o[5]); w.w = pk2(o[6], o[7]); *(LAS u32x4*)(Cg + (g * 64 + l) * 72 + n0) = w; } } } }
    __syncthreads();
    const int g4 = F.lane >> 4, r16 = F.lane & 15;
    if (STAGE == 1) {
        float* MST = (float*)(F.ws + WS_MST) + ((size_t)(b * 64 + c) * 4) * 4096;
#pragma unroll
        for (int q = 0; q < 8; ++q) { const int tix = F.wave * 8 + q, h = tix >> 4, mt = (tix >> 2) & 3, nt = tix & 3;
            f32x4 acc = (f32x4){0.f, 0.f, 0.f, 0.f};
            acc = mma_nt<64>(XT + (h * 64 + mt * 16) * 72, 72, BT + ((h >> 1) * 64 + nt * 16) * 72, 72, acc, F.lane);
#pragma unroll
            for (int i = 0; i < 4; ++i) MST[(size_t)h * 4096 + (mt * 16 + 4 * g4 + i) * 64 + nt * 16 + r16] = acc[i]; }
        if (F.tid < 4) ((float*)(F.ws + WS_MDEC))[(b * 64 + c) * 4 + F.tid] = __expf(acs[63 * 4 + F.tid]);
    } else {
        const int mt = F.wave & 3, nh = F.wave >> 2;
        const float* MST = (const float*)(F.ws + WS_MST) + ((size_t)(b * 64 + c) * 4) * 4096;
        f32x4 G[2], yv[4][2];
#pragma unroll
        for (int h = 0; h < 4; ++h) {
            const int g = h >> 1;
            { const float* src = MST + (size_t)h * 4096 + F.tid * 8; const f32x4 a = *(const f32x4*)src, bq = *(const f32x4*)(src + 4);
              u32x4 w; w.x = pk2(a[0], a[1]); w.y = pk2(a[2], a[3]); w.z = pk2(bq[0], bq[1]); w.w = pk2(bq[2], bq[3]);
              *(LAS u32x4*)(S0 + (F.tid >> 3) * 72 + (F.tid & 7) * 8) = w; }
            if ((h & 1) == 0) {
#pragma unroll
                for (int q = 0; q < 2; ++q) { G[q] = (f32x4){0.f, 0.f, 0.f, 0.f};
                    G[q] = mma_nt<64>(Cg + (g * 64 + mt * 16) * 72, 72, Bg + (g * 64 + (2 * nh + q) * 16) * 72, 72, G[q], F.lane); } }
#pragma unroll
            for (int q = 0; q < 2; ++q) { const int s = (2 * nh + q) * 16 + r16; const float as = acs[s * 4 + h];
#pragma unroll
                for (int i = 0; i < 4; ++i) { const int l = mt * 16 + 4 * g4 + i; const float v = (s <= l) ? G[q][i] * __expf(acs[l * 4 + h] - as) : 0.f;
                    Mb[l * 72 + s] = f2bf(v); } }
            __syncthreads();
#pragma unroll
            for (int q = 0; q < 2; ++q) { const int nt = 2 * nh + q;
                f32x4 yd = (f32x4){0.f, 0.f, 0.f, 0.f}, yo = (f32x4){0.f, 0.f, 0.f, 0.f};
                yd = mma_nt<64>(Mb + mt * 16 * 72, 72, XT + (h * 64 + nt * 16) * 72, 72, yd, F.lane);
                yo = mma_nt<64>(Cg + (g * 64 + mt * 16) * 72, 72, S0 + nt * 16 * 72, 72, yo, F.lane);
                const int p = nt * 16 + r16; const float dsk = F.in[I_MD][layer * 4 + h];
#pragma unroll
                for (int i = 0; i < 4; ++i) { const int l = mt * 16 + 4 * g4 + i;
                    const float xs = bf2f(XT[(h * 64 + p) * 72 + l]) / dts[l * 4 + h];
                    yv[h][q][i] = yd[i] + yo[i] * __expf(acs[l * 4 + h]) + dsk * xs; } }
            __syncthreads();
        }
        float part[4] = {0.f, 0.f, 0.f, 0.f};
#pragma unroll
        for (int h = 0; h < 4; ++h)
#pragma unroll
            for (int q = 0; q < 2; ++q) { const int ch = h * 64 + (2 * nh + q) * 16 + r16;
#pragma unroll
                for (int i = 0; i < 4; ++i) { const int l = mt * 16 + 4 * g4 + i; const float z = bf2f(U[(T0 + l) * NINP + UM + ch]);
                    const float v = yv[h][q][i] * siluf_(z); yv[h][q][i] = v; part[i] += v * v; } }
#pragma unroll
        for (int i = 0; i < 4; ++i) { const float s = sum16(part[i]); if (r16 == 0) atomicAdd((float*)(rs + mt * 16 + 4 * g4 + i), s); }
        __syncthreads();
        bf16_t* Y = (bf16_t*)(F.ws + WS_H);
#pragma unroll
        for (int i = 0; i < 4; ++i) { const int l = mt * 16 + 4 * g4 + i; const float rstd = rsqrtf(rs[l] * (1.0f / 256.0f) + 1e-6f);
#pragma unroll
            for (int h = 0; h < 4; ++h)
#pragma unroll
                for (int q = 0; q < 2; ++q) { const int ch = h * 64 + (2 * nh + q) * 16 + r16;
                    Y[(T0 + l) * DM + ch] = f2bf(yv[h][q][i] * rstd * F.in[I_MNORM][layer * 256 + ch]); } }
    }
}
__device__ __forceinline__ void item_mamba_carry(const Frame& F_, int item) { Frame F = relocal(F_);
    const int b = item >> 2, h = item & 3;
    float* MST = (float*)(F.ws + WS_MST); const float* MD = (const float*)(F.ws + WS_MDEC);
    float s[8];
#pragma unroll
    for (int j = 0; j < 8; ++j) s[j] = 0.f;
    for (int c = 0; c < 64; ++c) { float* p = MST + ((size_t)(b * 64 + c) * 4 + h) * 4096 + F.tid * 8; const float d = MD[(b * 64 + c) * 4 + h];
        const f32x4 a = *(f32x4*)p, q = *(f32x4*)(p + 4);
        *(f32x4*)p = (f32x4){s[0], s[1], s[2], s[3]}; *(f32x4*)(p + 4) = (f32x4){s[4], s[5], s[6], s[7]};
        s[0] = s[0] * d + a[0]; s[1] = s[1] * d + a[1]; s[2] = s[2] * d + a[2]; s[3] = s[3] * d + a[3];
        s[4] = s[4] * d + q[0]; s[5] = s[5] * d + q[1]; s[6] = s[6] * d + q[2]; s[7] = s[7] * d + q[3]; }
}

template <int STAGE> __device__ __forceinline__ void item_s5(const Frame& F_, int layer, int item) { Frame F = relocal(F_);
    const bf16_t* U = (const bf16_t*)(F.ws + WS_U);
    const int b = item >> 6, c = item & 63; const size_t T0 = (size_t)b * SEQ + c * 64;
    LAS bf16_t* us = (LAS bf16_t*)F.lds;
    LAS bf16_t* BuW = (LAS bf16_t*)(F.lds + 33792) + F.wave * 4224;
    const float* tab = (const float*)(F.ws + WS_S5TAB + (size_t)layer * S5TAB_L);
    { const int tok = F.tid >> 3, part = F.tid & 7;
#pragma unroll
      for (int q = 0; q < 4; ++q) *(LAS u32x4*)(us + tok * 264 + 32 * part + 8 * q) = *(const u32x4*)(U + (T0 + tok) * NINP + US + 32 * part + 8 * q); }
    const int lane = F.lane, r16 = lane & 15, g4 = lane >> 4, gq = lane >> 5, n0 = lane & 31, g = 2 * F.wave + gq, gn0 = g * 64 + n0, gn1 = gn0 + 32;
    bf16x8 bfr[2][8];
    { const bf16_t* bbt = (const bf16_t*)(F.ws + WS_S5TAB + (size_t)layer * S5TAB_L + S5TAB_BBT);
#pragma unroll
      for (int gg = 0; gg < 2; ++gg)
#pragma unroll
          for (int nt = 0; nt < 8; ++nt) { u32x4 z = (u32x4){0u, 0u, 0u, 0u}; if (g4 < 2) z = *(const u32x4*)(bbt + ((size_t)(2 * F.wave + gg) * 128 + 16 * nt + r16) * 16 + 8 * g4); bfr[gg][nt] = __builtin_bit_cast(bf16x8, z); } }
    const float a0r = tab[gn0 * 2], a0i = tab[gn0 * 2 + 1], a1r = tab[gn1 * 2], a1i = tab[gn1 * 2 + 1];
    float* ST = (float*)(F.ws + WS_S5ST) + (size_t)(b * 64 + c) * 2048;
    float h0r = 0.f, h0i = 0.f, h1r = 0.f, h1i = 0.f;
    if (STAGE == 2) { h0r = ST[gn0 * 2]; h0i = ST[gn0 * 2 + 1]; h1r = ST[gn1 * 2]; h1i = ST[gn1 * 2 + 1]; }
    bf16x8 cf[2][4];
    if (STAGE == 2) { const bf16_t* cm = (const bf16_t*)(F.ws + WS_S5TAB + (size_t)layer * S5TAB_L + S5TAB_F);
#pragma unroll
        for (int gg = 0; gg < 2; ++gg)
#pragma unroll
            for (int ks = 0; ks < 4; ++ks) cf[gg][ks] = *(const bf16x8*)(cm + ((size_t)((2 * F.wave + gg) * 16 + r16)) * 128 + 32 * ks + 8 * g4); }
    __syncthreads();
#pragma unroll 1
    for (int lb = 0; lb < 4; ++lb) {
#pragma unroll
        for (int gg = 0; gg < 2; ++gg) { u32x4 z = (u32x4){0u, 0u, 0u, 0u}; if (g4 < 2) z = *(const LAS u32x4*)(us + (16 * lb + r16) * 264 + (2 * F.wave + gg) * 16 + 8 * g4);
            const bf16x8 afr = __builtin_bit_cast(bf16x8, z);
#pragma unroll
            for (int nt = 0; nt < 8; ++nt) { const f32x4 acc = __builtin_amdgcn_mfma_f32_16x16x32_bf16(afr, bfr[gg][nt], (f32x4){0.f, 0.f, 0.f, 0.f}, 0, 0, 0);
#pragma unroll
                for (int i = 0; i < 4; ++i) BuW[(4 * g4 + i) * 264 + gg * 128 + 16 * nt + r16] = f2bf(acc[i]); } }
        __syncthreads();
#pragma unroll 4
        for (int li = 0; li < 16; ++li) { LAS u32x2* bp = (LAS u32x2*)(BuW + li * 264 + gq * 128 + 4 * n0); const u32x2 v = *bp;
            { const float br = __uint_as_float(v.x << 16), bi = __uint_as_float(v.x & 0xffff0000u); const float nr = a0r * h0r - a0i * h0i + br, ni = a0r * h0i + a0i * h0r + bi; h0r = nr; h0i = ni; }
            { const float br = __uint_as_float(v.y << 16), bi = __uint_as_float(v.y & 0xffff0000u); const float nr = a1r * h1r - a1i * h1i + br, ni = a1r * h1i + a1i * h1r + bi; h1r = nr; h1i = ni; }
            if (STAGE == 2) *bp = (u32x2){pk2(h0r, h0i), pk2(h1r, h1i)}; }
        __syncthreads();
        if (STAGE == 2) {
            bf16_t* YS = (bf16_t*)(F.ws + WS_MOE + YSG_OFF);
#pragma unroll
            for (int gg = 0; gg < 2; ++gg) { f32x4 acc = (f32x4){0.f, 0.f, 0.f, 0.f};
#pragma unroll
                for (int ks = 0; ks < 4; ++ks) { const bf16x8 a = *(const LAS bf16x8*)(BuW + r16 * 264 + gg * 128 + 32 * ks + 8 * g4);
                    acc = __builtin_amdgcn_mfma_f32_16x16x32_bf16(a, cf[gg][ks], acc, 0, 0, 0); }
                const int ch = (2 * F.wave + gg) * 16 + r16; const float dsk = F.in[I_SD][layer * 256 + ch];
#pragma unroll
                for (int i = 0; i < 4; ++i) { const int l = lb * 16 + 4 * g4 + i; const float y = acc[i] + dsk * bf2f(us[l * 264 + ch]);
                    YS[(T0 + l) * 256 + ch] = f2bf(gelu_tanh(y)); } }
            __syncthreads();
        }
    }
    if (STAGE == 1) { ST[gn0 * 2] = h0r; ST[gn0 * 2 + 1] = h0i; ST[gn1 * 2] = h1r; ST[gn1 * 2 + 1] = h1i; }
    if (STAGE == 2) {
        asm volatile("s_waitcnt vmcnt(0)" ::: "memory"); __syncthreads();
        const bf16_t* YS = (const bf16_t*)(F.ws + WS_MOE + YSG_OFF) + T0 * 256; const bf16_t* GW = (const bf16_t*)(F.ws + WS_GLU) + (size_t)layer * 512 * 256;
        const int r16 = F.lane & 15, g4 = F.lane >> 4;
        f32x4 av[4][2], ag[4][2];
#pragma unroll
        for (int m = 0; m < 4; ++m)
#pragma unroll
            for (int q = 0; q < 2; ++q) { av[m][q] = (f32x4){0.f, 0.f, 0.f, 0.f}; ag[m][q] = (f32x4){0.f, 0.f, 0.f, 0.f}; }
#pragma unroll 2
        for (int ks = 0; ks < 8; ++ks) {
            bf16x8 af[4], bv[2], bg[2];
#pragma unroll
            for (int m = 0; m < 4; ++m) af[m] = *(const bf16x8*)(YS + (size_t)(16 * m + r16) * 256 + 32 * ks + 8 * g4);
#pragma unroll
            for (int q = 0; q < 2; ++q) { const int c = 32 * F.wave + 16 * q + r16; const int rowv = 256 * (c >> 7) + (c & 127);
                bv[q] = *(const bf16x8*)(GW + (size_t)rowv * 256 + 32 * ks + 8 * g4); bg[q] = *(const bf16x8*)(GW + (size_t)(rowv + 128) * 256 + 32 * ks + 8 * g4); }
#pragma unroll
            for (int m = 0; m < 4; ++m)
#pragma unroll
                for (int q = 0; q < 2; ++q) { av[m][q] = __builtin_amdgcn_mfma_f32_16x16x32_bf16(af[m], bv[q], av[m][q], 0, 0, 0); ag[m][q] = __builtin_amdgcn_mfma_f32_16x16x32_bf16(af[m], bg[q], ag[m][q], 0, 0, 0); }
        }
        bf16_t* Y = (bf16_t*)(F.ws + WS_H);
#pragma unroll
        for (int q = 0; q < 2; ++q) { const int c = 32 * F.wave + 16 * q + r16; const float bvl = F.in[I_SGLUB][layer * 512 + c], bgt = F.in[I_SGLUB][layer * 512 + 256 + c];
#pragma unroll
            for (int m = 0; m < 4; ++m)
#pragma unroll
                for (int i = 0; i < 4; ++i) Y[(T0 + 16 * m + 4 * g4 + i) * DM + 768 + c] = f2bf((av[m][q][i] + bvl) * sigmoidf_(ag[m][q][i] + bgt)); }
    }
}
__device__ __forceinline__ void item_s5_carry(const Frame& F_, int layer, int b) { Frame F = relocal(F_);
    const float* tab = (const float*)(F.ws + WS_S5TAB + (size_t)layer * S5TAB_L) + 2048;
    float* ST = (float*)(F.ws + WS_S5ST) + (size_t)b * 64 * 2048;
#pragma unroll
    for (int q = 0; q < 2; ++q) { const int gn = F.tid + 512 * q; const float pr = tab[gn * 2], pi = tab[gn * 2 + 1]; float hr = 0.f, hi = 0.f;
        for (int c = 0; c < 64; ++c) { float* p = ST + (size_t)c * 2048 + gn * 2; const float tr = p[0], ti = p[1]; p[0] = hr; p[1] = hi;
            const float nr = pr * hr - pi * hi + tr, ni = pr * hi + pi * hr + ti; hr = nr; hi = ni; } }
}

constexpr int RB_LD = 72;
constexpr int RW_R = 0, RW_K = 16384, RW_V = 32768, RW_W = 49152, RW_A = 65536, RW_B = 81920;
constexpr int R3_G = 49152, R3_O = 65536, R3_TILES = 81920, R3_BON = 147456;
template <int STAGE> __device__ __forceinline__ void rwkv_prep(const Frame& F_, int layer, int b, int h, int c) { Frame F = relocal(F_);
    const bf16_t* U = (const bf16_t*)(F.ws + WS_U);
    const int l0 = c * 64; const size_t T0 = (size_t)b * SEQ + l0;
    LAS float* Rr = (LAS float*)(F.lds + RW_R); LAS float* Kk = (LAS float*)(F.lds + RW_K); LAS float* Vv = (LAS float*)(F.lds + RW_V); LAS float* Ww = (LAS float*)(F.lds + RW_W);
    LAS float* Aa = (LAS float*)(F.lds + (STAGE == 1 ? RW_A : R3_O)); LAS float* Bb = (LAS float*)(F.lds + RW_B); LAS float* Gg = (LAS float*)(F.lds + R3_G); LAS float* BON = (LAS float*)(F.lds + R3_BON);
    LAS bf16_t* TWb = (LAS bf16_t*)(F.lds + 98304); LAS bf16_t* DAb = (LAS bf16_t*)(F.lds + (STAGE == 1 ? 103424 : 118784)); LAS bf16_t* SGb = (LAS bf16_t*)(F.lds + 123904);
    LAS bf16_t* w2T = (LAS bf16_t*)(F.lds + 108544); LAS bf16_t* a2T = (LAS bf16_t*)(F.lds + (STAGE == 1 ? 113664 : 133120)); LAS bf16_t* g2T = (LAS bf16_t*)(F.lds + 138240);
    const float* mu = F.in[I_RMU] + layer * 896;
    { const int tok = F.tid >> 3, p8 = F.tid & 7; const bool first = (l0 + tok == 0);
      const bf16_t* cur = U + (T0 + tok) * NINP + UR; const bf16_t* prv = first ? cur : cur - NINP;
      const float pz = first ? 0.f : 1.f;
      u32x4 cw[3], pw[3]; u32x2 c1 = (u32x2){0u, 0u}, p1 = (u32x2){0u, 0u}, c2 = (u32x2){0u, 0u}, p2 = (u32x2){0u, 0u}; u32x4 c3 = (u32x4){0u, 0u, 0u, 0u}, p3 = (u32x4){0u, 0u, 0u, 0u};
#pragma unroll
      for (int sec = (STAGE == 1 ? 0 : 2); sec < 3; ++sec) { const int co = sec * 256 + h * 64 + 8 * p8; cw[sec] = *(const u32x4*)(cur + co); pw[sec] = *(const u32x4*)(prv + co); }
      if (STAGE == 1) { c1 = *(const u32x2*)(cur + 768 + 4 * p8); p1 = *(const u32x2*)(prv + 768 + 4 * p8); c2 = *(const u32x2*)(cur + 800 + 4 * p8); p2 = *(const u32x2*)(prv + 800 + 4 * p8); }
      if (STAGE == 3) { c3 = *(const u32x4*)(cur + 832 + 8 * p8); p3 = *(const u32x4*)(prv + 832 + 8 * p8); }
#pragma unroll
      for (int sec = (STAGE == 1 ? 0 : 2); sec < 3; ++sec) { const int co = sec * 256 + h * 64 + 8 * p8; float av[8], pq[8]; unpack8(cw[sec], av); unpack8(pw[sec], pq);
          const f32x4 m0 = *(const f32x4*)(mu + co), m1 = *(const f32x4*)(mu + co + 4);
          LAS float* dst = (sec == 0 ? Rr : sec == 1 ? Kk : Vv) + tok * 64 + 8 * p8;
#pragma unroll
          for (int j = 0; j < 8; ++j) pq[j] *= pz;
          *(LAS f32x4*)dst = (f32x4){av[0] + m0[0] * (pq[0] - av[0]), av[1] + m0[1] * (pq[1] - av[1]), av[2] + m0[2] * (pq[2] - av[2]), av[3] + m0[3] * (pq[3] - av[3])};
          *(LAS f32x4*)(dst + 4) = (f32x4){av[4] + m1[0] * (pq[4] - av[4]), av[5] + m1[1] * (pq[5] - av[5]), av[6] + m1[2] * (pq[6] - av[6]), av[7] + m1[3] * (pq[7] - av[7])}; }
      if (STAGE == 1) {
#pragma unroll
        for (int which = 0; which < 2; ++which) { const int co = 768 + 32 * which + 4 * p8; const u32x2 cv = which ? c2 : c1, pv = which ? p2 : p1;
          const f32x4 m0 = *(const f32x4*)(mu + co);
          float x[4] = {__uint_as_float(cv.x << 16), __uint_as_float(cv.x & 0xffff0000u), __uint_as_float(cv.y << 16), __uint_as_float(cv.y & 0xffff0000u)};
          const float y[4] = {pz * __uint_as_float(pv.x << 16), pz * __uint_as_float(pv.x & 0xffff0000u), pz * __uint_as_float(pv.y << 16), pz * __uint_as_float(pv.y & 0xffff0000u)};
#pragma unroll
          for (int j = 0; j < 4; ++j) { x[j] = x[j] + m0[j] * (y[j] - x[j]); if (which == 0) x[j] = tanhf_(x[j]); }
          *(LAS u32x2*)((which ? DAb : TWb) + tok * 40 + 4 * p8) = (u32x2){pk2(x[0], x[1]), pk2(x[2], x[3])}; } }
      if (STAGE == 3) { const int co = 832 + 8 * p8; float av[8], pq[8]; unpack8(c3, av); unpack8(p3, pq);
          const f32x4 m0 = *(const f32x4*)(mu + co), m1 = *(const f32x4*)(mu + co + 4); float x[8];
#pragma unroll
          for (int j = 0; j < 8; ++j) x[j] = sigmoidf_(av[j] + (j < 4 ? m0[j] : m1[j - 4]) * (pz * pq[j] - av[j]));
          *(LAS u32x4*)(SGb + tok * RB_LD + 8 * p8) = (u32x4){pk2(x[0], x[1]), pk2(x[2], x[3]), pk2(x[4], x[5]), pk2(x[6], x[7])}; } }
    { const int ch = F.tid & 63, part = F.tid >> 6;
      if (STAGE == 1) { const float* w2 = F.in[I_RW2] + ((size_t)layer * 32 + 4 * part) * 256 + h * 64 + ch;
          *(LAS u32x2*)(w2T + ch * 40 + 4 * part) = (u32x2){pk2(w2[0], w2[256]), pk2(w2[512], w2[768])}; }
      if (STAGE == 1) { const float* a2 = F.in[I_RA2] + ((size_t)layer * 32 + 4 * part) * 256 + h * 64 + ch;
          *(LAS u32x2*)(a2T + ch * 40 + 4 * part) = (u32x2){pk2(a2[0], a2[256]), pk2(a2[512], a2[768])}; }
      if (STAGE == 3) { const float* g2 = F.in[I_RG2] + ((size_t)layer * 64 + 8 * part) * 256 + h * 64 + ch;
          *(LAS u32x4*)(g2T + ch * RB_LD + 8 * part) = (u32x4){pk2(g2[0], g2[256]), pk2(g2[512], g2[768]), pk2(g2[1024], g2[1280]), pk2(g2[1536], g2[1792])}; } }
    __syncthreads();
    { const int lane = F.lane, mt = F.wave >> 1, nt0 = 2 * (F.wave & 1), r = lane & 15, g4 = lane >> 4; const f32x4 zero4 = (f32x4){0.f, 0.f, 0.f, 0.f};
#pragma unroll
      for (int q = 0; q < 2; ++q) { const int nt = nt0 + q, ch = 16 * nt + r, cg = layer * 256 + h * 64 + ch;
          if (STAGE == 1) { const f32x4 wl = mma_nt<32>(TWb + 16 * mt * 40, 40, w2T + 16 * nt * 40, 40, zero4, lane); const float w0 = F.in[I_RW0][cg];
#pragma unroll
              for (int i = 0; i < 4; ++i) { const float x = w0 + wl[i]; const float wlog = -__logf(1.0f + __expf(-x)) - 0.5f; Ww[(16 * mt + 4 * g4 + i) * 64 + ch] = __expf(-__expf(wlog)); } }
          if (STAGE == 1) { const f32x4 al = mma_nt<32>(DAb + 16 * mt * 40, 40, a2T + 16 * nt * 40, 40, zero4, lane); const float a0 = F.in[I_RA0][cg];
#pragma unroll
              for (int i = 0; i < 4; ++i) Aa[(16 * mt + 4 * g4 + i) * 64 + ch] = sigmoidf_(a0 + al[i]); }
          if (STAGE == 3) { const f32x4 gv = mma_nt<64>(SGb + 16 * mt * RB_LD, RB_LD, g2T + 16 * nt * RB_LD, RB_LD, zero4, lane);
#pragma unroll
              for (int i = 0; i < 4; ++i) Gg[(16 * mt + 4 * g4 + i) * 64 + ch] = gv[i]; } } }
    __syncthreads();
    float* gBON = (float*)(F.ws + WS_BON) + ((size_t)(b * 4 + h) * 64 + c) * 64;
    if (STAGE == 1) { const int j = F.lane, tq = F.wave, cg = layer * 256 + h * 64 + j;
      const float kkw = F.in[I_RKK][cg], kaw = F.in[I_RKA][cg], rk = F.in[I_RRK][cg];
#pragma unroll 2
      for (int i8 = 0; i8 < 8; ++i8) { const int t = tq + 8 * i8;
          const float a = Aa[t * 64 + j]; const float kraw = Kk[t * 64 + j]; const float kp = kraw * (1.0f + (a - 1.0f) * kaw);
          Kk[t * 64 + j] = kp;
          const float kkv = kraw * kkw; const float ss = wave_sum(kkv * kkv); const float kkn = kkv * rsqrtf(fmaxf(ss, 1e-24f)); Aa[t * 64 + j] = -kkn; Bb[t * 64 + j] = kkn * a;
          const float bo = wave_sum(Rr[t * 64 + j] * kp * rk); if (j == 0) gBON[t] = bo; } }
    else if (F.tid < 64) BON[F.tid] = gBON[F.tid];
    __syncthreads();
}
constexpr int RB_AT = 98304, RB_ATT = RB_AT + 9216, RB_BT = RB_ATT + 9216, RB_BTT = RB_BT + 9216, RB_KT = RB_BTT + 9216, RB_RT = RB_KT + 9216, RB_VT = RB_RT + 9216, RB_GC = RB_VT + 9216;
constexpr int RX_X = 0, RX_XT = 9216, RX_TB = 18432, RX_M = 27648, RX_NRT = 36864, RX_G1T = 46080, RX_G2T = 55296, RX_QT = 64512;
__device__ __forceinline__ void st_tile(LAS bf16_t* dst, int mt, int nt, const f32x4 v, int lane) {
    const int r = lane & 15, g = lane >> 4;
#pragma unroll
    for (int i = 0; i < 4; ++i) dst[(16 * mt + 4 * g + i) * RB_LD + 16 * nt + r] = f2bf(v[i]);
}
__device__ __forceinline__ void st_tile_t(LAS bf16_t* dst, int mt, int nt, const f32x4 v, int lane) {
    const int r = lane & 15, g = lane >> 4; u32x2 w; w.x = pk2(v[0], v[1]); w.y = pk2(v[2], v[3]);
    *(LAS u32x2*)(dst + (16 * nt + r) * RB_LD + 16 * mt + 4 * g) = w;
}
__device__ __forceinline__ void item_rwkv1(const Frame& F_, int layer, int item) { Frame F = relocal(F_);
    const int b = item >> 8, h = (item >> 6) & 3, c = item & 63;
    rwkv_prep<1>(F, layer, b, h, c);
    LAS float* Rr = (LAS float*)(F.lds + RW_R); LAS float* Kk = (LAS float*)(F.lds + RW_K); LAS float* Vv = (LAS float*)(F.lds + RW_V); LAS float* Ww = (LAS float*)(F.lds + RW_W);
    LAS float* Aa = (LAS float*)(F.lds + RW_A); LAS float* Bb = (LAS float*)(F.lds + RW_B);
    LAS bf16_t* At = (LAS bf16_t*)(F.lds + RB_AT); LAS bf16_t* AtT = (LAS bf16_t*)(F.lds + RB_ATT); LAS bf16_t* Bt = (LAS bf16_t*)(F.lds + RB_BT); LAS bf16_t* BtT = (LAS bf16_t*)(F.lds + RB_BTT);
    LAS bf16_t* Kt = (LAS bf16_t*)(F.lds + RB_KT); LAS bf16_t* Rt = (LAS bf16_t*)(F.lds + RB_RT); LAS bf16_t* VT = (LAS bf16_t*)(F.lds + RB_VT); LAS float* gC = (LAS float*)(F.lds + RB_GC);
    LAS bf16_t* X = (LAS bf16_t*)(F.lds + RX_X); LAS bf16_t* XT = (LAS bf16_t*)(F.lds + RX_XT); LAS bf16_t* Tb = (LAS bf16_t*)(F.lds + RX_TB); LAS bf16_t* Mm = (LAS bf16_t*)(F.lds + RX_M);
    LAS bf16_t* NrT = (LAS bf16_t*)(F.lds + RX_NRT); LAS bf16_t* G1T = (LAS bf16_t*)(F.lds + RX_G1T); LAS bf16_t* G2T = (LAS bf16_t*)(F.lds + RX_G2T); LAS bf16_t* QT = (LAS bf16_t*)(F.lds + RX_QT);
    { const int k = F.tid & 63, part = F.tid >> 6; float g = 1.0f;
      for (int pp = 0; pp < part; ++pp) { float w8[8];
#pragma unroll
          for (int i = 0; i < 8; ++i) w8[i] = Ww[(8 * pp + i) * 64 + k];
          g *= ((w8[0] * w8[1]) * (w8[2] * w8[3])) * ((w8[4] * w8[5]) * (w8[6] * w8[7])); }
#pragma unroll
      for (int i = 0; i < 8; ++i) { const int t = 8 * part + i; const float gp = g; g *= Ww[t * 64 + k]; const float ig = 1.0f / g;
          const bf16_t av = f2bf(Aa[t * 64 + k] * gp), bv = f2bf(Bb[t * 64 + k] * ig);
          At[t * RB_LD + k] = av; AtT[k * RB_LD + t] = av; Bt[t * RB_LD + k] = bv; BtT[k * RB_LD + t] = bv;
          Kt[t * RB_LD + k] = f2bf(Kk[t * 64 + k] * ig); Rt[t * RB_LD + k] = f2bf(Rr[t * 64 + k] * g); VT[k * RB_LD + t] = f2bf(Vv[t * 64 + k]); }
      if (part == 7) gC[k] = g; }
    __syncthreads();
    const int lane = F.lane, mt = F.wave >> 1, nt0 = 2 * (F.wave & 1), r = lane & 15, g4 = lane >> 4;
    const f32x4 zero4 = (f32x4){0.f, 0.f, 0.f, 0.f};
    f32x4 Tacc[2];
#pragma unroll
    for (int q = 0; q < 2; ++q) { const int nt = nt0 + q;
        f32x4 n = mma_nt<64>(Bt + 16 * mt * RB_LD, RB_LD, At + 16 * nt * RB_LD, RB_LD, zero4, lane);
        f32x4 m = mma_nt<64>(Kt + 16 * mt * RB_LD, RB_LD, At + 16 * nt * RB_LD, RB_LD, zero4, lane);
        f32x4 nr = mma_nt<64>(Rt + 16 * mt * RB_LD, RB_LD, Bt + 16 * nt * RB_LD, RB_LD, zero4, lane);
#pragma unroll
        for (int i = 0; i < 4; ++i) { const int row = 16 * mt + 4 * g4 + i, col = 16 * nt + r;
            n[i] = (row < col) ? n[i] : 0.f; m[i] = (row < col) ? m[i] : 0.f; nr[i] = (col <= row) ? nr[i] : 0.f;
            Tacc[q][i] = n[i] + (row == col ? 1.0f : 0.f); }
        st_tile(X, mt, nt, n, lane); st_tile_t(XT, mt, nt, n, lane); st_tile(Tb, mt, nt, Tacc[q], lane); st_tile(Mm, mt, nt, m, lane); st_tile(NrT, mt, nt, nr, lane); }
    __syncthreads();
#pragma unroll 1
    for (int it = 0; it < 6; ++it) {
        LAS bf16_t* Xr = (it & 1) ? G1T : X; LAS bf16_t* XTr = (it & 1) ? G2T : XT; LAS bf16_t* Tr = (it & 1) ? QT : Tb;
        LAS bf16_t* Xw = (it & 1) ? X : G1T; LAS bf16_t* XTw = (it & 1) ? XT : G2T; LAS bf16_t* Tw = (it & 1) ? Tb : QT;
#pragma unroll
        for (int q = 0; q < 2; ++q) { const int nt = nt0 + q;
            if (it > 0) Tacc[q] = mma_nt<64>(Tr + 16 * mt * RB_LD, RB_LD, XTr + 16 * nt * RB_LD, RB_LD, Tacc[q], lane);
            if (it < 5) { const f32x4 x2 = mma_nt<64>(Xr + 16 * mt * RB_LD, RB_LD, XTr + 16 * nt * RB_LD, RB_LD, zero4, lane); st_tile(Xw, mt, nt, x2, lane); st_tile_t(XTw, mt, nt, x2, lane); }
            st_tile(Tw, mt, nt, Tacc[q], lane); }
        __syncthreads();
    }
#pragma unroll
    for (int q = 0; q < 2; ++q) { const int nt = nt0 + q;
        st_tile(G1T, mt, nt, mma_nt<64>(NrT + 16 * mt * RB_LD, RB_LD, Tb + 16 * nt * RB_LD, RB_LD, zero4, lane), lane);
        st_tile(G2T, mt, nt, mma_nt<64>(BtT + 16 * mt * RB_LD, RB_LD, Tb + 16 * nt * RB_LD, RB_LD, zero4, lane), lane); }
    __syncthreads();
    const size_t ci = (size_t)(b * 4 + h) * 64 + c;
    bf16_t* gPT = (bf16_t*)(F.ws + WS_MOE + RW_PT) + ci * 4096; bf16_t* gW1 = (bf16_t*)(F.ws + WS_MOE + RW_W1) + ci * 4096; bf16_t* gZ = (bf16_t*)(F.ws + WS_MOE + RW_Z) + ci * 4096;
#pragma unroll
    for (int q = 0; q < 2; ++q) { const int nt = nt0 + q; const int col = 16 * nt + r;
        f32x4 w1 = mma_nt<64>(G1T + 16 * mt * RB_LD, RB_LD, AtT + 16 * nt * RB_LD, RB_LD, zero4, lane);
        f32x4 z = mma_nt<64>(G1T + 16 * mt * RB_LD, RB_LD, Mm + 16 * nt * RB_LD, RB_LD, zero4, lane);
        f32x4 mr = mma_nt<64>(Rt + 16 * mt * RB_LD, RB_LD, Kt + 16 * nt * RB_LD, RB_LD, zero4, lane);
        f32x4 p = mma_nt<64>(G2T + 16 * mt * RB_LD, RB_LD, AtT + 16 * nt * RB_LD, RB_LD, zero4, lane);
        f32x4 qq = mma_nt<64>(G2T + 16 * mt * RB_LD, RB_LD, Mm + 16 * nt * RB_LD, RB_LD, zero4, lane);
        const int pos = 32 * (col >> 5) + 8 * ((col >> 2) & 3) + 4 * ((col >> 4) & 1) + (col & 3);
#pragma unroll
        for (int i = 0; i < 4; ++i) { const int row = 16 * mt + 4 * g4 + i;
            gW1[row * 64 + col] = f2bf(w1[i] + bf2f(Rt[row * RB_LD + col]));
            gZ[row * 64 + col] = f2bf(z[i] + (col <= row ? mr[i] : 0.f));
            const float gc = gC[row];
            gPT[row * 64 + pos] = f2bf((p[i] + (row == col ? 1.0f : 0.f)) * gc);
            qq[i] = (qq[i] + bf2f(Kt[col * RB_LD + row])) * gc; }
        st_tile(QT, mt, nt, qq, lane); }
    __syncthreads();
    bf16_t* gU = (bf16_t*)(F.ws + WS_MOE + RW_U) + ci * 4096;
#pragma unroll
    for (int q = 0; q < 2; ++q) { const int nt = nt0 + q;
        const f32x4 u = mma_nt<64>(VT + 16 * mt * RB_LD, RB_LD, QT + 16 * nt * RB_LD, RB_LD, zero4, lane);
#pragma unroll
        for (int i = 0; i < 4; ++i) gU[(16 * mt + 4 * g4 + i) * 64 + 16 * nt + r] = f2bf(u[i]); }
}
__device__ __forceinline__ void item_rwkv_carry(const Frame& F_, int item) { Frame F = relocal(F_);
    const int bh = item * 2 + (F.wave >> 2), nt = F.wave & 3, r = F.lane & 15, g = F.lane >> 4;
    const bf16_t* PT = (const bf16_t*)(F.ws + WS_MOE + RW_PT); const bf16_t* Uc = (const bf16_t*)(F.ws + WS_MOE + RW_U); bf16_t* Ss = (bf16_t*)(F.ws + WS_MOE + RW_S);
    f32x4 acc[4];
#pragma unroll
    for (int m = 0; m < 4; ++m) acc[m] = (f32x4){0.f, 0.f, 0.f, 0.f};
    for (int c = 0; c < 64; ++c) { const size_t ci = (size_t)bh * 64 + c;
        bf16x8 af[4][2]; f32x4 cin[4];
#pragma unroll
        for (int m = 0; m < 4; ++m) { const u32x2 uv = *(const u32x2*)(Uc + ci * 4096 + (16 * nt + r) * 64 + 16 * m + 4 * g);
            cin[m] = (f32x4){__uint_as_float(uv.x << 16), __uint_as_float(uv.x & 0xffff0000u), __uint_as_float(uv.y << 16), __uint_as_float(uv.y & 0xffff0000u)};
#pragma unroll
            for (int s = 0; s < 2; ++s) af[m][s] = *(const bf16x8*)(PT + ci * 4096 + (16 * m + r) * 64 + 32 * s + 8 * g); }
        unsigned pw[4][2];
#pragma unroll
        for (int m = 0; m < 4; ++m) { pw[m][0] = pk2(acc[m][0], acc[m][1]); pw[m][1] = pk2(acc[m][2], acc[m][3]);
            *(u32x2*)(Ss + ci * 4096 + (16 * nt + r) * 64 + 16 * m + 4 * g) = (u32x2){pw[m][0], pw[m][1]}; }
        bf16x8 bfr[2];
#pragma unroll
        for (int s = 0; s < 2; ++s) bfr[s] = __builtin_bit_cast(bf16x8, (u32x4){pw[2 * s][0], pw[2 * s][1], pw[2 * s + 1][0], pw[2 * s + 1][1]});
#pragma unroll
        for (int m = 0; m < 4; ++m) { acc[m] = __builtin_amdgcn_mfma_f32_16x16x32_bf16(af[m][0], bfr[0], cin[m], 0, 0, 0);
            acc[m] = __builtin_amdgcn_mfma_f32_16x16x32_bf16(af[m][1], bfr[1], acc[m], 0, 0, 0); }
    }
}
__device__ __forceinline__ void item_rwkv3(const Frame& F_, int layer, int item) { Frame F = relocal(F_);
    const int b = item >> 8, h = (item >> 6) & 3, c = item & 63; const size_t T0 = (size_t)b * SEQ + c * 64;
    rwkv_prep<3>(F, layer, b, h, c);
    LAS float* Vv = (LAS float*)(F.lds + RW_V); LAS float* Oo = (LAS float*)(F.lds + R3_O);
    LAS float* Gg = (LAS float*)(F.lds + R3_G); LAS float* BON = (LAS float*)(F.lds + R3_BON);
    LAS bf16_t* S0b = (LAS bf16_t*)(F.lds + R3_TILES); LAS bf16_t* W1b = S0b + 4608; LAS bf16_t* Zb = W1b + 4608; LAS bf16_t* VTb = Zb + 4608;
    { const size_t ci = (size_t)(b * 4 + h) * 64 + c; const int row = F.tid >> 3, col = (F.tid & 7) * 8;
      *(LAS u32x4*)(S0b + row * RB_LD + col) = *(const u32x4*)((const bf16_t*)(F.ws + WS_MOE + RW_S) + ci * 4096 + F.tid * 8);
      *(LAS u32x4*)(W1b + row * RB_LD + col) = *(const u32x4*)((const bf16_t*)(F.ws + WS_MOE + RW_W1) + ci * 4096 + F.tid * 8);
      *(LAS u32x4*)(Zb + row * RB_LD + col) = *(const u32x4*)((const bf16_t*)(F.ws + WS_MOE + RW_Z) + ci * 4096 + F.tid * 8);
      const int vv = F.tid & 63, part = F.tid >> 6;
#pragma unroll
      for (int i = 0; i < 8; ++i) { const int t = 8 * part + i; VTb[vv * RB_LD + t] = f2bf(Vv[t * 64 + vv]); } }
    __syncthreads();
    { const int lane = F.lane, mt = F.wave >> 1, nt0 = 2 * (F.wave & 1), r = lane & 15, g4 = lane >> 4;
#pragma unroll
      for (int q = 0; q < 2; ++q) { const int nt = nt0 + q;
          f32x4 o = mma_nt<64>(W1b + 16 * mt * RB_LD, RB_LD, S0b + 16 * nt * RB_LD, RB_LD, (f32x4){0.f, 0.f, 0.f, 0.f}, lane);
          o = mma_nt<64>(Zb + 16 * mt * RB_LD, RB_LD, VTb + 16 * nt * RB_LD, RB_LD, o, lane);
#pragma unroll
          for (int i = 0; i < 4; ++i) Oo[(16 * mt + 4 * g4 + i) * 64 + 16 * nt + r] = o[i]; } }
    __syncthreads();
    { const int j = F.lane, tq = F.wave, ch = h * 64 + j;
      const float lw = F.in[I_RLNW][layer * 256 + ch], lb = F.in[I_RLNB][layer * 256 + ch];
      bf16_t* Y = (bf16_t*)(F.ws + WS_H);
#pragma unroll 2
      for (int i8 = 0; i8 < 8; ++i8) { const int t = tq + 8 * i8;
          const float o = Oo[t * 64 + j]; const float mean = wave_sum(o) * (1.0f / 64.0f); const float d = o - mean; const float var = wave_sum(d * d) * (1.0f / 64.0f);
          float on = d * rsqrtf(var + 64e-5f) * lw + lb; on += BON[t] * Vv[t * 64 + j];
          Y[(T0 + t) * DM + 256 + ch] = f2bf(on * Gg[t * 64 + j]); } }
}

constexpr int DS_SEL = 131072, DS_HIST = 135168, DS_BKT = 151552, DS_BIAS = 152064;
__device__ __forceinline__ void dsa_tables(const Frame& F_) { Frame F = relocal(F_);
    LAS int* bkt = (LAS int*)(F.lds + DS_BKT); LAS float* biasT = (LAS float*)(F.lds + DS_BIAS);
    if (F.tid < 128) { const int n = F.tid; int bk = n; if (n >= 16) { const float lr = logf((float)n / 16.0f) / 2.0794415416798357f; bk = 16 + (int)(lr * 16.0f); bk = bk < 31 ? bk : 31; } bkt[n] = bk; biasT[n] = F.in[I_RELB][n]; }
    __syncthreads();
}
__device__ __forceinline__ unsigned fkey(float f) { const unsigned u = __float_as_uint(f); return (u & 0x80000000u) ? ~u : (u | 0x80000000u); }
__device__ __forceinline__ void item_dsa(const Frame& F_, int layer, int item) { Frame F = relocal(F_);
    const bf16_t* U = (const bf16_t*)(F.ws + WS_U); const bf16_t* KI = (const bf16_t*)(F.ws + WS_KIDX);
    const bf16_t* Kb = (const bf16_t*)(F.ws + WS_K); const bf16_t* Vb = (const bf16_t*)(F.ws + WS_V);
    const int b = item & 3, qg = 511 - (item >> 2); const size_t TB = (size_t)b * SEQ, T0 = TB + qg * 8;
    LAS float* sc = (LAS float*)F.lds; LAS unsigned short* selall = (LAS unsigned short*)(F.lds + DS_SEL); LAS unsigned* histall = (LAS unsigned*)(F.lds + DS_HIST);
    LAS int* bkt = (LAS int*)(F.lds + DS_BKT); LAS float* biasT = (LAS float*)(F.lds + DS_BIAS);
    const int lane = F.lane, hh = lane >> 5;
    {
        bf16x8 af[2][2]; float wq[2][2][8];
        { const int r = lane & 31, q4 = 2 * ((r >> 2) & 1) + (r >> 4), head = 4 * ((r >> 3) & 1) + (r & 3);
#pragma unroll
          for (int mt = 0; mt < 2; ++mt)
#pragma unroll
              for (int ks = 0; ks < 2; ++ks) af[mt][ks] = *(const bf16x8*)(U + (T0 + 4 * mt + q4) * NINP + UC + 384 + head * 32 + 16 * ks + 8 * hh); }
#pragma unroll
        for (int mt = 0; mt < 2; ++mt)
#pragma unroll
            for (int q2 = 0; q2 < 2; ++q2) { float f[8]; unpack8(*(const u32x4*)(U + (T0 + 4 * mt + 2 * hh + q2) * NINP + UC + 672), f);
#pragma unroll
                for (int hd = 0; hd < 8; ++hd) wq[mt][q2][hd] = f[hd]; }
        const int ntile = (qg * 8 + 8 + 31) >> 5;
        bf16x8 nb0 = af[0][0], nb1 = af[0][0];
        if (F.wave < ntile) { const int key = F.wave * 32 + (lane & 31); nb0 = *(const bf16x8*)(KI + (TB + key) * 32 + 8 * hh); nb1 = *(const bf16x8*)(KI + (TB + key) * 32 + 16 + 8 * hh); }
        for (int kt = F.wave; kt < ntile; kt += 8) {
            const int key = kt * 32 + (lane & 31);
            const bf16x8 b0 = nb0, b1 = nb1;
            if (kt + 8 < ntile) { const int k2 = key + 256; nb0 = *(const bf16x8*)(KI + (TB + k2) * 32 + 8 * hh); nb1 = *(const bf16x8*)(KI + (TB + k2) * 32 + 16 + 8 * hh); }
#pragma unroll
            for (int mt = 0; mt < 2; ++mt) { f32x16 acc;
#pragma unroll
                for (int i = 0; i < 16; ++i) acc[i] = 0.f;
                acc = __builtin_amdgcn_mfma_f32_32x32x16_bf16(af[mt][0], b0, acc, 0, 0, 0);
                acc = __builtin_amdgcn_mfma_f32_32x32x16_bf16(af[mt][1], b1, acc, 0, 0, 0);
#pragma unroll
                for (int q2 = 0; q2 < 2; ++q2) { float s = 0.f;
#pragma unroll
                    for (int hd = 0; hd < 8; ++hd) s += fmaxf(acc[8 * q2 + hd], 0.f) * wq[mt][q2][hd];
                    const int qi = 4 * mt + 2 * hh + q2;
                    sc[qi * 4096 + key] = (key <= qg * 8 + qi) ? s : -INFINITY; } }
        }
    }
    __syncthreads();
    const int qi = F.wave, tq = qg * 8 + qi, n = tq + 1;
    LAS float* scq = sc + qi * 4096; LAS unsigned short* sel = selall + qi * 256; LAS unsigned* hist = histall + qi * 512;
    int nsel;
    if (n <= 256) { nsel = n; for (int j = lane; j < 256; j += 64) sel[j] = (unsigned short)(j < n ? j : 0); }
    else {
        nsel = 256;
        const int R = (n + 63) >> 6; const unsigned long long ltm = (1ull << lane) - 1ull;
        float lo = INFINITY, hi = -INFINITY;
        const int R4 = (n + 255) >> 8;
#pragma unroll 4
        for (int i = 0; i < R4; ++i) { const int j0 = 256 * i + 4 * lane; const f32x4 v4 = *(const LAS f32x4*)(scq + j0);
#pragma unroll
            for (int q = 0; q < 4; ++q) { const bool valid = j0 + q < n; lo = fminf(lo, valid ? v4[q] : INFINITY); hi = fmaxf(hi, valid ? v4[q] : -INFINITY); } }
#pragma unroll
        for (int o = 1; o < 64; o <<= 1) { lo = fminf(lo, shx(lo, o)); hi = fmaxf(hi, shx(hi, o)); }
        bool slow = false;
        if (!(hi > lo)) { for (int j = lane; j < 256; j += 64) sel[j] = (unsigned short)j; }
        else {
            const float scale = 1023.0f / (hi - lo);
            *(LAS u32x4*)(hist + 8 * lane) = (u32x4){0u, 0u, 0u, 0u}; *(LAS u32x4*)(hist + 8 * lane + 4) = (u32x4){0u, 0u, 0u, 0u};
#pragma unroll 2
            for (int i = 0; i < R4; ++i) { const int j0 = 256 * i + 4 * lane; const f32x4 v4 = *(const LAS f32x4*)(scq + j0);
#pragma unroll
                for (int q = 0; q < 4; ++q) { if (j0 + q < n) { int bk = (int)((v4[q] - lo) * scale); bk = bk < 1023 ? bk : 1023;
                    atomicAdd((unsigned*)(hist + (bk >> 1)), (bk & 1) ? 65536u : 1u); } } }
            const u32x4 h0 = *(const LAS u32x4*)(hist + 8 * lane), h1 = *(const LAS u32x4*)(hist + 8 * lane + 4);
            unsigned cb[16];
            cb[0] = h0.x & 0xffffu; cb[1] = h0.x >> 16; cb[2] = h0.y & 0xffffu; cb[3] = h0.y >> 16; cb[4] = h0.z & 0xffffu; cb[5] = h0.z >> 16; cb[6] = h0.w & 0xffffu; cb[7] = h0.w >> 16;
            cb[8] = h1.x & 0xffffu; cb[9] = h1.x >> 16; cb[10] = h1.y & 0xffffu; cb[11] = h1.y >> 16; cb[12] = h1.z & 0xffffu; cb[13] = h1.z >> 16; cb[14] = h1.w & 0xffffu; cb[15] = h1.w >> 16;
            unsigned tot = 0u;
#pragma unroll
            for (int q = 0; q < 16; ++q) tot += cb[q];
            unsigned incl = tot;
#pragma unroll
            for (int o = 1; o < 64; o <<= 1) { const unsigned t = shdown_u(incl, o); if (lane + o < 64) incl += t; }
            int fb = -1; unsigned fabove = 0u, fcnt = 0u; unsigned cum = incl - tot;
#pragma unroll
            for (int q = 15; q >= 0; --q) { if (fb < 0 && cum < 256u && 256u <= cum + cb[q]) { fb = 16 * lane + q; fabove = cum; fcnt = cb[q]; } cum += cb[q]; }
            const unsigned long long mf = __ballot(fb >= 0); const int src = (int)__ffsll((long long)mf) - 1;
            const int B = shidx_i(fb, src); const int above = shidx_i((int)fabove, src), cntB = shidx_i((int)fcnt, src); const int need = 256 - above;
            if (cntB > 256) slow = true;
            else {
                LAS unsigned* cand = hist;
                int base_gt = 0, base_c = 0;
#pragma unroll 2
                for (int i = 0; i < R4; ++i) { const int j0 = 256 * i + 4 * lane; const f32x4 v4 = *(const LAS f32x4*)(scq + j0);
#pragma unroll
                    for (int q = 0; q < 4; ++q) { const int j = j0 + q; const bool valid = j < n; const float v = valid ? v4[q] : lo;
                        int bk = (int)((v - lo) * scale); bk = bk < 1023 ? bk : 1023;
                        const bool gt = valid && bk > B, eq = valid && bk == B;
                        const unsigned long long mg = __ballot(gt), me = __ballot(eq);
                        if (gt) sel[base_gt + __popcll(mg & ltm)] = (unsigned short)j;
                        if (eq) { const int p = base_c + __popcll(me & ltm); cand[2 * p] = fkey(v); cand[2 * p + 1] = (unsigned)j; }
                        base_gt += __popcll(mg); base_c += __popcll(me); } }
                if (need == cntB) { for (int c = lane; c < cntB; c += 64) sel[above + c] = (unsigned short)cand[2 * c + 1]; }
                else {
                    unsigned ck[4], cx[4]; int rk[4];
#pragma unroll
                    for (int q = 0; q < 4; ++q) { const int c = lane + 64 * q; ck[q] = c < cntB ? cand[2 * c] : 0u; cx[q] = c < cntB ? cand[2 * c + 1] : 0u; rk[q] = 0; }
                    for (int c2 = 0; c2 < cntB; ++c2) { const unsigned k2 = cand[2 * c2], x2 = cand[2 * c2 + 1];
#pragma unroll
                        for (int q = 0; q < 4; ++q) rk[q] += (k2 > ck[q] || (k2 == ck[q] && x2 < cx[q])) ? 1 : 0; }
#pragma unroll
                    for (int q = 0; q < 4; ++q) { const int c = lane + 64 * q; if (c < cntB && rk[q] < need) sel[above + rk[q]] = (unsigned short)cand[2 * c + 1]; }
                }
            }
        }
        if (slow) {
        unsigned prefix = 0u; int need = 256; unsigned neq = 0u;
        for (int p = 0; p < 4; ++p) { const int shift = 24 - 8 * p;
            *(LAS u32x4*)(hist + 4 * lane) = (u32x4){0u, 0u, 0u, 0u};
            for (int i = 0; i < R; ++i) { const int j = lane + 64 * i; if (j < n) { const unsigned u = fkey(scq[j]);
                if (p == 0 || (u >> (shift + 8)) == prefix) atomicAdd((unsigned*)(hist + ((u >> shift) & 255u)), 1u); } }
            const u32x4 hv = *(const LAS u32x4*)(hist + 4 * lane);
            const unsigned tot = hv.x + hv.y + hv.z + hv.w;
            unsigned incl = tot;
#pragma unroll
            for (int o = 1; o < 64; o <<= 1) { const unsigned t = shdown_u(incl, o); if (lane + o < 64) incl += t; }
            const unsigned above = incl - tot;
            int fb = -1; unsigned fabove = 0u, feq = 0u; unsigned cum = above;
            { const unsigned hq[4] = {hv.x, hv.y, hv.z, hv.w};
#pragma unroll
              for (int q = 3; q >= 0; --q) { if (fb < 0 && cum < (unsigned)need && (unsigned)need <= cum + hq[q]) { fb = 4 * lane + q; fabove = cum; feq = hq[q]; } cum += hq[q]; } }
            const unsigned long long m = __ballot(fb >= 0);
            const int src = (int)__ffsll((long long)m) - 1;
            const int bin = shidx_i(fb, src); const unsigned ab = (unsigned)shidx_i((int)fabove, src); neq = (unsigned)shidx_i((int)feq, src);
            need -= (int)ab; prefix = (prefix << 8) | (unsigned)bin;
        }
        const int ngt = 256 - need;
        int base_gt = 0, base_eq = 0;
        for (int i = 0; i < R; ++i) { const int j = lane + 64 * i; const unsigned u = (j < n) ? fkey(scq[j]) : 0u;
            const bool gt = (j < n) && (u > prefix), eq = (j < n) && (u == prefix);
            const unsigned long long mg = __ballot(gt), me = __ballot(eq); const unsigned long long lt = (1ull << lane) - 1ull;
            if (gt) sel[base_gt + __popcll(mg & lt)] = (unsigned short)j;
            if (eq) { const int rk = base_eq + __popcll(me & lt); if (rk < need) sel[ngt + rk] = (unsigned short)j; }
            base_gt += __popcll(mg); base_eq += __popcll(me); }
        (void)neq;
            }
    }
    const int nt16 = (nsel + 15) >> 4, r16 = lane & 15, g4 = lane >> 4;
    LAS float* biasj = scq + 2048;
#pragma unroll
    for (int q = 0; q < 4; ++q) { const int j = lane + 64 * q; f32x4 bv = (f32x4){-INFINITY, -INFINITY, -INFINITY, -INFINITY};
        if (j < nsel) { const int dist = tq - (int)sel[j]; const int bk = dist < 128 ? bkt[dist < 0 ? 0 : dist] : 31; bv = *(const LAS f32x4*)(biasT + 4 * bk); }
        *(LAS f32x4*)(biasj + 4 * j) = bv; }
    bf16x8 qf[2];
#pragma unroll
    for (int s = 0; s < 2; ++s) { u32x4 z = (u32x4){0u, 0u, 0u, 0u}; if (r16 < 4) z = *(const u32x4*)(U + (T0 + qi) * NINP + UC + r16 * 64 + 32 * s + 8 * g4); qf[s] = __builtin_bit_cast(bf16x8, z); }
    float lg[16][4]; float mx = -INFINITY;
#define DSA_QK(M0, NM) do { int keyr[NM]; bf16x8 a0[NM], a1[NM]; \
        _Pragma("unroll") for (int m8 = 0; m8 < NM; ++m8) keyr[m8] = sel[16 * ((M0) + m8) + r16]; \
        _Pragma("unroll") for (int m8 = 0; m8 < NM; ++m8) { a0[m8] = *(const bf16x8*)(Kb + (TB + keyr[m8]) * 64 + 8 * g4); a1[m8] = *(const bf16x8*)(Kb + (TB + keyr[m8]) * 64 + 32 + 8 * g4); } \
        _Pragma("unroll") for (int m8 = 0; m8 < NM; ++m8) { const int m = (M0) + m8; \
            f32x4 acc = (f32x4){0.f, 0.f, 0.f, 0.f}; \
            acc = __builtin_amdgcn_mfma_f32_16x16x32_bf16(a0[m8], qf[0], acc, 0, 0, 0); \
            acc = __builtin_amdgcn_mfma_f32_16x16x32_bf16(a1[m8], qf[1], acc, 0, 0, 0); \
            _Pragma("unroll") for (int i = 0; i < 4; ++i) { const float v = acc[i] * 0.125f + biasj[(16 * m + 4 * g4 + i) * 4 + (r16 & 3)]; lg[m][i] = v; mx = fmaxf(mx, v); } } } while (0)
    if (nt16 > 8) { DSA_QK(0, 16); }
    else { DSA_QK(0, 8);
#pragma unroll
        for (int m8 = 8; m8 < 16; ++m8)
#pragma unroll
            for (int i = 0; i < 4; ++i) lg[m8][i] = -INFINITY; }
#undef DSA_QK
    mx = fmaxf(mx, shx(mx, 16)); mx = fmaxf(mx, shx(mx, 32));
    float sm = 0.f;
#pragma unroll
    for (int m = 0; m < 16; ++m)
#pragma unroll
        for (int i = 0; i < 4; ++i) { const float p = __expf(lg[m][i] - mx); lg[m][i] = p; sm += p; }
    sm += shx(sm, 16); sm += shx(sm, 32);
    f32x4 ov[4];
#pragma unroll
    for (int nt = 0; nt < 4; ++nt) ov[nt] = (f32x4){0.f, 0.f, 0.f, 0.f};
    const unsigned vs_base = (unsigned)(unsigned long)scq;
#pragma unroll
    for (int half = 0; half < 2; ++half) {
        if (half * 8 < nt16) {
            asm volatile("s_waitcnt lgkmcnt(0)" ::: "memory");
            int vkey[16];
#pragma unroll
            for (int q = 0; q < 16; ++q) { const int rho = 8 * q + (lane >> 3);
                vkey[q] = sel[half * 128 + (rho & ~31) + 16 * ((rho >> 2) & 1) + 4 * ((rho >> 3) & 3) + (rho & 3)]; }
            asm volatile("s_waitcnt lgkmcnt(0)" : "+v"(vkey[0]), "+v"(vkey[1]), "+v"(vkey[2]), "+v"(vkey[3]), "+v"(vkey[4]), "+v"(vkey[5]), "+v"(vkey[6]), "+v"(vkey[7]),
                         "+v"(vkey[8]), "+v"(vkey[9]), "+v"(vkey[10]), "+v"(vkey[11]), "+v"(vkey[12]), "+v"(vkey[13]), "+v"(vkey[14]), "+v"(vkey[15]) :: "memory");
#pragma unroll
            for (int q = 0; q < 16; ++q)
                __builtin_amdgcn_global_load_lds((const unsigned*)(Vb + (TB + vkey[q]) * 64 + 8 * (lane & 7)), (LAS unsigned*)((LAS unsigned char*)scq + q * 1024), 16, 0, 0);
            asm volatile("s_waitcnt vmcnt(0)" ::: "memory");
#pragma unroll
            for (int s4 = 0; s4 < 4; ++s4) { const int s = half * 4 + s4;
                u32x4 pw; pw.x = pk2(lg[2 * s][0], lg[2 * s][1]); pw.y = pk2(lg[2 * s][2], lg[2 * s][3]); pw.z = pk2(lg[2 * s + 1][0], lg[2 * s + 1][1]); pw.w = pk2(lg[2 * s + 1][2], lg[2 * s + 1][3]);
                const bf16x8 pa = __builtin_bit_cast(bf16x8, pw);
                const unsigned ad = vs_base + (unsigned)((32 * s4 + 8 * g4 + (r16 >> 2)) * 128 + (r16 & 3) * 8);
                u32x2 t0[4], t1[4];
                asm volatile("ds_read_b64_tr_b16 %0, %8\n\tds_read_b64_tr_b16 %1, %8 offset:512\n\tds_read_b64_tr_b16 %2, %8 offset:32\n\tds_read_b64_tr_b16 %3, %8 offset:544\n\t"
                             "ds_read_b64_tr_b16 %4, %8 offset:64\n\tds_read_b64_tr_b16 %5, %8 offset:576\n\tds_read_b64_tr_b16 %6, %8 offset:96\n\tds_read_b64_tr_b16 %7, %8 offset:608\n\ts_waitcnt lgkmcnt(0)"
                             : "=&v"(t0[0]), "=&v"(t1[0]), "=&v"(t0[1]), "=&v"(t1[1]), "=&v"(t0[2]), "=&v"(t1[2]), "=&v"(t0[3]), "=&v"(t1[3]) : "v"(ad) : "memory");
#pragma unroll
                for (int nt = 0; nt < 4; ++nt) { const bf16x8 vb = __builtin_bit_cast(bf16x8, (u32x4){t0[nt].x, t0[nt].y, t1[nt].x, t1[nt].y});
                    ov[nt] = __builtin_amdgcn_mfma_f32_16x16x32_bf16(pa, vb, ov[nt], 0, 0, 0); } }
        }
    }
    { float inv[4];
#pragma unroll
      for (int h = 0; h < 4; ++h) inv[h] = 1.0f / __int_as_float(__builtin_amdgcn_readlane(__float_as_int(sm), h));
      if (lane < 16) { bf16_t* Y = (bf16_t*)(F.ws + WS_H) + (T0 + qi) * DM + 512 + r16;
#pragma unroll
          for (int h = 0; h < 4; ++h)
#pragma unroll
              for (int nt = 0; nt < 4; ++nt) Y[h * 64 + 16 * nt] = f2bf(ov[nt][h] * inv[h]); } }
}

__device__ __forceinline__ void phase_router(const Frame& F_, int layer) { Frame F = relocal(F_); const int cset = layer;
    const float* X = (const float*)(F.ws + WS_X);
    const bf16_t* WH = (const bf16_t*)(F.ws + WS_WRT) + (size_t)layer * 2 * 49152; const bf16_t* WL = WH + 49152;
    LAS float* part = (LAS float*)F.lds;
    LAS float* ssq = (LAS float*)(F.lds + 24576);
    LAS int* es = (LAS int*)(F.lds + 25088);
    LAS int* lr = (LAS int*)(F.lds + 25600);
    LAS float* wsl = (LAS float*)(F.lds + 26112);
    LAS float* rsd = (LAS float*)(F.lds + 26624);
    for (int blk = F.bid; blk < NTOK / 64; blk += F.G) {
        __syncthreads();
        const int mt = F.wave & 3, kh = F.wave >> 2, r16 = F.lane & 15, g4 = F.lane >> 4;
        const float* xr = X + ((size_t)blk * 64 + mt * 16 + r16) * DM + kh * 512 + 8 * g4;
        f32x4 acc[3]; acc[0] = acc[1] = acc[2] = (f32x4){0.f, 0.f, 0.f, 0.f}; float ss = 0.f;
#pragma unroll 4
        for (int ks = 0; ks < 16; ++ks) {
            const f32x4 xa = *(const f32x4*)(xr + ks * 32), xb = *(const f32x4*)(xr + ks * 32 + 4);
            ss += xa[0] * xa[0] + xa[1] * xa[1] + xa[2] * xa[2] + xa[3] * xa[3] + xb[0] * xb[0] + xb[1] * xb[1] + xb[2] * xb[2] + xb[3] * xb[3];
            float xv[8] = {xa[0], xa[1], xa[2], xa[3], xb[0], xb[1], xb[2], xb[3]}; unsigned hw[4], lw[4];
#pragma unroll
            for (int j = 0; j < 4; ++j) { const bf16_t h0 = f2bf(xv[2 * j]), h1 = f2bf(xv[2 * j + 1]); hw[j] = (unsigned)h0 | ((unsigned)h1 << 16);
                lw[j] = pk2(xv[2 * j] - bf2f(h0), xv[2 * j + 1] - bf2f(h1)); }
            const bf16x8 ahi = __builtin_bit_cast(bf16x8, (u32x4){hw[0], hw[1], hw[2], hw[3]}), alo = __builtin_bit_cast(bf16x8, (u32x4){lw[0], lw[1], lw[2], lw[3]});
#pragma unroll
            for (int nt = 0; nt < 3; ++nt) { const size_t wo = (size_t)(nt * 16 + r16) * 1024 + kh * 512 + ks * 32 + 8 * g4;
                const bf16x8 bh = *(const bf16x8*)(WH + wo), bl = *(const bf16x8*)(WL + wo);
                acc[nt] = __builtin_amdgcn_mfma_f32_16x16x32_bf16(ahi, bh, acc[nt], 0, 0, 0);
                acc[nt] = __builtin_amdgcn_mfma_f32_16x16x32_bf16(ahi, bl, acc[nt], 0, 0, 0);
                acc[nt] = __builtin_amdgcn_mfma_f32_16x16x32_bf16(alo, bh, acc[nt], 0, 0, 0); }
        }
        ss += shx(ss, 16); ss += shx(ss, 32);
        if (g4 == 0) ssq[kh * 64 + mt * 16 + r16] = ss;
#pragma unroll
        for (int nt = 0; nt < 3; ++nt)
#pragma unroll
            for (int i = 0; i < 4; ++i) part[(kh * 64 + mt * 16 + 4 * g4 + i) * 48 + nt * 16 + r16] = acc[nt][i];
        __syncthreads();
        if (F.tid < 64) { const float rstd = rsqrtf((ssq[F.tid] + ssq[64 + F.tid]) * (1.0f / DM) + 1e-6f); rsd[F.tid] = rstd;
            float l[36];
#pragma unroll
            for (int o = 0; o < 36; ++o) l[o] = (part[F.tid * 48 + o] + part[(64 + F.tid) * 48 + o]) * rstd + (o < 32 ? F.in[I_BRE][layer * 32 + o] : F.in[I_BRG][layer * 4 + o - 32]);
            int gs = 0; float gm = l[32];
#pragma unroll
            for (int j = 1; j < 4; ++j) if (l[32 + j] > gm) { gm = l[32 + j]; gs = j; }
            float den = 0.f;
#pragma unroll
            for (int j = 0; j < 4; ++j) den += __expf(l[32 + j] - gm);
            const float gate = 1.0f / den;
            float e8[8];
#pragma unroll
            for (int j = 0; j < 8; ++j) e8[j] = gs == 0 ? l[j] : gs == 1 ? l[8 + j] : gs == 2 ? l[16 + j] : l[24 + j];
            int i1 = 0; float v1 = e8[0];
#pragma unroll
            for (int j = 1; j < 8; ++j) if (e8[j] > v1) { v1 = e8[j]; i1 = j; }
            int i2 = -1; float v2 = -INFINITY;
#pragma unroll
            for (int j = 0; j < 8; ++j) if (j != i1 && e8[j] > v2) { v2 = e8[j]; i2 = j; }
            const float e2 = __expf(v2 - v1); const float p1 = 1.0f / (1.0f + e2);
            es[F.tid * 2] = gs * 8 + i1; es[F.tid * 2 + 1] = gs * 8 + i2; wsl[F.tid * 2] = p1 * gate; wsl[F.tid * 2 + 1] = (1.0f - p1) * gate; }
        __syncthreads();
        if (F.tid < 32) { int cnt = 0; for (int i = 0; i < 128; ++i) if (es[i] == F.tid) lr[i] = cnt++;
            if (cnt) { const int base = (int)__hip_atomic_fetch_add(F.ctl + CW_CNT + cset * 32 + F.tid, (unsigned)cnt, __ATOMIC_RELAXED, __HIP_MEMORY_SCOPE_AGENT);
                for (int i = 0; i < 128; ++i) if (es[i] == F.tid) lr[i] += base; } }
        __syncthreads();
        if (F.tid < 64) { int* rt = (int*)(F.ws + WS_ROUTE) + ((size_t)blk * 64 + F.tid) * 8;
            rt[0] = es[F.tid * 2]; rt[1] = es[F.tid * 2 + 1]; ((float*)rt)[2] = wsl[F.tid * 2]; ((float*)rt)[3] = wsl[F.tid * 2 + 1]; rt[4] = lr[F.tid * 2]; rt[5] = lr[F.tid * 2 + 1]; ((float*)rt)[6] = rsd[F.tid]; }
    }
    __syncthreads();
    if (F.tid == 0) __hip_atomic_fetch_add(F.ctl + CW_RB + 64 * layer, 1u, __ATOMIC_RELAXED, __HIP_MEMORY_SCOPE_AGENT);
}
__device__ __forceinline__ void phase_moe_convert(const Frame& F_, int layer) { Frame F = relocal(F_);
    bf16_t* WGU = (bf16_t*)(F.ws + WS_MOE + MOE_WGU);
    for (int t = F.bid; t < 1024; t += F.G) {
        const int e = t >> 5, r = t & 31, kt = r >> 1, nt = r & 1; const size_t eo = ((size_t)layer * 32 + e) * 1024 * 256;
        tr_tile(F, 256, WGU + (size_t)e * 512 * 1024, 1024, kt * 64, nt * 256, SmGU{F.in[I_WGATE] + eo, F.in[I_WUP] + eo}); }
}
__device__ __forceinline__ void phase_moe_convert_down(const Frame& F_, int layer) { Frame F = relocal(F_);
    bf16_t* WD = (bf16_t*)(F.ws + WS_MOE + MOE_WD);
    for (;;) { const int q = q_pop(F, 32 + layer); if (q >= 512) break;
        const int e = q >> 4, r = q & 15, kt = r >> 2, nt = r & 3;
        tr_tile(F, 1024, WD + (size_t)e * 1024 * 256, 256, kt * 64, nt * 256, SmId{F.in[I_WDOWN] + ((size_t)layer * 32 + e) * 256 * 1024}); }
}
__device__ __forceinline__ void phase_gather(const Frame& F_, int layer) { Frame F = relocal(F_);
    LAS int* off = (LAS int*)F.lds;
    __syncthreads();
    if (F.tid == 0) { unsigned sp = 0;
        while (__hip_atomic_load(F.ctl + CW_RB + 64 * layer, __ATOMIC_RELAXED, __HIP_MEMORY_SCOPE_AGENT) < (unsigned)F.G) { __builtin_amdgcn_s_sleep(2); if (++sp > (1u << 22)) break; } }
    __syncthreads();
    if (F.tid == 0) { int acc = 0; for (int e = 0; e < 32; ++e) { off[e] = acc; const int c = (int)__hip_atomic_load(F.ctl + CW_CNT + layer * 32 + e, __ATOMIC_RELAXED, __HIP_MEMORY_SCOPE_AGENT); acc += (c + 255) & ~255; } off[32] = acc; }
    __syncthreads();
    int* tiles = (int*)(F.ws + WS_TILES); int* row_tok = (int*)(F.ws + WS_ROWS); float* row_w = (float*)(F.ws + WS_ROWS) + MAXROWS;
    if (F.bid == 0) { if (F.tid == 0) tiles[0] = off[32] >> 8; if (F.tid < 33) tiles[1 + F.tid] = off[F.tid];
        if (F.tid < 32) for (int rt = off[F.tid] >> 8; rt < (off[F.tid + 1] >> 8); ++rt) tiles[64 + rt] = F.tid; }
    for (int e = F.bid; e < 32; e += F.G) { const int c = (int)__hip_atomic_load(F.ctl + CW_CNT + layer * 32 + e, __ATOMIC_RELAXED, __HIP_MEMORY_SCOPE_AGENT);
        for (int r = off[e] + c + F.tid; r < off[e + 1]; r += NTHR) { row_tok[r] = -1; row_w[r] = 0.f; } }
    const float* X = (const float*)(F.ws + WS_X); bf16_t* HP = (bf16_t*)(F.ws + WS_U); const float* nw = F.in[I_NORM2] + (size_t)layer * DM;
    f32x4 nwv[4];
#pragma unroll
    for (int j = 0; j < 4; ++j) nwv[j] = *(const f32x4*)(nw + 4 * F.lane + 256 * j);
    for (int blk = F.bid; blk < NTOK / 64; blk += F.G)
    for (int i4 = 0; i4 < 2; ++i4) {
        int p0[4], p1[4], tt[4]; float rstd[4], w0[4], w1[4]; f32x4 xv[4][4];
#pragma unroll
        for (int r = 0; r < 4; ++r) { const int t = blk * 64 + F.wave * 8 + 4 * i4 + r; tt[r] = t;
            const int* rt = (const int*)(F.ws + WS_ROUTE) + (size_t)t * 8; rstd[r] = ((const float*)rt)[6]; w0[r] = ((const float*)rt)[2]; w1[r] = ((const float*)rt)[3];
            p0[r] = off[rt[0]] + rt[4]; p1[r] = off[rt[1]] + rt[5];
#pragma unroll
            for (int j = 0; j < 4; ++j) xv[r][j] = *(const f32x4*)(X + (size_t)t * DM + 4 * F.lane + 256 * j); }
#pragma unroll
        for (int r = 0; r < 4; ++r) {
#pragma unroll
            for (int j = 0; j < 4; ++j) { const int c = 4 * F.lane + 256 * j; const f32x4 v = xv[r][j] * rstd[r] * nwv[j];
                u32x2 o; o.x = pk2(v[0], v[1]); o.y = pk2(v[2], v[3]);
                *(u32x2*)(HP + (size_t)tt[r] * DM + c) = o; }
            if (F.lane == 0) { row_tok[p0[r]] = tt[r] * 2; row_w[p0[r]] = w0[r]; row_tok[p1[r]] = tt[r] * 2 + 1; row_w[p1[r]] = w1[r]; } }
    }
}

constexpr int NPH_LAYER = 9, NPHASE = 1 + 2 * NPH_LAYER + 1;
#ifndef MK_ONLY
#define MK_ONLY -1
#endif
#ifndef MK_ITEM
#define MK_ITEM -1
#endif
#define EN(o) (MK_ONLY < 0 || MK_ONLY == (o))
#define IT(o) (MK_ITEM < 0 || MK_ITEM == (o))
__global__ void __launch_bounds__(NTHR, 2) mk_forward(Params P) {
    extern __shared__ __attribute__((aligned(16))) unsigned char lds_raw[];
    Frame F; F.lds = (LAS unsigned char*)lds_raw; F.tid = threadIdx.x; F.lane = F.tid & 63; F.wave = __builtin_amdgcn_readfirstlane(F.tid >> 6); F.bid = blockIdx.x; F.G = gridDim.x;
    F.in = (in_tab_t)__builtin_amdgcn_kernarg_segment_ptr(); F.out = P.out; F.ws = P.ws; F.ctl = (unsigned*)(P.ws + WS_CTL); F.misc = (volatile LAS int*)(F.lds + MISC_OFF);
    if (F.tid < 64) ((LAS unsigned*)(F.lds + MISC_OFF))[F.tid] = 0u;
    __syncthreads();
    const int lo = P.ph_lo, hi = P.ph_hi;
    XcdBarrier bar; bar.bar = F.ctl + CW_BAR; bar.x = 0; bar.st = (volatile LAS unsigned*)(F.lds + MISC_OFF + 16);
    if (hi - lo > 1) bar = xcd_barrier_post(F.ctl + CW_BAR, (volatile LAS unsigned*)(F.lds + MISC_OFF + 16));
#define IN(k) (lo <= (k) && (k) < hi)
#define SEAM(k) do { if (IN(k) && IN((k) + 1)) xcd_barrier(bar); } while (0)
#define QLOOP(qi, n, body) for (;;) { const int it = q_pop(F, layer * 12 + (qi)); if (it >= (n)) break; body; }
    if (EN(100) && IN(0)) { phase_prologue(F); phase_norm(F, F.in[I_X], false, F.in[I_NORM1], 3); } SEAM(0);
#pragma unroll
    for (int layer = 0; layer < DEPTH; ++layer) {
        const int pb = 1 + layer * NPH_LAYER;
        if (layer > 0) { if (EN(0) && IN(pb + 0)) { phase_norm(F, (const float*)(F.ws + WS_X), true, F.in[I_NORM1] + (size_t)layer * DM, 0); } SEAM(pb + 0); }
        if (EN(1) && IN(pb + 1)) { const Frame F_ = F; Frame F = relocal(F_); pg8::StaticOrder S; S.init((const bf16_t*)(F.ws + WS_H), (const bf16_t*)(F.ws + WS_WIN) + (size_t)layer * NINP * DM, NTOK, NINP, DM, F.G, F.bid);
            pg8::EpiBf16 E{(bf16_t*)(F.ws + WS_U), NINP}; pg8::gemm_phase(F.lds, DM, S, E); } SEAM(pb + 1);
#define SLOOP(n, body) for (int it = F.bid; it < (n); it += F.G) { __syncthreads(); body; }
        if (EN(2) && IN(pb + 2)) {
            if (IT(1)) SLOOP(1024, item_rwkv1(F, layer, it));
            if (IT(0)) SLOOP(256, item_s5<1>(F, layer, it));
            if (IT(2)) SLOOP(256, item_mamba<1>(F, layer, it));
            if (IT(3)) SLOOP(256, item_kv(F, layer, it));
        } SEAM(pb + 2);
        if (EN(3) && IN(pb + 3)) {
            if (IT(0)) SLOOP(8, item_rwkv_carry(F, it));
            if (IT(1)) { for (int it = F.bid - 8; it >= 0 && it < 16; it += F.G) { __syncthreads(); item_mamba_carry(F, it); } }
            if (IT(2)) { for (int it = F.bid - 24; it >= 0 && it < 4; it += F.G) { __syncthreads(); item_s5_carry(F, layer, it); } }
            if (IT(3)) {
                dsa_tables(F);
                const int pref = (int)(xb_xcc_id() & 3u);
#pragma unroll 1
                for (int k4 = 0; k4 < 4; ++k4) { const int bq = (pref + k4) & 3;
                    for (;;) { const int it = q_pop(F, 24 + layer * 4 + bq); if (it >= 512) break; item_dsa(F, layer, it * 4 + bq); } } }
        } SEAM(pb + 3);
        if (EN(4) && IN(pb + 4)) {
            if (IT(0)) SLOOP(256, item_s5<2>(F, layer, it));
            if (IT(2)) SLOOP(256, item_mamba<2>(F, layer, it));
            if (IT(1)) SLOOP(1024, item_rwkv3(F, layer, it));
        } SEAM(pb + 4);
        if (EN(6) && IN(pb + 5)) { const Frame F_ = F; Frame F = relocal(F_); pg8::StaticOrder S; S.init((const bf16_t*)(F.ws + WS_H), (const bf16_t*)(F.ws + WS_WOUT) + (size_t)layer * DM * DM, NTOK, DM, DM, F.G, F.bid);
            pg8::EpiResid E{layer == 0 ? F.in[I_X] : (const float*)(F.ws + WS_X), (float*)(F.ws + WS_X), DM}; pg8::gemm_phase(F.lds, DM, S, E); } SEAM(pb + 5);
        if (EN(7) && IN(pb + 6)) { phase_router(F, layer); phase_moe_convert(F, layer); phase_gather(F, layer); } SEAM(pb + 6);
        if (EN(8) && IN(pb + 7)) { const Frame F_ = F; Frame F = relocal(F_); LAS int* ul = (LAS int*)(F.lds + pg8::STAGE_BYTES + 8192); if (F.tid == 0) pg8::MoeOrder::build(ul, (const int*)(F.ws + WS_TILES), 2, F.G, F.bid); __syncthreads();
            pg8::MoeOrder S{DM, (const char*)(F.ws + WS_U), (const char*)(F.ws + WS_MOE + MOE_WGU), (size_t)512 * 1024 * 2, ul};
            pg8::EpiGated<1> E{(bf16_t*)(F.ws + WS_H), 256, 0, nullptr, nullptr}; pg8::gemm_phase<pg8::EpiGated<1>, pg8::MoeOrder, true>(F.lds, DM, S, E, (const char*)(F.ws + WS_U), (const int*)(F.ws + WS_ROWS)); phase_moe_convert_down(F, layer); } SEAM(pb + 7);
        if (EN(9) && IN(pb + 8)) { const Frame F_ = F; Frame F = relocal(F_); LAS int* ul = (LAS int*)(F.lds + pg8::STAGE_BYTES + 8192); if (F.tid == 0) pg8::MoeOrder::build(ul, (const int*)(F.ws + WS_TILES), 4, F.G, F.bid); __syncthreads();
            pg8::MoeOrder S{256, (const char*)(F.ws + WS_H), (const char*)(F.ws + WS_MOE + MOE_WD), (size_t)1024 * 256 * 2, ul};
            pg8::EpiMoeOut E{(bf16_t*)(F.ws + WS_U), (const int*)(F.ws + WS_ROWS), (const float*)(F.ws + WS_ROWS) + MAXROWS, F.lds}; pg8::gemm_phase(F.lds, 256, S, E); } SEAM(pb + 8);
    }
    if (EN(101) && IN(NPHASE - 1)) { phase_norm(F, (const float*)(F.ws + WS_X), true, F.in[I_FNORM], 2); }
#undef IN
#undef SEAM
}

#ifndef MK_SPLIT
#define MK_SPLIT 0
#endif
extern "C" void kernel_launch(void* const* d_in, const int* in_sizes, int n_in, void* d_out, int out_size, void* d_ws, size_t ws_size, hipStream_t stream) {
    static int grid = 0;
    if (grid == 0) {
        if (n_in != 44 || out_size != NTOK * DM || ws_size < WS_END) { fprintf(stderr, "kernel_launch: unexpected shapes (n_in %d out %d ws %zu need %zu)\n", n_in, out_size, ws_size, (size_t)WS_END); grid = -1; return; }
        int dev = 0, cus = 0;
        if (hipGetDevice(&dev) != hipSuccess || hipDeviceGetAttribute(&cus, hipDeviceAttributeMultiprocessorCount, dev) != hipSuccess) { grid = -1; return; }
        if (hipFuncSetAttribute((const void*)mk_forward, hipFuncAttributeMaxDynamicSharedMemorySize, LDS_BYTES) != hipSuccess) { fprintf(stderr, "kernel_launch: hipFuncSetAttribute failed\n"); grid = -1; return; }
        int per_cu = 0;
        if (hipOccupancyMaxActiveBlocksPerMultiprocessor(&per_cu, (const void*)mk_forward, NTHR, LDS_BYTES) != hipSuccess || per_cu < 1) { fprintf(stderr, "kernel_launch: occupancy query says %d\n", per_cu); }
        (void)hipGetLastError();
        grid = cus;
    }
    if (grid < 0) return;
    hipMemsetAsync((char*)d_ws + WS_CTL, 0, CTL_BYTES, stream);
    Params p{};
    for (int i = 0; i < 44; ++i) p.in[i] = (const float*)d_in[i];
    p.out = (float*)d_out; p.ws = (unsigned char*)d_ws;
#if MK_SPLIT
    for (int ph = 0; ph < NPHASE; ++ph) { p.ph_lo = ph; p.ph_hi = ph + 1; hipLaunchKernelGGL(mk_forward, dim3(grid), dim3(NTHR), LDS_BYTES, stream, p); }
#else
    p.ph_lo = 0; p.ph_hi = NPHASE; hipLaunchKernelGGL(mk_forward, dim3(grid), dim3(NTHR), LDS_BYTES, stream, p);
#endif
}
```

```cpp
#include <hip/hip_runtime.h>
#include <stdint.h>
#include <stdio.h>

#define LAS __attribute__((address_space(3)))
typedef unsigned short bf16_t;
typedef short bf16x8 __attribute__((ext_vector_type(8)));
typedef float f32x4 __attribute__((ext_vector_type(4)));
typedef float f32x2 __attribute__((ext_vector_type(2)));
typedef float f32x16 __attribute__((ext_vector_type(16)));
typedef unsigned u32x4 __attribute__((ext_vector_type(4)));
typedef unsigned u32x2 __attribute__((ext_vector_type(2)));

constexpr int NTOK = 16384, DM = 1024, SEQ = 4096, NBATCH = 4, DEPTH = 2;
constexpr int NIN = 2604, NINP = 2816;
constexpr int UM = 0;
constexpr int UR = 784;
constexpr int UC = 1680;
constexpr int US = 2368;
constexpr int NTHR = 512;
constexpr int LDS_BYTES = 163840;
constexpr int MISC_OFF = LDS_BYTES - 256;

constexpr size_t WS_CTL   = 0;
constexpr size_t CTL_BYTES = 65536;
constexpr size_t WS_X     = WS_CTL + CTL_BYTES;
constexpr size_t WS_H     = WS_X + (size_t)NTOK * DM * 4;
constexpr size_t WS_U     = WS_H + (size_t)NTOK * DM * 2;
constexpr size_t WS_WIN   = WS_U + (size_t)NTOK * NINP * 2;
constexpr size_t WS_WOUT  = WS_WIN + (size_t)2 * NINP * DM * 2;
constexpr size_t WS_GLU   = WS_WOUT + (size_t)2 * DM * DM * 2;
constexpr size_t WS_MOE   = WS_GLU + (size_t)2 * 512 * 256 * 2;
constexpr size_t MOE_WGU  = 0;
constexpr size_t MOE_WD   = (size_t)32 * 512 * 1024 * 2;
constexpr size_t MOE_BYTES = MOE_WD + (size_t)32 * 1024 * 256 * 2;
constexpr size_t RW_PT    = 0;
constexpr size_t RW_U     = (size_t)1024 * 4096 * 2;
constexpr size_t RW_S     = RW_U + (size_t)1024 * 4096 * 2;
constexpr size_t RW_W1    = RW_S + (size_t)1024 * 4096 * 2;
constexpr size_t RW_Z     = RW_W1 + (size_t)1024 * 4096 * 2;
constexpr size_t YSG_OFF  = RW_Z + (size_t)1024 * 4096 * 2;
static_assert(YSG_OFF + (size_t)NTOK * 256 * 2 <= MOE_BYTES, "alias");
constexpr size_t WS_MST   = WS_MOE + MOE_BYTES;
constexpr size_t WS_MDEC  = WS_MST + (size_t)4 * 64 * 4 * 4096 * 4;
constexpr size_t WS_S5ST  = WS_MDEC + 4096;
constexpr size_t WS_K     = WS_S5ST + (size_t)4 * 64 * 2048 * 4;
constexpr size_t WS_V     = WS_K + (size_t)NTOK * 64 * 2;
constexpr size_t WS_KIDX  = WS_V + (size_t)NTOK * 64 * 2;
constexpr size_t WS_ROUTE = WS_KIDX + (size_t)NTOK * 32 * 2;
constexpr size_t WS_ROWS  = WS_ROUTE + (size_t)NTOK * 32;
constexpr int    MAXROWS  = 49152;
constexpr size_t WS_TILES = WS_ROWS + (size_t)MAXROWS * 8;
constexpr size_t WS_S5TAB = WS_TILES + 4096;
constexpr size_t S5TAB_F  = (size_t)(2048 + 2048 + 32768) * 4;
constexpr size_t S5TAB_BBT = S5TAB_F + (size_t)16 * 16 * 128 * 2;
constexpr size_t S5TAB_L  = S5TAB_BBT + (size_t)16 * 128 * 16 * 2;
constexpr size_t WS_WRT   = WS_S5TAB + 2 * S5TAB_L;
constexpr size_t WS_BON   = WS_WRT + (size_t)2 * 2 * 48 * 1024 * 2;
constexpr size_t WS_END   = WS_BON + (size_t)1024 * 64 * 4;

constexpr int CW_BAR = 0;
constexpr int CW_Q   = 4096;
constexpr int CW_CNT = 8192;
constexpr int CW_RB  = 8448;

__device__ __forceinline__ float bf2f(bf16_t b) { return __uint_as_float(((unsigned)b) << 16); }
__device__ __forceinline__ bf16_t f2bf(float f) { const __bf16 h = (__bf16)f; return __builtin_bit_cast(bf16_t, h); }
__device__ __forceinline__ unsigned pk2(float lo, float hi) { typedef __bf16 bf2_t __attribute__((ext_vector_type(2))); const bf2_t h = __builtin_convertvector((f32x2){lo, hi}, bf2_t); return __builtin_bit_cast(unsigned, h); }
__device__ __forceinline__ unsigned cvt_pk_bf16(float lo, float hi) { unsigned r; asm volatile("v_cvt_pk_bf16_f32 %0, %1, %2" : "=v"(r) : "v"(lo), "v"(hi)); return r; }
__device__ __forceinline__ float sigmoidf_(float x) { return 1.0f / (1.0f + __expf(-x)); }
__device__ __forceinline__ float siluf_(float x) { return x / (1.0f + __expf(-x)); }
__device__ __forceinline__ float tanhf_(float x) { const float e = __expf(2.0f * x); return 1.0f - 2.0f / (e + 1.0f); }
__device__ __forceinline__ float softplusf_(float x) { return fmaxf(x, 0.0f) + log1pf(__expf(-fabsf(x))); }
__device__ __forceinline__ float gelu_tanh(float x) { return 0.5f * x * (1.0f + tanhf_(0.7978845608028654f * (x + 0.044715f * x * x * x))); }
template <int CTRL> __device__ __forceinline__ float dppf(float x) { return __int_as_float(__builtin_amdgcn_update_dpp(0, __float_as_int(x), CTRL, 0xF, 0xF, true)); }
__device__ __forceinline__ float sum4(float x) { x += dppf<0xB1>(x); x += dppf<0x4E>(x); return x; }
__device__ __forceinline__ float sum8(float x) { x = sum4(x); x += dppf<0x141>(x); return x; }
__device__ __forceinline__ float sum16(float x) { x = sum8(x); x += dppf<0x140>(x); return x; }
__device__ __forceinline__ int lane_id_() { int l = (int)__builtin_amdgcn_mbcnt_hi(~0u, __builtin_amdgcn_mbcnt_lo(~0u, 0u)); asm volatile("" : "+v"(l)); return l; }
__device__ __forceinline__ float shx(float x, int o) { return __int_as_float(__builtin_amdgcn_ds_bpermute((lane_id_() ^ o) << 2, __float_as_int(x))); }
__device__ __forceinline__ unsigned shdown_u(unsigned x, int o) { return (unsigned)__builtin_amdgcn_ds_bpermute(((lane_id_() + o) & 63) << 2, (int)x); }
__device__ __forceinline__ int shidx_i(int x, int src) { return __builtin_amdgcn_ds_bpermute(src << 2, x); }
__device__ __forceinline__ float wave_sum(float x) { x = sum16(x); x += shx(x, 16); x += shx(x, 32); return x; }
__device__ __forceinline__ void unpack8(const u32x4 v, float (&f)[8]) {
    f[0] = __uint_as_float(v.x << 16); f[1] = __uint_as_float(v.x & 0xffff0000u); f[2] = __uint_as_float(v.y << 16); f[3] = __uint_as_float(v.y & 0xffff0000u);
    f[4] = __uint_as_float(v.z << 16); f[5] = __uint_as_float(v.z & 0xffff0000u); f[6] = __uint_as_float(v.w << 16); f[7] = __uint_as_float(v.w & 0xffff0000u);
}

__device__ __forceinline__ void st16_wt(void* p, u32x4 v) { asm volatile("global_store_dwordx4 %0, %1, off sc1\n\ts_nop 1" :: "v"(p), "v"(v) : "memory"); }
#define XB_TMO      128
#define XB_XCNT(j)  (256  + 64 * (j))
#define XB_XSUB(j)  (1280 + 64 * (j))
#define XB_XGEN(j)  (2304 + 64 * (j))
#define XB_TOP      3328
#define XB_TOPGEN   3392
#define XCD_BAR_WORDS 3456
#define XB_SPIN_CAP (1u << 22)
__device__ __forceinline__ unsigned xb_ld(unsigned* p)              { return __hip_atomic_load(p, __ATOMIC_RELAXED, __HIP_MEMORY_SCOPE_AGENT); }
__device__ __forceinline__ unsigned xb_add(unsigned* p, unsigned v) { return __hip_atomic_fetch_add(p, v, __ATOMIC_RELAXED, __HIP_MEMORY_SCOPE_AGENT); }
__device__ __forceinline__ unsigned xb_xcc_id() { return (unsigned)__builtin_amdgcn_s_getreg((3 << 11) | 20) & 0xFu; }
#define XB_SPIN(cond, bar) do { unsigned _sp = 0; while (cond) { __builtin_amdgcn_s_sleep(1); \
    if ((++_sp & 255u) == 0u) { if (xb_ld(&(bar)[XB_TMO])) break; if (_sp > XB_SPIN_CAP) { atomicAdd(&(bar)[XB_TMO], 1u); break; } } } } while (0)
struct XcdBarrier { unsigned* bar; unsigned x; volatile LAS unsigned* st; };
__device__ __forceinline__ XcdBarrier xcd_barrier_post(unsigned* bar, volatile LAS unsigned* st) {
    XcdBarrier b; b.bar = bar; b.x = xb_xcc_id(); b.st = st;
    if (threadIdx.x == 0) (void)xb_add(&bar[XB_XCNT(b.x)], 1u);
    return b;
}
__device__ __forceinline__ void xcd_barrier_complete(unsigned* bar, unsigned x, unsigned& nloc, unsigned& nx) {
    const unsigned G = gridDim.x * gridDim.y * gridDim.z;
    unsigned sum, cnt, mine, sp = 0u;
    for (;;) {
        sum = 0u; cnt = 0u; mine = 0u;
#pragma unroll
        for (unsigned j = 0; j < 16; ++j) { const unsigned c = xb_ld(&bar[XB_XCNT(j)]); sum += c; cnt += (c > 0u) ? 1u : 0u; mine = (j == x) ? c : mine; }
        if (sum == G) break;
        __builtin_amdgcn_s_sleep(1);
        if ((++sp & 255u) == 0u) { if (xb_ld(&bar[XB_TMO])) break; if (sp > XB_SPIN_CAP) { atomicAdd(&bar[XB_TMO], 1u); break; } }
    }
    nloc = mine > 0u ? mine : 1u; nx = cnt > 0u ? cnt : 1u;
}
__device__ __forceinline__ void xcd_barrier(const XcdBarrier& b_) {
    XcdBarrier b = b_; { const unsigned long long v = (unsigned long long)b.bar; unsigned lo = __builtin_amdgcn_readfirstlane((unsigned)v), hi = __builtin_amdgcn_readfirstlane((unsigned)(v >> 32)); asm volatile("" : "+s"(lo), "+s"(hi)); b.bar = (unsigned*)(((unsigned long long)hi << 32) | lo); unsigned xx = __builtin_amdgcn_readfirstlane(b.x); asm volatile("" : "+s"(xx)); b.x = xx; }
    asm volatile("s_waitcnt vmcnt(0)" ::: "memory");
    __syncthreads();
    if (threadIdx.x == 0) {
        unsigned* bar = b.bar;
        __builtin_amdgcn_s_waitcnt(0);
        unsigned nloc = b.st[0], nx = b.st[1];
        if (nloc == 0u) { xcd_barrier_complete(bar, b.x, nloc, nx); b.st[0] = nloc; b.st[1] = nx; }
        const unsigned old = xb_add(&bar[XB_XSUB(b.x)], 1u);
        const unsigned gen = old / nloc;
        if (old + 1u == (gen + 1u) * nloc) {
            __builtin_amdgcn_fence(__ATOMIC_RELEASE, "agent");
            asm volatile("s_waitcnt vmcnt(0)" ::: "memory");
            const unsigned og = xb_add(&bar[XB_TOP], 1u);
            const unsigned tg = og / nx;
            if (og + 1u == (tg + 1u) * nx) xb_add(&bar[XB_TOPGEN], 1u);
            else XB_SPIN(xb_ld(&bar[XB_TOPGEN]) == tg, bar);
            __builtin_amdgcn_fence(__ATOMIC_ACQUIRE, "agent");
            xb_add(&bar[XB_XGEN(b.x)], 1u);
            asm volatile("s_waitcnt vmcnt(0)" ::: "memory");
        } else {
            XB_SPIN(xb_ld(&bar[XB_XGEN(b.x)]) == gen, bar);
            __builtin_amdgcn_fence(__ATOMIC_ACQUIRE, "agent");
            asm volatile("s_waitcnt vmcnt(0)" ::: "memory");
        }
    }
    __syncthreads();
}

namespace pg8 {
constexpr int BM = 256, BK = 64, HALF = 128, HTB = HALF * BK * 2, STAGE_BYTES = 8 * HTB, NXCD = 8, WGM = 8;
__host__ __device__ __forceinline__ int lds_byte(int r, int c) { const int st = (r >> 4) * 2 + (c >> 5), rr = r & 15, cc = c & 31, ob = rr * 64 + cc * 2; return st * 1024 + (ob ^ (((ob >> 9) & 1) << 5)); }
__host__ __device__ __forceinline__ void stage_rc(int b, int& R, int& C) { const int st = b / 1024, sb = b % 1024, swz = sb ^ (((sb >> 9) & 1) << 5); R = (st >> 1) * 16 + swz / 64; C = (st & 1) * 32 + (swz % 64) / 2; }
__host__ __device__ __forceinline__ int perm32(int rho) { const int n = rho >> 4, i = rho & 15; return 8 * (i >> 2) + 4 * n + (i & 3); }
struct Unit { int pm, pn; const char* a; const char* b; };

struct StaticOrder {
    int nM, nN, nwg, G, c, K; const char* A; const char* B;
    __device__ void init(const bf16_t* A_, const bf16_t* B_, int M, int N, int K_, int G_, int c_) { A = (const char*)A_; B = (const char*)B_; K = K_; nM = M / BM; nN = N / BM; nwg = nM * nN; G = G_; c = c_; }
    __device__ bool next(int i, Unit& u) const {
        const long L = (long)i * G + c; if (L >= nwg) return false;
        int wgid = (int)L; { const int q = nwg / NXCD, r = nwg % NXCD, xcd = wgid % NXCD, off = wgid / NXCD; wgid = (xcd < r ? xcd * (q + 1) : r * (q + 1) + (xcd - r) * q) + off; }
        const int nig = WGM * nN, gid = wgid / nig, fm = gid * WGM, gsz = (nM - fm) < WGM ? (nM - fm) : WGM;
        u.pm = fm + ((wgid % nig) % gsz); u.pn = (wgid % nig) / gsz;
        u.a = A + (size_t)u.pm * 256 * K * 2; u.b = B + (size_t)u.pn * 256 * K * 2; return true;
    }
};

template <class Epi, class Sched, bool GATHER = false>
__device__ __forceinline__ void gemm_phase(LAS unsigned char* lds, const int K_, const Sched& S, const Epi& E, const char* Aall = nullptr, const int* arow = nullptr) {
    int K = K_; asm volatile("" : "+s"(K));
    int tid_ = threadIdx.x; asm volatile("" : "+v"(tid_));
    const int tid = tid_, wid = __builtin_amdgcn_readfirstlane(tid >> 6), lane = tid & 63, wr = wid >> 2, wc = wid & 3, fr = lane & 15, fq = lane >> 4;
    const int nt = K / BK;
    unsigned voffA[2], voffB[2]; int Rst[2], Cst[2];
#pragma unroll
    for (int i = 0; i < 2; ++i) { int R, C; stage_rc(tid * 16 + i * 8192, R, C); const int Rb = Epi::PERM ? ((R & ~31) + perm32(R & 31)) : R; Rst[i] = R; Cst[i] = C;
        voffA[i] = (unsigned)(R * K + C) * 2u; voffB[i] = (unsigned)(Rb * K + C) * 2u; }
    unsigned gv[2][2], gn[2][2];
#define PG8_GOFF(dst, unit) do { _Pragma("unroll") for (int h_ = 0; h_ < 2; ++h_) _Pragma("unroll") for (int i_ = 0; i_ < 2; ++i_) { const int rr_ = arow[(unit).pm * BM + h_ * HALF + Rst[i_]]; \
        dst[h_][i_] = ((unsigned)(rr_ < 0 ? 0 : rr_ >> 1) * (unsigned)K + (unsigned)Cst[i_]) * 2u; } } while (0)
    const size_t kstep = (size_t)(BK * 2);
    const size_t hstep = (size_t)HALF * K * 2;
    const unsigned ldsw = (unsigned)wid * 1024u;
    const int aoff = lds_byte(wr * 64 + fr, fq * 8), boff = lds_byte(wc * 32 + fr, fq * 8);
#define PG8_SA(b, h) (((b) * 2 + (h)) * HTB)
#define PG8_SB(b, h) ((4 + (b) * 2 + (h)) * HTB)
#define PG8_STAGE(bufoff, gbase, voff) do { _Pragma("unroll") for (int _i = 0; _i < 2; ++_i) \
        __builtin_amdgcn_global_load_lds((const unsigned*)((const char*)(gbase) + (voff)[_i]), (LAS unsigned*)(lds + (bufoff) + ldsw + _i * 8192), 16, 0, 0); } while (0)
#define PG8_LDA(dst, b, h) do { _Pragma("unroll") for (int m = 0; m < 4; ++m) _Pragma("unroll") for (int k = 0; k < 2; ++k) dst[m][k] = *(const LAS bf16x8*)(lds + PG8_SA(b, h) + aoff + m * 2048 + k * 1024); } while (0)
#define PG8_LDB(dst, b, h) do { _Pragma("unroll") for (int n = 0; n < 2; ++n) _Pragma("unroll") for (int k = 0; k < 2; ++k) dst[n][k] = *(const LAS bf16x8*)(lds + PG8_SB(b, h) + boff + n * 2048 + k * 1024); } while (0)
#define PG8_MMA(ai, bj, At, Bt) do { __builtin_amdgcn_s_setprio(1); _Pragma("unroll") for (int m = 0; m < 4; ++m) _Pragma("unroll") for (int n = 0; n < 2; ++n) _Pragma("unroll") for (int k = 0; k < 2; ++k) \
        acc[ai][bj][m][n] = __builtin_amdgcn_mfma_f32_16x16x32_bf16(Bt[n][k], At[m][k], acc[ai][bj][m][n], 0, 0, 0); __builtin_amdgcn_s_setprio(0); } while (0)
#define PG8_WAIT_V(n) asm volatile("s_waitcnt vmcnt(" #n ")" ::: "memory")
#define PG8_WAIT_L(n) asm volatile("s_waitcnt lgkmcnt(" #n ")" ::: "memory")
#define PG8_BAR __builtin_amdgcn_s_barrier()
#define PG8_SCHED __builtin_amdgcn_sched_barrier(0)
    Unit cur, nxt; int ui = 0;
    if (!S.next(0, cur)) return;
    f32x4 acc[2][2][4][2];
#pragma unroll
    for (int a = 0; a < 2; ++a)
#pragma unroll
        for (int b = 0; b < 2; ++b)
#pragma unroll
            for (int m = 0; m < 4; ++m)
#pragma unroll
                for (int n = 0; n < 2; ++n) acc[a][b][m][n] = (f32x4){0.f, 0.f, 0.f, 0.f};
    bf16x8 At[4][2], B0[2][2], B1[2][2];
    const char* cA = GATHER ? Aall : cur.a; const char* cB = cur.b;
    if (GATHER) PG8_GOFF(gv, cur);
#define PG8_STAGE_A(bufoff, gbase, h, vo) do { if (GATHER) PG8_STAGE(bufoff, gbase, (vo)[h]); else PG8_STAGE(bufoff, (gbase) + ((h) ? hstep : 0), voffA); } while (0)
    PG8_STAGE(PG8_SB(0, 0), cB, voffB); PG8_STAGE_A(PG8_SA(0, 0), cA, 0, gv); PG8_STAGE(PG8_SB(0, 1), cB + hstep, voffB); PG8_STAGE_A(PG8_SA(0, 1), cA, 1, gv);
    if (wr == 1) PG8_BAR;
    PG8_WAIT_V(4); PG8_BAR;
    PG8_STAGE(PG8_SB(1, 0), cB + kstep, voffB); PG8_STAGE_A(PG8_SA(1, 0), cA + kstep, 0, gv); PG8_STAGE(PG8_SB(1, 1), cB + hstep + kstep, voffB);
    PG8_WAIT_V(6); PG8_BAR;
    for (;;) {
        const bool has_next = S.next(ui + 1, nxt);
        const char* nA = GATHER ? cA : (has_next ? nxt.a : cA); const char* nB = has_next ? nxt.b : cB;
        if (GATHER) { if (has_next) PG8_GOFF(gn, nxt); else {
#pragma unroll
            for (int h_ = 0; h_ < 2; ++h_)
#pragma unroll
                for (int i_ = 0; i_ < 2; ++i_) gn[h_][i_] = gv[h_][i_]; } }
        for (int t = 0; t < nt; t += 2) {
            const bool last = (t == nt - 2);
            const char* a1 = cA + (size_t)(t + 1) * kstep;
            const char* a2 = last ? nA : cA + (size_t)(t + 2) * kstep; const char* b2 = last ? nB : cB + (size_t)(t + 2) * kstep;
            const char* a3 = a2 + kstep; const char* b3 = b2 + kstep;
            unsigned vo2[2][2];
#pragma unroll
            for (int h_ = 0; h_ < 2; ++h_)
#pragma unroll
                for (int i_ = 0; i_ < 2; ++i_) vo2[h_][i_] = GATHER ? (last ? gn[h_][i_] : gv[h_][i_]) : 0u;
            PG8_LDB(B0, 0, 0); PG8_SCHED; PG8_LDA(At, 0, 0); PG8_STAGE_A(PG8_SA(1, 1), a1, 1, gv);
            PG8_WAIT_L(8); PG8_BAR; PG8_WAIT_L(0); PG8_MMA(0, 0, At, B0); PG8_BAR; PG8_SCHED;
            PG8_LDB(B1, 0, 1); PG8_STAGE(PG8_SB(0, 0), b2, voffB);
            PG8_BAR; PG8_WAIT_L(0); PG8_MMA(0, 1, At, B1); PG8_BAR;
            PG8_LDA(At, 0, 1); PG8_STAGE_A(PG8_SA(0, 0), a2, 0, vo2);
            PG8_BAR; PG8_WAIT_L(0); PG8_MMA(1, 0, At, B0); PG8_BAR; PG8_SCHED;
            PG8_STAGE(PG8_SB(0, 1), b2 + hstep, voffB);
            PG8_WAIT_V(6); PG8_BAR; PG8_MMA(1, 1, At, B1); PG8_BAR;
            PG8_LDB(B0, 1, 0); PG8_SCHED; PG8_LDA(At, 1, 0); PG8_STAGE_A(PG8_SA(0, 1), a2, 1, vo2);
            PG8_WAIT_L(8); PG8_BAR; PG8_WAIT_L(0); PG8_MMA(0, 0, At, B0); PG8_BAR; PG8_SCHED;
            PG8_LDB(B1, 1, 1); PG8_STAGE(PG8_SB(1, 0), b3, voffB);
            PG8_BAR; PG8_WAIT_L(0); PG8_MMA(0, 1, At, B1); PG8_BAR;
            PG8_LDA(At, 1, 1); PG8_STAGE_A(PG8_SA(1, 0), a3, 0, vo2);
            PG8_BAR; PG8_WAIT_L(0); PG8_MMA(1, 0, At, B0); PG8_BAR; PG8_SCHED;
            PG8_STAGE(PG8_SB(1, 1), b3 + hstep, voffB);
            PG8_WAIT_V(6); PG8_BAR; PG8_MMA(1, 1, At, B1); PG8_BAR;
        }
        E(acc, cur, wr, wc, fr, fq);
        if (!has_next) break;
#pragma unroll
        for (int a = 0; a < 2; ++a)
#pragma unroll
            for (int b = 0; b < 2; ++b)
#pragma unroll
                for (int m = 0; m < 4; ++m)
#pragma unroll
                    for (int n = 0; n < 2; ++n) acc[a][b][m][n] = (f32x4){0.f, 0.f, 0.f, 0.f};
        cur = nxt; cA = nA; cB = nB; ++ui;
        if (GATHER) {
#pragma unroll
            for (int h_ = 0; h_ < 2; ++h_)
#pragma unroll
                for (int i_ = 0; i_ < 2; ++i_) gv[h_][i_] = gn[h_][i_]; }
    }
    PG8_WAIT_V(0);
    if (wr == 0) PG8_BAR;
    PG8_BAR;
#undef PG8_SA
#undef PG8_SB
#undef PG8_STAGE
#undef PG8_STAGE_A
#undef PG8_GOFF
#undef PG8_LDA
#undef PG8_LDB
#undef PG8_MMA
#undef PG8_WAIT_V
#undef PG8_WAIT_L
#undef PG8_BAR
#undef PG8_SCHED
}

struct EpiBf16 {
    static constexpr bool PERM = true;
    bf16_t* O; int ldc;
    __device__ __forceinline__ void operator()(const f32x4 (&acc)[2][2][4][2], const Unit& u, int wr, int wc, int fr, int fq) const {
        const int row0 = u.pm * BM + wr * 64 + fr, col0 = u.pn * BM + wc * 32 + 8 * fq;
#pragma unroll
        for (int ai = 0; ai < 2; ++ai)
#pragma unroll
            for (int m = 0; m < 4; ++m) { bf16_t* rowp = O + (size_t)(row0 + ai * HALF + m * 16) * ldc + col0;
#pragma unroll
                for (int bj = 0; bj < 2; ++bj) { const f32x4 v0 = acc[ai][bj][m][0], v1 = acc[ai][bj][m][1];
                    u32x4 w; w.x = cvt_pk_bf16(v0[0], v0[1]); w.y = cvt_pk_bf16(v0[2], v0[3]); w.z = cvt_pk_bf16(v1[0], v1[1]); w.w = cvt_pk_bf16(v1[2], v1[3]);
                    st16_wt(rowp + bj * HALF, w); } }
    }
};
struct EpiResid {
    static constexpr bool PERM = false;
    const float* Cin; float* C; int ldc;
    __device__ __forceinline__ void operator()(const f32x4 (&acc)[2][2][4][2], const Unit& u, int wr, int wc, int fr_, int fq_) const {
        int fr = fr_, fq = fq_; asm volatile("" : "+v"(fr), "+v"(fq));
        const int row0 = u.pm * BM + wr * 64 + fr, col0 = u.pn * BM + wc * 32 + 4 * fq;
#pragma unroll
        for (int ai = 0; ai < 2; ++ai)
#pragma unroll
            for (int mp = 0; mp < 2; ++mp) { f32x4 cv[2][2][2];
#pragma unroll
                for (int mm = 0; mm < 2; ++mm) { const float* rowp = Cin + (size_t)(row0 + ai * HALF + (2 * mp + mm) * 16) * ldc + col0;
#pragma unroll
                    for (int bj = 0; bj < 2; ++bj)
#pragma unroll
                        for (int n = 0; n < 2; ++n) cv[mm][bj][n] = *(const f32x4*)(rowp + bj * HALF + n * 16); }
#pragma unroll
                for (int mm = 0; mm < 2; ++mm) { float* rowp = C + (size_t)(row0 + ai * HALF + (2 * mp + mm) * 16) * ldc + col0;
#pragma unroll
                    for (int bj = 0; bj < 2; ++bj)
#pragma unroll
                        for (int n = 0; n < 2; ++n) { const f32x4 o_ = cv[mm][bj][n] + acc[ai][bj][2 * mp + mm][n]; st16_wt(rowp + bj * HALF + n * 16, __builtin_bit_cast(u32x4, o_)); } }
                asm volatile("" ::: "memory"); }
    }
};
template <int ACT  > struct EpiGated {
    static constexpr bool PERM = true;
    bf16_t* O; int ldo; int coloff; const float* ba; const float* bb;
    __device__ __forceinline__ void operator()(const f32x4 (&acc)[2][2][4][2], const Unit& u, int wr, int wc, int fr, int fq) const {
        const int row0 = u.pm * BM + wr * 64 + fr, cl = u.pn * HALF + wc * 32 + 8 * fq;
        float va[8], vb[8];
#pragma unroll
        for (int j = 0; j < 8; ++j) { va[j] = (ACT == 0) ? ba[cl + j] : 0.f; vb[j] = (ACT == 0) ? bb[cl + j] : 0.f; }
#pragma unroll
        for (int ai = 0; ai < 2; ++ai)
#pragma unroll
            for (int m = 0; m < 4; ++m) { bf16_t* rowp = O + (size_t)(row0 + ai * HALF + m * 16) * ldo + coloff + cl;
                float o[8];
#pragma unroll
                for (int n = 0; n < 2; ++n)
#pragma unroll
                    for (int j = 0; j < 4; ++j) { const float a = acc[ai][0][m][n][j] + va[4 * n + j], b = acc[ai][1][m][n][j] + vb[4 * n + j];
                        o[4 * n + j] = (ACT == 0) ? a * sigmoidf_(b) : siluf_(a) * b; }
                u32x4 w; w.x = cvt_pk_bf16(o[0], o[1]); w.y = cvt_pk_bf16(o[2], o[3]); w.z = cvt_pk_bf16(o[4], o[5]); w.w = cvt_pk_bf16(o[6], o[7]);
                st16_wt(rowp, w); asm volatile("" ::: "memory"); }
    }
};
struct EpiMoeOut {
    static constexpr bool PERM = true;
    bf16_t* O; const int* row_tok; const float* row_w; LAS unsigned char* lds;
    __device__ __forceinline__ void operator()(const f32x4 (&acc)[2][2][4][2], const Unit& u, int wr, int wc, int fr_, int fq_) const {
        int fr = fr_, fq = fq_; asm volatile("" : "+v"(fr), "+v"(fq));
        const int col0 = u.pn * BM + wc * 32 + 8 * fq, lane = fq * 16 + fr;
        LAS u32x2* rinfo = (LAS u32x2*)(lds + STAGE_BYTES) + (wr * 4 + wc) * 128;
        { const int ra = u.pm * BM + wr * 64 + lane, rb = ra + HALF;
          const u32x2 ia = (u32x2){(unsigned)row_tok[ra], __float_as_uint(row_w[ra])}, ib = (u32x2){(unsigned)row_tok[rb], __float_as_uint(row_w[rb])};
          rinfo[lane] = ia; rinfo[64 + lane] = ib; }
#pragma unroll
        for (int ai = 0; ai < 2; ++ai)
#pragma unroll
            for (int m = 0; m < 4; ++m) { const u32x2 inf = rinfo[ai * 64 + m * 16 + fr]; const int ts = (int)inf.x; const float w = __uint_as_float(inf.y);
                if (ts >= 0) { bf16_t* rowp = O + ((size_t)(ts & 1) * NTOK + (size_t)(ts >> 1)) * DM + col0;
#pragma unroll
                    for (int bj = 0; bj < 2; ++bj) { const f32x4 v0 = acc[ai][bj][m][0] * w, v1 = acc[ai][bj][m][1] * w;
                        u32x4 q; q.x = cvt_pk_bf16(v0[0], v0[1]); q.y = cvt_pk_bf16(v0[2], v0[3]); q.z = cvt_pk_bf16(v1[0], v1[1]); q.w = cvt_pk_bf16(v1[2], v1[3]);
                        st16_wt(rowp + bj * HALF, q); } } }
    }
};
struct MoeOrder {
    int K; const char* A; const char* B; size_t bstride; const LAS int* list;
    static __device__ __forceinline__ void build(LAS int* list, const int* tiles, int nN, int G, int c) {
        const int nrt = tiles[0], nwg = nrt * nN; int n = 0;
        for (int i = 0; ; ++i) { const long L = (long)i * G + c; if (L >= (long)nwg || n >= 20) break;
            int wgid = (int)L; { const int q = nwg / NXCD, r = nwg % NXCD, xcd = wgid % NXCD, off = wgid / NXCD; wgid = (xcd < r ? xcd * (q + 1) : r * (q + 1) + (xcd - r) * q) + off; }
            const int pm = wgid / nN; list[1 + 3 * n] = pm; list[2 + 3 * n] = wgid % nN; list[3 + 3 * n] = tiles[64 + pm]; ++n; }
        list[0] = n;
    }
    __device__ bool next(int i, Unit& u) const {
        const int n = __builtin_amdgcn_readfirstlane(list[0]); if (i >= n) return false;
        u.pm = __builtin_amdgcn_readfirstlane(list[1 + 3 * i]); u.pn = __builtin_amdgcn_readfirstlane(list[2 + 3 * i]); const int e = __builtin_amdgcn_readfirstlane(list[3 + 3 * i]);
        u.a = A + (size_t)u.pm * 256 * K * 2; u.b = B + (size_t)e * bstride + (size_t)u.pn * 256 * K * 2; return true;
    }
};
}

struct Params { const float* in[44]; float* out; unsigned char* ws; int ph_lo, ph_hi; };
enum { I_X = 0, I_NORM1, I_WIN, I_MCONVW, I_MCONVB, I_MDTB, I_MALOG, I_MD, I_MNORM, I_RMU, I_RW0, I_RW2, I_RA0, I_RA2, I_RG2, I_RKK, I_RKA, I_RRK, I_RLNW, I_RLNB,
       I_CKVN, I_CWUK, I_CWUV, I_RELB, I_SARE, I_SAIM, I_SBRE, I_SBIM, I_SCRE, I_SCIM, I_SD, I_SLOGDT, I_SGLUW, I_SGLUB, I_WOUT, I_NORM2, I_WRG, I_BRG, I_WRE, I_BRE,
       I_WGATE, I_WUP, I_WDOWN, I_FNORM };

typedef const float* const __attribute__((address_space(4)))* in_tab_t;
struct Frame {
    LAS unsigned char* lds; int tid, lane, wave, bid, G;
    in_tab_t in; float* out; unsigned char* ws; unsigned* ctl;
    volatile LAS int* misc;
};

__device__ __forceinline__ int q_pop(Frame& F, int qi) {
    __syncthreads();
    if (F.tid == 0) F.misc[0] = (int)__hip_atomic_fetch_add(F.ctl + CW_Q + 64 * qi, 1u, __ATOMIC_RELAXED, __HIP_MEMORY_SCOPE_AGENT);
    __syncthreads();
    return F.misc[0];
}

__device__ __forceinline__ const void* opaque_ptr(const void* p) { const unsigned long long v = (unsigned long long)p; unsigned lo = __builtin_amdgcn_readfirstlane((unsigned)v), hi = __builtin_amdgcn_readfirstlane((unsigned)(v >> 32));
    asm volatile("" : "+s"(lo), "+s"(hi)); return (const void*)(((unsigned long long)hi << 32) | lo); }
__device__ __forceinline__ Frame relocal(const Frame& G) { Frame F = G; asm volatile("" : "+v"(F.tid)); F.ws = (unsigned char*)opaque_ptr(F.ws); F.ctl = (unsigned*)(F.ws + WS_CTL); F.in = (in_tab_t)(unsigned long long)opaque_ptr((const void*)(unsigned long long)F.in); F.lane = F.tid & 63; F.wave = __builtin_amdgcn_readfirstlane(F.tid >> 6); return F; }
template <int K> __device__ __forceinline__ f32x4 mma_nt(const LAS bf16_t* A, int lda, const LAS bf16_t* Bt, int ldb, f32x4 acc, int lane) {
    const int r = lane & 15, g = lane >> 4;
#pragma unroll
    for (int k0 = 0; k0 < K; k0 += 32) {
        const bf16x8 a = *(const LAS bf16x8*)(A + r * lda + k0 + 8 * g);
        const bf16x8 b = *(const LAS bf16x8*)(Bt + r * ldb + k0 + 8 * g);
        acc = __builtin_amdgcn_mfma_f32_16x16x32_bf16(a, b, acc, 0, 0, 0);
    }
    return acc;
}

template <class SrcMap> __device__ __forceinline__ void tr_tile(Frame& F, int ldsrc, bf16_t* dst, int K, int k0, int n0, SrcMap sm) {
    LAS float* tile = (LAS float*)F.lds;
    __syncthreads();
    { const int n4 = (F.tid & 63) * 4, kk = F.tid >> 6; const float* sp = sm(n0 + n4);
      f32x4 v[8];
#pragma unroll
      for (int ps = 0; ps < 8; ++ps) { v[ps] = (f32x4){0.f, 0.f, 0.f, 0.f}; if (sp) v[ps] = __builtin_nontemporal_load((const f32x4*)(sp + (size_t)(k0 + kk + 8 * ps) * ldsrc)); }
#pragma unroll
      for (int ps = 0; ps < 8; ++ps) { LAS float* t = tile + (kk + 8 * ps) * 257 + n4; t[0] = v[ps][0]; t[1] = v[ps][1]; t[2] = v[ps][2]; t[3] = v[ps][3]; } }
    __syncthreads();
    { const int kc = F.tid & 7;
#pragma unroll
      for (int j = 0; j < 4; ++j) { const int n = (F.tid >> 3) + 64 * j; float f[8];
#pragma unroll
          for (int i = 0; i < 8; ++i) f[i] = tile[(8 * kc + i) * 257 + n];
          u32x4 w; w.x = pk2(f[0], f[1]); w.y = pk2(f[2], f[3]); w.z = pk2(f[4], f[5]); w.w = pk2(f[6], f[7]);
          *(u32x4*)(dst + (size_t)(n0 + n) * K + k0 + 8 * kc) = w; } }
}

struct SmIn { const float* base; __device__ __forceinline__ const float* operator()(int n) const {
    int c; if (n < 772) c = n; else if (n < UR) return nullptr; else if (n < UR + 896) c = 772 + (n - UR); else if (n < UC) return nullptr;
    else if (n < UC + 680) c = 1668 + (n - UC); else if (n < US) return nullptr; else if (n < US + 256) c = 2348 + (n - US); else return nullptr; return base + c; } };
struct SmId { const float* base; __device__ __forceinline__ const float* operator()(int n) const { return base + n; } };
struct SmGlu { const float* base; __device__ __forceinline__ const float* operator()(int n) const { const int pn = n >> 8, rr = n & 255; return base + (rr < 128 ? 128 * pn + rr : 256 + 128 * pn + (rr - 128)); } };
struct SmGU { const float* gate; const float* up; __device__ __forceinline__ const float* operator()(int n) const {
    const unsigned long long d = (unsigned long long)up - (unsigned long long)gate; const unsigned long long a = (unsigned long long)gate + (((n & 255) < 128) ? 0ull : d); return (const float*)a + 128 * (n >> 8) + (n & 127); } };
__device__ __forceinline__ void phase_prologue(const Frame& F_) { Frame F = relocal(F_);
    for (int t = F.bid; t < 496; t += F.G) {
        if (t < 352) { const int l = t / 176, r = t % 176, kt = r / 11, nt = r % 11;
            tr_tile(F, NIN, (bf16_t*)(F.ws + WS_WIN) + (size_t)l * NINP * DM, DM, kt * 64, nt * 256, SmIn{F.in[I_WIN] + (size_t)l * DM * NIN}); }
        else if (t < 480) { const int q = t - 352, l = q / 64, r = q % 64, kt = r / 4, nt = r % 4;
            tr_tile(F, DM, (bf16_t*)(F.ws + WS_WOUT) + (size_t)l * DM * DM, DM, kt * 64, nt * 256, SmId{F.in[I_WOUT] + (size_t)l * DM * DM}); }
        else { const int q = t - 480, l = q / 8, r = q % 8, kt = r / 2, nt = r % 2;
            tr_tile(F, 512, (bf16_t*)(F.ws + WS_GLU) + (size_t)l * 512 * 256, 256, kt * 64, nt * 256, SmGlu{F.in[I_SGLUW] + (size_t)l * 256 * 512}); }
    }
    for (int i = F.bid * NTHR + F.tid; i < 2 * 48 * 1024; i += F.G * NTHR) { const int l = i / 49152, r = i % 49152, o = r >> 10, k = r & 1023;
        float v = 0.f; if (o < 32) v = F.in[I_WRE][((size_t)l * DM + k) * 32 + o]; else if (o < 36) v = F.in[I_WRG][((size_t)l * DM + k) * 4 + (o - 32)];
        v *= F.in[I_NORM2][l * DM + k];
        const bf16_t hi = f2bf(v); const bf16_t lo = f2bf(v - bf2f(hi));
        bf16_t* w = (bf16_t*)(F.ws + WS_WRT) + (size_t)l * 2 * 49152; w[r] = hi; w[49152 + r] = lo; }
    for (int i = F.bid * NTHR + F.tid; i < 2048 + 65536; i += F.G * NTHR) {
        if (i < 2048) {
            const int l = i >> 10, gn = i & 1023, g = gn >> 6;
            float* tab = (float*)(F.ws + WS_S5TAB + (size_t)l * S5TAB_L);
            const float lre = fminf(F.in[I_SARE][l * 1024 + gn], -1e-4f), lim = F.in[I_SAIM][l * 1024 + gn];
            const float dt = expf(F.in[I_SLOGDT][l * 16 + g]);
            const float mag = expf(dt * lre); float sn, cs; sincosf(dt * lim, &sn, &cs);
            const float are = mag * cs, aim = mag * sn;
            const float den = lre * lre + lim * lim;
            const float fre = ((are - 1.0f) * lre + aim * lim) / den, fim = (aim * lre - (are - 1.0f) * lim) / den;
            tab[gn * 2] = are; tab[gn * 2 + 1] = aim;
            float pr = are, pi = aim;
#pragma unroll
            for (int s = 0; s < 6; ++s) { const float nr = pr * pr - pi * pi, ni = 2.0f * pr * pi; pr = nr; pi = ni; }
            tab[2048 + gn * 2] = pr; tab[2048 + gn * 2 + 1] = pi;
            const float* bre = F.in[I_SBRE] + ((size_t)l * 1024 + gn) * 16; const float* bim = F.in[I_SBIM] + ((size_t)l * 1024 + gn) * 16;
            bf16_t* bbt = (bf16_t*)(F.ws + WS_S5TAB + (size_t)l * S5TAB_L + S5TAB_BBT); const int n = gn & 63, col = 4 * (n & 31) + 2 * (n >> 5);
            for (int p = 0; p < 16; ++p) { const float vr = fre * bre[p] - fim * bim[p], vi = fre * bim[p] + fim * bre[p];
                bbt[((size_t)g * 128 + col) * 16 + p] = f2bf(vr); bbt[((size_t)g * 128 + col + 1) * 16 + p] = f2bf(vi); }
        } else {
            const int j = i - 2048, l = j >> 15, r = j & 32767, gp = r >> 7, k = r & 127;
            bf16_t* cm = (bf16_t*)(F.ws + WS_S5TAB + (size_t)l * S5TAB_L + S5TAB_F);
            const int n = (k >> 2) + 32 * ((k >> 1) & 1);
            const float v = (k & 1) == 0 ? F.in[I_SCRE][((size_t)l * 256 + gp) * 64 + n] : -F.in[I_SCIM][((size_t)l * 256 + gp) * 64 + n];
            cm[r] = f2bf(v);
        }
    }
}

__device__ __forceinline__ void phase_norm(const Frame& F_, const float* xin, bool add_o, const float* w, int mode) { Frame F = relocal(F_);
    float* X = (float*)(F.ws + WS_X); bf16_t* H = (bf16_t*)(F.ws + WS_H); const bf16_t* O = (const bf16_t*)(F.ws + WS_U);
    for (int row0 = F.bid * 32 + F.wave * 4; row0 < NTOK; row0 += F.G * 32) {
        f32x4 v[4][4]; u32x2 oa[4][4], ob[4][4];
#pragma unroll
        for (int r = 0; r < 4; ++r)
#pragma unroll
            for (int j = 0; j < 4; ++j) { const int c = 4 * F.lane + 256 * j; const size_t o = (size_t)(row0 + r) * DM + c; v[r][j] = (mode == 2) ? __builtin_nontemporal_load((const f32x4*)(xin + o)) : *(const f32x4*)(xin + o);
                if (add_o) { oa[r][j] = __builtin_nontemporal_load((const u32x2*)(O + o)); ob[r][j] = __builtin_nontemporal_load((const u32x2*)(O + (size_t)NTOK * DM + o)); } }
#pragma unroll
        for (int r = 0; r < 4; ++r) { const int row = row0 + r; float ss = 0.f;
#pragma unroll
            for (int j = 0; j < 4; ++j) {
                if (add_o) { const u32x2 a = oa[r][j], b = ob[r][j];
                    v[r][j][0] += __uint_as_float(a.x << 16) + __uint_as_float(b.x << 16); v[r][j][1] += __uint_as_float(a.x & 0xffff0000u) + __uint_as_float(b.x & 0xffff0000u);
                    v[r][j][2] += __uint_as_float(a.y << 16) + __uint_as_float(b.y << 16); v[r][j][3] += __uint_as_float(a.y & 0xffff0000u) + __uint_as_float(b.y & 0xffff0000u); }
                ss += v[r][j][0] * v[r][j][0] + v[r][j][1] * v[r][j][1] + v[r][j][2] * v[r][j][2] + v[r][j][3] * v[r][j][3]; }
            ss = wave_sum(ss);
            const float rstd = rsqrtf(ss * (1.0f / DM) + 1e-6f);
#pragma unroll
            for (int j = 0; j < 4; ++j) { const int c = 4 * F.lane + 256 * j; const f32x4 wv = *(const f32x4*)(w + c);
                if (mode == 2) { __builtin_nontemporal_store(v[r][j] * rstd * wv, (f32x4*)(F.out + (size_t)row * DM + c)); }
                else { if (mode == 0) *(f32x4*)(X + (size_t)row * DM + c) = v[r][j];
                    u32x2 o; o.x = pk2(v[r][j][0] * rstd * wv[0], v[r][j][1] * rstd * wv[1]); o.y = pk2(v[r][j][2] * rstd * wv[2], v[r][j][3] * rstd * wv[3]);
                    *(u32x2*)(H + (size_t)row * DM + c) = o; } } }
    }
}

__device__ __forceinline__ void item_kv(const Frame& F_, int layer, int item) { Frame F = relocal(F_);
    const bf16_t* U = (const bf16_t*)(F.ws + WS_U);
    LAS bf16_t* Ab = (LAS bf16_t*)F.lds;
    LAS bf16_t* Bt = (LAS bf16_t*)(F.lds + 17408);
    const int t0 = item * 64;
    { const int tok = F.tid >> 3, part = F.tid & 7; const bf16_t* src = U + (size_t)(t0 + tok) * NINP + UC + 256 + 16 * part;
      float f[16]; { float a[8], b[8]; unpack8(*(const u32x4*)src, a); unpack8(*(const u32x4*)(src + 8), b);
#pragma unroll
        for (int j = 0; j < 8; ++j) { f[j] = a[j]; f[8 + j] = b[j]; } }
      float ss = 0.f;
#pragma unroll
      for (int j = 0; j < 16; ++j) ss += f[j] * f[j];
      ss = sum8(ss);
      const float rstd = rsqrtf(ss * (1.0f / 128.0f) + 1e-6f); const float* nw = F.in[I_CKVN] + layer * 128 + 16 * part;
#pragma unroll
      for (int j = 0; j < 16; j += 2) *(LAS unsigned*)(Ab + tok * 136 + 16 * part + j) = pk2(f[j] * rstd * nw[j], f[j + 1] * rstd * nw[j + 1]); }
    { const int n = F.tid >> 2, kq = F.tid & 3; const float* w = (n < 64 ? F.in[I_CWUK] : F.in[I_CWUV]) + (size_t)layer * 128 * 64 + (n & 63);
      float wv[32];
#pragma unroll
      for (int k = 0; k < 32; ++k) wv[k] = w[(size_t)(32 * kq + k) * 64];
#pragma unroll
      for (int k = 0; k < 32; k += 2) *(LAS unsigned*)(Bt + n * 136 + 32 * kq + k) = pk2(wv[k], wv[k + 1]); }
    if (F.tid < 256) { const int tok = F.tid >> 2, q = F.tid & 3;
        *(u32x4*)((bf16_t*)(F.ws + WS_KIDX) + (size_t)(t0 + tok) * 32 + 8 * q) = *(const u32x4*)(U + (size_t)(t0 + tok) * NINP + UC + 640 + 8 * q); }
    __syncthreads();
    const int mt = F.wave & 3, g = F.lane >> 4, r = F.lane & 15;
#pragma unroll
    for (int q = 0; q < 4; ++q) { const int nt = (F.wave >> 2) * 4 + q;
        f32x4 acc = (f32x4){0.f, 0.f, 0.f, 0.f};
        acc = mma_nt<128>(Ab + mt * 16 * 136, 136, Bt + nt * 16 * 136, 136, acc, F.lane);
        const int n = nt * 16 + r; bf16_t* dst = (bf16_t*)(F.ws + (n < 64 ? WS_K : WS_V));
#pragma unroll
        for (int i = 0; i < 4; ++i) dst[(size_t)(t0 + mt * 16 + 4 * g + i) * 64 + (n & 63)] = f2bf(acc[i]); }
}

constexpr int MB_CG = 0, MB_BG = 18432, MB_XT = 36864, MB_BT = 73728, MB_M = 73728, MB_S0 = 110592, MB_DT = 147456, MB_AC = 148480, MB_RS = 149504;
static_assert(MB_RS + 256 <= MISC_OFF && MB_BT == MB_XT + 4 * 64 * 72 * 2, "mamba LDS");
template <int STAGE> __device__ __forceinline__ void item_mamba(const Frame& F_, int layer, int item) { Frame F = relocal(F_);
    const bf16_t* U = (const bf16_t*)(F.ws + WS_U);
    const int b = item >> 6, c = item & 63, l0 = c * 64; const size_t T0 = (size_t)b * SEQ + l0;
    LAS bf16_t* Cg = (LAS bf16_t*)(F.lds + MB_CG); LAS bf16_t* Bg = (LAS bf16_t*)(F.lds + MB_BG); LAS bf16_t* BT = (LAS bf16_t*)(F.lds + MB_BT);
    LAS bf16_t* XT = (LAS bf16_t*)(F.lds + MB_XT); LAS bf16_t* Mb = (LAS bf16_t*)(F.lds + MB_M); LAS bf16_t* S0 = (LAS bf16_t*)(F.lds + MB_S0);
    LAS float* dts = (LAS float*)(F.lds + MB_DT); LAS float* acs = (LAS float*)(F.lds + MB_AC); LAS float* rs = (LAS float*)(F.lds + MB_RS);
    const int tg = F.tid & 7, c0 = (F.tid >> 3) * 8;
    const bool conv_on = (STAGE == 2) || (F.wave < 6);
    u32x4 rows[11]; float wv[4][8], bv[8];
    if (conv_on) {
#pragma unroll
        for (int k = 0; k < 11; ++k) { const int l = l0 + tg * 8 - 3 + k;
            if (l >= 0) rows[k] = *(const u32x4*)(U + ((size_t)b * SEQ + l) * NINP + UM + 256 + c0); else rows[k] = (u32x4){0u, 0u, 0u, 0u}; }
#pragma unroll
        for (int j = 0; j < 8; ++j) { bv[j] = F.in[I_MCONVB][layer * 512 + c0 + j];
#pragma unroll
            for (int k = 0; k < 4; ++k) wv[k][j] = F.in[I_MCONVW][(layer * 4 + k) * 512 + c0 + j]; } }
    const float* MSTi = (const float*)(F.ws + WS_MST) + ((size_t)(b * 64 + c) * 4) * 4096;
    f32x4 s0a[4], s0b[4];
    if (STAGE == 2) {
#pragma unroll
        for (int h = 0; h < 4; ++h) { const float* src = MSTi + (size_t)h * 4096 + F.tid * 8; s0a[h] = *(const f32x4*)src; s0b[h] = *(const f32x4*)(src + 4); } }
    if (F.wave < 4) { const int l = F.lane, h = F.wave;
        const float raw = bf2f(U[(T0 + l) * NINP + UM + 768 + h]) + F.in[I_MDTB][layer * 4 + h];
        const float dt = softplusf_(raw); float cum = -__expf(F.in[I_MALOG][layer * 4 + h]) * dt;
#pragma unroll
        for (int o = 1; o < 64; o <<= 1) { const float t = __int_as_float(__builtin_amdgcn_ds_bpermute(((lane_id_() - o) & 63) << 2, __float_as_int(cum))); if (l >= o) cum += t; }
        dts[l * 4 + h] = dt; acs[l * 4 + h] = cum; }
    if (STAGE == 2) { if (F.tid < 64) rs[F.tid] = 0.f;
#pragma unroll
        for (int h = 0; h < 4; ++h) { u32x4 w; w.x = pk2(s0a[h][0], s0a[h][1]); w.y = pk2(s0a[h][2], s0a[h][3]); w.z = pk2(s0b[h][0], s0b[h][1]); w.w = pk2(s0b[h][2], s0b[h][3]);
            *(LAS u32x4*)(S0 + (h * 64 + (F.tid >> 3)) * 72 + (F.tid & 7) * 8) = w; } }
    __syncthreads();
    if (conv_on) {
        float win[3][8]; unpack8(rows[0], win[0]); unpack8(rows[1], win[1]); unpack8(rows[2], win[2]);
        const bool isx = F.wave < 4, tr = isx || STAGE == 1;
        unsigned pkT[8][4]; float prev[8];
#pragma unroll
        for (int i = 0; i < 8; ++i) { const int l = tg * 8 + i; float cur[8]; unpack8(rows[3 + i], cur);
            float o[8];
#pragma unroll
            for (int j = 0; j < 8; ++j) { o[j] = siluf_(bv[j] + wv[0][j] * win[0][j] + wv[1][j] * win[1][j] + wv[2][j] * win[2][j] + wv[3][j] * cur[j]);
                win[0][j] = win[1][j]; win[1][j] = win[2][j]; win[2][j] = cur[j]; }
            if (isx) { const int h = F.wave; float sc = dts[l * 4 + h]; if (STAGE == 1) sc *= __expf(acs[63 * 4 + h] - acs[l * 4 + h]);
#pragma unroll
                for (int j = 0; j < 8; ++j) o[j] *= sc; }
            if (tr) {
#pragma unroll
                for (int j = 0; j < 8; ++j) { if (i & 1) pkT[j][i >> 1] = pk2(prev[j], o[j]); else prev[j] = o[j]; } }
            else { u32x4 w; w.x = pk2(o[0], o[1]); w.y = pk2(o[2], o[3]); w.z = pk2(o[4], o[5]); w.w = pk2(o[6], o[7]);
                *(LAS u32x4*)(Cg + (F.wave < 6 ? (MB_BG - MB_CG) / 2 : 0) + ((F.wave & 1) * 64 + l) * 72 + (c0 & 63)) = w; } }
        if (tr) { LAS bf16_t* dstT = XT + F.wave * 64 * 72;
#pragma unroll
            for (int j = 0; j < 8; ++j) *(LAS u32x4*)(dstT + ((c0 & 63) + j) * 72 + tg * 8) = (u32x4){pkT[j][0], pkT[j][1], pkT[j][2], pkT[j][3]}; } }
    const int g4 = F.lane >> 4, r16 = F.lane & 15;
    if (STAGE == 1) {
        __syncthreads();
        float* MST = (float*)(F.ws + WS_MST) + ((size_t)(b * 64 + c) * 4) * 4096;
#pragma unroll
        for (int q = 0; q < 8; ++q) { const int tix = F.wave * 8 + q, h = tix >> 4, mt = (tix >> 2) & 3, nt = tix & 3;
            f32x4 acc = (f32x4){0.f, 0.f, 0.f, 0.f};
            acc = mma_nt<64>(XT + (h * 64 + mt * 16) * 72, 72, BT + ((h >> 1) * 64 + nt * 16) * 72, 72, acc, F.lane);
#pragma unroll
            for (int i = 0; i < 4; ++i) MST[(size_t)h * 4096 + (mt * 16 + 4 * g4 + i) * 64 + nt * 16 + r16] = acc[i]; }
        if (F.tid < 4) ((float*)(F.ws + WS_MDEC))[(b * 64 + c) * 4 + F.tid] = __expf(acs[63 * 4 + F.tid]);
    } else {
        const int mt = F.wave & 3, nh = F.wave >> 2;
        bf16_t zz[4][2][4];
#pragma unroll
        for (int h = 0; h < 4; ++h)
#pragma unroll
            for (int q = 0; q < 2; ++q)
#pragma unroll
                for (int i = 0; i < 4; ++i) zz[h][q][i] = U[(T0 + mt * 16 + 4 * g4 + i) * NINP + UM + h * 64 + (2 * nh + q) * 16 + r16];
        __syncthreads();
        f32x4 yv[4][2];
#pragma unroll
        for (int g = 0; g < 2; ++g)
#pragma unroll
            for (int q = 0; q < 2; ++q) { f32x4 G = (f32x4){0.f, 0.f, 0.f, 0.f};
                G = mma_nt<64>(Cg + (g * 64 + mt * 16) * 72, 72, Bg + (g * 64 + (2 * nh + q) * 16) * 72, 72, G, F.lane);
                const int s = (2 * nh + q) * 16 + r16;
#pragma unroll
                for (int hh = 0; hh < 2; ++hh) { const int h = 2 * g + hh; const float as = acs[s * 4 + h];
#pragma unroll
                    for (int i = 0; i < 4; ++i) { const int l = mt * 16 + 4 * g4 + i; const float v = (s <= l) ? G[i] * __expf(acs[l * 4 + h] - as) : 0.f;
                        Mb[(h * 64 + l) * 72 + s] = f2bf(v); } } }
        __syncthreads();
#pragma unroll
        for (int h = 0; h < 4; ++h) { const int g = h >> 1;
#pragma unroll
            for (int q = 0; q < 2; ++q) { const int nt = 2 * nh + q;
                f32x4 yd = (f32x4){0.f, 0.f, 0.f, 0.f}, yo = (f32x4){0.f, 0.f, 0.f, 0.f};
                yd = mma_nt<64>(Mb + (h * 64 + mt * 16) * 72, 72, XT + (h * 64 + nt * 16) * 72, 72, yd, F.lane);
                yo = mma_nt<64>(Cg + (g * 64 + mt * 16) * 72, 72, S0 + (h * 64 + nt * 16) * 72, 72, yo, F.lane);
                const int p = nt * 16 + r16; const float dsk = F.in[I_MD][layer * 4 + h];
#pragma unroll
                for (int i = 0; i < 4; ++i) { const int l = mt * 16 + 4 * g4 + i;
                    const float xs = bf2f(XT[(h * 64 + p) * 72 + l]) / dts[l * 4 + h];
                    yv[h][q][i] = yd[i] + yo[i] * __expf(acs[l * 4 + h]) + dsk * xs; } } }
        float part[4] = {0.f, 0.f, 0.f, 0.f};
#pragma unroll
        for (int h = 0; h < 4; ++h)
#pragma unroll
            for (int q = 0; q < 2; ++q) {
#pragma unroll
                for (int i = 0; i < 4; ++i) { const float z = bf2f(zz[h][q][i]);
                    const float v = yv[h][q][i] * siluf_(z); yv[h][q][i] = v; part[i] += v * v; } }
#pragma unroll
        for (int i = 0; i < 4; ++i) { const float s = sum16(part[i]); if (r16 == 0) atomicAdd((float*)(rs + mt * 16 + 4 * g4 + i), s); }
        __syncthreads();
        bf16_t* Y = (bf16_t*)(F.ws + WS_H);
#pragma unroll
        for (int i = 0; i < 4; ++i) { const int l = mt * 16 + 4 * g4 + i; const float rstd = rsqrtf(rs[l] * (1.0f / 256.0f) + 1e-6f);
#pragma unroll
            for (int h = 0; h < 4; ++h)
#pragma unroll
                for (int q = 0; q < 2; ++q) { const int ch = h * 64 + (2 * nh + q) * 16 + r16;
                    Y[(T0 + l) * DM + ch] = f2bf(yv[h][q][i] * rstd * F.in[I_MNORM][layer * 256 + ch]); } }
    }
}
__device__ __forceinline__ void item_mamba_carry(const Frame& F_, int item) { Frame F = relocal(F_);
    const int b = item >> 2, h = item & 3;
    float* MST = (float*)(F.ws + WS_MST); const float* MD = (const float*)(F.ws + WS_MDEC);
    float s[8];
#pragma unroll
    for (int j = 0; j < 8; ++j) s[j] = 0.f;
    for (int c = 0; c < 64; ++c) { float* p = MST + ((size_t)(b * 64 + c) * 4 + h) * 4096 + F.tid * 8; const float d = MD[(b * 64 + c) * 4 + h];
        const f32x4 a = *(f32x4*)p, q = *(f32x4*)(p + 4);
        *(f32x4*)p = (f32x4){s[0], s[1], s[2], s[3]}; *(f32x4*)(p + 4) = (f32x4){s[4], s[5], s[6], s[7]};
        s[0] = s[0] * d + a[0]; s[1] = s[1] * d + a[1]; s[2] = s[2] * d + a[2]; s[3] = s[3] * d + a[3];
        s[4] = s[4] * d + q[0]; s[5] = s[5] * d + q[1]; s[6] = s[6] * d + q[2]; s[7] = s[7] * d + q[3]; }
}

template <int STAGE> __device__ __forceinline__ void item_s5(const Frame& F_, int layer, int item) { Frame F = relocal(F_);
    const bf16_t* U = (const bf16_t*)(F.ws + WS_U);
    const int b = item >> 6, c = item & 63; const size_t T0 = (size_t)b * SEQ + c * 64;
    LAS bf16_t* us = (LAS bf16_t*)F.lds;
    LAS bf16_t* BuW = (LAS bf16_t*)(F.lds + 33792) + F.wave * 4224;
    const float* tab = (const float*)(F.ws + WS_S5TAB + (size_t)layer * S5TAB_L);
    { const int tok = F.tid >> 3, part = F.tid & 7;
#pragma unroll
      for (int q = 0; q < 4; ++q) *(LAS u32x4*)(us + tok * 264 + 32 * part + 8 * q) = *(const u32x4*)(U + (T0 + tok) * NINP + US + 32 * part + 8 * q); }
    const int lane = F.lane, r16 = lane & 15, g4 = lane >> 4, gq = lane >> 5, n0 = lane & 31, g = 2 * F.wave + gq, gn0 = g * 64 + n0, gn1 = gn0 + 32;
    bf16x8 bfr[2][8];
    { const bf16_t* bbt = (const bf16_t*)(F.ws + WS_S5TAB + (size_t)layer * S5TAB_L + S5TAB_BBT);
#pragma unroll
      for (int gg = 0; gg < 2; ++gg)
#pragma unroll
          for (int nt = 0; nt < 8; ++nt) { u32x4 z = (u32x4){0u, 0u, 0u, 0u}; if (g4 < 2) z = *(const u32x4*)(bbt + ((size_t)(2 * F.wave + gg) * 128 + 16 * nt + r16) * 16 + 8 * g4); bfr[gg][nt] = __builtin_bit_cast(bf16x8, z); } }
    const float a0r = tab[gn0 * 2], a0i = tab[gn0 * 2 + 1], a1r = tab[gn1 * 2], a1i = tab[gn1 * 2 + 1];
    float* ST = (float*)(F.ws + WS_S5ST) + (size_t)(b * 64 + c) * 2048;
    float h0r = 0.f, h0i = 0.f, h1r = 0.f, h1i = 0.f;
    if (STAGE == 2) { h0r = ST[gn0 * 2]; h0i = ST[gn0 * 2 + 1]; h1r = ST[gn1 * 2]; h1i = ST[gn1 * 2 + 1]; }
    bf16x8 cf[2][4];
    if (STAGE == 2) { const bf16_t* cm = (const bf16_t*)(F.ws + WS_S5TAB + (size_t)layer * S5TAB_L + S5TAB_F);
#pragma unroll
        for (int gg = 0; gg < 2; ++gg)
#pragma unroll
            for (int ks = 0; ks < 4; ++ks) cf[gg][ks] = *(const bf16x8*)(cm + ((size_t)((2 * F.wave + gg) * 16 + r16)) * 128 + 32 * ks + 8 * g4); }
    __syncthreads();
#pragma unroll 1
    for (int lb = 0; lb < 4; ++lb) {
#pragma unroll
        for (int gg = 0; gg < 2; ++gg) { u32x4 z = (u32x4){0u, 0u, 0u, 0u}; if (g4 < 2) z = *(const LAS u32x4*)(us + (16 * lb + r16) * 264 + (2 * F.wave + gg) * 16 + 8 * g4);
            const bf16x8 afr = __builtin_bit_cast(bf16x8, z);
#pragma unroll
            for (int nt = 0; nt < 8; ++nt) { const f32x4 acc = __builtin_amdgcn_mfma_f32_16x16x32_bf16(afr, bfr[gg][nt], (f32x4){0.f, 0.f, 0.f, 0.f}, 0, 0, 0);
#pragma unroll
                for (int i = 0; i < 4; ++i) BuW[(4 * g4 + i) * 264 + gg * 128 + 16 * nt + r16] = f2bf(acc[i]); } }
        __syncthreads();
#pragma unroll 4
        for (int li = 0; li < 16; ++li) { LAS u32x2* bp = (LAS u32x2*)(BuW + li * 264 + gq * 128 + 4 * n0); const u32x2 v = *bp;
            { const float br = __uint_as_float(v.x << 16), bi = __uint_as_float(v.x & 0xffff0000u); const float nr = a0r * h0r - a0i * h0i + br, ni = a0r * h0i + a0i * h0r + bi; h0r = nr; h0i = ni; }
            { const float br = __uint_as_float(v.y << 16), bi = __uint_as_float(v.y & 0xffff0000u); const float nr = a1r * h1r - a1i * h1i + br, ni = a1r * h1i + a1i * h1r + bi; h1r = nr; h1i = ni; }
            if (STAGE == 2) *bp = (u32x2){pk2(h0r, h0i), pk2(h1r, h1i)}; }
        __syncthreads();
        if (STAGE == 2) {
            bf16_t* YS = (bf16_t*)(F.ws + WS_MOE + YSG_OFF);
#pragma unroll
            for (int gg = 0; gg < 2; ++gg) { f32x4 acc = (f32x4){0.f, 0.f, 0.f, 0.f};
#pragma unroll
                for (int ks = 0; ks < 4; ++ks) { const bf16x8 a = *(const LAS bf16x8*)(BuW + r16 * 264 + gg * 128 + 32 * ks + 8 * g4);
                    acc = __builtin_amdgcn_mfma_f32_16x16x32_bf16(a, cf[gg][ks], acc, 0, 0, 0); }
                const int ch = (2 * F.wave + gg) * 16 + r16; const float dsk = F.in[I_SD][layer * 256 + ch];
#pragma unroll
                for (int i = 0; i < 4; ++i) { const int l = lb * 16 + 4 * g4 + i; const float y = acc[i] + dsk * bf2f(us[l * 264 + ch]);
                    YS[(T0 + l) * 256 + ch] = f2bf(gelu_tanh(y)); } }
            __syncthreads();
        }
    }
    if (STAGE == 1) { ST[gn0 * 2] = h0r; ST[gn0 * 2 + 1] = h0i; ST[gn1 * 2] = h1r; ST[gn1 * 2 + 1] = h1i; }
    if (STAGE == 2) {
        asm volatile("s_waitcnt vmcnt(0)" ::: "memory"); __syncthreads();
        const bf16_t* YS = (const bf16_t*)(F.ws + WS_MOE + YSG_OFF) + T0 * 256; const bf16_t* GW = (const bf16_t*)(F.ws + WS_GLU) + (size_t)layer * 512 * 256;
        const int r16 = F.lane & 15, g4 = F.lane >> 4;
        f32x4 av[4][2], ag[4][2];
#pragma unroll
        for (int m = 0; m < 4; ++m)
#pragma unroll
            for (int q = 0; q < 2; ++q) { av[m][q] = (f32x4){0.f, 0.f, 0.f, 0.f}; ag[m][q] = (f32x4){0.f, 0.f, 0.f, 0.f}; }
#pragma unroll 2
        for (int ks = 0; ks < 8; ++ks) {
            bf16x8 af[4], bv[2], bg[2];
#pragma unroll
            for (int m = 0; m < 4; ++m) af[m] = *(const bf16x8*)(YS + (size_t)(16 * m + r16) * 256 + 32 * ks + 8 * g4);
#pragma unroll
            for (int q = 0; q < 2; ++q) { const int c = 32 * F.wave + 16 * q + r16; const int rowv = 256 * (c >> 7) + (c & 127);
                bv[q] = *(const bf16x8*)(GW + (size_t)rowv * 256 + 32 * ks + 8 * g4); bg[q] = *(const bf16x8*)(GW + (size_t)(rowv + 128) * 256 + 32 * ks + 8 * g4); }
#pragma unroll
            for (int m = 0; m < 4; ++m)
#pragma unroll
                for (int q = 0; q < 2; ++q) { av[m][q] = __builtin_amdgcn_mfma_f32_16x16x32_bf16(af[m], bv[q], av[m][q], 0, 0, 0); ag[m][q] = __builtin_amdgcn_mfma_f32_16x16x32_bf16(af[m], bg[q], ag[m][q], 0, 0, 0); }
        }
        bf16_t* Y = (bf16_t*)(F.ws + WS_H);
#pragma unroll
        for (int q = 0; q < 2; ++q) { const int c = 32 * F.wave + 16 * q + r16; const float bvl = F.in[I_SGLUB][layer * 512 + c], bgt = F.in[I_SGLUB][layer * 512 + 256 + c];
#pragma unroll
            for (int m = 0; m < 4; ++m)
#pragma unroll
                for (int i = 0; i < 4; ++i) Y[(T0 + 16 * m + 4 * g4 + i) * DM + 768 + c] = f2bf((av[m][q][i] + bvl) * sigmoidf_(ag[m][q][i] + bgt)); }
    }
}
__device__ __forceinline__ void item_s5_carry(const Frame& F_, int layer, int b) { Frame F = relocal(F_);
    const float* tab = (const float*)(F.ws + WS_S5TAB + (size_t)layer * S5TAB_L) + 2048;
    float* ST = (float*)(F.ws + WS_S5ST) + (size_t)b * 64 * 2048;
#pragma unroll
    for (int q = 0; q < 2; ++q) { const int gn = F.tid + 512 * q; const float pr = tab[gn * 2], pi = tab[gn * 2 + 1]; float hr = 0.f, hi = 0.f;
        for (int c = 0; c < 64; ++c) { float* p = ST + (size_t)c * 2048 + gn * 2; const float tr = p[0], ti = p[1]; p[0] = hr; p[1] = hi;
            const float nr = pr * hr - pi * hi + tr, ni = pr * hi + pi * hr + ti; hr = nr; hi = ni; } }
}

constexpr int RB_LD = 72;
constexpr int RW_R = 0, RW_K = 16384, RW_V = 32768, RW_W = 49152, RW_A = 65536, RW_B = 81920;
constexpr int R3_G = 49152, R3_O = 65536, R3_TILES = 81920, R3_BON = 147456;
template <int STAGE> __device__ __forceinline__ void rwkv_prep(const Frame& F_, int layer, int b, int h, int c) { Frame F = relocal(F_);
    const bf16_t* U = (const bf16_t*)(F.ws + WS_U);
    const int l0 = c * 64; const size_t T0 = (size_t)b * SEQ + l0;
    LAS float* Rr = (LAS float*)(F.lds + RW_R); LAS float* Kk = (LAS float*)(F.lds + RW_K); LAS float* Vv = (LAS float*)(F.lds + RW_V); LAS float* Ww = (LAS float*)(F.lds + RW_W);
    LAS float* Aa = (LAS float*)(F.lds + (STAGE == 1 ? RW_A : R3_O)); LAS float* Bb = (LAS float*)(F.lds + RW_B); LAS float* Gg = (LAS float*)(F.lds + R3_G); LAS float* BON = (LAS float*)(F.lds + R3_BON);
    LAS bf16_t* TWb = (LAS bf16_t*)(F.lds + 98304); LAS bf16_t* DAb = (LAS bf16_t*)(F.lds + (STAGE == 1 ? 103424 : 118784)); LAS bf16_t* SGb = (LAS bf16_t*)(F.lds + 123904);
    LAS bf16_t* w2T = (LAS bf16_t*)(F.lds + 108544); LAS bf16_t* a2T = (LAS bf16_t*)(F.lds + (STAGE == 1 ? 113664 : 133120)); LAS bf16_t* g2T = (LAS bf16_t*)(F.lds + 138240);
    const float* mu = F.in[I_RMU] + layer * 896;
    { const int tok = F.tid >> 3, p8 = F.tid & 7; const bool first = (l0 + tok == 0);
      const bf16_t* cur = U + (T0 + tok) * NINP + UR; const bf16_t* prv = first ? cur : cur - NINP;
      const float pz = first ? 0.f : 1.f;
      u32x4 cw[3], pw[3]; u32x2 c1 = (u32x2){0u, 0u}, p1 = (u32x2){0u, 0u}, c2 = (u32x2){0u, 0u}, p2 = (u32x2){0u, 0u}; u32x4 c3 = (u32x4){0u, 0u, 0u, 0u}, p3 = (u32x4){0u, 0u, 0u, 0u};
#pragma unroll
      for (int sec = (STAGE == 1 ? 0 : 2); sec < 3; ++sec) { const int co = sec * 256 + h * 64 + 8 * p8; cw[sec] = *(const u32x4*)(cur + co); pw[sec] = *(const u32x4*)(prv + co); }
      if (STAGE == 1) { c1 = *(const u32x2*)(cur + 768 + 4 * p8); p1 = *(const u32x2*)(prv + 768 + 4 * p8); c2 = *(const u32x2*)(cur + 800 + 4 * p8); p2 = *(const u32x2*)(prv + 800 + 4 * p8); }
      if (STAGE == 3) { c3 = *(const u32x4*)(cur + 832 + 8 * p8); p3 = *(const u32x4*)(prv + 832 + 8 * p8); }
#pragma unroll
      for (int sec = (STAGE == 1 ? 0 : 2); sec < 3; ++sec) { const int co = sec * 256 + h * 64 + 8 * p8; float av[8], pq[8]; unpack8(cw[sec], av); unpack8(pw[sec], pq);
          const f32x4 m0 = *(const f32x4*)(mu + co), m1 = *(const f32x4*)(mu + co + 4);
          LAS float* dst = (sec == 0 ? Rr : sec == 1 ? Kk : Vv) + tok * 64 + 8 * p8;
#pragma unroll
          for (int j = 0; j < 8; ++j) pq[j] *= pz;
          *(LAS f32x4*)dst = (f32x4){av[0] + m0[0] * (pq[0] - av[0]), av[1] + m0[1] * (pq[1] - av[1]), av[2] + m0[2] * (pq[2] - av[2]), av[3] + m0[3] * (pq[3] - av[3])};
          *(LAS f32x4*)(dst + 4) = (f32x4){av[4] + m1[0] * (pq[4] - av[4]), av[5] + m1[1] * (pq[5] - av[5]), av[6] + m1[2] * (pq[6] - av[6]), av[7] + m1[3] * (pq[7] - av[7])}; }
      if (STAGE == 1) {
#pragma unroll
        for (int which = 0; which < 2; ++which) { const int co = 768 + 32 * which + 4 * p8; const u32x2 cv = which ? c2 : c1, pv = which ? p2 : p1;
          const f32x4 m0 = *(const f32x4*)(mu + co);
          float x[4] = {__uint_as_float(cv.x << 16), __uint_as_float(cv.x & 0xffff0000u), __uint_as_float(cv.y << 16), __uint_as_float(cv.y & 0xffff0000u)};
          const float y[4] = {pz * __uint_as_float(pv.x << 16), pz * __uint_as_float(pv.x & 0xffff0000u), pz * __uint_as_float(pv.y << 16), pz * __uint_as_float(pv.y & 0xffff0000u)};
#pragma unroll
          for (int j = 0; j < 4; ++j) { x[j] = x[j] + m0[j] * (y[j] - x[j]); if (which == 0) x[j] = tanhf_(x[j]); }
          *(LAS u32x2*)((which ? DAb : TWb) + tok * 40 + 4 * p8) = (u32x2){pk2(x[0], x[1]), pk2(x[2], x[3])}; } }
      if (STAGE == 3) { const int co = 832 + 8 * p8; float av[8], pq[8]; unpack8(c3, av); unpack8(p3, pq);
          const f32x4 m0 = *(const f32x4*)(mu + co), m1 = *(const f32x4*)(mu + co + 4); float x[8];
#pragma unroll
          for (int j = 0; j < 8; ++j) x[j] = sigmoidf_(av[j] + (j < 4 ? m0[j] : m1[j - 4]) * (pz * pq[j] - av[j]));
          *(LAS u32x4*)(SGb + tok * RB_LD + 8 * p8) = (u32x4){pk2(x[0], x[1]), pk2(x[2], x[3]), pk2(x[4], x[5]), pk2(x[6], x[7])}; } }
    { const int ch = F.tid & 63, part = F.tid >> 6;
      if (STAGE == 1) { const float* w2 = F.in[I_RW2] + ((size_t)layer * 32 + 4 * part) * 256 + h * 64 + ch;
          *(LAS u32x2*)(w2T + ch * 40 + 4 * part) = (u32x2){pk2(w2[0], w2[256]), pk2(w2[512], w2[768])}; }
      if (STAGE == 1) { const float* a2 = F.in[I_RA2] + ((size_t)layer * 32 + 4 * part) * 256 + h * 64 + ch;
          *(LAS u32x2*)(a2T + ch * 40 + 4 * part) = (u32x2){pk2(a2[0], a2[256]), pk2(a2[512], a2[768])}; }
      if (STAGE == 3) { const float* g2 = F.in[I_RG2] + ((size_t)layer * 64 + 8 * part) * 256 + h * 64 + ch;
          *(LAS u32x4*)(g2T + ch * RB_LD + 8 * part) = (u32x4){pk2(g2[0], g2[256]), pk2(g2[512], g2[768]), pk2(g2[1024], g2[1280]), pk2(g2[1536], g2[1792])}; } }
    __syncthreads();
    { const int lane = F.lane, mt = F.wave >> 1, nt0 = 2 * (F.wave & 1), r = lane & 15, g4 = lane >> 4; const f32x4 zero4 = (f32x4){0.f, 0.f, 0.f, 0.f};
#pragma unroll
      for (int q = 0; q < 2; ++q) { const int nt = nt0 + q, ch = 16 * nt + r, cg = layer * 256 + h * 64 + ch;
          if (STAGE == 1) { const f32x4 wl = mma_nt<32>(TWb + 16 * mt * 40, 40, w2T + 16 * nt * 40, 40, zero4, lane); const float w0 = F.in[I_RW0][cg];
#pragma unroll
              for (int i = 0; i < 4; ++i) { const float x = w0 + wl[i]; const float wlog = -__logf(1.0f + __expf(-x)) - 0.5f; Ww[(16 * mt + 4 * g4 + i) * 64 + ch] = __expf(-__expf(wlog)); } }
          if (STAGE == 1) { const f32x4 al = mma_nt<32>(DAb + 16 * mt * 40, 40, a2T + 16 * nt * 40, 40, zero4, lane); const float a0 = F.in[I_RA0][cg];
#pragma unroll
              for (int i = 0; i < 4; ++i) Aa[(16 * mt + 4 * g4 + i) * 64 + ch] = sigmoidf_(a0 + al[i]); }
          if (STAGE == 3) { const f32x4 gv = mma_nt<64>(SGb + 16 * mt * RB_LD, RB_LD, g2T + 16 * nt * RB_LD, RB_LD, zero4, lane);
#pragma unroll
              for (int i = 0; i < 4; ++i) Gg[(16 * mt + 4 * g4 + i) * 64 + ch] = gv[i]; } } }
    __syncthreads();
    float* gBON = (float*)(F.ws + WS_BON) + ((size_t)(b * 4 + h) * 64 + c) * 64;
    if (STAGE == 1) { const int j = F.lane, tq = F.wave, cg = layer * 256 + h * 64 + j;
      const float kkw = F.in[I_RKK][cg], kaw = F.in[I_RKA][cg], rk = F.in[I_RRK][cg];
#pragma unroll 2
      for (int i8 = 0; i8 < 8; ++i8) { const int t = tq + 8 * i8;
          const float a = Aa[t * 64 + j]; const float kraw = Kk[t * 64 + j]; const float kp = kraw * (1.0f + (a - 1.0f) * kaw);
          Kk[t * 64 + j] = kp;
          const float kkv = kraw * kkw; const float ss = wave_sum(kkv * kkv); const float kkn = kkv * rsqrtf(fmaxf(ss, 1e-24f)); Aa[t * 64 + j] = -kkn; Bb[t * 64 + j] = kkn * a;
          const float bo = wave_sum(Rr[t * 64 + j] * kp * rk); if (j == 0) gBON[t] = bo; } }
    else if (F.tid < 64) BON[F.tid] = gBON[F.tid];
    __syncthreads();
}
constexpr int RB_AT = 98304, RB_ATT = RB_AT + 9216, RB_BT = RB_ATT + 9216, RB_BTT = RB_BT + 9216, RB_KT = RB_BTT + 9216, RB_RT = RB_KT + 9216, RB_VT = RB_RT + 9216, RB_GC = RB_VT + 9216;
constexpr int RX_X = 0, RX_XT = 9216, RX_TB = 18432, RX_M = 27648, RX_NRT = 36864, RX_G1T = 46080, RX_G2T = 55296, RX_QT = 64512;
__device__ __forceinline__ void st_tile(LAS bf16_t* dst, int mt, int nt, const f32x4 v, int lane) {
    const int r = lane & 15, g = lane >> 4;
#pragma unroll
    for (int i = 0; i < 4; ++i) dst[(16 * mt + 4 * g + i) * RB_LD + 16 * nt + r] = f2bf(v[i]);
}
__device__ __forceinline__ void st_tile_t(LAS bf16_t* dst, int mt, int nt, const f32x4 v, int lane) {
    const int r = lane & 15, g = lane >> 4; u32x2 w; w.x = pk2(v[0], v[1]); w.y = pk2(v[2], v[3]);
    *(LAS u32x2*)(dst + (16 * nt + r) * RB_LD + 16 * mt + 4 * g) = w;
}
__device__ __forceinline__ void item_rwkv1(const Frame& F_, int layer, int item) { Frame F = relocal(F_);
    const int b = item >> 8, h = (item >> 6) & 3, c = item & 63;
    rwkv_prep<1>(F, layer, b, h, c);
    LAS float* Rr = (LAS float*)(F.lds + RW_R); LAS float* Kk = (LAS float*)(F.lds + RW_K); LAS float* Vv = (LAS float*)(F.lds + RW_V); LAS float* Ww = (LAS float*)(F.lds + RW_W);
    LAS float* Aa = (LAS float*)(F.lds + RW_A); LAS float* Bb = (LAS float*)(F.lds + RW_B);
    LAS bf16_t* At = (LAS bf16_t*)(F.lds + RB_AT); LAS bf16_t* AtT = (LAS bf16_t*)(F.lds + RB_ATT); LAS bf16_t* Bt = (LAS bf16_t*)(F.lds + RB_BT); LAS bf16_t* BtT = (LAS bf16_t*)(F.lds + RB_BTT);
    LAS bf16_t* Kt = (LAS bf16_t*)(F.lds + RB_KT); LAS bf16_t* Rt = (LAS bf16_t*)(F.lds + RB_RT); LAS bf16_t* VT = (LAS bf16_t*)(F.lds + RB_VT); LAS float* gC = (LAS float*)(F.lds + RB_GC);
    LAS bf16_t* X = (LAS bf16_t*)(F.lds + RX_X); LAS bf16_t* XT = (LAS bf16_t*)(F.lds + RX_XT); LAS bf16_t* Tb = (LAS bf16_t*)(F.lds + RX_TB); LAS bf16_t* Mm = (LAS bf16_t*)(F.lds + RX_M);
    LAS bf16_t* NrT = (LAS bf16_t*)(F.lds + RX_NRT); LAS bf16_t* G1T = (LAS bf16_t*)(F.lds + RX_G1T); LAS bf16_t* G2T = (LAS bf16_t*)(F.lds + RX_G2T); LAS bf16_t* QT = (LAS bf16_t*)(F.lds + RX_QT);
    { const int k = F.tid & 63, part = F.tid >> 6; float g = 1.0f;
      for (int pp = 0; pp < part; ++pp) { float w8[8];
#pragma unroll
          for (int i = 0; i < 8; ++i) w8[i] = Ww[(8 * pp + i) * 64 + k];
          g *= ((w8[0] * w8[1]) * (w8[2] * w8[3])) * ((w8[4] * w8[5]) * (w8[6] * w8[7])); }
#pragma unroll
      for (int i = 0; i < 8; ++i) { const int t = 8 * part + i; const float gp = g; g *= Ww[t * 64 + k]; const float ig = 1.0f / g;
          const bf16_t av = f2bf(Aa[t * 64 + k] * gp), bv = f2bf(Bb[t * 64 + k] * ig);
          At[t * RB_LD + k] = av; AtT[k * RB_LD + t] = av; Bt[t * RB_LD + k] = bv; BtT[k * RB_LD + t] = bv;
          Kt[t * RB_LD + k] = f2bf(Kk[t * 64 + k] * ig); Rt[t * RB_LD + k] = f2bf(Rr[t * 64 + k] * g); VT[k * RB_LD + t] = f2bf(Vv[t * 64 + k]); }
      if (part == 7) gC[k] = g; }
    __syncthreads();
    const int lane = F.lane, mt = F.wave >> 1, nt0 = 2 * (F.wave & 1), r = lane & 15, g4 = lane >> 4;
    const f32x4 zero4 = (f32x4){0.f, 0.f, 0.f, 0.f};
    f32x4 Tacc[2];
#pragma unroll
    for (int q = 0; q < 2; ++q) { const int nt = nt0 + q;
        f32x4 n = mma_nt<64>(Bt + 16 * mt * RB_LD, RB_LD, At + 16 * nt * RB_LD, RB_LD, zero4, lane);
        f32x4 m = mma_nt<64>(Kt + 16 * mt * RB_LD, RB_LD, At + 16 * nt * RB_LD, RB_LD, zero4, lane);
        f32x4 nr = mma_nt<64>(Rt + 16 * mt * RB_LD, RB_LD, Bt + 16 * nt * RB_LD, RB_LD, zero4, lane);
#pragma unroll
        for (int i = 0; i < 4; ++i) { const int row = 16 * mt + 4 * g4 + i, col = 16 * nt + r;
            n[i] = (row < col) ? n[i] : 0.f; m[i] = (row < col) ? m[i] : 0.f; nr[i] = (col <= row) ? nr[i] : 0.f;
            Tacc[q][i] = n[i] + (row == col ? 1.0f : 0.f); }
        st_tile(X, mt, nt, n, lane); st_tile_t(XT, mt, nt, n, lane); st_tile(Tb, mt, nt, Tacc[q], lane); st_tile(Mm, mt, nt, m, lane); st_tile(NrT, mt, nt, nr, lane); }
    __syncthreads();
#pragma unroll 1
    for (int it = 0; it < 6; ++it) {
        LAS bf16_t* Xr = (it & 1) ? G1T : X; LAS bf16_t* XTr = (it & 1) ? G2T : XT; LAS bf16_t* Tr = (it & 1) ? QT : Tb;
        LAS bf16_t* Xw = (it & 1) ? X : G1T; LAS bf16_t* XTw = (it & 1) ? XT : G2T; LAS bf16_t* Tw = (it & 1) ? Tb : QT;
#pragma unroll
        for (int q = 0; q < 2; ++q) { const int nt = nt0 + q;
            if (it > 0) Tacc[q] = mma_nt<64>(Tr + 16 * mt * RB_LD, RB_LD, XTr + 16 * nt * RB_LD, RB_LD, Tacc[q], lane);
            if (it < 5) { const f32x4 x2 = mma_nt<64>(Xr + 16 * mt * RB_LD, RB_LD, XTr + 16 * nt * RB_LD, RB_LD, zero4, lane); st_tile(Xw, mt, nt, x2, lane); st_tile_t(XTw, mt, nt, x2, lane); }
            st_tile(Tw, mt, nt, Tacc[q], lane); }
        __syncthreads();
    }
#pragma unroll
    for (int q = 0; q < 2; ++q) { const int nt = nt0 + q;
        st_tile(G1T, mt, nt, mma_nt<64>(NrT + 16 * mt * RB_LD, RB_LD, Tb + 16 * nt * RB_LD, RB_LD, zero4, lane), lane);
        st_tile(G2T, mt, nt, mma_nt<64>(BtT + 16 * mt * RB_LD, RB_LD, Tb + 16 * nt * RB_LD, RB_LD, zero4, lane), lane); }
    __syncthreads();
    const size_t ci = (size_t)(b * 4 + h) * 64 + c;
    bf16_t* gPT = (bf16_t*)(F.ws + WS_MOE + RW_PT) + ci * 4096; bf16_t* gW1 = (bf16_t*)(F.ws + WS_MOE + RW_W1) + ci * 4096; bf16_t* gZ = (bf16_t*)(F.ws + WS_MOE + RW_Z) + ci * 4096;
#pragma unroll
    for (int q = 0; q < 2; ++q) { const int nt = nt0 + q; const int col = 16 * nt + r;
        f32x4 w1 = mma_nt<64>(G1T + 16 * mt * RB_LD, RB_LD, AtT + 16 * nt * RB_LD, RB_LD, zero4, lane);
        f32x4 z = mma_nt<64>(G1T + 16 * mt * RB_LD, RB_LD, Mm + 16 * nt * RB_LD, RB_LD, zero4, lane);
        f32x4 mr = mma_nt<64>(Rt + 16 * mt * RB_LD, RB_LD, Kt + 16 * nt * RB_LD, RB_LD, zero4, lane);
        f32x4 p = mma_nt<64>(G2T + 16 * mt * RB_LD, RB_LD, AtT + 16 * nt * RB_LD, RB_LD, zero4, lane);
        f32x4 qq = mma_nt<64>(G2T + 16 * mt * RB_LD, RB_LD, Mm + 16 * nt * RB_LD, RB_LD, zero4, lane);
        const int pos = 32 * (col >> 5) + 8 * ((col >> 2) & 3) + 4 * ((col >> 4) & 1) + (col & 3);
#pragma unroll
        for (int i = 0; i < 4; ++i) { const int row = 16 * mt + 4 * g4 + i;
            gW1[row * 64 + col] = f2bf(w1[i] + bf2f(Rt[row * RB_LD + col]));
            gZ[row * 64 + col] = f2bf(z[i] + (col <= row ? mr[i] : 0.f));
            const float gc = gC[row];
            gPT[row * 64 + pos] = f2bf((p[i] + (row == col ? 1.0f : 0.f)) * gc);
            qq[i] = (qq[i] + bf2f(Kt[col * RB_LD + row])) * gc; }
        st_tile(QT, mt, nt, qq, lane); }
    __syncthreads();
    bf16_t* gU = (bf16_t*)(F.ws + WS_MOE + RW_U) + ci * 4096;
#pragma unroll
    for (int q = 0; q < 2; ++q) { const int nt = nt0 + q;
        const f32x4 u = mma_nt<64>(VT + 16 * mt * RB_LD, RB_LD, QT + 16 * nt * RB_LD, RB_LD, zero4, lane);
#pragma unroll
        for (int i = 0; i < 4; ++i) gU[(16 * mt + 4 * g4 + i) * 64 + 16 * nt + r] = f2bf(u[i]); }
}
__device__ __forceinline__ void item_rwkv_carry(const Frame& F_, int item) { Frame F = relocal(F_);
    const int bh = item * 2 + (F.wave >> 2), nt = F.wave & 3, r = F.lane & 15, g = F.lane >> 4;
    const bf16_t* PT = (const bf16_t*)(F.ws + WS_MOE + RW_PT); const bf16_t* Uc = (const bf16_t*)(F.ws + WS_MOE + RW_U); bf16_t* Ss = (bf16_t*)(F.ws + WS_MOE + RW_S);
    f32x4 acc[4];
#pragma unroll
    for (int m = 0; m < 4; ++m) acc[m] = (f32x4){0.f, 0.f, 0.f, 0.f};
    for (int c = 0; c < 64; ++c) { const size_t ci = (size_t)bh * 64 + c;
        bf16x8 af[4][2]; f32x4 cin[4];
#pragma unroll
        for (int m = 0; m < 4; ++m) { const u32x2 uv = *(const u32x2*)(Uc + ci * 4096 + (16 * nt + r) * 64 + 16 * m + 4 * g);
            cin[m] = (f32x4){__uint_as_float(uv.x << 16), __uint_as_float(uv.x & 0xffff0000u), __uint_as_float(uv.y << 16), __uint_as_float(uv.y & 0xffff0000u)};
#pragma unroll
            for (int s = 0; s < 2; ++s) af[m][s] = *(const bf16x8*)(PT + ci * 4096 + (16 * m + r) * 64 + 32 * s + 8 * g); }
        unsigned pw[4][2];
#pragma unroll
        for (int m = 0; m < 4; ++m) { pw[m][0] = pk2(acc[m][0], acc[m][1]); pw[m][1] = pk2(acc[m][2], acc[m][3]);
            *(u32x2*)(Ss + ci * 4096 + (16 * nt + r) * 64 + 16 * m + 4 * g) = (u32x2){pw[m][0], pw[m][1]}; }
        bf16x8 bfr[2];
#pragma unroll
        for (int s = 0; s < 2; ++s) bfr[s] = __builtin_bit_cast(bf16x8, (u32x4){pw[2 * s][0], pw[2 * s][1], pw[2 * s + 1][0], pw[2 * s + 1][1]});
#pragma unroll
        for (int m = 0; m < 4; ++m) { acc[m] = __builtin_amdgcn_mfma_f32_16x16x32_bf16(af[m][0], bfr[0], cin[m], 0, 0, 0);
            acc[m] = __builtin_amdgcn_mfma_f32_16x16x32_bf16(af[m][1], bfr[1], acc[m], 0, 0, 0); }
    }
}
__device__ __forceinline__ void item_rwkv3(const Frame& F_, int layer, int item) { Frame F = relocal(F_);
    const int b = item >> 8, h = (item >> 6) & 3, c = item & 63; const size_t T0 = (size_t)b * SEQ + c * 64;
    rwkv_prep<3>(F, layer, b, h, c);
    LAS float* Vv = (LAS float*)(F.lds + RW_V); LAS float* Oo = (LAS float*)(F.lds + R3_O);
    LAS float* Gg = (LAS float*)(F.lds + R3_G); LAS float* BON = (LAS float*)(F.lds + R3_BON);
    LAS bf16_t* S0b = (LAS bf16_t*)(F.lds + R3_TILES); LAS bf16_t* W1b = S0b + 4608; LAS bf16_t* Zb = W1b + 4608; LAS bf16_t* VTb = Zb + 4608;
    { const size_t ci = (size_t)(b * 4 + h) * 64 + c; const int row = F.tid >> 3, col = (F.tid & 7) * 8;
      *(LAS u32x4*)(S0b + row * RB_LD + col) = *(const u32x4*)((const bf16_t*)(F.ws + WS_MOE + RW_S) + ci * 4096 + F.tid * 8);
      *(LAS u32x4*)(W1b + row * RB_LD + col) = *(const u32x4*)((const bf16_t*)(F.ws + WS_MOE + RW_W1) + ci * 4096 + F.tid * 8);
      *(LAS u32x4*)(Zb + row * RB_LD + col) = *(const u32x4*)((const bf16_t*)(F.ws + WS_MOE + RW_Z) + ci * 4096 + F.tid * 8);
      const int vv = F.tid & 63, part = F.tid >> 6;
#pragma unroll
      for (int i = 0; i < 8; ++i) { const int t = 8 * part + i; VTb[vv * RB_LD + t] = f2bf(Vv[t * 64 + vv]); } }
    __syncthreads();
    { const int lane = F.lane, mt = F.wave >> 1, nt0 = 2 * (F.wave & 1), r = lane & 15, g4 = lane >> 4;
#pragma unroll
      for (int q = 0; q < 2; ++q) { const int nt = nt0 + q;
          f32x4 o = mma_nt<64>(W1b + 16 * mt * RB_LD, RB_LD, S0b + 16 * nt * RB_LD, RB_LD, (f32x4){0.f, 0.f, 0.f, 0.f}, lane);
          o = mma_nt<64>(Zb + 16 * mt * RB_LD, RB_LD, VTb + 16 * nt * RB_LD, RB_LD, o, lane);
#pragma unroll
          for (int i = 0; i < 4; ++i) Oo[(16 * mt + 4 * g4 + i) * 64 + 16 * nt + r] = o[i]; } }
    __syncthreads();
    { const int j = F.lane, tq = F.wave, ch = h * 64 + j;
      const float lw = F.in[I_RLNW][layer * 256 + ch], lb = F.in[I_RLNB][layer * 256 + ch];
      bf16_t* Y = (bf16_t*)(F.ws + WS_H);
#pragma unroll 2
      for (int i8 = 0; i8 < 8; ++i8) { const int t = tq + 8 * i8;
          const float o = Oo[t * 64 + j]; const float mean = wave_sum(o) * (1.0f / 64.0f); const float d = o - mean; const float var = wave_sum(d * d) * (1.0f / 64.0f);
          float on = d * rsqrtf(var + 64e-5f) * lw + lb; on += BON[t] * Vv[t * 64 + j];
          Y[(T0 + t) * DM + 256 + ch] = f2bf(on * Gg[t * 64 + j]); } }
}

constexpr int DS_SEL = 131072, DS_HIST = 135168, DS_BKT = 151552, DS_BIAS = 152064;
__device__ __forceinline__ void dsa_tables(const Frame& F_) { Frame F = relocal(F_);
    LAS int* bkt = (LAS int*)(F.lds + DS_BKT); LAS float* biasT = (LAS float*)(F.lds + DS_BIAS);
    if (F.tid < 128) { const int n = F.tid; int bk = n; if (n >= 16) { const float lr = logf((float)n / 16.0f) / 2.0794415416798357f; bk = 16 + (int)(lr * 16.0f); bk = bk < 31 ? bk : 31; } bkt[n] = bk; biasT[n] = F.in[I_RELB][n]; }
    __syncthreads();
}
__device__ __forceinline__ unsigned fkey(float f) { const unsigned u = __float_as_uint(f); return (u & 0x80000000u) ? ~u : (u | 0x80000000u); }
__device__ __forceinline__ void item_dsa(const Frame& F_, int layer, int item) { Frame F = relocal(F_);
    const bf16_t* U = (const bf16_t*)(F.ws + WS_U); const bf16_t* KI = (const bf16_t*)(F.ws + WS_KIDX);
    const bf16_t* Kb = (const bf16_t*)(F.ws + WS_K); const bf16_t* Vb = (const bf16_t*)(F.ws + WS_V);
    const int b = item & 3, qg = 511 - (item >> 2); const size_t TB = (size_t)b * SEQ, T0 = TB + qg * 8;
    LAS float* sc = (LAS float*)F.lds; LAS unsigned short* selall = (LAS unsigned short*)(F.lds + DS_SEL); LAS unsigned* histall = (LAS unsigned*)(F.lds + DS_HIST);
    LAS int* bkt = (LAS int*)(F.lds + DS_BKT); LAS float* biasT = (LAS float*)(F.lds + DS_BIAS);
    const int lane = F.lane, hh = lane >> 5;
    {
        bf16x8 af[2][2]; float wq[2][2][8];
        { const int r = lane & 31, q4 = 2 * ((r >> 2) & 1) + (r >> 4), head = 4 * ((r >> 3) & 1) + (r & 3);
#pragma unroll
          for (int mt = 0; mt < 2; ++mt)
#pragma unroll
              for (int ks = 0; ks < 2; ++ks) af[mt][ks] = *(const bf16x8*)(U + (T0 + 4 * mt + q4) * NINP + UC + 384 + head * 32 + 16 * ks + 8 * hh); }
#pragma unroll
        for (int mt = 0; mt < 2; ++mt)
#pragma unroll
            for (int q2 = 0; q2 < 2; ++q2) { float f[8]; unpack8(*(const u32x4*)(U + (T0 + 4 * mt + 2 * hh + q2) * NINP + UC + 672), f);
#pragma unroll
                for (int hd = 0; hd < 8; ++hd) wq[mt][q2][hd] = f[hd]; }
        const int ntile = (qg * 8 + 8 + 31) >> 5;
        bf16x8 nb0 = af[0][0], nb1 = af[0][0];
        if (F.wave < ntile) { const int key = F.wave * 32 + (lane & 31); nb0 = *(const bf16x8*)(KI + (TB + key) * 32 + 8 * hh); nb1 = *(const bf16x8*)(KI + (TB + key) * 32 + 16 + 8 * hh); }
        for (int kt = F.wave; kt < ntile; kt += 8) {
            const int key = kt * 32 + (lane & 31);
            const bf16x8 b0 = nb0, b1 = nb1;
            if (kt + 8 < ntile) { const int k2 = key + 256; nb0 = *(const bf16x8*)(KI + (TB + k2) * 32 + 8 * hh); nb1 = *(const bf16x8*)(KI + (TB + k2) * 32 + 16 + 8 * hh); }
#pragma unroll
            for (int mt = 0; mt < 2; ++mt) { f32x16 acc;
#pragma unroll
                for (int i = 0; i < 16; ++i) acc[i] = 0.f;
                acc = __builtin_amdgcn_mfma_f32_32x32x16_bf16(af[mt][0], b0, acc, 0, 0, 0);
                acc = __builtin_amdgcn_mfma_f32_32x32x16_bf16(af[mt][1], b1, acc, 0, 0, 0);
#pragma unroll
                for (int q2 = 0; q2 < 2; ++q2) { float s = 0.f;
#pragma unroll
                    for (int hd = 0; hd < 8; ++hd) s += fmaxf(acc[8 * q2 + hd], 0.f) * wq[mt][q2][hd];
                    const int qi = 4 * mt + 2 * hh + q2;
                    sc[qi * 4096 + key] = (key <= qg * 8 + qi) ? s : -INFINITY; } }
        }
    }
    __syncthreads();
    const int qi = F.wave, tq = qg * 8 + qi, n = tq + 1;
    LAS float* scq = sc + qi * 4096; LAS unsigned short* sel = selall + qi * 256; LAS unsigned* hist = histall + qi * 512;
    int nsel;
    if (n <= 256) { nsel = n; for (int j = lane; j < 256; j += 64) sel[j] = (unsigned short)(j < n ? j : 0); }
    else {
        nsel = 256;
        const int R = (n + 63) >> 6; const unsigned long long ltm = (1ull << lane) - 1ull;
        float lo = INFINITY, hi = -INFINITY;
        const int R4 = (n + 255) >> 8;
#pragma unroll 4
        for (int i = 0; i < R4; ++i) { const int j0 = 256 * i + 4 * lane; const f32x4 v4 = *(const LAS f32x4*)(scq + j0);
#pragma unroll
            for (int q = 0; q < 4; ++q) { const bool valid = j0 + q < n; lo = fminf(lo, valid ? v4[q] : INFINITY); hi = fmaxf(hi, valid ? v4[q] : -INFINITY); } }
#pragma unroll
        for (int o = 1; o < 64; o <<= 1) { lo = fminf(lo, shx(lo, o)); hi = fmaxf(hi, shx(hi, o)); }
        bool slow = false;
        if (!(hi > lo)) { for (int j = lane; j < 256; j += 64) sel[j] = (unsigned short)j; }
        else {
            const float scale = 1023.0f / (hi - lo);
            *(LAS u32x4*)(hist + 8 * lane) = (u32x4){0u, 0u, 0u, 0u}; *(LAS u32x4*)(hist + 8 * lane + 4) = (u32x4){0u, 0u, 0u, 0u};
#pragma unroll 2
            for (int i = 0; i < R4; ++i) { const int j0 = 256 * i + 4 * lane; const f32x4 v4 = *(const LAS f32x4*)(scq + j0);
#pragma unroll
                for (int q = 0; q < 4; ++q) { if (j0 + q < n) { int bk = (int)((v4[q] - lo) * scale); bk = bk < 1023 ? bk : 1023;
                    atomicAdd((unsigned*)(hist + (bk >> 1)), (bk & 1) ? 65536u : 1u); } } }
            const u32x4 h0 = *(const LAS u32x4*)(hist + 8 * lane), h1 = *(const LAS u32x4*)(hist + 8 * lane + 4);
            unsigned cb[16];
            cb[0] = h0.x & 0xffffu; cb[1] = h0.x >> 16; cb[2] = h0.y & 0xffffu; cb[3] = h0.y >> 16; cb[4] = h0.z & 0xffffu; cb[5] = h0.z >> 16; cb[6] = h0.w & 0xffffu; cb[7] = h0.w >> 16;
            cb[8] = h1.x & 0xffffu; cb[9] = h1.x >> 16; cb[10] = h1.y & 0xffffu; cb[11] = h1.y >> 16; cb[12] = h1.z & 0xffffu; cb[13] = h1.z >> 16; cb[14] = h1.w & 0xffffu; cb[15] = h1.w >> 16;
            unsigned tot = 0u;
#pragma unroll
            for (int q = 0; q < 16; ++q) tot += cb[q];
            unsigned incl = tot;
#pragma unroll
            for (int o = 1; o < 64; o <<= 1) { const unsigned t = shdown_u(incl, o); if (lane + o < 64) incl += t; }
            int fb = -1; unsigned fabove = 0u, fcnt = 0u; unsigned cum = incl - tot;
#pragma unroll
            for (int q = 15; q >= 0; --q) { if (fb < 0 && cum < 256u && 256u <= cum + cb[q]) { fb = 16 * lane + q; fabove = cum; fcnt = cb[q]; } cum += cb[q]; }
            const unsigned long long mf = __ballot(fb >= 0); const int src = (int)__ffsll((long long)mf) - 1;
            const int B = shidx_i(fb, src); const int above = shidx_i((int)fabove, src), cntB = shidx_i((int)fcnt, src); const int need = 256 - above;
            if (cntB > 256) slow = true;
            else {
                LAS unsigned* cand = hist;
                int base_gt = 0, base_c = 0;
#pragma unroll 2
                for (int i = 0; i < R4; ++i) { const int j0 = 256 * i + 4 * lane; const f32x4 v4 = *(const LAS f32x4*)(scq + j0);
#pragma unroll
                    for (int q = 0; q < 4; ++q) { const int j = j0 + q; const bool valid = j < n; const float v = valid ? v4[q] : lo;
                        int bk = (int)((v - lo) * scale); bk = bk < 1023 ? bk : 1023;
                        const bool gt = valid && bk > B, eq = valid && bk == B;
                        const unsigned long long mg = __ballot(gt), me = __ballot(eq);
                        if (gt) sel[base_gt + __popcll(mg & ltm)] = (unsigned short)j;
                        if (eq) { const int p = base_c + __popcll(me & ltm); cand[2 * p] = fkey(v); cand[2 * p + 1] = (unsigned)j; }
                        base_gt += __popcll(mg); base_c += __popcll(me); } }
                if (need == cntB) { for (int c = lane; c < cntB; c += 64) sel[above + c] = (unsigned short)cand[2 * c + 1]; }
                else {
                    unsigned ck[4], cx[4]; int rk[4];
#pragma unroll
                    for (int q = 0; q < 4; ++q) { const int c = lane + 64 * q; ck[q] = c < cntB ? cand[2 * c] : 0u; cx[q] = c < cntB ? cand[2 * c + 1] : 0u; rk[q] = 0; }
                    for (int c2 = 0; c2 < cntB; ++c2) { const unsigned k2 = cand[2 * c2], x2 = cand[2 * c2 + 1];
#pragma unroll
                        for (int q = 0; q < 4; ++q) rk[q] += (k2 > ck[q] || (k2 == ck[q] && x2 < cx[q])) ? 1 : 0; }
#pragma unroll
                    for (int q = 0; q < 4; ++q) { const int c = lane + 64 * q; if (c < cntB && rk[q] < need) sel[above + rk[q]] = (unsigned short)cand[2 * c + 1]; }
                }
            }
        }
        if (slow) {
        unsigned prefix = 0u; int need = 256; unsigned neq = 0u;
        for (int p = 0; p < 4; ++p) { const int shift = 24 - 8 * p;
            *(LAS u32x4*)(hist + 4 * lane) = (u32x4){0u, 0u, 0u, 0u};
            for (int i = 0; i < R; ++i) { const int j = lane + 64 * i; if (j < n) { const unsigned u = fkey(scq[j]);
                if (p == 0 || (u >> (shift + 8)) == prefix) atomicAdd((unsigned*)(hist + ((u >> shift) & 255u)), 1u); } }
            const u32x4 hv = *(const LAS u32x4*)(hist + 4 * lane);
            const unsigned tot = hv.x + hv.y + hv.z + hv.w;
            unsigned incl = tot;
#pragma unroll
            for (int o = 1; o < 64; o <<= 1) { const unsigned t = shdown_u(incl, o); if (lane + o < 64) incl += t; }
            const unsigned above = incl - tot;
            int fb = -1; unsigned fabove = 0u, feq = 0u; unsigned cum = above;
            { const unsigned hq[4] = {hv.x, hv.y, hv.z, hv.w};
#pragma unroll
              for (int q = 3; q >= 0; --q) { if (fb < 0 && cum < (unsigned)need && (unsigned)need <= cum + hq[q]) { fb = 4 * lane + q; fabove = cum; feq = hq[q]; } cum += hq[q]; } }
            const unsigned long long m = __ballot(fb >= 0);
            const int src = (int)__ffsll((long long)m) - 1;
            const int bin = shidx_i(fb, src); const unsigned ab = (unsigned)shidx_i((int)fabove, src); neq = (unsigned)shidx_i((int)feq, src);
            need -= (int)ab; prefix = (prefix << 8) | (unsigned)bin;
        }
        const int ngt = 256 - need;
        int base_gt = 0, base_eq = 0;
        for (int i = 0; i < R; ++i) { const int j = lane + 64 * i; const unsigned u = (j < n) ? fkey(scq[j]) : 0u;
            const bool gt = (j < n) && (u > prefix), eq = (j < n) && (u == prefix);
            const unsigned long long mg = __ballot(gt), me = __ballot(eq); const unsigned long long lt = (1ull << lane) - 1ull;
            if (gt) sel[base_gt + __popcll(mg & lt)] = (unsigned short)j;
            if (eq) { const int rk = base_eq + __popcll(me & lt); if (rk < need) sel[ngt + rk] = (unsigned short)j; }
            base_gt += __popcll(mg); base_eq += __popcll(me); }
        (void)neq;
            }
    }
    const int nt16 = (nsel + 15) >> 4, r16 = lane & 15, g4 = lane >> 4;
    LAS float* biasj = scq + 2048;
#pragma unroll
    for (int q = 0; q < 4; ++q) { const int j = lane + 64 * q; f32x4 bv = (f32x4){-INFINITY, -INFINITY, -INFINITY, -INFINITY};
        if (j < nsel) { const int dist = tq - (int)sel[j]; const int bk = dist < 128 ? bkt[dist < 0 ? 0 : dist] : 31; bv = *(const LAS f32x4*)(biasT + 4 * bk); }
        *(LAS f32x4*)(biasj + 4 * j) = bv; }
    bf16x8 qf[2];
#pragma unroll
    for (int s = 0; s < 2; ++s) { u32x4 z = (u32x4){0u, 0u, 0u, 0u}; if (r16 < 4) z = *(const u32x4*)(U + (T0 + qi) * NINP + UC + r16 * 64 + 32 * s + 8 * g4); qf[s] = __builtin_bit_cast(bf16x8, z); }
    float lg[16][4]; float mx = -INFINITY;
#define DSA_QK(M0, NM) do { int keyr[NM]; bf16x8 a0[NM], a1[NM]; \
        _Pragma("unroll") for (int m8 = 0; m8 < NM; ++m8) keyr[m8] = sel[16 * ((M0) + m8) + r16]; \
        _Pragma("unroll") for (int m8 = 0; m8 < NM; ++m8) { a0[m8] = *(const bf16x8*)(Kb + (TB + keyr[m8]) * 64 + 8 * g4); a1[m8] = *(const bf16x8*)(Kb + (TB + keyr[m8]) * 64 + 32 + 8 * g4); } \
        _Pragma("unroll") for (int m8 = 0; m8 < NM; ++m8) { const int m = (M0) + m8; \
            f32x4 acc = (f32x4){0.f, 0.f, 0.f, 0.f}; \
            acc = __builtin_amdgcn_mfma_f32_16x16x32_bf16(a0[m8], qf[0], acc, 0, 0, 0); \
            acc = __builtin_amdgcn_mfma_f32_16x16x32_bf16(a1[m8], qf[1], acc, 0, 0, 0); \
            _Pragma("unroll") for (int i = 0; i < 4; ++i) { const float v = acc[i] * 0.125f + biasj[(16 * m + 4 * g4 + i) * 4 + (r16 & 3)]; lg[m][i] = v; mx = fmaxf(mx, v); } } } while (0)
    if (nt16 > 8) { DSA_QK(0, 16); }
    else { DSA_QK(0, 8);
#pragma unroll
        for (int m8 = 8; m8 < 16; ++m8)
#pragma unroll
            for (int i = 0; i < 4; ++i) lg[m8][i] = -INFINITY; }
#undef DSA_QK
    mx = fmaxf(mx, shx(mx, 16)); mx = fmaxf(mx, shx(mx, 32));
    float sm = 0.f;
#pragma unroll
    for (int m = 0; m < 16; ++m)
#pragma unroll
        for (int i = 0; i < 4; ++i) { const float p = __expf(lg[m][i] - mx); lg[m][i] = p; sm += p; }
    sm += shx(sm, 16); sm += shx(sm, 32);
    f32x4 ov[4];
#pragma unroll
    for (int nt = 0; nt < 4; ++nt) ov[nt] = (f32x4){0.f, 0.f, 0.f, 0.f};
    const unsigned vs_base = (unsigned)(unsigned long)scq;
#pragma unroll
    for (int half = 0; half < 2; ++half) {
        if (half * 8 < nt16) {
            asm volatile("s_waitcnt lgkmcnt(0)" ::: "memory");
            int vkey[16];
#pragma unroll
            for (int q = 0; q < 16; ++q) { const int rho = 8 * q + (lane >> 3);
                vkey[q] = sel[half * 128 + (rho & ~31) + 16 * ((rho >> 2) & 1) + 4 * ((rho >> 3) & 3) + (rho & 3)]; }
            asm volatile("s_waitcnt lgkmcnt(0)" : "+v"(vkey[0]), "+v"(vkey[1]), "+v"(vkey[2]), "+v"(vkey[3]), "+v"(vkey[4]), "+v"(vkey[5]), "+v"(vkey[6]), "+v"(vkey[7]),
                         "+v"(vkey[8]), "+v"(vkey[9]), "+v"(vkey[10]), "+v"(vkey[11]), "+v"(vkey[12]), "+v"(vkey[13]), "+v"(vkey[14]), "+v"(vkey[15]) :: "memory");
#pragma unroll
            for (int q = 0; q < 16; ++q)
                __builtin_amdgcn_global_load_lds((const unsigned*)(Vb + (TB + vkey[q]) * 64 + 8 * (lane & 7)), (LAS unsigned*)((LAS unsigned char*)scq + q * 1024), 16, 0, 0);
            asm volatile("s_waitcnt vmcnt(0)" ::: "memory");
#pragma unroll
            for (int s4 = 0; s4 < 4; ++s4) { const int s = half * 4 + s4;
                u32x4 pw; pw.x = pk2(lg[2 * s][0], lg[2 * s][1]); pw.y = pk2(lg[2 * s][2], lg[2 * s][3]); pw.z = pk2(lg[2 * s + 1][0], lg[2 * s + 1][1]); pw.w = pk2(lg[2 * s + 1][2], lg[2 * s + 1][3]);
                const bf16x8 pa = __builtin_bit_cast(bf16x8, pw);
                const unsigned ad = vs_base + (unsigned)((32 * s4 + 8 * g4 + (r16 >> 2)) * 128 + (r16 & 3) * 8);
                u32x2 t0[4], t1[4];
                asm volatile("ds_read_b64_tr_b16 %0, %8\n\tds_read_b64_tr_b16 %1, %8 offset:512\n\tds_read_b64_tr_b16 %2, %8 offset:32\n\tds_read_b64_tr_b16 %3, %8 offset:544\n\t"
                             "ds_read_b64_tr_b16 %4, %8 offset:64\n\tds_read_b64_tr_b16 %5, %8 offset:576\n\tds_read_b64_tr_b16 %6, %8 offset:96\n\tds_read_b64_tr_b16 %7, %8 offset:608\n\ts_waitcnt lgkmcnt(0)"
                             : "=&v"(t0[0]), "=&v"(t1[0]), "=&v"(t0[1]), "=&v"(t1[1]), "=&v"(t0[2]), "=&v"(t1[2]), "=&v"(t0[3]), "=&v"(t1[3]) : "v"(ad) : "memory");
#pragma unroll
                for (int nt = 0; nt < 4; ++nt) { const bf16x8 vb = __builtin_bit_cast(bf16x8, (u32x4){t0[nt].x, t0[nt].y, t1[nt].x, t1[nt].y});
                    ov[nt] = __builtin_amdgcn_mfma_f32_16x16x32_bf16(pa, vb, ov[nt], 0, 0, 0); } }
        }
    }
    { float inv[4];
#pragma unroll
      for (int h = 0; h < 4; ++h) inv[h] = 1.0f / __int_as_float(__builtin_amdgcn_readlane(__float_as_int(sm), h));
      if (lane < 16) { bf16_t* Y = (bf16_t*)(F.ws + WS_H) + (T0 + qi) * DM + 512 + r16;
#pragma unroll
          for (int h = 0; h < 4; ++h)
#pragma unroll
              for (int nt = 0; nt < 4; ++nt) Y[h * 64 + 16 * nt] = f2bf(ov[nt][h] * inv[h]); } }
}

__device__ __forceinline__ void phase_router(const Frame& F_, int layer) { Frame F = relocal(F_); const int cset = layer;
    const float* X = (const float*)(F.ws + WS_X);
    const bf16_t* WH = (const bf16_t*)(F.ws + WS_WRT) + (size_t)layer * 2 * 49152; const bf16_t* WL = WH + 49152;
    LAS float* part = (LAS float*)F.lds;
    LAS float* ssq = (LAS float*)(F.lds + 24576);
    LAS int* es = (LAS int*)(F.lds + 25088);
    LAS int* lr = (LAS int*)(F.lds + 25600);
    LAS float* wsl = (LAS float*)(F.lds + 26112);
    LAS float* rsd = (LAS float*)(F.lds + 26624);
    for (int blk = F.bid; blk < NTOK / 64; blk += F.G) {
        __syncthreads();
        const int mt = F.wave & 3, kh = F.wave >> 2, r16 = F.lane & 15, g4 = F.lane >> 4;
        const float* xr = X + ((size_t)blk * 64 + mt * 16 + r16) * DM + kh * 512 + 8 * g4;
        f32x4 acc[3]; acc[0] = acc[1] = acc[2] = (f32x4){0.f, 0.f, 0.f, 0.f}; float ss = 0.f;
#pragma unroll 4
        for (int ks = 0; ks < 16; ++ks) {
            const f32x4 xa = *(const f32x4*)(xr + ks * 32), xb = *(const f32x4*)(xr + ks * 32 + 4);
            ss += xa[0] * xa[0] + xa[1] * xa[1] + xa[2] * xa[2] + xa[3] * xa[3] + xb[0] * xb[0] + xb[1] * xb[1] + xb[2] * xb[2] + xb[3] * xb[3];
            float xv[8] = {xa[0], xa[1], xa[2], xa[3], xb[0], xb[1], xb[2], xb[3]}; unsigned hw[4], lw[4];
#pragma unroll
            for (int j = 0; j < 4; ++j) { const bf16_t h0 = f2bf(xv[2 * j]), h1 = f2bf(xv[2 * j + 1]); hw[j] = (unsigned)h0 | ((unsigned)h1 << 16);
                lw[j] = pk2(xv[2 * j] - bf2f(h0), xv[2 * j + 1] - bf2f(h1)); }
            const bf16x8 ahi = __builtin_bit_cast(bf16x8, (u32x4){hw[0], hw[1], hw[2], hw[3]}), alo = __builtin_bit_cast(bf16x8, (u32x4){lw[0], lw[1], lw[2], lw[3]});
#pragma unroll
            for (int nt = 0; nt < 3; ++nt) { const size_t wo = (size_t)(nt * 16 + r16) * 1024 + kh * 512 + ks * 32 + 8 * g4;
                const bf16x8 bh = *(const bf16x8*)(WH + wo), bl = *(const bf16x8*)(WL + wo);
                acc[nt] = __builtin_amdgcn_mfma_f32_16x16x32_bf16(ahi, bh, acc[nt], 0, 0, 0);
                acc[nt] = __builtin_amdgcn_mfma_f32_16x16x32_bf16(ahi, bl, acc[nt], 0, 0, 0);
                acc[nt] = __builtin_amdgcn_mfma_f32_16x16x32_bf16(alo, bh, acc[nt], 0, 0, 0); }
        }
        ss += shx(ss, 16); ss += shx(ss, 32);
        if (g4 == 0) ssq[kh * 64 + mt * 16 + r16] = ss;
#pragma unroll
        for (int nt = 0; nt < 3; ++nt)
#pragma unroll
            for (int i = 0; i < 4; ++i) part[(kh * 64 + mt * 16 + 4 * g4 + i) * 48 + nt * 16 + r16] = acc[nt][i];
        __syncthreads();
        if (F.tid < 64) { const float rstd = rsqrtf((ssq[F.tid] + ssq[64 + F.tid]) * (1.0f / DM) + 1e-6f); rsd[F.tid] = rstd;
            float l[36];
#pragma unroll
            for (int o = 0; o < 36; ++o) l[o] = (part[F.tid * 48 + o] + part[(64 + F.tid) * 48 + o]) * rstd + (o < 32 ? F.in[I_BRE][layer * 32 + o] : F.in[I_BRG][layer * 4 + o - 32]);
            int gs = 0; float gm = l[32];
#pragma unroll
            for (int j = 1; j < 4; ++j) if (l[32 + j] > gm) { gm = l[32 + j]; gs = j; }
            float den = 0.f;
#pragma unroll
            for (int j = 0; j < 4; ++j) den += __expf(l[32 + j] - gm);
            const float gate = 1.0f / den;
            float e8[8];
#pragma unroll
            for (int j = 0; j < 8; ++j) e8[j] = gs == 0 ? l[j] : gs == 1 ? l[8 + j] : gs == 2 ? l[16 + j] : l[24 + j];
            int i1 = 0; float v1 = e8[0];
#pragma unroll
            for (int j = 1; j < 8; ++j) if (e8[j] > v1) { v1 = e8[j]; i1 = j; }
            int i2 = -1; float v2 = -INFINITY;
#pragma unroll
            for (int j = 0; j < 8; ++j) if (j != i1 && e8[j] > v2) { v2 = e8[j]; i2 = j; }
            const float e2 = __expf(v2 - v1); const float p1 = 1.0f / (1.0f + e2);
            es[F.tid * 2] = gs * 8 + i1; es[F.tid * 2 + 1] = gs * 8 + i2; wsl[F.tid * 2] = p1 * gate; wsl[F.tid * 2 + 1] = (1.0f - p1) * gate; }
        __syncthreads();
        if (F.tid < 32) { int cnt = 0; for (int i = 0; i < 128; ++i) if (es[i] == F.tid) lr[i] = cnt++;
            if (cnt) { const int base = (int)__hip_atomic_fetch_add(F.ctl + CW_CNT + cset * 32 + F.tid, (unsigned)cnt, __ATOMIC_RELAXED, __HIP_MEMORY_SCOPE_AGENT);
                for (int i = 0; i < 128; ++i) if (es[i] == F.tid) lr[i] += base; } }
        __syncthreads();
        if (F.tid < 64) { int* rt = (int*)(F.ws + WS_ROUTE) + ((size_t)blk * 64 + F.tid) * 8;
            rt[0] = es[F.tid * 2]; rt[1] = es[F.tid * 2 + 1]; ((float*)rt)[2] = wsl[F.tid * 2]; ((float*)rt)[3] = wsl[F.tid * 2 + 1]; rt[4] = lr[F.tid * 2]; rt[5] = lr[F.tid * 2 + 1]; ((float*)rt)[6] = rsd[F.tid]; }
    }
    __syncthreads();
    if (F.tid == 0) __hip_atomic_fetch_add(F.ctl + CW_RB + 64 * layer, 1u, __ATOMIC_RELAXED, __HIP_MEMORY_SCOPE_AGENT);
}
__device__ __forceinline__ void phase_moe_convert(const Frame& F_, int layer) { Frame F = relocal(F_);
    bf16_t* WGU = (bf16_t*)(F.ws + WS_MOE + MOE_WGU);
    for (int t = F.bid; t < 1024; t += F.G) {
        const int e = t >> 5, r = t & 31, kt = r >> 1, nt = r & 1; const size_t eo = ((size_t)layer * 32 + e) * 1024 * 256;
        tr_tile(F, 256, WGU + (size_t)e * 512 * 1024, 1024, kt * 64, nt * 256, SmGU{F.in[I_WGATE] + eo, F.in[I_WUP] + eo}); }
}
__device__ __forceinline__ void phase_moe_convert_down(const Frame& F_, int layer) { Frame F = relocal(F_);
    bf16_t* WD = (bf16_t*)(F.ws + WS_MOE + MOE_WD);
    for (;;) { const int q = q_pop(F, 32 + layer); if (q >= 512) break;
        const int e = q >> 4, r = q & 15, kt = r >> 2, nt = r & 3;
        tr_tile(F, 1024, WD + (size_t)e * 1024 * 256, 256, kt * 64, nt * 256, SmId{F.in[I_WDOWN] + ((size_t)layer * 32 + e) * 256 * 1024}); }
}
__device__ __forceinline__ void phase_gather(const Frame& F_, int layer) { Frame F = relocal(F_);
    LAS int* off = (LAS int*)F.lds;
    __syncthreads();
    if (F.tid == 0) { unsigned sp = 0;
        while (__hip_atomic_load(F.ctl + CW_RB + 64 * layer, __ATOMIC_RELAXED, __HIP_MEMORY_SCOPE_AGENT) < (unsigned)F.G) { __builtin_amdgcn_s_sleep(2); if (++sp > (1u << 22)) break; } }
    __syncthreads();
    if (F.tid == 0) { int acc = 0; for (int e = 0; e < 32; ++e) { off[e] = acc; const int c = (int)__hip_atomic_load(F.ctl + CW_CNT + layer * 32 + e, __ATOMIC_RELAXED, __HIP_MEMORY_SCOPE_AGENT); acc += (c + 255) & ~255; } off[32] = acc; }
    __syncthreads();
    int* tiles = (int*)(F.ws + WS_TILES); int* row_tok = (int*)(F.ws + WS_ROWS); float* row_w = (float*)(F.ws + WS_ROWS) + MAXROWS;
    if (F.bid == 0) { if (F.tid == 0) tiles[0] = off[32] >> 8; if (F.tid < 33) tiles[1 + F.tid] = off[F.tid];
        if (F.tid < 32) for (int rt = off[F.tid] >> 8; rt < (off[F.tid + 1] >> 8); ++rt) tiles[64 + rt] = F.tid; }
    for (int e = F.bid; e < 32; e += F.G) { const int c = (int)__hip_atomic_load(F.ctl + CW_CNT + layer * 32 + e, __ATOMIC_RELAXED, __HIP_MEMORY_SCOPE_AGENT);
        for (int r = off[e] + c + F.tid; r < off[e + 1]; r += NTHR) { row_tok[r] = -1; row_w[r] = 0.f; } }
    const float* X = (const float*)(F.ws + WS_X); bf16_t* HP = (bf16_t*)(F.ws + WS_U); const float* nw = F.in[I_NORM2] + (size_t)layer * DM;
    f32x4 nwv[4];
#pragma unroll
    for (int j = 0; j < 4; ++j) nwv[j] = *(const f32x4*)(nw + 4 * F.lane + 256 * j);
    for (int blk = F.bid; blk < NTOK / 64; blk += F.G)
    for (int i4 = 0; i4 < 2; ++i4) {
        int p0[4], p1[4], tt[4]; float rstd[4], w0[4], w1[4]; f32x4 xv[4][4];
#pragma unroll
        for (int r = 0; r < 4; ++r) { const int t = blk * 64 + F.wave * 8 + 4 * i4 + r; tt[r] = t;
            const int* rt = (const int*)(F.ws + WS_ROUTE) + (size_t)t * 8; rstd[r] = ((const float*)rt)[6]; w0[r] = ((const float*)rt)[2]; w1[r] = ((const float*)rt)[3];
            p0[r] = off[rt[0]] + rt[4]; p1[r] = off[rt[1]] + rt[5];
#pragma unroll
            for (int j = 0; j < 4; ++j) xv[r][j] = *(const f32x4*)(X + (size_t)t * DM + 4 * F.lane + 256 * j); }
#pragma unroll
        for (int r = 0; r < 4; ++r) {
#pragma unroll
            for (int j = 0; j < 4; ++j) { const int c = 4 * F.lane + 256 * j; const f32x4 v = xv[r][j] * rstd[r] * nwv[j];
                u32x2 o; o.x = pk2(v[0], v[1]); o.y = pk2(v[2], v[3]);
                *(u32x2*)(HP + (size_t)tt[r] * DM + c) = o; }
            if (F.lane == 0) { row_tok[p0[r]] = tt[r] * 2; row_w[p0[r]] = w0[r]; row_tok[p1[r]] = tt[r] * 2 + 1; row_w[p1[r]] = w1[r]; } }
    }
}

constexpr int NPH_LAYER = 9, NPHASE = 1 + 2 * NPH_LAYER + 1;
#ifndef MK_ONLY
#define MK_ONLY -1
#endif
#ifndef MK_ITEM
#define MK_ITEM -1
#endif
#define EN(o) (MK_ONLY < 0 || MK_ONLY == (o))
#define IT(o) (MK_ITEM < 0 || MK_ITEM == (o))
__global__ void __launch_bounds__(NTHR, 2) mk_forward(Params P) {
    extern __shared__ __attribute__((aligned(16))) unsigned char lds_raw[];
    Frame F; F.lds = (LAS unsigned char*)lds_raw; F.tid = threadIdx.x; F.lane = F.tid & 63; F.wave = __builtin_amdgcn_readfirstlane(F.tid >> 6); F.bid = blockIdx.x; F.G = gridDim.x;
    F.in = (in_tab_t)__builtin_amdgcn_kernarg_segment_ptr(); F.out = P.out; F.ws = P.ws; F.ctl = (unsigned*)(P.ws + WS_CTL); F.misc = (volatile LAS int*)(F.lds + MISC_OFF);
    if (F.tid < 64) ((LAS unsigned*)(F.lds + MISC_OFF))[F.tid] = 0u;
    __syncthreads();
    const int lo = P.ph_lo, hi = P.ph_hi;
    XcdBarrier bar; bar.bar = F.ctl + CW_BAR; bar.x = 0; bar.st = (volatile LAS unsigned*)(F.lds + MISC_OFF + 16);
    if (hi - lo > 1) bar = xcd_barrier_post(F.ctl + CW_BAR, (volatile LAS unsigned*)(F.lds + MISC_OFF + 16));
#define IN(k) (lo <= (k) && (k) < hi)
#define SEAM(k) do { if (IN(k) && IN((k) + 1)) xcd_barrier(bar); } while (0)
#define QLOOP(qi, n, body) for (;;) { const int it = q_pop(F, layer * 12 + (qi)); if (it >= (n)) break; body; }
    if (EN(100) && IN(0)) { phase_prologue(F); phase_norm(F, F.in[I_X], false, F.in[I_NORM1], 3); } SEAM(0);
#pragma unroll
    for (int layer = 0; layer < DEPTH; ++layer) {
        const int pb = 1 + layer * NPH_LAYER;
        if (layer > 0) { if (EN(0) && IN(pb + 0)) { phase_norm(F, (const float*)(F.ws + WS_X), true, F.in[I_NORM1] + (size_t)layer * DM, 0); } SEAM(pb + 0); }
        if (EN(1) && IN(pb + 1)) { const Frame F_ = F; Frame F = relocal(F_); pg8::StaticOrder S; S.init((const bf16_t*)(F.ws + WS_H), (const bf16_t*)(F.ws + WS_WIN) + (size_t)layer * NINP * DM, NTOK, NINP, DM, F.G, F.bid);
            pg8::EpiBf16 E{(bf16_t*)(F.ws + WS_U), NINP}; pg8::gemm_phase(F.lds, DM, S, E); } SEAM(pb + 1);
#define SLOOP(n, body) for (int it = F.bid; it < (n); it += F.G) { __syncthreads(); body; }
        if (EN(2) && IN(pb + 2)) {
            if (IT(1)) SLOOP(1024, item_rwkv1(F, layer, it));
            if (IT(0)) SLOOP(256, item_s5<1>(F, layer, it));
            if (IT(2)) SLOOP(256, item_mamba<1>(F, layer, it));
            if (IT(3)) SLOOP(256, item_kv(F, layer, it));
        } SEAM(pb + 2);
        if (EN(3) && IN(pb + 3)) {
            if (IT(0)) SLOOP(8, item_rwkv_carry(F, it));
            if (IT(1)) { for (int it = F.bid - 8; it >= 0 && it < 16; it += F.G) { __syncthreads(); item_mamba_carry(F, it); } }
            if (IT(2)) { for (int it = F.bid - 24; it >= 0 && it < 4; it += F.G) { __syncthreads(); item_s5_carry(F, layer, it); } }
            if (IT(3)) {
                dsa_tables(F);
                const int pref = (int)(xb_xcc_id() & 3u);
#pragma unroll 1
                for (int k4 = 0; k4 < 4; ++k4) { const int bq = (pref + k4) & 3;
                    for (;;) { const int it = q_pop(F, 24 + layer * 4 + bq); if (it >= 512) break; item_dsa(F, layer, it * 4 + bq); } } }
        } SEAM(pb + 3);
        if (EN(4) && IN(pb + 4)) {
            if (IT(0)) SLOOP(256, item_s5<2>(F, layer, it));
            if (IT(2)) SLOOP(256, item_mamba<2>(F, layer, it));
            if (IT(1)) SLOOP(1024, item_rwkv3(F, layer, it));
        } SEAM(pb + 4);
        if (EN(6) && IN(pb + 5)) { const Frame F_ = F; Frame F = relocal(F_); pg8::StaticOrder S; S.init((const bf16_t*)(F.ws + WS_H), (const bf16_t*)(F.ws + WS_WOUT) + (size_t)layer * DM * DM, NTOK, DM, DM, F.G, F.bid);
            pg8::EpiResid E{layer == 0 ? F.in[I_X] : (const float*)(F.ws + WS_X), (float*)(F.ws + WS_X), DM}; pg8::gemm_phase(F.lds, DM, S, E); } SEAM(pb + 5);
        if (EN(7) && IN(pb + 6)) { phase_router(F, layer); phase_moe_convert(F, layer); phase_gather(F, layer); } SEAM(pb + 6);
        if (EN(8) && IN(pb + 7)) { const Frame F_ = F; Frame F = relocal(F_); LAS int* ul = (LAS int*)(F.lds + pg8::STAGE_BYTES + 8192); if (F.tid == 0) pg8::MoeOrder::build(ul, (const int*)(F.ws + WS_TILES), 2, F.G, F.bid); __syncthreads();
            pg8::MoeOrder S{DM, (const char*)(F.ws + WS_U), (const char*)(F.ws + WS_MOE + MOE_WGU), (size_t)512 * 1024 * 2, ul};
            pg8::EpiGated<1> E{(bf16_t*)(F.ws + WS_H), 256, 0, nullptr, nullptr}; pg8::gemm_phase<pg8::EpiGated<1>, pg8::MoeOrder, true>(F.lds, DM, S, E, (const char*)(F.ws + WS_U), (const int*)(F.ws + WS_ROWS)); phase_moe_convert_down(F, layer); } SEAM(pb + 7);
        if (EN(9) && IN(pb + 8)) { const Frame F_ = F; Frame F = relocal(F_); LAS int* ul = (LAS int*)(F.lds + pg8::STAGE_BYTES + 8192); if (F.tid == 0) pg8::MoeOrder::build(ul, (const int*)(F.ws + WS_TILES), 4, F.G, F.bid); __syncthreads();
            pg8::MoeOrder S{256, (const char*)(F.ws + WS_H), (const char*)(F.ws + WS_MOE + MOE_WD), (size_t)1024 * 256 * 2, ul};
            pg8::EpiMoeOut E{(bf16_t*)(F.ws + WS_U), (const int*)(F.ws + WS_ROWS), (const float*)(F.ws + WS_ROWS) + MAXROWS, F.lds}; pg8::gemm_phase(F.lds, 256, S, E); } SEAM(pb + 8);
    }
    if (EN(101) && IN(NPHASE - 1)) { phase_norm(F, (const float*)(F.ws + WS_X), true, F.in[I_FNORM], 2); }
#undef IN
#undef SEAM
}

#ifndef MK_SPLIT
#define MK_SPLIT 0
#endif
extern "C" void kernel_launch(void* const* d_in, const int* in_sizes, int n_in, void* d_out, int out_size, void* d_ws, size_t ws_size, hipStream_t stream) {
    static int grid = 0;
    if (grid == 0) {
        if (n_in != 44 || out_size != NTOK * DM || ws_size < WS_END) { fprintf(stderr, "kernel_launch: unexpected shapes (n_in %d out %d ws %zu need %zu)\n", n_in, out_size, ws_size, (size_t)WS_END); grid = -1; return; }
        int dev = 0, cus = 0;
        if (hipGetDevice(&dev) != hipSuccess || hipDeviceGetAttribute(&cus, hipDeviceAttributeMultiprocessorCount, dev) != hipSuccess) { grid = -1; return; }
        if (hipFuncSetAttribute((const void*)mk_forward, hipFuncAttributeMaxDynamicSharedMemorySize, LDS_BYTES) != hipSuccess) { fprintf(stderr, "kernel_launch: hipFuncSetAttribute failed\n"); grid = -1; return; }
        int per_cu = 0;
        if (hipOccupancyMaxActiveBlocksPerMultiprocessor(&per_cu, (const void*)mk_forward, NTHR, LDS_BYTES) != hipSuccess || per_cu < 1) { fprintf(stderr, "kernel_launch: occupancy query says %d\n", per_cu); }
        (void)hipGetLastError();
        grid = cus;
    }
    if (grid < 0) return;
    hipMemsetAsync((char*)d_ws + WS_CTL, 0, CTL_BYTES, stream);
    Params p{};
    for (int i = 0; i < 44; ++i) p.in[i] = (const float*)d_in[i];
    p.out = (float*)d_out; p.ws = (unsigned char*)d_ws;
#if MK_SPLIT
    for (int ph = 0; ph < NPHASE; ++ph) { p.ph_lo = ph; p.ph_hi = ph + 1; hipLaunchKernelGGL(mk_forward, dim3(grid), dim3(NTHR), LDS_BYTES, stream, p); }
#else
    p.ph_lo = 0; p.ph_hi = NPHASE; hipLaunchKernelGGL(mk_forward, dim3(grid), dim3(NTHR), LDS_BYTES, stream, p);
#endif
}
```

```cpp
#include <hip/hip_runtime.h>
#include <stdint.h>
#include <stdio.h>

#define LAS __attribute__((address_space(3)))
typedef unsigned short bf16_t;
typedef short bf16x8 __attribute__((ext_vector_type(8)));
typedef float f32x4 __attribute__((ext_vector_type(4)));
typedef float f32x2 __attribute__((ext_vector_type(2)));
typedef float f32x16 __attribute__((ext_vector_type(16)));
typedef unsigned u32x4 __attribute__((ext_vector_type(4)));
typedef unsigned u32x2 __attribute__((ext_vector_type(2)));

constexpr int NTOK = 16384, DM = 1024, SEQ = 4096, NBATCH = 4, DEPTH = 2;
constexpr int NIN = 2604, NINP = 2816;
constexpr int UM = 0;
constexpr int UR = 784;
constexpr int UC = 1680;
constexpr int US = 2368;
constexpr int NTHR = 512;
constexpr int LDS_BYTES = 163840;
constexpr int MISC_OFF = LDS_BYTES - 256;

constexpr size_t WS_CTL   = 0;
constexpr size_t CTL_BYTES = 65536;
constexpr size_t WS_X     = WS_CTL + CTL_BYTES;
constexpr size_t WS_H     = WS_X + (size_t)NTOK * DM * 4;
constexpr size_t WS_U     = WS_H + (size_t)NTOK * DM * 2;
constexpr size_t WS_WIN   = WS_U + (size_t)NTOK * NINP * 2;
constexpr size_t WS_WOUT  = WS_WIN + (size_t)2 * NINP * DM * 2;
constexpr size_t WS_GLU   = WS_WOUT + (size_t)2 * DM * DM * 2;
constexpr size_t WS_MOE   = WS_GLU + (size_t)2 * 512 * 256 * 2;
constexpr size_t MOE_WGU  = 0;
constexpr size_t MOE_WD   = (size_t)32 * 512 * 1024 * 2;
constexpr size_t MOE_BYTES = MOE_WD + (size_t)32 * 1024 * 256 * 2;
constexpr size_t RW_PT    = 0;
constexpr size_t RW_U     = (size_t)1024 * 4096 * 2;
constexpr size_t RW_S     = RW_U + (size_t)1024 * 4096 * 2;
constexpr size_t RW_W1    = RW_S + (size_t)1024 * 4096 * 2;
constexpr size_t RW_Z     = RW_W1 + (size_t)1024 * 4096 * 2;
constexpr size_t YSG_OFF  = RW_Z + (size_t)1024 * 4096 * 2;
static_assert(YSG_OFF + (size_t)NTOK * 256 * 2 <= MOE_BYTES, "alias");
constexpr size_t WS_MST   = WS_MOE + MOE_BYTES;
constexpr size_t WS_MDEC  = WS_MST + (size_t)4 * 64 * 4 * 4096 * 4;
constexpr size_t WS_S5ST  = WS_MDEC + 4096;
constexpr size_t WS_K     = WS_S5ST + (size_t)4 * 64 * 2048 * 4;
constexpr size_t WS_V     = WS_K + (size_t)NTOK * 64 * 2;
constexpr size_t WS_KIDX  = WS_V + (size_t)NTOK * 64 * 2;
constexpr size_t WS_ROUTE = WS_KIDX + (size_t)NTOK * 32 * 2;
constexpr size_t WS_ROWS  = WS_ROUTE + (size_t)NTOK * 32;
constexpr int    MAXROWS  = 49152;
constexpr size_t WS_TILES = WS_ROWS + (size_t)MAXROWS * 8;
constexpr size_t WS_S5TAB = WS_TILES + 4096;
constexpr size_t S5TAB_F  = (size_t)(2048 + 2048 + 32768) * 4;
constexpr size_t S5TAB_BBT = S5TAB_F + (size_t)16 * 16 * 128 * 2;
constexpr size_t S5TAB_L  = S5TAB_BBT + (size_t)16 * 128 * 16 * 2;
constexpr size_t WS_WRT   = WS_S5TAB + 2 * S5TAB_L;
constexpr size_t WS_BON   = WS_WRT + (size_t)2 * 2 * 48 * 1024 * 2;
constexpr size_t WS_END   = WS_BON + (size_t)1024 * 64 * 4;

constexpr int CW_BAR = 0;
constexpr int CW_Q   = 4096;
constexpr int CW_CNT = 8192;
constexpr int CW_RB  = 8448;

__device__ __forceinline__ float bf2f(bf16_t b) { return __uint_as_float(((unsigned)b) << 16); }
__device__ __forceinline__ bf16_t f2bf(float f) { const __bf16 h = (__bf16)f; return __builtin_bit_cast(bf16_t, h); }
__device__ __forceinline__ unsigned pk2(float lo, float hi) { typedef __bf16 bf2_t __attribute__((ext_vector_type(2))); const bf2_t h = __builtin_convertvector((f32x2){lo, hi}, bf2_t); return __builtin_bit_cast(unsigned, h); }
__device__ __forceinline__ unsigned cvt_pk_bf16(float lo, float hi) { unsigned r; asm volatile("v_cvt_pk_bf16_f32 %0, %1, %2" : "=v"(r) : "v"(lo), "v"(hi)); return r; }
__device__ __forceinline__ float sigmoidf_(float x) { return 1.0f / (1.0f + __expf(-x)); }
__device__ __forceinline__ float siluf_(float x) { return x / (1.0f + __expf(-x)); }
__device__ __forceinline__ float tanhf_(float x) { const float e = __expf(2.0f * x); return 1.0f - 2.0f / (e + 1.0f); }
__device__ __forceinline__ float softplusf_(float x) { return fmaxf(x, 0.0f) + log1pf(__expf(-fabsf(x))); }
__device__ __forceinline__ float gelu_tanh(float x) { return 0.5f * x * (1.0f + tanhf_(0.7978845608028654f * (x + 0.044715f * x * x * x))); }
template <int CTRL> __device__ __forceinline__ float dppf(float x) { return __int_as_float(__builtin_amdgcn_update_dpp(0, __float_as_int(x), CTRL, 0xF, 0xF, true)); }
__device__ __forceinline__ float sum4(float x) { x += dppf<0xB1>(x); x += dppf<0x4E>(x); return x; }
__device__ __forceinline__ float sum8(float x) { x = sum4(x); x += dppf<0x141>(x); return x; }
__device__ __forceinline__ float sum16(float x) { x = sum8(x); x += dppf<0x140>(x); return x; }
__device__ __forceinline__ int lane_id_() { int l = (int)__builtin_amdgcn_mbcnt_hi(~0u, __builtin_amdgcn_mbcnt_lo(~0u, 0u)); asm volatile("" : "+v"(l)); return l; }
__device__ __forceinline__ float shx(float x, int o) { return __int_as_float(__builtin_amdgcn_ds_bpermute((lane_id_() ^ o) << 2, __float_as_int(x))); }
__device__ __forceinline__ unsigned shdown_u(unsigned x, int o) { return (unsigned)__builtin_amdgcn_ds_bpermute(((lane_id_() + o) & 63) << 2, (int)x); }
__device__ __forceinline__ int shidx_i(int x, int src) { return __builtin_amdgcn_ds_bpermute(src << 2, x); }
__device__ __forceinline__ float wave_sum(float x) { x = sum16(x); x += shx(x, 16); x += shx(x, 32); return x; }
__device__ __forceinline__ void unpack8(const u32x4 v, float (&f)[8]) {
    f[0] = __uint_as_float(v.x << 16); f[1] = __uint_as_float(v.x & 0xffff0000u); f[2] = __uint_as_float(v.y << 16); f[3] = __uint_as_float(v.y & 0xffff0000u);
    f[4] = __uint_as_float(v.z << 16); f[5] = __uint_as_float(v.z & 0xffff0000u); f[6] = __uint_as_float(v.w << 16); f[7] = __uint_as_float(v.w & 0xffff0000u);
}

__device__ __forceinline__ void st16_wt(void* p, u32x4 v) { asm volatile("global_store_dwordx4 %0, %1, off sc1\n\ts_nop 1" :: "v"(p), "v"(v) : "memory"); }
#define XB_TMO      128
#define XB_XCNT(j)  (256  + 64 * (j))
#define XB_XSUB(j)  (1280 + 64 * (j))
#define XB_XGEN(j)  (2304 + 64 * (j))
#define XB_TOP      3328
#define XB_TOPGEN   3392
#define XCD_BAR_WORDS 3456
#define XB_SPIN_CAP (1u << 22)
__device__ __forceinline__ unsigned xb_ld(unsigned* p)              { return __hip_atomic_load(p, __ATOMIC_RELAXED, __HIP_MEMORY_SCOPE_AGENT); }
__device__ __forceinline__ unsigned xb_add(unsigned* p, unsigned v) { return __hip_atomic_fetch_add(p, v, __ATOMIC_RELAXED, __HIP_MEMORY_SCOPE_AGENT); }
__device__ __forceinline__ unsigned xb_xcc_id() { return (unsigned)__builtin_amdgcn_s_getreg((3 << 11) | 20) & 0xFu; }
#define XB_SPIN(cond, bar) do { unsigned _sp = 0; while (cond) { __builtin_amdgcn_s_sleep(1); \
    if ((++_sp & 255u) == 0u) { if (xb_ld(&(bar)[XB_TMO])) break; if (_sp > XB_SPIN_CAP) { atomicAdd(&(bar)[XB_TMO], 1u); break; } } } } while (0)
struct XcdBarrier { unsigned* bar; unsigned x; volatile LAS unsigned* st; };
__device__ __forceinline__ XcdBarrier xcd_barrier_post(unsigned* bar, volatile LAS unsigned* st) {
    XcdBarrier b; b.bar = bar; b.x = xb_xcc_id(); b.st = st;
    if (threadIdx.x == 0) (void)xb_add(&bar[XB_XCNT(b.x)], 1u);
    return b;
}
__device__ __forceinline__ void xcd_barrier_complete(unsigned* bar, unsigned x, unsigned& nloc, unsigned& nx) {
    const unsigned G = gridDim.x * gridDim.y * gridDim.z;
    unsigned sum, cnt, mine, sp = 0u;
    for (;;) {
        sum = 0u; cnt = 0u; mine = 0u;
#pragma unroll
        for (unsigned j = 0; j < 16; ++j) { const unsigned c = xb_ld(&bar[XB_XCNT(j)]); sum += c; cnt += (c > 0u) ? 1u : 0u; mine = (j == x) ? c : mine; }
        if (sum == G) break;
        __builtin_amdgcn_s_sleep(1);
        if ((++sp & 255u) == 0u) { if (xb_ld(&bar[XB_TMO])) break; if (sp > XB_SPIN_CAP) { atomicAdd(&bar[XB_TMO], 1u); break; } }
    }
    nloc = mine > 0u ? mine : 1u; nx = cnt > 0u ? cnt : 1u;
}
__device__ __forceinline__ void xcd_barrier(const XcdBarrier& b_) {
    XcdBarrier b = b_; { const unsigned long long v = (unsigned long long)b.bar; unsigned lo = __builtin_amdgcn_readfirstlane((unsigned)v), hi = __builtin_amdgcn_readfirstlane((unsigned)(v >> 32)); asm volatile("" : "+s"(lo), "+s"(hi)); b.bar = (unsigned*)(((unsigned long long)hi << 32) | lo); unsigned xx = __builtin_amdgcn_readfirstlane(b.x); asm volatile("" : "+s"(xx)); b.x = xx; }
    asm volatile("s_waitcnt vmcnt(0)" ::: "memory");
    __syncthreads();
    if (threadIdx.x == 0) {
        unsigned* bar = b.bar;
        __builtin_amdgcn_s_waitcnt(0);
        unsigned nloc = b.st[0], nx = b.st[1];
        if (nloc == 0u) { xcd_barrier_complete(bar, b.x, nloc, nx); b.st[0] = nloc; b.st[1] = nx; }
        const unsigned old = xb_add(&bar[XB_XSUB(b.x)], 1u);
        const unsigned gen = old / nloc;
        if (old + 1u == (gen + 1u) * nloc) {
            __builtin_amdgcn_fence(__ATOMIC_RELEASE, "agent");
            asm volatile("s_waitcnt vmcnt(0)" ::: "memory");
            const unsigned og = xb_add(&bar[XB_TOP], 1u);
            const unsigned tg = og / nx;
            if (og + 1u == (tg + 1u) * nx) xb_add(&bar[XB_TOPGEN], 1u);
            else XB_SPIN(xb_ld(&bar[XB_TOPGEN]) == tg, bar);
            __builtin_amdgcn_fence(__ATOMIC_ACQUIRE, "agent");
            xb_add(&bar[XB_XGEN(b.x)], 1u);
            asm volatile("s_waitcnt vmcnt(0)" ::: "memory");
        } else {
            XB_SPIN(xb_ld(&bar[XB_XGEN(b.x)]) == gen, bar);
            __builtin_amdgcn_fence(__ATOMIC_ACQUIRE, "agent");
            asm volatile("s_waitcnt vmcnt(0)" ::: "memory");
        }
    }
    __syncthreads();
}

namespace pg8 {
constexpr int BM = 256, BK = 64, HALF = 128, HTB = HALF * BK * 2, STAGE_BYTES = 8 * HTB, NXCD = 8, WGM = 8;
__host__ __device__ __forceinline__ int lds_byte(int r, int c) { const int st = (r >> 4) * 2 + (c >> 5), rr = r & 15, cc = c & 31, ob = rr * 64 + cc * 2; return st * 1024 + (ob ^ (((ob >> 9) & 1) << 5)); }
__host__ __device__ __forceinline__ void stage_rc(int b, int& R, int& C) { const int st = b / 1024, sb = b % 1024, swz = sb ^ (((sb >> 9) & 1) << 5); R = (st >> 1) * 16 + swz / 64; C = (st & 1) * 32 + (swz % 64) / 2; }
__host__ __device__ __forceinline__ int perm32(int rho) { const int n = rho >> 4, i = rho & 15; return 8 * (i >> 2) + 4 * n + (i & 3); }
struct Unit { int pm, pn; const char* a; const char* b; };

struct StaticOrder {
    int nM, nN, nwg, G, c, K; const char* A; const char* B;
    __device__ void init(const bf16_t* A_, const bf16_t* B_, int M, int N, int K_, int G_, int c_) { A = (const char*)A_; B = (const char*)B_; K = K_; nM = M / BM; nN = N / BM; nwg = nM * nN; G = G_; c = c_; }
    __device__ bool next(int i, Unit& u) const {
        const long L = (long)i * G + c; if (L >= nwg) return false;
        int wgid = (int)L; { const int q = nwg / NXCD, r = nwg % NXCD, xcd = wgid % NXCD, off = wgid / NXCD; wgid = (xcd < r ? xcd * (q + 1) : r * (q + 1) + (xcd - r) * q) + off; }
        const int nig = WGM * nN, gid = wgid / nig, fm = gid * WGM, gsz = (nM - fm) < WGM ? (nM - fm) : WGM;
        u.pm = fm + ((wgid % nig) % gsz); u.pn = (wgid % nig) / gsz;
        u.a = A + (size_t)u.pm * 256 * K * 2; u.b = B + (size_t)u.pn * 256 * K * 2; return true;
    }
};

template <class Epi, class Sched, bool GATHER = false>
__device__ __forceinline__ void gemm_phase(LAS unsigned char* lds, const int K_, const Sched& S, const Epi& E, const char* Aall = nullptr, const int* arow = nullptr) {
    int K = K_; asm volatile("" : "+s"(K));
    int tid_ = threadIdx.x; asm volatile("" : "+v"(tid_));
    const int tid = tid_, wid = __builtin_amdgcn_readfirstlane(tid >> 6), lane = tid & 63, wr = wid >> 2, wc = wid & 3, fr = lane & 15, fq = lane >> 4;
    const int nt = K / BK;
    unsigned voffA[2], voffB[2]; int Rst[2], Cst[2];
#pragma unroll
    for (int i = 0; i < 2; ++i) { int R, C; stage_rc(tid * 16 + i * 8192, R, C); const int Rb = Epi::PERM ? ((R & ~31) + perm32(R & 31)) : R; Rst[i] = R; Cst[i] = C;
        voffA[i] = (unsigned)(R * K + C) * 2u; voffB[i] = (unsigned)(Rb * K + C) * 2u; }
    unsigned gv[2][2], gn[2][2];
#define PG8_GOFF(dst, unit) do { _Pragma("unroll") for (int h_ = 0; h_ < 2; ++h_) _Pragma("unroll") for (int i_ = 0; i_ < 2; ++i_) { const int rr_ = arow[(unit).pm * BM + h_ * HALF + Rst[i_]]; \
        dst[h_][i_] = ((unsigned)(rr_ < 0 ? 0 : rr_ >> 1) * (unsigned)K + (unsigned)Cst[i_]) * 2u; } } while (0)
    const size_t kstep = (size_t)(BK * 2);
    const size_t hstep = (size_t)HALF * K * 2;
    const unsigned ldsw = (unsigned)wid * 1024u;
    const int aoff = lds_byte(wr * 64 + fr, fq * 8), boff = lds_byte(wc * 32 + fr, fq * 8);
#define PG8_SA(b, h) (((b) * 2 + (h)) * HTB)
#define PG8_SB(b, h) ((4 + (b) * 2 + (h)) * HTB)
#define PG8_STAGE(bufoff, gbase, voff) do { _Pragma("unroll") for (int _i = 0; _i < 2; ++_i) \
        __builtin_amdgcn_global_load_lds((const unsigned*)((const char*)(gbase) + (voff)[_i]), (LAS unsigned*)(lds + (bufoff) + ldsw + _i * 8192), 16, 0, 0); } while (0)
#define PG8_LDA(dst, b, h) do { _Pragma("unroll") for (int m = 0; m < 4; ++m) _Pragma("unroll") for (int k = 0; k < 2; ++k) dst[m][k] = *(const LAS bf16x8*)(lds + PG8_SA(b, h) + aoff + m * 2048 + k * 1024); } while (0)
#define PG8_LDB(dst, b, h) do { _Pragma("unroll") for (int n = 0; n < 2; ++n) _Pragma("unroll") for (int k = 0; k < 2; ++k) dst[n][k] = *(const LAS bf16x8*)(lds + PG8_SB(b, h) + boff + n * 2048 + k * 1024); } while (0)
#define PG8_MMA(ai, bj, At, Bt) do { __builtin_amdgcn_s_setprio(1); _Pragma("unroll") for (int m = 0; m < 4; ++m) _Pragma("unroll") for (int n = 0; n < 2; ++n) _Pragma("unroll") for (int k = 0; k < 2; ++k) \
        acc[ai][bj][m][n] = __builtin_amdgcn_mfma_f32_16x16x32_bf16(Bt[n][k], At[m][k], acc[ai][bj][m][n], 0, 0, 0); __builtin_amdgcn_s_setprio(0); } while (0)
#define PG8_WAIT_V(n) asm volatile("s_waitcnt vmcnt(" #n ")" ::: "memory")
#define PG8_WAIT_L(n) asm volatile("s_waitcnt lgkmcnt(" #n ")" ::: "memory")
#define PG8_BAR __builtin_amdgcn_s_barrier()
#define PG8_SCHED __builtin_amdgcn_sched_barrier(0)
    Unit cur, nxt; int ui = 0;
    if (!S.next(0, cur)) return;
    f32x4 acc[2][2][4][2];
#pragma unroll
    for (int a = 0; a < 2; ++a)
#pragma unroll
        for (int b = 0; b < 2; ++b)
#pragma unroll
            for (int m = 0; m < 4; ++m)
#pragma unroll
                for (int n = 0; n < 2; ++n) acc[a][b][m][n] = (f32x4){0.f, 0.f, 0.f, 0.f};
    bf16x8 At[4][2], B0[2][2], B1[2][2];
    const char* cA = GATHER ? Aall : cur.a; const char* cB = cur.b;
    if (GATHER) PG8_GOFF(gv, cur);
#define PG8_STAGE_A(bufoff, gbase, h, vo) do { if (GATHER) PG8_STAGE(bufoff, gbase, (vo)[h]); else PG8_STAGE(bufoff, (gbase) + ((h) ? hstep : 0), voffA); } while (0)
    PG8_STAGE(PG8_SB(0, 0), cB, voffB); PG8_STAGE_A(PG8_SA(0, 0), cA, 0, gv); PG8_STAGE(PG8_SB(0, 1), cB + hstep, voffB); PG8_STAGE_A(PG8_SA(0, 1), cA, 1, gv);
    if (wr == 1) PG8_BAR;
    PG8_WAIT_V(4); PG8_BAR;
    PG8_STAGE(PG8_SB(1, 0), cB + kstep, voffB); PG8_STAGE_A(PG8_SA(1, 0), cA + kstep, 0, gv); PG8_STAGE(PG8_SB(1, 1), cB + hstep + kstep, voffB);
    PG8_WAIT_V(6); PG8_BAR;
    for (;;) {
        const bool has_next = S.next(ui + 1, nxt);
        const char* nA = GATHER ? cA : (has_next ? nxt.a : cA); const char* nB = has_next ? nxt.b : cB;
        if (GATHER) { if (has_next) PG8_GOFF(gn, nxt); else {
#pragma unroll
            for (int h_ = 0; h_ < 2; ++h_)
#pragma unroll
                for (int i_ = 0; i_ < 2; ++i_) gn[h_][i_] = gv[h_][i_]; } }
        for (int t = 0; t < nt; t += 2) {
            const bool last = (t == nt - 2);
            const char* a1 = cA + (size_t)(t + 1) * kstep;
            const char* a2 = last ? nA : cA + (size_t)(t + 2) * kstep; const char* b2 = last ? nB : cB + (size_t)(t + 2) * kstep;
            const char* a3 = a2 + kstep; const char* b3 = b2 + kstep;
            unsigned vo2[2][2];
#pragma unroll
            for (int h_ = 0; h_ < 2; ++h_)
#pragma unroll
                for (int i_ = 0; i_ < 2; ++i_) vo2[h_][i_] = GATHER ? (last ? gn[h_][i_] : gv[h_][i_]) : 0u;
            PG8_LDB(B0, 0, 0); PG8_SCHED; PG8_LDA(At, 0, 0); PG8_STAGE_A(PG8_SA(1, 1), a1, 1, gv);
            PG8_WAIT_L(8); PG8_BAR; PG8_WAIT_L(0); PG8_MMA(0, 0, At, B0); PG8_BAR; PG8_SCHED;
            PG8_LDB(B1, 0, 1); PG8_STAGE(PG8_SB(0, 0), b2, voffB);
            PG8_BAR; PG8_WAIT_L(0); PG8_MMA(0, 1, At, B1); PG8_BAR;
            PG8_LDA(At, 0, 1); PG8_STAGE_A(PG8_SA(0, 0), a2, 0, vo2);
            PG8_BAR; PG8_WAIT_L(0); PG8_MMA(1, 0, At, B0); PG8_BAR; PG8_SCHED;
            PG8_STAGE(PG8_SB(0, 1), b2 + hstep, voffB);
            PG8_WAIT_V(6); PG8_BAR; PG8_MMA(1, 1, At, B1); PG8_BAR;
            PG8_LDB(B0, 1, 0); PG8_SCHED; PG8_LDA(At, 1, 0); PG8_STAGE_A(PG8_SA(0, 1), a2, 1, vo2);
            PG8_WAIT_L(8); PG8_BAR; PG8_WAIT_L(0); PG8_MMA(0, 0, At, B0); PG8_BAR; PG8_SCHED;
            PG8_LDB(B1, 1, 1); PG8_STAGE(PG8_SB(1, 0), b3, voffB);
            PG8_BAR; PG8_WAIT_L(0); PG8_MMA(0, 1, At, B1); PG8_BAR;
            PG8_LDA(At, 1, 1); PG8_STAGE_A(PG8_SA(1, 0), a3, 0, vo2);
            PG8_BAR; PG8_WAIT_L(0); PG8_MMA(1, 0, At, B0); PG8_BAR; PG8_SCHED;
            PG8_STAGE(PG8_SB(1, 1), b3 + hstep, voffB);
            PG8_WAIT_V(6); PG8_BAR; PG8_MMA(1, 1, At, B1); PG8_BAR;
        }
        E(acc, cur, wr, wc, fr, fq);
        if (!has_next) break;
#pragma unroll
        for (int a = 0; a < 2; ++a)
#pragma unroll
            for (int b = 0; b < 2; ++b)
#pragma unroll
                for (int m = 0; m < 4; ++m)
#pragma unroll
                    for (int n = 0; n < 2; ++n) acc[a][b][m][n] = (f32x4){0.f, 0.f, 0.f, 0.f};
        cur = nxt; cA = nA; cB = nB; ++ui;
        if (GATHER) {
#pragma unroll
            for (int h_ = 0; h_ < 2; ++h_)
#pragma unroll
                for (int i_ = 0; i_ < 2; ++i_) gv[h_][i_] = gn[h_][i_]; }
    }
    PG8_WAIT_V(0);
    if (wr == 0) PG8_BAR;
    PG8_BAR;
#undef PG8_SA
#undef PG8_SB
#undef PG8_STAGE
#undef PG8_STAGE_A
#undef PG8_GOFF
#undef PG8_LDA
#undef PG8_LDB
#undef PG8_MMA
#undef PG8_WAIT_V
#undef PG8_WAIT_L
#undef PG8_BAR
#undef PG8_SCHED
}

struct EpiBf16 {
    static constexpr bool PERM = true;
    bf16_t* O; int ldc;
    __device__ __forceinline__ void operator()(const f32x4 (&acc)[2][2][4][2], const Unit& u, int wr, int wc, int fr, int fq) const {
        const int row0 = u.pm * BM + wr * 64 + fr, col0 = u.pn * BM + wc * 32 + 8 * fq;
#pragma unroll
        for (int ai = 0; ai < 2; ++ai)
#pragma unroll
            for (int m = 0; m < 4; ++m) { bf16_t* rowp = O + (size_t)(row0 + ai * HALF + m * 16) * ldc + col0;
#pragma unroll
                for (int bj = 0; bj < 2; ++bj) { const f32x4 v0 = acc[ai][bj][m][0], v1 = acc[ai][bj][m][1];
                    u32x4 w; w.x = cvt_pk_bf16(v0[0], v0[1]); w.y = cvt_pk_bf16(v0[2], v0[3]); w.z = cvt_pk_bf16(v1[0], v1[1]); w.w = cvt_pk_bf16(v1[2], v1[3]);
                    st16_wt(rowp + bj * HALF, w); } }
    }
};
struct EpiResid {
    static constexpr bool PERM = false;
    const float* Cin; float* C; int ldc;
    __device__ __forceinline__ void operator()(const f32x4 (&acc)[2][2][4][2], const Unit& u, int wr, int wc, int fr_, int fq_) const {
        int fr = fr_, fq = fq_; asm volatile("" : "+v"(fr), "+v"(fq));
        const int row0 = u.pm * BM + wr * 64 + fr, col0 = u.pn * BM + wc * 32 + 4 * fq;
#pragma unroll
        for (int ai = 0; ai < 2; ++ai)
#pragma unroll
            for (int mp = 0; mp < 2; ++mp) { f32x4 cv[2][2][2];
#pragma unroll
                for (int mm = 0; mm < 2; ++mm) { const float* rowp = Cin + (size_t)(row0 + ai * HALF + (2 * mp + mm) * 16) * ldc + col0;
#pragma unroll
                    for (int bj = 0; bj < 2; ++bj)
#pragma unroll
                        for (int n = 0; n < 2; ++n) cv[mm][bj][n] = *(const f32x4*)(rowp + bj * HALF + n * 16); }
#pragma unroll
                for (int mm = 0; mm < 2; ++mm) { float* rowp = C + (size_t)(row0 + ai * HALF + (2 * mp + mm) * 16) * ldc + col0;
#pragma unroll
                    for (int bj = 0; bj < 2; ++bj)
#pragma unroll
                        for (int n = 0; n < 2; ++n) { const f32x4 o_ = cv[mm][bj][n] + acc[ai][bj][2 * mp + mm][n]; st16_wt(rowp + bj * HALF + n * 16, __builtin_bit_cast(u32x4, o_)); } }
                asm volatile("" ::: "memory"); }
    }
};
template <int ACT  > struct EpiGated {
    static constexpr bool PERM = true;
    bf16_t* O; int ldo; int coloff; const float* ba; const float* bb;
    __device__ __forceinline__ void operator()(const f32x4 (&acc)[2][2][4][2], const Unit& u, int wr, int wc, int fr, int fq) const {
        const int row0 = u.pm * BM + wr * 64 + fr, cl = u.pn * HALF + wc * 32 + 8 * fq;
        float va[8], vb[8];
#pragma unroll
        for (int j = 0; j < 8; ++j) { va[j] = (ACT == 0) ? ba[cl + j] : 0.f; vb[j] = (ACT == 0) ? bb[cl + j] : 0.f; }
#pragma unroll
        for (int ai = 0; ai < 2; ++ai)
#pragma unroll
            for (int m = 0; m < 4; ++m) { bf16_t* rowp = O + (size_t)(row0 + ai * HALF + m * 16) * ldo + coloff + cl;
                float o[8];
#pragma unroll
                for (int n = 0; n < 2; ++n)
#pragma unroll
                    for (int j = 0; j < 4; ++j) { const float a = acc[ai][0][m][n][j] + va[4 * n + j], b = acc[ai][1][m][n][j] + vb[4 * n + j];
                        o[4 * n + j] = (ACT == 0) ? a * sigmoidf_(b) : siluf_(a) * b; }
                u32x4 w; w.x = cvt_pk_bf16(o[0], o[1]); w.y = cvt_pk_bf16(o[2], o[3]); w.z = cvt_pk_bf16(o[4], o[5]); w.w = cvt_pk_bf16(o[6], o[7]);
                st16_wt(rowp, w); asm volatile("" ::: "memory"); }
    }
};
struct EpiMoeOut {
    static constexpr bool PERM = true;
    bf16_t* O; const int* row_tok; const float* row_w; LAS unsigned char* lds;
    __device__ __forceinline__ void operator()(const f32x4 (&acc)[2][2][4][2], const Unit& u, int wr, int wc, int fr_, int fq_) const {
        int fr = fr_, fq = fq_; asm volatile("" : "+v"(fr), "+v"(fq));
        const int col0 = u.pn * BM + wc * 32 + 8 * fq, lane = fq * 16 + fr;
        LAS u32x2* rinfo = (LAS u32x2*)(lds + STAGE_BYTES) + (wr * 4 + wc) * 128;
        { const int ra = u.pm * BM + wr * 64 + lane, rb = ra + HALF;
          const u32x2 ia = (u32x2){(unsigned)row_tok[ra], __float_as_uint(row_w[ra])}, ib = (u32x2){(unsigned)row_tok[rb], __float_as_uint(row_w[rb])};
          rinfo[lane] = ia; rinfo[64 + lane] = ib; }
#pragma unroll
        for (int ai = 0; ai < 2; ++ai)
#pragma unroll
            for (int m = 0; m < 4; ++m) { const u32x2 inf = rinfo[ai * 64 + m * 16 + fr]; const int ts = (int)inf.x; const float w = __uint_as_float(inf.y);
                if (ts >= 0) { bf16_t* rowp = O + ((size_t)(ts & 1) * NTOK + (size_t)(ts >> 1)) * DM + col0;
#pragma unroll
                    for (int bj = 0; bj < 2; ++bj) { const f32x4 v0 = acc[ai][bj][m][0] * w, v1 = acc[ai][bj][m][1] * w;
                        u32x4 q; q.x = cvt_pk_bf16(v0[0], v0[1]); q.y = cvt_pk_bf16(v0[2], v0[3]); q.z = cvt_pk_bf16(v1[0], v1[1]); q.w = cvt_pk_bf16(v1[2], v1[3]);
                        st16_wt(rowp + bj * HALF, q); } } }
    }
};
struct MoeOrder {
    int K; const char* A; const char* B; size_t bstride; const LAS int* list;
    static __device__ __forceinline__ void build(LAS int* list, const int* tiles, int nN, int G, int c) {
        const int nrt = tiles[0], nwg = nrt * nN; int n = 0;
        for (int i = 0; ; ++i) { const long L = (long)i * G + c; if (L >= (long)nwg || n >= 20) break;
            int wgid = (int)L; { const int q = nwg / NXCD, r = nwg % NXCD, xcd = wgid % NXCD, off = wgid / NXCD; wgid = (xcd < r ? xcd * (q + 1) : r * (q + 1) + (xcd - r) * q) + off; }
            const int pm = wgid / nN; list[1 + 3 * n] = pm; list[2 + 3 * n] = wgid % nN; list[3 + 3 * n] = tiles[64 + pm]; ++n; }
        list[0] = n;
    }
    __device__ bool next(int i, Unit& u) const {
        const int n = __builtin_amdgcn_readfirstlane(list[0]); if (i >= n) return false;
        u.pm = __builtin_amdgcn_readfirstlane(list[1 + 3 * i]); u.pn = __builtin_amdgcn_readfirstlane(list[2 + 3 * i]); const int e = __builtin_amdgcn_readfirstlane(list[3 + 3 * i]);
        u.a = A + (size_t)u.pm * 256 * K * 2; u.b = B + (size_t)e * bstride + (size_t)u.pn * 256 * K * 2; return true;
    }
};
}

struct Params { const float* in[44]; float* out; unsigned char* ws; int ph_lo, ph_hi; };
enum { I_X = 0, I_NORM1, I_WIN, I_MCONVW, I_MCONVB, I_MDTB, I_MALOG, I_MD, I_MNORM, I_RMU, I_RW0, I_RW2, I_RA0, I_RA2, I_RG2, I_RKK, I_RKA, I_RRK, I_RLNW, I_RLNB,
       I_CKVN, I_CWUK, I_CWUV, I_RELB, I_SARE, I_SAIM, I_SBRE, I_SBIM, I_SCRE, I_SCIM, I_SD, I_SLOGDT, I_SGLUW, I_SGLUB, I_WOUT, I_NORM2, I_WRG, I_BRG, I_WRE, I_BRE,
       I_WGATE, I_WUP, I_WDOWN, I_FNORM };

typedef const float* const __attribute__((address_space(4)))* in_tab_t;
struct Frame {
    LAS unsigned char* lds; int tid, lane, wave, bid, G;
    in_tab_t in; float* out; unsigned char* ws; unsigned* ctl;
    volatile LAS int* misc;
};

__device__ __forceinline__ int q_pop(Frame& F, int qi) {
    __syncthreads();
    if (F.tid == 0) F.misc[0] = (int)__hip_atomic_fetch_add(F.ctl + CW_Q + 64 * qi, 1u, __ATOMIC_RELAXED, __HIP_MEMORY_SCOPE_AGENT);
    __syncthreads();
    return F.misc[0];
}

__device__ __forceinline__ const void* opaque_ptr(const void* p) { const unsigned long long v = (unsigned long long)p; unsigned lo = __builtin_amdgcn_readfirstlane((unsigned)v), hi = __builtin_amdgcn_readfirstlane((unsigned)(v >> 32));
    asm volatile("" : "+s"(lo), "+s"(hi)); return (const void*)(((unsigned long long)hi << 32) | lo); }
__device__ __forceinline__ Frame relocal(const Frame& G) { Frame F = G; asm volatile("" : "+v"(F.tid)); F.ws = (unsigned char*)opaque_ptr(F.ws); F.ctl = (unsigned*)(F.ws + WS_CTL); F.in = (in_tab_t)(unsigned long long)opaque_ptr((const void*)(unsigned long long)F.in); F.lane = F.tid & 63; F.wave = __builtin_amdgcn_readfirstlane(F.tid >> 6); return F; }
template <int K> __device__ __forceinline__ f32x4 mma_nt(const LAS bf16_t* A, int lda, const LAS bf16_t* Bt, int ldb, f32x4 acc, int lane) {
    const int r = lane & 15, g = lane >> 4;
#pragma unroll
    for (int k0 = 0; k0 < K; k0 += 32) {
        const bf16x8 a = *(const LAS bf16x8*)(A + r * lda + k0 + 8 * g);
        const bf16x8 b = *(const LAS bf16x8*)(Bt + r * ldb + k0 + 8 * g);
        acc = __builtin_amdgcn_mfma_f32_16x16x32_bf16(a, b, acc, 0, 0, 0);
    }
    return acc;
}

template <class SrcMap> __device__ __forceinline__ void tr_tile(Frame& F, int ldsrc, bf16_t* dst, int K, int k0, int n0, SrcMap sm) {
    LAS float* tile = (LAS float*)F.lds;
    __syncthreads();
    { const int n4 = (F.tid & 63) * 4, kk = F.tid >> 6; const float* sp = sm(n0 + n4);
      f32x4 v[8];
#pragma unroll
      for (int ps = 0; ps < 8; ++ps) { v[ps] = (f32x4){0.f, 0.f, 0.f, 0.f}; if (sp) v[ps] = __builtin_nontemporal_load((const f32x4*)(sp + (size_t)(k0 + kk + 8 * ps) * ldsrc)); }
#pragma unroll
      for (int ps = 0; ps < 8; ++ps) { LAS float* t = tile + (kk + 8 * ps) * 257 + n4; t[0] = v[ps][0]; t[1] = v[ps][1]; t[2] = v[ps][2]; t[3] = v[ps][3]; } }
    __syncthreads();
    { const int kc = F.tid & 7;
#pragma unroll
      for (int j = 0; j < 4; ++j) { const int n = (F.tid >> 3) + 64 * j; float f[8];
#pragma unroll
          for (int i = 0; i < 8; ++i) f[i] = tile[(8 * kc + i) * 257 + n];
          u32x4 w; w.x = pk2(f[0], f[1]); w.y = pk2(f[2], f[3]); w.z = pk2(f[4], f[5]); w.w = pk2(f[6], f[7]);
          *(u32x4*)(dst + (size_t)(n0 + n) * K + k0 + 8 * kc) = w; } }
}

struct SmIn { const float* base; __device__ __forceinline__ const float* operator()(int n) const {
    int c; if (n < 772) c = n; else if (n < UR) return nullptr; else if (n < UR + 896) c = 772 + (n - UR); else if (n < UC) return nullptr;
    else if (n < UC + 680) c = 1668 + (n - UC); else if (n < US) return nullptr; else if (n < US + 256) c = 2348 + (n - US); else return nullptr; return base + c; } };
struct SmId { const float* base; __device__ __forceinline__ const float* operator()(int n) const { return base + n; } };
struct SmGlu { const float* base; __device__ __forceinline__ const float* operator()(int n) const { const int pn = n >> 8, rr = n & 255; return base + (rr < 128 ? 128 * pn + rr : 256 + 128 * pn + (rr - 128)); } };
struct SmGU { const float* gate; const float* up; __device__ __forceinline__ const float* operator()(int n) const {
    const unsigned long long d = (unsigned long long)up - (unsigned long long)gate; const unsigned long long a = (unsigned long long)gate + (((n & 255) < 128) ? 0ull : d); return (const float*)a + 128 * (n >> 8) + (n & 127); } };
__device__ __forceinline__ void phase_prologue(const Frame& F_) { Frame F = relocal(F_);
    for (int t = F.bid; t < 496; t += F.G) {
        if (t < 352) { const int l = t / 176, r = t % 176, kt = r / 11, nt = r % 11;
            tr_tile(F, NIN, (bf16_t*)(F.ws + WS_WIN) + (size_t)l * NINP * DM, DM, kt * 64, nt * 256, SmIn{F.in[I_WIN] + (size_t)l * DM * NIN}); }
        else if (t < 480) { const int q = t - 352, l = q / 64, r = q % 64, kt = r / 4, nt = r % 4;
            tr_tile(F, DM, (bf16_t*)(F.ws + WS_WOUT) + (size_t)l * DM * DM, DM, kt * 64, nt * 256, SmId{F.in[I_WOUT] + (size_t)l * DM * DM}); }
        else { const int q = t - 480, l = q / 8, r = q % 8, kt = r / 2, nt = r % 2;
            tr_tile(F, 512, (bf16_t*)(F.ws + WS_GLU) + (size_t)l * 512 * 256, 256, kt * 64, nt * 256, SmGlu{F.in[I_SGLUW] + (size_t)l * 256 * 512}); }
    }
    for (int i = F.bid * NTHR + F.tid; i < 2 * 48 * 1024; i += F.G * NTHR) { const int l = i / 49152, r = i % 49152, o = r >> 10, k = r & 1023;
        float v = 0.f; if (o < 32) v = F.in[I_WRE][((size_t)l * DM + k) * 32 + o]; else if (o < 36) v = F.in[I_WRG][((size_t)l * DM + k) * 4 + (o - 32)];
        v *= F.in[I_NORM2][l * DM + k];
        const bf16_t hi = f2bf(v); const bf16_t lo = f2bf(v - bf2f(hi));
        bf16_t* w = (bf16_t*)(F.ws + WS_WRT) + (size_t)l * 2 * 49152; w[r] = hi; w[49152 + r] = lo; }
    for (int i = F.bid * NTHR + F.tid; i < 2048 + 65536; i += F.G * NTHR) {
        if (i < 2048) {
            const int l = i >> 10, gn = i & 1023, g = gn >> 6;
            float* tab = (float*)(F.ws + WS_S5TAB + (size_t)l * S5TAB_L);
            const float lre = fminf(F.in[I_SARE][l * 1024 + gn], -1e-4f), lim = F.in[I_SAIM][l * 1024 + gn];
            const float dt = expf(F.in[I_SLOGDT][l * 16 + g]);
            const float mag = expf(dt * lre); float sn, cs; sincosf(dt * lim, &sn, &cs);
            const float are = mag * cs, aim = mag * sn;
            const float den = lre * lre + lim * lim;
            const float fre = ((are - 1.0f) * lre + aim * lim) / den, fim = (aim * lre - (are - 1.0f) * lim) / den;
            tab[gn * 2] = are; tab[gn * 2 + 1] = aim;
            float pr = are, pi = aim;
#pragma unroll
            for (int s = 0; s < 6; ++s) { const float nr = pr * pr - pi * pi, ni = 2.0f * pr * pi; pr = nr; pi = ni; }
            tab[2048 + gn * 2] = pr; tab[2048 + gn * 2 + 1] = pi;
            const float* bre = F.in[I_SBRE] + ((size_t)l * 1024 + gn) * 16; const float* bim = F.in[I_SBIM] + ((size_t)l * 1024 + gn) * 16;
            bf16_t* bbt = (bf16_t*)(F.ws + WS_S5TAB + (size_t)l * S5TAB_L + S5TAB_BBT); const int n = gn & 63, col = 4 * (n & 31) + 2 * (n >> 5);
            for (int p = 0; p < 16; ++p) { const float vr = fre * bre[p] - fim * bim[p], vi = fre * bim[p] + fim * bre[p];
                bbt[((size_t)g * 128 + col) * 16 + p] = f2bf(vr); bbt[((size_t)g * 128 + col + 1) * 16 + p] = f2bf(vi); }
        } else {
            const int j = i - 2048, l = j >> 15, r = j & 32767, gp = r >> 7, k = r & 127;
            bf16_t* cm = (bf16_t*)(F.ws + WS_S5TAB + (size_t)l * S5TAB_L + S5TAB_F);
            const int n = (k >> 2) + 32 * ((k >> 1) & 1);
            const float v = (k & 1) == 0 ? F.in[I_SCRE][((size_t)l * 256 + gp) * 64 + n] : -F.in[I_SCIM][((size_t)l * 256 + gp) * 64 + n];
            cm[r] = f2bf(v);
        }
    }
}

__device__ __forceinline__ void phase_norm(const Frame& F_, const float* xin, bool add_o, const float* w, int mode) { Frame F = relocal(F_);
    float* X = (float*)(F.ws + WS_X); bf16_t* H = (bf16_t*)(F.ws + WS_H); const bf16_t* O = (const bf16_t*)(F.ws + WS_U);
    for (int row0 = F.bid * 32 + F.wave * 4; row0 < NTOK; row0 += F.G * 32) {
        f32x4 v[4][4]; u32x2 oa[4][4], ob[4][4];
#pragma unroll
        for (int r = 0; r < 4; ++r)
#pragma unroll
            for (int j = 0; j < 4; ++j) { const int c = 4 * F.lane + 256 * j; const size_t o = (size_t)(row0 + r) * DM + c; v[r][j] = (mode == 2) ? __builtin_nontemporal_load((const f32x4*)(xin + o)) : *(const f32x4*)(xin + o);
                if (add_o) { oa[r][j] = __builtin_nontemporal_load((const u32x2*)(O + o)); ob[r][j] = __builtin_nontemporal_load((const u32x2*)(O + (size_t)NTOK * DM + o)); } }
#pragma unroll
        for (int r = 0; r < 4; ++r) { const int row = row0 + r; float ss = 0.f;
#pragma unroll
            for (int j = 0; j < 4; ++j) {
                if (add_o) { const u32x2 a = oa[r][j], b = ob[r][j];
                    v[r][j][0] += __uint_as_float(a.x << 16) + __uint_as_float(b.x << 16); v[r][j][1] += __uint_as_float(a.x & 0xffff0000u) + __uint_as_float(b.x & 0xffff0000u);
                    v[r][j][2] += __uint_as_float(a.y << 16) + __uint_as_float(b.y << 16); v[r][j][3] += __uint_as_float(a.y & 0xffff0000u) + __uint_as_float(b.y & 0xffff0000u); }
                ss += v[r][j][0] * v[r][j][0] + v[r][j][1] * v[r][j][1] + v[r][j][2] * v[r][j][2] + v[r][j][3] * v[r][j][3]; }
            ss = wave_sum(ss);
            const float rstd = rsqrtf(ss * (1.0f / DM) + 1e-6f);
#pragma unroll
            for (int j = 0; j < 4; ++j) { const int c = 4 * F.lane + 256 * j; const f32x4 wv = *(const f32x4*)(w + c);
                if (mode == 2) { __builtin_nontemporal_store(v[r][j] * rstd * wv, (f32x4*)(F.out + (size_t)row * DM + c)); }
                else { if (mode == 0) *(f32x4*)(X + (size_t)row * DM + c) = v[r][j];
                    u32x2 o; o.x = pk2(v[r][j][0] * rstd * wv[0], v[r][j][1] * rstd * wv[1]); o.y = pk2(v[r][j][2] * rstd * wv[2], v[r][j][3] * rstd * wv[3]);
                    *(u32x2*)(H + (size_t)row * DM + c) = o; } } }
    }
}

__device__ __forceinline__ void item_kv(const Frame& F_, int layer, int item) { Frame F = relocal(F_);
    const bf16_t* U = (const bf16_t*)(F.ws + WS_U);
    LAS bf16_t* Ab = (LAS bf16_t*)F.lds;
    LAS bf16_t* Bt = (LAS bf16_t*)(F.lds + 17408);
    const int t0 = item * 64;
    { const int tok = F.tid >> 3, part = F.tid & 7; const bf16_t* src = U + (size_t)(t0 + tok) * NINP + UC + 256 + 16 * part;
      float f[16]; { float a[8], b[8]; unpack8(*(const u32x4*)src, a); unpack8(*(const u32x4*)(src + 8), b);
#pragma unroll
        for (int j = 0; j < 8; ++j) { f[j] = a[j]; f[8 + j] = b[j]; } }
      float ss = 0.f;
#pragma unroll
      for (int j = 0; j < 16; ++j) ss += f[j] * f[j];
      ss = sum8(ss);
      const float rstd = rsqrtf(ss * (1.0f / 128.0f) + 1e-6f); const float* nw = F.in[I_CKVN] + layer * 128 + 16 * part;
#pragma unroll
      for (int j = 0; j < 16; j += 2) *(LAS unsigned*)(Ab + tok * 136 + 16 * part + j) = pk2(f[j] * rstd * nw[j], f[j + 1] * rstd * nw[j + 1]); }
    { const int n = F.tid >> 2, kq = F.tid & 3; const float* w = (n < 64 ? F.in[I_CWUK] : F.in[I_CWUV]) + (size_t)layer * 128 * 64 + (n & 63);
      float wv[32];
#pragma unroll
      for (int k = 0; k < 32; ++k) wv[k] = w[(size_t)(32 * kq + k) * 64];
#pragma unroll
      for (int k = 0; k < 32; k += 2) *(LAS unsigned*)(Bt + n * 136 + 32 * kq + k) = pk2(wv[k], wv[k + 1]); }
    if (F.tid < 256) { const int tok = F.tid >> 2, q = F.tid & 3;
        *(u32x4*)((bf16_t*)(F.ws + WS_KIDX) + (size_t)(t0 + tok) * 32 + 8 * q) = *(const u32x4*)(U + (size_t)(t0 + tok) * NINP + UC + 640 + 8 * q); }
    __syncthreads();
    const int mt = F.wave & 3, g = F.lane >> 4, r = F.lane & 15;
#pragma unroll
    for (int q = 0; q < 4; ++q) { const int nt = (F.wave >> 2) * 4 + q;
        f32x4 acc = (f32x4){0.f, 0.f, 0.f, 0.f};
        acc = mma_nt<128>(Ab + mt * 16 * 136, 136, Bt + nt * 16 * 136, 136, acc, F.lane);
        const int n = nt * 16 + r; bf16_t* dst = (bf16_t*)(F.ws + (n < 64 ? WS_K : WS_V));
#pragma unroll
        for (int i = 0; i < 4; ++i) dst[(size_t)(t0 + mt * 16 + 4 * g + i) * 64 + (n & 63)] = f2bf(acc[i]); }
}

constexpr int MB_CG = 0, MB_BG = 18432, MB_XT = 36864, MB_BT = 73728, MB_M = 73728, MB_S0 = 110592, MB_DT = 147456, MB_AC = 148480, MB_RS = 149504;
static_assert(MB_RS + 256 <= MISC_OFF && MB_BT == MB_XT + 4 * 64 * 72 * 2, "mamba LDS");
template <int STAGE> __device__ __forceinline__ void item_mamba(const Frame& F_, int layer, int item) { Frame F = relocal(F_);
    const bf16_t* U = (const bf16_t*)(F.ws + WS_U);
    const int b = item >> 6, c = item & 63, l0 = c * 64; const size_t T0 = (size_t)b * SEQ + l0;
    LAS bf16_t* Cg = (LAS bf16_t*)(F.lds + MB_CG); LAS bf16_t* Bg = (LAS bf16_t*)(F.lds + MB_BG); LAS bf16_t* BT = (LAS bf16_t*)(F.lds + MB_BT);
    LAS bf16_t* XT = (LAS bf16_t*)(F.lds + MB_XT); LAS bf16_t* Mb = (LAS bf16_t*)(F.lds + MB_M); LAS bf16_t* S0 = (LAS bf16_t*)(F.lds + MB_S0);
    LAS float* dts = (LAS float*)(F.lds + MB_DT); LAS float* acs = (LAS float*)(F.lds + MB_AC); LAS float* rs = (LAS float*)(F.lds + MB_RS);
    const int tg = F.tid & 7, c0 = (F.tid >> 3) * 8;
    const bool conv_on = (STAGE == 2) || (F.wave < 6);
    u32x4 rows[11]; float wv[4][8], bv[8];
    if (conv_on) {
#pragma unroll
        for (int k = 0; k < 11; ++k) { const int l = l0 + tg * 8 - 3 + k;
            if (l >= 0) rows[k] = *(const u32x4*)(U + ((size_t)b * SEQ + l) * NINP + UM + 256 + c0); else rows[k] = (u32x4){0u, 0u, 0u, 0u}; }
#pragma unroll
        for (int j = 0; j < 8; ++j) { bv[j] = F.in[I_MCONVB][layer * 512 + c0 + j];
#pragma unroll
            for (int k = 0; k < 4; ++k) wv[k][j] = F.in[I_MCONVW][(layer * 4 + k) * 512 + c0 + j]; } }
    const float* MSTi = (const float*)(F.ws + WS_MST) + ((size_t)(b * 64 + c) * 4) * 4096;
    f32x4 s0a[4], s0b[4];
    if (STAGE == 2) {
#pragma unroll
        for (int h = 0; h < 4; ++h) { const float* src = MSTi + (size_t)h * 4096 + F.tid * 8; s0a[h] = *(const f32x4*)src; s0b[h] = *(const f32x4*)(src + 4); } }
    if (F.wave < 4) { const int l = F.lane, h = F.wave;
        const float raw = bf2f(U[(T0 + l) * NINP + UM + 768 + h]) + F.in[I_MDTB][layer * 4 + h];
        const float dt = softplusf_(raw); float cum = -__expf(F.in[I_MALOG][layer * 4 + h]) * dt;
#pragma unroll
        for (int o = 1; o < 64; o <<= 1) { const float t = __int_as_float(__builtin_amdgcn_ds_bpermute(((lane_id_() - o) & 63) << 2, __float_as_int(cum))); if (l >= o) cum += t; }
        dts[l * 4 + h] = dt; acs[l * 4 + h] = cum; }
    if (STAGE == 2) { if (F.tid < 64) rs[F.tid] = 0.f;
#pragma unroll
        for (int h = 0; h < 4; ++h) { u32x4 w; w.x = pk2(s0a[h][0], s0a[h][1]); w.y = pk2(s0a[h][2], s0a[h][3]); w.z = pk2(s0b[h][0], s0b[h][1]); w.w = pk2(s0b[h][2], s0b[h][3]);
            *(LAS u32x4*)(S0 + (h * 64 + (F.tid >> 3)) * 72 + (F.tid & 7) * 8) = w; } }
    __syncthreads();
    if (conv_on) {
        float win[3][8]; unpack8(rows[0], win[0]); unpack8(rows[1], win[1]); unpack8(rows[2], win[2]);
        const bool isx = F.wave < 4, tr = isx || STAGE == 1;
        unsigned pkT[8][4]; float prev[8];
#pragma unroll
        for (int i = 0; i < 8; ++i) { const int l = tg * 8 + i; float cur[8]; unpack8(rows[3 + i], cur);
            float o[8];
#pragma unroll
            for (int j = 0; j < 8; ++j) { o[j] = siluf_(bv[j] + wv[0][j] * win[0][j] + wv[1][j] * win[1][j] + wv[2][j] * win[2][j] + wv[3][j] * cur[j]);
                win[0][j] = win[1][j]; win[1][j] = win[2][j]; win[2][j] = cur[j]; }
            if (isx) { const int h = F.wave; float sc = dts[l * 4 + h]; if (STAGE == 1) sc *= __expf(acs[63 * 4 + h] - acs[l * 4 + h]);
#pragma unroll
                for (int j = 0; j < 8; ++j) o[j] *= sc; }
            if (tr) {
#pragma unroll
                for (int j = 0; j < 8; ++j) { if (i & 1) pkT[j][i >> 1] = pk2(prev[j], o[j]); else prev[j] = o[j]; } }
            else { u32x4 w; w.x = pk2(o[0], o[1]); w.y = pk2(o[2], o[3]); w.z = pk2(o[4], o[5]); w.w = pk2(o[6], o[7]);
                *(LAS u32x4*)(Cg + (F.wave < 6 ? (MB_BG - MB_CG) / 2 : 0) + ((F.wave & 1) * 64 + l) * 72 + (c0 & 63)) = w; } }
        if (tr) { LAS bf16_t* dstT = XT + F.wave * 64 * 72;
#pragma unroll
            for (int j = 0; j < 8; ++j) *(LAS u32x4*)(dstT + ((c0 & 63) + j) * 72 + tg * 8) = (u32x4){pkT[j][0], pkT[j][1], pkT[j][2], pkT[j][3]}; } }
    const int g4 = F.lane >> 4, r16 = F.lane & 15;
    if (STAGE == 1) {
        __syncthreads();
        float* MST = (float*)(F.ws + WS_MST) + ((size_t)(b * 64 + c) * 4) * 4096;
#pragma unroll
        for (int q = 0; q < 8; ++q) { const int tix = F.wave * 8 + q, h = tix >> 4, mt = (tix >> 2) & 3, nt = tix & 3;
            f32x4 acc = (f32x4){0.f, 0.f, 0.f, 0.f};
            acc = mma_nt<64>(XT + (h * 64 + mt * 16) * 72, 72, BT + ((h >> 1) * 64 + nt * 16) * 72, 72, acc, F.lane);
#pragma unroll
            for (int i = 0; i < 4; ++i) MST[(size_t)h * 4096 + (mt * 16 + 4 * g4 + i) * 64 + nt * 16 + r16] = acc[i]; }
        if (F.tid < 4) ((float*)(F.ws + WS_MDEC))[(b * 64 + c) * 4 + F.tid] = __expf(acs[63 * 4 + F.tid]);
    } else {
        const int mt = F.wave & 3, nh = F.wave >> 2;
        bf16_t zz[4][2][4];
#pragma unroll
        for (int h = 0; h < 4; ++h)
#pragma unroll
            for (int q = 0; q < 2; ++q)
#pragma unroll
                for (int i = 0; i < 4; ++i) zz[h][q][i] = U[(T0 + mt * 16 + 4 * g4 + i) * NINP + UM + h * 64 + (2 * nh + q) * 16 + r16];
        __syncthreads();
        f32x4 yv[4][2];
#pragma unroll
        for (int g = 0; g < 2; ++g)
#pragma unroll
            for (int q = 0; q < 2; ++q) { f32x4 G = (f32x4){0.f, 0.f, 0.f, 0.f};
                G = mma_nt<64>(Cg + (g * 64 + mt * 16) * 72, 72, Bg + (g * 64 + (2 * nh + q) * 16) * 72, 72, G, F.lane);
                const int s = (2 * nh + q) * 16 + r16;
#pragma unroll
                for (int hh = 0; hh < 2; ++hh) { const int h = 2 * g + hh; const float as = acs[s * 4 + h];
#pragma unroll
                    for (int i = 0; i < 4; ++i) { const int l = mt * 16 + 4 * g4 + i; const float v = (s <= l) ? G[i] * __expf(acs[l * 4 + h] - as) : 0.f;
                        Mb[(h * 64 + l) * 72 + s] = f2bf(v); } } }
        __syncthreads();
#pragma unroll
        for (int h = 0; h < 4; ++h) { const int g = h >> 1;
#pragma unroll
            for (int q = 0; q < 2; ++q) { const int nt = 2 * nh + q;
                f32x4 yd = (f32x4){0.f, 0.f, 0.f, 0.f}, yo = (f32x4){0.f, 0.f, 0.f, 0.f};
                yd = mma_nt<64>(Mb + (h * 64 + mt * 16) * 72, 72, XT + (h * 64 + nt * 16) * 72, 72, yd, F.lane);
                yo = mma_nt<64>(Cg + (g * 64 + mt * 16) * 72, 72, S0 + (h * 64 + nt * 16) * 72, 72, yo, F.lane);
                const int p = nt * 16 + r16; const float dsk = F.in[I_MD][layer * 4 + h];
#pragma unroll
                for (int i = 0; i < 4; ++i) { const int l = mt * 16 + 4 * g4 + i;
                    const float xs = bf2f(XT[(h * 64 + p) * 72 + l]) / dts[l * 4 + h];
                    yv[h][q][i] = yd[i] + yo[i] * __expf(acs[l * 4 + h]) + dsk * xs; } } }
        float part[4] = {0.f, 0.f, 0.f, 0.f};
#pragma unroll
        for (int h = 0; h < 4; ++h)
#pragma unroll
            for (int q = 0; q < 2; ++q) {
#pragma unroll
                for (int i = 0; i < 4; ++i) { const float z = bf2f(zz[h][q][i]);
                    const float v = yv[h][q][i] * siluf_(z); yv[h][q][i] = v; part[i] += v * v; } }
#pragma unroll
        for (int i = 0; i < 4; ++i) { const float s = sum16(part[i]); if (r16 == 0) atomicAdd((float*)(rs + mt * 16 + 4 * g4 + i), s); }
        __syncthreads();
        bf16_t* Y = (bf16_t*)(F.ws + WS_H);
#pragma unroll
        for (int i = 0; i < 4; ++i) { const int l = mt * 16 + 4 * g4 + i; const float rstd = rsqrtf(rs[l] * (1.0f / 256.0f) + 1e-6f);
#pragma unroll
            for (int h = 0; h < 4; ++h)
#pragma unroll
                for (int q = 0; q < 2; ++q) { const int ch = h * 64 + (2 * nh + q) * 16 + r16;
                    Y[(T0 + l) * DM + ch] = f2bf(yv[h][q][i] * rstd * F.in[I_MNORM][layer * 256 + ch]); } }
    }
}
__device__ __forceinline__ void item_mamba_carry(const Frame& F_, int item) { Frame F = relocal(F_);
    const int b = item >> 2, h = item & 3;
    float* MST = (float*)(F.ws + WS_MST); const float* MD = (const float*)(F.ws + WS_MDEC);
    float s[8];
#pragma unroll
    for (int j = 0; j < 8; ++j) s[j] = 0.f;
    for (int c = 0; c < 64; ++c) { float* p = MST + ((size_t)(b * 64 + c) * 4 + h) * 4096 + F.tid * 8; const float d = MD[(b * 64 + c) * 4 + h];
        const f32x4 a = *(f32x4*)p, q = *(f32x4*)(p + 4);
        *(f32x4*)p = (f32x4){s[0], s[1], s[2], s[3]}; *(f32x4*)(p + 4) = (f32x4){s[4], s[5], s[6], s[7]};
        s[0] = s[0] * d + a[0]; s[1] = s[1] * d + a[1]; s[2] = s[2] * d + a[2]; s[3] = s[3] * d + a[3];
        s[4] = s[4] * d + q[0]; s[5] = s[5] * d + q[1]; s[6] = s[6] * d + q[2]; s[7] = s[7] * d + q[3]; }
}

template <int STAGE> __device__ __forceinline__ void item_s5(const Frame& F_, int layer, int item) { Frame F = relocal(F_);
    const bf16_t* U = (const bf16_t*)(F.ws + WS_U);
    const int b = item >> 6, c = item & 63; const size_t T0 = (size_t)b * SEQ + c * 64;
    LAS bf16_t* us = (LAS bf16_t*)F.lds;
    LAS bf16_t* BuW = (LAS bf16_t*)(F.lds + 33792) + F.wave * 4224;
    const float* tab = (const float*)(F.ws + WS_S5TAB + (size_t)layer * S5TAB_L);
    { const int tok = F.tid >> 3, part = F.tid & 7;
#pragma unroll
      for (int q = 0; q < 4; ++q) *(LAS u32x4*)(us + tok * 264 + 32 * part + 8 * q) = *(const u32x4*)(U + (T0 + tok) * NINP + US + 32 * part + 8 * q); }
    const int lane = F.lane, r16 = lane & 15, g4 = lane >> 4, gq = lane >> 5, n0 = lane & 31, g = 2 * F.wave + gq, gn0 = g * 64 + n0, gn1 = gn0 + 32;
    bf16x8 bfr[2][8];
    { const bf16_t* bbt = (const bf16_t*)(F.ws + WS_S5TAB + (size_t)layer * S5TAB_L + S5TAB_BBT);
#pragma unroll
      for (int gg = 0; gg < 2; ++gg)
#pragma unroll
          for (int nt = 0; nt < 8; ++nt) { u32x4 z = (u32x4){0u, 0u, 0u, 0u}; if (g4 < 2) z = *(const u32x4*)(bbt + ((size_t)(2 * F.wave + gg) * 128 + 16 * nt + r16) * 16 + 8 * g4); bfr[gg][nt] = __builtin_bit_cast(bf16x8, z); } }
    const float a0r = tab[gn0 * 2], a0i = tab[gn0 * 2 + 1], a1r = tab[gn1 * 2], a1i = tab[gn1 * 2 + 1];
    float* ST = (float*)(F.ws + WS_S5ST) + (size_t)(b * 64 + c) * 2048;
    float h0r = 0.f, h0i = 0.f, h1r = 0.f, h1i = 0.f;
    if (STAGE == 2) { h0r = ST[gn0 * 2]; h0i = ST[gn0 * 2 + 1]; h1r = ST[gn1 * 2]; h1i = ST[gn1 * 2 + 1]; }
    bf16x8 cf[2][4];
    if (STAGE == 2) { const bf16_t* cm = (const bf16_t*)(F.ws + WS_S5TAB + (size_t)layer * S5TAB_L + S5TAB_F);
#pragma unroll
        for (int gg = 0; gg < 2; ++gg)
#pragma unroll
            for (int ks = 0; ks < 4; ++ks) cf[gg][ks] = *(const bf16x8*)(cm + ((size_t)((2 * F.wave + gg) * 16 + r16)) * 128 + 32 * ks + 8 * g4); }
    LAS bf16_t* YSl = (LAS bf16_t*)(F.lds + 101376);
    const bf16_t* GW = (const bf16_t*)(F.ws + WS_GLU) + (size_t)layer * 512 * 256;
    float dsk[2] = {0.f, 0.f}, bvl[2] = {0.f, 0.f}, bgt[2] = {0.f, 0.f}; bf16x8 gwb[2][4];
    if (STAGE == 2) {
#pragma unroll
        for (int gg = 0; gg < 2; ++gg) dsk[gg] = F.in[I_SD][layer * 256 + (2 * F.wave + gg) * 16 + r16];
#pragma unroll
        for (int q = 0; q < 2; ++q) { const int c = 32 * F.wave + 16 * q + r16; bvl[q] = F.in[I_SGLUB][layer * 512 + c]; bgt[q] = F.in[I_SGLUB][layer * 512 + 256 + c]; }
#pragma unroll
        for (int ks = 0; ks < 2; ++ks)
#pragma unroll
            for (int q = 0; q < 2; ++q) { const int c = 32 * F.wave + 16 * q + r16; const int rowv = 256 * (c >> 7) + (c & 127);
                gwb[ks][2 * q] = *(const bf16x8*)(GW + (size_t)rowv * 256 + 32 * ks + 8 * g4); gwb[ks][2 * q + 1] = *(const bf16x8*)(GW + (size_t)(rowv + 128) * 256 + 32 * ks + 8 * g4); } }
    __syncthreads();
#pragma unroll 1
    for (int lb = 0; lb < 4; ++lb) {
#pragma unroll
        for (int gg = 0; gg < 2; ++gg) { u32x4 z = (u32x4){0u, 0u, 0u, 0u}; if (g4 < 2) z = *(const LAS u32x4*)(us + (16 * lb + r16) * 264 + (2 * F.wave + gg) * 16 + 8 * g4);
            const bf16x8 afr = __builtin_bit_cast(bf16x8, z);
#pragma unroll
            for (int nt = 0; nt < 8; ++nt) { const f32x4 acc = __builtin_amdgcn_mfma_f32_16x16x32_bf16(afr, bfr[gg][nt], (f32x4){0.f, 0.f, 0.f, 0.f}, 0, 0, 0);
#pragma unroll
                for (int i = 0; i < 4; ++i) BuW[(4 * g4 + i) * 264 + gg * 128 + 16 * nt + r16] = f2bf(acc[i]); } }
        __syncthreads();
#pragma unroll 4
        for (int li = 0; li < 16; ++li) { LAS u32x2* bp = (LAS u32x2*)(BuW + li * 264 + gq * 128 + 4 * n0); const u32x2 v = *bp;
            { const float br = __uint_as_float(v.x << 16), bi = __uint_as_float(v.x & 0xffff0000u); const float nr = a0r * h0r - a0i * h0i + br, ni = a0r * h0i + a0i * h0r + bi; h0r = nr; h0i = ni; }
            { const float br = __uint_as_float(v.y << 16), bi = __uint_as_float(v.y & 0xffff0000u); const float nr = a1r * h1r - a1i * h1i + br, ni = a1r * h1i + a1i * h1r + bi; h1r = nr; h1i = ni; }
            if (STAGE == 2) *bp = (u32x2){pk2(h0r, h0i), pk2(h1r, h1i)}; }
        __syncthreads();
        if (STAGE == 2) {
#pragma unroll
            for (int gg = 0; gg < 2; ++gg) { f32x4 acc = (f32x4){0.f, 0.f, 0.f, 0.f};
#pragma unroll
                for (int ks = 0; ks < 4; ++ks) { const bf16x8 a = *(const LAS bf16x8*)(BuW + r16 * 264 + gg * 128 + 32 * ks + 8 * g4);
                    acc = __builtin_amdgcn_mfma_f32_16x16x32_bf16(a, cf[gg][ks], acc, 0, 0, 0); }
                const int ch = (2 * F.wave + gg) * 16 + r16;
#pragma unroll
                for (int i = 0; i < 4; ++i) { const int l = lb * 16 + 4 * g4 + i; const float y = acc[i] + dsk[gg] * bf2f(us[l * 264 + ch]);
                    YSl[l * 264 + ch] = f2bf(gelu_tanh(y)); } }
            __syncthreads();
        }
    }
    if (STAGE == 1) { ST[gn0 * 2] = h0r; ST[gn0 * 2 + 1] = h0i; ST[gn1 * 2] = h1r; ST[gn1 * 2 + 1] = h1i; }
    if (STAGE == 2) {
        f32x4 av[4][2], ag[4][2];
#pragma unroll
        for (int m = 0; m < 4; ++m)
#pragma unroll
            for (int q = 0; q < 2; ++q) { av[m][q] = (f32x4){0.f, 0.f, 0.f, 0.f}; ag[m][q] = (f32x4){0.f, 0.f, 0.f, 0.f}; }
#pragma unroll
        for (int ks = 0; ks < 8; ++ks) {
            bf16x8 af[4], bcur[4];
#pragma unroll
            for (int j = 0; j < 4; ++j) bcur[j] = gwb[ks & 1][j];
            if (ks + 2 < 8) {
#pragma unroll
                for (int q = 0; q < 2; ++q) { const int c = 32 * F.wave + 16 * q + r16; const int rowv = 256 * (c >> 7) + (c & 127);
                    gwb[ks & 1][2 * q] = *(const bf16x8*)(GW + (size_t)rowv * 256 + 32 * (ks + 2) + 8 * g4); gwb[ks & 1][2 * q + 1] = *(const bf16x8*)(GW + (size_t)(rowv + 128) * 256 + 32 * (ks + 2) + 8 * g4); } }
#pragma unroll
            for (int m = 0; m < 4; ++m) af[m] = *(const LAS bf16x8*)(YSl + (16 * m + r16) * 264 + 32 * ks + 8 * g4);
#pragma unroll
            for (int m = 0; m < 4; ++m)
#pragma unroll
                for (int q = 0; q < 2; ++q) { av[m][q] = __builtin_amdgcn_mfma_f32_16x16x32_bf16(af[m], bcur[2 * q], av[m][q], 0, 0, 0); ag[m][q] = __builtin_amdgcn_mfma_f32_16x16x32_bf16(af[m], bcur[2 * q + 1], ag[m][q], 0, 0, 0); }
        }
        bf16_t* Y = (bf16_t*)(F.ws + WS_H);
#pragma unroll
        for (int q = 0; q < 2; ++q) { const int c = 32 * F.wave + 16 * q + r16;
#pragma unroll
            for (int m = 0; m < 4; ++m)
#pragma unroll
                for (int i = 0; i < 4; ++i) Y[(T0 + 16 * m + 4 * g4 + i) * DM + 768 + c] = f2bf((av[m][q][i] + bvl[q]) * sigmoidf_(ag[m][q][i] + bgt[q])); }
    }
}
__device__ __forceinline__ void item_s5_carry(const Frame& F_, int layer, int b) { Frame F = relocal(F_);
    const float* tab = (const float*)(F.ws + WS_S5TAB + (size_t)layer * S5TAB_L) + 2048;
    float* ST = (float*)(F.ws + WS_S5ST) + (size_t)b * 64 * 2048;
#pragma unroll
    for (int q = 0; q < 2; ++q) { const int gn = F.tid + 512 * q; const float pr = tab[gn * 2], pi = tab[gn * 2 + 1]; float hr = 0.f, hi = 0.f;
        for (int c = 0; c < 64; ++c) { float* p = ST + (size_t)c * 2048 + gn * 2; const float tr = p[0], ti = p[1]; p[0] = hr; p[1] = hi;
            const float nr = pr * hr - pi * hi + tr, ni = pr * hi + pi * hr + ti; hr = nr; hi = ni; } }
}

constexpr int RB_LD = 72;
constexpr int RW_R = 0, RW_K = 16384, RW_V = 32768, RW_W = 49152, RW_A = 65536, RW_B = 81920;
constexpr int R3_G = 49152, R3_O = 65536, R3_TILES = 81920, R3_BON = 147456;
template <int STAGE> __device__ __forceinline__ void rwkv_prep(const Frame& F_, int layer, int b, int h, int c) { Frame F = relocal(F_);
    const bf16_t* U = (const bf16_t*)(F.ws + WS_U);
    const int l0 = c * 64; const size_t T0 = (size_t)b * SEQ + l0;
    LAS float* Rr = (LAS float*)(F.lds + RW_R); LAS float* Kk = (LAS float*)(F.lds + RW_K); LAS float* Vv = (LAS float*)(F.lds + RW_V); LAS float* Ww = (LAS float*)(F.lds + RW_W);
    LAS float* Aa = (LAS float*)(F.lds + (STAGE == 1 ? RW_A : R3_O)); LAS float* Bb = (LAS float*)(F.lds + RW_B); LAS float* Gg = (LAS float*)(F.lds + R3_G); LAS float* BON = (LAS float*)(F.lds + R3_BON);
    LAS bf16_t* TWb = (LAS bf16_t*)(F.lds + 98304); LAS bf16_t* DAb = (LAS bf16_t*)(F.lds + (STAGE == 1 ? 103424 : 118784)); LAS bf16_t* SGb = (LAS bf16_t*)(F.lds + 123904);
    LAS bf16_t* w2T = (LAS bf16_t*)(F.lds + 108544); LAS bf16_t* a2T = (LAS bf16_t*)(F.lds + (STAGE == 1 ? 113664 : 133120)); LAS bf16_t* g2T = (LAS bf16_t*)(F.lds + 138240);
    const float* mu = F.in[I_RMU] + layer * 896;
    { const int tok = F.tid >> 3, p8 = F.tid & 7; const bool first = (l0 + tok == 0);
      const bf16_t* cur = U + (T0 + tok) * NINP + UR; const bf16_t* prv = first ? cur : cur - NINP;
      const float pz = first ? 0.f : 1.f;
      u32x4 cw[3], pw[3]; u32x2 c1 = (u32x2){0u, 0u}, p1 = (u32x2){0u, 0u}, c2 = (u32x2){0u, 0u}, p2 = (u32x2){0u, 0u}; u32x4 c3 = (u32x4){0u, 0u, 0u, 0u}, p3 = (u32x4){0u, 0u, 0u, 0u};
#pragma unroll
      for (int sec = (STAGE == 1 ? 0 : 2); sec < 3; ++sec) { const int co = sec * 256 + h * 64 + 8 * p8; cw[sec] = *(const u32x4*)(cur + co); pw[sec] = *(const u32x4*)(prv + co); }
      if (STAGE == 1) { c1 = *(const u32x2*)(cur + 768 + 4 * p8); p1 = *(const u32x2*)(prv + 768 + 4 * p8); c2 = *(const u32x2*)(cur + 800 + 4 * p8); p2 = *(const u32x2*)(prv + 800 + 4 * p8); }
      if (STAGE == 3) { c3 = *(const u32x4*)(cur + 832 + 8 * p8); p3 = *(const u32x4*)(prv + 832 + 8 * p8); }
#pragma unroll
      for (int sec = (STAGE == 1 ? 0 : 2); sec < 3; ++sec) { const int co = sec * 256 + h * 64 + 8 * p8; float av[8], pq[8]; unpack8(cw[sec], av); unpack8(pw[sec], pq);
          const f32x4 m0 = *(const f32x4*)(mu + co), m1 = *(const f32x4*)(mu + co + 4);
          LAS float* dst = (sec == 0 ? Rr : sec == 1 ? Kk : Vv) + tok * 64 + 8 * p8;
#pragma unroll
          for (int j = 0; j < 8; ++j) pq[j] *= pz;
          *(LAS f32x4*)dst = (f32x4){av[0] + m0[0] * (pq[0] - av[0]), av[1] + m0[1] * (pq[1] - av[1]), av[2] + m0[2] * (pq[2] - av[2]), av[3] + m0[3] * (pq[3] - av[3])};
          *(LAS f32x4*)(dst + 4) = (f32x4){av[4] + m1[0] * (pq[4] - av[4]), av[5] + m1[1] * (pq[5] - av[5]), av[6] + m1[2] * (pq[6] - av[6]), av[7] + m1[3] * (pq[7] - av[7])}; }
      if (STAGE == 1) {
#pragma unroll
        for (int which = 0; which < 2; ++which) { const int co = 768 + 32 * which + 4 * p8; const u32x2 cv = which ? c2 : c1, pv = which ? p2 : p1;
          const f32x4 m0 = *(const f32x4*)(mu + co);
          float x[4] = {__uint_as_float(cv.x << 16), __uint_as_float(cv.x & 0xffff0000u), __uint_as_float(cv.y << 16), __uint_as_float(cv.y & 0xffff0000u)};
          const float y[4] = {pz * __uint_as_float(pv.x << 16), pz * __uint_as_float(pv.x & 0xffff0000u), pz * __uint_as_float(pv.y << 16), pz * __uint_as_float(pv.y & 0xffff0000u)};
#pragma unroll
          for (int j = 0; j < 4; ++j) { x[j] = x[j] + m0[j] * (y[j] - x[j]); if (which == 0) x[j] = tanhf_(x[j]); }
          *(LAS u32x2*)((which ? DAb : TWb) + tok * 40 + 4 * p8) = (u32x2){pk2(x[0], x[1]), pk2(x[2], x[3])}; } }
      if (STAGE == 3) { const int co = 832 + 8 * p8; float av[8], pq[8]; unpack8(c3, av); unpack8(p3, pq);
          const f32x4 m0 = *(const f32x4*)(mu + co), m1 = *(const f32x4*)(mu + co + 4); float x[8];
#pragma unroll
          for (int j = 0; j < 8; ++j) x[j] = sigmoidf_(av[j] + (j < 4 ? m0[j] : m1[j - 4]) * (pz * pq[j] - av[j]));
          *(LAS u32x4*)(SGb + tok * RB_LD + 8 * p8) = (u32x4){pk2(x[0], x[1]), pk2(x[2], x[3]), pk2(x[4], x[5]), pk2(x[6], x[7])}; } }
    { const int ch = F.tid & 63, part = F.tid >> 6;
      if (STAGE == 1) { const float* w2 = F.in[I_RW2] + ((size_t)layer * 32 + 4 * part) * 256 + h * 64 + ch;
          *(LAS u32x2*)(w2T + ch * 40 + 4 * part) = (u32x2){pk2(w2[0], w2[256]), pk2(w2[512], w2[768])}; }
      if (STAGE == 1) { const float* a2 = F.in[I_RA2] + ((size_t)layer * 32 + 4 * part) * 256 + h * 64 + ch;
          *(LAS u32x2*)(a2T + ch * 40 + 4 * part) = (u32x2){pk2(a2[0], a2[256]), pk2(a2[512], a2[768])}; }
      if (STAGE == 3) { const float* g2 = F.in[I_RG2] + ((size_t)layer * 64 + 8 * part) * 256 + h * 64 + ch;
          *(LAS u32x4*)(g2T + ch * RB_LD + 8 * part) = (u32x4){pk2(g2[0], g2[256]), pk2(g2[512], g2[768]), pk2(g2[1024], g2[1280]), pk2(g2[1536], g2[1792])}; } }
    __syncthreads();
    { const int lane = F.lane, mt = F.wave >> 1, nt0 = 2 * (F.wave & 1), r = lane & 15, g4 = lane >> 4; const f32x4 zero4 = (f32x4){0.f, 0.f, 0.f, 0.f};
#pragma unroll
      for (int q = 0; q < 2; ++q) { const int nt = nt0 + q, ch = 16 * nt + r, cg = layer * 256 + h * 64 + ch;
          if (STAGE == 1) { const f32x4 wl = mma_nt<32>(TWb + 16 * mt * 40, 40, w2T + 16 * nt * 40, 40, zero4, lane); const float w0 = F.in[I_RW0][cg];
#pragma unroll
              for (int i = 0; i < 4; ++i) { const float x = w0 + wl[i]; const float wlog = -__logf(1.0f + __expf(-x)) - 0.5f; Ww[(16 * mt + 4 * g4 + i) * 64 + ch] = __expf(-__expf(wlog)); } }
          if (STAGE == 1) { const f32x4 al = mma_nt<32>(DAb + 16 * mt * 40, 40, a2T + 16 * nt * 40, 40, zero4, lane); const float a0 = F.in[I_RA0][cg];
#pragma unroll
              for (int i = 0; i < 4; ++i) Aa[(16 * mt + 4 * g4 + i) * 64 + ch] = sigmoidf_(a0 + al[i]); }
          if (STAGE == 3) { const f32x4 gv = mma_nt<64>(SGb + 16 * mt * RB_LD, RB_LD, g2T + 16 * nt * RB_LD, RB_LD, zero4, lane);
#pragma unroll
              for (int i = 0; i < 4; ++i) Gg[(16 * mt + 4 * g4 + i) * 64 + ch] = gv[i]; } } }
    __syncthreads();
    float* gBON = (float*)(F.ws + WS_BON) + ((size_t)(b * 4 + h) * 64 + c) * 64;
    if (STAGE == 1) { const int j = F.lane, tq = F.wave, cg = layer * 256 + h * 64 + j;
      const float kkw = F.in[I_RKK][cg], kaw = F.in[I_RKA][cg], rk = F.in[I_RRK][cg];
#pragma unroll 2
      for (int i8 = 0; i8 < 8; ++i8) { const int t = tq + 8 * i8;
          const float a = Aa[t * 64 + j]; const float kraw = Kk[t * 64 + j]; const float kp = kraw * (1.0f + (a - 1.0f) * kaw);
          Kk[t * 64 + j] = kp;
          const float kkv = kraw * kkw; const float ss = wave_sum(kkv * kkv); const float kkn = kkv * rsqrtf(fmaxf(ss, 1e-24f)); Aa[t * 64 + j] = -kkn; Bb[t * 64 + j] = kkn * a;
          const float bo = wave_sum(Rr[t * 64 + j] * kp * rk); if (j == 0) gBON[t] = bo; } }
    else if (F.tid < 64) BON[F.tid] = gBON[F.tid];
    __syncthreads();
}
constexpr int RB_AT = 98304, RB_ATT = RB_AT + 9216, RB_BT = RB_ATT + 9216, RB_BTT = RB_BT + 9216, RB_KT = RB_BTT + 9216, RB_RT = RB_KT + 9216, RB_VT = RB_RT + 9216, RB_GC = RB_VT + 9216;
constexpr int RX_X = 0, RX_XT = 9216, RX_TB = 18432, RX_M = 27648, RX_NRT = 36864, RX_G1T = 46080, RX_G2T = 55296, RX_QT = 64512;
__device__ __forceinline__ void st_tile(LAS bf16_t* dst, int mt, int nt, const f32x4 v, int lane) {
    const int r = lane & 15, g = lane >> 4;
#pragma unroll
    for (int i = 0; i < 4; ++i) dst[(16 * mt + 4 * g + i) * RB_LD + 16 * nt + r] = f2bf(v[i]);
}
__device__ __forceinline__ void st_tile_t(LAS bf16_t* dst, int mt, int nt, const f32x4 v, int lane) {
    const int r = lane & 15, g = lane >> 4; u32x2 w; w.x = pk2(v[0], v[1]); w.y = pk2(v[2], v[3]);
    *(LAS u32x2*)(dst + (16 * nt + r) * RB_LD + 16 * mt + 4 * g) = w;
}
__device__ __forceinline__ void item_rwkv1(const Frame& F_, int layer, int item) { Frame F = relocal(F_);
    const int b = item >> 8, h = (item >> 6) & 3, c = item & 63;
    rwkv_prep<1>(F, layer, b, h, c);
    LAS float* Rr = (LAS float*)(F.lds + RW_R); LAS float* Kk = (LAS float*)(F.lds + RW_K); LAS float* Vv = (LAS float*)(F.lds + RW_V); LAS float* Ww = (LAS float*)(F.lds + RW_W);
    LAS float* Aa = (LAS float*)(F.lds + RW_A); LAS float* Bb = (LAS float*)(F.lds + RW_B);
    LAS bf16_t* At = (LAS bf16_t*)(F.lds + RB_AT); LAS bf16_t* AtT = (LAS bf16_t*)(F.lds + RB_ATT); LAS bf16_t* Bt = (LAS bf16_t*)(F.lds + RB_BT); LAS bf16_t* BtT = (LAS bf16_t*)(F.lds + RB_BTT);
    LAS bf16_t* Kt = (LAS bf16_t*)(F.lds + RB_KT); LAS bf16_t* Rt = (LAS bf16_t*)(F.lds + RB_RT); LAS bf16_t* VT = (LAS bf16_t*)(F.lds + RB_VT); LAS float* gC = (LAS float*)(F.lds + RB_GC);
    LAS bf16_t* X = (LAS bf16_t*)(F.lds + RX_X); LAS bf16_t* XT = (LAS bf16_t*)(F.lds + RX_XT); LAS bf16_t* Tb = (LAS bf16_t*)(F.lds + RX_TB); LAS bf16_t* Mm = (LAS bf16_t*)(F.lds + RX_M);
    LAS bf16_t* NrT = (LAS bf16_t*)(F.lds + RX_NRT); LAS bf16_t* G1T = (LAS bf16_t*)(F.lds + RX_G1T); LAS bf16_t* G2T = (LAS bf16_t*)(F.lds + RX_G2T); LAS bf16_t* QT = (LAS bf16_t*)(F.lds + RX_QT);
    { const int k = F.tid & 63, part = F.tid >> 6; float g = 1.0f;
      for (int pp = 0; pp < part; ++pp) { float w8[8];
#pragma unroll
          for (int i = 0; i < 8; ++i) w8[i] = Ww[(8 * pp + i) * 64 + k];
          g *= ((w8[0] * w8[1]) * (w8[2] * w8[3])) * ((w8[4] * w8[5]) * (w8[6] * w8[7])); }
#pragma unroll
      for (int i = 0; i < 8; ++i) { const int t = 8 * part + i; const float gp = g; g *= Ww[t * 64 + k]; const float ig = 1.0f / g;
          const bf16_t av = f2bf(Aa[t * 64 + k] * gp), bv = f2bf(Bb[t * 64 + k] * ig);
          At[t * RB_LD + k] = av; AtT[k * RB_LD + t] = av; Bt[t * RB_LD + k] = bv; BtT[k * RB_LD + t] = bv;
          Kt[t * RB_LD + k] = f2bf(Kk[t * 64 + k] * ig); Rt[t * RB_LD + k] = f2bf(Rr[t * 64 + k] * g); VT[k * RB_LD + t] = f2bf(Vv[t * 64 + k]); }
      if (part == 7) gC[k] = g; }
    __syncthreads();
    const int lane = F.lane, mt = F.wave >> 1, nt0 = 2 * (F.wave & 1), r = lane & 15, g4 = lane >> 4;
    const f32x4 zero4 = (f32x4){0.f, 0.f, 0.f, 0.f};
    f32x4 Tacc[2];
#pragma unroll
    for (int q = 0; q < 2; ++q) { const int nt = nt0 + q;
        f32x4 n = mma_nt<64>(Bt + 16 * mt * RB_LD, RB_LD, At + 16 * nt * RB_LD, RB_LD, zero4, lane);
        f32x4 m = mma_nt<64>(Kt + 16 * mt * RB_LD, RB_LD, At + 16 * nt * RB_LD, RB_LD, zero4, lane);
        f32x4 nr = mma_nt<64>(Rt + 16 * mt * RB_LD, RB_LD, Bt + 16 * nt * RB_LD, RB_LD, zero4, lane);
#pragma unroll
        for (int i = 0; i < 4; ++i) { const int row = 16 * mt + 4 * g4 + i, col = 16 * nt + r;
            n[i] = (row < col) ? n[i] : 0.f; m[i] = (row < col) ? m[i] : 0.f; nr[i] = (col <= row) ? nr[i] : 0.f;
            Tacc[q][i] = n[i] + (row == col ? 1.0f : 0.f); }
        st_tile(X, mt, nt, n, lane); st_tile_t(XT, mt, nt, n, lane); st_tile(Tb, mt, nt, Tacc[q], lane); st_tile(Mm, mt, nt, m, lane); st_tile(NrT, mt, nt, nr, lane); }
    __syncthreads();
#pragma unroll 1
    for (int it = 0; it < 6; ++it) {
        LAS bf16_t* Xr = (it & 1) ? G1T : X; LAS bf16_t* XTr = (it & 1) ? G2T : XT; LAS bf16_t* Tr = (it & 1) ? QT : Tb;
        LAS bf16_t* Xw = (it & 1) ? X : G1T; LAS bf16_t* XTw = (it & 1) ? XT : G2T; LAS bf16_t* Tw = (it & 1) ? Tb : QT;
#pragma unroll
        for (int q = 0; q < 2; ++q) { const int nt = nt0 + q;
            if (it > 0) Tacc[q] = mma_nt<64>(Tr + 16 * mt * RB_LD, RB_LD, XTr + 16 * nt * RB_LD, RB_LD, Tacc[q], lane);
            if (it < 5) { const f32x4 x2 = mma_nt<64>(Xr + 16 * mt * RB_LD, RB_LD, XTr + 16 * nt * RB_LD, RB_LD, zero4, lane); st_tile(Xw, mt, nt, x2, lane); st_tile_t(XTw, mt, nt, x2, lane); }
            st_tile(Tw, mt, nt, Tacc[q], lane); }
        __syncthreads();
    }
#pragma unroll
    for (int q = 0; q < 2; ++q) { const int nt = nt0 + q;
        st_tile(G1T, mt, nt, mma_nt<64>(NrT + 16 * mt * RB_LD, RB_LD, Tb + 16 * nt * RB_LD, RB_LD, zero4, lane), lane);
        st_tile(G2T, mt, nt, mma_nt<64>(BtT + 16 * mt * RB_LD, RB_LD, Tb + 16 * nt * RB_LD, RB_LD, zero4, lane), lane); }
    __syncthreads();
    const size_t ci = (size_t)(b * 4 + h) * 64 + c;
    bf16_t* gPT = (bf16_t*)(F.ws + WS_MOE + RW_PT) + ci * 4096; bf16_t* gW1 = (bf16_t*)(F.ws + WS_MOE + RW_W1) + ci * 4096; bf16_t* gZ = (bf16_t*)(F.ws + WS_MOE + RW_Z) + ci * 4096;
#pragma unroll
    for (int q = 0; q < 2; ++q) { const int nt = nt0 + q; const int col = 16 * nt + r;
        f32x4 w1 = mma_nt<64>(G1T + 16 * mt * RB_LD, RB_LD, AtT + 16 * nt * RB_LD, RB_LD, zero4, lane);
        f32x4 z = mma_nt<64>(G1T + 16 * mt * RB_LD, RB_LD, Mm + 16 * nt * RB_LD, RB_LD, zero4, lane);
        f32x4 mr = mma_nt<64>(Rt + 16 * mt * RB_LD, RB_LD, Kt + 16 * nt * RB_LD, RB_LD, zero4, lane);
        f32x4 p = mma_nt<64>(G2T + 16 * mt * RB_LD, RB_LD, AtT + 16 * nt * RB_LD, RB_LD, zero4, lane);
        f32x4 qq = mma_nt<64>(G2T + 16 * mt * RB_LD, RB_LD, Mm + 16 * nt * RB_LD, RB_LD, zero4, lane);
        const int pos = 32 * (col >> 5) + 8 * ((col >> 2) & 3) + 4 * ((col >> 4) & 1) + (col & 3);
#pragma unroll
        for (int i = 0; i < 4; ++i) { const int row = 16 * mt + 4 * g4 + i;
            gW1[row * 64 + col] = f2bf(w1[i] + bf2f(Rt[row * RB_LD + col]));
            gZ[row * 64 + col] = f2bf(z[i] + (col <= row ? mr[i] : 0.f));
            const float gc = gC[row];
            gPT[row * 64 + pos] = f2bf((p[i] + (row == col ? 1.0f : 0.f)) * gc);
            qq[i] = (qq[i] + bf2f(Kt[col * RB_LD + row])) * gc; }
        st_tile(QT, mt, nt, qq, lane); }
    __syncthreads();
    bf16_t* gU = (bf16_t*)(F.ws + WS_MOE + RW_U) + ci * 4096;
#pragma unroll
    for (int q = 0; q < 2; ++q) { const int nt = nt0 + q;
        const f32x4 u = mma_nt<64>(VT + 16 * mt * RB_LD, RB_LD, QT + 16 * nt * RB_LD, RB_LD, zero4, lane);
#pragma unroll
        for (int i = 0; i < 4; ++i) gU[(16 * mt + 4 * g4 + i) * 64 + 16 * nt + r] = f2bf(u[i]); }
}
__device__ __forceinline__ void item_rwkv_carry(const Frame& F_, int item) { Frame F = relocal(F_);
    const int bh = item * 2 + (F.wave >> 2), nt = F.wave & 3, r = F.lane & 15, g = F.lane >> 4;
    const bf16_t* PT = (const bf16_t*)(F.ws + WS_MOE + RW_PT); const bf16_t* Uc = (const bf16_t*)(F.ws + WS_MOE + RW_U); bf16_t* Ss = (bf16_t*)(F.ws + WS_MOE + RW_S);
    f32x4 acc[4];
#pragma unroll
    for (int m = 0; m < 4; ++m) acc[m] = (f32x4){0.f, 0.f, 0.f, 0.f};
    for (int c = 0; c < 64; ++c) { const size_t ci = (size_t)bh * 64 + c;
        bf16x8 af[4][2]; f32x4 cin[4];
#pragma unroll
        for (int m = 0; m < 4; ++m) { const u32x2 uv = *(const u32x2*)(Uc + ci * 4096 + (16 * nt + r) * 64 + 16 * m + 4 * g);
            cin[m] = (f32x4){__uint_as_float(uv.x << 16), __uint_as_float(uv.x & 0xffff0000u), __uint_as_float(uv.y << 16), __uint_as_float(uv.y & 0xffff0000u)};
#pragma unroll
            for (int s = 0; s < 2; ++s) af[m][s] = *(const bf16x8*)(PT + ci * 4096 + (16 * m + r) * 64 + 32 * s + 8 * g); }
        unsigned pw[4][2];
#pragma unroll
        for (int m = 0; m < 4; ++m) { pw[m][0] = pk2(acc[m][0], acc[m][1]); pw[m][1] = pk2(acc[m][2], acc[m][3]);
            *(u32x2*)(Ss + ci * 4096 + (16 * nt + r) * 64 + 16 * m + 4 * g) = (u32x2){pw[m][0], pw[m][1]}; }
        bf16x8 bfr[2];
#pragma unroll
        for (int s = 0; s < 2; ++s) bfr[s] = __builtin_bit_cast(bf16x8, (u32x4){pw[2 * s][0], pw[2 * s][1], pw[2 * s + 1][0], pw[2 * s + 1][1]});
#pragma unroll
        for (int m = 0; m < 4; ++m) { acc[m] = __builtin_amdgcn_mfma_f32_16x16x32_bf16(af[m][0], bfr[0], cin[m], 0, 0, 0);
            acc[m] = __builtin_amdgcn_mfma_f32_16x16x32_bf16(af[m][1], bfr[1], acc[m], 0, 0, 0); }
    }
}
__device__ __forceinline__ void item_rwkv3(const Frame& F_, int layer, int item) { Frame F = relocal(F_);
    const int b = item >> 8, h = (item >> 6) & 3, c = item & 63; const size_t T0 = (size_t)b * SEQ + c * 64;
    rwkv_prep<3>(F, layer, b, h, c);
    LAS float* Vv = (LAS float*)(F.lds + RW_V); LAS float* Oo = (LAS float*)(F.lds + R3_O);
    LAS float* Gg = (LAS float*)(F.lds + R3_G); LAS float* BON = (LAS float*)(F.lds + R3_BON);
    LAS bf16_t* S0b = (LAS bf16_t*)(F.lds + R3_TILES); LAS bf16_t* W1b = S0b + 4608; LAS bf16_t* Zb = W1b + 4608; LAS bf16_t* VTb = Zb + 4608;
    { const size_t ci = (size_t)(b * 4 + h) * 64 + c; const int row = F.tid >> 3, col = (F.tid & 7) * 8;
      *(LAS u32x4*)(S0b + row * RB_LD + col) = *(const u32x4*)((const bf16_t*)(F.ws + WS_MOE + RW_S) + ci * 4096 + F.tid * 8);
      *(LAS u32x4*)(W1b + row * RB_LD + col) = *(const u32x4*)((const bf16_t*)(F.ws + WS_MOE + RW_W1) + ci * 4096 + F.tid * 8);
      *(LAS u32x4*)(Zb + row * RB_LD + col) = *(const u32x4*)((const bf16_t*)(F.ws + WS_MOE + RW_Z) + ci * 4096 + F.tid * 8);
      const int vv = F.tid & 63, part = F.tid >> 6;
#pragma unroll
      for (int i = 0; i < 8; ++i) { const int t = 8 * part + i; VTb[vv * RB_LD + t] = f2bf(Vv[t * 64 + vv]); } }
    __syncthreads();
    { const int lane = F.lane, mt = F.wave >> 1, nt0 = 2 * (F.wave & 1), r = lane & 15, g4 = lane >> 4;
#pragma unroll
      for (int q = 0; q < 2; ++q) { const int nt = nt0 + q;
          f32x4 o = mma_nt<64>(W1b + 16 * mt * RB_LD, RB_LD, S0b + 16 * nt * RB_LD, RB_LD, (f32x4){0.f, 0.f, 0.f, 0.f}, lane);
          o = mma_nt<64>(Zb + 16 * mt * RB_LD, RB_LD, VTb + 16 * nt * RB_LD, RB_LD, o, lane);
#pragma unroll
          for (int i = 0; i < 4; ++i) Oo[(16 * mt + 4 * g4 + i) * 64 + 16 * nt + r] = o[i]; } }
    __syncthreads();
    { const int j = F.lane, tq = F.wave, ch = h * 64 + j;
      const float lw = F.in[I_RLNW][layer * 256 + ch], lb = F.in[I_RLNB][layer * 256 + ch];
      bf16_t* Y = (bf16_t*)(F.ws + WS_H);
#pragma unroll 2
      for (int i8 = 0; i8 < 8; ++i8) { const int t = tq + 8 * i8;
          const float o = Oo[t * 64 + j]; const float mean = wave_sum(o) * (1.0f / 64.0f); const float d = o - mean; const float var = wave_sum(d * d) * (1.0f / 64.0f);
          float on = d * rsqrtf(var + 64e-5f) * lw + lb; on += BON[t] * Vv[t * 64 + j];
          Y[(T0 + t) * DM + 256 + ch] = f2bf(on * Gg[t * 64 + j]); } }
}

constexpr int DS_SEL = 131072, DS_HIST = 135168, DS_BKT = 151552, DS_BIAS = 152064;
__device__ __forceinline__ void dsa_tables(const Frame& F_) { Frame F = relocal(F_);
    LAS int* bkt = (LAS int*)(F.lds + DS_BKT); LAS float* biasT = (LAS float*)(F.lds + DS_BIAS);
    if (F.tid < 128) { const int n = F.tid; int bk = n; if (n >= 16) { const float lr = logf((float)n / 16.0f) / 2.0794415416798357f; bk = 16 + (int)(lr * 16.0f); bk = bk < 31 ? bk : 31; } bkt[n] = bk; biasT[n] = F.in[I_RELB][n]; }
    __syncthreads();
}
__device__ __forceinline__ unsigned fkey(float f) { const unsigned u = __float_as_uint(f); return (u & 0x80000000u) ? ~u : (u | 0x80000000u); }
__device__ __forceinline__ void item_dsa(const Frame& F_, int layer, int item) { Frame F = relocal(F_);
    const bf16_t* U = (const bf16_t*)(F.ws + WS_U); const bf16_t* KI = (const bf16_t*)(F.ws + WS_KIDX);
    const bf16_t* Kb = (const bf16_t*)(F.ws + WS_K); const bf16_t* Vb = (const bf16_t*)(F.ws + WS_V);
    const int b = item & 3, qg = 511 - (item >> 2); const size_t TB = (size_t)b * SEQ, T0 = TB + qg * 8;
    LAS float* sc = (LAS float*)F.lds; LAS unsigned short* selall = (LAS unsigned short*)(F.lds + DS_SEL); LAS unsigned* histall = (LAS unsigned*)(F.lds + DS_HIST);
    LAS int* bkt = (LAS int*)(F.lds + DS_BKT); LAS float* biasT = (LAS float*)(F.lds + DS_BIAS);
    const int lane = F.lane, hh = lane >> 5;
    {
        bf16x8 af[2][2]; float wq[2][2][8];
        { const int r = lane & 31, q4 = 2 * ((r >> 2) & 1) + (r >> 4), head = 4 * ((r >> 3) & 1) + (r & 3);
#pragma unroll
          for (int mt = 0; mt < 2; ++mt)
#pragma unroll
              for (int ks = 0; ks < 2; ++ks) af[mt][ks] = *(const bf16x8*)(U + (T0 + 4 * mt + q4) * NINP + UC + 384 + head * 32 + 16 * ks + 8 * hh); }
#pragma unroll
        for (int mt = 0; mt < 2; ++mt)
#pragma unroll
            for (int q2 = 0; q2 < 2; ++q2) { float f[8]; unpack8(*(const u32x4*)(U + (T0 + 4 * mt + 2 * hh + q2) * NINP + UC + 672), f);
#pragma unroll
                for (int hd = 0; hd < 8; ++hd) wq[mt][q2][hd] = f[hd]; }
        const int ntile = (qg * 8 + 8 + 31) >> 5;
        bf16x8 nb0 = af[0][0], nb1 = af[0][0];
        if (F.wave < ntile) { const int key = F.wave * 32 + (lane & 31); nb0 = *(const bf16x8*)(KI + (TB + key) * 32 + 8 * hh); nb1 = *(const bf16x8*)(KI + (TB + key) * 32 + 16 + 8 * hh); }
        for (int kt = F.wave; kt < ntile; kt += 8) {
            const int key = kt * 32 + (lane & 31);
            const bf16x8 b0 = nb0, b1 = nb1;
            if (kt + 8 < ntile) { const int k2 = key + 256; nb0 = *(const bf16x8*)(KI + (TB + k2) * 32 + 8 * hh); nb1 = *(const bf16x8*)(KI + (TB + k2) * 32 + 16 + 8 * hh); }
#pragma unroll
            for (int mt = 0; mt < 2; ++mt) { f32x16 acc;
#pragma unroll
                for (int i = 0; i < 16; ++i) acc[i] = 0.f;
                acc = __builtin_amdgcn_mfma_f32_32x32x16_bf16(af[mt][0], b0, acc, 0, 0, 0);
                acc = __builtin_amdgcn_mfma_f32_32x32x16_bf16(af[mt][1], b1, acc, 0, 0, 0);
#pragma unroll
                for (int q2 = 0; q2 < 2; ++q2) { float s = 0.f;
#pragma unroll
                    for (int hd = 0; hd < 8; ++hd) s += fmaxf(acc[8 * q2 + hd], 0.f) * wq[mt][q2][hd];
                    const int qi = 4 * mt + 2 * hh + q2;
                    sc[qi * 4096 + key] = (key <= qg * 8 + qi) ? s : -INFINITY; } }
        }
    }
    __syncthreads();
    const int qi = F.wave, tq = qg * 8 + qi, n = tq + 1;
    LAS float* scq = sc + qi * 4096; LAS unsigned short* sel = selall + qi * 256; LAS unsigned* hist = histall + qi * 512;
    int nsel;
    if (n <= 256) { nsel = n; for (int j = lane; j < 256; j += 64) sel[j] = (unsigned short)(j < n ? j : 0); }
    else {
        nsel = 256;
        const int R = (n + 63) >> 6; const unsigned long long ltm = (1ull << lane) - 1ull;
        float lo = INFINITY, hi = -INFINITY;
        const int R4 = (n + 255) >> 8;
#pragma unroll 4
        for (int i = 0; i < R4; ++i) { const int j0 = 256 * i + 4 * lane; const f32x4 v4 = *(const LAS f32x4*)(scq + j0);
#pragma unroll
            for (int q = 0; q < 4; ++q) { const bool valid = j0 + q < n; lo = fminf(lo, valid ? v4[q] : INFINITY); hi = fmaxf(hi, valid ? v4[q] : -INFINITY); } }
#pragma unroll
        for (int o = 1; o < 64; o <<= 1) { lo = fminf(lo, shx(lo, o)); hi = fmaxf(hi, shx(hi, o)); }
        bool slow = false;
        if (!(hi > lo)) { for (int j = lane; j < 256; j += 64) sel[j] = (unsigned short)j; }
        else {
            const float scale = 1023.0f / (hi - lo);
            *(LAS u32x4*)(hist + 8 * lane) = (u32x4){0u, 0u, 0u, 0u}; *(LAS u32x4*)(hist + 8 * lane + 4) = (u32x4){0u, 0u, 0u, 0u};
#pragma unroll 2
            for (int i = 0; i < R4; ++i) { const int j0 = 256 * i + 4 * lane; const f32x4 v4 = *(const LAS f32x4*)(scq + j0);
#pragma unroll
                for (int q = 0; q < 4; ++q) { if (j0 + q < n) { int bk = (int)((v4[q] - lo) * scale); bk = bk < 1023 ? bk : 1023;
                    atomicAdd((unsigned*)(hist + (bk >> 1)), (bk & 1) ? 65536u : 1u); } } }
            const u32x4 h0 = *(const LAS u32x4*)(hist + 8 * lane), h1 = *(const LAS u32x4*)(hist + 8 * lane + 4);
            unsigned cb[16];
            cb[0] = h0.x & 0xffffu; cb[1] = h0.x >> 16; cb[2] = h0.y & 0xffffu; cb[3] = h0.y >> 16; cb[4] = h0.z & 0xffffu; cb[5] = h0.z >> 16; cb[6] = h0.w & 0xffffu; cb[7] = h0.w >> 16;
            cb[8] = h1.x & 0xffffu; cb[9] = h1.x >> 16; cb[10] = h1.y & 0xffffu; cb[11] = h1.y >> 16; cb[12] = h1.z & 0xffffu; cb[13] = h1.z >> 16; cb[14] = h1.w & 0xffffu; cb[15] = h1.w >> 16;
            unsigned tot = 0u;
#pragma unroll
            for (int q = 0; q < 16; ++q) tot += cb[q];
            unsigned incl = tot;
#pragma unroll
            for (int o = 1; o < 64; o <<= 1) { const unsigned t = shdown_u(incl, o); if (lane + o < 64) incl += t; }
            int fb = -1; unsigned fabove = 0u, fcnt = 0u; unsigned cum = incl - tot;
#pragma unroll
            for (int q = 15; q >= 0; --q) { if (fb < 0 && cum < 256u && 256u <= cum + cb[q]) { fb = 16 * lane + q; fabove = cum; fcnt = cb[q]; } cum += cb[q]; }
            const unsigned long long mf = __ballot(fb >= 0); const int src = (int)__ffsll((long long)mf) - 1;
            const int B = shidx_i(fb, src); const int above = shidx_i((int)fabove, src), cntB = shidx_i((int)fcnt, src); const int need = 256 - above;
            if (cntB > 256) slow = true;
            else {
                LAS unsigned* cand = hist;
                int base_gt = 0, base_c = 0;
#pragma unroll 2
                for (int i = 0; i < R4; ++i) { const int j0 = 256 * i + 4 * lane; const f32x4 v4 = *(const LAS f32x4*)(scq + j0);
#pragma unroll
                    for (int q = 0; q < 4; ++q) { const int j = j0 + q; const bool valid = j < n; const float v = valid ? v4[q] : lo;
                        int bk = (int)((v - lo) * scale); bk = bk < 1023 ? bk : 1023;
                        const bool gt = valid && bk > B, eq = valid && bk == B;
                        const unsigned long long mg = __ballot(gt), me = __ballot(eq);
                        if (gt) sel[base_gt + __popcll(mg & ltm)] = (unsigned short)j;
                        if (eq) { const int p = base_c + __popcll(me & ltm); cand[2 * p] = fkey(v); cand[2 * p + 1] = (unsigned)j; }
                        base_gt += __popcll(mg); base_c += __popcll(me); } }
                if (need == cntB) { for (int c = lane; c < cntB; c += 64) sel[above + c] = (unsigned short)cand[2 * c + 1]; }
                else {
                    unsigned ck[4], cx[4]; int rk[4];
#pragma unroll
                    for (int q = 0; q < 4; ++q) { const int c = lane + 64 * q; ck[q] = c < cntB ? cand[2 * c] : 0u; cx[q] = c < cntB ? cand[2 * c + 1] : 0u; rk[q] = 0; }
                    for (int c2 = 0; c2 < cntB; ++c2) { const unsigned k2 = cand[2 * c2], x2 = cand[2 * c2 + 1];
#pragma unroll
                        for (int q = 0; q < 4; ++q) rk[q] += (k2 > ck[q] || (k2 == ck[q] && x2 < cx[q])) ? 1 : 0; }
#pragma unroll
                    for (int q = 0; q < 4; ++q) { const int c = lane + 64 * q; if (c < cntB && rk[q] < need) sel[above + rk[q]] = (unsigned short)cand[2 * c + 1]; }
                }
            }
        }
        if (slow) {
        unsigned prefix = 0u; int need = 256; unsigned neq = 0u;
        for (int p = 0; p < 4; ++p) { const int shift = 24 - 8 * p;
            *(LAS u32x4*)(hist + 4 * lane) = (u32x4){0u, 0u, 0u, 0u};
            for (int i = 0; i < R; ++i) { const int j = lane + 64 * i; if (j < n) { const unsigned u = fkey(scq[j]);
                if (p == 0 || (u >> (shift + 8)) == prefix) atomicAdd((unsigned*)(hist + ((u >> shift) & 255u)), 1u); } }
            const u32x4 hv = *(const LAS u32x4*)(hist + 4 * lane);
            const unsigned tot = hv.x + hv.y + hv.z + hv.w;
            unsigned incl = tot;
#pragma unroll
            for (int o = 1; o < 64; o <<= 1) { const unsigned t = shdown_u(incl, o); if (lane + o < 64) incl += t; }
            const unsigned above = incl - tot;
            int fb = -1; unsigned fabove = 0u, feq = 0u; unsigned cum = above;
            { const unsigned hq[4] = {hv.x, hv.y, hv.z, hv.w};
#pragma unroll
              for (int q = 3; q >= 0; --q) { if (fb < 0 && cum < (unsigned)need && (unsigned)need <= cum + hq[q]) { fb = 4 * lane + q; fabove = cum; feq = hq[q]; } cum += hq[q]; } }
            const unsigned long long m = __ballot(fb >= 0);
            const int src = (int)__ffsll((long long)m) - 1;
            const int bin = shidx_i(fb, src); const unsigned ab = (unsigned)shidx_i((int)fabove, src); neq = (unsigned)shidx_i((int)feq, src);
            need -= (int)ab; prefix = (prefix << 8) | (unsigned)bin;
        }
        const int ngt = 256 - need;
        int base_gt = 0, base_eq = 0;
        for (int i = 0; i < R; ++i) { const int j = lane + 64 * i; const unsigned u = (j < n) ? fkey(scq[j]) : 0u;
            const bool gt = (j < n) && (u > prefix), eq = (j < n) && (u == prefix);
            const unsigned long long mg = __ballot(gt), me = __ballot(eq); const unsigned long long lt = (1ull << lane) - 1ull;
            if (gt) sel[base_gt + __popcll(mg & lt)] = (unsigned short)j;
            if (eq) { const int rk = base_eq + __popcll(me & lt); if (rk < need) sel[ngt + rk] = (unsigned short)j; }
            base_gt += __popcll(mg); base_eq += __popcll(me); }
        (void)neq;
            }
    }
    const int nt16 = (nsel + 15) >> 4, r16 = lane & 15, g4 = lane >> 4;
    LAS float* biasj = scq + 2048;
#pragma unroll
    for (int q = 0; q < 4; ++q) { const int j = lane + 64 * q; f32x4 bv = (f32x4){-INFINITY, -INFINITY, -INFINITY, -INFINITY};
        if (j < nsel) { const int dist = tq - (int)sel[j]; const int bk = dist < 128 ? bkt[dist < 0 ? 0 : dist] : 31; bv = *(const LAS f32x4*)(biasT + 4 * bk); }
        *(LAS f32x4*)(biasj + 4 * j) = bv; }
    bf16x8 qf[2];
#pragma unroll
    for (int s = 0; s < 2; ++s) { u32x4 z = (u32x4){0u, 0u, 0u, 0u}; if (r16 < 4) z = *(const u32x4*)(U + (T0 + qi) * NINP + UC + r16 * 64 + 32 * s + 8 * g4); qf[s] = __builtin_bit_cast(bf16x8, z); }
    float lg[16][4]; float mx = -INFINITY;
#define DSA_QK(M0, NM) do { int keyr[NM]; bf16x8 a0[NM], a1[NM]; \
        _Pragma("unroll") for (int m8 = 0; m8 < NM; ++m8) keyr[m8] = sel[16 * ((M0) + m8) + r16]; \
        _Pragma("unroll") for (int m8 = 0; m8 < NM; ++m8) { a0[m8] = *(const bf16x8*)(Kb + (TB + keyr[m8]) * 64 + 8 * g4); a1[m8] = *(const bf16x8*)(Kb + (TB + keyr[m8]) * 64 + 32 + 8 * g4); } \
        _Pragma("unroll") for (int m8 = 0; m8 < NM; ++m8) { const int m = (M0) + m8; \
            f32x4 acc = (f32x4){0.f, 0.f, 0.f, 0.f}; \
            acc = __builtin_amdgcn_mfma_f32_16x16x32_bf16(a0[m8], qf[0], acc, 0, 0, 0); \
            acc = __builtin_amdgcn_mfma_f32_16x16x32_bf16(a1[m8], qf[1], acc, 0, 0, 0); \
            _Pragma("unroll") for (int i = 0; i < 4; ++i) { const float v = acc[i] * 0.125f + biasj[(16 * m + 4 * g4 + i) * 4 + (r16 & 3)]; lg[m][i] = v; mx = fmaxf(mx, v); } } } while (0)
    if (nt16 > 8) { DSA_QK(0, 16); }
    else { DSA_QK(0, 8);
#pragma unroll
        for (int m8 = 8; m8 < 16; ++m8)
#pragma unroll
            for (int i = 0; i < 4; ++i) lg[m8][i] = -INFINITY; }
#undef DSA_QK
    mx = fmaxf(mx, shx(mx, 16)); mx = fmaxf(mx, shx(mx, 32));
    float sm = 0.f;
#pragma unroll
    for (int m = 0; m < 16; ++m)
#pragma unroll
        for (int i = 0; i < 4; ++i) { const float p = __expf(lg[m][i] - mx); lg[m][i] = p; sm += p; }
    sm += shx(sm, 16); sm += shx(sm, 32);
    f32x4 ov[4];
#pragma unroll
    for (int nt = 0; nt < 4; ++nt) ov[nt] = (f32x4){0.f, 0.f, 0.f, 0.f};
    const unsigned vs_base = (unsigned)(unsigned long)scq;
#pragma unroll
    for (int half = 0; half < 2; ++half) {
        if (half * 8 < nt16) {
            asm volatile("s_waitcnt lgkmcnt(0)" ::: "memory");
            int vkey[16];
#pragma unroll
            for (int q = 0; q < 16; ++q) { const int rho = 8 * q + (lane >> 3);
                vkey[q] = sel[half * 128 + (rho & ~31) + 16 * ((rho >> 2) & 1) + 4 * ((rho >> 3) & 3) + (rho & 3)]; }
            asm volatile("s_waitcnt lgkmcnt(0)" : "+v"(vkey[0]), "+v"(vkey[1]), "+v"(vkey[2]), "+v"(vkey[3]), "+v"(vkey[4]), "+v"(vkey[5]), "+v"(vkey[6]), "+v"(vkey[7]),
                         "+v"(vkey[8]), "+v"(vkey[9]), "+v"(vkey[10]), "+v"(vkey[11]), "+v"(vkey[12]), "+v"(vkey[13]), "+v"(vkey[14]), "+v"(vkey[15]) :: "memory");
#pragma unroll
            for (int q = 0; q < 16; ++q)
                __builtin_amdgcn_global_load_lds((const unsigned*)(Vb + (TB + vkey[q]) * 64 + 8 * (lane & 7)), (LAS unsigned*)((LAS unsigned char*)scq + q * 1024), 16, 0, 0);
            asm volatile("s_waitcnt vmcnt(0)" ::: "memory");
#pragma unroll
            for (int s4 = 0; s4 < 4; ++s4) { const int s = half * 4 + s4;
                u32x4 pw; pw.x = pk2(lg[2 * s][0], lg[2 * s][1]); pw.y = pk2(lg[2 * s][2], lg[2 * s][3]); pw.z = pk2(lg[2 * s + 1][0], lg[2 * s + 1][1]); pw.w = pk2(lg[2 * s + 1][2], lg[2 * s + 1][3]);
                const bf16x8 pa = __builtin_bit_cast(bf16x8, pw);
                const unsigned ad = vs_base + (unsigned)((32 * s4 + 8 * g4 + (r16 >> 2)) * 128 + (r16 & 3) * 8);
                u32x2 t0[4], t1[4];
                asm volatile("ds_read_b64_tr_b16 %0, %8\n\tds_read_b64_tr_b16 %1, %8 offset:512\n\tds_read_b64_tr_b16 %2, %8 offset:32\n\tds_read_b64_tr_b16 %3, %8 offset:544\n\t"
                             "ds_read_b64_tr_b16 %4, %8 offset:64\n\tds_read_b64_tr_b16 %5, %8 offset:576\n\tds_read_b64_tr_b16 %6, %8 offset:96\n\tds_read_b64_tr_b16 %7, %8 offset:608\n\ts_waitcnt lgkmcnt(0)"
                             : "=&v"(t0[0]), "=&v"(t1[0]), "=&v"(t0[1]), "=&v"(t1[1]), "=&v"(t0[2]), "=&v"(t1[2]), "=&v"(t0[3]), "=&v"(t1[3]) : "v"(ad) : "memory");
#pragma unroll
                for (int nt = 0; nt < 4; ++nt) { const bf16x8 vb = __builtin_bit_cast(bf16x8, (u32x4){t0[nt].x, t0[nt].y, t1[nt].x, t1[nt].y});
                    ov[nt] = __builtin_amdgcn_mfma_f32_16x16x32_bf16(pa, vb, ov[nt], 0, 0, 0); } }
        }
    }
    { float inv[4];
#pragma unroll
      for (int h = 0; h < 4; ++h) inv[h] = 1.0f / __int_as_float(__builtin_amdgcn_readlane(__float_as_int(sm), h));
      if (lane < 16) { bf16_t* Y = (bf16_t*)(F.ws + WS_H) + (T0 + qi) * DM + 512 + r16;
#pragma unroll
          for (int h = 0; h < 4; ++h)
#pragma unroll
              for (int nt = 0; nt < 4; ++nt) Y[h * 64 + 16 * nt] = f2bf(ov[nt][h] * inv[h]); } }
}

__device__ __forceinline__ void phase_router(const Frame& F_, int layer) { Frame F = relocal(F_); const int cset = layer;
    const float* X = (const float*)(F.ws + WS_X);
    const bf16_t* WH = (const bf16_t*)(F.ws + WS_WRT) + (size_t)layer * 2 * 49152; const bf16_t* WL = WH + 49152;
    LAS float* part = (LAS float*)F.lds;
    LAS float* ssq = (LAS float*)(F.lds + 24576);
    LAS int* es = (LAS int*)(F.lds + 25088);
    LAS int* lr = (LAS int*)(F.lds + 25600);
    LAS float* wsl = (LAS float*)(F.lds + 26112);
    LAS float* rsd = (LAS float*)(F.lds + 26624);
    for (int blk = F.bid; blk < NTOK / 64; blk += F.G) {
        __syncthreads();
        const int mt = F.wave & 3, kh = F.wave >> 2, r16 = F.lane & 15, g4 = F.lane >> 4;
        const float* xr = X + ((size_t)blk * 64 + mt * 16 + r16) * DM + kh * 512 + 8 * g4;
        f32x4 acc[3]; acc[0] = acc[1] = acc[2] = (f32x4){0.f, 0.f, 0.f, 0.f}; float ss = 0.f;
#pragma unroll 4
        for (int ks = 0; ks < 16; ++ks) {
            const f32x4 xa = *(const f32x4*)(xr + ks * 32), xb = *(const f32x4*)(xr + ks * 32 + 4);
            ss += xa[0] * xa[0] + xa[1] * xa[1] + xa[2] * xa[2] + xa[3] * xa[3] + xb[0] * xb[0] + xb[1] * xb[1] + xb[2] * xb[2] + xb[3] * xb[3];
            float xv[8] = {xa[0], xa[1], xa[2], xa[3], xb[0], xb[1], xb[2], xb[3]}; unsigned hw[4], lw[4];
#pragma unroll
            for (int j = 0; j < 4; ++j) { const bf16_t h0 = f2bf(xv[2 * j]), h1 = f2bf(xv[2 * j + 1]); hw[j] = (unsigned)h0 | ((unsigned)h1 << 16);
                lw[j] = pk2(xv[2 * j] - bf2f(h0), xv[2 * j + 1] - bf2f(h1)); }
            const bf16x8 ahi = __builtin_bit_cast(bf16x8, (u32x4){hw[0], hw[1], hw[2], hw[3]}), alo = __builtin_bit_cast(bf16x8, (u32x4){lw[0], lw[1], lw[2], lw[3]});
#pragma unroll
            for (int nt = 0; nt < 3; ++nt) { const size_t wo = (size_t)(nt * 16 + r16) * 1024 + kh * 512 + ks * 32 + 8 * g4;
                const bf16x8 bh = *(const bf16x8*)(WH + wo), bl = *(const bf16x8*)(WL + wo);
                acc[nt] = __builtin_amdgcn_mfma_f32_16x16x32_bf16(ahi, bh, acc[nt], 0, 0, 0);
                acc[nt] = __builtin_amdgcn_mfma_f32_16x16x32_bf16(ahi, bl, acc[nt], 0, 0, 0);
                acc[nt] = __builtin_amdgcn_mfma_f32_16x16x32_bf16(alo, bh, acc[nt], 0, 0, 0); }
        }
        ss += shx(ss, 16); ss += shx(ss, 32);
        if (g4 == 0) ssq[kh * 64 + mt * 16 + r16] = ss;
#pragma unroll
        for (int nt = 0; nt < 3; ++nt)
#pragma unroll
            for (int i = 0; i < 4; ++i) part[(kh * 64 + mt * 16 + 4 * g4 + i) * 48 + nt * 16 + r16] = acc[nt][i];
        __syncthreads();
        if (F.tid < 64) { const float rstd = rsqrtf((ssq[F.tid] + ssq[64 + F.tid]) * (1.0f / DM) + 1e-6f); rsd[F.tid] = rstd;
            float l[36];
#pragma unroll
            for (int o = 0; o < 36; ++o) l[o] = (part[F.tid * 48 + o] + part[(64 + F.tid) * 48 + o]) * rstd + (o < 32 ? F.in[I_BRE][layer * 32 + o] : F.in[I_BRG][layer * 4 + o - 32]);
            int gs = 0; float gm = l[32];
#pragma unroll
            for (int j = 1; j < 4; ++j) if (l[32 + j] > gm) { gm = l[32 + j]; gs = j; }
            float den = 0.f;
#pragma unroll
            for (int j = 0; j < 4; ++j) den += __expf(l[32 + j] - gm);
            const float gate = 1.0f / den;
            float e8[8];
#pragma unroll
            for (int j = 0; j < 8; ++j) e8[j] = gs == 0 ? l[j] : gs == 1 ? l[8 + j] : gs == 2 ? l[16 + j] : l[24 + j];
            int i1 = 0; float v1 = e8[0];
#pragma unroll
            for (int j = 1; j < 8; ++j) if (e8[j] > v1) { v1 = e8[j]; i1 = j; }
            int i2 = -1; float v2 = -INFINITY;
#pragma unroll
            for (int j = 0; j < 8; ++j) if (j != i1 && e8[j] > v2) { v2 = e8[j]; i2 = j; }
            const float e2 = __expf(v2 - v1); const float p1 = 1.0f / (1.0f + e2);
            es[F.tid * 2] = gs * 8 + i1; es[F.tid * 2 + 1] = gs * 8 + i2; wsl[F.tid * 2] = p1 * gate; wsl[F.tid * 2 + 1] = (1.0f - p1) * gate; }
        __syncthreads();
        if (F.tid < 32) { int cnt = 0; for (int i = 0; i < 128; ++i) if (es[i] == F.tid) lr[i] = cnt++;
            if (cnt) { const int base = (int)__hip_atomic_fetch_add(F.ctl + CW_CNT + cset * 32 + F.tid, (unsigned)cnt, __ATOMIC_RELAXED, __HIP_MEMORY_SCOPE_AGENT);
                for (int i = 0; i < 128; ++i) if (es[i] == F.tid) lr[i] += base; } }
        __syncthreads();
        if (F.tid < 64) { int* rt = (int*)(F.ws + WS_ROUTE) + ((size_t)blk * 64 + F.tid) * 8;
            rt[0] = es[F.tid * 2]; rt[1] = es[F.tid * 2 + 1]; ((float*)rt)[2] = wsl[F.tid * 2]; ((float*)rt)[3] = wsl[F.tid * 2 + 1]; rt[4] = lr[F.tid * 2]; rt[5] = lr[F.tid * 2 + 1]; ((float*)rt)[6] = rsd[F.tid]; }
    }
    __syncthreads();
    if (F.tid == 0) __hip_atomic_fetch_add(F.ctl + CW_RB + 64 * layer, 1u, __ATOMIC_RELAXED, __HIP_MEMORY_SCOPE_AGENT);
}
__device__ __forceinline__ void phase_moe_convert(const Frame& F_, int layer) { Frame F = relocal(F_);
    bf16_t* WGU = (bf16_t*)(F.ws + WS_MOE + MOE_WGU);
    for (int t = F.bid; t < 1024; t += F.G) {
        const int e = t >> 5, r = t & 31, kt = r >> 1, nt = r & 1; const size_t eo = ((size_t)layer * 32 + e) * 1024 * 256;
        tr_tile(F, 256, WGU + (size_t)e * 512 * 1024, 1024, kt * 64, nt * 256, SmGU{F.in[I_WGATE] + eo, F.in[I_WUP] + eo}); }
}
__device__ __forceinline__ void phase_moe_convert_down(const Frame& F_, int layer) { Frame F = relocal(F_);
    bf16_t* WD = (bf16_t*)(F.ws + WS_MOE + MOE_WD);
    for (;;) { const int q = q_pop(F, 32 + layer); if (q >= 512) break;
        const int e = q >> 4, r = q & 15, kt = r >> 2, nt = r & 3;
        tr_tile(F, 1024, WD + (size_t)e * 1024 * 256, 256, kt * 64, nt * 256, SmId{F.in[I_WDOWN] + ((size_t)layer * 32 + e) * 256 * 1024}); }
}
__device__ __forceinline__ void phase_gather(const Frame& F_, int layer) { Frame F = relocal(F_);
    LAS int* off = (LAS int*)F.lds;
    __syncthreads();
    if (F.tid == 0) { unsigned sp = 0;
        while (__hip_atomic_load(F.ctl + CW_RB + 64 * layer, __ATOMIC_RELAXED, __HIP_MEMORY_SCOPE_AGENT) < (unsigned)F.G) { __builtin_amdgcn_s_sleep(2); if (++sp > (1u << 22)) break; } }
    __syncthreads();
    if (F.tid == 0) { int acc = 0; for (int e = 0; e < 32; ++e) { off[e] = acc; const int c = (int)__hip_atomic_load(F.ctl + CW_CNT + layer * 32 + e, __ATOMIC_RELAXED, __HIP_MEMORY_SCOPE_AGENT); acc += (c + 255) & ~255; } off[32] = acc; }
    __syncthreads();
    int* tiles = (int*)(F.ws + WS_TILES); int* row_tok = (int*)(F.ws + WS_ROWS); float* row_w = (float*)(F.ws + WS_ROWS) + MAXROWS;
    if (F.bid == 0) { if (F.tid == 0) tiles[0] = off[32] >> 8; if (F.tid < 33) tiles[1 + F.tid] = off[F.tid];
        if (F.tid < 32) for (int rt = off[F.tid] >> 8; rt < (off[F.tid + 1] >> 8); ++rt) tiles[64 + rt] = F.tid; }
    for (int e = F.bid; e < 32; e += F.G) { const int c = (int)__hip_atomic_load(F.ctl + CW_CNT + layer * 32 + e, __ATOMIC_RELAXED, __HIP_MEMORY_SCOPE_AGENT);
        for (int r = off[e] + c + F.tid; r < off[e + 1]; r += NTHR) { row_tok[r] = -1; row_w[r] = 0.f; } }
    const float* X = (const float*)(F.ws + WS_X); bf16_t* HP = (bf16_t*)(F.ws + WS_U); const float* nw = F.in[I_NORM2] + (size_t)layer * DM;
    f32x4 nwv[4];
#pragma unroll
    for (int j = 0; j < 4; ++j) nwv[j] = *(const f32x4*)(nw + 4 * F.lane + 256 * j);
    for (int blk = F.bid; blk < NTOK / 64; blk += F.G)
    for (int i4 = 0; i4 < 2; ++i4) {
        int p0[4], p1[4], tt[4]; float rstd[4], w0[4], w1[4]; f32x4 xv[4][4];
#pragma unroll
        for (int r = 0; r < 4; ++r) { const int t = blk * 64 + F.wave * 8 + 4 * i4 + r; tt[r] = t;
            const int* rt = (const int*)(F.ws + WS_ROUTE) + (size_t)t * 8; rstd[r] = ((const float*)rt)[6]; w0[r] = ((const float*)rt)[2]; w1[r] = ((const float*)rt)[3];
            p0[r] = off[rt[0]] + rt[4]; p1[r] = off[rt[1]] + rt[5];
#pragma unroll
            for (int j = 0; j < 4; ++j) xv[r][j] = *(const f32x4*)(X + (size_t)t * DM + 4 * F.lane + 256 * j); }
#pragma unroll
        for (int r = 0; r < 4; ++r) {
#pragma unroll
            for (int j = 0; j < 4; ++j) { const int c = 4 * F.lane + 256 * j; const f32x4 v = xv[r][j] * rstd[r] * nwv[j];
                u32x2 o; o.x = pk2(v[0], v[1]); o.y = pk2(v[2], v[3]);
                *(u32x2*)(HP + (size_t)tt[r] * DM + c) = o; }
            if (F.lane == 0) { row_tok[p0[r]] = tt[r] * 2; row_w[p0[r]] = w0[r]; row_tok[p1[r]] = tt[r] * 2 + 1; row_w[p1[r]] = w1[r]; } }
    }
}

constexpr int NPH_LAYER = 9, NPHASE = 1 + 2 * NPH_LAYER + 1;
#ifndef MK_ONLY
#define MK_ONLY -1
#endif
#ifndef MK_ITEM
#define MK_ITEM -1
#endif
#define EN(o) (MK_ONLY < 0 || MK_ONLY == (o))
#define IT(o) (MK_ITEM < 0 || MK_ITEM == (o))
__global__ void __launch_bounds__(NTHR, 2) mk_forward(Params P) {
    extern __shared__ __attribute__((aligned(16))) unsigned char lds_raw[];
    Frame F; F.lds = (LAS unsigned char*)lds_raw; F.tid = threadIdx.x; F.lane = F.tid & 63; F.wave = __builtin_amdgcn_readfirstlane(F.tid >> 6); F.bid = blockIdx.x; F.G = gridDim.x;
    F.in = (in_tab_t)__builtin_amdgcn_kernarg_segment_ptr(); F.out = P.out; F.ws = P.ws; F.ctl = (unsigned*)(P.ws + WS_CTL); F.misc = (volatile LAS int*)(F.lds + MISC_OFF);
    if (F.tid < 64) ((LAS unsigned*)(F.lds + MISC_OFF))[F.tid] = 0u;
    __syncthreads();
    const int lo = P.ph_lo, hi = P.ph_hi;
    XcdBarrier bar; bar.bar = F.ctl + CW_BAR; bar.x = 0; bar.st = (volatile LAS unsigned*)(F.lds + MISC_OFF + 16);
    if (hi - lo > 1) bar = xcd_barrier_post(F.ctl + CW_BAR, (volatile LAS unsigned*)(F.lds + MISC_OFF + 16));
#define IN(k) (lo <= (k) && (k) < hi)
#define SEAM(k) do { if (IN(k) && IN((k) + 1)) xcd_barrier(bar); } while (0)
#define QLOOP(qi, n, body) for (;;) { const int it = q_pop(F, layer * 12 + (qi)); if (it >= (n)) break; body; }
    if (EN(100) && IN(0)) { phase_prologue(F); phase_norm(F, F.in[I_X], false, F.in[I_NORM1], 3); } SEAM(0);
#pragma unroll
    for (int layer = 0; layer < DEPTH; ++layer) {
        const int pb = 1 + layer * NPH_LAYER;
        if (layer > 0) { if (EN(0) && IN(pb + 0)) { phase_norm(F, (const float*)(F.ws + WS_X), true, F.in[I_NORM1] + (size_t)layer * DM, 0); } SEAM(pb + 0); }
        if (EN(1) && IN(pb + 1)) { const Frame F_ = F; Frame F = relocal(F_); pg8::StaticOrder S; S.init((const bf16_t*)(F.ws + WS_H), (const bf16_t*)(F.ws + WS_WIN) + (size_t)layer * NINP * DM, NTOK, NINP, DM, F.G, F.bid);
            pg8::EpiBf16 E{(bf16_t*)(F.ws + WS_U), NINP}; pg8::gemm_phase(F.lds, DM, S, E); } SEAM(pb + 1);
#define SLOOP(n, body) for (int it = F.bid; it < (n); it += F.G) { __syncthreads(); body; }
        if (EN(2) && IN(pb + 2)) {
            if (IT(1)) SLOOP(1024, item_rwkv1(F, layer, it));
            if (IT(0)) SLOOP(256, item_s5<1>(F, layer, it));
            if (IT(2)) SLOOP(256, item_mamba<1>(F, layer, it));
            if (IT(3)) SLOOP(256, item_kv(F, layer, it));
        } SEAM(pb + 2);
        if (EN(3) && IN(pb + 3)) {
            if (IT(0)) SLOOP(8, item_rwkv_carry(F, it));
            if (IT(1)) { for (int it = F.bid - 8; it >= 0 && it < 16; it += F.G) { __syncthreads(); item_mamba_carry(F, it); } }
            if (IT(2)) { for (int it = F.bid - 24; it >= 0 && it < 4; it += F.G) { __syncthreads(); item_s5_carry(F, layer, it); } }
            if (IT(3)) {
                dsa_tables(F);
                const int pref = (int)(xb_xcc_id() & 3u);
#pragma unroll 1
                for (int k4 = 0; k4 < 4; ++k4) { const int bq = (pref + k4) & 3;
                    for (;;) { const int it = q_pop(F, 24 + layer * 4 + bq); if (it >= 512) break; item_dsa(F, layer, it * 4 + bq); } } }
        } SEAM(pb + 3);
        if (EN(4) && IN(pb + 4)) {
            if (IT(0)) SLOOP(256, item_s5<2>(F, layer, it));
            if (IT(2)) SLOOP(256, item_mamba<2>(F, layer, it));
            if (IT(1)) SLOOP(1024, item_rwkv3(F, layer, it));
        } SEAM(pb + 4);
        if (EN(6) && IN(pb + 5)) { const Frame F_ = F; Frame F = relocal(F_); pg8::StaticOrder S; S.init((const bf16_t*)(F.ws + WS_H), (const bf16_t*)(F.ws + WS_WOUT) + (size_t)layer * DM * DM, NTOK, DM, DM, F.G, F.bid);
            pg8::EpiResid E{layer == 0 ? F.in[I_X] : (const float*)(F.ws + WS_X), (float*)(F.ws + WS_X), DM}; pg8::gemm_phase(F.lds, DM, S, E); } SEAM(pb + 5);
        if (EN(7) && IN(pb + 6)) { phase_router(F, layer); phase_moe_convert(F, layer); phase_gather(F, layer); } SEAM(pb + 6);
        if (EN(8) && IN(pb + 7)) { const Frame F_ = F; Frame F = relocal(F_); LAS int* ul = (LAS int*)(F.lds + pg8::STAGE_BYTES + 8192); if (F.tid == 0) pg8::MoeOrder::build(ul, (const int*)(F.ws + WS_TILES), 2, F.G, F.bid); __syncthreads();
            pg8::MoeOrder S{DM, (const char*)(F.ws + WS_U), (const char*)(F.ws + WS_MOE + MOE_WGU), (size_t)512 * 1024 * 2, ul};
            pg8::EpiGated<1> E{(bf16_t*)(F.ws + WS_H), 256, 0, nullptr, nullptr}; pg8::gemm_phase<pg8::EpiGated<1>, pg8::MoeOrder, true>(F.lds, DM, S, E, (const char*)(F.ws + WS_U), (const int*)(F.ws + WS_ROWS)); phase_moe_convert_down(F, layer); } SEAM(pb + 7);
        if (EN(9) && IN(pb + 8)) { const Frame F_ = F; Frame F = relocal(F_); LAS int* ul = (LAS int*)(F.lds + pg8::STAGE_BYTES + 8192); if (F.tid == 0) pg8::MoeOrder::build(ul, (const int*)(F.ws + WS_TILES), 4, F.G, F.bid); __syncthreads();
            pg8::MoeOrder S{256, (const char*)(F.ws + WS_H), (const char*)(F.ws + WS_MOE + MOE_WD), (size_t)1024 * 256 * 2, ul};
            pg8::EpiMoeOut E{(bf16_t*)(F.ws + WS_U), (const int*)(F.ws + WS_ROWS), (const float*)(F.ws + WS_ROWS) + MAXROWS, F.lds}; pg8::gemm_phase(F.lds, 256, S, E); } SEAM(pb + 8);
    }
    if (EN(101) && IN(NPHASE - 1)) { phase_norm(F, (const float*)(F.ws + WS_X), true, F.in[I_FNORM], 2); }
#undef IN
#undef SEAM
}

#ifndef MK_SPLIT
#define MK_SPLIT 0
#endif
extern "C" void kernel_launch(void* const* d_in, const int* in_sizes, int n_in, void* d_out, int out_size, void* d_ws, size_t ws_size, hipStream_t stream) {
    static int grid = 0;
    if (grid == 0) {
        if (n_in != 44 || out_size != NTOK * DM || ws_size < WS_END) { fprintf(stderr, "kernel_launch: unexpected shapes (n_in %d out %d ws %zu need %zu)\n", n_in, out_size, ws_size, (size_t)WS_END); grid = -1; return; }
        int dev = 0, cus = 0;
        if (hipGetDevice(&dev) != hipSuccess || hipDeviceGetAttribute(&cus, hipDeviceAttributeMultiprocessorCount, dev) != hipSuccess) { grid = -1; return; }
        if (hipFuncSetAttribute((const void*)mk_forward, hipFuncAttributeMaxDynamicSharedMemorySize, LDS_BYTES) != hipSuccess) { fprintf(stderr, "kernel_launch: hipFuncSetAttribute failed\n"); grid = -1; return; }
        int per_cu = 0;
        if (hipOccupancyMaxActiveBlocksPerMultiprocessor(&per_cu, (const void*)mk_forward, NTHR, LDS_BYTES) != hipSuccess || per_cu < 1) { fprintf(stderr, "kernel_launch: occupancy query says %d\n", per_cu); }
        (void)hipGetLastError();
        grid = cus;
    }
    if (grid < 0) return;
    hipMemsetAsync((char*)d_ws + WS_CTL, 0, CTL_BYTES, stream);
    Params p{};
    for (int i = 0; i < 44; ++i) p.in[i] = (const float*)d_in[i];
    p.out = (float*)d_out; p.ws = (unsigned char*)d_ws;
#if MK_SPLIT
    for (int ph = 0; ph < NPHASE; ++ph) { p.ph_lo = ph; p.ph_hi = ph + 1; hipLaunchKernelGGL(mk_forward, dim3(grid), dim3(NTHR), LDS_BYTES, stream, p); }
#else
    p.ph_lo = 0; p.ph_hi = NPHASE; hipLaunchKernelGGL(mk_forward, dim3(grid), dim3(NTHR), LDS_BYTES, stream, p);
#endif
}
```

```cpp
#include <hip/hip_runtime.h>
#include <stdint.h>
#include <stdio.h>

#define LAS __attribute__((address_space(3)))
typedef unsigned short bf16_t;
typedef short bf16x8 __attribute__((ext_vector_type(8)));
typedef float f32x4 __attribute__((ext_vector_type(4)));
typedef float f32x2 __attribute__((ext_vector_type(2)));
typedef float f32x16 __attribute__((ext_vector_type(16)));
typedef unsigned u32x4 __attribute__((ext_vector_type(4)));
typedef unsigned u32x2 __attribute__((ext_vector_type(2)));

constexpr int NTOK = 16384, DM = 1024, SEQ = 4096, NBATCH = 4, DEPTH = 2;
constexpr int NIN = 2604, NINP = 2816;
constexpr int UM = 0;
constexpr int UR = 784;
constexpr int UC = 1680;
constexpr int US = 2368;
constexpr int NTHR = 512;
constexpr int LDS_BYTES = 163840;
constexpr int MISC_OFF = LDS_BYTES - 256;

constexpr size_t WS_CTL   = 0;
constexpr size_t CTL_BYTES = 65536;
constexpr size_t WS_X     = WS_CTL + CTL_BYTES;
constexpr size_t WS_H     = WS_X + (size_t)NTOK * DM * 4;
constexpr size_t WS_U     = WS_H + (size_t)NTOK * DM * 2;
constexpr size_t WS_WIN   = WS_U + (size_t)NTOK * NINP * 2;
constexpr size_t WS_WOUT  = WS_WIN + (size_t)2 * NINP * DM * 2;
constexpr size_t WS_GLU   = WS_WOUT + (size_t)2 * DM * DM * 2;
constexpr size_t WS_MOE   = WS_GLU + (size_t)2 * 512 * 256 * 2;
constexpr size_t MOE_WGU  = 0;
constexpr size_t MOE_WD   = (size_t)32 * 512 * 1024 * 2;
constexpr size_t MOE_BYTES = MOE_WD + (size_t)32 * 1024 * 256 * 2;
constexpr size_t RW_PT    = 0;
constexpr size_t RW_U     = (size_t)1024 * 4096 * 2;
constexpr size_t RW_S     = RW_U + (size_t)1024 * 4096 * 2;
constexpr size_t RW_W1    = RW_S + (size_t)1024 * 4096 * 2;
constexpr size_t RW_Z     = RW_W1 + (size_t)1024 * 4096 * 2;
constexpr size_t YSG_OFF  = RW_Z + (size_t)1024 * 4096 * 2;
static_assert(YSG_OFF + (size_t)NTOK * 256 * 2 <= MOE_BYTES, "alias");
constexpr size_t WS_MST   = WS_MOE + MOE_BYTES;
constexpr size_t WS_MDEC  = WS_MST + (size_t)4 * 64 * 4 * 4096 * 4;
constexpr size_t WS_S5ST  = WS_MDEC + 4096;
constexpr size_t WS_K     = WS_S5ST + (size_t)4 * 64 * 2048 * 4;
constexpr size_t WS_V     = WS_K + (size_t)NTOK * 64 * 2;
constexpr size_t WS_KIDX  = WS_V + (size_t)NTOK * 64 * 2;
constexpr size_t WS_ROUTE = WS_KIDX + (size_t)NTOK * 32 * 2;
constexpr size_t WS_ROWS  = WS_ROUTE + (size_t)NTOK * 32;
constexpr int    MAXROWS  = 49152;
constexpr size_t WS_TILES = WS_ROWS + (size_t)MAXROWS * 8;
constexpr size_t WS_S5TAB = WS_TILES + 4096;
constexpr size_t S5TAB_F  = (size_t)(2048 + 2048 + 32768) * 4;
constexpr size_t S5TAB_BBT = S5TAB_F + (size_t)16 * 16 * 128 * 2;
constexpr size_t S5TAB_L  = S5TAB_BBT + (size_t)16 * 128 * 16 * 2;
constexpr size_t WS_WRT   = WS_S5TAB + 2 * S5TAB_L;
constexpr size_t WS_BON   = WS_WRT + (size_t)2 * 2 * 48 * 1024 * 2;
constexpr size_t WS_END   = WS_BON + (size_t)1024 * 64 * 4;

constexpr int CW_BAR = 0;
constexpr int CW_Q   = 4096;
constexpr int CW_CNT = 8192;
constexpr int CW_RB  = 8448;

__device__ __forceinline__ float bf2f(bf16_t b) { return __uint_as_float(((unsigned)b) << 16); }
__device__ __forceinline__ bf16_t f2bf(float f) { const __bf16 h = (__bf16)f; return __builtin_bit_cast(bf16_t, h); }
__device__ __forceinline__ unsigned pk2(float lo, float hi) { typedef __bf16 bf2_t __attribute__((ext_vector_type(2))); const bf2_t h = __builtin_convertvector((f32x2){lo, hi}, bf2_t); return __builtin_bit_cast(unsigned, h); }
__device__ __forceinline__ unsigned cvt_pk_bf16(float lo, float hi) { unsigned r; asm volatile("v_cvt_pk_bf16_f32 %0, %1, %2" : "=v"(r) : "v"(lo), "v"(hi)); return r; }
__device__ __forceinline__ float sigmoidf_(float x) { return 1.0f / (1.0f + __expf(-x)); }
__device__ __forceinline__ float siluf_(float x) { return x / (1.0f + __expf(-x)); }
__device__ __forceinline__ float tanhf_(float x) { const float e = __expf(2.0f * x); return 1.0f - 2.0f / (e + 1.0f); }
__device__ __forceinline__ float softplusf_(float x) { return fmaxf(x, 0.0f) + log1pf(__expf(-fabsf(x))); }
__device__ __forceinline__ float gelu_tanh(float x) { return 0.5f * x * (1.0f + tanhf_(0.7978845608028654f * (x + 0.044715f * x * x * x))); }
template <int CTRL> __device__ __forceinline__ float dppf(float x) { return __int_as_float(__builtin_amdgcn_update_dpp(0, __float_as_int(x), CTRL, 0xF, 0xF, true)); }
__device__ __forceinline__ float sum4(float x) { x += dppf<0xB1>(x); x += dppf<0x4E>(x); return x; }
__device__ __forceinline__ float sum8(float x) { x = sum4(x); x += dppf<0x141>(x); return x; }
__device__ __forceinline__ float sum16(float x) { x = sum8(x); x += dppf<0x140>(x); return x; }
__device__ __forceinline__ int lane_id_() { int l = (int)__builtin_amdgcn_mbcnt_hi(~0u, __builtin_amdgcn_mbcnt_lo(~0u, 0u)); asm volatile("" : "+v"(l)); return l; }
__device__ __forceinline__ float shx(float x, int o) { return __int_as_float(__builtin_amdgcn_ds_bpermute((lane_id_() ^ o) << 2, __float_as_int(x))); }
__device__ __forceinline__ unsigned shdown_u(unsigned x, int o) { return (unsigned)__builtin_amdgcn_ds_bpermute(((lane_id_() + o) & 63) << 2, (int)x); }
__device__ __forceinline__ int shidx_i(int x, int src) { return __builtin_amdgcn_ds_bpermute(src << 2, x); }
__device__ __forceinline__ float wave_sum(float x) { x = sum16(x); x += shx(x, 16); x += shx(x, 32); return x; }
__device__ __forceinline__ void unpack8(const u32x4 v, float (&f)[8]) {
    f[0] = __uint_as_float(v.x << 16); f[1] = __uint_as_float(v.x & 0xffff0000u); f[2] = __uint_as_float(v.y << 16); f[3] = __uint_as_float(v.y & 0xffff0000u);
    f[4] = __uint_as_float(v.z << 16); f[5] = __uint_as_float(v.z & 0xffff0000u); f[6] = __uint_as_float(v.w << 16); f[7] = __uint_as_float(v.w & 0xffff0000u);
}

__device__ __forceinline__ void st16_wt(void* p, u32x4 v) { asm volatile("global_store_dwordx4 %0, %1, off sc1\n\ts_nop 1" :: "v"(p), "v"(v) : "memory"); }
#define XB_TMO      128
#define XB_XCNT(j)  (256  + 64 * (j))
#define XB_XSUB(j)  (1280 + 64 * (j))
#define XB_XGEN(j)  (2304 + 64 * (j))
#define XB_TOP      3328
#define XB_TOPGEN   3392
#define XCD_BAR_WORDS 3456
#define XB_SPIN_CAP (1u << 22)
__device__ __forceinline__ unsigned xb_ld(unsigned* p)              { return __hip_atomic_load(p, __ATOMIC_RELAXED, __HIP_MEMORY_SCOPE_AGENT); }
__device__ __forceinline__ unsigned xb_add(unsigned* p, unsigned v) { return __hip_atomic_fetch_add(p, v, __ATOMIC_RELAXED, __HIP_MEMORY_SCOPE_AGENT); }
__device__ __forceinline__ unsigned xb_xcc_id() { return (unsigned)__builtin_amdgcn_s_getreg((3 << 11) | 20) & 0xFu; }
#define XB_SPIN(cond, bar) do { unsigned _sp = 0; while (cond) { __builtin_amdgcn_s_sleep(1); \
    if ((++_sp & 255u) == 0u) { if (xb_ld(&(bar)[XB_TMO])) break; if (_sp > XB_SPIN_CAP) { atomicAdd(&(bar)[XB_TMO], 1u); break; } } } } while (0)
struct XcdBarrier { unsigned* bar; unsigned x; volatile LAS unsigned* st; };
__device__ __forceinline__ XcdBarrier xcd_barrier_post(unsigned* bar, volatile LAS unsigned* st) {
    XcdBarrier b; b.bar = bar; b.x = xb_xcc_id(); b.st = st;
    if (threadIdx.x == 0) (void)xb_add(&bar[XB_XCNT(b.x)], 1u);
    return b;
}
__device__ __forceinline__ void xcd_barrier_complete(unsigned* bar, unsigned x, unsigned& nloc, unsigned& nx) {
    const unsigned G = gridDim.x * gridDim.y * gridDim.z;
    unsigned sum, cnt, mine, sp = 0u;
    for (;;) {
        sum = 0u; cnt = 0u; mine = 0u;
#pragma unroll
        for (unsigned j = 0; j < 16; ++j) { const unsigned c = xb_ld(&bar[XB_XCNT(j)]); sum += c; cnt += (c > 0u) ? 1u : 0u; mine = (j == x) ? c : mine; }
        if (sum == G) break;
        __builtin_amdgcn_s_sleep(1);
        if ((++sp & 255u) == 0u) { if (xb_ld(&bar[XB_TMO])) break; if (sp > XB_SPIN_CAP) { atomicAdd(&bar[XB_TMO], 1u); break; } }
    }
    nloc = mine > 0u ? mine : 1u; nx = cnt > 0u ? cnt : 1u;
}
__device__ __forceinline__ void xcd_barrier(const XcdBarrier& b_) {
    XcdBarrier b = b_; { const unsigned long long v = (unsigned long long)b.bar; unsigned lo = __builtin_amdgcn_readfirstlane((unsigned)v), hi = __builtin_amdgcn_readfirstlane((unsigned)(v >> 32)); asm volatile("" : "+s"(lo), "+s"(hi)); b.bar = (unsigned*)(((unsigned long long)hi << 32) | lo); unsigned xx = __builtin_amdgcn_readfirstlane(b.x); asm volatile("" : "+s"(xx)); b.x = xx; }
    asm volatile("s_waitcnt vmcnt(0)" ::: "memory");
    __syncthreads();
    if (threadIdx.x == 0) {
        unsigned* bar = b.bar;
        __builtin_amdgcn_s_waitcnt(0);
        unsigned nloc = b.st[0], nx = b.st[1];
        if (nloc == 0u) { xcd_barrier_complete(bar, b.x, nloc, nx); b.st[0] = nloc; b.st[1] = nx; }
        const unsigned old = xb_add(&bar[XB_XSUB(b.x)], 1u);
        const unsigned gen = old / nloc;
        if (old + 1u == (gen + 1u) * nloc) {
            __builtin_amdgcn_fence(__ATOMIC_RELEASE, "agent");
            asm volatile("s_waitcnt vmcnt(0)" ::: "memory");
            const unsigned og = xb_add(&bar[XB_TOP], 1u);
            const unsigned tg = og / nx;
            if (og + 1u == (tg + 1u) * nx) xb_add(&bar[XB_TOPGEN], 1u);
            else XB_SPIN(xb_ld(&bar[XB_TOPGEN]) == tg, bar);
            __builtin_amdgcn_fence(__ATOMIC_ACQUIRE, "agent");
            xb_add(&bar[XB_XGEN(b.x)], 1u);
            asm volatile("s_waitcnt vmcnt(0)" ::: "memory");
        } else {
            XB_SPIN(xb_ld(&bar[XB_XGEN(b.x)]) == gen, bar);
            __builtin_amdgcn_fence(__ATOMIC_ACQUIRE, "agent");
            asm volatile("s_waitcnt vmcnt(0)" ::: "memory");
        }
    }
    __syncthreads();
}

namespace pg8 {
constexpr int BM = 256, BK = 64, HALF = 128, HTB = HALF * BK * 2, STAGE_BYTES = 8 * HTB, NXCD = 8, WGM = 8;
__host__ __device__ __forceinline__ int lds_byte(int r, int c) { const int st = (r >> 4) * 2 + (c >> 5), rr = r & 15, cc = c & 31, ob = rr * 64 + cc * 2; return st * 1024 + (ob ^ (((ob >> 9) & 1) << 5)); }
__host__ __device__ __forceinline__ void stage_rc(int b, int& R, int& C) { const int st = b / 1024, sb = b % 1024, swz = sb ^ (((sb >> 9) & 1) << 5); R = (st >> 1) * 16 + swz / 64; C = (st & 1) * 32 + (swz % 64) / 2; }
__host__ __device__ __forceinline__ int perm32(int rho) { const int n = rho >> 4, i = rho & 15; return 8 * (i >> 2) + 4 * n + (i & 3); }
struct Unit { int pm, pn; const char* a; const char* b; };

struct StaticOrder {
    int nM, nN, nwg, G, c, K; const char* A; const char* B;
    __device__ void init(const bf16_t* A_, const bf16_t* B_, int M, int N, int K_, int G_, int c_) { A = (const char*)A_; B = (const char*)B_; K = K_; nM = M / BM; nN = N / BM; nwg = nM * nN; G = G_; c = c_; }
    __device__ bool next(int i, Unit& u) const {
        const long L = (long)i * G + c; if (L >= nwg) return false;
        int wgid = (int)L; { const int q = nwg / NXCD, r = nwg % NXCD, xcd = wgid % NXCD, off = wgid / NXCD; wgid = (xcd < r ? xcd * (q + 1) : r * (q + 1) + (xcd - r) * q) + off; }
        const int nig = WGM * nN, gid = wgid / nig, fm = gid * WGM, gsz = (nM - fm) < WGM ? (nM - fm) : WGM;
        u.pm = fm + ((wgid % nig) % gsz); u.pn = (wgid % nig) / gsz;
        u.a = A + (size_t)u.pm * 256 * K * 2; u.b = B + (size_t)u.pn * 256 * K * 2; return true;
    }
};

template <class Epi, class Sched, bool GATHER = false>
__device__ __forceinline__ void gemm_phase(LAS unsigned char* lds, const int K_, const Sched& S, const Epi& E, const char* Aall = nullptr, const int* arow = nullptr) {
    int K = K_; asm volatile("" : "+s"(K));
    int tid_ = threadIdx.x; asm volatile("" : "+v"(tid_));
    const int tid = tid_, wid = __builtin_amdgcn_readfirstlane(tid >> 6), lane = tid & 63, wr = wid >> 2, wc = wid & 3, fr = lane & 15, fq = lane >> 4;
    const int nt = K / BK;
    unsigned voffA[2], voffB[2]; int Rst[2], Cst[2];
#pragma unroll
    for (int i = 0; i < 2; ++i) { int R, C; stage_rc(tid * 16 + i * 8192, R, C); const int Rb = Epi::PERM ? ((R & ~31) + perm32(R & 31)) : R; Rst[i] = R; Cst[i] = C;
        voffA[i] = (unsigned)(R * K + C) * 2u; voffB[i] = (unsigned)(Rb * K + C) * 2u; }
    unsigned gv[2][2], gn[2][2];
#define PG8_GOFF(dst, unit) do { _Pragma("unroll") for (int h_ = 0; h_ < 2; ++h_) _Pragma("unroll") for (int i_ = 0; i_ < 2; ++i_) { const int rr_ = arow[(unit).pm * BM + h_ * HALF + Rst[i_]]; \
        dst[h_][i_] = ((unsigned)(rr_ < 0 ? 0 : rr_ >> 1) * (unsigned)K + (unsigned)Cst[i_]) * 2u; } } while (0)
    const size_t kstep = (size_t)(BK * 2);
    const size_t hstep = (size_t)HALF * K * 2;
    const unsigned ldsw = (unsigned)wid * 1024u;
    const int aoff = lds_byte(wr * 64 + fr, fq * 8), boff = lds_byte(wc * 32 + fr, fq * 8);
#define PG8_SA(b, h) (((b) * 2 + (h)) * HTB)
#define PG8_SB(b, h) ((4 + (b) * 2 + (h)) * HTB)
#define PG8_STAGE(bufoff, gbase, voff) do { _Pragma("unroll") for (int _i = 0; _i < 2; ++_i) \
        __builtin_amdgcn_global_load_lds((const unsigned*)((const char*)(gbase) + (voff)[_i]), (LAS unsigned*)(lds + (bufoff) + ldsw + _i * 8192), 16, 0, 0); } while (0)
#define PG8_LDA(dst, b, h) do { _Pragma("unroll") for (int m = 0; m < 4; ++m) _Pragma("unroll") for (int k = 0; k < 2; ++k) dst[m][k] = *(const LAS bf16x8*)(lds + PG8_SA(b, h) + aoff + m * 2048 + k * 1024); } while (0)
#define PG8_LDB(dst, b, h) do { _Pragma("unroll") for (int n = 0; n < 2; ++n) _Pragma("unroll") for (int k = 0; k < 2; ++k) dst[n][k] = *(const LAS bf16x8*)(lds + PG8_SB(b, h) + boff + n * 2048 + k * 1024); } while (0)
#define PG8_MMA(ai, bj, At, Bt) do { __builtin_amdgcn_s_setprio(1); _Pragma("unroll") for (int m = 0; m < 4; ++m) _Pragma("unroll") for (int n = 0; n < 2; ++n) _Pragma("unroll") for (int k = 0; k < 2; ++k) \
        acc[ai][bj][m][n] = __builtin_amdgcn_mfma_f32_16x16x32_bf16(Bt[n][k], At[m][k], acc[ai][bj][m][n], 0, 0, 0); __builtin_amdgcn_s_setprio(0); } while (0)
#define PG8_WAIT_V(n) asm volatile("s_waitcnt vmcnt(" #n ")" ::: "memory")
#define PG8_WAIT_L(n) asm volatile("s_waitcnt lgkmcnt(" #n ")" ::: "memory")
#define PG8_BAR __builtin_amdgcn_s_barrier()
#define PG8_SCHED __builtin_amdgcn_sched_barrier(0)
    Unit cur, nxt; int ui = 0;
    if (!S.next(0, cur)) return;
    f32x4 acc[2][2][4][2];
#pragma unroll
    for (int a = 0; a < 2; ++a)
#pragma unroll
        for (int b = 0; b < 2; ++b)
#pragma unroll
            for (int m = 0; m < 4; ++m)
#pragma unroll
                for (int n = 0; n < 2; ++n) acc[a][b][m][n] = (f32x4){0.f, 0.f, 0.f, 0.f};
    bf16x8 At[4][2], B0[2][2], B1[2][2];
    const char* cA = GATHER ? Aall : cur.a; const char* cB = cur.b;
    if (GATHER) PG8_GOFF(gv, cur);
#define PG8_STAGE_A(bufoff, gbase, h, vo) do { if (GATHER) PG8_STAGE(bufoff, gbase, (vo)[h]); else PG8_STAGE(bufoff, (gbase) + ((h) ? hstep : 0), voffA); } while (0)
    PG8_STAGE(PG8_SB(0, 0), cB, voffB); PG8_STAGE_A(PG8_SA(0, 0), cA, 0, gv); PG8_STAGE(PG8_SB(0, 1), cB + hstep, voffB); PG8_STAGE_A(PG8_SA(0, 1), cA, 1, gv);
    if (wr == 1) PG8_BAR;
    PG8_WAIT_V(4); PG8_BAR;
    PG8_STAGE(PG8_SB(1, 0), cB + kstep, voffB); PG8_STAGE_A(PG8_SA(1, 0), cA + kstep, 0, gv); PG8_STAGE(PG8_SB(1, 1), cB + hstep + kstep, voffB);
    PG8_WAIT_V(6); PG8_BAR;
    for (;;) {
        const bool has_next = S.next(ui + 1, nxt);
        const char* nA = GATHER ? cA : (has_next ? nxt.a : cA); const char* nB = has_next ? nxt.b : cB;
        if (GATHER) { if (has_next) PG8_GOFF(gn, nxt); else {
#pragma unroll
            for (int h_ = 0; h_ < 2; ++h_)
#pragma unroll
                for (int i_ = 0; i_ < 2; ++i_) gn[h_][i_] = gv[h_][i_]; } }
        for (int t = 0; t < nt; t += 2) {
            const bool last = (t == nt - 2);
            const char* a1 = cA + (size_t)(t + 1) * kstep;
            const char* a2 = last ? nA : cA + (size_t)(t + 2) * kstep; const char* b2 = last ? nB : cB + (size_t)(t + 2) * kstep;
            const char* a3 = a2 + kstep; const char* b3 = b2 + kstep;
            unsigned vo2[2][2];
#pragma unroll
            for (int h_ = 0; h_ < 2; ++h_)
#pragma unroll
                for (int i_ = 0; i_ < 2; ++i_) vo2[h_][i_] = GATHER ? (last ? gn[h_][i_] : gv[h_][i_]) : 0u;
            PG8_LDB(B0, 0, 0); PG8_SCHED; PG8_LDA(At, 0, 0); PG8_STAGE_A(PG8_SA(1, 1), a1, 1, gv);
            PG8_WAIT_L(8); PG8_BAR; PG8_WAIT_L(0); PG8_MMA(0, 0, At, B0); PG8_BAR; PG8_SCHED;
            PG8_LDB(B1, 0, 1); PG8_STAGE(PG8_SB(0, 0), b2, voffB);
            PG8_BAR; PG8_WAIT_L(0); PG8_MMA(0, 1, At, B1); PG8_BAR;
            PG8_LDA(At, 0, 1); PG8_STAGE_A(PG8_SA(0, 0), a2, 0, vo2);
            PG8_BAR; PG8_WAIT_L(0); PG8_MMA(1, 0, At, B0); PG8_BAR; PG8_SCHED;
            PG8_STAGE(PG8_SB(0, 1), b2 + hstep, voffB);
            PG8_WAIT_V(6); PG8_BAR; PG8_MMA(1, 1, At, B1); PG8_BAR;
            PG8_LDB(B0, 1, 0); PG8_SCHED; PG8_LDA(At, 1, 0); PG8_STAGE_A(PG8_SA(0, 1), a2, 1, vo2);
            PG8_WAIT_L(8); PG8_BAR; PG8_WAIT_L(0); PG8_MMA(0, 0, At, B0); PG8_BAR; PG8_SCHED;
            PG8_LDB(B1, 1, 1); PG8_STAGE(PG8_SB(1, 0), b3, voffB);
            PG8_BAR; PG8_WAIT_L(0); PG8_MMA(0, 1, At, B1); PG8_BAR;
            PG8_LDA(At, 1, 1); PG8_STAGE_A(PG8_SA(1, 0), a3, 0, vo2);
            PG8_BAR; PG8_WAIT_L(0); PG8_MMA(1, 0, At, B0); PG8_BAR; PG8_SCHED;
            PG8_STAGE(PG8_SB(1, 1), b3 + hstep, voffB);
            PG8_WAIT_V(6); PG8_BAR; PG8_MMA(1, 1, At, B1); PG8_BAR;
        }
        E(acc, cur, wr, wc, fr, fq);
        if (!has_next) break;
#pragma unroll
        for (int a = 0; a < 2; ++a)
#pragma unroll
            for (int b = 0; b < 2; ++b)
#pragma unroll
                for (int m = 0; m < 4; ++m)
#pragma unroll
                    for (int n = 0; n < 2; ++n) acc[a][b][m][n] = (f32x4){0.f, 0.f, 0.f, 0.f};
        cur = nxt; cA = nA; cB = nB; ++ui;
        if (GATHER) {
#pragma unroll
            for (int h_ = 0; h_ < 2; ++h_)
#pragma unroll
                for (int i_ = 0; i_ < 2; ++i_) gv[h_][i_] = gn[h_][i_]; }
    }
    PG8_WAIT_V(0);
    if (wr == 0) PG8_BAR;
    PG8_BAR;
#undef PG8_SA
#undef PG8_SB
#undef PG8_STAGE
#undef PG8_STAGE_A
#undef PG8_GOFF
#undef PG8_LDA
#undef PG8_LDB
#undef PG8_MMA
#undef PG8_WAIT_V
#undef PG8_WAIT_L
#undef PG8_BAR
#undef PG8_SCHED
}

struct EpiBf16 {
    static constexpr bool PERM = true;
    bf16_t* O; int ldc;
    __device__ __forceinline__ void operator()(const f32x4 (&acc)[2][2][4][2], const Unit& u, int wr, int wc, int fr, int fq) const {
        const int row0 = u.pm * BM + wr * 64 + fr, col0 = u.pn * BM + wc * 32 + 8 * fq;
#pragma unroll
        for (int ai = 0; ai < 2; ++ai)
#pragma unroll
            for (int m = 0; m < 4; ++m) { bf16_t* rowp = O + (size_t)(row0 + ai * HALF + m * 16) * ldc + col0;
#pragma unroll
                for (int bj = 0; bj < 2; ++bj) { const f32x4 v0 = acc[ai][bj][m][0], v1 = acc[ai][bj][m][1];
                    u32x4 w; w.x = cvt_pk_bf16(v0[0], v0[1]); w.y = cvt_pk_bf16(v0[2], v0[3]); w.z = cvt_pk_bf16(v1[0], v1[1]); w.w = cvt_pk_bf16(v1[2], v1[3]);
                    st16_wt(rowp + bj * HALF, w); } }
    }
};
struct EpiResid {
    static constexpr bool PERM = false;
    const float* Cin; float* C; int ldc;
    __device__ __forceinline__ void operator()(const f32x4 (&acc)[2][2][4][2], const Unit& u, int wr, int wc, int fr_, int fq_) const {
        int fr = fr_, fq = fq_; asm volatile("" : "+v"(fr), "+v"(fq));
        const int row0 = u.pm * BM + wr * 64 + fr, col0 = u.pn * BM + wc * 32 + 4 * fq;
#pragma unroll
        for (int ai = 0; ai < 2; ++ai)
#pragma unroll
            for (int mp = 0; mp < 2; ++mp) { f32x4 cv[2][2][2];
#pragma unroll
                for (int mm = 0; mm < 2; ++mm) { const float* rowp = Cin + (size_t)(row0 + ai * HALF + (2 * mp + mm) * 16) * ldc + col0;
#pragma unroll
                    for (int bj = 0; bj < 2; ++bj)
#pragma unroll
                        for (int n = 0; n < 2; ++n) cv[mm][bj][n] = *(const f32x4*)(rowp + bj * HALF + n * 16); }
#pragma unroll
                for (int mm = 0; mm < 2; ++mm) { float* rowp = C + (size_t)(row0 + ai * HALF + (2 * mp + mm) * 16) * ldc + col0;
#pragma unroll
                    for (int bj = 0; bj < 2; ++bj)
#pragma unroll
                        for (int n = 0; n < 2; ++n) { const f32x4 o_ = cv[mm][bj][n] + acc[ai][bj][2 * mp + mm][n]; st16_wt(rowp + bj * HALF + n * 16, __builtin_bit_cast(u32x4, o_)); } }
                asm volatile("" ::: "memory"); }
    }
};
template <int ACT  > struct EpiGated {
    static constexpr bool PERM = true;
    bf16_t* O; int ldo; int coloff; const float* ba; const float* bb;
    __device__ __forceinline__ void operator()(const f32x4 (&acc)[2][2][4][2], const Unit& u, int wr, int wc, int fr, int fq) const {
        const int row0 = u.pm * BM + wr * 64 + fr, cl = u.pn * HALF + wc * 32 + 8 * fq;
        float va[8], vb[8];
#pragma unroll
        for (int j = 0; j < 8; ++j) { va[j] = (ACT == 0) ? ba[cl + j] : 0.f; vb[j] = (ACT == 0) ? bb[cl + j] : 0.f; }
#pragma unroll
        for (int ai = 0; ai < 2; ++ai)
#pragma unroll
            for (int m = 0; m < 4; ++m) { bf16_t* rowp = O + (size_t)(row0 + ai * HALF + m * 16) * ldo + coloff + cl;
                float o[8];
#pragma unroll
                for (int n = 0; n < 2; ++n)
#pragma unroll
                    for (int j = 0; j < 4; ++j) { const float a = acc[ai][0][m][n][j] + va[4 * n + j], b = acc[ai][1][m][n][j] + vb[4 * n + j];
                        o[4 * n + j] = (ACT == 0) ? a * sigmoidf_(b) : siluf_(a) * b; }
                u32x4 w; w.x = cvt_pk_bf16(o[0], o[1]); w.y = cvt_pk_bf16(o[2], o[3]); w.z = cvt_pk_bf16(o[4], o[5]); w.w = cvt_pk_bf16(o[6], o[7]);
                st16_wt(rowp, w); asm volatile("" ::: "memory"); }
    }
};
struct EpiMoeOut {
    static constexpr bool PERM = true;
    bf16_t* O; const int* row_tok; const float* row_w; LAS unsigned char* lds;
    __device__ __forceinline__ void operator()(const f32x4 (&acc)[2][2][4][2], const Unit& u, int wr, int wc, int fr_, int fq_) const {
        int fr = fr_, fq = fq_; asm volatile("" : "+v"(fr), "+v"(fq));
        const int col0 = u.pn * BM + wc * 32 + 8 * fq, lane = fq * 16 + fr;
        LAS u32x2* rinfo = (LAS u32x2*)(lds + STAGE_BYTES) + (wr * 4 + wc) * 128;
        { const int ra = u.pm * BM + wr * 64 + lane, rb = ra + HALF;
          const u32x2 ia = (u32x2){(unsigned)row_tok[ra], __float_as_uint(row_w[ra])}, ib = (u32x2){(unsigned)row_tok[rb], __float_as_uint(row_w[rb])};
          rinfo[lane] = ia; rinfo[64 + lane] = ib; }
#pragma unroll
        for (int ai = 0; ai < 2; ++ai)
#pragma unroll
            for (int m = 0; m < 4; ++m) { const u32x2 inf = rinfo[ai * 64 + m * 16 + fr]; const int ts = (int)inf.x; const float w = __uint_as_float(inf.y);
                if (ts >= 0) { bf16_t* rowp = O + ((size_t)(ts & 1) * NTOK + (size_t)(ts >> 1)) * DM + col0;
#pragma unroll
                    for (int bj = 0; bj < 2; ++bj) { const f32x4 v0 = acc[ai][bj][m][0] * w, v1 = acc[ai][bj][m][1] * w;
                        u32x4 q; q.x = cvt_pk_bf16(v0[0], v0[1]); q.y = cvt_pk_bf16(v0[2], v0[3]); q.z = cvt_pk_bf16(v1[0], v1[1]); q.w = cvt_pk_bf16(v1[2], v1[3]);
                        st16_wt(rowp + bj * HALF, q); } } }
    }
};
struct MoeOrder {
    int K; const char* A; const char* B; size_t bstride; const LAS int* list;
    static __device__ __forceinline__ void build(LAS int* list, const int* tiles, int nN, int G, int c) {
        const int nrt = tiles[0], nwg = nrt * nN; int n = 0;
        for (int i = 0; ; ++i) { const long L = (long)i * G + c; if (L >= (long)nwg || n >= 20) break;
            int wgid = (int)L; { const int q = nwg / NXCD, r = nwg % NXCD, xcd = wgid % NXCD, off = wgid / NXCD; wgid = (xcd < r ? xcd * (q + 1) : r * (q + 1) + (xcd - r) * q) + off; }
            const int pm = wgid / nN; list[1 + 3 * n] = pm; list[2 + 3 * n] = wgid % nN; list[3 + 3 * n] = tiles[64 + pm]; ++n; }
        list[0] = n;
    }
    __device__ bool next(int i, Unit& u) const {
        const int n = __builtin_amdgcn_readfirstlane(list[0]); if (i >= n) return false;
        u.pm = __builtin_amdgcn_readfirstlane(list[1 + 3 * i]); u.pn = __builtin_amdgcn_readfirstlane(list[2 + 3 * i]); const int e = __builtin_amdgcn_readfirstlane(list[3 + 3 * i]);
        u.a = A + (size_t)u.pm * 256 * K * 2; u.b = B + (size_t)e * bstride + (size_t)u.pn * 256 * K * 2; return true;
    }
};
}

struct Params { const float* in[44]; float* out; unsigned char* ws; int ph_lo, ph_hi; };
enum { I_X = 0, I_NORM1, I_WIN, I_MCONVW, I_MCONVB, I_MDTB, I_MALOG, I_MD, I_MNORM, I_RMU, I_RW0, I_RW2, I_RA0, I_RA2, I_RG2, I_RKK, I_RKA, I_RRK, I_RLNW, I_RLNB,
       I_CKVN, I_CWUK, I_CWUV, I_RELB, I_SARE, I_SAIM, I_SBRE, I_SBIM, I_SCRE, I_SCIM, I_SD, I_SLOGDT, I_SGLUW, I_SGLUB, I_WOUT, I_NORM2, I_WRG, I_BRG, I_WRE, I_BRE,
       I_WGATE, I_WUP, I_WDOWN, I_FNORM };

typedef const float* const __attribute__((address_space(4)))* in_tab_t;
struct Frame {
    LAS unsigned char* lds; int tid, lane, wave, bid, G;
    in_tab_t in; float* out; unsigned char* ws; unsigned* ctl;
    volatile LAS int* misc;
};

__device__ __forceinline__ int q_pop(Frame& F, int qi) {
    __syncthreads();
    if (F.tid == 0) F.misc[0] = (int)__hip_atomic_fetch_add(F.ctl + CW_Q + 64 * qi, 1u, __ATOMIC_RELAXED, __HIP_MEMORY_SCOPE_AGENT);
    __syncthreads();
    return F.misc[0];
}

__device__ __forceinline__ const void* opaque_ptr(const void* p) { const unsigned long long v = (unsigned long long)p; unsigned lo = __builtin_amdgcn_readfirstlane((unsigned)v), hi = __builtin_amdgcn_readfirstlane((unsigned)(v >> 32));
    asm volatile("" : "+s"(lo), "+s"(hi)); return (const void*)(((unsigned long long)hi << 32) | lo); }
__device__ __forceinline__ Frame relocal(const Frame& G) { Frame F = G; asm volatile("" : "+v"(F.tid)); F.ws = (unsigned char*)opaque_ptr(F.ws); F.ctl = (unsigned*)(F.ws + WS_CTL); F.in = (in_tab_t)(unsigned long long)opaque_ptr((const void*)(unsigned long long)F.in); F.lane = F.tid & 63; F.wave = __builtin_amdgcn_readfirstlane(F.tid >> 6); return F; }
template <int K> __device__ __forceinline__ f32x4 mma_nt(const LAS bf16_t* A, int lda, const LAS bf16_t* Bt, int ldb, f32x4 acc, int lane) {
    const int r = lane & 15, g = lane >> 4;
#pragma unroll
    for (int k0 = 0; k0 < K; k0 += 32) {
        const bf16x8 a = *(const LAS bf16x8*)(A + r * lda + k0 + 8 * g);
        const bf16x8 b = *(const LAS bf16x8*)(Bt + r * ldb + k0 + 8 * g);
        acc = __builtin_amdgcn_mfma_f32_16x16x32_bf16(a, b, acc, 0, 0, 0);
    }
    return acc;
}

template <class SrcMap> __device__ __forceinline__ void tr_tile(Frame& F, int ldsrc, bf16_t* dst, int K, int k0, int n0, SrcMap sm) {
    LAS float* tile = (LAS float*)F.lds;
    __syncthreads();
    { const int n4 = (F.tid & 63) * 4, kk = F.tid >> 6; const float* sp = sm(n0 + n4);
      f32x4 v[8];
#pragma unroll
      for (int ps = 0; ps < 8; ++ps) { v[ps] = (f32x4){0.f, 0.f, 0.f, 0.f}; if (sp) v[ps] = __builtin_nontemporal_load((const f32x4*)(sp + (size_t)(k0 + kk + 8 * ps) * ldsrc)); }
#pragma unroll
      for (int ps = 0; ps < 8; ++ps) { LAS float* t = tile + (kk + 8 * ps) * 257 + n4; t[0] = v[ps][0]; t[1] = v[ps][1]; t[2] = v[ps][2]; t[3] = v[ps][3]; } }
    __syncthreads();
    { const int kc = F.tid & 7;
#pragma unroll
      for (int j = 0; j < 4; ++j) { const int n = (F.tid >> 3) + 64 * j; float f[8];
#pragma unroll
          for (int i = 0; i < 8; ++i) f[i] = tile[(8 * kc + i) * 257 + n];
          u32x4 w; w.x = pk2(f[0], f[1]); w.y = pk2(f[2], f[3]); w.z = pk2(f[4], f[5]); w.w = pk2(f[6], f[7]);
          *(u32x4*)(dst + (size_t)(n0 + n) * K + k0 + 8 * kc) = w; } }
}

struct SmIn { const float* base; __device__ __forceinline__ const float* operator()(int n) const {
    int c; if (n < 772) c = n; else if (n < UR) return nullptr; else if (n < UR + 896) c = 772 + (n - UR); else if (n < UC) return nullptr;
    else if (n < UC + 680) c = 1668 + (n - UC); else if (n < US) return nullptr; else if (n < US + 256) c = 2348 + (n - US); else return nullptr; return base + c; } };
struct SmId { const float* base; __device__ __forceinline__ const float* operator()(int n) const { return base + n; } };
struct SmGlu { const float* base; __device__ __forceinline__ const float* operator()(int n) const { const int pn = n >> 8, rr = n & 255; return base + (rr < 128 ? 128 * pn + rr : 256 + 128 * pn + (rr - 128)); } };
struct SmGU { const float* gate; const float* up; __device__ __forceinline__ const float* operator()(int n) const {
    const unsigned long long d = (unsigned long long)up - (unsigned long long)gate; const unsigned long long a = (unsigned long long)gate + (((n & 255) < 128) ? 0ull : d); return (const float*)a + 128 * (n >> 8) + (n & 127); } };
__device__ __forceinline__ void phase_prologue(const Frame& F_) { Frame F = relocal(F_);
    for (int t = F.bid; t < 496; t += F.G) {
        if (t < 352) { const int l = t / 176, r = t % 176, kt = r / 11, nt = r % 11;
            tr_tile(F, NIN, (bf16_t*)(F.ws + WS_WIN) + (size_t)l * NINP * DM, DM, kt * 64, nt * 256, SmIn{F.in[I_WIN] + (size_t)l * DM * NIN}); }
        else if (t < 480) { const int q = t - 352, l = q / 64, r = q % 64, kt = r / 4, nt = r % 4;
            tr_tile(F, DM, (bf16_t*)(F.ws + WS_WOUT) + (size_t)l * DM * DM, DM, kt * 64, nt * 256, SmId{F.in[I_WOUT] + (size_t)l * DM * DM}); }
        else { const int q = t - 480, l = q / 8, r = q % 8, kt = r / 2, nt = r % 2;
            tr_tile(F, 512, (bf16_t*)(F.ws + WS_GLU) + (size_t)l * 512 * 256, 256, kt * 64, nt * 256, SmGlu{F.in[I_SGLUW] + (size_t)l * 256 * 512}); }
    }
    for (int i = F.bid * NTHR + F.tid; i < 2 * 48 * 1024; i += F.G * NTHR) { const int l = i / 49152, r = i % 49152, o = r >> 10, k = r & 1023;
        float v = 0.f; if (o < 32) v = F.in[I_WRE][((size_t)l * DM + k) * 32 + o]; else if (o < 36) v = F.in[I_WRG][((size_t)l * DM + k) * 4 + (o - 32)];
        v *= F.in[I_NORM2][l * DM + k];
        const bf16_t hi = f2bf(v); const bf16_t lo = f2bf(v - bf2f(hi));
        bf16_t* w = (bf16_t*)(F.ws + WS_WRT) + (size_t)l * 2 * 49152; w[r] = hi; w[49152 + r] = lo; }
    for (int i = F.bid * NTHR + F.tid; i < 2048 + 65536; i += F.G * NTHR) {
        if (i < 2048) {
            const int l = i >> 10, gn = i & 1023, g = gn >> 6;
            float* tab = (float*)(F.ws + WS_S5TAB + (size_t)l * S5TAB_L);
            const float lre = fminf(F.in[I_SARE][l * 1024 + gn], -1e-4f), lim = F.in[I_SAIM][l * 1024 + gn];
            const float dt = expf(F.in[I_SLOGDT][l * 16 + g]);
            const float mag = expf(dt * lre); float sn, cs; sincosf(dt * lim, &sn, &cs);
            const float are = mag * cs, aim = mag * sn;
            const float den = lre * lre + lim * lim;
            const float fre = ((are - 1.0f) * lre + aim * lim) / den, fim = (aim * lre - (are - 1.0f) * lim) / den;
            tab[gn * 2] = are; tab[gn * 2 + 1] = aim;
            float pr = are, pi = aim;
#pragma unroll
            for (int s = 0; s < 6; ++s) { const float nr = pr * pr - pi * pi, ni = 2.0f * pr * pi; pr = nr; pi = ni; }
            tab[2048 + gn * 2] = pr; tab[2048 + gn * 2 + 1] = pi;
            const float* bre = F.in[I_SBRE] + ((size_t)l * 1024 + gn) * 16; const float* bim = F.in[I_SBIM] + ((size_t)l * 1024 + gn) * 16;
            bf16_t* bbt = (bf16_t*)(F.ws + WS_S5TAB + (size_t)l * S5TAB_L + S5TAB_BBT); const int n = gn & 63, col = 4 * (n & 31) + 2 * (n >> 5);
            for (int p = 0; p < 16; ++p) { const float vr = fre * bre[p] - fim * bim[p], vi = fre * bim[p] + fim * bre[p];
                bbt[((size_t)g * 128 + col) * 16 + p] = f2bf(vr); bbt[((size_t)g * 128 + col + 1) * 16 + p] = f2bf(vi); }
        } else {
            const int j = i - 2048, l = j >> 15, r = j & 32767, gp = r >> 7, k = r & 127;
            bf16_t* cm = (bf16_t*)(F.ws + WS_S5TAB + (size_t)l * S5TAB_L + S5TAB_F);
            const int n = (k >> 2) + 32 * ((k >> 1) & 1);
            const float v = (k & 1) == 0 ? F.in[I_SCRE][((size_t)l * 256 + gp) * 64 + n] : -F.in[I_SCIM][((size_t)l * 256 + gp) * 64 + n];
            cm[r] = f2bf(v);
        }
    }
}

__device__ __forceinline__ void phase_norm(const Frame& F_, const float* xin, bool add_o, const float* w, int mode) { Frame F = relocal(F_);
    float* X = (float*)(F.ws + WS_X); bf16_t* H = (bf16_t*)(F.ws + WS_H); const bf16_t* O = (const bf16_t*)(F.ws + WS_U);
    for (int row0 = F.bid * 32 + F.wave * 4; row0 < NTOK; row0 += F.G * 32) {
        f32x4 v[4][4]; u32x2 oa[4][4], ob[4][4];
#pragma unroll
        for (int r = 0; r < 4; ++r)
#pragma unroll
            for (int j = 0; j < 4; ++j) { const int c = 4 * F.lane + 256 * j; const size_t o = (size_t)(row0 + r) * DM + c; v[r][j] = (mode == 2) ? __builtin_nontemporal_load((const f32x4*)(xin + o)) : *(const f32x4*)(xin + o);
                if (add_o) { oa[r][j] = __builtin_nontemporal_load((const u32x2*)(O + o)); ob[r][j] = __builtin_nontemporal_load((const u32x2*)(O + (size_t)NTOK * DM + o)); } }
#pragma unroll
        for (int r = 0; r < 4; ++r) { const int row = row0 + r; float ss = 0.f;
#pragma unroll
            for (int j = 0; j < 4; ++j) {
                if (add_o) { const u32x2 a = oa[r][j], b = ob[r][j];
                    v[r][j][0] += __uint_as_float(a.x << 16) + __uint_as_float(b.x << 16); v[r][j][1] += __uint_as_float(a.x & 0xffff0000u) + __uint_as_float(b.x & 0xffff0000u);
                    v[r][j][2] += __uint_as_float(a.y << 16) + __uint_as_float(b.y << 16); v[r][j][3] += __uint_as_float(a.y & 0xffff0000u) + __uint_as_float(b.y & 0xffff0000u); }
                ss += v[r][j][0] * v[r][j][0] + v[r][j][1] * v[r][j][1] + v[r][j][2] * v[r][j][2] + v[r][j][3] * v[r][j][3]; }
            ss = wave_sum(ss);
            const float rstd = rsqrtf(ss * (1.0f / DM) + 1e-6f);
#pragma unroll
            for (int j = 0; j < 4; ++j) { const int c = 4 * F.lane + 256 * j; const f32x4 wv = *(const f32x4*)(w + c);
                if (mode == 2) { __builtin_nontemporal_store(v[r][j] * rstd * wv, (f32x4*)(F.out + (size_t)row * DM + c)); }
                else { if (mode == 0) *(f32x4*)(X + (size_t)row * DM + c) = v[r][j];
                    u32x2 o; o.x = pk2(v[r][j][0] * rstd * wv[0], v[r][j][1] * rstd * wv[1]); o.y = pk2(v[r][j][2] * rstd * wv[2], v[r][j][3] * rstd * wv[3]);
                    *(u32x2*)(H + (size_t)row * DM + c) = o; } } }
    }
}

__device__ __forceinline__ void item_kv(const Frame& F_, int layer, int item) { Frame F = relocal(F_);
    const bf16_t* U = (const bf16_t*)(F.ws + WS_U);
    LAS bf16_t* Ab = (LAS bf16_t*)F.lds;
    LAS bf16_t* Bt = (LAS bf16_t*)(F.lds + 17408);
    const int t0 = item * 64;
    { const int tok = F.tid >> 3, part = F.tid & 7; const bf16_t* src = U + (size_t)(t0 + tok) * NINP + UC + 256 + 16 * part;
      float f[16]; { float a[8], b[8]; unpack8(*(const u32x4*)src, a); unpack8(*(const u32x4*)(src + 8), b);
#pragma unroll
        for (int j = 0; j < 8; ++j) { f[j] = a[j]; f[8 + j] = b[j]; } }
      float ss = 0.f;
#pragma unroll
      for (int j = 0; j < 16; ++j) ss += f[j] * f[j];
      ss = sum8(ss);
      const float rstd = rsqrtf(ss * (1.0f / 128.0f) + 1e-6f); const float* nw = F.in[I_CKVN] + layer * 128 + 16 * part;
#pragma unroll
      for (int j = 0; j < 16; j += 2) *(LAS unsigned*)(Ab + tok * 136 + 16 * part + j) = pk2(f[j] * rstd * nw[j], f[j + 1] * rstd * nw[j + 1]); }
    { const int n = F.tid >> 2, kq = F.tid & 3; const float* w = (n < 64 ? F.in[I_CWUK] : F.in[I_CWUV]) + (size_t)layer * 128 * 64 + (n & 63);
      float wv[32];
#pragma unroll
      for (int k = 0; k < 32; ++k) wv[k] = w[(size_t)(32 * kq + k) * 64];
#pragma unroll
      for (int k = 0; k < 32; k += 2) *(LAS unsigned*)(Bt + n * 136 + 32 * kq + k) = pk2(wv[k], wv[k + 1]); }
    if (F.tid < 256) { const int tok = F.tid >> 2, q = F.tid & 3;
        *(u32x4*)((bf16_t*)(F.ws + WS_KIDX) + (size_t)(t0 + tok) * 32 + 8 * q) = *(const u32x4*)(U + (size_t)(t0 + tok) * NINP + UC + 640 + 8 * q); }
    __syncthreads();
    const int mt = F.wave & 3, g = F.lane >> 4, r = F.lane & 15;
#pragma unroll
    for (int q = 0; q < 4; ++q) { const int nt = (F.wave >> 2) * 4 + q;
        f32x4 acc = (f32x4){0.f, 0.f, 0.f, 0.f};
        acc = mma_nt<128>(Ab + mt * 16 * 136, 136, Bt + nt * 16 * 136, 136, acc, F.lane);
        const int n = nt * 16 + r; bf16_t* dst = (bf16_t*)(F.ws + (n < 64 ? WS_K : WS_V));
#pragma unroll
        for (int i = 0; i < 4; ++i) dst[(size_t)(t0 + mt * 16 + 4 * g + i) * 64 + (n & 63)] = f2bf(acc[i]); }
}

constexpr int MB_CG = 0, MB_BG = 18432, MB_XT = 36864, MB_BT = 73728, MB_M = 73728, MB_S0 = 110592, MB_DT = 147456, MB_AC = 148480, MB_RS = 149504;
static_assert(MB_RS + 256 <= MISC_OFF && MB_BT == MB_XT + 4 * 64 * 72 * 2, "mamba LDS");
template <int STAGE> __device__ __forceinline__ void item_mamba(const Frame& F_, int layer, int item) { Frame F = relocal(F_);
    const bf16_t* U = (const bf16_t*)(F.ws + WS_U);
    const int b = item >> 6, c = item & 63, l0 = c * 64; const size_t T0 = (size_t)b * SEQ + l0;
    LAS bf16_t* Cg = (LAS bf16_t*)(F.lds + MB_CG); LAS bf16_t* Bg = (LAS bf16_t*)(F.lds + MB_BG); LAS bf16_t* BT = (LAS bf16_t*)(F.lds + MB_BT);
    LAS bf16_t* XT = (LAS bf16_t*)(F.lds + MB_XT); LAS bf16_t* Mb = (LAS bf16_t*)(F.lds + MB_M); LAS bf16_t* S0 = (LAS bf16_t*)(F.lds + MB_S0);
    LAS float* dts = (LAS float*)(F.lds + MB_DT); LAS float* acs = (LAS float*)(F.lds + MB_AC); LAS float* rs = (LAS float*)(F.lds + MB_RS);
    const int tg = F.tid & 7, c0 = (F.tid >> 3) * 8;
    const bool conv_on = (STAGE == 2) || (F.wave < 6);
    u32x4 rows[11]; float wv[4][8], bv[8];
    if (conv_on) {
#pragma unroll
        for (int k = 0; k < 11; ++k) { const int l = l0 + tg * 8 - 3 + k;
            if (l >= 0) rows[k] = *(const u32x4*)(U + ((size_t)b * SEQ + l) * NINP + UM + 256 + c0); else rows[k] = (u32x4){0u, 0u, 0u, 0u}; }
#pragma unroll
        for (int j = 0; j < 8; ++j) { bv[j] = F.in[I_MCONVB][layer * 512 + c0 + j];
#pragma unroll
            for (int k = 0; k < 4; ++k) wv[k][j] = F.in[I_MCONVW][(layer * 4 + k) * 512 + c0 + j]; } }
    const float* MSTi = (const float*)(F.ws + WS_MST) + ((size_t)(b * 64 + c) * 4) * 4096;
    f32x4 s0a[4], s0b[4];
    if (STAGE == 2) {
#pragma unroll
        for (int h = 0; h < 4; ++h) { const float* src = MSTi + (size_t)h * 4096 + F.tid * 8; s0a[h] = *(const f32x4*)src; s0b[h] = *(const f32x4*)(src + 4); } }
    if (F.wave < 4) { const int l = F.lane, h = F.wave;
        const float raw = bf2f(U[(T0 + l) * NINP + UM + 768 + h]) + F.in[I_MDTB][layer * 4 + h];
        const float dt = softplusf_(raw); float cum = -__expf(F.in[I_MALOG][layer * 4 + h]) * dt;
#pragma unroll
        for (int o = 1; o < 64; o <<= 1) { const float t = __int_as_float(__builtin_amdgcn_ds_bpermute(((lane_id_() - o) & 63) << 2, __float_as_int(cum))); if (l >= o) cum += t; }
        dts[l * 4 + h] = dt; acs[l * 4 + h] = cum; }
    if (STAGE == 2) { if (F.tid < 64) rs[F.tid] = 0.f;
#pragma unroll
        for (int h = 0; h < 4; ++h) { u32x4 w; w.x = pk2(s0a[h][0], s0a[h][1]); w.y = pk2(s0a[h][2], s0a[h][3]); w.z = pk2(s0b[h][0], s0b[h][1]); w.w = pk2(s0b[h][2], s0b[h][3]);
            *(LAS u32x4*)(S0 + (h * 64 + (F.tid >> 3)) * 72 + (F.tid & 7) * 8) = w; } }
    __syncthreads();
    if (conv_on) {
        float win[3][8]; unpack8(rows[0], win[0]); unpack8(rows[1], win[1]); unpack8(rows[2], win[2]);
        const bool isx = F.wave < 4, tr = isx || STAGE == 1;
        unsigned pkT[8][4]; float prev[8];
#pragma unroll
        for (int i = 0; i < 8; ++i) { const int l = tg * 8 + i; float cur[8]; unpack8(rows[3 + i], cur);
            float o[8];
#pragma unroll
            for (int j = 0; j < 8; ++j) { o[j] = siluf_(bv[j] + wv[0][j] * win[0][j] + wv[1][j] * win[1][j] + wv[2][j] * win[2][j] + wv[3][j] * cur[j]);
                win[0][j] = win[1][j]; win[1][j] = win[2][j]; win[2][j] = cur[j]; }
            if (isx) { const int h = F.wave; float sc = dts[l * 4 + h]; if (STAGE == 1) sc *= __expf(acs[63 * 4 + h] - acs[l * 4 + h]);
#pragma unroll
                for (int j = 0; j < 8; ++j) o[j] *= sc; }
            if (tr) {
#pragma unroll
                for (int j = 0; j < 8; ++j) { if (i & 1) pkT[j][i >> 1] = pk2(prev[j], o[j]); else prev[j] = o[j]; } }
            else { u32x4 w; w.x = pk2(o[0], o[1]); w.y = pk2(o[2], o[3]); w.z = pk2(o[4], o[5]); w.w = pk2(o[6], o[7]);
                *(LAS u32x4*)(Cg + (F.wave < 6 ? (MB_BG - MB_CG) / 2 : 0) + ((F.wave & 1) * 64 + l) * 72 + (c0 & 63)) = w; } }
        if (tr) { LAS bf16_t* dstT = XT + F.wave * 64 * 72;
#pragma unroll
            for (int j = 0; j < 8; ++j) *(LAS u32x4*)(dstT + ((c0 & 63) + j) * 72 + tg * 8) = (u32x4){pkT[j][0], pkT[j][1], pkT[j][2], pkT[j][3]}; } }
    const int g4 = F.lane >> 4, r16 = F.lane & 15;
    if (STAGE == 1) {
        __syncthreads();
        float* MST = (float*)(F.ws + WS_MST) + ((size_t)(b * 64 + c) * 4) * 4096;
#pragma unroll
        for (int q = 0; q < 8; ++q) { const int tix = F.wave * 8 + q, h = tix >> 4, mt = (tix >> 2) & 3, nt = tix & 3;
            f32x4 acc = (f32x4){0.f, 0.f, 0.f, 0.f};
            acc = mma_nt<64>(XT + (h * 64 + mt * 16) * 72, 72, BT + ((h >> 1) * 64 + nt * 16) * 72, 72, acc, F.lane);
#pragma unroll
            for (int i = 0; i < 4; ++i) MST[(size_t)h * 4096 + (mt * 16 + 4 * g4 + i) * 64 + nt * 16 + r16] = acc[i]; }
        if (F.tid < 4) ((float*)(F.ws + WS_MDEC))[(b * 64 + c) * 4 + F.tid] = __expf(acs[63 * 4 + F.tid]);
    } else {
        const int mt = F.wave & 3, nh = F.wave >> 2;
        bf16_t zz[4][2][4];
#pragma unroll
        for (int h = 0; h < 4; ++h)
#pragma unroll
            for (int q = 0; q < 2; ++q)
#pragma unroll
                for (int i = 0; i < 4; ++i) zz[h][q][i] = U[(T0 + mt * 16 + 4 * g4 + i) * NINP + UM + h * 64 + (2 * nh + q) * 16 + r16];
        __syncthreads();
        f32x4 yv[4][2];
#pragma unroll
        for (int g = 0; g < 2; ++g)
#pragma unroll
            for (int q = 0; q < 2; ++q) { f32x4 G = (f32x4){0.f, 0.f, 0.f, 0.f};
                G = mma_nt<64>(Cg + (g * 64 + mt * 16) * 72, 72, Bg + (g * 64 + (2 * nh + q) * 16) * 72, 72, G, F.lane);
                const int s = (2 * nh + q) * 16 + r16;
#pragma unroll
                for (int hh = 0; hh < 2; ++hh) { const int h = 2 * g + hh; const float as = acs[s * 4 + h];
#pragma unroll
                    for (int i = 0; i < 4; ++i) { const int l = mt * 16 + 4 * g4 + i; const float v = (s <= l) ? G[i] * __expf(acs[l * 4 + h] - as) : 0.f;
                        Mb[(h * 64 + l) * 72 + s] = f2bf(v); } } }
        __syncthreads();
#pragma unroll
        for (int h = 0; h < 4; ++h) { const int g = h >> 1;
#pragma unroll
            for (int q = 0; q < 2; ++q) { const int nt = 2 * nh + q;
                f32x4 yd = (f32x4){0.f, 0.f, 0.f, 0.f}, yo = (f32x4){0.f, 0.f, 0.f, 0.f};
                yd = mma_nt<64>(Mb + (h * 64 + mt * 16) * 72, 72, XT + (h * 64 + nt * 16) * 72, 72, yd, F.lane);
                yo = mma_nt<64>(Cg + (g * 64 + mt * 16) * 72, 72, S0 + (h * 64 + nt * 16) * 72, 72, yo, F.lane);
                const int p = nt * 16 + r16; const float dsk = F.in[I_MD][layer * 4 + h];
#pragma unroll
                for (int i = 0; i < 4; ++i) { const int l = mt * 16 + 4 * g4 + i;
                    const float xs = bf2f(XT[(h * 64 + p) * 72 + l]) / dts[l * 4 + h];
                    yv[h][q][i] = yd[i] + yo[i] * __expf(acs[l * 4 + h]) + dsk * xs; } } }
        float part[4] = {0.f, 0.f, 0.f, 0.f};
#pragma unroll
        for (int h = 0; h < 4; ++h)
#pragma unroll
            for (int q = 0; q < 2; ++q) {
#pragma unroll
                for (int i = 0; i < 4; ++i) { const float z = bf2f(zz[h][q][i]);
                    const float v = yv[h][q][i] * siluf_(z); yv[h][q][i] = v; part[i] += v * v; } }
#pragma unroll
        for (int i = 0; i < 4; ++i) { const float s = sum16(part[i]); if (r16 == 0) atomicAdd((float*)(rs + mt * 16 + 4 * g4 + i), s); }
        __syncthreads();
        bf16_t* Y = (bf16_t*)(F.ws + WS_H);
#pragma unroll
        for (int i = 0; i < 4; ++i) { const int l = mt * 16 + 4 * g4 + i; const float rstd = rsqrtf(rs[l] * (1.0f / 256.0f) + 1e-6f);
#pragma unroll
            for (int h = 0; h < 4; ++h)
#pragma unroll
                for (int q = 0; q < 2; ++q) { const int ch = h * 64 + (2 * nh + q) * 16 + r16;
                    Y[(T0 + l) * DM + ch] = f2bf(yv[h][q][i] * rstd * F.in[I_MNORM][layer * 256 + ch]); } }
    }
}
__device__ __forceinline__ void item_mamba_carry(const Frame& F_, int item) { Frame F = relocal(F_);
    const int b = item >> 2, h = item & 3;
    float* MST = (float*)(F.ws + WS_MST); const float* MD = (const float*)(F.ws + WS_MDEC);
    float s[8];
#pragma unroll
    for (int j = 0; j < 8; ++j) s[j] = 0.f;
    for (int c = 0; c < 64; ++c) { float* p = MST + ((size_t)(b * 64 + c) * 4 + h) * 4096 + F.tid * 8; const float d = MD[(b * 64 + c) * 4 + h];
        const f32x4 a = *(f32x4*)p, q = *(f32x4*)(p + 4);
        *(f32x4*)p = (f32x4){s[0], s[1], s[2], s[3]}; *(f32x4*)(p + 4) = (f32x4){s[4], s[5], s[6], s[7]};
        s[0] = s[0] * d + a[0]; s[1] = s[1] * d + a[1]; s[2] = s[2] * d + a[2]; s[3] = s[3] * d + a[3];
        s[4] = s[4] * d + q[0]; s[5] = s[5] * d + q[1]; s[6] = s[6] * d + q[2]; s[7] = s[7] * d + q[3]; }
}

template <int STAGE> __device__ __forceinline__ void item_s5(const Frame& F_, int layer, int item) { Frame F = relocal(F_);
    const bf16_t* U = (const bf16_t*)(F.ws + WS_U);
    const int b = item >> 6, c = item & 63; const size_t T0 = (size_t)b * SEQ + c * 64;
    LAS bf16_t* us = (LAS bf16_t*)F.lds;
    LAS bf16_t* BuW = (LAS bf16_t*)(F.lds + 33792) + F.wave * 4224;
    const float* tab = (const float*)(F.ws + WS_S5TAB + (size_t)layer * S5TAB_L);
    { const int tok = F.tid >> 3, part = F.tid & 7;
#pragma unroll
      for (int q = 0; q < 4; ++q) *(LAS u32x4*)(us + tok * 264 + 32 * part + 8 * q) = *(const u32x4*)(U + (T0 + tok) * NINP + US + 32 * part + 8 * q); }
    const int lane = F.lane, r16 = lane & 15, g4 = lane >> 4, gq = lane >> 5, n0 = lane & 31, g = 2 * F.wave + gq, gn0 = g * 64 + n0, gn1 = gn0 + 32;
    bf16x8 bfr[2][8];
    { const bf16_t* bbt = (const bf16_t*)(F.ws + WS_S5TAB + (size_t)layer * S5TAB_L + S5TAB_BBT);
#pragma unroll
      for (int gg = 0; gg < 2; ++gg)
#pragma unroll
          for (int nt = 0; nt < 8; ++nt) { u32x4 z = (u32x4){0u, 0u, 0u, 0u}; if (g4 < 2) z = *(const u32x4*)(bbt + ((size_t)(2 * F.wave + gg) * 128 + 16 * nt + r16) * 16 + 8 * g4); bfr[gg][nt] = __builtin_bit_cast(bf16x8, z); } }
    const float a0r = tab[gn0 * 2], a0i = tab[gn0 * 2 + 1], a1r = tab[gn1 * 2], a1i = tab[gn1 * 2 + 1];
    float* ST = (float*)(F.ws + WS_S5ST) + (size_t)(b * 64 + c) * 2048;
    float h0r = 0.f, h0i = 0.f, h1r = 0.f, h1i = 0.f;
    if (STAGE == 2) { h0r = ST[gn0 * 2]; h0i = ST[gn0 * 2 + 1]; h1r = ST[gn1 * 2]; h1i = ST[gn1 * 2 + 1]; }
    bf16x8 cf[2][4];
    if (STAGE == 2) { const bf16_t* cm = (const bf16_t*)(F.ws + WS_S5TAB + (size_t)layer * S5TAB_L + S5TAB_F);
#pragma unroll
        for (int gg = 0; gg < 2; ++gg)
#pragma unroll
            for (int ks = 0; ks < 4; ++ks) cf[gg][ks] = *(const bf16x8*)(cm + ((size_t)((2 * F.wave + gg) * 16 + r16)) * 128 + 32 * ks + 8 * g4); }
    LAS bf16_t* YSl = (LAS bf16_t*)(F.lds + 101376);
    const bf16_t* GW = (const bf16_t*)(F.ws + WS_GLU) + (size_t)layer * 512 * 256;
    float dsk[2] = {0.f, 0.f}, bvl[2] = {0.f, 0.f}, bgt[2] = {0.f, 0.f}; bf16x8 gwb[2][4];
    if (STAGE == 2) {
#pragma unroll
        for (int gg = 0; gg < 2; ++gg) dsk[gg] = F.in[I_SD][layer * 256 + (2 * F.wave + gg) * 16 + r16];
#pragma unroll
        for (int q = 0; q < 2; ++q) { const int c = 32 * F.wave + 16 * q + r16; bvl[q] = F.in[I_SGLUB][layer * 512 + c]; bgt[q] = F.in[I_SGLUB][layer * 512 + 256 + c]; }
#pragma unroll
        for (int ks = 0; ks < 2; ++ks)
#pragma unroll
            for (int q = 0; q < 2; ++q) { const int c = 32 * F.wave + 16 * q + r16; const int rowv = 256 * (c >> 7) + (c & 127);
                gwb[ks][2 * q] = *(const bf16x8*)(GW + (size_t)rowv * 256 + 32 * ks + 8 * g4); gwb[ks][2 * q + 1] = *(const bf16x8*)(GW + (size_t)(rowv + 128) * 256 + 32 * ks + 8 * g4); } }
    __syncthreads();
#pragma unroll 1
    for (int lb = 0; lb < 4; ++lb) {
#pragma unroll
        for (int gg = 0; gg < 2; ++gg) { u32x4 z = (u32x4){0u, 0u, 0u, 0u}; if (g4 < 2) z = *(const LAS u32x4*)(us + (16 * lb + r16) * 264 + (2 * F.wave + gg) * 16 + 8 * g4);
            const bf16x8 afr = __builtin_bit_cast(bf16x8, z);
#pragma unroll
            for (int nt = 0; nt < 8; ++nt) { const f32x4 acc = __builtin_amdgcn_mfma_f32_16x16x32_bf16(afr, bfr[gg][nt], (f32x4){0.f, 0.f, 0.f, 0.f}, 0, 0, 0);
#pragma unroll
                for (int i = 0; i < 4; ++i) BuW[(4 * g4 + i) * 264 + gg * 128 + 16 * nt + r16] = f2bf(acc[i]); } }
        __syncthreads();
#pragma unroll 4
        for (int li = 0; li < 16; ++li) { LAS u32x2* bp = (LAS u32x2*)(BuW + li * 264 + gq * 128 + 4 * n0); const u32x2 v = *bp;
            { const float br = __uint_as_float(v.x << 16), bi = __uint_as_float(v.x & 0xffff0000u); const float nr = a0r * h0r - a0i * h0i + br, ni = a0r * h0i + a0i * h0r + bi; h0r = nr; h0i = ni; }
            { const float br = __uint_as_float(v.y << 16), bi = __uint_as_float(v.y & 0xffff0000u); const float nr = a1r * h1r - a1i * h1i + br, ni = a1r * h1i + a1i * h1r + bi; h1r = nr; h1i = ni; }
            if (STAGE == 2) *bp = (u32x2){pk2(h0r, h0i), pk2(h1r, h1i)}; }
        __syncthreads();
        if (STAGE == 2) {
#pragma unroll
            for (int gg = 0; gg < 2; ++gg) { f32x4 acc = (f32x4){0.f, 0.f, 0.f, 0.f};
#pragma unroll
                for (int ks = 0; ks < 4; ++ks) { const bf16x8 a = *(const LAS bf16x8*)(BuW + r16 * 264 + gg * 128 + 32 * ks + 8 * g4);
                    acc = __builtin_amdgcn_mfma_f32_16x16x32_bf16(a, cf[gg][ks], acc, 0, 0, 0); }
                const int ch = (2 * F.wave + gg) * 16 + r16;
#pragma unroll
                for (int i = 0; i < 4; ++i) { const int l = lb * 16 + 4 * g4 + i; const float y = acc[i] + dsk[gg] * bf2f(us[l * 264 + ch]);
                    YSl[l * 264 + ch] = f2bf(gelu_tanh(y)); } }
            __syncthreads();
        }
    }
    if (STAGE == 1) { ST[gn0 * 2] = h0r; ST[gn0 * 2 + 1] = h0i; ST[gn1 * 2] = h1r; ST[gn1 * 2 + 1] = h1i; }
    if (STAGE == 2) {
        f32x4 av[4][2], ag[4][2];
#pragma unroll
        for (int m = 0; m < 4; ++m)
#pragma unroll
            for (int q = 0; q < 2; ++q) { av[m][q] = (f32x4){0.f, 0.f, 0.f, 0.f}; ag[m][q] = (f32x4){0.f, 0.f, 0.f, 0.f}; }
#pragma unroll
        for (int ks = 0; ks < 8; ++ks) {
            bf16x8 af[4], bcur[4];
#pragma unroll
            for (int j = 0; j < 4; ++j) bcur[j] = gwb[ks & 1][j];
            if (ks + 2 < 8) {
#pragma unroll
                for (int q = 0; q < 2; ++q) { const int c = 32 * F.wave + 16 * q + r16; const int rowv = 256 * (c >> 7) + (c & 127);
                    gwb[ks & 1][2 * q] = *(const bf16x8*)(GW + (size_t)rowv * 256 + 32 * (ks + 2) + 8 * g4); gwb[ks & 1][2 * q + 1] = *(const bf16x8*)(GW + (size_t)(rowv + 128) * 256 + 32 * (ks + 2) + 8 * g4); } }
#pragma unroll
            for (int m = 0; m < 4; ++m) af[m] = *(const LAS bf16x8*)(YSl + (16 * m + r16) * 264 + 32 * ks + 8 * g4);
#pragma unroll
            for (int m = 0; m < 4; ++m)
#pragma unroll
                for (int q = 0; q < 2; ++q) { av[m][q] = __builtin_amdgcn_mfma_f32_16x16x32_bf16(af[m], bcur[2 * q], av[m][q], 0, 0, 0); ag[m][q] = __builtin_amdgcn_mfma_f32_16x16x32_bf16(af[m], bcur[2 * q + 1], ag[m][q], 0, 0, 0); }
        }
        bf16_t* Y = (bf16_t*)(F.ws + WS_H);
#pragma unroll
        for (int q = 0; q < 2; ++q) { const int c = 32 * F.wave + 16 * q + r16;
#pragma unroll
            for (int m = 0; m < 4; ++m)
#pragma unroll
                for (int i = 0; i < 4; ++i) Y[(T0 + 16 * m + 4 * g4 + i) * DM + 768 + c] = f2bf((av[m][q][i] + bvl[q]) * sigmoidf_(ag[m][q][i] + bgt[q])); }
    }
}
__device__ __forceinline__ void item_s5_carry(const Frame& F_, int layer, int b) { Frame F = relocal(F_);
    const float* tab = (const float*)(F.ws + WS_S5TAB + (size_t)layer * S5TAB_L) + 2048;
    float* ST = (float*)(F.ws + WS_S5ST) + (size_t)b * 64 * 2048;
#pragma unroll
    for (int q = 0; q < 2; ++q) { const int gn = F.tid + 512 * q; const float pr = tab[gn * 2], pi = tab[gn * 2 + 1]; float hr = 0.f, hi = 0.f;
        for (int c = 0; c < 64; ++c) { float* p = ST + (size_t)c * 2048 + gn * 2; const float tr = p[0], ti = p[1]; p[0] = hr; p[1] = hi;
            const float nr = pr * hr - pi * hi + tr, ni = pr * hi + pi * hr + ti; hr = nr; hi = ni; } }
}

constexpr int RB_LD = 72;
constexpr int RW_R = 0, RW_K = 16384, RW_V = 32768, RW_W = 49152, RW_A = 65536, RW_B = 81920;
constexpr int R3_G = 49152, R3_O = 65536, R3_TILES = 81920, R3_BON = 147456;
template <int STAGE> __device__ __forceinline__ void rwkv_prep(const Frame& F_, int layer, int b, int h, int c) { Frame F = relocal(F_);
    const bf16_t* U = (const bf16_t*)(F.ws + WS_U);
    const int l0 = c * 64; const size_t T0 = (size_t)b * SEQ + l0;
    LAS float* Rr = (LAS float*)(F.lds + RW_R); LAS float* Kk = (LAS float*)(F.lds + RW_K); LAS float* Vv = (LAS float*)(F.lds + RW_V); LAS float* Ww = (LAS float*)(F.lds + RW_W);
    LAS float* Aa = (LAS float*)(F.lds + (STAGE == 1 ? RW_A : R3_O)); LAS float* Bb = (LAS float*)(F.lds + RW_B); LAS float* Gg = (LAS float*)(F.lds + R3_G); LAS float* BON = (LAS float*)(F.lds + R3_BON);
    LAS bf16_t* TWb = (LAS bf16_t*)(F.lds + 98304); LAS bf16_t* DAb = (LAS bf16_t*)(F.lds + (STAGE == 1 ? 103424 : 118784)); LAS bf16_t* SGb = (LAS bf16_t*)(F.lds + 123904);
    LAS bf16_t* w2T = (LAS bf16_t*)(F.lds + 108544); LAS bf16_t* a2T = (LAS bf16_t*)(F.lds + (STAGE == 1 ? 113664 : 133120)); LAS bf16_t* g2T = (LAS bf16_t*)(F.lds + 138240);
    const float* mu = F.in[I_RMU] + layer * 896;
    float pw0[2] = {0.f, 0.f}, pa0[2] = {0.f, 0.f}; f32x4 pkkw[2], pkaw[2], prk[2];
    if (STAGE == 1) { const int cgl = layer * 256 + h * 64 + 8 * (F.tid & 7);
#pragma unroll
        for (int q = 0; q < 2; ++q) { pkkw[q] = *(const f32x4*)(F.in[I_RKK] + cgl + 4 * q); pkaw[q] = *(const f32x4*)(F.in[I_RKA] + cgl + 4 * q); prk[q] = *(const f32x4*)(F.in[I_RRK] + cgl + 4 * q); }
#pragma unroll
        for (int q = 0; q < 2; ++q) { const int cg = layer * 256 + h * 64 + 16 * (2 * (F.wave & 1) + q) + (F.lane & 15); pw0[q] = F.in[I_RW0][cg]; pa0[q] = F.in[I_RA0][cg]; } }
    { const int tok = F.tid >> 3, p8 = F.tid & 7; const bool first = (l0 + tok == 0);
      const bf16_t* cur = U + (T0 + tok) * NINP + UR; const bf16_t* prv = first ? cur : cur - NINP;
      const float pz = first ? 0.f : 1.f;
      u32x4 cw[3], pw[3]; u32x2 c1 = (u32x2){0u, 0u}, p1 = (u32x2){0u, 0u}, c2 = (u32x2){0u, 0u}, p2 = (u32x2){0u, 0u}; u32x4 c3 = (u32x4){0u, 0u, 0u, 0u}, p3 = (u32x4){0u, 0u, 0u, 0u};
#pragma unroll
      for (int sec = (STAGE == 1 ? 0 : 2); sec < 3; ++sec) { const int co = sec * 256 + h * 64 + 8 * p8; cw[sec] = *(const u32x4*)(cur + co); pw[sec] = *(const u32x4*)(prv + co); }
      if (STAGE == 1) { c1 = *(const u32x2*)(cur + 768 + 4 * p8); p1 = *(const u32x2*)(prv + 768 + 4 * p8); c2 = *(const u32x2*)(cur + 800 + 4 * p8); p2 = *(const u32x2*)(prv + 800 + 4 * p8); }
      if (STAGE == 3) { c3 = *(const u32x4*)(cur + 832 + 8 * p8); p3 = *(const u32x4*)(prv + 832 + 8 * p8); }
#pragma unroll
      for (int sec = (STAGE == 1 ? 0 : 2); sec < 3; ++sec) { const int co = sec * 256 + h * 64 + 8 * p8; float av[8], pq[8]; unpack8(cw[sec], av); unpack8(pw[sec], pq);
          const f32x4 m0 = *(const f32x4*)(mu + co), m1 = *(const f32x4*)(mu + co + 4);
          LAS float* dst = (sec == 0 ? Rr : sec == 1 ? Kk : Vv) + tok * 64 + 8 * p8;
#pragma unroll
          for (int j = 0; j < 8; ++j) pq[j] *= pz;
          *(LAS f32x4*)dst = (f32x4){av[0] + m0[0] * (pq[0] - av[0]), av[1] + m0[1] * (pq[1] - av[1]), av[2] + m0[2] * (pq[2] - av[2]), av[3] + m0[3] * (pq[3] - av[3])};
          *(LAS f32x4*)(dst + 4) = (f32x4){av[4] + m1[0] * (pq[4] - av[4]), av[5] + m1[1] * (pq[5] - av[5]), av[6] + m1[2] * (pq[6] - av[6]), av[7] + m1[3] * (pq[7] - av[7])}; }
      if (STAGE == 1) {
#pragma unroll
        for (int which = 0; which < 2; ++which) { const int co = 768 + 32 * which + 4 * p8; const u32x2 cv = which ? c2 : c1, pv = which ? p2 : p1;
          const f32x4 m0 = *(const f32x4*)(mu + co);
          float x[4] = {__uint_as_float(cv.x << 16), __uint_as_float(cv.x & 0xffff0000u), __uint_as_float(cv.y << 16), __uint_as_float(cv.y & 0xffff0000u)};
          const float y[4] = {pz * __uint_as_float(pv.x << 16), pz * __uint_as_float(pv.x & 0xffff0000u), pz * __uint_as_float(pv.y << 16), pz * __uint_as_float(pv.y & 0xffff0000u)};
#pragma unroll
          for (int j = 0; j < 4; ++j) { x[j] = x[j] + m0[j] * (y[j] - x[j]); if (which == 0) x[j] = tanhf_(x[j]); }
          *(LAS u32x2*)((which ? DAb : TWb) + tok * 40 + 4 * p8) = (u32x2){pk2(x[0], x[1]), pk2(x[2], x[3])}; } }
      if (STAGE == 3) { const int co = 832 + 8 * p8; float av[8], pq[8]; unpack8(c3, av); unpack8(p3, pq);
          const f32x4 m0 = *(const f32x4*)(mu + co), m1 = *(const f32x4*)(mu + co + 4); float x[8];
#pragma unroll
          for (int j = 0; j < 8; ++j) x[j] = sigmoidf_(av[j] + (j < 4 ? m0[j] : m1[j - 4]) * (pz * pq[j] - av[j]));
          *(LAS u32x4*)(SGb + tok * RB_LD + 8 * p8) = (u32x4){pk2(x[0], x[1]), pk2(x[2], x[3]), pk2(x[4], x[5]), pk2(x[6], x[7])}; } }
    { const int ch = F.tid & 63, part = F.tid >> 6;
      if (STAGE == 1) { const float* w2 = F.in[I_RW2] + ((size_t)layer * 32 + 4 * part) * 256 + h * 64 + ch;
          *(LAS u32x2*)(w2T + ch * 40 + 4 * part) = (u32x2){pk2(w2[0], w2[256]), pk2(w2[512], w2[768])}; }
      if (STAGE == 1) { const float* a2 = F.in[I_RA2] + ((size_t)layer * 32 + 4 * part) * 256 + h * 64 + ch;
          *(LAS u32x2*)(a2T + ch * 40 + 4 * part) = (u32x2){pk2(a2[0], a2[256]), pk2(a2[512], a2[768])}; }
      if (STAGE == 3) { const float* g2 = F.in[I_RG2] + ((size_t)layer * 64 + 8 * part) * 256 + h * 64 + ch;
          *(LAS u32x4*)(g2T + ch * RB_LD + 8 * part) = (u32x4){pk2(g2[0], g2[256]), pk2(g2[512], g2[768]), pk2(g2[1024], g2[1280]), pk2(g2[1536], g2[1792])}; } }
    __syncthreads();
    { const int lane = F.lane, mt = F.wave >> 1, nt0 = 2 * (F.wave & 1), r = lane & 15, g4 = lane >> 4; const f32x4 zero4 = (f32x4){0.f, 0.f, 0.f, 0.f};
#pragma unroll
      for (int q = 0; q < 2; ++q) { const int nt = nt0 + q, ch = 16 * nt + r;
          if (STAGE == 1) { const f32x4 wl = mma_nt<32>(TWb + 16 * mt * 40, 40, w2T + 16 * nt * 40, 40, zero4, lane); const float w0 = pw0[q];
#pragma unroll
              for (int i = 0; i < 4; ++i) { const float x = w0 + wl[i]; const float wlog = -__logf(1.0f + __expf(-x)) - 0.5f; Ww[(16 * mt + 4 * g4 + i) * 64 + ch] = __expf(-__expf(wlog)); } }
          if (STAGE == 1) { const f32x4 al = mma_nt<32>(DAb + 16 * mt * 40, 40, a2T + 16 * nt * 40, 40, zero4, lane); const float a0 = pa0[q];
#pragma unroll
              for (int i = 0; i < 4; ++i) Aa[(16 * mt + 4 * g4 + i) * 64 + ch] = sigmoidf_(a0 + al[i]); }
          if (STAGE == 3) { const f32x4 gv = mma_nt<64>(SGb + 16 * mt * RB_LD, RB_LD, g2T + 16 * nt * RB_LD, RB_LD, zero4, lane);
#pragma unroll
              for (int i = 0; i < 4; ++i) Gg[(16 * mt + 4 * g4 + i) * 64 + ch] = gv[i]; } } }
    __syncthreads();
    float* gBON = (float*)(F.ws + WS_BON) + ((size_t)(b * 4 + h) * 64 + c) * 64;
    if (STAGE == 1) { const int t = F.tid >> 3, p8 = F.tid & 7;
      LAS float* pa = Aa + t * 64 + 8 * p8; LAS float* pk = Kk + t * 64 + 8 * p8; LAS float* pr = Rr + t * 64 + 8 * p8; LAS float* pb = Bb + t * 64 + 8 * p8;
      float kp[8], kkv[8], av[8]; float ss = 0.f, bo = 0.f;
#pragma unroll
      for (int q = 0; q < 2; ++q) { const f32x4 a4 = *(const LAS f32x4*)(pa + 4 * q), k4 = *(const LAS f32x4*)(pk + 4 * q), r4 = *(const LAS f32x4*)(pr + 4 * q);
#pragma unroll
          for (int j = 0; j < 4; ++j) { const float a = a4[j], kraw = k4[j]; av[4 * q + j] = a; kp[4 * q + j] = kraw * (1.0f + (a - 1.0f) * pkaw[q][j]);
              kkv[4 * q + j] = kraw * pkkw[q][j]; ss += kkv[4 * q + j] * kkv[4 * q + j]; bo += r4[j] * kp[4 * q + j] * prk[q][j]; } }
      ss = sum8(ss); bo = sum8(bo);
      const float rn = rsqrtf(fmaxf(ss, 1e-24f));
#pragma unroll
      for (int q = 0; q < 2; ++q) { f32x4 ko, ao, bq;
#pragma unroll
          for (int j = 0; j < 4; ++j) { const float kkn = kkv[4 * q + j] * rn; ko[j] = kp[4 * q + j]; ao[j] = -kkn; bq[j] = kkn * av[4 * q + j]; }
          *(LAS f32x4*)(pk + 4 * q) = ko; *(LAS f32x4*)(pa + 4 * q) = ao; *(LAS f32x4*)(pb + 4 * q) = bq; }
      if (p8 == 0) gBON[t] = bo; }
    else if (F.tid < 64) BON[F.tid] = gBON[F.tid];
    __syncthreads();
}
constexpr int RB_AT = 98304, RB_ATT = RB_AT + 9216, RB_BT = RB_ATT + 9216, RB_BTT = RB_BT + 9216, RB_KT = RB_BTT + 9216, RB_RT = RB_KT + 9216, RB_VT = RB_RT + 9216, RB_GC = RB_VT + 9216;
constexpr int RX_X = 0, RX_XT = 9216, RX_TB = 18432, RX_M = 27648, RX_NRT = 36864, RX_G1T = 46080, RX_G2T = 55296, RX_QT = 64512;
__device__ __forceinline__ void st_tile(LAS bf16_t* dst, int mt, int nt, const f32x4 v, int lane) {
    const int r = lane & 15, g = lane >> 4;
#pragma unroll
    for (int i = 0; i < 4; ++i) dst[(16 * mt + 4 * g + i) * RB_LD + 16 * nt + r] = f2bf(v[i]);
}
__device__ __forceinline__ void st_tile_t(LAS bf16_t* dst, int mt, int nt, const f32x4 v, int lane) {
    const int r = lane & 15, g = lane >> 4; u32x2 w; w.x = pk2(v[0], v[1]); w.y = pk2(v[2], v[3]);
    *(LAS u32x2*)(dst + (16 * nt + r) * RB_LD + 16 * mt + 4 * g) = w;
}
__device__ __forceinline__ void item_rwkv1(const Frame& F_, int layer, int item) { Frame F = relocal(F_);
    const int b = item >> 8, h = (item >> 6) & 3, c = item & 63;
    rwkv_prep<1>(F, layer, b, h, c);
    LAS float* Rr = (LAS float*)(F.lds + RW_R); LAS float* Kk = (LAS float*)(F.lds + RW_K); LAS float* Vv = (LAS float*)(F.lds + RW_V); LAS float* Ww = (LAS float*)(F.lds + RW_W);
    LAS float* Aa = (LAS float*)(F.lds + RW_A); LAS float* Bb = (LAS float*)(F.lds + RW_B);
    LAS bf16_t* At = (LAS bf16_t*)(F.lds + RB_AT); LAS bf16_t* AtT = (LAS bf16_t*)(F.lds + RB_ATT); LAS bf16_t* Bt = (LAS bf16_t*)(F.lds + RB_BT); LAS bf16_t* BtT = (LAS bf16_t*)(F.lds + RB_BTT);
    LAS bf16_t* Kt = (LAS bf16_t*)(F.lds + RB_KT); LAS bf16_t* Rt = (LAS bf16_t*)(F.lds + RB_RT); LAS bf16_t* VT = (LAS bf16_t*)(F.lds + RB_VT); LAS float* gC = (LAS float*)(F.lds + RB_GC);
    LAS bf16_t* X = (LAS bf16_t*)(F.lds + RX_X); LAS bf16_t* XT = (LAS bf16_t*)(F.lds + RX_XT); LAS bf16_t* Tb = (LAS bf16_t*)(F.lds + RX_TB); LAS bf16_t* Mm = (LAS bf16_t*)(F.lds + RX_M);
    LAS bf16_t* NrT = (LAS bf16_t*)(F.lds + RX_NRT); LAS bf16_t* G1T = (LAS bf16_t*)(F.lds + RX_G1T); LAS bf16_t* G2T = (LAS bf16_t*)(F.lds + RX_G2T); LAS bf16_t* QT = (LAS bf16_t*)(F.lds + RX_QT);
    { const int k = F.tid & 63, part = F.tid >> 6; float g = 1.0f;
      for (int pp = 0; pp < part; ++pp) { float w8[8];
#pragma unroll
          for (int i = 0; i < 8; ++i) w8[i] = Ww[(8 * pp + i) * 64 + k];
          g *= ((w8[0] * w8[1]) * (w8[2] * w8[3])) * ((w8[4] * w8[5]) * (w8[6] * w8[7])); }
#pragma unroll
      for (int i = 0; i < 8; ++i) { const int t = 8 * part + i; const float gp = g; g *= Ww[t * 64 + k]; const float ig = 1.0f / g;
          const bf16_t av = f2bf(Aa[t * 64 + k] * gp), bv = f2bf(Bb[t * 64 + k] * ig);
          At[t * RB_LD + k] = av; AtT[k * RB_LD + t] = av; Bt[t * RB_LD + k] = bv; BtT[k * RB_LD + t] = bv;
          Kt[t * RB_LD + k] = f2bf(Kk[t * 64 + k] * ig); Rt[t * RB_LD + k] = f2bf(Rr[t * 64 + k] * g); VT[k * RB_LD + t] = f2bf(Vv[t * 64 + k]); }
      if (part == 7) gC[k] = g; }
    __syncthreads();
    const int lane = F.lane, mt = F.wave >> 1, nt0 = 2 * (F.wave & 1), r = lane & 15, g4 = lane >> 4;
    const f32x4 zero4 = (f32x4){0.f, 0.f, 0.f, 0.f};
    f32x4 Tacc[2];
#pragma unroll
    for (int q = 0; q < 2; ++q) { const int nt = nt0 + q;
        f32x4 n = mma_nt<64>(Bt + 16 * mt * RB_LD, RB_LD, At + 16 * nt * RB_LD, RB_LD, zero4, lane);
        f32x4 m = mma_nt<64>(Kt + 16 * mt * RB_LD, RB_LD, At + 16 * nt * RB_LD, RB_LD, zero4, lane);
        f32x4 nr = mma_nt<64>(Rt + 16 * mt * RB_LD, RB_LD, Bt + 16 * nt * RB_LD, RB_LD, zero4, lane);
#pragma unroll
        for (int i = 0; i < 4; ++i) { const int row = 16 * mt + 4 * g4 + i, col = 16 * nt + r;
            n[i] = (row < col) ? n[i] : 0.f; m[i] = (row < col) ? m[i] : 0.f; nr[i] = (col <= row) ? nr[i] : 0.f;
            Tacc[q][i] = n[i] + (row == col ? 1.0f : 0.f); }
        st_tile(X, mt, nt, n, lane); st_tile_t(XT, mt, nt, n, lane); st_tile(Tb, mt, nt, Tacc[q], lane); st_tile(Mm, mt, nt, m, lane); st_tile(NrT, mt, nt, nr, lane); }
    __syncthreads();
#pragma unroll 1
    for (int it = 0; it < 6; ++it) {
        LAS bf16_t* Xr = (it & 1) ? G1T : X; LAS bf16_t* XTr = (it & 1) ? G2T : XT; LAS bf16_t* Tr = (it & 1) ? QT : Tb;
        LAS bf16_t* Xw = (it & 1) ? X : G1T; LAS bf16_t* XTw = (it & 1) ? XT : G2T; LAS bf16_t* Tw = (it & 1) ? Tb : QT;
#pragma unroll
        for (int q = 0; q < 2; ++q) { const int nt = nt0 + q;
            if (it > 0) Tacc[q] = mma_nt<64>(Tr + 16 * mt * RB_LD, RB_LD, XTr + 16 * nt * RB_LD, RB_LD, Tacc[q], lane);
            if (it < 5) { const f32x4 x2 = mma_nt<64>(Xr + 16 * mt * RB_LD, RB_LD, XTr + 16 * nt * RB_LD, RB_LD, zero4, lane); st_tile(Xw, mt, nt, x2, lane); st_tile_t(XTw, mt, nt, x2, lane); }
            st_tile(Tw, mt, nt, Tacc[q], lane); }
        __syncthreads();
    }
#pragma unroll
    for (int q = 0; q < 2; ++q) { const int nt = nt0 + q;
        st_tile(G1T, mt, nt, mma_nt<64>(NrT + 16 * mt * RB_LD, RB_LD, Tb + 16 * nt * RB_LD, RB_LD, zero4, lane), lane);
        st_tile(G2T, mt, nt, mma_nt<64>(BtT + 16 * mt * RB_LD, RB_LD, Tb + 16 * nt * RB_LD, RB_LD, zero4, lane), lane); }
    __syncthreads();
    const size_t ci = (size_t)(b * 4 + h) * 64 + c;
    bf16_t* gPT = (bf16_t*)(F.ws + WS_MOE + RW_PT) + ci * 4096; bf16_t* gW1 = (bf16_t*)(F.ws + WS_MOE + RW_W1) + ci * 4096; bf16_t* gZ = (bf16_t*)(F.ws + WS_MOE + RW_Z) + ci * 4096;
#pragma unroll
    for (int q = 0; q < 2; ++q) { const int nt = nt0 + q; const int col = 16 * nt + r;
        f32x4 w1 = mma_nt<64>(G1T + 16 * mt * RB_LD, RB_LD, AtT + 16 * nt * RB_LD, RB_LD, zero4, lane);
        f32x4 z = mma_nt<64>(G1T + 16 * mt * RB_LD, RB_LD, Mm + 16 * nt * RB_LD, RB_LD, zero4, lane);
        f32x4 mr = mma_nt<64>(Rt + 16 * mt * RB_LD, RB_LD, Kt + 16 * nt * RB_LD, RB_LD, zero4, lane);
        f32x4 p = mma_nt<64>(G2T + 16 * mt * RB_LD, RB_LD, AtT + 16 * nt * RB_LD, RB_LD, zero4, lane);
        f32x4 qq = mma_nt<64>(G2T + 16 * mt * RB_LD, RB_LD, Mm + 16 * nt * RB_LD, RB_LD, zero4, lane);
        const int pos = 32 * (col >> 5) + 8 * ((col >> 2) & 3) + 4 * ((col >> 4) & 1) + (col & 3);
#pragma unroll
        for (int i = 0; i < 4; ++i) { const int row = 16 * mt + 4 * g4 + i;
            gW1[row * 64 + col] = f2bf(w1[i] + bf2f(Rt[row * RB_LD + col]));
            gZ[row * 64 + col] = f2bf(z[i] + (col <= row ? mr[i] : 0.f));
            const float gc = gC[row];
            gPT[row * 64 + pos] = f2bf((p[i] + (row == col ? 1.0f : 0.f)) * gc);
            qq[i] = (qq[i] + bf2f(Kt[col * RB_LD + row])) * gc; }
        st_tile(QT, mt, nt, qq, lane); }
    __syncthreads();
    bf16_t* gU = (bf16_t*)(F.ws + WS_MOE + RW_U) + ci * 4096;
#pragma unroll
    for (int q = 0; q < 2; ++q) { const int nt = nt0 + q;
        const f32x4 u = mma_nt<64>(VT + 16 * mt * RB_LD, RB_LD, QT + 16 * nt * RB_LD, RB_LD, zero4, lane);
#pragma unroll
        for (int i = 0; i < 4; ++i) gU[(16 * mt + 4 * g4 + i) * 64 + 16 * nt + r] = f2bf(u[i]); }
}
__device__ __forceinline__ void item_rwkv_carry(const Frame& F_, int item) { Frame F = relocal(F_);
    const int bh = item * 2 + (F.wave >> 2), nt = F.wave & 3, r = F.lane & 15, g = F.lane >> 4;
    const bf16_t* PT = (const bf16_t*)(F.ws + WS_MOE + RW_PT); const bf16_t* Uc = (const bf16_t*)(F.ws + WS_MOE + RW_U); bf16_t* Ss = (bf16_t*)(F.ws + WS_MOE + RW_S);
    f32x4 acc[4];
#pragma unroll
    for (int m = 0; m < 4; ++m) acc[m] = (f32x4){0.f, 0.f, 0.f, 0.f};
    for (int c = 0; c < 64; ++c) { const size_t ci = (size_t)bh * 64 + c;
        bf16x8 af[4][2]; f32x4 cin[4];
#pragma unroll
        for (int m = 0; m < 4; ++m) { const u32x2 uv = *(const u32x2*)(Uc + ci * 4096 + (16 * nt + r) * 64 + 16 * m + 4 * g);
            cin[m] = (f32x4){__uint_as_float(uv.x << 16), __uint_as_float(uv.x & 0xffff0000u), __uint_as_float(uv.y << 16), __uint_as_float(uv.y & 0xffff0000u)};
#pragma unroll
            for (int s = 0; s < 2; ++s) af[m][s] = *(const bf16x8*)(PT + ci * 4096 + (16 * m + r) * 64 + 32 * s + 8 * g); }
        unsigned pw[4][2];
#pragma unroll
        for (int m = 0; m < 4; ++m) { pw[m][0] = pk2(acc[m][0], acc[m][1]); pw[m][1] = pk2(acc[m][2], acc[m][3]);
            *(u32x2*)(Ss + ci * 4096 + (16 * nt + r) * 64 + 16 * m + 4 * g) = (u32x2){pw[m][0], pw[m][1]}; }
        bf16x8 bfr[2];
#pragma unroll
        for (int s = 0; s < 2; ++s) bfr[s] = __builtin_bit_cast(bf16x8, (u32x4){pw[2 * s][0], pw[2 * s][1], pw[2 * s + 1][0], pw[2 * s + 1][1]});
#pragma unroll
        for (int m = 0; m < 4; ++m) { acc[m] = __builtin_amdgcn_mfma_f32_16x16x32_bf16(af[m][0], bfr[0], cin[m], 0, 0, 0);
            acc[m] = __builtin_amdgcn_mfma_f32_16x16x32_bf16(af[m][1], bfr[1], acc[m], 0, 0, 0); }
    }
}
__device__ __forceinline__ void item_rwkv3(const Frame& F_, int layer, int item) { Frame F = relocal(F_);
    const int b = item >> 8, h = (item >> 6) & 3, c = item & 63; const size_t T0 = (size_t)b * SEQ + c * 64;
    const size_t ci3 = (size_t)(b * 4 + h) * 64 + c;
    const u32x4 tS = *(const u32x4*)((const bf16_t*)(F.ws + WS_MOE + RW_S) + ci3 * 4096 + F.tid * 8);
    const u32x4 tW = *(const u32x4*)((const bf16_t*)(F.ws + WS_MOE + RW_W1) + ci3 * 4096 + F.tid * 8);
    const u32x4 tZ = *(const u32x4*)((const bf16_t*)(F.ws + WS_MOE + RW_Z) + ci3 * 4096 + F.tid * 8);
    f32x4 lw4[2], lb4[2];
#pragma unroll
    for (int q = 0; q < 2; ++q) { lw4[q] = *(const f32x4*)(F.in[I_RLNW] + layer * 256 + h * 64 + 8 * (F.tid & 7) + 4 * q); lb4[q] = *(const f32x4*)(F.in[I_RLNB] + layer * 256 + h * 64 + 8 * (F.tid & 7) + 4 * q); }
    rwkv_prep<3>(F, layer, b, h, c);
    LAS float* Vv = (LAS float*)(F.lds + RW_V); LAS float* Oo = (LAS float*)(F.lds + R3_O);
    LAS float* Gg = (LAS float*)(F.lds + R3_G); LAS float* BON = (LAS float*)(F.lds + R3_BON);
    LAS bf16_t* S0b = (LAS bf16_t*)(F.lds + R3_TILES); LAS bf16_t* W1b = S0b + 4608; LAS bf16_t* Zb = W1b + 4608; LAS bf16_t* VTb = Zb + 4608;
    { const int row = F.tid >> 3, col = (F.tid & 7) * 8;
      *(LAS u32x4*)(S0b + row * RB_LD + col) = tS;
      *(LAS u32x4*)(W1b + row * RB_LD + col) = tW;
      *(LAS u32x4*)(Zb + row * RB_LD + col) = tZ;
      const int vv = F.tid & 63, part = F.tid >> 6;
#pragma unroll
      for (int i = 0; i < 8; ++i) { const int t = 8 * part + i; VTb[vv * RB_LD + t] = f2bf(Vv[t * 64 + vv]); } }
    __syncthreads();
    { const int lane = F.lane, mt = F.wave >> 1, nt0 = 2 * (F.wave & 1), r = lane & 15, g4 = lane >> 4;
#pragma unroll
      for (int q = 0; q < 2; ++q) { const int nt = nt0 + q;
          f32x4 o = mma_nt<64>(W1b + 16 * mt * RB_LD, RB_LD, S0b + 16 * nt * RB_LD, RB_LD, (f32x4){0.f, 0.f, 0.f, 0.f}, lane);
          o = mma_nt<64>(Zb + 16 * mt * RB_LD, RB_LD, VTb + 16 * nt * RB_LD, RB_LD, o, lane);
#pragma unroll
          for (int i = 0; i < 4; ++i) Oo[(16 * mt + 4 * g4 + i) * 64 + 16 * nt + r] = o[i]; } }
    __syncthreads();
    { const int t = F.tid >> 3, p8 = F.tid & 7;
      float o[8]; float sm = 0.f;
#pragma unroll
      for (int q = 0; q < 2; ++q) { const f32x4 o4 = *(const LAS f32x4*)(Oo + t * 64 + 8 * p8 + 4 * q);
#pragma unroll
          for (int j = 0; j < 4; ++j) { o[4 * q + j] = o4[j]; sm += o4[j]; } }
      const float mean = sum8(sm) * (1.0f / 64.0f); float vs = 0.f;
#pragma unroll
      for (int j = 0; j < 8; ++j) { o[j] -= mean; vs += o[j] * o[j]; }
      const float rstd = rsqrtf(sum8(vs) * (1.0f / 64.0f) + 64e-5f); const float bon = BON[t];
      float y[8];
#pragma unroll
      for (int q = 0; q < 2; ++q) { const f32x4 v4 = *(const LAS f32x4*)(Vv + t * 64 + 8 * p8 + 4 * q), g4v = *(const LAS f32x4*)(Gg + t * 64 + 8 * p8 + 4 * q);
#pragma unroll
          for (int j = 0; j < 4; ++j) y[4 * q + j] = (o[4 * q + j] * rstd * lw4[q][j] + lb4[q][j] + bon * v4[j]) * g4v[j]; }
      *(u32x4*)((bf16_t*)(F.ws + WS_H) + (T0 + t) * DM + 256 + h * 64 + 8 * p8) = (u32x4){pk2(y[0], y[1]), pk2(y[2], y[3]), pk2(y[4], y[5]), pk2(y[6], y[7])}; }
}

constexpr int DS_SEL = 131072, DS_HIST = 135168, DS_BKT = 151552, DS_BIAS = 152064;
__device__ __forceinline__ void dsa_tables(const Frame& F_) { Frame F = relocal(F_);
    LAS int* bkt = (LAS int*)(F.lds + DS_BKT); LAS float* biasT = (LAS float*)(F.lds + DS_BIAS);
    if (F.tid < 128) { const int n = F.tid; int bk = n; if (n >= 16) { const float lr = logf((float)n / 16.0f) / 2.0794415416798357f; bk = 16 + (int)(lr * 16.0f); bk = bk < 31 ? bk : 31; } bkt[n] = bk; biasT[n] = F.in[I_RELB][n]; }
    __syncthreads();
}
__device__ __forceinline__ unsigned fkey(float f) { const unsigned u = __float_as_uint(f); return (u & 0x80000000u) ? ~u : (u | 0x80000000u); }
__device__ __forceinline__ void item_dsa(const Frame& F_, int layer, int item) { Frame F = relocal(F_);
    const bf16_t* U = (const bf16_t*)(F.ws + WS_U); const bf16_t* KI = (const bf16_t*)(F.ws + WS_KIDX);
    const bf16_t* Kb = (const bf16_t*)(F.ws + WS_K); const bf16_t* Vb = (const bf16_t*)(F.ws + WS_V);
    const int b = item & 3, qg = 511 - (item >> 2); const size_t TB = (size_t)b * SEQ, T0 = TB + qg * 8;
    LAS float* sc = (LAS float*)F.lds; LAS unsigned short* selall = (LAS unsigned short*)(F.lds + DS_SEL); LAS unsigned* histall = (LAS unsigned*)(F.lds + DS_HIST);
    LAS int* bkt = (LAS int*)(F.lds + DS_BKT); LAS float* biasT = (LAS float*)(F.lds + DS_BIAS);
    const int lane = F.lane, hh = lane >> 5;
    {
        bf16x8 af[2][2]; float wq[2][2][8];
        { const int r = lane & 31, q4 = 2 * ((r >> 2) & 1) + (r >> 4), head = 4 * ((r >> 3) & 1) + (r & 3);
#pragma unroll
          for (int mt = 0; mt < 2; ++mt)
#pragma unroll
              for (int ks = 0; ks < 2; ++ks) af[mt][ks] = *(const bf16x8*)(U + (T0 + 4 * mt + q4) * NINP + UC + 384 + head * 32 + 16 * ks + 8 * hh); }
#pragma unroll
        for (int mt = 0; mt < 2; ++mt)
#pragma unroll
            for (int q2 = 0; q2 < 2; ++q2) { float f[8]; unpack8(*(const u32x4*)(U + (T0 + 4 * mt + 2 * hh + q2) * NINP + UC + 672), f);
#pragma unroll
                for (int hd = 0; hd < 8; ++hd) wq[mt][q2][hd] = f[hd]; }
        const int ntile = (qg * 8 + 8 + 31) >> 5;
        bf16x8 nb0 = af[0][0], nb1 = af[0][0];
        if (F.wave < ntile) { const int key = F.wave * 32 + (lane & 31); nb0 = *(const bf16x8*)(KI + (TB + key) * 32 + 8 * hh); nb1 = *(const bf16x8*)(KI + (TB + key) * 32 + 16 + 8 * hh); }
        for (int kt = F.wave; kt < ntile; kt += 8) {
            const int key = kt * 32 + (lane & 31);
            const bf16x8 b0 = nb0, b1 = nb1;
            if (kt + 8 < ntile) { const int k2 = key + 256; nb0 = *(const bf16x8*)(KI + (TB + k2) * 32 + 8 * hh); nb1 = *(const bf16x8*)(KI + (TB + k2) * 32 + 16 + 8 * hh); }
#pragma unroll
            for (int mt = 0; mt < 2; ++mt) { f32x16 acc;
#pragma unroll
                for (int i = 0; i < 16; ++i) acc[i] = 0.f;
                acc = __builtin_amdgcn_mfma_f32_32x32x16_bf16(af[mt][0], b0, acc, 0, 0, 0);
                acc = __builtin_amdgcn_mfma_f32_32x32x16_bf16(af[mt][1], b1, acc, 0, 0, 0);
#pragma unroll
                for (int q2 = 0; q2 < 2; ++q2) { float s = 0.f;
#pragma unroll
                    for (int hd = 0; hd < 8; ++hd) s += fmaxf(acc[8 * q2 + hd], 0.f) * wq[mt][q2][hd];
                    const int qi = 4 * mt + 2 * hh + q2;
                    sc[qi * 4096 + key] = (key <= qg * 8 + qi) ? s : -INFINITY; } }
        }
    }
    __syncthreads();
    const int qi = F.wave, tq = qg * 8 + qi, n = tq + 1;
    LAS float* scq = sc + qi * 4096; LAS unsigned short* sel = selall + qi * 256; LAS unsigned* hist = histall + qi * 512;
    int nsel;
    if (n <= 256) { nsel = n; for (int j = lane; j < 256; j += 64) sel[j] = (unsigned short)(j < n ? j : 0); }
    else {
        nsel = 256;
        const int R = (n + 63) >> 6; const unsigned long long ltm = (1ull << lane) - 1ull;
        float lo = INFINITY, hi = -INFINITY;
        const int R4 = (n + 255) >> 8;
#pragma unroll 4
        for (int i = 0; i < R4; ++i) { const int j0 = 256 * i + 4 * lane; const f32x4 v4 = *(const LAS f32x4*)(scq + j0);
#pragma unroll
            for (int q = 0; q < 4; ++q) { const bool valid = j0 + q < n; lo = fminf(lo, valid ? v4[q] : INFINITY); hi = fmaxf(hi, valid ? v4[q] : -INFINITY); } }
#pragma unroll
        for (int o = 1; o < 64; o <<= 1) { lo = fminf(lo, shx(lo, o)); hi = fmaxf(hi, shx(hi, o)); }
        bool slow = false;
        if (!(hi > lo)) { for (int j = lane; j < 256; j += 64) sel[j] = (unsigned short)j; }
        else {
            const float scale = 1023.0f / (hi - lo);
            *(LAS u32x4*)(hist + 8 * lane) = (u32x4){0u, 0u, 0u, 0u}; *(LAS u32x4*)(hist + 8 * lane + 4) = (u32x4){0u, 0u, 0u, 0u};
#pragma unroll 2
            for (int i = 0; i < R4; ++i) { const int j0 = 256 * i + 4 * lane; const f32x4 v4 = *(const LAS f32x4*)(scq + j0);
#pragma unroll
                for (int q = 0; q < 4; ++q) { if (j0 + q < n) { int bk = (int)((v4[q] - lo) * scale); bk = bk < 1023 ? bk : 1023;
                    atomicAdd((unsigned*)(hist + (bk >> 1)), (bk & 1) ? 65536u : 1u); } } }
            const u32x4 h0 = *(const LAS u32x4*)(hist + 8 * lane), h1 = *(const LAS u32x4*)(hist + 8 * lane + 4);
            unsigned cb[16];
            cb[0] = h0.x & 0xffffu; cb[1] = h0.x >> 16; cb[2] = h0.y & 0xffffu; cb[3] = h0.y >> 16; cb[4] = h0.z & 0xffffu; cb[5] = h0.z >> 16; cb[6] = h0.w & 0xffffu; cb[7] = h0.w >> 16;
            cb[8] = h1.x & 0xffffu; cb[9] = h1.x >> 16; cb[10] = h1.y & 0xffffu; cb[11] = h1.y >> 16; cb[12] = h1.z & 0xffffu; cb[13] = h1.z >> 16; cb[14] = h1.w & 0xffffu; cb[15] = h1.w >> 16;
            unsigned tot = 0u;
#pragma unroll
            for (int q = 0; q < 16; ++q) tot += cb[q];
            unsigned incl = tot;
#pragma unroll
            for (int o = 1; o < 64; o <<= 1) { const unsigned t = shdown_u(incl, o); if (lane + o < 64) incl += t; }
            int fb = -1; unsigned fabove = 0u, fcnt = 0u; unsigned cum = incl - tot;
#pragma unroll
            for (int q = 15; q >= 0; --q) { if (fb < 0 && cum < 256u && 256u <= cum + cb[q]) { fb = 16 * lane + q; fabove = cum; fcnt = cb[q]; } cum += cb[q]; }
            const unsigned long long mf = __ballot(fb >= 0); const int src = (int)__ffsll((long long)mf) - 1;
            const int B = shidx_i(fb, src); const int above = shidx_i((int)fabove, src), cntB = shidx_i((int)fcnt, src); const int need = 256 - above;
            if (cntB > 256) slow = true;
            else {
                LAS unsigned* cand = hist;
                int base_gt = 0, base_c = 0;
#pragma unroll 2
                for (int i = 0; i < R4; ++i) { const int j0 = 256 * i + 4 * lane; const f32x4 v4 = *(const LAS f32x4*)(scq + j0);
#pragma unroll
                    for (int q = 0; q < 4; ++q) { const int j = j0 + q; const bool valid = j < n; const float v = valid ? v4[q] : lo;
                        int bk = (int)((v - lo) * scale); bk = bk < 1023 ? bk : 1023;
                        const bool gt = valid && bk > B, eq = valid && bk == B;
                        const unsigned long long mg = __ballot(gt), me = __ballot(eq);
                        if (gt) sel[base_gt + __popcll(mg & ltm)] = (unsigned short)j;
                        if (eq) { const int p = base_c + __popcll(me & ltm); cand[2 * p] = fkey(v); cand[2 * p + 1] = (unsigned)j; }
                        base_gt += __popcll(mg); base_c += __popcll(me); } }
                if (need == cntB) { for (int c = lane; c < cntB; c += 64) sel[above + c] = (unsigned short)cand[2 * c + 1]; }
                else {
                    unsigned ck[4], cx[4]; int rk[4];
#pragma unroll
                    for (int q = 0; q < 4; ++q) { const int c = lane + 64 * q; ck[q] = c < cntB ? cand[2 * c] : 0u; cx[q] = c < cntB ? cand[2 * c + 1] : 0u; rk[q] = 0; }
                    for (int c2 = 0; c2 < cntB; ++c2) { const unsigned k2 = cand[2 * c2], x2 = cand[2 * c2 + 1];
#pragma unroll
                        for (int q = 0; q < 4; ++q) rk[q] += (k2 > ck[q] || (k2 == ck[q] && x2 < cx[q])) ? 1 : 0; }
#pragma unroll
                    for (int q = 0; q < 4; ++q) { const int c = lane + 64 * q; if (c < cntB && rk[q] < need) sel[above + rk[q]] = (unsigned short)cand[2 * c + 1]; }
                }
            }
        }
        if (slow) {
        unsigned prefix = 0u; int need = 256; unsigned neq = 0u;
        for (int p = 0; p < 4; ++p) { const int shift = 24 - 8 * p;
            *(LAS u32x4*)(hist + 4 * lane) = (u32x4){0u, 0u, 0u, 0u};
            for (int i = 0; i < R; ++i) { const int j = lane + 64 * i; if (j < n) { const unsigned u = fkey(scq[j]);
                if (p == 0 || (u >> (shift + 8)) == prefix) atomicAdd((unsigned*)(hist + ((u >> shift) & 255u)), 1u); } }
            const u32x4 hv = *(const LAS u32x4*)(hist + 4 * lane);
            const unsigned tot = hv.x + hv.y + hv.z + hv.w;
            unsigned incl = tot;
#pragma unroll
            for (int o = 1; o < 64; o <<= 1) { const unsigned t = shdown_u(incl, o); if (lane + o < 64) incl += t; }
            const unsigned above = incl - tot;
            int fb = -1; unsigned fabove = 0u, feq = 0u; unsigned cum = above;
            { const unsigned hq[4] = {hv.x, hv.y, hv.z, hv.w};
#pragma unroll
              for (int q = 3; q >= 0; --q) { if (fb < 0 && cum < (unsigned)need && (unsigned)need <= cum + hq[q]) { fb = 4 * lane + q; fabove = cum; feq = hq[q]; } cum += hq[q]; } }
            const unsigned long long m = __ballot(fb >= 0);
            const int src = (int)__ffsll((long long)m) - 1;
            const int bin = shidx_i(fb, src); const unsigned ab = (unsigned)shidx_i((int)fabove, src); neq = (unsigned)shidx_i((int)feq, src);
            need -= (int)ab; prefix = (prefix << 8) | (unsigned)bin;
        }
        const int ngt = 256 - need;
        int base_gt = 0, base_eq = 0;
        for (int i = 0; i < R; ++i) { const int j = lane + 64 * i; const unsigned u = (j < n) ? fkey(scq[j]) : 0u;
            const bool gt = (j < n) && (u > prefix), eq = (j < n) && (u == prefix);
            const unsigned long long mg = __ballot(gt), me = __ballot(eq); const unsigned long long lt = (1ull << lane) - 1ull;
            if (gt) sel[base_gt + __popcll(mg & lt)] = (unsigned short)j;
            if (eq) { const int rk = base_eq + __popcll(me & lt); if (rk < need) sel[ngt + rk] = (unsigned short)j; }
            base_gt += __popcll(mg); base_eq += __popcll(me); }
        (void)neq;
            }
    }
    const int nt16 = (nsel + 15) >> 4, r16 = lane & 15, g4 = lane >> 4;
    LAS float* biasj = scq + 2048;
#pragma unroll
    for (int q = 0; q < 4; ++q) { const int j = lane + 64 * q; f32x4 bv = (f32x4){-INFINITY, -INFINITY, -INFINITY, -INFINITY};
        if (j < nsel) { const int dist = tq - (int)sel[j]; const int bk = dist < 128 ? bkt[dist < 0 ? 0 : dist] : 31; bv = *(const LAS f32x4*)(biasT + 4 * bk); }
        *(LAS f32x4*)(biasj + 4 * j) = bv; }
    bf16x8 qf[2];
#pragma unroll
    for (int s = 0; s < 2; ++s) { u32x4 z = (u32x4){0u, 0u, 0u, 0u}; if (r16 < 4) z = *(const u32x4*)(U + (T0 + qi) * NINP + UC + r16 * 64 + 32 * s + 8 * g4); qf[s] = __builtin_bit_cast(bf16x8, z); }
    float lg[16][4]; float mx = -INFINITY;
#define DSA_QK(M0, NM) do { int keyr[NM]; bf16x8 a0[NM], a1[NM]; \
        _Pragma("unroll") for (int m8 = 0; m8 < NM; ++m8) keyr[m8] = sel[16 * ((M0) + m8) + r16]; \
        _Pragma("unroll") for (int m8 = 0; m8 < NM; ++m8) { a0[m8] = *(const bf16x8*)(Kb + (TB + keyr[m8]) * 64 + 8 * g4); a1[m8] = *(const bf16x8*)(Kb + (TB + keyr[m8]) * 64 + 32 + 8 * g4); } \
        _Pragma("unroll") for (int m8 = 0; m8 < NM; ++m8) { const int m = (M0) + m8; \
            f32x4 acc = (f32x4){0.f, 0.f, 0.f, 0.f}; \
            acc = __builtin_amdgcn_mfma_f32_16x16x32_bf16(a0[m8], qf[0], acc, 0, 0, 0); \
            acc = __builtin_amdgcn_mfma_f32_16x16x32_bf16(a1[m8], qf[1], acc, 0, 0, 0); \
            _Pragma("unroll") for (int i = 0; i < 4; ++i) { const float v = acc[i] * 0.125f + biasj[(16 * m + 4 * g4 + i) * 4 + (r16 & 3)]; lg[m][i] = v; mx = fmaxf(mx, v); } } } while (0)
    if (nt16 > 8) { DSA_QK(0, 16); }
    else { DSA_QK(0, 8);
#pragma unroll
        for (int m8 = 8; m8 < 16; ++m8)
#pragma unroll
            for (int i = 0; i < 4; ++i) lg[m8][i] = -INFINITY; }
#undef DSA_QK
    mx = fmaxf(mx, shx(mx, 16)); mx = fmaxf(mx, shx(mx, 32));
    float sm = 0.f;
#pragma unroll
    for (int m = 0; m < 16; ++m)
#pragma unroll
        for (int i = 0; i < 4; ++i) { const float p = __expf(lg[m][i] - mx); lg[m][i] = p; sm += p; }
    sm += shx(sm, 16); sm += shx(sm, 32);
    f32x4 ov[4];
#pragma unroll
    for (int nt = 0; nt < 4; ++nt) ov[nt] = (f32x4){0.f, 0.f, 0.f, 0.f};
    const unsigned vs_base = (unsigned)(unsigned long)scq;
#pragma unroll
    for (int half = 0; half < 2; ++half) {
        if (half * 8 < nt16) {
            asm volatile("s_waitcnt lgkmcnt(0)" ::: "memory");
            int vkey[16];
#pragma unroll
            for (int q = 0; q < 16; ++q) { const int rho = 8 * q + (lane >> 3);
                vkey[q] = sel[half * 128 + (rho & ~31) + 16 * ((rho >> 2) & 1) + 4 * ((rho >> 3) & 3) + (rho & 3)]; }
            asm volatile("s_waitcnt lgkmcnt(0)" : "+v"(vkey[0]), "+v"(vkey[1]), "+v"(vkey[2]), "+v"(vkey[3]), "+v"(vkey[4]), "+v"(vkey[5]), "+v"(vkey[6]), "+v"(vkey[7]),
                         "+v"(vkey[8]), "+v"(vkey[9]), "+v"(vkey[10]), "+v"(vkey[11]), "+v"(vkey[12]), "+v"(vkey[13]), "+v"(vkey[14]), "+v"(vkey[15]) :: "memory");
#pragma unroll
            for (int q = 0; q < 16; ++q)
                __builtin_amdgcn_global_load_lds((const unsigned*)(Vb + (TB + vkey[q]) * 64 + 8 * (lane & 7)), (LAS unsigned*)((LAS unsigned char*)scq + q * 1024), 16, 0, 0);
            asm volatile("s_waitcnt vmcnt(0)" ::: "memory");
#pragma unroll
            for (int s4 = 0; s4 < 4; ++s4) { const int s = half * 4 + s4;
                u32x4 pw; pw.x = pk2(lg[2 * s][0], lg[2 * s][1]); pw.y = pk2(lg[2 * s][2], lg[2 * s][3]); pw.z = pk2(lg[2 * s + 1][0], lg[2 * s + 1][1]); pw.w = pk2(lg[2 * s + 1][2], lg[2 * s + 1][3]);
                const bf16x8 pa = __builtin_bit_cast(bf16x8, pw);
                const unsigned ad = vs_base + (unsigned)((32 * s4 + 8 * g4 + (r16 >> 2)) * 128 + (r16 & 3) * 8);
                u32x2 t0[4], t1[4];
                asm volatile("ds_read_b64_tr_b16 %0, %8\n\tds_read_b64_tr_b16 %1, %8 offset:512\n\tds_read_b64_tr_b16 %2, %8 offset:32\n\tds_read_b64_tr_b16 %3, %8 offset:544\n\t"
                             "ds_read_b64_tr_b16 %4, %8 offset:64\n\tds_read_b64_tr_b16 %5, %8 offset:576\n\tds_read_b64_tr_b16 %6, %8 offset:96\n\tds_read_b64_tr_b16 %7, %8 offset:608\n\ts_waitcnt lgkmcnt(0)"
                             : "=&v"(t0[0]), "=&v"(t1[0]), "=&v"(t0[1]), "=&v"(t1[1]), "=&v"(t0[2]), "=&v"(t1[2]), "=&v"(t0[3]), "=&v"(t1[3]) : "v"(ad) : "memory");
#pragma unroll
                for (int nt = 0; nt < 4; ++nt) { const bf16x8 vb = __builtin_bit_cast(bf16x8, (u32x4){t0[nt].x, t0[nt].y, t1[nt].x, t1[nt].y});
                    ov[nt] = __builtin_amdgcn_mfma_f32_16x16x32_bf16(pa, vb, ov[nt], 0, 0, 0); } }
        }
    }
    { float inv[4];
#pragma unroll
      for (int h = 0; h < 4; ++h) inv[h] = 1.0f / __int_as_float(__builtin_amdgcn_readlane(__float_as_int(sm), h));
      if (lane < 16) { bf16_t* Y = (bf16_t*)(F.ws + WS_H) + (T0 + qi) * DM + 512 + r16;
#pragma unroll
          for (int h = 0; h < 4; ++h)
#pragma unroll
              for (int nt = 0; nt < 4; ++nt) Y[h * 64 + 16 * nt] = f2bf(ov[nt][h] * inv[h]); } }
}

__device__ __forceinline__ void phase_router(const Frame& F_, int layer) { Frame F = relocal(F_); const int cset = layer;
    const float* X = (const float*)(F.ws + WS_X);
    const bf16_t* WH = (const bf16_t*)(F.ws + WS_WRT) + (size_t)layer * 2 * 49152; const bf16_t* WL = WH + 49152;
    LAS float* part = (LAS float*)F.lds;
    LAS float* ssq = (LAS float*)(F.lds + 24576);
    LAS int* es = (LAS int*)(F.lds + 25088);
    LAS int* lr = (LAS int*)(F.lds + 25600);
    LAS float* wsl = (LAS float*)(F.lds + 26112);
    LAS float* rsd = (LAS float*)(F.lds + 26624);
    for (int blk = F.bid; blk < NTOK / 64; blk += F.G) {
        __syncthreads();
        const int mt = F.wave & 3, kh = F.wave >> 2, r16 = F.lane & 15, g4 = F.lane >> 4;
        const float* xr = X + ((size_t)blk * 64 + mt * 16 + r16) * DM + kh * 512 + 8 * g4;
        f32x4 acc[3]; acc[0] = acc[1] = acc[2] = (f32x4){0.f, 0.f, 0.f, 0.f}; float ss = 0.f;
#pragma unroll 4
        for (int ks = 0; ks < 16; ++ks) {
            const f32x4 xa = *(const f32x4*)(xr + ks * 32), xb = *(const f32x4*)(xr + ks * 32 + 4);
            ss += xa[0] * xa[0] + xa[1] * xa[1] + xa[2] * xa[2] + xa[3] * xa[3] + xb[0] * xb[0] + xb[1] * xb[1] + xb[2] * xb[2] + xb[3] * xb[3];
            float xv[8] = {xa[0], xa[1], xa[2], xa[3], xb[0], xb[1], xb[2], xb[3]}; unsigned hw[4], lw[4];
#pragma unroll
            for (int j = 0; j < 4; ++j) { const bf16_t h0 = f2bf(xv[2 * j]), h1 = f2bf(xv[2 * j + 1]); hw[j] = (unsigned)h0 | ((unsigned)h1 << 16);
                lw[j] = pk2(xv[2 * j] - bf2f(h0), xv[2 * j + 1] - bf2f(h1)); }
            const bf16x8 ahi = __builtin_bit_cast(bf16x8, (u32x4){hw[0], hw[1], hw[2], hw[3]}), alo = __builtin_bit_cast(bf16x8, (u32x4){lw[0], lw[1], lw[2], lw[3]});
#pragma unroll
            for (int nt = 0; nt < 3; ++nt) { const size_t wo = (size_t)(nt * 16 + r16) * 1024 + kh * 512 + ks * 32 + 8 * g4;
                const bf16x8 bh = *(const bf16x8*)(WH + wo), bl = *(const bf16x8*)(WL + wo);
                acc[nt] = __builtin_amdgcn_mfma_f32_16x16x32_bf16(ahi, bh, acc[nt], 0, 0, 0);
                acc[nt] = __builtin_amdgcn_mfma_f32_16x16x32_bf16(ahi, bl, acc[nt], 0, 0, 0);
                acc[nt] = __builtin_amdgcn_mfma_f32_16x16x32_bf16(alo, bh, acc[nt], 0, 0, 0); }
        }
        ss += shx(ss, 16); ss += shx(ss, 32);
        if (g4 == 0) ssq[kh * 64 + mt * 16 + r16] = ss;
#pragma unroll
        for (int nt = 0; nt < 3; ++nt)
#pragma unroll
            for (int i = 0; i < 4; ++i) part[(kh * 64 + mt * 16 + 4 * g4 + i) * 48 + nt * 16 + r16] = acc[nt][i];
        __syncthreads();
        if (F.tid < 64) { const float rstd = rsqrtf((ssq[F.tid] + ssq[64 + F.tid]) * (1.0f / DM) + 1e-6f); rsd[F.tid] = rstd;
            float l[36];
#pragma unroll
            for (int o = 0; o < 36; ++o) l[o] = (part[F.tid * 48 + o] + part[(64 + F.tid) * 48 + o]) * rstd + (o < 32 ? F.in[I_BRE][layer * 32 + o] : F.in[I_BRG][layer * 4 + o - 32]);
            int gs = 0; float gm = l[32];
#pragma unroll
            for (int j = 1; j < 4; ++j) if (l[32 + j] > gm) { gm = l[32 + j]; gs = j; }
            float den = 0.f;
#pragma unroll
            for (int j = 0; j < 4; ++j) den += __expf(l[32 + j] - gm);
            const float gate = 1.0f / den;
            float e8[8];
#pragma unroll
            for (int j = 0; j < 8; ++j) e8[j] = gs == 0 ? l[j] : gs == 1 ? l[8 + j] : gs == 2 ? l[16 + j] : l[24 + j];
            int i1 = 0; float v1 = e8[0];
#pragma unroll
            for (int j = 1; j < 8; ++j) if (e8[j] > v1) { v1 = e8[j]; i1 = j; }
            int i2 = -1; float v2 = -INFINITY;
#pragma unroll
            for (int j = 0; j < 8; ++j) if (j != i1 && e8[j] > v2) { v2 = e8[j]; i2 = j; }
            const float e2 = __expf(v2 - v1); const float p1 = 1.0f / (1.0f + e2);
            es[F.tid * 2] = gs * 8 + i1; es[F.tid * 2 + 1] = gs * 8 + i2; wsl[F.tid * 2] = p1 * gate; wsl[F.tid * 2 + 1] = (1.0f - p1) * gate; }
        __syncthreads();
        if (F.tid < 32) { int cnt = 0; for (int i = 0; i < 128; ++i) if (es[i] == F.tid) lr[i] = cnt++;
            if (cnt) { const int base = (int)__hip_atomic_fetch_add(F.ctl + CW_CNT + cset * 32 + F.tid, (unsigned)cnt, __ATOMIC_RELAXED, __HIP_MEMORY_SCOPE_AGENT);
                for (int i = 0; i < 128; ++i) if (es[i] == F.tid) lr[i] += base; } }
        __syncthreads();
        if (F.tid < 64) { int* rt = (int*)(F.ws + WS_ROUTE) + ((size_t)blk * 64 + F.tid) * 8;
            rt[0] = es[F.tid * 2]; rt[1] = es[F.tid * 2 + 1]; ((float*)rt)[2] = wsl[F.tid * 2]; ((float*)rt)[3] = wsl[F.tid * 2 + 1]; rt[4] = lr[F.tid * 2]; rt[5] = lr[F.tid * 2 + 1]; ((float*)rt)[6] = rsd[F.tid]; }
    }
    __syncthreads();
    if (F.tid == 0) __hip_atomic_fetch_add(F.ctl + CW_RB + 64 * layer, 1u, __ATOMIC_RELAXED, __HIP_MEMORY_SCOPE_AGENT);
}
__device__ __forceinline__ void phase_moe_convert(const Frame& F_, int layer) { Frame F = relocal(F_);
    bf16_t* WGU = (bf16_t*)(F.ws + WS_MOE + MOE_WGU);
    for (int t = F.bid; t < 1024; t += F.G) {
        const int e = t >> 5, r = t & 31, kt = r >> 1, nt = r & 1; const size_t eo = ((size_t)layer * 32 + e) * 1024 * 256;
        tr_tile(F, 256, WGU + (size_t)e * 512 * 1024, 1024, kt * 64, nt * 256, SmGU{F.in[I_WGATE] + eo, F.in[I_WUP] + eo}); }
}
__device__ __forceinline__ void phase_moe_convert_down(const Frame& F_, int layer) { Frame F = relocal(F_);
    bf16_t* WD = (bf16_t*)(F.ws + WS_MOE + MOE_WD);
    for (;;) { const int q = q_pop(F, 32 + layer); if (q >= 512) break;
        const int e = q >> 4, r = q & 15, kt = r >> 2, nt = r & 3;
        tr_tile(F, 1024, WD + (size_t)e * 1024 * 256, 256, kt * 64, nt * 256, SmId{F.in[I_WDOWN] + ((size_t)layer * 32 + e) * 256 * 1024}); }
}
__device__ __forceinline__ void phase_gather(const Frame& F_, int layer) { Frame F = relocal(F_);
    LAS int* off = (LAS int*)F.lds;
    __syncthreads();
    if (F.tid == 0) { unsigned sp = 0;
        while (__hip_atomic_load(F.ctl + CW_RB + 64 * layer, __ATOMIC_RELAXED, __HIP_MEMORY_SCOPE_AGENT) < (unsigned)F.G) { __builtin_amdgcn_s_sleep(2); if (++sp > (1u << 22)) break; } }
    __syncthreads();
    if (F.tid == 0) { int acc = 0; for (int e = 0; e < 32; ++e) { off[e] = acc; const int c = (int)__hip_atomic_load(F.ctl + CW_CNT + layer * 32 + e, __ATOMIC_RELAXED, __HIP_MEMORY_SCOPE_AGENT); acc += (c + 255) & ~255; } off[32] = acc; }
    __syncthreads();
    int* tiles = (int*)(F.ws + WS_TILES); int* row_tok = (int*)(F.ws + WS_ROWS); float* row_w = (float*)(F.ws + WS_ROWS) + MAXROWS;
    if (F.bid == 0) { if (F.tid == 0) tiles[0] = off[32] >> 8; if (F.tid < 33) tiles[1 + F.tid] = off[F.tid];
        if (F.tid < 32) for (int rt = off[F.tid] >> 8; rt < (off[F.tid + 1] >> 8); ++rt) tiles[64 + rt] = F.tid; }
    for (int e = F.bid; e < 32; e += F.G) { const int c = (int)__hip_atomic_load(F.ctl + CW_CNT + layer * 32 + e, __ATOMIC_RELAXED, __HIP_MEMORY_SCOPE_AGENT);
        for (int r = off[e] + c + F.tid; r < off[e + 1]; r += NTHR) { row_tok[r] = -1; row_w[r] = 0.f; } }
    const float* X = (const float*)(F.ws + WS_X); bf16_t* HP = (bf16_t*)(F.ws + WS_U); const float* nw = F.in[I_NORM2] + (size_t)layer * DM;
    f32x4 nwv[4];
#pragma unroll
    for (int j = 0; j < 4; ++j) nwv[j] = *(const f32x4*)(nw + 4 * F.lane + 256 * j);
    for (int blk = F.bid; blk < NTOK / 64; blk += F.G)
    for (int i4 = 0; i4 < 2; ++i4) {
        int p0[4], p1[4], tt[4]; float rstd[4], w0[4], w1[4]; f32x4 xv[4][4];
#pragma unroll
        for (int r = 0; r < 4; ++r) { const int t = blk * 64 + F.wave * 8 + 4 * i4 + r; tt[r] = t;
            const int* rt = (const int*)(F.ws + WS_ROUTE) + (size_t)t * 8; rstd[r] = ((const float*)rt)[6]; w0[r] = ((const float*)rt)[2]; w1[r] = ((const float*)rt)[3];
            p0[r] = off[rt[0]] + rt[4]; p1[r] = off[rt[1]] + rt[5];
#pragma unroll
            for (int j = 0; j < 4; ++j) xv[r][j] = *(const f32x4*)(X + (size_t)t * DM + 4 * F.lane + 256 * j); }
#pragma unroll
        for (int r = 0; r < 4; ++r) {
#pragma unroll
            for (int j = 0; j < 4; ++j) { const int c = 4 * F.lane + 256 * j; const f32x4 v = xv[r][j] * rstd[r] * nwv[j];
                u32x2 o; o.x = pk2(v[0], v[1]); o.y = pk2(v[2], v[3]);
                *(u32x2*)(HP + (size_t)tt[r] * DM + c) = o; }
            if (F.lane == 0) { row_tok[p0[r]] = tt[r] * 2; row_w[p0[r]] = w0[r]; row_tok[p1[r]] = tt[r] * 2 + 1; row_w[p1[r]] = w1[r]; } }
    }
}

constexpr int NPH_LAYER = 9, NPHASE = 1 + 2 * NPH_LAYER + 1;
#ifndef MK_ONLY
#define MK_ONLY -1
#endif
#ifndef MK_ITEM
#define MK_ITEM -1
#endif
#define EN(o) (MK_ONLY < 0 || MK_ONLY == (o))
#define IT(o) (MK_ITEM < 0 || MK_ITEM == (o))
__global__ void __launch_bounds__(NTHR, 2) mk_forward(Params P) {
    extern __shared__ __attribute__((aligned(16))) unsigned char lds_raw[];
    Frame F; F.lds = (LAS unsigned char*)lds_raw; F.tid = threadIdx.x; F.lane = F.tid & 63; F.wave = __builtin_amdgcn_readfirstlane(F.tid >> 6); F.bid = blockIdx.x; F.G = gridDim.x;
    F.in = (in_tab_t)__builtin_amdgcn_kernarg_segment_ptr(); F.out = P.out; F.ws = P.ws; F.ctl = (unsigned*)(P.ws + WS_CTL); F.misc = (volatile LAS int*)(F.lds + MISC_OFF);
    if (F.tid < 64) ((LAS unsigned*)(F.lds + MISC_OFF))[F.tid] = 0u;
    __syncthreads();
    const int lo = P.ph_lo, hi = P.ph_hi;
    XcdBarrier bar; bar.bar = F.ctl + CW_BAR; bar.x = 0; bar.st = (volatile LAS unsigned*)(F.lds + MISC_OFF + 16);
    if (hi - lo > 1) bar = xcd_barrier_post(F.ctl + CW_BAR, (volatile LAS unsigned*)(F.lds + MISC_OFF + 16));
#define IN(k) (lo <= (k) && (k) < hi)
#define SEAM(k) do { if (IN(k) && IN((k) + 1)) xcd_barrier(bar); } while (0)
#define QLOOP(qi, n, body) for (;;) { const int it = q_pop(F, layer * 12 + (qi)); if (it >= (n)) break; body; }
    if (EN(100) && IN(0)) { phase_prologue(F); phase_norm(F, F.in[I_X], false, F.in[I_NORM1], 3); } SEAM(0);
#pragma unroll
    for (int layer = 0; layer < DEPTH; ++layer) {
        const int pb = 1 + layer * NPH_LAYER;
        if (layer > 0) { if (EN(0) && IN(pb + 0)) { phase_norm(F, (const float*)(F.ws + WS_X), true, F.in[I_NORM1] + (size_t)layer * DM, 0); } SEAM(pb + 0); }
        if (EN(1) && IN(pb + 1)) { const Frame F_ = F; Frame F = relocal(F_); pg8::StaticOrder S; S.init((const bf16_t*)(F.ws + WS_H), (const bf16_t*)(F.ws + WS_WIN) + (size_t)layer * NINP * DM, NTOK, NINP, DM, F.G, F.bid);
            pg8::EpiBf16 E{(bf16_t*)(F.ws + WS_U), NINP}; pg8::gemm_phase(F.lds, DM, S, E); } SEAM(pb + 1);
#define SLOOP(n, body) for (int it = F.bid; it < (n); it += F.G) { __syncthreads(); body; }
        if (EN(2) && IN(pb + 2)) {
            if (IT(1)) SLOOP(1024, item_rwkv1(F, layer, it));
            if (IT(0)) SLOOP(256, item_s5<1>(F, layer, it));
            if (IT(2)) SLOOP(256, item_mamba<1>(F, layer, it));
            if (IT(3)) SLOOP(256, item_kv(F, layer, it));
        } SEAM(pb + 2);
        if (EN(3) && IN(pb + 3)) {
            if (IT(0)) SLOOP(8, item_rwkv_carry(F, it));
            if (IT(1)) { for (int it = F.bid - 8; it >= 0 && it < 16; it += F.G) { __syncthreads(); item_mamba_carry(F, it); } }
            if (IT(2)) { for (int it = F.bid - 24; it >= 0 && it < 4; it += F.G) { __syncthreads(); item_s5_carry(F, layer, it); } }
            if (IT(3)) {
                dsa_tables(F);
                const int pref = (int)(xb_xcc_id() & 3u);
#pragma unroll 1
                for (int k4 = 0; k4 < 4; ++k4) { const int bq = (pref + k4) & 3;
                    for (;;) { const int it = q_pop(F, 24 + layer * 4 + bq); if (it >= 512) break; item_dsa(F, layer, it * 4 + bq); } } }
        } SEAM(pb + 3);
        if (EN(4) && IN(pb + 4)) {
            if (IT(0)) SLOOP(256, item_s5<2>(F, layer, it));
            if (IT(2)) SLOOP(256, item_mamba<2>(F, layer, it));
            if (IT(1)) SLOOP(1024, item_rwkv3(F, layer, it));
        } SEAM(pb + 4);
        if (EN(6) && IN(pb + 5)) { const Frame F_ = F; Frame F = relocal(F_); pg8::StaticOrder S; S.init((const bf16_t*)(F.ws + WS_H), (const bf16_t*)(F.ws + WS_WOUT) + (size_t)layer * DM * DM, NTOK, DM, DM, F.G, F.bid);
            pg8::EpiResid E{layer == 0 ? F.in[I_X] : (const float*)(F.ws + WS_X), (float*)(F.ws + WS_X), DM}; pg8::gemm_phase(F.lds, DM, S, E); } SEAM(pb + 5);
        if (EN(7) && IN(pb + 6)) { phase_router(F, layer); phase_moe_convert(F, layer); phase_gather(F, layer); } SEAM(pb + 6);
        if (EN(8) && IN(pb + 7)) { const Frame F_ = F; Frame F = relocal(F_); LAS int* ul = (LAS int*)(F.lds + pg8::STAGE_BYTES + 8192); if (F.tid == 0) pg8::MoeOrder::build(ul, (const int*)(F.ws + WS_TILES), 2, F.G, F.bid); __syncthreads();
            pg8::MoeOrder S{DM, (const char*)(F.ws + WS_U), (const char*)(F.ws + WS_MOE + MOE_WGU), (size_t)512 * 1024 * 2, ul};
            pg8::EpiGated<1> E{(bf16_t*)(F.ws + WS_H), 256, 0, nullptr, nullptr}; pg8::gemm_phase<pg8::EpiGated<1>, pg8::MoeOrder, true>(F.lds, DM, S, E, (const char*)(F.ws + WS_U), (const int*)(F.ws + WS_ROWS)); phase_moe_convert_down(F, layer); } SEAM(pb + 7);
        if (EN(9) && IN(pb + 8)) { const Frame F_ = F; Frame F = relocal(F_); LAS int* ul = (LAS int*)(F.lds + pg8::STAGE_BYTES + 8192); if (F.tid == 0) pg8::MoeOrder::build(ul, (const int*)(F.ws + WS_TILES), 4, F.G, F.bid); __syncthreads();
            pg8::MoeOrder S{256, (const char*)(F.ws + WS_H), (const char*)(F.ws + WS_MOE + MOE_WD), (size_t)1024 * 256 * 2, ul};
            pg8::EpiMoeOut E{(bf16_t*)(F.ws + WS_U), (const int*)(F.ws + WS_ROWS), (const float*)(F.ws + WS_ROWS) + MAXROWS, F.lds}; pg8::gemm_phase(F.lds, 256, S, E); } SEAM(pb + 8);
    }
    if (EN(101) && IN(NPHASE - 1)) { phase_norm(F, (const float*)(F.ws + WS_X), true, F.in[I_FNORM], 2); }
#undef IN
#undef SEAM
}

#ifndef MK_SPLIT
#define MK_SPLIT 0
#endif
extern "C" void kernel_launch(void* const* d_in, const int* in_sizes, int n_in, void* d_out, int out_size, void* d_ws, size_t ws_size, hipStream_t stream) {
    static int grid = 0;
    if (grid == 0) {
        if (n_in != 44 || out_size != NTOK * DM || ws_size < WS_END) { fprintf(stderr, "kernel_launch: unexpected shapes (n_in %d out %d ws %zu need %zu)\n", n_in, out_size, ws_size, (size_t)WS_END); grid = -1; return; }
        int dev = 0, cus = 0;
        if (hipGetDevice(&dev) != hipSuccess || hipDeviceGetAttribute(&cus, hipDeviceAttributeMultiprocessorCount, dev) != hipSuccess) { grid = -1; return; }
        if (hipFuncSetAttribute((const void*)mk_forward, hipFuncAttributeMaxDynamicSharedMemorySize, LDS_BYTES) != hipSuccess) { fprintf(stderr, "kernel_launch: hipFuncSetAttribute failed\n"); grid = -1; return; }
        int per_cu = 0;
        if (hipOccupancyMaxActiveBlocksPerMultiprocessor(&per_cu, (const void*)mk_forward, NTHR, LDS_BYTES) != hipSuccess || per_cu < 1) { fprintf(stderr, "kernel_launch: occupancy query says %d\n", per_cu); }
        (void)hipGetLastError();
        grid = cus;
    }
    if (grid < 0) return;
    hipMemsetAsync((char*)d_ws + WS_CTL, 0, CTL_BYTES, stream);
    Params p{};
    for (int i = 0; i < 44; ++i) p.in[i] = (const float*)d_in[i];
    p.out = (float*)d_out; p.ws = (unsigned char*)d_ws;
#if MK_SPLIT
    for (int ph = 0; ph < NPHASE; ++ph) { p.ph_lo = ph; p.ph_hi = ph + 1; hipLaunchKernelGGL(mk_forward, dim3(grid), dim3(NTHR), LDS_BYTES, stream, p); }
#else
    p.ph_lo = 0; p.ph_hi = NPHASE; hipLaunchKernelGGL(mk_forward, dim3(grid), dim3(NTHR), LDS_BYTES, stream, p);
#endif
}
```

```cpp
#include <hip/hip_runtime.h>
#include <stdint.h>
#include <stdio.h>

#define LAS __attribute__((address_space(3)))
typedef unsigned short bf16_t;
typedef short bf16x8 __attribute__((ext_vector_type(8)));
typedef float f32x4 __attribute__((ext_vector_type(4)));
typedef float f32x2 __attribute__((ext_vector_type(2)));
typedef float f32x16 __attribute__((ext_vector_type(16)));
typedef unsigned u32x4 __attribute__((ext_vector_type(4)));
typedef unsigned u32x2 __attribute__((ext_vector_type(2)));

constexpr int NTOK = 16384, DM = 1024, SEQ = 4096, NBATCH = 4, DEPTH = 2;
constexpr int NIN = 2604, NINP = 2816;
constexpr int UM = 0;
constexpr int UR = 784;
constexpr int UC = 1680;
constexpr int US = 2368;
constexpr int NTHR = 512;
constexpr int LDS_BYTES = 163840;
constexpr int MISC_OFF = LDS_BYTES - 256;

constexpr size_t WS_CTL   = 0;
constexpr size_t CTL_BYTES = 65536;
constexpr size_t WS_X     = WS_CTL + CTL_BYTES;
constexpr size_t WS_H     = WS_X + (size_t)NTOK * DM * 4;
constexpr size_t WS_U     = WS_H + (size_t)NTOK * DM * 2;
constexpr size_t WS_WIN   = WS_U + (size_t)NTOK * NINP * 2;
constexpr size_t WS_WOUT  = WS_WIN + (size_t)2 * NINP * DM * 2;
constexpr size_t WS_GLU   = WS_WOUT + (size_t)2 * DM * DM * 2;
constexpr size_t WS_MOE   = WS_GLU + (size_t)2 * 512 * 256 * 2;
constexpr size_t MOE_WGU  = 0;
constexpr size_t MOE_WD   = (size_t)32 * 512 * 1024 * 2;
constexpr size_t MOE_BYTES = MOE_WD + (size_t)32 * 1024 * 256 * 2;
constexpr size_t RW_PT    = 0;
constexpr size_t RW_U     = (size_t)1024 * 4096 * 2;
constexpr size_t RW_S     = RW_U + (size_t)1024 * 4096 * 2;
constexpr size_t RW_W1    = RW_S + (size_t)1024 * 4096 * 2;
constexpr size_t RW_Z     = RW_W1 + (size_t)1024 * 4096 * 2;
constexpr size_t YSG_OFF  = RW_Z + (size_t)1024 * 4096 * 2;
static_assert(YSG_OFF + (size_t)NTOK * 256 * 2 <= MOE_BYTES, "alias");
constexpr size_t WS_MST   = WS_MOE + MOE_BYTES;
constexpr size_t WS_MDEC  = WS_MST + (size_t)4 * 64 * 4 * 4096 * 4;
constexpr size_t WS_S5ST  = WS_MDEC + 4096;
constexpr size_t WS_K     = WS_S5ST + (size_t)4 * 64 * 2048 * 4;
constexpr size_t WS_V     = WS_K + (size_t)NTOK * 64 * 2;
constexpr size_t WS_KIDX  = WS_V + (size_t)NTOK * 64 * 2;
constexpr size_t WS_ROUTE = WS_KIDX + (size_t)NTOK * 32 * 2;
constexpr size_t WS_ROWS  = WS_ROUTE + (size_t)NTOK * 32;
constexpr int    MAXROWS  = 49152;
constexpr size_t WS_TILES = WS_ROWS + (size_t)MAXROWS * 8;
constexpr size_t WS_S5TAB = WS_TILES + 4096;
constexpr size_t S5TAB_F  = (size_t)(2048 + 2048 + 32768) * 4;
constexpr size_t S5TAB_BBT = S5TAB_F + (size_t)16 * 16 * 128 * 2;
constexpr size_t S5TAB_L  = S5TAB_BBT + (size_t)16 * 128 * 16 * 2;
constexpr size_t WS_WRT   = WS_S5TAB + 2 * S5TAB_L;
constexpr size_t WS_BON   = WS_WRT + (size_t)2 * 2 * 48 * 1024 * 2;
constexpr size_t WS_END   = WS_BON + (size_t)1024 * 64 * 4;

constexpr int CW_BAR = 0;
constexpr int CW_Q   = 4096;
constexpr int CW_CNT = 8192;
constexpr int CW_RB  = 8448;

__device__ __forceinline__ float bf2f(bf16_t b) { return __uint_as_float(((unsigned)b) << 16); }
__device__ __forceinline__ bf16_t f2bf(float f) { const __bf16 h = (__bf16)f; return __builtin_bit_cast(bf16_t, h); }
__device__ __forceinline__ unsigned pk2(float lo, float hi) { typedef __bf16 bf2_t __attribute__((ext_vector_type(2))); const bf2_t h = __builtin_convertvector((f32x2){lo, hi}, bf2_t); return __builtin_bit_cast(unsigned, h); }
__device__ __forceinline__ unsigned cvt_pk_bf16(float lo, float hi) { unsigned r; asm volatile("v_cvt_pk_bf16_f32 %0, %1, %2" : "=v"(r) : "v"(lo), "v"(hi)); return r; }
__device__ __forceinline__ float sigmoidf_(float x) { return 1.0f / (1.0f + __expf(-x)); }
__device__ __forceinline__ float siluf_(float x) { return x / (1.0f + __expf(-x)); }
__device__ __forceinline__ float tanhf_(float x) { const float e = __expf(2.0f * x); return 1.0f - 2.0f / (e + 1.0f); }
__device__ __forceinline__ float softplusf_(float x) { return fmaxf(x, 0.0f) + log1pf(__expf(-fabsf(x))); }
__device__ __forceinline__ float gelu_tanh(float x) { return 0.5f * x * (1.0f + tanhf_(0.7978845608028654f * (x + 0.044715f * x * x * x))); }
template <int CTRL> __device__ __forceinline__ float dppf(float x) { return __int_as_float(__builtin_amdgcn_update_dpp(0, __float_as_int(x), CTRL, 0xF, 0xF, true)); }
__device__ __forceinline__ float sum4(float x) { x += dppf<0xB1>(x); x += dppf<0x4E>(x); return x; }
__device__ __forceinline__ float sum8(float x) { x = sum4(x); x += dppf<0x141>(x); return x; }
__device__ __forceinline__ float sum16(float x) { x = sum8(x); x += dppf<0x140>(x); return x; }
__device__ __forceinline__ int lane_id_() { int l = (int)__builtin_amdgcn_mbcnt_hi(~0u, __builtin_amdgcn_mbcnt_lo(~0u, 0u)); asm volatile("" : "+v"(l)); return l; }
__device__ __forceinline__ float shx(float x, int o) { return __int_as_float(__builtin_amdgcn_ds_bpermute((lane_id_() ^ o) << 2, __float_as_int(x))); }
__device__ __forceinline__ unsigned shdown_u(unsigned x, int o) { return (unsigned)__builtin_amdgcn_ds_bpermute(((lane_id_() + o) & 63) << 2, (int)x); }
__device__ __forceinline__ int shidx_i(int x, int src) { return __builtin_amdgcn_ds_bpermute(src << 2, x); }
__device__ __forceinline__ float wave_sum(float x) { x = sum16(x); x += shx(x, 16); x += shx(x, 32); return x; }
__device__ __forceinline__ void unpack8(const u32x4 v, float (&f)[8]) {
    f[0] = __uint_as_float(v.x << 16); f[1] = __uint_as_float(v.x & 0xffff0000u); f[2] = __uint_as_float(v.y << 16); f[3] = __uint_as_float(v.y & 0xffff0000u);
    f[4] = __uint_as_float(v.z << 16); f[5] = __uint_as_float(v.z & 0xffff0000u); f[6] = __uint_as_float(v.w << 16); f[7] = __uint_as_float(v.w & 0xffff0000u);
}

__device__ __forceinline__ void st16_wt(void* p, u32x4 v) { asm volatile("global_store_dwordx4 %0, %1, off sc1\n\ts_nop 1" :: "v"(p), "v"(v) : "memory"); }
#define XB_TMO      128
#define XB_XCNT(j)  (256  + 64 * (j))
#define XB_XSUB(j)  (1280 + 64 * (j))
#define XB_XGEN(j)  (2304 + 64 * (j))
#define XB_TOP      3328
#define XB_TOPGEN   3392
#define XCD_BAR_WORDS 3456
#define XB_SPIN_CAP (1u << 22)
__device__ __forceinline__ unsigned xb_ld(unsigned* p)              { return __hip_atomic_load(p, __ATOMIC_RELAXED, __HIP_MEMORY_SCOPE_AGENT); }
__device__ __forceinline__ unsigned xb_add(unsigned* p, unsigned v) { return __hip_atomic_fetch_add(p, v, __ATOMIC_RELAXED, __HIP_MEMORY_SCOPE_AGENT); }
__device__ __forceinline__ unsigned xb_xcc_id() { return (unsigned)__builtin_amdgcn_s_getreg((3 << 11) | 20) & 0xFu; }
#define XB_SPIN(cond, bar) do { unsigned _sp = 0; while (cond) { __builtin_amdgcn_s_sleep(1); \
    if ((++_sp & 255u) == 0u) { if (xb_ld(&(bar)[XB_TMO])) break; if (_sp > XB_SPIN_CAP) { atomicAdd(&(bar)[XB_TMO], 1u); break; } } } } while (0)
struct XcdBarrier { unsigned* bar; unsigned x; volatile LAS unsigned* st; };
__device__ __forceinline__ XcdBarrier xcd_barrier_post(unsigned* bar, volatile LAS unsigned* st) {
    XcdBarrier b; b.bar = bar; b.x = xb_xcc_id(); b.st = st;
    if (threadIdx.x == 0) (void)xb_add(&bar[XB_XCNT(b.x)], 1u);
    return b;
}
__device__ __forceinline__ void xcd_barrier_complete(unsigned* bar, unsigned x, unsigned& nloc, unsigned& nx) {
    const unsigned G = gridDim.x * gridDim.y * gridDim.z;
    unsigned sum, cnt, mine, sp = 0u;
    for (;;) {
        sum = 0u; cnt = 0u; mine = 0u;
#pragma unroll
        for (unsigned j = 0; j < 16; ++j) { const unsigned c = xb_ld(&bar[XB_XCNT(j)]); sum += c; cnt += (c > 0u) ? 1u : 0u; mine = (j == x) ? c : mine; }
        if (sum == G) break;
        __builtin_amdgcn_s_sleep(1);
        if ((++sp & 255u) == 0u) { if (xb_ld(&bar[XB_TMO])) break; if (sp > XB_SPIN_CAP) { atomicAdd(&bar[XB_TMO], 1u); break; } }
    }
    nloc = mine > 0u ? mine : 1u; nx = cnt > 0u ? cnt : 1u;
}
__device__ __forceinline__ void xcd_barrier(const XcdBarrier& b_) {
    XcdBarrier b = b_; { const unsigned long long v = (unsigned long long)b.bar; unsigned lo = __builtin_amdgcn_readfirstlane((unsigned)v), hi = __builtin_amdgcn_readfirstlane((unsigned)(v >> 32)); asm volatile("" : "+s"(lo), "+s"(hi)); b.bar = (unsigned*)(((unsigned long long)hi << 32) | lo); unsigned xx = __builtin_amdgcn_readfirstlane(b.x); asm volatile("" : "+s"(xx)); b.x = xx; }
    asm volatile("s_waitcnt vmcnt(0)" ::: "memory");
    __syncthreads();
    if (threadIdx.x == 0) {
        unsigned* bar = b.bar;
        __builtin_amdgcn_s_waitcnt(0);
        unsigned nloc = b.st[0], nx = b.st[1];
        if (nloc == 0u) { xcd_barrier_complete(bar, b.x, nloc, nx); b.st[0] = nloc; b.st[1] = nx; }
        const unsigned old = xb_add(&bar[XB_XSUB(b.x)], 1u);
        const unsigned gen = old / nloc;
        if (old + 1u == (gen + 1u) * nloc) {
            __builtin_amdgcn_fence(__ATOMIC_RELEASE, "agent");
            asm volatile("s_waitcnt vmcnt(0)" ::: "memory");
            const unsigned og = xb_add(&bar[XB_TOP], 1u);
            const unsigned tg = og / nx;
            if (og + 1u == (tg + 1u) * nx) xb_add(&bar[XB_TOPGEN], 1u);
            else XB_SPIN(xb_ld(&bar[XB_TOPGEN]) == tg, bar);
            __builtin_amdgcn_fence(__ATOMIC_ACQUIRE, "agent");
            xb_add(&bar[XB_XGEN(b.x)], 1u);
            asm volatile("s_waitcnt vmcnt(0)" ::: "memory");
        } else {
            XB_SPIN(xb_ld(&bar[XB_XGEN(b.x)]) == gen, bar);
            __builtin_amdgcn_fence(__ATOMIC_ACQUIRE, "agent");
            asm volatile("s_waitcnt vmcnt(0)" ::: "memory");
        }
    }
    __syncthreads();
}

namespace pg8 {
constexpr int BM = 256, BK = 64, HALF = 128, HTB = HALF * BK * 2, STAGE_BYTES = 8 * HTB, NXCD = 8, WGM = 8;
__host__ __device__ __forceinline__ int lds_byte(int r, int c) { const int st = (r >> 4) * 2 + (c >> 5), rr = r & 15, cc = c & 31, ob = rr * 64 + cc * 2; return st * 1024 + (ob ^ (((ob >> 9) & 1) << 5)); }
__host__ __device__ __forceinline__ void stage_rc(int b, int& R, int& C) { const int st = b / 1024, sb = b % 1024, swz = sb ^ (((sb >> 9) & 1) << 5); R = (st >> 1) * 16 + swz / 64; C = (st & 1) * 32 + (swz % 64) / 2; }
__host__ __device__ __forceinline__ int perm32(int rho) { const int n = rho >> 4, i = rho & 15; return 8 * (i >> 2) + 4 * n + (i & 3); }
struct Unit { int pm, pn; const char* a; const char* b; };

struct StaticOrder {
    int nM, nN, nwg, G, c, K; const char* A; const char* B;
    __device__ void init(const bf16_t* A_, const bf16_t* B_, int M, int N, int K_, int G_, int c_) { A = (const char*)A_; B = (const char*)B_; K = K_; nM = M / BM; nN = N / BM; nwg = nM * nN; G = G_; c = c_; }
    __device__ bool next(int i, Unit& u) const {
        const long L = (long)i * G + c; if (L >= nwg) return false;
        int wgid = (int)L; { const int q = nwg / NXCD, r = nwg % NXCD, xcd = wgid % NXCD, off = wgid / NXCD; wgid = (xcd < r ? xcd * (q + 1) : r * (q + 1) + (xcd - r) * q) + off; }
        const int nig = WGM * nN, gid = wgid / nig, fm = gid * WGM, gsz = (nM - fm) < WGM ? (nM - fm) : WGM;
        u.pm = fm + ((wgid % nig) % gsz); u.pn = (wgid % nig) / gsz;
        u.a = A + (size_t)u.pm * 256 * K * 2; u.b = B + (size_t)u.pn * 256 * K * 2; return true;
    }
};

template <class Epi, class Sched, bool GATHER = false>
__device__ __forceinline__ void gemm_phase(LAS unsigned char* lds, const int K_, const Sched& S, const Epi& E, const char* Aall = nullptr, const int* arow = nullptr) {
    int K = K_; asm volatile("" : "+s"(K));
    int tid_ = threadIdx.x; asm volatile("" : "+v"(tid_));
    const int tid = tid_, wid = __builtin_amdgcn_readfirstlane(tid >> 6), lane = tid & 63, wr = wid >> 2, wc = wid & 3, fr = lane & 15, fq = lane >> 4;
    const int nt = K / BK;
    unsigned voffA[2], voffB[2]; int Rst[2], Cst[2];
#pragma unroll
    for (int i = 0; i < 2; ++i) { int R, C; stage_rc(tid * 16 + i * 8192, R, C); const int Rb = Epi::PERM ? ((R & ~31) + perm32(R & 31)) : R; Rst[i] = R; Cst[i] = C;
        voffA[i] = (unsigned)(R * K + C) * 2u; voffB[i] = (unsigned)(Rb * K + C) * 2u; }
    unsigned gv[2][2], gn[2][2];
#define PG8_GOFF(dst, unit) do { _Pragma("unroll") for (int h_ = 0; h_ < 2; ++h_) _Pragma("unroll") for (int i_ = 0; i_ < 2; ++i_) { const int rr_ = arow[(unit).pm * BM + h_ * HALF + Rst[i_]]; \
        dst[h_][i_] = ((unsigned)(rr_ < 0 ? 0 : rr_ >> 1) * (unsigned)K + (unsigned)Cst[i_]) * 2u; } } while (0)
    const size_t kstep = (size_t)(BK * 2);
    const size_t hstep = (size_t)HALF * K * 2;
    const unsigned ldsw = (unsigned)wid * 1024u;
    const int aoff = lds_byte(wr * 64 + fr, fq * 8), boff = lds_byte(wc * 32 + fr, fq * 8);
#define PG8_SA(b, h) (((b) * 2 + (h)) * HTB)
#define PG8_SB(b, h) ((4 + (b) * 2 + (h)) * HTB)
#define PG8_STAGE(bufoff, gbase, voff) do { _Pragma("unroll") for (int _i = 0; _i < 2; ++_i) \
        __builtin_amdgcn_global_load_lds((const unsigned*)((const char*)(gbase) + (voff)[_i]), (LAS unsigned*)(lds + (bufoff) + ldsw + _i * 8192), 16, 0, 0); } while (0)
#define PG8_LDA(dst, b, h) do { _Pragma("unroll") for (int m = 0; m < 4; ++m) _Pragma("unroll") for (int k = 0; k < 2; ++k) dst[m][k] = *(const LAS bf16x8*)(lds + PG8_SA(b, h) + aoff + m * 2048 + k * 1024); } while (0)
#define PG8_LDB(dst, b, h) do { _Pragma("unroll") for (int n = 0; n < 2; ++n) _Pragma("unroll") for (int k = 0; k < 2; ++k) dst[n][k] = *(const LAS bf16x8*)(lds + PG8_SB(b, h) + boff + n * 2048 + k * 1024); } while (0)
#define PG8_MMA(ai, bj, At, Bt) do { __builtin_amdgcn_s_setprio(1); _Pragma("unroll") for (int m = 0; m < 4; ++m) _Pragma("unroll") for (int n = 0; n < 2; ++n) _Pragma("unroll") for (int k = 0; k < 2; ++k) \
        acc[ai][bj][m][n] = __builtin_amdgcn_mfma_f32_16x16x32_bf16(Bt[n][k], At[m][k], acc[ai][bj][m][n], 0, 0, 0); __builtin_amdgcn_s_setprio(0); } while (0)
#define PG8_WAIT_V(n) asm volatile("s_waitcnt vmcnt(" #n ")" ::: "memory")
#define PG8_WAIT_L(n) asm volatile("s_waitcnt lgkmcnt(" #n ")" ::: "memory")
#define PG8_BAR __builtin_amdgcn_s_barrier()
#define PG8_SCHED __builtin_amdgcn_sched_barrier(0)
    Unit cur, nxt; int ui = 0;
    if (!S.next(0, cur)) return;
    f32x4 acc[2][2][4][2];
#pragma unroll
    for (int a = 0; a < 2; ++a)
#pragma unroll
        for (int b = 0; b < 2; ++b)
#pragma unroll
            for (int m = 0; m < 4; ++m)
#pragma unroll
                for (int n = 0; n < 2; ++n) acc[a][b][m][n] = (f32x4){0.f, 0.f, 0.f, 0.f};
    bf16x8 At[4][2], B0[2][2], B1[2][2];
    const char* cA = GATHER ? Aall : cur.a; const char* cB = cur.b;
    if (GATHER) PG8_GOFF(gv, cur);
#define PG8_STAGE_A(bufoff, gbase, h, vo) do { if (GATHER) PG8_STAGE(bufoff, gbase, (vo)[h]); else PG8_STAGE(bufoff, (gbase) + ((h) ? hstep : 0), voffA); } while (0)
    PG8_STAGE(PG8_SB(0, 0), cB, voffB); PG8_STAGE_A(PG8_SA(0, 0), cA, 0, gv); PG8_STAGE(PG8_SB(0, 1), cB + hstep, voffB); PG8_STAGE_A(PG8_SA(0, 1), cA, 1, gv);
    if (wr == 1) PG8_BAR;
    PG8_WAIT_V(4); PG8_BAR;
    PG8_STAGE(PG8_SB(1, 0), cB + kstep, voffB); PG8_STAGE_A(PG8_SA(1, 0), cA + kstep, 0, gv); PG8_STAGE(PG8_SB(1, 1), cB + hstep + kstep, voffB);
    PG8_WAIT_V(6); PG8_BAR;
    for (;;) {
        const bool has_next = S.next(ui + 1, nxt);
        const char* nA = GATHER ? cA : (has_next ? nxt.a : cA); const char* nB = has_next ? nxt.b : cB;
        if (GATHER) { if (has_next) PG8_GOFF(gn, nxt); else {
#pragma unroll
            for (int h_ = 0; h_ < 2; ++h_)
#pragma unroll
                for (int i_ = 0; i_ < 2; ++i_) gn[h_][i_] = gv[h_][i_]; } }
        for (int t = 0; t < nt; t += 2) {
            const bool last = (t == nt - 2);
            const char* a1 = cA + (size_t)(t + 1) * kstep;
            const char* a2 = last ? nA : cA + (size_t)(t + 2) * kstep; const char* b2 = last ? nB : cB + (size_t)(t + 2) * kstep;
            const char* a3 = a2 + kstep; const char* b3 = b2 + kstep;
            unsigned vo2[2][2];
#pragma unroll
            for (int h_ = 0; h_ < 2; ++h_)
#pragma unroll
                for (int i_ = 0; i_ < 2; ++i_) vo2[h_][i_] = GATHER ? (last ? gn[h_][i_] : gv[h_][i_]) : 0u;
            PG8_LDB(B0, 0, 0); PG8_SCHED; PG8_LDA(At, 0, 0); PG8_STAGE_A(PG8_SA(1, 1), a1, 1, gv);
            PG8_WAIT_L(8); PG8_BAR; PG8_WAIT_L(0); PG8_MMA(0, 0, At, B0); PG8_BAR; PG8_SCHED;
            PG8_LDB(B1, 0, 1); PG8_STAGE(PG8_SB(0, 0), b2, voffB);
            PG8_BAR; PG8_WAIT_L(0); PG8_MMA(0, 1, At, B1); PG8_BAR;
            PG8_LDA(At, 0, 1); PG8_STAGE_A(PG8_SA(0, 0), a2, 0, vo2);
            PG8_BAR; PG8_WAIT_L(0); PG8_MMA(1, 0, At, B0); PG8_BAR; PG8_SCHED;
            PG8_STAGE(PG8_SB(0, 1), b2 + hstep, voffB);
            PG8_WAIT_V(6); PG8_BAR; PG8_MMA(1, 1, At, B1); PG8_BAR;
            PG8_LDB(B0, 1, 0); PG8_SCHED; PG8_LDA(At, 1, 0); PG8_STAGE_A(PG8_SA(0, 1), a2, 1, vo2);
            PG8_WAIT_L(8); PG8_BAR; PG8_WAIT_L(0); PG8_MMA(0, 0, At, B0); PG8_BAR; PG8_SCHED;
            PG8_LDB(B1, 1, 1); PG8_STAGE(PG8_SB(1, 0), b3, voffB);
            PG8_BAR; PG8_WAIT_L(0); PG8_MMA(0, 1, At, B1); PG8_BAR;
            PG8_LDA(At, 1, 1); PG8_STAGE_A(PG8_SA(1, 0), a3, 0, vo2);
            PG8_BAR; PG8_WAIT_L(0); PG8_MMA(1, 0, At, B0); PG8_BAR; PG8_SCHED;
            PG8_STAGE(PG8_SB(1, 1), b3 + hstep, voffB);
            PG8_WAIT_V(6); PG8_BAR; PG8_MMA(1, 1, At, B1); PG8_BAR;
        }
        E(acc, cur, wr, wc, fr, fq);
        if (!has_next) break;
#pragma unroll
        for (int a = 0; a < 2; ++a)
#pragma unroll
            for (int b = 0; b < 2; ++b)
#pragma unroll
                for (int m = 0; m < 4; ++m)
#pragma unroll
                    for (int n = 0; n < 2; ++n) acc[a][b][m][n] = (f32x4){0.f, 0.f, 0.f, 0.f};
        cur = nxt; cA = nA; cB = nB; ++ui;
        if (GATHER) {
#pragma unroll
            for (int h_ = 0; h_ < 2; ++h_)
#pragma unroll
                for (int i_ = 0; i_ < 2; ++i_) gv[h_][i_] = gn[h_][i_]; }
    }
    PG8_WAIT_V(0);
    if (wr == 0) PG8_BAR;
    PG8_BAR;
#undef PG8_SA
#undef PG8_SB
#undef PG8_STAGE
#undef PG8_STAGE_A
#undef PG8_GOFF
#undef PG8_LDA
#undef PG8_LDB
#undef PG8_MMA
#undef PG8_WAIT_V
#undef PG8_WAIT_L
#undef PG8_BAR
#undef PG8_SCHED
}

struct EpiBf16 {
    static constexpr bool PERM = true;
    bf16_t* O; int ldc;
    __device__ __forceinline__ void operator()(const f32x4 (&acc)[2][2][4][2], const Unit& u, int wr, int wc, int fr, int fq) const {
        const int row0 = u.pm * BM + wr * 64 + fr, col0 = u.pn * BM + wc * 32 + 8 * fq;
#pragma unroll
        for (int ai = 0; ai < 2; ++ai)
#pragma unroll
            for (int m = 0; m < 4; ++m) { bf16_t* rowp = O + (size_t)(row0 + ai * HALF + m * 16) * ldc + col0;
#pragma unroll
                for (int bj = 0; bj < 2; ++bj) { const f32x4 v0 = acc[ai][bj][m][0], v1 = acc[ai][bj][m][1];
                    u32x4 w; w.x = cvt_pk_bf16(v0[0], v0[1]); w.y = cvt_pk_bf16(v0[2], v0[3]); w.z = cvt_pk_bf16(v1[0], v1[1]); w.w = cvt_pk_bf16(v1[2], v1[3]);
                    st16_wt(rowp + bj * HALF, w); } }
    }
};
struct EpiResid {
    static constexpr bool PERM = false;
    const float* Cin; float* C; int ldc;
    __device__ __forceinline__ void operator()(const f32x4 (&acc)[2][2][4][2], const Unit& u, int wr, int wc, int fr_, int fq_) const {
        int fr = fr_, fq = fq_; asm volatile("" : "+v"(fr), "+v"(fq));
        const int row0 = u.pm * BM + wr * 64 + fr, col0 = u.pn * BM + wc * 32 + 4 * fq;
#pragma unroll
        for (int ai = 0; ai < 2; ++ai)
#pragma unroll
            for (int mp = 0; mp < 2; ++mp) { f32x4 cv[2][2][2];
#pragma unroll
                for (int mm = 0; mm < 2; ++mm) { const float* rowp = Cin + (size_t)(row0 + ai * HALF + (2 * mp + mm) * 16) * ldc + col0;
#pragma unroll
                    for (int bj = 0; bj < 2; ++bj)
#pragma unroll
                        for (int n = 0; n < 2; ++n) cv[mm][bj][n] = *(const f32x4*)(rowp + bj * HALF + n * 16); }
#pragma unroll
                for (int mm = 0; mm < 2; ++mm) { float* rowp = C + (size_t)(row0 + ai * HALF + (2 * mp + mm) * 16) * ldc + col0;
#pragma unroll
                    for (int bj = 0; bj < 2; ++bj)
#pragma unroll
                        for (int n = 0; n < 2; ++n) { const f32x4 o_ = cv[mm][bj][n] + acc[ai][bj][2 * mp + mm][n]; st16_wt(rowp + bj * HALF + n * 16, __builtin_bit_cast(u32x4, o_)); } }
                asm volatile("" ::: "memory"); }
    }
};
template <int ACT  > struct EpiGated {
    static constexpr bool PERM = true;
    bf16_t* O; int ldo; int coloff; const float* ba; const float* bb;
    __device__ __forceinline__ void operator()(const f32x4 (&acc)[2][2][4][2], const Unit& u, int wr, int wc, int fr, int fq) const {
        const int row0 = u.pm * BM + wr * 64 + fr, cl = u.pn * HALF + wc * 32 + 8 * fq;
        float va[8], vb[8];
#pragma unroll
        for (int j = 0; j < 8; ++j) { va[j] = (ACT == 0) ? ba[cl + j] : 0.f; vb[j] = (ACT == 0) ? bb[cl + j] : 0.f; }
#pragma unroll
        for (int ai = 0; ai < 2; ++ai)
#pragma unroll
            for (int m = 0; m < 4; ++m) { bf16_t* rowp = O + (size_t)(row0 + ai * HALF + m * 16) * ldo + coloff + cl;
                float o[8];
#pragma unroll
                for (int n = 0; n < 2; ++n)
#pragma unroll
                    for (int j = 0; j < 4; ++j) { const float a = acc[ai][0][m][n][j] + va[4 * n + j], b = acc[ai][1][m][n][j] + vb[4 * n + j];
                        o[4 * n + j] = (ACT == 0) ? a * sigmoidf_(b) : siluf_(a) * b; }
                u32x4 w; w.x = cvt_pk_bf16(o[0], o[1]); w.y = cvt_pk_bf16(o[2], o[3]); w.z = cvt_pk_bf16(o[4], o[5]); w.w = cvt_pk_bf16(o[6], o[7]);
                st16_wt(rowp, w); asm volatile("" ::: "memory"); }
    }
};
struct EpiMoeOut {
    static constexpr bool PERM = true;
    bf16_t* O; const int* row_tok; const float* row_w; LAS unsigned char* lds;
    __device__ __forceinline__ void operator()(const f32x4 (&acc)[2][2][4][2], const Unit& u, int wr, int wc, int fr_, int fq_) const {
        int fr = fr_, fq = fq_; asm volatile("" : "+v"(fr), "+v"(fq));
        const int col0 = u.pn * BM + wc * 32 + 8 * fq, lane = fq * 16 + fr;
        LAS u32x2* rinfo = (LAS u32x2*)(lds + STAGE_BYTES) + (wr * 4 + wc) * 128;
        { const int ra = u.pm * BM + wr * 64 + lane, rb = ra + HALF;
          const u32x2 ia = (u32x2){(unsigned)row_tok[ra], __float_as_uint(row_w[ra])}, ib = (u32x2){(unsigned)row_tok[rb], __float_as_uint(row_w[rb])};
          rinfo[lane] = ia; rinfo[64 + lane] = ib; }
#pragma unroll
        for (int ai = 0; ai < 2; ++ai)
#pragma unroll
            for (int m = 0; m < 4; ++m) { const u32x2 inf = rinfo[ai * 64 + m * 16 + fr]; const int ts = (int)inf.x; const float w = __uint_as_float(inf.y);
                if (ts >= 0) { bf16_t* rowp = O + ((size_t)(ts & 1) * NTOK + (size_t)(ts >> 1)) * DM + col0;
#pragma unroll
                    for (int bj = 0; bj < 2; ++bj) { const f32x4 v0 = acc[ai][bj][m][0] * w, v1 = acc[ai][bj][m][1] * w;
                        u32x4 q; q.x = cvt_pk_bf16(v0[0], v0[1]); q.y = cvt_pk_bf16(v0[2], v0[3]); q.z = cvt_pk_bf16(v1[0], v1[1]); q.w = cvt_pk_bf16(v1[2], v1[3]);
                        st16_wt(rowp + bj * HALF, q); } } }
    }
};
struct MoeOrder {
    int K; const char* A; const char* B; size_t bstride; const LAS int* list;
    static __device__ __forceinline__ void build(LAS int* list, const int* tiles, int nN, int G, int c) {
        const int nrt = tiles[0], nwg = nrt * nN; int n = 0;
        for (int i = 0; ; ++i) { const long L = (long)i * G + c; if (L >= (long)nwg || n >= 20) break;
            int wgid = (int)L; { const int q = nwg / NXCD, r = nwg % NXCD, xcd = wgid % NXCD, off = wgid / NXCD; wgid = (xcd < r ? xcd * (q + 1) : r * (q + 1) + (xcd - r) * q) + off; }
            const int pm = wgid / nN; list[1 + 3 * n] = pm; list[2 + 3 * n] = wgid % nN; list[3 + 3 * n] = tiles[64 + pm]; ++n; }
        list[0] = n;
    }
    __device__ bool next(int i, Unit& u) const {
        const int n = __builtin_amdgcn_readfirstlane(list[0]); if (i >= n) return false;
        u.pm = __builtin_amdgcn_readfirstlane(list[1 + 3 * i]); u.pn = __builtin_amdgcn_readfirstlane(list[2 + 3 * i]); const int e = __builtin_amdgcn_readfirstlane(list[3 + 3 * i]);
        u.a = A + (size_t)u.pm * 256 * K * 2; u.b = B + (size_t)e * bstride + (size_t)u.pn * 256 * K * 2; return true;
    }
};
}

struct Params { const float* in[44]; float* out; unsigned char* ws; int ph_lo, ph_hi; };
enum { I_X = 0, I_NORM1, I_WIN, I_MCONVW, I_MCONVB, I_MDTB, I_MALOG, I_MD, I_MNORM, I_RMU, I_RW0, I_RW2, I_RA0, I_RA2, I_RG2, I_RKK, I_RKA, I_RRK, I_RLNW, I_RLNB,
       I_CKVN, I_CWUK, I_CWUV, I_RELB, I_SARE, I_SAIM, I_SBRE, I_SBIM, I_SCRE, I_SCIM, I_SD, I_SLOGDT, I_SGLUW, I_SGLUB, I_WOUT, I_NORM2, I_WRG, I_BRG, I_WRE, I_BRE,
       I_WGATE, I_WUP, I_WDOWN, I_FNORM };

typedef const float* const __attribute__((address_space(4)))* in_tab_t;
struct Frame {
    LAS unsigned char* lds; int tid, lane, wave, bid, G;
    in_tab_t in; float* out; unsigned char* ws; unsigned* ctl;
    volatile LAS int* misc;
};

__device__ __forceinline__ int q_pop(Frame& F, int qi) {
    __syncthreads();
    if (F.tid == 0) F.misc[0] = (int)__hip_atomic_fetch_add(F.ctl + CW_Q + 64 * qi, 1u, __ATOMIC_RELAXED, __HIP_MEMORY_SCOPE_AGENT);
    __syncthreads();
    return F.misc[0];
}

__device__ __forceinline__ const void* opaque_ptr(const void* p) { const unsigned long long v = (unsigned long long)p; unsigned lo = __builtin_amdgcn_readfirstlane((unsigned)v), hi = __builtin_amdgcn_readfirstlane((unsigned)(v >> 32));
    asm volatile("" : "+s"(lo), "+s"(hi)); return (const void*)(((unsigned long long)hi << 32) | lo); }
__device__ __forceinline__ Frame relocal(const Frame& G) { Frame F = G; asm volatile("" : "+v"(F.tid)); F.ws = (unsigned char*)opaque_ptr(F.ws); F.ctl = (unsigned*)(F.ws + WS_CTL); F.in = (in_tab_t)(unsigned long long)opaque_ptr((const void*)(unsigned long long)F.in); F.lane = F.tid & 63; F.wave = __builtin_amdgcn_readfirstlane(F.tid >> 6); return F; }
template <int K> __device__ __forceinline__ f32x4 mma_nt(const LAS bf16_t* A, int lda, const LAS bf16_t* Bt, int ldb, f32x4 acc, int lane) {
    const int r = lane & 15, g = lane >> 4;
#pragma unroll
    for (int k0 = 0; k0 < K; k0 += 32) {
        const bf16x8 a = *(const LAS bf16x8*)(A + r * lda + k0 + 8 * g);
        const bf16x8 b = *(const LAS bf16x8*)(Bt + r * ldb + k0 + 8 * g);
        acc = __builtin_amdgcn_mfma_f32_16x16x32_bf16(a, b, acc, 0, 0, 0);
    }
    return acc;
}

template <class SrcMap> __device__ __forceinline__ void tr_tile(Frame& F, int ldsrc, bf16_t* dst, int K, int k0, int n0, SrcMap sm) {
    LAS float* tile = (LAS float*)F.lds;
    __syncthreads();
    { const int n4 = (F.tid & 63) * 4, kk = F.tid >> 6; const float* sp = sm(n0 + n4);
      f32x4 v[8];
#pragma unroll
      for (int ps = 0; ps < 8; ++ps) { v[ps] = (f32x4){0.f, 0.f, 0.f, 0.f}; if (sp) v[ps] = __builtin_nontemporal_load((const f32x4*)(sp + (size_t)(k0 + kk + 8 * ps) * ldsrc)); }
#pragma unroll
      for (int ps = 0; ps < 8; ++ps) { LAS float* t = tile + (kk + 8 * ps) * 257 + n4; t[0] = v[ps][0]; t[1] = v[ps][1]; t[2] = v[ps][2]; t[3] = v[ps][3]; } }
    __syncthreads();
    { const int kc = F.tid & 7;
#pragma unroll
      for (int j = 0; j < 4; ++j) { const int n = (F.tid >> 3) + 64 * j; float f[8];
#pragma unroll
          for (int i = 0; i < 8; ++i) f[i] = tile[(8 * kc + i) * 257 + n];
          u32x4 w; w.x = pk2(f[0], f[1]); w.y = pk2(f[2], f[3]); w.z = pk2(f[4], f[5]); w.w = pk2(f[6], f[7]);
          *(u32x4*)(dst + (size_t)(n0 + n) * K + k0 + 8 * kc) = w; } }
}

struct SmIn { const float* base; __device__ __forceinline__ const float* operator()(int n) const {
    int c; if (n < 772) c = n; else if (n < UR) return nullptr; else if (n < UR + 896) c = 772 + (n - UR); else if (n < UC) return nullptr;
    else if (n < UC + 680) c = 1668 + (n - UC); else if (n < US) return nullptr; else if (n < US + 256) c = 2348 + (n - US); else return nullptr; return base + c; } };
struct SmId { const float* base; __device__ __forceinline__ const float* operator()(int n) const { return base + n; } };
struct SmGlu { const float* base; __device__ __forceinline__ const float* operator()(int n) const { const int pn = n >> 8, rr = n & 255; return base + (rr < 128 ? 128 * pn + rr : 256 + 128 * pn + (rr - 128)); } };
struct SmGU { const float* gate; const float* up; __device__ __forceinline__ const float* operator()(int n) const {
    const unsigned long long d = (unsigned long long)up - (unsigned long long)gate; const unsigned long long a = (unsigned long long)gate + (((n & 255) < 128) ? 0ull : d); return (const float*)a + 128 * (n >> 8) + (n & 127); } };
__device__ __forceinline__ void phase_prologue(const Frame& F_) { Frame F = relocal(F_);
    for (int t = F.bid; t < 496; t += F.G) {
        if (t < 352) { const int l = t / 176, r = t % 176, kt = r / 11, nt = r % 11;
            tr_tile(F, NIN, (bf16_t*)(F.ws + WS_WIN) + (size_t)l * NINP * DM, DM, kt * 64, nt * 256, SmIn{F.in[I_WIN] + (size_t)l * DM * NIN}); }
        else if (t < 480) { const int q = t - 352, l = q / 64, r = q % 64, kt = r / 4, nt = r % 4;
            tr_tile(F, DM, (bf16_t*)(F.ws + WS_WOUT) + (size_t)l * DM * DM, DM, kt * 64, nt * 256, SmId{F.in[I_WOUT] + (size_t)l * DM * DM}); }
        else { const int q = t - 480, l = q / 8, r = q % 8, kt = r / 2, nt = r % 2;
            tr_tile(F, 512, (bf16_t*)(F.ws + WS_GLU) + (size_t)l * 512 * 256, 256, kt * 64, nt * 256, SmGlu{F.in[I_SGLUW] + (size_t)l * 256 * 512}); }
    }
    for (int i = F.bid * NTHR + F.tid; i < 2 * 48 * 1024; i += F.G * NTHR) { const int l = i / 49152, r = i % 49152, o = r >> 10, k = r & 1023;
        float v = 0.f; if (o < 32) v = F.in[I_WRE][((size_t)l * DM + k) * 32 + o]; else if (o < 36) v = F.in[I_WRG][((size_t)l * DM + k) * 4 + (o - 32)];
        v *= F.in[I_NORM2][l * DM + k];
        const bf16_t hi = f2bf(v); const bf16_t lo = f2bf(v - bf2f(hi));
        bf16_t* w = (bf16_t*)(F.ws + WS_WRT) + (size_t)l * 2 * 49152; w[r] = hi; w[49152 + r] = lo; }
    for (int i = F.bid * NTHR + F.tid; i < 2048 + 65536; i += F.G * NTHR) {
        if (i < 2048) {
            const int l = i >> 10, gn = i & 1023, g = gn >> 6;
            float* tab = (float*)(F.ws + WS_S5TAB + (size_t)l * S5TAB_L);
            const float lre = fminf(F.in[I_SARE][l * 1024 + gn], -1e-4f), lim = F.in[I_SAIM][l * 1024 + gn];
            const float dt = expf(F.in[I_SLOGDT][l * 16 + g]);
            const float mag = expf(dt * lre); float sn, cs; sincosf(dt * lim, &sn, &cs);
            const float are = mag * cs, aim = mag * sn;
            const float den = lre * lre + lim * lim;
            const float fre = ((are - 1.0f) * lre + aim * lim) / den, fim = (aim * lre - (are - 1.0f) * lim) / den;
            tab[gn * 2] = are; tab[gn * 2 + 1] = aim;
            float pr = are, pi = aim;
#pragma unroll
            for (int s = 0; s < 6; ++s) { const float nr = pr * pr - pi * pi, ni = 2.0f * pr * pi; pr = nr; pi = ni; }
            tab[2048 + gn * 2] = pr; tab[2048 + gn * 2 + 1] = pi;
            const float* bre = F.in[I_SBRE] + ((size_t)l * 1024 + gn) * 16; const float* bim = F.in[I_SBIM] + ((size_t)l * 1024 + gn) * 16;
            bf16_t* bbt = (bf16_t*)(F.ws + WS_S5TAB + (size_t)l * S5TAB_L + S5TAB_BBT); const int n = gn & 63, col = 4 * (n & 31) + 2 * (n >> 5);
            for (int p = 0; p < 16; ++p) { const float vr = fre * bre[p] - fim * bim[p], vi = fre * bim[p] + fim * bre[p];
                bbt[((size_t)g * 128 + col) * 16 + p] = f2bf(vr); bbt[((size_t)g * 128 + col + 1) * 16 + p] = f2bf(vi); }
        } else {
            const int j = i - 2048, l = j >> 15, r = j & 32767, gp = r >> 7, k = r & 127;
            bf16_t* cm = (bf16_t*)(F.ws + WS_S5TAB + (size_t)l * S5TAB_L + S5TAB_F);
            const int n = (k >> 2) + 32 * ((k >> 1) & 1);
            const float v = (k & 1) == 0 ? F.in[I_SCRE][((size_t)l * 256 + gp) * 64 + n] : -F.in[I_SCIM][((size_t)l * 256 + gp) * 64 + n];
            cm[r] = f2bf(v);
        }
    }
}

__device__ __forceinline__ void phase_norm(const Frame& F_, const float* xin, bool add_o, const float* w, int mode) { Frame F = relocal(F_);
    float* X = (float*)(F.ws + WS_X); bf16_t* H = (bf16_t*)(F.ws + WS_H); const bf16_t* O = (const bf16_t*)(F.ws + WS_U);
    for (int row0 = F.bid * 32 + F.wave * 4; row0 < NTOK; row0 += F.G * 32) {
        f32x4 v[4][4]; u32x2 oa[4][4], ob[4][4];
#pragma unroll
        for (int r = 0; r < 4; ++r)
#pragma unroll
            for (int j = 0; j < 4; ++j) { const int c = 4 * F.lane + 256 * j; const size_t o = (size_t)(row0 + r) * DM + c; v[r][j] = (mode == 2) ? __builtin_nontemporal_load((const f32x4*)(xin + o)) : *(const f32x4*)(xin + o);
                if (add_o) { oa[r][j] = __builtin_nontemporal_load((const u32x2*)(O + o)); ob[r][j] = __builtin_nontemporal_load((const u32x2*)(O + (size_t)NTOK * DM + o)); } }
#pragma unroll
        for (int r = 0; r < 4; ++r) { const int row = row0 + r; float ss = 0.f;
#pragma unroll
            for (int j = 0; j < 4; ++j) {
                if (add_o) { const u32x2 a = oa[r][j], b = ob[r][j];
                    v[r][j][0] += __uint_as_float(a.x << 16) + __uint_as_float(b.x << 16); v[r][j][1] += __uint_as_float(a.x & 0xffff0000u) + __uint_as_float(b.x & 0xffff0000u);
                    v[r][j][2] += __uint_as_float(a.y << 16) + __uint_as_float(b.y << 16); v[r][j][3] += __uint_as_float(a.y & 0xffff0000u) + __uint_as_float(b.y & 0xffff0000u); }
                ss += v[r][j][0] * v[r][j][0] + v[r][j][1] * v[r][j][1] + v[r][j][2] * v[r][j][2] + v[r][j][3] * v[r][j][3]; }
            ss = wave_sum(ss);
            const float rstd = rsqrtf(ss * (1.0f / DM) + 1e-6f);
#pragma unroll
            for (int j = 0; j < 4; ++j) { const int c = 4 * F.lane + 256 * j; const f32x4 wv = *(const f32x4*)(w + c);
                if (mode == 2) { __builtin_nontemporal_store(v[r][j] * rstd * wv, (f32x4*)(F.out + (size_t)row * DM + c)); }
                else { if (mode == 0) *(f32x4*)(X + (size_t)row * DM + c) = v[r][j];
                    u32x2 o; o.x = pk2(v[r][j][0] * rstd * wv[0], v[r][j][1] * rstd * wv[1]); o.y = pk2(v[r][j][2] * rstd * wv[2], v[r][j][3] * rstd * wv[3]);
                    *(u32x2*)(H + (size_t)row * DM + c) = o; } } }
    }
}

__device__ __forceinline__ void item_kv(const Frame& F_, int layer, int item) { Frame F = relocal(F_);
    const bf16_t* U = (const bf16_t*)(F.ws + WS_U);
    LAS bf16_t* Ab = (LAS bf16_t*)F.lds;
    LAS bf16_t* Bt = (LAS bf16_t*)(F.lds + 17408);
    const int t0 = item * 64;
    { const int tok = F.tid >> 3, part = F.tid & 7; const bf16_t* src = U + (size_t)(t0 + tok) * NINP + UC + 256 + 16 * part;
      float f[16]; { float a[8], b[8]; unpack8(*(const u32x4*)src, a); unpack8(*(const u32x4*)(src + 8), b);
#pragma unroll
        for (int j = 0; j < 8; ++j) { f[j] = a[j]; f[8 + j] = b[j]; } }
      float ss = 0.f;
#pragma unroll
      for (int j = 0; j < 16; ++j) ss += f[j] * f[j];
      ss = sum8(ss);
      const float rstd = rsqrtf(ss * (1.0f / 128.0f) + 1e-6f); const float* nw = F.in[I_CKVN] + layer * 128 + 16 * part;
#pragma unroll
      for (int j = 0; j < 16; j += 2) *(LAS unsigned*)(Ab + tok * 136 + 16 * part + j) = pk2(f[j] * rstd * nw[j], f[j + 1] * rstd * nw[j + 1]); }
    { const int n = F.tid >> 2, kq = F.tid & 3; const float* w = (n < 64 ? F.in[I_CWUK] : F.in[I_CWUV]) + (size_t)layer * 128 * 64 + (n & 63);
      float wv[32];
#pragma unroll
      for (int k = 0; k < 32; ++k) wv[k] = w[(size_t)(32 * kq + k) * 64];
#pragma unroll
      for (int k = 0; k < 32; k += 2) *(LAS unsigned*)(Bt + n * 136 + 32 * kq + k) = pk2(wv[k], wv[k + 1]); }
    if (F.tid < 256) { const int tok = F.tid >> 2, q = F.tid & 3;
        *(u32x4*)((bf16_t*)(F.ws + WS_KIDX) + (size_t)(t0 + tok) * 32 + 8 * q) = *(const u32x4*)(U + (size_t)(t0 + tok) * NINP + UC + 640 + 8 * q); }
    __syncthreads();
    const int mt = F.wave & 3, g = F.lane >> 4, r = F.lane & 15;
#pragma unroll
    for (int q = 0; q < 4; ++q) { const int nt = (F.wave >> 2) * 4 + q;
        f32x4 acc = (f32x4){0.f, 0.f, 0.f, 0.f};
        acc = mma_nt<128>(Ab + mt * 16 * 136, 136, Bt + nt * 16 * 136, 136, acc, F.lane);
        const int n = nt * 16 + r; bf16_t* dst = (bf16_t*)(F.ws + (n < 64 ? WS_K : WS_V));
#pragma unroll
        for (int i = 0; i < 4; ++i) dst[(size_t)(t0 + mt * 16 + 4 * g + i) * 64 + (n & 63)] = f2bf(acc[i]); }
}

constexpr int MB_CG = 0, MB_BG = 18432, MB_XT = 36864, MB_BT = 73728, MB_M = 73728, MB_S0 = 110592, MB_DT = 147456, MB_AC = 148480, MB_RS = 149504;
static_assert(MB_RS + 256 <= MISC_OFF && MB_BT == MB_XT + 4 * 64 * 72 * 2, "mamba LDS");
template <int STAGE> __device__ __forceinline__ void item_mamba(const Frame& F_, int layer, int item) { Frame F = relocal(F_);
    const bf16_t* U = (const bf16_t*)(F.ws + WS_U);
    const int b = item >> 6, c = item & 63, l0 = c * 64; const size_t T0 = (size_t)b * SEQ + l0;
    LAS bf16_t* Cg = (LAS bf16_t*)(F.lds + MB_CG); LAS bf16_t* Bg = (LAS bf16_t*)(F.lds + MB_BG); LAS bf16_t* BT = (LAS bf16_t*)(F.lds + MB_BT);
    LAS bf16_t* XT = (LAS bf16_t*)(F.lds + MB_XT); LAS bf16_t* Mb = (LAS bf16_t*)(F.lds + MB_M); LAS bf16_t* S0 = (LAS bf16_t*)(F.lds + MB_S0);
    LAS float* dts = (LAS float*)(F.lds + MB_DT); LAS float* acs = (LAS float*)(F.lds + MB_AC); LAS float* rs = (LAS float*)(F.lds + MB_RS);
    const int tg = F.tid & 7, c0 = (F.tid >> 3) * 8;
    const bool conv_on = (STAGE == 2) || (F.wave < 6);
    u32x4 rows[11]; float wv[4][8], bv[8];
    if (conv_on) {
#pragma unroll
        for (int k = 0; k < 11; ++k) { const int l = l0 + tg * 8 - 3 + k;
            if (l >= 0) rows[k] = *(const u32x4*)(U + ((size_t)b * SEQ + l) * NINP + UM + 256 + c0); else rows[k] = (u32x4){0u, 0u, 0u, 0u}; }
#pragma unroll
        for (int j = 0; j < 8; ++j) { bv[j] = F.in[I_MCONVB][layer * 512 + c0 + j];
#pragma unroll
            for (int k = 0; k < 4; ++k) wv[k][j] = F.in[I_MCONVW][(layer * 4 + k) * 512 + c0 + j]; } }
    const float* MSTi = (const float*)(F.ws + WS_MST) + ((size_t)(b * 64 + c) * 4) * 4096;
    f32x4 s0a[4], s0b[4];
    if (STAGE == 2) {
#pragma unroll
        for (int h = 0; h < 4; ++h) { const float* src = MSTi + (size_t)h * 4096 + F.tid * 8; s0a[h] = *(const f32x4*)src; s0b[h] = *(const f32x4*)(src + 4); } }
    if (F.wave < 4) { const int l = F.lane, h = F.wave;
        const float raw = bf2f(U[(T0 + l) * NINP + UM + 768 + h]) + F.in[I_MDTB][layer * 4 + h];
        const float dt = softplusf_(raw); float cum = -__expf(F.in[I_MALOG][layer * 4 + h]) * dt;
#pragma unroll
        for (int o = 1; o < 64; o <<= 1) { const float t = __int_as_float(__builtin_amdgcn_ds_bpermute(((lane_id_() - o) & 63) << 2, __float_as_int(cum))); if (l >= o) cum += t; }
        dts[l * 4 + h] = dt; acs[l * 4 + h] = cum; }
    if (STAGE == 2) { if (F.tid < 64) rs[F.tid] = 0.f;
#pragma unroll
        for (int h = 0; h < 4; ++h) { u32x4 w; w.x = pk2(s0a[h][0], s0a[h][1]); w.y = pk2(s0a[h][2], s0a[h][3]); w.z = pk2(s0b[h][0], s0b[h][1]); w.w = pk2(s0b[h][2], s0b[h][3]);
            *(LAS u32x4*)(S0 + (h * 64 + (F.tid >> 3)) * 72 + (F.tid & 7) * 8) = w; } }
    __syncthreads();
    if (conv_on) {
        float win[3][8]; unpack8(rows[0], win[0]); unpack8(rows[1], win[1]); unpack8(rows[2], win[2]);
        const bool isx = F.wave < 4, tr = isx || STAGE == 1;
        unsigned pkT[8][4]; float prev[8];
#pragma unroll
        for (int i = 0; i < 8; ++i) { const int l = tg * 8 + i; float cur[8]; unpack8(rows[3 + i], cur);
            float o[8];
#pragma unroll
            for (int j = 0; j < 8; ++j) { o[j] = siluf_(bv[j] + wv[0][j] * win[0][j] + wv[1][j] * win[1][j] + wv[2][j] * win[2][j] + wv[3][j] * cur[j]);
                win[0][j] = win[1][j]; win[1][j] = win[2][j]; win[2][j] = cur[j]; }
            if (isx) { const int h = F.wave; float sc = dts[l * 4 + h]; if (STAGE == 1) sc *= __expf(acs[63 * 4 + h] - acs[l * 4 + h]);
#pragma unroll
                for (int j = 0; j < 8; ++j) o[j] *= sc; }
            if (tr) {
#pragma unroll
                for (int j = 0; j < 8; ++j) { if (i & 1) pkT[j][i >> 1] = pk2(prev[j], o[j]); else prev[j] = o[j]; } }
            else { u32x4 w; w.x = pk2(o[0], o[1]); w.y = pk2(o[2], o[3]); w.z = pk2(o[4], o[5]); w.w = pk2(o[6], o[7]);
                *(LAS u32x4*)(Cg + (F.wave < 6 ? (MB_BG - MB_CG) / 2 : 0) + ((F.wave & 1) * 64 + l) * 72 + (c0 & 63)) = w; } }
        if (tr) { LAS bf16_t* dstT = XT + F.wave * 64 * 72;
#pragma unroll
            for (int j = 0; j < 8; ++j) *(LAS u32x4*)(dstT + ((c0 & 63) + j) * 72 + tg * 8) = (u32x4){pkT[j][0], pkT[j][1], pkT[j][2], pkT[j][3]}; } }
    const int g4 = F.lane >> 4, r16 = F.lane & 15;
    if (STAGE == 1) {
        __syncthreads();
        float* MST = (float*)(F.ws + WS_MST) + ((size_t)(b * 64 + c) * 4) * 4096;
#pragma unroll
        for (int q = 0; q < 8; ++q) { const int tix = F.wave * 8 + q, h = tix >> 4, mt = (tix >> 2) & 3, nt = tix & 3;
            f32x4 acc = (f32x4){0.f, 0.f, 0.f, 0.f};
            acc = mma_nt<64>(XT + (h * 64 + mt * 16) * 72, 72, BT + ((h >> 1) * 64 + nt * 16) * 72, 72, acc, F.lane);
#pragma unroll
            for (int i = 0; i < 4; ++i) MST[(size_t)h * 4096 + (mt * 16 + 4 * g4 + i) * 64 + nt * 16 + r16] = acc[i]; }
        if (F.tid < 4) ((float*)(F.ws + WS_MDEC))[(b * 64 + c) * 4 + F.tid] = __expf(acs[63 * 4 + F.tid]);
    } else {
        const int mt = F.wave & 3, nh = F.wave >> 2;
        bf16_t zz[4][2][4];
#pragma unroll
        for (int h = 0; h < 4; ++h)
#pragma unroll
            for (int q = 0; q < 2; ++q)
#pragma unroll
                for (int i = 0; i < 4; ++i) zz[h][q][i] = U[(T0 + mt * 16 + 4 * g4 + i) * NINP + UM + h * 64 + (2 * nh + q) * 16 + r16];
        __syncthreads();
        f32x4 yv[4][2];
#pragma unroll
        for (int g = 0; g < 2; ++g)
#pragma unroll
            for (int q = 0; q < 2; ++q) { f32x4 G = (f32x4){0.f, 0.f, 0.f, 0.f};
                G = mma_nt<64>(Cg + (g * 64 + mt * 16) * 72, 72, Bg + (g * 64 + (2 * nh + q) * 16) * 72, 72, G, F.lane);
                const int s = (2 * nh + q) * 16 + r16;
#pragma unroll
                for (int hh = 0; hh < 2; ++hh) { const int h = 2 * g + hh; const float as = acs[s * 4 + h];
#pragma unroll
                    for (int i = 0; i < 4; ++i) { const int l = mt * 16 + 4 * g4 + i; const float v = (s <= l) ? G[i] * __expf(acs[l * 4 + h] - as) : 0.f;
                        Mb[(h * 64 + l) * 72 + s] = f2bf(v); } } }
        __syncthreads();
#pragma unroll
        for (int h = 0; h < 4; ++h) { const int g = h >> 1;
#pragma unroll
            for (int q = 0; q < 2; ++q) { const int nt = 2 * nh + q;
                f32x4 yd = (f32x4){0.f, 0.f, 0.f, 0.f}, yo = (f32x4){0.f, 0.f, 0.f, 0.f};
                yd = mma_nt<64>(Mb + (h * 64 + mt * 16) * 72, 72, XT + (h * 64 + nt * 16) * 72, 72, yd, F.lane);
                yo = mma_nt<64>(Cg + (g * 64 + mt * 16) * 72, 72, S0 + (h * 64 + nt * 16) * 72, 72, yo, F.lane);
                const int p = nt * 16 + r16; const float dsk = F.in[I_MD][layer * 4 + h];
#pragma unroll
                for (int i = 0; i < 4; ++i) { const int l = mt * 16 + 4 * g4 + i;
                    const float xs = bf2f(XT[(h * 64 + p) * 72 + l]) / dts[l * 4 + h];
                    yv[h][q][i] = yd[i] + yo[i] * __expf(acs[l * 4 + h]) + dsk * xs; } } }
        float part[4] = {0.f, 0.f, 0.f, 0.f};
#pragma unroll
        for (int h = 0; h < 4; ++h)
#pragma unroll
            for (int q = 0; q < 2; ++q) {
#pragma unroll
                for (int i = 0; i < 4; ++i) { const float z = bf2f(zz[h][q][i]);
                    const float v = yv[h][q][i] * siluf_(z); yv[h][q][i] = v; part[i] += v * v; } }
#pragma unroll
        for (int i = 0; i < 4; ++i) { const float s = sum16(part[i]); if (r16 == 0) atomicAdd((float*)(rs + mt * 16 + 4 * g4 + i), s); }
        __syncthreads();
        bf16_t* Y = (bf16_t*)(F.ws + WS_H);
#pragma unroll
        for (int i = 0; i < 4; ++i) { const int l = mt * 16 + 4 * g4 + i; const float rstd = rsqrtf(rs[l] * (1.0f / 256.0f) + 1e-6f);
#pragma unroll
            for (int h = 0; h < 4; ++h)
#pragma unroll
                for (int q = 0; q < 2; ++q) { const int ch = h * 64 + (2 * nh + q) * 16 + r16;
                    Y[(T0 + l) * DM + ch] = f2bf(yv[h][q][i] * rstd * F.in[I_MNORM][layer * 256 + ch]); } }
    }
}
__device__ __forceinline__ void item_mamba_carry(const Frame& F_, int item) { Frame F = relocal(F_);
    const int b = item >> 2, h = item & 3;
    float* MST = (float*)(F.ws + WS_MST); const float* MD = (const float*)(F.ws + WS_MDEC);
    float s[8];
#pragma unroll
    for (int j = 0; j < 8; ++j) s[j] = 0.f;
    for (int c = 0; c < 64; ++c) { float* p = MST + ((size_t)(b * 64 + c) * 4 + h) * 4096 + F.tid * 8; const float d = MD[(b * 64 + c) * 4 + h];
        const f32x4 a = *(f32x4*)p, q = *(f32x4*)(p + 4);
        *(f32x4*)p = (f32x4){s[0], s[1], s[2], s[3]}; *(f32x4*)(p + 4) = (f32x4){s[4], s[5], s[6], s[7]};
        s[0] = s[0] * d + a[0]; s[1] = s[1] * d + a[1]; s[2] = s[2] * d + a[2]; s[3] = s[3] * d + a[3];
        s[4] = s[4] * d + q[0]; s[5] = s[5] * d + q[1]; s[6] = s[6] * d + q[2]; s[7] = s[7] * d + q[3]; }
}

template <int STAGE> __device__ __forceinline__ void item_s5(const Frame& F_, int layer, int item) { Frame F = relocal(F_);
    const bf16_t* U = (const bf16_t*)(F.ws + WS_U);
    const int b = item >> 6, c = item & 63; const size_t T0 = (size_t)b * SEQ + c * 64;
    LAS bf16_t* us = (LAS bf16_t*)F.lds;
    LAS bf16_t* BuW = (LAS bf16_t*)(F.lds + 33792) + F.wave * 4224;
    const float* tab = (const float*)(F.ws + WS_S5TAB + (size_t)layer * S5TAB_L);
    { const int tok = F.tid >> 3, part = F.tid & 7;
#pragma unroll
      for (int q = 0; q < 4; ++q) *(LAS u32x4*)(us + tok * 264 + 32 * part + 8 * q) = *(const u32x4*)(U + (T0 + tok) * NINP + US + 32 * part + 8 * q); }
    const int lane = F.lane, r16 = lane & 15, g4 = lane >> 4, gq = lane >> 5, n0 = lane & 31, g = 2 * F.wave + gq, gn0 = g * 64 + n0, gn1 = gn0 + 32;
    bf16x8 bfr[2][8];
    { const bf16_t* bbt = (const bf16_t*)(F.ws + WS_S5TAB + (size_t)layer * S5TAB_L + S5TAB_BBT);
#pragma unroll
      for (int gg = 0; gg < 2; ++gg)
#pragma unroll
          for (int nt = 0; nt < 8; ++nt) { u32x4 z = (u32x4){0u, 0u, 0u, 0u}; if (g4 < 2) z = *(const u32x4*)(bbt + ((size_t)(2 * F.wave + gg) * 128 + 16 * nt + r16) * 16 + 8 * g4); bfr[gg][nt] = __builtin_bit_cast(bf16x8, z); } }
    const float a0r = tab[gn0 * 2], a0i = tab[gn0 * 2 + 1], a1r = tab[gn1 * 2], a1i = tab[gn1 * 2 + 1];
    float* ST = (float*)(F.ws + WS_S5ST) + (size_t)(b * 64 + c) * 2048;
    float h0r = 0.f, h0i = 0.f, h1r = 0.f, h1i = 0.f;
    if (STAGE == 2) { h0r = ST[gn0 * 2]; h0i = ST[gn0 * 2 + 1]; h1r = ST[gn1 * 2]; h1i = ST[gn1 * 2 + 1]; }
    bf16x8 cf[2][4];
    if (STAGE == 2) { const bf16_t* cm = (const bf16_t*)(F.ws + WS_S5TAB + (size_t)layer * S5TAB_L + S5TAB_F);
#pragma unroll
        for (int gg = 0; gg < 2; ++gg)
#pragma unroll
            for (int ks = 0; ks < 4; ++ks) cf[gg][ks] = *(const bf16x8*)(cm + ((size_t)((2 * F.wave + gg) * 16 + r16)) * 128 + 32 * ks + 8 * g4); }
    LAS bf16_t* YSl = (LAS bf16_t*)(F.lds + 101376);
    const bf16_t* GW = (const bf16_t*)(F.ws + WS_GLU) + (size_t)layer * 512 * 256;
    float dsk[2] = {0.f, 0.f}, bvl[2] = {0.f, 0.f}, bgt[2] = {0.f, 0.f}; bf16x8 gwb[2][4];
    if (STAGE == 2) {
#pragma unroll
        for (int gg = 0; gg < 2; ++gg) dsk[gg] = F.in[I_SD][layer * 256 + (2 * F.wave + gg) * 16 + r16];
#pragma unroll
        for (int q = 0; q < 2; ++q) { const int c = 32 * F.wave + 16 * q + r16; bvl[q] = F.in[I_SGLUB][layer * 512 + c]; bgt[q] = F.in[I_SGLUB][layer * 512 + 256 + c]; }
#pragma unroll
        for (int ks = 0; ks < 2; ++ks)
#pragma unroll
            for (int q = 0; q < 2; ++q) { const int c = 32 * F.wave + 16 * q + r16; const int rowv = 256 * (c >> 7) + (c & 127);
                gwb[ks][2 * q] = *(const bf16x8*)(GW + (size_t)rowv * 256 + 32 * ks + 8 * g4); gwb[ks][2 * q + 1] = *(const bf16x8*)(GW + (size_t)(rowv + 128) * 256 + 32 * ks + 8 * g4); } }
    __syncthreads();
#pragma unroll 1
    for (int lb = 0; lb < 4; ++lb) {
#pragma unroll
        for (int gg = 0; gg < 2; ++gg) { u32x4 z = (u32x4){0u, 0u, 0u, 0u}; if (g4 < 2) z = *(const LAS u32x4*)(us + (16 * lb + r16) * 264 + (2 * F.wave + gg) * 16 + 8 * g4);
            const bf16x8 afr = __builtin_bit_cast(bf16x8, z);
#pragma unroll
            for (int nt = 0; nt < 8; ++nt) { const f32x4 acc = __builtin_amdgcn_mfma_f32_16x16x32_bf16(afr, bfr[gg][nt], (f32x4){0.f, 0.f, 0.f, 0.f}, 0, 0, 0);
#pragma unroll
                for (int i = 0; i < 4; ++i) BuW[(4 * g4 + i) * 264 + gg * 128 + 16 * nt + r16] = f2bf(acc[i]); } }
        __syncthreads();
#pragma unroll 4
        for (int li = 0; li < 16; ++li) { LAS u32x2* bp = (LAS u32x2*)(BuW + li * 264 + gq * 128 + 4 * n0); const u32x2 v = *bp;
            { const float br = __uint_as_float(v.x << 16), bi = __uint_as_float(v.x & 0xffff0000u); const float nr = a0r * h0r - a0i * h0i + br, ni = a0r * h0i + a0i * h0r + bi; h0r = nr; h0i = ni; }
            { const float br = __uint_as_float(v.y << 16), bi = __uint_as_float(v.y & 0xffff0000u); const float nr = a1r * h1r - a1i * h1i + br, ni = a1r * h1i + a1i * h1r + bi; h1r = nr; h1i = ni; }
            if (STAGE == 2) *bp = (u32x2){pk2(h0r, h0i), pk2(h1r, h1i)}; }
        __syncthreads();
        if (STAGE == 2) {
#pragma unroll
            for (int gg = 0; gg < 2; ++gg) { f32x4 acc = (f32x4){0.f, 0.f, 0.f, 0.f};
#pragma unroll
                for (int ks = 0; ks < 4; ++ks) { const bf16x8 a = *(const LAS bf16x8*)(BuW + r16 * 264 + gg * 128 + 32 * ks + 8 * g4);
                    acc = __builtin_amdgcn_mfma_f32_16x16x32_bf16(a, cf[gg][ks], acc, 0, 0, 0); }
                const int ch = (2 * F.wave + gg) * 16 + r16;
#pragma unroll
                for (int i = 0; i < 4; ++i) { const int l = lb * 16 + 4 * g4 + i; const float y = acc[i] + dsk[gg] * bf2f(us[l * 264 + ch]);
                    YSl[l * 264 + ch] = f2bf(gelu_tanh(y)); } }
            __syncthreads();
        }
    }
    if (STAGE == 1) { ST[gn0 * 2] = h0r; ST[gn0 * 2 + 1] = h0i; ST[gn1 * 2] = h1r; ST[gn1 * 2 + 1] = h1i; }
    if (STAGE == 2) {
        f32x4 av[4][2], ag[4][2];
#pragma unroll
        for (int m = 0; m < 4; ++m)
#pragma unroll
            for (int q = 0; q < 2; ++q) { av[m][q] = (f32x4){0.f, 0.f, 0.f, 0.f}; ag[m][q] = (f32x4){0.f, 0.f, 0.f, 0.f}; }
#pragma unroll
        for (int ks = 0; ks < 8; ++ks) {
            bf16x8 af[4], bcur[4];
#pragma unroll
            for (int j = 0; j < 4; ++j) bcur[j] = gwb[ks & 1][j];
            if (ks + 2 < 8) {
#pragma unroll
                for (int q = 0; q < 2; ++q) { const int c = 32 * F.wave + 16 * q + r16; const int rowv = 256 * (c >> 7) + (c & 127);
                    gwb[ks & 1][2 * q] = *(const bf16x8*)(GW + (size_t)rowv * 256 + 32 * (ks + 2) + 8 * g4); gwb[ks & 1][2 * q + 1] = *(const bf16x8*)(GW + (size_t)(rowv + 128) * 256 + 32 * (ks + 2) + 8 * g4); } }
#pragma unroll
            for (int m = 0; m < 4; ++m) af[m] = *(const LAS bf16x8*)(YSl + (16 * m + r16) * 264 + 32 * ks + 8 * g4);
#pragma unroll
            for (int m = 0; m < 4; ++m)
#pragma unroll
                for (int q = 0; q < 2; ++q) { av[m][q] = __builtin_amdgcn_mfma_f32_16x16x32_bf16(af[m], bcur[2 * q], av[m][q], 0, 0, 0); ag[m][q] = __builtin_amdgcn_mfma_f32_16x16x32_bf16(af[m], bcur[2 * q + 1], ag[m][q], 0, 0, 0); }
        }
        bf16_t* Y = (bf16_t*)(F.ws + WS_H);
#pragma unroll
        for (int q = 0; q < 2; ++q) { const int c = 32 * F.wave + 16 * q + r16;
#pragma unroll
            for (int m = 0; m < 4; ++m)
#pragma unroll
                for (int i = 0; i < 4; ++i) Y[(T0 + 16 * m + 4 * g4 + i) * DM + 768 + c] = f2bf((av[m][q][i] + bvl[q]) * sigmoidf_(ag[m][q][i] + bgt[q])); }
    }
}
__device__ __forceinline__ void item_s5_carry(const Frame& F_, int layer, int b) { Frame F = relocal(F_);
    const float* tab = (const float*)(F.ws + WS_S5TAB + (size_t)layer * S5TAB_L) + 2048;
    float* ST = (float*)(F.ws + WS_S5ST) + (size_t)b * 64 * 2048;
#pragma unroll
    for (int q = 0; q < 2; ++q) { const int gn = F.tid + 512 * q; const float pr = tab[gn * 2], pi = tab[gn * 2 + 1]; float hr = 0.f, hi = 0.f;
        for (int c = 0; c < 64; ++c) { float* p = ST + (size_t)c * 2048 + gn * 2; const float tr = p[0], ti = p[1]; p[0] = hr; p[1] = hi;
            const float nr = pr * hr - pi * hi + tr, ni = pr * hi + pi * hr + ti; hr = nr; hi = ni; } }
}

constexpr int RB_LD = 72;
constexpr int RW_R = 0, RW_K = 16384, RW_V = 32768, RW_W = 49152, RW_A = 65536, RW_B = 81920;
constexpr int R3_G = 49152, R3_O = 65536, R3_TILES = 81920, R3_BON = 147456;
template <int STAGE> __device__ __forceinline__ void rwkv_prep(const Frame& F_, int layer, int b, int h, int c) { Frame F = relocal(F_);
    const bf16_t* U = (const bf16_t*)(F.ws + WS_U);
    const int l0 = c * 64; const size_t T0 = (size_t)b * SEQ + l0;
    LAS float* Rr = (LAS float*)(F.lds + RW_R); LAS float* Kk = (LAS float*)(F.lds + RW_K); LAS float* Vv = (LAS float*)(F.lds + RW_V); LAS float* Ww = (LAS float*)(F.lds + RW_W);
    LAS float* Aa = (LAS float*)(F.lds + (STAGE == 1 ? RW_A : R3_O)); LAS float* Bb = (LAS float*)(F.lds + RW_B); LAS float* Gg = (LAS float*)(F.lds + R3_G); LAS float* BON = (LAS float*)(F.lds + R3_BON);
    LAS bf16_t* TWb = (LAS bf16_t*)(F.lds + 98304); LAS bf16_t* DAb = (LAS bf16_t*)(F.lds + (STAGE == 1 ? 103424 : 118784)); LAS bf16_t* SGb = (LAS bf16_t*)(F.lds + 123904);
    LAS bf16_t* w2T = (LAS bf16_t*)(F.lds + 108544); LAS bf16_t* a2T = (LAS bf16_t*)(F.lds + (STAGE == 1 ? 113664 : 133120)); LAS bf16_t* g2T = (LAS bf16_t*)(F.lds + 138240);
    const float* mu = F.in[I_RMU] + layer * 896;
    float pw0[2] = {0.f, 0.f}, pa0[2] = {0.f, 0.f}; f32x4 pkkw[2], pkaw[2], prk[2];
    if (STAGE == 1) { const int cgl = layer * 256 + h * 64 + 8 * (F.tid & 7);
#pragma unroll
        for (int q = 0; q < 2; ++q) { pkkw[q] = *(const f32x4*)(F.in[I_RKK] + cgl + 4 * q); pkaw[q] = *(const f32x4*)(F.in[I_RKA] + cgl + 4 * q); prk[q] = *(const f32x4*)(F.in[I_RRK] + cgl + 4 * q); }
#pragma unroll
        for (int q = 0; q < 2; ++q) { const int cg = layer * 256 + h * 64 + 16 * (2 * (F.wave & 1) + q) + (F.lane & 15); pw0[q] = F.in[I_RW0][cg]; pa0[q] = F.in[I_RA0][cg]; } }
    { const int tok = F.tid >> 3, p8 = F.tid & 7; const bool first = (l0 + tok == 0);
      const bf16_t* cur = U + (T0 + tok) * NINP + UR; const bf16_t* prv = first ? cur : cur - NINP;
      const float pz = first ? 0.f : 1.f;
      u32x4 cw[3], pw[3]; u32x2 c1 = (u32x2){0u, 0u}, p1 = (u32x2){0u, 0u}, c2 = (u32x2){0u, 0u}, p2 = (u32x2){0u, 0u}; u32x4 c3 = (u32x4){0u, 0u, 0u, 0u}, p3 = (u32x4){0u, 0u, 0u, 0u};
#pragma unroll
      for (int sec = (STAGE == 1 ? 0 : 2); sec < 3; ++sec) { const int co = sec * 256 + h * 64 + 8 * p8; cw[sec] = *(const u32x4*)(cur + co); pw[sec] = *(const u32x4*)(prv + co); }
      if (STAGE == 1) { c1 = *(const u32x2*)(cur + 768 + 4 * p8); p1 = *(const u32x2*)(prv + 768 + 4 * p8); c2 = *(const u32x2*)(cur + 800 + 4 * p8); p2 = *(const u32x2*)(prv + 800 + 4 * p8); }
      if (STAGE == 3) { c3 = *(const u32x4*)(cur + 832 + 8 * p8); p3 = *(const u32x4*)(prv + 832 + 8 * p8); }
#pragma unroll
      for (int sec = (STAGE == 1 ? 0 : 2); sec < 3; ++sec) { const int co = sec * 256 + h * 64 + 8 * p8; float av[8], pq[8]; unpack8(cw[sec], av); unpack8(pw[sec], pq);
          const f32x4 m0 = *(const f32x4*)(mu + co), m1 = *(const f32x4*)(mu + co + 4);
          LAS float* dst = (sec == 0 ? Rr : sec == 1 ? Kk : Vv) + tok * 64 + 8 * p8;
#pragma unroll
          for (int j = 0; j < 8; ++j) pq[j] *= pz;
          *(LAS f32x4*)dst = (f32x4){av[0] + m0[0] * (pq[0] - av[0]), av[1] + m0[1] * (pq[1] - av[1]), av[2] + m0[2] * (pq[2] - av[2]), av[3] + m0[3] * (pq[3] - av[3])};
          *(LAS f32x4*)(dst + 4) = (f32x4){av[4] + m1[0] * (pq[4] - av[4]), av[5] + m1[1] * (pq[5] - av[5]), av[6] + m1[2] * (pq[6] - av[6]), av[7] + m1[3] * (pq[7] - av[7])}; }
      if (STAGE == 1) {
#pragma unroll
        for (int which = 0; which < 2; ++which) { const int co = 768 + 32 * which + 4 * p8; const u32x2 cv = which ? c2 : c1, pv = which ? p2 : p1;
          const f32x4 m0 = *(const f32x4*)(mu + co);
          float x[4] = {__uint_as_float(cv.x << 16), __uint_as_float(cv.x & 0xffff0000u), __uint_as_float(cv.y << 16), __uint_as_float(cv.y & 0xffff0000u)};
          const float y[4] = {pz * __uint_as_float(pv.x << 16), pz * __uint_as_float(pv.x & 0xffff0000u), pz * __uint_as_float(pv.y << 16), pz * __uint_as_float(pv.y & 0xffff0000u)};
#pragma unroll
          for (int j = 0; j < 4; ++j) { x[j] = x[j] + m0[j] * (y[j] - x[j]); if (which == 0) x[j] = tanhf_(x[j]); }
          *(LAS u32x2*)((which ? DAb : TWb) + tok * 40 + 4 * p8) = (u32x2){pk2(x[0], x[1]), pk2(x[2], x[3])}; } }
      if (STAGE == 3) { const int co = 832 + 8 * p8; float av[8], pq[8]; unpack8(c3, av); unpack8(p3, pq);
          const f32x4 m0 = *(const f32x4*)(mu + co), m1 = *(const f32x4*)(mu + co + 4); float x[8];
#pragma unroll
          for (int j = 0; j < 8; ++j) x[j] = sigmoidf_(av[j] + (j < 4 ? m0[j] : m1[j - 4]) * (pz * pq[j] - av[j]));
          *(LAS u32x4*)(SGb + tok * RB_LD + 8 * p8) = (u32x4){pk2(x[0], x[1]), pk2(x[2], x[3]), pk2(x[4], x[5]), pk2(x[6], x[7])}; } }
    { const int ch = F.tid & 63, part = F.tid >> 6;
      if (STAGE == 1) { const float* w2 = F.in[I_RW2] + ((size_t)layer * 32 + 4 * part) * 256 + h * 64 + ch;
          *(LAS u32x2*)(w2T + ch * 40 + 4 * part) = (u32x2){pk2(w2[0], w2[256]), pk2(w2[512], w2[768])}; }
      if (STAGE == 1) { const float* a2 = F.in[I_RA2] + ((size_t)layer * 32 + 4 * part) * 256 + h * 64 + ch;
          *(LAS u32x2*)(a2T + ch * 40 + 4 * part) = (u32x2){pk2(a2[0], a2[256]), pk2(a2[512], a2[768])}; }
      if (STAGE == 3) { const float* g2 = F.in[I_RG2] + ((size_t)layer * 64 + 8 * part) * 256 + h * 64 + ch;
          *(LAS u32x4*)(g2T + ch * RB_LD + 8 * part) = (u32x4){pk2(g2[0], g2[256]), pk2(g2[512], g2[768]), pk2(g2[1024], g2[1280]), pk2(g2[1536], g2[1792])}; } }
    __syncthreads();
    { const int lane = F.lane, mt = F.wave >> 1, nt0 = 2 * (F.wave & 1), r = lane & 15, g4 = lane >> 4; const f32x4 zero4 = (f32x4){0.f, 0.f, 0.f, 0.f};
#pragma unroll
      for (int q = 0; q < 2; ++q) { const int nt = nt0 + q, ch = 16 * nt + r;
          if (STAGE == 1) { const f32x4 wl = mma_nt<32>(TWb + 16 * mt * 40, 40, w2T + 16 * nt * 40, 40, zero4, lane); const float w0 = pw0[q];
#pragma unroll
              for (int i = 0; i < 4; ++i) { const float x = w0 + wl[i]; const float wlog = -__logf(1.0f + __expf(-x)) - 0.5f; Ww[(16 * mt + 4 * g4 + i) * 64 + ch] = __expf(-__expf(wlog)); } }
          if (STAGE == 1) { const f32x4 al = mma_nt<32>(DAb + 16 * mt * 40, 40, a2T + 16 * nt * 40, 40, zero4, lane); const float a0 = pa0[q];
#pragma unroll
              for (int i = 0; i < 4; ++i) Aa[(16 * mt + 4 * g4 + i) * 64 + ch] = sigmoidf_(a0 + al[i]); }
          if (STAGE == 3) { const f32x4 gv = mma_nt<64>(SGb + 16 * mt * RB_LD, RB_LD, g2T + 16 * nt * RB_LD, RB_LD, zero4, lane);
#pragma unroll
              for (int i = 0; i < 4; ++i) Gg[(16 * mt + 4 * g4 + i) * 64 + ch] = gv[i]; } } }
    __syncthreads();
    float* gBON = (float*)(F.ws + WS_BON) + ((size_t)(b * 4 + h) * 64 + c) * 64;
    if (STAGE == 1) { const int t = F.tid >> 3, p8 = F.tid & 7;
      LAS float* pa = Aa + t * 64 + 8 * p8; LAS float* pk = Kk + t * 64 + 8 * p8; LAS float* pr = Rr + t * 64 + 8 * p8; LAS float* pb = Bb + t * 64 + 8 * p8;
      float kp[8], kkv[8], av[8]; float ss = 0.f, bo = 0.f;
#pragma unroll
      for (int q = 0; q < 2; ++q) { const f32x4 a4 = *(const LAS f32x4*)(pa + 4 * q), k4 = *(const LAS f32x4*)(pk + 4 * q), r4 = *(const LAS f32x4*)(pr + 4 * q);
#pragma unroll
          for (int j = 0; j < 4; ++j) { const float a = a4[j], kraw = k4[j]; av[4 * q + j] = a; kp[4 * q + j] = kraw * (1.0f + (a - 1.0f) * pkaw[q][j]);
              kkv[4 * q + j] = kraw * pkkw[q][j]; ss += kkv[4 * q + j] * kkv[4 * q + j]; bo += r4[j] * kp[4 * q + j] * prk[q][j]; } }
      ss = sum8(ss); bo = sum8(bo);
      const float rn = rsqrtf(fmaxf(ss, 1e-24f));
#pragma unroll
      for (int q = 0; q < 2; ++q) { f32x4 ko, ao, bq;
#pragma unroll
          for (int j = 0; j < 4; ++j) { const float kkn = kkv[4 * q + j] * rn; ko[j] = kp[4 * q + j]; ao[j] = -kkn; bq[j] = kkn * av[4 * q + j]; }
          *(LAS f32x4*)(pk + 4 * q) = ko; *(LAS f32x4*)(pa + 4 * q) = ao; *(LAS f32x4*)(pb + 4 * q) = bq; }
      if (p8 == 0) gBON[t] = bo; }
    else if (F.tid < 64) BON[F.tid] = gBON[F.tid];
    __syncthreads();
}
constexpr int RB_AT = 98304, RB_ATT = RB_AT + 9216, RB_BT = RB_ATT + 9216, RB_BTT = RB_BT + 9216, RB_KT = RB_BTT + 9216, RB_RT = RB_KT + 9216, RB_VT = RB_RT + 9216, RB_GC = RB_VT + 9216;
constexpr int RX_X = 0, RX_XT = 9216, RX_TB = 18432, RX_M = 27648, RX_NRT = 36864, RX_G1T = 46080, RX_G2T = 55296, RX_QT = 64512;
__device__ __forceinline__ void st_tile(LAS bf16_t* dst, int mt, int nt, const f32x4 v, int lane) {
    const int r = lane & 15, g = lane >> 4;
#pragma unroll
    for (int i = 0; i < 4; ++i) dst[(16 * mt + 4 * g + i) * RB_LD + 16 * nt + r] = f2bf(v[i]);
}
__device__ __forceinline__ void st_tile_t(LAS bf16_t* dst, int mt, int nt, const f32x4 v, int lane) {
    const int r = lane & 15, g = lane >> 4; u32x2 w; w.x = pk2(v[0], v[1]); w.y = pk2(v[2], v[3]);
    *(LAS u32x2*)(dst + (16 * nt + r) * RB_LD + 16 * mt + 4 * g) = w;
}
__device__ __forceinline__ void ld_fr(const LAS bf16_t* M, int row0, int lane, bf16x8 (&f)[2]) { const LAS bf16_t* p = M + (row0 + (lane & 15)) * RB_LD + 8 * (lane >> 4); f[0] = *(const LAS bf16x8*)p; f[1] = *(const LAS bf16x8*)(p + 32); }
__device__ __forceinline__ f32x4 mm_fr(const bf16x8 (&a)[2], const bf16x8 (&b)[2], f32x4 acc) { acc = __builtin_amdgcn_mfma_f32_16x16x32_bf16(a[0], b[0], acc, 0, 0, 0); return __builtin_amdgcn_mfma_f32_16x16x32_bf16(a[1], b[1], acc, 0, 0, 0); }
__device__ __forceinline__ void item_rwkv1(const Frame& F_, int layer, int item) { Frame F = relocal(F_);
    const int b = item >> 8, h = (item >> 6) & 3, c = item & 63;
    rwkv_prep<1>(F, layer, b, h, c);
    LAS float* Rr = (LAS float*)(F.lds + RW_R); LAS float* Kk = (LAS float*)(F.lds + RW_K); LAS float* Vv = (LAS float*)(F.lds + RW_V); LAS float* Ww = (LAS float*)(F.lds + RW_W);
    LAS float* Aa = (LAS float*)(F.lds + RW_A); LAS float* Bb = (LAS float*)(F.lds + RW_B);
    LAS bf16_t* At = (LAS bf16_t*)(F.lds + RB_AT); LAS bf16_t* AtT = (LAS bf16_t*)(F.lds + RB_ATT); LAS bf16_t* Bt = (LAS bf16_t*)(F.lds + RB_BT); LAS bf16_t* BtT = (LAS bf16_t*)(F.lds + RB_BTT);
    LAS bf16_t* Kt = (LAS bf16_t*)(F.lds + RB_KT); LAS bf16_t* Rt = (LAS bf16_t*)(F.lds + RB_RT); LAS bf16_t* VT = (LAS bf16_t*)(F.lds + RB_VT); LAS float* gC = (LAS float*)(F.lds + RB_GC);
    LAS bf16_t* X = (LAS bf16_t*)(F.lds + RX_X); LAS bf16_t* XT = (LAS bf16_t*)(F.lds + RX_XT); LAS bf16_t* Tb = (LAS bf16_t*)(F.lds + RX_TB); LAS bf16_t* Mm = (LAS bf16_t*)(F.lds + RX_M);
    LAS bf16_t* NrT = (LAS bf16_t*)(F.lds + RX_NRT); LAS bf16_t* G1T = (LAS bf16_t*)(F.lds + RX_G1T); LAS bf16_t* G2T = (LAS bf16_t*)(F.lds + RX_G2T); LAS bf16_t* QT = (LAS bf16_t*)(F.lds + RX_QT);
    { const int k = F.tid & 63, part = F.tid >> 6; float g = 1.0f;
      for (int pp = 0; pp < part; ++pp) { float w8[8];
#pragma unroll
          for (int i = 0; i < 8; ++i) w8[i] = Ww[(8 * pp + i) * 64 + k];
          g *= ((w8[0] * w8[1]) * (w8[2] * w8[3])) * ((w8[4] * w8[5]) * (w8[6] * w8[7])); }
#pragma unroll
      for (int i = 0; i < 8; ++i) { const int t = 8 * part + i; const float gp = g; g *= Ww[t * 64 + k]; const float ig = 1.0f / g;
          const bf16_t av = f2bf(Aa[t * 64 + k] * gp), bv = f2bf(Bb[t * 64 + k] * ig);
          At[t * RB_LD + k] = av; AtT[k * RB_LD + t] = av; Bt[t * RB_LD + k] = bv; BtT[k * RB_LD + t] = bv;
          Kt[t * RB_LD + k] = f2bf(Kk[t * 64 + k] * ig); Rt[t * RB_LD + k] = f2bf(Rr[t * 64 + k] * g); VT[k * RB_LD + t] = f2bf(Vv[t * 64 + k]); }
      if (part == 7) gC[k] = g; }
    __syncthreads();
    const int lane = F.lane, mt = F.wave >> 1, nt0 = 2 * (F.wave & 1), r = lane & 15, g4 = lane >> 4;
    const f32x4 zero4 = (f32x4){0.f, 0.f, 0.f, 0.f};
    f32x4 Tacc[2];
    bf16x8 fa0[2], fa1[2], fa2[2], fb0[2][2], fb1[2][2], fb2[2][2];
    ld_fr(Bt, 16 * mt, lane, fa0); ld_fr(Kt, 16 * mt, lane, fa1); ld_fr(Rt, 16 * mt, lane, fa2);
#pragma unroll
    for (int q = 0; q < 2; ++q) { ld_fr(At, 16 * (nt0 + q), lane, fb0[q]); ld_fr(Bt, 16 * (nt0 + q), lane, fb1[q]); }
#pragma unroll
    for (int q = 0; q < 2; ++q) { const int nt = nt0 + q;
        f32x4 n = mm_fr(fa0, fb0[q], zero4);
        f32x4 m = mm_fr(fa1, fb0[q], zero4);
        f32x4 nr = mm_fr(fa2, fb1[q], zero4);
#pragma unroll
        for (int i = 0; i < 4; ++i) { const int row = 16 * mt + 4 * g4 + i, col = 16 * nt + r;
            n[i] = (row < col) ? n[i] : 0.f; m[i] = (row < col) ? m[i] : 0.f; nr[i] = (col <= row) ? nr[i] : 0.f;
            Tacc[q][i] = n[i] + (row == col ? 1.0f : 0.f); }
        st_tile(X, mt, nt, n, lane); st_tile_t(XT, mt, nt, n, lane); st_tile(Tb, mt, nt, Tacc[q], lane); st_tile(Mm, mt, nt, m, lane); st_tile(NrT, mt, nt, nr, lane); }
    __syncthreads();
#pragma unroll 1
    for (int it = 0; it < 6; ++it) {
        LAS bf16_t* Xr = (it & 1) ? G1T : X; LAS bf16_t* XTr = (it & 1) ? G2T : XT; LAS bf16_t* Tr = (it & 1) ? QT : Tb;
        LAS bf16_t* Xw = (it & 1) ? X : G1T; LAS bf16_t* XTw = (it & 1) ? XT : G2T; LAS bf16_t* Tw = (it & 1) ? Tb : QT;
        ld_fr(Tr, 16 * mt, lane, fa0); ld_fr(Xr, 16 * mt, lane, fa1);
#pragma unroll
        for (int q = 0; q < 2; ++q) ld_fr(XTr, 16 * (nt0 + q), lane, fb0[q]);
#pragma unroll
        for (int q = 0; q < 2; ++q) { const int nt = nt0 + q;
            if (it > 0) Tacc[q] = mm_fr(fa0, fb0[q], Tacc[q]);
            if (it < 5) { const f32x4 x2 = mm_fr(fa1, fb0[q], zero4); st_tile(Xw, mt, nt, x2, lane); st_tile_t(XTw, mt, nt, x2, lane); }
            st_tile(Tw, mt, nt, Tacc[q], lane); }
        __syncthreads();
    }
    ld_fr(NrT, 16 * mt, lane, fa0); ld_fr(BtT, 16 * mt, lane, fa1);
#pragma unroll
    for (int q = 0; q < 2; ++q) ld_fr(Tb, 16 * (nt0 + q), lane, fb0[q]);
#pragma unroll
    for (int q = 0; q < 2; ++q) { const int nt = nt0 + q;
        st_tile(G1T, mt, nt, mm_fr(fa0, fb0[q], zero4), lane);
        st_tile(G2T, mt, nt, mm_fr(fa1, fb0[q], zero4), lane); }
    __syncthreads();
    const size_t ci = (size_t)(b * 4 + h) * 64 + c;
    bf16_t* gPT = (bf16_t*)(F.ws + WS_MOE + RW_PT) + ci * 4096; bf16_t* gW1 = (bf16_t*)(F.ws + WS_MOE + RW_W1) + ci * 4096; bf16_t* gZ = (bf16_t*)(F.ws + WS_MOE + RW_Z) + ci * 4096;
    ld_fr(G1T, 16 * mt, lane, fa0); ld_fr(Rt, 16 * mt, lane, fa1); ld_fr(G2T, 16 * mt, lane, fa2);
#pragma unroll
    for (int q = 0; q < 2; ++q) { ld_fr(AtT, 16 * (nt0 + q), lane, fb0[q]); ld_fr(Mm, 16 * (nt0 + q), lane, fb1[q]); ld_fr(Kt, 16 * (nt0 + q), lane, fb2[q]); }
#pragma unroll
    for (int q = 0; q < 2; ++q) { const int nt = nt0 + q; const int col = 16 * nt + r;
        f32x4 w1 = mm_fr(fa0, fb0[q], zero4);
        f32x4 z = mm_fr(fa0, fb1[q], zero4);
        f32x4 mr = mm_fr(fa1, fb2[q], zero4);
        f32x4 p = mm_fr(fa2, fb0[q], zero4);
        f32x4 qq = mm_fr(fa2, fb1[q], zero4);
        const int pos = 32 * (col >> 5) + 8 * ((col >> 2) & 3) + 4 * ((col >> 4) & 1) + (col & 3);
#pragma unroll
        for (int i = 0; i < 4; ++i) { const int row = 16 * mt + 4 * g4 + i;
            gW1[row * 64 + col] = f2bf(w1[i] + bf2f(Rt[row * RB_LD + col]));
            gZ[row * 64 + col] = f2bf(z[i] + (col <= row ? mr[i] : 0.f));
            const float gc = gC[row];
            gPT[row * 64 + pos] = f2bf((p[i] + (row == col ? 1.0f : 0.f)) * gc);
            qq[i] = (qq[i] + bf2f(Kt[col * RB_LD + row])) * gc; }
        st_tile(QT, mt, nt, qq, lane); }
    __syncthreads();
    bf16_t* gU = (bf16_t*)(F.ws + WS_MOE + RW_U) + ci * 4096;
    ld_fr(VT, 16 * mt, lane, fa0);
#pragma unroll
    for (int q = 0; q < 2; ++q) ld_fr(QT, 16 * (nt0 + q), lane, fb0[q]);
#pragma unroll
    for (int q = 0; q < 2; ++q) { const int nt = nt0 + q;
        const f32x4 u = mm_fr(fa0, fb0[q], zero4);
#pragma unroll
        for (int i = 0; i < 4; ++i) gU[(16 * mt + 4 * g4 + i) * 64 + 16 * nt + r] = f2bf(u[i]); }
}
__device__ __forceinline__ void item_rwkv_carry(const Frame& F_, int item) { Frame F = relocal(F_);
    const int bh = item * 2 + (F.wave >> 2), nt = F.wave & 3, r = F.lane & 15, g = F.lane >> 4;
    const bf16_t* PT = (const bf16_t*)(F.ws + WS_MOE + RW_PT); const bf16_t* Uc = (const bf16_t*)(F.ws + WS_MOE + RW_U); bf16_t* Ss = (bf16_t*)(F.ws + WS_MOE + RW_S);
    f32x4 acc[4];
#pragma unroll
    for (int m = 0; m < 4; ++m) acc[m] = (f32x4){0.f, 0.f, 0.f, 0.f};
    for (int c = 0; c < 64; ++c) { const size_t ci = (size_t)bh * 64 + c;
        bf16x8 af[4][2]; f32x4 cin[4];
#pragma unroll
        for (int m = 0; m < 4; ++m) { const u32x2 uv = *(const u32x2*)(Uc + ci * 4096 + (16 * nt + r) * 64 + 16 * m + 4 * g);
            cin[m] = (f32x4){__uint_as_float(uv.x << 16), __uint_as_float(uv.x & 0xffff0000u), __uint_as_float(uv.y << 16), __uint_as_float(uv.y & 0xffff0000u)};
#pragma unroll
            for (int s = 0; s < 2; ++s) af[m][s] = *(const bf16x8*)(PT + ci * 4096 + (16 * m + r) * 64 + 32 * s + 8 * g); }
        unsigned pw[4][2];
#pragma unroll
        for (int m = 0; m < 4; ++m) { pw[m][0] = pk2(acc[m][0], acc[m][1]); pw[m][1] = pk2(acc[m][2], acc[m][3]);
            *(u32x2*)(Ss + ci * 4096 + (16 * nt + r) * 64 + 16 * m + 4 * g) = (u32x2){pw[m][0], pw[m][1]}; }
        bf16x8 bfr[2];
#pragma unroll
        for (int s = 0; s < 2; ++s) bfr[s] = __builtin_bit_cast(bf16x8, (u32x4){pw[2 * s][0], pw[2 * s][1], pw[2 * s + 1][0], pw[2 * s + 1][1]});
#pragma unroll
        for (int m = 0; m < 4; ++m) { acc[m] = __builtin_amdgcn_mfma_f32_16x16x32_bf16(af[m][0], bfr[0], cin[m], 0, 0, 0);
            acc[m] = __builtin_amdgcn_mfma_f32_16x16x32_bf16(af[m][1], bfr[1], acc[m], 0, 0, 0); }
    }
}
__device__ __forceinline__ void item_rwkv3(const Frame& F_, int layer, int item) { Frame F = relocal(F_);
    const int b = item >> 8, h = (item >> 6) & 3, c = item & 63; const size_t T0 = (size_t)b * SEQ + c * 64;
    const size_t ci3 = (size_t)(b * 4 + h) * 64 + c;
    const u32x4 tS = *(const u32x4*)((const bf16_t*)(F.ws + WS_MOE + RW_S) + ci3 * 4096 + F.tid * 8);
    const u32x4 tW = *(const u32x4*)((const bf16_t*)(F.ws + WS_MOE + RW_W1) + ci3 * 4096 + F.tid * 8);
    const u32x4 tZ = *(const u32x4*)((const bf16_t*)(F.ws + WS_MOE + RW_Z) + ci3 * 4096 + F.tid * 8);
    f32x4 lw4[2], lb4[2];
#pragma unroll
    for (int q = 0; q < 2; ++q) { lw4[q] = *(const f32x4*)(F.in[I_RLNW] + layer * 256 + h * 64 + 8 * (F.tid & 7) + 4 * q); lb4[q] = *(const f32x4*)(F.in[I_RLNB] + layer * 256 + h * 64 + 8 * (F.tid & 7) + 4 * q); }
    rwkv_prep<3>(F, layer, b, h, c);
    LAS float* Vv = (LAS float*)(F.lds + RW_V); LAS float* Oo = (LAS float*)(F.lds + R3_O);
    LAS float* Gg = (LAS float*)(F.lds + R3_G); LAS float* BON = (LAS float*)(F.lds + R3_BON);
    LAS bf16_t* S0b = (LAS bf16_t*)(F.lds + R3_TILES); LAS bf16_t* W1b = S0b + 4608; LAS bf16_t* Zb = W1b + 4608; LAS bf16_t* VTb = Zb + 4608;
    { const int row = F.tid >> 3, col = (F.tid & 7) * 8;
      *(LAS u32x4*)(S0b + row * RB_LD + col) = tS;
      *(LAS u32x4*)(W1b + row * RB_LD + col) = tW;
      *(LAS u32x4*)(Zb + row * RB_LD + col) = tZ;
      const int vv = F.tid & 63, part = F.tid >> 6;
#pragma unroll
      for (int i = 0; i < 8; ++i) { const int t = 8 * part + i; VTb[vv * RB_LD + t] = f2bf(Vv[t * 64 + vv]); } }
    __syncthreads();
    { const int lane = F.lane, mt = F.wave >> 1, nt0 = 2 * (F.wave & 1), r = lane & 15, g4 = lane >> 4;
      bf16x8 fa0[2], fa1[2], fb0[2][2], fb1[2][2];
      ld_fr(W1b, 16 * mt, lane, fa0); ld_fr(Zb, 16 * mt, lane, fa1);
#pragma unroll
      for (int q = 0; q < 2; ++q) { ld_fr(S0b, 16 * (nt0 + q), lane, fb0[q]); ld_fr(VTb, 16 * (nt0 + q), lane, fb1[q]); }
#pragma unroll
      for (int q = 0; q < 2; ++q) { const int nt = nt0 + q;
          f32x4 o = mm_fr(fa0, fb0[q], (f32x4){0.f, 0.f, 0.f, 0.f});
          o = mm_fr(fa1, fb1[q], o);
#pragma unroll
          for (int i = 0; i < 4; ++i) Oo[(16 * mt + 4 * g4 + i) * 64 + 16 * nt + r] = o[i]; } }
    __syncthreads();
    { const int t = F.tid >> 3, p8 = F.tid & 7;
      float o[8]; float sm = 0.f;
#pragma unroll
      for (int q = 0; q < 2; ++q) { const f32x4 o4 = *(const LAS f32x4*)(Oo + t * 64 + 8 * p8 + 4 * q);
#pragma unroll
          for (int j = 0; j < 4; ++j) { o[4 * q + j] = o4[j]; sm += o4[j]; } }
      const float mean = sum8(sm) * (1.0f / 64.0f); float vs = 0.f;
#pragma unroll
      for (int j = 0; j < 8; ++j) { o[j] -= mean; vs += o[j] * o[j]; }
      const float rstd = rsqrtf(sum8(vs) * (1.0f / 64.0f) + 64e-5f); const float bon = BON[t];
      float y[8];
#pragma unroll
      for (int q = 0; q < 2; ++q) { const f32x4 v4 = *(const LAS f32x4*)(Vv + t * 64 + 8 * p8 + 4 * q), g4v = *(const LAS f32x4*)(Gg + t * 64 + 8 * p8 + 4 * q);
#pragma unroll
          for (int j = 0; j < 4; ++j) y[4 * q + j] = (o[4 * q + j] * rstd * lw4[q][j] + lb4[q][j] + bon * v4[j]) * g4v[j]; }
      *(u32x4*)((bf16_t*)(F.ws + WS_H) + (T0 + t) * DM + 256 + h * 64 + 8 * p8) = (u32x4){pk2(y[0], y[1]), pk2(y[2], y[3]), pk2(y[4], y[5]), pk2(y[6], y[7])}; }
}

constexpr int DS_SEL = 131072, DS_HIST = 135168, DS_BKT = 151552, DS_BIAS = 152064;
__device__ __forceinline__ void dsa_tables(const Frame& F_) { Frame F = relocal(F_);
    LAS int* bkt = (LAS int*)(F.lds + DS_BKT); LAS float* biasT = (LAS float*)(F.lds + DS_BIAS);
    if (F.tid < 128) { const int n = F.tid; int bk = n; if (n >= 16) { const float lr = logf((float)n / 16.0f) / 2.0794415416798357f; bk = 16 + (int)(lr * 16.0f); bk = bk < 31 ? bk : 31; } bkt[n] = bk; biasT[n] = F.in[I_RELB][n]; }
    __syncthreads();
}
__device__ __forceinline__ unsigned fkey(float f) { const unsigned u = __float_as_uint(f); return (u & 0x80000000u) ? ~u : (u | 0x80000000u); }
__device__ __forceinline__ void item_dsa(const Frame& F_, int layer, int item) { Frame F = relocal(F_);
    const bf16_t* U = (const bf16_t*)(F.ws + WS_U); const bf16_t* KI = (const bf16_t*)(F.ws + WS_KIDX);
    const bf16_t* Kb = (const bf16_t*)(F.ws + WS_K); const bf16_t* Vb = (const bf16_t*)(F.ws + WS_V);
    const int b = item & 3, qg = 511 - (item >> 2); const size_t TB = (size_t)b * SEQ, T0 = TB + qg * 8;
    LAS float* sc = (LAS float*)F.lds; LAS unsigned short* selall = (LAS unsigned short*)(F.lds + DS_SEL); LAS unsigned* histall = (LAS unsigned*)(F.lds + DS_HIST);
    LAS int* bkt = (LAS int*)(F.lds + DS_BKT); LAS float* biasT = (LAS float*)(F.lds + DS_BIAS);
    const int lane = F.lane, hh = lane >> 5;
    {
        bf16x8 af[2][2]; float wq[2][2][8];
        { const int r = lane & 31, q4 = 2 * ((r >> 2) & 1) + (r >> 4), head = 4 * ((r >> 3) & 1) + (r & 3);
#pragma unroll
          for (int mt = 0; mt < 2; ++mt)
#pragma unroll
              for (int ks = 0; ks < 2; ++ks) af[mt][ks] = *(const bf16x8*)(U + (T0 + 4 * mt + q4) * NINP + UC + 384 + head * 32 + 16 * ks + 8 * hh); }
#pragma unroll
        for (int mt = 0; mt < 2; ++mt)
#pragma unroll
            for (int q2 = 0; q2 < 2; ++q2) { float f[8]; unpack8(*(const u32x4*)(U + (T0 + 4 * mt + 2 * hh + q2) * NINP + UC + 672), f);
#pragma unroll
                for (int hd = 0; hd < 8; ++hd) wq[mt][q2][hd] = f[hd]; }
        const int ntile = (qg * 8 + 8 + 31) >> 5;
        bf16x8 nb0 = af[0][0], nb1 = af[0][0];
        if (F.wave < ntile) { const int key = F.wave * 32 + (lane & 31); nb0 = *(const bf16x8*)(KI + (TB + key) * 32 + 8 * hh); nb1 = *(const bf16x8*)(KI + (TB + key) * 32 + 16 + 8 * hh); }
        for (int kt = F.wave; kt < ntile; kt += 8) {
            const int key = kt * 32 + (lane & 31);
            const bf16x8 b0 = nb0, b1 = nb1;
            if (kt + 8 < ntile) { const int k2 = key + 256; nb0 = *(const bf16x8*)(KI + (TB + k2) * 32 + 8 * hh); nb1 = *(const bf16x8*)(KI + (TB + k2) * 32 + 16 + 8 * hh); }
#pragma unroll
            for (int mt = 0; mt < 2; ++mt) { f32x16 acc;
#pragma unroll
                for (int i = 0; i < 16; ++i) acc[i] = 0.f;
                acc = __builtin_amdgcn_mfma_f32_32x32x16_bf16(af[mt][0], b0, acc, 0, 0, 0);
                acc = __builtin_amdgcn_mfma_f32_32x32x16_bf16(af[mt][1], b1, acc, 0, 0, 0);
#pragma unroll
                for (int q2 = 0; q2 < 2; ++q2) { float s = 0.f;
#pragma unroll
                    for (int hd = 0; hd < 8; ++hd) s += fmaxf(acc[8 * q2 + hd], 0.f) * wq[mt][q2][hd];
                    const int qi = 4 * mt + 2 * hh + q2;
                    sc[qi * 4096 + key] = (key <= qg * 8 + qi) ? s : -INFINITY; } }
        }
    }
    __syncthreads();
    const int qi = F.wave, tq = qg * 8 + qi, n = tq + 1;
    LAS float* scq = sc + qi * 4096; LAS unsigned short* sel = selall + qi * 256; LAS unsigned* hist = histall + qi * 512;
    int nsel;
    if (n <= 256) { nsel = n; for (int j = lane; j < 256; j += 64) sel[j] = (unsigned short)(j < n ? j : 0); }
    else {
        nsel = 256;
        const int R = (n + 63) >> 6; const unsigned long long ltm = (1ull << lane) - 1ull;
        float lo = INFINITY, hi = -INFINITY;
        const int R4 = (n + 255) >> 8;
#pragma unroll 4
        for (int i = 0; i < R4; ++i) { const int j0 = 256 * i + 4 * lane; const f32x4 v4 = *(const LAS f32x4*)(scq + j0);
#pragma unroll
            for (int q = 0; q < 4; ++q) { const bool valid = j0 + q < n; lo = fminf(lo, valid ? v4[q] : INFINITY); hi = fmaxf(hi, valid ? v4[q] : -INFINITY); } }
#pragma unroll
        for (int o = 1; o < 64; o <<= 1) { lo = fminf(lo, shx(lo, o)); hi = fmaxf(hi, shx(hi, o)); }
        bool slow = false;
        if (!(hi > lo)) { for (int j = lane; j < 256; j += 64) sel[j] = (unsigned short)j; }
        else {
            const float scale = 1023.0f / (hi - lo);
            *(LAS u32x4*)(hist + 8 * lane) = (u32x4){0u, 0u, 0u, 0u}; *(LAS u32x4*)(hist + 8 * lane + 4) = (u32x4){0u, 0u, 0u, 0u};
#pragma unroll 2
            for (int i = 0; i < R4; ++i) { const int j0 = 256 * i + 4 * lane; const f32x4 v4 = *(const LAS f32x4*)(scq + j0);
#pragma unroll
                for (int q = 0; q < 4; ++q) { if (j0 + q < n) { int bk = (int)((v4[q] - lo) * scale); bk = bk < 1023 ? bk : 1023;
                    atomicAdd((unsigned*)(hist + (bk >> 1)), (bk & 1) ? 65536u : 1u); } } }
            const u32x4 h0 = *(const LAS u32x4*)(hist + 8 * lane), h1 = *(const LAS u32x4*)(hist + 8 * lane + 4);
            unsigned cb[16];
            cb[0] = h0.x & 0xffffu; cb[1] = h0.x >> 16; cb[2] = h0.y & 0xffffu; cb[3] = h0.y >> 16; cb[4] = h0.z & 0xffffu; cb[5] = h0.z >> 16; cb[6] = h0.w & 0xffffu; cb[7] = h0.w >> 16;
            cb[8] = h1.x & 0xffffu; cb[9] = h1.x >> 16; cb[10] = h1.y & 0xffffu; cb[11] = h1.y >> 16; cb[12] = h1.z & 0xffffu; cb[13] = h1.z >> 16; cb[14] = h1.w & 0xffffu; cb[15] = h1.w >> 16;
            unsigned tot = 0u;
#pragma unroll
            for (int q = 0; q < 16; ++q) tot += cb[q];
            unsigned incl = tot;
#pragma unroll
            for (int o = 1; o < 64; o <<= 1) { const unsigned t = shdown_u(incl, o); if (lane + o < 64) incl += t; }
            int fb = -1; unsigned fabove = 0u, fcnt = 0u; unsigned cum = incl - tot;
#pragma unroll
            for (int q = 15; q >= 0; --q) { if (fb < 0 && cum < 256u && 256u <= cum + cb[q]) { fb = 16 * lane + q; fabove = cum; fcnt = cb[q]; } cum += cb[q]; }
            const unsigned long long mf = __ballot(fb >= 0); const int src = (int)__ffsll((long long)mf) - 1;
            const int B = shidx_i(fb, src); const int above = shidx_i((int)fabove, src), cntB = shidx_i((int)fcnt, src); const int need = 256 - above;
            if (cntB > 256) slow = true;
            else {
                LAS unsigned* cand = hist;
                int base_gt = 0, base_c = 0;
#pragma unroll 2
                for (int i = 0; i < R4; ++i) { const int j0 = 256 * i + 4 * lane; const f32x4 v4 = *(const LAS f32x4*)(scq + j0);
#pragma unroll
                    for (int q = 0; q < 4; ++q) { const int j = j0 + q; const bool valid = j < n; const float v = valid ? v4[q] : lo;
                        int bk = (int)((v - lo) * scale); bk = bk < 1023 ? bk : 1023;
                        const bool gt = valid && bk > B, eq = valid && bk == B;
                        const unsigned long long mg = __ballot(gt), me = __ballot(eq);
                        if (gt) sel[base_gt + __popcll(mg & ltm)] = (unsigned short)j;
                        if (eq) { const int p = base_c + __popcll(me & ltm); cand[2 * p] = fkey(v); cand[2 * p + 1] = (unsigned)j; }
                        base_gt += __popcll(mg); base_c += __popcll(me); } }
                if (need == cntB) { for (int c = lane; c < cntB; c += 64) sel[above + c] = (unsigned short)cand[2 * c + 1]; }
                else {
                    unsigned ck[4], cx[4]; int rk[4];
#pragma unroll
                    for (int q = 0; q < 4; ++q) { const int c = lane + 64 * q; ck[q] = c < cntB ? cand[2 * c] : 0u; cx[q] = c < cntB ? cand[2 * c + 1] : 0u; rk[q] = 0; }
                    for (int c2 = 0; c2 < cntB; ++c2) { const unsigned k2 = cand[2 * c2], x2 = cand[2 * c2 + 1];
#pragma unroll
                        for (int q = 0; q < 4; ++q) rk[q] += (k2 > ck[q] || (k2 == ck[q] && x2 < cx[q])) ? 1 : 0; }
#pragma unroll
                    for (int q = 0; q < 4; ++q) { const int c = lane + 64 * q; if (c < cntB && rk[q] < need) sel[above + rk[q]] = (unsigned short)cand[2 * c + 1]; }
                }
            }
        }
        if (slow) {
        unsigned prefix = 0u; int need = 256; unsigned neq = 0u;
        for (int p = 0; p < 4; ++p) { const int shift = 24 - 8 * p;
            *(LAS u32x4*)(hist + 4 * lane) = (u32x4){0u, 0u, 0u, 0u};
            for (int i = 0; i < R; ++i) { const int j = lane + 64 * i; if (j < n) { const unsigned u = fkey(scq[j]);
                if (p == 0 || (u >> (shift + 8)) == prefix) atomicAdd((unsigned*)(hist + ((u >> shift) & 255u)), 1u); } }
            const u32x4 hv = *(const LAS u32x4*)(hist + 4 * lane);
            const unsigned tot = hv.x + hv.y + hv.z + hv.w;
            unsigned incl = tot;
#pragma unroll
            for (int o = 1; o < 64; o <<= 1) { const unsigned t = shdown_u(incl, o); if (lane + o < 64) incl += t; }
            const unsigned above = incl - tot;
            int fb = -1; unsigned fabove = 0u, feq = 0u; unsigned cum = above;
            { const unsigned hq[4] = {hv.x, hv.y, hv.z, hv.w};
#pragma unroll
              for (int q = 3; q >= 0; --q) { if (fb < 0 && cum < (unsigned)need && (unsigned)need <= cum + hq[q]) { fb = 4 * lane + q; fabove = cum; feq = hq[q]; } cum += hq[q]; } }
            const unsigned long long m = __ballot(fb >= 0);
            const int src = (int)__ffsll((long long)m) - 1;
            const int bin = shidx_i(fb, src); const unsigned ab = (unsigned)shidx_i((int)fabove, src); neq = (unsigned)shidx_i((int)feq, src);
            need -= (int)ab; prefix = (prefix << 8) | (unsigned)bin;
        }
        const int ngt = 256 - need;
        int base_gt = 0, base_eq = 0;
        for (int i = 0; i < R; ++i) { const int j = lane + 64 * i; const unsigned u = (j < n) ? fkey(scq[j]) : 0u;
            const bool gt = (j < n) && (u > prefix), eq = (j < n) && (u == prefix);
            const unsigned long long mg = __ballot(gt), me = __ballot(eq); const unsigned long long lt = (1ull << lane) - 1ull;
            if (gt) sel[base_gt + __popcll(mg & lt)] = (unsigned short)j;
            if (eq) { const int rk = base_eq + __popcll(me & lt); if (rk < need) sel[ngt + rk] = (unsigned short)j; }
            base_gt += __popcll(mg); base_eq += __popcll(me); }
        (void)neq;
            }
    }
    const int nt16 = (nsel + 15) >> 4, r16 = lane & 15, g4 = lane >> 4;
    LAS float* biasj = scq + 2048;
#pragma unroll
    for (int q = 0; q < 4; ++q) { const int j = lane + 64 * q; f32x4 bv = (f32x4){-INFINITY, -INFINITY, -INFINITY, -INFINITY};
        if (j < nsel) { const int dist = tq - (int)sel[j]; const int bk = dist < 128 ? bkt[dist < 0 ? 0 : dist] : 31; bv = *(const LAS f32x4*)(biasT + 4 * bk); }
        *(LAS f32x4*)(biasj + 4 * j) = bv; }
    bf16x8 qf[2];
#pragma unroll
    for (int s = 0; s < 2; ++s) { u32x4 z = (u32x4){0u, 0u, 0u, 0u}; if (r16 < 4) z = *(const u32x4*)(U + (T0 + qi) * NINP + UC + r16 * 64 + 32 * s + 8 * g4); qf[s] = __builtin_bit_cast(bf16x8, z); }
    float lg[16][4]; float mx = -INFINITY;
#define DSA_QK(M0, NM) do { int keyr[NM]; bf16x8 a0[NM], a1[NM]; \
        _Pragma("unroll") for (int m8 = 0; m8 < NM; ++m8) keyr[m8] = sel[16 * ((M0) + m8) + r16]; \
        _Pragma("unroll") for (int m8 = 0; m8 < NM; ++m8) { a0[m8] = *(const bf16x8*)(Kb + (TB + keyr[m8]) * 64 + 8 * g4); a1[m8] = *(const bf16x8*)(Kb + (TB + keyr[m8]) * 64 + 32 + 8 * g4); } \
        _Pragma("unroll") for (int m8 = 0; m8 < NM; ++m8) { const int m = (M0) + m8; \
            f32x4 acc = (f32x4){0.f, 0.f, 0.f, 0.f}; \
            acc = __builtin_amdgcn_mfma_f32_16x16x32_bf16(a0[m8], qf[0], acc, 0, 0, 0); \
            acc = __builtin_amdgcn_mfma_f32_16x16x32_bf16(a1[m8], qf[1], acc, 0, 0, 0); \
            _Pragma("unroll") for (int i = 0; i < 4; ++i) { const float v = acc[i] * 0.125f + biasj[(16 * m + 4 * g4 + i) * 4 + (r16 & 3)]; lg[m][i] = v; mx = fmaxf(mx, v); } } } while (0)
    if (nt16 > 8) { DSA_QK(0, 16); }
    else { DSA_QK(0, 8);
#pragma unroll
        for (int m8 = 8; m8 < 16; ++m8)
#pragma unroll
            for (int i = 0; i < 4; ++i) lg[m8][i] = -INFINITY; }
#undef DSA_QK
    mx = fmaxf(mx, shx(mx, 16)); mx = fmaxf(mx, shx(mx, 32));
    float sm = 0.f;
#pragma unroll
    for (int m = 0; m < 16; ++m)
#pragma unroll
        for (int i = 0; i < 4; ++i) { const float p = __expf(lg[m][i] - mx); lg[m][i] = p; sm += p; }
    sm += shx(sm, 16); sm += shx(sm, 32);
    f32x4 ov[4];
#pragma unroll
    for (int nt = 0; nt < 4; ++nt) ov[nt] = (f32x4){0.f, 0.f, 0.f, 0.f};
    const unsigned vs_base = (unsigned)(unsigned long)scq;
#pragma unroll
    for (int half = 0; half < 2; ++half) {
        if (half * 8 < nt16) {
            asm volatile("s_waitcnt lgkmcnt(0)" ::: "memory");
            int vkey[16];
#pragma unroll
            for (int q = 0; q < 16; ++q) { const int rho = 8 * q + (lane >> 3);
                vkey[q] = sel[half * 128 + (rho & ~31) + 16 * ((rho >> 2) & 1) + 4 * ((rho >> 3) & 3) + (rho & 3)]; }
            asm volatile("s_waitcnt lgkmcnt(0)" : "+v"(vkey[0]), "+v"(vkey[1]), "+v"(vkey[2]), "+v"(vkey[3]), "+v"(vkey[4]), "+v"(vkey[5]), "+v"(vkey[6]), "+v"(vkey[7]),
                         "+v"(vkey[8]), "+v"(vkey[9]), "+v"(vkey[10]), "+v"(vkey[11]), "+v"(vkey[12]), "+v"(vkey[13]), "+v"(vkey[14]), "+v"(vkey[15]) :: "memory");
#pragma unroll
            for (int q = 0; q < 16; ++q)
                __builtin_amdgcn_global_load_lds((const unsigned*)(Vb + (TB + vkey[q]) * 64 + 8 * (lane & 7)), (LAS unsigned*)((LAS unsigned char*)scq + q * 1024), 16, 0, 0);
            asm volatile("s_waitcnt vmcnt(0)" ::: "memory");
#pragma unroll
            for (int s4 = 0; s4 < 4; ++s4) { const int s = half * 4 + s4;
                u32x4 pw; pw.x = pk2(lg[2 * s][0], lg[2 * s][1]); pw.y = pk2(lg[2 * s][2], lg[2 * s][3]); pw.z = pk2(lg[2 * s + 1][0], lg[2 * s + 1][1]); pw.w = pk2(lg[2 * s + 1][2], lg[2 * s + 1][3]);
                const bf16x8 pa = __builtin_bit_cast(bf16x8, pw);
                const unsigned ad = vs_base + (unsigned)((32 * s4 + 8 * g4 + (r16 >> 2)) * 128 + (r16 & 3) * 8);
                u32x2 t0[4], t1[4];
                asm volatile("ds_read_b64_tr_b16 %0, %8\n\tds_read_b64_tr_b16 %1, %8 offset:512\n\tds_read_b64_tr_b16 %2, %8 offset:32\n\tds_read_b64_tr_b16 %3, %8 offset:544\n\t"
                             "ds_read_b64_tr_b16 %4, %8 offset:64\n\tds_read_b64_tr_b16 %5, %8 offset:576\n\tds_read_b64_tr_b16 %6, %8 offset:96\n\tds_read_b64_tr_b16 %7, %8 offset:608\n\ts_waitcnt lgkmcnt(0)"
                             : "=&v"(t0[0]), "=&v"(t1[0]), "=&v"(t0[1]), "=&v"(t1[1]), "=&v"(t0[2]), "=&v"(t1[2]), "=&v"(t0[3]), "=&v"(t1[3]) : "v"(ad) : "memory");
#pragma unroll
                for (int nt = 0; nt < 4; ++nt) { const bf16x8 vb = __builtin_bit_cast(bf16x8, (u32x4){t0[nt].x, t0[nt].y, t1[nt].x, t1[nt].y});
                    ov[nt] = __builtin_amdgcn_mfma_f32_16x16x32_bf16(pa, vb, ov[nt], 0, 0, 0); } }
        }
    }
    { float inv[4];
#pragma unroll
      for (int h = 0; h < 4; ++h) inv[h] = 1.0f / __int_as_float(__builtin_amdgcn_readlane(__float_as_int(sm), h));
      if (lane < 16) { bf16_t* Y = (bf16_t*)(F.ws + WS_H) + (T0 + qi) * DM + 512 + r16;
#pragma unroll
          for (int h = 0; h < 4; ++h)
#pragma unroll
              for (int nt = 0; nt < 4; ++nt) Y[h * 64 + 16 * nt] = f2bf(ov[nt][h] * inv[h]); } }
}

__device__ __forceinline__ void phase_router(const Frame& F_, int layer) { Frame F = relocal(F_); const int cset = layer;
    const float* X = (const float*)(F.ws + WS_X);
    const bf16_t* WH = (const bf16_t*)(F.ws + WS_WRT) + (size_t)layer * 2 * 49152; const bf16_t* WL = WH + 49152;
    LAS float* part = (LAS float*)F.lds;
    LAS float* ssq = (LAS float*)(F.lds + 24576);
    LAS int* es = (LAS int*)(F.lds + 25088);
    LAS int* lr = (LAS int*)(F.lds + 25600);
    LAS float* wsl = (LAS float*)(F.lds + 26112);
    LAS float* rsd = (LAS float*)(F.lds + 26624);
    for (int blk = F.bid; blk < NTOK / 64; blk += F.G) {
        __syncthreads();
        const int mt = F.wave & 3, kh = F.wave >> 2, r16 = F.lane & 15, g4 = F.lane >> 4;
        const float* xr = X + ((size_t)blk * 64 + mt * 16 + r16) * DM + kh * 512 + 8 * g4;
        f32x4 acc[3]; acc[0] = acc[1] = acc[2] = (f32x4){0.f, 0.f, 0.f, 0.f}; float ss = 0.f;
#pragma unroll 4
        for (int ks = 0; ks < 16; ++ks) {
            const f32x4 xa = *(const f32x4*)(xr + ks * 32), xb = *(const f32x4*)(xr + ks * 32 + 4);
            ss += xa[0] * xa[0] + xa[1] * xa[1] + xa[2] * xa[2] + xa[3] * xa[3] + xb[0] * xb[0] + xb[1] * xb[1] + xb[2] * xb[2] + xb[3] * xb[3];
            float xv[8] = {xa[0], xa[1], xa[2], xa[3], xb[0], xb[1], xb[2], xb[3]}; unsigned hw[4], lw[4];
#pragma unroll
            for (int j = 0; j < 4; ++j) { const bf16_t h0 = f2bf(xv[2 * j]), h1 = f2bf(xv[2 * j + 1]); hw[j] = (unsigned)h0 | ((unsigned)h1 << 16);
                lw[j] = pk2(xv[2 * j] - bf2f(h0), xv[2 * j + 1] - bf2f(h1)); }
            const bf16x8 ahi = __builtin_bit_cast(bf16x8, (u32x4){hw[0], hw[1], hw[2], hw[3]}), alo = __builtin_bit_cast(bf16x8, (u32x4){lw[0], lw[1], lw[2], lw[3]});
#pragma unroll
            for (int nt = 0; nt < 3; ++nt) { const size_t wo = (size_t)(nt * 16 + r16) * 1024 + kh * 512 + ks * 32 + 8 * g4;
                const bf16x8 bh = *(const bf16x8*)(WH + wo), bl = *(const bf16x8*)(WL + wo);
                acc[nt] = __builtin_amdgcn_mfma_f32_16x16x32_bf16(ahi, bh, acc[nt], 0, 0, 0);
                acc[nt] = __builtin_amdgcn_mfma_f32_16x16x32_bf16(ahi, bl, acc[nt], 0, 0, 0);
                acc[nt] = __builtin_amdgcn_mfma_f32_16x16x32_bf16(alo, bh, acc[nt], 0, 0, 0); }
        }
        ss += shx(ss, 16); ss += shx(ss, 32);
        if (g4 == 0) ssq[kh * 64 + mt * 16 + r16] = ss;
#pragma unroll
        for (int nt = 0; nt < 3; ++nt)
#pragma unroll
            for (int i = 0; i < 4; ++i) part[(kh * 64 + mt * 16 + 4 * g4 + i) * 48 + nt * 16 + r16] = acc[nt][i];
        __syncthreads();
        if (F.tid < 64) { const float rstd = rsqrtf((ssq[F.tid] + ssq[64 + F.tid]) * (1.0f / DM) + 1e-6f); rsd[F.tid] = rstd;
            float l[36];
#pragma unroll
            for (int o = 0; o < 36; ++o) l[o] = (part[F.tid * 48 + o] + part[(64 + F.tid) * 48 + o]) * rstd + (o < 32 ? F.in[I_BRE][layer * 32 + o] : F.in[I_BRG][layer * 4 + o - 32]);
            int gs = 0; float gm = l[32];
#pragma unroll
            for (int j = 1; j < 4; ++j) if (l[32 + j] > gm) { gm = l[32 + j]; gs = j; }
            float den = 0.f;
#pragma unroll
            for (int j = 0; j < 4; ++j) den += __expf(l[32 + j] - gm);
            const float gate = 1.0f / den;
            float e8[8];
#pragma unroll
            for (int j = 0; j < 8; ++j) e8[j] = gs == 0 ? l[j] : gs == 1 ? l[8 + j] : gs == 2 ? l[16 + j] : l[24 + j];
            int i1 = 0; float v1 = e8[0];
#pragma unroll
            for (int j = 1; j < 8; ++j) if (e8[j] > v1) { v1 = e8[j]; i1 = j; }
            int i2 = -1; float v2 = -INFINITY;
#pragma unroll
            for (int j = 0; j < 8; ++j) if (j != i1 && e8[j] > v2) { v2 = e8[j]; i2 = j; }
            const float e2 = __expf(v2 - v1); const float p1 = 1.0f / (1.0f + e2);
            es[F.tid * 2] = gs * 8 + i1; es[F.tid * 2 + 1] = gs * 8 + i2; wsl[F.tid * 2] = p1 * gate; wsl[F.tid * 2 + 1] = (1.0f - p1) * gate; }
        __syncthreads();
        if (F.tid < 32) { int cnt = 0; for (int i = 0; i < 128; ++i) if (es[i] == F.tid) lr[i] = cnt++;
            if (cnt) { const int base = (int)__hip_atomic_fetch_add(F.ctl + CW_CNT + cset * 32 + F.tid, (unsigned)cnt, __ATOMIC_RELAXED, __HIP_MEMORY_SCOPE_AGENT);
                for (int i = 0; i < 128; ++i) if (es[i] == F.tid) lr[i] += base; } }
        __syncthreads();
        if (F.tid < 64) { int* rt = (int*)(F.ws + WS_ROUTE) + ((size_t)blk * 64 + F.tid) * 8;
            rt[0] = es[F.tid * 2]; rt[1] = es[F.tid * 2 + 1]; ((float*)rt)[2] = wsl[F.tid * 2]; ((float*)rt)[3] = wsl[F.tid * 2 + 1]; rt[4] = lr[F.tid * 2]; rt[5] = lr[F.tid * 2 + 1]; ((float*)rt)[6] = rsd[F.tid]; }
    }
    __syncthreads();
    if (F.tid == 0) __hip_atomic_fetch_add(F.ctl + CW_RB + 64 * layer, 1u, __ATOMIC_RELAXED, __HIP_MEMORY_SCOPE_AGENT);
}
__device__ __forceinline__ void phase_moe_convert(const Frame& F_, int layer) { Frame F = relocal(F_);
    bf16_t* WGU = (bf16_t*)(F.ws + WS_MOE + MOE_WGU);
    for (int t = F.bid; t < 1024; t += F.G) {
        const int e = t >> 5, r = t & 31, kt = r >> 1, nt = r & 1; const size_t eo = ((size_t)layer * 32 + e) * 1024 * 256;
        tr_tile(F, 256, WGU + (size_t)e * 512 * 1024, 1024, kt * 64, nt * 256, SmGU{F.in[I_WGATE] + eo, F.in[I_WUP] + eo}); }
}
__device__ __forceinline__ void phase_moe_convert_down(const Frame& F_, int layer) { Frame F = relocal(F_);
    bf16_t* WD = (bf16_t*)(F.ws + WS_MOE + MOE_WD);
    for (;;) { const int q = q_pop(F, 32 + layer); if (q >= 512) break;
        const int e = q >> 4, r = q & 15, kt = r >> 2, nt = r & 3;
        tr_tile(F, 1024, WD + (size_t)e * 1024 * 256, 256, kt * 64, nt * 256, SmId{F.in[I_WDOWN] + ((size_t)layer * 32 + e) * 256 * 1024}); }
}
__device__ __forceinline__ void phase_gather(const Frame& F_, int layer) { Frame F = relocal(F_);
    LAS int* off = (LAS int*)F.lds;
    __syncthreads();
    if (F.tid == 0) { unsigned sp = 0;
        while (__hip_atomic_load(F.ctl + CW_RB + 64 * layer, __ATOMIC_RELAXED, __HIP_MEMORY_SCOPE_AGENT) < (unsigned)F.G) { __builtin_amdgcn_s_sleep(2); if (++sp > (1u << 22)) break; } }
    __syncthreads();
    if (F.tid == 0) { int acc = 0; for (int e = 0; e < 32; ++e) { off[e] = acc; const int c = (int)__hip_atomic_load(F.ctl + CW_CNT + layer * 32 + e, __ATOMIC_RELAXED, __HIP_MEMORY_SCOPE_AGENT); acc += (c + 255) & ~255; } off[32] = acc; }
    __syncthreads();
    int* tiles = (int*)(F.ws + WS_TILES); int* row_tok = (int*)(F.ws + WS_ROWS); float* row_w = (float*)(F.ws + WS_ROWS) + MAXROWS;
    if (F.bid == 0) { if (F.tid == 0) tiles[0] = off[32] >> 8; if (F.tid < 33) tiles[1 + F.tid] = off[F.tid];
        if (F.tid < 32) for (int rt = off[F.tid] >> 8; rt < (off[F.tid + 1] >> 8); ++rt) tiles[64 + rt] = F.tid; }
    for (int e = F.bid; e < 32; e += F.G) { const int c = (int)__hip_atomic_load(F.ctl + CW_CNT + layer * 32 + e, __ATOMIC_RELAXED, __HIP_MEMORY_SCOPE_AGENT);
        for (int r = off[e] + c + F.tid; r < off[e + 1]; r += NTHR) { row_tok[r] = -1; row_w[r] = 0.f; } }
    const float* X = (const float*)(F.ws + WS_X); bf16_t* HP = (bf16_t*)(F.ws + WS_U); const float* nw = F.in[I_NORM2] + (size_t)layer * DM;
    f32x4 nwv[4];
#pragma unroll
    for (int j = 0; j < 4; ++j) nwv[j] = *(const f32x4*)(nw + 4 * F.lane + 256 * j);
    for (int blk = F.bid; blk < NTOK / 64; blk += F.G)
    for (int i4 = 0; i4 < 2; ++i4) {
        int p0[4], p1[4], tt[4]; float rstd[4], w0[4], w1[4]; f32x4 xv[4][4];
#pragma unroll
        for (int r = 0; r < 4; ++r) { const int t = blk * 64 + F.wave * 8 + 4 * i4 + r; tt[r] = t;
            const int* rt = (const int*)(F.ws + WS_ROUTE) + (size_t)t * 8; rstd[r] = ((const float*)rt)[6]; w0[r] = ((const float*)rt)[2]; w1[r] = ((const float*)rt)[3];
            p0[r] = off[rt[0]] + rt[4]; p1[r] = off[rt[1]] + rt[5];
#pragma unroll
            for (int j = 0; j < 4; ++j) xv[r][j] = *(const f32x4*)(X + (size_t)t * DM + 4 * F.lane + 256 * j); }
#pragma unroll
        for (int r = 0; r < 4; ++r) {
#pragma unroll
            for (int j = 0; j < 4; ++j) { const int c = 4 * F.lane + 256 * j; const f32x4 v = xv[r][j] * rstd[r] * nwv[j];
                u32x2 o; o.x = pk2(v[0], v[1]); o.y = pk2(v[2], v[3]);
                *(u32x2*)(HP + (size_t)tt[r] * DM + c) = o; }
            if (F.lane == 0) { row_tok[p0[r]] = tt[r] * 2; row_w[p0[r]] = w0[r]; row_tok[p1[r]] = tt[r] * 2 + 1; row_w[p1[r]] = w1[r]; } }
    }
}

constexpr int NPH_LAYER = 9, NPHASE = 1 + 2 * NPH_LAYER + 1;
#ifndef MK_ONLY
#define MK_ONLY -1
#endif
#ifndef MK_ITEM
#define MK_ITEM -1
#endif
#define EN(o) (MK_ONLY < 0 || MK_ONLY == (o))
#define IT(o) (MK_ITEM < 0 || MK_ITEM == (o))
__global__ void __launch_bounds__(NTHR, 2) mk_forward(Params P) {
    extern __shared__ __attribute__((aligned(16))) unsigned char lds_raw[];
    Frame F; F.lds = (LAS unsigned char*)lds_raw; F.tid = threadIdx.x; F.lane = F.tid & 63; F.wave = __builtin_amdgcn_readfirstlane(F.tid >> 6); F.bid = blockIdx.x; F.G = gridDim.x;
    F.in = (in_tab_t)__builtin_amdgcn_kernarg_segment_ptr(); F.out = P.out; F.ws = P.ws; F.ctl = (unsigned*)(P.ws + WS_CTL); F.misc = (volatile LAS int*)(F.lds + MISC_OFF);
    if (F.tid < 64) ((LAS unsigned*)(F.lds + MISC_OFF))[F.tid] = 0u;
    __syncthreads();
    const int lo = P.ph_lo, hi = P.ph_hi;
    XcdBarrier bar; bar.bar = F.ctl + CW_BAR; bar.x = 0; bar.st = (volatile LAS unsigned*)(F.lds + MISC_OFF + 16);
    if (hi - lo > 1) bar = xcd_barrier_post(F.ctl + CW_BAR, (volatile LAS unsigned*)(F.lds + MISC_OFF + 16));
#define IN(k) (lo <= (k) && (k) < hi)
#define SEAM(k) do { if (IN(k) && IN((k) + 1)) xcd_barrier(bar); } while (0)
#define QLOOP(qi, n, body) for (;;) { const int it = q_pop(F, layer * 12 + (qi)); if (it >= (n)) break; body; }
    if (EN(100) && IN(0)) { phase_prologue(F); phase_norm(F, F.in[I_X], false, F.in[I_NORM1], 3); } SEAM(0);
#pragma unroll
    for (int layer = 0; layer < DEPTH; ++layer) {
        const int pb = 1 + layer * NPH_LAYER;
        if (layer > 0) { if (EN(0) && IN(pb + 0)) { phase_norm(F, (const float*)(F.ws + WS_X), true, F.in[I_NORM1] + (size_t)layer * DM, 0); } SEAM(pb + 0); }
        if (EN(1) && IN(pb + 1)) { const Frame F_ = F; Frame F = relocal(F_); pg8::StaticOrder S; S.init((const bf16_t*)(F.ws + WS_H), (const bf16_t*)(F.ws + WS_WIN) + (size_t)layer * NINP * DM, NTOK, NINP, DM, F.G, F.bid);
            pg8::EpiBf16 E{(bf16_t*)(F.ws + WS_U), NINP}; pg8::gemm_phase(F.lds, DM, S, E); } SEAM(pb + 1);
#define SLOOP(n, body) for (int it = F.bid; it < (n); it += F.G) { __syncthreads(); body; }
        if (EN(2) && IN(pb + 2)) {
            if (IT(1)) SLOOP(1024, item_rwkv1(F, layer, it));
            if (IT(0)) SLOOP(256, item_s5<1>(F, layer, it));
            if (IT(2)) SLOOP(256, item_mamba<1>(F, layer, it));
            if (IT(3)) SLOOP(256, item_kv(F, layer, it));
        } SEAM(pb + 2);
        if (EN(3) && IN(pb + 3)) {
            if (IT(0)) SLOOP(8, item_rwkv_carry(F, it));
            if (IT(1)) { for (int it = F.bid - 8; it >= 0 && it < 16; it += F.G) { __syncthreads(); item_mamba_carry(F, it); } }
            if (IT(2)) { for (int it = F.bid - 24; it >= 0 && it < 4; it += F.G) { __syncthreads(); item_s5_carry(F, layer, it); } }
            if (IT(3)) {
                dsa_tables(F);
                const int pref = (int)(xb_xcc_id() & 3u);
#pragma unroll 1
                for (int k4 = 0; k4 < 4; ++k4) { const int bq = (pref + k4) & 3;
                    for (;;) { const int it = q_pop(F, 24 + layer * 4 + bq); if (it >= 512) break; item_dsa(F, layer, it * 4 + bq); } } }
        } SEAM(pb + 3);
        if (EN(4) && IN(pb + 4)) {
            if (IT(0)) SLOOP(256, item_s5<2>(F, layer, it));
            if (IT(2)) SLOOP(256, item_mamba<2>(F, layer, it));
            if (IT(1)) SLOOP(1024, item_rwkv3(F, layer, it));
        } SEAM(pb + 4);
        if (EN(6) && IN(pb + 5)) { const Frame F_ = F; Frame F = relocal(F_); pg8::StaticOrder S; S.init((const bf16_t*)(F.ws + WS_H), (const bf16_t*)(F.ws + WS_WOUT) + (size_t)layer * DM * DM, NTOK, DM, DM, F.G, F.bid);
            pg8::EpiResid E{layer == 0 ? F.in[I_X] : (const float*)(F.ws + WS_X), (float*)(F.ws + WS_X), DM}; pg8::gemm_phase(F.lds, DM, S, E); } SEAM(pb + 5);
        if (EN(7) && IN(pb + 6)) { phase_router(F, layer); phase_moe_convert(F, layer); phase_gather(F, layer); } SEAM(pb + 6);
        if (EN(8) && IN(pb + 7)) { const Frame F_ = F; Frame F = relocal(F_); LAS int* ul = (LAS int*)(F.lds + pg8::STAGE_BYTES + 8192); if (F.tid == 0) pg8::MoeOrder::build(ul, (const int*)(F.ws + WS_TILES), 2, F.G, F.bid); __syncthreads();
            pg8::MoeOrder S{DM, (const char*)(F.ws + WS_U), (const char*)(F.ws + WS_MOE + MOE_WGU), (size_t)512 * 1024 * 2, ul};
            pg8::EpiGated<1> E{(bf16_t*)(F.ws + WS_H), 256, 0, nullptr, nullptr}; pg8::gemm_phase<pg8::EpiGated<1>, pg8::MoeOrder, true>(F.lds, DM, S, E, (const char*)(F.ws + WS_U), (const int*)(F.ws + WS_ROWS)); phase_moe_convert_down(F, layer); } SEAM(pb + 7);
        if (EN(9) && IN(pb + 8)) { const Frame F_ = F; Frame F = relocal(F_); LAS int* ul = (LAS int*)(F.lds + pg8::STAGE_BYTES + 8192); if (F.tid == 0) pg8::MoeOrder::build(ul, (const int*)(F.ws + WS_TILES), 4, F.G, F.bid); __syncthreads();
            pg8::MoeOrder S{256, (const char*)(F.ws + WS_H), (const char*)(F.ws + WS_MOE + MOE_WD), (size_t)1024 * 256 * 2, ul};
            pg8::EpiMoeOut E{(bf16_t*)(F.ws + WS_U), (const int*)(F.ws + WS_ROWS), (const float*)(F.ws + WS_ROWS) + MAXROWS, F.lds}; pg8::gemm_phase(F.lds, 256, S, E); } SEAM(pb + 8);
    }
    if (EN(101) && IN(NPHASE - 1)) { phase_norm(F, (const float*)(F.ws + WS_X), true, F.in[I_FNORM], 2); }
#undef IN
#undef SEAM
}

#ifndef MK_SPLIT
#define MK_SPLIT 0
#endif
extern "C" void kernel_launch(void* const* d_in, const int* in_sizes, int n_in, void* d_out, int out_size, void* d_ws, size_t ws_size, hipStream_t stream) {
    static int grid = 0;
    if (grid == 0) {
        if (n_in != 44 || out_size != NTOK * DM || ws_size < WS_END) { fprintf(stderr, "kernel_launch: unexpected shapes (n_in %d out %d ws %zu need %zu)\n", n_in, out_size, ws_size, (size_t)WS_END); grid = -1; return; }
        int dev = 0, cus = 0;
        if (hipGetDevice(&dev) != hipSuccess || hipDeviceGetAttribute(&cus, hipDeviceAttributeMultiprocessorCount, dev) != hipSuccess) { grid = -1; return; }
        if (hipFuncSetAttribute((const void*)mk_forward, hipFuncAttributeMaxDynamicSharedMemorySize, LDS_BYTES) != hipSuccess) { fprintf(stderr, "kernel_launch: hipFuncSetAttribute failed\n"); grid = -1; return; }
        int per_cu = 0;
        if (hipOccupancyMaxActiveBlocksPerMultiprocessor(&per_cu, (const void*)mk_forward, NTHR, LDS_BYTES) != hipSuccess || per_cu < 1) { fprintf(stderr, "kernel_launch: occupancy query says %d\n", per_cu); }
        (void)hipGetLastError();
        grid = cus;
    }
    if (grid < 0) return;
    hipMemsetAsync((char*)d_ws + WS_CTL, 0, CTL_BYTES, stream);
    Params p{};
    for (int i = 0; i < 44; ++i) p.in[i] = (const float*)d_in[i];
    p.out = (float*)d_out; p.ws = (unsigned char*)d_ws;
#if MK_SPLIT
    for (int ph = 0; ph < NPHASE; ++ph) { p.ph_lo = ph; p.ph_hi = ph + 1; hipLaunchKernelGGL(mk_forward, dim3(grid), dim3(NTHR), LDS_BYTES, stream, p); }
#else
    p.ph_lo = 0; p.ph_hi = NPHASE; hipLaunchKernelGGL(mk_forward, dim3(grid), dim3(NTHR), LDS_BYTES, stream, p);
#endif
}
```

```cpp
#include <hip/hip_runtime.h>
#include <stdint.h>
#include <stdio.h>

#define LAS __attribute__((address_space(3)))
typedef unsigned short bf16_t;
typedef short bf16x8 __attribute__((ext_vector_type(8)));
typedef float f32x4 __attribute__((ext_vector_type(4)));
typedef float f32x2 __attribute__((ext_vector_type(2)));
typedef float f32x16 __attribute__((ext_vector_type(16)));
typedef unsigned u32x4 __attribute__((ext_vector_type(4)));
typedef unsigned u32x2 __attribute__((ext_vector_type(2)));

constexpr int NTOK = 16384, DM = 1024, SEQ = 4096, NBATCH = 4, DEPTH = 2;
constexpr int NIN = 2604, NINP = 2816;
constexpr int UM = 0;
constexpr int UR = 784;
constexpr int UC = 1680;
constexpr int US = 2368;
constexpr int NTHR = 512;
constexpr int LDS_BYTES = 163840;
constexpr int MISC_OFF = LDS_BYTES - 256;

constexpr size_t WS_CTL   = 0;
constexpr size_t CTL_BYTES = 65536;
constexpr size_t WS_X     = WS_CTL + CTL_BYTES;
constexpr size_t WS_H     = WS_X + (size_t)NTOK * DM * 4;
constexpr size_t WS_U     = WS_H + (size_t)NTOK * DM * 2;
constexpr size_t WS_WIN   = WS_U + (size_t)NTOK * NINP * 2;
constexpr size_t WS_WOUT  = WS_WIN + (size_t)2 * NINP * DM * 2;
constexpr size_t WS_GLU   = WS_WOUT + (size_t)2 * DM * DM * 2;
constexpr size_t WS_MOE   = WS_GLU + (size_t)2 * 512 * 256 * 2;
constexpr size_t MOE_WGU  = 0;
constexpr size_t MOE_WD   = (size_t)32 * 512 * 1024 * 2;
constexpr size_t MOE_BYTES = MOE_WD + (size_t)32 * 1024 * 256 * 2;
constexpr size_t RW_PT    = 0;
constexpr size_t RW_U     = (size_t)1024 * 4096 * 2;
constexpr size_t RW_S     = RW_U + (size_t)1024 * 4096 * 2;
constexpr size_t RW_W1    = RW_S + (size_t)1024 * 4096 * 2;
constexpr size_t RW_Z     = RW_W1 + (size_t)1024 * 4096 * 2;
constexpr size_t YSG_OFF  = RW_Z + (size_t)1024 * 4096 * 2;
static_assert(YSG_OFF + (size_t)NTOK * 256 * 2 <= MOE_BYTES, "alias");
constexpr size_t WS_MST   = WS_MOE + MOE_BYTES;
constexpr size_t WS_MDEC  = WS_MST + (size_t)4 * 64 * 4 * 4096 * 4;
constexpr size_t WS_S5ST  = WS_MDEC + 4096;
constexpr size_t WS_K     = WS_S5ST + (size_t)4 * 64 * 2048 * 4;
constexpr size_t WS_V     = WS_K + (size_t)NTOK * 64 * 2;
constexpr size_t WS_KIDX  = WS_V + (size_t)NTOK * 64 * 2;
constexpr size_t WS_ROUTE = WS_KIDX + (size_t)NTOK * 32 * 2;
constexpr size_t WS_ROWS  = WS_ROUTE + (size_t)NTOK * 32;
constexpr int    MAXROWS  = 49152;
constexpr size_t WS_TILES = WS_ROWS + (size_t)MAXROWS * 8;
constexpr size_t WS_S5TAB = WS_TILES + 4096;
constexpr size_t S5TAB_F  = (size_t)(2048 + 2048 + 32768) * 4;
constexpr size_t S5TAB_BBT = S5TAB_F + (size_t)16 * 16 * 128 * 2;
constexpr size_t S5TAB_L  = S5TAB_BBT + (size_t)16 * 128 * 16 * 2;
constexpr size_t WS_WRT   = WS_S5TAB + 2 * S5TAB_L;
constexpr size_t WS_BON   = WS_WRT + (size_t)2 * 2 * 48 * 1024 * 2;
constexpr size_t WS_END   = WS_BON + (size_t)1024 * 64 * 4;

constexpr int CW_BAR = 0;
constexpr int CW_Q   = 4096;
constexpr int CW_CNT = 8192;
constexpr int CW_RB  = 8448;

__device__ __forceinline__ float bf2f(bf16_t b) { return __uint_as_float(((unsigned)b) << 16); }
__device__ __forceinline__ bf16_t f2bf(float f) { const __bf16 h = (__bf16)f; return __builtin_bit_cast(bf16_t, h); }
__device__ __forceinline__ unsigned pk2(float lo, float hi) { typedef __bf16 bf2_t __attribute__((ext_vector_type(2))); const bf2_t h = __builtin_convertvector((f32x2){lo, hi}, bf2_t); return __builtin_bit_cast(unsigned, h); }
__device__ __forceinline__ unsigned cvt_pk_bf16(float lo, float hi) { unsigned r; asm volatile("v_cvt_pk_bf16_f32 %0, %1, %2" : "=v"(r) : "v"(lo), "v"(hi)); return r; }
__device__ __forceinline__ float sigmoidf_(float x) { return 1.0f / (1.0f + __expf(-x)); }
__device__ __forceinline__ float siluf_(float x) { return x / (1.0f + __expf(-x)); }
__device__ __forceinline__ float tanhf_(float x) { const float e = __expf(2.0f * x); return 1.0f - 2.0f / (e + 1.0f); }
__device__ __forceinline__ float softplusf_(float x) { return fmaxf(x, 0.0f) + log1pf(__expf(-fabsf(x))); }
__device__ __forceinline__ float gelu_tanh(float x) { return 0.5f * x * (1.0f + tanhf_(0.7978845608028654f * (x + 0.044715f * x * x * x))); }
template <int CTRL> __device__ __forceinline__ float dppf(float x) { return __int_as_float(__builtin_amdgcn_update_dpp(0, __float_as_int(x), CTRL, 0xF, 0xF, true)); }
__device__ __forceinline__ float sum4(float x) { x += dppf<0xB1>(x); x += dppf<0x4E>(x); return x; }
__device__ __forceinline__ float sum8(float x) { x = sum4(x); x += dppf<0x141>(x); return x; }
__device__ __forceinline__ float sum16(float x) { x = sum8(x); x += dppf<0x140>(x); return x; }
__device__ __forceinline__ int lane_id_() { int l = (int)__builtin_amdgcn_mbcnt_hi(~0u, __builtin_amdgcn_mbcnt_lo(~0u, 0u)); asm volatile("" : "+v"(l)); return l; }
__device__ __forceinline__ float shx(float x, int o) { return __int_as_float(__builtin_amdgcn_ds_bpermute((lane_id_() ^ o) << 2, __float_as_int(x))); }
__device__ __forceinline__ unsigned shdown_u(unsigned x, int o) { return (unsigned)__builtin_amdgcn_ds_bpermute(((lane_id_() + o) & 63) << 2, (int)x); }
__device__ __forceinline__ int shidx_i(int x, int src) { return __builtin_amdgcn_ds_bpermute(src << 2, x); }
template <class OP> __device__ __forceinline__ float xrows(float x, OP op) {
    u32x2 r = __builtin_amdgcn_permlane16_swap(__float_as_uint(x), __float_as_uint(x), false, false); x = op(__uint_as_float(r[0]), __uint_as_float(r[1]));
    r = __builtin_amdgcn_permlane32_swap(__float_as_uint(x), __float_as_uint(x), false, false); return op(__uint_as_float(r[0]), __uint_as_float(r[1])); }
struct OpAdd { __device__ __forceinline__ float operator()(float a, float b) const { return a + b; } };
struct OpMin { __device__ __forceinline__ float operator()(float a, float b) const { return fminf(a, b); } };
struct OpMax { __device__ __forceinline__ float operator()(float a, float b) const { return fmaxf(a, b); } };
__device__ __forceinline__ float wave_sum(float x) { x = sum16(x); return xrows(x, OpAdd()); }
__device__ __forceinline__ float wave_min(float x) { x = fminf(x, dppf<0xB1>(x)); x = fminf(x, dppf<0x4E>(x)); x = fminf(x, dppf<0x141>(x)); x = fminf(x, dppf<0x140>(x)); return xrows(x, OpMin()); }
__device__ __forceinline__ float wave_max(float x) { x = fmaxf(x, dppf<0xB1>(x)); x = fmaxf(x, dppf<0x4E>(x)); x = fmaxf(x, dppf<0x141>(x)); x = fmaxf(x, dppf<0x140>(x)); return xrows(x, OpMax()); }
template <int CTRL, int RM, bool BC> __device__ __forceinline__ float dpp_addf(float x) { return x + __int_as_float(__builtin_amdgcn_update_dpp(0, __float_as_int(x), CTRL, RM, 0xF, BC)); }
__device__ __forceinline__ float wave_prefix_f(float x) { x = dpp_addf<0x111, 0xF, true>(x); x = dpp_addf<0x112, 0xF, true>(x); x = dpp_addf<0x114, 0xF, true>(x); x = dpp_addf<0x118, 0xF, true>(x);
    x = dpp_addf<0x142, 0xA, false>(x); return dpp_addf<0x143, 0xC, false>(x); }
__device__ __forceinline__ unsigned wave_prefix_u(unsigned x) { int v = (int)x;
    v += __builtin_amdgcn_update_dpp(0, v, 0x111, 0xF, 0xF, true); v += __builtin_amdgcn_update_dpp(0, v, 0x112, 0xF, 0xF, true);
    v += __builtin_amdgcn_update_dpp(0, v, 0x114, 0xF, 0xF, true); v += __builtin_amdgcn_update_dpp(0, v, 0x118, 0xF, 0xF, true);
    v += __builtin_amdgcn_update_dpp(0, v, 0x142, 0xA, 0xF, false); v += __builtin_amdgcn_update_dpp(0, v, 0x143, 0xC, 0xF, false); return (unsigned)v; }
__device__ __forceinline__ void unpack8(const u32x4 v, float (&f)[8]) {
    f[0] = __uint_as_float(v.x << 16); f[1] = __uint_as_float(v.x & 0xffff0000u); f[2] = __uint_as_float(v.y << 16); f[3] = __uint_as_float(v.y & 0xffff0000u);
    f[4] = __uint_as_float(v.z << 16); f[5] = __uint_as_float(v.z & 0xffff0000u); f[6] = __uint_as_float(v.w << 16); f[7] = __uint_as_float(v.w & 0xffff0000u);
}

__device__ __forceinline__ void st16_wt(void* p, u32x4 v) { asm volatile("global_store_dwordx4 %0, %1, off sc1\n\ts_nop 1" :: "v"(p), "v"(v) : "memory"); }
#define XB_TMO      128
#define XB_XCNT(j)  (256  + 64 * (j))
#define XB_XSUB(j)  (1280 + 64 * (j))
#define XB_XGEN(j)  (2304 + 64 * (j))
#define XB_TOP      3328
#define XB_TOPGEN   3392
#define XCD_BAR_WORDS 3456
#define XB_SPIN_CAP (1u << 22)
__device__ __forceinline__ unsigned xb_ld(unsigned* p)              { return __hip_atomic_load(p, __ATOMIC_RELAXED, __HIP_MEMORY_SCOPE_AGENT); }
__device__ __forceinline__ unsigned xb_add(unsigned* p, unsigned v) { return __hip_atomic_fetch_add(p, v, __ATOMIC_RELAXED, __HIP_MEMORY_SCOPE_AGENT); }
__device__ __forceinline__ unsigned xb_xcc_id() { return (unsigned)__builtin_amdgcn_s_getreg((3 << 11) | 20) & 0xFu; }
#define XB_SPIN(cond, bar) do { unsigned _sp = 0; while (cond) { __builtin_amdgcn_s_sleep(1); \
    if ((++_sp & 255u) == 0u) { if (xb_ld(&(bar)[XB_TMO])) break; if (_sp > XB_SPIN_CAP) { atomicAdd(&(bar)[XB_TMO], 1u); break; } } } } while (0)
struct XcdBarrier { unsigned* bar; unsigned x; volatile LAS unsigned* st; };
__device__ __forceinline__ XcdBarrier xcd_barrier_post(unsigned* bar, volatile LAS unsigned* st) {
    XcdBarrier b; b.bar = bar; b.x = xb_xcc_id(); b.st = st;
    if (threadIdx.x == 0) (void)xb_add(&bar[XB_XCNT(b.x)], 1u);
    return b;
}
__device__ __forceinline__ void xcd_barrier_complete(unsigned* bar, unsigned x, unsigned& nloc, unsigned& nx) {
    const unsigned G = gridDim.x * gridDim.y * gridDim.z;
    unsigned sum, cnt, mine, sp = 0u;
    for (;;) {
        sum = 0u; cnt = 0u; mine = 0u;
#pragma unroll
        for (unsigned j = 0; j < 16; ++j) { const unsigned c = xb_ld(&bar[XB_XCNT(j)]); sum += c; cnt += (c > 0u) ? 1u : 0u; mine = (j == x) ? c : mine; }
        if (sum == G) break;
        __builtin_amdgcn_s_sleep(1);
        if ((++sp & 255u) == 0u) { if (xb_ld(&bar[XB_TMO])) break; if (sp > XB_SPIN_CAP) { atomicAdd(&bar[XB_TMO], 1u); break; } }
    }
    nloc = mine > 0u ? mine : 1u; nx = cnt > 0u ? cnt : 1u;
}
__device__ __forceinline__ void xcd_barrier(const XcdBarrier& b_) {
    XcdBarrier b = b_; { const unsigned long long v = (unsigned long long)b.bar; unsigned lo = __builtin_amdgcn_readfirstlane((unsigned)v), hi = __builtin_amdgcn_readfirstlane((unsigned)(v >> 32)); asm volatile("" : "+s"(lo), "+s"(hi)); b.bar = (unsigned*)(((unsigned long long)hi << 32) | lo); unsigned xx = __builtin_amdgcn_readfirstlane(b.x); asm volatile("" : "+s"(xx)); b.x = xx; }
    asm volatile("s_waitcnt vmcnt(0)" ::: "memory");
    __syncthreads();
    if (threadIdx.x == 0) {
        unsigned* bar = b.bar;
        __builtin_amdgcn_s_waitcnt(0);
        unsigned nloc = b.st[0], nx = b.st[1];
        if (nloc == 0u) { xcd_barrier_complete(bar, b.x, nloc, nx); b.st[0] = nloc; b.st[1] = nx; }
        const unsigned old = xb_add(&bar[XB_XSUB(b.x)], 1u);
        const unsigned gen = old / nloc;
        if (old + 1u == (gen + 1u) * nloc) {
            __builtin_amdgcn_fence(__ATOMIC_RELEASE, "agent");
            asm volatile("s_waitcnt vmcnt(0)" ::: "memory");
            const unsigned og = xb_add(&bar[XB_TOP], 1u);
            const unsigned tg = og / nx;
            if (og + 1u == (tg + 1u) * nx) xb_add(&bar[XB_TOPGEN], 1u);
            else XB_SPIN(xb_ld(&bar[XB_TOPGEN]) == tg, bar);
            __builtin_amdgcn_fence(__ATOMIC_ACQUIRE, "agent");
            xb_add(&bar[XB_XGEN(b.x)], 1u);
            asm volatile("s_waitcnt vmcnt(0)" ::: "memory");
        } else {
            XB_SPIN(xb_ld(&bar[XB_XGEN(b.x)]) == gen, bar);
            __builtin_amdgcn_fence(__ATOMIC_ACQUIRE, "agent");
            asm volatile("s_waitcnt vmcnt(0)" ::: "memory");
        }
    }
    __syncthreads();
}

namespace pg8 {
constexpr int BM = 256, BK = 64, HALF = 128, HTB = HALF * BK * 2, STAGE_BYTES = 8 * HTB, NXCD = 8, WGM = 8;
__host__ __device__ __forceinline__ int lds_byte(int r, int c) { const int st = (r >> 4) * 2 + (c >> 5), rr = r & 15, cc = c & 31, ob = rr * 64 + cc * 2; return st * 1024 + (ob ^ (((ob >> 9) & 1) << 5)); }
__host__ __device__ __forceinline__ void stage_rc(int b, int& R, int& C) { const int st = b / 1024, sb = b % 1024, swz = sb ^ (((sb >> 9) & 1) << 5); R = (st >> 1) * 16 + swz / 64; C = (st & 1) * 32 + (swz % 64) / 2; }
__host__ __device__ __forceinline__ int perm32(int rho) { const int n = rho >> 4, i = rho & 15; return 8 * (i >> 2) + 4 * n + (i & 3); }
struct Unit { int pm, pn; const char* a; const char* b; };

struct StaticOrder {
    int nM, nN, nwg, G, c, K; const char* A; const char* B;
    __device__ void init(const bf16_t* A_, const bf16_t* B_, int M, int N, int K_, int G_, int c_) { A = (const char*)A_; B = (const char*)B_; K = K_; nM = M / BM; nN = N / BM; nwg = nM * nN; G = G_; c = c_; }
    __device__ bool next(int i, Unit& u) const {
        const long L = (long)i * G + c; if (L >= nwg) return false;
        int wgid = (int)L; { const int q = nwg / NXCD, r = nwg % NXCD, xcd = wgid % NXCD, off = wgid / NXCD; wgid = (xcd < r ? xcd * (q + 1) : r * (q + 1) + (xcd - r) * q) + off; }
        const int nig = WGM * nN, gid = wgid / nig, fm = gid * WGM, gsz = (nM - fm) < WGM ? (nM - fm) : WGM;
        u.pm = fm + ((wgid % nig) % gsz); u.pn = (wgid % nig) / gsz;
        u.a = A + (size_t)u.pm * 256 * K * 2; u.b = B + (size_t)u.pn * 256 * K * 2; return true;
    }
};

template <class Epi, class Sched, bool GATHER = false>
__device__ __forceinline__ void gemm_phase(LAS unsigned char* lds, const int K_, const Sched& S, const Epi& E, const char* Aall = nullptr, const int* arow = nullptr) {
    int K = K_; asm volatile("" : "+s"(K));
    int tid_ = threadIdx.x; asm volatile("" : "+v"(tid_));
    const int tid = tid_, wid = __builtin_amdgcn_readfirstlane(tid >> 6), lane = tid & 63, wr = wid >> 2, wc = wid & 3, fr = lane & 15, fq = lane >> 4;
    const int nt = K / BK;
    unsigned voffA[2], voffB[2]; int Rst[2], Cst[2];
#pragma unroll
    for (int i = 0; i < 2; ++i) { int R, C; stage_rc(tid * 16 + i * 8192, R, C); const int Rb = Epi::PERM ? ((R & ~31) + perm32(R & 31)) : R; Rst[i] = R; Cst[i] = C;
        voffA[i] = (unsigned)(R * K + C) * 2u; voffB[i] = (unsigned)(Rb * K + C) * 2u; }
    unsigned gv[2][2], gn[2][2];
#define PG8_GOFF(dst, unit) do { _Pragma("unroll") for (int h_ = 0; h_ < 2; ++h_) _Pragma("unroll") for (int i_ = 0; i_ < 2; ++i_) { const int rr_ = arow[(unit).pm * BM + h_ * HALF + Rst[i_]]; \
        dst[h_][i_] = ((unsigned)(rr_ < 0 ? 0 : rr_ >> 1) * (unsigned)K + (unsigned)Cst[i_]) * 2u; } } while (0)
    const size_t kstep = (size_t)(BK * 2);
    const size_t hstep = (size_t)HALF * K * 2;
    const unsigned ldsw = (unsigned)wid * 1024u;
    const int aoff = lds_byte(wr * 64 + fr, fq * 8), boff = lds_byte(wc * 32 + fr, fq * 8);
#define PG8_SA(b, h) (((b) * 2 + (h)) * HTB)
#define PG8_SB(b, h) ((4 + (b) * 2 + (h)) * HTB)
#define PG8_STAGE(bufoff, gbase, voff) do { _Pragma("unroll") for (int _i = 0; _i < 2; ++_i) \
        __builtin_amdgcn_global_load_lds((const unsigned*)((const char*)(gbase) + (voff)[_i]), (LAS unsigned*)(lds + (bufoff) + ldsw + _i * 8192), 16, 0, 0); } while (0)
#define PG8_LDA(dst, b, h) do { _Pragma("unroll") for (int m = 0; m < 4; ++m) _Pragma("unroll") for (int k = 0; k < 2; ++k) dst[m][k] = *(const LAS bf16x8*)(lds + PG8_SA(b, h) + aoff + m * 2048 + k * 1024); } while (0)
#define PG8_LDB(dst, b, h) do { _Pragma("unroll") for (int n = 0; n < 2; ++n) _Pragma("unroll") for (int k = 0; k < 2; ++k) dst[n][k] = *(const LAS bf16x8*)(lds + PG8_SB(b, h) + boff + n * 2048 + k * 1024); } while (0)
#define PG8_MMA(ai, bj, At, Bt) do { __builtin_amdgcn_s_setprio(1); _Pragma("unroll") for (int m = 0; m < 4; ++m) _Pragma("unroll") for (int n = 0; n < 2; ++n) _Pragma("unroll") for (int k = 0; k < 2; ++k) \
        acc[ai][bj][m][n] = __builtin_amdgcn_mfma_f32_16x16x32_bf16(Bt[n][k], At[m][k], acc[ai][bj][m][n], 0, 0, 0); __builtin_amdgcn_s_setprio(0); } while (0)
#define PG8_WAIT_V(n) asm volatile("s_waitcnt vmcnt(" #n ")" ::: "memory")
#define PG8_WAIT_L(n) asm volatile("s_waitcnt lgkmcnt(" #n ")" ::: "memory")
#define PG8_BAR __builtin_amdgcn_s_barrier()
#define PG8_SCHED __builtin_amdgcn_sched_barrier(0)
    Unit cur, nxt; int ui = 0;
    if (!S.next(0, cur)) return;
    f32x4 acc[2][2][4][2];
#pragma unroll
    for (int a = 0; a < 2; ++a)
#pragma unroll
        for (int b = 0; b < 2; ++b)
#pragma unroll
            for (int m = 0; m < 4; ++m)
#pragma unroll
                for (int n = 0; n < 2; ++n) acc[a][b][m][n] = (f32x4){0.f, 0.f, 0.f, 0.f};
    bf16x8 At[4][2], B0[2][2], B1[2][2];
    const char* cA = GATHER ? Aall : cur.a; const char* cB = cur.b;
    if (GATHER) PG8_GOFF(gv, cur);
#define PG8_STAGE_A(bufoff, gbase, h, vo) do { if (GATHER) PG8_STAGE(bufoff, gbase, (vo)[h]); else PG8_STAGE(bufoff, (gbase) + ((h) ? hstep : 0), voffA); } while (0)
    PG8_STAGE(PG8_SB(0, 0), cB, voffB); PG8_STAGE_A(PG8_SA(0, 0), cA, 0, gv); PG8_STAGE(PG8_SB(0, 1), cB + hstep, voffB); PG8_STAGE_A(PG8_SA(0, 1), cA, 1, gv);
    if (wr == 1) PG8_BAR;
    PG8_WAIT_V(4); PG8_BAR;
    PG8_STAGE(PG8_SB(1, 0), cB + kstep, voffB); PG8_STAGE_A(PG8_SA(1, 0), cA + kstep, 0, gv); PG8_STAGE(PG8_SB(1, 1), cB + hstep + kstep, voffB);
    PG8_WAIT_V(6); PG8_BAR;
    for (;;) {
        const bool has_next = S.next(ui + 1, nxt);
        const char* nA = GATHER ? cA : (has_next ? nxt.a : cA); const char* nB = has_next ? nxt.b : cB;
        if (GATHER) { if (has_next) PG8_GOFF(gn, nxt); else {
#pragma unroll
            for (int h_ = 0; h_ < 2; ++h_)
#pragma unroll
                for (int i_ = 0; i_ < 2; ++i_) gn[h_][i_] = gv[h_][i_]; } }
        for (int t = 0; t < nt; t += 2) {
            const bool last = (t == nt - 2);
            const char* a1 = cA + (size_t)(t + 1) * kstep;
            const char* a2 = last ? nA : cA + (size_t)(t + 2) * kstep; const char* b2 = last ? nB : cB + (size_t)(t + 2) * kstep;
            const char* a3 = a2 + kstep; const char* b3 = b2 + kstep;
            unsigned vo2[2][2];
#pragma unroll
            for (int h_ = 0; h_ < 2; ++h_)
#pragma unroll
                for (int i_ = 0; i_ < 2; ++i_) vo2[h_][i_] = GATHER ? (last ? gn[h_][i_] : gv[h_][i_]) : 0u;
            PG8_LDB(B0, 0, 0); PG8_SCHED; PG8_LDA(At, 0, 0); PG8_STAGE_A(PG8_SA(1, 1), a1, 1, gv);
            PG8_WAIT_L(8); PG8_BAR; PG8_WAIT_L(0); PG8_MMA(0, 0, At, B0); PG8_BAR; PG8_SCHED;
            PG8_LDB(B1, 0, 1); PG8_STAGE(PG8_SB(0, 0), b2, voffB);
            PG8_BAR; PG8_WAIT_L(0); PG8_MMA(0, 1, At, B1); PG8_BAR;
            PG8_LDA(At, 0, 1); PG8_STAGE_A(PG8_SA(0, 0), a2, 0, vo2);
            PG8_BAR; PG8_WAIT_L(0); PG8_MMA(1, 0, At, B0); PG8_BAR; PG8_SCHED;
            PG8_STAGE(PG8_SB(0, 1), b2 + hstep, voffB);
            PG8_WAIT_V(6); PG8_BAR; PG8_MMA(1, 1, At, B1); PG8_BAR;
            PG8_LDB(B0, 1, 0); PG8_SCHED; PG8_LDA(At, 1, 0); PG8_STAGE_A(PG8_SA(0, 1), a2, 1, vo2);
            PG8_WAIT_L(8); PG8_BAR; PG8_WAIT_L(0); PG8_MMA(0, 0, At, B0); PG8_BAR; PG8_SCHED;
            PG8_LDB(B1, 1, 1); PG8_STAGE(PG8_SB(1, 0), b3, voffB);
            PG8_BAR; PG8_WAIT_L(0); PG8_MMA(0, 1, At, B1); PG8_BAR;
            PG8_LDA(At, 1, 1); PG8_STAGE_A(PG8_SA(1, 0), a3, 0, vo2);
            PG8_BAR; PG8_WAIT_L(0); PG8_MMA(1, 0, At, B0); PG8_BAR; PG8_SCHED;
            PG8_STAGE(PG8_SB(1, 1), b3 + hstep, voffB);
            PG8_WAIT_V(6); PG8_BAR; PG8_MMA(1, 1, At, B1); PG8_BAR;
        }
        E(acc, cur, wr, wc, fr, fq);
        if (!has_next) break;
#pragma unroll
        for (int a = 0; a < 2; ++a)
#pragma unroll
            for (int b = 0; b < 2; ++b)
#pragma unroll
                for (int m = 0; m < 4; ++m)
#pragma unroll
                    for (int n = 0; n < 2; ++n) acc[a][b][m][n] = (f32x4){0.f, 0.f, 0.f, 0.f};
        cur = nxt; cA = nA; cB = nB; ++ui;
        if (GATHER) {
#pragma unroll
            for (int h_ = 0; h_ < 2; ++h_)
#pragma unroll
                for (int i_ = 0; i_ < 2; ++i_) gv[h_][i_] = gn[h_][i_]; }
    }
    PG8_WAIT_V(0);
    if (wr == 0) PG8_BAR;
    PG8_BAR;
#undef PG8_SA
#undef PG8_SB
#undef PG8_STAGE
#undef PG8_STAGE_A
#undef PG8_GOFF
#undef PG8_LDA
#undef PG8_LDB
#undef PG8_MMA
#undef PG8_WAIT_V
#undef PG8_WAIT_L
#undef PG8_BAR
#undef PG8_SCHED
}

struct EpiBf16 {
    static constexpr bool PERM = true;
    bf16_t* O; int ldc;
    __device__ __forceinline__ void operator()(const f32x4 (&acc)[2][2][4][2], const Unit& u, int wr, int wc, int fr, int fq) const {
        const int row0 = u.pm * BM + wr * 64 + fr, col0 = u.pn * BM + wc * 32 + 8 * fq;
#pragma unroll
        for (int ai = 0; ai < 2; ++ai)
#pragma unroll
            for (int m = 0; m < 4; ++m) { bf16_t* rowp = O + (size_t)(row0 + ai * HALF + m * 16) * ldc + col0;
#pragma unroll
                for (int bj = 0; bj < 2; ++bj) { const f32x4 v0 = acc[ai][bj][m][0], v1 = acc[ai][bj][m][1];
                    u32x4 w; w.x = cvt_pk_bf16(v0[0], v0[1]); w.y = cvt_pk_bf16(v0[2], v0[3]); w.z = cvt_pk_bf16(v1[0], v1[1]); w.w = cvt_pk_bf16(v1[2], v1[3]);
                    st16_wt(rowp + bj * HALF, w); } }
    }
};
struct EpiResid {
    static constexpr bool PERM = false;
    const float* Cin; float* C; int ldc;
    __device__ __forceinline__ void operator()(const f32x4 (&acc)[2][2][4][2], const Unit& u, int wr, int wc, int fr_, int fq_) const {
        int fr = fr_, fq = fq_; asm volatile("" : "+v"(fr), "+v"(fq));
        const int row0 = u.pm * BM + wr * 64 + fr, col0 = u.pn * BM + wc * 32 + 4 * fq;
#pragma unroll
        for (int ai = 0; ai < 2; ++ai)
#pragma unroll
            for (int mp = 0; mp < 2; ++mp) { f32x4 cv[2][2][2];
#pragma unroll
                for (int mm = 0; mm < 2; ++mm) { const float* rowp = Cin + (size_t)(row0 + ai * HALF + (2 * mp + mm) * 16) * ldc + col0;
#pragma unroll
                    for (int bj = 0; bj < 2; ++bj)
#pragma unroll
                        for (int n = 0; n < 2; ++n) cv[mm][bj][n] = *(const f32x4*)(rowp + bj * HALF + n * 16); }
#pragma unroll
                for (int mm = 0; mm < 2; ++mm) { float* rowp = C + (size_t)(row0 + ai * HALF + (2 * mp + mm) * 16) * ldc + col0;
#pragma unroll
                    for (int bj = 0; bj < 2; ++bj)
#pragma unroll
                        for (int n = 0; n < 2; ++n) { const f32x4 o_ = cv[mm][bj][n] + acc[ai][bj][2 * mp + mm][n]; st16_wt(rowp + bj * HALF + n * 16, __builtin_bit_cast(u32x4, o_)); } }
                asm volatile("" ::: "memory"); }
    }
};
template <int ACT  > struct EpiGated {
    static constexpr bool PERM = true;
    bf16_t* O; int ldo; int coloff; const float* ba; const float* bb;
    __device__ __forceinline__ void operator()(const f32x4 (&acc)[2][2][4][2], const Unit& u, int wr, int wc, int fr, int fq) const {
        const int row0 = u.pm * BM + wr * 64 + fr, cl = u.pn * HALF + wc * 32 + 8 * fq;
        float va[8], vb[8];
#pragma unroll
        for (int j = 0; j < 8; ++j) { va[j] = (ACT == 0) ? ba[cl + j] : 0.f; vb[j] = (ACT == 0) ? bb[cl + j] : 0.f; }
#pragma unroll
        for (int ai = 0; ai < 2; ++ai)
#pragma unroll
            for (int m = 0; m < 4; ++m) { bf16_t* rowp = O + (size_t)(row0 + ai * HALF + m * 16) * ldo + coloff + cl;
                float o[8];
#pragma unroll
                for (int n = 0; n < 2; ++n)
#pragma unroll
                    for (int j = 0; j < 4; ++j) { const float a = acc[ai][0][m][n][j] + va[4 * n + j], b = acc[ai][1][m][n][j] + vb[4 * n + j];
                        o[4 * n + j] = (ACT == 0) ? a * sigmoidf_(b) : siluf_(a) * b; }
                u32x4 w; w.x = cvt_pk_bf16(o[0], o[1]); w.y = cvt_pk_bf16(o[2], o[3]); w.z = cvt_pk_bf16(o[4], o[5]); w.w = cvt_pk_bf16(o[6], o[7]);
                st16_wt(rowp, w); asm volatile("" ::: "memory"); }
    }
};
struct EpiMoeOut {
    static constexpr bool PERM = true;
    bf16_t* O; const int* row_tok; const float* row_w; LAS unsigned char* lds;
    __device__ __forceinline__ void operator()(const f32x4 (&acc)[2][2][4][2], const Unit& u, int wr, int wc, int fr_, int fq_) const {
        int fr = fr_, fq = fq_; asm volatile("" : "+v"(fr), "+v"(fq));
        const int col0 = u.pn * BM + wc * 32 + 8 * fq, lane = fq * 16 + fr;
        LAS u32x2* rinfo = (LAS u32x2*)(lds + STAGE_BYTES) + (wr * 4 + wc) * 128;
        { const int ra = u.pm * BM + wr * 64 + lane, rb = ra + HALF;
          const u32x2 ia = (u32x2){(unsigned)row_tok[ra], __float_as_uint(row_w[ra])}, ib = (u32x2){(unsigned)row_tok[rb], __float_as_uint(row_w[rb])};
          rinfo[lane] = ia; rinfo[64 + lane] = ib; }
#pragma unroll
        for (int ai = 0; ai < 2; ++ai)
#pragma unroll
            for (int m = 0; m < 4; ++m) { const u32x2 inf = rinfo[ai * 64 + m * 16 + fr]; const int ts = (int)inf.x; const float w = __uint_as_float(inf.y);
                if (ts >= 0) { bf16_t* rowp = O + ((size_t)(ts & 1) * NTOK + (size_t)(ts >> 1)) * DM + col0;
#pragma unroll
                    for (int bj = 0; bj < 2; ++bj) { const f32x4 v0 = acc[ai][bj][m][0] * w, v1 = acc[ai][bj][m][1] * w;
                        u32x4 q; q.x = cvt_pk_bf16(v0[0], v0[1]); q.y = cvt_pk_bf16(v0[2], v0[3]); q.z = cvt_pk_bf16(v1[0], v1[1]); q.w = cvt_pk_bf16(v1[2], v1[3]);
                        st16_wt(rowp + bj * HALF, q); } } }
    }
};
struct MoeOrder {
    int K; const char* A; const char* B; size_t bstride; const LAS int* list;
    static __device__ __forceinline__ void build(LAS int* list, const int* tiles, int nN, int G, int c) {
        const int nrt = tiles[0], nwg = nrt * nN; int n = 0;
        for (int i = 0; ; ++i) { const long L = (long)i * G + c; if (L >= (long)nwg || n >= 20) break;
            int wgid = (int)L; { const int q = nwg / NXCD, r = nwg % NXCD, xcd = wgid % NXCD, off = wgid / NXCD; wgid = (xcd < r ? xcd * (q + 1) : r * (q + 1) + (xcd - r) * q) + off; }
            const int pm = wgid / nN; list[1 + 3 * n] = pm; list[2 + 3 * n] = wgid % nN; list[3 + 3 * n] = tiles[64 + pm]; ++n; }
        list[0] = n;
    }
    __device__ bool next(int i, Unit& u) const {
        const int n = __builtin_amdgcn_readfirstlane(list[0]); if (i >= n) return false;
        u.pm = __builtin_amdgcn_readfirstlane(list[1 + 3 * i]); u.pn = __builtin_amdgcn_readfirstlane(list[2 + 3 * i]); const int e = __builtin_amdgcn_readfirstlane(list[3 + 3 * i]);
        u.a = A + (size_t)u.pm * 256 * K * 2; u.b = B + (size_t)e * bstride + (size_t)u.pn * 256 * K * 2; return true;
    }
};
}

struct Params { const float* in[44]; float* out; unsigned char* ws; int ph_lo, ph_hi; };
enum { I_X = 0, I_NORM1, I_WIN, I_MCONVW, I_MCONVB, I_MDTB, I_MALOG, I_MD, I_MNORM, I_RMU, I_RW0, I_RW2, I_RA0, I_RA2, I_RG2, I_RKK, I_RKA, I_RRK, I_RLNW, I_RLNB,
       I_CKVN, I_CWUK, I_CWUV, I_RELB, I_SARE, I_SAIM, I_SBRE, I_SBIM, I_SCRE, I_SCIM, I_SD, I_SLOGDT, I_SGLUW, I_SGLUB, I_WOUT, I_NORM2, I_WRG, I_BRG, I_WRE, I_BRE,
       I_WGATE, I_WUP, I_WDOWN, I_FNORM };

typedef const float* const __attribute__((address_space(4)))* in_tab_t;
struct Frame {
    LAS unsigned char* lds; int tid, lane, wave, bid, G;
    in_tab_t in; float* out; unsigned char* ws; unsigned* ctl;
    volatile LAS int* misc;
};

__device__ __forceinline__ int q_pop(Frame& F, int qi) {
    __syncthreads();
    if (F.tid == 0) F.misc[0] = (int)__hip_atomic_fetch_add(F.ctl + CW_Q + 64 * qi, 1u, __ATOMIC_RELAXED, __HIP_MEMORY_SCOPE_AGENT);
    __syncthreads();
    return F.misc[0];
}

__device__ __forceinline__ const void* opaque_ptr(const void* p) { const unsigned long long v = (unsigned long long)p; unsigned lo = __builtin_amdgcn_readfirstlane((unsigned)v), hi = __builtin_amdgcn_readfirstlane((unsigned)(v >> 32));
    asm volatile("" : "+s"(lo), "+s"(hi)); return (const void*)(((unsigned long long)hi << 32) | lo); }
__device__ __forceinline__ Frame relocal(const Frame& G) { Frame F = G; asm volatile("" : "+v"(F.tid)); F.ws = (unsigned char*)opaque_ptr(F.ws); F.ctl = (unsigned*)(F.ws + WS_CTL); F.in = (in_tab_t)(unsigned long long)opaque_ptr((const void*)(unsigned long long)F.in); F.lane = F.tid & 63; F.wave = __builtin_amdgcn_readfirstlane(F.tid >> 6); return F; }
template <int K> __device__ __forceinline__ f32x4 mma_nt(const LAS bf16_t* A, int lda, const LAS bf16_t* Bt, int ldb, f32x4 acc, int lane) {
    const int r = lane & 15, g = lane >> 4;
#pragma unroll
    for (int k0 = 0; k0 < K; k0 += 32) {
        const bf16x8 a = *(const LAS bf16x8*)(A + r * lda + k0 + 8 * g);
        const bf16x8 b = *(const LAS bf16x8*)(Bt + r * ldb + k0 + 8 * g);
        acc = __builtin_amdgcn_mfma_f32_16x16x32_bf16(a, b, acc, 0, 0, 0);
    }
    return acc;
}

template <class SrcMap> __device__ __forceinline__ void tr_tile(Frame& F, int ldsrc, bf16_t* dst, int K, int k0, int n0, SrcMap sm) {
    LAS float* tile = (LAS float*)F.lds;
    __syncthreads();
    { const int n4 = (F.tid & 63) * 4, kk = F.tid >> 6; const float* sp = sm(n0 + n4);
      f32x4 v[8];
#pragma unroll
      for (int ps = 0; ps < 8; ++ps) { v[ps] = (f32x4){0.f, 0.f, 0.f, 0.f}; if (sp) v[ps] = __builtin_nontemporal_load((const f32x4*)(sp + (size_t)(k0 + kk + 8 * ps) * ldsrc)); }
#pragma unroll
      for (int ps = 0; ps < 8; ++ps) { LAS float* t = tile + (kk + 8 * ps) * 257 + n4; t[0] = v[ps][0]; t[1] = v[ps][1]; t[2] = v[ps][2]; t[3] = v[ps][3]; } }
    __syncthreads();
    { const int kc = F.tid & 7;
#pragma unroll
      for (int j = 0; j < 4; ++j) { const int n = (F.tid >> 3) + 64 * j; float f[8];
#pragma unroll
          for (int i = 0; i < 8; ++i) f[i] = tile[(8 * kc + i) * 257 + n];
          u32x4 w; w.x = pk2(f[0], f[1]); w.y = pk2(f[2], f[3]); w.z = pk2(f[4], f[5]); w.w = pk2(f[6], f[7]);
          *(u32x4*)(dst + (size_t)(n0 + n) * K + k0 + 8 * kc) = w; } }
}

struct SmIn { const float* base; __device__ __forceinline__ const float* operator()(int n) const {
    int c; if (n < 772) c = n; else if (n < UR) return nullptr; else if (n < UR + 896) c = 772 + (n - UR); else if (n < UC) return nullptr;
    else if (n < UC + 680) c = 1668 + (n - UC); else if (n < US) return nullptr; else if (n < US + 256) c = 2348 + (n - US); else return nullptr; return base + c; } };
struct SmId { const float* base; __device__ __forceinline__ const float* operator()(int n) const { return base + n; } };
struct SmGlu { const float* base; __device__ __forceinline__ const float* operator()(int n) const { const int pn = n >> 8, rr = n & 255; return base + (rr < 128 ? 128 * pn + rr : 256 + 128 * pn + (rr - 128)); } };
struct SmGU { const float* gate; const float* up; __device__ __forceinline__ const float* operator()(int n) const {
    const unsigned long long d = (unsigned long long)up - (unsigned long long)gate; const unsigned long long a = (unsigned long long)gate + (((n & 255) < 128) ? 0ull : d); return (const float*)a + 128 * (n >> 8) + (n & 127); } };
__device__ __forceinline__ void phase_prologue(const Frame& F_) { Frame F = relocal(F_);
    for (int t = F.bid; t < 496; t += F.G) {
        if (t < 352) { const int l = t / 176, r = t % 176, kt = r / 11, nt = r % 11;
            tr_tile(F, NIN, (bf16_t*)(F.ws + WS_WIN) + (size_t)l * NINP * DM, DM, kt * 64, nt * 256, SmIn{F.in[I_WIN] + (size_t)l * DM * NIN}); }
        else if (t < 480) { const int q = t - 352, l = q / 64, r = q % 64, kt = r / 4, nt = r % 4;
            tr_tile(F, DM, (bf16_t*)(F.ws + WS_WOUT) + (size_t)l * DM * DM, DM, kt * 64, nt * 256, SmId{F.in[I_WOUT] + (size_t)l * DM * DM}); }
        else { const int q = t - 480, l = q / 8, r = q % 8, kt = r / 2, nt = r % 2;
            tr_tile(F, 512, (bf16_t*)(F.ws + WS_GLU) + (size_t)l * 512 * 256, 256, kt * 64, nt * 256, SmGlu{F.in[I_SGLUW] + (size_t)l * 256 * 512}); }
    }
    for (int i = F.bid * NTHR + F.tid; i < 2 * 48 * 1024; i += F.G * NTHR) { const int l = i / 49152, r = i % 49152, o = r >> 10, k = r & 1023;
        float v = 0.f; if (o < 32) v = F.in[I_WRE][((size_t)l * DM + k) * 32 + o]; else if (o < 36) v = F.in[I_WRG][((size_t)l * DM + k) * 4 + (o - 32)];
        v *= F.in[I_NORM2][l * DM + k];
        const bf16_t hi = f2bf(v); const bf16_t lo = f2bf(v - bf2f(hi));
        bf16_t* w = (bf16_t*)(F.ws + WS_WRT) + (size_t)l * 2 * 49152; w[r] = hi; w[49152 + r] = lo; }
    for (int i = F.bid * NTHR + F.tid; i < 2048 + 65536; i += F.G * NTHR) {
        if (i < 2048) {
            const int l = i >> 10, gn = i & 1023, g = gn >> 6;
            float* tab = (float*)(F.ws + WS_S5TAB + (size_t)l * S5TAB_L);
            const float lre = fminf(F.in[I_SARE][l * 1024 + gn], -1e-4f), lim = F.in[I_SAIM][l * 1024 + gn];
            const float dt = expf(F.in[I_SLOGDT][l * 16 + g]);
            const float mag = expf(dt * lre); float sn, cs; sincosf(dt * lim, &sn, &cs);
            const float are = mag * cs, aim = mag * sn;
            const float den = lre * lre + lim * lim;
            const float fre = ((are - 1.0f) * lre + aim * lim) / den, fim = (aim * lre - (are - 1.0f) * lim) / den;
            tab[gn * 2] = are; tab[gn * 2 + 1] = aim;
            float pr = are, pi = aim;
#pragma unroll
            for (int s = 0; s < 6; ++s) { const float nr = pr * pr - pi * pi, ni = 2.0f * pr * pi; pr = nr; pi = ni; }
            tab[2048 + gn * 2] = pr; tab[2048 + gn * 2 + 1] = pi;
            const float* bre = F.in[I_SBRE] + ((size_t)l * 1024 + gn) * 16; const float* bim = F.in[I_SBIM] + ((size_t)l * 1024 + gn) * 16;
            bf16_t* bbt = (bf16_t*)(F.ws + WS_S5TAB + (size_t)l * S5TAB_L + S5TAB_BBT); const int n = gn & 63, col = 4 * (n & 31) + 2 * (n >> 5);
            for (int p = 0; p < 16; ++p) { const float vr = fre * bre[p] - fim * bim[p], vi = fre * bim[p] + fim * bre[p];
                bbt[((size_t)g * 128 + col) * 16 + p] = f2bf(vr); bbt[((size_t)g * 128 + col + 1) * 16 + p] = f2bf(vi); }
        } else {
            const int j = i - 2048, l = j >> 15, r = j & 32767, gp = r >> 7, k = r & 127;
            bf16_t* cm = (bf16_t*)(F.ws + WS_S5TAB + (size_t)l * S5TAB_L + S5TAB_F);
            const int n = (k >> 2) + 32 * ((k >> 1) & 1);
            const float v = (k & 1) == 0 ? F.in[I_SCRE][((size_t)l * 256 + gp) * 64 + n] : -F.in[I_SCIM][((size_t)l * 256 + gp) * 64 + n];
            cm[r] = f2bf(v);
        }
    }
}

__device__ __forceinline__ void phase_norm(const Frame& F_, const float* xin, bool add_o, const float* w, int mode) { Frame F = relocal(F_);
    float* X = (float*)(F.ws + WS_X); bf16_t* H = (bf16_t*)(F.ws + WS_H); const bf16_t* O = (const bf16_t*)(F.ws + WS_U);
    for (int row0 = F.bid * 32 + F.wave * 4; row0 < NTOK; row0 += F.G * 32) {
        f32x4 v[4][4]; u32x2 oa[4][4], ob[4][4];
#pragma unroll
        for (int r = 0; r < 4; ++r)
#pragma unroll
            for (int j = 0; j < 4; ++j) { const int c = 4 * F.lane + 256 * j; const size_t o = (size_t)(row0 + r) * DM + c; v[r][j] = (mode == 2) ? __builtin_nontemporal_load((const f32x4*)(xin + o)) : *(const f32x4*)(xin + o);
                if (add_o) { oa[r][j] = __builtin_nontemporal_load((const u32x2*)(O + o)); ob[r][j] = __builtin_nontemporal_load((const u32x2*)(O + (size_t)NTOK * DM + o)); } }
#pragma unroll
        for (int r = 0; r < 4; ++r) { const int row = row0 + r; float ss = 0.f;
#pragma unroll
            for (int j = 0; j < 4; ++j) {
                if (add_o) { const u32x2 a = oa[r][j], b = ob[r][j];
                    v[r][j][0] += __uint_as_float(a.x << 16) + __uint_as_float(b.x << 16); v[r][j][1] += __uint_as_float(a.x & 0xffff0000u) + __uint_as_float(b.x & 0xffff0000u);
                    v[r][j][2] += __uint_as_float(a.y << 16) + __uint_as_float(b.y << 16); v[r][j][3] += __uint_as_float(a.y & 0xffff0000u) + __uint_as_float(b.y & 0xffff0000u); }
                ss += v[r][j][0] * v[r][j][0] + v[r][j][1] * v[r][j][1] + v[r][j][2] * v[r][j][2] + v[r][j][3] * v[r][j][3]; }
            ss = wave_sum(ss);
            const float rstd = rsqrtf(ss * (1.0f / DM) + 1e-6f);
#pragma unroll
            for (int j = 0; j < 4; ++j) { const int c = 4 * F.lane + 256 * j; const f32x4 wv = *(const f32x4*)(w + c);
                if (mode == 2) { __builtin_nontemporal_store(v[r][j] * rstd * wv, (f32x4*)(F.out + (size_t)row * DM + c)); }
                else { if (mode == 0) *(f32x4*)(X + (size_t)row * DM + c) = v[r][j];
                    u32x2 o; o.x = pk2(v[r][j][0] * rstd * wv[0], v[r][j][1] * rstd * wv[1]); o.y = pk2(v[r][j][2] * rstd * wv[2], v[r][j][3] * rstd * wv[3]);
                    *(u32x2*)(H + (size_t)row * DM + c) = o; } } }
    }
}

__device__ __forceinline__ void item_kv(const Frame& F_, int layer, int item) { Frame F = relocal(F_);
    const bf16_t* U = (const bf16_t*)(F.ws + WS_U);
    LAS bf16_t* Ab = (LAS bf16_t*)F.lds;
    LAS bf16_t* Bt = (LAS bf16_t*)(F.lds + 17408);
    const int t0 = item * 64;
    { const int tok = F.tid >> 3, part = F.tid & 7; const bf16_t* src = U + (size_t)(t0 + tok) * NINP + UC + 256 + 16 * part;
      float f[16]; { float a[8], b[8]; unpack8(*(const u32x4*)src, a); unpack8(*(const u32x4*)(src + 8), b);
#pragma unroll
        for (int j = 0; j < 8; ++j) { f[j] = a[j]; f[8 + j] = b[j]; } }
      float ss = 0.f;
#pragma unroll
      for (int j = 0; j < 16; ++j) ss += f[j] * f[j];
      ss = sum8(ss);
      const float rstd = rsqrtf(ss * (1.0f / 128.0f) + 1e-6f); const float* nw = F.in[I_CKVN] + layer * 128 + 16 * part;
#pragma unroll
      for (int j = 0; j < 16; j += 2) *(LAS unsigned*)(Ab + tok * 136 + 16 * part + j) = pk2(f[j] * rstd * nw[j], f[j + 1] * rstd * nw[j + 1]); }
    { const int n = F.tid >> 2, kq = F.tid & 3; const float* w = (n < 64 ? F.in[I_CWUK] : F.in[I_CWUV]) + (size_t)layer * 128 * 64 + (n & 63);
      float wv[32];
#pragma unroll
      for (int k = 0; k < 32; ++k) wv[k] = w[(size_t)(32 * kq + k) * 64];
#pragma unroll
      for (int k = 0; k < 32; k += 2) *(LAS unsigned*)(Bt + n * 136 + 32 * kq + k) = pk2(wv[k], wv[k + 1]); }
    if (F.tid < 256) { const int tok = F.tid >> 2, q = F.tid & 3;
        *(u32x4*)((bf16_t*)(F.ws + WS_KIDX) + (size_t)(t0 + tok) * 32 + 8 * q) = *(const u32x4*)(U + (size_t)(t0 + tok) * NINP + UC + 640 + 8 * q); }
    __syncthreads();
    const int mt = F.wave & 3, g = F.lane >> 4, r = F.lane & 15;
#pragma unroll
    for (int q = 0; q < 4; ++q) { const int nt = (F.wave >> 2) * 4 + q;
        f32x4 acc = (f32x4){0.f, 0.f, 0.f, 0.f};
        acc = mma_nt<128>(Ab + mt * 16 * 136, 136, Bt + nt * 16 * 136, 136, acc, F.lane);
        const int n = nt * 16 + r; bf16_t* dst = (bf16_t*)(F.ws + (n < 64 ? WS_K : WS_V));
#pragma unroll
        for (int i = 0; i < 4; ++i) dst[(size_t)(t0 + mt * 16 + 4 * g + i) * 64 + (n & 63)] = f2bf(acc[i]); }
}

constexpr int MB_CG = 0, MB_BG = 18432, MB_XT = 36864, MB_BT = 73728, MB_M = 73728, MB_S0 = 110592, MB_DT = 147456, MB_AC = 148480, MB_RS = 149504;
static_assert(MB_RS + 256 <= MISC_OFF && MB_BT == MB_XT + 4 * 64 * 72 * 2, "mamba LDS");
template <int STAGE> __device__ __forceinline__ void item_mamba(const Frame& F_, int layer, int item) { Frame F = relocal(F_);
    const bf16_t* U = (const bf16_t*)(F.ws + WS_U);
    const int b = item >> 6, c = item & 63, l0 = c * 64; const size_t T0 = (size_t)b * SEQ + l0;
    LAS bf16_t* Cg = (LAS bf16_t*)(F.lds + MB_CG); LAS bf16_t* Bg = (LAS bf16_t*)(F.lds + MB_BG); LAS bf16_t* BT = (LAS bf16_t*)(F.lds + MB_BT);
    LAS bf16_t* XT = (LAS bf16_t*)(F.lds + MB_XT); LAS bf16_t* Mb = (LAS bf16_t*)(F.lds + MB_M); LAS bf16_t* S0 = (LAS bf16_t*)(F.lds + MB_S0);
    LAS float* dts = (LAS float*)(F.lds + MB_DT); LAS float* acs = (LAS float*)(F.lds + MB_AC); LAS float* rs = (LAS float*)(F.lds + MB_RS);
    const int tg = F.tid & 7, c0 = (F.tid >> 3) * 8;
    const bool conv_on = (STAGE == 2) || (F.wave < 6);
    u32x4 rows[11]; float wv[4][8], bv[8];
    if (conv_on) {
#pragma unroll
        for (int k = 0; k < 11; ++k) { const int l = l0 + tg * 8 - 3 + k;
            if (l >= 0) rows[k] = *(const u32x4*)(U + ((size_t)b * SEQ + l) * NINP + UM + 256 + c0); else rows[k] = (u32x4){0u, 0u, 0u, 0u}; }
#pragma unroll
        for (int j = 0; j < 8; ++j) { bv[j] = F.in[I_MCONVB][layer * 512 + c0 + j];
#pragma unroll
            for (int k = 0; k < 4; ++k) wv[k][j] = F.in[I_MCONVW][(layer * 4 + k) * 512 + c0 + j]; } }
    const float* MSTi = (const float*)(F.ws + WS_MST) + ((size_t)(b * 64 + c) * 4) * 4096;
    f32x4 s0a[4], s0b[4];
    if (STAGE == 2) {
#pragma unroll
        for (int h = 0; h < 4; ++h) { const float* src = MSTi + (size_t)h * 4096 + F.tid * 8; s0a[h] = *(const f32x4*)src; s0b[h] = *(const f32x4*)(src + 4); } }
    if (F.wave < 4) { const int l = F.lane, h = F.wave;
        const float raw = bf2f(U[(T0 + l) * NINP + UM + 768 + h]) + F.in[I_MDTB][layer * 4 + h];
        const float dt = softplusf_(raw); const float cum = wave_prefix_f(-__expf(F.in[I_MALOG][layer * 4 + h]) * dt);
        dts[l * 4 + h] = dt; acs[l * 4 + h] = cum; }
    if (STAGE == 2) { if (F.tid < 64) rs[F.tid] = 0.f;
#pragma unroll
        for (int h = 0; h < 4; ++h) { u32x4 w; w.x = pk2(s0a[h][0], s0a[h][1]); w.y = pk2(s0a[h][2], s0a[h][3]); w.z = pk2(s0b[h][0], s0b[h][1]); w.w = pk2(s0b[h][2], s0b[h][3]);
            *(LAS u32x4*)(S0 + (h * 64 + (F.tid >> 3)) * 72 + (F.tid & 7) * 8) = w; } }
    __syncthreads();
    if (conv_on) {
        float win[3][8]; unpack8(rows[0], win[0]); unpack8(rows[1], win[1]); unpack8(rows[2], win[2]);
        const bool isx = F.wave < 4, tr = isx || STAGE == 1;
        unsigned pkT[8][4]; float prev[8];
#pragma unroll
        for (int i = 0; i < 8; ++i) { const int l = tg * 8 + i; float cur[8]; unpack8(rows[3 + i], cur);
            float o[8];
#pragma unroll
            for (int j = 0; j < 8; ++j) { o[j] = siluf_(bv[j] + wv[0][j] * win[0][j] + wv[1][j] * win[1][j] + wv[2][j] * win[2][j] + wv[3][j] * cur[j]);
                win[0][j] = win[1][j]; win[1][j] = win[2][j]; win[2][j] = cur[j]; }
            if (isx) { const int h = F.wave; float sc = dts[l * 4 + h]; if (STAGE == 1) sc *= __expf(acs[63 * 4 + h] - acs[l * 4 + h]);
#pragma unroll
                for (int j = 0; j < 8; ++j) o[j] *= sc; }
            if (tr) {
#pragma unroll
                for (int j = 0; j < 8; ++j) { if (i & 1) pkT[j][i >> 1] = pk2(prev[j], o[j]); else prev[j] = o[j]; } }
            else { u32x4 w; w.x = pk2(o[0], o[1]); w.y = pk2(o[2], o[3]); w.z = pk2(o[4], o[5]); w.w = pk2(o[6], o[7]);
                *(LAS u32x4*)(Cg + (F.wave < 6 ? (MB_BG - MB_CG) / 2 : 0) + ((F.wave & 1) * 64 + l) * 72 + (c0 & 63)) = w; } }
        if (tr) { LAS bf16_t* dstT = XT + F.wave * 64 * 72;
#pragma unroll
            for (int j = 0; j < 8; ++j) *(LAS u32x4*)(dstT + ((c0 & 63) + j) * 72 + tg * 8) = (u32x4){pkT[j][0], pkT[j][1], pkT[j][2], pkT[j][3]}; } }
    const int g4 = F.lane >> 4, r16 = F.lane & 15;
    if (STAGE == 1) {
        __syncthreads();
        float* MST = (float*)(F.ws + WS_MST) + ((size_t)(b * 64 + c) * 4) * 4096;
#pragma unroll
        for (int q = 0; q < 8; ++q) { const int tix = F.wave * 8 + q, h = tix >> 4, mt = (tix >> 2) & 3, nt = tix & 3;
            f32x4 acc = (f32x4){0.f, 0.f, 0.f, 0.f};
            acc = mma_nt<64>(XT + (h * 64 + mt * 16) * 72, 72, BT + ((h >> 1) * 64 + nt * 16) * 72, 72, acc, F.lane);
#pragma unroll
            for (int i = 0; i < 4; ++i) MST[(size_t)h * 4096 + (mt * 16 + 4 * g4 + i) * 64 + nt * 16 + r16] = acc[i]; }
        if (F.tid < 4) ((float*)(F.ws + WS_MDEC))[(b * 64 + c) * 4 + F.tid] = __expf(acs[63 * 4 + F.tid]);
    } else {
        const int mt = F.wave & 3, nh = F.wave >> 2;
        bf16_t zz[4][2][4];
#pragma unroll
        for (int h = 0; h < 4; ++h)
#pragma unroll
            for (int q = 0; q < 2; ++q)
#pragma unroll
                for (int i = 0; i < 4; ++i) zz[h][q][i] = U[(T0 + mt * 16 + 4 * g4 + i) * NINP + UM + h * 64 + (2 * nh + q) * 16 + r16];
        __syncthreads();
        f32x4 yv[4][2];
#pragma unroll
        for (int g = 0; g < 2; ++g)
#pragma unroll
            for (int q = 0; q < 2; ++q) { f32x4 G = (f32x4){0.f, 0.f, 0.f, 0.f};
                G = mma_nt<64>(Cg + (g * 64 + mt * 16) * 72, 72, Bg + (g * 64 + (2 * nh + q) * 16) * 72, 72, G, F.lane);
                const int s = (2 * nh + q) * 16 + r16;
#pragma unroll
                for (int hh = 0; hh < 2; ++hh) { const int h = 2 * g + hh; const float as = acs[s * 4 + h];
#pragma unroll
                    for (int i = 0; i < 4; ++i) { const int l = mt * 16 + 4 * g4 + i; const float v = (s <= l) ? G[i] * __expf(acs[l * 4 + h] - as) : 0.f;
                        Mb[(h * 64 + l) * 72 + s] = f2bf(v); } } }
        __syncthreads();
#pragma unroll
        for (int h = 0; h < 4; ++h) { const int g = h >> 1;
#pragma unroll
            for (int q = 0; q < 2; ++q) { const int nt = 2 * nh + q;
                f32x4 yd = (f32x4){0.f, 0.f, 0.f, 0.f}, yo = (f32x4){0.f, 0.f, 0.f, 0.f};
                yd = mma_nt<64>(Mb + (h * 64 + mt * 16) * 72, 72, XT + (h * 64 + nt * 16) * 72, 72, yd, F.lane);
                yo = mma_nt<64>(Cg + (g * 64 + mt * 16) * 72, 72, S0 + (h * 64 + nt * 16) * 72, 72, yo, F.lane);
                const int p = nt * 16 + r16; const float dsk = F.in[I_MD][layer * 4 + h];
#pragma unroll
                for (int i = 0; i < 4; ++i) { const int l = mt * 16 + 4 * g4 + i;
                    const float xs = bf2f(XT[(h * 64 + p) * 72 + l]) / dts[l * 4 + h];
                    yv[h][q][i] = yd[i] + yo[i] * __expf(acs[l * 4 + h]) + dsk * xs; } } }
        float part[4] = {0.f, 0.f, 0.f, 0.f};
#pragma unroll
        for (int h = 0; h < 4; ++h)
#pragma unroll
            for (int q = 0; q < 2; ++q) {
#pragma unroll
                for (int i = 0; i < 4; ++i) { const float z = bf2f(zz[h][q][i]);
                    const float v = yv[h][q][i] * siluf_(z); yv[h][q][i] = v; part[i] += v * v; } }
#pragma unroll
        for (int i = 0; i < 4; ++i) { const float s = sum16(part[i]); if (r16 == 0) atomicAdd((float*)(rs + mt * 16 + 4 * g4 + i), s); }
        __syncthreads();
        bf16_t* Y = (bf16_t*)(F.ws + WS_H);
#pragma unroll
        for (int i = 0; i < 4; ++i) { const int l = mt * 16 + 4 * g4 + i; const float rstd = rsqrtf(rs[l] * (1.0f / 256.0f) + 1e-6f);
#pragma unroll
            for (int h = 0; h < 4; ++h)
#pragma unroll
                for (int q = 0; q < 2; ++q) { const int ch = h * 64 + (2 * nh + q) * 16 + r16;
                    Y[(T0 + l) * DM + ch] = f2bf(yv[h][q][i] * rstd * F.in[I_MNORM][layer * 256 + ch]); } }
    }
}
__device__ __forceinline__ void item_mamba_carry(const Frame& F_, int item) { Frame F = relocal(F_);
    const int b = item >> 2, h = item & 3;
    float* MST = (float*)(F.ws + WS_MST); const float* MD = (const float*)(F.ws + WS_MDEC);
    float s[8];
#pragma unroll
    for (int j = 0; j < 8; ++j) s[j] = 0.f;
    for (int c = 0; c < 64; ++c) { float* p = MST + ((size_t)(b * 64 + c) * 4 + h) * 4096 + F.tid * 8; const float d = MD[(b * 64 + c) * 4 + h];
        const f32x4 a = *(f32x4*)p, q = *(f32x4*)(p + 4);
        *(f32x4*)p = (f32x4){s[0], s[1], s[2], s[3]}; *(f32x4*)(p + 4) = (f32x4){s[4], s[5], s[6], s[7]};
        s[0] = s[0] * d + a[0]; s[1] = s[1] * d + a[1]; s[2] = s[2] * d + a[2]; s[3] = s[3] * d + a[3];
        s[4] = s[4] * d + q[0]; s[5] = s[5] * d + q[1]; s[6] = s[6] * d + q[2]; s[7] = s[7] * d + q[3]; }
}

template <int STAGE> __device__ __forceinline__ void item_s5(const Frame& F_, int layer, int item) { Frame F = relocal(F_);
    const bf16_t* U = (const bf16_t*)(F.ws + WS_U);
    const int b = item >> 6, c = item & 63; const size_t T0 = (size_t)b * SEQ + c * 64;
    LAS bf16_t* us = (LAS bf16_t*)F.lds;
    LAS bf16_t* BuW = (LAS bf16_t*)(F.lds + 33792) + F.wave * 4224;
    const float* tab = (const float*)(F.ws + WS_S5TAB + (size_t)layer * S5TAB_L);
    { const int tok = F.tid >> 3, part = F.tid & 7;
#pragma unroll
      for (int q = 0; q < 4; ++q) *(LAS u32x4*)(us + tok * 264 + 32 * part + 8 * q) = *(const u32x4*)(U + (T0 + tok) * NINP + US + 32 * part + 8 * q); }
    const int lane = F.lane, r16 = lane & 15, g4 = lane >> 4, gq = lane >> 5, n0 = lane & 31, g = 2 * F.wave + gq, gn0 = g * 64 + n0, gn1 = gn0 + 32;
    bf16x8 bfr[2][8];
    { const bf16_t* bbt = (const bf16_t*)(F.ws + WS_S5TAB + (size_t)layer * S5TAB_L + S5TAB_BBT);
#pragma unroll
      for (int gg = 0; gg < 2; ++gg)
#pragma unroll
          for (int nt = 0; nt < 8; ++nt) { u32x4 z = (u32x4){0u, 0u, 0u, 0u}; if (g4 < 2) z = *(const u32x4*)(bbt + ((size_t)(2 * F.wave + gg) * 128 + 16 * nt + r16) * 16 + 8 * g4); bfr[gg][nt] = __builtin_bit_cast(bf16x8, z); } }
    const float a0r = tab[gn0 * 2], a0i = tab[gn0 * 2 + 1], a1r = tab[gn1 * 2], a1i = tab[gn1 * 2 + 1];
    float* ST = (float*)(F.ws + WS_S5ST) + (size_t)(b * 64 + c) * 2048;
    float h0r = 0.f, h0i = 0.f, h1r = 0.f, h1i = 0.f;
    if (STAGE == 2) { h0r = ST[gn0 * 2]; h0i = ST[gn0 * 2 + 1]; h1r = ST[gn1 * 2]; h1i = ST[gn1 * 2 + 1]; }
    bf16x8 cf[2][4];
    if (STAGE == 2) { const bf16_t* cm = (const bf16_t*)(F.ws + WS_S5TAB + (size_t)layer * S5TAB_L + S5TAB_F);
#pragma unroll
        for (int gg = 0; gg < 2; ++gg)
#pragma unroll
            for (int ks = 0; ks < 4; ++ks) cf[gg][ks] = *(const bf16x8*)(cm + ((size_t)((2 * F.wave + gg) * 16 + r16)) * 128 + 32 * ks + 8 * g4); }
    LAS bf16_t* YSl = (LAS bf16_t*)(F.lds + 101376);
    const bf16_t* GW = (const bf16_t*)(F.ws + WS_GLU) + (size_t)layer * 512 * 256;
    float dsk[2] = {0.f, 0.f}, bvl[2] = {0.f, 0.f}, bgt[2] = {0.f, 0.f}; bf16x8 gwb[2][4];
    if (STAGE == 2) {
#pragma unroll
        for (int gg = 0; gg < 2; ++gg) dsk[gg] = F.in[I_SD][layer * 256 + (2 * F.wave + gg) * 16 + r16];
#pragma unroll
        for (int q = 0; q < 2; ++q) { const int c = 32 * F.wave + 16 * q + r16; bvl[q] = F.in[I_SGLUB][layer * 512 + c]; bgt[q] = F.in[I_SGLUB][layer * 512 + 256 + c]; }
#pragma unroll
        for (int ks = 0; ks < 2; ++ks)
#pragma unroll
            for (int q = 0; q < 2; ++q) { const int c = 32 * F.wave + 16 * q + r16; const int rowv = 256 * (c >> 7) + (c & 127);
                gwb[ks][2 * q] = *(const bf16x8*)(GW + (size_t)rowv * 256 + 32 * ks + 8 * g4); gwb[ks][2 * q + 1] = *(const bf16x8*)(GW + (size_t)(rowv + 128) * 256 + 32 * ks + 8 * g4); } }
    __syncthreads();
#pragma unroll 1
    for (int lb = 0; lb < 4; ++lb) {
#pragma unroll
        for (int gg = 0; gg < 2; ++gg) { u32x4 z = (u32x4){0u, 0u, 0u, 0u}; if (g4 < 2) z = *(const LAS u32x4*)(us + (16 * lb + r16) * 264 + (2 * F.wave + gg) * 16 + 8 * g4);
            const bf16x8 afr = __builtin_bit_cast(bf16x8, z);
#pragma unroll
            for (int nt = 0; nt < 8; ++nt) { const f32x4 acc = __builtin_amdgcn_mfma_f32_16x16x32_bf16(afr, bfr[gg][nt], (f32x4){0.f, 0.f, 0.f, 0.f}, 0, 0, 0);
#pragma unroll
                for (int i = 0; i < 4; ++i) BuW[(4 * g4 + i) * 264 + gg * 128 + 16 * nt + r16] = f2bf(acc[i]); } }
        __syncthreads();
#pragma unroll 4
        for (int li = 0; li < 16; ++li) { LAS u32x2* bp = (LAS u32x2*)(BuW + li * 264 + gq * 128 + 4 * n0); const u32x2 v = *bp;
            { const float br = __uint_as_float(v.x << 16), bi = __uint_as_float(v.x & 0xffff0000u); const float nr = a0r * h0r - a0i * h0i + br, ni = a0r * h0i + a0i * h0r + bi; h0r = nr; h0i = ni; }
            { const float br = __uint_as_float(v.y << 16), bi = __uint_as_float(v.y & 0xffff0000u); const float nr = a1r * h1r - a1i * h1i + br, ni = a1r * h1i + a1i * h1r + bi; h1r = nr; h1i = ni; }
            if (STAGE == 2) *bp = (u32x2){pk2(h0r, h0i), pk2(h1r, h1i)}; }
        __syncthreads();
        if (STAGE == 2) {
#pragma unroll
            for (int gg = 0; gg < 2; ++gg) { f32x4 acc = (f32x4){0.f, 0.f, 0.f, 0.f};
#pragma unroll
                for (int ks = 0; ks < 4; ++ks) { const bf16x8 a = *(const LAS bf16x8*)(BuW + r16 * 264 + gg * 128 + 32 * ks + 8 * g4);
                    acc = __builtin_amdgcn_mfma_f32_16x16x32_bf16(a, cf[gg][ks], acc, 0, 0, 0); }
                const int ch = (2 * F.wave + gg) * 16 + r16;
#pragma unroll
                for (int i = 0; i < 4; ++i) { const int l = lb * 16 + 4 * g4 + i; const float y = acc[i] + dsk[gg] * bf2f(us[l * 264 + ch]);
                    YSl[l * 264 + ch] = f2bf(gelu_tanh(y)); } }
            __syncthreads();
        }
    }
    if (STAGE == 1) { ST[gn0 * 2] = h0r; ST[gn0 * 2 + 1] = h0i; ST[gn1 * 2] = h1r; ST[gn1 * 2 + 1] = h1i; }
    if (STAGE == 2) {
        f32x4 av[4][2], ag[4][2];
#pragma unroll
        for (int m = 0; m < 4; ++m)
#pragma unroll
            for (int q = 0; q < 2; ++q) { av[m][q] = (f32x4){0.f, 0.f, 0.f, 0.f}; ag[m][q] = (f32x4){0.f, 0.f, 0.f, 0.f}; }
#pragma unroll
        for (int ks = 0; ks < 8; ++ks) {
            bf16x8 af[4], bcur[4];
#pragma unroll
            for (int j = 0; j < 4; ++j) bcur[j] = gwb[ks & 1][j];
            if (ks + 2 < 8) {
#pragma unroll
                for (int q = 0; q < 2; ++q) { const int c = 32 * F.wave + 16 * q + r16; const int rowv = 256 * (c >> 7) + (c & 127);
                    gwb[ks & 1][2 * q] = *(const bf16x8*)(GW + (size_t)rowv * 256 + 32 * (ks + 2) + 8 * g4); gwb[ks & 1][2 * q + 1] = *(const bf16x8*)(GW + (size_t)(rowv + 128) * 256 + 32 * (ks + 2) + 8 * g4); } }
#pragma unroll
            for (int m = 0; m < 4; ++m) af[m] = *(const LAS bf16x8*)(YSl + (16 * m + r16) * 264 + 32 * ks + 8 * g4);
#pragma unroll
            for (int m = 0; m < 4; ++m)
#pragma unroll
                for (int q = 0; q < 2; ++q) { av[m][q] = __builtin_amdgcn_mfma_f32_16x16x32_bf16(af[m], bcur[2 * q], av[m][q], 0, 0, 0); ag[m][q] = __builtin_amdgcn_mfma_f32_16x16x32_bf16(af[m], bcur[2 * q + 1], ag[m][q], 0, 0, 0); }
        }
        bf16_t* Y = (bf16_t*)(F.ws + WS_H);
#pragma unroll
        for (int q = 0; q < 2; ++q) { const int c = 32 * F.wave + 16 * q + r16;
#pragma unroll
            for (int m = 0; m < 4; ++m)
#pragma unroll
                for (int i = 0; i < 4; ++i) Y[(T0 + 16 * m + 4 * g4 + i) * DM + 768 + c] = f2bf((av[m][q][i] + bvl[q]) * sigmoidf_(ag[m][q][i] + bgt[q])); }
    }
}
__device__ __forceinline__ void item_s5_carry(const Frame& F_, int layer, int b) { Frame F = relocal(F_);
    const float* tab = (const float*)(F.ws + WS_S5TAB + (size_t)layer * S5TAB_L) + 2048;
    float* ST = (float*)(F.ws + WS_S5ST) + (size_t)b * 64 * 2048;
#pragma unroll
    for (int q = 0; q < 2; ++q) { const int gn = F.tid + 512 * q; const float pr = tab[gn * 2], pi = tab[gn * 2 + 1]; float hr = 0.f, hi = 0.f;
        for (int c = 0; c < 64; ++c) { float* p = ST + (size_t)c * 2048 + gn * 2; const float tr = p[0], ti = p[1]; p[0] = hr; p[1] = hi;
            const float nr = pr * hr - pi * hi + tr, ni = pr * hi + pi * hr + ti; hr = nr; hi = ni; } }
}

constexpr int RB_LD = 72;
constexpr int RW_R = 0, RW_K = 16384, RW_V = 32768, RW_W = 49152, RW_A = 65536, RW_B = 81920;
constexpr int R3_G = 49152, R3_O = 65536, R3_TILES = 81920, R3_BON = 147456;
template <int STAGE> __device__ __forceinline__ void rwkv_prep(const Frame& F_, int layer, int b, int h, int c) { Frame F = relocal(F_);
    const bf16_t* U = (const bf16_t*)(F.ws + WS_U);
    const int l0 = c * 64; const size_t T0 = (size_t)b * SEQ + l0;
    LAS float* Rr = (LAS float*)(F.lds + RW_R); LAS float* Kk = (LAS float*)(F.lds + RW_K); LAS float* Vv = (LAS float*)(F.lds + RW_V); LAS float* Ww = (LAS float*)(F.lds + RW_W);
    LAS float* Aa = (LAS float*)(F.lds + (STAGE == 1 ? RW_A : R3_O)); LAS float* Bb = (LAS float*)(F.lds + RW_B); LAS float* Gg = (LAS float*)(F.lds + R3_G); LAS float* BON = (LAS float*)(F.lds + R3_BON);
    LAS bf16_t* TWb = (LAS bf16_t*)(F.lds + 98304); LAS bf16_t* DAb = (LAS bf16_t*)(F.lds + (STAGE == 1 ? 103424 : 118784)); LAS bf16_t* SGb = (LAS bf16_t*)(F.lds + 123904);
    LAS bf16_t* w2T = (LAS bf16_t*)(F.lds + 108544); LAS bf16_t* a2T = (LAS bf16_t*)(F.lds + (STAGE == 1 ? 113664 : 133120)); LAS bf16_t* g2T = (LAS bf16_t*)(F.lds + 138240);
    const float* mu = F.in[I_RMU] + layer * 896;
    float pw0[2] = {0.f, 0.f}, pa0[2] = {0.f, 0.f}; f32x4 pkkw[2], pkaw[2], prk[2];
    if (STAGE == 1) { const int cgl = layer * 256 + h * 64 + 8 * (F.tid & 7);
#pragma unroll
        for (int q = 0; q < 2; ++q) { pkkw[q] = *(const f32x4*)(F.in[I_RKK] + cgl + 4 * q); pkaw[q] = *(const f32x4*)(F.in[I_RKA] + cgl + 4 * q); prk[q] = *(const f32x4*)(F.in[I_RRK] + cgl + 4 * q); }
#pragma unroll
        for (int q = 0; q < 2; ++q) { const int cg = layer * 256 + h * 64 + 16 * (2 * (F.wave & 1) + q) + (F.lane & 15); pw0[q] = F.in[I_RW0][cg]; pa0[q] = F.in[I_RA0][cg]; } }
    { const int tok = F.tid >> 3, p8 = F.tid & 7; const bool first = (l0 + tok == 0);
      const bf16_t* cur = U + (T0 + tok) * NINP + UR; const bf16_t* prv = first ? cur : cur - NINP;
      const float pz = first ? 0.f : 1.f;
      u32x4 cw[3], pw[3]; u32x2 c1 = (u32x2){0u, 0u}, p1 = (u32x2){0u, 0u}, c2 = (u32x2){0u, 0u}, p2 = (u32x2){0u, 0u}; u32x4 c3 = (u32x4){0u, 0u, 0u, 0u}, p3 = (u32x4){0u, 0u, 0u, 0u};
#pragma unroll
      for (int sec = (STAGE == 1 ? 0 : 2); sec < 3; ++sec) { const int co = sec * 256 + h * 64 + 8 * p8; cw[sec] = *(const u32x4*)(cur + co); pw[sec] = *(const u32x4*)(prv + co); }
      if (STAGE == 1) { c1 = *(const u32x2*)(cur + 768 + 4 * p8); p1 = *(const u32x2*)(prv + 768 + 4 * p8); c2 = *(const u32x2*)(cur + 800 + 4 * p8); p2 = *(const u32x2*)(prv + 800 + 4 * p8); }
      if (STAGE == 3) { c3 = *(const u32x4*)(cur + 832 + 8 * p8); p3 = *(const u32x4*)(prv + 832 + 8 * p8); }
#pragma unroll
      for (int sec = (STAGE == 1 ? 0 : 2); sec < 3; ++sec) { const int co = sec * 256 + h * 64 + 8 * p8; float av[8], pq[8]; unpack8(cw[sec], av); unpack8(pw[sec], pq);
          const f32x4 m0 = *(const f32x4*)(mu + co), m1 = *(const f32x4*)(mu + co + 4);
          LAS float* dst = (sec == 0 ? Rr : sec == 1 ? Kk : Vv) + tok * 64 + 8 * p8;
#pragma unroll
          for (int j = 0; j < 8; ++j) pq[j] *= pz;
          *(LAS f32x4*)dst = (f32x4){av[0] + m0[0] * (pq[0] - av[0]), av[1] + m0[1] * (pq[1] - av[1]), av[2] + m0[2] * (pq[2] - av[2]), av[3] + m0[3] * (pq[3] - av[3])};
          *(LAS f32x4*)(dst + 4) = (f32x4){av[4] + m1[0] * (pq[4] - av[4]), av[5] + m1[1] * (pq[5] - av[5]), av[6] + m1[2] * (pq[6] - av[6]), av[7] + m1[3] * (pq[7] - av[7])}; }
      if (STAGE == 1) {
#pragma unroll
        for (int which = 0; which < 2; ++which) { const int co = 768 + 32 * which + 4 * p8; const u32x2 cv = which ? c2 : c1, pv = which ? p2 : p1;
          const f32x4 m0 = *(const f32x4*)(mu + co);
          float x[4] = {__uint_as_float(cv.x << 16), __uint_as_float(cv.x & 0xffff0000u), __uint_as_float(cv.y << 16), __uint_as_float(cv.y & 0xffff0000u)};
          const float y[4] = {pz * __uint_as_float(pv.x << 16), pz * __uint_as_float(pv.x & 0xffff0000u), pz * __uint_as_float(pv.y << 16), pz * __uint_as_float(pv.y & 0xffff0000u)};
#pragma unroll
          for (int j = 0; j < 4; ++j) { x[j] = x[j] + m0[j] * (y[j] - x[j]); if (which == 0) x[j] = tanhf_(x[j]); }
          *(LAS u32x2*)((which ? DAb : TWb) + tok * 40 + 4 * p8) = (u32x2){pk2(x[0], x[1]), pk2(x[2], x[3])}; } }
      if (STAGE == 3) { const int co = 832 + 8 * p8; float av[8], pq[8]; unpack8(c3, av); unpack8(p3, pq);
          const f32x4 m0 = *(const f32x4*)(mu + co), m1 = *(const f32x4*)(mu + co + 4); float x[8];
#pragma unroll
          for (int j = 0; j < 8; ++j) x[j] = sigmoidf_(av[j] + (j < 4 ? m0[j] : m1[j - 4]) * (pz * pq[j] - av[j]));
          *(LAS u32x4*)(SGb + tok * RB_LD + 8 * p8) = (u32x4){pk2(x[0], x[1]), pk2(x[2], x[3]), pk2(x[4], x[5]), pk2(x[6], x[7])}; } }
    { const int ch = F.tid & 63, part = F.tid >> 6;
      if (STAGE == 1) { const float* w2 = F.in[I_RW2] + ((size_t)layer * 32 + 4 * part) * 256 + h * 64 + ch;
          *(LAS u32x2*)(w2T + ch * 40 + 4 * part) = (u32x2){pk2(w2[0], w2[256]), pk2(w2[512], w2[768])}; }
      if (STAGE == 1) { const float* a2 = F.in[I_RA2] + ((size_t)layer * 32 + 4 * part) * 256 + h * 64 + ch;
          *(LAS u32x2*)(a2T + ch * 40 + 4 * part) = (u32x2){pk2(a2[0], a2[256]), pk2(a2[512], a2[768])}; }
      if (STAGE == 3) { const float* g2 = F.in[I_RG2] + ((size_t)layer * 64 + 8 * part) * 256 + h * 64 + ch;
          *(LAS u32x4*)(g2T + ch * RB_LD + 8 * part) = (u32x4){pk2(g2[0], g2[256]), pk2(g2[512], g2[768]), pk2(g2[1024], g2[1280]), pk2(g2[1536], g2[1792])}; } }
    __syncthreads();
    { const int lane = F.lane, mt = F.wave >> 1, nt0 = 2 * (F.wave & 1), r = lane & 15, g4 = lane >> 4; const f32x4 zero4 = (f32x4){0.f, 0.f, 0.f, 0.f};
#pragma unroll
      for (int q = 0; q < 2; ++q) { const int nt = nt0 + q, ch = 16 * nt + r;
          if (STAGE == 1) { const f32x4 wl = mma_nt<32>(TWb + 16 * mt * 40, 40, w2T + 16 * nt * 40, 40, zero4, lane); const float w0 = pw0[q];
#pragma unroll
              for (int i = 0; i < 4; ++i) { const float x = w0 + wl[i]; const float wlog = -__logf(1.0f + __expf(-x)) - 0.5f; Ww[(16 * mt + 4 * g4 + i) * 64 + ch] = __expf(-__expf(wlog)); } }
          if (STAGE == 1) { const f32x4 al = mma_nt<32>(DAb + 16 * mt * 40, 40, a2T + 16 * nt * 40, 40, zero4, lane); const float a0 = pa0[q];
#pragma unroll
              for (int i = 0; i < 4; ++i) Aa[(16 * mt + 4 * g4 + i) * 64 + ch] = sigmoidf_(a0 + al[i]); }
          if (STAGE == 3) { const f32x4 gv = mma_nt<64>(SGb + 16 * mt * RB_LD, RB_LD, g2T + 16 * nt * RB_LD, RB_LD, zero4, lane);
#pragma unroll
              for (int i = 0; i < 4; ++i) Gg[(16 * mt + 4 * g4 + i) * 64 + ch] = gv[i]; } } }
    __syncthreads();
    float* gBON = (float*)(F.ws + WS_BON) + ((size_t)(b * 4 + h) * 64 + c) * 64;
    if (STAGE == 1) { const int t = F.tid >> 3, p8 = F.tid & 7;
      LAS float* pa = Aa + t * 64 + 8 * p8; LAS float* pk = Kk + t * 64 + 8 * p8; LAS float* pr = Rr + t * 64 + 8 * p8; LAS float* pb = Bb + t * 64 + 8 * p8;
      float kp[8], kkv[8], av[8]; float ss = 0.f, bo = 0.f;
#pragma unroll
      for (int q = 0; q < 2; ++q) { const f32x4 a4 = *(const LAS f32x4*)(pa + 4 * q), k4 = *(const LAS f32x4*)(pk + 4 * q), r4 = *(const LAS f32x4*)(pr + 4 * q);
#pragma unroll
          for (int j = 0; j < 4; ++j) { const float a = a4[j], kraw = k4[j]; av[4 * q + j] = a; kp[4 * q + j] = kraw * (1.0f + (a - 1.0f) * pkaw[q][j]);
              kkv[4 * q + j] = kraw * pkkw[q][j]; ss += kkv[4 * q + j] * kkv[4 * q + j]; bo += r4[j] * kp[4 * q + j] * prk[q][j]; } }
      ss = sum8(ss); bo = sum8(bo);
      const float rn = rsqrtf(fmaxf(ss, 1e-24f));
#pragma unroll
      for (int q = 0; q < 2; ++q) { f32x4 ko, ao, bq;
#pragma unroll
          for (int j = 0; j < 4; ++j) { const float kkn = kkv[4 * q + j] * rn; ko[j] = kp[4 * q + j]; ao[j] = -kkn; bq[j] = kkn * av[4 * q + j]; }
          *(LAS f32x4*)(pk + 4 * q) = ko; *(LAS f32x4*)(pa + 4 * q) = ao; *(LAS f32x4*)(pb + 4 * q) = bq; }
      if (p8 == 0) gBON[t] = bo; }
    else if (F.tid < 64) BON[F.tid] = gBON[F.tid];
    __syncthreads();
}
constexpr int RB_AT = 98304, RB_ATT = RB_AT + 9216, RB_BT = RB_ATT + 9216, RB_BTT = RB_BT + 9216, RB_KT = RB_BTT + 9216, RB_RT = RB_KT + 9216, RB_VT = RB_RT + 9216, RB_GC = RB_VT + 9216;
constexpr int RX_X = 0, RX_XT = 9216, RX_TB = 18432, RX_M = 27648, RX_NRT = 36864, RX_G1T = 46080, RX_G2T = 55296, RX_QT = 64512;
__device__ __forceinline__ void st_tile(LAS bf16_t* dst, int mt, int nt, const f32x4 v, int lane) {
    const int r = lane & 15, g = lane >> 4;
#pragma unroll
    for (int i = 0; i < 4; ++i) dst[(16 * mt + 4 * g + i) * RB_LD + 16 * nt + r] = f2bf(v[i]);
}
__device__ __forceinline__ void st_tile_t(LAS bf16_t* dst, int mt, int nt, const f32x4 v, int lane) {
    const int r = lane & 15, g = lane >> 4; u32x2 w; w.x = pk2(v[0], v[1]); w.y = pk2(v[2], v[3]);
    *(LAS u32x2*)(dst + (16 * nt + r) * RB_LD + 16 * mt + 4 * g) = w;
}
__device__ __forceinline__ void ld_fr(const LAS bf16_t* M, int row0, int lane, bf16x8 (&f)[2]) { const LAS bf16_t* p = M + (row0 + (lane & 15)) * RB_LD + 8 * (lane >> 4); f[0] = *(const LAS bf16x8*)p; f[1] = *(const LAS bf16x8*)(p + 32); }
__device__ __forceinline__ f32x4 mm_fr(const bf16x8 (&a)[2], const bf16x8 (&b)[2], f32x4 acc) { acc = __builtin_amdgcn_mfma_f32_16x16x32_bf16(a[0], b[0], acc, 0, 0, 0); return __builtin_amdgcn_mfma_f32_16x16x32_bf16(a[1], b[1], acc, 0, 0, 0); }
__device__ __forceinline__ void item_rwkv1(const Frame& F_, int layer, int item) { Frame F = relocal(F_);
    const int b = item >> 8, h = (item >> 6) & 3, c = item & 63;
    rwkv_prep<1>(F, layer, b, h, c);
    LAS float* Rr = (LAS float*)(F.lds + RW_R); LAS float* Kk = (LAS float*)(F.lds + RW_K); LAS float* Vv = (LAS float*)(F.lds + RW_V); LAS float* Ww = (LAS float*)(F.lds + RW_W);
    LAS float* Aa = (LAS float*)(F.lds + RW_A); LAS float* Bb = (LAS float*)(F.lds + RW_B);
    LAS bf16_t* At = (LAS bf16_t*)(F.lds + RB_AT); LAS bf16_t* AtT = (LAS bf16_t*)(F.lds + RB_ATT); LAS bf16_t* Bt = (LAS bf16_t*)(F.lds + RB_BT); LAS bf16_t* BtT = (LAS bf16_t*)(F.lds + RB_BTT);
    LAS bf16_t* Kt = (LAS bf16_t*)(F.lds + RB_KT); LAS bf16_t* Rt = (LAS bf16_t*)(F.lds + RB_RT); LAS bf16_t* VT = (LAS bf16_t*)(F.lds + RB_VT); LAS float* gC = (LAS float*)(F.lds + RB_GC);
    LAS bf16_t* X = (LAS bf16_t*)(F.lds + RX_X); LAS bf16_t* XT = (LAS bf16_t*)(F.lds + RX_XT); LAS bf16_t* Tb = (LAS bf16_t*)(F.lds + RX_TB); LAS bf16_t* Mm = (LAS bf16_t*)(F.lds + RX_M);
    LAS bf16_t* NrT = (LAS bf16_t*)(F.lds + RX_NRT); LAS bf16_t* G1T = (LAS bf16_t*)(F.lds + RX_G1T); LAS bf16_t* G2T = (LAS bf16_t*)(F.lds + RX_G2T); LAS bf16_t* QT = (LAS bf16_t*)(F.lds + RX_QT);
    { const int k = F.tid & 63, part = F.tid >> 6; float g = 1.0f;
      for (int pp = 0; pp < part; ++pp) { float w8[8];
#pragma unroll
          for (int i = 0; i < 8; ++i) w8[i] = Ww[(8 * pp + i) * 64 + k];
          g *= ((w8[0] * w8[1]) * (w8[2] * w8[3])) * ((w8[4] * w8[5]) * (w8[6] * w8[7])); }
#pragma unroll
      for (int i = 0; i < 8; ++i) { const int t = 8 * part + i; const float gp = g; g *= Ww[t * 64 + k]; const float ig = 1.0f / g;
          const bf16_t av = f2bf(Aa[t * 64 + k] * gp), bv = f2bf(Bb[t * 64 + k] * ig);
          At[t * RB_LD + k] = av; AtT[k * RB_LD + t] = av; Bt[t * RB_LD + k] = bv; BtT[k * RB_LD + t] = bv;
          Kt[t * RB_LD + k] = f2bf(Kk[t * 64 + k] * ig); Rt[t * RB_LD + k] = f2bf(Rr[t * 64 + k] * g); VT[k * RB_LD + t] = f2bf(Vv[t * 64 + k]); }
      if (part == 7) gC[k] = g; }
    __syncthreads();
    const int lane = F.lane, mt = F.wave >> 1, nt0 = 2 * (F.wave & 1), r = lane & 15, g4 = lane >> 4;
    const f32x4 zero4 = (f32x4){0.f, 0.f, 0.f, 0.f};
    f32x4 Tacc[2];
    bf16x8 fa0[2], fa1[2], fa2[2], fb0[2][2], fb1[2][2], fb2[2][2];
    ld_fr(Bt, 16 * mt, lane, fa0); ld_fr(Kt, 16 * mt, lane, fa1); ld_fr(Rt, 16 * mt, lane, fa2);
#pragma unroll
    for (int q = 0; q < 2; ++q) { ld_fr(At, 16 * (nt0 + q), lane, fb0[q]); ld_fr(Bt, 16 * (nt0 + q), lane, fb1[q]); }
#pragma unroll
    for (int q = 0; q < 2; ++q) { const int nt = nt0 + q;
        f32x4 n = mm_fr(fa0, fb0[q], zero4);
        f32x4 m = mm_fr(fa1, fb0[q], zero4);
        f32x4 nr = mm_fr(fa2, fb1[q], zero4);
#pragma unroll
        for (int i = 0; i < 4; ++i) { const int row = 16 * mt + 4 * g4 + i, col = 16 * nt + r;
            n[i] = (row < col) ? n[i] : 0.f; m[i] = (row < col) ? m[i] : 0.f; nr[i] = (col <= row) ? nr[i] : 0.f;
            Tacc[q][i] = n[i] + (row == col ? 1.0f : 0.f); }
        st_tile(X, mt, nt, n, lane); st_tile_t(XT, mt, nt, n, lane); st_tile(Tb, mt, nt, Tacc[q], lane); st_tile(Mm, mt, nt, m, lane); st_tile(NrT, mt, nt, nr, lane); }
    __syncthreads();
#pragma unroll 1
    for (int it = 0; it < 6; ++it) {
        LAS bf16_t* Xr = (it & 1) ? G1T : X; LAS bf16_t* XTr = (it & 1) ? G2T : XT; LAS bf16_t* Tr = (it & 1) ? QT : Tb;
        LAS bf16_t* Xw = (it & 1) ? X : G1T; LAS bf16_t* XTw = (it & 1) ? XT : G2T; LAS bf16_t* Tw = (it & 1) ? Tb : QT;
        ld_fr(Tr, 16 * mt, lane, fa0); ld_fr(Xr, 16 * mt, lane, fa1);
#pragma unroll
        for (int q = 0; q < 2; ++q) ld_fr(XTr, 16 * (nt0 + q), lane, fb0[q]);
#pragma unroll
        for (int q = 0; q < 2; ++q) { const int nt = nt0 + q;
            if (it > 0) Tacc[q] = mm_fr(fa0, fb0[q], Tacc[q]);
            if (it < 5) { const f32x4 x2 = mm_fr(fa1, fb0[q], zero4); st_tile(Xw, mt, nt, x2, lane); st_tile_t(XTw, mt, nt, x2, lane); }
            st_tile(Tw, mt, nt, Tacc[q], lane); }
        __syncthreads();
    }
    ld_fr(NrT, 16 * mt, lane, fa0); ld_fr(BtT, 16 * mt, lane, fa1);
#pragma unroll
    for (int q = 0; q < 2; ++q) ld_fr(Tb, 16 * (nt0 + q), lane, fb0[q]);
#pragma unroll
    for (int q = 0; q < 2; ++q) { const int nt = nt0 + q;
        st_tile(G1T, mt, nt, mm_fr(fa0, fb0[q], zero4), lane);
        st_tile(G2T, mt, nt, mm_fr(fa1, fb0[q], zero4), lane); }
    __syncthreads();
    const size_t ci = (size_t)(b * 4 + h) * 64 + c;
    bf16_t* gPT = (bf16_t*)(F.ws + WS_MOE + RW_PT) + ci * 4096; bf16_t* gW1 = (bf16_t*)(F.ws + WS_MOE + RW_W1) + ci * 4096; bf16_t* gZ = (bf16_t*)(F.ws + WS_MOE + RW_Z) + ci * 4096;
    ld_fr(G1T, 16 * mt, lane, fa0); ld_fr(Rt, 16 * mt, lane, fa1); ld_fr(G2T, 16 * mt, lane, fa2);
#pragma unroll
    for (int q = 0; q < 2; ++q) { ld_fr(AtT, 16 * (nt0 + q), lane, fb0[q]); ld_fr(Mm, 16 * (nt0 + q), lane, fb1[q]); ld_fr(Kt, 16 * (nt0 + q), lane, fb2[q]); }
#pragma unroll
    for (int q = 0; q < 2; ++q) { const int nt = nt0 + q; const int col = 16 * nt + r;
        f32x4 w1 = mm_fr(fa0, fb0[q], zero4);
        f32x4 z = mm_fr(fa0, fb1[q], zero4);
        f32x4 mr = mm_fr(fa1, fb2[q], zero4);
        f32x4 p = mm_fr(fa2, fb0[q], zero4);
        f32x4 qq = mm_fr(fa2, fb1[q], zero4);
        const int pos = 32 * (col >> 5) + 8 * ((col >> 2) & 3) + 4 * ((col >> 4) & 1) + (col & 3);
#pragma unroll
        for (int i = 0; i < 4; ++i) { const int row = 16 * mt + 4 * g4 + i;
            gW1[row * 64 + col] = f2bf(w1[i] + bf2f(Rt[row * RB_LD + col]));
            gZ[row * 64 + col] = f2bf(z[i] + (col <= row ? mr[i] : 0.f));
            const float gc = gC[row];
            gPT[row * 64 + pos] = f2bf((p[i] + (row == col ? 1.0f : 0.f)) * gc);
            qq[i] = (qq[i] + bf2f(Kt[col * RB_LD + row])) * gc; }
        st_tile(QT, mt, nt, qq, lane); }
    __syncthreads();
    bf16_t* gU = (bf16_t*)(F.ws + WS_MOE + RW_U) + ci * 4096;
    ld_fr(VT, 16 * mt, lane, fa0);
#pragma unroll
    for (int q = 0; q < 2; ++q) ld_fr(QT, 16 * (nt0 + q), lane, fb0[q]);
#pragma unroll
    for (int q = 0; q < 2; ++q) { const int nt = nt0 + q;
        const f32x4 u = mm_fr(fa0, fb0[q], zero4);
#pragma unroll
        for (int i = 0; i < 4; ++i) gU[(16 * mt + 4 * g4 + i) * 64 + 16 * nt + r] = f2bf(u[i]); }
}
__device__ __forceinline__ void item_rwkv_carry(const Frame& F_, int item) { Frame F = relocal(F_);
    const int bh = item * 2 + (F.wave >> 2), nt = F.wave & 3, r = F.lane & 15, g = F.lane >> 4;
    const bf16_t* PT = (const bf16_t*)(F.ws + WS_MOE + RW_PT); const bf16_t* Uc = (const bf16_t*)(F.ws + WS_MOE + RW_U); bf16_t* Ss = (bf16_t*)(F.ws + WS_MOE + RW_S);
    f32x4 acc[4];
#pragma unroll
    for (int m = 0; m < 4; ++m) acc[m] = (f32x4){0.f, 0.f, 0.f, 0.f};
    for (int c = 0; c < 64; ++c) { const size_t ci = (size_t)bh * 64 + c;
        bf16x8 af[4][2]; f32x4 cin[4];
#pragma unroll
        for (int m = 0; m < 4; ++m) { const u32x2 uv = *(const u32x2*)(Uc + ci * 4096 + (16 * nt + r) * 64 + 16 * m + 4 * g);
            cin[m] = (f32x4){__uint_as_float(uv.x << 16), __uint_as_float(uv.x & 0xffff0000u), __uint_as_float(uv.y << 16), __uint_as_float(uv.y & 0xffff0000u)};
#pragma unroll
            for (int s = 0; s < 2; ++s) af[m][s] = *(const bf16x8*)(PT + ci * 4096 + (16 * m + r) * 64 + 32 * s + 8 * g); }
        unsigned pw[4][2];
#pragma unroll
        for (int m = 0; m < 4; ++m) { pw[m][0] = pk2(acc[m][0], acc[m][1]); pw[m][1] = pk2(acc[m][2], acc[m][3]);
            *(u32x2*)(Ss + ci * 4096 + (16 * nt + r) * 64 + 16 * m + 4 * g) = (u32x2){pw[m][0], pw[m][1]}; }
        bf16x8 bfr[2];
#pragma unroll
        for (int s = 0; s < 2; ++s) bfr[s] = __builtin_bit_cast(bf16x8, (u32x4){pw[2 * s][0], pw[2 * s][1], pw[2 * s + 1][0], pw[2 * s + 1][1]});
#pragma unroll
        for (int m = 0; m < 4; ++m) { acc[m] = __builtin_amdgcn_mfma_f32_16x16x32_bf16(af[m][0], bfr[0], cin[m], 0, 0, 0);
            acc[m] = __builtin_amdgcn_mfma_f32_16x16x32_bf16(af[m][1], bfr[1], acc[m], 0, 0, 0); }
    }
}
__device__ __forceinline__ void item_rwkv3(const Frame& F_, int layer, int item) { Frame F = relocal(F_);
    const int b = item >> 8, h = (item >> 6) & 3, c = item & 63; const size_t T0 = (size_t)b * SEQ + c * 64;
    const size_t ci3 = (size_t)(b * 4 + h) * 64 + c;
    const u32x4 tS = *(const u32x4*)((const bf16_t*)(F.ws + WS_MOE + RW_S) + ci3 * 4096 + F.tid * 8);
    const u32x4 tW = *(const u32x4*)((const bf16_t*)(F.ws + WS_MOE + RW_W1) + ci3 * 4096 + F.tid * 8);
    const u32x4 tZ = *(const u32x4*)((const bf16_t*)(F.ws + WS_MOE + RW_Z) + ci3 * 4096 + F.tid * 8);
    f32x4 lw4[2], lb4[2];
#pragma unroll
    for (int q = 0; q < 2; ++q) { lw4[q] = *(const f32x4*)(F.in[I_RLNW] + layer * 256 + h * 64 + 8 * (F.tid & 7) + 4 * q); lb4[q] = *(const f32x4*)(F.in[I_RLNB] + layer * 256 + h * 64 + 8 * (F.tid & 7) + 4 * q); }
    rwkv_prep<3>(F, layer, b, h, c);
    LAS float* Vv = (LAS float*)(F.lds + RW_V); LAS float* Oo = (LAS float*)(F.lds + R3_O);
    LAS float* Gg = (LAS float*)(F.lds + R3_G); LAS float* BON = (LAS float*)(F.lds + R3_BON);
    LAS bf16_t* S0b = (LAS bf16_t*)(F.lds + R3_TILES); LAS bf16_t* W1b = S0b + 4608; LAS bf16_t* Zb = W1b + 4608; LAS bf16_t* VTb = Zb + 4608;
    { const int row = F.tid >> 3, col = (F.tid & 7) * 8;
      *(LAS u32x4*)(S0b + row * RB_LD + col) = tS;
      *(LAS u32x4*)(W1b + row * RB_LD + col) = tW;
      *(LAS u32x4*)(Zb + row * RB_LD + col) = tZ;
      const int vv = F.tid & 63, part = F.tid >> 6;
#pragma unroll
      for (int i = 0; i < 8; ++i) { const int t = 8 * part + i; VTb[vv * RB_LD + t] = f2bf(Vv[t * 64 + vv]); } }
    __syncthreads();
    { const int lane = F.lane, mt = F.wave >> 1, nt0 = 2 * (F.wave & 1), r = lane & 15, g4 = lane >> 4;
      bf16x8 fa0[2], fa1[2], fb0[2][2], fb1[2][2];
      ld_fr(W1b, 16 * mt, lane, fa0); ld_fr(Zb, 16 * mt, lane, fa1);
#pragma unroll
      for (int q = 0; q < 2; ++q) { ld_fr(S0b, 16 * (nt0 + q), lane, fb0[q]); ld_fr(VTb, 16 * (nt0 + q), lane, fb1[q]); }
#pragma unroll
      for (int q = 0; q < 2; ++q) { const int nt = nt0 + q;
          f32x4 o = mm_fr(fa0, fb0[q], (f32x4){0.f, 0.f, 0.f, 0.f});
          o = mm_fr(fa1, fb1[q], o);
#pragma unroll
          for (int i = 0; i < 4; ++i) Oo[(16 * mt + 4 * g4 + i) * 64 + 16 * nt + r] = o[i]; } }
    __syncthreads();
    { const int t = F.tid >> 3, p8 = F.tid & 7;
      float o[8]; float sm = 0.f;
#pragma unroll
      for (int q = 0; q < 2; ++q) { const f32x4 o4 = *(const LAS f32x4*)(Oo + t * 64 + 8 * p8 + 4 * q);
#pragma unroll
          for (int j = 0; j < 4; ++j) { o[4 * q + j] = o4[j]; sm += o4[j]; } }
      const float mean = sum8(sm) * (1.0f / 64.0f); float vs = 0.f;
#pragma unroll
      for (int j = 0; j < 8; ++j) { o[j] -= mean; vs += o[j] * o[j]; }
      const float rstd = rsqrtf(sum8(vs) * (1.0f / 64.0f) + 64e-5f); const float bon = BON[t];
      float y[8];
#pragma unroll
      for (int q = 0; q < 2; ++q) { const f32x4 v4 = *(const LAS f32x4*)(Vv + t * 64 + 8 * p8 + 4 * q), g4v = *(const LAS f32x4*)(Gg + t * 64 + 8 * p8 + 4 * q);
#pragma unroll
          for (int j = 0; j < 4; ++j) y[4 * q + j] = (o[4 * q + j] * rstd * lw4[q][j] + lb4[q][j] + bon * v4[j]) * g4v[j]; }
      *(u32x4*)((bf16_t*)(F.ws + WS_H) + (T0 + t) * DM + 256 + h * 64 + 8 * p8) = (u32x4){pk2(y[0], y[1]), pk2(y[2], y[3]), pk2(y[4], y[5]), pk2(y[6], y[7])}; }
}

constexpr int DS_SEL = 131072, DS_HIST = 135168, DS_BKT = 151552, DS_BIAS = 152064;
__device__ __forceinline__ void dsa_tables(const Frame& F_) { Frame F = relocal(F_);
    LAS int* bkt = (LAS int*)(F.lds + DS_BKT); LAS float* biasT = (LAS float*)(F.lds + DS_BIAS);
    if (F.tid < 128) { const int n = F.tid; int bk = n; if (n >= 16) { const float lr = logf((float)n / 16.0f) / 2.0794415416798357f; bk = 16 + (int)(lr * 16.0f); bk = bk < 31 ? bk : 31; } bkt[n] = bk; biasT[n] = F.in[I_RELB][n]; }
    __syncthreads();
}
__device__ __forceinline__ unsigned fkey(float f) { const unsigned u = __float_as_uint(f); return (u & 0x80000000u) ? ~u : (u | 0x80000000u); }
__device__ __forceinline__ void item_dsa(const Frame& F_, int layer, int item) { Frame F = relocal(F_);
    const bf16_t* U = (const bf16_t*)(F.ws + WS_U); const bf16_t* KI = (const bf16_t*)(F.ws + WS_KIDX);
    const bf16_t* Kb = (const bf16_t*)(F.ws + WS_K); const bf16_t* Vb = (const bf16_t*)(F.ws + WS_V);
    const int b = item & 3, qg = 511 - (item >> 2); const size_t TB = (size_t)b * SEQ, T0 = TB + qg * 8;
    LAS float* sc = (LAS float*)F.lds; LAS unsigned short* selall = (LAS unsigned short*)(F.lds + DS_SEL); LAS unsigned* histall = (LAS unsigned*)(F.lds + DS_HIST);
    LAS int* bkt = (LAS int*)(F.lds + DS_BKT); LAS float* biasT = (LAS float*)(F.lds + DS_BIAS);
    const int lane = F.lane, hh = lane >> 5;
    {
        bf16x8 af[2][2]; float wq[2][2][8];
        { const int r = lane & 31, q4 = 2 * ((r >> 2) & 1) + (r >> 4), head = 4 * ((r >> 3) & 1) + (r & 3);
#pragma unroll
          for (int mt = 0; mt < 2; ++mt)
#pragma unroll
              for (int ks = 0; ks < 2; ++ks) af[mt][ks] = *(const bf16x8*)(U + (T0 + 4 * mt + q4) * NINP + UC + 384 + head * 32 + 16 * ks + 8 * hh); }
#pragma unroll
        for (int mt = 0; mt < 2; ++mt)
#pragma unroll
            for (int q2 = 0; q2 < 2; ++q2) { float f[8]; unpack8(*(const u32x4*)(U + (T0 + 4 * mt + 2 * hh + q2) * NINP + UC + 672), f);
#pragma unroll
                for (int hd = 0; hd < 8; ++hd) wq[mt][q2][hd] = f[hd]; }
        const int ntile = (qg * 8 + 8 + 31) >> 5;
        bf16x8 nb0 = af[0][0], nb1 = af[0][0];
        if (F.wave < ntile) { const int key = F.wave * 32 + (lane & 31); nb0 = *(const bf16x8*)(KI + (TB + key) * 32 + 8 * hh); nb1 = *(const bf16x8*)(KI + (TB + key) * 32 + 16 + 8 * hh); }
        for (int kt = F.wave; kt < ntile; kt += 8) {
            const int key = kt * 32 + (lane & 31);
            const bf16x8 b0 = nb0, b1 = nb1;
            if (kt + 8 < ntile) { const int k2 = key + 256; nb0 = *(const bf16x8*)(KI + (TB + k2) * 32 + 8 * hh); nb1 = *(const bf16x8*)(KI + (TB + k2) * 32 + 16 + 8 * hh); }
#pragma unroll
            for (int mt = 0; mt < 2; ++mt) { f32x16 acc;
#pragma unroll
                for (int i = 0; i < 16; ++i) acc[i] = 0.f;
                acc = __builtin_amdgcn_mfma_f32_32x32x16_bf16(af[mt][0], b0, acc, 0, 0, 0);
                acc = __builtin_amdgcn_mfma_f32_32x32x16_bf16(af[mt][1], b1, acc, 0, 0, 0);
#pragma unroll
                for (int q2 = 0; q2 < 2; ++q2) { float s = 0.f;
#pragma unroll
                    for (int hd = 0; hd < 8; ++hd) s += fmaxf(acc[8 * q2 + hd], 0.f) * wq[mt][q2][hd];
                    const int qi = 4 * mt + 2 * hh + q2;
                    sc[qi * 4096 + key] = (key <= qg * 8 + qi) ? s : -INFINITY; } }
        }
    }
    __syncthreads();
    const int qi = F.wave, tq = qg * 8 + qi, n = tq + 1;
    LAS float* scq = sc + qi * 4096; LAS unsigned short* sel = selall + qi * 256; LAS unsigned* hist = histall + qi * 512;
    int nsel;
    if (n <= 256) { nsel = n; for (int j = lane; j < 256; j += 64) sel[j] = (unsigned short)(j < n ? j : 0); }
    else {
        nsel = 256;
        const int R = (n + 63) >> 6; const unsigned long long ltm = (1ull << lane) - 1ull;
        float lo = INFINITY, hi = -INFINITY;
        const int R4 = (n + 255) >> 8;
#pragma unroll 4
        for (int i = 0; i < R4; ++i) { const int j0 = 256 * i + 4 * lane; const f32x4 v4 = *(const LAS f32x4*)(scq + j0);
#pragma unroll
            for (int q = 0; q < 4; ++q) { const bool valid = j0 + q < n; lo = fminf(lo, valid ? v4[q] : INFINITY); hi = fmaxf(hi, valid ? v4[q] : -INFINITY); } }
        lo = wave_min(lo); hi = wave_max(hi);
        bool slow = false;
        if (!(hi > lo)) { for (int j = lane; j < 256; j += 64) sel[j] = (unsigned short)j; }
        else {
            const float scale = 1023.0f / (hi - lo);
            *(LAS u32x4*)(hist + 8 * lane) = (u32x4){0u, 0u, 0u, 0u}; *(LAS u32x4*)(hist + 8 * lane + 4) = (u32x4){0u, 0u, 0u, 0u};
#pragma unroll 2
            for (int i = 0; i < R4; ++i) { const int j0 = 256 * i + 4 * lane; const f32x4 v4 = *(const LAS f32x4*)(scq + j0);
#pragma unroll
                for (int q = 0; q < 4; ++q) { if (j0 + q < n) { int bk = (int)((v4[q] - lo) * scale); bk = bk < 1023 ? bk : 1023;
                    atomicAdd((unsigned*)(hist + (bk >> 1)), (bk & 1) ? 65536u : 1u); } } }
            const u32x4 h0 = *(const LAS u32x4*)(hist + 8 * lane), h1 = *(const LAS u32x4*)(hist + 8 * lane + 4);
            unsigned cb[16];
            cb[0] = h0.x & 0xffffu; cb[1] = h0.x >> 16; cb[2] = h0.y & 0xffffu; cb[3] = h0.y >> 16; cb[4] = h0.z & 0xffffu; cb[5] = h0.z >> 16; cb[6] = h0.w & 0xffffu; cb[7] = h0.w >> 16;
            cb[8] = h1.x & 0xffffu; cb[9] = h1.x >> 16; cb[10] = h1.y & 0xffffu; cb[11] = h1.y >> 16; cb[12] = h1.z & 0xffffu; cb[13] = h1.z >> 16; cb[14] = h1.w & 0xffffu; cb[15] = h1.w >> 16;
            unsigned tot = 0u;
#pragma unroll
            for (int q = 0; q < 16; ++q) tot += cb[q];
            const unsigned pre = wave_prefix_u(tot); const unsigned incl = (unsigned)__builtin_amdgcn_readlane((int)pre, 63) - pre + tot;
            int fb = -1; unsigned fabove = 0u, fcnt = 0u; unsigned cum = incl - tot;
#pragma unroll
            for (int q = 15; q >= 0; --q) { if (fb < 0 && cum < 256u && 256u <= cum + cb[q]) { fb = 16 * lane + q; fabove = cum; fcnt = cb[q]; } cum += cb[q]; }
            const unsigned long long mf = __ballot(fb >= 0); const int src = (int)__ffsll((long long)mf) - 1;
            const int B = __builtin_amdgcn_readlane(fb, src); const int above = __builtin_amdgcn_readlane((int)fabove, src), cntB = __builtin_amdgcn_readlane((int)fcnt, src); const int need = 256 - above;
            if (cntB > 256) slow = true;
            else {
                LAS unsigned* cand = hist;
                int base_gt = 0, base_c = 0;
#pragma unroll 2
                for (int i = 0; i < R4; ++i) { const int j0 = 256 * i + 4 * lane; const f32x4 v4 = *(const LAS f32x4*)(scq + j0);
#pragma unroll
                    for (int q = 0; q < 4; ++q) { const int j = j0 + q; const bool valid = j < n; const float v = valid ? v4[q] : lo;
                        int bk = (int)((v - lo) * scale); bk = bk < 1023 ? bk : 1023;
                        const bool gt = valid && bk > B, eq = valid && bk == B;
                        const unsigned long long mg = __ballot(gt), me = __ballot(eq);
                        if (gt) sel[base_gt + __popcll(mg & ltm)] = (unsigned short)j;
                        if (eq) { const int p = base_c + __popcll(me & ltm); cand[2 * p] = fkey(v); cand[2 * p + 1] = (unsigned)j; }
                        base_gt += __popcll(mg); base_c += __popcll(me); } }
                if (need == cntB) { for (int c = lane; c < cntB; c += 64) sel[above + c] = (unsigned short)cand[2 * c + 1]; }
                else {
                    unsigned ck[4], cx[4]; int rk[4];
#pragma unroll
                    for (int q = 0; q < 4; ++q) { const int c = lane + 64 * q; ck[q] = c < cntB ? cand[2 * c] : 0u; cx[q] = c < cntB ? cand[2 * c + 1] : 0u; rk[q] = 0; }
                    for (int c2 = 0; c2 < cntB; ++c2) { const unsigned k2 = cand[2 * c2], x2 = cand[2 * c2 + 1];
#pragma unroll
                        for (int q = 0; q < 4; ++q) rk[q] += (k2 > ck[q] || (k2 == ck[q] && x2 < cx[q])) ? 1 : 0; }
#pragma unroll
                    for (int q = 0; q < 4; ++q) { const int c = lane + 64 * q; if (c < cntB && rk[q] < need) sel[above + rk[q]] = (unsigned short)cand[2 * c + 1]; }
                }
            }
        }
        if (slow) {
        unsigned prefix = 0u; int need = 256; unsigned neq = 0u;
        for (int p = 0; p < 4; ++p) { const int shift = 24 - 8 * p;
            *(LAS u32x4*)(hist + 4 * lane) = (u32x4){0u, 0u, 0u, 0u};
            for (int i = 0; i < R; ++i) { const int j = lane + 64 * i; if (j < n) { const unsigned u = fkey(scq[j]);
                if (p == 0 || (u >> (shift + 8)) == prefix) atomicAdd((unsigned*)(hist + ((u >> shift) & 255u)), 1u); } }
            const u32x4 hv = *(const LAS u32x4*)(hist + 4 * lane);
            const unsigned tot = hv.x + hv.y + hv.z + hv.w;
            unsigned incl = tot;
#pragma unroll
            for (int o = 1; o < 64; o <<= 1) { const unsigned t = shdown_u(incl, o); if (lane + o < 64) incl += t; }
            const unsigned above = incl - tot;
            int fb = -1; unsigned fabove = 0u, feq = 0u; unsigned cum = above;
            { const unsigned hq[4] = {hv.x, hv.y, hv.z, hv.w};
#pragma unroll
              for (int q = 3; q >= 0; --q) { if (fb < 0 && cum < (unsigned)need && (unsigned)need <= cum + hq[q]) { fb = 4 * lane + q; fabove = cum; feq = hq[q]; } cum += hq[q]; } }
            const unsigned long long m = __ballot(fb >= 0);
            const int src = (int)__ffsll((long long)m) - 1;
            const int bin = shidx_i(fb, src); const unsigned ab = (unsigned)shidx_i((int)fabove, src); neq = (unsigned)shidx_i((int)feq, src);
            need -= (int)ab; prefix = (prefix << 8) | (unsigned)bin;
        }
        const int ngt = 256 - need;
        int base_gt = 0, base_eq = 0;
        for (int i = 0; i < R; ++i) { const int j = lane + 64 * i; const unsigned u = (j < n) ? fkey(scq[j]) : 0u;
            const bool gt = (j < n) && (u > prefix), eq = (j < n) && (u == prefix);
            const unsigned long long mg = __ballot(gt), me = __ballot(eq); const unsigned long long lt = (1ull << lane) - 1ull;
            if (gt) sel[base_gt + __popcll(mg & lt)] = (unsigned short)j;
            if (eq) { const int rk = base_eq + __popcll(me & lt); if (rk < need) sel[ngt + rk] = (unsigned short)j; }
            base_gt += __popcll(mg); base_eq += __popcll(me); }
        (void)neq;
            }
    }
    const int nt16 = (nsel + 15) >> 4, r16 = lane & 15, g4 = lane >> 4;
    LAS float* biasj = scq + 2048;
#pragma unroll
    for (int q = 0; q < 4; ++q) { const int j = lane + 64 * q; f32x4 bv = (f32x4){-INFINITY, -INFINITY, -INFINITY, -INFINITY};
        if (j < nsel) { const int dist = tq - (int)sel[j]; const int bk = dist < 128 ? bkt[dist < 0 ? 0 : dist] : 31; bv = *(const LAS f32x4*)(biasT + 4 * bk); }
        *(LAS f32x4*)(biasj + 4 * j) = bv; }
    bf16x8 qf[2];
#pragma unroll
    for (int s = 0; s < 2; ++s) { u32x4 z = (u32x4){0u, 0u, 0u, 0u}; if (r16 < 4) z = *(const u32x4*)(U + (T0 + qi) * NINP + UC + r16 * 64 + 32 * s + 8 * g4); qf[s] = __builtin_bit_cast(bf16x8, z); }
    float lg[16][4]; float mx = -INFINITY;
#define DSA_QK(M0, NM) do { int keyr[NM]; bf16x8 a0[NM], a1[NM]; \
        _Pragma("unroll") for (int m8 = 0; m8 < NM; ++m8) keyr[m8] = sel[16 * ((M0) + m8) + r16]; \
        _Pragma("unroll") for (int m8 = 0; m8 < NM; ++m8) { a0[m8] = *(const bf16x8*)(Kb + (TB + keyr[m8]) * 64 + 8 * g4); a1[m8] = *(const bf16x8*)(Kb + (TB + keyr[m8]) * 64 + 32 + 8 * g4); } \
        _Pragma("unroll") for (int m8 = 0; m8 < NM; ++m8) { const int m = (M0) + m8; \
            f32x4 acc = (f32x4){0.f, 0.f, 0.f, 0.f}; \
            acc = __builtin_amdgcn_mfma_f32_16x16x32_bf16(a0[m8], qf[0], acc, 0, 0, 0); \
            acc = __builtin_amdgcn_mfma_f32_16x16x32_bf16(a1[m8], qf[1], acc, 0, 0, 0); \
            _Pragma("unroll") for (int i = 0; i < 4; ++i) { const float v = acc[i] * 0.125f + biasj[(16 * m + 4 * g4 + i) * 4 + (r16 & 3)]; lg[m][i] = v; mx = fmaxf(mx, v); } } } while (0)
    if (nt16 > 8) { DSA_QK(0, 16); }
    else { DSA_QK(0, 8);
#pragma unroll
        for (int m8 = 8; m8 < 16; ++m8)
#pragma unroll
            for (int i = 0; i < 4; ++i) lg[m8][i] = -INFINITY; }
#undef DSA_QK
    mx = xrows(mx, OpMax());
    float sm = 0.f;
#pragma unroll
    for (int m = 0; m < 16; ++m)
#pragma unroll
        for (int i = 0; i < 4; ++i) { const float p = __expf(lg[m][i] - mx); lg[m][i] = p; sm += p; }
    sm = xrows(sm, OpAdd());
    f32x4 ov[4];
#pragma unroll
    for (int nt = 0; nt < 4; ++nt) ov[nt] = (f32x4){0.f, 0.f, 0.f, 0.f};
    const unsigned vs_base = (unsigned)(unsigned long)scq;
#pragma unroll
    for (int half = 0; half < 2; ++half) {
        if (half * 8 < nt16) {
            asm volatile("s_waitcnt lgkmcnt(0)" ::: "memory");
            int vkey[16];
#pragma unroll
            for (int q = 0; q < 16; ++q) { const int rho = 8 * q + (lane >> 3);
                vkey[q] = sel[half * 128 + (rho & ~31) + 16 * ((rho >> 2) & 1) + 4 * ((rho >> 3) & 3) + (rho & 3)]; }
            asm volatile("s_waitcnt lgkmcnt(0)" : "+v"(vkey[0]), "+v"(vkey[1]), "+v"(vkey[2]), "+v"(vkey[3]), "+v"(vkey[4]), "+v"(vkey[5]), "+v"(vkey[6]), "+v"(vkey[7]),
                         "+v"(vkey[8]), "+v"(vkey[9]), "+v"(vkey[10]), "+v"(vkey[11]), "+v"(vkey[12]), "+v"(vkey[13]), "+v"(vkey[14]), "+v"(vkey[15]) :: "memory");
#pragma unroll
            for (int q = 0; q < 16; ++q)
                __builtin_amdgcn_global_load_lds((const unsigned*)(Vb + (TB + vkey[q]) * 64 + 8 * (lane & 7)), (LAS unsigned*)((LAS unsigned char*)scq + q * 1024), 16, 0, 0);
            asm volatile("s_waitcnt vmcnt(0)" ::: "memory");
#pragma unroll
            for (int s4 = 0; s4 < 4; ++s4) { const int s = half * 4 + s4;
                u32x4 pw; pw.x = pk2(lg[2 * s][0], lg[2 * s][1]); pw.y = pk2(lg[2 * s][2], lg[2 * s][3]); pw.z = pk2(lg[2 * s + 1][0], lg[2 * s + 1][1]); pw.w = pk2(lg[2 * s + 1][2], lg[2 * s + 1][3]);
                const bf16x8 pa = __builtin_bit_cast(bf16x8, pw);
                const unsigned ad = vs_base + (unsigned)((32 * s4 + 8 * g4 + (r16 >> 2)) * 128 + (r16 & 3) * 8);
                u32x2 t0[4], t1[4];
                asm volatile("ds_read_b64_tr_b16 %0, %8\n\tds_read_b64_tr_b16 %1, %8 offset:512\n\tds_read_b64_tr_b16 %2, %8 offset:32\n\tds_read_b64_tr_b16 %3, %8 offset:544\n\t"
                             "ds_read_b64_tr_b16 %4, %8 offset:64\n\tds_read_b64_tr_b16 %5, %8 offset:576\n\tds_read_b64_tr_b16 %6, %8 offset:96\n\tds_read_b64_tr_b16 %7, %8 offset:608\n\ts_waitcnt lgkmcnt(0)"
                             : "=&v"(t0[0]), "=&v"(t1[0]), "=&v"(t0[1]), "=&v"(t1[1]), "=&v"(t0[2]), "=&v"(t1[2]), "=&v"(t0[3]), "=&v"(t1[3]) : "v"(ad) : "memory");
#pragma unroll
                for (int nt = 0; nt < 4; ++nt) { const bf16x8 vb = __builtin_bit_cast(bf16x8, (u32x4){t0[nt].x, t0[nt].y, t1[nt].x, t1[nt].y});
                    ov[nt] = __builtin_amdgcn_mfma_f32_16x16x32_bf16(pa, vb, ov[nt], 0, 0, 0); } }
        }
    }
    { float inv[4];
#pragma unroll
      for (int h = 0; h < 4; ++h) inv[h] = 1.0f / __int_as_float(__builtin_amdgcn_readlane(__float_as_int(sm), h));
      if (lane < 16) { bf16_t* Y = (bf16_t*)(F.ws + WS_H) + (T0 + qi) * DM + 512 + r16;
#pragma unroll
          for (int h = 0; h < 4; ++h)
#pragma unroll
              for (int nt = 0; nt < 4; ++nt) Y[h * 64 + 16 * nt] = f2bf(ov[nt][h] * inv[h]); } }
}

__device__ __forceinline__ void phase_router(const Frame& F_, int layer) { Frame F = relocal(F_); const int cset = layer;
    const float* X = (const float*)(F.ws + WS_X);
    const bf16_t* WH = (const bf16_t*)(F.ws + WS_WRT) + (size_t)layer * 2 * 49152; const bf16_t* WL = WH + 49152;
    LAS float* part = (LAS float*)F.lds;
    LAS float* ssq = (LAS float*)(F.lds + 24576);
    LAS int* es = (LAS int*)(F.lds + 25088);
    LAS int* lr = (LAS int*)(F.lds + 25600);
    LAS float* wsl = (LAS float*)(F.lds + 26112);
    LAS float* rsd = (LAS float*)(F.lds + 26624);
    for (int blk = F.bid; blk < NTOK / 64; blk += F.G) {
        __syncthreads();
        const int mt = F.wave & 3, kh = F.wave >> 2, r16 = F.lane & 15, g4 = F.lane >> 4;
        const float* xr = X + ((size_t)blk * 64 + mt * 16 + r16) * DM + kh * 512 + 8 * g4;
        f32x4 acc[3]; acc[0] = acc[1] = acc[2] = (f32x4){0.f, 0.f, 0.f, 0.f}; float ss = 0.f;
#pragma unroll 4
        for (int ks = 0; ks < 16; ++ks) {
            const f32x4 xa = *(const f32x4*)(xr + ks * 32), xb = *(const f32x4*)(xr + ks * 32 + 4);
            ss += xa[0] * xa[0] + xa[1] * xa[1] + xa[2] * xa[2] + xa[3] * xa[3] + xb[0] * xb[0] + xb[1] * xb[1] + xb[2] * xb[2] + xb[3] * xb[3];
            float xv[8] = {xa[0], xa[1], xa[2], xa[3], xb[0], xb[1], xb[2], xb[3]}; unsigned hw[4], lw[4];
#pragma unroll
            for (int j = 0; j < 4; ++j) { const bf16_t h0 = f2bf(xv[2 * j]), h1 = f2bf(xv[2 * j + 1]); hw[j] = (unsigned)h0 | ((unsigned)h1 << 16);
                lw[j] = pk2(xv[2 * j] - bf2f(h0), xv[2 * j + 1] - bf2f(h1)); }
            const bf16x8 ahi = __builtin_bit_cast(bf16x8, (u32x4){hw[0], hw[1], hw[2], hw[3]}), alo = __builtin_bit_cast(bf16x8, (u32x4){lw[0], lw[1], lw[2], lw[3]});
#pragma unroll
            for (int nt = 0; nt < 3; ++nt) { const size_t wo = (size_t)(nt * 16 + r16) * 1024 + kh * 512 + ks * 32 + 8 * g4;
                const bf16x8 bh = *(const bf16x8*)(WH + wo), bl = *(const bf16x8*)(WL + wo);
                acc[nt] = __builtin_amdgcn_mfma_f32_16x16x32_bf16(ahi, bh, acc[nt], 0, 0, 0);
                acc[nt] = __builtin_amdgcn_mfma_f32_16x16x32_bf16(ahi, bl, acc[nt], 0, 0, 0);
                acc[nt] = __builtin_amdgcn_mfma_f32_16x16x32_bf16(alo, bh, acc[nt], 0, 0, 0); }
        }
        ss = xrows(ss, OpAdd());
        if (g4 == 0) ssq[kh * 64 + mt * 16 + r16] = ss;
#pragma unroll
        for (int nt = 0; nt < 3; ++nt)
#pragma unroll
            for (int i = 0; i < 4; ++i) part[(kh * 64 + mt * 16 + 4 * g4 + i) * 48 + nt * 16 + r16] = acc[nt][i];
        __syncthreads();
        if (F.tid < 64) { const float rstd = rsqrtf((ssq[F.tid] + ssq[64 + F.tid]) * (1.0f / DM) + 1e-6f); rsd[F.tid] = rstd;
            float l[36];
#pragma unroll
            for (int o = 0; o < 36; ++o) l[o] = (part[F.tid * 48 + o] + part[(64 + F.tid) * 48 + o]) * rstd + (o < 32 ? F.in[I_BRE][layer * 32 + o] : F.in[I_BRG][layer * 4 + o - 32]);
            int gs = 0; float gm = l[32];
#pragma unroll
            for (int j = 1; j < 4; ++j) if (l[32 + j] > gm) { gm = l[32 + j]; gs = j; }
            float den = 0.f;
#pragma unroll
            for (int j = 0; j < 4; ++j) den += __expf(l[32 + j] - gm);
            const float gate = 1.0f / den;
            float e8[8];
#pragma unroll
            for (int j = 0; j < 8; ++j) e8[j] = gs == 0 ? l[j] : gs == 1 ? l[8 + j] : gs == 2 ? l[16 + j] : l[24 + j];
            int i1 = 0; float v1 = e8[0];
#pragma unroll
            for (int j = 1; j < 8; ++j) if (e8[j] > v1) { v1 = e8[j]; i1 = j; }
            int i2 = -1; float v2 = -INFINITY;
#pragma unroll
            for (int j = 0; j < 8; ++j) if (j != i1 && e8[j] > v2) { v2 = e8[j]; i2 = j; }
            const float e2 = __expf(v2 - v1); const float p1 = 1.0f / (1.0f + e2);
            es[F.tid * 2] = gs * 8 + i1; es[F.tid * 2 + 1] = gs * 8 + i2; wsl[F.tid * 2] = p1 * gate; wsl[F.tid * 2 + 1] = (1.0f - p1) * gate; }
        __syncthreads();
        if (F.tid < 32) { int cnt = 0; for (int i = 0; i < 128; ++i) if (es[i] == F.tid) lr[i] = cnt++;
            if (cnt) { const int base = (int)__hip_atomic_fetch_add(F.ctl + CW_CNT + cset * 32 + F.tid, (unsigned)cnt, __ATOMIC_RELAXED, __HIP_MEMORY_SCOPE_AGENT);
                for (int i = 0; i < 128; ++i) if (es[i] == F.tid) lr[i] += base; } }
        __syncthreads();
        if (F.tid < 64) { int* rt = (int*)(F.ws + WS_ROUTE) + ((size_t)blk * 64 + F.tid) * 8;
            rt[0] = es[F.tid * 2]; rt[1] = es[F.tid * 2 + 1]; ((float*)rt)[2] = wsl[F.tid * 2]; ((float*)rt)[3] = wsl[F.tid * 2 + 1]; rt[4] = lr[F.tid * 2]; rt[5] = lr[F.tid * 2 + 1]; ((float*)rt)[6] = rsd[F.tid]; }
    }
    __syncthreads();
    if (F.tid == 0) __hip_atomic_fetch_add(F.ctl + CW_RB + 64 * layer, 1u, __ATOMIC_RELAXED, __HIP_MEMORY_SCOPE_AGENT);
}
__device__ __forceinline__ void phase_moe_convert(const Frame& F_, int layer) { Frame F = relocal(F_);
    bf16_t* WGU = (bf16_t*)(F.ws + WS_MOE + MOE_WGU);
    for (int t = F.bid; t < 1024; t += F.G) {
        const int e = t >> 5, r = t & 31, kt = r >> 1, nt = r & 1; const size_t eo = ((size_t)layer * 32 + e) * 1024 * 256;
        tr_tile(F, 256, WGU + (size_t)e * 512 * 1024, 1024, kt * 64, nt * 256, SmGU{F.in[I_WGATE] + eo, F.in[I_WUP] + eo}); }
}
__device__ __forceinline__ void phase_moe_convert_down(const Frame& F_, int layer) { Frame F = relocal(F_);
    bf16_t* WD = (bf16_t*)(F.ws + WS_MOE + MOE_WD);
    for (;;) { const int q = q_pop(F, 32 + layer); if (q >= 512) break;
        const int e = q >> 4, r = q & 15, kt = r >> 2, nt = r & 3;
        tr_tile(F, 1024, WD + (size_t)e * 1024 * 256, 256, kt * 64, nt * 256, SmId{F.in[I_WDOWN] + ((size_t)layer * 32 + e) * 256 * 1024}); }
}
__device__ __forceinline__ void phase_gather(const Frame& F_, int layer) { Frame F = relocal(F_);
    LAS int* off = (LAS int*)F.lds;
    __syncthreads();
    if (F.tid == 0) { unsigned sp = 0;
        while (__hip_atomic_load(F.ctl + CW_RB + 64 * layer, __ATOMIC_RELAXED, __HIP_MEMORY_SCOPE_AGENT) < (unsigned)F.G) { __builtin_amdgcn_s_sleep(2); if (++sp > (1u << 22)) break; } }
    __syncthreads();
    if (F.tid == 0) { int acc = 0; for (int e = 0; e < 32; ++e) { off[e] = acc; const int c = (int)__hip_atomic_load(F.ctl + CW_CNT + layer * 32 + e, __ATOMIC_RELAXED, __HIP_MEMORY_SCOPE_AGENT); acc += (c + 255) & ~255; } off[32] = acc; }
    __syncthreads();
    int* tiles = (int*)(F.ws + WS_TILES); int* row_tok = (int*)(F.ws + WS_ROWS); float* row_w = (float*)(F.ws + WS_ROWS) + MAXROWS;
    if (F.bid == 0) { if (F.tid == 0) tiles[0] = off[32] >> 8; if (F.tid < 33) tiles[1 + F.tid] = off[F.tid];
        if (F.tid < 32) for (int rt = off[F.tid] >> 8; rt < (off[F.tid + 1] >> 8); ++rt) tiles[64 + rt] = F.tid; }
    for (int e = F.bid; e < 32; e += F.G) { const int c = (int)__hip_atomic_load(F.ctl + CW_CNT + layer * 32 + e, __ATOMIC_RELAXED, __HIP_MEMORY_SCOPE_AGENT);
        for (int r = off[e] + c + F.tid; r < off[e + 1]; r += NTHR) { row_tok[r] = -1; row_w[r] = 0.f; } }
    const float* X = (const float*)(F.ws + WS_X); bf16_t* HP = (bf16_t*)(F.ws + WS_U); const float* nw = F.in[I_NORM2] + (size_t)layer * DM;
    f32x4 nwv[4];
#pragma unroll
    for (int j = 0; j < 4; ++j) nwv[j] = *(const f32x4*)(nw + 4 * F.lane + 256 * j);
    for (int blk = F.bid; blk < NTOK / 64; blk += F.G)
    for (int i4 = 0; i4 < 2; ++i4) {
        int p0[4], p1[4], tt[4]; float rstd[4], w0[4], w1[4]; f32x4 xv[4][4];
#pragma unroll
        for (int r = 0; r < 4; ++r) { const int t = blk * 64 + F.wave * 8 + 4 * i4 + r; tt[r] = t;
            const int* rt = (const int*)(F.ws + WS_ROUTE) + (size_t)t * 8; rstd[r] = ((const float*)rt)[6]; w0[r] = ((const float*)rt)[2]; w1[r] = ((const float*)rt)[3];
            p0[r] = off[rt[0]] + rt[4]; p1[r] = off[rt[1]] + rt[5];
#pragma unroll
            for (int j = 0; j < 4; ++j) xv[r][j] = *(const f32x4*)(X + (size_t)t * DM + 4 * F.lane + 256 * j); }
#pragma unroll
        for (int r = 0; r < 4; ++r) {
#pragma unroll
            for (int j = 0; j < 4; ++j) { const int c = 4 * F.lane + 256 * j; const f32x4 v = xv[r][j] * rstd[r] * nwv[j];
                u32x2 o; o.x = pk2(v[0], v[1]); o.y = pk2(v[2], v[3]);
                *(u32x2*)(HP + (size_t)tt[r] * DM + c) = o; }
            if (F.lane == 0) { row_tok[p0[r]] = tt[r] * 2; row_w[p0[r]] = w0[r]; row_tok[p1[r]] = tt[r] * 2 + 1; row_w[p1[r]] = w1[r]; } }
    }
}

constexpr int NPH_LAYER = 9, NPHASE = 1 + 2 * NPH_LAYER + 1;
#ifndef MK_ONLY
#define MK_ONLY -1
#endif
#ifndef MK_ITEM
#define MK_ITEM -1
#endif
#define EN(o) (MK_ONLY < 0 || MK_ONLY == (o))
#define IT(o) (MK_ITEM < 0 || MK_ITEM == (o))
__global__ void __launch_bounds__(NTHR, 2) mk_forward(Params P) {
    extern __shared__ __attribute__((aligned(16))) unsigned char lds_raw[];
    Frame F; F.lds = (LAS unsigned char*)lds_raw; F.tid = threadIdx.x; F.lane = F.tid & 63; F.wave = __builtin_amdgcn_readfirstlane(F.tid >> 6); F.bid = blockIdx.x; F.G = gridDim.x;
    F.in = (in_tab_t)__builtin_amdgcn_kernarg_segment_ptr(); F.out = P.out; F.ws = P.ws; F.ctl = (unsigned*)(P.ws + WS_CTL); F.misc = (volatile LAS int*)(F.lds + MISC_OFF);
    if (F.tid < 64) ((LAS unsigned*)(F.lds + MISC_OFF))[F.tid] = 0u;
    __syncthreads();
    const int lo = P.ph_lo, hi = P.ph_hi;
    XcdBarrier bar; bar.bar = F.ctl + CW_BAR; bar.x = 0; bar.st = (volatile LAS unsigned*)(F.lds + MISC_OFF + 16);
    if (hi - lo > 1) bar = xcd_barrier_post(F.ctl + CW_BAR, (volatile LAS unsigned*)(F.lds + MISC_OFF + 16));
#define IN(k) (lo <= (k) && (k) < hi)
#define SEAM(k) do { if (IN(k) && IN((k) + 1)) xcd_barrier(bar); } while (0)
#define QLOOP(qi, n, body) for (;;) { const int it = q_pop(F, layer * 12 + (qi)); if (it >= (n)) break; body; }
    if (EN(100) && IN(0)) { phase_prologue(F); phase_norm(F, F.in[I_X], false, F.in[I_NORM1], 3); } SEAM(0);
#pragma unroll
    for (int layer = 0; layer < DEPTH; ++layer) {
        const int pb = 1 + layer * NPH_LAYER;
        if (layer > 0) { if (EN(0) && IN(pb + 0)) { phase_norm(F, (const float*)(F.ws + WS_X), true, F.in[I_NORM1] + (size_t)layer * DM, 0); } SEAM(pb + 0); }
        if (EN(1) && IN(pb + 1)) { const Frame F_ = F; Frame F = relocal(F_); pg8::StaticOrder S; S.init((const bf16_t*)(F.ws + WS_H), (const bf16_t*)(F.ws + WS_WIN) + (size_t)layer * NINP * DM, NTOK, NINP, DM, F.G, F.bid);
            pg8::EpiBf16 E{(bf16_t*)(F.ws + WS_U), NINP}; pg8::gemm_phase(F.lds, DM, S, E); } SEAM(pb + 1);
#define SLOOP(n, body) for (int it = F.bid; it < (n); it += F.G) { __syncthreads(); body; }
        if (EN(2) && IN(pb + 2)) {
            if (IT(1)) SLOOP(1024, item_rwkv1(F, layer, it));
            if (IT(0)) SLOOP(256, item_s5<1>(F, layer, it));
            if (IT(2)) SLOOP(256, item_mamba<1>(F, layer, it));
            if (IT(3)) SLOOP(256, item_kv(F, layer, it));
        } SEAM(pb + 2);
        if (EN(3) && IN(pb + 3)) {
            if (IT(0)) SLOOP(8, item_rwkv_carry(F, it));
            if (IT(1)) { for (int it = F.bid - 8; it >= 0 && it < 16; it += F.G) { __syncthreads(); item_mamba_carry(F, it); } }
            if (IT(2)) { for (int it = F.bid - 24; it >= 0 && it < 4; it += F.G) { __syncthreads(); item_s5_carry(F, layer, it); } }
            if (IT(3)) {
                dsa_tables(F);
                const int pref = (int)(xb_xcc_id() & 3u);
#pragma unroll 1
                for (int k4 = 0; k4 < 4; ++k4) { const int bq = (pref + k4) & 3;
                    for (;;) { const int it = q_pop(F, 24 + layer * 4 + bq); if (it >= 512) break; item_dsa(F, layer, it * 4 + bq); } } }
        } SEAM(pb + 3);
        if (EN(4) && IN(pb + 4)) {
            if (IT(0)) SLOOP(256, item_s5<2>(F, layer, it));
            if (IT(2)) SLOOP(256, item_mamba<2>(F, layer, it));
            if (IT(1)) SLOOP(1024, item_rwkv3(F, layer, it));
        } SEAM(pb + 4);
        if (EN(6) && IN(pb + 5)) { const Frame F_ = F; Frame F = relocal(F_); pg8::StaticOrder S; S.init((const bf16_t*)(F.ws + WS_H), (const bf16_t*)(F.ws + WS_WOUT) + (size_t)layer * DM * DM, NTOK, DM, DM, F.G, F.bid);
            pg8::EpiResid E{layer == 0 ? F.in[I_X] : (const float*)(F.ws + WS_X), (float*)(F.ws + WS_X), DM}; pg8::gemm_phase(F.lds, DM, S, E); } SEAM(pb + 5);
        if (EN(7) && IN(pb + 6)) { phase_router(F, layer); phase_moe_convert(F, layer); phase_gather(F, layer); } SEAM(pb + 6);
        if (EN(8) && IN(pb + 7)) { const Frame F_ = F; Frame F = relocal(F_); LAS int* ul = (LAS int*)(F.lds + pg8::STAGE_BYTES + 8192); if (F.tid == 0) pg8::MoeOrder::build(ul, (const int*)(F.ws + WS_TILES), 2, F.G, F.bid); __syncthreads();
            pg8::MoeOrder S{DM, (const char*)(F.ws + WS_U), (const char*)(F.ws + WS_MOE + MOE_WGU), (size_t)512 * 1024 * 2, ul};
            pg8::EpiGated<1> E{(bf16_t*)(F.ws + WS_H), 256, 0, nullptr, nullptr}; pg8::gemm_phase<pg8::EpiGated<1>, pg8::MoeOrder, true>(F.lds, DM, S, E, (const char*)(F.ws + WS_U), (const int*)(F.ws + WS_ROWS)); phase_moe_convert_down(F, layer); } SEAM(pb + 7);
        if (EN(9) && IN(pb + 8)) { const Frame F_ = F; Frame F = relocal(F_); LAS int* ul = (LAS int*)(F.lds + pg8::STAGE_BYTES + 8192); if (F.tid == 0) pg8::MoeOrder::build(ul, (const int*)(F.ws + WS_TILES), 4, F.G, F.bid); __syncthreads();
            pg8::MoeOrder S{256, (const char*)(F.ws + WS_H), (const char*)(F.ws + WS_MOE + MOE_WD), (size_t)1024 * 256 * 2, ul};
            pg8::EpiMoeOut E{(bf16_t*)(F.ws + WS_U), (const int*)(F.ws + WS_ROWS), (const float*)(F.ws + WS_ROWS) + MAXROWS, F.lds}; pg8::gemm_phase(F.lds, 256, S, E); } SEAM(pb + 8);
    }
    if (EN(101) && IN(NPHASE - 1)) { phase_norm(F, (const float*)(F.ws + WS_X), true, F.in[I_FNORM], 2); }
#undef IN
#undef SEAM
}

#ifndef MK_SPLIT
#define MK_SPLIT 0
#endif
extern "C" void kernel_launch(void* const* d_in, const int* in_sizes, int n_in, void* d_out, int out_size, void* d_ws, size_t ws_size, hipStream_t stream) {
    static int grid = 0;
    if (grid == 0) {
        if (n_in != 44 || out_size != NTOK * DM || ws_size < WS_END) { fprintf(stderr, "kernel_launch: unexpected shapes (n_in %d out %d ws %zu need %zu)\n", n_in, out_size, ws_size, (size_t)WS_END); grid = -1; return; }
        int dev = 0, cus = 0;
        if (hipGetDevice(&dev) != hipSuccess || hipDeviceGetAttribute(&cus, hipDeviceAttributeMultiprocessorCount, dev) != hipSuccess) { grid = -1; return; }
        if (hipFuncSetAttribute((const void*)mk_forward, hipFuncAttributeMaxDynamicSharedMemorySize, LDS_BYTES) != hipSuccess) { fprintf(stderr, "kernel_launch: hipFuncSetAttribute failed\n"); grid = -1; return; }
        int per_cu = 0;
        if (hipOccupancyMaxActiveBlocksPerMultiprocessor(&per_cu, (const void*)mk_forward, NTHR, LDS_BYTES) != hipSuccess || per_cu < 1) { fprintf(stderr, "kernel_launch: occupancy query says %d\n", per_cu); }
        (void)hipGetLastError();
        grid = cus;
    }
    if (grid < 0) return;
    hipMemsetAsync((char*)d_ws + WS_CTL, 0, CTL_BYTES, stream);
    Params p{};
    for (int i = 0; i < 44; ++i) p.in[i] = (const float*)d_in[i];
    p.out = (float*)d_out; p.ws = (unsigned char*)d_ws;
#if MK_SPLIT
    for (int ph = 0; ph < NPHASE; ++ph) { p.ph_lo = ph; p.ph_hi = ph + 1; hipLaunchKernelGGL(mk_forward, dim3(grid), dim3(NTHR), LDS_BYTES, stream, p); }
#else
    p.ph_lo = 0; p.ph_hi = NPHASE; hipLaunchKernelGGL(mk_forward, dim3(grid), dim3(NTHR), LDS_BYTES, stream, p);
#endif
}
```

```cpp
#include <hip/hip_runtime.h>
#include <stdint.h>
#include <stdio.h>

#define LAS __attribute__((address_space(3)))
typedef unsigned short bf16_t;
typedef short bf16x8 __attribute__((ext_vector_type(8)));
typedef float f32x4 __attribute__((ext_vector_type(4)));
typedef float f32x2 __attribute__((ext_vector_type(2)));
typedef float f32x16 __attribute__((ext_vector_type(16)));
typedef unsigned u32x4 __attribute__((ext_vector_type(4)));
typedef unsigned u32x2 __attribute__((ext_vector_type(2)));

constexpr int NTOK = 16384, DM = 1024, SEQ = 4096, NBATCH = 4, DEPTH = 2;
constexpr int NIN = 2604, NINP = 2816;
constexpr int UM = 0;
constexpr int UR = 784;
constexpr int UC = 1680;
constexpr int US = 2368;
constexpr int NTHR = 512;
constexpr int LDS_BYTES = 163840;
constexpr int MISC_OFF = LDS_BYTES - 256;

constexpr size_t WS_CTL   = 0;
constexpr size_t CTL_BYTES = 65536;
constexpr size_t WS_X     = WS_CTL + CTL_BYTES;
constexpr size_t WS_H     = WS_X + (size_t)NTOK * DM * 4;
constexpr size_t WS_U     = WS_H + (size_t)NTOK * DM * 2;
constexpr size_t WS_WIN   = WS_U + (size_t)NTOK * NINP * 2;
constexpr size_t WS_WOUT  = WS_WIN + (size_t)2 * NINP * DM * 2;
constexpr size_t WS_GLU   = WS_WOUT + (size_t)2 * DM * DM * 2;
constexpr size_t WS_MOE   = WS_GLU + (size_t)2 * 512 * 256 * 2;
constexpr size_t MOE_WGU  = 0;
constexpr size_t MOE_WD   = (size_t)32 * 512 * 1024 * 2;
constexpr size_t MOE_BYTES = MOE_WD + (size_t)32 * 1024 * 256 * 2;
constexpr size_t RW_PT    = 0;
constexpr size_t RW_U     = (size_t)1024 * 4096 * 2;
constexpr size_t RW_S     = RW_U + (size_t)1024 * 4096 * 2;
constexpr size_t RW_W1    = RW_S + (size_t)1024 * 4096 * 2;
constexpr size_t RW_Z     = RW_W1 + (size_t)1024 * 4096 * 2;
constexpr size_t YSG_OFF  = RW_Z + (size_t)1024 * 4096 * 2;
static_assert(YSG_OFF + (size_t)NTOK * 256 * 2 <= MOE_BYTES, "alias");
constexpr size_t WS_MST   = WS_MOE + MOE_BYTES;
constexpr size_t WS_MDEC  = WS_MST + (size_t)4 * 64 * 4 * 4096 * 4;
constexpr size_t WS_S5ST  = WS_MDEC + 4096;
constexpr size_t WS_K     = WS_S5ST + (size_t)4 * 64 * 2048 * 4;
constexpr size_t WS_V     = WS_K + (size_t)NTOK * 64 * 2;
constexpr size_t WS_KIDX  = WS_V + (size_t)NTOK * 64 * 2;
constexpr size_t WS_ROUTE = WS_KIDX + (size_t)NTOK * 32 * 2;
constexpr size_t WS_ROWS  = WS_ROUTE + (size_t)NTOK * 32;
constexpr int    MAXROWS  = 49152;
constexpr size_t WS_TILES = WS_ROWS + (size_t)MAXROWS * 8;
constexpr size_t WS_S5TAB = WS_TILES + 4096;
constexpr size_t S5TAB_F  = (size_t)(2048 + 2048 + 32768) * 4;
constexpr size_t S5TAB_BBT = S5TAB_F + (size_t)16 * 16 * 128 * 2;
constexpr size_t S5TAB_L  = S5TAB_BBT + (size_t)16 * 128 * 16 * 2;
constexpr size_t WS_WRT   = WS_S5TAB + 2 * S5TAB_L;
constexpr size_t WS_BON   = WS_WRT + (size_t)2 * 2 * 48 * 1024 * 2;
constexpr size_t WS_END   = WS_BON + (size_t)1024 * 64 * 4;

constexpr int CW_BAR = 0;
constexpr int CW_Q   = 4096;
constexpr int CW_CNT = 8192;
constexpr int CW_RB  = 8448;

__device__ __forceinline__ float bf2f(bf16_t b) { return __uint_as_float(((unsigned)b) << 16); }
__device__ __forceinline__ bf16_t f2bf(float f) { const __bf16 h = (__bf16)f; return __builtin_bit_cast(bf16_t, h); }
__device__ __forceinline__ unsigned pk2(float lo, float hi) { typedef __bf16 bf2_t __attribute__((ext_vector_type(2))); const bf2_t h = __builtin_convertvector((f32x2){lo, hi}, bf2_t); return __builtin_bit_cast(unsigned, h); }
__device__ __forceinline__ unsigned cvt_pk_bf16(float lo, float hi) { unsigned r; asm volatile("v_cvt_pk_bf16_f32 %0, %1, %2" : "=v"(r) : "v"(lo), "v"(hi)); return r; }
__device__ __forceinline__ float sigmoidf_(float x) { return 1.0f / (1.0f + __expf(-x)); }
__device__ __forceinline__ float siluf_(float x) { return x / (1.0f + __expf(-x)); }
__device__ __forceinline__ float tanhf_(float x) { const float e = __expf(2.0f * x); return 1.0f - 2.0f / (e + 1.0f); }
__device__ __forceinline__ float softplusf_(float x) { return fmaxf(x, 0.0f) + log1pf(__expf(-fabsf(x))); }
__device__ __forceinline__ float gelu_tanh(float x) { return 0.5f * x * (1.0f + tanhf_(0.7978845608028654f * (x + 0.044715f * x * x * x))); }
template <int CTRL> __device__ __forceinline__ float dppf(float x) { return __int_as_float(__builtin_amdgcn_update_dpp(0, __float_as_int(x), CTRL, 0xF, 0xF, true)); }
__device__ __forceinline__ float sum4(float x) { x += dppf<0xB1>(x); x += dppf<0x4E>(x); return x; }
__device__ __forceinline__ float sum8(float x) { x = sum4(x); x += dppf<0x141>(x); return x; }
__device__ __forceinline__ float sum16(float x) { x = sum8(x); x += dppf<0x140>(x); return x; }
__device__ __forceinline__ int lane_id_() { int l = (int)__builtin_amdgcn_mbcnt_hi(~0u, __builtin_amdgcn_mbcnt_lo(~0u, 0u)); asm volatile("" : "+v"(l)); return l; }
__device__ __forceinline__ float shx(float x, int o) { return __int_as_float(__builtin_amdgcn_ds_bpermute((lane_id_() ^ o) << 2, __float_as_int(x))); }
__device__ __forceinline__ unsigned shdown_u(unsigned x, int o) { return (unsigned)__builtin_amdgcn_ds_bpermute(((lane_id_() + o) & 63) << 2, (int)x); }
__device__ __forceinline__ int shidx_i(int x, int src) { return __builtin_amdgcn_ds_bpermute(src << 2, x); }
template <class OP> __device__ __forceinline__ float xrows(float x, OP op) {
    u32x2 r = __builtin_amdgcn_permlane16_swap(__float_as_uint(x), __float_as_uint(x), false, false); x = op(__uint_as_float(r[0]), __uint_as_float(r[1]));
    r = __builtin_amdgcn_permlane32_swap(__float_as_uint(x), __float_as_uint(x), false, false); return op(__uint_as_float(r[0]), __uint_as_float(r[1])); }
struct OpAdd { __device__ __forceinline__ float operator()(float a, float b) const { return a + b; } };
struct OpMin { __device__ __forceinline__ float operator()(float a, float b) const { return fminf(a, b); } };
struct OpMax { __device__ __forceinline__ float operator()(float a, float b) const { return fmaxf(a, b); } };
__device__ __forceinline__ float wave_sum(float x) { x = sum16(x); return xrows(x, OpAdd()); }
__device__ __forceinline__ float wave_min(float x) { x = fminf(x, dppf<0xB1>(x)); x = fminf(x, dppf<0x4E>(x)); x = fminf(x, dppf<0x141>(x)); x = fminf(x, dppf<0x140>(x)); return xrows(x, OpMin()); }
__device__ __forceinline__ float wave_max(float x) { x = fmaxf(x, dppf<0xB1>(x)); x = fmaxf(x, dppf<0x4E>(x)); x = fmaxf(x, dppf<0x141>(x)); x = fmaxf(x, dppf<0x140>(x)); return xrows(x, OpMax()); }
template <int CTRL, int RM, bool BC> __device__ __forceinline__ float dpp_addf(float x) { return x + __int_as_float(__builtin_amdgcn_update_dpp(0, __float_as_int(x), CTRL, RM, 0xF, BC)); }
__device__ __forceinline__ float wave_prefix_f(float x) { x = dpp_addf<0x111, 0xF, true>(x); x = dpp_addf<0x112, 0xF, true>(x); x = dpp_addf<0x114, 0xF, true>(x); x = dpp_addf<0x118, 0xF, true>(x);
    x = dpp_addf<0x142, 0xA, false>(x); return dpp_addf<0x143, 0xC, false>(x); }
__device__ __forceinline__ unsigned wave_prefix_u(unsigned x) { int v = (int)x;
    v += __builtin_amdgcn_update_dpp(0, v, 0x111, 0xF, 0xF, true); v += __builtin_amdgcn_update_dpp(0, v, 0x112, 0xF, 0xF, true);
    v += __builtin_amdgcn_update_dpp(0, v, 0x114, 0xF, 0xF, true); v += __builtin_amdgcn_update_dpp(0, v, 0x118, 0xF, 0xF, true);
    v += __builtin_amdgcn_update_dpp(0, v, 0x142, 0xA, 0xF, false); v += __builtin_amdgcn_update_dpp(0, v, 0x143, 0xC, 0xF, false); return (unsigned)v; }
__device__ __forceinline__ void unpack8(const u32x4 v, float (&f)[8]) {
    f[0] = __uint_as_float(v.x << 16); f[1] = __uint_as_float(v.x & 0xffff0000u); f[2] = __uint_as_float(v.y << 16); f[3] = __uint_as_float(v.y & 0xffff0000u);
    f[4] = __uint_as_float(v.z << 16); f[5] = __uint_as_float(v.z & 0xffff0000u); f[6] = __uint_as_float(v.w << 16); f[7] = __uint_as_float(v.w & 0xffff0000u);
}

__device__ __forceinline__ void st16_wt(void* p, u32x4 v) { asm volatile("global_store_dwordx4 %0, %1, off sc1\n\ts_nop 1" :: "v"(p), "v"(v) : "memory"); }
#define XB_TMO      128
#define XB_XCNT(j)  (256  + 64 * (j))
#define XB_XSUB(j)  (1280 + 64 * (j))
#define XB_XGEN(j)  (2304 + 64 * (j))
#define XB_TOP      3328
#define XB_TOPGEN   3392
#define XCD_BAR_WORDS 3456
#define XB_SPIN_CAP (1u << 22)
__device__ __forceinline__ unsigned xb_ld(unsigned* p)              { return __hip_atomic_load(p, __ATOMIC_RELAXED, __HIP_MEMORY_SCOPE_AGENT); }
__device__ __forceinline__ unsigned xb_add(unsigned* p, unsigned v) { return __hip_atomic_fetch_add(p, v, __ATOMIC_RELAXED, __HIP_MEMORY_SCOPE_AGENT); }
__device__ __forceinline__ unsigned xb_xcc_id() { return (unsigned)__builtin_amdgcn_s_getreg((3 << 11) | 20) & 0xFu; }
#define XB_SPIN(cond, bar) do { unsigned _sp = 0; while (cond) { __builtin_amdgcn_s_sleep(1); \
    if ((++_sp & 255u) == 0u) { if (xb_ld(&(bar)[XB_TMO])) break; if (_sp > XB_SPIN_CAP) { atomicAdd(&(bar)[XB_TMO], 1u); break; } } } } while (0)
struct XcdBarrier { unsigned* bar; unsigned x; volatile LAS unsigned* st; };
__device__ __forceinline__ XcdBarrier xcd_barrier_post(unsigned* bar, volatile LAS unsigned* st) {
    XcdBarrier b; b.bar = bar; b.x = xb_xcc_id(); b.st = st;
    if (threadIdx.x == 0) (void)xb_add(&bar[XB_XCNT(b.x)], 1u);
    return b;
}
__device__ __forceinline__ void xcd_barrier_complete(unsigned* bar, unsigned x, unsigned& nloc, unsigned& nx) {
    const unsigned G = gridDim.x * gridDim.y * gridDim.z;
    unsigned sum, cnt, mine, sp = 0u;
    for (;;) {
        sum = 0u; cnt = 0u; mine = 0u;
#pragma unroll
        for (unsigned j = 0; j < 16; ++j) { const unsigned c = xb_ld(&bar[XB_XCNT(j)]); sum += c; cnt += (c > 0u) ? 1u : 0u; mine = (j == x) ? c : mine; }
        if (sum == G) break;
        __builtin_amdgcn_s_sleep(1);
        if ((++sp & 255u) == 0u) { if (xb_ld(&bar[XB_TMO])) break; if (sp > XB_SPIN_CAP) { atomicAdd(&bar[XB_TMO], 1u); break; } }
    }
    nloc = mine > 0u ? mine : 1u; nx = cnt > 0u ? cnt : 1u;
}
__device__ __forceinline__ void xcd_barrier(const XcdBarrier& b_) {
    XcdBarrier b = b_; { const unsigned long long v = (unsigned long long)b.bar; unsigned lo = __builtin_amdgcn_readfirstlane((unsigned)v), hi = __builtin_amdgcn_readfirstlane((unsigned)(v >> 32)); asm volatile("" : "+s"(lo), "+s"(hi)); b.bar = (unsigned*)(((unsigned long long)hi << 32) | lo); unsigned xx = __builtin_amdgcn_readfirstlane(b.x); asm volatile("" : "+s"(xx)); b.x = xx; }
    asm volatile("s_waitcnt vmcnt(0)" ::: "memory");
    __syncthreads();
    if (threadIdx.x == 0) {
        unsigned* bar = b.bar;
        __builtin_amdgcn_s_waitcnt(0);
        unsigned nloc = b.st[0], nx = b.st[1];
        if (nloc == 0u) { xcd_barrier_complete(bar, b.x, nloc, nx); b.st[0] = nloc; b.st[1] = nx; }
        const unsigned old = xb_add(&bar[XB_XSUB(b.x)], 1u);
        const unsigned gen = old / nloc;
        if (old + 1u == (gen + 1u) * nloc) {
            __builtin_amdgcn_fence(__ATOMIC_RELEASE, "agent");
            asm volatile("s_waitcnt vmcnt(0)" ::: "memory");
            const unsigned og = xb_add(&bar[XB_TOP], 1u);
            const unsigned tg = og / nx;
            if (og + 1u == (tg + 1u) * nx) xb_add(&bar[XB_TOPGEN], 1u);
            else XB_SPIN(xb_ld(&bar[XB_TOPGEN]) == tg, bar);
            __builtin_amdgcn_fence(__ATOMIC_ACQUIRE, "agent");
            xb_add(&bar[XB_XGEN(b.x)], 1u);
            asm volatile("s_waitcnt vmcnt(0)" ::: "memory");
        } else {
            XB_SPIN(xb_ld(&bar[XB_XGEN(b.x)]) == gen, bar);
            __builtin_amdgcn_fence(__ATOMIC_ACQUIRE, "agent");
            asm volatile("s_waitcnt vmcnt(0)" ::: "memory");
        }
    }
    __syncthreads();
}

namespace pg8 {
constexpr int BM = 256, BK = 64, HALF = 128, HTB = HALF * BK * 2, STAGE_BYTES = 8 * HTB, NXCD = 8, WGM = 8;
__host__ __device__ __forceinline__ int lds_byte(int r, int c) { const int st = (r >> 4) * 2 + (c >> 5), rr = r & 15, cc = c & 31, ob = rr * 64 + cc * 2; return st * 1024 + (ob ^ (((ob >> 9) & 1) << 5)); }
__host__ __device__ __forceinline__ void stage_rc(int b, int& R, int& C) { const int st = b / 1024, sb = b % 1024, swz = sb ^ (((sb >> 9) & 1) << 5); R = (st >> 1) * 16 + swz / 64; C = (st & 1) * 32 + (swz % 64) / 2; }
__host__ __device__ __forceinline__ int perm32(int rho) { const int n = rho >> 4, i = rho & 15; return 8 * (i >> 2) + 4 * n + (i & 3); }
struct Unit { int pm, pn; const char* a; const char* b; };

struct StaticOrder {
    int nM, nN, nwg, G, c, K; const char* A; const char* B;
    __device__ void init(const bf16_t* A_, const bf16_t* B_, int M, int N, int K_, int G_, int c_) { A = (const char*)A_; B = (const char*)B_; K = K_; nM = M / BM; nN = N / BM; nwg = nM * nN; G = G_; c = c_; }
    __device__ bool next(int i, Unit& u) const {
        const long L = (long)i * G + c; if (L >= nwg) return false;
        int wgid = (int)L; { const int q = nwg / NXCD, r = nwg % NXCD, xcd = wgid % NXCD, off = wgid / NXCD; wgid = (xcd < r ? xcd * (q + 1) : r * (q + 1) + (xcd - r) * q) + off; }
        const int nig = WGM * nN, gid = wgid / nig, fm = gid * WGM, gsz = (nM - fm) < WGM ? (nM - fm) : WGM;
        u.pm = fm + ((wgid % nig) % gsz); u.pn = (wgid % nig) / gsz;
        u.a = A + (size_t)u.pm * 256 * K * 2; u.b = B + (size_t)u.pn * 256 * K * 2; return true;
    }
};

template <class Epi, class Sched, bool GATHER = false>
__device__ __forceinline__ void gemm_phase(LAS unsigned char* lds, const int K_, const Sched& S, const Epi& E, const char* Aall = nullptr, const int* arow = nullptr) {
    int K = K_; asm volatile("" : "+s"(K));
    int tid_ = threadIdx.x; asm volatile("" : "+v"(tid_));
    const int tid = tid_, wid = __builtin_amdgcn_readfirstlane(tid >> 6), lane = tid & 63, wr = wid >> 2, wc = wid & 3, fr = lane & 15, fq = lane >> 4;
    const int nt = K / BK;
    unsigned voffA[2], voffB[2]; int Rst[2], Cst[2];
#pragma unroll
    for (int i = 0; i < 2; ++i) { int R, C; stage_rc(tid * 16 + i * 8192, R, C); const int Rb = Epi::PERM ? ((R & ~31) + perm32(R & 31)) : R; Rst[i] = R; Cst[i] = C;
        voffA[i] = (unsigned)(R * K + C) * 2u; voffB[i] = (unsigned)(Rb * K + C) * 2u; }
    unsigned gv[2][2], gn[2][2];
#define PG8_GOFF(dst, unit) do { _Pragma("unroll") for (int h_ = 0; h_ < 2; ++h_) _Pragma("unroll") for (int i_ = 0; i_ < 2; ++i_) { const int rr_ = arow[(unit).pm * BM + h_ * HALF + Rst[i_]]; \
        dst[h_][i_] = ((unsigned)(rr_ < 0 ? 0 : rr_ >> 1) * (unsigned)K + (unsigned)Cst[i_]) * 2u; } } while (0)
    const size_t kstep = (size_t)(BK * 2);
    const size_t hstep = (size_t)HALF * K * 2;
    const unsigned ldsw = (unsigned)wid * 1024u;
    const int aoff = lds_byte(wr * 64 + fr, fq * 8), boff = lds_byte(wc * 32 + fr, fq * 8);
#define PG8_SA(b, h) (((b) * 2 + (h)) * HTB)
#define PG8_SB(b, h) ((4 + (b) * 2 + (h)) * HTB)
#define PG8_STAGE(bufoff, gbase, voff) do { _Pragma("unroll") for (int _i = 0; _i < 2; ++_i) \
        __builtin_amdgcn_global_load_lds((const unsigned*)((const char*)(gbase) + (voff)[_i]), (LAS unsigned*)(lds + (bufoff) + ldsw + _i * 8192), 16, 0, 0); } while (0)
#define PG8_LDA(dst, b, h) do { _Pragma("unroll") for (int m = 0; m < 4; ++m) _Pragma("unroll") for (int k = 0; k < 2; ++k) dst[m][k] = *(const LAS bf16x8*)(lds + PG8_SA(b, h) + aoff + m * 2048 + k * 1024); } while (0)
#define PG8_LDB(dst, b, h) do { _Pragma("unroll") for (int n = 0; n < 2; ++n) _Pragma("unroll") for (int k = 0; k < 2; ++k) dst[n][k] = *(const LAS bf16x8*)(lds + PG8_SB(b, h) + boff + n * 2048 + k * 1024); } while (0)
#define PG8_MMA(ai, bj, At, Bt) do { __builtin_amdgcn_s_setprio(1); _Pragma("unroll") for (int m = 0; m < 4; ++m) _Pragma("unroll") for (int n = 0; n < 2; ++n) _Pragma("unroll") for (int k = 0; k < 2; ++k) \
        acc[ai][bj][m][n] = __builtin_amdgcn_mfma_f32_16x16x32_bf16(Bt[n][k], At[m][k], acc[ai][bj][m][n], 0, 0, 0); __builtin_amdgcn_s_setprio(0); } while (0)
#define PG8_WAIT_V(n) asm volatile("s_waitcnt vmcnt(" #n ")" ::: "memory")
#define PG8_WAIT_L(n) asm volatile("s_waitcnt lgkmcnt(" #n ")" ::: "memory")
#define PG8_BAR __builtin_amdgcn_s_barrier()
#define PG8_SCHED __builtin_amdgcn_sched_barrier(0)
    Unit cur, nxt; int ui = 0;
    if (!S.next(0, cur)) return;
    f32x4 acc[2][2][4][2];
#pragma unroll
    for (int a = 0; a < 2; ++a)
#pragma unroll
        for (int b = 0; b < 2; ++b)
#pragma unroll
            for (int m = 0; m < 4; ++m)
#pragma unroll
                for (int n = 0; n < 2; ++n) acc[a][b][m][n] = (f32x4){0.f, 0.f, 0.f, 0.f};
    bf16x8 At[4][2], B0[2][2], B1[2][2];
    const char* cA = GATHER ? Aall : cur.a; const char* cB = cur.b;
    if (GATHER) PG8_GOFF(gv, cur);
#define PG8_STAGE_A(bufoff, gbase, h, vo) do { if (GATHER) PG8_STAGE(bufoff, gbase, (vo)[h]); else PG8_STAGE(bufoff, (gbase) + ((h) ? hstep : 0), voffA); } while (0)
    PG8_STAGE(PG8_SB(0, 0), cB, voffB); PG8_STAGE_A(PG8_SA(0, 0), cA, 0, gv); PG8_STAGE(PG8_SB(0, 1), cB + hstep, voffB); PG8_STAGE_A(PG8_SA(0, 1), cA, 1, gv);
    if (wr == 1) PG8_BAR;
    PG8_WAIT_V(4); PG8_BAR;
    PG8_STAGE(PG8_SB(1, 0), cB + kstep, voffB); PG8_STAGE_A(PG8_SA(1, 0), cA + kstep, 0, gv); PG8_STAGE(PG8_SB(1, 1), cB + hstep + kstep, voffB);
    PG8_WAIT_V(6); PG8_BAR;
    for (;;) {
        const bool has_next = S.next(ui + 1, nxt);
        const char* nA = GATHER ? cA : (has_next ? nxt.a : cA); const char* nB = has_next ? nxt.b : cB;
        if (GATHER) { if (has_next) PG8_GOFF(gn, nxt); else {
#pragma unroll
            for (int h_ = 0; h_ < 2; ++h_)
#pragma unroll
                for (int i_ = 0; i_ < 2; ++i_) gn[h_][i_] = gv[h_][i_]; } }
        for (int t = 0; t < nt; t += 2) {
            const bool last = (t == nt - 2);
            const char* a1 = cA + (size_t)(t + 1) * kstep;
            const char* a2 = last ? nA : cA + (size_t)(t + 2) * kstep; const char* b2 = last ? nB : cB + (size_t)(t + 2) * kstep;
            const char* a3 = a2 + kstep; const char* b3 = b2 + kstep;
            unsigned vo2[2][2];
#pragma unroll
            for (int h_ = 0; h_ < 2; ++h_)
#pragma unroll
                for (int i_ = 0; i_ < 2; ++i_) vo2[h_][i_] = GATHER ? (last ? gn[h_][i_] : gv[h_][i_]) : 0u;
            PG8_LDB(B0, 0, 0); PG8_SCHED; PG8_LDA(At, 0, 0); PG8_STAGE_A(PG8_SA(1, 1), a1, 1, gv);
            PG8_WAIT_L(8); PG8_BAR; PG8_WAIT_L(0); PG8_MMA(0, 0, At, B0); PG8_BAR; PG8_SCHED;
            PG8_LDB(B1, 0, 1); PG8_STAGE(PG8_SB(0, 0), b2, voffB);
            PG8_BAR; PG8_WAIT_L(0); PG8_MMA(0, 1, At, B1); PG8_BAR;
            PG8_LDA(At, 0, 1); PG8_STAGE_A(PG8_SA(0, 0), a2, 0, vo2);
            PG8_BAR; PG8_WAIT_L(0); PG8_MMA(1, 0, At, B0); PG8_BAR; PG8_SCHED;
            PG8_STAGE(PG8_SB(0, 1), b2 + hstep, voffB);
            PG8_WAIT_V(6); PG8_BAR; PG8_MMA(1, 1, At, B1); PG8_BAR;
            PG8_LDB(B0, 1, 0); PG8_SCHED; PG8_LDA(At, 1, 0); PG8_STAGE_A(PG8_SA(0, 1), a2, 1, vo2);
            PG8_WAIT_L(8); PG8_BAR; PG8_WAIT_L(0); PG8_MMA(0, 0, At, B0); PG8_BAR; PG8_SCHED;
            PG8_LDB(B1, 1, 1); PG8_STAGE(PG8_SB(1, 0), b3, voffB);
            PG8_BAR; PG8_WAIT_L(0); PG8_MMA(0, 1, At, B1); PG8_BAR;
            PG8_LDA(At, 1, 1); PG8_STAGE_A(PG8_SA(1, 0), a3, 0, vo2);
            PG8_BAR; PG8_WAIT_L(0); PG8_MMA(1, 0, At, B0); PG8_BAR; PG8_SCHED;
            PG8_STAGE(PG8_SB(1, 1), b3 + hstep, voffB);
            PG8_WAIT_V(6); PG8_BAR; PG8_MMA(1, 1, At, B1); PG8_BAR;
        }
        E(acc, cur, wr, wc, fr, fq);
        if (!has_next) break;
#pragma unroll
        for (int a = 0; a < 2; ++a)
#pragma unroll
            for (int b = 0; b < 2; ++b)
#pragma unroll
                for (int m = 0; m < 4; ++m)
#pragma unroll
                    for (int n = 0; n < 2; ++n) acc[a][b][m][n] = (f32x4){0.f, 0.f, 0.f, 0.f};
        cur = nxt; cA = nA; cB = nB; ++ui;
        if (GATHER) {
#pragma unroll
            for (int h_ = 0; h_ < 2; ++h_)
#pragma unroll
                for (int i_ = 0; i_ < 2; ++i_) gv[h_][i_] = gn[h_][i_]; }
    }
    PG8_WAIT_V(0);
    if (wr == 0) PG8_BAR;
    PG8_BAR;
#undef PG8_SA
#undef PG8_SB
#undef PG8_STAGE
#undef PG8_STAGE_A
#undef PG8_GOFF
#undef PG8_LDA
#undef PG8_LDB
#undef PG8_MMA
#undef PG8_WAIT_V
#undef PG8_WAIT_L
#undef PG8_BAR
#undef PG8_SCHED
}

struct EpiBf16 {
    static constexpr bool PERM = true;
    bf16_t* O; int ldc;
    __device__ __forceinline__ void operator()(const f32x4 (&acc)[2][2][4][2], const Unit& u, int wr, int wc, int fr, int fq) const {
        const int row0 = u.pm * BM + wr * 64 + fr, col0 = u.pn * BM + wc * 32 + 8 * fq;
#pragma unroll
        for (int ai = 0; ai < 2; ++ai)
#pragma unroll
            for (int m = 0; m < 4; ++m) { bf16_t* rowp = O + (size_t)(row0 + ai * HALF + m * 16) * ldc + col0;
#pragma unroll
                for (int bj = 0; bj < 2; ++bj) { const f32x4 v0 = acc[ai][bj][m][0], v1 = acc[ai][bj][m][1];
                    u32x4 w; w.x = cvt_pk_bf16(v0[0], v0[1]); w.y = cvt_pk_bf16(v0[2], v0[3]); w.z = cvt_pk_bf16(v1[0], v1[1]); w.w = cvt_pk_bf16(v1[2], v1[3]);
                    st16_wt(rowp + bj * HALF, w); } }
    }
};
struct EpiResid {
    static constexpr bool PERM = false;
    const float* Cin; float* C; int ldc;
    __device__ __forceinline__ void operator()(const f32x4 (&acc)[2][2][4][2], const Unit& u, int wr, int wc, int fr_, int fq_) const {
        int fr = fr_, fq = fq_; asm volatile("" : "+v"(fr), "+v"(fq));
        const int row0 = u.pm * BM + wr * 64 + fr, col0 = u.pn * BM + wc * 32 + 4 * fq;
#pragma unroll
        for (int ai = 0; ai < 2; ++ai)
#pragma unroll
            for (int mp = 0; mp < 2; ++mp) { f32x4 cv[2][2][2];
#pragma unroll
                for (int mm = 0; mm < 2; ++mm) { const float* rowp = Cin + (size_t)(row0 + ai * HALF + (2 * mp + mm) * 16) * ldc + col0;
#pragma unroll
                    for (int bj = 0; bj < 2; ++bj)
#pragma unroll
                        for (int n = 0; n < 2; ++n) cv[mm][bj][n] = *(const f32x4*)(rowp + bj * HALF + n * 16); }
#pragma unroll
                for (int mm = 0; mm < 2; ++mm) { float* rowp = C + (size_t)(row0 + ai * HALF + (2 * mp + mm) * 16) * ldc + col0;
#pragma unroll
                    for (int bj = 0; bj < 2; ++bj)
#pragma unroll
                        for (int n = 0; n < 2; ++n) { const f32x4 o_ = cv[mm][bj][n] + acc[ai][bj][2 * mp + mm][n]; st16_wt(rowp + bj * HALF + n * 16, __builtin_bit_cast(u32x4, o_)); } }
                asm volatile("" ::: "memory"); }
    }
};
template <int ACT  > struct EpiGated {
    static constexpr bool PERM = true;
    bf16_t* O; int ldo; int coloff; const float* ba; const float* bb;
    __device__ __forceinline__ void operator()(const f32x4 (&acc)[2][2][4][2], const Unit& u, int wr, int wc, int fr, int fq) const {
        const int row0 = u.pm * BM + wr * 64 + fr, cl = u.pn * HALF + wc * 32 + 8 * fq;
        float va[8], vb[8];
#pragma unroll
        for (int j = 0; j < 8; ++j) { va[j] = (ACT == 0) ? ba[cl + j] : 0.f; vb[j] = (ACT == 0) ? bb[cl + j] : 0.f; }
#pragma unroll
        for (int ai = 0; ai < 2; ++ai)
#pragma unroll
            for (int m = 0; m < 4; ++m) { bf16_t* rowp = O + (size_t)(row0 + ai * HALF + m * 16) * ldo + coloff + cl;
                float o[8];
#pragma unroll
                for (int n = 0; n < 2; ++n)
#pragma unroll
                    for (int j = 0; j < 4; ++j) { const float a = acc[ai][0][m][n][j] + va[4 * n + j], b = acc[ai][1][m][n][j] + vb[4 * n + j];
                        o[4 * n + j] = (ACT == 0) ? a * sigmoidf_(b) : siluf_(a) * b; }
                u32x4 w; w.x = cvt_pk_bf16(o[0], o[1]); w.y = cvt_pk_bf16(o[2], o[3]); w.z = cvt_pk_bf16(o[4], o[5]); w.w = cvt_pk_bf16(o[6], o[7]);
                st16_wt(rowp, w); asm volatile("" ::: "memory"); }
    }
};
struct EpiMoeOut {
    static constexpr bool PERM = true;
    bf16_t* O; const int* row_tok; const float* row_w; LAS unsigned char* lds;
    __device__ __forceinline__ void operator()(const f32x4 (&acc)[2][2][4][2], const Unit& u, int wr, int wc, int fr_, int fq_) const {
        int fr = fr_, fq = fq_; asm volatile("" : "+v"(fr), "+v"(fq));
        const int col0 = u.pn * BM + wc * 32 + 8 * fq, lane = fq * 16 + fr;
        LAS u32x2* rinfo = (LAS u32x2*)(lds + STAGE_BYTES) + (wr * 4 + wc) * 128;
        { const int ra = u.pm * BM + wr * 64 + lane, rb = ra + HALF;
          const u32x2 ia = (u32x2){(unsigned)row_tok[ra], __float_as_uint(row_w[ra])}, ib = (u32x2){(unsigned)row_tok[rb], __float_as_uint(row_w[rb])};
          rinfo[lane] = ia; rinfo[64 + lane] = ib; }
#pragma unroll
        for (int ai = 0; ai < 2; ++ai)
#pragma unroll
            for (int m = 0; m < 4; ++m) { const u32x2 inf = rinfo[ai * 64 + m * 16 + fr]; const int ts = (int)inf.x; const float w = __uint_as_float(inf.y);
                if (ts >= 0) { bf16_t* rowp = O + ((size_t)(ts & 1) * NTOK + (size_t)(ts >> 1)) * DM + col0;
#pragma unroll
                    for (int bj = 0; bj < 2; ++bj) { const f32x4 v0 = acc[ai][bj][m][0] * w, v1 = acc[ai][bj][m][1] * w;
                        u32x4 q; q.x = cvt_pk_bf16(v0[0], v0[1]); q.y = cvt_pk_bf16(v0[2], v0[3]); q.z = cvt_pk_bf16(v1[0], v1[1]); q.w = cvt_pk_bf16(v1[2], v1[3]);
                        st16_wt(rowp + bj * HALF, q); } } }
    }
};
struct MoeOrder {
    int K; const char* A; const char* B; size_t bstride; const LAS int* list;
    static __device__ __forceinline__ void build(LAS int* list, const int* tiles, int nN, int G, int c) {
        const int nrt = tiles[0], nwg = nrt * nN; int n = 0;
        for (int i = 0; ; ++i) { const long L = (long)i * G + c; if (L >= (long)nwg || n >= 20) break;
            int wgid = (int)L; { const int q = nwg / NXCD, r = nwg % NXCD, xcd = wgid % NXCD, off = wgid / NXCD; wgid = (xcd < r ? xcd * (q + 1) : r * (q + 1) + (xcd - r) * q) + off; }
            const int pm = wgid / nN; list[1 + 3 * n] = pm; list[2 + 3 * n] = wgid % nN; list[3 + 3 * n] = tiles[64 + pm]; ++n; }
        list[0] = n;
    }
    __device__ bool next(int i, Unit& u) const {
        const int n = __builtin_amdgcn_readfirstlane(list[0]); if (i >= n) return false;
        u.pm = __builtin_amdgcn_readfirstlane(list[1 + 3 * i]); u.pn = __builtin_amdgcn_readfirstlane(list[2 + 3 * i]); const int e = __builtin_amdgcn_readfirstlane(list[3 + 3 * i]);
        u.a = A + (size_t)u.pm * 256 * K * 2; u.b = B + (size_t)e * bstride + (size_t)u.pn * 256 * K * 2; return true;
    }
};
}

struct Params { const float* in[44]; float* out; unsigned char* ws; int ph_lo, ph_hi; };
enum { I_X = 0, I_NORM1, I_WIN, I_MCONVW, I_MCONVB, I_MDTB, I_MALOG, I_MD, I_MNORM, I_RMU, I_RW0, I_RW2, I_RA0, I_RA2, I_RG2, I_RKK, I_RKA, I_RRK, I_RLNW, I_RLNB,
       I_CKVN, I_CWUK, I_CWUV, I_RELB, I_SARE, I_SAIM, I_SBRE, I_SBIM, I_SCRE, I_SCIM, I_SD, I_SLOGDT, I_SGLUW, I_SGLUB, I_WOUT, I_NORM2, I_WRG, I_BRG, I_WRE, I_BRE,
       I_WGATE, I_WUP, I_WDOWN, I_FNORM };

typedef const float* const __attribute__((address_space(4)))* in_tab_t;
struct Frame {
    LAS unsigned char* lds; int tid, lane, wave, bid, G;
    in_tab_t in; float* out; unsigned char* ws; unsigned* ctl;
    volatile LAS int* misc;
};

__device__ __forceinline__ int q_pop(Frame& F, int qi) {
    __syncthreads();
    if (F.tid == 0) F.misc[0] = (int)__hip_atomic_fetch_add(F.ctl + CW_Q + 64 * qi, 1u, __ATOMIC_RELAXED, __HIP_MEMORY_SCOPE_AGENT);
    __syncthreads();
    return F.misc[0];
}

__device__ __forceinline__ const void* opaque_ptr(const void* p) { const unsigned long long v = (unsigned long long)p; unsigned lo = __builtin_amdgcn_readfirstlane((unsigned)v), hi = __builtin_amdgcn_readfirstlane((unsigned)(v >> 32));
    asm volatile("" : "+s"(lo), "+s"(hi)); return (const void*)(((unsigned long long)hi << 32) | lo); }
__device__ __forceinline__ Frame relocal(const Frame& G) { Frame F = G; asm volatile("" : "+v"(F.tid)); F.ws = (unsigned char*)opaque_ptr(F.ws); F.ctl = (unsigned*)(F.ws + WS_CTL); F.in = (in_tab_t)(unsigned long long)opaque_ptr((const void*)(unsigned long long)F.in); F.lane = F.tid & 63; F.wave = __builtin_amdgcn_readfirstlane(F.tid >> 6); return F; }
template <int K> __device__ __forceinline__ f32x4 mma_nt(const LAS bf16_t* A, int lda, const LAS bf16_t* Bt, int ldb, f32x4 acc, int lane) {
    const int r = lane & 15, g = lane >> 4;
#pragma unroll
    for (int k0 = 0; k0 < K; k0 += 32) {
        const bf16x8 a = *(const LAS bf16x8*)(A + r * lda + k0 + 8 * g);
        const bf16x8 b = *(const LAS bf16x8*)(Bt + r * ldb + k0 + 8 * g);
        acc = __builtin_amdgcn_mfma_f32_16x16x32_bf16(a, b, acc, 0, 0, 0);
    }
    return acc;
}

template <class SrcMap> __device__ __forceinline__ void tr_tile(Frame& F, int ldsrc, bf16_t* dst, int K, int k0, int n0, SrcMap sm) {
    LAS float* tile = (LAS float*)F.lds;
    __syncthreads();
    { const int n4 = (F.tid & 63) * 4, kk = F.tid >> 6; const float* sp = sm(n0 + n4);
      f32x4 v[8];
#pragma unroll
      for (int ps = 0; ps < 8; ++ps) { v[ps] = (f32x4){0.f, 0.f, 0.f, 0.f}; if (sp) v[ps] = __builtin_nontemporal_load((const f32x4*)(sp + (size_t)(k0 + kk + 8 * ps) * ldsrc)); }
#pragma unroll
      for (int ps = 0; ps < 8; ++ps) { LAS float* t = tile + (kk + 8 * ps) * 257 + n4; t[0] = v[ps][0]; t[1] = v[ps][1]; t[2] = v[ps][2]; t[3] = v[ps][3]; } }
    __syncthreads();
    { const int kc = F.tid & 7;
#pragma unroll
      for (int j = 0; j < 4; ++j) { const int n = (F.tid >> 3) + 64 * j; float f[8];
#pragma unroll
          for (int i = 0; i < 8; ++i) f[i] = tile[(8 * kc + i) * 257 + n];
          u32x4 w; w.x = pk2(f[0], f[1]); w.y = pk2(f[2], f[3]); w.z = pk2(f[4], f[5]); w.w = pk2(f[6], f[7]);
          *(u32x4*)(dst + (size_t)(n0 + n) * K + k0 + 8 * kc) = w; } }
}

struct SmIn { const float* base; __device__ __forceinline__ const float* operator()(int n) const {
    int c; if (n < 772) c = n; else if (n < UR) return nullptr; else if (n < UR + 896) c = 772 + (n - UR); else if (n < UC) return nullptr;
    else if (n < UC + 680) c = 1668 + (n - UC); else if (n < US) return nullptr; else if (n < US + 256) c = 2348 + (n - US); else return nullptr; return base + c; } };
struct SmId { const float* base; __device__ __forceinline__ const float* operator()(int n) const { return base + n; } };
struct SmGlu { const float* base; __device__ __forceinline__ const float* operator()(int n) const { const int pn = n >> 8, rr = n & 255; return base + (rr < 128 ? 128 * pn + rr : 256 + 128 * pn + (rr - 128)); } };
struct SmGU { const float* gate; const float* up; __device__ __forceinline__ const float* operator()(int n) const {
    const unsigned long long d = (unsigned long long)up - (unsigned long long)gate; const unsigned long long a = (unsigned long long)gate + (((n & 255) < 128) ? 0ull : d); return (const float*)a + 128 * (n >> 8) + (n & 127); } };
__device__ __forceinline__ void phase_prologue(const Frame& F_) { Frame F = relocal(F_);
    for (int t = F.bid; t < 496; t += F.G) {
        if (t < 352) { const int l = t / 176, r = t % 176, kt = r / 11, nt = r % 11;
            tr_tile(F, NIN, (bf16_t*)(F.ws + WS_WIN) + (size_t)l * NINP * DM, DM, kt * 64, nt * 256, SmIn{F.in[I_WIN] + (size_t)l * DM * NIN}); }
        else if (t < 480) { const int q = t - 352, l = q / 64, r = q % 64, kt = r / 4, nt = r % 4;
            tr_tile(F, DM, (bf16_t*)(F.ws + WS_WOUT) + (size_t)l * DM * DM, DM, kt * 64, nt * 256, SmId{F.in[I_WOUT] + (size_t)l * DM * DM}); }
        else { const int q = t - 480, l = q / 8, r = q % 8, kt = r / 2, nt = r % 2;
            tr_tile(F, 512, (bf16_t*)(F.ws + WS_GLU) + (size_t)l * 512 * 256, 256, kt * 64, nt * 256, SmGlu{F.in[I_SGLUW] + (size_t)l * 256 * 512}); }
    }
    for (int i = F.bid * NTHR + F.tid; i < 2 * 48 * 1024; i += F.G * NTHR) { const int l = i / 49152, r = i % 49152, o = r >> 10, k = r & 1023;
        float v = 0.f; if (o < 32) v = F.in[I_WRE][((size_t)l * DM + k) * 32 + o]; else if (o < 36) v = F.in[I_WRG][((size_t)l * DM + k) * 4 + (o - 32)];
        v *= F.in[I_NORM2][l * DM + k];
        const bf16_t hi = f2bf(v); const bf16_t lo = f2bf(v - bf2f(hi));
        bf16_t* w = (bf16_t*)(F.ws + WS_WRT) + (size_t)l * 2 * 49152; w[r] = hi; w[49152 + r] = lo; }
    for (int i = F.bid * NTHR + F.tid; i < 2048 + 65536; i += F.G * NTHR) {
        if (i < 2048) {
            const int l = i >> 10, gn = i & 1023, g = gn >> 6;
            float* tab = (float*)(F.ws + WS_S5TAB + (size_t)l * S5TAB_L);
            const float lre = fminf(F.in[I_SARE][l * 1024 + gn], -1e-4f), lim = F.in[I_SAIM][l * 1024 + gn];
            const float dt = expf(F.in[I_SLOGDT][l * 16 + g]);
            const float mag = expf(dt * lre); float sn, cs; sincosf(dt * lim, &sn, &cs);
            const float are = mag * cs, aim = mag * sn;
            const float den = lre * lre + lim * lim;
            const float fre = ((are - 1.0f) * lre + aim * lim) / den, fim = (aim * lre - (are - 1.0f) * lim) / den;
            tab[gn * 2] = are; tab[gn * 2 + 1] = aim;
            float pr = are, pi = aim;
#pragma unroll
            for (int s = 0; s < 6; ++s) { const float nr = pr * pr - pi * pi, ni = 2.0f * pr * pi; pr = nr; pi = ni; }
            tab[2048 + gn * 2] = pr; tab[2048 + gn * 2 + 1] = pi;
            const float* bre = F.in[I_SBRE] + ((size_t)l * 1024 + gn) * 16; const float* bim = F.in[I_SBIM] + ((size_t)l * 1024 + gn) * 16;
            bf16_t* bbt = (bf16_t*)(F.ws + WS_S5TAB + (size_t)l * S5TAB_L + S5TAB_BBT); const int n = gn & 63, col = 4 * (n & 31) + 2 * (n >> 5);
            for (int p = 0; p < 16; ++p) { const float vr = fre * bre[p] - fim * bim[p], vi = fre * bim[p] + fim * bre[p];
                bbt[((size_t)g * 128 + col) * 16 + p] = f2bf(vr); bbt[((size_t)g * 128 + col + 1) * 16 + p] = f2bf(vi); }
        } else {
            const int j = i - 2048, l = j >> 15, r = j & 32767, gp = r >> 7, k = r & 127;
            bf16_t* cm = (bf16_t*)(F.ws + WS_S5TAB + (size_t)l * S5TAB_L + S5TAB_F);
            const int n = (k >> 2) + 32 * ((k >> 1) & 1);
            const float v = (k & 1) == 0 ? F.in[I_SCRE][((size_t)l * 256 + gp) * 64 + n] : -F.in[I_SCIM][((size_t)l * 256 + gp) * 64 + n];
            cm[r] = f2bf(v);
        }
    }
}

__device__ __forceinline__ void phase_norm(const Frame& F_, const float* xin, bool add_o, const float* w, int mode) { Frame F = relocal(F_);
    float* X = (float*)(F.ws + WS_X); bf16_t* H = (bf16_t*)(F.ws + WS_H); const bf16_t* O = (const bf16_t*)(F.ws + WS_U);
    for (int row0 = F.bid * 32 + F.wave * 4; row0 < NTOK; row0 += F.G * 32) {
        f32x4 v[4][4]; u32x2 oa[4][4], ob[4][4];
#pragma unroll
        for (int r = 0; r < 4; ++r)
#pragma unroll
            for (int j = 0; j < 4; ++j) { const int c = 4 * F.lane + 256 * j; const size_t o = (size_t)(row0 + r) * DM + c; v[r][j] = (mode == 2) ? __builtin_nontemporal_load((const f32x4*)(xin + o)) : *(const f32x4*)(xin + o);
                if (add_o) { oa[r][j] = __builtin_nontemporal_load((const u32x2*)(O + o)); ob[r][j] = __builtin_nontemporal_load((const u32x2*)(O + (size_t)NTOK * DM + o)); } }
#pragma unroll
        for (int r = 0; r < 4; ++r) { const int row = row0 + r; float ss = 0.f;
#pragma unroll
            for (int j = 0; j < 4; ++j) {
                if (add_o) { const u32x2 a = oa[r][j], b = ob[r][j];
                    v[r][j][0] += __uint_as_float(a.x << 16) + __uint_as_float(b.x << 16); v[r][j][1] += __uint_as_float(a.x & 0xffff0000u) + __uint_as_float(b.x & 0xffff0000u);
                    v[r][j][2] += __uint_as_float(a.y << 16) + __uint_as_float(b.y << 16); v[r][j][3] += __uint_as_float(a.y & 0xffff0000u) + __uint_as_float(b.y & 0xffff0000u); }
                ss += v[r][j][0] * v[r][j][0] + v[r][j][1] * v[r][j][1] + v[r][j][2] * v[r][j][2] + v[r][j][3] * v[r][j][3]; }
            ss = wave_sum(ss);
            const float rstd = rsqrtf(ss * (1.0f / DM) + 1e-6f);
#pragma unroll
            for (int j = 0; j < 4; ++j) { const int c = 4 * F.lane + 256 * j; const f32x4 wv = *(const f32x4*)(w + c);
                if (mode == 2) { __builtin_nontemporal_store(v[r][j] * rstd * wv, (f32x4*)(F.out + (size_t)row * DM + c)); }
                else { if (mode == 0) *(f32x4*)(X + (size_t)row * DM + c) = v[r][j];
                    u32x2 o; o.x = pk2(v[r][j][0] * rstd * wv[0], v[r][j][1] * rstd * wv[1]); o.y = pk2(v[r][j][2] * rstd * wv[2], v[r][j][3] * rstd * wv[3]);
                    *(u32x2*)(H + (size_t)row * DM + c) = o; } } }
    }
}

__device__ __forceinline__ void item_kv(const Frame& F_, int layer, int item) { Frame F = relocal(F_);
    const bf16_t* U = (const bf16_t*)(F.ws + WS_U);
    LAS bf16_t* Ab = (LAS bf16_t*)F.lds;
    LAS bf16_t* Bt = (LAS bf16_t*)(F.lds + 17408);
    const int t0 = item * 64;
    { const int tok = F.tid >> 3, part = F.tid & 7; const bf16_t* src = U + (size_t)(t0 + tok) * NINP + UC + 256 + 16 * part;
      float f[16]; { float a[8], b[8]; unpack8(*(const u32x4*)src, a); unpack8(*(const u32x4*)(src + 8), b);
#pragma unroll
        for (int j = 0; j < 8; ++j) { f[j] = a[j]; f[8 + j] = b[j]; } }
      float ss = 0.f;
#pragma unroll
      for (int j = 0; j < 16; ++j) ss += f[j] * f[j];
      ss = sum8(ss);
      const float rstd = rsqrtf(ss * (1.0f / 128.0f) + 1e-6f); const float* nw = F.in[I_CKVN] + layer * 128 + 16 * part;
#pragma unroll
      for (int j = 0; j < 16; j += 2) *(LAS unsigned*)(Ab + tok * 136 + 16 * part + j) = pk2(f[j] * rstd * nw[j], f[j + 1] * rstd * nw[j + 1]); }
    { const int n = F.tid >> 2, kq = F.tid & 3; const float* w = (n < 64 ? F.in[I_CWUK] : F.in[I_CWUV]) + (size_t)layer * 128 * 64 + (n & 63);
      float wv[32];
#pragma unroll
      for (int k = 0; k < 32; ++k) wv[k] = w[(size_t)(32 * kq + k) * 64];
#pragma unroll
      for (int k = 0; k < 32; k += 2) *(LAS unsigned*)(Bt + n * 136 + 32 * kq + k) = pk2(wv[k], wv[k + 1]); }
    if (F.tid < 256) { const int tok = F.tid >> 2, q = F.tid & 3;
        *(u32x4*)((bf16_t*)(F.ws + WS_KIDX) + (size_t)(t0 + tok) * 32 + 8 * q) = *(const u32x4*)(U + (size_t)(t0 + tok) * NINP + UC + 640 + 8 * q); }
    __syncthreads();
    const int mt = F.wave & 3, g = F.lane >> 4, r = F.lane & 15;
#pragma unroll
    for (int q = 0; q < 4; ++q) { const int nt = (F.wave >> 2) * 4 + q;
        f32x4 acc = (f32x4){0.f, 0.f, 0.f, 0.f};
        acc = mma_nt<128>(Ab + mt * 16 * 136, 136, Bt + nt * 16 * 136, 136, acc, F.lane);
        const int n = nt * 16 + r; bf16_t* dst = (bf16_t*)(F.ws + (n < 64 ? WS_K : WS_V));
#pragma unroll
        for (int i = 0; i < 4; ++i) dst[(size_t)(t0 + mt * 16 + 4 * g + i) * 64 + (n & 63)] = f2bf(acc[i]); }
}

constexpr int MB_CG = 0, MB_BG = 18432, MB_XT = 36864, MB_BT = 73728, MB_M = 73728, MB_S0 = 110592, MB_DT = 147456, MB_AC = 148480, MB_RS = 149504;
static_assert(MB_RS + 256 <= MISC_OFF && MB_BT == MB_XT + 4 * 64 * 72 * 2, "mamba LDS");
template <int STAGE> __device__ __forceinline__ void item_mamba(const Frame& F_, int layer, int item) { Frame F = relocal(F_);
    const bf16_t* U = (const bf16_t*)(F.ws + WS_U);
    const int b = item >> 6, c = item & 63, l0 = c * 64; const size_t T0 = (size_t)b * SEQ + l0;
    LAS bf16_t* Cg = (LAS bf16_t*)(F.lds + MB_CG); LAS bf16_t* Bg = (LAS bf16_t*)(F.lds + MB_BG); LAS bf16_t* BT = (LAS bf16_t*)(F.lds + MB_BT);
    LAS bf16_t* XT = (LAS bf16_t*)(F.lds + MB_XT); LAS bf16_t* Mb = (LAS bf16_t*)(F.lds + MB_M); LAS bf16_t* S0 = (LAS bf16_t*)(F.lds + MB_S0);
    LAS float* dts = (LAS float*)(F.lds + MB_DT); LAS float* acs = (LAS float*)(F.lds + MB_AC); LAS float* rs = (LAS float*)(F.lds + MB_RS);
    const int tg = F.tid & 7, c0 = (F.tid >> 3) * 8;
    const bool conv_on = (STAGE == 2) || (F.wave < 6);
    u32x4 rows[11]; float wv[4][8], bv[8];
    if (conv_on) {
#pragma unroll
        for (int k = 0; k < 11; ++k) { const int l = l0 + tg * 8 - 3 + k;
            if (l >= 0) rows[k] = *(const u32x4*)(U + ((size_t)b * SEQ + l) * NINP + UM + 256 + c0); else rows[k] = (u32x4){0u, 0u, 0u, 0u}; }
#pragma unroll
        for (int j = 0; j < 8; ++j) { bv[j] = F.in[I_MCONVB][layer * 512 + c0 + j];
#pragma unroll
            for (int k = 0; k < 4; ++k) wv[k][j] = F.in[I_MCONVW][(layer * 4 + k) * 512 + c0 + j]; } }
    const float* MSTi = (const float*)(F.ws + WS_MST) + ((size_t)(b * 64 + c) * 4) * 4096;
    f32x4 s0a[4], s0b[4];
    if (STAGE == 2) {
#pragma unroll
        for (int h = 0; h < 4; ++h) { const float* src = MSTi + (size_t)h * 4096 + F.tid * 8; s0a[h] = *(const f32x4*)src; s0b[h] = *(const f32x4*)(src + 4); } }
    if (F.wave < 4) { const int l = F.lane, h = F.wave;
        const float raw = bf2f(U[(T0 + l) * NINP + UM + 768 + h]) + F.in[I_MDTB][layer * 4 + h];
        const float dt = softplusf_(raw); const float cum = wave_prefix_f(-__expf(F.in[I_MALOG][layer * 4 + h]) * dt);
        dts[l * 4 + h] = dt; acs[l * 4 + h] = cum; }
    if (STAGE == 2) { if (F.tid < 64) rs[F.tid] = 0.f;
#pragma unroll
        for (int h = 0; h < 4; ++h) { u32x4 w; w.x = pk2(s0a[h][0], s0a[h][1]); w.y = pk2(s0a[h][2], s0a[h][3]); w.z = pk2(s0b[h][0], s0b[h][1]); w.w = pk2(s0b[h][2], s0b[h][3]);
            *(LAS u32x4*)(S0 + (h * 64 + (F.tid >> 3)) * 72 + (F.tid & 7) * 8) = w; } }
    __syncthreads();
    if (conv_on) {
        float win[3][8]; unpack8(rows[0], win[0]); unpack8(rows[1], win[1]); unpack8(rows[2], win[2]);
        const bool isx = F.wave < 4, tr = isx || STAGE == 1;
        unsigned pkT[8][4]; float prev[8];
#pragma unroll
        for (int i = 0; i < 8; ++i) { const int l = tg * 8 + i; float cur[8]; unpack8(rows[3 + i], cur);
            float o[8];
#pragma unroll
            for (int j = 0; j < 8; ++j) { o[j] = siluf_(bv[j] + wv[0][j] * win[0][j] + wv[1][j] * win[1][j] + wv[2][j] * win[2][j] + wv[3][j] * cur[j]);
                win[0][j] = win[1][j]; win[1][j] = win[2][j]; win[2][j] = cur[j]; }
            if (isx) { const int h = F.wave; float sc = dts[l * 4 + h]; if (STAGE == 1) sc *= __expf(acs[63 * 4 + h] - acs[l * 4 + h]);
#pragma unroll
                for (int j = 0; j < 8; ++j) o[j] *= sc; }
            if (tr) {
#pragma unroll
                for (int j = 0; j < 8; ++j) { if (i & 1) pkT[j][i >> 1] = pk2(prev[j], o[j]); else prev[j] = o[j]; } }
            else { u32x4 w; w.x = pk2(o[0], o[1]); w.y = pk2(o[2], o[3]); w.z = pk2(o[4], o[5]); w.w = pk2(o[6], o[7]);
                *(LAS u32x4*)(Cg + (F.wave < 6 ? (MB_BG - MB_CG) / 2 : 0) + ((F.wave & 1) * 64 + l) * 72 + (c0 & 63)) = w; } }
        if (tr) { LAS bf16_t* dstT = XT + F.wave * 64 * 72;
#pragma unroll
            for (int j = 0; j < 8; ++j) *(LAS u32x4*)(dstT + ((c0 & 63) + j) * 72 + tg * 8) = (u32x4){pkT[j][0], pkT[j][1], pkT[j][2], pkT[j][3]}; } }
    const int g4 = F.lane >> 4, r16 = F.lane & 15;
    if (STAGE == 1) {
        __syncthreads();
        float* MST = (float*)(F.ws + WS_MST) + ((size_t)(b * 64 + c) * 4) * 4096;
#pragma unroll
        for (int q = 0; q < 8; ++q) { const int tix = F.wave * 8 + q, h = tix >> 4, mt = (tix >> 2) & 3, nt = tix & 3;
            f32x4 acc = (f32x4){0.f, 0.f, 0.f, 0.f};
            acc = mma_nt<64>(XT + (h * 64 + mt * 16) * 72, 72, BT + ((h >> 1) * 64 + nt * 16) * 72, 72, acc, F.lane);
#pragma unroll
            for (int i = 0; i < 4; ++i) MST[(size_t)h * 4096 + (mt * 16 + 4 * g4 + i) * 64 + nt * 16 + r16] = acc[i]; }
        if (F.tid < 4) ((float*)(F.ws + WS_MDEC))[(b * 64 + c) * 4 + F.tid] = __expf(acs[63 * 4 + F.tid]);
    } else {
        const int mt = F.wave & 3, nh = F.wave >> 2;
        bf16_t zz[4][2][4];
#pragma unroll
        for (int h = 0; h < 4; ++h)
#pragma unroll
            for (int q = 0; q < 2; ++q)
#pragma unroll
                for (int i = 0; i < 4; ++i) zz[h][q][i] = U[(T0 + mt * 16 + 4 * g4 + i) * NINP + UM + h * 64 + (2 * nh + q) * 16 + r16];
        __syncthreads();
        f32x4 yv[4][2];
#pragma unroll
        for (int g = 0; g < 2; ++g)
#pragma unroll
            for (int q = 0; q < 2; ++q) { f32x4 G = (f32x4){0.f, 0.f, 0.f, 0.f};
                G = mma_nt<64>(Bg + (g * 64 + (2 * nh + q) * 16) * 72, 72, Cg + (g * 64 + mt * 16) * 72, 72, G, F.lane);
                const int s0 = (2 * nh + q) * 16 + 4 * g4, l = mt * 16 + r16;
#pragma unroll
                for (int hh = 0; hh < 2; ++hh) { const int h = 2 * g + hh; const float al = acs[l * 4 + h]; float v[4];
#pragma unroll
                    for (int i = 0; i < 4; ++i) v[i] = (s0 + i <= l) ? G[i] * __expf(al - acs[(s0 + i) * 4 + h]) : 0.f;
                    *(LAS u32x2*)(Mb + (h * 64 + l) * 72 + s0) = (u32x2){pk2(v[0], v[1]), pk2(v[2], v[3])}; } }
        __syncthreads();
#pragma unroll
        for (int h = 0; h < 4; ++h) { const int g = h >> 1;
#pragma unroll
            for (int q = 0; q < 2; ++q) { const int nt = 2 * nh + q;
                f32x4 yd = (f32x4){0.f, 0.f, 0.f, 0.f}, yo = (f32x4){0.f, 0.f, 0.f, 0.f};
                yd = mma_nt<64>(Mb + (h * 64 + mt * 16) * 72, 72, XT + (h * 64 + nt * 16) * 72, 72, yd, F.lane);
                yo = mma_nt<64>(Cg + (g * 64 + mt * 16) * 72, 72, S0 + (h * 64 + nt * 16) * 72, 72, yo, F.lane);
                const int p = nt * 16 + r16; const float dsk = F.in[I_MD][layer * 4 + h];
#pragma unroll
                for (int i = 0; i < 4; ++i) { const int l = mt * 16 + 4 * g4 + i;
                    const float xs = bf2f(XT[(h * 64 + p) * 72 + l]) / dts[l * 4 + h];
                    yv[h][q][i] = yd[i] + yo[i] * __expf(acs[l * 4 + h]) + dsk * xs; } } }
        float part[4] = {0.f, 0.f, 0.f, 0.f};
#pragma unroll
        for (int h = 0; h < 4; ++h)
#pragma unroll
            for (int q = 0; q < 2; ++q) {
#pragma unroll
                for (int i = 0; i < 4; ++i) { const float z = bf2f(zz[h][q][i]);
                    const float v = yv[h][q][i] * siluf_(z); yv[h][q][i] = v; part[i] += v * v; } }
#pragma unroll
        for (int i = 0; i < 4; ++i) { const float s = sum16(part[i]); if (r16 == 0) atomicAdd((float*)(rs + mt * 16 + 4 * g4 + i), s); }
        __syncthreads();
        bf16_t* Y = (bf16_t*)(F.ws + WS_H);
#pragma unroll
        for (int i = 0; i < 4; ++i) { const int l = mt * 16 + 4 * g4 + i; const float rstd = rsqrtf(rs[l] * (1.0f / 256.0f) + 1e-6f);
#pragma unroll
            for (int h = 0; h < 4; ++h)
#pragma unroll
                for (int q = 0; q < 2; ++q) { const int ch = h * 64 + (2 * nh + q) * 16 + r16;
                    Y[(T0 + l) * DM + ch] = f2bf(yv[h][q][i] * rstd * F.in[I_MNORM][layer * 256 + ch]); } }
    }
}
__device__ __forceinline__ void item_mamba_carry(const Frame& F_, int item) { Frame F = relocal(F_);
    const int b = item >> 2, h = item & 3;
    float* MST = (float*)(F.ws + WS_MST); const float* MD = (const float*)(F.ws + WS_MDEC);
    float s[8];
#pragma unroll
    for (int j = 0; j < 8; ++j) s[j] = 0.f;
    for (int c = 0; c < 64; ++c) { float* p = MST + ((size_t)(b * 64 + c) * 4 + h) * 4096 + F.tid * 8; const float d = MD[(b * 64 + c) * 4 + h];
        const f32x4 a = *(f32x4*)p, q = *(f32x4*)(p + 4);
        *(f32x4*)p = (f32x4){s[0], s[1], s[2], s[3]}; *(f32x4*)(p + 4) = (f32x4){s[4], s[5], s[6], s[7]};
        s[0] = s[0] * d + a[0]; s[1] = s[1] * d + a[1]; s[2] = s[2] * d + a[2]; s[3] = s[3] * d + a[3];
        s[4] = s[4] * d + q[0]; s[5] = s[5] * d + q[1]; s[6] = s[6] * d + q[2]; s[7] = s[7] * d + q[3]; }
}

template <int STAGE> __device__ __forceinline__ void item_s5(const Frame& F_, int layer, int item) { Frame F = relocal(F_);
    const bf16_t* U = (const bf16_t*)(F.ws + WS_U);
    const int b = item >> 6, c = item & 63; const size_t T0 = (size_t)b * SEQ + c * 64;
    LAS bf16_t* us = (LAS bf16_t*)F.lds;
    LAS bf16_t* BuW = (LAS bf16_t*)(F.lds + 33792) + F.wave * 4224;
    const float* tab = (const float*)(F.ws + WS_S5TAB + (size_t)layer * S5TAB_L);
    { const int tok = F.tid >> 3, part = F.tid & 7;
#pragma unroll
      for (int q = 0; q < 4; ++q) *(LAS u32x4*)(us + tok * 264 + 32 * part + 8 * q) = *(const u32x4*)(U + (T0 + tok) * NINP + US + 32 * part + 8 * q); }
    const int lane = F.lane, r16 = lane & 15, g4 = lane >> 4, gq = lane >> 5, n0 = lane & 31, g = 2 * F.wave + gq, gn0 = g * 64 + n0, gn1 = gn0 + 32;
    bf16x8 bfr[2][8];
    { const bf16_t* bbt = (const bf16_t*)(F.ws + WS_S5TAB + (size_t)layer * S5TAB_L + S5TAB_BBT);
#pragma unroll
      for (int gg = 0; gg < 2; ++gg)
#pragma unroll
          for (int nt = 0; nt < 8; ++nt) { u32x4 z = (u32x4){0u, 0u, 0u, 0u}; if (g4 < 2) z = *(const u32x4*)(bbt + ((size_t)(2 * F.wave + gg) * 128 + 16 * nt + r16) * 16 + 8 * g4); bfr[gg][nt] = __builtin_bit_cast(bf16x8, z); } }
    const float a0r = tab[gn0 * 2], a0i = tab[gn0 * 2 + 1], a1r = tab[gn1 * 2], a1i = tab[gn1 * 2 + 1];
    float* ST = (float*)(F.ws + WS_S5ST) + (size_t)(b * 64 + c) * 2048;
    float h0r = 0.f, h0i = 0.f, h1r = 0.f, h1i = 0.f;
    if (STAGE == 2) { h0r = ST[gn0 * 2]; h0i = ST[gn0 * 2 + 1]; h1r = ST[gn1 * 2]; h1i = ST[gn1 * 2 + 1]; }
    bf16x8 cf[2][4];
    if (STAGE == 2) { const bf16_t* cm = (const bf16_t*)(F.ws + WS_S5TAB + (size_t)layer * S5TAB_L + S5TAB_F);
#pragma unroll
        for (int gg = 0; gg < 2; ++gg)
#pragma unroll
            for (int ks = 0; ks < 4; ++ks) cf[gg][ks] = *(const bf16x8*)(cm + ((size_t)((2 * F.wave + gg) * 16 + r16)) * 128 + 32 * ks + 8 * g4); }
    LAS bf16_t* YSl = (LAS bf16_t*)(F.lds + 101376);
    const bf16_t* GW = (const bf16_t*)(F.ws + WS_GLU) + (size_t)layer * 512 * 256;
    float dsk[2] = {0.f, 0.f}, bvl[2] = {0.f, 0.f}, bgt[2] = {0.f, 0.f}; bf16x8 gwb[2][4];
    if (STAGE == 2) {
#pragma unroll
        for (int gg = 0; gg < 2; ++gg) dsk[gg] = F.in[I_SD][layer * 256 + (2 * F.wave + gg) * 16 + r16];
#pragma unroll
        for (int q = 0; q < 2; ++q) { const int c = 32 * F.wave + 16 * q + r16; bvl[q] = F.in[I_SGLUB][layer * 512 + c]; bgt[q] = F.in[I_SGLUB][layer * 512 + 256 + c]; }
#pragma unroll
        for (int ks = 0; ks < 2; ++ks)
#pragma unroll
            for (int q = 0; q < 2; ++q) { const int c = 32 * F.wave + 16 * q + r16; const int rowv = 256 * (c >> 7) + (c & 127);
                gwb[ks][2 * q] = *(const bf16x8*)(GW + (size_t)rowv * 256 + 32 * ks + 8 * g4); gwb[ks][2 * q + 1] = *(const bf16x8*)(GW + (size_t)(rowv + 128) * 256 + 32 * ks + 8 * g4); } }
    __syncthreads();
#pragma unroll 1
    for (int lb = 0; lb < 4; ++lb) {
#pragma unroll
        for (int gg = 0; gg < 2; ++gg) { u32x4 z = (u32x4){0u, 0u, 0u, 0u}; if (g4 < 2) z = *(const LAS u32x4*)(us + (16 * lb + r16) * 264 + (2 * F.wave + gg) * 16 + 8 * g4);
            const bf16x8 afr = __builtin_bit_cast(bf16x8, z);
#pragma unroll
            for (int nt = 0; nt < 8; ++nt) { const f32x4 acc = __builtin_amdgcn_mfma_f32_16x16x32_bf16(bfr[gg][nt], afr, (f32x4){0.f, 0.f, 0.f, 0.f}, 0, 0, 0);
                *(LAS u32x2*)(BuW + r16 * 264 + gg * 128 + 16 * nt + 4 * g4) = (u32x2){pk2(acc[0], acc[1]), pk2(acc[2], acc[3])}; } }
        __syncthreads();
#pragma unroll 4
        for (int li = 0; li < 16; ++li) { LAS u32x2* bp = (LAS u32x2*)(BuW + li * 264 + gq * 128 + 4 * n0); const u32x2 v = *bp;
            { const float br = __uint_as_float(v.x << 16), bi = __uint_as_float(v.x & 0xffff0000u); const float nr = a0r * h0r - a0i * h0i + br, ni = a0r * h0i + a0i * h0r + bi; h0r = nr; h0i = ni; }
            { const float br = __uint_as_float(v.y << 16), bi = __uint_as_float(v.y & 0xffff0000u); const float nr = a1r * h1r - a1i * h1i + br, ni = a1r * h1i + a1i * h1r + bi; h1r = nr; h1i = ni; }
            if (STAGE == 2) *bp = (u32x2){pk2(h0r, h0i), pk2(h1r, h1i)}; }
        __syncthreads();
        if (STAGE == 2) {
#pragma unroll
            for (int gg = 0; gg < 2; ++gg) { f32x4 acc = (f32x4){0.f, 0.f, 0.f, 0.f};
#pragma unroll
                for (int ks = 0; ks < 4; ++ks) { const bf16x8 a = *(const LAS bf16x8*)(BuW + r16 * 264 + gg * 128 + 32 * ks + 8 * g4);
                    acc = __builtin_amdgcn_mfma_f32_16x16x32_bf16(a, cf[gg][ks], acc, 0, 0, 0); }
                const int ch = (2 * F.wave + gg) * 16 + r16;
#pragma unroll
                for (int i = 0; i < 4; ++i) { const int l = lb * 16 + 4 * g4 + i; const float y = acc[i] + dsk[gg] * bf2f(us[l * 264 + ch]);
                    YSl[l * 264 + ch] = f2bf(gelu_tanh(y)); } }
            __syncthreads();
        }
    }
    if (STAGE == 1) { ST[gn0 * 2] = h0r; ST[gn0 * 2 + 1] = h0i; ST[gn1 * 2] = h1r; ST[gn1 * 2 + 1] = h1i; }
    if (STAGE == 2) {
        f32x4 av[4][2], ag[4][2];
#pragma unroll
        for (int m = 0; m < 4; ++m)
#pragma unroll
            for (int q = 0; q < 2; ++q) { av[m][q] = (f32x4){0.f, 0.f, 0.f, 0.f}; ag[m][q] = (f32x4){0.f, 0.f, 0.f, 0.f}; }
#pragma unroll
        for (int ks = 0; ks < 8; ++ks) {
            bf16x8 af[4], bcur[4];
#pragma unroll
            for (int j = 0; j < 4; ++j) bcur[j] = gwb[ks & 1][j];
            if (ks + 2 < 8) {
#pragma unroll
                for (int q = 0; q < 2; ++q) { const int c = 32 * F.wave + 16 * q + r16; const int rowv = 256 * (c >> 7) + (c & 127);
                    gwb[ks & 1][2 * q] = *(const bf16x8*)(GW + (size_t)rowv * 256 + 32 * (ks + 2) + 8 * g4); gwb[ks & 1][2 * q + 1] = *(const bf16x8*)(GW + (size_t)(rowv + 128) * 256 + 32 * (ks + 2) + 8 * g4); } }
#pragma unroll
            for (int m = 0; m < 4; ++m) af[m] = *(const LAS bf16x8*)(YSl + (16 * m + r16) * 264 + 32 * ks + 8 * g4);
#pragma unroll
            for (int m = 0; m < 4; ++m)
#pragma unroll
                for (int q = 0; q < 2; ++q) { av[m][q] = __builtin_amdgcn_mfma_f32_16x16x32_bf16(af[m], bcur[2 * q], av[m][q], 0, 0, 0); ag[m][q] = __builtin_amdgcn_mfma_f32_16x16x32_bf16(af[m], bcur[2 * q + 1], ag[m][q], 0, 0, 0); }
        }
        bf16_t* Y = (bf16_t*)(F.ws + WS_H);
#pragma unroll
        for (int q = 0; q < 2; ++q) { const int c = 32 * F.wave + 16 * q + r16;
#pragma unroll
            for (int m = 0; m < 4; ++m)
#pragma unroll
                for (int i = 0; i < 4; ++i) Y[(T0 + 16 * m + 4 * g4 + i) * DM + 768 + c] = f2bf((av[m][q][i] + bvl[q]) * sigmoidf_(ag[m][q][i] + bgt[q])); }
    }
}
__device__ __forceinline__ void item_s5_carry(const Frame& F_, int layer, int b) { Frame F = relocal(F_);
    const float* tab = (const float*)(F.ws + WS_S5TAB + (size_t)layer * S5TAB_L) + 2048;
    float* ST = (float*)(F.ws + WS_S5ST) + (size_t)b * 64 * 2048;
#pragma unroll
    for (int q = 0; q < 2; ++q) { const int gn = F.tid + 512 * q; const float pr = tab[gn * 2], pi = tab[gn * 2 + 1]; float hr = 0.f, hi = 0.f;
        for (int c = 0; c < 64; ++c) { float* p = ST + (size_t)c * 2048 + gn * 2; const float tr = p[0], ti = p[1]; p[0] = hr; p[1] = hi;
            const float nr = pr * hr - pi * hi + tr, ni = pr * hi + pi * hr + ti; hr = nr; hi = ni; } }
}

constexpr int RB_LD = 72;
constexpr int RW_R = 0, RW_K = 16384, RW_V = 32768, RW_W = 49152, RW_A = 65536, RW_B = 81920;
constexpr int R3_G = 49152, R3_O = 65536, R3_TILES = 81920, R3_BON = 147456;
template <int STAGE> __device__ __forceinline__ void rwkv_prep(const Frame& F_, int layer, int b, int h, int c) { Frame F = relocal(F_);
    const bf16_t* U = (const bf16_t*)(F.ws + WS_U);
    const int l0 = c * 64; const size_t T0 = (size_t)b * SEQ + l0;
    LAS float* Rr = (LAS float*)(F.lds + RW_R); LAS float* Kk = (LAS float*)(F.lds + RW_K); LAS float* Vv = (LAS float*)(F.lds + RW_V); LAS float* Ww = (LAS float*)(F.lds + RW_W);
    LAS float* Aa = (LAS float*)(F.lds + (STAGE == 1 ? RW_A : R3_O)); LAS float* Bb = (LAS float*)(F.lds + RW_B); LAS float* Gg = (LAS float*)(F.lds + R3_G); LAS float* BON = (LAS float*)(F.lds + R3_BON);
    LAS bf16_t* TWb = (LAS bf16_t*)(F.lds + 98304); LAS bf16_t* DAb = (LAS bf16_t*)(F.lds + (STAGE == 1 ? 103424 : 118784)); LAS bf16_t* SGb = (LAS bf16_t*)(F.lds + 123904);
    LAS bf16_t* w2T = (LAS bf16_t*)(F.lds + 108544); LAS bf16_t* a2T = (LAS bf16_t*)(F.lds + (STAGE == 1 ? 113664 : 133120)); LAS bf16_t* g2T = (LAS bf16_t*)(F.lds + 138240);
    const float* mu = F.in[I_RMU] + layer * 896;
    float pw0[2] = {0.f, 0.f}, pa0[2] = {0.f, 0.f}; f32x4 pkkw[2], pkaw[2], prk[2];
    if (STAGE == 1) { const int cgl = layer * 256 + h * 64 + 8 * (F.tid & 7);
#pragma unroll
        for (int q = 0; q < 2; ++q) { pkkw[q] = *(const f32x4*)(F.in[I_RKK] + cgl + 4 * q); pkaw[q] = *(const f32x4*)(F.in[I_RKA] + cgl + 4 * q); prk[q] = *(const f32x4*)(F.in[I_RRK] + cgl + 4 * q); }
#pragma unroll
        for (int q = 0; q < 2; ++q) { const int cg = layer * 256 + h * 64 + 16 * (2 * (F.wave & 1) + q) + (F.lane & 15); pw0[q] = F.in[I_RW0][cg]; pa0[q] = F.in[I_RA0][cg]; } }
    { const int tok = F.tid >> 3, p8 = F.tid & 7; const bool first = (l0 + tok == 0);
      const bf16_t* cur = U + (T0 + tok) * NINP + UR; const bf16_t* prv = first ? cur : cur - NINP;
      const float pz = first ? 0.f : 1.f;
      u32x4 cw[3], pw[3]; u32x2 c1 = (u32x2){0u, 0u}, p1 = (u32x2){0u, 0u}, c2 = (u32x2){0u, 0u}, p2 = (u32x2){0u, 0u}; u32x4 c3 = (u32x4){0u, 0u, 0u, 0u}, p3 = (u32x4){0u, 0u, 0u, 0u};
#pragma unroll
      for (int sec = (STAGE == 1 ? 0 : 2); sec < 3; ++sec) { const int co = sec * 256 + h * 64 + 8 * p8; cw[sec] = *(const u32x4*)(cur + co); pw[sec] = *(const u32x4*)(prv + co); }
      if (STAGE == 1) { c1 = *(const u32x2*)(cur + 768 + 4 * p8); p1 = *(const u32x2*)(prv + 768 + 4 * p8); c2 = *(const u32x2*)(cur + 800 + 4 * p8); p2 = *(const u32x2*)(prv + 800 + 4 * p8); }
      if (STAGE == 3) { c3 = *(const u32x4*)(cur + 832 + 8 * p8); p3 = *(const u32x4*)(prv + 832 + 8 * p8); }
#pragma unroll
      for (int sec = (STAGE == 1 ? 0 : 2); sec < 3; ++sec) { const int co = sec * 256 + h * 64 + 8 * p8; float av[8], pq[8]; unpack8(cw[sec], av); unpack8(pw[sec], pq);
          const f32x4 m0 = *(const f32x4*)(mu + co), m1 = *(const f32x4*)(mu + co + 4);
          LAS float* dst = (sec == 0 ? Rr : sec == 1 ? Kk : Vv) + tok * 64 + 8 * p8;
#pragma unroll
          for (int j = 0; j < 8; ++j) pq[j] *= pz;
          *(LAS f32x4*)dst = (f32x4){av[0] + m0[0] * (pq[0] - av[0]), av[1] + m0[1] * (pq[1] - av[1]), av[2] + m0[2] * (pq[2] - av[2]), av[3] + m0[3] * (pq[3] - av[3])};
          *(LAS f32x4*)(dst + 4) = (f32x4){av[4] + m1[0] * (pq[4] - av[4]), av[5] + m1[1] * (pq[5] - av[5]), av[6] + m1[2] * (pq[6] - av[6]), av[7] + m1[3] * (pq[7] - av[7])}; }
      if (STAGE == 1) {
#pragma unroll
        for (int which = 0; which < 2; ++which) { const int co = 768 + 32 * which + 4 * p8; const u32x2 cv = which ? c2 : c1, pv = which ? p2 : p1;
          const f32x4 m0 = *(const f32x4*)(mu + co);
          float x[4] = {__uint_as_float(cv.x << 16), __uint_as_float(cv.x & 0xffff0000u), __uint_as_float(cv.y << 16), __uint_as_float(cv.y & 0xffff0000u)};
          const float y[4] = {pz * __uint_as_float(pv.x << 16), pz * __uint_as_float(pv.x & 0xffff0000u), pz * __uint_as_float(pv.y << 16), pz * __uint_as_float(pv.y & 0xffff0000u)};
#pragma unroll
          for (int j = 0; j < 4; ++j) { x[j] = x[j] + m0[j] * (y[j] - x[j]); if (which == 0) x[j] = tanhf_(x[j]); }
          *(LAS u32x2*)((which ? DAb : TWb) + tok * 40 + 4 * p8) = (u32x2){pk2(x[0], x[1]), pk2(x[2], x[3])}; } }
      if (STAGE == 3) { const int co = 832 + 8 * p8; float av[8], pq[8]; unpack8(c3, av); unpack8(p3, pq);
          const f32x4 m0 = *(const f32x4*)(mu + co), m1 = *(const f32x4*)(mu + co + 4); float x[8];
#pragma unroll
          for (int j = 0; j < 8; ++j) x[j] = sigmoidf_(av[j] + (j < 4 ? m0[j] : m1[j - 4]) * (pz * pq[j] - av[j]));
          *(LAS u32x4*)(SGb + tok * RB_LD + 8 * p8) = (u32x4){pk2(x[0], x[1]), pk2(x[2], x[3]), pk2(x[4], x[5]), pk2(x[6], x[7])}; } }
    { const int ch = F.tid & 63, part = F.tid >> 6;
      if (STAGE == 1) { const float* w2 = F.in[I_RW2] + ((size_t)layer * 32 + 4 * part) * 256 + h * 64 + ch;
          *(LAS u32x2*)(w2T + ch * 40 + 4 * part) = (u32x2){pk2(w2[0], w2[256]), pk2(w2[512], w2[768])}; }
      if (STAGE == 1) { const float* a2 = F.in[I_RA2] + ((size_t)layer * 32 + 4 * part) * 256 + h * 64 + ch;
          *(LAS u32x2*)(a2T + ch * 40 + 4 * part) = (u32x2){pk2(a2[0], a2[256]), pk2(a2[512], a2[768])}; }
      if (STAGE == 3) { const float* g2 = F.in[I_RG2] + ((size_t)layer * 64 + 8 * part) * 256 + h * 64 + ch;
          *(LAS u32x4*)(g2T + ch * RB_LD + 8 * part) = (u32x4){pk2(g2[0], g2[256]), pk2(g2[512], g2[768]), pk2(g2[1024], g2[1280]), pk2(g2[1536], g2[1792])}; } }
    __syncthreads();
    { const int lane = F.lane, mt = F.wave >> 1, nt0 = 2 * (F.wave & 1), r = lane & 15, g4 = lane >> 4; const f32x4 zero4 = (f32x4){0.f, 0.f, 0.f, 0.f};
#pragma unroll
      for (int q = 0; q < 2; ++q) { const int nt = nt0 + q, ch = 16 * nt + r;
          if (STAGE == 1) { const f32x4 wl = mma_nt<32>(TWb + 16 * mt * 40, 40, w2T + 16 * nt * 40, 40, zero4, lane); const float w0 = pw0[q];
#pragma unroll
              for (int i = 0; i < 4; ++i) { const float x = w0 + wl[i]; const float wlog = -__logf(1.0f + __expf(-x)) - 0.5f; Ww[(16 * mt + 4 * g4 + i) * 64 + ch] = __expf(-__expf(wlog)); } }
          if (STAGE == 1) { const f32x4 al = mma_nt<32>(DAb + 16 * mt * 40, 40, a2T + 16 * nt * 40, 40, zero4, lane); const float a0 = pa0[q];
#pragma unroll
              for (int i = 0; i < 4; ++i) Aa[(16 * mt + 4 * g4 + i) * 64 + ch] = sigmoidf_(a0 + al[i]); }
          if (STAGE == 3) { const f32x4 gv = mma_nt<64>(SGb + 16 * mt * RB_LD, RB_LD, g2T + 16 * nt * RB_LD, RB_LD, zero4, lane);
#pragma unroll
              for (int i = 0; i < 4; ++i) Gg[(16 * mt + 4 * g4 + i) * 64 + ch] = gv[i]; } } }
    __syncthreads();
    float* gBON = (float*)(F.ws + WS_BON) + ((size_t)(b * 4 + h) * 64 + c) * 64;
    if (STAGE == 1) { const int t = F.tid >> 3, p8 = F.tid & 7;
      LAS float* pa = Aa + t * 64 + 8 * p8; LAS float* pk = Kk + t * 64 + 8 * p8; LAS float* pr = Rr + t * 64 + 8 * p8; LAS float* pb = Bb + t * 64 + 8 * p8;
      float kp[8], kkv[8], av[8]; float ss = 0.f, bo = 0.f;
#pragma unroll
      for (int q = 0; q < 2; ++q) { const f32x4 a4 = *(const LAS f32x4*)(pa + 4 * q), k4 = *(const LAS f32x4*)(pk + 4 * q), r4 = *(const LAS f32x4*)(pr + 4 * q);
#pragma unroll
          for (int j = 0; j < 4; ++j) { const float a = a4[j], kraw = k4[j]; av[4 * q + j] = a; kp[4 * q + j] = kraw * (1.0f + (a - 1.0f) * pkaw[q][j]);
              kkv[4 * q + j] = kraw * pkkw[q][j]; ss += kkv[4 * q + j] * kkv[4 * q + j]; bo += r4[j] * kp[4 * q + j] * prk[q][j]; } }
      ss = sum8(ss); bo = sum8(bo);
      const float rn = rsqrtf(fmaxf(ss, 1e-24f));
#pragma unroll
      for (int q = 0; q < 2; ++q) { f32x4 ko, ao, bq;
#pragma unroll
          for (int j = 0; j < 4; ++j) { const float kkn = kkv[4 * q + j] * rn; ko[j] = kp[4 * q + j]; ao[j] = -kkn; bq[j] = kkn * av[4 * q + j]; }
          *(LAS f32x4*)(pk + 4 * q) = ko; *(LAS f32x4*)(pa + 4 * q) = ao; *(LAS f32x4*)(pb + 4 * q) = bq; }
      if (p8 == 0) gBON[t] = bo; }
    else if (F.tid < 64) BON[F.tid] = gBON[F.tid];
    __syncthreads();
}
constexpr int RB_AT = 98304, RB_ATT = RB_AT + 9216, RB_BT = RB_ATT + 9216, RB_BTT = RB_BT + 9216, RB_KT = RB_BTT + 9216, RB_RT = RB_KT + 9216, RB_VT = RB_RT + 9216, RB_GC = RB_VT + 9216;
constexpr int RX_X = 0, RX_XT = 9216, RX_TB = 18432, RX_M = 27648, RX_NRT = 36864, RX_G1T = 46080, RX_G2T = 55296, RX_QT = 64512;
__device__ __forceinline__ void st_tile(LAS bf16_t* dst, int mt, int nt, const f32x4 v, int lane) {
    const int r = lane & 15, g = lane >> 4;
#pragma unroll
    for (int i = 0; i < 4; ++i) dst[(16 * mt + 4 * g + i) * RB_LD + 16 * nt + r] = f2bf(v[i]);
}
__device__ __forceinline__ void st_tile_t(LAS bf16_t* dst, int mt, int nt, const f32x4 v, int lane) {
    const int r = lane & 15, g = lane >> 4; u32x2 w; w.x = pk2(v[0], v[1]); w.y = pk2(v[2], v[3]);
    *(LAS u32x2*)(dst + (16 * nt + r) * RB_LD + 16 * mt + 4 * g) = w;
}
__device__ __forceinline__ void ld_fr(const LAS bf16_t* M, int row0, int lane, bf16x8 (&f)[2]) { const LAS bf16_t* p = M + (row0 + (lane & 15)) * RB_LD + 8 * (lane >> 4); f[0] = *(const LAS bf16x8*)p; f[1] = *(const LAS bf16x8*)(p + 32); }
__device__ __forceinline__ f32x4 mm_fr(const bf16x8 (&a)[2], const bf16x8 (&b)[2], f32x4 acc) { acc = __builtin_amdgcn_mfma_f32_16x16x32_bf16(a[0], b[0], acc, 0, 0, 0); return __builtin_amdgcn_mfma_f32_16x16x32_bf16(a[1], b[1], acc, 0, 0, 0); }
__device__ __forceinline__ void item_rwkv1(const Frame& F_, int layer, int item) { Frame F = relocal(F_);
    const int b = item >> 8, h = (item >> 6) & 3, c = item & 63;
    rwkv_prep<1>(F, layer, b, h, c);
    LAS float* Rr = (LAS float*)(F.lds + RW_R); LAS float* Kk = (LAS float*)(F.lds + RW_K); LAS float* Vv = (LAS float*)(F.lds + RW_V); LAS float* Ww = (LAS float*)(F.lds + RW_W);
    LAS float* Aa = (LAS float*)(F.lds + RW_A); LAS float* Bb = (LAS float*)(F.lds + RW_B);
    LAS bf16_t* At = (LAS bf16_t*)(F.lds + RB_AT); LAS bf16_t* AtT = (LAS bf16_t*)(F.lds + RB_ATT); LAS bf16_t* Bt = (LAS bf16_t*)(F.lds + RB_BT); LAS bf16_t* BtT = (LAS bf16_t*)(F.lds + RB_BTT);
    LAS bf16_t* Kt = (LAS bf16_t*)(F.lds + RB_KT); LAS bf16_t* Rt = (LAS bf16_t*)(F.lds + RB_RT); LAS bf16_t* VT = (LAS bf16_t*)(F.lds + RB_VT); LAS float* gC = (LAS float*)(F.lds + RB_GC);
    LAS bf16_t* X = (LAS bf16_t*)(F.lds + RX_X); LAS bf16_t* XT = (LAS bf16_t*)(F.lds + RX_XT); LAS bf16_t* Tb = (LAS bf16_t*)(F.lds + RX_TB); LAS bf16_t* Mm = (LAS bf16_t*)(F.lds + RX_M);
    LAS bf16_t* NrT = (LAS bf16_t*)(F.lds + RX_NRT); LAS bf16_t* G1T = (LAS bf16_t*)(F.lds + RX_G1T); LAS bf16_t* G2T = (LAS bf16_t*)(F.lds + RX_G2T); LAS bf16_t* QT = (LAS bf16_t*)(F.lds + RX_QT);
    { const int k = F.tid & 63, part = F.tid >> 6; float g = 1.0f;
      for (int pp = 0; pp < part; ++pp) { float w8[8];
#pragma unroll
          for (int i = 0; i < 8; ++i) w8[i] = Ww[(8 * pp + i) * 64 + k];
          g *= ((w8[0] * w8[1]) * (w8[2] * w8[3])) * ((w8[4] * w8[5]) * (w8[6] * w8[7])); }
      unsigned aT[4], bT[4], vT[4]; unsigned pa = 0u, pb = 0u, pv = 0u;
#pragma unroll
      for (int i = 0; i < 8; ++i) { const int t = 8 * part + i; const float gp = g; g *= Ww[t * 64 + k]; const float ig = __builtin_amdgcn_rcpf(g);
          const bf16_t av = f2bf(Aa[t * 64 + k] * gp), bv = f2bf(Bb[t * 64 + k] * ig), vv = f2bf(Vv[t * 64 + k]);
          At[t * RB_LD + k] = av; Bt[t * RB_LD + k] = bv;
          Kt[t * RB_LD + k] = f2bf(Kk[t * 64 + k] * ig); Rt[t * RB_LD + k] = f2bf(Rr[t * 64 + k] * g);
          if (i & 1) { aT[i >> 1] = pa | ((unsigned)av << 16); bT[i >> 1] = pb | ((unsigned)bv << 16); vT[i >> 1] = pv | ((unsigned)vv << 16); } else { pa = av; pb = bv; pv = vv; } }
      *(LAS u32x4*)(AtT + k * RB_LD + 8 * part) = (u32x4){aT[0], aT[1], aT[2], aT[3]}; *(LAS u32x4*)(BtT + k * RB_LD + 8 * part) = (u32x4){bT[0], bT[1], bT[2], bT[3]};
      *(LAS u32x4*)(VT + k * RB_LD + 8 * part) = (u32x4){vT[0], vT[1], vT[2], vT[3]};
      if (part == 7) gC[k] = g; }
    __syncthreads();
    const int lane = F.lane, mt = F.wave >> 1, nt0 = 2 * (F.wave & 1), r = lane & 15, g4 = lane >> 4;
    const f32x4 zero4 = (f32x4){0.f, 0.f, 0.f, 0.f};
    f32x4 Tacc[2];
    bf16x8 fa0[2], fa1[2], fa2[2], fb0[2][2], fb1[2][2], fb2[2][2];
    ld_fr(Bt, 16 * mt, lane, fa0); ld_fr(Kt, 16 * mt, lane, fa1); ld_fr(Rt, 16 * mt, lane, fa2);
#pragma unroll
    for (int q = 0; q < 2; ++q) { ld_fr(At, 16 * (nt0 + q), lane, fb0[q]); ld_fr(Bt, 16 * (nt0 + q), lane, fb1[q]); }
#pragma unroll
    for (int q = 0; q < 2; ++q) { const int nt = nt0 + q;
        f32x4 n = mm_fr(fa0, fb0[q], zero4);
        f32x4 m = mm_fr(fa1, fb0[q], zero4);
        f32x4 nr = mm_fr(fa2, fb1[q], zero4);
#pragma unroll
        for (int i = 0; i < 4; ++i) { const int row = 16 * mt + 4 * g4 + i, col = 16 * nt + r;
            n[i] = (row < col) ? n[i] : 0.f; m[i] = (row < col) ? m[i] : 0.f; nr[i] = (col <= row) ? nr[i] : 0.f;
            Tacc[q][i] = n[i] + (row == col ? 1.0f : 0.f); }
        st_tile(X, mt, nt, n, lane); st_tile_t(XT, mt, nt, n, lane); st_tile(Tb, mt, nt, Tacc[q], lane); st_tile(Mm, mt, nt, m, lane); st_tile(NrT, mt, nt, nr, lane); }
    __syncthreads();
#pragma unroll 1
    for (int it = 0; it < 6; ++it) {
        LAS bf16_t* Xr = (it & 1) ? G1T : X; LAS bf16_t* XTr = (it & 1) ? G2T : XT; LAS bf16_t* Tr = (it & 1) ? QT : Tb;
        LAS bf16_t* Xw = (it & 1) ? X : G1T; LAS bf16_t* XTw = (it & 1) ? XT : G2T; LAS bf16_t* Tw = (it & 1) ? Tb : QT;
        ld_fr(Tr, 16 * mt, lane, fa0); ld_fr(Xr, 16 * mt, lane, fa1);
#pragma unroll
        for (int q = 0; q < 2; ++q) ld_fr(XTr, 16 * (nt0 + q), lane, fb0[q]);
#pragma unroll
        for (int q = 0; q < 2; ++q) { const int nt = nt0 + q;
            if (it > 0) Tacc[q] = mm_fr(fa0, fb0[q], Tacc[q]);
            if (it < 5) { const f32x4 x2 = mm_fr(fa1, fb0[q], zero4); st_tile(Xw, mt, nt, x2, lane); st_tile_t(XTw, mt, nt, x2, lane); }
            st_tile(Tw, mt, nt, Tacc[q], lane); }
        __syncthreads();
    }
    ld_fr(NrT, 16 * mt, lane, fa0); ld_fr(BtT, 16 * mt, lane, fa1);
#pragma unroll
    for (int q = 0; q < 2; ++q) ld_fr(Tb, 16 * (nt0 + q), lane, fb0[q]);
#pragma unroll
    for (int q = 0; q < 2; ++q) { const int nt = nt0 + q;
        st_tile(G1T, mt, nt, mm_fr(fa0, fb0[q], zero4), lane);
        st_tile(G2T, mt, nt, mm_fr(fa1, fb0[q], zero4), lane); }
    __syncthreads();
    const size_t ci = (size_t)(b * 4 + h) * 64 + c;
    bf16_t* gPT = (bf16_t*)(F.ws + WS_MOE + RW_PT) + ci * 4096; bf16_t* gW1 = (bf16_t*)(F.ws + WS_MOE + RW_W1) + ci * 4096; bf16_t* gZ = (bf16_t*)(F.ws + WS_MOE + RW_Z) + ci * 4096;
    ld_fr(G1T, 16 * mt, lane, fa0); ld_fr(Rt, 16 * mt, lane, fa1); ld_fr(G2T, 16 * mt, lane, fa2);
#pragma unroll
    for (int q = 0; q < 2; ++q) { ld_fr(AtT, 16 * (nt0 + q), lane, fb0[q]); ld_fr(Mm, 16 * (nt0 + q), lane, fb1[q]); ld_fr(Kt, 16 * (nt0 + q), lane, fb2[q]); }
#pragma unroll
    for (int q = 0; q < 2; ++q) { const int nt = nt0 + q; const int col = 16 * nt + r;
        f32x4 w1 = mm_fr(fa0, fb0[q], zero4);
        f32x4 z = mm_fr(fa0, fb1[q], zero4);
        f32x4 mr = mm_fr(fa1, fb2[q], zero4);
        f32x4 p = mm_fr(fa2, fb0[q], zero4);
        f32x4 qq = mm_fr(fa2, fb1[q], zero4);
        const int pos = 32 * (col >> 5) + 8 * ((col >> 2) & 3) + 4 * ((col >> 4) & 1) + (col & 3);
#pragma unroll
        for (int i = 0; i < 4; ++i) { const int row = 16 * mt + 4 * g4 + i;
            gW1[row * 64 + col] = f2bf(w1[i] + bf2f(Rt[row * RB_LD + col]));
            gZ[row * 64 + col] = f2bf(z[i] + (col <= row ? mr[i] : 0.f));
            const float gc = gC[row];
            gPT[row * 64 + pos] = f2bf((p[i] + (row == col ? 1.0f : 0.f)) * gc);
            qq[i] = (qq[i] + bf2f(Kt[col * RB_LD + row])) * gc; }
        st_tile(QT, mt, nt, qq, lane); }
    __syncthreads();
    bf16_t* gU = (bf16_t*)(F.ws + WS_MOE + RW_U) + ci * 4096;
    ld_fr(VT, 16 * mt, lane, fa0);
#pragma unroll
    for (int q = 0; q < 2; ++q) ld_fr(QT, 16 * (nt0 + q), lane, fb0[q]);
#pragma unroll
    for (int q = 0; q < 2; ++q) { const int nt = nt0 + q;
        const f32x4 u = mm_fr(fa0, fb0[q], zero4);
#pragma unroll
        for (int i = 0; i < 4; ++i) gU[(16 * mt + 4 * g4 + i) * 64 + 16 * nt + r] = f2bf(u[i]); }
}
__device__ __forceinline__ void item_rwkv_carry(const Frame& F_, int item) { Frame F = relocal(F_);
    const int bh = item * 2 + (F.wave >> 2), nt = F.wave & 3, r = F.lane & 15, g = F.lane >> 4;
    const bf16_t* PT = (const bf16_t*)(F.ws + WS_MOE + RW_PT); const bf16_t* Uc = (const bf16_t*)(F.ws + WS_MOE + RW_U); bf16_t* Ss = (bf16_t*)(F.ws + WS_MOE + RW_S);
    f32x4 acc[4];
#pragma unroll
    for (int m = 0; m < 4; ++m) acc[m] = (f32x4){0.f, 0.f, 0.f, 0.f};
    for (int c = 0; c < 64; ++c) { const size_t ci = (size_t)bh * 64 + c;
        bf16x8 af[4][2]; f32x4 cin[4];
#pragma unroll
        for (int m = 0; m < 4; ++m) { const u32x2 uv = *(const u32x2*)(Uc + ci * 4096 + (16 * nt + r) * 64 + 16 * m + 4 * g);
            cin[m] = (f32x4){__uint_as_float(uv.x << 16), __uint_as_float(uv.x & 0xffff0000u), __uint_as_float(uv.y << 16), __uint_as_float(uv.y & 0xffff0000u)};
#pragma unroll
            for (int s = 0; s < 2; ++s) af[m][s] = *(const bf16x8*)(PT + ci * 4096 + (16 * m + r) * 64 + 32 * s + 8 * g); }
        unsigned pw[4][2];
#pragma unroll
        for (int m = 0; m < 4; ++m) { pw[m][0] = pk2(acc[m][0], acc[m][1]); pw[m][1] = pk2(acc[m][2], acc[m][3]);
            *(u32x2*)(Ss + ci * 4096 + (16 * nt + r) * 64 + 16 * m + 4 * g) = (u32x2){pw[m][0], pw[m][1]}; }
        bf16x8 bfr[2];
#pragma unroll
        for (int s = 0; s < 2; ++s) bfr[s] = __builtin_bit_cast(bf16x8, (u32x4){pw[2 * s][0], pw[2 * s][1], pw[2 * s + 1][0], pw[2 * s + 1][1]});
#pragma unroll
        for (int m = 0; m < 4; ++m) { acc[m] = __builtin_amdgcn_mfma_f32_16x16x32_bf16(af[m][0], bfr[0], cin[m], 0, 0, 0);
            acc[m] = __builtin_amdgcn_mfma_f32_16x16x32_bf16(af[m][1], bfr[1], acc[m], 0, 0, 0); }
    }
}
__device__ __forceinline__ void item_rwkv3(const Frame& F_, int layer, int item) { Frame F = relocal(F_);
    const int b = item >> 8, h = (item >> 6) & 3, c = item & 63; const size_t T0 = (size_t)b * SEQ + c * 64;
    const size_t ci3 = (size_t)(b * 4 + h) * 64 + c;
    const u32x4 tS = *(const u32x4*)((const bf16_t*)(F.ws + WS_MOE + RW_S) + ci3 * 4096 + F.tid * 8);
    const u32x4 tW = *(const u32x4*)((const bf16_t*)(F.ws + WS_MOE + RW_W1) + ci3 * 4096 + F.tid * 8);
    const u32x4 tZ = *(const u32x4*)((const bf16_t*)(F.ws + WS_MOE + RW_Z) + ci3 * 4096 + F.tid * 8);
    f32x4 lw4[2], lb4[2];
#pragma unroll
    for (int q = 0; q < 2; ++q) { lw4[q] = *(const f32x4*)(F.in[I_RLNW] + layer * 256 + h * 64 + 8 * (F.tid & 7) + 4 * q); lb4[q] = *(const f32x4*)(F.in[I_RLNB] + layer * 256 + h * 64 + 8 * (F.tid & 7) + 4 * q); }
    rwkv_prep<3>(F, layer, b, h, c);
    LAS float* Vv = (LAS float*)(F.lds + RW_V); LAS float* Oo = (LAS float*)(F.lds + R3_O);
    LAS float* Gg = (LAS float*)(F.lds + R3_G); LAS float* BON = (LAS float*)(F.lds + R3_BON);
    LAS bf16_t* S0b = (LAS bf16_t*)(F.lds + R3_TILES); LAS bf16_t* W1b = S0b + 4608; LAS bf16_t* Zb = W1b + 4608; LAS bf16_t* VTb = Zb + 4608;
    { const int row = F.tid >> 3, col = (F.tid & 7) * 8;
      *(LAS u32x4*)(S0b + row * RB_LD + col) = tS;
      *(LAS u32x4*)(W1b + row * RB_LD + col) = tW;
      *(LAS u32x4*)(Zb + row * RB_LD + col) = tZ;
      const int vv = F.tid & 63, part = F.tid >> 6;
      unsigned vT[4];
#pragma unroll
      for (int i = 0; i < 8; i += 2) vT[i >> 1] = pk2(Vv[(8 * part + i) * 64 + vv], Vv[(8 * part + i + 1) * 64 + vv]);
      *(LAS u32x4*)(VTb + vv * RB_LD + 8 * part) = (u32x4){vT[0], vT[1], vT[2], vT[3]}; }
    __syncthreads();
    { const int lane = F.lane, mt = F.wave >> 1, nt0 = 2 * (F.wave & 1), r = lane & 15, g4 = lane >> 4;
      bf16x8 fa0[2], fa1[2], fb0[2][2], fb1[2][2];
      ld_fr(W1b, 16 * mt, lane, fa0); ld_fr(Zb, 16 * mt, lane, fa1);
#pragma unroll
      for (int q = 0; q < 2; ++q) { ld_fr(S0b, 16 * (nt0 + q), lane, fb0[q]); ld_fr(VTb, 16 * (nt0 + q), lane, fb1[q]); }
#pragma unroll
      for (int q = 0; q < 2; ++q) { const int nt = nt0 + q;
          f32x4 o = mm_fr(fa0, fb0[q], (f32x4){0.f, 0.f, 0.f, 0.f});
          o = mm_fr(fa1, fb1[q], o);
#pragma unroll
          for (int i = 0; i < 4; ++i) Oo[(16 * mt + 4 * g4 + i) * 64 + 16 * nt + r] = o[i]; } }
    __syncthreads();
    { const int t = F.tid >> 3, p8 = F.tid & 7;
      float o[8]; float sm = 0.f;
#pragma unroll
      for (int q = 0; q < 2; ++q) { const f32x4 o4 = *(const LAS f32x4*)(Oo + t * 64 + 8 * p8 + 4 * q);
#pragma unroll
          for (int j = 0; j < 4; ++j) { o[4 * q + j] = o4[j]; sm += o4[j]; } }
      const float mean = sum8(sm) * (1.0f / 64.0f); float vs = 0.f;
#pragma unroll
      for (int j = 0; j < 8; ++j) { o[j] -= mean; vs += o[j] * o[j]; }
      const float rstd = rsqrtf(sum8(vs) * (1.0f / 64.0f) + 64e-5f); const float bon = BON[t];
      float y[8];
#pragma unroll
      for (int q = 0; q < 2; ++q) { const f32x4 v4 = *(const LAS f32x4*)(Vv + t * 64 + 8 * p8 + 4 * q), g4v = *(const LAS f32x4*)(Gg + t * 64 + 8 * p8 + 4 * q);
#pragma unroll
          for (int j = 0; j < 4; ++j) y[4 * q + j] = (o[4 * q + j] * rstd * lw4[q][j] + lb4[q][j] + bon * v4[j]) * g4v[j]; }
      *(u32x4*)((bf16_t*)(F.ws + WS_H) + (T0 + t) * DM + 256 + h * 64 + 8 * p8) = (u32x4){pk2(y[0], y[1]), pk2(y[2], y[3]), pk2(y[4], y[5]), pk2(y[6], y[7])}; }
}

constexpr int DS_SEL = 131072, DS_HIST = 135168, DS_BKT = 151552, DS_BIAS = 152064;
__device__ __forceinline__ void dsa_tables(const Frame& F_) { Frame F = relocal(F_);
    LAS int* bkt = (LAS int*)(F.lds + DS_BKT); LAS float* biasT = (LAS float*)(F.lds + DS_BIAS);
    if (F.tid < 128) { const int n = F.tid; int bk = n; if (n >= 16) { const float lr = logf((float)n / 16.0f) / 2.0794415416798357f; bk = 16 + (int)(lr * 16.0f); bk = bk < 31 ? bk : 31; } bkt[n] = bk; biasT[n] = F.in[I_RELB][n]; }
    __syncthreads();
}
__device__ __forceinline__ unsigned fkey(float f) { const unsigned u = __float_as_uint(f); return (u & 0x80000000u) ? ~u : (u | 0x80000000u); }
__device__ __forceinline__ void item_dsa(const Frame& F_, int layer, int item) { Frame F = relocal(F_);
    const bf16_t* U = (const bf16_t*)(F.ws + WS_U); const bf16_t* KI = (const bf16_t*)(F.ws + WS_KIDX);
    const bf16_t* Kb = (const bf16_t*)(F.ws + WS_K); const bf16_t* Vb = (const bf16_t*)(F.ws + WS_V);
    const int b = item & 3, qg = 511 - (item >> 2); const size_t TB = (size_t)b * SEQ, T0 = TB + qg * 8;
    LAS float* sc = (LAS float*)F.lds; LAS unsigned short* selall = (LAS unsigned short*)(F.lds + DS_SEL); LAS unsigned* histall = (LAS unsigned*)(F.lds + DS_HIST);
    LAS int* bkt = (LAS int*)(F.lds + DS_BKT); LAS float* biasT = (LAS float*)(F.lds + DS_BIAS);
    const int lane = F.lane, hh = lane >> 5;
    {
        bf16x8 af[2][2]; float wq[2][2][8];
        { const int r = lane & 31, q4 = 2 * ((r >> 2) & 1) + (r >> 4), head = 4 * ((r >> 3) & 1) + (r & 3);
#pragma unroll
          for (int mt = 0; mt < 2; ++mt)
#pragma unroll
              for (int ks = 0; ks < 2; ++ks) af[mt][ks] = *(const bf16x8*)(U + (T0 + 4 * mt + q4) * NINP + UC + 384 + head * 32 + 16 * ks + 8 * hh); }
#pragma unroll
        for (int mt = 0; mt < 2; ++mt)
#pragma unroll
            for (int q2 = 0; q2 < 2; ++q2) { float f[8]; unpack8(*(const u32x4*)(U + (T0 + 4 * mt + 2 * hh + q2) * NINP + UC + 672), f);
#pragma unroll
                for (int hd = 0; hd < 8; ++hd) wq[mt][q2][hd] = f[hd]; }
        const int ntile = (qg * 8 + 8 + 31) >> 5;
        bf16x8 nb0 = af[0][0], nb1 = af[0][0];
        if (F.wave < ntile) { const int key = F.wave * 32 + (lane & 31); nb0 = *(const bf16x8*)(KI + (TB + key) * 32 + 8 * hh); nb1 = *(const bf16x8*)(KI + (TB + key) * 32 + 16 + 8 * hh); }
        for (int kt = F.wave; kt < ntile; kt += 8) {
            const int key = kt * 32 + (lane & 31);
            const bf16x8 b0 = nb0, b1 = nb1;
            if (kt + 8 < ntile) { const int k2 = key + 256; nb0 = *(const bf16x8*)(KI + (TB + k2) * 32 + 8 * hh); nb1 = *(const bf16x8*)(KI + (TB + k2) * 32 + 16 + 8 * hh); }
#pragma unroll
            for (int mt = 0; mt < 2; ++mt) { f32x16 acc;
#pragma unroll
                for (int i = 0; i < 16; ++i) acc[i] = 0.f;
                acc = __builtin_amdgcn_mfma_f32_32x32x16_bf16(af[mt][0], b0, acc, 0, 0, 0);
                acc = __builtin_amdgcn_mfma_f32_32x32x16_bf16(af[mt][1], b1, acc, 0, 0, 0);
#pragma unroll
                for (int q2 = 0; q2 < 2; ++q2) { float s = 0.f;
#pragma unroll
                    for (int hd = 0; hd < 8; ++hd) s += fmaxf(acc[8 * q2 + hd], 0.f) * wq[mt][q2][hd];
                    const int qi = 4 * mt + 2 * hh + q2;
                    sc[qi * 4096 + key] = (key <= qg * 8 + qi) ? s : -INFINITY; } }
        }
    }
    __syncthreads();
    const int qi = F.wave, tq = qg * 8 + qi, n = tq + 1;
    LAS float* scq = sc + qi * 4096; LAS unsigned short* sel = selall + qi * 256; LAS unsigned* hist = histall + qi * 512;
    int nsel;
    if (n <= 256) { nsel = n; for (int j = lane; j < 256; j += 64) sel[j] = (unsigned short)(j < n ? j : 0); }
    else {
        nsel = 256;
        const int R = (n + 63) >> 6; const unsigned long long ltm = (1ull << lane) - 1ull;
        float lo = INFINITY, hi = -INFINITY;
        const int R4 = (n + 255) >> 8;
#pragma unroll 4
        for (int i = 0; i < R4; ++i) { const int j0 = 256 * i + 4 * lane; const f32x4 v4 = *(const LAS f32x4*)(scq + j0);
#pragma unroll
            for (int q = 0; q < 4; ++q) { const bool valid = j0 + q < n; lo = fminf(lo, valid ? v4[q] : INFINITY); hi = fmaxf(hi, valid ? v4[q] : -INFINITY); } }
        lo = wave_min(lo); hi = wave_max(hi);
        bool slow = false;
        if (!(hi > lo)) { for (int j = lane; j < 256; j += 64) sel[j] = (unsigned short)j; }
        else {
            const float scale = 1023.0f / (hi - lo);
            *(LAS u32x4*)(hist + 8 * lane) = (u32x4){0u, 0u, 0u, 0u}; *(LAS u32x4*)(hist + 8 * lane + 4) = (u32x4){0u, 0u, 0u, 0u};
#pragma unroll 2
            for (int i = 0; i < R4; ++i) { const int j0 = 256 * i + 4 * lane; const f32x4 v4 = *(const LAS f32x4*)(scq + j0);
#pragma unroll
                for (int q = 0; q < 4; ++q) { if (j0 + q < n) { int bk = (int)((v4[q] - lo) * scale); bk = bk < 1023 ? bk : 1023;
                    atomicAdd((unsigned*)(hist + (bk >> 1)), (bk & 1) ? 65536u : 1u); } } }
            const u32x4 h0 = *(const LAS u32x4*)(hist + 8 * lane), h1 = *(const LAS u32x4*)(hist + 8 * lane + 4);
            unsigned cb[16];
            cb[0] = h0.x & 0xffffu; cb[1] = h0.x >> 16; cb[2] = h0.y & 0xffffu; cb[3] = h0.y >> 16; cb[4] = h0.z & 0xffffu; cb[5] = h0.z >> 16; cb[6] = h0.w & 0xffffu; cb[7] = h0.w >> 16;
            cb[8] = h1.x & 0xffffu; cb[9] = h1.x >> 16; cb[10] = h1.y & 0xffffu; cb[11] = h1.y >> 16; cb[12] = h1.z & 0xffffu; cb[13] = h1.z >> 16; cb[14] = h1.w & 0xffffu; cb[15] = h1.w >> 16;
            unsigned tot = 0u;
#pragma unroll
            for (int q = 0; q < 16; ++q) tot += cb[q];
            const unsigned pre = wave_prefix_u(tot); const unsigned incl = (unsigned)__builtin_amdgcn_readlane((int)pre, 63) - pre + tot;
            int fb = -1; unsigned fabove = 0u, fcnt = 0u; unsigned cum = incl - tot;
#pragma unroll
            for (int q = 15; q >= 0; --q) { if (fb < 0 && cum < 256u && 256u <= cum + cb[q]) { fb = 16 * lane + q; fabove = cum; fcnt = cb[q]; } cum += cb[q]; }
            const unsigned long long mf = __ballot(fb >= 0); const int src = (int)__ffsll((long long)mf) - 1;
            const int B = __builtin_amdgcn_readlane(fb, src); const int above = __builtin_amdgcn_readlane((int)fabove, src), cntB = __builtin_amdgcn_readlane((int)fcnt, src); const int need = 256 - above;
            if (cntB > 256) slow = true;
            else {
                LAS unsigned* cand = hist;
                int base_gt = 0, base_c = 0;
#pragma unroll 2
                for (int i = 0; i < R4; ++i) { const int j0 = 256 * i + 4 * lane; const f32x4 v4 = *(const LAS f32x4*)(scq + j0);
#pragma unroll
                    for (int q = 0; q < 4; ++q) { const int j = j0 + q; const bool valid = j < n; const float v = valid ? v4[q] : lo;
                        int bk = (int)((v - lo) * scale); bk = bk < 1023 ? bk : 1023;
                        const bool gt = valid && bk > B, eq = valid && bk == B;
                        const unsigned long long mg = __ballot(gt), me = __ballot(eq);
                        if (gt) sel[base_gt + __popcll(mg & ltm)] = (unsigned short)j;
                        if (eq) { const int p = base_c + __popcll(me & ltm); cand[2 * p] = fkey(v); cand[2 * p + 1] = (unsigned)j; }
                        base_gt += __popcll(mg); base_c += __popcll(me); } }
                if (need == cntB) { for (int c = lane; c < cntB; c += 64) sel[above + c] = (unsigned short)cand[2 * c + 1]; }
                else {
                    unsigned ck[4], cx[4]; int rk[4];
#pragma unroll
                    for (int q = 0; q < 4; ++q) { const int c = lane + 64 * q; ck[q] = c < cntB ? cand[2 * c] : 0u; cx[q] = c < cntB ? cand[2 * c + 1] : 0u; rk[q] = 0; }
                    for (int c2 = 0; c2 < cntB; ++c2) { const unsigned k2 = cand[2 * c2], x2 = cand[2 * c2 + 1];
#pragma unroll
                        for (int q = 0; q < 4; ++q) rk[q] += (k2 > ck[q] || (k2 == ck[q] && x2 < cx[q])) ? 1 : 0; }
#pragma unroll
                    for (int q = 0; q < 4; ++q) { const int c = lane + 64 * q; if (c < cntB && rk[q] < need) sel[above + rk[q]] = (unsigned short)cand[2 * c + 1]; }
                }
            }
        }
        if (slow) {
        unsigned prefix = 0u; int need = 256; unsigned neq = 0u;
        for (int p = 0; p < 4; ++p) { const int shift = 24 - 8 * p;
            *(LAS u32x4*)(hist + 4 * lane) = (u32x4){0u, 0u, 0u, 0u};
            for (int i = 0; i < R; ++i) { const int j = lane + 64 * i; if (j < n) { const unsigned u = fkey(scq[j]);
                if (p == 0 || (u >> (shift + 8)) == prefix) atomicAdd((unsigned*)(hist + ((u >> shift) & 255u)), 1u); } }
            const u32x4 hv = *(const LAS u32x4*)(hist + 4 * lane);
            const unsigned tot = hv.x + hv.y + hv.z + hv.w;
            unsigned incl = tot;
#pragma unroll
            for (int o = 1; o < 64; o <<= 1) { const unsigned t = shdown_u(incl, o); if (lane + o < 64) incl += t; }
            const unsigned above = incl - tot;
            int fb = -1; unsigned fabove = 0u, feq = 0u; unsigned cum = above;
            { const unsigned hq[4] = {hv.x, hv.y, hv.z, hv.w};
#pragma unroll
              for (int q = 3; q >= 0; --q) { if (fb < 0 && cum < (unsigned)need && (unsigned)need <= cum + hq[q]) { fb = 4 * lane + q; fabove = cum; feq = hq[q]; } cum += hq[q]; } }
            const unsigned long long m = __ballot(fb >= 0);
            const int src = (int)__ffsll((long long)m) - 1;
            const int bin = shidx_i(fb, src); const unsigned ab = (unsigned)shidx_i((int)fabove, src); neq = (unsigned)shidx_i((int)feq, src);
            need -= (int)ab; prefix = (prefix << 8) | (unsigned)bin;
        }
        const int ngt = 256 - need;
        int base_gt = 0, base_eq = 0;
        for (int i = 0; i < R; ++i) { const int j = lane + 64 * i; const unsigned u = (j < n) ? fkey(scq[j]) : 0u;
            const bool gt = (j < n) && (u > prefix), eq = (j < n) && (u == prefix);
            const unsigned long long mg = __ballot(gt), me = __ballot(eq); const unsigned long long lt = (1ull << lane) - 1ull;
            if (gt) sel[base_gt + __popcll(mg & lt)] = (unsigned short)j;
            if (eq) { const int rk = base_eq + __popcll(me & lt); if (rk < need) sel[ngt + rk] = (unsigned short)j; }
            base_gt += __popcll(mg); base_eq += __popcll(me); }
        (void)neq;
            }
    }
    const int nt16 = (nsel + 15) >> 4, r16 = lane & 15, g4 = lane >> 4;
    LAS float* biasj = scq + 2048;
#pragma unroll
    for (int q = 0; q < 4; ++q) { const int j = lane + 64 * q; f32x4 bv = (f32x4){-INFINITY, -INFINITY, -INFINITY, -INFINITY};
        if (j < nsel) { const int dist = tq - (int)sel[j]; const int bk = dist < 128 ? bkt[dist < 0 ? 0 : dist] : 31; bv = *(const LAS f32x4*)(biasT + 4 * bk); }
        *(LAS f32x4*)(biasj + 4 * j) = bv; }
    bf16x8 qf[2];
#pragma unroll
    for (int s = 0; s < 2; ++s) { u32x4 z = (u32x4){0u, 0u, 0u, 0u}; if (r16 < 4) z = *(const u32x4*)(U + (T0 + qi) * NINP + UC + r16 * 64 + 32 * s + 8 * g4); qf[s] = __builtin_bit_cast(bf16x8, z); }
    float lg[16][4]; float mx = -INFINITY;
#define DSA_QK(M0, NM) do { int keyr[NM]; bf16x8 a0[NM], a1[NM]; \
        _Pragma("unroll") for (int m8 = 0; m8 < NM; ++m8) keyr[m8] = sel[16 * ((M0) + m8) + r16]; \
        _Pragma("unroll") for (int m8 = 0; m8 < NM; ++m8) { a0[m8] = *(const bf16x8*)(Kb + (TB + keyr[m8]) * 64 + 8 * g4); a1[m8] = *(const bf16x8*)(Kb + (TB + keyr[m8]) * 64 + 32 + 8 * g4); } \
        _Pragma("unroll") for (int m8 = 0; m8 < NM; ++m8) { const int m = (M0) + m8; \
            f32x4 acc = (f32x4){0.f, 0.f, 0.f, 0.f}; \
            acc = __builtin_amdgcn_mfma_f32_16x16x32_bf16(a0[m8], qf[0], acc, 0, 0, 0); \
            acc = __builtin_amdgcn_mfma_f32_16x16x32_bf16(a1[m8], qf[1], acc, 0, 0, 0); \
            _Pragma("unroll") for (int i = 0; i < 4; ++i) { const float v = acc[i] * 0.125f + biasj[(16 * m + 4 * g4 + i) * 4 + (r16 & 3)]; lg[m][i] = v; mx = fmaxf(mx, v); } } } while (0)
    if (nt16 > 8) { DSA_QK(0, 16); }
    else { DSA_QK(0, 8);
#pragma unroll
        for (int m8 = 8; m8 < 16; ++m8)
#pragma unroll
            for (int i = 0; i < 4; ++i) lg[m8][i] = -INFINITY; }
#undef DSA_QK
    mx = xrows(mx, OpMax());
    float sm = 0.f;
#pragma unroll
    for (int m = 0; m < 16; ++m)
#pragma unroll
        for (int i = 0; i < 4; ++i) { const float p = __expf(lg[m][i] - mx); lg[m][i] = p; sm += p; }
    sm = xrows(sm, OpAdd());
    f32x4 ov[4];
#pragma unroll
    for (int nt = 0; nt < 4; ++nt) ov[nt] = (f32x4){0.f, 0.f, 0.f, 0.f};
    const unsigned vs_base = (unsigned)(unsigned long)scq;
#pragma unroll
    for (int half = 0; half < 2; ++half) {
        if (half * 8 < nt16) {
            asm volatile("s_waitcnt lgkmcnt(0)" ::: "memory");
            int vkey[16];
#pragma unroll
            for (int q = 0; q < 16; ++q) { const int rho = 8 * q + (lane >> 3);
                vkey[q] = sel[half * 128 + (rho & ~31) + 16 * ((rho >> 2) & 1) + 4 * ((rho >> 3) & 3) + (rho & 3)]; }
            asm volatile("s_waitcnt lgkmcnt(0)" : "+v"(vkey[0]), "+v"(vkey[1]), "+v"(vkey[2]), "+v"(vkey[3]), "+v"(vkey[4]), "+v"(vkey[5]), "+v"(vkey[6]), "+v"(vkey[7]),
                         "+v"(vkey[8]), "+v"(vkey[9]), "+v"(vkey[10]), "+v"(vkey[11]), "+v"(vkey[12]), "+v"(vkey[13]), "+v"(vkey[14]), "+v"(vkey[15]) :: "memory");
#pragma unroll
            for (int q = 0; q < 16; ++q)
                __builtin_amdgcn_global_load_lds((const unsigned*)(Vb + (TB + vkey[q]) * 64 + 8 * (lane & 7)), (LAS unsigned*)((LAS unsigned char*)scq + q * 1024), 16, 0, 0);
            asm volatile("s_waitcnt vmcnt(0)" ::: "memory");
#pragma unroll
            for (int s4 = 0; s4 < 4; ++s4) { const int s = half * 4 + s4;
                u32x4 pw; pw.x = pk2(lg[2 * s][0], lg[2 * s][1]); pw.y = pk2(lg[2 * s][2], lg[2 * s][3]); pw.z = pk2(lg[2 * s + 1][0], lg[2 * s + 1][1]); pw.w = pk2(lg[2 * s + 1][2], lg[2 * s + 1][3]);
                const bf16x8 pa = __builtin_bit_cast(bf16x8, pw);
                const unsigned ad = vs_base + (unsigned)((32 * s4 + 8 * g4 + (r16 >> 2)) * 128 + (r16 & 3) * 8);
                u32x2 t0[4], t1[4];
                asm volatile("ds_read_b64_tr_b16 %0, %8\n\tds_read_b64_tr_b16 %1, %8 offset:512\n\tds_read_b64_tr_b16 %2, %8 offset:32\n\tds_read_b64_tr_b16 %3, %8 offset:544\n\t"
                             "ds_read_b64_tr_b16 %4, %8 offset:64\n\tds_read_b64_tr_b16 %5, %8 offset:576\n\tds_read_b64_tr_b16 %6, %8 offset:96\n\tds_read_b64_tr_b16 %7, %8 offset:608\n\ts_waitcnt lgkmcnt(0)"
                             : "=&v"(t0[0]), "=&v"(t1[0]), "=&v"(t0[1]), "=&v"(t1[1]), "=&v"(t0[2]), "=&v"(t1[2]), "=&v"(t0[3]), "=&v"(t1[3]) : "v"(ad) : "memory");
#pragma unroll
                for (int nt = 0; nt < 4; ++nt) { const bf16x8 vb = __builtin_bit_cast(bf16x8, (u32x4){t0[nt].x, t0[nt].y, t1[nt].x, t1[nt].y});
                    ov[nt] = __builtin_amdgcn_mfma_f32_16x16x32_bf16(pa, vb, ov[nt], 0, 0, 0); } }
        }
    }
    { float inv[4];
#pragma unroll
      for (int h = 0; h < 4; ++h) inv[h] = 1.0f / __int_as_float(__builtin_amdgcn_readlane(__float_as_int(sm), h));
      if (lane < 16) { bf16_t* Y = (bf16_t*)(F.ws + WS_H) + (T0 + qi) * DM + 512 + r16;
#pragma unroll
          for (int h = 0; h < 4; ++h)
#pragma unroll
              for (int nt = 0; nt < 4; ++nt) Y[h * 64 + 16 * nt] = f2bf(ov[nt][h] * inv[h]); } }
}

__device__ __forceinline__ void phase_router(const Frame& F_, int layer) { Frame F = relocal(F_); const int cset = layer;
    const float* X = (const float*)(F.ws + WS_X);
    const bf16_t* WH = (const bf16_t*)(F.ws + WS_WRT) + (size_t)layer * 2 * 49152; const bf16_t* WL = WH + 49152;
    LAS float* part = (LAS float*)F.lds;
    LAS float* ssq = (LAS float*)(F.lds + 24576);
    LAS int* es = (LAS int*)(F.lds + 25088);
    LAS int* lr = (LAS int*)(F.lds + 25600);
    LAS float* wsl = (LAS float*)(F.lds + 26112);
    LAS float* rsd = (LAS float*)(F.lds + 26624);
    for (int blk = F.bid; blk < NTOK / 64; blk += F.G) {
        __syncthreads();
        const int mt = F.wave & 3, kh = F.wave >> 2, r16 = F.lane & 15, g4 = F.lane >> 4;
        const float* xr = X + ((size_t)blk * 64 + mt * 16 + r16) * DM + kh * 512 + 8 * g4;
        f32x4 acc[3]; acc[0] = acc[1] = acc[2] = (f32x4){0.f, 0.f, 0.f, 0.f}; float ss = 0.f;
#pragma unroll 4
        for (int ks = 0; ks < 16; ++ks) {
            const f32x4 xa = *(const f32x4*)(xr + ks * 32), xb = *(const f32x4*)(xr + ks * 32 + 4);
            ss += xa[0] * xa[0] + xa[1] * xa[1] + xa[2] * xa[2] + xa[3] * xa[3] + xb[0] * xb[0] + xb[1] * xb[1] + xb[2] * xb[2] + xb[3] * xb[3];
            float xv[8] = {xa[0], xa[1], xa[2], xa[3], xb[0], xb[1], xb[2], xb[3]}; unsigned hw[4], lw[4];
#pragma unroll
            for (int j = 0; j < 4; ++j) { const bf16_t h0 = f2bf(xv[2 * j]), h1 = f2bf(xv[2 * j + 1]); hw[j] = (unsigned)h0 | ((unsigned)h1 << 16);
                lw[j] = pk2(xv[2 * j] - bf2f(h0), xv[2 * j + 1] - bf2f(h1)); }
            const bf16x8 ahi = __builtin_bit_cast(bf16x8, (u32x4){hw[0], hw[1], hw[2], hw[3]}), alo = __builtin_bit_cast(bf16x8, (u32x4){lw[0], lw[1], lw[2], lw[3]});
#pragma unroll
            for (int nt = 0; nt < 3; ++nt) { const size_t wo = (size_t)(nt * 16 + r16) * 1024 + kh * 512 + ks * 32 + 8 * g4;
                const bf16x8 bh = *(const bf16x8*)(WH + wo), bl = *(const bf16x8*)(WL + wo);
                acc[nt] = __builtin_amdgcn_mfma_f32_16x16x32_bf16(ahi, bh, acc[nt], 0, 0, 0);
                acc[nt] = __builtin_amdgcn_mfma_f32_16x16x32_bf16(ahi, bl, acc[nt], 0, 0, 0);
                acc[nt] = __builtin_amdgcn_mfma_f32_16x16x32_bf16(alo, bh, acc[nt], 0, 0, 0); }
        }
        ss = xrows(ss, OpAdd());
        if (g4 == 0) ssq[kh * 64 + mt * 16 + r16] = ss;
#pragma unroll
        for (int nt = 0; nt < 3; ++nt)
#pragma unroll
            for (int i = 0; i < 4; ++i) part[(kh * 64 + mt * 16 + 4 * g4 + i) * 48 + nt * 16 + r16] = acc[nt][i];
        __syncthreads();
        if (F.tid < 64) { const float rstd = rsqrtf((ssq[F.tid] + ssq[64 + F.tid]) * (1.0f / DM) + 1e-6f); rsd[F.tid] = rstd;
            float l[36];
#pragma unroll
            for (int o = 0; o < 36; ++o) l[o] = (part[F.tid * 48 + o] + part[(64 + F.tid) * 48 + o]) * rstd + (o < 32 ? F.in[I_BRE][layer * 32 + o] : F.in[I_BRG][layer * 4 + o - 32]);
            int gs = 0; float gm = l[32];
#pragma unroll
            for (int j = 1; j < 4; ++j) if (l[32 + j] > gm) { gm = l[32 + j]; gs = j; }
            float den = 0.f;
#pragma unroll
            for (int j = 0; j < 4; ++j) den += __expf(l[32 + j] - gm);
            const float gate = 1.0f / den;
            float e8[8];
#pragma unroll
            for (int j = 0; j < 8; ++j) e8[j] = gs == 0 ? l[j] : gs == 1 ? l[8 + j] : gs == 2 ? l[16 + j] : l[24 + j];
            int i1 = 0; float v1 = e8[0];
#pragma unroll
            for (int j = 1; j < 8; ++j) if (e8[j] > v1) { v1 = e8[j]; i1 = j; }
            int i2 = -1; float v2 = -INFINITY;
#pragma unroll
            for (int j = 0; j < 8; ++j) if (j != i1 && e8[j] > v2) { v2 = e8[j]; i2 = j; }
            const float e2 = __expf(v2 - v1); const float p1 = 1.0f / (1.0f + e2);
            es[F.tid * 2] = gs * 8 + i1; es[F.tid * 2 + 1] = gs * 8 + i2; wsl[F.tid * 2] = p1 * gate; wsl[F.tid * 2 + 1] = (1.0f - p1) * gate; }
        __syncthreads();
        if (F.tid < 32) { int cnt = 0; for (int i = 0; i < 128; ++i) if (es[i] == F.tid) lr[i] = cnt++;
            if (cnt) { const int base = (int)__hip_atomic_fetch_add(F.ctl + CW_CNT + cset * 32 + F.tid, (unsigned)cnt, __ATOMIC_RELAXED, __HIP_MEMORY_SCOPE_AGENT);
                for (int i = 0; i < 128; ++i) if (es[i] == F.tid) lr[i] += base; } }
        __syncthreads();
        if (F.tid < 64) { int* rt = (int*)(F.ws + WS_ROUTE) + ((size_t)blk * 64 + F.tid) * 8;
            rt[0] = es[F.tid * 2]; rt[1] = es[F.tid * 2 + 1]; ((float*)rt)[2] = wsl[F.tid * 2]; ((float*)rt)[3] = wsl[F.tid * 2 + 1]; rt[4] = lr[F.tid * 2]; rt[5] = lr[F.tid * 2 + 1]; ((float*)rt)[6] = rsd[F.tid]; }
    }
    __syncthreads();
    if (F.tid == 0) __hip_atomic_fetch_add(F.ctl + CW_RB + 64 * layer, 1u, __ATOMIC_RELAXED, __HIP_MEMORY_SCOPE_AGENT);
}
__device__ __forceinline__ void phase_moe_convert(const Frame& F_, int layer) { Frame F = relocal(F_);
    bf16_t* WGU = (bf16_t*)(F.ws + WS_MOE + MOE_WGU);
    for (int t = F.bid; t < 1024; t += F.G) {
        const int e = t >> 5, r = t & 31, kt = r >> 1, nt = r & 1; const size_t eo = ((size_t)layer * 32 + e) * 1024 * 256;
        tr_tile(F, 256, WGU + (size_t)e * 512 * 1024, 1024, kt * 64, nt * 256, SmGU{F.in[I_WGATE] + eo, F.in[I_WUP] + eo}); }
}
__device__ __forceinline__ void phase_moe_convert_down(const Frame& F_, int layer) { Frame F = relocal(F_);
    bf16_t* WD = (bf16_t*)(F.ws + WS_MOE + MOE_WD);
    for (;;) { const int q = q_pop(F, 32 + layer); if (q >= 512) break;
        const int e = q >> 4, r = q & 15, kt = r >> 2, nt = r & 3;
        tr_tile(F, 1024, WD + (size_t)e * 1024 * 256, 256, kt * 64, nt * 256, SmId{F.in[I_WDOWN] + ((size_t)layer * 32 + e) * 256 * 1024}); }
}
__device__ __forceinline__ void phase_gather(const Frame& F_, int layer) { Frame F = relocal(F_);
    LAS int* off = (LAS int*)F.lds;
    __syncthreads();
    if (F.tid == 0) { unsigned sp = 0;
        while (__hip_atomic_load(F.ctl + CW_RB + 64 * layer, __ATOMIC_RELAXED, __HIP_MEMORY_SCOPE_AGENT) < (unsigned)F.G) { __builtin_amdgcn_s_sleep(2); if (++sp > (1u << 22)) break; } }
    __syncthreads();
    if (F.tid == 0) { int acc = 0; for (int e = 0; e < 32; ++e) { off[e] = acc; const int c = (int)__hip_atomic_load(F.ctl + CW_CNT + layer * 32 + e, __ATOMIC_RELAXED, __HIP_MEMORY_SCOPE_AGENT); acc += (c + 255) & ~255; } off[32] = acc; }
    __syncthreads();
    int* tiles = (int*)(F.ws + WS_TILES); int* row_tok = (int*)(F.ws + WS_ROWS); float* row_w = (float*)(F.ws + WS_ROWS) + MAXROWS;
    if (F.bid == 0) { if (F.tid == 0) tiles[0] = off[32] >> 8; if (F.tid < 33) tiles[1 + F.tid] = off[F.tid];
        if (F.tid < 32) for (int rt = off[F.tid] >> 8; rt < (off[F.tid + 1] >> 8); ++rt) tiles[64 + rt] = F.tid; }
    for (int e = F.bid; e < 32; e += F.G) { const int c = (int)__hip_atomic_load(F.ctl + CW_CNT + layer * 32 + e, __ATOMIC_RELAXED, __HIP_MEMORY_SCOPE_AGENT);
        for (int r = off[e] + c + F.tid; r < off[e + 1]; r += NTHR) { row_tok[r] = -1; row_w[r] = 0.f; } }
    const float* X = (const float*)(F.ws + WS_X); bf16_t* HP = (bf16_t*)(F.ws + WS_U); const float* nw = F.in[I_NORM2] + (size_t)layer * DM;
    f32x4 nwv[4];
#pragma unroll
    for (int j = 0; j < 4; ++j) nwv[j] = *(const f32x4*)(nw + 4 * F.lane + 256 * j);
    for (int blk = F.bid; blk < NTOK / 64; blk += F.G)
    for (int i4 = 0; i4 < 2; ++i4) {
        int p0[4], p1[4], tt[4]; float rstd[4], w0[4], w1[4]; f32x4 xv[4][4];
#pragma unroll
        for (int r = 0; r < 4; ++r) { const int t = blk * 64 + F.wave * 8 + 4 * i4 + r; tt[r] = t;
            const int* rt = (const int*)(F.ws + WS_ROUTE) + (size_t)t * 8; rstd[r] = ((const float*)rt)[6]; w0[r] = ((const float*)rt)[2]; w1[r] = ((const float*)rt)[3];
            p0[r] = off[rt[0]] + rt[4]; p1[r] = off[rt[1]] + rt[5];
#pragma unroll
            for (int j = 0; j < 4; ++j) xv[r][j] = *(const f32x4*)(X + (size_t)t * DM + 4 * F.lane + 256 * j); }
#pragma unroll
        for (int r = 0; r < 4; ++r) {
#pragma unroll
            for (int j = 0; j < 4; ++j) { const int c = 4 * F.lane + 256 * j; const f32x4 v = xv[r][j] * rstd[r] * nwv[j];
                u32x2 o; o.x = pk2(v[0], v[1]); o.y = pk2(v[2], v[3]);
                *(u32x2*)(HP + (size_t)tt[r] * DM + c) = o; }
            if (F.lane == 0) { row_tok[p0[r]] = tt[r] * 2; row_w[p0[r]] = w0[r]; row_tok[p1[r]] = tt[r] * 2 + 1; row_w[p1[r]] = w1[r]; } }
    }
}

constexpr int NPH_LAYER = 9, NPHASE = 1 + 2 * NPH_LAYER + 1;
#ifndef MK_ONLY
#define MK_ONLY -1
#endif
#ifndef MK_ITEM
#define MK_ITEM -1
#endif
#define EN(o) (MK_ONLY < 0 || MK_ONLY == (o))
#define IT(o) (MK_ITEM < 0 || MK_ITEM == (o))
__global__ void __launch_bounds__(NTHR, 2) mk_forward(Params P) {
    extern __shared__ __attribute__((aligned(16))) unsigned char lds_raw[];
    Frame F; F.lds = (LAS unsigned char*)lds_raw; F.tid = threadIdx.x; F.lane = F.tid & 63; F.wave = __builtin_amdgcn_readfirstlane(F.tid >> 6); F.bid = blockIdx.x; F.G = gridDim.x;
    F.in = (in_tab_t)__builtin_amdgcn_kernarg_segment_ptr(); F.out = P.out; F.ws = P.ws; F.ctl = (unsigned*)(P.ws + WS_CTL); F.misc = (volatile LAS int*)(F.lds + MISC_OFF);
    if (F.tid < 64) ((LAS unsigned*)(F.lds + MISC_OFF))[F.tid] = 0u;
    __syncthreads();
    const int lo = P.ph_lo, hi = P.ph_hi;
    XcdBarrier bar; bar.bar = F.ctl + CW_BAR; bar.x = 0; bar.st = (volatile LAS unsigned*)(F.lds + MISC_OFF + 16);
    if (hi - lo > 1) bar = xcd_barrier_post(F.ctl + CW_BAR, (volatile LAS unsigned*)(F.lds + MISC_OFF + 16));
#define IN(k) (lo <= (k) && (k) < hi)
#define SEAM(k) do { if (IN(k) && IN((k) + 1)) xcd_barrier(bar); } while (0)
#define QLOOP(qi, n, body) for (;;) { const int it = q_pop(F, layer * 12 + (qi)); if (it >= (n)) break; body; }
    if (EN(100) && IN(0)) { phase_prologue(F); phase_norm(F, F.in[I_X], false, F.in[I_NORM1], 3); } SEAM(0);
#pragma unroll
    for (int layer = 0; layer < DEPTH; ++layer) {
        const int pb = 1 + layer * NPH_LAYER;
        if (layer > 0) { if (EN(0) && IN(pb + 0)) { phase_norm(F, (const float*)(F.ws + WS_X), true, F.in[I_NORM1] + (size_t)layer * DM, 0); } SEAM(pb + 0); }
        if (EN(1) && IN(pb + 1)) { const Frame F_ = F; Frame F = relocal(F_); pg8::StaticOrder S; S.init((const bf16_t*)(F.ws + WS_H), (const bf16_t*)(F.ws + WS_WIN) + (size_t)layer * NINP * DM, NTOK, NINP, DM, F.G, F.bid);
            pg8::EpiBf16 E{(bf16_t*)(F.ws + WS_U), NINP}; pg8::gemm_phase(F.lds, DM, S, E); } SEAM(pb + 1);
#define SLOOP(n, body) for (int it = F.bid; it < (n); it += F.G) { __syncthreads(); body; }
        if (EN(2) && IN(pb + 2)) {
            if (IT(1)) SLOOP(1024, item_rwkv1(F, layer, it));
            if (IT(0)) SLOOP(256, item_s5<1>(F, layer, it));
            if (IT(2)) SLOOP(256, item_mamba<1>(F, layer, it));
            if (IT(3)) SLOOP(256, item_kv(F, layer, it));
        } SEAM(pb + 2);
        if (EN(3) && IN(pb + 3)) {
            if (IT(0)) SLOOP(8, item_rwkv_carry(F, it));
            if (IT(1)) { for (int it = F.bid - 8; it >= 0 && it < 16; it += F.G) { __syncthreads(); item_mamba_carry(F, it); } }
            if (IT(2)) { for (int it = F.bid - 24; it >= 0 && it < 4; it += F.G) { __syncthreads(); item_s5_carry(F, layer, it); } }
            if (IT(3)) {
                dsa_tables(F);
                const int pref = (int)(xb_xcc_id() & 3u);
#pragma unroll 1
                for (int k4 = 0; k4 < 4; ++k4) { const int bq = (pref + k4) & 3;
                    for (;;) { const int it = q_pop(F, 24 + layer * 4 + bq); if (it >= 512) break; item_dsa(F, layer, it * 4 + bq); } } }
        } SEAM(pb + 3);
        if (EN(4) && IN(pb + 4)) {
            if (IT(0)) SLOOP(256, item_s5<2>(F, layer, it));
            if (IT(2)) SLOOP(256, item_mamba<2>(F, layer, it));
            if (IT(1)) SLOOP(1024, item_rwkv3(F, layer, it));
        } SEAM(pb + 4);
        if (EN(6) && IN(pb + 5)) { const Frame F_ = F; Frame F = relocal(F_); pg8::StaticOrder S; S.init((const bf16_t*)(F.ws + WS_H), (const bf16_t*)(F.ws + WS_WOUT) + (size_t)layer * DM * DM, NTOK, DM, DM, F.G, F.bid);
            pg8::EpiResid E{layer == 0 ? F.in[I_X] : (const float*)(F.ws + WS_X), (float*)(F.ws + WS_X), DM}; pg8::gemm_phase(F.lds, DM, S, E); } SEAM(pb + 5);
        if (EN(7) && IN(pb + 6)) { phase_router(F, layer); phase_moe_convert(F, layer); phase_gather(F, layer); } SEAM(pb + 6);
        if (EN(8) && IN(pb + 7)) { const Frame F_ = F; Frame F = relocal(F_); LAS int* ul = (LAS int*)(F.lds + pg8::STAGE_BYTES + 8192); if (F.tid == 0) pg8::MoeOrder::build(ul, (const int*)(F.ws + WS_TILES), 2, F.G, F.bid); __syncthreads();
            pg8::MoeOrder S{DM, (const char*)(F.ws + WS_U), (const char*)(F.ws + WS_MOE + MOE_WGU), (size_t)512 * 1024 * 2, ul};
            pg8::EpiGated<1> E{(bf16_t*)(F.ws + WS_H), 256, 0, nullptr, nullptr}; pg8::gemm_phase<pg8::EpiGated<1>, pg8::MoeOrder, true>(F.lds, DM, S, E, (const char*)(F.ws + WS_U), (const int*)(F.ws + WS_ROWS)); phase_moe_convert_down(F, layer); } SEAM(pb + 7);
        if (EN(9) && IN(pb + 8)) { const Frame F_ = F; Frame F = relocal(F_); LAS int* ul = (LAS int*)(F.lds + pg8::STAGE_BYTES + 8192); if (F.tid == 0) pg8::MoeOrder::build(ul, (const int*)(F.ws + WS_TILES), 4, F.G, F.bid); __syncthreads();
            pg8::MoeOrder S{256, (const char*)(F.ws + WS_H), (const char*)(F.ws + WS_MOE + MOE_WD), (size_t)1024 * 256 * 2, ul};
            pg8::EpiMoeOut E{(bf16_t*)(F.ws + WS_U), (const int*)(F.ws + WS_ROWS), (const float*)(F.ws + WS_ROWS) + MAXROWS, F.lds}; pg8::gemm_phase(F.lds, 256, S, E); } SEAM(pb + 8);
    }
    if (EN(101) && IN(NPHASE - 1)) { phase_norm(F, (const float*)(F.ws + WS_X), true, F.in[I_FNORM], 2); }
#undef IN
#undef SEAM
}

#ifndef MK_SPLIT
#define MK_SPLIT 0
#endif
extern "C" void kernel_launch(void* const* d_in, const int* in_sizes, int n_in, void* d_out, int out_size, void* d_ws, size_t ws_size, hipStream_t stream) {
    static int grid = 0;
    if (grid == 0) {
        if (n_in != 44 || out_size != NTOK * DM || ws_size < WS_END) { fprintf(stderr, "kernel_launch: unexpected shapes (n_in %d out %d ws %zu need %zu)\n", n_in, out_size, ws_size, (size_t)WS_END); grid = -1; return; }
        int dev = 0, cus = 0;
        if (hipGetDevice(&dev) != hipSuccess || hipDeviceGetAttribute(&cus, hipDeviceAttributeMultiprocessorCount, dev) != hipSuccess) { grid = -1; return; }
        if (hipFuncSetAttribute((const void*)mk_forward, hipFuncAttributeMaxDynamicSharedMemorySize, LDS_BYTES) != hipSuccess) { fprintf(stderr, "kernel_launch: hipFuncSetAttribute failed\n"); grid = -1; return; }
        int per_cu = 0;
        if (hipOccupancyMaxActiveBlocksPerMultiprocessor(&per_cu, (const void*)mk_forward, NTHR, LDS_BYTES) != hipSuccess || per_cu < 1) { fprintf(stderr, "kernel_launch: occupancy query says %d\n", per_cu); }
        (void)hipGetLastError();
        grid = cus;
    }
    if (grid < 0) return;
    hipMemsetAsync((char*)d_ws + WS_CTL, 0, CTL_BYTES, stream);
    Params p{};
    for (int i = 0; i < 44; ++i) p.in[i] = (const float*)d_in[i];
    p.out = (float*)d_out; p.ws = (unsigned char*)d_ws;
#if MK_SPLIT
    for (int ph = 0; ph < NPHASE; ++ph) { p.ph_lo = ph; p.ph_hi = ph + 1; hipLaunchKernelGGL(mk_forward, dim3(grid), dim3(NTHR), LDS_BYTES, stream, p); }
#else
    p.ph_lo = 0; p.ph_hi = NPHASE; hipLaunchKernelGGL(mk_forward, dim3(grid), dim3(NTHR), LDS_BYTES, stream, p);
#endif
}
```

```cpp
#include <hip/hip_runtime.h>
#include <stdint.h>
#include <stdio.h>

#define LAS __attribute__((address_space(3)))
typedef unsigned short bf16_t;
typedef short bf16x8 __attribute__((ext_vector_type(8)));
typedef float f32x4 __attribute__((ext_vector_type(4)));
typedef float f32x2 __attribute__((ext_vector_type(2)));
typedef float f32x16 __attribute__((ext_vector_type(16)));
typedef unsigned u32x4 __attribute__((ext_vector_type(4)));
typedef unsigned u32x2 __attribute__((ext_vector_type(2)));

constexpr int NTOK = 16384, DM = 1024, SEQ = 4096, NBATCH = 4, DEPTH = 2;
constexpr int NIN = 2604, NINP = 2816;
constexpr int UM = 0;
constexpr int UR = 784;
constexpr int UC = 1680;
constexpr int US = 2368;
constexpr int NTHR = 512;
constexpr int LDS_BYTES = 163840;
constexpr int MISC_OFF = LDS_BYTES - 256;

constexpr size_t WS_CTL   = 0;
constexpr size_t CTL_BYTES = 65536;
constexpr size_t WS_X     = WS_CTL + CTL_BYTES;
constexpr size_t WS_H     = WS_X + (size_t)NTOK * DM * 4;
constexpr size_t WS_U     = WS_H + (size_t)NTOK * DM * 2;
constexpr size_t WS_WIN   = WS_U + (size_t)NTOK * NINP * 2;
constexpr size_t WS_WOUT  = WS_WIN + (size_t)2 * NINP * DM * 2;
constexpr size_t WS_GLU   = WS_WOUT + (size_t)2 * DM * DM * 2;
constexpr size_t WS_MOE   = WS_GLU + (size_t)2 * 512 * 256 * 2;
constexpr size_t MOE_WGU  = 0;
constexpr size_t MOE_WD   = (size_t)32 * 512 * 1024 * 2;
constexpr size_t MOE_BYTES = MOE_WD + (size_t)32 * 1024 * 256 * 2;
constexpr size_t RW_PT    = 0;
constexpr size_t RW_U     = (size_t)1024 * 4096 * 2;
constexpr size_t RW_S     = RW_U + (size_t)1024 * 4096 * 2;
constexpr size_t RW_W1    = RW_S + (size_t)1024 * 4096 * 2;
constexpr size_t RW_Z     = RW_W1 + (size_t)1024 * 4096 * 2;
constexpr size_t YSG_OFF  = RW_Z + (size_t)1024 * 4096 * 2;
static_assert(YSG_OFF + (size_t)NTOK * 256 * 2 <= MOE_BYTES, "alias");
constexpr size_t WS_MST   = WS_MOE + MOE_BYTES;
constexpr size_t WS_MDEC  = WS_MST + (size_t)4 * 64 * 4 * 4096 * 4;
constexpr size_t WS_S5ST  = WS_MDEC + 4096;
constexpr size_t WS_K     = WS_S5ST + (size_t)4 * 64 * 2048 * 4;
constexpr size_t WS_V     = WS_K + (size_t)NTOK * 64 * 2;
constexpr size_t WS_KIDX  = WS_V + (size_t)NTOK * 64 * 2;
constexpr size_t WS_ROUTE = WS_KIDX + (size_t)NTOK * 32 * 2;
constexpr size_t WS_ROWS  = WS_ROUTE + (size_t)NTOK * 32;
constexpr int    MAXROWS  = 49152;
constexpr size_t WS_TILES = WS_ROWS + (size_t)MAXROWS * 8;
constexpr size_t WS_S5TAB = WS_TILES + 4096;
constexpr size_t S5TAB_F  = (size_t)(2048 + 2048 + 32768) * 4;
constexpr size_t S5TAB_BBT = S5TAB_F + (size_t)16 * 16 * 128 * 2;
constexpr size_t S5TAB_L  = S5TAB_BBT + (size_t)16 * 128 * 16 * 2;
constexpr size_t WS_WRT   = WS_S5TAB + 2 * S5TAB_L;
constexpr size_t WS_BON   = WS_WRT + (size_t)2 * 2 * 48 * 1024 * 2;
constexpr size_t WS_END   = WS_BON + (size_t)1024 * 64 * 4;

constexpr int CW_BAR = 0;
constexpr int CW_Q   = 4096;
constexpr int CW_CNT = 8192;
constexpr int CW_RB  = 8448;

__device__ __forceinline__ float bf2f(bf16_t b) { return __uint_as_float(((unsigned)b) << 16); }
__device__ __forceinline__ bf16_t f2bf(float f) { const __bf16 h = (__bf16)f; return __builtin_bit_cast(bf16_t, h); }
__device__ __forceinline__ unsigned pk2(float lo, float hi) { typedef __bf16 bf2_t __attribute__((ext_vector_type(2))); const bf2_t h = __builtin_convertvector((f32x2){lo, hi}, bf2_t); return __builtin_bit_cast(unsigned, h); }
__device__ __forceinline__ unsigned cvt_pk_bf16(float lo, float hi) { unsigned r; asm volatile("v_cvt_pk_bf16_f32 %0, %1, %2" : "=v"(r) : "v"(lo), "v"(hi)); return r; }
__device__ __forceinline__ float sigmoidf_(float x) { return 1.0f / (1.0f + __expf(-x)); }
__device__ __forceinline__ float siluf_(float x) { return x / (1.0f + __expf(-x)); }
__device__ __forceinline__ float tanhf_(float x) { const float e = __expf(2.0f * x); return 1.0f - 2.0f / (e + 1.0f); }
__device__ __forceinline__ float softplusf_(float x) { return fmaxf(x, 0.0f) + log1pf(__expf(-fabsf(x))); }
__device__ __forceinline__ float gelu_tanh(float x) { return 0.5f * x * (1.0f + tanhf_(0.7978845608028654f * (x + 0.044715f * x * x * x))); }
template <int CTRL> __device__ __forceinline__ float dppf(float x) { return __int_as_float(__builtin_amdgcn_update_dpp(0, __float_as_int(x), CTRL, 0xF, 0xF, true)); }
__device__ __forceinline__ float sum4(float x) { x += dppf<0xB1>(x); x += dppf<0x4E>(x); return x; }
__device__ __forceinline__ float sum8(float x) { x = sum4(x); x += dppf<0x141>(x); return x; }
__device__ __forceinline__ float sum16(float x) { x = sum8(x); x += dppf<0x140>(x); return x; }
__device__ __forceinline__ int lane_id_() { int l = (int)__builtin_amdgcn_mbcnt_hi(~0u, __builtin_amdgcn_mbcnt_lo(~0u, 0u)); asm volatile("" : "+v"(l)); return l; }
__device__ __forceinline__ float shx(float x, int o) { return __int_as_float(__builtin_amdgcn_ds_bpermute((lane_id_() ^ o) << 2, __float_as_int(x))); }
__device__ __forceinline__ unsigned shdown_u(unsigned x, int o) { return (unsigned)__builtin_amdgcn_ds_bpermute(((lane_id_() + o) & 63) << 2, (int)x); }
__device__ __forceinline__ int shidx_i(int x, int src) { return __builtin_amdgcn_ds_bpermute(src << 2, x); }
template <class OP> __device__ __forceinline__ float xrows(float x, OP op) {
    u32x2 r = __builtin_amdgcn_permlane16_swap(__float_as_uint(x), __float_as_uint(x), false, false); x = op(__uint_as_float(r[0]), __uint_as_float(r[1]));
    r = __builtin_amdgcn_permlane32_swap(__float_as_uint(x), __float_as_uint(x), false, false); return op(__uint_as_float(r[0]), __uint_as_float(r[1])); }
struct OpAdd { __device__ __forceinline__ float operator()(float a, float b) const { return a + b; } };
struct OpMin { __device__ __forceinline__ float operator()(float a, float b) const { return fminf(a, b); } };
struct OpMax { __device__ __forceinline__ float operator()(float a, float b) const { return fmaxf(a, b); } };
__device__ __forceinline__ float wave_sum(float x) { x = sum16(x); return xrows(x, OpAdd()); }
__device__ __forceinline__ float wave_min(float x) { x = fminf(x, dppf<0xB1>(x)); x = fminf(x, dppf<0x4E>(x)); x = fminf(x, dppf<0x141>(x)); x = fminf(x, dppf<0x140>(x)); return xrows(x, OpMin()); }
__device__ __forceinline__ float wave_max(float x) { x = fmaxf(x, dppf<0xB1>(x)); x = fmaxf(x, dppf<0x4E>(x)); x = fmaxf(x, dppf<0x141>(x)); x = fmaxf(x, dppf<0x140>(x)); return xrows(x, OpMax()); }
template <int CTRL, int RM, bool BC> __device__ __forceinline__ float dpp_addf(float x) { return x + __int_as_float(__builtin_amdgcn_update_dpp(0, __float_as_int(x), CTRL, RM, 0xF, BC)); }
__device__ __forceinline__ float wave_prefix_f(float x) { x = dpp_addf<0x111, 0xF, true>(x); x = dpp_addf<0x112, 0xF, true>(x); x = dpp_addf<0x114, 0xF, true>(x); x = dpp_addf<0x118, 0xF, true>(x);
    x = dpp_addf<0x142, 0xA, false>(x); return dpp_addf<0x143, 0xC, false>(x); }
__device__ __forceinline__ unsigned wave_prefix_u(unsigned x) { int v = (int)x;
    v += __builtin_amdgcn_update_dpp(0, v, 0x111, 0xF, 0xF, true); v += __builtin_amdgcn_update_dpp(0, v, 0x112, 0xF, 0xF, true);
    v += __builtin_amdgcn_update_dpp(0, v, 0x114, 0xF, 0xF, true); v += __builtin_amdgcn_update_dpp(0, v, 0x118, 0xF, 0xF, true);
    v += __builtin_amdgcn_update_dpp(0, v, 0x142, 0xA, 0xF, false); v += __builtin_amdgcn_update_dpp(0, v, 0x143, 0xC, 0xF, false); return (unsigned)v; }
__device__ __forceinline__ void unpack8(const u32x4 v, float (&f)[8]) {
    f[0] = __uint_as_float(v.x << 16); f[1] = __uint_as_float(v.x & 0xffff0000u); f[2] = __uint_as_float(v.y << 16); f[3] = __uint_as_float(v.y & 0xffff0000u);
    f[4] = __uint_as_float(v.z << 16); f[5] = __uint_as_float(v.z & 0xffff0000u); f[6] = __uint_as_float(v.w << 16); f[7] = __uint_as_float(v.w & 0xffff0000u);
}

__device__ __forceinline__ void st16_wt(void* p, u32x4 v) { asm volatile("global_store_dwordx4 %0, %1, off sc1\n\ts_nop 1" :: "v"(p), "v"(v) : "memory"); }
#define XB_TMO      128
#define XB_XCNT(j)  (256  + 64 * (j))
#define XB_XSUB(j)  (1280 + 64 * (j))
#define XB_XGEN(j)  (2304 + 64 * (j))
#define XB_TOP      3328
#define XB_TOPGEN   3392
#define XCD_BAR_WORDS 3456
#define XB_SPIN_CAP (1u << 22)
__device__ __forceinline__ unsigned xb_ld(unsigned* p)              { return __hip_atomic_load(p, __ATOMIC_RELAXED, __HIP_MEMORY_SCOPE_AGENT); }
__device__ __forceinline__ unsigned xb_add(unsigned* p, unsigned v) { return __hip_atomic_fetch_add(p, v, __ATOMIC_RELAXED, __HIP_MEMORY_SCOPE_AGENT); }
__device__ __forceinline__ unsigned xb_xcc_id() { return (unsigned)__builtin_amdgcn_s_getreg((3 << 11) | 20) & 0xFu; }
#define XB_SPIN(cond, bar) do { unsigned _sp = 0; while (cond) { __builtin_amdgcn_s_sleep(1); \
    if ((++_sp & 255u) == 0u) { if (xb_ld(&(bar)[XB_TMO])) break; if (_sp > XB_SPIN_CAP) { atomicAdd(&(bar)[XB_TMO], 1u); break; } } } } while (0)
struct XcdBarrier { unsigned* bar; unsigned x; volatile LAS unsigned* st; };
__device__ __forceinline__ XcdBarrier xcd_barrier_post(unsigned* bar, volatile LAS unsigned* st) {
    XcdBarrier b; b.bar = bar; b.x = xb_xcc_id(); b.st = st;
    if (threadIdx.x == 0) (void)xb_add(&bar[XB_XCNT(b.x)], 1u);
    return b;
}
__device__ __forceinline__ void xcd_barrier_complete(unsigned* bar, unsigned x, unsigned& nloc, unsigned& nx) {
    const unsigned G = gridDim.x * gridDim.y * gridDim.z;
    unsigned sum, cnt, mine, sp = 0u;
    for (;;) {
        sum = 0u; cnt = 0u; mine = 0u;
#pragma unroll
        for (unsigned j = 0; j < 16; ++j) { const unsigned c = xb_ld(&bar[XB_XCNT(j)]); sum += c; cnt += (c > 0u) ? 1u : 0u; mine = (j == x) ? c : mine; }
        if (sum == G) break;
        __builtin_amdgcn_s_sleep(1);
        if ((++sp & 255u) == 0u) { if (xb_ld(&bar[XB_TMO])) break; if (sp > XB_SPIN_CAP) { atomicAdd(&bar[XB_TMO], 1u); break; } }
    }
    nloc = mine > 0u ? mine : 1u; nx = cnt > 0u ? cnt : 1u;
}
__device__ __forceinline__ void xcd_barrier(const XcdBarrier& b_) {
    XcdBarrier b = b_; { const unsigned long long v = (unsigned long long)b.bar; unsigned lo = __builtin_amdgcn_readfirstlane((unsigned)v), hi = __builtin_amdgcn_readfirstlane((unsigned)(v >> 32)); asm volatile("" : "+s"(lo), "+s"(hi)); b.bar = (unsigned*)(((unsigned long long)hi << 32) | lo); unsigned xx = __builtin_amdgcn_readfirstlane(b.x); asm volatile("" : "+s"(xx)); b.x = xx; }
    asm volatile("s_waitcnt vmcnt(0)" ::: "memory");
    __syncthreads();
    if (threadIdx.x == 0) {
        unsigned* bar = b.bar;
        __builtin_amdgcn_s_waitcnt(0);
        unsigned nloc = b.st[0], nx = b.st[1];
        if (nloc == 0u) { xcd_barrier_complete(bar, b.x, nloc, nx); b.st[0] = nloc; b.st[1] = nx; }
        const unsigned old = xb_add(&bar[XB_XSUB(b.x)], 1u);
        const unsigned gen = old / nloc;
        if (old + 1u == (gen + 1u) * nloc) {
            __builtin_amdgcn_fence(__ATOMIC_RELEASE, "agent");
            asm volatile("s_waitcnt vmcnt(0)" ::: "memory");
            const unsigned og = xb_add(&bar[XB_TOP], 1u);
            const unsigned tg = og / nx;
            if (og + 1u == (tg + 1u) * nx) xb_add(&bar[XB_TOPGEN], 1u);
            else XB_SPIN(xb_ld(&bar[XB_TOPGEN]) == tg, bar);
            __builtin_amdgcn_fence(__ATOMIC_ACQUIRE, "agent");
            xb_add(&bar[XB_XGEN(b.x)], 1u);
            asm volatile("s_waitcnt vmcnt(0)" ::: "memory");
        } else {
            XB_SPIN(xb_ld(&bar[XB_XGEN(b.x)]) == gen, bar);
            __builtin_amdgcn_fence(__ATOMIC_ACQUIRE, "agent");
            asm volatile("s_waitcnt vmcnt(0)" ::: "memory");
        }
    }
    __syncthreads();
}

namespace pg8 {
constexpr int BM = 256, BK = 64, HALF = 128, HTB = HALF * BK * 2, STAGE_BYTES = 8 * HTB, NXCD = 8, WGM = 8;
__host__ __device__ __forceinline__ int lds_byte(int r, int c) { const int st = (r >> 4) * 2 + (c >> 5), rr = r & 15, cc = c & 31, ob = rr * 64 + cc * 2; return st * 1024 + (ob ^ (((ob >> 9) & 1) << 5)); }
__host__ __device__ __forceinline__ void stage_rc(int b, int& R, int& C) { const int st = b / 1024, sb = b % 1024, swz = sb ^ (((sb >> 9) & 1) << 5); R = (st >> 1) * 16 + swz / 64; C = (st & 1) * 32 + (swz % 64) / 2; }
__host__ __device__ __forceinline__ int perm32(int rho) { const int n = rho >> 4, i = rho & 15; return 8 * (i >> 2) + 4 * n + (i & 3); }
struct Unit { int pm, pn; const char* a; const char* b; };

struct StaticOrder {
    int nM, nN, nwg, G, c, K; const char* A; const char* B;
    __device__ void init(const bf16_t* A_, const bf16_t* B_, int M, int N, int K_, int G_, int c_) { A = (const char*)A_; B = (const char*)B_; K = K_; nM = M / BM; nN = N / BM; nwg = nM * nN; G = G_; c = c_; }
    __device__ bool next(int i, Unit& u) const {
        const long L = (long)i * G + c; if (L >= nwg) return false;
        int wgid = (int)L; { const int q = nwg / NXCD, r = nwg % NXCD, xcd = wgid % NXCD, off = wgid / NXCD; wgid = (xcd < r ? xcd * (q + 1) : r * (q + 1) + (xcd - r) * q) + off; }
        const int nig = WGM * nN, gid = wgid / nig, fm = gid * WGM, gsz = (nM - fm) < WGM ? (nM - fm) : WGM;
        u.pm = fm + ((wgid % nig) % gsz); u.pn = (wgid % nig) / gsz;
        u.a = A + (size_t)u.pm * 256 * K * 2; u.b = B + (size_t)u.pn * 256 * K * 2; return true;
    }
};

template <class Epi, class Sched, bool GATHER = false>
__device__ __forceinline__ void gemm_phase(LAS unsigned char* lds, const int K_, const Sched& S, const Epi& E, const char* Aall = nullptr, const int* arow = nullptr) {
    int K = K_; asm volatile("" : "+s"(K));
    int tid_ = threadIdx.x; asm volatile("" : "+v"(tid_));
    const int tid = tid_, wid = __builtin_amdgcn_readfirstlane(tid >> 6), lane = tid & 63, wr = wid >> 2, wc = wid & 3, fr = lane & 15, fq = lane >> 4;
    const int nt = K / BK;
    unsigned voffA[2], voffB[2]; int Rst[2], Cst[2];
#pragma unroll
    for (int i = 0; i < 2; ++i) { int R, C; stage_rc(tid * 16 + i * 8192, R, C); const int Rb = Epi::PERM ? ((R & ~31) + perm32(R & 31)) : R; Rst[i] = R; Cst[i] = C;
        voffA[i] = (unsigned)(R * K + C) * 2u; voffB[i] = (unsigned)(Rb * K + C) * 2u; }
    unsigned gv[2][2], gn[2][2];
#define PG8_GOFF(dst, unit) do { _Pragma("unroll") for (int h_ = 0; h_ < 2; ++h_) _Pragma("unroll") for (int i_ = 0; i_ < 2; ++i_) { const int rr_ = arow[(unit).pm * BM + h_ * HALF + Rst[i_]]; \
        dst[h_][i_] = ((unsigned)(rr_ < 0 ? 0 : rr_ >> 1) * (unsigned)K + (unsigned)Cst[i_]) * 2u; } } while (0)
    const size_t kstep = (size_t)(BK * 2);
    const size_t hstep = (size_t)HALF * K * 2;
    const unsigned ldsw = (unsigned)wid * 1024u;
    const int aoff = lds_byte(wr * 64 + fr, fq * 8), boff = lds_byte(wc * 32 + fr, fq * 8);
#define PG8_SA(b, h) (((b) * 2 + (h)) * HTB)
#define PG8_SB(b, h) ((4 + (b) * 2 + (h)) * HTB)
#define PG8_STAGE(bufoff, gbase, voff) do { _Pragma("unroll") for (int _i = 0; _i < 2; ++_i) \
        __builtin_amdgcn_global_load_lds((const unsigned*)((const char*)(gbase) + (voff)[_i]), (LAS unsigned*)(lds + (bufoff) + ldsw + _i * 8192), 16, 0, 0); } while (0)
#define PG8_LDA(dst, b, h) do { _Pragma("unroll") for (int m = 0; m < 4; ++m) _Pragma("unroll") for (int k = 0; k < 2; ++k) dst[m][k] = *(const LAS bf16x8*)(lds + PG8_SA(b, h) + aoff + m * 2048 + k * 1024); } while (0)
#define PG8_LDB(dst, b, h) do { _Pragma("unroll") for (int n = 0; n < 2; ++n) _Pragma("unroll") for (int k = 0; k < 2; ++k) dst[n][k] = *(const LAS bf16x8*)(lds + PG8_SB(b, h) + boff + n * 2048 + k * 1024); } while (0)
#define PG8_MMA(ai, bj, At, Bt) do { __builtin_amdgcn_s_setprio(1); _Pragma("unroll") for (int m = 0; m < 4; ++m) _Pragma("unroll") for (int n = 0; n < 2; ++n) _Pragma("unroll") for (int k = 0; k < 2; ++k) \
        acc[ai][bj][m][n] = __builtin_amdgcn_mfma_f32_16x16x32_bf16(Bt[n][k], At[m][k], acc[ai][bj][m][n], 0, 0, 0); __builtin_amdgcn_s_setprio(0); } while (0)
#define PG8_WAIT_V(n) asm volatile("s_waitcnt vmcnt(" #n ")" ::: "memory")
#define PG8_WAIT_L(n) asm volatile("s_waitcnt lgkmcnt(" #n ")" ::: "memory")
#define PG8_BAR __builtin_amdgcn_s_barrier()
#define PG8_SCHED __builtin_amdgcn_sched_barrier(0)
    Unit cur, nxt; int ui = 0;
    if (!S.next(0, cur)) return;
    f32x4 acc[2][2][4][2];
#pragma unroll
    for (int a = 0; a < 2; ++a)
#pragma unroll
        for (int b = 0; b < 2; ++b)
#pragma unroll
            for (int m = 0; m < 4; ++m)
#pragma unroll
                for (int n = 0; n < 2; ++n) acc[a][b][m][n] = (f32x4){0.f, 0.f, 0.f, 0.f};
    bf16x8 At[4][2], B0[2][2], B1[2][2];
    const char* cA = GATHER ? Aall : cur.a; const char* cB = cur.b;
    if (GATHER) PG8_GOFF(gv, cur);
#define PG8_STAGE_A(bufoff, gbase, h, vo) do { if (GATHER) PG8_STAGE(bufoff, gbase, (vo)[h]); else PG8_STAGE(bufoff, (gbase) + ((h) ? hstep : 0), voffA); } while (0)
    PG8_STAGE(PG8_SB(0, 0), cB, voffB); PG8_STAGE_A(PG8_SA(0, 0), cA, 0, gv); PG8_STAGE(PG8_SB(0, 1), cB + hstep, voffB); PG8_STAGE_A(PG8_SA(0, 1), cA, 1, gv);
    if (wr == 1) PG8_BAR;
    PG8_WAIT_V(4); PG8_BAR;
    PG8_STAGE(PG8_SB(1, 0), cB + kstep, voffB); PG8_STAGE_A(PG8_SA(1, 0), cA + kstep, 0, gv); PG8_STAGE(PG8_SB(1, 1), cB + hstep + kstep, voffB);
    PG8_WAIT_V(6); PG8_BAR;
    for (;;) {
        const bool has_next = S.next(ui + 1, nxt);
        const char* nA = GATHER ? cA : (has_next ? nxt.a : cA); const char* nB = has_next ? nxt.b : cB;
        if (GATHER) { if (has_next) PG8_GOFF(gn, nxt); else {
#pragma unroll
            for (int h_ = 0; h_ < 2; ++h_)
#pragma unroll
                for (int i_ = 0; i_ < 2; ++i_) gn[h_][i_] = gv[h_][i_]; } }
        for (int t = 0; t < nt; t += 2) {
            const bool last = (t == nt - 2);
            const char* a1 = cA + (size_t)(t + 1) * kstep;
            const char* a2 = last ? nA : cA + (size_t)(t + 2) * kstep; const char* b2 = last ? nB : cB + (size_t)(t + 2) * kstep;
            const char* a3 = a2 + kstep; const char* b3 = b2 + kstep;
            unsigned vo2[2][2];
#pragma unroll
            for (int h_ = 0; h_ < 2; ++h_)
#pragma unroll
                for (int i_ = 0; i_ < 2; ++i_) vo2[h_][i_] = GATHER ? (last ? gn[h_][i_] : gv[h_][i_]) : 0u;
            PG8_LDB(B0, 0, 0); PG8_SCHED; PG8_LDA(At, 0, 0); PG8_STAGE_A(PG8_SA(1, 1), a1, 1, gv);
            PG8_WAIT_L(8); PG8_BAR; PG8_WAIT_L(0); PG8_MMA(0, 0, At, B0); PG8_BAR; PG8_SCHED;
            PG8_LDB(B1, 0, 1); PG8_STAGE(PG8_SB(0, 0), b2, voffB);
            PG8_BAR; PG8_WAIT_L(0); PG8_MMA(0, 1, At, B1); PG8_BAR;
            PG8_LDA(At, 0, 1); PG8_STAGE_A(PG8_SA(0, 0), a2, 0, vo2);
            PG8_BAR; PG8_WAIT_L(0); PG8_MMA(1, 0, At, B0); PG8_BAR; PG8_SCHED;
            PG8_STAGE(PG8_SB(0, 1), b2 + hstep, voffB);
            PG8_WAIT_V(6); PG8_BAR; PG8_MMA(1, 1, At, B1); PG8_BAR;
            PG8_LDB(B0, 1, 0); PG8_SCHED; PG8_LDA(At, 1, 0); PG8_STAGE_A(PG8_SA(0, 1), a2, 1, vo2);
            PG8_WAIT_L(8); PG8_BAR; PG8_WAIT_L(0); PG8_MMA(0, 0, At, B0); PG8_BAR; PG8_SCHED;
            PG8_LDB(B1, 1, 1); PG8_STAGE(PG8_SB(1, 0), b3, voffB);
            PG8_BAR; PG8_WAIT_L(0); PG8_MMA(0, 1, At, B1); PG8_BAR;
            PG8_LDA(At, 1, 1); PG8_STAGE_A(PG8_SA(1, 0), a3, 0, vo2);
            PG8_BAR; PG8_WAIT_L(0); PG8_MMA(1, 0, At, B0); PG8_BAR; PG8_SCHED;
            PG8_STAGE(PG8_SB(1, 1), b3 + hstep, voffB);
            PG8_WAIT_V(6); PG8_BAR; PG8_MMA(1, 1, At, B1); PG8_BAR;
        }
        E(acc, cur, wr, wc, fr, fq);
        if (!has_next) break;
#pragma unroll
        for (int a = 0; a < 2; ++a)
#pragma unroll
            for (int b = 0; b < 2; ++b)
#pragma unroll
                for (int m = 0; m < 4; ++m)
#pragma unroll
                    for (int n = 0; n < 2; ++n) acc[a][b][m][n] = (f32x4){0.f, 0.f, 0.f, 0.f};
        cur = nxt; cA = nA; cB = nB; ++ui;
        if (GATHER) {
#pragma unroll
            for (int h_ = 0; h_ < 2; ++h_)
#pragma unroll
                for (int i_ = 0; i_ < 2; ++i_) gv[h_][i_] = gn[h_][i_]; }
    }
    PG8_WAIT_V(0);
    if (wr == 0) PG8_BAR;
    PG8_BAR;
#undef PG8_SA
#undef PG8_SB
#undef PG8_STAGE
#undef PG8_STAGE_A
#undef PG8_GOFF
#undef PG8_LDA
#undef PG8_LDB
#undef PG8_MMA
#undef PG8_WAIT_V
#undef PG8_WAIT_L
#undef PG8_BAR
#undef PG8_SCHED
}

struct EpiBf16 {
    static constexpr bool PERM = true;
    bf16_t* O; int ldc;
    __device__ __forceinline__ void operator()(const f32x4 (&acc)[2][2][4][2], const Unit& u, int wr, int wc, int fr, int fq) const {
        const int row0 = u.pm * BM + wr * 64 + fr, col0 = u.pn * BM + wc * 32 + 8 * fq;
#pragma unroll
        for (int ai = 0; ai < 2; ++ai)
#pragma unroll
            for (int m = 0; m < 4; ++m) { bf16_t* rowp = O + (size_t)(row0 + ai * HALF + m * 16) * ldc + col0;
#pragma unroll
                for (int bj = 0; bj < 2; ++bj) { const f32x4 v0 = acc[ai][bj][m][0], v1 = acc[ai][bj][m][1];
                    u32x4 w; w.x = cvt_pk_bf16(v0[0], v0[1]); w.y = cvt_pk_bf16(v0[2], v0[3]); w.z = cvt_pk_bf16(v1[0], v1[1]); w.w = cvt_pk_bf16(v1[2], v1[3]);
                    st16_wt(rowp + bj * HALF, w); } }
    }
};
struct EpiResid {
    static constexpr bool PERM = false;
    const float* Cin; float* C; int ldc;
    __device__ __forceinline__ void operator()(const f32x4 (&acc)[2][2][4][2], const Unit& u, int wr, int wc, int fr_, int fq_) const {
        int fr = fr_, fq = fq_; asm volatile("" : "+v"(fr), "+v"(fq));
        const int row0 = u.pm * BM + wr * 64 + fr, col0 = u.pn * BM + wc * 32 + 4 * fq;
#pragma unroll
        for (int ai = 0; ai < 2; ++ai)
#pragma unroll
            for (int mp = 0; mp < 2; ++mp) { f32x4 cv[2][2][2];
#pragma unroll
                for (int mm = 0; mm < 2; ++mm) { const float* rowp = Cin + (size_t)(row0 + ai * HALF + (2 * mp + mm) * 16) * ldc + col0;
#pragma unroll
                    for (int bj = 0; bj < 2; ++bj)
#pragma unroll
                        for (int n = 0; n < 2; ++n) cv[mm][bj][n] = *(const f32x4*)(rowp + bj * HALF + n * 16); }
#pragma unroll
                for (int mm = 0; mm < 2; ++mm) { float* rowp = C + (size_t)(row0 + ai * HALF + (2 * mp + mm) * 16) * ldc + col0;
#pragma unroll
                    for (int bj = 0; bj < 2; ++bj)
#pragma unroll
                        for (int n = 0; n < 2; ++n) { const f32x4 o_ = cv[mm][bj][n] + acc[ai][bj][2 * mp + mm][n]; st16_wt(rowp + bj * HALF + n * 16, __builtin_bit_cast(u32x4, o_)); } }
                asm volatile("" ::: "memory"); }
    }
};
template <int ACT  > struct EpiGated {
    static constexpr bool PERM = true;
    bf16_t* O; int ldo; int coloff; const float* ba; const float* bb;
    __device__ __forceinline__ void operator()(const f32x4 (&acc)[2][2][4][2], const Unit& u, int wr, int wc, int fr, int fq) const {
        const int row0 = u.pm * BM + wr * 64 + fr, cl = u.pn * HALF + wc * 32 + 8 * fq;
        float va[8], vb[8];
#pragma unroll
        for (int j = 0; j < 8; ++j) { va[j] = (ACT == 0) ? ba[cl + j] : 0.f; vb[j] = (ACT == 0) ? bb[cl + j] : 0.f; }
#pragma unroll
        for (int ai = 0; ai < 2; ++ai)
#pragma unroll
            for (int m = 0; m < 4; ++m) { bf16_t* rowp = O + (size_t)(row0 + ai * HALF + m * 16) * ldo + coloff + cl;
                float o[8];
#pragma unroll
                for (int n = 0; n < 2; ++n)
#pragma unroll
                    for (int j = 0; j < 4; ++j) { const float a = acc[ai][0][m][n][j] + va[4 * n + j], b = acc[ai][1][m][n][j] + vb[4 * n + j];
                        o[4 * n + j] = (ACT == 0) ? a * sigmoidf_(b) : siluf_(a) * b; }
                u32x4 w; w.x = cvt_pk_bf16(o[0], o[1]); w.y = cvt_pk_bf16(o[2], o[3]); w.z = cvt_pk_bf16(o[4], o[5]); w.w = cvt_pk_bf16(o[6], o[7]);
                st16_wt(rowp, w); asm volatile("" ::: "memory"); }
    }
};
struct EpiMoeOut {
    static constexpr bool PERM = true;
    bf16_t* O; const int* row_tok; const float* row_w; LAS unsigned char* lds;
    __device__ __forceinline__ void operator()(const f32x4 (&acc)[2][2][4][2], const Unit& u, int wr, int wc, int fr_, int fq_) const {
        int fr = fr_, fq = fq_; asm volatile("" : "+v"(fr), "+v"(fq));
        const int col0 = u.pn * BM + wc * 32 + 8 * fq, lane = fq * 16 + fr;
        LAS u32x2* rinfo = (LAS u32x2*)(lds + STAGE_BYTES) + (wr * 4 + wc) * 128;
        { const int ra = u.pm * BM + wr * 64 + lane, rb = ra + HALF;
          const u32x2 ia = (u32x2){(unsigned)row_tok[ra], __float_as_uint(row_w[ra])}, ib = (u32x2){(unsigned)row_tok[rb], __float_as_uint(row_w[rb])};
          rinfo[lane] = ia; rinfo[64 + lane] = ib; }
#pragma unroll
        for (int ai = 0; ai < 2; ++ai)
#pragma unroll
            for (int m = 0; m < 4; ++m) { const u32x2 inf = rinfo[ai * 64 + m * 16 + fr]; const int ts = (int)inf.x; const float w = __uint_as_float(inf.y);
                if (ts >= 0) { bf16_t* rowp = O + ((size_t)(ts & 1) * NTOK + (size_t)(ts >> 1)) * DM + col0;
#pragma unroll
                    for (int bj = 0; bj < 2; ++bj) { const f32x4 v0 = acc[ai][bj][m][0] * w, v1 = acc[ai][bj][m][1] * w;
                        u32x4 q; q.x = cvt_pk_bf16(v0[0], v0[1]); q.y = cvt_pk_bf16(v0[2], v0[3]); q.z = cvt_pk_bf16(v1[0], v1[1]); q.w = cvt_pk_bf16(v1[2], v1[3]);
                        st16_wt(rowp + bj * HALF, q); } } }
    }
};
struct MoeOrder {
    int K; const char* A; const char* B; size_t bstride; const LAS int* list;
    static __device__ __forceinline__ void build(LAS int* list, const int* tiles, int nN, int G, int c) {
        const int nrt = tiles[0], nwg = nrt * nN; int n = 0;
        for (int i = 0; ; ++i) { const long L = (long)i * G + c; if (L >= (long)nwg || n >= 20) break;
            int wgid = (int)L; { const int q = nwg / NXCD, r = nwg % NXCD, xcd = wgid % NXCD, off = wgid / NXCD; wgid = (xcd < r ? xcd * (q + 1) : r * (q + 1) + (xcd - r) * q) + off; }
            const int pm = wgid / nN; list[1 + 3 * n] = pm; list[2 + 3 * n] = wgid % nN; list[3 + 3 * n] = tiles[64 + pm]; ++n; }
        list[0] = n;
    }
    __device__ bool next(int i, Unit& u) const {
        const int n = __builtin_amdgcn_readfirstlane(list[0]); if (i >= n) return false;
        u.pm = __builtin_amdgcn_readfirstlane(list[1 + 3 * i]); u.pn = __builtin_amdgcn_readfirstlane(list[2 + 3 * i]); const int e = __builtin_amdgcn_readfirstlane(list[3 + 3 * i]);
        u.a = A + (size_t)u.pm * 256 * K * 2; u.b = B + (size_t)e * bstride + (size_t)u.pn * 256 * K * 2; return true;
    }
};
}

struct Params { const float* in[44]; float* out; unsigned char* ws; int ph_lo, ph_hi; };
enum { I_X = 0, I_NORM1, I_WIN, I_MCONVW, I_MCONVB, I_MDTB, I_MALOG, I_MD, I_MNORM, I_RMU, I_RW0, I_RW2, I_RA0, I_RA2, I_RG2, I_RKK, I_RKA, I_RRK, I_RLNW, I_RLNB,
       I_CKVN, I_CWUK, I_CWUV, I_RELB, I_SARE, I_SAIM, I_SBRE, I_SBIM, I_SCRE, I_SCIM, I_SD, I_SLOGDT, I_SGLUW, I_SGLUB, I_WOUT, I_NORM2, I_WRG, I_BRG, I_WRE, I_BRE,
       I_WGATE, I_WUP, I_WDOWN, I_FNORM };

typedef const float* const __attribute__((address_space(4)))* in_tab_t;
struct Frame {
    LAS unsigned char* lds; int tid, lane, wave, bid, G;
    in_tab_t in; float* out; unsigned char* ws; unsigned* ctl;
    volatile LAS int* misc;
};

__device__ __forceinline__ int q_pop(Frame& F, int qi) {
    __syncthreads();
    if (F.tid == 0) F.misc[0] = (int)__hip_atomic_fetch_add(F.ctl + CW_Q + 64 * qi, 1u, __ATOMIC_RELAXED, __HIP_MEMORY_SCOPE_AGENT);
    __syncthreads();
    return F.misc[0];
}

__device__ __forceinline__ const void* opaque_ptr(const void* p) { const unsigned long long v = (unsigned long long)p; unsigned lo = __builtin_amdgcn_readfirstlane((unsigned)v), hi = __builtin_amdgcn_readfirstlane((unsigned)(v >> 32));
    asm volatile("" : "+s"(lo), "+s"(hi)); return (const void*)(((unsigned long long)hi << 32) | lo); }
__device__ __forceinline__ Frame relocal(const Frame& G) { Frame F = G; asm volatile("" : "+v"(F.tid)); F.ws = (unsigned char*)opaque_ptr(F.ws); F.ctl = (unsigned*)(F.ws + WS_CTL); F.in = (in_tab_t)(unsigned long long)opaque_ptr((const void*)(unsigned long long)F.in); F.lane = F.tid & 63; F.wave = __builtin_amdgcn_readfirstlane(F.tid >> 6); return F; }
template <int K> __device__ __forceinline__ f32x4 mma_nt(const LAS bf16_t* A, int lda, const LAS bf16_t* Bt, int ldb, f32x4 acc, int lane) {
    const int r = lane & 15, g = lane >> 4;
#pragma unroll
    for (int k0 = 0; k0 < K; k0 += 32) {
        const bf16x8 a = *(const LAS bf16x8*)(A + r * lda + k0 + 8 * g);
        const bf16x8 b = *(const LAS bf16x8*)(Bt + r * ldb + k0 + 8 * g);
        acc = __builtin_amdgcn_mfma_f32_16x16x32_bf16(a, b, acc, 0, 0, 0);
    }
    return acc;
}

template <class SrcMap> __device__ __forceinline__ void tr_tile(Frame& F, int ldsrc, bf16_t* dst, int K, int k0, int n0, SrcMap sm) {
    LAS float* tile = (LAS float*)F.lds;
    __syncthreads();
    { const int n4 = (F.tid & 63) * 4, kk = F.tid >> 6; const float* sp = sm(n0 + n4);
      f32x4 v[8];
#pragma unroll
      for (int ps = 0; ps < 8; ++ps) { v[ps] = (f32x4){0.f, 0.f, 0.f, 0.f}; if (sp) v[ps] = __builtin_nontemporal_load((const f32x4*)(sp + (size_t)(k0 + kk + 8 * ps) * ldsrc)); }
#pragma unroll
      for (int ps = 0; ps < 8; ++ps) { LAS float* t = tile + (kk + 8 * ps) * 257 + n4; t[0] = v[ps][0]; t[1] = v[ps][1]; t[2] = v[ps][2]; t[3] = v[ps][3]; } }
    __syncthreads();
    { const int kc = F.tid & 7;
#pragma unroll
      for (int j = 0; j < 4; ++j) { const int n = (F.tid >> 3) + 64 * j; float f[8];
#pragma unroll
          for (int i = 0; i < 8; ++i) f[i] = tile[(8 * kc + i) * 257 + n];
          u32x4 w; w.x = pk2(f[0], f[1]); w.y = pk2(f[2], f[3]); w.z = pk2(f[4], f[5]); w.w = pk2(f[6], f[7]);
          *(u32x4*)(dst + (size_t)(n0 + n) * K + k0 + 8 * kc) = w; } }
}

struct SmIn { const float* base; __device__ __forceinline__ const float* operator()(int n) const {
    int c; if (n < 772) c = n; else if (n < UR) return nullptr; else if (n < UR + 896) c = 772 + (n - UR); else if (n < UC) return nullptr;
    else if (n < UC + 680) c = 1668 + (n - UC); else if (n < US) return nullptr; else if (n < US + 256) c = 2348 + (n - US); else return nullptr; return base + c; } };
struct SmId { const float* base; __device__ __forceinline__ const float* operator()(int n) const { return base + n; } };
struct SmGlu { const float* base; __device__ __forceinline__ const float* operator()(int n) const { const int pn = n >> 8, rr = n & 255; return base + (rr < 128 ? 128 * pn + rr : 256 + 128 * pn + (rr - 128)); } };
struct SmGU { const float* gate; const float* up; __device__ __forceinline__ const float* operator()(int n) const {
    const unsigned long long d = (unsigned long long)up - (unsigned long long)gate; const unsigned long long a = (unsigned long long)gate + (((n & 255) < 128) ? 0ull : d); return (const float*)a + 128 * (n >> 8) + (n & 127); } };
__device__ __forceinline__ void phase_prologue(const Frame& F_) { Frame F = relocal(F_);
    for (int t = F.bid; t < 496; t += F.G) {
        if (t < 352) { const int l = t / 176, r = t % 176, kt = r / 11, nt = r % 11;
            tr_tile(F, NIN, (bf16_t*)(F.ws + WS_WIN) + (size_t)l * NINP * DM, DM, kt * 64, nt * 256, SmIn{F.in[I_WIN] + (size_t)l * DM * NIN}); }
        else if (t < 480) { const int q = t - 352, l = q / 64, r = q % 64, kt = r / 4, nt = r % 4;
            tr_tile(F, DM, (bf16_t*)(F.ws + WS_WOUT) + (size_t)l * DM * DM, DM, kt * 64, nt * 256, SmId{F.in[I_WOUT] + (size_t)l * DM * DM}); }
        else { const int q = t - 480, l = q / 8, r = q % 8, kt = r / 2, nt = r % 2;
            tr_tile(F, 512, (bf16_t*)(F.ws + WS_GLU) + (size_t)l * 512 * 256, 256, kt * 64, nt * 256, SmGlu{F.in[I_SGLUW] + (size_t)l * 256 * 512}); }
    }
    for (int i = F.bid * NTHR + F.tid; i < 2 * 48 * 1024; i += F.G * NTHR) { const int l = i / 49152, r = i % 49152, o = r >> 10, k = r & 1023;
        float v = 0.f; if (o < 32) v = F.in[I_WRE][((size_t)l * DM + k) * 32 + o]; else if (o < 36) v = F.in[I_WRG][((size_t)l * DM + k) * 4 + (o - 32)];
        v *= F.in[I_NORM2][l * DM + k];
        const bf16_t hi = f2bf(v); const bf16_t lo = f2bf(v - bf2f(hi));
        bf16_t* w = (bf16_t*)(F.ws + WS_WRT) + (size_t)l * 2 * 49152; w[r] = hi; w[49152 + r] = lo; }
    for (int i = F.bid * NTHR + F.tid; i < 2048 + 65536; i += F.G * NTHR) {
        if (i < 2048) {
            const int l = i >> 10, gn = i & 1023, g = gn >> 6;
            float* tab = (float*)(F.ws + WS_S5TAB + (size_t)l * S5TAB_L);
            const float lre = fminf(F.in[I_SARE][l * 1024 + gn], -1e-4f), lim = F.in[I_SAIM][l * 1024 + gn];
            const float dt = expf(F.in[I_SLOGDT][l * 16 + g]);
            const float mag = expf(dt * lre); float sn, cs; sincosf(dt * lim, &sn, &cs);
            const float are = mag * cs, aim = mag * sn;
            const float den = lre * lre + lim * lim;
            const float fre = ((are - 1.0f) * lre + aim * lim) / den, fim = (aim * lre - (are - 1.0f) * lim) / den;
            tab[gn * 2] = are; tab[gn * 2 + 1] = aim;
            float pr = are, pi = aim;
#pragma unroll
            for (int s = 0; s < 6; ++s) { const float nr = pr * pr - pi * pi, ni = 2.0f * pr * pi; pr = nr; pi = ni; }
            tab[2048 + gn * 2] = pr; tab[2048 + gn * 2 + 1] = pi;
            const float* bre = F.in[I_SBRE] + ((size_t)l * 1024 + gn) * 16; const float* bim = F.in[I_SBIM] + ((size_t)l * 1024 + gn) * 16;
            bf16_t* bbt = (bf16_t*)(F.ws + WS_S5TAB + (size_t)l * S5TAB_L + S5TAB_BBT); const int n = gn & 63, col = 4 * (n & 31) + 2 * (n >> 5);
            for (int p = 0; p < 16; ++p) { const float vr = fre * bre[p] - fim * bim[p], vi = fre * bim[p] + fim * bre[p];
                bbt[((size_t)g * 128 + col) * 16 + p] = f2bf(vr); bbt[((size_t)g * 128 + col + 1) * 16 + p] = f2bf(vi); }
        } else {
            const int j = i - 2048, l = j >> 15, r = j & 32767, gp = r >> 7, k = r & 127;
            bf16_t* cm = (bf16_t*)(F.ws + WS_S5TAB + (size_t)l * S5TAB_L + S5TAB_F);
            const int n = (k >> 2) + 32 * ((k >> 1) & 1);
            const float v = (k & 1) == 0 ? F.in[I_SCRE][((size_t)l * 256 + gp) * 64 + n] : -F.in[I_SCIM][((size_t)l * 256 + gp) * 64 + n];
            cm[r] = f2bf(v);
        }
    }
}

__device__ __forceinline__ void phase_norm(const Frame& F_, const float* xin, bool add_o, const float* w, int mode) { Frame F = relocal(F_);
    float* X = (float*)(F.ws + WS_X); bf16_t* H = (bf16_t*)(F.ws + WS_H); const bf16_t* O = (const bf16_t*)(F.ws + WS_U);
    for (int row0 = F.bid * 32 + F.wave * 4; row0 < NTOK; row0 += F.G * 32) {
        f32x4 v[4][4]; u32x2 oa[4][4], ob[4][4];
#pragma unroll
        for (int r = 0; r < 4; ++r)
#pragma unroll
            for (int j = 0; j < 4; ++j) { const int c = 4 * F.lane + 256 * j; const size_t o = (size_t)(row0 + r) * DM + c; v[r][j] = (mode == 2) ? __builtin_nontemporal_load((const f32x4*)(xin + o)) : *(const f32x4*)(xin + o);
                if (add_o) { oa[r][j] = __builtin_nontemporal_load((const u32x2*)(O + o)); ob[r][j] = __builtin_nontemporal_load((const u32x2*)(O + (size_t)NTOK * DM + o)); } }
#pragma unroll
        for (int r = 0; r < 4; ++r) { const int row = row0 + r; float ss = 0.f;
#pragma unroll
            for (int j = 0; j < 4; ++j) {
                if (add_o) { const u32x2 a = oa[r][j], b = ob[r][j];
                    v[r][j][0] += __uint_as_float(a.x << 16) + __uint_as_float(b.x << 16); v[r][j][1] += __uint_as_float(a.x & 0xffff0000u) + __uint_as_float(b.x & 0xffff0000u);
                    v[r][j][2] += __uint_as_float(a.y << 16) + __uint_as_float(b.y << 16); v[r][j][3] += __uint_as_float(a.y & 0xffff0000u) + __uint_as_float(b.y & 0xffff0000u); }
                ss += v[r][j][0] * v[r][j][0] + v[r][j][1] * v[r][j][1] + v[r][j][2] * v[r][j][2] + v[r][j][3] * v[r][j][3]; }
            ss = wave_sum(ss);
            const float rstd = rsqrtf(ss * (1.0f / DM) + 1e-6f);
#pragma unroll
            for (int j = 0; j < 4; ++j) { const int c = 4 * F.lane + 256 * j; const f32x4 wv = *(const f32x4*)(w + c);
                if (mode == 2) { __builtin_nontemporal_store(v[r][j] * rstd * wv, (f32x4*)(F.out + (size_t)row * DM + c)); }
                else { if (mode == 0) *(f32x4*)(X + (size_t)row * DM + c) = v[r][j];
                    u32x2 o; o.x = pk2(v[r][j][0] * rstd * wv[0], v[r][j][1] * rstd * wv[1]); o.y = pk2(v[r][j][2] * rstd * wv[2], v[r][j][3] * rstd * wv[3]);
                    *(u32x2*)(H + (size_t)row * DM + c) = o; } } }
    }
}

__device__ __forceinline__ void item_kv(const Frame& F_, int layer, int item) { Frame F = relocal(F_);
    const bf16_t* U = (const bf16_t*)(F.ws + WS_U);
    LAS bf16_t* Ab = (LAS bf16_t*)F.lds;
    LAS bf16_t* Bt = (LAS bf16_t*)(F.lds + 17408);
    const int t0 = item * 64;
    { const int tok = F.tid >> 3, part = F.tid & 7; const bf16_t* src = U + (size_t)(t0 + tok) * NINP + UC + 256 + 16 * part;
      float f[16]; { float a[8], b[8]; unpack8(*(const u32x4*)src, a); unpack8(*(const u32x4*)(src + 8), b);
#pragma unroll
        for (int j = 0; j < 8; ++j) { f[j] = a[j]; f[8 + j] = b[j]; } }
      float ss = 0.f;
#pragma unroll
      for (int j = 0; j < 16; ++j) ss += f[j] * f[j];
      ss = sum8(ss);
      const float rstd = rsqrtf(ss * (1.0f / 128.0f) + 1e-6f); const float* nw = F.in[I_CKVN] + layer * 128 + 16 * part;
#pragma unroll
      for (int j = 0; j < 16; j += 2) *(LAS unsigned*)(Ab + tok * 136 + 16 * part + j) = pk2(f[j] * rstd * nw[j], f[j + 1] * rstd * nw[j + 1]); }
    { const int n = F.tid >> 2, kq = F.tid & 3; const float* w = (n < 64 ? F.in[I_CWUK] : F.in[I_CWUV]) + (size_t)layer * 128 * 64 + (n & 63);
      float wv[32];
#pragma unroll
      for (int k = 0; k < 32; ++k) wv[k] = w[(size_t)(32 * kq + k) * 64];
#pragma unroll
      for (int k = 0; k < 32; k += 2) *(LAS unsigned*)(Bt + n * 136 + 32 * kq + k) = pk2(wv[k], wv[k + 1]); }
    if (F.tid < 256) { const int tok = F.tid >> 2, q = F.tid & 3;
        *(u32x4*)((bf16_t*)(F.ws + WS_KIDX) + (size_t)(t0 + tok) * 32 + 8 * q) = *(const u32x4*)(U + (size_t)(t0 + tok) * NINP + UC + 640 + 8 * q); }
    __syncthreads();
    const int mt = F.wave & 3, g = F.lane >> 4, r = F.lane & 15;
#pragma unroll
    for (int q = 0; q < 4; ++q) { const int nt = (F.wave >> 2) * 4 + q;
        f32x4 acc = (f32x4){0.f, 0.f, 0.f, 0.f};
        acc = mma_nt<128>(Ab + mt * 16 * 136, 136, Bt + nt * 16 * 136, 136, acc, F.lane);
        const int n = nt * 16 + r; bf16_t* dst = (bf16_t*)(F.ws + (n < 64 ? WS_K : WS_V));
#pragma unroll
        for (int i = 0; i < 4; ++i) dst[(size_t)(t0 + mt * 16 + 4 * g + i) * 64 + (n & 63)] = f2bf(acc[i]); }
}

constexpr int MB_CG = 0, MB_BG = 18432, MB_XT = 36864, MB_BT = 73728, MB_M = 73728, MB_S0 = 110592, MB_DT = 147456, MB_AC = 148480, MB_RS = 149504;
static_assert(MB_RS + 256 <= MISC_OFF && MB_BT == MB_XT + 4 * 64 * 72 * 2, "mamba LDS");
template <int STAGE> __device__ __forceinline__ void item_mamba(const Frame& F_, int layer, int item) { Frame F = relocal(F_);
    const bf16_t* U = (const bf16_t*)(F.ws + WS_U);
    const int b = item >> 6, c = item & 63, l0 = c * 64; const size_t T0 = (size_t)b * SEQ + l0;
    LAS bf16_t* Cg = (LAS bf16_t*)(F.lds + MB_CG); LAS bf16_t* Bg = (LAS bf16_t*)(F.lds + MB_BG); LAS bf16_t* BT = (LAS bf16_t*)(F.lds + MB_BT);
    LAS bf16_t* XT = (LAS bf16_t*)(F.lds + MB_XT); LAS bf16_t* Mb = (LAS bf16_t*)(F.lds + MB_M); LAS bf16_t* S0 = (LAS bf16_t*)(F.lds + MB_S0);
    LAS float* dts = (LAS float*)(F.lds + MB_DT); LAS float* acs = (LAS float*)(F.lds + MB_AC); LAS float* rs = (LAS float*)(F.lds + MB_RS);
    const int tg = F.tid & 7, c0 = (F.tid >> 3) * 8;
    const bool conv_on = (STAGE == 2) || (F.wave < 6);
    u32x4 rows[11]; float wv[4][8], bv[8];
    if (conv_on) {
#pragma unroll
        for (int k = 0; k < 11; ++k) { const int l = l0 + tg * 8 - 3 + k;
            if (l >= 0) rows[k] = *(const u32x4*)(U + ((size_t)b * SEQ + l) * NINP + UM + 256 + c0); else rows[k] = (u32x4){0u, 0u, 0u, 0u}; }
#pragma unroll
        for (int j = 0; j < 8; ++j) { bv[j] = F.in[I_MCONVB][layer * 512 + c0 + j];
#pragma unroll
            for (int k = 0; k < 4; ++k) wv[k][j] = F.in[I_MCONVW][(layer * 4 + k) * 512 + c0 + j]; } }
    const float* MSTi = (const float*)(F.ws + WS_MST) + ((size_t)(b * 64 + c) * 4) * 4096;
    f32x4 s0a[4], s0b[4];
    if (STAGE == 2) {
#pragma unroll
        for (int h = 0; h < 4; ++h) { const float* src = MSTi + (size_t)h * 4096 + F.tid * 8; s0a[h] = *(const f32x4*)src; s0b[h] = *(const f32x4*)(src + 4); } }
    if (F.wave < 4) { const int l = F.lane, h = F.wave;
        const float raw = bf2f(U[(T0 + l) * NINP + UM + 768 + h]) + F.in[I_MDTB][layer * 4 + h];
        const float dt = softplusf_(raw); const float cum = wave_prefix_f(-__expf(F.in[I_MALOG][layer * 4 + h]) * dt);
        dts[l * 4 + h] = dt; acs[l * 4 + h] = cum; }
    if (STAGE == 2) { if (F.tid < 64) rs[F.tid] = 0.f;
#pragma unroll
        for (int h = 0; h < 4; ++h) { u32x4 w; w.x = pk2(s0a[h][0], s0a[h][1]); w.y = pk2(s0a[h][2], s0a[h][3]); w.z = pk2(s0b[h][0], s0b[h][1]); w.w = pk2(s0b[h][2], s0b[h][3]);
            *(LAS u32x4*)(S0 + (h * 64 + (F.tid >> 3)) * 72 + (F.tid & 7) * 8) = w; } }
    __syncthreads();
    if (conv_on) {
        float win[3][8]; unpack8(rows[0], win[0]); unpack8(rows[1], win[1]); unpack8(rows[2], win[2]);
        const bool isx = F.wave < 4, tr = isx || STAGE == 1;
        unsigned pkT[8][4]; float prev[8];
#pragma unroll
        for (int i = 0; i < 8; ++i) { const int l = tg * 8 + i; float cur[8]; unpack8(rows[3 + i], cur);
            float o[8];
#pragma unroll
            for (int j = 0; j < 8; ++j) { o[j] = siluf_(bv[j] + wv[0][j] * win[0][j] + wv[1][j] * win[1][j] + wv[2][j] * win[2][j] + wv[3][j] * cur[j]);
                win[0][j] = win[1][j]; win[1][j] = win[2][j]; win[2][j] = cur[j]; }
            if (isx) { const int h = F.wave; float sc = dts[l * 4 + h]; if (STAGE == 1) sc *= __expf(acs[63 * 4 + h] - acs[l * 4 + h]);
#pragma unroll
                for (int j = 0; j < 8; ++j) o[j] *= sc; }
            if (tr) {
#pragma unroll
                for (int j = 0; j < 8; ++j) { if (i & 1) pkT[j][i >> 1] = pk2(prev[j], o[j]); else prev[j] = o[j]; } }
            else { u32x4 w; w.x = pk2(o[0], o[1]); w.y = pk2(o[2], o[3]); w.z = pk2(o[4], o[5]); w.w = pk2(o[6], o[7]);
                *(LAS u32x4*)(Cg + (F.wave < 6 ? (MB_BG - MB_CG) / 2 : 0) + ((F.wave & 1) * 64 + l) * 72 + (c0 & 63)) = w; } }
        if (tr) { LAS bf16_t* dstT = XT + F.wave * 64 * 72;
#pragma unroll
            for (int j = 0; j < 8; ++j) *(LAS u32x4*)(dstT + ((c0 & 63) + j) * 72 + tg * 8) = (u32x4){pkT[j][0], pkT[j][1], pkT[j][2], pkT[j][3]}; } }
    const int g4 = F.lane >> 4, r16 = F.lane & 15;
    if (STAGE == 1) {
        __syncthreads();
        float* MST = (float*)(F.ws + WS_MST) + ((size_t)(b * 64 + c) * 4) * 4096;
#pragma unroll
        for (int q = 0; q < 8; ++q) { const int tix = F.wave * 8 + q, h = tix >> 4, mt = (tix >> 2) & 3, nt = tix & 3;
            f32x4 acc = (f32x4){0.f, 0.f, 0.f, 0.f};
            acc = mma_nt<64>(XT + (h * 64 + mt * 16) * 72, 72, BT + ((h >> 1) * 64 + nt * 16) * 72, 72, acc, F.lane);
#pragma unroll
            for (int i = 0; i < 4; ++i) MST[(size_t)h * 4096 + (mt * 16 + 4 * g4 + i) * 64 + nt * 16 + r16] = acc[i]; }
        if (F.tid < 4) ((float*)(F.ws + WS_MDEC))[(b * 64 + c) * 4 + F.tid] = __expf(acs[63 * 4 + F.tid]);
    } else {
        const int mt = F.wave & 3, nh = F.wave >> 2;
        bf16_t zz[4][2][4];
#pragma unroll
        for (int h = 0; h < 4; ++h)
#pragma unroll
            for (int q = 0; q < 2; ++q)
#pragma unroll
                for (int i = 0; i < 4; ++i) zz[h][q][i] = U[(T0 + mt * 16 + 4 * g4 + i) * NINP + UM + h * 64 + (2 * nh + q) * 16 + r16];
        __syncthreads();
        f32x4 yv[4][2];
#pragma unroll
        for (int g = 0; g < 2; ++g)
#pragma unroll
            for (int q = 0; q < 2; ++q) { f32x4 G = (f32x4){0.f, 0.f, 0.f, 0.f};
                G = mma_nt<64>(Bg + (g * 64 + (2 * nh + q) * 16) * 72, 72, Cg + (g * 64 + mt * 16) * 72, 72, G, F.lane);
                const int s0 = (2 * nh + q) * 16 + 4 * g4, l = mt * 16 + r16;
#pragma unroll
                for (int hh = 0; hh < 2; ++hh) { const int h = 2 * g + hh; const float al = acs[l * 4 + h]; float v[4];
#pragma unroll
                    for (int i = 0; i < 4; ++i) v[i] = (s0 + i <= l) ? G[i] * __expf(al - acs[(s0 + i) * 4 + h]) : 0.f;
                    *(LAS u32x2*)(Mb + (h * 64 + l) * 72 + s0) = (u32x2){pk2(v[0], v[1]), pk2(v[2], v[3])}; } }
        __syncthreads();
#pragma unroll
        for (int h = 0; h < 4; ++h) { const int g = h >> 1;
#pragma unroll
            for (int q = 0; q < 2; ++q) { const int nt = 2 * nh + q;
                f32x4 yd = (f32x4){0.f, 0.f, 0.f, 0.f}, yo = (f32x4){0.f, 0.f, 0.f, 0.f};
                yd = mma_nt<64>(Mb + (h * 64 + mt * 16) * 72, 72, XT + (h * 64 + nt * 16) * 72, 72, yd, F.lane);
                yo = mma_nt<64>(Cg + (g * 64 + mt * 16) * 72, 72, S0 + (h * 64 + nt * 16) * 72, 72, yo, F.lane);
                const int p = nt * 16 + r16; const float dsk = F.in[I_MD][layer * 4 + h];
#pragma unroll
                for (int i = 0; i < 4; ++i) { const int l = mt * 16 + 4 * g4 + i;
                    const float xs = bf2f(XT[(h * 64 + p) * 72 + l]) / dts[l * 4 + h];
                    yv[h][q][i] = yd[i] + yo[i] * __expf(acs[l * 4 + h]) + dsk * xs; } } }
        float part[4] = {0.f, 0.f, 0.f, 0.f};
#pragma unroll
        for (int h = 0; h < 4; ++h)
#pragma unroll
            for (int q = 0; q < 2; ++q) {
#pragma unroll
                for (int i = 0; i < 4; ++i) { const float z = bf2f(zz[h][q][i]);
                    const float v = yv[h][q][i] * siluf_(z); yv[h][q][i] = v; part[i] += v * v; } }
#pragma unroll
        for (int i = 0; i < 4; ++i) { const float s = sum16(part[i]); if (r16 == 0) atomicAdd((float*)(rs + mt * 16 + 4 * g4 + i), s); }
        __syncthreads();
        bf16_t* Y = (bf16_t*)(F.ws + WS_H);
#pragma unroll
        for (int i = 0; i < 4; ++i) { const int l = mt * 16 + 4 * g4 + i; const float rstd = rsqrtf(rs[l] * (1.0f / 256.0f) + 1e-6f);
#pragma unroll
            for (int h = 0; h < 4; ++h)
#pragma unroll
                for (int q = 0; q < 2; ++q) { const int ch = h * 64 + (2 * nh + q) * 16 + r16;
                    Y[(T0 + l) * DM + ch] = f2bf(yv[h][q][i] * rstd * F.in[I_MNORM][layer * 256 + ch]); } }
    }
}
__device__ __forceinline__ void item_mamba_carry(const Frame& F_, int item) { Frame F = relocal(F_);
    const int b = item >> 2, h = item & 3;
    float* MST = (float*)(F.ws + WS_MST); const float* MD = (const float*)(F.ws + WS_MDEC);
    float s[8];
#pragma unroll
    for (int j = 0; j < 8; ++j) s[j] = 0.f;
    for (int c = 0; c < 64; ++c) { float* p = MST + ((size_t)(b * 64 + c) * 4 + h) * 4096 + F.tid * 8; const float d = MD[(b * 64 + c) * 4 + h];
        const f32x4 a = *(f32x4*)p, q = *(f32x4*)(p + 4);
        *(f32x4*)p = (f32x4){s[0], s[1], s[2], s[3]}; *(f32x4*)(p + 4) = (f32x4){s[4], s[5], s[6], s[7]};
        s[0] = s[0] * d + a[0]; s[1] = s[1] * d + a[1]; s[2] = s[2] * d + a[2]; s[3] = s[3] * d + a[3];
        s[4] = s[4] * d + q[0]; s[5] = s[5] * d + q[1]; s[6] = s[6] * d + q[2]; s[7] = s[7] * d + q[3]; }
}

template <int STAGE> __device__ __forceinline__ void item_s5(const Frame& F_, int layer, int item) { Frame F = relocal(F_);
    const bf16_t* U = (const bf16_t*)(F.ws + WS_U);
    const int b = item >> 6, c = item & 63; const size_t T0 = (size_t)b * SEQ + c * 64;
    LAS bf16_t* us = (LAS bf16_t*)F.lds;
    LAS bf16_t* BuW = (LAS bf16_t*)(F.lds + 33792) + F.wave * 4224;
    const float* tab = (const float*)(F.ws + WS_S5TAB + (size_t)layer * S5TAB_L);
    { const int tok = F.tid >> 3, part = F.tid & 7;
#pragma unroll
      for (int q = 0; q < 4; ++q) *(LAS u32x4*)(us + tok * 264 + 32 * part + 8 * q) = *(const u32x4*)(U + (T0 + tok) * NINP + US + 32 * part + 8 * q); }
    const int lane = F.lane, r16 = lane & 15, g4 = lane >> 4, gq = lane >> 5, n0 = lane & 31, g = 2 * F.wave + gq, gn0 = g * 64 + n0, gn1 = gn0 + 32;
    bf16x8 bfr[2][8];
    { const bf16_t* bbt = (const bf16_t*)(F.ws + WS_S5TAB + (size_t)layer * S5TAB_L + S5TAB_BBT);
#pragma unroll
      for (int gg = 0; gg < 2; ++gg)
#pragma unroll
          for (int nt = 0; nt < 8; ++nt) { u32x4 z = (u32x4){0u, 0u, 0u, 0u}; if (g4 < 2) z = *(const u32x4*)(bbt + ((size_t)(2 * F.wave + gg) * 128 + 16 * nt + r16) * 16 + 8 * g4); bfr[gg][nt] = __builtin_bit_cast(bf16x8, z); } }
    const float a0r = tab[gn0 * 2], a0i = tab[gn0 * 2 + 1], a1r = tab[gn1 * 2], a1i = tab[gn1 * 2 + 1];
    float* ST = (float*)(F.ws + WS_S5ST) + (size_t)(b * 64 + c) * 2048;
    float h0r = 0.f, h0i = 0.f, h1r = 0.f, h1i = 0.f;
    if (STAGE == 2) { h0r = ST[gn0 * 2]; h0i = ST[gn0 * 2 + 1]; h1r = ST[gn1 * 2]; h1i = ST[gn1 * 2 + 1]; }
    bf16x8 cf[2][4];
    if (STAGE == 2) { const bf16_t* cm = (const bf16_t*)(F.ws + WS_S5TAB + (size_t)layer * S5TAB_L + S5TAB_F);
#pragma unroll
        for (int gg = 0; gg < 2; ++gg)
#pragma unroll
            for (int ks = 0; ks < 4; ++ks) cf[gg][ks] = *(const bf16x8*)(cm + ((size_t)((2 * F.wave + gg) * 16 + r16)) * 128 + 32 * ks + 8 * g4); }
    LAS bf16_t* YSl = (LAS bf16_t*)(F.lds + 101376);
    const bf16_t* GW = (const bf16_t*)(F.ws + WS_GLU) + (size_t)layer * 512 * 256;
    float dsk[2] = {0.f, 0.f}, bvl[2] = {0.f, 0.f}, bgt[2] = {0.f, 0.f}; bf16x8 gwb[2][4];
    if (STAGE == 2) {
#pragma unroll
        for (int gg = 0; gg < 2; ++gg) dsk[gg] = F.in[I_SD][layer * 256 + (2 * F.wave + gg) * 16 + r16];
#pragma unroll
        for (int q = 0; q < 2; ++q) { const int c = 32 * F.wave + 16 * q + r16; bvl[q] = F.in[I_SGLUB][layer * 512 + c]; bgt[q] = F.in[I_SGLUB][layer * 512 + 256 + c]; }
#pragma unroll
        for (int ks = 0; ks < 2; ++ks)
#pragma unroll
            for (int q = 0; q < 2; ++q) { const int c = 32 * F.wave + 16 * q + r16; const int rowv = 256 * (c >> 7) + (c & 127);
                gwb[ks][2 * q] = *(const bf16x8*)(GW + (size_t)rowv * 256 + 32 * ks + 8 * g4); gwb[ks][2 * q + 1] = *(const bf16x8*)(GW + (size_t)(rowv + 128) * 256 + 32 * ks + 8 * g4); } }
    __syncthreads();
#pragma unroll 1
    for (int lb = 0; lb < 4; ++lb) {
#pragma unroll
        for (int gg = 0; gg < 2; ++gg) { u32x4 z = (u32x4){0u, 0u, 0u, 0u}; if (g4 < 2) z = *(const LAS u32x4*)(us + (16 * lb + r16) * 264 + (2 * F.wave + gg) * 16 + 8 * g4);
            const bf16x8 afr = __builtin_bit_cast(bf16x8, z);
#pragma unroll
            for (int nt = 0; nt < 8; ++nt) { const f32x4 acc = __builtin_amdgcn_mfma_f32_16x16x32_bf16(bfr[gg][nt], afr, (f32x4){0.f, 0.f, 0.f, 0.f}, 0, 0, 0);
                *(LAS u32x2*)(BuW + r16 * 264 + gg * 128 + 16 * nt + 4 * g4) = (u32x2){pk2(acc[0], acc[1]), pk2(acc[2], acc[3])}; } }
        __syncthreads();
#pragma unroll 4
        for (int li = 0; li < 16; ++li) { LAS u32x2* bp = (LAS u32x2*)(BuW + li * 264 + gq * 128 + 4 * n0); const u32x2 v = *bp;
            { const float br = __uint_as_float(v.x << 16), bi = __uint_as_float(v.x & 0xffff0000u); const float nr = a0r * h0r - a0i * h0i + br, ni = a0r * h0i + a0i * h0r + bi; h0r = nr; h0i = ni; }
            { const float br = __uint_as_float(v.y << 16), bi = __uint_as_float(v.y & 0xffff0000u); const float nr = a1r * h1r - a1i * h1i + br, ni = a1r * h1i + a1i * h1r + bi; h1r = nr; h1i = ni; }
            if (STAGE == 2) *bp = (u32x2){pk2(h0r, h0i), pk2(h1r, h1i)}; }
        __syncthreads();
        if (STAGE == 2) {
#pragma unroll
            for (int gg = 0; gg < 2; ++gg) { f32x4 acc = (f32x4){0.f, 0.f, 0.f, 0.f};
#pragma unroll
                for (int ks = 0; ks < 4; ++ks) { const bf16x8 a = *(const LAS bf16x8*)(BuW + r16 * 264 + gg * 128 + 32 * ks + 8 * g4);
                    acc = __builtin_amdgcn_mfma_f32_16x16x32_bf16(a, cf[gg][ks], acc, 0, 0, 0); }
                const int ch = (2 * F.wave + gg) * 16 + r16;
#pragma unroll
                for (int i = 0; i < 4; ++i) { const int l = lb * 16 + 4 * g4 + i; const float y = acc[i] + dsk[gg] * bf2f(us[l * 264 + ch]);
                    YSl[l * 264 + ch] = f2bf(gelu_tanh(y)); } }
            __syncthreads();
        }
    }
    if (STAGE == 1) { ST[gn0 * 2] = h0r; ST[gn0 * 2 + 1] = h0i; ST[gn1 * 2] = h1r; ST[gn1 * 2 + 1] = h1i; }
    if (STAGE == 2) {
        f32x4 av[4][2], ag[4][2];
#pragma unroll
        for (int m = 0; m < 4; ++m)
#pragma unroll
            for (int q = 0; q < 2; ++q) { av[m][q] = (f32x4){0.f, 0.f, 0.f, 0.f}; ag[m][q] = (f32x4){0.f, 0.f, 0.f, 0.f}; }
#pragma unroll
        for (int ks = 0; ks < 8; ++ks) {
            bf16x8 af[4], bcur[4];
#pragma unroll
            for (int j = 0; j < 4; ++j) bcur[j] = gwb[ks & 1][j];
            if (ks + 2 < 8) {
#pragma unroll
                for (int q = 0; q < 2; ++q) { const int c = 32 * F.wave + 16 * q + r16; const int rowv = 256 * (c >> 7) + (c & 127);
                    gwb[ks & 1][2 * q] = *(const bf16x8*)(GW + (size_t)rowv * 256 + 32 * (ks + 2) + 8 * g4); gwb[ks & 1][2 * q + 1] = *(const bf16x8*)(GW + (size_t)(rowv + 128) * 256 + 32 * (ks + 2) + 8 * g4); } }
#pragma unroll
            for (int m = 0; m < 4; ++m) af[m] = *(const LAS bf16x8*)(YSl + (16 * m + r16) * 264 + 32 * ks + 8 * g4);
#pragma unroll
            for (int m = 0; m < 4; ++m)
#pragma unroll
                for (int q = 0; q < 2; ++q) { av[m][q] = __builtin_amdgcn_mfma_f32_16x16x32_bf16(af[m], bcur[2 * q], av[m][q], 0, 0, 0); ag[m][q] = __builtin_amdgcn_mfma_f32_16x16x32_bf16(af[m], bcur[2 * q + 1], ag[m][q], 0, 0, 0); }
        }
        bf16_t* Y = (bf16_t*)(F.ws + WS_H);
#pragma unroll
        for (int q = 0; q < 2; ++q) { const int c = 32 * F.wave + 16 * q + r16;
#pragma unroll
            for (int m = 0; m < 4; ++m)
#pragma unroll
                for (int i = 0; i < 4; ++i) Y[(T0 + 16 * m + 4 * g4 + i) * DM + 768 + c] = f2bf((av[m][q][i] + bvl[q]) * sigmoidf_(ag[m][q][i] + bgt[q])); }
    }
}
__device__ __forceinline__ void item_s5_carry(const Frame& F_, int layer, int b) { Frame F = relocal(F_);
    const float* tab = (const float*)(F.ws + WS_S5TAB + (size_t)layer * S5TAB_L) + 2048;
    float* ST = (float*)(F.ws + WS_S5ST) + (size_t)b * 64 * 2048;
#pragma unroll
    for (int q = 0; q < 2; ++q) { const int gn = F.tid + 512 * q; const float pr = tab[gn * 2], pi = tab[gn * 2 + 1]; float hr = 0.f, hi = 0.f;
        for (int c = 0; c < 64; ++c) { float* p = ST + (size_t)c * 2048 + gn * 2; const float tr = p[0], ti = p[1]; p[0] = hr; p[1] = hi;
            const float nr = pr * hr - pi * hi + tr, ni = pr * hi + pi * hr + ti; hr = nr; hi = ni; } }
}

constexpr int RB_LD = 72;
constexpr int RW_R = 0, RW_K = 16384, RW_V = 32768, RW_W = 49152, RW_A = 65536, RW_B = 81920;
constexpr int R3_G = 49152, R3_O = 65536, R3_TILES = 81920, R3_BON = 147456;
template <int STAGE> __device__ __forceinline__ void rwkv_prep(const Frame& F_, int layer, int b, int h, int c) { Frame F = relocal(F_);
    const bf16_t* U = (const bf16_t*)(F.ws + WS_U);
    const int l0 = c * 64; const size_t T0 = (size_t)b * SEQ + l0;
    LAS float* Rr = (LAS float*)(F.lds + RW_R); LAS float* Kk = (LAS float*)(F.lds + RW_K); LAS float* Vv = (LAS float*)(F.lds + RW_V); LAS float* Ww = (LAS float*)(F.lds + RW_W);
    LAS float* Aa = (LAS float*)(F.lds + (STAGE == 1 ? RW_A : R3_O)); LAS float* Bb = (LAS float*)(F.lds + RW_B); LAS float* Gg = (LAS float*)(F.lds + R3_G); LAS float* BON = (LAS float*)(F.lds + R3_BON);
    LAS bf16_t* TWb = (LAS bf16_t*)(F.lds + 98304); LAS bf16_t* DAb = (LAS bf16_t*)(F.lds + (STAGE == 1 ? 103424 : 118784)); LAS bf16_t* SGb = (LAS bf16_t*)(F.lds + 123904);
    LAS bf16_t* w2T = (LAS bf16_t*)(F.lds + 108544); LAS bf16_t* a2T = (LAS bf16_t*)(F.lds + (STAGE == 1 ? 113664 : 133120)); LAS bf16_t* g2T = (LAS bf16_t*)(F.lds + 138240);
    const float* mu = F.in[I_RMU] + layer * 896;
    float pw0[2] = {0.f, 0.f}, pa0[2] = {0.f, 0.f}; f32x4 pkkw[2], pkaw[2], prk[2];
    if (STAGE == 1) { const int cgl = layer * 256 + h * 64 + 8 * (F.tid & 7);
#pragma unroll
        for (int q = 0; q < 2; ++q) { pkkw[q] = *(const f32x4*)(F.in[I_RKK] + cgl + 4 * q); pkaw[q] = *(const f32x4*)(F.in[I_RKA] + cgl + 4 * q); prk[q] = *(const f32x4*)(F.in[I_RRK] + cgl + 4 * q); }
#pragma unroll
        for (int q = 0; q < 2; ++q) { const int cg = layer * 256 + h * 64 + 16 * (2 * (F.wave & 1) + q) + (F.lane & 15); pw0[q] = F.in[I_RW0][cg]; pa0[q] = F.in[I_RA0][cg]; } }
    { const int tok = F.tid >> 3, p8 = F.tid & 7; const bool first = (l0 + tok == 0);
      const bf16_t* cur = U + (T0 + tok) * NINP + UR; const bf16_t* prv = first ? cur : cur - NINP;
      const float pz = first ? 0.f : 1.f;
      u32x4 cw[3], pw[3]; u32x2 c1 = (u32x2){0u, 0u}, p1 = (u32x2){0u, 0u}, c2 = (u32x2){0u, 0u}, p2 = (u32x2){0u, 0u}; u32x4 c3 = (u32x4){0u, 0u, 0u, 0u}, p3 = (u32x4){0u, 0u, 0u, 0u};
#pragma unroll
      for (int sec = (STAGE == 1 ? 0 : 2); sec < 3; ++sec) { const int co = sec * 256 + h * 64 + 8 * p8; cw[sec] = *(const u32x4*)(cur + co); pw[sec] = *(const u32x4*)(prv + co); }
      if (STAGE == 1) { c1 = *(const u32x2*)(cur + 768 + 4 * p8); p1 = *(const u32x2*)(prv + 768 + 4 * p8); c2 = *(const u32x2*)(cur + 800 + 4 * p8); p2 = *(const u32x2*)(prv + 800 + 4 * p8); }
      if (STAGE == 3) { c3 = *(const u32x4*)(cur + 832 + 8 * p8); p3 = *(const u32x4*)(prv + 832 + 8 * p8); }
#pragma unroll
      for (int sec = (STAGE == 1 ? 0 : 2); sec < 3; ++sec) { const int co = sec * 256 + h * 64 + 8 * p8; float av[8], pq[8]; unpack8(cw[sec], av); unpack8(pw[sec], pq);
          const f32x4 m0 = *(const f32x4*)(mu + co), m1 = *(const f32x4*)(mu + co + 4);
          LAS float* dst = (sec == 0 ? Rr : sec == 1 ? Kk : Vv) + tok * 64 + 8 * p8;
#pragma unroll
          for (int j = 0; j < 8; ++j) pq[j] *= pz;
          *(LAS f32x4*)dst = (f32x4){av[0] + m0[0] * (pq[0] - av[0]), av[1] + m0[1] * (pq[1] - av[1]), av[2] + m0[2] * (pq[2] - av[2]), av[3] + m0[3] * (pq[3] - av[3])};
          *(LAS f32x4*)(dst + 4) = (f32x4){av[4] + m1[0] * (pq[4] - av[4]), av[5] + m1[1] * (pq[5] - av[5]), av[6] + m1[2] * (pq[6] - av[6]), av[7] + m1[3] * (pq[7] - av[7])}; }
      if (STAGE == 1) {
#pragma unroll
        for (int which = 0; which < 2; ++which) { const int co = 768 + 32 * which + 4 * p8; const u32x2 cv = which ? c2 : c1, pv = which ? p2 : p1;
          const f32x4 m0 = *(const f32x4*)(mu + co);
          float x[4] = {__uint_as_float(cv.x << 16), __uint_as_float(cv.x & 0xffff0000u), __uint_as_float(cv.y << 16), __uint_as_float(cv.y & 0xffff0000u)};
          const float y[4] = {pz * __uint_as_float(pv.x << 16), pz * __uint_as_float(pv.x & 0xffff0000u), pz * __uint_as_float(pv.y << 16), pz * __uint_as_float(pv.y & 0xffff0000u)};
#pragma unroll
          for (int j = 0; j < 4; ++j) { x[j] = x[j] + m0[j] * (y[j] - x[j]); if (which == 0) x[j] = tanhf_(x[j]); }
          *(LAS u32x2*)((which ? DAb : TWb) + tok * 40 + 4 * p8) = (u32x2){pk2(x[0], x[1]), pk2(x[2], x[3])}; } }
      if (STAGE == 3) { const int co = 832 + 8 * p8; float av[8], pq[8]; unpack8(c3, av); unpack8(p3, pq);
          const f32x4 m0 = *(const f32x4*)(mu + co), m1 = *(const f32x4*)(mu + co + 4); float x[8];
#pragma unroll
          for (int j = 0; j < 8; ++j) x[j] = sigmoidf_(av[j] + (j < 4 ? m0[j] : m1[j - 4]) * (pz * pq[j] - av[j]));
          *(LAS u32x4*)(SGb + tok * RB_LD + 8 * p8) = (u32x4){pk2(x[0], x[1]), pk2(x[2], x[3]), pk2(x[4], x[5]), pk2(x[6], x[7])}; } }
    { const int ch = F.tid & 63, part = F.tid >> 6;
      if (STAGE == 1) { const float* w2 = F.in[I_RW2] + ((size_t)layer * 32 + 4 * part) * 256 + h * 64 + ch;
          *(LAS u32x2*)(w2T + ch * 40 + 4 * part) = (u32x2){pk2(w2[0], w2[256]), pk2(w2[512], w2[768])}; }
      if (STAGE == 1) { const float* a2 = F.in[I_RA2] + ((size_t)layer * 32 + 4 * part) * 256 + h * 64 + ch;
          *(LAS u32x2*)(a2T + ch * 40 + 4 * part) = (u32x2){pk2(a2[0], a2[256]), pk2(a2[512], a2[768])}; }
      if (STAGE == 3) { const float* g2 = F.in[I_RG2] + ((size_t)layer * 64 + 8 * part) * 256 + h * 64 + ch;
          *(LAS u32x4*)(g2T + ch * RB_LD + 8 * part) = (u32x4){pk2(g2[0], g2[256]), pk2(g2[512], g2[768]), pk2(g2[1024], g2[1280]), pk2(g2[1536], g2[1792])}; } }
    __syncthreads();
    { const int lane = F.lane, mt = F.wave >> 1, nt0 = 2 * (F.wave & 1), r = lane & 15, g4 = lane >> 4; const f32x4 zero4 = (f32x4){0.f, 0.f, 0.f, 0.f};
#pragma unroll
      for (int q = 0; q < 2; ++q) { const int nt = nt0 + q, ch = 16 * nt + r;
          if (STAGE == 1) { const f32x4 wl = mma_nt<32>(TWb + 16 * mt * 40, 40, w2T + 16 * nt * 40, 40, zero4, lane); const float w0 = pw0[q];
#pragma unroll
              for (int i = 0; i < 4; ++i) { const float x = w0 + wl[i]; const float wlog = -__logf(1.0f + __expf(-x)) - 0.5f; Ww[(16 * mt + 4 * g4 + i) * 64 + ch] = __expf(-__expf(wlog)); } }
          if (STAGE == 1) { const f32x4 al = mma_nt<32>(DAb + 16 * mt * 40, 40, a2T + 16 * nt * 40, 40, zero4, lane); const float a0 = pa0[q];
#pragma unroll
              for (int i = 0; i < 4; ++i) Aa[(16 * mt + 4 * g4 + i) * 64 + ch] = sigmoidf_(a0 + al[i]); }
          if (STAGE == 3) { const f32x4 gv = mma_nt<64>(SGb + 16 * mt * RB_LD, RB_LD, g2T + 16 * nt * RB_LD, RB_LD, zero4, lane);
#pragma unroll
              for (int i = 0; i < 4; ++i) Gg[(16 * mt + 4 * g4 + i) * 64 + ch] = gv[i]; } } }
    __syncthreads();
    float* gBON = (float*)(F.ws + WS_BON) + ((size_t)(b * 4 + h) * 64 + c) * 64;
    if (STAGE == 1) { const int t = F.tid >> 3, p8 = F.tid & 7;
      LAS float* pa = Aa + t * 64 + 8 * p8; LAS float* pk = Kk + t * 64 + 8 * p8; LAS float* pr = Rr + t * 64 + 8 * p8; LAS float* pb = Bb + t * 64 + 8 * p8;
      float kp[8], kkv[8], av[8]; float ss = 0.f, bo = 0.f;
#pragma unroll
      for (int q = 0; q < 2; ++q) { const f32x4 a4 = *(const LAS f32x4*)(pa + 4 * q), k4 = *(const LAS f32x4*)(pk + 4 * q), r4 = *(const LAS f32x4*)(pr + 4 * q);
#pragma unroll
          for (int j = 0; j < 4; ++j) { const float a = a4[j], kraw = k4[j]; av[4 * q + j] = a; kp[4 * q + j] = kraw * (1.0f + (a - 1.0f) * pkaw[q][j]);
              kkv[4 * q + j] = kraw * pkkw[q][j]; ss += kkv[4 * q + j] * kkv[4 * q + j]; bo += r4[j] * kp[4 * q + j] * prk[q][j]; } }
      ss = sum8(ss); bo = sum8(bo);
      const float rn = rsqrtf(fmaxf(ss, 1e-24f));
#pragma unroll
      for (int q = 0; q < 2; ++q) { f32x4 ko, ao, bq;
#pragma unroll
          for (int j = 0; j < 4; ++j) { const float kkn = kkv[4 * q + j] * rn; ko[j] = kp[4 * q + j]; ao[j] = -kkn; bq[j] = kkn * av[4 * q + j]; }
          *(LAS f32x4*)(pk + 4 * q) = ko; *(LAS f32x4*)(pa + 4 * q) = ao; *(LAS f32x4*)(pb + 4 * q) = bq; }
      if (p8 == 0) gBON[t] = bo; }
    else if (F.tid < 64) BON[F.tid] = gBON[F.tid];
    __syncthreads();
}
constexpr int RB_AT = 98304, RB_ATT = RB_AT + 9216, RB_BT = RB_ATT + 9216, RB_BTT = RB_BT + 9216, RB_KT = RB_BTT + 9216, RB_RT = RB_KT + 9216, RB_VT = RB_RT + 9216, RB_GC = RB_VT + 9216;
constexpr int RX_X = 0, RX_XT = 9216, RX_TB = 18432, RX_M = 27648, RX_NRT = 36864, RX_G1T = 46080, RX_G2T = 55296, RX_QT = 64512;
__device__ __forceinline__ void st_tile(LAS bf16_t* dst, int mt, int nt, const f32x4 v, int lane) {
    const int r = lane & 15, g = lane >> 4;
#pragma unroll
    for (int i = 0; i < 4; ++i) dst[(16 * mt + 4 * g + i) * RB_LD + 16 * nt + r] = f2bf(v[i]);
}
__device__ __forceinline__ void st_tile_t(LAS bf16_t* dst, int mt, int nt, const f32x4 v, int lane) {
    const int r = lane & 15, g = lane >> 4; u32x2 w; w.x = pk2(v[0], v[1]); w.y = pk2(v[2], v[3]);
    *(LAS u32x2*)(dst + (16 * nt + r) * RB_LD + 16 * mt + 4 * g) = w;
}
__device__ __forceinline__ void st_rm(LAS bf16_t* dst, int mt, int nt, const f32x4 v, int lane) {
    const int r = lane & 15, g = lane >> 4; *(LAS u32x2*)(dst + (16 * mt + r) * RB_LD + 16 * nt + 4 * g) = (u32x2){pk2(v[0], v[1]), pk2(v[2], v[3])};
}
__device__ __forceinline__ void st_tr(LAS bf16_t* dst, int mt, int nt, const f32x4 v, int lane) {
    const int r = lane & 15, g = lane >> 4;
#pragma unroll
    for (int i = 0; i < 4; ++i) dst[(16 * nt + 4 * g + i) * RB_LD + 16 * mt + r] = f2bf(v[i]);
}
__device__ __forceinline__ void ld_fr(const LAS bf16_t* M, int row0, int lane, bf16x8 (&f)[2]) { const LAS bf16_t* p = M + (row0 + (lane & 15)) * RB_LD + 8 * (lane >> 4); f[0] = *(const LAS bf16x8*)p; f[1] = *(const LAS bf16x8*)(p + 32); }
__device__ __forceinline__ f32x4 mm_fr(const bf16x8 (&a)[2], const bf16x8 (&b)[2], f32x4 acc) { acc = __builtin_amdgcn_mfma_f32_16x16x32_bf16(a[0], b[0], acc, 0, 0, 0); return __builtin_amdgcn_mfma_f32_16x16x32_bf16(a[1], b[1], acc, 0, 0, 0); }
__device__ __forceinline__ void item_rwkv1(const Frame& F_, int layer, int item) { Frame F = relocal(F_);
    const int b = item >> 8, h = (item >> 6) & 3, c = item & 63;
    rwkv_prep<1>(F, layer, b, h, c);
    LAS float* Rr = (LAS float*)(F.lds + RW_R); LAS float* Kk = (LAS float*)(F.lds + RW_K); LAS float* Vv = (LAS float*)(F.lds + RW_V); LAS float* Ww = (LAS float*)(F.lds + RW_W);
    LAS float* Aa = (LAS float*)(F.lds + RW_A); LAS float* Bb = (LAS float*)(F.lds + RW_B);
    LAS bf16_t* At = (LAS bf16_t*)(F.lds + RB_AT); LAS bf16_t* AtT = (LAS bf16_t*)(F.lds + RB_ATT); LAS bf16_t* Bt = (LAS bf16_t*)(F.lds + RB_BT); LAS bf16_t* BtT = (LAS bf16_t*)(F.lds + RB_BTT);
    LAS bf16_t* Kt = (LAS bf16_t*)(F.lds + RB_KT); LAS bf16_t* Rt = (LAS bf16_t*)(F.lds + RB_RT); LAS bf16_t* VT = (LAS bf16_t*)(F.lds + RB_VT); LAS float* gC = (LAS float*)(F.lds + RB_GC);
    LAS bf16_t* X = (LAS bf16_t*)(F.lds + RX_X); LAS bf16_t* XT = (LAS bf16_t*)(F.lds + RX_XT); LAS bf16_t* Tb = (LAS bf16_t*)(F.lds + RX_TB); LAS bf16_t* Mm = (LAS bf16_t*)(F.lds + RX_M);
    LAS bf16_t* NrT = (LAS bf16_t*)(F.lds + RX_NRT); LAS bf16_t* G1T = (LAS bf16_t*)(F.lds + RX_G1T); LAS bf16_t* G2T = (LAS bf16_t*)(F.lds + RX_G2T); LAS bf16_t* QT = (LAS bf16_t*)(F.lds + RX_QT);
    { const int k = F.tid & 63, part = F.tid >> 6; float g = 1.0f;
      for (int pp = 0; pp < part; ++pp) { float w8[8];
#pragma unroll
          for (int i = 0; i < 8; ++i) w8[i] = Ww[(8 * pp + i) * 64 + k];
          g *= ((w8[0] * w8[1]) * (w8[2] * w8[3])) * ((w8[4] * w8[5]) * (w8[6] * w8[7])); }
      unsigned aT[4], bT[4], vT[4]; unsigned pa = 0u, pb = 0u, pv = 0u;
#pragma unroll
      for (int i = 0; i < 8; ++i) { const int t = 8 * part + i; const float gp = g; g *= Ww[t * 64 + k]; const float ig = __builtin_amdgcn_rcpf(g);
          const bf16_t av = f2bf(Aa[t * 64 + k] * gp), bv = f2bf(Bb[t * 64 + k] * ig), vv = f2bf(Vv[t * 64 + k]);
          At[t * RB_LD + k] = av; Bt[t * RB_LD + k] = bv;
          Kt[t * RB_LD + k] = f2bf(Kk[t * 64 + k] * ig); Rt[t * RB_LD + k] = f2bf(Rr[t * 64 + k] * g);
          if (i & 1) { aT[i >> 1] = pa | ((unsigned)av << 16); bT[i >> 1] = pb | ((unsigned)bv << 16); vT[i >> 1] = pv | ((unsigned)vv << 16); } else { pa = av; pb = bv; pv = vv; } }
      *(LAS u32x4*)(AtT + k * RB_LD + 8 * part) = (u32x4){aT[0], aT[1], aT[2], aT[3]}; *(LAS u32x4*)(BtT + k * RB_LD + 8 * part) = (u32x4){bT[0], bT[1], bT[2], bT[3]};
      *(LAS u32x4*)(VT + k * RB_LD + 8 * part) = (u32x4){vT[0], vT[1], vT[2], vT[3]};
      if (part == 7) gC[k] = g; }
    __syncthreads();
    const int lane = F.lane, mt = F.wave >> 1, nt0 = 2 * (F.wave & 1), r = lane & 15, g4 = lane >> 4;
    const f32x4 zero4 = (f32x4){0.f, 0.f, 0.f, 0.f};
    f32x4 Tacc[2];
    bf16x8 fa0[2], fa1[2], fa2[2], fb0[2][2], fb1[2][2], fb2[2][2];
    ld_fr(Bt, 16 * mt, lane, fa0); ld_fr(Kt, 16 * mt, lane, fa1); ld_fr(Rt, 16 * mt, lane, fa2);
#pragma unroll
    for (int q = 0; q < 2; ++q) { ld_fr(At, 16 * (nt0 + q), lane, fb0[q]); ld_fr(Bt, 16 * (nt0 + q), lane, fb1[q]); }
#pragma unroll
    for (int q = 0; q < 2; ++q) { const int nt = nt0 + q;
        f32x4 n = mm_fr(fb0[q], fa0, zero4);
        f32x4 m = mm_fr(fb0[q], fa1, zero4);
        f32x4 nr = mm_fr(fb1[q], fa2, zero4);
#pragma unroll
        for (int i = 0; i < 4; ++i) { const int row = 16 * mt + r, col = 16 * nt + 4 * g4 + i;
            n[i] = (row < col) ? n[i] : 0.f; m[i] = (row < col) ? m[i] : 0.f; nr[i] = (col <= row) ? nr[i] : 0.f;
            Tacc[q][i] = n[i] + (row == col ? 1.0f : 0.f); }
        st_rm(X, mt, nt, n, lane); st_tr(XT, mt, nt, n, lane); st_rm(Tb, mt, nt, Tacc[q], lane); st_rm(Mm, mt, nt, m, lane); st_rm(NrT, mt, nt, nr, lane); }
    __syncthreads();
#pragma unroll 1
    for (int it = 0; it < 6; ++it) {
        LAS bf16_t* Xr = (it & 1) ? G1T : X; LAS bf16_t* XTr = (it & 1) ? G2T : XT; LAS bf16_t* Tr = (it & 1) ? QT : Tb;
        LAS bf16_t* Xw = (it & 1) ? X : G1T; LAS bf16_t* XTw = (it & 1) ? XT : G2T; LAS bf16_t* Tw = (it & 1) ? Tb : QT;
        ld_fr(Tr, 16 * mt, lane, fa0); ld_fr(Xr, 16 * mt, lane, fa1);
#pragma unroll
        for (int q = 0; q < 2; ++q) ld_fr(XTr, 16 * (nt0 + q), lane, fb0[q]);
#pragma unroll
        for (int q = 0; q < 2; ++q) { const int nt = nt0 + q;
            if (it > 0) Tacc[q] = mm_fr(fb0[q], fa0, Tacc[q]);
            if (it < 5) { const f32x4 x2 = mm_fr(fb0[q], fa1, zero4); st_rm(Xw, mt, nt, x2, lane); st_tr(XTw, mt, nt, x2, lane); }
            st_rm(Tw, mt, nt, Tacc[q], lane); }
        __syncthreads();
    }
    ld_fr(NrT, 16 * mt, lane, fa0); ld_fr(BtT, 16 * mt, lane, fa1);
#pragma unroll
    for (int q = 0; q < 2; ++q) ld_fr(Tb, 16 * (nt0 + q), lane, fb0[q]);
#pragma unroll
    for (int q = 0; q < 2; ++q) { const int nt = nt0 + q;
        st_rm(G1T, mt, nt, mm_fr(fb0[q], fa0, zero4), lane);
        st_rm(G2T, mt, nt, mm_fr(fb0[q], fa1, zero4), lane); }
    __syncthreads();
    const size_t ci = (size_t)(b * 4 + h) * 64 + c;
    bf16_t* gPT = (bf16_t*)(F.ws + WS_MOE + RW_PT) + ci * 4096; bf16_t* gW1 = (bf16_t*)(F.ws + WS_MOE + RW_W1) + ci * 4096; bf16_t* gZ = (bf16_t*)(F.ws + WS_MOE + RW_Z) + ci * 4096;
    ld_fr(G1T, 16 * mt, lane, fa0); ld_fr(Rt, 16 * mt, lane, fa1); ld_fr(G2T, 16 * mt, lane, fa2);
#pragma unroll
    for (int q = 0; q < 2; ++q) { ld_fr(AtT, 16 * (nt0 + q), lane, fb0[q]); ld_fr(Mm, 16 * (nt0 + q), lane, fb1[q]); ld_fr(Kt, 16 * (nt0 + q), lane, fb2[q]); }
#pragma unroll
    for (int q = 0; q < 2; ++q) { const int nt = nt0 + q; const int row = 16 * mt + r, c0 = 16 * nt + 4 * g4;
        const f32x4 w1 = mm_fr(fb0[q], fa0, zero4);
        const f32x4 z = mm_fr(fb1[q], fa0, zero4);
        const f32x4 mr = mm_fr(fb2[q], fa1, zero4);
        const f32x4 p = mm_fr(fb0[q], fa2, zero4);
        f32x4 qq = mm_fr(fb1[q], fa2, zero4);
        const float gc = gC[row]; const u32x2 rt = *(const LAS u32x2*)(Rt + row * RB_LD + c0);
        const float rv[4] = {__uint_as_float(rt.x << 16), __uint_as_float(rt.x & 0xffff0000u), __uint_as_float(rt.y << 16), __uint_as_float(rt.y & 0xffff0000u)};
        float wv[4], zv[4], pv[4];
#pragma unroll
        for (int i = 0; i < 4; ++i) { const int col = c0 + i;
            wv[i] = w1[i] + rv[i]; zv[i] = z[i] + (col <= row ? mr[i] : 0.f); pv[i] = (p[i] + (row == col ? 1.0f : 0.f)) * gc;
            qq[i] = (qq[i] + bf2f(Kt[col * RB_LD + row])) * gc; }
        *(u32x2*)(gW1 + row * 64 + c0) = (u32x2){pk2(wv[0], wv[1]), pk2(wv[2], wv[3])};
        *(u32x2*)(gZ + row * 64 + c0) = (u32x2){pk2(zv[0], zv[1]), pk2(zv[2], zv[3])};
        *(u32x2*)(gPT + row * 64 + 32 * (nt >> 1) + 8 * g4 + 4 * (nt & 1)) = (u32x2){pk2(pv[0], pv[1]), pk2(pv[2], pv[3])};
        st_rm(QT, mt, nt, qq, lane); }
    __syncthreads();
    bf16_t* gU = (bf16_t*)(F.ws + WS_MOE + RW_U) + ci * 4096;
    ld_fr(VT, 16 * mt, lane, fa0);
#pragma unroll
    for (int q = 0; q < 2; ++q) ld_fr(QT, 16 * (nt0 + q), lane, fb0[q]);
#pragma unroll
    for (int q = 0; q < 2; ++q) { const int nt = nt0 + q;
        const f32x4 u = mm_fr(fb0[q], fa0, zero4);
        *(u32x2*)(gU + (16 * mt + r) * 64 + 16 * nt + 4 * g4) = (u32x2){pk2(u[0], u[1]), pk2(u[2], u[3])}; }
}
__device__ __forceinline__ void item_rwkv_carry(const Frame& F_, int item) { Frame F = relocal(F_);
    const int bh = item * 2 + (F.wave >> 2), nt = F.wave & 3, r = F.lane & 15, g = F.lane >> 4;
    const bf16_t* PT = (const bf16_t*)(F.ws + WS_MOE + RW_PT); const bf16_t* Uc = (const bf16_t*)(F.ws + WS_MOE + RW_U); bf16_t* Ss = (bf16_t*)(F.ws + WS_MOE + RW_S);
    f32x4 acc[4];
#pragma unroll
    for (int m = 0; m < 4; ++m) acc[m] = (f32x4){0.f, 0.f, 0.f, 0.f};
    for (int c = 0; c < 64; ++c) { const size_t ci = (size_t)bh * 64 + c;
        bf16x8 af[4][2]; f32x4 cin[4];
#pragma unroll
        for (int m = 0; m < 4; ++m) { const u32x2 uv = *(const u32x2*)(Uc + ci * 4096 + (16 * nt + r) * 64 + 16 * m + 4 * g);
            cin[m] = (f32x4){__uint_as_float(uv.x << 16), __uint_as_float(uv.x & 0xffff0000u), __uint_as_float(uv.y << 16), __uint_as_float(uv.y & 0xffff0000u)};
#pragma unroll
            for (int s = 0; s < 2; ++s) af[m][s] = *(const bf16x8*)(PT + ci * 4096 + (16 * m + r) * 64 + 32 * s + 8 * g); }
        unsigned pw[4][2];
#pragma unroll
        for (int m = 0; m < 4; ++m) { pw[m][0] = pk2(acc[m][0], acc[m][1]); pw[m][1] = pk2(acc[m][2], acc[m][3]);
            *(u32x2*)(Ss + ci * 4096 + (16 * nt + r) * 64 + 16 * m + 4 * g) = (u32x2){pw[m][0], pw[m][1]}; }
        bf16x8 bfr[2];
#pragma unroll
        for (int s = 0; s < 2; ++s) bfr[s] = __builtin_bit_cast(bf16x8, (u32x4){pw[2 * s][0], pw[2 * s][1], pw[2 * s + 1][0], pw[2 * s + 1][1]});
#pragma unroll
        for (int m = 0; m < 4; ++m) { acc[m] = __builtin_amdgcn_mfma_f32_16x16x32_bf16(af[m][0], bfr[0], cin[m], 0, 0, 0);
            acc[m] = __builtin_amdgcn_mfma_f32_16x16x32_bf16(af[m][1], bfr[1], acc[m], 0, 0, 0); }
    }
}
__device__ __forceinline__ void item_rwkv3(const Frame& F_, int layer, int item) { Frame F = relocal(F_);
    const int b = item >> 8, h = (item >> 6) & 3, c = item & 63; const size_t T0 = (size_t)b * SEQ + c * 64;
    const size_t ci3 = (size_t)(b * 4 + h) * 64 + c;
    const u32x4 tS = *(const u32x4*)((const bf16_t*)(F.ws + WS_MOE + RW_S) + ci3 * 4096 + F.tid * 8);
    const u32x4 tW = *(const u32x4*)((const bf16_t*)(F.ws + WS_MOE + RW_W1) + ci3 * 4096 + F.tid * 8);
    const u32x4 tZ = *(const u32x4*)((const bf16_t*)(F.ws + WS_MOE + RW_Z) + ci3 * 4096 + F.tid * 8);
    f32x4 lw4[2], lb4[2];
#pragma unroll
    for (int q = 0; q < 2; ++q) { lw4[q] = *(const f32x4*)(F.in[I_RLNW] + layer * 256 + h * 64 + 8 * (F.tid & 7) + 4 * q); lb4[q] = *(const f32x4*)(F.in[I_RLNB] + layer * 256 + h * 64 + 8 * (F.tid & 7) + 4 * q); }
    rwkv_prep<3>(F, layer, b, h, c);
    LAS float* Vv = (LAS float*)(F.lds + RW_V); LAS float* Oo = (LAS float*)(F.lds + R3_O);
    LAS float* Gg = (LAS float*)(F.lds + R3_G); LAS float* BON = (LAS float*)(F.lds + R3_BON);
    LAS bf16_t* S0b = (LAS bf16_t*)(F.lds + R3_TILES); LAS bf16_t* W1b = S0b + 4608; LAS bf16_t* Zb = W1b + 4608; LAS bf16_t* VTb = Zb + 4608;
    { const int row = F.tid >> 3, col = (F.tid & 7) * 8;
      *(LAS u32x4*)(S0b + row * RB_LD + col) = tS;
      *(LAS u32x4*)(W1b + row * RB_LD + col) = tW;
      *(LAS u32x4*)(Zb + row * RB_LD + col) = tZ;
      const int vv = F.tid & 63, part = F.tid >> 6;
      unsigned vT[4];
#pragma unroll
      for (int i = 0; i < 8; i += 2) vT[i >> 1] = pk2(Vv[(8 * part + i) * 64 + vv], Vv[(8 * part + i + 1) * 64 + vv]);
      *(LAS u32x4*)(VTb + vv * RB_LD + 8 * part) = (u32x4){vT[0], vT[1], vT[2], vT[3]}; }
    __syncthreads();
    { const int lane = F.lane, mt = F.wave >> 1, nt0 = 2 * (F.wave & 1), r = lane & 15, g4 = lane >> 4;
      bf16x8 fa0[2], fa1[2], fb0[2][2], fb1[2][2];
      ld_fr(W1b, 16 * mt, lane, fa0); ld_fr(Zb, 16 * mt, lane, fa1);
#pragma unroll
      for (int q = 0; q < 2; ++q) { ld_fr(S0b, 16 * (nt0 + q), lane, fb0[q]); ld_fr(VTb, 16 * (nt0 + q), lane, fb1[q]); }
#pragma unroll
      for (int q = 0; q < 2; ++q) { const int nt = nt0 + q;
          f32x4 o = mm_fr(fa0, fb0[q], (f32x4){0.f, 0.f, 0.f, 0.f});
          o = mm_fr(fa1, fb1[q], o);
#pragma unroll
          for (int i = 0; i < 4; ++i) Oo[(16 * mt + 4 * g4 + i) * 64 + 16 * nt + r] = o[i]; } }
    __syncthreads();
    { const int t = F.tid >> 3, p8 = F.tid & 7;
      float o[8]; float sm = 0.f;
#pragma unroll
      for (int q = 0; q < 2; ++q) { const f32x4 o4 = *(const LAS f32x4*)(Oo + t * 64 + 8 * p8 + 4 * q);
#pragma unroll
          for (int j = 0; j < 4; ++j) { o[4 * q + j] = o4[j]; sm += o4[j]; } }
      const float mean = sum8(sm) * (1.0f / 64.0f); float vs = 0.f;
#pragma unroll
      for (int j = 0; j < 8; ++j) { o[j] -= mean; vs += o[j] * o[j]; }
      const float rstd = rsqrtf(sum8(vs) * (1.0f / 64.0f) + 64e-5f); const float bon = BON[t];
      float y[8];
#pragma unroll
      for (int q = 0; q < 2; ++q) { const f32x4 v4 = *(const LAS f32x4*)(Vv + t * 64 + 8 * p8 + 4 * q), g4v = *(const LAS f32x4*)(Gg + t * 64 + 8 * p8 + 4 * q);
#pragma unroll
          for (int j = 0; j < 4; ++j) y[4 * q + j] = (o[4 * q + j] * rstd * lw4[q][j] + lb4[q][j] + bon * v4[j]) * g4v[j]; }
      *(u32x4*)((bf16_t*)(F.ws + WS_H) + (T0 + t) * DM + 256 + h * 64 + 8 * p8) = (u32x4){pk2(y[0], y[1]), pk2(y[2], y[3]), pk2(y[4], y[5]), pk2(y[6], y[7])}; }
}

constexpr int DS_SEL = 131072, DS_HIST = 135168, DS_BKT = 151552, DS_BIAS = 152064;
__device__ __forceinline__ void dsa_tables(const Frame& F_) { Frame F = relocal(F_);
    LAS int* bkt = (LAS int*)(F.lds + DS_BKT); LAS float* biasT = (LAS float*)(F.lds + DS_BIAS);
    if (F.tid < 128) { const int n = F.tid; int bk = n; if (n >= 16) { const float lr = logf((float)n / 16.0f) / 2.0794415416798357f; bk = 16 + (int)(lr * 16.0f); bk = bk < 31 ? bk : 31; } bkt[n] = bk; biasT[n] = F.in[I_RELB][n]; }
    __syncthreads();
}
__device__ __forceinline__ unsigned fkey(float f) { const unsigned u = __float_as_uint(f); return (u & 0x80000000u) ? ~u : (u | 0x80000000u); }
__device__ __forceinline__ void item_dsa(const Frame& F_, int layer, int item) { Frame F = relocal(F_);
    const bf16_t* U = (const bf16_t*)(F.ws + WS_U); const bf16_t* KI = (const bf16_t*)(F.ws + WS_KIDX);
    const bf16_t* Kb = (const bf16_t*)(F.ws + WS_K); const bf16_t* Vb = (const bf16_t*)(F.ws + WS_V);
    const int b = item & 3, qg = 511 - (item >> 2); const size_t TB = (size_t)b * SEQ, T0 = TB + qg * 8;
    LAS float* sc = (LAS float*)F.lds; LAS unsigned short* selall = (LAS unsigned short*)(F.lds + DS_SEL); LAS unsigned* histall = (LAS unsigned*)(F.lds + DS_HIST);
    LAS int* bkt = (LAS int*)(F.lds + DS_BKT); LAS float* biasT = (LAS float*)(F.lds + DS_BIAS);
    const int lane = F.lane, hh = lane >> 5;
    {
        bf16x8 af[2][2]; float wq[2][2][8];
        { const int r = lane & 31, q4 = 2 * ((r >> 2) & 1) + (r >> 4), head = 4 * ((r >> 3) & 1) + (r & 3);
#pragma unroll
          for (int mt = 0; mt < 2; ++mt)
#pragma unroll
              for (int ks = 0; ks < 2; ++ks) af[mt][ks] = *(const bf16x8*)(U + (T0 + 4 * mt + q4) * NINP + UC + 384 + head * 32 + 16 * ks + 8 * hh); }
#pragma unroll
        for (int mt = 0; mt < 2; ++mt)
#pragma unroll
            for (int q2 = 0; q2 < 2; ++q2) { float f[8]; unpack8(*(const u32x4*)(U + (T0 + 4 * mt + 2 * hh + q2) * NINP + UC + 672), f);
#pragma unroll
                for (int hd = 0; hd < 8; ++hd) wq[mt][q2][hd] = f[hd]; }
        const int ntile = (qg * 8 + 8 + 31) >> 5;
        bf16x8 nb0 = af[0][0], nb1 = af[0][0];
        if (F.wave < ntile) { const int key = F.wave * 32 + (lane & 31); nb0 = *(const bf16x8*)(KI + (TB + key) * 32 + 8 * hh); nb1 = *(const bf16x8*)(KI + (TB + key) * 32 + 16 + 8 * hh); }
        for (int kt = F.wave; kt < ntile; kt += 8) {
            const int key = kt * 32 + (lane & 31);
            const bf16x8 b0 = nb0, b1 = nb1;
            if (kt + 8 < ntile) { const int k2 = key + 256; nb0 = *(const bf16x8*)(KI + (TB + k2) * 32 + 8 * hh); nb1 = *(const bf16x8*)(KI + (TB + k2) * 32 + 16 + 8 * hh); }
#pragma unroll
            for (int mt = 0; mt < 2; ++mt) { f32x16 acc;
#pragma unroll
                for (int i = 0; i < 16; ++i) acc[i] = 0.f;
                acc = __builtin_amdgcn_mfma_f32_32x32x16_bf16(af[mt][0], b0, acc, 0, 0, 0);
                acc = __builtin_amdgcn_mfma_f32_32x32x16_bf16(af[mt][1], b1, acc, 0, 0, 0);
#pragma unroll
                for (int q2 = 0; q2 < 2; ++q2) { float s = 0.f;
#pragma unroll
                    for (int hd = 0; hd < 8; ++hd) s += fmaxf(acc[8 * q2 + hd], 0.f) * wq[mt][q2][hd];
                    const int qi = 4 * mt + 2 * hh + q2;
                    sc[qi * 4096 + key] = (key <= qg * 8 + qi) ? s : -INFINITY; } }
        }
    }
    __syncthreads();
    const int qi = F.wave, tq = qg * 8 + qi, n = tq + 1;
    LAS float* scq = sc + qi * 4096; LAS unsigned short* sel = selall + qi * 256; LAS unsigned* hist = histall + qi * 512;
    int nsel;
    if (n <= 256) { nsel = n; for (int j = lane; j < 256; j += 64) sel[j] = (unsigned short)(j < n ? j : 0); }
    else {
        nsel = 256;
        const int R = (n + 63) >> 6; const unsigned long long ltm = (1ull << lane) - 1ull;
        float lo = INFINITY, hi = -INFINITY;
        const int R4 = (n + 255) >> 8;
#pragma unroll 4
        for (int i = 0; i < R4; ++i) { const int j0 = 256 * i + 4 * lane; const f32x4 v4 = *(const LAS f32x4*)(scq + j0);
#pragma unroll
            for (int q = 0; q < 4; ++q) { const bool valid = j0 + q < n; lo = fminf(lo, valid ? v4[q] : INFINITY); hi = fmaxf(hi, valid ? v4[q] : -INFINITY); } }
        lo = wave_min(lo); hi = wave_max(hi);
        bool slow = false;
        if (!(hi > lo)) { for (int j = lane; j < 256; j += 64) sel[j] = (unsigned short)j; }
        else {
            const float scale = 1023.0f / (hi - lo);
            *(LAS u32x4*)(hist + 8 * lane) = (u32x4){0u, 0u, 0u, 0u}; *(LAS u32x4*)(hist + 8 * lane + 4) = (u32x4){0u, 0u, 0u, 0u};
#pragma unroll 2
            for (int i = 0; i < R4; ++i) { const int j0 = 256 * i + 4 * lane; const f32x4 v4 = *(const LAS f32x4*)(scq + j0);
#pragma unroll
                for (int q = 0; q < 4; ++q) { if (j0 + q < n) { int bk = (int)((v4[q] - lo) * scale); bk = bk < 1023 ? bk : 1023;
                    atomicAdd((unsigned*)(hist + (bk >> 1)), (bk & 1) ? 65536u : 1u); } } }
            const u32x4 h0 = *(const LAS u32x4*)(hist + 8 * lane), h1 = *(const LAS u32x4*)(hist + 8 * lane + 4);
            unsigned cb[16];
            cb[0] = h0.x & 0xffffu; cb[1] = h0.x >> 16; cb[2] = h0.y & 0xffffu; cb[3] = h0.y >> 16; cb[4] = h0.z & 0xffffu; cb[5] = h0.z >> 16; cb[6] = h0.w & 0xffffu; cb[7] = h0.w >> 16;
            cb[8] = h1.x & 0xffffu; cb[9] = h1.x >> 16; cb[10] = h1.y & 0xffffu; cb[11] = h1.y >> 16; cb[12] = h1.z & 0xffffu; cb[13] = h1.z >> 16; cb[14] = h1.w & 0xffffu; cb[15] = h1.w >> 16;
            unsigned tot = 0u;
#pragma unroll
            for (int q = 0; q < 16; ++q) tot += cb[q];
            const unsigned pre = wave_prefix_u(tot); const unsigned incl = (unsigned)__builtin_amdgcn_readlane((int)pre, 63) - pre + tot;
            int fb = -1; unsigned fabove = 0u, fcnt = 0u; unsigned cum = incl - tot;
#pragma unroll
            for (int q = 15; q >= 0; --q) { if (fb < 0 && cum < 256u && 256u <= cum + cb[q]) { fb = 16 * lane + q; fabove = cum; fcnt = cb[q]; } cum += cb[q]; }
            const unsigned long long mf = __ballot(fb >= 0); const int src = (int)__ffsll((long long)mf) - 1;
            const int B = __builtin_amdgcn_readlane(fb, src); const int above = __builtin_amdgcn_readlane((int)fabove, src), cntB = __builtin_amdgcn_readlane((int)fcnt, src); const int need = 256 - above;
            if (cntB > 256) slow = true;
            else {
                LAS unsigned* cand = hist;
                int base_gt = 0, base_c = 0;
#pragma unroll 2
                for (int i = 0; i < R4; ++i) { const int j0 = 256 * i + 4 * lane; const f32x4 v4 = *(const LAS f32x4*)(scq + j0);
#pragma unroll
                    for (int q = 0; q < 4; ++q) { const int j = j0 + q; const bool valid = j < n; const float v = valid ? v4[q] : lo;
                        int bk = (int)((v - lo) * scale); bk = bk < 1023 ? bk : 1023;
                        const bool gt = valid && bk > B, eq = valid && bk == B;
                        const unsigned long long mg = __ballot(gt), me = __ballot(eq);
                        if (gt) sel[base_gt + __popcll(mg & ltm)] = (unsigned short)j;
                        if (eq) { const int p = base_c + __popcll(me & ltm); cand[2 * p] = fkey(v); cand[2 * p + 1] = (unsigned)j; }
                        base_gt += __popcll(mg); base_c += __popcll(me); } }
                if (need == cntB) { for (int c = lane; c < cntB; c += 64) sel[above + c] = (unsigned short)cand[2 * c + 1]; }
                else {
                    unsigned ck[4], cx[4]; int rk[4];
#pragma unroll
                    for (int q = 0; q < 4; ++q) { const int c = lane + 64 * q; ck[q] = c < cntB ? cand[2 * c] : 0u; cx[q] = c < cntB ? cand[2 * c + 1] : 0u; rk[q] = 0; }
                    for (int c2 = 0; c2 < cntB; ++c2) { const unsigned k2 = cand[2 * c2], x2 = cand[2 * c2 + 1];
#pragma unroll
                        for (int q = 0; q < 4; ++q) rk[q] += (k2 > ck[q] || (k2 == ck[q] && x2 < cx[q])) ? 1 : 0; }
#pragma unroll
                    for (int q = 0; q < 4; ++q) { const int c = lane + 64 * q; if (c < cntB && rk[q] < need) sel[above + rk[q]] = (unsigned short)cand[2 * c + 1]; }
                }
            }
        }
        if (slow) {
        unsigned prefix = 0u; int need = 256; unsigned neq = 0u;
        for (int p = 0; p < 4; ++p) { const int shift = 24 - 8 * p;
            *(LAS u32x4*)(hist + 4 * lane) = (u32x4){0u, 0u, 0u, 0u};
            for (int i = 0; i < R; ++i) { const int j = lane + 64 * i; if (j < n) { const unsigned u = fkey(scq[j]);
                if (p == 0 || (u >> (shift + 8)) == prefix) atomicAdd((unsigned*)(hist + ((u >> shift) & 255u)), 1u); } }
            const u32x4 hv = *(const LAS u32x4*)(hist + 4 * lane);
            const unsigned tot = hv.x + hv.y + hv.z + hv.w;
            unsigned incl = tot;
#pragma unroll
            for (int o = 1; o < 64; o <<= 1) { const unsigned t = shdown_u(incl, o); if (lane + o < 64) incl += t; }
            const unsigned above = incl - tot;
            int fb = -1; unsigned fabove = 0u, feq = 0u; unsigned cum = above;
            { const unsigned hq[4] = {hv.x, hv.y, hv.z, hv.w};
#pragma unroll
              for (int q = 3; q >= 0; --q) { if (fb < 0 && cum < (unsigned)need && (unsigned)need <= cum + hq[q]) { fb = 4 * lane + q; fabove = cum; feq = hq[q]; } cum += hq[q]; } }
            const unsigned long long m = __ballot(fb >= 0);
            const int src = (int)__ffsll((long long)m) - 1;
            const int bin = shidx_i(fb, src); const unsigned ab = (unsigned)shidx_i((int)fabove, src); neq = (unsigned)shidx_i((int)feq, src);
            need -= (int)ab; prefix = (prefix << 8) | (unsigned)bin;
        }
        const int ngt = 256 - need;
        int base_gt = 0, base_eq = 0;
        for (int i = 0; i < R; ++i) { const int j = lane + 64 * i; const unsigned u = (j < n) ? fkey(scq[j]) : 0u;
            const bool gt = (j < n) && (u > prefix), eq = (j < n) && (u == prefix);
            const unsigned long long mg = __ballot(gt), me = __ballot(eq); const unsigned long long lt = (1ull << lane) - 1ull;
            if (gt) sel[base_gt + __popcll(mg & lt)] = (unsigned short)j;
            if (eq) { const int rk = base_eq + __popcll(me & lt); if (rk < need) sel[ngt + rk] = (unsigned short)j; }
            base_gt += __popcll(mg); base_eq += __popcll(me); }
        (void)neq;
            }
    }
    const int nt16 = (nsel + 15) >> 4, r16 = lane & 15, g4 = lane >> 4;
    LAS float* biasj = scq + 2048;
#pragma unroll
    for (int q = 0; q < 4; ++q) { const int j = lane + 64 * q; f32x4 bv = (f32x4){-INFINITY, -INFINITY, -INFINITY, -INFINITY};
        if (j < nsel) { const int dist = tq - (int)sel[j]; const int bk = dist < 128 ? bkt[dist < 0 ? 0 : dist] : 31; bv = *(const LAS f32x4*)(biasT + 4 * bk); }
        *(LAS f32x4*)(biasj + 4 * j) = bv; }
    bf16x8 qf[2];
#pragma unroll
    for (int s = 0; s < 2; ++s) { u32x4 z = (u32x4){0u, 0u, 0u, 0u}; if (r16 < 4) z = *(const u32x4*)(U + (T0 + qi) * NINP + UC + r16 * 64 + 32 * s + 8 * g4); qf[s] = __builtin_bit_cast(bf16x8, z); }
    float lg[16][4]; float mx = -INFINITY;
#define DSA_QK(M0, NM) do { int keyr[NM]; bf16x8 a0[NM], a1[NM]; \
        _Pragma("unroll") for (int m8 = 0; m8 < NM; ++m8) keyr[m8] = sel[16 * ((M0) + m8) + r16]; \
        _Pragma("unroll") for (int m8 = 0; m8 < NM; ++m8) { a0[m8] = *(const bf16x8*)(Kb + (TB + keyr[m8]) * 64 + 8 * g4); a1[m8] = *(const bf16x8*)(Kb + (TB + keyr[m8]) * 64 + 32 + 8 * g4); } \
        _Pragma("unroll") for (int m8 = 0; m8 < NM; ++m8) { const int m = (M0) + m8; \
            f32x4 acc = (f32x4){0.f, 0.f, 0.f, 0.f}; \
            acc = __builtin_amdgcn_mfma_f32_16x16x32_bf16(a0[m8], qf[0], acc, 0, 0, 0); \
            acc = __builtin_amdgcn_mfma_f32_16x16x32_bf16(a1[m8], qf[1], acc, 0, 0, 0); \
            _Pragma("unroll") for (int i = 0; i < 4; ++i) { const float v = acc[i] * 0.125f + biasj[(16 * m + 4 * g4 + i) * 4 + (r16 & 3)]; lg[m][i] = v; mx = fmaxf(mx, v); } } } while (0)
    if (nt16 > 8) { DSA_QK(0, 16); }
    else { DSA_QK(0, 8);
#pragma unroll
        for (int m8 = 8; m8 < 16; ++m8)
#pragma unroll
            for (int i = 0; i < 4; ++i) lg[m8][i] = -INFINITY; }
#undef DSA_QK
    mx = xrows(mx, OpMax());
    float sm = 0.f;
#pragma unroll
    for (int m = 0; m < 16; ++m)
#pragma unroll
        for (int i = 0; i < 4; ++i) { const float p = __expf(lg[m][i] - mx); lg[m][i] = p; sm += p; }
    sm = xrows(sm, OpAdd());
    f32x4 ov[4];
#pragma unroll
    for (int nt = 0; nt < 4; ++nt) ov[nt] = (f32x4){0.f, 0.f, 0.f, 0.f};
    const unsigned vs_base = (unsigned)(unsigned long)scq;
#pragma unroll
    for (int half = 0; half < 2; ++half) {
        if (half * 8 < nt16) {
            asm volatile("s_waitcnt lgkmcnt(0)" ::: "memory");
            int vkey[16];
#pragma unroll
            for (int q = 0; q < 16; ++q) { const int rho = 8 * q + (lane >> 3);
                vkey[q] = sel[half * 128 + (rho & ~31) + 16 * ((rho >> 2) & 1) + 4 * ((rho >> 3) & 3) + (rho & 3)]; }
            asm volatile("s_waitcnt lgkmcnt(0)" : "+v"(vkey[0]), "+v"(vkey[1]), "+v"(vkey[2]), "+v"(vkey[3]), "+v"(vkey[4]), "+v"(vkey[5]), "+v"(vkey[6]), "+v"(vkey[7]),
                         "+v"(vkey[8]), "+v"(vkey[9]), "+v"(vkey[10]), "+v"(vkey[11]), "+v"(vkey[12]), "+v"(vkey[13]), "+v"(vkey[14]), "+v"(vkey[15]) :: "memory");
#pragma unroll
            for (int q = 0; q < 16; ++q)
                __builtin_amdgcn_global_load_lds((const unsigned*)(Vb + (TB + vkey[q]) * 64 + 8 * (lane & 7)), (LAS unsigned*)((LAS unsigned char*)scq + q * 1024), 16, 0, 0);
            asm volatile("s_waitcnt vmcnt(0)" ::: "memory");
#pragma unroll
            for (int s4 = 0; s4 < 4; ++s4) { const int s = half * 4 + s4;
                u32x4 pw; pw.x = pk2(lg[2 * s][0], lg[2 * s][1]); pw.y = pk2(lg[2 * s][2], lg[2 * s][3]); pw.z = pk2(lg[2 * s + 1][0], lg[2 * s + 1][1]); pw.w = pk2(lg[2 * s + 1][2], lg[2 * s + 1][3]);
                const bf16x8 pa = __builtin_bit_cast(bf16x8, pw);
                const unsigned ad = vs_base + (unsigned)((32 * s4 + 8 * g4 + (r16 >> 2)) * 128 + (r16 & 3) * 8);
                u32x2 t0[4], t1[4];
                asm volatile("ds_read_b64_tr_b16 %0, %8\n\tds_read_b64_tr_b16 %1, %8 offset:512\n\tds_read_b64_tr_b16 %2, %8 offset:32\n\tds_read_b64_tr_b16 %3, %8 offset:544\n\t"
                             "ds_read_b64_tr_b16 %4, %8 offset:64\n\tds_read_b64_tr_b16 %5, %8 offset:576\n\tds_read_b64_tr_b16 %6, %8 offset:96\n\tds_read_b64_tr_b16 %7, %8 offset:608\n\ts_waitcnt lgkmcnt(0)"
                             : "=&v"(t0[0]), "=&v"(t1[0]), "=&v"(t0[1]), "=&v"(t1[1]), "=&v"(t0[2]), "=&v"(t1[2]), "=&v"(t0[3]), "=&v"(t1[3]) : "v"(ad) : "memory");
#pragma unroll
                for (int nt = 0; nt < 4; ++nt) { const bf16x8 vb = __builtin_bit_cast(bf16x8, (u32x4){t0[nt].x, t0[nt].y, t1[nt].x, t1[nt].y});
                    ov[nt] = __builtin_amdgcn_mfma_f32_16x16x32_bf16(pa, vb, ov[nt], 0, 0, 0); } }
        }
    }
    { float inv[4];
#pragma unroll
      for (int h = 0; h < 4; ++h) inv[h] = 1.0f / __int_as_float(__builtin_amdgcn_readlane(__float_as_int(sm), h));
      if (lane < 16) { bf16_t* Y = (bf16_t*)(F.ws + WS_H) + (T0 + qi) * DM + 512 + r16;
#pragma unroll
          for (int h = 0; h < 4; ++h)
#pragma unroll
              for (int nt = 0; nt < 4; ++nt) Y[h * 64 + 16 * nt] = f2bf(ov[nt][h] * inv[h]); } }
}

__device__ __forceinline__ void phase_router(const Frame& F_, int layer) { Frame F = relocal(F_); const int cset = layer;
    const float* X = (const float*)(F.ws + WS_X);
    const bf16_t* WH = (const bf16_t*)(F.ws + WS_WRT) + (size_t)layer * 2 * 49152; const bf16_t* WL = WH + 49152;
    LAS float* part = (LAS float*)F.lds;
    LAS float* ssq = (LAS float*)(F.lds + 24576);
    LAS int* es = (LAS int*)(F.lds + 25088);
    LAS int* lr = (LAS int*)(F.lds + 25600);
    LAS float* wsl = (LAS float*)(F.lds + 26112);
    LAS float* rsd = (LAS float*)(F.lds + 26624);
    for (int blk = F.bid; blk < NTOK / 64; blk += F.G) {
        __syncthreads();
        const int mt = F.wave & 3, kh = F.wave >> 2, r16 = F.lane & 15, g4 = F.lane >> 4;
        const float* xr = X + ((size_t)blk * 64 + mt * 16 + r16) * DM + kh * 512 + 8 * g4;
        f32x4 acc[3]; acc[0] = acc[1] = acc[2] = (f32x4){0.f, 0.f, 0.f, 0.f}; float ss = 0.f;
#pragma unroll 4
        for (int ks = 0; ks < 16; ++ks) {
            const f32x4 xa = *(const f32x4*)(xr + ks * 32), xb = *(const f32x4*)(xr + ks * 32 + 4);
            ss += xa[0] * xa[0] + xa[1] * xa[1] + xa[2] * xa[2] + xa[3] * xa[3] + xb[0] * xb[0] + xb[1] * xb[1] + xb[2] * xb[2] + xb[3] * xb[3];
            float xv[8] = {xa[0], xa[1], xa[2], xa[3], xb[0], xb[1], xb[2], xb[3]}; unsigned hw[4], lw[4];
#pragma unroll
            for (int j = 0; j < 4; ++j) { const bf16_t h0 = f2bf(xv[2 * j]), h1 = f2bf(xv[2 * j + 1]); hw[j] = (unsigned)h0 | ((unsigned)h1 << 16);
                lw[j] = pk2(xv[2 * j] - bf2f(h0), xv[2 * j + 1] - bf2f(h1)); }
            const bf16x8 ahi = __builtin_bit_cast(bf16x8, (u32x4){hw[0], hw[1], hw[2], hw[3]}), alo = __builtin_bit_cast(bf16x8, (u32x4){lw[0], lw[1], lw[2], lw[3]});
#pragma unroll
            for (int nt = 0; nt < 3; ++nt) { const size_t wo = (size_t)(nt * 16 + r16) * 1024 + kh * 512 + ks * 32 + 8 * g4;
                const bf16x8 bh = *(const bf16x8*)(WH + wo), bl = *(const bf16x8*)(WL + wo);
                acc[nt] = __builtin_amdgcn_mfma_f32_16x16x32_bf16(ahi, bh, acc[nt], 0, 0, 0);
                acc[nt] = __builtin_amdgcn_mfma_f32_16x16x32_bf16(ahi, bl, acc[nt], 0, 0, 0);
                acc[nt] = __builtin_amdgcn_mfma_f32_16x16x32_bf16(alo, bh, acc[nt], 0, 0, 0); }
        }
        ss = xrows(ss, OpAdd());
        if (g4 == 0) ssq[kh * 64 + mt * 16 + r16] = ss;
#pragma unroll
        for (int nt = 0; nt < 3; ++nt)
#pragma unroll
            for (int i = 0; i < 4; ++i) part[(kh * 64 + mt * 16 + 4 * g4 + i) * 48 + nt * 16 + r16] = acc[nt][i];
        __syncthreads();
        if (F.tid < 64) { const float rstd = rsqrtf((ssq[F.tid] + ssq[64 + F.tid]) * (1.0f / DM) + 1e-6f); rsd[F.tid] = rstd;
            float l[36];
#pragma unroll
            for (int o = 0; o < 36; ++o) l[o] = (part[F.tid * 48 + o] + part[(64 + F.tid) * 48 + o]) * rstd + (o < 32 ? F.in[I_BRE][layer * 32 + o] : F.in[I_BRG][layer * 4 + o - 32]);
            int gs = 0; float gm = l[32];
#pragma unroll
            for (int j = 1; j < 4; ++j) if (l[32 + j] > gm) { gm = l[32 + j]; gs = j; }
            float den = 0.f;
#pragma unroll
            for (int j = 0; j < 4; ++j) den += __expf(l[32 + j] - gm);
            const float gate = 1.0f / den;
            float e8[8];
#pragma unroll
            for (int j = 0; j < 8; ++j) e8[j] = gs == 0 ? l[j] : gs == 1 ? l[8 + j] : gs == 2 ? l[16 + j] : l[24 + j];
            int i1 = 0; float v1 = e8[0];
#pragma unroll
            for (int j = 1; j < 8; ++j) if (e8[j] > v1) { v1 = e8[j]; i1 = j; }
            int i2 = -1; float v2 = -INFINITY;
#pragma unroll
            for (int j = 0; j < 8; ++j) if (j != i1 && e8[j] > v2) { v2 = e8[j]; i2 = j; }
            const float e2 = __expf(v2 - v1); const float p1 = 1.0f / (1.0f + e2);
            es[F.tid * 2] = gs * 8 + i1; es[F.tid * 2 + 1] = gs * 8 + i2; wsl[F.tid * 2] = p1 * gate; wsl[F.tid * 2 + 1] = (1.0f - p1) * gate; }
        __syncthreads();
        if (F.tid < 32) { int cnt = 0; for (int i = 0; i < 128; ++i) if (es[i] == F.tid) lr[i] = cnt++;
            if (cnt) { const int base = (int)__hip_atomic_fetch_add(F.ctl + CW_CNT + cset * 32 + F.tid, (unsigned)cnt, __ATOMIC_RELAXED, __HIP_MEMORY_SCOPE_AGENT);
                for (int i = 0; i < 128; ++i) if (es[i] == F.tid) lr[i] += base; } }
        __syncthreads();
        if (F.tid < 64) { int* rt = (int*)(F.ws + WS_ROUTE) + ((size_t)blk * 64 + F.tid) * 8;
            rt[0] = es[F.tid * 2]; rt[1] = es[F.tid * 2 + 1]; ((float*)rt)[2] = wsl[F.tid * 2]; ((float*)rt)[3] = wsl[F.tid * 2 + 1]; rt[4] = lr[F.tid * 2]; rt[5] = lr[F.tid * 2 + 1]; ((float*)rt)[6] = rsd[F.tid]; }
    }
    __syncthreads();
    if (F.tid == 0) __hip_atomic_fetch_add(F.ctl + CW_RB + 64 * layer, 1u, __ATOMIC_RELAXED, __HIP_MEMORY_SCOPE_AGENT);
}
__device__ __forceinline__ void phase_moe_convert(const Frame& F_, int layer) { Frame F = relocal(F_);
    bf16_t* WGU = (bf16_t*)(F.ws + WS_MOE + MOE_WGU);
    for (int t = F.bid; t < 1024; t += F.G) {
        const int e = t >> 5, r = t & 31, kt = r >> 1, nt = r & 1; const size_t eo = ((size_t)layer * 32 + e) * 1024 * 256;
        tr_tile(F, 256, WGU + (size_t)e * 512 * 1024, 1024, kt * 64, nt * 256, SmGU{F.in[I_WGATE] + eo, F.in[I_WUP] + eo}); }
}
__device__ __forceinline__ void phase_moe_convert_down(const Frame& F_, int layer) { Frame F = relocal(F_);
    bf16_t* WD = (bf16_t*)(F.ws + WS_MOE + MOE_WD);
    for (;;) { const int q = q_pop(F, 32 + layer); if (q >= 512) break;
        const int e = q >> 4, r = q & 15, kt = r >> 2, nt = r & 3;
        tr_tile(F, 1024, WD + (size_t)e * 1024 * 256, 256, kt * 64, nt * 256, SmId{F.in[I_WDOWN] + ((size_t)layer * 32 + e) * 256 * 1024}); }
}
__device__ __forceinline__ void phase_gather(const Frame& F_, int layer) { Frame F = relocal(F_);
    LAS int* off = (LAS int*)F.lds;
    __syncthreads();
    if (F.tid == 0) { unsigned sp = 0;
        while (__hip_atomic_load(F.ctl + CW_RB + 64 * layer, __ATOMIC_RELAXED, __HIP_MEMORY_SCOPE_AGENT) < (unsigned)F.G) { __builtin_amdgcn_s_sleep(2); if (++sp > (1u << 22)) break; } }
    __syncthreads();
    if (F.tid == 0) { int acc = 0; for (int e = 0; e < 32; ++e) { off[e] = acc; const int c = (int)__hip_atomic_load(F.ctl + CW_CNT + layer * 32 + e, __ATOMIC_RELAXED, __HIP_MEMORY_SCOPE_AGENT); acc += (c + 255) & ~255; } off[32] = acc; }
    __syncthreads();
    int* tiles = (int*)(F.ws + WS_TILES); int* row_tok = (int*)(F.ws + WS_ROWS); float* row_w = (float*)(F.ws + WS_ROWS) + MAXROWS;
    if (F.bid == 0) { if (F.tid == 0) tiles[0] = off[32] >> 8; if (F.tid < 33) tiles[1 + F.tid] = off[F.tid];
        if (F.tid < 32) for (int rt = off[F.tid] >> 8; rt < (off[F.tid + 1] >> 8); ++rt) tiles[64 + rt] = F.tid; }
    for (int e = F.bid; e < 32; e += F.G) { const int c = (int)__hip_atomic_load(F.ctl + CW_CNT + layer * 32 + e, __ATOMIC_RELAXED, __HIP_MEMORY_SCOPE_AGENT);
        for (int r = off[e] + c + F.tid; r < off[e + 1]; r += NTHR) { row_tok[r] = -1; row_w[r] = 0.f; } }
    const float* X = (const float*)(F.ws + WS_X); bf16_t* HP = (bf16_t*)(F.ws + WS_U); const float* nw = F.in[I_NORM2] + (size_t)layer * DM;
    f32x4 nwv[4];
#pragma unroll
    for (int j = 0; j < 4; ++j) nwv[j] = *(const f32x4*)(nw + 4 * F.lane + 256 * j);
    for (int blk = F.bid; blk < NTOK / 64; blk += F.G)
    for (int i4 = 0; i4 < 2; ++i4) {
        int p0[4], p1[4], tt[4]; float rstd[4], w0[4], w1[4]; f32x4 xv[4][4];
#pragma unroll
        for (int r = 0; r < 4; ++r) { const int t = blk * 64 + F.wave * 8 + 4 * i4 + r; tt[r] = t;
            const int* rt = (const int*)(F.ws + WS_ROUTE) + (size_t)t * 8; rstd[r] = ((const float*)rt)[6]; w0[r] = ((const float*)rt)[2]; w1[r] = ((const float*)rt)[3];
            p0[r] = off[rt[0]] + rt[4]; p1[r] = off[rt[1]] + rt[5];
#pragma unroll
            for (int j = 0; j < 4; ++j) xv[r][j] = *(const f32x4*)(X + (size_t)t * DM + 4 * F.lane + 256 * j); }
#pragma unroll
        for (int r = 0; r < 4; ++r) {
#pragma unroll
            for (int j = 0; j < 4; ++j) { const int c = 4 * F.lane + 256 * j; const f32x4 v = xv[r][j] * rstd[r] * nwv[j];
                u32x2 o; o.x = pk2(v[0], v[1]); o.y = pk2(v[2], v[3]);
                *(u32x2*)(HP + (size_t)tt[r] * DM + c) = o; }
            if (F.lane == 0) { row_tok[p0[r]] = tt[r] * 2; row_w[p0[r]] = w0[r]; row_tok[p1[r]] = tt[r] * 2 + 1; row_w[p1[r]] = w1[r]; } }
    }
}

constexpr int NPH_LAYER = 9, NPHASE = 1 + 2 * NPH_LAYER + 1;
#ifndef MK_ONLY
#define MK_ONLY -1
#endif
#ifndef MK_ITEM
#define MK_ITEM -1
#endif
#define EN(o) (MK_ONLY < 0 || MK_ONLY == (o))
#define IT(o) (MK_ITEM < 0 || MK_ITEM == (o))
__global__ void __launch_bounds__(NTHR, 2) mk_forward(Params P) {
    extern __shared__ __attribute__((aligned(16))) unsigned char lds_raw[];
    Frame F; F.lds = (LAS unsigned char*)lds_raw; F.tid = threadIdx.x; F.lane = F.tid & 63; F.wave = __builtin_amdgcn_readfirstlane(F.tid >> 6); F.bid = blockIdx.x; F.G = gridDim.x;
    F.in = (in_tab_t)__builtin_amdgcn_kernarg_segment_ptr(); F.out = P.out; F.ws = P.ws; F.ctl = (unsigned*)(P.ws + WS_CTL); F.misc = (volatile LAS int*)(F.lds + MISC_OFF);
    if (F.tid < 64) ((LAS unsigned*)(F.lds + MISC_OFF))[F.tid] = 0u;
    __syncthreads();
    const int lo = P.ph_lo, hi = P.ph_hi;
    XcdBarrier bar; bar.bar = F.ctl + CW_BAR; bar.x = 0; bar.st = (volatile LAS unsigned*)(F.lds + MISC_OFF + 16);
    if (hi - lo > 1) bar = xcd_barrier_post(F.ctl + CW_BAR, (volatile LAS unsigned*)(F.lds + MISC_OFF + 16));
#define IN(k) (lo <= (k) && (k) < hi)
#define SEAM(k) do { if (IN(k) && IN((k) + 1)) xcd_barrier(bar); } while (0)
#define QLOOP(qi, n, body) for (;;) { const int it = q_pop(F, layer * 12 + (qi)); if (it >= (n)) break; body; }
    if (EN(100) && IN(0)) { phase_prologue(F); phase_norm(F, F.in[I_X], false, F.in[I_NORM1], 3); } SEAM(0);
#pragma unroll
    for (int layer = 0; layer < DEPTH; ++layer) {
        const int pb = 1 + layer * NPH_LAYER;
        if (layer > 0) { if (EN(0) && IN(pb + 0)) { phase_norm(F, (const float*)(F.ws + WS_X), true, F.in[I_NORM1] + (size_t)layer * DM, 0); } SEAM(pb + 0); }
        if (EN(1) && IN(pb + 1)) { const Frame F_ = F; Frame F = relocal(F_); pg8::StaticOrder S; S.init((const bf16_t*)(F.ws + WS_H), (const bf16_t*)(F.ws + WS_WIN) + (size_t)layer * NINP * DM, NTOK, NINP, DM, F.G, F.bid);
            pg8::EpiBf16 E{(bf16_t*)(F.ws + WS_U), NINP}; pg8::gemm_phase(F.lds, DM, S, E); } SEAM(pb + 1);
#define SLOOP(n, body) for (int it = F.bid; it < (n); it += F.G) { __syncthreads(); body; }
        if (EN(2) && IN(pb + 2)) {
            if (IT(1)) SLOOP(1024, item_rwkv1(F, layer, it));
            if (IT(0)) SLOOP(256, item_s5<1>(F, layer, it));
            if (IT(2)) SLOOP(256, item_mamba<1>(F, layer, it));
            if (IT(3)) SLOOP(256, item_kv(F, layer, it));
        } SEAM(pb + 2);
        if (EN(3) && IN(pb + 3)) {
            if (IT(0)) SLOOP(8, item_rwkv_carry(F, it));
            if (IT(1)) { for (int it = F.bid - 8; it >= 0 && it < 16; it += F.G) { __syncthreads(); item_mamba_carry(F, it); } }
            if (IT(2)) { for (int it = F.bid - 24; it >= 0 && it < 4; it += F.G) { __syncthreads(); item_s5_carry(F, layer, it); } }
            if (IT(3)) {
                dsa_tables(F);
                const int pref = (int)(xb_xcc_id() & 3u);
#pragma unroll 1
                for (int k4 = 0; k4 < 4; ++k4) { const int bq = (pref + k4) & 3;
                    for (;;) { const int it = q_pop(F, 24 + layer * 4 + bq); if (it >= 512) break; item_dsa(F, layer, it * 4 + bq); } } }
        } SEAM(pb + 3);
        if (EN(4) && IN(pb + 4)) {
            if (IT(0)) SLOOP(256, item_s5<2>(F, layer, it));
            if (IT(2)) SLOOP(256, item_mamba<2>(F, layer, it));
            if (IT(1)) SLOOP(1024, item_rwkv3(F, layer, it));
        } SEAM(pb + 4);
        if (EN(6) && IN(pb + 5)) { const Frame F_ = F; Frame F = relocal(F_); pg8::StaticOrder S; S.init((const bf16_t*)(F.ws + WS_H), (const bf16_t*)(F.ws + WS_WOUT) + (size_t)layer * DM * DM, NTOK, DM, DM, F.G, F.bid);
            pg8::EpiResid E{layer == 0 ? F.in[I_X] : (const float*)(F.ws + WS_X), (float*)(F.ws + WS_X), DM}; pg8::gemm_phase(F.lds, DM, S, E); } SEAM(pb + 5);
        if (EN(7) && IN(pb + 6)) { phase_router(F, layer); phase_moe_convert(F, layer); phase_gather(F, layer); } SEAM(pb + 6);
        if (EN(8) && IN(pb + 7)) { const Frame F_ = F; Frame F = relocal(F_); LAS int* ul = (LAS int*)(F.lds + pg8::STAGE_BYTES + 8192); if (F.tid == 0) pg8::MoeOrder::build(ul, (const int*)(F.ws + WS_TILES), 2, F.G, F.bid); __syncthreads();
            pg8::MoeOrder S{DM, (const char*)(F.ws + WS_U), (const char*)(F.ws + WS_MOE + MOE_WGU), (size_t)512 * 1024 * 2, ul};
            pg8::EpiGated<1> E{(bf16_t*)(F.ws + WS_H), 256, 0, nullptr, nullptr}; pg8::gemm_phase<pg8::EpiGated<1>, pg8::MoeOrder, true>(F.lds, DM, S, E, (const char*)(F.ws + WS_U), (const int*)(F.ws + WS_ROWS)); phase_moe_convert_down(F, layer); } SEAM(pb + 7);
        if (EN(9) && IN(pb + 8)) { const Frame F_ = F; Frame F = relocal(F_); LAS int* ul = (LAS int*)(F.lds + pg8::STAGE_BYTES + 8192); if (F.tid == 0) pg8::MoeOrder::build(ul, (const int*)(F.ws + WS_TILES), 4, F.G, F.bid); __syncthreads();
            pg8::MoeOrder S{256, (const char*)(F.ws + WS_H), (const char*)(F.ws + WS_MOE + MOE_WD), (size_t)1024 * 256 * 2, ul};
            pg8::EpiMoeOut E{(bf16_t*)(F.ws + WS_U), (const int*)(F.ws + WS_ROWS), (const float*)(F.ws + WS_ROWS) + MAXROWS, F.lds}; pg8::gemm_phase(F.lds, 256, S, E); } SEAM(pb + 8);
    }
    if (EN(101) && IN(NPHASE - 1)) { phase_norm(F, (const float*)(F.ws + WS_X), true, F.in[I_FNORM], 2); }
#undef IN
#undef SEAM
}

#ifndef MK_SPLIT
#define MK_SPLIT 0
#endif
extern "C" void kernel_launch(void* const* d_in, const int* in_sizes, int n_in, void* d_out, int out_size, void* d_ws, size_t ws_size, hipStream_t stream) {
    static int grid = 0;
    if (grid == 0) {
        if (n_in != 44 || out_size != NTOK * DM || ws_size < WS_END) { fprintf(stderr, "kernel_launch: unexpected shapes (n_in %d out %d ws %zu need %zu)\n", n_in, out_size, ws_size, (size_t)WS_END); grid = -1; return; }
        int dev = 0, cus = 0;
        if (hipGetDevice(&dev) != hipSuccess || hipDeviceGetAttribute(&cus, hipDeviceAttributeMultiprocessorCount, dev) != hipSuccess) { grid = -1; return; }
        if (hipFuncSetAttribute((const void*)mk_forward, hipFuncAttributeMaxDynamicSharedMemorySize, LDS_BYTES) != hipSuccess) { fprintf(stderr, "kernel_launch: hipFuncSetAttribute failed\n"); grid = -1; return; }
        int per_cu = 0;
        if (hipOccupancyMaxActiveBlocksPerMultiprocessor(&per_cu, (const void*)mk_forward, NTHR, LDS_BYTES) != hipSuccess || per_cu < 1) { fprintf(stderr, "kernel_launch: occupancy query says %d\n", per_cu); }
        (void)hipGetLastError();
        grid = cus;
    }
    if (grid < 0) return;
    hipMemsetAsync((char*)d_ws + WS_CTL, 0, CTL_BYTES, stream);
    Params p{};
    for (int i = 0; i < 44; ++i) p.in[i] = (const float*)d_in[i];
    p.out = (float*)d_out; p.ws = (unsigned char*)d_ws;
#if MK_SPLIT
    for (int ph = 0; ph < NPHASE; ++ph) { p.ph_lo = ph; p.ph_hi = ph + 1; hipLaunchKernelGGL(mk_forward, dim3(grid), dim3(NTHR), LDS_BYTES, stream, p); }
#else
    p.ph_lo = 0; p.ph_hi = NPHASE; hipLaunchKernelGGL(mk_forward, dim3(grid), dim3(NTHR), LDS_BYTES, stream, p);
#endif
}
```

```cpp
#include <hip/hip_runtime.h>
#include <stdint.h>
#include <stdio.h>

#define LAS __attribute__((address_space(3)))
typedef unsigned short bf16_t;
typedef short bf16x8 __attribute__((ext_vector_type(8)));
typedef float f32x4 __attribute__((ext_vector_type(4)));
typedef float f32x2 __attribute__((ext_vector_type(2)));
typedef float f32x16 __attribute__((ext_vector_type(16)));
typedef unsigned u32x4 __attribute__((ext_vector_type(4)));
typedef unsigned u32x2 __attribute__((ext_vector_type(2)));

constexpr int NTOK = 16384, DM = 1024, SEQ = 4096, NBATCH = 4, DEPTH = 2;
constexpr int NIN = 2604, NINP = 2816;
constexpr int UM = 0;
constexpr int UR = 784;
constexpr int UC = 1680;
constexpr int US = 2368;
constexpr int NTHR = 512;
constexpr int LDS_BYTES = 163840;
constexpr int MISC_OFF = LDS_BYTES - 256;

constexpr size_t WS_CTL   = 0;
constexpr size_t CTL_BYTES = 65536;
constexpr size_t WS_X     = WS_CTL + CTL_BYTES;
constexpr size_t WS_H     = WS_X + (size_t)NTOK * DM * 4;
constexpr size_t WS_U     = WS_H + (size_t)NTOK * DM * 2;
constexpr size_t WS_WIN   = WS_U + (size_t)NTOK * NINP * 2;
constexpr size_t WS_WOUT  = WS_WIN + (size_t)2 * NINP * DM * 2;
constexpr size_t WS_GLU   = WS_WOUT + (size_t)2 * DM * DM * 2;
constexpr size_t WS_MOE   = WS_GLU + (size_t)2 * 512 * 256 * 2;
constexpr size_t MOE_WGU  = 0;
constexpr size_t MOE_WD   = (size_t)32 * 512 * 1024 * 2;
constexpr size_t MOE_BYTES = MOE_WD + (size_t)32 * 1024 * 256 * 2;
constexpr size_t RW_PT    = 0;
constexpr size_t RW_U     = (size_t)1024 * 4096 * 2;
constexpr size_t RW_S     = RW_U + (size_t)1024 * 4096 * 2;
constexpr size_t RW_W1    = RW_S + (size_t)1024 * 4096 * 2;
constexpr size_t RW_Z     = RW_W1 + (size_t)1024 * 4096 * 2;
constexpr size_t YSG_OFF  = RW_Z + (size_t)1024 * 4096 * 2;
static_assert(YSG_OFF + (size_t)NTOK * 256 * 2 <= MOE_BYTES, "alias");
constexpr size_t WS_MST   = WS_MOE + MOE_BYTES;
constexpr size_t WS_MDEC  = WS_MST + (size_t)4 * 64 * 4 * 4096 * 4;
constexpr size_t WS_S5ST  = WS_MDEC + 4096;
constexpr size_t WS_K     = WS_S5ST + (size_t)4 * 64 * 2048 * 4;
constexpr size_t WS_V     = WS_K + (size_t)NTOK * 64 * 2;
constexpr size_t WS_KIDX  = WS_V + (size_t)NTOK * 64 * 2;
constexpr size_t WS_ROUTE = WS_KIDX + (size_t)NTOK * 32 * 2;
constexpr size_t WS_ROWS  = WS_ROUTE + (size_t)NTOK * 32;
constexpr int    MAXROWS  = 49152;
constexpr size_t WS_TILES = WS_ROWS + (size_t)MAXROWS * 8;
constexpr size_t WS_S5TAB = WS_TILES + 4096;
constexpr size_t S5TAB_F  = (size_t)(2048 + 2048 + 32768) * 4;
constexpr size_t S5TAB_BBT = S5TAB_F + (size_t)16 * 16 * 128 * 2;
constexpr size_t S5TAB_L  = S5TAB_BBT + (size_t)16 * 128 * 16 * 2;
constexpr size_t WS_WRT   = WS_S5TAB + 2 * S5TAB_L;
constexpr size_t WS_BON   = WS_WRT + (size_t)2 * 2 * 48 * 1024 * 2;
constexpr size_t WS_END   = WS_BON + (size_t)1024 * 64 * 4;

constexpr int CW_BAR = 0;
constexpr int CW_Q   = 4096;
constexpr int CW_CNT = 8192;
constexpr int CW_RB  = 8448;

__device__ __forceinline__ float bf2f(bf16_t b) { return __uint_as_float(((unsigned)b) << 16); }
__device__ __forceinline__ bf16_t f2bf(float f) { const __bf16 h = (__bf16)f; return __builtin_bit_cast(bf16_t, h); }
__device__ __forceinline__ unsigned pk2(float lo, float hi) { typedef __bf16 bf2_t __attribute__((ext_vector_type(2))); const bf2_t h = __builtin_convertvector((f32x2){lo, hi}, bf2_t); return __builtin_bit_cast(unsigned, h); }
__device__ __forceinline__ unsigned cvt_pk_bf16(float lo, float hi) { unsigned r; asm volatile("v_cvt_pk_bf16_f32 %0, %1, %2" : "=v"(r) : "v"(lo), "v"(hi)); return r; }
__device__ __forceinline__ float sigmoidf_(float x) { return 1.0f / (1.0f + __expf(-x)); }
__device__ __forceinline__ float siluf_(float x) { return x / (1.0f + __expf(-x)); }
__device__ __forceinline__ float tanhf_(float x) { const float e = __expf(2.0f * x); return 1.0f - 2.0f / (e + 1.0f); }
__device__ __forceinline__ float softplusf_(float x) { return fmaxf(x, 0.0f) + log1pf(__expf(-fabsf(x))); }
__device__ __forceinline__ float gelu_tanh(float x) { return 0.5f * x * (1.0f + tanhf_(0.7978845608028654f * (x + 0.044715f * x * x * x))); }
template <int CTRL> __device__ __forceinline__ float dppf(float x) { return __int_as_float(__builtin_amdgcn_update_dpp(0, __float_as_int(x), CTRL, 0xF, 0xF, true)); }
__device__ __forceinline__ float sum4(float x) { x += dppf<0xB1>(x); x += dppf<0x4E>(x); return x; }
__device__ __forceinline__ float sum8(float x) { x = sum4(x); x += dppf<0x141>(x); return x; }
__device__ __forceinline__ float sum16(float x) { x = sum8(x); x += dppf<0x140>(x); return x; }
__device__ __forceinline__ int lane_id_() { int l = (int)__builtin_amdgcn_mbcnt_hi(~0u, __builtin_amdgcn_mbcnt_lo(~0u, 0u)); asm volatile("" : "+v"(l)); return l; }
__device__ __forceinline__ float shx(float x, int o) { return __int_as_float(__builtin_amdgcn_ds_bpermute((lane_id_() ^ o) << 2, __float_as_int(x))); }
__device__ __forceinline__ unsigned shdown_u(unsigned x, int o) { return (unsigned)__builtin_amdgcn_ds_bpermute(((lane_id_() + o) & 63) << 2, (int)x); }
__device__ __forceinline__ int shidx_i(int x, int src) { return __builtin_amdgcn_ds_bpermute(src << 2, x); }
template <class OP> __device__ __forceinline__ float xrows(float x, OP op) {
    u32x2 r = __builtin_amdgcn_permlane16_swap(__float_as_uint(x), __float_as_uint(x), false, false); x = op(__uint_as_float(r[0]), __uint_as_float(r[1]));
    r = __builtin_amdgcn_permlane32_swap(__float_as_uint(x), __float_as_uint(x), false, false); return op(__uint_as_float(r[0]), __uint_as_float(r[1])); }
struct OpAdd { __device__ __forceinline__ float operator()(float a, float b) const { return a + b; } };
struct OpMin { __device__ __forceinline__ float operator()(float a, float b) const { return fminf(a, b); } };
struct OpMax { __device__ __forceinline__ float operator()(float a, float b) const { return fmaxf(a, b); } };
__device__ __forceinline__ float wave_sum(float x) { x = sum16(x); return xrows(x, OpAdd()); }
__device__ __forceinline__ float wave_min(float x) { x = fminf(x, dppf<0xB1>(x)); x = fminf(x, dppf<0x4E>(x)); x = fminf(x, dppf<0x141>(x)); x = fminf(x, dppf<0x140>(x)); return xrows(x, OpMin()); }
__device__ __forceinline__ float wave_max(float x) { x = fmaxf(x, dppf<0xB1>(x)); x = fmaxf(x, dppf<0x4E>(x)); x = fmaxf(x, dppf<0x141>(x)); x = fmaxf(x, dppf<0x140>(x)); return xrows(x, OpMax()); }
template <int CTRL, int RM, bool BC> __device__ __forceinline__ float dpp_addf(float x) { return x + __int_as_float(__builtin_amdgcn_update_dpp(0, __float_as_int(x), CTRL, RM, 0xF, BC)); }
__device__ __forceinline__ float wave_prefix_f(float x) { x = dpp_addf<0x111, 0xF, true>(x); x = dpp_addf<0x112, 0xF, true>(x); x = dpp_addf<0x114, 0xF, true>(x); x = dpp_addf<0x118, 0xF, true>(x);
    x = dpp_addf<0x142, 0xA, false>(x); return dpp_addf<0x143, 0xC, false>(x); }
__device__ __forceinline__ unsigned wave_prefix_u(unsigned x) { int v = (int)x;
    v += __builtin_amdgcn_update_dpp(0, v, 0x111, 0xF, 0xF, true); v += __builtin_amdgcn_update_dpp(0, v, 0x112, 0xF, 0xF, true);
    v += __builtin_amdgcn_update_dpp(0, v, 0x114, 0xF, 0xF, true); v += __builtin_amdgcn_update_dpp(0, v, 0x118, 0xF, 0xF, true);
    v += __builtin_amdgcn_update_dpp(0, v, 0x142, 0xA, 0xF, false); v += __builtin_amdgcn_update_dpp(0, v, 0x143, 0xC, 0xF, false); return (unsigned)v; }
__device__ __forceinline__ void unpack8(const u32x4 v, float (&f)[8]) {
    f[0] = __uint_as_float(v.x << 16); f[1] = __uint_as_float(v.x & 0xffff0000u); f[2] = __uint_as_float(v.y << 16); f[3] = __uint_as_float(v.y & 0xffff0000u);
    f[4] = __uint_as_float(v.z << 16); f[5] = __uint_as_float(v.z & 0xffff0000u); f[6] = __uint_as_float(v.w << 16); f[7] = __uint_as_float(v.w & 0xffff0000u);
}

__device__ __forceinline__ void st16_wt(void* p, u32x4 v) { asm volatile("global_store_dwordx4 %0, %1, off sc1\n\ts_nop 1" :: "v"(p), "v"(v) : "memory"); }
#define XB_TMO      128
#define XB_XCNT(j)  (256  + 64 * (j))
#define XB_XSUB(j)  (1280 + 64 * (j))
#define XB_XGEN(j)  (2304 + 64 * (j))
#define XB_TOP      3328
#define XB_TOPGEN   3392
#define XCD_BAR_WORDS 3456
#define XB_SPIN_CAP (1u << 22)
__device__ __forceinline__ unsigned xb_ld(unsigned* p)              { return __hip_atomic_load(p, __ATOMIC_RELAXED, __HIP_MEMORY_SCOPE_AGENT); }
__device__ __forceinline__ unsigned xb_add(unsigned* p, unsigned v) { return __hip_atomic_fetch_add(p, v, __ATOMIC_RELAXED, __HIP_MEMORY_SCOPE_AGENT); }
__device__ __forceinline__ unsigned xb_xcc_id() { return (unsigned)__builtin_amdgcn_s_getreg((3 << 11) | 20) & 0xFu; }
#define XB_SPIN(cond, bar) do { unsigned _sp = 0; while (cond) { __builtin_amdgcn_s_sleep(1); \
    if ((++_sp & 255u) == 0u) { if (xb_ld(&(bar)[XB_TMO])) break; if (_sp > XB_SPIN_CAP) { atomicAdd(&(bar)[XB_TMO], 1u); break; } } } } while (0)
struct XcdBarrier { unsigned* bar; unsigned x; volatile LAS unsigned* st; };
__device__ __forceinline__ XcdBarrier xcd_barrier_post(unsigned* bar, volatile LAS unsigned* st) {
    XcdBarrier b; b.bar = bar; b.x = xb_xcc_id(); b.st = st;
    if (threadIdx.x == 0) (void)xb_add(&bar[XB_XCNT(b.x)], 1u);
    return b;
}
__device__ __forceinline__ void xcd_barrier_complete(unsigned* bar, unsigned x, unsigned& nloc, unsigned& nx) {
    const unsigned G = gridDim.x * gridDim.y * gridDim.z;
    unsigned sum, cnt, mine, sp = 0u;
    for (;;) {
        sum = 0u; cnt = 0u; mine = 0u;
#pragma unroll
        for (unsigned j = 0; j < 16; ++j) { const unsigned c = xb_ld(&bar[XB_XCNT(j)]); sum += c; cnt += (c > 0u) ? 1u : 0u; mine = (j == x) ? c : mine; }
        if (sum == G) break;
        __builtin_amdgcn_s_sleep(1);
        if ((++sp & 255u) == 0u) { if (xb_ld(&bar[XB_TMO])) break; if (sp > XB_SPIN_CAP) { atomicAdd(&bar[XB_TMO], 1u); break; } }
    }
    nloc = mine > 0u ? mine : 1u; nx = cnt > 0u ? cnt : 1u;
}
__device__ __forceinline__ void xcd_barrier(const XcdBarrier& b_) {
    XcdBarrier b = b_; { const unsigned long long v = (unsigned long long)b.bar; unsigned lo = __builtin_amdgcn_readfirstlane((unsigned)v), hi = __builtin_amdgcn_readfirstlane((unsigned)(v >> 32)); asm volatile("" : "+s"(lo), "+s"(hi)); b.bar = (unsigned*)(((unsigned long long)hi << 32) | lo); unsigned xx = __builtin_amdgcn_readfirstlane(b.x); asm volatile("" : "+s"(xx)); b.x = xx; }
    asm volatile("s_waitcnt vmcnt(0)" ::: "memory");
    __syncthreads();
    if (threadIdx.x == 0) {
        unsigned* bar = b.bar;
        __builtin_amdgcn_s_waitcnt(0);
        unsigned nloc = b.st[0], nx = b.st[1];
        if (nloc == 0u) { xcd_barrier_complete(bar, b.x, nloc, nx); b.st[0] = nloc; b.st[1] = nx; }
        const unsigned old = xb_add(&bar[XB_XSUB(b.x)], 1u);
        const unsigned gen = old / nloc;
        if (old + 1u == (gen + 1u) * nloc) {
            __builtin_amdgcn_fence(__ATOMIC_RELEASE, "agent");
            asm volatile("s_waitcnt vmcnt(0)" ::: "memory");
            const unsigned og = xb_add(&bar[XB_TOP], 1u);
            const unsigned tg = og / nx;
            if (og + 1u == (tg + 1u) * nx) xb_add(&bar[XB_TOPGEN], 1u);
            else XB_SPIN(xb_ld(&bar[XB_TOPGEN]) == tg, bar);
            __builtin_amdgcn_fence(__ATOMIC_ACQUIRE, "agent");
            xb_add(&bar[XB_XGEN(b.x)], 1u);
            asm volatile("s_waitcnt vmcnt(0)" ::: "memory");
        } else {
            XB_SPIN(xb_ld(&bar[XB_XGEN(b.x)]) == gen, bar);
            __builtin_amdgcn_fence(__ATOMIC_ACQUIRE, "agent");
            asm volatile("s_waitcnt vmcnt(0)" ::: "memory");
        }
    }
    __syncthreads();
}

namespace pg8 {
constexpr int BM = 256, BK = 64, HALF = 128, HTB = HALF * BK * 2, STAGE_BYTES = 8 * HTB, NXCD = 8, WGM = 8;
__host__ __device__ __forceinline__ int lds_byte(int r, int c) { const int st = (r >> 4) * 2 + (c >> 5), rr = r & 15, cc = c & 31, ob = rr * 64 + cc * 2; return st * 1024 + (ob ^ (((ob >> 9) & 1) << 5)); }
__host__ __device__ __forceinline__ void stage_rc(int b, int& R, int& C) { const int st = b / 1024, sb = b % 1024, swz = sb ^ (((sb >> 9) & 1) << 5); R = (st >> 1) * 16 + swz / 64; C = (st & 1) * 32 + (swz % 64) / 2; }
__host__ __device__ __forceinline__ int perm32(int rho) { const int n = rho >> 4, i = rho & 15; return 8 * (i >> 2) + 4 * n + (i & 3); }
struct Unit { int pm, pn; const char* a; const char* b; };

struct StaticOrder {
    int nM, nN, nwg, G, c, K; const char* A; const char* B;
    __device__ void init(const bf16_t* A_, const bf16_t* B_, int M, int N, int K_, int G_, int c_) { A = (const char*)A_; B = (const char*)B_; K = K_; nM = M / BM; nN = N / BM; nwg = nM * nN; G = G_; c = c_; }
    __device__ bool next(int i, Unit& u) const {
        const long L = (long)i * G + c; if (L >= nwg) return false;
        int wgid = (int)L; { const int q = nwg / NXCD, r = nwg % NXCD, xcd = wgid % NXCD, off = wgid / NXCD; wgid = (xcd < r ? xcd * (q + 1) : r * (q + 1) + (xcd - r) * q) + off; }
        const int nig = WGM * nN, gid = wgid / nig, fm = gid * WGM, gsz = (nM - fm) < WGM ? (nM - fm) : WGM;
        u.pm = fm + ((wgid % nig) % gsz); u.pn = (wgid % nig) / gsz;
        u.a = A + (size_t)u.pm * 256 * K * 2; u.b = B + (size_t)u.pn * 256 * K * 2; return true;
    }
};

template <class Epi, class Sched, bool GATHER = false>
__device__ __forceinline__ void gemm_phase(LAS unsigned char* lds, const int K_, const Sched& S, const Epi& E, const char* Aall = nullptr, const int* arow = nullptr) {
    int K = K_; asm volatile("" : "+s"(K));
    int tid_ = threadIdx.x; asm volatile("" : "+v"(tid_));
    const int tid = tid_, wid = __builtin_amdgcn_readfirstlane(tid >> 6), lane = tid & 63, wr = wid >> 2, wc = wid & 3, fr = lane & 15, fq = lane >> 4;
    const int nt = K / BK;
    unsigned voffA[2], voffB[2]; int Rst[2], Cst[2];
#pragma unroll
    for (int i = 0; i < 2; ++i) { int R, C; stage_rc(tid * 16 + i * 8192, R, C); const int Rb = Epi::PERM ? ((R & ~31) + perm32(R & 31)) : R; Rst[i] = R; Cst[i] = C;
        voffA[i] = (unsigned)(R * K + C) * 2u; voffB[i] = (unsigned)(Rb * K + C) * 2u; }
    unsigned gv[2][2], gn[2][2];
#define PG8_GOFF(dst, unit) do { _Pragma("unroll") for (int h_ = 0; h_ < 2; ++h_) _Pragma("unroll") for (int i_ = 0; i_ < 2; ++i_) { const int rr_ = arow[(unit).pm * BM + h_ * HALF + Rst[i_]]; \
        dst[h_][i_] = ((unsigned)(rr_ < 0 ? 0 : rr_ >> 1) * (unsigned)K + (unsigned)Cst[i_]) * 2u; } } while (0)
    const size_t kstep = (size_t)(BK * 2);
    const size_t hstep = (size_t)HALF * K * 2;
    const unsigned ldsw = (unsigned)wid * 1024u;
    const int aoff = lds_byte(wr * 64 + fr, fq * 8), boff = lds_byte(wc * 32 + fr, fq * 8);
#define PG8_SA(b, h) (((b) * 2 + (h)) * HTB)
#define PG8_SB(b, h) ((4 + (b) * 2 + (h)) * HTB)
#define PG8_STAGE(bufoff, gbase, voff) do { _Pragma("unroll") for (int _i = 0; _i < 2; ++_i) \
        __builtin_amdgcn_global_load_lds((const unsigned*)((const char*)(gbase) + (voff)[_i]), (LAS unsigned*)(lds + (bufoff) + ldsw + _i * 8192), 16, 0, 0); } while (0)
#define PG8_LDA(dst, b, h) do { _Pragma("unroll") for (int m = 0; m < 4; ++m) _Pragma("unroll") for (int k = 0; k < 2; ++k) dst[m][k] = *(const LAS bf16x8*)(lds + PG8_SA(b, h) + aoff + m * 2048 + k * 1024); } while (0)
#define PG8_LDB(dst, b, h) do { _Pragma("unroll") for (int n = 0; n < 2; ++n) _Pragma("unroll") for (int k = 0; k < 2; ++k) dst[n][k] = *(const LAS bf16x8*)(lds + PG8_SB(b, h) + boff + n * 2048 + k * 1024); } while (0)
#define PG8_MMA(ai, bj, At, Bt) do { __builtin_amdgcn_s_setprio(1); _Pragma("unroll") for (int m = 0; m < 4; ++m) _Pragma("unroll") for (int n = 0; n < 2; ++n) _Pragma("unroll") for (int k = 0; k < 2; ++k) \
        acc[ai][bj][m][n] = __builtin_amdgcn_mfma_f32_16x16x32_bf16(Bt[n][k], At[m][k], acc[ai][bj][m][n], 0, 0, 0); __builtin_amdgcn_s_setprio(0); } while (0)
#define PG8_WAIT_V(n) asm volatile("s_waitcnt vmcnt(" #n ")" ::: "memory")
#define PG8_WAIT_L(n) asm volatile("s_waitcnt lgkmcnt(" #n ")" ::: "memory")
#define PG8_BAR __builtin_amdgcn_s_barrier()
#define PG8_SCHED __builtin_amdgcn_sched_barrier(0)
    Unit cur, nxt; int ui = 0;
    if (!S.next(0, cur)) return;
    f32x4 acc[2][2][4][2];
#pragma unroll
    for (int a = 0; a < 2; ++a)
#pragma unroll
        for (int b = 0; b < 2; ++b)
#pragma unroll
            for (int m = 0; m < 4; ++m)
#pragma unroll
                for (int n = 0; n < 2; ++n) acc[a][b][m][n] = (f32x4){0.f, 0.f, 0.f, 0.f};
    bf16x8 At[4][2], B0[2][2], B1[2][2];
    const char* cA = GATHER ? Aall : cur.a; const char* cB = cur.b;
    if (GATHER) PG8_GOFF(gv, cur);
#define PG8_STAGE_A(bufoff, gbase, h, vo) do { if (GATHER) PG8_STAGE(bufoff, gbase, (vo)[h]); else PG8_STAGE(bufoff, (gbase) + ((h) ? hstep : 0), voffA); } while (0)
    PG8_STAGE(PG8_SB(0, 0), cB, voffB); PG8_STAGE_A(PG8_SA(0, 0), cA, 0, gv); PG8_STAGE(PG8_SB(0, 1), cB + hstep, voffB); PG8_STAGE_A(PG8_SA(0, 1), cA, 1, gv);
    if (wr == 1) PG8_BAR;
    PG8_WAIT_V(4); PG8_BAR;
    PG8_STAGE(PG8_SB(1, 0), cB + kstep, voffB); PG8_STAGE_A(PG8_SA(1, 0), cA + kstep, 0, gv); PG8_STAGE(PG8_SB(1, 1), cB + hstep + kstep, voffB);
    PG8_WAIT_V(6); PG8_BAR;
    for (;;) {
        const bool has_next = S.next(ui + 1, nxt);
        const char* nA = GATHER ? cA : (has_next ? nxt.a : cA); const char* nB = has_next ? nxt.b : cB;
        if (GATHER) { if (has_next) PG8_GOFF(gn, nxt); else {
#pragma unroll
            for (int h_ = 0; h_ < 2; ++h_)
#pragma unroll
                for (int i_ = 0; i_ < 2; ++i_) gn[h_][i_] = gv[h_][i_]; } }
        for (int t = 0; t < nt; t += 2) {
            const bool last = (t == nt - 2);
            const char* a1 = cA + (size_t)(t + 1) * kstep;
            const char* a2 = last ? nA : cA + (size_t)(t + 2) * kstep; const char* b2 = last ? nB : cB + (size_t)(t + 2) * kstep;
            const char* a3 = a2 + kstep; const char* b3 = b2 + kstep;
            unsigned vo2[2][2];
#pragma unroll
            for (int h_ = 0; h_ < 2; ++h_)
#pragma unroll
                for (int i_ = 0; i_ < 2; ++i_) vo2[h_][i_] = GATHER ? (last ? gn[h_][i_] : gv[h_][i_]) : 0u;
            PG8_LDB(B0, 0, 0); PG8_SCHED; PG8_LDA(At, 0, 0); PG8_STAGE_A(PG8_SA(1, 1), a1, 1, gv);
            PG8_WAIT_L(8); PG8_BAR; PG8_WAIT_L(0); PG8_MMA(0, 0, At, B0); PG8_BAR; PG8_SCHED;
            PG8_LDB(B1, 0, 1); PG8_STAGE(PG8_SB(0, 0), b2, voffB);
            PG8_BAR; PG8_WAIT_L(0); PG8_MMA(0, 1, At, B1); PG8_BAR;
            PG8_LDA(At, 0, 1); PG8_STAGE_A(PG8_SA(0, 0), a2, 0, vo2);
            PG8_BAR; PG8_WAIT_L(0); PG8_MMA(1, 0, At, B0); PG8_BAR; PG8_SCHED;
            PG8_STAGE(PG8_SB(0, 1), b2 + hstep, voffB);
            PG8_WAIT_V(6); PG8_BAR; PG8_MMA(1, 1, At, B1); PG8_BAR;
            PG8_LDB(B0, 1, 0); PG8_SCHED; PG8_LDA(At, 1, 0); PG8_STAGE_A(PG8_SA(0, 1), a2, 1, vo2);
            PG8_WAIT_L(8); PG8_BAR; PG8_WAIT_L(0); PG8_MMA(0, 0, At, B0); PG8_BAR; PG8_SCHED;
            PG8_LDB(B1, 1, 1); PG8_STAGE(PG8_SB(1, 0), b3, voffB);
            PG8_BAR; PG8_WAIT_L(0); PG8_MMA(0, 1, At, B1); PG8_BAR;
            PG8_LDA(At, 1, 1); PG8_STAGE_A(PG8_SA(1, 0), a3, 0, vo2);
            PG8_BAR; PG8_WAIT_L(0); PG8_MMA(1, 0, At, B0); PG8_BAR; PG8_SCHED;
            PG8_STAGE(PG8_SB(1, 1), b3 + hstep, voffB);
            PG8_WAIT_V(6); PG8_BAR; PG8_MMA(1, 1, At, B1); PG8_BAR;
        }
        E(acc, cur, wr, wc, fr, fq);
        if (!has_next) break;
#pragma unroll
        for (int a = 0; a < 2; ++a)
#pragma unroll
            for (int b = 0; b < 2; ++b)
#pragma unroll
                for (int m = 0; m < 4; ++m)
#pragma unroll
                    for (int n = 0; n < 2; ++n) acc[a][b][m][n] = (f32x4){0.f, 0.f, 0.f, 0.f};
        cur = nxt; cA = nA; cB = nB; ++ui;
        if (GATHER) {
#pragma unroll
            for (int h_ = 0; h_ < 2; ++h_)
#pragma unroll
                for (int i_ = 0; i_ < 2; ++i_) gv[h_][i_] = gn[h_][i_]; }
    }
    PG8_WAIT_V(0);
    if (wr == 0) PG8_BAR;
    PG8_BAR;
#undef PG8_SA
#undef PG8_SB
#undef PG8_STAGE
#undef PG8_STAGE_A
#undef PG8_GOFF
#undef PG8_LDA
#undef PG8_LDB
#undef PG8_MMA
#undef PG8_WAIT_V
#undef PG8_WAIT_L
#undef PG8_BAR
#undef PG8_SCHED
}

struct EpiBf16 {
    static constexpr bool PERM = true;
    bf16_t* O; int ldc;
    __device__ __forceinline__ void operator()(const f32x4 (&acc)[2][2][4][2], const Unit& u, int wr, int wc, int fr, int fq) const {
        const int row0 = u.pm * BM + wr * 64 + fr, col0 = u.pn * BM + wc * 32 + 8 * fq;
#pragma unroll
        for (int ai = 0; ai < 2; ++ai)
#pragma unroll
            for (int m = 0; m < 4; ++m) { bf16_t* rowp = O + (size_t)(row0 + ai * HALF + m * 16) * ldc + col0;
#pragma unroll
                for (int bj = 0; bj < 2; ++bj) { const f32x4 v0 = acc[ai][bj][m][0], v1 = acc[ai][bj][m][1];
                    u32x4 w; w.x = cvt_pk_bf16(v0[0], v0[1]); w.y = cvt_pk_bf16(v0[2], v0[3]); w.z = cvt_pk_bf16(v1[0], v1[1]); w.w = cvt_pk_bf16(v1[2], v1[3]);
                    st16_wt(rowp + bj * HALF, w); } }
    }
};
struct EpiResid {
    static constexpr bool PERM = false;
    const float* Cin; float* C; int ldc;
    __device__ __forceinline__ void operator()(const f32x4 (&acc)[2][2][4][2], const Unit& u, int wr, int wc, int fr_, int fq_) const {
        int fr = fr_, fq = fq_; asm volatile("" : "+v"(fr), "+v"(fq));
        const int row0 = u.pm * BM + wr * 64 + fr, col0 = u.pn * BM + wc * 32 + 4 * fq;
#pragma unroll
        for (int ai = 0; ai < 2; ++ai)
#pragma unroll
            for (int mp = 0; mp < 2; ++mp) { f32x4 cv[2][2][2];
#pragma unroll
                for (int mm = 0; mm < 2; ++mm) { const float* rowp = Cin + (size_t)(row0 + ai * HALF + (2 * mp + mm) * 16) * ldc + col0;
#pragma unroll
                    for (int bj = 0; bj < 2; ++bj)
#pragma unroll
                        for (int n = 0; n < 2; ++n) cv[mm][bj][n] = *(const f32x4*)(rowp + bj * HALF + n * 16); }
#pragma unroll
                for (int mm = 0; mm < 2; ++mm) { float* rowp = C + (size_t)(row0 + ai * HALF + (2 * mp + mm) * 16) * ldc + col0;
#pragma unroll
                    for (int bj = 0; bj < 2; ++bj)
#pragma unroll
                        for (int n = 0; n < 2; ++n) { const f32x4 o_ = cv[mm][bj][n] + acc[ai][bj][2 * mp + mm][n]; st16_wt(rowp + bj * HALF + n * 16, __builtin_bit_cast(u32x4, o_)); } }
                asm volatile("" ::: "memory"); }
    }
};
template <int ACT  > struct EpiGated {
    static constexpr bool PERM = true;
    bf16_t* O; int ldo; int coloff; const float* ba; const float* bb;
    __device__ __forceinline__ void operator()(const f32x4 (&acc)[2][2][4][2], const Unit& u, int wr, int wc, int fr, int fq) const {
        const int row0 = u.pm * BM + wr * 64 + fr, cl = u.pn * HALF + wc * 32 + 8 * fq;
        float va[8], vb[8];
#pragma unroll
        for (int j = 0; j < 8; ++j) { va[j] = (ACT == 0) ? ba[cl + j] : 0.f; vb[j] = (ACT == 0) ? bb[cl + j] : 0.f; }
#pragma unroll
        for (int ai = 0; ai < 2; ++ai)
#pragma unroll
            for (int m = 0; m < 4; ++m) { bf16_t* rowp = O + (size_t)(row0 + ai * HALF + m * 16) * ldo + coloff + cl;
                float o[8];
#pragma unroll
                for (int n = 0; n < 2; ++n)
#pragma unroll
                    for (int j = 0; j < 4; ++j) { const float a = acc[ai][0][m][n][j] + va[4 * n + j], b = acc[ai][1][m][n][j] + vb[4 * n + j];
                        o[4 * n + j] = (ACT == 0) ? a * sigmoidf_(b) : siluf_(a) * b; }
                u32x4 w; w.x = cvt_pk_bf16(o[0], o[1]); w.y = cvt_pk_bf16(o[2], o[3]); w.z = cvt_pk_bf16(o[4], o[5]); w.w = cvt_pk_bf16(o[6], o[7]);
                st16_wt(rowp, w); asm volatile("" ::: "memory"); }
    }
};
struct EpiMoeOut {
    static constexpr bool PERM = true;
    bf16_t* O; const int* row_tok; const float* row_w; LAS unsigned char* lds;
    __device__ __forceinline__ void operator()(const f32x4 (&acc)[2][2][4][2], const Unit& u, int wr, int wc, int fr_, int fq_) const {
        int fr = fr_, fq = fq_; asm volatile("" : "+v"(fr), "+v"(fq));
        const int col0 = u.pn * BM + wc * 32 + 8 * fq, lane = fq * 16 + fr;
        LAS u32x2* rinfo = (LAS u32x2*)(lds + STAGE_BYTES) + (wr * 4 + wc) * 128;
        { const int ra = u.pm * BM + wr * 64 + lane, rb = ra + HALF;
          const u32x2 ia = (u32x2){(unsigned)row_tok[ra], __float_as_uint(row_w[ra])}, ib = (u32x2){(unsigned)row_tok[rb], __float_as_uint(row_w[rb])};
          rinfo[lane] = ia; rinfo[64 + lane] = ib; }
#pragma unroll
        for (int ai = 0; ai < 2; ++ai)
#pragma unroll
            for (int m = 0; m < 4; ++m) { const u32x2 inf = rinfo[ai * 64 + m * 16 + fr]; const int ts = (int)inf.x; const float w = __uint_as_float(inf.y);
                if (ts >= 0) { bf16_t* rowp = O + ((size_t)(ts & 1) * NTOK + (size_t)(ts >> 1)) * DM + col0;
#pragma unroll
                    for (int bj = 0; bj < 2; ++bj) { const f32x4 v0 = acc[ai][bj][m][0] * w, v1 = acc[ai][bj][m][1] * w;
                        u32x4 q; q.x = cvt_pk_bf16(v0[0], v0[1]); q.y = cvt_pk_bf16(v0[2], v0[3]); q.z = cvt_pk_bf16(v1[0], v1[1]); q.w = cvt_pk_bf16(v1[2], v1[3]);
                        st16_wt(rowp + bj * HALF, q); } } }
    }
};
struct MoeOrder {
    int K; const char* A; const char* B; size_t bstride; const LAS int* list;
    static __device__ __forceinline__ void build(LAS int* list, const int* tiles, int nN, int G, int c) {
        const int nrt = tiles[0], nwg = nrt * nN; int n = 0;
        for (int i = 0; ; ++i) { const long L = (long)i * G + c; if (L >= (long)nwg || n >= 20) break;
            int wgid = (int)L; { const int q = nwg / NXCD, r = nwg % NXCD, xcd = wgid % NXCD, off = wgid / NXCD; wgid = (xcd < r ? xcd * (q + 1) : r * (q + 1) + (xcd - r) * q) + off; }
            const int pm = wgid / nN; list[1 + 3 * n] = pm; list[2 + 3 * n] = wgid % nN; list[3 + 3 * n] = tiles[64 + pm]; ++n; }
        list[0] = n;
    }
    __device__ bool next(int i, Unit& u) const {
        const int n = __builtin_amdgcn_readfirstlane(list[0]); if (i >= n) return false;
        u.pm = __builtin_amdgcn_readfirstlane(list[1 + 3 * i]); u.pn = __builtin_amdgcn_readfirstlane(list[2 + 3 * i]); const int e = __builtin_amdgcn_readfirstlane(list[3 + 3 * i]);
        u.a = A + (size_t)u.pm * 256 * K * 2; u.b = B + (size_t)e * bstride + (size_t)u.pn * 256 * K * 2; return true;
    }
};
}

struct Params { const float* in[44]; float* out; unsigned char* ws; int ph_lo, ph_hi; };
enum { I_X = 0, I_NORM1, I_WIN, I_MCONVW, I_MCONVB, I_MDTB, I_MALOG, I_MD, I_MNORM, I_RMU, I_RW0, I_RW2, I_RA0, I_RA2, I_RG2, I_RKK, I_RKA, I_RRK, I_RLNW, I_RLNB,
       I_CKVN, I_CWUK, I_CWUV, I_RELB, I_SARE, I_SAIM, I_SBRE, I_SBIM, I_SCRE, I_SCIM, I_SD, I_SLOGDT, I_SGLUW, I_SGLUB, I_WOUT, I_NORM2, I_WRG, I_BRG, I_WRE, I_BRE,
       I_WGATE, I_WUP, I_WDOWN, I_FNORM };

typedef const float* const __attribute__((address_space(4)))* in_tab_t;
struct Frame {
    LAS unsigned char* lds; int tid, lane, wave, bid, G;
    in_tab_t in; float* out; unsigned char* ws; unsigned* ctl;
    volatile LAS int* misc;
};

__device__ __forceinline__ int q_pop(Frame& F, int qi) {
    __syncthreads();
    if (F.tid == 0) F.misc[0] = (int)__hip_atomic_fetch_add(F.ctl + CW_Q + 64 * qi, 1u, __ATOMIC_RELAXED, __HIP_MEMORY_SCOPE_AGENT);
    __syncthreads();
    return F.misc[0];
}

__device__ __forceinline__ const void* opaque_ptr(const void* p) { const unsigned long long v = (unsigned long long)p; unsigned lo = __builtin_amdgcn_readfirstlane((unsigned)v), hi = __builtin_amdgcn_readfirstlane((unsigned)(v >> 32));
    asm volatile("" : "+s"(lo), "+s"(hi)); return (const void*)(((unsigned long long)hi << 32) | lo); }
__device__ __forceinline__ Frame relocal(const Frame& G) { Frame F = G; asm volatile("" : "+v"(F.tid)); F.ws = (unsigned char*)opaque_ptr(F.ws); F.ctl = (unsigned*)(F.ws + WS_CTL); F.in = (in_tab_t)(unsigned long long)opaque_ptr((const void*)(unsigned long long)F.in); F.lane = F.tid & 63; F.wave = __builtin_amdgcn_readfirstlane(F.tid >> 6); return F; }
template <int K> __device__ __forceinline__ f32x4 mma_nt(const LAS bf16_t* A, int lda, const LAS bf16_t* Bt, int ldb, f32x4 acc, int lane) {
    const int r = lane & 15, g = lane >> 4;
#pragma unroll
    for (int k0 = 0; k0 < K; k0 += 32) {
        const bf16x8 a = *(const LAS bf16x8*)(A + r * lda + k0 + 8 * g);
        const bf16x8 b = *(const LAS bf16x8*)(Bt + r * ldb + k0 + 8 * g);
        acc = __builtin_amdgcn_mfma_f32_16x16x32_bf16(a, b, acc, 0, 0, 0);
    }
    return acc;
}

template <class SrcMap> __device__ __forceinline__ void tr_tile(Frame& F, int ldsrc, bf16_t* dst, int K, int k0, int n0, SrcMap sm) {
    LAS float* tile = (LAS float*)F.lds;
    __syncthreads();
    { const int n4 = (F.tid & 63) * 4, kk = F.tid >> 6; const float* sp = sm(n0 + n4);
      f32x4 v[8];
#pragma unroll
      for (int ps = 0; ps < 8; ++ps) { v[ps] = (f32x4){0.f, 0.f, 0.f, 0.f}; if (sp) v[ps] = __builtin_nontemporal_load((const f32x4*)(sp + (size_t)(k0 + kk + 8 * ps) * ldsrc)); }
#pragma unroll
      for (int ps = 0; ps < 8; ++ps) { LAS float* t = tile + (kk + 8 * ps) * 257 + n4; t[0] = v[ps][0]; t[1] = v[ps][1]; t[2] = v[ps][2]; t[3] = v[ps][3]; } }
    __syncthreads();
    { const int kc = F.tid & 7;
#pragma unroll
      for (int j = 0; j < 4; ++j) { const int n = (F.tid >> 3) + 64 * j; float f[8];
#pragma unroll
          for (int i = 0; i < 8; ++i) f[i] = tile[(8 * kc + i) * 257 + n];
          u32x4 w; w.x = pk2(f[0], f[1]); w.y = pk2(f[2], f[3]); w.z = pk2(f[4], f[5]); w.w = pk2(f[6], f[7]);
          *(u32x4*)(dst + (size_t)(n0 + n) * K + k0 + 8 * kc) = w; } }
}

struct SmIn { const float* base; __device__ __forceinline__ const float* operator()(int n) const {
    int c; if (n < 772) c = n; else if (n < UR) return nullptr; else if (n < UR + 896) c = 772 + (n - UR); else if (n < UC) return nullptr;
    else if (n < UC + 680) c = 1668 + (n - UC); else if (n < US) return nullptr; else if (n < US + 256) c = 2348 + (n - US); else return nullptr; return base + c; } };
struct SmId { const float* base; __device__ __forceinline__ const float* operator()(int n) const { return base + n; } };
struct SmGlu { const float* base; __device__ __forceinline__ const float* operator()(int n) const { const int pn = n >> 8, rr = n & 255; return base + (rr < 128 ? 128 * pn + rr : 256 + 128 * pn + (rr - 128)); } };
struct SmGU { const float* gate; const float* up; __device__ __forceinline__ const float* operator()(int n) const {
    const unsigned long long d = (unsigned long long)up - (unsigned long long)gate; const unsigned long long a = (unsigned long long)gate + (((n & 255) < 128) ? 0ull : d); return (const float*)a + 128 * (n >> 8) + (n & 127); } };
__device__ __forceinline__ void phase_prologue(const Frame& F_) { Frame F = relocal(F_);
    for (int t = F.bid; t < 496; t += F.G) {
        if (t < 352) { const int l = t / 176, r = t % 176, kt = r / 11, nt = r % 11;
            tr_tile(F, NIN, (bf16_t*)(F.ws + WS_WIN) + (size_t)l * NINP * DM, DM, kt * 64, nt * 256, SmIn{F.in[I_WIN] + (size_t)l * DM * NIN}); }
        else if (t < 480) { const int q = t - 352, l = q / 64, r = q % 64, kt = r / 4, nt = r % 4;
            tr_tile(F, DM, (bf16_t*)(F.ws + WS_WOUT) + (size_t)l * DM * DM, DM, kt * 64, nt * 256, SmId{F.in[I_WOUT] + (size_t)l * DM * DM}); }
        else { const int q = t - 480, l = q / 8, r = q % 8, kt = r / 2, nt = r % 2;
            tr_tile(F, 512, (bf16_t*)(F.ws + WS_GLU) + (size_t)l * 512 * 256, 256, kt * 64, nt * 256, SmGlu{F.in[I_SGLUW] + (size_t)l * 256 * 512}); }
    }
    for (int i = F.bid * NTHR + F.tid; i < 2 * 48 * 1024; i += F.G * NTHR) { const int l = i / 49152, r = i % 49152, o = r >> 10, k = r & 1023;
        float v = 0.f; if (o < 32) v = F.in[I_WRE][((size_t)l * DM + k) * 32 + o]; else if (o < 36) v = F.in[I_WRG][((size_t)l * DM + k) * 4 + (o - 32)];
        v *= F.in[I_NORM2][l * DM + k];
        const bf16_t hi = f2bf(v); const bf16_t lo = f2bf(v - bf2f(hi));
        bf16_t* w = (bf16_t*)(F.ws + WS_WRT) + (size_t)l * 2 * 49152; w[r] = hi; w[49152 + r] = lo; }
    for (int i = F.bid * NTHR + F.tid; i < 2048 + 65536; i += F.G * NTHR) {
        if (i < 2048) {
            const int l = i >> 10, gn = i & 1023, g = gn >> 6;
            float* tab = (float*)(F.ws + WS_S5TAB + (size_t)l * S5TAB_L);
            const float lre = fminf(F.in[I_SARE][l * 1024 + gn], -1e-4f), lim = F.in[I_SAIM][l * 1024 + gn];
            const float dt = expf(F.in[I_SLOGDT][l * 16 + g]);
            const float mag = expf(dt * lre); float sn, cs; sincosf(dt * lim, &sn, &cs);
            const float are = mag * cs, aim = mag * sn;
            const float den = lre * lre + lim * lim;
            const float fre = ((are - 1.0f) * lre + aim * lim) / den, fim = (aim * lre - (are - 1.0f) * lim) / den;
            tab[gn * 2] = are; tab[gn * 2 + 1] = aim;
            float pr = are, pi = aim;
#pragma unroll
            for (int s = 0; s < 6; ++s) { const float nr = pr * pr - pi * pi, ni = 2.0f * pr * pi; pr = nr; pi = ni; }
            tab[2048 + gn * 2] = pr; tab[2048 + gn * 2 + 1] = pi;
            const float* bre = F.in[I_SBRE] + ((size_t)l * 1024 + gn) * 16; const float* bim = F.in[I_SBIM] + ((size_t)l * 1024 + gn) * 16;
            bf16_t* bbt = (bf16_t*)(F.ws + WS_S5TAB + (size_t)l * S5TAB_L + S5TAB_BBT); const int n = gn & 63, col = 4 * (n & 31) + 2 * (n >> 5);
            for (int p = 0; p < 16; ++p) { const float vr = fre * bre[p] - fim * bim[p], vi = fre * bim[p] + fim * bre[p];
                bbt[((size_t)g * 128 + col) * 16 + p] = f2bf(vr); bbt[((size_t)g * 128 + col + 1) * 16 + p] = f2bf(vi); }
        } else {
            const int j = i - 2048, l = j >> 15, r = j & 32767, gp = r >> 7, k = r & 127;
            bf16_t* cm = (bf16_t*)(F.ws + WS_S5TAB + (size_t)l * S5TAB_L + S5TAB_F);
            const int n = (k >> 2) + 32 * ((k >> 1) & 1);
            const float v = (k & 1) == 0 ? F.in[I_SCRE][((size_t)l * 256 + gp) * 64 + n] : -F.in[I_SCIM][((size_t)l * 256 + gp) * 64 + n];
            cm[r] = f2bf(v);
        }
    }
}

__device__ __forceinline__ void phase_norm(const Frame& F_, const float* xin, bool add_o, const float* w, int mode) { Frame F = relocal(F_);
    float* X = (float*)(F.ws + WS_X); bf16_t* H = (bf16_t*)(F.ws + WS_H); const bf16_t* O = (const bf16_t*)(F.ws + WS_U);
    for (int row0 = F.bid * 32 + F.wave * 4; row0 < NTOK; row0 += F.G * 32) {
        f32x4 v[4][4]; u32x2 oa[4][4], ob[4][4];
#pragma unroll
        for (int r = 0; r < 4; ++r)
#pragma unroll
            for (int j = 0; j < 4; ++j) { const int c = 4 * F.lane + 256 * j; const size_t o = (size_t)(row0 + r) * DM + c; v[r][j] = (mode == 2) ? __builtin_nontemporal_load((const f32x4*)(xin + o)) : *(const f32x4*)(xin + o);
                if (add_o) { oa[r][j] = __builtin_nontemporal_load((const u32x2*)(O + o)); ob[r][j] = __builtin_nontemporal_load((const u32x2*)(O + (size_t)NTOK * DM + o)); } }
#pragma unroll
        for (int r = 0; r < 4; ++r) { const int row = row0 + r; float ss = 0.f;
#pragma unroll
            for (int j = 0; j < 4; ++j) {
                if (add_o) { const u32x2 a = oa[r][j], b = ob[r][j];
                    v[r][j][0] += __uint_as_float(a.x << 16) + __uint_as_float(b.x << 16); v[r][j][1] += __uint_as_float(a.x & 0xffff0000u) + __uint_as_float(b.x & 0xffff0000u);
                    v[r][j][2] += __uint_as_float(a.y << 16) + __uint_as_float(b.y << 16); v[r][j][3] += __uint_as_float(a.y & 0xffff0000u) + __uint_as_float(b.y & 0xffff0000u); }
                ss += v[r][j][0] * v[r][j][0] + v[r][j][1] * v[r][j][1] + v[r][j][2] * v[r][j][2] + v[r][j][3] * v[r][j][3]; }
            ss = wave_sum(ss);
            const float rstd = rsqrtf(ss * (1.0f / DM) + 1e-6f);
#pragma unroll
            for (int j = 0; j < 4; ++j) { const int c = 4 * F.lane + 256 * j; const f32x4 wv = *(const f32x4*)(w + c);
                if (mode == 2) { __builtin_nontemporal_store(v[r][j] * rstd * wv, (f32x4*)(F.out + (size_t)row * DM + c)); }
                else { if (mode == 0) *(f32x4*)(X + (size_t)row * DM + c) = v[r][j];
                    u32x2 o; o.x = pk2(v[r][j][0] * rstd * wv[0], v[r][j][1] * rstd * wv[1]); o.y = pk2(v[r][j][2] * rstd * wv[2], v[r][j][3] * rstd * wv[3]);
                    *(u32x2*)(H + (size_t)row * DM + c) = o; } } }
    }
}

__device__ __forceinline__ void item_kv(const Frame& F_, int layer, int item) { Frame F = relocal(F_);
    const bf16_t* U = (const bf16_t*)(F.ws + WS_U);
    LAS bf16_t* Ab = (LAS bf16_t*)F.lds;
    LAS bf16_t* Bt = (LAS bf16_t*)(F.lds + 17408);
    const int t0 = item * 64;
    { const int tok = F.tid >> 3, part = F.tid & 7; const bf16_t* src = U + (size_t)(t0 + tok) * NINP + UC + 256 + 16 * part;
      float f[16]; { float a[8], b[8]; unpack8(*(const u32x4*)src, a); unpack8(*(const u32x4*)(src + 8), b);
#pragma unroll
        for (int j = 0; j < 8; ++j) { f[j] = a[j]; f[8 + j] = b[j]; } }
      float ss = 0.f;
#pragma unroll
      for (int j = 0; j < 16; ++j) ss += f[j] * f[j];
      ss = sum8(ss);
      const float rstd = rsqrtf(ss * (1.0f / 128.0f) + 1e-6f); const float* nw = F.in[I_CKVN] + layer * 128 + 16 * part;
#pragma unroll
      for (int j = 0; j < 16; j += 2) *(LAS unsigned*)(Ab + tok * 136 + 16 * part + j) = pk2(f[j] * rstd * nw[j], f[j + 1] * rstd * nw[j + 1]); }
    { const int n = F.tid >> 2, kq = F.tid & 3; const float* w = (n < 64 ? F.in[I_CWUK] : F.in[I_CWUV]) + (size_t)layer * 128 * 64 + (n & 63);
      float wv[32];
#pragma unroll
      for (int k = 0; k < 32; ++k) wv[k] = w[(size_t)(32 * kq + k) * 64];
#pragma unroll
      for (int k = 0; k < 32; k += 2) *(LAS unsigned*)(Bt + n * 136 + 32 * kq + k) = pk2(wv[k], wv[k + 1]); }
    if (F.tid < 256) { const int tok = F.tid >> 2, q = F.tid & 3;
        *(u32x4*)((bf16_t*)(F.ws + WS_KIDX) + (size_t)(t0 + tok) * 32 + 8 * q) = *(const u32x4*)(U + (size_t)(t0 + tok) * NINP + UC + 640 + 8 * q); }
    __syncthreads();
    const int mt = F.wave & 3, g = F.lane >> 4, r = F.lane & 15;
#pragma unroll
    for (int q = 0; q < 4; ++q) { const int nt = (F.wave >> 2) * 4 + q;
        f32x4 acc = (f32x4){0.f, 0.f, 0.f, 0.f};
        acc = mma_nt<128>(Bt + nt * 16 * 136, 136, Ab + mt * 16 * 136, 136, acc, F.lane);
        const int n0 = nt * 16 + 4 * g; bf16_t* dst = (bf16_t*)(F.ws + WS_K) + (size_t)(n0 >> 6) * ((WS_V - WS_K) / 2);
        *(u32x2*)(dst + (size_t)(t0 + mt * 16 + r) * 64 + (n0 & 63)) = (u32x2){pk2(acc[0], acc[1]), pk2(acc[2], acc[3])}; }
}

constexpr int MB_CG = 0, MB_BG = 18432, MB_XT = 36864, MB_BT = 73728, MB_M = 73728, MB_S0 = 110592, MB_DT = 147456, MB_AC = 148480, MB_RS = 149504;
static_assert(MB_RS + 256 <= MISC_OFF && MB_BT == MB_XT + 4 * 64 * 72 * 2, "mamba LDS");
template <int STAGE> __device__ __forceinline__ void item_mamba(const Frame& F_, int layer, int item) { Frame F = relocal(F_);
    const bf16_t* U = (const bf16_t*)(F.ws + WS_U);
    const int b = item >> 6, c = item & 63, l0 = c * 64; const size_t T0 = (size_t)b * SEQ + l0;
    LAS bf16_t* Cg = (LAS bf16_t*)(F.lds + MB_CG); LAS bf16_t* Bg = (LAS bf16_t*)(F.lds + MB_BG); LAS bf16_t* BT = (LAS bf16_t*)(F.lds + MB_BT);
    LAS bf16_t* XT = (LAS bf16_t*)(F.lds + MB_XT); LAS bf16_t* Mb = (LAS bf16_t*)(F.lds + MB_M); LAS bf16_t* S0 = (LAS bf16_t*)(F.lds + MB_S0);
    LAS float* dts = (LAS float*)(F.lds + MB_DT); LAS float* acs = (LAS float*)(F.lds + MB_AC); LAS float* rs = (LAS float*)(F.lds + MB_RS);
    const int tg = F.tid & 7, c0 = (F.tid >> 3) * 8;
    const bool conv_on = (STAGE == 2) || (F.wave < 6);
    u32x4 rows[11]; float wv[4][8], bv[8];
    if (conv_on) {
#pragma unroll
        for (int k = 0; k < 11; ++k) { const int l = l0 + tg * 8 - 3 + k;
            if (l >= 0) rows[k] = *(const u32x4*)(U + ((size_t)b * SEQ + l) * NINP + UM + 256 + c0); else rows[k] = (u32x4){0u, 0u, 0u, 0u}; }
#pragma unroll
        for (int j = 0; j < 8; ++j) { bv[j] = F.in[I_MCONVB][layer * 512 + c0 + j];
#pragma unroll
            for (int k = 0; k < 4; ++k) wv[k][j] = F.in[I_MCONVW][(layer * 4 + k) * 512 + c0 + j]; } }
    const float* MSTi = (const float*)(F.ws + WS_MST) + ((size_t)(b * 64 + c) * 4) * 4096;
    f32x4 s0a[4], s0b[4];
    if (STAGE == 2) {
#pragma unroll
        for (int h = 0; h < 4; ++h) { const float* src = MSTi + (size_t)h * 4096 + F.tid * 8; s0a[h] = *(const f32x4*)src; s0b[h] = *(const f32x4*)(src + 4); } }
    if (F.wave < 4) { const int l = F.lane, h = F.wave;
        const float raw = bf2f(U[(T0 + l) * NINP + UM + 768 + h]) + F.in[I_MDTB][layer * 4 + h];
        const float dt = softplusf_(raw); const float cum = wave_prefix_f(-__expf(F.in[I_MALOG][layer * 4 + h]) * dt);
        dts[l * 4 + h] = dt; acs[l * 4 + h] = cum; }
    if (STAGE == 2) { if (F.tid < 64) rs[F.tid] = 0.f;
#pragma unroll
        for (int h = 0; h < 4; ++h) { u32x4 w; w.x = pk2(s0a[h][0], s0a[h][1]); w.y = pk2(s0a[h][2], s0a[h][3]); w.z = pk2(s0b[h][0], s0b[h][1]); w.w = pk2(s0b[h][2], s0b[h][3]);
            *(LAS u32x4*)(S0 + (h * 64 + (F.tid >> 3)) * 72 + (F.tid & 7) * 8) = w; } }
    __syncthreads();
    if (conv_on) {
        float win[3][8]; unpack8(rows[0], win[0]); unpack8(rows[1], win[1]); unpack8(rows[2], win[2]);
        const bool isx = F.wave < 4, tr = isx || STAGE == 1;
        unsigned pkT[8][4]; float prev[8];
#pragma unroll
        for (int i = 0; i < 8; ++i) { const int l = tg * 8 + i; float cur[8]; unpack8(rows[3 + i], cur);
            float o[8];
#pragma unroll
            for (int j = 0; j < 8; ++j) { o[j] = siluf_(bv[j] + wv[0][j] * win[0][j] + wv[1][j] * win[1][j] + wv[2][j] * win[2][j] + wv[3][j] * cur[j]);
                win[0][j] = win[1][j]; win[1][j] = win[2][j]; win[2][j] = cur[j]; }
            if (isx) { const int h = F.wave; float sc = dts[l * 4 + h]; if (STAGE == 1) sc *= __expf(acs[63 * 4 + h] - acs[l * 4 + h]);
#pragma unroll
                for (int j = 0; j < 8; ++j) o[j] *= sc; }
            if (tr) {
#pragma unroll
                for (int j = 0; j < 8; ++j) { if (i & 1) pkT[j][i >> 1] = pk2(prev[j], o[j]); else prev[j] = o[j]; } }
            else { u32x4 w; w.x = pk2(o[0], o[1]); w.y = pk2(o[2], o[3]); w.z = pk2(o[4], o[5]); w.w = pk2(o[6], o[7]);
                *(LAS u32x4*)(Cg + (F.wave < 6 ? (MB_BG - MB_CG) / 2 : 0) + ((F.wave & 1) * 64 + l) * 72 + (c0 & 63)) = w; } }
        if (tr) { LAS bf16_t* dstT = XT + F.wave * 64 * 72;
#pragma unroll
            for (int j = 0; j < 8; ++j) *(LAS u32x4*)(dstT + ((c0 & 63) + j) * 72 + tg * 8) = (u32x4){pkT[j][0], pkT[j][1], pkT[j][2], pkT[j][3]}; } }
    const int g4 = F.lane >> 4, r16 = F.lane & 15;
    if (STAGE == 1) {
        __syncthreads();
        float* MST = (float*)(F.ws + WS_MST) + ((size_t)(b * 64 + c) * 4) * 4096;
#pragma unroll
        for (int q = 0; q < 8; ++q) { const int tix = F.wave * 8 + q, h = tix >> 4, mt = (tix >> 2) & 3, nt = tix & 3;
            f32x4 acc = (f32x4){0.f, 0.f, 0.f, 0.f};
            acc = mma_nt<64>(BT + ((h >> 1) * 64 + nt * 16) * 72, 72, XT + (h * 64 + mt * 16) * 72, 72, acc, F.lane);
            *(f32x4*)(MST + (size_t)h * 4096 + (mt * 16 + r16) * 64 + nt * 16 + 4 * g4) = acc; }
        if (F.tid < 4) ((float*)(F.ws + WS_MDEC))[(b * 64 + c) * 4 + F.tid] = __expf(acs[63 * 4 + F.tid]);
    } else {
        const int mt = F.wave & 3, nh = F.wave >> 2;
        const int l = mt * 16 + r16;
        u32x2 zz[4][2];
#pragma unroll
        for (int h = 0; h < 4; ++h)
#pragma unroll
            for (int q = 0; q < 2; ++q) zz[h][q] = *(const u32x2*)(U + (T0 + l) * NINP + UM + h * 64 + (2 * nh + q) * 16 + 4 * g4);
        __syncthreads();
        f32x4 yv[4][2];
#pragma unroll
        for (int g = 0; g < 2; ++g)
#pragma unroll
            for (int q = 0; q < 2; ++q) { f32x4 G = (f32x4){0.f, 0.f, 0.f, 0.f};
                G = mma_nt<64>(Bg + (g * 64 + (2 * nh + q) * 16) * 72, 72, Cg + (g * 64 + mt * 16) * 72, 72, G, F.lane);
                const int s0 = (2 * nh + q) * 16 + 4 * g4;
#pragma unroll
                for (int hh = 0; hh < 2; ++hh) { const int h = 2 * g + hh; const float al = acs[l * 4 + h]; float v[4];
#pragma unroll
                    for (int i = 0; i < 4; ++i) v[i] = (s0 + i <= l) ? G[i] * __expf(al - acs[(s0 + i) * 4 + h]) : 0.f;
                    *(LAS u32x2*)(Mb + (h * 64 + l) * 72 + s0) = (u32x2){pk2(v[0], v[1]), pk2(v[2], v[3])}; } }
        __syncthreads();
#pragma unroll
        for (int h = 0; h < 4; ++h) { const int g = h >> 1; const float eal = __expf(acs[l * 4 + h]), idt = 1.0f / dts[l * 4 + h], dsk = F.in[I_MD][layer * 4 + h];
#pragma unroll
            for (int q = 0; q < 2; ++q) { const int nt = 2 * nh + q;
                f32x4 yd = (f32x4){0.f, 0.f, 0.f, 0.f}, yo = (f32x4){0.f, 0.f, 0.f, 0.f};
                yd = mma_nt<64>(XT + (h * 64 + nt * 16) * 72, 72, Mb + (h * 64 + mt * 16) * 72, 72, yd, F.lane);
                yo = mma_nt<64>(S0 + (h * 64 + nt * 16) * 72, 72, Cg + (g * 64 + mt * 16) * 72, 72, yo, F.lane);
#pragma unroll
                for (int i = 0; i < 4; ++i) { const int p = nt * 16 + 4 * g4 + i;
                    const float xs = bf2f(XT[(h * 64 + p) * 72 + l]) * idt;
                    yv[h][q][i] = yd[i] + yo[i] * eal + dsk * xs; } } }
        float part = 0.f;
#pragma unroll
        for (int h = 0; h < 4; ++h)
#pragma unroll
            for (int q = 0; q < 2; ++q) { const float z4[4] = {__uint_as_float(zz[h][q].x << 16), __uint_as_float(zz[h][q].x & 0xffff0000u), __uint_as_float(zz[h][q].y << 16), __uint_as_float(zz[h][q].y & 0xffff0000u)};
#pragma unroll
                for (int i = 0; i < 4; ++i) { const float v = yv[h][q][i] * siluf_(z4[i]); yv[h][q][i] = v; part += v * v; } }
        f32x4 nw[4][2];
#pragma unroll
        for (int h = 0; h < 4; ++h)
#pragma unroll
            for (int q = 0; q < 2; ++q) nw[h][q] = *(const f32x4*)(F.in[I_MNORM] + layer * 256 + h * 64 + (2 * nh + q) * 16 + 4 * g4);
        part = xrows(part, OpAdd());
        if (g4 == 0) atomicAdd((float*)(rs + l), part);
        __syncthreads();
        bf16_t* Y = (bf16_t*)(F.ws + WS_H);
        const float rstd = rsqrtf(rs[l] * (1.0f / 256.0f) + 1e-6f);
#pragma unroll
        for (int h = 0; h < 4; ++h)
#pragma unroll
            for (int q = 0; q < 2; ++q) { const f32x4 o = yv[h][q] * rstd * nw[h][q];
                *(u32x2*)(Y + (T0 + l) * DM + h * 64 + (2 * nh + q) * 16 + 4 * g4) = (u32x2){pk2(o[0], o[1]), pk2(o[2], o[3])}; }
    }
}
__device__ __forceinline__ void item_mamba_carry(const Frame& F_, int item) { Frame F = relocal(F_);
    const int b = item >> 2, h = item & 3;
    float* MST = (float*)(F.ws + WS_MST); const float* MD = (const float*)(F.ws + WS_MDEC);
    float s[8];
#pragma unroll
    for (int j = 0; j < 8; ++j) s[j] = 0.f;
    for (int c = 0; c < 64; ++c) { float* p = MST + ((size_t)(b * 64 + c) * 4 + h) * 4096 + F.tid * 8; const float d = MD[(b * 64 + c) * 4 + h];
        const f32x4 a = *(f32x4*)p, q = *(f32x4*)(p + 4);
        *(f32x4*)p = (f32x4){s[0], s[1], s[2], s[3]}; *(f32x4*)(p + 4) = (f32x4){s[4], s[5], s[6], s[7]};
        s[0] = s[0] * d + a[0]; s[1] = s[1] * d + a[1]; s[2] = s[2] * d + a[2]; s[3] = s[3] * d + a[3];
        s[4] = s[4] * d + q[0]; s[5] = s[5] * d + q[1]; s[6] = s[6] * d + q[2]; s[7] = s[7] * d + q[3]; }
}

template <int STAGE> __device__ __forceinline__ void item_s5(const Frame& F_, int layer, int item) { Frame F = relocal(F_);
    const bf16_t* U = (const bf16_t*)(F.ws + WS_U);
    const int b = item >> 6, c = item & 63; const size_t T0 = (size_t)b * SEQ + c * 64;
    LAS bf16_t* us = (LAS bf16_t*)F.lds;
    LAS bf16_t* BuW = (LAS bf16_t*)(F.lds + 33792) + F.wave * 4224;
    const float* tab = (const float*)(F.ws + WS_S5TAB + (size_t)layer * S5TAB_L);
    { const int tok = F.tid >> 3, part = F.tid & 7;
#pragma unroll
      for (int q = 0; q < 4; ++q) *(LAS u32x4*)(us + tok * 264 + 32 * part + 8 * q) = *(const u32x4*)(U + (T0 + tok) * NINP + US + 32 * part + 8 * q); }
    const int lane = F.lane, r16 = lane & 15, g4 = lane >> 4, gq = lane >> 5, n0 = lane & 31, g = 2 * F.wave + gq, gn0 = g * 64 + n0, gn1 = gn0 + 32;
    bf16x8 bfr[2][8];
    { const bf16_t* bbt = (const bf16_t*)(F.ws + WS_S5TAB + (size_t)layer * S5TAB_L + S5TAB_BBT);
#pragma unroll
      for (int gg = 0; gg < 2; ++gg)
#pragma unroll
          for (int nt = 0; nt < 8; ++nt) { u32x4 z = (u32x4){0u, 0u, 0u, 0u}; if (g4 < 2) z = *(const u32x4*)(bbt + ((size_t)(2 * F.wave + gg) * 128 + 16 * nt + r16) * 16 + 8 * g4); bfr[gg][nt] = __builtin_bit_cast(bf16x8, z); } }
    const float a0r = tab[gn0 * 2], a0i = tab[gn0 * 2 + 1], a1r = tab[gn1 * 2], a1i = tab[gn1 * 2 + 1];
    float* ST = (float*)(F.ws + WS_S5ST) + (size_t)(b * 64 + c) * 2048;
    float h0r = 0.f, h0i = 0.f, h1r = 0.f, h1i = 0.f;
    if (STAGE == 2) { h0r = ST[gn0 * 2]; h0i = ST[gn0 * 2 + 1]; h1r = ST[gn1 * 2]; h1i = ST[gn1 * 2 + 1]; }
    bf16x8 cf[2][4];
    if (STAGE == 2) { const bf16_t* cm = (const bf16_t*)(F.ws + WS_S5TAB + (size_t)layer * S5TAB_L + S5TAB_F);
#pragma unroll
        for (int gg = 0; gg < 2; ++gg)
#pragma unroll
            for (int ks = 0; ks < 4; ++ks) cf[gg][ks] = *(const bf16x8*)(cm + ((size_t)((2 * F.wave + gg) * 16 + r16)) * 128 + 32 * ks + 8 * g4); }
    LAS bf16_t* YSl = (LAS bf16_t*)(F.lds + 101376);
    const bf16_t* GW = (const bf16_t*)(F.ws + WS_GLU) + (size_t)layer * 512 * 256;
    f32x4 dsk[2], bvl[2], bgt[2]; bf16x8 gwb[2][4];
    if (STAGE == 2) {
#pragma unroll
        for (int gg = 0; gg < 2; ++gg) dsk[gg] = *(const f32x4*)(F.in[I_SD] + layer * 256 + (2 * F.wave + gg) * 16 + 4 * g4);
#pragma unroll
        for (int q = 0; q < 2; ++q) { const int c0 = 32 * F.wave + 16 * q + 4 * g4; bvl[q] = *(const f32x4*)(F.in[I_SGLUB] + layer * 512 + c0); bgt[q] = *(const f32x4*)(F.in[I_SGLUB] + layer * 512 + 256 + c0); }
#pragma unroll
        for (int ks = 0; ks < 2; ++ks)
#pragma unroll
            for (int q = 0; q < 2; ++q) { const int c = 32 * F.wave + 16 * q + r16; const int rowv = 256 * (c >> 7) + (c & 127);
                gwb[ks][2 * q] = *(const bf16x8*)(GW + (size_t)rowv * 256 + 32 * ks + 8 * g4); gwb[ks][2 * q + 1] = *(const bf16x8*)(GW + (size_t)(rowv + 128) * 256 + 32 * ks + 8 * g4); } }
    __syncthreads();
#pragma unroll 1
    for (int lb = 0; lb < 4; ++lb) {
#pragma unroll
        for (int gg = 0; gg < 2; ++gg) { u32x4 z = (u32x4){0u, 0u, 0u, 0u}; if (g4 < 2) z = *(const LAS u32x4*)(us + (16 * lb + r16) * 264 + (2 * F.wave + gg) * 16 + 8 * g4);
            const bf16x8 afr = __builtin_bit_cast(bf16x8, z);
#pragma unroll
            for (int nt = 0; nt < 8; ++nt) { const f32x4 acc = __builtin_amdgcn_mfma_f32_16x16x32_bf16(bfr[gg][nt], afr, (f32x4){0.f, 0.f, 0.f, 0.f}, 0, 0, 0);
                *(LAS u32x2*)(BuW + r16 * 264 + gg * 128 + 16 * nt + 4 * g4) = (u32x2){pk2(acc[0], acc[1]), pk2(acc[2], acc[3])}; } }
        __syncthreads();
#pragma unroll 4
        for (int li = 0; li < 16; ++li) { LAS u32x2* bp = (LAS u32x2*)(BuW + li * 264 + gq * 128 + 4 * n0); const u32x2 v = *bp;
            { const float br = __uint_as_float(v.x << 16), bi = __uint_as_float(v.x & 0xffff0000u); const float nr = a0r * h0r - a0i * h0i + br, ni = a0r * h0i + a0i * h0r + bi; h0r = nr; h0i = ni; }
            { const float br = __uint_as_float(v.y << 16), bi = __uint_as_float(v.y & 0xffff0000u); const float nr = a1r * h1r - a1i * h1i + br, ni = a1r * h1i + a1i * h1r + bi; h1r = nr; h1i = ni; }
            if (STAGE == 2) *bp = (u32x2){pk2(h0r, h0i), pk2(h1r, h1i)}; }
        __syncthreads();
        if (STAGE == 2) {
#pragma unroll
            for (int gg = 0; gg < 2; ++gg) { f32x4 acc = (f32x4){0.f, 0.f, 0.f, 0.f};
#pragma unroll
                for (int ks = 0; ks < 4; ++ks) { const bf16x8 a = *(const LAS bf16x8*)(BuW + r16 * 264 + gg * 128 + 32 * ks + 8 * g4);
                    acc = __builtin_amdgcn_mfma_f32_16x16x32_bf16(cf[gg][ks], a, acc, 0, 0, 0); }
                const int ch0 = (2 * F.wave + gg) * 16 + 4 * g4, l = lb * 16 + r16; const u32x2 uw = *(const LAS u32x2*)(us + l * 264 + ch0);
                const float u4[4] = {__uint_as_float(uw.x << 16), __uint_as_float(uw.x & 0xffff0000u), __uint_as_float(uw.y << 16), __uint_as_float(uw.y & 0xffff0000u)}; float y[4];
#pragma unroll
                for (int i = 0; i < 4; ++i) y[i] = gelu_tanh(acc[i] + dsk[gg][i] * u4[i]);
                *(LAS u32x2*)(YSl + l * 264 + ch0) = (u32x2){pk2(y[0], y[1]), pk2(y[2], y[3])}; }
            __syncthreads();
        }
    }
    if (STAGE == 1) { ST[gn0 * 2] = h0r; ST[gn0 * 2 + 1] = h0i; ST[gn1 * 2] = h1r; ST[gn1 * 2 + 1] = h1i; }
    if (STAGE == 2) {
        f32x4 av[4][2], ag[4][2];
#pragma unroll
        for (int m = 0; m < 4; ++m)
#pragma unroll
            for (int q = 0; q < 2; ++q) { av[m][q] = (f32x4){0.f, 0.f, 0.f, 0.f}; ag[m][q] = (f32x4){0.f, 0.f, 0.f, 0.f}; }
#pragma unroll
        for (int ks = 0; ks < 8; ++ks) {
            bf16x8 af[4], bcur[4];
#pragma unroll
            for (int j = 0; j < 4; ++j) bcur[j] = gwb[ks & 1][j];
            if (ks + 2 < 8) {
#pragma unroll
                for (int q = 0; q < 2; ++q) { const int c = 32 * F.wave + 16 * q + r16; const int rowv = 256 * (c >> 7) + (c & 127);
                    gwb[ks & 1][2 * q] = *(const bf16x8*)(GW + (size_t)rowv * 256 + 32 * (ks + 2) + 8 * g4); gwb[ks & 1][2 * q + 1] = *(const bf16x8*)(GW + (size_t)(rowv + 128) * 256 + 32 * (ks + 2) + 8 * g4); } }
#pragma unroll
            for (int m = 0; m < 4; ++m) af[m] = *(const LAS bf16x8*)(YSl + (16 * m + r16) * 264 + 32 * ks + 8 * g4);
#pragma unroll
            for (int m = 0; m < 4; ++m)
#pragma unroll
                for (int q = 0; q < 2; ++q) { av[m][q] = __builtin_amdgcn_mfma_f32_16x16x32_bf16(bcur[2 * q], af[m], av[m][q], 0, 0, 0); ag[m][q] = __builtin_amdgcn_mfma_f32_16x16x32_bf16(bcur[2 * q + 1], af[m], ag[m][q], 0, 0, 0); }
        }
        bf16_t* Y = (bf16_t*)(F.ws + WS_H);
#pragma unroll
        for (int q = 0; q < 2; ++q) { const int c0 = 32 * F.wave + 16 * q + 4 * g4;
#pragma unroll
            for (int m = 0; m < 4; ++m) { float o[4];
#pragma unroll
                for (int i = 0; i < 4; ++i) o[i] = (av[m][q][i] + bvl[q][i]) * sigmoidf_(ag[m][q][i] + bgt[q][i]);
                *(u32x2*)(Y + (T0 + 16 * m + r16) * DM + 768 + c0) = (u32x2){pk2(o[0], o[1]), pk2(o[2], o[3])}; } }
    }
}
__device__ __forceinline__ void item_s5_carry(const Frame& F_, int layer, int b) { Frame F = relocal(F_);
    const float* tab = (const float*)(F.ws + WS_S5TAB + (size_t)layer * S5TAB_L) + 2048;
    float* ST = (float*)(F.ws + WS_S5ST) + (size_t)b * 64 * 2048;
#pragma unroll
    for (int q = 0; q < 2; ++q) { const int gn = F.tid + 512 * q; const float pr = tab[gn * 2], pi = tab[gn * 2 + 1]; float hr = 0.f, hi = 0.f;
        for (int c = 0; c < 64; ++c) { float* p = ST + (size_t)c * 2048 + gn * 2; const float tr = p[0], ti = p[1]; p[0] = hr; p[1] = hi;
            const float nr = pr * hr - pi * hi + tr, ni = pr * hi + pi * hr + ti; hr = nr; hi = ni; } }
}

constexpr int RB_LD = 72;
constexpr int RW_R = 0, RW_K = 16384, RW_V = 32768, RW_W = 49152, RW_A = 65536, RW_B = 81920;
constexpr int R3_G = 49152, R3_O = 65536, R3_TILES = 81920, R3_BON = 147456;
template <int STAGE> __device__ __forceinline__ void rwkv_prep(const Frame& F_, int layer, int b, int h, int c) { Frame F = relocal(F_);
    const bf16_t* U = (const bf16_t*)(F.ws + WS_U);
    const int l0 = c * 64; const size_t T0 = (size_t)b * SEQ + l0;
    LAS float* Rr = (LAS float*)(F.lds + RW_R); LAS float* Kk = (LAS float*)(F.lds + RW_K); LAS float* Vv = (LAS float*)(F.lds + RW_V); LAS float* Ww = (LAS float*)(F.lds + RW_W);
    LAS float* Aa = (LAS float*)(F.lds + (STAGE == 1 ? RW_A : R3_O)); LAS float* Bb = (LAS float*)(F.lds + RW_B); LAS float* Gg = (LAS float*)(F.lds + R3_G); LAS float* BON = (LAS float*)(F.lds + R3_BON);
    LAS bf16_t* TWb = (LAS bf16_t*)(F.lds + 98304); LAS bf16_t* DAb = (LAS bf16_t*)(F.lds + (STAGE == 1 ? 103424 : 118784)); LAS bf16_t* SGb = (LAS bf16_t*)(F.lds + 123904);
    LAS bf16_t* w2T = (LAS bf16_t*)(F.lds + 108544); LAS bf16_t* a2T = (LAS bf16_t*)(F.lds + (STAGE == 1 ? 113664 : 133120)); LAS bf16_t* g2T = (LAS bf16_t*)(F.lds + 138240);
    const float* mu = F.in[I_RMU] + layer * 896;
    float pw0[2] = {0.f, 0.f}, pa0[2] = {0.f, 0.f}; f32x4 pkkw[2], pkaw[2], prk[2];
    if (STAGE == 1) { const int cgl = layer * 256 + h * 64 + 8 * (F.tid & 7);
#pragma unroll
        for (int q = 0; q < 2; ++q) { pkkw[q] = *(const f32x4*)(F.in[I_RKK] + cgl + 4 * q); pkaw[q] = *(const f32x4*)(F.in[I_RKA] + cgl + 4 * q); prk[q] = *(const f32x4*)(F.in[I_RRK] + cgl + 4 * q); }
#pragma unroll
        for (int q = 0; q < 2; ++q) { const int cg = layer * 256 + h * 64 + 16 * (2 * (F.wave & 1) + q) + (F.lane & 15); pw0[q] = F.in[I_RW0][cg]; pa0[q] = F.in[I_RA0][cg]; } }
    { const int tok = F.tid >> 3, p8 = F.tid & 7; const bool first = (l0 + tok == 0);
      const bf16_t* cur = U + (T0 + tok) * NINP + UR; const bf16_t* prv = first ? cur : cur - NINP;
      const float pz = first ? 0.f : 1.f;
      u32x4 cw[3], pw[3]; u32x2 c1 = (u32x2){0u, 0u}, p1 = (u32x2){0u, 0u}, c2 = (u32x2){0u, 0u}, p2 = (u32x2){0u, 0u}; u32x4 c3 = (u32x4){0u, 0u, 0u, 0u}, p3 = (u32x4){0u, 0u, 0u, 0u};
#pragma unroll
      for (int sec = (STAGE == 1 ? 0 : 2); sec < 3; ++sec) { const int co = sec * 256 + h * 64 + 8 * p8; cw[sec] = *(const u32x4*)(cur + co); pw[sec] = *(const u32x4*)(prv + co); }
      if (STAGE == 1) { c1 = *(const u32x2*)(cur + 768 + 4 * p8); p1 = *(const u32x2*)(prv + 768 + 4 * p8); c2 = *(const u32x2*)(cur + 800 + 4 * p8); p2 = *(const u32x2*)(prv + 800 + 4 * p8); }
      if (STAGE == 3) { c3 = *(const u32x4*)(cur + 832 + 8 * p8); p3 = *(const u32x4*)(prv + 832 + 8 * p8); }
#pragma unroll
      for (int sec = (STAGE == 1 ? 0 : 2); sec < 3; ++sec) { const int co = sec * 256 + h * 64 + 8 * p8; float av[8], pq[8]; unpack8(cw[sec], av); unpack8(pw[sec], pq);
          const f32x4 m0 = *(const f32x4*)(mu + co), m1 = *(const f32x4*)(mu + co + 4);
          LAS float* dst = (sec == 0 ? Rr : sec == 1 ? Kk : Vv) + tok * 64 + 8 * p8;
#pragma unroll
          for (int j = 0; j < 8; ++j) pq[j] *= pz;
          *(LAS f32x4*)dst = (f32x4){av[0] + m0[0] * (pq[0] - av[0]), av[1] + m0[1] * (pq[1] - av[1]), av[2] + m0[2] * (pq[2] - av[2]), av[3] + m0[3] * (pq[3] - av[3])};
          *(LAS f32x4*)(dst + 4) = (f32x4){av[4] + m1[0] * (pq[4] - av[4]), av[5] + m1[1] * (pq[5] - av[5]), av[6] + m1[2] * (pq[6] - av[6]), av[7] + m1[3] * (pq[7] - av[7])}; }
      if (STAGE == 1) {
#pragma unroll
        for (int which = 0; which < 2; ++which) { const int co = 768 + 32 * which + 4 * p8; const u32x2 cv = which ? c2 : c1, pv = which ? p2 : p1;
          const f32x4 m0 = *(const f32x4*)(mu + co);
          float x[4] = {__uint_as_float(cv.x << 16), __uint_as_float(cv.x & 0xffff0000u), __uint_as_float(cv.y << 16), __uint_as_float(cv.y & 0xffff0000u)};
          const float y[4] = {pz * __uint_as_float(pv.x << 16), pz * __uint_as_float(pv.x & 0xffff0000u), pz * __uint_as_float(pv.y << 16), pz * __uint_as_float(pv.y & 0xffff0000u)};
#pragma unroll
          for (int j = 0; j < 4; ++j) { x[j] = x[j] + m0[j] * (y[j] - x[j]); if (which == 0) x[j] = tanhf_(x[j]); }
          *(LAS u32x2*)((which ? DAb : TWb) + tok * 40 + 4 * p8) = (u32x2){pk2(x[0], x[1]), pk2(x[2], x[3])}; } }
      if (STAGE == 3) { const int co = 832 + 8 * p8; float av[8], pq[8]; unpack8(c3, av); unpack8(p3, pq);
          const f32x4 m0 = *(const f32x4*)(mu + co), m1 = *(const f32x4*)(mu + co + 4); float x[8];
#pragma unroll
          for (int j = 0; j < 8; ++j) x[j] = sigmoidf_(av[j] + (j < 4 ? m0[j] : m1[j - 4]) * (pz * pq[j] - av[j]));
          *(LAS u32x4*)(SGb + tok * RB_LD + 8 * p8) = (u32x4){pk2(x[0], x[1]), pk2(x[2], x[3]), pk2(x[4], x[5]), pk2(x[6], x[7])}; } }
    { const int ch = F.tid & 63, part = F.tid >> 6;
      if (STAGE == 1) { const float* w2 = F.in[I_RW2] + ((size_t)layer * 32 + 4 * part) * 256 + h * 64 + ch;
          *(LAS u32x2*)(w2T + ch * 40 + 4 * part) = (u32x2){pk2(w2[0], w2[256]), pk2(w2[512], w2[768])}; }
      if (STAGE == 1) { const float* a2 = F.in[I_RA2] + ((size_t)layer * 32 + 4 * part) * 256 + h * 64 + ch;
          *(LAS u32x2*)(a2T + ch * 40 + 4 * part) = (u32x2){pk2(a2[0], a2[256]), pk2(a2[512], a2[768])}; }
      if (STAGE == 3) { const float* g2 = F.in[I_RG2] + ((size_t)layer * 64 + 8 * part) * 256 + h * 64 + ch;
          *(LAS u32x4*)(g2T + ch * RB_LD + 8 * part) = (u32x4){pk2(g2[0], g2[256]), pk2(g2[512], g2[768]), pk2(g2[1024], g2[1280]), pk2(g2[1536], g2[1792])}; } }
    __syncthreads();
    { const int lane = F.lane, mt = F.wave >> 1, nt0 = 2 * (F.wave & 1), r = lane & 15, g4 = lane >> 4; const f32x4 zero4 = (f32x4){0.f, 0.f, 0.f, 0.f};
#pragma unroll
      for (int q = 0; q < 2; ++q) { const int nt = nt0 + q, ch = 16 * nt + r;
          if (STAGE == 1) { const f32x4 wl = mma_nt<32>(TWb + 16 * mt * 40, 40, w2T + 16 * nt * 40, 40, zero4, lane); const float w0 = pw0[q];
#pragma unroll
              for (int i = 0; i < 4; ++i) { const float x = w0 + wl[i]; const float wlog = -__logf(1.0f + __expf(-x)) - 0.5f; Ww[(16 * mt + 4 * g4 + i) * 64 + ch] = __expf(-__expf(wlog)); } }
          if (STAGE == 1) { const f32x4 al = mma_nt<32>(DAb + 16 * mt * 40, 40, a2T + 16 * nt * 40, 40, zero4, lane); const float a0 = pa0[q];
#pragma unroll
              for (int i = 0; i < 4; ++i) Aa[(16 * mt + 4 * g4 + i) * 64 + ch] = sigmoidf_(a0 + al[i]); }
          if (STAGE == 3) { const f32x4 gv = mma_nt<64>(SGb + 16 * mt * RB_LD, RB_LD, g2T + 16 * nt * RB_LD, RB_LD, zero4, lane);
#pragma unroll
              for (int i = 0; i < 4; ++i) Gg[(16 * mt + 4 * g4 + i) * 64 + ch] = gv[i]; } } }
    __syncthreads();
    float* gBON = (float*)(F.ws + WS_BON) + ((size_t)(b * 4 + h) * 64 + c) * 64;
    if (STAGE == 1) { const int t = F.tid >> 3, p8 = F.tid & 7;
      LAS float* pa = Aa + t * 64 + 8 * p8; LAS float* pk = Kk + t * 64 + 8 * p8; LAS float* pr = Rr + t * 64 + 8 * p8; LAS float* pb = Bb + t * 64 + 8 * p8;
      float kp[8], kkv[8], av[8]; float ss = 0.f, bo = 0.f;
#pragma unroll
      for (int q = 0; q < 2; ++q) { const f32x4 a4 = *(const LAS f32x4*)(pa + 4 * q), k4 = *(const LAS f32x4*)(pk + 4 * q), r4 = *(const LAS f32x4*)(pr + 4 * q);
#pragma unroll
          for (int j = 0; j < 4; ++j) { const float a = a4[j], kraw = k4[j]; av[4 * q + j] = a; kp[4 * q + j] = kraw * (1.0f + (a - 1.0f) * pkaw[q][j]);
              kkv[4 * q + j] = kraw * pkkw[q][j]; ss += kkv[4 * q + j] * kkv[4 * q + j]; bo += r4[j] * kp[4 * q + j] * prk[q][j]; } }
      ss = sum8(ss); bo = sum8(bo);
      const float rn = rsqrtf(fmaxf(ss, 1e-24f));
#pragma unroll
      for (int q = 0; q < 2; ++q) { f32x4 ko, ao, bq;
#pragma unroll
          for (int j = 0; j < 4; ++j) { const float kkn = kkv[4 * q + j] * rn; ko[j] = kp[4 * q + j]; ao[j] = -kkn; bq[j] = kkn * av[4 * q + j]; }
          *(LAS f32x4*)(pk + 4 * q) = ko; *(LAS f32x4*)(pa + 4 * q) = ao; *(LAS f32x4*)(pb + 4 * q) = bq; }
      if (p8 == 0) gBON[t] = bo; }
    else if (F.tid < 64) BON[F.tid] = gBON[F.tid];
    __syncthreads();
}
constexpr int RB_AT = 98304, RB_ATT = RB_AT + 9216, RB_BT = RB_ATT + 9216, RB_BTT = RB_BT + 9216, RB_KT = RB_BTT + 9216, RB_RT = RB_KT + 9216, RB_VT = RB_RT + 9216, RB_GC = RB_VT + 9216;
constexpr int RX_X = 0, RX_XT = 9216, RX_TB = 18432, RX_M = 27648, RX_NRT = 36864, RX_G1T = 46080, RX_G2T = 55296, RX_QT = 64512;
__device__ __forceinline__ void st_tile(LAS bf16_t* dst, int mt, int nt, const f32x4 v, int lane) {
    const int r = lane & 15, g = lane >> 4;
#pragma unroll
    for (int i = 0; i < 4; ++i) dst[(16 * mt + 4 * g + i) * RB_LD + 16 * nt + r] = f2bf(v[i]);
}
__device__ __forceinline__ void st_tile_t(LAS bf16_t* dst, int mt, int nt, const f32x4 v, int lane) {
    const int r = lane & 15, g = lane >> 4; u32x2 w; w.x = pk2(v[0], v[1]); w.y = pk2(v[2], v[3]);
    *(LAS u32x2*)(dst + (16 * nt + r) * RB_LD + 16 * mt + 4 * g) = w;
}
__device__ __forceinline__ void st_rm(LAS bf16_t* dst, int mt, int nt, const f32x4 v, int lane) {
    const int r = lane & 15, g = lane >> 4; *(LAS u32x2*)(dst + (16 * mt + r) * RB_LD + 16 * nt + 4 * g) = (u32x2){pk2(v[0], v[1]), pk2(v[2], v[3])};
}
__device__ __forceinline__ void st_tr(LAS bf16_t* dst, int mt, int nt, const f32x4 v, int lane) {
    const int r = lane & 15, g = lane >> 4;
#pragma unroll
    for (int i = 0; i < 4; ++i) dst[(16 * nt + 4 * g + i) * RB_LD + 16 * mt + r] = f2bf(v[i]);
}
__device__ __forceinline__ void ld_fr(const LAS bf16_t* M, int row0, int lane, bf16x8 (&f)[2]) { const LAS bf16_t* p = M + (row0 + (lane & 15)) * RB_LD + 8 * (lane >> 4); f[0] = *(const LAS bf16x8*)p; f[1] = *(const LAS bf16x8*)(p + 32); }
__device__ __forceinline__ f32x4 mm_fr(const bf16x8 (&a)[2], const bf16x8 (&b)[2], f32x4 acc) { acc = __builtin_amdgcn_mfma_f32_16x16x32_bf16(a[0], b[0], acc, 0, 0, 0); return __builtin_amdgcn_mfma_f32_16x16x32_bf16(a[1], b[1], acc, 0, 0, 0); }
__device__ __forceinline__ void item_rwkv1(const Frame& F_, int layer, int item) { Frame F = relocal(F_);
    const int b = item >> 8, h = (item >> 6) & 3, c = item & 63;
    rwkv_prep<1>(F, layer, b, h, c);
    LAS float* Rr = (LAS float*)(F.lds + RW_R); LAS float* Kk = (LAS float*)(F.lds + RW_K); LAS float* Vv = (LAS float*)(F.lds + RW_V); LAS float* Ww = (LAS float*)(F.lds + RW_W);
    LAS float* Aa = (LAS float*)(F.lds + RW_A); LAS float* Bb = (LAS float*)(F.lds + RW_B);
    LAS bf16_t* At = (LAS bf16_t*)(F.lds + RB_AT); LAS bf16_t* AtT = (LAS bf16_t*)(F.lds + RB_ATT); LAS bf16_t* Bt = (LAS bf16_t*)(F.lds + RB_BT); LAS bf16_t* BtT = (LAS bf16_t*)(F.lds + RB_BTT);
    LAS bf16_t* Kt = (LAS bf16_t*)(F.lds + RB_KT); LAS bf16_t* Rt = (LAS bf16_t*)(F.lds + RB_RT); LAS bf16_t* VT = (LAS bf16_t*)(F.lds + RB_VT); LAS float* gC = (LAS float*)(F.lds + RB_GC);
    LAS bf16_t* X = (LAS bf16_t*)(F.lds + RX_X); LAS bf16_t* XT = (LAS bf16_t*)(F.lds + RX_XT); LAS bf16_t* Tb = (LAS bf16_t*)(F.lds + RX_TB); LAS bf16_t* Mm = (LAS bf16_t*)(F.lds + RX_M);
    LAS bf16_t* NrT = (LAS bf16_t*)(F.lds + RX_NRT); LAS bf16_t* G1T = (LAS bf16_t*)(F.lds + RX_G1T); LAS bf16_t* G2T = (LAS bf16_t*)(F.lds + RX_G2T); LAS bf16_t* QT = (LAS bf16_t*)(F.lds + RX_QT);
    { const int k = F.tid & 63, part = F.tid >> 6; float g = 1.0f;
      for (int pp = 0; pp < part; ++pp) { float w8[8];
#pragma unroll
          for (int i = 0; i < 8; ++i) w8[i] = Ww[(8 * pp + i) * 64 + k];
          g *= ((w8[0] * w8[1]) * (w8[2] * w8[3])) * ((w8[4] * w8[5]) * (w8[6] * w8[7])); }
      unsigned aT[4], bT[4], vT[4]; unsigned pa = 0u, pb = 0u, pv = 0u;
#pragma unroll
      for (int i = 0; i < 8; ++i) { const int t = 8 * part + i; const float gp = g; g *= Ww[t * 64 + k]; const float ig = __builtin_amdgcn_rcpf(g);
          const bf16_t av = f2bf(Aa[t * 64 + k] * gp), bv = f2bf(Bb[t * 64 + k] * ig), vv = f2bf(Vv[t * 64 + k]);
          At[t * RB_LD + k] = av; Bt[t * RB_LD + k] = bv;
          Kt[t * RB_LD + k] = f2bf(Kk[t * 64 + k] * ig); Rt[t * RB_LD + k] = f2bf(Rr[t * 64 + k] * g);
          if (i & 1) { aT[i >> 1] = pa | ((unsigned)av << 16); bT[i >> 1] = pb | ((unsigned)bv << 16); vT[i >> 1] = pv | ((unsigned)vv << 16); } else { pa = av; pb = bv; pv = vv; } }
      *(LAS u32x4*)(AtT + k * RB_LD + 8 * part) = (u32x4){aT[0], aT[1], aT[2], aT[3]}; *(LAS u32x4*)(BtT + k * RB_LD + 8 * part) = (u32x4){bT[0], bT[1], bT[2], bT[3]};
      *(LAS u32x4*)(VT + k * RB_LD + 8 * part) = (u32x4){vT[0], vT[1], vT[2], vT[3]};
      if (part == 7) gC[k] = g; }
    __syncthreads();
    const int lane = F.lane, mt = F.wave >> 1, nt0 = 2 * (F.wave & 1), r = lane & 15, g4 = lane >> 4;
    const f32x4 zero4 = (f32x4){0.f, 0.f, 0.f, 0.f};
    f32x4 Tacc[2];
    bf16x8 fa0[2], fa1[2], fa2[2], fb0[2][2], fb1[2][2], fb2[2][2];
    ld_fr(Bt, 16 * mt, lane, fa0); ld_fr(Kt, 16 * mt, lane, fa1); ld_fr(Rt, 16 * mt, lane, fa2);
#pragma unroll
    for (int q = 0; q < 2; ++q) { ld_fr(At, 16 * (nt0 + q), lane, fb0[q]); ld_fr(Bt, 16 * (nt0 + q), lane, fb1[q]); }
#pragma unroll
    for (int q = 0; q < 2; ++q) { const int nt = nt0 + q;
        f32x4 n = mm_fr(fb0[q], fa0, zero4);
        f32x4 m = mm_fr(fb0[q], fa1, zero4);
        f32x4 nr = mm_fr(fb1[q], fa2, zero4);
#pragma unroll
        for (int i = 0; i < 4; ++i) { const int row = 16 * mt + r, col = 16 * nt + 4 * g4 + i;
            n[i] = (row < col) ? n[i] : 0.f; m[i] = (row < col) ? m[i] : 0.f; nr[i] = (col <= row) ? nr[i] : 0.f;
            Tacc[q][i] = n[i] + (row == col ? 1.0f : 0.f); }
        st_rm(X, mt, nt, n, lane); st_tr(XT, mt, nt, n, lane); st_rm(Tb, mt, nt, Tacc[q], lane); st_rm(Mm, mt, nt, m, lane); st_rm(NrT, mt, nt, nr, lane); }
    __syncthreads();
#pragma unroll 1
    for (int it = 0; it < 6; ++it) {
        LAS bf16_t* Xr = (it & 1) ? G1T : X; LAS bf16_t* XTr = (it & 1) ? G2T : XT; LAS bf16_t* Tr = (it & 1) ? QT : Tb;
        LAS bf16_t* Xw = (it & 1) ? X : G1T; LAS bf16_t* XTw = (it & 1) ? XT : G2T; LAS bf16_t* Tw = (it & 1) ? Tb : QT;
        ld_fr(Tr, 16 * mt, lane, fa0); ld_fr(Xr, 16 * mt, lane, fa1);
#pragma unroll
        for (int q = 0; q < 2; ++q) ld_fr(XTr, 16 * (nt0 + q), lane, fb0[q]);
#pragma unroll
        for (int q = 0; q < 2; ++q) { const int nt = nt0 + q;
            if (it > 0) Tacc[q] = mm_fr(fb0[q], fa0, Tacc[q]);
            if (it < 5) { const f32x4 x2 = mm_fr(fb0[q], fa1, zero4); st_rm(Xw, mt, nt, x2, lane); st_tr(XTw, mt, nt, x2, lane); }
            st_rm(Tw, mt, nt, Tacc[q], lane); }
        __syncthreads();
    }
    ld_fr(NrT, 16 * mt, lane, fa0); ld_fr(BtT, 16 * mt, lane, fa1);
#pragma unroll
    for (int q = 0; q < 2; ++q) ld_fr(Tb, 16 * (nt0 + q), lane, fb0[q]);
#pragma unroll
    for (int q = 0; q < 2; ++q) { const int nt = nt0 + q;
        st_rm(G1T, mt, nt, mm_fr(fb0[q], fa0, zero4), lane);
        st_rm(G2T, mt, nt, mm_fr(fb0[q], fa1, zero4), lane); }
    __syncthreads();
    const size_t ci = (size_t)(b * 4 + h) * 64 + c;
    bf16_t* gPT = (bf16_t*)(F.ws + WS_MOE + RW_PT) + ci * 4096; bf16_t* gW1 = (bf16_t*)(F.ws + WS_MOE + RW_W1) + ci * 4096; bf16_t* gZ = (bf16_t*)(F.ws + WS_MOE + RW_Z) + ci * 4096;
    ld_fr(G1T, 16 * mt, lane, fa0); ld_fr(Rt, 16 * mt, lane, fa1); ld_fr(G2T, 16 * mt, lane, fa2);
#pragma unroll
    for (int q = 0; q < 2; ++q) { ld_fr(AtT, 16 * (nt0 + q), lane, fb0[q]); ld_fr(Mm, 16 * (nt0 + q), lane, fb1[q]); ld_fr(Kt, 16 * (nt0 + q), lane, fb2[q]); }
#pragma unroll
    for (int q = 0; q < 2; ++q) { const int nt = nt0 + q; const int row = 16 * mt + r, c0 = 16 * nt + 4 * g4;
        const f32x4 w1 = mm_fr(fb0[q], fa0, zero4);
        const f32x4 z = mm_fr(fb1[q], fa0, zero4);
        const f32x4 mr = mm_fr(fb2[q], fa1, zero4);
        const f32x4 p = mm_fr(fb0[q], fa2, zero4);
        f32x4 qq = mm_fr(fb1[q], fa2, zero4);
        const float gc = gC[row]; const u32x2 rt = *(const LAS u32x2*)(Rt + row * RB_LD + c0);
        const float rv[4] = {__uint_as_float(rt.x << 16), __uint_as_float(rt.x & 0xffff0000u), __uint_as_float(rt.y << 16), __uint_as_float(rt.y & 0xffff0000u)};
        float wv[4], zv[4], pv[4];
#pragma unroll
        for (int i = 0; i < 4; ++i) { const int col = c0 + i;
            wv[i] = w1[i] + rv[i]; zv[i] = z[i] + (col <= row ? mr[i] : 0.f); pv[i] = (p[i] + (row == col ? 1.0f : 0.f)) * gc;
            qq[i] = (qq[i] + bf2f(Kt[col * RB_LD + row])) * gc; }
        *(u32x2*)(gW1 + row * 64 + c0) = (u32x2){pk2(wv[0], wv[1]), pk2(wv[2], wv[3])};
        *(u32x2*)(gZ + row * 64 + c0) = (u32x2){pk2(zv[0], zv[1]), pk2(zv[2], zv[3])};
        *(u32x2*)(gPT + row * 64 + 32 * (nt >> 1) + 8 * g4 + 4 * (nt & 1)) = (u32x2){pk2(pv[0], pv[1]), pk2(pv[2], pv[3])};
        st_rm(QT, mt, nt, qq, lane); }
    __syncthreads();
    bf16_t* gU = (bf16_t*)(F.ws + WS_MOE + RW_U) + ci * 4096;
    ld_fr(VT, 16 * mt, lane, fa0);
#pragma unroll
    for (int q = 0; q < 2; ++q) ld_fr(QT, 16 * (nt0 + q), lane, fb0[q]);
#pragma unroll
    for (int q = 0; q < 2; ++q) { const int nt = nt0 + q;
        const f32x4 u = mm_fr(fb0[q], fa0, zero4);
        *(u32x2*)(gU + (16 * mt + r) * 64 + 16 * nt + 4 * g4) = (u32x2){pk2(u[0], u[1]), pk2(u[2], u[3])}; }
}
__device__ __forceinline__ void item_rwkv_carry(const Frame& F_, int item) { Frame F = relocal(F_);
    const int bh = item * 2 + (F.wave >> 2), nt = F.wave & 3, r = F.lane & 15, g = F.lane >> 4;
    const bf16_t* PT = (const bf16_t*)(F.ws + WS_MOE + RW_PT); const bf16_t* Uc = (const bf16_t*)(F.ws + WS_MOE + RW_U); bf16_t* Ss = (bf16_t*)(F.ws + WS_MOE + RW_S);
    f32x4 acc[4];
#pragma unroll
    for (int m = 0; m < 4; ++m) acc[m] = (f32x4){0.f, 0.f, 0.f, 0.f};
    for (int c = 0; c < 64; ++c) { const size_t ci = (size_t)bh * 64 + c;
        bf16x8 af[4][2]; f32x4 cin[4];
#pragma unroll
        for (int m = 0; m < 4; ++m) { const u32x2 uv = *(const u32x2*)(Uc + ci * 4096 + (16 * nt + r) * 64 + 16 * m + 4 * g);
            cin[m] = (f32x4){__uint_as_float(uv.x << 16), __uint_as_float(uv.x & 0xffff0000u), __uint_as_float(uv.y << 16), __uint_as_float(uv.y & 0xffff0000u)};
#pragma unroll
            for (int s = 0; s < 2; ++s) af[m][s] = *(const bf16x8*)(PT + ci * 4096 + (16 * m + r) * 64 + 32 * s + 8 * g); }
        unsigned pw[4][2];
#pragma unroll
        for (int m = 0; m < 4; ++m) { pw[m][0] = pk2(acc[m][0], acc[m][1]); pw[m][1] = pk2(acc[m][2], acc[m][3]);
            *(u32x2*)(Ss + ci * 4096 + (16 * nt + r) * 64 + 16 * m + 4 * g) = (u32x2){pw[m][0], pw[m][1]}; }
        bf16x8 bfr[2];
#pragma unroll
        for (int s = 0; s < 2; ++s) bfr[s] = __builtin_bit_cast(bf16x8, (u32x4){pw[2 * s][0], pw[2 * s][1], pw[2 * s + 1][0], pw[2 * s + 1][1]});
#pragma unroll
        for (int m = 0; m < 4; ++m) { acc[m] = __builtin_amdgcn_mfma_f32_16x16x32_bf16(af[m][0], bfr[0], cin[m], 0, 0, 0);
            acc[m] = __builtin_amdgcn_mfma_f32_16x16x32_bf16(af[m][1], bfr[1], acc[m], 0, 0, 0); }
    }
}
__device__ __forceinline__ void item_rwkv3(const Frame& F_, int layer, int item) { Frame F = relocal(F_);
    const int b = item >> 8, h = (item >> 6) & 3, c = item & 63; const size_t T0 = (size_t)b * SEQ + c * 64;
    const size_t ci3 = (size_t)(b * 4 + h) * 64 + c;
    const u32x4 tS = *(const u32x4*)((const bf16_t*)(F.ws + WS_MOE + RW_S) + ci3 * 4096 + F.tid * 8);
    const u32x4 tW = *(const u32x4*)((const bf16_t*)(F.ws + WS_MOE + RW_W1) + ci3 * 4096 + F.tid * 8);
    const u32x4 tZ = *(const u32x4*)((const bf16_t*)(F.ws + WS_MOE + RW_Z) + ci3 * 4096 + F.tid * 8);
    f32x4 lw4[2], lb4[2];
#pragma unroll
    for (int q = 0; q < 2; ++q) { lw4[q] = *(const f32x4*)(F.in[I_RLNW] + layer * 256 + h * 64 + 8 * (F.tid & 7) + 4 * q); lb4[q] = *(const f32x4*)(F.in[I_RLNB] + layer * 256 + h * 64 + 8 * (F.tid & 7) + 4 * q); }
    rwkv_prep<3>(F, layer, b, h, c);
    LAS float* Vv = (LAS float*)(F.lds + RW_V); LAS float* Oo = (LAS float*)(F.lds + R3_O);
    LAS float* Gg = (LAS float*)(F.lds + R3_G); LAS float* BON = (LAS float*)(F.lds + R3_BON);
    LAS bf16_t* S0b = (LAS bf16_t*)(F.lds + R3_TILES); LAS bf16_t* W1b = S0b + 4608; LAS bf16_t* Zb = W1b + 4608; LAS bf16_t* VTb = Zb + 4608;
    { const int row = F.tid >> 3, col = (F.tid & 7) * 8;
      *(LAS u32x4*)(S0b + row * RB_LD + col) = tS;
      *(LAS u32x4*)(W1b + row * RB_LD + col) = tW;
      *(LAS u32x4*)(Zb + row * RB_LD + col) = tZ;
      const int vv = F.tid & 63, part = F.tid >> 6;
      unsigned vT[4];
#pragma unroll
      for (int i = 0; i < 8; i += 2) vT[i >> 1] = pk2(Vv[(8 * part + i) * 64 + vv], Vv[(8 * part + i + 1) * 64 + vv]);
      *(LAS u32x4*)(VTb + vv * RB_LD + 8 * part) = (u32x4){vT[0], vT[1], vT[2], vT[3]}; }
    __syncthreads();
    { const int lane = F.lane, mt = F.wave >> 1, nt0 = 2 * (F.wave & 1), r = lane & 15, g4 = lane >> 4;
      bf16x8 fa0[2], fa1[2], fb0[2][2], fb1[2][2];
      ld_fr(W1b, 16 * mt, lane, fa0); ld_fr(Zb, 16 * mt, lane, fa1);
#pragma unroll
      for (int q = 0; q < 2; ++q) { ld_fr(S0b, 16 * (nt0 + q), lane, fb0[q]); ld_fr(VTb, 16 * (nt0 + q), lane, fb1[q]); }
#pragma unroll
      for (int q = 0; q < 2; ++q) { const int nt = nt0 + q;
          f32x4 o = mm_fr(fa0, fb0[q], (f32x4){0.f, 0.f, 0.f, 0.f});
          o = mm_fr(fa1, fb1[q], o);
#pragma unroll
          for (int i = 0; i < 4; ++i) Oo[(16 * mt + 4 * g4 + i) * 64 + 16 * nt + r] = o[i]; } }
    __syncthreads();
    { const int t = F.tid >> 3, p8 = F.tid & 7;
      float o[8]; float sm = 0.f;
#pragma unroll
      for (int q = 0; q < 2; ++q) { const f32x4 o4 = *(const LAS f32x4*)(Oo + t * 64 + 8 * p8 + 4 * q);
#pragma unroll
          for (int j = 0; j < 4; ++j) { o[4 * q + j] = o4[j]; sm += o4[j]; } }
      const float mean = sum8(sm) * (1.0f / 64.0f); float vs = 0.f;
#pragma unroll
      for (int j = 0; j < 8; ++j) { o[j] -= mean; vs += o[j] * o[j]; }
      const float rstd = rsqrtf(sum8(vs) * (1.0f / 64.0f) + 64e-5f); const float bon = BON[t];
      float y[8];
#pragma unroll
      for (int q = 0; q < 2; ++q) { const f32x4 v4 = *(const LAS f32x4*)(Vv + t * 64 + 8 * p8 + 4 * q), g4v = *(const LAS f32x4*)(Gg + t * 64 + 8 * p8 + 4 * q);
#pragma unroll
          for (int j = 0; j < 4; ++j) y[4 * q + j] = (o[4 * q + j] * rstd * lw4[q][j] + lb4[q][j] + bon * v4[j]) * g4v[j]; }
      *(u32x4*)((bf16_t*)(F.ws + WS_H) + (T0 + t) * DM + 256 + h * 64 + 8 * p8) = (u32x4){pk2(y[0], y[1]), pk2(y[2], y[3]), pk2(y[4], y[5]), pk2(y[6], y[7])}; }
}

constexpr int DS_SEL = 131072, DS_HIST = 135168, DS_BKT = 151552, DS_BIAS = 152064;
__device__ __forceinline__ void dsa_tables(const Frame& F_) { Frame F = relocal(F_);
    LAS int* bkt = (LAS int*)(F.lds + DS_BKT); LAS float* biasT = (LAS float*)(F.lds + DS_BIAS);
    if (F.tid < 128) { const int n = F.tid; int bk = n; if (n >= 16) { const float lr = logf((float)n / 16.0f) / 2.0794415416798357f; bk = 16 + (int)(lr * 16.0f); bk = bk < 31 ? bk : 31; } bkt[n] = bk; biasT[n] = F.in[I_RELB][n]; }
    __syncthreads();
}
__device__ __forceinline__ unsigned fkey(float f) { const unsigned u = __float_as_uint(f); return (u & 0x80000000u) ? ~u : (u | 0x80000000u); }
__device__ __forceinline__ void item_dsa(const Frame& F_, int layer, int item) { Frame F = relocal(F_);
    const bf16_t* U = (const bf16_t*)(F.ws + WS_U); const bf16_t* KI = (const bf16_t*)(F.ws + WS_KIDX);
    const bf16_t* Kb = (const bf16_t*)(F.ws + WS_K); const bf16_t* Vb = (const bf16_t*)(F.ws + WS_V);
    const int b = item & 3, qg = 511 - (item >> 2); const size_t TB = (size_t)b * SEQ, T0 = TB + qg * 8;
    LAS float* sc = (LAS float*)F.lds; LAS unsigned short* selall = (LAS unsigned short*)(F.lds + DS_SEL); LAS unsigned* histall = (LAS unsigned*)(F.lds + DS_HIST);
    LAS int* bkt = (LAS int*)(F.lds + DS_BKT); LAS float* biasT = (LAS float*)(F.lds + DS_BIAS);
    const int lane = F.lane, hh = lane >> 5;
    {
        bf16x8 af[2][2]; float wq[2][2][8];
        { const int r = lane & 31, q4 = 2 * ((r >> 2) & 1) + (r >> 4), head = 4 * ((r >> 3) & 1) + (r & 3);
#pragma unroll
          for (int mt = 0; mt < 2; ++mt)
#pragma unroll
              for (int ks = 0; ks < 2; ++ks) af[mt][ks] = *(const bf16x8*)(U + (T0 + 4 * mt + q4) * NINP + UC + 384 + head * 32 + 16 * ks + 8 * hh); }
#pragma unroll
        for (int mt = 0; mt < 2; ++mt)
#pragma unroll
            for (int q2 = 0; q2 < 2; ++q2) { float f[8]; unpack8(*(const u32x4*)(U + (T0 + 4 * mt + 2 * hh + q2) * NINP + UC + 672), f);
#pragma unroll
                for (int hd = 0; hd < 8; ++hd) wq[mt][q2][hd] = f[hd]; }
        const int ntile = (qg * 8 + 8 + 31) >> 5;
        bf16x8 nb0 = af[0][0], nb1 = af[0][0];
        if (F.wave < ntile) { const int key = F.wave * 32 + (lane & 31); nb0 = *(const bf16x8*)(KI + (TB + key) * 32 + 8 * hh); nb1 = *(const bf16x8*)(KI + (TB + key) * 32 + 16 + 8 * hh); }
        for (int kt = F.wave; kt < ntile; kt += 8) {
            const int key = kt * 32 + (lane & 31);
            const bf16x8 b0 = nb0, b1 = nb1;
            if (kt + 8 < ntile) { const int k2 = key + 256; nb0 = *(const bf16x8*)(KI + (TB + k2) * 32 + 8 * hh); nb1 = *(const bf16x8*)(KI + (TB + k2) * 32 + 16 + 8 * hh); }
#pragma unroll
            for (int mt = 0; mt < 2; ++mt) { f32x16 acc;
#pragma unroll
                for (int i = 0; i < 16; ++i) acc[i] = 0.f;
                acc = __builtin_amdgcn_mfma_f32_32x32x16_bf16(af[mt][0], b0, acc, 0, 0, 0);
                acc = __builtin_amdgcn_mfma_f32_32x32x16_bf16(af[mt][1], b1, acc, 0, 0, 0);
#pragma unroll
                for (int q2 = 0; q2 < 2; ++q2) { float s = 0.f;
#pragma unroll
                    for (int hd = 0; hd < 8; ++hd) s += fmaxf(acc[8 * q2 + hd], 0.f) * wq[mt][q2][hd];
                    const int qi = 4 * mt + 2 * hh + q2;
                    sc[qi * 4096 + key] = (key <= qg * 8 + qi) ? s : -INFINITY; } }
        }
    }
    __syncthreads();
    const int qi = F.wave, tq = qg * 8 + qi, n = tq + 1;
    LAS float* scq = sc + qi * 4096; LAS unsigned short* sel = selall + qi * 256; LAS unsigned* hist = histall + qi * 512;
    int nsel;
    if (n <= 256) { nsel = n; for (int j = lane; j < 256; j += 64) sel[j] = (unsigned short)(j < n ? j : 0); }
    else {
        nsel = 256;
        const int R = (n + 63) >> 6; const unsigned long long ltm = (1ull << lane) - 1ull;
        float lo = INFINITY, hi = -INFINITY;
        const int R4 = (n + 255) >> 8;
#pragma unroll 4
        for (int i = 0; i < R4; ++i) { const int j0 = 256 * i + 4 * lane; const f32x4 v4 = *(const LAS f32x4*)(scq + j0);
#pragma unroll
            for (int q = 0; q < 4; ++q) { const bool valid = j0 + q < n; lo = fminf(lo, valid ? v4[q] : INFINITY); hi = fmaxf(hi, valid ? v4[q] : -INFINITY); } }
        lo = wave_min(lo); hi = wave_max(hi);
        bool slow = false;
        if (!(hi > lo)) { for (int j = lane; j < 256; j += 64) sel[j] = (unsigned short)j; }
        else {
            const float scale = 1023.0f / (hi - lo);
            *(LAS u32x4*)(hist + 8 * lane) = (u32x4){0u, 0u, 0u, 0u}; *(LAS u32x4*)(hist + 8 * lane + 4) = (u32x4){0u, 0u, 0u, 0u};
#pragma unroll 2
            for (int i = 0; i < R4; ++i) { const int j0 = 256 * i + 4 * lane; const f32x4 v4 = *(const LAS f32x4*)(scq + j0);
#pragma unroll
                for (int q = 0; q < 4; ++q) { if (j0 + q < n) { int bk = (int)((v4[q] - lo) * scale); bk = bk < 1023 ? bk : 1023;
                    atomicAdd((unsigned*)(hist + (bk >> 1)), (bk & 1) ? 65536u : 1u); } } }
            const u32x4 h0 = *(const LAS u32x4*)(hist + 8 * lane), h1 = *(const LAS u32x4*)(hist + 8 * lane + 4);
            unsigned cb[16];
            cb[0] = h0.x & 0xffffu; cb[1] = h0.x >> 16; cb[2] = h0.y & 0xffffu; cb[3] = h0.y >> 16; cb[4] = h0.z & 0xffffu; cb[5] = h0.z >> 16; cb[6] = h0.w & 0xffffu; cb[7] = h0.w >> 16;
            cb[8] = h1.x & 0xffffu; cb[9] = h1.x >> 16; cb[10] = h1.y & 0xffffu; cb[11] = h1.y >> 16; cb[12] = h1.z & 0xffffu; cb[13] = h1.z >> 16; cb[14] = h1.w & 0xffffu; cb[15] = h1.w >> 16;
            unsigned tot = 0u;
#pragma unroll
            for (int q = 0; q < 16; ++q) tot += cb[q];
            const unsigned pre = wave_prefix_u(tot); const unsigned incl = (unsigned)__builtin_amdgcn_readlane((int)pre, 63) - pre + tot;
            int fb = -1; unsigned fabove = 0u, fcnt = 0u; unsigned cum = incl - tot;
#pragma unroll
            for (int q = 15; q >= 0; --q) { if (fb < 0 && cum < 256u && 256u <= cum + cb[q]) { fb = 16 * lane + q; fabove = cum; fcnt = cb[q]; } cum += cb[q]; }
            const unsigned long long mf = __ballot(fb >= 0); const int src = (int)__ffsll((long long)mf) - 1;
            const int B = __builtin_amdgcn_readlane(fb, src); const int above = __builtin_amdgcn_readlane((int)fabove, src), cntB = __builtin_amdgcn_readlane((int)fcnt, src); const int need = 256 - above;
            if (cntB > 256) slow = true;
            else {
                LAS unsigned* cand = hist;
                int base_gt = 0, base_c = 0;
#pragma unroll 2
                for (int i = 0; i < R4; ++i) { const int j0 = 256 * i + 4 * lane; const f32x4 v4 = *(const LAS f32x4*)(scq + j0);
#pragma unroll
                    for (int q = 0; q < 4; ++q) { const int j = j0 + q; const bool valid = j < n; const float v = valid ? v4[q] : lo;
                        int bk = (int)((v - lo) * scale); bk = bk < 1023 ? bk : 1023;
                        const bool gt = valid && bk > B, eq = valid && bk == B;
                        const unsigned long long mg = __ballot(gt), me = __ballot(eq);
                        if (gt) sel[base_gt + __popcll(mg & ltm)] = (unsigned short)j;
                        if (eq) { const int p = base_c + __popcll(me & ltm); cand[2 * p] = fkey(v); cand[2 * p + 1] = (unsigned)j; }
                        base_gt += __popcll(mg); base_c += __popcll(me); } }
                if (need == cntB) { for (int c = lane; c < cntB; c += 64) sel[above + c] = (unsigned short)cand[2 * c + 1]; }
                else {
                    unsigned ck[4], cx[4]; int rk[4];
#pragma unroll
                    for (int q = 0; q < 4; ++q) { const int c = lane + 64 * q; ck[q] = c < cntB ? cand[2 * c] : 0u; cx[q] = c < cntB ? cand[2 * c + 1] : 0u; rk[q] = 0; }
                    for (int c2 = 0; c2 < cntB; ++c2) { const unsigned k2 = cand[2 * c2], x2 = cand[2 * c2 + 1];
#pragma unroll
                        for (int q = 0; q < 4; ++q) rk[q] += (k2 > ck[q] || (k2 == ck[q] && x2 < cx[q])) ? 1 : 0; }
#pragma unroll
                    for (int q = 0; q < 4; ++q) { const int c = lane + 64 * q; if (c < cntB && rk[q] < need) sel[above + rk[q]] = (unsigned short)cand[2 * c + 1]; }
                }
            }
        }
        if (slow) {
        unsigned prefix = 0u; int need = 256; unsigned neq = 0u;
        for (int p = 0; p < 4; ++p) { const int shift = 24 - 8 * p;
            *(LAS u32x4*)(hist + 4 * lane) = (u32x4){0u, 0u, 0u, 0u};
            for (int i = 0; i < R; ++i) { const int j = lane + 64 * i; if (j < n) { const unsigned u = fkey(scq[j]);
                if (p == 0 || (u >> (shift + 8)) == prefix) atomicAdd((unsigned*)(hist + ((u >> shift) & 255u)), 1u); } }
            const u32x4 hv = *(const LAS u32x4*)(hist + 4 * lane);
            const unsigned tot = hv.x + hv.y + hv.z + hv.w;
            unsigned incl = tot;
#pragma unroll
            for (int o = 1; o < 64; o <<= 1) { const unsigned t = shdown_u(incl, o); if (lane + o < 64) incl += t; }
            const unsigned above = incl - tot;
            int fb = -1; unsigned fabove = 0u, feq = 0u; unsigned cum = above;
            { const unsigned hq[4] = {hv.x, hv.y, hv.z, hv.w};
#pragma unroll
              for (int q = 3; q >= 0; --q) { if (fb < 0 && cum < (unsigned)need && (unsigned)need <= cum + hq[q]) { fb = 4 * lane + q; fabove = cum; feq = hq[q]; } cum += hq[q]; } }
            const unsigned long long m = __ballot(fb >= 0);
            const int src = (int)__ffsll((long long)m) - 1;
            const int bin = shidx_i(fb, src); const unsigned ab = (unsigned)shidx_i((int)fabove, src); neq = (unsigned)shidx_i((int)feq, src);
            need -= (int)ab; prefix = (prefix << 8) | (unsigned)bin;
        }
        const int ngt = 256 - need;
        int base_gt = 0, base_eq = 0;
        for (int i = 0; i < R; ++i) { const int j = lane + 64 * i; const unsigned u = (j < n) ? fkey(scq[j]) : 0u;
            const bool gt = (j < n) && (u > prefix), eq = (j < n) && (u == prefix);
            const unsigned long long mg = __ballot(gt), me = __ballot(eq); const unsigned long long lt = (1ull << lane) - 1ull;
            if (gt) sel[base_gt + __popcll(mg & lt)] = (unsigned short)j;
            if (eq) { const int rk = base_eq + __popcll(me & lt); if (rk < need) sel[ngt + rk] = (unsigned short)j; }
            base_gt += __popcll(mg); base_eq += __popcll(me); }
        (void)neq;
            }
    }
    const int nt16 = (nsel + 15) >> 4, r16 = lane & 15, g4 = lane >> 4;
    LAS float* biasj = scq + 2048;
#pragma unroll
    for (int q = 0; q < 4; ++q) { const int j = lane + 64 * q; f32x4 bv = (f32x4){-INFINITY, -INFINITY, -INFINITY, -INFINITY};
        if (j < nsel) { const int dist = tq - (int)sel[j]; const int bk = dist < 128 ? bkt[dist < 0 ? 0 : dist] : 31; bv = *(const LAS f32x4*)(biasT + 4 * bk); }
        *(LAS f32x4*)(biasj + 4 * j) = bv; }
    bf16x8 qf[2];
#pragma unroll
    for (int s = 0; s < 2; ++s) { u32x4 z = (u32x4){0u, 0u, 0u, 0u}; if (r16 < 4) z = *(const u32x4*)(U + (T0 + qi) * NINP + UC + r16 * 64 + 32 * s + 8 * g4); qf[s] = __builtin_bit_cast(bf16x8, z); }
    float lg[16][4]; float mx = -INFINITY;
#define DSA_QK(M0, NM) do { int keyr[NM]; bf16x8 a0[NM], a1[NM]; \
        _Pragma("unroll") for (int m8 = 0; m8 < NM; ++m8) keyr[m8] = sel[16 * ((M0) + m8) + r16]; \
        _Pragma("unroll") for (int m8 = 0; m8 < NM; ++m8) { a0[m8] = *(const bf16x8*)(Kb + (TB + keyr[m8]) * 64 + 8 * g4); a1[m8] = *(const bf16x8*)(Kb + (TB + keyr[m8]) * 64 + 32 + 8 * g4); } \
        _Pragma("unroll") for (int m8 = 0; m8 < NM; ++m8) { const int m = (M0) + m8; \
            f32x4 acc = (f32x4){0.f, 0.f, 0.f, 0.f}; \
            acc = __builtin_amdgcn_mfma_f32_16x16x32_bf16(a0[m8], qf[0], acc, 0, 0, 0); \
            acc = __builtin_amdgcn_mfma_f32_16x16x32_bf16(a1[m8], qf[1], acc, 0, 0, 0); \
            _Pragma("unroll") for (int i = 0; i < 4; ++i) { const float v = acc[i] * 0.125f + biasj[(16 * m + 4 * g4 + i) * 4 + (r16 & 3)]; lg[m][i] = v; mx = fmaxf(mx, v); } } } while (0)
    if (nt16 > 8) { DSA_QK(0, 16); }
    else { DSA_QK(0, 8);
#pragma unroll
        for (int m8 = 8; m8 < 16; ++m8)
#pragma unroll
            for (int i = 0; i < 4; ++i) lg[m8][i] = -INFINITY; }
#undef DSA_QK
    mx = xrows(mx, OpMax());
    float sm = 0.f;
#pragma unroll
    for (int m = 0; m < 16; ++m)
#pragma unroll
        for (int i = 0; i < 4; ++i) { const float p = __expf(lg[m][i] - mx); lg[m][i] = p; sm += p; }
    sm = xrows(sm, OpAdd());
    f32x4 ov[4];
#pragma unroll
    for (int nt = 0; nt < 4; ++nt) ov[nt] = (f32x4){0.f, 0.f, 0.f, 0.f};
    const unsigned vs_base = (unsigned)(unsigned long)scq;
#pragma unroll
    for (int half = 0; half < 2; ++half) {
        if (half * 8 < nt16) {
            asm volatile("s_waitcnt lgkmcnt(0)" ::: "memory");
            int vkey[16];
#pragma unroll
            for (int q = 0; q < 16; ++q) { const int rho = 8 * q + (lane >> 3);
                vkey[q] = sel[half * 128 + (rho & ~31) + 16 * ((rho >> 2) & 1) + 4 * ((rho >> 3) & 3) + (rho & 3)]; }
            asm volatile("s_waitcnt lgkmcnt(0)" : "+v"(vkey[0]), "+v"(vkey[1]), "+v"(vkey[2]), "+v"(vkey[3]), "+v"(vkey[4]), "+v"(vkey[5]), "+v"(vkey[6]), "+v"(vkey[7]),
                         "+v"(vkey[8]), "+v"(vkey[9]), "+v"(vkey[10]), "+v"(vkey[11]), "+v"(vkey[12]), "+v"(vkey[13]), "+v"(vkey[14]), "+v"(vkey[15]) :: "memory");
#pragma unroll
            for (int q = 0; q < 16; ++q)
                __builtin_amdgcn_global_load_lds((const unsigned*)(Vb + (TB + vkey[q]) * 64 + 8 * (lane & 7)), (LAS unsigned*)((LAS unsigned char*)scq + q * 1024), 16, 0, 0);
            asm volatile("s_waitcnt vmcnt(0)" ::: "memory");
#pragma unroll
            for (int s4 = 0; s4 < 4; ++s4) { const int s = half * 4 + s4;
                u32x4 pw; pw.x = pk2(lg[2 * s][0], lg[2 * s][1]); pw.y = pk2(lg[2 * s][2], lg[2 * s][3]); pw.z = pk2(lg[2 * s + 1][0], lg[2 * s + 1][1]); pw.w = pk2(lg[2 * s + 1][2], lg[2 * s + 1][3]);
                const bf16x8 pa = __builtin_bit_cast(bf16x8, pw);
                const unsigned ad = vs_base + (unsigned)((32 * s4 + 8 * g4 + (r16 >> 2)) * 128 + (r16 & 3) * 8);
                u32x2 t0[4], t1[4];
                asm volatile("ds_read_b64_tr_b16 %0, %8\n\tds_read_b64_tr_b16 %1, %8 offset:512\n\tds_read_b64_tr_b16 %2, %8 offset:32\n\tds_read_b64_tr_b16 %3, %8 offset:544\n\t"
                             "ds_read_b64_tr_b16 %4, %8 offset:64\n\tds_read_b64_tr_b16 %5, %8 offset:576\n\tds_read_b64_tr_b16 %6, %8 offset:96\n\tds_read_b64_tr_b16 %7, %8 offset:608\n\ts_waitcnt lgkmcnt(0)"
                             : "=&v"(t0[0]), "=&v"(t1[0]), "=&v"(t0[1]), "=&v"(t1[1]), "=&v"(t0[2]), "=&v"(t1[2]), "=&v"(t0[3]), "=&v"(t1[3]) : "v"(ad) : "memory");
#pragma unroll
                for (int nt = 0; nt < 4; ++nt) { const bf16x8 vb = __builtin_bit_cast(bf16x8, (u32x4){t0[nt].x, t0[nt].y, t1[nt].x, t1[nt].y});
                    ov[nt] = __builtin_amdgcn_mfma_f32_16x16x32_bf16(pa, vb, ov[nt], 0, 0, 0); } }
        }
    }
    { float inv[4];
#pragma unroll
      for (int h = 0; h < 4; ++h) inv[h] = 1.0f / __int_as_float(__builtin_amdgcn_readlane(__float_as_int(sm), h));
      if (lane < 16) { bf16_t* Y = (bf16_t*)(F.ws + WS_H) + (T0 + qi) * DM + 512 + r16;
#pragma unroll
          for (int h = 0; h < 4; ++h)
#pragma unroll
              for (int nt = 0; nt < 4; ++nt) Y[h * 64 + 16 * nt] = f2bf(ov[nt][h] * inv[h]); } }
}

__device__ __forceinline__ void phase_router(const Frame& F_, int layer) { Frame F = relocal(F_); const int cset = layer;
    const float* X = (const float*)(F.ws + WS_X);
    const bf16_t* WH = (const bf16_t*)(F.ws + WS_WRT) + (size_t)layer * 2 * 49152; const bf16_t* WL = WH + 49152;
    LAS float* part = (LAS float*)F.lds;
    LAS float* ssq = (LAS float*)(F.lds + 24576);
    LAS int* es = (LAS int*)(F.lds + 25088);
    LAS int* lr = (LAS int*)(F.lds + 25600);
    LAS float* wsl = (LAS float*)(F.lds + 26112);
    LAS float* rsd = (LAS float*)(F.lds + 26624);
    for (int blk = F.bid; blk < NTOK / 64; blk += F.G) {
        __syncthreads();
        const int mt = F.wave & 3, kh = F.wave >> 2, r16 = F.lane & 15, g4 = F.lane >> 4;
        const float* xr = X + ((size_t)blk * 64 + mt * 16 + r16) * DM + kh * 512 + 8 * g4;
        f32x4 acc[3]; acc[0] = acc[1] = acc[2] = (f32x4){0.f, 0.f, 0.f, 0.f}; float ss = 0.f;
#pragma unroll 4
        for (int ks = 0; ks < 16; ++ks) {
            const f32x4 xa = *(const f32x4*)(xr + ks * 32), xb = *(const f32x4*)(xr + ks * 32 + 4);
            ss += xa[0] * xa[0] + xa[1] * xa[1] + xa[2] * xa[2] + xa[3] * xa[3] + xb[0] * xb[0] + xb[1] * xb[1] + xb[2] * xb[2] + xb[3] * xb[3];
            float xv[8] = {xa[0], xa[1], xa[2], xa[3], xb[0], xb[1], xb[2], xb[3]}; unsigned hw[4], lw[4];
#pragma unroll
            for (int j = 0; j < 4; ++j) { const bf16_t h0 = f2bf(xv[2 * j]), h1 = f2bf(xv[2 * j + 1]); hw[j] = (unsigned)h0 | ((unsigned)h1 << 16);
                lw[j] = pk2(xv[2 * j] - bf2f(h0), xv[2 * j + 1] - bf2f(h1)); }
            const bf16x8 ahi = __builtin_bit_cast(bf16x8, (u32x4){hw[0], hw[1], hw[2], hw[3]}), alo = __builtin_bit_cast(bf16x8, (u32x4){lw[0], lw[1], lw[2], lw[3]});
#pragma unroll
            for (int nt = 0; nt < 3; ++nt) { const size_t wo = (size_t)(nt * 16 + r16) * 1024 + kh * 512 + ks * 32 + 8 * g4;
                const bf16x8 bh = *(const bf16x8*)(WH + wo), bl = *(const bf16x8*)(WL + wo);
                acc[nt] = __builtin_amdgcn_mfma_f32_16x16x32_bf16(ahi, bh, acc[nt], 0, 0, 0);
                acc[nt] = __builtin_amdgcn_mfma_f32_16x16x32_bf16(ahi, bl, acc[nt], 0, 0, 0);
                acc[nt] = __builtin_amdgcn_mfma_f32_16x16x32_bf16(alo, bh, acc[nt], 0, 0, 0); }
        }
        ss = xrows(ss, OpAdd());
        if (g4 == 0) ssq[kh * 64 + mt * 16 + r16] = ss;
#pragma unroll
        for (int nt = 0; nt < 3; ++nt)
#pragma unroll
            for (int i = 0; i < 4; ++i) part[(kh * 64 + mt * 16 + 4 * g4 + i) * 48 + nt * 16 + r16] = acc[nt][i];
        __syncthreads();
        if (F.tid < 64) { const float rstd = rsqrtf((ssq[F.tid] + ssq[64 + F.tid]) * (1.0f / DM) + 1e-6f); rsd[F.tid] = rstd;
            float l[36];
#pragma unroll
            for (int o = 0; o < 36; ++o) l[o] = (part[F.tid * 48 + o] + part[(64 + F.tid) * 48 + o]) * rstd + (o < 32 ? F.in[I_BRE][layer * 32 + o] : F.in[I_BRG][layer * 4 + o - 32]);
            int gs = 0; float gm = l[32];
#pragma unroll
            for (int j = 1; j < 4; ++j) if (l[32 + j] > gm) { gm = l[32 + j]; gs = j; }
            float den = 0.f;
#pragma unroll
            for (int j = 0; j < 4; ++j) den += __expf(l[32 + j] - gm);
            const float gate = 1.0f / den;
            float e8[8];
#pragma unroll
            for (int j = 0; j < 8; ++j) e8[j] = gs == 0 ? l[j] : gs == 1 ? l[8 + j] : gs == 2 ? l[16 + j] : l[24 + j];
            int i1 = 0; float v1 = e8[0];
#pragma unroll
            for (int j = 1; j < 8; ++j) if (e8[j] > v1) { v1 = e8[j]; i1 = j; }
            int i2 = -1; float v2 = -INFINITY;
#pragma unroll
            for (int j = 0; j < 8; ++j) if (j != i1 && e8[j] > v2) { v2 = e8[j]; i2 = j; }
            const float e2 = __expf(v2 - v1); const float p1 = 1.0f / (1.0f + e2);
            es[F.tid * 2] = gs * 8 + i1; es[F.tid * 2 + 1] = gs * 8 + i2; wsl[F.tid * 2] = p1 * gate; wsl[F.tid * 2 + 1] = (1.0f - p1) * gate; }
        __syncthreads();
        if (F.tid < 32) { int cnt = 0; for (int i = 0; i < 128; ++i) if (es[i] == F.tid) lr[i] = cnt++;
            if (cnt) { const int base = (int)__hip_atomic_fetch_add(F.ctl + CW_CNT + cset * 32 + F.tid, (unsigned)cnt, __ATOMIC_RELAXED, __HIP_MEMORY_SCOPE_AGENT);
                for (int i = 0; i < 128; ++i) if (es[i] == F.tid) lr[i] += base; } }
        __syncthreads();
        if (F.tid < 64) { int* rt = (int*)(F.ws + WS_ROUTE) + ((size_t)blk * 64 + F.tid) * 8;
            rt[0] = es[F.tid * 2]; rt[1] = es[F.tid * 2 + 1]; ((float*)rt)[2] = wsl[F.tid * 2]; ((float*)rt)[3] = wsl[F.tid * 2 + 1]; rt[4] = lr[F.tid * 2]; rt[5] = lr[F.tid * 2 + 1]; ((float*)rt)[6] = rsd[F.tid]; }
    }
    __syncthreads();
    if (F.tid == 0) __hip_atomic_fetch_add(F.ctl + CW_RB + 64 * layer, 1u, __ATOMIC_RELAXED, __HIP_MEMORY_SCOPE_AGENT);
}
__device__ __forceinline__ void phase_moe_convert(const Frame& F_, int layer) { Frame F = relocal(F_);
    bf16_t* WGU = (bf16_t*)(F.ws + WS_MOE + MOE_WGU);
    for (int t = F.bid; t < 1024; t += F.G) {
        const int e = t >> 5, r = t & 31, kt = r >> 1, nt = r & 1; const size_t eo = ((size_t)layer * 32 + e) * 1024 * 256;
        tr_tile(F, 256, WGU + (size_t)e * 512 * 1024, 1024, kt * 64, nt * 256, SmGU{F.in[I_WGATE] + eo, F.in[I_WUP] + eo}); }
}
__device__ __forceinline__ void phase_moe_convert_down(const Frame& F_, int layer) { Frame F = relocal(F_);
    bf16_t* WD = (bf16_t*)(F.ws + WS_MOE + MOE_WD);
    for (;;) { const int q = q_pop(F, 32 + layer); if (q >= 512) break;
        const int e = q >> 4, r = q & 15, kt = r >> 2, nt = r & 3;
        tr_tile(F, 1024, WD + (size_t)e * 1024 * 256, 256, kt * 64, nt * 256, SmId{F.in[I_WDOWN] + ((size_t)layer * 32 + e) * 256 * 1024}); }
}
__device__ __forceinline__ void phase_gather(const Frame& F_, int layer) { Frame F = relocal(F_);
    LAS int* off = (LAS int*)F.lds;
    __syncthreads();
    if (F.tid == 0) { unsigned sp = 0;
        while (__hip_atomic_load(F.ctl + CW_RB + 64 * layer, __ATOMIC_RELAXED, __HIP_MEMORY_SCOPE_AGENT) < (unsigned)F.G) { __builtin_amdgcn_s_sleep(2); if (++sp > (1u << 22)) break; } }
    __syncthreads();
    if (F.tid == 0) { int acc = 0; for (int e = 0; e < 32; ++e) { off[e] = acc; const int c = (int)__hip_atomic_load(F.ctl + CW_CNT + layer * 32 + e, __ATOMIC_RELAXED, __HIP_MEMORY_SCOPE_AGENT); acc += (c + 255) & ~255; } off[32] = acc; }
    __syncthreads();
    int* tiles = (int*)(F.ws + WS_TILES); int* row_tok = (int*)(F.ws + WS_ROWS); float* row_w = (float*)(F.ws + WS_ROWS) + MAXROWS;
    if (F.bid == 0) { if (F.tid == 0) tiles[0] = off[32] >> 8; if (F.tid < 33) tiles[1 + F.tid] = off[F.tid];
        if (F.tid < 32) for (int rt = off[F.tid] >> 8; rt < (off[F.tid + 1] >> 8); ++rt) tiles[64 + rt] = F.tid; }
    for (int e = F.bid; e < 32; e += F.G) { const int c = (int)__hip_atomic_load(F.ctl + CW_CNT + layer * 32 + e, __ATOMIC_RELAXED, __HIP_MEMORY_SCOPE_AGENT);
        for (int r = off[e] + c + F.tid; r < off[e + 1]; r += NTHR) { row_tok[r] = -1; row_w[r] = 0.f; } }
    const float* X = (const float*)(F.ws + WS_X); bf16_t* HP = (bf16_t*)(F.ws + WS_U); const float* nw = F.in[I_NORM2] + (size_t)layer * DM;
    f32x4 nwv[4];
#pragma unroll
    for (int j = 0; j < 4; ++j) nwv[j] = *(const f32x4*)(nw + 4 * F.lane + 256 * j);
    for (int blk = F.bid; blk < NTOK / 64; blk += F.G)
    for (int i4 = 0; i4 < 2; ++i4) {
        int p0[4], p1[4], tt[4]; float rstd[4], w0[4], w1[4]; f32x4 xv[4][4];
#pragma unroll
        for (int r = 0; r < 4; ++r) { const int t = blk * 64 + F.wave * 8 + 4 * i4 + r; tt[r] = t;
            const int* rt = (const int*)(F.ws + WS_ROUTE) + (size_t)t * 8; rstd[r] = ((const float*)rt)[6]; w0[r] = ((const float*)rt)[2]; w1[r] = ((const float*)rt)[3];
            p0[r] = off[rt[0]] + rt[4]; p1[r] = off[rt[1]] + rt[5];
#pragma unroll
            for (int j = 0; j < 4; ++j) xv[r][j] = *(const f32x4*)(X + (size_t)t * DM + 4 * F.lane + 256 * j); }
#pragma unroll
        for (int r = 0; r < 4; ++r) {
#pragma unroll
            for (int j = 0; j < 4; ++j) { const int c = 4 * F.lane + 256 * j; const f32x4 v = xv[r][j] * rstd[r] * nwv[j];
                u32x2 o; o.x = pk2(v[0], v[1]); o.y = pk2(v[2], v[3]);
                *(u32x2*)(HP + (size_t)tt[r] * DM + c) = o; }
            if (F.lane == 0) { row_tok[p0[r]] = tt[r] * 2; row_w[p0[r]] = w0[r]; row_tok[p1[r]] = tt[r] * 2 + 1; row_w[p1[r]] = w1[r]; } }
    }
}

constexpr int NPH_LAYER = 9, NPHASE = 1 + 2 * NPH_LAYER + 1;
#ifndef MK_ONLY
#define MK_ONLY -1
#endif
#ifndef MK_ITEM
#define MK_ITEM -1
#endif
#define EN(o) (MK_ONLY < 0 || MK_ONLY == (o))
#define IT(o) (MK_ITEM < 0 || MK_ITEM == (o))
__global__ void __launch_bounds__(NTHR, 2) mk_forward(Params P) {
    extern __shared__ __attribute__((aligned(16))) unsigned char lds_raw[];
    Frame F; F.lds = (LAS unsigned char*)lds_raw; F.tid = threadIdx.x; F.lane = F.tid & 63; F.wave = __builtin_amdgcn_readfirstlane(F.tid >> 6); F.bid = blockIdx.x; F.G = gridDim.x;
    F.in = (in_tab_t)__builtin_amdgcn_kernarg_segment_ptr(); F.out = P.out; F.ws = P.ws; F.ctl = (unsigned*)(P.ws + WS_CTL); F.misc = (volatile LAS int*)(F.lds + MISC_OFF);
    if (F.tid < 64) ((LAS unsigned*)(F.lds + MISC_OFF))[F.tid] = 0u;
    __syncthreads();
    const int lo = P.ph_lo, hi = P.ph_hi;
    XcdBarrier bar; bar.bar = F.ctl + CW_BAR; bar.x = 0; bar.st = (volatile LAS unsigned*)(F.lds + MISC_OFF + 16);
    if (hi - lo > 1) bar = xcd_barrier_post(F.ctl + CW_BAR, (volatile LAS unsigned*)(F.lds + MISC_OFF + 16));
#define IN(k) (lo <= (k) && (k) < hi)
#define SEAM(k) do { if (IN(k) && IN((k) + 1)) xcd_barrier(bar); } while (0)
#define QLOOP(qi, n, body) for (;;) { const int it = q_pop(F, layer * 12 + (qi)); if (it >= (n)) break; body; }
    if (EN(100) && IN(0)) { phase_prologue(F); phase_norm(F, F.in[I_X], false, F.in[I_NORM1], 3); } SEAM(0);
#pragma unroll
    for (int layer = 0; layer < DEPTH; ++layer) {
        const int pb = 1 + layer * NPH_LAYER;
        if (layer > 0) { if (EN(0) && IN(pb + 0)) { phase_norm(F, (const float*)(F.ws + WS_X), true, F.in[I_NORM1] + (size_t)layer * DM, 0); } SEAM(pb + 0); }
        if (EN(1) && IN(pb + 1)) { const Frame F_ = F; Frame F = relocal(F_); pg8::StaticOrder S; S.init((const bf16_t*)(F.ws + WS_H), (const bf16_t*)(F.ws + WS_WIN) + (size_t)layer * NINP * DM, NTOK, NINP, DM, F.G, F.bid);
            pg8::EpiBf16 E{(bf16_t*)(F.ws + WS_U), NINP}; pg8::gemm_phase(F.lds, DM, S, E); } SEAM(pb + 1);
#define SLOOP(n, body) for (int it = F.bid; it < (n); it += F.G) { __syncthreads(); body; }
        if (EN(2) && IN(pb + 2)) {
            if (IT(1)) SLOOP(1024, item_rwkv1(F, layer, it));
            if (IT(0)) SLOOP(256, item_s5<1>(F, layer, it));
            if (IT(2)) SLOOP(256, item_mamba<1>(F, layer, it));
            if (IT(3)) SLOOP(256, item_kv(F, layer, it));
        } SEAM(pb + 2);
        if (EN(3) && IN(pb + 3)) {
            if (IT(0)) SLOOP(8, item_rwkv_carry(F, it));
            if (IT(1)) { for (int it = F.bid - 8; it >= 0 && it < 16; it += F.G) { __syncthreads(); item_mamba_carry(F, it); } }
            if (IT(2)) { for (int it = F.bid - 24; it >= 0 && it < 4; it += F.G) { __syncthreads(); item_s5_carry(F, layer, it); } }
            if (IT(3)) {
                dsa_tables(F);
                const int pref = (int)(xb_xcc_id() & 3u);
#pragma unroll 1
                for (int k4 = 0; k4 < 4; ++k4) { const int bq = (pref + k4) & 3;
                    for (;;) { const int it = q_pop(F, 24 + layer * 4 + bq); if (it >= 512) break; item_dsa(F, layer, it * 4 + bq); } } }
        } SEAM(pb + 3);
        if (EN(4) && IN(pb + 4)) {
            if (IT(0)) SLOOP(256, item_s5<2>(F, layer, it));
            if (IT(2)) SLOOP(256, item_mamba<2>(F, layer, it));
            if (IT(1)) SLOOP(1024, item_rwkv3(F, layer, it));
        } SEAM(pb + 4);
        if (EN(6) && IN(pb + 5)) { const Frame F_ = F; Frame F = relocal(F_); pg8::StaticOrder S; S.init((const bf16_t*)(F.ws + WS_H), (const bf16_t*)(F.ws + WS_WOUT) + (size_t)layer * DM * DM, NTOK, DM, DM, F.G, F.bid);
            pg8::EpiResid E{layer == 0 ? F.in[I_X] : (const float*)(F.ws + WS_X), (float*)(F.ws + WS_X), DM}; pg8::gemm_phase(F.lds, DM, S, E); } SEAM(pb + 5);
        if (EN(7) && IN(pb + 6)) { phase_router(F, layer); phase_moe_convert(F, layer); phase_gather(F, layer); } SEAM(pb + 6);
        if (EN(8) && IN(pb + 7)) { const Frame F_ = F; Frame F = relocal(F_); LAS int* ul = (LAS int*)(F.lds + pg8::STAGE_BYTES + 8192); if (F.tid == 0) pg8::MoeOrder::build(ul, (const int*)(F.ws + WS_TILES), 2, F.G, F.bid); __syncthreads();
            pg8::MoeOrder S{DM, (const char*)(F.ws + WS_U), (const char*)(F.ws + WS_MOE + MOE_WGU), (size_t)512 * 1024 * 2, ul};
            pg8::EpiGated<1> E{(bf16_t*)(F.ws + WS_H), 256, 0, nullptr, nullptr}; pg8::gemm_phase<pg8::EpiGated<1>, pg8::MoeOrder, true>(F.lds, DM, S, E, (const char*)(F.ws + WS_U), (const int*)(F.ws + WS_ROWS)); phase_moe_convert_down(F, layer); } SEAM(pb + 7);
        if (EN(9) && IN(pb + 8)) { const Frame F_ = F; Frame F = relocal(F_); LAS int* ul = (LAS int*)(F.lds + pg8::STAGE_BYTES + 8192); if (F.tid == 0) pg8::MoeOrder::build(ul, (const int*)(F.ws + WS_TILES), 4, F.G, F.bid); __syncthreads();
            pg8::MoeOrder S{256, (const char*)(F.ws + WS_H), (const char*)(F.ws + WS_MOE + MOE_WD), (size_t)1024 * 256 * 2, ul};
            pg8::EpiMoeOut E{(bf16_t*)(F.ws + WS_U), (const int*)(F.ws + WS_ROWS), (const float*)(F.ws + WS_ROWS) + MAXROWS, F.lds}; pg8::gemm_phase(F.lds, 256, S, E); } SEAM(pb + 8);
    }
    if (EN(101) && IN(NPHASE - 1)) { phase_norm(F, (const float*)(F.ws + WS_X), true, F.in[I_FNORM], 2); }
#undef IN
#undef SEAM
}

#ifndef MK_SPLIT
#define MK_SPLIT 0
#endif
extern "C" void kernel_launch(void* const* d_in, const int* in_sizes, int n_in, void* d_out, int out_size, void* d_ws, size_t ws_size, hipStream_t stream) {
    static int grid = 0;
    if (grid == 0) {
        if (n_in != 44 || out_size != NTOK * DM || ws_size < WS_END) { fprintf(stderr, "kernel_launch: unexpected shapes (n_in %d out %d ws %zu need %zu)\n", n_in, out_size, ws_size, (size_t)WS_END); grid = -1; return; }
        int dev = 0, cus = 0;
        if (hipGetDevice(&dev) != hipSuccess || hipDeviceGetAttribute(&cus, hipDeviceAttributeMultiprocessorCount, dev) != hipSuccess) { grid = -1; return; }
        if (hipFuncSetAttribute((const void*)mk_forward, hipFuncAttributeMaxDynamicSharedMemorySize, LDS_BYTES) != hipSuccess) { fprintf(stderr, "kernel_launch: hipFuncSetAttribute failed\n"); grid = -1; return; }
        int per_cu = 0;
        if (hipOccupancyMaxActiveBlocksPerMultiprocessor(&per_cu, (const void*)mk_forward, NTHR, LDS_BYTES) != hipSuccess || per_cu < 1) { fprintf(stderr, "kernel_launch: occupancy query says %d\n", per_cu); }
        (void)hipGetLastError();
        grid = cus;
    }
    if (grid < 0) return;
    hipMemsetAsync((char*)d_ws + WS_CTL, 0, CTL_BYTES, stream);
    Params p{};
    for (int i = 0; i < 44; ++i) p.in[i] = (const float*)d_in[i];
    p.out = (float*)d_out; p.ws = (unsigned char*)d_ws;
#if MK_SPLIT
    for (int ph = 0; ph < NPHASE; ++ph) { p.ph_lo = ph; p.ph_hi = ph + 1; hipLaunchKernelGGL(mk_forward, dim3(grid), dim3(NTHR), LDS_BYTES, stream, p); }
#else
    p.ph_lo = 0; p.ph_hi = NPHASE; hipLaunchKernelGGL(mk_forward, dim3(grid), dim3(NTHR), LDS_BYTES, stream, p);
#endif
}
```

```cpp
#include <hip/hip_runtime.h>
#include <stdint.h>
#include <stdio.h>

#define LAS __attribute__((address_space(3)))
typedef unsigned short bf16_t;
typedef short bf16x8 __attribute__((ext_vector_type(8)));
typedef float f32x4 __attribute__((ext_vector_type(4)));
typedef float f32x2 __attribute__((ext_vector_type(2)));
typedef float f32x16 __attribute__((ext_vector_type(16)));
typedef unsigned u32x4 __attribute__((ext_vector_type(4)));
typedef unsigned u32x2 __attribute__((ext_vector_type(2)));

constexpr int NTOK = 16384, DM = 1024, SEQ = 4096, NBATCH = 4, DEPTH = 2;
constexpr int NIN = 2604, NINP = 2816;
constexpr int UM = 0;
constexpr int UR = 784;
constexpr int UC = 1680;
constexpr int US = 2368;
constexpr int NTHR = 512;
constexpr int LDS_BYTES = 163840;
constexpr int MISC_OFF = LDS_BYTES - 256;

constexpr size_t WS_CTL   = 0;
constexpr size_t CTL_BYTES = 65536;
constexpr size_t WS_X     = WS_CTL + CTL_BYTES;
constexpr size_t WS_H     = WS_X + (size_t)NTOK * DM * 4;
constexpr size_t WS_U     = WS_H + (size_t)NTOK * DM * 2;
constexpr size_t WS_WIN   = WS_U + (size_t)NTOK * NINP * 2;
constexpr size_t WS_WOUT  = WS_WIN + (size_t)2 * NINP * DM * 2;
constexpr size_t WS_GLU   = WS_WOUT + (size_t)2 * DM * DM * 2;
constexpr size_t WS_MOE   = WS_GLU + (size_t)2 * 512 * 256 * 2;
constexpr size_t MOE_WGU  = 0;
constexpr size_t MOE_WD   = (size_t)32 * 512 * 1024 * 2;
constexpr size_t MOE_BYTES = MOE_WD + (size_t)32 * 1024 * 256 * 2;
constexpr size_t RW_PT    = 0;
constexpr size_t RW_U     = (size_t)1024 * 4096 * 2;
constexpr size_t RW_S     = RW_U + (size_t)1024 * 4096 * 2;
constexpr size_t RW_W1    = RW_S + (size_t)1024 * 4096 * 2;
constexpr size_t RW_Z     = RW_W1 + (size_t)1024 * 4096 * 2;
constexpr size_t YSG_OFF  = RW_Z + (size_t)1024 * 4096 * 2;
static_assert(YSG_OFF + (size_t)NTOK * 256 * 2 <= MOE_BYTES, "alias");
constexpr size_t WS_MST   = WS_MOE + MOE_BYTES;
constexpr size_t WS_MDEC  = WS_MST + (size_t)4 * 64 * 4 * 4096 * 4;
constexpr size_t WS_S5ST  = WS_MDEC + 4096;
constexpr size_t WS_K     = WS_S5ST + (size_t)4 * 64 * 2048 * 4;
constexpr size_t WS_V     = WS_K + (size_t)NTOK * 64 * 2;
constexpr size_t WS_KIDX  = WS_V + (size_t)NTOK * 64 * 2;
constexpr size_t WS_ROUTE = WS_KIDX + (size_t)NTOK * 32 * 2;
constexpr size_t WS_ROWS  = WS_ROUTE + (size_t)NTOK * 32;
constexpr int    MAXROWS  = 49152;
constexpr size_t WS_TILES = WS_ROWS + (size_t)MAXROWS * 8;
constexpr size_t WS_S5TAB = WS_TILES + 4096;
constexpr size_t S5TAB_F  = (size_t)(2048 + 2048 + 32768) * 4;
constexpr size_t S5TAB_BBT = S5TAB_F + (size_t)16 * 16 * 128 * 2;
constexpr size_t S5TAB_L  = S5TAB_BBT + (size_t)16 * 128 * 16 * 2;
constexpr size_t WS_WRT   = WS_S5TAB + 2 * S5TAB_L;
constexpr size_t WS_BON   = WS_WRT + (size_t)2 * 2 * 48 * 1024 * 2;
constexpr size_t WS_END   = WS_BON + (size_t)1024 * 64 * 4;

constexpr int CW_BAR = 0;
constexpr int CW_Q   = 4096;
constexpr int CW_CNT = 8192;
constexpr int CW_RB  = 8448;

__device__ __forceinline__ float bf2f(bf16_t b) { return __uint_as_float(((unsigned)b) << 16); }
__device__ __forceinline__ bf16_t f2bf(float f) { const __bf16 h = (__bf16)f; return __builtin_bit_cast(bf16_t, h); }
__device__ __forceinline__ unsigned pk2(float lo, float hi) { typedef __bf16 bf2_t __attribute__((ext_vector_type(2))); const bf2_t h = __builtin_convertvector((f32x2){lo, hi}, bf2_t); return __builtin_bit_cast(unsigned, h); }
__device__ __forceinline__ unsigned cvt_pk_bf16(float lo, float hi) { unsigned r; asm volatile("v_cvt_pk_bf16_f32 %0, %1, %2" : "=v"(r) : "v"(lo), "v"(hi)); return r; }
__device__ __forceinline__ float sigmoidf_(float x) { return 1.0f / (1.0f + __expf(-x)); }
__device__ __forceinline__ float siluf_(float x) { return x / (1.0f + __expf(-x)); }
__device__ __forceinline__ float tanhf_(float x) { const float e = __expf(2.0f * x); return 1.0f - 2.0f / (e + 1.0f); }
__device__ __forceinline__ float softplusf_(float x) { return fmaxf(x, 0.0f) + log1pf(__expf(-fabsf(x))); }
__device__ __forceinline__ float gelu_tanh(float x) { return 0.5f * x * (1.0f + tanhf_(0.7978845608028654f * (x + 0.044715f * x * x * x))); }
template <int CTRL> __device__ __forceinline__ float dppf(float x) { return __int_as_float(__builtin_amdgcn_update_dpp(0, __float_as_int(x), CTRL, 0xF, 0xF, true)); }
__device__ __forceinline__ float sum4(float x) { x += dppf<0xB1>(x); x += dppf<0x4E>(x); return x; }
__device__ __forceinline__ float sum8(float x) { x = sum4(x); x += dppf<0x141>(x); return x; }
__device__ __forceinline__ float sum16(float x) { x = sum8(x); x += dppf<0x140>(x); return x; }
__device__ __forceinline__ int lane_id_() { int l = (int)__builtin_amdgcn_mbcnt_hi(~0u, __builtin_amdgcn_mbcnt_lo(~0u, 0u)); asm volatile("" : "+v"(l)); return l; }
__device__ __forceinline__ float shx(float x, int o) { return __int_as_float(__builtin_amdgcn_ds_bpermute((lane_id_() ^ o) << 2, __float_as_int(x))); }
__device__ __forceinline__ unsigned shdown_u(unsigned x, int o) { return (unsigned)__builtin_amdgcn_ds_bpermute(((lane_id_() + o) & 63) << 2, (int)x); }
__device__ __forceinline__ int shidx_i(int x, int src) { return __builtin_amdgcn_ds_bpermute(src << 2, x); }
template <class OP> __device__ __forceinline__ float xrows(float x, OP op) {
    u32x2 r = __builtin_amdgcn_permlane16_swap(__float_as_uint(x), __float_as_uint(x), false, false); x = op(__uint_as_float(r[0]), __uint_as_float(r[1]));
    r = __builtin_amdgcn_permlane32_swap(__float_as_uint(x), __float_as_uint(x), false, false); return op(__uint_as_float(r[0]), __uint_as_float(r[1])); }
struct OpAdd { __device__ __forceinline__ float operator()(float a, float b) const { return a + b; } };
struct OpMin { __device__ __forceinline__ float operator()(float a, float b) const { return fminf(a, b); } };
struct OpMax { __device__ __forceinline__ float operator()(float a, float b) const { return fmaxf(a, b); } };
__device__ __forceinline__ float wave_sum(float x) { x = sum16(x); return xrows(x, OpAdd()); }
__device__ __forceinline__ float wave_min(float x) { x = fminf(x, dppf<0xB1>(x)); x = fminf(x, dppf<0x4E>(x)); x = fminf(x, dppf<0x141>(x)); x = fminf(x, dppf<0x140>(x)); return xrows(x, OpMin()); }
__device__ __forceinline__ float wave_max(float x) { x = fmaxf(x, dppf<0xB1>(x)); x = fmaxf(x, dppf<0x4E>(x)); x = fmaxf(x, dppf<0x141>(x)); x = fmaxf(x, dppf<0x140>(x)); return xrows(x, OpMax()); }
template <int CTRL, int RM, bool BC> __device__ __forceinline__ float dpp_addf(float x) { return x + __int_as_float(__builtin_amdgcn_update_dpp(0, __float_as_int(x), CTRL, RM, 0xF, BC)); }
__device__ __forceinline__ float wave_prefix_f(float x) { x = dpp_addf<0x111, 0xF, true>(x); x = dpp_addf<0x112, 0xF, true>(x); x = dpp_addf<0x114, 0xF, true>(x); x = dpp_addf<0x118, 0xF, true>(x);
    x = dpp_addf<0x142, 0xA, false>(x); return dpp_addf<0x143, 0xC, false>(x); }
__device__ __forceinline__ unsigned wave_prefix_u(unsigned x) { int v = (int)x;
    v += __builtin_amdgcn_update_dpp(0, v, 0x111, 0xF, 0xF, true); v += __builtin_amdgcn_update_dpp(0, v, 0x112, 0xF, 0xF, true);
    v += __builtin_amdgcn_update_dpp(0, v, 0x114, 0xF, 0xF, true); v += __builtin_amdgcn_update_dpp(0, v, 0x118, 0xF, 0xF, true);
    v += __builtin_amdgcn_update_dpp(0, v, 0x142, 0xA, 0xF, false); v += __builtin_amdgcn_update_dpp(0, v, 0x143, 0xC, 0xF, false); return (unsigned)v; }
__device__ __forceinline__ void unpack8(const u32x4 v, float (&f)[8]) {
    f[0] = __uint_as_float(v.x << 16); f[1] = __uint_as_float(v.x & 0xffff0000u); f[2] = __uint_as_float(v.y << 16); f[3] = __uint_as_float(v.y & 0xffff0000u);
    f[4] = __uint_as_float(v.z << 16); f[5] = __uint_as_float(v.z & 0xffff0000u); f[6] = __uint_as_float(v.w << 16); f[7] = __uint_as_float(v.w & 0xffff0000u);
}

__device__ __forceinline__ void st16_wt(void* p, u32x4 v) { asm volatile("global_store_dwordx4 %0, %1, off sc1\n\ts_nop 1" :: "v"(p), "v"(v) : "memory"); }
#define XB_TMO      128
#define XB_XCNT(j)  (256  + 64 * (j))
#define XB_XSUB(j)  (1280 + 64 * (j))
#define XB_XGEN(j)  (2304 + 64 * (j))
#define XB_TOP      3328
#define XB_TOPGEN   3392
#define XCD_BAR_WORDS 3456
#define XB_SPIN_CAP (1u << 22)
__device__ __forceinline__ unsigned xb_ld(unsigned* p)              { return __hip_atomic_load(p, __ATOMIC_RELAXED, __HIP_MEMORY_SCOPE_AGENT); }
__device__ __forceinline__ unsigned xb_add(unsigned* p, unsigned v) { return __hip_atomic_fetch_add(p, v, __ATOMIC_RELAXED, __HIP_MEMORY_SCOPE_AGENT); }
__device__ __forceinline__ unsigned xb_xcc_id() { return (unsigned)__builtin_amdgcn_s_getreg((3 << 11) | 20) & 0xFu; }
#define XB_SPIN(cond, bar) do { unsigned _sp = 0; while (cond) { __builtin_amdgcn_s_sleep(1); \
    if ((++_sp & 255u) == 0u) { if (xb_ld(&(bar)[XB_TMO])) break; if (_sp > XB_SPIN_CAP) { atomicAdd(&(bar)[XB_TMO], 1u); break; } } } } while (0)
struct XcdBarrier { unsigned* bar; unsigned x; volatile LAS unsigned* st; };
__device__ __forceinline__ XcdBarrier xcd_barrier_post(unsigned* bar, volatile LAS unsigned* st) {
    XcdBarrier b; b.bar = bar; b.x = xb_xcc_id(); b.st = st;
    if (threadIdx.x == 0) (void)xb_add(&bar[XB_XCNT(b.x)], 1u);
    return b;
}
__device__ __forceinline__ void xcd_barrier_complete(unsigned* bar, unsigned x, unsigned& nloc, unsigned& nx) {
    const unsigned G = gridDim.x * gridDim.y * gridDim.z;
    unsigned sum, cnt, mine, sp = 0u;
    for (;;) {
        sum = 0u; cnt = 0u; mine = 0u;
#pragma unroll
        for (unsigned j = 0; j < 16; ++j) { const unsigned c = xb_ld(&bar[XB_XCNT(j)]); sum += c; cnt += (c > 0u) ? 1u : 0u; mine = (j == x) ? c : mine; }
        if (sum == G) break;
        __builtin_amdgcn_s_sleep(1);
        if ((++sp & 255u) == 0u) { if (xb_ld(&bar[XB_TMO])) break; if (sp > XB_SPIN_CAP) { atomicAdd(&bar[XB_TMO], 1u); break; } }
    }
    nloc = mine > 0u ? mine : 1u; nx = cnt > 0u ? cnt : 1u;
}
__device__ __forceinline__ void xcd_barrier(const XcdBarrier& b_) {
    XcdBarrier b = b_; { const unsigned long long v = (unsigned long long)b.bar; unsigned lo = __builtin_amdgcn_readfirstlane((unsigned)v), hi = __builtin_amdgcn_readfirstlane((unsigned)(v >> 32)); asm volatile("" : "+s"(lo), "+s"(hi)); b.bar = (unsigned*)(((unsigned long long)hi << 32) | lo); unsigned xx = __builtin_amdgcn_readfirstlane(b.x); asm volatile("" : "+s"(xx)); b.x = xx; }
    asm volatile("s_waitcnt vmcnt(0)" ::: "memory");
    __syncthreads();
    if (threadIdx.x == 0) {
        unsigned* bar = b.bar;
        __builtin_amdgcn_s_waitcnt(0);
        unsigned nloc = b.st[0], nx = b.st[1];
        if (nloc == 0u) { xcd_barrier_complete(bar, b.x, nloc, nx); b.st[0] = nloc; b.st[1] = nx; }
        const unsigned old = xb_add(&bar[XB_XSUB(b.x)], 1u);
        const unsigned gen = old / nloc;
        if (old + 1u == (gen + 1u) * nloc) {
            __builtin_amdgcn_fence(__ATOMIC_RELEASE, "agent");
            asm volatile("s_waitcnt vmcnt(0)" ::: "memory");
            const unsigned og = xb_add(&bar[XB_TOP], 1u);
            const unsigned tg = og / nx;
            if (og + 1u == (tg + 1u) * nx) xb_add(&bar[XB_TOPGEN], 1u);
            else XB_SPIN(xb_ld(&bar[XB_TOPGEN]) == tg, bar);
            __builtin_amdgcn_fence(__ATOMIC_ACQUIRE, "agent");
            xb_add(&bar[XB_XGEN(b.x)], 1u);
            asm volatile("s_waitcnt vmcnt(0)" ::: "memory");
        } else {
            XB_SPIN(xb_ld(&bar[XB_XGEN(b.x)]) == gen, bar);
            __builtin_amdgcn_fence(__ATOMIC_ACQUIRE, "agent");
            asm volatile("s_waitcnt vmcnt(0)" ::: "memory");
        }
    }
    __syncthreads();
}

namespace pg8 {
constexpr int BM = 256, BK = 64, HALF = 128, HTB = HALF * BK * 2, STAGE_BYTES = 8 * HTB, NXCD = 8, WGM = 8;
__host__ __device__ __forceinline__ int lds_byte(int r, int c) { const int st = (r >> 4) * 2 + (c >> 5), rr = r & 15, cc = c & 31, ob = rr * 64 + cc * 2; return st * 1024 + (ob ^ (((ob >> 9) & 1) << 5)); }
__host__ __device__ __forceinline__ void stage_rc(int b, int& R, int& C) { const int st = b / 1024, sb = b % 1024, swz = sb ^ (((sb >> 9) & 1) << 5); R = (st >> 1) * 16 + swz / 64; C = (st & 1) * 32 + (swz % 64) / 2; }
__host__ __device__ __forceinline__ int perm32(int rho) { const int n = rho >> 4, i = rho & 15; return 8 * (i >> 2) + 4 * n + (i & 3); }
struct Unit { int pm, pn; const char* a; const char* b; };

struct StaticOrder {
    int nM, nN, nwg, G, c, K; const char* A; const char* B;
    __device__ void init(const bf16_t* A_, const bf16_t* B_, int M, int N, int K_, int G_, int c_) { A = (const char*)A_; B = (const char*)B_; K = K_; nM = M / BM; nN = N / BM; nwg = nM * nN; G = G_; c = c_; }
    __device__ bool next(int i, Unit& u) const {
        const long L = (long)i * G + c; if (L >= nwg) return false;
        int wgid = (int)L; { const int q = nwg / NXCD, r = nwg % NXCD, xcd = wgid % NXCD, off = wgid / NXCD; wgid = (xcd < r ? xcd * (q + 1) : r * (q + 1) + (xcd - r) * q) + off; }
        const int nig = WGM * nN, gid = wgid / nig, fm = gid * WGM, gsz = (nM - fm) < WGM ? (nM - fm) : WGM;
        u.pm = fm + ((wgid % nig) % gsz); u.pn = (wgid % nig) / gsz;
        u.a = A + (size_t)u.pm * 256 * K * 2; u.b = B + (size_t)u.pn * 256 * K * 2; return true;
    }
};

template <class Epi, class Sched, bool GATHER = false>
__device__ __forceinline__ void gemm_phase(LAS unsigned char* lds, const int K_, const Sched& S, const Epi& E, const char* Aall = nullptr, const int* arow = nullptr) {
    int K = K_; asm volatile("" : "+s"(K));
    int tid_ = threadIdx.x; asm volatile("" : "+v"(tid_));
    const int tid = tid_, wid = __builtin_amdgcn_readfirstlane(tid >> 6), lane = tid & 63, wr = wid >> 2, wc = wid & 3, fr = lane & 15, fq = lane >> 4;
    const int nt = K / BK;
    unsigned voffA[2], voffB[2]; int Rst[2], Cst[2];
#pragma unroll
    for (int i = 0; i < 2; ++i) { int R, C; stage_rc(tid * 16 + i * 8192, R, C); const int Rb = Epi::PERM ? ((R & ~31) + perm32(R & 31)) : R; Rst[i] = R; Cst[i] = C;
        voffA[i] = (unsigned)(R * K + C) * 2u; voffB[i] = (unsigned)(Rb * K + C) * 2u; }
    unsigned gv[2][2], gn[2][2];
#define PG8_GOFF(dst, unit) do { _Pragma("unroll") for (int h_ = 0; h_ < 2; ++h_) _Pragma("unroll") for (int i_ = 0; i_ < 2; ++i_) { const int rr_ = arow[(unit).pm * BM + h_ * HALF + Rst[i_]]; \
        dst[h_][i_] = ((unsigned)(rr_ < 0 ? 0 : rr_ >> 1) * (unsigned)K + (unsigned)Cst[i_]) * 2u; } } while (0)
    const size_t kstep = (size_t)(BK * 2);
    const size_t hstep = (size_t)HALF * K * 2;
    const unsigned ldsw = (unsigned)wid * 1024u;
    const int aoff = lds_byte(wr * 64 + fr, fq * 8), boff = lds_byte(wc * 32 + fr, fq * 8);
#define PG8_SA(b, h) (((b) * 2 + (h)) * HTB)
#define PG8_SB(b, h) ((4 + (b) * 2 + (h)) * HTB)
#define PG8_STAGE(bufoff, gbase, voff) do { _Pragma("unroll") for (int _i = 0; _i < 2; ++_i) \
        __builtin_amdgcn_global_load_lds((const unsigned*)((const char*)(gbase) + (voff)[_i]), (LAS unsigned*)(lds + (bufoff) + ldsw + _i * 8192), 16, 0, 0); } while (0)
#define PG8_LDA(dst, b, h) do { _Pragma("unroll") for (int m = 0; m < 4; ++m) _Pragma("unroll") for (int k = 0; k < 2; ++k) dst[m][k] = *(const LAS bf16x8*)(lds + PG8_SA(b, h) + aoff + m * 2048 + k * 1024); } while (0)
#define PG8_LDB(dst, b, h) do { _Pragma("unroll") for (int n = 0; n < 2; ++n) _Pragma("unroll") for (int k = 0; k < 2; ++k) dst[n][k] = *(const LAS bf16x8*)(lds + PG8_SB(b, h) + boff + n * 2048 + k * 1024); } while (0)
#define PG8_MMA(ai, bj, At, Bt) do { __builtin_amdgcn_s_setprio(1); _Pragma("unroll") for (int m = 0; m < 4; ++m) _Pragma("unroll") for (int n = 0; n < 2; ++n) _Pragma("unroll") for (int k = 0; k < 2; ++k) \
        acc[ai][bj][m][n] = __builtin_amdgcn_mfma_f32_16x16x32_bf16(Bt[n][k], At[m][k], acc[ai][bj][m][n], 0, 0, 0); __builtin_amdgcn_s_setprio(0); } while (0)
#define PG8_WAIT_V(n) asm volatile("s_waitcnt vmcnt(" #n ")" ::: "memory")
#define PG8_WAIT_L(n) asm volatile("s_waitcnt lgkmcnt(" #n ")" ::: "memory")
#define PG8_BAR __builtin_amdgcn_s_barrier()
#define PG8_SCHED __builtin_amdgcn_sched_barrier(0)
    Unit cur, nxt; int ui = 0;
    if (!S.next(0, cur)) return;
    f32x4 acc[2][2][4][2];
#pragma unroll
    for (int a = 0; a < 2; ++a)
#pragma unroll
        for (int b = 0; b < 2; ++b)
#pragma unroll
            for (int m = 0; m < 4; ++m)
#pragma unroll
                for (int n = 0; n < 2; ++n) acc[a][b][m][n] = (f32x4){0.f, 0.f, 0.f, 0.f};
    bf16x8 At[4][2], B0[2][2], B1[2][2];
    const char* cA = GATHER ? Aall : cur.a; const char* cB = cur.b;
    if (GATHER) PG8_GOFF(gv, cur);
#define PG8_STAGE_A(bufoff, gbase, h, vo) do { if (GATHER) PG8_STAGE(bufoff, gbase, (vo)[h]); else PG8_STAGE(bufoff, (gbase) + ((h) ? hstep : 0), voffA); } while (0)
    PG8_STAGE(PG8_SB(0, 0), cB, voffB); PG8_STAGE_A(PG8_SA(0, 0), cA, 0, gv); PG8_STAGE(PG8_SB(0, 1), cB + hstep, voffB); PG8_STAGE_A(PG8_SA(0, 1), cA, 1, gv);
    if (wr == 1) PG8_BAR;
    PG8_WAIT_V(4); PG8_BAR;
    PG8_STAGE(PG8_SB(1, 0), cB + kstep, voffB); PG8_STAGE_A(PG8_SA(1, 0), cA + kstep, 0, gv); PG8_STAGE(PG8_SB(1, 1), cB + hstep + kstep, voffB);
    PG8_WAIT_V(6); PG8_BAR;
    for (;;) {
        const bool has_next = S.next(ui + 1, nxt);
        const char* nA = GATHER ? cA : (has_next ? nxt.a : cA); const char* nB = has_next ? nxt.b : cB;
        if (GATHER) { if (has_next) PG8_GOFF(gn, nxt); else {
#pragma unroll
            for (int h_ = 0; h_ < 2; ++h_)
#pragma unroll
                for (int i_ = 0; i_ < 2; ++i_) gn[h_][i_] = gv[h_][i_]; } }
        for (int t = 0; t < nt; t += 2) {
            const bool last = (t == nt - 2);
            const char* a1 = cA + (size_t)(t + 1) * kstep;
            const char* a2 = last ? nA : cA + (size_t)(t + 2) * kstep; const char* b2 = last ? nB : cB + (size_t)(t + 2) * kstep;
            const char* a3 = a2 + kstep; const char* b3 = b2 + kstep;
            unsigned vo2[2][2];
#pragma unroll
            for (int h_ = 0; h_ < 2; ++h_)
#pragma unroll
                for (int i_ = 0; i_ < 2; ++i_) vo2[h_][i_] = GATHER ? (last ? gn[h_][i_] : gv[h_][i_]) : 0u;
            PG8_LDB(B0, 0, 0); PG8_SCHED; PG8_LDA(At, 0, 0); PG8_STAGE_A(PG8_SA(1, 1), a1, 1, gv);
            PG8_WAIT_L(8); PG8_BAR; PG8_WAIT_L(0); PG8_MMA(0, 0, At, B0); PG8_BAR; PG8_SCHED;
            PG8_LDB(B1, 0, 1); PG8_STAGE(PG8_SB(0, 0), b2, voffB);
            PG8_BAR; PG8_WAIT_L(0); PG8_MMA(0, 1, At, B1); PG8_BAR;
            PG8_LDA(At, 0, 1); PG8_STAGE_A(PG8_SA(0, 0), a2, 0, vo2);
            PG8_BAR; PG8_WAIT_L(0); PG8_MMA(1, 0, At, B0); PG8_BAR; PG8_SCHED;
            PG8_STAGE(PG8_SB(0, 1), b2 + hstep, voffB);
            PG8_WAIT_V(6); PG8_BAR; PG8_MMA(1, 1, At, B1); PG8_BAR;
            PG8_LDB(B0, 1, 0); PG8_SCHED; PG8_LDA(At, 1, 0); PG8_STAGE_A(PG8_SA(0, 1), a2, 1, vo2);
            PG8_WAIT_L(8); PG8_BAR; PG8_WAIT_L(0); PG8_MMA(0, 0, At, B0); PG8_BAR; PG8_SCHED;
            PG8_LDB(B1, 1, 1); PG8_STAGE(PG8_SB(1, 0), b3, voffB);
            PG8_BAR; PG8_WAIT_L(0); PG8_MMA(0, 1, At, B1); PG8_BAR;
            PG8_LDA(At, 1, 1); PG8_STAGE_A(PG8_SA(1, 0), a3, 0, vo2);
            PG8_BAR; PG8_WAIT_L(0); PG8_MMA(1, 0, At, B0); PG8_BAR; PG8_SCHED;
            PG8_STAGE(PG8_SB(1, 1), b3 + hstep, voffB);
            PG8_WAIT_V(6); PG8_BAR; PG8_MMA(1, 1, At, B1); PG8_BAR;
        }
        E(acc, cur, wr, wc, fr, fq);
        if (!has_next) break;
#pragma unroll
        for (int a = 0; a < 2; ++a)
#pragma unroll
            for (int b = 0; b < 2; ++b)
#pragma unroll
                for (int m = 0; m < 4; ++m)
#pragma unroll
                    for (int n = 0; n < 2; ++n) acc[a][b][m][n] = (f32x4){0.f, 0.f, 0.f, 0.f};
        cur = nxt; cA = nA; cB = nB; ++ui;
        if (GATHER) {
#pragma unroll
            for (int h_ = 0; h_ < 2; ++h_)
#pragma unroll
                for (int i_ = 0; i_ < 2; ++i_) gv[h_][i_] = gn[h_][i_]; }
    }
    PG8_WAIT_V(0);
    if (wr == 0) PG8_BAR;
    PG8_BAR;
#undef PG8_SA
#undef PG8_SB
#undef PG8_STAGE
#undef PG8_STAGE_A
#undef PG8_GOFF
#undef PG8_LDA
#undef PG8_LDB
#undef PG8_MMA
#undef PG8_WAIT_V
#undef PG8_WAIT_L
#undef PG8_BAR
#undef PG8_SCHED
}

struct EpiBf16 {
    static constexpr bool PERM = true;
    bf16_t* O; int ldc;
    __device__ __forceinline__ void operator()(const f32x4 (&acc)[2][2][4][2], const Unit& u, int wr, int wc, int fr, int fq) const {
        const int row0 = u.pm * BM + wr * 64 + fr, col0 = u.pn * BM + wc * 32 + 8 * fq;
#pragma unroll
        for (int ai = 0; ai < 2; ++ai)
#pragma unroll
            for (int m = 0; m < 4; ++m) { bf16_t* rowp = O + (size_t)(row0 + ai * HALF + m * 16) * ldc + col0;
#pragma unroll
                for (int bj = 0; bj < 2; ++bj) { const f32x4 v0 = acc[ai][bj][m][0], v1 = acc[ai][bj][m][1];
                    u32x4 w; w.x = cvt_pk_bf16(v0[0], v0[1]); w.y = cvt_pk_bf16(v0[2], v0[3]); w.z = cvt_pk_bf16(v1[0], v1[1]); w.w = cvt_pk_bf16(v1[2], v1[3]);
                    st16_wt(rowp + bj * HALF, w); } }
    }
};
struct EpiResid {
    static constexpr bool PERM = false;
    const float* Cin; float* C; int ldc;
    __device__ __forceinline__ void operator()(const f32x4 (&acc)[2][2][4][2], const Unit& u, int wr, int wc, int fr_, int fq_) const {
        int fr = fr_, fq = fq_; asm volatile("" : "+v"(fr), "+v"(fq));
        const int row0 = u.pm * BM + wr * 64 + fr, col0 = u.pn * BM + wc * 32 + 4 * fq;
#pragma unroll
        for (int ai = 0; ai < 2; ++ai)
#pragma unroll
            for (int mp = 0; mp < 2; ++mp) { f32x4 cv[2][2][2];
#pragma unroll
                for (int mm = 0; mm < 2; ++mm) { const float* rowp = Cin + (size_t)(row0 + ai * HALF + (2 * mp + mm) * 16) * ldc + col0;
#pragma unroll
                    for (int bj = 0; bj < 2; ++bj)
#pragma unroll
                        for (int n = 0; n < 2; ++n) cv[mm][bj][n] = *(const f32x4*)(rowp + bj * HALF + n * 16); }
#pragma unroll
                for (int mm = 0; mm < 2; ++mm) { float* rowp = C + (size_t)(row0 + ai * HALF + (2 * mp + mm) * 16) * ldc + col0;
#pragma unroll
                    for (int bj = 0; bj < 2; ++bj)
#pragma unroll
                        for (int n = 0; n < 2; ++n) { const f32x4 o_ = cv[mm][bj][n] + acc[ai][bj][2 * mp + mm][n]; st16_wt(rowp + bj * HALF + n * 16, __builtin_bit_cast(u32x4, o_)); } }
                asm volatile("" ::: "memory"); }
    }
};
template <int ACT  > struct EpiGated {
    static constexpr bool PERM = true;
    bf16_t* O; int ldo; int coloff; const float* ba; const float* bb;
    __device__ __forceinline__ void operator()(const f32x4 (&acc)[2][2][4][2], const Unit& u, int wr, int wc, int fr, int fq) const {
        const int row0 = u.pm * BM + wr * 64 + fr, cl = u.pn * HALF + wc * 32 + 8 * fq;
        float va[8], vb[8];
#pragma unroll
        for (int j = 0; j < 8; ++j) { va[j] = (ACT == 0) ? ba[cl + j] : 0.f; vb[j] = (ACT == 0) ? bb[cl + j] : 0.f; }
#pragma unroll
        for (int ai = 0; ai < 2; ++ai)
#pragma unroll
            for (int m = 0; m < 4; ++m) { bf16_t* rowp = O + (size_t)(row0 + ai * HALF + m * 16) * ldo + coloff + cl;
                float o[8];
#pragma unroll
                for (int n = 0; n < 2; ++n)
#pragma unroll
                    for (int j = 0; j < 4; ++j) { const float a = acc[ai][0][m][n][j] + va[4 * n + j], b = acc[ai][1][m][n][j] + vb[4 * n + j];
                        o[4 * n + j] = (ACT == 0) ? a * sigmoidf_(b) : siluf_(a) * b; }
                u32x4 w; w.x = cvt_pk_bf16(o[0], o[1]); w.y = cvt_pk_bf16(o[2], o[3]); w.z = cvt_pk_bf16(o[4], o[5]); w.w = cvt_pk_bf16(o[6], o[7]);
                st16_wt(rowp, w); asm volatile("" ::: "memory"); }
    }
};
struct EpiMoeOut {
    static constexpr bool PERM = true;
    bf16_t* O; const int* row_tok; const float* row_w; LAS unsigned char* lds;
    __device__ __forceinline__ void operator()(const f32x4 (&acc)[2][2][4][2], const Unit& u, int wr, int wc, int fr_, int fq_) const {
        int fr = fr_, fq = fq_; asm volatile("" : "+v"(fr), "+v"(fq));
        const int col0 = u.pn * BM + wc * 32 + 8 * fq, lane = fq * 16 + fr;
        LAS u32x2* rinfo = (LAS u32x2*)(lds + STAGE_BYTES) + (wr * 4 + wc) * 128;
        { const int ra = u.pm * BM + wr * 64 + lane, rb = ra + HALF;
          const u32x2 ia = (u32x2){(unsigned)row_tok[ra], __float_as_uint(row_w[ra])}, ib = (u32x2){(unsigned)row_tok[rb], __float_as_uint(row_w[rb])};
          rinfo[lane] = ia; rinfo[64 + lane] = ib; }
#pragma unroll
        for (int ai = 0; ai < 2; ++ai)
#pragma unroll
            for (int m = 0; m < 4; ++m) { const u32x2 inf = rinfo[ai * 64 + m * 16 + fr]; const int ts = (int)inf.x; const float w = __uint_as_float(inf.y);
                if (ts >= 0) { bf16_t* rowp = O + ((size_t)(ts & 1) * NTOK + (size_t)(ts >> 1)) * DM + col0;
#pragma unroll
                    for (int bj = 0; bj < 2; ++bj) { const f32x4 v0 = acc[ai][bj][m][0] * w, v1 = acc[ai][bj][m][1] * w;
                        u32x4 q; q.x = cvt_pk_bf16(v0[0], v0[1]); q.y = cvt_pk_bf16(v0[2], v0[3]); q.z = cvt_pk_bf16(v1[0], v1[1]); q.w = cvt_pk_bf16(v1[2], v1[3]);
                        st16_wt(rowp + bj * HALF, q); } } }
    }
};
struct MoeOrder {
    int K; const char* A; const char* B; size_t bstride; const LAS int* list;
    static __device__ __forceinline__ void build(LAS int* list, const int* tiles, int nN, int G, int c) {
        const int nrt = tiles[0], nwg = nrt * nN; int n = 0;
        for (int i = 0; ; ++i) { const long L = (long)i * G + c; if (L >= (long)nwg || n >= 20) break;
            int wgid = (int)L; { const int q = nwg / NXCD, r = nwg % NXCD, xcd = wgid % NXCD, off = wgid / NXCD; wgid = (xcd < r ? xcd * (q + 1) : r * (q + 1) + (xcd - r) * q) + off; }
            const int pm = wgid / nN; list[1 + 3 * n] = pm; list[2 + 3 * n] = wgid % nN; list[3 + 3 * n] = tiles[64 + pm]; ++n; }
        list[0] = n;
    }
    __device__ bool next(int i, Unit& u) const {
        const int n = __builtin_amdgcn_readfirstlane(list[0]); if (i >= n) return false;
        u.pm = __builtin_amdgcn_readfirstlane(list[1 + 3 * i]); u.pn = __builtin_amdgcn_readfirstlane(list[2 + 3 * i]); const int e = __builtin_amdgcn_readfirstlane(list[3 + 3 * i]);
        u.a = A + (size_t)u.pm * 256 * K * 2; u.b = B + (size_t)e * bstride + (size_t)u.pn * 256 * K * 2; return true;
    }
};
}

struct Params { const float* in[44]; float* out; unsigned char* ws; int ph_lo, ph_hi; };
enum { I_X = 0, I_NORM1, I_WIN, I_MCONVW, I_MCONVB, I_MDTB, I_MALOG, I_MD, I_MNORM, I_RMU, I_RW0, I_RW2, I_RA0, I_RA2, I_RG2, I_RKK, I_RKA, I_RRK, I_RLNW, I_RLNB,
       I_CKVN, I_CWUK, I_CWUV, I_RELB, I_SARE, I_SAIM, I_SBRE, I_SBIM, I_SCRE, I_SCIM, I_SD, I_SLOGDT, I_SGLUW, I_SGLUB, I_WOUT, I_NORM2, I_WRG, I_BRG, I_WRE, I_BRE,
       I_WGATE, I_WUP, I_WDOWN, I_FNORM };

typedef const float* const __attribute__((address_space(4)))* in_tab_t;
struct Frame {
    LAS unsigned char* lds; int tid, lane, wave, bid, G;
    in_tab_t in; float* out; unsigned char* ws; unsigned* ctl;
    volatile LAS int* misc;
};

__device__ __forceinline__ int q_pop(Frame& F, int qi) {
    __syncthreads();
    if (F.tid == 0) F.misc[0] = (int)__hip_atomic_fetch_add(F.ctl + CW_Q + 64 * qi, 1u, __ATOMIC_RELAXED, __HIP_MEMORY_SCOPE_AGENT);
    __syncthreads();
    return F.misc[0];
}

__device__ __forceinline__ const void* opaque_ptr(const void* p) { const unsigned long long v = (unsigned long long)p; unsigned lo = __builtin_amdgcn_readfirstlane((unsigned)v), hi = __builtin_amdgcn_readfirstlane((unsigned)(v >> 32));
    asm volatile("" : "+s"(lo), "+s"(hi)); return (const void*)(((unsigned long long)hi << 32) | lo); }
__device__ __forceinline__ Frame relocal(const Frame& G) { Frame F = G; asm volatile("" : "+v"(F.tid)); F.ws = (unsigned char*)opaque_ptr(F.ws); F.ctl = (unsigned*)(F.ws + WS_CTL); F.in = (in_tab_t)(unsigned long long)opaque_ptr((const void*)(unsigned long long)F.in); F.lane = F.tid & 63; F.wave = __builtin_amdgcn_readfirstlane(F.tid >> 6); return F; }
template <int K> __device__ __forceinline__ f32x4 mma_nt(const LAS bf16_t* A, int lda, const LAS bf16_t* Bt, int ldb, f32x4 acc, int lane) {
    const int r = lane & 15, g = lane >> 4;
#pragma unroll
    for (int k0 = 0; k0 < K; k0 += 32) {
        const bf16x8 a = *(const LAS bf16x8*)(A + r * lda + k0 + 8 * g);
        const bf16x8 b = *(const LAS bf16x8*)(Bt + r * ldb + k0 + 8 * g);
        acc = __builtin_amdgcn_mfma_f32_16x16x32_bf16(a, b, acc, 0, 0, 0);
    }
    return acc;
}

template <class SrcMap> __device__ __forceinline__ void tr_tile(Frame& F, int ldsrc, bf16_t* dst, int K, int k0, int n0, SrcMap sm) {
    LAS float* tile = (LAS float*)F.lds;
    __syncthreads();
    { const int n4 = (F.tid & 63) * 4, kk = F.tid >> 6; const float* sp = sm(n0 + n4);
      f32x4 v[8];
#pragma unroll
      for (int ps = 0; ps < 8; ++ps) { v[ps] = (f32x4){0.f, 0.f, 0.f, 0.f}; if (sp) v[ps] = __builtin_nontemporal_load((const f32x4*)(sp + (size_t)(k0 + kk + 8 * ps) * ldsrc)); }
#pragma unroll
      for (int ps = 0; ps < 8; ++ps) { LAS float* t = tile + (kk + 8 * ps) * 257 + n4; t[0] = v[ps][0]; t[1] = v[ps][1]; t[2] = v[ps][2]; t[3] = v[ps][3]; } }
    __syncthreads();
    { const int kc = F.tid & 7;
#pragma unroll
      for (int j = 0; j < 4; ++j) { const int n = (F.tid >> 3) + 64 * j; float f[8];
#pragma unroll
          for (int i = 0; i < 8; ++i) f[i] = tile[(8 * kc + i) * 257 + n];
          u32x4 w; w.x = pk2(f[0], f[1]); w.y = pk2(f[2], f[3]); w.z = pk2(f[4], f[5]); w.w = pk2(f[6], f[7]);
          *(u32x4*)(dst + (size_t)(n0 + n) * K + k0 + 8 * kc) = w; } }
}

struct SmIn { const float* base; __device__ __forceinline__ const float* operator()(int n) const {
    int c; if (n < 772) c = n; else if (n < UR) return nullptr; else if (n < UR + 896) c = 772 + (n - UR); else if (n < UC) return nullptr;
    else if (n < UC + 680) c = 1668 + (n - UC); else if (n < US) return nullptr; else if (n < US + 256) c = 2348 + (n - US); else return nullptr; return base + c; } };
struct SmId { const float* base; __device__ __forceinline__ const float* operator()(int n) const { return base + n; } };
struct SmGlu { const float* base; __device__ __forceinline__ const float* operator()(int n) const { const int pn = n >> 8, rr = n & 255; return base + (rr < 128 ? 128 * pn + rr : 256 + 128 * pn + (rr - 128)); } };
struct SmGU { const float* gate; const float* up; __device__ __forceinline__ const float* operator()(int n) const {
    const unsigned long long d = (unsigned long long)up - (unsigned long long)gate; const unsigned long long a = (unsigned long long)gate + (((n & 255) < 128) ? 0ull : d); return (const float*)a + 128 * (n >> 8) + (n & 127); } };
__device__ __forceinline__ void phase_prologue(const Frame& F_) { Frame F = relocal(F_);
    for (int t = F.bid; t < 496; t += F.G) {
        if (t < 352) { const int l = t / 176, r = t % 176, kt = r / 11, nt = r % 11;
            tr_tile(F, NIN, (bf16_t*)(F.ws + WS_WIN) + (size_t)l * NINP * DM, DM, kt * 64, nt * 256, SmIn{F.in[I_WIN] + (size_t)l * DM * NIN}); }
        else if (t < 480) { const int q = t - 352, l = q / 64, r = q % 64, kt = r / 4, nt = r % 4;
            tr_tile(F, DM, (bf16_t*)(F.ws + WS_WOUT) + (size_t)l * DM * DM, DM, kt * 64, nt * 256, SmId{F.in[I_WOUT] + (size_t)l * DM * DM}); }
        else { const int q = t - 480, l = q / 8, r = q % 8, kt = r / 2, nt = r % 2;
            tr_tile(F, 512, (bf16_t*)(F.ws + WS_GLU) + (size_t)l * 512 * 256, 256, kt * 64, nt * 256, SmGlu{F.in[I_SGLUW] + (size_t)l * 256 * 512}); }
    }
    for (int i = F.bid * NTHR + F.tid; i < 2 * 48 * 1024; i += F.G * NTHR) { const int l = i / 49152, r = i % 49152, o = r >> 10, k = r & 1023;
        float v = 0.f; if (o < 32) v = F.in[I_WRE][((size_t)l * DM + k) * 32 + o]; else if (o < 36) v = F.in[I_WRG][((size_t)l * DM + k) * 4 + (o - 32)];
        v *= F.in[I_NORM2][l * DM + k];
        const bf16_t hi = f2bf(v); const bf16_t lo = f2bf(v - bf2f(hi));
        bf16_t* w = (bf16_t*)(F.ws + WS_WRT) + (size_t)l * 2 * 49152; w[r] = hi; w[49152 + r] = lo; }
    for (int i = F.bid * NTHR + F.tid; i < 2048 + 65536; i += F.G * NTHR) {
        if (i < 2048) {
            const int l = i >> 10, gn = i & 1023, g = gn >> 6;
            float* tab = (float*)(F.ws + WS_S5TAB + (size_t)l * S5TAB_L);
            const float lre = fminf(F.in[I_SARE][l * 1024 + gn], -1e-4f), lim = F.in[I_SAIM][l * 1024 + gn];
            const float dt = expf(F.in[I_SLOGDT][l * 16 + g]);
            const float mag = expf(dt * lre); float sn, cs; sincosf(dt * lim, &sn, &cs);
            const float are = mag * cs, aim = mag * sn;
            const float den = lre * lre + lim * lim;
            const float fre = ((are - 1.0f) * lre + aim * lim) / den, fim = (aim * lre - (are - 1.0f) * lim) / den;
            tab[gn * 2] = are; tab[gn * 2 + 1] = aim;
            float pr = are, pi = aim;
#pragma unroll
            for (int s = 0; s < 6; ++s) { const float nr = pr * pr - pi * pi, ni = 2.0f * pr * pi; pr = nr; pi = ni; }
            tab[2048 + gn * 2] = pr; tab[2048 + gn * 2 + 1] = pi;
            const float* bre = F.in[I_SBRE] + ((size_t)l * 1024 + gn) * 16; const float* bim = F.in[I_SBIM] + ((size_t)l * 1024 + gn) * 16;
            bf16_t* bbt = (bf16_t*)(F.ws + WS_S5TAB + (size_t)l * S5TAB_L + S5TAB_BBT); const int n = gn & 63, col = 4 * (n & 31) + 2 * (n >> 5);
            for (int p = 0; p < 16; ++p) { const float vr = fre * bre[p] - fim * bim[p], vi = fre * bim[p] + fim * bre[p];
                bbt[((size_t)g * 128 + col) * 16 + p] = f2bf(vr); bbt[((size_t)g * 128 + col + 1) * 16 + p] = f2bf(vi); }
        } else {
            const int j = i - 2048, l = j >> 15, r = j & 32767, gp = r >> 7, k = r & 127;
            bf16_t* cm = (bf16_t*)(F.ws + WS_S5TAB + (size_t)l * S5TAB_L + S5TAB_F);
            const int n = (k >> 2) + 32 * ((k >> 1) & 1);
            const float v = (k & 1) == 0 ? F.in[I_SCRE][((size_t)l * 256 + gp) * 64 + n] : -F.in[I_SCIM][((size_t)l * 256 + gp) * 64 + n];
            cm[r] = f2bf(v);
        }
    }
}

__device__ __forceinline__ void phase_norm(const Frame& F_, const float* xin, bool add_o, const float* w, int mode) { Frame F = relocal(F_);
    float* X = (float*)(F.ws + WS_X); bf16_t* H = (bf16_t*)(F.ws + WS_H); const bf16_t* O = (const bf16_t*)(F.ws + WS_U);
    for (int row0 = F.bid * 32 + F.wave * 4; row0 < NTOK; row0 += F.G * 32) {
        f32x4 v[4][4]; u32x2 oa[4][4], ob[4][4];
#pragma unroll
        for (int r = 0; r < 4; ++r)
#pragma unroll
            for (int j = 0; j < 4; ++j) { const int c = 4 * F.lane + 256 * j; const size_t o = (size_t)(row0 + r) * DM + c; v[r][j] = (mode == 2) ? __builtin_nontemporal_load((const f32x4*)(xin + o)) : *(const f32x4*)(xin + o);
                if (add_o) { oa[r][j] = __builtin_nontemporal_load((const u32x2*)(O + o)); ob[r][j] = __builtin_nontemporal_load((const u32x2*)(O + (size_t)NTOK * DM + o)); } }
#pragma unroll
        for (int r = 0; r < 4; ++r) { const int row = row0 + r; float ss = 0.f;
#pragma unroll
            for (int j = 0; j < 4; ++j) {
                if (add_o) { const u32x2 a = oa[r][j], b = ob[r][j];
                    v[r][j][0] += __uint_as_float(a.x << 16) + __uint_as_float(b.x << 16); v[r][j][1] += __uint_as_float(a.x & 0xffff0000u) + __uint_as_float(b.x & 0xffff0000u);
                    v[r][j][2] += __uint_as_float(a.y << 16) + __uint_as_float(b.y << 16); v[r][j][3] += __uint_as_float(a.y & 0xffff0000u) + __uint_as_float(b.y & 0xffff0000u); }
                ss += v[r][j][0] * v[r][j][0] + v[r][j][1] * v[r][j][1] + v[r][j][2] * v[r][j][2] + v[r][j][3] * v[r][j][3]; }
            ss = wave_sum(ss);
            const float rstd = rsqrtf(ss * (1.0f / DM) + 1e-6f);
#pragma unroll
            for (int j = 0; j < 4; ++j) { const int c = 4 * F.lane + 256 * j; const f32x4 wv = *(const f32x4*)(w + c);
                if (mode == 2) { __builtin_nontemporal_store(v[r][j] * rstd * wv, (f32x4*)(F.out + (size_t)row * DM + c)); }
                else { if (mode == 0) *(f32x4*)(X + (size_t)row * DM + c) = v[r][j];
                    u32x2 o; o.x = pk2(v[r][j][0] * rstd * wv[0], v[r][j][1] * rstd * wv[1]); o.y = pk2(v[r][j][2] * rstd * wv[2], v[r][j][3] * rstd * wv[3]);
                    *(u32x2*)(H + (size_t)row * DM + c) = o; } } }
    }
}

__device__ __forceinline__ void item_kv(const Frame& F_, int layer, int item) { Frame F = relocal(F_);
    const bf16_t* U = (const bf16_t*)(F.ws + WS_U);
    LAS bf16_t* Ab = (LAS bf16_t*)F.lds;
    LAS bf16_t* Bt = (LAS bf16_t*)(F.lds + 17408);
    const int t0 = item * 64;
    { const int tok = F.tid >> 3, part = F.tid & 7; const bf16_t* src = U + (size_t)(t0 + tok) * NINP + UC + 256 + 16 * part;
      float f[16]; { float a[8], b[8]; unpack8(*(const u32x4*)src, a); unpack8(*(const u32x4*)(src + 8), b);
#pragma unroll
        for (int j = 0; j < 8; ++j) { f[j] = a[j]; f[8 + j] = b[j]; } }
      float ss = 0.f;
#pragma unroll
      for (int j = 0; j < 16; ++j) ss += f[j] * f[j];
      ss = sum8(ss);
      const float rstd = rsqrtf(ss * (1.0f / 128.0f) + 1e-6f); const float* nw = F.in[I_CKVN] + layer * 128 + 16 * part;
#pragma unroll
      for (int j = 0; j < 16; j += 2) *(LAS unsigned*)(Ab + tok * 136 + 16 * part + j) = pk2(f[j] * rstd * nw[j], f[j + 1] * rstd * nw[j + 1]); }
    { const int n = F.tid >> 2, kq = F.tid & 3; const float* w = (n < 64 ? F.in[I_CWUK] : F.in[I_CWUV]) + (size_t)layer * 128 * 64 + (n & 63);
      float wv[32];
#pragma unroll
      for (int k = 0; k < 32; ++k) wv[k] = w[(size_t)(32 * kq + k) * 64];
#pragma unroll
      for (int k = 0; k < 32; k += 2) *(LAS unsigned*)(Bt + n * 136 + 32 * kq + k) = pk2(wv[k], wv[k + 1]); }
    if (F.tid < 256) { const int tok = F.tid >> 2, q = F.tid & 3;
        *(u32x4*)((bf16_t*)(F.ws + WS_KIDX) + (size_t)(t0 + tok) * 32 + 8 * q) = *(const u32x4*)(U + (size_t)(t0 + tok) * NINP + UC + 640 + 8 * q); }
    __syncthreads();
    const int mt = F.wave & 3, g = F.lane >> 4, r = F.lane & 15;
#pragma unroll
    for (int q = 0; q < 4; ++q) { const int nt = (F.wave >> 2) * 4 + q;
        f32x4 acc = (f32x4){0.f, 0.f, 0.f, 0.f};
        acc = mma_nt<128>(Bt + nt * 16 * 136, 136, Ab + mt * 16 * 136, 136, acc, F.lane);
        const int n0 = nt * 16 + 4 * g; bf16_t* dst = (bf16_t*)(F.ws + WS_K) + (size_t)(n0 >> 6) * ((WS_V - WS_K) / 2);
        *(u32x2*)(dst + (size_t)(t0 + mt * 16 + r) * 64 + (n0 & 63)) = (u32x2){pk2(acc[0], acc[1]), pk2(acc[2], acc[3])}; }
}

constexpr int MB_CG = 0, MB_BG = 18432, MB_XT = 36864, MB_BT = 73728, MB_M = 73728, MB_S0 = 110592, MB_DT = 147456, MB_AC = 148480, MB_RS = 149504;
static_assert(MB_RS + 256 <= MISC_OFF && MB_BT == MB_XT + 4 * 64 * 72 * 2, "mamba LDS");
template <int STAGE> __device__ __forceinline__ void item_mamba(const Frame& F_, int layer, int item) { Frame F = relocal(F_);
    const bf16_t* U = (const bf16_t*)(F.ws + WS_U);
    const int b = item >> 6, c = item & 63, l0 = c * 64; const size_t T0 = (size_t)b * SEQ + l0;
    LAS bf16_t* Cg = (LAS bf16_t*)(F.lds + MB_CG); LAS bf16_t* Bg = (LAS bf16_t*)(F.lds + MB_BG); LAS bf16_t* BT = (LAS bf16_t*)(F.lds + MB_BT);
    LAS bf16_t* XT = (LAS bf16_t*)(F.lds + MB_XT); LAS bf16_t* Mb = (LAS bf16_t*)(F.lds + MB_M); LAS bf16_t* S0 = (LAS bf16_t*)(F.lds + MB_S0);
    LAS float* dts = (LAS float*)(F.lds + MB_DT); LAS float* acs = (LAS float*)(F.lds + MB_AC); LAS float* rs = (LAS float*)(F.lds + MB_RS);
    const int tg = F.tid & 7, c0 = (F.tid >> 3) * 8;
    const bool conv_on = (STAGE == 2) || (F.wave < 6);
    u32x4 rows[11]; float wv[4][8], bv[8];
    if (conv_on) {
#pragma unroll
        for (int k = 0; k < 11; ++k) { const int l = l0 + tg * 8 - 3 + k;
            if (l >= 0) rows[k] = *(const u32x4*)(U + ((size_t)b * SEQ + l) * NINP + UM + 256 + c0); else rows[k] = (u32x4){0u, 0u, 0u, 0u}; }
#pragma unroll
        for (int j = 0; j < 8; ++j) { bv[j] = F.in[I_MCONVB][layer * 512 + c0 + j];
#pragma unroll
            for (int k = 0; k < 4; ++k) wv[k][j] = F.in[I_MCONVW][(layer * 4 + k) * 512 + c0 + j]; } }
    const float* MSTi = (const float*)(F.ws + WS_MST) + ((size_t)(b * 64 + c) * 4) * 4096;
    f32x4 s0a[4], s0b[4];
    if (STAGE == 2) {
#pragma unroll
        for (int h = 0; h < 4; ++h) { const float* src = MSTi + (size_t)h * 4096 + F.tid * 8; s0a[h] = *(const f32x4*)src; s0b[h] = *(const f32x4*)(src + 4); } }
    if (F.wave < 4) { const int l = F.lane, h = F.wave;
        const float raw = bf2f(U[(T0 + l) * NINP + UM + 768 + h]) + F.in[I_MDTB][layer * 4 + h];
        const float dt = softplusf_(raw); const float cum = wave_prefix_f(-__expf(F.in[I_MALOG][layer * 4 + h]) * dt);
        dts[l * 4 + h] = dt; acs[l * 4 + h] = cum; }
    if (STAGE == 2) { if (F.tid < 64) rs[F.tid] = 0.f;
#pragma unroll
        for (int h = 0; h < 4; ++h) { u32x4 w; w.x = pk2(s0a[h][0], s0a[h][1]); w.y = pk2(s0a[h][2], s0a[h][3]); w.z = pk2(s0b[h][0], s0b[h][1]); w.w = pk2(s0b[h][2], s0b[h][3]);
            *(LAS u32x4*)(S0 + (h * 64 + (F.tid >> 3)) * 72 + (F.tid & 7) * 8) = w; } }
    __syncthreads();
    if (conv_on) {
        float win[3][8]; unpack8(rows[0], win[0]); unpack8(rows[1], win[1]); unpack8(rows[2], win[2]);
        const bool isx = F.wave < 4, tr = isx || STAGE == 1;
        unsigned pkT[8][4]; float prev[8];
#pragma unroll
        for (int i = 0; i < 8; ++i) { const int l = tg * 8 + i; float cur[8]; unpack8(rows[3 + i], cur);
            float o[8];
#pragma unroll
            for (int j = 0; j < 8; ++j) { o[j] = siluf_(bv[j] + wv[0][j] * win[0][j] + wv[1][j] * win[1][j] + wv[2][j] * win[2][j] + wv[3][j] * cur[j]);
                win[0][j] = win[1][j]; win[1][j] = win[2][j]; win[2][j] = cur[j]; }
            if (isx) { const int h = F.wave; float sc = dts[l * 4 + h]; if (STAGE == 1) sc *= __expf(acs[63 * 4 + h] - acs[l * 4 + h]);
#pragma unroll
                for (int j = 0; j < 8; ++j) o[j] *= sc; }
            if (tr) {
#pragma unroll
                for (int j = 0; j < 8; ++j) { if (i & 1) pkT[j][i >> 1] = pk2(prev[j], o[j]); else prev[j] = o[j]; } }
            else { u32x4 w; w.x = pk2(o[0], o[1]); w.y = pk2(o[2], o[3]); w.z = pk2(o[4], o[5]); w.w = pk2(o[6], o[7]);
                *(LAS u32x4*)(Cg + (F.wave < 6 ? (MB_BG - MB_CG) / 2 : 0) + ((F.wave & 1) * 64 + l) * 72 + (c0 & 63)) = w; } }
        if (tr) { LAS bf16_t* dstT = XT + F.wave * 64 * 72;
#pragma unroll
            for (int j = 0; j < 8; ++j) *(LAS u32x4*)(dstT + ((c0 & 63) + j) * 72 + tg * 8) = (u32x4){pkT[j][0], pkT[j][1], pkT[j][2], pkT[j][3]}; } }
    const int g4 = F.lane >> 4, r16 = F.lane & 15;
    if (STAGE == 1) {
        __syncthreads();
        float* MST = (float*)(F.ws + WS_MST) + ((size_t)(b * 64 + c) * 4) * 4096;
#pragma unroll
        for (int q = 0; q < 8; ++q) { const int tix = F.wave * 8 + q, h = tix >> 4, mt = (tix >> 2) & 3, nt = tix & 3;
            f32x4 acc = (f32x4){0.f, 0.f, 0.f, 0.f};
            acc = mma_nt<64>(BT + ((h >> 1) * 64 + nt * 16) * 72, 72, XT + (h * 64 + mt * 16) * 72, 72, acc, F.lane);
            *(f32x4*)(MST + (size_t)h * 4096 + (mt * 16 + r16) * 64 + nt * 16 + 4 * g4) = acc; }
        if (F.tid < 4) ((float*)(F.ws + WS_MDEC))[(b * 64 + c) * 4 + F.tid] = __expf(acs[63 * 4 + F.tid]);
    } else {
        const int mt = F.wave & 3, nh = F.wave >> 2;
        const int l = mt * 16 + r16;
        u32x2 zz[4][2];
#pragma unroll
        for (int h = 0; h < 4; ++h)
#pragma unroll
            for (int q = 0; q < 2; ++q) zz[h][q] = *(const u32x2*)(U + (T0 + l) * NINP + UM + h * 64 + (2 * nh + q) * 16 + 4 * g4);
        __syncthreads();
        f32x4 yv[4][2];
#pragma unroll
        for (int g = 0; g < 2; ++g)
#pragma unroll
            for (int q = 0; q < 2; ++q) { f32x4 G = (f32x4){0.f, 0.f, 0.f, 0.f};
                G = mma_nt<64>(Bg + (g * 64 + (2 * nh + q) * 16) * 72, 72, Cg + (g * 64 + mt * 16) * 72, 72, G, F.lane);
                const int s0 = (2 * nh + q) * 16 + 4 * g4;
#pragma unroll
                for (int hh = 0; hh < 2; ++hh) { const int h = 2 * g + hh; const float al = acs[l * 4 + h]; float v[4];
#pragma unroll
                    for (int i = 0; i < 4; ++i) v[i] = (s0 + i <= l) ? G[i] * __expf(al - acs[(s0 + i) * 4 + h]) : 0.f;
                    *(LAS u32x2*)(Mb + (h * 64 + l) * 72 + s0) = (u32x2){pk2(v[0], v[1]), pk2(v[2], v[3])}; } }
        __syncthreads();
#pragma unroll
        for (int h = 0; h < 4; ++h) { const int g = h >> 1; const float eal = __expf(acs[l * 4 + h]), idt = 1.0f / dts[l * 4 + h], dsk = F.in[I_MD][layer * 4 + h];
#pragma unroll
            for (int q = 0; q < 2; ++q) { const int nt = 2 * nh + q;
                f32x4 yd = (f32x4){0.f, 0.f, 0.f, 0.f}, yo = (f32x4){0.f, 0.f, 0.f, 0.f};
                yd = mma_nt<64>(XT + (h * 64 + nt * 16) * 72, 72, Mb + (h * 64 + mt * 16) * 72, 72, yd, F.lane);
                yo = mma_nt<64>(S0 + (h * 64 + nt * 16) * 72, 72, Cg + (g * 64 + mt * 16) * 72, 72, yo, F.lane);
#pragma unroll
                for (int i = 0; i < 4; ++i) { const int p = nt * 16 + 4 * g4 + i;
                    const float xs = bf2f(XT[(h * 64 + p) * 72 + l]) * idt;
                    yv[h][q][i] = yd[i] + yo[i] * eal + dsk * xs; } } }
        float part = 0.f;
#pragma unroll
        for (int h = 0; h < 4; ++h)
#pragma unroll
            for (int q = 0; q < 2; ++q) { const float z4[4] = {__uint_as_float(zz[h][q].x << 16), __uint_as_float(zz[h][q].x & 0xffff0000u), __uint_as_float(zz[h][q].y << 16), __uint_as_float(zz[h][q].y & 0xffff0000u)};
#pragma unroll
                for (int i = 0; i < 4; ++i) { const float v = yv[h][q][i] * siluf_(z4[i]); yv[h][q][i] = v; part += v * v; } }
        f32x4 nw[4][2];
#pragma unroll
        for (int h = 0; h < 4; ++h)
#pragma unroll
            for (int q = 0; q < 2; ++q) nw[h][q] = *(const f32x4*)(F.in[I_MNORM] + layer * 256 + h * 64 + (2 * nh + q) * 16 + 4 * g4);
        part = xrows(part, OpAdd());
        if (g4 == 0) atomicAdd((float*)(rs + l), part);
        __syncthreads();
        bf16_t* Y = (bf16_t*)(F.ws + WS_H);
        const float rstd = rsqrtf(rs[l] * (1.0f / 256.0f) + 1e-6f);
#pragma unroll
        for (int h = 0; h < 4; ++h)
#pragma unroll
            for (int q = 0; q < 2; ++q) { const f32x4 o = yv[h][q] * rstd * nw[h][q];
                *(u32x2*)(Y + (T0 + l) * DM + h * 64 + (2 * nh + q) * 16 + 4 * g4) = (u32x2){pk2(o[0], o[1]), pk2(o[2], o[3])}; }
    }
}
__device__ __forceinline__ void item_mamba_carry(const Frame& F_, int item) { Frame F = relocal(F_);
    const int b = item >> 2, h = item & 3;
    float* MST = (float*)(F.ws + WS_MST); const float* MD = (const float*)(F.ws + WS_MDEC);
    float s[8];
#pragma unroll
    for (int j = 0; j < 8; ++j) s[j] = 0.f;
    for (int c = 0; c < 64; ++c) { float* p = MST + ((size_t)(b * 64 + c) * 4 + h) * 4096 + F.tid * 8; const float d = MD[(b * 64 + c) * 4 + h];
        const f32x4 a = *(f32x4*)p, q = *(f32x4*)(p + 4);
        *(f32x4*)p = (f32x4){s[0], s[1], s[2], s[3]}; *(f32x4*)(p + 4) = (f32x4){s[4], s[5], s[6], s[7]};
        s[0] = s[0] * d + a[0]; s[1] = s[1] * d + a[1]; s[2] = s[2] * d + a[2]; s[3] = s[3] * d + a[3];
        s[4] = s[4] * d + q[0]; s[5] = s[5] * d + q[1]; s[6] = s[6] * d + q[2]; s[7] = s[7] * d + q[3]; }
}

template <int STAGE> __device__ __forceinline__ void item_s5(const Frame& F_, int layer, int item) { Frame F = relocal(F_);
    const bf16_t* U = (const bf16_t*)(F.ws + WS_U);
    const int b = item >> 6, c = item & 63; const size_t T0 = (size_t)b * SEQ + c * 64;
    LAS bf16_t* us = (LAS bf16_t*)F.lds;
    LAS bf16_t* BuW = (LAS bf16_t*)(F.lds + 33792) + F.wave * 4224;
    const float* tab = (const float*)(F.ws + WS_S5TAB + (size_t)layer * S5TAB_L);
    { const int tok = F.tid >> 3, part = F.tid & 7;
#pragma unroll
      for (int q = 0; q < 4; ++q) *(LAS u32x4*)(us + tok * 264 + 32 * part + 8 * q) = *(const u32x4*)(U + (T0 + tok) * NINP + US + 32 * part + 8 * q); }
    const int lane = F.lane, r16 = lane & 15, g4 = lane >> 4, gq = lane >> 5, n0 = lane & 31, g = 2 * F.wave + gq, gn0 = g * 64 + n0, gn1 = gn0 + 32;
    bf16x8 bfr[2][8];
    { const bf16_t* bbt = (const bf16_t*)(F.ws + WS_S5TAB + (size_t)layer * S5TAB_L + S5TAB_BBT);
#pragma unroll
      for (int gg = 0; gg < 2; ++gg)
#pragma unroll
          for (int nt = 0; nt < 8; ++nt) { u32x4 z = (u32x4){0u, 0u, 0u, 0u}; if (g4 < 2) z = *(const u32x4*)(bbt + ((size_t)(2 * F.wave + gg) * 128 + 16 * nt + r16) * 16 + 8 * g4); bfr[gg][nt] = __builtin_bit_cast(bf16x8, z); } }
    const float a0r = tab[gn0 * 2], a0i = tab[gn0 * 2 + 1], a1r = tab[gn1 * 2], a1i = tab[gn1 * 2 + 1];
    float* ST = (float*)(F.ws + WS_S5ST) + (size_t)(b * 64 + c) * 2048;
    float h0r = 0.f, h0i = 0.f, h1r = 0.f, h1i = 0.f;
    if (STAGE == 2) { h0r = ST[gn0 * 2]; h0i = ST[gn0 * 2 + 1]; h1r = ST[gn1 * 2]; h1i = ST[gn1 * 2 + 1]; }
    bf16x8 cf[2][4];
    if (STAGE == 2) { const bf16_t* cm = (const bf16_t*)(F.ws + WS_S5TAB + (size_t)layer * S5TAB_L + S5TAB_F);
#pragma unroll
        for (int gg = 0; gg < 2; ++gg)
#pragma unroll
            for (int ks = 0; ks < 4; ++ks) cf[gg][ks] = *(const bf16x8*)(cm + ((size_t)((2 * F.wave + gg) * 16 + r16)) * 128 + 32 * ks + 8 * g4); }
    LAS bf16_t* YSl = (LAS bf16_t*)(F.lds + 101376);
    const bf16_t* GW = (const bf16_t*)(F.ws + WS_GLU) + (size_t)layer * 512 * 256;
    f32x4 dsk[2], bvl[2], bgt[2]; bf16x8 gwb[2][4];
    if (STAGE == 2) {
#pragma unroll
        for (int gg = 0; gg < 2; ++gg) dsk[gg] = *(const f32x4*)(F.in[I_SD] + layer * 256 + (2 * F.wave + gg) * 16 + 4 * g4);
#pragma unroll
        for (int q = 0; q < 2; ++q) { const int c0 = 32 * F.wave + 16 * q + 4 * g4; bvl[q] = *(const f32x4*)(F.in[I_SGLUB] + layer * 512 + c0); bgt[q] = *(const f32x4*)(F.in[I_SGLUB] + layer * 512 + 256 + c0); }
#pragma unroll
        for (int ks = 0; ks < 2; ++ks)
#pragma unroll
            for (int q = 0; q < 2; ++q) { const int c = 32 * F.wave + 16 * q + r16; const int rowv = 256 * (c >> 7) + (c & 127);
                gwb[ks][2 * q] = *(const bf16x8*)(GW + (size_t)rowv * 256 + 32 * ks + 8 * g4); gwb[ks][2 * q + 1] = *(const bf16x8*)(GW + (size_t)(rowv + 128) * 256 + 32 * ks + 8 * g4); } }
    __syncthreads();
#pragma unroll 1
    for (int lb = 0; lb < 4; ++lb) {
#pragma unroll
        for (int gg = 0; gg < 2; ++gg) { u32x4 z = (u32x4){0u, 0u, 0u, 0u}; if (g4 < 2) z = *(const LAS u32x4*)(us + (16 * lb + r16) * 264 + (2 * F.wave + gg) * 16 + 8 * g4);
            const bf16x8 afr = __builtin_bit_cast(bf16x8, z);
#pragma unroll
            for (int nt = 0; nt < 8; ++nt) { const f32x4 acc = __builtin_amdgcn_mfma_f32_16x16x32_bf16(bfr[gg][nt], afr, (f32x4){0.f, 0.f, 0.f, 0.f}, 0, 0, 0);
                *(LAS u32x2*)(BuW + r16 * 264 + gg * 128 + 16 * nt + 4 * g4) = (u32x2){pk2(acc[0], acc[1]), pk2(acc[2], acc[3])}; } }
        __syncthreads();
#pragma unroll 4
        for (int li = 0; li < 16; ++li) { LAS u32x2* bp = (LAS u32x2*)(BuW + li * 264 + gq * 128 + 4 * n0); const u32x2 v = *bp;
            { const float br = __uint_as_float(v.x << 16), bi = __uint_as_float(v.x & 0xffff0000u); const float nr = a0r * h0r - a0i * h0i + br, ni = a0r * h0i + a0i * h0r + bi; h0r = nr; h0i = ni; }
            { const float br = __uint_as_float(v.y << 16), bi = __uint_as_float(v.y & 0xffff0000u); const float nr = a1r * h1r - a1i * h1i + br, ni = a1r * h1i + a1i * h1r + bi; h1r = nr; h1i = ni; }
            if (STAGE == 2) *bp = (u32x2){pk2(h0r, h0i), pk2(h1r, h1i)}; }
        __syncthreads();
        if (STAGE == 2) {
#pragma unroll
            for (int gg = 0; gg < 2; ++gg) { f32x4 acc = (f32x4){0.f, 0.f, 0.f, 0.f};
#pragma unroll
                for (int ks = 0; ks < 4; ++ks) { const bf16x8 a = *(const LAS bf16x8*)(BuW + r16 * 264 + gg * 128 + 32 * ks + 8 * g4);
                    acc = __builtin_amdgcn_mfma_f32_16x16x32_bf16(cf[gg][ks], a, acc, 0, 0, 0); }
                const int ch0 = (2 * F.wave + gg) * 16 + 4 * g4, l = lb * 16 + r16; const u32x2 uw = *(const LAS u32x2*)(us + l * 264 + ch0);
                const float u4[4] = {__uint_as_float(uw.x << 16), __uint_as_float(uw.x & 0xffff0000u), __uint_as_float(uw.y << 16), __uint_as_float(uw.y & 0xffff0000u)}; float y[4];
#pragma unroll
                for (int i = 0; i < 4; ++i) y[i] = gelu_tanh(acc[i] + dsk[gg][i] * u4[i]);
                *(LAS u32x2*)(YSl + l * 264 + ch0) = (u32x2){pk2(y[0], y[1]), pk2(y[2], y[3])}; }
            __syncthreads();
        }
    }
    if (STAGE == 1) { ST[gn0 * 2] = h0r; ST[gn0 * 2 + 1] = h0i; ST[gn1 * 2] = h1r; ST[gn1 * 2 + 1] = h1i; }
    if (STAGE == 2) {
        f32x4 av[4][2], ag[4][2];
#pragma unroll
        for (int m = 0; m < 4; ++m)
#pragma unroll
            for (int q = 0; q < 2; ++q) { av[m][q] = (f32x4){0.f, 0.f, 0.f, 0.f}; ag[m][q] = (f32x4){0.f, 0.f, 0.f, 0.f}; }
#pragma unroll
        for (int ks = 0; ks < 8; ++ks) {
            bf16x8 af[4], bcur[4];
#pragma unroll
            for (int j = 0; j < 4; ++j) bcur[j] = gwb[ks & 1][j];
            if (ks + 2 < 8) {
#pragma unroll
                for (int q = 0; q < 2; ++q) { const int c = 32 * F.wave + 16 * q + r16; const int rowv = 256 * (c >> 7) + (c & 127);
                    gwb[ks & 1][2 * q] = *(const bf16x8*)(GW + (size_t)rowv * 256 + 32 * (ks + 2) + 8 * g4); gwb[ks & 1][2 * q + 1] = *(const bf16x8*)(GW + (size_t)(rowv + 128) * 256 + 32 * (ks + 2) + 8 * g4); } }
#pragma unroll
            for (int m = 0; m < 4; ++m) af[m] = *(const LAS bf16x8*)(YSl + (16 * m + r16) * 264 + 32 * ks + 8 * g4);
#pragma unroll
            for (int m = 0; m < 4; ++m)
#pragma unroll
                for (int q = 0; q < 2; ++q) { av[m][q] = __builtin_amdgcn_mfma_f32_16x16x32_bf16(bcur[2 * q], af[m], av[m][q], 0, 0, 0); ag[m][q] = __builtin_amdgcn_mfma_f32_16x16x32_bf16(bcur[2 * q + 1], af[m], ag[m][q], 0, 0, 0); }
        }
        bf16_t* Y = (bf16_t*)(F.ws + WS_H);
#pragma unroll
        for (int q = 0; q < 2; ++q) { const int c0 = 32 * F.wave + 16 * q + 4 * g4;
#pragma unroll
            for (int m = 0; m < 4; ++m) { float o[4];
#pragma unroll
                for (int i = 0; i < 4; ++i) o[i] = (av[m][q][i] + bvl[q][i]) * sigmoidf_(ag[m][q][i] + bgt[q][i]);
                *(u32x2*)(Y + (T0 + 16 * m + r16) * DM + 768 + c0) = (u32x2){pk2(o[0], o[1]), pk2(o[2], o[3])}; } }
    }
}
__device__ __forceinline__ void item_s5_carry(const Frame& F_, int layer, int b) { Frame F = relocal(F_);
    const float* tab = (const float*)(F.ws + WS_S5TAB + (size_t)layer * S5TAB_L) + 2048;
    float* ST = (float*)(F.ws + WS_S5ST) + (size_t)b * 64 * 2048;
#pragma unroll
    for (int q = 0; q < 2; ++q) { const int gn = F.tid + 512 * q; const float pr = tab[gn * 2], pi = tab[gn * 2 + 1]; float hr = 0.f, hi = 0.f;
        for (int c = 0; c < 64; ++c) { float* p = ST + (size_t)c * 2048 + gn * 2; const float tr = p[0], ti = p[1]; p[0] = hr; p[1] = hi;
            const float nr = pr * hr - pi * hi + tr, ni = pr * hi + pi * hr + ti; hr = nr; hi = ni; } }
}

constexpr int RB_LD = 72;
constexpr int RW_R = 0, RW_K = 16384, RW_V = 32768, RW_W = 49152, RW_A = 65536, RW_B = 81920;
constexpr int R3_G = 49152, R3_O = 65536, R3_TILES = 81920, R3_BON = 147456;
template <int STAGE> __device__ __forceinline__ void rwkv_prep(const Frame& F_, int layer, int b, int h, int c) { Frame F = relocal(F_);
    const bf16_t* U = (const bf16_t*)(F.ws + WS_U);
    const int l0 = c * 64; const size_t T0 = (size_t)b * SEQ + l0;
    LAS float* Rr = (LAS float*)(F.lds + RW_R); LAS float* Kk = (LAS float*)(F.lds + RW_K); LAS float* Vv = (LAS float*)(F.lds + RW_V); LAS float* Ww = (LAS float*)(F.lds + RW_W);
    LAS float* Aa = (LAS float*)(F.lds + (STAGE == 1 ? RW_A : R3_O)); LAS float* Bb = (LAS float*)(F.lds + RW_B); LAS float* Gg = (LAS float*)(F.lds + R3_G); LAS float* BON = (LAS float*)(F.lds + R3_BON);
    LAS bf16_t* TWb = (LAS bf16_t*)(F.lds + 98304); LAS bf16_t* DAb = (LAS bf16_t*)(F.lds + (STAGE == 1 ? 103424 : 118784)); LAS bf16_t* SGb = (LAS bf16_t*)(F.lds + 123904);
    LAS bf16_t* w2T = (LAS bf16_t*)(F.lds + 108544); LAS bf16_t* a2T = (LAS bf16_t*)(F.lds + (STAGE == 1 ? 113664 : 133120)); LAS bf16_t* g2T = (LAS bf16_t*)(F.lds + 138240);
    const float* mu = F.in[I_RMU] + layer * 896;
    float pw0[2] = {0.f, 0.f}, pa0[2] = {0.f, 0.f}; f32x4 pkkw[2], pkaw[2], prk[2];
    if (STAGE == 1) { const int cgl = layer * 256 + h * 64 + 8 * (F.tid & 7);
#pragma unroll
        for (int q = 0; q < 2; ++q) { pkkw[q] = *(const f32x4*)(F.in[I_RKK] + cgl + 4 * q); pkaw[q] = *(const f32x4*)(F.in[I_RKA] + cgl + 4 * q); prk[q] = *(const f32x4*)(F.in[I_RRK] + cgl + 4 * q); }
#pragma unroll
        for (int q = 0; q < 2; ++q) { const int cg = layer * 256 + h * 64 + 16 * (2 * (F.wave & 1) + q) + (F.lane & 15); pw0[q] = F.in[I_RW0][cg]; pa0[q] = F.in[I_RA0][cg]; } }
    { const int tok = F.tid >> 3, p8 = F.tid & 7; const bool first = (l0 + tok == 0);
      const bf16_t* cur = U + (T0 + tok) * NINP + UR; const bf16_t* prv = first ? cur : cur - NINP;
      const float pz = first ? 0.f : 1.f;
      u32x4 cw[3], pw[3]; u32x2 c1 = (u32x2){0u, 0u}, p1 = (u32x2){0u, 0u}, c2 = (u32x2){0u, 0u}, p2 = (u32x2){0u, 0u}; u32x4 c3 = (u32x4){0u, 0u, 0u, 0u}, p3 = (u32x4){0u, 0u, 0u, 0u};
#pragma unroll
      for (int sec = (STAGE == 1 ? 0 : 2); sec < 3; ++sec) { const int co = sec * 256 + h * 64 + 8 * p8; cw[sec] = *(const u32x4*)(cur + co); pw[sec] = *(const u32x4*)(prv + co); }
      if (STAGE == 1) { c1 = *(const u32x2*)(cur + 768 + 4 * p8); p1 = *(const u32x2*)(prv + 768 + 4 * p8); c2 = *(const u32x2*)(cur + 800 + 4 * p8); p2 = *(const u32x2*)(prv + 800 + 4 * p8); }
      if (STAGE == 3) { c3 = *(const u32x4*)(cur + 832 + 8 * p8); p3 = *(const u32x4*)(prv + 832 + 8 * p8); }
#pragma unroll
      for (int sec = (STAGE == 1 ? 0 : 2); sec < 3; ++sec) { const int co = sec * 256 + h * 64 + 8 * p8; float av[8], pq[8]; unpack8(cw[sec], av); unpack8(pw[sec], pq);
          const f32x4 m0 = *(const f32x4*)(mu + co), m1 = *(const f32x4*)(mu + co + 4);
          LAS float* dst = (sec == 0 ? Rr : sec == 1 ? Kk : Vv) + tok * 64 + 8 * p8;
#pragma unroll
          for (int j = 0; j < 8; ++j) pq[j] *= pz;
          *(LAS f32x4*)dst = (f32x4){av[0] + m0[0] * (pq[0] - av[0]), av[1] + m0[1] * (pq[1] - av[1]), av[2] + m0[2] * (pq[2] - av[2]), av[3] + m0[3] * (pq[3] - av[3])};
          *(LAS f32x4*)(dst + 4) = (f32x4){av[4] + m1[0] * (pq[4] - av[4]), av[5] + m1[1] * (pq[5] - av[5]), av[6] + m1[2] * (pq[6] - av[6]), av[7] + m1[3] * (pq[7] - av[7])}; }
      if (STAGE == 1) {
#pragma unroll
        for (int which = 0; which < 2; ++which) { const int co = 768 + 32 * which + 4 * p8; const u32x2 cv = which ? c2 : c1, pv = which ? p2 : p1;
          const f32x4 m0 = *(const f32x4*)(mu + co);
          float x[4] = {__uint_as_float(cv.x << 16), __uint_as_float(cv.x & 0xffff0000u), __uint_as_float(cv.y << 16), __uint_as_float(cv.y & 0xffff0000u)};
          const float y[4] = {pz * __uint_as_float(pv.x << 16), pz * __uint_as_float(pv.x & 0xffff0000u), pz * __uint_as_float(pv.y << 16), pz * __uint_as_float(pv.y & 0xffff0000u)};
#pragma unroll
          for (int j = 0; j < 4; ++j) { x[j] = x[j] + m0[j] * (y[j] - x[j]); if (which == 0) x[j] = tanhf_(x[j]); }
          *(LAS u32x2*)((which ? DAb : TWb) + tok * 40 + 4 * p8) = (u32x2){pk2(x[0], x[1]), pk2(x[2], x[3])}; } }
      if (STAGE == 3) { const int co = 832 + 8 * p8; float av[8], pq[8]; unpack8(c3, av); unpack8(p3, pq);
          const f32x4 m0 = *(const f32x4*)(mu + co), m1 = *(const f32x4*)(mu + co + 4); float x[8];
#pragma unroll
          for (int j = 0; j < 8; ++j) x[j] = sigmoidf_(av[j] + (j < 4 ? m0[j] : m1[j - 4]) * (pz * pq[j] - av[j]));
          *(LAS u32x4*)(SGb + tok * RB_LD + 8 * p8) = (u32x4){pk2(x[0], x[1]), pk2(x[2], x[3]), pk2(x[4], x[5]), pk2(x[6], x[7])}; } }
    { const int ch = F.tid & 63, part = F.tid >> 6;
      if (STAGE == 1) { const float* w2 = F.in[I_RW2] + ((size_t)layer * 32 + 4 * part) * 256 + h * 64 + ch;
          *(LAS u32x2*)(w2T + ch * 40 + 4 * part) = (u32x2){pk2(w2[0], w2[256]), pk2(w2[512], w2[768])}; }
      if (STAGE == 1) { const float* a2 = F.in[I_RA2] + ((size_t)layer * 32 + 4 * part) * 256 + h * 64 + ch;
          *(LAS u32x2*)(a2T + ch * 40 + 4 * part) = (u32x2){pk2(a2[0], a2[256]), pk2(a2[512], a2[768])}; }
      if (STAGE == 3) { const float* g2 = F.in[I_RG2] + ((size_t)layer * 64 + 8 * part) * 256 + h * 64 + ch;
          *(LAS u32x4*)(g2T + ch * RB_LD + 8 * part) = (u32x4){pk2(g2[0], g2[256]), pk2(g2[512], g2[768]), pk2(g2[1024], g2[1280]), pk2(g2[1536], g2[1792])}; } }
    __syncthreads();
    { const int lane = F.lane, mt = F.wave >> 1, nt0 = 2 * (F.wave & 1), r = lane & 15, g4 = lane >> 4; const f32x4 zero4 = (f32x4){0.f, 0.f, 0.f, 0.f};
#pragma unroll
      for (int q = 0; q < 2; ++q) { const int nt = nt0 + q, ch = 16 * nt + r;
          if (STAGE == 1) { const f32x4 wl = mma_nt<32>(TWb + 16 * mt * 40, 40, w2T + 16 * nt * 40, 40, zero4, lane); const float w0 = pw0[q];
#pragma unroll
              for (int i = 0; i < 4; ++i) { const float x = w0 + wl[i]; const float wlog = -__logf(1.0f + __expf(-x)) - 0.5f; Ww[(16 * mt + 4 * g4 + i) * 64 + ch] = __expf(-__expf(wlog)); } }
          if (STAGE == 1) { const f32x4 al = mma_nt<32>(DAb + 16 * mt * 40, 40, a2T + 16 * nt * 40, 40, zero4, lane); const float a0 = pa0[q];
#pragma unroll
              for (int i = 0; i < 4; ++i) Aa[(16 * mt + 4 * g4 + i) * 64 + ch] = sigmoidf_(a0 + al[i]); }
          if (STAGE == 3) { const f32x4 gv = mma_nt<64>(SGb + 16 * mt * RB_LD, RB_LD, g2T + 16 * nt * RB_LD, RB_LD, zero4, lane);
#pragma unroll
              for (int i = 0; i < 4; ++i) Gg[(16 * mt + 4 * g4 + i) * 64 + ch] = gv[i]; } } }
    __syncthreads();
    float* gBON = (float*)(F.ws + WS_BON) + ((size_t)(b * 4 + h) * 64 + c) * 64;
    if (STAGE == 1) { const int t = F.tid >> 3, p8 = F.tid & 7;
      LAS float* pa = Aa + t * 64 + 8 * p8; LAS float* pk = Kk + t * 64 + 8 * p8; LAS float* pr = Rr + t * 64 + 8 * p8; LAS float* pb = Bb + t * 64 + 8 * p8;
      float kp[8], kkv[8], av[8]; float ss = 0.f, bo = 0.f;
#pragma unroll
      for (int q = 0; q < 2; ++q) { const f32x4 a4 = *(const LAS f32x4*)(pa + 4 * q), k4 = *(const LAS f32x4*)(pk + 4 * q), r4 = *(const LAS f32x4*)(pr + 4 * q);
#pragma unroll
          for (int j = 0; j < 4; ++j) { const float a = a4[j], kraw = k4[j]; av[4 * q + j] = a; kp[4 * q + j] = kraw * (1.0f + (a - 1.0f) * pkaw[q][j]);
              kkv[4 * q + j] = kraw * pkkw[q][j]; ss += kkv[4 * q + j] * kkv[4 * q + j]; bo += r4[j] * kp[4 * q + j] * prk[q][j]; } }
      ss = sum8(ss); bo = sum8(bo);
      const float rn = rsqrtf(fmaxf(ss, 1e-24f));
#pragma unroll
      for (int q = 0; q < 2; ++q) { f32x4 ko, ao, bq;
#pragma unroll
          for (int j = 0; j < 4; ++j) { const float kkn = kkv[4 * q + j] * rn; ko[j] = kp[4 * q + j]; ao[j] = -kkn; bq[j] = kkn * av[4 * q + j]; }
          *(LAS f32x4*)(pk + 4 * q) = ko; *(LAS f32x4*)(pa + 4 * q) = ao; *(LAS f32x4*)(pb + 4 * q) = bq; }
      if (p8 == 0) gBON[t] = bo; }
    else if (F.tid < 64) BON[F.tid] = gBON[F.tid];
    __syncthreads();
}
constexpr int RB_AT = 98304, RB_ATT = RB_AT + 9216, RB_BT = RB_ATT + 9216, RB_BTT = RB_BT + 9216, RB_KT = RB_BTT + 9216, RB_RT = RB_KT + 9216, RB_VT = RB_RT + 9216, RB_GC = RB_VT + 9216;
constexpr int RX_X = 0, RX_XT = 9216, RX_TB = 18432, RX_M = 27648, RX_NRT = 36864, RX_G1T = 46080, RX_G2T = 55296, RX_QT = 64512;
__device__ __forceinline__ void st_tile(LAS bf16_t* dst, int mt, int nt, const f32x4 v, int lane) {
    const int r = lane & 15, g = lane >> 4;
#pragma unroll
    for (int i = 0; i < 4; ++i) dst[(16 * mt + 4 * g + i) * RB_LD + 16 * nt + r] = f2bf(v[i]);
}
__device__ __forceinline__ void st_tile_t(LAS bf16_t* dst, int mt, int nt, const f32x4 v, int lane) {
    const int r = lane & 15, g = lane >> 4; u32x2 w; w.x = pk2(v[0], v[1]); w.y = pk2(v[2], v[3]);
    *(LAS u32x2*)(dst + (16 * nt + r) * RB_LD + 16 * mt + 4 * g) = w;
}
__device__ __forceinline__ void st_rm(LAS bf16_t* dst, int mt, int nt, const f32x4 v, int lane) {
    const int r = lane & 15, g = lane >> 4; *(LAS u32x2*)(dst + (16 * mt + r) * RB_LD + 16 * nt + 4 * g) = (u32x2){pk2(v[0], v[1]), pk2(v[2], v[3])};
}
__device__ __forceinline__ void st_tr(LAS bf16_t* dst, int mt, int nt, const f32x4 v, int lane) {
    const int r = lane & 15, g = lane >> 4;
#pragma unroll
    for (int i = 0; i < 4; ++i) dst[(16 * nt + 4 * g + i) * RB_LD + 16 * mt + r] = f2bf(v[i]);
}
__device__ __forceinline__ void ld_fr(const LAS bf16_t* M, int row0, int lane, bf16x8 (&f)[2]) { const LAS bf16_t* p = M + (row0 + (lane & 15)) * RB_LD + 8 * (lane >> 4); f[0] = *(const LAS bf16x8*)p; f[1] = *(const LAS bf16x8*)(p + 32); }
__device__ __forceinline__ f32x4 mm_fr(const bf16x8 (&a)[2], const bf16x8 (&b)[2], f32x4 acc) { acc = __builtin_amdgcn_mfma_f32_16x16x32_bf16(a[0], b[0], acc, 0, 0, 0); return __builtin_amdgcn_mfma_f32_16x16x32_bf16(a[1], b[1], acc, 0, 0, 0); }
__device__ __forceinline__ void item_rwkv1(const Frame& F_, int layer, int item) { Frame F = relocal(F_);
    const int b = item >> 8, h = (item >> 6) & 3, c = item & 63;
    rwkv_prep<1>(F, layer, b, h, c);
    LAS float* Rr = (LAS float*)(F.lds + RW_R); LAS float* Kk = (LAS float*)(F.lds + RW_K); LAS float* Vv = (LAS float*)(F.lds + RW_V); LAS float* Ww = (LAS float*)(F.lds + RW_W);
    LAS float* Aa = (LAS float*)(F.lds + RW_A); LAS float* Bb = (LAS float*)(F.lds + RW_B);
    LAS bf16_t* At = (LAS bf16_t*)(F.lds + RB_AT); LAS bf16_t* AtT = (LAS bf16_t*)(F.lds + RB_ATT); LAS bf16_t* Bt = (LAS bf16_t*)(F.lds + RB_BT); LAS bf16_t* BtT = (LAS bf16_t*)(F.lds + RB_BTT);
    LAS bf16_t* Kt = (LAS bf16_t*)(F.lds + RB_KT); LAS bf16_t* Rt = (LAS bf16_t*)(F.lds + RB_RT); LAS bf16_t* VT = (LAS bf16_t*)(F.lds + RB_VT); LAS float* gC = (LAS float*)(F.lds + RB_GC);
    LAS bf16_t* X = (LAS bf16_t*)(F.lds + RX_X); LAS bf16_t* XT = (LAS bf16_t*)(F.lds + RX_XT); LAS bf16_t* Tb = (LAS bf16_t*)(F.lds + RX_TB); LAS bf16_t* Mm = (LAS bf16_t*)(F.lds + RX_M);
    LAS bf16_t* NrT = (LAS bf16_t*)(F.lds + RX_NRT); LAS bf16_t* G1T = (LAS bf16_t*)(F.lds + RX_G1T); LAS bf16_t* G2T = (LAS bf16_t*)(F.lds + RX_G2T); LAS bf16_t* QT = (LAS bf16_t*)(F.lds + RX_QT);
    { const int k = F.tid & 63, part = F.tid >> 6; float g = 1.0f;
      for (int pp = 0; pp < part; ++pp) { float w8[8];
#pragma unroll
          for (int i = 0; i < 8; ++i) w8[i] = Ww[(8 * pp + i) * 64 + k];
          g *= ((w8[0] * w8[1]) * (w8[2] * w8[3])) * ((w8[4] * w8[5]) * (w8[6] * w8[7])); }
      unsigned aT[4], bT[4], vT[4]; unsigned pa = 0u, pb = 0u, pv = 0u;
#pragma unroll
      for (int i = 0; i < 8; ++i) { const int t = 8 * part + i; const float gp = g; g *= Ww[t * 64 + k]; const float ig = __builtin_amdgcn_rcpf(g);
          const bf16_t av = f2bf(Aa[t * 64 + k] * gp), bv = f2bf(Bb[t * 64 + k] * ig), vv = f2bf(Vv[t * 64 + k]);
          At[t * RB_LD + k] = av; Bt[t * RB_LD + k] = bv;
          Kt[t * RB_LD + k] = f2bf(Kk[t * 64 + k] * ig); Rt[t * RB_LD + k] = f2bf(Rr[t * 64 + k] * g);
          if (i & 1) { aT[i >> 1] = pa | ((unsigned)av << 16); bT[i >> 1] = pb | ((unsigned)bv << 16); vT[i >> 1] = pv | ((unsigned)vv << 16); } else { pa = av; pb = bv; pv = vv; } }
      *(LAS u32x4*)(AtT + k * RB_LD + 8 * part) = (u32x4){aT[0], aT[1], aT[2], aT[3]}; *(LAS u32x4*)(BtT + k * RB_LD + 8 * part) = (u32x4){bT[0], bT[1], bT[2], bT[3]};
      *(LAS u32x4*)(VT + k * RB_LD + 8 * part) = (u32x4){vT[0], vT[1], vT[2], vT[3]};
      if (part == 7) gC[k] = g; }
    __syncthreads();
    const int lane = F.lane, mt = F.wave >> 1, nt0 = 2 * (F.wave & 1), r = lane & 15, g4 = lane >> 4;
    const f32x4 zero4 = (f32x4){0.f, 0.f, 0.f, 0.f};
    f32x4 Tacc[2];
    bf16x8 fa0[2], fa1[2], fa2[2], fb0[2][2], fb1[2][2], fb2[2][2];
    ld_fr(Bt, 16 * mt, lane, fa0); ld_fr(Kt, 16 * mt, lane, fa1); ld_fr(Rt, 16 * mt, lane, fa2);
#pragma unroll
    for (int q = 0; q < 2; ++q) { ld_fr(At, 16 * (nt0 + q), lane, fb0[q]); ld_fr(Bt, 16 * (nt0 + q), lane, fb1[q]); }
#pragma unroll
    for (int q = 0; q < 2; ++q) { const int nt = nt0 + q;
        f32x4 n = mm_fr(fb0[q], fa0, zero4);
        f32x4 m = mm_fr(fb0[q], fa1, zero4);
        f32x4 nr = mm_fr(fb1[q], fa2, zero4);
#pragma unroll
        for (int i = 0; i < 4; ++i) { const int row = 16 * mt + r, col = 16 * nt + 4 * g4 + i;
            n[i] = (row < col) ? n[i] : 0.f; m[i] = (row < col) ? m[i] : 0.f; nr[i] = (col <= row) ? nr[i] : 0.f;
            Tacc[q][i] = n[i] + (row == col ? 1.0f : 0.f); }
        st_rm(X, mt, nt, n, lane); st_tr(XT, mt, nt, n, lane); st_rm(Tb, mt, nt, Tacc[q], lane); st_rm(Mm, mt, nt, m, lane); st_rm(NrT, mt, nt, nr, lane); }
    __syncthreads();
#pragma unroll 1
    for (int it = 0; it < 6; ++it) {
        LAS bf16_t* Xr = (it & 1) ? G1T : X; LAS bf16_t* XTr = (it & 1) ? G2T : XT; LAS bf16_t* Tr = (it & 1) ? QT : Tb;
        LAS bf16_t* Xw = (it & 1) ? X : G1T; LAS bf16_t* XTw = (it & 1) ? XT : G2T; LAS bf16_t* Tw = (it & 1) ? Tb : QT;
        ld_fr(Tr, 16 * mt, lane, fa0); ld_fr(Xr, 16 * mt, lane, fa1);
#pragma unroll
        for (int q = 0; q < 2; ++q) ld_fr(XTr, 16 * (nt0 + q), lane, fb0[q]);
#pragma unroll
        for (int q = 0; q < 2; ++q) { const int nt = nt0 + q;
            if (it > 0) Tacc[q] = mm_fr(fb0[q], fa0, Tacc[q]);
            if (it < 5) { const f32x4 x2 = mm_fr(fb0[q], fa1, zero4); st_rm(Xw, mt, nt, x2, lane); st_tr(XTw, mt, nt, x2, lane); }
            st_rm(Tw, mt, nt, Tacc[q], lane); }
        __syncthreads();
    }
    ld_fr(NrT, 16 * mt, lane, fa0); ld_fr(BtT, 16 * mt, lane, fa1);
#pragma unroll
    for (int q = 0; q < 2; ++q) ld_fr(Tb, 16 * (nt0 + q), lane, fb0[q]);
#pragma unroll
    for (int q = 0; q < 2; ++q) { const int nt = nt0 + q;
        st_rm(G1T, mt, nt, mm_fr(fb0[q], fa0, zero4), lane);
        st_rm(G2T, mt, nt, mm_fr(fb0[q], fa1, zero4), lane); }
    __syncthreads();
    const size_t ci = (size_t)(b * 4 + h) * 64 + c;
    bf16_t* gPT = (bf16_t*)(F.ws + WS_MOE + RW_PT) + ci * 4096; bf16_t* gW1 = (bf16_t*)(F.ws + WS_MOE + RW_W1) + ci * 4096; bf16_t* gZ = (bf16_t*)(F.ws + WS_MOE + RW_Z) + ci * 4096;
    ld_fr(G1T, 16 * mt, lane, fa0); ld_fr(Rt, 16 * mt, lane, fa1); ld_fr(G2T, 16 * mt, lane, fa2);
#pragma unroll
    for (int q = 0; q < 2; ++q) { ld_fr(AtT, 16 * (nt0 + q), lane, fb0[q]); ld_fr(Mm, 16 * (nt0 + q), lane, fb1[q]); ld_fr(Kt, 16 * (nt0 + q), lane, fb2[q]); }
#pragma unroll
    for (int q = 0; q < 2; ++q) { const int nt = nt0 + q; const int row = 16 * mt + r, c0 = 16 * nt + 4 * g4;
        const f32x4 w1 = mm_fr(fb0[q], fa0, zero4);
        const f32x4 z = mm_fr(fb1[q], fa0, zero4);
        const f32x4 mr = mm_fr(fb2[q], fa1, zero4);
        const f32x4 p = mm_fr(fb0[q], fa2, zero4);
        f32x4 qq = mm_fr(fb1[q], fa2, zero4);
        const float gc = gC[row]; const u32x2 rt = *(const LAS u32x2*)(Rt + row * RB_LD + c0);
        const float rv[4] = {__uint_as_float(rt.x << 16), __uint_as_float(rt.x & 0xffff0000u), __uint_as_float(rt.y << 16), __uint_as_float(rt.y & 0xffff0000u)};
        float wv[4], zv[4], pv[4];
#pragma unroll
        for (int i = 0; i < 4; ++i) { const int col = c0 + i;
            wv[i] = w1[i] + rv[i]; zv[i] = z[i] + (col <= row ? mr[i] : 0.f); pv[i] = (p[i] + (row == col ? 1.0f : 0.f)) * gc;
            qq[i] = (qq[i] + bf2f(Kt[col * RB_LD + row])) * gc; }
        *(u32x2*)(gW1 + row * 64 + c0) = (u32x2){pk2(wv[0], wv[1]), pk2(wv[2], wv[3])};
        *(u32x2*)(gZ + row * 64 + c0) = (u32x2){pk2(zv[0], zv[1]), pk2(zv[2], zv[3])};
        *(u32x2*)(gPT + row * 64 + 32 * (nt >> 1) + 8 * g4 + 4 * (nt & 1)) = (u32x2){pk2(pv[0], pv[1]), pk2(pv[2], pv[3])};
        st_rm(QT, mt, nt, qq, lane); }
    __syncthreads();
    bf16_t* gU = (bf16_t*)(F.ws + WS_MOE + RW_U) + ci * 4096;
    ld_fr(VT, 16 * mt, lane, fa0);
#pragma unroll
    for (int q = 0; q < 2; ++q) ld_fr(QT, 16 * (nt0 + q), lane, fb0[q]);
#pragma unroll
    for (int q = 0; q < 2; ++q) { const int nt = nt0 + q;
        const f32x4 u = mm_fr(fb0[q], fa0, zero4);
        *(u32x2*)(gU + (16 * mt + r) * 64 + 16 * nt + 4 * g4) = (u32x2){pk2(u[0], u[1]), pk2(u[2], u[3])}; }
}
__device__ __forceinline__ void item_rwkv_carry(const Frame& F_, int item) { Frame F = relocal(F_);
    const int bh = item * 2 + (F.wave >> 2), nt = F.wave & 3, r = F.lane & 15, g = F.lane >> 4;
    const bf16_t* PT = (const bf16_t*)(F.ws + WS_MOE + RW_PT); const bf16_t* Uc = (const bf16_t*)(F.ws + WS_MOE + RW_U); bf16_t* Ss = (bf16_t*)(F.ws + WS_MOE + RW_S);
    f32x4 acc[4];
#pragma unroll
    for (int m = 0; m < 4; ++m) acc[m] = (f32x4){0.f, 0.f, 0.f, 0.f};
    for (int c = 0; c < 64; ++c) { const size_t ci = (size_t)bh * 64 + c;
        bf16x8 af[4][2]; f32x4 cin[4];
#pragma unroll
        for (int m = 0; m < 4; ++m) { const u32x2 uv = *(const u32x2*)(Uc + ci * 4096 + (16 * nt + r) * 64 + 16 * m + 4 * g);
            cin[m] = (f32x4){__uint_as_float(uv.x << 16), __uint_as_float(uv.x & 0xffff0000u), __uint_as_float(uv.y << 16), __uint_as_float(uv.y & 0xffff0000u)};
#pragma unroll
            for (int s = 0; s < 2; ++s) af[m][s] = *(const bf16x8*)(PT + ci * 4096 + (16 * m + r) * 64 + 32 * s + 8 * g); }
        unsigned pw[4][2];
#pragma unroll
        for (int m = 0; m < 4; ++m) { pw[m][0] = pk2(acc[m][0], acc[m][1]); pw[m][1] = pk2(acc[m][2], acc[m][3]);
            *(u32x2*)(Ss + ci * 4096 + (16 * nt + r) * 64 + 16 * m + 4 * g) = (u32x2){pw[m][0], pw[m][1]}; }
        bf16x8 bfr[2];
#pragma unroll
        for (int s = 0; s < 2; ++s) bfr[s] = __builtin_bit_cast(bf16x8, (u32x4){pw[2 * s][0], pw[2 * s][1], pw[2 * s + 1][0], pw[2 * s + 1][1]});
#pragma unroll
        for (int m = 0; m < 4; ++m) { acc[m] = __builtin_amdgcn_mfma_f32_16x16x32_bf16(af[m][0], bfr[0], cin[m], 0, 0, 0);
            acc[m] = __builtin_amdgcn_mfma_f32_16x16x32_bf16(af[m][1], bfr[1], acc[m], 0, 0, 0); }
    }
}
__device__ __forceinline__ void item_rwkv3(const Frame& F_, int layer, int item) { Frame F = relocal(F_);
    const int b = item >> 8, h = (item >> 6) & 3, c = item & 63; const size_t T0 = (size_t)b * SEQ + c * 64;
    const size_t ci3 = (size_t)(b * 4 + h) * 64 + c;
    const u32x4 tS = *(const u32x4*)((const bf16_t*)(F.ws + WS_MOE + RW_S) + ci3 * 4096 + F.tid * 8);
    const u32x4 tW = *(const u32x4*)((const bf16_t*)(F.ws + WS_MOE + RW_W1) + ci3 * 4096 + F.tid * 8);
    const u32x4 tZ = *(const u32x4*)((const bf16_t*)(F.ws + WS_MOE + RW_Z) + ci3 * 4096 + F.tid * 8);
    f32x4 lw4[2], lb4[2];
#pragma unroll
    for (int q = 0; q < 2; ++q) { lw4[q] = *(const f32x4*)(F.in[I_RLNW] + layer * 256 + h * 64 + 8 * (F.tid & 7) + 4 * q); lb4[q] = *(const f32x4*)(F.in[I_RLNB] + layer * 256 + h * 64 + 8 * (F.tid & 7) + 4 * q); }
    rwkv_prep<3>(F, layer, b, h, c);
    LAS float* Vv = (LAS float*)(F.lds + RW_V); LAS float* Oo = (LAS float*)(F.lds + R3_O);
    LAS float* Gg = (LAS float*)(F.lds + R3_G); LAS float* BON = (LAS float*)(F.lds + R3_BON);
    LAS bf16_t* S0b = (LAS bf16_t*)(F.lds + R3_TILES); LAS bf16_t* W1b = S0b + 4608; LAS bf16_t* Zb = W1b + 4608; LAS bf16_t* VTb = Zb + 4608;
    { const int row = F.tid >> 3, col = (F.tid & 7) * 8;
      *(LAS u32x4*)(S0b + row * RB_LD + col) = tS;
      *(LAS u32x4*)(W1b + row * RB_LD + col) = tW;
      *(LAS u32x4*)(Zb + row * RB_LD + col) = tZ;
      const int vv = F.tid & 63, part = F.tid >> 6;
      unsigned vT[4];
#pragma unroll
      for (int i = 0; i < 8; i += 2) vT[i >> 1] = pk2(Vv[(8 * part + i) * 64 + vv], Vv[(8 * part + i + 1) * 64 + vv]);
      *(LAS u32x4*)(VTb + vv * RB_LD + 8 * part) = (u32x4){vT[0], vT[1], vT[2], vT[3]}; }
    __syncthreads();
    { const int lane = F.lane, mt = F.wave >> 1, nt0 = 2 * (F.wave & 1), r = lane & 15, g4 = lane >> 4;
      bf16x8 fa0[2], fa1[2], fb0[2][2], fb1[2][2];
      ld_fr(W1b, 16 * mt, lane, fa0); ld_fr(Zb, 16 * mt, lane, fa1);
#pragma unroll
      for (int q = 0; q < 2; ++q) { ld_fr(S0b, 16 * (nt0 + q), lane, fb0[q]); ld_fr(VTb, 16 * (nt0 + q), lane, fb1[q]); }
#pragma unroll
      for (int q = 0; q < 2; ++q) { const int nt = nt0 + q;
          f32x4 o = mm_fr(fa0, fb0[q], (f32x4){0.f, 0.f, 0.f, 0.f});
          o = mm_fr(fa1, fb1[q], o);
#pragma unroll
          for (int i = 0; i < 4; ++i) Oo[(16 * mt + 4 * g4 + i) * 64 + 16 * nt + r] = o[i]; } }
    __syncthreads();
    { const int t = F.tid >> 3, p8 = F.tid & 7;
      float o[8]; float sm = 0.f;
#pragma unroll
      for (int q = 0; q < 2; ++q) { const f32x4 o4 = *(const LAS f32x4*)(Oo + t * 64 + 8 * p8 + 4 * q);
#pragma unroll
          for (int j = 0; j < 4; ++j) { o[4 * q + j] = o4[j]; sm += o4[j]; } }
      const float mean = sum8(sm) * (1.0f / 64.0f); float vs = 0.f;
#pragma unroll
      for (int j = 0; j < 8; ++j) { o[j] -= mean; vs += o[j] * o[j]; }
      const float rstd = rsqrtf(sum8(vs) * (1.0f / 64.0f) + 64e-5f); const float bon = BON[t];
      float y[8];
#pragma unroll
      for (int q = 0; q < 2; ++q) { const f32x4 v4 = *(const LAS f32x4*)(Vv + t * 64 + 8 * p8 + 4 * q), g4v = *(const LAS f32x4*)(Gg + t * 64 + 8 * p8 + 4 * q);
#pragma unroll
          for (int j = 0; j < 4; ++j) y[4 * q + j] = (o[4 * q + j] * rstd * lw4[q][j] + lb4[q][j] + bon * v4[j]) * g4v[j]; }
      *(u32x4*)((bf16_t*)(F.ws + WS_H) + (T0 + t) * DM + 256 + h * 64 + 8 * p8) = (u32x4){pk2(y[0], y[1]), pk2(y[2], y[3]), pk2(y[4], y[5]), pk2(y[6], y[7])}; }
}

constexpr int DS_SEL = 131072, DS_HIST = 135168, DS_BKT = 151552, DS_BIAS = 152064;
__device__ __forceinline__ void dsa_tables(const Frame& F_) { Frame F = relocal(F_);
    LAS int* bkt = (LAS int*)(F.lds + DS_BKT); LAS float* biasT = (LAS float*)(F.lds + DS_BIAS);
    if (F.tid < 128) { const int n = F.tid; int bk = n; if (n >= 16) { const float lr = logf((float)n / 16.0f) / 2.0794415416798357f; bk = 16 + (int)(lr * 16.0f); bk = bk < 31 ? bk : 31; } bkt[n] = bk; biasT[n] = F.in[I_RELB][n]; }
    __syncthreads();
}
__device__ __forceinline__ unsigned fkey(float f) { const unsigned u = __float_as_uint(f); return (u & 0x80000000u) ? ~u : (u | 0x80000000u); }
__device__ __forceinline__ void item_dsa(const Frame& F_, int layer, int item) { Frame F = relocal(F_);
    const bf16_t* U = (const bf16_t*)(F.ws + WS_U); const bf16_t* KI = (const bf16_t*)(F.ws + WS_KIDX);
    const bf16_t* Kb = (const bf16_t*)(F.ws + WS_K); const bf16_t* Vb = (const bf16_t*)(F.ws + WS_V);
    const int b = item & 3, qg = 511 - (item >> 2); const size_t TB = (size_t)b * SEQ, T0 = TB + qg * 8;
    LAS float* sc = (LAS float*)F.lds; LAS unsigned short* selall = (LAS unsigned short*)(F.lds + DS_SEL); LAS unsigned* histall = (LAS unsigned*)(F.lds + DS_HIST);
    LAS int* bkt = (LAS int*)(F.lds + DS_BKT); LAS float* biasT = (LAS float*)(F.lds + DS_BIAS);
    const int lane = F.lane, hh = lane >> 5;
    {
        bf16x8 af[2][2]; float wq[2][2][8];
        { const int r = lane & 31, q4 = 2 * ((r >> 2) & 1) + (r >> 4), head = 4 * ((r >> 3) & 1) + (r & 3);
#pragma unroll
          for (int mt = 0; mt < 2; ++mt)
#pragma unroll
              for (int ks = 0; ks < 2; ++ks) af[mt][ks] = *(const bf16x8*)(U + (T0 + 4 * mt + q4) * NINP + UC + 384 + head * 32 + 16 * ks + 8 * hh); }
#pragma unroll
        for (int mt = 0; mt < 2; ++mt)
#pragma unroll
            for (int q2 = 0; q2 < 2; ++q2) { float f[8]; unpack8(*(const u32x4*)(U + (T0 + 4 * mt + 2 * hh + q2) * NINP + UC + 672), f);
#pragma unroll
                for (int hd = 0; hd < 8; ++hd) wq[mt][q2][hd] = f[hd]; }
        const int ntile = (qg * 8 + 8 + 31) >> 5;
        bf16x8 nb0 = af[0][0], nb1 = af[0][0];
        if (F.wave < ntile) { const int key = F.wave * 32 + (lane & 31); nb0 = *(const bf16x8*)(KI + (TB + key) * 32 + 8 * hh); nb1 = *(const bf16x8*)(KI + (TB + key) * 32 + 16 + 8 * hh); }
        for (int kt = F.wave; kt < ntile; kt += 8) {
            const int key = kt * 32 + (lane & 31);
            const bf16x8 b0 = nb0, b1 = nb1;
            if (kt + 8 < ntile) { const int k2 = key + 256; nb0 = *(const bf16x8*)(KI + (TB + k2) * 32 + 8 * hh); nb1 = *(const bf16x8*)(KI + (TB + k2) * 32 + 16 + 8 * hh); }
#pragma unroll
            for (int mt = 0; mt < 2; ++mt) { f32x16 acc;
#pragma unroll
                for (int i = 0; i < 16; ++i) acc[i] = 0.f;
                acc = __builtin_amdgcn_mfma_f32_32x32x16_bf16(af[mt][0], b0, acc, 0, 0, 0);
                acc = __builtin_amdgcn_mfma_f32_32x32x16_bf16(af[mt][1], b1, acc, 0, 0, 0);
#pragma unroll
                for (int q2 = 0; q2 < 2; ++q2) { float s = 0.f;
#pragma unroll
                    for (int hd = 0; hd < 8; ++hd) s += fmaxf(acc[8 * q2 + hd], 0.f) * wq[mt][q2][hd];
                    const int qi = 4 * mt + 2 * hh + q2;
                    sc[qi * 4096 + key] = (key <= qg * 8 + qi) ? s : -INFINITY; } }
        }
    }
    __syncthreads();
    const int qi = F.wave, tq = qg * 8 + qi, n = tq + 1;
    LAS float* scq = sc + qi * 4096; LAS unsigned short* sel = selall + qi * 256; LAS unsigned* hist = histall + qi * 512;
    int nsel;
    if (n <= 256) { nsel = n; for (int j = lane; j < 256; j += 64) sel[j] = (unsigned short)(j < n ? j : 0); }
    else {
        nsel = 256;
        const int R = (n + 63) >> 6; const unsigned long long ltm = (1ull << lane) - 1ull;
        float lo = INFINITY, hi = -INFINITY;
        const int R4 = (n + 255) >> 8;
#pragma unroll 4
        for (int i = 0; i < R4; ++i) { const int j0 = 256 * i + 4 * lane; const f32x4 v4 = *(const LAS f32x4*)(scq + j0);
#pragma unroll
            for (int q = 0; q < 4; ++q) { const bool valid = j0 + q < n; lo = fminf(lo, valid ? v4[q] : INFINITY); hi = fmaxf(hi, valid ? v4[q] : -INFINITY); } }
        lo = wave_min(lo); hi = wave_max(hi);
        bool slow = false;
        if (!(hi > lo)) { for (int j = lane; j < 256; j += 64) sel[j] = (unsigned short)j; }
        else {
            const float scale = 1023.0f / (hi - lo);
            *(LAS u32x4*)(hist + 8 * lane) = (u32x4){0u, 0u, 0u, 0u}; *(LAS u32x4*)(hist + 8 * lane + 4) = (u32x4){0u, 0u, 0u, 0u};
#pragma unroll 2
            for (int i = 0; i < R4; ++i) { const int j0 = 256 * i + 4 * lane; const f32x4 v4 = *(const LAS f32x4*)(scq + j0);
#pragma unroll
                for (int q = 0; q < 4; ++q) { if (j0 + q < n) { int bk = (int)((v4[q] - lo) * scale); bk = bk < 1023 ? bk : 1023;
                    atomicAdd((unsigned*)(hist + (bk >> 1)), (bk & 1) ? 65536u : 1u); } } }
            const u32x4 h0 = *(const LAS u32x4*)(hist + 8 * lane), h1 = *(const LAS u32x4*)(hist + 8 * lane + 4);
            unsigned cb[16];
            cb[0] = h0.x & 0xffffu; cb[1] = h0.x >> 16; cb[2] = h0.y & 0xffffu; cb[3] = h0.y >> 16; cb[4] = h0.z & 0xffffu; cb[5] = h0.z >> 16; cb[6] = h0.w & 0xffffu; cb[7] = h0.w >> 16;
            cb[8] = h1.x & 0xffffu; cb[9] = h1.x >> 16; cb[10] = h1.y & 0xffffu; cb[11] = h1.y >> 16; cb[12] = h1.z & 0xffffu; cb[13] = h1.z >> 16; cb[14] = h1.w & 0xffffu; cb[15] = h1.w >> 16;
            unsigned tot = 0u;
#pragma unroll
            for (int q = 0; q < 16; ++q) tot += cb[q];
            const unsigned pre = wave_prefix_u(tot); const unsigned incl = (unsigned)__builtin_amdgcn_readlane((int)pre, 63) - pre + tot;
            int fb = -1; unsigned fabove = 0u, fcnt = 0u; unsigned cum = incl - tot;
#pragma unroll
            for (int q = 15; q >= 0; --q) { if (fb < 0 && cum < 256u && 256u <= cum + cb[q]) { fb = 16 * lane + q; fabove = cum; fcnt = cb[q]; } cum += cb[q]; }
            const unsigned long long mf = __ballot(fb >= 0); const int src = (int)__ffsll((long long)mf) - 1;
            const int B = __builtin_amdgcn_readlane(fb, src); const int above = __builtin_amdgcn_readlane((int)fabove, src), cntB = __builtin_amdgcn_readlane((int)fcnt, src); const int need = 256 - above;
            if (cntB > 256) slow = true;
            else {
                LAS unsigned* cand = hist;
                int base_gt = 0, base_c = 0;
#pragma unroll 2
                for (int i = 0; i < R4; ++i) { const int j0 = 256 * i + 4 * lane; const f32x4 v4 = *(const LAS f32x4*)(scq + j0);
#pragma unroll
                    for (int q = 0; q < 4; ++q) { const int j = j0 + q; const bool valid = j < n; const float v = valid ? v4[q] : lo;
                        int bk = (int)((v - lo) * scale); bk = bk < 1023 ? bk : 1023;
                        const bool gt = valid && bk > B, eq = valid && bk == B;
                        const unsigned long long mg = __ballot(gt), me = __ballot(eq);
                        if (gt) sel[base_gt + __popcll(mg & ltm)] = (unsigned short)j;
                        if (eq) { const int p = base_c + __popcll(me & ltm); cand[2 * p] = fkey(v); cand[2 * p + 1] = (unsigned)j; }
                        base_gt += __popcll(mg); base_c += __popcll(me); } }
                if (need == cntB) { for (int c = lane; c < cntB; c += 64) sel[above + c] = (unsigned short)cand[2 * c + 1]; }
                else {
                    unsigned ck[4], cx[4]; int rk[4];
#pragma unroll
                    for (int q = 0; q < 4; ++q) { const int c = lane + 64 * q; ck[q] = c < cntB ? cand[2 * c] : 0u; cx[q] = c < cntB ? cand[2 * c + 1] : 0u; rk[q] = 0; }
                    for (int c2 = 0; c2 < cntB; ++c2) { const unsigned k2 = cand[2 * c2], x2 = cand[2 * c2 + 1];
#pragma unroll
                        for (int q = 0; q < 4; ++q) rk[q] += (k2 > ck[q] || (k2 == ck[q] && x2 < cx[q])) ? 1 : 0; }
#pragma unroll
                    for (int q = 0; q < 4; ++q) { const int c = lane + 64 * q; if (c < cntB && rk[q] < need) sel[above + rk[q]] = (unsigned short)cand[2 * c + 1]; }
                }
            }
        }
        if (slow) {
        unsigned prefix = 0u; int need = 256; unsigned neq = 0u;
        for (int p = 0; p < 4; ++p) { const int shift = 24 - 8 * p;
            *(LAS u32x4*)(hist + 4 * lane) = (u32x4){0u, 0u, 0u, 0u};
            for (int i = 0; i < R; ++i) { const int j = lane + 64 * i; if (j < n) { const unsigned u = fkey(scq[j]);
                if (p == 0 || (u >> (shift + 8)) == prefix) atomicAdd((unsigned*)(hist + ((u >> shift) & 255u)), 1u); } }
            const u32x4 hv = *(const LAS u32x4*)(hist + 4 * lane);
            const unsigned tot = hv.x + hv.y + hv.z + hv.w;
            unsigned incl = tot;
#pragma unroll
            for (int o = 1; o < 64; o <<= 1) { const unsigned t = shdown_u(incl, o); if (lane + o < 64) incl += t; }
            const unsigned above = incl - tot;
            int fb = -1; unsigned fabove = 0u, feq = 0u; unsigned cum = above;
            { const unsigned hq[4] = {hv.x, hv.y, hv.z, hv.w};
#pragma unroll
              for (int q = 3; q >= 0; --q) { if (fb < 0 && cum < (unsigned)need && (unsigned)need <= cum + hq[q]) { fb = 4 * lane + q; fabove = cum; feq = hq[q]; } cum += hq[q]; } }
            const unsigned long long m = __ballot(fb >= 0);
            const int src = (int)__ffsll((long long)m) - 1;
            const int bin = shidx_i(fb, src); const unsigned ab = (unsigned)shidx_i((int)fabove, src); neq = (unsigned)shidx_i((int)feq, src);
            need -= (int)ab; prefix = (prefix << 8) | (unsigned)bin;
        }
        const int ngt = 256 - need;
        int base_gt = 0, base_eq = 0;
        for (int i = 0; i < R; ++i) { const int j = lane + 64 * i; const unsigned u = (j < n) ? fkey(scq[j]) : 0u;
            const bool gt = (j < n) && (u > prefix), eq = (j < n) && (u == prefix);
            const unsigned long long mg = __ballot(gt), me = __ballot(eq); const unsigned long long lt = (1ull << lane) - 1ull;
            if (gt) sel[base_gt + __popcll(mg & lt)] = (unsigned short)j;
            if (eq) { const int rk = base_eq + __popcll(me & lt); if (rk < need) sel[ngt + rk] = (unsigned short)j; }
            base_gt += __popcll(mg); base_eq += __popcll(me); }
        (void)neq;
            }
    }
    const int nt16 = (nsel + 15) >> 4, r16 = lane & 15, g4 = lane >> 4;
    LAS float* biasj = scq + 2048;
#pragma unroll
    for (int q = 0; q < 4; ++q) { const int j = lane + 64 * q; f32x4 bv = (f32x4){-INFINITY, -INFINITY, -INFINITY, -INFINITY};
        if (j < nsel) { const int dist = tq - (int)sel[j]; const int bk = dist < 128 ? bkt[dist < 0 ? 0 : dist] : 31; bv = *(const LAS f32x4*)(biasT + 4 * bk); }
#pragma unroll
        for (int h = 0; h < 4; ++h) biasj[h * 256 + j] = bv[h]; }
    bf16x8 qf[2];
#pragma unroll
    for (int s = 0; s < 2; ++s) { u32x4 z = (u32x4){0u, 0u, 0u, 0u}; if (r16 < 4) z = *(const u32x4*)(U + (T0 + qi) * NINP + UC + r16 * 64 + 32 * s + 8 * g4); qf[s] = __builtin_bit_cast(bf16x8, z); }
    float lg[16][4]; float mx = -INFINITY;
#define DSA_QK(M0, NM) do { int keyr[NM]; bf16x8 a0[NM], a1[NM]; \
        _Pragma("unroll") for (int m8 = 0; m8 < NM; ++m8) keyr[m8] = sel[16 * ((M0) + m8) + r16]; \
        _Pragma("unroll") for (int m8 = 0; m8 < NM; ++m8) { a0[m8] = *(const bf16x8*)(Kb + (TB + keyr[m8]) * 64 + 8 * g4); a1[m8] = *(const bf16x8*)(Kb + (TB + keyr[m8]) * 64 + 32 + 8 * g4); } \
        _Pragma("unroll") for (int m8 = 0; m8 < NM; ++m8) { const int m = (M0) + m8; \
            f32x4 acc = (f32x4){0.f, 0.f, 0.f, 0.f}; \
            acc = __builtin_amdgcn_mfma_f32_16x16x32_bf16(a0[m8], qf[0], acc, 0, 0, 0); \
            acc = __builtin_amdgcn_mfma_f32_16x16x32_bf16(a1[m8], qf[1], acc, 0, 0, 0); \
            const f32x4 bq = *(const LAS f32x4*)(biasj + (r16 & 3) * 256 + 16 * m + 4 * g4); \
            _Pragma("unroll") for (int i = 0; i < 4; ++i) { const float v = acc[i] * 0.125f + bq[i]; lg[m][i] = v; mx = fmaxf(mx, v); } } } while (0)
    if (nt16 > 8) { DSA_QK(0, 16); }
    else { DSA_QK(0, 8);
#pragma unroll
        for (int m8 = 8; m8 < 16; ++m8)
#pragma unroll
            for (int i = 0; i < 4; ++i) lg[m8][i] = -INFINITY; }
#undef DSA_QK
    mx = xrows(mx, OpMax());
    float sm = 0.f;
#pragma unroll
    for (int m = 0; m < 16; ++m)
#pragma unroll
        for (int i = 0; i < 4; ++i) { const float p = __expf(lg[m][i] - mx); lg[m][i] = p; sm += p; }
    sm = xrows(sm, OpAdd());
    f32x4 ov[4];
#pragma unroll
    for (int nt = 0; nt < 4; ++nt) ov[nt] = (f32x4){0.f, 0.f, 0.f, 0.f};
    const unsigned vs_base = (unsigned)(unsigned long)scq;
#pragma unroll
    for (int half = 0; half < 2; ++half) {
        if (half * 8 < nt16) {
            asm volatile("s_waitcnt lgkmcnt(0)" ::: "memory");
            int vkey[16];
#pragma unroll
            for (int q = 0; q < 16; ++q) { const int rho = 8 * q + (lane >> 3);
                vkey[q] = sel[half * 128 + (rho & ~31) + 16 * ((rho >> 2) & 1) + 4 * ((rho >> 3) & 3) + (rho & 3)]; }
            asm volatile("s_waitcnt lgkmcnt(0)" : "+v"(vkey[0]), "+v"(vkey[1]), "+v"(vkey[2]), "+v"(vkey[3]), "+v"(vkey[4]), "+v"(vkey[5]), "+v"(vkey[6]), "+v"(vkey[7]),
                         "+v"(vkey[8]), "+v"(vkey[9]), "+v"(vkey[10]), "+v"(vkey[11]), "+v"(vkey[12]), "+v"(vkey[13]), "+v"(vkey[14]), "+v"(vkey[15]) :: "memory");
#pragma unroll
            for (int q = 0; q < 16; ++q)
                __builtin_amdgcn_global_load_lds((const unsigned*)(Vb + (TB + vkey[q]) * 64 + 8 * (lane & 7)), (LAS unsigned*)((LAS unsigned char*)scq + q * 1024), 16, 0, 0);
            asm volatile("s_waitcnt vmcnt(0)" ::: "memory");
#pragma unroll
            for (int s4 = 0; s4 < 4; ++s4) { const int s = half * 4 + s4;
                u32x4 pw; pw.x = pk2(lg[2 * s][0], lg[2 * s][1]); pw.y = pk2(lg[2 * s][2], lg[2 * s][3]); pw.z = pk2(lg[2 * s + 1][0], lg[2 * s + 1][1]); pw.w = pk2(lg[2 * s + 1][2], lg[2 * s + 1][3]);
                const bf16x8 pa = __builtin_bit_cast(bf16x8, pw);
                const unsigned ad = vs_base + (unsigned)((32 * s4 + 8 * g4 + (r16 >> 2)) * 128 + (r16 & 3) * 8);
                u32x2 t0[4], t1[4];
                asm volatile("ds_read_b64_tr_b16 %0, %8\n\tds_read_b64_tr_b16 %1, %8 offset:512\n\tds_read_b64_tr_b16 %2, %8 offset:32\n\tds_read_b64_tr_b16 %3, %8 offset:544\n\t"
                             "ds_read_b64_tr_b16 %4, %8 offset:64\n\tds_read_b64_tr_b16 %5, %8 offset:576\n\tds_read_b64_tr_b16 %6, %8 offset:96\n\tds_read_b64_tr_b16 %7, %8 offset:608\n\ts_waitcnt lgkmcnt(0)"
                             : "=&v"(t0[0]), "=&v"(t1[0]), "=&v"(t0[1]), "=&v"(t1[1]), "=&v"(t0[2]), "=&v"(t1[2]), "=&v"(t0[3]), "=&v"(t1[3]) : "v"(ad) : "memory");
#pragma unroll
                for (int nt = 0; nt < 4; ++nt) { const bf16x8 vb = __builtin_bit_cast(bf16x8, (u32x4){t0[nt].x, t0[nt].y, t1[nt].x, t1[nt].y});
                    ov[nt] = __builtin_amdgcn_mfma_f32_16x16x32_bf16(vb, pa, ov[nt], 0, 0, 0); } }
        }
    }
    if (r16 < 4) { const float inv = 1.0f / sm;
        bf16_t* Y = (bf16_t*)(F.ws + WS_H) + (T0 + qi) * DM + 512 + r16 * 64 + 4 * g4;
#pragma unroll
        for (int nt = 0; nt < 4; ++nt) *(u32x2*)(Y + 16 * nt) = (u32x2){pk2(ov[nt][0] * inv, ov[nt][1] * inv), pk2(ov[nt][2] * inv, ov[nt][3] * inv)}; }
}

__device__ __forceinline__ void phase_router(const Frame& F_, int layer) { Frame F = relocal(F_); const int cset = layer;
    const float* X = (const float*)(F.ws + WS_X);
    const bf16_t* WH = (const bf16_t*)(F.ws + WS_WRT) + (size_t)layer * 2 * 49152; const bf16_t* WL = WH + 49152;
    LAS float* part = (LAS float*)F.lds;
    LAS float* ssq = (LAS float*)(F.lds + 24576);
    LAS int* es = (LAS int*)(F.lds + 25088);
    LAS int* lr = (LAS int*)(F.lds + 25600);
    LAS float* wsl = (LAS float*)(F.lds + 26112);
    LAS float* rsd = (LAS float*)(F.lds + 26624);
    for (int blk = F.bid; blk < NTOK / 64; blk += F.G) {
        __syncthreads();
        const int mt = F.wave & 3, kh = F.wave >> 2, r16 = F.lane & 15, g4 = F.lane >> 4;
        const float* xr = X + ((size_t)blk * 64 + mt * 16 + r16) * DM + kh * 512 + 8 * g4;
        f32x4 acc[3]; acc[0] = acc[1] = acc[2] = (f32x4){0.f, 0.f, 0.f, 0.f}; float ss = 0.f;
#pragma unroll 4
        for (int ks = 0; ks < 16; ++ks) {
            const f32x4 xa = *(const f32x4*)(xr + ks * 32), xb = *(const f32x4*)(xr + ks * 32 + 4);
            ss += xa[0] * xa[0] + xa[1] * xa[1] + xa[2] * xa[2] + xa[3] * xa[3] + xb[0] * xb[0] + xb[1] * xb[1] + xb[2] * xb[2] + xb[3] * xb[3];
            float xv[8] = {xa[0], xa[1], xa[2], xa[3], xb[0], xb[1], xb[2], xb[3]}; unsigned hw[4], lw[4];
#pragma unroll
            for (int j = 0; j < 4; ++j) { const bf16_t h0 = f2bf(xv[2 * j]), h1 = f2bf(xv[2 * j + 1]); hw[j] = (unsigned)h0 | ((unsigned)h1 << 16);
                lw[j] = pk2(xv[2 * j] - bf2f(h0), xv[2 * j + 1] - bf2f(h1)); }
            const bf16x8 ahi = __builtin_bit_cast(bf16x8, (u32x4){hw[0], hw[1], hw[2], hw[3]}), alo = __builtin_bit_cast(bf16x8, (u32x4){lw[0], lw[1], lw[2], lw[3]});
#pragma unroll
            for (int nt = 0; nt < 3; ++nt) { const size_t wo = (size_t)(nt * 16 + r16) * 1024 + kh * 512 + ks * 32 + 8 * g4;
                const bf16x8 bh = *(const bf16x8*)(WH + wo), bl = *(const bf16x8*)(WL + wo);
                acc[nt] = __builtin_amdgcn_mfma_f32_16x16x32_bf16(ahi, bh, acc[nt], 0, 0, 0);
                acc[nt] = __builtin_amdgcn_mfma_f32_16x16x32_bf16(ahi, bl, acc[nt], 0, 0, 0);
                acc[nt] = __builtin_amdgcn_mfma_f32_16x16x32_bf16(alo, bh, acc[nt], 0, 0, 0); }
        }
        ss = xrows(ss, OpAdd());
        if (g4 == 0) ssq[kh * 64 + mt * 16 + r16] = ss;
#pragma unroll
        for (int nt = 0; nt < 3; ++nt)
#pragma unroll
            for (int i = 0; i < 4; ++i) part[(kh * 64 + mt * 16 + 4 * g4 + i) * 48 + nt * 16 + r16] = acc[nt][i];
        __syncthreads();
        if (F.tid < 64) { const float rstd = rsqrtf((ssq[F.tid] + ssq[64 + F.tid]) * (1.0f / DM) + 1e-6f); rsd[F.tid] = rstd;
            float l[36];
#pragma unroll
            for (int o = 0; o < 36; ++o) l[o] = (part[F.tid * 48 + o] + part[(64 + F.tid) * 48 + o]) * rstd + (o < 32 ? F.in[I_BRE][layer * 32 + o] : F.in[I_BRG][layer * 4 + o - 32]);
            int gs = 0; float gm = l[32];
#pragma unroll
            for (int j = 1; j < 4; ++j) if (l[32 + j] > gm) { gm = l[32 + j]; gs = j; }
            float den = 0.f;
#pragma unroll
            for (int j = 0; j < 4; ++j) den += __expf(l[32 + j] - gm);
            const float gate = 1.0f / den;
            float e8[8];
#pragma unroll
            for (int j = 0; j < 8; ++j) e8[j] = gs == 0 ? l[j] : gs == 1 ? l[8 + j] : gs == 2 ? l[16 + j] : l[24 + j];
            int i1 = 0; float v1 = e8[0];
#pragma unroll
            for (int j = 1; j < 8; ++j) if (e8[j] > v1) { v1 = e8[j]; i1 = j; }
            int i2 = -1; float v2 = -INFINITY;
#pragma unroll
            for (int j = 0; j < 8; ++j) if (j != i1 && e8[j] > v2) { v2 = e8[j]; i2 = j; }
            const float e2 = __expf(v2 - v1); const float p1 = 1.0f / (1.0f + e2);
            es[F.tid * 2] = gs * 8 + i1; es[F.tid * 2 + 1] = gs * 8 + i2; wsl[F.tid * 2] = p1 * gate; wsl[F.tid * 2 + 1] = (1.0f - p1) * gate; }
        __syncthreads();
        if (F.tid < 32) { int cnt = 0; for (int i = 0; i < 128; ++i) if (es[i] == F.tid) lr[i] = cnt++;
            if (cnt) { const int base = (int)__hip_atomic_fetch_add(F.ctl + CW_CNT + cset * 32 + F.tid, (unsigned)cnt, __ATOMIC_RELAXED, __HIP_MEMORY_SCOPE_AGENT);
                for (int i = 0; i < 128; ++i) if (es[i] == F.tid) lr[i] += base; } }
        __syncthreads();
        if (F.tid < 64) { int* rt = (int*)(F.ws + WS_ROUTE) + ((size_t)blk * 64 + F.tid) * 8;
            rt[0] = es[F.tid * 2]; rt[1] = es[F.tid * 2 + 1]; ((float*)rt)[2] = wsl[F.tid * 2]; ((float*)rt)[3] = wsl[F.tid * 2 + 1]; rt[4] = lr[F.tid * 2]; rt[5] = lr[F.tid * 2 + 1]; ((float*)rt)[6] = rsd[F.tid]; }
    }
    __syncthreads();
    if (F.tid == 0) __hip_atomic_fetch_add(F.ctl + CW_RB + 64 * layer, 1u, __ATOMIC_RELAXED, __HIP_MEMORY_SCOPE_AGENT);
}
__device__ __forceinline__ void phase_moe_convert(const Frame& F_, int layer) { Frame F = relocal(F_);
    bf16_t* WGU = (bf16_t*)(F.ws + WS_MOE + MOE_WGU);
    for (int t = F.bid; t < 1024; t += F.G) {
        const int e = t >> 5, r = t & 31, kt = r >> 1, nt = r & 1; const size_t eo = ((size_t)layer * 32 + e) * 1024 * 256;
        tr_tile(F, 256, WGU + (size_t)e * 512 * 1024, 1024, kt * 64, nt * 256, SmGU{F.in[I_WGATE] + eo, F.in[I_WUP] + eo}); }
}
__device__ __forceinline__ void phase_moe_convert_down(const Frame& F_, int layer) { Frame F = relocal(F_);
    bf16_t* WD = (bf16_t*)(F.ws + WS_MOE + MOE_WD);
    for (;;) { const int q = q_pop(F, 32 + layer); if (q >= 512) break;
        const int e = q >> 4, r = q & 15, kt = r >> 2, nt = r & 3;
        tr_tile(F, 1024, WD + (size_t)e * 1024 * 256, 256, kt * 64, nt * 256, SmId{F.in[I_WDOWN] + ((size_t)layer * 32 + e) * 256 * 1024}); }
}
__device__ __forceinline__ void phase_gather(const Frame& F_, int layer) { Frame F = relocal(F_);
    LAS int* off = (LAS int*)F.lds;
    __syncthreads();
    if (F.tid == 0) { unsigned sp = 0;
        while (__hip_atomic_load(F.ctl + CW_RB + 64 * layer, __ATOMIC_RELAXED, __HIP_MEMORY_SCOPE_AGENT) < (unsigned)F.G) { __builtin_amdgcn_s_sleep(2); if (++sp > (1u << 22)) break; } }
    __syncthreads();
    if (F.tid == 0) { int acc = 0; for (int e = 0; e < 32; ++e) { off[e] = acc; const int c = (int)__hip_atomic_load(F.ctl + CW_CNT + layer * 32 + e, __ATOMIC_RELAXED, __HIP_MEMORY_SCOPE_AGENT); acc += (c + 255) & ~255; } off[32] = acc; }
    __syncthreads();
    int* tiles = (int*)(F.ws + WS_TILES); int* row_tok = (int*)(F.ws + WS_ROWS); float* row_w = (float*)(F.ws + WS_ROWS) + MAXROWS;
    if (F.bid == 0) { if (F.tid == 0) tiles[0] = off[32] >> 8; if (F.tid < 33) tiles[1 + F.tid] = off[F.tid];
        if (F.tid < 32) for (int rt = off[F.tid] >> 8; rt < (off[F.tid + 1] >> 8); ++rt) tiles[64 + rt] = F.tid; }
    for (int e = F.bid; e < 32; e += F.G) { const int c = (int)__hip_atomic_load(F.ctl + CW_CNT + layer * 32 + e, __ATOMIC_RELAXED, __HIP_MEMORY_SCOPE_AGENT);
        for (int r = off[e] + c + F.tid; r < off[e + 1]; r += NTHR) { row_tok[r] = -1; row_w[r] = 0.f; } }
    const float* X = (const float*)(F.ws + WS_X); bf16_t* HP = (bf16_t*)(F.ws + WS_U); const float* nw = F.in[I_NORM2] + (size_t)layer * DM;
    f32x4 nwv[4];
#pragma unroll
    for (int j = 0; j < 4; ++j) nwv[j] = *(const f32x4*)(nw + 4 * F.lane + 256 * j);
    for (int blk = F.bid; blk < NTOK / 64; blk += F.G)
    for (int i4 = 0; i4 < 2; ++i4) {
        int p0[4], p1[4], tt[4]; float rstd[4], w0[4], w1[4]; f32x4 xv[4][4];
#pragma unroll
        for (int r = 0; r < 4; ++r) { const int t = blk * 64 + F.wave * 8 + 4 * i4 + r; tt[r] = t;
            const int* rt = (const int*)(F.ws + WS_ROUTE) + (size_t)t * 8; rstd[r] = ((const float*)rt)[6]; w0[r] = ((const float*)rt)[2]; w1[r] = ((const float*)rt)[3];
            p0[r] = off[rt[0]] + rt[4]; p1[r] = off[rt[1]] + rt[5];
#pragma unroll
            for (int j = 0; j < 4; ++j) xv[r][j] = *(const f32x4*)(X + (size_t)t * DM + 4 * F.lane + 256 * j); }
#pragma unroll
        for (int r = 0; r < 4; ++r) {
#pragma unroll
            for (int j = 0; j < 4; ++j) { const int c = 4 * F.lane + 256 * j; const f32x4 v = xv[r][j] * rstd[r] * nwv[j];
                u32x2 o; o.x = pk2(v[0], v[1]); o.y = pk2(v[2], v[3]);
                *(u32x2*)(HP + (size_t)tt[r] * DM + c) = o; }
            if (F.lane == 0) { row_tok[p0[r]] = tt[r] * 2; row_w[p0[r]] = w0[r]; row_tok[p1[r]] = tt[r] * 2 + 1; row_w[p1[r]] = w1[r]; } }
    }
}

constexpr int NPH_LAYER = 9, NPHASE = 1 + 2 * NPH_LAYER + 1;
#ifndef MK_ONLY
#define MK_ONLY -1
#endif
#ifndef MK_ITEM
#define MK_ITEM -1
#endif
#define EN(o) (MK_ONLY < 0 || MK_ONLY == (o))
#define IT(o) (MK_ITEM < 0 || MK_ITEM == (o))
__global__ void __launch_bounds__(NTHR, 2) mk_forward(Params P) {
    extern __shared__ __attribute__((aligned(16))) unsigned char lds_raw[];
    Frame F; F.lds = (LAS unsigned char*)lds_raw; F.tid = threadIdx.x; F.lane = F.tid & 63; F.wave = __builtin_amdgcn_readfirstlane(F.tid >> 6); F.bid = blockIdx.x; F.G = gridDim.x;
    F.in = (in_tab_t)__builtin_amdgcn_kernarg_segment_ptr(); F.out = P.out; F.ws = P.ws; F.ctl = (unsigned*)(P.ws + WS_CTL); F.misc = (volatile LAS int*)(F.lds + MISC_OFF);
    if (F.tid < 64) ((LAS unsigned*)(F.lds + MISC_OFF))[F.tid] = 0u;
    __syncthreads();
    const int lo = P.ph_lo, hi = P.ph_hi;
    XcdBarrier bar; bar.bar = F.ctl + CW_BAR; bar.x = 0; bar.st = (volatile LAS unsigned*)(F.lds + MISC_OFF + 16);
    if (hi - lo > 1) bar = xcd_barrier_post(F.ctl + CW_BAR, (volatile LAS unsigned*)(F.lds + MISC_OFF + 16));
#define IN(k) (lo <= (k) && (k) < hi)
#define SEAM(k) do { if (IN(k) && IN((k) + 1)) xcd_barrier(bar); } while (0)
#define QLOOP(qi, n, body) for (;;) { const int it = q_pop(F, layer * 12 + (qi)); if (it >= (n)) break; body; }
    if (EN(100) && IN(0)) { phase_prologue(F); phase_norm(F, F.in[I_X], false, F.in[I_NORM1], 3); } SEAM(0);
#pragma unroll
    for (int layer = 0; layer < DEPTH; ++layer) {
        const int pb = 1 + layer * NPH_LAYER;
        if (layer > 0) { if (EN(0) && IN(pb + 0)) { phase_norm(F, (const float*)(F.ws + WS_X), true, F.in[I_NORM1] + (size_t)layer * DM, 0); } SEAM(pb + 0); }
        if (EN(1) && IN(pb + 1)) { const Frame F_ = F; Frame F = relocal(F_); pg8::StaticOrder S; S.init((const bf16_t*)(F.ws + WS_H), (const bf16_t*)(F.ws + WS_WIN) + (size_t)layer * NINP * DM, NTOK, NINP, DM, F.G, F.bid);
            pg8::EpiBf16 E{(bf16_t*)(F.ws + WS_U), NINP}; pg8::gemm_phase(F.lds, DM, S, E); } SEAM(pb + 1);
#define SLOOP(n, body) for (int it = F.bid; it < (n); it += F.G) { __syncthreads(); body; }
        if (EN(2) && IN(pb + 2)) {
            if (IT(1)) SLOOP(1024, item_rwkv1(F, layer, it));
            if (IT(0)) SLOOP(256, item_s5<1>(F, layer, it));
            if (IT(2)) SLOOP(256, item_mamba<1>(F, layer, it));
            if (IT(3)) SLOOP(256, item_kv(F, layer, it));
        } SEAM(pb + 2);
        if (EN(3) && IN(pb + 3)) {
            if (IT(0)) SLOOP(8, item_rwkv_carry(F, it));
            if (IT(1)) { for (int it = F.bid - 8; it >= 0 && it < 16; it += F.G) { __syncthreads(); item_mamba_carry(F, it); } }
            if (IT(2)) { for (int it = F.bid - 24; it >= 0 && it < 4; it += F.G) { __syncthreads(); item_s5_carry(F, layer, it); } }
            if (IT(3)) {
                dsa_tables(F);
                const int pref = (int)(xb_xcc_id() & 3u);
#pragma unroll 1
                for (int k4 = 0; k4 < 4; ++k4) { const int bq = (pref + k4) & 3;
                    for (;;) { const int it = q_pop(F, 24 + layer * 4 + bq); if (it >= 512) break; item_dsa(F, layer, it * 4 + bq); } } }
        } SEAM(pb + 3);
        if (EN(4) && IN(pb + 4)) {
            if (IT(0)) SLOOP(256, item_s5<2>(F, layer, it));
            if (IT(2)) SLOOP(256, item_mamba<2>(F, layer, it));
            if (IT(1)) SLOOP(1024, item_rwkv3(F, layer, it));
        } SEAM(pb + 4);
        if (EN(6) && IN(pb + 5)) { const Frame F_ = F; Frame F = relocal(F_); pg8::StaticOrder S; S.init((const bf16_t*)(F.ws + WS_H), (const bf16_t*)(F.ws + WS_WOUT) + (size_t)layer * DM * DM, NTOK, DM, DM, F.G, F.bid);
            pg8::EpiResid E{layer == 0 ? F.in[I_X] : (const float*)(F.ws + WS_X), (float*)(F.ws + WS_X), DM}; pg8::gemm_phase(F.lds, DM, S, E); } SEAM(pb + 5);
        if (EN(7) && IN(pb + 6)) { phase_router(F, layer); phase_moe_convert(F, layer); phase_gather(F, layer); } SEAM(pb + 6);
        if (EN(8) && IN(pb + 7)) { const Frame F_ = F; Frame F = relocal(F_); LAS int* ul = (LAS int*)(F.lds + pg8::STAGE_BYTES + 8192); if (F.tid == 0) pg8::MoeOrder::build(ul, (const int*)(F.ws + WS_TILES), 2, F.G, F.bid); __syncthreads();
            pg8::MoeOrder S{DM, (const char*)(F.ws + WS_U), (const char*)(F.ws + WS_MOE + MOE_WGU), (size_t)512 * 1024 * 2, ul};
            pg8::EpiGated<1> E{(bf16_t*)(F.ws + WS_H), 256, 0, nullptr, nullptr}; pg8::gemm_phase<pg8::EpiGated<1>, pg8::MoeOrder, true>(F.lds, DM, S, E, (const char*)(F.ws + WS_U), (const int*)(F.ws + WS_ROWS)); phase_moe_convert_down(F, layer); } SEAM(pb + 7);
        if (EN(9) && IN(pb + 8)) { const Frame F_ = F; Frame F = relocal(F_); LAS int* ul = (LAS int*)(F.lds + pg8::STAGE_BYTES + 8192); if (F.tid == 0) pg8::MoeOrder::build(ul, (const int*)(F.ws + WS_TILES), 4, F.G, F.bid); __syncthreads();
            pg8::MoeOrder S{256, (const char*)(F.ws + WS_H), (const char*)(F.ws + WS_MOE + MOE_WD), (size_t)1024 * 256 * 2, ul};
            pg8::EpiMoeOut E{(bf16_t*)(F.ws + WS_U), (const int*)(F.ws + WS_ROWS), (const float*)(F.ws + WS_ROWS) + MAXROWS, F.lds}; pg8::gemm_phase(F.lds, 256, S, E); } SEAM(pb + 8);
    }
    if (EN(101) && IN(NPHASE - 1)) { phase_norm(F, (const float*)(F.ws + WS_X), true, F.in[I_FNORM], 2); }
#undef IN
#undef SEAM
}

#ifndef MK_SPLIT
#define MK_SPLIT 0
#endif
extern "C" void kernel_launch(void* const* d_in, const int* in_sizes, int n_in, void* d_out, int out_size, void* d_ws, size_t ws_size, hipStream_t stream) {
    static int grid = 0;
    if (grid == 0) {
        if (n_in != 44 || out_size != NTOK * DM || ws_size < WS_END) { fprintf(stderr, "kernel_launch: unexpected shapes (n_in %d out %d ws %zu need %zu)\n", n_in, out_size, ws_size, (size_t)WS_END); grid = -1; return; }
        int dev = 0, cus = 0;
        if (hipGetDevice(&dev) != hipSuccess || hipDeviceGetAttribute(&cus, hipDeviceAttributeMultiprocessorCount, dev) != hipSuccess) { grid = -1; return; }
        if (hipFuncSetAttribute((const void*)mk_forward, hipFuncAttributeMaxDynamicSharedMemorySize, LDS_BYTES) != hipSuccess) { fprintf(stderr, "kernel_launch: hipFuncSetAttribute failed\n"); grid = -1; return; }
        int per_cu = 0;
        if (hipOccupancyMaxActiveBlocksPerMultiprocessor(&per_cu, (const void*)mk_forward, NTHR, LDS_BYTES) != hipSuccess || per_cu < 1) { fprintf(stderr, "kernel_launch: occupancy query says %d\n", per_cu); }
        (void)hipGetLastError();
        grid = cus;
    }
    if (grid < 0) return;
    hipMemsetAsync((char*)d_ws + WS_CTL, 0, CTL_BYTES, stream);
    Params p{};
    for (int i = 0; i < 44; ++i) p.in[i] = (const float*)d_in[i];
    p.out = (float*)d_out; p.ws = (unsigned char*)d_ws;
#if MK_SPLIT
    for (int ph = 0; ph < NPHASE; ++ph) { p.ph_lo = ph; p.ph_hi = ph + 1; hipLaunchKernelGGL(mk_forward, dim3(grid), dim3(NTHR), LDS_BYTES, stream, p); }
#else
    p.ph_lo = 0; p.ph_hi = NPHASE; hipLaunchKernelGGL(mk_forward, dim3(grid), dim3(NTHR), LDS_BYTES, stream, p);
#endif
}
```

```cpp
#include <hip/hip_runtime.h>
#include <stdint.h>
#include <stdio.h>

#define LAS __attribute__((address_space(3)))
typedef unsigned short bf16_t;
typedef short bf16x8 __attribute__((ext_vector_type(8)));
typedef float f32x4 __attribute__((ext_vector_type(4)));
typedef float f32x2 __attribute__((ext_vector_type(2)));
typedef float f32x16 __attribute__((ext_vector_type(16)));
typedef unsigned u32x4 __attribute__((ext_vector_type(4)));
typedef unsigned u32x2 __attribute__((ext_vector_type(2)));

constexpr int NTOK = 16384, DM = 1024, SEQ = 4096, NBATCH = 4, DEPTH = 2;
constexpr int NIN = 2604, NINP = 2816;
constexpr int UM = 0;
constexpr int UR = 784;
constexpr int UC = 1680;
constexpr int US = 2368;
constexpr int NTHR = 512;
constexpr int LDS_BYTES = 163840;
constexpr int MISC_OFF = LDS_BYTES - 256;

constexpr size_t WS_CTL   = 0;
constexpr size_t CTL_BYTES = 65536;
constexpr size_t WS_X     = WS_CTL + CTL_BYTES;
constexpr size_t WS_H     = WS_X + (size_t)NTOK * DM * 4;
constexpr size_t WS_U     = WS_H + (size_t)NTOK * DM * 2;
constexpr size_t WS_WIN   = WS_U + (size_t)NTOK * NINP * 2;
constexpr size_t WS_WOUT  = WS_WIN + (size_t)2 * NINP * DM * 2;
constexpr size_t WS_GLU   = WS_WOUT + (size_t)2 * DM * DM * 2;
constexpr size_t WS_MOE   = WS_GLU + (size_t)2 * 512 * 256 * 2;
constexpr size_t MOE_WGU  = 0;
constexpr size_t MOE_WD   = (size_t)32 * 512 * 1024 * 2;
constexpr size_t MOE_BYTES = MOE_WD + (size_t)32 * 1024 * 256 * 2;
constexpr size_t RW_PT    = 0;
constexpr size_t RW_U     = (size_t)1024 * 4096 * 2;
constexpr size_t RW_S     = RW_U + (size_t)1024 * 4096 * 2;
constexpr size_t RW_W1    = RW_S + (size_t)1024 * 4096 * 2;
constexpr size_t RW_Z     = RW_W1 + (size_t)1024 * 4096 * 2;
constexpr size_t YSG_OFF  = RW_Z + (size_t)1024 * 4096 * 2;
static_assert(YSG_OFF + (size_t)NTOK * 256 * 2 <= MOE_BYTES, "alias");
constexpr size_t WS_MST   = WS_MOE + MOE_BYTES;
constexpr size_t WS_MDEC  = WS_MST + (size_t)4 * 64 * 4 * 4096 * 4;
constexpr size_t WS_S5ST  = WS_MDEC + 4096;
constexpr size_t WS_K     = WS_S5ST + (size_t)4 * 64 * 2048 * 4;
constexpr size_t WS_V     = WS_K + (size_t)NTOK * 64 * 2;
constexpr size_t WS_KIDX  = WS_V + (size_t)NTOK * 64 * 2;
constexpr size_t WS_ROUTE = WS_KIDX + (size_t)NTOK * 32 * 2;
constexpr size_t WS_ROWS  = WS_ROUTE + (size_t)NTOK * 32;
constexpr int    MAXROWS  = 49152;
constexpr size_t WS_TILES = WS_ROWS + (size_t)MAXROWS * 8;
constexpr size_t WS_S5TAB = WS_TILES + 4096;
constexpr size_t S5TAB_F  = (size_t)(2048 + 2048 + 32768) * 4;
constexpr size_t S5TAB_BBT = S5TAB_F + (size_t)16 * 16 * 128 * 2;
constexpr size_t S5TAB_L  = S5TAB_BBT + (size_t)16 * 128 * 16 * 2;
constexpr size_t WS_WRT   = WS_S5TAB + 2 * S5TAB_L;
constexpr size_t WS_BON   = WS_WRT + (size_t)2 * 2 * 48 * 1024 * 2;
constexpr size_t WS_END   = WS_BON + (size_t)1024 * 64 * 4;

constexpr int CW_BAR = 0;
constexpr int CW_Q   = 4096;
constexpr int CW_CNT = 8192;
constexpr int CW_RB  = 8448;

__device__ __forceinline__ float bf2f(bf16_t b) { return __uint_as_float(((unsigned)b) << 16); }
__device__ __forceinline__ bf16_t f2bf(float f) { const __bf16 h = (__bf16)f; return __builtin_bit_cast(bf16_t, h); }
__device__ __forceinline__ unsigned pk2(float lo, float hi) { typedef __bf16 bf2_t __attribute__((ext_vector_type(2))); const bf2_t h = __builtin_convertvector((f32x2){lo, hi}, bf2_t); return __builtin_bit_cast(unsigned, h); }
__device__ __forceinline__ unsigned cvt_pk_bf16(float lo, float hi) { unsigned r; asm volatile("v_cvt_pk_bf16_f32 %0, %1, %2" : "=v"(r) : "v"(lo), "v"(hi)); return r; }
__device__ __forceinline__ float sigmoidf_(float x) { return 1.0f / (1.0f + __expf(-x)); }
__device__ __forceinline__ float siluf_(float x) { return x / (1.0f + __expf(-x)); }
__device__ __forceinline__ float tanhf_(float x) { const float e = __expf(2.0f * x); return 1.0f - 2.0f / (e + 1.0f); }
__device__ __forceinline__ float softplusf_(float x) { return fmaxf(x, 0.0f) + log1pf(__expf(-fabsf(x))); }
__device__ __forceinline__ float gelu_tanh(float x) { return 0.5f * x * (1.0f + tanhf_(0.7978845608028654f * (x + 0.044715f * x * x * x))); }
template <int CTRL> __device__ __forceinline__ float dppf(float x) { return __int_as_float(__builtin_amdgcn_update_dpp(0, __float_as_int(x), CTRL, 0xF, 0xF, true)); }
__device__ __forceinline__ float sum4(float x) { x += dppf<0xB1>(x); x += dppf<0x4E>(x); return x; }
__device__ __forceinline__ float sum8(float x) { x = sum4(x); x += dppf<0x141>(x); return x; }
__device__ __forceinline__ float sum16(float x) { x = sum8(x); x += dppf<0x140>(x); return x; }
__device__ __forceinline__ int lane_id_() { int l = (int)__builtin_amdgcn_mbcnt_hi(~0u, __builtin_amdgcn_mbcnt_lo(~0u, 0u)); asm volatile("" : "+v"(l)); return l; }
__device__ __forceinline__ float shx(float x, int o) { return __int_as_float(__builtin_amdgcn_ds_bpermute((lane_id_() ^ o) << 2, __float_as_int(x))); }
__device__ __forceinline__ unsigned shdown_u(unsigned x, int o) { return (unsigned)__builtin_amdgcn_ds_bpermute(((lane_id_() + o) & 63) << 2, (int)x); }
__device__ __forceinline__ int shidx_i(int x, int src) { return __builtin_amdgcn_ds_bpermute(src << 2, x); }
template <class OP> __device__ __forceinline__ float xrows(float x, OP op) {
    u32x2 r = __builtin_amdgcn_permlane16_swap(__float_as_uint(x), __float_as_uint(x), false, false); x = op(__uint_as_float(r[0]), __uint_as_float(r[1]));
    r = __builtin_amdgcn_permlane32_swap(__float_as_uint(x), __float_as_uint(x), false, false); return op(__uint_as_float(r[0]), __uint_as_float(r[1])); }
struct OpAdd { __device__ __forceinline__ float operator()(float a, float b) const { return a + b; } };
struct OpMin { __device__ __forceinline__ float operator()(float a, float b) const { return fminf(a, b); } };
struct OpMax { __device__ __forceinline__ float operator()(float a, float b) const { return fmaxf(a, b); } };
__device__ __forceinline__ float wave_sum(float x) { x = sum16(x); return xrows(x, OpAdd()); }
__device__ __forceinline__ float wave_min(float x) { x = fminf(x, dppf<0xB1>(x)); x = fminf(x, dppf<0x4E>(x)); x = fminf(x, dppf<0x141>(x)); x = fminf(x, dppf<0x140>(x)); return xrows(x, OpMin()); }
__device__ __forceinline__ float wave_max(float x) { x = fmaxf(x, dppf<0xB1>(x)); x = fmaxf(x, dppf<0x4E>(x)); x = fmaxf(x, dppf<0x141>(x)); x = fmaxf(x, dppf<0x140>(x)); return xrows(x, OpMax()); }
template <int CTRL, int RM, bool BC> __device__ __forceinline__ float dpp_addf(float x) { return x + __int_as_float(__builtin_amdgcn_update_dpp(0, __float_as_int(x), CTRL, RM, 0xF, BC)); }
__device__ __forceinline__ float wave_prefix_f(float x) { x = dpp_addf<0x111, 0xF, true>(x); x = dpp_addf<0x112, 0xF, true>(x); x = dpp_addf<0x114, 0xF, true>(x); x = dpp_addf<0x118, 0xF, true>(x);
    x = dpp_addf<0x142, 0xA, false>(x); return dpp_addf<0x143, 0xC, false>(x); }
__device__ __forceinline__ unsigned wave_prefix_u(unsigned x) { int v = (int)x;
    v += __builtin_amdgcn_update_dpp(0, v, 0x111, 0xF, 0xF, true); v += __builtin_amdgcn_update_dpp(0, v, 0x112, 0xF, 0xF, true);
    v += __builtin_amdgcn_update_dpp(0, v, 0x114, 0xF, 0xF, true); v += __builtin_amdgcn_update_dpp(0, v, 0x118, 0xF, 0xF, true);
    v += __builtin_amdgcn_update_dpp(0, v, 0x142, 0xA, 0xF, false); v += __builtin_amdgcn_update_dpp(0, v, 0x143, 0xC, 0xF, false); return (unsigned)v; }
__device__ __forceinline__ void unpack8(const u32x4 v, float (&f)[8]) {
    f[0] = __uint_as_float(v.x << 16); f[1] = __uint_as_float(v.x & 0xffff0000u); f[2] = __uint_as_float(v.y << 16); f[3] = __uint_as_float(v.y & 0xffff0000u);
    f[4] = __uint_as_float(v.z << 16); f[5] = __uint_as_float(v.z & 0xffff0000u); f[6] = __uint_as_float(v.w << 16); f[7] = __uint_as_float(v.w & 0xffff0000u);
}

__device__ __forceinline__ void st16_wt(void* p, u32x4 v) { asm volatile("global_store_dwordx4 %0, %1, off sc1\n\ts_nop 1" :: "v"(p), "v"(v) : "memory"); }
#define XB_TMO      128
#define XB_XCNT(j)  (256  + 64 * (j))
#define XB_XSUB(j)  (1280 + 64 * (j))
#define XB_XGEN(j)  (2304 + 64 * (j))
#define XB_TOP      3328
#define XB_TOPGEN   3392
#define XCD_BAR_WORDS 3456
#define XB_SPIN_CAP (1u << 22)
__device__ __forceinline__ unsigned xb_ld(unsigned* p)              { return __hip_atomic_load(p, __ATOMIC_RELAXED, __HIP_MEMORY_SCOPE_AGENT); }
__device__ __forceinline__ unsigned xb_add(unsigned* p, unsigned v) { return __hip_atomic_fetch_add(p, v, __ATOMIC_RELAXED, __HIP_MEMORY_SCOPE_AGENT); }
__device__ __forceinline__ unsigned xb_xcc_id() { return (unsigned)__builtin_amdgcn_s_getreg((3 << 11) | 20) & 0xFu; }
#define XB_SPIN(cond, bar) do { unsigned _sp = 0; while (cond) { __builtin_amdgcn_s_sleep(1); \
    if ((++_sp & 255u) == 0u) { if (xb_ld(&(bar)[XB_TMO])) break; if (_sp > XB_SPIN_CAP) { atomicAdd(&(bar)[XB_TMO], 1u); break; } } } } while (0)
struct XcdBarrier { unsigned* bar; unsigned x; volatile LAS unsigned* st; };
__device__ __forceinline__ XcdBarrier xcd_barrier_post(unsigned* bar, volatile LAS unsigned* st) {
    XcdBarrier b; b.bar = bar; b.x = xb_xcc_id(); b.st = st;
    if (threadIdx.x == 0) (void)xb_add(&bar[XB_XCNT(b.x)], 1u);
    return b;
}
__device__ __forceinline__ void xcd_barrier_complete(unsigned* bar, unsigned x, unsigned& nloc, unsigned& nx) {
    const unsigned G = gridDim.x * gridDim.y * gridDim.z;
    unsigned sum, cnt, mine, sp = 0u;
    for (;;) {
        sum = 0u; cnt = 0u; mine = 0u;
#pragma unroll
        for (unsigned j = 0; j < 16; ++j) { const unsigned c = xb_ld(&bar[XB_XCNT(j)]); sum += c; cnt += (c > 0u) ? 1u : 0u; mine = (j == x) ? c : mine; }
        if (sum == G) break;
        __builtin_amdgcn_s_sleep(1);
        if ((++sp & 255u) == 0u) { if (xb_ld(&bar[XB_TMO])) break; if (sp > XB_SPIN_CAP) { atomicAdd(&bar[XB_TMO], 1u); break; } }
    }
    nloc = mine > 0u ? mine : 1u; nx = cnt > 0u ? cnt : 1u;
}
__device__ __forceinline__ void xcd_barrier(const XcdBarrier& b_) {
    XcdBarrier b = b_; { const unsigned long long v = (unsigned long long)b.bar; unsigned lo = __builtin_amdgcn_readfirstlane((unsigned)v), hi = __builtin_amdgcn_readfirstlane((unsigned)(v >> 32)); asm volatile("" : "+s"(lo), "+s"(hi)); b.bar = (unsigned*)(((unsigned long long)hi << 32) | lo); unsigned xx = __builtin_amdgcn_readfirstlane(b.x); asm volatile("" : "+s"(xx)); b.x = xx; }
    asm volatile("s_waitcnt vmcnt(0)" ::: "memory");
    __syncthreads();
    if (threadIdx.x == 0) {
        unsigned* bar = b.bar;
        __builtin_amdgcn_s_waitcnt(0);
        unsigned nloc = b.st[0], nx = b.st[1];
        if (nloc == 0u) { xcd_barrier_complete(bar, b.x, nloc, nx); b.st[0] = nloc; b.st[1] = nx; }
        const unsigned old = xb_add(&bar[XB_XSUB(b.x)], 1u);
        const unsigned gen = old / nloc;
        if (old + 1u == (gen + 1u) * nloc) {
            __builtin_amdgcn_fence(__ATOMIC_RELEASE, "agent");
            asm volatile("s_waitcnt vmcnt(0)" ::: "memory");
            const unsigned og = xb_add(&bar[XB_TOP], 1u);
            const unsigned tg = og / nx;
            if (og + 1u == (tg + 1u) * nx) xb_add(&bar[XB_TOPGEN], 1u);
            else XB_SPIN(xb_ld(&bar[XB_TOPGEN]) == tg, bar);
            __builtin_amdgcn_fence(__ATOMIC_ACQUIRE, "agent");
            xb_add(&bar[XB_XGEN(b.x)], 1u);
            asm volatile("s_waitcnt vmcnt(0)" ::: "memory");
        } else {
            XB_SPIN(xb_ld(&bar[XB_XGEN(b.x)]) == gen, bar);
            __builtin_amdgcn_fence(__ATOMIC_ACQUIRE, "agent");
            asm volatile("s_waitcnt vmcnt(0)" ::: "memory");
        }
    }
    __syncthreads();
}

namespace pg8 {
constexpr int BM = 256, BK = 64, HALF = 128, HTB = HALF * BK * 2, STAGE_BYTES = 8 * HTB, NXCD = 8, WGM = 8;
__host__ __device__ __forceinline__ int lds_byte(int r, int c) { const int st = (r >> 4) * 2 + (c >> 5), rr = r & 15, cc = c & 31, ob = rr * 64 + cc * 2; return st * 1024 + (ob ^ (((ob >> 9) & 1) << 5)); }
__host__ __device__ __forceinline__ void stage_rc(int b, int& R, int& C) { const int st = b / 1024, sb = b % 1024, swz = sb ^ (((sb >> 9) & 1) << 5); R = (st >> 1) * 16 + swz / 64; C = (st & 1) * 32 + (swz % 64) / 2; }
__host__ __device__ __forceinline__ int perm32(int rho) { const int n = rho >> 4, i = rho & 15; return 8 * (i >> 2) + 4 * n + (i & 3); }
struct Unit { int pm, pn; const char* a; const char* b; };

struct StaticOrder {
    int nM, nN, nwg, G, c, K; const char* A; const char* B;
    __device__ void init(const bf16_t* A_, const bf16_t* B_, int M, int N, int K_, int G_, int c_) { A = (const char*)A_; B = (const char*)B_; K = K_; nM = M / BM; nN = N / BM; nwg = nM * nN; G = G_; c = c_; }
    __device__ bool next(int i, Unit& u) const {
        const long L = (long)i * G + c; if (L >= nwg) return false;
        int wgid = (int)L; { const int q = nwg / NXCD, r = nwg % NXCD, xcd = wgid % NXCD, off = wgid / NXCD; wgid = (xcd < r ? xcd * (q + 1) : r * (q + 1) + (xcd - r) * q) + off; }
        const int nig = WGM * nN, gid = wgid / nig, fm = gid * WGM, gsz = (nM - fm) < WGM ? (nM - fm) : WGM;
        u.pm = fm + ((wgid % nig) % gsz); u.pn = (wgid % nig) / gsz;
        u.a = A + (size_t)u.pm * 256 * K * 2; u.b = B + (size_t)u.pn * 256 * K * 2; return true;
    }
};

template <class Epi, class Sched, bool GATHER = false>
__device__ __forceinline__ void gemm_phase(LAS unsigned char* lds, const int K_, const Sched& S, const Epi& E, const char* Aall = nullptr, const int* arow = nullptr) {
    int K = K_; asm volatile("" : "+s"(K));
    int tid_ = threadIdx.x; asm volatile("" : "+v"(tid_));
    const int tid = tid_, wid = __builtin_amdgcn_readfirstlane(tid >> 6), lane = tid & 63, wr = wid >> 2, wc = wid & 3, fr = lane & 15, fq = lane >> 4;
    const int nt = K / BK;
    unsigned voffA[2], voffB[2]; int Rst[2], Cst[2];
#pragma unroll
    for (int i = 0; i < 2; ++i) { int R, C; stage_rc(tid * 16 + i * 8192, R, C); const int Rb = Epi::PERM ? ((R & ~31) + perm32(R & 31)) : R; Rst[i] = R; Cst[i] = C;
        voffA[i] = (unsigned)(R * K + C) * 2u; voffB[i] = (unsigned)(Rb * K + C) * 2u; }
    unsigned gv[2][2], gn[2][2];
#define PG8_GOFF(dst, unit) do { _Pragma("unroll") for (int h_ = 0; h_ < 2; ++h_) _Pragma("unroll") for (int i_ = 0; i_ < 2; ++i_) { const int rr_ = arow[(unit).pm * BM + h_ * HALF + Rst[i_]]; \
        dst[h_][i_] = ((unsigned)(rr_ < 0 ? 0 : rr_ >> 1) * (unsigned)K + (unsigned)Cst[i_]) * 2u; } } while (0)
    const size_t kstep = (size_t)(BK * 2);
    const size_t hstep = (size_t)HALF * K * 2;
    const unsigned ldsw = (unsigned)wid * 1024u;
    const int aoff = lds_byte(wr * 64 + fr, fq * 8), boff = lds_byte(wc * 32 + fr, fq * 8);
#define PG8_SA(b, h) (((b) * 2 + (h)) * HTB)
#define PG8_SB(b, h) ((4 + (b) * 2 + (h)) * HTB)
#define PG8_STAGE(bufoff, gbase, voff) do { _Pragma("unroll") for (int _i = 0; _i < 2; ++_i) \
        __builtin_amdgcn_global_load_lds((const unsigned*)((const char*)(gbase) + (voff)[_i]), (LAS unsigned*)(lds + (bufoff) + ldsw + _i * 8192), 16, 0, 0); } while (0)
#define PG8_LDA(dst, b, h) do { _Pragma("unroll") for (int m = 0; m < 4; ++m) _Pragma("unroll") for (int k = 0; k < 2; ++k) dst[m][k] = *(const LAS bf16x8*)(lds + PG8_SA(b, h) + aoff + m * 2048 + k * 1024); } while (0)
#define PG8_LDB(dst, b, h) do { _Pragma("unroll") for (int n = 0; n < 2; ++n) _Pragma("unroll") for (int k = 0; k < 2; ++k) dst[n][k] = *(const LAS bf16x8*)(lds + PG8_SB(b, h) + boff + n * 2048 + k * 1024); } while (0)
#define PG8_MMA(ai, bj, At, Bt) do { __builtin_amdgcn_s_setprio(1); _Pragma("unroll") for (int m = 0; m < 4; ++m) _Pragma("unroll") for (int n = 0; n < 2; ++n) _Pragma("unroll") for (int k = 0; k < 2; ++k) \
        acc[ai][bj][m][n] = __builtin_amdgcn_mfma_f32_16x16x32_bf16(Bt[n][k], At[m][k], acc[ai][bj][m][n], 0, 0, 0); __builtin_amdgcn_s_setprio(0); } while (0)
#define PG8_WAIT_V(n) asm volatile("s_waitcnt vmcnt(" #n ")" ::: "memory")
#define PG8_WAIT_L(n) asm volatile("s_waitcnt lgkmcnt(" #n ")" ::: "memory")
#define PG8_BAR __builtin_amdgcn_s_barrier()
#define PG8_SCHED __builtin_amdgcn_sched_barrier(0)
    Unit cur, nxt; int ui = 0;
    if (!S.next(0, cur)) return;
    f32x4 acc[2][2][4][2];
#pragma unroll
    for (int a = 0; a < 2; ++a)
#pragma unroll
        for (int b = 0; b < 2; ++b)
#pragma unroll
            for (int m = 0; m < 4; ++m)
#pragma unroll
                for (int n = 0; n < 2; ++n) acc[a][b][m][n] = (f32x4){0.f, 0.f, 0.f, 0.f};
    bf16x8 At[4][2], B0[2][2], B1[2][2];
    const char* cA = GATHER ? Aall : cur.a; const char* cB = cur.b;
    if (GATHER) PG8_GOFF(gv, cur);
#define PG8_STAGE_A(bufoff, gbase, h, vo) do { if (GATHER) PG8_STAGE(bufoff, gbase, (vo)[h]); else PG8_STAGE(bufoff, (gbase) + ((h) ? hstep : 0), voffA); } while (0)
    PG8_STAGE(PG8_SB(0, 0), cB, voffB); PG8_STAGE_A(PG8_SA(0, 0), cA, 0, gv); PG8_STAGE(PG8_SB(0, 1), cB + hstep, voffB); PG8_STAGE_A(PG8_SA(0, 1), cA, 1, gv);
    if (wr == 1) PG8_BAR;
    PG8_WAIT_V(4); PG8_BAR;
    PG8_STAGE(PG8_SB(1, 0), cB + kstep, voffB); PG8_STAGE_A(PG8_SA(1, 0), cA + kstep, 0, gv); PG8_STAGE(PG8_SB(1, 1), cB + hstep + kstep, voffB);
    PG8_WAIT_V(6); PG8_BAR;
    for (;;) {
        const bool has_next = S.next(ui + 1, nxt);
        const char* nA = GATHER ? cA : (has_next ? nxt.a : cA); const char* nB = has_next ? nxt.b : cB;
        if (GATHER) { if (has_next) PG8_GOFF(gn, nxt); else {
#pragma unroll
            for (int h_ = 0; h_ < 2; ++h_)
#pragma unroll
                for (int i_ = 0; i_ < 2; ++i_) gn[h_][i_] = gv[h_][i_]; } }
        for (int t = 0; t < nt; t += 2) {
            const bool last = (t == nt - 2);
            const char* a1 = cA + (size_t)(t + 1) * kstep;
            const char* a2 = last ? nA : cA + (size_t)(t + 2) * kstep; const char* b2 = last ? nB : cB + (size_t)(t + 2) * kstep;
            const char* a3 = a2 + kstep; const char* b3 = b2 + kstep;
            unsigned vo2[2][2];
#pragma unroll
            for (int h_ = 0; h_ < 2; ++h_)
#pragma unroll
                for (int i_ = 0; i_ < 2; ++i_) vo2[h_][i_] = GATHER ? (last ? gn[h_][i_] : gv[h_][i_]) : 0u;
            PG8_LDB(B0, 0, 0); PG8_SCHED; PG8_LDA(At, 0, 0); PG8_STAGE_A(PG8_SA(1, 1), a1, 1, gv);
            PG8_WAIT_L(8); PG8_BAR; PG8_WAIT_L(0); PG8_MMA(0, 0, At, B0); PG8_BAR; PG8_SCHED;
            PG8_LDB(B1, 0, 1); PG8_STAGE(PG8_SB(0, 0), b2, voffB);
            PG8_BAR; PG8_WAIT_L(0); PG8_MMA(0, 1, At, B1); PG8_BAR;
            PG8_LDA(At, 0, 1); PG8_STAGE_A(PG8_SA(0, 0), a2, 0, vo2);
            PG8_BAR; PG8_WAIT_L(0); PG8_MMA(1, 0, At, B0); PG8_BAR; PG8_SCHED;
            PG8_STAGE(PG8_SB(0, 1), b2 + hstep, voffB);
            PG8_WAIT_V(6); PG8_BAR; PG8_MMA(1, 1, At, B1); PG8_BAR;
            PG8_LDB(B0, 1, 0); PG8_SCHED; PG8_LDA(At, 1, 0); PG8_STAGE_A(PG8_SA(0, 1), a2, 1, vo2);
            PG8_WAIT_L(8); PG8_BAR; PG8_WAIT_L(0); PG8_MMA(0, 0, At, B0); PG8_BAR; PG8_SCHED;
            PG8_LDB(B1, 1, 1); PG8_STAGE(PG8_SB(1, 0), b3, voffB);
            PG8_BAR; PG8_WAIT_L(0); PG8_MMA(0, 1, At, B1); PG8_BAR;
            PG8_LDA(At, 1, 1); PG8_STAGE_A(PG8_SA(1, 0), a3, 0, vo2);
            PG8_BAR; PG8_WAIT_L(0); PG8_MMA(1, 0, At, B0); PG8_BAR; PG8_SCHED;
            PG8_STAGE(PG8_SB(1, 1), b3 + hstep, voffB);
            PG8_WAIT_V(6); PG8_BAR; PG8_MMA(1, 1, At, B1); PG8_BAR;
        }
        E(acc, cur, wr, wc, fr, fq);
        if (!has_next) break;
#pragma unroll
        for (int a = 0; a < 2; ++a)
#pragma unroll
            for (int b = 0; b < 2; ++b)
#pragma unroll
                for (int m = 0; m < 4; ++m)
#pragma unroll
                    for (int n = 0; n < 2; ++n) acc[a][b][m][n] = (f32x4){0.f, 0.f, 0.f, 0.f};
        cur = nxt; cA = nA; cB = nB; ++ui;
        if (GATHER) {
#pragma unroll
            for (int h_ = 0; h_ < 2; ++h_)
#pragma unroll
                for (int i_ = 0; i_ < 2; ++i_) gv[h_][i_] = gn[h_][i_]; }
    }
    PG8_WAIT_V(0);
    if (wr == 0) PG8_BAR;
    PG8_BAR;
#undef PG8_SA
#undef PG8_SB
#undef PG8_STAGE
#undef PG8_STAGE_A
#undef PG8_GOFF
#undef PG8_LDA
#undef PG8_LDB
#undef PG8_MMA
#undef PG8_WAIT_V
#undef PG8_WAIT_L
#undef PG8_BAR
#undef PG8_SCHED
}

struct EpiBf16 {
    static constexpr bool PERM = true;
    bf16_t* O; int ldc;
    __device__ __forceinline__ void operator()(const f32x4 (&acc)[2][2][4][2], const Unit& u, int wr, int wc, int fr, int fq) const {
        const int row0 = u.pm * BM + wr * 64 + fr, col0 = u.pn * BM + wc * 32 + 8 * fq;
#pragma unroll
        for (int ai = 0; ai < 2; ++ai)
#pragma unroll
            for (int m = 0; m < 4; ++m) { bf16_t* rowp = O + (size_t)(row0 + ai * HALF + m * 16) * ldc + col0;
#pragma unroll
                for (int bj = 0; bj < 2; ++bj) { const f32x4 v0 = acc[ai][bj][m][0], v1 = acc[ai][bj][m][1];
                    u32x4 w; w.x = cvt_pk_bf16(v0[0], v0[1]); w.y = cvt_pk_bf16(v0[2], v0[3]); w.z = cvt_pk_bf16(v1[0], v1[1]); w.w = cvt_pk_bf16(v1[2], v1[3]);
                    st16_wt(rowp + bj * HALF, w); } }
    }
};
struct EpiResid {
    static constexpr bool PERM = false;
    const float* Cin; float* C; int ldc;
    __device__ __forceinline__ void operator()(const f32x4 (&acc)[2][2][4][2], const Unit& u, int wr, int wc, int fr_, int fq_) const {
        int fr = fr_, fq = fq_; asm volatile("" : "+v"(fr), "+v"(fq));
        const int row0 = u.pm * BM + wr * 64 + fr, col0 = u.pn * BM + wc * 32 + 4 * fq;
#pragma unroll
        for (int ai = 0; ai < 2; ++ai)
#pragma unroll
            for (int mp = 0; mp < 2; ++mp) { f32x4 cv[2][2][2];
#pragma unroll
                for (int mm = 0; mm < 2; ++mm) { const float* rowp = Cin + (size_t)(row0 + ai * HALF + (2 * mp + mm) * 16) * ldc + col0;
#pragma unroll
                    for (int bj = 0; bj < 2; ++bj)
#pragma unroll
                        for (int n = 0; n < 2; ++n) cv[mm][bj][n] = *(const f32x4*)(rowp + bj * HALF + n * 16); }
#pragma unroll
                for (int mm = 0; mm < 2; ++mm) { float* rowp = C + (size_t)(row0 + ai * HALF + (2 * mp + mm) * 16) * ldc + col0;
#pragma unroll
                    for (int bj = 0; bj < 2; ++bj)
#pragma unroll
                        for (int n = 0; n < 2; ++n) { const f32x4 o_ = cv[mm][bj][n] + acc[ai][bj][2 * mp + mm][n]; st16_wt(rowp + bj * HALF + n * 16, __builtin_bit_cast(u32x4, o_)); } }
                asm volatile("" ::: "memory"); }
    }
};
template <int ACT  > struct EpiGated {
    static constexpr bool PERM = true;
    bf16_t* O; int ldo; int coloff; const float* ba; const float* bb;
    __device__ __forceinline__ void operator()(const f32x4 (&acc)[2][2][4][2], const Unit& u, int wr, int wc, int fr, int fq) const {
        const int row0 = u.pm * BM + wr * 64 + fr, cl = u.pn * HALF + wc * 32 + 8 * fq;
        float va[8], vb[8];
#pragma unroll
        for (int j = 0; j < 8; ++j) { va[j] = (ACT == 0) ? ba[cl + j] : 0.f; vb[j] = (ACT == 0) ? bb[cl + j] : 0.f; }
#pragma unroll
        for (int ai = 0; ai < 2; ++ai)
#pragma unroll
            for (int m = 0; m < 4; ++m) { bf16_t* rowp = O + (size_t)(row0 + ai * HALF + m * 16) * ldo + coloff + cl;
                float o[8];
#pragma unroll
                for (int n = 0; n < 2; ++n)
#pragma unroll
                    for (int j = 0; j < 4; ++j) { const float a = acc[ai][0][m][n][j] + va[4 * n + j], b = acc[ai][1][m][n][j] + vb[4 * n + j];
                        o[4 * n + j] = (ACT == 0) ? a * sigmoidf_(b) : siluf_(a) * b; }
                u32x4 w; w.x = cvt_pk_bf16(o[0], o[1]); w.y = cvt_pk_bf16(o[2], o[3]); w.z = cvt_pk_bf16(o[4], o[5]); w.w = cvt_pk_bf16(o[6], o[7]);
                st16_wt(rowp, w); asm volatile("" ::: "memory"); }
    }
};
struct EpiMoeOut {
    static constexpr bool PERM = true;
    bf16_t* O; const int* row_tok; const float* row_w; LAS unsigned char* lds;
    __device__ __forceinline__ void operator()(const f32x4 (&acc)[2][2][4][2], const Unit& u, int wr, int wc, int fr_, int fq_) const {
        int fr = fr_, fq = fq_; asm volatile("" : "+v"(fr), "+v"(fq));
        const int col0 = u.pn * BM + wc * 32 + 8 * fq, lane = fq * 16 + fr;
        LAS u32x2* rinfo = (LAS u32x2*)(lds + STAGE_BYTES) + (wr * 4 + wc) * 128;
        { const int ra = u.pm * BM + wr * 64 + lane, rb = ra + HALF;
          const u32x2 ia = (u32x2){(unsigned)row_tok[ra], __float_as_uint(row_w[ra])}, ib = (u32x2){(unsigned)row_tok[rb], __float_as_uint(row_w[rb])};
          rinfo[lane] = ia; rinfo[64 + lane] = ib; }
#pragma unroll
        for (int ai = 0; ai < 2; ++ai)
#pragma unroll
            for (int m = 0; m < 4; ++m) { const u32x2 inf = rinfo[ai * 64 + m * 16 + fr]; const int ts = (int)inf.x; const float w = __uint_as_float(inf.y);
                if (ts >= 0) { bf16_t* rowp = O + ((size_t)(ts & 1) * NTOK + (size_t)(ts >> 1)) * DM + col0;
#pragma unroll
                    for (int bj = 0; bj < 2; ++bj) { const f32x4 v0 = acc[ai][bj][m][0] * w, v1 = acc[ai][bj][m][1] * w;
                        u32x4 q; q.x = cvt_pk_bf16(v0[0], v0[1]); q.y = cvt_pk_bf16(v0[2], v0[3]); q.z = cvt_pk_bf16(v1[0], v1[1]); q.w = cvt_pk_bf16(v1[2], v1[3]);
                        st16_wt(rowp + bj * HALF, q); } } }
    }
};
struct MoeOrder {
    int K; const char* A; const char* B; size_t bstride; const LAS int* list;
    static __device__ __forceinline__ void build(LAS int* list, const int* tiles, int nN, int G, int c) {
        const int nrt = tiles[0], nwg = nrt * nN; int n = 0;
        for (int i = 0; ; ++i) { const long L = (long)i * G + c; if (L >= (long)nwg || n >= 20) break;
            int wgid = (int)L; { const int q = nwg / NXCD, r = nwg % NXCD, xcd = wgid % NXCD, off = wgid / NXCD; wgid = (xcd < r ? xcd * (q + 1) : r * (q + 1) + (xcd - r) * q) + off; }
            const int pm = wgid / nN; list[1 + 3 * n] = pm; list[2 + 3 * n] = wgid % nN; list[3 + 3 * n] = tiles[64 + pm]; ++n; }
        list[0] = n;
    }
    __device__ bool next(int i, Unit& u) const {
        const int n = __builtin_amdgcn_readfirstlane(list[0]); if (i >= n) return false;
        u.pm = __builtin_amdgcn_readfirstlane(list[1 + 3 * i]); u.pn = __builtin_amdgcn_readfirstlane(list[2 + 3 * i]); const int e = __builtin_amdgcn_readfirstlane(list[3 + 3 * i]);
        u.a = A + (size_t)u.pm * 256 * K * 2; u.b = B + (size_t)e * bstride + (size_t)u.pn * 256 * K * 2; return true;
    }
};
}

struct Params { const float* in[44]; float* out; unsigned char* ws; int ph_lo, ph_hi; };
enum { I_X = 0, I_NORM1, I_WIN, I_MCONVW, I_MCONVB, I_MDTB, I_MALOG, I_MD, I_MNORM, I_RMU, I_RW0, I_RW2, I_RA0, I_RA2, I_RG2, I_RKK, I_RKA, I_RRK, I_RLNW, I_RLNB,
       I_CKVN, I_CWUK, I_CWUV, I_RELB, I_SARE, I_SAIM, I_SBRE, I_SBIM, I_SCRE, I_SCIM, I_SD, I_SLOGDT, I_SGLUW, I_SGLUB, I_WOUT, I_NORM2, I_WRG, I_BRG, I_WRE, I_BRE,
       I_WGATE, I_WUP, I_WDOWN, I_FNORM };

typedef const float* const __attribute__((address_space(4)))* in_tab_t;
struct Frame {
    LAS unsigned char* lds; int tid, lane, wave, bid, G;
    in_tab_t in; float* out; unsigned char* ws; unsigned* ctl;
    volatile LAS int* misc;
};

__device__ __forceinline__ int q_pop(Frame& F, int qi) {
    __syncthreads();
    if (F.tid == 0) F.misc[0] = (int)__hip_atomic_fetch_add(F.ctl + CW_Q + 64 * qi, 1u, __ATOMIC_RELAXED, __HIP_MEMORY_SCOPE_AGENT);
    __syncthreads();
    return F.misc[0];
}

__device__ __forceinline__ const void* opaque_ptr(const void* p) { const unsigned long long v = (unsigned long long)p; unsigned lo = __builtin_amdgcn_readfirstlane((unsigned)v), hi = __builtin_amdgcn_readfirstlane((unsigned)(v >> 32));
    asm volatile("" : "+s"(lo), "+s"(hi)); return (const void*)(((unsigned long long)hi << 32) | lo); }
__device__ __forceinline__ Frame relocal(const Frame& G) { Frame F = G; asm volatile("" : "+v"(F.tid)); F.ws = (unsigned char*)opaque_ptr(F.ws); F.ctl = (unsigned*)(F.ws + WS_CTL); F.in = (in_tab_t)(unsigned long long)opaque_ptr((const void*)(unsigned long long)F.in); F.lane = F.tid & 63; F.wave = __builtin_amdgcn_readfirstlane(F.tid >> 6); return F; }
template <int K> __device__ __forceinline__ f32x4 mma_nt(const LAS bf16_t* A, int lda, const LAS bf16_t* Bt, int ldb, f32x4 acc, int lane) {
    const int r = lane & 15, g = lane >> 4;
#pragma unroll
    for (int k0 = 0; k0 < K; k0 += 32) {
        const bf16x8 a = *(const LAS bf16x8*)(A + r * lda + k0 + 8 * g);
        const bf16x8 b = *(const LAS bf16x8*)(Bt + r * ldb + k0 + 8 * g);
        acc = __builtin_amdgcn_mfma_f32_16x16x32_bf16(a, b, acc, 0, 0, 0);
    }
    return acc;
}

template <class SrcMap> __device__ __forceinline__ void tr_tile(Frame& F, int ldsrc, bf16_t* dst, int K, int k0, int n0, SrcMap sm) {
    LAS float* tile = (LAS float*)F.lds;
    __syncthreads();
    { const int n4 = (F.tid & 63) * 4, kk = F.tid >> 6; const float* sp = sm(n0 + n4);
      f32x4 v[8];
#pragma unroll
      for (int ps = 0; ps < 8; ++ps) { v[ps] = (f32x4){0.f, 0.f, 0.f, 0.f}; if (sp) v[ps] = __builtin_nontemporal_load((const f32x4*)(sp + (size_t)(k0 + kk + 8 * ps) * ldsrc)); }
#pragma unroll
      for (int ps = 0; ps < 8; ++ps) { LAS float* t = tile + (kk + 8 * ps) * 257 + n4; t[0] = v[ps][0]; t[1] = v[ps][1]; t[2] = v[ps][2]; t[3] = v[ps][3]; } }
    __syncthreads();
    { const int kc = F.tid & 7;
#pragma unroll
      for (int j = 0; j < 4; ++j) { const int n = (F.tid >> 3) + 64 * j; float f[8];
#pragma unroll
          for (int i = 0; i < 8; ++i) f[i] = tile[(8 * kc + i) * 257 + n];
          u32x4 w; w.x = pk2(f[0], f[1]); w.y = pk2(f[2], f[3]); w.z = pk2(f[4], f[5]); w.w = pk2(f[6], f[7]);
          *(u32x4*)(dst + (size_t)(n0 + n) * K + k0 + 8 * kc) = w; } }
}

struct SmIn { const float* base; __device__ __forceinline__ const float* operator()(int n) const {
    int c; if (n < 772) c = n; else if (n < UR) return nullptr; else if (n < UR + 896) c = 772 + (n - UR); else if (n < UC) return nullptr;
    else if (n < UC + 680) c = 1668 + (n - UC); else if (n < US) return nullptr; else if (n < US + 256) c = 2348 + (n - US); else return nullptr; return base + c; } };
struct SmId { const float* base; __device__ __forceinline__ const float* operator()(int n) const { return base + n; } };
struct SmGlu { const float* base; __device__ __forceinline__ const float* operator()(int n) const { const int pn = n >> 8, rr = n & 255; return base + (rr < 128 ? 128 * pn + rr : 256 + 128 * pn + (rr - 128)); } };
struct SmGU { const float* gate; const float* up; __device__ __forceinline__ const float* operator()(int n) const {
    const unsigned long long d = (unsigned long long)up - (unsigned long long)gate; const unsigned long long a = (unsigned long long)gate + (((n & 255) < 128) ? 0ull : d); return (const float*)a + 128 * (n >> 8) + (n & 127); } };
__device__ __forceinline__ void phase_prologue(const Frame& F_) { Frame F = relocal(F_);
    for (int t = F.bid; t < 496; t += F.G) {
        if (t < 352) { const int l = t / 176, r = t % 176, kt = r / 11, nt = r % 11;
            tr_tile(F, NIN, (bf16_t*)(F.ws + WS_WIN) + (size_t)l * NINP * DM, DM, kt * 64, nt * 256, SmIn{F.in[I_WIN] + (size_t)l * DM * NIN}); }
        else if (t < 480) { const int q = t - 352, l = q / 64, r = q % 64, kt = r / 4, nt = r % 4;
            tr_tile(F, DM, (bf16_t*)(F.ws + WS_WOUT) + (size_t)l * DM * DM, DM, kt * 64, nt * 256, SmId{F.in[I_WOUT] + (size_t)l * DM * DM}); }
        else { const int q = t - 480, l = q / 8, r = q % 8, kt = r / 2, nt = r % 2;
            tr_tile(F, 512, (bf16_t*)(F.ws + WS_GLU) + (size_t)l * 512 * 256, 256, kt * 64, nt * 256, SmGlu{F.in[I_SGLUW] + (size_t)l * 256 * 512}); }
    }
    for (int i = F.bid * NTHR + F.tid; i < 2 * 48 * 1024; i += F.G * NTHR) { const int l = i / 49152, r = i % 49152, o = r >> 10, k = r & 1023;
        float v = 0.f; if (o < 32) v = F.in[I_WRE][((size_t)l * DM + k) * 32 + o]; else if (o < 36) v = F.in[I_WRG][((size_t)l * DM + k) * 4 + (o - 32)];
        v *= F.in[I_NORM2][l * DM + k];
        const bf16_t hi = f2bf(v); const bf16_t lo = f2bf(v - bf2f(hi));
        bf16_t* w = (bf16_t*)(F.ws + WS_WRT) + (size_t)l * 2 * 49152; w[r] = hi; w[49152 + r] = lo; }
    for (int i = F.bid * NTHR + F.tid; i < 2048 + 65536; i += F.G * NTHR) {
        if (i < 2048) {
            const int l = i >> 10, gn = i & 1023, g = gn >> 6;
            float* tab = (float*)(F.ws + WS_S5TAB + (size_t)l * S5TAB_L);
            const float lre = fminf(F.in[I_SARE][l * 1024 + gn], -1e-4f), lim = F.in[I_SAIM][l * 1024 + gn];
            const float dt = expf(F.in[I_SLOGDT][l * 16 + g]);
            const float mag = expf(dt * lre); float sn, cs; sincosf(dt * lim, &sn, &cs);
            const float are = mag * cs, aim = mag * sn;
            const float den = lre * lre + lim * lim;
            const float fre = ((are - 1.0f) * lre + aim * lim) / den, fim = (aim * lre - (are - 1.0f) * lim) / den;
            tab[gn * 2] = are; tab[gn * 2 + 1] = aim;
            float pr = are, pi = aim;
#pragma unroll
            for (int s = 0; s < 6; ++s) { const float nr = pr * pr - pi * pi, ni = 2.0f * pr * pi; pr = nr; pi = ni; }
            tab[2048 + gn * 2] = pr; tab[2048 + gn * 2 + 1] = pi;
            const float* bre = F.in[I_SBRE] + ((size_t)l * 1024 + gn) * 16; const float* bim = F.in[I_SBIM] + ((size_t)l * 1024 + gn) * 16;
            bf16_t* bbt = (bf16_t*)(F.ws + WS_S5TAB + (size_t)l * S5TAB_L + S5TAB_BBT); const int n = gn & 63, col = 4 * (n & 31) + 2 * (n >> 5);
            for (int p = 0; p < 16; ++p) { const float vr = fre * bre[p] - fim * bim[p], vi = fre * bim[p] + fim * bre[p];
                bbt[((size_t)g * 128 + col) * 16 + p] = f2bf(vr); bbt[((size_t)g * 128 + col + 1) * 16 + p] = f2bf(vi); }
        } else {
            const int j = i - 2048, l = j >> 15, r = j & 32767, gp = r >> 7, k = r & 127;
            bf16_t* cm = (bf16_t*)(F.ws + WS_S5TAB + (size_t)l * S5TAB_L + S5TAB_F);
            const int n = (k >> 2) + 32 * ((k >> 1) & 1);
            const float v = (k & 1) == 0 ? F.in[I_SCRE][((size_t)l * 256 + gp) * 64 + n] : -F.in[I_SCIM][((size_t)l * 256 + gp) * 64 + n];
            cm[r] = f2bf(v);
        }
    }
}

__device__ __forceinline__ void phase_norm(const Frame& F_, const float* xin, bool add_o, const float* w, int mode) { Frame F = relocal(F_);
    float* X = (float*)(F.ws + WS_X); bf16_t* H = (bf16_t*)(F.ws + WS_H); const bf16_t* O = (const bf16_t*)(F.ws + WS_U);
    for (int row0 = F.bid * 32 + F.wave * 4; row0 < NTOK; row0 += F.G * 32) {
        f32x4 v[4][4]; u32x2 oa[4][4], ob[4][4];
#pragma unroll
        for (int r = 0; r < 4; ++r)
#pragma unroll
            for (int j = 0; j < 4; ++j) { const int c = 4 * F.lane + 256 * j; const size_t o = (size_t)(row0 + r) * DM + c; v[r][j] = (mode == 2) ? __builtin_nontemporal_load((const f32x4*)(xin + o)) : *(const f32x4*)(xin + o);
                if (add_o) { oa[r][j] = __builtin_nontemporal_load((const u32x2*)(O + o)); ob[r][j] = __builtin_nontemporal_load((const u32x2*)(O + (size_t)NTOK * DM + o)); } }
#pragma unroll
        for (int r = 0; r < 4; ++r) { const int row = row0 + r; float ss = 0.f;
#pragma unroll
            for (int j = 0; j < 4; ++j) {
                if (add_o) { const u32x2 a = oa[r][j], b = ob[r][j];
                    v[r][j][0] += __uint_as_float(a.x << 16) + __uint_as_float(b.x << 16); v[r][j][1] += __uint_as_float(a.x & 0xffff0000u) + __uint_as_float(b.x & 0xffff0000u);
                    v[r][j][2] += __uint_as_float(a.y << 16) + __uint_as_float(b.y << 16); v[r][j][3] += __uint_as_float(a.y & 0xffff0000u) + __uint_as_float(b.y & 0xffff0000u); }
                ss += v[r][j][0] * v[r][j][0] + v[r][j][1] * v[r][j][1] + v[r][j][2] * v[r][j][2] + v[r][j][3] * v[r][j][3]; }
            ss = wave_sum(ss);
            const float rstd = rsqrtf(ss * (1.0f / DM) + 1e-6f);
#pragma unroll
            for (int j = 0; j < 4; ++j) { const int c = 4 * F.lane + 256 * j; const f32x4 wv = *(const f32x4*)(w + c);
                if (mode == 2) { __builtin_nontemporal_store(v[r][j] * rstd * wv, (f32x4*)(F.out + (size_t)row * DM + c)); }
                else { if (mode == 0) *(f32x4*)(X + (size_t)row * DM + c) = v[r][j];
                    u32x2 o; o.x = pk2(v[r][j][0] * rstd * wv[0], v[r][j][1] * rstd * wv[1]); o.y = pk2(v[r][j][2] * rstd * wv[2], v[r][j][3] * rstd * wv[3]);
                    *(u32x2*)(H + (size_t)row * DM + c) = o; } } }
    }
}

__device__ __forceinline__ void item_kv(const Frame& F_, int layer, int item) { Frame F = relocal(F_);
    const bf16_t* U = (const bf16_t*)(F.ws + WS_U);
    LAS bf16_t* Ab = (LAS bf16_t*)F.lds;
    LAS bf16_t* Bt = (LAS bf16_t*)(F.lds + 17408);
    const int t0 = item * 64;
    { const int tok = F.tid >> 3, part = F.tid & 7; const bf16_t* src = U + (size_t)(t0 + tok) * NINP + UC + 256 + 16 * part;
      float f[16]; { float a[8], b[8]; unpack8(*(const u32x4*)src, a); unpack8(*(const u32x4*)(src + 8), b);
#pragma unroll
        for (int j = 0; j < 8; ++j) { f[j] = a[j]; f[8 + j] = b[j]; } }
      float ss = 0.f;
#pragma unroll
      for (int j = 0; j < 16; ++j) ss += f[j] * f[j];
      ss = sum8(ss);
      const float rstd = rsqrtf(ss * (1.0f / 128.0f) + 1e-6f); const float* nw = F.in[I_CKVN] + layer * 128 + 16 * part;
#pragma unroll
      for (int j = 0; j < 16; j += 2) *(LAS unsigned*)(Ab + tok * 136 + 16 * part + j) = pk2(f[j] * rstd * nw[j], f[j + 1] * rstd * nw[j + 1]); }
    { const int n = F.tid >> 2, kq = F.tid & 3; const float* w = (n < 64 ? F.in[I_CWUK] : F.in[I_CWUV]) + (size_t)layer * 128 * 64 + (n & 63);
      float wv[32];
#pragma unroll
      for (int k = 0; k < 32; ++k) wv[k] = w[(size_t)(32 * kq + k) * 64];
#pragma unroll
      for (int k = 0; k < 32; k += 2) *(LAS unsigned*)(Bt + n * 136 + 32 * kq + k) = pk2(wv[k], wv[k + 1]); }
    if (F.tid < 256) { const int tok = F.tid >> 2, q = F.tid & 3;
        *(u32x4*)((bf16_t*)(F.ws + WS_KIDX) + (size_t)(t0 + tok) * 32 + 8 * q) = *(const u32x4*)(U + (size_t)(t0 + tok) * NINP + UC + 640 + 8 * q); }
    __syncthreads();
    const int mt = F.wave & 3, g = F.lane >> 4, r = F.lane & 15;
#pragma unroll
    for (int q = 0; q < 4; ++q) { const int nt = (F.wave >> 2) * 4 + q;
        f32x4 acc = (f32x4){0.f, 0.f, 0.f, 0.f};
        acc = mma_nt<128>(Bt + nt * 16 * 136, 136, Ab + mt * 16 * 136, 136, acc, F.lane);
        const int n0 = nt * 16 + 4 * g; bf16_t* dst = (bf16_t*)(F.ws + WS_K) + (size_t)(n0 >> 6) * ((WS_V - WS_K) / 2);
        *(u32x2*)(dst + (size_t)(t0 + mt * 16 + r) * 64 + (n0 & 63)) = (u32x2){pk2(acc[0], acc[1]), pk2(acc[2], acc[3])}; }
}

constexpr int MB_CG = 0, MB_BG = 18432, MB_XT = 36864, MB_BT = 73728, MB_M = 73728, MB_S0 = 110592, MB_DT = 147456, MB_AC = 148480, MB_RS = 149504;
static_assert(MB_RS + 256 <= MISC_OFF && MB_BT == MB_XT + 4 * 64 * 72 * 2, "mamba LDS");
template <int STAGE> __device__ __forceinline__ void item_mamba(const Frame& F_, int layer, int item) { Frame F = relocal(F_);
    const bf16_t* U = (const bf16_t*)(F.ws + WS_U);
    const int b = item >> 6, c = item & 63, l0 = c * 64; const size_t T0 = (size_t)b * SEQ + l0;
    LAS bf16_t* Cg = (LAS bf16_t*)(F.lds + MB_CG); LAS bf16_t* Bg = (LAS bf16_t*)(F.lds + MB_BG); LAS bf16_t* BT = (LAS bf16_t*)(F.lds + MB_BT);
    LAS bf16_t* XT = (LAS bf16_t*)(F.lds + MB_XT); LAS bf16_t* Mb = (LAS bf16_t*)(F.lds + MB_M); LAS bf16_t* S0 = (LAS bf16_t*)(F.lds + MB_S0);
    LAS float* dts = (LAS float*)(F.lds + MB_DT); LAS float* acs = (LAS float*)(F.lds + MB_AC); LAS float* rs = (LAS float*)(F.lds + MB_RS);
    const int tg = F.tid & 7, c0 = (F.tid >> 3) * 8;
    const bool conv_on = (STAGE == 2) || (F.wave < 6);
    u32x4 rows[11]; float wv[4][8], bv[8];
    if (conv_on) {
#pragma unroll
        for (int k = 0; k < 11; ++k) { const int l = l0 + tg * 8 - 3 + k;
            if (l >= 0) rows[k] = *(const u32x4*)(U + ((size_t)b * SEQ + l) * NINP + UM + 256 + c0); else rows[k] = (u32x4){0u, 0u, 0u, 0u}; }
#pragma unroll
        for (int j = 0; j < 8; ++j) { bv[j] = F.in[I_MCONVB][layer * 512 + c0 + j];
#pragma unroll
            for (int k = 0; k < 4; ++k) wv[k][j] = F.in[I_MCONVW][(layer * 4 + k) * 512 + c0 + j]; } }
    const float* MSTi = (const float*)(F.ws + WS_MST) + ((size_t)(b * 64 + c) * 4) * 4096;
    f32x4 s0a[4], s0b[4];
    if (STAGE == 2) {
#pragma unroll
        for (int h = 0; h < 4; ++h) { const float* src = MSTi + (size_t)h * 4096 + F.tid * 8; s0a[h] = *(const f32x4*)src; s0b[h] = *(const f32x4*)(src + 4); } }
    if (F.wave < 4) { const int l = F.lane, h = F.wave;
        const float raw = bf2f(U[(T0 + l) * NINP + UM + 768 + h]) + F.in[I_MDTB][layer * 4 + h];
        const float dt = softplusf_(raw); const float cum = wave_prefix_f(-__expf(F.in[I_MALOG][layer * 4 + h]) * dt);
        dts[l * 4 + h] = dt; acs[l * 4 + h] = cum; }
    if (STAGE == 2) { if (F.tid < 64) rs[F.tid] = 0.f;
#pragma unroll
        for (int h = 0; h < 4; ++h) { u32x4 w; w.x = pk2(s0a[h][0], s0a[h][1]); w.y = pk2(s0a[h][2], s0a[h][3]); w.z = pk2(s0b[h][0], s0b[h][1]); w.w = pk2(s0b[h][2], s0b[h][3]);
            *(LAS u32x4*)(S0 + (h * 64 + (F.tid >> 3)) * 72 + (F.tid & 7) * 8) = w; } }
    __syncthreads();
    if (conv_on) {
        float win[3][8]; unpack8(rows[0], win[0]); unpack8(rows[1], win[1]); unpack8(rows[2], win[2]);
        const bool isx = F.wave < 4, tr = isx || STAGE == 1;
        unsigned pkT[8][4]; float prev[8];
#pragma unroll
        for (int i = 0; i < 8; ++i) { const int l = tg * 8 + i; float cur[8]; unpack8(rows[3 + i], cur);
            float o[8];
#pragma unroll
            for (int j = 0; j < 8; ++j) { o[j] = siluf_(bv[j] + wv[0][j] * win[0][j] + wv[1][j] * win[1][j] + wv[2][j] * win[2][j] + wv[3][j] * cur[j]);
                win[0][j] = win[1][j]; win[1][j] = win[2][j]; win[2][j] = cur[j]; }
            if (isx) { const int h = F.wave; float sc = dts[l * 4 + h]; if (STAGE == 1) sc *= __expf(acs[63 * 4 + h] - acs[l * 4 + h]);
#pragma unroll
                for (int j = 0; j < 8; ++j) o[j] *= sc; }
            if (tr) {
#pragma unroll
                for (int j = 0; j < 8; ++j) { if (i & 1) pkT[j][i >> 1] = pk2(prev[j], o[j]); else prev[j] = o[j]; } }
            else { u32x4 w; w.x = pk2(o[0], o[1]); w.y = pk2(o[2], o[3]); w.z = pk2(o[4], o[5]); w.w = pk2(o[6], o[7]);
                *(LAS u32x4*)(Cg + (F.wave < 6 ? (MB_BG - MB_CG) / 2 : 0) + ((F.wave & 1) * 64 + l) * 72 + (c0 & 63)) = w; } }
        if (tr) { LAS bf16_t* dstT = XT + F.wave * 64 * 72;
#pragma unroll
            for (int j = 0; j < 8; ++j) *(LAS u32x4*)(dstT + ((c0 & 63) + j) * 72 + tg * 8) = (u32x4){pkT[j][0], pkT[j][1], pkT[j][2], pkT[j][3]}; } }
    const int g4 = F.lane >> 4, r16 = F.lane & 15;
    if (STAGE == 1) {
        __syncthreads();
        float* MST = (float*)(F.ws + WS_MST) + ((size_t)(b * 64 + c) * 4) * 4096;
#pragma unroll
        for (int q = 0; q < 8; ++q) { const int tix = F.wave * 8 + q, h = tix >> 4, mt = (tix >> 2) & 3, nt = tix & 3;
            f32x4 acc = (f32x4){0.f, 0.f, 0.f, 0.f};
            acc = mma_nt<64>(BT + ((h >> 1) * 64 + nt * 16) * 72, 72, XT + (h * 64 + mt * 16) * 72, 72, acc, F.lane);
            *(f32x4*)(MST + (size_t)h * 4096 + (mt * 16 + r16) * 64 + nt * 16 + 4 * g4) = acc; }
        if (F.tid < 4) ((float*)(F.ws + WS_MDEC))[(b * 64 + c) * 4 + F.tid] = __expf(acs[63 * 4 + F.tid]);
    } else {
        const int mt = F.wave & 3, nh = F.wave >> 2;
        const int l = mt * 16 + r16;
        u32x2 zz[4][2];
#pragma unroll
        for (int h = 0; h < 4; ++h)
#pragma unroll
            for (int q = 0; q < 2; ++q) zz[h][q] = *(const u32x2*)(U + (T0 + l) * NINP + UM + h * 64 + (2 * nh + q) * 16 + 4 * g4);
        __syncthreads();
        f32x4 yv[4][2];
#pragma unroll
        for (int g = 0; g < 2; ++g)
#pragma unroll
            for (int q = 0; q < 2; ++q) { f32x4 G = (f32x4){0.f, 0.f, 0.f, 0.f};
                G = mma_nt<64>(Bg + (g * 64 + (2 * nh + q) * 16) * 72, 72, Cg + (g * 64 + mt * 16) * 72, 72, G, F.lane);
                const int s0 = (2 * nh + q) * 16 + 4 * g4;
#pragma unroll
                for (int hh = 0; hh < 2; ++hh) { const int h = 2 * g + hh; const float al = acs[l * 4 + h]; float v[4];
#pragma unroll
                    for (int i = 0; i < 4; ++i) v[i] = (s0 + i <= l) ? G[i] * __expf(al - acs[(s0 + i) * 4 + h]) : 0.f;
                    *(LAS u32x2*)(Mb + (h * 64 + l) * 72 + s0) = (u32x2){pk2(v[0], v[1]), pk2(v[2], v[3])}; } }
        __syncthreads();
#pragma unroll
        for (int h = 0; h < 4; ++h) { const int g = h >> 1; const float eal = __expf(acs[l * 4 + h]), idt = 1.0f / dts[l * 4 + h], dsk = F.in[I_MD][layer * 4 + h];
#pragma unroll
            for (int q = 0; q < 2; ++q) { const int nt = 2 * nh + q;
                f32x4 yd = (f32x4){0.f, 0.f, 0.f, 0.f}, yo = (f32x4){0.f, 0.f, 0.f, 0.f};
                yd = mma_nt<64>(XT + (h * 64 + nt * 16) * 72, 72, Mb + (h * 64 + mt * 16) * 72, 72, yd, F.lane);
                yo = mma_nt<64>(S0 + (h * 64 + nt * 16) * 72, 72, Cg + (g * 64 + mt * 16) * 72, 72, yo, F.lane);
#pragma unroll
                for (int i = 0; i < 4; ++i) { const int p = nt * 16 + 4 * g4 + i;
                    const float xs = bf2f(XT[(h * 64 + p) * 72 + l]) * idt;
                    yv[h][q][i] = yd[i] + yo[i] * eal + dsk * xs; } } }
        float part = 0.f;
#pragma unroll
        for (int h = 0; h < 4; ++h)
#pragma unroll
            for (int q = 0; q < 2; ++q) { const float z4[4] = {__uint_as_float(zz[h][q].x << 16), __uint_as_float(zz[h][q].x & 0xffff0000u), __uint_as_float(zz[h][q].y << 16), __uint_as_float(zz[h][q].y & 0xffff0000u)};
#pragma unroll
                for (int i = 0; i < 4; ++i) { const float v = yv[h][q][i] * siluf_(z4[i]); yv[h][q][i] = v; part += v * v; } }
        f32x4 nw[4][2];
#pragma unroll
        for (int h = 0; h < 4; ++h)
#pragma unroll
            for (int q = 0; q < 2; ++q) nw[h][q] = *(const f32x4*)(F.in[I_MNORM] + layer * 256 + h * 64 + (2 * nh + q) * 16 + 4 * g4);
        part = xrows(part, OpAdd());
        if (g4 == 0) atomicAdd((float*)(rs + l), part);
        __syncthreads();
        bf16_t* Y = (bf16_t*)(F.ws + WS_H);
        const float rstd = rsqrtf(rs[l] * (1.0f / 256.0f) + 1e-6f);
#pragma unroll
        for (int h = 0; h < 4; ++h)
#pragma unroll
            for (int q = 0; q < 2; ++q) { const f32x4 o = yv[h][q] * rstd * nw[h][q];
                *(u32x2*)(Y + (T0 + l) * DM + h * 64 + (2 * nh + q) * 16 + 4 * g4) = (u32x2){pk2(o[0], o[1]), pk2(o[2], o[3])}; }
    }
}
__device__ __forceinline__ void item_mamba_carry(const Frame& F_, int item) { Frame F = relocal(F_);
    const int b = item >> 2, h = item & 3;
    float* MST = (float*)(F.ws + WS_MST); const float* MD = (const float*)(F.ws + WS_MDEC);
    float s[8];
#pragma unroll
    for (int j = 0; j < 8; ++j) s[j] = 0.f;
    for (int c = 0; c < 64; ++c) { float* p = MST + ((size_t)(b * 64 + c) * 4 + h) * 4096 + F.tid * 8; const float d = MD[(b * 64 + c) * 4 + h];
        const f32x4 a = *(f32x4*)p, q = *(f32x4*)(p + 4);
        *(f32x4*)p = (f32x4){s[0], s[1], s[2], s[3]}; *(f32x4*)(p + 4) = (f32x4){s[4], s[5], s[6], s[7]};
        s[0] = s[0] * d + a[0]; s[1] = s[1] * d + a[1]; s[2] = s[2] * d + a[2]; s[3] = s[3] * d + a[3];
        s[4] = s[4] * d + q[0]; s[5] = s[5] * d + q[1]; s[6] = s[6] * d + q[2]; s[7] = s[7] * d + q[3]; }
}

#define S5_WSYNC() asm volatile("s_waitcnt lgkmcnt(0)" ::: "memory")
template <int STAGE> __device__ __forceinline__ void item_s5(const Frame& F_, int layer, int item) { Frame F = relocal(F_);
    const bf16_t* U = (const bf16_t*)(F.ws + WS_U);
    const int b = item >> 6, c = item & 63; const size_t T0 = (size_t)b * SEQ + c * 64;
    LAS bf16_t* us = (LAS bf16_t*)F.lds;
    LAS bf16_t* BuW = (LAS bf16_t*)(F.lds + 33792) + F.wave * 4224;
    const float* tab = (const float*)(F.ws + WS_S5TAB + (size_t)layer * S5TAB_L);
    { const int tok = F.tid >> 3, part = F.tid & 7;
#pragma unroll
      for (int q = 0; q < 4; ++q) *(LAS u32x4*)(us + tok * 264 + 32 * part + 8 * q) = *(const u32x4*)(U + (T0 + tok) * NINP + US + 32 * part + 8 * q); }
    const int lane = F.lane, r16 = lane & 15, g4 = lane >> 4, gq = lane >> 5, n0 = lane & 31, g = 2 * F.wave + gq, gn0 = g * 64 + n0, gn1 = gn0 + 32;
    bf16x8 bfr[2][8];
    { const bf16_t* bbt = (const bf16_t*)(F.ws + WS_S5TAB + (size_t)layer * S5TAB_L + S5TAB_BBT);
#pragma unroll
      for (int gg = 0; gg < 2; ++gg)
#pragma unroll
          for (int nt = 0; nt < 8; ++nt) { u32x4 z = (u32x4){0u, 0u, 0u, 0u}; if (g4 < 2) z = *(const u32x4*)(bbt + ((size_t)(2 * F.wave + gg) * 128 + 16 * nt + r16) * 16 + 8 * g4); bfr[gg][nt] = __builtin_bit_cast(bf16x8, z); } }
    const float a0r = tab[gn0 * 2], a0i = tab[gn0 * 2 + 1], a1r = tab[gn1 * 2], a1i = tab[gn1 * 2 + 1];
    float* ST = (float*)(F.ws + WS_S5ST) + (size_t)(b * 64 + c) * 2048;
    float h0r = 0.f, h0i = 0.f, h1r = 0.f, h1i = 0.f;
    if (STAGE == 2) { h0r = ST[gn0 * 2]; h0i = ST[gn0 * 2 + 1]; h1r = ST[gn1 * 2]; h1i = ST[gn1 * 2 + 1]; }
    bf16x8 cf[2][4];
    if (STAGE == 2) { const bf16_t* cm = (const bf16_t*)(F.ws + WS_S5TAB + (size_t)layer * S5TAB_L + S5TAB_F);
#pragma unroll
        for (int gg = 0; gg < 2; ++gg)
#pragma unroll
            for (int ks = 0; ks < 4; ++ks) cf[gg][ks] = *(const bf16x8*)(cm + ((size_t)((2 * F.wave + gg) * 16 + r16)) * 128 + 32 * ks + 8 * g4); }
    LAS bf16_t* YSl = (LAS bf16_t*)(F.lds + 101376);
    const bf16_t* GW = (const bf16_t*)(F.ws + WS_GLU) + (size_t)layer * 512 * 256;
    f32x4 dsk[2], bvl[2], bgt[2]; bf16x8 gwb[2][4];
    if (STAGE == 2) {
#pragma unroll
        for (int gg = 0; gg < 2; ++gg) dsk[gg] = *(const f32x4*)(F.in[I_SD] + layer * 256 + (2 * F.wave + gg) * 16 + 4 * g4);
#pragma unroll
        for (int q = 0; q < 2; ++q) { const int c0 = 32 * F.wave + 16 * q + 4 * g4; bvl[q] = *(const f32x4*)(F.in[I_SGLUB] + layer * 512 + c0); bgt[q] = *(const f32x4*)(F.in[I_SGLUB] + layer * 512 + 256 + c0); }
#pragma unroll
        for (int ks = 0; ks < 2; ++ks)
#pragma unroll
            for (int q = 0; q < 2; ++q) { const int c = 32 * F.wave + 16 * q + r16; const int rowv = 256 * (c >> 7) + (c & 127);
                gwb[ks][2 * q] = *(const bf16x8*)(GW + (size_t)rowv * 256 + 32 * ks + 8 * g4); gwb[ks][2 * q + 1] = *(const bf16x8*)(GW + (size_t)(rowv + 128) * 256 + 32 * ks + 8 * g4); } }
    __syncthreads();
#pragma unroll 1
    for (int lb = 0; lb < 4; ++lb) {
#pragma unroll
        for (int gg = 0; gg < 2; ++gg) { u32x4 z = (u32x4){0u, 0u, 0u, 0u}; if (g4 < 2) z = *(const LAS u32x4*)(us + (16 * lb + r16) * 264 + (2 * F.wave + gg) * 16 + 8 * g4);
            const bf16x8 afr = __builtin_bit_cast(bf16x8, z);
#pragma unroll
            for (int nt = 0; nt < 8; ++nt) { const f32x4 acc = __builtin_amdgcn_mfma_f32_16x16x32_bf16(bfr[gg][nt], afr, (f32x4){0.f, 0.f, 0.f, 0.f}, 0, 0, 0);
                *(LAS u32x2*)(BuW + r16 * 264 + gg * 128 + 16 * nt + 4 * g4) = (u32x2){pk2(acc[0], acc[1]), pk2(acc[2], acc[3])}; } }
        S5_WSYNC();
#pragma unroll 4
        for (int li = 0; li < 16; ++li) { LAS u32x2* bp = (LAS u32x2*)(BuW + li * 264 + gq * 128 + 4 * n0); const u32x2 v = *bp;
            { const float br = __uint_as_float(v.x << 16), bi = __uint_as_float(v.x & 0xffff0000u); const float nr = a0r * h0r - a0i * h0i + br, ni = a0r * h0i + a0i * h0r + bi; h0r = nr; h0i = ni; }
            { const float br = __uint_as_float(v.y << 16), bi = __uint_as_float(v.y & 0xffff0000u); const float nr = a1r * h1r - a1i * h1i + br, ni = a1r * h1i + a1i * h1r + bi; h1r = nr; h1i = ni; }
            if (STAGE == 2) *bp = (u32x2){pk2(h0r, h0i), pk2(h1r, h1i)}; }
        S5_WSYNC();
        if (STAGE == 2) {
#pragma unroll
            for (int gg = 0; gg < 2; ++gg) { f32x4 acc = (f32x4){0.f, 0.f, 0.f, 0.f};
#pragma unroll
                for (int ks = 0; ks < 4; ++ks) { const bf16x8 a = *(const LAS bf16x8*)(BuW + r16 * 264 + gg * 128 + 32 * ks + 8 * g4);
                    acc = __builtin_amdgcn_mfma_f32_16x16x32_bf16(cf[gg][ks], a, acc, 0, 0, 0); }
                const int ch0 = (2 * F.wave + gg) * 16 + 4 * g4, l = lb * 16 + r16; const u32x2 uw = *(const LAS u32x2*)(us + l * 264 + ch0);
                const float u4[4] = {__uint_as_float(uw.x << 16), __uint_as_float(uw.x & 0xffff0000u), __uint_as_float(uw.y << 16), __uint_as_float(uw.y & 0xffff0000u)}; float y[4];
#pragma unroll
                for (int i = 0; i < 4; ++i) y[i] = gelu_tanh(acc[i] + dsk[gg][i] * u4[i]);
                *(LAS u32x2*)(YSl + l * 264 + ch0) = (u32x2){pk2(y[0], y[1]), pk2(y[2], y[3])}; }
            S5_WSYNC();
        }
    }
    if (STAGE == 2) __syncthreads();
    if (STAGE == 1) { ST[gn0 * 2] = h0r; ST[gn0 * 2 + 1] = h0i; ST[gn1 * 2] = h1r; ST[gn1 * 2 + 1] = h1i; }
    if (STAGE == 2) {
        f32x4 av[4][2], ag[4][2];
#pragma unroll
        for (int m = 0; m < 4; ++m)
#pragma unroll
            for (int q = 0; q < 2; ++q) { av[m][q] = (f32x4){0.f, 0.f, 0.f, 0.f}; ag[m][q] = (f32x4){0.f, 0.f, 0.f, 0.f}; }
#pragma unroll
        for (int ks = 0; ks < 8; ++ks) {
            bf16x8 af[4], bcur[4];
#pragma unroll
            for (int j = 0; j < 4; ++j) bcur[j] = gwb[ks & 1][j];
            if (ks + 2 < 8) {
#pragma unroll
                for (int q = 0; q < 2; ++q) { const int c = 32 * F.wave + 16 * q + r16; const int rowv = 256 * (c >> 7) + (c & 127);
                    gwb[ks & 1][2 * q] = *(const bf16x8*)(GW + (size_t)rowv * 256 + 32 * (ks + 2) + 8 * g4); gwb[ks & 1][2 * q + 1] = *(const bf16x8*)(GW + (size_t)(rowv + 128) * 256 + 32 * (ks + 2) + 8 * g4); } }
#pragma unroll
            for (int m = 0; m < 4; ++m) af[m] = *(const LAS bf16x8*)(YSl + (16 * m + r16) * 264 + 32 * ks + 8 * g4);
#pragma unroll
            for (int m = 0; m < 4; ++m)
#pragma unroll
                for (int q = 0; q < 2; ++q) { av[m][q] = __builtin_amdgcn_mfma_f32_16x16x32_bf16(bcur[2 * q], af[m], av[m][q], 0, 0, 0); ag[m][q] = __builtin_amdgcn_mfma_f32_16x16x32_bf16(bcur[2 * q + 1], af[m], ag[m][q], 0, 0, 0); }
        }
        bf16_t* Y = (bf16_t*)(F.ws + WS_H);
#pragma unroll
        for (int q = 0; q < 2; ++q) { const int c0 = 32 * F.wave + 16 * q + 4 * g4;
#pragma unroll
            for (int m = 0; m < 4; ++m) { float o[4];
#pragma unroll
                for (int i = 0; i < 4; ++i) o[i] = (av[m][q][i] + bvl[q][i]) * sigmoidf_(ag[m][q][i] + bgt[q][i]);
                *(u32x2*)(Y + (T0 + 16 * m + r16) * DM + 768 + c0) = (u32x2){pk2(o[0], o[1]), pk2(o[2], o[3])}; } }
    }
}
__device__ __forceinline__ void item_s5_carry(const Frame& F_, int layer, int b) { Frame F = relocal(F_);
    const float* tab = (const float*)(F.ws + WS_S5TAB + (size_t)layer * S5TAB_L) + 2048;
    float* ST = (float*)(F.ws + WS_S5ST) + (size_t)b * 64 * 2048;
#pragma unroll
    for (int q = 0; q < 2; ++q) { const int gn = F.tid + 512 * q; const float pr = tab[gn * 2], pi = tab[gn * 2 + 1]; float hr = 0.f, hi = 0.f;
        for (int c = 0; c < 64; ++c) { float* p = ST + (size_t)c * 2048 + gn * 2; const float tr = p[0], ti = p[1]; p[0] = hr; p[1] = hi;
            const float nr = pr * hr - pi * hi + tr, ni = pr * hi + pi * hr + ti; hr = nr; hi = ni; } }
}

constexpr int RB_LD = 72;
constexpr int RW_R = 0, RW_K = 16384, RW_V = 32768, RW_W = 49152, RW_A = 65536, RW_B = 81920;
constexpr int R3_G = 49152, R3_O = 65536, R3_TILES = 81920, R3_BON = 147456;
template <int STAGE> __device__ __forceinline__ void rwkv_prep(const Frame& F_, int layer, int b, int h, int c) { Frame F = relocal(F_);
    const bf16_t* U = (const bf16_t*)(F.ws + WS_U);
    const int l0 = c * 64; const size_t T0 = (size_t)b * SEQ + l0;
    LAS float* Rr = (LAS float*)(F.lds + RW_R); LAS float* Kk = (LAS float*)(F.lds + RW_K); LAS float* Vv = (LAS float*)(F.lds + RW_V); LAS float* Ww = (LAS float*)(F.lds + RW_W);
    LAS float* Aa = (LAS float*)(F.lds + (STAGE == 1 ? RW_A : R3_O)); LAS float* Bb = (LAS float*)(F.lds + RW_B); LAS float* Gg = (LAS float*)(F.lds + R3_G); LAS float* BON = (LAS float*)(F.lds + R3_BON);
    LAS bf16_t* TWb = (LAS bf16_t*)(F.lds + 98304); LAS bf16_t* DAb = (LAS bf16_t*)(F.lds + (STAGE == 1 ? 103424 : 118784)); LAS bf16_t* SGb = (LAS bf16_t*)(F.lds + 123904);
    LAS bf16_t* w2T = (LAS bf16_t*)(F.lds + 108544); LAS bf16_t* a2T = (LAS bf16_t*)(F.lds + (STAGE == 1 ? 113664 : 133120)); LAS bf16_t* g2T = (LAS bf16_t*)(F.lds + 138240);
    const float* mu = F.in[I_RMU] + layer * 896;
    float pw0[2] = {0.f, 0.f}, pa0[2] = {0.f, 0.f}; f32x4 pkkw[2], pkaw[2], prk[2];
    if (STAGE == 1) { const int cgl = layer * 256 + h * 64 + 8 * (F.tid & 7);
#pragma unroll
        for (int q = 0; q < 2; ++q) { pkkw[q] = *(const f32x4*)(F.in[I_RKK] + cgl + 4 * q); pkaw[q] = *(const f32x4*)(F.in[I_RKA] + cgl + 4 * q); prk[q] = *(const f32x4*)(F.in[I_RRK] + cgl + 4 * q); }
#pragma unroll
        for (int q = 0; q < 2; ++q) { const int cg = layer * 256 + h * 64 + 16 * (2 * (F.wave & 1) + q) + (F.lane & 15); pw0[q] = F.in[I_RW0][cg]; pa0[q] = F.in[I_RA0][cg]; } }
    { const int tok = F.tid >> 3, p8 = F.tid & 7; const bool first = (l0 + tok == 0);
      const bf16_t* cur = U + (T0 + tok) * NINP + UR; const bf16_t* prv = first ? cur : cur - NINP;
      const float pz = first ? 0.f : 1.f;
      u32x4 cw[3], pw[3]; u32x2 c1 = (u32x2){0u, 0u}, p1 = (u32x2){0u, 0u}, c2 = (u32x2){0u, 0u}, p2 = (u32x2){0u, 0u}; u32x4 c3 = (u32x4){0u, 0u, 0u, 0u}, p3 = (u32x4){0u, 0u, 0u, 0u};
#pragma unroll
      for (int sec = (STAGE == 1 ? 0 : 2); sec < 3; ++sec) { const int co = sec * 256 + h * 64 + 8 * p8; cw[sec] = *(const u32x4*)(cur + co); pw[sec] = *(const u32x4*)(prv + co); }
      if (STAGE == 1) { c1 = *(const u32x2*)(cur + 768 + 4 * p8); p1 = *(const u32x2*)(prv + 768 + 4 * p8); c2 = *(const u32x2*)(cur + 800 + 4 * p8); p2 = *(const u32x2*)(prv + 800 + 4 * p8); }
      if (STAGE == 3) { c3 = *(const u32x4*)(cur + 832 + 8 * p8); p3 = *(const u32x4*)(prv + 832 + 8 * p8); }
#pragma unroll
      for (int sec = (STAGE == 1 ? 0 : 2); sec < 3; ++sec) { const int co = sec * 256 + h * 64 + 8 * p8; float av[8], pq[8]; unpack8(cw[sec], av); unpack8(pw[sec], pq);
          const f32x4 m0 = *(const f32x4*)(mu + co), m1 = *(const f32x4*)(mu + co + 4);
          LAS float* dst = (sec == 0 ? Rr : sec == 1 ? Kk : Vv) + tok * 64 + 8 * p8;
#pragma unroll
          for (int j = 0; j < 8; ++j) pq[j] *= pz;
          *(LAS f32x4*)dst = (f32x4){av[0] + m0[0] * (pq[0] - av[0]), av[1] + m0[1] * (pq[1] - av[1]), av[2] + m0[2] * (pq[2] - av[2]), av[3] + m0[3] * (pq[3] - av[3])};
          *(LAS f32x4*)(dst + 4) = (f32x4){av[4] + m1[0] * (pq[4] - av[4]), av[5] + m1[1] * (pq[5] - av[5]), av[6] + m1[2] * (pq[6] - av[6]), av[7] + m1[3] * (pq[7] - av[7])}; }
      if (STAGE == 1) {
#pragma unroll
        for (int which = 0; which < 2; ++which) { const int co = 768 + 32 * which + 4 * p8; const u32x2 cv = which ? c2 : c1, pv = which ? p2 : p1;
          const f32x4 m0 = *(const f32x4*)(mu + co);
          float x[4] = {__uint_as_float(cv.x << 16), __uint_as_float(cv.x & 0xffff0000u), __uint_as_float(cv.y << 16), __uint_as_float(cv.y & 0xffff0000u)};
          const float y[4] = {pz * __uint_as_float(pv.x << 16), pz * __uint_as_float(pv.x & 0xffff0000u), pz * __uint_as_float(pv.y << 16), pz * __uint_as_float(pv.y & 0xffff0000u)};
#pragma unroll
          for (int j = 0; j < 4; ++j) { x[j] = x[j] + m0[j] * (y[j] - x[j]); if (which == 0) x[j] = tanhf_(x[j]); }
          *(LAS u32x2*)((which ? DAb : TWb) + tok * 40 + 4 * p8) = (u32x2){pk2(x[0], x[1]), pk2(x[2], x[3])}; } }
      if (STAGE == 3) { const int co = 832 + 8 * p8; float av[8], pq[8]; unpack8(c3, av); unpack8(p3, pq);
          const f32x4 m0 = *(const f32x4*)(mu + co), m1 = *(const f32x4*)(mu + co + 4); float x[8];
#pragma unroll
          for (int j = 0; j < 8; ++j) x[j] = sigmoidf_(av[j] + (j < 4 ? m0[j] : m1[j - 4]) * (pz * pq[j] - av[j]));
          *(LAS u32x4*)(SGb + tok * RB_LD + 8 * p8) = (u32x4){pk2(x[0], x[1]), pk2(x[2], x[3]), pk2(x[4], x[5]), pk2(x[6], x[7])}; } }
    { const int ch = F.tid & 63, part = F.tid >> 6;
      if (STAGE == 1) { const float* w2 = F.in[I_RW2] + ((size_t)layer * 32 + 4 * part) * 256 + h * 64 + ch;
          *(LAS u32x2*)(w2T + ch * 40 + 4 * part) = (u32x2){pk2(w2[0], w2[256]), pk2(w2[512], w2[768])}; }
      if (STAGE == 1) { const float* a2 = F.in[I_RA2] + ((size_t)layer * 32 + 4 * part) * 256 + h * 64 + ch;
          *(LAS u32x2*)(a2T + ch * 40 + 4 * part) = (u32x2){pk2(a2[0], a2[256]), pk2(a2[512], a2[768])}; }
      if (STAGE == 3) { const float* g2 = F.in[I_RG2] + ((size_t)layer * 64 + 8 * part) * 256 + h * 64 + ch;
          *(LAS u32x4*)(g2T + ch * RB_LD + 8 * part) = (u32x4){pk2(g2[0], g2[256]), pk2(g2[512], g2[768]), pk2(g2[1024], g2[1280]), pk2(g2[1536], g2[1792])}; } }
    __syncthreads();
    { const int lane = F.lane, mt = F.wave >> 1, nt0 = 2 * (F.wave & 1), r = lane & 15, g4 = lane >> 4; const f32x4 zero4 = (f32x4){0.f, 0.f, 0.f, 0.f};
#pragma unroll
      for (int q = 0; q < 2; ++q) { const int nt = nt0 + q, ch = 16 * nt + r;
          if (STAGE == 1) { const f32x4 wl = mma_nt<32>(TWb + 16 * mt * 40, 40, w2T + 16 * nt * 40, 40, zero4, lane); const float w0 = pw0[q];
#pragma unroll
              for (int i = 0; i < 4; ++i) { const float x = w0 + wl[i]; const float wlog = -__logf(1.0f + __expf(-x)) - 0.5f; Ww[(16 * mt + 4 * g4 + i) * 64 + ch] = __expf(-__expf(wlog)); } }
          if (STAGE == 1) { const f32x4 al = mma_nt<32>(DAb + 16 * mt * 40, 40, a2T + 16 * nt * 40, 40, zero4, lane); const float a0 = pa0[q];
#pragma unroll
              for (int i = 0; i < 4; ++i) Aa[(16 * mt + 4 * g4 + i) * 64 + ch] = sigmoidf_(a0 + al[i]); }
          if (STAGE == 3) { const f32x4 gv = mma_nt<64>(SGb + 16 * mt * RB_LD, RB_LD, g2T + 16 * nt * RB_LD, RB_LD, zero4, lane);
#pragma unroll
              for (int i = 0; i < 4; ++i) Gg[(16 * mt + 4 * g4 + i) * 64 + ch] = gv[i]; } } }
    __syncthreads();
    float* gBON = (float*)(F.ws + WS_BON) + ((size_t)(b * 4 + h) * 64 + c) * 64;
    if (STAGE == 1) { const int t = F.tid >> 3, p8 = F.tid & 7;
      LAS float* pa = Aa + t * 64 + 8 * p8; LAS float* pk = Kk + t * 64 + 8 * p8; LAS float* pr = Rr + t * 64 + 8 * p8; LAS float* pb = Bb + t * 64 + 8 * p8;
      float kp[8], kkv[8], av[8]; float ss = 0.f, bo = 0.f;
#pragma unroll
      for (int q = 0; q < 2; ++q) { const f32x4 a4 = *(const LAS f32x4*)(pa + 4 * q), k4 = *(const LAS f32x4*)(pk + 4 * q), r4 = *(const LAS f32x4*)(pr + 4 * q);
#pragma unroll
          for (int j = 0; j < 4; ++j) { const float a = a4[j], kraw = k4[j]; av[4 * q + j] = a; kp[4 * q + j] = kraw * (1.0f + (a - 1.0f) * pkaw[q][j]);
              kkv[4 * q + j] = kraw * pkkw[q][j]; ss += kkv[4 * q + j] * kkv[4 * q + j]; bo += r4[j] * kp[4 * q + j] * prk[q][j]; } }
      ss = sum8(ss); bo = sum8(bo);
      const float rn = rsqrtf(fmaxf(ss, 1e-24f));
#pragma unroll
      for (int q = 0; q < 2; ++q) { f32x4 ko, ao, bq;
#pragma unroll
          for (int j = 0; j < 4; ++j) { const float kkn = kkv[4 * q + j] * rn; ko[j] = kp[4 * q + j]; ao[j] = -kkn; bq[j] = kkn * av[4 * q + j]; }
          *(LAS f32x4*)(pk + 4 * q) = ko; *(LAS f32x4*)(pa + 4 * q) = ao; *(LAS f32x4*)(pb + 4 * q) = bq; }
      if (p8 == 0) gBON[t] = bo; }
    else if (F.tid < 64) BON[F.tid] = gBON[F.tid];
    __syncthreads();
}
constexpr int RB_AT = 98304, RB_ATT = RB_AT + 9216, RB_BT = RB_ATT + 9216, RB_BTT = RB_BT + 9216, RB_KT = RB_BTT + 9216, RB_RT = RB_KT + 9216, RB_VT = RB_RT + 9216, RB_GC = RB_VT + 9216;
constexpr int RX_X = 0, RX_XT = 9216, RX_TB = 18432, RX_M = 27648, RX_NRT = 36864, RX_G1T = 46080, RX_G2T = 55296, RX_QT = 64512;
__device__ __forceinline__ void st_tile(LAS bf16_t* dst, int mt, int nt, const f32x4 v, int lane) {
    const int r = lane & 15, g = lane >> 4;
#pragma unroll
    for (int i = 0; i < 4; ++i) dst[(16 * mt + 4 * g + i) * RB_LD + 16 * nt + r] = f2bf(v[i]);
}
__device__ __forceinline__ void st_tile_t(LAS bf16_t* dst, int mt, int nt, const f32x4 v, int lane) {
    const int r = lane & 15, g = lane >> 4; u32x2 w; w.x = pk2(v[0], v[1]); w.y = pk2(v[2], v[3]);
    *(LAS u32x2*)(dst + (16 * nt + r) * RB_LD + 16 * mt + 4 * g) = w;
}
__device__ __forceinline__ void st_rm(LAS bf16_t* dst, int mt, int nt, const f32x4 v, int lane) {
    const int r = lane & 15, g = lane >> 4; *(LAS u32x2*)(dst + (16 * mt + r) * RB_LD + 16 * nt + 4 * g) = (u32x2){pk2(v[0], v[1]), pk2(v[2], v[3])};
}
__device__ __forceinline__ void st_tr(LAS bf16_t* dst, int mt, int nt, const f32x4 v, int lane) {
    const int r = lane & 15, g = lane >> 4;
#pragma unroll
    for (int i = 0; i < 4; ++i) dst[(16 * nt + 4 * g + i) * RB_LD + 16 * mt + r] = f2bf(v[i]);
}
__device__ __forceinline__ void ld_fr(const LAS bf16_t* M, int row0, int lane, bf16x8 (&f)[2]) { const LAS bf16_t* p = M + (row0 + (lane & 15)) * RB_LD + 8 * (lane >> 4); f[0] = *(const LAS bf16x8*)p; f[1] = *(const LAS bf16x8*)(p + 32); }
__device__ __forceinline__ f32x4 mm_fr(const bf16x8 (&a)[2], const bf16x8 (&b)[2], f32x4 acc) { acc = __builtin_amdgcn_mfma_f32_16x16x32_bf16(a[0], b[0], acc, 0, 0, 0); return __builtin_amdgcn_mfma_f32_16x16x32_bf16(a[1], b[1], acc, 0, 0, 0); }
__device__ __forceinline__ void item_rwkv1(const Frame& F_, int layer, int item) { Frame F = relocal(F_);
    const int b = item >> 8, h = (item >> 6) & 3, c = item & 63;
    rwkv_prep<1>(F, layer, b, h, c);
    LAS float* Rr = (LAS float*)(F.lds + RW_R); LAS float* Kk = (LAS float*)(F.lds + RW_K); LAS float* Vv = (LAS float*)(F.lds + RW_V); LAS float* Ww = (LAS float*)(F.lds + RW_W);
    LAS float* Aa = (LAS float*)(F.lds + RW_A); LAS float* Bb = (LAS float*)(F.lds + RW_B);
    LAS bf16_t* At = (LAS bf16_t*)(F.lds + RB_AT); LAS bf16_t* AtT = (LAS bf16_t*)(F.lds + RB_ATT); LAS bf16_t* Bt = (LAS bf16_t*)(F.lds + RB_BT); LAS bf16_t* BtT = (LAS bf16_t*)(F.lds + RB_BTT);
    LAS bf16_t* Kt = (LAS bf16_t*)(F.lds + RB_KT); LAS bf16_t* Rt = (LAS bf16_t*)(F.lds + RB_RT); LAS bf16_t* VT = (LAS bf16_t*)(F.lds + RB_VT); LAS float* gC = (LAS float*)(F.lds + RB_GC);
    LAS bf16_t* X = (LAS bf16_t*)(F.lds + RX_X); LAS bf16_t* XT = (LAS bf16_t*)(F.lds + RX_XT); LAS bf16_t* Tb = (LAS bf16_t*)(F.lds + RX_TB); LAS bf16_t* Mm = (LAS bf16_t*)(F.lds + RX_M);
    LAS bf16_t* NrT = (LAS bf16_t*)(F.lds + RX_NRT); LAS bf16_t* G1T = (LAS bf16_t*)(F.lds + RX_G1T); LAS bf16_t* G2T = (LAS bf16_t*)(F.lds + RX_G2T); LAS bf16_t* QT = (LAS bf16_t*)(F.lds + RX_QT);
    { const int k = F.tid & 63, part = F.tid >> 6; float g = 1.0f;
      for (int pp = 0; pp < part; ++pp) { float w8[8];
#pragma unroll
          for (int i = 0; i < 8; ++i) w8[i] = Ww[(8 * pp + i) * 64 + k];
          g *= ((w8[0] * w8[1]) * (w8[2] * w8[3])) * ((w8[4] * w8[5]) * (w8[6] * w8[7])); }
      unsigned aT[4], bT[4], vT[4]; unsigned pa = 0u, pb = 0u, pv = 0u;
#pragma unroll
      for (int i = 0; i < 8; ++i) { const int t = 8 * part + i; const float gp = g; g *= Ww[t * 64 + k]; const float ig = __builtin_amdgcn_rcpf(g);
          const bf16_t av = f2bf(Aa[t * 64 + k] * gp), bv = f2bf(Bb[t * 64 + k] * ig), vv = f2bf(Vv[t * 64 + k]);
          At[t * RB_LD + k] = av; Bt[t * RB_LD + k] = bv;
          Kt[t * RB_LD + k] = f2bf(Kk[t * 64 + k] * ig); Rt[t * RB_LD + k] = f2bf(Rr[t * 64 + k] * g);
          if (i & 1) { aT[i >> 1] = pa | ((unsigned)av << 16); bT[i >> 1] = pb | ((unsigned)bv << 16); vT[i >> 1] = pv | ((unsigned)vv << 16); } else { pa = av; pb = bv; pv = vv; } }
      *(LAS u32x4*)(AtT + k * RB_LD + 8 * part) = (u32x4){aT[0], aT[1], aT[2], aT[3]}; *(LAS u32x4*)(BtT + k * RB_LD + 8 * part) = (u32x4){bT[0], bT[1], bT[2], bT[3]};
      *(LAS u32x4*)(VT + k * RB_LD + 8 * part) = (u32x4){vT[0], vT[1], vT[2], vT[3]};
      if (part == 7) gC[k] = g; }
    __syncthreads();
    const int lane = F.lane, mt = F.wave >> 1, nt0 = 2 * (F.wave & 1), r = lane & 15, g4 = lane >> 4;
    const f32x4 zero4 = (f32x4){0.f, 0.f, 0.f, 0.f};
    f32x4 Tacc[2];
    bf16x8 fa0[2], fa1[2], fa2[2], fb0[2][2], fb1[2][2], fb2[2][2];
    ld_fr(Bt, 16 * mt, lane, fa0); ld_fr(Kt, 16 * mt, lane, fa1); ld_fr(Rt, 16 * mt, lane, fa2);
#pragma unroll
    for (int q = 0; q < 2; ++q) { ld_fr(At, 16 * (nt0 + q), lane, fb0[q]); ld_fr(Bt, 16 * (nt0 + q), lane, fb1[q]); }
#pragma unroll
    for (int q = 0; q < 2; ++q) { const int nt = nt0 + q;
        f32x4 n = mm_fr(fb0[q], fa0, zero4);
        f32x4 m = mm_fr(fb0[q], fa1, zero4);
        f32x4 nr = mm_fr(fb1[q], fa2, zero4);
#pragma unroll
        for (int i = 0; i < 4; ++i) { const int row = 16 * mt + r, col = 16 * nt + 4 * g4 + i;
            n[i] = (row < col) ? n[i] : 0.f; m[i] = (row < col) ? m[i] : 0.f; nr[i] = (col <= row) ? nr[i] : 0.f;
            Tacc[q][i] = n[i] + (row == col ? 1.0f : 0.f); }
        st_rm(X, mt, nt, n, lane); st_tr(XT, mt, nt, n, lane); st_rm(Tb, mt, nt, Tacc[q], lane); st_rm(Mm, mt, nt, m, lane); st_rm(NrT, mt, nt, nr, lane); }
    __syncthreads();
#pragma unroll 1
    for (int it = 0; it < 6; ++it) {
        LAS bf16_t* Xr = (it & 1) ? G1T : X; LAS bf16_t* XTr = (it & 1) ? G2T : XT; LAS bf16_t* Tr = (it & 1) ? QT : Tb;
        LAS bf16_t* Xw = (it & 1) ? X : G1T; LAS bf16_t* XTw = (it & 1) ? XT : G2T; LAS bf16_t* Tw = (it & 1) ? Tb : QT;
        ld_fr(Tr, 16 * mt, lane, fa0); ld_fr(Xr, 16 * mt, lane, fa1);
#pragma unroll
        for (int q = 0; q < 2; ++q) ld_fr(XTr, 16 * (nt0 + q), lane, fb0[q]);
#pragma unroll
        for (int q = 0; q < 2; ++q) { const int nt = nt0 + q;
            if (it > 0) Tacc[q] = mm_fr(fb0[q], fa0, Tacc[q]);
            if (it < 5) { const f32x4 x2 = mm_fr(fb0[q], fa1, zero4); st_rm(Xw, mt, nt, x2, lane); st_tr(XTw, mt, nt, x2, lane); }
            st_rm(Tw, mt, nt, Tacc[q], lane); }
        __syncthreads();
    }
    ld_fr(NrT, 16 * mt, lane, fa0); ld_fr(BtT, 16 * mt, lane, fa1);
#pragma unroll
    for (int q = 0; q < 2; ++q) ld_fr(Tb, 16 * (nt0 + q), lane, fb0[q]);
#pragma unroll
    for (int q = 0; q < 2; ++q) { const int nt = nt0 + q;
        st_rm(G1T, mt, nt, mm_fr(fb0[q], fa0, zero4), lane);
        st_rm(G2T, mt, nt, mm_fr(fb0[q], fa1, zero4), lane); }
    __syncthreads();
    const size_t ci = (size_t)(b * 4 + h) * 64 + c;
    bf16_t* gPT = (bf16_t*)(F.ws + WS_MOE + RW_PT) + ci * 4096; bf16_t* gW1 = (bf16_t*)(F.ws + WS_MOE + RW_W1) + ci * 4096; bf16_t* gZ = (bf16_t*)(F.ws + WS_MOE + RW_Z) + ci * 4096;
    ld_fr(G1T, 16 * mt, lane, fa0); ld_fr(Rt, 16 * mt, lane, fa1); ld_fr(G2T, 16 * mt, lane, fa2);
#pragma unroll
    for (int q = 0; q < 2; ++q) { ld_fr(AtT, 16 * (nt0 + q), lane, fb0[q]); ld_fr(Mm, 16 * (nt0 + q), lane, fb1[q]); ld_fr(Kt, 16 * (nt0 + q), lane, fb2[q]); }
#pragma unroll
    for (int q = 0; q < 2; ++q) { const int nt = nt0 + q; const int row = 16 * mt + r, c0 = 16 * nt + 4 * g4;
        const f32x4 w1 = mm_fr(fb0[q], fa0, zero4);
        const f32x4 z = mm_fr(fb1[q], fa0, zero4);
        const f32x4 mr = mm_fr(fb2[q], fa1, zero4);
        const f32x4 p = mm_fr(fb0[q], fa2, zero4);
        f32x4 qq = mm_fr(fb1[q], fa2, zero4);
        const float gc = gC[row]; const u32x2 rt = *(const LAS u32x2*)(Rt + row * RB_LD + c0);
        const float rv[4] = {__uint_as_float(rt.x << 16), __uint_as_float(rt.x & 0xffff0000u), __uint_as_float(rt.y << 16), __uint_as_float(rt.y & 0xffff0000u)};
        float wv[4], zv[4], pv[4];
#pragma unroll
        for (int i = 0; i < 4; ++i) { const int col = c0 + i;
            wv[i] = w1[i] + rv[i]; zv[i] = z[i] + (col <= row ? mr[i] : 0.f); pv[i] = (p[i] + (row == col ? 1.0f : 0.f)) * gc;
            qq[i] = (qq[i] + bf2f(Kt[col * RB_LD + row])) * gc; }
        *(u32x2*)(gW1 + row * 64 + c0) = (u32x2){pk2(wv[0], wv[1]), pk2(wv[2], wv[3])};
        *(u32x2*)(gZ + row * 64 + c0) = (u32x2){pk2(zv[0], zv[1]), pk2(zv[2], zv[3])};
        *(u32x2*)(gPT + row * 64 + 32 * (nt >> 1) + 8 * g4 + 4 * (nt & 1)) = (u32x2){pk2(pv[0], pv[1]), pk2(pv[2], pv[3])};
        st_rm(QT, mt, nt, qq, lane); }
    __syncthreads();
    bf16_t* gU = (bf16_t*)(F.ws + WS_MOE + RW_U) + ci * 4096;
    ld_fr(VT, 16 * mt, lane, fa0);
#pragma unroll
    for (int q = 0; q < 2; ++q) ld_fr(QT, 16 * (nt0 + q), lane, fb0[q]);
#pragma unroll
    for (int q = 0; q < 2; ++q) { const int nt = nt0 + q;
        const f32x4 u = mm_fr(fb0[q], fa0, zero4);
        *(u32x2*)(gU + (16 * mt + r) * 64 + 16 * nt + 4 * g4) = (u32x2){pk2(u[0], u[1]), pk2(u[2], u[3])}; }
}
__device__ __forceinline__ void item_rwkv_carry(const Frame& F_, int item) { Frame F = relocal(F_);
    const int bh = item * 2 + (F.wave >> 2), nt = F.wave & 3, r = F.lane & 15, g = F.lane >> 4;
    const bf16_t* PT = (const bf16_t*)(F.ws + WS_MOE + RW_PT); const bf16_t* Uc = (const bf16_t*)(F.ws + WS_MOE + RW_U); bf16_t* Ss = (bf16_t*)(F.ws + WS_MOE + RW_S);
    f32x4 acc[4];
#pragma unroll
    for (int m = 0; m < 4; ++m) acc[m] = (f32x4){0.f, 0.f, 0.f, 0.f};
    for (int c = 0; c < 64; ++c) { const size_t ci = (size_t)bh * 64 + c;
        bf16x8 af[4][2]; f32x4 cin[4];
#pragma unroll
        for (int m = 0; m < 4; ++m) { const u32x2 uv = *(const u32x2*)(Uc + ci * 4096 + (16 * nt + r) * 64 + 16 * m + 4 * g);
            cin[m] = (f32x4){__uint_as_float(uv.x << 16), __uint_as_float(uv.x & 0xffff0000u), __uint_as_float(uv.y << 16), __uint_as_float(uv.y & 0xffff0000u)};
#pragma unroll
            for (int s = 0; s < 2; ++s) af[m][s] = *(const bf16x8*)(PT + ci * 4096 + (16 * m + r) * 64 + 32 * s + 8 * g); }
        unsigned pw[4][2];
#pragma unroll
        for (int m = 0; m < 4; ++m) { pw[m][0] = pk2(acc[m][0], acc[m][1]); pw[m][1] = pk2(acc[m][2], acc[m][3]);
            *(u32x2*)(Ss + ci * 4096 + (16 * nt + r) * 64 + 16 * m + 4 * g) = (u32x2){pw[m][0], pw[m][1]}; }
        bf16x8 bfr[2];
#pragma unroll
        for (int s = 0; s < 2; ++s) bfr[s] = __builtin_bit_cast(bf16x8, (u32x4){pw[2 * s][0], pw[2 * s][1], pw[2 * s + 1][0], pw[2 * s + 1][1]});
#pragma unroll
        for (int m = 0; m < 4; ++m) { acc[m] = __builtin_amdgcn_mfma_f32_16x16x32_bf16(af[m][0], bfr[0], cin[m], 0, 0, 0);
            acc[m] = __builtin_amdgcn_mfma_f32_16x16x32_bf16(af[m][1], bfr[1], acc[m], 0, 0, 0); }
    }
}
__device__ __forceinline__ void item_rwkv3(const Frame& F_, int layer, int item) { Frame F = relocal(F_);
    const int b = item >> 8, h = (item >> 6) & 3, c = item & 63; const size_t T0 = (size_t)b * SEQ + c * 64;
    const size_t ci3 = (size_t)(b * 4 + h) * 64 + c;
    const u32x4 tS = *(const u32x4*)((const bf16_t*)(F.ws + WS_MOE + RW_S) + ci3 * 4096 + F.tid * 8);
    const u32x4 tW = *(const u32x4*)((const bf16_t*)(F.ws + WS_MOE + RW_W1) + ci3 * 4096 + F.tid * 8);
    const u32x4 tZ = *(const u32x4*)((const bf16_t*)(F.ws + WS_MOE + RW_Z) + ci3 * 4096 + F.tid * 8);
    f32x4 lw4[2], lb4[2];
#pragma unroll
    for (int q = 0; q < 2; ++q) { lw4[q] = *(const f32x4*)(F.in[I_RLNW] + layer * 256 + h * 64 + 8 * (F.tid & 7) + 4 * q); lb4[q] = *(const f32x4*)(F.in[I_RLNB] + layer * 256 + h * 64 + 8 * (F.tid & 7) + 4 * q); }
    rwkv_prep<3>(F, layer, b, h, c);
    LAS float* Vv = (LAS float*)(F.lds + RW_V); LAS float* Oo = (LAS float*)(F.lds + R3_O);
    LAS float* Gg = (LAS float*)(F.lds + R3_G); LAS float* BON = (LAS float*)(F.lds + R3_BON);
    LAS bf16_t* S0b = (LAS bf16_t*)(F.lds + R3_TILES); LAS bf16_t* W1b = S0b + 4608; LAS bf16_t* Zb = W1b + 4608; LAS bf16_t* VTb = Zb + 4608;
    { const int row = F.tid >> 3, col = (F.tid & 7) * 8;
      *(LAS u32x4*)(S0b + row * RB_LD + col) = tS;
      *(LAS u32x4*)(W1b + row * RB_LD + col) = tW;
      *(LAS u32x4*)(Zb + row * RB_LD + col) = tZ;
      const int vv = F.tid & 63, part = F.tid >> 6;
      unsigned vT[4];
#pragma unroll
      for (int i = 0; i < 8; i += 2) vT[i >> 1] = pk2(Vv[(8 * part + i) * 64 + vv], Vv[(8 * part + i + 1) * 64 + vv]);
      *(LAS u32x4*)(VTb + vv * RB_LD + 8 * part) = (u32x4){vT[0], vT[1], vT[2], vT[3]}; }
    __syncthreads();
    { const int lane = F.lane, mt = F.wave >> 1, nt0 = 2 * (F.wave & 1), r = lane & 15, g4 = lane >> 4;
      bf16x8 fa0[2], fa1[2], fb0[2][2], fb1[2][2];
      ld_fr(W1b, 16 * mt, lane, fa0); ld_fr(Zb, 16 * mt, lane, fa1);
#pragma unroll
      for (int q = 0; q < 2; ++q) { ld_fr(S0b, 16 * (nt0 + q), lane, fb0[q]); ld_fr(VTb, 16 * (nt0 + q), lane, fb1[q]); }
#pragma unroll
      for (int q = 0; q < 2; ++q) { const int nt = nt0 + q;
          f32x4 o = mm_fr(fa0, fb0[q], (f32x4){0.f, 0.f, 0.f, 0.f});
          o = mm_fr(fa1, fb1[q], o);
#pragma unroll
          for (int i = 0; i < 4; ++i) Oo[(16 * mt + 4 * g4 + i) * 64 + 16 * nt + r] = o[i]; } }
    __syncthreads();
    { const int t = F.tid >> 3, p8 = F.tid & 7;
      float o[8]; float sm = 0.f;
#pragma unroll
      for (int q = 0; q < 2; ++q) { const f32x4 o4 = *(const LAS f32x4*)(Oo + t * 64 + 8 * p8 + 4 * q);
#pragma unroll
          for (int j = 0; j < 4; ++j) { o[4 * q + j] = o4[j]; sm += o4[j]; } }
      const float mean = sum8(sm) * (1.0f / 64.0f); float vs = 0.f;
#pragma unroll
      for (int j = 0; j < 8; ++j) { o[j] -= mean; vs += o[j] * o[j]; }
      const float rstd = rsqrtf(sum8(vs) * (1.0f / 64.0f) + 64e-5f); const float bon = BON[t];
      float y[8];
#pragma unroll
      for (int q = 0; q < 2; ++q) { const f32x4 v4 = *(const LAS f32x4*)(Vv + t * 64 + 8 * p8 + 4 * q), g4v = *(const LAS f32x4*)(Gg + t * 64 + 8 * p8 + 4 * q);
#pragma unroll
          for (int j = 0; j < 4; ++j) y[4 * q + j] = (o[4 * q + j] * rstd * lw4[q][j] + lb4[q][j] + bon * v4[j]) * g4v[j]; }
      *(u32x4*)((bf16_t*)(F.ws + WS_H) + (T0 + t) * DM + 256 + h * 64 + 8 * p8) = (u32x4){pk2(y[0], y[1]), pk2(y[2], y[3]), pk2(y[4], y[5]), pk2(y[6], y[7])}; }
}

constexpr int DS_SEL = 131072, DS_HIST = 135168, DS_BKT = 151552, DS_BIAS = 152064;
__device__ __forceinline__ void dsa_tables(const Frame& F_) { Frame F = relocal(F_);
    LAS int* bkt = (LAS int*)(F.lds + DS_BKT); LAS float* biasT = (LAS float*)(F.lds + DS_BIAS);
    if (F.tid < 128) { const int n = F.tid; int bk = n; if (n >= 16) { const float lr = logf((float)n / 16.0f) / 2.0794415416798357f; bk = 16 + (int)(lr * 16.0f); bk = bk < 31 ? bk : 31; } bkt[n] = bk; biasT[n] = F.in[I_RELB][n]; }
    __syncthreads();
}
__device__ __forceinline__ unsigned fkey(float f) { const unsigned u = __float_as_uint(f); return (u & 0x80000000u) ? ~u : (u | 0x80000000u); }
__device__ __forceinline__ void item_dsa(const Frame& F_, int layer, int item) { Frame F = relocal(F_);
    const bf16_t* U = (const bf16_t*)(F.ws + WS_U); const bf16_t* KI = (const bf16_t*)(F.ws + WS_KIDX);
    const bf16_t* Kb = (const bf16_t*)(F.ws + WS_K); const bf16_t* Vb = (const bf16_t*)(F.ws + WS_V);
    const int b = item & 3, qg = 511 - (item >> 2); const size_t TB = (size_t)b * SEQ, T0 = TB + qg * 8;
    LAS float* sc = (LAS float*)F.lds; LAS unsigned short* selall = (LAS unsigned short*)(F.lds + DS_SEL); LAS unsigned* histall = (LAS unsigned*)(F.lds + DS_HIST);
    LAS int* bkt = (LAS int*)(F.lds + DS_BKT); LAS float* biasT = (LAS float*)(F.lds + DS_BIAS);
    const int lane = F.lane, hh = lane >> 5;
    {
        bf16x8 af[2][2]; float wq[2][2][8];
        { const int r = lane & 31, q4 = 2 * ((r >> 2) & 1) + (r >> 4), head = 4 * ((r >> 3) & 1) + (r & 3);
#pragma unroll
          for (int mt = 0; mt < 2; ++mt)
#pragma unroll
              for (int ks = 0; ks < 2; ++ks) af[mt][ks] = *(const bf16x8*)(U + (T0 + 4 * mt + q4) * NINP + UC + 384 + head * 32 + 16 * ks + 8 * hh); }
#pragma unroll
        for (int mt = 0; mt < 2; ++mt)
#pragma unroll
            for (int q2 = 0; q2 < 2; ++q2) { float f[8]; unpack8(*(const u32x4*)(U + (T0 + 4 * mt + 2 * hh + q2) * NINP + UC + 672), f);
#pragma unroll
                for (int hd = 0; hd < 8; ++hd) wq[mt][q2][hd] = f[hd]; }
        const int ntile = (qg * 8 + 8 + 31) >> 5;
        bf16x8 nb0 = af[0][0], nb1 = af[0][0];
        if (F.wave < ntile) { const int key = F.wave * 32 + (lane & 31); nb0 = *(const bf16x8*)(KI + (TB + key) * 32 + 8 * hh); nb1 = *(const bf16x8*)(KI + (TB + key) * 32 + 16 + 8 * hh); }
        for (int kt = F.wave; kt < ntile; kt += 8) {
            const int key = kt * 32 + (lane & 31);
            const bf16x8 b0 = nb0, b1 = nb1;
            if (kt + 8 < ntile) { const int k2 = key + 256; nb0 = *(const bf16x8*)(KI + (TB + k2) * 32 + 8 * hh); nb1 = *(const bf16x8*)(KI + (TB + k2) * 32 + 16 + 8 * hh); }
#pragma unroll
            for (int mt = 0; mt < 2; ++mt) { f32x16 acc;
#pragma unroll
                for (int i = 0; i < 16; ++i) acc[i] = 0.f;
                acc = __builtin_amdgcn_mfma_f32_32x32x16_bf16(af[mt][0], b0, acc, 0, 0, 0);
                acc = __builtin_amdgcn_mfma_f32_32x32x16_bf16(af[mt][1], b1, acc, 0, 0, 0);
#pragma unroll
                for (int q2 = 0; q2 < 2; ++q2) { float s = 0.f;
#pragma unroll
                    for (int hd = 0; hd < 8; ++hd) s += fmaxf(acc[8 * q2 + hd], 0.f) * wq[mt][q2][hd];
                    const int qi = 4 * mt + 2 * hh + q2;
                    sc[qi * 4096 + key] = (key <= qg * 8 + qi) ? s : -INFINITY; } }
        }
    }
    __syncthreads();
    const int qi = F.wave, tq = qg * 8 + qi, n = tq + 1;
    LAS float* scq = sc + qi * 4096; LAS unsigned short* sel = selall + qi * 256; LAS unsigned* hist = histall + qi * 512;
    int nsel;
    if (n <= 256) { nsel = n; for (int j = lane; j < 256; j += 64) sel[j] = (unsigned short)(j < n ? j : 0); }
    else {
        nsel = 256;
        const int R = (n + 63) >> 6; const unsigned long long ltm = (1ull << lane) - 1ull;
        float lo = INFINITY, hi = -INFINITY;
        const int R4 = (n + 255) >> 8;
#pragma unroll 4
        for (int i = 0; i < R4; ++i) { const int j0 = 256 * i + 4 * lane; const f32x4 v4 = *(const LAS f32x4*)(scq + j0);
#pragma unroll
            for (int q = 0; q < 4; ++q) { const bool valid = j0 + q < n; lo = fminf(lo, valid ? v4[q] : INFINITY); hi = fmaxf(hi, valid ? v4[q] : -INFINITY); } }
        lo = wave_min(lo); hi = wave_max(hi);
        bool slow = false;
        if (!(hi > lo)) { for (int j = lane; j < 256; j += 64) sel[j] = (unsigned short)j; }
        else {
            const float scale = 1023.0f / (hi - lo);
            *(LAS u32x4*)(hist + 8 * lane) = (u32x4){0u, 0u, 0u, 0u}; *(LAS u32x4*)(hist + 8 * lane + 4) = (u32x4){0u, 0u, 0u, 0u};
#pragma unroll 2
            for (int i = 0; i < R4; ++i) { const int j0 = 256 * i + 4 * lane; const f32x4 v4 = *(const LAS f32x4*)(scq + j0);
#pragma unroll
                for (int q = 0; q < 4; ++q) { if (j0 + q < n) { int bk = (int)((v4[q] - lo) * scale); bk = bk < 1023 ? bk : 1023;
                    atomicAdd((unsigned*)(hist + (bk >> 1)), (bk & 1) ? 65536u : 1u); } } }
            const u32x4 h0 = *(const LAS u32x4*)(hist + 8 * lane), h1 = *(const LAS u32x4*)(hist + 8 * lane + 4);
            unsigned cb[16];
            cb[0] = h0.x & 0xffffu; cb[1] = h0.x >> 16; cb[2] = h0.y & 0xffffu; cb[3] = h0.y >> 16; cb[4] = h0.z & 0xffffu; cb[5] = h0.z >> 16; cb[6] = h0.w & 0xffffu; cb[7] = h0.w >> 16;
            cb[8] = h1.x & 0xffffu; cb[9] = h1.x >> 16; cb[10] = h1.y & 0xffffu; cb[11] = h1.y >> 16; cb[12] = h1.z & 0xffffu; cb[13] = h1.z >> 16; cb[14] = h1.w & 0xffffu; cb[15] = h1.w >> 16;
            unsigned tot = 0u;
#pragma unroll
            for (int q = 0; q < 16; ++q) tot += cb[q];
            const unsigned pre = wave_prefix_u(tot); const unsigned incl = (unsigned)__builtin_amdgcn_readlane((int)pre, 63) - pre + tot;
            int fb = -1; unsigned fabove = 0u, fcnt = 0u; unsigned cum = incl - tot;
#pragma unroll
            for (int q = 15; q >= 0; --q) { if (fb < 0 && cum < 256u && 256u <= cum + cb[q]) { fb = 16 * lane + q; fabove = cum; fcnt = cb[q]; } cum += cb[q]; }
            const unsigned long long mf = __ballot(fb >= 0); const int src = (int)__ffsll((long long)mf) - 1;
            const int B = __builtin_amdgcn_readlane(fb, src); const int above = __builtin_amdgcn_readlane((int)fabove, src), cntB = __builtin_amdgcn_readlane((int)fcnt, src); const int need = 256 - above;
            if (cntB > 256) slow = true;
            else {
                LAS unsigned* cand = hist;
                int base_gt = 0, base_c = 0;
#pragma unroll 2
                for (int i = 0; i < R4; ++i) { const int j0 = 256 * i + 4 * lane; const f32x4 v4 = *(const LAS f32x4*)(scq + j0);
#pragma unroll
                    for (int q = 0; q < 4; ++q) { const int j = j0 + q; const bool valid = j < n; const float v = valid ? v4[q] : lo;
                        int bk = (int)((v - lo) * scale); bk = bk < 1023 ? bk : 1023;
                        const bool gt = valid && bk > B, eq = valid && bk == B;
                        const unsigned long long mg = __ballot(gt), me = __ballot(eq);
                        if (gt) sel[base_gt + __popcll(mg & ltm)] = (unsigned short)j;
                        if (eq) { const int p = base_c + __popcll(me & ltm); cand[2 * p] = fkey(v); cand[2 * p + 1] = (unsigned)j; }
                        base_gt += __popcll(mg); base_c += __popcll(me); } }
                if (need == cntB) { for (int c = lane; c < cntB; c += 64) sel[above + c] = (unsigned short)cand[2 * c + 1]; }
                else {
                    unsigned ck[4], cx[4]; int rk[4];
#pragma unroll
                    for (int q = 0; q < 4; ++q) { const int c = lane + 64 * q; ck[q] = c < cntB ? cand[2 * c] : 0u; cx[q] = c < cntB ? cand[2 * c + 1] : 0u; rk[q] = 0; }
                    for (int c2 = 0; c2 < cntB; ++c2) { const unsigned k2 = cand[2 * c2], x2 = cand[2 * c2 + 1];
#pragma unroll
                        for (int q = 0; q < 4; ++q) rk[q] += (k2 > ck[q] || (k2 == ck[q] && x2 < cx[q])) ? 1 : 0; }
#pragma unroll
                    for (int q = 0; q < 4; ++q) { const int c = lane + 64 * q; if (c < cntB && rk[q] < need) sel[above + rk[q]] = (unsigned short)cand[2 * c + 1]; }
                }
            }
        }
        if (slow) {
        unsigned prefix = 0u; int need = 256; unsigned neq = 0u;
        for (int p = 0; p < 4; ++p) { const int shift = 24 - 8 * p;
            *(LAS u32x4*)(hist + 4 * lane) = (u32x4){0u, 0u, 0u, 0u};
            for (int i = 0; i < R; ++i) { const int j = lane + 64 * i; if (j < n) { const unsigned u = fkey(scq[j]);
                if (p == 0 || (u >> (shift + 8)) == prefix) atomicAdd((unsigned*)(hist + ((u >> shift) & 255u)), 1u); } }
            const u32x4 hv = *(const LAS u32x4*)(hist + 4 * lane);
            const unsigned tot = hv.x + hv.y + hv.z + hv.w;
            unsigned incl = tot;
#pragma unroll
            for (int o = 1; o < 64; o <<= 1) { const unsigned t = shdown_u(incl, o); if (lane + o < 64) incl += t; }
            const unsigned above = incl - tot;
            int fb = -1; unsigned fabove = 0u, feq = 0u; unsigned cum = above;
            { const unsigned hq[4] = {hv.x, hv.y, hv.z, hv.w};
#pragma unroll
              for (int q = 3; q >= 0; --q) { if (fb < 0 && cum < (unsigned)need && (unsigned)need <= cum + hq[q]) { fb = 4 * lane + q; fabove = cum; feq = hq[q]; } cum += hq[q]; } }
            const unsigned long long m = __ballot(fb >= 0);
            const int src = (int)__ffsll((long long)m) - 1;
            const int bin = shidx_i(fb, src); const unsigned ab = (unsigned)shidx_i((int)fabove, src); neq = (unsigned)shidx_i((int)feq, src);
            need -= (int)ab; prefix = (prefix << 8) | (unsigned)bin;
        }
        const int ngt = 256 - need;
        int base_gt = 0, base_eq = 0;
        for (int i = 0; i < R; ++i) { const int j = lane + 64 * i; const unsigned u = (j < n) ? fkey(scq[j]) : 0u;
            const bool gt = (j < n) && (u > prefix), eq = (j < n) && (u == prefix);
            const unsigned long long mg = __ballot(gt), me = __ballot(eq); const unsigned long long lt = (1ull << lane) - 1ull;
            if (gt) sel[base_gt + __popcll(mg & lt)] = (unsigned short)j;
            if (eq) { const int rk = base_eq + __popcll(me & lt); if (rk < need) sel[ngt + rk] = (unsigned short)j; }
            base_gt += __popcll(mg); base_eq += __popcll(me); }
        (void)neq;
            }
    }
    const int nt16 = (nsel + 15) >> 4, r16 = lane & 15, g4 = lane >> 4;
    LAS float* biasj = scq + 2048;
#pragma unroll
    for (int q = 0; q < 4; ++q) { const int j = lane + 64 * q; f32x4 bv = (f32x4){-INFINITY, -INFINITY, -INFINITY, -INFINITY};
        if (j < nsel) { const int dist = tq - (int)sel[j]; const int bk = dist < 128 ? bkt[dist < 0 ? 0 : dist] : 31; bv = *(const LAS f32x4*)(biasT + 4 * bk); }
#pragma unroll
        for (int h = 0; h < 4; ++h) biasj[h * 256 + j] = bv[h]; }
    bf16x8 qf[2];
#pragma unroll
    for (int s = 0; s < 2; ++s) { u32x4 z = (u32x4){0u, 0u, 0u, 0u}; if (r16 < 4) z = *(const u32x4*)(U + (T0 + qi) * NINP + UC + r16 * 64 + 32 * s + 8 * g4); qf[s] = __builtin_bit_cast(bf16x8, z); }
    float lg[16][4]; float mx = -INFINITY;
#define DSA_QK(M0, NM) do { int keyr[NM]; bf16x8 a0[NM], a1[NM]; \
        _Pragma("unroll") for (int m8 = 0; m8 < NM; ++m8) keyr[m8] = sel[16 * ((M0) + m8) + r16]; \
        _Pragma("unroll") for (int m8 = 0; m8 < NM; ++m8) { a0[m8] = *(const bf16x8*)(Kb + (TB + keyr[m8]) * 64 + 8 * g4); a1[m8] = *(const bf16x8*)(Kb + (TB + keyr[m8]) * 64 + 32 + 8 * g4); } \
        _Pragma("unroll") for (int m8 = 0; m8 < NM; ++m8) { const int m = (M0) + m8; \
            f32x4 acc = (f32x4){0.f, 0.f, 0.f, 0.f}; \
            acc = __builtin_amdgcn_mfma_f32_16x16x32_bf16(a0[m8], qf[0], acc, 0, 0, 0); \
            acc = __builtin_amdgcn_mfma_f32_16x16x32_bf16(a1[m8], qf[1], acc, 0, 0, 0); \
            const f32x4 bq = *(const LAS f32x4*)(biasj + (r16 & 3) * 256 + 16 * m + 4 * g4); \
            _Pragma("unroll") for (int i = 0; i < 4; ++i) { const float v = acc[i] * 0.125f + bq[i]; lg[m][i] = v; mx = fmaxf(mx, v); } } } while (0)
    if (nt16 > 8) { DSA_QK(0, 16); }
    else { DSA_QK(0, 8);
#pragma unroll
        for (int m8 = 8; m8 < 16; ++m8)
#pragma unroll
            for (int i = 0; i < 4; ++i) lg[m8][i] = -INFINITY; }
#undef DSA_QK
    mx = xrows(mx, OpMax());
    float sm = 0.f;
#pragma unroll
    for (int m = 0; m < 16; ++m)
#pragma unroll
        for (int i = 0; i < 4; ++i) { const float p = __expf(lg[m][i] - mx); lg[m][i] = p; sm += p; }
    sm = xrows(sm, OpAdd());
    f32x4 ov[4];
#pragma unroll
    for (int nt = 0; nt < 4; ++nt) ov[nt] = (f32x4){0.f, 0.f, 0.f, 0.f};
    const unsigned vs_base = (unsigned)(unsigned long)scq;
#pragma unroll
    for (int half = 0; half < 2; ++half) {
        if (half * 8 < nt16) {
            asm volatile("s_waitcnt lgkmcnt(0)" ::: "memory");
            int vkey[16];
#pragma unroll
            for (int q = 0; q < 16; ++q) { const int rho = 8 * q + (lane >> 3);
                vkey[q] = sel[half * 128 + (rho & ~31) + 16 * ((rho >> 2) & 1) + 4 * ((rho >> 3) & 3) + (rho & 3)]; }
            asm volatile("s_waitcnt lgkmcnt(0)" : "+v"(vkey[0]), "+v"(vkey[1]), "+v"(vkey[2]), "+v"(vkey[3]), "+v"(vkey[4]), "+v"(vkey[5]), "+v"(vkey[6]), "+v"(vkey[7]),
                         "+v"(vkey[8]), "+v"(vkey[9]), "+v"(vkey[10]), "+v"(vkey[11]), "+v"(vkey[12]), "+v"(vkey[13]), "+v"(vkey[14]), "+v"(vkey[15]) :: "memory");
#pragma unroll
            for (int q = 0; q < 16; ++q)
                __builtin_amdgcn_global_load_lds((const unsigned*)(Vb + (TB + vkey[q]) * 64 + 8 * (lane & 7)), (LAS unsigned*)((LAS unsigned char*)scq + q * 1024), 16, 0, 0);
            asm volatile("s_waitcnt vmcnt(0)" ::: "memory");
#pragma unroll
            for (int s4 = 0; s4 < 4; ++s4) { const int s = half * 4 + s4;
                u32x4 pw; pw.x = pk2(lg[2 * s][0], lg[2 * s][1]); pw.y = pk2(lg[2 * s][2], lg[2 * s][3]); pw.z = pk2(lg[2 * s + 1][0], lg[2 * s + 1][1]); pw.w = pk2(lg[2 * s + 1][2], lg[2 * s + 1][3]);
                const bf16x8 pa = __builtin_bit_cast(bf16x8, pw);
                const unsigned ad = vs_base + (unsigned)((32 * s4 + 8 * g4 + (r16 >> 2)) * 128 + (r16 & 3) * 8);
                u32x2 t0[4], t1[4];
                asm volatile("ds_read_b64_tr_b16 %0, %8\n\tds_read_b64_tr_b16 %1, %8 offset:512\n\tds_read_b64_tr_b16 %2, %8 offset:32\n\tds_read_b64_tr_b16 %3, %8 offset:544\n\t"
                             "ds_read_b64_tr_b16 %4, %8 offset:64\n\tds_read_b64_tr_b16 %5, %8 offset:576\n\tds_read_b64_tr_b16 %6, %8 offset:96\n\tds_read_b64_tr_b16 %7, %8 offset:608\n\ts_waitcnt lgkmcnt(0)"
                             : "=&v"(t0[0]), "=&v"(t1[0]), "=&v"(t0[1]), "=&v"(t1[1]), "=&v"(t0[2]), "=&v"(t1[2]), "=&v"(t0[3]), "=&v"(t1[3]) : "v"(ad) : "memory");
#pragma unroll
                for (int nt = 0; nt < 4; ++nt) { const bf16x8 vb = __builtin_bit_cast(bf16x8, (u32x4){t0[nt].x, t0[nt].y, t1[nt].x, t1[nt].y});
                    ov[nt] = __builtin_amdgcn_mfma_f32_16x16x32_bf16(vb, pa, ov[nt], 0, 0, 0); } }
        }
    }
    if (r16 < 4) { const float inv = 1.0f / sm;
        bf16_t* Y = (bf16_t*)(F.ws + WS_H) + (T0 + qi) * DM + 512 + r16 * 64 + 4 * g4;
#pragma unroll
        for (int nt = 0; nt < 4; ++nt) *(u32x2*)(Y + 16 * nt) = (u32x2){pk2(ov[nt][0] * inv, ov[nt][1] * inv), pk2(ov[nt][2] * inv, ov[nt][3] * inv)}; }
}

__device__ __forceinline__ void phase_router(const Frame& F_, int layer) { Frame F = relocal(F_); const int cset = layer;
    const float* X = (const float*)(F.ws + WS_X);
    const bf16_t* WH = (const bf16_t*)(F.ws + WS_WRT) + (size_t)layer * 2 * 49152; const bf16_t* WL = WH + 49152;
    LAS float* part = (LAS float*)F.lds;
    LAS float* ssq = (LAS float*)(F.lds + 24576);
    LAS int* es = (LAS int*)(F.lds + 25088);
    LAS int* lr = (LAS int*)(F.lds + 25600);
    LAS float* wsl = (LAS float*)(F.lds + 26112);
    LAS float* rsd = (LAS float*)(F.lds + 26624);
    for (int blk = F.bid; blk < NTOK / 64; blk += F.G) {
        __syncthreads();
        const int mt = F.wave & 3, kh = F.wave >> 2, r16 = F.lane & 15, g4 = F.lane >> 4;
        const float* xr = X + ((size_t)blk * 64 + mt * 16 + r16) * DM + kh * 512 + 8 * g4;
        f32x4 acc[3]; acc[0] = acc[1] = acc[2] = (f32x4){0.f, 0.f, 0.f, 0.f}; float ss = 0.f;
#pragma unroll 4
        for (int ks = 0; ks < 16; ++ks) {
            const f32x4 xa = *(const f32x4*)(xr + ks * 32), xb = *(const f32x4*)(xr + ks * 32 + 4);
            ss += xa[0] * xa[0] + xa[1] * xa[1] + xa[2] * xa[2] + xa[3] * xa[3] + xb[0] * xb[0] + xb[1] * xb[1] + xb[2] * xb[2] + xb[3] * xb[3];
            float xv[8] = {xa[0], xa[1], xa[2], xa[3], xb[0], xb[1], xb[2], xb[3]}; unsigned hw[4], lw[4];
#pragma unroll
            for (int j = 0; j < 4; ++j) { const bf16_t h0 = f2bf(xv[2 * j]), h1 = f2bf(xv[2 * j + 1]); hw[j] = (unsigned)h0 | ((unsigned)h1 << 16);
                lw[j] = pk2(xv[2 * j] - bf2f(h0), xv[2 * j + 1] - bf2f(h1)); }
            const bf16x8 ahi = __builtin_bit_cast(bf16x8, (u32x4){hw[0], hw[1], hw[2], hw[3]}), alo = __builtin_bit_cast(bf16x8, (u32x4){lw[0], lw[1], lw[2], lw[3]});
#pragma unroll
            for (int nt = 0; nt < 3; ++nt) { const size_t wo = (size_t)(nt * 16 + r16) * 1024 + kh * 512 + ks * 32 + 8 * g4;
                const bf16x8 bh = *(const bf16x8*)(WH + wo), bl = *(const bf16x8*)(WL + wo);
                acc[nt] = __builtin_amdgcn_mfma_f32_16x16x32_bf16(ahi, bh, acc[nt], 0, 0, 0);
                acc[nt] = __builtin_amdgcn_mfma_f32_16x16x32_bf16(ahi, bl, acc[nt], 0, 0, 0);
                acc[nt] = __builtin_amdgcn_mfma_f32_16x16x32_bf16(alo, bh, acc[nt], 0, 0, 0); }
        }
        ss = xrows(ss, OpAdd());
        if (g4 == 0) ssq[kh * 64 + mt * 16 + r16] = ss;
#pragma unroll
        for (int nt = 0; nt < 3; ++nt)
#pragma unroll
            for (int i = 0; i < 4; ++i) part[(kh * 64 + mt * 16 + 4 * g4 + i) * 48 + nt * 16 + r16] = acc[nt][i];
        __syncthreads();
        if (F.tid < 64) { const float rstd = rsqrtf((ssq[F.tid] + ssq[64 + F.tid]) * (1.0f / DM) + 1e-6f); rsd[F.tid] = rstd;
            float l[36];
#pragma unroll
            for (int o = 0; o < 36; ++o) l[o] = (part[F.tid * 48 + o] + part[(64 + F.tid) * 48 + o]) * rstd + (o < 32 ? F.in[I_BRE][layer * 32 + o] : F.in[I_BRG][layer * 4 + o - 32]);
            int gs = 0; float gm = l[32];
#pragma unroll
            for (int j = 1; j < 4; ++j) if (l[32 + j] > gm) { gm = l[32 + j]; gs = j; }
            float den = 0.f;
#pragma unroll
            for (int j = 0; j < 4; ++j) den += __expf(l[32 + j] - gm);
            const float gate = 1.0f / den;
            float e8[8];
#pragma unroll
            for (int j = 0; j < 8; ++j) e8[j] = gs == 0 ? l[j] : gs == 1 ? l[8 + j] : gs == 2 ? l[16 + j] : l[24 + j];
            int i1 = 0; float v1 = e8[0];
#pragma unroll
            for (int j = 1; j < 8; ++j) if (e8[j] > v1) { v1 = e8[j]; i1 = j; }
            int i2 = -1; float v2 = -INFINITY;
#pragma unroll
            for (int j = 0; j < 8; ++j) if (j != i1 && e8[j] > v2) { v2 = e8[j]; i2 = j; }
            const float e2 = __expf(v2 - v1); const float p1 = 1.0f / (1.0f + e2);
            es[F.tid * 2] = gs * 8 + i1; es[F.tid * 2 + 1] = gs * 8 + i2; wsl[F.tid * 2] = p1 * gate; wsl[F.tid * 2 + 1] = (1.0f - p1) * gate; }
        __syncthreads();
        if (F.tid < 32) { int cnt = 0; for (int i = 0; i < 128; ++i) if (es[i] == F.tid) lr[i] = cnt++;
            if (cnt) { const int base = (int)__hip_atomic_fetch_add(F.ctl + CW_CNT + cset * 32 + F.tid, (unsigned)cnt, __ATOMIC_RELAXED, __HIP_MEMORY_SCOPE_AGENT);
                for (int i = 0; i < 128; ++i) if (es[i] == F.tid) lr[i] += base; } }
        __syncthreads();
        if (F.tid < 64) { int* rt = (int*)(F.ws + WS_ROUTE) + ((size_t)blk * 64 + F.tid) * 8;
            rt[0] = es[F.tid * 2]; rt[1] = es[F.tid * 2 + 1]; ((float*)rt)[2] = wsl[F.tid * 2]; ((float*)rt)[3] = wsl[F.tid * 2 + 1]; rt[4] = lr[F.tid * 2]; rt[5] = lr[F.tid * 2 + 1]; ((float*)rt)[6] = rsd[F.tid]; }
    }
    __syncthreads();
    if (F.tid == 0) __hip_atomic_fetch_add(F.ctl + CW_RB + 64 * layer, 1u, __ATOMIC_RELAXED, __HIP_MEMORY_SCOPE_AGENT);
}
__device__ __forceinline__ void phase_moe_convert(const Frame& F_, int layer) { Frame F = relocal(F_);
    bf16_t* WGU = (bf16_t*)(F.ws + WS_MOE + MOE_WGU);
    for (int t = F.bid; t < 1024; t += F.G) {
        const int e = t >> 5, r = t & 31, kt = r >> 1, nt = r & 1; const size_t eo = ((size_t)layer * 32 + e) * 1024 * 256;
        tr_tile(F, 256, WGU + (size_t)e * 512 * 1024, 1024, kt * 64, nt * 256, SmGU{F.in[I_WGATE] + eo, F.in[I_WUP] + eo}); }
}
__device__ __forceinline__ void phase_moe_convert_down(const Frame& F_, int layer) { Frame F = relocal(F_);
    bf16_t* WD = (bf16_t*)(F.ws + WS_MOE + MOE_WD);
    for (;;) { const int q = q_pop(F, 32 + layer); if (q >= 512) break;
        const int e = q >> 4, r = q & 15, kt = r >> 2, nt = r & 3;
        tr_tile(F, 1024, WD + (size_t)e * 1024 * 256, 256, kt * 64, nt * 256, SmId{F.in[I_WDOWN] + ((size_t)layer * 32 + e) * 256 * 1024}); }
}
__device__ __forceinline__ void phase_gather(const Frame& F_, int layer) { Frame F = relocal(F_);
    LAS int* off = (LAS int*)F.lds;
    __syncthreads();
    if (F.tid == 0) { unsigned sp = 0;
        while (__hip_atomic_load(F.ctl + CW_RB + 64 * layer, __ATOMIC_RELAXED, __HIP_MEMORY_SCOPE_AGENT) < (unsigned)F.G) { __builtin_amdgcn_s_sleep(2); if (++sp > (1u << 22)) break; } }
    __syncthreads();
    if (F.tid == 0) { int acc = 0; for (int e = 0; e < 32; ++e) { off[e] = acc; const int c = (int)__hip_atomic_load(F.ctl + CW_CNT + layer * 32 + e, __ATOMIC_RELAXED, __HIP_MEMORY_SCOPE_AGENT); acc += (c + 255) & ~255; } off[32] = acc; }
    __syncthreads();
    int* tiles = (int*)(F.ws + WS_TILES); int* row_tok = (int*)(F.ws + WS_ROWS); float* row_w = (float*)(F.ws + WS_ROWS) + MAXROWS;
    if (F.bid == 0) { if (F.tid == 0) tiles[0] = off[32] >> 8; if (F.tid < 33) tiles[1 + F.tid] = off[F.tid];
        if (F.tid < 32) for (int rt = off[F.tid] >> 8; rt < (off[F.tid + 1] >> 8); ++rt) tiles[64 + rt] = F.tid; }
    for (int e = F.bid; e < 32; e += F.G) { const int c = (int)__hip_atomic_load(F.ctl + CW_CNT + layer * 32 + e, __ATOMIC_RELAXED, __HIP_MEMORY_SCOPE_AGENT);
        for (int r = off[e] + c + F.tid; r < off[e + 1]; r += NTHR) { row_tok[r] = -1; row_w[r] = 0.f; } }
    const float* X = (const float*)(F.ws + WS_X); bf16_t* HP = (bf16_t*)(F.ws + WS_U); const float* nw = F.in[I_NORM2] + (size_t)layer * DM;
    f32x4 nwv[4];
#pragma unroll
    for (int j = 0; j < 4; ++j) nwv[j] = *(const f32x4*)(nw + 4 * F.lane + 256 * j);
    for (int blk = F.bid; blk < NTOK / 64; blk += F.G)
    for (int i4 = 0; i4 < 2; ++i4) {
        int p0[4], p1[4], tt[4]; float rstd[4], w0[4], w1[4]; f32x4 xv[4][4];
#pragma unroll
        for (int r = 0; r < 4; ++r) { const int t = blk * 64 + F.wave * 8 + 4 * i4 + r; tt[r] = t;
            const int* rt = (const int*)(F.ws + WS_ROUTE) + (size_t)t * 8; rstd[r] = ((const float*)rt)[6]; w0[r] = ((const float*)rt)[2]; w1[r] = ((const float*)rt)[3];
            p0[r] = off[rt[0]] + rt[4]; p1[r] = off[rt[1]] + rt[5];
#pragma unroll
            for (int j = 0; j < 4; ++j) xv[r][j] = *(const f32x4*)(X + (size_t)t * DM + 4 * F.lane + 256 * j); }
#pragma unroll
        for (int r = 0; r < 4; ++r) {
#pragma unroll
            for (int j = 0; j < 4; ++j) { const int c = 4 * F.lane + 256 * j; const f32x4 v = xv[r][j] * rstd[r] * nwv[j];
                u32x2 o; o.x = pk2(v[0], v[1]); o.y = pk2(v[2], v[3]);
                *(u32x2*)(HP + (size_t)tt[r] * DM + c) = o; }
            if (F.lane == 0) { row_tok[p0[r]] = tt[r] * 2; row_w[p0[r]] = w0[r]; row_tok[p1[r]] = tt[r] * 2 + 1; row_w[p1[r]] = w1[r]; } }
    }
}

constexpr int NPH_LAYER = 9, NPHASE = 1 + 2 * NPH_LAYER + 1;
#ifndef MK_ONLY
#define MK_ONLY -1
#endif
#ifndef MK_ITEM
#define MK_ITEM -1
#endif
#define EN(o) (MK_ONLY < 0 || MK_ONLY == (o))
#define IT(o) (MK_ITEM < 0 || MK_ITEM == (o))
__global__ void __launch_bounds__(NTHR, 2) mk_forward(Params P) {
    extern __shared__ __attribute__((aligned(16))) unsigned char lds_raw[];
    Frame F; F.lds = (LAS unsigned char*)lds_raw; F.tid = threadIdx.x; F.lane = F.tid & 63; F.wave = __builtin_amdgcn_readfirstlane(F.tid >> 6); F.bid = blockIdx.x; F.G = gridDim.x;
    F.in = (in_tab_t)__builtin_amdgcn_kernarg_segment_ptr(); F.out = P.out; F.ws = P.ws; F.ctl = (unsigned*)(P.ws + WS_CTL); F.misc = (volatile LAS int*)(F.lds + MISC_OFF);
    if (F.tid < 64) ((LAS unsigned*)(F.lds + MISC_OFF))[F.tid] = 0u;
    __syncthreads();
    const int lo = P.ph_lo, hi = P.ph_hi;
    XcdBarrier bar; bar.bar = F.ctl + CW_BAR; bar.x = 0; bar.st = (volatile LAS unsigned*)(F.lds + MISC_OFF + 16);
    if (hi - lo > 1) bar = xcd_barrier_post(F.ctl + CW_BAR, (volatile LAS unsigned*)(F.lds + MISC_OFF + 16));
#define IN(k) (lo <= (k) && (k) < hi)
#define SEAM(k) do { if (IN(k) && IN((k) + 1)) xcd_barrier(bar); } while (0)
#define QLOOP(qi, n, body) for (;;) { const int it = q_pop(F, layer * 12 + (qi)); if (it >= (n)) break; body; }
    if (EN(100) && IN(0)) { phase_prologue(F); phase_norm(F, F.in[I_X], false, F.in[I_NORM1], 3); } SEAM(0);
#pragma unroll
    for (int layer = 0; layer < DEPTH; ++layer) {
        const int pb = 1 + layer * NPH_LAYER;
        if (layer > 0) { if (EN(0) && IN(pb + 0)) { phase_norm(F, (const float*)(F.ws + WS_X), true, F.in[I_NORM1] + (size_t)layer * DM, 0); } SEAM(pb + 0); }
        if (EN(1) && IN(pb + 1)) { const Frame F_ = F; Frame F = relocal(F_); pg8::StaticOrder S; S.init((const bf16_t*)(F.ws + WS_H), (const bf16_t*)(F.ws + WS_WIN) + (size_t)layer * NINP * DM, NTOK, NINP, DM, F.G, F.bid);
            pg8::EpiBf16 E{(bf16_t*)(F.ws + WS_U), NINP}; pg8::gemm_phase(F.lds, DM, S, E); } SEAM(pb + 1);
#define SLOOP(n, body) for (int it = F.bid; it < (n); it += F.G) { __syncthreads(); body; }
        if (EN(2) && IN(pb + 2)) {
            if (IT(1)) SLOOP(1024, item_rwkv1(F, layer, it));
            if (IT(0)) SLOOP(256, item_s5<1>(F, layer, it));
            if (IT(2)) SLOOP(256, item_mamba<1>(F, layer, it));
            if (IT(3)) SLOOP(256, item_kv(F, layer, it));
        } SEAM(pb + 2);
        if (EN(3) && IN(pb + 3)) {
            if (IT(0)) SLOOP(8, item_rwkv_carry(F, it));
            if (IT(1)) { for (int it = F.bid - 8; it >= 0 && it < 16; it += F.G) { __syncthreads(); item_mamba_carry(F, it); } }
            if (IT(2)) { for (int it = F.bid - 24; it >= 0 && it < 4; it += F.G) { __syncthreads(); item_s5_carry(F, layer, it); } }
            if (IT(3)) {
                dsa_tables(F);
                const int pref = (int)(xb_xcc_id() & 3u);
#pragma unroll 1
                for (int k4 = 0; k4 < 4; ++k4) { const int bq = (pref + k4) & 3;
                    for (;;) { const int it = q_pop(F, 24 + layer * 4 + bq); if (it >= 512) break; item_dsa(F, layer, it * 4 + bq); } } }
        } SEAM(pb + 3);
        if (EN(4) && IN(pb + 4)) {
            if (IT(0)) SLOOP(256, item_s5<2>(F, layer, it));
            if (IT(2)) SLOOP(256, item_mamba<2>(F, layer, it));
            if (IT(1)) SLOOP(1024, item_rwkv3(F, layer, it));
        } SEAM(pb + 4);
        if (EN(6) && IN(pb + 5)) { const Frame F_ = F; Frame F = relocal(F_); pg8::StaticOrder S; S.init((const bf16_t*)(F.ws + WS_H), (const bf16_t*)(F.ws + WS_WOUT) + (size_t)layer * DM * DM, NTOK, DM, DM, F.G, F.bid);
            pg8::EpiResid E{layer == 0 ? F.in[I_X] : (const float*)(F.ws + WS_X), (float*)(F.ws + WS_X), DM}; pg8::gemm_phase(F.lds, DM, S, E); } SEAM(pb + 5);
        if (EN(7) && IN(pb + 6)) { phase_router(F, layer); phase_moe_convert(F, layer); phase_gather(F, layer); } SEAM(pb + 6);
        if (EN(8) && IN(pb + 7)) { const Frame F_ = F; Frame F = relocal(F_); LAS int* ul = (LAS int*)(F.lds + pg8::STAGE_BYTES + 8192); if (F.tid == 0) pg8::MoeOrder::build(ul, (const int*)(F.ws + WS_TILES), 2, F.G, F.bid); __syncthreads();
            pg8::MoeOrder S{DM, (const char*)(F.ws + WS_U), (const char*)(F.ws + WS_MOE + MOE_WGU), (size_t)512 * 1024 * 2, ul};
            pg8::EpiGated<1> E{(bf16_t*)(F.ws + WS_H), 256, 0, nullptr, nullptr}; pg8::gemm_phase<pg8::EpiGated<1>, pg8::MoeOrder, true>(F.lds, DM, S, E, (const char*)(F.ws + WS_U), (const int*)(F.ws + WS_ROWS)); phase_moe_convert_down(F, layer); } SEAM(pb + 7);
        if (EN(9) && IN(pb + 8)) { const Frame F_ = F; Frame F = relocal(F_); LAS int* ul = (LAS int*)(F.lds + pg8::STAGE_BYTES + 8192); if (F.tid == 0) pg8::MoeOrder::build(ul, (const int*)(F.ws + WS_TILES), 4, F.G, F.bid); __syncthreads();
            pg8::MoeOrder S{256, (const char*)(F.ws + WS_H), (const char*)(F.ws + WS_MOE + MOE_WD), (size_t)1024 * 256 * 2, ul};
            pg8::EpiMoeOut E{(bf16_t*)(F.ws + WS_U), (const int*)(F.ws + WS_ROWS), (const float*)(F.ws + WS_ROWS) + MAXROWS, F.lds}; pg8::gemm_phase(F.lds, 256, S, E); } SEAM(pb + 8);
    }
    if (EN(101) && IN(NPHASE - 1)) { phase_norm(F, (const float*)(F.ws + WS_X), true, F.in[I_FNORM], 2); }
#undef IN
#undef SEAM
}

#ifndef MK_SPLIT
#define MK_SPLIT 0
#endif
extern "C" void kernel_launch(void* const* d_in, const int* in_sizes, int n_in, void* d_out, int out_size, void* d_ws, size_t ws_size, hipStream_t stream) {
    static int grid = 0;
    if (grid == 0) {
        if (n_in != 44 || out_size != NTOK * DM || ws_size < WS_END) { fprintf(stderr, "kernel_launch: unexpected shapes (n_in %d out %d ws %zu need %zu)\n", n_in, out_size, ws_size, (size_t)WS_END); grid = -1; return; }
        int dev = 0, cus = 0;
        if (hipGetDevice(&dev) != hipSuccess || hipDeviceGetAttribute(&cus, hipDeviceAttributeMultiprocessorCount, dev) != hipSuccess) { grid = -1; return; }
        if (hipFuncSetAttribute((const void*)mk_forward, hipFuncAttributeMaxDynamicSharedMemorySize, LDS_BYTES) != hipSuccess) { fprintf(stderr, "kernel_launch: hipFuncSetAttribute failed\n"); grid = -1; return; }
        int per_cu = 0;
        if (hipOccupancyMaxActiveBlocksPerMultiprocessor(&per_cu, (const void*)mk_forward, NTHR, LDS_BYTES) != hipSuccess || per_cu < 1) { fprintf(stderr, "kernel_launch: occupancy query says %d\n", per_cu); }
        (void)hipGetLastError();
        grid = cus;
    }
    if (grid < 0) return;
    hipMemsetAsync((char*)d_ws + WS_CTL, 0, CTL_BYTES, stream);
    Params p{};
    for (int i = 0; i < 44; ++i) p.in[i] = (const float*)d_in[i];
    p.out = (float*)d_out; p.ws = (unsigned char*)d_ws;
#if MK_SPLIT
    for (int ph = 0; ph < NPHASE; ++ph) { p.ph_lo = ph; p.ph_hi = ph + 1; hipLaunchKernelGGL(mk_forward, dim3(grid), dim3(NTHR), LDS_BYTES, stream, p); }
#else
    p.ph_lo = 0; p.ph_hi = NPHASE; hipLaunchKernelGGL(mk_forward, dim3(grid), dim3(NTHR), LDS_BYTES, stream, p);
#endif
}
```
